# Optimizing an MI355X kernel written in HIP

```python
import math
import jax
import jax.numpy as jnp
from jax import lax
import numpy as np

D_MODEL = 1024
BATCH = 8
SEQ = 2048
DEPTH = 2

HEAD_DIM = 64
A_HEADS = 6
A_KV_HEADS = 2
A_GROUP = A_HEADS // A_KV_HEADS
A_WIDTH = A_HEADS * HEAD_DIM
CMP_BLOCK = 32
CMP_STRIDE = 16
SEL_BLOCK = 64
N_SELECT = 16
WINDOW = 512
NSA_Q_BLOCK = 64
FORCE = 1e4
B_HEADS = 4
B_WIDTH = B_HEADS * HEAD_DIM
CONV_K = 4
MLSTM_CHUNK = 64
C_HEADS = 6
C_NOPE = 64
C_ROPE = 32
C_V = 64
C_WIDTH = C_HEADS * C_V
Q_RANK = 192
KV_RANK = 128
ROPE_THETA = 10000.0
ATTN_Q_BLOCK = 128
D_MIX = A_WIDTH + B_WIDTH + C_WIDTH
REL_BUCKETS = 32
REL_MAX_DIST = 128
N_GROUPS = 4
EXPERTS_PER_GROUP = 8
N_EXPERTS = N_GROUPS * EXPERTS_PER_GROUP
TOP_K_INNER = 2
D_EXPERT = 256
EPS = 1e-6
NEG = -1e30
IN_SPLITS = (A_WIDTH, 3 * 2 * A_KV_HEADS * HEAD_DIM, 3 * A_HEADS,
             2 * B_WIDTH, B_WIDTH, 2 * B_HEADS, B_WIDTH,
             Q_RANK, KV_RANK, C_ROPE)
D_IN = 384 + 768 + 18 + 512 + 256 + 8 + 256 + 192 + 128 + 32

kernel_name = 'hybrid_nsa_mlstm_mla_hmoe'


def split_points():
    pts, acc = [], 0
    for w in IN_SPLITS[:-1]:
        acc += w
        pts.append(acc)
    return pts


def rms_norm(x, g):
    xf = x.astype(jnp.float32)
    y = xf * lax.rsqrt(jnp.mean(xf * xf, axis=-1, keepdims=True) + EPS)
    return (y * g.astype(jnp.float32)).astype(x.dtype)


def masked_softmax(logits, mask):
    p = jax.nn.softmax(jnp.where(mask, logits, NEG), axis=-1)
    return jnp.where(mask, p, 0.0)


def t5_bucket(dist):
    n = jnp.maximum(dist, 0)
    exact = REL_BUCKETS // 2
    nf = jnp.maximum(n, 1).astype(jnp.float32)
    large = exact + (jnp.log(nf / exact) / math.log(REL_MAX_DIST / exact)
                     * (REL_BUCKETS - exact)).astype(jnp.int32)
    large = jnp.minimum(large, REL_BUCKETS - 1)
    return jnp.where(n < exact, n, large)


def rope(x, positions):
    half = x.shape[-1] // 2
    inv = 1.0 / (ROPE_THETA ** (jnp.arange(half, dtype=jnp.float32) * 2.0 / x.shape[-1]))
    ang = positions.astype(jnp.float32)[:, :, None, None] * inv
    cos, sin = jnp.cos(ang).astype(x.dtype), jnp.sin(ang).astype(x.dtype)
    x1, x2 = x[..., :half], x[..., half:]
    return jnp.concatenate([x1 * cos - x2 * sin, x2 * cos + x1 * sin], axis=-1)


def causal_dwconv(x, w):
    T = x.shape[1]
    xp = jnp.pad(x, ((0, 0), (CONV_K - 1, 0), (0, 0)))
    y = xp[:, 0:T] * w[0]
    for j in range(1, CONV_K):
        y = y + xp[:, j:j + T] * w[j]
    return y


def nsa_mixer(q, kv, gates, rel_bias, cmp_pe, cmp_w1, cmp_w2, q_norm_g, k_norm_g):
    bsz, T, _ = q.shape
    dt = q.dtype
    f32 = jnp.float32
    scale = HEAD_DIM ** -0.5
    n_cmp = (T - CMP_BLOCK) // CMP_STRIDE + 1
    n_sel = T // SEL_BLOCK
    k_top = min(N_SELECT, n_sel)
    qh = rms_norm(q.reshape(bsz, T, A_HEADS, HEAD_DIM), q_norm_g)
    qh = qh.reshape(bsz, T, A_KV_HEADS, A_GROUP, HEAD_DIM).transpose(0, 2, 3, 1, 4)
    kv = kv.reshape(bsz, T, 3, 2, A_KV_HEADS, HEAD_DIM)

    def to_heads(t):
        return t.transpose(0, 2, 1, 3)

    starts = jnp.arange(n_cmp) * CMP_STRIDE
    cmp_end = starts + (CMP_BLOCK - 1)
    tok = starts[:, None] + jnp.arange(CMP_BLOCK)[None, :]
    blk = kv[:, :, 0][:, tok]
    blk = blk + cmp_pe.transpose(1, 0, 2)[:, :, None, :]
    hid = jax.nn.silu(jnp.einsum('bnlshd,sldf->bnshf', blk, cmp_w1))
    comp = jnp.einsum('bnshf,sfd->bnshd', hid, cmp_w2)
    k_cmp = rms_norm(comp[:, :, 0], k_norm_g).transpose(0, 2, 1, 3)
    v_cmp = comp[:, :, 1].transpose(0, 2, 1, 3)
    k_slc = to_heads(rms_norm(kv[:, :, 1, 0], k_norm_g)).reshape(bsz, A_KV_HEADS, n_sel, SEL_BLOCK, HEAD_DIM)
    v_slc = to_heads(kv[:, :, 1, 1]).reshape(bsz, A_KV_HEADS, n_sel, SEL_BLOCK, HEAD_DIM)
    sel_id = jnp.arange(n_sel)
    overlap = ((starts[:, None] < (sel_id[None, :] + 1) * SEL_BLOCK)
               & (starts[:, None] + CMP_BLOCK > sel_id[None, :] * SEL_BLOCK)).astype(f32)
    pad = ((0, 0), (0, 0), (WINDOW, 0), (0, 0))
    k_win = jnp.pad(to_heads(rms_norm(kv[:, :, 2, 0], k_norm_g)), pad)
    v_win = jnp.pad(to_heads(kv[:, :, 2, 1]), pad)
    g = jax.nn.sigmoid(gates.astype(f32)).reshape(bsz, T, A_KV_HEADS, A_GROUP, 3).transpose(0, 2, 3, 1, 4)
    bias_tbl = rel_bias.astype(f32).reshape(REL_BUCKETS, A_KV_HEADS, A_GROUP)
    b_idx = jnp.arange(bsz)[:, None, None, None]
    h_idx = jnp.arange(A_KV_HEADS)[None, :, None, None]

    def head_bias(dist):
        return bias_tbl[t5_bucket(dist)].transpose(2, 3, 0, 1)

    def block(i):
        t0 = i * NSA_Q_BLOCK
        tq = t0 + jnp.arange(NSA_Q_BLOCK)
        qb = lax.dynamic_slice_in_dim(qh, t0, NSA_Q_BLOCK, axis=3)
        gb = lax.dynamic_slice_in_dim(g, t0, NSA_Q_BLOCK, axis=3).astype(dt)
        dist_c = tq[:, None] - cmp_end[None, :]
        lc = jnp.einsum('bhgqd,bhnd->bhgqn', qb, k_cmp).astype(f32) * scale + head_bias(dist_c)
        pc = masked_softmax(lc, dist_c >= 0)
        o_c = jnp.einsum('bhgqn,bhnd->bhgqd', pc.astype(dt), v_cmp)
        ps = jnp.einsum('bhgqn,ns->bhqs', pc, overlap)
        cur = tq[:, None] // SEL_BLOCK
        forced = (sel_id[None, :] == 0) | (sel_id[None, :] == cur) | (sel_id[None, :] == cur - 1)
        ps = jnp.where(forced, ps + FORCE, ps)
        ps = jnp.where(sel_id[None, :] <= cur, ps, -1.0)
        top_s, top_i = lax.top_k(ps, k_top)
        n_tok = k_top * SEL_BLOCK
        ks = k_slc[b_idx, h_idx, top_i].reshape(bsz, A_KV_HEADS, NSA_Q_BLOCK, n_tok, HEAD_DIM)
        vs = v_slc[b_idx, h_idx, top_i].reshape(bsz, A_KV_HEADS, NSA_Q_BLOCK, n_tok, HEAD_DIM)
        pos_s = (top_i[..., None] * SEL_BLOCK + jnp.arange(SEL_BLOCK)).reshape(bsz, A_KV_HEADS, NSA_Q_BLOCK, n_tok)
        dist_s = tq[:, None] - pos_s
        mask_s = (dist_s >= 0) & jnp.repeat(top_s >= 0, SEL_BLOCK, axis=-1)
        bias_s = bias_tbl[t5_bucket(dist_s), h_idx].transpose(0, 1, 4, 2, 3)
        ls = jnp.einsum('bhgqd,bhqnd->bhgqn', qb, ks).astype(f32) * scale + bias_s
        p_s = masked_softmax(ls, mask_s[:, :, None])
        o_s = jnp.einsum('bhgqn,bhqnd->bhgqd', p_s.astype(dt), vs)
        kw = lax.dynamic_slice_in_dim(k_win, t0, WINDOW + NSA_Q_BLOCK, axis=2)
        vw = lax.dynamic_slice_in_dim(v_win, t0, WINDOW + NSA_Q_BLOCK, axis=2)
        pos_w = t0 - WINDOW + jnp.arange(WINDOW + NSA_Q_BLOCK)
        dist_w = tq[:, None] - pos_w[None, :]
        mask_w = (dist_w >= 0) & (dist_w < WINDOW) & (pos_w[None, :] >= 0)
        lw = jnp.einsum('bhgqd,bhkd->bhgqk', qb, kw).astype(f32) * scale + head_bias(dist_w)
        p_w = masked_softmax(lw, mask_w)
        o_w = jnp.einsum('bhgqk,bhkd->bhgqd', p_w.astype(dt), vw)
        return gb[..., 0:1] * o_c + gb[..., 1:2] * o_s + gb[..., 2:3] * o_w

    out = lax.map(block, jnp.arange(T // NSA_Q_BLOCK))
    return out.transpose(1, 0, 4, 2, 3, 5).reshape(bsz, T, A_WIDTH)


def mlstm_chunkwise(q, k, v, i_pre, f_pre):
    bsz, H, T, dh = q.shape
    L = MLSTM_CHUNK
    nc = T // L
    log_f = jax.nn.log_sigmoid(f_pre)

    def chunks(t):
        return jnp.moveaxis(t.reshape(bsz, H, nc, L, *t.shape[3:]), 2, 0)

    tri = jnp.tril(jnp.ones((L, L), dtype=bool))

    def step(carry, inp):
        C, n, m = carry
        qc, kc, vc, ic, lfc = inp
        b = jnp.cumsum(lfc, axis=-1)
        D = jnp.where(tri, b[..., :, None] - b[..., None, :] + ic[..., None, :], -jnp.inf)
        m_inter = b + m[..., None]
        m_j = jnp.maximum(m_inter, D.max(-1))
        inter_scale = jnp.exp(m_inter - m_j)
        s = jnp.einsum('bhjd,bhsd->bhjs', qc, kc) * jnp.exp(D - m_j[..., None])
        num = jnp.einsum('bhjs,bhsd->bhjd', s, vc) + inter_scale[..., None] * jnp.einsum('bhed,bhjd->bhje', C, qc)
        den = s.sum(-1) + inter_scale * jnp.einsum('bhd,bhjd->bhj', n, qc)
        h = num / jnp.maximum(jnp.abs(den), jnp.exp(-m_j))[..., None]
        bL = b[..., -1]
        w_log = bL[..., None] - b + ic
        m_new = jnp.maximum(bL + m, w_log.max(-1))
        w = jnp.exp(w_log - m_new[..., None])
        decay = jnp.exp(bL + m - m_new)
        C_new = decay[..., None, None] * C + jnp.einsum('bhs,bhse,bhsd->bhed', w, vc, kc)
        n_new = decay[..., None] * n + jnp.einsum('bhs,bhsd->bhd', w, kc)
        return (C_new, n_new, m_new), h

    init = (jnp.zeros((bsz, H, dh, dh), jnp.float32), jnp.zeros((bsz, H, dh), jnp.float32),
            jnp.zeros((bsz, H), jnp.float32))
    _, hs = lax.scan(step, init, (chunks(q), chunks(k), chunks(v), chunks(i_pre), chunks(log_f)))
    return jnp.moveaxis(hs, 0, 2).reshape(bsz, H, T, dh)


def mlstm_mixer(qk, v, if_pre, o_pre, conv_w, i_bias, f_bias, out_norm_g):
    bsz, T, _ = qk.shape
    dt = qk.dtype
    f32 = jnp.float32
    qk = jax.nn.silu(causal_dwconv(qk, conv_w))

    def heads(t):
        return t.reshape(bsz, T, B_HEADS, HEAD_DIM).transpose(0, 2, 1, 3).astype(f32)

    q = heads(qk[..., :B_WIDTH])
    k = heads(qk[..., B_WIDTH:]) * (HEAD_DIM ** -0.5)
    vh = heads(v)
    i_pre = (if_pre[..., :B_HEADS].astype(f32) + i_bias.astype(f32)).transpose(0, 2, 1)
    f_pre = (if_pre[..., B_HEADS:].astype(f32) + f_bias.astype(f32)).transpose(0, 2, 1)
    h = mlstm_chunkwise(q, k, vh, i_pre, f_pre).transpose(0, 2, 1, 3)
    h = rms_norm(h, out_norm_g.reshape(B_HEADS, HEAD_DIM)).reshape(bsz, T, B_WIDTH)
    return (jax.nn.sigmoid(o_pre.astype(f32)) * h).astype(dt)


def mla_mixer(dq, dkv, kr, positions, q_a_norm, w_uq, kv_a_norm, w_ukv, qk_norm):
    bsz, T, _ = dq.shape
    dt = dq.dtype
    f32 = jnp.float32
    q = (rms_norm(dq, q_a_norm) @ w_uq).reshape(bsz, T, C_HEADS, C_NOPE + C_ROPE)
    kv = (rms_norm(dkv, kv_a_norm) @ w_ukv).reshape(bsz, T, C_HEADS, C_NOPE + C_V)
    q_nope = rms_norm(q[..., :C_NOPE], qk_norm[0, :C_NOPE]).transpose(0, 2, 1, 3)
    q_rope = rope(rms_norm(q[..., C_NOPE:], qk_norm[0, C_NOPE:]), positions).transpose(0, 2, 1, 3)
    k_nope = rms_norm(kv[..., :C_NOPE], qk_norm[1, :C_NOPE]).transpose(0, 2, 1, 3)
    v = kv[..., C_NOPE:].transpose(0, 2, 1, 3)
    k_rope = rope(rms_norm(kr, qk_norm[1, C_NOPE:])[:, :, None, :], positions)[:, :, 0]
    scale = (C_NOPE + C_ROPE) ** -0.5
    k_pos = jnp.arange(T)

    def block(i):
        t0 = i * ATTN_Q_BLOCK
        qn = lax.dynamic_slice_in_dim(q_nope, t0, ATTN_Q_BLOCK, axis=2)
        qr = lax.dynamic_slice_in_dim(q_rope, t0, ATTN_Q_BLOCK, axis=2)
        logits = (jnp.einsum('bhqd,bhkd->bhqk', qn, k_nope)
                  + jnp.einsum('bhqr,bkr->bhqk', qr, k_rope)).astype(f32) * scale
        mask = k_pos[None, :] <= (t0 + jnp.arange(ATTN_Q_BLOCK))[:, None]
        p = masked_softmax(logits, mask)
        return jnp.einsum('bhqk,bhkd->bhqd', p.astype(dt), v)

    out = lax.map(block, jnp.arange(T // ATTN_Q_BLOCK))
    return out.transpose(1, 0, 3, 2, 4).reshape(bsz, T, C_WIDTH)


def hier_moe(x, w_group, b_group, w_expert, b_expert, w_gate, w_up, w_down):
    bsz, T, D = x.shape
    dt = x.dtype
    f32 = jnp.float32
    xt = x.reshape(-1, D)
    gp = jax.nn.softmax((xt @ w_group).astype(f32) + b_group.astype(f32), axis=-1)
    g_top, g_idx = lax.top_k(gp, 1)
    el = ((xt @ w_expert).astype(f32) + b_expert.astype(f32)).reshape(-1, N_GROUPS, EXPERTS_PER_GROUP)
    el_sel = jnp.take_along_axis(el, g_idx[:, :, None], axis=1)[:, 0]
    e_top, e_idx = lax.top_k(jax.nn.softmax(el_sel, axis=-1), TOP_K_INNER)
    e_w = e_top / e_top.sum(-1, keepdims=True) * g_top
    expert_id = g_idx * EXPERTS_PER_GROUP + e_idx
    combine = (jax.nn.one_hot(expert_id, N_EXPERTS, dtype=f32) * e_w[..., None]).sum(1).astype(dt)
    h = jax.nn.silu(jnp.einsum('nd,edf->nef', xt, w_gate)) * jnp.einsum('nd,edf->nef', xt, w_up)
    y = jnp.einsum('nef,ne,efd->nd', h, combine, w_down)
    return y.reshape(bsz, T, D)


def setup_inputs(seed: int = 0) -> dict:
    key = jax.random.key(seed)
    ks = jax.random.split(key, 30)
    f32 = jnp.float32
    L = DEPTH

    def nrm(k, shape, scale):
        return jax.random.normal(k, shape, f32) * scale

    def gain(k, shape):
        return 1.0 + 0.1 * jax.random.normal(k, shape, f32)

    return {
        'x': nrm(ks[0], (BATCH, SEQ, D_MODEL), 1.0),
        'positions': (jax.random.randint(ks[1], (BATCH, 1), 0, 4096) + jnp.arange(SEQ)[None, :]).astype(jnp.int32),
        'rel_bias': nrm(ks[2], (REL_BUCKETS, A_HEADS), 0.5),
        'norm1_g': gain(ks[3], (L, D_MODEL)),
        'w_in': nrm(ks[4], (L, D_MODEL, D_IN), D_MODEL ** -0.5),
        'nsa_cmp_pe': nrm(ks[5], (L, 2, CMP_BLOCK, HEAD_DIM), 0.1),
        'nsa_cmp_w1': nrm(ks[6], (L, 2, CMP_BLOCK, HEAD_DIM, HEAD_DIM), (CMP_BLOCK * HEAD_DIM) ** -0.5),
        'nsa_cmp_w2': nrm(ks[7], (L, 2, HEAD_DIM, HEAD_DIM), HEAD_DIM ** -0.5),
        'nsa_q_norm': gain(ks[8], (L, HEAD_DIM)),
        'nsa_k_norm': gain(ks[9], (L, HEAD_DIM)),
        'nsa_out_norm': gain(ks[10], (L, A_WIDTH)),
        'mlstm_conv': nrm(ks[11], (L, CONV_K, 2 * B_WIDTH), 0.5),
        'mlstm_i_bias': nrm(ks[12], (L, B_HEADS), 0.1),
        'mlstm_f_bias': jnp.linspace(3.0, 6.0, B_HEADS, dtype=f32)[None, :] + nrm(ks[13], (L, B_HEADS), 0.1),
        'mlstm_out_norm': gain(ks[14], (L, B_WIDTH)),
        'mla_q_a_norm': gain(ks[15], (L, Q_RANK)),
        'mla_w_uq': nrm(ks[16], (L, Q_RANK, C_HEADS * (C_NOPE + C_ROPE)), Q_RANK ** -0.5),
        'mla_kv_a_norm': gain(ks[17], (L, KV_RANK)),
        'mla_w_ukv': nrm(ks[18], (L, KV_RANK, C_HEADS * (C_NOPE + C_V)), KV_RANK ** -0.5),
        'mla_qk_norm': gain(ks[19], (L, 2, C_NOPE + C_ROPE)),
        'mla_out_norm': gain(ks[20], (L, C_WIDTH)),
        'w_out': nrm(ks[21], (L, D_MIX, D_MODEL), D_MIX ** -0.5),
        'norm2_g': gain(ks[22], (L, D_MODEL)),
        'moe_w_group': nrm(ks[23], (L, D_MODEL, N_GROUPS), D_MODEL ** -0.5),
        'moe_b_group': nrm(ks[24], (L, N_GROUPS), 0.01),
        'moe_w_expert': nrm(ks[25], (L, D_MODEL, N_EXPERTS), D_MODEL ** -0.5),
        'moe_b_expert': nrm(ks[26], (L, N_EXPERTS), 0.01),
        'moe_w_gate': nrm(ks[27], (L, N_EXPERTS, D_MODEL, D_EXPERT), D_MODEL ** -0.5),
        'moe_w_up': nrm(ks[28], (L, N_EXPERTS, D_MODEL, D_EXPERT), D_MODEL ** -0.5),
        'moe_w_down': nrm(ks[29], (L, N_EXPERTS, D_EXPERT, D_MODEL), D_EXPERT ** -0.5),
    }


def reference(x, positions, rel_bias, norm1_g, w_in, nsa_cmp_pe, nsa_cmp_w1, nsa_cmp_w2, nsa_q_norm,
              nsa_k_norm, nsa_out_norm, mlstm_conv, mlstm_i_bias, mlstm_f_bias, mlstm_out_norm,
              mla_q_a_norm, mla_w_uq, mla_kv_a_norm, mla_w_ukv, mla_qk_norm, mla_out_norm, w_out,
              norm2_g, moe_w_group, moe_b_group, moe_w_expert, moe_b_expert, moe_w_gate, moe_w_up,
              moe_w_down):
    points = split_points()
    for l in range(DEPTH):
        h = rms_norm(x, norm1_g[l])
        proj = h @ w_in[l]
        a_q, a_kv, a_gate, b_qk, b_v, b_if, b_o, c_dq, c_dkv, c_kr = jnp.split(proj, points, axis=-1)
        y_a = nsa_mixer(a_q, a_kv, a_gate, rel_bias, nsa_cmp_pe[l], nsa_cmp_w1[l], nsa_cmp_w2[l],
                        nsa_q_norm[l], nsa_k_norm[l])
        y_b = mlstm_mixer(b_qk, b_v, b_if, b_o, mlstm_conv[l], mlstm_i_bias[l], mlstm_f_bias[l],
                          mlstm_out_norm[l])
        y_c = mla_mixer(c_dq, c_dkv, c_kr, positions, mla_q_a_norm[l], mla_w_uq[l], mla_kv_a_norm[l],
                        mla_w_ukv[l], mla_qk_norm[l])
        y = jnp.concatenate([rms_norm(y_a, nsa_out_norm[l]), y_b, rms_norm(y_c, mla_out_norm[l])], axis=-1)
        x = x + y @ w_out[l]
        x = x + hier_moe(rms_norm(x, norm2_g[l]), moe_w_group[l], moe_b_group[l], moe_w_expert[l],
                         moe_b_expert[l], moe_w_gate[l], moe_w_up[l], moe_w_down[l])
    return x
```

```cpp
#include <hip/hip_runtime.h>
#include <stdint.h>

constexpr int B_ = 8, T_ = 2048, D_ = 1024, L_ = 2, NTOK = B_ * T_;
constexpr int DIN = 2554;
constexpr int O_AQ = 0, O_AKV = 384, O_AG = 1152, O_BQK = 1170, O_BV = 1682, O_BIF = 1938, O_BO = 1946, O_CDQ = 2202, O_CDKV = 2394, O_CKR = 2522;

__device__ __forceinline__ float wave_sum(float v) { for (int o = 32; o; o >>= 1) v += __shfl_xor(v, o); return v; }
__device__ __forceinline__ float wave_max(float v) { for (int o = 32; o; o >>= 1) v = fmaxf(v, __shfl_xor(v, o)); return v; }
__device__ __forceinline__ float siluf(float x) { return x / (1.f + expf(-x)); }
__device__ __forceinline__ float sigmf(float x) { return 1.f / (1.f + expf(-x)); }
__device__ __forceinline__ int t5b(int dist) {
    int n = dist > 0 ? dist : 0; if (n < 16) return n;
    float v = logf((float)n / 16.f) / logf(8.f) * 16.f; int l = 16 + (int)v; return l < 31 ? l : 31;
}

__global__ void nv_rmsnorm(const float* in, long ld_in, long sub_in, float* out, long ld_out, long sub_out, const float* g, int gstride, int width) {
    const int r = blockIdx.x, y = blockIdx.y, lane = threadIdx.x;
    const float* x = in + (long)r * ld_in + (long)y * sub_in; float* o = out + (long)r * ld_out + (long)y * sub_out; const float* gg = g + y * gstride;
    float s = 0.f; for (int c = lane; c < width; c += 64) { float v = x[c]; s += v * v; }
    s = wave_sum(s); const float rs = rsqrtf(s / (float)width + 1e-6f);
    for (int c = lane; c < width; c += 64) o[c] = x[c] * rs * gg[c];
}

__global__ void __launch_bounds__(256) nv_gemm(const float* A, long lda, const float* Bm, long ldb, float* C, long ldc, const float* R, long ldr, int M, int N, int K) {
    __shared__ float sA[16][65]; __shared__ float sB[16][65];
    const int tx = threadIdx.x & 15, ty = threadIdx.x >> 4; const int m0 = blockIdx.y * 64, n0 = blockIdx.x * 64;
    float acc[4][4];
#pragma unroll
    for (int i = 0; i < 4; ++i)
#pragma unroll
        for (int j = 0; j < 4; ++j) acc[i][j] = 0.f;
    for (int k0 = 0; k0 < K; k0 += 16) {
        for (int i = threadIdx.x; i < 1024; i += 256) { int r = i >> 4, c = i & 15; int gm = m0 + r, gk = k0 + c; sA[c][r] = (gm < M && gk < K) ? A[(long)gm * lda + gk] : 0.f; }
        for (int i = threadIdx.x; i < 1024; i += 256) { int r = i >> 6, c = i & 63; int gk = k0 + r, gn = n0 + c; sB[r][c] = (gk < K && gn < N) ? Bm[(long)gk * ldb + gn] : 0.f; }
        __syncthreads();
#pragma unroll
        for (int kk = 0; kk < 16; ++kk) {
            float a[4], b[4];
#pragma unroll
            for (int i = 0; i < 4; ++i) { a[i] = sA[kk][ty * 4 + i]; b[i] = sB[kk][tx * 4 + i]; }
#pragma unroll
            for (int i = 0; i < 4; ++i)
#pragma unroll
                for (int j = 0; j < 4; ++j) acc[i][j] += a[i] * b[j];
        }
        __syncthreads();
    }
#pragma unroll
    for (int i = 0; i < 4; ++i)
#pragma unroll
        for (int j = 0; j < 4; ++j) { int gm = m0 + ty * 4 + i, gn = n0 + tx * 4 + j; if (gm < M && gn < N) C[(long)gm * ldc + gn] = acc[i][j] + (R ? R[(long)gm * ldr + gn] : 0.f); }
}

__global__ void __launch_bounds__(64) nv_nsa_cmp(const float* proj, const float* pe, const float* w1, const float* w2, const float* kg, float* kcmp, float* vcmp) {
    const int n = blockIdx.x, s = blockIdx.y, h = blockIdx.z, f = threadIdx.x;
    __shared__ float blk[2048]; __shared__ float hid[64];
    for (int i = f; i < 2048; i += 64) { int l = i >> 6, d = i & 63; blk[i] = proj[(long)(16 * n + l) * DIN + O_AKV + ((0 * 2 + s) * 2 + h) * 64 + d] + pe[(s * 32 + l) * 64 + d]; }
    __syncthreads();
    float a = 0.f; for (int i = 0; i < 2048; ++i) a += blk[i] * w1[((long)s * 2048 + i) * 64 + f];
    hid[f] = siluf(a); __syncthreads();
    float c = 0.f; for (int ff = 0; ff < 64; ++ff) c += hid[ff] * w2[(s * 64 + ff) * 64 + f];
    if (s == 0) { float ss = wave_sum(c * c); c = c * rsqrtf(ss / 64.f + 1e-6f) * kg[f]; kcmp[(h * 127 + n) * 64 + f] = c; } else vcmp[(h * 127 + n) * 64 + f] = c;
}

__global__ void __launch_bounds__(64) nv_nsa_knorm(const float* proj, const float* kg, float* kn) {
    const int t = blockIdx.x, y = blockIdx.y, br = 1 + (y >> 1), h = y & 1, lane = threadIdx.x;
    float v = proj[(long)t * DIN + O_AKV + ((br * 2 + 0) * 2 + h) * 64 + lane]; float ss = wave_sum(v * v);
    kn[((long)y * 2048 + t) * 64 + lane] = v * rsqrtf(ss / 64.f + 1e-6f) * kg[lane];
}

__global__ void __launch_bounds__(192) nv_nsa_attn(const float* proj, const float* kn, const float* kcmp, const float* vcmp, const float* rel_bias, const float* qg, float* y) {
    const int t = blockIdx.x, hk = blockIdx.y; const int g = threadIdx.x >> 6, lane = threadIdx.x & 63; const int head = hk * 3 + g;
    __shared__ float sq[3][64]; __shared__ float spc[3][128]; __shared__ float sps[32]; __shared__ int ssel[32];
    { float qv = proj[(long)t * DIN + O_AQ + head * 64 + lane]; float ss = wave_sum(qv * qv); sq[g][lane] = qv * rsqrtf(ss / 64.f + 1e-6f) * qg[lane]; }
    __syncthreads();
    float lg[2]; bool vd[2]; float mx = -1e30f;
#pragma unroll
    for (int r = 0; r < 2; ++r) {
        int n = lane + 64 * r; vd[r] = (n < 127) && (t - (16 * n + 31) >= 0); float l = -1e30f;
        if (vd[r]) { float d = 0.f; for (int k = 0; k < 64; ++k) d += sq[g][k] * kcmp[(hk * 127 + n) * 64 + k]; l = d * 0.125f + rel_bias[t5b(t - 16 * n - 31) * 6 + head]; }
        lg[r] = l; mx = fmaxf(mx, l);
    }
    mx = wave_max(mx); float e[2], sum = 0.f;
#pragma unroll
    for (int r = 0; r < 2; ++r) { e[r] = vd[r] ? expf(lg[r] - mx) : 0.f; sum += e[r]; }
    sum = wave_sum(sum);
#pragma unroll
    for (int r = 0; r < 2; ++r) { int n = lane + 64 * r; spc[g][n] = (sum > 0.f) ? e[r] / sum : 0.f; }
    __syncthreads();
    float oc = 0.f; for (int n = 0; n < 127; ++n) oc += spc[g][n] * vcmp[(hk * 127 + n) * 64 + lane];
    const int cur = t >> 6;
    if (threadIdx.x < 32) {
        int s = threadIdx.x; float a = 0.f;
        for (int gg = 0; gg < 3; ++gg) for (int n = 0; n < 127; ++n) { bool ov = (16 * n < (s + 1) * 64) && (16 * n + 32 > s * 64); if (ov) a += spc[gg][n]; }
        bool forced = (s == 0) || (s == cur) || (s == cur - 1); if (forced) a += 1e4f; if (s > cur) a = -1.f; sps[s] = a;
    }
    __syncthreads();
    if (threadIdx.x < 32) { int s = threadIdx.x; float v = sps[s]; int rank = 0; for (int s2 = 0; s2 < 32; ++s2) { float v2 = sps[s2]; if (v2 > v || (v2 == v && s2 < s)) ++rank; } ssel[s] = (rank < 16 && v >= 0.f) ? 1 : 0; }
    __syncthreads();
    float m = -1e30f, l = 0.f, os = 0.f;
    for (int s = 0; s < 32; ++s) {
        if (!ssel[s]) continue;
        int pos = 64 * s + lane; bool v = pos <= t; float lgt = -1e30f;
        if (v) { float d = 0.f; const float* kp = kn + ((long)(0 * 2 + hk) * 2048 + pos) * 64; for (int k = 0; k < 64; ++k) d += sq[g][k] * kp[k]; lgt = d * 0.125f + rel_bias[t5b(t - pos) * 6 + head]; }
        float bm = wave_max(lgt); if (bm <= -1e29f) continue;
        float mn = fmaxf(m, bm); float sc = expf(m - mn); float p = v ? expf(lgt - mn) : 0.f; l = l * sc + wave_sum(p); os *= sc;
        for (int j = 0; j < 64; ++j) { float pj = __shfl(p, j); os += pj * proj[(long)(64 * s + j) * DIN + O_AKV + ((1 * 2 + 1) * 2 + hk) * 64 + lane]; }
        m = mn;
    }
    os = l > 0.f ? os / l : 0.f;
    float m2 = -1e30f, l2 = 0.f, ow = 0.f; int lo = t - 511; if (lo < 0) lo = 0;
    for (int c0 = (lo & ~63); c0 <= t; c0 += 64) {
        int pos = c0 + lane; bool v = pos >= lo && pos <= t; float lgt = -1e30f;
        if (v) { float d = 0.f; const float* kp = kn + ((long)(1 * 2 + hk) * 2048 + pos) * 64; for (int k = 0; k < 64; ++k) d += sq[g][k] * kp[k]; lgt = d * 0.125f + rel_bias[t5b(t - pos) * 6 + head]; }
        float bm = wave_max(lgt); if (bm <= -1e29f) continue;
        float mn = fmaxf(m2, bm); float sc = expf(m2 - mn); float p = v ? expf(lgt - mn) : 0.f; l2 = l2 * sc + wave_sum(p); ow *= sc;
        for (int j = 0; j < 64; ++j) { float pj = __shfl(p, j); int pj_pos = c0 + j; if (pj_pos <= t) ow += pj * proj[(long)pj_pos * DIN + O_AKV + ((2 * 2 + 1) * 2 + hk) * 64 + lane]; }
        m2 = mn;
    }
    ow = l2 > 0.f ? ow / l2 : 0.f;
    const float* gp = proj + (long)t * DIN + O_AG + head * 3;
    y[(long)t * 1024 + head * 64 + lane] = sigmf(gp[0]) * oc + sigmf(gp[1]) * os + sigmf(gp[2]) * ow;
}

__global__ void __launch_bounds__(512) nv_ml_conv(const float* proj, const float* cw, float* qk) {
    const int t = blockIdx.x, c = threadIdx.x; float a = 0.f;
#pragma unroll
    for (int j = 0; j < 4; ++j) { int tt = t - 3 + j; if (tt >= 0) a += proj[(long)tt * DIN + O_BQK + c] * cw[j * 512 + c]; }
    a = siluf(a); if (c >= 256) a *= 0.125f; qk[(long)t * 512 + c] = a;
}
__global__ void __launch_bounds__(256) nv_ml_rec(const float* proj, const float* qk, const float* ib, const float* fb, float* hraw) {
    const int h = blockIdx.x, e = threadIdx.x >> 2, dg = threadIdx.x & 3;
    float C[16], nn[16];
#pragma unroll
    for (int j = 0; j < 16; ++j) { C[j] = 0.f; nn[j] = 0.f; }
    const float ibh = ib[h], fbh = fb[h];
    for (int t = 0; t < 2048; ++t) {
        const float ip = proj[(long)t * DIN + O_BIF + h] + ibh, fp = proj[(long)t * DIN + O_BIF + 4 + h] + fbh;
        const float f = sigmf(fp), ig = expf(ip), ve = proj[(long)t * DIN + O_BV + h * 64 + e];
        float num = 0.f, den = 0.f;
#pragma unroll
        for (int j = 0; j < 16; ++j) { int d = dg * 16 + j; float kd = qk[(long)t * 512 + 256 + h * 64 + d], qd = qk[(long)t * 512 + h * 64 + d]; C[j] = f * C[j] + ig * ve * kd; nn[j] = f * nn[j] + ig * kd; num += C[j] * qd; den += nn[j] * qd; }
        num += __shfl_xor(num, 1); num += __shfl_xor(num, 2); den += __shfl_xor(den, 1); den += __shfl_xor(den, 2);
        if (dg == 0) hraw[(long)t * 256 + h * 64 + e] = num / fmaxf(fabsf(den), 1.f);
    }
}
__global__ void __launch_bounds__(64) nv_ml_fin(const float* proj, const float* hraw, const float* og, float* y) {
    const int t = blockIdx.x, h = blockIdx.y, lane = threadIdx.x; float v = hraw[(long)t * 256 + h * 64 + lane]; float ss = wave_sum(v * v);
    v = v * rsqrtf(ss / 64.f + 1e-6f) * og[h * 64 + lane];
    y[(long)t * 1024 + 384 + h * 64 + lane] = sigmf(proj[(long)t * DIN + O_BO + h * 64 + lane]) * v;
}

__global__ void __launch_bounds__(64) nv_mla_prep(float* q, float* kv, const float* proj, float* krope, const float* qkn, const int* pos) {
    const int t = blockIdx.x, y = blockIdx.y, lane = threadIdx.x; const float p = (float)pos[t];
    if (y < 6) {
        const int h = y;
        { float v = q[(long)t * 576 + h * 96 + lane]; float ss = wave_sum(v * v); q[(long)t * 576 + h * 96 + lane] = v * rsqrtf(ss / 64.f + 1e-6f) * qkn[lane]; }
        { float v = kv[(long)t * 768 + h * 128 + lane]; float ss = wave_sum(v * v); kv[(long)t * 768 + h * 128 + lane] = v * rsqrtf(ss / 64.f + 1e-6f) * qkn[96 + lane]; }
        { float v = lane < 32 ? q[(long)t * 576 + h * 96 + 64 + lane] : 0.f; float ss = wave_sum(v * v); v = v * rsqrtf(ss / 32.f + 1e-6f) * (lane < 32 ? qkn[64 + lane] : 0.f);
          float other = __shfl_xor(v, 16); int i = lane & 15; double ang = (double)p * pow(10000.0, -(double)i / 16.0); float cs = (float)cos(ang), sn = (float)sin(ang);
          float o = (lane < 16) ? (v * cs - other * sn) : (v * cs + other * sn); if (lane < 32) q[(long)t * 576 + h * 96 + 64 + lane] = o; }
    } else {
        float v = lane < 32 ? proj[(long)t * DIN + O_CKR + lane] : 0.f; float ss = wave_sum(v * v); v = v * rsqrtf(ss / 32.f + 1e-6f) * (lane < 32 ? qkn[96 + 64 + lane] : 0.f);
        float other = __shfl_xor(v, 16); int i = lane & 15; double ang = (double)p * pow(10000.0, -(double)i / 16.0); float cs = (float)cos(ang), sn = (float)sin(ang);
        float o = (lane < 16) ? (v * cs - other * sn) : (v * cs + other * sn); if (lane < 32) krope[(long)t * 32 + lane] = o;
    }
}
__global__ void __launch_bounds__(64) nv_mla_attn(const float* q, const float* kv, const float* krope, float* y) {
    const int t = blockIdx.x, h = blockIdx.y, lane = threadIdx.x; __shared__ float sq[96];
    sq[lane] = q[(long)t * 576 + h * 96 + lane]; if (lane < 32) sq[64 + lane] = q[(long)t * 576 + h * 96 + 64 + lane];
    __syncthreads();
    const float scale = rsqrtf(96.f); float m = -1e30f, l = 0.f, o = 0.f;
    for (int c0 = 0; c0 <= t; c0 += 64) {
        int pos = c0 + lane; bool v = pos <= t; float lgt = -1e30f;
        if (v) { float d = 0.f; const float* kp = kv + (long)pos * 768 + h * 128; for (int k = 0; k < 64; ++k) d += sq[k] * kp[k]; const float* kr = krope + (long)pos * 32; for (int k = 0; k < 32; ++k) d += sq[64 + k] * kr[k]; lgt = d * scale; }
        float bm = wave_max(lgt); float mn = fmaxf(m, bm); float sc = expf(m - mn); float p = v ? expf(lgt - mn) : 0.f; l = l * sc + wave_sum(p); o *= sc;
        for (int j = 0; j < 64; ++j) { float pj = __shfl(p, j); int pp = c0 + j; if (pp <= t) o += pj * kv[(long)pp * 768 + h * 128 + 64 + lane]; }
        m = mn;
    }
    y[(long)t * 1024 + 640 + h * 64 + lane] = o / l;
}

__global__ void __launch_bounds__(64) nv_moe_route(const float* x1, const float* g2, const float* wg, const float* bg, const float* we, const float* be, float* xtn, int* rt_e, float* rt_w) {
    const int t = blockIdx.x, lane = threadIdx.x; __shared__ float xt[1024]; __shared__ float lg[36];
    float s = 0.f; for (int c = lane; c < 1024; c += 64) { float v = x1[(long)t * 1024 + c]; s += v * v; }
    s = wave_sum(s); const float rs = rsqrtf(s / 1024.f + 1e-6f);
    for (int c = lane; c < 1024; c += 64) { float v = x1[(long)t * 1024 + c] * rs * g2[c]; xt[c] = v; xtn[(long)t * 1024 + c] = v; }
    __syncthreads();
    if (lane < 36) { float a = 0.f; if (lane < 4) { for (int k = 0; k < 1024; ++k) a += xt[k] * wg[k * 4 + lane]; a += bg[lane]; } else { int j = lane - 4; for (int k = 0; k < 1024; ++k) a += xt[k] * we[k * 32 + j]; a += be[j]; } lg[lane] = a; }
    __syncthreads();
    if (lane == 0) {
        int gi = 0; float gm = lg[0]; for (int j = 1; j < 4; ++j) if (lg[j] > gm) { gm = lg[j]; gi = j; }
        float gs = 0.f; for (int j = 0; j < 4; ++j) gs += expf(lg[j] - gm); const float gtop = 1.f / gs;
        const float* el = lg + 4 + gi * 8; int e0 = 0; for (int j = 1; j < 8; ++j) if (el[j] > el[e0]) e0 = j;
        int e1 = -1; for (int j = 0; j < 8; ++j) if (j != e0 && (e1 < 0 || el[j] > el[e1])) e1 = j;
        const float w0 = 1.f / (1.f + expf(el[e1] - el[e0]));
        rt_e[t * 2] = gi * 8 + e0; rt_e[t * 2 + 1] = gi * 8 + e1; rt_w[t * 2] = w0 * gtop; rt_w[t * 2 + 1] = (1.f - w0) * gtop;
    }
}
__global__ void __launch_bounds__(256) nv_moe_exp(const float* x1, const float* xtn, const int* rt_e, const float* rt_w, const float* Wg, const float* Wu, const float* Wd, float* out) {
    const int t = blockIdx.x, tid = threadIdx.x; __shared__ float xt[1024]; __shared__ float hh[256];
    for (int c = tid; c < 1024; c += 256) xt[c] = xtn[(long)t * 1024 + c];
    float acc0 = 0.f, acc1 = 0.f, acc2 = 0.f, acc3 = 0.f;
    __syncthreads();
    for (int slot = 0; slot < 2; ++slot) {
        const int e = rt_e[t * 2 + slot]; const float w = rt_w[t * 2 + slot];
        float g = 0.f, u = 0.f; const float* pg = Wg + (long)e * 1024 * 256 + tid; const float* pu = Wu + (long)e * 1024 * 256 + tid;
        for (int k = 0; k < 1024; ++k) { g += xt[k] * pg[(long)k * 256]; u += xt[k] * pu[(long)k * 256]; }
        hh[tid] = siluf(g) * u; __syncthreads();
        float y0 = 0.f, y1 = 0.f, y2 = 0.f, y3 = 0.f; const float* pd = Wd + (long)e * 256 * 1024 + tid;
        for (int f = 0; f < 256; ++f) { float hv = hh[f]; y0 += hv * pd[(long)f * 1024]; y1 += hv * pd[(long)f * 1024 + 256]; y2 += hv * pd[(long)f * 1024 + 512]; y3 += hv * pd[(long)f * 1024 + 768]; }
        acc0 += w * y0; acc1 += w * y1; acc2 += w * y2; acc3 += w * y3; __syncthreads();
    }
    const long o = (long)t * 1024 + tid;
    out[o] = x1[o] + acc0; out[o + 256] = x1[o + 256] + acc1; out[o + 512] = x1[o + 512] + acc2; out[o + 768] = x1[o + 768] + acc3;
}

struct NvScratch { float *proj, *h1, *qk, *hraw, *kn, *kcmp, *vcmp, *dqn, *q, *dkvn, *kv, *krope, *y, *x1; int* rt_e; float* rt_w; };

static void naive_layer_batch(void* const* d_in, int l, int b, const float* xin  , float* xout  , const NvScratch& S, hipStream_t st) {
    const float* rel_bias = (const float*)d_in[2];
    const float* norm1_g = (const float*)d_in[3] + (long)l * 1024;
    const float* w_in = (const float*)d_in[4] + (long)l * 1024 * DIN;
    const float* cmp_pe = (const float*)d_in[5] + (long)l * 2 * 32 * 64;
    const float* cmp_w1 = (const float*)d_in[6] + (long)l * 2 * 32 * 64 * 64;
    const float* cmp_w2 = (const float*)d_in[7] + (long)l * 2 * 64 * 64;
    const float* q_norm = (const float*)d_in[8] + l * 64;
    const float* k_norm = (const float*)d_in[9] + l * 64;
    const float* nsa_on = (const float*)d_in[10] + l * 384;
    const float* conv = (const float*)d_in[11] + l * 4 * 512;
    const float* ibias = (const float*)d_in[12] + l * 4;
    const float* fbias = (const float*)d_in[13] + l * 4;
    const float* ml_on = (const float*)d_in[14] + l * 256;
    const float* qan = (const float*)d_in[15] + l * 192;
    const float* w_uq = (const float*)d_in[16] + (long)l * 192 * 576;
    const float* kvan = (const float*)d_in[17] + l * 128;
    const float* w_ukv = (const float*)d_in[18] + (long)l * 128 * 768;
    const float* qkn = (const float*)d_in[19] + l * 192;
    const float* mla_on = (const float*)d_in[20] + l * 384;
    const float* w_out = (const float*)d_in[21] + (long)l * 1024 * 1024;
    const float* norm2_g = (const float*)d_in[22] + l * 1024;
    const float* wgrp = (const float*)d_in[23] + (long)l * 1024 * 4;
    const float* bgrp = (const float*)d_in[24] + l * 4;
    const float* wexp = (const float*)d_in[25] + (long)l * 1024 * 32;
    const float* bexp = (const float*)d_in[26] + l * 32;
    const float* Wg = (const float*)d_in[27] + (long)l * 32 * 1024 * 256;
    const float* Wu = (const float*)d_in[28] + (long)l * 32 * 1024 * 256;
    const float* Wd = (const float*)d_in[29] + (long)l * 32 * 256 * 1024;
    const int* pos = (const int*)d_in[1] + b * 2048;
    nv_rmsnorm<<<dim3(2048, 1), 64, 0, st>>>(xin, 1024, 0, S.h1, 1024, 0, norm1_g, 0, 1024);
    nv_gemm<<<dim3((DIN + 63) / 64, 2048 / 64), 256, 0, st>>>(S.h1, 1024, w_in, DIN, S.proj, DIN, nullptr, 0, 2048, DIN, 1024);
    nv_nsa_cmp<<<dim3(127, 2, 2), 64, 0, st>>>(S.proj, cmp_pe, cmp_w1, cmp_w2, k_norm, S.kcmp, S.vcmp);
    nv_nsa_knorm<<<dim3(2048, 4), 64, 0, st>>>(S.proj, k_norm, S.kn);
    nv_nsa_attn<<<dim3(2048, 2), 192, 0, st>>>(S.proj, S.kn, S.kcmp, S.vcmp, rel_bias, q_norm, S.y);
    nv_ml_conv<<<2048, 512, 0, st>>>(S.proj, conv, S.qk);
    nv_ml_rec<<<4, 256, 0, st>>>(S.proj, S.qk, ibias, fbias, S.hraw);
    nv_ml_fin<<<dim3(2048, 4), 64, 0, st>>>(S.proj, S.hraw, ml_on, S.y);
    nv_rmsnorm<<<dim3(2048, 1), 64, 0, st>>>(S.proj + O_CDQ, DIN, 0, S.dqn, 192, 0, qan, 0, 192);
    nv_gemm<<<dim3(576 / 64, 2048 / 64), 256, 0, st>>>(S.dqn, 192, w_uq, 576, S.q, 576, nullptr, 0, 2048, 576, 192);
    nv_rmsnorm<<<dim3(2048, 1), 64, 0, st>>>(S.proj + O_CDKV, DIN, 0, S.dkvn, 128, 0, kvan, 0, 128);
    nv_gemm<<<dim3(768 / 64, 2048 / 64), 256, 0, st>>>(S.dkvn, 128, w_ukv, 768, S.kv, 768, nullptr, 0, 2048, 768, 128);
    nv_mla_prep<<<dim3(2048, 7), 64, 0, st>>>(S.q, S.kv, S.proj, S.krope, qkn, pos);
    nv_mla_attn<<<dim3(2048, 6), 64, 0, st>>>(S.q, S.kv, S.krope, S.y);
    nv_rmsnorm<<<dim3(2048, 1), 64, 0, st>>>(S.y, 1024, 0, S.y, 1024, 0, nsa_on, 0, 384);
    nv_rmsnorm<<<dim3(2048, 1), 64, 0, st>>>(S.y + 640, 1024, 0, S.y + 640, 1024, 0, mla_on, 0, 384);
    nv_gemm<<<dim3(1024 / 64, 2048 / 64), 256, 0, st>>>(S.y, 1024, w_out, 1024, S.x1, 1024, xin, 1024, 2048, 1024, 1024);
    nv_moe_route<<<2048, 64, 0, st>>>(S.x1, norm2_g, wgrp, bgrp, wexp, bexp, S.h1, S.rt_e, S.rt_w);
    nv_moe_exp<<<2048, 256, 0, st>>>(S.x1, S.h1, S.rt_e, S.rt_w, Wg, Wu, Wd, xout);
}

extern "C" void kernel_launch(void* const* d_in, const int* in_sizes, int n_in, void* d_out, int out_size, void* d_ws, size_t ws_size, hipStream_t stream) {
    float* ws = (float*)d_ws;
    float* xbuf = ws; size_t off = (size_t)NTOK * 1024;
    NvScratch S;
    auto take = [&](size_t n) { float* p = ws + off; off += (n + 63) & ~(size_t)63; return p; };
    S.proj = take((size_t)2048 * DIN); S.h1 = take(2048 * 1024); S.qk = take(2048 * 512); S.hraw = take(2048 * 256); S.kn = take(4 * 2048 * 64);
    S.kcmp = take(2 * 127 * 64); S.vcmp = take(2 * 127 * 64); S.dqn = take(2048 * 192); S.q = take(2048 * 576); S.dkvn = take(2048 * 128); S.kv = take(2048 * 768);
    S.krope = take(2048 * 32); S.y = take(2048 * 1024); S.x1 = take(2048 * 1024); S.rt_e = (int*)take(2048 * 2); S.rt_w = take(2048 * 2);
    const float* x0 = (const float*)d_in[0];
    for (int l = 0; l < L_; ++l)
        for (int b = 0; b < B_; ++b) {
            const float* xin = (l == 0 ? x0 : xbuf) + (size_t)b * 2048 * 1024;
            float* xout = (l == L_ - 1 ? (float*)d_out : xbuf) + (size_t)b * 2048 * 1024;
            naive_layer_batch(d_in, l, b, xin, xout, S, stream);
        }
}
```

```cpp
#define CHECK 0
#define CHECK_LAYERS 2
#define CHECK_UPTO 99
#define SPLIT_LAUNCH 0
#include <hip/hip_runtime.h>
#include <stdint.h>
#include <cstdio>

constexpr int B_ = 8, T_ = 2048, D_ = 1024, L_ = 2, NTOK = B_ * T_;
constexpr int DIN = 2554;
constexpr int O_AQ = 0, O_AKV = 384, O_AG = 1152, O_BQK = 1170, O_BV = 1682, O_BIF = 1938, O_BO = 1946, O_CDQ = 2202, O_CDKV = 2394, O_CKR = 2522;

typedef unsigned short bf16_t;
typedef short bf16x8 __attribute__((ext_vector_type(8)));
typedef short s16x4 __attribute__((ext_vector_type(4)));
typedef float f32x4 __attribute__((ext_vector_type(4)));
typedef float f32x16 __attribute__((ext_vector_type(16)));
typedef unsigned u32x4 __attribute__((ext_vector_type(4)));
typedef unsigned u32x2 __attribute__((ext_vector_type(2)));
typedef float f32x2_t __attribute__((ext_vector_type(2)));
typedef __bf16 bf16x2_t __attribute__((ext_vector_type(2)));
#define LAS __attribute__((address_space(3)))

__device__ __forceinline__ unsigned pk_bf16(float lo, float hi) { f32x2_t v = {lo, hi}; bf16x2_t b = __builtin_convertvector(v, bf16x2_t); return __builtin_bit_cast(unsigned, b); }
__device__ __forceinline__ float bf_lo(unsigned u) { return __builtin_bit_cast(float, u << 16); }
__device__ __forceinline__ float bf_hi(unsigned u) { return __builtin_bit_cast(float, u & 0xffff0000u); }
__device__ __forceinline__ float bf2f(bf16_t h) { return __builtin_bit_cast(float, (unsigned)h << 16); }
__device__ __forceinline__ bf16_t f2bf(float f) { return (bf16_t)(pk_bf16(f, 0.f) & 0xffffu); }
__device__ __forceinline__ float wave_sum(float v) { for (int o = 32; o; o >>= 1) v += __shfl_xor(v, o); return v; }
__device__ __forceinline__ float wave_max(float v) { for (int o = 32; o; o >>= 1) v = fmaxf(v, __shfl_xor(v, o)); return v; }
__device__ __forceinline__ float siluf(float x) { return x / (1.f + __expf(-x)); }
__device__ __forceinline__ float sigmf(float x) { return 1.f / (1.f + __expf(-x)); }
__device__ __forceinline__ int t5b(int dist) {
    int n = dist > 0 ? dist : 0; if (n < 16) return n;
    float v = logf((float)n / 16.f) / logf(8.f) * 16.f; int l = 16 + (int)v; return l < 31 ? l : 31;
}

constexpr size_t WS_CTL = 0, CTL_BYTES = 65536;
constexpr size_t WS_SSQ = WS_CTL + CTL_BYTES;
constexpr size_t ZERO_BYTES = CTL_BYTES;
constexpr size_t PT_DQ = 0, PT_DKV = PT_DQ + (size_t)2 * 16384 * 4 * 4, PT_A = PT_DKV + (size_t)2 * 16384 * 2 * 4, PT_C = PT_A + (size_t)2 * 16384 * 8 * 4, PT_X1 = PT_C + (size_t)2 * 16384 * 8 * 4, PT_END = PT_X1 + (size_t)2 * 16384 * 16 * 4;
constexpr size_t WS_SSQX = WS_SSQ + PT_END;
constexpr size_t WS_RS2 = WS_SSQX + 2 * 65536;
constexpr size_t WS_WIN = WS_RS2 + 65536;
constexpr size_t WS_WOUT = WS_WIN + (size_t)2 * 2560 * 1024 * 2;
constexpr size_t WS_WUQ = WS_WOUT + (size_t)2 * 1024 * 1024 * 2;
constexpr size_t WS_WUKV = WS_WUQ + (size_t)2 * 768 * 256 * 2;
constexpr size_t WS_WC1 = WS_WUKV + (size_t)2 * 768 * 256 * 2;
constexpr size_t WS_WC2 = WS_WC1 + (size_t)2 * 2 * 64 * 2048 * 2;
constexpr size_t WS_WR = WS_WC2 + (size_t)2 * 2 * 64 * 64 * 2;
constexpr size_t WS_B1C = WS_WR + (size_t)2 * 64 * 1024 * 2;
constexpr size_t WS_BIASD = WS_B1C + 1024;
constexpr size_t WS_ROPE = WS_BIASD + 6 * 2048 * 4;
constexpr size_t WS_WMOE = WS_ROPE + (size_t)16384 * 32 * 4;
constexpr size_t WMOE_WD = (size_t)32 * 512 * 1024 * 2;
constexpr size_t WS_XB = WS_WMOE + 50331648;
constexpr size_t WS_MLA = WS_XB + 33554432;
constexpr size_t MLA_KM = (size_t)8 * 6 * 2048 * 96 * 2, MLA_VM = 2 * MLA_KM;
constexpr size_t WS_HBUF = WS_MLA;
constexpr size_t WS_PRJ = WS_MLA + 50331648;
constexpr size_t HM64 = (size_t)2048 * 64 * 2;
constexpr size_t PRJ_QN = 0;
constexpr size_t PRJ_KN1 = PRJ_QN + 48 * HM64, PRJ_VN1 = PRJ_KN1 + 16 * HM64, PRJ_KN2 = PRJ_VN1 + 16 * HM64, PRJ_VN2 = PRJ_KN2 + 16 * HM64;
constexpr size_t PRJ_VML = PRJ_VN2 + 16 * HM64;
constexpr size_t PRJ_OG = PRJ_VML + 32 * HM64;
constexpr size_t PRJ_KR = PRJ_OG + (size_t)16384 * 256 * 2;
constexpr size_t PRJ_GATES = PRJ_KR + (size_t)16384 * 32 * 2;
constexpr size_t PRJ_DEAD = PRJ_GATES + (size_t)16384 * 32 * 4;
constexpr size_t PRJ_C0K = PRJ_DEAD, PRJ_C0V = PRJ_C0K + 16 * HM64 + 8192;
constexpr size_t PRJ_RAWQK = PRJ_C0V + 16 * HM64 + 8192;
constexpr size_t PRJ_DQKV = PRJ_RAWQK + (size_t)16384 * 512 * 2;
constexpr size_t PRJ_END = PRJ_DQKV + (size_t)16384 * 384 * 2;
static_assert(PRJ_END - PRJ_DEAD >= 33554432, "Y fits the dead part of PRJ");
constexpr size_t WS_Y = WS_PRJ + PRJ_DEAD;
constexpr size_t WS_YBUF = WS_PRJ;
static_assert((size_t)2 * 16384 * 1024 * 2 <= PRJ_END, "YBUF fits the PRJ region");
constexpr size_t WS_ML = WS_PRJ + PRJ_END;
constexpr size_t ML_KC = 32 * HM64, ML_DELTA = 2 * ML_KC, ML_DN = ML_DELTA + (size_t)1024 * 4096 * 2, ML_G = ML_DN + (size_t)1024 * 64 * 4, ML_BL = ML_G + (size_t)8 * 4 * 2048 * 2 * 4, ML_END = ML_BL + 4096;
constexpr size_t WS_CMP = WS_ML + ML_END;
constexpr size_t CMP_V = (size_t)8 * 2 * 128 * 64 * 2;
constexpr size_t WS_META = WS_CMP + 2 * CMP_V;
constexpr size_t META_W = (size_t)32 * 16384 * 4, META_RT = 2 * META_W;
constexpr size_t WS_END = WS_META + META_RT + (size_t)16384 * 16;
constexpr int CW_BAR = 0;
constexpr int CW_Q = 4096;
constexpr int CW_CNT = 8192;
constexpr int CW_CHK = 9000;
constexpr int LDS_BYTES = 147456;
constexpr int LDS_MISC = LDS_BYTES - 256;
#define XB_TMO      128
#define XB_XCNT(j)  (256  + 64 * (j))
#define XB_XSUB(j)  (1280 + 64 * (j))
#define XB_XGEN(j)  (2304 + 64 * (j))
#define XB_TOP      3328
#define XB_TOPGEN   3392
#define XCD_BAR_WORDS 3456
#define XB_SPIN_CAP (1u << 18)

__device__ __forceinline__ unsigned xb_ld(unsigned* p)              { return __hip_atomic_load(p, __ATOMIC_RELAXED, __HIP_MEMORY_SCOPE_AGENT); }
__device__ __forceinline__ unsigned xb_add(unsigned* p, unsigned v) { return __hip_atomic_fetch_add(p, v, __ATOMIC_RELAXED, __HIP_MEMORY_SCOPE_AGENT); }
__device__ __forceinline__ unsigned xb_xcc_id() { return (unsigned)__builtin_amdgcn_s_getreg((3 << 11) | 20) & 0xFu; }
#define XB_SPIN(cond, bar) do { unsigned _sp = 0; while (cond) { __builtin_amdgcn_s_sleep(1); \
    if ((++_sp & 255u) == 0u) { if (xb_ld(&(bar)[XB_TMO])) break; if (_sp > XB_SPIN_CAP) { atomicAdd(&(bar)[XB_TMO], 1u); break; } } } } while (0)

struct XcdBarrier {
    unsigned* bar; unsigned x;
    volatile LAS unsigned* st;
};

__device__ __forceinline__ XcdBarrier xcd_barrier_post(unsigned* bar, volatile LAS unsigned* st) {
    XcdBarrier b; b.bar = bar; b.x = xb_xcc_id(); b.st = st;
    if (threadIdx.x == 0) (void)xb_add(&bar[XB_XCNT(b.x)], 1u);
    return b;
}
__device__ __forceinline__ void xcd_barrier_complete(unsigned* bar, unsigned x, unsigned& nloc, unsigned& nx) {
    const unsigned G = gridDim.x * gridDim.y * gridDim.z;
    unsigned sum, cnt, mine, sp = 0u;
    for (;;) {
        sum = 0u; cnt = 0u; mine = 0u;
#pragma unroll
        for (unsigned j = 0; j < 16; ++j) { const unsigned c = xb_ld(&bar[XB_XCNT(j)]); sum += c; cnt += (c > 0u) ? 1u : 0u; mine = (j == x) ? c : mine; }
        if (sum == G) break;
        __builtin_amdgcn_s_sleep(1);
        if ((++sp & 255u) == 0u) { if (xb_ld(&bar[XB_TMO])) break; if (sp > XB_SPIN_CAP) { atomicAdd(&bar[XB_TMO], 1u); break; } }
    }
    nloc = mine > 0u ? mine : 1u; nx = cnt > 0u ? cnt : 1u;
}

__device__ __forceinline__ void xcd_barrier(const XcdBarrier& b) {
    asm volatile("s_waitcnt vmcnt(0)" ::: "memory");
    __syncthreads();
    if (threadIdx.x == 0) {
        unsigned* bar = b.bar;
        __builtin_amdgcn_s_waitcnt(0);
        unsigned nloc = b.st[0], nx = b.st[1];
        if (nloc == 0u) { xcd_barrier_complete(bar, b.x, nloc, nx); b.st[0] = nloc; b.st[1] = nx; }
        const unsigned old = xb_add(&bar[XB_XSUB(b.x)], 1u);
        const unsigned gen = old / nloc;
        if (old + 1u == (gen + 1u) * nloc) {
            __builtin_amdgcn_fence(__ATOMIC_RELEASE, "agent");
            asm volatile("s_waitcnt vmcnt(0)" ::: "memory");
            const unsigned og = xb_add(&bar[XB_TOP], 1u);
            const unsigned tg = og / nx;
            if (og + 1u == (tg + 1u) * nx) xb_add(&bar[XB_TOPGEN], 1u);
            else XB_SPIN(xb_ld(&bar[XB_TOPGEN]) == tg, bar);
            __builtin_amdgcn_fence(__ATOMIC_ACQUIRE, "agent");
            xb_add(&bar[XB_XGEN(b.x)], 1u);
            asm volatile("s_waitcnt vmcnt(0)" ::: "memory");
        } else {
            XB_SPIN(xb_ld(&bar[XB_XGEN(b.x)]) == gen, bar);
            __builtin_amdgcn_fence(__ATOMIC_ACQUIRE, "agent");
            asm volatile("s_waitcnt vmcnt(0)" ::: "memory");
        }
    }
    __syncthreads();
}
struct Inputs { const float* p[30]; };
typedef const __attribute__((address_space(4))) Inputs* InPtr;
__device__ __forceinline__ InPtr in_tab() { InPtr p = (InPtr)__builtin_amdgcn_kernarg_segment_ptr(); asm volatile("" : "+s"(p)); return p; }
__device__ __forceinline__ unsigned char* launder(unsigned char* p) { asm volatile("" : "+s"(p)); return p; }

__host__ __device__ inline int inproj_refcol(int G, int e) {
    if (G < 6) return O_AQ + G * 64 + e;
    if (G < 18) return O_AKV + (G - 6) * 64 + e;
    if (G < 26) return O_BQK + (G - 18) * 64 + e;
    if (G < 30) return O_BV + (G - 26) * 64 + e;
    if (G < 34) return O_BO + (G - 30) * 64 + e;
    if (G < 37) return O_CDQ + (G - 34) * 64 + e;
    if (G == 37) { if (e < 32) return O_CKR + e; if (e < 50) return O_AG + (e - 32); if (e < 58) return O_BIF + (e - 50); return -1; }
    return O_CDKV + (G - 38) * 64 + e;
}
__host__ __device__ inline int uq_refcol(int G, int e) {
    if (G < 6) return G * 96 + e;
    if (G < 9) { const int idx = e & 31, bj = e >> 5, sub = idx >> 4, i = idx & 15; return (2 * (G - 6) + sub) * 96 + 64 + bj * 16 + i; }
    return -1;
}
__host__ __device__ inline int ukv_refcol(int G, int e) { return G < 6 ? G * 128 + e : (G - 6) * 128 + 64 + e; }
#define N2G(n) ((((n) >> 8) << 2) + (((n) >> 5) & 3))
#define N2E(n) (((((n) >> 7) & 1) << 5) + ((n) & 31))

struct FWin { const float* w; const float* g; __device__ __forceinline__ float operator()(int k, int n) const { const int c = inproj_refcol(N2G(n), N2E(n)); return c < 0 ? 0.f : w[(size_t)k * DIN + c] * g[k]; } };
struct FWout { const float* w; const float* ga; const float* gc; __device__ __forceinline__ float operator()(int k, int n) const { const float og = k < 384 ? ga[k] : (k < 640 ? 1.f : gc[k - 640]); return w[(size_t)k * 1024 + n] * og; } };
struct FWuq { const float* w; const float* g; __device__ __forceinline__ float operator()(int k, int n) const { const int c = uq_refcol(N2G(n), N2E(n)); return (k < 192 && c >= 0) ? w[(size_t)k * 576 + c] * g[k] : 0.f; } };
struct FWukv { const float* w; const float* g; __device__ __forceinline__ float operator()(int k, int n) const { const int c = ukv_refcol(N2G(n), N2E(n)); return k >= 128 ? w[(size_t)(k - 128) * 768 + c] * g[k - 128] : 0.f; } };
struct FWc1 { const float* w; __device__ __forceinline__ float operator()(int k, int n) const { return w[(size_t)k * 64 + n]; } };
struct FWr { const float* wg; const float* we; const float* g; __device__ __forceinline__ float operator()(int k, int n) const { return n < 4 ? wg[k * 4 + n] * g[k] : (n < 36 ? we[k * 32 + n - 4] * g[k] : 0.f); } };
struct FWgu { const float* src; const float* g; int n0, col0; __device__ __forceinline__ float operator()(int k, int n) const { return src[(size_t)k * 256 + col0 + (n - n0)] * g[k]; } };
struct FWd { const float* w; __device__ __forceinline__ float operator()(int k, int n) const { return w[(size_t)k * 1024 + n]; } };

__device__ __forceinline__ void rope_cs(int pos, int j, float& cs, float& sn) {
    const double inv = exp2(-(double)j * (13.287712379549449 / 16.0));
    const double rev = (double)pos * inv * 0.15915494309189535; const float f = (float)(rev - rint(rev));
    cs = __builtin_amdgcn_cosf(f); sn = __builtin_amdgcn_sinf(f);
}
template <class F>
__device__ __forceinline__ void cvt_tile(const F& f, int n0, int k0, bf16_t* dst, int ldk, LAS float* tile, int tid) {
    { const int k = tid >> 3, nb = (tid & 7) * 8;
#pragma unroll
      for (int j = 0; j < 8; ++j) tile[k * 65 + nb + j] = f(k0 + k, n0 + nb + j); }
    __syncthreads();
    { const int n = tid >> 3, kb = (tid & 7) * 8; const LAS float* s = tile + kb * 65 + n;
      u32x4 o; o.x = pk_bf16(s[0], s[65]); o.y = pk_bf16(s[130], s[195]); o.z = pk_bf16(s[260], s[325]); o.w = pk_bf16(s[390], s[455]);
      *(u32x4*)(dst + (size_t)(n0 + n) * ldk + k0 + kb) = o; }
    __syncthreads();
}
template <class F>
__device__ __forceinline__ void cvt_item(const F& f, int it, int nK, bf16_t* dst, int ldk, LAS float* tile, int tid) { cvt_tile(f, (it / nK) * 64, (it % nK) * 64, dst, ldk, tile, tid); }

__device__ __forceinline__ void cvt_moe_layer(InPtr in, unsigned char* ws, int l, LAS float* tile, int bid, int nb, int tid) {
    asm volatile("" : "+v"(tid));
    const float* g2 = in->p[22] + l * 1024;
    bf16_t* WGU = (bf16_t*)(ws + WS_WMOE); bf16_t* WD = (bf16_t*)(ws + WS_WMOE + WMOE_WD);
    for (int it = bid; it < 32 * (128 + 64); it += nb) {
        if (it < 32 * 128) { const int e = it >> 7, r = it & 127, n0 = (r >> 4) * 64, c0 = n0 & 255; FWgu f{(c0 < 128 ? in->p[27] : in->p[28]) + ((size_t)l * 32 + e) * 262144, g2, n0, (n0 >> 8) * 128 + (c0 & 127)}; cvt_item(f, r, 16, WGU + (size_t)e * 512 * 1024, 1024, tile, tid); }
        else { const int j = it - 32 * 128, e = j >> 6, r = j & 63; FWd f{in->p[29] + ((size_t)l * 32 + e) * 262144}; cvt_item(f, r, 4, WD + (size_t)e * 1024 * 256, 256, tile, tid); }
    }
}

__device__ __forceinline__ void prologue(InPtr in, unsigned char* ws, LAS unsigned char* lds, int bid, int nb) {
    int tid_ = threadIdx.x; asm volatile("" : "+v"(tid_));
    const int tid = tid_, lane = tid & 63, wid = tid >> 6;
    LAS float* tile = (LAS float*)lds;
    constexpr int I_WIN = 40 * 16, I_WOUT = 16 * 16, I_WU = 12 * 4, I_WC1 = 32, I_WC2 = 1, I_WR = 16;
    constexpr int PER_L = I_WIN + I_WOUT + 2 * I_WU + 2 * I_WC1 + 2 * I_WC2 + I_WR;
    for (int it0 = bid; it0 < 2 * PER_L; it0 += nb) {
        const int l = it0 / PER_L; int it = it0 % PER_L;
        if (it < I_WIN) { FWin f{in->p[4] + (size_t)l * 1024 * DIN, in->p[3] + l * 1024}; cvt_item(f, it, 16, (bf16_t*)(ws + WS_WIN) + (size_t)l * 2560 * 1024, 1024, tile, tid); continue; } it -= I_WIN;
        if (it < I_WOUT) { FWout f{in->p[21] + (size_t)l * 1048576, in->p[10] + l * 384, in->p[20] + l * 384}; cvt_item(f, it, 16, (bf16_t*)(ws + WS_WOUT) + (size_t)l * 1048576, 1024, tile, tid); continue; } it -= I_WOUT;
        if (it < I_WU) { FWuq f{in->p[16] + (size_t)l * 192 * 576, in->p[15] + l * 192}; cvt_item(f, it, 4, (bf16_t*)(ws + WS_WUQ) + (size_t)l * 768 * 256, 256, tile, tid); continue; } it -= I_WU;
        if (it < I_WU) { FWukv f{in->p[18] + (size_t)l * 128 * 768, in->p[17] + l * 128}; cvt_item(f, it, 4, (bf16_t*)(ws + WS_WUKV) + (size_t)l * 768 * 256, 256, tile, tid); continue; } it -= I_WU;
        if (it < 2 * I_WC1) { const int s = it / I_WC1; FWc1 f{in->p[6] + ((size_t)l * 2 + s) * 2048 * 64}; cvt_item(f, it % I_WC1, 32, (bf16_t*)(ws + WS_WC1) + ((size_t)l * 2 + s) * 64 * 2048, 2048, tile, tid); continue; } it -= 2 * I_WC1;
        if (it < 2 * I_WC2) { const int s = it; FWc1 f{in->p[7] + ((size_t)l * 2 + s) * 64 * 64}; cvt_item(f, 0, 1, (bf16_t*)(ws + WS_WC2) + ((size_t)l * 2 + s) * 64 * 64, 64, tile, tid); continue; } it -= 2 * I_WC2;
        { FWr f{in->p[23] + (size_t)l * 4096, in->p[25] + (size_t)l * 32768, in->p[22] + l * 1024}; cvt_item(f, it, 16, (bf16_t*)(ws + WS_WR) + (size_t)l * 64 * 1024, 1024, tile, tid); }
    }
    cvt_moe_layer(in, ws, 0, tile, bid, nb, tid);
    { const float* x = in->p[0]; bf16_t* XB = (bf16_t*)(ws + WS_XB); float* ssqx = (float*)(ws + WS_SSQX);
      for (int r = bid * 8 + wid; r < NTOK; r += nb * 8) {
          const f32x4* xr = (const f32x4*)(x + (size_t)r * 1024) + lane; float s = 0.f; u32x2* o = (u32x2*)(XB + (size_t)r * 1024) + lane;
#pragma unroll
          for (int j = 0; j < 4; ++j) { const f32x4 v = xr[64 * j]; s += (v.x * v.x + v.y * v.y) + (v.z * v.z + v.w * v.w); u32x2 w; w.x = pk_bf16(v.x, v.y); w.y = pk_bf16(v.z, v.w); o[64 * j] = w; }
          s = wave_sum(s); if (lane == 0) ssqx[r] = s;
      } }
    { float* biasd = (float*)(ws + WS_BIASD); const float* rb = in->p[2];
      for (int i = bid * 512 + tid; i < 6 * 2048; i += nb * 512) { const int h = i >> 11, d = i & 2047; biasd[i] = rb[t5b(d) * 6 + h]; } }
    { float* rope = (float*)(ws + WS_ROPE); const int* pos = (const int*)in->p[1];
      for (int i = bid * 512 + tid; i < NTOK * 16; i += nb * 512) { const int tk = i >> 4, j = i & 15; float cs, sn; rope_cs(pos[tk], j, cs, sn); rope[(size_t)tk * 32 + j] = cs; rope[(size_t)tk * 32 + 16 + j] = sn; } }
    { float* b1c = (float*)(ws + WS_B1C); LAS float* red = (LAS float*)lds;
      for (int it = bid; it < 4; it += nb) { const float* pe = in->p[5] + (size_t)it * 2048; const float* w1 = in->p[6] + (size_t)it * 2048 * 64; const int f = tid & 63, part = tid >> 6;
          float a = 0.f; for (int k = part * 256; k < part * 256 + 256; ++k) a += pe[k] * w1[(size_t)k * 64 + f];
          __syncthreads(); red[tid] = a; __syncthreads();
          if (tid < 64) { float s = 0.f; for (int p2 = 0; p2 < 8; ++p2) s += red[p2 * 64 + tid]; b1c[it * 64 + tid] = s; }
          __syncthreads(); } }
}
namespace g8 {
constexpr int BM = 256, BK = 64, HALF = 128, HTB = HALF * BK * 2, STAGE_BYTES = 8 * HTB, NXCD = 8, WGM = 8;
__host__ __device__ __forceinline__ int lds_byte(int r, int c) { const int st = (r >> 4) * 2 + (c >> 5), rr = r & 15, cc = c & 31, ob = rr * 64 + cc * 2; return st * 1024 + (ob ^ (((ob >> 9) & 1) << 5)); }
__host__ __device__ __forceinline__ void stage_rc(int b, int& R, int& C) { const int st = b / 1024, sb = b % 1024, swz = sb ^ (((sb >> 9) & 1) << 5); R = (st >> 1) * 16 + swz / 64; C = (st & 1) * 32 + (swz % 64) / 2; }
__host__ __device__ __forceinline__ int perm32(int rho) { const int n = rho >> 4, i = rho & 15; return 8 * (i >> 2) + 4 * n + (i & 3); }

struct GUnit { const char* a; const char* b; int pm, pn, e, rows; };

__device__ __forceinline__ bool static_unit(int i, int G, int c, int nM, int nN, int& pm, int& pn) {
    const int nwg = nM * nN; const long L = (long)i * G + c; if (L >= nwg) return false;
    int wgid = (int)L; { const int q = nwg / NXCD, r = nwg % NXCD, xcd = wgid % NXCD, off = wgid / NXCD; wgid = (xcd < r ? xcd * (q + 1) : r * (q + 1) + (xcd - r) * q) + off; }
    const int nig = WGM * nN, gid = wgid / nig, fm = gid * WGM, gsz = (nM - fm) < WGM ? (nM - fm) : WGM;
    pm = fm + ((wgid % nig) % gsz); pn = (wgid % nig) / gsz; return true;
}
struct DenseSched {
    static constexpr bool GATHER = false;
    const char* A; const char* Bt; int lda, ldb, nM, nN, G, c;
    __device__ __forceinline__ bool next(int i, GUnit& u) const {
        int pm, pn; if (!static_unit(i, G, c, nM, nN, pm, pn)) return false;
        u.pm = pm; u.pn = pn; u.e = 0; u.rows = 256; u.a = A + (size_t)pm * 256 * lda * 2; u.b = Bt + (size_t)pn * 256 * ldb * 2; return true;
    }
    __device__ __forceinline__ void aoff(const GUnit&, unsigned (&v)[2][2], const int (&R)[2], const int (&C)[2]) const {
#pragma unroll
        for (int h = 0; h < 2; ++h)
#pragma unroll
            for (int i = 0; i < 2; ++i) v[h][i] = (unsigned)((h * 128 + R[i]) * lda + C[i]) * 2u;
    }
};

template <class Epi, class Sched>
__device__ __forceinline__ void gemm_run(LAS unsigned char* lds, const int K, const int ldb, const Sched& S, const Epi& E) {
    int tid_ = threadIdx.x; asm volatile("" : "+v"(tid_));
    const int tid = tid_, wid = __builtin_amdgcn_readfirstlane(tid >> 6), lane = tid & 63, wr = wid >> 2, wc = wid & 3, fr = lane & 15, fq = lane >> 4;
    int nt_ = K / BK; asm volatile("" : "+s"(nt_));
    const int nt = nt_;
    int R[2], C[2]; unsigned voffB[2];
#pragma unroll
    for (int i = 0; i < 2; ++i) { stage_rc(tid * 16 + i * 8192, R[i], C[i]); const int Rb = (R[i] & ~31) + perm32(R[i] & 31); voffB[i] = (unsigned)(Rb * ldb + C[i]) * 2u; }
    const size_t kstep = (size_t)(BK * 2);
    const size_t hstepB = (size_t)HALF * ldb * 2;
    const unsigned ldsw = (unsigned)wid * 1024u;
    const int aoff = lds_byte(wr * 64 + fr, fq * 8), boff = lds_byte(wc * 32 + fr, fq * 8);
#define G8_SA(b, h) (((b) * 2 + (h)) * HTB)
#define G8_SB(b, h) ((4 + (b) * 2 + (h)) * HTB)
#define G8_GLDS(bufoff, gptr, i_) __builtin_amdgcn_global_load_lds((const unsigned*)(gptr), (LAS unsigned*)(lds + (bufoff) + ldsw + (i_) * 8192), 16, 0, 0)
#define G8_STAGE_B(bufoff, gbase) do { G8_GLDS(bufoff, (const char*)(gbase) + voffB[0], 0); G8_GLDS(bufoff, (const char*)(gbase) + voffB[1], 1); } while (0)
#define G8_STAGE_A(bufoff, gbase, v0, v1) do { G8_GLDS(bufoff, (const char*)(gbase) + (v0), 0); G8_GLDS(bufoff, (const char*)(gbase) + (v1), 1); } while (0)
#define G8_LDA(dst, b, h) do { _Pragma("unroll") for (int m = 0; m < 4; ++m) _Pragma("unroll") for (int k = 0; k < 2; ++k) dst[m][k] = *(const LAS bf16x8*)(lds + G8_SA(b, h) + aoff + m * 2048 + k * 1024); } while (0)
#define G8_LDB(dst, b, h) do { _Pragma("unroll") for (int n = 0; n < 2; ++n) _Pragma("unroll") for (int k = 0; k < 2; ++k) dst[n][k] = *(const LAS bf16x8*)(lds + G8_SB(b, h) + boff + n * 2048 + k * 1024); } while (0)
#define G8_MMA(ai, bj, At, Bt) do { __builtin_amdgcn_s_setprio(1); _Pragma("unroll") for (int m = 0; m < 4; ++m) _Pragma("unroll") for (int n = 0; n < 2; ++n) _Pragma("unroll") for (int k = 0; k < 2; ++k) \
        acc[ai][bj][m][n] = __builtin_amdgcn_mfma_f32_16x16x32_bf16(Bt[n][k], At[m][k], acc[ai][bj][m][n], 0, 0, 0); __builtin_amdgcn_s_setprio(0); } while (0)
#define G8_WAIT_V(n) asm volatile("s_waitcnt vmcnt(" #n ")" ::: "memory")
#define G8_WAIT_L(n) asm volatile("s_waitcnt lgkmcnt(" #n ")" ::: "memory")
#define G8_BAR __builtin_amdgcn_s_barrier()
#define G8_SCHED __builtin_amdgcn_sched_barrier(0)
    GUnit cur, nxt; int ui = 0;
    if (!S.next(0, cur)) return;
    constexpr bool GATHER = Sched::GATHER;
    unsigned vc[2][2];
    S.aoff(cur, vc, R, C);
    LAS u32x4* stash = (LAS u32x4*)(lds + STAGE_BYTES + 4096) + tid;
    f32x4 acc[2][2][4][2];
#pragma unroll
    for (int a = 0; a < 2; ++a)
#pragma unroll
        for (int b = 0; b < 2; ++b)
#pragma unroll
            for (int m = 0; m < 4; ++m)
#pragma unroll
                for (int n = 0; n < 2; ++n) acc[a][b][m][n] = (f32x4){0.f, 0.f, 0.f, 0.f};
    bf16x8 At[4][2], B0[2][2], B1[2][2];
    const char* cA = cur.a; const char* cB = cur.b;
    G8_STAGE_B(G8_SB(0, 0), cB); G8_STAGE_B(G8_SB(0, 1), cB + hstepB); G8_STAGE_A(G8_SA(0, 0), cA, vc[0][0], vc[0][1]); G8_STAGE_A(G8_SA(0, 1), cA, vc[1][0], vc[1][1]);
    if (wr == 1) G8_BAR;
    G8_WAIT_V(2); G8_BAR;
    G8_STAGE_B(G8_SB(1, 0), cB + kstep); G8_STAGE_A(G8_SA(1, 0), cA + kstep, vc[0][0], vc[0][1]); G8_STAGE_B(G8_SB(1, 1), cB + hstepB + kstep);
    G8_WAIT_V(6); G8_BAR;
    for (;;) {
        const bool has_next = S.next(ui + 1, nxt);
        if (GATHER) { unsigned vn[2][2];
            if (has_next) S.aoff(nxt, vn, R, C);
            else { vn[0][0] = vc[0][0]; vn[0][1] = vc[0][1]; vn[1][0] = vc[1][0]; vn[1][1] = vc[1][1]; }
            u32x4 sv; sv.x = vn[0][0]; sv.y = vn[0][1]; sv.z = vn[1][0]; sv.w = vn[1][1]; *stash = sv; }
        const char* nA = has_next ? nxt.a : cA; const char* nB = has_next ? nxt.b : cB;
#pragma unroll 1
        for (int t = 0; t < nt; t += 2) {
            const bool last = (t == nt - 2);
            const char* a1 = cA + (size_t)(t + 1) * kstep;
            const char* a2 = last ? nA : cA + (size_t)(t + 2) * kstep; const char* b2 = last ? nB : cB + (size_t)(t + 2) * kstep;
            const char* a3 = a2 + kstep; const char* b3 = b2 + kstep;
            unsigned w00 = vc[0][0], w01 = vc[0][1], w10 = vc[1][0], w11 = vc[1][1];
            if (GATHER) { if (last) { const u32x4 sv = *stash; w00 = sv.x; w01 = sv.y; w10 = sv.z; w11 = sv.w; } }
            G8_LDB(B0, 0, 0); G8_LDB(B1, 0, 1); G8_SCHED; G8_LDA(At, 0, 0); G8_STAGE_A(G8_SA(1, 1), a1, vc[1][0], vc[1][1]);
            G8_WAIT_V(8); G8_WAIT_L(0); G8_BAR; G8_MMA(0, 0, At, B0); G8_MMA(0, 1, At, B1); G8_BAR; G8_SCHED;
            G8_LDA(At, 0, 1); G8_STAGE_B(G8_SB(0, 0), b2); G8_STAGE_B(G8_SB(0, 1), b2 + hstepB); G8_STAGE_A(G8_SA(0, 0), a2, w00, w01);
            G8_WAIT_V(8); G8_WAIT_L(0); G8_BAR; G8_MMA(1, 0, At, B0); G8_MMA(1, 1, At, B1); G8_BAR; G8_SCHED;
            G8_LDB(B0, 1, 0); G8_LDB(B1, 1, 1); G8_SCHED; G8_LDA(At, 1, 0); G8_STAGE_A(G8_SA(0, 1), a2, w10, w11);
            G8_WAIT_V(8); G8_WAIT_L(0); G8_BAR; G8_MMA(0, 0, At, B0); G8_MMA(0, 1, At, B1); G8_BAR; G8_SCHED;
            G8_LDA(At, 1, 1); G8_STAGE_B(G8_SB(1, 0), b3); G8_STAGE_B(G8_SB(1, 1), b3 + hstepB); G8_STAGE_A(G8_SA(1, 0), a3, w00, w01);
            G8_WAIT_V(8); G8_WAIT_L(0); G8_BAR; G8_MMA(1, 0, At, B0); G8_MMA(1, 1, At, B1); G8_BAR; G8_SCHED;
        }
        if (wr == 0) G8_BAR;
        { int fr_ = fr, fq_ = fq; asm volatile("" : "+v"(fr_), "+v"(fq_));
          E(acc, cur, wr, wc, fr_, fq_); }
        if (!has_next) break;
#pragma unroll
        for (int a = 0; a < 2; ++a)
#pragma unroll
            for (int b = 0; b < 2; ++b)
#pragma unroll
                for (int m = 0; m < 4; ++m)
#pragma unroll
                    for (int n = 0; n < 2; ++n) acc[a][b][m][n] = (f32x4){0.f, 0.f, 0.f, 0.f};
        cur = nxt; cA = nA; cB = nB; ++ui;
        if (GATHER) { const u32x4 sv = *stash; vc[0][0] = sv.x; vc[0][1] = sv.y; vc[1][0] = sv.z; vc[1][1] = sv.w; }
        if (wr == 1) G8_BAR;
    }
    G8_WAIT_V(0);
    G8_BAR;
#undef G8_SA
#undef G8_SB
#undef G8_GLDS
#undef G8_STAGE_A
#undef G8_STAGE_B
#undef G8_LDA
#undef G8_LDB
#undef G8_MMA
#undef G8_WAIT_V
#undef G8_WAIT_L
#undef G8_BAR
#undef G8_SCHED
}
}
using g8::GUnit;
__device__ __forceinline__ void st_bf16x8(bf16_t* p, const float (&v)[8]) { u32x4 w; w.x = pk_bf16(v[0], v[1]); w.y = pk_bf16(v[2], v[3]); w.z = pk_bf16(v[4], v[5]); w.w = pk_bf16(v[6], v[7]); *(u32x4*)p = w; }
__device__ __forceinline__ float quad_sum(float s) { s += __shfl_xor(s, 16); s += __shfl_xor(s, 32); return s; }

struct EpiInProj {
    const float* ssqx; float* part_dq; float* part_dkv; const float* qg; const float* kg; const float* krg; const float* rope;
    unsigned char* prj;
    __device__ __forceinline__ void operator()(const f32x4 (&acc)[2][2][4][2], const GUnit& u, int wr, int wc, int fr, int fq) const {
        const int G = u.pn * 4 + wc;
        const bool isq = G < 6; const int a = G - 6; const bool isk = (G >= 10 && G < 18 && ((a >> 1) & 1) == 0);
        const float* g0 = (isq ? qg : kg) + 8 * fq;
#pragma unroll
        for (int ai = 0; ai < 2; ++ai)
#pragma unroll
            for (int m = 0; m < 4; ++m) {
                __builtin_amdgcn_sched_barrier(0);
                const int row = u.pm * 256 + ai * 128 + wr * 64 + m * 16 + fr; const int b = row >> 11, t = row & 2047;
                const float rs = rsqrtf(ssqx[row] * (1.f / 1024.f) + 1e-6f);
                float v[2][8];
#pragma unroll
                for (int bj = 0; bj < 2; ++bj)
#pragma unroll
                    for (int n = 0; n < 2; ++n)
#pragma unroll
                        for (int j = 0; j < 4; ++j) v[bj][4 * n + j] = acc[ai][bj][m][n][j] * rs;
                float ss = 0.f;
#pragma unroll
                for (int bj = 0; bj < 2; ++bj)
#pragma unroll
                    for (int i = 0; i < 8; ++i) ss += v[bj][i] * v[bj][i];
                bf16_t* dst = nullptr; int bstride = 32;
                if (isq) {
                    ss = quad_sum(ss); const float sc = rsqrtf(ss * (1.f / 64.f) + 1e-6f) * 0.125f;
#pragma unroll
                    for (int i = 0; i < 8; ++i) { v[0][i] *= sc * g0[i]; v[1][i] *= sc * g0[32 + i]; }
                    dst = (bf16_t*)(prj + PRJ_QN) + ((size_t)(b * 6 + G) * 2048 + t) * 64;
                } else if (G < 18) {
                    const int br = a >> 2, s = (a >> 1) & 1, hk = a & 1;
                    if (br > 0 && s == 0) {
                        ss = quad_sum(ss); const float sc = rsqrtf(ss * (1.f / 64.f) + 1e-6f);
#pragma unroll
                        for (int i = 0; i < 8; ++i) { v[0][i] *= sc * g0[i]; v[1][i] *= sc * g0[32 + i]; }
                    }
                    const size_t base = br == 0 ? (s ? PRJ_C0V : PRJ_C0K) : (br == 1 ? (s ? PRJ_VN1 : PRJ_KN1) : (s ? PRJ_VN2 : PRJ_KN2));
                    dst = (bf16_t*)(prj + base) + ((size_t)(b * 2 + hk) * 2048 + t) * 64;
                } else if (G < 26) { dst = (bf16_t*)(prj + PRJ_RAWQK) + (size_t)row * 512 + (G - 18) * 64; }
                else if (G < 30) { dst = (bf16_t*)(prj + PRJ_VML) + ((size_t)(b * 4 + (G - 26)) * 2048 + t) * 64; }
                else if (G < 34) { dst = (bf16_t*)(prj + PRJ_OG) + (size_t)row * 256 + (G - 30) * 64; }
                else if (G < 37) { dst = (bf16_t*)(prj + PRJ_DQKV) + (size_t)row * 384 + (G - 34) * 64; ss = quad_sum(ss); if (fq == 0) part_dq[(size_t)row * 4 + (G - 34)] = ss; }
                else if (G == 37) {
                    dst = (bf16_t*)(prj + PRJ_DQKV) + (size_t)row * 384 + 192;
                    float* gt = (float*)(prj + PRJ_GATES) + (size_t)row * 32 + 8 * fq;
                    *(f32x4*)gt = (f32x4){v[1][0], v[1][1], v[1][2], v[1][3]}; *(f32x4*)(gt + 4) = (f32x4){v[1][4], v[1][5], v[1][6], v[1][7]};
                    float s0 = 0.f;
#pragma unroll
                    for (int i = 0; i < 8; ++i) s0 += v[0][i] * v[0][i];
                    s0 = quad_sum(s0); const float sc = rsqrtf(s0 * (1.f / 32.f) + 1e-6f);
                    const float* rp = rope + (size_t)row * 32 + ((8 * fq) & 15);
                    float kr[8];
#pragma unroll
                    for (int i = 0; i < 8; ++i) { const float val = v[0][i] * sc * krg[8 * fq + i]; const float oth = __shfl_xor(val, 32); const float cs = rp[i], sn = rp[16 + i]; kr[i] = fq < 2 ? val * cs - oth * sn : val * cs + oth * sn; }
                    st_bf16x8((bf16_t*)(prj + PRJ_KR) + (size_t)row * 32 + 8 * fq, kr);
                } else { dst = (bf16_t*)(prj + PRJ_DQKV) + (size_t)row * 384 + 256 + (G - 38) * 64; ss = quad_sum(ss); if (fq == 0) part_dkv[(size_t)row * 2 + (G - 38)] = ss; }
                st_bf16x8(dst + 8 * fq, v[0]); st_bf16x8(dst + bstride + 8 * fq, v[1]);
            }
    }
};

struct EpiUq {
    const float* ssq_dq; const float* qkn; const float* rope; bf16_t* QM;
    __device__ __forceinline__ void operator()(const f32x4 (&acc)[2][2][4][2], const GUnit& u, int wr, int wc, int fr, int fq) const {
        const int G = u.pn * 4 + wc; if (G >= 9) return;
        const float scale = 0.10206207261596575f;
        const float* g0 = G < 6 ? qkn + 8 * fq : qkn + 64 + 8 * (fq & 1); const float* g1 = G < 6 ? g0 + 32 : g0 + 16;
#pragma unroll
        for (int ai = 0; ai < 2; ++ai)
#pragma unroll
            for (int m = 0; m < 4; ++m) {
                __builtin_amdgcn_sched_barrier(0);
                const int row = u.pm * 256 + ai * 128 + wr * 64 + m * 16 + fr; const int b = row >> 11, t = row & 2047;
                const f32x4 pq = *(const f32x4*)(ssq_dq + (size_t)row * 4); const float rs = rsqrtf(((pq.x + pq.y) + pq.z) * (1.f / 192.f) + 1e-6f);
                float v[2][8]; float ss = 0.f;
#pragma unroll
                for (int bj = 0; bj < 2; ++bj)
#pragma unroll
                    for (int n = 0; n < 2; ++n)
#pragma unroll
                        for (int j = 0; j < 4; ++j) { const float x = acc[ai][bj][m][n][j] * rs; v[bj][4 * n + j] = x; ss += x * x; }
                if (G < 6) ss = quad_sum(ss); else ss += __shfl_xor(ss, 16);
                const float sc = rsqrtf(ss * (G < 6 ? 1.f / 64.f : 1.f / 32.f) + 1e-6f) * scale;
#pragma unroll
                for (int i = 0; i < 8; ++i) { v[0][i] *= sc * g0[i]; v[1][i] *= sc * g1[i]; }
                if (G < 6) {
                    bf16_t* dst = QM + ((size_t)(b * 6 + G) * 2048 + t) * 96;
                    st_bf16x8(dst + 8 * fq, v[0]); st_bf16x8(dst + 32 + 8 * fq, v[1]);
                } else {
                    const int i16 = 8 * (fq & 1); const int head = 2 * (G - 6) + (fq >> 1);
                    const float* rp = rope + (size_t)row * 32 + i16; float o1[8], o2[8];
#pragma unroll
                    for (int i = 0; i < 8; ++i) { const float cs = rp[i], sn = rp[16 + i]; o1[i] = v[0][i] * cs - v[1][i] * sn; o2[i] = v[1][i] * cs + v[0][i] * sn; }
                    bf16_t* dst = QM + ((size_t)(b * 6 + head) * 2048 + t) * 96 + 64 + i16;
                    st_bf16x8(dst, o1); st_bf16x8(dst + 16, o2);
                }
            }
    }
};
struct EpiUkv {
    const float* ssq_dkv; const float* qkn; const bf16_t* KR; bf16_t* KM; bf16_t* VM;
    __device__ __forceinline__ void operator()(const f32x4 (&acc)[2][2][4][2], const GUnit& u, int wr, int wc, int fr, int fq) const {
        const int G = u.pn * 4 + wc;
        const float* g0 = qkn + 96 + 8 * fq;
#pragma unroll
        for (int ai = 0; ai < 2; ++ai)
#pragma unroll
            for (int m = 0; m < 4; ++m) {
                __builtin_amdgcn_sched_barrier(0);
                const int row = u.pm * 256 + ai * 128 + wr * 64 + m * 16 + fr; const int b = row >> 11, t = row & 2047;
                const float rs = rsqrtf((ssq_dkv[(size_t)row * 2] + ssq_dkv[(size_t)row * 2 + 1]) * (1.f / 128.f) + 1e-6f);
                float v[2][8]; float ss = 0.f;
#pragma unroll
                for (int bj = 0; bj < 2; ++bj)
#pragma unroll
                    for (int n = 0; n < 2; ++n)
#pragma unroll
                        for (int j = 0; j < 4; ++j) { const float x = acc[ai][bj][m][n][j] * rs; v[bj][4 * n + j] = x; ss += x * x; }
                if (G < 6) {
                    ss = quad_sum(ss); const float sc = rsqrtf(ss * (1.f / 64.f) + 1e-6f);
#pragma unroll
                    for (int i = 0; i < 8; ++i) { v[0][i] *= sc * g0[i]; v[1][i] *= sc * g0[32 + i]; }
                    bf16_t* dst = KM + ((size_t)(b * 6 + G) * 2048 + t) * 96;
                    st_bf16x8(dst + 8 * fq, v[0]); st_bf16x8(dst + 32 + 8 * fq, v[1]);
                    *(u32x4*)(dst + 64 + 8 * fq) = *(const u32x4*)(KR + (size_t)row * 32 + 8 * fq);
                } else {
                    bf16_t* dst = VM + ((size_t)(b * 6 + (G - 6)) * 2048 + t) * 64;
                    st_bf16x8(dst + 8 * fq, v[0]); st_bf16x8(dst + 32 + 8 * fq, v[1]);
                }
            }
    }
};
#define MFMA16(a, b, c) __builtin_amdgcn_mfma_f32_16x16x32_bf16(a, b, c, 0, 0, 0)
#define MFMA32(a, b, c) __builtin_amdgcn_mfma_f32_32x32x16_bf16(a, b, c, 0, 0, 0)
#define LDS_FENCE() asm volatile("s_waitcnt lgkmcnt(0)" ::: "memory")

__device__ __forceinline__ void cmp_unit(int u, int l, InPtr in, unsigned char* ws, LAS unsigned char* lds) {
    int tid_ = threadIdx.x; asm volatile("" : "+v"(tid_));
    const int tid = tid_, w = tid >> 6, lane = tid & 63, r = lane & 15, q = lane >> 4;
    const int b = u >> 2, s = (u >> 1) & 1, hk = u & 1;
    const bf16_t* A = (const bf16_t*)(ws + WS_PRJ + (s ? PRJ_C0V : PRJ_C0K)) + (size_t)(b * 2 + hk) * 2048 * 64;
    const bf16_t* W1 = (const bf16_t*)(ws + WS_WC1) + ((size_t)l * 2 + s) * 64 * 2048;
    const bf16_t* W2 = (const bf16_t*)(ws + WS_WC2) + ((size_t)l * 2 + s) * 64 * 64;
    const float* b1 = (const float*)(ws + WS_B1C) + (l * 2 + s) * 64;
    f32x4 acc[4];
#pragma unroll
    for (int nb = 0; nb < 4; ++nb) acc[nb] = (f32x4){0.f, 0.f, 0.f, 0.f};
    const bf16_t* ap = A + (size_t)(16 * w + r) * 1024 + 8 * q;
    const bf16_t* bp = W1 + (size_t)r * 2048 + 8 * q;
#pragma unroll 4
    for (int ks = 0; ks < 64; ++ks) {
        const bf16x8 a = *(const bf16x8*)(ap + 32 * ks);
#pragma unroll
        for (int nb = 0; nb < 4; ++nb) { const bf16x8 bb = *(const bf16x8*)(bp + (size_t)nb * 16 * 2048 + 32 * ks); acc[nb] = MFMA16(a, bb, acc[nb]); }
    }
    LAS bf16_t* hl = (LAS bf16_t*)(lds + w * 2304);
#pragma unroll
    for (int nb = 0; nb < 4; ++nb) { const float bias = b1[16 * nb + r];
#pragma unroll
        for (int j = 0; j < 4; ++j) hl[(4 * q + j) * 72 + 16 * nb + r] = f2bf(siluf(acc[nb][j] + bias)); }
    LDS_FENCE();
    f32x4 o[4];
#pragma unroll
    for (int nb = 0; nb < 4; ++nb) o[nb] = (f32x4){0.f, 0.f, 0.f, 0.f};
#pragma unroll
    for (int ks = 0; ks < 2; ++ks) {
        const bf16x8 a = *(const LAS bf16x8*)(hl + r * 72 + 32 * ks + 8 * q);
#pragma unroll
        for (int nb = 0; nb < 4; ++nb) { const bf16x8 bb = *(const bf16x8*)(W2 + (size_t)(16 * nb + r) * 64 + 32 * ks + 8 * q); o[nb] = MFMA16(a, bb, o[nb]); }
    }
    LDS_FENCE();
    const float* kg = in->p[9] + l * 64;
    bf16_t* dst = (bf16_t*)(ws + WS_CMP + (s ? CMP_V : 0)) + (size_t)(b * 2 + hk) * 128 * 64;
#pragma unroll
    for (int j = 0; j < 4; ++j) {
        const int n = 16 * w + 4 * q + j; float ss = 0.f;
#pragma unroll
        for (int nb = 0; nb < 4; ++nb) ss += o[nb][j] * o[nb][j];
        ss += __shfl_xor(ss, 1); ss += __shfl_xor(ss, 2); ss += __shfl_xor(ss, 4); ss += __shfl_xor(ss, 8);
        const float sc = s == 0 ? rsqrtf(ss * (1.f / 64.f) + 1e-6f) : 1.f;
#pragma unroll
        for (int nb = 0; nb < 4; ++nb) { const int d = 16 * nb + r; const float v = o[nb][j] * sc * (s == 0 ? kg[d] : 1.f); dst[(size_t)n * 64 + d] = n < 127 ? f2bf(v) : (bf16_t)0; }
    }
}

__device__ __forceinline__ int swz_off(int row, int chunk) { return row * 128 + ((chunk ^ (row & 7)) << 4); }
__device__ __forceinline__ float log_sigmoid(float x) { return fminf(x, 0.f) - log1pf(__expf(-fabsf(x))); }
__device__ __forceinline__ void ml_delta_wave(int cu, int l, InPtr in, unsigned char* ws, LAS unsigned char* wl, int lane) {
    const int c = cu & 31, bh = cu >> 5, h = bh & 3, b = bh >> 2; const int t0 = c * 64; const size_t row0 = (size_t)b * 2048 + t0;
    const float* G = (const float*)(ws + WS_PRJ + PRJ_GATES);
    const float ip = G[(row0 + lane) * 32 + 18 + h] + in->p[12][l * 4 + h], fp = G[(row0 + lane) * 32 + 22 + h] + in->p[13][l * 4 + h];
    float bcum = log_sigmoid(fp);
#pragma unroll
    for (int o = 1; o < 64; o <<= 1) { const float t = __shfl_up(bcum, o); if (lane >= o) bcum += t; }
    const float bL = __shfl(bcum, 63); const float wgt = __expf(bL - bcum + ip);
    { float* mlg = (float*)(ws + WS_ML + ML_G) + ((size_t)bh * 2048 + t0 + lane) * 2; mlg[0] = bcum; mlg[1] = ip; if (lane == 0) ((float*)(ws + WS_ML + ML_BL))[cu] = bL; }
    const bf16_t* raw = (const bf16_t*)(ws + WS_PRJ + PRJ_RAWQK); const float* cw = in->p[11] + (size_t)l * 4 * 512;
    float wq[4], wk[4];
#pragma unroll
    for (int j = 0; j < 4; ++j) { wq[j] = cw[j * 512 + h * 64 + lane]; wk[j] = cw[j * 512 + 256 + h * 64 + lane]; }
    float q3 = 0.f, q2 = 0.f, q1 = 0.f, k3 = 0.f, k2 = 0.f, k1 = 0.f;
    if (c > 0) { const bf16_t* p = raw + (row0 - 3) * 512 + h * 64 + lane; q3 = bf2f(p[0]); q2 = bf2f(p[512]); q1 = bf2f(p[1024]); k3 = bf2f(p[256]); k2 = bf2f(p[512 + 256]); k1 = bf2f(p[1024 + 256]); }
    bf16_t* QC = (bf16_t*)(ws + WS_ML) + ((size_t)bh * 2048 + t0) * 64 + lane; bf16_t* KC = (bf16_t*)(ws + WS_ML + ML_KC) + ((size_t)bh * 2048 + t0) * 64 + lane;
    const bf16_t* V = (const bf16_t*)(ws + WS_PRJ + PRJ_VML) + ((size_t)bh * 2048 + t0) * 64 + lane;
    float dn = 0.f;
#pragma unroll
    for (int s8 = 0; s8 < 8; ++s8) {
        float kb[8], vb[8];
#pragma unroll
        for (int j = 0; j < 8; ++j) {
            const int s = s8 * 8 + j; const bf16_t* p = raw + (row0 + s) * 512 + h * 64 + lane;
            const float q0 = bf2f(p[0]), k0 = bf2f(p[256]);
            const float qv = siluf(wq[0] * q3 + wq[1] * q2 + wq[2] * q1 + wq[3] * q0), kv = siluf(wk[0] * k3 + wk[1] * k2 + wk[2] * k1 + wk[3] * k0) * 0.125f;
            q3 = q2; q2 = q1; q1 = q0; k3 = k2; k2 = k1; k1 = k0;
            const bf16_t kh = f2bf(kv); QC[(size_t)s * 64] = f2bf(qv); KC[(size_t)s * 64] = kh;
            const float ws_ = __shfl(wgt, s); kb[j] = bf2f(kh); dn += ws_ * kb[j]; vb[j] = ws_ * bf2f(V[(size_t)s * 64]);
        }
        u32x4 pk; pk.x = pk_bf16(kb[0], kb[1]); pk.y = pk_bf16(kb[2], kb[3]); pk.z = pk_bf16(kb[4], kb[5]); pk.w = pk_bf16(kb[6], kb[7]);
        *(LAS u32x4*)(wl + swz_off(lane, s8)) = pk;
        pk.x = pk_bf16(vb[0], vb[1]); pk.y = pk_bf16(vb[2], vb[3]); pk.z = pk_bf16(vb[4], vb[5]); pk.w = pk_bf16(vb[6], vb[7]);
        *(LAS u32x4*)(wl + 8192 + swz_off(lane, s8)) = pk;
    }
    ((float*)(ws + WS_ML + ML_DN))[(size_t)cu * 64 + lane] = dn;
    LDS_FENCE();
    const int r = lane & 15, q = lane >> 4;
    bf16_t* DL = (bf16_t*)(ws + WS_ML + ML_DELTA) + (size_t)cu * 4096;
#pragma unroll
    for (int mb = 0; mb < 4; ++mb) {
        f32x4 acc[4];
#pragma unroll
        for (int nb = 0; nb < 4; ++nb) acc[nb] = (f32x4){0.f, 0.f, 0.f, 0.f};
#pragma unroll
        for (int ks = 0; ks < 2; ++ks) {
            const bf16x8 a = *(const LAS bf16x8*)(wl + 8192 + swz_off(16 * mb + r, 4 * ks + q));
#pragma unroll
            for (int nb = 0; nb < 4; ++nb) { const bf16x8 bb = *(const LAS bf16x8*)(wl + swz_off(16 * nb + r, 4 * ks + q)); acc[nb] = MFMA16(a, bb, acc[nb]); }
        }
#pragma unroll
        for (int nb = 0; nb < 4; ++nb)
#pragma unroll
            for (int j = 0; j < 4; ++j) DL[(16 * mb + 4 * q + j) * 64 + 16 * nb + r] = f2bf(acc[nb][j]);
    }
    LDS_FENCE();
}

__device__ __forceinline__ void phase_prep(int l, InPtr in, unsigned char* ws, LAS unsigned char* lds, int bid, int nb) {
    asm volatile("" : "+s"(bid));
#ifndef NO_UQ
    { g8::DenseSched S{(const char*)(ws + WS_PRJ + PRJ_DQKV), (const char*)(ws + WS_WUQ) + (size_t)l * 768 * 256 * 2, 384, 256, 64, 3, nb, bid};
      EpiUq E{(const float*)(ws + WS_SSQ + PT_DQ) + (size_t)l * 16384 * 4, in->p[19] + l * 192, (const float*)(ws + WS_ROPE), (bf16_t*)(ws + WS_MLA)};
      g8::gemm_run(lds, 256, 256, S, E); }
#endif
#ifndef NO_UKV
    asm volatile("" : "+s"(bid));
    { g8::DenseSched S{(const char*)(ws + WS_PRJ + PRJ_DQKV) + 256, (const char*)(ws + WS_WUKV) + (size_t)l * 768 * 256 * 2, 384, 256, 64, 3, nb, bid};
      EpiUkv E{(const float*)(ws + WS_SSQ + PT_DKV) + (size_t)l * 16384 * 2, in->p[19] + l * 192, (const bf16_t*)(ws + WS_PRJ + PRJ_KR), (bf16_t*)(ws + WS_MLA + MLA_KM), (bf16_t*)(ws + WS_MLA + MLA_VM)};
      g8::gemm_run(lds, 256, 256, S, E); }
#endif
    __syncthreads();
#ifndef NO_CMP
    for (int u = nb - 1 - bid; u < 32; u += nb) cmp_unit(u, l, in, ws, lds);
#endif
    __syncthreads();
#ifndef NO_DELTA
    { int tid_ = threadIdx.x; asm volatile("" : "+v"(tid_));
      for (int g = bid; g < 128; g += nb) ml_delta_wave(g * 8 + (tid_ >> 6), l, in, ws, lds + (tid_ >> 6) * 16384, tid_ & 63); }
#endif
}
#define CHK_TOL(st) (((st) & 15) == 8 ? 1e-2f : 1e-3f)
#define CHECK_REST
constexpr int VTP = 136;
__device__ __forceinline__ int crow(int reg, int h) { return (reg & 3) + 8 * (reg >> 2) + 4 * h; }
struct AttnState { f32x16 o[2]; float m, l; };
__device__ __forceinline__ void attn_reset(AttnState& A) { A.m = -1e30f; A.l = 0.f;
#pragma unroll
    for (int i = 0; i < 16; ++i) { A.o[0][i] = 0.f; A.o[1][i] = 0.f; } }

template <int DK>
__device__ __forceinline__ void attn_scores(f32x16 (&s)[2], const bf16x8 (&qf)[DK / 16], const LAS unsigned char* Kt, int r, int h) {
    constexpr int KP = 2 * DK + 16;
#pragma unroll
    for (int kb = 0; kb < 2; ++kb) {
#pragma unroll
        for (int i = 0; i < 16; ++i) s[kb][i] = 0.f;
#pragma unroll
        for (int ks = 0; ks < DK / 16; ++ks) { const bf16x8 kf = *(const LAS bf16x8*)(Kt + (32 * kb + r) * KP + (16 * ks + 8 * h) * 2); s[kb] = MFMA32(kf, qf[ks], s[kb]); }
    }
}
__device__ __forceinline__ void attn_softmax_pv(AttnState& A, f32x16 (&s)[2], const LAS unsigned char* Vt, int r, int h) {
    float mx = -1e30f;
#pragma unroll
    for (int kb = 0; kb < 2; ++kb)
#pragma unroll
        for (int i = 0; i < 16; ++i) mx = fmaxf(mx, s[kb][i]);
    mx = fmaxf(mx, __shfl_xor(mx, 32));
    const float mnew = fmaxf(A.m, mx); const float mref = mnew <= -1e29f ? 0.f : mnew;
    const float alpha = __expf(A.m - mref); float rs = 0.f;
#pragma unroll
    for (int kb = 0; kb < 2; ++kb)
#pragma unroll
        for (int i = 0; i < 16; ++i) { const float p = __expf(s[kb][i] - mref); s[kb][i] = p; rs += p; }
    rs += __shfl_xor(rs, 32);
    A.l = A.l * alpha + rs; A.m = mnew;
#pragma unroll
    for (int i = 0; i < 16; ++i) { A.o[0][i] *= alpha; A.o[1][i] *= alpha; }
#pragma unroll
    for (int s4 = 0; s4 < 4; ++s4) {
        const int kb = s4 >> 1, hf = (s4 & 1) * 8;
        u32x4 pw; pw.x = pk_bf16(s[kb][hf + 0], s[kb][hf + 1]); pw.y = pk_bf16(s[kb][hf + 2], s[kb][hf + 3]); pw.z = pk_bf16(s[kb][hf + 4], s[kb][hf + 5]); pw.w = pk_bf16(s[kb][hf + 6], s[kb][hf + 7]);
        const bf16x8 pf = __builtin_bit_cast(bf16x8, pw);
#pragma unroll
        for (int eb = 0; eb < 2; ++eb) {
            const LAS unsigned char* vp = Vt + (32 * eb + r) * VTP + (16 * s4 + 4 * h) * 2;
            const u32x2 v0 = *(const LAS u32x2*)vp, v1 = *(const LAS u32x2*)(vp + 16);
            u32x4 vw; vw.x = v0.x; vw.y = v0.y; vw.z = v1.x; vw.w = v1.y;
            A.o[eb] = MFMA32(__builtin_bit_cast(bf16x8, vw), pf, A.o[eb]);
        }
    }
}
template <int DK>
__device__ __forceinline__ void stage_k_load(u32x4 (&kr)[2], const bf16_t* Kg  , int tid) {
    constexpr int CH = DK / 8;
    kr[0] = *(const u32x4*)(Kg + (size_t)(tid / CH) * DK + (tid % CH) * 8);
    if (64 * CH > 512) { const int c2 = tid + 512; if (c2 < 64 * CH) kr[1] = *(const u32x4*)(Kg + (size_t)(c2 / CH) * DK + (c2 % CH) * 8); }
}
template <int DK>
__device__ __forceinline__ void stage_k_store(const u32x4 (&kr)[2], LAS unsigned char* Kt, int tid) {
    constexpr int CH = DK / 8, KP = 2 * DK + 16;
    *(LAS u32x4*)(Kt + (tid / CH) * KP + (tid % CH) * 16) = kr[0];
    if (64 * CH > 512) { const int c2 = tid + 512; if (c2 < 64 * CH) *(LAS u32x4*)(Kt + (c2 / CH) * KP + (c2 % CH) * 16) = kr[1]; }
}
__device__ __forceinline__ u32x4 stage_v_load(const bf16_t* Vg, int tid) { return *(const u32x4*)(Vg + (size_t)(tid >> 3) * 64 + (tid & 7) * 8); }
__device__ __forceinline__ void stage_v_store(const u32x4& v, LAS unsigned char* Vt, int tid) {
    const int key = tid >> 3, e0 = (tid & 7) * 8; LAS bf16_t* p = (LAS bf16_t*)(Vt + e0 * VTP + key * 2);
    p[0] = (bf16_t)(v.x & 0xffff); p[VTP / 2] = (bf16_t)(v.x >> 16); p[2 * (VTP / 2)] = (bf16_t)(v.y & 0xffff); p[3 * (VTP / 2)] = (bf16_t)(v.y >> 16);
    p[4 * (VTP / 2)] = (bf16_t)(v.z & 0xffff); p[5 * (VTP / 2)] = (bf16_t)(v.z >> 16); p[6 * (VTP / 2)] = (bf16_t)(v.w & 0xffff); p[7 * (VTP / 2)] = (bf16_t)(v.w >> 16);
}

constexpr int MLA_KT = 0, MLA_VT = 2 * 64 * 208, MLA_LDS = MLA_VT + 2 * 64 * VTP;
__device__ __forceinline__ void mla_unit(int b, int hd, int qt, int l, unsigned char* ws, LAS unsigned char* lds) {
    int tid_ = threadIdx.x; asm volatile("" : "+v"(tid_));
    const int tid = tid_, w = tid >> 6, lane = tid & 63, r = lane & 31, h = lane >> 5;
    const size_t slab = (size_t)(b * 6 + hd) * 2048;
    const bf16_t* QM = (const bf16_t*)(ws + WS_MLA) + slab * 96; const bf16_t* KM = (const bf16_t*)(ws + WS_MLA + MLA_KM) + slab * 96; const bf16_t* VM = (const bf16_t*)(ws + WS_MLA + MLA_VM) + slab * 64;
    const int q0 = 256 * qt + 32 * w, q = q0 + r;
    bf16x8 qf[6];
#pragma unroll
    for (int ks = 0; ks < 6; ++ks) qf[ks] = *(const bf16x8*)(QM + (size_t)q * 96 + 16 * ks + 8 * h);
    AttnState A; attn_reset(A);
    const int ntile = 4 * qt + 4;
    u32x4 kr[2], vr;
    stage_k_load<96>(kr, KM, tid); vr = stage_v_load(VM, tid);
    stage_k_store<96>(kr, lds + MLA_KT, tid); stage_v_store(vr, lds + MLA_VT, tid);
    __syncthreads();
    for (int j = 0; j < ntile; ++j) {
        const int cur = j & 1;
        if (j + 1 < ntile) { stage_k_load<96>(kr, KM + (size_t)(j + 1) * 64 * 96, tid); vr = stage_v_load(VM + (size_t)(j + 1) * 64 * 64, tid); }
        if (64 * j <= q0 + 31) {
            f32x16 s[2];
            attn_scores<96>(s, qf, lds + MLA_KT + cur * 64 * 208, r, h);
            if (64 * j + 63 > q0) {
#pragma unroll
                for (int kb = 0; kb < 2; ++kb)
#pragma unroll
                    for (int i = 0; i < 16; ++i) { const int key = 64 * j + 32 * kb + crow(i, h); if (key > q) s[kb][i] = -1e30f; }
            }
            attn_softmax_pv(A, s, lds + MLA_VT + cur * 64 * VTP, r, h);
        }
        if (j + 1 < ntile) { stage_k_store<96>(kr, lds + MLA_KT + (cur ^ 1) * 64 * 208, tid); stage_v_store(vr, lds + MLA_VT + (cur ^ 1) * 64 * VTP, tid); }
        __syncthreads();
    }
    const float inv = A.l > 0.f ? 1.f / A.l : 0.f; float ss = 0.f;
    bf16_t* Y = (bf16_t*)(ws + WS_Y) + ((size_t)b * 2048 + q) * 1024 + 640 + hd * 64;
#pragma unroll
    for (int eb = 0; eb < 2; ++eb)
#pragma unroll
        for (int g4 = 0; g4 < 4; ++g4) {
            const float v0 = A.o[eb][4 * g4] * inv, v1 = A.o[eb][4 * g4 + 1] * inv, v2 = A.o[eb][4 * g4 + 2] * inv, v3 = A.o[eb][4 * g4 + 3] * inv;
            u32x2 pw; pw.x = pk_bf16(v0, v1); pw.y = pk_bf16(v2, v3);
            const float f0 = bf_lo(pw.x), f1 = bf_hi(pw.x), f2 = bf_lo(pw.y), f3 = bf_hi(pw.y); ss += (f0 * f0 + f1 * f1) + (f2 * f2 + f3 * f3);
            *(u32x2*)(Y + 32 * eb + 8 * g4 + 4 * h) = pw;
        }
    ss += __shfl_xor(ss, 32);
    if (h == 0) ((float*)(ws + WS_SSQ + PT_C))[((size_t)l * 16384 + (size_t)b * 2048 + q) * 8 + hd] = ss;
}

__device__ __forceinline__ void nsa_mask_bias(f32x16 (&sc)[2], int dq, int h, const LAS float* bl, bool sel, int lim) {
    int dd = dq - 4 * h - 63; asm volatile("" : "+v"(dd));
    const LAS float* bp = bl + dd;
#pragma unroll
    for (int kb = 0; kb < 2; ++kb)
#pragma unroll
        for (int k = 0; k < 16; ++k) { const int c = 63 - (32 * kb + (k & 3) + 8 * (k >> 2)); const int d = dd + c; sc[kb][k] = (sel && d >= 0 && d < lim) ? sc[kb][k] + bp[c] : -1e30f; }
}

constexpr int NSA_KT = 0, NSA_VT = 2 * 64 * 144, NSA_BIAS = NSA_VT + 2 * 64 * VTP, NSA_PS = NSA_BIAS + 3 * 2048 * 4, NSA_SEL = NSA_PS + 3 * 64 * 32 * 4, NSA_UNI = NSA_SEL + 256, NSA_LDS = NSA_UNI + 16;
__device__ __forceinline__ void nsa_unit(int b, int hk, int i, int l, InPtr in, unsigned char* ws, LAS unsigned char* lds) {
    int tid_ = threadIdx.x; asm volatile("" : "+v"(tid_));
    const int tid = tid_, w = tid >> 6, lane = tid & 63, r = lane & 31, h = lane >> 5;
    const bool active = w < 6; const int g = active ? (w >> 1) : 0, th = w & 1, head = hk * 3 + g;
    const int t = 64 * i + 32 * th + r, tl = 32 * th + r; const size_t row = (size_t)b * 2048 + t;
    const size_t kvslab = (size_t)(b * 2 + hk) * 2048 * 64;
    LAS float* biasl = (LAS float*)(lds + NSA_BIAS); LAS float* PS = (LAS float*)(lds + NSA_PS); LAS unsigned* SEL = (LAS unsigned*)(lds + NSA_SEL); LAS unsigned* UNI = (LAS unsigned*)(lds + NSA_UNI);
    { const float* bd = (const float*)(ws + WS_BIASD) + (size_t)hk * 3 * 2048;
#pragma unroll
      for (int k = 0; k < 12; ++k) biasl[tid + 512 * k] = bd[tid + 512 * k];
#pragma unroll
      for (int k = 0; k < 12; ++k) PS[tid + 512 * k] = 0.f;
      if (tid < 4) UNI[tid] = 0u; }
    bf16x8 qf[4];
    { const bf16_t* QN = (const bf16_t*)(ws + WS_PRJ + PRJ_QN) + ((size_t)(b * 6 + head) * 2048 + t) * 64;
#pragma unroll
      for (int ks = 0; ks < 4; ++ks) qf[ks] = *(const bf16x8*)(QN + 16 * ks + 8 * h); }
    const float* gt = (const float*)(ws + WS_PRJ + PRJ_GATES) + row * 32 + head * 3;
    const float gc = sigmf(gt[0]), gs = sigmf(gt[1]), gw = sigmf(gt[2]);
    LAS float* bl = biasl + g * 2048;
    f32x16 ot[2];
    u32x4 kr[2], vr;
    const int ntc = i >= 16 ? 2 : 1;
    { const bf16_t* KC = (const bf16_t*)(ws + WS_CMP) + (size_t)(b * 2 + hk) * 128 * 64; const bf16_t* VC = (const bf16_t*)(ws + WS_CMP + CMP_V) + (size_t)(b * 2 + hk) * 128 * 64;
      for (int T = 0; T < ntc; ++T) { stage_k_load<64>(kr, KC + T * 4096, tid); vr = stage_v_load(VC + T * 4096, tid); stage_k_store<64>(kr, lds + NSA_KT + T * 64 * 144, tid); stage_v_store(vr, lds + NSA_VT + T * 64 * VTP, tid); } }
    __syncthreads();
    {
        if (active) {
            float m = -1e30f, lsum = 0.f;
            for (int T = 0; T < ntc; ++T) {
                f32x16 sc[2]; attn_scores<64>(sc, qf, lds + NSA_KT + T * 64 * 144, r, h);
                float mx = -1e30f;
#pragma unroll
                for (int kb = 0; kb < 2; ++kb)
#pragma unroll
                    for (int k = 0; k < 16; ++k) { const int n = 64 * T + 32 * kb + crow(k, h); const int d = t - 16 * n - 31; const float x = (d >= 0 && n < 127) ? sc[kb][k] + bl[d] : -1e30f; sc[kb][k] = x; mx = fmaxf(mx, x); }
                mx = fmaxf(mx, __shfl_xor(mx, 32));
                const float mnew = fmaxf(m, mx), mref = mnew <= -1e29f ? 0.f : mnew; float rs = 0.f;
#pragma unroll
                for (int kb = 0; kb < 2; ++kb)
#pragma unroll
                    for (int k = 0; k < 16; ++k) rs += __expf(sc[kb][k] - mref);
                rs += __shfl_xor(rs, 32);
                lsum = lsum * __expf(m - mref) + rs; m = mnew;
            }
            const float mref = m <= -1e29f ? 0.f : m, inv = lsum > 0.f ? 1.f / lsum : 0.f;
#pragma unroll
            for (int k = 0; k < 16; ++k) { ot[0][k] = 0.f; ot[1][k] = 0.f; }
            float carry = 0.f;
            for (int T = 0; T < ntc; ++T) {
                f32x16 sc[2]; attn_scores<64>(sc, qf, lds + NSA_KT + T * 64 * 144, r, h);
#pragma unroll
                for (int kb = 0; kb < 2; ++kb)
#pragma unroll
                    for (int k = 0; k < 16; ++k) { const int n = 64 * T + 32 * kb + crow(k, h); const int d = t - 16 * n - 31; sc[kb][k] = (d >= 0 && n < 127) ? __expf(sc[kb][k] + bl[d] - mref) * inv : 0.f; }
                float prevL = carry;
#pragma unroll
                for (int kb = 0; kb < 2; ++kb)
#pragma unroll
                    for (int g4 = 0; g4 < 4; ++g4) {
                        const float G4 = (sc[kb][4 * g4] + sc[kb][4 * g4 + 1]) + (sc[kb][4 * g4 + 2] + sc[kb][4 * g4 + 3]); const float L = sc[kb][4 * g4 + 3];
                        const float Lo = __shfl_xor(L, 32);
                        const float add = h ? Lo : prevL;
                        prevL = Lo;
                        const int idx = T * 8 + kb * 4 + g4;
                        PS[g * 2048 + tl * 32 + 2 * idx + h] = G4 + add;
                    }
                carry = prevL;
#pragma unroll
                for (int s4 = 0; s4 < 4; ++s4) {
                    const int kb = s4 >> 1, hf = (s4 & 1) * 8;
                    u32x4 pw; pw.x = pk_bf16(sc[kb][hf + 0], sc[kb][hf + 1]); pw.y = pk_bf16(sc[kb][hf + 2], sc[kb][hf + 3]); pw.z = pk_bf16(sc[kb][hf + 4], sc[kb][hf + 5]); pw.w = pk_bf16(sc[kb][hf + 6], sc[kb][hf + 7]);
                    const bf16x8 pf = __builtin_bit_cast(bf16x8, pw);
#pragma unroll
                    for (int eb = 0; eb < 2; ++eb) {
                        const LAS unsigned char* vp = lds + NSA_VT + T * 64 * VTP + (32 * eb + r) * VTP + (16 * s4 + 4 * h) * 2;
                        const u32x2 v0 = *(const LAS u32x2*)vp, v1 = *(const LAS u32x2*)(vp + 16);
                        u32x4 vw; vw.x = v0.x; vw.y = v0.y; vw.z = v1.x; vw.w = v1.y;
                        ot[eb] = MFMA32(__builtin_bit_cast(bf16x8, vw), pf, ot[eb]);
                    }
                }
            }
#pragma unroll
            for (int k = 0; k < 16; ++k) { ot[0][k] *= gc; ot[1][k] *= gc; }
        } else {
#pragma unroll
            for (int k = 0; k < 16; ++k) { ot[0][k] = 0.f; ot[1][k] = 0.f; }
        }
    }
    __syncthreads();
#ifndef NO_NSA_SEL
    {
        const int tk = tid >> 3, sg = tid & 7; float v[32];
#pragma unroll
        for (int k = 0; k < 8; ++k) { const f32x4 x0 = *(const LAS f32x4*)(PS + tk * 32 + 4 * k), x1 = *(const LAS f32x4*)(PS + 2048 + tk * 32 + 4 * k), x2 = *(const LAS f32x4*)(PS + 4096 + tk * 32 + 4 * k);
            v[4 * k] = (x0.x + x1.x) + x2.x; v[4 * k + 1] = (x0.y + x1.y) + x2.y; v[4 * k + 2] = (x0.z + x1.z) + x2.z; v[4 * k + 3] = (x0.w + x1.w) + x2.w; }
#pragma unroll
        for (int s = 0; s < 32; ++s) { const bool forced = (s == 0) || (s == i) || (s == i - 1); float x = forced ? v[s] + 1e4f : v[s]; v[s] = s > i ? -1.f : x; }
        unsigned bits = 0u;
#pragma unroll
        for (int k = 0; k < 4; ++k) {
            float x = 0.f;
#pragma unroll
            for (int s = 0; s < 32; ++s) x = (s == 4 * sg + k) ? v[s] : x;
            int rank = 0;
#pragma unroll
            for (int s = 0; s < 32; ++s) rank += (v[s] > x || (v[s] == x && s < 4 * sg + k)) ? 1 : 0;
            if (rank < 16 && x >= 0.f) bits |= 1u << (4 * sg + k);
        }
        bits |= __shfl_xor(bits, 1); bits |= __shfl_xor(bits, 2); bits |= __shfl_xor(bits, 4);
        if (sg == 0) { SEL[tk] = bits; __hip_atomic_fetch_or(UNI, bits, __ATOMIC_RELAXED, __HIP_MEMORY_SCOPE_WORKGROUP); __hip_atomic_fetch_or(UNI + 1 + (tk >> 5), bits, __ATOMIC_RELAXED, __HIP_MEMORY_SCOPE_WORKGROUP); }
    }
#endif
    __syncthreads();
    const unsigned selbits = SEL[tl], uni = UNI[0], unih = UNI[1 + th];
    const float c31 = bl[2047];
#ifndef NO_NSA_SLC
    {
        AttnState A; attn_reset(A);
        const bf16_t* KS = (const bf16_t*)(ws + WS_PRJ + PRJ_KN1) + kvslab; const bf16_t* VS = (const bf16_t*)(ws + WS_PRJ + PRJ_VN1) + kvslab;
        unsigned todo = uni; int cur = 0;
        int s = __ffs(todo) - 1; todo &= todo - 1;
        stage_k_load<64>(kr, KS + (size_t)s * 4096, tid); vr = stage_v_load(VS + (size_t)s * 4096, tid);
        stage_k_store<64>(kr, lds + NSA_KT, tid); stage_v_store(vr, lds + NSA_VT, tid);
        __syncthreads();
        while (s >= 0) {
            const int sn = todo ? __ffs(todo) - 1 : -1; todo &= todo - 1;
            if (sn >= 0) { stage_k_load<64>(kr, KS + (size_t)sn * 4096, tid); vr = stage_v_load(VS + (size_t)sn * 4096, tid); }
            if (active && ((unih >> s) & 1u)) {
                f32x16 sc[2];
                attn_scores<64>(sc, qf, lds + NSA_KT + cur * 64 * 144, r, h);
                const bool sel = (selbits >> s) & 1u;
                if (i - s >= 3) {
#pragma unroll
                    for (int kb = 0; kb < 2; ++kb)
#pragma unroll
                        for (int k = 0; k < 16; ++k) sc[kb][k] = sel ? sc[kb][k] + c31 : -1e30f;
                } else nsa_mask_bias(sc, t - 64 * s, h, bl, sel, 4096);
                attn_softmax_pv(A, sc, lds + NSA_VT + cur * 64 * VTP, r, h);
            }
            if (sn >= 0) { stage_k_store<64>(kr, lds + NSA_KT + (cur ^ 1) * 64 * 144, tid); stage_v_store(vr, lds + NSA_VT + (cur ^ 1) * 64 * VTP, tid); }
            __syncthreads();
            s = sn; cur ^= 1;
        }
        const float inv = A.l > 0.f ? gs / A.l : 0.f;
#pragma unroll
        for (int k = 0; k < 16; ++k) { ot[0][k] += A.o[0][k] * inv; ot[1][k] += A.o[1][k] * inv; }
    }
#endif
#ifndef NO_NSA_WIN
    {
        AttnState A; attn_reset(A);
        const bf16_t* KW = (const bf16_t*)(ws + WS_PRJ + PRJ_KN2) + kvslab; const bf16_t* VW = (const bf16_t*)(ws + WS_PRJ + PRJ_VN2) + kvslab;
        const int j0 = i > 8 ? i - 8 : 0; int cur = 0;
        stage_k_load<64>(kr, KW + (size_t)j0 * 4096, tid); vr = stage_v_load(VW + (size_t)j0 * 4096, tid);
        stage_k_store<64>(kr, lds + NSA_KT, tid); stage_v_store(vr, lds + NSA_VT, tid);
        __syncthreads();
        for (int j = j0; j <= i; ++j) {
            if (j < i) { stage_k_load<64>(kr, KW + (size_t)(j + 1) * 4096, tid); vr = stage_v_load(VW + (size_t)(j + 1) * 4096, tid); }
            if (active) {
                f32x16 sc[2];
                attn_scores<64>(sc, qf, lds + NSA_KT + cur * 64 * 144, r, h);
                if (i - j >= 3 && j > i - 8) {
#pragma unroll
                    for (int kb = 0; kb < 2; ++kb)
#pragma unroll
                        for (int k = 0; k < 16; ++k) sc[kb][k] += c31;
                } else nsa_mask_bias(sc, t - 64 * j, h, bl, true, 512);
                attn_softmax_pv(A, sc, lds + NSA_VT + cur * 64 * VTP, r, h);
            }
            if (j < i) { stage_k_store<64>(kr, lds + NSA_KT + (cur ^ 1) * 64 * 144, tid); stage_v_store(vr, lds + NSA_VT + (cur ^ 1) * 64 * VTP, tid); }
            __syncthreads();
            cur ^= 1;
        }
        const float inv = A.l > 0.f ? gw / A.l : 0.f;
#pragma unroll
        for (int k = 0; k < 16; ++k) { ot[0][k] += A.o[0][k] * inv; ot[1][k] += A.o[1][k] * inv; }
    }
#endif
    if (active) {
        float ss = 0.f; bf16_t* Y = (bf16_t*)(ws + WS_Y) + row * 1024 + head * 64;
#pragma unroll
        for (int eb = 0; eb < 2; ++eb)
#pragma unroll
            for (int g4 = 0; g4 < 4; ++g4) {
                u32x2 pw; pw.x = pk_bf16(ot[eb][4 * g4], ot[eb][4 * g4 + 1]); pw.y = pk_bf16(ot[eb][4 * g4 + 2], ot[eb][4 * g4 + 3]);
                const float f0 = bf_lo(pw.x), f1 = bf_hi(pw.x), f2 = bf_lo(pw.y), f3 = bf_hi(pw.y); ss += (f0 * f0 + f1 * f1) + (f2 * f2 + f3 * f3);
                *(u32x2*)(Y + 32 * eb + 8 * g4 + 4 * h) = pw;
            }
        ss += __shfl_xor(ss, 32);
        if (h == 0) ((float*)(ws + WS_SSQ + PT_A))[((size_t)l * 16384 + row) * 8 + head] = ss;
    }
}

__device__ __forceinline__ void ml_out_wave(int cu, int l, InPtr in, unsigned char* ws, LAS unsigned char* wl, LAS unsigned char* npl, int lane) {
    const int c = cu & 31, bh = cu >> 5, hd = bh & 3, b = bh >> 2; const int t0 = c * 64; const int r = lane & 15, q = lane >> 4;
    const bf16_t* QC = (const bf16_t*)(ws + WS_ML) + ((size_t)bh * 2048 + t0) * 64; const bf16_t* KC = (const bf16_t*)(ws + WS_ML + ML_KC) + ((size_t)bh * 2048 + t0) * 64;
    const bf16_t* V = (const bf16_t*)(ws + WS_PRJ + PRJ_VML) + ((size_t)bh * 2048 + t0) * 64;
    const float* mlg = (const float*)(ws + WS_ML + ML_G) + ((size_t)bh * 2048 + t0) * 2;
    {
        float cp[64];
#pragma unroll
        for (int k = 0; k < 64; ++k) cp[k] = 0.f;
        float np = 0.f, suffix = 0.f;
        const bf16_t* DL = (const bf16_t*)(ws + WS_ML + ML_DELTA) + (size_t)bh * 32 * 4096 + lane * 64; const float* DN = (const float*)(ws + WS_ML + ML_DN) + (size_t)bh * 32 * 64 + lane; const float* BL = (const float*)(ws + WS_ML + ML_BL) + bh * 32;
        for (int cc = c - 1; cc >= 0; --cc) {
            const float coef = __expf(suffix);
#pragma unroll
            for (int k = 0; k < 8; ++k) { const u32x4 x = *(const u32x4*)(DL + (size_t)cc * 4096 + 8 * k);
                cp[8 * k] += coef * bf_lo(x.x); cp[8 * k + 1] += coef * bf_hi(x.x); cp[8 * k + 2] += coef * bf_lo(x.y); cp[8 * k + 3] += coef * bf_hi(x.y);
                cp[8 * k + 4] += coef * bf_lo(x.z); cp[8 * k + 5] += coef * bf_hi(x.z); cp[8 * k + 6] += coef * bf_lo(x.w); cp[8 * k + 7] += coef * bf_hi(x.w); }
            np += coef * DN[(size_t)cc * 64];
            suffix += BL[cc];
        }
#pragma unroll
        for (int k = 0; k < 8; ++k) { u32x4 pk; pk.x = pk_bf16(cp[8 * k], cp[8 * k + 1]); pk.y = pk_bf16(cp[8 * k + 2], cp[8 * k + 3]); pk.z = pk_bf16(cp[8 * k + 4], cp[8 * k + 5]); pk.w = pk_bf16(cp[8 * k + 6], cp[8 * k + 7]);
            *(LAS u32x4*)(wl + swz_off(lane, k)) = pk; }
        ((LAS bf16_t*)npl)[lane] = f2bf(np);
    }
    LDS_FENCE();
    bf16x8 aq[4][2];
#pragma unroll
    for (int mb = 0; mb < 4; ++mb)
#pragma unroll
        for (int ks = 0; ks < 2; ++ks) aq[mb][ks] = *(const bf16x8*)(QC + (size_t)(16 * mb + r) * 64 + 32 * ks + 8 * q);
    float bj[4][4], den[4][4];
#pragma unroll
    for (int mb = 0; mb < 4; ++mb)
#pragma unroll
        for (int j = 0; j < 4; ++j) bj[mb][j] = mlg[(16 * mb + 4 * q + j) * 2];
    {
        float cs[4];
#pragma unroll
        for (int nb = 0; nb < 4; ++nb) { const float2 gg = *(const float2*)(mlg + (16 * nb + r) * 2); cs[nb] = gg.y - gg.x; }
#pragma unroll
        for (int mb = 0; mb < 4; ++mb) {
            f32x4 accS[4];
#pragma unroll
            for (int nb = 0; nb < 4; ++nb) { accS[nb] = (f32x4){0.f, 0.f, 0.f, 0.f};
#pragma unroll
                for (int ks = 0; ks < 2; ++ks) { const bf16x8 bk = *(const bf16x8*)(KC + (size_t)(16 * nb + r) * 64 + 32 * ks + 8 * q); accS[nb] = MFMA16(aq[mb][ks], bk, accS[nb]); } }
#pragma unroll
            for (int j = 0; j < 4; ++j) {
                const int jj = 16 * mb + 4 * q + j; float rs = 0.f;
#pragma unroll
                for (int nb = 0; nb < 4; ++nb) { const int s = 16 * nb + r; const float p = s <= jj ? accS[nb][j] * __expf(bj[mb][j] + cs[nb]) : 0.f; rs += p;
                    *(LAS bf16_t*)(wl + 8192 + swz_off(jj, s >> 3) + (s & 7) * 2) = f2bf(p); }
                rs += __shfl_xor(rs, 1); rs += __shfl_xor(rs, 2); rs += __shfl_xor(rs, 4); rs += __shfl_xor(rs, 8);
                den[mb][j] = rs;
            }
        }
    }
#pragma unroll
    for (int mb = 0; mb < 4; ++mb) { const float e = __expf(mlg[(16 * mb + r) * 2]);
#pragma unroll
        for (int ks = 0; ks < 2; ++ks) { const u32x4 x = __builtin_bit_cast(u32x4, aq[mb][ks]); u32x4 y;
            y.x = pk_bf16(bf_lo(x.x) * e, bf_hi(x.x) * e); y.y = pk_bf16(bf_lo(x.y) * e, bf_hi(x.y) * e); y.z = pk_bf16(bf_lo(x.z) * e, bf_hi(x.z) * e); y.w = pk_bf16(bf_lo(x.w) * e, bf_hi(x.w) * e);
            aq[mb][ks] = __builtin_bit_cast(bf16x8, y); } }
    f32x4 acc[4][4], accn[4];
#pragma unroll
    for (int mb = 0; mb < 4; ++mb) { accn[mb] = (f32x4){0.f, 0.f, 0.f, 0.f};
#pragma unroll
        for (int nb = 0; nb < 4; ++nb) acc[mb][nb] = (f32x4){0.f, 0.f, 0.f, 0.f}; }
#pragma unroll
    for (int ks = 0; ks < 2; ++ks) {
        u32x4 nz = *(const LAS u32x4*)(npl + (32 * ks + 8 * q) * 2); if (r != 0) nz = (u32x4){0u, 0u, 0u, 0u};
        const bf16x8 bn = __builtin_bit_cast(bf16x8, nz);
#pragma unroll
        for (int nb = 0; nb < 4; ++nb) { const bf16x8 bb = *(const LAS bf16x8*)(wl + swz_off(16 * nb + r, 4 * ks + q));
#pragma unroll
            for (int mb = 0; mb < 4; ++mb) acc[mb][nb] = MFMA16(aq[mb][ks], bb, acc[mb][nb]); }
#pragma unroll
        for (int mb = 0; mb < 4; ++mb) accn[mb] = MFMA16(aq[mb][ks], bn, accn[mb]);
    }
    LDS_FENCE();
#pragma unroll
    for (int s8 = 0; s8 < 8; ++s8) { float vb[8];
#pragma unroll
        for (int j = 0; j < 8; ++j) vb[j] = bf2f(V[(size_t)(s8 * 8 + j) * 64 + lane]);
        u32x4 pk; pk.x = pk_bf16(vb[0], vb[1]); pk.y = pk_bf16(vb[2], vb[3]); pk.z = pk_bf16(vb[4], vb[5]); pk.w = pk_bf16(vb[6], vb[7]);
        *(LAS u32x4*)(wl + swz_off(lane, s8)) = pk; }
    LDS_FENCE();
#pragma unroll
    for (int ks = 0; ks < 2; ++ks) {
        bf16x8 ap[4];
#pragma unroll
        for (int mb = 0; mb < 4; ++mb) ap[mb] = *(const LAS bf16x8*)(wl + 8192 + swz_off(16 * mb + r, 4 * ks + q));
#pragma unroll
        for (int nb = 0; nb < 4; ++nb) { const bf16x8 bv = *(const LAS bf16x8*)(wl + swz_off(16 * nb + r, 4 * ks + q));
#pragma unroll
            for (int mb = 0; mb < 4; ++mb) acc[mb][nb] = MFMA16(ap[mb], bv, acc[mb][nb]); }
    }
    LDS_FENCE();
    const float* gain = in->p[14] + l * 256 + hd * 64; const bf16_t* OG = (const bf16_t*)(ws + WS_PRJ + PRJ_OG);
    bf16_t* Y = (bf16_t*)(ws + WS_Y);
#pragma unroll
    for (int mb = 0; mb < 4; ++mb)
#pragma unroll
        for (int j = 0; j < 4; ++j) {
            const int jj = 16 * mb + 4 * q + j;
            const float dn = den[mb][j] + __shfl(accn[mb][j], lane & 48);
            const float inv = 1.f / fmaxf(fabsf(dn), 1.f); float hv[4]; float ss = 0.f;
#pragma unroll
            for (int nb = 0; nb < 4; ++nb) { hv[nb] = acc[mb][nb][j] * inv; ss += hv[nb] * hv[nb]; }
            ss += __shfl_xor(ss, 1); ss += __shfl_xor(ss, 2); ss += __shfl_xor(ss, 4); ss += __shfl_xor(ss, 8);
            const float rstd = rsqrtf(ss * (1.f / 64.f) + 1e-6f); const size_t row = (size_t)b * 2048 + t0 + jj;
#pragma unroll
            for (int nb = 0; nb < 4; ++nb) { const int e = 16 * nb + r; Y[row * 1024 + 384 + hd * 64 + e] = f2bf(hv[nb] * rstd * gain[e] * sigmf(bf2f(OG[row * 256 + hd * 64 + e]))); }
        }
}

#ifdef NO_MLA
#define MLA_CALL(...) do {} while (0)
#else
#define MLA_CALL(...) mla_unit(__VA_ARGS__)
#endif
__device__ __forceinline__ void phase_mix(int l, InPtr in, unsigned char* ws, LAS unsigned char* lds, unsigned* qhead) {
    LAS int* slot = (LAS int*)(lds + LDS_MISC + 64);
    for (;;) {
        __syncthreads();
        if (threadIdx.x == 0) *slot = (int)__hip_atomic_fetch_add(qhead, 1u, __ATOMIC_RELAXED, __HIP_MEMORY_SCOPE_AGENT);
        __syncthreads();
        int u = *slot;
        if (u >= 512 + 384 + 128) break;
#ifndef NO_NSA
        if (u < 256) { const int i = 31 - (u >> 4), bh = u & 15; nsa_unit(bh >> 1, bh & 1, i, l, in, ws, lds); continue; }
#endif
        u -= 256;
        if (u < 192) { const int qt = 7 - u / 48, bh = u % 48; MLA_CALL(bh / 6, bh % 6, qt, l, ws, lds); continue; }
        u -= 192;
#ifndef NO_NSA
        if (u < 128) { const int i = 15 - (u >> 4), bh = u & 15; nsa_unit(bh >> 1, bh & 1, i, l, in, ws, lds); continue; }
#endif
        u -= 128;
        if (u < 192) { const int qt = 3 - u / 48, bh = u % 48; MLA_CALL(bh / 6, bh % 6, qt, l, ws, lds); continue; } u -= 192;
#ifndef NO_NSA
        if (u < 128) { const int i = 7 - (u >> 4), bh = u & 15; nsa_unit(bh >> 1, bh & 1, i, l, in, ws, lds); continue; }
#endif
        u -= 128;
#ifndef NO_MLOUT
        { int tid_ = threadIdx.x; asm volatile("" : "+v"(tid_)); const int w = tid_ >> 6; ml_out_wave(u * 8 + w, l, in, ws, lds + w * 16384, lds + 131072 + w * 256, tid_ & 63); }
#endif
    }
}
__device__ __forceinline__ void phase_ynorm(int l, unsigned char* ws, int bid, int nb) {
    int tid_ = threadIdx.x; asm volatile("" : "+v"(tid_)); const int w = tid_ >> 6, lane = tid_ & 63;
    bf16_t* Y = (bf16_t*)(ws + WS_Y); const float* sa = (const float*)(ws + WS_SSQ + PT_A) + (size_t)l * 16384 * 8; const float* sc = (const float*)(ws + WS_SSQ + PT_C) + (size_t)l * 16384 * 8;
    for (int row = bid * 8 + w; row < NTOK; row += nb * 8) {
        if (lane < 48) {
            const f32x4 a0 = *(const f32x4*)(sa + (size_t)row * 8), a1 = *(const f32x4*)(sa + (size_t)row * 8 + 4), c0 = *(const f32x4*)(sc + (size_t)row * 8), c1 = *(const f32x4*)(sc + (size_t)row * 8 + 4);
            const float ra = rsqrtf((((a0.x + a0.y) + (a0.z + a0.w)) + (a1.x + a1.y)) * (1.f / 384.f) + 1e-6f), rc = rsqrtf((((c0.x + c0.y) + (c0.z + c0.w)) + (c1.x + c1.y)) * (1.f / 384.f) + 1e-6f);
            u32x4* pa = (u32x4*)(Y + (size_t)row * 1024) + lane; u32x4* pc = (u32x4*)(Y + (size_t)row * 1024 + 640) + lane;
            u32x4 x = *pa, y = *pc;
            x.x = pk_bf16(bf_lo(x.x) * ra, bf_hi(x.x) * ra); x.y = pk_bf16(bf_lo(x.y) * ra, bf_hi(x.y) * ra); x.z = pk_bf16(bf_lo(x.z) * ra, bf_hi(x.z) * ra); x.w = pk_bf16(bf_lo(x.w) * ra, bf_hi(x.w) * ra);
            y.x = pk_bf16(bf_lo(y.x) * rc, bf_hi(y.x) * rc); y.y = pk_bf16(bf_lo(y.y) * rc, bf_hi(y.y) * rc); y.z = pk_bf16(bf_lo(y.z) * rc, bf_hi(y.z) * rc); y.w = pk_bf16(bf_lo(y.w) * rc, bf_hi(y.w) * rc);
            *pa = x; *pc = y;
        }
    }
}
struct EpiOut {
    bf16_t* XB; float* ssq;
    __device__ __forceinline__ void operator()(const f32x4 (&acc)[2][2][4][2], const GUnit& u, int wr, int wc, int fr, int fq) const {
#pragma unroll
        for (int ai = 0; ai < 2; ++ai)
#pragma unroll
            for (int m = 0; m < 4; ++m) {
                __builtin_amdgcn_sched_barrier(0);
                const int row = u.pm * 256 + ai * 128 + wr * 64 + m * 16 + fr; float ss = 0.f;
#pragma unroll
                for (int bj = 0; bj < 2; ++bj) {
                    u32x4* p = (u32x4*)(XB + (size_t)row * 1024 + u.pn * 256 + bj * 128 + wc * 32 + 8 * fq); const u32x4 x = *p; u32x4 o;
                    o.x = pk_bf16(bf_lo(x.x) + acc[ai][bj][m][0][0], bf_hi(x.x) + acc[ai][bj][m][0][1]); o.y = pk_bf16(bf_lo(x.y) + acc[ai][bj][m][0][2], bf_hi(x.y) + acc[ai][bj][m][0][3]);
                    o.z = pk_bf16(bf_lo(x.z) + acc[ai][bj][m][1][0], bf_hi(x.z) + acc[ai][bj][m][1][1]); o.w = pk_bf16(bf_lo(x.w) + acc[ai][bj][m][1][2], bf_hi(x.w) + acc[ai][bj][m][1][3]);
                    *p = o;
                    ss += (bf_lo(o.x) * bf_lo(o.x) + bf_hi(o.x) * bf_hi(o.x)) + (bf_lo(o.y) * bf_lo(o.y) + bf_hi(o.y) * bf_hi(o.y)) + (bf_lo(o.z) * bf_lo(o.z) + bf_hi(o.z) * bf_hi(o.z)) + (bf_lo(o.w) * bf_lo(o.w) + bf_hi(o.w) * bf_hi(o.w));
                }
                ss = quad_sum(ss); if (fq == 0) ssq[(size_t)row * 16 + u.pn * 4 + wc] = ss;
            }
    }
};

__device__ __forceinline__ float sum16(const float* p) { const f32x4 a = *(const f32x4*)p, b = *(const f32x4*)(p + 4), c = *(const f32x4*)(p + 8), d = *(const f32x4*)(p + 12);
    return (((a.x + a.y) + (a.z + a.w)) + ((b.x + b.y) + (b.z + b.w))) + (((c.x + c.y) + (c.z + c.w)) + ((d.x + d.y) + (d.z + d.w))); }
__device__ __forceinline__ void phase_route(int l, InPtr in, unsigned char* ws, LAS unsigned char* lds, int bid, int nb) {
    int tid_ = threadIdx.x; asm volatile("" : "+v"(tid_)); const int w = tid_ >> 6, lane = tid_ & 63, r = lane & 15, q = lane >> 4;
    const bf16_t* XB = (const bf16_t*)(ws + WS_XB); const bf16_t* WR = (const bf16_t*)(ws + WS_WR) + (size_t)l * 64 * 1024;
    const float* ssq = (const float*)(ws + WS_SSQ + PT_X1) + (size_t)l * 16384 * 16; const float* bg = in->p[24] + l * 4; const float* be = in->p[26] + l * 32;
    unsigned* cnt = (unsigned*)(ws + WS_CTL) + CW_CNT + 64 * l; unsigned* mtok = (unsigned*)(ws + WS_META); float* mw = (float*)(ws + WS_META + META_W);
    LAS float* lg = (LAS float*)(lds + w * 4096);
    for (int g = bid * 8 + w; g < NTOK / 16; g += nb * 8) {
        const int tok0 = g * 16; f32x4 acc[3];
#pragma unroll
        for (int n = 0; n < 3; ++n) acc[n] = (f32x4){0.f, 0.f, 0.f, 0.f};
        const bf16_t* ap = XB + (size_t)(tok0 + r) * 1024 + 8 * q; const bf16_t* bp = WR + (size_t)r * 1024 + 8 * q;
#pragma unroll 4
        for (int ks = 0; ks < 32; ++ks) { const bf16x8 a = *(const bf16x8*)(ap + 32 * ks);
#pragma unroll
            for (int n = 0; n < 3; ++n) { const bf16x8 bb = *(const bf16x8*)(bp + (size_t)n * 16 * 1024 + 32 * ks); acc[n] = MFMA16(a, bb, acc[n]); } }
#pragma unroll
        for (int n = 0; n < 3; ++n)
#pragma unroll
            for (int j = 0; j < 4; ++j) lg[(4 * q + j) * 48 + 16 * n + r] = acc[n][j];
        LDS_FENCE();
        if (lane < 16) {
            const int tok = tok0 + lane; const float rs = rsqrtf(sum16(ssq + (size_t)tok * 16) * (1.f / 1024.f) + 1e-6f); ((float*)(ws + WS_RS2))[tok] = rs; const LAS float* L = lg + lane * 48;
            float gl[4]; int gi = 0;
#pragma unroll
            for (int j = 0; j < 4; ++j) gl[j] = L[j] * rs + bg[j];
            float gm = gl[0];
#pragma unroll
            for (int j = 1; j < 4; ++j) if (gl[j] > gm) { gm = gl[j]; gi = j; }
            float gsum = 0.f;
#pragma unroll
            for (int j = 0; j < 4; ++j) gsum += __expf(gl[j] - gm);
            const float gtop = 1.f / gsum;
            float el[8];
#pragma unroll
            for (int j = 0; j < 8; ++j) el[j] = L[4 + gi * 8 + j] * rs + be[gi * 8 + j];
            int e0 = 0; float v0 = el[0];
#pragma unroll
            for (int j = 1; j < 8; ++j) if (el[j] > v0) { v0 = el[j]; e0 = j; }
            int e1 = -1; float v1 = -3.0e38f;
#pragma unroll
            for (int j = 0; j < 8; ++j) if (j != e0 && el[j] > v1) { v1 = el[j]; e1 = j; }
            const float w0 = 1.f / (1.f + __expf(v1 - v0)); const int E0 = gi * 8 + e0, E1 = gi * 8 + e1;
            const unsigned p0 = atomicAdd(cnt + E0, 1u), p1 = atomicAdd(cnt + E1, 1u);
            mtok[(size_t)E0 * 16384 + p0] = (unsigned)tok; mw[(size_t)E0 * 16384 + p0] = w0 * gtop;
            mtok[(size_t)E1 * 16384 + p1] = (unsigned)tok | 0x80000000u; mw[(size_t)E1 * 16384 + p1] = (1.f - w0) * gtop;
        }
        LDS_FENCE();
    }
}

constexpr int LDS_TB = 131072 + 2048;
__device__ __forceinline__ void moe_tables(int l, unsigned char* ws, LAS unsigned char* lds) {
    if (threadIdx.x == 0) { const unsigned* cnt = (const unsigned*)(ws + WS_CTL) + CW_CNT + 64 * l; LAS int* tb = (LAS int*)(lds + LDS_TB); int acc = 0;
        for (int e = 0; e < 32; ++e) { tb[e] = acc; acc += ((int)__hip_atomic_load(cnt + e, __ATOMIC_RELAXED, __HIP_MEMORY_SCOPE_AGENT) + 255) >> 8; } tb[32] = acc; }
    __syncthreads();
}
template <int NPN, bool GATHER_>
struct MoeSched {
    static constexpr bool GATHER = GATHER_;
    const char* A; const char* Bt; const unsigned* cnt; const unsigned* mtok; const LAS int* tb; int G, c; size_t bstride_e  , bstride_pn;
    __device__ __forceinline__ bool next(int i, GUnit& u) const {
        const int L = i * G + c; const int ntile = tb[32]; if (L >= ntile * NPN) return false;
        const int tile = L / NPN, pn = L % NPN; int e = 0;
        for (int k = 1; k < 32; ++k) e = (tb[k] <= tile) ? k : e;
        e = __builtin_amdgcn_readfirstlane(e);
        u.e = e; u.pm = tile; u.pn = pn; u.rows = (int)__hip_atomic_load(cnt + e, __ATOMIC_RELAXED, __HIP_MEMORY_SCOPE_AGENT) - 256 * (tile - tb[e]);
        u.a = GATHER ? A : A + (size_t)tile * 256 * 256 * 2;
        u.b = Bt + (size_t)e * bstride_e + (size_t)pn * bstride_pn; return true;
    }
    __device__ __forceinline__ void aoff(const GUnit& u, unsigned (&v)[2][2], const int (&R)[2], const int (&C)[2]) const {
#pragma unroll
        for (int h = 0; h < 2; ++h)
#pragma unroll
            for (int i = 0; i < 2; ++i) {
                if (GATHER) { const int lr = h * 128 + R[i]; const int rr = 256 * (u.pm - tb[u.e]) + (lr < u.rows ? lr : 0); const unsigned tok = mtok[(size_t)u.e * 16384 + rr] & 0x7fffffffu; v[h][i] = (tok * 1024u + (unsigned)C[i]) * 2u; }
                else v[h][i] = (unsigned)((h * 128 + R[i]) * 256 + C[i]) * 2u;
            }
    }
};
struct EpiMoeUp {
    const unsigned* mtok; const float* ssq; const LAS int* tb; bf16_t* HB;
    __device__ __forceinline__ void operator()(const f32x4 (&acc)[2][2][4][2], const GUnit& u, int wr, int wc, int fr, int fq) const {
        const int r0 = 256 * (u.pm - tb[u.e]);
#pragma unroll
        for (int ai = 0; ai < 2; ++ai)
#pragma unroll
            for (int m = 0; m < 4; ++m) {
                __builtin_amdgcn_sched_barrier(0);
                const int lr = ai * 128 + wr * 64 + m * 16 + fr;
                if (lr < u.rows) {
                    const unsigned tok = mtok[(size_t)u.e * 16384 + r0 + lr] & 0x7fffffffu; const float rs = ssq[tok];
                    float hv[8];
#pragma unroll
                    for (int n = 0; n < 2; ++n)
#pragma unroll
                        for (int j = 0; j < 4; ++j) { const float gv = acc[ai][0][m][n][j] * rs, uv = acc[ai][1][m][n][j] * rs; hv[4 * n + j] = siluf(gv) * uv; }
                    st_bf16x8(HB + ((size_t)u.pm * 256 + lr) * 256 + u.pn * 128 + wc * 32 + 8 * fq, hv);
                }
            }
    }
};
struct EpiMoeDown {
    const unsigned* mtok; const float* mw; const LAS int* tb; bf16_t* YB;
    __device__ __forceinline__ void operator()(const f32x4 (&acc)[2][2][4][2], const GUnit& u, int wr, int wc, int fr, int fq) const {
        const int r0 = 256 * (u.pm - tb[u.e]);
#pragma unroll
        for (int ai = 0; ai < 2; ++ai)
#pragma unroll
            for (int m = 0; m < 4; ++m) {
                __builtin_amdgcn_sched_barrier(0);
                const int lr = ai * 128 + wr * 64 + m * 16 + fr;
                if (lr < u.rows) {
                    const unsigned mt = mtok[(size_t)u.e * 16384 + r0 + lr]; const float wt = mw[(size_t)u.e * 16384 + r0 + lr];
                    bf16_t* dst = YB + ((size_t)(mt >> 31) * 16384 + (mt & 0x7fffffffu)) * 1024 + u.pn * 256 + wc * 32 + 8 * fq;
#pragma unroll
                    for (int bj = 0; bj < 2; ++bj) { float v[8];
#pragma unroll
                        for (int n = 0; n < 2; ++n)
#pragma unroll
                            for (int j = 0; j < 4; ++j) v[4 * n + j] = acc[ai][bj][m][n][j] * wt;
                        st_bf16x8(dst + bj * 128, v); }
                }
            }
    }
};
__device__ __forceinline__ void phase_combine(int l, unsigned char* ws, float* out, int bid, int nb) {
    int tid_ = threadIdx.x; asm volatile("" : "+v"(tid_)); const int w = tid_ >> 6, lane = tid_ & 63;
    bf16_t* XB = (bf16_t*)(ws + WS_XB); const bf16_t* Y0 = (const bf16_t*)(ws + WS_YBUF); const bf16_t* Y1 = Y0 + (size_t)16384 * 1024; float* ssqx = (float*)(ws + WS_SSQX) + 16384;
    for (int row = bid * 8 + w; row < NTOK; row += nb * 8) {
        float ss = 0.f;
#pragma unroll
        for (int k = 0; k < 2; ++k) {
            const size_t o = (size_t)row * 1024 + (lane + 64 * k) * 8;
            const u32x4 x = *(const u32x4*)(XB + o), a = *(const u32x4*)(Y0 + o), c = *(const u32x4*)(Y1 + o);
            float v[8] = { bf_lo(x.x) + bf_lo(a.x) + bf_lo(c.x), bf_hi(x.x) + bf_hi(a.x) + bf_hi(c.x), bf_lo(x.y) + bf_lo(a.y) + bf_lo(c.y), bf_hi(x.y) + bf_hi(a.y) + bf_hi(c.y),
                           bf_lo(x.z) + bf_lo(a.z) + bf_lo(c.z), bf_hi(x.z) + bf_hi(a.z) + bf_hi(c.z), bf_lo(x.w) + bf_lo(a.w) + bf_lo(c.w), bf_hi(x.w) + bf_hi(a.w) + bf_hi(c.w) };
            if (l == L_ - 1 && out) { *(f32x4*)(out + o) = (f32x4){v[0], v[1], v[2], v[3]}; *(f32x4*)(out + o + 4) = (f32x4){v[4], v[5], v[6], v[7]}; }
            else { u32x4 p; p.x = pk_bf16(v[0], v[1]); p.y = pk_bf16(v[2], v[3]); p.z = pk_bf16(v[4], v[5]); p.w = pk_bf16(v[6], v[7]); *(u32x4*)(XB + o) = p;
#pragma unroll
                   for (int j = 0; j < 4; ++j) { const unsigned q = j == 0 ? p.x : (j == 1 ? p.y : (j == 2 ? p.z : p.w)); ss += bf_lo(q) * bf_lo(q) + bf_hi(q) * bf_hi(q); } }
        }
        if (l < L_ - 1) { ss = wave_sum(ss); if (lane == 0) ssqx[row] = ss; }
    }
}
constexpr int NPH = 9;
enum { PH_INPROJ = 0, PH_PREP, PH_MIX, PH_YNORM, PH_OUTPROJ, PH_ROUTE, PH_MOEUP, PH_MOEDOWN, PH_COMBINE };
struct Args { Inputs in; float* out; unsigned char* ws; int ph_lo, ph_hi; };

__global__ void __launch_bounds__(512, 2) mk(Args args) {
    extern __shared__ __attribute__((aligned(16))) unsigned char lds_raw[];
    LAS unsigned char* lds = (LAS unsigned char*)lds_raw;
    const int tid = threadIdx.x, bid0 = blockIdx.x, nb = gridDim.x;
#define BID() ({ int b_ = bid0; asm volatile("" : "+s"(b_)); b_; })
    unsigned char* ws = args.ws; unsigned* ctl = (unsigned*)(ws + WS_CTL);
    const int lo = args.ph_lo, hi = args.ph_hi;
    if (tid < 4) ((LAS unsigned*)(lds + LDS_MISC))[tid] = 0u;
    __syncthreads();
    XcdBarrier bar; bar.bar = ctl + CW_BAR; bar.x = 0; bar.st = nullptr;
    if (hi - lo > 1) bar = xcd_barrier_post(ctl + CW_BAR, (volatile LAS unsigned*)(lds + LDS_MISC));
#define IN(k) (lo <= (k) && (k) < hi)
#define SEAM(k) do { if (IN(k) && IN((k) + 1)) xcd_barrier(bar); } while (0)
#ifndef NO_PRO
    if (IN(0)) prologue(in_tab(), launder(ws), lds, BID(), nb);
#endif
    SEAM(0);
    for (int l = 0; l < L_; ++l) {
        const int pb = 1 + l * NPH;
        if (IN(pb + PH_INPROJ)) {
            InPtr in = in_tab(); unsigned char* ws = launder(args.ws);
            g8::DenseSched S{(const char*)(ws + WS_XB), (const char*)(ws + WS_WIN) + (size_t)l * 2560 * 1024 * 2, 1024, 1024, 64, 10, nb, BID()};
            EpiInProj E{(const float*)(ws + WS_SSQX) + l * 16384, (float*)(ws + WS_SSQ + PT_DQ) + (size_t)l * 16384 * 4, (float*)(ws + WS_SSQ + PT_DKV) + (size_t)l * 16384 * 2,
                        in->p[8] + l * 64, in->p[9] + l * 64, in->p[19] + l * 192 + 96 + 64, (const float*)(ws + WS_ROPE), ws + WS_PRJ};
#ifndef NO_INPROJ
            g8::gemm_run(lds, 1024, 1024, S, E);
#endif
        }
        SEAM(pb + PH_INPROJ);
        if (IN(pb + PH_PREP)) phase_prep(l, in_tab(), launder(ws), lds, BID(), nb);
        SEAM(pb + PH_PREP);
        if (IN(pb + PH_MIX)) phase_mix(l, in_tab(), launder(ws), lds, (unsigned*)launder(ws) + CW_Q + 64 * l);
        SEAM(pb + PH_MIX);
        if (IN(pb + PH_YNORM)) phase_ynorm(l, launder(ws), BID(), nb);
        SEAM(pb + PH_YNORM);
        if (IN(pb + PH_OUTPROJ)) {
            unsigned char* ws = launder(args.ws);
            g8::DenseSched S{(const char*)(ws + WS_Y), (const char*)(ws + WS_WOUT) + (size_t)l * 1024 * 1024 * 2, 1024, 1024, 64, 4, nb, BID()};
            EpiOut E{(bf16_t*)(ws + WS_XB), (float*)(ws + WS_SSQ + PT_X1) + (size_t)l * 16384 * 16};
#ifndef NO_OUTPROJ
            g8::gemm_run(lds, 1024, 1024, S, E);
#endif
        }
        SEAM(pb + PH_OUTPROJ);
#ifndef NO_ROUTE
        if (IN(pb + PH_ROUTE)) phase_route(l, in_tab(), launder(ws), lds, BID(), nb);
#endif
        SEAM(pb + PH_ROUTE);
        if (IN(pb + PH_MOEUP)) {
            unsigned char* ws = launder(args.ws); moe_tables(l, ws, lds);
            const unsigned* cnt = (const unsigned*)(ws + WS_CTL) + CW_CNT + 64 * l; const unsigned* mtok = (const unsigned*)(ws + WS_META); const LAS int* tb = (const LAS int*)(lds + LDS_TB);
            MoeSched<2, true> S{(const char*)(ws + WS_XB), (const char*)(ws + WS_WMOE), cnt, mtok, tb, nb, BID(), (size_t)512 * 1024 * 2, (size_t)256 * 1024 * 2};
            EpiMoeUp E{mtok, (const float*)(ws + WS_RS2), tb, (bf16_t*)(ws + WS_HBUF)};
#ifndef NO_MOEUP
            g8::gemm_run(lds, 1024, 1024, S, E);
#endif
        }
        SEAM(pb + PH_MOEUP);
        if (IN(pb + PH_MOEDOWN)) {
            unsigned char* ws = launder(args.ws); moe_tables(l, ws, lds);
            const unsigned* cnt = (const unsigned*)(ws + WS_CTL) + CW_CNT + 64 * l; const unsigned* mtok = (const unsigned*)(ws + WS_META); const LAS int* tb = (const LAS int*)(lds + LDS_TB);
            MoeSched<4, false> S{(const char*)(ws + WS_HBUF), (const char*)(ws + WS_WMOE + WMOE_WD), cnt, mtok, tb, nb, BID(), (size_t)1024 * 256 * 2, (size_t)256 * 256 * 2};
            EpiMoeDown E{mtok, (const float*)(ws + WS_META + META_W), tb, (bf16_t*)(ws + WS_YBUF)};
#ifndef NO_MOEDOWN
            g8::gemm_run(lds, 256, 256, S, E);
#endif
        }
        SEAM(pb + PH_MOEDOWN);
#ifndef NO_COMBINE
        if (IN(pb + PH_COMBINE)) { unsigned char* ws = launder(args.ws); phase_combine(l, ws, args.out, BID(), nb); if (l + 1 < L_) cvt_moe_layer(in_tab(), ws, l + 1, (LAS float*)lds, BID(), nb, threadIdx.x); }
#endif
        SEAM(pb + PH_COMBINE);
    }
#undef IN
#undef SEAM
}
#if CHECK
struct NvScratch { float *proj, *h1, *qk, *hraw, *kn, *kcmp, *vcmp, *dqn, *q, *dkvn, *kv, *krope, *y, *x1, *xl; int* rt_e; float* rt_w; };
constexpr int CB = 5;
enum { NS_INPROJ = 0, NS_NSAPREP, NS_MLAPREP, NS_NSA, NS_ML, NS_MLA, NS_OUT, NS_ROUTE, NS_MOE };
static void naive_step(void* const* d_in, int l, int step, const float* xin, float* xout, const NvScratch& S, hipStream_t st) {
    const int b = CB;
    const float* rel_bias = (const float*)d_in[2];
    const float* norm1_g = (const float*)d_in[3] + (long)l * 1024;
    const float* w_in = (const float*)d_in[4] + (long)l * 1024 * DIN;
    const float* cmp_pe = (const float*)d_in[5] + (long)l * 2 * 32 * 64;
    const float* cmp_w1 = (const float*)d_in[6] + (long)l * 2 * 32 * 64 * 64;
    const float* cmp_w2 = (const float*)d_in[7] + (long)l * 2 * 64 * 64;
    const float* q_norm = (const float*)d_in[8] + l * 64;
    const float* k_norm = (const float*)d_in[9] + l * 64;
    const float* nsa_on = (const float*)d_in[10] + l * 384;
    const float* conv = (const float*)d_in[11] + l * 4 * 512;
    const float* ibias = (const float*)d_in[12] + l * 4;
    const float* fbias = (const float*)d_in[13] + l * 4;
    const float* ml_on = (const float*)d_in[14] + l * 256;
    const float* qan = (const float*)d_in[15] + l * 192;
    const float* w_uq = (const float*)d_in[16] + (long)l * 192 * 576;
    const float* kvan = (const float*)d_in[17] + l * 128;
    const float* w_ukv = (const float*)d_in[18] + (long)l * 128 * 768;
    const float* qkn = (const float*)d_in[19] + l * 192;
    const float* mla_on = (const float*)d_in[20] + l * 384;
    const float* w_out = (const float*)d_in[21] + (long)l * 1024 * 1024;
    const float* norm2_g = (const float*)d_in[22] + l * 1024;
    const float* wgrp = (const float*)d_in[23] + (long)l * 1024 * 4;
    const float* bgrp = (const float*)d_in[24] + l * 4;
    const float* wexp = (const float*)d_in[25] + (long)l * 1024 * 32;
    const float* bexp = (const float*)d_in[26] + l * 32;
    const float* Wg = (const float*)d_in[27] + (long)l * 32 * 1024 * 256;
    const float* Wu = (const float*)d_in[28] + (long)l * 32 * 1024 * 256;
    const float* Wd = (const float*)d_in[29] + (long)l * 32 * 256 * 1024;
    const int* pos = (const int*)d_in[1] + b * 2048;
    switch (step) {
    case NS_INPROJ:
        nv_rmsnorm<<<dim3(2048, 1), 64, 0, st>>>(xin, 1024, 0, S.h1, 1024, 0, norm1_g, 0, 1024);
        nv_gemm<<<dim3((DIN + 63) / 64, 2048 / 64), 256, 0, st>>>(S.h1, 1024, w_in, DIN, S.proj, DIN, nullptr, 0, 2048, DIN, 1024);
        break;
    case NS_NSAPREP:
        nv_nsa_cmp<<<dim3(127, 2, 2), 64, 0, st>>>(S.proj, cmp_pe, cmp_w1, cmp_w2, k_norm, S.kcmp, S.vcmp);
        nv_nsa_knorm<<<dim3(2048, 4), 64, 0, st>>>(S.proj, k_norm, S.kn);
        break;
    case NS_MLAPREP:
        nv_rmsnorm<<<dim3(2048, 1), 64, 0, st>>>(S.proj + O_CDQ, DIN, 0, S.dqn, 192, 0, qan, 0, 192);
        nv_gemm<<<dim3(576 / 64, 2048 / 64), 256, 0, st>>>(S.dqn, 192, w_uq, 576, S.q, 576, nullptr, 0, 2048, 576, 192);
        nv_rmsnorm<<<dim3(2048, 1), 64, 0, st>>>(S.proj + O_CDKV, DIN, 0, S.dkvn, 128, 0, kvan, 0, 128);
        nv_gemm<<<dim3(768 / 64, 2048 / 64), 256, 0, st>>>(S.dkvn, 128, w_ukv, 768, S.kv, 768, nullptr, 0, 2048, 768, 128);
        nv_mla_prep<<<dim3(2048, 7), 64, 0, st>>>(S.q, S.kv, S.proj, S.krope, qkn, pos);
        break;
    case NS_NSA:
        nv_nsa_attn<<<dim3(2048, 2), 192, 0, st>>>(S.proj, S.kn, S.kcmp, S.vcmp, rel_bias, q_norm, S.y);
        break;
    case NS_ML:
        nv_ml_conv<<<2048, 512, 0, st>>>(S.proj, conv, S.qk);
        nv_ml_rec<<<4, 256, 0, st>>>(S.proj, S.qk, ibias, fbias, S.hraw);
        nv_ml_fin<<<dim3(2048, 4), 64, 0, st>>>(S.proj, S.hraw, ml_on, S.y);
        break;
    case NS_MLA:
        nv_mla_attn<<<dim3(2048, 6), 64, 0, st>>>(S.q, S.kv, S.krope, S.y);
        break;
    case NS_OUT:
        nv_rmsnorm<<<dim3(2048, 1), 64, 0, st>>>(S.y, 1024, 0, S.y, 1024, 0, nsa_on, 0, 384);
        nv_rmsnorm<<<dim3(2048, 1), 64, 0, st>>>(S.y + 640, 1024, 0, S.y + 640, 1024, 0, mla_on, 0, 384);
        nv_gemm<<<dim3(1024 / 64, 2048 / 64), 256, 0, st>>>(S.y, 1024, w_out, 1024, S.x1, 1024, xin, 1024, 2048, 1024, 1024);
        break;
    case NS_ROUTE:
        nv_moe_route<<<2048, 64, 0, st>>>(S.x1, norm2_g, wgrp, bgrp, wexp, bexp, S.h1, S.rt_e, S.rt_w);
        break;
    case NS_MOE:
        nv_moe_exp<<<2048, 256, 0, st>>>(S.x1, S.h1, S.rt_e, S.rt_w, Wg, Wu, Wd, xout);
        break;
    }
}

__device__ __forceinline__ void chk_commit(float d2, float r2, float* acc) { d2 = wave_sum(d2); r2 = wave_sum(r2); if ((threadIdx.x & 63) == 0) { atomicAdd(acc, d2); atomicAdd(acc + 1, r2); } }
__device__ __forceinline__ void chk_add(float f, float r, float& d2, float& r2) { const float d = f - r; d2 += (d == d) ? d * d : 1e30f; r2 += r * r; }

__global__ void __launch_bounds__(64) chk_proj(const float* nproj, const unsigned char* prj, const float* ssq_dq, const float* ssq_dkv, const float* qg, const float* kg, const float* krg, const int* pos, float* acc) {
    const int t = blockIdx.x, e = threadIdx.x; const size_t row = (size_t)CB * 2048 + t; float d2 = 0.f, r2 = 0.f;
    for (int G = 0; G < 40; ++G) {
        const int c = inproj_refcol(G, e); float r = c < 0 ? 0.f : nproj[(size_t)t * DIN + c]; float f = 0.f;
        const float rr = (G == 37 && e >= 32) ? 0.f : r; const float ss = wave_sum(rr * rr);
        if (G < 6) { r = r * rsqrtf(ss / 64.f + 1e-6f) * qg[e] * 0.125f; f = bf2f(((const bf16_t*)(prj + PRJ_QN))[((size_t)(CB * 6 + G) * 2048 + t) * 64 + e]); }
        else if (G < 18) { const int a = G - 6, br = a >> 2, s = (a >> 1) & 1, hk = a & 1;
            if (br > 0 && s == 0) r = r * rsqrtf(ss / 64.f + 1e-6f) * kg[e];
            const size_t base = br == 0 ? (s ? PRJ_C0V : PRJ_C0K) : (br == 1 ? (s ? PRJ_VN1 : PRJ_KN1) : (s ? PRJ_VN2 : PRJ_KN2));
            f = bf2f(((const bf16_t*)(prj + base))[((size_t)(CB * 2 + hk) * 2048 + t) * 64 + e]); }
        else if (G < 26) f = bf2f(((const bf16_t*)(prj + PRJ_RAWQK))[row * 512 + (G - 18) * 64 + e]);
        else if (G < 30) f = bf2f(((const bf16_t*)(prj + PRJ_VML))[((size_t)(CB * 4 + (G - 26)) * 2048 + t) * 64 + e]);
        else if (G < 34) f = bf2f(((const bf16_t*)(prj + PRJ_OG))[row * 256 + (G - 30) * 64 + e]);
        else if (G < 37) f = bf2f(((const bf16_t*)(prj + PRJ_DQKV))[row * 384 + (G - 34) * 64 + e]);
        else if (G == 37) {
            const float val = e < 32 ? rr * rsqrtf(ss / 32.f + 1e-6f) * krg[e & 31] : 0.f; const float oth = __shfl_xor(val, 16);
            if (e < 32) { const int i = e & 15; const double ang = (double)pos[row] * pow(10000.0, -(double)i / 16.0); const float cs = (float)cos(ang), sn = (float)sin(ang);
                r = e < 16 ? val * cs - oth * sn : val * cs + oth * sn; f = bf2f(((const bf16_t*)(prj + PRJ_KR))[row * 32 + e]); }
            else if (e < 58) f = ((const float*)(prj + PRJ_GATES))[row * 32 + (e - 32)];
            else { f = 0.f; r = 0.f; }
        }
        else f = bf2f(((const bf16_t*)(prj + PRJ_DQKV))[row * 384 + 256 + (G - 38) * 64 + e]);
        chk_add(f, r, d2, r2);
    }
    float d2s = 0.f, r2s = 0.f;
    { float s1 = 0.f, s2 = 0.f; for (int c = e; c < 192; c += 64) { float v = nproj[(size_t)t * DIN + O_CDQ + c]; s1 += v * v; } for (int c = e; c < 128; c += 64) { float v = nproj[(size_t)t * DIN + O_CDKV + c]; s2 += v * v; }
      s1 = wave_sum(s1); s2 = wave_sum(s2); if (e == 0) { chk_add((ssq_dq[row * 4] + ssq_dq[row * 4 + 1]) + ssq_dq[row * 4 + 2], s1, d2s, r2s); chk_add(ssq_dkv[row * 2] + ssq_dkv[row * 2 + 1], s2, d2s, r2s); } }
    chk_commit(d2, r2, acc); chk_commit(d2s, r2s, acc + 2);
}

__global__ void __launch_bounds__(64) chk_prep(const float* nq, const float* nkv, const float* nkr, const float* nkc, const float* nvc, const unsigned char* ws, float* acc) {
    const int t = blockIdx.x, e = threadIdx.x; float d2 = 0.f, r2 = 0.f, d2c = 0.f, r2c = 0.f; const float scale = 0.10206207261596575f;
    const bf16_t* QM = (const bf16_t*)(ws + WS_MLA); const bf16_t* KM = (const bf16_t*)(ws + WS_MLA + MLA_KM); const bf16_t* VM = (const bf16_t*)(ws + WS_MLA + MLA_VM);
    for (int h = 0; h < 6; ++h) {
        const size_t rq = ((size_t)(CB * 6 + h) * 2048 + t);
        chk_add(bf2f(QM[rq * 96 + e]), nq[(size_t)t * 576 + h * 96 + e] * scale, d2, r2);
        chk_add(bf2f(KM[rq * 96 + e]), nkv[(size_t)t * 768 + h * 128 + e], d2, r2);
        chk_add(bf2f(VM[rq * 64 + e]), nkv[(size_t)t * 768 + h * 128 + 64 + e], d2, r2);
        if (e < 32) { chk_add(bf2f(QM[rq * 96 + 64 + e]), nq[(size_t)t * 576 + h * 96 + 64 + e] * scale, d2, r2); chk_add(bf2f(KM[rq * 96 + 64 + e]), nkr[(size_t)t * 32 + e], d2, r2); }
    }
    if (t < 128) for (int hk = 0; hk < 2; ++hk) {
        const bf16_t* KC = (const bf16_t*)(ws + WS_CMP); const bf16_t* VC = (const bf16_t*)(ws + WS_CMP + CMP_V); const size_t rf = ((size_t)(CB * 2 + hk) * 128 + t) * 64 + e;
        chk_add(bf2f(KC[rf]), t < 127 ? nkc[(size_t)(hk * 127 + t) * 64 + e] : 0.f, d2c, r2c); chk_add(bf2f(VC[rf]), t < 127 ? nvc[(size_t)(hk * 127 + t) * 64 + e] : 0.f, d2c, r2c);
    }
    chk_commit(d2, r2, acc); chk_commit(d2c, r2c, acc + 2);
}

__global__ void __launch_bounds__(64) chk_y(const float* ny, const unsigned char* ws, float* acc, int nseg) {
    const int t = blockIdx.x, e = threadIdx.x; const bf16_t* Y = (const bf16_t*)(ws + WS_Y) + ((size_t)CB * 2048 + t) * 1024;
    float d2[3] = {0.f, 0.f, 0.f}, r2[3] = {0.f, 0.f, 0.f};
    for (int c = e; c < 1024; c += 64) { const int seg = c < 384 ? 0 : (c < 640 ? 1 : 2); const float f = bf2f(Y[c]), r = ny[(size_t)t * 1024 + c];
        if (seg == 0) chk_add(f, r, d2[0], r2[0]); else if (seg == 1) chk_add(f, r, d2[1], r2[1]); else chk_add(f, r, d2[2], r2[2]); }
    if (nseg == 3) { chk_commit(d2[0], r2[0], acc); chk_commit(d2[1], r2[1], acc + 2); chk_commit(d2[2], r2[2], acc + 4); }
    else chk_commit(d2[0] + d2[1] + d2[2], r2[0] + r2[1] + r2[2], acc);
}

__global__ void __launch_bounds__(64) chk_x(const float* nx, const unsigned char* ws, float* acc) {
    const int t = blockIdx.x, e = threadIdx.x; const bf16_t* X = (const bf16_t*)(ws + WS_XB) + ((size_t)CB * 2048 + t) * 1024; float d2 = 0.f, r2 = 0.f;
    for (int c = e; c < 1024; c += 64) chk_add(bf2f(X[c]), nx[(size_t)t * 1024 + c], d2, r2);
    chk_commit(d2, r2, acc);
}

__global__ void __launch_bounds__(512) chk_code(float* acc, int nst, const float* nout) {
    __shared__ float sh[512];
    float s = 0.f; for (int i = threadIdx.x; i < 2048 * 1024; i += 512) { float v = nout[i]; s += v * v; }
    sh[threadIdx.x] = s; __syncthreads();
    if (threadIdx.x == 0) { float tot = 0.f; for (int i = 0; i < 512; ++i) tot += sh[i]; float rms = sqrtf(tot / (2048.f * 1024.f)); if (!(rms > 1e-3f && rms < 1e3f)) rms = 1.f;
        int code = 0;
        for (int st = 0; st < nst; ++st) { const float d2 = acc[2 * st], r2 = acc[2 * st + 1]; if (r2 == 0.f && d2 == 0.f) { if ((st & 15) >= 9) continue; code = (st + 1) * 4 + 3; break; } const float err = d2 / fmaxf(r2, 1e-30f);
            const float tol = CHK_TOL(st);
            if (!(err <= tol)) { const int cls = !(err < 1.f) ? 3 : (err >= 0.1f ? 2 : (err >= 0.01f ? 1 : 0)); code = (st + 1) * 4 + cls; break; } }
        acc[2 * 40] = rms * 32.f * exp2f(0.5f * (float)code); }
}
__global__ void __launch_bounds__(512) chk_fill(const float* acc, float* out) {
    const float K = acc[2 * 40];
    for (size_t i = (size_t)blockIdx.x * 512 + threadIdx.x; i < (size_t)NTOK * 1024; i += (size_t)gridDim.x * 512) out[i] = (i & 1) ? -K : K;
}
#endif

static int g_grid = 0;
static bool setup_once(size_t ws_size) {
    if (g_grid) return g_grid > 0;
    if (ws_size < WS_END) { fprintf(stderr, "kernel_launch: workspace too small: %zu < %zu\n", ws_size, (size_t)WS_END); g_grid = -1; return false; }
    int dev = 0, cus = 0, per_cu = 0;
    if (hipGetDevice(&dev) != hipSuccess || hipDeviceGetAttribute(&cus, hipDeviceAttributeMultiprocessorCount, dev) != hipSuccess) { g_grid = -1; return false; }
    if (hipFuncSetAttribute((const void*)mk, hipFuncAttributeMaxDynamicSharedMemorySize, LDS_BYTES) != hipSuccess) { fprintf(stderr, "kernel_launch: hipFuncSetAttribute failed\n"); g_grid = -1; return false; }
    if (hipOccupancyMaxActiveBlocksPerMultiprocessor(&per_cu, (const void*)mk, 512, LDS_BYTES) != hipSuccess || per_cu < 1) { fprintf(stderr, "kernel_launch: occupancy query says %d\n", per_cu); }
    (void)hipGetLastError();
    g_grid = cus;
    return true;
}
static void launch_mk(const Args& a0, int lo, int hi, hipStream_t stream) { Args a = a0; a.ph_lo = lo; a.ph_hi = hi; hipLaunchKernelGGL(mk, dim3(g_grid), dim3(512), LDS_BYTES, stream, a); }

extern "C" void kernel_launch(void* const* d_in, const int* in_sizes, int n_in, void* d_out, int out_size, void* d_ws, size_t ws_size, hipStream_t stream) {
    if (!setup_once(ws_size)) return;
    unsigned char* ws = (unsigned char*)d_ws;
    (void)hipMemsetAsync(ws + WS_CTL, 0, ZERO_BYTES, stream);
    Args a{}; for (int i = 0; i < 30; ++i) a.in.p[i] = (const float*)d_in[i];
    a.out = (float*)d_out; a.ws = ws; a.ph_lo = 0; a.ph_hi = 0;
#if CHECK
    a.out = nullptr;
#endif
#if CHECK
    float* nb = (float*)d_out; size_t off = 0; NvScratch S;
    auto take = [&](size_t n) { float* p = nb + off; off += (n + 63) & ~(size_t)63; return p; };
    S.proj = take((size_t)2048 * DIN); S.h1 = take(2048 * 1024); S.qk = S.h1; S.hraw = S.qk + 2048 * 512; S.kn = S.hraw + 2048 * 256;
    S.kcmp = take(2 * 127 * 64); S.vcmp = take(2 * 127 * 64); S.dqn = take(2048 * 192); S.q = take(2048 * 576); S.dkvn = take(2048 * 128); S.kv = take(2048 * 768); S.x1 = S.dqn;
    S.krope = take(2048 * 32); S.y = take(2048 * 1024); S.xl = take(2048 * 1024); S.rt_e = (int*)take(2048 * 2); S.rt_w = take(2048 * 2);
    if (off * 4 > (size_t)NTOK * 1024 * 4) { fprintf(stderr, "naive scratch too big\n"); return; }
    float* acc = (float*)(ws + WS_CTL) + CW_CHK;
    launch_mk(a, 0, 1, stream);
    const float* nx_in = (const float*)d_in[0] + (size_t)CB * 2048 * 1024;
    int nst = 0;
    for (int l = 0; l < L_; ++l) {
        const int pb = 1 + l * NPH; const int sb = l * 16;
        launch_mk(a, pb + PH_INPROJ, pb + PH_INPROJ + 1, stream);
        naive_step(d_in, l, NS_INPROJ, nx_in, S.xl, S, stream);
        chk_proj<<<2048, 64, 0, stream>>>(S.proj, ws + WS_PRJ, (const float*)(ws + WS_SSQ + PT_DQ) + (size_t)l * 16384 * 4, (const float*)(ws + WS_SSQ + PT_DKV) + (size_t)l * 16384 * 2,
                                           (const float*)d_in[8] + l * 64, (const float*)d_in[9] + l * 64, (const float*)d_in[19] + l * 192 + 160, (const int*)d_in[1], acc + 2 * (sb + 0));
        nst = sb + 2;
        int ns_done = NS_INPROJ;
#if CHECK_UPTO >= 1
        launch_mk(a, pb + PH_PREP, pb + PH_PREP + 1, stream);
        naive_step(d_in, l, NS_NSAPREP, nx_in, S.xl, S, stream); naive_step(d_in, l, NS_MLAPREP, nx_in, S.xl, S, stream); ns_done = NS_MLAPREP;
        chk_prep<<<2048, 64, 0, stream>>>(S.q, S.kv, S.krope, S.kcmp, S.vcmp, ws, acc + 2 * (sb + 2));
        nst = sb + 4;
#endif
#if CHECK_UPTO >= 2
        launch_mk(a, pb + PH_MIX, pb + PH_MIX + 1, stream);
        naive_step(d_in, l, NS_NSA, nx_in, S.xl, S, stream); naive_step(d_in, l, NS_ML, nx_in, S.xl, S, stream); naive_step(d_in, l, NS_MLA, nx_in, S.xl, S, stream); ns_done = NS_MLA;
        chk_y<<<2048, 64, 0, stream>>>(S.y, ws, acc + 2 * (sb + 4), 3);
        nst = sb + 7;
#endif
#if CHECK_UPTO >= 3
        launch_mk(a, pb + PH_YNORM, pb + PH_YNORM + 1, stream); launch_mk(a, pb + PH_OUTPROJ, pb + PH_OUTPROJ + 1, stream);
        naive_step(d_in, l, NS_OUT, nx_in, S.xl, S, stream); ns_done = NS_OUT;
        chk_x<<<2048, 64, 0, stream>>>(S.x1, ws, acc + 2 * (sb + 7));
        nst = sb + 8;
#endif
#if CHECK_UPTO >= 4
        for (int ph = PH_ROUTE; ph <= PH_COMBINE; ++ph) launch_mk(a, pb + ph, pb + ph + 1, stream);
        naive_step(d_in, l, NS_ROUTE, nx_in, S.xl, S, stream); naive_step(d_in, l, NS_MOE, nx_in, S.xl, S, stream); ns_done = NS_MOE;
        chk_x<<<2048, 64, 0, stream>>>(S.xl, ws, acc + 2 * (sb + 8));
        nst = sb + 9;
#endif
        CHECK_REST
        for (int s = ns_done + 1; s <= NS_MOE; ++s) naive_step(d_in, l, s, nx_in, S.xl, S, stream);
        nx_in = S.xl;
        if (l == CHECK_LAYERS - 1) break;
    }
    chk_code<<<1, 512, 0, stream>>>(acc, nst, S.xl);
    chk_fill<<<1024, 512, 0, stream>>>(acc, (float*)d_out);
#else
#if defined(SPLIT_LAUNCH) && SPLIT_LAUNCH
    for (int ph = 0; ph < 1 + L_ * NPH; ++ph) launch_mk(a, ph, ph + 1, stream);
#else
    launch_mk(a, 0, 1 + L_ * NPH, stream);
#endif
#endif
}
```

```cpp
#define CHECK 0
#define CHECK_LAYERS 2
#define CHECK_UPTO 99
#define SPLIT_LAUNCH 0
#define REPEAT_PH -1
#include <hip/hip_runtime.h>
#include <stdint.h>
#include <cstdio>

constexpr int B_ = 8, T_ = 2048, D_ = 1024, L_ = 2, NTOK = B_ * T_;
constexpr int DIN = 2554;
constexpr int O_AQ = 0, O_AKV = 384, O_AG = 1152, O_BQK = 1170, O_BV = 1682, O_BIF = 1938, O_BO = 1946, O_CDQ = 2202, O_CDKV = 2394, O_CKR = 2522;

typedef unsigned short bf16_t;
typedef short bf16x8 __attribute__((ext_vector_type(8)));
typedef short s16x4 __attribute__((ext_vector_type(4)));
typedef float f32x4 __attribute__((ext_vector_type(4)));
typedef float f32x16 __attribute__((ext_vector_type(16)));
typedef unsigned u32x4 __attribute__((ext_vector_type(4)));
typedef unsigned u32x2 __attribute__((ext_vector_type(2)));
typedef float f32x2_t __attribute__((ext_vector_type(2)));
typedef __bf16 bf16x2_t __attribute__((ext_vector_type(2)));
#define LAS __attribute__((address_space(3)))

__device__ __forceinline__ unsigned pk_bf16(float lo, float hi) { f32x2_t v = {lo, hi}; bf16x2_t b = __builtin_convertvector(v, bf16x2_t); return __builtin_bit_cast(unsigned, b); }
__device__ __forceinline__ float bf_lo(unsigned u) { return __builtin_bit_cast(float, u << 16); }
__device__ __forceinline__ float bf_hi(unsigned u) { return __builtin_bit_cast(float, u & 0xffff0000u); }
__device__ __forceinline__ float bf2f(bf16_t h) { return __builtin_bit_cast(float, (unsigned)h << 16); }
__device__ __forceinline__ bf16_t f2bf(float f) { return (bf16_t)(pk_bf16(f, 0.f) & 0xffffu); }
__device__ __forceinline__ float wave_sum(float v) { for (int o = 32; o; o >>= 1) v += __shfl_xor(v, o); return v; }
__device__ __forceinline__ float wave_max(float v) { for (int o = 32; o; o >>= 1) v = fmaxf(v, __shfl_xor(v, o)); return v; }
__device__ __forceinline__ float siluf(float x) { return x / (1.f + __expf(-x)); }
__device__ __forceinline__ float sigmf(float x) { return 1.f / (1.f + __expf(-x)); }
__device__ __forceinline__ int t5b(int dist) {
    int n = dist > 0 ? dist : 0; if (n < 16) return n;
    float v = logf((float)n / 16.f) / logf(8.f) * 16.f; int l = 16 + (int)v; return l < 31 ? l : 31;
}

constexpr size_t WS_CTL = 0, CTL_BYTES = 65536;
constexpr size_t WS_SSQ = WS_CTL + CTL_BYTES;
constexpr size_t ZERO_BYTES = CTL_BYTES;
constexpr size_t PT_DQ = 0, PT_DKV = PT_DQ + (size_t)2 * 16384 * 4 * 4, PT_A = PT_DKV + (size_t)2 * 16384 * 2 * 4, PT_C = PT_A + (size_t)2 * 16384 * 8 * 4, PT_X1 = PT_C + (size_t)2 * 16384 * 8 * 4, PT_END = PT_X1 + (size_t)2 * 16384 * 16 * 4;
constexpr size_t WS_SSQX = WS_SSQ + PT_END;
constexpr size_t WS_RS2 = WS_SSQX + 2 * 65536;
constexpr size_t WS_WIN = WS_RS2 + 65536;
constexpr size_t WS_WOUT = WS_WIN + (size_t)2 * 2560 * 1024 * 2;
constexpr size_t WS_WUQ = WS_WOUT + (size_t)2 * 1024 * 1024 * 2;
constexpr size_t WS_WUKV = WS_WUQ + (size_t)2 * 768 * 256 * 2;
constexpr size_t WS_WC1 = WS_WUKV + (size_t)2 * 768 * 256 * 2;
constexpr size_t WS_WC2 = WS_WC1 + (size_t)2 * 2 * 64 * 2048 * 2;
constexpr size_t WS_WR = WS_WC2 + (size_t)2 * 2 * 64 * 64 * 2;
constexpr size_t WS_B1C = WS_WR + (size_t)2 * 64 * 1024 * 2;
constexpr size_t WS_BIASD = WS_B1C + 1024;
constexpr size_t WS_ROPE = WS_BIASD + 6 * 2048 * 4;
constexpr size_t WS_WMOE = WS_ROPE + (size_t)16384 * 32 * 4;
constexpr size_t WMOE_WD = (size_t)32 * 512 * 1024 * 2;
constexpr size_t WS_XB = WS_WMOE + 50331648;
constexpr size_t WS_MLA = WS_XB + 33554432;
constexpr size_t MLA_KM = (size_t)8 * 6 * 2048 * 96 * 2, MLA_VM = 2 * MLA_KM;
constexpr size_t WS_HBUF = WS_MLA;
constexpr size_t WS_PRJ = WS_MLA + 50331648;
constexpr size_t HM64 = (size_t)2048 * 64 * 2;
constexpr size_t PRJ_QN = 0;
constexpr size_t PRJ_KN1 = PRJ_QN + 48 * HM64, PRJ_VN1 = PRJ_KN1 + 16 * HM64, PRJ_KN2 = PRJ_VN1 + 16 * HM64, PRJ_VN2 = PRJ_KN2 + 16 * HM64;
constexpr size_t PRJ_VML = PRJ_VN2 + 16 * HM64;
constexpr size_t PRJ_OG = PRJ_VML + 32 * HM64;
constexpr size_t PRJ_KR = PRJ_OG + (size_t)16384 * 256 * 2;
constexpr size_t PRJ_GATES = PRJ_KR + (size_t)16384 * 32 * 2;
constexpr size_t PRJ_DEAD = PRJ_GATES + (size_t)16384 * 32 * 4;
constexpr size_t PRJ_C0K = PRJ_DEAD, PRJ_C0V = PRJ_C0K + 16 * HM64 + 8192;
constexpr size_t PRJ_RAWQK = PRJ_C0V + 16 * HM64 + 8192;
constexpr size_t PRJ_DQKV = PRJ_RAWQK + (size_t)16384 * 512 * 2;
constexpr size_t PRJ_END = PRJ_DQKV + (size_t)16384 * 384 * 2;
static_assert(PRJ_END - PRJ_DEAD >= 33554432, "Y fits the dead part of PRJ");
constexpr size_t WS_Y = WS_PRJ + PRJ_DEAD;
constexpr size_t WS_YBUF = WS_PRJ;
static_assert((size_t)2 * 16384 * 1024 * 2 <= PRJ_END, "YBUF fits the PRJ region");
constexpr size_t WS_ML = WS_PRJ + PRJ_END;
constexpr size_t ML_KC = 32 * HM64, ML_DELTA = 2 * ML_KC, ML_DN = ML_DELTA + (size_t)1024 * 4096 * 2, ML_G = ML_DN + (size_t)1024 * 64 * 4, ML_BL = ML_G + (size_t)8 * 4 * 2048 * 2 * 4, ML_CP = ML_BL + 4096, ML_NP = ML_CP + (size_t)1024 * 4096 * 2, ML_END = ML_NP + (size_t)1024 * 64 * 2;
constexpr size_t WS_CMP = WS_ML + ML_END;
constexpr size_t CMP_V = (size_t)8 * 2 * 128 * 64 * 2;
constexpr size_t WS_META = WS_CMP + 2 * CMP_V;
constexpr size_t META_W = (size_t)32 * 16384 * 4, META_RT = 2 * META_W;
constexpr size_t WS_END = WS_META + META_RT + (size_t)16384 * 16;
constexpr int CW_BAR = 0;
constexpr int CW_Q = 4096;
constexpr int CW_CNT = 8192;
constexpr int CW_SCAN = 8448;
constexpr int CW_CHK = 9000;
constexpr int LDS_BYTES = 147456;
constexpr int LDS_MISC = LDS_BYTES - 256;
#define XB_TMO      128
#define XB_XCNT(j)  (256  + 64 * (j))
#define XB_XSUB(j)  (1280 + 64 * (j))
#define XB_XGEN(j)  (2304 + 64 * (j))
#define XB_TOP      3328
#define XB_TOPGEN   3392
#define XCD_BAR_WORDS 3456
#define XB_SPIN_CAP (1u << 18)

__device__ __forceinline__ unsigned xb_ld(unsigned* p)              { return __hip_atomic_load(p, __ATOMIC_RELAXED, __HIP_MEMORY_SCOPE_AGENT); }
__device__ __forceinline__ unsigned xb_add(unsigned* p, unsigned v) { return __hip_atomic_fetch_add(p, v, __ATOMIC_RELAXED, __HIP_MEMORY_SCOPE_AGENT); }
__device__ __forceinline__ unsigned xb_xcc_id() { return (unsigned)__builtin_amdgcn_s_getreg((3 << 11) | 20) & 0xFu; }
#define XB_SPIN(cond, bar) do { unsigned _sp = 0; while (cond) { __builtin_amdgcn_s_sleep(1); \
    if ((++_sp & 255u) == 0u) { if (xb_ld(&(bar)[XB_TMO])) break; if (_sp > XB_SPIN_CAP) { atomicAdd(&(bar)[XB_TMO], 1u); break; } } } } while (0)

struct XcdBarrier {
    unsigned* bar; unsigned x;
    volatile LAS unsigned* st;
};

__device__ __forceinline__ XcdBarrier xcd_barrier_post(unsigned* bar, volatile LAS unsigned* st) {
    XcdBarrier b; b.bar = bar; b.x = xb_xcc_id(); b.st = st;
    if (threadIdx.x == 0) (void)xb_add(&bar[XB_XCNT(b.x)], 1u);
    return b;
}
__device__ __forceinline__ void xcd_barrier_complete(unsigned* bar, unsigned x, unsigned& nloc, unsigned& nx) {
    const unsigned G = gridDim.x * gridDim.y * gridDim.z;
    unsigned sum, cnt, mine, sp = 0u;
    for (;;) {
        sum = 0u; cnt = 0u; mine = 0u;
#pragma unroll
        for (unsigned j = 0; j < 16; ++j) { const unsigned c = xb_ld(&bar[XB_XCNT(j)]); sum += c; cnt += (c > 0u) ? 1u : 0u; mine = (j == x) ? c : mine; }
        if (sum == G) break;
        __builtin_amdgcn_s_sleep(1);
        if ((++sp & 255u) == 0u) { if (xb_ld(&bar[XB_TMO])) break; if (sp > XB_SPIN_CAP) { atomicAdd(&bar[XB_TMO], 1u); break; } }
    }
    nloc = mine > 0u ? mine : 1u; nx = cnt > 0u ? cnt : 1u;
}

__device__ __forceinline__ void xcd_barrier(const XcdBarrier& b) {
    asm volatile("s_waitcnt vmcnt(0)" ::: "memory");
    __syncthreads();
    if (threadIdx.x == 0) {
        unsigned* bar = b.bar;
        __builtin_amdgcn_s_waitcnt(0);
        unsigned nloc = b.st[0], nx = b.st[1];
        if (nloc == 0u) { xcd_barrier_complete(bar, b.x, nloc, nx); b.st[0] = nloc; b.st[1] = nx; }
        const unsigned old = xb_add(&bar[XB_XSUB(b.x)], 1u);
        const unsigned gen = old / nloc;
        if (old + 1u == (gen + 1u) * nloc) {
            __builtin_amdgcn_fence(__ATOMIC_RELEASE, "agent");
            asm volatile("s_waitcnt vmcnt(0)" ::: "memory");
            const unsigned og = xb_add(&bar[XB_TOP], 1u);
            const unsigned tg = og / nx;
            if (og + 1u == (tg + 1u) * nx) xb_add(&bar[XB_TOPGEN], 1u);
            else XB_SPIN(xb_ld(&bar[XB_TOPGEN]) == tg, bar);
            __builtin_amdgcn_fence(__ATOMIC_ACQUIRE, "agent");
            xb_add(&bar[XB_XGEN(b.x)], 1u);
            asm volatile("s_waitcnt vmcnt(0)" ::: "memory");
        } else {
            XB_SPIN(xb_ld(&bar[XB_XGEN(b.x)]) == gen, bar);
            __builtin_amdgcn_fence(__ATOMIC_ACQUIRE, "agent");
            asm volatile("s_waitcnt vmcnt(0)" ::: "memory");
        }
    }
    __syncthreads();
}
struct Inputs { const float* p[30]; };
typedef const __attribute__((address_space(4))) Inputs* InPtr;
__device__ __forceinline__ InPtr in_tab() { InPtr p = (InPtr)__builtin_amdgcn_kernarg_segment_ptr(); asm volatile("" : "+s"(p)); return p; }
__device__ __forceinline__ unsigned char* launder(unsigned char* p) { asm volatile("" : "+s"(p)); return p; }

__host__ __device__ inline int inproj_refcol(int G, int e) {
    if (G < 6) return O_AQ + G * 64 + e;
    if (G < 18) return O_AKV + (G - 6) * 64 + e;
    if (G < 26) return O_BQK + (G - 18) * 64 + e;
    if (G < 30) return O_BV + (G - 26) * 64 + e;
    if (G < 34) return O_BO + (G - 30) * 64 + e;
    if (G < 37) return O_CDQ + (G - 34) * 64 + e;
    if (G == 37) { if (e < 32) return O_CKR + e; if (e < 50) return O_AG + (e - 32); if (e < 58) return O_BIF + (e - 50); return -1; }
    return O_CDKV + (G - 38) * 64 + e;
}
__host__ __device__ inline int uq_refcol(int G, int e) {
    if (G < 6) return G * 96 + e;
    if (G < 9) { const int idx = e & 31, bj = e >> 5, sub = idx >> 4, i = idx & 15; return (2 * (G - 6) + sub) * 96 + 64 + bj * 16 + i; }
    return -1;
}
__host__ __device__ inline int ukv_refcol(int G, int e) { return G < 6 ? G * 128 + e : (G - 6) * 128 + 64 + e; }
#define N2G(n) ((((n) >> 8) << 2) + (((n) >> 5) & 3))
#define N2E(n) (((((n) >> 7) & 1) << 5) + ((n) & 31))

struct FWin { const float* w; const float* g; __device__ __forceinline__ float operator()(int k, int n) const { const int c = inproj_refcol(N2G(n), N2E(n)); return c < 0 ? 0.f : w[(size_t)k * DIN + c] * g[k]; } };
struct FWout { const float* w; const float* ga; const float* gc; __device__ __forceinline__ float operator()(int k, int n) const { const float og = k < 384 ? ga[k] : (k < 640 ? 1.f : gc[k - 640]); return w[(size_t)k * 1024 + n] * og; } };
struct FWuq { const float* w; const float* g; __device__ __forceinline__ float operator()(int k, int n) const { const int c = uq_refcol(N2G(n), N2E(n)); return (k < 192 && c >= 0) ? w[(size_t)k * 576 + c] * g[k] : 0.f; } };
struct FWukv { const float* w; const float* g; __device__ __forceinline__ float operator()(int k, int n) const { const int c = ukv_refcol(N2G(n), N2E(n)); return k >= 128 ? w[(size_t)(k - 128) * 768 + c] * g[k - 128] : 0.f; } };
struct FWc1 { const float* w; __device__ __forceinline__ float operator()(int k, int n) const { return w[(size_t)k * 64 + n]; } };
struct FWr { const float* wg; const float* we; const float* g; __device__ __forceinline__ float operator()(int k, int n) const { return n < 4 ? wg[k * 4 + n] * g[k] : (n < 36 ? we[k * 32 + n - 4] * g[k] : 0.f); } };
struct FWgu { const float* src; const float* g; int n0, col0; __device__ __forceinline__ float operator()(int k, int n) const { return src[(size_t)k * 256 + col0 + (n - n0)] * g[k]; } };
struct FWd { const float* w; __device__ __forceinline__ float operator()(int k, int n) const { return w[(size_t)k * 1024 + n]; } };

__device__ __forceinline__ void rope_cs(int pos, int j, float& cs, float& sn) {
    const double inv = exp2(-(double)j * (13.287712379549449 / 16.0));
    const double rev = (double)pos * inv * 0.15915494309189535; const float f = (float)(rev - rint(rev));
    cs = __builtin_amdgcn_cosf(f); sn = __builtin_amdgcn_sinf(f);
}
template <class F>
__device__ __forceinline__ void cvt_tile(const F& f, int n0, int k0, bf16_t* dst, int ldk, LAS float* tile, int tid) {
    { const int k = tid >> 3, nb = (tid & 7) * 8;
#pragma unroll
      for (int j = 0; j < 8; ++j) tile[k * 65 + nb + j] = f(k0 + k, n0 + nb + j); }
    __syncthreads();
    { const int n = tid >> 3, kb = (tid & 7) * 8; const LAS float* s = tile + kb * 65 + n;
      u32x4 o; o.x = pk_bf16(s[0], s[65]); o.y = pk_bf16(s[130], s[195]); o.z = pk_bf16(s[260], s[325]); o.w = pk_bf16(s[390], s[455]);
      *(u32x4*)(dst + (size_t)(n0 + n) * ldk + k0 + kb) = o; }
    __syncthreads();
}
template <class F>
__device__ __forceinline__ void cvt_item(const F& f, int it, int nK, bf16_t* dst, int ldk, LAS float* tile, int tid) { cvt_tile(f, (it / nK) * 64, (it % nK) * 64, dst, ldk, tile, tid); }

__device__ __forceinline__ void cvt_moe_layer(InPtr in, unsigned char* ws, int l, LAS float* tile, int bid, int nb, int tid) {
    asm volatile("" : "+v"(tid));
    const float* g2 = in->p[22] + l * 1024;
    bf16_t* WGU = (bf16_t*)(ws + WS_WMOE); bf16_t* WD = (bf16_t*)(ws + WS_WMOE + WMOE_WD);
    for (int it = bid; it < 32 * (128 + 64); it += nb) {
        if (it < 32 * 128) { const int e = it >> 7, r = it & 127, n0 = (r >> 4) * 64, c0 = n0 & 255; FWgu f{(c0 < 128 ? in->p[27] : in->p[28]) + ((size_t)l * 32 + e) * 262144, g2, n0, (n0 >> 8) * 128 + (c0 & 127)}; cvt_item(f, r, 16, WGU + (size_t)e * 512 * 1024, 1024, tile, tid); }
        else { const int j = it - 32 * 128, e = j >> 6, r = j & 63; FWd f{in->p[29] + ((size_t)l * 32 + e) * 262144}; cvt_item(f, r, 4, WD + (size_t)e * 1024 * 256, 256, tile, tid); }
    }
}

__device__ __forceinline__ void prologue(InPtr in, unsigned char* ws, LAS unsigned char* lds, int bid, int nb) {
    int tid_ = threadIdx.x; asm volatile("" : "+v"(tid_));
    const int tid = tid_, lane = tid & 63, wid = tid >> 6;
    LAS float* tile = (LAS float*)lds;
    constexpr int I_WIN = 40 * 16, I_WOUT = 16 * 16, I_WU = 12 * 4, I_WC1 = 32, I_WC2 = 1, I_WR = 16;
    constexpr int PER_L = I_WIN + I_WOUT + 2 * I_WU + 2 * I_WC1 + 2 * I_WC2 + I_WR;
    for (int it0 = bid; it0 < 2 * PER_L; it0 += nb) {
        const int l = it0 / PER_L; int it = it0 % PER_L;
        if (it < I_WIN) { FWin f{in->p[4] + (size_t)l * 1024 * DIN, in->p[3] + l * 1024}; cvt_item(f, it, 16, (bf16_t*)(ws + WS_WIN) + (size_t)l * 2560 * 1024, 1024, tile, tid); continue; } it -= I_WIN;
        if (it < I_WOUT) { FWout f{in->p[21] + (size_t)l * 1048576, in->p[10] + l * 384, in->p[20] + l * 384}; cvt_item(f, it, 16, (bf16_t*)(ws + WS_WOUT) + (size_t)l * 1048576, 1024, tile, tid); continue; } it -= I_WOUT;
        if (it < I_WU) { FWuq f{in->p[16] + (size_t)l * 192 * 576, in->p[15] + l * 192}; cvt_item(f, it, 4, (bf16_t*)(ws + WS_WUQ) + (size_t)l * 768 * 256, 256, tile, tid); continue; } it -= I_WU;
        if (it < I_WU) { FWukv f{in->p[18] + (size_t)l * 128 * 768, in->p[17] + l * 128}; cvt_item(f, it, 4, (bf16_t*)(ws + WS_WUKV) + (size_t)l * 768 * 256, 256, tile, tid); continue; } it -= I_WU;
        if (it < 2 * I_WC1) { const int s = it / I_WC1; FWc1 f{in->p[6] + ((size_t)l * 2 + s) * 2048 * 64}; cvt_item(f, it % I_WC1, 32, (bf16_t*)(ws + WS_WC1) + ((size_t)l * 2 + s) * 64 * 2048, 2048, tile, tid); continue; } it -= 2 * I_WC1;
        if (it < 2 * I_WC2) { const int s = it; FWc1 f{in->p[7] + ((size_t)l * 2 + s) * 64 * 64}; cvt_item(f, 0, 1, (bf16_t*)(ws + WS_WC2) + ((size_t)l * 2 + s) * 64 * 64, 64, tile, tid); continue; } it -= 2 * I_WC2;
        { FWr f{in->p[23] + (size_t)l * 4096, in->p[25] + (size_t)l * 32768, in->p[22] + l * 1024}; cvt_item(f, it, 16, (bf16_t*)(ws + WS_WR) + (size_t)l * 64 * 1024, 1024, tile, tid); }
    }
    cvt_moe_layer(in, ws, 0, tile, bid, nb, tid);
    { const float* x = in->p[0]; bf16_t* XB = (bf16_t*)(ws + WS_XB); float* ssqx = (float*)(ws + WS_SSQX);
      for (int r = bid * 8 + wid; r < NTOK; r += nb * 8) {
          const f32x4* xr = (const f32x4*)(x + (size_t)r * 1024) + lane; float s = 0.f; u32x2* o = (u32x2*)(XB + (size_t)r * 1024) + lane;
#pragma unroll
          for (int j = 0; j < 4; ++j) { const f32x4 v = xr[64 * j]; s += (v.x * v.x + v.y * v.y) + (v.z * v.z + v.w * v.w); u32x2 w; w.x = pk_bf16(v.x, v.y); w.y = pk_bf16(v.z, v.w); o[64 * j] = w; }
          s = wave_sum(s); if (lane == 0) ssqx[r] = s;
      } }
    { float* biasd = (float*)(ws + WS_BIASD); const float* rb = in->p[2];
      for (int i = bid * 512 + tid; i < 6 * 2048; i += nb * 512) { const int h = i >> 11, d = i & 2047; biasd[i] = rb[t5b(d) * 6 + h]; } }
    { float* rope = (float*)(ws + WS_ROPE); const int* pos = (const int*)in->p[1];
      for (int i = bid * 512 + tid; i < NTOK * 16; i += nb * 512) { const int tk = i >> 4, j = i & 15; float cs, sn; rope_cs(pos[tk], j, cs, sn); rope[(size_t)tk * 32 + j] = cs; rope[(size_t)tk * 32 + 16 + j] = sn; } }
    { float* b1c = (float*)(ws + WS_B1C); LAS float* red = (LAS float*)lds;
      for (int it = bid; it < 4; it += nb) { const float* pe = in->p[5] + (size_t)it * 2048; const float* w1 = in->p[6] + (size_t)it * 2048 * 64; const int f = tid & 63, part = tid >> 6;
          float a = 0.f; for (int k = part * 256; k < part * 256 + 256; ++k) a += pe[k] * w1[(size_t)k * 64 + f];
          __syncthreads(); red[tid] = a; __syncthreads();
          if (tid < 64) { float s = 0.f; for (int p2 = 0; p2 < 8; ++p2) s += red[p2 * 64 + tid]; b1c[it * 64 + tid] = s; }
          __syncthreads(); } }
}
namespace g8 {
constexpr int BM = 256, BK = 64, HALF = 128, HTB = HALF * BK * 2, STAGE_BYTES = 8 * HTB, NXCD = 8, WGM = 8;
__host__ __device__ __forceinline__ int lds_byte(int r, int c) { const int st = (r >> 4) * 2 + (c >> 5), rr = r & 15, cc = c & 31, ob = rr * 64 + cc * 2; return st * 1024 + (ob ^ (((ob >> 9) & 1) << 5)); }
__host__ __device__ __forceinline__ void stage_rc(int b, int& R, int& C) { const int st = b / 1024, sb = b % 1024, swz = sb ^ (((sb >> 9) & 1) << 5); R = (st >> 1) * 16 + swz / 64; C = (st & 1) * 32 + (swz % 64) / 2; }
__host__ __device__ __forceinline__ int perm32(int rho) { const int n = rho >> 4, i = rho & 15; return 8 * (i >> 2) + 4 * n + (i & 3); }

struct GUnit { const char* a; const char* b; int pm, pn, e, rows; };

__device__ __forceinline__ bool static_unit(int i, int G, int c, int nM, int nN, int& pm, int& pn) {
    const int nwg = nM * nN; const long L = (long)i * G + c; if (L >= nwg) return false;
    int wgid = (int)L; { const int q = nwg / NXCD, r = nwg % NXCD, xcd = wgid % NXCD, off = wgid / NXCD; wgid = (xcd < r ? xcd * (q + 1) : r * (q + 1) + (xcd - r) * q) + off; }
    const int nig = WGM * nN, gid = wgid / nig, fm = gid * WGM, gsz = (nM - fm) < WGM ? (nM - fm) : WGM;
    pm = fm + ((wgid % nig) % gsz); pn = (wgid % nig) / gsz; return true;
}
struct DenseSched {
    static constexpr bool GATHER = false;
    const char* A; const char* Bt; int lda, ldb, nM, nN, G, c;
    __device__ __forceinline__ bool next(int i, GUnit& u) const {
        int pm, pn; if (!static_unit(i, G, c, nM, nN, pm, pn)) return false;
        u.pm = pm; u.pn = pn; u.e = 0; u.rows = 256; u.a = A + (size_t)pm * 256 * lda * 2; u.b = Bt + (size_t)pn * 256 * ldb * 2; return true;
    }
    __device__ __forceinline__ void aoff(const GUnit&, unsigned (&v)[2][2], const int (&R)[2], const int (&C)[2]) const {
#pragma unroll
        for (int h = 0; h < 2; ++h)
#pragma unroll
            for (int i = 0; i < 2; ++i) v[h][i] = (unsigned)((h * 128 + R[i]) * lda + C[i]) * 2u;
    }
};

template <class Epi, class Sched>
__device__ __forceinline__ void gemm_run(LAS unsigned char* lds, const int K, const int ldb, const Sched& S, const Epi& E) {
    int tid_ = threadIdx.x; asm volatile("" : "+v"(tid_));
    const int tid = tid_, wid = __builtin_amdgcn_readfirstlane(tid >> 6), lane = tid & 63, wr = wid >> 2, wc = wid & 3, fr = lane & 15, fq = lane >> 4;
    int nt_ = K / BK; asm volatile("" : "+s"(nt_));
    const int nt = nt_;
    int R[2], C[2]; unsigned voffB[2];
#pragma unroll
    for (int i = 0; i < 2; ++i) { stage_rc(tid * 16 + i * 8192, R[i], C[i]); const int Rb = (R[i] & ~31) + perm32(R[i] & 31); voffB[i] = (unsigned)(Rb * ldb + C[i]) * 2u; }
    const size_t kstep = (size_t)(BK * 2);
    const size_t hstepB = (size_t)HALF * ldb * 2;
    const unsigned ldsw = (unsigned)wid * 1024u;
    const int aoff = lds_byte(wr * 64 + fr, fq * 8), boff = lds_byte(wc * 32 + fr, fq * 8);
#define G8_SA(b, h) (((b) * 2 + (h)) * HTB)
#define G8_SB(b, h) ((4 + (b) * 2 + (h)) * HTB)
#define G8_GLDS(bufoff, gptr, i_) __builtin_amdgcn_global_load_lds((const unsigned*)(gptr), (LAS unsigned*)(lds + (bufoff) + ldsw + (i_) * 8192), 16, 0, 0)
#define G8_STAGE_B(bufoff, gbase) do { G8_GLDS(bufoff, (const char*)(gbase) + voffB[0], 0); G8_GLDS(bufoff, (const char*)(gbase) + voffB[1], 1); } while (0)
#define G8_STAGE_A(bufoff, gbase, v0, v1) do { G8_GLDS(bufoff, (const char*)(gbase) + (v0), 0); G8_GLDS(bufoff, (const char*)(gbase) + (v1), 1); } while (0)
#define G8_LDA(dst, b, h) do { _Pragma("unroll") for (int m = 0; m < 4; ++m) _Pragma("unroll") for (int k = 0; k < 2; ++k) dst[m][k] = *(const LAS bf16x8*)(lds + G8_SA(b, h) + aoff + m * 2048 + k * 1024); } while (0)
#define G8_LDB(dst, b, h) do { _Pragma("unroll") for (int n = 0; n < 2; ++n) _Pragma("unroll") for (int k = 0; k < 2; ++k) dst[n][k] = *(const LAS bf16x8*)(lds + G8_SB(b, h) + boff + n * 2048 + k * 1024); } while (0)
#define G8_MMA(ai, bj, At, Bt) do { __builtin_amdgcn_s_setprio(1); _Pragma("unroll") for (int m = 0; m < 4; ++m) _Pragma("unroll") for (int n = 0; n < 2; ++n) _Pragma("unroll") for (int k = 0; k < 2; ++k) \
        acc[ai][bj][m][n] = __builtin_amdgcn_mfma_f32_16x16x32_bf16(Bt[n][k], At[m][k], acc[ai][bj][m][n], 0, 0, 0); __builtin_amdgcn_s_setprio(0); } while (0)
#define G8_WAIT_V(n) asm volatile("s_waitcnt vmcnt(" #n ")" ::: "memory")
#define G8_WAIT_L(n) asm volatile("s_waitcnt lgkmcnt(" #n ")" ::: "memory")
#define G8_BAR __builtin_amdgcn_s_barrier()
#define G8_SCHED __builtin_amdgcn_sched_barrier(0)
    GUnit cur, nxt; int ui = 0;
    if (!S.next(0, cur)) return;
    constexpr bool GATHER = Sched::GATHER;
    unsigned vc[2][2];
    S.aoff(cur, vc, R, C);
    LAS u32x4* stash = (LAS u32x4*)(lds + STAGE_BYTES + 4096) + tid;
    f32x4 acc[2][2][4][2];
#pragma unroll
    for (int a = 0; a < 2; ++a)
#pragma unroll
        for (int b = 0; b < 2; ++b)
#pragma unroll
            for (int m = 0; m < 4; ++m)
#pragma unroll
                for (int n = 0; n < 2; ++n) acc[a][b][m][n] = (f32x4){0.f, 0.f, 0.f, 0.f};
    bf16x8 At[4][2], B0[2][2], B1[2][2];
    const char* cA = cur.a; const char* cB = cur.b;
    G8_STAGE_B(G8_SB(0, 0), cB); G8_STAGE_B(G8_SB(0, 1), cB + hstepB); G8_STAGE_A(G8_SA(0, 0), cA, vc[0][0], vc[0][1]); G8_STAGE_A(G8_SA(0, 1), cA, vc[1][0], vc[1][1]);
    if (wr == 1) G8_BAR;
    G8_WAIT_V(2); G8_BAR;
    G8_STAGE_B(G8_SB(1, 0), cB + kstep); G8_STAGE_A(G8_SA(1, 0), cA + kstep, vc[0][0], vc[0][1]); G8_STAGE_B(G8_SB(1, 1), cB + hstepB + kstep);
    G8_WAIT_V(6); G8_BAR;
    for (;;) {
        const bool has_next = S.next(ui + 1, nxt);
        if (GATHER) { unsigned vn[2][2];
            if (has_next) S.aoff(nxt, vn, R, C);
            else { vn[0][0] = vc[0][0]; vn[0][1] = vc[0][1]; vn[1][0] = vc[1][0]; vn[1][1] = vc[1][1]; }
            u32x4 sv; sv.x = vn[0][0]; sv.y = vn[0][1]; sv.z = vn[1][0]; sv.w = vn[1][1]; *stash = sv; }
        const char* nA = has_next ? nxt.a : cA; const char* nB = has_next ? nxt.b : cB;
#pragma unroll 1
        for (int t = 0; t < nt; t += 2) {
            const bool last = (t == nt - 2);
            const char* a1 = cA + (size_t)(t + 1) * kstep;
            const char* a2 = last ? nA : cA + (size_t)(t + 2) * kstep; const char* b2 = last ? nB : cB + (size_t)(t + 2) * kstep;
            const char* a3 = a2 + kstep; const char* b3 = b2 + kstep;
            unsigned w00 = vc[0][0], w01 = vc[0][1], w10 = vc[1][0], w11 = vc[1][1];
            if (GATHER) { if (last) { const u32x4 sv = *stash; w00 = sv.x; w01 = sv.y; w10 = sv.z; w11 = sv.w; } }
            G8_LDB(B0, 0, 0); G8_LDB(B1, 0, 1); G8_SCHED; G8_LDA(At, 0, 0); G8_STAGE_A(G8_SA(1, 1), a1, vc[1][0], vc[1][1]);
            G8_WAIT_V(8); G8_WAIT_L(0); G8_BAR; G8_MMA(0, 0, At, B0); G8_MMA(0, 1, At, B1); G8_BAR; G8_SCHED;
            G8_LDA(At, 0, 1); G8_STAGE_B(G8_SB(0, 0), b2); G8_STAGE_B(G8_SB(0, 1), b2 + hstepB); G8_STAGE_A(G8_SA(0, 0), a2, w00, w01);
            G8_WAIT_V(8); G8_WAIT_L(0); G8_BAR; G8_MMA(1, 0, At, B0); G8_MMA(1, 1, At, B1); G8_BAR; G8_SCHED;
            G8_LDB(B0, 1, 0); G8_LDB(B1, 1, 1); G8_SCHED; G8_LDA(At, 1, 0); G8_STAGE_A(G8_SA(0, 1), a2, w10, w11);
            G8_WAIT_V(8); G8_WAIT_L(0); G8_BAR; G8_MMA(0, 0, At, B0); G8_MMA(0, 1, At, B1); G8_BAR; G8_SCHED;
            G8_LDA(At, 1, 1); G8_STAGE_B(G8_SB(1, 0), b3); G8_STAGE_B(G8_SB(1, 1), b3 + hstepB); G8_STAGE_A(G8_SA(1, 0), a3, w00, w01);
            G8_WAIT_V(8); G8_WAIT_L(0); G8_BAR; G8_MMA(1, 0, At, B0); G8_MMA(1, 1, At, B1); G8_BAR; G8_SCHED;
        }
        if (wr == 0) G8_BAR;
        { int fr_ = fr, fq_ = fq; asm volatile("" : "+v"(fr_), "+v"(fq_));
          E(acc, cur, wr, wc, fr_, fq_); }
        if (!has_next) break;
#pragma unroll
        for (int a = 0; a < 2; ++a)
#pragma unroll
            for (int b = 0; b < 2; ++b)
#pragma unroll
                for (int m = 0; m < 4; ++m)
#pragma unroll
                    for (int n = 0; n < 2; ++n) acc[a][b][m][n] = (f32x4){0.f, 0.f, 0.f, 0.f};
        cur = nxt; cA = nA; cB = nB; ++ui;
        if (GATHER) { const u32x4 sv = *stash; vc[0][0] = sv.x; vc[0][1] = sv.y; vc[1][0] = sv.z; vc[1][1] = sv.w; }
        if (wr == 1) G8_BAR;
    }
    G8_WAIT_V(0);
    G8_BAR;
#undef G8_SA
#undef G8_SB
#undef G8_GLDS
#undef G8_STAGE_A
#undef G8_STAGE_B
#undef G8_LDA
#undef G8_LDB
#undef G8_MMA
#undef G8_WAIT_V
#undef G8_WAIT_L
#undef G8_BAR
#undef G8_SCHED
}
}
using g8::GUnit;
__device__ __forceinline__ void st_bf16x8(bf16_t* p, const float (&v)[8]) { u32x4 w; w.x = pk_bf16(v[0], v[1]); w.y = pk_bf16(v[2], v[3]); w.z = pk_bf16(v[4], v[5]); w.w = pk_bf16(v[6], v[7]); *(u32x4*)p = w; }
__device__ __forceinline__ float quad_sum(float s) { s += __shfl_xor(s, 16); s += __shfl_xor(s, 32); return s; }

struct EpiInProj {
    const float* ssqx; float* part_dq; float* part_dkv; const float* qg; const float* kg; const float* krg; const float* rope;
    unsigned char* prj;
    __device__ __forceinline__ void operator()(const f32x4 (&acc)[2][2][4][2], const GUnit& u, int wr, int wc, int fr, int fq) const {
        const int G = u.pn * 4 + wc;
        const bool isq = G < 6; const int a = G - 6; const bool isk = (G >= 10 && G < 18 && ((a >> 1) & 1) == 0);
        const float* g0 = (isq ? qg : kg) + 8 * fq;
#pragma unroll
        for (int ai = 0; ai < 2; ++ai)
#pragma unroll
            for (int m = 0; m < 4; ++m) {
                __builtin_amdgcn_sched_barrier(0);
                const int row = u.pm * 256 + ai * 128 + wr * 64 + m * 16 + fr; const int b = row >> 11, t = row & 2047;
                const float rs = rsqrtf(ssqx[row] * (1.f / 1024.f) + 1e-6f);
                float v[2][8];
#pragma unroll
                for (int bj = 0; bj < 2; ++bj)
#pragma unroll
                    for (int n = 0; n < 2; ++n)
#pragma unroll
                        for (int j = 0; j < 4; ++j) v[bj][4 * n + j] = acc[ai][bj][m][n][j] * rs;
                float ss = 0.f;
#pragma unroll
                for (int bj = 0; bj < 2; ++bj)
#pragma unroll
                    for (int i = 0; i < 8; ++i) ss += v[bj][i] * v[bj][i];
                bf16_t* dst = nullptr; int bstride = 32;
                if (isq) {
                    ss = quad_sum(ss); const float sc = rsqrtf(ss * (1.f / 64.f) + 1e-6f) * 0.125f;
#pragma unroll
                    for (int i = 0; i < 8; ++i) { v[0][i] *= sc * g0[i]; v[1][i] *= sc * g0[32 + i]; }
                    dst = (bf16_t*)(prj + PRJ_QN) + ((size_t)(b * 6 + G) * 2048 + t) * 64;
                } else if (G < 18) {
                    const int br = a >> 2, s = (a >> 1) & 1, hk = a & 1;
                    if (br > 0 && s == 0) {
                        ss = quad_sum(ss); const float sc = rsqrtf(ss * (1.f / 64.f) + 1e-6f);
#pragma unroll
                        for (int i = 0; i < 8; ++i) { v[0][i] *= sc * g0[i]; v[1][i] *= sc * g0[32 + i]; }
                    }
                    const size_t base = br == 0 ? (s ? PRJ_C0V : PRJ_C0K) : (br == 1 ? (s ? PRJ_VN1 : PRJ_KN1) : (s ? PRJ_VN2 : PRJ_KN2));
                    dst = (bf16_t*)(prj + base) + ((size_t)(b * 2 + hk) * 2048 + t) * 64;
                } else if (G < 26) { dst = (bf16_t*)(prj + PRJ_RAWQK) + (size_t)row * 512 + (G - 18) * 64; }
                else if (G < 30) { dst = (bf16_t*)(prj + PRJ_VML) + ((size_t)(b * 4 + (G - 26)) * 2048 + t) * 64; }
                else if (G < 34) { dst = (bf16_t*)(prj + PRJ_OG) + (size_t)row * 256 + (G - 30) * 64; }
                else if (G < 37) { dst = (bf16_t*)(prj + PRJ_DQKV) + (size_t)row * 384 + (G - 34) * 64; ss = quad_sum(ss); if (fq == 0) part_dq[(size_t)row * 4 + (G - 34)] = ss; }
                else if (G == 37) {
                    dst = (bf16_t*)(prj + PRJ_DQKV) + (size_t)row * 384 + 192;
                    float* gt = (float*)(prj + PRJ_GATES) + (size_t)row * 32 + 8 * fq;
                    *(f32x4*)gt = (f32x4){v[1][0], v[1][1], v[1][2], v[1][3]}; *(f32x4*)(gt + 4) = (f32x4){v[1][4], v[1][5], v[1][6], v[1][7]};
                    float s0 = 0.f;
#pragma unroll
                    for (int i = 0; i < 8; ++i) s0 += v[0][i] * v[0][i];
                    s0 = quad_sum(s0); const float sc = rsqrtf(s0 * (1.f / 32.f) + 1e-6f);
                    const float* rp = rope + (size_t)row * 32 + ((8 * fq) & 15);
                    float kr[8];
#pragma unroll
                    for (int i = 0; i < 8; ++i) { const float val = v[0][i] * sc * krg[8 * fq + i]; const float oth = __shfl_xor(val, 32); const float cs = rp[i], sn = rp[16 + i]; kr[i] = fq < 2 ? val * cs - oth * sn : val * cs + oth * sn; }
                    st_bf16x8((bf16_t*)(prj + PRJ_KR) + (size_t)row * 32 + 8 * fq, kr);
                } else { dst = (bf16_t*)(prj + PRJ_DQKV) + (size_t)row * 384 + 256 + (G - 38) * 64; ss = quad_sum(ss); if (fq == 0) part_dkv[(size_t)row * 2 + (G - 38)] = ss; }
                st_bf16x8(dst + 8 * fq, v[0]); st_bf16x8(dst + bstride + 8 * fq, v[1]);
            }
    }
};

struct EpiUq {
    const float* ssq_dq; const float* qkn; const float* rope; bf16_t* QM;
    __device__ __forceinline__ void operator()(const f32x4 (&acc)[2][2][4][2], const GUnit& u, int wr, int wc, int fr, int fq) const {
        const int G = u.pn * 4 + wc; if (G >= 9) return;
        const float scale = 0.10206207261596575f;
        const float* g0 = G < 6 ? qkn + 8 * fq : qkn + 64 + 8 * (fq & 1); const float* g1 = G < 6 ? g0 + 32 : g0 + 16;
#pragma unroll
        for (int ai = 0; ai < 2; ++ai)
#pragma unroll
            for (int m = 0; m < 4; ++m) {
                __builtin_amdgcn_sched_barrier(0);
                const int row = u.pm * 256 + ai * 128 + wr * 64 + m * 16 + fr; const int b = row >> 11, t = row & 2047;
                const f32x4 pq = *(const f32x4*)(ssq_dq + (size_t)row * 4); const float rs = rsqrtf(((pq.x + pq.y) + pq.z) * (1.f / 192.f) + 1e-6f);
                float v[2][8]; float ss = 0.f;
#pragma unroll
                for (int bj = 0; bj < 2; ++bj)
#pragma unroll
                    for (int n = 0; n < 2; ++n)
#pragma unroll
                        for (int j = 0; j < 4; ++j) { const float x = acc[ai][bj][m][n][j] * rs; v[bj][4 * n + j] = x; ss += x * x; }
                if (G < 6) ss = quad_sum(ss); else ss += __shfl_xor(ss, 16);
                const float sc = rsqrtf(ss * (G < 6 ? 1.f / 64.f : 1.f / 32.f) + 1e-6f) * scale;
#pragma unroll
                for (int i = 0; i < 8; ++i) { v[0][i] *= sc * g0[i]; v[1][i] *= sc * g1[i]; }
                if (G < 6) {
                    bf16_t* dst = QM + ((size_t)(b * 6 + G) * 2048 + t) * 96;
                    st_bf16x8(dst + 8 * fq, v[0]); st_bf16x8(dst + 32 + 8 * fq, v[1]);
                } else {
                    const int i16 = 8 * (fq & 1); const int head = 2 * (G - 6) + (fq >> 1);
                    const float* rp = rope + (size_t)row * 32 + i16; float o1[8], o2[8];
#pragma unroll
                    for (int i = 0; i < 8; ++i) { const float cs = rp[i], sn = rp[16 + i]; o1[i] = v[0][i] * cs - v[1][i] * sn; o2[i] = v[1][i] * cs + v[0][i] * sn; }
                    bf16_t* dst = QM + ((size_t)(b * 6 + head) * 2048 + t) * 96 + 64 + i16;
                    st_bf16x8(dst, o1); st_bf16x8(dst + 16, o2);
                }
            }
    }
};
struct EpiUkv {
    const float* ssq_dkv; const float* qkn; const bf16_t* KR; bf16_t* KM; bf16_t* VM;
    __device__ __forceinline__ void operator()(const f32x4 (&acc)[2][2][4][2], const GUnit& u, int wr, int wc, int fr, int fq) const {
        const int G = u.pn * 4 + wc;
        const float* g0 = qkn + 96 + 8 * fq;
#pragma unroll
        for (int ai = 0; ai < 2; ++ai)
#pragma unroll
            for (int m = 0; m < 4; ++m) {
                __builtin_amdgcn_sched_barrier(0);
                const int row = u.pm * 256 + ai * 128 + wr * 64 + m * 16 + fr; const int b = row >> 11, t = row & 2047;
                const float rs = rsqrtf((ssq_dkv[(size_t)row * 2] + ssq_dkv[(size_t)row * 2 + 1]) * (1.f / 128.f) + 1e-6f);
                float v[2][8]; float ss = 0.f;
#pragma unroll
                for (int bj = 0; bj < 2; ++bj)
#pragma unroll
                    for (int n = 0; n < 2; ++n)
#pragma unroll
                        for (int j = 0; j < 4; ++j) { const float x = acc[ai][bj][m][n][j] * rs; v[bj][4 * n + j] = x; ss += x * x; }
                if (G < 6) {
                    ss = quad_sum(ss); const float sc = rsqrtf(ss * (1.f / 64.f) + 1e-6f);
#pragma unroll
                    for (int i = 0; i < 8; ++i) { v[0][i] *= sc * g0[i]; v[1][i] *= sc * g0[32 + i]; }
                    bf16_t* dst = KM + ((size_t)(b * 6 + G) * 2048 + t) * 96;
                    st_bf16x8(dst + 8 * fq, v[0]); st_bf16x8(dst + 32 + 8 * fq, v[1]);
                    *(u32x4*)(dst + 64 + 8 * fq) = *(const u32x4*)(KR + (size_t)row * 32 + 8 * fq);
                } else {
                    bf16_t* dst = VM + ((size_t)(b * 6 + (G - 6)) * 2048 + t) * 64;
                    st_bf16x8(dst + 8 * fq, v[0]); st_bf16x8(dst + 32 + 8 * fq, v[1]);
                }
            }
    }
};
#define MFMA16(a, b, c) __builtin_amdgcn_mfma_f32_16x16x32_bf16(a, b, c, 0, 0, 0)
#define MFMA32(a, b, c) __builtin_amdgcn_mfma_f32_32x32x16_bf16(a, b, c, 0, 0, 0)
#define LDS_FENCE() asm volatile("s_waitcnt lgkmcnt(0)" ::: "memory")

__device__ __forceinline__ void cmp_unit(int u, int l, InPtr in, unsigned char* ws, LAS unsigned char* lds) {
    int tid_ = threadIdx.x; asm volatile("" : "+v"(tid_));
    const int tid = tid_, w = tid >> 6, lane = tid & 63, r = lane & 15, q = lane >> 4;
    const int b = u >> 2, s = (u >> 1) & 1, hk = u & 1;
    const bf16_t* A = (const bf16_t*)(ws + WS_PRJ + (s ? PRJ_C0V : PRJ_C0K)) + (size_t)(b * 2 + hk) * 2048 * 64;
    const bf16_t* W1 = (const bf16_t*)(ws + WS_WC1) + ((size_t)l * 2 + s) * 64 * 2048;
    const bf16_t* W2 = (const bf16_t*)(ws + WS_WC2) + ((size_t)l * 2 + s) * 64 * 64;
    const float* b1 = (const float*)(ws + WS_B1C) + (l * 2 + s) * 64;
    f32x4 acc[4];
#pragma unroll
    for (int nb = 0; nb < 4; ++nb) acc[nb] = (f32x4){0.f, 0.f, 0.f, 0.f};
    const bf16_t* ap = A + (size_t)(16 * w + r) * 1024 + 8 * q;
    const bf16_t* bp = W1 + (size_t)r * 2048 + 8 * q;
#pragma unroll 4
    for (int ks = 0; ks < 64; ++ks) {
        const bf16x8 a = *(const bf16x8*)(ap + 32 * ks);
#pragma unroll
        for (int nb = 0; nb < 4; ++nb) { const bf16x8 bb = *(const bf16x8*)(bp + (size_t)nb * 16 * 2048 + 32 * ks); acc[nb] = MFMA16(a, bb, acc[nb]); }
    }
    LAS bf16_t* hl = (LAS bf16_t*)(lds + w * 2304);
#pragma unroll
    for (int nb = 0; nb < 4; ++nb) { const float bias = b1[16 * nb + r];
#pragma unroll
        for (int j = 0; j < 4; ++j) hl[(4 * q + j) * 72 + 16 * nb + r] = f2bf(siluf(acc[nb][j] + bias)); }
    LDS_FENCE();
    f32x4 o[4];
#pragma unroll
    for (int nb = 0; nb < 4; ++nb) o[nb] = (f32x4){0.f, 0.f, 0.f, 0.f};
#pragma unroll
    for (int ks = 0; ks < 2; ++ks) {
        const bf16x8 a = *(const LAS bf16x8*)(hl + r * 72 + 32 * ks + 8 * q);
#pragma unroll
        for (int nb = 0; nb < 4; ++nb) { const bf16x8 bb = *(const bf16x8*)(W2 + (size_t)(16 * nb + r) * 64 + 32 * ks + 8 * q); o[nb] = MFMA16(a, bb, o[nb]); }
    }
    LDS_FENCE();
    const float* kg = in->p[9] + l * 64;
    bf16_t* dst = (bf16_t*)(ws + WS_CMP + (s ? CMP_V : 0)) + (size_t)(b * 2 + hk) * 128 * 64;
#pragma unroll
    for (int j = 0; j < 4; ++j) {
        const int n = 16 * w + 4 * q + j; float ss = 0.f;
#pragma unroll
        for (int nb = 0; nb < 4; ++nb) ss += o[nb][j] * o[nb][j];
        ss += __shfl_xor(ss, 1); ss += __shfl_xor(ss, 2); ss += __shfl_xor(ss, 4); ss += __shfl_xor(ss, 8);
        const float sc = s == 0 ? rsqrtf(ss * (1.f / 64.f) + 1e-6f) : 1.f;
#pragma unroll
        for (int nb = 0; nb < 4; ++nb) { const int d = 16 * nb + r; const float v = o[nb][j] * sc * (s == 0 ? kg[d] : 1.f); dst[(size_t)n * 64 + d] = n < 127 ? f2bf(v) : (bf16_t)0; }
    }
}

__device__ __forceinline__ int swz_off(int row, int chunk) { return row * 128 + ((chunk ^ (row & 7)) << 4); }
__device__ __forceinline__ float log_sigmoid(float x) { return fminf(x, 0.f) - log1pf(__expf(-fabsf(x))); }
__device__ __forceinline__ void ml_delta_wave(int cu, int l, InPtr in, unsigned char* ws, LAS unsigned char* wl, int lane) {
    const int c = cu & 31, bh = cu >> 5, h = bh & 3, b = bh >> 2; const int t0 = c * 64; const size_t row0 = (size_t)b * 2048 + t0;
    const float* G = (const float*)(ws + WS_PRJ + PRJ_GATES);
    const float ip = G[(row0 + lane) * 32 + 18 + h] + in->p[12][l * 4 + h], fp = G[(row0 + lane) * 32 + 22 + h] + in->p[13][l * 4 + h];
    float bcum = log_sigmoid(fp);
#pragma unroll
    for (int o = 1; o < 64; o <<= 1) { const float t = __shfl_up(bcum, o); if (lane >= o) bcum += t; }
    const float bL = __shfl(bcum, 63); const float wgt = __expf(bL - bcum + ip);
    { float* mlg = (float*)(ws + WS_ML + ML_G) + ((size_t)bh * 2048 + t0 + lane) * 2; mlg[0] = bcum; mlg[1] = ip; if (lane == 0) ((float*)(ws + WS_ML + ML_BL))[cu] = bL; }
    const bf16_t* raw = (const bf16_t*)(ws + WS_PRJ + PRJ_RAWQK); const float* cw = in->p[11] + (size_t)l * 4 * 512;
    float wq[4], wk[4];
#pragma unroll
    for (int j = 0; j < 4; ++j) { wq[j] = cw[j * 512 + h * 64 + lane]; wk[j] = cw[j * 512 + 256 + h * 64 + lane]; }
    float q3 = 0.f, q2 = 0.f, q1 = 0.f, k3 = 0.f, k2 = 0.f, k1 = 0.f;
    if (c > 0) { const bf16_t* p = raw + (row0 - 3) * 512 + h * 64 + lane; q3 = bf2f(p[0]); q2 = bf2f(p[512]); q1 = bf2f(p[1024]); k3 = bf2f(p[256]); k2 = bf2f(p[512 + 256]); k1 = bf2f(p[1024 + 256]); }
    bf16_t* QC = (bf16_t*)(ws + WS_ML) + ((size_t)bh * 2048 + t0) * 64 + lane; bf16_t* KC = (bf16_t*)(ws + WS_ML + ML_KC) + ((size_t)bh * 2048 + t0) * 64 + lane;
    const bf16_t* V = (const bf16_t*)(ws + WS_PRJ + PRJ_VML) + ((size_t)bh * 2048 + t0) * 64 + lane;
    float dn = 0.f;
#pragma unroll
    for (int s8 = 0; s8 < 8; ++s8) {
        float kb[8], vb[8];
#pragma unroll
        for (int j = 0; j < 8; ++j) {
            const int s = s8 * 8 + j; const bf16_t* p = raw + (row0 + s) * 512 + h * 64 + lane;
            const float q0 = bf2f(p[0]), k0 = bf2f(p[256]);
            const float qv = siluf(wq[0] * q3 + wq[1] * q2 + wq[2] * q1 + wq[3] * q0), kv = siluf(wk[0] * k3 + wk[1] * k2 + wk[2] * k1 + wk[3] * k0) * 0.125f;
            q3 = q2; q2 = q1; q1 = q0; k3 = k2; k2 = k1; k1 = k0;
            const bf16_t kh = f2bf(kv); QC[(size_t)s * 64] = f2bf(qv); KC[(size_t)s * 64] = kh;
            const float ws_ = __shfl(wgt, s); kb[j] = bf2f(kh); dn += ws_ * kb[j]; vb[j] = ws_ * bf2f(V[(size_t)s * 64]);
        }
        u32x4 pk; pk.x = pk_bf16(kb[0], kb[1]); pk.y = pk_bf16(kb[2], kb[3]); pk.z = pk_bf16(kb[4], kb[5]); pk.w = pk_bf16(kb[6], kb[7]);
        *(LAS u32x4*)(wl + swz_off(lane, s8)) = pk;
        pk.x = pk_bf16(vb[0], vb[1]); pk.y = pk_bf16(vb[2], vb[3]); pk.z = pk_bf16(vb[4], vb[5]); pk.w = pk_bf16(vb[6], vb[7]);
        *(LAS u32x4*)(wl + 8192 + swz_off(lane, s8)) = pk;
    }
    ((float*)(ws + WS_ML + ML_DN))[(size_t)cu * 64 + lane] = dn;
    LDS_FENCE();
    const int r = lane & 15, q = lane >> 4;
    bf16_t* DL = (bf16_t*)(ws + WS_ML + ML_DELTA) + (size_t)cu * 4096;
#pragma unroll
    for (int mb = 0; mb < 4; ++mb) {
        f32x4 acc[4];
#pragma unroll
        for (int nb = 0; nb < 4; ++nb) acc[nb] = (f32x4){0.f, 0.f, 0.f, 0.f};
#pragma unroll
        for (int ks = 0; ks < 2; ++ks) {
            const bf16x8 a = *(const LAS bf16x8*)(wl + 8192 + swz_off(16 * mb + r, 4 * ks + q));
#pragma unroll
            for (int nb = 0; nb < 4; ++nb) { const bf16x8 bb = *(const LAS bf16x8*)(wl + swz_off(16 * nb + r, 4 * ks + q)); acc[nb] = MFMA16(a, bb, acc[nb]); }
        }
#pragma unroll
        for (int nb = 0; nb < 4; ++nb)
#pragma unroll
            for (int j = 0; j < 4; ++j) DL[(16 * mb + 4 * q + j) * 64 + 16 * nb + r] = f2bf(acc[nb][j]);
    }
    LDS_FENCE();
}

__device__ __forceinline__ void phase_prep(int l, InPtr in, unsigned char* ws, LAS unsigned char* lds, int bid, int nb) {
    asm volatile("" : "+s"(bid));
#ifndef NO_UQ
    { g8::DenseSched S{(const char*)(ws + WS_PRJ + PRJ_DQKV), (const char*)(ws + WS_WUQ) + (size_t)l * 768 * 256 * 2, 384, 256, 64, 3, nb, bid};
      EpiUq E{(const float*)(ws + WS_SSQ + PT_DQ) + (size_t)l * 16384 * 4, in->p[19] + l * 192, (const float*)(ws + WS_ROPE), (bf16_t*)(ws + WS_MLA)};
      g8::gemm_run(lds, 256, 256, S, E); }
#endif
#ifndef NO_UKV
    asm volatile("" : "+s"(bid));
    { g8::DenseSched S{(const char*)(ws + WS_PRJ + PRJ_DQKV) + 256, (const char*)(ws + WS_WUKV) + (size_t)l * 768 * 256 * 2, 384, 256, 64, 3, nb, bid};
      EpiUkv E{(const float*)(ws + WS_SSQ + PT_DKV) + (size_t)l * 16384 * 2, in->p[19] + l * 192, (const bf16_t*)(ws + WS_PRJ + PRJ_KR), (bf16_t*)(ws + WS_MLA + MLA_KM), (bf16_t*)(ws + WS_MLA + MLA_VM)};
      g8::gemm_run(lds, 256, 256, S, E); }
#endif
    __syncthreads();
#ifndef NO_CMP
    for (int u = nb - 1 - bid; u < 32; u += nb) cmp_unit(u, l, in, ws, lds);
#endif
    __syncthreads();
#ifndef NO_DELTA
    { int tid_ = threadIdx.x; asm volatile("" : "+v"(tid_));
      for (int g = bid; g < 128; g += nb) ml_delta_wave(g * 8 + (tid_ >> 6), l, in, ws, lds + (tid_ >> 6) * 16384, tid_ & 63); }
#endif
}
#define CHK_TOL(st) (((st) & 15) == 8 ? 1e-2f : 1e-3f)
#define CHECK_REST
constexpr int VTP = 136;
__device__ __forceinline__ int crow(int reg, int h) { return (reg & 3) + 8 * (reg >> 2) + 4 * h; }
struct AttnState { f32x16 o[2]; float m, l; };
__device__ __forceinline__ void attn_reset(AttnState& A) { A.m = -1e30f; A.l = 0.f;
#pragma unroll
    for (int i = 0; i < 16; ++i) { A.o[0][i] = 0.f; A.o[1][i] = 0.f; } }

template <int DK>
__device__ __forceinline__ void attn_scores(f32x16 (&s)[2], const bf16x8 (&qf)[DK / 16], const LAS unsigned char* Kt, int r, int h) {
    constexpr int KP = 2 * DK + 16;
#pragma unroll
    for (int kb = 0; kb < 2; ++kb) {
#pragma unroll
        for (int i = 0; i < 16; ++i) s[kb][i] = 0.f;
#pragma unroll
        for (int ks = 0; ks < DK / 16; ++ks) { const bf16x8 kf = *(const LAS bf16x8*)(Kt + (32 * kb + r) * KP + (16 * ks + 8 * h) * 2); s[kb] = MFMA32(kf, qf[ks], s[kb]); }
    }
}
__device__ __forceinline__ void attn_softmax_pv(AttnState& A, f32x16 (&s)[2], const LAS unsigned char* Vt, int r, int h) {
    float mx = -1e30f;
#pragma unroll
    for (int kb = 0; kb < 2; ++kb)
#pragma unroll
        for (int i = 0; i < 16; ++i) mx = fmaxf(mx, s[kb][i]);
    mx = fmaxf(mx, __shfl_xor(mx, 32));
    const float mnew = fmaxf(A.m, mx); const float mref = mnew <= -1e29f ? 0.f : mnew;
    const float alpha = __expf(A.m - mref); float rs = 0.f;
#pragma unroll
    for (int kb = 0; kb < 2; ++kb)
#pragma unroll
        for (int i = 0; i < 16; ++i) { const float p = __expf(s[kb][i] - mref); s[kb][i] = p; rs += p; }
    rs += __shfl_xor(rs, 32);
    A.l = A.l * alpha + rs; A.m = mnew;
#pragma unroll
    for (int i = 0; i < 16; ++i) { A.o[0][i] *= alpha; A.o[1][i] *= alpha; }
#pragma unroll
    for (int s4 = 0; s4 < 4; ++s4) {
        const int kb = s4 >> 1, hf = (s4 & 1) * 8;
        u32x4 pw; pw.x = pk_bf16(s[kb][hf + 0], s[kb][hf + 1]); pw.y = pk_bf16(s[kb][hf + 2], s[kb][hf + 3]); pw.z = pk_bf16(s[kb][hf + 4], s[kb][hf + 5]); pw.w = pk_bf16(s[kb][hf + 6], s[kb][hf + 7]);
        const bf16x8 pf = __builtin_bit_cast(bf16x8, pw);
#pragma unroll
        for (int eb = 0; eb < 2; ++eb) {
            const LAS unsigned char* vp = Vt + (32 * eb + r) * VTP + (16 * s4 + 4 * h) * 2;
            const u32x2 v0 = *(const LAS u32x2*)vp, v1 = *(const LAS u32x2*)(vp + 16);
            u32x4 vw; vw.x = v0.x; vw.y = v0.y; vw.z = v1.x; vw.w = v1.y;
            A.o[eb] = MFMA32(__builtin_bit_cast(bf16x8, vw), pf, A.o[eb]);
        }
    }
}
template <int DK>
__device__ __forceinline__ void stage_k_load(u32x4 (&kr)[2], const bf16_t* Kg  , int tid) {
    constexpr int CH = DK / 8;
    kr[0] = *(const u32x4*)(Kg + (size_t)(tid / CH) * DK + (tid % CH) * 8);
    if (64 * CH > 512) { const int c2 = tid + 512; if (c2 < 64 * CH) kr[1] = *(const u32x4*)(Kg + (size_t)(c2 / CH) * DK + (c2 % CH) * 8); }
}
template <int DK>
__device__ __forceinline__ void stage_k_store(const u32x4 (&kr)[2], LAS unsigned char* Kt, int tid) {
    constexpr int CH = DK / 8, KP = 2 * DK + 16;
    *(LAS u32x4*)(Kt + (tid / CH) * KP + (tid % CH) * 16) = kr[0];
    if (64 * CH > 512) { const int c2 = tid + 512; if (c2 < 64 * CH) *(LAS u32x4*)(Kt + (c2 / CH) * KP + (c2 % CH) * 16) = kr[1]; }
}
__device__ __forceinline__ u32x4 stage_v_load(const bf16_t* Vg, int tid) { return *(const u32x4*)(Vg + (size_t)(tid >> 3) * 64 + (tid & 7) * 8); }
__device__ __forceinline__ void stage_v_store(const u32x4& v, LAS unsigned char* Vt, int tid) {
    const int key = tid >> 3, e0 = (tid & 7) * 8; LAS bf16_t* p = (LAS bf16_t*)(Vt + e0 * VTP + key * 2);
    p[0] = (bf16_t)(v.x & 0xffff); p[VTP / 2] = (bf16_t)(v.x >> 16); p[2 * (VTP / 2)] = (bf16_t)(v.y & 0xffff); p[3 * (VTP / 2)] = (bf16_t)(v.y >> 16);
    p[4 * (VTP / 2)] = (bf16_t)(v.z & 0xffff); p[5 * (VTP / 2)] = (bf16_t)(v.z >> 16); p[6 * (VTP / 2)] = (bf16_t)(v.w & 0xffff); p[7 * (VTP / 2)] = (bf16_t)(v.w >> 16);
}

constexpr int MLA_KT = 0, MLA_VT = 2 * 64 * 208, MLA_LDS = MLA_VT + 2 * 64 * VTP;
__device__ __forceinline__ void mla_unit(int b, int hd, int qt, int l, unsigned char* ws, LAS unsigned char* lds) {
    int tid_ = threadIdx.x; asm volatile("" : "+v"(tid_));
    const int tid = tid_, w = tid >> 6, lane = tid & 63, r = lane & 31, h = lane >> 5;
    const size_t slab = (size_t)(b * 6 + hd) * 2048;
    const bf16_t* QM = (const bf16_t*)(ws + WS_MLA) + slab * 96; const bf16_t* KM = (const bf16_t*)(ws + WS_MLA + MLA_KM) + slab * 96; const bf16_t* VM = (const bf16_t*)(ws + WS_MLA + MLA_VM) + slab * 64;
    const int q0 = 256 * qt + 32 * w, q = q0 + r;
    bf16x8 qf[6];
#pragma unroll
    for (int ks = 0; ks < 6; ++ks) qf[ks] = *(const bf16x8*)(QM + (size_t)q * 96 + 16 * ks + 8 * h);
    AttnState A; attn_reset(A);
    const int ntile = 4 * qt + 4;
    u32x4 kr[2], vr;
    stage_k_load<96>(kr, KM, tid); vr = stage_v_load(VM, tid);
    stage_k_store<96>(kr, lds + MLA_KT, tid); stage_v_store(vr, lds + MLA_VT, tid);
    __syncthreads();
    for (int j = 0; j < ntile; ++j) {
        const int cur = j & 1;
        if (j + 1 < ntile) { stage_k_load<96>(kr, KM + (size_t)(j + 1) * 64 * 96, tid); vr = stage_v_load(VM + (size_t)(j + 1) * 64 * 64, tid); }
        if (64 * j <= q0 + 31) {
            f32x16 s[2];
            attn_scores<96>(s, qf, lds + MLA_KT + cur * 64 * 208, r, h);
            if (64 * j + 63 > q0) {
#pragma unroll
                for (int kb = 0; kb < 2; ++kb)
#pragma unroll
                    for (int i = 0; i < 16; ++i) { const int key = 64 * j + 32 * kb + crow(i, h); if (key > q) s[kb][i] = -1e30f; }
            }
            attn_softmax_pv(A, s, lds + MLA_VT + cur * 64 * VTP, r, h);
        }
        if (j + 1 < ntile) { stage_k_store<96>(kr, lds + MLA_KT + (cur ^ 1) * 64 * 208, tid); stage_v_store(vr, lds + MLA_VT + (cur ^ 1) * 64 * VTP, tid); }
        __syncthreads();
    }
    const float inv = A.l > 0.f ? 1.f / A.l : 0.f; float ss = 0.f;
    bf16_t* Y = (bf16_t*)(ws + WS_Y) + ((size_t)b * 2048 + q) * 1024 + 640 + hd * 64;
#pragma unroll
    for (int eb = 0; eb < 2; ++eb)
#pragma unroll
        for (int g4 = 0; g4 < 4; ++g4) {
            const float v0 = A.o[eb][4 * g4] * inv, v1 = A.o[eb][4 * g4 + 1] * inv, v2 = A.o[eb][4 * g4 + 2] * inv, v3 = A.o[eb][4 * g4 + 3] * inv;
            u32x2 pw; pw.x = pk_bf16(v0, v1); pw.y = pk_bf16(v2, v3);
            const float f0 = bf_lo(pw.x), f1 = bf_hi(pw.x), f2 = bf_lo(pw.y), f3 = bf_hi(pw.y); ss += (f0 * f0 + f1 * f1) + (f2 * f2 + f3 * f3);
            *(u32x2*)(Y + 32 * eb + 8 * g4 + 4 * h) = pw;
        }
    ss += __shfl_xor(ss, 32);
    if (h == 0) ((float*)(ws + WS_SSQ + PT_C))[((size_t)l * 16384 + (size_t)b * 2048 + q) * 8 + hd] = ss;
}

__device__ __forceinline__ void nsa_mask_bias(f32x16 (&sc)[2], int dq, int h, const LAS float* bl, bool sel, int lim) {
    int dd = dq - 4 * h - 63; asm volatile("" : "+v"(dd));
    const LAS float* bp = bl + dd;
#pragma unroll
    for (int kb = 0; kb < 2; ++kb)
#pragma unroll
        for (int k = 0; k < 16; ++k) { const int c = 63 - (32 * kb + (k & 3) + 8 * (k >> 2)); const int d = dd + c; sc[kb][k] = (sel && d >= 0 && d < lim) ? sc[kb][k] + bp[c] : -1e30f; }
}

constexpr int NSA_KT = 0, NSA_VT = 2 * 64 * 144, NSA_BIAS = NSA_VT + 2 * 64 * VTP, NSA_PS = NSA_BIAS + 3 * 2048 * 4, NSA_SEL = NSA_PS + 3 * 64 * 32 * 4, NSA_UNI = NSA_SEL + 256, NSA_LDS = NSA_UNI + 16;
__device__ __forceinline__ void nsa_unit(int b, int hk, int i, int l, InPtr in, unsigned char* ws, LAS unsigned char* lds) {
    int tid_ = threadIdx.x; asm volatile("" : "+v"(tid_));
    const int tid = tid_, w = tid >> 6, lane = tid & 63, r = lane & 31, h = lane >> 5;
    const bool active = w < 6; const int g = active ? (w >> 1) : 0, th = w & 1, head = hk * 3 + g;
    const int t = 64 * i + 32 * th + r, tl = 32 * th + r; const size_t row = (size_t)b * 2048 + t;
    const size_t kvslab = (size_t)(b * 2 + hk) * 2048 * 64;
    LAS float* biasl = (LAS float*)(lds + NSA_BIAS); LAS float* PS = (LAS float*)(lds + NSA_PS); LAS unsigned* SEL = (LAS unsigned*)(lds + NSA_SEL); LAS unsigned* UNI = (LAS unsigned*)(lds + NSA_UNI);
    { const float* bd = (const float*)(ws + WS_BIASD) + (size_t)hk * 3 * 2048;
#pragma unroll
      for (int k = 0; k < 12; ++k) biasl[tid + 512 * k] = bd[tid + 512 * k];
#pragma unroll
      for (int k = 0; k < 12; ++k) PS[tid + 512 * k] = 0.f;
      if (tid < 4) UNI[tid] = 0u; }
    bf16x8 qf[4];
    { const bf16_t* QN = (const bf16_t*)(ws + WS_PRJ + PRJ_QN) + ((size_t)(b * 6 + head) * 2048 + t) * 64;
#pragma unroll
      for (int ks = 0; ks < 4; ++ks) qf[ks] = *(const bf16x8*)(QN + 16 * ks + 8 * h); }
    const float* gt = (const float*)(ws + WS_PRJ + PRJ_GATES) + row * 32 + head * 3;
#define NSA_GATE(k) ({ const float* gp_ = gt; asm volatile("" : "+v"(gp_)); sigmf(gp_[k]); })
    LAS float* bl = biasl + g * 2048;
    f32x16 ot[2];
    u32x4 kr[2], vr;
    const int ntc = i >= 16 ? 2 : 1;
    { const bf16_t* KC = (const bf16_t*)(ws + WS_CMP) + (size_t)(b * 2 + hk) * 128 * 64; const bf16_t* VC = (const bf16_t*)(ws + WS_CMP + CMP_V) + (size_t)(b * 2 + hk) * 128 * 64;
      for (int T = 0; T < ntc; ++T) { stage_k_load<64>(kr, KC + T * 4096, tid); vr = stage_v_load(VC + T * 4096, tid); stage_k_store<64>(kr, lds + NSA_KT + T * 64 * 144, tid); stage_v_store(vr, lds + NSA_VT + T * 64 * VTP, tid); } }
    __syncthreads();
    {
        if (active) {
            float m = -1e30f, lsum = 0.f;
            for (int T = 0; T < ntc; ++T) {
                f32x16 sc[2]; attn_scores<64>(sc, qf, lds + NSA_KT + T * 64 * 144, r, h);
                float mx = -1e30f;
#pragma unroll
                for (int kb = 0; kb < 2; ++kb)
#pragma unroll
                    for (int k = 0; k < 16; ++k) { const int n = 64 * T + 32 * kb + crow(k, h); const int d = t - 16 * n - 31; const float x = (d >= 0 && n < 127) ? sc[kb][k] + bl[d] : -1e30f; sc[kb][k] = x; mx = fmaxf(mx, x); }
                mx = fmaxf(mx, __shfl_xor(mx, 32));
                const float mnew = fmaxf(m, mx), mref = mnew <= -1e29f ? 0.f : mnew; float rs = 0.f;
#pragma unroll
                for (int kb = 0; kb < 2; ++kb)
#pragma unroll
                    for (int k = 0; k < 16; ++k) rs += __expf(sc[kb][k] - mref);
                rs += __shfl_xor(rs, 32);
                lsum = lsum * __expf(m - mref) + rs; m = mnew;
            }
            const float mref = m <= -1e29f ? 0.f : m, inv = lsum > 0.f ? 1.f / lsum : 0.f;
#pragma unroll
            for (int k = 0; k < 16; ++k) { ot[0][k] = 0.f; ot[1][k] = 0.f; }
            float carry = 0.f;
            for (int T = 0; T < ntc; ++T) {
                f32x16 sc[2]; attn_scores<64>(sc, qf, lds + NSA_KT + T * 64 * 144, r, h);
#pragma unroll
                for (int kb = 0; kb < 2; ++kb)
#pragma unroll
                    for (int k = 0; k < 16; ++k) { const int n = 64 * T + 32 * kb + crow(k, h); const int d = t - 16 * n - 31; sc[kb][k] = (d >= 0 && n < 127) ? __expf(sc[kb][k] + bl[d] - mref) * inv : 0.f; }
                float prevL = carry;
#pragma unroll
                for (int kb = 0; kb < 2; ++kb)
#pragma unroll
                    for (int g4 = 0; g4 < 4; ++g4) {
                        const float G4 = (sc[kb][4 * g4] + sc[kb][4 * g4 + 1]) + (sc[kb][4 * g4 + 2] + sc[kb][4 * g4 + 3]); const float L = sc[kb][4 * g4 + 3];
                        const float Lo = __shfl_xor(L, 32);
                        const float add = h ? Lo : prevL;
                        prevL = Lo;
                        const int idx = T * 8 + kb * 4 + g4;
                        PS[g * 2048 + tl * 32 + 2 * idx + h] = G4 + add;
                    }
                carry = prevL;
#pragma unroll
                for (int s4 = 0; s4 < 4; ++s4) {
                    const int kb = s4 >> 1, hf = (s4 & 1) * 8;
                    u32x4 pw; pw.x = pk_bf16(sc[kb][hf + 0], sc[kb][hf + 1]); pw.y = pk_bf16(sc[kb][hf + 2], sc[kb][hf + 3]); pw.z = pk_bf16(sc[kb][hf + 4], sc[kb][hf + 5]); pw.w = pk_bf16(sc[kb][hf + 6], sc[kb][hf + 7]);
                    const bf16x8 pf = __builtin_bit_cast(bf16x8, pw);
#pragma unroll
                    for (int eb = 0; eb < 2; ++eb) {
                        const LAS unsigned char* vp = lds + NSA_VT + T * 64 * VTP + (32 * eb + r) * VTP + (16 * s4 + 4 * h) * 2;
                        const u32x2 v0 = *(const LAS u32x2*)vp, v1 = *(const LAS u32x2*)(vp + 16);
                        u32x4 vw; vw.x = v0.x; vw.y = v0.y; vw.z = v1.x; vw.w = v1.y;
                        ot[eb] = MFMA32(__builtin_bit_cast(bf16x8, vw), pf, ot[eb]);
                    }
                }
            }
            { const float gc = NSA_GATE(0);
#pragma unroll
            for (int k = 0; k < 16; ++k) { ot[0][k] *= gc; ot[1][k] *= gc; } }
        } else {
#pragma unroll
            for (int k = 0; k < 16; ++k) { ot[0][k] = 0.f; ot[1][k] = 0.f; }
        }
    }
    __syncthreads();
#ifndef NO_NSA_SEL
    {
        const int tk = tid >> 3, sg = tid & 7; float v[32];
#pragma unroll
        for (int k = 0; k < 8; ++k) { const f32x4 x0 = *(const LAS f32x4*)(PS + tk * 32 + 4 * k), x1 = *(const LAS f32x4*)(PS + 2048 + tk * 32 + 4 * k), x2 = *(const LAS f32x4*)(PS + 4096 + tk * 32 + 4 * k);
            v[4 * k] = (x0.x + x1.x) + x2.x; v[4 * k + 1] = (x0.y + x1.y) + x2.y; v[4 * k + 2] = (x0.z + x1.z) + x2.z; v[4 * k + 3] = (x0.w + x1.w) + x2.w; }
#pragma unroll
        for (int s = 0; s < 32; ++s) { const bool forced = (s == 0) || (s == i) || (s == i - 1); float x = forced ? v[s] + 1e4f : v[s]; v[s] = s > i ? -1.f : x; }
        unsigned bits = 0u;
#pragma unroll
        for (int k = 0; k < 4; ++k) {
            float x = 0.f;
#pragma unroll
            for (int s = 0; s < 32; ++s) x = (s == 4 * sg + k) ? v[s] : x;
            int rank = 0;
#pragma unroll
            for (int s = 0; s < 32; ++s) rank += (v[s] > x || (v[s] == x && s < 4 * sg + k)) ? 1 : 0;
            if (rank < 16 && x >= 0.f) bits |= 1u << (4 * sg + k);
        }
        bits |= __shfl_xor(bits, 1); bits |= __shfl_xor(bits, 2); bits |= __shfl_xor(bits, 4);
        if (sg == 0) { SEL[tk] = bits; __hip_atomic_fetch_or(UNI, bits, __ATOMIC_RELAXED, __HIP_MEMORY_SCOPE_WORKGROUP); __hip_atomic_fetch_or(UNI + 1 + (tk >> 5), bits, __ATOMIC_RELAXED, __HIP_MEMORY_SCOPE_WORKGROUP); }
    }
#endif
    __syncthreads();
    const unsigned selbits = SEL[tl], uni = UNI[0], unih = UNI[1 + th];
    const float c31 = bl[2047];
#ifndef NO_NSA_SLC
    {
        AttnState A; attn_reset(A);
        const bf16_t* KS = (const bf16_t*)(ws + WS_PRJ + PRJ_KN1) + kvslab; const bf16_t* VS = (const bf16_t*)(ws + WS_PRJ + PRJ_VN1) + kvslab;
        unsigned todo = uni; int cur = 0;
        int s = __ffs(todo) - 1; todo &= todo - 1;
        stage_k_load<64>(kr, KS + (size_t)s * 4096, tid); vr = stage_v_load(VS + (size_t)s * 4096, tid);
        stage_k_store<64>(kr, lds + NSA_KT, tid); stage_v_store(vr, lds + NSA_VT, tid);
        __syncthreads();
        while (s >= 0) {
            const int sn = todo ? __ffs(todo) - 1 : -1; todo &= todo - 1;
            if (sn >= 0) { stage_k_load<64>(kr, KS + (size_t)sn * 4096, tid); vr = stage_v_load(VS + (size_t)sn * 4096, tid); }
            if (active && ((unih >> s) & 1u)) {
                f32x16 sc[2];
                attn_scores<64>(sc, qf, lds + NSA_KT + cur * 64 * 144, r, h);
                const bool sel = (selbits >> s) & 1u;
                if (i - s >= 3) {
#pragma unroll
                    for (int kb = 0; kb < 2; ++kb)
#pragma unroll
                        for (int k = 0; k < 16; ++k) sc[kb][k] = sel ? sc[kb][k] + c31 : -1e30f;
                } else nsa_mask_bias(sc, t - 64 * s, h, bl, sel, 4096);
                attn_softmax_pv(A, sc, lds + NSA_VT + cur * 64 * VTP, r, h);
            }
            if (sn >= 0) { stage_k_store<64>(kr, lds + NSA_KT + (cur ^ 1) * 64 * 144, tid); stage_v_store(vr, lds + NSA_VT + (cur ^ 1) * 64 * VTP, tid); }
            __syncthreads();
            s = sn; cur ^= 1;
        }
        const float gs = NSA_GATE(1); const float inv = A.l > 0.f ? gs / A.l : 0.f;
#pragma unroll
        for (int k = 0; k < 16; ++k) { ot[0][k] += A.o[0][k] * inv; ot[1][k] += A.o[1][k] * inv; }
    }
#endif
#ifndef NO_NSA_WIN
    {
        AttnState A; attn_reset(A);
        const bf16_t* KW = (const bf16_t*)(ws + WS_PRJ + PRJ_KN2) + kvslab; const bf16_t* VW = (const bf16_t*)(ws + WS_PRJ + PRJ_VN2) + kvslab;
        const int j0 = i > 8 ? i - 8 : 0; int cur = 0;
        stage_k_load<64>(kr, KW + (size_t)j0 * 4096, tid); vr = stage_v_load(VW + (size_t)j0 * 4096, tid);
        stage_k_store<64>(kr, lds + NSA_KT, tid); stage_v_store(vr, lds + NSA_VT, tid);
        __syncthreads();
        for (int j = j0; j <= i; ++j) {
            if (j < i) { stage_k_load<64>(kr, KW + (size_t)(j + 1) * 4096, tid); vr = stage_v_load(VW + (size_t)(j + 1) * 4096, tid); }
            if (active) {
                f32x16 sc[2];
                attn_scores<64>(sc, qf, lds + NSA_KT + cur * 64 * 144, r, h);
                if (i - j >= 3 && j > i - 8) {
#pragma unroll
                    for (int kb = 0; kb < 2; ++kb)
#pragma unroll
                        for (int k = 0; k < 16; ++k) sc[kb][k] += c31;
                } else nsa_mask_bias(sc, t - 64 * j, h, bl, true, 512);
                attn_softmax_pv(A, sc, lds + NSA_VT + cur * 64 * VTP, r, h);
            }
            if (j < i) { stage_k_store<64>(kr, lds + NSA_KT + (cur ^ 1) * 64 * 144, tid); stage_v_store(vr, lds + NSA_VT + (cur ^ 1) * 64 * VTP, tid); }
            __syncthreads();
            cur ^= 1;
        }
        const float gw = NSA_GATE(2); const float inv = A.l > 0.f ? gw / A.l : 0.f;
#pragma unroll
        for (int k = 0; k < 16; ++k) { ot[0][k] += A.o[0][k] * inv; ot[1][k] += A.o[1][k] * inv; }
    }
#endif
    if (active) {
        float ss = 0.f; bf16_t* Y = (bf16_t*)(ws + WS_Y) + row * 1024 + head * 64;
#pragma unroll
        for (int eb = 0; eb < 2; ++eb)
#pragma unroll
            for (int g4 = 0; g4 < 4; ++g4) {
                u32x2 pw; pw.x = pk_bf16(ot[eb][4 * g4], ot[eb][4 * g4 + 1]); pw.y = pk_bf16(ot[eb][4 * g4 + 2], ot[eb][4 * g4 + 3]);
                const float f0 = bf_lo(pw.x), f1 = bf_hi(pw.x), f2 = bf_lo(pw.y), f3 = bf_hi(pw.y); ss += (f0 * f0 + f1 * f1) + (f2 * f2 + f3 * f3);
                *(u32x2*)(Y + 32 * eb + 8 * g4 + 4 * h) = pw;
            }
        ss += __shfl_xor(ss, 32);
        if (h == 0) ((float*)(ws + WS_SSQ + PT_A))[((size_t)l * 16384 + row) * 8 + head] = ss;
    }
}

__device__ __forceinline__ void ml_out_wave(int cu, int l, InPtr in, unsigned char* ws, LAS unsigned char* wl, LAS unsigned char* npl, int lane) {
    const int c = cu & 31, bh = cu >> 5, hd = bh & 3, b = bh >> 2; const int t0 = c * 64; const int r = lane & 15, q = lane >> 4;
    const bf16_t* QC = (const bf16_t*)(ws + WS_ML) + ((size_t)bh * 2048 + t0) * 64; const bf16_t* KC = (const bf16_t*)(ws + WS_ML + ML_KC) + ((size_t)bh * 2048 + t0) * 64;
    const bf16_t* V = (const bf16_t*)(ws + WS_PRJ + PRJ_VML) + ((size_t)bh * 2048 + t0) * 64;
    const float* mlg = (const float*)(ws + WS_ML + ML_G) + ((size_t)bh * 2048 + t0) * 2;
    const bf16_t* CP = (const bf16_t*)(ws + WS_ML + ML_CP) + (size_t)cu * 4096; const bf16_t* NP = (const bf16_t*)(ws + WS_ML + ML_NP) + (size_t)cu * 64;
    bf16x8 aq[4][2];
#pragma unroll
    for (int mb = 0; mb < 4; ++mb)
#pragma unroll
        for (int ks = 0; ks < 2; ++ks) aq[mb][ks] = *(const bf16x8*)(QC + (size_t)(16 * mb + r) * 64 + 32 * ks + 8 * q);
    float bj[4][4], den[4][4];
#pragma unroll
    for (int mb = 0; mb < 4; ++mb)
#pragma unroll
        for (int j = 0; j < 4; ++j) bj[mb][j] = mlg[(16 * mb + 4 * q + j) * 2];
    {
        float cs[4];
#pragma unroll
        for (int nb = 0; nb < 4; ++nb) { const float2 gg = *(const float2*)(mlg + (16 * nb + r) * 2); cs[nb] = gg.y - gg.x; }
#pragma unroll
        for (int mb = 0; mb < 4; ++mb) {
            f32x4 accS[4];
#pragma unroll
            for (int nb = 0; nb < 4; ++nb) { accS[nb] = (f32x4){0.f, 0.f, 0.f, 0.f};
#pragma unroll
                for (int ks = 0; ks < 2; ++ks) { const bf16x8 bk = *(const bf16x8*)(KC + (size_t)(16 * nb + r) * 64 + 32 * ks + 8 * q); accS[nb] = MFMA16(aq[mb][ks], bk, accS[nb]); } }
#pragma unroll
            for (int j = 0; j < 4; ++j) {
                const int jj = 16 * mb + 4 * q + j; float rs = 0.f;
#pragma unroll
                for (int nb = 0; nb < 4; ++nb) { const int s = 16 * nb + r; const float p = s <= jj ? accS[nb][j] * __expf(bj[mb][j] + cs[nb]) : 0.f; rs += p;
                    *(LAS bf16_t*)(wl + 8192 + swz_off(jj, s >> 3) + (s & 7) * 2) = f2bf(p); }
                rs += __shfl_xor(rs, 1); rs += __shfl_xor(rs, 2); rs += __shfl_xor(rs, 4); rs += __shfl_xor(rs, 8);
                den[mb][j] = rs;
            }
        }
    }
#pragma unroll
    for (int mb = 0; mb < 4; ++mb) { const float e = __expf(mlg[(16 * mb + r) * 2]);
#pragma unroll
        for (int ks = 0; ks < 2; ++ks) { const u32x4 x = __builtin_bit_cast(u32x4, aq[mb][ks]); u32x4 y;
            y.x = pk_bf16(bf_lo(x.x) * e, bf_hi(x.x) * e); y.y = pk_bf16(bf_lo(x.y) * e, bf_hi(x.y) * e); y.z = pk_bf16(bf_lo(x.z) * e, bf_hi(x.z) * e); y.w = pk_bf16(bf_lo(x.w) * e, bf_hi(x.w) * e);
            aq[mb][ks] = __builtin_bit_cast(bf16x8, y); } }
    f32x4 acc[4][4], accn[4];
#pragma unroll
    for (int mb = 0; mb < 4; ++mb) { accn[mb] = (f32x4){0.f, 0.f, 0.f, 0.f};
#pragma unroll
        for (int nb = 0; nb < 4; ++nb) acc[mb][nb] = (f32x4){0.f, 0.f, 0.f, 0.f}; }
#pragma unroll
    for (int ks = 0; ks < 2; ++ks) {
        u32x4 nz = *(const u32x4*)(NP + 32 * ks + 8 * q); if (r != 0) nz = (u32x4){0u, 0u, 0u, 0u};
        const bf16x8 bn = __builtin_bit_cast(bf16x8, nz);
#pragma unroll
        for (int nb = 0; nb < 4; ++nb) { const bf16x8 bb = *(const bf16x8*)(CP + (size_t)(16 * nb + r) * 64 + 32 * ks + 8 * q);
#pragma unroll
            for (int mb = 0; mb < 4; ++mb) acc[mb][nb] = MFMA16(aq[mb][ks], bb, acc[mb][nb]); }
#pragma unroll
        for (int mb = 0; mb < 4; ++mb) accn[mb] = MFMA16(aq[mb][ks], bn, accn[mb]);
    }
#pragma unroll
    for (int s8 = 0; s8 < 8; ++s8) { float vb[8];
#pragma unroll
        for (int j = 0; j < 8; ++j) vb[j] = bf2f(V[(size_t)(s8 * 8 + j) * 64 + lane]);
        u32x4 pk; pk.x = pk_bf16(vb[0], vb[1]); pk.y = pk_bf16(vb[2], vb[3]); pk.z = pk_bf16(vb[4], vb[5]); pk.w = pk_bf16(vb[6], vb[7]);
        *(LAS u32x4*)(wl + swz_off(lane, s8)) = pk; }
    LDS_FENCE();
#pragma unroll
    for (int ks = 0; ks < 2; ++ks) {
        bf16x8 ap[4];
#pragma unroll
        for (int mb = 0; mb < 4; ++mb) ap[mb] = *(const LAS bf16x8*)(wl + 8192 + swz_off(16 * mb + r, 4 * ks + q));
#pragma unroll
        for (int nb = 0; nb < 4; ++nb) { const bf16x8 bv = *(const LAS bf16x8*)(wl + swz_off(16 * nb + r, 4 * ks + q));
#pragma unroll
            for (int mb = 0; mb < 4; ++mb) acc[mb][nb] = MFMA16(ap[mb], bv, acc[mb][nb]); }
    }
    LDS_FENCE();
    const float* gain = in->p[14] + l * 256 + hd * 64; const bf16_t* OG = (const bf16_t*)(ws + WS_PRJ + PRJ_OG);
    bf16_t* Y = (bf16_t*)(ws + WS_Y);
#pragma unroll
    for (int mb = 0; mb < 4; ++mb)
#pragma unroll
        for (int j = 0; j < 4; ++j) {
            const int jj = 16 * mb + 4 * q + j;
            const float dn = den[mb][j] + __shfl(accn[mb][j], lane & 48);
            const float inv = 1.f / fmaxf(fabsf(dn), 1.f); float hv[4]; float ss = 0.f;
#pragma unroll
            for (int nb = 0; nb < 4; ++nb) { hv[nb] = acc[mb][nb][j] * inv; ss += hv[nb] * hv[nb]; }
            ss += __shfl_xor(ss, 1); ss += __shfl_xor(ss, 2); ss += __shfl_xor(ss, 4); ss += __shfl_xor(ss, 8);
            const float rstd = rsqrtf(ss * (1.f / 64.f) + 1e-6f); const size_t row = (size_t)b * 2048 + t0 + jj;
#pragma unroll
            for (int nb = 0; nb < 4; ++nb) { const int e = 16 * nb + r; Y[row * 1024 + 384 + hd * 64 + e] = f2bf(hv[nb] * rstd * gain[e] * sigmf(bf2f(OG[row * 256 + hd * 64 + e]))); }
        }
}

__device__ __forceinline__ void ml_scan_unit(int bh, int l, unsigned char* ws) {
    int tid_ = threadIdx.x; asm volatile("" : "+v"(tid_)); const int tid = tid_;
    const bf16_t* DL = (const bf16_t*)(ws + WS_ML + ML_DELTA) + (size_t)bh * 32 * 4096 + tid * 8; bf16_t* CP = (bf16_t*)(ws + WS_ML + ML_CP) + (size_t)bh * 32 * 4096 + tid * 8;
    const float* DN = (const float*)(ws + WS_ML + ML_DN) + (size_t)bh * 32 * 64; bf16_t* NP = (bf16_t*)(ws + WS_ML + ML_NP) + (size_t)bh * 32 * 64; const float* BL = (const float*)(ws + WS_ML + ML_BL) + bh * 32;
    float c[8]; float n = 0.f;
#pragma unroll
    for (int k = 0; k < 8; ++k) c[k] = 0.f;
#pragma unroll 1
    for (int c0 = 0; c0 < 32; c0 += 8) {
        u32x4 d[8]; float dn[8], co[8];
#pragma unroll
        for (int k = 0; k < 8; ++k) { d[k] = *(const u32x4*)(DL + (size_t)(c0 + k) * 4096); dn[k] = tid < 64 ? DN[(c0 + k) * 64 + tid] : 0.f; co[k] = __expf(BL[c0 + k]); }
#pragma unroll
        for (int k = 0; k < 8; ++k) {
            u32x4 o; o.x = pk_bf16(c[0], c[1]); o.y = pk_bf16(c[2], c[3]); o.z = pk_bf16(c[4], c[5]); o.w = pk_bf16(c[6], c[7]);
            *(u32x4*)(CP + (size_t)(c0 + k) * 4096) = o; if (tid < 64) NP[(c0 + k) * 64 + tid] = f2bf(n);
            c[0] = co[k] * c[0] + bf_lo(d[k].x); c[1] = co[k] * c[1] + bf_hi(d[k].x); c[2] = co[k] * c[2] + bf_lo(d[k].y); c[3] = co[k] * c[3] + bf_hi(d[k].y);
            c[4] = co[k] * c[4] + bf_lo(d[k].z); c[5] = co[k] * c[5] + bf_hi(d[k].z); c[6] = co[k] * c[6] + bf_lo(d[k].w); c[7] = co[k] * c[7] + bf_hi(d[k].w);
            n = co[k] * n + dn[k];
        }
    }
    asm volatile("s_waitcnt vmcnt(0)" ::: "memory"); __syncthreads();
    if (tid == 0) { __builtin_amdgcn_fence(__ATOMIC_RELEASE, "agent"); asm volatile("s_waitcnt vmcnt(0)" ::: "memory");
        __hip_atomic_fetch_add((unsigned*)(ws + WS_CTL) + CW_SCAN + 64 * l, 1u, __ATOMIC_RELAXED, __HIP_MEMORY_SCOPE_AGENT); }
}
__device__ __forceinline__ void ml_scan_wait(int l, unsigned char* ws) {
    if (threadIdx.x == 0) { unsigned* p = (unsigned*)(ws + WS_CTL) + CW_SCAN + 64 * l; unsigned sp = 0;
        while (__hip_atomic_load(p, __ATOMIC_RELAXED, __HIP_MEMORY_SCOPE_AGENT) < 32u) { __builtin_amdgcn_s_sleep(2); if (++sp > (1u << 22)) break; }
        __builtin_amdgcn_fence(__ATOMIC_ACQUIRE, "agent"); asm volatile("s_waitcnt vmcnt(0)" ::: "memory"); }
    __syncthreads();
}

#ifndef DUP_NSA
#define DUP_NSA 1
#endif
#ifndef DUP_MLA
#define DUP_MLA 1
#endif
#ifndef DUP_ML
#define DUP_ML 1
#endif
#ifdef NO_MLA
#define MLA_CALL(...) do {} while (0)
#else
#define MLA_CALL(...) do { for (int rp = 0; rp < DUP_MLA; ++rp) { if (rp) __syncthreads(); mla_unit(__VA_ARGS__); } } while (0)
#endif
__device__ __forceinline__ void phase_mix(int l, InPtr in, unsigned char* ws, LAS unsigned char* lds, unsigned* qhead) {
    LAS int* slot = (LAS int*)(lds + LDS_MISC + 64);
    for (;;) {
        __syncthreads();
        if (threadIdx.x == 0) *slot = (int)__hip_atomic_fetch_add(qhead, 1u, __ATOMIC_RELAXED, __HIP_MEMORY_SCOPE_AGENT);
        __syncthreads();
        int u = *slot;
        if (u >= 32 + 512 + 384 + 128) break;
        if (u < 32) { ml_scan_unit(u, l, ws); continue; } u -= 32;
#ifndef NO_NSA
        if (u < 256) { const int i = 31 - (u >> 4), bh = u & 15; { for (int rp = 0; rp < DUP_NSA; ++rp) { if (rp) __syncthreads(); nsa_unit(bh >> 1, bh & 1, i, l, in, ws, lds); } } continue; }
#endif
        u -= 256;
        if (u < 192) { const int qt = 7 - u / 48, bh = u % 48; MLA_CALL(bh / 6, bh % 6, qt, l, ws, lds); continue; }
        u -= 192;
#ifndef NO_NSA
        if (u < 128) { const int i = 15 - (u >> 4), bh = u & 15; { for (int rp = 0; rp < DUP_NSA; ++rp) { if (rp) __syncthreads(); nsa_unit(bh >> 1, bh & 1, i, l, in, ws, lds); } } continue; }
#endif
        u -= 128;
        if (u < 192) { const int qt = 3 - u / 48, bh = u % 48; MLA_CALL(bh / 6, bh % 6, qt, l, ws, lds); continue; } u -= 192;
#ifndef NO_NSA
        if (u < 128) { const int i = 7 - (u >> 4), bh = u & 15; { for (int rp = 0; rp < DUP_NSA; ++rp) { if (rp) __syncthreads(); nsa_unit(bh >> 1, bh & 1, i, l, in, ws, lds); } } continue; }
#endif
        u -= 128;
#ifndef NO_MLOUT
        ml_scan_wait(l, ws);
        for (int rp = 0; rp < DUP_ML; ++rp) { int tid_ = threadIdx.x; asm volatile("" : "+v"(tid_)); const int w = tid_ >> 6; ml_out_wave(u * 8 + w, l, in, ws, lds + w * 16384, lds + 131072 + w * 256, tid_ & 63); }
#endif
    }
}
__device__ __forceinline__ void phase_ynorm(int l, unsigned char* ws, int bid, int nb) {
    int tid_ = threadIdx.x; asm volatile("" : "+v"(tid_)); const int w = tid_ >> 6, lane = tid_ & 63;
    bf16_t* Y = (bf16_t*)(ws + WS_Y); const float* sa = (const float*)(ws + WS_SSQ + PT_A) + (size_t)l * 16384 * 8; const float* sc = (const float*)(ws + WS_SSQ + PT_C) + (size_t)l * 16384 * 8;
    for (int row = bid * 8 + w; row < NTOK; row += nb * 8) {
        if (lane < 48) {
            const f32x4 a0 = *(const f32x4*)(sa + (size_t)row * 8), a1 = *(const f32x4*)(sa + (size_t)row * 8 + 4), c0 = *(const f32x4*)(sc + (size_t)row * 8), c1 = *(const f32x4*)(sc + (size_t)row * 8 + 4);
            const float ra = rsqrtf((((a0.x + a0.y) + (a0.z + a0.w)) + (a1.x + a1.y)) * (1.f / 384.f) + 1e-6f), rc = rsqrtf((((c0.x + c0.y) + (c0.z + c0.w)) + (c1.x + c1.y)) * (1.f / 384.f) + 1e-6f);
            u32x4* pa = (u32x4*)(Y + (size_t)row * 1024) + lane; u32x4* pc = (u32x4*)(Y + (size_t)row * 1024 + 640) + lane;
            u32x4 x = *pa, y = *pc;
            x.x = pk_bf16(bf_lo(x.x) * ra, bf_hi(x.x) * ra); x.y = pk_bf16(bf_lo(x.y) * ra, bf_hi(x.y) * ra); x.z = pk_bf16(bf_lo(x.z) * ra, bf_hi(x.z) * ra); x.w = pk_bf16(bf_lo(x.w) * ra, bf_hi(x.w) * ra);
            y.x = pk_bf16(bf_lo(y.x) * rc, bf_hi(y.x) * rc); y.y = pk_bf16(bf_lo(y.y) * rc, bf_hi(y.y) * rc); y.z = pk_bf16(bf_lo(y.z) * rc, bf_hi(y.z) * rc); y.w = pk_bf16(bf_lo(y.w) * rc, bf_hi(y.w) * rc);
            *pa = x; *pc = y;
        }
    }
}
struct EpiOut {
    bf16_t* XB; float* ssq;
    __device__ __forceinline__ void operator()(const f32x4 (&acc)[2][2][4][2], const GUnit& u, int wr, int wc, int fr, int fq) const {
#pragma unroll
        for (int ai = 0; ai < 2; ++ai)
#pragma unroll
            for (int m = 0; m < 4; ++m) {
                __builtin_amdgcn_sched_barrier(0);
                const int row = u.pm * 256 + ai * 128 + wr * 64 + m * 16 + fr; float ss = 0.f;
#pragma unroll
                for (int bj = 0; bj < 2; ++bj) {
                    u32x4* p = (u32x4*)(XB + (size_t)row * 1024 + u.pn * 256 + bj * 128 + wc * 32 + 8 * fq); const u32x4 x = *p; u32x4 o;
                    o.x = pk_bf16(bf_lo(x.x) + acc[ai][bj][m][0][0], bf_hi(x.x) + acc[ai][bj][m][0][1]); o.y = pk_bf16(bf_lo(x.y) + acc[ai][bj][m][0][2], bf_hi(x.y) + acc[ai][bj][m][0][3]);
                    o.z = pk_bf16(bf_lo(x.z) + acc[ai][bj][m][1][0], bf_hi(x.z) + acc[ai][bj][m][1][1]); o.w = pk_bf16(bf_lo(x.w) + acc[ai][bj][m][1][2], bf_hi(x.w) + acc[ai][bj][m][1][3]);
                    *p = o;
                    ss += (bf_lo(o.x) * bf_lo(o.x) + bf_hi(o.x) * bf_hi(o.x)) + (bf_lo(o.y) * bf_lo(o.y) + bf_hi(o.y) * bf_hi(o.y)) + (bf_lo(o.z) * bf_lo(o.z) + bf_hi(o.z) * bf_hi(o.z)) + (bf_lo(o.w) * bf_lo(o.w) + bf_hi(o.w) * bf_hi(o.w));
                }
                ss = quad_sum(ss); if (fq == 0) ssq[(size_t)row * 16 + u.pn * 4 + wc] = ss;
            }
    }
};

__device__ __forceinline__ float sum16(const float* p) { const f32x4 a = *(const f32x4*)p, b = *(const f32x4*)(p + 4), c = *(const f32x4*)(p + 8), d = *(const f32x4*)(p + 12);
    return (((a.x + a.y) + (a.z + a.w)) + ((b.x + b.y) + (b.z + b.w))) + (((c.x + c.y) + (c.z + c.w)) + ((d.x + d.y) + (d.z + d.w))); }
__device__ __forceinline__ void phase_route(int l, InPtr in, unsigned char* ws, LAS unsigned char* lds, int bid, int nb) {
    int tid_ = threadIdx.x; asm volatile("" : "+v"(tid_)); const int w = tid_ >> 6, lane = tid_ & 63, r = lane & 15, q = lane >> 4;
    const bf16_t* XB = (const bf16_t*)(ws + WS_XB); const bf16_t* WR = (const bf16_t*)(ws + WS_WR) + (size_t)l * 64 * 1024;
    const float* ssq = (const float*)(ws + WS_SSQ + PT_X1) + (size_t)l * 16384 * 16; const float* bg = in->p[24] + l * 4; const float* be = in->p[26] + l * 32;
    unsigned* cnt = (unsigned*)(ws + WS_CTL) + CW_CNT + 64 * l; unsigned* mtok = (unsigned*)(ws + WS_META); float* mw = (float*)(ws + WS_META + META_W);
    LAS float* lg = (LAS float*)(lds + w * 4096);
    for (int g = bid * 8 + w; g < NTOK / 16; g += nb * 8) {
        const int tok0 = g * 16; f32x4 acc[3];
#pragma unroll
        for (int n = 0; n < 3; ++n) acc[n] = (f32x4){0.f, 0.f, 0.f, 0.f};
        const bf16_t* ap = XB + (size_t)(tok0 + r) * 1024 + 8 * q; const bf16_t* bp = WR + (size_t)r * 1024 + 8 * q;
#pragma unroll 4
        for (int ks = 0; ks < 32; ++ks) { const bf16x8 a = *(const bf16x8*)(ap + 32 * ks);
#pragma unroll
            for (int n = 0; n < 3; ++n) { const bf16x8 bb = *(const bf16x8*)(bp + (size_t)n * 16 * 1024 + 32 * ks); acc[n] = MFMA16(a, bb, acc[n]); } }
#pragma unroll
        for (int n = 0; n < 3; ++n)
#pragma unroll
            for (int j = 0; j < 4; ++j) lg[(4 * q + j) * 48 + 16 * n + r] = acc[n][j];
        LDS_FENCE();
        if (lane < 16) {
            const int tok = tok0 + lane; const float rs = rsqrtf(sum16(ssq + (size_t)tok * 16) * (1.f / 1024.f) + 1e-6f); ((float*)(ws + WS_RS2))[tok] = rs; const LAS float* L = lg + lane * 48;
            float gl[4]; int gi = 0;
#pragma unroll
            for (int j = 0; j < 4; ++j) gl[j] = L[j] * rs + bg[j];
            float gm = gl[0];
#pragma unroll
            for (int j = 1; j < 4; ++j) if (gl[j] > gm) { gm = gl[j]; gi = j; }
            float gsum = 0.f;
#pragma unroll
            for (int j = 0; j < 4; ++j) gsum += __expf(gl[j] - gm);
            const float gtop = 1.f / gsum;
            float el[8];
#pragma unroll
            for (int j = 0; j < 8; ++j) el[j] = L[4 + gi * 8 + j] * rs + be[gi * 8 + j];
            int e0 = 0; float v0 = el[0];
#pragma unroll
            for (int j = 1; j < 8; ++j) if (el[j] > v0) { v0 = el[j]; e0 = j; }
            int e1 = -1; float v1 = -3.0e38f;
#pragma unroll
            for (int j = 0; j < 8; ++j) if (j != e0 && el[j] > v1) { v1 = el[j]; e1 = j; }
            const float w0 = 1.f / (1.f + __expf(v1 - v0)); const int E0 = gi * 8 + e0, E1 = gi * 8 + e1;
            const unsigned p0 = atomicAdd(cnt + E0, 1u), p1 = atomicAdd(cnt + E1, 1u);
            mtok[(size_t)E0 * 16384 + p0] = (unsigned)tok; mw[(size_t)E0 * 16384 + p0] = w0 * gtop;
            mtok[(size_t)E1 * 16384 + p1] = (unsigned)tok | 0x80000000u; mw[(size_t)E1 * 16384 + p1] = (1.f - w0) * gtop;
        }
        LDS_FENCE();
    }
}

constexpr int LDS_TB = 131072 + 2048;
__device__ __forceinline__ void moe_tables(int l, unsigned char* ws, LAS unsigned char* lds) {
    if (threadIdx.x == 0) { const unsigned* cnt = (const unsigned*)(ws + WS_CTL) + CW_CNT + 64 * l; LAS int* tb = (LAS int*)(lds + LDS_TB); int acc = 0;
        for (int e = 0; e < 32; ++e) { tb[e] = acc; acc += ((int)__hip_atomic_load(cnt + e, __ATOMIC_RELAXED, __HIP_MEMORY_SCOPE_AGENT) + 255) >> 8; } tb[32] = acc; }
    __syncthreads();
}
template <int NPN, bool GATHER_>
struct MoeSched {
    static constexpr bool GATHER = GATHER_;
    const char* A; const char* Bt; const unsigned* cnt; const unsigned* mtok; const LAS int* tb; int G, c; size_t bstride_e  , bstride_pn;
    __device__ __forceinline__ bool next(int i, GUnit& u) const {
        const int L = i * G + c; const int ntile = tb[32]; if (L >= ntile * NPN) return false;
        const int tile = L / NPN, pn = L % NPN; int e = 0;
        for (int k = 1; k < 32; ++k) e = (tb[k] <= tile) ? k : e;
        e = __builtin_amdgcn_readfirstlane(e);
        u.e = e; u.pm = tile; u.pn = pn; u.rows = (int)__hip_atomic_load(cnt + e, __ATOMIC_RELAXED, __HIP_MEMORY_SCOPE_AGENT) - 256 * (tile - tb[e]);
        u.a = GATHER ? A : A + (size_t)tile * 256 * 256 * 2;
        u.b = Bt + (size_t)e * bstride_e + (size_t)pn * bstride_pn; return true;
    }
    __device__ __forceinline__ void aoff(const GUnit& u, unsigned (&v)[2][2], const int (&R)[2], const int (&C)[2]) const {
#pragma unroll
        for (int h = 0; h < 2; ++h)
#pragma unroll
            for (int i = 0; i < 2; ++i) {
                if (GATHER) { const int lr = h * 128 + R[i]; const int rr = 256 * (u.pm - tb[u.e]) + (lr < u.rows ? lr : 0); const unsigned tok = mtok[(size_t)u.e * 16384 + rr] & 0x7fffffffu; v[h][i] = (tok * 1024u + (unsigned)C[i]) * 2u; }
                else v[h][i] = (unsigned)((h * 128 + R[i]) * 256 + C[i]) * 2u;
            }
    }
};
struct EpiMoeUp {
    const unsigned* mtok; const float* ssq; const LAS int* tb; bf16_t* HB;
    __device__ __forceinline__ void operator()(const f32x4 (&acc)[2][2][4][2], const GUnit& u, int wr, int wc, int fr, int fq) const {
        const int r0 = 256 * (u.pm - tb[u.e]);
#pragma unroll
        for (int ai = 0; ai < 2; ++ai)
#pragma unroll
            for (int m = 0; m < 4; ++m) {
                __builtin_amdgcn_sched_barrier(0);
                const int lr = ai * 128 + wr * 64 + m * 16 + fr;
                if (lr < u.rows) {
                    const unsigned tok = mtok[(size_t)u.e * 16384 + r0 + lr] & 0x7fffffffu; const float rs = ssq[tok];
                    float hv[8];
#pragma unroll
                    for (int n = 0; n < 2; ++n)
#pragma unroll
                        for (int j = 0; j < 4; ++j) { const float gv = acc[ai][0][m][n][j] * rs, uv = acc[ai][1][m][n][j] * rs; hv[4 * n + j] = siluf(gv) * uv; }
                    st_bf16x8(HB + ((size_t)u.pm * 256 + lr) * 256 + u.pn * 128 + wc * 32 + 8 * fq, hv);
                }
            }
    }
};
struct EpiMoeDown {
    const unsigned* mtok; const float* mw; const LAS int* tb; bf16_t* YB;
    __device__ __forceinline__ void operator()(const f32x4 (&acc)[2][2][4][2], const GUnit& u, int wr, int wc, int fr, int fq) const {
        const int r0 = 256 * (u.pm - tb[u.e]);
#pragma unroll
        for (int ai = 0; ai < 2; ++ai)
#pragma unroll
            for (int m = 0; m < 4; ++m) {
                __builtin_amdgcn_sched_barrier(0);
                const int lr = ai * 128 + wr * 64 + m * 16 + fr;
                if (lr < u.rows) {
                    const unsigned mt = mtok[(size_t)u.e * 16384 + r0 + lr]; const float wt = mw[(size_t)u.e * 16384 + r0 + lr];
                    bf16_t* dst = YB + ((size_t)(mt >> 31) * 16384 + (mt & 0x7fffffffu)) * 1024 + u.pn * 256 + wc * 32 + 8 * fq;
#pragma unroll
                    for (int bj = 0; bj < 2; ++bj) { float v[8];
#pragma unroll
                        for (int n = 0; n < 2; ++n)
#pragma unroll
                            for (int j = 0; j < 4; ++j) v[4 * n + j] = acc[ai][bj][m][n][j] * wt;
                        st_bf16x8(dst + bj * 128, v); }
                }
            }
    }
};
__device__ __forceinline__ void phase_combine(int l, unsigned char* ws, float* out, int bid, int nb) {
    int tid_ = threadIdx.x; asm volatile("" : "+v"(tid_)); const int w = tid_ >> 6, lane = tid_ & 63;
    bf16_t* XB = (bf16_t*)(ws + WS_XB); const bf16_t* Y0 = (const bf16_t*)(ws + WS_YBUF); const bf16_t* Y1 = Y0 + (size_t)16384 * 1024; float* ssqx = (float*)(ws + WS_SSQX) + 16384;
    for (int row = bid * 8 + w; row < NTOK; row += nb * 8) {
        float ss = 0.f;
#pragma unroll
        for (int k = 0; k < 2; ++k) {
            const size_t o = (size_t)row * 1024 + (lane + 64 * k) * 8;
            const u32x4 x = *(const u32x4*)(XB + o), a = *(const u32x4*)(Y0 + o), c = *(const u32x4*)(Y1 + o);
            float v[8] = { bf_lo(x.x) + bf_lo(a.x) + bf_lo(c.x), bf_hi(x.x) + bf_hi(a.x) + bf_hi(c.x), bf_lo(x.y) + bf_lo(a.y) + bf_lo(c.y), bf_hi(x.y) + bf_hi(a.y) + bf_hi(c.y),
                           bf_lo(x.z) + bf_lo(a.z) + bf_lo(c.z), bf_hi(x.z) + bf_hi(a.z) + bf_hi(c.z), bf_lo(x.w) + bf_lo(a.w) + bf_lo(c.w), bf_hi(x.w) + bf_hi(a.w) + bf_hi(c.w) };
            if (l == L_ - 1 && out) { *(f32x4*)(out + o) = (f32x4){v[0], v[1], v[2], v[3]}; *(f32x4*)(out + o + 4) = (f32x4){v[4], v[5], v[6], v[7]}; }
            else { u32x4 p; p.x = pk_bf16(v[0], v[1]); p.y = pk_bf16(v[2], v[3]); p.z = pk_bf16(v[4], v[5]); p.w = pk_bf16(v[6], v[7]); *(u32x4*)(XB + o) = p;
#pragma unroll
                   for (int j = 0; j < 4; ++j) { const unsigned q = j == 0 ? p.x : (j == 1 ? p.y : (j == 2 ? p.z : p.w)); ss += bf_lo(q) * bf_lo(q) + bf_hi(q) * bf_hi(q); } }
        }
        if (l < L_ - 1) { ss = wave_sum(ss); if (lane == 0) ssqx[row] = ss; }
    }
}
constexpr int NPH = 9;
enum { PH_INPROJ = 0, PH_PREP, PH_MIX, PH_YNORM, PH_OUTPROJ, PH_ROUTE, PH_MOEUP, PH_MOEDOWN, PH_COMBINE };
struct Args { Inputs in; float* out; unsigned char* ws; int ph_lo, ph_hi; };

__global__ void __launch_bounds__(512, 2) mk(Args args) {
    extern __shared__ __attribute__((aligned(16))) unsigned char lds_raw[];
    LAS unsigned char* lds = (LAS unsigned char*)lds_raw;
    const int tid = threadIdx.x, bid0 = blockIdx.x, nb = gridDim.x;
#define BID() ({ int b_ = bid0; asm volatile("" : "+s"(b_)); b_; })
    unsigned char* ws = args.ws; unsigned* ctl = (unsigned*)(ws + WS_CTL);
    const int lo = args.ph_lo, hi = args.ph_hi;
    if (tid < 4) ((LAS unsigned*)(lds + LDS_MISC))[tid] = 0u;
    __syncthreads();
    XcdBarrier bar; bar.bar = ctl + CW_BAR; bar.x = 0; bar.st = nullptr;
    if (hi - lo > 1) bar = xcd_barrier_post(ctl + CW_BAR, (volatile LAS unsigned*)(lds + LDS_MISC));
#define IN(k) (lo <= (k) && (k) < hi)
#ifndef REPEAT_PH
#define REPEAT_PH -1
#endif
#define NREP(k) ((REPEAT_PH == (k)) ? 2 : 1)
#define SEAM(k) do { if (IN(k) && IN((k) + 1)) xcd_barrier(bar); } while (0)
#ifndef NO_PRO
    if (IN(0)) for (int rep = 0; rep < NREP(100); ++rep) { prologue(in_tab(), launder(ws), lds, BID(), nb); if (rep + 1 < NREP(100)) xcd_barrier(bar); }
#endif
    SEAM(0);
    for (int l = 0; l < L_; ++l) {
        const int pb = 1 + l * NPH;
        if (IN(pb + PH_INPROJ)) for (int rep = 0; rep < NREP(PH_INPROJ); ++rep) {
            if (rep) xcd_barrier(bar);
            InPtr in = in_tab(); unsigned char* ws = launder(args.ws);
            g8::DenseSched S{(const char*)(ws + WS_XB), (const char*)(ws + WS_WIN) + (size_t)l * 2560 * 1024 * 2, 1024, 1024, 64, 10, nb, BID()};
            EpiInProj E{(const float*)(ws + WS_SSQX) + l * 16384, (float*)(ws + WS_SSQ + PT_DQ) + (size_t)l * 16384 * 4, (float*)(ws + WS_SSQ + PT_DKV) + (size_t)l * 16384 * 2,
                        in->p[8] + l * 64, in->p[9] + l * 64, in->p[19] + l * 192 + 96 + 64, (const float*)(ws + WS_ROPE), ws + WS_PRJ};
#ifndef NO_INPROJ
            g8::gemm_run(lds, 1024, 1024, S, E);
#endif
        }
        SEAM(pb + PH_INPROJ);
        if (IN(pb + PH_PREP)) for (int rep = 0; rep < NREP(PH_PREP); ++rep) { if (rep) xcd_barrier(bar); phase_prep(l, in_tab(), launder(ws), lds, BID(), nb); }
        SEAM(pb + PH_PREP);
        if (IN(pb + PH_MIX)) for (int rep = 0; rep < NREP(PH_MIX); ++rep) { if (rep) xcd_barrier(bar); phase_mix(l, in_tab(), launder(ws), lds, (unsigned*)launder(ws) + CW_Q + 64 * (l + 2 * rep)); }
        SEAM(pb + PH_MIX);
        if (IN(pb + PH_YNORM)) phase_ynorm(l, launder(ws), BID(), nb);
        SEAM(pb + PH_YNORM);
        if (IN(pb + PH_OUTPROJ)) {
            unsigned char* ws = launder(args.ws);
            g8::DenseSched S{(const char*)(ws + WS_Y), (const char*)(ws + WS_WOUT) + (size_t)l * 1024 * 1024 * 2, 1024, 1024, 64, 4, nb, BID()};
            EpiOut E{(bf16_t*)(ws + WS_XB), (float*)(ws + WS_SSQ + PT_X1) + (size_t)l * 16384 * 16};
#ifndef NO_OUTPROJ
            g8::gemm_run(lds, 1024, 1024, S, E);
#endif
        }
        SEAM(pb + PH_OUTPROJ);
#ifndef NO_ROUTE
        if (IN(pb + PH_ROUTE)) phase_route(l, in_tab(), launder(ws), lds, BID(), nb);
#endif
        SEAM(pb + PH_ROUTE);
        if (IN(pb + PH_MOEUP)) for (int rep = 0; rep < NREP(PH_MOEUP); ++rep) {
            if (rep) xcd_barrier(bar);
            unsigned char* ws = launder(args.ws); moe_tables(l, ws, lds);
            const unsigned* cnt = (const unsigned*)(ws + WS_CTL) + CW_CNT + 64 * l; const unsigned* mtok = (const unsigned*)(ws + WS_META); const LAS int* tb = (const LAS int*)(lds + LDS_TB);
            MoeSched<2, true> S{(const char*)(ws + WS_XB), (const char*)(ws + WS_WMOE), cnt, mtok, tb, nb, BID(), (size_t)512 * 1024 * 2, (size_t)256 * 1024 * 2};
            EpiMoeUp E{mtok, (const float*)(ws + WS_RS2), tb, (bf16_t*)(ws + WS_HBUF)};
#ifndef NO_MOEUP
            g8::gemm_run(lds, 1024, 1024, S, E);
#endif
        }
        SEAM(pb + PH_MOEUP);
        if (IN(pb + PH_MOEDOWN)) for (int rep = 0; rep < NREP(PH_MOEDOWN); ++rep) {
            if (rep) xcd_barrier(bar);
            unsigned char* ws = launder(args.ws); moe_tables(l, ws, lds);
            const unsigned* cnt = (const unsigned*)(ws + WS_CTL) + CW_CNT + 64 * l; const unsigned* mtok = (const unsigned*)(ws + WS_META); const LAS int* tb = (const LAS int*)(lds + LDS_TB);
            MoeSched<4, false> S{(const char*)(ws + WS_HBUF), (const char*)(ws + WS_WMOE + WMOE_WD), cnt, mtok, tb, nb, BID(), (size_t)1024 * 256 * 2, (size_t)256 * 256 * 2};
            EpiMoeDown E{mtok, (const float*)(ws + WS_META + META_W), tb, (bf16_t*)(ws + WS_YBUF)};
#ifndef NO_MOEDOWN
            g8::gemm_run(lds, 256, 256, S, E);
#endif
        }
        SEAM(pb + PH_MOEDOWN);
#ifndef NO_COMBINE
        if (IN(pb + PH_COMBINE)) { unsigned char* ws = launder(args.ws); phase_combine(l, ws, args.out, BID(), nb); if (l + 1 < L_) cvt_moe_layer(in_tab(), ws, l + 1, (LAS float*)lds, BID(), nb, threadIdx.x); }
#endif
        SEAM(pb + PH_COMBINE);
    }
#undef IN
#undef SEAM
}
#if CHECK
struct NvScratch { float *proj, *h1, *qk, *hraw, *kn, *kcmp, *vcmp, *dqn, *q, *dkvn, *kv, *krope, *y, *x1, *xl; int* rt_e; float* rt_w; };
constexpr int CB = 5;
enum { NS_INPROJ = 0, NS_NSAPREP, NS_MLAPREP, NS_NSA, NS_ML, NS_MLA, NS_OUT, NS_ROUTE, NS_MOE };
static void naive_step(void* const* d_in, int l, int step, const float* xin, float* xout, const NvScratch& S, hipStream_t st) {
    const int b = CB;
    const float* rel_bias = (const float*)d_in[2];
    const float* norm1_g = (const float*)d_in[3] + (long)l * 1024;
    const float* w_in = (const float*)d_in[4] + (long)l * 1024 * DIN;
    const float* cmp_pe = (const float*)d_in[5] + (long)l * 2 * 32 * 64;
    const float* cmp_w1 = (const float*)d_in[6] + (long)l * 2 * 32 * 64 * 64;
    const float* cmp_w2 = (const float*)d_in[7] + (long)l * 2 * 64 * 64;
    const float* q_norm = (const float*)d_in[8] + l * 64;
    const float* k_norm = (const float*)d_in[9] + l * 64;
    const float* nsa_on = (const float*)d_in[10] + l * 384;
    const float* conv = (const float*)d_in[11] + l * 4 * 512;
    const float* ibias = (const float*)d_in[12] + l * 4;
    const float* fbias = (const float*)d_in[13] + l * 4;
    const float* ml_on = (const float*)d_in[14] + l * 256;
    const float* qan = (const float*)d_in[15] + l * 192;
    const float* w_uq = (const float*)d_in[16] + (long)l * 192 * 576;
    const float* kvan = (const float*)d_in[17] + l * 128;
    const float* w_ukv = (const float*)d_in[18] + (long)l * 128 * 768;
    const float* qkn = (const float*)d_in[19] + l * 192;
    const float* mla_on = (const float*)d_in[20] + l * 384;
    const float* w_out = (const float*)d_in[21] + (long)l * 1024 * 1024;
    const float* norm2_g = (const float*)d_in[22] + l * 1024;
    const float* wgrp = (const float*)d_in[23] + (long)l * 1024 * 4;
    const float* bgrp = (const float*)d_in[24] + l * 4;
    const float* wexp = (const float*)d_in[25] + (long)l * 1024 * 32;
    const float* bexp = (const float*)d_in[26] + l * 32;
    const float* Wg = (const float*)d_in[27] + (long)l * 32 * 1024 * 256;
    const float* Wu = (const float*)d_in[28] + (long)l * 32 * 1024 * 256;
    const float* Wd = (const float*)d_in[29] + (long)l * 32 * 256 * 1024;
    const int* pos = (const int*)d_in[1] + b * 2048;
    switch (step) {
    case NS_INPROJ:
        nv_rmsnorm<<<dim3(2048, 1), 64, 0, st>>>(xin, 1024, 0, S.h1, 1024, 0, norm1_g, 0, 1024);
        nv_gemm<<<dim3((DIN + 63) / 64, 2048 / 64), 256, 0, st>>>(S.h1, 1024, w_in, DIN, S.proj, DIN, nullptr, 0, 2048, DIN, 1024);
        break;
    case NS_NSAPREP:
        nv_nsa_cmp<<<dim3(127, 2, 2), 64, 0, st>>>(S.proj, cmp_pe, cmp_w1, cmp_w2, k_norm, S.kcmp, S.vcmp);
        nv_nsa_knorm<<<dim3(2048, 4), 64, 0, st>>>(S.proj, k_norm, S.kn);
        break;
    case NS_MLAPREP:
        nv_rmsnorm<<<dim3(2048, 1), 64, 0, st>>>(S.proj + O_CDQ, DIN, 0, S.dqn, 192, 0, qan, 0, 192);
        nv_gemm<<<dim3(576 / 64, 2048 / 64), 256, 0, st>>>(S.dqn, 192, w_uq, 576, S.q, 576, nullptr, 0, 2048, 576, 192);
        nv_rmsnorm<<<dim3(2048, 1), 64, 0, st>>>(S.proj + O_CDKV, DIN, 0, S.dkvn, 128, 0, kvan, 0, 128);
        nv_gemm<<<dim3(768 / 64, 2048 / 64), 256, 0, st>>>(S.dkvn, 128, w_ukv, 768, S.kv, 768, nullptr, 0, 2048, 768, 128);
        nv_mla_prep<<<dim3(2048, 7), 64, 0, st>>>(S.q, S.kv, S.proj, S.krope, qkn, pos);
        break;
    case NS_NSA:
        nv_nsa_attn<<<dim3(2048, 2), 192, 0, st>>>(S.proj, S.kn, S.kcmp, S.vcmp, rel_bias, q_norm, S.y);
        break;
    case NS_ML:
        nv_ml_conv<<<2048, 512, 0, st>>>(S.proj, conv, S.qk);
        nv_ml_rec<<<4, 256, 0, st>>>(S.proj, S.qk, ibias, fbias, S.hraw);
        nv_ml_fin<<<dim3(2048, 4), 64, 0, st>>>(S.proj, S.hraw, ml_on, S.y);
        break;
    case NS_MLA:
        nv_mla_attn<<<dim3(2048, 6), 64, 0, st>>>(S.q, S.kv, S.krope, S.y);
        break;
    case NS_OUT:
        nv_rmsnorm<<<dim3(2048, 1), 64, 0, st>>>(S.y, 1024, 0, S.y, 1024, 0, nsa_on, 0, 384);
        nv_rmsnorm<<<dim3(2048, 1), 64, 0, st>>>(S.y + 640, 1024, 0, S.y + 640, 1024, 0, mla_on, 0, 384);
        nv_gemm<<<dim3(1024 / 64, 2048 / 64), 256, 0, st>>>(S.y, 1024, w_out, 1024, S.x1, 1024, xin, 1024, 2048, 1024, 1024);
        break;
    case NS_ROUTE:
        nv_moe_route<<<2048, 64, 0, st>>>(S.x1, norm2_g, wgrp, bgrp, wexp, bexp, S.h1, S.rt_e, S.rt_w);
        break;
    case NS_MOE:
        nv_moe_exp<<<2048, 256, 0, st>>>(S.x1, S.h1, S.rt_e, S.rt_w, Wg, Wu, Wd, xout);
        break;
    }
}

__device__ __forceinline__ void chk_commit(float d2, float r2, float* acc) { d2 = wave_sum(d2); r2 = wave_sum(r2); if ((threadIdx.x & 63) == 0) { atomicAdd(acc, d2); atomicAdd(acc + 1, r2); } }
__device__ __forceinline__ void chk_add(float f, float r, float& d2, float& r2) { const float d = f - r; d2 += (d == d) ? d * d : 1e30f; r2 += r * r; }

__global__ void __launch_bounds__(64) chk_proj(const float* nproj, const unsigned char* prj, const float* ssq_dq, const float* ssq_dkv, const float* qg, const float* kg, const float* krg, const int* pos, float* acc) {
    const int t = blockIdx.x, e = threadIdx.x; const size_t row = (size_t)CB * 2048 + t; float d2 = 0.f, r2 = 0.f;
    for (int G = 0; G < 40; ++G) {
        const int c = inproj_refcol(G, e); float r = c < 0 ? 0.f : nproj[(size_t)t * DIN + c]; float f = 0.f;
        const float rr = (G == 37 && e >= 32) ? 0.f : r; const float ss = wave_sum(rr * rr);
        if (G < 6) { r = r * rsqrtf(ss / 64.f + 1e-6f) * qg[e] * 0.125f; f = bf2f(((const bf16_t*)(prj + PRJ_QN))[((size_t)(CB * 6 + G) * 2048 + t) * 64 + e]); }
        else if (G < 18) { const int a = G - 6, br = a >> 2, s = (a >> 1) & 1, hk = a & 1;
            if (br > 0 && s == 0) r = r * rsqrtf(ss / 64.f + 1e-6f) * kg[e];
            const size_t base = br == 0 ? (s ? PRJ_C0V : PRJ_C0K) : (br == 1 ? (s ? PRJ_VN1 : PRJ_KN1) : (s ? PRJ_VN2 : PRJ_KN2));
            f = bf2f(((const bf16_t*)(prj + base))[((size_t)(CB * 2 + hk) * 2048 + t) * 64 + e]); }
        else if (G < 26) f = bf2f(((const bf16_t*)(prj + PRJ_RAWQK))[row * 512 + (G - 18) * 64 + e]);
        else if (G < 30) f = bf2f(((const bf16_t*)(prj + PRJ_VML))[((size_t)(CB * 4 + (G - 26)) * 2048 + t) * 64 + e]);
        else if (G < 34) f = bf2f(((const bf16_t*)(prj + PRJ_OG))[row * 256 + (G - 30) * 64 + e]);
        else if (G < 37) f = bf2f(((const bf16_t*)(prj + PRJ_DQKV))[row * 384 + (G - 34) * 64 + e]);
        else if (G == 37) {
            const float val = e < 32 ? rr * rsqrtf(ss / 32.f + 1e-6f) * krg[e & 31] : 0.f; const float oth = __shfl_xor(val, 16);
            if (e < 32) { const int i = e & 15; const double ang = (double)pos[row] * pow(10000.0, -(double)i / 16.0); const float cs = (float)cos(ang), sn = (float)sin(ang);
                r = e < 16 ? val * cs - oth * sn : val * cs + oth * sn; f = bf2f(((const bf16_t*)(prj + PRJ_KR))[row * 32 + e]); }
            else if (e < 58) f = ((const float*)(prj + PRJ_GATES))[row * 32 + (e - 32)];
            else { f = 0.f; r = 0.f; }
        }
        else f = bf2f(((const bf16_t*)(prj + PRJ_DQKV))[row * 384 + 256 + (G - 38) * 64 + e]);
        chk_add(f, r, d2, r2);
    }
    float d2s = 0.f, r2s = 0.f;
    { float s1 = 0.f, s2 = 0.f; for (int c = e; c < 192; c += 64) { float v = nproj[(size_t)t * DIN + O_CDQ + c]; s1 += v * v; } for (int c = e; c < 128; c += 64) { float v = nproj[(size_t)t * DIN + O_CDKV + c]; s2 += v * v; }
      s1 = wave_sum(s1); s2 = wave_sum(s2); if (e == 0) { chk_add((ssq_dq[row * 4] + ssq_dq[row * 4 + 1]) + ssq_dq[row * 4 + 2], s1, d2s, r2s); chk_add(ssq_dkv[row * 2] + ssq_dkv[row * 2 + 1], s2, d2s, r2s); } }
    chk_commit(d2, r2, acc); chk_commit(d2s, r2s, acc + 2);
}

__global__ void __launch_bounds__(64) chk_prep(const float* nq, const float* nkv, const float* nkr, const float* nkc, const float* nvc, const unsigned char* ws, float* acc) {
    const int t = blockIdx.x, e = threadIdx.x; float d2 = 0.f, r2 = 0.f, d2c = 0.f, r2c = 0.f; const float scale = 0.10206207261596575f;
    const bf16_t* QM = (const bf16_t*)(ws + WS_MLA); const bf16_t* KM = (const bf16_t*)(ws + WS_MLA + MLA_KM); const bf16_t* VM = (const bf16_t*)(ws + WS_MLA + MLA_VM);
    for (int h = 0; h < 6; ++h) {
        const size_t rq = ((size_t)(CB * 6 + h) * 2048 + t);
        chk_add(bf2f(QM[rq * 96 + e]), nq[(size_t)t * 576 + h * 96 + e] * scale, d2, r2);
        chk_add(bf2f(KM[rq * 96 + e]), nkv[(size_t)t * 768 + h * 128 + e], d2, r2);
        chk_add(bf2f(VM[rq * 64 + e]), nkv[(size_t)t * 768 + h * 128 + 64 + e], d2, r2);
        if (e < 32) { chk_add(bf2f(QM[rq * 96 + 64 + e]), nq[(size_t)t * 576 + h * 96 + 64 + e] * scale, d2, r2); chk_add(bf2f(KM[rq * 96 + 64 + e]), nkr[(size_t)t * 32 + e], d2, r2); }
    }
    if (t < 128) for (int hk = 0; hk < 2; ++hk) {
        const bf16_t* KC = (const bf16_t*)(ws + WS_CMP); const bf16_t* VC = (const bf16_t*)(ws + WS_CMP + CMP_V); const size_t rf = ((size_t)(CB * 2 + hk) * 128 + t) * 64 + e;
        chk_add(bf2f(KC[rf]), t < 127 ? nkc[(size_t)(hk * 127 + t) * 64 + e] : 0.f, d2c, r2c); chk_add(bf2f(VC[rf]), t < 127 ? nvc[(size_t)(hk * 127 + t) * 64 + e] : 0.f, d2c, r2c);
    }
    chk_commit(d2, r2, acc); chk_commit(d2c, r2c, acc + 2);
}

__global__ void __launch_bounds__(64) chk_y(const float* ny, const unsigned char* ws, float* acc, int nseg) {
    const int t = blockIdx.x, e = threadIdx.x; const bf16_t* Y = (const bf16_t*)(ws + WS_Y) + ((size_t)CB * 2048 + t) * 1024;
    float d2[3] = {0.f, 0.f, 0.f}, r2[3] = {0.f, 0.f, 0.f};
    for (int c = e; c < 1024; c += 64) { const int seg = c < 384 ? 0 : (c < 640 ? 1 : 2); const float f = bf2f(Y[c]), r = ny[(size_t)t * 1024 + c];
        if (seg == 0) chk_add(f, r, d2[0], r2[0]); else if (seg == 1) chk_add(f, r, d2[1], r2[1]); else chk_add(f, r, d2[2], r2[2]); }
    if (nseg == 3) { chk_commit(d2[0], r2[0], acc); chk_commit(d2[1], r2[1], acc + 2); chk_commit(d2[2], r2[2], acc + 4); }
    else chk_commit(d2[0] + d2[1] + d2[2], r2[0] + r2[1] + r2[2], acc);
}

__global__ void __launch_bounds__(64) chk_x(const float* nx, const unsigned char* ws, float* acc) {
    const int t = blockIdx.x, e = threadIdx.x; const bf16_t* X = (const bf16_t*)(ws + WS_XB) + ((size_t)CB * 2048 + t) * 1024; float d2 = 0.f, r2 = 0.f;
    for (int c = e; c < 1024; c += 64) chk_add(bf2f(X[c]), nx[(size_t)t * 1024 + c], d2, r2);
    chk_commit(d2, r2, acc);
}

__global__ void __launch_bounds__(512) chk_code(float* acc, int nst, const float* nout) {
    __shared__ float sh[512];
    float s = 0.f; for (int i = threadIdx.x; i < 2048 * 1024; i += 512) { float v = nout[i]; s += v * v; }
    sh[threadIdx.x] = s; __syncthreads();
    if (threadIdx.x == 0) { float tot = 0.f; for (int i = 0; i < 512; ++i) tot += sh[i]; float rms = sqrtf(tot / (2048.f * 1024.f)); if (!(rms > 1e-3f && rms < 1e3f)) rms = 1.f;
        int code = 0;
        for (int st = 0; st < nst; ++st) { const float d2 = acc[2 * st], r2 = acc[2 * st + 1]; if (r2 == 0.f && d2 == 0.f) { if ((st & 15) >= 9) continue; code = (st + 1) * 4 + 3; break; } const float err = d2 / fmaxf(r2, 1e-30f);
            const float tol = CHK_TOL(st);
            if (!(err <= tol)) { const int cls = !(err < 1.f) ? 3 : (err >= 0.1f ? 2 : (err >= 0.01f ? 1 : 0)); code = (st + 1) * 4 + cls; break; } }
        acc[2 * 40] = rms * 32.f * exp2f(0.5f * (float)code); }
}
__global__ void __launch_bounds__(512) chk_fill(const float* acc, float* out) {
    const float K = acc[2 * 40];
    for (size_t i = (size_t)blockIdx.x * 512 + threadIdx.x; i < (size_t)NTOK * 1024; i += (size_t)gridDim.x * 512) out[i] = (i & 1) ? -K : K;
}
#endif

static int g_grid = 0;
static bool setup_once(size_t ws_size) {
    if (g_grid) return g_grid > 0;
    if (ws_size < WS_END) { fprintf(stderr, "kernel_launch: workspace too small: %zu < %zu\n", ws_size, (size_t)WS_END); g_grid = -1; return false; }
    int dev = 0, cus = 0, per_cu = 0;
    if (hipGetDevice(&dev) != hipSuccess || hipDeviceGetAttribute(&cus, hipDeviceAttributeMultiprocessorCount, dev) != hipSuccess) { g_grid = -1; return false; }
    if (hipFuncSetAttribute((const void*)mk, hipFuncAttributeMaxDynamicSharedMemorySize, LDS_BYTES) != hipSuccess) { fprintf(stderr, "kernel_launch: hipFuncSetAttribute failed\n"); g_grid = -1; return false; }
    if (hipOccupancyMaxActiveBlocksPerMultiprocessor(&per_cu, (const void*)mk, 512, LDS_BYTES) != hipSuccess || per_cu < 1) { fprintf(stderr, "kernel_launch: occupancy query says %d\n", per_cu); }
    (void)hipGetLastError();
    g_grid = cus;
    return true;
}
static void launch_mk(const Args& a0, int lo, int hi, hipStream_t stream) { Args a = a0; a.ph_lo = lo; a.ph_hi = hi; hipLaunchKernelGGL(mk, dim3(g_grid), dim3(512), LDS_BYTES, stream, a); }

extern "C" void kernel_launch(void* const* d_in, const int* in_sizes, int n_in, void* d_out, int out_size, void* d_ws, size_t ws_size, hipStream_t stream) {
    if (!setup_once(ws_size)) return;
    unsigned char* ws = (unsigned char*)d_ws;
    (void)hipMemsetAsync(ws + WS_CTL, 0, ZERO_BYTES, stream);
    Args a{}; for (int i = 0; i < 30; ++i) a.in.p[i] = (const float*)d_in[i];
    a.out = (float*)d_out; a.ws = ws; a.ph_lo = 0; a.ph_hi = 0;
#if CHECK
    a.out = nullptr;
#endif
#if CHECK
    float* nb = (float*)d_out; size_t off = 0; NvScratch S;
    auto take = [&](size_t n) { float* p = nb + off; off += (n + 63) & ~(size_t)63; return p; };
    S.proj = take((size_t)2048 * DIN); S.h1 = take(2048 * 1024); S.qk = S.h1; S.hraw = S.qk + 2048 * 512; S.kn = S.hraw + 2048 * 256;
    S.kcmp = take(2 * 127 * 64); S.vcmp = take(2 * 127 * 64); S.dqn = take(2048 * 192); S.q = take(2048 * 576); S.dkvn = take(2048 * 128); S.kv = take(2048 * 768); S.x1 = S.dqn;
    S.krope = take(2048 * 32); S.y = take(2048 * 1024); S.xl = take(2048 * 1024); S.rt_e = (int*)take(2048 * 2); S.rt_w = take(2048 * 2);
    if (off * 4 > (size_t)NTOK * 1024 * 4) { fprintf(stderr, "naive scratch too big\n"); return; }
    float* acc = (float*)(ws + WS_CTL) + CW_CHK;
    launch_mk(a, 0, 1, stream);
    const float* nx_in = (const float*)d_in[0] + (size_t)CB * 2048 * 1024;
    int nst = 0;
    for (int l = 0; l < L_; ++l) {
        const int pb = 1 + l * NPH; const int sb = l * 16;
        launch_mk(a, pb + PH_INPROJ, pb + PH_INPROJ + 1, stream);
        naive_step(d_in, l, NS_INPROJ, nx_in, S.xl, S, stream);
        chk_proj<<<2048, 64, 0, stream>>>(S.proj, ws + WS_PRJ, (const float*)(ws + WS_SSQ + PT_DQ) + (size_t)l * 16384 * 4, (const float*)(ws + WS_SSQ + PT_DKV) + (size_t)l * 16384 * 2,
                                           (const float*)d_in[8] + l * 64, (const float*)d_in[9] + l * 64, (const float*)d_in[19] + l * 192 + 160, (const int*)d_in[1], acc + 2 * (sb + 0));
        nst = sb + 2;
        int ns_done = NS_INPROJ;
#if CHECK_UPTO >= 1
        launch_mk(a, pb + PH_PREP, pb + PH_PREP + 1, stream);
        naive_step(d_in, l, NS_NSAPREP, nx_in, S.xl, S, stream); naive_step(d_in, l, NS_MLAPREP, nx_in, S.xl, S, stream); ns_done = NS_MLAPREP;
        chk_prep<<<2048, 64, 0, stream>>>(S.q, S.kv, S.krope, S.kcmp, S.vcmp, ws, acc + 2 * (sb + 2));
        nst = sb + 4;
#endif
#if CHECK_UPTO >= 2
        launch_mk(a, pb + PH_MIX, pb + PH_MIX + 1, stream);
        naive_step(d_in, l, NS_NSA, nx_in, S.xl, S, stream); naive_step(d_in, l, NS_ML, nx_in, S.xl, S, stream); naive_step(d_in, l, NS_MLA, nx_in, S.xl, S, stream); ns_done = NS_MLA;
        chk_y<<<2048, 64, 0, stream>>>(S.y, ws, acc + 2 * (sb + 4), 3);
        nst = sb + 7;
#endif
#if CHECK_UPTO >= 3
        launch_mk(a, pb + PH_YNORM, pb + PH_YNORM + 1, stream); launch_mk(a, pb + PH_OUTPROJ, pb + PH_OUTPROJ + 1, stream);
        naive_step(d_in, l, NS_OUT, nx_in, S.xl, S, stream); ns_done = NS_OUT;
        chk_x<<<2048, 64, 0, stream>>>(S.x1, ws, acc + 2 * (sb + 7));
        nst = sb + 8;
#endif
#if CHECK_UPTO >= 4
        for (int ph = PH_ROUTE; ph <= PH_COMBINE; ++ph) launch_mk(a, pb + ph, pb + ph + 1, stream);
        naive_step(d_in, l, NS_ROUTE, nx_in, S.xl, S, stream); naive_step(d_in, l, NS_MOE, nx_in, S.xl, S, stream); ns_done = NS_MOE;
        chk_x<<<2048, 64, 0, stream>>>(S.xl, ws, acc + 2 * (sb + 8));
        nst = sb + 9;
#endif
        CHECK_REST
        for (int s = ns_done + 1; s <= NS_MOE; ++s) naive_step(d_in, l, s, nx_in, S.xl, S, stream);
        nx_in = S.xl;
        if (l == CHECK_LAYERS - 1) break;
    }
    chk_code<<<1, 512, 0, stream>>>(acc, nst, S.xl);
    chk_fill<<<1024, 512, 0, stream>>>(acc, (float*)d_out);
#else
#if defined(SPLIT_LAUNCH) && SPLIT_LAUNCH
    for (int ph = 0; ph < 1 + L_ * NPH; ++ph) launch_mk(a, ph, ph + 1, stream);
#else
    launch_mk(a, 0, 1 + L_ * NPH, stream);
#endif
#endif
}
```

```cpp
#define CHECK 0
#define CHECK_LAYERS 2
#define CHECK_UPTO 99
#define SPLIT_LAUNCH 0
#define REPEAT_PH -1
#include <hip/hip_runtime.h>
#include <stdint.h>
#include <cstdio>

constexpr int B_ = 8, T_ = 2048, D_ = 1024, L_ = 2, NTOK = B_ * T_;
constexpr int DIN = 2554;
constexpr int O_AQ = 0, O_AKV = 384, O_AG = 1152, O_BQK = 1170, O_BV = 1682, O_BIF = 1938, O_BO = 1946, O_CDQ = 2202, O_CDKV = 2394, O_CKR = 2522;

typedef unsigned short bf16_t;
typedef short bf16x8 __attribute__((ext_vector_type(8)));
typedef short s16x4 __attribute__((ext_vector_type(4)));
typedef float f32x4 __attribute__((ext_vector_type(4)));
typedef float f32x16 __attribute__((ext_vector_type(16)));
typedef unsigned u32x4 __attribute__((ext_vector_type(4)));
typedef unsigned u32x2 __attribute__((ext_vector_type(2)));
typedef float f32x2_t __attribute__((ext_vector_type(2)));
typedef __bf16 bf16x2_t __attribute__((ext_vector_type(2)));
#define LAS __attribute__((address_space(3)))

__device__ __forceinline__ unsigned pk_bf16(float lo, float hi) { f32x2_t v = {lo, hi}; bf16x2_t b = __builtin_convertvector(v, bf16x2_t); return __builtin_bit_cast(unsigned, b); }
__device__ __forceinline__ float bf_lo(unsigned u) { return __builtin_bit_cast(float, u << 16); }
__device__ __forceinline__ float bf_hi(unsigned u) { return __builtin_bit_cast(float, u & 0xffff0000u); }
__device__ __forceinline__ float bf2f(bf16_t h) { return __builtin_bit_cast(float, (unsigned)h << 16); }
__device__ __forceinline__ bf16_t f2bf(float f) { return (bf16_t)(pk_bf16(f, 0.f) & 0xffffu); }
__device__ __forceinline__ float wave_sum(float v) { for (int o = 32; o; o >>= 1) v += __shfl_xor(v, o); return v; }
__device__ __forceinline__ float wave_max(float v) { for (int o = 32; o; o >>= 1) v = fmaxf(v, __shfl_xor(v, o)); return v; }
__device__ __forceinline__ float siluf(float x) { return x / (1.f + __expf(-x)); }
__device__ __forceinline__ float sigmf(float x) { return 1.f / (1.f + __expf(-x)); }
__device__ __forceinline__ int t5b(int dist) {
    int n = dist > 0 ? dist : 0; if (n < 16) return n;
    float v = logf((float)n / 16.f) / logf(8.f) * 16.f; int l = 16 + (int)v; return l < 31 ? l : 31;
}

constexpr size_t WS_CTL = 0, CTL_BYTES = 65536;
constexpr size_t WS_SSQ = WS_CTL + CTL_BYTES;
constexpr size_t ZERO_BYTES = CTL_BYTES;
constexpr size_t PT_DQ = 0, PT_DKV = PT_DQ + (size_t)2 * 16384 * 4 * 4, PT_A = PT_DKV + (size_t)2 * 16384 * 2 * 4, PT_C = PT_A + (size_t)2 * 16384 * 8 * 4, PT_X1 = PT_C + (size_t)2 * 16384 * 8 * 4, PT_END = PT_X1 + (size_t)2 * 16384 * 16 * 4;
constexpr size_t WS_SSQX = WS_SSQ + PT_END;
constexpr size_t WS_RS2 = WS_SSQX + 2 * 65536;
constexpr size_t WS_WIN = WS_RS2 + 65536;
constexpr size_t WS_WOUT = WS_WIN + (size_t)2 * 2560 * 1024 * 2;
constexpr size_t WS_WUQ = WS_WOUT + (size_t)2 * 1024 * 1024 * 2;
constexpr size_t WS_WUKV = WS_WUQ + (size_t)2 * 768 * 256 * 2;
constexpr size_t WS_WC1 = WS_WUKV + (size_t)2 * 768 * 256 * 2;
constexpr size_t WS_WC2 = WS_WC1 + (size_t)2 * 2 * 64 * 2048 * 2;
constexpr size_t WS_WR = WS_WC2 + (size_t)2 * 2 * 64 * 64 * 2;
constexpr size_t WS_B1C = WS_WR + (size_t)2 * 64 * 1024 * 2;
constexpr size_t WS_BIASD = WS_B1C + 1024;
constexpr size_t WS_ROPE = WS_BIASD + 6 * 2048 * 4;
constexpr size_t WS_WMOE = WS_ROPE + (size_t)16384 * 32 * 4;
constexpr size_t WMOE_WD = (size_t)32 * 512 * 1024 * 2;
constexpr size_t WS_XB = WS_WMOE + 50331648;
constexpr size_t WS_MLA = WS_XB + 33554432;
constexpr size_t MLA_KM = (size_t)8 * 6 * 2048 * 96 * 2, MLA_VM = 2 * MLA_KM;
constexpr size_t WS_HBUF = WS_MLA;
constexpr size_t WS_PRJ = WS_MLA + 50331648;
constexpr size_t HM64 = (size_t)2048 * 64 * 2;
constexpr size_t PRJ_QN = 0;
constexpr size_t PRJ_KN1 = PRJ_QN + 48 * HM64, PRJ_VN1 = PRJ_KN1 + 16 * HM64, PRJ_KN2 = PRJ_VN1 + 16 * HM64, PRJ_VN2 = PRJ_KN2 + 16 * HM64;
constexpr size_t PRJ_VML = PRJ_VN2 + 16 * HM64;
constexpr size_t PRJ_OG = PRJ_VML + 32 * HM64;
constexpr size_t PRJ_KR = PRJ_OG + (size_t)16384 * 256 * 2;
constexpr size_t PRJ_GATES = PRJ_KR + (size_t)16384 * 32 * 2;
constexpr size_t PRJ_DEAD = PRJ_GATES + (size_t)16384 * 32 * 4;
constexpr size_t PRJ_C0K = PRJ_DEAD, PRJ_C0V = PRJ_C0K + 16 * HM64 + 8192;
constexpr size_t PRJ_RAWQK = PRJ_C0V + 16 * HM64 + 8192;
constexpr size_t PRJ_DQKV = PRJ_RAWQK + (size_t)16384 * 512 * 2;
constexpr size_t PRJ_END = PRJ_DQKV + (size_t)16384 * 384 * 2;
static_assert(PRJ_END - PRJ_DEAD >= 33554432, "Y fits the dead part of PRJ");
constexpr size_t WS_Y = WS_PRJ + PRJ_DEAD;
constexpr size_t WS_YBUF = WS_PRJ;
static_assert((size_t)2 * 16384 * 1024 * 2 <= PRJ_END, "YBUF fits the PRJ region");
constexpr size_t WS_ML = WS_PRJ + PRJ_END;
constexpr size_t ML_KC = 32 * HM64, ML_DELTA = 2 * ML_KC, ML_DN = ML_DELTA + (size_t)1024 * 4096 * 2, ML_G = ML_DN + (size_t)1024 * 64 * 4, ML_BL = ML_G + (size_t)8 * 4 * 2048 * 2 * 4, ML_CP = ML_BL + 4096, ML_NP = ML_CP + (size_t)1024 * 4096 * 2, ML_END = ML_NP + (size_t)1024 * 64 * 2;
constexpr size_t WS_CMP = WS_ML + ML_END;
constexpr size_t CMP_V = (size_t)8 * 2 * 128 * 64 * 2;
constexpr size_t WS_META = WS_CMP + 2 * CMP_V;
constexpr size_t META_W = (size_t)32 * 16384 * 4, META_RT = 2 * META_W;
constexpr size_t WS_END = WS_META + META_RT + (size_t)16384 * 16;
constexpr int CW_BAR = 0;
constexpr int CW_Q = 4096;
constexpr int CW_SCAN = 4608;
constexpr int CW_TS = 4864;
constexpr int CW_CHK = 5120;
constexpr int CW_CNT = 8192;
constexpr int LDS_BYTES = 147456;
constexpr int LDS_MISC = LDS_BYTES - 256;
#define XB_TMO      128
#define XB_XCNT(j)  (256  + 64 * (j))
#define XB_XSUB(j)  (1280 + 64 * (j))
#define XB_XGEN(j)  (2304 + 64 * (j))
#define XB_TOP      3328
#define XB_TOPGEN   3392
#define XCD_BAR_WORDS 3456
#define XB_SPIN_CAP (1u << 18)

__device__ __forceinline__ unsigned xb_ld(unsigned* p)              { return __hip_atomic_load(p, __ATOMIC_RELAXED, __HIP_MEMORY_SCOPE_AGENT); }
__device__ __forceinline__ unsigned xb_add(unsigned* p, unsigned v) { return __hip_atomic_fetch_add(p, v, __ATOMIC_RELAXED, __HIP_MEMORY_SCOPE_AGENT); }
__device__ __forceinline__ unsigned xb_xcc_id() { return (unsigned)__builtin_amdgcn_s_getreg((3 << 11) | 20) & 0xFu; }
#define XB_SPIN(cond, bar) do { unsigned _sp = 0; while (cond) { __builtin_amdgcn_s_sleep(1); \
    if ((++_sp & 255u) == 0u) { if (xb_ld(&(bar)[XB_TMO])) break; if (_sp > XB_SPIN_CAP) { atomicAdd(&(bar)[XB_TMO], 1u); break; } } } } while (0)

struct XcdBarrier {
    unsigned* bar; unsigned x;
    volatile LAS unsigned* st;
};

__device__ __forceinline__ XcdBarrier xcd_barrier_post(unsigned* bar, volatile LAS unsigned* st) {
    XcdBarrier b; b.bar = bar; b.x = xb_xcc_id(); b.st = st;
    if (threadIdx.x == 0) (void)xb_add(&bar[XB_XCNT(b.x)], 1u);
    return b;
}
__device__ __forceinline__ void xcd_barrier_complete(unsigned* bar, unsigned x, unsigned& nloc, unsigned& nx) {
    const unsigned G = gridDim.x * gridDim.y * gridDim.z;
    unsigned sum, cnt, mine, sp = 0u;
    for (;;) {
        sum = 0u; cnt = 0u; mine = 0u;
#pragma unroll
        for (unsigned j = 0; j < 16; ++j) { const unsigned c = xb_ld(&bar[XB_XCNT(j)]); sum += c; cnt += (c > 0u) ? 1u : 0u; mine = (j == x) ? c : mine; }
        if (sum == G) break;
        __builtin_amdgcn_s_sleep(1);
        if ((++sp & 255u) == 0u) { if (xb_ld(&bar[XB_TMO])) break; if (sp > XB_SPIN_CAP) { atomicAdd(&bar[XB_TMO], 1u); break; } }
    }
    nloc = mine > 0u ? mine : 1u; nx = cnt > 0u ? cnt : 1u;
}

__device__ __forceinline__ void xcd_barrier(const XcdBarrier& b) {
    asm volatile("s_waitcnt vmcnt(0)" ::: "memory");
    __syncthreads();
    if (threadIdx.x == 0) {
        unsigned* bar = b.bar;
        __builtin_amdgcn_s_waitcnt(0);
        unsigned nloc = b.st[0], nx = b.st[1];
        if (nloc == 0u) { xcd_barrier_complete(bar, b.x, nloc, nx); b.st[0] = nloc; b.st[1] = nx; }
        const unsigned old = xb_add(&bar[XB_XSUB(b.x)], 1u);
        const unsigned gen = old / nloc;
        if (old + 1u == (gen + 1u) * nloc) {
            __builtin_amdgcn_fence(__ATOMIC_RELEASE, "agent");
            asm volatile("s_waitcnt vmcnt(0)" ::: "memory");
            const unsigned og = xb_add(&bar[XB_TOP], 1u);
            const unsigned tg = og / nx;
            if (og + 1u == (tg + 1u) * nx) xb_add(&bar[XB_TOPGEN], 1u);
            else XB_SPIN(xb_ld(&bar[XB_TOPGEN]) == tg, bar);
            __builtin_amdgcn_fence(__ATOMIC_ACQUIRE, "agent");
            xb_add(&bar[XB_XGEN(b.x)], 1u);
            asm volatile("s_waitcnt vmcnt(0)" ::: "memory");
        } else {
            XB_SPIN(xb_ld(&bar[XB_XGEN(b.x)]) == gen, bar);
            __builtin_amdgcn_fence(__ATOMIC_ACQUIRE, "agent");
            asm volatile("s_waitcnt vmcnt(0)" ::: "memory");
        }
    }
    __syncthreads();
}
struct Inputs { const float* p[30]; };
typedef const __attribute__((address_space(4))) Inputs* InPtr;
__device__ __forceinline__ InPtr in_tab() { InPtr p = (InPtr)__builtin_amdgcn_kernarg_segment_ptr(); asm volatile("" : "+s"(p)); return p; }
__device__ __forceinline__ unsigned char* launder(unsigned char* p) { asm volatile("" : "+s"(p)); return p; }

__host__ __device__ inline int inproj_refcol(int G, int e) {
    if (G < 6) return O_AQ + G * 64 + e;
    if (G < 18) return O_AKV + (G - 6) * 64 + e;
    if (G < 26) return O_BQK + (G - 18) * 64 + e;
    if (G < 30) return O_BV + (G - 26) * 64 + e;
    if (G < 34) return O_BO + (G - 30) * 64 + e;
    if (G < 37) return O_CDQ + (G - 34) * 64 + e;
    if (G == 37) { if (e < 32) return O_CKR + e; if (e < 50) return O_AG + (e - 32); if (e < 58) return O_BIF + (e - 50); return -1; }
    return O_CDKV + (G - 38) * 64 + e;
}
__host__ __device__ inline int uq_refcol(int G, int e) {
    if (G < 6) return G * 96 + e;
    if (G < 9) { const int idx = e & 31, bj = e >> 5, sub = idx >> 4, i = idx & 15; return (2 * (G - 6) + sub) * 96 + 64 + bj * 16 + i; }
    return -1;
}
__host__ __device__ inline int ukv_refcol(int G, int e) { return G < 6 ? G * 128 + e : (G - 6) * 128 + 64 + e; }
#define N2G(n) ((((n) >> 8) << 2) + (((n) >> 5) & 3))
#define N2E(n) (((((n) >> 7) & 1) << 5) + ((n) & 31))

struct FWin { const float* w; const float* g; __device__ __forceinline__ float operator()(int k, int n) const { const int c = inproj_refcol(N2G(n), N2E(n)); return c < 0 ? 0.f : w[(size_t)k * DIN + c] * g[k]; } };
struct FWout { const float* w; const float* ga; const float* gc; __device__ __forceinline__ float operator()(int k, int n) const { const float og = k < 384 ? ga[k] : (k < 640 ? 1.f : gc[k - 640]); return w[(size_t)k * 1024 + n] * og; } };
struct FWuq { const float* w; const float* g; __device__ __forceinline__ float operator()(int k, int n) const { const int c = uq_refcol(N2G(n), N2E(n)); return (k < 192 && c >= 0) ? w[(size_t)k * 576 + c] * g[k] : 0.f; } };
struct FWukv { const float* w; const float* g; __device__ __forceinline__ float operator()(int k, int n) const { const int c = ukv_refcol(N2G(n), N2E(n)); return k >= 128 ? w[(size_t)(k - 128) * 768 + c] * g[k - 128] : 0.f; } };
struct FWc1 { const float* w; __device__ __forceinline__ float operator()(int k, int n) const { return w[(size_t)k * 64 + n]; } };
struct FWr { const float* wg; const float* we; const float* g; __device__ __forceinline__ float operator()(int k, int n) const { return n < 4 ? wg[k * 4 + n] * g[k] : (n < 36 ? we[k * 32 + n - 4] * g[k] : 0.f); } };
struct FWgu { const float* src; const float* g; int n0, col0; __device__ __forceinline__ float operator()(int k, int n) const { return src[(size_t)k * 256 + col0 + (n - n0)] * g[k]; } };
struct FWd { const float* w; __device__ __forceinline__ float operator()(int k, int n) const { return w[(size_t)k * 1024 + n]; } };

__device__ __forceinline__ void rope_cs(int pos, int j, float& cs, float& sn) {
    const double inv = exp2(-(double)j * (13.287712379549449 / 16.0));
    const double rev = (double)pos * inv * 0.15915494309189535; const float f = (float)(rev - rint(rev));
    cs = __builtin_amdgcn_cosf(f); sn = __builtin_amdgcn_sinf(f);
}
template <class F>
__device__ __forceinline__ void cvt_tile(const F& f, int n0, int k0, bf16_t* dst, int ldk, LAS float* tile, int tid) {
    { const int k = tid >> 3, nb = (tid & 7) * 8;
#pragma unroll
      for (int j = 0; j < 8; ++j) tile[k * 65 + nb + j] = f(k0 + k, n0 + nb + j); }
    __syncthreads();
    { const int n = tid >> 3, kb = (tid & 7) * 8; const LAS float* s = tile + kb * 65 + n;
      u32x4 o; o.x = pk_bf16(s[0], s[65]); o.y = pk_bf16(s[130], s[195]); o.z = pk_bf16(s[260], s[325]); o.w = pk_bf16(s[390], s[455]);
      *(u32x4*)(dst + (size_t)(n0 + n) * ldk + k0 + kb) = o; }
    __syncthreads();
}
template <class F>
__device__ __forceinline__ void cvt_item(const F& f, int it, int nK, bf16_t* dst, int ldk, LAS float* tile, int tid) { cvt_tile(f, (it / nK) * 64, (it % nK) * 64, dst, ldk, tile, tid); }

__device__ __forceinline__ void moe_item(InPtr in, int l, int it, const float*& src, int& ld, size_t& dst, int& ldk, bool& gain) {
    if (it < 32 * 128) { const int e = it >> 7, r = it & 127, n0 = (r >> 4) * 64, k0 = (r & 15) * 64, c0 = n0 & 255;
        src = (c0 < 128 ? in->p[27] : in->p[28]) + ((size_t)l * 32 + e) * 262144 + (size_t)k0 * 256 + (n0 >> 8) * 128 + (c0 & 127); ld = 256; gain = true;
        dst = ((size_t)e * 512 + n0) * 1024 + k0; ldk = 1024; }
    else { const int j = it - 32 * 128, e = j >> 6, r = j & 63, n0 = (r >> 2) * 64, k0 = (r & 3) * 64;
        src = in->p[29] + ((size_t)l * 32 + e) * 262144 + (size_t)k0 * 1024 + n0; ld = 1024; gain = false;
        dst = (size_t)16777216 + ((size_t)e * 1024 + n0) * 256 + k0; ldk = 256; }
}
__device__ __forceinline__ void cvt_moe_layer(InPtr in, unsigned char* ws, int l, LAS float* tile, int bid, int nb, int tid) {
    asm volatile("" : "+v"(tid));
    const float* g2 = in->p[22] + l * 1024; bf16_t* W = (bf16_t*)(ws + WS_WMOE);
    const int k = tid >> 3, nbq = (tid & 7) * 8;
    const int n = tid >> 3, kb = (tid & 7) * 8;
    constexpr int NIT = 32 * (128 + 64);
    int it = bid; f32x4 v0, v1; const float* src; int ld, ldk; size_t dst = 0; bool gain; float gk = 1.f; int kk0 = 0;
    if (it < NIT) { moe_item(in, l, it, src, ld, dst, ldk, gain); v0 = *(const f32x4*)(src + (size_t)k * ld + nbq); v1 = *(const f32x4*)(src + (size_t)k * ld + nbq + 4);
        kk0 = it < 32 * 128 ? ((it & 127) & 15) * 64 : 0; gk = gain ? g2[kk0 + k] : 1.f; }
    int buf = 0;
    for (; it < NIT; it += nb) {
        LAS float* t = tile + buf * (64 * 65);
        t[k * 65 + nbq + 0] = v0.x * gk; t[k * 65 + nbq + 1] = v0.y * gk; t[k * 65 + nbq + 2] = v0.z * gk; t[k * 65 + nbq + 3] = v0.w * gk;
        t[k * 65 + nbq + 4] = v1.x * gk; t[k * 65 + nbq + 5] = v1.y * gk; t[k * 65 + nbq + 6] = v1.z * gk; t[k * 65 + nbq + 7] = v1.w * gk;
        const size_t cdst = dst; const int cldk = ldk;
        __syncthreads();
        const int itn = it + nb;
        if (itn < NIT) { moe_item(in, l, itn, src, ld, dst, ldk, gain); v0 = *(const f32x4*)(src + (size_t)k * ld + nbq); v1 = *(const f32x4*)(src + (size_t)k * ld + nbq + 4);
            kk0 = itn < 32 * 128 ? ((itn & 127) & 15) * 64 : 0; gk = gain ? g2[kk0 + k] : 1.f; }
        const LAS float* s = t + kb * 65 + n;
        u32x4 o; o.x = pk_bf16(s[0], s[65]); o.y = pk_bf16(s[130], s[195]); o.z = pk_bf16(s[260], s[325]); o.w = pk_bf16(s[390], s[455]);
        *(u32x4*)(W + cdst + (size_t)n * cldk + kb) = o;
        buf ^= 1;
    }
    __syncthreads();
}

__device__ __forceinline__ void prologue(InPtr in, unsigned char* ws, LAS unsigned char* lds, int bid, int nb) {
    int tid_ = threadIdx.x; asm volatile("" : "+v"(tid_));
    const int tid = tid_, lane = tid & 63, wid = tid >> 6;
    LAS float* tile = (LAS float*)lds;
    constexpr int I_WIN = 40 * 16, I_WOUT = 16 * 16, I_WU = 12 * 4, I_WC1 = 32, I_WC2 = 1, I_WR = 16;
    constexpr int PER_L = I_WIN + I_WOUT + 2 * I_WU + 2 * I_WC1 + 2 * I_WC2 + I_WR;
    for (int it0 = bid; it0 < 2 * PER_L; it0 += nb) {
        const int l = it0 / PER_L; int it = it0 % PER_L;
        if (it < I_WIN) { FWin f{in->p[4] + (size_t)l * 1024 * DIN, in->p[3] + l * 1024}; cvt_item(f, it, 16, (bf16_t*)(ws + WS_WIN) + (size_t)l * 2560 * 1024, 1024, tile, tid); continue; } it -= I_WIN;
        if (it < I_WOUT) { FWout f{in->p[21] + (size_t)l * 1048576, in->p[10] + l * 384, in->p[20] + l * 384}; cvt_item(f, it, 16, (bf16_t*)(ws + WS_WOUT) + (size_t)l * 1048576, 1024, tile, tid); continue; } it -= I_WOUT;
        if (it < I_WU) { FWuq f{in->p[16] + (size_t)l * 192 * 576, in->p[15] + l * 192}; cvt_item(f, it, 4, (bf16_t*)(ws + WS_WUQ) + (size_t)l * 768 * 256, 256, tile, tid); continue; } it -= I_WU;
        if (it < I_WU) { FWukv f{in->p[18] + (size_t)l * 128 * 768, in->p[17] + l * 128}; cvt_item(f, it, 4, (bf16_t*)(ws + WS_WUKV) + (size_t)l * 768 * 256, 256, tile, tid); continue; } it -= I_WU;
        if (it < 2 * I_WC1) { const int s = it / I_WC1; FWc1 f{in->p[6] + ((size_t)l * 2 + s) * 2048 * 64}; cvt_item(f, it % I_WC1, 32, (bf16_t*)(ws + WS_WC1) + ((size_t)l * 2 + s) * 64 * 2048, 2048, tile, tid); continue; } it -= 2 * I_WC1;
        if (it < 2 * I_WC2) { const int s = it; FWc1 f{in->p[7] + ((size_t)l * 2 + s) * 64 * 64}; cvt_item(f, 0, 1, (bf16_t*)(ws + WS_WC2) + ((size_t)l * 2 + s) * 64 * 64, 64, tile, tid); continue; } it -= 2 * I_WC2;
        { FWr f{in->p[23] + (size_t)l * 4096, in->p[25] + (size_t)l * 32768, in->p[22] + l * 1024}; cvt_item(f, it, 16, (bf16_t*)(ws + WS_WR) + (size_t)l * 64 * 1024, 1024, tile, tid); }
    }
    cvt_moe_layer(in, ws, 0, tile, bid, nb, tid);
    { const float* x = in->p[0]; bf16_t* XB = (bf16_t*)(ws + WS_XB); float* ssqx = (float*)(ws + WS_SSQX);
      for (int r = bid * 8 + wid; r < NTOK; r += nb * 8) {
          const f32x4* xr = (const f32x4*)(x + (size_t)r * 1024) + lane; float s = 0.f; u32x2* o = (u32x2*)(XB + (size_t)r * 1024) + lane;
#pragma unroll
          for (int j = 0; j < 4; ++j) { const f32x4 v = xr[64 * j]; s += (v.x * v.x + v.y * v.y) + (v.z * v.z + v.w * v.w); u32x2 w; w.x = pk_bf16(v.x, v.y); w.y = pk_bf16(v.z, v.w); o[64 * j] = w; }
          s = wave_sum(s); if (lane == 0) ssqx[r] = s;
      } }
    { float* biasd = (float*)(ws + WS_BIASD); const float* rb = in->p[2];
      for (int i = bid * 512 + tid; i < 6 * 2048; i += nb * 512) { const int h = i >> 11, d = i & 2047; biasd[i] = rb[t5b(d) * 6 + h]; } }
    { float* rope = (float*)(ws + WS_ROPE); const int* pos = (const int*)in->p[1];
      for (int i = bid * 512 + tid; i < NTOK * 16; i += nb * 512) { const int tk = i >> 4, j = i & 15; float cs, sn; rope_cs(pos[tk], j, cs, sn); rope[(size_t)tk * 32 + j] = cs; rope[(size_t)tk * 32 + 16 + j] = sn; } }
    { float* b1c = (float*)(ws + WS_B1C); LAS float* red = (LAS float*)lds;
      for (int it = bid; it < 4; it += nb) { const float* pe = in->p[5] + (size_t)it * 2048; const float* w1 = in->p[6] + (size_t)it * 2048 * 64; const int f = tid & 63, part = tid >> 6;
          float a = 0.f; for (int k = part * 256; k < part * 256 + 256; ++k) a += pe[k] * w1[(size_t)k * 64 + f];
          __syncthreads(); red[tid] = a; __syncthreads();
          if (tid < 64) { float s = 0.f; for (int p2 = 0; p2 < 8; ++p2) s += red[p2 * 64 + tid]; b1c[it * 64 + tid] = s; }
          __syncthreads(); } }
}
namespace g8 {
constexpr int BM = 256, BK = 64, HALF = 128, HTB = HALF * BK * 2, STAGE_BYTES = 8 * HTB, NXCD = 8, WGM = 8;
__host__ __device__ __forceinline__ int lds_byte(int r, int c) { const int st = (r >> 4) * 2 + (c >> 5), rr = r & 15, cc = c & 31, ob = rr * 64 + cc * 2; return st * 1024 + (ob ^ (((ob >> 9) & 1) << 5)); }
__host__ __device__ __forceinline__ void stage_rc(int b, int& R, int& C) { const int st = b / 1024, sb = b % 1024, swz = sb ^ (((sb >> 9) & 1) << 5); R = (st >> 1) * 16 + swz / 64; C = (st & 1) * 32 + (swz % 64) / 2; }
__host__ __device__ __forceinline__ int perm32(int rho) { const int n = rho >> 4, i = rho & 15; return 8 * (i >> 2) + 4 * n + (i & 3); }

struct GUnit { const char* a; const char* b; int pm, pn, e, rows; };

__device__ __forceinline__ bool static_unit(int i, int G, int c, int nM, int nN, int& pm, int& pn) {
    const int nwg = nM * nN; const long L = (long)i * G + c; if (L >= nwg) return false;
    int wgid = (int)L; { const int q = nwg / NXCD, r = nwg % NXCD, xcd = wgid % NXCD, off = wgid / NXCD; wgid = (xcd < r ? xcd * (q + 1) : r * (q + 1) + (xcd - r) * q) + off; }
    const int nig = WGM * nN, gid = wgid / nig, fm = gid * WGM, gsz = (nM - fm) < WGM ? (nM - fm) : WGM;
    pm = fm + ((wgid % nig) % gsz); pn = (wgid % nig) / gsz; return true;
}
struct DenseSched {
    static constexpr bool GATHER = false;
    const char* A; const char* Bt; int lda, ldb, nM, nN, G, c;
    __device__ __forceinline__ bool next(int i, GUnit& u) const {
        int pm, pn; if (!static_unit(i, G, c, nM, nN, pm, pn)) return false;
        u.pm = pm; u.pn = pn; u.e = 0; u.rows = 256; u.a = A + (size_t)pm * 256 * lda * 2; u.b = Bt + (size_t)pn * 256 * ldb * 2; return true;
    }
    __device__ __forceinline__ void aoff(const GUnit&, unsigned (&v)[2][2], const int (&R)[2], const int (&C)[2]) const {
#pragma unroll
        for (int h = 0; h < 2; ++h)
#pragma unroll
            for (int i = 0; i < 2; ++i) v[h][i] = (unsigned)((h * 128 + R[i]) * lda + C[i]) * 2u;
    }
};

template <class Epi, class Sched>
__device__ __forceinline__ void gemm_run(LAS unsigned char* lds, const int K, const int ldb, const Sched& S, const Epi& E) {
    int tid_ = threadIdx.x; asm volatile("" : "+v"(tid_));
    const int tid = tid_, wid = __builtin_amdgcn_readfirstlane(tid >> 6), lane = tid & 63, wr = wid >> 2, wc = wid & 3, fr = lane & 15, fq = lane >> 4;
    int nt_ = K / BK; asm volatile("" : "+s"(nt_));
    const int nt = nt_;
    int R[2], C[2]; unsigned voffB[2];
#pragma unroll
    for (int i = 0; i < 2; ++i) { stage_rc(tid * 16 + i * 8192, R[i], C[i]); const int Rb = (R[i] & ~31) + perm32(R[i] & 31); voffB[i] = (unsigned)(Rb * ldb + C[i]) * 2u; }
    const size_t kstep = (size_t)(BK * 2);
    const size_t hstepB = (size_t)HALF * ldb * 2;
    const unsigned ldsw = (unsigned)wid * 1024u;
    const int aoff = lds_byte(wr * 64 + fr, fq * 8), boff = lds_byte(wc * 32 + fr, fq * 8);
#define G8_SA(b, h) (((b) * 2 + (h)) * HTB)
#define G8_SB(b, h) ((4 + (b) * 2 + (h)) * HTB)
#define G8_GLDS(bufoff, gptr, i_) __builtin_amdgcn_global_load_lds((const unsigned*)(gptr), (LAS unsigned*)(lds + (bufoff) + ldsw + (i_) * 8192), 16, 0, 0)
#define G8_STAGE_B(bufoff, gbase) do { G8_GLDS(bufoff, (const char*)(gbase) + voffB[0], 0); G8_GLDS(bufoff, (const char*)(gbase) + voffB[1], 1); } while (0)
#define G8_STAGE_A(bufoff, gbase, v0, v1) do { G8_GLDS(bufoff, (const char*)(gbase) + (v0), 0); G8_GLDS(bufoff, (const char*)(gbase) + (v1), 1); } while (0)
#define G8_LDA(dst, b, h) do { _Pragma("unroll") for (int m = 0; m < 4; ++m) _Pragma("unroll") for (int k = 0; k < 2; ++k) dst[m][k] = *(const LAS bf16x8*)(lds + G8_SA(b, h) + aoff + m * 2048 + k * 1024); } while (0)
#define G8_LDB(dst, b, h) do { _Pragma("unroll") for (int n = 0; n < 2; ++n) _Pragma("unroll") for (int k = 0; k < 2; ++k) dst[n][k] = *(const LAS bf16x8*)(lds + G8_SB(b, h) + boff + n * 2048 + k * 1024); } while (0)
#define G8_MMA(ai, bj, At, Bt) do { __builtin_amdgcn_s_setprio(1); _Pragma("unroll") for (int m = 0; m < 4; ++m) _Pragma("unroll") for (int n = 0; n < 2; ++n) _Pragma("unroll") for (int k = 0; k < 2; ++k) \
        acc[ai][bj][m][n] = __builtin_amdgcn_mfma_f32_16x16x32_bf16(Bt[n][k], At[m][k], acc[ai][bj][m][n], 0, 0, 0); __builtin_amdgcn_s_setprio(0); } while (0)
#define G8_WAIT_V(n) asm volatile("s_waitcnt vmcnt(" #n ")" ::: "memory")
#define G8_WAIT_L(n) asm volatile("s_waitcnt lgkmcnt(" #n ")" ::: "memory")
#define G8_BAR __builtin_amdgcn_s_barrier()
#define G8_SCHED __builtin_amdgcn_sched_barrier(0)
    GUnit cur, nxt; int ui = 0;
    if (!S.next(0, cur)) return;
    constexpr bool GATHER = Sched::GATHER;
    unsigned vc[2][2];
    S.aoff(cur, vc, R, C);
    LAS u32x4* stash = (LAS u32x4*)(lds + STAGE_BYTES + 4096) + tid;
    f32x4 acc[2][2][4][2];
#pragma unroll
    for (int a = 0; a < 2; ++a)
#pragma unroll
        for (int b = 0; b < 2; ++b)
#pragma unroll
            for (int m = 0; m < 4; ++m)
#pragma unroll
                for (int n = 0; n < 2; ++n) acc[a][b][m][n] = (f32x4){0.f, 0.f, 0.f, 0.f};
    bf16x8 At[4][2], B0[2][2], B1[2][2];
    const char* cA = cur.a; const char* cB = cur.b;
    G8_STAGE_B(G8_SB(0, 0), cB); G8_STAGE_B(G8_SB(0, 1), cB + hstepB); G8_STAGE_A(G8_SA(0, 0), cA, vc[0][0], vc[0][1]); G8_STAGE_A(G8_SA(0, 1), cA, vc[1][0], vc[1][1]);
    if (wr == 1) G8_BAR;
    G8_WAIT_V(2); G8_BAR;
    G8_STAGE_B(G8_SB(1, 0), cB + kstep); G8_STAGE_A(G8_SA(1, 0), cA + kstep, vc[0][0], vc[0][1]); G8_STAGE_B(G8_SB(1, 1), cB + hstepB + kstep);
    G8_WAIT_V(6); G8_BAR;
    for (;;) {
        const bool has_next = S.next(ui + 1, nxt);
        if (GATHER) { unsigned vn[2][2];
            if (has_next) S.aoff(nxt, vn, R, C);
            else { vn[0][0] = vc[0][0]; vn[0][1] = vc[0][1]; vn[1][0] = vc[1][0]; vn[1][1] = vc[1][1]; }
            u32x4 sv; sv.x = vn[0][0]; sv.y = vn[0][1]; sv.z = vn[1][0]; sv.w = vn[1][1]; *stash = sv; }
        const char* nA = has_next ? nxt.a : cA; const char* nB = has_next ? nxt.b : cB;
#pragma unroll 1
        for (int t = 0; t < nt; t += 2) {
            const bool last = (t == nt - 2);
            const char* a1 = cA + (size_t)(t + 1) * kstep;
            const char* a2 = last ? nA : cA + (size_t)(t + 2) * kstep; const char* b2 = last ? nB : cB + (size_t)(t + 2) * kstep;
            const char* a3 = a2 + kstep; const char* b3 = b2 + kstep;
            unsigned w00 = vc[0][0], w01 = vc[0][1], w10 = vc[1][0], w11 = vc[1][1];
            if (GATHER) { if (last) { const u32x4 sv = *stash; w00 = sv.x; w01 = sv.y; w10 = sv.z; w11 = sv.w; } }
            G8_LDB(B0, 0, 0); G8_LDB(B1, 0, 1); G8_SCHED; G8_LDA(At, 0, 0); G8_STAGE_A(G8_SA(1, 1), a1, vc[1][0], vc[1][1]);
            G8_WAIT_V(8); G8_WAIT_L(0); G8_BAR; G8_MMA(0, 0, At, B0); G8_MMA(0, 1, At, B1); G8_BAR; G8_SCHED;
            G8_LDA(At, 0, 1); G8_STAGE_B(G8_SB(0, 0), b2); G8_STAGE_B(G8_SB(0, 1), b2 + hstepB); G8_STAGE_A(G8_SA(0, 0), a2, w00, w01);
            G8_WAIT_V(8); G8_WAIT_L(0); G8_BAR; G8_MMA(1, 0, At, B0); G8_MMA(1, 1, At, B1); G8_BAR; G8_SCHED;
            G8_LDB(B0, 1, 0); G8_LDB(B1, 1, 1); G8_SCHED; G8_LDA(At, 1, 0); G8_STAGE_A(G8_SA(0, 1), a2, w10, w11);
            G8_WAIT_V(8); G8_WAIT_L(0); G8_BAR; G8_MMA(0, 0, At, B0); G8_MMA(0, 1, At, B1); G8_BAR; G8_SCHED;
            G8_LDA(At, 1, 1); G8_STAGE_B(G8_SB(1, 0), b3); G8_STAGE_B(G8_SB(1, 1), b3 + hstepB); G8_STAGE_A(G8_SA(1, 0), a3, w00, w01);
            G8_WAIT_V(8); G8_WAIT_L(0); G8_BAR; G8_MMA(1, 0, At, B0); G8_MMA(1, 1, At, B1); G8_BAR; G8_SCHED;
        }
        if (wr == 0) G8_BAR;
        { int fr_ = fr, fq_ = fq; asm volatile("" : "+v"(fr_), "+v"(fq_));
          E(acc, cur, wr, wc, fr_, fq_); }
        if (!has_next) break;
#pragma unroll
        for (int a = 0; a < 2; ++a)
#pragma unroll
            for (int b = 0; b < 2; ++b)
#pragma unroll
                for (int m = 0; m < 4; ++m)
#pragma unroll
                    for (int n = 0; n < 2; ++n) acc[a][b][m][n] = (f32x4){0.f, 0.f, 0.f, 0.f};
        cur = nxt; cA = nA; cB = nB; ++ui;
        if (GATHER) { const u32x4 sv = *stash; vc[0][0] = sv.x; vc[0][1] = sv.y; vc[1][0] = sv.z; vc[1][1] = sv.w; }
        if (wr == 1) G8_BAR;
    }
    G8_WAIT_V(0);
    G8_BAR;
#undef G8_SA
#undef G8_SB
#undef G8_GLDS
#undef G8_STAGE_A
#undef G8_STAGE_B
#undef G8_LDA
#undef G8_LDB
#undef G8_MMA
#undef G8_WAIT_V
#undef G8_WAIT_L
#undef G8_BAR
#undef G8_SCHED
}
}
using g8::GUnit;
__device__ __forceinline__ void st_bf16x8(bf16_t* p, const float (&v)[8]) { u32x4 w; w.x = pk_bf16(v[0], v[1]); w.y = pk_bf16(v[2], v[3]); w.z = pk_bf16(v[4], v[5]); w.w = pk_bf16(v[6], v[7]); *(u32x4*)p = w; }
__device__ __forceinline__ float quad_sum(float s) { s += __shfl_xor(s, 16); s += __shfl_xor(s, 32); return s; }

struct EpiInProj {
    const float* ssqx; float* part_dq; float* part_dkv; const float* qg; const float* kg; const float* krg; const float* rope;
    unsigned char* prj;
    __device__ __forceinline__ void operator()(const f32x4 (&acc)[2][2][4][2], const GUnit& u, int wr, int wc, int fr, int fq) const {
        const int G = u.pn * 4 + wc;
        const bool isq = G < 6; const int a = G - 6; const bool isk = (G >= 10 && G < 18 && ((a >> 1) & 1) == 0);
        const float* g0 = (isq ? qg : kg) + 8 * fq;
#pragma unroll
        for (int ai = 0; ai < 2; ++ai)
#pragma unroll
            for (int m = 0; m < 4; ++m) {
                __builtin_amdgcn_sched_barrier(0);
                const int row = u.pm * 256 + ai * 128 + wr * 64 + m * 16 + fr; const int b = row >> 11, t = row & 2047;
                const float rs = rsqrtf(ssqx[row] * (1.f / 1024.f) + 1e-6f);
                float v[2][8];
#pragma unroll
                for (int bj = 0; bj < 2; ++bj)
#pragma unroll
                    for (int n = 0; n < 2; ++n)
#pragma unroll
                        for (int j = 0; j < 4; ++j) v[bj][4 * n + j] = acc[ai][bj][m][n][j] * rs;
                float ss = 0.f;
#pragma unroll
                for (int bj = 0; bj < 2; ++bj)
#pragma unroll
                    for (int i = 0; i < 8; ++i) ss += v[bj][i] * v[bj][i];
                bf16_t* dst = nullptr; int bstride = 32;
                if (isq) {
                    ss = quad_sum(ss); const float sc = rsqrtf(ss * (1.f / 64.f) + 1e-6f) * 0.125f;
#pragma unroll
                    for (int i = 0; i < 8; ++i) { v[0][i] *= sc * g0[i]; v[1][i] *= sc * g0[32 + i]; }
                    dst = (bf16_t*)(prj + PRJ_QN) + ((size_t)(b * 6 + G) * 2048 + t) * 64;
                } else if (G < 18) {
                    const int br = a >> 2, s = (a >> 1) & 1, hk = a & 1;
                    if (br > 0 && s == 0) {
                        ss = quad_sum(ss); const float sc = rsqrtf(ss * (1.f / 64.f) + 1e-6f);
#pragma unroll
                        for (int i = 0; i < 8; ++i) { v[0][i] *= sc * g0[i]; v[1][i] *= sc * g0[32 + i]; }
                    }
                    const size_t base = br == 0 ? (s ? PRJ_C0V : PRJ_C0K) : (br == 1 ? (s ? PRJ_VN1 : PRJ_KN1) : (s ? PRJ_VN2 : PRJ_KN2));
                    dst = (bf16_t*)(prj + base) + ((size_t)(b * 2 + hk) * 2048 + t) * 64;
                } else if (G < 26) { dst = (bf16_t*)(prj + PRJ_RAWQK) + (size_t)row * 512 + (G - 18) * 64; }
                else if (G < 30) { dst = (bf16_t*)(prj + PRJ_VML) + ((size_t)(b * 4 + (G - 26)) * 2048 + t) * 64; }
                else if (G < 34) { dst = (bf16_t*)(prj + PRJ_OG) + (size_t)row * 256 + (G - 30) * 64; }
                else if (G < 37) { dst = (bf16_t*)(prj + PRJ_DQKV) + (size_t)row * 384 + (G - 34) * 64; ss = quad_sum(ss); if (fq == 0) part_dq[(size_t)row * 4 + (G - 34)] = ss; }
                else if (G == 37) {
                    dst = (bf16_t*)(prj + PRJ_DQKV) + (size_t)row * 384 + 192;
                    float* gt = (float*)(prj + PRJ_GATES) + (size_t)row * 32 + 8 * fq;
                    *(f32x4*)gt = (f32x4){v[1][0], v[1][1], v[1][2], v[1][3]}; *(f32x4*)(gt + 4) = (f32x4){v[1][4], v[1][5], v[1][6], v[1][7]};
                    float s0 = 0.f;
#pragma unroll
                    for (int i = 0; i < 8; ++i) s0 += v[0][i] * v[0][i];
                    s0 = quad_sum(s0); const float sc = rsqrtf(s0 * (1.f / 32.f) + 1e-6f);
                    const float* rp = rope + (size_t)row * 32 + ((8 * fq) & 15);
                    float kr[8];
#pragma unroll
                    for (int i = 0; i < 8; ++i) { const float val = v[0][i] * sc * krg[8 * fq + i]; const float oth = __shfl_xor(val, 32); const float cs = rp[i], sn = rp[16 + i]; kr[i] = fq < 2 ? val * cs - oth * sn : val * cs + oth * sn; }
                    st_bf16x8((bf16_t*)(prj + PRJ_KR) + (size_t)row * 32 + 8 * fq, kr);
                } else { dst = (bf16_t*)(prj + PRJ_DQKV) + (size_t)row * 384 + 256 + (G - 38) * 64; ss = quad_sum(ss); if (fq == 0) part_dkv[(size_t)row * 2 + (G - 38)] = ss; }
                st_bf16x8(dst + 8 * fq, v[0]); st_bf16x8(dst + bstride + 8 * fq, v[1]);
            }
    }
};

struct EpiUq {
    const float* ssq_dq; const float* qkn; const float* rope; bf16_t* QM;
    __device__ __forceinline__ void operator()(const f32x4 (&acc)[2][2][4][2], const GUnit& u, int wr, int wc, int fr, int fq) const {
        const int G = u.pn * 4 + wc; if (G >= 9) return;
        const float scale = 0.10206207261596575f;
        const float* g0 = G < 6 ? qkn + 8 * fq : qkn + 64 + 8 * (fq & 1); const float* g1 = G < 6 ? g0 + 32 : g0 + 16;
#pragma unroll
        for (int ai = 0; ai < 2; ++ai)
#pragma unroll
            for (int m = 0; m < 4; ++m) {
                __builtin_amdgcn_sched_barrier(0);
                const int row = u.pm * 256 + ai * 128 + wr * 64 + m * 16 + fr; const int b = row >> 11, t = row & 2047;
                const f32x4 pq = *(const f32x4*)(ssq_dq + (size_t)row * 4); const float rs = rsqrtf(((pq.x + pq.y) + pq.z) * (1.f / 192.f) + 1e-6f);
                float v[2][8]; float ss = 0.f;
#pragma unroll
                for (int bj = 0; bj < 2; ++bj)
#pragma unroll
                    for (int n = 0; n < 2; ++n)
#pragma unroll
                        for (int j = 0; j < 4; ++j) { const float x = acc[ai][bj][m][n][j] * rs; v[bj][4 * n + j] = x; ss += x * x; }
                if (G < 6) ss = quad_sum(ss); else ss += __shfl_xor(ss, 16);
                const float sc = rsqrtf(ss * (G < 6 ? 1.f / 64.f : 1.f / 32.f) + 1e-6f) * scale;
#pragma unroll
                for (int i = 0; i < 8; ++i) { v[0][i] *= sc * g0[i]; v[1][i] *= sc * g1[i]; }
                if (G < 6) {
                    bf16_t* dst = QM + ((size_t)(b * 6 + G) * 2048 + t) * 96;
                    st_bf16x8(dst + 8 * fq, v[0]); st_bf16x8(dst + 32 + 8 * fq, v[1]);
                } else {
                    const int i16 = 8 * (fq & 1); const int head = 2 * (G - 6) + (fq >> 1);
                    const float* rp = rope + (size_t)row * 32 + i16; float o1[8], o2[8];
#pragma unroll
                    for (int i = 0; i < 8; ++i) { const float cs = rp[i], sn = rp[16 + i]; o1[i] = v[0][i] * cs - v[1][i] * sn; o2[i] = v[1][i] * cs + v[0][i] * sn; }
                    bf16_t* dst = QM + ((size_t)(b * 6 + head) * 2048 + t) * 96 + 64 + i16;
                    st_bf16x8(dst, o1); st_bf16x8(dst + 16, o2);
                }
            }
    }
};
struct EpiUkv {
    const float* ssq_dkv; const float* qkn; const bf16_t* KR; bf16_t* KM; bf16_t* VM;
    __device__ __forceinline__ void operator()(const f32x4 (&acc)[2][2][4][2], const GUnit& u, int wr, int wc, int fr, int fq) const {
        const int G = u.pn * 4 + wc;
        const float* g0 = qkn + 96 + 8 * fq;
#pragma unroll
        for (int ai = 0; ai < 2; ++ai)
#pragma unroll
            for (int m = 0; m < 4; ++m) {
                __builtin_amdgcn_sched_barrier(0);
                const int row = u.pm * 256 + ai * 128 + wr * 64 + m * 16 + fr; const int b = row >> 11, t = row & 2047;
                const float rs = rsqrtf((ssq_dkv[(size_t)row * 2] + ssq_dkv[(size_t)row * 2 + 1]) * (1.f / 128.f) + 1e-6f);
                float v[2][8]; float ss = 0.f;
#pragma unroll
                for (int bj = 0; bj < 2; ++bj)
#pragma unroll
                    for (int n = 0; n < 2; ++n)
#pragma unroll
                        for (int j = 0; j < 4; ++j) { const float x = acc[ai][bj][m][n][j] * rs; v[bj][4 * n + j] = x; ss += x * x; }
                if (G < 6) {
                    ss = quad_sum(ss); const float sc = rsqrtf(ss * (1.f / 64.f) + 1e-6f);
#pragma unroll
                    for (int i = 0; i < 8; ++i) { v[0][i] *= sc * g0[i]; v[1][i] *= sc * g0[32 + i]; }
                    bf16_t* dst = KM + ((size_t)(b * 6 + G) * 2048 + t) * 96;
                    st_bf16x8(dst + 8 * fq, v[0]); st_bf16x8(dst + 32 + 8 * fq, v[1]);
                    *(u32x4*)(dst + 64 + 8 * fq) = *(const u32x4*)(KR + (size_t)row * 32 + 8 * fq);
                } else {
                    bf16_t* dst = VM + ((size_t)(b * 6 + (G - 6)) * 2048 + t) * 64;
                    st_bf16x8(dst + 8 * fq, v[0]); st_bf16x8(dst + 32 + 8 * fq, v[1]);
                }
            }
    }
};
#define MFMA16(a, b, c) __builtin_amdgcn_mfma_f32_16x16x32_bf16(a, b, c, 0, 0, 0)
#define MFMA32(a, b, c) __builtin_amdgcn_mfma_f32_32x32x16_bf16(a, b, c, 0, 0, 0)
#define LDS_FENCE() asm volatile("s_waitcnt lgkmcnt(0)" ::: "memory")

__device__ __forceinline__ void cmp_unit(int u, int l, InPtr in, unsigned char* ws, LAS unsigned char* lds) {
    int tid_ = threadIdx.x; asm volatile("" : "+v"(tid_));
    const int tid = tid_, w = tid >> 6, lane = tid & 63, r = lane & 15, q = lane >> 4;
    const int b = u >> 2, s = (u >> 1) & 1, hk = u & 1;
    const bf16_t* A = (const bf16_t*)(ws + WS_PRJ + (s ? PRJ_C0V : PRJ_C0K)) + (size_t)(b * 2 + hk) * 2048 * 64;
    const bf16_t* W1 = (const bf16_t*)(ws + WS_WC1) + ((size_t)l * 2 + s) * 64 * 2048;
    const bf16_t* W2 = (const bf16_t*)(ws + WS_WC2) + ((size_t)l * 2 + s) * 64 * 64;
    const float* b1 = (const float*)(ws + WS_B1C) + (l * 2 + s) * 64;
    f32x4 acc[4];
#pragma unroll
    for (int nb = 0; nb < 4; ++nb) acc[nb] = (f32x4){0.f, 0.f, 0.f, 0.f};
    const bf16_t* ap = A + (size_t)(16 * w + r) * 1024 + 8 * q;
    constexpr int WP = 528, WBUF = 64 * WP; LAS unsigned char* wb = lds + 24576;
    u32x4 st[4];
#pragma unroll
    for (int i = 0; i < 4; ++i) { const int c = tid + 512 * i; st[i] = *(const u32x4*)(W1 + (size_t)(c >> 5) * 2048 + (c & 31) * 8); }
#pragma unroll
    for (int i = 0; i < 4; ++i) { const int c = tid + 512 * i; *(LAS u32x4*)(wb + (c >> 5) * WP + (c & 31) * 16) = st[i]; }
    __syncthreads();
#pragma unroll 1
    for (int kc = 0; kc < 8; ++kc) {
        const int cur = kc & 1;
        if (kc < 7) {
#pragma unroll
            for (int i = 0; i < 4; ++i) { const int c = tid + 512 * i; st[i] = *(const u32x4*)(W1 + (size_t)(c >> 5) * 2048 + (kc + 1) * 256 + (c & 31) * 8); }
        }
        bf16x8 af[8];
#pragma unroll
        for (int ks = 0; ks < 8; ++ks) af[ks] = *(const bf16x8*)(ap + 256 * kc + 32 * ks);
#pragma unroll
        for (int ks = 0; ks < 8; ++ks)
#pragma unroll
            for (int nb = 0; nb < 4; ++nb) { const bf16x8 bb = *(const LAS bf16x8*)(wb + cur * WBUF + (16 * nb + r) * WP + (32 * ks + 8 * q) * 2); acc[nb] = MFMA16(af[ks], bb, acc[nb]); }
        if (kc < 7) {
#pragma unroll
            for (int i = 0; i < 4; ++i) { const int c = tid + 512 * i; *(LAS u32x4*)(wb + (cur ^ 1) * WBUF + (c >> 5) * WP + (c & 31) * 16) = st[i]; }
        }
        __syncthreads();
    }
    LAS bf16_t* hl = (LAS bf16_t*)(lds + w * 2304);
#pragma unroll
    for (int nb = 0; nb < 4; ++nb) { const float bias = b1[16 * nb + r];
#pragma unroll
        for (int j = 0; j < 4; ++j) hl[(4 * q + j) * 72 + 16 * nb + r] = f2bf(siluf(acc[nb][j] + bias)); }
    LDS_FENCE();
    f32x4 o[4];
#pragma unroll
    for (int nb = 0; nb < 4; ++nb) o[nb] = (f32x4){0.f, 0.f, 0.f, 0.f};
#pragma unroll
    for (int ks = 0; ks < 2; ++ks) {
        const bf16x8 a = *(const LAS bf16x8*)(hl + r * 72 + 32 * ks + 8 * q);
#pragma unroll
        for (int nb = 0; nb < 4; ++nb) { const bf16x8 bb = *(const bf16x8*)(W2 + (size_t)(16 * nb + r) * 64 + 32 * ks + 8 * q); o[nb] = MFMA16(a, bb, o[nb]); }
    }
    LDS_FENCE();
    const float* kg = in->p[9] + l * 64;
    bf16_t* dst = (bf16_t*)(ws + WS_CMP + (s ? CMP_V : 0)) + (size_t)(b * 2 + hk) * 128 * 64;
#pragma unroll
    for (int j = 0; j < 4; ++j) {
        const int n = 16 * w + 4 * q + j; float ss = 0.f;
#pragma unroll
        for (int nb = 0; nb < 4; ++nb) ss += o[nb][j] * o[nb][j];
        ss += __shfl_xor(ss, 1); ss += __shfl_xor(ss, 2); ss += __shfl_xor(ss, 4); ss += __shfl_xor(ss, 8);
        const float sc = s == 0 ? rsqrtf(ss * (1.f / 64.f) + 1e-6f) : 1.f;
#pragma unroll
        for (int nb = 0; nb < 4; ++nb) { const int d = 16 * nb + r; const float v = o[nb][j] * sc * (s == 0 ? kg[d] : 1.f); dst[(size_t)n * 64 + d] = n < 127 ? f2bf(v) : (bf16_t)0; }
    }
}

__device__ __forceinline__ int swz_off(int row, int chunk) { return row * 128 + ((chunk ^ (row & 7)) << 4); }
__device__ __forceinline__ float log_sigmoid(float x) { return fminf(x, 0.f) - log1pf(__expf(-fabsf(x))); }
__device__ __forceinline__ void ml_delta_wave(int cu, int l, InPtr in, unsigned char* ws, LAS unsigned char* wl, int lane) {
    const int c = cu & 31, bh = cu >> 5, h = bh & 3, b = bh >> 2; const int t0 = c * 64; const size_t row0 = (size_t)b * 2048 + t0;
    const float* G = (const float*)(ws + WS_PRJ + PRJ_GATES);
    const float ip = G[(row0 + lane) * 32 + 18 + h] + in->p[12][l * 4 + h], fp = G[(row0 + lane) * 32 + 22 + h] + in->p[13][l * 4 + h];
    float bcum = log_sigmoid(fp);
#pragma unroll
    for (int o = 1; o < 64; o <<= 1) { const float t = __shfl_up(bcum, o); if (lane >= o) bcum += t; }
    const float bL = __shfl(bcum, 63); const float wgt = __expf(bL - bcum + ip);
    { float* mlg = (float*)(ws + WS_ML + ML_G) + ((size_t)bh * 2048 + t0 + lane) * 2; mlg[0] = bcum; mlg[1] = ip; if (lane == 0) ((float*)(ws + WS_ML + ML_BL))[cu] = bL; }
    const bf16_t* raw = (const bf16_t*)(ws + WS_PRJ + PRJ_RAWQK); const float* cw = in->p[11] + (size_t)l * 4 * 512;
    float wq[4], wk[4];
#pragma unroll
    for (int j = 0; j < 4; ++j) { wq[j] = cw[j * 512 + h * 64 + lane]; wk[j] = cw[j * 512 + 256 + h * 64 + lane]; }
    float q3 = 0.f, q2 = 0.f, q1 = 0.f, k3 = 0.f, k2 = 0.f, k1 = 0.f;
    if (c > 0) { const bf16_t* p = raw + (row0 - 3) * 512 + h * 64 + lane; q3 = bf2f(p[0]); q2 = bf2f(p[512]); q1 = bf2f(p[1024]); k3 = bf2f(p[256]); k2 = bf2f(p[512 + 256]); k1 = bf2f(p[1024 + 256]); }
    bf16_t* QC = (bf16_t*)(ws + WS_ML) + ((size_t)bh * 2048 + t0) * 64 + lane; bf16_t* KC = (bf16_t*)(ws + WS_ML + ML_KC) + ((size_t)bh * 2048 + t0) * 64 + lane;
    const bf16_t* V = (const bf16_t*)(ws + WS_PRJ + PRJ_VML) + ((size_t)bh * 2048 + t0) * 64 + lane;
    float dn = 0.f;
    const bf16_t* rq = raw + row0 * 512 + h * 64 + lane;
    bf16_t cq[8], ck[8], cv[8], nq[8], nk[8], nv[8];
#pragma unroll
    for (int j = 0; j < 8; ++j) { cq[j] = rq[(size_t)j * 512]; ck[j] = rq[(size_t)j * 512 + 256]; cv[j] = V[(size_t)j * 64]; }
#pragma unroll 1
    for (int s8 = 0; s8 < 8; ++s8) {
        if (s8 < 7) {
#pragma unroll
            for (int j = 0; j < 8; ++j) { const int s = s8 * 8 + 8 + j; nq[j] = rq[(size_t)s * 512]; nk[j] = rq[(size_t)s * 512 + 256]; nv[j] = V[(size_t)s * 64]; }
        }
        float kb[8], vb[8]; bf16_t qo[8], ko[8];
#pragma unroll
        for (int j = 0; j < 8; ++j) {
            const int s = s8 * 8 + j;
            const float q0 = bf2f(cq[j]), k0 = bf2f(ck[j]);
            const float qv = siluf(wq[0] * q3 + wq[1] * q2 + wq[2] * q1 + wq[3] * q0), kv = siluf(wk[0] * k3 + wk[1] * k2 + wk[2] * k1 + wk[3] * k0) * 0.125f;
            q3 = q2; q2 = q1; q1 = q0; k3 = k2; k2 = k1; k1 = k0;
            qo[j] = f2bf(qv); ko[j] = f2bf(kv);
            const float ws_ = __builtin_bit_cast(float, __builtin_amdgcn_readlane(__builtin_bit_cast(int, wgt), s)); kb[j] = bf2f(ko[j]); dn += ws_ * kb[j]; vb[j] = ws_ * bf2f(cv[j]);
        }
#pragma unroll
        for (int j = 0; j < 8; ++j) { QC[(size_t)(s8 * 8 + j) * 64] = qo[j]; KC[(size_t)(s8 * 8 + j) * 64] = ko[j]; }
        u32x4 pk; pk.x = pk_bf16(kb[0], kb[1]); pk.y = pk_bf16(kb[2], kb[3]); pk.z = pk_bf16(kb[4], kb[5]); pk.w = pk_bf16(kb[6], kb[7]);
        *(LAS u32x4*)(wl + swz_off(lane, s8)) = pk;
        pk.x = pk_bf16(vb[0], vb[1]); pk.y = pk_bf16(vb[2], vb[3]); pk.z = pk_bf16(vb[4], vb[5]); pk.w = pk_bf16(vb[6], vb[7]);
        *(LAS u32x4*)(wl + 8192 + swz_off(lane, s8)) = pk;
#pragma unroll
        for (int j = 0; j < 8; ++j) { cq[j] = nq[j]; ck[j] = nk[j]; cv[j] = nv[j]; }
    }
    ((float*)(ws + WS_ML + ML_DN))[(size_t)cu * 64 + lane] = dn;
    LDS_FENCE();
    const int r = lane & 15, q = lane >> 4;
    bf16_t* DL = (bf16_t*)(ws + WS_ML + ML_DELTA) + (size_t)cu * 4096;
#pragma unroll
    for (int mb = 0; mb < 4; ++mb) {
        f32x4 acc[4];
#pragma unroll
        for (int nb = 0; nb < 4; ++nb) acc[nb] = (f32x4){0.f, 0.f, 0.f, 0.f};
#pragma unroll
        for (int ks = 0; ks < 2; ++ks) {
            const bf16x8 a = *(const LAS bf16x8*)(wl + 8192 + swz_off(16 * mb + r, 4 * ks + q));
#pragma unroll
            for (int nb = 0; nb < 4; ++nb) { const bf16x8 bb = *(const LAS bf16x8*)(wl + swz_off(16 * nb + r, 4 * ks + q)); acc[nb] = MFMA16(a, bb, acc[nb]); }
        }
#pragma unroll
        for (int nb = 0; nb < 4; ++nb)
#pragma unroll
            for (int j = 0; j < 4; ++j) DL[(16 * mb + 4 * q + j) * 64 + 16 * nb + r] = f2bf(acc[nb][j]);
    }
    LDS_FENCE();
}

#ifndef TIME_PH
#define TIME_PH -1
#endif
#define PSTAMP(i, blk) do { if (TIME_PH != -1 && l == 0 && blockIdx.x == (blk) && threadIdx.x == 0) ((unsigned long long*)((unsigned*)(ws + WS_CTL) + CW_TS))[i] = __builtin_amdgcn_s_memrealtime(); } while (0)
__device__ __forceinline__ void phase_prep(int l, InPtr in, unsigned char* ws, LAS unsigned char* lds, int bid, int nb) {
    asm volatile("" : "+s"(bid));
    PSTAMP(40, 0);
#ifndef NO_UQ
    { g8::DenseSched S{(const char*)(ws + WS_PRJ + PRJ_DQKV), (const char*)(ws + WS_WUQ) + (size_t)l * 768 * 256 * 2, 384, 256, 64, 3, nb, bid};
      EpiUq E{(const float*)(ws + WS_SSQ + PT_DQ) + (size_t)l * 16384 * 4, in->p[19] + l * 192, (const float*)(ws + WS_ROPE), (bf16_t*)(ws + WS_MLA)};
      g8::gemm_run(lds, 256, 256, S, E); }
#endif
    PSTAMP(41, 0);
#ifndef NO_UKV
    asm volatile("" : "+s"(bid));
    { g8::DenseSched S{(const char*)(ws + WS_PRJ + PRJ_DQKV) + 256, (const char*)(ws + WS_WUKV) + (size_t)l * 768 * 256 * 2, 384, 256, 64, 3, nb, bid};
      EpiUkv E{(const float*)(ws + WS_SSQ + PT_DKV) + (size_t)l * 16384 * 2, in->p[19] + l * 192, (const bf16_t*)(ws + WS_PRJ + PRJ_KR), (bf16_t*)(ws + WS_MLA + MLA_KM), (bf16_t*)(ws + WS_MLA + MLA_VM)};
      g8::gemm_run(lds, 256, 256, S, E); }
#endif
    PSTAMP(42, 0); PSTAMP(44, 255);
    __syncthreads();
#ifndef NO_CMP
    for (int u = nb - 1 - bid; u < 32; u += nb) cmp_unit(u, l, in, ws, lds);
#endif
    PSTAMP(45, 255);
    __syncthreads();
#ifndef NO_DELTA
    { int tid_ = threadIdx.x; asm volatile("" : "+v"(tid_));
      for (int g = bid; g < 128; g += nb) ml_delta_wave(g * 8 + (tid_ >> 6), l, in, ws, lds + (tid_ >> 6) * 16384, tid_ & 63); }
#endif
    __syncthreads(); PSTAMP(43, 0);
}
#define CHK_TOL(st) (((st) & 15) == 8 ? 1e-2f : 1e-3f)
#define CHECK_REST
constexpr int VTP = 136;
__device__ __forceinline__ int crow(int reg, int h) { return (reg & 3) + 8 * (reg >> 2) + 4 * h; }
struct AttnState { f32x16 o[2]; float m, l; };
__device__ __forceinline__ void attn_reset(AttnState& A) { A.m = -1e30f; A.l = 0.f;
#pragma unroll
    for (int i = 0; i < 16; ++i) { A.o[0][i] = 0.f; A.o[1][i] = 0.f; } }

template <int DK>
__device__ __forceinline__ void attn_scores(f32x16 (&s)[2], const bf16x8 (&qf)[DK / 16], const LAS unsigned char* Kt, int r, int h) {
    constexpr int KP = 2 * DK + 16;
#pragma unroll
    for (int kb = 0; kb < 2; ++kb) {
#pragma unroll
        for (int i = 0; i < 16; ++i) s[kb][i] = 0.f;
#pragma unroll
        for (int ks = 0; ks < DK / 16; ++ks) { const bf16x8 kf = *(const LAS bf16x8*)(Kt + (32 * kb + r) * KP + (16 * ks + 8 * h) * 2); s[kb] = MFMA32(kf, qf[ks], s[kb]); }
    }
}
__device__ __forceinline__ void attn_softmax_pv(AttnState& A, f32x16 (&s)[2], const LAS unsigned char* Vt, int r, int h) {
    float mx = -1e30f;
#pragma unroll
    for (int kb = 0; kb < 2; ++kb)
#pragma unroll
        for (int i = 0; i < 16; ++i) mx = fmaxf(mx, s[kb][i]);
    mx = fmaxf(mx, __shfl_xor(mx, 32));
    const float mnew = fmaxf(A.m, mx); const float mref = mnew <= -1e29f ? 0.f : mnew;
    const float alpha = __expf(A.m - mref); float rs = 0.f;
#pragma unroll
    for (int kb = 0; kb < 2; ++kb)
#pragma unroll
        for (int i = 0; i < 16; ++i) { const float p = __expf(s[kb][i] - mref); s[kb][i] = p; rs += p; }
    rs += __shfl_xor(rs, 32);
    A.l = A.l * alpha + rs; A.m = mnew;
#pragma unroll
    for (int i = 0; i < 16; ++i) { A.o[0][i] *= alpha; A.o[1][i] *= alpha; }
#pragma unroll
    for (int s4 = 0; s4 < 4; ++s4) {
        const int kb = s4 >> 1, hf = (s4 & 1) * 8;
        u32x4 pw; pw.x = pk_bf16(s[kb][hf + 0], s[kb][hf + 1]); pw.y = pk_bf16(s[kb][hf + 2], s[kb][hf + 3]); pw.z = pk_bf16(s[kb][hf + 4], s[kb][hf + 5]); pw.w = pk_bf16(s[kb][hf + 6], s[kb][hf + 7]);
        const bf16x8 pf = __builtin_bit_cast(bf16x8, pw);
#pragma unroll
        for (int eb = 0; eb < 2; ++eb) {
            const LAS unsigned char* vp = Vt + (32 * eb + r) * VTP + (16 * s4 + 4 * h) * 2;
            const u32x2 v0 = *(const LAS u32x2*)vp, v1 = *(const LAS u32x2*)(vp + 16);
            u32x4 vw; vw.x = v0.x; vw.y = v0.y; vw.z = v1.x; vw.w = v1.y;
            A.o[eb] = MFMA32(__builtin_bit_cast(bf16x8, vw), pf, A.o[eb]);
        }
    }
}
template <int DK>
__device__ __forceinline__ void stage_k_load(u32x4 (&kr)[2], const bf16_t* Kg  , int tid) {
    constexpr int CH = DK / 8;
    kr[0] = *(const u32x4*)(Kg + (size_t)(tid / CH) * DK + (tid % CH) * 8);
    if (64 * CH > 512) { const int c2 = tid + 512; if (c2 < 64 * CH) kr[1] = *(const u32x4*)(Kg + (size_t)(c2 / CH) * DK + (c2 % CH) * 8); }
}
template <int DK>
__device__ __forceinline__ void stage_k_store(const u32x4 (&kr)[2], LAS unsigned char* Kt, int tid) {
    constexpr int CH = DK / 8, KP = 2 * DK + 16;
    *(LAS u32x4*)(Kt + (tid / CH) * KP + (tid % CH) * 16) = kr[0];
    if (64 * CH > 512) { const int c2 = tid + 512; if (c2 < 64 * CH) *(LAS u32x4*)(Kt + (c2 / CH) * KP + (c2 % CH) * 16) = kr[1]; }
}
__device__ __forceinline__ u32x4 stage_v_load(const bf16_t* Vg, int tid) { return *(const u32x4*)(Vg + (size_t)(tid >> 3) * 64 + (tid & 7) * 8); }
__device__ __forceinline__ void stage_v_store(const u32x4& v, LAS unsigned char* Vt, int tid) {
    const int key = tid >> 3, e0 = (tid & 7) * 8; LAS bf16_t* p = (LAS bf16_t*)(Vt + e0 * VTP + key * 2);
    p[0] = (bf16_t)(v.x & 0xffff); p[VTP / 2] = (bf16_t)(v.x >> 16); p[2 * (VTP / 2)] = (bf16_t)(v.y & 0xffff); p[3 * (VTP / 2)] = (bf16_t)(v.y >> 16);
    p[4 * (VTP / 2)] = (bf16_t)(v.z & 0xffff); p[5 * (VTP / 2)] = (bf16_t)(v.z >> 16); p[6 * (VTP / 2)] = (bf16_t)(v.w & 0xffff); p[7 * (VTP / 2)] = (bf16_t)(v.w >> 16);
}

constexpr int MLA_KT = 0, MLA_VT = 2 * 64 * 208, MLA_LDS = MLA_VT + 2 * 64 * VTP;
__device__ __forceinline__ void mla_unit(int b, int hd, int qt, int l, unsigned char* ws, LAS unsigned char* lds) {
    int tid_ = threadIdx.x; asm volatile("" : "+v"(tid_));
    const int tid = tid_, w = tid >> 6, lane = tid & 63, r = lane & 31, h = lane >> 5;
    const size_t slab = (size_t)(b * 6 + hd) * 2048;
    const bf16_t* QM = (const bf16_t*)(ws + WS_MLA) + slab * 96; const bf16_t* KM = (const bf16_t*)(ws + WS_MLA + MLA_KM) + slab * 96; const bf16_t* VM = (const bf16_t*)(ws + WS_MLA + MLA_VM) + slab * 64;
    const int q0 = 256 * qt + 32 * w, q = q0 + r;
    bf16x8 qf[6];
#pragma unroll
    for (int ks = 0; ks < 6; ++ks) qf[ks] = *(const bf16x8*)(QM + (size_t)q * 96 + 16 * ks + 8 * h);
    AttnState A; attn_reset(A);
    const int ntile = 4 * qt + 4;
    u32x4 kr[2], vr;
    stage_k_load<96>(kr, KM, tid); vr = stage_v_load(VM, tid);
    stage_k_store<96>(kr, lds + MLA_KT, tid); stage_v_store(vr, lds + MLA_VT, tid);
    __syncthreads();
    for (int j = 0; j < ntile; ++j) {
        const int cur = j & 1;
        if (j + 1 < ntile) { stage_k_load<96>(kr, KM + (size_t)(j + 1) * 64 * 96, tid); vr = stage_v_load(VM + (size_t)(j + 1) * 64 * 64, tid); }
        if (64 * j <= q0 + 31) {
            f32x16 s[2];
            attn_scores<96>(s, qf, lds + MLA_KT + cur * 64 * 208, r, h);
            if (64 * j + 63 > q0) {
#pragma unroll
                for (int kb = 0; kb < 2; ++kb)
#pragma unroll
                    for (int i = 0; i < 16; ++i) { const int key = 64 * j + 32 * kb + crow(i, h); if (key > q) s[kb][i] = -1e30f; }
            }
            attn_softmax_pv(A, s, lds + MLA_VT + cur * 64 * VTP, r, h);
        }
        if (j + 1 < ntile) { stage_k_store<96>(kr, lds + MLA_KT + (cur ^ 1) * 64 * 208, tid); stage_v_store(vr, lds + MLA_VT + (cur ^ 1) * 64 * VTP, tid); }
        __syncthreads();
    }
    const float inv = A.l > 0.f ? 1.f / A.l : 0.f; float ss = 0.f;
    bf16_t* Y = (bf16_t*)(ws + WS_Y) + ((size_t)b * 2048 + q) * 1024 + 640 + hd * 64;
#pragma unroll
    for (int eb = 0; eb < 2; ++eb)
#pragma unroll
        for (int g4 = 0; g4 < 4; ++g4) {
            const float v0 = A.o[eb][4 * g4] * inv, v1 = A.o[eb][4 * g4 + 1] * inv, v2 = A.o[eb][4 * g4 + 2] * inv, v3 = A.o[eb][4 * g4 + 3] * inv;
            u32x2 pw; pw.x = pk_bf16(v0, v1); pw.y = pk_bf16(v2, v3);
            const float f0 = bf_lo(pw.x), f1 = bf_hi(pw.x), f2 = bf_lo(pw.y), f3 = bf_hi(pw.y); ss += (f0 * f0 + f1 * f1) + (f2 * f2 + f3 * f3);
            *(u32x2*)(Y + 32 * eb + 8 * g4 + 4 * h) = pw;
        }
    ss += __shfl_xor(ss, 32);
    if (h == 0) ((float*)(ws + WS_SSQ + PT_C))[((size_t)l * 16384 + (size_t)b * 2048 + q) * 8 + hd] = ss;
}

__device__ __forceinline__ void nsa_mask_bias(f32x16 (&sc)[2], int dq, int h, const LAS float* bl, bool sel, int lim) {
    int dd = dq - 4 * h - 63; asm volatile("" : "+v"(dd));
    const LAS float* bp = bl + dd;
#pragma unroll
    for (int kb = 0; kb < 2; ++kb)
#pragma unroll
        for (int k = 0; k < 16; ++k) { const int c = 63 - (32 * kb + (k & 3) + 8 * (k >> 2)); const int d = dd + c; sc[kb][k] = (sel && d >= 0 && d < lim) ? sc[kb][k] + bp[c] : -1e30f; }
}

constexpr int NSA_KT = 0, NSA_VT = 2 * 64 * 144, NSA_BIAS = NSA_VT + 2 * 64 * VTP, NSA_PS = NSA_BIAS + 3 * 2048 * 4, NSA_SEL = NSA_PS + 3 * 64 * 32 * 4, NSA_UNI = NSA_SEL + 256, NSA_LDS = NSA_UNI + 16;
__device__ __forceinline__ void nsa_unit(int b, int hk, int i, int l, InPtr in, unsigned char* ws, LAS unsigned char* lds) {
    int tid_ = threadIdx.x; asm volatile("" : "+v"(tid_));
    const int tid = tid_, w = tid >> 6, lane = tid & 63, r = lane & 31, h = lane >> 5;
    const bool active = w < 6; const int g = active ? (w >> 1) : 0, th = w & 1, head = hk * 3 + g;
    const int t = 64 * i + 32 * th + r, tl = 32 * th + r; const size_t row = (size_t)b * 2048 + t;
    const size_t kvslab = (size_t)(b * 2 + hk) * 2048 * 64;
    LAS float* biasl = (LAS float*)(lds + NSA_BIAS); LAS float* PS = (LAS float*)(lds + NSA_PS); LAS unsigned* SEL = (LAS unsigned*)(lds + NSA_SEL); LAS unsigned* UNI = (LAS unsigned*)(lds + NSA_UNI);
    { const float* bd = (const float*)(ws + WS_BIASD) + (size_t)hk * 3 * 2048;
#pragma unroll
      for (int k = 0; k < 12; ++k) biasl[tid + 512 * k] = bd[tid + 512 * k];
#pragma unroll
      for (int k = 0; k < 12; ++k) PS[tid + 512 * k] = 0.f;
      if (tid < 4) UNI[tid] = 0u; }
    bf16x8 qf[4];
    { const bf16_t* QN = (const bf16_t*)(ws + WS_PRJ + PRJ_QN) + ((size_t)(b * 6 + head) * 2048 + t) * 64;
#pragma unroll
      for (int ks = 0; ks < 4; ++ks) qf[ks] = *(const bf16x8*)(QN + 16 * ks + 8 * h); }
#define NSA_GATE(k) ({ int t_ = t; asm volatile("" : "+v"(t_)); sigmf(((const float*)(ws + WS_PRJ + PRJ_GATES))[((size_t)b * 2048 + t_) * 32 + head * 3 + (k)]); })
    LAS float* bl = biasl + g * 2048;
    f32x16 ot[2];
    u32x4 kr[2], vr;
    const int ntc = i >= 16 ? 2 : 1;
    { const bf16_t* KC = (const bf16_t*)(ws + WS_CMP) + (size_t)(b * 2 + hk) * 128 * 64; const bf16_t* VC = (const bf16_t*)(ws + WS_CMP + CMP_V) + (size_t)(b * 2 + hk) * 128 * 64;
      for (int T = 0; T < ntc; ++T) { stage_k_load<64>(kr, KC + T * 4096, tid); vr = stage_v_load(VC + T * 4096, tid); stage_k_store<64>(kr, lds + NSA_KT + T * 64 * 144, tid); stage_v_store(vr, lds + NSA_VT + T * 64 * VTP, tid); } }
    __syncthreads();
    {
        if (active) {
            float m = -1e30f, lsum = 0.f;
            for (int T = 0; T < ntc; ++T) {
                f32x16 sc[2]; attn_scores<64>(sc, qf, lds + NSA_KT + T * 64 * 144, r, h);
                float mx = -1e30f;
#pragma unroll
                for (int kb = 0; kb < 2; ++kb)
#pragma unroll
                    for (int k = 0; k < 16; ++k) { const int n = 64 * T + 32 * kb + crow(k, h); const int d = t - 16 * n - 31; const float x = (d >= 0 && n < 127) ? sc[kb][k] + bl[d] : -1e30f; sc[kb][k] = x; mx = fmaxf(mx, x); }
                mx = fmaxf(mx, __shfl_xor(mx, 32));
                const float mnew = fmaxf(m, mx), mref = mnew <= -1e29f ? 0.f : mnew; float rs = 0.f;
#pragma unroll
                for (int kb = 0; kb < 2; ++kb)
#pragma unroll
                    for (int k = 0; k < 16; ++k) rs += __expf(sc[kb][k] - mref);
                rs += __shfl_xor(rs, 32);
                lsum = lsum * __expf(m - mref) + rs; m = mnew;
            }
            const float mref = m <= -1e29f ? 0.f : m, inv = lsum > 0.f ? 1.f / lsum : 0.f;
#pragma unroll
            for (int k = 0; k < 16; ++k) { ot[0][k] = 0.f; ot[1][k] = 0.f; }
            float carry = 0.f;
            for (int T = 0; T < ntc; ++T) {
                f32x16 sc[2]; attn_scores<64>(sc, qf, lds + NSA_KT + T * 64 * 144, r, h);
#pragma unroll
                for (int kb = 0; kb < 2; ++kb)
#pragma unroll
                    for (int k = 0; k < 16; ++k) { const int n = 64 * T + 32 * kb + crow(k, h); const int d = t - 16 * n - 31; sc[kb][k] = (d >= 0 && n < 127) ? __expf(sc[kb][k] + bl[d] - mref) * inv : 0.f; }
                float prevL = carry;
#pragma unroll
                for (int kb = 0; kb < 2; ++kb)
#pragma unroll
                    for (int g4 = 0; g4 < 4; ++g4) {
                        const float G4 = (sc[kb][4 * g4] + sc[kb][4 * g4 + 1]) + (sc[kb][4 * g4 + 2] + sc[kb][4 * g4 + 3]); const float L = sc[kb][4 * g4 + 3];
                        const float Lo = __shfl_xor(L, 32);
                        const float add = h ? Lo : prevL;
                        prevL = Lo;
                        const int idx = T * 8 + kb * 4 + g4;
                        PS[g * 2048 + tl * 32 + 2 * idx + h] = G4 + add;
                    }
                carry = prevL;
#pragma unroll
                for (int s4 = 0; s4 < 4; ++s4) {
                    const int kb = s4 >> 1, hf = (s4 & 1) * 8;
                    u32x4 pw; pw.x = pk_bf16(sc[kb][hf + 0], sc[kb][hf + 1]); pw.y = pk_bf16(sc[kb][hf + 2], sc[kb][hf + 3]); pw.z = pk_bf16(sc[kb][hf + 4], sc[kb][hf + 5]); pw.w = pk_bf16(sc[kb][hf + 6], sc[kb][hf + 7]);
                    const bf16x8 pf = __builtin_bit_cast(bf16x8, pw);
#pragma unroll
                    for (int eb = 0; eb < 2; ++eb) {
                        const LAS unsigned char* vp = lds + NSA_VT + T * 64 * VTP + (32 * eb + r) * VTP + (16 * s4 + 4 * h) * 2;
                        const u32x2 v0 = *(const LAS u32x2*)vp, v1 = *(const LAS u32x2*)(vp + 16);
                        u32x4 vw; vw.x = v0.x; vw.y = v0.y; vw.z = v1.x; vw.w = v1.y;
                        ot[eb] = MFMA32(__builtin_bit_cast(bf16x8, vw), pf, ot[eb]);
                    }
                }
            }
            { const float gc = NSA_GATE(0);
#pragma unroll
            for (int k = 0; k < 16; ++k) { ot[0][k] *= gc; ot[1][k] *= gc; } }
        } else {
#pragma unroll
            for (int k = 0; k < 16; ++k) { ot[0][k] = 0.f; ot[1][k] = 0.f; }
        }
    }
    __syncthreads();
#ifndef NO_NSA_SEL
    {
        const int tk = tid >> 3, sg = tid & 7; float v[32];
#pragma unroll
        for (int k = 0; k < 8; ++k) { const f32x4 x0 = *(const LAS f32x4*)(PS + tk * 32 + 4 * k), x1 = *(const LAS f32x4*)(PS + 2048 + tk * 32 + 4 * k), x2 = *(const LAS f32x4*)(PS + 4096 + tk * 32 + 4 * k);
            v[4 * k] = (x0.x + x1.x) + x2.x; v[4 * k + 1] = (x0.y + x1.y) + x2.y; v[4 * k + 2] = (x0.z + x1.z) + x2.z; v[4 * k + 3] = (x0.w + x1.w) + x2.w; }
#pragma unroll
        for (int s = 0; s < 32; ++s) { const bool forced = (s == 0) || (s == i) || (s == i - 1); float x = forced ? v[s] + 1e4f : v[s]; v[s] = s > i ? -1.f : x; }
        unsigned bits = 0u;
#pragma unroll
        for (int k = 0; k < 4; ++k) {
            float x = 0.f;
#pragma unroll
            for (int s = 0; s < 32; ++s) x = (s == 4 * sg + k) ? v[s] : x;
            int rank = 0;
#pragma unroll
            for (int s = 0; s < 32; ++s) rank += (v[s] > x || (v[s] == x && s < 4 * sg + k)) ? 1 : 0;
            if (rank < 16 && x >= 0.f) bits |= 1u << (4 * sg + k);
        }
        bits |= __shfl_xor(bits, 1); bits |= __shfl_xor(bits, 2); bits |= __shfl_xor(bits, 4);
        if (sg == 0) { SEL[tk] = bits; __hip_atomic_fetch_or(UNI, bits, __ATOMIC_RELAXED, __HIP_MEMORY_SCOPE_WORKGROUP); __hip_atomic_fetch_or(UNI + 1 + (tk >> 5), bits, __ATOMIC_RELAXED, __HIP_MEMORY_SCOPE_WORKGROUP); }
    }
#endif
    __syncthreads();
    const unsigned selbits = SEL[tl], uni = UNI[0], unih = UNI[1 + th];
    const float c31 = bl[2047];
#ifndef NO_NSA_SLC
    {
        AttnState A; attn_reset(A);
        const bf16_t* KS = (const bf16_t*)(ws + WS_PRJ + PRJ_KN1) + kvslab; const bf16_t* VS = (const bf16_t*)(ws + WS_PRJ + PRJ_VN1) + kvslab;
        unsigned todo = uni; int cur = 0;
        int s = __ffs(todo) - 1; todo &= todo - 1;
        stage_k_load<64>(kr, KS + (size_t)s * 4096, tid); vr = stage_v_load(VS + (size_t)s * 4096, tid);
        stage_k_store<64>(kr, lds + NSA_KT, tid); stage_v_store(vr, lds + NSA_VT, tid);
        __syncthreads();
        while (s >= 0) {
            const int sn = todo ? __ffs(todo) - 1 : -1; todo &= todo - 1;
            if (sn >= 0) { stage_k_load<64>(kr, KS + (size_t)sn * 4096, tid); vr = stage_v_load(VS + (size_t)sn * 4096, tid); }
            if (active && ((unih >> s) & 1u)) {
                f32x16 sc[2];
                attn_scores<64>(sc, qf, lds + NSA_KT + cur * 64 * 144, r, h);
                const bool sel = (selbits >> s) & 1u;
                if (i - s >= 3) {
#pragma unroll
                    for (int kb = 0; kb < 2; ++kb)
#pragma unroll
                        for (int k = 0; k < 16; ++k) sc[kb][k] = sel ? sc[kb][k] + c31 : -1e30f;
                } else nsa_mask_bias(sc, t - 64 * s, h, bl, sel, 4096);
                attn_softmax_pv(A, sc, lds + NSA_VT + cur * 64 * VTP, r, h);
            }
            if (sn >= 0) { stage_k_store<64>(kr, lds + NSA_KT + (cur ^ 1) * 64 * 144, tid); stage_v_store(vr, lds + NSA_VT + (cur ^ 1) * 64 * VTP, tid); }
            __syncthreads();
            s = sn; cur ^= 1;
        }
        const float gs = NSA_GATE(1); const float inv = A.l > 0.f ? gs / A.l : 0.f;
#pragma unroll
        for (int k = 0; k < 16; ++k) { ot[0][k] += A.o[0][k] * inv; ot[1][k] += A.o[1][k] * inv; }
    }
#endif
#ifndef NO_NSA_WIN
    {
        AttnState A; attn_reset(A);
        const bf16_t* KW = (const bf16_t*)(ws + WS_PRJ + PRJ_KN2) + kvslab; const bf16_t* VW = (const bf16_t*)(ws + WS_PRJ + PRJ_VN2) + kvslab;
        const int j0 = i > 8 ? i - 8 : 0; int cur = 0;
        stage_k_load<64>(kr, KW + (size_t)j0 * 4096, tid); vr = stage_v_load(VW + (size_t)j0 * 4096, tid);
        stage_k_store<64>(kr, lds + NSA_KT, tid); stage_v_store(vr, lds + NSA_VT, tid);
        __syncthreads();
        for (int j = j0; j <= i; ++j) {
            if (j < i) { stage_k_load<64>(kr, KW + (size_t)(j + 1) * 4096, tid); vr = stage_v_load(VW + (size_t)(j + 1) * 4096, tid); }
            if (active) {
                f32x16 sc[2];
                attn_scores<64>(sc, qf, lds + NSA_KT + cur * 64 * 144, r, h);
                if (i - j >= 3 && j > i - 8) {
#pragma unroll
                    for (int kb = 0; kb < 2; ++kb)
#pragma unroll
                        for (int k = 0; k < 16; ++k) sc[kb][k] += c31;
                } else nsa_mask_bias(sc, t - 64 * j, h, bl, true, 512);
                attn_softmax_pv(A, sc, lds + NSA_VT + cur * 64 * VTP, r, h);
            }
            if (j < i) { stage_k_store<64>(kr, lds + NSA_KT + (cur ^ 1) * 64 * 144, tid); stage_v_store(vr, lds + NSA_VT + (cur ^ 1) * 64 * VTP, tid); }
            __syncthreads();
            cur ^= 1;
        }
        const float gw = NSA_GATE(2); const float inv = A.l > 0.f ? gw / A.l : 0.f;
#pragma unroll
        for (int k = 0; k < 16; ++k) { ot[0][k] += A.o[0][k] * inv; ot[1][k] += A.o[1][k] * inv; }
    }
#endif
    if (active) {
        float ss = 0.f; bf16_t* Y = (bf16_t*)(ws + WS_Y) + row * 1024 + head * 64;
#pragma unroll
        for (int eb = 0; eb < 2; ++eb)
#pragma unroll
            for (int g4 = 0; g4 < 4; ++g4) {
                u32x2 pw; pw.x = pk_bf16(ot[eb][4 * g4], ot[eb][4 * g4 + 1]); pw.y = pk_bf16(ot[eb][4 * g4 + 2], ot[eb][4 * g4 + 3]);
                const float f0 = bf_lo(pw.x), f1 = bf_hi(pw.x), f2 = bf_lo(pw.y), f3 = bf_hi(pw.y); ss += (f0 * f0 + f1 * f1) + (f2 * f2 + f3 * f3);
                *(u32x2*)(Y + 32 * eb + 8 * g4 + 4 * h) = pw;
            }
        ss += __shfl_xor(ss, 32);
        if (h == 0) ((float*)(ws + WS_SSQ + PT_A))[((size_t)l * 16384 + row) * 8 + head] = ss;
    }
}

__device__ __forceinline__ void ml_out_wave(int cu, int l, InPtr in, unsigned char* ws, LAS unsigned char* wl, LAS unsigned char* npl, int lane) {
    const int c = cu & 31, bh = cu >> 5, hd = bh & 3, b = bh >> 2; const int t0 = c * 64; const int r = lane & 15, q = lane >> 4;
    const bf16_t* QC = (const bf16_t*)(ws + WS_ML) + ((size_t)bh * 2048 + t0) * 64; const bf16_t* KC = (const bf16_t*)(ws + WS_ML + ML_KC) + ((size_t)bh * 2048 + t0) * 64;
    const bf16_t* V = (const bf16_t*)(ws + WS_PRJ + PRJ_VML) + ((size_t)bh * 2048 + t0) * 64;
    const float* mlg = (const float*)(ws + WS_ML + ML_G) + ((size_t)bh * 2048 + t0) * 2;
    const bf16_t* CP = (const bf16_t*)(ws + WS_ML + ML_CP) + (size_t)cu * 4096; const bf16_t* NP = (const bf16_t*)(ws + WS_ML + ML_NP) + (size_t)cu * 64;
    bf16x8 aq[4][2];
#pragma unroll
    for (int mb = 0; mb < 4; ++mb)
#pragma unroll
        for (int ks = 0; ks < 2; ++ks) aq[mb][ks] = *(const bf16x8*)(QC + (size_t)(16 * mb + r) * 64 + 32 * ks + 8 * q);
    float bj[4][4], den[4][4];
#pragma unroll
    for (int mb = 0; mb < 4; ++mb)
#pragma unroll
        for (int j = 0; j < 4; ++j) bj[mb][j] = mlg[(16 * mb + 4 * q + j) * 2];
    {
        float cs[4];
#pragma unroll
        for (int nb = 0; nb < 4; ++nb) { const float2 gg = *(const float2*)(mlg + (16 * nb + r) * 2); cs[nb] = gg.y - gg.x; }
#pragma unroll
        for (int mb = 0; mb < 4; ++mb) {
            f32x4 accS[4];
#pragma unroll
            for (int nb = 0; nb < 4; ++nb) { accS[nb] = (f32x4){0.f, 0.f, 0.f, 0.f};
#pragma unroll
                for (int ks = 0; ks < 2; ++ks) { const bf16x8 bk = *(const bf16x8*)(KC + (size_t)(16 * nb + r) * 64 + 32 * ks + 8 * q); accS[nb] = MFMA16(aq[mb][ks], bk, accS[nb]); } }
#pragma unroll
            for (int j = 0; j < 4; ++j) {
                const int jj = 16 * mb + 4 * q + j; float rs = 0.f;
#pragma unroll
                for (int nb = 0; nb < 4; ++nb) { const int s = 16 * nb + r; const float p = s <= jj ? accS[nb][j] * __expf(bj[mb][j] + cs[nb]) : 0.f; rs += p;
                    *(LAS bf16_t*)(wl + 8192 + swz_off(jj, s >> 3) + (s & 7) * 2) = f2bf(p); }
                rs += __shfl_xor(rs, 1); rs += __shfl_xor(rs, 2); rs += __shfl_xor(rs, 4); rs += __shfl_xor(rs, 8);
                den[mb][j] = rs;
            }
        }
    }
#pragma unroll
    for (int mb = 0; mb < 4; ++mb) { const float e = __expf(mlg[(16 * mb + r) * 2]);
#pragma unroll
        for (int ks = 0; ks < 2; ++ks) { const u32x4 x = __builtin_bit_cast(u32x4, aq[mb][ks]); u32x4 y;
            y.x = pk_bf16(bf_lo(x.x) * e, bf_hi(x.x) * e); y.y = pk_bf16(bf_lo(x.y) * e, bf_hi(x.y) * e); y.z = pk_bf16(bf_lo(x.z) * e, bf_hi(x.z) * e); y.w = pk_bf16(bf_lo(x.w) * e, bf_hi(x.w) * e);
            aq[mb][ks] = __builtin_bit_cast(bf16x8, y); } }
    f32x4 acc[4][4], accn[4];
#pragma unroll
    for (int mb = 0; mb < 4; ++mb) { accn[mb] = (f32x4){0.f, 0.f, 0.f, 0.f};
#pragma unroll
        for (int nb = 0; nb < 4; ++nb) acc[mb][nb] = (f32x4){0.f, 0.f, 0.f, 0.f}; }
#pragma unroll
    for (int ks = 0; ks < 2; ++ks) {
        u32x4 nz = *(const u32x4*)(NP + 32 * ks + 8 * q); if (r != 0) nz = (u32x4){0u, 0u, 0u, 0u};
        const bf16x8 bn = __builtin_bit_cast(bf16x8, nz);
#pragma unroll
        for (int nb = 0; nb < 4; ++nb) { const bf16x8 bb = *(const bf16x8*)(CP + (size_t)(16 * nb + r) * 64 + 32 * ks + 8 * q);
#pragma unroll
            for (int mb = 0; mb < 4; ++mb) acc[mb][nb] = MFMA16(aq[mb][ks], bb, acc[mb][nb]); }
#pragma unroll
        for (int mb = 0; mb < 4; ++mb) accn[mb] = MFMA16(aq[mb][ks], bn, accn[mb]);
    }
#pragma unroll
    for (int s8 = 0; s8 < 8; ++s8) { float vb[8];
#pragma unroll
        for (int j = 0; j < 8; ++j) vb[j] = bf2f(V[(size_t)(s8 * 8 + j) * 64 + lane]);
        u32x4 pk; pk.x = pk_bf16(vb[0], vb[1]); pk.y = pk_bf16(vb[2], vb[3]); pk.z = pk_bf16(vb[4], vb[5]); pk.w = pk_bf16(vb[6], vb[7]);
        *(LAS u32x4*)(wl + swz_off(lane, s8)) = pk; }
    LDS_FENCE();
#pragma unroll
    for (int ks = 0; ks < 2; ++ks) {
        bf16x8 ap[4];
#pragma unroll
        for (int mb = 0; mb < 4; ++mb) ap[mb] = *(const LAS bf16x8*)(wl + 8192 + swz_off(16 * mb + r, 4 * ks + q));
#pragma unroll
        for (int nb = 0; nb < 4; ++nb) { const bf16x8 bv = *(const LAS bf16x8*)(wl + swz_off(16 * nb + r, 4 * ks + q));
#pragma unroll
            for (int mb = 0; mb < 4; ++mb) acc[mb][nb] = MFMA16(ap[mb], bv, acc[mb][nb]); }
    }
    LDS_FENCE();
    const float* gain = in->p[14] + l * 256 + hd * 64; const bf16_t* OG = (const bf16_t*)(ws + WS_PRJ + PRJ_OG);
    bf16_t* Y = (bf16_t*)(ws + WS_Y);
#pragma unroll
    for (int mb = 0; mb < 4; ++mb)
#pragma unroll
        for (int j = 0; j < 4; ++j) {
            const int jj = 16 * mb + 4 * q + j;
            const float dn = den[mb][j] + __shfl(accn[mb][j], lane & 48);
            const float inv = 1.f / fmaxf(fabsf(dn), 1.f); float hv[4]; float ss = 0.f;
#pragma unroll
            for (int nb = 0; nb < 4; ++nb) { hv[nb] = acc[mb][nb][j] * inv; ss += hv[nb] * hv[nb]; }
            ss += __shfl_xor(ss, 1); ss += __shfl_xor(ss, 2); ss += __shfl_xor(ss, 4); ss += __shfl_xor(ss, 8);
            const float rstd = rsqrtf(ss * (1.f / 64.f) + 1e-6f); const size_t row = (size_t)b * 2048 + t0 + jj;
#pragma unroll
            for (int nb = 0; nb < 4; ++nb) { const int e = 16 * nb + r; Y[row * 1024 + 384 + hd * 64 + e] = f2bf(hv[nb] * rstd * gain[e] * sigmf(bf2f(OG[row * 256 + hd * 64 + e]))); }
        }
}

__device__ __forceinline__ void ml_scan_unit(int bh, int l, unsigned char* ws) {
    int tid_ = threadIdx.x; asm volatile("" : "+v"(tid_)); const int tid = tid_;
    const bf16_t* DL = (const bf16_t*)(ws + WS_ML + ML_DELTA) + (size_t)bh * 32 * 4096 + tid * 8; bf16_t* CP = (bf16_t*)(ws + WS_ML + ML_CP) + (size_t)bh * 32 * 4096 + tid * 8;
    const float* DN = (const float*)(ws + WS_ML + ML_DN) + (size_t)bh * 32 * 64; bf16_t* NP = (bf16_t*)(ws + WS_ML + ML_NP) + (size_t)bh * 32 * 64; const float* BL = (const float*)(ws + WS_ML + ML_BL) + bh * 32;
    float c[8]; float n = 0.f;
#pragma unroll
    for (int k = 0; k < 8; ++k) c[k] = 0.f;
#pragma unroll 1
    for (int c0 = 0; c0 < 32; c0 += 8) {
        u32x4 d[8]; float dn[8], co[8];
#pragma unroll
        for (int k = 0; k < 8; ++k) { d[k] = *(const u32x4*)(DL + (size_t)(c0 + k) * 4096); dn[k] = tid < 64 ? DN[(c0 + k) * 64 + tid] : 0.f; co[k] = __expf(BL[c0 + k]); }
#pragma unroll
        for (int k = 0; k < 8; ++k) {
            u32x4 o; o.x = pk_bf16(c[0], c[1]); o.y = pk_bf16(c[2], c[3]); o.z = pk_bf16(c[4], c[5]); o.w = pk_bf16(c[6], c[7]);
            *(u32x4*)(CP + (size_t)(c0 + k) * 4096) = o; if (tid < 64) NP[(c0 + k) * 64 + tid] = f2bf(n);
            c[0] = co[k] * c[0] + bf_lo(d[k].x); c[1] = co[k] * c[1] + bf_hi(d[k].x); c[2] = co[k] * c[2] + bf_lo(d[k].y); c[3] = co[k] * c[3] + bf_hi(d[k].y);
            c[4] = co[k] * c[4] + bf_lo(d[k].z); c[5] = co[k] * c[5] + bf_hi(d[k].z); c[6] = co[k] * c[6] + bf_lo(d[k].w); c[7] = co[k] * c[7] + bf_hi(d[k].w);
            n = co[k] * n + dn[k];
        }
    }
    asm volatile("s_waitcnt vmcnt(0)" ::: "memory"); __syncthreads();
    if (tid == 0) { __builtin_amdgcn_fence(__ATOMIC_RELEASE, "agent"); asm volatile("s_waitcnt vmcnt(0)" ::: "memory");
        __hip_atomic_fetch_add((unsigned*)(ws + WS_CTL) + CW_SCAN + 64 * l, 1u, __ATOMIC_RELAXED, __HIP_MEMORY_SCOPE_AGENT); }
}
__device__ __forceinline__ void ml_scan_wait(int l, unsigned char* ws) {
    if (threadIdx.x == 0) { unsigned* p = (unsigned*)(ws + WS_CTL) + CW_SCAN + 64 * l; unsigned sp = 0;
        while (__hip_atomic_load(p, __ATOMIC_RELAXED, __HIP_MEMORY_SCOPE_AGENT) < 32u) { __builtin_amdgcn_s_sleep(2); if (++sp > (1u << 22)) break; }
        __builtin_amdgcn_fence(__ATOMIC_ACQUIRE, "agent"); asm volatile("s_waitcnt vmcnt(0)" ::: "memory"); }
    __syncthreads();
}

#ifndef DUP_NSA
#define DUP_NSA 1
#endif
#ifndef DUP_MLA
#define DUP_MLA 1
#endif
#ifndef DUP_ML
#define DUP_ML 1
#endif
#ifdef NO_MLA
#define MLA_CALL(...) do {} while (0)
#else
#define MLA_CALL(...) do { for (int rp = 0; rp < DUP_MLA; ++rp) { if (rp) __syncthreads(); mla_unit(__VA_ARGS__); } } while (0)
#endif
__device__ __forceinline__ void phase_mix(int l, InPtr in, unsigned char* ws, LAS unsigned char* lds, unsigned* qhead) {
    LAS int* slot = (LAS int*)(lds + LDS_MISC + 64);
    for (;;) {
        __syncthreads();
        if (threadIdx.x == 0) *slot = (int)__hip_atomic_fetch_add(qhead, 1u, __ATOMIC_RELAXED, __HIP_MEMORY_SCOPE_AGENT);
        __syncthreads();
        int u = *slot;
        if (u >= 32 + 512 + 384 + 128) break;
        if (u < 32) { ml_scan_unit(u, l, ws); continue; } u -= 32;
#ifndef NO_NSA
        if (u < 256) { const int i = 31 - (u >> 4), bh = u & 15; { for (int rp = 0; rp < DUP_NSA; ++rp) { if (rp) __syncthreads(); nsa_unit(bh >> 1, bh & 1, i, l, in, ws, lds); } } continue; }
#endif
        u -= 256;
        if (u < 192) { const int qt = 7 - u / 48, bh = u % 48; MLA_CALL(bh / 6, bh % 6, qt, l, ws, lds); continue; }
        u -= 192;
#ifndef NO_NSA
        if (u < 128) { const int i = 15 - (u >> 4), bh = u & 15; { for (int rp = 0; rp < DUP_NSA; ++rp) { if (rp) __syncthreads(); nsa_unit(bh >> 1, bh & 1, i, l, in, ws, lds); } } continue; }
#endif
        u -= 128;
        if (u < 192) { const int qt = 3 - u / 48, bh = u % 48; MLA_CALL(bh / 6, bh % 6, qt, l, ws, lds); continue; } u -= 192;
#ifndef NO_NSA
        if (u < 128) { const int i = 7 - (u >> 4), bh = u & 15; { for (int rp = 0; rp < DUP_NSA; ++rp) { if (rp) __syncthreads(); nsa_unit(bh >> 1, bh & 1, i, l, in, ws, lds); } } continue; }
#endif
        u -= 128;
#ifndef NO_MLOUT
        ml_scan_wait(l, ws);
        for (int rp = 0; rp < DUP_ML; ++rp) { int tid_ = threadIdx.x; asm volatile("" : "+v"(tid_)); const int w = tid_ >> 6; ml_out_wave(u * 8 + w, l, in, ws, lds + w * 16384, lds + 131072 + w * 256, tid_ & 63); }
#endif
    }
}
__device__ __forceinline__ void phase_ynorm(int l, unsigned char* ws, int bid, int nb) {
    int tid_ = threadIdx.x; asm volatile("" : "+v"(tid_)); const int w = tid_ >> 6, lane = tid_ & 63;
    bf16_t* Y = (bf16_t*)(ws + WS_Y); const float* sa = (const float*)(ws + WS_SSQ + PT_A) + (size_t)l * 16384 * 8; const float* sc = (const float*)(ws + WS_SSQ + PT_C) + (size_t)l * 16384 * 8;
    for (int r0 = (bid * 8 + w) * 8; r0 < NTOK; r0 += nb * 64) {
        if (lane < 48) {
            u32x4 x[8], y[8]; float ra[8], rc[8];
#pragma unroll
            for (int k = 0; k < 8; ++k) { const int row = r0 + k;
                const f32x4 a0 = *(const f32x4*)(sa + (size_t)row * 8), a1 = *(const f32x4*)(sa + (size_t)row * 8 + 4), c0 = *(const f32x4*)(sc + (size_t)row * 8), c1 = *(const f32x4*)(sc + (size_t)row * 8 + 4);
                ra[k] = rsqrtf((((a0.x + a0.y) + (a0.z + a0.w)) + (a1.x + a1.y)) * (1.f / 384.f) + 1e-6f); rc[k] = rsqrtf((((c0.x + c0.y) + (c0.z + c0.w)) + (c1.x + c1.y)) * (1.f / 384.f) + 1e-6f);
                x[k] = *((const u32x4*)(Y + (size_t)row * 1024) + lane); y[k] = *((const u32x4*)(Y + (size_t)row * 1024 + 640) + lane); }
#pragma unroll
            for (int k = 0; k < 8; ++k) { const int row = r0 + k; u32x4 a = x[k], c = y[k]; const float fa = ra[k], fc = rc[k];
                a.x = pk_bf16(bf_lo(a.x) * fa, bf_hi(a.x) * fa); a.y = pk_bf16(bf_lo(a.y) * fa, bf_hi(a.y) * fa); a.z = pk_bf16(bf_lo(a.z) * fa, bf_hi(a.z) * fa); a.w = pk_bf16(bf_lo(a.w) * fa, bf_hi(a.w) * fa);
                c.x = pk_bf16(bf_lo(c.x) * fc, bf_hi(c.x) * fc); c.y = pk_bf16(bf_lo(c.y) * fc, bf_hi(c.y) * fc); c.z = pk_bf16(bf_lo(c.z) * fc, bf_hi(c.z) * fc); c.w = pk_bf16(bf_lo(c.w) * fc, bf_hi(c.w) * fc);
                *((u32x4*)(Y + (size_t)row * 1024) + lane) = a; *((u32x4*)(Y + (size_t)row * 1024 + 640) + lane) = c; }
        }
    }
}
struct EpiOut {
    bf16_t* XB; float* ssq;
    __device__ __forceinline__ void operator()(const f32x4 (&acc)[2][2][4][2], const GUnit& u, int wr, int wc, int fr, int fq) const {
#pragma unroll
        for (int ai = 0; ai < 2; ++ai)
#pragma unroll
            for (int m = 0; m < 4; ++m) {
                __builtin_amdgcn_sched_barrier(0);
                const int row = u.pm * 256 + ai * 128 + wr * 64 + m * 16 + fr; float ss = 0.f;
#pragma unroll
                for (int bj = 0; bj < 2; ++bj) {
                    u32x4* p = (u32x4*)(XB + (size_t)row * 1024 + u.pn * 256 + bj * 128 + wc * 32 + 8 * fq); const u32x4 x = *p; u32x4 o;
                    o.x = pk_bf16(bf_lo(x.x) + acc[ai][bj][m][0][0], bf_hi(x.x) + acc[ai][bj][m][0][1]); o.y = pk_bf16(bf_lo(x.y) + acc[ai][bj][m][0][2], bf_hi(x.y) + acc[ai][bj][m][0][3]);
                    o.z = pk_bf16(bf_lo(x.z) + acc[ai][bj][m][1][0], bf_hi(x.z) + acc[ai][bj][m][1][1]); o.w = pk_bf16(bf_lo(x.w) + acc[ai][bj][m][1][2], bf_hi(x.w) + acc[ai][bj][m][1][3]);
                    *p = o;
                    ss += (bf_lo(o.x) * bf_lo(o.x) + bf_hi(o.x) * bf_hi(o.x)) + (bf_lo(o.y) * bf_lo(o.y) + bf_hi(o.y) * bf_hi(o.y)) + (bf_lo(o.z) * bf_lo(o.z) + bf_hi(o.z) * bf_hi(o.z)) + (bf_lo(o.w) * bf_lo(o.w) + bf_hi(o.w) * bf_hi(o.w));
                }
                ss = quad_sum(ss); if (fq == 0) ssq[(size_t)row * 16 + u.pn * 4 + wc] = ss;
            }
    }
};

__device__ __forceinline__ float sum16(const float* p) { const f32x4 a = *(const f32x4*)p, b = *(const f32x4*)(p + 4), c = *(const f32x4*)(p + 8), d = *(const f32x4*)(p + 12);
    return (((a.x + a.y) + (a.z + a.w)) + ((b.x + b.y) + (b.z + b.w))) + (((c.x + c.y) + (c.z + c.w)) + ((d.x + d.y) + (d.z + d.w))); }
__device__ __forceinline__ void phase_route(int l, InPtr in, unsigned char* ws, LAS unsigned char* lds, int bid, int nb) {
    int tid_ = threadIdx.x; asm volatile("" : "+v"(tid_)); const int w = tid_ >> 6, lane = tid_ & 63, r = lane & 15, q = lane >> 4;
    const bf16_t* XB = (const bf16_t*)(ws + WS_XB); const bf16_t* WR = (const bf16_t*)(ws + WS_WR) + (size_t)l * 64 * 1024;
    const float* ssq = (const float*)(ws + WS_SSQ + PT_X1) + (size_t)l * 16384 * 16; const float* bg = in->p[24] + l * 4; const float* be = in->p[26] + l * 32;
    unsigned* cnt = (unsigned*)(ws + WS_CTL) + CW_CNT + 2048 * l; unsigned* mtok = (unsigned*)(ws + WS_META); float* mw = (float*)(ws + WS_META + META_W);
    LAS float* lg = (LAS float*)(lds + w * 4096);
    LAS unsigned* lcnt = (LAS unsigned*)(lds + 32768); LAS unsigned* lbase = lcnt + 32;
    for (int g0 = bid * 8; g0 < NTOK / 16; g0 += nb * 8) {
        if (tid_ < 32) lcnt[tid_] = 0u;
        __syncthreads();
        const int tok0 = (g0 + w) * 16; f32x4 acc[3];
#pragma unroll
        for (int n = 0; n < 3; ++n) acc[n] = (f32x4){0.f, 0.f, 0.f, 0.f};
        const bf16_t* ap = XB + (size_t)(tok0 + r) * 1024 + 8 * q; const bf16_t* bp = WR + (size_t)r * 1024 + 8 * q;
#pragma unroll 8
        for (int ks = 0; ks < 32; ++ks) { const bf16x8 a = *(const bf16x8*)(ap + 32 * ks);
#pragma unroll
            for (int n = 0; n < 3; ++n) { const bf16x8 bb = *(const bf16x8*)(bp + (size_t)n * 16 * 1024 + 32 * ks); acc[n] = MFMA16(a, bb, acc[n]); } }
#pragma unroll
        for (int n = 0; n < 3; ++n)
#pragma unroll
            for (int j = 0; j < 4; ++j) lg[(4 * q + j) * 48 + 16 * n + r] = acc[n][j];
        LDS_FENCE();
        int E0 = 0, E1 = 0; unsigned r0 = 0, r1 = 0; float wt0 = 0.f, wt1 = 0.f; const int tok = tok0 + (lane & 15);
        if (lane < 16) {
            const float rs = rsqrtf(sum16(ssq + (size_t)tok * 16) * (1.f / 1024.f) + 1e-6f); ((float*)(ws + WS_RS2))[tok] = rs; const LAS float* L = lg + lane * 48;
            float gl[4]; int gi = 0;
#pragma unroll
            for (int j = 0; j < 4; ++j) gl[j] = L[j] * rs + bg[j];
            float gm = gl[0];
#pragma unroll
            for (int j = 1; j < 4; ++j) if (gl[j] > gm) { gm = gl[j]; gi = j; }
            float gsum = 0.f;
#pragma unroll
            for (int j = 0; j < 4; ++j) gsum += __expf(gl[j] - gm);
            const float gtop = 1.f / gsum;
            float el[8];
#pragma unroll
            for (int j = 0; j < 8; ++j) el[j] = L[4 + gi * 8 + j] * rs + be[gi * 8 + j];
            int e0 = 0; float v0 = el[0];
#pragma unroll
            for (int j = 1; j < 8; ++j) if (el[j] > v0) { v0 = el[j]; e0 = j; }
            int e1 = -1; float v1 = -3.0e38f;
#pragma unroll
            for (int j = 0; j < 8; ++j) if (j != e0 && el[j] > v1) { v1 = el[j]; e1 = j; }
            const float w0 = 1.f / (1.f + __expf(v1 - v0)); E0 = gi * 8 + e0; E1 = gi * 8 + e1; wt0 = w0 * gtop; wt1 = (1.f - w0) * gtop;
            r0 = __hip_atomic_fetch_add(lcnt + E0, 1u, __ATOMIC_RELAXED, __HIP_MEMORY_SCOPE_WORKGROUP); r1 = __hip_atomic_fetch_add(lcnt + E1, 1u, __ATOMIC_RELAXED, __HIP_MEMORY_SCOPE_WORKGROUP);
        }
        __syncthreads();
        if (tid_ < 32) { const unsigned c = lcnt[tid_]; lbase[tid_] = c ? atomicAdd(cnt + tid_ * 64, c) : 0u; }
        __syncthreads();
        if (lane < 16) {
            const unsigned p0 = lbase[E0] + r0, p1 = lbase[E1] + r1;
            mtok[(size_t)E0 * 16384 + p0] = (unsigned)tok; mw[(size_t)E0 * 16384 + p0] = wt0;
            mtok[(size_t)E1 * 16384 + p1] = (unsigned)tok | 0x80000000u; mw[(size_t)E1 * 16384 + p1] = wt1;
        }
        __syncthreads();
    }
}

constexpr int LDS_TB = 131072 + 2048;
__device__ __forceinline__ void moe_tables(int l, unsigned char* ws, LAS unsigned char* lds) {
    LAS int* tb = (LAS int*)(lds + LDS_TB);
    if (threadIdx.x < 32) { const unsigned* cnt = (const unsigned*)(ws + WS_CTL) + CW_CNT + 2048 * l; tb[40 + threadIdx.x] = ((int)__hip_atomic_load(cnt + threadIdx.x * 64, __ATOMIC_RELAXED, __HIP_MEMORY_SCOPE_AGENT) + 255) >> 8; }
    __syncthreads();
    if (threadIdx.x == 0) { int acc = 0; for (int e = 0; e < 32; ++e) { tb[e] = acc; acc += tb[40 + e]; } tb[32] = acc; }
    __syncthreads();
}
template <int NPN, bool GATHER_>
struct MoeSched {
    static constexpr bool GATHER = GATHER_;
    const char* A; const char* Bt; const unsigned* cnt; const unsigned* mtok; const LAS int* tb; int G, c; size_t bstride_e  , bstride_pn;
    __device__ __forceinline__ bool next(int i, GUnit& u) const {
        const int L = i * G + c; const int ntile = tb[32]; if (L >= ntile * NPN) return false;
        const int tile = L / NPN, pn = L % NPN; int e = 0;
        for (int k = 1; k < 32; ++k) e = (tb[k] <= tile) ? k : e;
        e = __builtin_amdgcn_readfirstlane(e);
        u.e = e; u.pm = tile; u.pn = pn; u.rows = (int)__hip_atomic_load(cnt + e * 64, __ATOMIC_RELAXED, __HIP_MEMORY_SCOPE_AGENT) - 256 * (tile - tb[e]);
        u.a = GATHER ? A : A + (size_t)tile * 256 * 256 * 2;
        u.b = Bt + (size_t)e * bstride_e + (size_t)pn * bstride_pn; return true;
    }
    __device__ __forceinline__ void aoff(const GUnit& u, unsigned (&v)[2][2], const int (&R)[2], const int (&C)[2]) const {
#pragma unroll
        for (int h = 0; h < 2; ++h)
#pragma unroll
            for (int i = 0; i < 2; ++i) {
                if (GATHER) { const int lr = h * 128 + R[i]; const int rr = 256 * (u.pm - tb[u.e]) + (lr < u.rows ? lr : 0); const unsigned tok = mtok[(size_t)u.e * 16384 + rr] & 0x7fffffffu; v[h][i] = (tok * 1024u + (unsigned)C[i]) * 2u; }
                else v[h][i] = (unsigned)((h * 128 + R[i]) * 256 + C[i]) * 2u;
            }
    }
};
struct EpiMoeUp {
    const unsigned* mtok; const float* ssq; const LAS int* tb; bf16_t* HB;
    __device__ __forceinline__ void operator()(const f32x4 (&acc)[2][2][4][2], const GUnit& u, int wr, int wc, int fr, int fq) const {
        const int r0 = 256 * (u.pm - tb[u.e]);
#pragma unroll
        for (int ai = 0; ai < 2; ++ai)
#pragma unroll
            for (int m = 0; m < 4; ++m) {
                __builtin_amdgcn_sched_barrier(0);
                const int lr = ai * 128 + wr * 64 + m * 16 + fr;
                if (lr < u.rows) {
                    const unsigned tok = mtok[(size_t)u.e * 16384 + r0 + lr] & 0x7fffffffu; const float rs = ssq[tok];
                    float hv[8];
#pragma unroll
                    for (int n = 0; n < 2; ++n)
#pragma unroll
                        for (int j = 0; j < 4; ++j) { const float gv = acc[ai][0][m][n][j] * rs, uv = acc[ai][1][m][n][j] * rs; hv[4 * n + j] = siluf(gv) * uv; }
                    st_bf16x8(HB + ((size_t)u.pm * 256 + lr) * 256 + u.pn * 128 + wc * 32 + 8 * fq, hv);
                }
            }
    }
};
struct EpiMoeDown {
    const unsigned* mtok; const float* mw; const LAS int* tb; bf16_t* YB;
    __device__ __forceinline__ void operator()(const f32x4 (&acc)[2][2][4][2], const GUnit& u, int wr, int wc, int fr, int fq) const {
        const int r0 = 256 * (u.pm - tb[u.e]);
#pragma unroll
        for (int ai = 0; ai < 2; ++ai)
#pragma unroll
            for (int m = 0; m < 4; ++m) {
                __builtin_amdgcn_sched_barrier(0);
                const int lr = ai * 128 + wr * 64 + m * 16 + fr;
                if (lr < u.rows) {
                    const unsigned mt = mtok[(size_t)u.e * 16384 + r0 + lr]; const float wt = mw[(size_t)u.e * 16384 + r0 + lr];
                    bf16_t* dst = YB + ((size_t)(mt >> 31) * 16384 + (mt & 0x7fffffffu)) * 1024 + u.pn * 256 + wc * 32 + 8 * fq;
#pragma unroll
                    for (int bj = 0; bj < 2; ++bj) { float v[8];
#pragma unroll
                        for (int n = 0; n < 2; ++n)
#pragma unroll
                            for (int j = 0; j < 4; ++j) v[4 * n + j] = acc[ai][bj][m][n][j] * wt;
                        st_bf16x8(dst + bj * 128, v); }
                }
            }
    }
};
__device__ __forceinline__ void phase_combine(int l, unsigned char* ws, float* out, int bid, int nb) {
    int tid_ = threadIdx.x; asm volatile("" : "+v"(tid_)); const int w = tid_ >> 6, lane = tid_ & 63;
    bf16_t* XB = (bf16_t*)(ws + WS_XB); const bf16_t* Y0 = (const bf16_t*)(ws + WS_YBUF); const bf16_t* Y1 = Y0 + (size_t)16384 * 1024; float* ssqx = (float*)(ws + WS_SSQX) + 16384;
    for (int row = bid * 8 + w; row < NTOK; row += nb * 8) {
        float ss = 0.f;
#pragma unroll
        for (int k = 0; k < 2; ++k) {
            const size_t o = (size_t)row * 1024 + (lane + 64 * k) * 8;
            const u32x4 x = *(const u32x4*)(XB + o), a = *(const u32x4*)(Y0 + o), c = *(const u32x4*)(Y1 + o);
            float v[8] = { bf_lo(x.x) + bf_lo(a.x) + bf_lo(c.x), bf_hi(x.x) + bf_hi(a.x) + bf_hi(c.x), bf_lo(x.y) + bf_lo(a.y) + bf_lo(c.y), bf_hi(x.y) + bf_hi(a.y) + bf_hi(c.y),
                           bf_lo(x.z) + bf_lo(a.z) + bf_lo(c.z), bf_hi(x.z) + bf_hi(a.z) + bf_hi(c.z), bf_lo(x.w) + bf_lo(a.w) + bf_lo(c.w), bf_hi(x.w) + bf_hi(a.w) + bf_hi(c.w) };
            if (l == L_ - 1 && out) { *(f32x4*)(out + o) = (f32x4){v[0], v[1], v[2], v[3]}; *(f32x4*)(out + o + 4) = (f32x4){v[4], v[5], v[6], v[7]}; }
            else { u32x4 p; p.x = pk_bf16(v[0], v[1]); p.y = pk_bf16(v[2], v[3]); p.z = pk_bf16(v[4], v[5]); p.w = pk_bf16(v[6], v[7]); *(u32x4*)(XB + o) = p;
#pragma unroll
                   for (int j = 0; j < 4; ++j) { const unsigned q = j == 0 ? p.x : (j == 1 ? p.y : (j == 2 ? p.z : p.w)); ss += bf_lo(q) * bf_lo(q) + bf_hi(q) * bf_hi(q); } }
        }
        if (l < L_ - 1) { ss = wave_sum(ss); if (lane == 0) ssqx[row] = ss; }
    }
}
constexpr int NPH = 9;
enum { PH_INPROJ = 0, PH_PREP, PH_MIX, PH_YNORM, PH_OUTPROJ, PH_ROUTE, PH_MOEUP, PH_MOEDOWN, PH_COMBINE };
struct Args { Inputs in; float* out; unsigned char* ws; int ph_lo, ph_hi; };

__global__ void __launch_bounds__(512, 2) mk(Args args) {
    extern __shared__ __attribute__((aligned(16))) unsigned char lds_raw[];
    LAS unsigned char* lds = (LAS unsigned char*)lds_raw;
    const int tid = threadIdx.x, bid0 = blockIdx.x, nb = gridDim.x;
#define BID() ({ int b_ = bid0; asm volatile("" : "+s"(b_)); b_; })
    unsigned char* ws = args.ws; unsigned* ctl = (unsigned*)(ws + WS_CTL);
    const int lo = args.ph_lo, hi = args.ph_hi;
    if (tid < 4) ((LAS unsigned*)(lds + LDS_MISC))[tid] = 0u;
    __syncthreads();
    XcdBarrier bar; bar.bar = ctl + CW_BAR; bar.x = 0; bar.st = nullptr;
    if (hi - lo > 1) bar = xcd_barrier_post(ctl + CW_BAR, (volatile LAS unsigned*)(lds + LDS_MISC));
#define IN(k) (lo <= (k) && (k) < hi)
#ifndef REPEAT_PH
#define REPEAT_PH -1
#endif
#define NREP(k) ((REPEAT_PH == (k)) ? 2 : 1)
#ifndef NBAR
#define NBAR 1
#endif
#ifndef TIME_PH
#define TIME_PH -1
#endif
#define STAMP(i) do { if (TIME_PH != -1 && blockIdx.x == 0 && threadIdx.x == 0) ((unsigned long long*)(ctl + CW_TS))[i] = __builtin_amdgcn_s_memrealtime(); } while (0)
#define SEAM(k) do { if (IN(k) && IN((k) + 1)) for (int nb_ = 0; nb_ < NBAR; ++nb_) xcd_barrier(bar); STAMP((k) + 1); } while (0)
    STAMP(0);
#ifndef NO_PRO
    if (IN(0)) for (int rep = 0; rep < NREP(100); ++rep) { prologue(in_tab(), launder(ws), lds, BID(), nb); if (rep + 1 < NREP(100)) xcd_barrier(bar); }
#endif
    SEAM(0);
    for (int l = 0; l < L_; ++l) {
        const int pb = 1 + l * NPH;
        if (IN(pb + PH_INPROJ)) for (int rep = 0; rep < NREP(PH_INPROJ); ++rep) {
            if (rep) xcd_barrier(bar);
            InPtr in = in_tab(); unsigned char* ws = launder(args.ws);
            g8::DenseSched S{(const char*)(ws + WS_XB), (const char*)(ws + WS_WIN) + (size_t)l * 2560 * 1024 * 2, 1024, 1024, 64, 10, nb, BID()};
            EpiInProj E{(const float*)(ws + WS_SSQX) + l * 16384, (float*)(ws + WS_SSQ + PT_DQ) + (size_t)l * 16384 * 4, (float*)(ws + WS_SSQ + PT_DKV) + (size_t)l * 16384 * 2,
                        in->p[8] + l * 64, in->p[9] + l * 64, in->p[19] + l * 192 + 96 + 64, (const float*)(ws + WS_ROPE), ws + WS_PRJ};
#ifndef NO_INPROJ
            g8::gemm_run(lds, 1024, 1024, S, E);
#endif
        }
        SEAM(pb + PH_INPROJ);
        if (IN(pb + PH_PREP)) for (int rep = 0; rep < NREP(PH_PREP); ++rep) { if (rep) xcd_barrier(bar); phase_prep(l, in_tab(), launder(ws), lds, BID(), nb); }
        SEAM(pb + PH_PREP);
        if (IN(pb + PH_MIX)) for (int rep = 0; rep < NREP(PH_MIX); ++rep) { if (rep) xcd_barrier(bar); phase_mix(l, in_tab(), launder(ws), lds, (unsigned*)launder(ws) + CW_Q + 64 * (l + 2 * rep)); }
        SEAM(pb + PH_MIX);
        if (IN(pb + PH_YNORM)) phase_ynorm(l, launder(ws), BID(), nb);
        SEAM(pb + PH_YNORM);
        if (IN(pb + PH_OUTPROJ)) {
            unsigned char* ws = launder(args.ws);
            g8::DenseSched S{(const char*)(ws + WS_Y), (const char*)(ws + WS_WOUT) + (size_t)l * 1024 * 1024 * 2, 1024, 1024, 64, 4, nb, BID()};
            EpiOut E{(bf16_t*)(ws + WS_XB), (float*)(ws + WS_SSQ + PT_X1) + (size_t)l * 16384 * 16};
#ifndef NO_OUTPROJ
            g8::gemm_run(lds, 1024, 1024, S, E);
#endif
        }
        SEAM(pb + PH_OUTPROJ);
#ifndef NO_ROUTE
        if (IN(pb + PH_ROUTE)) phase_route(l, in_tab(), launder(ws), lds, BID(), nb);
#endif
        SEAM(pb + PH_ROUTE);
        if (IN(pb + PH_MOEUP)) for (int rep = 0; rep < NREP(PH_MOEUP); ++rep) {
            if (rep) xcd_barrier(bar);
            unsigned char* ws = launder(args.ws); moe_tables(l, ws, lds);
            const unsigned* cnt = (const unsigned*)(ws + WS_CTL) + CW_CNT + 2048 * l; const unsigned* mtok = (const unsigned*)(ws + WS_META); const LAS int* tb = (const LAS int*)(lds + LDS_TB);
            MoeSched<2, true> S{(const char*)(ws + WS_XB), (const char*)(ws + WS_WMOE), cnt, mtok, tb, nb, BID(), (size_t)512 * 1024 * 2, (size_t)256 * 1024 * 2};
            EpiMoeUp E{mtok, (const float*)(ws + WS_RS2), tb, (bf16_t*)(ws + WS_HBUF)};
#ifndef NO_MOEUP
            g8::gemm_run(lds, 1024, 1024, S, E);
#endif
        }
        SEAM(pb + PH_MOEUP);
        if (IN(pb + PH_MOEDOWN)) for (int rep = 0; rep < NREP(PH_MOEDOWN); ++rep) {
            if (rep) xcd_barrier(bar);
            unsigned char* ws = launder(args.ws); moe_tables(l, ws, lds);
            const unsigned* cnt = (const unsigned*)(ws + WS_CTL) + CW_CNT + 2048 * l; const unsigned* mtok = (const unsigned*)(ws + WS_META); const LAS int* tb = (const LAS int*)(lds + LDS_TB);
            MoeSched<4, false> S{(const char*)(ws + WS_HBUF), (const char*)(ws + WS_WMOE + WMOE_WD), cnt, mtok, tb, nb, BID(), (size_t)1024 * 256 * 2, (size_t)256 * 256 * 2};
            EpiMoeDown E{mtok, (const float*)(ws + WS_META + META_W), tb, (bf16_t*)(ws + WS_YBUF)};
#ifndef NO_MOEDOWN
            g8::gemm_run(lds, 256, 256, S, E);
#endif
        }
        SEAM(pb + PH_MOEDOWN);
#ifndef NO_COMBINE
        if (IN(pb + PH_COMBINE)) { unsigned char* ws = launder(args.ws); phase_combine(l, ws, args.out, BID(), nb); if (l + 1 < L_) cvt_moe_layer(in_tab(), ws, l + 1, (LAS float*)lds, BID(), nb, threadIdx.x); }
#endif
        SEAM(pb + PH_COMBINE);
    }
#undef IN
#undef SEAM
}
#if CHECK
struct NvScratch { float *proj, *h1, *qk, *hraw, *kn, *kcmp, *vcmp, *dqn, *q, *dkvn, *kv, *krope, *y, *x1, *xl; int* rt_e; float* rt_w; };
constexpr int CB = 5;
enum { NS_INPROJ = 0, NS_NSAPREP, NS_MLAPREP, NS_NSA, NS_ML, NS_MLA, NS_OUT, NS_ROUTE, NS_MOE };
static void naive_step(void* const* d_in, int l, int step, const float* xin, float* xout, const NvScratch& S, hipStream_t st) {
    const int b = CB;
    const float* rel_bias = (const float*)d_in[2];
    const float* norm1_g = (const float*)d_in[3] + (long)l * 1024;
    const float* w_in = (const float*)d_in[4] + (long)l * 1024 * DIN;
    const float* cmp_pe = (const float*)d_in[5] + (long)l * 2 * 32 * 64;
    const float* cmp_w1 = (const float*)d_in[6] + (long)l * 2 * 32 * 64 * 64;
    const float* cmp_w2 = (const float*)d_in[7] + (long)l * 2 * 64 * 64;
    const float* q_norm = (const float*)d_in[8] + l * 64;
    const float* k_norm = (const float*)d_in[9] + l * 64;
    const float* nsa_on = (const float*)d_in[10] + l * 384;
    const float* conv = (const float*)d_in[11] + l * 4 * 512;
    const float* ibias = (const float*)d_in[12] + l * 4;
    const float* fbias = (const float*)d_in[13] + l * 4;
    const float* ml_on = (const float*)d_in[14] + l * 256;
    const float* qan = (const float*)d_in[15] + l * 192;
    const float* w_uq = (const float*)d_in[16] + (long)l * 192 * 576;
    const float* kvan = (const float*)d_in[17] + l * 128;
    const float* w_ukv = (const float*)d_in[18] + (long)l * 128 * 768;
    const float* qkn = (const float*)d_in[19] + l * 192;
    const float* mla_on = (const float*)d_in[20] + l * 384;
    const float* w_out = (const float*)d_in[21] + (long)l * 1024 * 1024;
    const float* norm2_g = (const float*)d_in[22] + l * 1024;
    const float* wgrp = (const float*)d_in[23] + (long)l * 1024 * 4;
    const float* bgrp = (const float*)d_in[24] + l * 4;
    const float* wexp = (const float*)d_in[25] + (long)l * 1024 * 32;
    const float* bexp = (const float*)d_in[26] + l * 32;
    const float* Wg = (const float*)d_in[27] + (long)l * 32 * 1024 * 256;
    const float* Wu = (const float*)d_in[28] + (long)l * 32 * 1024 * 256;
    const float* Wd = (const float*)d_in[29] + (long)l * 32 * 256 * 1024;
    const int* pos = (const int*)d_in[1] + b * 2048;
    switch (step) {
    case NS_INPROJ:
        nv_rmsnorm<<<dim3(2048, 1), 64, 0, st>>>(xin, 1024, 0, S.h1, 1024, 0, norm1_g, 0, 1024);
        nv_gemm<<<dim3((DIN + 63) / 64, 2048 / 64), 256, 0, st>>>(S.h1, 1024, w_in, DIN, S.proj, DIN, nullptr, 0, 2048, DIN, 1024);
        break;
    case NS_NSAPREP:
        nv_nsa_cmp<<<dim3(127, 2, 2), 64, 0, st>>>(S.proj, cmp_pe, cmp_w1, cmp_w2, k_norm, S.kcmp, S.vcmp);
        nv_nsa_knorm<<<dim3(2048, 4), 64, 0, st>>>(S.proj, k_norm, S.kn);
        break;
    case NS_MLAPREP:
        nv_rmsnorm<<<dim3(2048, 1), 64, 0, st>>>(S.proj + O_CDQ, DIN, 0, S.dqn, 192, 0, qan, 0, 192);
        nv_gemm<<<dim3(576 / 64, 2048 / 64), 256, 0, st>>>(S.dqn, 192, w_uq, 576, S.q, 576, nullptr, 0, 2048, 576, 192);
        nv_rmsnorm<<<dim3(2048, 1), 64, 0, st>>>(S.proj + O_CDKV, DIN, 0, S.dkvn, 128, 0, kvan, 0, 128);
        nv_gemm<<<dim3(768 / 64, 2048 / 64), 256, 0, st>>>(S.dkvn, 128, w_ukv, 768, S.kv, 768, nullptr, 0, 2048, 768, 128);
        nv_mla_prep<<<dim3(2048, 7), 64, 0, st>>>(S.q, S.kv, S.proj, S.krope, qkn, pos);
        break;
    case NS_NSA:
        nv_nsa_attn<<<dim3(2048, 2), 192, 0, st>>>(S.proj, S.kn, S.kcmp, S.vcmp, rel_bias, q_norm, S.y);
        break;
    case NS_ML:
        nv_ml_conv<<<2048, 512, 0, st>>>(S.proj, conv, S.qk);
        nv_ml_rec<<<4, 256, 0, st>>>(S.proj, S.qk, ibias, fbias, S.hraw);
        nv_ml_fin<<<dim3(2048, 4), 64, 0, st>>>(S.proj, S.hraw, ml_on, S.y);
        break;
    case NS_MLA:
        nv_mla_attn<<<dim3(2048, 6), 64, 0, st>>>(S.q, S.kv, S.krope, S.y);
        break;
    case NS_OUT:
        nv_rmsnorm<<<dim3(2048, 1), 64, 0, st>>>(S.y, 1024, 0, S.y, 1024, 0, nsa_on, 0, 384);
        nv_rmsnorm<<<dim3(2048, 1), 64, 0, st>>>(S.y + 640, 1024, 0, S.y + 640, 1024, 0, mla_on, 0, 384);
        nv_gemm<<<dim3(1024 / 64, 2048 / 64), 256, 0, st>>>(S.y, 1024, w_out, 1024, S.x1, 1024, xin, 1024, 2048, 1024, 1024);
        break;
    case NS_ROUTE:
        nv_moe_route<<<2048, 64, 0, st>>>(S.x1, norm2_g, wgrp, bgrp, wexp, bexp, S.h1, S.rt_e, S.rt_w);
        break;
    case NS_MOE:
        nv_moe_exp<<<2048, 256, 0, st>>>(S.x1, S.h1, S.rt_e, S.rt_w, Wg, Wu, Wd, xout);
        break;
    }
}

__device__ __forceinline__ void chk_commit(float d2, float r2, float* acc) { d2 = wave_sum(d2); r2 = wave_sum(r2); if ((threadIdx.x & 63) == 0) { atomicAdd(acc, d2); atomicAdd(acc + 1, r2); } }
__device__ __forceinline__ void chk_add(float f, float r, float& d2, float& r2) { const float d = f - r; d2 += (d == d) ? d * d : 1e30f; r2 += r * r; }

__global__ void __launch_bounds__(64) chk_proj(const float* nproj, const unsigned char* prj, const float* ssq_dq, const float* ssq_dkv, const float* qg, const float* kg, const float* krg, const int* pos, float* acc) {
    const int t = blockIdx.x, e = threadIdx.x; const size_t row = (size_t)CB * 2048 + t; float d2 = 0.f, r2 = 0.f;
    for (int G = 0; G < 40; ++G) {
        const int c = inproj_refcol(G, e); float r = c < 0 ? 0.f : nproj[(size_t)t * DIN + c]; float f = 0.f;
        const float rr = (G == 37 && e >= 32) ? 0.f : r; const float ss = wave_sum(rr * rr);
        if (G < 6) { r = r * rsqrtf(ss / 64.f + 1e-6f) * qg[e] * 0.125f; f = bf2f(((const bf16_t*)(prj + PRJ_QN))[((size_t)(CB * 6 + G) * 2048 + t) * 64 + e]); }
        else if (G < 18) { const int a = G - 6, br = a >> 2, s = (a >> 1) & 1, hk = a & 1;
            if (br > 0 && s == 0) r = r * rsqrtf(ss / 64.f + 1e-6f) * kg[e];
            const size_t base = br == 0 ? (s ? PRJ_C0V : PRJ_C0K) : (br == 1 ? (s ? PRJ_VN1 : PRJ_KN1) : (s ? PRJ_VN2 : PRJ_KN2));
            f = bf2f(((const bf16_t*)(prj + base))[((size_t)(CB * 2 + hk) * 2048 + t) * 64 + e]); }
        else if (G < 26) f = bf2f(((const bf16_t*)(prj + PRJ_RAWQK))[row * 512 + (G - 18) * 64 + e]);
        else if (G < 30) f = bf2f(((const bf16_t*)(prj + PRJ_VML))[((size_t)(CB * 4 + (G - 26)) * 2048 + t) * 64 + e]);
        else if (G < 34) f = bf2f(((const bf16_t*)(prj + PRJ_OG))[row * 256 + (G - 30) * 64 + e]);
        else if (G < 37) f = bf2f(((const bf16_t*)(prj + PRJ_DQKV))[row * 384 + (G - 34) * 64 + e]);
        else if (G == 37) {
            const float val = e < 32 ? rr * rsqrtf(ss / 32.f + 1e-6f) * krg[e & 31] : 0.f; const float oth = __shfl_xor(val, 16);
            if (e < 32) { const int i = e & 15; const double ang = (double)pos[row] * pow(10000.0, -(double)i / 16.0); const float cs = (float)cos(ang), sn = (float)sin(ang);
                r = e < 16 ? val * cs - oth * sn : val * cs + oth * sn; f = bf2f(((const bf16_t*)(prj + PRJ_KR))[row * 32 + e]); }
            else if (e < 58) f = ((const float*)(prj + PRJ_GATES))[row * 32 + (e - 32)];
            else { f = 0.f; r = 0.f; }
        }
        else f = bf2f(((const bf16_t*)(prj + PRJ_DQKV))[row * 384 + 256 + (G - 38) * 64 + e]);
        chk_add(f, r, d2, r2);
    }
    float d2s = 0.f, r2s = 0.f;
    { float s1 = 0.f, s2 = 0.f; for (int c = e; c < 192; c += 64) { float v = nproj[(size_t)t * DIN + O_CDQ + c]; s1 += v * v; } for (int c = e; c < 128; c += 64) { float v = nproj[(size_t)t * DIN + O_CDKV + c]; s2 += v * v; }
      s1 = wave_sum(s1); s2 = wave_sum(s2); if (e == 0) { chk_add((ssq_dq[row * 4] + ssq_dq[row * 4 + 1]) + ssq_dq[row * 4 + 2], s1, d2s, r2s); chk_add(ssq_dkv[row * 2] + ssq_dkv[row * 2 + 1], s2, d2s, r2s); } }
    chk_commit(d2, r2, acc); chk_commit(d2s, r2s, acc + 2);
}

__global__ void __launch_bounds__(64) chk_prep(const float* nq, const float* nkv, const float* nkr, const float* nkc, const float* nvc, const unsigned char* ws, float* acc) {
    const int t = blockIdx.x, e = threadIdx.x; float d2 = 0.f, r2 = 0.f, d2c = 0.f, r2c = 0.f; const float scale = 0.10206207261596575f;
    const bf16_t* QM = (const bf16_t*)(ws + WS_MLA); const bf16_t* KM = (const bf16_t*)(ws + WS_MLA + MLA_KM); const bf16_t* VM = (const bf16_t*)(ws + WS_MLA + MLA_VM);
    for (int h = 0; h < 6; ++h) {
        const size_t rq = ((size_t)(CB * 6 + h) * 2048 + t);
        chk_add(bf2f(QM[rq * 96 + e]), nq[(size_t)t * 576 + h * 96 + e] * scale, d2, r2);
        chk_add(bf2f(KM[rq * 96 + e]), nkv[(size_t)t * 768 + h * 128 + e], d2, r2);
        chk_add(bf2f(VM[rq * 64 + e]), nkv[(size_t)t * 768 + h * 128 + 64 + e], d2, r2);
        if (e < 32) { chk_add(bf2f(QM[rq * 96 + 64 + e]), nq[(size_t)t * 576 + h * 96 + 64 + e] * scale, d2, r2); chk_add(bf2f(KM[rq * 96 + 64 + e]), nkr[(size_t)t * 32 + e], d2, r2); }
    }
    if (t < 128) for (int hk = 0; hk < 2; ++hk) {
        const bf16_t* KC = (const bf16_t*)(ws + WS_CMP); const bf16_t* VC = (const bf16_t*)(ws + WS_CMP + CMP_V); const size_t rf = ((size_t)(CB * 2 + hk) * 128 + t) * 64 + e;
        chk_add(bf2f(KC[rf]), t < 127 ? nkc[(size_t)(hk * 127 + t) * 64 + e] : 0.f, d2c, r2c); chk_add(bf2f(VC[rf]), t < 127 ? nvc[(size_t)(hk * 127 + t) * 64 + e] : 0.f, d2c, r2c);
    }
    chk_commit(d2, r2, acc); chk_commit(d2c, r2c, acc + 2);
}

__global__ void __launch_bounds__(64) chk_y(const float* ny, const unsigned char* ws, float* acc, int nseg) {
    const int t = blockIdx.x, e = threadIdx.x; const bf16_t* Y = (const bf16_t*)(ws + WS_Y) + ((size_t)CB * 2048 + t) * 1024;
    float d2[3] = {0.f, 0.f, 0.f}, r2[3] = {0.f, 0.f, 0.f};
    for (int c = e; c < 1024; c += 64) { const int seg = c < 384 ? 0 : (c < 640 ? 1 : 2); const float f = bf2f(Y[c]), r = ny[(size_t)t * 1024 + c];
        if (seg == 0) chk_add(f, r, d2[0], r2[0]); else if (seg == 1) chk_add(f, r, d2[1], r2[1]); else chk_add(f, r, d2[2], r2[2]); }
    if (nseg == 3) { chk_commit(d2[0], r2[0], acc); chk_commit(d2[1], r2[1], acc + 2); chk_commit(d2[2], r2[2], acc + 4); }
    else chk_commit(d2[0] + d2[1] + d2[2], r2[0] + r2[1] + r2[2], acc);
}

__global__ void __launch_bounds__(64) chk_x(const float* nx, const unsigned char* ws, float* acc) {
    const int t = blockIdx.x, e = threadIdx.x; const bf16_t* X = (const bf16_t*)(ws + WS_XB) + ((size_t)CB * 2048 + t) * 1024; float d2 = 0.f, r2 = 0.f;
    for (int c = e; c < 1024; c += 64) chk_add(bf2f(X[c]), nx[(size_t)t * 1024 + c], d2, r2);
    chk_commit(d2, r2, acc);
}

__global__ void __launch_bounds__(512) chk_code(float* acc, int nst, const float* nout) {
    __shared__ float sh[512];
    float s = 0.f; for (int i = threadIdx.x; i < 2048 * 1024; i += 512) { float v = nout[i]; s += v * v; }
    sh[threadIdx.x] = s; __syncthreads();
    if (threadIdx.x == 0) { float tot = 0.f; for (int i = 0; i < 512; ++i) tot += sh[i]; float rms = sqrtf(tot / (2048.f * 1024.f)); if (!(rms > 1e-3f && rms < 1e3f)) rms = 1.f;
        int code = 0;
        for (int st = 0; st < nst; ++st) { const float d2 = acc[2 * st], r2 = acc[2 * st + 1]; if (r2 == 0.f && d2 == 0.f) { if ((st & 15) >= 9) continue; code = (st + 1) * 4 + 3; break; } const float err = d2 / fmaxf(r2, 1e-30f);
            const float tol = CHK_TOL(st);
            if (!(err <= tol)) { const int cls = !(err < 1.f) ? 3 : (err >= 0.1f ? 2 : (err >= 0.01f ? 1 : 0)); code = (st + 1) * 4 + cls; break; } }
        acc[2 * 40] = rms * 32.f * exp2f(0.5f * (float)code); }
}
__global__ void __launch_bounds__(512) chk_fill(const float* acc, float* out) {
    const float K = acc[2 * 40];
    for (size_t i = (size_t)blockIdx.x * 512 + threadIdx.x; i < (size_t)NTOK * 1024; i += (size_t)gridDim.x * 512) out[i] = (i & 1) ? -K : K;
}
#endif

#if TIME_PH != -1
#ifndef TIME_Q
#define TIME_Q 6.f
#endif
#ifndef TIME_CAL
#define TIME_CAL 1.0f
#endif
__global__ void __launch_bounds__(512) tm_fill(const unsigned long long* ts, float* out) {
    float T = 100.f; if (TIME_PH >= 0) { int a = TIME_PH, b = TIME_PH + 1;
#ifdef TIME_PH_END
        b = TIME_PH_END;
#endif
        T = (float)(ts[b] - ts[a]) * 0.01f; }
    T = exp2f(rintf(log2f(fmaxf(T, 1.f)) * TIME_Q) / TIME_Q);
    const float c = sqrtf(T) * TIME_CAL;
    for (size_t i = (size_t)blockIdx.x * 512 + threadIdx.x; i < (size_t)NTOK * 1024; i += (size_t)gridDim.x * 512) out[i] = (i & 1) ? -c : c;
}
#endif
static int g_grid = 0;
static bool setup_once(size_t ws_size) {
    if (g_grid) return g_grid > 0;
    if (ws_size < WS_END) { fprintf(stderr, "kernel_launch: workspace too small: %zu < %zu\n", ws_size, (size_t)WS_END); g_grid = -1; return false; }
    int dev = 0, cus = 0, per_cu = 0;
    if (hipGetDevice(&dev) != hipSuccess || hipDeviceGetAttribute(&cus, hipDeviceAttributeMultiprocessorCount, dev) != hipSuccess) { g_grid = -1; return false; }
    if (hipFuncSetAttribute((const void*)mk, hipFuncAttributeMaxDynamicSharedMemorySize, LDS_BYTES) != hipSuccess) { fprintf(stderr, "kernel_launch: hipFuncSetAttribute failed\n"); g_grid = -1; return false; }
    if (hipOccupancyMaxActiveBlocksPerMultiprocessor(&per_cu, (const void*)mk, 512, LDS_BYTES) != hipSuccess || per_cu < 1) { fprintf(stderr, "kernel_launch: occupancy query says %d\n", per_cu); }
    (void)hipGetLastError();
    g_grid = cus;
    return true;
}
static void launch_mk(const Args& a0, int lo, int hi, hipStream_t stream) { Args a = a0; a.ph_lo = lo; a.ph_hi = hi; hipLaunchKernelGGL(mk, dim3(g_grid), dim3(512), LDS_BYTES, stream, a); }

extern "C" void kernel_launch(void* const* d_in, const int* in_sizes, int n_in, void* d_out, int out_size, void* d_ws, size_t ws_size, hipStream_t stream) {
    if (!setup_once(ws_size)) return;
    unsigned char* ws = (unsigned char*)d_ws;
    (void)hipMemsetAsync(ws + WS_CTL, 0, ZERO_BYTES, stream);
    Args a{}; for (int i = 0; i < 30; ++i) a.in.p[i] = (const float*)d_in[i];
    a.out = (float*)d_out; a.ws = ws; a.ph_lo = 0; a.ph_hi = 0;
#if CHECK
    a.out = nullptr;
#endif
#if CHECK
    float* nb = (float*)d_out; size_t off = 0; NvScratch S;
    auto take = [&](size_t n) { float* p = nb + off; off += (n + 63) & ~(size_t)63; return p; };
    S.proj = take((size_t)2048 * DIN); S.h1 = take(2048 * 1024); S.qk = S.h1; S.hraw = S.qk + 2048 * 512; S.kn = S.hraw + 2048 * 256;
    S.kcmp = take(2 * 127 * 64); S.vcmp = take(2 * 127 * 64); S.dqn = take(2048 * 192); S.q = take(2048 * 576); S.dkvn = take(2048 * 128); S.kv = take(2048 * 768); S.x1 = S.dqn;
    S.krope = take(2048 * 32); S.y = take(2048 * 1024); S.xl = take(2048 * 1024); S.rt_e = (int*)take(2048 * 2); S.rt_w = take(2048 * 2);
    if (off * 4 > (size_t)NTOK * 1024 * 4) { fprintf(stderr, "naive scratch too big\n"); return; }
    float* acc = (float*)(ws + WS_CTL) + CW_CHK;
    launch_mk(a, 0, 1, stream);
    const float* nx_in = (const float*)d_in[0] + (size_t)CB * 2048 * 1024;
    int nst = 0;
    for (int l = 0; l < L_; ++l) {
        const int pb = 1 + l * NPH; const int sb = l * 16;
        launch_mk(a, pb + PH_INPROJ, pb + PH_INPROJ + 1, stream);
        naive_step(d_in, l, NS_INPROJ, nx_in, S.xl, S, stream);
        chk_proj<<<2048, 64, 0, stream>>>(S.proj, ws + WS_PRJ, (const float*)(ws + WS_SSQ + PT_DQ) + (size_t)l * 16384 * 4, (const float*)(ws + WS_SSQ + PT_DKV) + (size_t)l * 16384 * 2,
                                           (const float*)d_in[8] + l * 64, (const float*)d_in[9] + l * 64, (const float*)d_in[19] + l * 192 + 160, (const int*)d_in[1], acc + 2 * (sb + 0));
        nst = sb + 2;
        int ns_done = NS_INPROJ;
#if CHECK_UPTO >= 1
        launch_mk(a, pb + PH_PREP, pb + PH_PREP + 1, stream);
        naive_step(d_in, l, NS_NSAPREP, nx_in, S.xl, S, stream); naive_step(d_in, l, NS_MLAPREP, nx_in, S.xl, S, stream); ns_done = NS_MLAPREP;
        chk_prep<<<2048, 64, 0, stream>>>(S.q, S.kv, S.krope, S.kcmp, S.vcmp, ws, acc + 2 * (sb + 2));
        nst = sb + 4;
#endif
#if CHECK_UPTO >= 2
        launch_mk(a, pb + PH_MIX, pb + PH_MIX + 1, stream);
        naive_step(d_in, l, NS_NSA, nx_in, S.xl, S, stream); naive_step(d_in, l, NS_ML, nx_in, S.xl, S, stream); naive_step(d_in, l, NS_MLA, nx_in, S.xl, S, stream); ns_done = NS_MLA;
        chk_y<<<2048, 64, 0, stream>>>(S.y, ws, acc + 2 * (sb + 4), 3);
        nst = sb + 7;
#endif
#if CHECK_UPTO >= 3
        launch_mk(a, pb + PH_YNORM, pb + PH_YNORM + 1, stream); launch_mk(a, pb + PH_OUTPROJ, pb + PH_OUTPROJ + 1, stream);
        naive_step(d_in, l, NS_OUT, nx_in, S.xl, S, stream); ns_done = NS_OUT;
        chk_x<<<2048, 64, 0, stream>>>(S.x1, ws, acc + 2 * (sb + 7));
        nst = sb + 8;
#endif
#if CHECK_UPTO >= 4
        for (int ph = PH_ROUTE; ph <= PH_COMBINE; ++ph) launch_mk(a, pb + ph, pb + ph + 1, stream);
        naive_step(d_in, l, NS_ROUTE, nx_in, S.xl, S, stream); naive_step(d_in, l, NS_MOE, nx_in, S.xl, S, stream); ns_done = NS_MOE;
        chk_x<<<2048, 64, 0, stream>>>(S.xl, ws, acc + 2 * (sb + 8));
        nst = sb + 9;
#endif
        CHECK_REST
        for (int s = ns_done + 1; s <= NS_MOE; ++s) naive_step(d_in, l, s, nx_in, S.xl, S, stream);
        nx_in = S.xl;
        if (l == CHECK_LAYERS - 1) break;
    }
    chk_code<<<1, 512, 0, stream>>>(acc, nst, S.xl);
    chk_fill<<<1024, 512, 0, stream>>>(acc, (float*)d_out);
#else
#if defined(SPLIT_LAUNCH) && SPLIT_LAUNCH
    for (int ph = 0; ph < 1 + L_ * NPH; ++ph) launch_mk(a, ph, ph + 1, stream);
#else
    launch_mk(a, 0, 1 + L_ * NPH, stream);
#if TIME_PH != -1
    (void)hipMemsetAsync(ws + WS_CTL, 0, ZERO_BYTES, stream); launch_mk(a, 0, 1 + L_ * NPH, stream);
    tm_fill<<<1024, 512, 0, stream>>>((const unsigned long long*)((unsigned*)(ws + WS_CTL) + CW_TS), (float*)d_out);
#endif
#endif
#endif
}
```

```cpp
#define CHECK 0
#define CHECK_LAYERS 2
#define CHECK_UPTO 99
#define SPLIT_LAUNCH 0
#define REPEAT_PH -1
#include <hip/hip_runtime.h>
#include <stdint.h>
#include <cstdio>

constexpr int B_ = 8, T_ = 2048, D_ = 1024, L_ = 2, NTOK = B_ * T_;
constexpr int DIN = 2554;
constexpr int O_AQ = 0, O_AKV = 384, O_AG = 1152, O_BQK = 1170, O_BV = 1682, O_BIF = 1938, O_BO = 1946, O_CDQ = 2202, O_CDKV = 2394, O_CKR = 2522;

typedef unsigned short bf16_t;
typedef short bf16x8 __attribute__((ext_vector_type(8)));
typedef short s16x4 __attribute__((ext_vector_type(4)));
typedef float f32x4 __attribute__((ext_vector_type(4)));
typedef float f32x16 __attribute__((ext_vector_type(16)));
typedef unsigned u32x4 __attribute__((ext_vector_type(4)));
typedef unsigned u32x2 __attribute__((ext_vector_type(2)));
typedef float f32x2_t __attribute__((ext_vector_type(2)));
typedef __bf16 bf16x2_t __attribute__((ext_vector_type(2)));
#define LAS __attribute__((address_space(3)))

__device__ __forceinline__ unsigned pk_bf16(float lo, float hi) { f32x2_t v = {lo, hi}; bf16x2_t b = __builtin_convertvector(v, bf16x2_t); return __builtin_bit_cast(unsigned, b); }
__device__ __forceinline__ float bf_lo(unsigned u) { return __builtin_bit_cast(float, u << 16); }
__device__ __forceinline__ float bf_hi(unsigned u) { return __builtin_bit_cast(float, u & 0xffff0000u); }
__device__ __forceinline__ float bf2f(bf16_t h) { return __builtin_bit_cast(float, (unsigned)h << 16); }
__device__ __forceinline__ bf16_t f2bf(float f) { return (bf16_t)(pk_bf16(f, 0.f) & 0xffffu); }
__device__ __forceinline__ float wave_sum(float v) { for (int o = 32; o; o >>= 1) v += __shfl_xor(v, o); return v; }
__device__ __forceinline__ float wave_max(float v) { for (int o = 32; o; o >>= 1) v = fmaxf(v, __shfl_xor(v, o)); return v; }
__device__ __forceinline__ float siluf(float x) { return x / (1.f + __expf(-x)); }
__device__ __forceinline__ float sigmf(float x) { return 1.f / (1.f + __expf(-x)); }
__device__ __forceinline__ int t5b(int dist) {
    int n = dist > 0 ? dist : 0; if (n < 16) return n;
    float v = logf((float)n / 16.f) / logf(8.f) * 16.f; int l = 16 + (int)v; return l < 31 ? l : 31;
}

constexpr size_t WS_CTL = 0, CTL_BYTES = 65536;
constexpr size_t WS_SSQ = WS_CTL + CTL_BYTES;
constexpr size_t ZERO_BYTES = CTL_BYTES;
constexpr size_t PT_DQ = 0, PT_DKV = PT_DQ + (size_t)2 * 16384 * 4 * 4, PT_A = PT_DKV + (size_t)2 * 16384 * 2 * 4, PT_C = PT_A + (size_t)2 * 16384 * 8 * 4, PT_X1 = PT_C + (size_t)2 * 16384 * 8 * 4, PT_END = PT_X1 + (size_t)2 * 16384 * 16 * 4;
constexpr size_t WS_SSQX = WS_SSQ + PT_END;
constexpr size_t WS_RS2 = WS_SSQX + 2 * 65536;
constexpr size_t WS_WIN = WS_RS2 + 65536;
constexpr size_t WS_WOUT = WS_WIN + (size_t)2 * 2560 * 1024 * 2;
constexpr size_t WS_WUQ = WS_WOUT + (size_t)2 * 1024 * 1024 * 2;
constexpr size_t WS_WUKV = WS_WUQ + (size_t)2 * 768 * 256 * 2;
constexpr size_t WS_WC1 = WS_WUKV + (size_t)2 * 768 * 256 * 2;
constexpr size_t WS_WC2 = WS_WC1 + (size_t)2 * 2 * 64 * 2048 * 2;
constexpr size_t WS_WR = WS_WC2 + (size_t)2 * 2 * 64 * 64 * 2;
constexpr size_t WS_B1C = WS_WR + (size_t)2 * 64 * 1024 * 2;
constexpr size_t WS_BIASD = WS_B1C + 1024;
constexpr size_t WS_ROPE = WS_BIASD + 6 * 2048 * 4;
constexpr size_t WS_WMOE = WS_ROPE + (size_t)16384 * 32 * 4;
constexpr size_t WMOE_WD = (size_t)32 * 512 * 1024 * 2;
constexpr size_t WS_XB = WS_WMOE + 50331648;
constexpr size_t WS_MLA = WS_XB + 33554432;
constexpr size_t MLA_KM = (size_t)8 * 6 * 2048 * 96 * 2, MLA_VM = 2 * MLA_KM;
constexpr size_t WS_HBUF = WS_MLA;
constexpr size_t WS_PRJ = WS_MLA + 50331648;
constexpr size_t HM64 = (size_t)2048 * 64 * 2;
constexpr size_t PRJ_QN = 0;
constexpr size_t PRJ_KN1 = PRJ_QN + 48 * HM64, PRJ_VN1 = PRJ_KN1 + 16 * HM64, PRJ_KN2 = PRJ_VN1 + 16 * HM64, PRJ_VN2 = PRJ_KN2 + 16 * HM64;
constexpr size_t PRJ_VML = PRJ_VN2 + 16 * HM64;
constexpr size_t PRJ_OG = PRJ_VML + 32 * HM64;
constexpr size_t PRJ_KR = PRJ_OG + (size_t)16384 * 256 * 2;
constexpr size_t PRJ_GATES = PRJ_KR + (size_t)16384 * 32 * 2;
constexpr size_t PRJ_DEAD = PRJ_GATES + (size_t)16384 * 32 * 4;
constexpr size_t PRJ_C0K = PRJ_DEAD, PRJ_C0V = PRJ_C0K + 16 * HM64 + 8192;
constexpr size_t PRJ_RAWQK = PRJ_C0V + 16 * HM64 + 8192;
constexpr size_t PRJ_DQKV = PRJ_RAWQK + (size_t)16384 * 512 * 2;
constexpr size_t PRJ_END = PRJ_DQKV + (size_t)16384 * 384 * 2;
static_assert(PRJ_END - PRJ_DEAD >= 33554432, "Y fits the dead part of PRJ");
constexpr size_t WS_Y = WS_PRJ + PRJ_DEAD;
constexpr size_t WS_YBUF = WS_PRJ;
static_assert((size_t)2 * 16384 * 1024 * 2 <= PRJ_END, "YBUF fits the PRJ region");
constexpr size_t WS_ML = WS_PRJ + PRJ_END;
constexpr size_t ML_KC = 32 * HM64, ML_DELTA = 2 * ML_KC, ML_DN = ML_DELTA + (size_t)1024 * 4096 * 2, ML_G = ML_DN + (size_t)1024 * 64 * 4, ML_BL = ML_G + (size_t)8 * 4 * 2048 * 2 * 4, ML_CP = ML_BL + 4096, ML_NP = ML_CP + (size_t)1024 * 4096 * 2, ML_END = ML_NP + (size_t)1024 * 64 * 2;
constexpr size_t WS_CMP = WS_ML + ML_END;
constexpr size_t CMP_V = (size_t)8 * 2 * 128 * 64 * 2;
constexpr size_t WS_META = WS_CMP + 2 * CMP_V;
constexpr size_t META_W = (size_t)32 * 16384 * 4, META_RT = 2 * META_W;
constexpr size_t WS_END = WS_META + META_RT + (size_t)16384 * 16;
constexpr int CW_BAR = 0;
constexpr int CW_Q = 4096;
constexpr int CW_SCAN = 4608;
constexpr int CW_TS = 4864;
constexpr int CW_CHK = 5120;
constexpr int CW_CNT = 8192;
constexpr int LDS_BYTES = 147456;
constexpr int LDS_MISC = LDS_BYTES - 256;
#define XB_TMO      128
#define XB_XCNT(j)  (256  + 64 * (j))
#define XB_XSUB(j)  (1280 + 64 * (j))
#define XB_XGEN(j)  (2304 + 64 * (j))
#define XB_TOP      3328
#define XB_TOPGEN   3392
#define XCD_BAR_WORDS 3456
#define XB_SPIN_CAP (1u << 18)

__device__ __forceinline__ unsigned xb_ld(unsigned* p)              { return __hip_atomic_load(p, __ATOMIC_RELAXED, __HIP_MEMORY_SCOPE_AGENT); }
__device__ __forceinline__ unsigned xb_add(unsigned* p, unsigned v) { return __hip_atomic_fetch_add(p, v, __ATOMIC_RELAXED, __HIP_MEMORY_SCOPE_AGENT); }
__device__ __forceinline__ unsigned xb_xcc_id() { return (unsigned)__builtin_amdgcn_s_getreg((3 << 11) | 20) & 0xFu; }
#define XB_SPIN(cond, bar) do { unsigned _sp = 0; while (cond) { __builtin_amdgcn_s_sleep(1); \
    if ((++_sp & 255u) == 0u) { if (xb_ld(&(bar)[XB_TMO])) break; if (_sp > XB_SPIN_CAP) { atomicAdd(&(bar)[XB_TMO], 1u); break; } } } } while (0)

struct XcdBarrier {
    unsigned* bar; unsigned x;
    volatile LAS unsigned* st;
};

__device__ __forceinline__ XcdBarrier xcd_barrier_post(unsigned* bar, volatile LAS unsigned* st) {
    XcdBarrier b; b.bar = bar; b.x = xb_xcc_id(); b.st = st;
    if (threadIdx.x == 0) (void)xb_add(&bar[XB_XCNT(b.x)], 1u);
    return b;
}
__device__ __forceinline__ void xcd_barrier_complete(unsigned* bar, unsigned x, unsigned& nloc, unsigned& nx) {
    const unsigned G = gridDim.x * gridDim.y * gridDim.z;
    unsigned sum, cnt, mine, sp = 0u;
    for (;;) {
        sum = 0u; cnt = 0u; mine = 0u;
#pragma unroll
        for (unsigned j = 0; j < 16; ++j) { const unsigned c = xb_ld(&bar[XB_XCNT(j)]); sum += c; cnt += (c > 0u) ? 1u : 0u; mine = (j == x) ? c : mine; }
        if (sum == G) break;
        __builtin_amdgcn_s_sleep(1);
        if ((++sp & 255u) == 0u) { if (xb_ld(&bar[XB_TMO])) break; if (sp > XB_SPIN_CAP) { atomicAdd(&bar[XB_TMO], 1u); break; } }
    }
    nloc = mine > 0u ? mine : 1u; nx = cnt > 0u ? cnt : 1u;
}

__device__ __forceinline__ void xcd_barrier(const XcdBarrier& b) {
    asm volatile("s_waitcnt vmcnt(0)" ::: "memory");
    __syncthreads();
    if (threadIdx.x == 0) {
        unsigned* bar = b.bar;
        __builtin_amdgcn_s_waitcnt(0);
        unsigned nloc = b.st[0], nx = b.st[1];
        if (nloc == 0u) { xcd_barrier_complete(bar, b.x, nloc, nx); b.st[0] = nloc; b.st[1] = nx; }
        const unsigned old = xb_add(&bar[XB_XSUB(b.x)], 1u);
        const unsigned gen = old / nloc;
        if (old + 1u == (gen + 1u) * nloc) {
            __builtin_amdgcn_fence(__ATOMIC_RELEASE, "agent");
            asm volatile("s_waitcnt vmcnt(0)" ::: "memory");
            const unsigned og = xb_add(&bar[XB_TOP], 1u);
            const unsigned tg = og / nx;
            if (og + 1u == (tg + 1u) * nx) xb_add(&bar[XB_TOPGEN], 1u);
            else XB_SPIN(xb_ld(&bar[XB_TOPGEN]) == tg, bar);
            __builtin_amdgcn_fence(__ATOMIC_ACQUIRE, "agent");
            xb_add(&bar[XB_XGEN(b.x)], 1u);
            asm volatile("s_waitcnt vmcnt(0)" ::: "memory");
        } else {
            XB_SPIN(xb_ld(&bar[XB_XGEN(b.x)]) == gen, bar);
            __builtin_amdgcn_fence(__ATOMIC_ACQUIRE, "agent");
            asm volatile("s_waitcnt vmcnt(0)" ::: "memory");
        }
    }
    __syncthreads();
}
struct Inputs { const float* p[30]; };
typedef const __attribute__((address_space(4))) Inputs* InPtr;
__device__ __forceinline__ InPtr in_tab() { InPtr p = (InPtr)__builtin_amdgcn_kernarg_segment_ptr(); asm volatile("" : "+s"(p)); return p; }
__device__ __forceinline__ unsigned char* launder(unsigned char* p) { asm volatile("" : "+s"(p)); return p; }

__host__ __device__ inline int inproj_refcol(int G, int e) {
    if (G < 6) return O_AQ + G * 64 + e;
    if (G < 18) return O_AKV + (G - 6) * 64 + e;
    if (G < 26) return O_BQK + (G - 18) * 64 + e;
    if (G < 30) return O_BV + (G - 26) * 64 + e;
    if (G < 34) return O_BO + (G - 30) * 64 + e;
    if (G < 37) return O_CDQ + (G - 34) * 64 + e;
    if (G == 37) { if (e < 32) return O_CKR + e; if (e < 50) return O_AG + (e - 32); if (e < 58) return O_BIF + (e - 50); return -1; }
    return O_CDKV + (G - 38) * 64 + e;
}
__host__ __device__ inline int uq_refcol(int G, int e) {
    if (G < 6) return G * 96 + e;
    if (G < 9) { const int idx = e & 31, bj = e >> 5, sub = idx >> 4, i = idx & 15; return (2 * (G - 6) + sub) * 96 + 64 + bj * 16 + i; }
    return -1;
}
__host__ __device__ inline int ukv_refcol(int G, int e) { return G < 6 ? G * 128 + e : (G - 6) * 128 + 64 + e; }
#define N2G(n) ((((n) >> 8) << 2) + (((n) >> 5) & 3))
#define N2E(n) (((((n) >> 7) & 1) << 5) + ((n) & 31))

struct FWin { const float* w; const float* g; __device__ __forceinline__ float operator()(int k, int n) const { const int c = inproj_refcol(N2G(n), N2E(n)); return c < 0 ? 0.f : w[(size_t)k * DIN + c] * g[k]; } };
struct FWout { const float* w; const float* ga; const float* gc; __device__ __forceinline__ float operator()(int k, int n) const { const float og = k < 384 ? ga[k] : (k < 640 ? 1.f : gc[k - 640]); return w[(size_t)k * 1024 + n] * og; } };
struct FWuq { const float* w; const float* g; __device__ __forceinline__ float operator()(int k, int n) const { const int c = uq_refcol(N2G(n), N2E(n)); return (k < 192 && c >= 0) ? w[(size_t)k * 576 + c] * g[k] : 0.f; } };
struct FWukv { const float* w; const float* g; __device__ __forceinline__ float operator()(int k, int n) const { const int c = ukv_refcol(N2G(n), N2E(n)); return k >= 128 ? w[(size_t)(k - 128) * 768 + c] * g[k - 128] : 0.f; } };
struct FWc1 { const float* w; __device__ __forceinline__ float operator()(int k, int n) const { return w[(size_t)k * 64 + n]; } };
struct FWr { const float* wg; const float* we; const float* g; __device__ __forceinline__ float operator()(int k, int n) const { return n < 4 ? wg[k * 4 + n] * g[k] : (n < 36 ? we[k * 32 + n - 4] * g[k] : 0.f); } };
struct FWgu { const float* src; const float* g; int n0, col0; __device__ __forceinline__ float operator()(int k, int n) const { return src[(size_t)k * 256 + col0 + (n - n0)] * g[k]; } };
struct FWd { const float* w; __device__ __forceinline__ float operator()(int k, int n) const { return w[(size_t)k * 1024 + n]; } };

__device__ __forceinline__ void rope_cs(int pos, int j, float& cs, float& sn) {
    const double inv = exp2(-(double)j * (13.287712379549449 / 16.0));
    const double rev = (double)pos * inv * 0.15915494309189535; const float f = (float)(rev - rint(rev));
    cs = __builtin_amdgcn_cosf(f); sn = __builtin_amdgcn_sinf(f);
}
template <class F>
__device__ __forceinline__ void cvt_tile(const F& f, int n0, int k0, bf16_t* dst, int ldk, LAS float* tile, int tid) {
    { const int k = tid >> 3, nb = (tid & 7) * 8;
#pragma unroll
      for (int j = 0; j < 8; ++j) tile[k * 65 + nb + j] = f(k0 + k, n0 + nb + j); }
    __syncthreads();
    { const int n = tid >> 3, kb = (tid & 7) * 8; const LAS float* s = tile + kb * 65 + n;
      u32x4 o; o.x = pk_bf16(s[0], s[65]); o.y = pk_bf16(s[130], s[195]); o.z = pk_bf16(s[260], s[325]); o.w = pk_bf16(s[390], s[455]);
      *(u32x4*)(dst + (size_t)(n0 + n) * ldk + k0 + kb) = o; }
    __syncthreads();
}
template <class F>
__device__ __forceinline__ void cvt_item(const F& f, int it, int nK, bf16_t* dst, int ldk, LAS float* tile, int tid) { cvt_tile(f, (it / nK) * 64, (it % nK) * 64, dst, ldk, tile, tid); }

__device__ __forceinline__ void moe_item(InPtr in, int l, int it, const float*& src, int& ld, size_t& dst, int& ldk, bool& gain) {
    if (it < 32 * 128) { const int e = it >> 7, r = it & 127, n0 = (r >> 4) * 64, k0 = (r & 15) * 64, c0 = n0 & 255;
        src = (c0 < 128 ? in->p[27] : in->p[28]) + ((size_t)l * 32 + e) * 262144 + (size_t)k0 * 256 + (n0 >> 8) * 128 + (c0 & 127); ld = 256; gain = true;
        dst = ((size_t)e * 512 + n0) * 1024 + k0; ldk = 1024; }
    else { const int j = it - 32 * 128, e = j >> 6, r = j & 63, n0 = (r >> 2) * 64, k0 = (r & 3) * 64;
        src = in->p[29] + ((size_t)l * 32 + e) * 262144 + (size_t)k0 * 1024 + n0; ld = 1024; gain = false;
        dst = (size_t)16777216 + ((size_t)e * 1024 + n0) * 256 + k0; ldk = 256; }
}
__device__ __forceinline__ void cvt_moe_layer(InPtr in, unsigned char* ws, int l, LAS float* tile, int bid, int nb, int tid) {
    asm volatile("" : "+v"(tid));
    const float* g2 = in->p[22] + l * 1024; bf16_t* W = (bf16_t*)(ws + WS_WMOE);
    const int k = tid >> 3, nbq = (tid & 7) * 8;
    const int n = tid >> 3, kb = (tid & 7) * 8;
    constexpr int NIT = 32 * (128 + 64);
    int it = bid; f32x4 v0, v1; const float* src; int ld, ldk; size_t dst = 0; bool gain; float gk = 1.f; int kk0 = 0;
    if (it < NIT) { moe_item(in, l, it, src, ld, dst, ldk, gain); v0 = *(const f32x4*)(src + (size_t)k * ld + nbq); v1 = *(const f32x4*)(src + (size_t)k * ld + nbq + 4);
        kk0 = it < 32 * 128 ? ((it & 127) & 15) * 64 : 0; gk = gain ? g2[kk0 + k] : 1.f; }
    int buf = 0;
    for (; it < NIT; it += nb) {
        LAS float* t = tile + buf * (64 * 65);
        t[k * 65 + nbq + 0] = v0.x * gk; t[k * 65 + nbq + 1] = v0.y * gk; t[k * 65 + nbq + 2] = v0.z * gk; t[k * 65 + nbq + 3] = v0.w * gk;
        t[k * 65 + nbq + 4] = v1.x * gk; t[k * 65 + nbq + 5] = v1.y * gk; t[k * 65 + nbq + 6] = v1.z * gk; t[k * 65 + nbq + 7] = v1.w * gk;
        const size_t cdst = dst; const int cldk = ldk;
        __syncthreads();
        const int itn = it + nb;
        if (itn < NIT) { moe_item(in, l, itn, src, ld, dst, ldk, gain); v0 = *(const f32x4*)(src + (size_t)k * ld + nbq); v1 = *(const f32x4*)(src + (size_t)k * ld + nbq + 4);
            kk0 = itn < 32 * 128 ? ((itn & 127) & 15) * 64 : 0; gk = gain ? g2[kk0 + k] : 1.f; }
        const LAS float* s = t + kb * 65 + n;
        u32x4 o; o.x = pk_bf16(s[0], s[65]); o.y = pk_bf16(s[130], s[195]); o.z = pk_bf16(s[260], s[325]); o.w = pk_bf16(s[390], s[455]);
        *(u32x4*)(W + cdst + (size_t)n * cldk + kb) = o;
        buf ^= 1;
    }
    __syncthreads();
}

__device__ __forceinline__ void prologue(InPtr in, unsigned char* ws, LAS unsigned char* lds, int bid, int nb) {
    int tid_ = threadIdx.x; asm volatile("" : "+v"(tid_));
    const int tid = tid_, lane = tid & 63, wid = tid >> 6;
    LAS float* tile = (LAS float*)lds;
    constexpr int I_WIN = 40 * 16, I_WOUT = 16 * 16, I_WU = 12 * 4, I_WC1 = 32, I_WC2 = 1, I_WR = 16;
    constexpr int PER_L = I_WIN + I_WOUT + 2 * I_WU + 2 * I_WC1 + 2 * I_WC2 + I_WR;
    for (int it0 = bid; it0 < 2 * PER_L; it0 += nb) {
        const int l = it0 / PER_L; int it = it0 % PER_L;
        if (it < I_WIN) { FWin f{in->p[4] + (size_t)l * 1024 * DIN, in->p[3] + l * 1024}; cvt_item(f, it, 16, (bf16_t*)(ws + WS_WIN) + (size_t)l * 2560 * 1024, 1024, tile, tid); continue; } it -= I_WIN;
        if (it < I_WOUT) { FWout f{in->p[21] + (size_t)l * 1048576, in->p[10] + l * 384, in->p[20] + l * 384}; cvt_item(f, it, 16, (bf16_t*)(ws + WS_WOUT) + (size_t)l * 1048576, 1024, tile, tid); continue; } it -= I_WOUT;
        if (it < I_WU) { FWuq f{in->p[16] + (size_t)l * 192 * 576, in->p[15] + l * 192}; cvt_item(f, it, 4, (bf16_t*)(ws + WS_WUQ) + (size_t)l * 768 * 256, 256, tile, tid); continue; } it -= I_WU;
        if (it < I_WU) { FWukv f{in->p[18] + (size_t)l * 128 * 768, in->p[17] + l * 128}; cvt_item(f, it, 4, (bf16_t*)(ws + WS_WUKV) + (size_t)l * 768 * 256, 256, tile, tid); continue; } it -= I_WU;
        if (it < 2 * I_WC1) { const int s = it / I_WC1; FWc1 f{in->p[6] + ((size_t)l * 2 + s) * 2048 * 64}; cvt_item(f, it % I_WC1, 32, (bf16_t*)(ws + WS_WC1) + ((size_t)l * 2 + s) * 64 * 2048, 2048, tile, tid); continue; } it -= 2 * I_WC1;
        if (it < 2 * I_WC2) { const int s = it; FWc1 f{in->p[7] + ((size_t)l * 2 + s) * 64 * 64}; cvt_item(f, 0, 1, (bf16_t*)(ws + WS_WC2) + ((size_t)l * 2 + s) * 64 * 64, 64, tile, tid); continue; } it -= 2 * I_WC2;
        { FWr f{in->p[23] + (size_t)l * 4096, in->p[25] + (size_t)l * 32768, in->p[22] + l * 1024}; cvt_item(f, it, 16, (bf16_t*)(ws + WS_WR) + (size_t)l * 64 * 1024, 1024, tile, tid); }
    }
    { const float* x = in->p[0]; bf16_t* XB = (bf16_t*)(ws + WS_XB); float* ssqx = (float*)(ws + WS_SSQX);
      for (int r = bid * 8 + wid; r < NTOK; r += nb * 8) {
          const f32x4* xr = (const f32x4*)(x + (size_t)r * 1024) + lane; float s = 0.f; u32x2* o = (u32x2*)(XB + (size_t)r * 1024) + lane;
#pragma unroll
          for (int j = 0; j < 4; ++j) { const f32x4 v = xr[64 * j]; s += (v.x * v.x + v.y * v.y) + (v.z * v.z + v.w * v.w); u32x2 w; w.x = pk_bf16(v.x, v.y); w.y = pk_bf16(v.z, v.w); o[64 * j] = w; }
          s = wave_sum(s); if (lane == 0) ssqx[r] = s;
      } }
    { float* biasd = (float*)(ws + WS_BIASD); const float* rb = in->p[2];
      for (int i = bid * 512 + tid; i < 6 * 2048; i += nb * 512) { const int h = i >> 11, d = i & 2047; biasd[i] = rb[t5b(d) * 6 + h] * 1.44269504f; } }
    { float* rope = (float*)(ws + WS_ROPE); const int* pos = (const int*)in->p[1];
      for (int i = bid * 512 + tid; i < NTOK * 16; i += nb * 512) { const int tk = i >> 4, j = i & 15; float cs, sn; rope_cs(pos[tk], j, cs, sn); rope[(size_t)tk * 32 + j] = cs; rope[(size_t)tk * 32 + 16 + j] = sn; } }
    { float* b1c = (float*)(ws + WS_B1C); LAS float* red = (LAS float*)lds;
      for (int it = bid; it < 4; it += nb) { const float* pe = in->p[5] + (size_t)it * 2048; const float* w1 = in->p[6] + (size_t)it * 2048 * 64; const int f = tid & 63, part = tid >> 6;
          float a = 0.f; for (int k = part * 256; k < part * 256 + 256; ++k) a += pe[k] * w1[(size_t)k * 64 + f];
          __syncthreads(); red[tid] = a; __syncthreads();
          if (tid < 64) { float s = 0.f; for (int p2 = 0; p2 < 8; ++p2) s += red[p2 * 64 + tid]; b1c[it * 64 + tid] = s; }
          __syncthreads(); } }
}
namespace g8 {
constexpr int BM = 256, BK = 64, HALF = 128, HTB = HALF * BK * 2, STAGE_BYTES = 8 * HTB, NXCD = 8, WGM = 8;
__host__ __device__ __forceinline__ int lds_byte(int r, int c) { const int st = (r >> 4) * 2 + (c >> 5), rr = r & 15, cc = c & 31, ob = rr * 64 + cc * 2; return st * 1024 + (ob ^ (((ob >> 9) & 1) << 5)); }
__host__ __device__ __forceinline__ void stage_rc(int b, int& R, int& C) { const int st = b / 1024, sb = b % 1024, swz = sb ^ (((sb >> 9) & 1) << 5); R = (st >> 1) * 16 + swz / 64; C = (st & 1) * 32 + (swz % 64) / 2; }
__host__ __device__ __forceinline__ int perm32(int rho) { const int n = rho >> 4, i = rho & 15; return 8 * (i >> 2) + 4 * n + (i & 3); }

struct GUnit { const char* a; const char* b; int pm, pn, e, rows; };

__device__ __forceinline__ bool static_unit(int i, int G, int c, int nM, int nN, int& pm, int& pn) {
    const int nwg = nM * nN; const long L = (long)i * G + c; if (L >= nwg) return false;
    int wgid = (int)L; { const int q = nwg / NXCD, r = nwg % NXCD, xcd = wgid % NXCD, off = wgid / NXCD; wgid = (xcd < r ? xcd * (q + 1) : r * (q + 1) + (xcd - r) * q) + off; }
    const int nig = WGM * nN, gid = wgid / nig, fm = gid * WGM, gsz = (nM - fm) < WGM ? (nM - fm) : WGM;
    pm = fm + ((wgid % nig) % gsz); pn = (wgid % nig) / gsz; return true;
}
struct DenseSched {
    static constexpr bool GATHER = false;
    const char* A; const char* Bt; int lda, ldb, nM, nN, G, c;
    __device__ __forceinline__ bool next(int i, GUnit& u) const {
        int pm, pn; if (!static_unit(i, G, c, nM, nN, pm, pn)) return false;
        u.pm = pm; u.pn = pn; u.e = 0; u.rows = 256; u.a = A + (size_t)pm * 256 * lda * 2; u.b = Bt + (size_t)pn * 256 * ldb * 2; return true;
    }
    __device__ __forceinline__ void aoff(const GUnit&, unsigned (&v)[2][2], const int (&R)[2], const int (&C)[2]) const {
#pragma unroll
        for (int h = 0; h < 2; ++h)
#pragma unroll
            for (int i = 0; i < 2; ++i) v[h][i] = (unsigned)((h * 128 + R[i]) * lda + C[i]) * 2u;
    }
};

template <class Epi, class Sched>
__device__ __forceinline__ void gemm_run(LAS unsigned char* lds, const int K, const int ldb, const Sched& S, const Epi& E) {
    int tid_ = threadIdx.x; asm volatile("" : "+v"(tid_));
    const int tid = tid_, wid = __builtin_amdgcn_readfirstlane(tid >> 6), lane = tid & 63, wr = wid >> 2, wc = wid & 3, fr = lane & 15, fq = lane >> 4;
    int nt_ = K / BK; asm volatile("" : "+s"(nt_));
    const int nt = nt_;
    int R[2], C[2]; unsigned voffB[2];
#pragma unroll
    for (int i = 0; i < 2; ++i) { stage_rc(tid * 16 + i * 8192, R[i], C[i]); const int Rb = (R[i] & ~31) + perm32(R[i] & 31); voffB[i] = (unsigned)(Rb * ldb + C[i]) * 2u; }
    const size_t kstep = (size_t)(BK * 2);
    const size_t hstepB = (size_t)HALF * ldb * 2;
    const unsigned ldsw = (unsigned)wid * 1024u;
    const int aoff = lds_byte(wr * 64 + fr, fq * 8), boff = lds_byte(wc * 32 + fr, fq * 8);
#define G8_SA(b, h) (((b) * 2 + (h)) * HTB)
#define G8_SB(b, h) ((4 + (b) * 2 + (h)) * HTB)
#define G8_GLDS(bufoff, gptr, i_) __builtin_amdgcn_global_load_lds((const unsigned*)(gptr), (LAS unsigned*)(lds + (bufoff) + ldsw + (i_) * 8192), 16, 0, 0)
#define G8_STAGE_B(bufoff, gbase) do { G8_GLDS(bufoff, (const char*)(gbase) + voffB[0], 0); G8_GLDS(bufoff, (const char*)(gbase) + voffB[1], 1); } while (0)
#define G8_STAGE_A(bufoff, gbase, v0, v1) do { G8_GLDS(bufoff, (const char*)(gbase) + (v0), 0); G8_GLDS(bufoff, (const char*)(gbase) + (v1), 1); } while (0)
#define G8_LDA(dst, b, h) do { _Pragma("unroll") for (int m = 0; m < 4; ++m) _Pragma("unroll") for (int k = 0; k < 2; ++k) dst[m][k] = *(const LAS bf16x8*)(lds + G8_SA(b, h) + aoff + m * 2048 + k * 1024); } while (0)
#define G8_LDB(dst, b, h) do { _Pragma("unroll") for (int n = 0; n < 2; ++n) _Pragma("unroll") for (int k = 0; k < 2; ++k) dst[n][k] = *(const LAS bf16x8*)(lds + G8_SB(b, h) + boff + n * 2048 + k * 1024); } while (0)
#define G8_MMA(ai, bj, At, Bt) do { __builtin_amdgcn_s_setprio(1); _Pragma("unroll") for (int m = 0; m < 4; ++m) _Pragma("unroll") for (int n = 0; n < 2; ++n) _Pragma("unroll") for (int k = 0; k < 2; ++k) \
        acc[ai][bj][m][n] = __builtin_amdgcn_mfma_f32_16x16x32_bf16(Bt[n][k], At[m][k], acc[ai][bj][m][n], 0, 0, 0); __builtin_amdgcn_s_setprio(0); } while (0)
#define G8_WAIT_V(n) asm volatile("s_waitcnt vmcnt(" #n ")" ::: "memory")
#define G8_WAIT_L(n) asm volatile("s_waitcnt lgkmcnt(" #n ")" ::: "memory")
#define G8_BAR __builtin_amdgcn_s_barrier()
#define G8_SCHED __builtin_amdgcn_sched_barrier(0)
    GUnit cur, nxt; int ui = 0;
    if (!S.next(0, cur)) return;
    constexpr bool GATHER = Sched::GATHER;
    unsigned vc[2][2];
    S.aoff(cur, vc, R, C);
    LAS u32x4* stash = (LAS u32x4*)(lds + STAGE_BYTES + 4096) + tid;
    f32x4 acc[2][2][4][2];
#pragma unroll
    for (int a = 0; a < 2; ++a)
#pragma unroll
        for (int b = 0; b < 2; ++b)
#pragma unroll
            for (int m = 0; m < 4; ++m)
#pragma unroll
                for (int n = 0; n < 2; ++n) acc[a][b][m][n] = (f32x4){0.f, 0.f, 0.f, 0.f};
    bf16x8 At[4][2], B0[2][2], B1[2][2];
    const char* cA = cur.a; const char* cB = cur.b;
    G8_STAGE_B(G8_SB(0, 0), cB); G8_STAGE_B(G8_SB(0, 1), cB + hstepB); G8_STAGE_A(G8_SA(0, 0), cA, vc[0][0], vc[0][1]); G8_STAGE_A(G8_SA(0, 1), cA, vc[1][0], vc[1][1]);
    if (wr == 1) G8_BAR;
    G8_WAIT_V(2); G8_BAR;
    G8_STAGE_B(G8_SB(1, 0), cB + kstep); G8_STAGE_A(G8_SA(1, 0), cA + kstep, vc[0][0], vc[0][1]); G8_STAGE_B(G8_SB(1, 1), cB + hstepB + kstep);
    G8_WAIT_V(6); G8_BAR;
    for (;;) {
        const bool has_next = S.next(ui + 1, nxt);
        if (GATHER) { unsigned vn[2][2];
            if (has_next) S.aoff(nxt, vn, R, C);
            else { vn[0][0] = vc[0][0]; vn[0][1] = vc[0][1]; vn[1][0] = vc[1][0]; vn[1][1] = vc[1][1]; }
            u32x4 sv; sv.x = vn[0][0]; sv.y = vn[0][1]; sv.z = vn[1][0]; sv.w = vn[1][1]; *stash = sv; }
        const char* nA = has_next ? nxt.a : cA; const char* nB = has_next ? nxt.b : cB;
#pragma unroll 1
        for (int t = 0; t < nt; t += 2) {
            const bool last = (t == nt - 2);
            const char* a1 = cA + (size_t)(t + 1) * kstep;
            const char* a2 = last ? nA : cA + (size_t)(t + 2) * kstep; const char* b2 = last ? nB : cB + (size_t)(t + 2) * kstep;
            const char* a3 = a2 + kstep; const char* b3 = b2 + kstep;
            unsigned w00 = vc[0][0], w01 = vc[0][1], w10 = vc[1][0], w11 = vc[1][1];
            if (GATHER) { if (last) { const u32x4 sv = *stash; w00 = sv.x; w01 = sv.y; w10 = sv.z; w11 = sv.w; } }
            G8_LDB(B0, 0, 0); G8_LDB(B1, 0, 1); G8_SCHED; G8_LDA(At, 0, 0); G8_STAGE_A(G8_SA(1, 1), a1, vc[1][0], vc[1][1]);
            G8_WAIT_V(8); G8_WAIT_L(0); G8_BAR; G8_MMA(0, 0, At, B0); G8_MMA(0, 1, At, B1); G8_BAR; G8_SCHED;
            G8_LDA(At, 0, 1); G8_STAGE_B(G8_SB(0, 0), b2); G8_STAGE_B(G8_SB(0, 1), b2 + hstepB); G8_STAGE_A(G8_SA(0, 0), a2, w00, w01);
            G8_WAIT_V(8); G8_WAIT_L(0); G8_BAR; G8_MMA(1, 0, At, B0); G8_MMA(1, 1, At, B1); G8_BAR; G8_SCHED;
            G8_LDB(B0, 1, 0); G8_LDB(B1, 1, 1); G8_SCHED; G8_LDA(At, 1, 0); G8_STAGE_A(G8_SA(0, 1), a2, w10, w11);
            G8_WAIT_V(8); G8_WAIT_L(0); G8_BAR; G8_MMA(0, 0, At, B0); G8_MMA(0, 1, At, B1); G8_BAR; G8_SCHED;
            G8_LDA(At, 1, 1); G8_STAGE_B(G8_SB(1, 0), b3); G8_STAGE_B(G8_SB(1, 1), b3 + hstepB); G8_STAGE_A(G8_SA(1, 0), a3, w00, w01);
            G8_WAIT_V(8); G8_WAIT_L(0); G8_BAR; G8_MMA(1, 0, At, B0); G8_MMA(1, 1, At, B1); G8_BAR; G8_SCHED;
        }
        if (wr == 0) G8_BAR;
        { int fr_ = fr, fq_ = fq; asm volatile("" : "+v"(fr_), "+v"(fq_));
          E(acc, cur, wr, wc, fr_, fq_); }
        if (!has_next) break;
#pragma unroll
        for (int a = 0; a < 2; ++a)
#pragma unroll
            for (int b = 0; b < 2; ++b)
#pragma unroll
                for (int m = 0; m < 4; ++m)
#pragma unroll
                    for (int n = 0; n < 2; ++n) acc[a][b][m][n] = (f32x4){0.f, 0.f, 0.f, 0.f};
        cur = nxt; cA = nA; cB = nB; ++ui;
        if (GATHER) { const u32x4 sv = *stash; vc[0][0] = sv.x; vc[0][1] = sv.y; vc[1][0] = sv.z; vc[1][1] = sv.w; }
        if (wr == 1) G8_BAR;
    }
    G8_WAIT_V(0);
    G8_BAR;
#undef G8_SA
#undef G8_SB
#undef G8_GLDS
#undef G8_STAGE_A
#undef G8_STAGE_B
#undef G8_LDA
#undef G8_LDB
#undef G8_MMA
#undef G8_WAIT_V
#undef G8_WAIT_L
#undef G8_BAR
#undef G8_SCHED
}
}
using g8::GUnit;
__device__ __forceinline__ void st_bf16x8(bf16_t* p, const float (&v)[8]) { u32x4 w; w.x = pk_bf16(v[0], v[1]); w.y = pk_bf16(v[2], v[3]); w.z = pk_bf16(v[4], v[5]); w.w = pk_bf16(v[6], v[7]); *(u32x4*)p = w; }
__device__ __forceinline__ float quad_sum(float s) { s += __shfl_xor(s, 16); s += __shfl_xor(s, 32); return s; }

struct EpiInProj {
    const float* ssqx; float* part_dq; float* part_dkv; const float* qg; const float* kg; const float* krg; const float* rope;
    unsigned char* prj;
    __device__ __forceinline__ void operator()(const f32x4 (&acc)[2][2][4][2], const GUnit& u, int wr, int wc, int fr, int fq) const {
        const int G = u.pn * 4 + wc;
        const bool isq = G < 6; const int a = G - 6; const bool isk = (G >= 10 && G < 18 && ((a >> 1) & 1) == 0);
        const float* g0 = (isq ? qg : kg) + 8 * fq;
#pragma unroll
        for (int ai = 0; ai < 2; ++ai)
#pragma unroll
            for (int m = 0; m < 4; ++m) {
                __builtin_amdgcn_sched_barrier(0);
                const int row = u.pm * 256 + ai * 128 + wr * 64 + m * 16 + fr; const int b = row >> 11, t = row & 2047;
                const float rs = rsqrtf(ssqx[row] * (1.f / 1024.f) + 1e-6f);
                float v[2][8];
#pragma unroll
                for (int bj = 0; bj < 2; ++bj)
#pragma unroll
                    for (int n = 0; n < 2; ++n)
#pragma unroll
                        for (int j = 0; j < 4; ++j) v[bj][4 * n + j] = acc[ai][bj][m][n][j] * rs;
                float ss = 0.f;
#pragma unroll
                for (int bj = 0; bj < 2; ++bj)
#pragma unroll
                    for (int i = 0; i < 8; ++i) ss += v[bj][i] * v[bj][i];
                bf16_t* dst = nullptr; int bstride = 32;
                if (isq) {
                    ss = quad_sum(ss); const float sc = rsqrtf(ss * (1.f / 64.f) + 1e-6f) * 0.18033688f;
#pragma unroll
                    for (int i = 0; i < 8; ++i) { v[0][i] *= sc * g0[i]; v[1][i] *= sc * g0[32 + i]; }
                    dst = (bf16_t*)(prj + PRJ_QN) + ((size_t)(b * 6 + G) * 2048 + t) * 64;
                } else if (G < 18) {
                    const int br = a >> 2, s = (a >> 1) & 1, hk = a & 1;
                    if (br > 0 && s == 0) {
                        ss = quad_sum(ss); const float sc = rsqrtf(ss * (1.f / 64.f) + 1e-6f);
#pragma unroll
                        for (int i = 0; i < 8; ++i) { v[0][i] *= sc * g0[i]; v[1][i] *= sc * g0[32 + i]; }
                    }
                    const size_t base = br == 0 ? (s ? PRJ_C0V : PRJ_C0K) : (br == 1 ? (s ? PRJ_VN1 : PRJ_KN1) : (s ? PRJ_VN2 : PRJ_KN2));
                    dst = (bf16_t*)(prj + base) + ((size_t)(b * 2 + hk) * 2048 + t) * 64;
                } else if (G < 26) { dst = (bf16_t*)(prj + PRJ_RAWQK) + (size_t)row * 512 + (G - 18) * 64; }
                else if (G < 30) { dst = (bf16_t*)(prj + PRJ_VML) + ((size_t)(b * 4 + (G - 26)) * 2048 + t) * 64; }
                else if (G < 34) { dst = (bf16_t*)(prj + PRJ_OG) + (size_t)row * 256 + (G - 30) * 64; }
                else if (G < 37) { dst = (bf16_t*)(prj + PRJ_DQKV) + (size_t)row * 384 + (G - 34) * 64; ss = quad_sum(ss); if (fq == 0) part_dq[(size_t)row * 4 + (G - 34)] = ss; }
                else if (G == 37) {
                    dst = (bf16_t*)(prj + PRJ_DQKV) + (size_t)row * 384 + 192;
                    float* gt = (float*)(prj + PRJ_GATES) + (size_t)row * 32 + 8 * fq;
                    *(f32x4*)gt = (f32x4){v[1][0], v[1][1], v[1][2], v[1][3]}; *(f32x4*)(gt + 4) = (f32x4){v[1][4], v[1][5], v[1][6], v[1][7]};
                    float s0 = 0.f;
#pragma unroll
                    for (int i = 0; i < 8; ++i) s0 += v[0][i] * v[0][i];
                    s0 = quad_sum(s0); const float sc = rsqrtf(s0 * (1.f / 32.f) + 1e-6f);
                    const float* rp = rope + (size_t)row * 32 + ((8 * fq) & 15);
                    float kr[8];
#pragma unroll
                    for (int i = 0; i < 8; ++i) { const float val = v[0][i] * sc * krg[8 * fq + i]; const float oth = __shfl_xor(val, 32); const float cs = rp[i], sn = rp[16 + i]; kr[i] = fq < 2 ? val * cs - oth * sn : val * cs + oth * sn; }
                    st_bf16x8((bf16_t*)(prj + PRJ_KR) + (size_t)row * 32 + 8 * fq, kr);
                } else { dst = (bf16_t*)(prj + PRJ_DQKV) + (size_t)row * 384 + 256 + (G - 38) * 64; ss = quad_sum(ss); if (fq == 0) part_dkv[(size_t)row * 2 + (G - 38)] = ss; }
                st_bf16x8(dst + 8 * fq, v[0]); st_bf16x8(dst + bstride + 8 * fq, v[1]);
            }
    }
};

struct EpiUq {
    const float* ssq_dq; const float* qkn; const float* rope; bf16_t* QM;
    __device__ __forceinline__ void operator()(const f32x4 (&acc)[2][2][4][2], const GUnit& u, int wr, int wc, int fr, int fq) const {
        const int G = u.pn * 4 + wc; if (G >= 9) return;
        const float scale = 0.14724444f;
        const float* g0 = G < 6 ? qkn + 8 * fq : qkn + 64 + 8 * (fq & 1); const float* g1 = G < 6 ? g0 + 32 : g0 + 16;
#pragma unroll
        for (int ai = 0; ai < 2; ++ai)
#pragma unroll
            for (int m = 0; m < 4; ++m) {
                __builtin_amdgcn_sched_barrier(0);
                const int row = u.pm * 256 + ai * 128 + wr * 64 + m * 16 + fr; const int b = row >> 11, t = row & 2047;
                const f32x4 pq = *(const f32x4*)(ssq_dq + (size_t)row * 4); const float rs = rsqrtf(((pq.x + pq.y) + pq.z) * (1.f / 192.f) + 1e-6f);
                float v[2][8]; float ss = 0.f;
#pragma unroll
                for (int bj = 0; bj < 2; ++bj)
#pragma unroll
                    for (int n = 0; n < 2; ++n)
#pragma unroll
                        for (int j = 0; j < 4; ++j) { const float x = acc[ai][bj][m][n][j] * rs; v[bj][4 * n + j] = x; ss += x * x; }
                if (G < 6) ss = quad_sum(ss); else ss += __shfl_xor(ss, 16);
                const float sc = rsqrtf(ss * (G < 6 ? 1.f / 64.f : 1.f / 32.f) + 1e-6f) * scale;
#pragma unroll
                for (int i = 0; i < 8; ++i) { v[0][i] *= sc * g0[i]; v[1][i] *= sc * g1[i]; }
                if (G < 6) {
                    bf16_t* dst = QM + ((size_t)(b * 6 + G) * 2048 + t) * 96;
                    st_bf16x8(dst + 8 * fq, v[0]); st_bf16x8(dst + 32 + 8 * fq, v[1]);
                } else {
                    const int i16 = 8 * (fq & 1); const int head = 2 * (G - 6) + (fq >> 1);
                    const float* rp = rope + (size_t)row * 32 + i16; float o1[8], o2[8];
#pragma unroll
                    for (int i = 0; i < 8; ++i) { const float cs = rp[i], sn = rp[16 + i]; o1[i] = v[0][i] * cs - v[1][i] * sn; o2[i] = v[1][i] * cs + v[0][i] * sn; }
                    bf16_t* dst = QM + ((size_t)(b * 6 + head) * 2048 + t) * 96 + 64 + i16;
                    st_bf16x8(dst, o1); st_bf16x8(dst + 16, o2);
                }
            }
    }
};
struct EpiUkv {
    const float* ssq_dkv; const float* qkn; const bf16_t* KR; bf16_t* KM; bf16_t* VM;
    __device__ __forceinline__ void operator()(const f32x4 (&acc)[2][2][4][2], const GUnit& u, int wr, int wc, int fr, int fq) const {
        const int G = u.pn * 4 + wc;
        const float* g0 = qkn + 96 + 8 * fq;
#pragma unroll
        for (int ai = 0; ai < 2; ++ai)
#pragma unroll
            for (int m = 0; m < 4; ++m) {
                __builtin_amdgcn_sched_barrier(0);
                const int row = u.pm * 256 + ai * 128 + wr * 64 + m * 16 + fr; const int b = row >> 11, t = row & 2047;
                const float rs = rsqrtf((ssq_dkv[(size_t)row * 2] + ssq_dkv[(size_t)row * 2 + 1]) * (1.f / 128.f) + 1e-6f);
                float v[2][8]; float ss = 0.f;
#pragma unroll
                for (int bj = 0; bj < 2; ++bj)
#pragma unroll
                    for (int n = 0; n < 2; ++n)
#pragma unroll
                        for (int j = 0; j < 4; ++j) { const float x = acc[ai][bj][m][n][j] * rs; v[bj][4 * n + j] = x; ss += x * x; }
                if (G < 6) {
                    ss = quad_sum(ss); const float sc = rsqrtf(ss * (1.f / 64.f) + 1e-6f);
#pragma unroll
                    for (int i = 0; i < 8; ++i) { v[0][i] *= sc * g0[i]; v[1][i] *= sc * g0[32 + i]; }
                    bf16_t* dst = KM + ((size_t)(b * 6 + G) * 2048 + t) * 96;
                    st_bf16x8(dst + 8 * fq, v[0]); st_bf16x8(dst + 32 + 8 * fq, v[1]);
                    *(u32x4*)(dst + 64 + 8 * fq) = *(const u32x4*)(KR + (size_t)row * 32 + 8 * fq);
                } else {
                    bf16_t* dst = VM + ((size_t)(b * 6 + (G - 6)) * 2048 + t) * 64;
                    st_bf16x8(dst + 8 * fq, v[0]); st_bf16x8(dst + 32 + 8 * fq, v[1]);
                }
            }
    }
};
#define MFMA16(a, b, c) __builtin_amdgcn_mfma_f32_16x16x32_bf16(a, b, c, 0, 0, 0)
#define MFMA32(a, b, c) __builtin_amdgcn_mfma_f32_32x32x16_bf16(a, b, c, 0, 0, 0)
#define LDS_FENCE() asm volatile("s_waitcnt lgkmcnt(0)" ::: "memory")

__device__ __forceinline__ void cmp_unit(int u, int l, InPtr in, unsigned char* ws, LAS unsigned char* lds) {
    int tid_ = threadIdx.x; asm volatile("" : "+v"(tid_));
    const int tid = tid_, w = tid >> 6, lane = tid & 63, r = lane & 15, q = lane >> 4;
    const int b = u >> 2, s = (u >> 1) & 1, hk = u & 1;
    const bf16_t* A = (const bf16_t*)(ws + WS_PRJ + (s ? PRJ_C0V : PRJ_C0K)) + (size_t)(b * 2 + hk) * 2048 * 64;
    const bf16_t* W1 = (const bf16_t*)(ws + WS_WC1) + ((size_t)l * 2 + s) * 64 * 2048;
    const bf16_t* W2 = (const bf16_t*)(ws + WS_WC2) + ((size_t)l * 2 + s) * 64 * 64;
    const float* b1 = (const float*)(ws + WS_B1C) + (l * 2 + s) * 64;
    f32x4 acc[4];
#pragma unroll
    for (int nb = 0; nb < 4; ++nb) acc[nb] = (f32x4){0.f, 0.f, 0.f, 0.f};
    const bf16_t* ap = A + (size_t)(16 * w + r) * 1024 + 8 * q;
    constexpr int WP = 528, WBUF = 64 * WP; LAS unsigned char* wb = lds + 24576;
    u32x4 st[4];
#pragma unroll
    for (int i = 0; i < 4; ++i) { const int c = tid + 512 * i; st[i] = *(const u32x4*)(W1 + (size_t)(c >> 5) * 2048 + (c & 31) * 8); }
#pragma unroll
    for (int i = 0; i < 4; ++i) { const int c = tid + 512 * i; *(LAS u32x4*)(wb + (c >> 5) * WP + (c & 31) * 16) = st[i]; }
    __syncthreads();
#pragma unroll 1
    for (int kc = 0; kc < 8; ++kc) {
        const int cur = kc & 1;
        if (kc < 7) {
#pragma unroll
            for (int i = 0; i < 4; ++i) { const int c = tid + 512 * i; st[i] = *(const u32x4*)(W1 + (size_t)(c >> 5) * 2048 + (kc + 1) * 256 + (c & 31) * 8); }
        }
        bf16x8 af[8];
#pragma unroll
        for (int ks = 0; ks < 8; ++ks) af[ks] = *(const bf16x8*)(ap + 256 * kc + 32 * ks);
#pragma unroll
        for (int ks = 0; ks < 8; ++ks)
#pragma unroll
            for (int nb = 0; nb < 4; ++nb) { const bf16x8 bb = *(const LAS bf16x8*)(wb + cur * WBUF + (16 * nb + r) * WP + (32 * ks + 8 * q) * 2); acc[nb] = MFMA16(af[ks], bb, acc[nb]); }
        if (kc < 7) {
#pragma unroll
            for (int i = 0; i < 4; ++i) { const int c = tid + 512 * i; *(LAS u32x4*)(wb + (cur ^ 1) * WBUF + (c >> 5) * WP + (c & 31) * 16) = st[i]; }
        }
        __syncthreads();
    }
    LAS bf16_t* hl = (LAS bf16_t*)(lds + w * 2304);
#pragma unroll
    for (int nb = 0; nb < 4; ++nb) { const float bias = b1[16 * nb + r];
#pragma unroll
        for (int j = 0; j < 4; ++j) hl[(4 * q + j) * 72 + 16 * nb + r] = f2bf(siluf(acc[nb][j] + bias)); }
    LDS_FENCE();
    f32x4 o[4];
#pragma unroll
    for (int nb = 0; nb < 4; ++nb) o[nb] = (f32x4){0.f, 0.f, 0.f, 0.f};
#pragma unroll
    for (int ks = 0; ks < 2; ++ks) {
        const bf16x8 a = *(const LAS bf16x8*)(hl + r * 72 + 32 * ks + 8 * q);
#pragma unroll
        for (int nb = 0; nb < 4; ++nb) { const bf16x8 bb = *(const bf16x8*)(W2 + (size_t)(16 * nb + r) * 64 + 32 * ks + 8 * q); o[nb] = MFMA16(a, bb, o[nb]); }
    }
    LDS_FENCE();
    const float* kg = in->p[9] + l * 64;
    bf16_t* dst = (bf16_t*)(ws + WS_CMP + (s ? CMP_V : 0)) + (size_t)(b * 2 + hk) * 128 * 64;
#pragma unroll
    for (int j = 0; j < 4; ++j) {
        const int n = 16 * w + 4 * q + j; float ss = 0.f;
#pragma unroll
        for (int nb = 0; nb < 4; ++nb) ss += o[nb][j] * o[nb][j];
        ss += __shfl_xor(ss, 1); ss += __shfl_xor(ss, 2); ss += __shfl_xor(ss, 4); ss += __shfl_xor(ss, 8);
        const float sc = s == 0 ? rsqrtf(ss * (1.f / 64.f) + 1e-6f) : 1.f;
#pragma unroll
        for (int nb = 0; nb < 4; ++nb) { const int d = 16 * nb + r; const float v = o[nb][j] * sc * (s == 0 ? kg[d] : 1.f); dst[(size_t)n * 64 + d] = n < 127 ? f2bf(v) : (bf16_t)0; }
    }
}

__device__ __forceinline__ int swz_off(int row, int chunk) { return row * 128 + ((chunk ^ (row & 7)) << 4); }
__device__ __forceinline__ float log_sigmoid(float x) { return fminf(x, 0.f) - log1pf(__expf(-fabsf(x))); }
__device__ __forceinline__ void ml_delta_wave(int cu, int l, InPtr in, unsigned char* ws, LAS unsigned char* wl, int lane) {
    const int c = cu & 31, bh = cu >> 5, h = bh & 3, b = bh >> 2; const int t0 = c * 64; const size_t row0 = (size_t)b * 2048 + t0;
    const float* G = (const float*)(ws + WS_PRJ + PRJ_GATES);
    const float ip = G[(row0 + lane) * 32 + 18 + h] + in->p[12][l * 4 + h], fp = G[(row0 + lane) * 32 + 22 + h] + in->p[13][l * 4 + h];
    float bcum = log_sigmoid(fp);
#pragma unroll
    for (int o = 1; o < 64; o <<= 1) { const float t = __shfl_up(bcum, o); if (lane >= o) bcum += t; }
    const float bL = __shfl(bcum, 63); const float wgt = __expf(bL - bcum + ip);
    { float* mlg = (float*)(ws + WS_ML + ML_G) + ((size_t)bh * 2048 + t0 + lane) * 2; mlg[0] = bcum; mlg[1] = ip; if (lane == 0) ((float*)(ws + WS_ML + ML_BL))[cu] = bL; }
    const bf16_t* raw = (const bf16_t*)(ws + WS_PRJ + PRJ_RAWQK); const float* cw = in->p[11] + (size_t)l * 4 * 512;
    float wq[4], wk[4];
#pragma unroll
    for (int j = 0; j < 4; ++j) { wq[j] = cw[j * 512 + h * 64 + lane]; wk[j] = cw[j * 512 + 256 + h * 64 + lane]; }
    float q3 = 0.f, q2 = 0.f, q1 = 0.f, k3 = 0.f, k2 = 0.f, k1 = 0.f;
    if (c > 0) { const bf16_t* p = raw + (row0 - 3) * 512 + h * 64 + lane; q3 = bf2f(p[0]); q2 = bf2f(p[512]); q1 = bf2f(p[1024]); k3 = bf2f(p[256]); k2 = bf2f(p[512 + 256]); k1 = bf2f(p[1024 + 256]); }
    bf16_t* QC = (bf16_t*)(ws + WS_ML) + ((size_t)bh * 2048 + t0) * 64 + lane; bf16_t* KC = (bf16_t*)(ws + WS_ML + ML_KC) + ((size_t)bh * 2048 + t0) * 64 + lane;
    const bf16_t* V = (const bf16_t*)(ws + WS_PRJ + PRJ_VML) + ((size_t)bh * 2048 + t0) * 64 + lane;
    float dn = 0.f;
    const bf16_t* rq = raw + row0 * 512 + h * 64 + lane;
    bf16_t cq[8], ck[8], cv[8], nq[8], nk[8], nv[8];
#pragma unroll
    for (int j = 0; j < 8; ++j) { cq[j] = rq[(size_t)j * 512]; ck[j] = rq[(size_t)j * 512 + 256]; cv[j] = V[(size_t)j * 64]; }
#pragma unroll 1
    for (int s8 = 0; s8 < 8; ++s8) {
        if (s8 < 7) {
#pragma unroll
            for (int j = 0; j < 8; ++j) { const int s = s8 * 8 + 8 + j; nq[j] = rq[(size_t)s * 512]; nk[j] = rq[(size_t)s * 512 + 256]; nv[j] = V[(size_t)s * 64]; }
        }
        float kb[8], vb[8]; bf16_t qo[8], ko[8];
#pragma unroll
        for (int j = 0; j < 8; ++j) {
            const int s = s8 * 8 + j;
            const float q0 = bf2f(cq[j]), k0 = bf2f(ck[j]);
            const float qv = siluf(wq[0] * q3 + wq[1] * q2 + wq[2] * q1 + wq[3] * q0), kv = siluf(wk[0] * k3 + wk[1] * k2 + wk[2] * k1 + wk[3] * k0) * 0.125f;
            q3 = q2; q2 = q1; q1 = q0; k3 = k2; k2 = k1; k1 = k0;
            qo[j] = f2bf(qv); ko[j] = f2bf(kv);
            const float ws_ = __builtin_bit_cast(float, __builtin_amdgcn_readlane(__builtin_bit_cast(int, wgt), s)); kb[j] = bf2f(ko[j]); dn += ws_ * kb[j]; vb[j] = ws_ * bf2f(cv[j]);
        }
#pragma unroll
        for (int j = 0; j < 8; ++j) { QC[(size_t)(s8 * 8 + j) * 64] = qo[j]; KC[(size_t)(s8 * 8 + j) * 64] = ko[j]; }
        u32x4 pk; pk.x = pk_bf16(kb[0], kb[1]); pk.y = pk_bf16(kb[2], kb[3]); pk.z = pk_bf16(kb[4], kb[5]); pk.w = pk_bf16(kb[6], kb[7]);
        *(LAS u32x4*)(wl + swz_off(lane, s8)) = pk;
        pk.x = pk_bf16(vb[0], vb[1]); pk.y = pk_bf16(vb[2], vb[3]); pk.z = pk_bf16(vb[4], vb[5]); pk.w = pk_bf16(vb[6], vb[7]);
        *(LAS u32x4*)(wl + 8192 + swz_off(lane, s8)) = pk;
#pragma unroll
        for (int j = 0; j < 8; ++j) { cq[j] = nq[j]; ck[j] = nk[j]; cv[j] = nv[j]; }
    }
    ((float*)(ws + WS_ML + ML_DN))[(size_t)cu * 64 + lane] = dn;
    LDS_FENCE();
    const int r = lane & 15, q = lane >> 4;
    bf16_t* DL = (bf16_t*)(ws + WS_ML + ML_DELTA) + (size_t)cu * 4096;
#pragma unroll
    for (int mb = 0; mb < 4; ++mb) {
        f32x4 acc[4];
#pragma unroll
        for (int nb = 0; nb < 4; ++nb) acc[nb] = (f32x4){0.f, 0.f, 0.f, 0.f};
#pragma unroll
        for (int ks = 0; ks < 2; ++ks) {
            const bf16x8 a = *(const LAS bf16x8*)(wl + 8192 + swz_off(16 * mb + r, 4 * ks + q));
#pragma unroll
            for (int nb = 0; nb < 4; ++nb) { const bf16x8 bb = *(const LAS bf16x8*)(wl + swz_off(16 * nb + r, 4 * ks + q)); acc[nb] = MFMA16(a, bb, acc[nb]); }
        }
#pragma unroll
        for (int nb = 0; nb < 4; ++nb)
#pragma unroll
            for (int j = 0; j < 4; ++j) DL[(16 * mb + 4 * q + j) * 64 + 16 * nb + r] = f2bf(acc[nb][j]);
    }
    LDS_FENCE();
}

#ifndef TIME_PH
#define TIME_PH -1
#endif
#define PSTAMP(i, blk) do { if (TIME_PH != -1 && l == 0 && blockIdx.x == (blk) && threadIdx.x == 0) ((unsigned long long*)((unsigned*)(ws + WS_CTL) + CW_TS))[i] = __builtin_amdgcn_s_memrealtime(); } while (0)
__device__ __forceinline__ void phase_prep(int l, InPtr in, unsigned char* ws, LAS unsigned char* lds, int bid, int nb) {
    asm volatile("" : "+s"(bid));
    PSTAMP(40, 0);
#ifndef NO_UQ
    { g8::DenseSched S{(const char*)(ws + WS_PRJ + PRJ_DQKV), (const char*)(ws + WS_WUQ) + (size_t)l * 768 * 256 * 2, 384, 256, 64, 3, nb, bid};
      EpiUq E{(const float*)(ws + WS_SSQ + PT_DQ) + (size_t)l * 16384 * 4, in->p[19] + l * 192, (const float*)(ws + WS_ROPE), (bf16_t*)(ws + WS_MLA)};
      g8::gemm_run(lds, 256, 256, S, E); }
#endif
    PSTAMP(41, 0);
#ifndef NO_UKV
    asm volatile("" : "+s"(bid));
    { g8::DenseSched S{(const char*)(ws + WS_PRJ + PRJ_DQKV) + 256, (const char*)(ws + WS_WUKV) + (size_t)l * 768 * 256 * 2, 384, 256, 64, 3, nb, bid};
      EpiUkv E{(const float*)(ws + WS_SSQ + PT_DKV) + (size_t)l * 16384 * 2, in->p[19] + l * 192, (const bf16_t*)(ws + WS_PRJ + PRJ_KR), (bf16_t*)(ws + WS_MLA + MLA_KM), (bf16_t*)(ws + WS_MLA + MLA_VM)};
      g8::gemm_run(lds, 256, 256, S, E); }
#endif
    PSTAMP(42, 0); PSTAMP(44, 255);
    __syncthreads();
#ifndef NO_CMP
    for (int u = nb - 1 - bid; u < 32; u += nb) cmp_unit(u, l, in, ws, lds);
#endif
    PSTAMP(45, 255);
    __syncthreads();
#ifndef NO_DELTA
    { int tid_ = threadIdx.x; asm volatile("" : "+v"(tid_));
      for (int g = bid; g < 128; g += nb) ml_delta_wave(g * 8 + (tid_ >> 6), l, in, ws, lds + (tid_ >> 6) * 16384, tid_ & 63); }
#endif
    __syncthreads(); PSTAMP(43, 0);
}
#define CHK_TOL(st) (((st) & 15) == 8 ? 1e-2f : 1e-3f)
#define CHECK_REST
constexpr int VTP = 192;
typedef short v4i16_t __attribute__((ext_vector_type(4)));
__device__ __forceinline__ int vt_lane_off(int lane) { return (4 * (lane >> 5) + ((lane & 15) >> 2)) * VTP + ((((lane >> 4) & 1) * 16) + 4 * (lane & 3)) * 2; }
__device__ __forceinline__ bf16x8 vt_frag(const LAS unsigned char* Vt, int voff, int s4, int eb) {
    const LAS unsigned char* a = Vt + voff + 16 * s4 * VTP + 64 * eb;
    const v4i16_t lo = __builtin_amdgcn_ds_read_tr16_b64_v4i16((LAS v4i16_t*)a), hi = __builtin_amdgcn_ds_read_tr16_b64_v4i16((LAS v4i16_t*)(a + 8 * VTP));
    return (bf16x8){lo[0], lo[1], lo[2], lo[3], hi[0], hi[1], hi[2], hi[3]};
}
__device__ __forceinline__ int crow(int reg, int h) { return (reg & 3) + 8 * (reg >> 2) + 4 * h; }
struct AttnState { f32x16 o[2]; float m, l; };
__device__ __forceinline__ void attn_reset(AttnState& A) { A.m = -1e30f; A.l = 0.f;
#pragma unroll
    for (int i = 0; i < 16; ++i) { A.o[0][i] = 0.f; A.o[1][i] = 0.f; } }

template <int DK>
__device__ __forceinline__ void attn_scores(f32x16 (&s)[2], const bf16x8 (&qf)[DK / 16], const LAS unsigned char* Kt, int r, int h) {
    constexpr int KP = 2 * DK + 16;
#pragma unroll
    for (int kb = 0; kb < 2; ++kb) {
#pragma unroll
        for (int i = 0; i < 16; ++i) s[kb][i] = 0.f;
#pragma unroll
        for (int ks = 0; ks < DK / 16; ++ks) { const bf16x8 kf = *(const LAS bf16x8*)(Kt + (32 * kb + r) * KP + (16 * ks + 8 * h) * 2); s[kb] = MFMA32(kf, qf[ks], s[kb]); }
    }
}
__device__ __forceinline__ float max3f(float a, float b, float c) { return fmaxf(fmaxf(a, b), c); }
__device__ __forceinline__ void attn_softmax_pv(AttnState& A, f32x16 (&s)[2], const LAS unsigned char* Vt, int r, int h, float bias_c = 0.f, bool lane_ok = true) {
    constexpr float THR = 8.f; const int voff = vt_lane_off(r + 32 * h);
    float mx = max3f(s[0][0], s[0][1], s[0][2]);
#pragma unroll
    for (int i = 3; i < 15; i += 2) mx = max3f(mx, s[0][i], s[0][i + 1]);
    mx = max3f(mx, s[0][15], s[1][0]);
#pragma unroll
    for (int i = 1; i < 15; i += 2) mx = max3f(mx, s[1][i], s[1][i + 1]);
    mx = fmaxf(mx, s[1][15]);
    mx = fmaxf(mx, __shfl_xor(mx, 32));
    const float mxb = (lane_ok && mx > -1e29f) ? mx + bias_c : -1e30f;
    const bool grow = mxb > A.m + THR;
    const float mnew = grow ? mxb : A.m;
    if (__any(grow)) {
        const float alpha = __builtin_amdgcn_exp2f(A.m - mnew);
        A.l *= alpha;
#pragma unroll
        for (int i = 0; i < 16; ++i) { A.o[0][i] *= alpha; A.o[1][i] *= alpha; }
    }
    A.m = mnew;
    const float sub = (lane_ok && mnew > -1e29f) ? mnew - bias_c : 1e30f;
    float rs = 0.f;
#pragma unroll
    for (int kb = 0; kb < 2; ++kb)
#pragma unroll
        for (int i = 0; i < 16; ++i) { const float p = __builtin_amdgcn_exp2f(s[kb][i] - sub); s[kb][i] = p; rs += p; }
    rs += __shfl_xor(rs, 32);
    A.l += rs;
#pragma unroll
    for (int s4 = 0; s4 < 4; ++s4) {
        const int kb = s4 >> 1, hf = (s4 & 1) * 8;
        u32x4 pw; pw.x = pk_bf16(s[kb][hf + 0], s[kb][hf + 1]); pw.y = pk_bf16(s[kb][hf + 2], s[kb][hf + 3]); pw.z = pk_bf16(s[kb][hf + 4], s[kb][hf + 5]); pw.w = pk_bf16(s[kb][hf + 6], s[kb][hf + 7]);
        const bf16x8 pf = __builtin_bit_cast(bf16x8, pw);
#pragma unroll
        for (int eb = 0; eb < 2; ++eb) A.o[eb] = MFMA32(vt_frag(Vt, voff, s4, eb), pf, A.o[eb]);
    }
}
template <int DK>
__device__ __forceinline__ void stage_k_load(u32x4 (&kr)[2], const bf16_t* Kg  , int tid) {
    constexpr int CH = DK / 8;
    kr[0] = *(const u32x4*)(Kg + (size_t)(tid / CH) * DK + (tid % CH) * 8);
    if (64 * CH > 512) { const int c2 = tid + 512; if (c2 < 64 * CH) kr[1] = *(const u32x4*)(Kg + (size_t)(c2 / CH) * DK + (c2 % CH) * 8); }
}
template <int DK>
__device__ __forceinline__ void stage_k_store(const u32x4 (&kr)[2], LAS unsigned char* Kt, int tid) {
    constexpr int CH = DK / 8, KP = 2 * DK + 16;
    *(LAS u32x4*)(Kt + (tid / CH) * KP + (tid % CH) * 16) = kr[0];
    if (64 * CH > 512) { const int c2 = tid + 512; if (c2 < 64 * CH) *(LAS u32x4*)(Kt + (c2 / CH) * KP + (c2 % CH) * 16) = kr[1]; }
}
__device__ __forceinline__ u32x4 stage_v_load(const bf16_t* Vg, int tid) { return *(const u32x4*)(Vg + (size_t)(tid >> 3) * 64 + (tid & 7) * 8); }
__device__ __forceinline__ void stage_v_store(const u32x4& v, LAS unsigned char* Vt, int tid) { *(LAS u32x4*)(Vt + (tid >> 3) * VTP + (tid & 7) * 16) = v; }

constexpr int MLA_KT = 0, MLA_VT = 2 * 64 * 208, MLA_LDS = MLA_VT + 2 * 64 * VTP;
__device__ __forceinline__ void mla_unit(int b, int hd, int qt, int l, unsigned char* ws, LAS unsigned char* lds) {
    int tid_ = threadIdx.x; asm volatile("" : "+v"(tid_));
    const int tid = tid_, w = tid >> 6, lane = tid & 63, r = lane & 31, h = lane >> 5;
    const size_t slab = (size_t)(b * 6 + hd) * 2048;
    const bf16_t* QM = (const bf16_t*)(ws + WS_MLA) + slab * 96; const bf16_t* KM = (const bf16_t*)(ws + WS_MLA + MLA_KM) + slab * 96; const bf16_t* VM = (const bf16_t*)(ws + WS_MLA + MLA_VM) + slab * 64;
    const int q0 = 256 * qt + 32 * w, q = q0 + r;
    bf16x8 qf[6];
#pragma unroll
    for (int ks = 0; ks < 6; ++ks) qf[ks] = *(const bf16x8*)(QM + (size_t)q * 96 + 16 * ks + 8 * h);
    AttnState A; attn_reset(A);
    const int ntile = 4 * qt + 4;
    u32x4 kr[2], vr, kr2[2], vr2;
    stage_k_load<96>(kr, KM, tid); vr = stage_v_load(VM, tid);
    stage_k_store<96>(kr, lds + MLA_KT, tid); stage_v_store(vr, lds + MLA_VT, tid);
    if (ntile > 1) { stage_k_load<96>(kr, KM + (size_t)64 * 96, tid); vr = stage_v_load(VM + (size_t)64 * 64, tid); }
    __syncthreads();
    for (int j = 0; j < ntile; ++j) {
        const int cur = j & 1;
        if (j + 2 < ntile) { stage_k_load<96>(kr2, KM + (size_t)(j + 2) * 64 * 96, tid); vr2 = stage_v_load(VM + (size_t)(j + 2) * 64 * 64, tid); }
        if (64 * j <= q0 + 31) {
            f32x16 s[2];
            attn_scores<96>(s, qf, lds + MLA_KT + cur * 64 * 208, r, h);
            if (64 * j + 63 > q0) {
#pragma unroll
                for (int kb = 0; kb < 2; ++kb)
#pragma unroll
                    for (int i = 0; i < 16; ++i) { const int key = 64 * j + 32 * kb + crow(i, h); if (key > q) s[kb][i] = -1e30f; }
            }
            attn_softmax_pv(A, s, lds + MLA_VT + cur * 64 * VTP, r, h);
        }
        if (j + 1 < ntile) { stage_k_store<96>(kr, lds + MLA_KT + (cur ^ 1) * 64 * 208, tid); stage_v_store(vr, lds + MLA_VT + (cur ^ 1) * 64 * VTP, tid); }
        kr[0] = kr2[0]; kr[1] = kr2[1]; vr = vr2;
        __syncthreads();
    }
    const float inv = A.l > 0.f ? 1.f / A.l : 0.f; float ss = 0.f;
    bf16_t* Y = (bf16_t*)(ws + WS_Y) + ((size_t)b * 2048 + q) * 1024 + 640 + hd * 64;
#pragma unroll
    for (int eb = 0; eb < 2; ++eb)
#pragma unroll
        for (int g4 = 0; g4 < 4; ++g4) {
            const float v0 = A.o[eb][4 * g4] * inv, v1 = A.o[eb][4 * g4 + 1] * inv, v2 = A.o[eb][4 * g4 + 2] * inv, v3 = A.o[eb][4 * g4 + 3] * inv;
            u32x2 pw; pw.x = pk_bf16(v0, v1); pw.y = pk_bf16(v2, v3);
            const float f0 = bf_lo(pw.x), f1 = bf_hi(pw.x), f2 = bf_lo(pw.y), f3 = bf_hi(pw.y); ss += (f0 * f0 + f1 * f1) + (f2 * f2 + f3 * f3);
            *(u32x2*)(Y + 32 * eb + 8 * g4 + 4 * h) = pw;
        }
    ss += __shfl_xor(ss, 32);
    if (h == 0) ((float*)(ws + WS_SSQ + PT_C))[((size_t)l * 16384 + (size_t)b * 2048 + q) * 8 + hd] = ss;
}

__device__ __forceinline__ void nsa_mask_bias(f32x16 (&sc)[2], int dq, int h, const LAS float* bl, bool sel, int lim) {
    int dd = dq - 4 * h - 63; asm volatile("" : "+v"(dd));
    const LAS float* bp = bl + dd;
#pragma unroll
    for (int kb = 0; kb < 2; ++kb)
#pragma unroll
        for (int k = 0; k < 16; ++k) { const int c = 63 - (32 * kb + (k & 3) + 8 * (k >> 2)); const int d = dd + c; sc[kb][k] = (sel && d >= 0 && d < lim) ? sc[kb][k] + bp[c] : -1e30f; }
}

constexpr int NSA_KT = 0, NSA_VT = 2 * 64 * 144, NSA_BIAS = NSA_VT + 2 * 64 * VTP, NSA_PS = NSA_BIAS + 3 * 2048 * 4, NSA_SEL = NSA_PS + 3 * 64 * 32 * 4, NSA_UNI = NSA_SEL + 256, NSA_OT = NSA_UNI + 256, NSA_LDS = NSA_OT + 6 * 8192;
__device__ __forceinline__ void nsa_unit(int b, int hk, int i, int l, InPtr in, unsigned char* ws, LAS unsigned char* lds) {
    int tid_ = threadIdx.x; asm volatile("" : "+v"(tid_));
    const int tid = tid_, w = tid >> 6, lane = tid & 63, r = lane & 31, h = lane >> 5;
    const bool active = w < 6; const int g = active ? (w >> 1) : 0, th = w & 1, head = hk * 3 + g;
    const int t = 64 * i + 32 * th + r, tl = 32 * th + r; const size_t row = (size_t)b * 2048 + t;
    const size_t kvslab = (size_t)(b * 2 + hk) * 2048 * 64;
    LAS float* biasl = (LAS float*)(lds + NSA_BIAS); LAS float* PS = (LAS float*)(lds + NSA_PS); LAS unsigned* SEL = (LAS unsigned*)(lds + NSA_SEL); LAS unsigned* UNI = (LAS unsigned*)(lds + NSA_UNI);
    { const float* bd = (const float*)(ws + WS_BIASD) + (size_t)hk * 3 * 2048;
#pragma unroll
      for (int k = 0; k < 12; ++k) biasl[tid + 512 * k] = bd[tid + 512 * k];
#pragma unroll
      for (int k = 0; k < 12; ++k) PS[tid + 512 * k] = 0.f;
      if (tid < 4) UNI[tid] = 0u; }
    bf16x8 qf[4];
    { const bf16_t* QN = (const bf16_t*)(ws + WS_PRJ + PRJ_QN) + ((size_t)(b * 6 + head) * 2048 + t) * 64;
#pragma unroll
      for (int ks = 0; ks < 4; ++ks) qf[ks] = *(const bf16x8*)(QN + 16 * ks + 8 * h); }
#define NSA_GATE(k) ({ int t_ = t; asm volatile("" : "+v"(t_)); sigmf(((const float*)(ws + WS_PRJ + PRJ_GATES))[((size_t)b * 2048 + t_) * 32 + head * 3 + (k)]); })
    LAS float* bl = biasl + g * 2048;
    LAS float* otl = (LAS float*)(lds + NSA_OT + (active ? w : 0) * 8192) + lane;
    u32x4 kr[2], vr;
    const int ntc = i >= 16 ? 2 : 1;
    { const bf16_t* KC = (const bf16_t*)(ws + WS_CMP) + (size_t)(b * 2 + hk) * 128 * 64; const bf16_t* VC = (const bf16_t*)(ws + WS_CMP + CMP_V) + (size_t)(b * 2 + hk) * 128 * 64;
      for (int T = 0; T < ntc; ++T) { stage_k_load<64>(kr, KC + T * 4096, tid); vr = stage_v_load(VC + T * 4096, tid); stage_k_store<64>(kr, lds + NSA_KT + T * 64 * 144, tid); stage_v_store(vr, lds + NSA_VT + T * 64 * VTP, tid); } }
    __syncthreads();
    {
        f32x16 ot[2];
        if (active) {
            float m = -1e30f, lsum = 0.f;
            for (int T = 0; T < ntc; ++T) {
                f32x16 sc[2]; attn_scores<64>(sc, qf, lds + NSA_KT + T * 64 * 144, r, h);
                float mx = -1e30f;
#pragma unroll
                for (int kb = 0; kb < 2; ++kb)
#pragma unroll
                    for (int k = 0; k < 16; ++k) { const int n = 64 * T + 32 * kb + crow(k, h); const int d = t - 16 * n - 31; const float x = (d >= 0 && n < 127) ? sc[kb][k] + bl[d] : -1e30f; sc[kb][k] = x; mx = fmaxf(mx, x); }
                mx = fmaxf(mx, __shfl_xor(mx, 32));
                const float mnew = fmaxf(m, mx), mref = mnew <= -1e29f ? 0.f : mnew; float rs = 0.f;
#pragma unroll
                for (int kb = 0; kb < 2; ++kb)
#pragma unroll
                    for (int k = 0; k < 16; ++k) rs += __builtin_amdgcn_exp2f(sc[kb][k] - mref);
                rs += __shfl_xor(rs, 32);
                lsum = lsum * __builtin_amdgcn_exp2f(m - mref) + rs; m = mnew;
            }
            const float mref = m <= -1e29f ? 0.f : m, inv = lsum > 0.f ? 1.f / lsum : 0.f;
#pragma unroll
            for (int k = 0; k < 16; ++k) { ot[0][k] = 0.f; ot[1][k] = 0.f; }
            float carry = 0.f;
            for (int T = 0; T < ntc; ++T) {
                f32x16 sc[2]; attn_scores<64>(sc, qf, lds + NSA_KT + T * 64 * 144, r, h);
#pragma unroll
                for (int kb = 0; kb < 2; ++kb)
#pragma unroll
                    for (int k = 0; k < 16; ++k) { const int n = 64 * T + 32 * kb + crow(k, h); const int d = t - 16 * n - 31; sc[kb][k] = (d >= 0 && n < 127) ? __builtin_amdgcn_exp2f(sc[kb][k] + bl[d] - mref) * inv : 0.f; }
                float prevL = carry;
#pragma unroll
                for (int kb = 0; kb < 2; ++kb)
#pragma unroll
                    for (int g4 = 0; g4 < 4; ++g4) {
                        const float G4 = (sc[kb][4 * g4] + sc[kb][4 * g4 + 1]) + (sc[kb][4 * g4 + 2] + sc[kb][4 * g4 + 3]); const float L = sc[kb][4 * g4 + 3];
                        const float Lo = __shfl_xor(L, 32);
                        const float add = h ? Lo : prevL;
                        prevL = Lo;
                        const int idx = T * 8 + kb * 4 + g4;
                        PS[g * 2048 + tl * 32 + 2 * idx + h] = G4 + add;
                    }
                carry = prevL;
#pragma unroll
                for (int s4 = 0; s4 < 4; ++s4) {
                    const int kb = s4 >> 1, hf = (s4 & 1) * 8;
                    u32x4 pw; pw.x = pk_bf16(sc[kb][hf + 0], sc[kb][hf + 1]); pw.y = pk_bf16(sc[kb][hf + 2], sc[kb][hf + 3]); pw.z = pk_bf16(sc[kb][hf + 4], sc[kb][hf + 5]); pw.w = pk_bf16(sc[kb][hf + 6], sc[kb][hf + 7]);
                    const bf16x8 pf = __builtin_bit_cast(bf16x8, pw);
#pragma unroll
                    for (int eb = 0; eb < 2; ++eb) ot[eb] = MFMA32(vt_frag(lds + NSA_VT + T * 64 * VTP, vt_lane_off(lane), s4, eb), pf, ot[eb]);
                }
            }
            { const float gc = NSA_GATE(0);
#pragma unroll
            for (int k = 0; k < 16; ++k) { otl[64 * k] = ot[0][k] * gc; otl[64 * (16 + k)] = ot[1][k] * gc; } }
        }
    }
    __syncthreads();
#ifndef NO_NSA_SEL
    {
        const int tk = tid >> 3, sg = tid & 7; float v[32];
#pragma unroll
        for (int k = 0; k < 8; ++k) { const f32x4 x0 = *(const LAS f32x4*)(PS + tk * 32 + 4 * k), x1 = *(const LAS f32x4*)(PS + 2048 + tk * 32 + 4 * k), x2 = *(const LAS f32x4*)(PS + 4096 + tk * 32 + 4 * k);
            v[4 * k] = (x0.x + x1.x) + x2.x; v[4 * k + 1] = (x0.y + x1.y) + x2.y; v[4 * k + 2] = (x0.z + x1.z) + x2.z; v[4 * k + 3] = (x0.w + x1.w) + x2.w; }
#pragma unroll
        for (int s = 0; s < 32; ++s) { const bool forced = (s == 0) || (s == i) || (s == i - 1); float x = forced ? v[s] + 1e4f : v[s]; v[s] = s > i ? -1.f : x; }
        unsigned bits = 0u;
#pragma unroll
        for (int k = 0; k < 4; ++k) {
            float x = 0.f;
#pragma unroll
            for (int s = 0; s < 32; ++s) x = (s == 4 * sg + k) ? v[s] : x;
            int rank = 0;
#pragma unroll
            for (int s = 0; s < 32; ++s) rank += (v[s] > x || (v[s] == x && s < 4 * sg + k)) ? 1 : 0;
            if (rank < 16 && x >= 0.f) bits |= 1u << (4 * sg + k);
        }
        bits |= __shfl_xor(bits, 1); bits |= __shfl_xor(bits, 2); bits |= __shfl_xor(bits, 4);
        if (sg == 0) { SEL[tk] = bits; __hip_atomic_fetch_or(UNI, bits, __ATOMIC_RELAXED, __HIP_MEMORY_SCOPE_WORKGROUP); __hip_atomic_fetch_or(UNI + 1 + (tk >> 5), bits, __ATOMIC_RELAXED, __HIP_MEMORY_SCOPE_WORKGROUP); }
    }
#endif
    __syncthreads();
    const unsigned selbits = SEL[tl], uni = UNI[0], unih = UNI[1 + th];
    const float c31 = bl[2047];
#ifndef NO_NSA_SLC
    {
        AttnState A; attn_reset(A);
        const bf16_t* KS = (const bf16_t*)(ws + WS_PRJ + PRJ_KN1) + kvslab; const bf16_t* VS = (const bf16_t*)(ws + WS_PRJ + PRJ_VN1) + kvslab;
        unsigned todo = uni; int cur = 0; u32x4 kr2[2], vr2;
        int s = __ffs(todo) - 1; todo &= todo - 1;
        stage_k_load<64>(kr, KS + (size_t)s * 4096, tid); vr = stage_v_load(VS + (size_t)s * 4096, tid);
        stage_k_store<64>(kr, lds + NSA_KT, tid); stage_v_store(vr, lds + NSA_VT, tid);
        int sn = todo ? __ffs(todo) - 1 : -1; todo &= todo - 1;
        if (sn >= 0) { stage_k_load<64>(kr, KS + (size_t)sn * 4096, tid); vr = stage_v_load(VS + (size_t)sn * 4096, tid); }
        __syncthreads();
        while (s >= 0) {
            const int sn2 = todo ? __ffs(todo) - 1 : -1; todo &= todo - 1;
            if (sn2 >= 0) { stage_k_load<64>(kr2, KS + (size_t)sn2 * 4096, tid); vr2 = stage_v_load(VS + (size_t)sn2 * 4096, tid); }
            if (active && ((unih >> s) & 1u)) {
                f32x16 sc[2];
                attn_scores<64>(sc, qf, lds + NSA_KT + cur * 64 * 144, r, h);
                const bool sel = (selbits >> s) & 1u;
                if (i - s >= 3) attn_softmax_pv(A, sc, lds + NSA_VT + cur * 64 * VTP, r, h, c31, sel);
                else { nsa_mask_bias(sc, t - 64 * s, h, bl, sel, 4096); attn_softmax_pv(A, sc, lds + NSA_VT + cur * 64 * VTP, r, h); }
            }
            if (sn >= 0) { stage_k_store<64>(kr, lds + NSA_KT + (cur ^ 1) * 64 * 144, tid); stage_v_store(vr, lds + NSA_VT + (cur ^ 1) * 64 * VTP, tid); }
            kr[0] = kr2[0]; vr = vr2;
            __syncthreads();
            s = sn; sn = sn2; cur ^= 1;
        }
        if (active) { const float gs = NSA_GATE(1); const float inv = A.l > 0.f ? gs / A.l : 0.f;
#pragma unroll
            for (int k = 0; k < 16; ++k) { otl[64 * k] += A.o[0][k] * inv; otl[64 * (16 + k)] += A.o[1][k] * inv; } }
    }
#endif
#ifndef NO_NSA_WIN
    {
        AttnState A; attn_reset(A);
        const bf16_t* KW = (const bf16_t*)(ws + WS_PRJ + PRJ_KN2) + kvslab; const bf16_t* VW = (const bf16_t*)(ws + WS_PRJ + PRJ_VN2) + kvslab;
        const int j0 = i > 8 ? i - 8 : 0; int cur = 0; u32x4 kr2[2], vr2;
        stage_k_load<64>(kr, KW + (size_t)j0 * 4096, tid); vr = stage_v_load(VW + (size_t)j0 * 4096, tid);
        stage_k_store<64>(kr, lds + NSA_KT, tid); stage_v_store(vr, lds + NSA_VT, tid);
        if (j0 < i) { stage_k_load<64>(kr, KW + (size_t)(j0 + 1) * 4096, tid); vr = stage_v_load(VW + (size_t)(j0 + 1) * 4096, tid); }
        __syncthreads();
        for (int j = j0; j <= i; ++j) {
            if (j + 2 <= i) { stage_k_load<64>(kr2, KW + (size_t)(j + 2) * 4096, tid); vr2 = stage_v_load(VW + (size_t)(j + 2) * 4096, tid); }
            if (active) {
                f32x16 sc[2];
                attn_scores<64>(sc, qf, lds + NSA_KT + cur * 64 * 144, r, h);
                if (i - j >= 3 && j > i - 8) attn_softmax_pv(A, sc, lds + NSA_VT + cur * 64 * VTP, r, h, c31, true);
                else { nsa_mask_bias(sc, t - 64 * j, h, bl, true, 512); attn_softmax_pv(A, sc, lds + NSA_VT + cur * 64 * VTP, r, h); }
            }
            if (j < i) { stage_k_store<64>(kr, lds + NSA_KT + (cur ^ 1) * 64 * 144, tid); stage_v_store(vr, lds + NSA_VT + (cur ^ 1) * 64 * VTP, tid); }
            kr[0] = kr2[0]; vr = vr2;
            __syncthreads();
            cur ^= 1;
        }
        if (active) { const float gw = NSA_GATE(2); const float inv = A.l > 0.f ? gw / A.l : 0.f;
            float ss = 0.f; bf16_t* Y = (bf16_t*)(ws + WS_Y) + row * 1024 + head * 64;
#pragma unroll
            for (int eb = 0; eb < 2; ++eb)
#pragma unroll
                for (int g4 = 0; g4 < 4; ++g4) {
                    const float v0 = otl[64 * (16 * eb + 4 * g4)] + A.o[eb][4 * g4] * inv, v1 = otl[64 * (16 * eb + 4 * g4 + 1)] + A.o[eb][4 * g4 + 1] * inv;
                    const float v2 = otl[64 * (16 * eb + 4 * g4 + 2)] + A.o[eb][4 * g4 + 2] * inv, v3 = otl[64 * (16 * eb + 4 * g4 + 3)] + A.o[eb][4 * g4 + 3] * inv;
                    u32x2 pw; pw.x = pk_bf16(v0, v1); pw.y = pk_bf16(v2, v3);
                    const float f0 = bf_lo(pw.x), f1 = bf_hi(pw.x), f2 = bf_lo(pw.y), f3 = bf_hi(pw.y); ss += (f0 * f0 + f1 * f1) + (f2 * f2 + f3 * f3);
                    *(u32x2*)(Y + 32 * eb + 8 * g4 + 4 * h) = pw;
                }
            ss += __shfl_xor(ss, 32);
            if (h == 0) ((float*)(ws + WS_SSQ + PT_A))[((size_t)l * 16384 + row) * 8 + head] = ss;
        }
    }
#endif
}

__device__ __forceinline__ void ml_out_wave(int cu, int l, InPtr in, unsigned char* ws, LAS unsigned char* wl, LAS unsigned char* npl, int lane) {
    const int c = cu & 31, bh = cu >> 5, hd = bh & 3, b = bh >> 2; const int t0 = c * 64; const int r = lane & 15, q = lane >> 4;
    const bf16_t* QC = (const bf16_t*)(ws + WS_ML) + ((size_t)bh * 2048 + t0) * 64; const bf16_t* KC = (const bf16_t*)(ws + WS_ML + ML_KC) + ((size_t)bh * 2048 + t0) * 64;
    const bf16_t* V = (const bf16_t*)(ws + WS_PRJ + PRJ_VML) + ((size_t)bh * 2048 + t0) * 64;
    const float* mlg = (const float*)(ws + WS_ML + ML_G) + ((size_t)bh * 2048 + t0) * 2;
    const bf16_t* CP = (const bf16_t*)(ws + WS_ML + ML_CP) + (size_t)cu * 4096; const bf16_t* NP = (const bf16_t*)(ws + WS_ML + ML_NP) + (size_t)cu * 64;
    bf16x8 aq[4][2];
#pragma unroll
    for (int mb = 0; mb < 4; ++mb)
#pragma unroll
        for (int ks = 0; ks < 2; ++ks) aq[mb][ks] = *(const bf16x8*)(QC + (size_t)(16 * mb + r) * 64 + 32 * ks + 8 * q);
    float bj[4][4], den[4][4];
#pragma unroll
    for (int mb = 0; mb < 4; ++mb)
#pragma unroll
        for (int j = 0; j < 4; ++j) bj[mb][j] = mlg[(16 * mb + 4 * q + j) * 2];
    {
        float cs[4];
#pragma unroll
        for (int nb = 0; nb < 4; ++nb) { const float2 gg = *(const float2*)(mlg + (16 * nb + r) * 2); cs[nb] = gg.y - gg.x; }
#pragma unroll
        for (int mb = 0; mb < 4; ++mb) {
            f32x4 accS[4];
#pragma unroll
            for (int nb = 0; nb < 4; ++nb) { accS[nb] = (f32x4){0.f, 0.f, 0.f, 0.f};
#pragma unroll
                for (int ks = 0; ks < 2; ++ks) { const bf16x8 bk = *(const bf16x8*)(KC + (size_t)(16 * nb + r) * 64 + 32 * ks + 8 * q); accS[nb] = MFMA16(aq[mb][ks], bk, accS[nb]); } }
#pragma unroll
            for (int j = 0; j < 4; ++j) {
                const int jj = 16 * mb + 4 * q + j; float rs = 0.f;
#pragma unroll
                for (int nb = 0; nb < 4; ++nb) { const int s = 16 * nb + r; const float p = s <= jj ? accS[nb][j] * __expf(bj[mb][j] + cs[nb]) : 0.f; rs += p;
                    *(LAS bf16_t*)(wl + 8192 + swz_off(jj, s >> 3) + (s & 7) * 2) = f2bf(p); }
                rs += __shfl_xor(rs, 1); rs += __shfl_xor(rs, 2); rs += __shfl_xor(rs, 4); rs += __shfl_xor(rs, 8);
                den[mb][j] = rs;
            }
        }
    }
#pragma unroll
    for (int mb = 0; mb < 4; ++mb) { const float e = __expf(mlg[(16 * mb + r) * 2]);
#pragma unroll
        for (int ks = 0; ks < 2; ++ks) { const u32x4 x = __builtin_bit_cast(u32x4, aq[mb][ks]); u32x4 y;
            y.x = pk_bf16(bf_lo(x.x) * e, bf_hi(x.x) * e); y.y = pk_bf16(bf_lo(x.y) * e, bf_hi(x.y) * e); y.z = pk_bf16(bf_lo(x.z) * e, bf_hi(x.z) * e); y.w = pk_bf16(bf_lo(x.w) * e, bf_hi(x.w) * e);
            aq[mb][ks] = __builtin_bit_cast(bf16x8, y); } }
    f32x4 acc[4][4], accn[4];
#pragma unroll
    for (int mb = 0; mb < 4; ++mb) { accn[mb] = (f32x4){0.f, 0.f, 0.f, 0.f};
#pragma unroll
        for (int nb = 0; nb < 4; ++nb) acc[mb][nb] = (f32x4){0.f, 0.f, 0.f, 0.f}; }
#pragma unroll
    for (int ks = 0; ks < 2; ++ks) {
        u32x4 nz = *(const u32x4*)(NP + 32 * ks + 8 * q); if (r != 0) nz = (u32x4){0u, 0u, 0u, 0u};
        const bf16x8 bn = __builtin_bit_cast(bf16x8, nz);
#pragma unroll
        for (int nb = 0; nb < 4; ++nb) { const bf16x8 bb = *(const bf16x8*)(CP + (size_t)(16 * nb + r) * 64 + 32 * ks + 8 * q);
#pragma unroll
            for (int mb = 0; mb < 4; ++mb) acc[mb][nb] = MFMA16(aq[mb][ks], bb, acc[mb][nb]); }
#pragma unroll
        for (int mb = 0; mb < 4; ++mb) accn[mb] = MFMA16(aq[mb][ks], bn, accn[mb]);
    }
#pragma unroll
    for (int s8 = 0; s8 < 8; ++s8) { float vb[8];
#pragma unroll
        for (int j = 0; j < 8; ++j) vb[j] = bf2f(V[(size_t)(s8 * 8 + j) * 64 + lane]);
        u32x4 pk; pk.x = pk_bf16(vb[0], vb[1]); pk.y = pk_bf16(vb[2], vb[3]); pk.z = pk_bf16(vb[4], vb[5]); pk.w = pk_bf16(vb[6], vb[7]);
        *(LAS u32x4*)(wl + swz_off(lane, s8)) = pk; }
    LDS_FENCE();
#pragma unroll
    for (int ks = 0; ks < 2; ++ks) {
        bf16x8 ap[4];
#pragma unroll
        for (int mb = 0; mb < 4; ++mb) ap[mb] = *(const LAS bf16x8*)(wl + 8192 + swz_off(16 * mb + r, 4 * ks + q));
#pragma unroll
        for (int nb = 0; nb < 4; ++nb) { const bf16x8 bv = *(const LAS bf16x8*)(wl + swz_off(16 * nb + r, 4 * ks + q));
#pragma unroll
            for (int mb = 0; mb < 4; ++mb) acc[mb][nb] = MFMA16(ap[mb], bv, acc[mb][nb]); }
    }
    LDS_FENCE();
    const float* gain = in->p[14] + l * 256 + hd * 64; const bf16_t* OG = (const bf16_t*)(ws + WS_PRJ + PRJ_OG);
    bf16_t* Y = (bf16_t*)(ws + WS_Y);
#pragma unroll
    for (int mb = 0; mb < 4; ++mb)
#pragma unroll
        for (int j = 0; j < 4; ++j) {
            const int jj = 16 * mb + 4 * q + j;
            const float dn = den[mb][j] + __shfl(accn[mb][j], lane & 48);
            const float inv = 1.f / fmaxf(fabsf(dn), 1.f); float hv[4]; float ss = 0.f;
#pragma unroll
            for (int nb = 0; nb < 4; ++nb) { hv[nb] = acc[mb][nb][j] * inv; ss += hv[nb] * hv[nb]; }
            ss += __shfl_xor(ss, 1); ss += __shfl_xor(ss, 2); ss += __shfl_xor(ss, 4); ss += __shfl_xor(ss, 8);
            const float rstd = rsqrtf(ss * (1.f / 64.f) + 1e-6f); const size_t row = (size_t)b * 2048 + t0 + jj;
#pragma unroll
            for (int nb = 0; nb < 4; ++nb) { const int e = 16 * nb + r; Y[row * 1024 + 384 + hd * 64 + e] = f2bf(hv[nb] * rstd * gain[e] * sigmf(bf2f(OG[row * 256 + hd * 64 + e]))); }
        }
}

__device__ __forceinline__ void ml_scan_unit(int bh, int l, unsigned char* ws) {
    int tid_ = threadIdx.x; asm volatile("" : "+v"(tid_)); const int tid = tid_;
    const bf16_t* DL = (const bf16_t*)(ws + WS_ML + ML_DELTA) + (size_t)bh * 32 * 4096 + tid * 8; bf16_t* CP = (bf16_t*)(ws + WS_ML + ML_CP) + (size_t)bh * 32 * 4096 + tid * 8;
    const float* DN = (const float*)(ws + WS_ML + ML_DN) + (size_t)bh * 32 * 64; bf16_t* NP = (bf16_t*)(ws + WS_ML + ML_NP) + (size_t)bh * 32 * 64; const float* BL = (const float*)(ws + WS_ML + ML_BL) + bh * 32;
    float c[8]; float n = 0.f;
#pragma unroll
    for (int k = 0; k < 8; ++k) c[k] = 0.f;
#pragma unroll 1
    for (int c0 = 0; c0 < 32; c0 += 8) {
        u32x4 d[8]; float dn[8], co[8];
#pragma unroll
        for (int k = 0; k < 8; ++k) { d[k] = *(const u32x4*)(DL + (size_t)(c0 + k) * 4096); dn[k] = tid < 64 ? DN[(c0 + k) * 64 + tid] : 0.f; co[k] = __expf(BL[c0 + k]); }
#pragma unroll
        for (int k = 0; k < 8; ++k) {
            u32x4 o; o.x = pk_bf16(c[0], c[1]); o.y = pk_bf16(c[2], c[3]); o.z = pk_bf16(c[4], c[5]); o.w = pk_bf16(c[6], c[7]);
            *(u32x4*)(CP + (size_t)(c0 + k) * 4096) = o; if (tid < 64) NP[(c0 + k) * 64 + tid] = f2bf(n);
            c[0] = co[k] * c[0] + bf_lo(d[k].x); c[1] = co[k] * c[1] + bf_hi(d[k].x); c[2] = co[k] * c[2] + bf_lo(d[k].y); c[3] = co[k] * c[3] + bf_hi(d[k].y);
            c[4] = co[k] * c[4] + bf_lo(d[k].z); c[5] = co[k] * c[5] + bf_hi(d[k].z); c[6] = co[k] * c[6] + bf_lo(d[k].w); c[7] = co[k] * c[7] + bf_hi(d[k].w);
            n = co[k] * n + dn[k];
        }
    }
    asm volatile("s_waitcnt vmcnt(0)" ::: "memory"); __syncthreads();
    if (tid == 0) { __builtin_amdgcn_fence(__ATOMIC_RELEASE, "agent"); asm volatile("s_waitcnt vmcnt(0)" ::: "memory");
        __hip_atomic_fetch_add((unsigned*)(ws + WS_CTL) + CW_SCAN + 64 * l, 1u, __ATOMIC_RELAXED, __HIP_MEMORY_SCOPE_AGENT); }
}
__device__ __forceinline__ void ml_scan_wait(int l, unsigned char* ws) {
    if (threadIdx.x == 0) { unsigned* p = (unsigned*)(ws + WS_CTL) + CW_SCAN + 64 * l; unsigned sp = 0;
        while (__hip_atomic_load(p, __ATOMIC_RELAXED, __HIP_MEMORY_SCOPE_AGENT) < 32u) { __builtin_amdgcn_s_sleep(2); if (++sp > (1u << 22)) break; }
        __builtin_amdgcn_fence(__ATOMIC_ACQUIRE, "agent"); asm volatile("s_waitcnt vmcnt(0)" ::: "memory"); }
    __syncthreads();
}

#ifndef DUP_NSA
#define DUP_NSA 1
#endif
#ifndef DUP_MLA
#define DUP_MLA 1
#endif
#ifndef DUP_ML
#define DUP_ML 1
#endif
#ifdef NO_MLA
#define MLA_CALL(...) do {} while (0)
#else
#define MLA_CALL(...) do { for (int rp = 0; rp < DUP_MLA; ++rp) { if (rp) __syncthreads(); mla_unit(__VA_ARGS__); } } while (0)
#endif
__device__ __forceinline__ void phase_mix(int l, InPtr in, unsigned char* ws, LAS unsigned char* lds, unsigned* qhead) {
    LAS int* slot = (LAS int*)(lds + LDS_MISC + 64);
    for (;;) {
        __syncthreads();
        if (threadIdx.x == 0) *slot = (int)__hip_atomic_fetch_add(qhead, 1u, __ATOMIC_RELAXED, __HIP_MEMORY_SCOPE_AGENT);
        __syncthreads();
        int u = *slot;
        if (u >= 32 + 512 + 384 + 128) break;
        if (u < 32) { ml_scan_unit(u, l, ws); continue; } u -= 32;
#ifndef NO_NSA
        if (u < 256) { const int i = 31 - (u >> 4), bh = u & 15; { for (int rp = 0; rp < DUP_NSA; ++rp) { if (rp) __syncthreads(); nsa_unit(bh >> 1, bh & 1, i, l, in, ws, lds); } } continue; }
#endif
        u -= 256;
        if (u < 192) { const int qt = 7 - u / 48, bh = u % 48; MLA_CALL(bh / 6, bh % 6, qt, l, ws, lds); continue; }
        u -= 192;
#ifndef NO_NSA
        if (u < 128) { const int i = 15 - (u >> 4), bh = u & 15; { for (int rp = 0; rp < DUP_NSA; ++rp) { if (rp) __syncthreads(); nsa_unit(bh >> 1, bh & 1, i, l, in, ws, lds); } } continue; }
#endif
        u -= 128;
        if (u < 192) { const int qt = 3 - u / 48, bh = u % 48; MLA_CALL(bh / 6, bh % 6, qt, l, ws, lds); continue; } u -= 192;
#ifndef NO_NSA
        if (u < 128) { const int i = 7 - (u >> 4), bh = u & 15; { for (int rp = 0; rp < DUP_NSA; ++rp) { if (rp) __syncthreads(); nsa_unit(bh >> 1, bh & 1, i, l, in, ws, lds); } } continue; }
#endif
        u -= 128;
#ifndef NO_MLOUT
        ml_scan_wait(l, ws);
        for (int rp = 0; rp < DUP_ML; ++rp) { int tid_ = threadIdx.x; asm volatile("" : "+v"(tid_)); const int w = tid_ >> 6; ml_out_wave(u * 8 + w, l, in, ws, lds + w * 16384, lds + 131072 + w * 256, tid_ & 63); }
#endif
    }
}
__device__ __forceinline__ void phase_ynorm(int l, unsigned char* ws, int bid, int nb) {
    int tid_ = threadIdx.x; asm volatile("" : "+v"(tid_)); const int w = tid_ >> 6, lane = tid_ & 63;
    bf16_t* Y = (bf16_t*)(ws + WS_Y); const float* sa = (const float*)(ws + WS_SSQ + PT_A) + (size_t)l * 16384 * 8; const float* sc = (const float*)(ws + WS_SSQ + PT_C) + (size_t)l * 16384 * 8;
    for (int r0 = (bid * 8 + w) * 8; r0 < NTOK; r0 += nb * 64) {
        if (lane < 48) {
            u32x4 x[8], y[8]; float ra[8], rc[8];
#pragma unroll
            for (int k = 0; k < 8; ++k) { const int row = r0 + k;
                const f32x4 a0 = *(const f32x4*)(sa + (size_t)row * 8), a1 = *(const f32x4*)(sa + (size_t)row * 8 + 4), c0 = *(const f32x4*)(sc + (size_t)row * 8), c1 = *(const f32x4*)(sc + (size_t)row * 8 + 4);
                ra[k] = rsqrtf((((a0.x + a0.y) + (a0.z + a0.w)) + (a1.x + a1.y)) * (1.f / 384.f) + 1e-6f); rc[k] = rsqrtf((((c0.x + c0.y) + (c0.z + c0.w)) + (c1.x + c1.y)) * (1.f / 384.f) + 1e-6f);
                x[k] = *((const u32x4*)(Y + (size_t)row * 1024) + lane); y[k] = *((const u32x4*)(Y + (size_t)row * 1024 + 640) + lane); }
#pragma unroll
            for (int k = 0; k < 8; ++k) { const int row = r0 + k; u32x4 a = x[k], c = y[k]; const float fa = ra[k], fc = rc[k];
                a.x = pk_bf16(bf_lo(a.x) * fa, bf_hi(a.x) * fa); a.y = pk_bf16(bf_lo(a.y) * fa, bf_hi(a.y) * fa); a.z = pk_bf16(bf_lo(a.z) * fa, bf_hi(a.z) * fa); a.w = pk_bf16(bf_lo(a.w) * fa, bf_hi(a.w) * fa);
                c.x = pk_bf16(bf_lo(c.x) * fc, bf_hi(c.x) * fc); c.y = pk_bf16(bf_lo(c.y) * fc, bf_hi(c.y) * fc); c.z = pk_bf16(bf_lo(c.z) * fc, bf_hi(c.z) * fc); c.w = pk_bf16(bf_lo(c.w) * fc, bf_hi(c.w) * fc);
                *((u32x4*)(Y + (size_t)row * 1024) + lane) = a; *((u32x4*)(Y + (size_t)row * 1024 + 640) + lane) = c; }
        }
    }
}
struct EpiOut {
    bf16_t* XB; float* ssq;
    __device__ __forceinline__ void operator()(const f32x4 (&acc)[2][2][4][2], const GUnit& u, int wr, int wc, int fr, int fq) const {
#pragma unroll
        for (int ai = 0; ai < 2; ++ai)
#pragma unroll
            for (int m = 0; m < 4; ++m) {
                __builtin_amdgcn_sched_barrier(0);
                const int row = u.pm * 256 + ai * 128 + wr * 64 + m * 16 + fr; float ss = 0.f;
#pragma unroll
                for (int bj = 0; bj < 2; ++bj) {
                    u32x4* p = (u32x4*)(XB + (size_t)row * 1024 + u.pn * 256 + bj * 128 + wc * 32 + 8 * fq); const u32x4 x = *p; u32x4 o;
                    o.x = pk_bf16(bf_lo(x.x) + acc[ai][bj][m][0][0], bf_hi(x.x) + acc[ai][bj][m][0][1]); o.y = pk_bf16(bf_lo(x.y) + acc[ai][bj][m][0][2], bf_hi(x.y) + acc[ai][bj][m][0][3]);
                    o.z = pk_bf16(bf_lo(x.z) + acc[ai][bj][m][1][0], bf_hi(x.z) + acc[ai][bj][m][1][1]); o.w = pk_bf16(bf_lo(x.w) + acc[ai][bj][m][1][2], bf_hi(x.w) + acc[ai][bj][m][1][3]);
                    *p = o;
                    ss += (bf_lo(o.x) * bf_lo(o.x) + bf_hi(o.x) * bf_hi(o.x)) + (bf_lo(o.y) * bf_lo(o.y) + bf_hi(o.y) * bf_hi(o.y)) + (bf_lo(o.z) * bf_lo(o.z) + bf_hi(o.z) * bf_hi(o.z)) + (bf_lo(o.w) * bf_lo(o.w) + bf_hi(o.w) * bf_hi(o.w));
                }
                ss = quad_sum(ss); if (fq == 0) ssq[(size_t)row * 16 + u.pn * 4 + wc] = ss;
            }
    }
};

__device__ __forceinline__ float sum16(const float* p) { const f32x4 a = *(const f32x4*)p, b = *(const f32x4*)(p + 4), c = *(const f32x4*)(p + 8), d = *(const f32x4*)(p + 12);
    return (((a.x + a.y) + (a.z + a.w)) + ((b.x + b.y) + (b.z + b.w))) + (((c.x + c.y) + (c.z + c.w)) + ((d.x + d.y) + (d.z + d.w))); }
__device__ __forceinline__ void phase_route(int l, InPtr in, unsigned char* ws, LAS unsigned char* lds, int bid, int nb) {
    int tid_ = threadIdx.x; asm volatile("" : "+v"(tid_)); const int w = tid_ >> 6, lane = tid_ & 63, r = lane & 15, q = lane >> 4;
    const bf16_t* XB = (const bf16_t*)(ws + WS_XB); const bf16_t* WR = (const bf16_t*)(ws + WS_WR) + (size_t)l * 64 * 1024;
    const float* ssq = (const float*)(ws + WS_SSQ + PT_X1) + (size_t)l * 16384 * 16; const float* bg = in->p[24] + l * 4; const float* be = in->p[26] + l * 32;
    unsigned* cnt = (unsigned*)(ws + WS_CTL) + CW_CNT + 2048 * l; unsigned* mtok = (unsigned*)(ws + WS_META); float* mw = (float*)(ws + WS_META + META_W);
    LAS float* lg = (LAS float*)(lds + w * 4096);
    LAS unsigned* lcnt = (LAS unsigned*)(lds + 32768); LAS unsigned* lbase = lcnt + 32;
    for (int g0 = bid * 8; g0 < NTOK / 16; g0 += nb * 8) {
        if (tid_ < 32) lcnt[tid_] = 0u;
        __syncthreads();
        const int tok0 = (g0 + w) * 16; f32x4 acc[3];
#pragma unroll
        for (int n = 0; n < 3; ++n) acc[n] = (f32x4){0.f, 0.f, 0.f, 0.f};
        const bf16_t* ap = XB + (size_t)(tok0 + r) * 1024 + 8 * q; const bf16_t* bp = WR + (size_t)r * 1024 + 8 * q;
#pragma unroll 8
        for (int ks = 0; ks < 32; ++ks) { const bf16x8 a = *(const bf16x8*)(ap + 32 * ks);
#pragma unroll
            for (int n = 0; n < 3; ++n) { const bf16x8 bb = *(const bf16x8*)(bp + (size_t)n * 16 * 1024 + 32 * ks); acc[n] = MFMA16(a, bb, acc[n]); } }
#pragma unroll
        for (int n = 0; n < 3; ++n)
#pragma unroll
            for (int j = 0; j < 4; ++j) lg[(4 * q + j) * 48 + 16 * n + r] = acc[n][j];
        LDS_FENCE();
        int E0 = 0, E1 = 0; unsigned r0 = 0, r1 = 0; float wt0 = 0.f, wt1 = 0.f; const int tok = tok0 + (lane & 15);
        if (lane < 16) {
            const float rs = rsqrtf(sum16(ssq + (size_t)tok * 16) * (1.f / 1024.f) + 1e-6f); ((float*)(ws + WS_RS2))[tok] = rs; const LAS float* L = lg + lane * 48;
            float gl[4]; int gi = 0;
#pragma unroll
            for (int j = 0; j < 4; ++j) gl[j] = L[j] * rs + bg[j];
            float gm = gl[0];
#pragma unroll
            for (int j = 1; j < 4; ++j) if (gl[j] > gm) { gm = gl[j]; gi = j; }
            float gsum = 0.f;
#pragma unroll
            for (int j = 0; j < 4; ++j) gsum += __expf(gl[j] - gm);
            const float gtop = 1.f / gsum;
            float el[8];
#pragma unroll
            for (int j = 0; j < 8; ++j) el[j] = L[4 + gi * 8 + j] * rs + be[gi * 8 + j];
            int e0 = 0; float v0 = el[0];
#pragma unroll
            for (int j = 1; j < 8; ++j) if (el[j] > v0) { v0 = el[j]; e0 = j; }
            int e1 = -1; float v1 = -3.0e38f;
#pragma unroll
            for (int j = 0; j < 8; ++j) if (j != e0 && el[j] > v1) { v1 = el[j]; e1 = j; }
            const float w0 = 1.f / (1.f + __expf(v1 - v0)); E0 = gi * 8 + e0; E1 = gi * 8 + e1; wt0 = w0 * gtop; wt1 = (1.f - w0) * gtop;
            r0 = __hip_atomic_fetch_add(lcnt + E0, 1u, __ATOMIC_RELAXED, __HIP_MEMORY_SCOPE_WORKGROUP); r1 = __hip_atomic_fetch_add(lcnt + E1, 1u, __ATOMIC_RELAXED, __HIP_MEMORY_SCOPE_WORKGROUP);
        }
        __syncthreads();
        if (tid_ < 32) { const unsigned c = lcnt[tid_]; lbase[tid_] = c ? atomicAdd(cnt + tid_ * 64, c) : 0u; }
        __syncthreads();
        if (lane < 16) {
            const unsigned p0 = lbase[E0] + r0, p1 = lbase[E1] + r1;
            mtok[(size_t)E0 * 16384 + p0] = (unsigned)tok; mw[(size_t)E0 * 16384 + p0] = wt0;
            mtok[(size_t)E1 * 16384 + p1] = (unsigned)tok | 0x80000000u; mw[(size_t)E1 * 16384 + p1] = wt1;
        }
        __syncthreads();
    }
}

constexpr int LDS_TB = 131072 + 2048;
__device__ __forceinline__ void moe_tables(int l, unsigned char* ws, LAS unsigned char* lds) {
    LAS int* tb = (LAS int*)(lds + LDS_TB);
    if (threadIdx.x < 32) { const unsigned* cnt = (const unsigned*)(ws + WS_CTL) + CW_CNT + 2048 * l; tb[40 + threadIdx.x] = ((int)__hip_atomic_load(cnt + threadIdx.x * 64, __ATOMIC_RELAXED, __HIP_MEMORY_SCOPE_AGENT) + 255) >> 8; }
    __syncthreads();
    if (threadIdx.x == 0) { int acc = 0; for (int e = 0; e < 32; ++e) { tb[e] = acc; acc += tb[40 + e]; } tb[32] = acc; }
    __syncthreads();
}
template <int NPN, bool GATHER_>
struct MoeSched {
    static constexpr bool GATHER = GATHER_;
    const char* A; const char* Bt; const unsigned* cnt; const unsigned* mtok; const LAS int* tb; int G, c; size_t bstride_e  , bstride_pn;
    __device__ __forceinline__ bool next(int i, GUnit& u) const {
        const int L = i * G + c; const int ntile = tb[32]; if (L >= ntile * NPN) return false;
        const int tile = L / NPN, pn = L % NPN; int e = 0;
        for (int k = 1; k < 32; ++k) e = (tb[k] <= tile) ? k : e;
        e = __builtin_amdgcn_readfirstlane(e);
        u.e = e; u.pm = tile; u.pn = pn; u.rows = (int)__hip_atomic_load(cnt + e * 64, __ATOMIC_RELAXED, __HIP_MEMORY_SCOPE_AGENT) - 256 * (tile - tb[e]);
        u.a = GATHER ? A : A + (size_t)tile * 256 * 256 * 2;
        u.b = Bt + (size_t)e * bstride_e + (size_t)pn * bstride_pn; return true;
    }
    __device__ __forceinline__ void aoff(const GUnit& u, unsigned (&v)[2][2], const int (&R)[2], const int (&C)[2]) const {
#pragma unroll
        for (int h = 0; h < 2; ++h)
#pragma unroll
            for (int i = 0; i < 2; ++i) {
                if (GATHER) { const int lr = h * 128 + R[i]; const int rr = 256 * (u.pm - tb[u.e]) + (lr < u.rows ? lr : 0); const unsigned tok = mtok[(size_t)u.e * 16384 + rr] & 0x7fffffffu; v[h][i] = (tok * 1024u + (unsigned)C[i]) * 2u; }
                else v[h][i] = (unsigned)((h * 128 + R[i]) * 256 + C[i]) * 2u;
            }
    }
};
struct EpiMoeUp {
    const unsigned* mtok; const float* ssq; const LAS int* tb; bf16_t* HB;
    __device__ __forceinline__ void operator()(const f32x4 (&acc)[2][2][4][2], const GUnit& u, int wr, int wc, int fr, int fq) const {
        const int r0 = 256 * (u.pm - tb[u.e]);
#pragma unroll
        for (int ai = 0; ai < 2; ++ai)
#pragma unroll
            for (int m = 0; m < 4; ++m) {
                __builtin_amdgcn_sched_barrier(0);
                const int lr = ai * 128 + wr * 64 + m * 16 + fr;
                if (lr < u.rows) {
                    const unsigned tok = mtok[(size_t)u.e * 16384 + r0 + lr] & 0x7fffffffu; const float rs = ssq[tok];
                    float hv[8];
#pragma unroll
                    for (int n = 0; n < 2; ++n)
#pragma unroll
                        for (int j = 0; j < 4; ++j) { const float gv = acc[ai][0][m][n][j] * rs, uv = acc[ai][1][m][n][j] * rs; hv[4 * n + j] = siluf(gv) * uv; }
                    st_bf16x8(HB + ((size_t)u.pm * 256 + lr) * 256 + u.pn * 128 + wc * 32 + 8 * fq, hv);
                }
            }
    }
};
struct EpiMoeDown {
    const unsigned* mtok; const float* mw; const LAS int* tb; bf16_t* YB;
    __device__ __forceinline__ void operator()(const f32x4 (&acc)[2][2][4][2], const GUnit& u, int wr, int wc, int fr, int fq) const {
        const int r0 = 256 * (u.pm - tb[u.e]);
#pragma unroll
        for (int ai = 0; ai < 2; ++ai)
#pragma unroll
            for (int m = 0; m < 4; ++m) {
                __builtin_amdgcn_sched_barrier(0);
                const int lr = ai * 128 + wr * 64 + m * 16 + fr;
                if (lr < u.rows) {
                    const unsigned mt = mtok[(size_t)u.e * 16384 + r0 + lr]; const float wt = mw[(size_t)u.e * 16384 + r0 + lr];
                    bf16_t* dst = YB + ((size_t)(mt >> 31) * 16384 + (mt & 0x7fffffffu)) * 1024 + u.pn * 256 + wc * 32 + 8 * fq;
#pragma unroll
                    for (int bj = 0; bj < 2; ++bj) { float v[8];
#pragma unroll
                        for (int n = 0; n < 2; ++n)
#pragma unroll
                            for (int j = 0; j < 4; ++j) v[4 * n + j] = acc[ai][bj][m][n][j] * wt;
                        st_bf16x8(dst + bj * 128, v); }
                }
            }
    }
};
__device__ __forceinline__ void phase_combine(int l, unsigned char* ws, float* out, int bid, int nb) {
    int tid_ = threadIdx.x; asm volatile("" : "+v"(tid_)); const int w = tid_ >> 6, lane = tid_ & 63;
    bf16_t* XB = (bf16_t*)(ws + WS_XB); const bf16_t* Y0 = (const bf16_t*)(ws + WS_YBUF); const bf16_t* Y1 = Y0 + (size_t)16384 * 1024; float* ssqx = (float*)(ws + WS_SSQX) + 16384;
    for (int row = bid * 8 + w; row < NTOK; row += nb * 8) {
        float ss = 0.f;
#pragma unroll
        for (int k = 0; k < 2; ++k) {
            const size_t o = (size_t)row * 1024 + (lane + 64 * k) * 8;
            const u32x4 x = *(const u32x4*)(XB + o), a = *(const u32x4*)(Y0 + o), c = *(const u32x4*)(Y1 + o);
            float v[8] = { bf_lo(x.x) + bf_lo(a.x) + bf_lo(c.x), bf_hi(x.x) + bf_hi(a.x) + bf_hi(c.x), bf_lo(x.y) + bf_lo(a.y) + bf_lo(c.y), bf_hi(x.y) + bf_hi(a.y) + bf_hi(c.y),
                           bf_lo(x.z) + bf_lo(a.z) + bf_lo(c.z), bf_hi(x.z) + bf_hi(a.z) + bf_hi(c.z), bf_lo(x.w) + bf_lo(a.w) + bf_lo(c.w), bf_hi(x.w) + bf_hi(a.w) + bf_hi(c.w) };
            if (l == L_ - 1 && out) { *(f32x4*)(out + o) = (f32x4){v[0], v[1], v[2], v[3]}; *(f32x4*)(out + o + 4) = (f32x4){v[4], v[5], v[6], v[7]}; }
            else { u32x4 p; p.x = pk_bf16(v[0], v[1]); p.y = pk_bf16(v[2], v[3]); p.z = pk_bf16(v[4], v[5]); p.w = pk_bf16(v[6], v[7]); *(u32x4*)(XB + o) = p;
#pragma unroll
                   for (int j = 0; j < 4; ++j) { const unsigned q = j == 0 ? p.x : (j == 1 ? p.y : (j == 2 ? p.z : p.w)); ss += bf_lo(q) * bf_lo(q) + bf_hi(q) * bf_hi(q); } }
        }
        if (l < L_ - 1) { ss = wave_sum(ss); if (lane == 0) ssqx[row] = ss; }
    }
}
constexpr int NPH = 9;
enum { PH_INPROJ = 0, PH_PREP, PH_MIX, PH_YNORM, PH_OUTPROJ, PH_ROUTE, PH_MOEUP, PH_MOEDOWN, PH_COMBINE };
struct Args { Inputs in; float* out; unsigned char* ws; int ph_lo, ph_hi; };

__global__ void __launch_bounds__(512, 2) mk(Args args) {
    extern __shared__ __attribute__((aligned(16))) unsigned char lds_raw[];
    LAS unsigned char* lds = (LAS unsigned char*)lds_raw;
    const int tid = threadIdx.x, bid0 = blockIdx.x, nb = gridDim.x;
#define BID() ({ int b_ = bid0; asm volatile("" : "+s"(b_)); b_; })
    unsigned char* ws = args.ws; unsigned* ctl = (unsigned*)(ws + WS_CTL);
    const int lo = args.ph_lo, hi = args.ph_hi;
    if (tid < 4) ((LAS unsigned*)(lds + LDS_MISC))[tid] = 0u;
    __syncthreads();
    XcdBarrier bar; bar.bar = ctl + CW_BAR; bar.x = 0; bar.st = nullptr;
    if (hi - lo > 1) bar = xcd_barrier_post(ctl + CW_BAR, (volatile LAS unsigned*)(lds + LDS_MISC));
#define IN(k) (lo <= (k) && (k) < hi)
#ifndef REPEAT_PH
#define REPEAT_PH -1
#endif
#define NREP(k) ((REPEAT_PH == (k)) ? 2 : 1)
#ifndef NBAR
#define NBAR 1
#endif
#ifndef TIME_PH
#define TIME_PH -1
#endif
#define STAMP(i) do { if (TIME_PH != -1 && blockIdx.x == 0 && threadIdx.x == 0) ((unsigned long long*)(ctl + CW_TS))[i] = __builtin_amdgcn_s_memrealtime(); } while (0)
#define SEAM(k) do { if (IN(k) && IN((k) + 1)) for (int nb_ = 0; nb_ < NBAR; ++nb_) xcd_barrier(bar); STAMP((k) + 1); } while (0)
    STAMP(0);
#ifndef NO_PRO
    if (IN(0)) for (int rep = 0; rep < NREP(100); ++rep) { prologue(in_tab(), launder(ws), lds, BID(), nb); if (rep + 1 < NREP(100)) xcd_barrier(bar); }
#endif
    SEAM(0);
    for (int l = 0; l < L_; ++l) {
        const int pb = 1 + l * NPH;
        if (IN(pb + PH_INPROJ)) for (int rep = 0; rep < NREP(PH_INPROJ); ++rep) {
            if (rep) xcd_barrier(bar);
            InPtr in = in_tab(); unsigned char* ws = launder(args.ws);
            g8::DenseSched S{(const char*)(ws + WS_XB), (const char*)(ws + WS_WIN) + (size_t)l * 2560 * 1024 * 2, 1024, 1024, 64, 10, nb, BID()};
            EpiInProj E{(const float*)(ws + WS_SSQX) + l * 16384, (float*)(ws + WS_SSQ + PT_DQ) + (size_t)l * 16384 * 4, (float*)(ws + WS_SSQ + PT_DKV) + (size_t)l * 16384 * 2,
                        in->p[8] + l * 64, in->p[9] + l * 64, in->p[19] + l * 192 + 96 + 64, (const float*)(ws + WS_ROPE), ws + WS_PRJ};
#ifndef NO_INPROJ
            g8::gemm_run(lds, 1024, 1024, S, E);
#endif
        }
        SEAM(pb + PH_INPROJ);
        if (IN(pb + PH_PREP)) for (int rep = 0; rep < NREP(PH_PREP); ++rep) { if (rep) xcd_barrier(bar); phase_prep(l, in_tab(), launder(ws), lds, BID(), nb); }
        SEAM(pb + PH_PREP);
        if (IN(pb + PH_MIX)) for (int rep = 0; rep < NREP(PH_MIX); ++rep) { if (rep) xcd_barrier(bar); phase_mix(l, in_tab(), launder(ws), lds, (unsigned*)launder(ws) + CW_Q + 64 * (l + 2 * rep)); }
        SEAM(pb + PH_MIX);
        if (IN(pb + PH_YNORM)) phase_ynorm(l, launder(ws), BID(), nb);
        SEAM(pb + PH_YNORM);
        if (IN(pb + PH_OUTPROJ)) {
            unsigned char* ws = launder(args.ws);
            g8::DenseSched S{(const char*)(ws + WS_Y), (const char*)(ws + WS_WOUT) + (size_t)l * 1024 * 1024 * 2, 1024, 1024, 64, 4, nb, BID()};
            EpiOut E{(bf16_t*)(ws + WS_XB), (float*)(ws + WS_SSQ + PT_X1) + (size_t)l * 16384 * 16};
#ifndef NO_OUTPROJ
            g8::gemm_run(lds, 1024, 1024, S, E);
#endif
        }
        SEAM(pb + PH_OUTPROJ);
#ifndef NO_ROUTE
        if (IN(pb + PH_ROUTE)) {
            const int b_ = BID();
            if (nb >= 256 && b_ >= 128) cvt_moe_layer(in_tab(), launder(ws), l, (LAS float*)lds, b_ - 128, nb - 128, threadIdx.x);
            else { phase_route(l, in_tab(), launder(ws), lds, b_, nb >= 256 ? 128 : nb); if (nb < 256) cvt_moe_layer(in_tab(), launder(ws), l, (LAS float*)lds, b_, nb, threadIdx.x); }
        }
#endif
        SEAM(pb + PH_ROUTE);
        if (IN(pb + PH_MOEUP)) for (int rep = 0; rep < NREP(PH_MOEUP); ++rep) {
            if (rep) xcd_barrier(bar);
            unsigned char* ws = launder(args.ws); moe_tables(l, ws, lds);
            const unsigned* cnt = (const unsigned*)(ws + WS_CTL) + CW_CNT + 2048 * l; const unsigned* mtok = (const unsigned*)(ws + WS_META); const LAS int* tb = (const LAS int*)(lds + LDS_TB);
            MoeSched<2, true> S{(const char*)(ws + WS_XB), (const char*)(ws + WS_WMOE), cnt, mtok, tb, nb, BID(), (size_t)512 * 1024 * 2, (size_t)256 * 1024 * 2};
            EpiMoeUp E{mtok, (const float*)(ws + WS_RS2), tb, (bf16_t*)(ws + WS_HBUF)};
#ifndef NO_MOEUP
            g8::gemm_run(lds, 1024, 1024, S, E);
#endif
        }
        SEAM(pb + PH_MOEUP);
        if (IN(pb + PH_MOEDOWN)) for (int rep = 0; rep < NREP(PH_MOEDOWN); ++rep) {
            if (rep) xcd_barrier(bar);
            unsigned char* ws = launder(args.ws); moe_tables(l, ws, lds);
            const unsigned* cnt = (const unsigned*)(ws + WS_CTL) + CW_CNT + 2048 * l; const unsigned* mtok = (const unsigned*)(ws + WS_META); const LAS int* tb = (const LAS int*)(lds + LDS_TB);
            MoeSched<4, false> S{(const char*)(ws + WS_HBUF), (const char*)(ws + WS_WMOE + WMOE_WD), cnt, mtok, tb, nb, BID(), (size_t)1024 * 256 * 2, (size_t)256 * 256 * 2};
            EpiMoeDown E{mtok, (const float*)(ws + WS_META + META_W), tb, (bf16_t*)(ws + WS_YBUF)};
#ifndef NO_MOEDOWN
            g8::gemm_run(lds, 256, 256, S, E);
#endif
        }
        SEAM(pb + PH_MOEDOWN);
#ifndef NO_COMBINE
        if (IN(pb + PH_COMBINE)) { unsigned char* ws = launder(args.ws); phase_combine(l, ws, args.out, BID(), nb); }
#endif
        SEAM(pb + PH_COMBINE);
    }
#undef IN
#undef SEAM
}
#if CHECK
struct NvScratch { float *proj, *h1, *qk, *hraw, *kn, *kcmp, *vcmp, *dqn, *q, *dkvn, *kv, *krope, *y, *x1, *xl; int* rt_e; float* rt_w; };
constexpr int CB = 5;
enum { NS_INPROJ = 0, NS_NSAPREP, NS_MLAPREP, NS_NSA, NS_ML, NS_MLA, NS_OUT, NS_ROUTE, NS_MOE };
static void naive_step(void* const* d_in, int l, int step, const float* xin, float* xout, const NvScratch& S, hipStream_t st) {
    const int b = CB;
    const float* rel_bias = (const float*)d_in[2];
    const float* norm1_g = (const float*)d_in[3] + (long)l * 1024;
    const float* w_in = (const float*)d_in[4] + (long)l * 1024 * DIN;
    const float* cmp_pe = (const float*)d_in[5] + (long)l * 2 * 32 * 64;
    const float* cmp_w1 = (const float*)d_in[6] + (long)l * 2 * 32 * 64 * 64;
    const float* cmp_w2 = (const float*)d_in[7] + (long)l * 2 * 64 * 64;
    const float* q_norm = (const float*)d_in[8] + l * 64;
    const float* k_norm = (const float*)d_in[9] + l * 64;
    const float* nsa_on = (const float*)d_in[10] + l * 384;
    const float* conv = (const float*)d_in[11] + l * 4 * 512;
    const float* ibias = (const float*)d_in[12] + l * 4;
    const float* fbias = (const float*)d_in[13] + l * 4;
    const float* ml_on = (const float*)d_in[14] + l * 256;
    const float* qan = (const float*)d_in[15] + l * 192;
    const float* w_uq = (const float*)d_in[16] + (long)l * 192 * 576;
    const float* kvan = (const float*)d_in[17] + l * 128;
    const float* w_ukv = (const float*)d_in[18] + (long)l * 128 * 768;
    const float* qkn = (const float*)d_in[19] + l * 192;
    const float* mla_on = (const float*)d_in[20] + l * 384;
    const float* w_out = (const float*)d_in[21] + (long)l * 1024 * 1024;
    const float* norm2_g = (const float*)d_in[22] + l * 1024;
    const float* wgrp = (const float*)d_in[23] + (long)l * 1024 * 4;
    const float* bgrp = (const float*)d_in[24] + l * 4;
    const float* wexp = (const float*)d_in[25] + (long)l * 1024 * 32;
    const float* bexp = (const float*)d_in[26] + l * 32;
    const float* Wg = (const float*)d_in[27] + (long)l * 32 * 1024 * 256;
    const float* Wu = (const float*)d_in[28] + (long)l * 32 * 1024 * 256;
    const float* Wd = (const float*)d_in[29] + (long)l * 32 * 256 * 1024;
    const int* pos = (const int*)d_in[1] + b * 2048;
    switch (step) {
    case NS_INPROJ:
        nv_rmsnorm<<<dim3(2048, 1), 64, 0, st>>>(xin, 1024, 0, S.h1, 1024, 0, norm1_g, 0, 1024);
        nv_gemm<<<dim3((DIN + 63) / 64, 2048 / 64), 256, 0, st>>>(S.h1, 1024, w_in, DIN, S.proj, DIN, nullptr, 0, 2048, DIN, 1024);
        break;
    case NS_NSAPREP:
        nv_nsa_cmp<<<dim3(127, 2, 2), 64, 0, st>>>(S.proj, cmp_pe, cmp_w1, cmp_w2, k_norm, S.kcmp, S.vcmp);
        nv_nsa_knorm<<<dim3(2048, 4), 64, 0, st>>>(S.proj, k_norm, S.kn);
        break;
    case NS_MLAPREP:
        nv_rmsnorm<<<dim3(2048, 1), 64, 0, st>>>(S.proj + O_CDQ, DIN, 0, S.dqn, 192, 0, qan, 0, 192);
        nv_gemm<<<dim3(576 / 64, 2048 / 64), 256, 0, st>>>(S.dqn, 192, w_uq, 576, S.q, 576, nullptr, 0, 2048, 576, 192);
        nv_rmsnorm<<<dim3(2048, 1), 64, 0, st>>>(S.proj + O_CDKV, DIN, 0, S.dkvn, 128, 0, kvan, 0, 128);
        nv_gemm<<<dim3(768 / 64, 2048 / 64), 256, 0, st>>>(S.dkvn, 128, w_ukv, 768, S.kv, 768, nullptr, 0, 2048, 768, 128);
        nv_mla_prep<<<dim3(2048, 7), 64, 0, st>>>(S.q, S.kv, S.proj, S.krope, qkn, pos);
        break;
    case NS_NSA:
        nv_nsa_attn<<<dim3(2048, 2), 192, 0, st>>>(S.proj, S.kn, S.kcmp, S.vcmp, rel_bias, q_norm, S.y);
        break;
    case NS_ML:
        nv_ml_conv<<<2048, 512, 0, st>>>(S.proj, conv, S.qk);
        nv_ml_rec<<<4, 256, 0, st>>>(S.proj, S.qk, ibias, fbias, S.hraw);
        nv_ml_fin<<<dim3(2048, 4), 64, 0, st>>>(S.proj, S.hraw, ml_on, S.y);
        break;
    case NS_MLA:
        nv_mla_attn<<<dim3(2048, 6), 64, 0, st>>>(S.q, S.kv, S.krope, S.y);
        break;
    case NS_OUT:
        nv_rmsnorm<<<dim3(2048, 1), 64, 0, st>>>(S.y, 1024, 0, S.y, 1024, 0, nsa_on, 0, 384);
        nv_rmsnorm<<<dim3(2048, 1), 64, 0, st>>>(S.y + 640, 1024, 0, S.y + 640, 1024, 0, mla_on, 0, 384);
        nv_gemm<<<dim3(1024 / 64, 2048 / 64), 256, 0, st>>>(S.y, 1024, w_out, 1024, S.x1, 1024, xin, 1024, 2048, 1024, 1024);
        break;
    case NS_ROUTE:
        nv_moe_route<<<2048, 64, 0, st>>>(S.x1, norm2_g, wgrp, bgrp, wexp, bexp, S.h1, S.rt_e, S.rt_w);
        break;
    case NS_MOE:
        nv_moe_exp<<<2048, 256, 0, st>>>(S.x1, S.h1, S.rt_e, S.rt_w, Wg, Wu, Wd, xout);
        break;
    }
}

__device__ __forceinline__ void chk_commit(float d2, float r2, float* acc) { d2 = wave_sum(d2); r2 = wave_sum(r2); if ((threadIdx.x & 63) == 0) { atomicAdd(acc, d2); atomicAdd(acc + 1, r2); } }
__device__ __forceinline__ void chk_add(float f, float r, float& d2, float& r2) { const float d = f - r; d2 += (d == d) ? d * d : 1e30f; r2 += r * r; }

__global__ void __launch_bounds__(64) chk_proj(const float* nproj, const unsigned char* prj, const float* ssq_dq, const float* ssq_dkv, const float* qg, const float* kg, const float* krg, const int* pos, float* acc) {
    const int t = blockIdx.x, e = threadIdx.x; const size_t row = (size_t)CB * 2048 + t; float d2 = 0.f, r2 = 0.f;
    for (int G = 0; G < 40; ++G) {
        const int c = inproj_refcol(G, e); float r = c < 0 ? 0.f : nproj[(size_t)t * DIN + c]; float f = 0.f;
        const float rr = (G == 37 && e >= 32) ? 0.f : r; const float ss = wave_sum(rr * rr);
        if (G < 6) { r = r * rsqrtf(ss / 64.f + 1e-6f) * qg[e] * 0.18033688f; f = bf2f(((const bf16_t*)(prj + PRJ_QN))[((size_t)(CB * 6 + G) * 2048 + t) * 64 + e]); }
        else if (G < 18) { const int a = G - 6, br = a >> 2, s = (a >> 1) & 1, hk = a & 1;
            if (br > 0 && s == 0) r = r * rsqrtf(ss / 64.f + 1e-6f) * kg[e];
            const size_t base = br == 0 ? (s ? PRJ_C0V : PRJ_C0K) : (br == 1 ? (s ? PRJ_VN1 : PRJ_KN1) : (s ? PRJ_VN2 : PRJ_KN2));
            f = bf2f(((const bf16_t*)(prj + base))[((size_t)(CB * 2 + hk) * 2048 + t) * 64 + e]); }
        else if (G < 26) f = bf2f(((const bf16_t*)(prj + PRJ_RAWQK))[row * 512 + (G - 18) * 64 + e]);
        else if (G < 30) f = bf2f(((const bf16_t*)(prj + PRJ_VML))[((size_t)(CB * 4 + (G - 26)) * 2048 + t) * 64 + e]);
        else if (G < 34) f = bf2f(((const bf16_t*)(prj + PRJ_OG))[row * 256 + (G - 30) * 64 + e]);
        else if (G < 37) f = bf2f(((const bf16_t*)(prj + PRJ_DQKV))[row * 384 + (G - 34) * 64 + e]);
        else if (G == 37) {
            const float val = e < 32 ? rr * rsqrtf(ss / 32.f + 1e-6f) * krg[e & 31] : 0.f; const float oth = __shfl_xor(val, 16);
            if (e < 32) { const int i = e & 15; const double ang = (double)pos[row] * pow(10000.0, -(double)i / 16.0); const float cs = (float)cos(ang), sn = (float)sin(ang);
                r = e < 16 ? val * cs - oth * sn : val * cs + oth * sn; f = bf2f(((const bf16_t*)(prj + PRJ_KR))[row * 32 + e]); }
            else if (e < 58) f = ((const float*)(prj + PRJ_GATES))[row * 32 + (e - 32)];
            else { f = 0.f; r = 0.f; }
        }
        else f = bf2f(((const bf16_t*)(prj + PRJ_DQKV))[row * 384 + 256 + (G - 38) * 64 + e]);
        chk_add(f, r, d2, r2);
    }
    float d2s = 0.f, r2s = 0.f;
    { float s1 = 0.f, s2 = 0.f; for (int c = e; c < 192; c += 64) { float v = nproj[(size_t)t * DIN + O_CDQ + c]; s1 += v * v; } for (int c = e; c < 128; c += 64) { float v = nproj[(size_t)t * DIN + O_CDKV + c]; s2 += v * v; }
      s1 = wave_sum(s1); s2 = wave_sum(s2); if (e == 0) { chk_add((ssq_dq[row * 4] + ssq_dq[row * 4 + 1]) + ssq_dq[row * 4 + 2], s1, d2s, r2s); chk_add(ssq_dkv[row * 2] + ssq_dkv[row * 2 + 1], s2, d2s, r2s); } }
    chk_commit(d2, r2, acc); chk_commit(d2s, r2s, acc + 2);
}

__global__ void __launch_bounds__(64) chk_prep(const float* nq, const float* nkv, const float* nkr, const float* nkc, const float* nvc, const unsigned char* ws, float* acc) {
    const int t = blockIdx.x, e = threadIdx.x; float d2 = 0.f, r2 = 0.f, d2c = 0.f, r2c = 0.f; const float scale = 0.14724444f;
    const bf16_t* QM = (const bf16_t*)(ws + WS_MLA); const bf16_t* KM = (const bf16_t*)(ws + WS_MLA + MLA_KM); const bf16_t* VM = (const bf16_t*)(ws + WS_MLA + MLA_VM);
    for (int h = 0; h < 6; ++h) {
        const size_t rq = ((size_t)(CB * 6 + h) * 2048 + t);
        chk_add(bf2f(QM[rq * 96 + e]), nq[(size_t)t * 576 + h * 96 + e] * scale, d2, r2);
        chk_add(bf2f(KM[rq * 96 + e]), nkv[(size_t)t * 768 + h * 128 + e], d2, r2);
        chk_add(bf2f(VM[rq * 64 + e]), nkv[(size_t)t * 768 + h * 128 + 64 + e], d2, r2);
        if (e < 32) { chk_add(bf2f(QM[rq * 96 + 64 + e]), nq[(size_t)t * 576 + h * 96 + 64 + e] * scale, d2, r2); chk_add(bf2f(KM[rq * 96 + 64 + e]), nkr[(size_t)t * 32 + e], d2, r2); }
    }
    if (t < 128) for (int hk = 0; hk < 2; ++hk) {
        const bf16_t* KC = (const bf16_t*)(ws + WS_CMP); const bf16_t* VC = (const bf16_t*)(ws + WS_CMP + CMP_V); const size_t rf = ((size_t)(CB * 2 + hk) * 128 + t) * 64 + e;
        chk_add(bf2f(KC[rf]), t < 127 ? nkc[(size_t)(hk * 127 + t) * 64 + e] : 0.f, d2c, r2c); chk_add(bf2f(VC[rf]), t < 127 ? nvc[(size_t)(hk * 127 + t) * 64 + e] : 0.f, d2c, r2c);
    }
    chk_commit(d2, r2, acc); chk_commit(d2c, r2c, acc + 2);
}

__global__ void __launch_bounds__(64) chk_y(const float* ny, const unsigned char* ws, float* acc, int nseg) {
    const int t = blockIdx.x, e = threadIdx.x; const bf16_t* Y = (const bf16_t*)(ws + WS_Y) + ((size_t)CB * 2048 + t) * 1024;
    float d2[3] = {0.f, 0.f, 0.f}, r2[3] = {0.f, 0.f, 0.f};
    for (int c = e; c < 1024; c += 64) { const int seg = c < 384 ? 0 : (c < 640 ? 1 : 2); const float f = bf2f(Y[c]), r = ny[(size_t)t * 1024 + c];
        if (seg == 0) chk_add(f, r, d2[0], r2[0]); else if (seg == 1) chk_add(f, r, d2[1], r2[1]); else chk_add(f, r, d2[2], r2[2]); }
    if (nseg == 3) { chk_commit(d2[0], r2[0], acc); chk_commit(d2[1], r2[1], acc + 2); chk_commit(d2[2], r2[2], acc + 4); }
    else chk_commit(d2[0] + d2[1] + d2[2], r2[0] + r2[1] + r2[2], acc);
}

__global__ void __launch_bounds__(64) chk_x(const float* nx, const unsigned char* ws, float* acc) {
    const int t = blockIdx.x, e = threadIdx.x; const bf16_t* X = (const bf16_t*)(ws + WS_XB) + ((size_t)CB * 2048 + t) * 1024; float d2 = 0.f, r2 = 0.f;
    for (int c = e; c < 1024; c += 64) chk_add(bf2f(X[c]), nx[(size_t)t * 1024 + c], d2, r2);
    chk_commit(d2, r2, acc);
}

__global__ void __launch_bounds__(512) chk_code(float* acc, int nst, const float* nout) {
    __shared__ float sh[512];
    float s = 0.f; for (int i = threadIdx.x; i < 2048 * 1024; i += 512) { float v = nout[i]; s += v * v; }
    sh[threadIdx.x] = s; __syncthreads();
    if (threadIdx.x == 0) { float tot = 0.f; for (int i = 0; i < 512; ++i) tot += sh[i]; float rms = sqrtf(tot / (2048.f * 1024.f)); if (!(rms > 1e-3f && rms < 1e3f)) rms = 1.f;
        int code = 0;
        for (int st = 0; st < nst; ++st) { const float d2 = acc[2 * st], r2 = acc[2 * st + 1]; if (r2 == 0.f && d2 == 0.f) { if ((st & 15) >= 9) continue; code = (st + 1) * 4 + 3; break; } const float err = d2 / fmaxf(r2, 1e-30f);
            const float tol = CHK_TOL(st);
            if (!(err <= tol)) { const int cls = !(err < 1.f) ? 3 : (err >= 0.1f ? 2 : (err >= 0.01f ? 1 : 0)); code = (st + 1) * 4 + cls; break; } }
        acc[2 * 40] = rms * 32.f * exp2f(0.5f * (float)code); }
}
__global__ void __launch_bounds__(512) chk_fill(const float* acc, float* out) {
    const float K = acc[2 * 40];
    for (size_t i = (size_t)blockIdx.x * 512 + threadIdx.x; i < (size_t)NTOK * 1024; i += (size_t)gridDim.x * 512) out[i] = (i & 1) ? -K : K;
}
#endif

#if TIME_PH != -1
#ifndef TIME_Q
#define TIME_Q 6.f
#endif
#ifndef TIME_CAL
#define TIME_CAL 1.0f
#endif
__global__ void __launch_bounds__(512) tm_fill(const unsigned long long* ts, float* out) {
    float T = 100.f; if (TIME_PH >= 0) { int a = TIME_PH, b = TIME_PH + 1;
#ifdef TIME_PH_END
        b = TIME_PH_END;
#endif
        T = (float)(ts[b] - ts[a]) * 0.01f; }
    T = exp2f(rintf(log2f(fmaxf(T, 1.f)) * TIME_Q) / TIME_Q);
    const float c = sqrtf(T) * TIME_CAL;
    for (size_t i = (size_t)blockIdx.x * 512 + threadIdx.x; i < (size_t)NTOK * 1024; i += (size_t)gridDim.x * 512) out[i] = (i & 1) ? -c : c;
}
#endif
static int g_grid = 0;
static bool setup_once(size_t ws_size) {
    if (g_grid) return g_grid > 0;
    if (ws_size < WS_END) { fprintf(stderr, "kernel_launch: workspace too small: %zu < %zu\n", ws_size, (size_t)WS_END); g_grid = -1; return false; }
    int dev = 0, cus = 0, per_cu = 0;
    if (hipGetDevice(&dev) != hipSuccess || hipDeviceGetAttribute(&cus, hipDeviceAttributeMultiprocessorCount, dev) != hipSuccess) { g_grid = -1; return false; }
    if (hipFuncSetAttribute((const void*)mk, hipFuncAttributeMaxDynamicSharedMemorySize, LDS_BYTES) != hipSuccess) { fprintf(stderr, "kernel_launch: hipFuncSetAttribute failed\n"); g_grid = -1; return false; }
    if (hipOccupancyMaxActiveBlocksPerMultiprocessor(&per_cu, (const void*)mk, 512, LDS_BYTES) != hipSuccess || per_cu < 1) { fprintf(stderr, "kernel_launch: occupancy query says %d\n", per_cu); }
    (void)hipGetLastError();
    g_grid = cus;
    return true;
}
static void launch_mk(const Args& a0, int lo, int hi, hipStream_t stream) { Args a = a0; a.ph_lo = lo; a.ph_hi = hi; hipLaunchKernelGGL(mk, dim3(g_grid), dim3(512), LDS_BYTES, stream, a); }

extern "C" void kernel_launch(void* const* d_in, const int* in_sizes, int n_in, void* d_out, int out_size, void* d_ws, size_t ws_size, hipStream_t stream) {
    if (!setup_once(ws_size)) return;
    unsigned char* ws = (unsigned char*)d_ws;
    (void)hipMemsetAsync(ws + WS_CTL, 0, ZERO_BYTES, stream);
    Args a{}; for (int i = 0; i < 30; ++i) a.in.p[i] = (const float*)d_in[i];
    a.out = (float*)d_out; a.ws = ws; a.ph_lo = 0; a.ph_hi = 0;
#if CHECK
    a.out = nullptr;
#endif
#if CHECK
    float* nb = (float*)d_out; size_t off = 0; NvScratch S;
    auto take = [&](size_t n) { float* p = nb + off; off += (n + 63) & ~(size_t)63; return p; };
    S.proj = take((size_t)2048 * DIN); S.h1 = take(2048 * 1024); S.qk = S.h1; S.hraw = S.qk + 2048 * 512; S.kn = S.hraw + 2048 * 256;
    S.kcmp = take(2 * 127 * 64); S.vcmp = take(2 * 127 * 64); S.dqn = take(2048 * 192); S.q = take(2048 * 576); S.dkvn = take(2048 * 128); S.kv = take(2048 * 768); S.x1 = S.dqn;
    S.krope = take(2048 * 32); S.y = take(2048 * 1024); S.xl = take(2048 * 1024); S.rt_e = (int*)take(2048 * 2); S.rt_w = take(2048 * 2);
    if (off * 4 > (size_t)NTOK * 1024 * 4) { fprintf(stderr, "naive scratch too big\n"); return; }
    float* acc = (float*)(ws + WS_CTL) + CW_CHK;
    launch_mk(a, 0, 1, stream);
    const float* nx_in = (const float*)d_in[0] + (size_t)CB * 2048 * 1024;
    int nst = 0;
    for (int l = 0; l < L_; ++l) {
        const int pb = 1 + l * NPH; const int sb = l * 16;
        launch_mk(a, pb + PH_INPROJ, pb + PH_INPROJ + 1, stream);
        naive_step(d_in, l, NS_INPROJ, nx_in, S.xl, S, stream);
        chk_proj<<<2048, 64, 0, stream>>>(S.proj, ws + WS_PRJ, (const float*)(ws + WS_SSQ + PT_DQ) + (size_t)l * 16384 * 4, (const float*)(ws + WS_SSQ + PT_DKV) + (size_t)l * 16384 * 2,
                                           (const float*)d_in[8] + l * 64, (const float*)d_in[9] + l * 64, (const float*)d_in[19] + l * 192 + 160, (const int*)d_in[1], acc + 2 * (sb + 0));
        nst = sb + 2;
        int ns_done = NS_INPROJ;
#if CHECK_UPTO >= 1
        launch_mk(a, pb + PH_PREP, pb + PH_PREP + 1, stream);
        naive_step(d_in, l, NS_NSAPREP, nx_in, S.xl, S, stream); naive_step(d_in, l, NS_MLAPREP, nx_in, S.xl, S, stream); ns_done = NS_MLAPREP;
        chk_prep<<<2048, 64, 0, stream>>>(S.q, S.kv, S.krope, S.kcmp, S.vcmp, ws, acc + 2 * (sb + 2));
        nst = sb + 4;
#endif
#if CHECK_UPTO >= 2
        launch_mk(a, pb + PH_MIX, pb + PH_MIX + 1, stream);
        naive_step(d_in, l, NS_NSA, nx_in, S.xl, S, stream); naive_step(d_in, l, NS_ML, nx_in, S.xl, S, stream); naive_step(d_in, l, NS_MLA, nx_in, S.xl, S, stream); ns_done = NS_MLA;
        chk_y<<<2048, 64, 0, stream>>>(S.y, ws, acc + 2 * (sb + 4), 3);
        nst = sb + 7;
#endif
#if CHECK_UPTO >= 3
        launch_mk(a, pb + PH_YNORM, pb + PH_YNORM + 1, stream); launch_mk(a, pb + PH_OUTPROJ, pb + PH_OUTPROJ + 1, stream);
        naive_step(d_in, l, NS_OUT, nx_in, S.xl, S, stream); ns_done = NS_OUT;
        chk_x<<<2048, 64, 0, stream>>>(S.x1, ws, acc + 2 * (sb + 7));
        nst = sb + 8;
#endif
#if CHECK_UPTO >= 4
        for (int ph = PH_ROUTE; ph <= PH_COMBINE; ++ph) launch_mk(a, pb + ph, pb + ph + 1, stream);
        naive_step(d_in, l, NS_ROUTE, nx_in, S.xl, S, stream); naive_step(d_in, l, NS_MOE, nx_in, S.xl, S, stream); ns_done = NS_MOE;
        chk_x<<<2048, 64, 0, stream>>>(S.xl, ws, acc + 2 * (sb + 8));
        nst = sb + 9;
#endif
        CHECK_REST
        for (int s = ns_done + 1; s <= NS_MOE; ++s) naive_step(d_in, l, s, nx_in, S.xl, S, stream);
        nx_in = S.xl;
        if (l == CHECK_LAYERS - 1) break;
    }
    chk_code<<<1, 512, 0, stream>>>(acc, nst, S.xl);
    chk_fill<<<1024, 512, 0, stream>>>(acc, (float*)d_out);
#else
#if defined(SPLIT_LAUNCH) && SPLIT_LAUNCH
    for (int ph = 0; ph < 1 + L_ * NPH; ++ph) launch_mk(a, ph, ph + 1, stream);
#else
    launch_mk(a, 0, 1 + L_ * NPH, stream);
#if TIME_PH != -1
    (void)hipMemsetAsync(ws + WS_CTL, 0, ZERO_BYTES, stream); launch_mk(a, 0, 1 + L_ * NPH, stream);
    tm_fill<<<1024, 512, 0, stream>>>((const unsigned long long*)((unsigned*)(ws + WS_CTL) + CW_TS), (float*)d_out);
#endif
#endif
#endif
}
```

```cpp
#define CHECK 0
#define CHECK_LAYERS 2
#define CHECK_UPTO 99
#define SPLIT_LAUNCH 0
#define REPEAT_PH -1
#include <hip/hip_runtime.h>
#include <stdint.h>
#include <cstdio>

constexpr int B_ = 8, T_ = 2048, D_ = 1024, L_ = 2, NTOK = B_ * T_;
constexpr int DIN = 2554;
constexpr int O_AQ = 0, O_AKV = 384, O_AG = 1152, O_BQK = 1170, O_BV = 1682, O_BIF = 1938, O_BO = 1946, O_CDQ = 2202, O_CDKV = 2394, O_CKR = 2522;

typedef unsigned short bf16_t;
typedef short bf16x8 __attribute__((ext_vector_type(8)));
typedef short s16x4 __attribute__((ext_vector_type(4)));
typedef float f32x4 __attribute__((ext_vector_type(4)));
typedef float f32x16 __attribute__((ext_vector_type(16)));
typedef unsigned u32x4 __attribute__((ext_vector_type(4)));
typedef unsigned u32x2 __attribute__((ext_vector_type(2)));
typedef float f32x2_t __attribute__((ext_vector_type(2)));
typedef __bf16 bf16x2_t __attribute__((ext_vector_type(2)));
#define LAS __attribute__((address_space(3)))

__device__ __forceinline__ unsigned pk_bf16(float lo, float hi) { f32x2_t v = {lo, hi}; bf16x2_t b = __builtin_convertvector(v, bf16x2_t); return __builtin_bit_cast(unsigned, b); }
__device__ __forceinline__ float bf_lo(unsigned u) { return __builtin_bit_cast(float, u << 16); }
__device__ __forceinline__ float bf_hi(unsigned u) { return __builtin_bit_cast(float, u & 0xffff0000u); }
__device__ __forceinline__ float bf2f(bf16_t h) { return __builtin_bit_cast(float, (unsigned)h << 16); }
__device__ __forceinline__ bf16_t f2bf(float f) { return (bf16_t)(pk_bf16(f, 0.f) & 0xffffu); }
__device__ __forceinline__ float wave_sum(float v) { for (int o = 32; o; o >>= 1) v += __shfl_xor(v, o); return v; }
__device__ __forceinline__ float wave_max(float v) { for (int o = 32; o; o >>= 1) v = fmaxf(v, __shfl_xor(v, o)); return v; }
__device__ __forceinline__ float siluf(float x) { return x / (1.f + __expf(-x)); }
__device__ __forceinline__ float sigmf(float x) { return 1.f / (1.f + __expf(-x)); }
__device__ __forceinline__ int t5b(int dist) {
    int n = dist > 0 ? dist : 0; if (n < 16) return n;
    float v = logf((float)n / 16.f) / logf(8.f) * 16.f; int l = 16 + (int)v; return l < 31 ? l : 31;
}

__device__ __forceinline__ int lane_now() { return (int)__builtin_amdgcn_mbcnt_hi(~0u, __builtin_amdgcn_mbcnt_lo(~0u, 0u)); }
#define TIDX ((g_wv << 6) | lane_now())

constexpr size_t WS_CTL = 0, CTL_BYTES = 65536;
constexpr size_t WS_SSQ = WS_CTL + CTL_BYTES;
constexpr size_t ZERO_BYTES = CTL_BYTES;
constexpr size_t PT_DQ = 0, PT_DKV = PT_DQ + (size_t)2 * 16384 * 4 * 4, PT_A = PT_DKV + (size_t)2 * 16384 * 2 * 4, PT_C = PT_A + (size_t)2 * 16384 * 8 * 4, PT_X1 = PT_C + (size_t)2 * 16384 * 8 * 4, PT_END = PT_X1 + (size_t)2 * 16384 * 16 * 4;
constexpr size_t WS_SSQX = WS_SSQ + PT_END;
constexpr size_t WS_RS2 = WS_SSQX + 2 * 65536;
constexpr size_t WS_WIN = WS_RS2 + 65536;
constexpr size_t WS_WOUT = WS_WIN + (size_t)2 * 2560 * 1024 * 2;
constexpr size_t WS_WUQ = WS_WOUT + (size_t)2 * 1024 * 1024 * 2;
constexpr size_t WS_WUKV = WS_WUQ + (size_t)2 * 768 * 256 * 2;
constexpr size_t WS_WC1 = WS_WUKV + (size_t)2 * 768 * 256 * 2;
constexpr size_t WS_WC2 = WS_WC1 + (size_t)2 * 2 * 64 * 2048 * 2;
constexpr size_t WS_WR = WS_WC2 + (size_t)2 * 2 * 64 * 64 * 2;
constexpr size_t WS_B1C = WS_WR + (size_t)2 * 64 * 1024 * 2;
constexpr size_t WS_BIASD = WS_B1C + 1024;
constexpr size_t WS_ROPE = WS_BIASD + 6 * 2048 * 4;
constexpr size_t WS_WMOE = WS_ROPE + (size_t)16384 * 32 * 4;
constexpr size_t WMOE_WD = (size_t)32 * 512 * 1024 * 2;
constexpr size_t WS_XB = WS_WMOE + 50331648;
constexpr size_t WS_MLA = WS_XB + 33554432;
constexpr size_t MLA_KM = (size_t)8 * 6 * 2048 * 96 * 2, MLA_VM = 2 * MLA_KM;
constexpr size_t WS_HBUF = WS_MLA;
constexpr size_t WS_PRJ = WS_MLA + 50331648;
constexpr size_t HM64 = (size_t)2048 * 64 * 2;
constexpr size_t PRJ_QN = 0;
constexpr size_t PRJ_KN1 = PRJ_QN + 48 * HM64, PRJ_VN1 = PRJ_KN1 + 16 * HM64, PRJ_KN2 = PRJ_VN1 + 16 * HM64, PRJ_VN2 = PRJ_KN2 + 16 * HM64;
constexpr size_t PRJ_VML = PRJ_VN2 + 16 * HM64;
constexpr size_t PRJ_OG = PRJ_VML + 32 * HM64;
constexpr size_t PRJ_KR = PRJ_OG + (size_t)16384 * 256 * 2;
constexpr size_t PRJ_GATES = PRJ_KR + (size_t)16384 * 32 * 2;
constexpr size_t PRJ_DEAD = PRJ_GATES + (size_t)16384 * 32 * 4;
constexpr size_t PRJ_C0K = PRJ_DEAD, PRJ_C0V = PRJ_C0K + 16 * HM64 + 8192;
constexpr size_t PRJ_RAWQK = PRJ_C0V + 16 * HM64 + 8192;
constexpr size_t PRJ_DQKV = PRJ_RAWQK + (size_t)16384 * 512 * 2;
constexpr size_t PRJ_END = PRJ_DQKV + (size_t)16384 * 384 * 2;
static_assert(PRJ_END - PRJ_DEAD >= 33554432, "Y fits the dead part of PRJ");
constexpr size_t WS_Y = WS_PRJ + PRJ_DEAD;
constexpr size_t WS_YBUF = WS_PRJ;
static_assert((size_t)2 * 16384 * 1024 * 2 <= PRJ_END, "YBUF fits the PRJ region");
constexpr size_t WS_ML = WS_PRJ + PRJ_END;
constexpr size_t ML_KC = 32 * HM64, ML_DELTA = 2 * ML_KC, ML_DN = ML_DELTA + (size_t)1024 * 4096 * 2, ML_G = ML_DN + (size_t)1024 * 64 * 4, ML_BL = ML_G + (size_t)8 * 4 * 2048 * 2 * 4, ML_CP = ML_BL + 4096, ML_NP = ML_CP + (size_t)1024 * 4096 * 2, ML_END = ML_NP + (size_t)1024 * 64 * 2;
constexpr size_t WS_CMP = WS_ML + ML_END;
constexpr size_t CMP_V = (size_t)8 * 2 * 128 * 64 * 2;
constexpr size_t WS_META = WS_CMP + 2 * CMP_V;
constexpr size_t META_W = (size_t)32 * 16384 * 4, META_RT = 2 * META_W;
constexpr size_t WS_END = WS_META + META_RT + (size_t)16384 * 16;
constexpr int CW_BAR = 0;
constexpr int CW_Q = 4096;
constexpr int CW_SCAN = 4608;
constexpr int CW_TS = 4864;
constexpr int CW_CHK = 5120;
constexpr int CW_CNT = 8192;
constexpr int LDS_BYTES = 147456;
constexpr int LDS_MISC = LDS_BYTES - 256;
#define XB_TMO      128
#define XB_XCNT(j)  (256  + 64 * (j))
#define XB_XSUB(j)  (1280 + 64 * (j))
#define XB_XGEN(j)  (2304 + 64 * (j))
#define XB_TOP      3328
#define XB_TOPGEN   3392
#define XCD_BAR_WORDS 3456
#define XB_SPIN_CAP (1u << 18)

__device__ __forceinline__ unsigned xb_ld(unsigned* p)              { return __hip_atomic_load(p, __ATOMIC_RELAXED, __HIP_MEMORY_SCOPE_AGENT); }
__device__ __forceinline__ unsigned xb_add(unsigned* p, unsigned v) { return __hip_atomic_fetch_add(p, v, __ATOMIC_RELAXED, __HIP_MEMORY_SCOPE_AGENT); }
__device__ __forceinline__ unsigned xb_xcc_id() { return (unsigned)__builtin_amdgcn_s_getreg((3 << 11) | 20) & 0xFu; }
#define XB_SPIN(cond, bar) do { unsigned _sp = 0; while (cond) { __builtin_amdgcn_s_sleep(1); \
    if ((++_sp & 255u) == 0u) { if (xb_ld(&(bar)[XB_TMO])) break; if (_sp > XB_SPIN_CAP) { atomicAdd(&(bar)[XB_TMO], 1u); break; } } } } while (0)

struct XcdBarrier {
    int g_wv; unsigned* bar; unsigned x;
    volatile LAS unsigned* st;
};

__device__ __forceinline__ XcdBarrier xcd_barrier_post(unsigned* bar, volatile LAS unsigned* st, int g_wv) {
    XcdBarrier b; b.g_wv = g_wv; b.bar = bar; b.x = xb_xcc_id(); b.st = st;
    if (TIDX == 0) (void)xb_add(&bar[XB_XCNT(b.x)], 1u);
    return b;
}
__device__ __forceinline__ void xcd_barrier_complete(unsigned* bar, unsigned x, unsigned& nloc, unsigned& nx) {
    const unsigned G = gridDim.x * gridDim.y * gridDim.z;
    unsigned sum, cnt, mine, sp = 0u;
    for (;;) {
        sum = 0u; cnt = 0u; mine = 0u;
#pragma unroll
        for (unsigned j = 0; j < 16; ++j) { const unsigned c = xb_ld(&bar[XB_XCNT(j)]); sum += c; cnt += (c > 0u) ? 1u : 0u; mine = (j == x) ? c : mine; }
        if (sum == G) break;
        __builtin_amdgcn_s_sleep(1);
        if ((++sp & 255u) == 0u) { if (xb_ld(&bar[XB_TMO])) break; if (sp > XB_SPIN_CAP) { atomicAdd(&bar[XB_TMO], 1u); break; } }
    }
    nloc = mine > 0u ? mine : 1u; nx = cnt > 0u ? cnt : 1u;
}

__device__ __forceinline__ void xcd_barrier(const XcdBarrier& b) {
    asm volatile("s_waitcnt vmcnt(0)" ::: "memory");
    __syncthreads();
    const int g_wv = b.g_wv;
    if (TIDX == 0) {
        unsigned* bar = b.bar;
        __builtin_amdgcn_s_waitcnt(0);
        unsigned nloc = b.st[0], nx = b.st[1];
        if (nloc == 0u) { xcd_barrier_complete(bar, b.x, nloc, nx); b.st[0] = nloc; b.st[1] = nx; }
        const unsigned old = xb_add(&bar[XB_XSUB(b.x)], 1u);
        const unsigned gen = old / nloc;
        if (old + 1u == (gen + 1u) * nloc) {
            __builtin_amdgcn_fence(__ATOMIC_RELEASE, "agent");
            asm volatile("s_waitcnt vmcnt(0)" ::: "memory");
            const unsigned og = xb_add(&bar[XB_TOP], 1u);
            const unsigned tg = og / nx;
            if (og + 1u == (tg + 1u) * nx) xb_add(&bar[XB_TOPGEN], 1u);
            else XB_SPIN(xb_ld(&bar[XB_TOPGEN]) == tg, bar);
            __builtin_amdgcn_fence(__ATOMIC_ACQUIRE, "agent");
            xb_add(&bar[XB_XGEN(b.x)], 1u);
            asm volatile("s_waitcnt vmcnt(0)" ::: "memory");
        } else {
            XB_SPIN(xb_ld(&bar[XB_XGEN(b.x)]) == gen, bar);
            __builtin_amdgcn_fence(__ATOMIC_ACQUIRE, "agent");
            asm volatile("s_waitcnt vmcnt(0)" ::: "memory");
        }
    }
    __syncthreads();
}
struct Inputs { const float* p[30]; };
typedef const __attribute__((address_space(4))) Inputs* InPtr;
__device__ __forceinline__ InPtr in_tab() { InPtr p = (InPtr)__builtin_amdgcn_kernarg_segment_ptr(); asm volatile("" : "+s"(p)); return p; }
__device__ __forceinline__ unsigned char* launder(unsigned char* p) { asm volatile("" : "+s"(p)); return p; }

__host__ __device__ inline int inproj_refcol(int G, int e) {
    if (G < 6) return O_AQ + G * 64 + e;
    if (G < 18) return O_AKV + (G - 6) * 64 + e;
    if (G < 26) return O_BQK + (G - 18) * 64 + e;
    if (G < 30) return O_BV + (G - 26) * 64 + e;
    if (G < 34) return O_BO + (G - 30) * 64 + e;
    if (G < 37) return O_CDQ + (G - 34) * 64 + e;
    if (G == 37) { if (e < 32) return O_CKR + e; if (e < 50) return O_AG + (e - 32); if (e < 58) return O_BIF + (e - 50); return -1; }
    return O_CDKV + (G - 38) * 64 + e;
}
__host__ __device__ inline int uq_refcol(int G, int e) {
    if (G < 6) return G * 96 + e;
    if (G < 9) { const int idx = e & 31, bj = e >> 5, sub = idx >> 4, i = idx & 15; return (2 * (G - 6) + sub) * 96 + 64 + bj * 16 + i; }
    return -1;
}
__host__ __device__ inline int ukv_refcol(int G, int e) { return G < 6 ? G * 128 + e : (G - 6) * 128 + 64 + e; }
#define N2G(n) ((((n) >> 8) << 2) + (((n) >> 5) & 3))
#define N2E(n) (((((n) >> 7) & 1) << 5) + ((n) & 31))

struct FWin { const float* w; const float* g; __device__ __forceinline__ float operator()(int k, int n) const { const int c = inproj_refcol(N2G(n), N2E(n)); return c < 0 ? 0.f : w[(size_t)k * DIN + c] * g[k]; } };
struct FWout { const float* w; const float* ga; const float* gc; __device__ __forceinline__ float operator()(int k, int n) const { const float og = k < 384 ? ga[k] : (k < 640 ? 1.f : gc[k - 640]); return w[(size_t)k * 1024 + n] * og; } };
struct FWuq { const float* w; const float* g; __device__ __forceinline__ float operator()(int k, int n) const { const int c = uq_refcol(N2G(n), N2E(n)); return (k < 192 && c >= 0) ? w[(size_t)k * 576 + c] * g[k] : 0.f; } };
struct FWukv { const float* w; const float* g; __device__ __forceinline__ float operator()(int k, int n) const { const int c = ukv_refcol(N2G(n), N2E(n)); return k >= 128 ? w[(size_t)(k - 128) * 768 + c] * g[k - 128] : 0.f; } };
struct FWc1 { const float* w; __device__ __forceinline__ float operator()(int k, int n) const { return w[(size_t)k * 64 + n]; } };
struct FWr { const float* wg; const float* we; const float* g; __device__ __forceinline__ float operator()(int k, int n) const { return n < 4 ? wg[k * 4 + n] * g[k] : (n < 36 ? we[k * 32 + n - 4] * g[k] : 0.f); } };
struct FWgu { const float* src; const float* g; int n0, col0; __device__ __forceinline__ float operator()(int k, int n) const { return src[(size_t)k * 256 + col0 + (n - n0)] * g[k]; } };
struct FWd { const float* w; __device__ __forceinline__ float operator()(int k, int n) const { return w[(size_t)k * 1024 + n]; } };

__device__ __forceinline__ void rope_cs(int pos, int j, float& cs, float& sn) {
    const double inv = exp2(-(double)j * (13.287712379549449 / 16.0));
    const double rev = (double)pos * inv * 0.15915494309189535; const float f = (float)(rev - rint(rev));
    cs = __builtin_amdgcn_cosf(f); sn = __builtin_amdgcn_sinf(f);
}
template <class F>
__device__ __forceinline__ void cvt_tile(const F& f, int n0, int k0, bf16_t* dst, int ldk, LAS float* tile, int tid) {
    { const int k = tid >> 3, nb = (tid & 7) * 8;
#pragma unroll
      for (int j = 0; j < 8; ++j) tile[k * 65 + nb + j] = f(k0 + k, n0 + nb + j); }
    __syncthreads();
    { const int n = tid >> 3, kb = (tid & 7) * 8; const LAS float* s = tile + kb * 65 + n;
      u32x4 o; o.x = pk_bf16(s[0], s[65]); o.y = pk_bf16(s[130], s[195]); o.z = pk_bf16(s[260], s[325]); o.w = pk_bf16(s[390], s[455]);
      *(u32x4*)(dst + (size_t)(n0 + n) * ldk + k0 + kb) = o; }
    __syncthreads();
}
template <class F>
__device__ __forceinline__ void cvt_item(const F& f, int it, int nK, bf16_t* dst, int ldk, LAS float* tile, int tid) { cvt_tile(f, (it / nK) * 64, (it % nK) * 64, dst, ldk, tile, tid); }

__device__ __forceinline__ void moe_item(InPtr in, int l, int it, const float*& src, int& ld, size_t& dst, int& ldk, bool& gain) {
    if (it < 32 * 128) { const int e = it >> 7, r = it & 127, n0 = (r >> 4) * 64, k0 = (r & 15) * 64, c0 = n0 & 255;
        src = (c0 < 128 ? in->p[27] : in->p[28]) + ((size_t)l * 32 + e) * 262144 + (size_t)k0 * 256 + (n0 >> 8) * 128 + (c0 & 127); ld = 256; gain = true;
        dst = ((size_t)e * 512 + n0) * 1024 + k0; ldk = 1024; }
    else { const int j = it - 32 * 128, e = j >> 6, r = j & 63, n0 = (r >> 2) * 64, k0 = (r & 3) * 64;
        src = in->p[29] + ((size_t)l * 32 + e) * 262144 + (size_t)k0 * 1024 + n0; ld = 1024; gain = false;
        dst = (size_t)16777216 + ((size_t)e * 1024 + n0) * 256 + k0; ldk = 256; }
}
__device__ __forceinline__ void cvt_moe_layer(InPtr in, unsigned char* ws, int l, LAS float* tile, int bid, int nb, int tid) {
    asm volatile("" : "+v"(tid));
    const float* g2 = in->p[22] + l * 1024; bf16_t* W = (bf16_t*)(ws + WS_WMOE);
    const int k = tid >> 3, nbq = (tid & 7) * 8;
    const int n = tid >> 3, kb = (tid & 7) * 8;
    constexpr int NIT = 32 * (128 + 64);
    int it = bid; f32x4 v0, v1; const float* src; int ld, ldk; size_t dst = 0; bool gain; float gk = 1.f; int kk0 = 0;
    if (it < NIT) { moe_item(in, l, it, src, ld, dst, ldk, gain); v0 = *(const f32x4*)(src + (size_t)k * ld + nbq); v1 = *(const f32x4*)(src + (size_t)k * ld + nbq + 4);
        kk0 = it < 32 * 128 ? ((it & 127) & 15) * 64 : 0; gk = gain ? g2[kk0 + k] : 1.f; }
    int buf = 0;
    for (; it < NIT; it += nb) {
        LAS float* t = tile + buf * (64 * 65);
        t[k * 65 + nbq + 0] = v0.x * gk; t[k * 65 + nbq + 1] = v0.y * gk; t[k * 65 + nbq + 2] = v0.z * gk; t[k * 65 + nbq + 3] = v0.w * gk;
        t[k * 65 + nbq + 4] = v1.x * gk; t[k * 65 + nbq + 5] = v1.y * gk; t[k * 65 + nbq + 6] = v1.z * gk; t[k * 65 + nbq + 7] = v1.w * gk;
        const size_t cdst = dst; const int cldk = ldk;
        __syncthreads();
        const int itn = it + nb;
        if (itn < NIT) { moe_item(in, l, itn, src, ld, dst, ldk, gain); v0 = *(const f32x4*)(src + (size_t)k * ld + nbq); v1 = *(const f32x4*)(src + (size_t)k * ld + nbq + 4);
            kk0 = itn < 32 * 128 ? ((itn & 127) & 15) * 64 : 0; gk = gain ? g2[kk0 + k] : 1.f; }
        const LAS float* s = t + kb * 65 + n;
        u32x4 o; o.x = pk_bf16(s[0], s[65]); o.y = pk_bf16(s[130], s[195]); o.z = pk_bf16(s[260], s[325]); o.w = pk_bf16(s[390], s[455]);
        *(u32x4*)(W + cdst + (size_t)n * cldk + kb) = o;
        buf ^= 1;
    }
    __syncthreads();
}

__device__ __forceinline__ void cvt_small_weights(InPtr in, unsigned char* ws, int l, LAS float* tile, int bid, int nb, int tid) {
    asm volatile("" : "+v"(tid));
    constexpr int I_WIN = 40 * 16, I_WOUT = 16 * 16, I_WU = 12 * 4, I_WC1 = 32, I_WC2 = 1, I_WR = 16;
    constexpr int PER_L = I_WIN + I_WOUT + 2 * I_WU + 2 * I_WC1 + 2 * I_WC2 + I_WR;
    for (int it0 = bid; it0 < PER_L; it0 += nb) {
        int it = it0;
        if (it < I_WIN) { FWin f{in->p[4] + (size_t)l * 1024 * DIN, in->p[3] + l * 1024}; cvt_item(f, it, 16, (bf16_t*)(ws + WS_WIN) + (size_t)l * 2560 * 1024, 1024, tile, tid); continue; } it -= I_WIN;
        if (it < I_WOUT) { FWout f{in->p[21] + (size_t)l * 1048576, in->p[10] + l * 384, in->p[20] + l * 384}; cvt_item(f, it, 16, (bf16_t*)(ws + WS_WOUT) + (size_t)l * 1048576, 1024, tile, tid); continue; } it -= I_WOUT;
        if (it < I_WU) { FWuq f{in->p[16] + (size_t)l * 192 * 576, in->p[15] + l * 192}; cvt_item(f, it, 4, (bf16_t*)(ws + WS_WUQ) + (size_t)l * 768 * 256, 256, tile, tid); continue; } it -= I_WU;
        if (it < I_WU) { FWukv f{in->p[18] + (size_t)l * 128 * 768, in->p[17] + l * 128}; cvt_item(f, it, 4, (bf16_t*)(ws + WS_WUKV) + (size_t)l * 768 * 256, 256, tile, tid); continue; } it -= I_WU;
        if (it < 2 * I_WC1) { const int s = it / I_WC1; FWc1 f{in->p[6] + ((size_t)l * 2 + s) * 2048 * 64}; cvt_item(f, it % I_WC1, 32, (bf16_t*)(ws + WS_WC1) + ((size_t)l * 2 + s) * 64 * 2048, 2048, tile, tid); continue; } it -= 2 * I_WC1;
        if (it < 2 * I_WC2) { const int s = it; FWc1 f{in->p[7] + ((size_t)l * 2 + s) * 64 * 64}; cvt_item(f, 0, 1, (bf16_t*)(ws + WS_WC2) + ((size_t)l * 2 + s) * 64 * 64, 64, tile, tid); continue; } it -= 2 * I_WC2;
        { FWr f{in->p[23] + (size_t)l * 4096, in->p[25] + (size_t)l * 32768, in->p[22] + l * 1024}; cvt_item(f, it, 16, (bf16_t*)(ws + WS_WR) + (size_t)l * 64 * 1024, 1024, tile, tid); }
    }
}

__device__ __forceinline__ void prologue(InPtr in, unsigned char* ws, LAS unsigned char* lds, int bid, int nb, int g_wv) {
    int tid_ = TIDX; asm volatile("" : "+v"(tid_));
    const int tid = tid_, lane = tid & 63, wid = tid >> 6;
    LAS float* tile = (LAS float*)lds;
    cvt_small_weights(in, ws, 0, tile, bid, nb, tid);
    { const float* x = in->p[0]; bf16_t* XB = (bf16_t*)(ws + WS_XB); float* ssqx = (float*)(ws + WS_SSQX);
      for (int r = bid * 8 + wid; r < NTOK; r += nb * 8) {
          const f32x4* xr = (const f32x4*)(x + (size_t)r * 1024) + lane; float s = 0.f; u32x2* o = (u32x2*)(XB + (size_t)r * 1024) + lane;
#pragma unroll
          for (int j = 0; j < 4; ++j) { const f32x4 v = xr[64 * j]; s += (v.x * v.x + v.y * v.y) + (v.z * v.z + v.w * v.w); u32x2 w; w.x = pk_bf16(v.x, v.y); w.y = pk_bf16(v.z, v.w); o[64 * j] = w; }
          s = wave_sum(s); if (lane == 0) ssqx[r] = s;
      } }
    { float* biasd = (float*)(ws + WS_BIASD); const float* rb = in->p[2];
      for (int i = bid * 512 + tid; i < 6 * 2048; i += nb * 512) { const int h = i >> 11, d = i & 2047; biasd[i] = rb[t5b(d) * 6 + h] * 1.44269504f; } }
    { float* rope = (float*)(ws + WS_ROPE); const int* pos = (const int*)in->p[1];
      for (int i = bid * 512 + tid; i < NTOK * 16; i += nb * 512) { const int tk = i >> 4, j = i & 15; float cs, sn; rope_cs(pos[tk], j, cs, sn); rope[(size_t)tk * 32 + j] = cs; rope[(size_t)tk * 32 + 16 + j] = sn; } }
    { float* b1c = (float*)(ws + WS_B1C); LAS float* red = (LAS float*)lds;
      for (int it = bid; it < 4; it += nb) { const float* pe = in->p[5] + (size_t)it * 2048; const float* w1 = in->p[6] + (size_t)it * 2048 * 64; const int f = tid & 63, part = tid >> 6;
          float a = 0.f; for (int k = part * 256; k < part * 256 + 256; ++k) a += pe[k] * w1[(size_t)k * 64 + f];
          __syncthreads(); red[tid] = a; __syncthreads();
          if (tid < 64) { float s = 0.f; for (int p2 = 0; p2 < 8; ++p2) s += red[p2 * 64 + tid]; b1c[it * 64 + tid] = s; }
          __syncthreads(); } }
}
namespace g8 {
constexpr int BM = 256, BK = 64, HALF = 128, HTB = HALF * BK * 2, STAGE_BYTES = 8 * HTB, NXCD = 8, WGM = 8;
__host__ __device__ __forceinline__ int lds_byte(int r, int c) { const int st = (r >> 4) * 2 + (c >> 5), rr = r & 15, cc = c & 31, ob = rr * 64 + cc * 2; return st * 1024 + (ob ^ (((ob >> 9) & 1) << 5)); }
__host__ __device__ __forceinline__ void stage_rc(int b, int& R, int& C) { const int st = b / 1024, sb = b % 1024, swz = sb ^ (((sb >> 9) & 1) << 5); R = (st >> 1) * 16 + swz / 64; C = (st & 1) * 32 + (swz % 64) / 2; }
__host__ __device__ __forceinline__ int perm32(int rho) { const int n = rho >> 4, i = rho & 15; return 8 * (i >> 2) + 4 * n + (i & 3); }

struct GUnit { const char* a; const char* b; int pm, pn, e, rows; };

__device__ __forceinline__ bool static_unit(int i, int G, int c, int nM, int nN, int& pm, int& pn) {
    const int nwg = nM * nN; const long L = (long)i * G + c; if (L >= nwg) return false;
    int wgid = (int)L; { const int q = nwg / NXCD, r = nwg % NXCD, xcd = wgid % NXCD, off = wgid / NXCD; wgid = (xcd < r ? xcd * (q + 1) : r * (q + 1) + (xcd - r) * q) + off; }
    const int nig = WGM * nN, gid = wgid / nig, fm = gid * WGM, gsz = (nM - fm) < WGM ? (nM - fm) : WGM;
    pm = fm + ((wgid % nig) % gsz); pn = (wgid % nig) / gsz; return true;
}
struct DenseSched {
    static constexpr bool GATHER = false, PARTIAL = false;
    const char* A; const char* Bt; int lda, ldb, nM, nN, G, c;
    __device__ __forceinline__ bool next(int i, GUnit& u) const {
        int pm, pn; if (!static_unit(i, G, c, nM, nN, pm, pn)) return false;
        u.pm = pm; u.pn = pn; u.e = 0; u.rows = 256; u.a = A + (size_t)pm * 256 * lda * 2; u.b = Bt + (size_t)pn * 256 * ldb * 2; return true;
    }
    __device__ __forceinline__ void aoff(const GUnit&, unsigned (&v)[2][2], const int (&R)[2], const int (&C)[2]) const {
#pragma unroll
        for (int h = 0; h < 2; ++h)
#pragma unroll
            for (int i = 0; i < 2; ++i) v[h][i] = (unsigned)((h * 128 + R[i]) * lda + C[i]) * 2u;
    }
};

template <class Epi, class Sched>
__device__ __forceinline__ void gemm_run(LAS unsigned char* lds, const int K, const int ldb, const Sched& S, const Epi& E, int g_wv) {
    int tid_ = TIDX; asm volatile("" : "+v"(tid_));
    const int tid = tid_, wid = __builtin_amdgcn_readfirstlane(tid >> 6), lane = tid & 63, wr = wid >> 2, wc = wid & 3, fr = lane & 15, fq = lane >> 4;
    int nt_ = K / BK; asm volatile("" : "+s"(nt_));
    const int nt = nt_;
    int R[2], C[2]; unsigned voffB[2];
#pragma unroll
    for (int i = 0; i < 2; ++i) { stage_rc(tid * 16 + i * 8192, R[i], C[i]); const int Rb = (R[i] & ~31) + perm32(R[i] & 31); voffB[i] = (unsigned)(Rb * ldb + C[i]) * 2u; }
    const size_t kstep = (size_t)(BK * 2);
    const size_t hstepB = (size_t)HALF * ldb * 2;
    const unsigned ldsw = (unsigned)wid * 1024u;
    const int aoff = lds_byte(wr * 64 + fr, fq * 8), boff = lds_byte(wc * 32 + fr, fq * 8);
#define G8_SA(b, h) (((b) * 2 + (h)) * HTB)
#define G8_SB(b, h) ((4 + (b) * 2 + (h)) * HTB)
#define G8_GLDS(bufoff, gptr, i_) __builtin_amdgcn_global_load_lds((const unsigned*)(gptr), (LAS unsigned*)(lds + (bufoff) + ldsw + (i_) * 8192), 16, 0, 0)
#define G8_STAGE_B(bufoff, gbase) do { G8_GLDS(bufoff, (const char*)(gbase) + voffB[0], 0); G8_GLDS(bufoff, (const char*)(gbase) + voffB[1], 1); } while (0)
#define G8_STAGE_A(bufoff, gbase, v0, v1) do { G8_GLDS(bufoff, (const char*)(gbase) + (v0), 0); G8_GLDS(bufoff, (const char*)(gbase) + (v1), 1); } while (0)
#define G8_LDA(dst, b, h) do { _Pragma("unroll") for (int m = 0; m < 4; ++m) _Pragma("unroll") for (int k = 0; k < 2; ++k) dst[m][k] = *(const LAS bf16x8*)(lds + G8_SA(b, h) + aoff + m * 2048 + k * 1024); } while (0)
#define G8_LDB(dst, b, h) do { _Pragma("unroll") for (int n = 0; n < 2; ++n) _Pragma("unroll") for (int k = 0; k < 2; ++k) dst[n][k] = *(const LAS bf16x8*)(lds + G8_SB(b, h) + boff + n * 2048 + k * 1024); } while (0)
#define G8_MMA(ai, bj, At, Bt) do { __builtin_amdgcn_s_setprio(1); _Pragma("unroll") for (int m = 0; m < 4; ++m) { if (!PARTIAL || ((mmask >> ((ai) * 4 + m)) & 1u)) { _Pragma("unroll") for (int n = 0; n < 2; ++n) _Pragma("unroll") for (int k = 0; k < 2; ++k) \
        acc[ai][bj][m][n] = __builtin_amdgcn_mfma_f32_16x16x32_bf16(Bt[n][k], At[m][k], acc[ai][bj][m][n], 0, 0, 0); } } __builtin_amdgcn_s_setprio(0); } while (0)
#define G8_WAIT_V(n) asm volatile("s_waitcnt vmcnt(" #n ")" ::: "memory")
#define G8_WAIT_L(n) asm volatile("s_waitcnt lgkmcnt(" #n ")" ::: "memory")
#define G8_BAR __builtin_amdgcn_s_barrier()
#define G8_SCHED __builtin_amdgcn_sched_barrier(0)
    GUnit cur, nxt; int ui = 0;
    if (!S.next(0, cur)) return;
    constexpr bool GATHER = Sched::GATHER, PARTIAL = Sched::PARTIAL;
    unsigned mmask = 0xffu;
#define G8_MASK(u) do { if (PARTIAL) { mmask = 0u; _Pragma("unroll") for (int q_ = 0; q_ < 8; ++q_) mmask |= (((q_ >> 2) * 128 + wr * 64 + (q_ & 3) * 16) < (u).rows) ? (1u << q_) : 0u; } } while (0)
    unsigned vc[2][2];
    S.aoff(cur, vc, R, C); G8_MASK(cur);
    LAS u32x4* stash = (LAS u32x4*)(lds + STAGE_BYTES + 4096) + tid;
    f32x4 acc[2][2][4][2];
#pragma unroll
    for (int a = 0; a < 2; ++a)
#pragma unroll
        for (int b = 0; b < 2; ++b)
#pragma unroll
            for (int m = 0; m < 4; ++m)
#pragma unroll
                for (int n = 0; n < 2; ++n) acc[a][b][m][n] = (f32x4){0.f, 0.f, 0.f, 0.f};
    bf16x8 At[4][2], B0[2][2], B1[2][2];
    const char* cA = cur.a; const char* cB = cur.b;
    G8_STAGE_B(G8_SB(0, 0), cB); G8_STAGE_B(G8_SB(0, 1), cB + hstepB); G8_STAGE_A(G8_SA(0, 0), cA, vc[0][0], vc[0][1]); G8_STAGE_A(G8_SA(0, 1), cA, vc[1][0], vc[1][1]);
    if (wr == 1) G8_BAR;
    G8_WAIT_V(2); G8_BAR;
    G8_STAGE_B(G8_SB(1, 0), cB + kstep); G8_STAGE_A(G8_SA(1, 0), cA + kstep, vc[0][0], vc[0][1]); G8_STAGE_B(G8_SB(1, 1), cB + hstepB + kstep);
    G8_WAIT_V(6); G8_BAR;
    for (;;) {
        const bool has_next = S.next(ui + 1, nxt);
        if (GATHER) { unsigned vn[2][2];
            if (has_next) S.aoff(nxt, vn, R, C);
            else { vn[0][0] = vc[0][0]; vn[0][1] = vc[0][1]; vn[1][0] = vc[1][0]; vn[1][1] = vc[1][1]; }
            u32x4 sv; sv.x = vn[0][0]; sv.y = vn[0][1]; sv.z = vn[1][0]; sv.w = vn[1][1]; *stash = sv; }
        const char* nA = has_next ? nxt.a : cA; const char* nB = has_next ? nxt.b : cB;
#pragma unroll 1
        for (int t = 0; t < nt; t += 2) {
            const bool last = (t == nt - 2);
            const char* a1 = cA + (size_t)(t + 1) * kstep;
            const char* a2 = last ? nA : cA + (size_t)(t + 2) * kstep; const char* b2 = last ? nB : cB + (size_t)(t + 2) * kstep;
            const char* a3 = a2 + kstep; const char* b3 = b2 + kstep;
            unsigned w00 = vc[0][0], w01 = vc[0][1], w10 = vc[1][0], w11 = vc[1][1];
            if (GATHER) { if (last) { const u32x4 sv = *stash; w00 = sv.x; w01 = sv.y; w10 = sv.z; w11 = sv.w; } }
            G8_LDB(B0, 0, 0); G8_LDB(B1, 0, 1); G8_SCHED; G8_LDA(At, 0, 0); G8_STAGE_A(G8_SA(1, 1), a1, vc[1][0], vc[1][1]);
            G8_WAIT_V(8); G8_WAIT_L(0); G8_BAR; G8_MMA(0, 0, At, B0); G8_MMA(0, 1, At, B1); G8_BAR; G8_SCHED;
            G8_LDA(At, 0, 1); G8_STAGE_B(G8_SB(0, 0), b2); G8_STAGE_B(G8_SB(0, 1), b2 + hstepB); G8_STAGE_A(G8_SA(0, 0), a2, w00, w01);
            G8_WAIT_V(8); G8_WAIT_L(0); G8_BAR; G8_MMA(1, 0, At, B0); G8_MMA(1, 1, At, B1); G8_BAR; G8_SCHED;
            G8_LDB(B0, 1, 0); G8_LDB(B1, 1, 1); G8_SCHED; G8_LDA(At, 1, 0); G8_STAGE_A(G8_SA(0, 1), a2, w10, w11);
            G8_WAIT_V(8); G8_WAIT_L(0); G8_BAR; G8_MMA(0, 0, At, B0); G8_MMA(0, 1, At, B1); G8_BAR; G8_SCHED;
            G8_LDA(At, 1, 1); G8_STAGE_B(G8_SB(1, 0), b3); G8_STAGE_B(G8_SB(1, 1), b3 + hstepB); G8_STAGE_A(G8_SA(1, 0), a3, w00, w01);
            G8_WAIT_V(8); G8_WAIT_L(0); G8_BAR; G8_MMA(1, 0, At, B0); G8_MMA(1, 1, At, B1); G8_BAR; G8_SCHED;
        }
        if (wr == 0) G8_BAR;
        { int fr_ = fr, fq_ = fq; asm volatile("" : "+v"(fr_), "+v"(fq_));
          E(acc, cur, wr, wc, fr_, fq_); }
        if (!has_next) break;
#pragma unroll
        for (int a = 0; a < 2; ++a)
#pragma unroll
            for (int b = 0; b < 2; ++b)
#pragma unroll
                for (int m = 0; m < 4; ++m)
#pragma unroll
                    for (int n = 0; n < 2; ++n) acc[a][b][m][n] = (f32x4){0.f, 0.f, 0.f, 0.f};
        cur = nxt; cA = nA; cB = nB; ++ui; G8_MASK(cur);
        if (GATHER) { const u32x4 sv = *stash; vc[0][0] = sv.x; vc[0][1] = sv.y; vc[1][0] = sv.z; vc[1][1] = sv.w; }
        if (wr == 1) G8_BAR;
    }
    G8_WAIT_V(0);
    G8_BAR;
#undef G8_SA
#undef G8_SB
#undef G8_GLDS
#undef G8_STAGE_A
#undef G8_STAGE_B
#undef G8_LDA
#undef G8_LDB
#undef G8_MMA
#undef G8_MASK
#undef G8_WAIT_V
#undef G8_WAIT_L
#undef G8_BAR
#undef G8_SCHED
}
}
using g8::GUnit;
__device__ __forceinline__ void st_bf16x8(bf16_t* p, const float (&v)[8]) { u32x4 w; w.x = pk_bf16(v[0], v[1]); w.y = pk_bf16(v[2], v[3]); w.z = pk_bf16(v[4], v[5]); w.w = pk_bf16(v[6], v[7]); *(u32x4*)p = w; }
__device__ __forceinline__ float quad_sum(float s) { s += __shfl_xor(s, 16); s += __shfl_xor(s, 32); return s; }

struct EpiInProj {
    const float* ssqx; float* part_dq; float* part_dkv; const float* qg; const float* kg; const float* krg; const float* rope;
    unsigned char* prj;
    __device__ __forceinline__ void operator()(const f32x4 (&acc)[2][2][4][2], const GUnit& u, int wr, int wc, int fr, int fq) const {
        const int G = u.pn * 4 + wc;
        const bool isq = G < 6; const int a = G - 6; const bool isk = (G >= 10 && G < 18 && ((a >> 1) & 1) == 0);
        const float* g0 = (isq ? qg : kg) + 8 * fq;
        float rs8[8];
#pragma unroll
        for (int k = 0; k < 8; ++k) rs8[k] = ssqx[u.pm * 256 + (k >> 2) * 128 + wr * 64 + (k & 3) * 16 + fr];
#pragma unroll
        for (int k = 0; k < 8; ++k) rs8[k] = rsqrtf(rs8[k] * (1.f / 1024.f) + 1e-6f);
#pragma unroll
        for (int ai = 0; ai < 2; ++ai)
#pragma unroll
            for (int m = 0; m < 4; ++m) {
                __builtin_amdgcn_sched_barrier(0);
                const int row = u.pm * 256 + ai * 128 + wr * 64 + m * 16 + fr; const int b = row >> 11, t = row & 2047;
                const float rs = rs8[ai * 4 + m];
                float v[2][8];
#pragma unroll
                for (int bj = 0; bj < 2; ++bj)
#pragma unroll
                    for (int n = 0; n < 2; ++n)
#pragma unroll
                        for (int j = 0; j < 4; ++j) v[bj][4 * n + j] = acc[ai][bj][m][n][j] * rs;
                float ss = 0.f;
#pragma unroll
                for (int bj = 0; bj < 2; ++bj)
#pragma unroll
                    for (int i = 0; i < 8; ++i) ss += v[bj][i] * v[bj][i];
                bf16_t* dst = nullptr; int bstride = 32;
                if (isq) {
                    ss = quad_sum(ss); const float sc = rsqrtf(ss * (1.f / 64.f) + 1e-6f) * 0.18033688f;
#pragma unroll
                    for (int i = 0; i < 8; ++i) { v[0][i] *= sc * g0[i]; v[1][i] *= sc * g0[32 + i]; }
                    dst = (bf16_t*)(prj + PRJ_QN) + ((size_t)(b * 6 + G) * 2048 + t) * 64;
                } else if (G < 18) {
                    const int br = a >> 2, s = (a >> 1) & 1, hk = a & 1;
                    if (br > 0 && s == 0) {
                        ss = quad_sum(ss); const float sc = rsqrtf(ss * (1.f / 64.f) + 1e-6f);
#pragma unroll
                        for (int i = 0; i < 8; ++i) { v[0][i] *= sc * g0[i]; v[1][i] *= sc * g0[32 + i]; }
                    }
                    const size_t base = br == 0 ? (s ? PRJ_C0V : PRJ_C0K) : (br == 1 ? (s ? PRJ_VN1 : PRJ_KN1) : (s ? PRJ_VN2 : PRJ_KN2));
                    dst = (bf16_t*)(prj + base) + ((size_t)(b * 2 + hk) * 2048 + t) * 64;
                } else if (G < 26) { dst = (bf16_t*)(prj + PRJ_RAWQK) + (size_t)row * 512 + (G - 18) * 64; }
                else if (G < 30) { dst = (bf16_t*)(prj + PRJ_VML) + ((size_t)(b * 4 + (G - 26)) * 2048 + t) * 64; }
                else if (G < 34) { dst = (bf16_t*)(prj + PRJ_OG) + (size_t)row * 256 + (G - 30) * 64; }
                else if (G < 37) { dst = (bf16_t*)(prj + PRJ_DQKV) + (size_t)row * 384 + (G - 34) * 64; ss = quad_sum(ss); if (fq == 0) part_dq[(size_t)row * 4 + (G - 34)] = ss; }
                else if (G == 37) {
                    dst = (bf16_t*)(prj + PRJ_DQKV) + (size_t)row * 384 + 192;
                    float* gt = (float*)(prj + PRJ_GATES) + (size_t)row * 32 + 8 * fq;
                    *(f32x4*)gt = (f32x4){v[1][0], v[1][1], v[1][2], v[1][3]}; *(f32x4*)(gt + 4) = (f32x4){v[1][4], v[1][5], v[1][6], v[1][7]};
                    float s0 = 0.f;
#pragma unroll
                    for (int i = 0; i < 8; ++i) s0 += v[0][i] * v[0][i];
                    s0 = quad_sum(s0); const float sc = rsqrtf(s0 * (1.f / 32.f) + 1e-6f);
                    const float* rp = rope + (size_t)row * 32 + ((8 * fq) & 15);
                    float kr[8];
#pragma unroll
                    for (int i = 0; i < 8; ++i) { const float val = v[0][i] * sc * krg[8 * fq + i]; const float oth = __shfl_xor(val, 32); const float cs = rp[i], sn = rp[16 + i]; kr[i] = fq < 2 ? val * cs - oth * sn : val * cs + oth * sn; }
                    st_bf16x8((bf16_t*)(prj + PRJ_KR) + (size_t)row * 32 + 8 * fq, kr);
                } else { dst = (bf16_t*)(prj + PRJ_DQKV) + (size_t)row * 384 + 256 + (G - 38) * 64; ss = quad_sum(ss); if (fq == 0) part_dkv[(size_t)row * 2 + (G - 38)] = ss; }
                st_bf16x8(dst + 8 * fq, v[0]); st_bf16x8(dst + bstride + 8 * fq, v[1]);
            }
    }
};

struct EpiUq {
    const float* ssq_dq; const float* qkn; const float* rope; bf16_t* QM;
    __device__ __forceinline__ void operator()(const f32x4 (&acc)[2][2][4][2], const GUnit& u, int wr, int wc, int fr, int fq) const {
        const int G = u.pn * 4 + wc; if (G >= 9) return;
        const float scale = 0.14724444f;
        const float* g0 = G < 6 ? qkn + 8 * fq : qkn + 64 + 8 * (fq & 1); const float* g1 = G < 6 ? g0 + 32 : g0 + 16;
        float rs8[8];
#pragma unroll
        for (int k = 0; k < 8; ++k) { const f32x4 pq = *(const f32x4*)(ssq_dq + (size_t)(u.pm * 256 + (k >> 2) * 128 + wr * 64 + (k & 3) * 16 + fr) * 4); rs8[k] = (pq.x + pq.y) + pq.z; }
#pragma unroll
        for (int k = 0; k < 8; ++k) rs8[k] = rsqrtf(rs8[k] * (1.f / 192.f) + 1e-6f);
#pragma unroll
        for (int ai = 0; ai < 2; ++ai)
#pragma unroll
            for (int m = 0; m < 4; ++m) {
                __builtin_amdgcn_sched_barrier(0);
                const int row = u.pm * 256 + ai * 128 + wr * 64 + m * 16 + fr; const int b = row >> 11, t = row & 2047;
                const float rs = rs8[ai * 4 + m];
                float v[2][8]; float ss = 0.f;
#pragma unroll
                for (int bj = 0; bj < 2; ++bj)
#pragma unroll
                    for (int n = 0; n < 2; ++n)
#pragma unroll
                        for (int j = 0; j < 4; ++j) { const float x = acc[ai][bj][m][n][j] * rs; v[bj][4 * n + j] = x; ss += x * x; }
                if (G < 6) ss = quad_sum(ss); else ss += __shfl_xor(ss, 16);
                const float sc = rsqrtf(ss * (G < 6 ? 1.f / 64.f : 1.f / 32.f) + 1e-6f) * scale;
#pragma unroll
                for (int i = 0; i < 8; ++i) { v[0][i] *= sc * g0[i]; v[1][i] *= sc * g1[i]; }
                if (G < 6) {
                    bf16_t* dst = QM + ((size_t)(b * 6 + G) * 2048 + t) * 96;
                    st_bf16x8(dst + 8 * fq, v[0]); st_bf16x8(dst + 32 + 8 * fq, v[1]);
                } else {
                    const int i16 = 8 * (fq & 1); const int head = 2 * (G - 6) + (fq >> 1);
                    const float* rp = rope + (size_t)row * 32 + i16; float o1[8], o2[8];
#pragma unroll
                    for (int i = 0; i < 8; ++i) { const float cs = rp[i], sn = rp[16 + i]; o1[i] = v[0][i] * cs - v[1][i] * sn; o2[i] = v[1][i] * cs + v[0][i] * sn; }
                    bf16_t* dst = QM + ((size_t)(b * 6 + head) * 2048 + t) * 96 + 64 + i16;
                    st_bf16x8(dst, o1); st_bf16x8(dst + 16, o2);
                }
            }
    }
};
struct EpiUkv {
    const float* ssq_dkv; const float* qkn; const bf16_t* KR; bf16_t* KM; bf16_t* VM;
    __device__ __forceinline__ void operator()(const f32x4 (&acc)[2][2][4][2], const GUnit& u, int wr, int wc, int fr, int fq) const {
        const int G = u.pn * 4 + wc;
        const float* g0 = qkn + 96 + 8 * fq;
        float rs8[8];
#pragma unroll
        for (int k = 0; k < 8; ++k) { const size_t rr = (size_t)(u.pm * 256 + (k >> 2) * 128 + wr * 64 + (k & 3) * 16 + fr); rs8[k] = ssq_dkv[rr * 2] + ssq_dkv[rr * 2 + 1]; }
#pragma unroll
        for (int k = 0; k < 8; ++k) rs8[k] = rsqrtf(rs8[k] * (1.f / 128.f) + 1e-6f);
#pragma unroll
        for (int ai = 0; ai < 2; ++ai)
#pragma unroll
            for (int m = 0; m < 4; ++m) {
                __builtin_amdgcn_sched_barrier(0);
                const int row = u.pm * 256 + ai * 128 + wr * 64 + m * 16 + fr; const int b = row >> 11, t = row & 2047;
                const float rs = rs8[ai * 4 + m];
                float v[2][8]; float ss = 0.f;
#pragma unroll
                for (int bj = 0; bj < 2; ++bj)
#pragma unroll
                    for (int n = 0; n < 2; ++n)
#pragma unroll
                        for (int j = 0; j < 4; ++j) { const float x = acc[ai][bj][m][n][j] * rs; v[bj][4 * n + j] = x; ss += x * x; }
                if (G < 6) {
                    ss = quad_sum(ss); const float sc = rsqrtf(ss * (1.f / 64.f) + 1e-6f);
#pragma unroll
                    for (int i = 0; i < 8; ++i) { v[0][i] *= sc * g0[i]; v[1][i] *= sc * g0[32 + i]; }
                    bf16_t* dst = KM + ((size_t)(b * 6 + G) * 2048 + t) * 96;
                    st_bf16x8(dst + 8 * fq, v[0]); st_bf16x8(dst + 32 + 8 * fq, v[1]);
                    *(u32x4*)(dst + 64 + 8 * fq) = *(const u32x4*)(KR + (size_t)row * 32 + 8 * fq);
                } else {
                    bf16_t* dst = VM + ((size_t)(b * 6 + (G - 6)) * 2048 + t) * 64;
                    st_bf16x8(dst + 8 * fq, v[0]); st_bf16x8(dst + 32 + 8 * fq, v[1]);
                }
            }
    }
};
#define MFMA16(a, b, c) __builtin_amdgcn_mfma_f32_16x16x32_bf16(a, b, c, 0, 0, 0)
#define MFMA32(a, b, c) __builtin_amdgcn_mfma_f32_32x32x16_bf16(a, b, c, 0, 0, 0)
#define LDS_FENCE() asm volatile("s_waitcnt lgkmcnt(0)" ::: "memory")

__device__ __forceinline__ void cmp_unit(int u, int l, InPtr in, unsigned char* ws, LAS unsigned char* lds, int g_wv) {
    int tid_ = TIDX; asm volatile("" : "+v"(tid_));
    const int tid = tid_, w = tid >> 6, lane = tid & 63, r = lane & 15, q = lane >> 4;
    const int b = u >> 2, s = (u >> 1) & 1, hk = u & 1;
    const bf16_t* A = (const bf16_t*)(ws + WS_PRJ + (s ? PRJ_C0V : PRJ_C0K)) + (size_t)(b * 2 + hk) * 2048 * 64;
    const bf16_t* W1 = (const bf16_t*)(ws + WS_WC1) + ((size_t)l * 2 + s) * 64 * 2048;
    const bf16_t* W2 = (const bf16_t*)(ws + WS_WC2) + ((size_t)l * 2 + s) * 64 * 64;
    const float* b1 = (const float*)(ws + WS_B1C) + (l * 2 + s) * 64;
    f32x4 acc[4];
#pragma unroll
    for (int nb = 0; nb < 4; ++nb) acc[nb] = (f32x4){0.f, 0.f, 0.f, 0.f};
    const bf16_t* ap = A + (size_t)(16 * w + r) * 1024 + 8 * q;
    constexpr int WP = 528, WBUF = 64 * WP; LAS unsigned char* wb = lds + 24576;
    u32x4 st[4];
#pragma unroll
    for (int i = 0; i < 4; ++i) { const int c = tid + 512 * i; st[i] = *(const u32x4*)(W1 + (size_t)(c >> 5) * 2048 + (c & 31) * 8); }
#pragma unroll
    for (int i = 0; i < 4; ++i) { const int c = tid + 512 * i; *(LAS u32x4*)(wb + (c >> 5) * WP + (c & 31) * 16) = st[i]; }
    __syncthreads();
#pragma unroll 1
    for (int kc = 0; kc < 8; ++kc) {
        const int cur = kc & 1;
        if (kc < 7) {
#pragma unroll
            for (int i = 0; i < 4; ++i) { const int c = tid + 512 * i; st[i] = *(const u32x4*)(W1 + (size_t)(c >> 5) * 2048 + (kc + 1) * 256 + (c & 31) * 8); }
        }
        bf16x8 af[8];
#pragma unroll
        for (int ks = 0; ks < 8; ++ks) af[ks] = *(const bf16x8*)(ap + 256 * kc + 32 * ks);
#pragma unroll
        for (int ks = 0; ks < 8; ++ks)
#pragma unroll
            for (int nb = 0; nb < 4; ++nb) { const bf16x8 bb = *(const LAS bf16x8*)(wb + cur * WBUF + (16 * nb + r) * WP + (32 * ks + 8 * q) * 2); acc[nb] = MFMA16(af[ks], bb, acc[nb]); }
        if (kc < 7) {
#pragma unroll
            for (int i = 0; i < 4; ++i) { const int c = tid + 512 * i; *(LAS u32x4*)(wb + (cur ^ 1) * WBUF + (c >> 5) * WP + (c & 31) * 16) = st[i]; }
        }
        __syncthreads();
    }
    LAS bf16_t* hl = (LAS bf16_t*)(lds + w * 2304);
#pragma unroll
    for (int nb = 0; nb < 4; ++nb) { const float bias = b1[16 * nb + r];
#pragma unroll
        for (int j = 0; j < 4; ++j) hl[(4 * q + j) * 72 + 16 * nb + r] = f2bf(siluf(acc[nb][j] + bias)); }
    LDS_FENCE();
    f32x4 o[4];
#pragma unroll
    for (int nb = 0; nb < 4; ++nb) o[nb] = (f32x4){0.f, 0.f, 0.f, 0.f};
#pragma unroll
    for (int ks = 0; ks < 2; ++ks) {
        const bf16x8 a = *(const LAS bf16x8*)(hl + r * 72 + 32 * ks + 8 * q);
#pragma unroll
        for (int nb = 0; nb < 4; ++nb) { const bf16x8 bb = *(const bf16x8*)(W2 + (size_t)(16 * nb + r) * 64 + 32 * ks + 8 * q); o[nb] = MFMA16(a, bb, o[nb]); }
    }
    LDS_FENCE();
    const float* kg = in->p[9] + l * 64;
    bf16_t* dst = (bf16_t*)(ws + WS_CMP + (s ? CMP_V : 0)) + (size_t)(b * 2 + hk) * 128 * 64;
#pragma unroll
    for (int j = 0; j < 4; ++j) {
        const int n = 16 * w + 4 * q + j; float ss = 0.f;
#pragma unroll
        for (int nb = 0; nb < 4; ++nb) ss += o[nb][j] * o[nb][j];
        ss += __shfl_xor(ss, 1); ss += __shfl_xor(ss, 2); ss += __shfl_xor(ss, 4); ss += __shfl_xor(ss, 8);
        const float sc = s == 0 ? rsqrtf(ss * (1.f / 64.f) + 1e-6f) : 1.f;
#pragma unroll
        for (int nb = 0; nb < 4; ++nb) { const int d = 16 * nb + r; const float v = o[nb][j] * sc * (s == 0 ? kg[d] : 1.f); dst[(size_t)n * 64 + d] = n < 127 ? f2bf(v) : (bf16_t)0; }
    }
}

__device__ __forceinline__ int swz_off(int row, int chunk) { return row * 128 + ((chunk ^ (row & 7)) << 4); }
__device__ __forceinline__ float log_sigmoid(float x) { return fminf(x, 0.f) - log1pf(__expf(-fabsf(x))); }
__device__ __forceinline__ void ml_delta_wave(int cu, int l, InPtr in, unsigned char* ws, LAS unsigned char* wl, int lane) {
    const int c = cu & 31, bh = cu >> 5, h = bh & 3, b = bh >> 2; const int t0 = c * 64; const size_t row0 = (size_t)b * 2048 + t0;
    const float* G = (const float*)(ws + WS_PRJ + PRJ_GATES);
    const float ip = G[(row0 + lane) * 32 + 18 + h] + in->p[12][l * 4 + h], fp = G[(row0 + lane) * 32 + 22 + h] + in->p[13][l * 4 + h];
    float bcum = log_sigmoid(fp);
#pragma unroll
    for (int o = 1; o < 64; o <<= 1) { const float t = __builtin_bit_cast(float, __builtin_amdgcn_ds_bpermute(((lane - o) & 63) << 2, __builtin_bit_cast(int, bcum))); if (lane >= o) bcum += t; }
    const float bL = __builtin_bit_cast(float, __builtin_amdgcn_readlane(__builtin_bit_cast(int, bcum), 63)); const float wgt = __expf(bL - bcum + ip);
    { float* mlg = (float*)(ws + WS_ML + ML_G) + ((size_t)bh * 2048 + t0 + lane) * 2; mlg[0] = bcum; mlg[1] = ip; if (lane == 0) ((float*)(ws + WS_ML + ML_BL))[cu] = bL; }
    const bf16_t* raw = (const bf16_t*)(ws + WS_PRJ + PRJ_RAWQK); const float* cw = in->p[11] + (size_t)l * 4 * 512;
    float wq[4], wk[4];
#pragma unroll
    for (int j = 0; j < 4; ++j) { wq[j] = cw[j * 512 + h * 64 + lane]; wk[j] = cw[j * 512 + 256 + h * 64 + lane]; }
    float q3 = 0.f, q2 = 0.f, q1 = 0.f, k3 = 0.f, k2 = 0.f, k1 = 0.f;
    if (c > 0) { const bf16_t* p = raw + (row0 - 3) * 512 + h * 64 + lane; q3 = bf2f(p[0]); q2 = bf2f(p[512]); q1 = bf2f(p[1024]); k3 = bf2f(p[256]); k2 = bf2f(p[512 + 256]); k1 = bf2f(p[1024 + 256]); }
    bf16_t* QC = (bf16_t*)(ws + WS_ML) + ((size_t)bh * 2048 + t0) * 64 + lane; bf16_t* KC = (bf16_t*)(ws + WS_ML + ML_KC) + ((size_t)bh * 2048 + t0) * 64 + lane;
    const bf16_t* V = (const bf16_t*)(ws + WS_PRJ + PRJ_VML) + ((size_t)bh * 2048 + t0) * 64 + lane;
    float dn = 0.f;
    const bf16_t* rq = raw + row0 * 512 + h * 64 + lane;
    bf16_t cq[8], ck[8], cv[8], nq[8], nk[8], nv[8];
#pragma unroll
    for (int j = 0; j < 8; ++j) { cq[j] = rq[(size_t)j * 512]; ck[j] = rq[(size_t)j * 512 + 256]; cv[j] = V[(size_t)j * 64]; }
#pragma unroll 1
    for (int s8 = 0; s8 < 8; ++s8) {
        if (s8 < 7) {
#pragma unroll
            for (int j = 0; j < 8; ++j) { const int s = s8 * 8 + 8 + j; nq[j] = rq[(size_t)s * 512]; nk[j] = rq[(size_t)s * 512 + 256]; nv[j] = V[(size_t)s * 64]; }
        }
        float kb[8], vb[8]; bf16_t qo[8], ko[8];
#pragma unroll
        for (int j = 0; j < 8; ++j) {
            const int s = s8 * 8 + j;
            const float q0 = bf2f(cq[j]), k0 = bf2f(ck[j]);
            const float qv = siluf(wq[0] * q3 + wq[1] * q2 + wq[2] * q1 + wq[3] * q0), kv = siluf(wk[0] * k3 + wk[1] * k2 + wk[2] * k1 + wk[3] * k0) * 0.125f;
            q3 = q2; q2 = q1; q1 = q0; k3 = k2; k2 = k1; k1 = k0;
            qo[j] = f2bf(qv); ko[j] = f2bf(kv);
            const float ws_ = __builtin_bit_cast(float, __builtin_amdgcn_readlane(__builtin_bit_cast(int, wgt), s)); kb[j] = bf2f(ko[j]); dn += ws_ * kb[j]; vb[j] = ws_ * bf2f(cv[j]);
        }
#pragma unroll
        for (int j = 0; j < 8; ++j) { QC[(size_t)(s8 * 8 + j) * 64] = qo[j]; KC[(size_t)(s8 * 8 + j) * 64] = ko[j]; }
        u32x4 pk; pk.x = pk_bf16(kb[0], kb[1]); pk.y = pk_bf16(kb[2], kb[3]); pk.z = pk_bf16(kb[4], kb[5]); pk.w = pk_bf16(kb[6], kb[7]);
        *(LAS u32x4*)(wl + swz_off(lane, s8)) = pk;
        pk.x = pk_bf16(vb[0], vb[1]); pk.y = pk_bf16(vb[2], vb[3]); pk.z = pk_bf16(vb[4], vb[5]); pk.w = pk_bf16(vb[6], vb[7]);
        *(LAS u32x4*)(wl + 8192 + swz_off(lane, s8)) = pk;
#pragma unroll
        for (int j = 0; j < 8; ++j) { cq[j] = nq[j]; ck[j] = nk[j]; cv[j] = nv[j]; }
    }
    ((float*)(ws + WS_ML + ML_DN))[(size_t)cu * 64 + lane] = dn;
    LDS_FENCE();
    const int r = lane & 15, q = lane >> 4;
    bf16_t* DL = (bf16_t*)(ws + WS_ML + ML_DELTA) + (size_t)cu * 4096;
#pragma unroll
    for (int mb = 0; mb < 4; ++mb) {
        f32x4 acc[4];
#pragma unroll
        for (int nb = 0; nb < 4; ++nb) acc[nb] = (f32x4){0.f, 0.f, 0.f, 0.f};
#pragma unroll
        for (int ks = 0; ks < 2; ++ks) {
            const bf16x8 a = *(const LAS bf16x8*)(wl + 8192 + swz_off(16 * mb + r, 4 * ks + q));
#pragma unroll
            for (int nb = 0; nb < 4; ++nb) { const bf16x8 bb = *(const LAS bf16x8*)(wl + swz_off(16 * nb + r, 4 * ks + q)); acc[nb] = MFMA16(a, bb, acc[nb]); }
        }
#pragma unroll
        for (int nb = 0; nb < 4; ++nb)
#pragma unroll
            for (int j = 0; j < 4; ++j) DL[(16 * mb + 4 * q + j) * 64 + 16 * nb + r] = f2bf(acc[nb][j]);
    }
    LDS_FENCE();
}

#ifndef TIME_PH
#define TIME_PH -1
#endif
#define PSTAMP(i, blk) do { if (TIME_PH != -1 && l == 0 && blockIdx.x == (blk) && TIDX == 0) ((unsigned long long*)((unsigned*)(ws + WS_CTL) + CW_TS))[i] = __builtin_amdgcn_s_memrealtime(); } while (0)
__device__ __forceinline__ void phase_prep(int l, InPtr in, unsigned char* ws, LAS unsigned char* lds, int bid, int nb, int g_wv) {
    asm volatile("" : "+s"(bid));
    PSTAMP(40, 0);
#ifndef NO_UQ
    { g8::DenseSched S{(const char*)(ws + WS_PRJ + PRJ_DQKV), (const char*)(ws + WS_WUQ) + (size_t)l * 768 * 256 * 2, 384, 256, 64, 3, nb, bid};
      EpiUq E{(const float*)(ws + WS_SSQ + PT_DQ) + (size_t)l * 16384 * 4, in->p[19] + l * 192, (const float*)(ws + WS_ROPE), (bf16_t*)(ws + WS_MLA)};
      g8::gemm_run(lds, 256, 256, S, E, g_wv); }
#endif
    PSTAMP(41, 0);
#ifndef NO_UKV
    asm volatile("" : "+s"(bid));
    { g8::DenseSched S{(const char*)(ws + WS_PRJ + PRJ_DQKV) + 256, (const char*)(ws + WS_WUKV) + (size_t)l * 768 * 256 * 2, 384, 256, 64, 3, nb, bid};
      EpiUkv E{(const float*)(ws + WS_SSQ + PT_DKV) + (size_t)l * 16384 * 2, in->p[19] + l * 192, (const bf16_t*)(ws + WS_PRJ + PRJ_KR), (bf16_t*)(ws + WS_MLA + MLA_KM), (bf16_t*)(ws + WS_MLA + MLA_VM)};
      g8::gemm_run(lds, 256, 256, S, E, g_wv); }
#endif
    PSTAMP(42, 0); PSTAMP(44, 255);
    __syncthreads();
#ifndef NO_CMP
    for (int u = nb - 1 - bid; u < 32; u += nb) cmp_unit(u, l, in, ws, lds, g_wv);
#endif
    PSTAMP(45, 255);
    __syncthreads();
#ifndef NO_DELTA
    { int tid_ = TIDX; asm volatile("" : "+v"(tid_));
      for (int g = bid; g < 128; g += nb) ml_delta_wave(g * 8 + (tid_ >> 6), l, in, ws, lds + (tid_ >> 6) * 16384, tid_ & 63); }
#endif
    __syncthreads(); PSTAMP(43, 0);
}
#define CHK_TOL(st) (((st) & 15) == 8 ? 1e-2f : 1e-3f)
#define CHECK_REST
constexpr int VTP = 192;
typedef short v4i16_t __attribute__((ext_vector_type(4)));
__device__ __forceinline__ int vt_lane_off(int lane) { return (4 * (lane >> 5) + ((lane & 15) >> 2)) * VTP + ((((lane >> 4) & 1) * 16) + 4 * (lane & 3)) * 2; }
__device__ __forceinline__ bf16x8 vt_frag(const LAS unsigned char* Vt, int voff, int s4, int eb) {
    const LAS unsigned char* a = Vt + voff + 16 * s4 * VTP + 64 * eb;
    const v4i16_t lo = __builtin_amdgcn_ds_read_tr16_b64_v4i16((LAS v4i16_t*)a), hi = __builtin_amdgcn_ds_read_tr16_b64_v4i16((LAS v4i16_t*)(a + 8 * VTP));
    return (bf16x8){lo[0], lo[1], lo[2], lo[3], hi[0], hi[1], hi[2], hi[3]};
}
__device__ __forceinline__ int crow(int reg, int h) { return (reg & 3) + 8 * (reg >> 2) + 4 * h; }
struct AttnState { f32x16 o[2]; float m, l; };
__device__ __forceinline__ void attn_reset(AttnState& A) { A.m = -1e30f; A.l = 0.f;
#pragma unroll
    for (int i = 0; i < 16; ++i) { A.o[0][i] = 0.f; A.o[1][i] = 0.f; } }

template <int DK>
__device__ __forceinline__ void attn_scores(f32x16 (&s)[2], const bf16x8 (&qf)[DK / 16], const LAS unsigned char* Kt, int r, int h) {
    constexpr int KP = 2 * DK + 16, NK = DK / 16;
    bf16x8 kf[2][NK];
#pragma unroll
    for (int kb = 0; kb < 2; ++kb)
#pragma unroll
        for (int ks = 0; ks < NK; ++ks) kf[kb][ks] = *(const LAS bf16x8*)(Kt + (32 * kb + r) * KP + (16 * ks + 8 * h) * 2);
    __builtin_amdgcn_sched_barrier(0);
#pragma unroll
    for (int kb = 0; kb < 2; ++kb) {
#pragma unroll
        for (int i = 0; i < 16; ++i) s[kb][i] = 0.f;
#pragma unroll
        for (int ks = 0; ks < NK; ++ks) s[kb] = MFMA32(kf[kb][ks], qf[ks], s[kb]);
    }
}
__device__ __forceinline__ float max3f(float a, float b, float c) { return fmaxf(fmaxf(a, b), c); }
__device__ __forceinline__ void attn_softmax_pv(AttnState& A, f32x16 (&s)[2], const LAS unsigned char* Vt, int r, int h, float bias_c = 0.f, bool lane_ok = true) {
    constexpr float THR = 8.f; const int voff = vt_lane_off(r + 32 * h);
    float mx = max3f(s[0][0], s[0][1], s[0][2]);
#pragma unroll
    for (int i = 3; i < 15; i += 2) mx = max3f(mx, s[0][i], s[0][i + 1]);
    mx = max3f(mx, s[0][15], s[1][0]);
#pragma unroll
    for (int i = 1; i < 15; i += 2) mx = max3f(mx, s[1][i], s[1][i + 1]);
    mx = fmaxf(mx, s[1][15]);
    mx = fmaxf(mx, __shfl_xor(mx, 32));
    const float mxb = (lane_ok && mx > -1e29f) ? mx + bias_c : -1e30f;
    const bool grow = mxb > A.m + THR;
    const float mnew = grow ? mxb : A.m;
    if (__any(grow)) {
        const float alpha = __builtin_amdgcn_exp2f(A.m - mnew);
        A.l *= alpha;
#pragma unroll
        for (int i = 0; i < 16; ++i) { A.o[0][i] *= alpha; A.o[1][i] *= alpha; }
    }
    A.m = mnew;
    const float sub = (lane_ok && mnew > -1e29f) ? mnew - bias_c : 1e30f;
    float rs = 0.f;
#pragma unroll
    for (int kb = 0; kb < 2; ++kb)
#pragma unroll
        for (int i = 0; i < 16; ++i) { const float p = __builtin_amdgcn_exp2f(s[kb][i] - sub); s[kb][i] = p; rs += p; }
    rs += __shfl_xor(rs, 32);
    A.l += rs;
    bf16x8 vf[4][2];
#pragma unroll
    for (int s4 = 0; s4 < 4; ++s4)
#pragma unroll
        for (int eb = 0; eb < 2; ++eb) vf[s4][eb] = vt_frag(Vt, voff, s4, eb);
    __builtin_amdgcn_sched_barrier(0);
#pragma unroll
    for (int s4 = 0; s4 < 4; ++s4) {
        const int kb = s4 >> 1, hf = (s4 & 1) * 8;
        u32x4 pw; pw.x = pk_bf16(s[kb][hf + 0], s[kb][hf + 1]); pw.y = pk_bf16(s[kb][hf + 2], s[kb][hf + 3]); pw.z = pk_bf16(s[kb][hf + 4], s[kb][hf + 5]); pw.w = pk_bf16(s[kb][hf + 6], s[kb][hf + 7]);
        const bf16x8 pf = __builtin_bit_cast(bf16x8, pw);
#pragma unroll
        for (int eb = 0; eb < 2; ++eb) A.o[eb] = MFMA32(vf[s4][eb], pf, A.o[eb]);
    }
}
template <int DK>
__device__ __forceinline__ void stage_k_load(u32x4 (&kr)[2], const bf16_t* Kg  , int tid) {
    constexpr int CH = DK / 8;
    kr[0] = *(const u32x4*)(Kg + (size_t)(tid / CH) * DK + (tid % CH) * 8);
    if (64 * CH > 512) { const int c2 = tid + 512; if (c2 < 64 * CH) kr[1] = *(const u32x4*)(Kg + (size_t)(c2 / CH) * DK + (c2 % CH) * 8); }
}
template <int DK>
__device__ __forceinline__ void stage_k_store(const u32x4 (&kr)[2], LAS unsigned char* Kt, int tid) {
    constexpr int CH = DK / 8, KP = 2 * DK + 16;
    *(LAS u32x4*)(Kt + (tid / CH) * KP + (tid % CH) * 16) = kr[0];
    if (64 * CH > 512) { const int c2 = tid + 512; if (c2 < 64 * CH) *(LAS u32x4*)(Kt + (c2 / CH) * KP + (c2 % CH) * 16) = kr[1]; }
}
__device__ __forceinline__ u32x4 stage_v_load(const bf16_t* Vg, int tid) { return *(const u32x4*)(Vg + (size_t)(tid >> 3) * 64 + (tid & 7) * 8); }
__device__ __forceinline__ void stage_v_store(const u32x4& v, LAS unsigned char* Vt, int tid) { *(LAS u32x4*)(Vt + (tid >> 3) * VTP + (tid & 7) * 16) = v; }

constexpr int MLA_KT = 0, MLA_VT = 2 * 64 * 208, MLA_LDS = MLA_VT + 2 * 64 * VTP;
__device__ __forceinline__ void mla_unit(int b, int hd, int qt, int l, unsigned char* ws, LAS unsigned char* lds, int g_wv) {
    int tid_ = TIDX; asm volatile("" : "+v"(tid_));
    const int tid = tid_, w = tid >> 6, lane = tid & 63, r = lane & 31, h = lane >> 5;
    const size_t slab = (size_t)(b * 6 + hd) * 2048;
    const bf16_t* QM = (const bf16_t*)(ws + WS_MLA) + slab * 96; const bf16_t* KM = (const bf16_t*)(ws + WS_MLA + MLA_KM) + slab * 96; const bf16_t* VM = (const bf16_t*)(ws + WS_MLA + MLA_VM) + slab * 64;
    const int q0 = 256 * qt + 32 * w, q = q0 + r;
    bf16x8 qf[6];
#pragma unroll
    for (int ks = 0; ks < 6; ++ks) qf[ks] = *(const bf16x8*)(QM + (size_t)q * 96 + 16 * ks + 8 * h);
    AttnState A; attn_reset(A);
    const int ntile = 4 * qt + 4;
    u32x4 kr[2], vr, kr2[2], vr2;
    stage_k_load<96>(kr, KM, tid); vr = stage_v_load(VM, tid);
    stage_k_store<96>(kr, lds + MLA_KT, tid); stage_v_store(vr, lds + MLA_VT, tid);
    if (ntile > 1) { stage_k_load<96>(kr, KM + (size_t)64 * 96, tid); vr = stage_v_load(VM + (size_t)64 * 64, tid); }
    __syncthreads();
    for (int j = 0; j < ntile; ++j) {
        const int cur = j & 1;
        if (j + 2 < ntile) { stage_k_load<96>(kr2, KM + (size_t)(j + 2) * 64 * 96, tid); vr2 = stage_v_load(VM + (size_t)(j + 2) * 64 * 64, tid); }
        if (64 * j <= q0 + 31) {
            f32x16 s[2];
            attn_scores<96>(s, qf, lds + MLA_KT + cur * 64 * 208, r, h);
            if (64 * j + 63 > q0) {
#pragma unroll
                for (int kb = 0; kb < 2; ++kb)
#pragma unroll
                    for (int i = 0; i < 16; ++i) { const int key = 64 * j + 32 * kb + crow(i, h); if (key > q) s[kb][i] = -1e30f; }
            }
            attn_softmax_pv(A, s, lds + MLA_VT + cur * 64 * VTP, r, h);
        }
        if (j + 1 < ntile) { stage_k_store<96>(kr, lds + MLA_KT + (cur ^ 1) * 64 * 208, tid); stage_v_store(vr, lds + MLA_VT + (cur ^ 1) * 64 * VTP, tid); }
        kr[0] = kr2[0]; kr[1] = kr2[1]; vr = vr2;
        __syncthreads();
    }
    const float inv = A.l > 0.f ? 1.f / A.l : 0.f; float ss = 0.f;
    bf16_t* Y = (bf16_t*)(ws + WS_Y) + ((size_t)b * 2048 + q) * 1024 + 640 + hd * 64;
#pragma unroll
    for (int eb = 0; eb < 2; ++eb)
#pragma unroll
        for (int g4 = 0; g4 < 4; ++g4) {
            const float v0 = A.o[eb][4 * g4] * inv, v1 = A.o[eb][4 * g4 + 1] * inv, v2 = A.o[eb][4 * g4 + 2] * inv, v3 = A.o[eb][4 * g4 + 3] * inv;
            u32x2 pw; pw.x = pk_bf16(v0, v1); pw.y = pk_bf16(v2, v3);
            const float f0 = bf_lo(pw.x), f1 = bf_hi(pw.x), f2 = bf_lo(pw.y), f3 = bf_hi(pw.y); ss += (f0 * f0 + f1 * f1) + (f2 * f2 + f3 * f3);
            *(u32x2*)(Y + 32 * eb + 8 * g4 + 4 * h) = pw;
        }
    ss += __shfl_xor(ss, 32);
    if (h == 0) ((float*)(ws + WS_SSQ + PT_C))[((size_t)l * 16384 + (size_t)b * 2048 + q) * 8 + hd] = ss;
}

__device__ __forceinline__ void nsa_bias32(float (&bv)[2][16], const LAS float* bl, int dd) {
#pragma unroll
    for (int kb = 0; kb < 2; ++kb)
#pragma unroll
        for (int k = 0; k < 16; ++k) { const int c = 63 - (32 * kb + (k & 3) + 8 * (k >> 2)); int d = dd + c; d = d < 0 ? 0 : (d > 255 ? 255 : d); bv[kb][k] = bl[d]; }
}
__device__ __forceinline__ void nsa_mask_bias(f32x16 (&sc)[2], int dq, int h, const LAS float* bl, bool sel, int lim) {
    int dd = dq - 4 * h - 63; asm volatile("" : "+v"(dd));
    float bv[2][16]; nsa_bias32(bv, bl, dd);
#pragma unroll
    for (int kb = 0; kb < 2; ++kb)
#pragma unroll
        for (int k = 0; k < 16; ++k) { const int c = 63 - (32 * kb + (k & 3) + 8 * (k >> 2)); const int d = dd + c; sc[kb][k] = (sel && d >= 0 && d < lim) ? sc[kb][k] + bv[kb][k] : -1e30f; }
}

constexpr int NSA_KT = 0, NSA_VT = 2 * 64 * 144, NSA_BIAS = NSA_VT + 2 * 64 * VTP, NSA_PS = NSA_BIAS + 3 * 256 * 4, NSA_SEL = NSA_PS + 3 * 64 * 32 * 4, NSA_UNI = NSA_SEL + 256, NSA_OT = NSA_UNI + 256, NSA_LDS = NSA_OT + 6 * 8192;
__device__ __forceinline__ void nsa_unit(int b, int hk, int i, int l, InPtr in, unsigned char* ws, LAS unsigned char* lds, int g_wv) {
    int tid_ = TIDX; asm volatile("" : "+v"(tid_));
    const int tid = tid_, w = tid >> 6, lane = tid & 63, r = lane & 31, h = lane >> 5;
    const bool active = w < 6; const int g = active ? (w >> 1) : 0, th = w & 1, head = hk * 3 + g;
    const int t = 64 * i + 32 * th + r, tl = 32 * th + r; const size_t row = (size_t)b * 2048 + t;
    const size_t kvslab = (size_t)(b * 2 + hk) * 2048 * 64;
    LAS float* biasl = (LAS float*)(lds + NSA_BIAS); LAS float* PS = (LAS float*)(lds + NSA_PS); LAS unsigned* SEL = (LAS unsigned*)(lds + NSA_SEL); LAS unsigned* UNI = (LAS unsigned*)(lds + NSA_UNI);
    { const float* bd = (const float*)(ws + WS_BIASD) + (size_t)hk * 3 * 2048;
      if (tid < 384) { const int gg = tid >> 7, d0 = (tid & 127) * 2; biasl[gg * 256 + d0] = bd[gg * 2048 + d0]; biasl[gg * 256 + d0 + 1] = bd[gg * 2048 + d0 + 1]; }
#pragma unroll
      for (int k = 0; k < 12; ++k) PS[tid + 512 * k] = 0.f;
      if (tid < 4) UNI[tid] = 0u; }
    bf16x8 qf[4];
    { const bf16_t* QN = (const bf16_t*)(ws + WS_PRJ + PRJ_QN) + ((size_t)(b * 6 + head) * 2048 + t) * 64;
#pragma unroll
      for (int ks = 0; ks < 4; ++ks) qf[ks] = *(const bf16x8*)(QN + 16 * ks + 8 * h); }
#define NSA_GATE(k) ({ int t_ = t; asm volatile("" : "+v"(t_)); sigmf(((const float*)(ws + WS_PRJ + PRJ_GATES))[((size_t)b * 2048 + t_) * 32 + head * 3 + (k)]); })
    LAS float* bl = biasl + g * 256;
    LAS float* otl = (LAS float*)(lds + NSA_OT + (active ? w : 0) * 8192) + lane;
    u32x4 kr[2], vr;
    const int ntc = i >= 16 ? 2 : 1;
    { const bf16_t* KC = (const bf16_t*)(ws + WS_CMP) + (size_t)(b * 2 + hk) * 128 * 64; const bf16_t* VC = (const bf16_t*)(ws + WS_CMP + CMP_V) + (size_t)(b * 2 + hk) * 128 * 64;
      for (int T = 0; T < ntc; ++T) { stage_k_load<64>(kr, KC + T * 4096, tid); vr = stage_v_load(VC + T * 4096, tid); stage_k_store<64>(kr, lds + NSA_KT + T * 64 * 144, tid); stage_v_store(vr, lds + NSA_VT + T * 64 * VTP, tid); } }
    __syncthreads();
    {
        f32x16 ot[2];
        if (active) {
            float m = -1e30f, lsum = 0.f;
            for (int T = 0; T < ntc; ++T) {
                f32x16 sc[2]; attn_scores<64>(sc, qf, lds + NSA_KT + T * 64 * 144, r, h);
                float bvc[2][16];
#pragma unroll
                for (int kb = 0; kb < 2; ++kb)
#pragma unroll
                    for (int k = 0; k < 16; ++k) { int d = t - 16 * (64 * T + 32 * kb + crow(k, h)) - 31; d = d < 0 ? 0 : (d > 255 ? 255 : d); bvc[kb][k] = bl[d]; }
                float mx = -1e30f;
#pragma unroll
                for (int kb = 0; kb < 2; ++kb)
#pragma unroll
                    for (int k = 0; k < 16; ++k) { const int n = 64 * T + 32 * kb + crow(k, h); const int d = t - 16 * n - 31; const float x = (d >= 0 && n < 127) ? sc[kb][k] + bvc[kb][k] : -1e30f; sc[kb][k] = x; mx = fmaxf(mx, x); }
                mx = fmaxf(mx, __shfl_xor(mx, 32));
                const float mnew = fmaxf(m, mx), mref = mnew <= -1e29f ? 0.f : mnew; float rs = 0.f;
#pragma unroll
                for (int kb = 0; kb < 2; ++kb)
#pragma unroll
                    for (int k = 0; k < 16; ++k) rs += __builtin_amdgcn_exp2f(sc[kb][k] - mref);
                rs += __shfl_xor(rs, 32);
                lsum = lsum * __builtin_amdgcn_exp2f(m - mref) + rs; m = mnew;
            }
            const float mref = m <= -1e29f ? 0.f : m, inv = lsum > 0.f ? 1.f / lsum : 0.f;
#pragma unroll
            for (int k = 0; k < 16; ++k) { ot[0][k] = 0.f; ot[1][k] = 0.f; }
            float carry = 0.f;
            for (int T = 0; T < ntc; ++T) {
                f32x16 sc[2]; attn_scores<64>(sc, qf, lds + NSA_KT + T * 64 * 144, r, h);
                float bvc[2][16];
#pragma unroll
                for (int kb = 0; kb < 2; ++kb)
#pragma unroll
                    for (int k = 0; k < 16; ++k) { int d = t - 16 * (64 * T + 32 * kb + crow(k, h)) - 31; d = d < 0 ? 0 : (d > 255 ? 255 : d); bvc[kb][k] = bl[d]; }
#pragma unroll
                for (int kb = 0; kb < 2; ++kb)
#pragma unroll
                    for (int k = 0; k < 16; ++k) { const int n = 64 * T + 32 * kb + crow(k, h); const int d = t - 16 * n - 31; sc[kb][k] = (d >= 0 && n < 127) ? __builtin_amdgcn_exp2f(sc[kb][k] + bvc[kb][k] - mref) * inv : 0.f; }
                float prevL = carry;
#pragma unroll
                for (int kb = 0; kb < 2; ++kb)
#pragma unroll
                    for (int g4 = 0; g4 < 4; ++g4) {
                        const float G4 = (sc[kb][4 * g4] + sc[kb][4 * g4 + 1]) + (sc[kb][4 * g4 + 2] + sc[kb][4 * g4 + 3]); const float L = sc[kb][4 * g4 + 3];
                        const float Lo = __shfl_xor(L, 32);
                        const float add = h ? Lo : prevL;
                        prevL = Lo;
                        const int idx = T * 8 + kb * 4 + g4;
                        PS[g * 2048 + tl * 32 + 2 * idx + h] = G4 + add;
                    }
                carry = prevL;
#pragma unroll
                for (int s4 = 0; s4 < 4; ++s4) {
                    const int kb = s4 >> 1, hf = (s4 & 1) * 8;
                    u32x4 pw; pw.x = pk_bf16(sc[kb][hf + 0], sc[kb][hf + 1]); pw.y = pk_bf16(sc[kb][hf + 2], sc[kb][hf + 3]); pw.z = pk_bf16(sc[kb][hf + 4], sc[kb][hf + 5]); pw.w = pk_bf16(sc[kb][hf + 6], sc[kb][hf + 7]);
                    const bf16x8 pf = __builtin_bit_cast(bf16x8, pw);
#pragma unroll
                    for (int eb = 0; eb < 2; ++eb) ot[eb] = MFMA32(vt_frag(lds + NSA_VT + T * 64 * VTP, vt_lane_off(lane), s4, eb), pf, ot[eb]);
                }
            }
            { const float gc = NSA_GATE(0);
#pragma unroll
            for (int k = 0; k < 16; ++k) { otl[64 * k] = ot[0][k] * gc; otl[64 * (16 + k)] = ot[1][k] * gc; } }
        }
    }
    __syncthreads();
#ifndef NO_NSA_SEL
    {
        const int tk = tid >> 3, sg = tid & 7; float v[32];
#pragma unroll
        for (int k = 0; k < 8; ++k) { const f32x4 x0 = *(const LAS f32x4*)(PS + tk * 32 + 4 * k), x1 = *(const LAS f32x4*)(PS + 2048 + tk * 32 + 4 * k), x2 = *(const LAS f32x4*)(PS + 4096 + tk * 32 + 4 * k);
            v[4 * k] = (x0.x + x1.x) + x2.x; v[4 * k + 1] = (x0.y + x1.y) + x2.y; v[4 * k + 2] = (x0.z + x1.z) + x2.z; v[4 * k + 3] = (x0.w + x1.w) + x2.w; }
#pragma unroll
        for (int s = 0; s < 32; ++s) { const bool forced = (s == 0) || (s == i) || (s == i - 1); float x = forced ? v[s] + 1e4f : v[s]; v[s] = s > i ? -1.f : x; }
        unsigned bits = 0u;
#pragma unroll
        for (int k = 0; k < 4; ++k) {
            float x = 0.f;
#pragma unroll
            for (int s = 0; s < 32; ++s) x = (s == 4 * sg + k) ? v[s] : x;
            int rank = 0;
#pragma unroll
            for (int s = 0; s < 32; ++s) rank += (v[s] > x || (v[s] == x && s < 4 * sg + k)) ? 1 : 0;
            if (rank < 16 && x >= 0.f) bits |= 1u << (4 * sg + k);
        }
        bits |= __shfl_xor(bits, 1); bits |= __shfl_xor(bits, 2); bits |= __shfl_xor(bits, 4);
        if (sg == 0) { SEL[tk] = bits; __hip_atomic_fetch_or(UNI, bits, __ATOMIC_RELAXED, __HIP_MEMORY_SCOPE_WORKGROUP); __hip_atomic_fetch_or(UNI + 1 + (tk >> 5), bits, __ATOMIC_RELAXED, __HIP_MEMORY_SCOPE_WORKGROUP); }
    }
#endif
    __syncthreads();
    const unsigned selbits = SEL[tl], uni = UNI[0], unih = UNI[1 + th];
    const float c31 = bl[255];
#ifndef NO_NSA_SLC
    {
        AttnState A; attn_reset(A);
        const bf16_t* KS = (const bf16_t*)(ws + WS_PRJ + PRJ_KN1) + kvslab; const bf16_t* VS = (const bf16_t*)(ws + WS_PRJ + PRJ_VN1) + kvslab;
        unsigned todo = uni; int cur = 0; u32x4 kr2[2], vr2;
        int s = __ffs(todo) - 1; todo &= todo - 1;
        stage_k_load<64>(kr, KS + (size_t)s * 4096, tid); vr = stage_v_load(VS + (size_t)s * 4096, tid);
        stage_k_store<64>(kr, lds + NSA_KT, tid); stage_v_store(vr, lds + NSA_VT, tid);
        int sn = todo ? __ffs(todo) - 1 : -1; todo &= todo - 1;
        if (sn >= 0) { stage_k_load<64>(kr, KS + (size_t)sn * 4096, tid); vr = stage_v_load(VS + (size_t)sn * 4096, tid); }
        __syncthreads();
        while (s >= 0) {
            const int sn2 = todo ? __ffs(todo) - 1 : -1; todo &= todo - 1;
            if (sn2 >= 0) { stage_k_load<64>(kr2, KS + (size_t)sn2 * 4096, tid); vr2 = stage_v_load(VS + (size_t)sn2 * 4096, tid); }
            if (active && ((unih >> s) & 1u)) {
                f32x16 sc[2];
                attn_scores<64>(sc, qf, lds + NSA_KT + cur * 64 * 144, r, h);
                const bool sel = (selbits >> s) & 1u;
                if (i - s >= 3) attn_softmax_pv(A, sc, lds + NSA_VT + cur * 64 * VTP, r, h, c31, sel);
                else { nsa_mask_bias(sc, t - 64 * s, h, bl, sel, 4096); attn_softmax_pv(A, sc, lds + NSA_VT + cur * 64 * VTP, r, h); }
            }
            if (sn >= 0) { stage_k_store<64>(kr, lds + NSA_KT + (cur ^ 1) * 64 * 144, tid); stage_v_store(vr, lds + NSA_VT + (cur ^ 1) * 64 * VTP, tid); }
            kr[0] = kr2[0]; vr = vr2;
            __syncthreads();
            s = sn; sn = sn2; cur ^= 1;
        }
        if (active) { const float gs = NSA_GATE(1); const float inv = A.l > 0.f ? gs / A.l : 0.f;
#pragma unroll
            for (int k = 0; k < 16; ++k) { otl[64 * k] += A.o[0][k] * inv; otl[64 * (16 + k)] += A.o[1][k] * inv; } }
    }
#endif
#ifndef NO_NSA_WIN
    {
        AttnState A; attn_reset(A);
        const bf16_t* KW = (const bf16_t*)(ws + WS_PRJ + PRJ_KN2) + kvslab; const bf16_t* VW = (const bf16_t*)(ws + WS_PRJ + PRJ_VN2) + kvslab;
        const int j0 = i > 8 ? i - 8 : 0; int cur = 0; u32x4 kr2[2], vr2;
        stage_k_load<64>(kr, KW + (size_t)j0 * 4096, tid); vr = stage_v_load(VW + (size_t)j0 * 4096, tid);
        stage_k_store<64>(kr, lds + NSA_KT, tid); stage_v_store(vr, lds + NSA_VT, tid);
        if (j0 < i) { stage_k_load<64>(kr, KW + (size_t)(j0 + 1) * 4096, tid); vr = stage_v_load(VW + (size_t)(j0 + 1) * 4096, tid); }
        __syncthreads();
        for (int j = j0; j <= i; ++j) {
            if (j + 2 <= i) { stage_k_load<64>(kr2, KW + (size_t)(j + 2) * 4096, tid); vr2 = stage_v_load(VW + (size_t)(j + 2) * 4096, tid); }
            if (active) {
                f32x16 sc[2];
                attn_scores<64>(sc, qf, lds + NSA_KT + cur * 64 * 144, r, h);
                if (i - j >= 3 && j > i - 8) attn_softmax_pv(A, sc, lds + NSA_VT + cur * 64 * VTP, r, h, c31, true);
                else { nsa_mask_bias(sc, t - 64 * j, h, bl, true, 512); attn_softmax_pv(A, sc, lds + NSA_VT + cur * 64 * VTP, r, h); }
            }
            if (j < i) { stage_k_store<64>(kr, lds + NSA_KT + (cur ^ 1) * 64 * 144, tid); stage_v_store(vr, lds + NSA_VT + (cur ^ 1) * 64 * VTP, tid); }
            kr[0] = kr2[0]; vr = vr2;
            __syncthreads();
            cur ^= 1;
        }
        if (active) { const float gw = NSA_GATE(2); const float inv = A.l > 0.f ? gw / A.l : 0.f;
            float ss = 0.f; bf16_t* Y = (bf16_t*)(ws + WS_Y) + row * 1024 + head * 64;
#pragma unroll
            for (int eb = 0; eb < 2; ++eb)
#pragma unroll
                for (int g4 = 0; g4 < 4; ++g4) {
                    const float v0 = otl[64 * (16 * eb + 4 * g4)] + A.o[eb][4 * g4] * inv, v1 = otl[64 * (16 * eb + 4 * g4 + 1)] + A.o[eb][4 * g4 + 1] * inv;
                    const float v2 = otl[64 * (16 * eb + 4 * g4 + 2)] + A.o[eb][4 * g4 + 2] * inv, v3 = otl[64 * (16 * eb + 4 * g4 + 3)] + A.o[eb][4 * g4 + 3] * inv;
                    u32x2 pw; pw.x = pk_bf16(v0, v1); pw.y = pk_bf16(v2, v3);
                    const float f0 = bf_lo(pw.x), f1 = bf_hi(pw.x), f2 = bf_lo(pw.y), f3 = bf_hi(pw.y); ss += (f0 * f0 + f1 * f1) + (f2 * f2 + f3 * f3);
                    *(u32x2*)(Y + 32 * eb + 8 * g4 + 4 * h) = pw;
                }
            ss += __shfl_xor(ss, 32);
            if (h == 0) ((float*)(ws + WS_SSQ + PT_A))[((size_t)l * 16384 + row) * 8 + head] = ss;
        }
    }
#endif
}

__device__ __forceinline__ void ml_out_wave(int cu, int l, InPtr in, unsigned char* ws, LAS unsigned char* wl, LAS unsigned char* npl, int lane) {
    const int c = cu & 31, bh = cu >> 5, hd = bh & 3, b = bh >> 2; const int t0 = c * 64; const int r = lane & 15, q = lane >> 4;
    const bf16_t* QC = (const bf16_t*)(ws + WS_ML) + ((size_t)bh * 2048 + t0) * 64; const bf16_t* KC = (const bf16_t*)(ws + WS_ML + ML_KC) + ((size_t)bh * 2048 + t0) * 64;
    const bf16_t* V = (const bf16_t*)(ws + WS_PRJ + PRJ_VML) + ((size_t)bh * 2048 + t0) * 64;
    const float* mlg = (const float*)(ws + WS_ML + ML_G) + ((size_t)bh * 2048 + t0) * 2;
    const bf16_t* CP = (const bf16_t*)(ws + WS_ML + ML_CP) + (size_t)cu * 4096; const bf16_t* NP = (const bf16_t*)(ws + WS_ML + ML_NP) + (size_t)cu * 64;
    bf16x8 aq[4][2];
#pragma unroll
    for (int mb = 0; mb < 4; ++mb)
#pragma unroll
        for (int ks = 0; ks < 2; ++ks) aq[mb][ks] = *(const bf16x8*)(QC + (size_t)(16 * mb + r) * 64 + 32 * ks + 8 * q);
    float bj[4][4], den[4][4];
#pragma unroll
    for (int mb = 0; mb < 4; ++mb)
#pragma unroll
        for (int j = 0; j < 4; ++j) bj[mb][j] = mlg[(16 * mb + 4 * q + j) * 2];
    {
        float cs[4];
#pragma unroll
        for (int nb = 0; nb < 4; ++nb) { const float2 gg = *(const float2*)(mlg + (16 * nb + r) * 2); cs[nb] = gg.y - gg.x; }
#pragma unroll
        for (int mb = 0; mb < 4; ++mb) {
            f32x4 accS[4];
#pragma unroll
            for (int nb = 0; nb < 4; ++nb) { accS[nb] = (f32x4){0.f, 0.f, 0.f, 0.f};
#pragma unroll
                for (int ks = 0; ks < 2; ++ks) { const bf16x8 bk = *(const bf16x8*)(KC + (size_t)(16 * nb + r) * 64 + 32 * ks + 8 * q); accS[nb] = MFMA16(aq[mb][ks], bk, accS[nb]); } }
#pragma unroll
            for (int j = 0; j < 4; ++j) {
                const int jj = 16 * mb + 4 * q + j; float rs = 0.f;
#pragma unroll
                for (int nb = 0; nb < 4; ++nb) { const int s = 16 * nb + r; const float p = s <= jj ? accS[nb][j] * __expf(bj[mb][j] + cs[nb]) : 0.f; rs += p;
                    *(LAS bf16_t*)(wl + 8192 + swz_off(jj, s >> 3) + (s & 7) * 2) = f2bf(p); }
                rs += __shfl_xor(rs, 1); rs += __shfl_xor(rs, 2); rs += __shfl_xor(rs, 4); rs += __shfl_xor(rs, 8);
                den[mb][j] = rs;
            }
        }
    }
#pragma unroll
    for (int mb = 0; mb < 4; ++mb) { const float e = __expf(mlg[(16 * mb + r) * 2]);
#pragma unroll
        for (int ks = 0; ks < 2; ++ks) { const u32x4 x = __builtin_bit_cast(u32x4, aq[mb][ks]); u32x4 y;
            y.x = pk_bf16(bf_lo(x.x) * e, bf_hi(x.x) * e); y.y = pk_bf16(bf_lo(x.y) * e, bf_hi(x.y) * e); y.z = pk_bf16(bf_lo(x.z) * e, bf_hi(x.z) * e); y.w = pk_bf16(bf_lo(x.w) * e, bf_hi(x.w) * e);
            aq[mb][ks] = __builtin_bit_cast(bf16x8, y); } }
    f32x4 acc[4][4], accn[4];
#pragma unroll
    for (int mb = 0; mb < 4; ++mb) { accn[mb] = (f32x4){0.f, 0.f, 0.f, 0.f};
#pragma unroll
        for (int nb = 0; nb < 4; ++nb) acc[mb][nb] = (f32x4){0.f, 0.f, 0.f, 0.f}; }
#pragma unroll
    for (int ks = 0; ks < 2; ++ks) {
        u32x4 nz = *(const u32x4*)(NP + 32 * ks + 8 * q); if (r != 0) nz = (u32x4){0u, 0u, 0u, 0u};
        const bf16x8 bn = __builtin_bit_cast(bf16x8, nz);
#pragma unroll
        for (int nb = 0; nb < 4; ++nb) { const bf16x8 bb = *(const bf16x8*)(CP + (size_t)(16 * nb + r) * 64 + 32 * ks + 8 * q);
#pragma unroll
            for (int mb = 0; mb < 4; ++mb) acc[mb][nb] = MFMA16(aq[mb][ks], bb, acc[mb][nb]); }
#pragma unroll
        for (int mb = 0; mb < 4; ++mb) accn[mb] = MFMA16(aq[mb][ks], bn, accn[mb]);
    }
#pragma unroll
    for (int s8 = 0; s8 < 8; ++s8) { float vb[8];
#pragma unroll
        for (int j = 0; j < 8; ++j) vb[j] = bf2f(V[(size_t)(s8 * 8 + j) * 64 + lane]);
        u32x4 pk; pk.x = pk_bf16(vb[0], vb[1]); pk.y = pk_bf16(vb[2], vb[3]); pk.z = pk_bf16(vb[4], vb[5]); pk.w = pk_bf16(vb[6], vb[7]);
        *(LAS u32x4*)(wl + swz_off(lane, s8)) = pk; }
    LDS_FENCE();
#pragma unroll
    for (int ks = 0; ks < 2; ++ks) {
        bf16x8 ap[4];
#pragma unroll
        for (int mb = 0; mb < 4; ++mb) ap[mb] = *(const LAS bf16x8*)(wl + 8192 + swz_off(16 * mb + r, 4 * ks + q));
#pragma unroll
        for (int nb = 0; nb < 4; ++nb) { const bf16x8 bv = *(const LAS bf16x8*)(wl + swz_off(16 * nb + r, 4 * ks + q));
#pragma unroll
            for (int mb = 0; mb < 4; ++mb) acc[mb][nb] = MFMA16(ap[mb], bv, acc[mb][nb]); }
    }
    LDS_FENCE();
    const float* gain = in->p[14] + l * 256 + hd * 64; const bf16_t* OG = (const bf16_t*)(ws + WS_PRJ + PRJ_OG);
    bf16_t* Y = (bf16_t*)(ws + WS_Y);
#pragma unroll
    for (int mb = 0; mb < 4; ++mb)
#pragma unroll
        for (int j = 0; j < 4; ++j) {
            const int jj = 16 * mb + 4 * q + j;
            const float dn = den[mb][j] + __builtin_bit_cast(float, __builtin_amdgcn_ds_bpermute((lane & 48) << 2, __builtin_bit_cast(int, accn[mb][j])));
            const float inv = 1.f / fmaxf(fabsf(dn), 1.f); float hv[4]; float ss = 0.f;
#pragma unroll
            for (int nb = 0; nb < 4; ++nb) { hv[nb] = acc[mb][nb][j] * inv; ss += hv[nb] * hv[nb]; }
            ss += __shfl_xor(ss, 1); ss += __shfl_xor(ss, 2); ss += __shfl_xor(ss, 4); ss += __shfl_xor(ss, 8);
            const float rstd = rsqrtf(ss * (1.f / 64.f) + 1e-6f); const size_t row = (size_t)b * 2048 + t0 + jj;
#pragma unroll
            for (int nb = 0; nb < 4; ++nb) { const int e = 16 * nb + r; Y[row * 1024 + 384 + hd * 64 + e] = f2bf(hv[nb] * rstd * gain[e] * sigmf(bf2f(OG[row * 256 + hd * 64 + e]))); }
        }
}

__device__ __forceinline__ void ml_scan_unit(int bh, int l, unsigned char* ws, int g_wv) {
    int tid_ = TIDX; asm volatile("" : "+v"(tid_)); const int tid = tid_;
    const bf16_t* DL = (const bf16_t*)(ws + WS_ML + ML_DELTA) + (size_t)bh * 32 * 4096 + tid * 8; bf16_t* CP = (bf16_t*)(ws + WS_ML + ML_CP) + (size_t)bh * 32 * 4096 + tid * 8;
    const float* DN = (const float*)(ws + WS_ML + ML_DN) + (size_t)bh * 32 * 64; bf16_t* NP = (bf16_t*)(ws + WS_ML + ML_NP) + (size_t)bh * 32 * 64; const float* BL = (const float*)(ws + WS_ML + ML_BL) + bh * 32;
    float c[8]; float n = 0.f;
#pragma unroll
    for (int k = 0; k < 8; ++k) c[k] = 0.f;
#pragma unroll 1
    for (int c0 = 0; c0 < 32; c0 += 8) {
        u32x4 d[8]; float dn[8], co[8];
#pragma unroll
        for (int k = 0; k < 8; ++k) { d[k] = *(const u32x4*)(DL + (size_t)(c0 + k) * 4096); dn[k] = tid < 64 ? DN[(c0 + k) * 64 + tid] : 0.f; co[k] = __expf(BL[c0 + k]); }
#pragma unroll
        for (int k = 0; k < 8; ++k) {
            u32x4 o; o.x = pk_bf16(c[0], c[1]); o.y = pk_bf16(c[2], c[3]); o.z = pk_bf16(c[4], c[5]); o.w = pk_bf16(c[6], c[7]);
            *(u32x4*)(CP + (size_t)(c0 + k) * 4096) = o; if (tid < 64) NP[(c0 + k) * 64 + tid] = f2bf(n);
            c[0] = co[k] * c[0] + bf_lo(d[k].x); c[1] = co[k] * c[1] + bf_hi(d[k].x); c[2] = co[k] * c[2] + bf_lo(d[k].y); c[3] = co[k] * c[3] + bf_hi(d[k].y);
            c[4] = co[k] * c[4] + bf_lo(d[k].z); c[5] = co[k] * c[5] + bf_hi(d[k].z); c[6] = co[k] * c[6] + bf_lo(d[k].w); c[7] = co[k] * c[7] + bf_hi(d[k].w);
            n = co[k] * n + dn[k];
        }
    }
    asm volatile("s_waitcnt vmcnt(0)" ::: "memory"); __syncthreads();
    if (tid == 0) { __builtin_amdgcn_fence(__ATOMIC_RELEASE, "agent"); asm volatile("s_waitcnt vmcnt(0)" ::: "memory");
        __hip_atomic_fetch_add((unsigned*)(ws + WS_CTL) + CW_SCAN + 64 * l, 1u, __ATOMIC_RELAXED, __HIP_MEMORY_SCOPE_AGENT); }
}
__device__ __forceinline__ void ml_scan_wait(int l, unsigned char* ws, int g_wv) {
    if (TIDX == 0) { unsigned* p = (unsigned*)(ws + WS_CTL) + CW_SCAN + 64 * l; unsigned sp = 0;
        while (__hip_atomic_load(p, __ATOMIC_RELAXED, __HIP_MEMORY_SCOPE_AGENT) < 32u) { __builtin_amdgcn_s_sleep(2); if (++sp > (1u << 22)) break; }
        __builtin_amdgcn_fence(__ATOMIC_ACQUIRE, "agent"); asm volatile("s_waitcnt vmcnt(0)" ::: "memory"); }
    __syncthreads();
}

#ifndef DUP_NSA
#define DUP_NSA 1
#endif
#ifndef DUP_MLA
#define DUP_MLA 1
#endif
#ifndef DUP_ML
#define DUP_ML 1
#endif
#ifdef NO_MLA
#define MLA_CALL(...) do {} while (0)
#else
#define MLA_CALL(...) do { for (int rp = 0; rp < DUP_MLA; ++rp) { if (rp) __syncthreads(); mla_unit(__VA_ARGS__); } } while (0)
#endif
__device__ __forceinline__ void phase_mix(int l, InPtr in, unsigned char* ws, LAS unsigned char* lds, unsigned* qhead, int g_wv) {
    LAS int* slot = (LAS int*)(lds + LDS_MISC + 64);
    for (;;) {
        __syncthreads();
        if (TIDX == 0) *slot = (int)__hip_atomic_fetch_add(qhead, 1u, __ATOMIC_RELAXED, __HIP_MEMORY_SCOPE_AGENT);
        __syncthreads();
        int u = *slot;
        if (u >= 32 + 512 + 384 + 128) break;
        if (u < 32) { ml_scan_unit(u, l, ws, g_wv); continue; } u -= 32;
#ifndef NO_NSA
        if (u < 256) { const int i = 31 - (u >> 4), bh = u & 15; { for (int rp = 0; rp < DUP_NSA; ++rp) { if (rp) __syncthreads(); nsa_unit(bh >> 1, bh & 1, i, l, in, ws, lds, g_wv); } } continue; }
#endif
        u -= 256;
        if (u < 192) { const int qt = 7 - u / 48, bh = u % 48; MLA_CALL(bh / 6, bh % 6, qt, l, ws, lds, g_wv); continue; }
        u -= 192;
#ifndef NO_NSA
        if (u < 128) { const int i = 15 - (u >> 4), bh = u & 15; { for (int rp = 0; rp < DUP_NSA; ++rp) { if (rp) __syncthreads(); nsa_unit(bh >> 1, bh & 1, i, l, in, ws, lds, g_wv); } } continue; }
#endif
        u -= 128;
        if (u < 192) { const int qt = 3 - u / 48, bh = u % 48; MLA_CALL(bh / 6, bh % 6, qt, l, ws, lds, g_wv); continue; } u -= 192;
#ifndef NO_NSA
        if (u < 128) { const int i = 7 - (u >> 4), bh = u & 15; { for (int rp = 0; rp < DUP_NSA; ++rp) { if (rp) __syncthreads(); nsa_unit(bh >> 1, bh & 1, i, l, in, ws, lds, g_wv); } } continue; }
#endif
        u -= 128;
#ifndef NO_MLOUT
        ml_scan_wait(l, ws, g_wv);
        for (int rp = 0; rp < DUP_ML; ++rp) { int tid_ = TIDX; asm volatile("" : "+v"(tid_)); const int w = tid_ >> 6; ml_out_wave(u * 8 + w, l, in, ws, lds + w * 16384, lds + 131072 + w * 256, tid_ & 63); }
#endif
    }
}
__device__ __forceinline__ void phase_ynorm(int l, unsigned char* ws, int bid, int nb, int g_wv) {
    int tid_ = TIDX; asm volatile("" : "+v"(tid_)); const int w = tid_ >> 6, lane = tid_ & 63;
    bf16_t* Y = (bf16_t*)(ws + WS_Y); const float* sa = (const float*)(ws + WS_SSQ + PT_A) + (size_t)l * 16384 * 8; const float* sc = (const float*)(ws + WS_SSQ + PT_C) + (size_t)l * 16384 * 8;
    for (int r0 = (bid * 8 + w) * 8; r0 < NTOK; r0 += nb * 64) {
        if (lane < 48) {
            u32x4 x[8], y[8]; float ra[8], rc[8];
#pragma unroll
            for (int k = 0; k < 8; ++k) { const int row = r0 + k;
                const f32x4 a0 = *(const f32x4*)(sa + (size_t)row * 8), a1 = *(const f32x4*)(sa + (size_t)row * 8 + 4), c0 = *(const f32x4*)(sc + (size_t)row * 8), c1 = *(const f32x4*)(sc + (size_t)row * 8 + 4);
                ra[k] = rsqrtf((((a0.x + a0.y) + (a0.z + a0.w)) + (a1.x + a1.y)) * (1.f / 384.f) + 1e-6f); rc[k] = rsqrtf((((c0.x + c0.y) + (c0.z + c0.w)) + (c1.x + c1.y)) * (1.f / 384.f) + 1e-6f);
                x[k] = *((const u32x4*)(Y + (size_t)row * 1024) + lane); y[k] = *((const u32x4*)(Y + (size_t)row * 1024 + 640) + lane); }
#pragma unroll
            for (int k = 0; k < 8; ++k) { const int row = r0 + k; u32x4 a = x[k], c = y[k]; const float fa = ra[k], fc = rc[k];
                a.x = pk_bf16(bf_lo(a.x) * fa, bf_hi(a.x) * fa); a.y = pk_bf16(bf_lo(a.y) * fa, bf_hi(a.y) * fa); a.z = pk_bf16(bf_lo(a.z) * fa, bf_hi(a.z) * fa); a.w = pk_bf16(bf_lo(a.w) * fa, bf_hi(a.w) * fa);
                c.x = pk_bf16(bf_lo(c.x) * fc, bf_hi(c.x) * fc); c.y = pk_bf16(bf_lo(c.y) * fc, bf_hi(c.y) * fc); c.z = pk_bf16(bf_lo(c.z) * fc, bf_hi(c.z) * fc); c.w = pk_bf16(bf_lo(c.w) * fc, bf_hi(c.w) * fc);
                *((u32x4*)(Y + (size_t)row * 1024) + lane) = a; *((u32x4*)(Y + (size_t)row * 1024 + 640) + lane) = c; }
        }
    }
}
struct EpiOut {
    bf16_t* XB; float* ssq;
    __device__ __forceinline__ void operator()(const f32x4 (&acc)[2][2][4][2], const GUnit& u, int wr, int wc, int fr, int fq) const {
#pragma unroll
        for (int ai = 0; ai < 2; ++ai)
#pragma unroll
          for (int mh = 0; mh < 2; ++mh) {
            __builtin_amdgcn_sched_barrier(0);
            u32x4 xr[2][2];
#pragma unroll
            for (int m2 = 0; m2 < 2; ++m2)
#pragma unroll
                for (int bj = 0; bj < 2; ++bj) xr[m2][bj] = *(const u32x4*)(XB + (size_t)(u.pm * 256 + ai * 128 + wr * 64 + (2 * mh + m2) * 16 + fr) * 1024 + u.pn * 256 + bj * 128 + wc * 32 + 8 * fq);
#pragma unroll
            for (int m2 = 0; m2 < 2; ++m2) {
                const int m = 2 * mh + m2; const int row = u.pm * 256 + ai * 128 + wr * 64 + m * 16 + fr; float ss = 0.f;
#pragma unroll
                for (int bj = 0; bj < 2; ++bj) {
                    const u32x4 x = xr[m2][bj]; u32x4 o;
                    o.x = pk_bf16(bf_lo(x.x) + acc[ai][bj][m][0][0], bf_hi(x.x) + acc[ai][bj][m][0][1]); o.y = pk_bf16(bf_lo(x.y) + acc[ai][bj][m][0][2], bf_hi(x.y) + acc[ai][bj][m][0][3]);
                    o.z = pk_bf16(bf_lo(x.z) + acc[ai][bj][m][1][0], bf_hi(x.z) + acc[ai][bj][m][1][1]); o.w = pk_bf16(bf_lo(x.w) + acc[ai][bj][m][1][2], bf_hi(x.w) + acc[ai][bj][m][1][3]);
                    *(u32x4*)(XB + (size_t)row * 1024 + u.pn * 256 + bj * 128 + wc * 32 + 8 * fq) = o;
                    ss += (bf_lo(o.x) * bf_lo(o.x) + bf_hi(o.x) * bf_hi(o.x)) + (bf_lo(o.y) * bf_lo(o.y) + bf_hi(o.y) * bf_hi(o.y)) + (bf_lo(o.z) * bf_lo(o.z) + bf_hi(o.z) * bf_hi(o.z)) + (bf_lo(o.w) * bf_lo(o.w) + bf_hi(o.w) * bf_hi(o.w));
                }
                ss = quad_sum(ss); if (fq == 0) ssq[(size_t)row * 16 + u.pn * 4 + wc] = ss;
            }
          }
    }
};

__device__ __forceinline__ float sum16(const float* p) { const f32x4 a = *(const f32x4*)p, b = *(const f32x4*)(p + 4), c = *(const f32x4*)(p + 8), d = *(const f32x4*)(p + 12);
    return (((a.x + a.y) + (a.z + a.w)) + ((b.x + b.y) + (b.z + b.w))) + (((c.x + c.y) + (c.z + c.w)) + ((d.x + d.y) + (d.z + d.w))); }
__device__ __forceinline__ void phase_route(int l, InPtr in, unsigned char* ws, LAS unsigned char* lds, int bid, int nb, int g_wv) {
    int tid_ = TIDX; asm volatile("" : "+v"(tid_)); const int w = tid_ >> 6, lane = tid_ & 63, r = lane & 15, q = lane >> 4;
    const bf16_t* XB = (const bf16_t*)(ws + WS_XB); const bf16_t* WR = (const bf16_t*)(ws + WS_WR) + (size_t)l * 64 * 1024;
    const float* ssq = (const float*)(ws + WS_SSQ + PT_X1) + (size_t)l * 16384 * 16; const float* bg = in->p[24] + l * 4; const float* be = in->p[26] + l * 32;
    unsigned* cnt = (unsigned*)(ws + WS_CTL) + CW_CNT + 2048 * l; unsigned* mtok = (unsigned*)(ws + WS_META); float* mw = (float*)(ws + WS_META + META_W);
    LAS float* lg = (LAS float*)(lds + w * 4096);
    LAS unsigned* lcnt = (LAS unsigned*)(lds + 32768); LAS unsigned* lbase = lcnt + 32;
    for (int g0 = bid * 8; g0 < NTOK / 16; g0 += nb * 8) {
        if (tid_ < 32) lcnt[tid_] = 0u;
        __syncthreads();
        const int tok0 = (g0 + w) * 16; f32x4 acc[3];
#pragma unroll
        for (int n = 0; n < 3; ++n) acc[n] = (f32x4){0.f, 0.f, 0.f, 0.f};
        const bf16_t* ap = XB + (size_t)(tok0 + r) * 1024 + 8 * q; const bf16_t* bp = WR + (size_t)r * 1024 + 8 * q;
#pragma unroll 8
        for (int ks = 0; ks < 32; ++ks) { const bf16x8 a = *(const bf16x8*)(ap + 32 * ks);
#pragma unroll
            for (int n = 0; n < 3; ++n) { const bf16x8 bb = *(const bf16x8*)(bp + (size_t)n * 16 * 1024 + 32 * ks); acc[n] = MFMA16(a, bb, acc[n]); } }
#pragma unroll
        for (int n = 0; n < 3; ++n)
#pragma unroll
            for (int j = 0; j < 4; ++j) lg[(4 * q + j) * 48 + 16 * n + r] = acc[n][j];
        LDS_FENCE();
        int E0 = 0, E1 = 0; unsigned r0 = 0, r1 = 0; float wt0 = 0.f, wt1 = 0.f; const int tok = tok0 + (lane & 15);
        if (lane < 16) {
            const float rs = rsqrtf(sum16(ssq + (size_t)tok * 16) * (1.f / 1024.f) + 1e-6f); ((float*)(ws + WS_RS2))[tok] = rs; const LAS float* L = lg + lane * 48;
            float gl[4]; int gi = 0;
#pragma unroll
            for (int j = 0; j < 4; ++j) gl[j] = L[j] * rs + bg[j];
            float gm = gl[0];
#pragma unroll
            for (int j = 1; j < 4; ++j) if (gl[j] > gm) { gm = gl[j]; gi = j; }
            float gsum = 0.f;
#pragma unroll
            for (int j = 0; j < 4; ++j) gsum += __expf(gl[j] - gm);
            const float gtop = 1.f / gsum;
            float el[8];
#pragma unroll
            for (int j = 0; j < 8; ++j) el[j] = L[4 + gi * 8 + j] * rs + be[gi * 8 + j];
            int e0 = 0; float v0 = el[0];
#pragma unroll
            for (int j = 1; j < 8; ++j) if (el[j] > v0) { v0 = el[j]; e0 = j; }
            int e1 = -1; float v1 = -3.0e38f;
#pragma unroll
            for (int j = 0; j < 8; ++j) if (j != e0 && el[j] > v1) { v1 = el[j]; e1 = j; }
            const float w0 = 1.f / (1.f + __expf(v1 - v0)); E0 = gi * 8 + e0; E1 = gi * 8 + e1; wt0 = w0 * gtop; wt1 = (1.f - w0) * gtop;
            r0 = __hip_atomic_fetch_add(lcnt + E0, 1u, __ATOMIC_RELAXED, __HIP_MEMORY_SCOPE_WORKGROUP); r1 = __hip_atomic_fetch_add(lcnt + E1, 1u, __ATOMIC_RELAXED, __HIP_MEMORY_SCOPE_WORKGROUP);
        }
        __syncthreads();
        if (tid_ < 32) { const unsigned c = lcnt[tid_]; lbase[tid_] = c ? atomicAdd(cnt + tid_ * 64, c) : 0u; }
        __syncthreads();
        if (lane < 16) {
            const unsigned p0 = lbase[E0] + r0, p1 = lbase[E1] + r1;
            mtok[(size_t)E0 * 16384 + p0] = (unsigned)tok; mw[(size_t)E0 * 16384 + p0] = wt0;
            mtok[(size_t)E1 * 16384 + p1] = (unsigned)tok | 0x80000000u; mw[(size_t)E1 * 16384 + p1] = wt1;
        }
        __syncthreads();
    }
}

constexpr int LDS_TB = 131072 + 2048;
__device__ __forceinline__ void moe_tables(int l, unsigned char* ws, LAS unsigned char* lds, int g_wv) {
    int tix = TIDX; asm volatile("" : "+v"(tix));
    LAS int* tb = (LAS int*)(lds + LDS_TB);
    if (tix < 32) { const unsigned* cnt = (const unsigned*)(ws + WS_CTL) + CW_CNT + 2048 * l; tb[160 + tix] = (int)__hip_atomic_load(cnt + tix * 64, __ATOMIC_RELAXED, __HIP_MEMORY_SCOPE_AGENT); }
    __syncthreads();
    if (tix == 0) { int a = 0, f = 0, p = 0; for (int e = 0; e < 32; ++e) { const int c = tb[160 + e]; tb[e] = a; tb[48 + e] = f; tb[96 + e] = p; a += (c + 255) >> 8; f += c >> 8; p += (c & 255) ? 1 : 0; } tb[32] = a; tb[80] = f; tb[128] = p; }
    __syncthreads();
}
template <int NPN, bool GATHER_>
struct MoeSched {
    static constexpr bool GATHER = GATHER_, PARTIAL = false;
    const char* A; const char* Bt; const unsigned* cnt; const unsigned* mtok; const LAS int* tb; int G, c; size_t bstride_e  , bstride_pn;
    __device__ __forceinline__ bool next(int i, GUnit& u) const {
        const int L = i * G + c; const int ntile = tb[32]; if (L >= ntile * NPN) return false;
        const int tile = L / NPN, pn = L % NPN; int e = 0;
        for (int k = 1; k < 32; ++k) e = (tb[k] <= tile) ? k : e;
        e = __builtin_amdgcn_readfirstlane(e);
        u.e = e; u.pm = tile; u.pn = pn; u.rows = tb[160 + e] - 256 * (tile - tb[e]);
        u.a = GATHER ? A : A + (size_t)tile * 256 * 256 * 2;
        u.b = Bt + (size_t)e * bstride_e + (size_t)pn * bstride_pn; return true;
    }
    __device__ __forceinline__ void aoff(const GUnit& u, unsigned (&v)[2][2], const int (&R)[2], const int (&C)[2]) const {
#pragma unroll
        for (int h = 0; h < 2; ++h)
#pragma unroll
            for (int i = 0; i < 2; ++i) {
                if (GATHER) { const int lr = h * 128 + R[i]; const int rr = 256 * (u.pm - tb[u.e]) + (lr < u.rows ? lr : 0); const unsigned tok = mtok[(size_t)u.e * 16384 + rr] & 0x7fffffffu; v[h][i] = (tok * 1024u + (unsigned)C[i]) * 2u; }
                else v[h][i] = (unsigned)((h * 128 + R[i]) * 256 + C[i]) * 2u;
            }
    }
};
struct EpiMoeUp {
    const unsigned* mtok; const float* ssq; const LAS int* tb; bf16_t* HB;
    __device__ __forceinline__ void operator()(const f32x4 (&acc)[2][2][4][2], const GUnit& u, int wr, int wc, int fr, int fq) const {
        const int r0 = 256 * (u.pm - tb[u.e]);
        float rs8[8];
        { unsigned tk[8];
#pragma unroll
          for (int k = 0; k < 8; ++k) { const int lr = (k >> 2) * 128 + wr * 64 + (k & 3) * 16 + fr; tk[k] = mtok[(size_t)u.e * 16384 + r0 + (lr < u.rows ? lr : 0)] & 0x7fffffffu; }
#pragma unroll
          for (int k = 0; k < 8; ++k) rs8[k] = ssq[tk[k]]; }
#pragma unroll
        for (int ai = 0; ai < 2; ++ai)
#pragma unroll
            for (int m = 0; m < 4; ++m) {
                __builtin_amdgcn_sched_barrier(0);
                const int lr = ai * 128 + wr * 64 + m * 16 + fr;
                if (lr < u.rows) {
                    const float rs = rs8[ai * 4 + m];
                    float hv[8];
#pragma unroll
                    for (int n = 0; n < 2; ++n)
#pragma unroll
                        for (int j = 0; j < 4; ++j) { const float gv = acc[ai][0][m][n][j] * rs, uv = acc[ai][1][m][n][j] * rs; hv[4 * n + j] = siluf(gv) * uv; }
                    st_bf16x8(HB + ((size_t)u.pm * 256 + lr) * 256 + u.pn * 128 + wc * 32 + 8 * fq, hv);
                }
            }
    }
};
struct EpiMoeDown {
    const unsigned* mtok; const float* mw; const LAS int* tb; bf16_t* YB;
    __device__ __forceinline__ void operator()(const f32x4 (&acc)[2][2][4][2], const GUnit& u, int wr, int wc, int fr, int fq) const {
        const int r0 = 256 * (u.pm - tb[u.e]);
        unsigned mt8[8]; float wt8[8];
#pragma unroll
        for (int k = 0; k < 8; ++k) { const int lr = (k >> 2) * 128 + wr * 64 + (k & 3) * 16 + fr; const size_t ix = (size_t)u.e * 16384 + r0 + (lr < u.rows ? lr : 0); mt8[k] = mtok[ix]; wt8[k] = mw[ix]; }
#pragma unroll
        for (int ai = 0; ai < 2; ++ai)
#pragma unroll
            for (int m = 0; m < 4; ++m) {
                __builtin_amdgcn_sched_barrier(0);
                const int lr = ai * 128 + wr * 64 + m * 16 + fr;
                if (lr < u.rows) {
                    const unsigned mt = mt8[ai * 4 + m]; const float wt = wt8[ai * 4 + m];
                    bf16_t* dst = YB + ((size_t)(mt >> 31) * 16384 + (mt & 0x7fffffffu)) * 1024 + u.pn * 256 + wc * 32 + 8 * fq;
#pragma unroll
                    for (int bj = 0; bj < 2; ++bj) { float v[8];
#pragma unroll
                        for (int n = 0; n < 2; ++n)
#pragma unroll
                            for (int j = 0; j < 4; ++j) v[4 * n + j] = acc[ai][bj][m][n][j] * wt;
                        st_bf16x8(dst + bj * 128, v); }
                }
            }
    }
};
__device__ __forceinline__ void phase_combine(int l, unsigned char* ws, float* out, int bid, int nb, int g_wv) {
    int tid_ = TIDX; asm volatile("" : "+v"(tid_)); const int w = tid_ >> 6, lane = tid_ & 63;
    bf16_t* XB = (bf16_t*)(ws + WS_XB); const bf16_t* Y0 = (const bf16_t*)(ws + WS_YBUF); const bf16_t* Y1 = Y0 + (size_t)16384 * 1024; float* ssqx = (float*)(ws + WS_SSQX) + 16384;
    for (int row = bid * 8 + w; row < NTOK; row += nb * 8) {
        float ss = 0.f;
#pragma unroll
        for (int k = 0; k < 2; ++k) {
            const size_t o = (size_t)row * 1024 + (lane + 64 * k) * 8;
            const u32x4 x = *(const u32x4*)(XB + o), a = *(const u32x4*)(Y0 + o), c = *(const u32x4*)(Y1 + o);
            float v[8] = { bf_lo(x.x) + bf_lo(a.x) + bf_lo(c.x), bf_hi(x.x) + bf_hi(a.x) + bf_hi(c.x), bf_lo(x.y) + bf_lo(a.y) + bf_lo(c.y), bf_hi(x.y) + bf_hi(a.y) + bf_hi(c.y),
                           bf_lo(x.z) + bf_lo(a.z) + bf_lo(c.z), bf_hi(x.z) + bf_hi(a.z) + bf_hi(c.z), bf_lo(x.w) + bf_lo(a.w) + bf_lo(c.w), bf_hi(x.w) + bf_hi(a.w) + bf_hi(c.w) };
            if (l == L_ - 1 && out) { *(f32x4*)(out + o) = (f32x4){v[0], v[1], v[2], v[3]}; *(f32x4*)(out + o + 4) = (f32x4){v[4], v[5], v[6], v[7]}; }
            else { u32x4 p; p.x = pk_bf16(v[0], v[1]); p.y = pk_bf16(v[2], v[3]); p.z = pk_bf16(v[4], v[5]); p.w = pk_bf16(v[6], v[7]); *(u32x4*)(XB + o) = p;
#pragma unroll
                   for (int j = 0; j < 4; ++j) { const unsigned q = j == 0 ? p.x : (j == 1 ? p.y : (j == 2 ? p.z : p.w)); ss += bf_lo(q) * bf_lo(q) + bf_hi(q) * bf_hi(q); } }
        }
        if (l < L_ - 1) { ss = wave_sum(ss); if (lane == 0) ssqx[row] = ss; }
    }
}
constexpr int NPH = 9;
enum { PH_INPROJ = 0, PH_PREP, PH_MIX, PH_YNORM, PH_OUTPROJ, PH_ROUTE, PH_MOEUP, PH_MOEDOWN, PH_COMBINE };
struct Args { Inputs in; float* out; unsigned char* ws; int ph_lo, ph_hi; };

__global__ void __launch_bounds__(512, 2) mk(Args args) {
    extern __shared__ __attribute__((aligned(16))) unsigned char lds_raw[];
    LAS unsigned char* lds = (LAS unsigned char*)lds_raw;
    const int g_wv = __builtin_amdgcn_readfirstlane((int)threadIdx.x >> 6);
    const int bid0 = blockIdx.x, nb = gridDim.x;
#define BID() ({ int b_ = bid0; asm volatile("" : "+s"(b_)); b_; })
    unsigned char* ws = args.ws; unsigned* ctl = (unsigned*)(ws + WS_CTL);
    const int lo = args.ph_lo, hi = args.ph_hi;
    if (TIDX < 4) ((LAS unsigned*)(lds + LDS_MISC))[TIDX] = 0u;
    __syncthreads();
    XcdBarrier bar; bar.g_wv = g_wv; bar.bar = ctl + CW_BAR; bar.x = 0; bar.st = nullptr;
    if (hi - lo > 1) bar = xcd_barrier_post(ctl + CW_BAR, (volatile LAS unsigned*)(lds + LDS_MISC), g_wv);
#define IN(k) (lo <= (k) && (k) < hi)
#ifndef REPEAT_PH
#define REPEAT_PH -1
#endif
#define NREP(k) ((REPEAT_PH == (k)) ? 2 : 1)
#ifndef NBAR
#define NBAR 1
#endif
#ifndef TIME_PH
#define TIME_PH -1
#endif
#define STAMP(i) do { if (TIME_PH != -1 && blockIdx.x == 0 && TIDX == 0) ((unsigned long long*)(ctl + CW_TS))[i] = __builtin_amdgcn_s_memrealtime(); } while (0)
#define SEAM(k) do { if (IN(k) && IN((k) + 1)) for (int nb_ = 0; nb_ < NBAR; ++nb_) xcd_barrier(bar); STAMP((k) + 1); } while (0)
    STAMP(0);
#ifndef NO_PRO
    if (IN(0)) for (int rep = 0; rep < NREP(100); ++rep) { prologue(in_tab(), launder(ws), lds, BID(), nb, g_wv); if (rep + 1 < NREP(100)) xcd_barrier(bar); }
#endif
    SEAM(0);
    for (int l = 0; l < L_; ++l) {
        const int pb = 1 + l * NPH;
        if (IN(pb + PH_INPROJ)) for (int rep = 0; rep < NREP(PH_INPROJ); ++rep) {
            if (rep) xcd_barrier(bar);
            InPtr in = in_tab(); unsigned char* ws = launder(args.ws);
            g8::DenseSched S{(const char*)(ws + WS_XB), (const char*)(ws + WS_WIN) + (size_t)l * 2560 * 1024 * 2, 1024, 1024, 64, 10, nb, BID()};
            EpiInProj E{(const float*)(ws + WS_SSQX) + l * 16384, (float*)(ws + WS_SSQ + PT_DQ) + (size_t)l * 16384 * 4, (float*)(ws + WS_SSQ + PT_DKV) + (size_t)l * 16384 * 2,
                        in->p[8] + l * 64, in->p[9] + l * 64, in->p[19] + l * 192 + 96 + 64, (const float*)(ws + WS_ROPE), ws + WS_PRJ};
#ifndef NO_INPROJ
            g8::gemm_run(lds, 1024, 1024, S, E, g_wv);
#endif
        }
        SEAM(pb + PH_INPROJ);
        if (IN(pb + PH_PREP)) for (int rep = 0; rep < NREP(PH_PREP); ++rep) { if (rep) xcd_barrier(bar); phase_prep(l, in_tab(), launder(ws), lds, BID(), nb, g_wv); }
        SEAM(pb + PH_PREP);
        if (IN(pb + PH_MIX)) for (int rep = 0; rep < NREP(PH_MIX); ++rep) { if (rep) xcd_barrier(bar); phase_mix(l, in_tab(), launder(ws), lds, (unsigned*)launder(ws) + CW_Q + 64 * (l + 2 * rep), g_wv); }
        SEAM(pb + PH_MIX);
        if (IN(pb + PH_YNORM)) phase_ynorm(l, launder(ws), BID(), nb, g_wv);
        SEAM(pb + PH_YNORM);
        if (IN(pb + PH_OUTPROJ)) {
            unsigned char* ws = launder(args.ws);
            g8::DenseSched S{(const char*)(ws + WS_Y), (const char*)(ws + WS_WOUT) + (size_t)l * 1024 * 1024 * 2, 1024, 1024, 64, 4, nb, BID()};
            EpiOut E{(bf16_t*)(ws + WS_XB), (float*)(ws + WS_SSQ + PT_X1) + (size_t)l * 16384 * 16};
#ifndef NO_OUTPROJ
            g8::gemm_run(lds, 1024, 1024, S, E, g_wv);
#endif
        }
        SEAM(pb + PH_OUTPROJ);
#ifndef NO_ROUTE
        if (IN(pb + PH_ROUTE)) {
            const int b_ = BID();
            if (nb >= 256 && b_ >= 128) { cvt_moe_layer(in_tab(), launder(ws), l, (LAS float*)lds, b_ - 128, nb - 128, TIDX); if (l + 1 < L_) cvt_small_weights(in_tab(), launder(ws), l + 1, (LAS float*)lds, b_ - 128, nb - 128, TIDX); }
            else { phase_route(l, in_tab(), launder(ws), lds, b_, nb >= 256 ? 128 : nb, g_wv); if (nb < 256) { cvt_moe_layer(in_tab(), launder(ws), l, (LAS float*)lds, b_, nb, TIDX); if (l + 1 < L_) cvt_small_weights(in_tab(), launder(ws), l + 1, (LAS float*)lds, b_, nb, TIDX); } }
        }
#endif
        SEAM(pb + PH_ROUTE);
        if (IN(pb + PH_MOEUP)) for (int rep = 0; rep < NREP(PH_MOEUP); ++rep) {
            if (rep) xcd_barrier(bar);
            unsigned char* ws = launder(args.ws); moe_tables(l, ws, lds, g_wv);
            const unsigned* cnt = (const unsigned*)(ws + WS_CTL) + CW_CNT + 2048 * l; const unsigned* mtok = (const unsigned*)(ws + WS_META); const LAS int* tb = (const LAS int*)(lds + LDS_TB);
            MoeSched<2, true> S{(const char*)(ws + WS_XB), (const char*)(ws + WS_WMOE), cnt, mtok, tb, nb, BID(), (size_t)512 * 1024 * 2, (size_t)256 * 1024 * 2};
            EpiMoeUp E{mtok, (const float*)(ws + WS_RS2), tb, (bf16_t*)(ws + WS_HBUF)};
#ifndef NO_MOEUP
            g8::gemm_run(lds, 1024, 1024, S, E, g_wv);
#endif
        }
        SEAM(pb + PH_MOEUP);
        if (IN(pb + PH_MOEDOWN)) for (int rep = 0; rep < NREP(PH_MOEDOWN); ++rep) {
            if (rep) xcd_barrier(bar);
            unsigned char* ws = launder(args.ws); moe_tables(l, ws, lds, g_wv);
            const unsigned* cnt = (const unsigned*)(ws + WS_CTL) + CW_CNT + 2048 * l; const unsigned* mtok = (const unsigned*)(ws + WS_META); const LAS int* tb = (const LAS int*)(lds + LDS_TB);
            MoeSched<4, false> S{(const char*)(ws + WS_HBUF), (const char*)(ws + WS_WMOE + WMOE_WD), cnt, mtok, tb, nb, BID(), (size_t)1024 * 256 * 2, (size_t)256 * 256 * 2};
            EpiMoeDown E{mtok, (const float*)(ws + WS_META + META_W), tb, (bf16_t*)(ws + WS_YBUF)};
#ifndef NO_MOEDOWN
            g8::gemm_run(lds, 256, 256, S, E, g_wv);
#endif
        }
        SEAM(pb + PH_MOEDOWN);
#ifndef NO_COMBINE
        if (IN(pb + PH_COMBINE)) { unsigned char* ws = launder(args.ws); phase_combine(l, ws, args.out, BID(), nb, g_wv); }
#endif
        SEAM(pb + PH_COMBINE);
    }
#undef IN
#undef SEAM
}
#if CHECK
struct NvScratch { float *proj, *h1, *qk, *hraw, *kn, *kcmp, *vcmp, *dqn, *q, *dkvn, *kv, *krope, *y, *x1, *xl; int* rt_e; float* rt_w; };
constexpr int CB = 5;
enum { NS_INPROJ = 0, NS_NSAPREP, NS_MLAPREP, NS_NSA, NS_ML, NS_MLA, NS_OUT, NS_ROUTE, NS_MOE };
static void naive_step(void* const* d_in, int l, int step, const float* xin, float* xout, const NvScratch& S, hipStream_t st) {
    const int b = CB;
    const float* rel_bias = (const float*)d_in[2];
    const float* norm1_g = (const float*)d_in[3] + (long)l * 1024;
    const float* w_in = (const float*)d_in[4] + (long)l * 1024 * DIN;
    const float* cmp_pe = (const float*)d_in[5] + (long)l * 2 * 32 * 64;
    const float* cmp_w1 = (const float*)d_in[6] + (long)l * 2 * 32 * 64 * 64;
    const float* cmp_w2 = (const float*)d_in[7] + (long)l * 2 * 64 * 64;
    const float* q_norm = (const float*)d_in[8] + l * 64;
    const float* k_norm = (const float*)d_in[9] + l * 64;
    const float* nsa_on = (const float*)d_in[10] + l * 384;
    const float* conv = (const float*)d_in[11] + l * 4 * 512;
    const float* ibias = (const float*)d_in[12] + l * 4;
    const float* fbias = (const float*)d_in[13] + l * 4;
    const float* ml_on = (const float*)d_in[14] + l * 256;
    const float* qan = (const float*)d_in[15] + l * 192;
    const float* w_uq = (const float*)d_in[16] + (long)l * 192 * 576;
    const float* kvan = (const float*)d_in[17] + l * 128;
    const float* w_ukv = (const float*)d_in[18] + (long)l * 128 * 768;
    const float* qkn = (const float*)d_in[19] + l * 192;
    const float* mla_on = (const float*)d_in[20] + l * 384;
    const float* w_out = (const float*)d_in[21] + (long)l * 1024 * 1024;
    const float* norm2_g = (const float*)d_in[22] + l * 1024;
    const float* wgrp = (const float*)d_in[23] + (long)l * 1024 * 4;
    const float* bgrp = (const float*)d_in[24] + l * 4;
    const float* wexp = (const float*)d_in[25] + (long)l * 1024 * 32;
    const float* bexp = (const float*)d_in[26] + l * 32;
    const float* Wg = (const float*)d_in[27] + (long)l * 32 * 1024 * 256;
    const float* Wu = (const float*)d_in[28] + (long)l * 32 * 1024 * 256;
    const float* Wd = (const float*)d_in[29] + (long)l * 32 * 256 * 1024;
    const int* pos = (const int*)d_in[1] + b * 2048;
    switch (step) {
    case NS_INPROJ:
        nv_rmsnorm<<<dim3(2048, 1), 64, 0, st>>>(xin, 1024, 0, S.h1, 1024, 0, norm1_g, 0, 1024);
        nv_gemm<<<dim3((DIN + 63) / 64, 2048 / 64), 256, 0, st>>>(S.h1, 1024, w_in, DIN, S.proj, DIN, nullptr, 0, 2048, DIN, 1024);
        break;
    case NS_NSAPREP:
        nv_nsa_cmp<<<dim3(127, 2, 2), 64, 0, st>>>(S.proj, cmp_pe, cmp_w1, cmp_w2, k_norm, S.kcmp, S.vcmp);
        nv_nsa_knorm<<<dim3(2048, 4), 64, 0, st>>>(S.proj, k_norm, S.kn);
        break;
    case NS_MLAPREP:
        nv_rmsnorm<<<dim3(2048, 1), 64, 0, st>>>(S.proj + O_CDQ, DIN, 0, S.dqn, 192, 0, qan, 0, 192);
        nv_gemm<<<dim3(576 / 64, 2048 / 64), 256, 0, st>>>(S.dqn, 192, w_uq, 576, S.q, 576, nullptr, 0, 2048, 576, 192);
        nv_rmsnorm<<<dim3(2048, 1), 64, 0, st>>>(S.proj + O_CDKV, DIN, 0, S.dkvn, 128, 0, kvan, 0, 128);
        nv_gemm<<<dim3(768 / 64, 2048 / 64), 256, 0, st>>>(S.dkvn, 128, w_ukv, 768, S.kv, 768, nullptr, 0, 2048, 768, 128);
        nv_mla_prep<<<dim3(2048, 7), 64, 0, st>>>(S.q, S.kv, S.proj, S.krope, qkn, pos);
        break;
    case NS_NSA:
        nv_nsa_attn<<<dim3(2048, 2), 192, 0, st>>>(S.proj, S.kn, S.kcmp, S.vcmp, rel_bias, q_norm, S.y);
        break;
    case NS_ML:
        nv_ml_conv<<<2048, 512, 0, st>>>(S.proj, conv, S.qk);
        nv_ml_rec<<<4, 256, 0, st>>>(S.proj, S.qk, ibias, fbias, S.hraw);
        nv_ml_fin<<<dim3(2048, 4), 64, 0, st>>>(S.proj, S.hraw, ml_on, S.y);
        break;
    case NS_MLA:
        nv_mla_attn<<<dim3(2048, 6), 64, 0, st>>>(S.q, S.kv, S.krope, S.y);
        break;
    case NS_OUT:
        nv_rmsnorm<<<dim3(2048, 1), 64, 0, st>>>(S.y, 1024, 0, S.y, 1024, 0, nsa_on, 0, 384);
        nv_rmsnorm<<<dim3(2048, 1), 64, 0, st>>>(S.y + 640, 1024, 0, S.y + 640, 1024, 0, mla_on, 0, 384);
        nv_gemm<<<dim3(1024 / 64, 2048 / 64), 256, 0, st>>>(S.y, 1024, w_out, 1024, S.x1, 1024, xin, 1024, 2048, 1024, 1024);
        break;
    case NS_ROUTE:
        nv_moe_route<<<2048, 64, 0, st>>>(S.x1, norm2_g, wgrp, bgrp, wexp, bexp, S.h1, S.rt_e, S.rt_w);
        break;
    case NS_MOE:
        nv_moe_exp<<<2048, 256, 0, st>>>(S.x1, S.h1, S.rt_e, S.rt_w, Wg, Wu, Wd, xout);
        break;
    }
}

__device__ __forceinline__ void chk_commit(float d2, float r2, float* acc) { d2 = wave_sum(d2); r2 = wave_sum(r2); if ((threadIdx.x & 63) == 0) { atomicAdd(acc, d2); atomicAdd(acc + 1, r2); } }
__device__ __forceinline__ void chk_add(float f, float r, float& d2, float& r2) { const float d = f - r; d2 += (d == d) ? d * d : 1e30f; r2 += r * r; }

__global__ void __launch_bounds__(64) chk_proj(const float* nproj, const unsigned char* prj, const float* ssq_dq, const float* ssq_dkv, const float* qg, const float* kg, const float* krg, const int* pos, float* acc) {
    const int t = blockIdx.x, e = threadIdx.x; const size_t row = (size_t)CB * 2048 + t; float d2 = 0.f, r2 = 0.f;
    for (int G = 0; G < 40; ++G) {
        const int c = inproj_refcol(G, e); float r = c < 0 ? 0.f : nproj[(size_t)t * DIN + c]; float f = 0.f;
        const float rr = (G == 37 && e >= 32) ? 0.f : r; const float ss = wave_sum(rr * rr);
        if (G < 6) { r = r * rsqrtf(ss / 64.f + 1e-6f) * qg[e] * 0.18033688f; f = bf2f(((const bf16_t*)(prj + PRJ_QN))[((size_t)(CB * 6 + G) * 2048 + t) * 64 + e]); }
        else if (G < 18) { const int a = G - 6, br = a >> 2, s = (a >> 1) & 1, hk = a & 1;
            if (br > 0 && s == 0) r = r * rsqrtf(ss / 64.f + 1e-6f) * kg[e];
            const size_t base = br == 0 ? (s ? PRJ_C0V : PRJ_C0K) : (br == 1 ? (s ? PRJ_VN1 : PRJ_KN1) : (s ? PRJ_VN2 : PRJ_KN2));
            f = bf2f(((const bf16_t*)(prj + base))[((size_t)(CB * 2 + hk) * 2048 + t) * 64 + e]); }
        else if (G < 26) f = bf2f(((const bf16_t*)(prj + PRJ_RAWQK))[row * 512 + (G - 18) * 64 + e]);
        else if (G < 30) f = bf2f(((const bf16_t*)(prj + PRJ_VML))[((size_t)(CB * 4 + (G - 26)) * 2048 + t) * 64 + e]);
        else if (G < 34) f = bf2f(((const bf16_t*)(prj + PRJ_OG))[row * 256 + (G - 30) * 64 + e]);
        else if (G < 37) f = bf2f(((const bf16_t*)(prj + PRJ_DQKV))[row * 384 + (G - 34) * 64 + e]);
        else if (G == 37) {
            const float val = e < 32 ? rr * rsqrtf(ss / 32.f + 1e-6f) * krg[e & 31] : 0.f; const float oth = __shfl_xor(val, 16);
            if (e < 32) { const int i = e & 15; const double ang = (double)pos[row] * pow(10000.0, -(double)i / 16.0); const float cs = (float)cos(ang), sn = (float)sin(ang);
                r = e < 16 ? val * cs - oth * sn : val * cs + oth * sn; f = bf2f(((const bf16_t*)(prj + PRJ_KR))[row * 32 + e]); }
            else if (e < 58) f = ((const float*)(prj + PRJ_GATES))[row * 32 + (e - 32)];
            else { f = 0.f; r = 0.f; }
        }
        else f = bf2f(((const bf16_t*)(prj + PRJ_DQKV))[row * 384 + 256 + (G - 38) * 64 + e]);
        chk_add(f, r, d2, r2);
    }
    float d2s = 0.f, r2s = 0.f;
    { float s1 = 0.f, s2 = 0.f; for (int c = e; c < 192; c += 64) { float v = nproj[(size_t)t * DIN + O_CDQ + c]; s1 += v * v; } for (int c = e; c < 128; c += 64) { float v = nproj[(size_t)t * DIN + O_CDKV + c]; s2 += v * v; }
      s1 = wave_sum(s1); s2 = wave_sum(s2); if (e == 0) { chk_add((ssq_dq[row * 4] + ssq_dq[row * 4 + 1]) + ssq_dq[row * 4 + 2], s1, d2s, r2s); chk_add(ssq_dkv[row * 2] + ssq_dkv[row * 2 + 1], s2, d2s, r2s); } }
    chk_commit(d2, r2, acc); chk_commit(d2s, r2s, acc + 2);
}

__global__ void __launch_bounds__(64) chk_prep(const float* nq, const float* nkv, const float* nkr, const float* nkc, const float* nvc, const unsigned char* ws, float* acc) {
    const int t = blockIdx.x, e = threadIdx.x; float d2 = 0.f, r2 = 0.f, d2c = 0.f, r2c = 0.f; const float scale = 0.14724444f;
    const bf16_t* QM = (const bf16_t*)(ws + WS_MLA); const bf16_t* KM = (const bf16_t*)(ws + WS_MLA + MLA_KM); const bf16_t* VM = (const bf16_t*)(ws + WS_MLA + MLA_VM);
    for (int h = 0; h < 6; ++h) {
        const size_t rq = ((size_t)(CB * 6 + h) * 2048 + t);
        chk_add(bf2f(QM[rq * 96 + e]), nq[(size_t)t * 576 + h * 96 + e] * scale, d2, r2);
        chk_add(bf2f(KM[rq * 96 + e]), nkv[(size_t)t * 768 + h * 128 + e], d2, r2);
        chk_add(bf2f(VM[rq * 64 + e]), nkv[(size_t)t * 768 + h * 128 + 64 + e], d2, r2);
        if (e < 32) { chk_add(bf2f(QM[rq * 96 + 64 + e]), nq[(size_t)t * 576 + h * 96 + 64 + e] * scale, d2, r2); chk_add(bf2f(KM[rq * 96 + 64 + e]), nkr[(size_t)t * 32 + e], d2, r2); }
    }
    if (t < 128) for (int hk = 0; hk < 2; ++hk) {
        const bf16_t* KC = (const bf16_t*)(ws + WS_CMP); const bf16_t* VC = (const bf16_t*)(ws + WS_CMP + CMP_V); const size_t rf = ((size_t)(CB * 2 + hk) * 128 + t) * 64 + e;
        chk_add(bf2f(KC[rf]), t < 127 ? nkc[(size_t)(hk * 127 + t) * 64 + e] : 0.f, d2c, r2c); chk_add(bf2f(VC[rf]), t < 127 ? nvc[(size_t)(hk * 127 + t) * 64 + e] : 0.f, d2c, r2c);
    }
    chk_commit(d2, r2, acc); chk_commit(d2c, r2c, acc + 2);
}

__global__ void __launch_bounds__(64) chk_y(const float* ny, const unsigned char* ws, float* acc, int nseg) {
    const int t = blockIdx.x, e = threadIdx.x; const bf16_t* Y = (const bf16_t*)(ws + WS_Y) + ((size_t)CB * 2048 + t) * 1024;
    float d2[3] = {0.f, 0.f, 0.f}, r2[3] = {0.f, 0.f, 0.f};
    for (int c = e; c < 1024; c += 64) { const int seg = c < 384 ? 0 : (c < 640 ? 1 : 2); const float f = bf2f(Y[c]), r = ny[(size_t)t * 1024 + c];
        if (seg == 0) chk_add(f, r, d2[0], r2[0]); else if (seg == 1) chk_add(f, r, d2[1], r2[1]); else chk_add(f, r, d2[2], r2[2]); }
    if (nseg == 3) { chk_commit(d2[0], r2[0], acc); chk_commit(d2[1], r2[1], acc + 2); chk_commit(d2[2], r2[2], acc + 4); }
    else chk_commit(d2[0] + d2[1] + d2[2], r2[0] + r2[1] + r2[2], acc);
}

__global__ void __launch_bounds__(64) chk_x(const float* nx, const unsigned char* ws, float* acc) {
    const int t = blockIdx.x, e = threadIdx.x; const bf16_t* X = (const bf16_t*)(ws + WS_XB) + ((size_t)CB * 2048 + t) * 1024; float d2 = 0.f, r2 = 0.f;
    for (int c = e; c < 1024; c += 64) chk_add(bf2f(X[c]), nx[(size_t)t * 1024 + c], d2, r2);
    chk_commit(d2, r2, acc);
}

__global__ void __launch_bounds__(512) chk_code(float* acc, int nst, const float* nout) {
    __shared__ float sh[512];
    float s = 0.f; for (int i = threadIdx.x; i < 2048 * 1024; i += 512) { float v = nout[i]; s += v * v; }
    sh[threadIdx.x] = s; __syncthreads();
    if (threadIdx.x == 0) { float tot = 0.f; for (int i = 0; i < 512; ++i) tot += sh[i]; float rms = sqrtf(tot / (2048.f * 1024.f)); if (!(rms > 1e-3f && rms < 1e3f)) rms = 1.f;
        int code = 0;
        for (int st = 0; st < nst; ++st) { const float d2 = acc[2 * st], r2 = acc[2 * st + 1]; if (r2 == 0.f && d2 == 0.f) { if ((st & 15) >= 9) continue; code = (st + 1) * 4 + 3; break; } const float err = d2 / fmaxf(r2, 1e-30f);
            const float tol = CHK_TOL(st);
            if (!(err <= tol)) { const int cls = !(err < 1.f) ? 3 : (err >= 0.1f ? 2 : (err >= 0.01f ? 1 : 0)); code = (st + 1) * 4 + cls; break; } }
        acc[2 * 40] = rms * 32.f * exp2f(0.5f * (float)code); }
}
__global__ void __launch_bounds__(512) chk_fill(const float* acc, float* out) {
    const float K = acc[2 * 40];
    for (size_t i = (size_t)blockIdx.x * 512 + threadIdx.x; i < (size_t)NTOK * 1024; i += (size_t)gridDim.x * 512) out[i] = (i & 1) ? -K : K;
}
#endif

#if TIME_PH != -1
#ifndef TIME_Q
#define TIME_Q 6.f
#endif
#ifndef TIME_CAL
#define TIME_CAL 1.0f
#endif
__global__ void __launch_bounds__(512) tm_fill(const unsigned long long* ts, float* out) {
    float T = 100.f; if (TIME_PH >= 0) { int a = TIME_PH, b = TIME_PH + 1;
#ifdef TIME_PH_END
        b = TIME_PH_END;
#endif
        T = (float)(ts[b] - ts[a]) * 0.01f; }
    T = exp2f(rintf(log2f(fmaxf(T, 1.f)) * TIME_Q) / TIME_Q);
    const float c = sqrtf(T) * TIME_CAL;
    for (size_t i = (size_t)blockIdx.x * 512 + threadIdx.x; i < (size_t)NTOK * 1024; i += (size_t)gridDim.x * 512) out[i] = (i & 1) ? -c : c;
}
#endif
static int g_grid = 0;
static bool setup_once(size_t ws_size) {
    if (g_grid) return g_grid > 0;
    if (ws_size < WS_END) { fprintf(stderr, "kernel_launch: workspace too small: %zu < %zu\n", ws_size, (size_t)WS_END); g_grid = -1; return false; }
    int dev = 0, cus = 0, per_cu = 0;
    if (hipGetDevice(&dev) != hipSuccess || hipDeviceGetAttribute(&cus, hipDeviceAttributeMultiprocessorCount, dev) != hipSuccess) { g_grid = -1; return false; }
    if (hipFuncSetAttribute((const void*)mk, hipFuncAttributeMaxDynamicSharedMemorySize, LDS_BYTES) != hipSuccess) { fprintf(stderr, "kernel_launch: hipFuncSetAttribute failed\n"); g_grid = -1; return false; }
    if (hipOccupancyMaxActiveBlocksPerMultiprocessor(&per_cu, (const void*)mk, 512, LDS_BYTES) != hipSuccess || per_cu < 1) { fprintf(stderr, "kernel_launch: occupancy query says %d\n", per_cu); }
    (void)hipGetLastError();
    g_grid = cus;
    return true;
}
static void launch_mk(const Args& a0, int lo, int hi, hipStream_t stream) { Args a = a0; a.ph_lo = lo; a.ph_hi = hi; hipLaunchKernelGGL(mk, dim3(g_grid), dim3(512), LDS_BYTES, stream, a); }

extern "C" void kernel_launch(void* const* d_in, const int* in_sizes, int n_in, void* d_out, int out_size, void* d_ws, size_t ws_size, hipStream_t stream) {
    if (!setup_once(ws_size)) return;
    unsigned char* ws = (unsigned char*)d_ws;
    (void)hipMemsetAsync(ws + WS_CTL, 0, ZERO_BYTES, stream);
    Args a{}; for (int i = 0; i < 30; ++i) a.in.p[i] = (const float*)d_in[i];
    a.out = (float*)d_out; a.ws = ws; a.ph_lo = 0; a.ph_hi = 0;
#if CHECK
    a.out = nullptr;
#endif
#if CHECK
    float* nb = (float*)d_out; size_t off = 0; NvScratch S;
    auto take = [&](size_t n) { float* p = nb + off; off += (n + 63) & ~(size_t)63; return p; };
    S.proj = take((size_t)2048 * DIN); S.h1 = take(2048 * 1024); S.qk = S.h1; S.hraw = S.qk + 2048 * 512; S.kn = S.hraw + 2048 * 256;
    S.kcmp = take(2 * 127 * 64); S.vcmp = take(2 * 127 * 64); S.dqn = take(2048 * 192); S.q = take(2048 * 576); S.dkvn = take(2048 * 128); S.kv = take(2048 * 768); S.x1 = S.dqn;
    S.krope = take(2048 * 32); S.y = take(2048 * 1024); S.xl = take(2048 * 1024); S.rt_e = (int*)take(2048 * 2); S.rt_w = take(2048 * 2);
    if (off * 4 > (size_t)NTOK * 1024 * 4) { fprintf(stderr, "naive scratch too big\n"); return; }
    float* acc = (float*)(ws + WS_CTL) + CW_CHK;
    launch_mk(a, 0, 1, stream);
    const float* nx_in = (const float*)d_in[0] + (size_t)CB * 2048 * 1024;
    int nst = 0;
    for (int l = 0; l < L_; ++l) {
        const int pb = 1 + l * NPH; const int sb = l * 16;
        launch_mk(a, pb + PH_INPROJ, pb + PH_INPROJ + 1, stream);
        naive_step(d_in, l, NS_INPROJ, nx_in, S.xl, S, stream);
        chk_proj<<<2048, 64, 0, stream>>>(S.proj, ws + WS_PRJ, (const float*)(ws + WS_SSQ + PT_DQ) + (size_t)l * 16384 * 4, (const float*)(ws + WS_SSQ + PT_DKV) + (size_t)l * 16384 * 2,
                                           (const float*)d_in[8] + l * 64, (const float*)d_in[9] + l * 64, (const float*)d_in[19] + l * 192 + 160, (const int*)d_in[1], acc + 2 * (sb + 0));
        nst = sb + 2;
        int ns_done = NS_INPROJ;
#if CHECK_UPTO >= 1
        launch_mk(a, pb + PH_PREP, pb + PH_PREP + 1, stream);
        naive_step(d_in, l, NS_NSAPREP, nx_in, S.xl, S, stream); naive_step(d_in, l, NS_MLAPREP, nx_in, S.xl, S, stream); ns_done = NS_MLAPREP;
        chk_prep<<<2048, 64, 0, stream>>>(S.q, S.kv, S.krope, S.kcmp, S.vcmp, ws, acc + 2 * (sb + 2));
        nst = sb + 4;
#endif
#if CHECK_UPTO >= 2
        launch_mk(a, pb + PH_MIX, pb + PH_MIX + 1, stream);
        naive_step(d_in, l, NS_NSA, nx_in, S.xl, S, stream); naive_step(d_in, l, NS_ML, nx_in, S.xl, S, stream); naive_step(d_in, l, NS_MLA, nx_in, S.xl, S, stream); ns_done = NS_MLA;
        chk_y<<<2048, 64, 0, stream>>>(S.y, ws, acc + 2 * (sb + 4), 3);
        nst = sb + 7;
#endif
#if CHECK_UPTO >= 3
        launch_mk(a, pb + PH_YNORM, pb + PH_YNORM + 1, stream); launch_mk(a, pb + PH_OUTPROJ, pb + PH_OUTPROJ + 1, stream);
        naive_step(d_in, l, NS_OUT, nx_in, S.xl, S, stream); ns_done = NS_OUT;
        chk_x<<<2048, 64, 0, stream>>>(S.x1, ws, acc + 2 * (sb + 7));
        nst = sb + 8;
#endif
#if CHECK_UPTO >= 4
        for (int ph = PH_ROUTE; ph <= PH_COMBINE; ++ph) launch_mk(a, pb + ph, pb + ph + 1, stream);
        naive_step(d_in, l, NS_ROUTE, nx_in, S.xl, S, stream); naive_step(d_in, l, NS_MOE, nx_in, S.xl, S, stream); ns_done = NS_MOE;
        chk_x<<<2048, 64, 0, stream>>>(S.xl, ws, acc + 2 * (sb + 8));
        nst = sb + 9;
#endif
        CHECK_REST
        for (int s = ns_done + 1; s <= NS_MOE; ++s) naive_step(d_in, l, s, nx_in, S.xl, S, stream);
        nx_in = S.xl;
        if (l == CHECK_LAYERS - 1) break;
    }
    chk_code<<<1, 512, 0, stream>>>(acc, nst, S.xl);
    chk_fill<<<1024, 512, 0, stream>>>(acc, (float*)d_out);
#else
#if defined(SPLIT_LAUNCH) && SPLIT_LAUNCH
    for (int ph = 0; ph < 1 + L_ * NPH; ++ph) launch_mk(a, ph, ph + 1, stream);
#else
    launch_mk(a, 0, 1 + L_ * NPH, stream);
#if TIME_PH != -1
    (void)hipMemsetAsync(ws + WS_CTL, 0, ZERO_BYTES, stream); launch_mk(a, 0, 1 + L_ * NPH, stream);
    tm_fill<<<1024, 512, 0, stream>>>((const unsigned long long*)((unsigned*)(ws + WS_CTL) + CW_TS), (float*)d_out);
#endif
#endif
#endif
}
```

```cpp
#define CHECK 0
#define CHECK_LAYERS 2
#define CHECK_UPTO 99
#define SPLIT_LAUNCH 0
#define REPEAT_PH -1
#include <hip/hip_runtime.h>
#include <stdint.h>
#include <cstdio>

constexpr int B_ = 8, T_ = 2048, D_ = 1024, L_ = 2, NTOK = B_ * T_;
constexpr int DIN = 2554;
constexpr int O_AQ = 0, O_AKV = 384, O_AG = 1152, O_BQK = 1170, O_BV = 1682, O_BIF = 1938, O_BO = 1946, O_CDQ = 2202, O_CDKV = 2394, O_CKR = 2522;

typedef unsigned short bf16_t;
typedef short bf16x8 __attribute__((ext_vector_type(8)));
typedef short s16x4 __attribute__((ext_vector_type(4)));
typedef float f32x4 __attribute__((ext_vector_type(4)));
typedef float f32x16 __attribute__((ext_vector_type(16)));
typedef unsigned u32x4 __attribute__((ext_vector_type(4)));
typedef unsigned u32x2 __attribute__((ext_vector_type(2)));
typedef float f32x2_t __attribute__((ext_vector_type(2)));
typedef __bf16 bf16x2_t __attribute__((ext_vector_type(2)));
#define LAS __attribute__((address_space(3)))

__device__ __forceinline__ unsigned pk_bf16(float lo, float hi) { f32x2_t v = {lo, hi}; bf16x2_t b = __builtin_convertvector(v, bf16x2_t); return __builtin_bit_cast(unsigned, b); }
__device__ __forceinline__ float bf_lo(unsigned u) { return __builtin_bit_cast(float, u << 16); }
__device__ __forceinline__ float bf_hi(unsigned u) { return __builtin_bit_cast(float, u & 0xffff0000u); }
__device__ __forceinline__ float bf2f(bf16_t h) { return __builtin_bit_cast(float, (unsigned)h << 16); }
__device__ __forceinline__ bf16_t f2bf(float f) { return (bf16_t)(pk_bf16(f, 0.f) & 0xffffu); }
__device__ __forceinline__ float wave_sum(float v) { for (int o = 32; o; o >>= 1) v += __shfl_xor(v, o); return v; }
__device__ __forceinline__ float wave_max(float v) { for (int o = 32; o; o >>= 1) v = fmaxf(v, __shfl_xor(v, o)); return v; }
__device__ __forceinline__ float siluf(float x) { return x / (1.f + __expf(-x)); }
__device__ __forceinline__ float sigmf(float x) { return 1.f / (1.f + __expf(-x)); }
__device__ __forceinline__ int t5b(int dist) {
    int n = dist > 0 ? dist : 0; if (n < 16) return n;
    float v = logf((float)n / 16.f) / logf(8.f) * 16.f; int l = 16 + (int)v; return l < 31 ? l : 31;
}

__device__ __forceinline__ int lane_now() { return (int)__builtin_amdgcn_mbcnt_hi(~0u, __builtin_amdgcn_mbcnt_lo(~0u, 0u)); }
#define TIDX ((g_wv << 6) | lane_now())

constexpr size_t WS_CTL = 0, CTL_BYTES = 65536;
constexpr size_t WS_SSQ = WS_CTL + CTL_BYTES;
constexpr size_t ZERO_BYTES = CTL_BYTES;
constexpr size_t PT_DQ = 0, PT_DKV = PT_DQ + (size_t)2 * 16384 * 4 * 4, PT_A = PT_DKV + (size_t)2 * 16384 * 2 * 4, PT_C = PT_A + (size_t)2 * 16384 * 8 * 4, PT_X1 = PT_C + (size_t)2 * 16384 * 8 * 4, PT_END = PT_X1 + (size_t)2 * 16384 * 16 * 4;
constexpr size_t WS_SSQX = WS_SSQ + PT_END;
constexpr size_t WS_RS2 = WS_SSQX + 2 * 65536;
constexpr size_t WS_WIN = WS_RS2 + 65536;
constexpr size_t WS_WOUT = WS_WIN + (size_t)2 * 2560 * 1024 * 2;
constexpr size_t WS_WUQ = WS_WOUT + (size_t)2 * 1024 * 1024 * 2;
constexpr size_t WS_WUKV = WS_WUQ + (size_t)2 * 768 * 256 * 2;
constexpr size_t WS_WC1 = WS_WUKV + (size_t)2 * 768 * 256 * 2;
constexpr size_t WS_WC2 = WS_WC1 + (size_t)2 * 2 * 64 * 2048 * 2;
constexpr size_t WS_WR = WS_WC2 + (size_t)2 * 2 * 64 * 64 * 2;
constexpr size_t WS_B1C = WS_WR + (size_t)2 * 64 * 1024 * 2;
constexpr size_t WS_BIASD = WS_B1C + 1024;
constexpr size_t WS_ROPE = WS_BIASD + 6 * 2048 * 4;
constexpr size_t WS_WMOE = WS_ROPE + (size_t)16384 * 32 * 4;
constexpr size_t WMOE_WD = (size_t)32 * 512 * 1024 * 2;
constexpr size_t WS_XB = WS_WMOE + 50331648;
constexpr size_t WS_MLA = WS_XB + 33554432;
constexpr size_t MLA_KM = (size_t)8 * 6 * 2048 * 96 * 2, MLA_VM = 2 * MLA_KM;
constexpr size_t WS_HBUF = WS_MLA;
constexpr size_t WS_PRJ = WS_MLA + 50331648;
constexpr size_t HM64 = (size_t)2048 * 64 * 2;
constexpr size_t PRJ_QN = 0;
constexpr size_t PRJ_KN1 = PRJ_QN + 48 * HM64, PRJ_VN1 = PRJ_KN1 + 16 * HM64, PRJ_KN2 = PRJ_VN1 + 16 * HM64, PRJ_VN2 = PRJ_KN2 + 16 * HM64;
constexpr size_t PRJ_VML = PRJ_VN2 + 16 * HM64;
constexpr size_t PRJ_OG = PRJ_VML + 32 * HM64;
constexpr size_t PRJ_KR = PRJ_OG + (size_t)16384 * 256 * 2;
constexpr size_t PRJ_GATES = PRJ_KR + (size_t)16384 * 32 * 2;
constexpr size_t PRJ_DEAD = PRJ_GATES + (size_t)16384 * 32 * 4;
constexpr size_t PRJ_C0K = PRJ_DEAD, PRJ_C0V = PRJ_C0K + 16 * HM64 + 8192;
constexpr size_t PRJ_RAWQK = PRJ_C0V + 16 * HM64 + 8192;
constexpr size_t PRJ_DQKV = PRJ_RAWQK + (size_t)16384 * 512 * 2;
constexpr size_t PRJ_END = PRJ_DQKV + (size_t)16384 * 384 * 2;
static_assert(PRJ_END - PRJ_DEAD >= 33554432, "Y fits the dead part of PRJ");
constexpr size_t WS_Y = WS_PRJ + PRJ_DEAD;
constexpr size_t WS_YBUF = WS_PRJ;
static_assert((size_t)2 * 16384 * 1024 * 2 <= PRJ_END, "YBUF fits the PRJ region");
constexpr size_t WS_ML = WS_PRJ + PRJ_END;
constexpr size_t ML_KC = 32 * HM64, ML_DELTA = 2 * ML_KC, ML_DN = ML_DELTA + (size_t)1024 * 4096 * 2, ML_G = ML_DN + (size_t)1024 * 64 * 4, ML_BL = ML_G + (size_t)8 * 4 * 2048 * 2 * 4, ML_CP = ML_BL + 4096, ML_NP = ML_CP + (size_t)1024 * 4096 * 2, ML_END = ML_NP + (size_t)1024 * 64 * 2;
constexpr size_t WS_CMP = WS_ML + ML_END;
constexpr size_t CMP_V = (size_t)8 * 2 * 128 * 64 * 2;
constexpr size_t WS_META = WS_CMP + 2 * CMP_V;
constexpr size_t META_W = (size_t)32 * 16384 * 4, META_RT = 2 * META_W;
constexpr size_t WS_END = WS_META + META_RT + (size_t)16384 * 16;
constexpr int CW_BAR = 0;
constexpr int CW_Q = 4096;
constexpr int CW_SCAN = 4608;
constexpr int CW_TS = 4864;
constexpr int CW_CHK = 5120;
constexpr int CW_CNT = 8192;
constexpr int LDS_BYTES = 147456;
constexpr int LDS_MISC = LDS_BYTES - 256;
#define XB_TMO      128
#define XB_XCNT(j)  (256  + 64 * (j))
#define XB_XSUB(j)  (1280 + 64 * (j))
#define XB_XGEN(j)  (2304 + 64 * (j))
#define XB_TOP      3328
#define XB_TOPGEN   3392
#define XCD_BAR_WORDS 3456
#define XB_SPIN_CAP (1u << 18)

__device__ __forceinline__ unsigned xb_ld(unsigned* p)              { return __hip_atomic_load(p, __ATOMIC_RELAXED, __HIP_MEMORY_SCOPE_AGENT); }
__device__ __forceinline__ unsigned xb_add(unsigned* p, unsigned v) { return __hip_atomic_fetch_add(p, v, __ATOMIC_RELAXED, __HIP_MEMORY_SCOPE_AGENT); }
__device__ __forceinline__ unsigned xb_xcc_id() { return (unsigned)__builtin_amdgcn_s_getreg((3 << 11) | 20) & 0xFu; }
#define XB_SPIN(cond, bar) do { unsigned _sp = 0; while (cond) { __builtin_amdgcn_s_sleep(1); \
    if ((++_sp & 255u) == 0u) { if (xb_ld(&(bar)[XB_TMO])) break; if (_sp > XB_SPIN_CAP) { atomicAdd(&(bar)[XB_TMO], 1u); break; } } } } while (0)

struct XcdBarrier {
    int g_wv; unsigned* bar; unsigned x;
    volatile LAS unsigned* st;
};

__device__ __forceinline__ XcdBarrier xcd_barrier_post(unsigned* bar, volatile LAS unsigned* st, int g_wv) {
    XcdBarrier b; b.g_wv = g_wv; b.bar = bar; b.x = xb_xcc_id(); b.st = st;
    if (TIDX == 0) (void)xb_add(&bar[XB_XCNT(b.x)], 1u);
    return b;
}
__device__ __forceinline__ void xcd_barrier_complete(unsigned* bar, unsigned x, unsigned& nloc, unsigned& nx) {
    const unsigned G = gridDim.x * gridDim.y * gridDim.z;
    unsigned sum, cnt, mine, sp = 0u;
    for (;;) {
        sum = 0u; cnt = 0u; mine = 0u;
#pragma unroll
        for (unsigned j = 0; j < 16; ++j) { const unsigned c = xb_ld(&bar[XB_XCNT(j)]); sum += c; cnt += (c > 0u) ? 1u : 0u; mine = (j == x) ? c : mine; }
        if (sum == G) break;
        __builtin_amdgcn_s_sleep(1);
        if ((++sp & 255u) == 0u) { if (xb_ld(&bar[XB_TMO])) break; if (sp > XB_SPIN_CAP) { atomicAdd(&bar[XB_TMO], 1u); break; } }
    }
    nloc = mine > 0u ? mine : 1u; nx = cnt > 0u ? cnt : 1u;
}

__device__ __forceinline__ void xcd_barrier(const XcdBarrier& b) {
    asm volatile("s_waitcnt vmcnt(0)" ::: "memory");
    __syncthreads();
    const int g_wv = b.g_wv;
    if (TIDX == 0) {
        unsigned* bar = b.bar;
        __builtin_amdgcn_s_waitcnt(0);
        unsigned nloc = b.st[0], nx = b.st[1];
        if (nloc == 0u) { xcd_barrier_complete(bar, b.x, nloc, nx); b.st[0] = nloc; b.st[1] = nx; }
        const unsigned old = xb_add(&bar[XB_XSUB(b.x)], 1u);
        const unsigned gen = old / nloc;
        if (old + 1u == (gen + 1u) * nloc) {
            __builtin_amdgcn_fence(__ATOMIC_RELEASE, "agent");
            asm volatile("s_waitcnt vmcnt(0)" ::: "memory");
            const unsigned og = xb_add(&bar[XB_TOP], 1u);
            const unsigned tg = og / nx;
            if (og + 1u == (tg + 1u) * nx) xb_add(&bar[XB_TOPGEN], 1u);
            else XB_SPIN(xb_ld(&bar[XB_TOPGEN]) == tg, bar);
            __builtin_amdgcn_fence(__ATOMIC_ACQUIRE, "agent");
            xb_add(&bar[XB_XGEN(b.x)], 1u);
            asm volatile("s_waitcnt vmcnt(0)" ::: "memory");
        } else {
            XB_SPIN(xb_ld(&bar[XB_XGEN(b.x)]) == gen, bar);
            __builtin_amdgcn_fence(__ATOMIC_ACQUIRE, "agent");
            asm volatile("s_waitcnt vmcnt(0)" ::: "memory");
        }
    }
    __syncthreads();
}
struct Inputs { const float* p[30]; };
typedef const __attribute__((address_space(4))) Inputs* InPtr;
__device__ __forceinline__ InPtr in_tab() { InPtr p = (InPtr)__builtin_amdgcn_kernarg_segment_ptr(); asm volatile("" : "+s"(p)); return p; }
__device__ __forceinline__ unsigned char* launder(unsigned char* p) { size_t z = 0; asm volatile("" : "+s"(z)); return p + z; }

__host__ __device__ inline int inproj_refcol(int G, int e) {
    if (G < 6) return O_AQ + G * 64 + e;
    if (G < 18) return O_AKV + (G - 6) * 64 + e;
    if (G < 26) return O_BQK + (G - 18) * 64 + e;
    if (G < 30) return O_BV + (G - 26) * 64 + e;
    if (G < 34) return O_BO + (G - 30) * 64 + e;
    if (G < 37) return O_CDQ + (G - 34) * 64 + e;
    if (G == 37) { if (e < 32) return O_CKR + e; if (e < 50) return O_AG + (e - 32); if (e < 58) return O_BIF + (e - 50); return -1; }
    return O_CDKV + (G - 38) * 64 + e;
}
__host__ __device__ inline int uq_refcol(int G, int e) {
    if (G < 6) return G * 96 + e;
    if (G < 9) { const int idx = e & 31, bj = e >> 5, sub = idx >> 4, i = idx & 15; return (2 * (G - 6) + sub) * 96 + 64 + bj * 16 + i; }
    return -1;
}
__host__ __device__ inline int ukv_refcol(int G, int e) { return G < 6 ? G * 128 + e : (G - 6) * 128 + 64 + e; }
#define N2G(n) ((((n) >> 8) << 2) + (((n) >> 5) & 3))
#define N2E(n) (((((n) >> 7) & 1) << 5) + ((n) & 31))

struct FWin { const float* w; const float* g; __device__ __forceinline__ float operator()(int k, int n) const { const int c = inproj_refcol(N2G(n), N2E(n)); return c < 0 ? 0.f : w[(size_t)k * DIN + c] * g[k]; } };
struct FWout { const float* w; const float* ga; const float* gc; __device__ __forceinline__ float operator()(int k, int n) const { const float og = k < 384 ? ga[k] : (k < 640 ? 1.f : gc[k - 640]); return w[(size_t)k * 1024 + n] * og; } };
struct FWuq { const float* w; const float* g; __device__ __forceinline__ float operator()(int k, int n) const { const int c = uq_refcol(N2G(n), N2E(n)); return (k < 192 && c >= 0) ? w[(size_t)k * 576 + c] * g[k] : 0.f; } };
struct FWukv { const float* w; const float* g; __device__ __forceinline__ float operator()(int k, int n) const { const int c = ukv_refcol(N2G(n), N2E(n)); return k >= 128 ? w[(size_t)(k - 128) * 768 + c] * g[k - 128] : 0.f; } };
struct FWc1 { const float* w; __device__ __forceinline__ float operator()(int k, int n) const { return w[(size_t)k * 64 + n]; } };
struct FWr { const float* wg; const float* we; const float* g; __device__ __forceinline__ float operator()(int k, int n) const { return n < 4 ? wg[k * 4 + n] * g[k] : (n < 36 ? we[k * 32 + n - 4] * g[k] : 0.f); } };
struct FWgu { const float* src; const float* g; int n0, col0; __device__ __forceinline__ float operator()(int k, int n) const { return src[(size_t)k * 256 + col0 + (n - n0)] * g[k]; } };
struct FWd { const float* w; __device__ __forceinline__ float operator()(int k, int n) const { return w[(size_t)k * 1024 + n]; } };

__device__ __forceinline__ void rope_cs(int pos, int j, float& cs, float& sn) {
    const double inv = exp2(-(double)j * (13.287712379549449 / 16.0));
    const double rev = (double)pos * inv * 0.15915494309189535; const float f = (float)(rev - rint(rev));
    cs = __builtin_amdgcn_cosf(f); sn = __builtin_amdgcn_sinf(f);
}
template <class F>
__device__ __forceinline__ void cvt_tile(const F& f, int n0, int k0, bf16_t* dst, int ldk, LAS float* tile, int tid) {
    { const int k = tid >> 3, nb = (tid & 7) * 8;
#pragma unroll
      for (int j = 0; j < 8; ++j) tile[k * 65 + nb + j] = f(k0 + k, n0 + nb + j); }
    __syncthreads();
    { const int n = tid >> 3, kb = (tid & 7) * 8; const LAS float* s = tile + kb * 65 + n;
      u32x4 o; o.x = pk_bf16(s[0], s[65]); o.y = pk_bf16(s[130], s[195]); o.z = pk_bf16(s[260], s[325]); o.w = pk_bf16(s[390], s[455]);
      *(u32x4*)(dst + (size_t)(n0 + n) * ldk + k0 + kb) = o; }
    __syncthreads();
}
template <class F>
__device__ __forceinline__ void cvt_item(const F& f, int it, int nK, bf16_t* dst, int ldk, LAS float* tile, int tid) { cvt_tile(f, (it / nK) * 64, (it % nK) * 64, dst, ldk, tile, tid); }

__device__ __forceinline__ void moe_item(InPtr in, int l, int it, const float*& src, int& ld, size_t& dst, int& ldk, bool& gain) {
    if (it < 32 * 128) { const int e = it >> 7, r = it & 127, n0 = (r >> 4) * 64, k0 = (r & 15) * 64, c0 = n0 & 255;
        src = (c0 < 128 ? in->p[27] : in->p[28]) + ((size_t)l * 32 + e) * 262144 + (size_t)k0 * 256 + (n0 >> 8) * 128 + (c0 & 127); ld = 256; gain = true;
        dst = ((size_t)e * 512 + n0) * 1024 + k0; ldk = 1024; }
    else { const int j = it - 32 * 128, e = j >> 6, r = j & 63, n0 = (r >> 2) * 64, k0 = (r & 3) * 64;
        src = in->p[29] + ((size_t)l * 32 + e) * 262144 + (size_t)k0 * 1024 + n0; ld = 1024; gain = false;
        dst = (size_t)16777216 + ((size_t)e * 1024 + n0) * 256 + k0; ldk = 256; }
}
__device__ __forceinline__ void cvt_moe_layer(InPtr in, unsigned char* ws, int l, LAS float* tile, int bid, int nb, int tid) {
    asm volatile("" : "+v"(tid));
    const float* g2 = in->p[22] + l * 1024; bf16_t* W = (bf16_t*)(ws + WS_WMOE);
    const int k = tid >> 3, nbq = (tid & 7) * 8;
    const int n = tid >> 3, kb = (tid & 7) * 8;
    constexpr int NIT = 32 * (128 + 64);
    int it = bid; f32x4 v0, v1; const float* src; int ld, ldk; size_t dst = 0; bool gain; float gk = 1.f; int kk0 = 0;
    if (it < NIT) { moe_item(in, l, it, src, ld, dst, ldk, gain); v0 = *(const f32x4*)(src + (size_t)k * ld + nbq); v1 = *(const f32x4*)(src + (size_t)k * ld + nbq + 4);
        kk0 = it < 32 * 128 ? ((it & 127) & 15) * 64 : 0; gk = gain ? g2[kk0 + k] : 1.f; }
    int buf = 0;
    for (; it < NIT; it += nb) {
        LAS float* t = tile + buf * (64 * 65);
        t[k * 65 + nbq + 0] = v0.x * gk; t[k * 65 + nbq + 1] = v0.y * gk; t[k * 65 + nbq + 2] = v0.z * gk; t[k * 65 + nbq + 3] = v0.w * gk;
        t[k * 65 + nbq + 4] = v1.x * gk; t[k * 65 + nbq + 5] = v1.y * gk; t[k * 65 + nbq + 6] = v1.z * gk; t[k * 65 + nbq + 7] = v1.w * gk;
        const size_t cdst = dst; const int cldk = ldk;
        __syncthreads();
        const int itn = it + nb;
        if (itn < NIT) { moe_item(in, l, itn, src, ld, dst, ldk, gain); v0 = *(const f32x4*)(src + (size_t)k * ld + nbq); v1 = *(const f32x4*)(src + (size_t)k * ld + nbq + 4);
            kk0 = itn < 32 * 128 ? ((itn & 127) & 15) * 64 : 0; gk = gain ? g2[kk0 + k] : 1.f; }
        const LAS float* s = t + kb * 65 + n;
        u32x4 o; o.x = pk_bf16(s[0], s[65]); o.y = pk_bf16(s[130], s[195]); o.z = pk_bf16(s[260], s[325]); o.w = pk_bf16(s[390], s[455]);
        *(u32x4*)(W + cdst + (size_t)n * cldk + kb) = o;
        buf ^= 1;
    }
    __syncthreads();
}

__device__ __forceinline__ void cvt_small_weights(InPtr in, unsigned char* ws, int l, LAS float* tile, int bid, int nb, int tid) {
    asm volatile("" : "+v"(tid));
    constexpr int I_WIN = 40 * 16, I_WOUT = 16 * 16, I_WU = 12 * 4, I_WC1 = 32, I_WC2 = 1, I_WR = 16;
    constexpr int PER_L = I_WIN + I_WOUT + 2 * I_WU + 2 * I_WC1 + 2 * I_WC2 + I_WR;
    for (int it0 = bid; it0 < PER_L; it0 += nb) {
        int it = it0;
        if (it < I_WIN) { FWin f{in->p[4] + (size_t)l * 1024 * DIN, in->p[3] + l * 1024}; cvt_item(f, it, 16, (bf16_t*)(ws + WS_WIN) + (size_t)l * 2560 * 1024, 1024, tile, tid); continue; } it -= I_WIN;
        if (it < I_WOUT) { FWout f{in->p[21] + (size_t)l * 1048576, in->p[10] + l * 384, in->p[20] + l * 384}; cvt_item(f, it, 16, (bf16_t*)(ws + WS_WOUT) + (size_t)l * 1048576, 1024, tile, tid); continue; } it -= I_WOUT;
        if (it < I_WU) { FWuq f{in->p[16] + (size_t)l * 192 * 576, in->p[15] + l * 192}; cvt_item(f, it, 4, (bf16_t*)(ws + WS_WUQ) + (size_t)l * 768 * 256, 256, tile, tid); continue; } it -= I_WU;
        if (it < I_WU) { FWukv f{in->p[18] + (size_t)l * 128 * 768, in->p[17] + l * 128}; cvt_item(f, it, 4, (bf16_t*)(ws + WS_WUKV) + (size_t)l * 768 * 256, 256, tile, tid); continue; } it -= I_WU;
        if (it < 2 * I_WC1) { const int s = it / I_WC1; FWc1 f{in->p[6] + ((size_t)l * 2 + s) * 2048 * 64}; cvt_item(f, it % I_WC1, 32, (bf16_t*)(ws + WS_WC1) + ((size_t)l * 2 + s) * 64 * 2048, 2048, tile, tid); continue; } it -= 2 * I_WC1;
        if (it < 2 * I_WC2) { const int s = it; FWc1 f{in->p[7] + ((size_t)l * 2 + s) * 64 * 64}; cvt_item(f, 0, 1, (bf16_t*)(ws + WS_WC2) + ((size_t)l * 2 + s) * 64 * 64, 64, tile, tid); continue; } it -= 2 * I_WC2;
        { FWr f{in->p[23] + (size_t)l * 4096, in->p[25] + (size_t)l * 32768, in->p[22] + l * 1024}; cvt_item(f, it, 16, (bf16_t*)(ws + WS_WR) + (size_t)l * 64 * 1024, 1024, tile, tid); }
    }
}

__device__ __forceinline__ void prologue(InPtr in, unsigned char* ws, LAS unsigned char* lds, int bid, int nb, int g_wv) {
    int tid_ = TIDX; asm volatile("" : "+v"(tid_));
    const int tid = tid_, lane = tid & 63, wid = tid >> 6;
    LAS float* tile = (LAS float*)lds;
    cvt_small_weights(in, ws, 0, tile, bid, nb, tid);
    { const float* x = in->p[0]; bf16_t* XB = (bf16_t*)(ws + WS_XB); float* ssqx = (float*)(ws + WS_SSQX);
      for (int r = bid * 8 + wid; r < NTOK; r += nb * 8) {
          const f32x4* xr = (const f32x4*)(x + (size_t)r * 1024) + lane; float s = 0.f; u32x2* o = (u32x2*)(XB + (size_t)r * 1024) + lane;
#pragma unroll
          for (int j = 0; j < 4; ++j) { const f32x4 v = xr[64 * j]; s += (v.x * v.x + v.y * v.y) + (v.z * v.z + v.w * v.w); u32x2 w; w.x = pk_bf16(v.x, v.y); w.y = pk_bf16(v.z, v.w); o[64 * j] = w; }
          s = wave_sum(s); if (lane == 0) ssqx[r] = s;
      } }
    { float* biasd = (float*)(ws + WS_BIASD); const float* rb = in->p[2];
      for (int i = bid * 512 + tid; i < 6 * 2048; i += nb * 512) { const int h = i >> 11, d = i & 2047; biasd[i] = rb[t5b(d) * 6 + h] * 1.44269504f; } }
    { float* rope = (float*)(ws + WS_ROPE); const int* pos = (const int*)in->p[1];
      for (int i = bid * 512 + tid; i < NTOK * 16; i += nb * 512) { const int tk = i >> 4, j = i & 15; float cs, sn; rope_cs(pos[tk], j, cs, sn); rope[(size_t)tk * 32 + j] = cs; rope[(size_t)tk * 32 + 16 + j] = sn; } }
    { float* b1c = (float*)(ws + WS_B1C); LAS float* red = (LAS float*)lds;
      for (int it = bid; it < 4; it += nb) { const float* pe = in->p[5] + (size_t)it * 2048; const float* w1 = in->p[6] + (size_t)it * 2048 * 64; const int f = tid & 63, part = tid >> 6;
          float a = 0.f; for (int k = part * 256; k < part * 256 + 256; ++k) a += pe[k] * w1[(size_t)k * 64 + f];
          __syncthreads(); red[tid] = a; __syncthreads();
          if (tid < 64) { float s = 0.f; for (int p2 = 0; p2 < 8; ++p2) s += red[p2 * 64 + tid]; b1c[it * 64 + tid] = s; }
          __syncthreads(); } }
}
namespace g8 {
constexpr int BM = 256, BK = 64, HALF = 128, HTB = HALF * BK * 2, STAGE_BYTES = 8 * HTB, NXCD = 8, WGM = 8;
__host__ __device__ __forceinline__ int lds_byte(int r, int c) { const int st = (r >> 4) * 2 + (c >> 5), rr = r & 15, cc = c & 31, ob = rr * 64 + cc * 2; return st * 1024 + (ob ^ (((ob >> 9) & 1) << 5)); }
__host__ __device__ __forceinline__ void stage_rc(int b, int& R, int& C) { const int st = b / 1024, sb = b % 1024, swz = sb ^ (((sb >> 9) & 1) << 5); R = (st >> 1) * 16 + swz / 64; C = (st & 1) * 32 + (swz % 64) / 2; }
__host__ __device__ __forceinline__ int perm32(int rho) { const int n = rho >> 4, i = rho & 15; return 8 * (i >> 2) + 4 * n + (i & 3); }

struct GUnit { const char* a; const char* b; int pm, pn, e, rows; };

__device__ __forceinline__ bool static_unit(int i, int G, int c, int nM, int nN, int& pm, int& pn) {
    const int nwg = nM * nN; const long L = (long)i * G + c; if (L >= nwg) return false;
    int wgid = (int)L; { const int q = nwg / NXCD, r = nwg % NXCD, xcd = wgid % NXCD, off = wgid / NXCD; wgid = (xcd < r ? xcd * (q + 1) : r * (q + 1) + (xcd - r) * q) + off; }
    const int nig = WGM * nN, gid = wgid / nig, fm = gid * WGM, gsz = (nM - fm) < WGM ? (nM - fm) : WGM;
    pm = fm + ((wgid % nig) % gsz); pn = (wgid % nig) / gsz; return true;
}
struct DenseSched {
    static constexpr bool GATHER = false, PARTIAL = false;
    const char* A; const char* Bt; int lda, ldb, nM, nN, G, c;
    __device__ __forceinline__ bool next(int i, GUnit& u) const {
        int pm, pn; if (!static_unit(i, G, c, nM, nN, pm, pn)) return false;
        u.pm = pm; u.pn = pn; u.e = 0; u.rows = 256; u.a = A + (size_t)pm * 256 * lda * 2; u.b = Bt + (size_t)pn * 256 * ldb * 2; return true;
    }
    __device__ __forceinline__ void aoff(const GUnit&, unsigned (&v)[2][2], const int (&R)[2], const int (&C)[2]) const {
#pragma unroll
        for (int h = 0; h < 2; ++h)
#pragma unroll
            for (int i = 0; i < 2; ++i) v[h][i] = (unsigned)((h * 128 + R[i]) * lda + C[i]) * 2u;
    }
};

template <class Epi, class Sched>
__device__ __forceinline__ void gemm_run(LAS unsigned char* lds, const int K, const int ldb, const Sched& S, const Epi& E, int g_wv) {
    int tid_ = TIDX; asm volatile("" : "+v"(tid_));
    const int tid = tid_, wid = __builtin_amdgcn_readfirstlane(tid >> 6), lane = tid & 63, wr = wid >> 2, wc = wid & 3, fr = lane & 15, fq = lane >> 4;
    int nt_ = K / BK; asm volatile("" : "+s"(nt_));
    const int nt = nt_;
    int R[2], C[2]; unsigned voffB[2];
#pragma unroll
    for (int i = 0; i < 2; ++i) { stage_rc(tid * 16 + i * 8192, R[i], C[i]); const int Rb = (R[i] & ~31) + perm32(R[i] & 31); voffB[i] = (unsigned)(Rb * ldb + C[i]) * 2u; }
    const size_t kstep = (size_t)(BK * 2);
    const size_t hstepB = (size_t)HALF * ldb * 2;
    const unsigned ldsw = (unsigned)wid * 1024u;
    const int aoff = lds_byte(wr * 64 + fr, fq * 8), boff = lds_byte(wc * 32 + fr, fq * 8);
#define G8_SA(b, h) (((b) * 2 + (h)) * HTB)
#define G8_SB(b, h) ((4 + (b) * 2 + (h)) * HTB)
#define G8_GLDS(bufoff, gptr, i_) __builtin_amdgcn_global_load_lds((const unsigned*)(gptr), (LAS unsigned*)(lds + (bufoff) + ldsw + (i_) * 8192), 16, 0, 0)
#define G8_STAGE_B(bufoff, gbase) do { G8_GLDS(bufoff, (const char*)(gbase) + voffB[0], 0); G8_GLDS(bufoff, (const char*)(gbase) + voffB[1], 1); } while (0)
#define G8_STAGE_A(bufoff, gbase, v0, v1) do { G8_GLDS(bufoff, (const char*)(gbase) + (v0), 0); G8_GLDS(bufoff, (const char*)(gbase) + (v1), 1); } while (0)
#define G8_LDA(dst, b, h) do { _Pragma("unroll") for (int m = 0; m < 4; ++m) _Pragma("unroll") for (int k = 0; k < 2; ++k) dst[m][k] = *(const LAS bf16x8*)(lds + G8_SA(b, h) + aoff + m * 2048 + k * 1024); } while (0)
#define G8_LDB(dst, b, h) do { _Pragma("unroll") for (int n = 0; n < 2; ++n) _Pragma("unroll") for (int k = 0; k < 2; ++k) dst[n][k] = *(const LAS bf16x8*)(lds + G8_SB(b, h) + boff + n * 2048 + k * 1024); } while (0)
#define G8_MMA(ai, bj, At, Bt) do { __builtin_amdgcn_s_setprio(1); _Pragma("unroll") for (int m = 0; m < 4; ++m) { if (!PARTIAL || ((mmask >> ((ai) * 4 + m)) & 1u)) { _Pragma("unroll") for (int n = 0; n < 2; ++n) _Pragma("unroll") for (int k = 0; k < 2; ++k) \
        acc[ai][bj][m][n] = __builtin_amdgcn_mfma_f32_16x16x32_bf16(Bt[n][k], At[m][k], acc[ai][bj][m][n], 0, 0, 0); } } __builtin_amdgcn_s_setprio(0); } while (0)
#define G8_WAIT_V(n) asm volatile("s_waitcnt vmcnt(" #n ")" ::: "memory")
#define G8_WAIT_L(n) asm volatile("s_waitcnt lgkmcnt(" #n ")" ::: "memory")
#define G8_BAR __builtin_amdgcn_s_barrier()
#define G8_SCHED __builtin_amdgcn_sched_barrier(0)
    GUnit cur, nxt; int ui = 0;
    if (!S.next(0, cur)) return;
    constexpr bool GATHER = Sched::GATHER, PARTIAL = Sched::PARTIAL;
    unsigned mmask = 0xffu;
#define G8_MASK(u) do { if (PARTIAL) { mmask = 0u; _Pragma("unroll") for (int q_ = 0; q_ < 8; ++q_) mmask |= (((q_ >> 2) * 128 + wr * 64 + (q_ & 3) * 16) < (u).rows) ? (1u << q_) : 0u; } } while (0)
    unsigned vc[2][2];
    S.aoff(cur, vc, R, C); G8_MASK(cur);
    LAS u32x4* stash = (LAS u32x4*)(lds + STAGE_BYTES + 4096) + tid;
    f32x4 acc[2][2][4][2];
#pragma unroll
    for (int a = 0; a < 2; ++a)
#pragma unroll
        for (int b = 0; b < 2; ++b)
#pragma unroll
            for (int m = 0; m < 4; ++m)
#pragma unroll
                for (int n = 0; n < 2; ++n) acc[a][b][m][n] = (f32x4){0.f, 0.f, 0.f, 0.f};
    bf16x8 At[4][2], B0[2][2], B1[2][2];
    const char* cA = cur.a; const char* cB = cur.b;
    G8_STAGE_B(G8_SB(0, 0), cB); G8_STAGE_B(G8_SB(0, 1), cB + hstepB); G8_STAGE_A(G8_SA(0, 0), cA, vc[0][0], vc[0][1]); G8_STAGE_A(G8_SA(0, 1), cA, vc[1][0], vc[1][1]);
    if (wr == 1) G8_BAR;
    G8_WAIT_V(2); G8_BAR;
    G8_STAGE_B(G8_SB(1, 0), cB + kstep); G8_STAGE_A(G8_SA(1, 0), cA + kstep, vc[0][0], vc[0][1]); G8_STAGE_B(G8_SB(1, 1), cB + hstepB + kstep);
    G8_WAIT_V(6); G8_BAR;
    for (;;) {
        const bool has_next = S.next(ui + 1, nxt);
        if (GATHER) { unsigned vn[2][2];
            if (has_next) S.aoff(nxt, vn, R, C);
            else { vn[0][0] = vc[0][0]; vn[0][1] = vc[0][1]; vn[1][0] = vc[1][0]; vn[1][1] = vc[1][1]; }
            u32x4 sv; sv.x = vn[0][0]; sv.y = vn[0][1]; sv.z = vn[1][0]; sv.w = vn[1][1]; *stash = sv; }
        const char* nA = has_next ? nxt.a : cA; const char* nB = has_next ? nxt.b : cB;
#pragma unroll 1
        for (int t = 0; t < nt; t += 2) {
            const bool last = (t == nt - 2);
            const char* a1 = cA + (size_t)(t + 1) * kstep;
            const char* a2 = last ? nA : cA + (size_t)(t + 2) * kstep; const char* b2 = last ? nB : cB + (size_t)(t + 2) * kstep;
            const char* a3 = a2 + kstep; const char* b3 = b2 + kstep;
            unsigned w00 = vc[0][0], w01 = vc[0][1], w10 = vc[1][0], w11 = vc[1][1];
            if (GATHER) { if (last) { const u32x4 sv = *stash; w00 = sv.x; w01 = sv.y; w10 = sv.z; w11 = sv.w; } }
            G8_LDB(B0, 0, 0); G8_LDB(B1, 0, 1); G8_SCHED; G8_LDA(At, 0, 0); G8_STAGE_A(G8_SA(1, 1), a1, vc[1][0], vc[1][1]);
            G8_WAIT_V(8); G8_WAIT_L(0); G8_BAR; G8_MMA(0, 0, At, B0); G8_MMA(0, 1, At, B1); G8_BAR; G8_SCHED;
            G8_LDA(At, 0, 1); G8_STAGE_B(G8_SB(0, 0), b2); G8_STAGE_B(G8_SB(0, 1), b2 + hstepB); G8_STAGE_A(G8_SA(0, 0), a2, w00, w01);
            G8_WAIT_V(8); G8_WAIT_L(0); G8_BAR; G8_MMA(1, 0, At, B0); G8_MMA(1, 1, At, B1); G8_BAR; G8_SCHED;
            G8_LDB(B0, 1, 0); G8_LDB(B1, 1, 1); G8_SCHED; G8_LDA(At, 1, 0); G8_STAGE_A(G8_SA(0, 1), a2, w10, w11);
            G8_WAIT_V(8); G8_WAIT_L(0); G8_BAR; G8_MMA(0, 0, At, B0); G8_MMA(0, 1, At, B1); G8_BAR; G8_SCHED;
            G8_LDA(At, 1, 1); G8_STAGE_B(G8_SB(1, 0), b3); G8_STAGE_B(G8_SB(1, 1), b3 + hstepB); G8_STAGE_A(G8_SA(1, 0), a3, w00, w01);
            G8_WAIT_V(8); G8_WAIT_L(0); G8_BAR; G8_MMA(1, 0, At, B0); G8_MMA(1, 1, At, B1); G8_BAR; G8_SCHED;
        }
        if (wr == 0) G8_BAR;
        { int fr_ = fr, fq_ = fq; asm volatile("" : "+v"(fr_), "+v"(fq_));
          E(acc, cur, wr, wc, fr_, fq_); }
        if (!has_next) break;
#pragma unroll
        for (int a = 0; a < 2; ++a)
#pragma unroll
            for (int b = 0; b < 2; ++b)
#pragma unroll
                for (int m = 0; m < 4; ++m)
#pragma unroll
                    for (int n = 0; n < 2; ++n) acc[a][b][m][n] = (f32x4){0.f, 0.f, 0.f, 0.f};
        cur = nxt; cA = nA; cB = nB; ++ui; G8_MASK(cur);
        if (GATHER) { const u32x4 sv = *stash; vc[0][0] = sv.x; vc[0][1] = sv.y; vc[1][0] = sv.z; vc[1][1] = sv.w; }
        if (wr == 1) G8_BAR;
    }
    G8_WAIT_V(0);
    G8_BAR;
#undef G8_SA
#undef G8_SB
#undef G8_GLDS
#undef G8_STAGE_A
#undef G8_STAGE_B
#undef G8_LDA
#undef G8_LDB
#undef G8_MMA
#undef G8_MASK
#undef G8_WAIT_V
#undef G8_WAIT_L
#undef G8_BAR
#undef G8_SCHED
}
}
using g8::GUnit;
__device__ __forceinline__ void st_bf16x8(bf16_t* p, const float (&v)[8]) { u32x4 w; w.x = pk_bf16(v[0], v[1]); w.y = pk_bf16(v[2], v[3]); w.z = pk_bf16(v[4], v[5]); w.w = pk_bf16(v[6], v[7]); *(u32x4*)p = w; }
__device__ __forceinline__ float quad_sum(float s) { s += __shfl_xor(s, 16); s += __shfl_xor(s, 32); return s; }

struct EpiInProj {
    const float* ssqx; float* part_dq; float* part_dkv; const float* qg; const float* kg; const float* krg; const float* rope;
    unsigned char* prj;
    __device__ __forceinline__ void operator()(const f32x4 (&acc)[2][2][4][2], const GUnit& u, int wr, int wc, int fr, int fq) const {
        const int G = u.pn * 4 + wc;
        const bool isq = G < 6; const int a = G - 6; const bool isk = (G >= 10 && G < 18 && ((a >> 1) & 1) == 0);
        const float* g0 = (isq ? qg : kg) + 8 * fq;
        float rs8[8];
#pragma unroll
        for (int k = 0; k < 8; ++k) rs8[k] = ssqx[u.pm * 256 + (k >> 2) * 128 + wr * 64 + (k & 3) * 16 + fr];
#pragma unroll
        for (int k = 0; k < 8; ++k) rs8[k] = rsqrtf(rs8[k] * (1.f / 1024.f) + 1e-6f);
#pragma unroll
        for (int ai = 0; ai < 2; ++ai)
#pragma unroll
            for (int m = 0; m < 4; ++m) {
                __builtin_amdgcn_sched_barrier(0);
                const int row = u.pm * 256 + ai * 128 + wr * 64 + m * 16 + fr; const int b = row >> 11, t = row & 2047;
                const float rs = rs8[ai * 4 + m];
                float v[2][8];
#pragma unroll
                for (int bj = 0; bj < 2; ++bj)
#pragma unroll
                    for (int n = 0; n < 2; ++n)
#pragma unroll
                        for (int j = 0; j < 4; ++j) v[bj][4 * n + j] = acc[ai][bj][m][n][j] * rs;
                float ss = 0.f;
#pragma unroll
                for (int bj = 0; bj < 2; ++bj)
#pragma unroll
                    for (int i = 0; i < 8; ++i) ss += v[bj][i] * v[bj][i];
                bf16_t* dst = nullptr; int bstride = 32;
                if (isq) {
                    ss = quad_sum(ss); const float sc = rsqrtf(ss * (1.f / 64.f) + 1e-6f) * 0.18033688f;
#pragma unroll
                    for (int i = 0; i < 8; ++i) { v[0][i] *= sc * g0[i]; v[1][i] *= sc * g0[32 + i]; }
                    dst = (bf16_t*)(prj + PRJ_QN) + ((size_t)(b * 6 + G) * 2048 + t) * 64;
                } else if (G < 18) {
                    const int br = a >> 2, s = (a >> 1) & 1, hk = a & 1;
                    if (br > 0 && s == 0) {
                        ss = quad_sum(ss); const float sc = rsqrtf(ss * (1.f / 64.f) + 1e-6f);
#pragma unroll
                        for (int i = 0; i < 8; ++i) { v[0][i] *= sc * g0[i]; v[1][i] *= sc * g0[32 + i]; }
                    }
                    const size_t base = br == 0 ? (s ? PRJ_C0V : PRJ_C0K) : (br == 1 ? (s ? PRJ_VN1 : PRJ_KN1) : (s ? PRJ_VN2 : PRJ_KN2));
                    dst = (bf16_t*)(prj + base) + ((size_t)(b * 2 + hk) * 2048 + t) * 64;
                } else if (G < 26) { dst = (bf16_t*)(prj + PRJ_RAWQK) + (size_t)row * 512 + (G - 18) * 64; }
                else if (G < 30) { dst = (bf16_t*)(prj + PRJ_VML) + ((size_t)(b * 4 + (G - 26)) * 2048 + t) * 64; }
                else if (G < 34) { dst = (bf16_t*)(prj + PRJ_OG) + (size_t)row * 256 + (G - 30) * 64; }
                else if (G < 37) { dst = (bf16_t*)(prj + PRJ_DQKV) + (size_t)row * 384 + (G - 34) * 64; ss = quad_sum(ss); if (fq == 0) part_dq[(size_t)row * 4 + (G - 34)] = ss; }
                else if (G == 37) {
                    dst = (bf16_t*)(prj + PRJ_DQKV) + (size_t)row * 384 + 192;
                    float* gt = (float*)(prj + PRJ_GATES) + (size_t)row * 32 + 8 * fq;
                    *(f32x4*)gt = (f32x4){v[1][0], v[1][1], v[1][2], v[1][3]}; *(f32x4*)(gt + 4) = (f32x4){v[1][4], v[1][5], v[1][6], v[1][7]};
                    float s0 = 0.f;
#pragma unroll
                    for (int i = 0; i < 8; ++i) s0 += v[0][i] * v[0][i];
                    s0 = quad_sum(s0); const float sc = rsqrtf(s0 * (1.f / 32.f) + 1e-6f);
                    const float* rp = rope + (size_t)row * 32 + ((8 * fq) & 15);
                    float kr[8];
#pragma unroll
                    for (int i = 0; i < 8; ++i) { const float val = v[0][i] * sc * krg[8 * fq + i]; const float oth = __shfl_xor(val, 32); const float cs = rp[i], sn = rp[16 + i]; kr[i] = fq < 2 ? val * cs - oth * sn : val * cs + oth * sn; }
                    st_bf16x8((bf16_t*)(prj + PRJ_KR) + (size_t)row * 32 + 8 * fq, kr);
                } else { dst = (bf16_t*)(prj + PRJ_DQKV) + (size_t)row * 384 + 256 + (G - 38) * 64; ss = quad_sum(ss); if (fq == 0) part_dkv[(size_t)row * 2 + (G - 38)] = ss; }
                st_bf16x8(dst + 8 * fq, v[0]); st_bf16x8(dst + bstride + 8 * fq, v[1]);
            }
    }
};

struct EpiUq {
    const float* ssq_dq; const float* qkn; const float* rope; bf16_t* QM;
    __device__ __forceinline__ void operator()(const f32x4 (&acc)[2][2][4][2], const GUnit& u, int wr, int wc, int fr, int fq) const {
        const int G = u.pn * 4 + wc; if (G >= 9) return;
        const float scale = 0.14724444f;
        const float* g0 = G < 6 ? qkn + 8 * fq : qkn + 64 + 8 * (fq & 1); const float* g1 = G < 6 ? g0 + 32 : g0 + 16;
        float rs8[8];
#pragma unroll
        for (int k = 0; k < 8; ++k) { const f32x4 pq = *(const f32x4*)(ssq_dq + (size_t)(u.pm * 256 + (k >> 2) * 128 + wr * 64 + (k & 3) * 16 + fr) * 4); rs8[k] = (pq.x + pq.y) + pq.z; }
#pragma unroll
        for (int k = 0; k < 8; ++k) rs8[k] = rsqrtf(rs8[k] * (1.f / 192.f) + 1e-6f);
#pragma unroll
        for (int ai = 0; ai < 2; ++ai)
#pragma unroll
            for (int m = 0; m < 4; ++m) {
                __builtin_amdgcn_sched_barrier(0);
                const int row = u.pm * 256 + ai * 128 + wr * 64 + m * 16 + fr; const int b = row >> 11, t = row & 2047;
                const float rs = rs8[ai * 4 + m];
                float v[2][8]; float ss = 0.f;
#pragma unroll
                for (int bj = 0; bj < 2; ++bj)
#pragma unroll
                    for (int n = 0; n < 2; ++n)
#pragma unroll
                        for (int j = 0; j < 4; ++j) { const float x = acc[ai][bj][m][n][j] * rs; v[bj][4 * n + j] = x; ss += x * x; }
                if (G < 6) ss = quad_sum(ss); else ss += __shfl_xor(ss, 16);
                const float sc = rsqrtf(ss * (G < 6 ? 1.f / 64.f : 1.f / 32.f) + 1e-6f) * scale;
#pragma unroll
                for (int i = 0; i < 8; ++i) { v[0][i] *= sc * g0[i]; v[1][i] *= sc * g1[i]; }
                if (G < 6) {
                    bf16_t* dst = QM + ((size_t)(b * 6 + G) * 2048 + t) * 96;
                    st_bf16x8(dst + 8 * fq, v[0]); st_bf16x8(dst + 32 + 8 * fq, v[1]);
                } else {
                    const int i16 = 8 * (fq & 1); const int head = 2 * (G - 6) + (fq >> 1);
                    const float* rp = rope + (size_t)row * 32 + i16; float o1[8], o2[8];
#pragma unroll
                    for (int i = 0; i < 8; ++i) { const float cs = rp[i], sn = rp[16 + i]; o1[i] = v[0][i] * cs - v[1][i] * sn; o2[i] = v[1][i] * cs + v[0][i] * sn; }
                    bf16_t* dst = QM + ((size_t)(b * 6 + head) * 2048 + t) * 96 + 64 + i16;
                    st_bf16x8(dst, o1); st_bf16x8(dst + 16, o2);
                }
            }
    }
};
struct EpiUkv {
    const float* ssq_dkv; const float* qkn; const bf16_t* KR; bf16_t* KM; bf16_t* VM;
    __device__ __forceinline__ void operator()(const f32x4 (&acc)[2][2][4][2], const GUnit& u, int wr, int wc, int fr, int fq) const {
        const int G = u.pn * 4 + wc;
        const float* g0 = qkn + 96 + 8 * fq;
        float rs8[8];
#pragma unroll
        for (int k = 0; k < 8; ++k) { const size_t rr = (size_t)(u.pm * 256 + (k >> 2) * 128 + wr * 64 + (k & 3) * 16 + fr); rs8[k] = ssq_dkv[rr * 2] + ssq_dkv[rr * 2 + 1]; }
#pragma unroll
        for (int k = 0; k < 8; ++k) rs8[k] = rsqrtf(rs8[k] * (1.f / 128.f) + 1e-6f);
#pragma unroll
        for (int ai = 0; ai < 2; ++ai)
#pragma unroll
            for (int m = 0; m < 4; ++m) {
                __builtin_amdgcn_sched_barrier(0);
                const int row = u.pm * 256 + ai * 128 + wr * 64 + m * 16 + fr; const int b = row >> 11, t = row & 2047;
                const float rs = rs8[ai * 4 + m];
                float v[2][8]; float ss = 0.f;
#pragma unroll
                for (int bj = 0; bj < 2; ++bj)
#pragma unroll
                    for (int n = 0; n < 2; ++n)
#pragma unroll
                        for (int j = 0; j < 4; ++j) { const float x = acc[ai][bj][m][n][j] * rs; v[bj][4 * n + j] = x; ss += x * x; }
                if (G < 6) {
                    ss = quad_sum(ss); const float sc = rsqrtf(ss * (1.f / 64.f) + 1e-6f);
#pragma unroll
                    for (int i = 0; i < 8; ++i) { v[0][i] *= sc * g0[i]; v[1][i] *= sc * g0[32 + i]; }
                    bf16_t* dst = KM + ((size_t)(b * 6 + G) * 2048 + t) * 96;
                    st_bf16x8(dst + 8 * fq, v[0]); st_bf16x8(dst + 32 + 8 * fq, v[1]);
                    *(u32x4*)(dst + 64 + 8 * fq) = *(const u32x4*)(KR + (size_t)row * 32 + 8 * fq);
                } else {
                    bf16_t* dst = VM + ((size_t)(b * 6 + (G - 6)) * 2048 + t) * 64;
                    st_bf16x8(dst + 8 * fq, v[0]); st_bf16x8(dst + 32 + 8 * fq, v[1]);
                }
            }
    }
};
#define MFMA16(a, b, c) __builtin_amdgcn_mfma_f32_16x16x32_bf16(a, b, c, 0, 0, 0)
#define MFMA32(a, b, c) __builtin_amdgcn_mfma_f32_32x32x16_bf16(a, b, c, 0, 0, 0)
#define LDS_FENCE() asm volatile("s_waitcnt lgkmcnt(0)" ::: "memory")

__device__ __forceinline__ void cmp_unit(int u, int l, InPtr in, unsigned char* ws, LAS unsigned char* lds, int g_wv) {
    int tid_ = TIDX; asm volatile("" : "+v"(tid_));
    const int tid = tid_, w = tid >> 6, lane = tid & 63, r = lane & 15, q = lane >> 4;
    const int b = u >> 2, s = (u >> 1) & 1, hk = u & 1;
    const bf16_t* A = (const bf16_t*)(ws + WS_PRJ + (s ? PRJ_C0V : PRJ_C0K)) + (size_t)(b * 2 + hk) * 2048 * 64;
    const bf16_t* W1 = (const bf16_t*)(ws + WS_WC1) + ((size_t)l * 2 + s) * 64 * 2048;
    const bf16_t* W2 = (const bf16_t*)(ws + WS_WC2) + ((size_t)l * 2 + s) * 64 * 64;
    const float* b1 = (const float*)(ws + WS_B1C) + (l * 2 + s) * 64;
    f32x4 acc[4];
#pragma unroll
    for (int nb = 0; nb < 4; ++nb) acc[nb] = (f32x4){0.f, 0.f, 0.f, 0.f};
    const bf16_t* ap = A + (size_t)(16 * w + r) * 1024 + 8 * q;
    constexpr int WP = 528, WBUF = 64 * WP; LAS unsigned char* wb = lds + 24576;
    u32x4 st[4];
#pragma unroll
    for (int i = 0; i < 4; ++i) { const int c = tid + 512 * i; st[i] = *(const u32x4*)(W1 + (size_t)(c >> 5) * 2048 + (c & 31) * 8); }
#pragma unroll
    for (int i = 0; i < 4; ++i) { const int c = tid + 512 * i; *(LAS u32x4*)(wb + (c >> 5) * WP + (c & 31) * 16) = st[i]; }
    __syncthreads();
#pragma unroll 1
    for (int kc = 0; kc < 8; ++kc) {
        const int cur = kc & 1;
        if (kc < 7) {
#pragma unroll
            for (int i = 0; i < 4; ++i) { const int c = tid + 512 * i; st[i] = *(const u32x4*)(W1 + (size_t)(c >> 5) * 2048 + (kc + 1) * 256 + (c & 31) * 8); }
        }
        bf16x8 af[8];
#pragma unroll
        for (int ks = 0; ks < 8; ++ks) af[ks] = *(const bf16x8*)(ap + 256 * kc + 32 * ks);
#pragma unroll
        for (int ks = 0; ks < 8; ++ks)
#pragma unroll
            for (int nb = 0; nb < 4; ++nb) { const bf16x8 bb = *(const LAS bf16x8*)(wb + cur * WBUF + (16 * nb + r) * WP + (32 * ks + 8 * q) * 2); acc[nb] = MFMA16(af[ks], bb, acc[nb]); }
        if (kc < 7) {
#pragma unroll
            for (int i = 0; i < 4; ++i) { const int c = tid + 512 * i; *(LAS u32x4*)(wb + (cur ^ 1) * WBUF + (c >> 5) * WP + (c & 31) * 16) = st[i]; }
        }
        __syncthreads();
    }
    LAS bf16_t* hl = (LAS bf16_t*)(lds + w * 2304);
#pragma unroll
    for (int nb = 0; nb < 4; ++nb) { const float bias = b1[16 * nb + r];
#pragma unroll
        for (int j = 0; j < 4; ++j) hl[(4 * q + j) * 72 + 16 * nb + r] = f2bf(siluf(acc[nb][j] + bias)); }
    LDS_FENCE();
    f32x4 o[4];
#pragma unroll
    for (int nb = 0; nb < 4; ++nb) o[nb] = (f32x4){0.f, 0.f, 0.f, 0.f};
#pragma unroll
    for (int ks = 0; ks < 2; ++ks) {
        const bf16x8 a = *(const LAS bf16x8*)(hl + r * 72 + 32 * ks + 8 * q);
#pragma unroll
        for (int nb = 0; nb < 4; ++nb) { const bf16x8 bb = *(const bf16x8*)(W2 + (size_t)(16 * nb + r) * 64 + 32 * ks + 8 * q); o[nb] = MFMA16(a, bb, o[nb]); }
    }
    LDS_FENCE();
    const float* kg = in->p[9] + l * 64;
    bf16_t* dst = (bf16_t*)(ws + WS_CMP + (s ? CMP_V : 0)) + (size_t)(b * 2 + hk) * 128 * 64;
#pragma unroll
    for (int j = 0; j < 4; ++j) {
        const int n = 16 * w + 4 * q + j; float ss = 0.f;
#pragma unroll
        for (int nb = 0; nb < 4; ++nb) ss += o[nb][j] * o[nb][j];
        ss += __shfl_xor(ss, 1); ss += __shfl_xor(ss, 2); ss += __shfl_xor(ss, 4); ss += __shfl_xor(ss, 8);
        const float sc = s == 0 ? rsqrtf(ss * (1.f / 64.f) + 1e-6f) : 1.f;
#pragma unroll
        for (int nb = 0; nb < 4; ++nb) { const int d = 16 * nb + r; const float v = o[nb][j] * sc * (s == 0 ? kg[d] : 1.f); dst[(size_t)n * 64 + d] = n < 127 ? f2bf(v) : (bf16_t)0; }
    }
}

__device__ __forceinline__ int swz_off(int row, int chunk) { return row * 128 + ((chunk ^ (row & 7)) << 4); }
__device__ __forceinline__ float log_sigmoid(float x) { return fminf(x, 0.f) - log1pf(__expf(-fabsf(x))); }
__device__ __forceinline__ void ml_delta_wave(int cu, int l, InPtr in, unsigned char* ws, LAS unsigned char* wl, int lane) {
    const int c = cu & 31, bh = cu >> 5, h = bh & 3, b = bh >> 2; const int t0 = c * 64; const size_t row0 = (size_t)b * 2048 + t0;
    const float* G = (const float*)(ws + WS_PRJ + PRJ_GATES);
    const float ip = G[(row0 + lane) * 32 + 18 + h] + in->p[12][l * 4 + h], fp = G[(row0 + lane) * 32 + 22 + h] + in->p[13][l * 4 + h];
    float bcum = log_sigmoid(fp);
#pragma unroll
    for (int o = 1; o < 64; o <<= 1) { const float t = __builtin_bit_cast(float, __builtin_amdgcn_ds_bpermute(((lane - o) & 63) << 2, __builtin_bit_cast(int, bcum))); if (lane >= o) bcum += t; }
    const float bL = __builtin_bit_cast(float, __builtin_amdgcn_readlane(__builtin_bit_cast(int, bcum), 63)); const float wgt = __expf(bL - bcum + ip);
    { float* mlg = (float*)(ws + WS_ML + ML_G) + ((size_t)bh * 2048 + t0 + lane) * 2; mlg[0] = bcum; mlg[1] = ip; if (lane == 0) ((float*)(ws + WS_ML + ML_BL))[cu] = bL; }
    const bf16_t* raw = (const bf16_t*)(ws + WS_PRJ + PRJ_RAWQK); const float* cw = in->p[11] + (size_t)l * 4 * 512;
    float wq[4], wk[4];
#pragma unroll
    for (int j = 0; j < 4; ++j) { wq[j] = cw[j * 512 + h * 64 + lane]; wk[j] = cw[j * 512 + 256 + h * 64 + lane]; }
    float q3 = 0.f, q2 = 0.f, q1 = 0.f, k3 = 0.f, k2 = 0.f, k1 = 0.f;
    if (c > 0) { const bf16_t* p = raw + (row0 - 3) * 512 + h * 64 + lane; q3 = bf2f(p[0]); q2 = bf2f(p[512]); q1 = bf2f(p[1024]); k3 = bf2f(p[256]); k2 = bf2f(p[512 + 256]); k1 = bf2f(p[1024 + 256]); }
    bf16_t* QC = (bf16_t*)(ws + WS_ML) + ((size_t)bh * 2048 + t0) * 64 + lane; bf16_t* KC = (bf16_t*)(ws + WS_ML + ML_KC) + ((size_t)bh * 2048 + t0) * 64 + lane;
    const bf16_t* V = (const bf16_t*)(ws + WS_PRJ + PRJ_VML) + ((size_t)bh * 2048 + t0) * 64 + lane;
    float dn = 0.f;
    const bf16_t* rq = raw + row0 * 512 + h * 64 + lane;
    bf16_t cq[8], ck[8], cv[8], nq[8], nk[8], nv[8];
#pragma unroll
    for (int j = 0; j < 8; ++j) { cq[j] = rq[(size_t)j * 512]; ck[j] = rq[(size_t)j * 512 + 256]; cv[j] = V[(size_t)j * 64]; }
#pragma unroll 1
    for (int s8 = 0; s8 < 8; ++s8) {
        if (s8 < 7) {
#pragma unroll
            for (int j = 0; j < 8; ++j) { const int s = s8 * 8 + 8 + j; nq[j] = rq[(size_t)s * 512]; nk[j] = rq[(size_t)s * 512 + 256]; nv[j] = V[(size_t)s * 64]; }
        }
        float kb[8], vb[8]; bf16_t qo[8], ko[8];
#pragma unroll
        for (int j = 0; j < 8; ++j) {
            const int s = s8 * 8 + j;
            const float q0 = bf2f(cq[j]), k0 = bf2f(ck[j]);
            const float qv = siluf(wq[0] * q3 + wq[1] * q2 + wq[2] * q1 + wq[3] * q0), kv = siluf(wk[0] * k3 + wk[1] * k2 + wk[2] * k1 + wk[3] * k0) * 0.125f;
            q3 = q2; q2 = q1; q1 = q0; k3 = k2; k2 = k1; k1 = k0;
            qo[j] = f2bf(qv); ko[j] = f2bf(kv);
            const float ws_ = __builtin_bit_cast(float, __builtin_amdgcn_readlane(__builtin_bit_cast(int, wgt), s)); kb[j] = bf2f(ko[j]); dn += ws_ * kb[j]; vb[j] = ws_ * bf2f(cv[j]);
        }
#pragma unroll
        for (int j = 0; j < 8; ++j) { QC[(size_t)(s8 * 8 + j) * 64] = qo[j]; KC[(size_t)(s8 * 8 + j) * 64] = ko[j]; }
        u32x4 pk; pk.x = pk_bf16(kb[0], kb[1]); pk.y = pk_bf16(kb[2], kb[3]); pk.z = pk_bf16(kb[4], kb[5]); pk.w = pk_bf16(kb[6], kb[7]);
        *(LAS u32x4*)(wl + swz_off(lane, s8)) = pk;
        pk.x = pk_bf16(vb[0], vb[1]); pk.y = pk_bf16(vb[2], vb[3]); pk.z = pk_bf16(vb[4], vb[5]); pk.w = pk_bf16(vb[6], vb[7]);
        *(LAS u32x4*)(wl + 8192 + swz_off(lane, s8)) = pk;
#pragma unroll
        for (int j = 0; j < 8; ++j) { cq[j] = nq[j]; ck[j] = nk[j]; cv[j] = nv[j]; }
    }
    ((float*)(ws + WS_ML + ML_DN))[(size_t)cu * 64 + lane] = dn;
    LDS_FENCE();
    const int r = lane & 15, q = lane >> 4;
    bf16_t* DL = (bf16_t*)(ws + WS_ML + ML_DELTA) + (size_t)cu * 4096;
#pragma unroll
    for (int mb = 0; mb < 4; ++mb) {
        f32x4 acc[4];
#pragma unroll
        for (int nb = 0; nb < 4; ++nb) acc[nb] = (f32x4){0.f, 0.f, 0.f, 0.f};
#pragma unroll
        for (int ks = 0; ks < 2; ++ks) {
            const bf16x8 a = *(const LAS bf16x8*)(wl + 8192 + swz_off(16 * mb + r, 4 * ks + q));
#pragma unroll
            for (int nb = 0; nb < 4; ++nb) { const bf16x8 bb = *(const LAS bf16x8*)(wl + swz_off(16 * nb + r, 4 * ks + q)); acc[nb] = MFMA16(a, bb, acc[nb]); }
        }
#pragma unroll
        for (int nb = 0; nb < 4; ++nb)
#pragma unroll
            for (int j = 0; j < 4; ++j) DL[(16 * mb + 4 * q + j) * 64 + 16 * nb + r] = f2bf(acc[nb][j]);
    }
    LDS_FENCE();
}

#ifndef TIME_PH
#define TIME_PH -1
#endif
#define PSTAMP(i, blk) do { if (TIME_PH != -1 && l == 0 && blockIdx.x == (blk) && TIDX == 0) ((unsigned long long*)((unsigned*)(ws + WS_CTL) + CW_TS))[i] = __builtin_amdgcn_s_memrealtime(); } while (0)
__device__ __forceinline__ void phase_prep(int l, InPtr in, unsigned char* ws, LAS unsigned char* lds, int bid, int nb, int g_wv, unsigned* dq) {
    asm volatile("" : "+s"(bid));
    PSTAMP(40, 0);
#ifndef NO_UQ
    { g8::DenseSched S{(const char*)(ws + WS_PRJ + PRJ_DQKV), (const char*)(ws + WS_WUQ) + (size_t)l * 768 * 256 * 2, 384, 256, 64, 3, nb, bid};
      EpiUq E{(const float*)(ws + WS_SSQ + PT_DQ) + (size_t)l * 16384 * 4, in->p[19] + l * 192, (const float*)(ws + WS_ROPE), (bf16_t*)(ws + WS_MLA)};
      g8::gemm_run(lds, 256, 256, S, E, g_wv); }
#endif
    PSTAMP(41, 0);
#ifndef NO_UKV
    asm volatile("" : "+s"(bid));
    { g8::DenseSched S{(const char*)(ws + WS_PRJ + PRJ_DQKV) + 256, (const char*)(ws + WS_WUKV) + (size_t)l * 768 * 256 * 2, 384, 256, 64, 3, nb, bid};
      EpiUkv E{(const float*)(ws + WS_SSQ + PT_DKV) + (size_t)l * 16384 * 2, in->p[19] + l * 192, (const bf16_t*)(ws + WS_PRJ + PRJ_KR), (bf16_t*)(ws + WS_MLA + MLA_KM), (bf16_t*)(ws + WS_MLA + MLA_VM)};
      g8::gemm_run(lds, 256, 256, S, E, g_wv); }
#endif
    PSTAMP(42, 0); PSTAMP(44, 255);
    __syncthreads();
#ifndef NO_CMP
    for (int u = nb - 1 - bid; u < 32; u += nb) cmp_unit(u, l, in, ws, lds, g_wv);
#endif
    PSTAMP(45, 255);
    __syncthreads();
#ifndef NO_DELTA
    { int tid_ = TIDX; asm volatile("" : "+v"(tid_)); LAS int* slot = (LAS int*)(lds + LDS_MISC + 64);
      for (;;) {
          __syncthreads();
          if (tid_ == 0) *slot = (int)__hip_atomic_fetch_add(dq, 1u, __ATOMIC_RELAXED, __HIP_MEMORY_SCOPE_AGENT);
          __syncthreads();
          const int g = *slot; if (g >= 128) break;
          ml_delta_wave(g * 8 + (tid_ >> 6), l, in, ws, lds + (tid_ >> 6) * 16384, tid_ & 63);
      } }
#endif
    __syncthreads(); PSTAMP(43, 0);
}
#define CHK_TOL(st) (((st) & 15) == 8 ? 1e-2f : 1e-3f)
#define CHECK_REST
constexpr int VTP = 192;
typedef short v4i16_t __attribute__((ext_vector_type(4)));
__device__ __forceinline__ int vt_lane_off(int lane) { return (4 * (lane >> 5) + ((lane & 15) >> 2)) * VTP + ((((lane >> 4) & 1) * 16) + 4 * (lane & 3)) * 2; }
__device__ __forceinline__ bf16x8 vt_frag(const LAS unsigned char* Vt, int voff, int s4, int eb) {
    const LAS unsigned char* a = Vt + voff + 16 * s4 * VTP + 64 * eb;
    const v4i16_t lo = __builtin_amdgcn_ds_read_tr16_b64_v4i16((LAS v4i16_t*)a), hi = __builtin_amdgcn_ds_read_tr16_b64_v4i16((LAS v4i16_t*)(a + 8 * VTP));
    return (bf16x8){lo[0], lo[1], lo[2], lo[3], hi[0], hi[1], hi[2], hi[3]};
}
__device__ __forceinline__ int crow(int reg, int h) { return (reg & 3) + 8 * (reg >> 2) + 4 * h; }
struct AttnState { f32x16 o[2]; float m, l; };
__device__ __forceinline__ void attn_reset(AttnState& A) { A.m = -1e30f; A.l = 0.f;
#pragma unroll
    for (int i = 0; i < 16; ++i) { A.o[0][i] = 0.f; A.o[1][i] = 0.f; } }

template <int DK>
__device__ __forceinline__ void attn_scores(f32x16 (&s)[2], const bf16x8 (&qf)[DK / 16], const LAS unsigned char* Kt, int r, int h) {
    constexpr int KP = 2 * DK + 16, NK = DK / 16;
    bf16x8 kf[2][NK];
#pragma unroll
    for (int kb = 0; kb < 2; ++kb)
#pragma unroll
        for (int ks = 0; ks < NK; ++ks) kf[kb][ks] = *(const LAS bf16x8*)(Kt + (32 * kb + r) * KP + (16 * ks + 8 * h) * 2);
    __builtin_amdgcn_sched_barrier(0);
#pragma unroll
    for (int kb = 0; kb < 2; ++kb) {
#pragma unroll
        for (int i = 0; i < 16; ++i) s[kb][i] = 0.f;
#pragma unroll
        for (int ks = 0; ks < NK; ++ks) s[kb] = MFMA32(kf[kb][ks], qf[ks], s[kb]);
    }
}
__device__ __forceinline__ float max3f(float a, float b, float c) { return fmaxf(fmaxf(a, b), c); }
__device__ __forceinline__ void attn_softmax_pv(AttnState& A, f32x16 (&s)[2], const LAS unsigned char* Vt, int r, int h, float bias_c = 0.f, bool lane_ok = true) {
    constexpr float THR = 8.f; const int voff = vt_lane_off(r + 32 * h);
    float mx = max3f(s[0][0], s[0][1], s[0][2]);
#pragma unroll
    for (int i = 3; i < 15; i += 2) mx = max3f(mx, s[0][i], s[0][i + 1]);
    mx = max3f(mx, s[0][15], s[1][0]);
#pragma unroll
    for (int i = 1; i < 15; i += 2) mx = max3f(mx, s[1][i], s[1][i + 1]);
    mx = fmaxf(mx, s[1][15]);
    mx = fmaxf(mx, __shfl_xor(mx, 32));
    const float mxb = (lane_ok && mx > -1e29f) ? mx + bias_c : -1e30f;
    const bool grow = mxb > A.m + THR;
    const float mnew = grow ? mxb : A.m;
    if (__any(grow)) {
        const float alpha = __builtin_amdgcn_exp2f(A.m - mnew);
        A.l *= alpha;
#pragma unroll
        for (int i = 0; i < 16; ++i) { A.o[0][i] *= alpha; A.o[1][i] *= alpha; }
    }
    A.m = mnew;
    const float sub = (lane_ok && mnew > -1e29f) ? mnew - bias_c : 1e30f;
    float rs = 0.f;
#pragma unroll
    for (int kb = 0; kb < 2; ++kb)
#pragma unroll
        for (int i = 0; i < 16; ++i) { const float p = __builtin_amdgcn_exp2f(s[kb][i] - sub); s[kb][i] = p; rs += p; }
    rs += __shfl_xor(rs, 32);
    A.l += rs;
    bf16x8 vf[4][2];
#pragma unroll
    for (int s4 = 0; s4 < 4; ++s4)
#pragma unroll
        for (int eb = 0; eb < 2; ++eb) vf[s4][eb] = vt_frag(Vt, voff, s4, eb);
    __builtin_amdgcn_sched_barrier(0);
#pragma unroll
    for (int s4 = 0; s4 < 4; ++s4) {
        const int kb = s4 >> 1, hf = (s4 & 1) * 8;
        u32x4 pw; pw.x = pk_bf16(s[kb][hf + 0], s[kb][hf + 1]); pw.y = pk_bf16(s[kb][hf + 2], s[kb][hf + 3]); pw.z = pk_bf16(s[kb][hf + 4], s[kb][hf + 5]); pw.w = pk_bf16(s[kb][hf + 6], s[kb][hf + 7]);
        const bf16x8 pf = __builtin_bit_cast(bf16x8, pw);
#pragma unroll
        for (int eb = 0; eb < 2; ++eb) A.o[eb] = MFMA32(vf[s4][eb], pf, A.o[eb]);
    }
}
template <int DK>
__device__ __forceinline__ void stage_k_load(u32x4 (&kr)[2], const bf16_t* Kg  , int tid) {
    constexpr int CH = DK / 8;
    kr[0] = *(const u32x4*)(Kg + (size_t)(tid / CH) * DK + (tid % CH) * 8);
    if (64 * CH > 512) { const int c2 = tid + 512; if (c2 < 64 * CH) kr[1] = *(const u32x4*)(Kg + (size_t)(c2 / CH) * DK + (c2 % CH) * 8); }
}
template <int DK>
__device__ __forceinline__ void stage_k_store(const u32x4 (&kr)[2], LAS unsigned char* Kt, int tid) {
    constexpr int CH = DK / 8, KP = 2 * DK + 16;
    *(LAS u32x4*)(Kt + (tid / CH) * KP + (tid % CH) * 16) = kr[0];
    if (64 * CH > 512) { const int c2 = tid + 512; if (c2 < 64 * CH) *(LAS u32x4*)(Kt + (c2 / CH) * KP + (c2 % CH) * 16) = kr[1]; }
}
__device__ __forceinline__ u32x4 stage_v_load(const bf16_t* Vg, int tid) { return *(const u32x4*)(Vg + (size_t)(tid >> 3) * 64 + (tid & 7) * 8); }
__device__ __forceinline__ void stage_v_store(const u32x4& v, LAS unsigned char* Vt, int tid) { *(LAS u32x4*)(Vt + (tid >> 3) * VTP + (tid & 7) * 16) = v; }

constexpr int MLA_KT = 0, MLA_VT = 2 * 64 * 208, MLA_LDS = MLA_VT + 2 * 64 * VTP;
__device__ __forceinline__ void mla_unit(int b, int hd, int qt, int l, unsigned char* ws, LAS unsigned char* lds, int g_wv) {
    int tid_ = TIDX; asm volatile("" : "+v"(tid_));
    const int tid = tid_, w = tid >> 6, lane = tid & 63, r = lane & 31, h = lane >> 5;
    const size_t slab = (size_t)(b * 6 + hd) * 2048;
    const bf16_t* QM = (const bf16_t*)(ws + WS_MLA) + slab * 96; const bf16_t* KM = (const bf16_t*)(ws + WS_MLA + MLA_KM) + slab * 96; const bf16_t* VM = (const bf16_t*)(ws + WS_MLA + MLA_VM) + slab * 64;
    const int q0 = 256 * qt + 32 * w, q = q0 + r;
    bf16x8 qf[6];
#pragma unroll
    for (int ks = 0; ks < 6; ++ks) qf[ks] = *(const bf16x8*)(QM + (size_t)q * 96 + 16 * ks + 8 * h);
    AttnState A; attn_reset(A);
    const int ntile = 4 * qt + 4;
    u32x4 kr[2], vr, kr2[2], vr2;
    stage_k_load<96>(kr, KM, tid); vr = stage_v_load(VM, tid);
    stage_k_store<96>(kr, lds + MLA_KT, tid); stage_v_store(vr, lds + MLA_VT, tid);
    if (ntile > 1) { stage_k_load<96>(kr, KM + (size_t)64 * 96, tid); vr = stage_v_load(VM + (size_t)64 * 64, tid); }
    __syncthreads();
    for (int j = 0; j < ntile; ++j) {
        const int cur = j & 1;
        if (j + 2 < ntile) { stage_k_load<96>(kr2, KM + (size_t)(j + 2) * 64 * 96, tid); vr2 = stage_v_load(VM + (size_t)(j + 2) * 64 * 64, tid); }
        if (64 * j <= q0 + 31) {
            f32x16 s[2];
            attn_scores<96>(s, qf, lds + MLA_KT + cur * 64 * 208, r, h);
            if (64 * j + 63 > q0) {
#pragma unroll
                for (int kb = 0; kb < 2; ++kb)
#pragma unroll
                    for (int i = 0; i < 16; ++i) { const int key = 64 * j + 32 * kb + crow(i, h); if (key > q) s[kb][i] = -1e30f; }
            }
            attn_softmax_pv(A, s, lds + MLA_VT + cur * 64 * VTP, r, h);
        }
        if (j + 1 < ntile) { stage_k_store<96>(kr, lds + MLA_KT + (cur ^ 1) * 64 * 208, tid); stage_v_store(vr, lds + MLA_VT + (cur ^ 1) * 64 * VTP, tid); }
        kr[0] = kr2[0]; kr[1] = kr2[1]; vr = vr2;
        __syncthreads();
    }
    const float inv = A.l > 0.f ? 1.f / A.l : 0.f; float ss = 0.f;
    bf16_t* Y = (bf16_t*)(ws + WS_Y) + ((size_t)b * 2048 + q) * 1024 + 640 + hd * 64;
#pragma unroll
    for (int eb = 0; eb < 2; ++eb)
#pragma unroll
        for (int g4 = 0; g4 < 4; ++g4) {
            const float v0 = A.o[eb][4 * g4] * inv, v1 = A.o[eb][4 * g4 + 1] * inv, v2 = A.o[eb][4 * g4 + 2] * inv, v3 = A.o[eb][4 * g4 + 3] * inv;
            u32x2 pw; pw.x = pk_bf16(v0, v1); pw.y = pk_bf16(v2, v3);
            const float f0 = bf_lo(pw.x), f1 = bf_hi(pw.x), f2 = bf_lo(pw.y), f3 = bf_hi(pw.y); ss += (f0 * f0 + f1 * f1) + (f2 * f2 + f3 * f3);
            *(u32x2*)(Y + 32 * eb + 8 * g4 + 4 * h) = pw;
        }
    ss += __shfl_xor(ss, 32);
    if (h == 0) ((float*)(ws + WS_SSQ + PT_C))[((size_t)l * 16384 + (size_t)b * 2048 + q) * 8 + hd] = ss;
}

__device__ __forceinline__ void nsa_bias32(float (&bv)[2][16], const LAS float* bl, int dd) {
#pragma unroll
    for (int kb = 0; kb < 2; ++kb)
#pragma unroll
        for (int k = 0; k < 16; ++k) { const int c = 63 - (32 * kb + (k & 3) + 8 * (k >> 2)); int d = dd + c; d = d < 0 ? 0 : (d > 255 ? 255 : d); bv[kb][k] = bl[d]; }
}
__device__ __forceinline__ void nsa_mask_bias(f32x16 (&sc)[2], int dq, int h, const LAS float* bl, bool sel, int lim) {
    int dd = dq - 4 * h - 63; asm volatile("" : "+v"(dd));
    float bv[2][16]; nsa_bias32(bv, bl, dd);
#pragma unroll
    for (int kb = 0; kb < 2; ++kb)
#pragma unroll
        for (int k = 0; k < 16; ++k) { const int c = 63 - (32 * kb + (k & 3) + 8 * (k >> 2)); const int d = dd + c; sc[kb][k] = (sel && d >= 0 && d < lim) ? sc[kb][k] + bv[kb][k] : -1e30f; }
}

constexpr int NSA_KT = 0, NSA_VT = 2 * 64 * 144, NSA_BIAS = NSA_VT + 2 * 64 * VTP, NSA_PS = NSA_BIAS + 3 * 256 * 4, NSA_SEL = NSA_PS + 3 * 64 * 32 * 4, NSA_UNI = NSA_SEL + 256, NSA_OT = NSA_UNI + 256, NSA_LDS = NSA_OT + 6 * 8192;
__device__ __forceinline__ void nsa_unit(int b, int hk, int i, int l, InPtr in, unsigned char* ws, LAS unsigned char* lds, int g_wv) {
    int tid_ = TIDX; asm volatile("" : "+v"(tid_));
    const int tid = tid_, w = tid >> 6, lane = tid & 63, r = lane & 31, h = lane >> 5;
    const bool active = w < 6; const int g = active ? (w >> 1) : 0, th = w & 1, head = hk * 3 + g;
    const int t = 64 * i + 32 * th + r, tl = 32 * th + r; const size_t row = (size_t)b * 2048 + t;
    const size_t kvslab = (size_t)(b * 2 + hk) * 2048 * 64;
    LAS float* biasl = (LAS float*)(lds + NSA_BIAS); LAS float* PS = (LAS float*)(lds + NSA_PS); LAS unsigned* SEL = (LAS unsigned*)(lds + NSA_SEL); LAS unsigned* UNI = (LAS unsigned*)(lds + NSA_UNI);
    { const float* bd = (const float*)(ws + WS_BIASD) + (size_t)hk * 3 * 2048;
      if (tid < 384) { const int gg = tid >> 7, d0 = (tid & 127) * 2; biasl[gg * 256 + d0] = bd[gg * 2048 + d0]; biasl[gg * 256 + d0 + 1] = bd[gg * 2048 + d0 + 1]; }
#pragma unroll
      for (int k = 0; k < 12; ++k) PS[tid + 512 * k] = 0.f;
      if (tid < 4) UNI[tid] = 0u; }
    bf16x8 qf[4];
    { const bf16_t* QN = (const bf16_t*)(ws + WS_PRJ + PRJ_QN) + ((size_t)(b * 6 + head) * 2048 + t) * 64;
#pragma unroll
      for (int ks = 0; ks < 4; ++ks) qf[ks] = *(const bf16x8*)(QN + 16 * ks + 8 * h); }
#define NSA_GATE(k) ({ int t_ = t; asm volatile("" : "+v"(t_)); sigmf(((const float*)(ws + WS_PRJ + PRJ_GATES))[((size_t)b * 2048 + t_) * 32 + head * 3 + (k)]); })
    LAS float* bl = biasl + g * 256;
    LAS float* otl = (LAS float*)(lds + NSA_OT + (active ? w : 0) * 8192) + lane;
    u32x4 kr[2], vr;
    const int ntc = i >= 16 ? 2 : 1;
    { const bf16_t* KC = (const bf16_t*)(ws + WS_CMP) + (size_t)(b * 2 + hk) * 128 * 64; const bf16_t* VC = (const bf16_t*)(ws + WS_CMP + CMP_V) + (size_t)(b * 2 + hk) * 128 * 64;
      for (int T = 0; T < ntc; ++T) { stage_k_load<64>(kr, KC + T * 4096, tid); vr = stage_v_load(VC + T * 4096, tid); stage_k_store<64>(kr, lds + NSA_KT + T * 64 * 144, tid); stage_v_store(vr, lds + NSA_VT + T * 64 * VTP, tid); } }
    __syncthreads();
    {
        f32x16 ot[2];
        if (active) {
            float m = -1e30f, lsum = 0.f;
            for (int T = 0; T < ntc; ++T) {
                f32x16 sc[2]; attn_scores<64>(sc, qf, lds + NSA_KT + T * 64 * 144, r, h);
                float bvc[2][16];
#pragma unroll
                for (int kb = 0; kb < 2; ++kb)
#pragma unroll
                    for (int k = 0; k < 16; ++k) { int d = t - 16 * (64 * T + 32 * kb + crow(k, h)) - 31; d = d < 0 ? 0 : (d > 255 ? 255 : d); bvc[kb][k] = bl[d]; }
                float mx = -1e30f;
#pragma unroll
                for (int kb = 0; kb < 2; ++kb)
#pragma unroll
                    for (int k = 0; k < 16; ++k) { const int n = 64 * T + 32 * kb + crow(k, h); const int d = t - 16 * n - 31; const float x = (d >= 0 && n < 127) ? sc[kb][k] + bvc[kb][k] : -1e30f; sc[kb][k] = x; mx = fmaxf(mx, x); }
                mx = fmaxf(mx, __shfl_xor(mx, 32));
                const float mnew = fmaxf(m, mx), mref = mnew <= -1e29f ? 0.f : mnew; float rs = 0.f;
#pragma unroll
                for (int kb = 0; kb < 2; ++kb)
#pragma unroll
                    for (int k = 0; k < 16; ++k) rs += __builtin_amdgcn_exp2f(sc[kb][k] - mref);
                rs += __shfl_xor(rs, 32);
                lsum = lsum * __builtin_amdgcn_exp2f(m - mref) + rs; m = mnew;
            }
            const float mref = m <= -1e29f ? 0.f : m, inv = lsum > 0.f ? 1.f / lsum : 0.f;
#pragma unroll
            for (int k = 0; k < 16; ++k) { ot[0][k] = 0.f; ot[1][k] = 0.f; }
            float carry = 0.f;
            for (int T = 0; T < ntc; ++T) {
                f32x16 sc[2]; attn_scores<64>(sc, qf, lds + NSA_KT + T * 64 * 144, r, h);
                float bvc[2][16];
#pragma unroll
                for (int kb = 0; kb < 2; ++kb)
#pragma unroll
                    for (int k = 0; k < 16; ++k) { int d = t - 16 * (64 * T + 32 * kb + crow(k, h)) - 31; d = d < 0 ? 0 : (d > 255 ? 255 : d); bvc[kb][k] = bl[d]; }
#pragma unroll
                for (int kb = 0; kb < 2; ++kb)
#pragma unroll
                    for (int k = 0; k < 16; ++k) { const int n = 64 * T + 32 * kb + crow(k, h); const int d = t - 16 * n - 31; sc[kb][k] = (d >= 0 && n < 127) ? __builtin_amdgcn_exp2f(sc[kb][k] + bvc[kb][k] - mref) * inv : 0.f; }
                float prevL = carry;
#pragma unroll
                for (int kb = 0; kb < 2; ++kb)
#pragma unroll
                    for (int g4 = 0; g4 < 4; ++g4) {
                        const float G4 = (sc[kb][4 * g4] + sc[kb][4 * g4 + 1]) + (sc[kb][4 * g4 + 2] + sc[kb][4 * g4 + 3]); const float L = sc[kb][4 * g4 + 3];
                        const float Lo = __shfl_xor(L, 32);
                        const float add = h ? Lo : prevL;
                        prevL = Lo;
                        const int idx = T * 8 + kb * 4 + g4;
                        PS[g * 2048 + tl * 32 + 2 * idx + h] = G4 + add;
                    }
                carry = prevL;
#pragma unroll
                for (int s4 = 0; s4 < 4; ++s4) {
                    const int kb = s4 >> 1, hf = (s4 & 1) * 8;
                    u32x4 pw; pw.x = pk_bf16(sc[kb][hf + 0], sc[kb][hf + 1]); pw.y = pk_bf16(sc[kb][hf + 2], sc[kb][hf + 3]); pw.z = pk_bf16(sc[kb][hf + 4], sc[kb][hf + 5]); pw.w = pk_bf16(sc[kb][hf + 6], sc[kb][hf + 7]);
                    const bf16x8 pf = __builtin_bit_cast(bf16x8, pw);
#pragma unroll
                    for (int eb = 0; eb < 2; ++eb) ot[eb] = MFMA32(vt_frag(lds + NSA_VT + T * 64 * VTP, vt_lane_off(lane), s4, eb), pf, ot[eb]);
                }
            }
            { const float gc = NSA_GATE(0);
#pragma unroll
            for (int k = 0; k < 16; ++k) { otl[64 * k] = ot[0][k] * gc; otl[64 * (16 + k)] = ot[1][k] * gc; } }
        }
    }
    __syncthreads();
#ifndef NO_NSA_SEL
    {
        const int tk = tid >> 3, sg = tid & 7; float v[32];
#pragma unroll
        for (int k = 0; k < 8; ++k) { const f32x4 x0 = *(const LAS f32x4*)(PS + tk * 32 + 4 * k), x1 = *(const LAS f32x4*)(PS + 2048 + tk * 32 + 4 * k), x2 = *(const LAS f32x4*)(PS + 4096 + tk * 32 + 4 * k);
            v[4 * k] = (x0.x + x1.x) + x2.x; v[4 * k + 1] = (x0.y + x1.y) + x2.y; v[4 * k + 2] = (x0.z + x1.z) + x2.z; v[4 * k + 3] = (x0.w + x1.w) + x2.w; }
#pragma unroll
        for (int s = 0; s < 32; ++s) { const bool forced = (s == 0) || (s == i) || (s == i - 1); float x = forced ? v[s] + 1e4f : v[s]; v[s] = s > i ? -1.f : x; }
        unsigned bits = 0u;
#pragma unroll
        for (int k = 0; k < 4; ++k) {
            float x = 0.f;
#pragma unroll
            for (int s = 0; s < 32; ++s) x = (s == 4 * sg + k) ? v[s] : x;
            int rank = 0;
#pragma unroll
            for (int s = 0; s < 32; ++s) rank += (v[s] > x || (v[s] == x && s < 4 * sg + k)) ? 1 : 0;
            if (rank < 16 && x >= 0.f) bits |= 1u << (4 * sg + k);
        }
        bits |= __shfl_xor(bits, 1); bits |= __shfl_xor(bits, 2); bits |= __shfl_xor(bits, 4);
        if (sg == 0) { SEL[tk] = bits; __hip_atomic_fetch_or(UNI, bits, __ATOMIC_RELAXED, __HIP_MEMORY_SCOPE_WORKGROUP); __hip_atomic_fetch_or(UNI + 1 + (tk >> 5), bits, __ATOMIC_RELAXED, __HIP_MEMORY_SCOPE_WORKGROUP); }
    }
#endif
    __syncthreads();
    const unsigned selbits = SEL[tl], uni = UNI[0], unih = UNI[1 + th];
    const float c31 = bl[255];
#ifndef NO_NSA_SLC
    {
        AttnState A; attn_reset(A);
        const bf16_t* KS = (const bf16_t*)(ws + WS_PRJ + PRJ_KN1) + kvslab; const bf16_t* VS = (const bf16_t*)(ws + WS_PRJ + PRJ_VN1) + kvslab;
        unsigned todo = uni; int cur = 0; u32x4 kr2[2], vr2;
        int s = __ffs(todo) - 1; todo &= todo - 1;
        stage_k_load<64>(kr, KS + (size_t)s * 4096, tid); vr = stage_v_load(VS + (size_t)s * 4096, tid);
        stage_k_store<64>(kr, lds + NSA_KT, tid); stage_v_store(vr, lds + NSA_VT, tid);
        int sn = todo ? __ffs(todo) - 1 : -1; todo &= todo - 1;
        if (sn >= 0) { stage_k_load<64>(kr, KS + (size_t)sn * 4096, tid); vr = stage_v_load(VS + (size_t)sn * 4096, tid); }
        __syncthreads();
        while (s >= 0) {
            const int sn2 = todo ? __ffs(todo) - 1 : -1; todo &= todo - 1;
            if (sn2 >= 0) { stage_k_load<64>(kr2, KS + (size_t)sn2 * 4096, tid); vr2 = stage_v_load(VS + (size_t)sn2 * 4096, tid); }
            if (active && ((unih >> s) & 1u)) {
                f32x16 sc[2];
                attn_scores<64>(sc, qf, lds + NSA_KT + cur * 64 * 144, r, h);
                const bool sel = (selbits >> s) & 1u;
                if (i - s >= 3) attn_softmax_pv(A, sc, lds + NSA_VT + cur * 64 * VTP, r, h, c31, sel);
                else { nsa_mask_bias(sc, t - 64 * s, h, bl, sel, 4096); attn_softmax_pv(A, sc, lds + NSA_VT + cur * 64 * VTP, r, h); }
            }
            if (sn >= 0) { stage_k_store<64>(kr, lds + NSA_KT + (cur ^ 1) * 64 * 144, tid); stage_v_store(vr, lds + NSA_VT + (cur ^ 1) * 64 * VTP, tid); }
            kr[0] = kr2[0]; vr = vr2;
            __syncthreads();
            s = sn; sn = sn2; cur ^= 1;
        }
        if (active) { const float gs = NSA_GATE(1); const float inv = A.l > 0.f ? gs / A.l : 0.f;
#pragma unroll
            for (int k = 0; k < 16; ++k) { otl[64 * k] += A.o[0][k] * inv; otl[64 * (16 + k)] += A.o[1][k] * inv; } }
    }
#endif
#ifndef NO_NSA_WIN
    {
        AttnState A; attn_reset(A);
        const bf16_t* KW = (const bf16_t*)(ws + WS_PRJ + PRJ_KN2) + kvslab; const bf16_t* VW = (const bf16_t*)(ws + WS_PRJ + PRJ_VN2) + kvslab;
        const int j0 = i > 8 ? i - 8 : 0; int cur = 0; u32x4 kr2[2], vr2;
        stage_k_load<64>(kr, KW + (size_t)j0 * 4096, tid); vr = stage_v_load(VW + (size_t)j0 * 4096, tid);
        stage_k_store<64>(kr, lds + NSA_KT, tid); stage_v_store(vr, lds + NSA_VT, tid);
        if (j0 < i) { stage_k_load<64>(kr, KW + (size_t)(j0 + 1) * 4096, tid); vr = stage_v_load(VW + (size_t)(j0 + 1) * 4096, tid); }
        __syncthreads();
        for (int j = j0; j <= i; ++j) {
            if (j + 2 <= i) { stage_k_load<64>(kr2, KW + (size_t)(j + 2) * 4096, tid); vr2 = stage_v_load(VW + (size_t)(j + 2) * 4096, tid); }
            if (active) {
                f32x16 sc[2];
                attn_scores<64>(sc, qf, lds + NSA_KT + cur * 64 * 144, r, h);
                if (i - j >= 3 && j > i - 8) attn_softmax_pv(A, sc, lds + NSA_VT + cur * 64 * VTP, r, h, c31, true);
                else { nsa_mask_bias(sc, t - 64 * j, h, bl, true, 512); attn_softmax_pv(A, sc, lds + NSA_VT + cur * 64 * VTP, r, h); }
            }
            if (j < i) { stage_k_store<64>(kr, lds + NSA_KT + (cur ^ 1) * 64 * 144, tid); stage_v_store(vr, lds + NSA_VT + (cur ^ 1) * 64 * VTP, tid); }
            kr[0] = kr2[0]; vr = vr2;
            __syncthreads();
            cur ^= 1;
        }
        if (active) { const float gw = NSA_GATE(2); const float inv = A.l > 0.f ? gw / A.l : 0.f;
            float ss = 0.f; bf16_t* Y = (bf16_t*)(ws + WS_Y) + row * 1024 + head * 64;
#pragma unroll
            for (int eb = 0; eb < 2; ++eb)
#pragma unroll
                for (int g4 = 0; g4 < 4; ++g4) {
                    const float v0 = otl[64 * (16 * eb + 4 * g4)] + A.o[eb][4 * g4] * inv, v1 = otl[64 * (16 * eb + 4 * g4 + 1)] + A.o[eb][4 * g4 + 1] * inv;
                    const float v2 = otl[64 * (16 * eb + 4 * g4 + 2)] + A.o[eb][4 * g4 + 2] * inv, v3 = otl[64 * (16 * eb + 4 * g4 + 3)] + A.o[eb][4 * g4 + 3] * inv;
                    u32x2 pw; pw.x = pk_bf16(v0, v1); pw.y = pk_bf16(v2, v3);
                    const float f0 = bf_lo(pw.x), f1 = bf_hi(pw.x), f2 = bf_lo(pw.y), f3 = bf_hi(pw.y); ss += (f0 * f0 + f1 * f1) + (f2 * f2 + f3 * f3);
                    *(u32x2*)(Y + 32 * eb + 8 * g4 + 4 * h) = pw;
                }
            ss += __shfl_xor(ss, 32);
            if (h == 0) ((float*)(ws + WS_SSQ + PT_A))[((size_t)l * 16384 + row) * 8 + head] = ss;
        }
    }
#endif
}

__device__ __forceinline__ void ml_out_wave(int cu, int l, InPtr in, unsigned char* ws, LAS unsigned char* wl, LAS unsigned char* npl, int lane) {
    const int c = cu & 31, bh = cu >> 5, hd = bh & 3, b = bh >> 2; const int t0 = c * 64; const int r = lane & 15, q = lane >> 4;
    const bf16_t* QC = (const bf16_t*)(ws + WS_ML) + ((size_t)bh * 2048 + t0) * 64; const bf16_t* KC = (const bf16_t*)(ws + WS_ML + ML_KC) + ((size_t)bh * 2048 + t0) * 64;
    const bf16_t* V = (const bf16_t*)(ws + WS_PRJ + PRJ_VML) + ((size_t)bh * 2048 + t0) * 64;
    const float* mlg = (const float*)(ws + WS_ML + ML_G) + ((size_t)bh * 2048 + t0) * 2;
    const bf16_t* CP = (const bf16_t*)(ws + WS_ML + ML_CP) + (size_t)cu * 4096; const bf16_t* NP = (const bf16_t*)(ws + WS_ML + ML_NP) + (size_t)cu * 64;
    bf16x8 aq[4][2];
#pragma unroll
    for (int mb = 0; mb < 4; ++mb)
#pragma unroll
        for (int ks = 0; ks < 2; ++ks) aq[mb][ks] = *(const bf16x8*)(QC + (size_t)(16 * mb + r) * 64 + 32 * ks + 8 * q);
    float bj[4][4], den[4][4];
#pragma unroll
    for (int mb = 0; mb < 4; ++mb)
#pragma unroll
        for (int j = 0; j < 4; ++j) bj[mb][j] = mlg[(16 * mb + 4 * q + j) * 2];
    {
        float cs[4];
#pragma unroll
        for (int nb = 0; nb < 4; ++nb) { const float2 gg = *(const float2*)(mlg + (16 * nb + r) * 2); cs[nb] = gg.y - gg.x; }
#pragma unroll
        for (int mb = 0; mb < 4; ++mb) {
            f32x4 accS[4];
#pragma unroll
            for (int nb = 0; nb < 4; ++nb) { accS[nb] = (f32x4){0.f, 0.f, 0.f, 0.f};
#pragma unroll
                for (int ks = 0; ks < 2; ++ks) { const bf16x8 bk = *(const bf16x8*)(KC + (size_t)(16 * nb + r) * 64 + 32 * ks + 8 * q); accS[nb] = MFMA16(aq[mb][ks], bk, accS[nb]); } }
#pragma unroll
            for (int j = 0; j < 4; ++j) {
                const int jj = 16 * mb + 4 * q + j; float rs = 0.f;
#pragma unroll
                for (int nb = 0; nb < 4; ++nb) { const int s = 16 * nb + r; const float p = s <= jj ? accS[nb][j] * __expf(bj[mb][j] + cs[nb]) : 0.f; rs += p;
                    *(LAS bf16_t*)(wl + 8192 + swz_off(jj, s >> 3) + (s & 7) * 2) = f2bf(p); }
                rs += __shfl_xor(rs, 1); rs += __shfl_xor(rs, 2); rs += __shfl_xor(rs, 4); rs += __shfl_xor(rs, 8);
                den[mb][j] = rs;
            }
        }
    }
#pragma unroll
    for (int mb = 0; mb < 4; ++mb) { const float e = __expf(mlg[(16 * mb + r) * 2]);
#pragma unroll
        for (int ks = 0; ks < 2; ++ks) { const u32x4 x = __builtin_bit_cast(u32x4, aq[mb][ks]); u32x4 y;
            y.x = pk_bf16(bf_lo(x.x) * e, bf_hi(x.x) * e); y.y = pk_bf16(bf_lo(x.y) * e, bf_hi(x.y) * e); y.z = pk_bf16(bf_lo(x.z) * e, bf_hi(x.z) * e); y.w = pk_bf16(bf_lo(x.w) * e, bf_hi(x.w) * e);
            aq[mb][ks] = __builtin_bit_cast(bf16x8, y); } }
    f32x4 acc[4][4], accn[4];
#pragma unroll
    for (int mb = 0; mb < 4; ++mb) { accn[mb] = (f32x4){0.f, 0.f, 0.f, 0.f};
#pragma unroll
        for (int nb = 0; nb < 4; ++nb) acc[mb][nb] = (f32x4){0.f, 0.f, 0.f, 0.f}; }
#pragma unroll
    for (int ks = 0; ks < 2; ++ks) {
        u32x4 nz = *(const u32x4*)(NP + 32 * ks + 8 * q); if (r != 0) nz = (u32x4){0u, 0u, 0u, 0u};
        const bf16x8 bn = __builtin_bit_cast(bf16x8, nz);
#pragma unroll
        for (int nb = 0; nb < 4; ++nb) { const bf16x8 bb = *(const bf16x8*)(CP + (size_t)(16 * nb + r) * 64 + 32 * ks + 8 * q);
#pragma unroll
            for (int mb = 0; mb < 4; ++mb) acc[mb][nb] = MFMA16(aq[mb][ks], bb, acc[mb][nb]); }
#pragma unroll
        for (int mb = 0; mb < 4; ++mb) accn[mb] = MFMA16(aq[mb][ks], bn, accn[mb]);
    }
#pragma unroll
    for (int s8 = 0; s8 < 8; ++s8) { float vb[8];
#pragma unroll
        for (int j = 0; j < 8; ++j) vb[j] = bf2f(V[(size_t)(s8 * 8 + j) * 64 + lane]);
        u32x4 pk; pk.x = pk_bf16(vb[0], vb[1]); pk.y = pk_bf16(vb[2], vb[3]); pk.z = pk_bf16(vb[4], vb[5]); pk.w = pk_bf16(vb[6], vb[7]);
        *(LAS u32x4*)(wl + swz_off(lane, s8)) = pk; }
    LDS_FENCE();
#pragma unroll
    for (int ks = 0; ks < 2; ++ks) {
        bf16x8 ap[4];
#pragma unroll
        for (int mb = 0; mb < 4; ++mb) ap[mb] = *(const LAS bf16x8*)(wl + 8192 + swz_off(16 * mb + r, 4 * ks + q));
#pragma unroll
        for (int nb = 0; nb < 4; ++nb) { const bf16x8 bv = *(const LAS bf16x8*)(wl + swz_off(16 * nb + r, 4 * ks + q));
#pragma unroll
            for (int mb = 0; mb < 4; ++mb) acc[mb][nb] = MFMA16(ap[mb], bv, acc[mb][nb]); }
    }
    LDS_FENCE();
    const float* gain = in->p[14] + l * 256 + hd * 64; const bf16_t* OG = (const bf16_t*)(ws + WS_PRJ + PRJ_OG);
    bf16_t* Y = (bf16_t*)(ws + WS_Y);
#pragma unroll
    for (int mb = 0; mb < 4; ++mb)
#pragma unroll
        for (int j = 0; j < 4; ++j) {
            const int jj = 16 * mb + 4 * q + j;
            const float dn = den[mb][j] + __builtin_bit_cast(float, __builtin_amdgcn_ds_bpermute((lane & 48) << 2, __builtin_bit_cast(int, accn[mb][j])));
            const float inv = 1.f / fmaxf(fabsf(dn), 1.f); float hv[4]; float ss = 0.f;
#pragma unroll
            for (int nb = 0; nb < 4; ++nb) { hv[nb] = acc[mb][nb][j] * inv; ss += hv[nb] * hv[nb]; }
            ss += __shfl_xor(ss, 1); ss += __shfl_xor(ss, 2); ss += __shfl_xor(ss, 4); ss += __shfl_xor(ss, 8);
            const float rstd = rsqrtf(ss * (1.f / 64.f) + 1e-6f); const size_t row = (size_t)b * 2048 + t0 + jj;
#pragma unroll
            for (int nb = 0; nb < 4; ++nb) { const int e = 16 * nb + r; Y[row * 1024 + 384 + hd * 64 + e] = f2bf(hv[nb] * rstd * gain[e] * sigmf(bf2f(OG[row * 256 + hd * 64 + e]))); }
        }
}

__device__ __forceinline__ void ml_scan_unit(int bh, int l, unsigned char* ws, int g_wv) {
    int tid_ = TIDX; asm volatile("" : "+v"(tid_)); const int tid = tid_;
    const bf16_t* DL = (const bf16_t*)(ws + WS_ML + ML_DELTA) + (size_t)bh * 32 * 4096 + tid * 8; bf16_t* CP = (bf16_t*)(ws + WS_ML + ML_CP) + (size_t)bh * 32 * 4096 + tid * 8;
    const float* DN = (const float*)(ws + WS_ML + ML_DN) + (size_t)bh * 32 * 64; bf16_t* NP = (bf16_t*)(ws + WS_ML + ML_NP) + (size_t)bh * 32 * 64; const float* BL = (const float*)(ws + WS_ML + ML_BL) + bh * 32;
    float c[8]; float n = 0.f;
#pragma unroll
    for (int k = 0; k < 8; ++k) c[k] = 0.f;
#pragma unroll 1
    for (int c0 = 0; c0 < 32; c0 += 8) {
        u32x4 d[8]; float dn[8], co[8];
#pragma unroll
        for (int k = 0; k < 8; ++k) { d[k] = *(const u32x4*)(DL + (size_t)(c0 + k) * 4096); dn[k] = tid < 64 ? DN[(c0 + k) * 64 + tid] : 0.f; co[k] = __expf(BL[c0 + k]); }
#pragma unroll
        for (int k = 0; k < 8; ++k) {
            u32x4 o; o.x = pk_bf16(c[0], c[1]); o.y = pk_bf16(c[2], c[3]); o.z = pk_bf16(c[4], c[5]); o.w = pk_bf16(c[6], c[7]);
            *(u32x4*)(CP + (size_t)(c0 + k) * 4096) = o; if (tid < 64) NP[(c0 + k) * 64 + tid] = f2bf(n);
            c[0] = co[k] * c[0] + bf_lo(d[k].x); c[1] = co[k] * c[1] + bf_hi(d[k].x); c[2] = co[k] * c[2] + bf_lo(d[k].y); c[3] = co[k] * c[3] + bf_hi(d[k].y);
            c[4] = co[k] * c[4] + bf_lo(d[k].z); c[5] = co[k] * c[5] + bf_hi(d[k].z); c[6] = co[k] * c[6] + bf_lo(d[k].w); c[7] = co[k] * c[7] + bf_hi(d[k].w);
            n = co[k] * n + dn[k];
        }
    }
    asm volatile("s_waitcnt vmcnt(0)" ::: "memory"); __syncthreads();
    if (tid == 0) { __builtin_amdgcn_fence(__ATOMIC_RELEASE, "agent"); asm volatile("s_waitcnt vmcnt(0)" ::: "memory");
        __hip_atomic_fetch_add((unsigned*)(ws + WS_CTL) + CW_SCAN + 64 * l, 1u, __ATOMIC_RELAXED, __HIP_MEMORY_SCOPE_AGENT); }
}
__device__ __forceinline__ void ml_scan_wait(int l, unsigned char* ws, int g_wv) {
    if (TIDX == 0) { unsigned* p = (unsigned*)(ws + WS_CTL) + CW_SCAN + 64 * l; unsigned sp = 0;
        while (__hip_atomic_load(p, __ATOMIC_RELAXED, __HIP_MEMORY_SCOPE_AGENT) < 32u) { __builtin_amdgcn_s_sleep(2); if (++sp > (1u << 22)) break; }
        __builtin_amdgcn_fence(__ATOMIC_ACQUIRE, "agent"); asm volatile("s_waitcnt vmcnt(0)" ::: "memory"); }
    __syncthreads();
}

#ifndef DUP_NSA
#define DUP_NSA 1
#endif
#ifndef DUP_MLA
#define DUP_MLA 1
#endif
#ifndef DUP_ML
#define DUP_ML 1
#endif
#ifdef NO_MLA
#define MLA_CALL(...) do {} while (0)
#else
#define MLA_CALL(...) do { for (int rp = 0; rp < DUP_MLA; ++rp) { if (rp) __syncthreads(); mla_unit(__VA_ARGS__); } } while (0)
#endif
__device__ __forceinline__ void phase_mix(int l, InPtr in, unsigned char* ws, LAS unsigned char* lds, unsigned* qhead, int g_wv) {
    LAS int* slot = (LAS int*)(lds + LDS_MISC + 64);
    for (;;) {
        __syncthreads();
        if (TIDX == 0) *slot = (int)__hip_atomic_fetch_add(qhead, 1u, __ATOMIC_RELAXED, __HIP_MEMORY_SCOPE_AGENT);
        __syncthreads();
        int u = *slot;
        if (u >= 32 + 512 + 384 + 128) break;
        if (u < 32) { ml_scan_unit(u, l, ws, g_wv); continue; } u -= 32;
#ifndef NO_NSA
        if (u < 256) { const int i = 31 - (u >> 4), bh = u & 15; { for (int rp = 0; rp < DUP_NSA; ++rp) { if (rp) __syncthreads(); nsa_unit(bh >> 1, bh & 1, i, l, in, ws, lds, g_wv); } } continue; }
#endif
        u -= 256;
        if (u < 192) { const int qt = 7 - u / 48, bh = u % 48; MLA_CALL(bh / 6, bh % 6, qt, l, ws, lds, g_wv); continue; }
        u -= 192;
#ifndef NO_NSA
        if (u < 128) { const int i = 15 - (u >> 4), bh = u & 15; { for (int rp = 0; rp < DUP_NSA; ++rp) { if (rp) __syncthreads(); nsa_unit(bh >> 1, bh & 1, i, l, in, ws, lds, g_wv); } } continue; }
#endif
        u -= 128;
        if (u < 192) { const int qt = 3 - u / 48, bh = u % 48; MLA_CALL(bh / 6, bh % 6, qt, l, ws, lds, g_wv); continue; } u -= 192;
#ifndef NO_NSA
        if (u < 128) { const int i = 7 - (u >> 4), bh = u & 15; { for (int rp = 0; rp < DUP_NSA; ++rp) { if (rp) __syncthreads(); nsa_unit(bh >> 1, bh & 1, i, l, in, ws, lds, g_wv); } } continue; }
#endif
        u -= 128;
#ifndef NO_MLOUT
        ml_scan_wait(l, ws, g_wv);
        for (int rp = 0; rp < DUP_ML; ++rp) { int tid_ = TIDX; asm volatile("" : "+v"(tid_)); const int w = tid_ >> 6; ml_out_wave(u * 8 + w, l, in, ws, lds + w * 16384, lds + 131072 + w * 256, tid_ & 63); }
#endif
    }
}
__device__ __forceinline__ void phase_ynorm(int l, unsigned char* ws, int bid, int nb, int g_wv) {
    int tid_ = TIDX; asm volatile("" : "+v"(tid_)); const int w = tid_ >> 6, lane = tid_ & 63;
    bf16_t* Y = (bf16_t*)(ws + WS_Y); const float* sa = (const float*)(ws + WS_SSQ + PT_A) + (size_t)l * 16384 * 8; const float* sc = (const float*)(ws + WS_SSQ + PT_C) + (size_t)l * 16384 * 8;
    for (int r0 = (bid * 8 + w) * 8; r0 < NTOK; r0 += nb * 64) {
        if (lane < 48) {
            u32x4 x[8], y[8]; float ra[8], rc[8];
#pragma unroll
            for (int k = 0; k < 8; ++k) { const int row = r0 + k;
                const f32x4 a0 = *(const f32x4*)(sa + (size_t)row * 8), a1 = *(const f32x4*)(sa + (size_t)row * 8 + 4), c0 = *(const f32x4*)(sc + (size_t)row * 8), c1 = *(const f32x4*)(sc + (size_t)row * 8 + 4);
                ra[k] = rsqrtf((((a0.x + a0.y) + (a0.z + a0.w)) + (a1.x + a1.y)) * (1.f / 384.f) + 1e-6f); rc[k] = rsqrtf((((c0.x + c0.y) + (c0.z + c0.w)) + (c1.x + c1.y)) * (1.f / 384.f) + 1e-6f);
                x[k] = *((const u32x4*)(Y + (size_t)row * 1024) + lane); y[k] = *((const u32x4*)(Y + (size_t)row * 1024 + 640) + lane); }
#pragma unroll
            for (int k = 0; k < 8; ++k) { const int row = r0 + k; u32x4 a = x[k], c = y[k]; const float fa = ra[k], fc = rc[k];
                a.x = pk_bf16(bf_lo(a.x) * fa, bf_hi(a.x) * fa); a.y = pk_bf16(bf_lo(a.y) * fa, bf_hi(a.y) * fa); a.z = pk_bf16(bf_lo(a.z) * fa, bf_hi(a.z) * fa); a.w = pk_bf16(bf_lo(a.w) * fa, bf_hi(a.w) * fa);
                c.x = pk_bf16(bf_lo(c.x) * fc, bf_hi(c.x) * fc); c.y = pk_bf16(bf_lo(c.y) * fc, bf_hi(c.y) * fc); c.z = pk_bf16(bf_lo(c.z) * fc, bf_hi(c.z) * fc); c.w = pk_bf16(bf_lo(c.w) * fc, bf_hi(c.w) * fc);
                *((u32x4*)(Y + (size_t)row * 1024) + lane) = a; *((u32x4*)(Y + (size_t)row * 1024 + 640) + lane) = c; }
        }
    }
}
struct EpiOut {
    bf16_t* XB; float* ssq;
    __device__ __forceinline__ void operator()(const f32x4 (&acc)[2][2][4][2], const GUnit& u, int wr, int wc, int fr, int fq) const {
#pragma unroll
        for (int ai = 0; ai < 2; ++ai)
#pragma unroll
          for (int mh = 0; mh < 2; ++mh) {
            __builtin_amdgcn_sched_barrier(0);
            u32x4 xr[2][2];
#pragma unroll
            for (int m2 = 0; m2 < 2; ++m2)
#pragma unroll
                for (int bj = 0; bj < 2; ++bj) xr[m2][bj] = *(const u32x4*)(XB + (size_t)(u.pm * 256 + ai * 128 + wr * 64 + (2 * mh + m2) * 16 + fr) * 1024 + u.pn * 256 + bj * 128 + wc * 32 + 8 * fq);
#pragma unroll
            for (int m2 = 0; m2 < 2; ++m2) {
                const int m = 2 * mh + m2; const int row = u.pm * 256 + ai * 128 + wr * 64 + m * 16 + fr; float ss = 0.f;
#pragma unroll
                for (int bj = 0; bj < 2; ++bj) {
                    const u32x4 x = xr[m2][bj]; u32x4 o;
                    o.x = pk_bf16(bf_lo(x.x) + acc[ai][bj][m][0][0], bf_hi(x.x) + acc[ai][bj][m][0][1]); o.y = pk_bf16(bf_lo(x.y) + acc[ai][bj][m][0][2], bf_hi(x.y) + acc[ai][bj][m][0][3]);
                    o.z = pk_bf16(bf_lo(x.z) + acc[ai][bj][m][1][0], bf_hi(x.z) + acc[ai][bj][m][1][1]); o.w = pk_bf16(bf_lo(x.w) + acc[ai][bj][m][1][2], bf_hi(x.w) + acc[ai][bj][m][1][3]);
                    *(u32x4*)(XB + (size_t)row * 1024 + u.pn * 256 + bj * 128 + wc * 32 + 8 * fq) = o;
                    ss += (bf_lo(o.x) * bf_lo(o.x) + bf_hi(o.x) * bf_hi(o.x)) + (bf_lo(o.y) * bf_lo(o.y) + bf_hi(o.y) * bf_hi(o.y)) + (bf_lo(o.z) * bf_lo(o.z) + bf_hi(o.z) * bf_hi(o.z)) + (bf_lo(o.w) * bf_lo(o.w) + bf_hi(o.w) * bf_hi(o.w));
                }
                ss = quad_sum(ss); if (fq == 0) ssq[(size_t)row * 16 + u.pn * 4 + wc] = ss;
            }
          }
    }
};

__device__ __forceinline__ float sum16(const float* p) { const f32x4 a = *(const f32x4*)p, b = *(const f32x4*)(p + 4), c = *(const f32x4*)(p + 8), d = *(const f32x4*)(p + 12);
    return (((a.x + a.y) + (a.z + a.w)) + ((b.x + b.y) + (b.z + b.w))) + (((c.x + c.y) + (c.z + c.w)) + ((d.x + d.y) + (d.z + d.w))); }
__device__ __forceinline__ void phase_route(int l, InPtr in, unsigned char* ws, LAS unsigned char* lds, int bid, int nb, int g_wv) {
    int tid_ = TIDX; asm volatile("" : "+v"(tid_)); const int w = tid_ >> 6, lane = tid_ & 63, r = lane & 15, q = lane >> 4;
    const bf16_t* XB = (const bf16_t*)(ws + WS_XB); const bf16_t* WR = (const bf16_t*)(ws + WS_WR) + (size_t)l * 64 * 1024;
    const float* ssq = (const float*)(ws + WS_SSQ + PT_X1) + (size_t)l * 16384 * 16; const float* bg = in->p[24] + l * 4; const float* be = in->p[26] + l * 32;
    unsigned* cnt = (unsigned*)(ws + WS_CTL) + CW_CNT + 2048 * l; unsigned* mtok = (unsigned*)(ws + WS_META); float* mw = (float*)(ws + WS_META + META_W);
    LAS float* lg = (LAS float*)(lds + w * 4096);
    LAS unsigned* lcnt = (LAS unsigned*)(lds + 32768); LAS unsigned* lbase = lcnt + 32;
    for (int g0 = bid * 8; g0 < NTOK / 16; g0 += nb * 8) {
        if (tid_ < 32) lcnt[tid_] = 0u;
        __syncthreads();
        const int tok0 = (g0 + w) * 16; f32x4 acc[3];
#pragma unroll
        for (int n = 0; n < 3; ++n) acc[n] = (f32x4){0.f, 0.f, 0.f, 0.f};
        const bf16_t* ap = XB + (size_t)(tok0 + r) * 1024 + 8 * q; const bf16_t* bp = WR + (size_t)r * 1024 + 8 * q;
#pragma unroll 8
        for (int ks = 0; ks < 32; ++ks) { const bf16x8 a = *(const bf16x8*)(ap + 32 * ks);
#pragma unroll
            for (int n = 0; n < 3; ++n) { const bf16x8 bb = *(const bf16x8*)(bp + (size_t)n * 16 * 1024 + 32 * ks); acc[n] = MFMA16(a, bb, acc[n]); } }
#pragma unroll
        for (int n = 0; n < 3; ++n)
#pragma unroll
            for (int j = 0; j < 4; ++j) lg[(4 * q + j) * 48 + 16 * n + r] = acc[n][j];
        LDS_FENCE();
        int E0 = 0, E1 = 0; unsigned r0 = 0, r1 = 0; float wt0 = 0.f, wt1 = 0.f; const int tok = tok0 + (lane & 15);
        if (lane < 16) {
            const float rs = rsqrtf(sum16(ssq + (size_t)tok * 16) * (1.f / 1024.f) + 1e-6f); ((float*)(ws + WS_RS2))[tok] = rs; const LAS float* L = lg + lane * 48;
            float gl[4]; int gi = 0;
#pragma unroll
            for (int j = 0; j < 4; ++j) gl[j] = L[j] * rs + bg[j];
            float gm = gl[0];
#pragma unroll
            for (int j = 1; j < 4; ++j) if (gl[j] > gm) { gm = gl[j]; gi = j; }
            float gsum = 0.f;
#pragma unroll
            for (int j = 0; j < 4; ++j) gsum += __expf(gl[j] - gm);
            const float gtop = 1.f / gsum;
            float el[8];
#pragma unroll
            for (int j = 0; j < 8; ++j) el[j] = L[4 + gi * 8 + j] * rs + be[gi * 8 + j];
            int e0 = 0; float v0 = el[0];
#pragma unroll
            for (int j = 1; j < 8; ++j) if (el[j] > v0) { v0 = el[j]; e0 = j; }
            int e1 = -1; float v1 = -3.0e38f;
#pragma unroll
            for (int j = 0; j < 8; ++j) if (j != e0 && el[j] > v1) { v1 = el[j]; e1 = j; }
            const float w0 = 1.f / (1.f + __expf(v1 - v0)); E0 = gi * 8 + e0; E1 = gi * 8 + e1; wt0 = w0 * gtop; wt1 = (1.f - w0) * gtop;
            r0 = __hip_atomic_fetch_add(lcnt + E0, 1u, __ATOMIC_RELAXED, __HIP_MEMORY_SCOPE_WORKGROUP); r1 = __hip_atomic_fetch_add(lcnt + E1, 1u, __ATOMIC_RELAXED, __HIP_MEMORY_SCOPE_WORKGROUP);
        }
        __syncthreads();
        if (tid_ < 32) { const unsigned c = lcnt[tid_]; lbase[tid_] = c ? atomicAdd(cnt + tid_ * 64, c) : 0u; }
        __syncthreads();
        if (lane < 16) {
            const unsigned p0 = lbase[E0] + r0, p1 = lbase[E1] + r1;
            mtok[(size_t)E0 * 16384 + p0] = (unsigned)tok; mw[(size_t)E0 * 16384 + p0] = wt0;
            mtok[(size_t)E1 * 16384 + p1] = (unsigned)tok | 0x80000000u; mw[(size_t)E1 * 16384 + p1] = wt1;
        }
        __syncthreads();
    }
}

constexpr int LDS_TB = 131072 + 2048;
__device__ __forceinline__ void moe_tables(int l, unsigned char* ws, LAS unsigned char* lds, int g_wv) {
    int tix = TIDX; asm volatile("" : "+v"(tix));
    LAS int* tb = (LAS int*)(lds + LDS_TB);
    if (tix < 32) { const unsigned* cnt = (const unsigned*)(ws + WS_CTL) + CW_CNT + 2048 * l; tb[160 + tix] = (int)__hip_atomic_load(cnt + tix * 64, __ATOMIC_RELAXED, __HIP_MEMORY_SCOPE_AGENT); }
    __syncthreads();
    if (tix == 0) { int a = 0, f = 0, p = 0; for (int e = 0; e < 32; ++e) { const int c = tb[160 + e]; tb[e] = a; tb[48 + e] = f; tb[96 + e] = p; a += (c + 255) >> 8; f += c >> 8; p += (c & 255) ? 1 : 0; } tb[32] = a; tb[80] = f; tb[128] = p; }
    __syncthreads();
}
template <int NPN, bool GATHER_>
struct MoeSched {
    static constexpr bool GATHER = GATHER_, PARTIAL = false;
    const char* A; const char* Bt; const unsigned* cnt; const unsigned* mtok; const LAS int* tb; int G, c; size_t bstride_e  , bstride_pn;
    __device__ __forceinline__ bool next(int i, GUnit& u) const {
        const int L = i * G + c; const int ntile = tb[32]; if (L >= ntile * NPN) return false;
        const int tile = L / NPN, pn = L % NPN; int e = 0;
        for (int k = 1; k < 32; ++k) e = (tb[k] <= tile) ? k : e;
        e = __builtin_amdgcn_readfirstlane(e);
        u.e = e; u.pm = tile; u.pn = pn; u.rows = tb[160 + e] - 256 * (tile - tb[e]);
        u.a = GATHER ? A : A + (size_t)tile * 256 * 256 * 2;
        u.b = Bt + (size_t)e * bstride_e + (size_t)pn * bstride_pn; return true;
    }
    __device__ __forceinline__ void aoff(const GUnit& u, unsigned (&v)[2][2], const int (&R)[2], const int (&C)[2]) const {
#pragma unroll
        for (int h = 0; h < 2; ++h)
#pragma unroll
            for (int i = 0; i < 2; ++i) {
                if (GATHER) { const int lr = h * 128 + R[i]; const int rr = 256 * (u.pm - tb[u.e]) + (lr < u.rows ? lr : 0); const unsigned tok = mtok[(size_t)u.e * 16384 + rr] & 0x7fffffffu; v[h][i] = (tok * 1024u + (unsigned)C[i]) * 2u; }
                else v[h][i] = (unsigned)((h * 128 + R[i]) * 256 + C[i]) * 2u;
            }
    }
};
struct EpiMoeUp {
    const unsigned* mtok; const float* ssq; const LAS int* tb; bf16_t* HB;
    __device__ __forceinline__ void operator()(const f32x4 (&acc)[2][2][4][2], const GUnit& u, int wr, int wc, int fr, int fq) const {
        const int r0 = 256 * (u.pm - tb[u.e]);
        float rs8[8];
        { unsigned tk[8];
#pragma unroll
          for (int k = 0; k < 8; ++k) { const int lr = (k >> 2) * 128 + wr * 64 + (k & 3) * 16 + fr; tk[k] = mtok[(size_t)u.e * 16384 + r0 + (lr < u.rows ? lr : 0)] & 0x7fffffffu; }
#pragma unroll
          for (int k = 0; k < 8; ++k) rs8[k] = ssq[tk[k]]; }
#pragma unroll
        for (int ai = 0; ai < 2; ++ai)
#pragma unroll
            for (int m = 0; m < 4; ++m) {
                __builtin_amdgcn_sched_barrier(0);
                const int lr = ai * 128 + wr * 64 + m * 16 + fr;
                if (lr < u.rows) {
                    const float rs = rs8[ai * 4 + m];
                    float hv[8];
#pragma unroll
                    for (int n = 0; n < 2; ++n)
#pragma unroll
                        for (int j = 0; j < 4; ++j) { const float gv = acc[ai][0][m][n][j] * rs, uv = acc[ai][1][m][n][j] * rs; hv[4 * n + j] = siluf(gv) * uv; }
                    st_bf16x8(HB + ((size_t)u.pm * 256 + lr) * 256 + u.pn * 128 + wc * 32 + 8 * fq, hv);
                }
            }
    }
};
struct EpiMoeDown {
    const unsigned* mtok; const float* mw; const LAS int* tb; bf16_t* YB;
    __device__ __forceinline__ void operator()(const f32x4 (&acc)[2][2][4][2], const GUnit& u, int wr, int wc, int fr, int fq) const {
        const int r0 = 256 * (u.pm - tb[u.e]);
        unsigned mt8[8]; float wt8[8];
#pragma unroll
        for (int k = 0; k < 8; ++k) { const int lr = (k >> 2) * 128 + wr * 64 + (k & 3) * 16 + fr; const size_t ix = (size_t)u.e * 16384 + r0 + (lr < u.rows ? lr : 0); mt8[k] = mtok[ix]; wt8[k] = mw[ix]; }
#pragma unroll
        for (int ai = 0; ai < 2; ++ai)
#pragma unroll
            for (int m = 0; m < 4; ++m) {
                __builtin_amdgcn_sched_barrier(0);
                const int lr = ai * 128 + wr * 64 + m * 16 + fr;
                if (lr < u.rows) {
                    const unsigned mt = mt8[ai * 4 + m]; const float wt = wt8[ai * 4 + m];
                    bf16_t* dst = YB + ((size_t)(mt >> 31) * 16384 + (mt & 0x7fffffffu)) * 1024 + u.pn * 256 + wc * 32 + 8 * fq;
#pragma unroll
                    for (int bj = 0; bj < 2; ++bj) { float v[8];
#pragma unroll
                        for (int n = 0; n < 2; ++n)
#pragma unroll
                            for (int j = 0; j < 4; ++j) v[4 * n + j] = acc[ai][bj][m][n][j] * wt;
                        st_bf16x8(dst + bj * 128, v); }
                }
            }
    }
};
__device__ __forceinline__ void phase_combine(int l, unsigned char* ws, float* out, int bid, int nb, int g_wv) {
    int tid_ = TIDX; asm volatile("" : "+v"(tid_)); const int w = tid_ >> 6, lane = tid_ & 63;
    bf16_t* XB = (bf16_t*)(ws + WS_XB); const bf16_t* Y0 = (const bf16_t*)(ws + WS_YBUF); const bf16_t* Y1 = Y0 + (size_t)16384 * 1024; float* ssqx = (float*)(ws + WS_SSQX) + 16384;
    for (int row = bid * 8 + w; row < NTOK; row += nb * 8) {
        float ss = 0.f;
#pragma unroll
        for (int k = 0; k < 2; ++k) {
            const size_t o = (size_t)row * 1024 + (lane + 64 * k) * 8;
            const u32x4 x = *(const u32x4*)(XB + o), a = *(const u32x4*)(Y0 + o), c = *(const u32x4*)(Y1 + o);
            float v[8] = { bf_lo(x.x) + bf_lo(a.x) + bf_lo(c.x), bf_hi(x.x) + bf_hi(a.x) + bf_hi(c.x), bf_lo(x.y) + bf_lo(a.y) + bf_lo(c.y), bf_hi(x.y) + bf_hi(a.y) + bf_hi(c.y),
                           bf_lo(x.z) + bf_lo(a.z) + bf_lo(c.z), bf_hi(x.z) + bf_hi(a.z) + bf_hi(c.z), bf_lo(x.w) + bf_lo(a.w) + bf_lo(c.w), bf_hi(x.w) + bf_hi(a.w) + bf_hi(c.w) };
            if (l == L_ - 1 && out) { *(f32x4*)(out + o) = (f32x4){v[0], v[1], v[2], v[3]}; *(f32x4*)(out + o + 4) = (f32x4){v[4], v[5], v[6], v[7]}; }
            else { u32x4 p; p.x = pk_bf16(v[0], v[1]); p.y = pk_bf16(v[2], v[3]); p.z = pk_bf16(v[4], v[5]); p.w = pk_bf16(v[6], v[7]); *(u32x4*)(XB + o) = p;
#pragma unroll
                   for (int j = 0; j < 4; ++j) { const unsigned q = j == 0 ? p.x : (j == 1 ? p.y : (j == 2 ? p.z : p.w)); ss += bf_lo(q) * bf_lo(q) + bf_hi(q) * bf_hi(q); } }
        }
        if (l < L_ - 1) { ss = wave_sum(ss); if (lane == 0) ssqx[row] = ss; }
    }
}
constexpr int NPH = 9;
enum { PH_INPROJ = 0, PH_PREP, PH_MIX, PH_YNORM, PH_OUTPROJ, PH_ROUTE, PH_MOEUP, PH_MOEDOWN, PH_COMBINE };
struct Args { Inputs in; float* out; unsigned char* ws; int ph_lo, ph_hi; };

__global__ void __launch_bounds__(512, 2) mk(Args args) {
    extern __shared__ __attribute__((aligned(16))) unsigned char lds_raw[];
    LAS unsigned char* lds = (LAS unsigned char*)lds_raw;
    const int g_wv = __builtin_amdgcn_readfirstlane((int)threadIdx.x >> 6);
    const int bid0 = blockIdx.x, nb = gridDim.x;
#define BID() ({ int b_ = bid0; asm volatile("" : "+s"(b_)); b_; })
    unsigned char* ws = args.ws; unsigned* ctl = (unsigned*)(ws + WS_CTL);
    const int lo = args.ph_lo, hi = args.ph_hi;
    if (TIDX < 4) ((LAS unsigned*)(lds + LDS_MISC))[TIDX] = 0u;
    __syncthreads();
    XcdBarrier bar; bar.g_wv = g_wv; bar.bar = ctl + CW_BAR; bar.x = 0; bar.st = nullptr;
    if (hi - lo > 1) bar = xcd_barrier_post(ctl + CW_BAR, (volatile LAS unsigned*)(lds + LDS_MISC), g_wv);
#define IN(k) (lo <= (k) && (k) < hi)
#ifndef REPEAT_PH
#define REPEAT_PH -1
#endif
#define NREP(k) ((REPEAT_PH == (k)) ? 2 : 1)
#ifndef NBAR
#define NBAR 1
#endif
#ifndef TIME_PH
#define TIME_PH -1
#endif
#define STAMP(i) do { if (TIME_PH != -1 && blockIdx.x == 0 && TIDX == 0) ((unsigned long long*)(ctl + CW_TS))[i] = __builtin_amdgcn_s_memrealtime(); } while (0)
#define SEAM(k) do { if (IN(k) && IN((k) + 1)) for (int nb_ = 0; nb_ < NBAR; ++nb_) xcd_barrier(bar); STAMP((k) + 1); } while (0)
    STAMP(0);
#ifndef NO_PRO
    if (IN(0)) for (int rep = 0; rep < NREP(100); ++rep) { prologue(in_tab(), launder(ws), lds, BID(), nb, g_wv); if (rep + 1 < NREP(100)) xcd_barrier(bar); }
#endif
    SEAM(0);
    for (int l = 0; l < L_; ++l) {
        const int pb = 1 + l * NPH;
        if (IN(pb + PH_INPROJ)) for (int rep = 0; rep < NREP(PH_INPROJ); ++rep) {
            if (rep) xcd_barrier(bar);
            InPtr in = in_tab(); unsigned char* ws = launder(args.ws);
            g8::DenseSched S{(const char*)(ws + WS_XB), (const char*)(ws + WS_WIN) + (size_t)l * 2560 * 1024 * 2, 1024, 1024, 64, 10, nb, BID()};
            EpiInProj E{(const float*)(ws + WS_SSQX) + l * 16384, (float*)(ws + WS_SSQ + PT_DQ) + (size_t)l * 16384 * 4, (float*)(ws + WS_SSQ + PT_DKV) + (size_t)l * 16384 * 2,
                        in->p[8] + l * 64, in->p[9] + l * 64, in->p[19] + l * 192 + 96 + 64, (const float*)(ws + WS_ROPE), ws + WS_PRJ};
#ifndef NO_INPROJ
            g8::gemm_run(lds, 1024, 1024, S, E, g_wv);
#endif
        }
        SEAM(pb + PH_INPROJ);
        if (IN(pb + PH_PREP)) for (int rep = 0; rep < NREP(PH_PREP); ++rep) { if (rep) xcd_barrier(bar); phase_prep(l, in_tab(), launder(ws), lds, BID(), nb, g_wv, (unsigned*)launder(ws) + CW_Q + 64 * (4 + l + 2 * rep)); }
        SEAM(pb + PH_PREP);
        if (IN(pb + PH_MIX)) for (int rep = 0; rep < NREP(PH_MIX); ++rep) { if (rep) xcd_barrier(bar); phase_mix(l, in_tab(), launder(ws), lds, (unsigned*)launder(ws) + CW_Q + 64 * (l + 2 * rep), g_wv); }
        SEAM(pb + PH_MIX);
        if (IN(pb + PH_YNORM)) phase_ynorm(l, launder(ws), BID(), nb, g_wv);
        SEAM(pb + PH_YNORM);
        if (IN(pb + PH_OUTPROJ)) {
            unsigned char* ws = launder(args.ws);
            g8::DenseSched S{(const char*)(ws + WS_Y), (const char*)(ws + WS_WOUT) + (size_t)l * 1024 * 1024 * 2, 1024, 1024, 64, 4, nb, BID()};
            EpiOut E{(bf16_t*)(ws + WS_XB), (float*)(ws + WS_SSQ + PT_X1) + (size_t)l * 16384 * 16};
#ifndef NO_OUTPROJ
            g8::gemm_run(lds, 1024, 1024, S, E, g_wv);
#endif
        }
        SEAM(pb + PH_OUTPROJ);
#ifndef NO_ROUTE
        if (IN(pb + PH_ROUTE)) {
            const int b_ = BID();
            if (nb >= 256 && b_ >= 128) cvt_moe_layer(in_tab(), launder(ws), l, (LAS float*)lds, b_ - 128, nb - 128, TIDX);
            else { phase_route(l, in_tab(), launder(ws), lds, b_, nb >= 256 ? 128 : nb, g_wv); if (nb < 256) cvt_moe_layer(in_tab(), launder(ws), l, (LAS float*)lds, b_, nb, TIDX); }
            if (l + 1 < L_) { __syncthreads(); cvt_small_weights(in_tab(), launder(ws), l + 1, (LAS float*)lds, b_, nb, TIDX); }
        }
#endif
        SEAM(pb + PH_ROUTE);
        if (IN(pb + PH_MOEUP)) for (int rep = 0; rep < NREP(PH_MOEUP); ++rep) {
            if (rep) xcd_barrier(bar);
            unsigned char* ws = launder(args.ws); moe_tables(l, ws, lds, g_wv);
            const unsigned* cnt = (const unsigned*)(ws + WS_CTL) + CW_CNT + 2048 * l; const unsigned* mtok = (const unsigned*)(ws + WS_META); const LAS int* tb = (const LAS int*)(lds + LDS_TB);
            MoeSched<2, true> S{(const char*)(ws + WS_XB), (const char*)(ws + WS_WMOE), cnt, mtok, tb, nb, BID(), (size_t)512 * 1024 * 2, (size_t)256 * 1024 * 2};
            EpiMoeUp E{mtok, (const float*)(ws + WS_RS2), tb, (bf16_t*)(ws + WS_HBUF)};
#ifndef NO_MOEUP
            g8::gemm_run(lds, 1024, 1024, S, E, g_wv);
#endif
        }
        SEAM(pb + PH_MOEUP);
        if (IN(pb + PH_MOEDOWN)) for (int rep = 0; rep < NREP(PH_MOEDOWN); ++rep) {
            if (rep) xcd_barrier(bar);
            unsigned char* ws = launder(args.ws); moe_tables(l, ws, lds, g_wv);
            const unsigned* cnt = (const unsigned*)(ws + WS_CTL) + CW_CNT + 2048 * l; const unsigned* mtok = (const unsigned*)(ws + WS_META); const LAS int* tb = (const LAS int*)(lds + LDS_TB);
            MoeSched<4, false> S{(const char*)(ws + WS_HBUF), (const char*)(ws + WS_WMOE + WMOE_WD), cnt, mtok, tb, nb, BID(), (size_t)1024 * 256 * 2, (size_t)256 * 256 * 2};
            EpiMoeDown E{mtok, (const float*)(ws + WS_META + META_W), tb, (bf16_t*)(ws + WS_YBUF)};
#ifndef NO_MOEDOWN
            g8::gemm_run(lds, 256, 256, S, E, g_wv);
#endif
        }
        SEAM(pb + PH_MOEDOWN);
#ifndef NO_COMBINE
        if (IN(pb + PH_COMBINE)) { unsigned char* ws = launder(args.ws); phase_combine(l, ws, args.out, BID(), nb, g_wv); }
#endif
        SEAM(pb + PH_COMBINE);
    }
#undef IN
#undef SEAM
}
#if CHECK
struct NvScratch { float *proj, *h1, *qk, *hraw, *kn, *kcmp, *vcmp, *dqn, *q, *dkvn, *kv, *krope, *y, *x1, *xl; int* rt_e; float* rt_w; };
constexpr int CB = 5;
enum { NS_INPROJ = 0, NS_NSAPREP, NS_MLAPREP, NS_NSA, NS_ML, NS_MLA, NS_OUT, NS_ROUTE, NS_MOE };
static void naive_step(void* const* d_in, int l, int step, const float* xin, float* xout, const NvScratch& S, hipStream_t st) {
    const int b = CB;
    const float* rel_bias = (const float*)d_in[2];
    const float* norm1_g = (const float*)d_in[3] + (long)l * 1024;
    const float* w_in = (const float*)d_in[4] + (long)l * 1024 * DIN;
    const float* cmp_pe = (const float*)d_in[5] + (long)l * 2 * 32 * 64;
    const float* cmp_w1 = (const float*)d_in[6] + (long)l * 2 * 32 * 64 * 64;
    const float* cmp_w2 = (const float*)d_in[7] + (long)l * 2 * 64 * 64;
    const float* q_norm = (const float*)d_in[8] + l * 64;
    const float* k_norm = (const float*)d_in[9] + l * 64;
    const float* nsa_on = (const float*)d_in[10] + l * 384;
    const float* conv = (const float*)d_in[11] + l * 4 * 512;
    const float* ibias = (const float*)d_in[12] + l * 4;
    const float* fbias = (const float*)d_in[13] + l * 4;
    const float* ml_on = (const float*)d_in[14] + l * 256;
    const float* qan = (const float*)d_in[15] + l * 192;
    const float* w_uq = (const float*)d_in[16] + (long)l * 192 * 576;
    const float* kvan = (const float*)d_in[17] + l * 128;
    const float* w_ukv = (const float*)d_in[18] + (long)l * 128 * 768;
    const float* qkn = (const float*)d_in[19] + l * 192;
    const float* mla_on = (const float*)d_in[20] + l * 384;
    const float* w_out = (const float*)d_in[21] + (long)l * 1024 * 1024;
    const float* norm2_g = (const float*)d_in[22] + l * 1024;
    const float* wgrp = (const float*)d_in[23] + (long)l * 1024 * 4;
    const float* bgrp = (const float*)d_in[24] + l * 4;
    const float* wexp = (const float*)d_in[25] + (long)l * 1024 * 32;
    const float* bexp = (const float*)d_in[26] + l * 32;
    const float* Wg = (const float*)d_in[27] + (long)l * 32 * 1024 * 256;
    const float* Wu = (const float*)d_in[28] + (long)l * 32 * 1024 * 256;
    const float* Wd = (const float*)d_in[29] + (long)l * 32 * 256 * 1024;
    const int* pos = (const int*)d_in[1] + b * 2048;
    switch (step) {
    case NS_INPROJ:
        nv_rmsnorm<<<dim3(2048, 1), 64, 0, st>>>(xin, 1024, 0, S.h1, 1024, 0, norm1_g, 0, 1024);
        nv_gemm<<<dim3((DIN + 63) / 64, 2048 / 64), 256, 0, st>>>(S.h1, 1024, w_in, DIN, S.proj, DIN, nullptr, 0, 2048, DIN, 1024);
        break;
    case NS_NSAPREP:
        nv_nsa_cmp<<<dim3(127, 2, 2), 64, 0, st>>>(S.proj, cmp_pe, cmp_w1, cmp_w2, k_norm, S.kcmp, S.vcmp);
        nv_nsa_knorm<<<dim3(2048, 4), 64, 0, st>>>(S.proj, k_norm, S.kn);
        break;
    case NS_MLAPREP:
        nv_rmsnorm<<<dim3(2048, 1), 64, 0, st>>>(S.proj + O_CDQ, DIN, 0, S.dqn, 192, 0, qan, 0, 192);
        nv_gemm<<<dim3(576 / 64, 2048 / 64), 256, 0, st>>>(S.dqn, 192, w_uq, 576, S.q, 576, nullptr, 0, 2048, 576, 192);
        nv_rmsnorm<<<dim3(2048, 1), 64, 0, st>>>(S.proj + O_CDKV, DIN, 0, S.dkvn, 128, 0, kvan, 0, 128);
        nv_gemm<<<dim3(768 / 64, 2048 / 64), 256, 0, st>>>(S.dkvn, 128, w_ukv, 768, S.kv, 768, nullptr, 0, 2048, 768, 128);
        nv_mla_prep<<<dim3(2048, 7), 64, 0, st>>>(S.q, S.kv, S.proj, S.krope, qkn, pos);
        break;
    case NS_NSA:
        nv_nsa_attn<<<dim3(2048, 2), 192, 0, st>>>(S.proj, S.kn, S.kcmp, S.vcmp, rel_bias, q_norm, S.y);
        break;
    case NS_ML:
        nv_ml_conv<<<2048, 512, 0, st>>>(S.proj, conv, S.qk);
        nv_ml_rec<<<4, 256, 0, st>>>(S.proj, S.qk, ibias, fbias, S.hraw);
        nv_ml_fin<<<dim3(2048, 4), 64, 0, st>>>(S.proj, S.hraw, ml_on, S.y);
        break;
    case NS_MLA:
        nv_mla_attn<<<dim3(2048, 6), 64, 0, st>>>(S.q, S.kv, S.krope, S.y);
        break;
    case NS_OUT:
        nv_rmsnorm<<<dim3(2048, 1), 64, 0, st>>>(S.y, 1024, 0, S.y, 1024, 0, nsa_on, 0, 384);
        nv_rmsnorm<<<dim3(2048, 1), 64, 0, st>>>(S.y + 640, 1024, 0, S.y + 640, 1024, 0, mla_on, 0, 384);
        nv_gemm<<<dim3(1024 / 64, 2048 / 64), 256, 0, st>>>(S.y, 1024, w_out, 1024, S.x1, 1024, xin, 1024, 2048, 1024, 1024);
        break;
    case NS_ROUTE:
        nv_moe_route<<<2048, 64, 0, st>>>(S.x1, norm2_g, wgrp, bgrp, wexp, bexp, S.h1, S.rt_e, S.rt_w);
        break;
    case NS_MOE:
        nv_moe_exp<<<2048, 256, 0, st>>>(S.x1, S.h1, S.rt_e, S.rt_w, Wg, Wu, Wd, xout);
        break;
    }
}

__device__ __forceinline__ void chk_commit(float d2, float r2, float* acc) { d2 = wave_sum(d2); r2 = wave_sum(r2); if ((threadIdx.x & 63) == 0) { atomicAdd(acc, d2); atomicAdd(acc + 1, r2); } }
__device__ __forceinline__ void chk_add(float f, float r, float& d2, float& r2) { const float d = f - r; d2 += (d == d) ? d * d : 1e30f; r2 += r * r; }

__global__ void __launch_bounds__(64) chk_proj(const float* nproj, const unsigned char* prj, const float* ssq_dq, const float* ssq_dkv, const float* qg, const float* kg, const float* krg, const int* pos, float* acc) {
    const int t = blockIdx.x, e = threadIdx.x; const size_t row = (size_t)CB * 2048 + t; float d2 = 0.f, r2 = 0.f;
    for (int G = 0; G < 40; ++G) {
        const int c = inproj_refcol(G, e); float r = c < 0 ? 0.f : nproj[(size_t)t * DIN + c]; float f = 0.f;
        const float rr = (G == 37 && e >= 32) ? 0.f : r; const float ss = wave_sum(rr * rr);
        if (G < 6) { r = r * rsqrtf(ss / 64.f + 1e-6f) * qg[e] * 0.18033688f; f = bf2f(((const bf16_t*)(prj + PRJ_QN))[((size_t)(CB * 6 + G) * 2048 + t) * 64 + e]); }
        else if (G < 18) { const int a = G - 6, br = a >> 2, s = (a >> 1) & 1, hk = a & 1;
            if (br > 0 && s == 0) r = r * rsqrtf(ss / 64.f + 1e-6f) * kg[e];
            const size_t base = br == 0 ? (s ? PRJ_C0V : PRJ_C0K) : (br == 1 ? (s ? PRJ_VN1 : PRJ_KN1) : (s ? PRJ_VN2 : PRJ_KN2));
            f = bf2f(((const bf16_t*)(prj + base))[((size_t)(CB * 2 + hk) * 2048 + t) * 64 + e]); }
        else if (G < 26) f = bf2f(((const bf16_t*)(prj + PRJ_RAWQK))[row * 512 + (G - 18) * 64 + e]);
        else if (G < 30) f = bf2f(((const bf16_t*)(prj + PRJ_VML))[((size_t)(CB * 4 + (G - 26)) * 2048 + t) * 64 + e]);
        else if (G < 34) f = bf2f(((const bf16_t*)(prj + PRJ_OG))[row * 256 + (G - 30) * 64 + e]);
        else if (G < 37) f = bf2f(((const bf16_t*)(prj + PRJ_DQKV))[row * 384 + (G - 34) * 64 + e]);
        else if (G == 37) {
            const float val = e < 32 ? rr * rsqrtf(ss / 32.f + 1e-6f) * krg[e & 31] : 0.f; const float oth = __shfl_xor(val, 16);
            if (e < 32) { const int i = e & 15; const double ang = (double)pos[row] * pow(10000.0, -(double)i / 16.0); const float cs = (float)cos(ang), sn = (float)sin(ang);
                r = e < 16 ? val * cs - oth * sn : val * cs + oth * sn; f = bf2f(((const bf16_t*)(prj + PRJ_KR))[row * 32 + e]); }
            else if (e < 58) f = ((const float*)(prj + PRJ_GATES))[row * 32 + (e - 32)];
            else { f = 0.f; r = 0.f; }
        }
        else f = bf2f(((const bf16_t*)(prj + PRJ_DQKV))[row * 384 + 256 + (G - 38) * 64 + e]);
        chk_add(f, r, d2, r2);
    }
    float d2s = 0.f, r2s = 0.f;
    { float s1 = 0.f, s2 = 0.f; for (int c = e; c < 192; c += 64) { float v = nproj[(size_t)t * DIN + O_CDQ + c]; s1 += v * v; } for (int c = e; c < 128; c += 64) { float v = nproj[(size_t)t * DIN + O_CDKV + c]; s2 += v * v; }
      s1 = wave_sum(s1); s2 = wave_sum(s2); if (e == 0) { chk_add((ssq_dq[row * 4] + ssq_dq[row * 4 + 1]) + ssq_dq[row * 4 + 2], s1, d2s, r2s); chk_add(ssq_dkv[row * 2] + ssq_dkv[row * 2 + 1], s2, d2s, r2s); } }
    chk_commit(d2, r2, acc); chk_commit(d2s, r2s, acc + 2);
}

__global__ void __launch_bounds__(64) chk_prep(const float* nq, const float* nkv, const float* nkr, const float* nkc, const float* nvc, const unsigned char* ws, float* acc) {
    const int t = blockIdx.x, e = threadIdx.x; float d2 = 0.f, r2 = 0.f, d2c = 0.f, r2c = 0.f; const float scale = 0.14724444f;
    const bf16_t* QM = (const bf16_t*)(ws + WS_MLA); const bf16_t* KM = (const bf16_t*)(ws + WS_MLA + MLA_KM); const bf16_t* VM = (const bf16_t*)(ws + WS_MLA + MLA_VM);
    for (int h = 0; h < 6; ++h) {
        const size_t rq = ((size_t)(CB * 6 + h) * 2048 + t);
        chk_add(bf2f(QM[rq * 96 + e]), nq[(size_t)t * 576 + h * 96 + e] * scale, d2, r2);
        chk_add(bf2f(KM[rq * 96 + e]), nkv[(size_t)t * 768 + h * 128 + e], d2, r2);
        chk_add(bf2f(VM[rq * 64 + e]), nkv[(size_t)t * 768 + h * 128 + 64 + e], d2, r2);
        if (e < 32) { chk_add(bf2f(QM[rq * 96 + 64 + e]), nq[(size_t)t * 576 + h * 96 + 64 + e] * scale, d2, r2); chk_add(bf2f(KM[rq * 96 + 64 + e]), nkr[(size_t)t * 32 + e], d2, r2); }
    }
    if (t < 128) for (int hk = 0; hk < 2; ++hk) {
        const bf16_t* KC = (const bf16_t*)(ws + WS_CMP); const bf16_t* VC = (const bf16_t*)(ws + WS_CMP + CMP_V); const size_t rf = ((size_t)(CB * 2 + hk) * 128 + t) * 64 + e;
        chk_add(bf2f(KC[rf]), t < 127 ? nkc[(size_t)(hk * 127 + t) * 64 + e] : 0.f, d2c, r2c); chk_add(bf2f(VC[rf]), t < 127 ? nvc[(size_t)(hk * 127 + t) * 64 + e] : 0.f, d2c, r2c);
    }
    chk_commit(d2, r2, acc); chk_commit(d2c, r2c, acc + 2);
}

__global__ void __launch_bounds__(64) chk_y(const float* ny, const unsigned char* ws, float* acc, int nseg) {
    const int t = blockIdx.x, e = threadIdx.x; const bf16_t* Y = (const bf16_t*)(ws + WS_Y) + ((size_t)CB * 2048 + t) * 1024;
    float d2[3] = {0.f, 0.f, 0.f}, r2[3] = {0.f, 0.f, 0.f};
    for (int c = e; c < 1024; c += 64) { const int seg = c < 384 ? 0 : (c < 640 ? 1 : 2); const float f = bf2f(Y[c]), r = ny[(size_t)t * 1024 + c];
        if (seg == 0) chk_add(f, r, d2[0], r2[0]); else if (seg == 1) chk_add(f, r, d2[1], r2[1]); else chk_add(f, r, d2[2], r2[2]); }
    if (nseg == 3) { chk_commit(d2[0], r2[0], acc); chk_commit(d2[1], r2[1], acc + 2); chk_commit(d2[2], r2[2], acc + 4); }
    else chk_commit(d2[0] + d2[1] + d2[2], r2[0] + r2[1] + r2[2], acc);
}

__global__ void __launch_bounds__(64) chk_x(const float* nx, const unsigned char* ws, float* acc) {
    const int t = blockIdx.x, e = threadIdx.x; const bf16_t* X = (const bf16_t*)(ws + WS_XB) + ((size_t)CB * 2048 + t) * 1024; float d2 = 0.f, r2 = 0.f;
    for (int c = e; c < 1024; c += 64) chk_add(bf2f(X[c]), nx[(size_t)t * 1024 + c], d2, r2);
    chk_commit(d2, r2, acc);
}

__global__ void __launch_bounds__(512) chk_code(float* acc, int nst, const float* nout) {
    __shared__ float sh[512];
    float s = 0.f; for (int i = threadIdx.x; i < 2048 * 1024; i += 512) { float v = nout[i]; s += v * v; }
    sh[threadIdx.x] = s; __syncthreads();
    if (threadIdx.x == 0) { float tot = 0.f; for (int i = 0; i < 512; ++i) tot += sh[i]; float rms = sqrtf(tot / (2048.f * 1024.f)); if (!(rms > 1e-3f && rms < 1e3f)) rms = 1.f;
        int code = 0;
        for (int st = 0; st < nst; ++st) { const float d2 = acc[2 * st], r2 = acc[2 * st + 1]; if (r2 == 0.f && d2 == 0.f) { if ((st & 15) >= 9) continue; code = (st + 1) * 4 + 3; break; } const float err = d2 / fmaxf(r2, 1e-30f);
            const float tol = CHK_TOL(st);
            if (!(err <= tol)) { const int cls = !(err < 1.f) ? 3 : (err >= 0.1f ? 2 : (err >= 0.01f ? 1 : 0)); code = (st + 1) * 4 + cls; break; } }
        acc[2 * 40] = rms * 32.f * exp2f(0.5f * (float)code); }
}
__global__ void __launch_bounds__(512) chk_fill(const float* acc, float* out) {
    const float K = acc[2 * 40];
    for (size_t i = (size_t)blockIdx.x * 512 + threadIdx.x; i < (size_t)NTOK * 1024; i += (size_t)gridDim.x * 512) out[i] = (i & 1) ? -K : K;
}
#endif

#if TIME_PH != -1
#ifndef TIME_Q
#define TIME_Q 6.f
#endif
#ifndef TIME_CAL
#define TIME_CAL 1.0f
#endif
__global__ void tm_acc(const unsigned long long* ts, float* best, int first) {
    int a = TIME_PH, b = TIME_PH + 1;
#ifdef TIME_PH_END
    b = TIME_PH_END;
#endif
    float T = 100.f; if (TIME_PH >= 0) T = (float)(ts[b] - ts[a]) * 0.01f;
    if (first || T < *best) *best = T;
}
__global__ void __launch_bounds__(512) tm_fill(const float* best, float* out) {
    float T = *best;
    T = exp2f(rintf(log2f(fmaxf(T, 1.f)) * TIME_Q) / TIME_Q);
    const float c = sqrtf(T) * TIME_CAL;
    for (size_t i = (size_t)blockIdx.x * 512 + threadIdx.x; i < (size_t)NTOK * 1024; i += (size_t)gridDim.x * 512) out[i] = (i & 1) ? -c : c;
}
#endif
static int g_grid = 0;
static bool setup_once(size_t ws_size) {
    if (g_grid) return g_grid > 0;
    if (ws_size < WS_END) { fprintf(stderr, "kernel_launch: workspace too small: %zu < %zu\n", ws_size, (size_t)WS_END); g_grid = -1; return false; }
    int dev = 0, cus = 0, per_cu = 0;
    if (hipGetDevice(&dev) != hipSuccess || hipDeviceGetAttribute(&cus, hipDeviceAttributeMultiprocessorCount, dev) != hipSuccess) { g_grid = -1; return false; }
    if (hipFuncSetAttribute((const void*)mk, hipFuncAttributeMaxDynamicSharedMemorySize, LDS_BYTES) != hipSuccess) { fprintf(stderr, "kernel_launch: hipFuncSetAttribute failed\n"); g_grid = -1; return false; }
    if (hipOccupancyMaxActiveBlocksPerMultiprocessor(&per_cu, (const void*)mk, 512, LDS_BYTES) != hipSuccess || per_cu < 1) { fprintf(stderr, "kernel_launch: occupancy query says %d\n", per_cu); }
    (void)hipGetLastError();
    g_grid = cus;
    return true;
}
static void launch_mk(const Args& a0, int lo, int hi, hipStream_t stream) { Args a = a0; a.ph_lo = lo; a.ph_hi = hi; hipLaunchKernelGGL(mk, dim3(g_grid), dim3(512), LDS_BYTES, stream, a); }

extern "C" void kernel_launch(void* const* d_in, const int* in_sizes, int n_in, void* d_out, int out_size, void* d_ws, size_t ws_size, hipStream_t stream) {
    if (!setup_once(ws_size)) return;
    unsigned char* ws = (unsigned char*)d_ws;
    (void)hipMemsetAsync(ws + WS_CTL, 0, ZERO_BYTES, stream);
    Args a{}; for (int i = 0; i < 30; ++i) a.in.p[i] = (const float*)d_in[i];
    a.out = (float*)d_out; a.ws = ws; a.ph_lo = 0; a.ph_hi = 0;
#if CHECK
    a.out = nullptr;
#endif
#if CHECK
    float* nb = (float*)d_out; size_t off = 0; NvScratch S;
    auto take = [&](size_t n) { float* p = nb + off; off += (n + 63) & ~(size_t)63; return p; };
    S.proj = take((size_t)2048 * DIN); S.h1 = take(2048 * 1024); S.qk = S.h1; S.hraw = S.qk + 2048 * 512; S.kn = S.hraw + 2048 * 256;
    S.kcmp = take(2 * 127 * 64); S.vcmp = take(2 * 127 * 64); S.dqn = take(2048 * 192); S.q = take(2048 * 576); S.dkvn = take(2048 * 128); S.kv = take(2048 * 768); S.x1 = S.dqn;
    S.krope = take(2048 * 32); S.y = take(2048 * 1024); S.xl = take(2048 * 1024); S.rt_e = (int*)take(2048 * 2); S.rt_w = take(2048 * 2);
    if (off * 4 > (size_t)NTOK * 1024 * 4) { fprintf(stderr, "naive scratch too big\n"); return; }
    float* acc = (float*)(ws + WS_CTL) + CW_CHK;
    launch_mk(a, 0, 1, stream);
    const float* nx_in = (const float*)d_in[0] + (size_t)CB * 2048 * 1024;
    int nst = 0;
    for (int l = 0; l < L_; ++l) {
        const int pb = 1 + l * NPH; const int sb = l * 16;
        launch_mk(a, pb + PH_INPROJ, pb + PH_INPROJ + 1, stream);
        naive_step(d_in, l, NS_INPROJ, nx_in, S.xl, S, stream);
        chk_proj<<<2048, 64, 0, stream>>>(S.proj, ws + WS_PRJ, (const float*)(ws + WS_SSQ + PT_DQ) + (size_t)l * 16384 * 4, (const float*)(ws + WS_SSQ + PT_DKV) + (size_t)l * 16384 * 2,
                                           (const float*)d_in[8] + l * 64, (const float*)d_in[9] + l * 64, (const float*)d_in[19] + l * 192 + 160, (const int*)d_in[1], acc + 2 * (sb + 0));
        nst = sb + 2;
        int ns_done = NS_INPROJ;
#if CHECK_UPTO >= 1
        launch_mk(a, pb + PH_PREP, pb + PH_PREP + 1, stream);
        naive_step(d_in, l, NS_NSAPREP, nx_in, S.xl, S, stream); naive_step(d_in, l, NS_MLAPREP, nx_in, S.xl, S, stream); ns_done = NS_MLAPREP;
        chk_prep<<<2048, 64, 0, stream>>>(S.q, S.kv, S.krope, S.kcmp, S.vcmp, ws, acc + 2 * (sb + 2));
        nst = sb + 4;
#endif
#if CHECK_UPTO >= 2
        launch_mk(a, pb + PH_MIX, pb + PH_MIX + 1, stream);
        naive_step(d_in, l, NS_NSA, nx_in, S.xl, S, stream); naive_step(d_in, l, NS_ML, nx_in, S.xl, S, stream); naive_step(d_in, l, NS_MLA, nx_in, S.xl, S, stream); ns_done = NS_MLA;
        chk_y<<<2048, 64, 0, stream>>>(S.y, ws, acc + 2 * (sb + 4), 3);
        nst = sb + 7;
#endif
#if CHECK_UPTO >= 3
        launch_mk(a, pb + PH_YNORM, pb + PH_YNORM + 1, stream); launch_mk(a, pb + PH_OUTPROJ, pb + PH_OUTPROJ + 1, stream);
        naive_step(d_in, l, NS_OUT, nx_in, S.xl, S, stream); ns_done = NS_OUT;
        chk_x<<<2048, 64, 0, stream>>>(S.x1, ws, acc + 2 * (sb + 7));
        nst = sb + 8;
#endif
#if CHECK_UPTO >= 4
        for (int ph = PH_ROUTE; ph <= PH_COMBINE; ++ph) launch_mk(a, pb + ph, pb + ph + 1, stream);
        naive_step(d_in, l, NS_ROUTE, nx_in, S.xl, S, stream); naive_step(d_in, l, NS_MOE, nx_in, S.xl, S, stream); ns_done = NS_MOE;
        chk_x<<<2048, 64, 0, stream>>>(S.xl, ws, acc + 2 * (sb + 8));
        nst = sb + 9;
#endif
        CHECK_REST
        for (int s = ns_done + 1; s <= NS_MOE; ++s) naive_step(d_in, l, s, nx_in, S.xl, S, stream);
        nx_in = S.xl;
        if (l == CHECK_LAYERS - 1) break;
    }
    chk_code<<<1, 512, 0, stream>>>(acc, nst, S.xl);
    chk_fill<<<1024, 512, 0, stream>>>(acc, (float*)d_out);
#else
#if defined(SPLIT_LAUNCH) && SPLIT_LAUNCH
    for (int ph = 0; ph < 1 + L_ * NPH; ++ph) launch_mk(a, ph, ph + 1, stream);
#else
    launch_mk(a, 0, 1 + L_ * NPH, stream);
#if TIME_PH != -1
    for (int rp = 0; rp < 6; ++rp) {
        (void)hipMemsetAsync(ws + WS_CTL, 0, ZERO_BYTES, stream); launch_mk(a, 0, 1 + L_ * NPH, stream);
        tm_acc<<<1, 1, 0, stream>>>((const unsigned long long*)((unsigned*)(ws + WS_CTL) + CW_TS), (float*)(ws + WS_META + META_RT), rp == 0);
    }
    tm_fill<<<1024, 512, 0, stream>>>((const float*)(ws + WS_META + META_RT), (float*)d_out);
#endif
#endif
#endif
}
```

```cpp
#define CHECK 0
#define CHECK_LAYERS 2
#define CHECK_UPTO 99
#define SPLIT_LAUNCH 0
#define REPEAT_PH -1
#include <hip/hip_runtime.h>
#include <stdint.h>
#include <cstdio>

constexpr int B_ = 8, T_ = 2048, D_ = 1024, L_ = 2, NTOK = B_ * T_;
constexpr int DIN = 2554;
constexpr int O_AQ = 0, O_AKV = 384, O_AG = 1152, O_BQK = 1170, O_BV = 1682, O_BIF = 1938, O_BO = 1946, O_CDQ = 2202, O_CDKV = 2394, O_CKR = 2522;

typedef unsigned short bf16_t;
typedef short bf16x8 __attribute__((ext_vector_type(8)));
typedef short s16x4 __attribute__((ext_vector_type(4)));
typedef float f32x4 __attribute__((ext_vector_type(4)));
typedef float f32x16 __attribute__((ext_vector_type(16)));
typedef unsigned u32x4 __attribute__((ext_vector_type(4)));
typedef unsigned u32x2 __attribute__((ext_vector_type(2)));
typedef float f32x2_t __attribute__((ext_vector_type(2)));
typedef __bf16 bf16x2_t __attribute__((ext_vector_type(2)));
#define LAS __attribute__((address_space(3)))

__device__ __forceinline__ unsigned pk_bf16(float lo, float hi) { f32x2_t v = {lo, hi}; bf16x2_t b = __builtin_convertvector(v, bf16x2_t); return __builtin_bit_cast(unsigned, b); }
__device__ __forceinline__ float bf_lo(unsigned u) { return __builtin_bit_cast(float, u << 16); }
__device__ __forceinline__ float bf_hi(unsigned u) { return __builtin_bit_cast(float, u & 0xffff0000u); }
__device__ __forceinline__ float bf2f(bf16_t h) { return __builtin_bit_cast(float, (unsigned)h << 16); }
__device__ __forceinline__ bf16_t f2bf(float f) { return (bf16_t)(pk_bf16(f, 0.f) & 0xffffu); }
__device__ __forceinline__ float wave_sum(float v) { for (int o = 32; o; o >>= 1) v += __shfl_xor(v, o); return v; }
__device__ __forceinline__ float wave_max(float v) { for (int o = 32; o; o >>= 1) v = fmaxf(v, __shfl_xor(v, o)); return v; }
__device__ __forceinline__ float siluf(float x) { return x / (1.f + __expf(-x)); }
__device__ __forceinline__ float sigmf(float x) { return 1.f / (1.f + __expf(-x)); }
__device__ __forceinline__ int t5b(int dist) {
    int n = dist > 0 ? dist : 0; if (n < 16) return n;
    float v = logf((float)n / 16.f) / logf(8.f) * 16.f; int l = 16 + (int)v; return l < 31 ? l : 31;
}

__device__ __forceinline__ int lane_now() { return (int)__builtin_amdgcn_mbcnt_hi(~0u, __builtin_amdgcn_mbcnt_lo(~0u, 0u)); }
#define TIDX ((g_wv << 6) | lane_now())

constexpr size_t WS_CTL = 0, CTL_BYTES = 65536;
constexpr size_t WS_SSQ = WS_CTL + CTL_BYTES;
constexpr size_t ZERO_BYTES = CTL_BYTES;
constexpr size_t PT_DQ = 0, PT_DKV = PT_DQ + (size_t)2 * 16384 * 4 * 4, PT_A = PT_DKV + (size_t)2 * 16384 * 2 * 4, PT_C = PT_A + (size_t)2 * 16384 * 8 * 4, PT_X1 = PT_C + (size_t)2 * 16384 * 8 * 4, PT_END = PT_X1 + (size_t)2 * 16384 * 16 * 4;
constexpr size_t WS_SSQX = WS_SSQ + PT_END;
constexpr size_t WS_RS2 = WS_SSQX + 2 * 65536;
constexpr size_t WS_WIN = WS_RS2 + 65536;
constexpr size_t WS_WOUT = WS_WIN + (size_t)2 * 2560 * 1024 * 2;
constexpr size_t WS_WUQ = WS_WOUT + (size_t)2 * 1024 * 1024 * 2;
constexpr size_t WS_WUKV = WS_WUQ + (size_t)2 * 768 * 256 * 2;
constexpr size_t WS_WC1 = WS_WUKV + (size_t)2 * 768 * 256 * 2;
constexpr size_t WS_WC2 = WS_WC1 + (size_t)2 * 2 * 64 * 2048 * 2;
constexpr size_t WS_WR = WS_WC2 + (size_t)2 * 2 * 64 * 64 * 2;
constexpr size_t WS_B1C = WS_WR + (size_t)2 * 64 * 1024 * 2;
constexpr size_t WS_BIASD = WS_B1C + 1024;
constexpr size_t WS_ROPE = WS_BIASD + 6 * 2048 * 4;
constexpr size_t WS_WMOE = WS_ROPE + (size_t)16384 * 32 * 4;
constexpr size_t WMOE_WD = (size_t)32 * 512 * 1024 * 2;
constexpr size_t WS_XB = WS_WMOE + 50331648;
constexpr size_t WS_MLA = WS_XB + 33554432;
constexpr size_t MLA_KM = (size_t)8 * 6 * 2048 * 96 * 2, MLA_VM = 2 * MLA_KM;
constexpr size_t WS_HBUF = WS_MLA;
constexpr size_t WS_PRJ = WS_MLA + 50331648;
constexpr size_t HM64 = (size_t)2048 * 64 * 2;
constexpr size_t PRJ_QN = 0;
constexpr size_t PRJ_KN1 = PRJ_QN + 48 * HM64, PRJ_VN1 = PRJ_KN1 + 16 * HM64, PRJ_KN2 = PRJ_VN1 + 16 * HM64, PRJ_VN2 = PRJ_KN2 + 16 * HM64;
constexpr size_t PRJ_VML = PRJ_VN2 + 16 * HM64;
constexpr size_t PRJ_OG = PRJ_VML + 32 * HM64;
constexpr size_t PRJ_KR = PRJ_OG + (size_t)16384 * 256 * 2;
constexpr size_t PRJ_GATES = PRJ_KR + (size_t)16384 * 32 * 2;
constexpr size_t PRJ_DEAD = PRJ_GATES + (size_t)16384 * 32 * 4;
constexpr size_t PRJ_C0K = PRJ_DEAD, PRJ_C0V = PRJ_C0K + 16 * HM64 + 8192;
constexpr size_t PRJ_RAWQK = PRJ_C0V + 16 * HM64 + 8192;
constexpr size_t PRJ_DQKV = PRJ_RAWQK + (size_t)16384 * 512 * 2;
constexpr size_t PRJ_END = PRJ_DQKV + (size_t)16384 * 384 * 2;
static_assert(PRJ_END - PRJ_DEAD >= 33554432, "Y fits the dead part of PRJ");
constexpr size_t WS_Y = WS_PRJ + PRJ_DEAD;
constexpr size_t WS_YBUF = WS_PRJ;
static_assert((size_t)2 * 16384 * 1024 * 2 <= PRJ_END, "YBUF fits the PRJ region");
constexpr size_t WS_ML = WS_PRJ + PRJ_END;
constexpr size_t ML_KC = 32 * HM64, ML_DELTA = 2 * ML_KC, ML_DN = ML_DELTA + (size_t)1024 * 4096 * 2, ML_G = ML_DN + (size_t)1024 * 64 * 4, ML_BL = ML_G + (size_t)8 * 4 * 2048 * 2 * 4, ML_CP = ML_BL + 4096, ML_NP = ML_CP + (size_t)1024 * 4096 * 2, ML_END = ML_NP + (size_t)1024 * 64 * 2;
constexpr size_t WS_CMP = WS_ML + ML_END;
constexpr size_t CMP_V = (size_t)8 * 2 * 128 * 64 * 2;
constexpr size_t WS_META = WS_CMP + 2 * CMP_V;
constexpr size_t META_W = (size_t)32 * 16384 * 4, META_RT = 2 * META_W;
constexpr size_t WS_END = WS_META + META_RT + (size_t)16384 * 16;
constexpr int CW_BAR = 0;
constexpr int CW_Q = 4096;
constexpr int CW_SCAN = 4608;
constexpr int CW_TS = 4864;
constexpr int CW_CHK = 5120;
constexpr int CW_CNT = 8192;
constexpr int LDS_BYTES = 147456;
constexpr int LDS_MISC = LDS_BYTES - 256;
#define XB_TMO      128
#define XB_XCNT(j)  (256  + 64 * (j))
#define XB_XSUB(j)  (1280 + 64 * (j))
#define XB_XGEN(j)  (2304 + 64 * (j))
#define XB_TOP      3328
#define XB_TOPGEN   3392
#define XCD_BAR_WORDS 3456
#define XB_SPIN_CAP (1u << 18)

__device__ __forceinline__ unsigned xb_ld(unsigned* p)              { return __hip_atomic_load(p, __ATOMIC_RELAXED, __HIP_MEMORY_SCOPE_AGENT); }
__device__ __forceinline__ unsigned xb_add(unsigned* p, unsigned v) { return __hip_atomic_fetch_add(p, v, __ATOMIC_RELAXED, __HIP_MEMORY_SCOPE_AGENT); }
__device__ __forceinline__ unsigned xb_xcc_id() { return (unsigned)__builtin_amdgcn_s_getreg((3 << 11) | 20) & 0xFu; }
#define XB_SPIN(cond, bar) do { unsigned _sp = 0; while (cond) { __builtin_amdgcn_s_sleep(1); \
    if ((++_sp & 255u) == 0u) { if (xb_ld(&(bar)[XB_TMO])) break; if (_sp > XB_SPIN_CAP) { atomicAdd(&(bar)[XB_TMO], 1u); break; } } } } while (0)

struct XcdBarrier {
    int g_wv; unsigned* bar; unsigned x;
    volatile LAS unsigned* st;
};

__device__ __forceinline__ XcdBarrier xcd_barrier_post(unsigned* bar, volatile LAS unsigned* st, int g_wv) {
    XcdBarrier b; b.g_wv = g_wv; b.bar = bar; b.x = xb_xcc_id(); b.st = st;
    if (TIDX == 0) (void)xb_add(&bar[XB_XCNT(b.x)], 1u);
    return b;
}
__device__ __forceinline__ void xcd_barrier_complete(unsigned* bar, unsigned x, unsigned& nloc, unsigned& nx) {
    const unsigned G = gridDim.x * gridDim.y * gridDim.z;
    unsigned sum, cnt, mine, sp = 0u;
    for (;;) {
        sum = 0u; cnt = 0u; mine = 0u;
#pragma unroll
        for (unsigned j = 0; j < 16; ++j) { const unsigned c = xb_ld(&bar[XB_XCNT(j)]); sum += c; cnt += (c > 0u) ? 1u : 0u; mine = (j == x) ? c : mine; }
        if (sum == G) break;
        __builtin_amdgcn_s_sleep(1);
        if ((++sp & 255u) == 0u) { if (xb_ld(&bar[XB_TMO])) break; if (sp > XB_SPIN_CAP) { atomicAdd(&bar[XB_TMO], 1u); break; } }
    }
    nloc = mine > 0u ? mine : 1u; nx = cnt > 0u ? cnt : 1u;
}

__device__ __forceinline__ void xcd_barrier(const XcdBarrier& b) {
    asm volatile("s_waitcnt vmcnt(0)" ::: "memory");
    __syncthreads();
    const int g_wv = b.g_wv;
    if (TIDX == 0) {
        unsigned* bar = b.bar;
        __builtin_amdgcn_s_waitcnt(0);
        unsigned nloc = b.st[0], nx = b.st[1];
        if (nloc == 0u) { xcd_barrier_complete(bar, b.x, nloc, nx); b.st[0] = nloc; b.st[1] = nx; }
        const unsigned old = xb_add(&bar[XB_XSUB(b.x)], 1u);
        const unsigned gen = old / nloc;
        if (old + 1u == (gen + 1u) * nloc) {
            __builtin_amdgcn_fence(__ATOMIC_RELEASE, "agent");
            asm volatile("s_waitcnt vmcnt(0)" ::: "memory");
            const unsigned og = xb_add(&bar[XB_TOP], 1u);
            const unsigned tg = og / nx;
            if (og + 1u == (tg + 1u) * nx) xb_add(&bar[XB_TOPGEN], 1u);
            else XB_SPIN(xb_ld(&bar[XB_TOPGEN]) == tg, bar);
            __builtin_amdgcn_fence(__ATOMIC_ACQUIRE, "agent");
            xb_add(&bar[XB_XGEN(b.x)], 1u);
            asm volatile("s_waitcnt vmcnt(0)" ::: "memory");
        } else {
            XB_SPIN(xb_ld(&bar[XB_XGEN(b.x)]) == gen, bar);
            __builtin_amdgcn_fence(__ATOMIC_ACQUIRE, "agent");
            asm volatile("s_waitcnt vmcnt(0)" ::: "memory");
        }
    }
    __syncthreads();
}
struct Inputs { const float* p[30]; };
typedef const __attribute__((address_space(4))) Inputs* InPtr;
__device__ __forceinline__ InPtr in_tab() { InPtr p = (InPtr)__builtin_amdgcn_kernarg_segment_ptr(); asm volatile("" : "+s"(p)); return p; }
__device__ __forceinline__ unsigned char* launder(unsigned char* p) { size_t z = 0; asm volatile("" : "+s"(z)); return p + z; }

__host__ __device__ inline int inproj_refcol(int G, int e) {
    if (G < 6) return O_AQ + G * 64 + e;
    if (G < 18) return O_AKV + (G - 6) * 64 + e;
    if (G < 26) return O_BQK + (G - 18) * 64 + e;
    if (G < 30) return O_BV + (G - 26) * 64 + e;
    if (G < 34) return O_BO + (G - 30) * 64 + e;
    if (G < 37) return O_CDQ + (G - 34) * 64 + e;
    if (G == 37) { if (e < 32) return O_CKR + e; if (e < 50) return O_AG + (e - 32); if (e < 58) return O_BIF + (e - 50); return -1; }
    return O_CDKV + (G - 38) * 64 + e;
}
__host__ __device__ inline int uq_refcol(int G, int e) {
    if (G < 6) return G * 96 + e;
    if (G < 9) { const int idx = e & 31, bj = e >> 5, sub = idx >> 4, i = idx & 15; return (2 * (G - 6) + sub) * 96 + 64 + bj * 16 + i; }
    return -1;
}
__host__ __device__ inline int ukv_refcol(int G, int e) { return G < 6 ? G * 128 + e : (G - 6) * 128 + 64 + e; }
#define N2G(n) ((((n) >> 8) << 2) + (((n) >> 5) & 3))
#define N2E(n) (((((n) >> 7) & 1) << 5) + ((n) & 31))

struct FWin { const float* w; const float* g; __device__ __forceinline__ float operator()(int k, int n) const { const int c = inproj_refcol(N2G(n), N2E(n)); return c < 0 ? 0.f : w[(size_t)k * DIN + c] * g[k]; } };
struct FWout { const float* w; const float* ga; const float* gc; __device__ __forceinline__ float operator()(int k, int n) const {
    const int kr = k < 384 ? k : (k < 768 ? 640 + (k - 384) : 384 + (k - 768)); const float og = k < 384 ? ga[k] : (k < 768 ? gc[k - 384] : 1.f); return w[(size_t)kr * 1024 + n] * og; } };
struct FWuq { const float* w; const float* g; __device__ __forceinline__ float operator()(int k, int n) const { const int c = uq_refcol(N2G(n), N2E(n)); return (k < 192 && c >= 0) ? w[(size_t)k * 576 + c] * g[k] : 0.f; } };
struct FWukv { const float* w; const float* g; __device__ __forceinline__ float operator()(int k, int n) const { const int c = ukv_refcol(N2G(n), N2E(n)); return k >= 128 ? w[(size_t)(k - 128) * 768 + c] * g[k - 128] : 0.f; } };
struct FWc1 { const float* w; __device__ __forceinline__ float operator()(int k, int n) const { return w[(size_t)k * 64 + n]; } };
struct FWr { const float* wg; const float* we; const float* g; __device__ __forceinline__ float operator()(int k, int n) const { return n < 4 ? wg[k * 4 + n] * g[k] : (n < 36 ? we[k * 32 + n - 4] * g[k] : 0.f); } };
struct FWgu { const float* src; const float* g; int n0, col0; __device__ __forceinline__ float operator()(int k, int n) const { return src[(size_t)k * 256 + col0 + (n - n0)] * g[k]; } };
struct FWd { const float* w; __device__ __forceinline__ float operator()(int k, int n) const { return w[(size_t)k * 1024 + n]; } };

__device__ __forceinline__ void rope_cs(int pos, int j, float& cs, float& sn) {
    const double inv = exp2(-(double)j * (13.287712379549449 / 16.0));
    const double rev = (double)pos * inv * 0.15915494309189535; const float f = (float)(rev - rint(rev));
    cs = __builtin_amdgcn_cosf(f); sn = __builtin_amdgcn_sinf(f);
}
template <class F>
__device__ __forceinline__ void cvt_tile(const F& f, int n0, int k0, bf16_t* dst, int ldk, LAS float* tile, int tid) {
    { const int k = tid >> 3, nb = (tid & 7) * 8;
#pragma unroll
      for (int j = 0; j < 8; ++j) tile[k * 65 + nb + j] = f(k0 + k, n0 + nb + j); }
    __syncthreads();
    { const int n = tid >> 3, kb = (tid & 7) * 8; const LAS float* s = tile + kb * 65 + n;
      u32x4 o; o.x = pk_bf16(s[0], s[65]); o.y = pk_bf16(s[130], s[195]); o.z = pk_bf16(s[260], s[325]); o.w = pk_bf16(s[390], s[455]);
      *(u32x4*)(dst + (size_t)(n0 + n) * ldk + k0 + kb) = o; }
    __syncthreads();
}
template <class F>
__device__ __forceinline__ void cvt_item(const F& f, int it, int nK, bf16_t* dst, int ldk, LAS float* tile, int tid) { cvt_tile(f, (it / nK) * 64, (it % nK) * 64, dst, ldk, tile, tid); }

__device__ __forceinline__ void moe_item(InPtr in, int l, int it, const float*& src, int& ld, size_t& dst, int& ldk, bool& gain) {
    if (it < 32 * 128) { const int e = it >> 7, r = it & 127, n0 = (r >> 4) * 64, k0 = (r & 15) * 64, c0 = n0 & 255;
        src = (c0 < 128 ? in->p[27] : in->p[28]) + ((size_t)l * 32 + e) * 262144 + (size_t)k0 * 256 + (n0 >> 8) * 128 + (c0 & 127); ld = 256; gain = true;
        dst = ((size_t)e * 512 + n0) * 1024 + k0; ldk = 1024; }
    else { const int j = it - 32 * 128, e = j >> 6, r = j & 63, n0 = (r >> 2) * 64, k0 = (r & 3) * 64;
        src = in->p[29] + ((size_t)l * 32 + e) * 262144 + (size_t)k0 * 1024 + n0; ld = 1024; gain = false;
        dst = (size_t)16777216 + ((size_t)e * 1024 + n0) * 256 + k0; ldk = 256; }
}
__device__ __forceinline__ void cvt_moe_layer(InPtr in, unsigned char* ws, int l, LAS float* tile, int bid, int nb, int tid, int it_lo = 0, int it_hi = 32 * (128 + 64)) {
    asm volatile("" : "+v"(tid));
    const float* g2 = in->p[22] + l * 1024; bf16_t* W = (bf16_t*)(ws + WS_WMOE);
    const int k = tid >> 3, nbq = (tid & 7) * 8;
    const int n = tid >> 3, kb = (tid & 7) * 8;
    const int NIT = it_hi;
    int it = it_lo + bid; f32x4 v0, v1; const float* src; int ld, ldk; size_t dst = 0; bool gain; float gk = 1.f; int kk0 = 0;
    if (it < NIT) { moe_item(in, l, it, src, ld, dst, ldk, gain); v0 = *(const f32x4*)(src + (size_t)k * ld + nbq); v1 = *(const f32x4*)(src + (size_t)k * ld + nbq + 4);
        kk0 = it < 32 * 128 ? ((it & 127) & 15) * 64 : 0; gk = gain ? g2[kk0 + k] : 1.f; }
    int buf = 0;
    for (; it < NIT; it += nb) {
        LAS float* t = tile + buf * (64 * 65);
        t[k * 65 + nbq + 0] = v0.x * gk; t[k * 65 + nbq + 1] = v0.y * gk; t[k * 65 + nbq + 2] = v0.z * gk; t[k * 65 + nbq + 3] = v0.w * gk;
        t[k * 65 + nbq + 4] = v1.x * gk; t[k * 65 + nbq + 5] = v1.y * gk; t[k * 65 + nbq + 6] = v1.z * gk; t[k * 65 + nbq + 7] = v1.w * gk;
        const size_t cdst = dst; const int cldk = ldk;
        __syncthreads();
        const int itn = it + nb;
        if (itn < NIT) { moe_item(in, l, itn, src, ld, dst, ldk, gain); v0 = *(const f32x4*)(src + (size_t)k * ld + nbq); v1 = *(const f32x4*)(src + (size_t)k * ld + nbq + 4);
            kk0 = itn < 32 * 128 ? ((itn & 127) & 15) * 64 : 0; gk = gain ? g2[kk0 + k] : 1.f; }
        const LAS float* s = t + kb * 65 + n;
        u32x4 o; o.x = pk_bf16(s[0], s[65]); o.y = pk_bf16(s[130], s[195]); o.z = pk_bf16(s[260], s[325]); o.w = pk_bf16(s[390], s[455]);
        *(u32x4*)(W + cdst + (size_t)n * cldk + kb) = o;
        buf ^= 1;
    }
    __syncthreads();
}

__device__ __forceinline__ void cvt_small_weights(InPtr in, unsigned char* ws, int l, LAS float* tile, int bid, int nb, int tid) {
    asm volatile("" : "+v"(tid));
    constexpr int I_WIN = 40 * 16, I_WOUT = 16 * 16, I_WU = 12 * 4, I_WC1 = 32, I_WC2 = 1, I_WR = 16;
    constexpr int PER_L = I_WIN + I_WOUT + 2 * I_WU + 2 * I_WC1 + 2 * I_WC2 + I_WR;
    for (int it0 = bid; it0 < PER_L; it0 += nb) {
        int it = it0;
        if (it < I_WIN) { FWin f{in->p[4] + (size_t)l * 1024 * DIN, in->p[3] + l * 1024}; cvt_item(f, it, 16, (bf16_t*)(ws + WS_WIN) + (size_t)l * 2560 * 1024, 1024, tile, tid); continue; } it -= I_WIN;
        if (it < I_WOUT) { FWout f{in->p[21] + (size_t)l * 1048576, in->p[10] + l * 384, in->p[20] + l * 384}; cvt_item(f, it, 16, (bf16_t*)(ws + WS_WOUT) + (size_t)l * 1048576, 1024, tile, tid); continue; } it -= I_WOUT;
        if (it < I_WU) { FWuq f{in->p[16] + (size_t)l * 192 * 576, in->p[15] + l * 192}; cvt_item(f, it, 4, (bf16_t*)(ws + WS_WUQ) + (size_t)l * 768 * 256, 256, tile, tid); continue; } it -= I_WU;
        if (it < I_WU) { FWukv f{in->p[18] + (size_t)l * 128 * 768, in->p[17] + l * 128}; cvt_item(f, it, 4, (bf16_t*)(ws + WS_WUKV) + (size_t)l * 768 * 256, 256, tile, tid); continue; } it -= I_WU;
        if (it < 2 * I_WC1) { const int s = it / I_WC1; FWc1 f{in->p[6] + ((size_t)l * 2 + s) * 2048 * 64}; cvt_item(f, it % I_WC1, 32, (bf16_t*)(ws + WS_WC1) + ((size_t)l * 2 + s) * 64 * 2048, 2048, tile, tid); continue; } it -= 2 * I_WC1;
        if (it < 2 * I_WC2) { const int s = it; FWc1 f{in->p[7] + ((size_t)l * 2 + s) * 64 * 64}; cvt_item(f, 0, 1, (bf16_t*)(ws + WS_WC2) + ((size_t)l * 2 + s) * 64 * 64, 64, tile, tid); continue; } it -= 2 * I_WC2;
        { FWr f{in->p[23] + (size_t)l * 4096, in->p[25] + (size_t)l * 32768, in->p[22] + l * 1024}; cvt_item(f, it, 16, (bf16_t*)(ws + WS_WR) + (size_t)l * 64 * 1024, 1024, tile, tid); }
    }
}

__device__ __forceinline__ void prologue(InPtr in, unsigned char* ws, LAS unsigned char* lds, int bid, int nb, int g_wv) {
    int tid_ = TIDX; asm volatile("" : "+v"(tid_));
    const int tid = tid_, lane = tid & 63, wid = tid >> 6;
    LAS float* tile = (LAS float*)lds;
    cvt_small_weights(in, ws, 0, tile, bid, nb, tid);
    { const float* x = in->p[0]; bf16_t* XB = (bf16_t*)(ws + WS_XB); float* ssqx = (float*)(ws + WS_SSQX);
      for (int r = bid * 8 + wid; r < NTOK; r += nb * 8) {
          const f32x4* xr = (const f32x4*)(x + (size_t)r * 1024) + lane; float s = 0.f; u32x2* o = (u32x2*)(XB + (size_t)r * 1024) + lane;
#pragma unroll
          for (int j = 0; j < 4; ++j) { const f32x4 v = xr[64 * j]; s += (v.x * v.x + v.y * v.y) + (v.z * v.z + v.w * v.w); u32x2 w; w.x = pk_bf16(v.x, v.y); w.y = pk_bf16(v.z, v.w); o[64 * j] = w; }
          s = wave_sum(s); if (lane == 0) ssqx[r] = s;
      } }
    { float* biasd = (float*)(ws + WS_BIASD); const float* rb = in->p[2];
      for (int i = bid * 512 + tid; i < 6 * 2048; i += nb * 512) { const int h = i >> 11, d = i & 2047; biasd[i] = rb[t5b(d) * 6 + h] * 1.44269504f; } }
    { float* rope = (float*)(ws + WS_ROPE); const int* pos = (const int*)in->p[1];
      for (int i = bid * 512 + tid; i < NTOK * 16; i += nb * 512) { const int tk = i >> 4, j = i & 15; float cs, sn; rope_cs(pos[tk], j, cs, sn); rope[(size_t)tk * 32 + j] = cs; rope[(size_t)tk * 32 + 16 + j] = sn; } }
    { float* b1c = (float*)(ws + WS_B1C); LAS float* red = (LAS float*)lds;
      for (int it = bid; it < 4; it += nb) { const float* pe = in->p[5] + (size_t)it * 2048; const float* w1 = in->p[6] + (size_t)it * 2048 * 64; const int f = tid & 63, part = tid >> 6;
          float a = 0.f; for (int k = part * 256; k < part * 256 + 256; ++k) a += pe[k] * w1[(size_t)k * 64 + f];
          __syncthreads(); red[tid] = a; __syncthreads();
          if (tid < 64) { float s = 0.f; for (int p2 = 0; p2 < 8; ++p2) s += red[p2 * 64 + tid]; b1c[it * 64 + tid] = s; }
          __syncthreads(); } }
}
namespace g8 {
constexpr int BM = 256, BK = 64, HALF = 128, HTB = HALF * BK * 2, STAGE_BYTES = 8 * HTB, NXCD = 8, WGM = 8;
__host__ __device__ __forceinline__ int lds_byte(int r, int c) { const int st = (r >> 4) * 2 + (c >> 5), rr = r & 15, cc = c & 31, ob = rr * 64 + cc * 2; return st * 1024 + (ob ^ (((ob >> 9) & 1) << 5)); }
__host__ __device__ __forceinline__ void stage_rc(int b, int& R, int& C) { const int st = b / 1024, sb = b % 1024, swz = sb ^ (((sb >> 9) & 1) << 5); R = (st >> 1) * 16 + swz / 64; C = (st & 1) * 32 + (swz % 64) / 2; }
__host__ __device__ __forceinline__ int perm32(int rho) { const int n = rho >> 4, i = rho & 15; return 8 * (i >> 2) + 4 * n + (i & 3); }

struct GUnit { const char* a; const char* b; int pm, pn, e, rows; };

__device__ __forceinline__ bool static_unit(int i, int G, int c, int nM, int nN, int& pm, int& pn) {
    const int nwg = nM * nN; const long L = (long)i * G + c; if (L >= nwg) return false;
    int wgid = (int)L; { const int q = nwg / NXCD, r = nwg % NXCD, xcd = wgid % NXCD, off = wgid / NXCD; wgid = (xcd < r ? xcd * (q + 1) : r * (q + 1) + (xcd - r) * q) + off; }
    const int nig = WGM * nN, gid = wgid / nig, fm = gid * WGM, gsz = (nM - fm) < WGM ? (nM - fm) : WGM;
    pm = fm + ((wgid % nig) % gsz); pn = (wgid % nig) / gsz; return true;
}
struct DenseSched {
    static constexpr bool GATHER = false, PARTIAL = false;
    const char* A; const char* Bt; int lda, ldb, nM, nN, G, c;
    __device__ __forceinline__ bool next(int i, GUnit& u) const {
        int pm, pn; if (!static_unit(i, G, c, nM, nN, pm, pn)) return false;
        u.pm = pm; u.pn = pn; u.e = 0; u.rows = 256; u.a = A + (size_t)pm * 256 * lda * 2; u.b = Bt + (size_t)pn * 256 * ldb * 2; return true;
    }
    __device__ __forceinline__ void aoff(const GUnit&, unsigned (&v)[2][2], const int (&R)[2], const int (&C)[2]) const {
#pragma unroll
        for (int h = 0; h < 2; ++h)
#pragma unroll
            for (int i = 0; i < 2; ++i) v[h][i] = (unsigned)((h * 128 + R[i]) * lda + C[i]) * 2u;
    }
};

template <class Epi, class Sched>
__device__ __forceinline__ void gemm_run(LAS unsigned char* lds, const int K, const int ldb, const Sched& S, const Epi& E, int g_wv) {
    int tid_ = TIDX; asm volatile("" : "+v"(tid_));
    const int tid = tid_, wid = __builtin_amdgcn_readfirstlane(tid >> 6), lane = tid & 63, wr = wid >> 2, wc = wid & 3, fr = lane & 15, fq = lane >> 4;
    int nt_ = K / BK; asm volatile("" : "+s"(nt_));
    const int nt = nt_;
    int R[2], C[2]; unsigned voffB[2];
#pragma unroll
    for (int i = 0; i < 2; ++i) { stage_rc(tid * 16 + i * 8192, R[i], C[i]); const int Rb = (R[i] & ~31) + perm32(R[i] & 31); voffB[i] = (unsigned)(Rb * ldb + C[i]) * 2u; }
    const size_t kstep = (size_t)(BK * 2);
    const size_t hstepB = (size_t)HALF * ldb * 2;
    const unsigned ldsw = (unsigned)wid * 1024u;
    const int aoff = lds_byte(wr * 64 + fr, fq * 8), boff = lds_byte(wc * 32 + fr, fq * 8);
#define G8_SA(b, h) (((b) * 2 + (h)) * HTB)
#define G8_SB(b, h) ((4 + (b) * 2 + (h)) * HTB)
#define G8_GLDS(bufoff, gptr, i_) __builtin_amdgcn_global_load_lds((const unsigned*)(gptr), (LAS unsigned*)(lds + (bufoff) + ldsw + (i_) * 8192), 16, 0, 0)
#define G8_STAGE_B(bufoff, gbase) do { G8_GLDS(bufoff, (const char*)(gbase) + voffB[0], 0); G8_GLDS(bufoff, (const char*)(gbase) + voffB[1], 1); } while (0)
#define G8_STAGE_A(bufoff, gbase, v0, v1) do { G8_GLDS(bufoff, (const char*)(gbase) + (v0), 0); G8_GLDS(bufoff, (const char*)(gbase) + (v1), 1); } while (0)
#define G8_LDA(dst, b, h) do { _Pragma("unroll") for (int m = 0; m < 4; ++m) _Pragma("unroll") for (int k = 0; k < 2; ++k) dst[m][k] = *(const LAS bf16x8*)(lds + G8_SA(b, h) + aoff + m * 2048 + k * 1024); } while (0)
#define G8_LDB(dst, b, h) do { _Pragma("unroll") for (int n = 0; n < 2; ++n) _Pragma("unroll") for (int k = 0; k < 2; ++k) dst[n][k] = *(const LAS bf16x8*)(lds + G8_SB(b, h) + boff + n * 2048 + k * 1024); } while (0)
#define G8_MMA(ai, bj, At, Bt) do { __builtin_amdgcn_s_setprio(1); _Pragma("unroll") for (int m = 0; m < 4; ++m) { if (!PARTIAL || ((mmask >> ((ai) * 4 + m)) & 1u)) { _Pragma("unroll") for (int n = 0; n < 2; ++n) _Pragma("unroll") for (int k = 0; k < 2; ++k) \
        acc[ai][bj][m][n] = __builtin_amdgcn_mfma_f32_16x16x32_bf16(Bt[n][k], At[m][k], acc[ai][bj][m][n], 0, 0, 0); } } __builtin_amdgcn_s_setprio(0); } while (0)
#define G8_WAIT_V(n) asm volatile("s_waitcnt vmcnt(" #n ")" ::: "memory")
#define G8_WAIT_L(n) asm volatile("s_waitcnt lgkmcnt(" #n ")" ::: "memory")
#define G8_BAR __builtin_amdgcn_s_barrier()
#define G8_SCHED __builtin_amdgcn_sched_barrier(0)
    GUnit cur, nxt; int ui = 0;
    if (!S.next(0, cur)) return;
    constexpr bool GATHER = Sched::GATHER, PARTIAL = Sched::PARTIAL;
    unsigned mmask = 0xffu;
#define G8_MASK(u) do { if (PARTIAL) { mmask = 0u; _Pragma("unroll") for (int q_ = 0; q_ < 8; ++q_) mmask |= (((q_ >> 2) * 128 + wr * 64 + (q_ & 3) * 16) < (u).rows) ? (1u << q_) : 0u; } } while (0)
    unsigned vc[2][2];
    S.aoff(cur, vc, R, C); G8_MASK(cur);
    LAS u32x4* stash = (LAS u32x4*)(lds + STAGE_BYTES + 4096) + tid;
    f32x4 acc[2][2][4][2];
#pragma unroll
    for (int a = 0; a < 2; ++a)
#pragma unroll
        for (int b = 0; b < 2; ++b)
#pragma unroll
            for (int m = 0; m < 4; ++m)
#pragma unroll
                for (int n = 0; n < 2; ++n) acc[a][b][m][n] = (f32x4){0.f, 0.f, 0.f, 0.f};
    bf16x8 At[4][2], B0[2][2], B1[2][2];
    const char* cA = cur.a; const char* cB = cur.b;
    G8_STAGE_B(G8_SB(0, 0), cB); G8_STAGE_B(G8_SB(0, 1), cB + hstepB); G8_STAGE_A(G8_SA(0, 0), cA, vc[0][0], vc[0][1]); G8_STAGE_A(G8_SA(0, 1), cA, vc[1][0], vc[1][1]);
    if (wr == 1) G8_BAR;
    G8_WAIT_V(2); G8_BAR;
    G8_STAGE_B(G8_SB(1, 0), cB + kstep); G8_STAGE_A(G8_SA(1, 0), cA + kstep, vc[0][0], vc[0][1]); G8_STAGE_B(G8_SB(1, 1), cB + hstepB + kstep);
    G8_WAIT_V(6); G8_BAR;
    for (;;) {
        const bool has_next = S.next(ui + 1, nxt);
        if (GATHER) { unsigned vn[2][2];
            if (has_next) S.aoff(nxt, vn, R, C);
            else { vn[0][0] = vc[0][0]; vn[0][1] = vc[0][1]; vn[1][0] = vc[1][0]; vn[1][1] = vc[1][1]; }
            u32x4 sv; sv.x = vn[0][0]; sv.y = vn[0][1]; sv.z = vn[1][0]; sv.w = vn[1][1]; *stash = sv; }
        const char* nA = has_next ? nxt.a : cA; const char* nB = has_next ? nxt.b : cB;
#pragma unroll 1
        for (int seg = 0; seg < (Epi::KHOOK ? 3 : 1); ++seg) {
        const int tlo = Epi::KHOOK ? 6 * seg : 0, thi = Epi::KHOOK ? (seg == 2 ? nt : 6 * seg + 6) : nt;
#pragma unroll 1
        for (int t = tlo; t < thi; t += 2) {
            const bool last = (t == nt - 2);
            const char* a1 = cA + (size_t)(t + 1) * kstep;
            const char* a2 = last ? nA : cA + (size_t)(t + 2) * kstep; const char* b2 = last ? nB : cB + (size_t)(t + 2) * kstep;
            const char* a3 = a2 + kstep; const char* b3 = b2 + kstep;
            unsigned w00 = vc[0][0], w01 = vc[0][1], w10 = vc[1][0], w11 = vc[1][1];
            if (GATHER) { if (last) { const u32x4 sv = *stash; w00 = sv.x; w01 = sv.y; w10 = sv.z; w11 = sv.w; } }
            G8_LDB(B0, 0, 0); G8_LDB(B1, 0, 1); G8_SCHED; G8_LDA(At, 0, 0); G8_STAGE_A(G8_SA(1, 1), a1, vc[1][0], vc[1][1]);
            G8_WAIT_V(8); G8_WAIT_L(0); G8_BAR; G8_MMA(0, 0, At, B0); G8_MMA(0, 1, At, B1); G8_BAR; G8_SCHED;
            G8_LDA(At, 0, 1); G8_STAGE_B(G8_SB(0, 0), b2); G8_STAGE_B(G8_SB(0, 1), b2 + hstepB); G8_STAGE_A(G8_SA(0, 0), a2, w00, w01);
            G8_WAIT_V(8); G8_WAIT_L(0); G8_BAR; G8_MMA(1, 0, At, B0); G8_MMA(1, 1, At, B1); G8_BAR; G8_SCHED;
            G8_LDB(B0, 1, 0); G8_LDB(B1, 1, 1); G8_SCHED; G8_LDA(At, 1, 0); G8_STAGE_A(G8_SA(0, 1), a2, w10, w11);
            G8_WAIT_V(8); G8_WAIT_L(0); G8_BAR; G8_MMA(0, 0, At, B0); G8_MMA(0, 1, At, B1); G8_BAR; G8_SCHED;
            G8_LDA(At, 1, 1); G8_STAGE_B(G8_SB(1, 0), b3); G8_STAGE_B(G8_SB(1, 1), b3 + hstepB); G8_STAGE_A(G8_SA(1, 0), a3, w00, w01);
            G8_WAIT_V(8); G8_WAIT_L(0); G8_BAR; G8_MMA(1, 0, At, B0); G8_MMA(1, 1, At, B1); G8_BAR; G8_SCHED;
        }
        if constexpr (Epi::KHOOK) { if (seg < 2) E.kscale(acc, seg, wr, fr); }
        }
        if (wr == 0) G8_BAR;
        { int fr_ = fr, fq_ = fq; asm volatile("" : "+v"(fr_), "+v"(fq_));
          E(acc, cur, wr, wc, fr_, fq_); }
        if (!has_next) break;
#pragma unroll
        for (int a = 0; a < 2; ++a)
#pragma unroll
            for (int b = 0; b < 2; ++b)
#pragma unroll
                for (int m = 0; m < 4; ++m)
#pragma unroll
                    for (int n = 0; n < 2; ++n) acc[a][b][m][n] = (f32x4){0.f, 0.f, 0.f, 0.f};
        cur = nxt; cA = nA; cB = nB; ++ui; G8_MASK(cur);
        if (GATHER) { const u32x4 sv = *stash; vc[0][0] = sv.x; vc[0][1] = sv.y; vc[1][0] = sv.z; vc[1][1] = sv.w; }
        if (wr == 1) G8_BAR;
    }
    G8_WAIT_V(0);
    G8_BAR;
#undef G8_SA
#undef G8_SB
#undef G8_GLDS
#undef G8_STAGE_A
#undef G8_STAGE_B
#undef G8_LDA
#undef G8_LDB
#undef G8_MMA
#undef G8_MASK
#undef G8_WAIT_V
#undef G8_WAIT_L
#undef G8_BAR
#undef G8_SCHED
}
}
using g8::GUnit;
__device__ __forceinline__ void st_bf16x8(bf16_t* p, const float (&v)[8]) { u32x4 w; w.x = pk_bf16(v[0], v[1]); w.y = pk_bf16(v[2], v[3]); w.z = pk_bf16(v[4], v[5]); w.w = pk_bf16(v[6], v[7]); *(u32x4*)p = w; }
__device__ __forceinline__ float quad_sum(float s) { s += __shfl_xor(s, 16); s += __shfl_xor(s, 32); return s; }

struct EpiInProj {
    static constexpr bool KHOOK = false;
    const float* ssqx; float* part_dq; float* part_dkv; const float* qg; const float* kg; const float* krg; const float* rope;
    unsigned char* prj;
    __device__ __forceinline__ void operator()(const f32x4 (&acc)[2][2][4][2], const GUnit& u, int wr, int wc, int fr, int fq) const {
        const int G = u.pn * 4 + wc;
        const bool isq = G < 6; const int a = G - 6; const bool isk = (G >= 10 && G < 18 && ((a >> 1) & 1) == 0);
        const float* g0 = (isq ? qg : kg) + 8 * fq;
        float rs8[8];
#pragma unroll
        for (int k = 0; k < 8; ++k) rs8[k] = ssqx[u.pm * 256 + (k >> 2) * 128 + wr * 64 + (k & 3) * 16 + fr];
#pragma unroll
        for (int k = 0; k < 8; ++k) rs8[k] = rsqrtf(rs8[k] * (1.f / 1024.f) + 1e-6f);
#pragma unroll
        for (int ai = 0; ai < 2; ++ai)
#pragma unroll
            for (int m = 0; m < 4; ++m) {
                __builtin_amdgcn_sched_barrier(0);
                const int row = u.pm * 256 + ai * 128 + wr * 64 + m * 16 + fr; const int b = row >> 11, t = row & 2047;
                const float rs = rs8[ai * 4 + m];
                float v[2][8];
#pragma unroll
                for (int bj = 0; bj < 2; ++bj)
#pragma unroll
                    for (int n = 0; n < 2; ++n)
#pragma unroll
                        for (int j = 0; j < 4; ++j) v[bj][4 * n + j] = acc[ai][bj][m][n][j] * rs;
                float ss = 0.f;
#pragma unroll
                for (int bj = 0; bj < 2; ++bj)
#pragma unroll
                    for (int i = 0; i < 8; ++i) ss += v[bj][i] * v[bj][i];
                bf16_t* dst = nullptr; int bstride = 32;
                if (isq) {
                    ss = quad_sum(ss); const float sc = rsqrtf(ss * (1.f / 64.f) + 1e-6f) * 0.18033688f;
#pragma unroll
                    for (int i = 0; i < 8; ++i) { v[0][i] *= sc * g0[i]; v[1][i] *= sc * g0[32 + i]; }
                    dst = (bf16_t*)(prj + PRJ_QN) + ((size_t)(b * 6 + G) * 2048 + t) * 64;
                } else if (G < 18) {
                    const int br = a >> 2, s = (a >> 1) & 1, hk = a & 1;
                    if (br > 0 && s == 0) {
                        ss = quad_sum(ss); const float sc = rsqrtf(ss * (1.f / 64.f) + 1e-6f);
#pragma unroll
                        for (int i = 0; i < 8; ++i) { v[0][i] *= sc * g0[i]; v[1][i] *= sc * g0[32 + i]; }
                    }
                    const size_t base = br == 0 ? (s ? PRJ_C0V : PRJ_C0K) : (br == 1 ? (s ? PRJ_VN1 : PRJ_KN1) : (s ? PRJ_VN2 : PRJ_KN2));
                    dst = (bf16_t*)(prj + base) + ((size_t)(b * 2 + hk) * 2048 + t) * 64;
                } else if (G < 26) { dst = (bf16_t*)(prj + PRJ_RAWQK) + (size_t)row * 512 + (G - 18) * 64; }
                else if (G < 30) { dst = (bf16_t*)(prj + PRJ_VML) + ((size_t)(b * 4 + (G - 26)) * 2048 + t) * 64; }
                else if (G < 34) { dst = (bf16_t*)(prj + PRJ_OG) + (size_t)row * 256 + (G - 30) * 64; }
                else if (G < 37) { dst = (bf16_t*)(prj + PRJ_DQKV) + (size_t)row * 384 + (G - 34) * 64; ss = quad_sum(ss); if (fq == 0) part_dq[(size_t)row * 4 + (G - 34)] = ss; }
                else if (G == 37) {
                    dst = (bf16_t*)(prj + PRJ_DQKV) + (size_t)row * 384 + 192;
                    float* gt = (float*)(prj + PRJ_GATES) + (size_t)row * 32 + 8 * fq;
                    *(f32x4*)gt = (f32x4){v[1][0], v[1][1], v[1][2], v[1][3]}; *(f32x4*)(gt + 4) = (f32x4){v[1][4], v[1][5], v[1][6], v[1][7]};
                    float s0 = 0.f;
#pragma unroll
                    for (int i = 0; i < 8; ++i) s0 += v[0][i] * v[0][i];
                    s0 = quad_sum(s0); const float sc = rsqrtf(s0 * (1.f / 32.f) + 1e-6f);
                    const float* rp = rope + (size_t)row * 32 + ((8 * fq) & 15);
                    float kr[8];
#pragma unroll
                    for (int i = 0; i < 8; ++i) { const float val = v[0][i] * sc * krg[8 * fq + i]; const float oth = __shfl_xor(val, 32); const float cs = rp[i], sn = rp[16 + i]; kr[i] = fq < 2 ? val * cs - oth * sn : val * cs + oth * sn; }
                    st_bf16x8((bf16_t*)(prj + PRJ_KR) + (size_t)row * 32 + 8 * fq, kr);
                } else { dst = (bf16_t*)(prj + PRJ_DQKV) + (size_t)row * 384 + 256 + (G - 38) * 64; ss = quad_sum(ss); if (fq == 0) part_dkv[(size_t)row * 2 + (G - 38)] = ss; }
                st_bf16x8(dst + 8 * fq, v[0]); st_bf16x8(dst + bstride + 8 * fq, v[1]);
            }
    }
};

struct EpiUq {
    static constexpr bool KHOOK = false;
    const float* ssq_dq; const float* qkn; const float* rope; bf16_t* QM;
    __device__ __forceinline__ void operator()(const f32x4 (&acc)[2][2][4][2], const GUnit& u, int wr, int wc, int fr, int fq) const {
        const int G = u.pn * 4 + wc; if (G >= 9) return;
        const float scale = 0.14724444f;
        const float* g0 = G < 6 ? qkn + 8 * fq : qkn + 64 + 8 * (fq & 1); const float* g1 = G < 6 ? g0 + 32 : g0 + 16;
        float rs8[8];
#pragma unroll
        for (int k = 0; k < 8; ++k) { const f32x4 pq = *(const f32x4*)(ssq_dq + (size_t)(u.pm * 256 + (k >> 2) * 128 + wr * 64 + (k & 3) * 16 + fr) * 4); rs8[k] = (pq.x + pq.y) + pq.z; }
#pragma unroll
        for (int k = 0; k < 8; ++k) rs8[k] = rsqrtf(rs8[k] * (1.f / 192.f) + 1e-6f);
#pragma unroll
        for (int ai = 0; ai < 2; ++ai)
#pragma unroll
            for (int m = 0; m < 4; ++m) {
                __builtin_amdgcn_sched_barrier(0);
                const int row = u.pm * 256 + ai * 128 + wr * 64 + m * 16 + fr; const int b = row >> 11, t = row & 2047;
                const float rs = rs8[ai * 4 + m];
                float v[2][8]; float ss = 0.f;
#pragma unroll
                for (int bj = 0; bj < 2; ++bj)
#pragma unroll
                    for (int n = 0; n < 2; ++n)
#pragma unroll
                        for (int j = 0; j < 4; ++j) { const float x = acc[ai][bj][m][n][j] * rs; v[bj][4 * n + j] = x; ss += x * x; }
                if (G < 6) ss = quad_sum(ss); else ss += __shfl_xor(ss, 16);
                const float sc = rsqrtf(ss * (G < 6 ? 1.f / 64.f : 1.f / 32.f) + 1e-6f) * scale;
#pragma unroll
                for (int i = 0; i < 8; ++i) { v[0][i] *= sc * g0[i]; v[1][i] *= sc * g1[i]; }
                if (G < 6) {
                    bf16_t* dst = QM + ((size_t)(b * 6 + G) * 2048 + t) * 96;
                    st_bf16x8(dst + 8 * fq, v[0]); st_bf16x8(dst + 32 + 8 * fq, v[1]);
                } else {
                    const int i16 = 8 * (fq & 1); const int head = 2 * (G - 6) + (fq >> 1);
                    const float* rp = rope + (size_t)row * 32 + i16; float o1[8], o2[8];
#pragma unroll
                    for (int i = 0; i < 8; ++i) { const float cs = rp[i], sn = rp[16 + i]; o1[i] = v[0][i] * cs - v[1][i] * sn; o2[i] = v[1][i] * cs + v[0][i] * sn; }
                    bf16_t* dst = QM + ((size_t)(b * 6 + head) * 2048 + t) * 96 + 64 + i16;
                    st_bf16x8(dst, o1); st_bf16x8(dst + 16, o2);
                }
            }
    }
};
struct EpiUkv {
    static constexpr bool KHOOK = false;
    const float* ssq_dkv; const float* qkn; const bf16_t* KR; bf16_t* KM; bf16_t* VM;
    __device__ __forceinline__ void operator()(const f32x4 (&acc)[2][2][4][2], const GUnit& u, int wr, int wc, int fr, int fq) const {
        const int G = u.pn * 4 + wc;
        const float* g0 = qkn + 96 + 8 * fq;
        float rs8[8];
#pragma unroll
        for (int k = 0; k < 8; ++k) { const size_t rr = (size_t)(u.pm * 256 + (k >> 2) * 128 + wr * 64 + (k & 3) * 16 + fr); rs8[k] = ssq_dkv[rr * 2] + ssq_dkv[rr * 2 + 1]; }
#pragma unroll
        for (int k = 0; k < 8; ++k) rs8[k] = rsqrtf(rs8[k] * (1.f / 128.f) + 1e-6f);
#pragma unroll
        for (int ai = 0; ai < 2; ++ai)
#pragma unroll
            for (int m = 0; m < 4; ++m) {
                __builtin_amdgcn_sched_barrier(0);
                const int row = u.pm * 256 + ai * 128 + wr * 64 + m * 16 + fr; const int b = row >> 11, t = row & 2047;
                const float rs = rs8[ai * 4 + m];
                float v[2][8]; float ss = 0.f;
#pragma unroll
                for (int bj = 0; bj < 2; ++bj)
#pragma unroll
                    for (int n = 0; n < 2; ++n)
#pragma unroll
                        for (int j = 0; j < 4; ++j) { const float x = acc[ai][bj][m][n][j] * rs; v[bj][4 * n + j] = x; ss += x * x; }
                if (G < 6) {
                    ss = quad_sum(ss); const float sc = rsqrtf(ss * (1.f / 64.f) + 1e-6f);
#pragma unroll
                    for (int i = 0; i < 8; ++i) { v[0][i] *= sc * g0[i]; v[1][i] *= sc * g0[32 + i]; }
                    bf16_t* dst = KM + ((size_t)(b * 6 + G) * 2048 + t) * 96;
                    st_bf16x8(dst + 8 * fq, v[0]); st_bf16x8(dst + 32 + 8 * fq, v[1]);
                    *(u32x4*)(dst + 64 + 8 * fq) = *(const u32x4*)(KR + (size_t)row * 32 + 8 * fq);
                } else {
                    bf16_t* dst = VM + ((size_t)(b * 6 + (G - 6)) * 2048 + t) * 64;
                    st_bf16x8(dst + 8 * fq, v[0]); st_bf16x8(dst + 32 + 8 * fq, v[1]);
                }
            }
    }
};
#define MFMA16(a, b, c) __builtin_amdgcn_mfma_f32_16x16x32_bf16(a, b, c, 0, 0, 0)
#define MFMA32(a, b, c) __builtin_amdgcn_mfma_f32_32x32x16_bf16(a, b, c, 0, 0, 0)
#define LDS_FENCE() asm volatile("s_waitcnt lgkmcnt(0)" ::: "memory")

__device__ __forceinline__ void cmp_unit(int u, int l, InPtr in, unsigned char* ws, LAS unsigned char* lds, int g_wv) {
    int tid_ = TIDX; asm volatile("" : "+v"(tid_));
    const int tid = tid_, w = tid >> 6, lane = tid & 63, r = lane & 15, q = lane >> 4;
    const int b = u >> 2, s = (u >> 1) & 1, hk = u & 1;
    const bf16_t* A = (const bf16_t*)(ws + WS_PRJ + (s ? PRJ_C0V : PRJ_C0K)) + (size_t)(b * 2 + hk) * 2048 * 64;
    const bf16_t* W1 = (const bf16_t*)(ws + WS_WC1) + ((size_t)l * 2 + s) * 64 * 2048;
    const bf16_t* W2 = (const bf16_t*)(ws + WS_WC2) + ((size_t)l * 2 + s) * 64 * 64;
    const float* b1 = (const float*)(ws + WS_B1C) + (l * 2 + s) * 64;
    f32x4 acc[4];
#pragma unroll
    for (int nb = 0; nb < 4; ++nb) acc[nb] = (f32x4){0.f, 0.f, 0.f, 0.f};
    const bf16_t* ap = A + (size_t)(16 * w + r) * 1024 + 8 * q;
    constexpr int WP = 528, WBUF = 64 * WP; LAS unsigned char* wb = lds + 24576;
    u32x4 st[4];
#pragma unroll
    for (int i = 0; i < 4; ++i) { const int c = tid + 512 * i; st[i] = *(const u32x4*)(W1 + (size_t)(c >> 5) * 2048 + (c & 31) * 8); }
#pragma unroll
    for (int i = 0; i < 4; ++i) { const int c = tid + 512 * i; *(LAS u32x4*)(wb + (c >> 5) * WP + (c & 31) * 16) = st[i]; }
    __syncthreads();
#pragma unroll 1
    for (int kc = 0; kc < 8; ++kc) {
        const int cur = kc & 1;
        if (kc < 7) {
#pragma unroll
            for (int i = 0; i < 4; ++i) { const int c = tid + 512 * i; st[i] = *(const u32x4*)(W1 + (size_t)(c >> 5) * 2048 + (kc + 1) * 256 + (c & 31) * 8); }
        }
        bf16x8 af[8];
#pragma unroll
        for (int ks = 0; ks < 8; ++ks) af[ks] = *(const bf16x8*)(ap + 256 * kc + 32 * ks);
#pragma unroll
        for (int ks = 0; ks < 8; ++ks)
#pragma unroll
            for (int nb = 0; nb < 4; ++nb) { const bf16x8 bb = *(const LAS bf16x8*)(wb + cur * WBUF + (16 * nb + r) * WP + (32 * ks + 8 * q) * 2); acc[nb] = MFMA16(af[ks], bb, acc[nb]); }
        if (kc < 7) {
#pragma unroll
            for (int i = 0; i < 4; ++i) { const int c = tid + 512 * i; *(LAS u32x4*)(wb + (cur ^ 1) * WBUF + (c >> 5) * WP + (c & 31) * 16) = st[i]; }
        }
        __syncthreads();
    }
    LAS bf16_t* hl = (LAS bf16_t*)(lds + w * 2304);
#pragma unroll
    for (int nb = 0; nb < 4; ++nb) { const float bias = b1[16 * nb + r];
#pragma unroll
        for (int j = 0; j < 4; ++j) hl[(4 * q + j) * 72 + 16 * nb + r] = f2bf(siluf(acc[nb][j] + bias)); }
    LDS_FENCE();
    f32x4 o[4];
#pragma unroll
    for (int nb = 0; nb < 4; ++nb) o[nb] = (f32x4){0.f, 0.f, 0.f, 0.f};
#pragma unroll
    for (int ks = 0; ks < 2; ++ks) {
        const bf16x8 a = *(const LAS bf16x8*)(hl + r * 72 + 32 * ks + 8 * q);
#pragma unroll
        for (int nb = 0; nb < 4; ++nb) { const bf16x8 bb = *(const bf16x8*)(W2 + (size_t)(16 * nb + r) * 64 + 32 * ks + 8 * q); o[nb] = MFMA16(a, bb, o[nb]); }
    }
    LDS_FENCE();
    const float* kg = in->p[9] + l * 64;
    bf16_t* dst = (bf16_t*)(ws + WS_CMP + (s ? CMP_V : 0)) + (size_t)(b * 2 + hk) * 128 * 64;
#pragma unroll
    for (int j = 0; j < 4; ++j) {
        const int n = 16 * w + 4 * q + j; float ss = 0.f;
#pragma unroll
        for (int nb = 0; nb < 4; ++nb) ss += o[nb][j] * o[nb][j];
        ss += __shfl_xor(ss, 1); ss += __shfl_xor(ss, 2); ss += __shfl_xor(ss, 4); ss += __shfl_xor(ss, 8);
        const float sc = s == 0 ? rsqrtf(ss * (1.f / 64.f) + 1e-6f) : 1.f;
#pragma unroll
        for (int nb = 0; nb < 4; ++nb) { const int d = 16 * nb + r; const float v = o[nb][j] * sc * (s == 0 ? kg[d] : 1.f); dst[(size_t)n * 64 + d] = n < 127 ? f2bf(v) : (bf16_t)0; }
    }
}

__device__ __forceinline__ int swz_off(int row, int chunk) { return row * 128 + ((chunk ^ (row & 7)) << 4); }
__device__ __forceinline__ float log_sigmoid(float x) { return fminf(x, 0.f) - log1pf(__expf(-fabsf(x))); }
__device__ __forceinline__ void ml_delta_wave(int cu, int l, InPtr in, unsigned char* ws, LAS unsigned char* wl, int lane) {
    const int c = cu & 31, bh = cu >> 5, h = bh & 3, b = bh >> 2; const int t0 = c * 64; const size_t row0 = (size_t)b * 2048 + t0;
    const float* G = (const float*)(ws + WS_PRJ + PRJ_GATES);
    const float ip = G[(row0 + lane) * 32 + 18 + h] + in->p[12][l * 4 + h], fp = G[(row0 + lane) * 32 + 22 + h] + in->p[13][l * 4 + h];
    float bcum = log_sigmoid(fp);
#pragma unroll
    for (int o = 1; o < 64; o <<= 1) { const float t = __builtin_bit_cast(float, __builtin_amdgcn_ds_bpermute(((lane - o) & 63) << 2, __builtin_bit_cast(int, bcum))); if (lane >= o) bcum += t; }
    const float bL = __builtin_bit_cast(float, __builtin_amdgcn_readlane(__builtin_bit_cast(int, bcum), 63)); const float wgt = __expf(bL - bcum + ip);
    { float* mlg = (float*)(ws + WS_ML + ML_G) + ((size_t)bh * 2048 + t0 + lane) * 2; mlg[0] = bcum; mlg[1] = ip; if (lane == 0) ((float*)(ws + WS_ML + ML_BL))[cu] = bL; }
    const bf16_t* raw = (const bf16_t*)(ws + WS_PRJ + PRJ_RAWQK); const float* cw = in->p[11] + (size_t)l * 4 * 512;
    float wq[4], wk[4];
#pragma unroll
    for (int j = 0; j < 4; ++j) { wq[j] = cw[j * 512 + h * 64 + lane]; wk[j] = cw[j * 512 + 256 + h * 64 + lane]; }
    float q3 = 0.f, q2 = 0.f, q1 = 0.f, k3 = 0.f, k2 = 0.f, k1 = 0.f;
    if (c > 0) { const bf16_t* p = raw + (row0 - 3) * 512 + h * 64 + lane; q3 = bf2f(p[0]); q2 = bf2f(p[512]); q1 = bf2f(p[1024]); k3 = bf2f(p[256]); k2 = bf2f(p[512 + 256]); k1 = bf2f(p[1024 + 256]); }
    bf16_t* QC = (bf16_t*)(ws + WS_ML) + ((size_t)bh * 2048 + t0) * 64 + lane; bf16_t* KC = (bf16_t*)(ws + WS_ML + ML_KC) + ((size_t)bh * 2048 + t0) * 64 + lane;
    const bf16_t* V = (const bf16_t*)(ws + WS_PRJ + PRJ_VML) + ((size_t)bh * 2048 + t0) * 64 + lane;
    float dn = 0.f;
    const bf16_t* rq = raw + row0 * 512 + h * 64 + lane;
    bf16_t cq[8], ck[8], cv[8], nq[8], nk[8], nv[8];
#pragma unroll
    for (int j = 0; j < 8; ++j) { cq[j] = rq[(size_t)j * 512]; ck[j] = rq[(size_t)j * 512 + 256]; cv[j] = V[(size_t)j * 64]; }
#pragma unroll 1
    for (int s8 = 0; s8 < 8; ++s8) {
        if (s8 < 7) {
#pragma unroll
            for (int j = 0; j < 8; ++j) { const int s = s8 * 8 + 8 + j; nq[j] = rq[(size_t)s * 512]; nk[j] = rq[(size_t)s * 512 + 256]; nv[j] = V[(size_t)s * 64]; }
        }
        float kb[8], vb[8]; bf16_t qo[8], ko[8];
#pragma unroll
        for (int j = 0; j < 8; ++j) {
            const int s = s8 * 8 + j;
            const float q0 = bf2f(cq[j]), k0 = bf2f(ck[j]);
            const float qv = siluf(wq[0] * q3 + wq[1] * q2 + wq[2] * q1 + wq[3] * q0), kv = siluf(wk[0] * k3 + wk[1] * k2 + wk[2] * k1 + wk[3] * k0) * 0.125f;
            q3 = q2; q2 = q1; q1 = q0; k3 = k2; k2 = k1; k1 = k0;
            qo[j] = f2bf(qv); ko[j] = f2bf(kv);
            const float ws_ = __builtin_bit_cast(float, __builtin_amdgcn_readlane(__builtin_bit_cast(int, wgt), s)); kb[j] = bf2f(ko[j]); dn += ws_ * kb[j]; vb[j] = ws_ * bf2f(cv[j]);
        }
#pragma unroll
        for (int j = 0; j < 8; ++j) { QC[(size_t)(s8 * 8 + j) * 64] = qo[j]; KC[(size_t)(s8 * 8 + j) * 64] = ko[j]; }
        u32x4 pk; pk.x = pk_bf16(kb[0], kb[1]); pk.y = pk_bf16(kb[2], kb[3]); pk.z = pk_bf16(kb[4], kb[5]); pk.w = pk_bf16(kb[6], kb[7]);
        *(LAS u32x4*)(wl + swz_off(lane, s8)) = pk;
        pk.x = pk_bf16(vb[0], vb[1]); pk.y = pk_bf16(vb[2], vb[3]); pk.z = pk_bf16(vb[4], vb[5]); pk.w = pk_bf16(vb[6], vb[7]);
        *(LAS u32x4*)(wl + 8192 + swz_off(lane, s8)) = pk;
#pragma unroll
        for (int j = 0; j < 8; ++j) { cq[j] = nq[j]; ck[j] = nk[j]; cv[j] = nv[j]; }
    }
    ((float*)(ws + WS_ML + ML_DN))[(size_t)cu * 64 + lane] = dn;
    LDS_FENCE();
    const int r = lane & 15, q = lane >> 4;
    bf16_t* DL = (bf16_t*)(ws + WS_ML + ML_DELTA) + (size_t)cu * 4096;
#pragma unroll
    for (int mb = 0; mb < 4; ++mb) {
        f32x4 acc[4];
#pragma unroll
        for (int nb = 0; nb < 4; ++nb) acc[nb] = (f32x4){0.f, 0.f, 0.f, 0.f};
#pragma unroll
        for (int ks = 0; ks < 2; ++ks) {
            const bf16x8 a = *(const LAS bf16x8*)(wl + 8192 + swz_off(16 * mb + r, 4 * ks + q));
#pragma unroll
            for (int nb = 0; nb < 4; ++nb) { const bf16x8 bb = *(const LAS bf16x8*)(wl + swz_off(16 * nb + r, 4 * ks + q)); acc[nb] = MFMA16(a, bb, acc[nb]); }
        }
#pragma unroll
        for (int nb = 0; nb < 4; ++nb)
#pragma unroll
            for (int j = 0; j < 4; ++j) DL[(16 * mb + 4 * q + j) * 64 + 16 * nb + r] = f2bf(acc[nb][j]);
    }
    LDS_FENCE();
}

#ifndef TIME_PH
#define TIME_PH -1
#endif
#define PSTAMP(i, blk) do { if (TIME_PH != -1 && l == 0 && blockIdx.x == (blk) && TIDX == 0) ((unsigned long long*)((unsigned*)(ws + WS_CTL) + CW_TS))[i] = __builtin_amdgcn_s_memrealtime(); } while (0)
__device__ __forceinline__ void phase_prep(int l, InPtr in, unsigned char* ws, LAS unsigned char* lds, int bid, int nb, int g_wv, unsigned* dq) {
    asm volatile("" : "+s"(bid));
    PSTAMP(40, 0);
#ifndef NO_UQ
    { g8::DenseSched S{(const char*)(ws + WS_PRJ + PRJ_DQKV), (const char*)(ws + WS_WUQ) + (size_t)l * 768 * 256 * 2, 384, 256, 64, 3, nb, bid};
      EpiUq E{(const float*)(ws + WS_SSQ + PT_DQ) + (size_t)l * 16384 * 4, in->p[19] + l * 192, (const float*)(ws + WS_ROPE), (bf16_t*)(ws + WS_MLA)};
      g8::gemm_run(lds, 256, 256, S, E, g_wv); }
#endif
    PSTAMP(41, 0);
#ifndef NO_UKV
    asm volatile("" : "+s"(bid));
    { g8::DenseSched S{(const char*)(ws + WS_PRJ + PRJ_DQKV) + 256, (const char*)(ws + WS_WUKV) + (size_t)l * 768 * 256 * 2, 384, 256, 64, 3, nb, bid};
      EpiUkv E{(const float*)(ws + WS_SSQ + PT_DKV) + (size_t)l * 16384 * 2, in->p[19] + l * 192, (const bf16_t*)(ws + WS_PRJ + PRJ_KR), (bf16_t*)(ws + WS_MLA + MLA_KM), (bf16_t*)(ws + WS_MLA + MLA_VM)};
      g8::gemm_run(lds, 256, 256, S, E, g_wv); }
#endif
    PSTAMP(42, 0); PSTAMP(44, 255);
    __syncthreads();
#ifndef NO_CMP
    for (int u = nb - 1 - bid; u < 32; u += nb) cmp_unit(u, l, in, ws, lds, g_wv);
#endif
    PSTAMP(45, 255);
    __syncthreads();
#ifndef NO_DELTA
    { int tid_ = TIDX; asm volatile("" : "+v"(tid_)); LAS int* slot = (LAS int*)(lds + LDS_MISC + 64);
      for (;;) {
          __syncthreads();
          if (tid_ == 0) *slot = (int)__hip_atomic_fetch_add(dq, 1u, __ATOMIC_RELAXED, __HIP_MEMORY_SCOPE_AGENT);
          __syncthreads();
          const int g = *slot; if (g >= 128) break;
          ml_delta_wave(g * 8 + (tid_ >> 6), l, in, ws, lds + (tid_ >> 6) * 16384, tid_ & 63);
      } }
#endif
    __syncthreads(); PSTAMP(43, 0);
}
#define CHK_TOL(st) (((st) & 15) == 8 ? 1e-2f : 1e-3f)
#define CHECK_REST
constexpr int VTP = 192;
typedef short v4i16_t __attribute__((ext_vector_type(4)));
__device__ __forceinline__ int vt_lane_off(int lane) { return (4 * (lane >> 5) + ((lane & 15) >> 2)) * VTP + ((((lane >> 4) & 1) * 16) + 4 * (lane & 3)) * 2; }
__device__ __forceinline__ bf16x8 vt_frag(const LAS unsigned char* Vt, int voff, int s4, int eb) {
    const LAS unsigned char* a = Vt + voff + 16 * s4 * VTP + 64 * eb;
    const v4i16_t lo = __builtin_amdgcn_ds_read_tr16_b64_v4i16((LAS v4i16_t*)a), hi = __builtin_amdgcn_ds_read_tr16_b64_v4i16((LAS v4i16_t*)(a + 8 * VTP));
    return (bf16x8){lo[0], lo[1], lo[2], lo[3], hi[0], hi[1], hi[2], hi[3]};
}
__device__ __forceinline__ int crow(int reg, int h) { return (reg & 3) + 8 * (reg >> 2) + 4 * h; }
struct AttnState { f32x16 o[2]; float m, l; };
__device__ __forceinline__ void attn_reset(AttnState& A) { A.m = -1e30f; A.l = 0.f;
#pragma unroll
    for (int i = 0; i < 16; ++i) { A.o[0][i] = 0.f; A.o[1][i] = 0.f; } }

template <int DK>
__device__ __forceinline__ void attn_scores(f32x16 (&s)[2], const bf16x8 (&qf)[DK / 16], const LAS unsigned char* Kt, int r, int h) {
    constexpr int KP = 2 * DK + 16, NK = DK / 16;
    bf16x8 kf[2][NK];
#pragma unroll
    for (int kb = 0; kb < 2; ++kb)
#pragma unroll
        for (int ks = 0; ks < NK; ++ks) kf[kb][ks] = *(const LAS bf16x8*)(Kt + (32 * kb + r) * KP + (16 * ks + 8 * h) * 2);
    __builtin_amdgcn_sched_barrier(0);
#pragma unroll
    for (int kb = 0; kb < 2; ++kb) {
#pragma unroll
        for (int i = 0; i < 16; ++i) s[kb][i] = 0.f;
#pragma unroll
        for (int ks = 0; ks < NK; ++ks) s[kb] = MFMA32(kf[kb][ks], qf[ks], s[kb]);
    }
}
__device__ __forceinline__ float max3f(float a, float b, float c) { return fmaxf(fmaxf(a, b), c); }
__device__ __forceinline__ void attn_softmax_pv(AttnState& A, f32x16 (&s)[2], const LAS unsigned char* Vt, int r, int h, float bias_c = 0.f, bool lane_ok = true) {
    constexpr float THR = 8.f; const int voff = vt_lane_off(r + 32 * h);
    float mx = max3f(s[0][0], s[0][1], s[0][2]);
#pragma unroll
    for (int i = 3; i < 15; i += 2) mx = max3f(mx, s[0][i], s[0][i + 1]);
    mx = max3f(mx, s[0][15], s[1][0]);
#pragma unroll
    for (int i = 1; i < 15; i += 2) mx = max3f(mx, s[1][i], s[1][i + 1]);
    mx = fmaxf(mx, s[1][15]);
    mx = fmaxf(mx, __shfl_xor(mx, 32));
    const float mxb = (lane_ok && mx > -1e29f) ? mx + bias_c : -1e30f;
    const bool grow = mxb > A.m + THR;
    const float mnew = grow ? mxb : A.m;
    if (__any(grow)) {
        const float alpha = __builtin_amdgcn_exp2f(A.m - mnew);
        A.l *= alpha;
#pragma unroll
        for (int i = 0; i < 16; ++i) { A.o[0][i] *= alpha; A.o[1][i] *= alpha; }
    }
    A.m = mnew;
    const float sub = (lane_ok && mnew > -1e29f) ? mnew - bias_c : 1e30f;
    float rs = 0.f;
#pragma unroll
    for (int kb = 0; kb < 2; ++kb)
#pragma unroll
        for (int i = 0; i < 16; ++i) { const float p = __builtin_amdgcn_exp2f(s[kb][i] - sub); s[kb][i] = p; rs += p; }
    rs += __shfl_xor(rs, 32);
    A.l += rs;
    bf16x8 vf[4][2];
#pragma unroll
    for (int s4 = 0; s4 < 4; ++s4)
#pragma unroll
        for (int eb = 0; eb < 2; ++eb) vf[s4][eb] = vt_frag(Vt, voff, s4, eb);
    __builtin_amdgcn_sched_barrier(0);
#pragma unroll
    for (int s4 = 0; s4 < 4; ++s4) {
        const int kb = s4 >> 1, hf = (s4 & 1) * 8;
        u32x4 pw; pw.x = pk_bf16(s[kb][hf + 0], s[kb][hf + 1]); pw.y = pk_bf16(s[kb][hf + 2], s[kb][hf + 3]); pw.z = pk_bf16(s[kb][hf + 4], s[kb][hf + 5]); pw.w = pk_bf16(s[kb][hf + 6], s[kb][hf + 7]);
        const bf16x8 pf = __builtin_bit_cast(bf16x8, pw);
#pragma unroll
        for (int eb = 0; eb < 2; ++eb) A.o[eb] = MFMA32(vf[s4][eb], pf, A.o[eb]);
    }
}
template <int DK>
__device__ __forceinline__ void stage_k_load(u32x4 (&kr)[2], const bf16_t* Kg  , int tid) {
    constexpr int CH = DK / 8;
    kr[0] = *(const u32x4*)(Kg + (size_t)(tid / CH) * DK + (tid % CH) * 8);
    if (64 * CH > 512) { const int c2 = tid + 512; if (c2 < 64 * CH) kr[1] = *(const u32x4*)(Kg + (size_t)(c2 / CH) * DK + (c2 % CH) * 8); }
}
template <int DK>
__device__ __forceinline__ void stage_k_store(const u32x4 (&kr)[2], LAS unsigned char* Kt, int tid) {
    constexpr int CH = DK / 8, KP = 2 * DK + 16;
    *(LAS u32x4*)(Kt + (tid / CH) * KP + (tid % CH) * 16) = kr[0];
    if (64 * CH > 512) { const int c2 = tid + 512; if (c2 < 64 * CH) *(LAS u32x4*)(Kt + (c2 / CH) * KP + (c2 % CH) * 16) = kr[1]; }
}
__device__ __forceinline__ u32x4 stage_v_load(const bf16_t* Vg, int tid) { return *(const u32x4*)(Vg + (size_t)(tid >> 3) * 64 + (tid & 7) * 8); }
__device__ __forceinline__ void stage_v_store(const u32x4& v, LAS unsigned char* Vt, int tid) { *(LAS u32x4*)(Vt + (tid >> 3) * VTP + (tid & 7) * 16) = v; }

constexpr int MLA_KT = 0, MLA_VT = 2 * 64 * 208, MLA_LDS = MLA_VT + 2 * 64 * VTP;
__device__ __forceinline__ void mla_unit(int b, int hd, int qt, int l, unsigned char* ws, LAS unsigned char* lds, int g_wv) {
    int tid_ = TIDX; asm volatile("" : "+v"(tid_));
    const int tid = tid_, w = tid >> 6, lane = tid & 63, r = lane & 31, h = lane >> 5;
    const size_t slab = (size_t)(b * 6 + hd) * 2048;
    const bf16_t* QM = (const bf16_t*)(ws + WS_MLA) + slab * 96; const bf16_t* KM = (const bf16_t*)(ws + WS_MLA + MLA_KM) + slab * 96; const bf16_t* VM = (const bf16_t*)(ws + WS_MLA + MLA_VM) + slab * 64;
    const int q0 = 256 * qt + 32 * w, q = q0 + r;
    bf16x8 qf[6];
#pragma unroll
    for (int ks = 0; ks < 6; ++ks) qf[ks] = *(const bf16x8*)(QM + (size_t)q * 96 + 16 * ks + 8 * h);
    AttnState A; attn_reset(A);
    const int ntile = 4 * qt + 4;
    u32x4 kr[2], vr, kr2[2], vr2;
    stage_k_load<96>(kr, KM, tid); vr = stage_v_load(VM, tid);
    stage_k_store<96>(kr, lds + MLA_KT, tid); stage_v_store(vr, lds + MLA_VT, tid);
    if (ntile > 1) { stage_k_load<96>(kr, KM + (size_t)64 * 96, tid); vr = stage_v_load(VM + (size_t)64 * 64, tid); }
    __syncthreads();
    for (int j = 0; j < ntile; ++j) {
        const int cur = j & 1;
        if (j + 2 < ntile) { stage_k_load<96>(kr2, KM + (size_t)(j + 2) * 64 * 96, tid); vr2 = stage_v_load(VM + (size_t)(j + 2) * 64 * 64, tid); }
        if (64 * j <= q0 + 31) {
            f32x16 s[2];
            attn_scores<96>(s, qf, lds + MLA_KT + cur * 64 * 208, r, h);
            if (64 * j + 63 > q0) {
#pragma unroll
                for (int kb = 0; kb < 2; ++kb)
#pragma unroll
                    for (int i = 0; i < 16; ++i) { const int key = 64 * j + 32 * kb + crow(i, h); if (key > q) s[kb][i] = -1e30f; }
            }
            attn_softmax_pv(A, s, lds + MLA_VT + cur * 64 * VTP, r, h);
        }
        if (j + 1 < ntile) { stage_k_store<96>(kr, lds + MLA_KT + (cur ^ 1) * 64 * 208, tid); stage_v_store(vr, lds + MLA_VT + (cur ^ 1) * 64 * VTP, tid); }
        kr[0] = kr2[0]; kr[1] = kr2[1]; vr = vr2;
        __syncthreads();
    }
    const float inv = A.l > 0.f ? 1.f / A.l : 0.f; float ss = 0.f;
    bf16_t* Y = (bf16_t*)(ws + WS_Y) + ((size_t)b * 2048 + q) * 1024 + 384 + hd * 64;
#pragma unroll
    for (int eb = 0; eb < 2; ++eb)
#pragma unroll
        for (int g4 = 0; g4 < 4; ++g4) {
            const float v0 = A.o[eb][4 * g4] * inv, v1 = A.o[eb][4 * g4 + 1] * inv, v2 = A.o[eb][4 * g4 + 2] * inv, v3 = A.o[eb][4 * g4 + 3] * inv;
            u32x2 pw; pw.x = pk_bf16(v0, v1); pw.y = pk_bf16(v2, v3);
            const float f0 = bf_lo(pw.x), f1 = bf_hi(pw.x), f2 = bf_lo(pw.y), f3 = bf_hi(pw.y); ss += (f0 * f0 + f1 * f1) + (f2 * f2 + f3 * f3);
            *(u32x2*)(Y + 32 * eb + 8 * g4 + 4 * h) = pw;
        }
    ss += __shfl_xor(ss, 32);
    if (h == 0) ((float*)(ws + WS_SSQ + PT_C))[((size_t)l * 16384 + (size_t)b * 2048 + q) * 8 + hd] = ss;
}

__device__ __forceinline__ void nsa_bias32(float (&bv)[2][16], const LAS float* bl, int dd) {
#pragma unroll
    for (int kb = 0; kb < 2; ++kb)
#pragma unroll
        for (int k = 0; k < 16; ++k) { const int c = 63 - (32 * kb + (k & 3) + 8 * (k >> 2)); int d = dd + c; d = d < 0 ? 0 : (d > 255 ? 255 : d); bv[kb][k] = bl[d]; }
}
__device__ __forceinline__ void nsa_mask_bias(f32x16 (&sc)[2], int dq, int h, const LAS float* bl, bool sel, int lim) {
    int dd = dq - 4 * h - 63; asm volatile("" : "+v"(dd));
    float bv[2][16]; nsa_bias32(bv, bl, dd);
#pragma unroll
    for (int kb = 0; kb < 2; ++kb)
#pragma unroll
        for (int k = 0; k < 16; ++k) { const int c = 63 - (32 * kb + (k & 3) + 8 * (k >> 2)); const int d = dd + c; sc[kb][k] = (sel && d >= 0 && d < lim) ? sc[kb][k] + bv[kb][k] : -1e30f; }
}

constexpr int NSA_KT = 0, NSA_VT = 2 * 64 * 144, NSA_BIAS = NSA_VT + 2 * 64 * VTP, NSA_PS = NSA_BIAS + 3 * 256 * 4, NSA_SEL = NSA_PS + 3 * 64 * 32 * 4, NSA_UNI = NSA_SEL + 256, NSA_OT = NSA_UNI + 256, NSA_LDS = NSA_OT + 6 * 8192;
__device__ __forceinline__ void nsa_unit(int b, int hk, int i, int l, InPtr in, unsigned char* ws, LAS unsigned char* lds, int g_wv) {
    int tid_ = TIDX; asm volatile("" : "+v"(tid_));
    const int tid = tid_, w = tid >> 6, lane = tid & 63, r = lane & 31, h = lane >> 5;
    const bool active = w < 6; const int g = active ? (w >> 1) : 0, th = w & 1, head = hk * 3 + g;
    const int t = 64 * i + 32 * th + r, tl = 32 * th + r; const size_t row = (size_t)b * 2048 + t;
    const size_t kvslab = (size_t)(b * 2 + hk) * 2048 * 64;
    LAS float* biasl = (LAS float*)(lds + NSA_BIAS); LAS float* PS = (LAS float*)(lds + NSA_PS); LAS unsigned* SEL = (LAS unsigned*)(lds + NSA_SEL); LAS unsigned* UNI = (LAS unsigned*)(lds + NSA_UNI);
    { const float* bd = (const float*)(ws + WS_BIASD) + (size_t)hk * 3 * 2048;
      if (tid < 384) { const int gg = tid >> 7, d0 = (tid & 127) * 2; biasl[gg * 256 + d0] = bd[gg * 2048 + d0]; biasl[gg * 256 + d0 + 1] = bd[gg * 2048 + d0 + 1]; }
#pragma unroll
      for (int k = 0; k < 12; ++k) if (i >= 16) PS[tid + 512 * k] = 0.f;
      if (tid < 4) UNI[tid] = 0u; }
    bf16x8 qf[4];
    { const bf16_t* QN = (const bf16_t*)(ws + WS_PRJ + PRJ_QN) + ((size_t)(b * 6 + head) * 2048 + t) * 64;
#pragma unroll
      for (int ks = 0; ks < 4; ++ks) qf[ks] = *(const bf16x8*)(QN + 16 * ks + 8 * h); }
#define NSA_GATE(k) ({ int t_ = t; asm volatile("" : "+v"(t_)); sigmf(((const float*)(ws + WS_PRJ + PRJ_GATES))[((size_t)b * 2048 + t_) * 32 + head * 3 + (k)]); })
    LAS float* bl = biasl + g * 256;
    LAS float* otl = (LAS float*)(lds + NSA_OT + (active ? w : 0) * 8192) + lane;
    u32x4 kr[2], vr;
    const int ntc = i >= 16 ? 2 : 1;
    { const bf16_t* KC = (const bf16_t*)(ws + WS_CMP) + (size_t)(b * 2 + hk) * 128 * 64; const bf16_t* VC = (const bf16_t*)(ws + WS_CMP + CMP_V) + (size_t)(b * 2 + hk) * 128 * 64;
      for (int T = 0; T < ntc; ++T) { stage_k_load<64>(kr, KC + T * 4096, tid); vr = stage_v_load(VC + T * 4096, tid); stage_k_store<64>(kr, lds + NSA_KT + T * 64 * 144, tid); stage_v_store(vr, lds + NSA_VT + T * 64 * VTP, tid); } }
    __syncthreads();
    {
        f32x16 ot[2];
        if (active && i < 16) {
            AttnState A; attn_reset(A); f32x16 sc[2]; attn_scores<64>(sc, qf, lds + NSA_KT, r, h);
            float bvc[2][16];
#pragma unroll
            for (int kb = 0; kb < 2; ++kb)
#pragma unroll
                for (int k = 0; k < 16; ++k) { int d = t - 16 * (32 * kb + crow(k, h)) - 31; d = d < 0 ? 0 : (d > 255 ? 255 : d); bvc[kb][k] = bl[d]; }
#pragma unroll
            for (int kb = 0; kb < 2; ++kb)
#pragma unroll
                for (int k = 0; k < 16; ++k) { const int d = t - 16 * (32 * kb + crow(k, h)) - 31; sc[kb][k] = d >= 0 ? sc[kb][k] + bvc[kb][k] : -1e30f; }
            attn_softmax_pv(A, sc, lds + NSA_VT, r, h);
            const float gc = NSA_GATE(0); const float inv = A.l > 0.f ? gc / A.l : 0.f;
#pragma unroll
            for (int k = 0; k < 16; ++k) { otl[64 * k] = A.o[0][k] * inv; otl[64 * (16 + k)] = A.o[1][k] * inv; }
        } else if (active) {
            float m = -1e30f, lsum = 0.f;
            for (int T = 0; T < ntc; ++T) {
                f32x16 sc[2]; attn_scores<64>(sc, qf, lds + NSA_KT + T * 64 * 144, r, h);
                float bvc[2][16];
#pragma unroll
                for (int kb = 0; kb < 2; ++kb)
#pragma unroll
                    for (int k = 0; k < 16; ++k) { int d = t - 16 * (64 * T + 32 * kb + crow(k, h)) - 31; d = d < 0 ? 0 : (d > 255 ? 255 : d); bvc[kb][k] = bl[d]; }
                float mx = -1e30f;
#pragma unroll
                for (int kb = 0; kb < 2; ++kb)
#pragma unroll
                    for (int k = 0; k < 16; ++k) { const int n = 64 * T + 32 * kb + crow(k, h); const int d = t - 16 * n - 31; const float x = (d >= 0 && n < 127) ? sc[kb][k] + bvc[kb][k] : -1e30f; sc[kb][k] = x; mx = fmaxf(mx, x); }
                mx = fmaxf(mx, __shfl_xor(mx, 32));
                const float mnew = fmaxf(m, mx), mref = mnew <= -1e29f ? 0.f : mnew; float rs = 0.f;
#pragma unroll
                for (int kb = 0; kb < 2; ++kb)
#pragma unroll
                    for (int k = 0; k < 16; ++k) rs += __builtin_amdgcn_exp2f(sc[kb][k] - mref);
                rs += __shfl_xor(rs, 32);
                lsum = lsum * __builtin_amdgcn_exp2f(m - mref) + rs; m = mnew;
            }
            const float mref = m <= -1e29f ? 0.f : m, inv = lsum > 0.f ? 1.f / lsum : 0.f;
#pragma unroll
            for (int k = 0; k < 16; ++k) { ot[0][k] = 0.f; ot[1][k] = 0.f; }
            float carry = 0.f;
            for (int T = 0; T < ntc; ++T) {
                f32x16 sc[2]; attn_scores<64>(sc, qf, lds + NSA_KT + T * 64 * 144, r, h);
                float bvc[2][16];
#pragma unroll
                for (int kb = 0; kb < 2; ++kb)
#pragma unroll
                    for (int k = 0; k < 16; ++k) { int d = t - 16 * (64 * T + 32 * kb + crow(k, h)) - 31; d = d < 0 ? 0 : (d > 255 ? 255 : d); bvc[kb][k] = bl[d]; }
#pragma unroll
                for (int kb = 0; kb < 2; ++kb)
#pragma unroll
                    for (int k = 0; k < 16; ++k) { const int n = 64 * T + 32 * kb + crow(k, h); const int d = t - 16 * n - 31; sc[kb][k] = (d >= 0 && n < 127) ? __builtin_amdgcn_exp2f(sc[kb][k] + bvc[kb][k] - mref) * inv : 0.f; }
                float prevL = carry;
#pragma unroll
                for (int kb = 0; kb < 2; ++kb)
#pragma unroll
                    for (int g4 = 0; g4 < 4; ++g4) {
                        const float G4 = (sc[kb][4 * g4] + sc[kb][4 * g4 + 1]) + (sc[kb][4 * g4 + 2] + sc[kb][4 * g4 + 3]); const float L = sc[kb][4 * g4 + 3];
                        const float Lo = __shfl_xor(L, 32);
                        const float add = h ? Lo : prevL;
                        prevL = Lo;
                        const int idx = T * 8 + kb * 4 + g4;
                        PS[g * 2048 + tl * 32 + 2 * idx + h] = G4 + add;
                    }
                carry = prevL;
#pragma unroll
                for (int s4 = 0; s4 < 4; ++s4) {
                    const int kb = s4 >> 1, hf = (s4 & 1) * 8;
                    u32x4 pw; pw.x = pk_bf16(sc[kb][hf + 0], sc[kb][hf + 1]); pw.y = pk_bf16(sc[kb][hf + 2], sc[kb][hf + 3]); pw.z = pk_bf16(sc[kb][hf + 4], sc[kb][hf + 5]); pw.w = pk_bf16(sc[kb][hf + 6], sc[kb][hf + 7]);
                    const bf16x8 pf = __builtin_bit_cast(bf16x8, pw);
#pragma unroll
                    for (int eb = 0; eb < 2; ++eb) ot[eb] = MFMA32(vt_frag(lds + NSA_VT + T * 64 * VTP, vt_lane_off(lane), s4, eb), pf, ot[eb]);
                }
            }
            { const float gc = NSA_GATE(0);
#pragma unroll
            for (int k = 0; k < 16; ++k) { otl[64 * k] = ot[0][k] * gc; otl[64 * (16 + k)] = ot[1][k] * gc; } }
        }
    }
    __syncthreads();
#ifndef NO_NSA_SEL
    if (i < 16) { if (tid < 64) SEL[tid] = (2u << i) - 1u; if (tid < 3) UNI[tid] = (2u << i) - 1u; }
    else {
        const int tk = tid >> 3, sg = tid & 7; float v[32];
#pragma unroll
        for (int k = 0; k < 8; ++k) { const f32x4 x0 = *(const LAS f32x4*)(PS + tk * 32 + 4 * k), x1 = *(const LAS f32x4*)(PS + 2048 + tk * 32 + 4 * k), x2 = *(const LAS f32x4*)(PS + 4096 + tk * 32 + 4 * k);
            v[4 * k] = (x0.x + x1.x) + x2.x; v[4 * k + 1] = (x0.y + x1.y) + x2.y; v[4 * k + 2] = (x0.z + x1.z) + x2.z; v[4 * k + 3] = (x0.w + x1.w) + x2.w; }
#pragma unroll
        for (int s = 0; s < 32; ++s) { const bool forced = (s == 0) || (s == i) || (s == i - 1); float x = forced ? v[s] + 1e4f : v[s]; v[s] = s > i ? -1.f : x; }
        unsigned bits = 0u;
#pragma unroll
        for (int k = 0; k < 4; ++k) {
            float x = 0.f;
#pragma unroll
            for (int s = 0; s < 32; ++s) x = (s == 4 * sg + k) ? v[s] : x;
            int rank = 0;
#pragma unroll
            for (int s = 0; s < 32; ++s) rank += (v[s] > x || (v[s] == x && s < 4 * sg + k)) ? 1 : 0;
            if (rank < 16 && x >= 0.f) bits |= 1u << (4 * sg + k);
        }
        bits |= __shfl_xor(bits, 1); bits |= __shfl_xor(bits, 2); bits |= __shfl_xor(bits, 4);
        if (sg == 0) { SEL[tk] = bits; __hip_atomic_fetch_or(UNI, bits, __ATOMIC_RELAXED, __HIP_MEMORY_SCOPE_WORKGROUP); __hip_atomic_fetch_or(UNI + 1 + (tk >> 5), bits, __ATOMIC_RELAXED, __HIP_MEMORY_SCOPE_WORKGROUP); }
    }
#endif
    __syncthreads();
    const unsigned selbits = SEL[tl], uni = UNI[0], unih = UNI[1 + th];
    const float c31 = bl[255];
#ifndef NO_NSA_SLC
#ifndef NSA_DUP_SLC
#define NSA_DUP_SLC 1
#endif
    for (int rp_ = 0; rp_ < NSA_DUP_SLC; ++rp_) {
        AttnState A; attn_reset(A);
        const bf16_t* KS = (const bf16_t*)(ws + WS_PRJ + PRJ_KN1) + kvslab; const bf16_t* VS = (const bf16_t*)(ws + WS_PRJ + PRJ_VN1) + kvslab;
        unsigned todo = uni; int cur = 0; u32x4 kr2[2], vr2;
        int s = __ffs(todo) - 1; todo &= todo - 1;
        stage_k_load<64>(kr, KS + (size_t)s * 4096, tid); vr = stage_v_load(VS + (size_t)s * 4096, tid);
        stage_k_store<64>(kr, lds + NSA_KT, tid); stage_v_store(vr, lds + NSA_VT, tid);
        int sn = todo ? __ffs(todo) - 1 : -1; todo &= todo - 1;
        if (sn >= 0) { stage_k_load<64>(kr, KS + (size_t)sn * 4096, tid); vr = stage_v_load(VS + (size_t)sn * 4096, tid); }
        __syncthreads();
        while (s >= 0) {
            const int sn2 = todo ? __ffs(todo) - 1 : -1; todo &= todo - 1;
            if (sn2 >= 0) { stage_k_load<64>(kr2, KS + (size_t)sn2 * 4096, tid); vr2 = stage_v_load(VS + (size_t)sn2 * 4096, tid); }
            if (active && ((unih >> s) & 1u)) {
                f32x16 sc[2];
                attn_scores<64>(sc, qf, lds + NSA_KT + cur * 64 * 144, r, h);
                const bool sel = (selbits >> s) & 1u;
                if (i - s >= 3) attn_softmax_pv(A, sc, lds + NSA_VT + cur * 64 * VTP, r, h, c31, sel);
                else { nsa_mask_bias(sc, t - 64 * s, h, bl, sel, 4096); attn_softmax_pv(A, sc, lds + NSA_VT + cur * 64 * VTP, r, h); }
            }
            if (sn >= 0) { stage_k_store<64>(kr, lds + NSA_KT + (cur ^ 1) * 64 * 144, tid); stage_v_store(vr, lds + NSA_VT + (cur ^ 1) * 64 * VTP, tid); }
            kr[0] = kr2[0]; vr = vr2;
            __syncthreads();
            s = sn; sn = sn2; cur ^= 1;
        }
        if (active && rp_ == NSA_DUP_SLC - 1) { const float gs = NSA_GATE(1); const float inv = A.l > 0.f ? gs / A.l : 0.f;
#pragma unroll
            for (int k = 0; k < 16; ++k) { otl[64 * k] += A.o[0][k] * inv; otl[64 * (16 + k)] += A.o[1][k] * inv; } }
    }
#endif
#ifndef NO_NSA_WIN
#ifndef NSA_DUP_WIN
#define NSA_DUP_WIN 1
#endif
    for (int rq_ = 0; rq_ < NSA_DUP_WIN; ++rq_) {
        AttnState A; attn_reset(A);
        const bf16_t* KW = (const bf16_t*)(ws + WS_PRJ + PRJ_KN2) + kvslab; const bf16_t* VW = (const bf16_t*)(ws + WS_PRJ + PRJ_VN2) + kvslab;
        const int j0 = i > 8 ? i - 8 : 0; int cur = 0; u32x4 kr2[2], vr2;
        stage_k_load<64>(kr, KW + (size_t)j0 * 4096, tid); vr = stage_v_load(VW + (size_t)j0 * 4096, tid);
        stage_k_store<64>(kr, lds + NSA_KT, tid); stage_v_store(vr, lds + NSA_VT, tid);
        if (j0 < i) { stage_k_load<64>(kr, KW + (size_t)(j0 + 1) * 4096, tid); vr = stage_v_load(VW + (size_t)(j0 + 1) * 4096, tid); }
        __syncthreads();
        for (int j = j0; j <= i; ++j) {
            if (j + 2 <= i) { stage_k_load<64>(kr2, KW + (size_t)(j + 2) * 4096, tid); vr2 = stage_v_load(VW + (size_t)(j + 2) * 4096, tid); }
            if (active) {
                f32x16 sc[2];
                attn_scores<64>(sc, qf, lds + NSA_KT + cur * 64 * 144, r, h);
                if (i - j >= 3 && j > i - 8) attn_softmax_pv(A, sc, lds + NSA_VT + cur * 64 * VTP, r, h, c31, true);
                else { nsa_mask_bias(sc, t - 64 * j, h, bl, true, 512); attn_softmax_pv(A, sc, lds + NSA_VT + cur * 64 * VTP, r, h); }
            }
            if (j < i) { stage_k_store<64>(kr, lds + NSA_KT + (cur ^ 1) * 64 * 144, tid); stage_v_store(vr, lds + NSA_VT + (cur ^ 1) * 64 * VTP, tid); }
            kr[0] = kr2[0]; vr = vr2;
            __syncthreads();
            cur ^= 1;
        }
        if (active && rq_ == NSA_DUP_WIN - 1) { const float gw = NSA_GATE(2); const float inv = A.l > 0.f ? gw / A.l : 0.f;
            float ss = 0.f; bf16_t* Y = (bf16_t*)(ws + WS_Y) + row * 1024 + head * 64;
#pragma unroll
            for (int eb = 0; eb < 2; ++eb)
#pragma unroll
                for (int g4 = 0; g4 < 4; ++g4) {
                    const float v0 = otl[64 * (16 * eb + 4 * g4)] + A.o[eb][4 * g4] * inv, v1 = otl[64 * (16 * eb + 4 * g4 + 1)] + A.o[eb][4 * g4 + 1] * inv;
                    const float v2 = otl[64 * (16 * eb + 4 * g4 + 2)] + A.o[eb][4 * g4 + 2] * inv, v3 = otl[64 * (16 * eb + 4 * g4 + 3)] + A.o[eb][4 * g4 + 3] * inv;
                    u32x2 pw; pw.x = pk_bf16(v0, v1); pw.y = pk_bf16(v2, v3);
                    const float f0 = bf_lo(pw.x), f1 = bf_hi(pw.x), f2 = bf_lo(pw.y), f3 = bf_hi(pw.y); ss += (f0 * f0 + f1 * f1) + (f2 * f2 + f3 * f3);
                    *(u32x2*)(Y + 32 * eb + 8 * g4 + 4 * h) = pw;
                }
            ss += __shfl_xor(ss, 32);
            if (h == 0) ((float*)(ws + WS_SSQ + PT_A))[((size_t)l * 16384 + row) * 8 + head] = ss;
        }
    }
#endif
}

__device__ __forceinline__ void ml_out_wave(int cu, int l, InPtr in, unsigned char* ws, LAS unsigned char* wl, LAS unsigned char* npl, int lane) {
    const int c = cu & 31, bh = cu >> 5, hd = bh & 3, b = bh >> 2; const int t0 = c * 64; const int r = lane & 15, q = lane >> 4;
    const bf16_t* QC = (const bf16_t*)(ws + WS_ML) + ((size_t)bh * 2048 + t0) * 64; const bf16_t* KC = (const bf16_t*)(ws + WS_ML + ML_KC) + ((size_t)bh * 2048 + t0) * 64;
    const bf16_t* V = (const bf16_t*)(ws + WS_PRJ + PRJ_VML) + ((size_t)bh * 2048 + t0) * 64;
    const float* mlg = (const float*)(ws + WS_ML + ML_G) + ((size_t)bh * 2048 + t0) * 2;
    const bf16_t* CP = (const bf16_t*)(ws + WS_ML + ML_CP) + (size_t)cu * 4096; const bf16_t* NP = (const bf16_t*)(ws + WS_ML + ML_NP) + (size_t)cu * 64;
    bf16x8 aq[4][2];
#pragma unroll
    for (int mb = 0; mb < 4; ++mb)
#pragma unroll
        for (int ks = 0; ks < 2; ++ks) aq[mb][ks] = *(const bf16x8*)(QC + (size_t)(16 * mb + r) * 64 + 32 * ks + 8 * q);
    float bj[4][4], den[4][4];
#pragma unroll
    for (int mb = 0; mb < 4; ++mb)
#pragma unroll
        for (int j = 0; j < 4; ++j) bj[mb][j] = mlg[(16 * mb + 4 * q + j) * 2];
    {
        float cs[4];
#pragma unroll
        for (int nb = 0; nb < 4; ++nb) { const float2 gg = *(const float2*)(mlg + (16 * nb + r) * 2); cs[nb] = gg.y - gg.x; }
#pragma unroll
        for (int mb = 0; mb < 4; ++mb) {
            f32x4 accS[4];
#pragma unroll
            for (int nb = 0; nb < 4; ++nb) { accS[nb] = (f32x4){0.f, 0.f, 0.f, 0.f};
#pragma unroll
                for (int ks = 0; ks < 2; ++ks) { const bf16x8 bk = *(const bf16x8*)(KC + (size_t)(16 * nb + r) * 64 + 32 * ks + 8 * q); accS[nb] = MFMA16(aq[mb][ks], bk, accS[nb]); } }
#pragma unroll
            for (int j = 0; j < 4; ++j) {
                const int jj = 16 * mb + 4 * q + j; float rs = 0.f;
#pragma unroll
                for (int nb = 0; nb < 4; ++nb) { const int s = 16 * nb + r; const float p = s <= jj ? accS[nb][j] * __expf(bj[mb][j] + cs[nb]) : 0.f; rs += p;
                    *(LAS bf16_t*)(wl + 8192 + swz_off(jj, s >> 3) + (s & 7) * 2) = f2bf(p); }
                rs += __shfl_xor(rs, 1); rs += __shfl_xor(rs, 2); rs += __shfl_xor(rs, 4); rs += __shfl_xor(rs, 8);
                den[mb][j] = rs;
            }
        }
    }
#pragma unroll
    for (int mb = 0; mb < 4; ++mb) { const float e = __expf(mlg[(16 * mb + r) * 2]);
#pragma unroll
        for (int ks = 0; ks < 2; ++ks) { const u32x4 x = __builtin_bit_cast(u32x4, aq[mb][ks]); u32x4 y;
            y.x = pk_bf16(bf_lo(x.x) * e, bf_hi(x.x) * e); y.y = pk_bf16(bf_lo(x.y) * e, bf_hi(x.y) * e); y.z = pk_bf16(bf_lo(x.z) * e, bf_hi(x.z) * e); y.w = pk_bf16(bf_lo(x.w) * e, bf_hi(x.w) * e);
            aq[mb][ks] = __builtin_bit_cast(bf16x8, y); } }
    f32x4 acc[4][4], accn[4];
#pragma unroll
    for (int mb = 0; mb < 4; ++mb) { accn[mb] = (f32x4){0.f, 0.f, 0.f, 0.f};
#pragma unroll
        for (int nb = 0; nb < 4; ++nb) acc[mb][nb] = (f32x4){0.f, 0.f, 0.f, 0.f}; }
#pragma unroll
    for (int ks = 0; ks < 2; ++ks) {
        u32x4 nz = *(const u32x4*)(NP + 32 * ks + 8 * q); if (r != 0) nz = (u32x4){0u, 0u, 0u, 0u};
        const bf16x8 bn = __builtin_bit_cast(bf16x8, nz);
#pragma unroll
        for (int nb = 0; nb < 4; ++nb) { const bf16x8 bb = *(const bf16x8*)(CP + (size_t)(16 * nb + r) * 64 + 32 * ks + 8 * q);
#pragma unroll
            for (int mb = 0; mb < 4; ++mb) acc[mb][nb] = MFMA16(aq[mb][ks], bb, acc[mb][nb]); }
#pragma unroll
        for (int mb = 0; mb < 4; ++mb) accn[mb] = MFMA16(aq[mb][ks], bn, accn[mb]);
    }
#pragma unroll
    for (int s8 = 0; s8 < 8; ++s8) { float vb[8];
#pragma unroll
        for (int j = 0; j < 8; ++j) vb[j] = bf2f(V[(size_t)(s8 * 8 + j) * 64 + lane]);
        u32x4 pk; pk.x = pk_bf16(vb[0], vb[1]); pk.y = pk_bf16(vb[2], vb[3]); pk.z = pk_bf16(vb[4], vb[5]); pk.w = pk_bf16(vb[6], vb[7]);
        *(LAS u32x4*)(wl + swz_off(lane, s8)) = pk; }
    LDS_FENCE();
#pragma unroll
    for (int ks = 0; ks < 2; ++ks) {
        bf16x8 ap[4];
#pragma unroll
        for (int mb = 0; mb < 4; ++mb) ap[mb] = *(const LAS bf16x8*)(wl + 8192 + swz_off(16 * mb + r, 4 * ks + q));
#pragma unroll
        for (int nb = 0; nb < 4; ++nb) { const bf16x8 bv = *(const LAS bf16x8*)(wl + swz_off(16 * nb + r, 4 * ks + q));
#pragma unroll
            for (int mb = 0; mb < 4; ++mb) acc[mb][nb] = MFMA16(ap[mb], bv, acc[mb][nb]); }
    }
    LDS_FENCE();
    const float* gain = in->p[14] + l * 256 + hd * 64; const bf16_t* OG = (const bf16_t*)(ws + WS_PRJ + PRJ_OG);
    bf16_t* Y = (bf16_t*)(ws + WS_Y);
#pragma unroll
    for (int mb = 0; mb < 4; ++mb)
#pragma unroll
        for (int j = 0; j < 4; ++j) {
            const int jj = 16 * mb + 4 * q + j;
            const float dn = den[mb][j] + __builtin_bit_cast(float, __builtin_amdgcn_ds_bpermute((lane & 48) << 2, __builtin_bit_cast(int, accn[mb][j])));
            const float inv = 1.f / fmaxf(fabsf(dn), 1.f); float hv[4]; float ss = 0.f;
#pragma unroll
            for (int nb = 0; nb < 4; ++nb) { hv[nb] = acc[mb][nb][j] * inv; ss += hv[nb] * hv[nb]; }
            ss += __shfl_xor(ss, 1); ss += __shfl_xor(ss, 2); ss += __shfl_xor(ss, 4); ss += __shfl_xor(ss, 8);
            const float rstd = rsqrtf(ss * (1.f / 64.f) + 1e-6f); const size_t row = (size_t)b * 2048 + t0 + jj;
#pragma unroll
            for (int nb = 0; nb < 4; ++nb) { const int e = 16 * nb + r; Y[row * 1024 + 768 + hd * 64 + e] = f2bf(hv[nb] * rstd * gain[e] * sigmf(bf2f(OG[row * 256 + hd * 64 + e]))); }
        }
}

__device__ __forceinline__ void ml_scan_unit(int bh, int l, unsigned char* ws, int g_wv) {
    int tid_ = TIDX; asm volatile("" : "+v"(tid_)); const int tid = tid_;
    const bf16_t* DL = (const bf16_t*)(ws + WS_ML + ML_DELTA) + (size_t)bh * 32 * 4096 + tid * 8; bf16_t* CP = (bf16_t*)(ws + WS_ML + ML_CP) + (size_t)bh * 32 * 4096 + tid * 8;
    const float* DN = (const float*)(ws + WS_ML + ML_DN) + (size_t)bh * 32 * 64; bf16_t* NP = (bf16_t*)(ws + WS_ML + ML_NP) + (size_t)bh * 32 * 64; const float* BL = (const float*)(ws + WS_ML + ML_BL) + bh * 32;
    float c[8]; float n = 0.f;
#pragma unroll
    for (int k = 0; k < 8; ++k) c[k] = 0.f;
#pragma unroll 1
    for (int c0 = 0; c0 < 32; c0 += 8) {
        u32x4 d[8]; float dn[8], co[8];
#pragma unroll
        for (int k = 0; k < 8; ++k) { d[k] = *(const u32x4*)(DL + (size_t)(c0 + k) * 4096); dn[k] = tid < 64 ? DN[(c0 + k) * 64 + tid] : 0.f; co[k] = __expf(BL[c0 + k]); }
#pragma unroll
        for (int k = 0; k < 8; ++k) {
            u32x4 o; o.x = pk_bf16(c[0], c[1]); o.y = pk_bf16(c[2], c[3]); o.z = pk_bf16(c[4], c[5]); o.w = pk_bf16(c[6], c[7]);
            *(u32x4*)(CP + (size_t)(c0 + k) * 4096) = o; if (tid < 64) NP[(c0 + k) * 64 + tid] = f2bf(n);
            c[0] = co[k] * c[0] + bf_lo(d[k].x); c[1] = co[k] * c[1] + bf_hi(d[k].x); c[2] = co[k] * c[2] + bf_lo(d[k].y); c[3] = co[k] * c[3] + bf_hi(d[k].y);
            c[4] = co[k] * c[4] + bf_lo(d[k].z); c[5] = co[k] * c[5] + bf_hi(d[k].z); c[6] = co[k] * c[6] + bf_lo(d[k].w); c[7] = co[k] * c[7] + bf_hi(d[k].w);
            n = co[k] * n + dn[k];
        }
    }
    asm volatile("s_waitcnt vmcnt(0)" ::: "memory"); __syncthreads();
    if (tid == 0) { __builtin_amdgcn_fence(__ATOMIC_RELEASE, "agent"); asm volatile("s_waitcnt vmcnt(0)" ::: "memory");
        __hip_atomic_fetch_add((unsigned*)(ws + WS_CTL) + CW_SCAN + 64 * l, 1u, __ATOMIC_RELAXED, __HIP_MEMORY_SCOPE_AGENT); }
}
__device__ __forceinline__ void ml_scan_wait(int l, unsigned char* ws, int g_wv) {
    if (TIDX == 0) { unsigned* p = (unsigned*)(ws + WS_CTL) + CW_SCAN + 64 * l; unsigned sp = 0;
        while (__hip_atomic_load(p, __ATOMIC_RELAXED, __HIP_MEMORY_SCOPE_AGENT) < 32u) { __builtin_amdgcn_s_sleep(2); if (++sp > (1u << 22)) break; }
        __builtin_amdgcn_fence(__ATOMIC_ACQUIRE, "agent"); asm volatile("s_waitcnt vmcnt(0)" ::: "memory"); }
    __syncthreads();
}

#ifndef DUP_NSA
#define DUP_NSA 1
#endif
#ifndef DUP_MLA
#define DUP_MLA 1
#endif
#ifndef DUP_ML
#define DUP_ML 1
#endif
#ifdef NO_MLA
#define MLA_CALL(...) do {} while (0)
#else
#define MLA_CALL(...) do { for (int rp = 0; rp < DUP_MLA; ++rp) { if (rp) __syncthreads(); mla_unit(__VA_ARGS__); } } while (0)
#endif
__device__ __forceinline__ void phase_mix(int l, InPtr in, unsigned char* ws, LAS unsigned char* lds, unsigned* qhead, int g_wv) {
    LAS int* slot = (LAS int*)(lds + LDS_MISC + 64);
    for (;;) {
        __syncthreads();
        if (TIDX == 0) *slot = (int)__hip_atomic_fetch_add(qhead, 1u, __ATOMIC_RELAXED, __HIP_MEMORY_SCOPE_AGENT);
        __syncthreads();
        int u = *slot;
        if (u >= 32 + 512 + 384 + 128) break;
        if (u < 32) { ml_scan_unit(u, l, ws, g_wv); continue; } u -= 32;
#ifndef NO_NSA
        if (u < 256) { const int i = 31 - (u >> 4), bh = u & 15; { for (int rp = 0; rp < DUP_NSA; ++rp) { if (rp) __syncthreads(); nsa_unit(bh >> 1, bh & 1, i, l, in, ws, lds, g_wv); } } continue; }
#endif
        u -= 256;
        if (u < 192) { const int qt = 7 - u / 48, bh = u % 48; MLA_CALL(bh / 6, bh % 6, qt, l, ws, lds, g_wv); continue; }
        u -= 192;
#ifndef NO_NSA
        if (u < 128) { const int i = 15 - (u >> 4), bh = u & 15; { for (int rp = 0; rp < DUP_NSA; ++rp) { if (rp) __syncthreads(); nsa_unit(bh >> 1, bh & 1, i, l, in, ws, lds, g_wv); } } continue; }
#endif
        u -= 128;
        if (u < 192) { const int qt = 3 - u / 48, bh = u % 48; MLA_CALL(bh / 6, bh % 6, qt, l, ws, lds, g_wv); continue; } u -= 192;
#ifndef NO_NSA
        if (u < 128) { const int i = 7 - (u >> 4), bh = u & 15; { for (int rp = 0; rp < DUP_NSA; ++rp) { if (rp) __syncthreads(); nsa_unit(bh >> 1, bh & 1, i, l, in, ws, lds, g_wv); } } continue; }
#endif
        u -= 128;
#ifndef NO_MLOUT
        ml_scan_wait(l, ws, g_wv);
        for (int rp = 0; rp < DUP_ML; ++rp) { int tid_ = TIDX; asm volatile("" : "+v"(tid_)); const int w = tid_ >> 6; ml_out_wave(u * 8 + w, l, in, ws, lds + w * 16384, lds + 131072 + w * 256, tid_ & 63); }
#endif
    }
}
__device__ __forceinline__ void phase_ynorm(int l, unsigned char* ws, int bid, int nb, int g_wv) {
    int tid_ = TIDX; asm volatile("" : "+v"(tid_)); const int w = tid_ >> 6, lane = tid_ & 63;
    bf16_t* Y = (bf16_t*)(ws + WS_Y); const float* sa = (const float*)(ws + WS_SSQ + PT_A) + (size_t)l * 16384 * 8; const float* sc = (const float*)(ws + WS_SSQ + PT_C) + (size_t)l * 16384 * 8;
    for (int r0 = (bid * 8 + w) * 8; r0 < NTOK; r0 += nb * 64) {
        if (lane < 48) {
            u32x4 x[8], y[8]; float ra[8], rc[8];
#pragma unroll
            for (int k = 0; k < 8; ++k) { const int row = r0 + k;
                const f32x4 a0 = *(const f32x4*)(sa + (size_t)row * 8), a1 = *(const f32x4*)(sa + (size_t)row * 8 + 4), c0 = *(const f32x4*)(sc + (size_t)row * 8), c1 = *(const f32x4*)(sc + (size_t)row * 8 + 4);
                ra[k] = rsqrtf((((a0.x + a0.y) + (a0.z + a0.w)) + (a1.x + a1.y)) * (1.f / 384.f) + 1e-6f); rc[k] = rsqrtf((((c0.x + c0.y) + (c0.z + c0.w)) + (c1.x + c1.y)) * (1.f / 384.f) + 1e-6f);
                x[k] = *((const u32x4*)(Y + (size_t)row * 1024) + lane); y[k] = *((const u32x4*)(Y + (size_t)row * 1024 + 384) + lane); }
#pragma unroll
            for (int k = 0; k < 8; ++k) { const int row = r0 + k; u32x4 a = x[k], c = y[k]; const float fa = ra[k], fc = rc[k];
                a.x = pk_bf16(bf_lo(a.x) * fa, bf_hi(a.x) * fa); a.y = pk_bf16(bf_lo(a.y) * fa, bf_hi(a.y) * fa); a.z = pk_bf16(bf_lo(a.z) * fa, bf_hi(a.z) * fa); a.w = pk_bf16(bf_lo(a.w) * fa, bf_hi(a.w) * fa);
                c.x = pk_bf16(bf_lo(c.x) * fc, bf_hi(c.x) * fc); c.y = pk_bf16(bf_lo(c.y) * fc, bf_hi(c.y) * fc); c.z = pk_bf16(bf_lo(c.z) * fc, bf_hi(c.z) * fc); c.w = pk_bf16(bf_lo(c.w) * fc, bf_hi(c.w) * fc);
                *((u32x4*)(Y + (size_t)row * 1024) + lane) = a; *((u32x4*)(Y + (size_t)row * 1024 + 384) + lane) = c; }
        }
    }
}
constexpr int LDS_FAC = 131072 + 2048;
__device__ __forceinline__ void outproj_factors(int l, unsigned char* ws, LAS unsigned char* lds, int pm, int tid) {
    asm volatile("" : "+v"(tid));
    if (tid < 256) { const int row = pm * 256 + tid; const float* sa = (const float*)(ws + WS_SSQ + PT_A) + ((size_t)l * 16384 + row) * 8; const float* sc = (const float*)(ws + WS_SSQ + PT_C) + ((size_t)l * 16384 + row) * 8;
        const f32x4 a0 = *(const f32x4*)sa, a1 = *(const f32x4*)(sa + 4), c0 = *(const f32x4*)sc, c1 = *(const f32x4*)(sc + 4);
        const float ra = rsqrtf((((a0.x + a0.y) + (a0.z + a0.w)) + (a1.x + a1.y)) * (1.f / 384.f) + 1e-6f), rc = rsqrtf((((c0.x + c0.y) + (c0.z + c0.w)) + (c1.x + c1.y)) * (1.f / 384.f) + 1e-6f);
        LAS float* F = (LAS float*)(lds + LDS_FAC); F[2 * tid] = ra / rc; F[2 * tid + 1] = rc; }
    __syncthreads();
}
struct EpiOut {
    static constexpr bool KHOOK = true;
    bf16_t* XB; float* ssq; const LAS float* F; bool fold;
    __device__ __forceinline__ void kscale(f32x4 (&acc)[2][2][4][2], int which, int wr, int fr) const {
        if (!fold) return;
#pragma unroll
        for (int ai = 0; ai < 2; ++ai)
#pragma unroll
            for (int m = 0; m < 4; ++m) { const float f = F[2 * (ai * 128 + wr * 64 + m * 16 + fr) + which];
#pragma unroll
                for (int bj = 0; bj < 2; ++bj)
#pragma unroll
                    for (int n = 0; n < 2; ++n) acc[ai][bj][m][n] = acc[ai][bj][m][n] * f; }
    }
    __device__ __forceinline__ void operator()(const f32x4 (&acc)[2][2][4][2], const GUnit& u, int wr, int wc, int fr, int fq) const {
#pragma unroll
        for (int ai = 0; ai < 2; ++ai)
#pragma unroll
          for (int mh = 0; mh < 2; ++mh) {
            __builtin_amdgcn_sched_barrier(0);
            u32x4 xr[2][2];
#pragma unroll
            for (int m2 = 0; m2 < 2; ++m2)
#pragma unroll
                for (int bj = 0; bj < 2; ++bj) xr[m2][bj] = *(const u32x4*)(XB + (size_t)(u.pm * 256 + ai * 128 + wr * 64 + (2 * mh + m2) * 16 + fr) * 1024 + u.pn * 256 + bj * 128 + wc * 32 + 8 * fq);
#pragma unroll
            for (int m2 = 0; m2 < 2; ++m2) {
                const int m = 2 * mh + m2; const int row = u.pm * 256 + ai * 128 + wr * 64 + m * 16 + fr; float ss = 0.f;
#pragma unroll
                for (int bj = 0; bj < 2; ++bj) {
                    const u32x4 x = xr[m2][bj]; u32x4 o;
                    o.x = pk_bf16(bf_lo(x.x) + acc[ai][bj][m][0][0], bf_hi(x.x) + acc[ai][bj][m][0][1]); o.y = pk_bf16(bf_lo(x.y) + acc[ai][bj][m][0][2], bf_hi(x.y) + acc[ai][bj][m][0][3]);
                    o.z = pk_bf16(bf_lo(x.z) + acc[ai][bj][m][1][0], bf_hi(x.z) + acc[ai][bj][m][1][1]); o.w = pk_bf16(bf_lo(x.w) + acc[ai][bj][m][1][2], bf_hi(x.w) + acc[ai][bj][m][1][3]);
                    *(u32x4*)(XB + (size_t)row * 1024 + u.pn * 256 + bj * 128 + wc * 32 + 8 * fq) = o;
                    ss += (bf_lo(o.x) * bf_lo(o.x) + bf_hi(o.x) * bf_hi(o.x)) + (bf_lo(o.y) * bf_lo(o.y) + bf_hi(o.y) * bf_hi(o.y)) + (bf_lo(o.z) * bf_lo(o.z) + bf_hi(o.z) * bf_hi(o.z)) + (bf_lo(o.w) * bf_lo(o.w) + bf_hi(o.w) * bf_hi(o.w));
                }
                ss = quad_sum(ss); if (fq == 0) ssq[(size_t)row * 16 + u.pn * 4 + wc] = ss;
            }
          }
    }
};

__device__ __forceinline__ float sum16(const float* p) { const f32x4 a = *(const f32x4*)p, b = *(const f32x4*)(p + 4), c = *(const f32x4*)(p + 8), d = *(const f32x4*)(p + 12);
    return (((a.x + a.y) + (a.z + a.w)) + ((b.x + b.y) + (b.z + b.w))) + (((c.x + c.y) + (c.z + c.w)) + ((d.x + d.y) + (d.z + d.w))); }
__device__ __forceinline__ void phase_route(int l, InPtr in, unsigned char* ws, LAS unsigned char* lds, int bid, int nb, int g_wv) {
    int tid_ = TIDX; asm volatile("" : "+v"(tid_)); const int w = tid_ >> 6, lane = tid_ & 63, r = lane & 15, q = lane >> 4;
    const bf16_t* XB = (const bf16_t*)(ws + WS_XB); const bf16_t* WR = (const bf16_t*)(ws + WS_WR) + (size_t)l * 64 * 1024;
    const float* ssq = (const float*)(ws + WS_SSQ + PT_X1) + (size_t)l * 16384 * 16; const float* bg = in->p[24] + l * 4; const float* be = in->p[26] + l * 32;
    unsigned* cnt = (unsigned*)(ws + WS_CTL) + CW_CNT + 2048 * l; unsigned* mtok = (unsigned*)(ws + WS_META); float* mw = (float*)(ws + WS_META + META_W);
    LAS float* lg = (LAS float*)(lds + w * 4096);
    LAS unsigned* lcnt = (LAS unsigned*)(lds + 32768); LAS unsigned* lbase = lcnt + 32;
    for (int g0 = bid * 8; g0 < NTOK / 16; g0 += nb * 8) {
        if (tid_ < 32) lcnt[tid_] = 0u;
        __syncthreads();
        const int tok0 = (g0 + w) * 16; f32x4 acc[3];
#pragma unroll
        for (int n = 0; n < 3; ++n) acc[n] = (f32x4){0.f, 0.f, 0.f, 0.f};
        const bf16_t* ap = XB + (size_t)(tok0 + r) * 1024 + 8 * q; const bf16_t* bp = WR + (size_t)r * 1024 + 8 * q;
#pragma unroll 8
        for (int ks = 0; ks < 32; ++ks) { const bf16x8 a = *(const bf16x8*)(ap + 32 * ks);
#pragma unroll
            for (int n = 0; n < 3; ++n) { const bf16x8 bb = *(const bf16x8*)(bp + (size_t)n * 16 * 1024 + 32 * ks); acc[n] = MFMA16(a, bb, acc[n]); } }
#pragma unroll
        for (int n = 0; n < 3; ++n)
#pragma unroll
            for (int j = 0; j < 4; ++j) lg[(4 * q + j) * 48 + 16 * n + r] = acc[n][j];
        LDS_FENCE();
        int E0 = 0, E1 = 0; unsigned r0 = 0, r1 = 0; float wt0 = 0.f, wt1 = 0.f; const int tok = tok0 + (lane & 15);
        if (lane < 16) {
            const float rs = rsqrtf(sum16(ssq + (size_t)tok * 16) * (1.f / 1024.f) + 1e-6f); ((float*)(ws + WS_RS2))[tok] = rs; const LAS float* L = lg + lane * 48;
            float gl[4]; int gi = 0;
#pragma unroll
            for (int j = 0; j < 4; ++j) gl[j] = L[j] * rs + bg[j];
            float gm = gl[0];
#pragma unroll
            for (int j = 1; j < 4; ++j) if (gl[j] > gm) { gm = gl[j]; gi = j; }
            float gsum = 0.f;
#pragma unroll
            for (int j = 0; j < 4; ++j) gsum += __expf(gl[j] - gm);
            const float gtop = 1.f / gsum;
            float el[8];
#pragma unroll
            for (int j = 0; j < 8; ++j) el[j] = L[4 + gi * 8 + j] * rs + be[gi * 8 + j];
            int e0 = 0; float v0 = el[0];
#pragma unroll
            for (int j = 1; j < 8; ++j) if (el[j] > v0) { v0 = el[j]; e0 = j; }
            int e1 = -1; float v1 = -3.0e38f;
#pragma unroll
            for (int j = 0; j < 8; ++j) if (j != e0 && el[j] > v1) { v1 = el[j]; e1 = j; }
            const float w0 = 1.f / (1.f + __expf(v1 - v0)); E0 = gi * 8 + e0; E1 = gi * 8 + e1; wt0 = w0 * gtop; wt1 = (1.f - w0) * gtop;
            r0 = __hip_atomic_fetch_add(lcnt + E0, 1u, __ATOMIC_RELAXED, __HIP_MEMORY_SCOPE_WORKGROUP); r1 = __hip_atomic_fetch_add(lcnt + E1, 1u, __ATOMIC_RELAXED, __HIP_MEMORY_SCOPE_WORKGROUP);
        }
        __syncthreads();
        if (tid_ < 32) { const unsigned c = lcnt[tid_]; lbase[tid_] = c ? atomicAdd(cnt + tid_ * 64, c) : 0u; }
        __syncthreads();
        if (lane < 16) {
            const unsigned p0 = lbase[E0] + r0, p1 = lbase[E1] + r1;
            mtok[(size_t)E0 * 16384 + p0] = (unsigned)tok; mw[(size_t)E0 * 16384 + p0] = wt0;
            mtok[(size_t)E1 * 16384 + p1] = (unsigned)tok | 0x80000000u; mw[(size_t)E1 * 16384 + p1] = wt1;
        }
        __syncthreads();
    }
}

constexpr int LDS_TB = 131072 + 2048;
__device__ __forceinline__ void moe_tables(int l, unsigned char* ws, LAS unsigned char* lds, int g_wv) {
    int tix = TIDX; asm volatile("" : "+v"(tix));
    LAS int* tb = (LAS int*)(lds + LDS_TB);
    if (tix < 32) { const unsigned* cnt = (const unsigned*)(ws + WS_CTL) + CW_CNT + 2048 * l; tb[160 + tix] = (int)__hip_atomic_load(cnt + tix * 64, __ATOMIC_RELAXED, __HIP_MEMORY_SCOPE_AGENT); }
    __syncthreads();
    if (tix == 0) { int a = 0, f = 0, p = 0; for (int e = 0; e < 32; ++e) { const int c = tb[160 + e]; tb[e] = a; tb[48 + e] = f; tb[96 + e] = p; a += (c + 255) >> 8; f += c >> 8; p += (c & 255) ? 1 : 0; } tb[32] = a; tb[80] = f; tb[128] = p; }
    __syncthreads();
}
template <int NPN, bool GATHER_>
struct MoeSched {
    static constexpr bool GATHER = GATHER_, PARTIAL = false;
    const char* A; const char* Bt; const unsigned* cnt; const unsigned* mtok; const LAS int* tb; int G, c; size_t bstride_e  , bstride_pn;
    __device__ __forceinline__ bool next(int i, GUnit& u) const {
        const int L = i * G + c; const int ntile = tb[32]; if (L >= ntile * NPN) return false;
        const int tile = L / NPN, pn = L % NPN;
        int e = 0;
        for (int k = 1; k < 32; ++k) e = (tb[k] <= tile) ? k : e;
        e = __builtin_amdgcn_readfirstlane(e);
        u.e = e; u.pm = tile; u.pn = pn; u.rows = tb[160 + e] - 256 * (tile - tb[e]);
        u.a = GATHER ? A : A + (size_t)tile * 256 * 256 * 2;
        u.b = Bt + (size_t)e * bstride_e + (size_t)pn * bstride_pn; return true;
    }
    __device__ __forceinline__ void aoff(const GUnit& u, unsigned (&v)[2][2], const int (&R)[2], const int (&C)[2]) const {
#pragma unroll
        for (int h = 0; h < 2; ++h)
#pragma unroll
            for (int i = 0; i < 2; ++i) {
                if (GATHER) { const int lr = h * 128 + R[i]; const int rr = 256 * (u.pm - tb[u.e]) + (lr < u.rows ? lr : 0); const unsigned tok = mtok[(size_t)u.e * 16384 + rr] & 0x7fffffffu; v[h][i] = (tok * 1024u + (unsigned)C[i]) * 2u; }
                else v[h][i] = (unsigned)((h * 128 + R[i]) * 256 + C[i]) * 2u;
            }
    }
};
struct EpiMoeUp {
    static constexpr bool KHOOK = false;
    const unsigned* mtok; const float* ssq; const LAS int* tb; bf16_t* HB;
    __device__ __forceinline__ void operator()(const f32x4 (&acc)[2][2][4][2], const GUnit& u, int wr, int wc, int fr, int fq) const {
        const int r0 = 256 * (u.pm - tb[u.e]);
        float rs8[8];
        { unsigned tk[8];
#pragma unroll
          for (int k = 0; k < 8; ++k) { const int lr = (k >> 2) * 128 + wr * 64 + (k & 3) * 16 + fr; tk[k] = mtok[(size_t)u.e * 16384 + r0 + (lr < u.rows ? lr : 0)] & 0x7fffffffu; }
#pragma unroll
          for (int k = 0; k < 8; ++k) rs8[k] = ssq[tk[k]]; }
#pragma unroll
        for (int ai = 0; ai < 2; ++ai)
#pragma unroll
            for (int m = 0; m < 4; ++m) {
                __builtin_amdgcn_sched_barrier(0);
                const int lr = ai * 128 + wr * 64 + m * 16 + fr;
                if (lr < u.rows) {
                    const float rs = rs8[ai * 4 + m];
                    float hv[8];
#pragma unroll
                    for (int n = 0; n < 2; ++n)
#pragma unroll
                        for (int j = 0; j < 4; ++j) { const float gv = acc[ai][0][m][n][j] * rs, uv = acc[ai][1][m][n][j] * rs; hv[4 * n + j] = siluf(gv) * uv; }
                    st_bf16x8(HB + ((size_t)u.pm * 256 + lr) * 256 + u.pn * 128 + wc * 32 + 8 * fq, hv);
                }
            }
    }
};
struct EpiMoeDown {
    static constexpr bool KHOOK = false;
    const unsigned* mtok; const float* mw; const LAS int* tb; bf16_t* YB;
    __device__ __forceinline__ void operator()(const f32x4 (&acc)[2][2][4][2], const GUnit& u, int wr, int wc, int fr, int fq) const {
        const int r0 = 256 * (u.pm - tb[u.e]);
        unsigned mt8[8]; float wt8[8];
#pragma unroll
        for (int k = 0; k < 8; ++k) { const int lr = (k >> 2) * 128 + wr * 64 + (k & 3) * 16 + fr; const size_t ix = (size_t)u.e * 16384 + r0 + (lr < u.rows ? lr : 0); mt8[k] = mtok[ix]; wt8[k] = mw[ix]; }
#pragma unroll
        for (int ai = 0; ai < 2; ++ai)
#pragma unroll
            for (int m = 0; m < 4; ++m) {
                __builtin_amdgcn_sched_barrier(0);
                const int lr = ai * 128 + wr * 64 + m * 16 + fr;
                if (lr < u.rows) {
                    const unsigned mt = mt8[ai * 4 + m]; const float wt = wt8[ai * 4 + m];
                    bf16_t* dst = YB + ((size_t)(mt >> 31) * 16384 + (mt & 0x7fffffffu)) * 1024 + u.pn * 256 + wc * 32 + 8 * fq;
#pragma unroll
                    for (int bj = 0; bj < 2; ++bj) { float v[8];
#pragma unroll
                        for (int n = 0; n < 2; ++n)
#pragma unroll
                            for (int j = 0; j < 4; ++j) v[4 * n + j] = acc[ai][bj][m][n][j] * wt;
                        st_bf16x8(dst + bj * 128, v); }
                }
            }
    }
};
__device__ __forceinline__ void phase_combine(int l, unsigned char* ws, float* out, int bid, int nb, int g_wv) {
    int tid_ = TIDX; asm volatile("" : "+v"(tid_)); const int w = tid_ >> 6, lane = tid_ & 63;
    bf16_t* XB = (bf16_t*)(ws + WS_XB); const bf16_t* Y0 = (const bf16_t*)(ws + WS_YBUF); const bf16_t* Y1 = Y0 + (size_t)16384 * 1024; float* ssqx = (float*)(ws + WS_SSQX) + 16384;
    for (int row = bid * 8 + w; row < NTOK; row += nb * 8) {
        float ss = 0.f;
#pragma unroll
        for (int k = 0; k < 2; ++k) {
            const size_t o = (size_t)row * 1024 + (lane + 64 * k) * 8;
            const u32x4 x = *(const u32x4*)(XB + o), a = *(const u32x4*)(Y0 + o), c = *(const u32x4*)(Y1 + o);
            float v[8] = { bf_lo(x.x) + bf_lo(a.x) + bf_lo(c.x), bf_hi(x.x) + bf_hi(a.x) + bf_hi(c.x), bf_lo(x.y) + bf_lo(a.y) + bf_lo(c.y), bf_hi(x.y) + bf_hi(a.y) + bf_hi(c.y),
                           bf_lo(x.z) + bf_lo(a.z) + bf_lo(c.z), bf_hi(x.z) + bf_hi(a.z) + bf_hi(c.z), bf_lo(x.w) + bf_lo(a.w) + bf_lo(c.w), bf_hi(x.w) + bf_hi(a.w) + bf_hi(c.w) };
            if (l == L_ - 1 && out) { *(f32x4*)(out + o) = (f32x4){v[0], v[1], v[2], v[3]}; *(f32x4*)(out + o + 4) = (f32x4){v[4], v[5], v[6], v[7]}; }
            else { u32x4 p; p.x = pk_bf16(v[0], v[1]); p.y = pk_bf16(v[2], v[3]); p.z = pk_bf16(v[4], v[5]); p.w = pk_bf16(v[6], v[7]); *(u32x4*)(XB + o) = p;
#pragma unroll
                   for (int j = 0; j < 4; ++j) { const unsigned q = j == 0 ? p.x : (j == 1 ? p.y : (j == 2 ? p.z : p.w)); ss += bf_lo(q) * bf_lo(q) + bf_hi(q) * bf_hi(q); } }
        }
        if (l < L_ - 1) { ss = wave_sum(ss); if (lane == 0) ssqx[row] = ss; }
    }
}
constexpr int MOE_CVT_SPLIT = 4608;
constexpr int NPH = 9;
enum { PH_INPROJ = 0, PH_PREP, PH_MIX, PH_YNORM, PH_OUTPROJ, PH_ROUTE, PH_MOEUP, PH_MOEDOWN, PH_COMBINE };
struct Args { Inputs in; float* out; unsigned char* ws; int ph_lo, ph_hi; };

__global__ void __launch_bounds__(512, 2) mk(Args args) {
    extern __shared__ __attribute__((aligned(16))) unsigned char lds_raw[];
    LAS unsigned char* lds = (LAS unsigned char*)lds_raw;
    const int g_wv = __builtin_amdgcn_readfirstlane((int)threadIdx.x >> 6);
    const int bid0 = blockIdx.x, nb = gridDim.x;
#define BID() ({ int b_ = bid0; asm volatile("" : "+s"(b_)); b_; })
    unsigned char* ws = args.ws; unsigned* ctl = (unsigned*)(ws + WS_CTL);
    const int lo = args.ph_lo, hi = args.ph_hi;
    if (TIDX < 4) ((LAS unsigned*)(lds + LDS_MISC))[TIDX] = 0u;
    __syncthreads();
    XcdBarrier bar; bar.g_wv = g_wv; bar.bar = ctl + CW_BAR; bar.x = 0; bar.st = nullptr;
    if (hi - lo > 1) bar = xcd_barrier_post(ctl + CW_BAR, (volatile LAS unsigned*)(lds + LDS_MISC), g_wv);
#define IN(k) (lo <= (k) && (k) < hi)
#ifndef REPEAT_PH
#define REPEAT_PH -1
#endif
#define NREP(k) ((REPEAT_PH == (k)) ? 2 : 1)
#ifndef NBAR
#define NBAR 1
#endif
#ifndef TIME_PH
#define TIME_PH -1
#endif
#define STAMP(i) do { if (TIME_PH != -1 && blockIdx.x == 0 && TIDX == 0) ((unsigned long long*)(ctl + CW_TS))[i] = __builtin_amdgcn_s_memrealtime(); } while (0)
#define SEAM(k) do { if (IN(k) && IN((k) + 1)) for (int nb_ = 0; nb_ < NBAR; ++nb_) xcd_barrier(bar); STAMP((k) + 1); } while (0)
    STAMP(0);
#ifndef NO_PRO
    if (IN(0)) for (int rep = 0; rep < NREP(100); ++rep) { prologue(in_tab(), launder(ws), lds, BID(), nb, g_wv); if (rep + 1 < NREP(100)) xcd_barrier(bar); }
#endif
    SEAM(0);
    for (int l = 0; l < L_; ++l) {
        const int pb = 1 + l * NPH;
        if (IN(pb + PH_INPROJ)) for (int rep = 0; rep < NREP(PH_INPROJ); ++rep) {
            if (rep) xcd_barrier(bar);
            InPtr in = in_tab(); unsigned char* ws = launder(args.ws);
            g8::DenseSched S{(const char*)(ws + WS_XB), (const char*)(ws + WS_WIN) + (size_t)l * 2560 * 1024 * 2, 1024, 1024, 64, 10, nb, BID()};
            EpiInProj E{(const float*)(ws + WS_SSQX) + l * 16384, (float*)(ws + WS_SSQ + PT_DQ) + (size_t)l * 16384 * 4, (float*)(ws + WS_SSQ + PT_DKV) + (size_t)l * 16384 * 2,
                        in->p[8] + l * 64, in->p[9] + l * 64, in->p[19] + l * 192 + 96 + 64, (const float*)(ws + WS_ROPE), ws + WS_PRJ};
#ifndef NO_INPROJ
            g8::gemm_run(lds, 1024, 1024, S, E, g_wv);
#endif
        }
        SEAM(pb + PH_INPROJ);
        if (IN(pb + PH_PREP)) for (int rep = 0; rep < NREP(PH_PREP); ++rep) { if (rep) xcd_barrier(bar); phase_prep(l, in_tab(), launder(ws), lds, BID(), nb, g_wv, (unsigned*)launder(ws) + CW_Q + 64 * (4 + l + 2 * rep)); }
        SEAM(pb + PH_PREP);
        if (IN(pb + PH_MIX)) for (int rep = 0; rep < NREP(PH_MIX); ++rep) { if (rep) xcd_barrier(bar); phase_mix(l, in_tab(), launder(ws), lds, (unsigned*)launder(ws) + CW_Q + 64 * (l + 2 * rep), g_wv); }
        SEAM(pb + PH_MIX);
        const bool fold_norm = (nb == 256);
        if (IN(pb + PH_YNORM) && !fold_norm) phase_ynorm(l, launder(ws), BID(), nb, g_wv);
        if (!fold_norm) SEAM(pb + PH_YNORM);
        if (IN(pb + PH_OUTPROJ)) {
            unsigned char* ws = launder(args.ws);
            g8::DenseSched S{(const char*)(ws + WS_Y), (const char*)(ws + WS_WOUT) + (size_t)l * 1024 * 1024 * 2, 1024, 1024, 64, 4, nb, BID()};
            EpiOut E{(bf16_t*)(ws + WS_XB), (float*)(ws + WS_SSQ + PT_X1) + (size_t)l * 16384 * 16, (const LAS float*)(lds + LDS_FAC), fold_norm};
            if (fold_norm) { g8::GUnit u0; if (S.next(0, u0)) outproj_factors(l, ws, lds, u0.pm, TIDX); else __syncthreads(); }
#ifndef NO_OUTPROJ
            g8::gemm_run(lds, 1024, 1024, S, E, g_wv);
#endif
        }
        SEAM(pb + PH_OUTPROJ);
#ifndef NO_ROUTE
        if (IN(pb + PH_ROUTE)) {
            const int b_ = BID();
            if (nb >= 256 && b_ >= 128) cvt_moe_layer(in_tab(), launder(ws), l, (LAS float*)lds, b_ - 128, nb - 128, TIDX);
            else { phase_route(l, in_tab(), launder(ws), lds, b_, nb >= 256 ? 128 : nb, g_wv); if (nb < 256) cvt_moe_layer(in_tab(), launder(ws), l, (LAS float*)lds, b_, nb, TIDX); }
            if (l + 1 < L_) { __syncthreads(); cvt_small_weights(in_tab(), launder(ws), l + 1, (LAS float*)lds, b_, nb, TIDX); }
        }
#endif
        SEAM(pb + PH_ROUTE);
        if (IN(pb + PH_MOEUP)) for (int rep = 0; rep < NREP(PH_MOEUP); ++rep) {
            if (rep) xcd_barrier(bar);
            unsigned char* ws = launder(args.ws); moe_tables(l, ws, lds, g_wv);
            const unsigned* cnt = (const unsigned*)(ws + WS_CTL) + CW_CNT + 2048 * l; const unsigned* mtok = (const unsigned*)(ws + WS_META); const LAS int* tb = (const LAS int*)(lds + LDS_TB);
            MoeSched<2, true> S{(const char*)(ws + WS_XB), (const char*)(ws + WS_WMOE), cnt, mtok, tb, nb, BID(), (size_t)512 * 1024 * 2, (size_t)256 * 1024 * 2};
            EpiMoeUp E{mtok, (const float*)(ws + WS_RS2), tb, (bf16_t*)(ws + WS_HBUF)};
#ifndef NO_MOEUP
            g8::gemm_run(lds, 1024, 1024, S, E, g_wv);
#endif
        }
        SEAM(pb + PH_MOEUP);
        if (IN(pb + PH_MOEDOWN)) for (int rep = 0; rep < NREP(PH_MOEDOWN); ++rep) {
            if (rep) xcd_barrier(bar);
            unsigned char* ws = launder(args.ws); moe_tables(l, ws, lds, g_wv);
            const unsigned* cnt = (const unsigned*)(ws + WS_CTL) + CW_CNT + 2048 * l; const unsigned* mtok = (const unsigned*)(ws + WS_META); const LAS int* tb = (const LAS int*)(lds + LDS_TB);
            MoeSched<4, false> S{(const char*)(ws + WS_HBUF), (const char*)(ws + WS_WMOE + WMOE_WD), cnt, mtok, tb, nb, BID(), (size_t)1024 * 256 * 2, (size_t)256 * 256 * 2};
            EpiMoeDown E{mtok, (const float*)(ws + WS_META + META_W), tb, (bf16_t*)(ws + WS_YBUF)};
#ifndef NO_MOEDOWN
            g8::gemm_run(lds, 256, 256, S, E, g_wv);
#endif
        }
        SEAM(pb + PH_MOEDOWN);
#ifndef NO_COMBINE
        if (IN(pb + PH_COMBINE)) { unsigned char* ws = launder(args.ws); phase_combine(l, ws, args.out, BID(), nb, g_wv); }
#endif
        SEAM(pb + PH_COMBINE);
    }
#undef IN
#undef SEAM
}
#if CHECK
struct NvScratch { float *proj, *h1, *qk, *hraw, *kn, *kcmp, *vcmp, *dqn, *q, *dkvn, *kv, *krope, *y, *x1, *xl; int* rt_e; float* rt_w; };
constexpr int CB = 5;
enum { NS_INPROJ = 0, NS_NSAPREP, NS_MLAPREP, NS_NSA, NS_ML, NS_MLA, NS_OUT, NS_ROUTE, NS_MOE };
static void naive_step(void* const* d_in, int l, int step, const float* xin, float* xout, const NvScratch& S, hipStream_t st) {
    const int b = CB;
    const float* rel_bias = (const float*)d_in[2];
    const float* norm1_g = (const float*)d_in[3] + (long)l * 1024;
    const float* w_in = (const float*)d_in[4] + (long)l * 1024 * DIN;
    const float* cmp_pe = (const float*)d_in[5] + (long)l * 2 * 32 * 64;
    const float* cmp_w1 = (const float*)d_in[6] + (long)l * 2 * 32 * 64 * 64;
    const float* cmp_w2 = (const float*)d_in[7] + (long)l * 2 * 64 * 64;
    const float* q_norm = (const float*)d_in[8] + l * 64;
    const float* k_norm = (const float*)d_in[9] + l * 64;
    const float* nsa_on = (const float*)d_in[10] + l * 384;
    const float* conv = (const float*)d_in[11] + l * 4 * 512;
    const float* ibias = (const float*)d_in[12] + l * 4;
    const float* fbias = (const float*)d_in[13] + l * 4;
    const float* ml_on = (const float*)d_in[14] + l * 256;
    const float* qan = (const float*)d_in[15] + l * 192;
    const float* w_uq = (const float*)d_in[16] + (long)l * 192 * 576;
    const float* kvan = (const float*)d_in[17] + l * 128;
    const float* w_ukv = (const float*)d_in[18] + (long)l * 128 * 768;
    const float* qkn = (const float*)d_in[19] + l * 192;
    const float* mla_on = (const float*)d_in[20] + l * 384;
    const float* w_out = (const float*)d_in[21] + (long)l * 1024 * 1024;
    const float* norm2_g = (const float*)d_in[22] + l * 1024;
    const float* wgrp = (const float*)d_in[23] + (long)l * 1024 * 4;
    const float* bgrp = (const float*)d_in[24] + l * 4;
    const float* wexp = (const float*)d_in[25] + (long)l * 1024 * 32;
    const float* bexp = (const float*)d_in[26] + l * 32;
    const float* Wg = (const float*)d_in[27] + (long)l * 32 * 1024 * 256;
    const float* Wu = (const float*)d_in[28] + (long)l * 32 * 1024 * 256;
    const float* Wd = (const float*)d_in[29] + (long)l * 32 * 256 * 1024;
    const int* pos = (const int*)d_in[1] + b * 2048;
    switch (step) {
    case NS_INPROJ:
        nv_rmsnorm<<<dim3(2048, 1), 64, 0, st>>>(xin, 1024, 0, S.h1, 1024, 0, norm1_g, 0, 1024);
        nv_gemm<<<dim3((DIN + 63) / 64, 2048 / 64), 256, 0, st>>>(S.h1, 1024, w_in, DIN, S.proj, DIN, nullptr, 0, 2048, DIN, 1024);
        break;
    case NS_NSAPREP:
        nv_nsa_cmp<<<dim3(127, 2, 2), 64, 0, st>>>(S.proj, cmp_pe, cmp_w1, cmp_w2, k_norm, S.kcmp, S.vcmp);
        nv_nsa_knorm<<<dim3(2048, 4), 64, 0, st>>>(S.proj, k_norm, S.kn);
        break;
    case NS_MLAPREP:
        nv_rmsnorm<<<dim3(2048, 1), 64, 0, st>>>(S.proj + O_CDQ, DIN, 0, S.dqn, 192, 0, qan, 0, 192);
        nv_gemm<<<dim3(576 / 64, 2048 / 64), 256, 0, st>>>(S.dqn, 192, w_uq, 576, S.q, 576, nullptr, 0, 2048, 576, 192);
        nv_rmsnorm<<<dim3(2048, 1), 64, 0, st>>>(S.proj + O_CDKV, DIN, 0, S.dkvn, 128, 0, kvan, 0, 128);
        nv_gemm<<<dim3(768 / 64, 2048 / 64), 256, 0, st>>>(S.dkvn, 128, w_ukv, 768, S.kv, 768, nullptr, 0, 2048, 768, 128);
        nv_mla_prep<<<dim3(2048, 7), 64, 0, st>>>(S.q, S.kv, S.proj, S.krope, qkn, pos);
        break;
    case NS_NSA:
        nv_nsa_attn<<<dim3(2048, 2), 192, 0, st>>>(S.proj, S.kn, S.kcmp, S.vcmp, rel_bias, q_norm, S.y);
        break;
    case NS_ML:
        nv_ml_conv<<<2048, 512, 0, st>>>(S.proj, conv, S.qk);
        nv_ml_rec<<<4, 256, 0, st>>>(S.proj, S.qk, ibias, fbias, S.hraw);
        nv_ml_fin<<<dim3(2048, 4), 64, 0, st>>>(S.proj, S.hraw, ml_on, S.y);
        break;
    case NS_MLA:
        nv_mla_attn<<<dim3(2048, 6), 64, 0, st>>>(S.q, S.kv, S.krope, S.y);
        break;
    case NS_OUT:
        nv_rmsnorm<<<dim3(2048, 1), 64, 0, st>>>(S.y, 1024, 0, S.y, 1024, 0, nsa_on, 0, 384);
        nv_rmsnorm<<<dim3(2048, 1), 64, 0, st>>>(S.y + 640, 1024, 0, S.y + 640, 1024, 0, mla_on, 0, 384);
        nv_gemm<<<dim3(1024 / 64, 2048 / 64), 256, 0, st>>>(S.y, 1024, w_out, 1024, S.x1, 1024, xin, 1024, 2048, 1024, 1024);
        break;
    case NS_ROUTE:
        nv_moe_route<<<2048, 64, 0, st>>>(S.x1, norm2_g, wgrp, bgrp, wexp, bexp, S.h1, S.rt_e, S.rt_w);
        break;
    case NS_MOE:
        nv_moe_exp<<<2048, 256, 0, st>>>(S.x1, S.h1, S.rt_e, S.rt_w, Wg, Wu, Wd, xout);
        break;
    }
}

__device__ __forceinline__ void chk_commit(float d2, float r2, float* acc) { d2 = wave_sum(d2); r2 = wave_sum(r2); if ((threadIdx.x & 63) == 0) { atomicAdd(acc, d2); atomicAdd(acc + 1, r2); } }
__device__ __forceinline__ void chk_add(float f, float r, float& d2, float& r2) { const float d = f - r; d2 += (d == d) ? d * d : 1e30f; r2 += r * r; }

__global__ void __launch_bounds__(64) chk_proj(const float* nproj, const unsigned char* prj, const float* ssq_dq, const float* ssq_dkv, const float* qg, const float* kg, const float* krg, const int* pos, float* acc) {
    const int t = blockIdx.x, e = threadIdx.x; const size_t row = (size_t)CB * 2048 + t; float d2 = 0.f, r2 = 0.f;
    for (int G = 0; G < 40; ++G) {
        const int c = inproj_refcol(G, e); float r = c < 0 ? 0.f : nproj[(size_t)t * DIN + c]; float f = 0.f;
        const float rr = (G == 37 && e >= 32) ? 0.f : r; const float ss = wave_sum(rr * rr);
        if (G < 6) { r = r * rsqrtf(ss / 64.f + 1e-6f) * qg[e] * 0.18033688f; f = bf2f(((const bf16_t*)(prj + PRJ_QN))[((size_t)(CB * 6 + G) * 2048 + t) * 64 + e]); }
        else if (G < 18) { const int a = G - 6, br = a >> 2, s = (a >> 1) & 1, hk = a & 1;
            if (br > 0 && s == 0) r = r * rsqrtf(ss / 64.f + 1e-6f) * kg[e];
            const size_t base = br == 0 ? (s ? PRJ_C0V : PRJ_C0K) : (br == 1 ? (s ? PRJ_VN1 : PRJ_KN1) : (s ? PRJ_VN2 : PRJ_KN2));
            f = bf2f(((const bf16_t*)(prj + base))[((size_t)(CB * 2 + hk) * 2048 + t) * 64 + e]); }
        else if (G < 26) f = bf2f(((const bf16_t*)(prj + PRJ_RAWQK))[row * 512 + (G - 18) * 64 + e]);
        else if (G < 30) f = bf2f(((const bf16_t*)(prj + PRJ_VML))[((size_t)(CB * 4 + (G - 26)) * 2048 + t) * 64 + e]);
        else if (G < 34) f = bf2f(((const bf16_t*)(prj + PRJ_OG))[row * 256 + (G - 30) * 64 + e]);
        else if (G < 37) f = bf2f(((const bf16_t*)(prj + PRJ_DQKV))[row * 384 + (G - 34) * 64 + e]);
        else if (G == 37) {
            const float val = e < 32 ? rr * rsqrtf(ss / 32.f + 1e-6f) * krg[e & 31] : 0.f; const float oth = __shfl_xor(val, 16);
            if (e < 32) { const int i = e & 15; const double ang = (double)pos[row] * pow(10000.0, -(double)i / 16.0); const float cs = (float)cos(ang), sn = (float)sin(ang);
                r = e < 16 ? val * cs - oth * sn : val * cs + oth * sn; f = bf2f(((const bf16_t*)(prj + PRJ_KR))[row * 32 + e]); }
            else if (e < 58) f = ((const float*)(prj + PRJ_GATES))[row * 32 + (e - 32)];
            else { f = 0.f; r = 0.f; }
        }
        else f = bf2f(((const bf16_t*)(prj + PRJ_DQKV))[row * 384 + 256 + (G - 38) * 64 + e]);
        chk_add(f, r, d2, r2);
    }
    float d2s = 0.f, r2s = 0.f;
    { float s1 = 0.f, s2 = 0.f; for (int c = e; c < 192; c += 64) { float v = nproj[(size_t)t * DIN + O_CDQ + c]; s1 += v * v; } for (int c = e; c < 128; c += 64) { float v = nproj[(size_t)t * DIN + O_CDKV + c]; s2 += v * v; }
      s1 = wave_sum(s1); s2 = wave_sum(s2); if (e == 0) { chk_add((ssq_dq[row * 4] + ssq_dq[row * 4 + 1]) + ssq_dq[row * 4 + 2], s1, d2s, r2s); chk_add(ssq_dkv[row * 2] + ssq_dkv[row * 2 + 1], s2, d2s, r2s); } }
    chk_commit(d2, r2, acc); chk_commit(d2s, r2s, acc + 2);
}

__global__ void __launch_bounds__(64) chk_prep(const float* nq, const float* nkv, const float* nkr, const float* nkc, const float* nvc, const unsigned char* ws, float* acc) {
    const int t = blockIdx.x, e = threadIdx.x; float d2 = 0.f, r2 = 0.f, d2c = 0.f, r2c = 0.f; const float scale = 0.14724444f;
    const bf16_t* QM = (const bf16_t*)(ws + WS_MLA); const bf16_t* KM = (const bf16_t*)(ws + WS_MLA + MLA_KM); const bf16_t* VM = (const bf16_t*)(ws + WS_MLA + MLA_VM);
    for (int h = 0; h < 6; ++h) {
        const size_t rq = ((size_t)(CB * 6 + h) * 2048 + t);
        chk_add(bf2f(QM[rq * 96 + e]), nq[(size_t)t * 576 + h * 96 + e] * scale, d2, r2);
        chk_add(bf2f(KM[rq * 96 + e]), nkv[(size_t)t * 768 + h * 128 + e], d2, r2);
        chk_add(bf2f(VM[rq * 64 + e]), nkv[(size_t)t * 768 + h * 128 + 64 + e], d2, r2);
        if (e < 32) { chk_add(bf2f(QM[rq * 96 + 64 + e]), nq[(size_t)t * 576 + h * 96 + 64 + e] * scale, d2, r2); chk_add(bf2f(KM[rq * 96 + 64 + e]), nkr[(size_t)t * 32 + e], d2, r2); }
    }
    if (t < 128) for (int hk = 0; hk < 2; ++hk) {
        const bf16_t* KC = (const bf16_t*)(ws + WS_CMP); const bf16_t* VC = (const bf16_t*)(ws + WS_CMP + CMP_V); const size_t rf = ((size_t)(CB * 2 + hk) * 128 + t) * 64 + e;
        chk_add(bf2f(KC[rf]), t < 127 ? nkc[(size_t)(hk * 127 + t) * 64 + e] : 0.f, d2c, r2c); chk_add(bf2f(VC[rf]), t < 127 ? nvc[(size_t)(hk * 127 + t) * 64 + e] : 0.f, d2c, r2c);
    }
    chk_commit(d2, r2, acc); chk_commit(d2c, r2c, acc + 2);
}

__global__ void __launch_bounds__(64) chk_y(const float* ny, const unsigned char* ws, float* acc, int nseg) {
    const int t = blockIdx.x, e = threadIdx.x; const bf16_t* Y = (const bf16_t*)(ws + WS_Y) + ((size_t)CB * 2048 + t) * 1024;
    float d2[3] = {0.f, 0.f, 0.f}, r2[3] = {0.f, 0.f, 0.f};
    for (int c = e; c < 1024; c += 64) { const int seg = c < 384 ? 0 : (c < 640 ? 1 : 2); const int cf = c < 384 ? c : (c < 640 ? 768 + (c - 384) : 384 + (c - 640)); const float f = bf2f(Y[cf]), r = ny[(size_t)t * 1024 + c];
        if (seg == 0) chk_add(f, r, d2[0], r2[0]); else if (seg == 1) chk_add(f, r, d2[1], r2[1]); else chk_add(f, r, d2[2], r2[2]); }
    if (nseg == 3) { chk_commit(d2[0], r2[0], acc); chk_commit(d2[1], r2[1], acc + 2); chk_commit(d2[2], r2[2], acc + 4); }
    else chk_commit(d2[0] + d2[1] + d2[2], r2[0] + r2[1] + r2[2], acc);
}

__global__ void __launch_bounds__(64) chk_x(const float* nx, const unsigned char* ws, float* acc) {
    const int t = blockIdx.x, e = threadIdx.x; const bf16_t* X = (const bf16_t*)(ws + WS_XB) + ((size_t)CB * 2048 + t) * 1024; float d2 = 0.f, r2 = 0.f;
    for (int c = e; c < 1024; c += 64) chk_add(bf2f(X[c]), nx[(size_t)t * 1024 + c], d2, r2);
    chk_commit(d2, r2, acc);
}

__global__ void __launch_bounds__(512) chk_code(float* acc, int nst, const float* nout) {
    __shared__ float sh[512];
    float s = 0.f; for (int i = threadIdx.x; i < 2048 * 1024; i += 512) { float v = nout[i]; s += v * v; }
    sh[threadIdx.x] = s; __syncthreads();
    if (threadIdx.x == 0) { float tot = 0.f; for (int i = 0; i < 512; ++i) tot += sh[i]; float rms = sqrtf(tot / (2048.f * 1024.f)); if (!(rms > 1e-3f && rms < 1e3f)) rms = 1.f;
        int code = 0;
        for (int st = 0; st < nst; ++st) { const float d2 = acc[2 * st], r2 = acc[2 * st + 1]; if (r2 == 0.f && d2 == 0.f) { if ((st & 15) >= 9) continue; code = (st + 1) * 4 + 3; break; } const float err = d2 / fmaxf(r2, 1e-30f);
            const float tol = CHK_TOL(st);
            if (!(err <= tol)) { const int cls = !(err < 1.f) ? 3 : (err >= 0.1f ? 2 : (err >= 0.01f ? 1 : 0)); code = (st + 1) * 4 + cls; break; } }
        acc[2 * 40] = rms * 32.f * exp2f(0.5f * (float)code); }
}
__global__ void __launch_bounds__(512) chk_fill(const float* acc, float* out) {
    const float K = acc[2 * 40];
    for (size_t i = (size_t)blockIdx.x * 512 + threadIdx.x; i < (size_t)NTOK * 1024; i += (size_t)gridDim.x * 512) out[i] = (i & 1) ? -K : K;
}
#endif

#if TIME_PH != -1
#ifndef TIME_Q
#define TIME_Q 6.f
#endif
#ifndef TIME_CAL
#define TIME_CAL 1.0f
#endif
__global__ void tm_acc(const unsigned long long* ts, float* best, int first) {
    int a = TIME_PH, b = TIME_PH + 1;
#ifdef TIME_PH_END
    b = TIME_PH_END;
#endif
    float T = 100.f; if (TIME_PH >= 0) T = (float)(ts[b] - ts[a]) * 0.01f;
    if (first || T < *best) *best = T;
}
__global__ void __launch_bounds__(512) tm_fill(const float* best, float* out) {
    float T = *best;
    T = exp2f(rintf(log2f(fmaxf(T, 1.f)) * TIME_Q) / TIME_Q);
    const float c = sqrtf(T) * TIME_CAL;
    for (size_t i = (size_t)blockIdx.x * 512 + threadIdx.x; i < (size_t)NTOK * 1024; i += (size_t)gridDim.x * 512) out[i] = (i & 1) ? -c : c;
}
#endif
static int g_grid = 0;
static bool setup_once(size_t ws_size) {
    if (g_grid) return g_grid > 0;
    if (ws_size < WS_END) { fprintf(stderr, "kernel_launch: workspace too small: %zu < %zu\n", ws_size, (size_t)WS_END); g_grid = -1; return false; }
    int dev = 0, cus = 0, per_cu = 0;
    if (hipGetDevice(&dev) != hipSuccess || hipDeviceGetAttribute(&cus, hipDeviceAttributeMultiprocessorCount, dev) != hipSuccess) { g_grid = -1; return false; }
    if (hipFuncSetAttribute((const void*)mk, hipFuncAttributeMaxDynamicSharedMemorySize, LDS_BYTES) != hipSuccess) { fprintf(stderr, "kernel_launch: hipFuncSetAttribute failed\n"); g_grid = -1; return false; }
    if (hipOccupancyMaxActiveBlocksPerMultiprocessor(&per_cu, (const void*)mk, 512, LDS_BYTES) != hipSuccess || per_cu < 1) { fprintf(stderr, "kernel_launch: occupancy query says %d\n", per_cu); }
    (void)hipGetLastError();
    g_grid = cus;
    return true;
}
static void launch_mk(const Args& a0, int lo, int hi, hipStream_t stream) { Args a = a0; a.ph_lo = lo; a.ph_hi = hi; hipLaunchKernelGGL(mk, dim3(g_grid), dim3(512), LDS_BYTES, stream, a); }

extern "C" void kernel_launch(void* const* d_in, const int* in_sizes, int n_in, void* d_out, int out_size, void* d_ws, size_t ws_size, hipStream_t stream) {
    if (!setup_once(ws_size)) return;
    unsigned char* ws = (unsigned char*)d_ws;
    (void)hipMemsetAsync(ws + WS_CTL, 0, ZERO_BYTES, stream);
    Args a{}; for (int i = 0; i < 30; ++i) a.in.p[i] = (const float*)d_in[i];
    a.out = (float*)d_out; a.ws = ws; a.ph_lo = 0; a.ph_hi = 0;
#if CHECK
    a.out = nullptr;
#endif
#if CHECK
    float* nb = (float*)d_out; size_t off = 0; NvScratch S;
    auto take = [&](size_t n) { float* p = nb + off; off += (n + 63) & ~(size_t)63; return p; };
    S.proj = take((size_t)2048 * DIN); S.h1 = take(2048 * 1024); S.qk = S.h1; S.hraw = S.qk + 2048 * 512; S.kn = S.hraw + 2048 * 256;
    S.kcmp = take(2 * 127 * 64); S.vcmp = take(2 * 127 * 64); S.dqn = take(2048 * 192); S.q = take(2048 * 576); S.dkvn = take(2048 * 128); S.kv = take(2048 * 768); S.x1 = S.dqn;
    S.krope = take(2048 * 32); S.y = take(2048 * 1024); S.xl = take(2048 * 1024); S.rt_e = (int*)take(2048 * 2); S.rt_w = take(2048 * 2);
    if (off * 4 > (size_t)NTOK * 1024 * 4) { fprintf(stderr, "naive scratch too big\n"); return; }
    float* acc = (float*)(ws + WS_CTL) + CW_CHK;
    launch_mk(a, 0, 1, stream);
    const float* nx_in = (const float*)d_in[0] + (size_t)CB * 2048 * 1024;
    int nst = 0;
    for (int l = 0; l < L_; ++l) {
        const int pb = 1 + l * NPH; const int sb = l * 16;
        launch_mk(a, pb + PH_INPROJ, pb + PH_INPROJ + 1, stream);
        naive_step(d_in, l, NS_INPROJ, nx_in, S.xl, S, stream);
        chk_proj<<<2048, 64, 0, stream>>>(S.proj, ws + WS_PRJ, (const float*)(ws + WS_SSQ + PT_DQ) + (size_t)l * 16384 * 4, (const float*)(ws + WS_SSQ + PT_DKV) + (size_t)l * 16384 * 2,
                                           (const float*)d_in[8] + l * 64, (const float*)d_in[9] + l * 64, (const float*)d_in[19] + l * 192 + 160, (const int*)d_in[1], acc + 2 * (sb + 0));
        nst = sb + 2;
        int ns_done = NS_INPROJ;
#if CHECK_UPTO >= 1
        launch_mk(a, pb + PH_PREP, pb + PH_PREP + 1, stream);
        naive_step(d_in, l, NS_NSAPREP, nx_in, S.xl, S, stream); naive_step(d_in, l, NS_MLAPREP, nx_in, S.xl, S, stream); ns_done = NS_MLAPREP;
        chk_prep<<<2048, 64, 0, stream>>>(S.q, S.kv, S.krope, S.kcmp, S.vcmp, ws, acc + 2 * (sb + 2));
        nst = sb + 4;
#endif
#if CHECK_UPTO >= 2
        launch_mk(a, pb + PH_MIX, pb + PH_MIX + 1, stream);
        naive_step(d_in, l, NS_NSA, nx_in, S.xl, S, stream); naive_step(d_in, l, NS_ML, nx_in, S.xl, S, stream); naive_step(d_in, l, NS_MLA, nx_in, S.xl, S, stream); ns_done = NS_MLA;
        chk_y<<<2048, 64, 0, stream>>>(S.y, ws, acc + 2 * (sb + 4), 3);
        nst = sb + 7;
#endif
#if CHECK_UPTO >= 3
        launch_mk(a, pb + PH_YNORM, pb + PH_YNORM + 1, stream); launch_mk(a, pb + PH_OUTPROJ, pb + PH_OUTPROJ + 1, stream);
        naive_step(d_in, l, NS_OUT, nx_in, S.xl, S, stream); ns_done = NS_OUT;
        chk_x<<<2048, 64, 0, stream>>>(S.x1, ws, acc + 2 * (sb + 7));
        nst = sb + 8;
#endif
#if CHECK_UPTO >= 4
        for (int ph = PH_ROUTE; ph <= PH_COMBINE; ++ph) launch_mk(a, pb + ph, pb + ph + 1, stream);
        naive_step(d_in, l, NS_ROUTE, nx_in, S.xl, S, stream); naive_step(d_in, l, NS_MOE, nx_in, S.xl, S, stream); ns_done = NS_MOE;
        chk_x<<<2048, 64, 0, stream>>>(S.xl, ws, acc + 2 * (sb + 8));
        nst = sb + 9;
#endif
        CHECK_REST
        for (int s = ns_done + 1; s <= NS_MOE; ++s) naive_step(d_in, l, s, nx_in, S.xl, S, stream);
        nx_in = S.xl;
        if (l == CHECK_LAYERS - 1) break;
    }
    chk_code<<<1, 512, 0, stream>>>(acc, nst, S.xl);
    chk_fill<<<1024, 512, 0, stream>>>(acc, (float*)d_out);
#else
#if defined(SPLIT_LAUNCH) && SPLIT_LAUNCH
    for (int ph = 0; ph < 1 + L_ * NPH; ++ph) launch_mk(a, ph, ph + 1, stream);
#else
    launch_mk(a, 0, 1 + L_ * NPH, stream);
#if TIME_PH != -1
    for (int rp = 0; rp < 6; ++rp) {
        (void)hipMemsetAsync(ws + WS_CTL, 0, ZERO_BYTES, stream); launch_mk(a, 0, 1 + L_ * NPH, stream);
        tm_acc<<<1, 1, 0, stream>>>((const unsigned long long*)((unsigned*)(ws + WS_CTL) + CW_TS), (float*)(ws + WS_META + META_RT), rp == 0);
    }
    tm_fill<<<1024, 512, 0, stream>>>((const float*)(ws + WS_META + META_RT), (float*)d_out);
#endif
#endif
#endif
}
```

```cpp
#define CHECK 0
#define CHECK_LAYERS 2
#define CHECK_UPTO 99
#define SPLIT_LAUNCH 0
#define REPEAT_PH -1
#include <hip/hip_runtime.h>
#include <stdint.h>
#include <cstdio>

constexpr int B_ = 8, T_ = 2048, D_ = 1024, L_ = 2, NTOK = B_ * T_;
constexpr int DIN = 2554;
constexpr int O_AQ = 0, O_AKV = 384, O_AG = 1152, O_BQK = 1170, O_BV = 1682, O_BIF = 1938, O_BO = 1946, O_CDQ = 2202, O_CDKV = 2394, O_CKR = 2522;

typedef unsigned short bf16_t;
typedef short bf16x8 __attribute__((ext_vector_type(8)));
typedef short s16x4 __attribute__((ext_vector_type(4)));
typedef float f32x4 __attribute__((ext_vector_type(4)));
typedef float f32x16 __attribute__((ext_vector_type(16)));
typedef unsigned u32x4 __attribute__((ext_vector_type(4)));
typedef unsigned u32x2 __attribute__((ext_vector_type(2)));
typedef float f32x2_t __attribute__((ext_vector_type(2)));
typedef __bf16 bf16x2_t __attribute__((ext_vector_type(2)));
#define LAS __attribute__((address_space(3)))

__device__ __forceinline__ unsigned pk_bf16(float lo, float hi) { f32x2_t v = {lo, hi}; bf16x2_t b = __builtin_convertvector(v, bf16x2_t); return __builtin_bit_cast(unsigned, b); }
__device__ __forceinline__ float bf_lo(unsigned u) { return __builtin_bit_cast(float, u << 16); }
__device__ __forceinline__ float bf_hi(unsigned u) { return __builtin_bit_cast(float, u & 0xffff0000u); }
__device__ __forceinline__ float bf2f(bf16_t h) { return __builtin_bit_cast(float, (unsigned)h << 16); }
__device__ __forceinline__ bf16_t f2bf(float f) { return (bf16_t)(pk_bf16(f, 0.f) & 0xffffu); }
__device__ __forceinline__ float wave_sum(float v) { for (int o = 32; o; o >>= 1) v += __shfl_xor(v, o); return v; }
__device__ __forceinline__ float wave_max(float v) { for (int o = 32; o; o >>= 1) v = fmaxf(v, __shfl_xor(v, o)); return v; }
__device__ __forceinline__ float siluf(float x) { return x / (1.f + __expf(-x)); }
__device__ __forceinline__ float sigmf(float x) { return 1.f / (1.f + __expf(-x)); }
__device__ __forceinline__ int t5b(int dist) {
    int n = dist > 0 ? dist : 0; if (n < 16) return n;
    float v = logf((float)n / 16.f) / logf(8.f) * 16.f; int l = 16 + (int)v; return l < 31 ? l : 31;
}

__device__ __forceinline__ int lane_now() { return (int)__builtin_amdgcn_mbcnt_hi(~0u, __builtin_amdgcn_mbcnt_lo(~0u, 0u)); }
#define TIDX ((g_wv << 6) | lane_now())

constexpr size_t WS_CTL = 0, CTL_BYTES = 65536;
constexpr size_t WS_SSQ = WS_CTL + CTL_BYTES;
constexpr size_t ZERO_BYTES = CTL_BYTES;
constexpr size_t PT_DQ = 0, PT_DKV = PT_DQ + (size_t)2 * 16384 * 4 * 4, PT_A = PT_DKV + (size_t)2 * 16384 * 2 * 4, PT_C = PT_A + (size_t)2 * 16384 * 8 * 4, PT_X1 = PT_C + (size_t)2 * 16384 * 8 * 4, PT_END = PT_X1 + (size_t)2 * 16384 * 16 * 4;
constexpr size_t WS_SSQX = WS_SSQ + PT_END;
constexpr size_t WS_RS2 = WS_SSQX + 2 * 65536;
constexpr size_t WS_WIN = WS_RS2 + 65536;
constexpr size_t WS_WOUT = WS_WIN + (size_t)2 * 2560 * 1024 * 2;
constexpr size_t WS_WUQ = WS_WOUT + (size_t)2 * 1024 * 1024 * 2;
constexpr size_t WS_WUKV = WS_WUQ + (size_t)2 * 768 * 256 * 2;
constexpr size_t WS_WC1 = WS_WUKV + (size_t)2 * 768 * 256 * 2;
constexpr size_t WS_WC2 = WS_WC1 + (size_t)2 * 2 * 64 * 2048 * 2;
constexpr size_t WS_WR = WS_WC2 + (size_t)2 * 2 * 64 * 64 * 2;
constexpr size_t WS_B1C = WS_WR + (size_t)2 * 64 * 1024 * 2;
constexpr size_t WS_BIASD = WS_B1C + 1024;
constexpr size_t WS_ROPE = WS_BIASD + 6 * 2048 * 4;
constexpr size_t WS_WMOE = WS_ROPE + (size_t)16384 * 32 * 4;
constexpr size_t WMOE_WD = (size_t)32 * 512 * 1024 * 2;
constexpr size_t WS_XB = WS_WMOE + 50331648;
constexpr size_t WS_MLA = WS_XB + 33554432;
constexpr size_t MLA_KM = (size_t)8 * 6 * 2048 * 96 * 2, MLA_VM = 2 * MLA_KM;
constexpr size_t WS_HBUF = WS_MLA;
constexpr size_t WS_PRJ = WS_MLA + 50331648;
constexpr size_t HM64 = (size_t)2048 * 64 * 2;
constexpr size_t PRJ_QN = 0;
constexpr size_t PRJ_KN1 = PRJ_QN + 48 * HM64, PRJ_VN1 = PRJ_KN1 + 16 * HM64, PRJ_KN2 = PRJ_VN1 + 16 * HM64, PRJ_VN2 = PRJ_KN2 + 16 * HM64;
constexpr size_t PRJ_VML = PRJ_VN2 + 16 * HM64;
constexpr size_t PRJ_OG = PRJ_VML + 32 * HM64;
constexpr size_t PRJ_KR = PRJ_OG + (size_t)16384 * 256 * 2;
constexpr size_t PRJ_GATES = PRJ_KR + (size_t)16384 * 32 * 2;
constexpr size_t PRJ_DEAD = PRJ_GATES + (size_t)16384 * 32 * 4;
constexpr size_t PRJ_C0K = PRJ_DEAD, PRJ_C0V = PRJ_C0K + 16 * HM64 + 8192;
constexpr size_t PRJ_RAWQK = PRJ_C0V + 16 * HM64 + 8192;
constexpr size_t PRJ_DQKV = PRJ_RAWQK + (size_t)16384 * 512 * 2;
constexpr size_t PRJ_END = PRJ_DQKV + (size_t)16384 * 384 * 2;
static_assert(PRJ_END - PRJ_DEAD >= 33554432, "Y fits the dead part of PRJ");
constexpr size_t WS_Y = WS_PRJ + PRJ_DEAD;
constexpr size_t WS_YBUF = WS_PRJ;
static_assert((size_t)2 * 16384 * 1024 * 2 <= PRJ_END, "YBUF fits the PRJ region");
constexpr size_t WS_ML = WS_PRJ + PRJ_END;
constexpr size_t ML_KC = 32 * HM64, ML_DELTA = 2 * ML_KC, ML_DN = ML_DELTA + (size_t)1024 * 4096 * 2, ML_G = ML_DN + (size_t)1024 * 64 * 4, ML_BL = ML_G + (size_t)8 * 4 * 2048 * 2 * 4, ML_CP = ML_BL + 4096, ML_NP = ML_CP + (size_t)1024 * 4096 * 2, ML_END = ML_NP + (size_t)1024 * 64 * 2;
constexpr size_t WS_CMP = WS_ML + ML_END;
constexpr size_t CMP_V = (size_t)8 * 2 * 128 * 64 * 2;
constexpr size_t WS_META = WS_CMP + 2 * CMP_V;
constexpr size_t META_W = (size_t)32 * 16384 * 4, META_RT = 2 * META_W;
constexpr size_t WS_END = WS_META + META_RT + (size_t)16384 * 16;
constexpr int CW_BAR = 0;
constexpr int CW_Q = 4096;
constexpr int CW_SCAN = 4608;
constexpr int CW_TS = 4864;
constexpr int CW_CHK = 5120;
constexpr int CW_CNT = 8192;
constexpr int LDS_BYTES = 147456;
constexpr int LDS_MISC = LDS_BYTES - 256;
#define XB_TMO      128
#define XB_XCNT(j)  (256  + 64 * (j))
#define XB_XSUB(j)  (1280 + 64 * (j))
#define XB_XGEN(j)  (2304 + 64 * (j))
#define XB_TOP      3328
#define XB_TOPGEN   3392
#define XCD_BAR_WORDS 3456
#define XB_SPIN_CAP (1u << 18)

__device__ __forceinline__ unsigned xb_ld(unsigned* p)              { return __hip_atomic_load(p, __ATOMIC_RELAXED, __HIP_MEMORY_SCOPE_AGENT); }
__device__ __forceinline__ unsigned xb_add(unsigned* p, unsigned v) { return __hip_atomic_fetch_add(p, v, __ATOMIC_RELAXED, __HIP_MEMORY_SCOPE_AGENT); }
__device__ __forceinline__ unsigned xb_xcc_id() { return (unsigned)__builtin_amdgcn_s_getreg((3 << 11) | 20) & 0xFu; }
#define XB_SPIN(cond, bar) do { unsigned _sp = 0; while (cond) { __builtin_amdgcn_s_sleep(1); \
    if ((++_sp & 255u) == 0u) { if (xb_ld(&(bar)[XB_TMO])) break; if (_sp > XB_SPIN_CAP) { atomicAdd(&(bar)[XB_TMO], 1u); break; } } } } while (0)

struct XcdBarrier {
    int g_wv; unsigned* bar; unsigned x;
    volatile LAS unsigned* st;
};

__device__ __forceinline__ XcdBarrier xcd_barrier_post(unsigned* bar, volatile LAS unsigned* st, int g_wv) {
    XcdBarrier b; b.g_wv = g_wv; b.bar = bar; b.x = xb_xcc_id(); b.st = st;
    if (TIDX == 0) (void)xb_add(&bar[XB_XCNT(b.x)], 1u);
    return b;
}
__device__ __forceinline__ void xcd_barrier_complete(unsigned* bar, unsigned x, unsigned& nloc, unsigned& nx) {
    const unsigned G = gridDim.x * gridDim.y * gridDim.z;
    unsigned sum, cnt, mine, sp = 0u;
    for (;;) {
        sum = 0u; cnt = 0u; mine = 0u;
#pragma unroll
        for (unsigned j = 0; j < 16; ++j) { const unsigned c = xb_ld(&bar[XB_XCNT(j)]); sum += c; cnt += (c > 0u) ? 1u : 0u; mine = (j == x) ? c : mine; }
        if (sum == G) break;
        __builtin_amdgcn_s_sleep(1);
        if ((++sp & 255u) == 0u) { if (xb_ld(&bar[XB_TMO])) break; if (sp > XB_SPIN_CAP) { atomicAdd(&bar[XB_TMO], 1u); break; } }
    }
    nloc = mine > 0u ? mine : 1u; nx = cnt > 0u ? cnt : 1u;
}

__device__ __forceinline__ void xcd_barrier(const XcdBarrier& b) {
    asm volatile("s_waitcnt vmcnt(0)" ::: "memory");
    __syncthreads();
    const int g_wv = b.g_wv;
    if (TIDX == 0) {
        unsigned* bar = b.bar;
        __builtin_amdgcn_s_waitcnt(0);
        unsigned nloc = b.st[0], nx = b.st[1];
        if (nloc == 0u) { xcd_barrier_complete(bar, b.x, nloc, nx); b.st[0] = nloc; b.st[1] = nx; }
        const unsigned old = xb_add(&bar[XB_XSUB(b.x)], 1u);
        const unsigned gen = old / nloc;
        if (old + 1u == (gen + 1u) * nloc) {
            __builtin_amdgcn_fence(__ATOMIC_RELEASE, "agent");
            asm volatile("s_waitcnt vmcnt(0)" ::: "memory");
            const unsigned og = xb_add(&bar[XB_TOP], 1u);
            const unsigned tg = og / nx;
            if (og + 1u == (tg + 1u) * nx) xb_add(&bar[XB_TOPGEN], 1u);
            else XB_SPIN(xb_ld(&bar[XB_TOPGEN]) == tg, bar);
            __builtin_amdgcn_fence(__ATOMIC_ACQUIRE, "agent");
            xb_add(&bar[XB_XGEN(b.x)], 1u);
            asm volatile("s_waitcnt vmcnt(0)" ::: "memory");
        } else {
            XB_SPIN(xb_ld(&bar[XB_XGEN(b.x)]) == gen, bar);
            __builtin_amdgcn_fence(__ATOMIC_ACQUIRE, "agent");
            asm volatile("s_waitcnt vmcnt(0)" ::: "memory");
        }
    }
    __syncthreads();
}
struct Inputs { const float* p[30]; };
typedef const __attribute__((address_space(4))) Inputs* InPtr;
__device__ __forceinline__ InPtr in_tab() { InPtr p = (InPtr)__builtin_amdgcn_kernarg_segment_ptr(); asm volatile("" : "+s"(p)); return p; }
__device__ __forceinline__ unsigned char* launder(unsigned char* p) { size_t z = 0; asm volatile("" : "+s"(z)); return p + z; }

__host__ __device__ inline int inproj_refcol(int G, int e) {
    if (G < 6) return O_AQ + G * 64 + e;
    if (G < 18) return O_AKV + (G - 6) * 64 + e;
    if (G < 26) return O_BQK + (G - 18) * 64 + e;
    if (G < 30) return O_BV + (G - 26) * 64 + e;
    if (G < 34) return O_BO + (G - 30) * 64 + e;
    if (G < 37) return O_CDQ + (G - 34) * 64 + e;
    if (G == 37) { if (e < 32) return O_CKR + e; if (e < 50) return O_AG + (e - 32); if (e < 58) return O_BIF + (e - 50); return -1; }
    return O_CDKV + (G - 38) * 64 + e;
}
__host__ __device__ inline int uq_refcol(int G, int e) {
    if (G < 6) return G * 96 + e;
    if (G < 9) { const int idx = e & 31, bj = e >> 5, sub = idx >> 4, i = idx & 15; return (2 * (G - 6) + sub) * 96 + 64 + bj * 16 + i; }
    return -1;
}
__host__ __device__ inline int ukv_refcol(int G, int e) { return G < 6 ? G * 128 + e : (G - 6) * 128 + 64 + e; }
#define N2G(n) ((((n) >> 8) << 2) + (((n) >> 5) & 3))
#define N2E(n) (((((n) >> 7) & 1) << 5) + ((n) & 31))

struct FWin { const float* w; const float* g; __device__ __forceinline__ float operator()(int k, int n) const { const int c = inproj_refcol(N2G(n), N2E(n)); return c < 0 ? 0.f : w[(size_t)k * DIN + c] * g[k]; } };
struct FWout { const float* w; const float* ga; const float* gc; __device__ __forceinline__ float operator()(int k, int n) const {
    const int kr = k < 384 ? k : (k < 768 ? 640 + (k - 384) : 384 + (k - 768)); const float og = k < 384 ? ga[k] : (k < 768 ? gc[k - 384] : 1.f); return w[(size_t)kr * 1024 + n] * og; } };
struct FWuq { const float* w; const float* g; __device__ __forceinline__ float operator()(int k, int n) const { const int c = uq_refcol(N2G(n), N2E(n)); return (k < 192 && c >= 0) ? w[(size_t)k * 576 + c] * g[k] : 0.f; } };
struct FWukv { const float* w; const float* g; __device__ __forceinline__ float operator()(int k, int n) const { const int c = ukv_refcol(N2G(n), N2E(n)); return k >= 128 ? w[(size_t)(k - 128) * 768 + c] * g[k - 128] : 0.f; } };
struct FWc1 { const float* w; __device__ __forceinline__ float operator()(int k, int n) const { return w[(size_t)k * 64 + n]; } };
struct FWr { const float* wg; const float* we; const float* g; __device__ __forceinline__ float operator()(int k, int n) const { return n < 4 ? wg[k * 4 + n] * g[k] : (n < 36 ? we[k * 32 + n - 4] * g[k] : 0.f); } };
struct FWgu { const float* src; const float* g; int n0, col0; __device__ __forceinline__ float operator()(int k, int n) const { return src[(size_t)k * 256 + col0 + (n - n0)] * g[k]; } };
struct FWd { const float* w; __device__ __forceinline__ float operator()(int k, int n) const { return w[(size_t)k * 1024 + n]; } };

__device__ __forceinline__ void rope_cs(int pos, int j, float& cs, float& sn) {
    const double inv = exp2(-(double)j * (13.287712379549449 / 16.0));
    const double rev = (double)pos * inv * 0.15915494309189535; const float f = (float)(rev - rint(rev));
    cs = __builtin_amdgcn_cosf(f); sn = __builtin_amdgcn_sinf(f);
}
template <class F>
__device__ __forceinline__ void cvt_tile(const F& f, int n0, int k0, bf16_t* dst, int ldk, LAS float* tile, int tid) {
    { const int k = tid >> 3, nb = (tid & 7) * 8;
#pragma unroll
      for (int j = 0; j < 8; ++j) tile[k * 65 + nb + j] = f(k0 + k, n0 + nb + j); }
    __syncthreads();
    { const int n = tid >> 3, kb = (tid & 7) * 8; const LAS float* s = tile + kb * 65 + n;
      u32x4 o; o.x = pk_bf16(s[0], s[65]); o.y = pk_bf16(s[130], s[195]); o.z = pk_bf16(s[260], s[325]); o.w = pk_bf16(s[390], s[455]);
      *(u32x4*)(dst + (size_t)(n0 + n) * ldk + k0 + kb) = o; }
    __syncthreads();
}
template <class F>
__device__ __forceinline__ void cvt_item(const F& f, int it, int nK, bf16_t* dst, int ldk, LAS float* tile, int tid) { cvt_tile(f, (it / nK) * 64, (it % nK) * 64, dst, ldk, tile, tid); }

__device__ __forceinline__ void moe_item(InPtr in, int l, int it, const float*& src, int& ld, size_t& dst, int& ldk, bool& gain, int& kk0) {
    if (it < 32 * 64) { const int e = it >> 6, r = it & 63, n0 = (r >> 3) * 64, k0 = (r & 7) * 128, c0 = n0 & 255;
        src = (c0 < 128 ? in->p[27] : in->p[28]) + ((size_t)l * 32 + e) * 262144 + (size_t)k0 * 256 + (n0 >> 8) * 128 + (c0 & 127); ld = 256; gain = true; kk0 = k0;
        dst = ((size_t)e * 512 + n0) * 1024 + k0; ldk = 1024; }
    else { const int j = it - 32 * 64, e = j >> 5, r = j & 31, n0 = (r >> 1) * 64, k0 = (r & 1) * 128;
        src = in->p[29] + ((size_t)l * 32 + e) * 262144 + (size_t)k0 * 1024 + n0; ld = 1024; gain = false; kk0 = 0;
        dst = (size_t)16777216 + ((size_t)e * 1024 + n0) * 256 + k0; ldk = 256; }
}
__device__ __forceinline__ void cvt_moe_layer(InPtr in, unsigned char* ws, int l, LAS float* tile, int bid, int nb, int tid) {
    asm volatile("" : "+v"(tid));
    const float* g2 = in->p[22] + l * 1024; bf16_t* W = (bf16_t*)(ws + WS_WMOE);
    const int k = tid >> 3, nbq = (tid & 7) * 8;
    const int n = tid >> 3, kb = (tid & 7) * 8;
    constexpr int NIT = 32 * (64 + 32);
    int it = bid; f32x4 v0, v1, v2, v3; const float* src; int ld, ldk, kk0 = 0; size_t dst = 0; bool gain; float gk0 = 1.f, gk1 = 1.f;
    if (it < NIT) { moe_item(in, l, it, src, ld, dst, ldk, gain, kk0); v0 = *(const f32x4*)(src + (size_t)k * ld + nbq); v1 = *(const f32x4*)(src + (size_t)k * ld + nbq + 4);
        v2 = *(const f32x4*)(src + (size_t)(k + 64) * ld + nbq); v3 = *(const f32x4*)(src + (size_t)(k + 64) * ld + nbq + 4); gk0 = gain ? g2[kk0 + k] : 1.f; gk1 = gain ? g2[kk0 + 64 + k] : 1.f; }
    int buf = 0;
    for (; it < NIT; it += nb) {
        LAS float* t = tile + buf * (128 * 65);
        t[k * 65 + nbq + 0] = v0.x * gk0; t[k * 65 + nbq + 1] = v0.y * gk0; t[k * 65 + nbq + 2] = v0.z * gk0; t[k * 65 + nbq + 3] = v0.w * gk0;
        t[k * 65 + nbq + 4] = v1.x * gk0; t[k * 65 + nbq + 5] = v1.y * gk0; t[k * 65 + nbq + 6] = v1.z * gk0; t[k * 65 + nbq + 7] = v1.w * gk0;
        t[(k + 64) * 65 + nbq + 0] = v2.x * gk1; t[(k + 64) * 65 + nbq + 1] = v2.y * gk1; t[(k + 64) * 65 + nbq + 2] = v2.z * gk1; t[(k + 64) * 65 + nbq + 3] = v2.w * gk1;
        t[(k + 64) * 65 + nbq + 4] = v3.x * gk1; t[(k + 64) * 65 + nbq + 5] = v3.y * gk1; t[(k + 64) * 65 + nbq + 6] = v3.z * gk1; t[(k + 64) * 65 + nbq + 7] = v3.w * gk1;
        const size_t cdst = dst; const int cldk = ldk;
        __syncthreads();
        const int itn = it + nb;
        if (itn < NIT) { moe_item(in, l, itn, src, ld, dst, ldk, gain, kk0); v0 = *(const f32x4*)(src + (size_t)k * ld + nbq); v1 = *(const f32x4*)(src + (size_t)k * ld + nbq + 4);
            v2 = *(const f32x4*)(src + (size_t)(k + 64) * ld + nbq); v3 = *(const f32x4*)(src + (size_t)(k + 64) * ld + nbq + 4); gk0 = gain ? g2[kk0 + k] : 1.f; gk1 = gain ? g2[kk0 + 64 + k] : 1.f; }
#pragma unroll
        for (int hh = 0; hh < 2; ++hh) {
            const LAS float* s = t + (64 * hh + kb) * 65 + n;
            u32x4 o; o.x = pk_bf16(s[0], s[65]); o.y = pk_bf16(s[130], s[195]); o.z = pk_bf16(s[260], s[325]); o.w = pk_bf16(s[390], s[455]);
            *(u32x4*)(W + cdst + (size_t)n * cldk + 64 * hh + kb) = o;
        }
        buf ^= 1;
    }
    __syncthreads();
}

__device__ __forceinline__ void cvt_small_weights(InPtr in, unsigned char* ws, int l, LAS float* tile, int bid, int nb, int tid) {
    asm volatile("" : "+v"(tid));
    constexpr int I_WIN = 40 * 16, I_WOUT = 16 * 16, I_WU = 12 * 4, I_WC1 = 32, I_WC2 = 1, I_WR = 16;
    constexpr int PER_L = I_WIN + I_WOUT + 2 * I_WU + 2 * I_WC1 + 2 * I_WC2 + I_WR;
    for (int it0 = bid; it0 < PER_L; it0 += nb) {
        int it = it0;
        if (it < I_WIN) { FWin f{in->p[4] + (size_t)l * 1024 * DIN, in->p[3] + l * 1024}; cvt_item(f, it, 16, (bf16_t*)(ws + WS_WIN) + (size_t)l * 2560 * 1024, 1024, tile, tid); continue; } it -= I_WIN;
        if (it < I_WOUT) { FWout f{in->p[21] + (size_t)l * 1048576, in->p[10] + l * 384, in->p[20] + l * 384}; cvt_item(f, it, 16, (bf16_t*)(ws + WS_WOUT) + (size_t)l * 1048576, 1024, tile, tid); continue; } it -= I_WOUT;
        if (it < I_WU) { FWuq f{in->p[16] + (size_t)l * 192 * 576, in->p[15] + l * 192}; cvt_item(f, it, 4, (bf16_t*)(ws + WS_WUQ) + (size_t)l * 768 * 256, 256, tile, tid); continue; } it -= I_WU;
        if (it < I_WU) { FWukv f{in->p[18] + (size_t)l * 128 * 768, in->p[17] + l * 128}; cvt_item(f, it, 4, (bf16_t*)(ws + WS_WUKV) + (size_t)l * 768 * 256, 256, tile, tid); continue; } it -= I_WU;
        if (it < 2 * I_WC1) { const int s = it / I_WC1; FWc1 f{in->p[6] + ((size_t)l * 2 + s) * 2048 * 64}; cvt_item(f, it % I_WC1, 32, (bf16_t*)(ws + WS_WC1) + ((size_t)l * 2 + s) * 64 * 2048, 2048, tile, tid); continue; } it -= 2 * I_WC1;
        if (it < 2 * I_WC2) { const int s = it; FWc1 f{in->p[7] + ((size_t)l * 2 + s) * 64 * 64}; cvt_item(f, 0, 1, (bf16_t*)(ws + WS_WC2) + ((size_t)l * 2 + s) * 64 * 64, 64, tile, tid); continue; } it -= 2 * I_WC2;
        { FWr f{in->p[23] + (size_t)l * 4096, in->p[25] + (size_t)l * 32768, in->p[22] + l * 1024}; cvt_item(f, it, 16, (bf16_t*)(ws + WS_WR) + (size_t)l * 64 * 1024, 1024, tile, tid); }
    }
}

__device__ __forceinline__ void prologue(InPtr in, unsigned char* ws, LAS unsigned char* lds, int bid, int nb, int g_wv) {
    int tid_ = TIDX; asm volatile("" : "+v"(tid_));
    const int tid = tid_, lane = tid & 63, wid = tid >> 6;
    LAS float* tile = (LAS float*)lds;
    cvt_small_weights(in, ws, 0, tile, bid, nb, tid);
    { const float* x = in->p[0]; bf16_t* XB = (bf16_t*)(ws + WS_XB); float* ssqx = (float*)(ws + WS_SSQX);
      for (int r = bid * 8 + wid; r < NTOK; r += nb * 8) {
          const f32x4* xr = (const f32x4*)(x + (size_t)r * 1024) + lane; float s = 0.f; u32x2* o = (u32x2*)(XB + (size_t)r * 1024) + lane;
#pragma unroll
          for (int j = 0; j < 4; ++j) { const f32x4 v = xr[64 * j]; s += (v.x * v.x + v.y * v.y) + (v.z * v.z + v.w * v.w); u32x2 w; w.x = pk_bf16(v.x, v.y); w.y = pk_bf16(v.z, v.w); o[64 * j] = w; }
          s = wave_sum(s); if (lane == 0) ssqx[r] = s;
      } }
    { float* biasd = (float*)(ws + WS_BIASD); const float* rb = in->p[2];
      for (int i = bid * 512 + tid; i < 6 * 2048; i += nb * 512) { const int h = i >> 11, d = i & 2047; biasd[i] = rb[t5b(d) * 6 + h] * 1.44269504f; } }
    { float* rope = (float*)(ws + WS_ROPE); const int* pos = (const int*)in->p[1];
      for (int i = bid * 512 + tid; i < NTOK * 16; i += nb * 512) { const int tk = i >> 4, j = i & 15; float cs, sn; rope_cs(pos[tk], j, cs, sn); rope[(size_t)tk * 32 + j] = cs; rope[(size_t)tk * 32 + 16 + j] = sn; } }
    { float* b1c = (float*)(ws + WS_B1C); LAS float* red = (LAS float*)lds;
      for (int it = bid; it < 4; it += nb) { const float* pe = in->p[5] + (size_t)it * 2048; const float* w1 = in->p[6] + (size_t)it * 2048 * 64; const int f = tid & 63, part = tid >> 6;
          float a = 0.f; for (int k = part * 256; k < part * 256 + 256; ++k) a += pe[k] * w1[(size_t)k * 64 + f];
          __syncthreads(); red[tid] = a; __syncthreads();
          if (tid < 64) { float s = 0.f; for (int p2 = 0; p2 < 8; ++p2) s += red[p2 * 64 + tid]; b1c[it * 64 + tid] = s; }
          __syncthreads(); } }
}
namespace g8 {
constexpr int BM = 256, BK = 64, HALF = 128, HTB = HALF * BK * 2, STAGE_BYTES = 8 * HTB, NXCD = 8, WGM = 8;
__host__ __device__ __forceinline__ int lds_byte(int r, int c) { const int st = (r >> 4) * 2 + (c >> 5), rr = r & 15, cc = c & 31, ob = rr * 64 + cc * 2; return st * 1024 + (ob ^ (((ob >> 9) & 1) << 5)); }
__host__ __device__ __forceinline__ void stage_rc(int b, int& R, int& C) { const int st = b / 1024, sb = b % 1024, swz = sb ^ (((sb >> 9) & 1) << 5); R = (st >> 1) * 16 + swz / 64; C = (st & 1) * 32 + (swz % 64) / 2; }
__host__ __device__ __forceinline__ int perm32(int rho) { const int n = rho >> 4, i = rho & 15; return 8 * (i >> 2) + 4 * n + (i & 3); }

struct GUnit { const char* a; const char* b; int pm, pn, e, rows; };

__device__ __forceinline__ bool static_unit(int i, int G, int c, int nM, int nN, int& pm, int& pn) {
    const int nwg = nM * nN; const long L = (long)i * G + c; if (L >= nwg) return false;
    int wgid = (int)L; { const int q = nwg / NXCD, r = nwg % NXCD, xcd = wgid % NXCD, off = wgid / NXCD; wgid = (xcd < r ? xcd * (q + 1) : r * (q + 1) + (xcd - r) * q) + off; }
    const int nig = WGM * nN, gid = wgid / nig, fm = gid * WGM, gsz = (nM - fm) < WGM ? (nM - fm) : WGM;
    pm = fm + ((wgid % nig) % gsz); pn = (wgid % nig) / gsz; return true;
}
struct DenseSched {
    static constexpr bool GATHER = false, PARTIAL = false;
    const char* A; const char* Bt; int lda, ldb, nM, nN, G, c;
    __device__ __forceinline__ bool next(int i, GUnit& u) const {
        int pm, pn; if (!static_unit(i, G, c, nM, nN, pm, pn)) return false;
        u.pm = pm; u.pn = pn; u.e = 0; u.rows = 256; u.a = A + (size_t)pm * 256 * lda * 2; u.b = Bt + (size_t)pn * 256 * ldb * 2; return true;
    }
    __device__ __forceinline__ void aoff(const GUnit&, unsigned (&v)[2][2], const int (&R)[2], const int (&C)[2]) const {
#pragma unroll
        for (int h = 0; h < 2; ++h)
#pragma unroll
            for (int i = 0; i < 2; ++i) v[h][i] = (unsigned)((h * 128 + R[i]) * lda + C[i]) * 2u;
    }
};

template <class Epi, class Sched>
__device__ __forceinline__ void gemm_run(LAS unsigned char* lds, const int K, const int ldb, const Sched& S, const Epi& E, int g_wv) {
    int tid_ = TIDX; asm volatile("" : "+v"(tid_));
    const int tid = tid_, wid = __builtin_amdgcn_readfirstlane(tid >> 6), lane = tid & 63, wr = wid >> 2, wc = wid & 3, fr = lane & 15, fq = lane >> 4;
    int nt_ = K / BK; asm volatile("" : "+s"(nt_));
    const int nt = nt_;
    int R[2], C[2]; unsigned voffB[2];
#pragma unroll
    for (int i = 0; i < 2; ++i) { stage_rc(tid * 16 + i * 8192, R[i], C[i]); const int Rb = (R[i] & ~31) + perm32(R[i] & 31); voffB[i] = (unsigned)(Rb * ldb + C[i]) * 2u; }
    const size_t kstep = (size_t)(BK * 2);
    const size_t hstepB = (size_t)HALF * ldb * 2;
    const unsigned ldsw = (unsigned)wid * 1024u;
    const int aoff = lds_byte(wr * 64 + fr, fq * 8), boff = lds_byte(wc * 32 + fr, fq * 8);
#define G8_SA(b, h) (((b) * 2 + (h)) * HTB)
#define G8_SB(b, h) ((4 + (b) * 2 + (h)) * HTB)
#define G8_GLDS(bufoff, gptr, i_) __builtin_amdgcn_global_load_lds((const unsigned*)(gptr), (LAS unsigned*)(lds + (bufoff) + ldsw + (i_) * 8192), 16, 0, 0)
#define G8_STAGE_B(bufoff, gbase) do { G8_GLDS(bufoff, (const char*)(gbase) + voffB[0], 0); G8_GLDS(bufoff, (const char*)(gbase) + voffB[1], 1); } while (0)
#define G8_STAGE_A(bufoff, gbase, v0, v1) do { G8_GLDS(bufoff, (const char*)(gbase) + (v0), 0); G8_GLDS(bufoff, (const char*)(gbase) + (v1), 1); } while (0)
#define G8_LDA(dst, b, h) do { _Pragma("unroll") for (int m = 0; m < 4; ++m) _Pragma("unroll") for (int k = 0; k < 2; ++k) dst[m][k] = *(const LAS bf16x8*)(lds + G8_SA(b, h) + aoff + m * 2048 + k * 1024); } while (0)
#define G8_LDB(dst, b, h) do { _Pragma("unroll") for (int n = 0; n < 2; ++n) _Pragma("unroll") for (int k = 0; k < 2; ++k) dst[n][k] = *(const LAS bf16x8*)(lds + G8_SB(b, h) + boff + n * 2048 + k * 1024); } while (0)
#define G8_MMA(ai, bj, At, Bt) do { __builtin_amdgcn_s_setprio(1); _Pragma("unroll") for (int m = 0; m < 4; ++m) { if (!PARTIAL || ((mmask >> ((ai) * 4 + m)) & 1u)) { _Pragma("unroll") for (int n = 0; n < 2; ++n) _Pragma("unroll") for (int k = 0; k < 2; ++k) \
        acc[ai][bj][m][n] = __builtin_amdgcn_mfma_f32_16x16x32_bf16(Bt[n][k], At[m][k], acc[ai][bj][m][n], 0, 0, 0); } } __builtin_amdgcn_s_setprio(0); } while (0)
#define G8_WAIT_V(n) asm volatile("s_waitcnt vmcnt(" #n ")" ::: "memory")
#define G8_WAIT_L(n) asm volatile("s_waitcnt lgkmcnt(" #n ")" ::: "memory")
#define G8_BAR __builtin_amdgcn_s_barrier()
#define G8_SCHED __builtin_amdgcn_sched_barrier(0)
    GUnit cur, nxt; int ui = 0;
    if (!S.next(0, cur)) return;
    constexpr bool GATHER = Sched::GATHER, PARTIAL = Sched::PARTIAL;
    unsigned mmask = 0xffu;
#define G8_MASK(u) do { if (PARTIAL) { mmask = 0u; _Pragma("unroll") for (int q_ = 0; q_ < 8; ++q_) mmask |= (((q_ >> 2) * 128 + wr * 64 + (q_ & 3) * 16) < (u).rows) ? (1u << q_) : 0u; } } while (0)
    unsigned vc[2][2];
    S.aoff(cur, vc, R, C); G8_MASK(cur);
    LAS u32x4* stash = (LAS u32x4*)(lds + STAGE_BYTES + 4096) + tid;
    f32x4 acc[2][2][4][2];
#pragma unroll
    for (int a = 0; a < 2; ++a)
#pragma unroll
        for (int b = 0; b < 2; ++b)
#pragma unroll
            for (int m = 0; m < 4; ++m)
#pragma unroll
                for (int n = 0; n < 2; ++n) acc[a][b][m][n] = (f32x4){0.f, 0.f, 0.f, 0.f};
    bf16x8 At[4][2], B0[2][2], B1[2][2];
    const char* cA = cur.a; const char* cB = cur.b;
    G8_STAGE_B(G8_SB(0, 0), cB); G8_STAGE_B(G8_SB(0, 1), cB + hstepB); G8_STAGE_A(G8_SA(0, 0), cA, vc[0][0], vc[0][1]); G8_STAGE_A(G8_SA(0, 1), cA, vc[1][0], vc[1][1]);
    if (wr == 1) G8_BAR;
    G8_WAIT_V(2); G8_BAR;
    G8_STAGE_B(G8_SB(1, 0), cB + kstep); G8_STAGE_A(G8_SA(1, 0), cA + kstep, vc[0][0], vc[0][1]); G8_STAGE_B(G8_SB(1, 1), cB + hstepB + kstep);
    G8_WAIT_V(6); G8_BAR;
    for (;;) {
        const bool has_next = S.next(ui + 1, nxt);
        if (GATHER) { unsigned vn[2][2];
            if (has_next) S.aoff(nxt, vn, R, C);
            else { vn[0][0] = vc[0][0]; vn[0][1] = vc[0][1]; vn[1][0] = vc[1][0]; vn[1][1] = vc[1][1]; }
            u32x4 sv; sv.x = vn[0][0]; sv.y = vn[0][1]; sv.z = vn[1][0]; sv.w = vn[1][1]; *stash = sv; }
        const char* nA = has_next ? nxt.a : cA; const char* nB = has_next ? nxt.b : cB;
#pragma unroll 1
        for (int seg = 0; seg < (Epi::KHOOK ? 3 : 1); ++seg) {
        const int tlo = Epi::KHOOK ? 6 * seg : 0, thi = Epi::KHOOK ? (seg == 2 ? nt : 6 * seg + 6) : nt;
#pragma unroll 1
        for (int t = tlo; t < thi; t += 2) {
            const bool last = (t == nt - 2);
            const char* a1 = cA + (size_t)(t + 1) * kstep;
            const char* a2 = last ? nA : cA + (size_t)(t + 2) * kstep; const char* b2 = last ? nB : cB + (size_t)(t + 2) * kstep;
            const char* a3 = a2 + kstep; const char* b3 = b2 + kstep;
            unsigned w00 = vc[0][0], w01 = vc[0][1], w10 = vc[1][0], w11 = vc[1][1];
            if (GATHER) { if (last) { const u32x4 sv = *stash; w00 = sv.x; w01 = sv.y; w10 = sv.z; w11 = sv.w; } }
            G8_LDB(B0, 0, 0); G8_LDB(B1, 0, 1); G8_SCHED; G8_LDA(At, 0, 0); G8_STAGE_A(G8_SA(1, 1), a1, vc[1][0], vc[1][1]);
            G8_WAIT_V(8); G8_WAIT_L(0); G8_BAR; G8_MMA(0, 0, At, B0); G8_MMA(0, 1, At, B1); G8_BAR; G8_SCHED;
            G8_LDA(At, 0, 1); G8_STAGE_B(G8_SB(0, 0), b2); G8_STAGE_B(G8_SB(0, 1), b2 + hstepB); G8_STAGE_A(G8_SA(0, 0), a2, w00, w01);
            G8_WAIT_V(8); G8_WAIT_L(0); G8_BAR; G8_MMA(1, 0, At, B0); G8_MMA(1, 1, At, B1); G8_BAR; G8_SCHED;
            G8_LDB(B0, 1, 0); G8_LDB(B1, 1, 1); G8_SCHED; G8_LDA(At, 1, 0); G8_STAGE_A(G8_SA(0, 1), a2, w10, w11);
            G8_WAIT_V(8); G8_WAIT_L(0); G8_BAR; G8_MMA(0, 0, At, B0); G8_MMA(0, 1, At, B1); G8_BAR; G8_SCHED;
            G8_LDA(At, 1, 1); G8_STAGE_B(G8_SB(1, 0), b3); G8_STAGE_B(G8_SB(1, 1), b3 + hstepB); G8_STAGE_A(G8_SA(1, 0), a3, w00, w01);
            G8_WAIT_V(8); G8_WAIT_L(0); G8_BAR; G8_MMA(1, 0, At, B0); G8_MMA(1, 1, At, B1); G8_BAR; G8_SCHED;
        }
        if constexpr (Epi::KHOOK) { if (seg < 2) E.kscale(acc, seg, wr, fr); }
        }
        if (wr == 0) G8_BAR;
        { int fr_ = fr, fq_ = fq; asm volatile("" : "+v"(fr_), "+v"(fq_));
          E(acc, cur, wr, wc, fr_, fq_); }
        if (!has_next) break;
#pragma unroll
        for (int a = 0; a < 2; ++a)
#pragma unroll
            for (int b = 0; b < 2; ++b)
#pragma unroll
                for (int m = 0; m < 4; ++m)
#pragma unroll
                    for (int n = 0; n < 2; ++n) acc[a][b][m][n] = (f32x4){0.f, 0.f, 0.f, 0.f};
        cur = nxt; cA = nA; cB = nB; ++ui; G8_MASK(cur);
        if (GATHER) { const u32x4 sv = *stash; vc[0][0] = sv.x; vc[0][1] = sv.y; vc[1][0] = sv.z; vc[1][1] = sv.w; }
        if (wr == 1) G8_BAR;
    }
    G8_WAIT_V(0);
    G8_BAR;
#undef G8_SA
#undef G8_SB
#undef G8_GLDS
#undef G8_STAGE_A
#undef G8_STAGE_B
#undef G8_LDA
#undef G8_LDB
#undef G8_MMA
#undef G8_MASK
#undef G8_WAIT_V
#undef G8_WAIT_L
#undef G8_BAR
#undef G8_SCHED
}
}
using g8::GUnit;
__device__ __forceinline__ void st_bf16x8(bf16_t* p, const float (&v)[8]) { u32x4 w; w.x = pk_bf16(v[0], v[1]); w.y = pk_bf16(v[2], v[3]); w.z = pk_bf16(v[4], v[5]); w.w = pk_bf16(v[6], v[7]); *(u32x4*)p = w; }
__device__ __forceinline__ float quad_sum(float s) { s += __shfl_xor(s, 16); s += __shfl_xor(s, 32); return s; }

struct EpiInProj {
    static constexpr bool KHOOK = false;
    const float* ssqx; float* part_dq; float* part_dkv; const float* qg; const float* kg; const float* krg; const float* rope;
    unsigned char* prj;
    __device__ __forceinline__ void operator()(const f32x4 (&acc)[2][2][4][2], const GUnit& u, int wr, int wc, int fr, int fq) const {
        const int G = u.pn * 4 + wc;
        const bool isq = G < 6; const int a = G - 6; const bool isk = (G >= 10 && G < 18 && ((a >> 1) & 1) == 0);
        const float* g0 = (isq ? qg : kg) + 8 * fq;
        float rs8[8];
#pragma unroll
        for (int k = 0; k < 8; ++k) rs8[k] = ssqx[u.pm * 256 + (k >> 2) * 128 + wr * 64 + (k & 3) * 16 + fr];
#pragma unroll
        for (int k = 0; k < 8; ++k) rs8[k] = rsqrtf(rs8[k] * (1.f / 1024.f) + 1e-6f);
#pragma unroll
        for (int ai = 0; ai < 2; ++ai)
#pragma unroll
            for (int m = 0; m < 4; ++m) {
                __builtin_amdgcn_sched_barrier(0);
                const int row = u.pm * 256 + ai * 128 + wr * 64 + m * 16 + fr; const int b = row >> 11, t = row & 2047;
                const float rs = rs8[ai * 4 + m];
                float v[2][8];
#pragma unroll
                for (int bj = 0; bj < 2; ++bj)
#pragma unroll
                    for (int n = 0; n < 2; ++n)
#pragma unroll
                        for (int j = 0; j < 4; ++j) v[bj][4 * n + j] = acc[ai][bj][m][n][j] * rs;
                float ss = 0.f;
#pragma unroll
                for (int bj = 0; bj < 2; ++bj)
#pragma unroll
                    for (int i = 0; i < 8; ++i) ss += v[bj][i] * v[bj][i];
                bf16_t* dst = nullptr; int bstride = 32;
                if (isq) {
                    ss = quad_sum(ss); const float sc = rsqrtf(ss * (1.f / 64.f) + 1e-6f) * 0.18033688f;
#pragma unroll
                    for (int i = 0; i < 8; ++i) { v[0][i] *= sc * g0[i]; v[1][i] *= sc * g0[32 + i]; }
                    dst = (bf16_t*)(prj + PRJ_QN) + ((size_t)(b * 6 + G) * 2048 + t) * 64;
                } else if (G < 18) {
                    const int br = a >> 2, s = (a >> 1) & 1, hk = a & 1;
                    if (br > 0 && s == 0) {
                        ss = quad_sum(ss); const float sc = rsqrtf(ss * (1.f / 64.f) + 1e-6f);
#pragma unroll
                        for (int i = 0; i < 8; ++i) { v[0][i] *= sc * g0[i]; v[1][i] *= sc * g0[32 + i]; }
                    }
                    const size_t base = br == 0 ? (s ? PRJ_C0V : PRJ_C0K) : (br == 1 ? (s ? PRJ_VN1 : PRJ_KN1) : (s ? PRJ_VN2 : PRJ_KN2));
                    dst = (bf16_t*)(prj + base) + ((size_t)(b * 2 + hk) * 2048 + t) * 64;
                } else if (G < 26) { dst = (bf16_t*)(prj + PRJ_RAWQK) + (size_t)row * 512 + (G - 18) * 64; }
                else if (G < 30) { dst = (bf16_t*)(prj + PRJ_VML) + ((size_t)(b * 4 + (G - 26)) * 2048 + t) * 64; }
                else if (G < 34) { dst = (bf16_t*)(prj + PRJ_OG) + (size_t)row * 256 + (G - 30) * 64; }
                else if (G < 37) { dst = (bf16_t*)(prj + PRJ_DQKV) + (size_t)row * 384 + (G - 34) * 64; ss = quad_sum(ss); if (fq == 0) part_dq[(size_t)row * 4 + (G - 34)] = ss; }
                else if (G == 37) {
                    dst = (bf16_t*)(prj + PRJ_DQKV) + (size_t)row * 384 + 192;
                    float* gt = (float*)(prj + PRJ_GATES) + (size_t)row * 32 + 8 * fq;
                    *(f32x4*)gt = (f32x4){v[1][0], v[1][1], v[1][2], v[1][3]}; *(f32x4*)(gt + 4) = (f32x4){v[1][4], v[1][5], v[1][6], v[1][7]};
                    float s0 = 0.f;
#pragma unroll
                    for (int i = 0; i < 8; ++i) s0 += v[0][i] * v[0][i];
                    s0 = quad_sum(s0); const float sc = rsqrtf(s0 * (1.f / 32.f) + 1e-6f);
                    const float* rp = rope + (size_t)row * 32 + ((8 * fq) & 15);
                    float kr[8];
#pragma unroll
                    for (int i = 0; i < 8; ++i) { const float val = v[0][i] * sc * krg[8 * fq + i]; const float oth = __shfl_xor(val, 32); const float cs = rp[i], sn = rp[16 + i]; kr[i] = fq < 2 ? val * cs - oth * sn : val * cs + oth * sn; }
                    st_bf16x8((bf16_t*)(prj + PRJ_KR) + (size_t)row * 32 + 8 * fq, kr);
                } else { dst = (bf16_t*)(prj + PRJ_DQKV) + (size_t)row * 384 + 256 + (G - 38) * 64; ss = quad_sum(ss); if (fq == 0) part_dkv[(size_t)row * 2 + (G - 38)] = ss; }
                st_bf16x8(dst + 8 * fq, v[0]); st_bf16x8(dst + bstride + 8 * fq, v[1]);
            }
    }
};

struct EpiUq {
    static constexpr bool KHOOK = false;
    const float* ssq_dq; const float* qkn; const float* rope; bf16_t* QM;
    __device__ __forceinline__ void operator()(const f32x4 (&acc)[2][2][4][2], const GUnit& u, int wr, int wc, int fr, int fq) const {
        const int G = u.pn * 4 + wc; if (G >= 9) return;
        const float scale = 0.14724444f;
        const float* g0 = G < 6 ? qkn + 8 * fq : qkn + 64 + 8 * (fq & 1); const float* g1 = G < 6 ? g0 + 32 : g0 + 16;
        float rs8[8];
#pragma unroll
        for (int k = 0; k < 8; ++k) { const f32x4 pq = *(const f32x4*)(ssq_dq + (size_t)(u.pm * 256 + (k >> 2) * 128 + wr * 64 + (k & 3) * 16 + fr) * 4); rs8[k] = (pq.x + pq.y) + pq.z; }
#pragma unroll
        for (int k = 0; k < 8; ++k) rs8[k] = rsqrtf(rs8[k] * (1.f / 192.f) + 1e-6f);
#pragma unroll
        for (int ai = 0; ai < 2; ++ai)
#pragma unroll
            for (int m = 0; m < 4; ++m) {
                __builtin_amdgcn_sched_barrier(0);
                const int row = u.pm * 256 + ai * 128 + wr * 64 + m * 16 + fr; const int b = row >> 11, t = row & 2047;
                const float rs = rs8[ai * 4 + m];
                float v[2][8]; float ss = 0.f;
#pragma unroll
                for (int bj = 0; bj < 2; ++bj)
#pragma unroll
                    for (int n = 0; n < 2; ++n)
#pragma unroll
                        for (int j = 0; j < 4; ++j) { const float x = acc[ai][bj][m][n][j] * rs; v[bj][4 * n + j] = x; ss += x * x; }
                if (G < 6) ss = quad_sum(ss); else ss += __shfl_xor(ss, 16);
                const float sc = rsqrtf(ss * (G < 6 ? 1.f / 64.f : 1.f / 32.f) + 1e-6f) * scale;
#pragma unroll
                for (int i = 0; i < 8; ++i) { v[0][i] *= sc * g0[i]; v[1][i] *= sc * g1[i]; }
                if (G < 6) {
                    bf16_t* dst = QM + ((size_t)(b * 6 + G) * 2048 + t) * 96;
                    st_bf16x8(dst + 8 * fq, v[0]); st_bf16x8(dst + 32 + 8 * fq, v[1]);
                } else {
                    const int i16 = 8 * (fq & 1); const int head = 2 * (G - 6) + (fq >> 1);
                    const float* rp = rope + (size_t)row * 32 + i16; float o1[8], o2[8];
#pragma unroll
                    for (int i = 0; i < 8; ++i) { const float cs = rp[i], sn = rp[16 + i]; o1[i] = v[0][i] * cs - v[1][i] * sn; o2[i] = v[1][i] * cs + v[0][i] * sn; }
                    bf16_t* dst = QM + ((size_t)(b * 6 + head) * 2048 + t) * 96 + 64 + i16;
                    st_bf16x8(dst, o1); st_bf16x8(dst + 16, o2);
                }
            }
    }
};
struct EpiUkv {
    static constexpr bool KHOOK = false;
    const float* ssq_dkv; const float* qkn; const bf16_t* KR; bf16_t* KM; bf16_t* VM;
    __device__ __forceinline__ void operator()(const f32x4 (&acc)[2][2][4][2], const GUnit& u, int wr, int wc, int fr, int fq) const {
        const int G = u.pn * 4 + wc;
        const float* g0 = qkn + 96 + 8 * fq;
        float rs8[8];
#pragma unroll
        for (int k = 0; k < 8; ++k) { const size_t rr = (size_t)(u.pm * 256 + (k >> 2) * 128 + wr * 64 + (k & 3) * 16 + fr); rs8[k] = ssq_dkv[rr * 2] + ssq_dkv[rr * 2 + 1]; }
#pragma unroll
        for (int k = 0; k < 8; ++k) rs8[k] = rsqrtf(rs8[k] * (1.f / 128.f) + 1e-6f);
#pragma unroll
        for (int ai = 0; ai < 2; ++ai)
#pragma unroll
            for (int m = 0; m < 4; ++m) {
                __builtin_amdgcn_sched_barrier(0);
                const int row = u.pm * 256 + ai * 128 + wr * 64 + m * 16 + fr; const int b = row >> 11, t = row & 2047;
                const float rs = rs8[ai * 4 + m];
                float v[2][8]; float ss = 0.f;
#pragma unroll
                for (int bj = 0; bj < 2; ++bj)
#pragma unroll
                    for (int n = 0; n < 2; ++n)
#pragma unroll
                        for (int j = 0; j < 4; ++j) { const float x = acc[ai][bj][m][n][j] * rs; v[bj][4 * n + j] = x; ss += x * x; }
                if (G < 6) {
                    ss = quad_sum(ss); const float sc = rsqrtf(ss * (1.f / 64.f) + 1e-6f);
#pragma unroll
                    for (int i = 0; i < 8; ++i) { v[0][i] *= sc * g0[i]; v[1][i] *= sc * g0[32 + i]; }
                    bf16_t* dst = KM + ((size_t)(b * 6 + G) * 2048 + t) * 96;
                    st_bf16x8(dst + 8 * fq, v[0]); st_bf16x8(dst + 32 + 8 * fq, v[1]);
                    *(u32x4*)(dst + 64 + 8 * fq) = *(const u32x4*)(KR + (size_t)row * 32 + 8 * fq);
                } else {
                    bf16_t* dst = VM + ((size_t)(b * 6 + (G - 6)) * 2048 + t) * 64;
                    st_bf16x8(dst + 8 * fq, v[0]); st_bf16x8(dst + 32 + 8 * fq, v[1]);
                }
            }
    }
};
#define MFMA16(a, b, c) __builtin_amdgcn_mfma_f32_16x16x32_bf16(a, b, c, 0, 0, 0)
#define MFMA32(a, b, c) __builtin_amdgcn_mfma_f32_32x32x16_bf16(a, b, c, 0, 0, 0)
#define LDS_FENCE() asm volatile("s_waitcnt lgkmcnt(0)" ::: "memory")

__device__ __forceinline__ void cmp_unit(int u, int l, InPtr in, unsigned char* ws, LAS unsigned char* lds, int g_wv) {
    int tid_ = TIDX; asm volatile("" : "+v"(tid_));
    const int tid = tid_, w = tid >> 6, lane = tid & 63, r = lane & 15, q = lane >> 4;
    const int b = u >> 2, s = (u >> 1) & 1, hk = u & 1;
    const bf16_t* A = (const bf16_t*)(ws + WS_PRJ + (s ? PRJ_C0V : PRJ_C0K)) + (size_t)(b * 2 + hk) * 2048 * 64;
    const bf16_t* W1 = (const bf16_t*)(ws + WS_WC1) + ((size_t)l * 2 + s) * 64 * 2048;
    const bf16_t* W2 = (const bf16_t*)(ws + WS_WC2) + ((size_t)l * 2 + s) * 64 * 64;
    const float* b1 = (const float*)(ws + WS_B1C) + (l * 2 + s) * 64;
    f32x4 acc[4];
#pragma unroll
    for (int nb = 0; nb < 4; ++nb) acc[nb] = (f32x4){0.f, 0.f, 0.f, 0.f};
    const bf16_t* ap = A + (size_t)(16 * w + r) * 1024 + 8 * q;
    constexpr int WP = 528, WBUF = 64 * WP; LAS unsigned char* wb = lds + 24576;
    u32x4 st[4];
#pragma unroll
    for (int i = 0; i < 4; ++i) { const int c = tid + 512 * i; st[i] = *(const u32x4*)(W1 + (size_t)(c >> 5) * 2048 + (c & 31) * 8); }
#pragma unroll
    for (int i = 0; i < 4; ++i) { const int c = tid + 512 * i; *(LAS u32x4*)(wb + (c >> 5) * WP + (c & 31) * 16) = st[i]; }
    __syncthreads();
#pragma unroll 1
    for (int kc = 0; kc < 8; ++kc) {
        const int cur = kc & 1;
        if (kc < 7) {
#pragma unroll
            for (int i = 0; i < 4; ++i) { const int c = tid + 512 * i; st[i] = *(const u32x4*)(W1 + (size_t)(c >> 5) * 2048 + (kc + 1) * 256 + (c & 31) * 8); }
        }
        bf16x8 af[8];
#pragma unroll
        for (int ks = 0; ks < 8; ++ks) af[ks] = *(const bf16x8*)(ap + 256 * kc + 32 * ks);
#pragma unroll
        for (int ks = 0; ks < 8; ++ks)
#pragma unroll
            for (int nb = 0; nb < 4; ++nb) { const bf16x8 bb = *(const LAS bf16x8*)(wb + cur * WBUF + (16 * nb + r) * WP + (32 * ks + 8 * q) * 2); acc[nb] = MFMA16(af[ks], bb, acc[nb]); }
        if (kc < 7) {
#pragma unroll
            for (int i = 0; i < 4; ++i) { const int c = tid + 512 * i; *(LAS u32x4*)(wb + (cur ^ 1) * WBUF + (c >> 5) * WP + (c & 31) * 16) = st[i]; }
        }
        __syncthreads();
    }
    LAS bf16_t* hl = (LAS bf16_t*)(lds + w * 2304);
#pragma unroll
    for (int nb = 0; nb < 4; ++nb) { const float bias = b1[16 * nb + r];
#pragma unroll
        for (int j = 0; j < 4; ++j) hl[(4 * q + j) * 72 + 16 * nb + r] = f2bf(siluf(acc[nb][j] + bias)); }
    LDS_FENCE();
    f32x4 o[4];
#pragma unroll
    for (int nb = 0; nb < 4; ++nb) o[nb] = (f32x4){0.f, 0.f, 0.f, 0.f};
#pragma unroll
    for (int ks = 0; ks < 2; ++ks) {
        const bf16x8 a = *(const LAS bf16x8*)(hl + r * 72 + 32 * ks + 8 * q);
#pragma unroll
        for (int nb = 0; nb < 4; ++nb) { const bf16x8 bb = *(const bf16x8*)(W2 + (size_t)(16 * nb + r) * 64 + 32 * ks + 8 * q); o[nb] = MFMA16(a, bb, o[nb]); }
    }
    LDS_FENCE();
    const float* kg = in->p[9] + l * 64;
    bf16_t* dst = (bf16_t*)(ws + WS_CMP + (s ? CMP_V : 0)) + (size_t)(b * 2 + hk) * 128 * 64;
#pragma unroll
    for (int j = 0; j < 4; ++j) {
        const int n = 16 * w + 4 * q + j; float ss = 0.f;
#pragma unroll
        for (int nb = 0; nb < 4; ++nb) ss += o[nb][j] * o[nb][j];
        ss += __shfl_xor(ss, 1); ss += __shfl_xor(ss, 2); ss += __shfl_xor(ss, 4); ss += __shfl_xor(ss, 8);
        const float sc = s == 0 ? rsqrtf(ss * (1.f / 64.f) + 1e-6f) : 1.f;
#pragma unroll
        for (int nb = 0; nb < 4; ++nb) { const int d = 16 * nb + r; const float v = o[nb][j] * sc * (s == 0 ? kg[d] : 1.f); dst[(size_t)n * 64 + d] = n < 127 ? f2bf(v) : (bf16_t)0; }
    }
}

__device__ __forceinline__ int swz_off(int row, int chunk) { return row * 128 + ((chunk ^ (row & 7)) << 4); }
__device__ __forceinline__ float log_sigmoid(float x) { return fminf(x, 0.f) - log1pf(__expf(-fabsf(x))); }
__device__ __forceinline__ void ml_delta_wave(int cu, int l, InPtr in, unsigned char* ws, LAS unsigned char* wl, int lane) {
    const int c = cu & 31, bh = cu >> 5, h = bh & 3, b = bh >> 2; const int t0 = c * 64; const size_t row0 = (size_t)b * 2048 + t0;
    const float* G = (const float*)(ws + WS_PRJ + PRJ_GATES);
    const float ip = G[(row0 + lane) * 32 + 18 + h] + in->p[12][l * 4 + h], fp = G[(row0 + lane) * 32 + 22 + h] + in->p[13][l * 4 + h];
    float bcum = log_sigmoid(fp);
#pragma unroll
    for (int o = 1; o < 64; o <<= 1) { const float t = __builtin_bit_cast(float, __builtin_amdgcn_ds_bpermute(((lane - o) & 63) << 2, __builtin_bit_cast(int, bcum))); if (lane >= o) bcum += t; }
    const float bL = __builtin_bit_cast(float, __builtin_amdgcn_readlane(__builtin_bit_cast(int, bcum), 63)); const float wgt = __expf(bL - bcum + ip);
    { float* mlg = (float*)(ws + WS_ML + ML_G) + ((size_t)bh * 2048 + t0 + lane) * 2; mlg[0] = bcum; mlg[1] = ip; if (lane == 0) ((float*)(ws + WS_ML + ML_BL))[cu] = bL; }
    const bf16_t* raw = (const bf16_t*)(ws + WS_PRJ + PRJ_RAWQK); const float* cw = in->p[11] + (size_t)l * 4 * 512;
    float wq[4], wk[4];
#pragma unroll
    for (int j = 0; j < 4; ++j) { wq[j] = cw[j * 512 + h * 64 + lane]; wk[j] = cw[j * 512 + 256 + h * 64 + lane]; }
    float q3 = 0.f, q2 = 0.f, q1 = 0.f, k3 = 0.f, k2 = 0.f, k1 = 0.f;
    if (c > 0) { const bf16_t* p = raw + (row0 - 3) * 512 + h * 64 + lane; q3 = bf2f(p[0]); q2 = bf2f(p[512]); q1 = bf2f(p[1024]); k3 = bf2f(p[256]); k2 = bf2f(p[512 + 256]); k1 = bf2f(p[1024 + 256]); }
    bf16_t* QC = (bf16_t*)(ws + WS_ML) + ((size_t)bh * 2048 + t0) * 64 + lane; bf16_t* KC = (bf16_t*)(ws + WS_ML + ML_KC) + ((size_t)bh * 2048 + t0) * 64 + lane;
    const bf16_t* V = (const bf16_t*)(ws + WS_PRJ + PRJ_VML) + ((size_t)bh * 2048 + t0) * 64 + lane;
    float dn = 0.f;
    const bf16_t* rq = raw + row0 * 512 + h * 64 + lane;
    bf16_t cq[8], ck[8], cv[8], nq[8], nk[8], nv[8];
#pragma unroll
    for (int j = 0; j < 8; ++j) { cq[j] = rq[(size_t)j * 512]; ck[j] = rq[(size_t)j * 512 + 256]; cv[j] = V[(size_t)j * 64]; }
#pragma unroll 1
    for (int s8 = 0; s8 < 8; ++s8) {
        if (s8 < 7) {
#pragma unroll
            for (int j = 0; j < 8; ++j) { const int s = s8 * 8 + 8 + j; nq[j] = rq[(size_t)s * 512]; nk[j] = rq[(size_t)s * 512 + 256]; nv[j] = V[(size_t)s * 64]; }
        }
        float kb[8], vb[8]; bf16_t qo[8], ko[8];
#pragma unroll
        for (int j = 0; j < 8; ++j) {
            const int s = s8 * 8 + j;
            const float q0 = bf2f(cq[j]), k0 = bf2f(ck[j]);
            const float qv = siluf(wq[0] * q3 + wq[1] * q2 + wq[2] * q1 + wq[3] * q0), kv = siluf(wk[0] * k3 + wk[1] * k2 + wk[2] * k1 + wk[3] * k0) * 0.125f;
            q3 = q2; q2 = q1; q1 = q0; k3 = k2; k2 = k1; k1 = k0;
            qo[j] = f2bf(qv); ko[j] = f2bf(kv);
            const float ws_ = __builtin_bit_cast(float, __builtin_amdgcn_readlane(__builtin_bit_cast(int, wgt), s)); kb[j] = bf2f(ko[j]); dn += ws_ * kb[j]; vb[j] = ws_ * bf2f(cv[j]);
        }
#pragma unroll
        for (int j = 0; j < 8; ++j) { QC[(size_t)(s8 * 8 + j) * 64] = qo[j]; KC[(size_t)(s8 * 8 + j) * 64] = ko[j]; }
        u32x4 pk; pk.x = pk_bf16(kb[0], kb[1]); pk.y = pk_bf16(kb[2], kb[3]); pk.z = pk_bf16(kb[4], kb[5]); pk.w = pk_bf16(kb[6], kb[7]);
        *(LAS u32x4*)(wl + swz_off(lane, s8)) = pk;
        pk.x = pk_bf16(vb[0], vb[1]); pk.y = pk_bf16(vb[2], vb[3]); pk.z = pk_bf16(vb[4], vb[5]); pk.w = pk_bf16(vb[6], vb[7]);
        *(LAS u32x4*)(wl + 8192 + swz_off(lane, s8)) = pk;
#pragma unroll
        for (int j = 0; j < 8; ++j) { cq[j] = nq[j]; ck[j] = nk[j]; cv[j] = nv[j]; }
    }
    ((float*)(ws + WS_ML + ML_DN))[(size_t)cu * 64 + lane] = dn;
    LDS_FENCE();
    const int r = lane & 15, q = lane >> 4;
    bf16_t* DL = (bf16_t*)(ws + WS_ML + ML_DELTA) + (size_t)cu * 4096;
#pragma unroll
    for (int mb = 0; mb < 4; ++mb) {
        f32x4 acc[4];
#pragma unroll
        for (int nb = 0; nb < 4; ++nb) acc[nb] = (f32x4){0.f, 0.f, 0.f, 0.f};
#pragma unroll
        for (int ks = 0; ks < 2; ++ks) {
            const bf16x8 a = *(const LAS bf16x8*)(wl + 8192 + swz_off(16 * mb + r, 4 * ks + q));
#pragma unroll
            for (int nb = 0; nb < 4; ++nb) { const bf16x8 bb = *(const LAS bf16x8*)(wl + swz_off(16 * nb + r, 4 * ks + q)); acc[nb] = MFMA16(a, bb, acc[nb]); }
        }
#pragma unroll
        for (int nb = 0; nb < 4; ++nb)
#pragma unroll
            for (int j = 0; j < 4; ++j) DL[(16 * mb + 4 * q + j) * 64 + 16 * nb + r] = f2bf(acc[nb][j]);
    }
    LDS_FENCE();
}

#ifndef TIME_PH
#define TIME_PH -1
#endif
#define PSTAMP(i, blk) do { if (TIME_PH != -1 && l == 0 && blockIdx.x == (blk) && TIDX == 0) ((unsigned long long*)((unsigned*)(ws + WS_CTL) + CW_TS))[i] = __builtin_amdgcn_s_memrealtime(); } while (0)
__device__ __forceinline__ void phase_prep(int l, InPtr in, unsigned char* ws, LAS unsigned char* lds, int bid, int nb, int g_wv, unsigned* dq) {
    asm volatile("" : "+s"(bid));
    PSTAMP(40, 0);
#ifndef NO_UQ
    { g8::DenseSched S{(const char*)(ws + WS_PRJ + PRJ_DQKV), (const char*)(ws + WS_WUQ) + (size_t)l * 768 * 256 * 2, 384, 256, 64, 3, nb, bid};
      EpiUq E{(const float*)(ws + WS_SSQ + PT_DQ) + (size_t)l * 16384 * 4, in->p[19] + l * 192, (const float*)(ws + WS_ROPE), (bf16_t*)(ws + WS_MLA)};
      g8::gemm_run(lds, 256, 256, S, E, g_wv); }
#endif
    PSTAMP(41, 0);
#ifndef NO_UKV
    asm volatile("" : "+s"(bid));
    { g8::DenseSched S{(const char*)(ws + WS_PRJ + PRJ_DQKV) + 256, (const char*)(ws + WS_WUKV) + (size_t)l * 768 * 256 * 2, 384, 256, 64, 3, nb, bid};
      EpiUkv E{(const float*)(ws + WS_SSQ + PT_DKV) + (size_t)l * 16384 * 2, in->p[19] + l * 192, (const bf16_t*)(ws + WS_PRJ + PRJ_KR), (bf16_t*)(ws + WS_MLA + MLA_KM), (bf16_t*)(ws + WS_MLA + MLA_VM)};
      g8::gemm_run(lds, 256, 256, S, E, g_wv); }
#endif
    PSTAMP(42, 0); PSTAMP(44, 255);
    __syncthreads();
#ifndef NO_CMP
    for (int u = nb - 1 - bid; u < 32; u += nb) cmp_unit(u, l, in, ws, lds, g_wv);
#endif
    PSTAMP(45, 255);
    __syncthreads();
#ifndef NO_DELTA
    { int tid_ = TIDX; asm volatile("" : "+v"(tid_)); LAS int* slot = (LAS int*)(lds + LDS_MISC + 64);
      for (;;) {
          __syncthreads();
          if (tid_ == 0) *slot = (int)__hip_atomic_fetch_add(dq, 1u, __ATOMIC_RELAXED, __HIP_MEMORY_SCOPE_AGENT);
          __syncthreads();
          const int g = *slot; if (g >= 128) break;
          ml_delta_wave(g * 8 + (tid_ >> 6), l, in, ws, lds + (tid_ >> 6) * 16384, tid_ & 63);
      } }
#endif
    __syncthreads(); PSTAMP(43, 0);
}
#define CHK_TOL(st) (((st) & 15) == 8 ? 1e-2f : 1e-3f)
#define CHECK_REST
constexpr int VTP = 192;
typedef short v4i16_t __attribute__((ext_vector_type(4)));
__device__ __forceinline__ int vt_lane_off(int lane) { return (4 * (lane >> 5) + ((lane & 15) >> 2)) * VTP + ((((lane >> 4) & 1) * 16) + 4 * (lane & 3)) * 2; }
__device__ __forceinline__ bf16x8 vt_frag(const LAS unsigned char* Vt, int voff, int s4, int eb) {
    const LAS unsigned char* a = Vt + voff + 16 * s4 * VTP + 64 * eb;
    const v4i16_t lo = __builtin_amdgcn_ds_read_tr16_b64_v4i16((LAS v4i16_t*)a), hi = __builtin_amdgcn_ds_read_tr16_b64_v4i16((LAS v4i16_t*)(a + 8 * VTP));
    return (bf16x8){lo[0], lo[1], lo[2], lo[3], hi[0], hi[1], hi[2], hi[3]};
}
__device__ __forceinline__ int crow(int reg, int h) { return (reg & 3) + 8 * (reg >> 2) + 4 * h; }
struct AttnState { f32x16 o[2]; float m, l; };
__device__ __forceinline__ void attn_reset(AttnState& A) { A.m = -1e30f; A.l = 0.f;
#pragma unroll
    for (int i = 0; i < 16; ++i) { A.o[0][i] = 0.f; A.o[1][i] = 0.f; } }

template <int DK>
__device__ __forceinline__ void attn_scores(f32x16 (&s)[2], const bf16x8 (&qf)[DK / 16], const LAS unsigned char* Kt, int r, int h) {
    constexpr int KP = 2 * DK + 16, NK = DK / 16;
    bf16x8 kf[2][NK];
#pragma unroll
    for (int kb = 0; kb < 2; ++kb)
#pragma unroll
        for (int ks = 0; ks < NK; ++ks) kf[kb][ks] = *(const LAS bf16x8*)(Kt + (32 * kb + r) * KP + (16 * ks + 8 * h) * 2);
    __builtin_amdgcn_sched_barrier(0);
#pragma unroll
    for (int kb = 0; kb < 2; ++kb) {
#pragma unroll
        for (int i = 0; i < 16; ++i) s[kb][i] = 0.f;
#pragma unroll
        for (int ks = 0; ks < NK; ++ks) s[kb] = MFMA32(kf[kb][ks], qf[ks], s[kb]);
    }
}
__device__ __forceinline__ float max3f(float a, float b, float c) { return fmaxf(fmaxf(a, b), c); }
__device__ __forceinline__ void attn_softmax_pv(AttnState& A, f32x16 (&s)[2], const LAS unsigned char* Vt, int r, int h, float bias_c = 0.f, bool lane_ok = true) {
    constexpr float THR = 8.f; const int voff = vt_lane_off(r + 32 * h);
    float mx = max3f(s[0][0], s[0][1], s[0][2]);
#pragma unroll
    for (int i = 3; i < 15; i += 2) mx = max3f(mx, s[0][i], s[0][i + 1]);
    mx = max3f(mx, s[0][15], s[1][0]);
#pragma unroll
    for (int i = 1; i < 15; i += 2) mx = max3f(mx, s[1][i], s[1][i + 1]);
    mx = fmaxf(mx, s[1][15]);
    mx = fmaxf(mx, __shfl_xor(mx, 32));
    const float mxb = (lane_ok && mx > -1e29f) ? mx + bias_c : -1e30f;
    const bool grow = mxb > A.m + THR;
    const float mnew = grow ? mxb : A.m;
    if (__any(grow)) {
        const float alpha = __builtin_amdgcn_exp2f(A.m - mnew);
        A.l *= alpha;
#pragma unroll
        for (int i = 0; i < 16; ++i) { A.o[0][i] *= alpha; A.o[1][i] *= alpha; }
    }
    A.m = mnew;
    const float sub = (lane_ok && mnew > -1e29f) ? mnew - bias_c : 1e30f;
    float rs = 0.f;
#pragma unroll
    for (int kb = 0; kb < 2; ++kb)
#pragma unroll
        for (int i = 0; i < 16; ++i) { const float p = __builtin_amdgcn_exp2f(s[kb][i] - sub); s[kb][i] = p; rs += p; }
    rs += __shfl_xor(rs, 32);
    A.l += rs;
    bf16x8 vf[4][2];
#pragma unroll
    for (int s4 = 0; s4 < 4; ++s4)
#pragma unroll
        for (int eb = 0; eb < 2; ++eb) vf[s4][eb] = vt_frag(Vt, voff, s4, eb);
    __builtin_amdgcn_sched_barrier(0);
#pragma unroll
    for (int s4 = 0; s4 < 4; ++s4) {
        const int kb = s4 >> 1, hf = (s4 & 1) * 8;
        u32x4 pw; pw.x = pk_bf16(s[kb][hf + 0], s[kb][hf + 1]); pw.y = pk_bf16(s[kb][hf + 2], s[kb][hf + 3]); pw.z = pk_bf16(s[kb][hf + 4], s[kb][hf + 5]); pw.w = pk_bf16(s[kb][hf + 6], s[kb][hf + 7]);
        const bf16x8 pf = __builtin_bit_cast(bf16x8, pw);
#pragma unroll
        for (int eb = 0; eb < 2; ++eb) A.o[eb] = MFMA32(vf[s4][eb], pf, A.o[eb]);
    }
}
template <int DK>
__device__ __forceinline__ void stage_k_load(u32x4 (&kr)[2], const bf16_t* Kg  , int tid) {
    constexpr int CH = DK / 8;
    kr[0] = *(const u32x4*)(Kg + (size_t)(tid / CH) * DK + (tid % CH) * 8);
    if (64 * CH > 512) { const int c2 = tid + 512; if (c2 < 64 * CH) kr[1] = *(const u32x4*)(Kg + (size_t)(c2 / CH) * DK + (c2 % CH) * 8); }
}
template <int DK>
__device__ __forceinline__ void stage_k_store(const u32x4 (&kr)[2], LAS unsigned char* Kt, int tid) {
    constexpr int CH = DK / 8, KP = 2 * DK + 16;
    *(LAS u32x4*)(Kt + (tid / CH) * KP + (tid % CH) * 16) = kr[0];
    if (64 * CH > 512) { const int c2 = tid + 512; if (c2 < 64 * CH) *(LAS u32x4*)(Kt + (c2 / CH) * KP + (c2 % CH) * 16) = kr[1]; }
}
__device__ __forceinline__ u32x4 stage_v_load(const bf16_t* Vg, int tid) { return *(const u32x4*)(Vg + (size_t)(tid >> 3) * 64 + (tid & 7) * 8); }
__device__ __forceinline__ void stage_v_store(const u32x4& v, LAS unsigned char* Vt, int tid) { *(LAS u32x4*)(Vt + (tid >> 3) * VTP + (tid & 7) * 16) = v; }

constexpr int MLA_KT = 0, MLA_VT = 2 * 64 * 208, MLA_LDS = MLA_VT + 2 * 64 * VTP;
__device__ __forceinline__ void mla_unit(int b, int hd, int qt, int l, unsigned char* ws, LAS unsigned char* lds, int g_wv) {
    int tid_ = TIDX; asm volatile("" : "+v"(tid_));
    const int tid = tid_, w = tid >> 6, lane = tid & 63, r = lane & 31, h = lane >> 5;
    const size_t slab = (size_t)(b * 6 + hd) * 2048;
    const bf16_t* QM = (const bf16_t*)(ws + WS_MLA) + slab * 96; const bf16_t* KM = (const bf16_t*)(ws + WS_MLA + MLA_KM) + slab * 96; const bf16_t* VM = (const bf16_t*)(ws + WS_MLA + MLA_VM) + slab * 64;
    const int q0 = 256 * qt + 32 * w, q = q0 + r;
    bf16x8 qf[6];
#pragma unroll
    for (int ks = 0; ks < 6; ++ks) qf[ks] = *(const bf16x8*)(QM + (size_t)q * 96 + 16 * ks + 8 * h);
    AttnState A; attn_reset(A);
    const int ntile = 4 * qt + 4;
    u32x4 kr[2], vr, kr2[2], vr2;
    stage_k_load<96>(kr, KM, tid); vr = stage_v_load(VM, tid);
    stage_k_store<96>(kr, lds + MLA_KT, tid); stage_v_store(vr, lds + MLA_VT, tid);
    if (ntile > 1) { stage_k_load<96>(kr, KM + (size_t)64 * 96, tid); vr = stage_v_load(VM + (size_t)64 * 64, tid); }
    __syncthreads();
    for (int j = 0; j < ntile; ++j) {
        const int cur = j & 1;
        if (j + 2 < ntile) { stage_k_load<96>(kr2, KM + (size_t)(j + 2) * 64 * 96, tid); vr2 = stage_v_load(VM + (size_t)(j + 2) * 64 * 64, tid); }
        if (64 * j <= q0 + 31) {
            f32x16 s[2];
            attn_scores<96>(s, qf, lds + MLA_KT + cur * 64 * 208, r, h);
            if (64 * j + 63 > q0) {
#pragma unroll
                for (int kb = 0; kb < 2; ++kb)
#pragma unroll
                    for (int i = 0; i < 16; ++i) { const int key = 64 * j + 32 * kb + crow(i, h); if (key > q) s[kb][i] = -1e30f; }
            }
            attn_softmax_pv(A, s, lds + MLA_VT + cur * 64 * VTP, r, h);
        }
        if (j + 1 < ntile) { stage_k_store<96>(kr, lds + MLA_KT + (cur ^ 1) * 64 * 208, tid); stage_v_store(vr, lds + MLA_VT + (cur ^ 1) * 64 * VTP, tid); }
        kr[0] = kr2[0]; kr[1] = kr2[1]; vr = vr2;
        __syncthreads();
    }
    const float inv = A.l > 0.f ? 1.f / A.l : 0.f; float ss = 0.f;
    bf16_t* Y = (bf16_t*)(ws + WS_Y) + ((size_t)b * 2048 + q) * 1024 + 384 + hd * 64;
#pragma unroll
    for (int eb = 0; eb < 2; ++eb)
#pragma unroll
        for (int g4 = 0; g4 < 4; ++g4) {
            const float v0 = A.o[eb][4 * g4] * inv, v1 = A.o[eb][4 * g4 + 1] * inv, v2 = A.o[eb][4 * g4 + 2] * inv, v3 = A.o[eb][4 * g4 + 3] * inv;
            u32x2 pw; pw.x = pk_bf16(v0, v1); pw.y = pk_bf16(v2, v3);
            const float f0 = bf_lo(pw.x), f1 = bf_hi(pw.x), f2 = bf_lo(pw.y), f3 = bf_hi(pw.y); ss += (f0 * f0 + f1 * f1) + (f2 * f2 + f3 * f3);
            *(u32x2*)(Y + 32 * eb + 8 * g4 + 4 * h) = pw;
        }
    ss += __shfl_xor(ss, 32);
    if (h == 0) ((float*)(ws + WS_SSQ + PT_C))[((size_t)l * 16384 + (size_t)b * 2048 + q) * 8 + hd] = ss;
}

__device__ __forceinline__ void nsa_bias32(float (&bv)[2][16], const LAS float* bl, int dd) {
#pragma unroll
    for (int kb = 0; kb < 2; ++kb)
#pragma unroll
        for (int k = 0; k < 16; ++k) { const int c = 63 - (32 * kb + (k & 3) + 8 * (k >> 2)); int d = dd + c; d = d < 0 ? 0 : (d > 255 ? 255 : d); bv[kb][k] = bl[d]; }
}
__device__ __forceinline__ void nsa_mask_bias(f32x16 (&sc)[2], int dq, int h, const LAS float* bl, bool sel, int lim) {
    int dd = dq - 4 * h - 63; asm volatile("" : "+v"(dd));
    float bv[2][16]; nsa_bias32(bv, bl, dd);
#pragma unroll
    for (int kb = 0; kb < 2; ++kb)
#pragma unroll
        for (int k = 0; k < 16; ++k) { const int c = 63 - (32 * kb + (k & 3) + 8 * (k >> 2)); const int d = dd + c; sc[kb][k] = (sel && d >= 0 && d < lim) ? sc[kb][k] + bv[kb][k] : -1e30f; }
}

constexpr int NSA_KT = 0, NSA_VT = 2 * 64 * 144, NSA_BIAS = NSA_VT + 2 * 64 * VTP, NSA_PS = NSA_BIAS + 3 * 256 * 4, NSA_SEL = NSA_PS + 3 * 64 * 32 * 4, NSA_UNI = NSA_SEL + 256, NSA_OT = NSA_UNI + 256, NSA_LDS = NSA_OT + 6 * 8192;
__device__ __forceinline__ void nsa_unit(int b, int hk, int i, int l, InPtr in, unsigned char* ws, LAS unsigned char* lds, int g_wv) {
    int tid_ = TIDX; asm volatile("" : "+v"(tid_));
    const int tid = tid_, w = tid >> 6, lane = tid & 63, r = lane & 31, h = lane >> 5;
    const bool active = w < 6; const int g = active ? (w >> 1) : 0, th = w & 1, head = hk * 3 + g;
    const int t = 64 * i + 32 * th + r, tl = 32 * th + r; const size_t row = (size_t)b * 2048 + t;
    const size_t kvslab = (size_t)(b * 2 + hk) * 2048 * 64;
    LAS float* biasl = (LAS float*)(lds + NSA_BIAS); LAS float* PS = (LAS float*)(lds + NSA_PS); LAS unsigned* SEL = (LAS unsigned*)(lds + NSA_SEL); LAS unsigned* UNI = (LAS unsigned*)(lds + NSA_UNI);
    { const float* bd = (const float*)(ws + WS_BIASD) + (size_t)hk * 3 * 2048;
      if (tid < 384) { const int gg = tid >> 7, d0 = (tid & 127) * 2; biasl[gg * 256 + d0] = bd[gg * 2048 + d0]; biasl[gg * 256 + d0 + 1] = bd[gg * 2048 + d0 + 1]; }
#pragma unroll
      for (int k = 0; k < 12; ++k) if (i >= 16) PS[tid + 512 * k] = 0.f;
      if (tid < 4) UNI[tid] = 0u; }
    bf16x8 qf[4];
    { const bf16_t* QN = (const bf16_t*)(ws + WS_PRJ + PRJ_QN) + ((size_t)(b * 6 + head) * 2048 + t) * 64;
#pragma unroll
      for (int ks = 0; ks < 4; ++ks) qf[ks] = *(const bf16x8*)(QN + 16 * ks + 8 * h); }
#define NSA_GATE(k) ({ int t_ = t; asm volatile("" : "+v"(t_)); sigmf(((const float*)(ws + WS_PRJ + PRJ_GATES))[((size_t)b * 2048 + t_) * 32 + head * 3 + (k)]); })
    LAS float* bl = biasl + g * 256;
    LAS float* otl = (LAS float*)(lds + NSA_OT + (active ? w : 0) * 8192) + lane;
    u32x4 kr[2], vr;
    const int ntc = i >= 16 ? 2 : 1;
    { const bf16_t* KC = (const bf16_t*)(ws + WS_CMP) + (size_t)(b * 2 + hk) * 128 * 64; const bf16_t* VC = (const bf16_t*)(ws + WS_CMP + CMP_V) + (size_t)(b * 2 + hk) * 128 * 64;
      for (int T = 0; T < ntc; ++T) { stage_k_load<64>(kr, KC + T * 4096, tid); vr = stage_v_load(VC + T * 4096, tid); stage_k_store<64>(kr, lds + NSA_KT + T * 64 * 144, tid); stage_v_store(vr, lds + NSA_VT + T * 64 * VTP, tid); } }
    __syncthreads();
    {
        f32x16 ot[2];
        if (active && i < 16) {
            AttnState A; attn_reset(A); f32x16 sc[2]; attn_scores<64>(sc, qf, lds + NSA_KT, r, h);
            float bvc[2][16];
#pragma unroll
            for (int kb = 0; kb < 2; ++kb)
#pragma unroll
                for (int k = 0; k < 16; ++k) { int d = t - 16 * (32 * kb + crow(k, h)) - 31; d = d < 0 ? 0 : (d > 255 ? 255 : d); bvc[kb][k] = bl[d]; }
#pragma unroll
            for (int kb = 0; kb < 2; ++kb)
#pragma unroll
                for (int k = 0; k < 16; ++k) { const int d = t - 16 * (32 * kb + crow(k, h)) - 31; sc[kb][k] = d >= 0 ? sc[kb][k] + bvc[kb][k] : -1e30f; }
            attn_softmax_pv(A, sc, lds + NSA_VT, r, h);
            const float gc = NSA_GATE(0); const float inv = A.l > 0.f ? gc / A.l : 0.f;
#pragma unroll
            for (int k = 0; k < 16; ++k) { otl[64 * k] = A.o[0][k] * inv; otl[64 * (16 + k)] = A.o[1][k] * inv; }
        } else if (active) {
            float m = -1e30f, lsum = 0.f;
            for (int T = 0; T < ntc; ++T) {
                f32x16 sc[2]; attn_scores<64>(sc, qf, lds + NSA_KT + T * 64 * 144, r, h);
                float bvc[2][16];
#pragma unroll
                for (int kb = 0; kb < 2; ++kb)
#pragma unroll
                    for (int k = 0; k < 16; ++k) { int d = t - 16 * (64 * T + 32 * kb + crow(k, h)) - 31; d = d < 0 ? 0 : (d > 255 ? 255 : d); bvc[kb][k] = bl[d]; }
                float mx = -1e30f;
#pragma unroll
                for (int kb = 0; kb < 2; ++kb)
#pragma unroll
                    for (int k = 0; k < 16; ++k) { const int n = 64 * T + 32 * kb + crow(k, h); const int d = t - 16 * n - 31; const float x = (d >= 0 && n < 127) ? sc[kb][k] + bvc[kb][k] : -1e30f; sc[kb][k] = x; mx = fmaxf(mx, x); }
                mx = fmaxf(mx, __shfl_xor(mx, 32));
                const float mnew = fmaxf(m, mx), mref = mnew <= -1e29f ? 0.f : mnew; float rs = 0.f;
#pragma unroll
                for (int kb = 0; kb < 2; ++kb)
#pragma unroll
                    for (int k = 0; k < 16; ++k) rs += __builtin_amdgcn_exp2f(sc[kb][k] - mref);
                rs += __shfl_xor(rs, 32);
                lsum = lsum * __builtin_amdgcn_exp2f(m - mref) + rs; m = mnew;
            }
            const float mref = m <= -1e29f ? 0.f : m, inv = lsum > 0.f ? 1.f / lsum : 0.f;
#pragma unroll
            for (int k = 0; k < 16; ++k) { ot[0][k] = 0.f; ot[1][k] = 0.f; }
            float carry = 0.f;
            for (int T = 0; T < ntc; ++T) {
                f32x16 sc[2]; attn_scores<64>(sc, qf, lds + NSA_KT + T * 64 * 144, r, h);
                float bvc[2][16];
#pragma unroll
                for (int kb = 0; kb < 2; ++kb)
#pragma unroll
                    for (int k = 0; k < 16; ++k) { int d = t - 16 * (64 * T + 32 * kb + crow(k, h)) - 31; d = d < 0 ? 0 : (d > 255 ? 255 : d); bvc[kb][k] = bl[d]; }
#pragma unroll
                for (int kb = 0; kb < 2; ++kb)
#pragma unroll
                    for (int k = 0; k < 16; ++k) { const int n = 64 * T + 32 * kb + crow(k, h); const int d = t - 16 * n - 31; sc[kb][k] = (d >= 0 && n < 127) ? __builtin_amdgcn_exp2f(sc[kb][k] + bvc[kb][k] - mref) * inv : 0.f; }
                float prevL = carry;
#pragma unroll
                for (int kb = 0; kb < 2; ++kb)
#pragma unroll
                    for (int g4 = 0; g4 < 4; ++g4) {
                        const float G4 = (sc[kb][4 * g4] + sc[kb][4 * g4 + 1]) + (sc[kb][4 * g4 + 2] + sc[kb][4 * g4 + 3]); const float L = sc[kb][4 * g4 + 3];
                        const float Lo = __shfl_xor(L, 32);
                        const float add = h ? Lo : prevL;
                        prevL = Lo;
                        const int idx = T * 8 + kb * 4 + g4;
                        PS[g * 2048 + tl * 32 + 2 * idx + h] = G4 + add;
                    }
                carry = prevL;
#pragma unroll
                for (int s4 = 0; s4 < 4; ++s4) {
                    const int kb = s4 >> 1, hf = (s4 & 1) * 8;
                    u32x4 pw; pw.x = pk_bf16(sc[kb][hf + 0], sc[kb][hf + 1]); pw.y = pk_bf16(sc[kb][hf + 2], sc[kb][hf + 3]); pw.z = pk_bf16(sc[kb][hf + 4], sc[kb][hf + 5]); pw.w = pk_bf16(sc[kb][hf + 6], sc[kb][hf + 7]);
                    const bf16x8 pf = __builtin_bit_cast(bf16x8, pw);
#pragma unroll
                    for (int eb = 0; eb < 2; ++eb) ot[eb] = MFMA32(vt_frag(lds + NSA_VT + T * 64 * VTP, vt_lane_off(lane), s4, eb), pf, ot[eb]);
                }
            }
            { const float gc = NSA_GATE(0);
#pragma unroll
            for (int k = 0; k < 16; ++k) { otl[64 * k] = ot[0][k] * gc; otl[64 * (16 + k)] = ot[1][k] * gc; } }
        }
    }
    __syncthreads();
#ifndef NO_NSA_SEL
    if (i < 16) { if (tid < 64) SEL[tid] = (2u << i) - 1u; if (tid < 3) UNI[tid] = (2u << i) - 1u; }
    else {
        const int tk = tid >> 3, sg = tid & 7; float v[32];
#pragma unroll
        for (int k = 0; k < 8; ++k) { const f32x4 x0 = *(const LAS f32x4*)(PS + tk * 32 + 4 * k), x1 = *(const LAS f32x4*)(PS + 2048 + tk * 32 + 4 * k), x2 = *(const LAS f32x4*)(PS + 4096 + tk * 32 + 4 * k);
            v[4 * k] = (x0.x + x1.x) + x2.x; v[4 * k + 1] = (x0.y + x1.y) + x2.y; v[4 * k + 2] = (x0.z + x1.z) + x2.z; v[4 * k + 3] = (x0.w + x1.w) + x2.w; }
#pragma unroll
        for (int s = 0; s < 32; ++s) { const bool forced = (s == 0) || (s == i) || (s == i - 1); float x = forced ? v[s] + 1e4f : v[s]; v[s] = s > i ? -1.f : x; }
        unsigned bits = 0u;
#pragma unroll
        for (int k = 0; k < 4; ++k) {
            float x = 0.f;
#pragma unroll
            for (int s = 0; s < 32; ++s) x = (s == 4 * sg + k) ? v[s] : x;
            int rank = 0;
#pragma unroll
            for (int s = 0; s < 32; ++s) rank += (v[s] > x || (v[s] == x && s < 4 * sg + k)) ? 1 : 0;
            if (rank < 16 && x >= 0.f) bits |= 1u << (4 * sg + k);
        }
        bits |= __shfl_xor(bits, 1); bits |= __shfl_xor(bits, 2); bits |= __shfl_xor(bits, 4);
        if (sg == 0) { SEL[tk] = bits; __hip_atomic_fetch_or(UNI, bits, __ATOMIC_RELAXED, __HIP_MEMORY_SCOPE_WORKGROUP); __hip_atomic_fetch_or(UNI + 1 + (tk >> 5), bits, __ATOMIC_RELAXED, __HIP_MEMORY_SCOPE_WORKGROUP); }
    }
#endif
    __syncthreads();
    const unsigned selbits = SEL[tl], uni = UNI[0], unih = UNI[1 + th];
    const float c31 = bl[255];
#ifndef NO_NSA_SLC
#ifndef NSA_DUP_SLC
#define NSA_DUP_SLC 1
#endif
    for (int rp_ = 0; rp_ < NSA_DUP_SLC; ++rp_) {
        AttnState A; attn_reset(A);
        const bf16_t* KS = (const bf16_t*)(ws + WS_PRJ + PRJ_KN1) + kvslab; const bf16_t* VS = (const bf16_t*)(ws + WS_PRJ + PRJ_VN1) + kvslab;
        unsigned todo = uni; int cur = 0; u32x4 kr2[2], vr2;
        int s = __ffs(todo) - 1; todo &= todo - 1;
        stage_k_load<64>(kr, KS + (size_t)s * 4096, tid); vr = stage_v_load(VS + (size_t)s * 4096, tid);
        stage_k_store<64>(kr, lds + NSA_KT, tid); stage_v_store(vr, lds + NSA_VT, tid);
        int sn = todo ? __ffs(todo) - 1 : -1; todo &= todo - 1;
        if (sn >= 0) { stage_k_load<64>(kr, KS + (size_t)sn * 4096, tid); vr = stage_v_load(VS + (size_t)sn * 4096, tid); }
        __syncthreads();
        while (s >= 0) {
            const int sn2 = todo ? __ffs(todo) - 1 : -1; todo &= todo - 1;
            if (sn2 >= 0) { stage_k_load<64>(kr2, KS + (size_t)sn2 * 4096, tid); vr2 = stage_v_load(VS + (size_t)sn2 * 4096, tid); }
            if (active && ((unih >> s) & 1u)) {
                f32x16 sc[2];
                attn_scores<64>(sc, qf, lds + NSA_KT + cur * 64 * 144, r, h);
                const bool sel = (selbits >> s) & 1u;
                if (i - s >= 3) attn_softmax_pv(A, sc, lds + NSA_VT + cur * 64 * VTP, r, h, c31, sel);
                else { nsa_mask_bias(sc, t - 64 * s, h, bl, sel, 4096); attn_softmax_pv(A, sc, lds + NSA_VT + cur * 64 * VTP, r, h); }
            }
            if (sn >= 0) { stage_k_store<64>(kr, lds + NSA_KT + (cur ^ 1) * 64 * 144, tid); stage_v_store(vr, lds + NSA_VT + (cur ^ 1) * 64 * VTP, tid); }
            kr[0] = kr2[0]; vr = vr2;
            __syncthreads();
            s = sn; sn = sn2; cur ^= 1;
        }
        if (active && rp_ == NSA_DUP_SLC - 1) { const float gs = NSA_GATE(1); const float inv = A.l > 0.f ? gs / A.l : 0.f;
#pragma unroll
            for (int k = 0; k < 16; ++k) { otl[64 * k] += A.o[0][k] * inv; otl[64 * (16 + k)] += A.o[1][k] * inv; } }
    }
#endif
#ifndef NO_NSA_WIN
#ifndef NSA_DUP_WIN
#define NSA_DUP_WIN 1
#endif
    for (int rq_ = 0; rq_ < NSA_DUP_WIN; ++rq_) {
        AttnState A; attn_reset(A);
        const bf16_t* KW = (const bf16_t*)(ws + WS_PRJ + PRJ_KN2) + kvslab; const bf16_t* VW = (const bf16_t*)(ws + WS_PRJ + PRJ_VN2) + kvslab;
        const int j0 = i > 8 ? i - 8 : 0; int cur = 0; u32x4 kr2[2], vr2;
        stage_k_load<64>(kr, KW + (size_t)j0 * 4096, tid); vr = stage_v_load(VW + (size_t)j0 * 4096, tid);
        stage_k_store<64>(kr, lds + NSA_KT, tid); stage_v_store(vr, lds + NSA_VT, tid);
        if (j0 < i) { stage_k_load<64>(kr, KW + (size_t)(j0 + 1) * 4096, tid); vr = stage_v_load(VW + (size_t)(j0 + 1) * 4096, tid); }
        __syncthreads();
        for (int j = j0; j <= i; ++j) {
            if (j + 2 <= i) { stage_k_load<64>(kr2, KW + (size_t)(j + 2) * 4096, tid); vr2 = stage_v_load(VW + (size_t)(j + 2) * 4096, tid); }
            if (active) {
                f32x16 sc[2];
                attn_scores<64>(sc, qf, lds + NSA_KT + cur * 64 * 144, r, h);
                if (i - j >= 3 && j > i - 8) attn_softmax_pv(A, sc, lds + NSA_VT + cur * 64 * VTP, r, h, c31, true);
                else { nsa_mask_bias(sc, t - 64 * j, h, bl, true, 512); attn_softmax_pv(A, sc, lds + NSA_VT + cur * 64 * VTP, r, h); }
            }
            if (j < i) { stage_k_store<64>(kr, lds + NSA_KT + (cur ^ 1) * 64 * 144, tid); stage_v_store(vr, lds + NSA_VT + (cur ^ 1) * 64 * VTP, tid); }
            kr[0] = kr2[0]; vr = vr2;
            __syncthreads();
            cur ^= 1;
        }
        if (active && rq_ == NSA_DUP_WIN - 1) { const float gw = NSA_GATE(2); const float inv = A.l > 0.f ? gw / A.l : 0.f;
            float ss = 0.f; bf16_t* Y = (bf16_t*)(ws + WS_Y) + row * 1024 + head * 64;
#pragma unroll
            for (int eb = 0; eb < 2; ++eb)
#pragma unroll
                for (int g4 = 0; g4 < 4; ++g4) {
                    const float v0 = otl[64 * (16 * eb + 4 * g4)] + A.o[eb][4 * g4] * inv, v1 = otl[64 * (16 * eb + 4 * g4 + 1)] + A.o[eb][4 * g4 + 1] * inv;
                    const float v2 = otl[64 * (16 * eb + 4 * g4 + 2)] + A.o[eb][4 * g4 + 2] * inv, v3 = otl[64 * (16 * eb + 4 * g4 + 3)] + A.o[eb][4 * g4 + 3] * inv;
                    u32x2 pw; pw.x = pk_bf16(v0, v1); pw.y = pk_bf16(v2, v3);
                    const float f0 = bf_lo(pw.x), f1 = bf_hi(pw.x), f2 = bf_lo(pw.y), f3 = bf_hi(pw.y); ss += (f0 * f0 + f1 * f1) + (f2 * f2 + f3 * f3);
                    *(u32x2*)(Y + 32 * eb + 8 * g4 + 4 * h) = pw;
                }
            ss += __shfl_xor(ss, 32);
            if (h == 0) ((float*)(ws + WS_SSQ + PT_A))[((size_t)l * 16384 + row) * 8 + head] = ss;
        }
    }
#endif
}

__device__ __forceinline__ void ml_out_wave(int cu, int l, InPtr in, unsigned char* ws, LAS unsigned char* wl, LAS unsigned char* npl, int lane) {
    const int c = cu & 31, bh = cu >> 5, hd = bh & 3, b = bh >> 2; const int t0 = c * 64; const int r = lane & 15, q = lane >> 4;
    const bf16_t* QC = (const bf16_t*)(ws + WS_ML) + ((size_t)bh * 2048 + t0) * 64; const bf16_t* KC = (const bf16_t*)(ws + WS_ML + ML_KC) + ((size_t)bh * 2048 + t0) * 64;
    const bf16_t* V = (const bf16_t*)(ws + WS_PRJ + PRJ_VML) + ((size_t)bh * 2048 + t0) * 64;
    const float* mlg = (const float*)(ws + WS_ML + ML_G) + ((size_t)bh * 2048 + t0) * 2;
    const bf16_t* CP = (const bf16_t*)(ws + WS_ML + ML_CP) + (size_t)cu * 4096; const bf16_t* NP = (const bf16_t*)(ws + WS_ML + ML_NP) + (size_t)cu * 64;
    bf16x8 aq[4][2];
#pragma unroll
    for (int mb = 0; mb < 4; ++mb)
#pragma unroll
        for (int ks = 0; ks < 2; ++ks) aq[mb][ks] = *(const bf16x8*)(QC + (size_t)(16 * mb + r) * 64 + 32 * ks + 8 * q);
    float bj[4][4], den[4][4];
#pragma unroll
    for (int mb = 0; mb < 4; ++mb)
#pragma unroll
        for (int j = 0; j < 4; ++j) bj[mb][j] = mlg[(16 * mb + 4 * q + j) * 2];
    {
        float cs[4];
#pragma unroll
        for (int nb = 0; nb < 4; ++nb) { const float2 gg = *(const float2*)(mlg + (16 * nb + r) * 2); cs[nb] = gg.y - gg.x; }
#pragma unroll
        for (int mb = 0; mb < 4; ++mb) {
            f32x4 accS[4];
#pragma unroll
            for (int nb = 0; nb < 4; ++nb) { accS[nb] = (f32x4){0.f, 0.f, 0.f, 0.f};
#pragma unroll
                for (int ks = 0; ks < 2; ++ks) { const bf16x8 bk = *(const bf16x8*)(KC + (size_t)(16 * nb + r) * 64 + 32 * ks + 8 * q); accS[nb] = MFMA16(aq[mb][ks], bk, accS[nb]); } }
#pragma unroll
            for (int j = 0; j < 4; ++j) {
                const int jj = 16 * mb + 4 * q + j; float rs = 0.f;
#pragma unroll
                for (int nb = 0; nb < 4; ++nb) { const int s = 16 * nb + r; const float p = s <= jj ? accS[nb][j] * __expf(bj[mb][j] + cs[nb]) : 0.f; rs += p;
                    *(LAS bf16_t*)(wl + 8192 + swz_off(jj, s >> 3) + (s & 7) * 2) = f2bf(p); }
                rs += __shfl_xor(rs, 1); rs += __shfl_xor(rs, 2); rs += __shfl_xor(rs, 4); rs += __shfl_xor(rs, 8);
                den[mb][j] = rs;
            }
        }
    }
#pragma unroll
    for (int mb = 0; mb < 4; ++mb) { const float e = __expf(mlg[(16 * mb + r) * 2]);
#pragma unroll
        for (int ks = 0; ks < 2; ++ks) { const u32x4 x = __builtin_bit_cast(u32x4, aq[mb][ks]); u32x4 y;
            y.x = pk_bf16(bf_lo(x.x) * e, bf_hi(x.x) * e); y.y = pk_bf16(bf_lo(x.y) * e, bf_hi(x.y) * e); y.z = pk_bf16(bf_lo(x.z) * e, bf_hi(x.z) * e); y.w = pk_bf16(bf_lo(x.w) * e, bf_hi(x.w) * e);
            aq[mb][ks] = __builtin_bit_cast(bf16x8, y); } }
    f32x4 acc[4][4], accn[4];
#pragma unroll
    for (int mb = 0; mb < 4; ++mb) { accn[mb] = (f32x4){0.f, 0.f, 0.f, 0.f};
#pragma unroll
        for (int nb = 0; nb < 4; ++nb) acc[mb][nb] = (f32x4){0.f, 0.f, 0.f, 0.f}; }
#pragma unroll
    for (int ks = 0; ks < 2; ++ks) {
        u32x4 nz = *(const u32x4*)(NP + 32 * ks + 8 * q); if (r != 0) nz = (u32x4){0u, 0u, 0u, 0u};
        const bf16x8 bn = __builtin_bit_cast(bf16x8, nz);
#pragma unroll
        for (int nb = 0; nb < 4; ++nb) { const bf16x8 bb = *(const bf16x8*)(CP + (size_t)(16 * nb + r) * 64 + 32 * ks + 8 * q);
#pragma unroll
            for (int mb = 0; mb < 4; ++mb) acc[mb][nb] = MFMA16(aq[mb][ks], bb, acc[mb][nb]); }
#pragma unroll
        for (int mb = 0; mb < 4; ++mb) accn[mb] = MFMA16(aq[mb][ks], bn, accn[mb]);
    }
#pragma unroll
    for (int s8 = 0; s8 < 8; ++s8) { float vb[8];
#pragma unroll
        for (int j = 0; j < 8; ++j) vb[j] = bf2f(V[(size_t)(s8 * 8 + j) * 64 + lane]);
        u32x4 pk; pk.x = pk_bf16(vb[0], vb[1]); pk.y = pk_bf16(vb[2], vb[3]); pk.z = pk_bf16(vb[4], vb[5]); pk.w = pk_bf16(vb[6], vb[7]);
        *(LAS u32x4*)(wl + swz_off(lane, s8)) = pk; }
    LDS_FENCE();
#pragma unroll
    for (int ks = 0; ks < 2; ++ks) {
        bf16x8 ap[4];
#pragma unroll
        for (int mb = 0; mb < 4; ++mb) ap[mb] = *(const LAS bf16x8*)(wl + 8192 + swz_off(16 * mb + r, 4 * ks + q));
#pragma unroll
        for (int nb = 0; nb < 4; ++nb) { const bf16x8 bv = *(const LAS bf16x8*)(wl + swz_off(16 * nb + r, 4 * ks + q));
#pragma unroll
            for (int mb = 0; mb < 4; ++mb) acc[mb][nb] = MFMA16(ap[mb], bv, acc[mb][nb]); }
    }
    LDS_FENCE();
    const float* gain = in->p[14] + l * 256 + hd * 64; const bf16_t* OG = (const bf16_t*)(ws + WS_PRJ + PRJ_OG);
    bf16_t* Y = (bf16_t*)(ws + WS_Y);
#pragma unroll
    for (int mb = 0; mb < 4; ++mb)
#pragma unroll
        for (int j = 0; j < 4; ++j) {
            const int jj = 16 * mb + 4 * q + j;
            const float dn = den[mb][j] + __builtin_bit_cast(float, __builtin_amdgcn_ds_bpermute((lane & 48) << 2, __builtin_bit_cast(int, accn[mb][j])));
            const float inv = 1.f / fmaxf(fabsf(dn), 1.f); float hv[4]; float ss = 0.f;
#pragma unroll
            for (int nb = 0; nb < 4; ++nb) { hv[nb] = acc[mb][nb][j] * inv; ss += hv[nb] * hv[nb]; }
            ss += __shfl_xor(ss, 1); ss += __shfl_xor(ss, 2); ss += __shfl_xor(ss, 4); ss += __shfl_xor(ss, 8);
            const float rstd = rsqrtf(ss * (1.f / 64.f) + 1e-6f); const size_t row = (size_t)b * 2048 + t0 + jj;
#pragma unroll
            for (int nb = 0; nb < 4; ++nb) { const int e = 16 * nb + r; Y[row * 1024 + 768 + hd * 64 + e] = f2bf(hv[nb] * rstd * gain[e] * sigmf(bf2f(OG[row * 256 + hd * 64 + e]))); }
        }
}

__device__ __forceinline__ void ml_scan_unit(int bh, int l, unsigned char* ws, int g_wv) {
    int tid_ = TIDX; asm volatile("" : "+v"(tid_)); const int tid = tid_;
    const bf16_t* DL = (const bf16_t*)(ws + WS_ML + ML_DELTA) + (size_t)bh * 32 * 4096 + tid * 8; bf16_t* CP = (bf16_t*)(ws + WS_ML + ML_CP) + (size_t)bh * 32 * 4096 + tid * 8;
    const float* DN = (const float*)(ws + WS_ML + ML_DN) + (size_t)bh * 32 * 64; bf16_t* NP = (bf16_t*)(ws + WS_ML + ML_NP) + (size_t)bh * 32 * 64; const float* BL = (const float*)(ws + WS_ML + ML_BL) + bh * 32;
    float c[8]; float n = 0.f;
#pragma unroll
    for (int k = 0; k < 8; ++k) c[k] = 0.f;
#pragma unroll 1
    for (int c0 = 0; c0 < 32; c0 += 8) {
        u32x4 d[8]; float dn[8], co[8];
#pragma unroll
        for (int k = 0; k < 8; ++k) { d[k] = *(const u32x4*)(DL + (size_t)(c0 + k) * 4096); dn[k] = tid < 64 ? DN[(c0 + k) * 64 + tid] : 0.f; co[k] = __expf(BL[c0 + k]); }
#pragma unroll
        for (int k = 0; k < 8; ++k) {
            u32x4 o; o.x = pk_bf16(c[0], c[1]); o.y = pk_bf16(c[2], c[3]); o.z = pk_bf16(c[4], c[5]); o.w = pk_bf16(c[6], c[7]);
            *(u32x4*)(CP + (size_t)(c0 + k) * 4096) = o; if (tid < 64) NP[(c0 + k) * 64 + tid] = f2bf(n);
            c[0] = co[k] * c[0] + bf_lo(d[k].x); c[1] = co[k] * c[1] + bf_hi(d[k].x); c[2] = co[k] * c[2] + bf_lo(d[k].y); c[3] = co[k] * c[3] + bf_hi(d[k].y);
            c[4] = co[k] * c[4] + bf_lo(d[k].z); c[5] = co[k] * c[5] + bf_hi(d[k].z); c[6] = co[k] * c[6] + bf_lo(d[k].w); c[7] = co[k] * c[7] + bf_hi(d[k].w);
            n = co[k] * n + dn[k];
        }
    }
    asm volatile("s_waitcnt vmcnt(0)" ::: "memory"); __syncthreads();
    if (tid == 0) { __builtin_amdgcn_fence(__ATOMIC_RELEASE, "agent"); asm volatile("s_waitcnt vmcnt(0)" ::: "memory");
        __hip_atomic_fetch_add((unsigned*)(ws + WS_CTL) + CW_SCAN + 64 * l, 1u, __ATOMIC_RELAXED, __HIP_MEMORY_SCOPE_AGENT); }
}
__device__ __forceinline__ void ml_scan_wait(int l, unsigned char* ws, int g_wv) {
    if (TIDX == 0) { unsigned* p = (unsigned*)(ws + WS_CTL) + CW_SCAN + 64 * l; unsigned sp = 0;
        while (__hip_atomic_load(p, __ATOMIC_RELAXED, __HIP_MEMORY_SCOPE_AGENT) < 32u) { __builtin_amdgcn_s_sleep(2); if (++sp > (1u << 22)) break; }
        __builtin_amdgcn_fence(__ATOMIC_ACQUIRE, "agent"); asm volatile("s_waitcnt vmcnt(0)" ::: "memory"); }
    __syncthreads();
}

#ifndef DUP_NSA
#define DUP_NSA 1
#endif
#ifndef DUP_MLA
#define DUP_MLA 1
#endif
#ifndef DUP_ML
#define DUP_ML 1
#endif
#ifdef NO_MLA
#define MLA_CALL(...) do {} while (0)
#else
#define MLA_CALL(...) do { for (int rp = 0; rp < DUP_MLA; ++rp) { if (rp) __syncthreads(); mla_unit(__VA_ARGS__); } } while (0)
#endif
__device__ __forceinline__ void phase_mix(int l, InPtr in, unsigned char* ws, LAS unsigned char* lds, unsigned* qhead, int g_wv) {
    LAS int* slot = (LAS int*)(lds + LDS_MISC + 64);
    for (;;) {
        __syncthreads();
        if (TIDX == 0) *slot = (int)__hip_atomic_fetch_add(qhead, 1u, __ATOMIC_RELAXED, __HIP_MEMORY_SCOPE_AGENT);
        __syncthreads();
        int u = *slot;
        if (u >= 32 + 512 + 384 + 128) break;
        if (u < 32) { ml_scan_unit(u, l, ws, g_wv); continue; } u -= 32;
#ifndef NO_NSA
        if (u < 256) { const int i = 31 - (u >> 4), bh = u & 15; { for (int rp = 0; rp < DUP_NSA; ++rp) { if (rp) __syncthreads(); nsa_unit(bh >> 1, bh & 1, i, l, in, ws, lds, g_wv); } } continue; }
#endif
        u -= 256;
        if (u < 192) { const int qt = 7 - u / 48, bh = u % 48; MLA_CALL(bh / 6, bh % 6, qt, l, ws, lds, g_wv); continue; }
        u -= 192;
#ifndef NO_NSA
        if (u < 128) { const int i = 15 - (u >> 4), bh = u & 15; { for (int rp = 0; rp < DUP_NSA; ++rp) { if (rp) __syncthreads(); nsa_unit(bh >> 1, bh & 1, i, l, in, ws, lds, g_wv); } } continue; }
#endif
        u -= 128;
        if (u < 192) { const int qt = 3 - u / 48, bh = u % 48; MLA_CALL(bh / 6, bh % 6, qt, l, ws, lds, g_wv); continue; } u -= 192;
#ifndef NO_NSA
        if (u < 128) { const int i = 7 - (u >> 4), bh = u & 15; { for (int rp = 0; rp < DUP_NSA; ++rp) { if (rp) __syncthreads(); nsa_unit(bh >> 1, bh & 1, i, l, in, ws, lds, g_wv); } } continue; }
#endif
        u -= 128;
#ifndef NO_MLOUT
        ml_scan_wait(l, ws, g_wv);
        for (int rp = 0; rp < DUP_ML; ++rp) { int tid_ = TIDX; asm volatile("" : "+v"(tid_)); const int w = tid_ >> 6; ml_out_wave(u * 8 + w, l, in, ws, lds + w * 16384, lds + 131072 + w * 256, tid_ & 63); }
#endif
    }
}
__device__ __forceinline__ void phase_ynorm(int l, unsigned char* ws, int bid, int nb, int g_wv) {
    int tid_ = TIDX; asm volatile("" : "+v"(tid_)); const int w = tid_ >> 6, lane = tid_ & 63;
    bf16_t* Y = (bf16_t*)(ws + WS_Y); const float* sa = (const float*)(ws + WS_SSQ + PT_A) + (size_t)l * 16384 * 8; const float* sc = (const float*)(ws + WS_SSQ + PT_C) + (size_t)l * 16384 * 8;
    for (int r0 = (bid * 8 + w) * 8; r0 < NTOK; r0 += nb * 64) {
        if (lane < 48) {
            u32x4 x[8], y[8]; float ra[8], rc[8];
#pragma unroll
            for (int k = 0; k < 8; ++k) { const int row = r0 + k;
                const f32x4 a0 = *(const f32x4*)(sa + (size_t)row * 8), a1 = *(const f32x4*)(sa + (size_t)row * 8 + 4), c0 = *(const f32x4*)(sc + (size_t)row * 8), c1 = *(const f32x4*)(sc + (size_t)row * 8 + 4);
                ra[k] = rsqrtf((((a0.x + a0.y) + (a0.z + a0.w)) + (a1.x + a1.y)) * (1.f / 384.f) + 1e-6f); rc[k] = rsqrtf((((c0.x + c0.y) + (c0.z + c0.w)) + (c1.x + c1.y)) * (1.f / 384.f) + 1e-6f);
                x[k] = *((const u32x4*)(Y + (size_t)row * 1024) + lane); y[k] = *((const u32x4*)(Y + (size_t)row * 1024 + 384) + lane); }
#pragma unroll
            for (int k = 0; k < 8; ++k) { const int row = r0 + k; u32x4 a = x[k], c = y[k]; const float fa = ra[k], fc = rc[k];
                a.x = pk_bf16(bf_lo(a.x) * fa, bf_hi(a.x) * fa); a.y = pk_bf16(bf_lo(a.y) * fa, bf_hi(a.y) * fa); a.z = pk_bf16(bf_lo(a.z) * fa, bf_hi(a.z) * fa); a.w = pk_bf16(bf_lo(a.w) * fa, bf_hi(a.w) * fa);
                c.x = pk_bf16(bf_lo(c.x) * fc, bf_hi(c.x) * fc); c.y = pk_bf16(bf_lo(c.y) * fc, bf_hi(c.y) * fc); c.z = pk_bf16(bf_lo(c.z) * fc, bf_hi(c.z) * fc); c.w = pk_bf16(bf_lo(c.w) * fc, bf_hi(c.w) * fc);
                *((u32x4*)(Y + (size_t)row * 1024) + lane) = a; *((u32x4*)(Y + (size_t)row * 1024 + 384) + lane) = c; }
        }
    }
}
constexpr int LDS_FAC = 131072 + 2048;
__device__ __forceinline__ void outproj_factors(int l, unsigned char* ws, LAS unsigned char* lds, int pm, int tid) {
    asm volatile("" : "+v"(tid));
    if (tid < 256) { const int row = pm * 256 + tid; const float* sa = (const float*)(ws + WS_SSQ + PT_A) + ((size_t)l * 16384 + row) * 8; const float* sc = (const float*)(ws + WS_SSQ + PT_C) + ((size_t)l * 16384 + row) * 8;
        const f32x4 a0 = *(const f32x4*)sa, a1 = *(const f32x4*)(sa + 4), c0 = *(const f32x4*)sc, c1 = *(const f32x4*)(sc + 4);
        const float ra = rsqrtf((((a0.x + a0.y) + (a0.z + a0.w)) + (a1.x + a1.y)) * (1.f / 384.f) + 1e-6f), rc = rsqrtf((((c0.x + c0.y) + (c0.z + c0.w)) + (c1.x + c1.y)) * (1.f / 384.f) + 1e-6f);
        LAS float* F = (LAS float*)(lds + LDS_FAC); F[2 * tid] = ra / rc; F[2 * tid + 1] = rc; }
    __syncthreads();
}
struct EpiOut {
    static constexpr bool KHOOK = true;
    bf16_t* XB; float* ssq; const LAS float* F; bool fold;
    __device__ __forceinline__ void kscale(f32x4 (&acc)[2][2][4][2], int which, int wr, int fr) const {
        if (!fold) return;
#pragma unroll
        for (int ai = 0; ai < 2; ++ai)
#pragma unroll
            for (int m = 0; m < 4; ++m) { const float f = F[2 * (ai * 128 + wr * 64 + m * 16 + fr) + which];
#pragma unroll
                for (int bj = 0; bj < 2; ++bj)
#pragma unroll
                    for (int n = 0; n < 2; ++n) acc[ai][bj][m][n] = acc[ai][bj][m][n] * f; }
    }
    __device__ __forceinline__ void operator()(const f32x4 (&acc)[2][2][4][2], const GUnit& u, int wr, int wc, int fr, int fq) const {
#pragma unroll
        for (int ai = 0; ai < 2; ++ai)
#pragma unroll
          for (int mh = 0; mh < 2; ++mh) {
            __builtin_amdgcn_sched_barrier(0);
            u32x4 xr[2][2];
#pragma unroll
            for (int m2 = 0; m2 < 2; ++m2)
#pragma unroll
                for (int bj = 0; bj < 2; ++bj) xr[m2][bj] = *(const u32x4*)(XB + (size_t)(u.pm * 256 + ai * 128 + wr * 64 + (2 * mh + m2) * 16 + fr) * 1024 + u.pn * 256 + bj * 128 + wc * 32 + 8 * fq);
#pragma unroll
            for (int m2 = 0; m2 < 2; ++m2) {
                const int m = 2 * mh + m2; const int row = u.pm * 256 + ai * 128 + wr * 64 + m * 16 + fr; float ss = 0.f;
#pragma unroll
                for (int bj = 0; bj < 2; ++bj) {
                    const u32x4 x = xr[m2][bj]; u32x4 o;
                    o.x = pk_bf16(bf_lo(x.x) + acc[ai][bj][m][0][0], bf_hi(x.x) + acc[ai][bj][m][0][1]); o.y = pk_bf16(bf_lo(x.y) + acc[ai][bj][m][0][2], bf_hi(x.y) + acc[ai][bj][m][0][3]);
                    o.z = pk_bf16(bf_lo(x.z) + acc[ai][bj][m][1][0], bf_hi(x.z) + acc[ai][bj][m][1][1]); o.w = pk_bf16(bf_lo(x.w) + acc[ai][bj][m][1][2], bf_hi(x.w) + acc[ai][bj][m][1][3]);
                    *(u32x4*)(XB + (size_t)row * 1024 + u.pn * 256 + bj * 128 + wc * 32 + 8 * fq) = o;
                    ss += (bf_lo(o.x) * bf_lo(o.x) + bf_hi(o.x) * bf_hi(o.x)) + (bf_lo(o.y) * bf_lo(o.y) + bf_hi(o.y) * bf_hi(o.y)) + (bf_lo(o.z) * bf_lo(o.z) + bf_hi(o.z) * bf_hi(o.z)) + (bf_lo(o.w) * bf_lo(o.w) + bf_hi(o.w) * bf_hi(o.w));
                }
                ss = quad_sum(ss); if (fq == 0) ssq[(size_t)row * 16 + u.pn * 4 + wc] = ss;
            }
          }
    }
};

__device__ __forceinline__ float sum16(const float* p) { const f32x4 a = *(const f32x4*)p, b = *(const f32x4*)(p + 4), c = *(const f32x4*)(p + 8), d = *(const f32x4*)(p + 12);
    return (((a.x + a.y) + (a.z + a.w)) + ((b.x + b.y) + (b.z + b.w))) + (((c.x + c.y) + (c.z + c.w)) + ((d.x + d.y) + (d.z + d.w))); }
__device__ __forceinline__ void phase_route(int l, InPtr in, unsigned char* ws, LAS unsigned char* lds, int bid, int nb, int g_wv) {
    int tid_ = TIDX; asm volatile("" : "+v"(tid_)); const int w = tid_ >> 6, lane = tid_ & 63, r = lane & 15, q = lane >> 4;
    const bf16_t* XB = (const bf16_t*)(ws + WS_XB); const bf16_t* WR = (const bf16_t*)(ws + WS_WR) + (size_t)l * 64 * 1024;
    const float* ssq = (const float*)(ws + WS_SSQ + PT_X1) + (size_t)l * 16384 * 16; const float* bg = in->p[24] + l * 4; const float* be = in->p[26] + l * 32;
    unsigned* cnt = (unsigned*)(ws + WS_CTL) + CW_CNT + 2048 * l; unsigned* mtok = (unsigned*)(ws + WS_META); float* mw = (float*)(ws + WS_META + META_W);
    LAS float* lg = (LAS float*)(lds + w * 4096);
    LAS unsigned* lcnt = (LAS unsigned*)(lds + 32768); LAS unsigned* lbase = lcnt + 32;
    for (int g0 = bid * 8; g0 < NTOK / 16; g0 += nb * 8) {
        if (tid_ < 32) lcnt[tid_] = 0u;
        __syncthreads();
        const int tok0 = (g0 + w) * 16; f32x4 acc[3];
#pragma unroll
        for (int n = 0; n < 3; ++n) acc[n] = (f32x4){0.f, 0.f, 0.f, 0.f};
        const bf16_t* ap = XB + (size_t)(tok0 + r) * 1024 + 8 * q; const bf16_t* bp = WR + (size_t)r * 1024 + 8 * q;
#pragma unroll 8
        for (int ks = 0; ks < 32; ++ks) { const bf16x8 a = *(const bf16x8*)(ap + 32 * ks);
#pragma unroll
            for (int n = 0; n < 3; ++n) { const bf16x8 bb = *(const bf16x8*)(bp + (size_t)n * 16 * 1024 + 32 * ks); acc[n] = MFMA16(a, bb, acc[n]); } }
#pragma unroll
        for (int n = 0; n < 3; ++n)
#pragma unroll
            for (int j = 0; j < 4; ++j) lg[(4 * q + j) * 48 + 16 * n + r] = acc[n][j];
        LDS_FENCE();
        int E0 = 0, E1 = 0; unsigned r0 = 0, r1 = 0; float wt0 = 0.f, wt1 = 0.f; const int tok = tok0 + (lane & 15);
        if (lane < 16) {
            const float rs = rsqrtf(sum16(ssq + (size_t)tok * 16) * (1.f / 1024.f) + 1e-6f); ((float*)(ws + WS_RS2))[tok] = rs; const LAS float* L = lg + lane * 48;
            float gl[4]; int gi = 0;
#pragma unroll
            for (int j = 0; j < 4; ++j) gl[j] = L[j] * rs + bg[j];
            float gm = gl[0];
#pragma unroll
            for (int j = 1; j < 4; ++j) if (gl[j] > gm) { gm = gl[j]; gi = j; }
            float gsum = 0.f;
#pragma unroll
            for (int j = 0; j < 4; ++j) gsum += __expf(gl[j] - gm);
            const float gtop = 1.f / gsum;
            float el[8];
#pragma unroll
            for (int j = 0; j < 8; ++j) el[j] = L[4 + gi * 8 + j] * rs + be[gi * 8 + j];
            int e0 = 0; float v0 = el[0];
#pragma unroll
            for (int j = 1; j < 8; ++j) if (el[j] > v0) { v0 = el[j]; e0 = j; }
            int e1 = -1; float v1 = -3.0e38f;
#pragma unroll
            for (int j = 0; j < 8; ++j) if (j != e0 && el[j] > v1) { v1 = el[j]; e1 = j; }
            const float w0 = 1.f / (1.f + __expf(v1 - v0)); E0 = gi * 8 + e0; E1 = gi * 8 + e1; wt0 = w0 * gtop; wt1 = (1.f - w0) * gtop;
            r0 = __hip_atomic_fetch_add(lcnt + E0, 1u, __ATOMIC_RELAXED, __HIP_MEMORY_SCOPE_WORKGROUP); r1 = __hip_atomic_fetch_add(lcnt + E1, 1u, __ATOMIC_RELAXED, __HIP_MEMORY_SCOPE_WORKGROUP);
        }
        __syncthreads();
        if (tid_ < 32) { const unsigned c = lcnt[tid_]; lbase[tid_] = c ? atomicAdd(cnt + tid_ * 64, c) : 0u; }
        __syncthreads();
        if (lane < 16) {
            const unsigned p0 = lbase[E0] + r0, p1 = lbase[E1] + r1;
            mtok[(size_t)E0 * 16384 + p0] = (unsigned)tok; mw[(size_t)E0 * 16384 + p0] = wt0;
            mtok[(size_t)E1 * 16384 + p1] = (unsigned)tok | 0x80000000u; mw[(size_t)E1 * 16384 + p1] = wt1;
        }
        __syncthreads();
    }
}

constexpr int LDS_TB = 131072 + 2048;
__device__ __forceinline__ void moe_tables(int l, unsigned char* ws, LAS unsigned char* lds, int g_wv) {
    int tix = TIDX; asm volatile("" : "+v"(tix));
    LAS int* tb = (LAS int*)(lds + LDS_TB);
    if (tix < 32) { const unsigned* cnt = (const unsigned*)(ws + WS_CTL) + CW_CNT + 2048 * l; tb[160 + tix] = (int)__hip_atomic_load(cnt + tix * 64, __ATOMIC_RELAXED, __HIP_MEMORY_SCOPE_AGENT); }
    __syncthreads();
    if (tix == 0) { int a = 0, f = 0, p = 0; for (int e = 0; e < 32; ++e) { const int c = tb[160 + e]; tb[e] = a; tb[48 + e] = f; tb[96 + e] = p; a += (c + 255) >> 8; f += c >> 8; p += (c & 255) ? 1 : 0; } tb[32] = a; tb[80] = f; tb[128] = p; }
    __syncthreads();
}
template <int NPN, bool GATHER_>
struct MoeSched {
    static constexpr bool GATHER = GATHER_, PARTIAL = false;
    const char* A; const char* Bt; const unsigned* cnt; const unsigned* mtok; const LAS int* tb; int G, c; size_t bstride_e  , bstride_pn;
    __device__ __forceinline__ bool next(int i, GUnit& u) const {
        const int L = i * G + c; const int ntile = tb[32]; if (L >= ntile * NPN) return false;
        const int tile = L / NPN, pn = L % NPN;
        int e = 0;
        for (int k = 1; k < 32; ++k) e = (tb[k] <= tile) ? k : e;
        e = __builtin_amdgcn_readfirstlane(e);
        u.e = e; u.pm = tile; u.pn = pn; u.rows = tb[160 + e] - 256 * (tile - tb[e]);
        u.a = GATHER ? A : A + (size_t)tile * 256 * 256 * 2;
        u.b = Bt + (size_t)e * bstride_e + (size_t)pn * bstride_pn; return true;
    }
    __device__ __forceinline__ void aoff(const GUnit& u, unsigned (&v)[2][2], const int (&R)[2], const int (&C)[2]) const {
#pragma unroll
        for (int h = 0; h < 2; ++h)
#pragma unroll
            for (int i = 0; i < 2; ++i) {
                if (GATHER) { const int lr = h * 128 + R[i]; const int rr = 256 * (u.pm - tb[u.e]) + (lr < u.rows ? lr : 0); const unsigned tok = mtok[(size_t)u.e * 16384 + rr] & 0x7fffffffu; v[h][i] = (tok * 1024u + (unsigned)C[i]) * 2u; }
                else v[h][i] = (unsigned)((h * 128 + R[i]) * 256 + C[i]) * 2u;
            }
    }
};
struct EpiMoeUp {
    static constexpr bool KHOOK = false;
    const unsigned* mtok; const float* ssq; const LAS int* tb; bf16_t* HB;
    __device__ __forceinline__ void operator()(const f32x4 (&acc)[2][2][4][2], const GUnit& u, int wr, int wc, int fr, int fq) const {
        const int r0 = 256 * (u.pm - tb[u.e]);
        float rs8[8];
        { unsigned tk[8];
#pragma unroll
          for (int k = 0; k < 8; ++k) { const int lr = (k >> 2) * 128 + wr * 64 + (k & 3) * 16 + fr; tk[k] = mtok[(size_t)u.e * 16384 + r0 + (lr < u.rows ? lr : 0)] & 0x7fffffffu; }
#pragma unroll
          for (int k = 0; k < 8; ++k) rs8[k] = ssq[tk[k]]; }
#pragma unroll
        for (int ai = 0; ai < 2; ++ai)
#pragma unroll
            for (int m = 0; m < 4; ++m) {
                __builtin_amdgcn_sched_barrier(0);
                const int lr = ai * 128 + wr * 64 + m * 16 + fr;
                if (lr < u.rows) {
                    const float rs = rs8[ai * 4 + m];
                    float hv[8];
#pragma unroll
                    for (int n = 0; n < 2; ++n)
#pragma unroll
                        for (int j = 0; j < 4; ++j) { const float gv = acc[ai][0][m][n][j] * rs, uv = acc[ai][1][m][n][j] * rs; hv[4 * n + j] = siluf(gv) * uv; }
                    st_bf16x8(HB + ((size_t)u.pm * 256 + lr) * 256 + u.pn * 128 + wc * 32 + 8 * fq, hv);
                }
            }
    }
};
struct EpiMoeDown {
    static constexpr bool KHOOK = false;
    const unsigned* mtok; const float* mw; const LAS int* tb; bf16_t* YB;
    __device__ __forceinline__ void operator()(const f32x4 (&acc)[2][2][4][2], const GUnit& u, int wr, int wc, int fr, int fq) const {
        const int r0 = 256 * (u.pm - tb[u.e]);
        unsigned mt8[8]; float wt8[8];
#pragma unroll
        for (int k = 0; k < 8; ++k) { const int lr = (k >> 2) * 128 + wr * 64 + (k & 3) * 16 + fr; const size_t ix = (size_t)u.e * 16384 + r0 + (lr < u.rows ? lr : 0); mt8[k] = mtok[ix]; wt8[k] = mw[ix]; }
#pragma unroll
        for (int ai = 0; ai < 2; ++ai)
#pragma unroll
            for (int m = 0; m < 4; ++m) {
                __builtin_amdgcn_sched_barrier(0);
                const int lr = ai * 128 + wr * 64 + m * 16 + fr;
                if (lr < u.rows) {
                    const unsigned mt = mt8[ai * 4 + m]; const float wt = wt8[ai * 4 + m];
                    bf16_t* dst = YB + ((size_t)(mt >> 31) * 16384 + (mt & 0x7fffffffu)) * 1024 + u.pn * 256 + wc * 32 + 8 * fq;
#pragma unroll
                    for (int bj = 0; bj < 2; ++bj) { float v[8];
#pragma unroll
                        for (int n = 0; n < 2; ++n)
#pragma unroll
                            for (int j = 0; j < 4; ++j) v[4 * n + j] = acc[ai][bj][m][n][j] * wt;
                        st_bf16x8(dst + bj * 128, v); }
                }
            }
    }
};
__device__ __forceinline__ void phase_combine(int l, unsigned char* ws, float* out, int bid, int nb, int g_wv) {
    int tid_ = TIDX; asm volatile("" : "+v"(tid_)); const int w = tid_ >> 6, lane = tid_ & 63;
    bf16_t* XB = (bf16_t*)(ws + WS_XB); const bf16_t* Y0 = (const bf16_t*)(ws + WS_YBUF); const bf16_t* Y1 = Y0 + (size_t)16384 * 1024; float* ssqx = (float*)(ws + WS_SSQX) + 16384;
    for (int row = bid * 8 + w; row < NTOK; row += nb * 8) {
        float ss = 0.f;
#pragma unroll
        for (int k = 0; k < 2; ++k) {
            const size_t o = (size_t)row * 1024 + (lane + 64 * k) * 8;
            const u32x4 x = *(const u32x4*)(XB + o), a = *(const u32x4*)(Y0 + o), c = *(const u32x4*)(Y1 + o);
            float v[8] = { bf_lo(x.x) + bf_lo(a.x) + bf_lo(c.x), bf_hi(x.x) + bf_hi(a.x) + bf_hi(c.x), bf_lo(x.y) + bf_lo(a.y) + bf_lo(c.y), bf_hi(x.y) + bf_hi(a.y) + bf_hi(c.y),
                           bf_lo(x.z) + bf_lo(a.z) + bf_lo(c.z), bf_hi(x.z) + bf_hi(a.z) + bf_hi(c.z), bf_lo(x.w) + bf_lo(a.w) + bf_lo(c.w), bf_hi(x.w) + bf_hi(a.w) + bf_hi(c.w) };
            if (l == L_ - 1 && out) { *(f32x4*)(out + o) = (f32x4){v[0], v[1], v[2], v[3]}; *(f32x4*)(out + o + 4) = (f32x4){v[4], v[5], v[6], v[7]}; }
            else { u32x4 p; p.x = pk_bf16(v[0], v[1]); p.y = pk_bf16(v[2], v[3]); p.z = pk_bf16(v[4], v[5]); p.w = pk_bf16(v[6], v[7]); *(u32x4*)(XB + o) = p;
#pragma unroll
                   for (int j = 0; j < 4; ++j) { const unsigned q = j == 0 ? p.x : (j == 1 ? p.y : (j == 2 ? p.z : p.w)); ss += bf_lo(q) * bf_lo(q) + bf_hi(q) * bf_hi(q); } }
        }
        if (l < L_ - 1) { ss = wave_sum(ss); if (lane == 0) ssqx[row] = ss; }
    }
}
constexpr int MOE_CVT_SPLIT = 4608;
constexpr int NPH = 9;
enum { PH_INPROJ = 0, PH_PREP, PH_MIX, PH_YNORM, PH_OUTPROJ, PH_ROUTE, PH_MOEUP, PH_MOEDOWN, PH_COMBINE };
struct Args { Inputs in; float* out; unsigned char* ws; int ph_lo, ph_hi; };

__global__ void __launch_bounds__(512, 2) mk(Args args) {
    extern __shared__ __attribute__((aligned(16))) unsigned char lds_raw[];
    LAS unsigned char* lds = (LAS unsigned char*)lds_raw;
    const int g_wv = __builtin_amdgcn_readfirstlane((int)threadIdx.x >> 6);
    const int bid0 = blockIdx.x, nb = gridDim.x;
#define BID() ({ int b_ = bid0; asm volatile("" : "+s"(b_)); b_; })
    unsigned char* ws = args.ws; unsigned* ctl = (unsigned*)(ws + WS_CTL);
    const int lo = args.ph_lo, hi = args.ph_hi;
    if (TIDX < 4) ((LAS unsigned*)(lds + LDS_MISC))[TIDX] = 0u;
    __syncthreads();
    XcdBarrier bar; bar.g_wv = g_wv; bar.bar = ctl + CW_BAR; bar.x = 0; bar.st = nullptr;
    if (hi - lo > 1) bar = xcd_barrier_post(ctl + CW_BAR, (volatile LAS unsigned*)(lds + LDS_MISC), g_wv);
#define IN(k) (lo <= (k) && (k) < hi)
#ifndef REPEAT_PH
#define REPEAT_PH -1
#endif
#define NREP(k) ((REPEAT_PH == (k)) ? 2 : 1)
#ifndef NBAR
#define NBAR 1
#endif
#ifndef TIME_PH
#define TIME_PH -1
#endif
#define STAMP(i) do { if (TIME_PH != -1 && blockIdx.x == 0 && TIDX == 0) ((unsigned long long*)(ctl + CW_TS))[i] = __builtin_amdgcn_s_memrealtime(); } while (0)
#define SEAM(k) do { if (IN(k) && IN((k) + 1)) for (int nb_ = 0; nb_ < NBAR; ++nb_) xcd_barrier(bar); STAMP((k) + 1); } while (0)
    STAMP(0);
#ifndef NO_PRO
    if (IN(0)) for (int rep = 0; rep < NREP(100); ++rep) { prologue(in_tab(), launder(ws), lds, BID(), nb, g_wv); if (rep + 1 < NREP(100)) xcd_barrier(bar); }
#endif
    SEAM(0);
    for (int l = 0; l < L_; ++l) {
        const int pb = 1 + l * NPH;
        if (IN(pb + PH_INPROJ)) for (int rep = 0; rep < NREP(PH_INPROJ); ++rep) {
            if (rep) xcd_barrier(bar);
            InPtr in = in_tab(); unsigned char* ws = launder(args.ws);
            g8::DenseSched S{(const char*)(ws + WS_XB), (const char*)(ws + WS_WIN) + (size_t)l * 2560 * 1024 * 2, 1024, 1024, 64, 10, nb, BID()};
            EpiInProj E{(const float*)(ws + WS_SSQX) + l * 16384, (float*)(ws + WS_SSQ + PT_DQ) + (size_t)l * 16384 * 4, (float*)(ws + WS_SSQ + PT_DKV) + (size_t)l * 16384 * 2,
                        in->p[8] + l * 64, in->p[9] + l * 64, in->p[19] + l * 192 + 96 + 64, (const float*)(ws + WS_ROPE), ws + WS_PRJ};
#ifndef NO_INPROJ
            g8::gemm_run(lds, 1024, 1024, S, E, g_wv);
#endif
        }
        SEAM(pb + PH_INPROJ);
        if (IN(pb + PH_PREP)) for (int rep = 0; rep < NREP(PH_PREP); ++rep) { if (rep) xcd_barrier(bar); phase_prep(l, in_tab(), launder(ws), lds, BID(), nb, g_wv, (unsigned*)launder(ws) + CW_Q + 64 * (4 + l + 2 * rep)); }
        SEAM(pb + PH_PREP);
        if (IN(pb + PH_MIX)) for (int rep = 0; rep < NREP(PH_MIX); ++rep) { if (rep) xcd_barrier(bar); phase_mix(l, in_tab(), launder(ws), lds, (unsigned*)launder(ws) + CW_Q + 64 * (l + 2 * rep), g_wv); }
        SEAM(pb + PH_MIX);
        const bool fold_norm = (nb == 256);
        if (IN(pb + PH_YNORM) && !fold_norm) phase_ynorm(l, launder(ws), BID(), nb, g_wv);
        if (!fold_norm) SEAM(pb + PH_YNORM);
        if (IN(pb + PH_OUTPROJ)) {
            unsigned char* ws = launder(args.ws);
            g8::DenseSched S{(const char*)(ws + WS_Y), (const char*)(ws + WS_WOUT) + (size_t)l * 1024 * 1024 * 2, 1024, 1024, 64, 4, nb, BID()};
            EpiOut E{(bf16_t*)(ws + WS_XB), (float*)(ws + WS_SSQ + PT_X1) + (size_t)l * 16384 * 16, (const LAS float*)(lds + LDS_FAC), fold_norm};
            if (fold_norm) { g8::GUnit u0; if (S.next(0, u0)) outproj_factors(l, ws, lds, u0.pm, TIDX); else __syncthreads(); }
#ifndef NO_OUTPROJ
            g8::gemm_run(lds, 1024, 1024, S, E, g_wv);
#endif
        }
        SEAM(pb + PH_OUTPROJ);
#ifndef NO_ROUTE
        if (IN(pb + PH_ROUTE)) {
            const int b_ = BID();
            if (nb >= 256 && b_ >= 128) cvt_moe_layer(in_tab(), launder(ws), l, (LAS float*)lds, b_ - 128, nb - 128, TIDX);
            else { phase_route(l, in_tab(), launder(ws), lds, b_, nb >= 256 ? 128 : nb, g_wv); if (nb < 256) cvt_moe_layer(in_tab(), launder(ws), l, (LAS float*)lds, b_, nb, TIDX); }
            if (l + 1 < L_) { __syncthreads(); cvt_small_weights(in_tab(), launder(ws), l + 1, (LAS float*)lds, b_, nb, TIDX); }
        }
#endif
        SEAM(pb + PH_ROUTE);
        if (IN(pb + PH_MOEUP)) for (int rep = 0; rep < NREP(PH_MOEUP); ++rep) {
            if (rep) xcd_barrier(bar);
            unsigned char* ws = launder(args.ws); moe_tables(l, ws, lds, g_wv);
            const unsigned* cnt = (const unsigned*)(ws + WS_CTL) + CW_CNT + 2048 * l; const unsigned* mtok = (const unsigned*)(ws + WS_META); const LAS int* tb = (const LAS int*)(lds + LDS_TB);
            MoeSched<2, true> S{(const char*)(ws + WS_XB), (const char*)(ws + WS_WMOE), cnt, mtok, tb, nb, BID(), (size_t)512 * 1024 * 2, (size_t)256 * 1024 * 2};
            EpiMoeUp E{mtok, (const float*)(ws + WS_RS2), tb, (bf16_t*)(ws + WS_HBUF)};
#ifndef NO_MOEUP
            g8::gemm_run(lds, 1024, 1024, S, E, g_wv);
#endif
        }
        SEAM(pb + PH_MOEUP);
        if (IN(pb + PH_MOEDOWN)) for (int rep = 0; rep < NREP(PH_MOEDOWN); ++rep) {
            if (rep) xcd_barrier(bar);
            unsigned char* ws = launder(args.ws); moe_tables(l, ws, lds, g_wv);
            const unsigned* cnt = (const unsigned*)(ws + WS_CTL) + CW_CNT + 2048 * l; const unsigned* mtok = (const unsigned*)(ws + WS_META); const LAS int* tb = (const LAS int*)(lds + LDS_TB);
            MoeSched<4, false> S{(const char*)(ws + WS_HBUF), (const char*)(ws + WS_WMOE + WMOE_WD), cnt, mtok, tb, nb, BID(), (size_t)1024 * 256 * 2, (size_t)256 * 256 * 2};
            EpiMoeDown E{mtok, (const float*)(ws + WS_META + META_W), tb, (bf16_t*)(ws + WS_YBUF)};
#ifndef NO_MOEDOWN
            g8::gemm_run(lds, 256, 256, S, E, g_wv);
#endif
        }
        SEAM(pb + PH_MOEDOWN);
#ifndef NO_COMBINE
        if (IN(pb + PH_COMBINE)) { unsigned char* ws = launder(args.ws); phase_combine(l, ws, args.out, BID(), nb, g_wv); }
#endif
        SEAM(pb + PH_COMBINE);
    }
#undef IN
#undef SEAM
}
#if CHECK
struct NvScratch { float *proj, *h1, *qk, *hraw, *kn, *kcmp, *vcmp, *dqn, *q, *dkvn, *kv, *krope, *y, *x1, *xl; int* rt_e; float* rt_w; };
constexpr int CB = 5;
enum { NS_INPROJ = 0, NS_NSAPREP, NS_MLAPREP, NS_NSA, NS_ML, NS_MLA, NS_OUT, NS_ROUTE, NS_MOE };
static void naive_step(void* const* d_in, int l, int step, const float* xin, float* xout, const NvScratch& S, hipStream_t st) {
    const int b = CB;
    const float* rel_bias = (const float*)d_in[2];
    const float* norm1_g = (const float*)d_in[3] + (long)l * 1024;
    const float* w_in = (const float*)d_in[4] + (long)l * 1024 * DIN;
    const float* cmp_pe = (const float*)d_in[5] + (long)l * 2 * 32 * 64;
    const float* cmp_w1 = (const float*)d_in[6] + (long)l * 2 * 32 * 64 * 64;
    const float* cmp_w2 = (const float*)d_in[7] + (long)l * 2 * 64 * 64;
    const float* q_norm = (const float*)d_in[8] + l * 64;
    const float* k_norm = (const float*)d_in[9] + l * 64;
    const float* nsa_on = (const float*)d_in[10] + l * 384;
    const float* conv = (const float*)d_in[11] + l * 4 * 512;
    const float* ibias = (const float*)d_in[12] + l * 4;
    const float* fbias = (const float*)d_in[13] + l * 4;
    const float* ml_on = (const float*)d_in[14] + l * 256;
    const float* qan = (const float*)d_in[15] + l * 192;
    const float* w_uq = (const float*)d_in[16] + (long)l * 192 * 576;
    const float* kvan = (const float*)d_in[17] + l * 128;
    const float* w_ukv = (const float*)d_in[18] + (long)l * 128 * 768;
    const float* qkn = (const float*)d_in[19] + l * 192;
    const float* mla_on = (const float*)d_in[20] + l * 384;
    const float* w_out = (const float*)d_in[21] + (long)l * 1024 * 1024;
    const float* norm2_g = (const float*)d_in[22] + l * 1024;
    const float* wgrp = (const float*)d_in[23] + (long)l * 1024 * 4;
    const float* bgrp = (const float*)d_in[24] + l * 4;
    const float* wexp = (const float*)d_in[25] + (long)l * 1024 * 32;
    const float* bexp = (const float*)d_in[26] + l * 32;
    const float* Wg = (const float*)d_in[27] + (long)l * 32 * 1024 * 256;
    const float* Wu = (const float*)d_in[28] + (long)l * 32 * 1024 * 256;
    const float* Wd = (const float*)d_in[29] + (long)l * 32 * 256 * 1024;
    const int* pos = (const int*)d_in[1] + b * 2048;
    switch (step) {
    case NS_INPROJ:
        nv_rmsnorm<<<dim3(2048, 1), 64, 0, st>>>(xin, 1024, 0, S.h1, 1024, 0, norm1_g, 0, 1024);
        nv_gemm<<<dim3((DIN + 63) / 64, 2048 / 64), 256, 0, st>>>(S.h1, 1024, w_in, DIN, S.proj, DIN, nullptr, 0, 2048, DIN, 1024);
        break;
    case NS_NSAPREP:
        nv_nsa_cmp<<<dim3(127, 2, 2), 64, 0, st>>>(S.proj, cmp_pe, cmp_w1, cmp_w2, k_norm, S.kcmp, S.vcmp);
        nv_nsa_knorm<<<dim3(2048, 4), 64, 0, st>>>(S.proj, k_norm, S.kn);
        break;
    case NS_MLAPREP:
        nv_rmsnorm<<<dim3(2048, 1), 64, 0, st>>>(S.proj + O_CDQ, DIN, 0, S.dqn, 192, 0, qan, 0, 192);
        nv_gemm<<<dim3(576 / 64, 2048 / 64), 256, 0, st>>>(S.dqn, 192, w_uq, 576, S.q, 576, nullptr, 0, 2048, 576, 192);
        nv_rmsnorm<<<dim3(2048, 1), 64, 0, st>>>(S.proj + O_CDKV, DIN, 0, S.dkvn, 128, 0, kvan, 0, 128);
        nv_gemm<<<dim3(768 / 64, 2048 / 64), 256, 0, st>>>(S.dkvn, 128, w_ukv, 768, S.kv, 768, nullptr, 0, 2048, 768, 128);
        nv_mla_prep<<<dim3(2048, 7), 64, 0, st>>>(S.q, S.kv, S.proj, S.krope, qkn, pos);
        break;
    case NS_NSA:
        nv_nsa_attn<<<dim3(2048, 2), 192, 0, st>>>(S.proj, S.kn, S.kcmp, S.vcmp, rel_bias, q_norm, S.y);
        break;
    case NS_ML:
        nv_ml_conv<<<2048, 512, 0, st>>>(S.proj, conv, S.qk);
        nv_ml_rec<<<4, 256, 0, st>>>(S.proj, S.qk, ibias, fbias, S.hraw);
        nv_ml_fin<<<dim3(2048, 4), 64, 0, st>>>(S.proj, S.hraw, ml_on, S.y);
        break;
    case NS_MLA:
        nv_mla_attn<<<dim3(2048, 6), 64, 0, st>>>(S.q, S.kv, S.krope, S.y);
        break;
    case NS_OUT:
        nv_rmsnorm<<<dim3(2048, 1), 64, 0, st>>>(S.y, 1024, 0, S.y, 1024, 0, nsa_on, 0, 384);
        nv_rmsnorm<<<dim3(2048, 1), 64, 0, st>>>(S.y + 640, 1024, 0, S.y + 640, 1024, 0, mla_on, 0, 384);
        nv_gemm<<<dim3(1024 / 64, 2048 / 64), 256, 0, st>>>(S.y, 1024, w_out, 1024, S.x1, 1024, xin, 1024, 2048, 1024, 1024);
        break;
    case NS_ROUTE:
        nv_moe_route<<<2048, 64, 0, st>>>(S.x1, norm2_g, wgrp, bgrp, wexp, bexp, S.h1, S.rt_e, S.rt_w);
        break;
    case NS_MOE:
        nv_moe_exp<<<2048, 256, 0, st>>>(S.x1, S.h1, S.rt_e, S.rt_w, Wg, Wu, Wd, xout);
        break;
    }
}

__device__ __forceinline__ void chk_commit(float d2, float r2, float* acc) { d2 = wave_sum(d2); r2 = wave_sum(r2); if ((threadIdx.x & 63) == 0) { atomicAdd(acc, d2); atomicAdd(acc + 1, r2); } }
__device__ __forceinline__ void chk_add(float f, float r, float& d2, float& r2) { const float d = f - r; d2 += (d == d) ? d * d : 1e30f; r2 += r * r; }

__global__ void __launch_bounds__(64) chk_proj(const float* nproj, const unsigned char* prj, const float* ssq_dq, const float* ssq_dkv, const float* qg, const float* kg, const float* krg, const int* pos, float* acc) {
    const int t = blockIdx.x, e = threadIdx.x; const size_t row = (size_t)CB * 2048 + t; float d2 = 0.f, r2 = 0.f;
    for (int G = 0; G < 40; ++G) {
        const int c = inproj_refcol(G, e); float r = c < 0 ? 0.f : nproj[(size_t)t * DIN + c]; float f = 0.f;
        const float rr = (G == 37 && e >= 32) ? 0.f : r; const float ss = wave_sum(rr * rr);
        if (G < 6) { r = r * rsqrtf(ss / 64.f + 1e-6f) * qg[e] * 0.18033688f; f = bf2f(((const bf16_t*)(prj + PRJ_QN))[((size_t)(CB * 6 + G) * 2048 + t) * 64 + e]); }
        else if (G < 18) { const int a = G - 6, br = a >> 2, s = (a >> 1) & 1, hk = a & 1;
            if (br > 0 && s == 0) r = r * rsqrtf(ss / 64.f + 1e-6f) * kg[e];
            const size_t base = br == 0 ? (s ? PRJ_C0V : PRJ_C0K) : (br == 1 ? (s ? PRJ_VN1 : PRJ_KN1) : (s ? PRJ_VN2 : PRJ_KN2));
            f = bf2f(((const bf16_t*)(prj + base))[((size_t)(CB * 2 + hk) * 2048 + t) * 64 + e]); }
        else if (G < 26) f = bf2f(((const bf16_t*)(prj + PRJ_RAWQK))[row * 512 + (G - 18) * 64 + e]);
        else if (G < 30) f = bf2f(((const bf16_t*)(prj + PRJ_VML))[((size_t)(CB * 4 + (G - 26)) * 2048 + t) * 64 + e]);
        else if (G < 34) f = bf2f(((const bf16_t*)(prj + PRJ_OG))[row * 256 + (G - 30) * 64 + e]);
        else if (G < 37) f = bf2f(((const bf16_t*)(prj + PRJ_DQKV))[row * 384 + (G - 34) * 64 + e]);
        else if (G == 37) {
            const float val = e < 32 ? rr * rsqrtf(ss / 32.f + 1e-6f) * krg[e & 31] : 0.f; const float oth = __shfl_xor(val, 16);
            if (e < 32) { const int i = e & 15; const double ang = (double)pos[row] * pow(10000.0, -(double)i / 16.0); const float cs = (float)cos(ang), sn = (float)sin(ang);
                r = e < 16 ? val * cs - oth * sn : val * cs + oth * sn; f = bf2f(((const bf16_t*)(prj + PRJ_KR))[row * 32 + e]); }
            else if (e < 58) f = ((const float*)(prj + PRJ_GATES))[row * 32 + (e - 32)];
            else { f = 0.f; r = 0.f; }
        }
        else f = bf2f(((const bf16_t*)(prj + PRJ_DQKV))[row * 384 + 256 + (G - 38) * 64 + e]);
        chk_add(f, r, d2, r2);
    }
    float d2s = 0.f, r2s = 0.f;
    { float s1 = 0.f, s2 = 0.f; for (int c = e; c < 192; c += 64) { float v = nproj[(size_t)t * DIN + O_CDQ + c]; s1 += v * v; } for (int c = e; c < 128; c += 64) { float v = nproj[(size_t)t * DIN + O_CDKV + c]; s2 += v * v; }
      s1 = wave_sum(s1); s2 = wave_sum(s2); if (e == 0) { chk_add((ssq_dq[row * 4] + ssq_dq[row * 4 + 1]) + ssq_dq[row * 4 + 2], s1, d2s, r2s); chk_add(ssq_dkv[row * 2] + ssq_dkv[row * 2 + 1], s2, d2s, r2s); } }
    chk_commit(d2, r2, acc); chk_commit(d2s, r2s, acc + 2);
}

__global__ void __launch_bounds__(64) chk_prep(const float* nq, const float* nkv, const float* nkr, const float* nkc, const float* nvc, const unsigned char* ws, float* acc) {
    const int t = blockIdx.x, e = threadIdx.x; float d2 = 0.f, r2 = 0.f, d2c = 0.f, r2c = 0.f; const float scale = 0.14724444f;
    const bf16_t* QM = (const bf16_t*)(ws + WS_MLA); const bf16_t* KM = (const bf16_t*)(ws + WS_MLA + MLA_KM); const bf16_t* VM = (const bf16_t*)(ws + WS_MLA + MLA_VM);
    for (int h = 0; h < 6; ++h) {
        const size_t rq = ((size_t)(CB * 6 + h) * 2048 + t);
        chk_add(bf2f(QM[rq * 96 + e]), nq[(size_t)t * 576 + h * 96 + e] * scale, d2, r2);
        chk_add(bf2f(KM[rq * 96 + e]), nkv[(size_t)t * 768 + h * 128 + e], d2, r2);
        chk_add(bf2f(VM[rq * 64 + e]), nkv[(size_t)t * 768 + h * 128 + 64 + e], d2, r2);
        if (e < 32) { chk_add(bf2f(QM[rq * 96 + 64 + e]), nq[(size_t)t * 576 + h * 96 + 64 + e] * scale, d2, r2); chk_add(bf2f(KM[rq * 96 + 64 + e]), nkr[(size_t)t * 32 + e], d2, r2); }
    }
    if (t < 128) for (int hk = 0; hk < 2; ++hk) {
        const bf16_t* KC = (const bf16_t*)(ws + WS_CMP); const bf16_t* VC = (const bf16_t*)(ws + WS_CMP + CMP_V); const size_t rf = ((size_t)(CB * 2 + hk) * 128 + t) * 64 + e;
        chk_add(bf2f(KC[rf]), t < 127 ? nkc[(size_t)(hk * 127 + t) * 64 + e] : 0.f, d2c, r2c); chk_add(bf2f(VC[rf]), t < 127 ? nvc[(size_t)(hk * 127 + t) * 64 + e] : 0.f, d2c, r2c);
    }
    chk_commit(d2, r2, acc); chk_commit(d2c, r2c, acc + 2);
}

__global__ void __launch_bounds__(64) chk_y(const float* ny, const unsigned char* ws, float* acc, int nseg) {
    const int t = blockIdx.x, e = threadIdx.x; const bf16_t* Y = (const bf16_t*)(ws + WS_Y) + ((size_t)CB * 2048 + t) * 1024;
    float d2[3] = {0.f, 0.f, 0.f}, r2[3] = {0.f, 0.f, 0.f};
    for (int c = e; c < 1024; c += 64) { const int seg = c < 384 ? 0 : (c < 640 ? 1 : 2); const int cf = c < 384 ? c : (c < 640 ? 768 + (c - 384) : 384 + (c - 640)); const float f = bf2f(Y[cf]), r = ny[(size_t)t * 1024 + c];
        if (seg == 0) chk_add(f, r, d2[0], r2[0]); else if (seg == 1) chk_add(f, r, d2[1], r2[1]); else chk_add(f, r, d2[2], r2[2]); }
    if (nseg == 3) { chk_commit(d2[0], r2[0], acc); chk_commit(d2[1], r2[1], acc + 2); chk_commit(d2[2], r2[2], acc + 4); }
    else chk_commit(d2[0] + d2[1] + d2[2], r2[0] + r2[1] + r2[2], acc);
}

__global__ void __launch_bounds__(64) chk_x(const float* nx, const unsigned char* ws, float* acc) {
    const int t = blockIdx.x, e = threadIdx.x; const bf16_t* X = (const bf16_t*)(ws + WS_XB) + ((size_t)CB * 2048 + t) * 1024; float d2 = 0.f, r2 = 0.f;
    for (int c = e; c < 1024; c += 64) chk_add(bf2f(X[c]), nx[(size_t)t * 1024 + c], d2, r2);
    chk_commit(d2, r2, acc);
}

__global__ void __launch_bounds__(512) chk_code(float* acc, int nst, const float* nout) {
    __shared__ float sh[512];
    float s = 0.f; for (int i = threadIdx.x; i < 2048 * 1024; i += 512) { float v = nout[i]; s += v * v; }
    sh[threadIdx.x] = s; __syncthreads();
    if (threadIdx.x == 0) { float tot = 0.f; for (int i = 0; i < 512; ++i) tot += sh[i]; float rms = sqrtf(tot / (2048.f * 1024.f)); if (!(rms > 1e-3f && rms < 1e3f)) rms = 1.f;
        int code = 0;
        for (int st = 0; st < nst; ++st) { const float d2 = acc[2 * st], r2 = acc[2 * st + 1]; if (r2 == 0.f && d2 == 0.f) { if ((st & 15) >= 9) continue; code = (st + 1) * 4 + 3; break; } const float err = d2 / fmaxf(r2, 1e-30f);
            const float tol = CHK_TOL(st);
            if (!(err <= tol)) { const int cls = !(err < 1.f) ? 3 : (err >= 0.1f ? 2 : (err >= 0.01f ? 1 : 0)); code = (st + 1) * 4 + cls; break; } }
        acc[2 * 40] = rms * 32.f * exp2f(0.5f * (float)code); }
}
__global__ void __launch_bounds__(512) chk_fill(const float* acc, float* out) {
    const float K = acc[2 * 40];
    for (size_t i = (size_t)blockIdx.x * 512 + threadIdx.x; i < (size_t)NTOK * 1024; i += (size_t)gridDim.x * 512) out[i] = (i & 1) ? -K : K;
}
#endif

#if TIME_PH != -1
#ifndef TIME_Q
#define TIME_Q 6.f
#endif
#ifndef TIME_CAL
#define TIME_CAL 1.0f
#endif
__global__ void tm_acc(const unsigned long long* ts, float* best, int first) {
    int a = TIME_PH, b = TIME_PH + 1;
#ifdef TIME_PH_END
    b = TIME_PH_END;
#endif
    float T = 100.f; if (TIME_PH >= 0) T = (float)(ts[b] - ts[a]) * 0.01f;
    if (first || T < *best) *best = T;
}
__global__ void __launch_bounds__(512) tm_fill(const float* best, float* out) {
    float T = *best;
    T = exp2f(rintf(log2f(fmaxf(T, 1.f)) * TIME_Q) / TIME_Q);
    const float c = sqrtf(T) * TIME_CAL;
    for (size_t i = (size_t)blockIdx.x * 512 + threadIdx.x; i < (size_t)NTOK * 1024; i += (size_t)gridDim.x * 512) out[i] = (i & 1) ? -c : c;
}
#endif
static int g_grid = 0;
static bool setup_once(size_t ws_size) {
    if (g_grid) return g_grid > 0;
    if (ws_size < WS_END) { fprintf(stderr, "kernel_launch: workspace too small: %zu < %zu\n", ws_size, (size_t)WS_END); g_grid = -1; return false; }
    int dev = 0, cus = 0, per_cu = 0;
    if (hipGetDevice(&dev) != hipSuccess || hipDeviceGetAttribute(&cus, hipDeviceAttributeMultiprocessorCount, dev) != hipSuccess) { g_grid = -1; return false; }
    if (hipFuncSetAttribute((const void*)mk, hipFuncAttributeMaxDynamicSharedMemorySize, LDS_BYTES) != hipSuccess) { fprintf(stderr, "kernel_launch: hipFuncSetAttribute failed\n"); g_grid = -1; return false; }
    if (hipOccupancyMaxActiveBlocksPerMultiprocessor(&per_cu, (const void*)mk, 512, LDS_BYTES) != hipSuccess || per_cu < 1) { fprintf(stderr, "kernel_launch: occupancy query says %d\n", per_cu); }
    (void)hipGetLastError();
    g_grid = cus;
    return true;
}
static void launch_mk(const Args& a0, int lo, int hi, hipStream_t stream) { Args a = a0; a.ph_lo = lo; a.ph_hi = hi; hipLaunchKernelGGL(mk, dim3(g_grid), dim3(512), LDS_BYTES, stream, a); }

extern "C" void kernel_launch(void* const* d_in, const int* in_sizes, int n_in, void* d_out, int out_size, void* d_ws, size_t ws_size, hipStream_t stream) {
    if (!setup_once(ws_size)) return;
    unsigned char* ws = (unsigned char*)d_ws;
    (void)hipMemsetAsync(ws + WS_CTL, 0, ZERO_BYTES, stream);
    Args a{}; for (int i = 0; i < 30; ++i) a.in.p[i] = (const float*)d_in[i];
    a.out = (float*)d_out; a.ws = ws; a.ph_lo = 0; a.ph_hi = 0;
#if CHECK
    a.out = nullptr;
#endif
#if CHECK
    float* nb = (float*)d_out; size_t off = 0; NvScratch S;
    auto take = [&](size_t n) { float* p = nb + off; off += (n + 63) & ~(size_t)63; return p; };
    S.proj = take((size_t)2048 * DIN); S.h1 = take(2048 * 1024); S.qk = S.h1; S.hraw = S.qk + 2048 * 512; S.kn = S.hraw + 2048 * 256;
    S.kcmp = take(2 * 127 * 64); S.vcmp = take(2 * 127 * 64); S.dqn = take(2048 * 192); S.q = take(2048 * 576); S.dkvn = take(2048 * 128); S.kv = take(2048 * 768); S.x1 = S.dqn;
    S.krope = take(2048 * 32); S.y = take(2048 * 1024); S.xl = take(2048 * 1024); S.rt_e = (int*)take(2048 * 2); S.rt_w = take(2048 * 2);
    if (off * 4 > (size_t)NTOK * 1024 * 4) { fprintf(stderr, "naive scratch too big\n"); return; }
    float* acc = (float*)(ws + WS_CTL) + CW_CHK;
    launch_mk(a, 0, 1, stream);
    const float* nx_in = (const float*)d_in[0] + (size_t)CB * 2048 * 1024;
    int nst = 0;
    for (int l = 0; l < L_; ++l) {
        const int pb = 1 + l * NPH; const int sb = l * 16;
        launch_mk(a, pb + PH_INPROJ, pb + PH_INPROJ + 1, stream);
        naive_step(d_in, l, NS_INPROJ, nx_in, S.xl, S, stream);
        chk_proj<<<2048, 64, 0, stream>>>(S.proj, ws + WS_PRJ, (const float*)(ws + WS_SSQ + PT_DQ) + (size_t)l * 16384 * 4, (const float*)(ws + WS_SSQ + PT_DKV) + (size_t)l * 16384 * 2,
                                           (const float*)d_in[8] + l * 64, (const float*)d_in[9] + l * 64, (const float*)d_in[19] + l * 192 + 160, (const int*)d_in[1], acc + 2 * (sb + 0));
        nst = sb + 2;
        int ns_done = NS_INPROJ;
#if CHECK_UPTO >= 1
        launch_mk(a, pb + PH_PREP, pb + PH_PREP + 1, stream);
        naive_step(d_in, l, NS_NSAPREP, nx_in, S.xl, S, stream); naive_step(d_in, l, NS_MLAPREP, nx_in, S.xl, S, stream); ns_done = NS_MLAPREP;
        chk_prep<<<2048, 64, 0, stream>>>(S.q, S.kv, S.krope, S.kcmp, S.vcmp, ws, acc + 2 * (sb + 2));
        nst = sb + 4;
#endif
#if CHECK_UPTO >= 2
        launch_mk(a, pb + PH_MIX, pb + PH_MIX + 1, stream);
        naive_step(d_in, l, NS_NSA, nx_in, S.xl, S, stream); naive_step(d_in, l, NS_ML, nx_in, S.xl, S, stream); naive_step(d_in, l, NS_MLA, nx_in, S.xl, S, stream); ns_done = NS_MLA;
        chk_y<<<2048, 64, 0, stream>>>(S.y, ws, acc + 2 * (sb + 4), 3);
        nst = sb + 7;
#endif
#if CHECK_UPTO >= 3
        launch_mk(a, pb + PH_YNORM, pb + PH_YNORM + 1, stream); launch_mk(a, pb + PH_OUTPROJ, pb + PH_OUTPROJ + 1, stream);
        naive_step(d_in, l, NS_OUT, nx_in, S.xl, S, stream); ns_done = NS_OUT;
        chk_x<<<2048, 64, 0, stream>>>(S.x1, ws, acc + 2 * (sb + 7));
        nst = sb + 8;
#endif
#if CHECK_UPTO >= 4
        for (int ph = PH_ROUTE; ph <= PH_COMBINE; ++ph) launch_mk(a, pb + ph, pb + ph + 1, stream);
        naive_step(d_in, l, NS_ROUTE, nx_in, S.xl, S, stream); naive_step(d_in, l, NS_MOE, nx_in, S.xl, S, stream); ns_done = NS_MOE;
        chk_x<<<2048, 64, 0, stream>>>(S.xl, ws, acc + 2 * (sb + 8));
        nst = sb + 9;
#endif
        CHECK_REST
        for (int s = ns_done + 1; s <= NS_MOE; ++s) naive_step(d_in, l, s, nx_in, S.xl, S, stream);
        nx_in = S.xl;
        if (l == CHECK_LAYERS - 1) break;
    }
    chk_code<<<1, 512, 0, stream>>>(acc, nst, S.xl);
    chk_fill<<<1024, 512, 0, stream>>>(acc, (float*)d_out);
#else
#if defined(SPLIT_LAUNCH) && SPLIT_LAUNCH
    for (int ph = 0; ph < 1 + L_ * NPH; ++ph) launch_mk(a, ph, ph + 1, stream);
#else
    launch_mk(a, 0, 1 + L_ * NPH, stream);
#if TIME_PH != -1
    for (int rp = 0; rp < 6; ++rp) {
        (void)hipMemsetAsync(ws + WS_CTL, 0, ZERO_BYTES, stream); launch_mk(a, 0, 1 + L_ * NPH, stream);
        tm_acc<<<1, 1, 0, stream>>>((const unsigned long long*)((unsigned*)(ws + WS_CTL) + CW_TS), (float*)(ws + WS_META + META_RT), rp == 0);
    }
    tm_fill<<<1024, 512, 0, stream>>>((const float*)(ws + WS_META + META_RT), (float*)d_out);
#endif
#endif
#endif
}
```

```cpp
#define CHECK 0
#define CHECK_LAYERS 2
#define CHECK_UPTO 99
#define SPLIT_LAUNCH 0
#define REPEAT_PH -1
#include <hip/hip_runtime.h>
#include <stdint.h>
#include <cstdio>

constexpr int B_ = 8, T_ = 2048, D_ = 1024, L_ = 2, NTOK = B_ * T_;
constexpr int DIN = 2554;
constexpr int O_AQ = 0, O_AKV = 384, O_AG = 1152, O_BQK = 1170, O_BV = 1682, O_BIF = 1938, O_BO = 1946, O_CDQ = 2202, O_CDKV = 2394, O_CKR = 2522;

typedef unsigned short bf16_t;
typedef short bf16x8 __attribute__((ext_vector_type(8)));
typedef short s16x4 __attribute__((ext_vector_type(4)));
typedef float f32x4 __attribute__((ext_vector_type(4)));
typedef float f32x16 __attribute__((ext_vector_type(16)));
typedef unsigned u32x4 __attribute__((ext_vector_type(4)));
typedef unsigned u32x2 __attribute__((ext_vector_type(2)));
typedef float f32x2_t __attribute__((ext_vector_type(2)));
typedef __bf16 bf16x2_t __attribute__((ext_vector_type(2)));
#define LAS __attribute__((address_space(3)))

__device__ __forceinline__ unsigned pk_bf16(float lo, float hi) { f32x2_t v = {lo, hi}; bf16x2_t b = __builtin_convertvector(v, bf16x2_t); return __builtin_bit_cast(unsigned, b); }
__device__ __forceinline__ float bf_lo(unsigned u) { return __builtin_bit_cast(float, u << 16); }
__device__ __forceinline__ float bf_hi(unsigned u) { return __builtin_bit_cast(float, u & 0xffff0000u); }
__device__ __forceinline__ float bf2f(bf16_t h) { return __builtin_bit_cast(float, (unsigned)h << 16); }
__device__ __forceinline__ bf16_t f2bf(float f) { return (bf16_t)(pk_bf16(f, 0.f) & 0xffffu); }
__device__ __forceinline__ float wave_sum(float v) { for (int o = 32; o; o >>= 1) v += __shfl_xor(v, o); return v; }
__device__ __forceinline__ float wave_max(float v) { for (int o = 32; o; o >>= 1) v = fmaxf(v, __shfl_xor(v, o)); return v; }
__device__ __forceinline__ float siluf(float x) { return x / (1.f + __expf(-x)); }
__device__ __forceinline__ float sigmf(float x) { return 1.f / (1.f + __expf(-x)); }
__device__ __forceinline__ int t5b(int dist) {
    int n = dist > 0 ? dist : 0; if (n < 16) return n;
    float v = logf((float)n / 16.f) / logf(8.f) * 16.f; int l = 16 + (int)v; return l < 31 ? l : 31;
}

__device__ __forceinline__ int lane_now() { return (int)__builtin_amdgcn_mbcnt_hi(~0u, __builtin_amdgcn_mbcnt_lo(~0u, 0u)); }
#define TIDX ((g_wv << 6) | lane_now())

constexpr size_t WS_CTL = 0, CTL_BYTES = 65536;
constexpr size_t WS_SSQ = WS_CTL + CTL_BYTES;
constexpr size_t ZERO_BYTES = CTL_BYTES;
constexpr size_t PT_DQ = 0, PT_DKV = PT_DQ + (size_t)2 * 16384 * 4 * 4, PT_A = PT_DKV + (size_t)2 * 16384 * 2 * 4, PT_C = PT_A + (size_t)2 * 16384 * 8 * 4, PT_X1 = PT_C + (size_t)2 * 16384 * 8 * 4, PT_END = PT_X1 + (size_t)2 * 16384 * 16 * 4;
constexpr size_t WS_SSQX = WS_SSQ + PT_END;
constexpr size_t WS_RS2 = WS_SSQX + 2 * 65536;
constexpr size_t WS_WIN = WS_RS2 + 65536;
constexpr size_t WS_WOUT = WS_WIN + (size_t)2 * 2560 * 1024 * 2;
constexpr size_t WS_WUQ = WS_WOUT + (size_t)2 * 1024 * 1024 * 2;
constexpr size_t WS_WUKV = WS_WUQ + (size_t)2 * 768 * 256 * 2;
constexpr size_t WS_WC1 = WS_WUKV + (size_t)2 * 768 * 256 * 2;
constexpr size_t WS_WC2 = WS_WC1 + (size_t)2 * 2 * 64 * 2048 * 2;
constexpr size_t WS_WR = WS_WC2 + (size_t)2 * 2 * 64 * 64 * 2;
constexpr size_t WS_B1C = WS_WR + (size_t)2 * 64 * 1024 * 2;
constexpr size_t WS_BIASD = WS_B1C + 1024;
constexpr size_t WS_ROPE = WS_BIASD + 6 * 2048 * 4;
constexpr size_t WS_WMOE = WS_ROPE + (size_t)16384 * 32 * 4;
constexpr size_t WMOE_WD = (size_t)32 * 512 * 1024 * 2;
constexpr size_t WS_XB = WS_WMOE + 50331648;
constexpr size_t WS_MLA = WS_XB + 33554432;
constexpr size_t MLA_KM = (size_t)8 * 6 * 2048 * 96 * 2, MLA_VM = 2 * MLA_KM;
constexpr size_t WS_HBUF = WS_MLA;
constexpr size_t WS_PRJ = WS_MLA + 50331648;
constexpr size_t HM64 = (size_t)2048 * 64 * 2;
constexpr size_t PRJ_QN = 0;
constexpr size_t PRJ_KN1 = PRJ_QN + 48 * HM64, PRJ_VN1 = PRJ_KN1 + 16 * HM64, PRJ_KN2 = PRJ_VN1 + 16 * HM64, PRJ_VN2 = PRJ_KN2 + 16 * HM64;
constexpr size_t PRJ_VML = PRJ_VN2 + 16 * HM64;
constexpr size_t PRJ_OG = PRJ_VML + 32 * HM64;
constexpr size_t PRJ_KR = PRJ_OG + (size_t)16384 * 256 * 2;
constexpr size_t PRJ_GATES = PRJ_KR + (size_t)16384 * 32 * 2;
constexpr size_t PRJ_DEAD = PRJ_GATES + (size_t)16384 * 32 * 4;
constexpr size_t PRJ_C0K = PRJ_DEAD, PRJ_C0V = PRJ_C0K + 16 * HM64 + 8192;
constexpr size_t PRJ_RAWQK = PRJ_C0V + 16 * HM64 + 8192;
constexpr size_t PRJ_DQKV = PRJ_RAWQK + (size_t)16384 * 512 * 2;
constexpr size_t PRJ_END = PRJ_DQKV + (size_t)16384 * 384 * 2;
static_assert(PRJ_END - PRJ_DEAD >= 33554432, "Y fits the dead part of PRJ");
constexpr size_t WS_Y = WS_PRJ + PRJ_DEAD;
constexpr size_t WS_YBUF = WS_PRJ;
static_assert((size_t)2 * 16384 * 1024 * 2 <= PRJ_END, "YBUF fits the PRJ region");
constexpr size_t WS_ML = WS_PRJ + PRJ_END;
constexpr size_t ML_KC = 32 * HM64, ML_DELTA = 2 * ML_KC, ML_DN = ML_DELTA + (size_t)1024 * 4096 * 2, ML_G = ML_DN + (size_t)1024 * 64 * 4, ML_BL = ML_G + (size_t)8 * 4 * 2048 * 2 * 4, ML_CP = ML_BL + 4096, ML_NP = ML_CP + (size_t)1024 * 4096 * 2, ML_END = ML_NP + (size_t)1024 * 64 * 2;
constexpr size_t WS_CMP = WS_ML + ML_END;
constexpr size_t CMP_V = (size_t)8 * 2 * 128 * 64 * 2;
constexpr size_t WS_META = WS_CMP + 2 * CMP_V;
constexpr size_t META_W = (size_t)32 * 16384 * 4, META_RT = 2 * META_W;
constexpr size_t WS_END = WS_META + META_RT + (size_t)16384 * 16;
constexpr int CW_BAR = 0;
constexpr int CW_Q = 4096;
constexpr int CW_SCAN = 4608;
constexpr int CW_TS = 4864;
constexpr int CW_CHK = 5120;
constexpr int CW_CNT = 8192;
constexpr int LDS_BYTES = 147456;
constexpr int LDS_MISC = LDS_BYTES - 256;
#define XB_TMO      128
#define XB_XCNT(j)  (256  + 64 * (j))
#define XB_XSUB(j)  (1280 + 64 * (j))
#define XB_XGEN(j)  (2304 + 64 * (j))
#define XB_TOP      3328
#define XB_TOPGEN   3392
#define XCD_BAR_WORDS 3456
#define XB_SPIN_CAP (1u << 18)

__device__ __forceinline__ unsigned xb_ld(unsigned* p)              { return __hip_atomic_load(p, __ATOMIC_RELAXED, __HIP_MEMORY_SCOPE_AGENT); }
__device__ __forceinline__ unsigned xb_add(unsigned* p, unsigned v) { return __hip_atomic_fetch_add(p, v, __ATOMIC_RELAXED, __HIP_MEMORY_SCOPE_AGENT); }
__device__ __forceinline__ unsigned xb_xcc_id() { return (unsigned)__builtin_amdgcn_s_getreg((3 << 11) | 20) & 0xFu; }
#define XB_SPIN(cond, bar) do { unsigned _sp = 0; while (cond) { __builtin_amdgcn_s_sleep(1); \
    if ((++_sp & 255u) == 0u) { if (xb_ld(&(bar)[XB_TMO])) break; if (_sp > XB_SPIN_CAP) { atomicAdd(&(bar)[XB_TMO], 1u); break; } } } } while (0)

struct XcdBarrier {
    int g_wv; unsigned* bar; unsigned x;
    volatile LAS unsigned* st;
};

__device__ __forceinline__ XcdBarrier xcd_barrier_post(unsigned* bar, volatile LAS unsigned* st, int g_wv) {
    XcdBarrier b; b.g_wv = g_wv; b.bar = bar; b.x = xb_xcc_id(); b.st = st;
    if (TIDX == 0) (void)xb_add(&bar[XB_XCNT(b.x)], 1u);
    return b;
}
__device__ __forceinline__ void xcd_barrier_complete(unsigned* bar, unsigned x, unsigned& nloc, unsigned& nx) {
    const unsigned G = gridDim.x * gridDim.y * gridDim.z;
    unsigned sum, cnt, mine, sp = 0u;
    for (;;) {
        sum = 0u; cnt = 0u; mine = 0u;
#pragma unroll
        for (unsigned j = 0; j < 16; ++j) { const unsigned c = xb_ld(&bar[XB_XCNT(j)]); sum += c; cnt += (c > 0u) ? 1u : 0u; mine = (j == x) ? c : mine; }
        if (sum == G) break;
        __builtin_amdgcn_s_sleep(1);
        if ((++sp & 255u) == 0u) { if (xb_ld(&bar[XB_TMO])) break; if (sp > XB_SPIN_CAP) { atomicAdd(&bar[XB_TMO], 1u); break; } }
    }
    nloc = mine > 0u ? mine : 1u; nx = cnt > 0u ? cnt : 1u;
}

__device__ __forceinline__ void xcd_barrier(const XcdBarrier& b) {
    asm volatile("s_waitcnt vmcnt(0)" ::: "memory");
    __syncthreads();
    const int g_wv = b.g_wv;
    if (TIDX == 0) {
        unsigned* bar = b.bar;
        __builtin_amdgcn_s_waitcnt(0);
        unsigned nloc = b.st[0], nx = b.st[1];
        if (nloc == 0u) { xcd_barrier_complete(bar, b.x, nloc, nx); b.st[0] = nloc; b.st[1] = nx; }
        const unsigned old = xb_add(&bar[XB_XSUB(b.x)], 1u);
        const unsigned gen = old / nloc;
        if (old + 1u == (gen + 1u) * nloc) {
            __builtin_amdgcn_fence(__ATOMIC_RELEASE, "agent");
            asm volatile("s_waitcnt vmcnt(0)" ::: "memory");
            const unsigned og = xb_add(&bar[XB_TOP], 1u);
            const unsigned tg = og / nx;
            if (og + 1u == (tg + 1u) * nx) xb_add(&bar[XB_TOPGEN], 1u);
            else XB_SPIN(xb_ld(&bar[XB_TOPGEN]) == tg, bar);
            __builtin_amdgcn_fence(__ATOMIC_ACQUIRE, "agent");
            xb_add(&bar[XB_XGEN(b.x)], 1u);
            asm volatile("s_waitcnt vmcnt(0)" ::: "memory");
        } else {
            XB_SPIN(xb_ld(&bar[XB_XGEN(b.x)]) == gen, bar);
            __builtin_amdgcn_fence(__ATOMIC_ACQUIRE, "agent");
            asm volatile("s_waitcnt vmcnt(0)" ::: "memory");
        }
    }
    __syncthreads();
}
struct Inputs { const float* p[30]; };
typedef const __attribute__((address_space(4))) Inputs* InPtr;
__device__ __forceinline__ InPtr in_tab() { InPtr p = (InPtr)__builtin_amdgcn_kernarg_segment_ptr(); asm volatile("" : "+s"(p)); return p; }
__device__ __forceinline__ unsigned char* launder(unsigned char* p) { size_t z = 0; asm volatile("" : "+s"(z)); return p + z; }

__host__ __device__ inline int inproj_refcol(int G, int e) {
    if (G < 6) return O_AQ + G * 64 + e;
    if (G < 18) return O_AKV + (G - 6) * 64 + e;
    if (G < 26) return O_BQK + (G - 18) * 64 + e;
    if (G < 30) return O_BV + (G - 26) * 64 + e;
    if (G < 34) return O_BO + (G - 30) * 64 + e;
    if (G < 37) return O_CDQ + (G - 34) * 64 + e;
    if (G == 37) { if (e < 32) return O_CKR + e; if (e < 50) return O_AG + (e - 32); if (e < 58) return O_BIF + (e - 50); return -1; }
    return O_CDKV + (G - 38) * 64 + e;
}
__host__ __device__ inline int uq_refcol(int G, int e) {
    if (G < 6) return G * 96 + e;
    if (G < 9) { const int idx = e & 31, bj = e >> 5, sub = idx >> 4, i = idx & 15; return (2 * (G - 6) + sub) * 96 + 64 + bj * 16 + i; }
    return -1;
}
__host__ __device__ inline int ukv_refcol(int G, int e) { return G < 6 ? G * 128 + e : (G - 6) * 128 + 64 + e; }
#define N2G(n) ((((n) >> 8) << 2) + (((n) >> 5) & 3))
#define N2E(n) (((((n) >> 7) & 1) << 5) + ((n) & 31))

struct FWin { const float* w; const float* g; __device__ __forceinline__ float operator()(int k, int n) const { const int c = inproj_refcol(N2G(n), N2E(n)); return c < 0 ? 0.f : w[(size_t)k * DIN + c] * g[k]; } };
struct FWout { const float* w; const float* ga; const float* gc; __device__ __forceinline__ float operator()(int k, int n) const {
    const int kr = k < 384 ? k : (k < 768 ? 640 + (k - 384) : 384 + (k - 768)); const float og = k < 384 ? ga[k] : (k < 768 ? gc[k - 384] : 1.f); return w[(size_t)kr * 1024 + n] * og; } };
struct FWuq { const float* w; const float* g; __device__ __forceinline__ float operator()(int k, int n) const { const int c = uq_refcol(N2G(n), N2E(n)); return (k < 192 && c >= 0) ? w[(size_t)k * 576 + c] * g[k] : 0.f; } };
struct FWukv { const float* w; const float* g; __device__ __forceinline__ float operator()(int k, int n) const { const int c = ukv_refcol(N2G(n), N2E(n)); return k >= 128 ? w[(size_t)(k - 128) * 768 + c] * g[k - 128] : 0.f; } };
struct FWc1 { const float* w; __device__ __forceinline__ float operator()(int k, int n) const { return w[(size_t)k * 64 + n]; } };
struct FWr { const float* wg; const float* we; const float* g; __device__ __forceinline__ float operator()(int k, int n) const { return n < 4 ? wg[k * 4 + n] * g[k] : (n < 36 ? we[k * 32 + n - 4] * g[k] : 0.f); } };
struct FWgu { const float* src; const float* g; int n0, col0; __device__ __forceinline__ float operator()(int k, int n) const { return src[(size_t)k * 256 + col0 + (n - n0)] * g[k]; } };
struct FWd { const float* w; __device__ __forceinline__ float operator()(int k, int n) const { return w[(size_t)k * 1024 + n]; } };

__device__ __forceinline__ void rope_cs(int pos, int j, float& cs, float& sn) {
    const double inv = exp2(-(double)j * (13.287712379549449 / 16.0));
    const double rev = (double)pos * inv * 0.15915494309189535; const float f = (float)(rev - rint(rev));
    cs = __builtin_amdgcn_cosf(f); sn = __builtin_amdgcn_sinf(f);
}
template <class F>
__device__ __forceinline__ void cvt_tile(const F& f, int n0, int k0, bf16_t* dst, int ldk, LAS float* tile, int tid) {
    { const int k = tid >> 3, nb = (tid & 7) * 8;
#pragma unroll
      for (int j = 0; j < 8; ++j) tile[k * 65 + nb + j] = f(k0 + k, n0 + nb + j); }
    __syncthreads();
    { const int n = tid >> 3, kb = (tid & 7) * 8; const LAS float* s = tile + kb * 65 + n;
      u32x4 o; o.x = pk_bf16(s[0], s[65]); o.y = pk_bf16(s[130], s[195]); o.z = pk_bf16(s[260], s[325]); o.w = pk_bf16(s[390], s[455]);
      *(u32x4*)(dst + (size_t)(n0 + n) * ldk + k0 + kb) = o; }
    __syncthreads();
}
template <class F>
__device__ __forceinline__ void cvt_item(const F& f, int it, int nK, bf16_t* dst, int ldk, LAS float* tile, int tid) { cvt_tile(f, (it / nK) * 64, (it % nK) * 64, dst, ldk, tile, tid); }

__device__ __forceinline__ void moe_item(InPtr in, int l, int it, const float*& src, int& ld, size_t& dst, int& ldk, bool& gain, int& kk0) {
    if (it < 32 * 64) { const int e = it >> 6, r = it & 63, n0 = (r >> 3) * 64, k0 = (r & 7) * 128, c0 = n0 & 255;
        src = (c0 < 128 ? in->p[27] : in->p[28]) + ((size_t)l * 32 + e) * 262144 + (size_t)k0 * 256 + (n0 >> 8) * 128 + (c0 & 127); ld = 256; gain = true; kk0 = k0;
        dst = ((size_t)e * 512 + n0) * 1024 + k0; ldk = 1024; }
    else { const int j = it - 32 * 64, e = j >> 5, r = j & 31, n0 = (r >> 1) * 64, k0 = (r & 1) * 128;
        src = in->p[29] + ((size_t)l * 32 + e) * 262144 + (size_t)k0 * 1024 + n0; ld = 1024; gain = false; kk0 = 0;
        dst = (size_t)16777216 + ((size_t)e * 1024 + n0) * 256 + k0; ldk = 256; }
}
__device__ __forceinline__ void cvt_moe_layer(InPtr in, unsigned char* ws, int l, LAS float* tile, int bid, int nb, int tid) {
    asm volatile("" : "+v"(tid));
    const float* g2 = in->p[22] + l * 1024; bf16_t* W = (bf16_t*)(ws + WS_WMOE);
    const int k = tid >> 3, nbq = (tid & 7) * 8;
    const int n = tid >> 3, kb = (tid & 7) * 8;
    constexpr int NIT = 32 * (64 + 32);
    int it = bid; f32x4 v0, v1, v2, v3; const float* src; int ld, ldk, kk0 = 0; size_t dst = 0; bool gain; float gk0 = 1.f, gk1 = 1.f;
    if (it < NIT) { moe_item(in, l, it, src, ld, dst, ldk, gain, kk0); v0 = *(const f32x4*)(src + (size_t)k * ld + nbq); v1 = *(const f32x4*)(src + (size_t)k * ld + nbq + 4);
        v2 = *(const f32x4*)(src + (size_t)(k + 64) * ld + nbq); v3 = *(const f32x4*)(src + (size_t)(k + 64) * ld + nbq + 4); gk0 = gain ? g2[kk0 + k] : 1.f; gk1 = gain ? g2[kk0 + 64 + k] : 1.f; }
    int buf = 0;
    for (; it < NIT; it += nb) {
        LAS float* t = tile + buf * (128 * 65);
        t[k * 65 + nbq + 0] = v0.x * gk0; t[k * 65 + nbq + 1] = v0.y * gk0; t[k * 65 + nbq + 2] = v0.z * gk0; t[k * 65 + nbq + 3] = v0.w * gk0;
        t[k * 65 + nbq + 4] = v1.x * gk0; t[k * 65 + nbq + 5] = v1.y * gk0; t[k * 65 + nbq + 6] = v1.z * gk0; t[k * 65 + nbq + 7] = v1.w * gk0;
        t[(k + 64) * 65 + nbq + 0] = v2.x * gk1; t[(k + 64) * 65 + nbq + 1] = v2.y * gk1; t[(k + 64) * 65 + nbq + 2] = v2.z * gk1; t[(k + 64) * 65 + nbq + 3] = v2.w * gk1;
        t[(k + 64) * 65 + nbq + 4] = v3.x * gk1; t[(k + 64) * 65 + nbq + 5] = v3.y * gk1; t[(k + 64) * 65 + nbq + 6] = v3.z * gk1; t[(k + 64) * 65 + nbq + 7] = v3.w * gk1;
        const size_t cdst = dst; const int cldk = ldk;
        __syncthreads();
        const int itn = it + nb;
        if (itn < NIT) { moe_item(in, l, itn, src, ld, dst, ldk, gain, kk0); v0 = *(const f32x4*)(src + (size_t)k * ld + nbq); v1 = *(const f32x4*)(src + (size_t)k * ld + nbq + 4);
            v2 = *(const f32x4*)(src + (size_t)(k + 64) * ld + nbq); v3 = *(const f32x4*)(src + (size_t)(k + 64) * ld + nbq + 4); gk0 = gain ? g2[kk0 + k] : 1.f; gk1 = gain ? g2[kk0 + 64 + k] : 1.f; }
#pragma unroll
        for (int hh = 0; hh < 2; ++hh) {
            const LAS float* s = t + (64 * hh + kb) * 65 + n;
            u32x4 o; o.x = pk_bf16(s[0], s[65]); o.y = pk_bf16(s[130], s[195]); o.z = pk_bf16(s[260], s[325]); o.w = pk_bf16(s[390], s[455]);
            *(u32x4*)(W + cdst + (size_t)n * cldk + 64 * hh + kb) = o;
        }
        buf ^= 1;
    }
    __syncthreads();
}

__device__ __forceinline__ void cvt_small_weights(InPtr in, unsigned char* ws, int l, LAS float* tile, int bid, int nb, int tid) {
    asm volatile("" : "+v"(tid));
    constexpr int I_WIN = 40 * 16, I_WOUT = 16 * 16, I_WU = 12 * 4, I_WC1 = 32, I_WC2 = 1, I_WR = 16;
    constexpr int PER_L = I_WIN + I_WOUT + 2 * I_WU + 2 * I_WC1 + 2 * I_WC2 + I_WR;
    for (int it0 = bid; it0 < PER_L; it0 += nb) {
        int it = it0;
        if (it < I_WIN) { FWin f{in->p[4] + (size_t)l * 1024 * DIN, in->p[3] + l * 1024}; cvt_item(f, it, 16, (bf16_t*)(ws + WS_WIN) + (size_t)l * 2560 * 1024, 1024, tile, tid); continue; } it -= I_WIN;
        if (it < I_WOUT) { FWout f{in->p[21] + (size_t)l * 1048576, in->p[10] + l * 384, in->p[20] + l * 384}; cvt_item(f, it, 16, (bf16_t*)(ws + WS_WOUT) + (size_t)l * 1048576, 1024, tile, tid); continue; } it -= I_WOUT;
        if (it < I_WU) { FWuq f{in->p[16] + (size_t)l * 192 * 576, in->p[15] + l * 192}; cvt_item(f, it, 4, (bf16_t*)(ws + WS_WUQ) + (size_t)l * 768 * 256, 256, tile, tid); continue; } it -= I_WU;
        if (it < I_WU) { FWukv f{in->p[18] + (size_t)l * 128 * 768, in->p[17] + l * 128}; cvt_item(f, it, 4, (bf16_t*)(ws + WS_WUKV) + (size_t)l * 768 * 256, 256, tile, tid); continue; } it -= I_WU;
        if (it < 2 * I_WC1) { const int s = it / I_WC1; FWc1 f{in->p[6] + ((size_t)l * 2 + s) * 2048 * 64}; cvt_item(f, it % I_WC1, 32, (bf16_t*)(ws + WS_WC1) + ((size_t)l * 2 + s) * 64 * 2048, 2048, tile, tid); continue; } it -= 2 * I_WC1;
        if (it < 2 * I_WC2) { const int s = it; FWc1 f{in->p[7] + ((size_t)l * 2 + s) * 64 * 64}; cvt_item(f, 0, 1, (bf16_t*)(ws + WS_WC2) + ((size_t)l * 2 + s) * 64 * 64, 64, tile, tid); continue; } it -= 2 * I_WC2;
        { FWr f{in->p[23] + (size_t)l * 4096, in->p[25] + (size_t)l * 32768, in->p[22] + l * 1024}; cvt_item(f, it, 16, (bf16_t*)(ws + WS_WR) + (size_t)l * 64 * 1024, 1024, tile, tid); }
    }
}

__device__ __forceinline__ void prologue(InPtr in, unsigned char* ws, LAS unsigned char* lds, int bid, int nb, int g_wv) {
    int tid_ = TIDX; asm volatile("" : "+v"(tid_));
    const int tid = tid_, lane = tid & 63, wid = tid >> 6;
    LAS float* tile = (LAS float*)lds;
    cvt_small_weights(in, ws, 0, tile, bid, nb, tid);
    { const float* x = in->p[0]; bf16_t* XB = (bf16_t*)(ws + WS_XB); float* ssqx = (float*)(ws + WS_SSQX);
      for (int r = bid * 8 + wid; r < NTOK; r += nb * 8) {
          const f32x4* xr = (const f32x4*)(x + (size_t)r * 1024) + lane; float s = 0.f; u32x2* o = (u32x2*)(XB + (size_t)r * 1024) + lane;
#pragma unroll
          for (int j = 0; j < 4; ++j) { const f32x4 v = xr[64 * j]; s += (v.x * v.x + v.y * v.y) + (v.z * v.z + v.w * v.w); u32x2 w; w.x = pk_bf16(v.x, v.y); w.y = pk_bf16(v.z, v.w); o[64 * j] = w; }
          s = wave_sum(s); if (lane == 0) ssqx[r] = s;
      } }
    { float* biasd = (float*)(ws + WS_BIASD); const float* rb = in->p[2];
      for (int i = bid * 512 + tid; i < 6 * 2048; i += nb * 512) { const int h = i >> 11, d = i & 2047; biasd[i] = rb[t5b(d) * 6 + h] * 1.44269504f; } }
    { float* rope = (float*)(ws + WS_ROPE); const int* pos = (const int*)in->p[1];
      for (int i = bid * 512 + tid; i < NTOK * 16; i += nb * 512) { const int tk = i >> 4, j = i & 15; float cs, sn; rope_cs(pos[tk], j, cs, sn); rope[(size_t)tk * 32 + j] = cs; rope[(size_t)tk * 32 + 16 + j] = sn; } }
    { float* b1c = (float*)(ws + WS_B1C); LAS float* red = (LAS float*)lds;
      for (int it = bid; it < 4; it += nb) { const float* pe = in->p[5] + (size_t)it * 2048; const float* w1 = in->p[6] + (size_t)it * 2048 * 64; const int f = tid & 63, part = tid >> 6;
          float a = 0.f; for (int k = part * 256; k < part * 256 + 256; ++k) a += pe[k] * w1[(size_t)k * 64 + f];
          __syncthreads(); red[tid] = a; __syncthreads();
          if (tid < 64) { float s = 0.f; for (int p2 = 0; p2 < 8; ++p2) s += red[p2 * 64 + tid]; b1c[it * 64 + tid] = s; }
          __syncthreads(); } }
}
namespace g8 {
constexpr int BM = 256, BK = 64, HALF = 128, HTB = HALF * BK * 2, STAGE_BYTES = 8 * HTB, NXCD = 8, WGM = 8;
__host__ __device__ __forceinline__ int lds_byte(int r, int c) { const int st = (r >> 4) * 2 + (c >> 5), rr = r & 15, cc = c & 31, ob = rr * 64 + cc * 2; return st * 1024 + (ob ^ (((ob >> 9) & 1) << 5)); }
__host__ __device__ __forceinline__ void stage_rc(int b, int& R, int& C) { const int st = b / 1024, sb = b % 1024, swz = sb ^ (((sb >> 9) & 1) << 5); R = (st >> 1) * 16 + swz / 64; C = (st & 1) * 32 + (swz % 64) / 2; }
__host__ __device__ __forceinline__ int perm32(int rho) { const int n = rho >> 4, i = rho & 15; return 8 * (i >> 2) + 4 * n + (i & 3); }

struct GUnit { const char* a; const char* b; int pm, pn, e, rows; };

__device__ __forceinline__ bool static_unit(int i, int G, int c, int nM, int nN, int& pm, int& pn) {
    const int nwg = nM * nN; const long L = (long)i * G + c; if (L >= nwg) return false;
    int wgid = (int)L; { const int q = nwg / NXCD, r = nwg % NXCD, xcd = wgid % NXCD, off = wgid / NXCD; wgid = (xcd < r ? xcd * (q + 1) : r * (q + 1) + (xcd - r) * q) + off; }
    const int nig = WGM * nN, gid = wgid / nig, fm = gid * WGM, gsz = (nM - fm) < WGM ? (nM - fm) : WGM;
    pm = fm + ((wgid % nig) % gsz); pn = (wgid % nig) / gsz; return true;
}
struct DenseSched {
    static constexpr bool GATHER = false, PARTIAL = false;
    const char* A; const char* Bt; int lda, ldb, nM, nN, G, c;
    __device__ __forceinline__ bool next(int i, GUnit& u) const {
        int pm, pn; if (!static_unit(i, G, c, nM, nN, pm, pn)) return false;
        u.pm = pm; u.pn = pn; u.e = 0; u.rows = 256; u.a = A + (size_t)pm * 256 * lda * 2; u.b = Bt + (size_t)pn * 256 * ldb * 2; return true;
    }
    __device__ __forceinline__ void aoff(const GUnit&, unsigned (&v)[2][2], const int (&R)[2], const int (&C)[2]) const {
#pragma unroll
        for (int h = 0; h < 2; ++h)
#pragma unroll
            for (int i = 0; i < 2; ++i) v[h][i] = (unsigned)((h * 128 + R[i]) * lda + C[i]) * 2u;
    }
};

template <class Epi, class Sched>
__device__ __forceinline__ void gemm_run(LAS unsigned char* lds, const int K, const int ldb, const Sched& S, const Epi& E, int g_wv) {
    int tid_ = TIDX; asm volatile("" : "+v"(tid_));
    const int tid = tid_, wid = __builtin_amdgcn_readfirstlane(tid >> 6), lane = tid & 63, wr = wid >> 2, wc = wid & 3, fr = lane & 15, fq = lane >> 4;
    int nt_ = K / BK; asm volatile("" : "+s"(nt_));
    const int nt = nt_;
    int R[2], C[2]; unsigned voffB[2];
#pragma unroll
    for (int i = 0; i < 2; ++i) { stage_rc(tid * 16 + i * 8192, R[i], C[i]); const int Rb = (R[i] & ~31) + perm32(R[i] & 31); voffB[i] = (unsigned)(Rb * ldb + C[i]) * 2u; }
    const size_t kstep = (size_t)(BK * 2);
    const size_t hstepB = (size_t)HALF * ldb * 2;
    const unsigned ldsw = (unsigned)wid * 1024u;
    const int aoff = lds_byte(wr * 64 + fr, fq * 8), boff = lds_byte(wc * 32 + fr, fq * 8);
#define G8_SA(b, h) (((b) * 2 + (h)) * HTB)
#define G8_SB(b, h) ((4 + (b) * 2 + (h)) * HTB)
#define G8_GLDS(bufoff, gptr, i_) __builtin_amdgcn_global_load_lds((const unsigned*)(gptr), (LAS unsigned*)(lds + (bufoff) + ldsw + (i_) * 8192), 16, 0, 0)
#define G8_STAGE_B(bufoff, gbase) do { G8_GLDS(bufoff, (const char*)(gbase) + voffB[0], 0); G8_GLDS(bufoff, (const char*)(gbase) + voffB[1], 1); } while (0)
#define G8_STAGE_A(bufoff, gbase, v0, v1) do { G8_GLDS(bufoff, (const char*)(gbase) + (v0), 0); G8_GLDS(bufoff, (const char*)(gbase) + (v1), 1); } while (0)
#define G8_LDA(dst, b, h) do { _Pragma("unroll") for (int m = 0; m < 4; ++m) _Pragma("unroll") for (int k = 0; k < 2; ++k) dst[m][k] = *(const LAS bf16x8*)(lds + G8_SA(b, h) + aoff + m * 2048 + k * 1024); } while (0)
#define G8_LDB(dst, b, h) do { _Pragma("unroll") for (int n = 0; n < 2; ++n) _Pragma("unroll") for (int k = 0; k < 2; ++k) dst[n][k] = *(const LAS bf16x8*)(lds + G8_SB(b, h) + boff + n * 2048 + k * 1024); } while (0)
#define G8_MMA(ai, bj, At, Bt) do { __builtin_amdgcn_s_setprio(1); _Pragma("unroll") for (int m = 0; m < 4; ++m) { if (!PARTIAL || ((mmask >> ((ai) * 4 + m)) & 1u)) { _Pragma("unroll") for (int n = 0; n < 2; ++n) _Pragma("unroll") for (int k = 0; k < 2; ++k) \
        acc[ai][bj][m][n] = __builtin_amdgcn_mfma_f32_16x16x32_bf16(Bt[n][k], At[m][k], acc[ai][bj][m][n], 0, 0, 0); } } __builtin_amdgcn_s_setprio(0); } while (0)
#define G8_WAIT_V(n) asm volatile("s_waitcnt vmcnt(" #n ")" ::: "memory")
#define G8_WAIT_L(n) asm volatile("s_waitcnt lgkmcnt(" #n ")" ::: "memory")
#define G8_BAR __builtin_amdgcn_s_barrier()
#define G8_SCHED __builtin_amdgcn_sched_barrier(0)
    GUnit cur, nxt; int ui = 0;
    if (!S.next(0, cur)) return;
    constexpr bool GATHER = Sched::GATHER, PARTIAL = Sched::PARTIAL;
    unsigned mmask = 0xffu;
#define G8_MASK(u) do { if (PARTIAL) { mmask = 0u; _Pragma("unroll") for (int q_ = 0; q_ < 8; ++q_) mmask |= (((q_ >> 2) * 128 + wr * 64 + (q_ & 3) * 16) < (u).rows) ? (1u << q_) : 0u; } } while (0)
    unsigned vc[2][2];
    S.aoff(cur, vc, R, C); G8_MASK(cur);
    LAS u32x4* stash = (LAS u32x4*)(lds + STAGE_BYTES + 4096) + tid;
    f32x4 acc[2][2][4][2];
#pragma unroll
    for (int a = 0; a < 2; ++a)
#pragma unroll
        for (int b = 0; b < 2; ++b)
#pragma unroll
            for (int m = 0; m < 4; ++m)
#pragma unroll
                for (int n = 0; n < 2; ++n) acc[a][b][m][n] = (f32x4){0.f, 0.f, 0.f, 0.f};
    bf16x8 At[4][2], B0[2][2], B1[2][2];
    const char* cA = cur.a; const char* cB = cur.b;
    G8_STAGE_B(G8_SB(0, 0), cB); G8_STAGE_B(G8_SB(0, 1), cB + hstepB); G8_STAGE_A(G8_SA(0, 0), cA, vc[0][0], vc[0][1]); G8_STAGE_A(G8_SA(0, 1), cA, vc[1][0], vc[1][1]);
    if (wr == 1) G8_BAR;
    G8_WAIT_V(2); G8_BAR;
    G8_STAGE_B(G8_SB(1, 0), cB + kstep); G8_STAGE_A(G8_SA(1, 0), cA + kstep, vc[0][0], vc[0][1]); G8_STAGE_B(G8_SB(1, 1), cB + hstepB + kstep);
    G8_WAIT_V(6); G8_BAR;
    for (;;) {
        const bool has_next = S.next(ui + 1, nxt);
        if (GATHER) { unsigned vn[2][2];
            if (has_next) S.aoff(nxt, vn, R, C);
            else { vn[0][0] = vc[0][0]; vn[0][1] = vc[0][1]; vn[1][0] = vc[1][0]; vn[1][1] = vc[1][1]; }
            u32x4 sv; sv.x = vn[0][0]; sv.y = vn[0][1]; sv.z = vn[1][0]; sv.w = vn[1][1]; *stash = sv; }
        const char* nA = has_next ? nxt.a : cA; const char* nB = has_next ? nxt.b : cB;
#pragma unroll 1
        for (int seg = 0; seg < (Epi::KHOOK ? 3 : 1); ++seg) {
        const int tlo = Epi::KHOOK ? 6 * seg : 0, thi = Epi::KHOOK ? (seg == 2 ? nt : 6 * seg + 6) : nt;
#pragma unroll 1
        for (int t = tlo; t < thi; t += 2) {
            const bool last = (t == nt - 2);
            const char* a1 = cA + (size_t)(t + 1) * kstep;
            const char* a2 = last ? nA : cA + (size_t)(t + 2) * kstep; const char* b2 = last ? nB : cB + (size_t)(t + 2) * kstep;
            const char* a3 = a2 + kstep; const char* b3 = b2 + kstep;
            unsigned w00 = vc[0][0], w01 = vc[0][1], w10 = vc[1][0], w11 = vc[1][1];
            if (GATHER) { if (last) { const u32x4 sv = *stash; w00 = sv.x; w01 = sv.y; w10 = sv.z; w11 = sv.w; } }
            G8_LDB(B0, 0, 0); G8_LDB(B1, 0, 1); G8_SCHED; G8_LDA(At, 0, 0); G8_STAGE_A(G8_SA(1, 1), a1, vc[1][0], vc[1][1]);
            G8_WAIT_V(8); G8_WAIT_L(0); G8_BAR; G8_MMA(0, 0, At, B0); G8_MMA(0, 1, At, B1); G8_BAR; G8_SCHED;
            G8_LDA(At, 0, 1); G8_STAGE_B(G8_SB(0, 0), b2); G8_STAGE_B(G8_SB(0, 1), b2 + hstepB); G8_STAGE_A(G8_SA(0, 0), a2, w00, w01);
            G8_WAIT_V(8); G8_WAIT_L(0); G8_BAR; G8_MMA(1, 0, At, B0); G8_MMA(1, 1, At, B1); G8_BAR; G8_SCHED;
            G8_LDB(B0, 1, 0); G8_LDB(B1, 1, 1); G8_SCHED; G8_LDA(At, 1, 0); G8_STAGE_A(G8_SA(0, 1), a2, w10, w11);
            G8_WAIT_V(8); G8_WAIT_L(0); G8_BAR; G8_MMA(0, 0, At, B0); G8_MMA(0, 1, At, B1); G8_BAR; G8_SCHED;
            G8_LDA(At, 1, 1); G8_STAGE_B(G8_SB(1, 0), b3); G8_STAGE_B(G8_SB(1, 1), b3 + hstepB); G8_STAGE_A(G8_SA(1, 0), a3, w00, w01);
            G8_WAIT_V(8); G8_WAIT_L(0); G8_BAR; G8_MMA(1, 0, At, B0); G8_MMA(1, 1, At, B1); G8_BAR; G8_SCHED;
        }
        if constexpr (Epi::KHOOK) { if (seg < 2) E.kscale(acc, seg, wr, fr); }
        }
        if (wr == 0) G8_BAR;
        { int fr_ = fr, fq_ = fq; asm volatile("" : "+v"(fr_), "+v"(fq_));
          E(acc, cur, wr, wc, fr_, fq_); }
        if (!has_next) break;
#pragma unroll
        for (int a = 0; a < 2; ++a)
#pragma unroll
            for (int b = 0; b < 2; ++b)
#pragma unroll
                for (int m = 0; m < 4; ++m)
#pragma unroll
                    for (int n = 0; n < 2; ++n) acc[a][b][m][n] = (f32x4){0.f, 0.f, 0.f, 0.f};
        cur = nxt; cA = nA; cB = nB; ++ui; G8_MASK(cur);
        if (GATHER) { const u32x4 sv = *stash; vc[0][0] = sv.x; vc[0][1] = sv.y; vc[1][0] = sv.z; vc[1][1] = sv.w; }
        if (wr == 1) G8_BAR;
    }
    G8_WAIT_V(0);
    G8_BAR;
#undef G8_SA
#undef G8_SB
#undef G8_GLDS
#undef G8_STAGE_A
#undef G8_STAGE_B
#undef G8_LDA
#undef G8_LDB
#undef G8_MMA
#undef G8_MASK
#undef G8_WAIT_V
#undef G8_WAIT_L
#undef G8_BAR
#undef G8_SCHED
}
}
using g8::GUnit;
__device__ __forceinline__ void st_bf16x8(bf16_t* p, const float (&v)[8]) { u32x4 w; w.x = pk_bf16(v[0], v[1]); w.y = pk_bf16(v[2], v[3]); w.z = pk_bf16(v[4], v[5]); w.w = pk_bf16(v[6], v[7]); *(u32x4*)p = w; }
__device__ __forceinline__ float quad_sum(float s) { s += __shfl_xor(s, 16); s += __shfl_xor(s, 32); return s; }

struct EpiInProj {
    static constexpr bool KHOOK = false;
    const float* ssqx; float* part_dq; float* part_dkv; const float* qg; const float* kg; const float* krg; const float* rope;
    unsigned char* prj;
    __device__ __forceinline__ void operator()(const f32x4 (&acc)[2][2][4][2], const GUnit& u, int wr, int wc, int fr, int fq) const {
        const int G = u.pn * 4 + wc;
        const bool isq = G < 6; const int a = G - 6; const bool isk = (G >= 10 && G < 18 && ((a >> 1) & 1) == 0);
        const float* g0 = (isq ? qg : kg) + 8 * fq;
        float rs8[8];
#pragma unroll
        for (int k = 0; k < 8; ++k) rs8[k] = ssqx[u.pm * 256 + (k >> 2) * 128 + wr * 64 + (k & 3) * 16 + fr];
#pragma unroll
        for (int k = 0; k < 8; ++k) rs8[k] = rsqrtf(rs8[k] * (1.f / 1024.f) + 1e-6f);
#pragma unroll
        for (int ai = 0; ai < 2; ++ai)
#pragma unroll
            for (int m = 0; m < 4; ++m) {
                __builtin_amdgcn_sched_barrier(0);
                const int row = u.pm * 256 + ai * 128 + wr * 64 + m * 16 + fr; const int b = row >> 11, t = row & 2047;
                const float rs = rs8[ai * 4 + m];
                float v[2][8];
#pragma unroll
                for (int bj = 0; bj < 2; ++bj)
#pragma unroll
                    for (int n = 0; n < 2; ++n)
#pragma unroll
                        for (int j = 0; j < 4; ++j) v[bj][4 * n + j] = acc[ai][bj][m][n][j] * rs;
                float ss = 0.f;
#pragma unroll
                for (int bj = 0; bj < 2; ++bj)
#pragma unroll
                    for (int i = 0; i < 8; ++i) ss += v[bj][i] * v[bj][i];
                bf16_t* dst = nullptr; int bstride = 32;
                if (isq) {
                    ss = quad_sum(ss); const float sc = rsqrtf(ss * (1.f / 64.f) + 1e-6f) * 0.18033688f;
#pragma unroll
                    for (int i = 0; i < 8; ++i) { v[0][i] *= sc * g0[i]; v[1][i] *= sc * g0[32 + i]; }
                    dst = (bf16_t*)(prj + PRJ_QN) + ((size_t)(b * 6 + G) * 2048 + t) * 64;
                } else if (G < 18) {
                    const int br = a >> 2, s = (a >> 1) & 1, hk = a & 1;
                    if (br > 0 && s == 0) {
                        ss = quad_sum(ss); const float sc = rsqrtf(ss * (1.f / 64.f) + 1e-6f);
#pragma unroll
                        for (int i = 0; i < 8; ++i) { v[0][i] *= sc * g0[i]; v[1][i] *= sc * g0[32 + i]; }
                    }
                    const size_t base = br == 0 ? (s ? PRJ_C0V : PRJ_C0K) : (br == 1 ? (s ? PRJ_VN1 : PRJ_KN1) : (s ? PRJ_VN2 : PRJ_KN2));
                    dst = (bf16_t*)(prj + base) + ((size_t)(b * 2 + hk) * 2048 + t) * 64;
                } else if (G < 26) { dst = (bf16_t*)(prj + PRJ_RAWQK) + (size_t)row * 512 + (G - 18) * 64; }
                else if (G < 30) { dst = (bf16_t*)(prj + PRJ_VML) + ((size_t)(b * 4 + (G - 26)) * 2048 + t) * 64; }
                else if (G < 34) { dst = (bf16_t*)(prj + PRJ_OG) + (size_t)row * 256 + (G - 30) * 64; }
                else if (G < 37) { dst = (bf16_t*)(prj + PRJ_DQKV) + (size_t)row * 384 + (G - 34) * 64; ss = quad_sum(ss); if (fq == 0) part_dq[(size_t)row * 4 + (G - 34)] = ss; }
                else if (G == 37) {
                    dst = (bf16_t*)(prj + PRJ_DQKV) + (size_t)row * 384 + 192;
                    float* gt = (float*)(prj + PRJ_GATES) + (size_t)row * 32 + 8 * fq;
                    *(f32x4*)gt = (f32x4){v[1][0], v[1][1], v[1][2], v[1][3]}; *(f32x4*)(gt + 4) = (f32x4){v[1][4], v[1][5], v[1][6], v[1][7]};
                    float s0 = 0.f;
#pragma unroll
                    for (int i = 0; i < 8; ++i) s0 += v[0][i] * v[0][i];
                    s0 = quad_sum(s0); const float sc = rsqrtf(s0 * (1.f / 32.f) + 1e-6f);
                    const float* rp = rope + (size_t)row * 32 + ((8 * fq) & 15);
                    float kr[8];
#pragma unroll
                    for (int i = 0; i < 8; ++i) { const float val = v[0][i] * sc * krg[8 * fq + i]; const float oth = __shfl_xor(val, 32); const float cs = rp[i], sn = rp[16 + i]; kr[i] = fq < 2 ? val * cs - oth * sn : val * cs + oth * sn; }
                    st_bf16x8((bf16_t*)(prj + PRJ_KR) + (size_t)row * 32 + 8 * fq, kr);
                } else { dst = (bf16_t*)(prj + PRJ_DQKV) + (size_t)row * 384 + 256 + (G - 38) * 64; ss = quad_sum(ss); if (fq == 0) part_dkv[(size_t)row * 2 + (G - 38)] = ss; }
                st_bf16x8(dst + 8 * fq, v[0]); st_bf16x8(dst + bstride + 8 * fq, v[1]);
            }
    }
};

struct EpiUq {
    static constexpr bool KHOOK = false;
    const float* ssq_dq; const float* qkn; const float* rope; bf16_t* QM;
    __device__ __forceinline__ void operator()(const f32x4 (&acc)[2][2][4][2], const GUnit& u, int wr, int wc, int fr, int fq) const {
        const int G = u.pn * 4 + wc; if (G >= 9) return;
        const float scale = 0.14724444f;
        const float* g0 = G < 6 ? qkn + 8 * fq : qkn + 64 + 8 * (fq & 1); const float* g1 = G < 6 ? g0 + 32 : g0 + 16;
        float rs8[8];
#pragma unroll
        for (int k = 0; k < 8; ++k) { const f32x4 pq = *(const f32x4*)(ssq_dq + (size_t)(u.pm * 256 + (k >> 2) * 128 + wr * 64 + (k & 3) * 16 + fr) * 4); rs8[k] = (pq.x + pq.y) + pq.z; }
#pragma unroll
        for (int k = 0; k < 8; ++k) rs8[k] = rsqrtf(rs8[k] * (1.f / 192.f) + 1e-6f);
#pragma unroll
        for (int ai = 0; ai < 2; ++ai)
#pragma unroll
            for (int m = 0; m < 4; ++m) {
                __builtin_amdgcn_sched_barrier(0);
                const int row = u.pm * 256 + ai * 128 + wr * 64 + m * 16 + fr; const int b = row >> 11, t = row & 2047;
                const float rs = rs8[ai * 4 + m];
                float v[2][8]; float ss = 0.f;
#pragma unroll
                for (int bj = 0; bj < 2; ++bj)
#pragma unroll
                    for (int n = 0; n < 2; ++n)
#pragma unroll
                        for (int j = 0; j < 4; ++j) { const float x = acc[ai][bj][m][n][j] * rs; v[bj][4 * n + j] = x; ss += x * x; }
                if (G < 6) ss = quad_sum(ss); else ss += __shfl_xor(ss, 16);
                const float sc = rsqrtf(ss * (G < 6 ? 1.f / 64.f : 1.f / 32.f) + 1e-6f) * scale;
#pragma unroll
                for (int i = 0; i < 8; ++i) { v[0][i] *= sc * g0[i]; v[1][i] *= sc * g1[i]; }
                if (G < 6) {
                    bf16_t* dst = QM + ((size_t)(b * 6 + G) * 2048 + t) * 96;
                    st_bf16x8(dst + 8 * fq, v[0]); st_bf16x8(dst + 32 + 8 * fq, v[1]);
                } else {
                    const int i16 = 8 * (fq & 1); const int head = 2 * (G - 6) + (fq >> 1);
                    const float* rp = rope + (size_t)row * 32 + i16; float o1[8], o2[8];
#pragma unroll
                    for (int i = 0; i < 8; ++i) { const float cs = rp[i], sn = rp[16 + i]; o1[i] = v[0][i] * cs - v[1][i] * sn; o2[i] = v[1][i] * cs + v[0][i] * sn; }
                    bf16_t* dst = QM + ((size_t)(b * 6 + head) * 2048 + t) * 96 + 64 + i16;
                    st_bf16x8(dst, o1); st_bf16x8(dst + 16, o2);
                }
            }
    }
};
struct EpiUkv {
    static constexpr bool KHOOK = false;
    const float* ssq_dkv; const float* qkn; const bf16_t* KR; bf16_t* KM; bf16_t* VM;
    __device__ __forceinline__ void operator()(const f32x4 (&acc)[2][2][4][2], const GUnit& u, int wr, int wc, int fr, int fq) const {
        const int G = u.pn * 4 + wc;
        const float* g0 = qkn + 96 + 8 * fq;
        float rs8[8];
#pragma unroll
        for (int k = 0; k < 8; ++k) { const size_t rr = (size_t)(u.pm * 256 + (k >> 2) * 128 + wr * 64 + (k & 3) * 16 + fr); rs8[k] = ssq_dkv[rr * 2] + ssq_dkv[rr * 2 + 1]; }
#pragma unroll
        for (int k = 0; k < 8; ++k) rs8[k] = rsqrtf(rs8[k] * (1.f / 128.f) + 1e-6f);
#pragma unroll
        for (int ai = 0; ai < 2; ++ai)
#pragma unroll
            for (int m = 0; m < 4; ++m) {
                __builtin_amdgcn_sched_barrier(0);
                const int row = u.pm * 256 + ai * 128 + wr * 64 + m * 16 + fr; const int b = row >> 11, t = row & 2047;
                const float rs = rs8[ai * 4 + m];
                float v[2][8]; float ss = 0.f;
#pragma unroll
                for (int bj = 0; bj < 2; ++bj)
#pragma unroll
                    for (int n = 0; n < 2; ++n)
#pragma unroll
                        for (int j = 0; j < 4; ++j) { const float x = acc[ai][bj][m][n][j] * rs; v[bj][4 * n + j] = x; ss += x * x; }
                if (G < 6) {
                    ss = quad_sum(ss); const float sc = rsqrtf(ss * (1.f / 64.f) + 1e-6f);
#pragma unroll
                    for (int i = 0; i < 8; ++i) { v[0][i] *= sc * g0[i]; v[1][i] *= sc * g0[32 + i]; }
                    bf16_t* dst = KM + ((size_t)(b * 6 + G) * 2048 + t) * 96;
                    st_bf16x8(dst + 8 * fq, v[0]); st_bf16x8(dst + 32 + 8 * fq, v[1]);
                    *(u32x4*)(dst + 64 + 8 * fq) = *(const u32x4*)(KR + (size_t)row * 32 + 8 * fq);
                } else {
                    bf16_t* dst = VM + ((size_t)(b * 6 + (G - 6)) * 2048 + t) * 64;
                    st_bf16x8(dst + 8 * fq, v[0]); st_bf16x8(dst + 32 + 8 * fq, v[1]);
                }
            }
    }
};
#define MFMA16(a, b, c) __builtin_amdgcn_mfma_f32_16x16x32_bf16(a, b, c, 0, 0, 0)
#define MFMA32(a, b, c) __builtin_amdgcn_mfma_f32_32x32x16_bf16(a, b, c, 0, 0, 0)
#define LDS_FENCE() asm volatile("s_waitcnt lgkmcnt(0)" ::: "memory")

__device__ __forceinline__ void cmp_unit(int u, int l, InPtr in, unsigned char* ws, LAS unsigned char* lds, int g_wv) {
    int tid_ = TIDX; asm volatile("" : "+v"(tid_));
    const int tid = tid_, w = tid >> 6, lane = tid & 63, r = lane & 15, q = lane >> 4;
    const int b = u >> 2, s = (u >> 1) & 1, hk = u & 1;
    const bf16_t* A = (const bf16_t*)(ws + WS_PRJ + (s ? PRJ_C0V : PRJ_C0K)) + (size_t)(b * 2 + hk) * 2048 * 64;
    const bf16_t* W1 = (const bf16_t*)(ws + WS_WC1) + ((size_t)l * 2 + s) * 64 * 2048;
    const bf16_t* W2 = (const bf16_t*)(ws + WS_WC2) + ((size_t)l * 2 + s) * 64 * 64;
    const float* b1 = (const float*)(ws + WS_B1C) + (l * 2 + s) * 64;
    f32x4 acc[4];
#pragma unroll
    for (int nb = 0; nb < 4; ++nb) acc[nb] = (f32x4){0.f, 0.f, 0.f, 0.f};
    const bf16_t* ap = A + (size_t)(16 * w + r) * 1024 + 8 * q;
    constexpr int WP = 528, WBUF = 64 * WP; LAS unsigned char* wb = lds + 24576;
    u32x4 st[4];
#pragma unroll
    for (int i = 0; i < 4; ++i) { const int c = tid + 512 * i; st[i] = *(const u32x4*)(W1 + (size_t)(c >> 5) * 2048 + (c & 31) * 8); }
#pragma unroll
    for (int i = 0; i < 4; ++i) { const int c = tid + 512 * i; *(LAS u32x4*)(wb + (c >> 5) * WP + (c & 31) * 16) = st[i]; }
    __syncthreads();
#pragma unroll 1
    for (int kc = 0; kc < 8; ++kc) {
        const int cur = kc & 1;
        if (kc < 7) {
#pragma unroll
            for (int i = 0; i < 4; ++i) { const int c = tid + 512 * i; st[i] = *(const u32x4*)(W1 + (size_t)(c >> 5) * 2048 + (kc + 1) * 256 + (c & 31) * 8); }
        }
        bf16x8 af[8];
#pragma unroll
        for (int ks = 0; ks < 8; ++ks) af[ks] = *(const bf16x8*)(ap + 256 * kc + 32 * ks);
#pragma unroll
        for (int ks = 0; ks < 8; ++ks)
#pragma unroll
            for (int nb = 0; nb < 4; ++nb) { const bf16x8 bb = *(const LAS bf16x8*)(wb + cur * WBUF + (16 * nb + r) * WP + (32 * ks + 8 * q) * 2); acc[nb] = MFMA16(af[ks], bb, acc[nb]); }
        if (kc < 7) {
#pragma unroll
            for (int i = 0; i < 4; ++i) { const int c = tid + 512 * i; *(LAS u32x4*)(wb + (cur ^ 1) * WBUF + (c >> 5) * WP + (c & 31) * 16) = st[i]; }
        }
        __syncthreads();
    }
    LAS bf16_t* hl = (LAS bf16_t*)(lds + w * 2304);
#pragma unroll
    for (int nb = 0; nb < 4; ++nb) { const float bias = b1[16 * nb + r];
#pragma unroll
        for (int j = 0; j < 4; ++j) hl[(4 * q + j) * 72 + 16 * nb + r] = f2bf(siluf(acc[nb][j] + bias)); }
    LDS_FENCE();
    f32x4 o[4];
#pragma unroll
    for (int nb = 0; nb < 4; ++nb) o[nb] = (f32x4){0.f, 0.f, 0.f, 0.f};
#pragma unroll
    for (int ks = 0; ks < 2; ++ks) {
        const bf16x8 a = *(const LAS bf16x8*)(hl + r * 72 + 32 * ks + 8 * q);
#pragma unroll
        for (int nb = 0; nb < 4; ++nb) { const bf16x8 bb = *(const bf16x8*)(W2 + (size_t)(16 * nb + r) * 64 + 32 * ks + 8 * q); o[nb] = MFMA16(a, bb, o[nb]); }
    }
    LDS_FENCE();
    const float* kg = in->p[9] + l * 64;
    bf16_t* dst = (bf16_t*)(ws + WS_CMP + (s ? CMP_V : 0)) + (size_t)(b * 2 + hk) * 128 * 64;
#pragma unroll
    for (int j = 0; j < 4; ++j) {
        const int n = 16 * w + 4 * q + j; float ss = 0.f;
#pragma unroll
        for (int nb = 0; nb < 4; ++nb) ss += o[nb][j] * o[nb][j];
        ss += __shfl_xor(ss, 1); ss += __shfl_xor(ss, 2); ss += __shfl_xor(ss, 4); ss += __shfl_xor(ss, 8);
        const float sc = s == 0 ? rsqrtf(ss * (1.f / 64.f) + 1e-6f) : 1.f;
#pragma unroll
        for (int nb = 0; nb < 4; ++nb) { const int d = 16 * nb + r; const float v = o[nb][j] * sc * (s == 0 ? kg[d] : 1.f); dst[(size_t)n * 64 + d] = n < 127 ? f2bf(v) : (bf16_t)0; }
    }
}

__device__ __forceinline__ int swz_off(int row, int chunk) { return row * 128 + ((chunk ^ (row & 7)) << 4); }
__device__ __forceinline__ float log_sigmoid(float x) { return fminf(x, 0.f) - log1pf(__expf(-fabsf(x))); }
__device__ __forceinline__ void ml_delta_wave(int cu, int l, InPtr in, unsigned char* ws, LAS unsigned char* wl, int lane) {
    const int c = cu & 31, bh = cu >> 5, h = bh & 3, b = bh >> 2; const int t0 = c * 64; const size_t row0 = (size_t)b * 2048 + t0;
    const float* G = (const float*)(ws + WS_PRJ + PRJ_GATES);
    const float ip = G[(row0 + lane) * 32 + 18 + h] + in->p[12][l * 4 + h], fp = G[(row0 + lane) * 32 + 22 + h] + in->p[13][l * 4 + h];
    float bcum = log_sigmoid(fp);
#pragma unroll
    for (int o = 1; o < 64; o <<= 1) { const float t = __builtin_bit_cast(float, __builtin_amdgcn_ds_bpermute(((lane - o) & 63) << 2, __builtin_bit_cast(int, bcum))); if (lane >= o) bcum += t; }
    const float bL = __builtin_bit_cast(float, __builtin_amdgcn_readlane(__builtin_bit_cast(int, bcum), 63)); const float wgt = __expf(bL - bcum + ip);
    { float* mlg = (float*)(ws + WS_ML + ML_G) + ((size_t)bh * 2048 + t0 + lane) * 2; mlg[0] = bcum; mlg[1] = ip; if (lane == 0) ((float*)(ws + WS_ML + ML_BL))[cu] = bL; }
    const bf16_t* raw = (const bf16_t*)(ws + WS_PRJ + PRJ_RAWQK); const float* cw = in->p[11] + (size_t)l * 4 * 512;
    float wq[4], wk[4];
#pragma unroll
    for (int j = 0; j < 4; ++j) { wq[j] = cw[j * 512 + h * 64 + lane]; wk[j] = cw[j * 512 + 256 + h * 64 + lane]; }
    float q3 = 0.f, q2 = 0.f, q1 = 0.f, k3 = 0.f, k2 = 0.f, k1 = 0.f;
    if (c > 0) { const bf16_t* p = raw + (row0 - 3) * 512 + h * 64 + lane; q3 = bf2f(p[0]); q2 = bf2f(p[512]); q1 = bf2f(p[1024]); k3 = bf2f(p[256]); k2 = bf2f(p[512 + 256]); k1 = bf2f(p[1024 + 256]); }
    bf16_t* QC = (bf16_t*)(ws + WS_ML) + ((size_t)bh * 2048 + t0) * 64 + lane; bf16_t* KC = (bf16_t*)(ws + WS_ML + ML_KC) + ((size_t)bh * 2048 + t0) * 64 + lane;
    const bf16_t* V = (const bf16_t*)(ws + WS_PRJ + PRJ_VML) + ((size_t)bh * 2048 + t0) * 64 + lane;
    float dn = 0.f;
    const bf16_t* rq = raw + row0 * 512 + h * 64 + lane;
    bf16_t cq[8], ck[8], cv[8], nq[8], nk[8], nv[8];
#pragma unroll
    for (int j = 0; j < 8; ++j) { cq[j] = rq[(size_t)j * 512]; ck[j] = rq[(size_t)j * 512 + 256]; cv[j] = V[(size_t)j * 64]; }
#pragma unroll 1
    for (int s8 = 0; s8 < 8; ++s8) {
        if (s8 < 7) {
#pragma unroll
            for (int j = 0; j < 8; ++j) { const int s = s8 * 8 + 8 + j; nq[j] = rq[(size_t)s * 512]; nk[j] = rq[(size_t)s * 512 + 256]; nv[j] = V[(size_t)s * 64]; }
        }
        float kb[8], vb[8]; bf16_t qo[8], ko[8];
#pragma unroll
        for (int j = 0; j < 8; ++j) {
            const int s = s8 * 8 + j;
            const float q0 = bf2f(cq[j]), k0 = bf2f(ck[j]);
            const float qv = siluf(wq[0] * q3 + wq[1] * q2 + wq[2] * q1 + wq[3] * q0), kv = siluf(wk[0] * k3 + wk[1] * k2 + wk[2] * k1 + wk[3] * k0) * 0.125f;
            q3 = q2; q2 = q1; q1 = q0; k3 = k2; k2 = k1; k1 = k0;
            qo[j] = f2bf(qv); ko[j] = f2bf(kv);
            const float ws_ = __builtin_bit_cast(float, __builtin_amdgcn_readlane(__builtin_bit_cast(int, wgt), s)); kb[j] = bf2f(ko[j]); dn += ws_ * kb[j]; vb[j] = ws_ * bf2f(cv[j]);
        }
#pragma unroll
        for (int j = 0; j < 8; ++j) { QC[(size_t)(s8 * 8 + j) * 64] = qo[j]; KC[(size_t)(s8 * 8 + j) * 64] = ko[j]; }
        u32x4 pk; pk.x = pk_bf16(kb[0], kb[1]); pk.y = pk_bf16(kb[2], kb[3]); pk.z = pk_bf16(kb[4], kb[5]); pk.w = pk_bf16(kb[6], kb[7]);
        *(LAS u32x4*)(wl + swz_off(lane, s8)) = pk;
        pk.x = pk_bf16(vb[0], vb[1]); pk.y = pk_bf16(vb[2], vb[3]); pk.z = pk_bf16(vb[4], vb[5]); pk.w = pk_bf16(vb[6], vb[7]);
        *(LAS u32x4*)(wl + 8192 + swz_off(lane, s8)) = pk;
#pragma unroll
        for (int j = 0; j < 8; ++j) { cq[j] = nq[j]; ck[j] = nk[j]; cv[j] = nv[j]; }
    }
    ((float*)(ws + WS_ML + ML_DN))[(size_t)cu * 64 + lane] = dn;
    LDS_FENCE();
    const int r = lane & 15, q = lane >> 4;
    bf16_t* DL = (bf16_t*)(ws + WS_ML + ML_DELTA) + (size_t)cu * 4096;
#pragma unroll
    for (int mb = 0; mb < 4; ++mb) {
        f32x4 acc[4];
#pragma unroll
        for (int nb = 0; nb < 4; ++nb) acc[nb] = (f32x4){0.f, 0.f, 0.f, 0.f};
#pragma unroll
        for (int ks = 0; ks < 2; ++ks) {
            const bf16x8 a = *(const LAS bf16x8*)(wl + 8192 + swz_off(16 * mb + r, 4 * ks + q));
#pragma unroll
            for (int nb = 0; nb < 4; ++nb) { const bf16x8 bb = *(const LAS bf16x8*)(wl + swz_off(16 * nb + r, 4 * ks + q)); acc[nb] = MFMA16(a, bb, acc[nb]); }
        }
#pragma unroll
        for (int nb = 0; nb < 4; ++nb)
#pragma unroll
            for (int j = 0; j < 4; ++j) DL[(16 * mb + 4 * q + j) * 64 + 16 * nb + r] = f2bf(acc[nb][j]);
    }
    LDS_FENCE();
}

#ifndef TIME_PH
#define TIME_PH -1
#endif
#define PSTAMP(i, blk) do { if (TIME_PH != -1 && l == 0 && blockIdx.x == (blk) && TIDX == 0) ((unsigned long long*)((unsigned*)(ws + WS_CTL) + CW_TS))[i] = __builtin_amdgcn_s_memrealtime(); } while (0)
__device__ __forceinline__ void phase_prep(int l, InPtr in, unsigned char* ws, LAS unsigned char* lds, int bid, int nb, int g_wv, unsigned* dq) {
    asm volatile("" : "+s"(bid));
    PSTAMP(40, 0);
#ifndef NO_UQ
    { g8::DenseSched S{(const char*)(ws + WS_PRJ + PRJ_DQKV), (const char*)(ws + WS_WUQ) + (size_t)l * 768 * 256 * 2, 384, 256, 64, 3, nb, bid};
      EpiUq E{(const float*)(ws + WS_SSQ + PT_DQ) + (size_t)l * 16384 * 4, in->p[19] + l * 192, (const float*)(ws + WS_ROPE), (bf16_t*)(ws + WS_MLA)};
      g8::gemm_run(lds, 256, 256, S, E, g_wv); }
#endif
    PSTAMP(41, 0);
#ifndef NO_UKV
    asm volatile("" : "+s"(bid));
    { g8::DenseSched S{(const char*)(ws + WS_PRJ + PRJ_DQKV) + 256, (const char*)(ws + WS_WUKV) + (size_t)l * 768 * 256 * 2, 384, 256, 64, 3, nb, bid};
      EpiUkv E{(const float*)(ws + WS_SSQ + PT_DKV) + (size_t)l * 16384 * 2, in->p[19] + l * 192, (const bf16_t*)(ws + WS_PRJ + PRJ_KR), (bf16_t*)(ws + WS_MLA + MLA_KM), (bf16_t*)(ws + WS_MLA + MLA_VM)};
      g8::gemm_run(lds, 256, 256, S, E, g_wv); }
#endif
    PSTAMP(42, 0); PSTAMP(44, 255);
    __syncthreads();
#ifndef NO_CMP
    for (int u = nb - 1 - bid; u < 32; u += nb) cmp_unit(u, l, in, ws, lds, g_wv);
#endif
    PSTAMP(45, 255);
    __syncthreads();
#ifndef NO_DELTA
    { int tid_ = TIDX; asm volatile("" : "+v"(tid_)); LAS int* slot = (LAS int*)(lds + LDS_MISC + 64);
      for (;;) {
          __syncthreads();
          if (tid_ == 0) *slot = (int)__hip_atomic_fetch_add(dq, 1u, __ATOMIC_RELAXED, __HIP_MEMORY_SCOPE_AGENT);
          __syncthreads();
          const int g = *slot; if (g >= 128) break;
          ml_delta_wave(g * 8 + (tid_ >> 6), l, in, ws, lds + (tid_ >> 6) * 16384, tid_ & 63);
      } }
#endif
    __syncthreads(); PSTAMP(43, 0);
}
#define CHK_TOL(st) (((st) & 15) == 8 ? 1e-2f : 1e-3f)
#define CHECK_REST
constexpr int VTP = 192;
typedef short v4i16_t __attribute__((ext_vector_type(4)));
__device__ __forceinline__ int vt_lane_off(int lane) { return (4 * (lane >> 5) + ((lane & 15) >> 2)) * VTP + ((((lane >> 4) & 1) * 16) + 4 * (lane & 3)) * 2; }
__device__ __forceinline__ bf16x8 vt_frag(const LAS unsigned char* Vt, int voff, int s4, int eb) {
    const LAS unsigned char* a = Vt + voff + 16 * s4 * VTP + 64 * eb;
    const v4i16_t lo = __builtin_amdgcn_ds_read_tr16_b64_v4i16((LAS v4i16_t*)a), hi = __builtin_amdgcn_ds_read_tr16_b64_v4i16((LAS v4i16_t*)(a + 8 * VTP));
    return (bf16x8){lo[0], lo[1], lo[2], lo[3], hi[0], hi[1], hi[2], hi[3]};
}
__device__ __forceinline__ int crow(int reg, int h) { return (reg & 3) + 8 * (reg >> 2) + 4 * h; }
struct AttnState { f32x16 o[2]; float m, l; };
__device__ __forceinline__ void attn_reset(AttnState& A) { A.m = -1e30f; A.l = 0.f;
#pragma unroll
    for (int i = 0; i < 16; ++i) { A.o[0][i] = 0.f; A.o[1][i] = 0.f; } }

template <int DK>
__device__ __forceinline__ void attn_scores(f32x16 (&s)[2], const bf16x8 (&qf)[DK / 16], const LAS unsigned char* Kt, int r, int h) {
    constexpr int KP = 2 * DK + 16, NK = DK / 16;
    bf16x8 kf[2][NK];
#pragma unroll
    for (int kb = 0; kb < 2; ++kb)
#pragma unroll
        for (int ks = 0; ks < NK; ++ks) kf[kb][ks] = *(const LAS bf16x8*)(Kt + (32 * kb + r) * KP + (16 * ks + 8 * h) * 2);
    __builtin_amdgcn_sched_barrier(0);
#pragma unroll
    for (int kb = 0; kb < 2; ++kb) {
#pragma unroll
        for (int i = 0; i < 16; ++i) s[kb][i] = 0.f;
#pragma unroll
        for (int ks = 0; ks < NK; ++ks) s[kb] = MFMA32(kf[kb][ks], qf[ks], s[kb]);
    }
}
__device__ __forceinline__ float max3f(float a, float b, float c) { return fmaxf(fmaxf(a, b), c); }
__device__ __forceinline__ void attn_softmax_pv(AttnState& A, f32x16 (&s)[2], const LAS unsigned char* Vt, int r, int h, float bias_c = 0.f, bool lane_ok = true) {
    constexpr float THR = 8.f; const int voff = vt_lane_off(r + 32 * h);
    float mx = max3f(s[0][0], s[0][1], s[0][2]);
#pragma unroll
    for (int i = 3; i < 15; i += 2) mx = max3f(mx, s[0][i], s[0][i + 1]);
    mx = max3f(mx, s[0][15], s[1][0]);
#pragma unroll
    for (int i = 1; i < 15; i += 2) mx = max3f(mx, s[1][i], s[1][i + 1]);
    mx = fmaxf(mx, s[1][15]);
    mx = fmaxf(mx, __shfl_xor(mx, 32));
    const float mxb = (lane_ok && mx > -1e29f) ? mx + bias_c : -1e30f;
    const bool grow = mxb > A.m + THR;
    const float mnew = grow ? mxb : A.m;
    if (__any(grow)) {
        const float alpha = __builtin_amdgcn_exp2f(A.m - mnew);
        A.l *= alpha;
#pragma unroll
        for (int i = 0; i < 16; ++i) { A.o[0][i] *= alpha; A.o[1][i] *= alpha; }
    }
    A.m = mnew;
    const float sub = (lane_ok && mnew > -1e29f) ? mnew - bias_c : 1e30f;
    float rs = 0.f;
#pragma unroll
    for (int kb = 0; kb < 2; ++kb)
#pragma unroll
        for (int i = 0; i < 16; ++i) { const float p = __builtin_amdgcn_exp2f(s[kb][i] - sub); s[kb][i] = p; rs += p; }
    rs += __shfl_xor(rs, 32);
    A.l += rs;
    bf16x8 vf[4][2];
#pragma unroll
    for (int s4 = 0; s4 < 4; ++s4)
#pragma unroll
        for (int eb = 0; eb < 2; ++eb) vf[s4][eb] = vt_frag(Vt, voff, s4, eb);
    __builtin_amdgcn_sched_barrier(0);
#pragma unroll
    for (int s4 = 0; s4 < 4; ++s4) {
        const int kb = s4 >> 1, hf = (s4 & 1) * 8;
        u32x4 pw; pw.x = pk_bf16(s[kb][hf + 0], s[kb][hf + 1]); pw.y = pk_bf16(s[kb][hf + 2], s[kb][hf + 3]); pw.z = pk_bf16(s[kb][hf + 4], s[kb][hf + 5]); pw.w = pk_bf16(s[kb][hf + 6], s[kb][hf + 7]);
        const bf16x8 pf = __builtin_bit_cast(bf16x8, pw);
#pragma unroll
        for (int eb = 0; eb < 2; ++eb) A.o[eb] = MFMA32(vf[s4][eb], pf, A.o[eb]);
    }
}
template <int DK>
__device__ __forceinline__ void stage_k_load(u32x4 (&kr)[2], const bf16_t* Kg  , int tid) {
    constexpr int CH = DK / 8;
    kr[0] = *(const u32x4*)(Kg + (size_t)(tid / CH) * DK + (tid % CH) * 8);
    if (64 * CH > 512) { const int c2 = tid + 512; if (c2 < 64 * CH) kr[1] = *(const u32x4*)(Kg + (size_t)(c2 / CH) * DK + (c2 % CH) * 8); }
}
template <int DK>
__device__ __forceinline__ void stage_k_store(const u32x4 (&kr)[2], LAS unsigned char* Kt, int tid) {
    constexpr int CH = DK / 8, KP = 2 * DK + 16;
    *(LAS u32x4*)(Kt + (tid / CH) * KP + (tid % CH) * 16) = kr[0];
    if (64 * CH > 512) { const int c2 = tid + 512; if (c2 < 64 * CH) *(LAS u32x4*)(Kt + (c2 / CH) * KP + (c2 % CH) * 16) = kr[1]; }
}
__device__ __forceinline__ u32x4 stage_v_load(const bf16_t* Vg, int tid) { return *(const u32x4*)(Vg + (size_t)(tid >> 3) * 64 + (tid & 7) * 8); }
__device__ __forceinline__ void stage_v_store(const u32x4& v, LAS unsigned char* Vt, int tid) { *(LAS u32x4*)(Vt + (tid >> 3) * VTP + (tid & 7) * 16) = v; }

constexpr int MLA_KT = 0, MLA_VT = 2 * 64 * 208, MLA_LDS = MLA_VT + 2 * 64 * VTP;
__device__ __forceinline__ void mla_unit(int b, int hd, int qt, int l, unsigned char* ws, LAS unsigned char* lds, int g_wv) {
    int tid_ = TIDX; asm volatile("" : "+v"(tid_));
    const int tid = tid_, w = tid >> 6, lane = tid & 63, r = lane & 31, h = lane >> 5;
    const size_t slab = (size_t)(b * 6 + hd) * 2048;
    const bf16_t* QM = (const bf16_t*)(ws + WS_MLA) + slab * 96; const bf16_t* KM = (const bf16_t*)(ws + WS_MLA + MLA_KM) + slab * 96; const bf16_t* VM = (const bf16_t*)(ws + WS_MLA + MLA_VM) + slab * 64;
    const int q0 = 256 * qt + 32 * w, q = q0 + r;
    bf16x8 qf[6];
#pragma unroll
    for (int ks = 0; ks < 6; ++ks) qf[ks] = *(const bf16x8*)(QM + (size_t)q * 96 + 16 * ks + 8 * h);
    AttnState A; attn_reset(A);
    const int ntile = 4 * qt + 4;
    u32x4 kr[2], vr, kr2[2], vr2;
    stage_k_load<96>(kr, KM, tid); vr = stage_v_load(VM, tid);
    stage_k_store<96>(kr, lds + MLA_KT, tid); stage_v_store(vr, lds + MLA_VT, tid);
    if (ntile > 1) { stage_k_load<96>(kr, KM + (size_t)64 * 96, tid); vr = stage_v_load(VM + (size_t)64 * 64, tid); }
    __syncthreads();
    for (int j = 0; j < ntile; ++j) {
        const int cur = j & 1;
        if (j + 2 < ntile) { stage_k_load<96>(kr2, KM + (size_t)(j + 2) * 64 * 96, tid); vr2 = stage_v_load(VM + (size_t)(j + 2) * 64 * 64, tid); }
        if (64 * j <= q0 + 31) {
            f32x16 s[2];
            attn_scores<96>(s, qf, lds + MLA_KT + cur * 64 * 208, r, h);
            if (64 * j + 63 > q0) {
#pragma unroll
                for (int kb = 0; kb < 2; ++kb)
#pragma unroll
                    for (int i = 0; i < 16; ++i) { const int key = 64 * j + 32 * kb + crow(i, h); if (key > q) s[kb][i] = -1e30f; }
            }
            attn_softmax_pv(A, s, lds + MLA_VT + cur * 64 * VTP, r, h);
        }
        if (j + 1 < ntile) { stage_k_store<96>(kr, lds + MLA_KT + (cur ^ 1) * 64 * 208, tid); stage_v_store(vr, lds + MLA_VT + (cur ^ 1) * 64 * VTP, tid); }
        kr[0] = kr2[0]; kr[1] = kr2[1]; vr = vr2;
        __syncthreads();
    }
    const float inv = A.l > 0.f ? 1.f / A.l : 0.f; float ss = 0.f;
    bf16_t* Y = (bf16_t*)(ws + WS_Y) + ((size_t)b * 2048 + q) * 1024 + 384 + hd * 64;
#pragma unroll
    for (int eb = 0; eb < 2; ++eb)
#pragma unroll
        for (int g4 = 0; g4 < 4; ++g4) {
            const float v0 = A.o[eb][4 * g4] * inv, v1 = A.o[eb][4 * g4 + 1] * inv, v2 = A.o[eb][4 * g4 + 2] * inv, v3 = A.o[eb][4 * g4 + 3] * inv;
            u32x2 pw; pw.x = pk_bf16(v0, v1); pw.y = pk_bf16(v2, v3);
            const float f0 = bf_lo(pw.x), f1 = bf_hi(pw.x), f2 = bf_lo(pw.y), f3 = bf_hi(pw.y); ss += (f0 * f0 + f1 * f1) + (f2 * f2 + f3 * f3);
            *(u32x2*)(Y + 32 * eb + 8 * g4 + 4 * h) = pw;
        }
    ss += __shfl_xor(ss, 32);
    if (h == 0) ((float*)(ws + WS_SSQ + PT_C))[((size_t)l * 16384 + (size_t)b * 2048 + q) * 8 + hd] = ss;
}

__device__ __forceinline__ void nsa_bias32(float (&bv)[2][16], const LAS float* bl, int dd) {
#pragma unroll
    for (int kb = 0; kb < 2; ++kb)
#pragma unroll
        for (int k = 0; k < 16; ++k) { const int c = 63 - (32 * kb + (k & 3) + 8 * (k >> 2)); int d = dd + c; d = d < 0 ? 0 : (d > 255 ? 255 : d); bv[kb][k] = bl[d]; }
}
__device__ __forceinline__ void nsa_mask_bias(f32x16 (&sc)[2], int dq, int h, const LAS float* bl, bool sel, int lim) {
    int dd = dq - 4 * h - 63; asm volatile("" : "+v"(dd));
    float bv[2][16]; nsa_bias32(bv, bl, dd);
#pragma unroll
    for (int kb = 0; kb < 2; ++kb)
#pragma unroll
        for (int k = 0; k < 16; ++k) { const int c = 63 - (32 * kb + (k & 3) + 8 * (k >> 2)); const int d = dd + c; sc[kb][k] = (sel && d >= 0 && d < lim) ? sc[kb][k] + bv[kb][k] : -1e30f; }
}

constexpr int NSA_KT = 0, NSA_VT = 2 * 64 * 144, NSA_BIAS = NSA_VT + 2 * 64 * VTP, NSA_PS = NSA_BIAS + 3 * 256 * 4, NSA_SEL = NSA_PS + 3 * 64 * 32 * 4, NSA_UNI = NSA_SEL + 256, NSA_OT = NSA_UNI + 256, NSA_LDS = NSA_OT + 6 * 8192;
__device__ __forceinline__ void nsa_unit(int b, int hk, int i, int l, InPtr in, unsigned char* ws, LAS unsigned char* lds, int g_wv) {
    int tid_ = TIDX; asm volatile("" : "+v"(tid_));
    const int tid = tid_, w = tid >> 6, lane = tid & 63, r = lane & 31, h = lane >> 5;
    const bool active = w < 6; const int g = active ? (w >> 1) : 0, th = w & 1, head = hk * 3 + g;
    const int t = 64 * i + 32 * th + r, tl = 32 * th + r; const size_t row = (size_t)b * 2048 + t;
    const size_t kvslab = (size_t)(b * 2 + hk) * 2048 * 64;
    LAS float* biasl = (LAS float*)(lds + NSA_BIAS); LAS float* PS = (LAS float*)(lds + NSA_PS); LAS unsigned* SEL = (LAS unsigned*)(lds + NSA_SEL); LAS unsigned* UNI = (LAS unsigned*)(lds + NSA_UNI);
    { const float* bd = (const float*)(ws + WS_BIASD) + (size_t)hk * 3 * 2048;
      if (tid < 384) { const int gg = tid >> 7, d0 = (tid & 127) * 2; biasl[gg * 256 + d0] = bd[gg * 2048 + d0]; biasl[gg * 256 + d0 + 1] = bd[gg * 2048 + d0 + 1]; }
#pragma unroll
      for (int k = 0; k < 12; ++k) if (i >= 16) PS[tid + 512 * k] = 0.f;
      if (tid < 4) UNI[tid] = 0u; }
    bf16x8 qf[4];
    { const bf16_t* QN = (const bf16_t*)(ws + WS_PRJ + PRJ_QN) + ((size_t)(b * 6 + head) * 2048 + t) * 64;
#pragma unroll
      for (int ks = 0; ks < 4; ++ks) qf[ks] = *(const bf16x8*)(QN + 16 * ks + 8 * h); }
#define NSA_GATE(k) ({ int t_ = t; asm volatile("" : "+v"(t_)); sigmf(((const float*)(ws + WS_PRJ + PRJ_GATES))[((size_t)b * 2048 + t_) * 32 + head * 3 + (k)]); })
    LAS float* bl = biasl + g * 256;
    LAS float* otl = (LAS float*)(lds + NSA_OT + (active ? w : 0) * 8192) + lane;
    u32x4 kr[2], vr;
    const int ntc = i >= 16 ? 2 : 1;
    { const bf16_t* KC = (const bf16_t*)(ws + WS_CMP) + (size_t)(b * 2 + hk) * 128 * 64; const bf16_t* VC = (const bf16_t*)(ws + WS_CMP + CMP_V) + (size_t)(b * 2 + hk) * 128 * 64;
      for (int T = 0; T < ntc; ++T) { stage_k_load<64>(kr, KC + T * 4096, tid); vr = stage_v_load(VC + T * 4096, tid); stage_k_store<64>(kr, lds + NSA_KT + T * 64 * 144, tid); stage_v_store(vr, lds + NSA_VT + T * 64 * VTP, tid); } }
    __syncthreads();
    {
        f32x16 ot[2];
        if (active && i < 16) {
            AttnState A; attn_reset(A); f32x16 sc[2]; attn_scores<64>(sc, qf, lds + NSA_KT, r, h);
            float bvc[2][16];
#pragma unroll
            for (int kb = 0; kb < 2; ++kb)
#pragma unroll
                for (int k = 0; k < 16; ++k) { int d = t - 16 * (32 * kb + crow(k, h)) - 31; d = d < 0 ? 0 : (d > 255 ? 255 : d); bvc[kb][k] = bl[d]; }
#pragma unroll
            for (int kb = 0; kb < 2; ++kb)
#pragma unroll
                for (int k = 0; k < 16; ++k) { const int d = t - 16 * (32 * kb + crow(k, h)) - 31; sc[kb][k] = d >= 0 ? sc[kb][k] + bvc[kb][k] : -1e30f; }
            attn_softmax_pv(A, sc, lds + NSA_VT, r, h);
            const float gc = NSA_GATE(0); const float inv = A.l > 0.f ? gc / A.l : 0.f;
#pragma unroll
            for (int k = 0; k < 16; ++k) { otl[64 * k] = A.o[0][k] * inv; otl[64 * (16 + k)] = A.o[1][k] * inv; }
        } else if (active) {
            float m = -1e30f, lsum = 0.f;
            for (int T = 0; T < ntc; ++T) {
                f32x16 sc[2]; attn_scores<64>(sc, qf, lds + NSA_KT + T * 64 * 144, r, h);
                float bvc[2][16];
#pragma unroll
                for (int kb = 0; kb < 2; ++kb)
#pragma unroll
                    for (int k = 0; k < 16; ++k) { int d = t - 16 * (64 * T + 32 * kb + crow(k, h)) - 31; d = d < 0 ? 0 : (d > 255 ? 255 : d); bvc[kb][k] = bl[d]; }
                float mx = -1e30f;
#pragma unroll
                for (int kb = 0; kb < 2; ++kb)
#pragma unroll
                    for (int k = 0; k < 16; ++k) { const int n = 64 * T + 32 * kb + crow(k, h); const int d = t - 16 * n - 31; const float x = (d >= 0 && n < 127) ? sc[kb][k] + bvc[kb][k] : -1e30f; sc[kb][k] = x; mx = fmaxf(mx, x); }
                mx = fmaxf(mx, __shfl_xor(mx, 32));
                const float mnew = fmaxf(m, mx), mref = mnew <= -1e29f ? 0.f : mnew; float rs = 0.f;
#pragma unroll
                for (int kb = 0; kb < 2; ++kb)
#pragma unroll
                    for (int k = 0; k < 16; ++k) rs += __builtin_amdgcn_exp2f(sc[kb][k] - mref);
                rs += __shfl_xor(rs, 32);
                lsum = lsum * __builtin_amdgcn_exp2f(m - mref) + rs; m = mnew;
            }
            const float mref = m <= -1e29f ? 0.f : m, inv = lsum > 0.f ? 1.f / lsum : 0.f;
#pragma unroll
            for (int k = 0; k < 16; ++k) { ot[0][k] = 0.f; ot[1][k] = 0.f; }
            float carry = 0.f;
            for (int T = 0; T < ntc; ++T) {
                f32x16 sc[2]; attn_scores<64>(sc, qf, lds + NSA_KT + T * 64 * 144, r, h);
                float bvc[2][16];
#pragma unroll
                for (int kb = 0; kb < 2; ++kb)
#pragma unroll
                    for (int k = 0; k < 16; ++k) { int d = t - 16 * (64 * T + 32 * kb + crow(k, h)) - 31; d = d < 0 ? 0 : (d > 255 ? 255 : d); bvc[kb][k] = bl[d]; }
#pragma unroll
                for (int kb = 0; kb < 2; ++kb)
#pragma unroll
                    for (int k = 0; k < 16; ++k) { const int n = 64 * T + 32 * kb + crow(k, h); const int d = t - 16 * n - 31; sc[kb][k] = (d >= 0 && n < 127) ? __builtin_amdgcn_exp2f(sc[kb][k] + bvc[kb][k] - mref) * inv : 0.f; }
                float prevL = carry;
#pragma unroll
                for (int kb = 0; kb < 2; ++kb)
#pragma unroll
                    for (int g4 = 0; g4 < 4; ++g4) {
                        const float G4 = (sc[kb][4 * g4] + sc[kb][4 * g4 + 1]) + (sc[kb][4 * g4 + 2] + sc[kb][4 * g4 + 3]); const float L = sc[kb][4 * g4 + 3];
                        const float Lo = __shfl_xor(L, 32);
                        const float add = h ? Lo : prevL;
                        prevL = Lo;
                        const int idx = T * 8 + kb * 4 + g4;
                        PS[g * 2048 + tl * 32 + 2 * idx + h] = G4 + add;
                    }
                carry = prevL;
#pragma unroll
                for (int s4 = 0; s4 < 4; ++s4) {
                    const int kb = s4 >> 1, hf = (s4 & 1) * 8;
                    u32x4 pw; pw.x = pk_bf16(sc[kb][hf + 0], sc[kb][hf + 1]); pw.y = pk_bf16(sc[kb][hf + 2], sc[kb][hf + 3]); pw.z = pk_bf16(sc[kb][hf + 4], sc[kb][hf + 5]); pw.w = pk_bf16(sc[kb][hf + 6], sc[kb][hf + 7]);
                    const bf16x8 pf = __builtin_bit_cast(bf16x8, pw);
#pragma unroll
                    for (int eb = 0; eb < 2; ++eb) ot[eb] = MFMA32(vt_frag(lds + NSA_VT + T * 64 * VTP, vt_lane_off(lane), s4, eb), pf, ot[eb]);
                }
            }
            { const float gc = NSA_GATE(0);
#pragma unroll
            for (int k = 0; k < 16; ++k) { otl[64 * k] = ot[0][k] * gc; otl[64 * (16 + k)] = ot[1][k] * gc; } }
        }
    }
    __syncthreads();
#ifndef NO_NSA_SEL
    if (i < 16) { if (tid < 64) SEL[tid] = (2u << i) - 1u; if (tid < 3) UNI[tid] = (2u << i) - 1u; }
    else {
        const int tk = tid >> 3, sg = tid & 7; float v[32];
#pragma unroll
        for (int k = 0; k < 8; ++k) { const f32x4 x0 = *(const LAS f32x4*)(PS + tk * 32 + 4 * k), x1 = *(const LAS f32x4*)(PS + 2048 + tk * 32 + 4 * k), x2 = *(const LAS f32x4*)(PS + 4096 + tk * 32 + 4 * k);
            v[4 * k] = (x0.x + x1.x) + x2.x; v[4 * k + 1] = (x0.y + x1.y) + x2.y; v[4 * k + 2] = (x0.z + x1.z) + x2.z; v[4 * k + 3] = (x0.w + x1.w) + x2.w; }
#pragma unroll
        for (int s = 0; s < 32; ++s) { const bool forced = (s == 0) || (s == i) || (s == i - 1); float x = forced ? v[s] + 1e4f : v[s]; v[s] = s > i ? -1.f : x; }
        unsigned bits = 0u;
#pragma unroll
        for (int k = 0; k < 4; ++k) {
            float x = 0.f;
#pragma unroll
            for (int s = 0; s < 32; ++s) x = (s == 4 * sg + k) ? v[s] : x;
            int rank = 0;
#pragma unroll
            for (int s = 0; s < 32; ++s) rank += (v[s] > x || (v[s] == x && s < 4 * sg + k)) ? 1 : 0;
            if (rank < 16 && x >= 0.f) bits |= 1u << (4 * sg + k);
        }
        bits |= __shfl_xor(bits, 1); bits |= __shfl_xor(bits, 2); bits |= __shfl_xor(bits, 4);
        if (sg == 0) { SEL[tk] = bits; __hip_atomic_fetch_or(UNI, bits, __ATOMIC_RELAXED, __HIP_MEMORY_SCOPE_WORKGROUP); __hip_atomic_fetch_or(UNI + 1 + (tk >> 5), bits, __ATOMIC_RELAXED, __HIP_MEMORY_SCOPE_WORKGROUP); }
    }
#endif
    __syncthreads();
    const unsigned selbits = SEL[tl], uni = UNI[0], unih = UNI[1 + th];
    const float c31 = bl[255];
#ifndef NO_NSA_SLC
#ifndef NSA_DUP_SLC
#define NSA_DUP_SLC 1
#endif
    for (int rp_ = 0; rp_ < NSA_DUP_SLC; ++rp_) {
        AttnState A; attn_reset(A);
        const bf16_t* KS = (const bf16_t*)(ws + WS_PRJ + PRJ_KN1) + kvslab; const bf16_t* VS = (const bf16_t*)(ws + WS_PRJ + PRJ_VN1) + kvslab;
        unsigned todo = uni; int cur = 0; u32x4 kr2[2], vr2;
        int s = __ffs(todo) - 1; todo &= todo - 1;
        stage_k_load<64>(kr, KS + (size_t)s * 4096, tid); vr = stage_v_load(VS + (size_t)s * 4096, tid);
        stage_k_store<64>(kr, lds + NSA_KT, tid); stage_v_store(vr, lds + NSA_VT, tid);
        int sn = todo ? __ffs(todo) - 1 : -1; todo &= todo - 1;
        if (sn >= 0) { stage_k_load<64>(kr, KS + (size_t)sn * 4096, tid); vr = stage_v_load(VS + (size_t)sn * 4096, tid); }
        __syncthreads();
        while (s >= 0) {
            const int sn2 = todo ? __ffs(todo) - 1 : -1; todo &= todo - 1;
            if (sn2 >= 0) { stage_k_load<64>(kr2, KS + (size_t)sn2 * 4096, tid); vr2 = stage_v_load(VS + (size_t)sn2 * 4096, tid); }
            if (active && ((unih >> s) & 1u)) {
                f32x16 sc[2];
                attn_scores<64>(sc, qf, lds + NSA_KT + cur * 64 * 144, r, h);
                const bool sel = (selbits >> s) & 1u;
                if (i - s >= 3) attn_softmax_pv(A, sc, lds + NSA_VT + cur * 64 * VTP, r, h, c31, sel);
                else { nsa_mask_bias(sc, t - 64 * s, h, bl, sel, 4096); attn_softmax_pv(A, sc, lds + NSA_VT + cur * 64 * VTP, r, h); }
            }
            if (sn >= 0) { stage_k_store<64>(kr, lds + NSA_KT + (cur ^ 1) * 64 * 144, tid); stage_v_store(vr, lds + NSA_VT + (cur ^ 1) * 64 * VTP, tid); }
            kr[0] = kr2[0]; vr = vr2;
            __syncthreads();
            s = sn; sn = sn2; cur ^= 1;
        }
        if (active && rp_ == NSA_DUP_SLC - 1) { const float gs = NSA_GATE(1); const float inv = A.l > 0.f ? gs / A.l : 0.f;
#pragma unroll
            for (int k = 0; k < 16; ++k) { otl[64 * k] += A.o[0][k] * inv; otl[64 * (16 + k)] += A.o[1][k] * inv; } }
    }
#endif
#ifndef NO_NSA_WIN
#ifndef NSA_DUP_WIN
#define NSA_DUP_WIN 1
#endif
    for (int rq_ = 0; rq_ < NSA_DUP_WIN; ++rq_) {
        AttnState A; attn_reset(A);
        const bf16_t* KW = (const bf16_t*)(ws + WS_PRJ + PRJ_KN2) + kvslab; const bf16_t* VW = (const bf16_t*)(ws + WS_PRJ + PRJ_VN2) + kvslab;
        const int j0 = i > 8 ? i - 8 : 0; int cur = 0; u32x4 kr2[2], vr2;
        stage_k_load<64>(kr, KW + (size_t)j0 * 4096, tid); vr = stage_v_load(VW + (size_t)j0 * 4096, tid);
        stage_k_store<64>(kr, lds + NSA_KT, tid); stage_v_store(vr, lds + NSA_VT, tid);
        if (j0 < i) { stage_k_load<64>(kr, KW + (size_t)(j0 + 1) * 4096, tid); vr = stage_v_load(VW + (size_t)(j0 + 1) * 4096, tid); }
        __syncthreads();
        for (int j = j0; j <= i; ++j) {
            if (j + 2 <= i) { stage_k_load<64>(kr2, KW + (size_t)(j + 2) * 4096, tid); vr2 = stage_v_load(VW + (size_t)(j + 2) * 4096, tid); }
            if (active) {
                f32x16 sc[2];
                attn_scores<64>(sc, qf, lds + NSA_KT + cur * 64 * 144, r, h);
                if (i - j >= 3 && j > i - 8) attn_softmax_pv(A, sc, lds + NSA_VT + cur * 64 * VTP, r, h, c31, true);
                else { nsa_mask_bias(sc, t - 64 * j, h, bl, true, 512); attn_softmax_pv(A, sc, lds + NSA_VT + cur * 64 * VTP, r, h); }
            }
            if (j < i) { stage_k_store<64>(kr, lds + NSA_KT + (cur ^ 1) * 64 * 144, tid); stage_v_store(vr, lds + NSA_VT + (cur ^ 1) * 64 * VTP, tid); }
            kr[0] = kr2[0]; vr = vr2;
            __syncthreads();
            cur ^= 1;
        }
        if (active && rq_ == NSA_DUP_WIN - 1) { const float gw = NSA_GATE(2); const float inv = A.l > 0.f ? gw / A.l : 0.f;
            float ss = 0.f; bf16_t* Y = (bf16_t*)(ws + WS_Y) + row * 1024 + head * 64;
#pragma unroll
            for (int eb = 0; eb < 2; ++eb)
#pragma unroll
                for (int g4 = 0; g4 < 4; ++g4) {
                    const float v0 = otl[64 * (16 * eb + 4 * g4)] + A.o[eb][4 * g4] * inv, v1 = otl[64 * (16 * eb + 4 * g4 + 1)] + A.o[eb][4 * g4 + 1] * inv;
                    const float v2 = otl[64 * (16 * eb + 4 * g4 + 2)] + A.o[eb][4 * g4 + 2] * inv, v3 = otl[64 * (16 * eb + 4 * g4 + 3)] + A.o[eb][4 * g4 + 3] * inv;
                    u32x2 pw; pw.x = pk_bf16(v0, v1); pw.y = pk_bf16(v2, v3);
                    const float f0 = bf_lo(pw.x), f1 = bf_hi(pw.x), f2 = bf_lo(pw.y), f3 = bf_hi(pw.y); ss += (f0 * f0 + f1 * f1) + (f2 * f2 + f3 * f3);
                    *(u32x2*)(Y + 32 * eb + 8 * g4 + 4 * h) = pw;
                }
            ss += __shfl_xor(ss, 32);
            if (h == 0) ((float*)(ws + WS_SSQ + PT_A))[((size_t)l * 16384 + row) * 8 + head] = ss;
        }
    }
#endif
}

__device__ __forceinline__ void ml_out_wave(int cu, int l, InPtr in, unsigned char* ws, LAS unsigned char* wl, LAS unsigned char* npl, int lane) {
    const int c = cu & 31, bh = cu >> 5, hd = bh & 3, b = bh >> 2; const int t0 = c * 64; const int r = lane & 15, q = lane >> 4;
    const bf16_t* QC = (const bf16_t*)(ws + WS_ML) + ((size_t)bh * 2048 + t0) * 64; const bf16_t* KC = (const bf16_t*)(ws + WS_ML + ML_KC) + ((size_t)bh * 2048 + t0) * 64;
    const bf16_t* V = (const bf16_t*)(ws + WS_PRJ + PRJ_VML) + ((size_t)bh * 2048 + t0) * 64;
    const float* mlg = (const float*)(ws + WS_ML + ML_G) + ((size_t)bh * 2048 + t0) * 2;
    const bf16_t* CP = (const bf16_t*)(ws + WS_ML + ML_CP) + (size_t)cu * 4096; const bf16_t* NP = (const bf16_t*)(ws + WS_ML + ML_NP) + (size_t)cu * 64;
    bf16x8 aq[4][2];
#pragma unroll
    for (int mb = 0; mb < 4; ++mb)
#pragma unroll
        for (int ks = 0; ks < 2; ++ks) aq[mb][ks] = *(const bf16x8*)(QC + (size_t)(16 * mb + r) * 64 + 32 * ks + 8 * q);
    float bj[4][4], den[4][4];
#pragma unroll
    for (int mb = 0; mb < 4; ++mb)
#pragma unroll
        for (int j = 0; j < 4; ++j) bj[mb][j] = mlg[(16 * mb + 4 * q + j) * 2];
    {
        float cs[4];
#pragma unroll
        for (int nb = 0; nb < 4; ++nb) { const float2 gg = *(const float2*)(mlg + (16 * nb + r) * 2); cs[nb] = gg.y - gg.x; }
#pragma unroll
        for (int mb = 0; mb < 4; ++mb) {
            f32x4 accS[4];
#pragma unroll
            for (int nb = 0; nb < 4; ++nb) { accS[nb] = (f32x4){0.f, 0.f, 0.f, 0.f};
#pragma unroll
                for (int ks = 0; ks < 2; ++ks) { const bf16x8 bk = *(const bf16x8*)(KC + (size_t)(16 * nb + r) * 64 + 32 * ks + 8 * q); accS[nb] = MFMA16(aq[mb][ks], bk, accS[nb]); } }
#pragma unroll
            for (int j = 0; j < 4; ++j) {
                const int jj = 16 * mb + 4 * q + j; float rs = 0.f;
#pragma unroll
                for (int nb = 0; nb < 4; ++nb) { const int s = 16 * nb + r; const float p = s <= jj ? accS[nb][j] * __expf(bj[mb][j] + cs[nb]) : 0.f; rs += p;
                    *(LAS bf16_t*)(wl + 8192 + swz_off(jj, s >> 3) + (s & 7) * 2) = f2bf(p); }
                rs += __shfl_xor(rs, 1); rs += __shfl_xor(rs, 2); rs += __shfl_xor(rs, 4); rs += __shfl_xor(rs, 8);
                den[mb][j] = rs;
            }
        }
    }
#pragma unroll
    for (int mb = 0; mb < 4; ++mb) { const float e = __expf(mlg[(16 * mb + r) * 2]);
#pragma unroll
        for (int ks = 0; ks < 2; ++ks) { const u32x4 x = __builtin_bit_cast(u32x4, aq[mb][ks]); u32x4 y;
            y.x = pk_bf16(bf_lo(x.x) * e, bf_hi(x.x) * e); y.y = pk_bf16(bf_lo(x.y) * e, bf_hi(x.y) * e); y.z = pk_bf16(bf_lo(x.z) * e, bf_hi(x.z) * e); y.w = pk_bf16(bf_lo(x.w) * e, bf_hi(x.w) * e);
            aq[mb][ks] = __builtin_bit_cast(bf16x8, y); } }
    f32x4 acc[4][4], accn[4];
#pragma unroll
    for (int mb = 0; mb < 4; ++mb) { accn[mb] = (f32x4){0.f, 0.f, 0.f, 0.f};
#pragma unroll
        for (int nb = 0; nb < 4; ++nb) acc[mb][nb] = (f32x4){0.f, 0.f, 0.f, 0.f}; }
#pragma unroll
    for (int ks = 0; ks < 2; ++ks) {
        u32x4 nz = *(const u32x4*)(NP + 32 * ks + 8 * q); if (r != 0) nz = (u32x4){0u, 0u, 0u, 0u};
        const bf16x8 bn = __builtin_bit_cast(bf16x8, nz);
#pragma unroll
        for (int nb = 0; nb < 4; ++nb) { const bf16x8 bb = *(const bf16x8*)(CP + (size_t)(16 * nb + r) * 64 + 32 * ks + 8 * q);
#pragma unroll
            for (int mb = 0; mb < 4; ++mb) acc[mb][nb] = MFMA16(aq[mb][ks], bb, acc[mb][nb]); }
#pragma unroll
        for (int mb = 0; mb < 4; ++mb) accn[mb] = MFMA16(aq[mb][ks], bn, accn[mb]);
    }
#pragma unroll
    for (int s8 = 0; s8 < 8; ++s8) { float vb[8];
#pragma unroll
        for (int j = 0; j < 8; ++j) vb[j] = bf2f(V[(size_t)(s8 * 8 + j) * 64 + lane]);
        u32x4 pk; pk.x = pk_bf16(vb[0], vb[1]); pk.y = pk_bf16(vb[2], vb[3]); pk.z = pk_bf16(vb[4], vb[5]); pk.w = pk_bf16(vb[6], vb[7]);
        *(LAS u32x4*)(wl + swz_off(lane, s8)) = pk; }
    LDS_FENCE();
#pragma unroll
    for (int ks = 0; ks < 2; ++ks) {
        bf16x8 ap[4];
#pragma unroll
        for (int mb = 0; mb < 4; ++mb) ap[mb] = *(const LAS bf16x8*)(wl + 8192 + swz_off(16 * mb + r, 4 * ks + q));
#pragma unroll
        for (int nb = 0; nb < 4; ++nb) { const bf16x8 bv = *(const LAS bf16x8*)(wl + swz_off(16 * nb + r, 4 * ks + q));
#pragma unroll
            for (int mb = 0; mb < 4; ++mb) acc[mb][nb] = MFMA16(ap[mb], bv, acc[mb][nb]); }
    }
    LDS_FENCE();
    const float* gain = in->p[14] + l * 256 + hd * 64; const bf16_t* OG = (const bf16_t*)(ws + WS_PRJ + PRJ_OG);
    bf16_t* Y = (bf16_t*)(ws + WS_Y);
#pragma unroll
    for (int mb = 0; mb < 4; ++mb)
#pragma unroll
        for (int j = 0; j < 4; ++j) {
            const int jj = 16 * mb + 4 * q + j;
            const float dn = den[mb][j] + __builtin_bit_cast(float, __builtin_amdgcn_ds_bpermute((lane & 48) << 2, __builtin_bit_cast(int, accn[mb][j])));
            const float inv = 1.f / fmaxf(fabsf(dn), 1.f); float hv[4]; float ss = 0.f;
#pragma unroll
            for (int nb = 0; nb < 4; ++nb) { hv[nb] = acc[mb][nb][j] * inv; ss += hv[nb] * hv[nb]; }
            ss += __shfl_xor(ss, 1); ss += __shfl_xor(ss, 2); ss += __shfl_xor(ss, 4); ss += __shfl_xor(ss, 8);
            const float rstd = rsqrtf(ss * (1.f / 64.f) + 1e-6f); const size_t row = (size_t)b * 2048 + t0 + jj;
#pragma unroll
            for (int nb = 0; nb < 4; ++nb) { const int e = 16 * nb + r; Y[row * 1024 + 768 + hd * 64 + e] = f2bf(hv[nb] * rstd * gain[e] * sigmf(bf2f(OG[row * 256 + hd * 64 + e]))); }
        }
}

__device__ __forceinline__ void ml_scan_unit(int bh, int l, unsigned char* ws, int g_wv) {
    int tid_ = TIDX; asm volatile("" : "+v"(tid_)); const int tid = tid_;
    const bf16_t* DL = (const bf16_t*)(ws + WS_ML + ML_DELTA) + (size_t)bh * 32 * 4096 + tid * 8; bf16_t* CP = (bf16_t*)(ws + WS_ML + ML_CP) + (size_t)bh * 32 * 4096 + tid * 8;
    const float* DN = (const float*)(ws + WS_ML + ML_DN) + (size_t)bh * 32 * 64; bf16_t* NP = (bf16_t*)(ws + WS_ML + ML_NP) + (size_t)bh * 32 * 64; const float* BL = (const float*)(ws + WS_ML + ML_BL) + bh * 32;
    float c[8]; float n = 0.f;
#pragma unroll
    for (int k = 0; k < 8; ++k) c[k] = 0.f;
#pragma unroll 1
    for (int c0 = 0; c0 < 32; c0 += 8) {
        u32x4 d[8]; float dn[8], co[8];
#pragma unroll
        for (int k = 0; k < 8; ++k) { d[k] = *(const u32x4*)(DL + (size_t)(c0 + k) * 4096); dn[k] = tid < 64 ? DN[(c0 + k) * 64 + tid] : 0.f; co[k] = __expf(BL[c0 + k]); }
#pragma unroll
        for (int k = 0; k < 8; ++k) {
            u32x4 o; o.x = pk_bf16(c[0], c[1]); o.y = pk_bf16(c[2], c[3]); o.z = pk_bf16(c[4], c[5]); o.w = pk_bf16(c[6], c[7]);
            *(u32x4*)(CP + (size_t)(c0 + k) * 4096) = o; if (tid < 64) NP[(c0 + k) * 64 + tid] = f2bf(n);
            c[0] = co[k] * c[0] + bf_lo(d[k].x); c[1] = co[k] * c[1] + bf_hi(d[k].x); c[2] = co[k] * c[2] + bf_lo(d[k].y); c[3] = co[k] * c[3] + bf_hi(d[k].y);
            c[4] = co[k] * c[4] + bf_lo(d[k].z); c[5] = co[k] * c[5] + bf_hi(d[k].z); c[6] = co[k] * c[6] + bf_lo(d[k].w); c[7] = co[k] * c[7] + bf_hi(d[k].w);
            n = co[k] * n + dn[k];
        }
    }
    asm volatile("s_waitcnt vmcnt(0)" ::: "memory"); __syncthreads();
    if (tid == 0) { __builtin_amdgcn_fence(__ATOMIC_RELEASE, "agent"); asm volatile("s_waitcnt vmcnt(0)" ::: "memory");
        __hip_atomic_fetch_add((unsigned*)(ws + WS_CTL) + CW_SCAN + 64 * l, 1u, __ATOMIC_RELAXED, __HIP_MEMORY_SCOPE_AGENT); }
}
__device__ __forceinline__ void ml_scan_wait(int l, unsigned char* ws, int g_wv) {
    if (TIDX == 0) { unsigned* p = (unsigned*)(ws + WS_CTL) + CW_SCAN + 64 * l; unsigned sp = 0;
        while (__hip_atomic_load(p, __ATOMIC_RELAXED, __HIP_MEMORY_SCOPE_AGENT) < 32u) { __builtin_amdgcn_s_sleep(2); if (++sp > (1u << 22)) break; }
        __builtin_amdgcn_fence(__ATOMIC_ACQUIRE, "agent"); asm volatile("s_waitcnt vmcnt(0)" ::: "memory"); }
    __syncthreads();
}

#ifndef DUP_NSA
#define DUP_NSA 1
#endif
#ifndef DUP_MLA
#define DUP_MLA 1
#endif
#ifndef DUP_ML
#define DUP_ML 1
#endif
#ifdef NO_MLA
#define MLA_CALL(...) do {} while (0)
#else
#define MLA_CALL(...) do { for (int rp = 0; rp < DUP_MLA; ++rp) { if (rp) __syncthreads(); mla_unit(__VA_ARGS__); } } while (0)
#endif
__device__ __forceinline__ void phase_mix(int l, InPtr in, unsigned char* ws, LAS unsigned char* lds, unsigned* qhead, int g_wv) {
    LAS int* slot = (LAS int*)(lds + LDS_MISC + 64);
    for (;;) {
        __syncthreads();
        if (TIDX == 0) *slot = (int)__hip_atomic_fetch_add(qhead, 1u, __ATOMIC_RELAXED, __HIP_MEMORY_SCOPE_AGENT);
        __syncthreads();
        int u = *slot;
        if (u >= 32 + 512 + 384 + 128) break;
        if (u < 32) { ml_scan_unit(u, l, ws, g_wv); continue; } u -= 32;
#ifndef NO_NSA
        if (u < 256) { const int i = 31 - (u >> 4), bh = u & 15; { for (int rp = 0; rp < DUP_NSA; ++rp) { if (rp) __syncthreads(); nsa_unit(bh >> 1, bh & 1, i, l, in, ws, lds, g_wv); } } continue; }
#endif
        u -= 256;
        if (u < 192) { const int qt = 7 - u / 48, bh = u % 48; MLA_CALL(bh / 6, bh % 6, qt, l, ws, lds, g_wv); continue; }
        u -= 192;
#ifndef NO_NSA
        if (u < 128) { const int i = 15 - (u >> 4), bh = u & 15; { for (int rp = 0; rp < DUP_NSA; ++rp) { if (rp) __syncthreads(); nsa_unit(bh >> 1, bh & 1, i, l, in, ws, lds, g_wv); } } continue; }
#endif
        u -= 128;
        if (u < 192) { const int qt = 3 - u / 48, bh = u % 48; MLA_CALL(bh / 6, bh % 6, qt, l, ws, lds, g_wv); continue; } u -= 192;
#ifndef NO_NSA
        if (u < 128) { const int i = 7 - (u >> 4), bh = u & 15; { for (int rp = 0; rp < DUP_NSA; ++rp) { if (rp) __syncthreads(); nsa_unit(bh >> 1, bh & 1, i, l, in, ws, lds, g_wv); } } continue; }
#endif
        u -= 128;
#ifndef NO_MLOUT
        ml_scan_wait(l, ws, g_wv);
        for (int rp = 0; rp < DUP_ML; ++rp) { int tid_ = TIDX; asm volatile("" : "+v"(tid_)); const int w = tid_ >> 6; ml_out_wave(u * 8 + w, l, in, ws, lds + w * 16384, lds + 131072 + w * 256, tid_ & 63); }
#endif
    }
}
__device__ __forceinline__ void phase_ynorm(int l, unsigned char* ws, int bid, int nb, int g_wv) {
    int tid_ = TIDX; asm volatile("" : "+v"(tid_)); const int w = tid_ >> 6, lane = tid_ & 63;
    bf16_t* Y = (bf16_t*)(ws + WS_Y); const float* sa = (const float*)(ws + WS_SSQ + PT_A) + (size_t)l * 16384 * 8; const float* sc = (const float*)(ws + WS_SSQ + PT_C) + (size_t)l * 16384 * 8;
    for (int r0 = (bid * 8 + w) * 8; r0 < NTOK; r0 += nb * 64) {
        if (lane < 48) {
            u32x4 x[8], y[8]; float ra[8], rc[8];
#pragma unroll
            for (int k = 0; k < 8; ++k) { const int row = r0 + k;
                const f32x4 a0 = *(const f32x4*)(sa + (size_t)row * 8), a1 = *(const f32x4*)(sa + (size_t)row * 8 + 4), c0 = *(const f32x4*)(sc + (size_t)row * 8), c1 = *(const f32x4*)(sc + (size_t)row * 8 + 4);
                ra[k] = rsqrtf((((a0.x + a0.y) + (a0.z + a0.w)) + (a1.x + a1.y)) * (1.f / 384.f) + 1e-6f); rc[k] = rsqrtf((((c0.x + c0.y) + (c0.z + c0.w)) + (c1.x + c1.y)) * (1.f / 384.f) + 1e-6f);
                x[k] = *((const u32x4*)(Y + (size_t)row * 1024) + lane); y[k] = *((const u32x4*)(Y + (size_t)row * 1024 + 384) + lane); }
#pragma unroll
            for (int k = 0; k < 8; ++k) { const int row = r0 + k; u32x4 a = x[k], c = y[k]; const float fa = ra[k], fc = rc[k];
                a.x = pk_bf16(bf_lo(a.x) * fa, bf_hi(a.x) * fa); a.y = pk_bf16(bf_lo(a.y) * fa, bf_hi(a.y) * fa); a.z = pk_bf16(bf_lo(a.z) * fa, bf_hi(a.z) * fa); a.w = pk_bf16(bf_lo(a.w) * fa, bf_hi(a.w) * fa);
                c.x = pk_bf16(bf_lo(c.x) * fc, bf_hi(c.x) * fc); c.y = pk_bf16(bf_lo(c.y) * fc, bf_hi(c.y) * fc); c.z = pk_bf16(bf_lo(c.z) * fc, bf_hi(c.z) * fc); c.w = pk_bf16(bf_lo(c.w) * fc, bf_hi(c.w) * fc);
                *((u32x4*)(Y + (size_t)row * 1024) + lane) = a; *((u32x4*)(Y + (size_t)row * 1024 + 384) + lane) = c; }
        }
    }
}
constexpr int LDS_FAC = 131072 + 2048;
__device__ __forceinline__ void outproj_factors(int l, unsigned char* ws, LAS unsigned char* lds, int pm, int tid) {
    asm volatile("" : "+v"(tid));
    if (tid < 256) { const int row = pm * 256 + tid; const float* sa = (const float*)(ws + WS_SSQ + PT_A) + ((size_t)l * 16384 + row) * 8; const float* sc = (const float*)(ws + WS_SSQ + PT_C) + ((size_t)l * 16384 + row) * 8;
        const f32x4 a0 = *(const f32x4*)sa, a1 = *(const f32x4*)(sa + 4), c0 = *(const f32x4*)sc, c1 = *(const f32x4*)(sc + 4);
        const float ra = rsqrtf((((a0.x + a0.y) + (a0.z + a0.w)) + (a1.x + a1.y)) * (1.f / 384.f) + 1e-6f), rc = rsqrtf((((c0.x + c0.y) + (c0.z + c0.w)) + (c1.x + c1.y)) * (1.f / 384.f) + 1e-6f);
        LAS float* F = (LAS float*)(lds + LDS_FAC); F[2 * tid] = ra / rc; F[2 * tid + 1] = rc; }
    __syncthreads();
}
struct EpiOut {
    static constexpr bool KHOOK = true;
    bf16_t* XB; float* ssq; const LAS float* F; bool fold;
    __device__ __forceinline__ void kscale(f32x4 (&acc)[2][2][4][2], int which, int wr, int fr) const {
        if (!fold) return;
#pragma unroll
        for (int ai = 0; ai < 2; ++ai)
#pragma unroll
            for (int m = 0; m < 4; ++m) { const float f = F[2 * (ai * 128 + wr * 64 + m * 16 + fr) + which];
#pragma unroll
                for (int bj = 0; bj < 2; ++bj)
#pragma unroll
                    for (int n = 0; n < 2; ++n) acc[ai][bj][m][n] = acc[ai][bj][m][n] * f; }
    }
    __device__ __forceinline__ void operator()(const f32x4 (&acc)[2][2][4][2], const GUnit& u, int wr, int wc, int fr, int fq) const {
#pragma unroll
        for (int ai = 0; ai < 2; ++ai)
#pragma unroll
          for (int mh = 0; mh < 2; ++mh) {
            __builtin_amdgcn_sched_barrier(0);
            u32x4 xr[2][2];
#pragma unroll
            for (int m2 = 0; m2 < 2; ++m2)
#pragma unroll
                for (int bj = 0; bj < 2; ++bj) xr[m2][bj] = *(const u32x4*)(XB + (size_t)(u.pm * 256 + ai * 128 + wr * 64 + (2 * mh + m2) * 16 + fr) * 1024 + u.pn * 256 + bj * 128 + wc * 32 + 8 * fq);
#pragma unroll
            for (int m2 = 0; m2 < 2; ++m2) {
                const int m = 2 * mh + m2; const int row = u.pm * 256 + ai * 128 + wr * 64 + m * 16 + fr; float ss = 0.f;
#pragma unroll
                for (int bj = 0; bj < 2; ++bj) {
                    const u32x4 x = xr[m2][bj]; u32x4 o;
                    o.x = pk_bf16(bf_lo(x.x) + acc[ai][bj][m][0][0], bf_hi(x.x) + acc[ai][bj][m][0][1]); o.y = pk_bf16(bf_lo(x.y) + acc[ai][bj][m][0][2], bf_hi(x.y) + acc[ai][bj][m][0][3]);
                    o.z = pk_bf16(bf_lo(x.z) + acc[ai][bj][m][1][0], bf_hi(x.z) + acc[ai][bj][m][1][1]); o.w = pk_bf16(bf_lo(x.w) + acc[ai][bj][m][1][2], bf_hi(x.w) + acc[ai][bj][m][1][3]);
                    *(u32x4*)(XB + (size_t)row * 1024 + u.pn * 256 + bj * 128 + wc * 32 + 8 * fq) = o;
                    ss += (bf_lo(o.x) * bf_lo(o.x) + bf_hi(o.x) * bf_hi(o.x)) + (bf_lo(o.y) * bf_lo(o.y) + bf_hi(o.y) * bf_hi(o.y)) + (bf_lo(o.z) * bf_lo(o.z) + bf_hi(o.z) * bf_hi(o.z)) + (bf_lo(o.w) * bf_lo(o.w) + bf_hi(o.w) * bf_hi(o.w));
                }
                ss = quad_sum(ss); if (fq == 0) ssq[(size_t)row * 16 + u.pn * 4 + wc] = ss;
            }
          }
    }
};

__device__ __forceinline__ float sum16(const float* p) { const f32x4 a = *(const f32x4*)p, b = *(const f32x4*)(p + 4), c = *(const f32x4*)(p + 8), d = *(const f32x4*)(p + 12);
    return (((a.x + a.y) + (a.z + a.w)) + ((b.x + b.y) + (b.z + b.w))) + (((c.x + c.y) + (c.z + c.w)) + ((d.x + d.y) + (d.z + d.w))); }
__device__ __forceinline__ void phase_route(int l, InPtr in, unsigned char* ws, LAS unsigned char* lds, int bid, int nb, int g_wv) {
    int tid_ = TIDX; asm volatile("" : "+v"(tid_)); const int w = tid_ >> 6, lane = tid_ & 63, r = lane & 15, q = lane >> 4;
    const bf16_t* XB = (const bf16_t*)(ws + WS_XB); const bf16_t* WR = (const bf16_t*)(ws + WS_WR) + (size_t)l * 64 * 1024;
    const float* ssq = (const float*)(ws + WS_SSQ + PT_X1) + (size_t)l * 16384 * 16; const float* bg = in->p[24] + l * 4; const float* be = in->p[26] + l * 32;
    unsigned* cnt = (unsigned*)(ws + WS_CTL) + CW_CNT + 2048 * l; unsigned* mtok = (unsigned*)(ws + WS_META); float* mw = (float*)(ws + WS_META + META_W);
    LAS float* lg = (LAS float*)(lds + w * 4096);
    LAS unsigned* lcnt = (LAS unsigned*)(lds + 32768); LAS unsigned* lbase = lcnt + 32;
    for (int g0 = bid * 8; g0 < NTOK / 16; g0 += nb * 8) {
        if (tid_ < 32) lcnt[tid_] = 0u;
        __syncthreads();
        const int tok0 = (g0 + w) * 16; f32x4 acc[3];
#pragma unroll
        for (int n = 0; n < 3; ++n) acc[n] = (f32x4){0.f, 0.f, 0.f, 0.f};
        const bf16_t* ap = XB + (size_t)(tok0 + r) * 1024 + 8 * q; const bf16_t* bp = WR + (size_t)r * 1024 + 8 * q;
#pragma unroll 8
        for (int ks = 0; ks < 32; ++ks) { const bf16x8 a = *(const bf16x8*)(ap + 32 * ks);
#pragma unroll
            for (int n = 0; n < 3; ++n) { const bf16x8 bb = *(const bf16x8*)(bp + (size_t)n * 16 * 1024 + 32 * ks); acc[n] = MFMA16(a, bb, acc[n]); } }
#pragma unroll
        for (int n = 0; n < 3; ++n)
#pragma unroll
            for (int j = 0; j < 4; ++j) lg[(4 * q + j) * 48 + 16 * n + r] = acc[n][j];
        LDS_FENCE();
        int E0 = 0, E1 = 0; unsigned r0 = 0, r1 = 0; float wt0 = 0.f, wt1 = 0.f; const int tok = tok0 + (lane & 15);
        if (lane < 16) {
            const float rs = rsqrtf(sum16(ssq + (size_t)tok * 16) * (1.f / 1024.f) + 1e-6f); ((float*)(ws + WS_RS2))[tok] = rs; const LAS float* L = lg + lane * 48;
            float gl[4]; int gi = 0;
#pragma unroll
            for (int j = 0; j < 4; ++j) gl[j] = L[j] * rs + bg[j];
            float gm = gl[0];
#pragma unroll
            for (int j = 1; j < 4; ++j) if (gl[j] > gm) { gm = gl[j]; gi = j; }
            float gsum = 0.f;
#pragma unroll
            for (int j = 0; j < 4; ++j) gsum += __expf(gl[j] - gm);
            const float gtop = 1.f / gsum;
            float el[8];
#pragma unroll
            for (int j = 0; j < 8; ++j) el[j] = L[4 + gi * 8 + j] * rs + be[gi * 8 + j];
            int e0 = 0; float v0 = el[0];
#pragma unroll
            for (int j = 1; j < 8; ++j) if (el[j] > v0) { v0 = el[j]; e0 = j; }
            int e1 = -1; float v1 = -3.0e38f;
#pragma unroll
            for (int j = 0; j < 8; ++j) if (j != e0 && el[j] > v1) { v1 = el[j]; e1 = j; }
            const float w0 = 1.f / (1.f + __expf(v1 - v0)); E0 = gi * 8 + e0; E1 = gi * 8 + e1; wt0 = w0 * gtop; wt1 = (1.f - w0) * gtop;
            r0 = __hip_atomic_fetch_add(lcnt + E0, 1u, __ATOMIC_RELAXED, __HIP_MEMORY_SCOPE_WORKGROUP); r1 = __hip_atomic_fetch_add(lcnt + E1, 1u, __ATOMIC_RELAXED, __HIP_MEMORY_SCOPE_WORKGROUP);
        }
        __syncthreads();
        if (tid_ < 32) { const unsigned c = lcnt[tid_]; lbase[tid_] = c ? atomicAdd(cnt + tid_ * 64, c) : 0u; }
        __syncthreads();
        if (lane < 16) {
            const unsigned p0 = lbase[E0] + r0, p1 = lbase[E1] + r1;
            mtok[(size_t)E0 * 16384 + p0] = (unsigned)tok; mw[(size_t)E0 * 16384 + p0] = wt0;
            mtok[(size_t)E1 * 16384 + p1] = (unsigned)tok | 0x80000000u; mw[(size_t)E1 * 16384 + p1] = wt1;
        }
        __syncthreads();
    }
}

constexpr int LDS_TB = 131072 + 2048;
__device__ __forceinline__ void moe_tables(int l, unsigned char* ws, LAS unsigned char* lds, int g_wv) {
    int tix = TIDX; asm volatile("" : "+v"(tix));
    LAS int* tb = (LAS int*)(lds + LDS_TB);
    if (tix < 32) { const unsigned* cnt = (const unsigned*)(ws + WS_CTL) + CW_CNT + 2048 * l; tb[160 + tix] = (int)__hip_atomic_load(cnt + tix * 64, __ATOMIC_RELAXED, __HIP_MEMORY_SCOPE_AGENT); }
    __syncthreads();
    if (tix == 0) { int a = 0, f = 0, p = 0; for (int e = 0; e < 32; ++e) { const int c = tb[160 + e]; tb[e] = a; tb[48 + e] = f; tb[96 + e] = p; a += (c + 255) >> 8; f += c >> 8; p += (c & 255) ? 1 : 0; } tb[32] = a; tb[80] = f; tb[128] = p; }
    __syncthreads();
}
template <int NPN, bool GATHER_>
struct MoeSched {
    static constexpr bool GATHER = GATHER_, PARTIAL = false;
    const char* A; const char* Bt; const unsigned* cnt; const unsigned* mtok; const LAS int* tb; int G, c; size_t bstride_e  , bstride_pn; int lo, hi;
    __device__ __forceinline__ bool next(int i, GUnit& u) const {
        const int L = lo + i * G + c; if (L >= hi) return false;
        const int tile = L / NPN, pn = L % NPN;
        int e = 0;
        for (int k = 1; k < 32; ++k) e = (tb[k] <= tile) ? k : e;
        e = __builtin_amdgcn_readfirstlane(e);
        u.e = e; u.pm = tile; u.pn = pn; u.rows = tb[160 + e] - 256 * (tile - tb[e]);
        u.a = GATHER ? A : A + (size_t)tile * 256 * 256 * 2;
        u.b = Bt + (size_t)e * bstride_e + (size_t)pn * bstride_pn; return true;
    }
    __device__ __forceinline__ void aoff(const GUnit& u, unsigned (&v)[2][2], const int (&R)[2], const int (&C)[2]) const {
#pragma unroll
        for (int h = 0; h < 2; ++h)
#pragma unroll
            for (int i = 0; i < 2; ++i) {
                if (GATHER) { const int lr = h * 128 + R[i]; const int rr = 256 * (u.pm - tb[u.e]) + (lr < u.rows ? lr : 0); const unsigned tok = mtok[(size_t)u.e * 16384 + rr] & 0x7fffffffu; v[h][i] = (tok * 1024u + (unsigned)C[i]) * 2u; }
                else v[h][i] = (unsigned)((h * 128 + R[i]) * 256 + C[i]) * 2u;
            }
    }
};
struct EpiMoeUp {
    static constexpr bool KHOOK = false;
    const unsigned* mtok; const float* ssq; const LAS int* tb; bf16_t* HB;
    __device__ __forceinline__ void operator()(const f32x4 (&acc)[2][2][4][2], const GUnit& u, int wr, int wc, int fr, int fq) const {
        const int r0 = 256 * (u.pm - tb[u.e]);
        float rs8[8];
        { unsigned tk[8];
#pragma unroll
          for (int k = 0; k < 8; ++k) { const int lr = (k >> 2) * 128 + wr * 64 + (k & 3) * 16 + fr; tk[k] = mtok[(size_t)u.e * 16384 + r0 + (lr < u.rows ? lr : 0)] & 0x7fffffffu; }
#pragma unroll
          for (int k = 0; k < 8; ++k) rs8[k] = ssq[tk[k]]; }
#pragma unroll
        for (int ai = 0; ai < 2; ++ai)
#pragma unroll
            for (int m = 0; m < 4; ++m) {
                __builtin_amdgcn_sched_barrier(0);
                const int lr = ai * 128 + wr * 64 + m * 16 + fr;
                if (lr < u.rows) {
                    const float rs = rs8[ai * 4 + m];
                    float hv[8];
#pragma unroll
                    for (int n = 0; n < 2; ++n)
#pragma unroll
                        for (int j = 0; j < 4; ++j) { const float gv = acc[ai][0][m][n][j] * rs, uv = acc[ai][1][m][n][j] * rs; hv[4 * n + j] = siluf(gv) * uv; }
                    st_bf16x8(HB + ((size_t)u.pm * 256 + lr) * 256 + u.pn * 128 + wc * 32 + 8 * fq, hv);
                }
            }
    }
};
struct EpiMoeDown {
    static constexpr bool KHOOK = false;
    const unsigned* mtok; const float* mw; const LAS int* tb; bf16_t* YB;
    __device__ __forceinline__ void operator()(const f32x4 (&acc)[2][2][4][2], const GUnit& u, int wr, int wc, int fr, int fq) const {
        const int r0 = 256 * (u.pm - tb[u.e]);
        unsigned mt8[8]; float wt8[8];
#pragma unroll
        for (int k = 0; k < 8; ++k) { const int lr = (k >> 2) * 128 + wr * 64 + (k & 3) * 16 + fr; const size_t ix = (size_t)u.e * 16384 + r0 + (lr < u.rows ? lr : 0); mt8[k] = mtok[ix]; wt8[k] = mw[ix]; }
#pragma unroll
        for (int ai = 0; ai < 2; ++ai)
#pragma unroll
            for (int m = 0; m < 4; ++m) {
                __builtin_amdgcn_sched_barrier(0);
                const int lr = ai * 128 + wr * 64 + m * 16 + fr;
                if (lr < u.rows) {
                    const unsigned mt = mt8[ai * 4 + m]; const float wt = wt8[ai * 4 + m];
                    bf16_t* dst = YB + ((size_t)(mt >> 31) * 16384 + (mt & 0x7fffffffu)) * 1024 + u.pn * 256 + wc * 32 + 8 * fq;
#pragma unroll
                    for (int bj = 0; bj < 2; ++bj) { float v[8];
#pragma unroll
                        for (int n = 0; n < 2; ++n)
#pragma unroll
                            for (int j = 0; j < 4; ++j) v[4 * n + j] = acc[ai][bj][m][n][j] * wt;
                        st_bf16x8(dst + bj * 128, v); }
                }
            }
    }
};
__device__ __forceinline__ void phase_combine(int l, unsigned char* ws, float* out, int bid, int nb, int g_wv) {
    int tid_ = TIDX; asm volatile("" : "+v"(tid_)); const int w = tid_ >> 6, lane = tid_ & 63;
    bf16_t* XB = (bf16_t*)(ws + WS_XB); const bf16_t* Y0 = (const bf16_t*)(ws + WS_YBUF); const bf16_t* Y1 = Y0 + (size_t)16384 * 1024; float* ssqx = (float*)(ws + WS_SSQX) + 16384;
    for (int row = bid * 8 + w; row < NTOK; row += nb * 8) {
        float ss = 0.f;
#pragma unroll
        for (int k = 0; k < 2; ++k) {
            const size_t o = (size_t)row * 1024 + (lane + 64 * k) * 8;
            const u32x4 x = *(const u32x4*)(XB + o), a = *(const u32x4*)(Y0 + o), c = *(const u32x4*)(Y1 + o);
            float v[8] = { bf_lo(x.x) + bf_lo(a.x) + bf_lo(c.x), bf_hi(x.x) + bf_hi(a.x) + bf_hi(c.x), bf_lo(x.y) + bf_lo(a.y) + bf_lo(c.y), bf_hi(x.y) + bf_hi(a.y) + bf_hi(c.y),
                           bf_lo(x.z) + bf_lo(a.z) + bf_lo(c.z), bf_hi(x.z) + bf_hi(a.z) + bf_hi(c.z), bf_lo(x.w) + bf_lo(a.w) + bf_lo(c.w), bf_hi(x.w) + bf_hi(a.w) + bf_hi(c.w) };
            if (l == L_ - 1 && out) { *(f32x4*)(out + o) = (f32x4){v[0], v[1], v[2], v[3]}; *(f32x4*)(out + o + 4) = (f32x4){v[4], v[5], v[6], v[7]}; }
            else { u32x4 p; p.x = pk_bf16(v[0], v[1]); p.y = pk_bf16(v[2], v[3]); p.z = pk_bf16(v[4], v[5]); p.w = pk_bf16(v[6], v[7]); *(u32x4*)(XB + o) = p;
#pragma unroll
                   for (int j = 0; j < 4; ++j) { const unsigned q = j == 0 ? p.x : (j == 1 ? p.y : (j == 2 ? p.z : p.w)); ss += bf_lo(q) * bf_lo(q) + bf_hi(q) * bf_hi(q); } }
        }
        if (l < L_ - 1) { ss = wave_sum(ss); if (lane == 0) ssqx[row] = ss; }
    }
}
constexpr int MOE_CVT_SPLIT = 4608;
constexpr int NPH = 9;
enum { PH_INPROJ = 0, PH_PREP, PH_MIX, PH_YNORM, PH_OUTPROJ, PH_ROUTE, PH_MOEUP, PH_MOEDOWN, PH_COMBINE };
struct Args { Inputs in; float* out; unsigned char* ws; int ph_lo, ph_hi; };

__global__ void __launch_bounds__(512, 2) mk(Args args) {
    extern __shared__ __attribute__((aligned(16))) unsigned char lds_raw[];
    LAS unsigned char* lds = (LAS unsigned char*)lds_raw;
    const int g_wv = __builtin_amdgcn_readfirstlane((int)threadIdx.x >> 6);
    const int bid0 = blockIdx.x, nb = gridDim.x;
#define BID() ({ int b_ = bid0; asm volatile("" : "+s"(b_)); b_; })
    unsigned char* ws = args.ws; unsigned* ctl = (unsigned*)(ws + WS_CTL);
    const int lo = args.ph_lo, hi = args.ph_hi;
    if (TIDX < 4) ((LAS unsigned*)(lds + LDS_MISC))[TIDX] = 0u;
    __syncthreads();
    XcdBarrier bar; bar.g_wv = g_wv; bar.bar = ctl + CW_BAR; bar.x = 0; bar.st = nullptr;
    if (hi - lo > 1) bar = xcd_barrier_post(ctl + CW_BAR, (volatile LAS unsigned*)(lds + LDS_MISC), g_wv);
#define IN(k) (lo <= (k) && (k) < hi)
#ifndef REPEAT_PH
#define REPEAT_PH -1
#endif
#define NREP(k) ((REPEAT_PH == (k)) ? 2 : 1)
#ifndef NBAR
#define NBAR 1
#endif
#ifndef TIME_PH
#define TIME_PH -1
#endif
#define STAMP(i) do { if (TIME_PH != -1 && blockIdx.x == 0 && TIDX == 0) ((unsigned long long*)(ctl + CW_TS))[i] = __builtin_amdgcn_s_memrealtime(); } while (0)
#define SEAM(k) do { if (IN(k) && IN((k) + 1)) for (int nb_ = 0; nb_ < NBAR; ++nb_) xcd_barrier(bar); STAMP((k) + 1); } while (0)
    STAMP(0);
#ifndef NO_PRO
    if (IN(0)) for (int rep = 0; rep < NREP(100); ++rep) { prologue(in_tab(), launder(ws), lds, BID(), nb, g_wv); if (rep + 1 < NREP(100)) xcd_barrier(bar); }
#endif
    SEAM(0);
    for (int l = 0; l < L_; ++l) {
        const int pb = 1 + l * NPH;
        if (IN(pb + PH_INPROJ)) for (int rep = 0; rep < NREP(PH_INPROJ); ++rep) {
            if (rep) xcd_barrier(bar);
            InPtr in = in_tab(); unsigned char* ws = launder(args.ws);
            g8::DenseSched S{(const char*)(ws + WS_XB), (const char*)(ws + WS_WIN) + (size_t)l * 2560 * 1024 * 2, 1024, 1024, 64, 10, nb, BID()};
            EpiInProj E{(const float*)(ws + WS_SSQX) + l * 16384, (float*)(ws + WS_SSQ + PT_DQ) + (size_t)l * 16384 * 4, (float*)(ws + WS_SSQ + PT_DKV) + (size_t)l * 16384 * 2,
                        in->p[8] + l * 64, in->p[9] + l * 64, in->p[19] + l * 192 + 96 + 64, (const float*)(ws + WS_ROPE), ws + WS_PRJ};
#ifndef NO_INPROJ
            g8::gemm_run(lds, 1024, 1024, S, E, g_wv);
#endif
        }
        SEAM(pb + PH_INPROJ);
        if (IN(pb + PH_PREP)) for (int rep = 0; rep < NREP(PH_PREP); ++rep) { if (rep) xcd_barrier(bar); phase_prep(l, in_tab(), launder(ws), lds, BID(), nb, g_wv, (unsigned*)launder(ws) + CW_Q + 64 * (4 + l + 2 * rep)); }
        SEAM(pb + PH_PREP);
        if (IN(pb + PH_MIX)) for (int rep = 0; rep < NREP(PH_MIX); ++rep) { if (rep) xcd_barrier(bar); phase_mix(l, in_tab(), launder(ws), lds, (unsigned*)launder(ws) + CW_Q + 64 * (l + 2 * rep), g_wv); }
        SEAM(pb + PH_MIX);
        const bool fold_norm = (nb == 256);
        if (IN(pb + PH_YNORM) && !fold_norm) phase_ynorm(l, launder(ws), BID(), nb, g_wv);
        if (!fold_norm) SEAM(pb + PH_YNORM);
        if (IN(pb + PH_OUTPROJ)) {
            unsigned char* ws = launder(args.ws);
            g8::DenseSched S{(const char*)(ws + WS_Y), (const char*)(ws + WS_WOUT) + (size_t)l * 1024 * 1024 * 2, 1024, 1024, 64, 4, nb, BID()};
            EpiOut E{(bf16_t*)(ws + WS_XB), (float*)(ws + WS_SSQ + PT_X1) + (size_t)l * 16384 * 16, (const LAS float*)(lds + LDS_FAC), fold_norm};
            if (fold_norm) { g8::GUnit u0; if (S.next(0, u0)) outproj_factors(l, ws, lds, u0.pm, TIDX); else __syncthreads(); }
#ifndef NO_OUTPROJ
            g8::gemm_run(lds, 1024, 1024, S, E, g_wv);
#endif
        }
        SEAM(pb + PH_OUTPROJ);
#ifndef NO_ROUTE
        if (IN(pb + PH_ROUTE)) {
            const int b_ = BID();
            if (nb >= 256 && b_ >= 128) cvt_moe_layer(in_tab(), launder(ws), l, (LAS float*)lds, b_ - 128, nb - 128, TIDX);
            else { phase_route(l, in_tab(), launder(ws), lds, b_, nb >= 256 ? 128 : nb, g_wv); if (nb < 256) cvt_moe_layer(in_tab(), launder(ws), l, (LAS float*)lds, b_, nb, TIDX); }
            if (l + 1 < L_) { __syncthreads(); cvt_small_weights(in_tab(), launder(ws), l + 1, (LAS float*)lds, b_, nb, TIDX); }
        }
#endif
        SEAM(pb + PH_ROUTE);
        {
            const bool do_up = IN(pb + PH_MOEUP), do_dn = IN(pb + PH_MOEDOWN), fuse = do_up && do_dn;
            for (int part = 0; part < (fuse ? 3 : 1); ++part) {
                if (part) xcd_barrier(bar);
                unsigned char* ws = launder(args.ws);
                if (do_up || do_dn) moe_tables(l, ws, lds, g_wv);
                const unsigned* cnt = (const unsigned*)(ws + WS_CTL) + CW_CNT + 2048 * l; const unsigned* mtok = (const unsigned*)(ws + WS_META); const LAS int* tb = (const LAS int*)(lds + LDS_TB);
                const int b_ = BID(), ntile = tb[32], UPU = 2 * ntile, DNU = 4 * ntile;
                const int hi0 = UPU < nb ? UPU : nb, nu_ = UPU - hi0, nu = nu_ < (nb >> 1) ? nu_ : (nb >> 1), nd = nb - nu;
                const int d1a = 4 * (hi0 >> 1), d1b = 2 * nd, D1 = nu == 0 ? DNU : (d1a < d1b ? d1a : d1b);
                int ulo = 0, uhi = UPU, uG = nb, uc = b_, dlo = 0, dhi = DNU, dG = nb, dc = b_;
                if (fuse) {
                    if (part == 0) { uhi = hi0; dhi = 0; }
                    else if (part == 1) { ulo = hi0; uG = nu; if (b_ >= nu) uhi = ulo; dhi = D1; dG = nd; dc = b_ - nu; if (b_ < nu) dhi = 0; }
                    else { uhi = 0; dlo = D1; }
                }
                if (do_up && uhi > ulo) {
                    MoeSched<2, true> S{(const char*)(ws + WS_XB), (const char*)(ws + WS_WMOE), cnt, mtok, tb, uG, uc, (size_t)512 * 1024 * 2, (size_t)256 * 1024 * 2, ulo, uhi};
                    EpiMoeUp E{mtok, (const float*)(ws + WS_RS2), tb, (bf16_t*)(ws + WS_HBUF)};
#ifndef NO_MOEUP
                    g8::gemm_run(lds, 1024, 1024, S, E, g_wv);
#endif
                }
                if (do_dn && dhi > dlo) {
                    MoeSched<4, false> S{(const char*)(ws + WS_HBUF), (const char*)(ws + WS_WMOE + WMOE_WD), cnt, mtok, tb, dG, dc, (size_t)1024 * 256 * 2, (size_t)256 * 256 * 2, dlo, dhi};
                    EpiMoeDown E{mtok, (const float*)(ws + WS_META + META_W), tb, (bf16_t*)(ws + WS_YBUF)};
#ifndef NO_MOEDOWN
                    g8::gemm_run(lds, 256, 256, S, E, g_wv);
#endif
                }
            }
        }
        SEAM(pb + PH_MOEDOWN);
#ifndef NO_COMBINE
        if (IN(pb + PH_COMBINE)) { unsigned char* ws = launder(args.ws); phase_combine(l, ws, args.out, BID(), nb, g_wv); }
#endif
        SEAM(pb + PH_COMBINE);
    }
#undef IN
#undef SEAM
}
#if CHECK
struct NvScratch { float *proj, *h1, *qk, *hraw, *kn, *kcmp, *vcmp, *dqn, *q, *dkvn, *kv, *krope, *y, *x1, *xl; int* rt_e; float* rt_w; };
constexpr int CB = 5;
enum { NS_INPROJ = 0, NS_NSAPREP, NS_MLAPREP, NS_NSA, NS_ML, NS_MLA, NS_OUT, NS_ROUTE, NS_MOE };
static void naive_step(void* const* d_in, int l, int step, const float* xin, float* xout, const NvScratch& S, hipStream_t st) {
    const int b = CB;
    const float* rel_bias = (const float*)d_in[2];
    const float* norm1_g = (const float*)d_in[3] + (long)l * 1024;
    const float* w_in = (const float*)d_in[4] + (long)l * 1024 * DIN;
    const float* cmp_pe = (const float*)d_in[5] + (long)l * 2 * 32 * 64;
    const float* cmp_w1 = (const float*)d_in[6] + (long)l * 2 * 32 * 64 * 64;
    const float* cmp_w2 = (const float*)d_in[7] + (long)l * 2 * 64 * 64;
    const float* q_norm = (const float*)d_in[8] + l * 64;
    const float* k_norm = (const float*)d_in[9] + l * 64;
    const float* nsa_on = (const float*)d_in[10] + l * 384;
    const float* conv = (const float*)d_in[11] + l * 4 * 512;
    const float* ibias = (const float*)d_in[12] + l * 4;
    const float* fbias = (const float*)d_in[13] + l * 4;
    const float* ml_on = (const float*)d_in[14] + l * 256;
    const float* qan = (const float*)d_in[15] + l * 192;
    const float* w_uq = (const float*)d_in[16] + (long)l * 192 * 576;
    const float* kvan = (const float*)d_in[17] + l * 128;
    const float* w_ukv = (const float*)d_in[18] + (long)l * 128 * 768;
    const float* qkn = (const float*)d_in[19] + l * 192;
    const float* mla_on = (const float*)d_in[20] + l * 384;
    const float* w_out = (const float*)d_in[21] + (long)l * 1024 * 1024;
    const float* norm2_g = (const float*)d_in[22] + l * 1024;
    const float* wgrp = (const float*)d_in[23] + (long)l * 1024 * 4;
    const float* bgrp = (const float*)d_in[24] + l * 4;
    const float* wexp = (const float*)d_in[25] + (long)l * 1024 * 32;
    const float* bexp = (const float*)d_in[26] + l * 32;
    const float* Wg = (const float*)d_in[27] + (long)l * 32 * 1024 * 256;
    const float* Wu = (const float*)d_in[28] + (long)l * 32 * 1024 * 256;
    const float* Wd = (const float*)d_in[29] + (long)l * 32 * 256 * 1024;
    const int* pos = (const int*)d_in[1] + b * 2048;
    switch (step) {
    case NS_INPROJ:
        nv_rmsnorm<<<dim3(2048, 1), 64, 0, st>>>(xin, 1024, 0, S.h1, 1024, 0, norm1_g, 0, 1024);
        nv_gemm<<<dim3((DIN + 63) / 64, 2048 / 64), 256, 0, st>>>(S.h1, 1024, w_in, DIN, S.proj, DIN, nullptr, 0, 2048, DIN, 1024);
        break;
    case NS_NSAPREP:
        nv_nsa_cmp<<<dim3(127, 2, 2), 64, 0, st>>>(S.proj, cmp_pe, cmp_w1, cmp_w2, k_norm, S.kcmp, S.vcmp);
        nv_nsa_knorm<<<dim3(2048, 4), 64, 0, st>>>(S.proj, k_norm, S.kn);
        break;
    case NS_MLAPREP:
        nv_rmsnorm<<<dim3(2048, 1), 64, 0, st>>>(S.proj + O_CDQ, DIN, 0, S.dqn, 192, 0, qan, 0, 192);
        nv_gemm<<<dim3(576 / 64, 2048 / 64), 256, 0, st>>>(S.dqn, 192, w_uq, 576, S.q, 576, nullptr, 0, 2048, 576, 192);
        nv_rmsnorm<<<dim3(2048, 1), 64, 0, st>>>(S.proj + O_CDKV, DIN, 0, S.dkvn, 128, 0, kvan, 0, 128);
        nv_gemm<<<dim3(768 / 64, 2048 / 64), 256, 0, st>>>(S.dkvn, 128, w_ukv, 768, S.kv, 768, nullptr, 0, 2048, 768, 128);
        nv_mla_prep<<<dim3(2048, 7), 64, 0, st>>>(S.q, S.kv, S.proj, S.krope, qkn, pos);
        break;
    case NS_NSA:
        nv_nsa_attn<<<dim3(2048, 2), 192, 0, st>>>(S.proj, S.kn, S.kcmp, S.vcmp, rel_bias, q_norm, S.y);
        break;
    case NS_ML:
        nv_ml_conv<<<2048, 512, 0, st>>>(S.proj, conv, S.qk);
        nv_ml_rec<<<4, 256, 0, st>>>(S.proj, S.qk, ibias, fbias, S.hraw);
        nv_ml_fin<<<dim3(2048, 4), 64, 0, st>>>(S.proj, S.hraw, ml_on, S.y);
        break;
    case NS_MLA:
        nv_mla_attn<<<dim3(2048, 6), 64, 0, st>>>(S.q, S.kv, S.krope, S.y);
        break;
    case NS_OUT:
        nv_rmsnorm<<<dim3(2048, 1), 64, 0, st>>>(S.y, 1024, 0, S.y, 1024, 0, nsa_on, 0, 384);
        nv_rmsnorm<<<dim3(2048, 1), 64, 0, st>>>(S.y + 640, 1024, 0, S.y + 640, 1024, 0, mla_on, 0, 384);
        nv_gemm<<<dim3(1024 / 64, 2048 / 64), 256, 0, st>>>(S.y, 1024, w_out, 1024, S.x1, 1024, xin, 1024, 2048, 1024, 1024);
        break;
    case NS_ROUTE:
        nv_moe_route<<<2048, 64, 0, st>>>(S.x1, norm2_g, wgrp, bgrp, wexp, bexp, S.h1, S.rt_e, S.rt_w);
        break;
    case NS_MOE:
        nv_moe_exp<<<2048, 256, 0, st>>>(S.x1, S.h1, S.rt_e, S.rt_w, Wg, Wu, Wd, xout);
        break;
    }
}

__device__ __forceinline__ void chk_commit(float d2, float r2, float* acc) { d2 = wave_sum(d2); r2 = wave_sum(r2); if ((threadIdx.x & 63) == 0) { atomicAdd(acc, d2); atomicAdd(acc + 1, r2); } }
__device__ __forceinline__ void chk_add(float f, float r, float& d2, float& r2) { const float d = f - r; d2 += (d == d) ? d * d : 1e30f; r2 += r * r; }

__global__ void __launch_bounds__(64) chk_proj(const float* nproj, const unsigned char* prj, const float* ssq_dq, const float* ssq_dkv, const float* qg, const float* kg, const float* krg, const int* pos, float* acc) {
    const int t = blockIdx.x, e = threadIdx.x; const size_t row = (size_t)CB * 2048 + t; float d2 = 0.f, r2 = 0.f;
    for (int G = 0; G < 40; ++G) {
        const int c = inproj_refcol(G, e); float r = c < 0 ? 0.f : nproj[(size_t)t * DIN + c]; float f = 0.f;
        const float rr = (G == 37 && e >= 32) ? 0.f : r; const float ss = wave_sum(rr * rr);
        if (G < 6) { r = r * rsqrtf(ss / 64.f + 1e-6f) * qg[e] * 0.18033688f; f = bf2f(((const bf16_t*)(prj + PRJ_QN))[((size_t)(CB * 6 + G) * 2048 + t) * 64 + e]); }
        else if (G < 18) { const int a = G - 6, br = a >> 2, s = (a >> 1) & 1, hk = a & 1;
            if (br > 0 && s == 0) r = r * rsqrtf(ss / 64.f + 1e-6f) * kg[e];
            const size_t base = br == 0 ? (s ? PRJ_C0V : PRJ_C0K) : (br == 1 ? (s ? PRJ_VN1 : PRJ_KN1) : (s ? PRJ_VN2 : PRJ_KN2));
            f = bf2f(((const bf16_t*)(prj + base))[((size_t)(CB * 2 + hk) * 2048 + t) * 64 + e]); }
        else if (G < 26) f = bf2f(((const bf16_t*)(prj + PRJ_RAWQK))[row * 512 + (G - 18) * 64 + e]);
        else if (G < 30) f = bf2f(((const bf16_t*)(prj + PRJ_VML))[((size_t)(CB * 4 + (G - 26)) * 2048 + t) * 64 + e]);
        else if (G < 34) f = bf2f(((const bf16_t*)(prj + PRJ_OG))[row * 256 + (G - 30) * 64 + e]);
        else if (G < 37) f = bf2f(((const bf16_t*)(prj + PRJ_DQKV))[row * 384 + (G - 34) * 64 + e]);
        else if (G == 37) {
            const float val = e < 32 ? rr * rsqrtf(ss / 32.f + 1e-6f) * krg[e & 31] : 0.f; const float oth = __shfl_xor(val, 16);
            if (e < 32) { const int i = e & 15; const double ang = (double)pos[row] * pow(10000.0, -(double)i / 16.0); const float cs = (float)cos(ang), sn = (float)sin(ang);
                r = e < 16 ? val * cs - oth * sn : val * cs + oth * sn; f = bf2f(((const bf16_t*)(prj + PRJ_KR))[row * 32 + e]); }
            else if (e < 58) f = ((const float*)(prj + PRJ_GATES))[row * 32 + (e - 32)];
            else { f = 0.f; r = 0.f; }
        }
        else f = bf2f(((const bf16_t*)(prj + PRJ_DQKV))[row * 384 + 256 + (G - 38) * 64 + e]);
        chk_add(f, r, d2, r2);
    }
    float d2s = 0.f, r2s = 0.f;
    { float s1 = 0.f, s2 = 0.f; for (int c = e; c < 192; c += 64) { float v = nproj[(size_t)t * DIN + O_CDQ + c]; s1 += v * v; } for (int c = e; c < 128; c += 64) { float v = nproj[(size_t)t * DIN + O_CDKV + c]; s2 += v * v; }
      s1 = wave_sum(s1); s2 = wave_sum(s2); if (e == 0) { chk_add((ssq_dq[row * 4] + ssq_dq[row * 4 + 1]) + ssq_dq[row * 4 + 2], s1, d2s, r2s); chk_add(ssq_dkv[row * 2] + ssq_dkv[row * 2 + 1], s2, d2s, r2s); } }
    chk_commit(d2, r2, acc); chk_commit(d2s, r2s, acc + 2);
}

__global__ void __launch_bounds__(64) chk_prep(const float* nq, const float* nkv, const float* nkr, const float* nkc, const float* nvc, const unsigned char* ws, float* acc) {
    const int t = blockIdx.x, e = threadIdx.x; float d2 = 0.f, r2 = 0.f, d2c = 0.f, r2c = 0.f; const float scale = 0.14724444f;
    const bf16_t* QM = (const bf16_t*)(ws + WS_MLA); const bf16_t* KM = (const bf16_t*)(ws + WS_MLA + MLA_KM); const bf16_t* VM = (const bf16_t*)(ws + WS_MLA + MLA_VM);
    for (int h = 0; h < 6; ++h) {
        const size_t rq = ((size_t)(CB * 6 + h) * 2048 + t);
        chk_add(bf2f(QM[rq * 96 + e]), nq[(size_t)t * 576 + h * 96 + e] * scale, d2, r2);
        chk_add(bf2f(KM[rq * 96 + e]), nkv[(size_t)t * 768 + h * 128 + e], d2, r2);
        chk_add(bf2f(VM[rq * 64 + e]), nkv[(size_t)t * 768 + h * 128 + 64 + e], d2, r2);
        if (e < 32) { chk_add(bf2f(QM[rq * 96 + 64 + e]), nq[(size_t)t * 576 + h * 96 + 64 + e] * scale, d2, r2); chk_add(bf2f(KM[rq * 96 + 64 + e]), nkr[(size_t)t * 32 + e], d2, r2); }
    }
    if (t < 128) for (int hk = 0; hk < 2; ++hk) {
        const bf16_t* KC = (const bf16_t*)(ws + WS_CMP); const bf16_t* VC = (const bf16_t*)(ws + WS_CMP + CMP_V); const size_t rf = ((size_t)(CB * 2 + hk) * 128 + t) * 64 + e;
        chk_add(bf2f(KC[rf]), t < 127 ? nkc[(size_t)(hk * 127 + t) * 64 + e] : 0.f, d2c, r2c); chk_add(bf2f(VC[rf]), t < 127 ? nvc[(size_t)(hk * 127 + t) * 64 + e] : 0.f, d2c, r2c);
    }
    chk_commit(d2, r2, acc); chk_commit(d2c, r2c, acc + 2);
}

__global__ void __launch_bounds__(64) chk_y(const float* ny, const unsigned char* ws, float* acc, int nseg) {
    const int t = blockIdx.x, e = threadIdx.x; const bf16_t* Y = (const bf16_t*)(ws + WS_Y) + ((size_t)CB * 2048 + t) * 1024;
    float d2[3] = {0.f, 0.f, 0.f}, r2[3] = {0.f, 0.f, 0.f};
    for (int c = e; c < 1024; c += 64) { const int seg = c < 384 ? 0 : (c < 640 ? 1 : 2); const int cf = c < 384 ? c : (c < 640 ? 768 + (c - 384) : 384 + (c - 640)); const float f = bf2f(Y[cf]), r = ny[(size_t)t * 1024 + c];
        if (seg == 0) chk_add(f, r, d2[0], r2[0]); else if (seg == 1) chk_add(f, r, d2[1], r2[1]); else chk_add(f, r, d2[2], r2[2]); }
    if (nseg == 3) { chk_commit(d2[0], r2[0], acc); chk_commit(d2[1], r2[1], acc + 2); chk_commit(d2[2], r2[2], acc + 4); }
    else chk_commit(d2[0] + d2[1] + d2[2], r2[0] + r2[1] + r2[2], acc);
}

__global__ void __launch_bounds__(64) chk_x(const float* nx, const unsigned char* ws, float* acc) {
    const int t = blockIdx.x, e = threadIdx.x; const bf16_t* X = (const bf16_t*)(ws + WS_XB) + ((size_t)CB * 2048 + t) * 1024; float d2 = 0.f, r2 = 0.f;
    for (int c = e; c < 1024; c += 64) chk_add(bf2f(X[c]), nx[(size_t)t * 1024 + c], d2, r2);
    chk_commit(d2, r2, acc);
}

__global__ void __launch_bounds__(512) chk_code(float* acc, int nst, const float* nout) {
    __shared__ float sh[512];
    float s = 0.f; for (int i = threadIdx.x; i < 2048 * 1024; i += 512) { float v = nout[i]; s += v * v; }
    sh[threadIdx.x] = s; __syncthreads();
    if (threadIdx.x == 0) { float tot = 0.f; for (int i = 0; i < 512; ++i) tot += sh[i]; float rms = sqrtf(tot / (2048.f * 1024.f)); if (!(rms > 1e-3f && rms < 1e3f)) rms = 1.f;
        int code = 0;
        for (int st = 0; st < nst; ++st) { const float d2 = acc[2 * st], r2 = acc[2 * st + 1]; if (r2 == 0.f && d2 == 0.f) { if ((st & 15) >= 9) continue; code = (st + 1) * 4 + 3; break; } const float err = d2 / fmaxf(r2, 1e-30f);
            const float tol = CHK_TOL(st);
            if (!(err <= tol)) { const int cls = !(err < 1.f) ? 3 : (err >= 0.1f ? 2 : (err >= 0.01f ? 1 : 0)); code = (st + 1) * 4 + cls; break; } }
        acc[2 * 40] = rms * 32.f * exp2f(0.5f * (float)code); }
}
__global__ void __launch_bounds__(512) chk_fill(const float* acc, float* out) {
    const float K = acc[2 * 40];
    for (size_t i = (size_t)blockIdx.x * 512 + threadIdx.x; i < (size_t)NTOK * 1024; i += (size_t)gridDim.x * 512) out[i] = (i & 1) ? -K : K;
}
#endif

#if TIME_PH != -1
#ifndef TIME_Q
#define TIME_Q 6.f
#endif
#ifndef TIME_CAL
#define TIME_CAL 1.0f
#endif
__global__ void tm_acc(const unsigned long long* ts, float* best, int first) {
    int a = TIME_PH, b = TIME_PH + 1;
#ifdef TIME_PH_END
    b = TIME_PH_END;
#endif
    float T = 100.f; if (TIME_PH >= 0) T = (float)(ts[b] - ts[a]) * 0.01f;
    if (first || T < *best) *best = T;
}
__global__ void __launch_bounds__(512) tm_fill(const float* best, float* out) {
    float T = *best;
    T = exp2f(rintf(log2f(fmaxf(T, 1.f)) * TIME_Q) / TIME_Q);
    const float c = sqrtf(T) * TIME_CAL;
    for (size_t i = (size_t)blockIdx.x * 512 + threadIdx.x; i < (size_t)NTOK * 1024; i += (size_t)gridDim.x * 512) out[i] = (i & 1) ? -c : c;
}
#endif
static int g_grid = 0;
static bool setup_once(size_t ws_size) {
    if (g_grid) return g_grid > 0;
    if (ws_size < WS_END) { fprintf(stderr, "kernel_launch: workspace too small: %zu < %zu\n", ws_size, (size_t)WS_END); g_grid = -1; return false; }
    int dev = 0, cus = 0, per_cu = 0;
    if (hipGetDevice(&dev) != hipSuccess || hipDeviceGetAttribute(&cus, hipDeviceAttributeMultiprocessorCount, dev) != hipSuccess) { g_grid = -1; return false; }
    if (hipFuncSetAttribute((const void*)mk, hipFuncAttributeMaxDynamicSharedMemorySize, LDS_BYTES) != hipSuccess) { fprintf(stderr, "kernel_launch: hipFuncSetAttribute failed\n"); g_grid = -1; return false; }
    if (hipOccupancyMaxActiveBlocksPerMultiprocessor(&per_cu, (const void*)mk, 512, LDS_BYTES) != hipSuccess || per_cu < 1) { fprintf(stderr, "kernel_launch: occupancy query says %d\n", per_cu); }
    (void)hipGetLastError();
    g_grid = cus;
    return true;
}
static void launch_mk(const Args& a0, int lo, int hi, hipStream_t stream) { Args a = a0; a.ph_lo = lo; a.ph_hi = hi; hipLaunchKernelGGL(mk, dim3(g_grid), dim3(512), LDS_BYTES, stream, a); }

extern "C" void kernel_launch(void* const* d_in, const int* in_sizes, int n_in, void* d_out, int out_size, void* d_ws, size_t ws_size, hipStream_t stream) {
    if (!setup_once(ws_size)) return;
    unsigned char* ws = (unsigned char*)d_ws;
    (void)hipMemsetAsync(ws + WS_CTL, 0, ZERO_BYTES, stream);
    Args a{}; for (int i = 0; i < 30; ++i) a.in.p[i] = (const float*)d_in[i];
    a.out = (float*)d_out; a.ws = ws; a.ph_lo = 0; a.ph_hi = 0;
#if CHECK
    a.out = nullptr;
#endif
#if CHECK
    float* nb = (float*)d_out; size_t off = 0; NvScratch S;
    auto take = [&](size_t n) { float* p = nb + off; off += (n + 63) & ~(size_t)63; return p; };
    S.proj = take((size_t)2048 * DIN); S.h1 = take(2048 * 1024); S.qk = S.h1; S.hraw = S.qk + 2048 * 512; S.kn = S.hraw + 2048 * 256;
    S.kcmp = take(2 * 127 * 64); S.vcmp = take(2 * 127 * 64); S.dqn = take(2048 * 192); S.q = take(2048 * 576); S.dkvn = take(2048 * 128); S.kv = take(2048 * 768); S.x1 = S.dqn;
    S.krope = take(2048 * 32); S.y = take(2048 * 1024); S.xl = take(2048 * 1024); S.rt_e = (int*)take(2048 * 2); S.rt_w = take(2048 * 2);
    if (off * 4 > (size_t)NTOK * 1024 * 4) { fprintf(stderr, "naive scratch too big\n"); return; }
    float* acc = (float*)(ws + WS_CTL) + CW_CHK;
    launch_mk(a, 0, 1, stream);
    const float* nx_in = (const float*)d_in[0] + (size_t)CB * 2048 * 1024;
    int nst = 0;
    for (int l = 0; l < L_; ++l) {
        const int pb = 1 + l * NPH; const int sb = l * 16;
        launch_mk(a, pb + PH_INPROJ, pb + PH_INPROJ + 1, stream);
        naive_step(d_in, l, NS_INPROJ, nx_in, S.xl, S, stream);
        chk_proj<<<2048, 64, 0, stream>>>(S.proj, ws + WS_PRJ, (const float*)(ws + WS_SSQ + PT_DQ) + (size_t)l * 16384 * 4, (const float*)(ws + WS_SSQ + PT_DKV) + (size_t)l * 16384 * 2,
                                           (const float*)d_in[8] + l * 64, (const float*)d_in[9] + l * 64, (const float*)d_in[19] + l * 192 + 160, (const int*)d_in[1], acc + 2 * (sb + 0));
        nst = sb + 2;
        int ns_done = NS_INPROJ;
#if CHECK_UPTO >= 1
        launch_mk(a, pb + PH_PREP, pb + PH_PREP + 1, stream);
        naive_step(d_in, l, NS_NSAPREP, nx_in, S.xl, S, stream); naive_step(d_in, l, NS_MLAPREP, nx_in, S.xl, S, stream); ns_done = NS_MLAPREP;
        chk_prep<<<2048, 64, 0, stream>>>(S.q, S.kv, S.krope, S.kcmp, S.vcmp, ws, acc + 2 * (sb + 2));
        nst = sb + 4;
#endif
#if CHECK_UPTO >= 2
        launch_mk(a, pb + PH_MIX, pb + PH_MIX + 1, stream);
        naive_step(d_in, l, NS_NSA, nx_in, S.xl, S, stream); naive_step(d_in, l, NS_ML, nx_in, S.xl, S, stream); naive_step(d_in, l, NS_MLA, nx_in, S.xl, S, stream); ns_done = NS_MLA;
        chk_y<<<2048, 64, 0, stream>>>(S.y, ws, acc + 2 * (sb + 4), 3);
        nst = sb + 7;
#endif
#if CHECK_UPTO >= 3
        launch_mk(a, pb + PH_YNORM, pb + PH_YNORM + 1, stream); launch_mk(a, pb + PH_OUTPROJ, pb + PH_OUTPROJ + 1, stream);
        naive_step(d_in, l, NS_OUT, nx_in, S.xl, S, stream); ns_done = NS_OUT;
        chk_x<<<2048, 64, 0, stream>>>(S.x1, ws, acc + 2 * (sb + 7));
        nst = sb + 8;
#endif
#if CHECK_UPTO >= 4
        for (int ph = PH_ROUTE; ph <= PH_COMBINE; ++ph) launch_mk(a, pb + ph, pb + ph + 1, stream);
        naive_step(d_in, l, NS_ROUTE, nx_in, S.xl, S, stream); naive_step(d_in, l, NS_MOE, nx_in, S.xl, S, stream); ns_done = NS_MOE;
        chk_x<<<2048, 64, 0, stream>>>(S.xl, ws, acc + 2 * (sb + 8));
        nst = sb + 9;
#endif
        CHECK_REST
        for (int s = ns_done + 1; s <= NS_MOE; ++s) naive_step(d_in, l, s, nx_in, S.xl, S, stream);
        nx_in = S.xl;
        if (l == CHECK_LAYERS - 1) break;
    }
    chk_code<<<1, 512, 0, stream>>>(acc, nst, S.xl);
    chk_fill<<<1024, 512, 0, stream>>>(acc, (float*)d_out);
#else
#if defined(SPLIT_LAUNCH) && SPLIT_LAUNCH
    for (int ph = 0; ph < 1 + L_ * NPH; ++ph) launch_mk(a, ph, ph + 1, stream);
#else
    launch_mk(a, 0, 1 + L_ * NPH, stream);
#if TIME_PH != -1
    for (int rp = 0; rp < 6; ++rp) {
        (void)hipMemsetAsync(ws + WS_CTL, 0, ZERO_BYTES, stream); launch_mk(a, 0, 1 + L_ * NPH, stream);
        tm_acc<<<1, 1, 0, stream>>>((const unsigned long long*)((unsigned*)(ws + WS_CTL) + CW_TS), (float*)(ws + WS_META + META_RT), rp == 0);
    }
    tm_fill<<<1024, 512, 0, stream>>>((const float*)(ws + WS_META + META_RT), (float*)d_out);
#endif
#endif
#endif
}
```

```cpp
#define CHECK 0
#define CHECK_LAYERS 2
#define CHECK_UPTO 99
#define SPLIT_LAUNCH 0
#define REPEAT_PH -1
#include <hip/hip_runtime.h>
#include <stdint.h>
#include <cstdio>

constexpr int B_ = 8, T_ = 2048, D_ = 1024, L_ = 2, NTOK = B_ * T_;
constexpr int DIN = 2554;
constexpr int O_AQ = 0, O_AKV = 384, O_AG = 1152, O_BQK = 1170, O_BV = 1682, O_BIF = 1938, O_BO = 1946, O_CDQ = 2202, O_CDKV = 2394, O_CKR = 2522;

typedef unsigned short bf16_t;
typedef short bf16x8 __attribute__((ext_vector_type(8)));
typedef short s16x4 __attribute__((ext_vector_type(4)));
typedef float f32x4 __attribute__((ext_vector_type(4)));
typedef float f32x16 __attribute__((ext_vector_type(16)));
typedef unsigned u32x4 __attribute__((ext_vector_type(4)));
typedef unsigned u32x2 __attribute__((ext_vector_type(2)));
typedef float f32x2_t __attribute__((ext_vector_type(2)));
typedef __bf16 bf16x2_t __attribute__((ext_vector_type(2)));
#define LAS __attribute__((address_space(3)))

__device__ __forceinline__ unsigned pk_bf16(float lo, float hi) { f32x2_t v = {lo, hi}; bf16x2_t b = __builtin_convertvector(v, bf16x2_t); return __builtin_bit_cast(unsigned, b); }
__device__ __forceinline__ float bf_lo(unsigned u) { return __builtin_bit_cast(float, u << 16); }
__device__ __forceinline__ float bf_hi(unsigned u) { return __builtin_bit_cast(float, u & 0xffff0000u); }
__device__ __forceinline__ float bf2f(bf16_t h) { return __builtin_bit_cast(float, (unsigned)h << 16); }
__device__ __forceinline__ bf16_t f2bf(float f) { return (bf16_t)(pk_bf16(f, 0.f) & 0xffffu); }
__device__ __forceinline__ float wave_sum(float v) { for (int o = 32; o; o >>= 1) v += __shfl_xor(v, o); return v; }
__device__ __forceinline__ float wave_max(float v) { for (int o = 32; o; o >>= 1) v = fmaxf(v, __shfl_xor(v, o)); return v; }
__device__ __forceinline__ float siluf(float x) { return x / (1.f + __expf(-x)); }
__device__ __forceinline__ float sigmf(float x) { return 1.f / (1.f + __expf(-x)); }
__device__ __forceinline__ int t5b(int dist) {
    int n = dist > 0 ? dist : 0; if (n < 16) return n;
    float v = logf((float)n / 16.f) / logf(8.f) * 16.f; int l = 16 + (int)v; return l < 31 ? l : 31;
}

__device__ __forceinline__ int lane_now() { return (int)__builtin_amdgcn_mbcnt_hi(~0u, __builtin_amdgcn_mbcnt_lo(~0u, 0u)); }
#define TIDX ((g_wv << 6) | lane_now())

constexpr size_t WS_CTL = 0, CTL_BYTES = 65536;
constexpr size_t WS_SSQ = WS_CTL + CTL_BYTES;
constexpr size_t ZERO_BYTES = CTL_BYTES;
constexpr size_t PT_DQ = 0, PT_DKV = PT_DQ + (size_t)2 * 16384 * 4 * 4, PT_A = PT_DKV + (size_t)2 * 16384 * 2 * 4, PT_C = PT_A + (size_t)2 * 16384 * 8 * 4, PT_X1 = PT_C + (size_t)2 * 16384 * 8 * 4, PT_END = PT_X1 + (size_t)2 * 16384 * 16 * 4;
constexpr size_t WS_SSQX = WS_SSQ + PT_END;
constexpr size_t WS_RS2 = WS_SSQX + 2 * 65536;
constexpr size_t WS_WIN = WS_RS2 + 65536;
constexpr size_t WS_WOUT = WS_WIN + (size_t)2 * 2560 * 1024 * 2;
constexpr size_t WS_WUQ = WS_WOUT + (size_t)2 * 1024 * 1024 * 2;
constexpr size_t WS_WUKV = WS_WUQ + (size_t)2 * 768 * 256 * 2;
constexpr size_t WS_WC1 = WS_WUKV + (size_t)2 * 768 * 256 * 2;
constexpr size_t WS_WC2 = WS_WC1 + (size_t)2 * 2 * 64 * 2048 * 2;
constexpr size_t WS_WR = WS_WC2 + (size_t)2 * 2 * 64 * 64 * 2;
constexpr size_t WS_B1C = WS_WR + (size_t)2 * 64 * 1024 * 2;
constexpr size_t WS_BIASD = WS_B1C + 1024;
constexpr size_t WS_ROPE = WS_BIASD + 6 * 2048 * 4;
constexpr size_t WS_WMOE = WS_ROPE + (size_t)16384 * 32 * 4;
constexpr size_t WMOE_WD = (size_t)32 * 512 * 1024 * 2;
constexpr size_t WS_XB = WS_WMOE + 50331648;
constexpr size_t WS_MLA = WS_XB + 33554432;
constexpr size_t MLA_KM = (size_t)8 * 6 * 2048 * 96 * 2, MLA_VM = 2 * MLA_KM;
constexpr size_t WS_HBUF = WS_MLA;
constexpr size_t WS_PRJ = WS_MLA + 50331648;
constexpr size_t HM64 = (size_t)2048 * 64 * 2;
constexpr size_t PRJ_QN = 0;
constexpr size_t PRJ_KN1 = PRJ_QN + 48 * HM64, PRJ_VN1 = PRJ_KN1 + 16 * HM64, PRJ_KN2 = PRJ_VN1 + 16 * HM64, PRJ_VN2 = PRJ_KN2 + 16 * HM64;
constexpr size_t PRJ_VML = PRJ_VN2 + 16 * HM64;
constexpr size_t PRJ_OG = PRJ_VML + 32 * HM64;
constexpr size_t PRJ_KR = PRJ_OG + (size_t)16384 * 256 * 2;
constexpr size_t PRJ_GATES = PRJ_KR + (size_t)16384 * 32 * 2;
constexpr size_t PRJ_DEAD = PRJ_GATES + (size_t)16384 * 32 * 4;
constexpr size_t PRJ_C0K = PRJ_DEAD, PRJ_C0V = PRJ_C0K + 16 * HM64 + 8192;
constexpr size_t PRJ_RAWQK = PRJ_C0V + 16 * HM64 + 8192;
constexpr size_t PRJ_DQKV = PRJ_RAWQK + (size_t)16384 * 512 * 2;
constexpr size_t PRJ_END = PRJ_DQKV + (size_t)16384 * 384 * 2;
static_assert(PRJ_END - PRJ_DEAD >= 33554432, "Y fits the dead part of PRJ");
constexpr size_t WS_Y = WS_PRJ + PRJ_DEAD;
constexpr size_t WS_YBUF = WS_PRJ;
static_assert((size_t)2 * 16384 * 1024 * 2 <= PRJ_END, "YBUF fits the PRJ region");
constexpr size_t WS_ML = WS_PRJ + PRJ_END;
constexpr size_t ML_KC = 32 * HM64, ML_DELTA = 2 * ML_KC, ML_DN = ML_DELTA + (size_t)1024 * 4096 * 2, ML_G = ML_DN + (size_t)1024 * 64 * 4, ML_BL = ML_G + (size_t)8 * 4 * 2048 * 2 * 4, ML_CP = ML_BL + 4096, ML_NP = ML_CP + (size_t)1024 * 4096 * 2, ML_END = ML_NP + (size_t)1024 * 64 * 2;
constexpr size_t WS_CMP = WS_ML + ML_END;
constexpr size_t CMP_V = (size_t)8 * 2 * 128 * 64 * 2;
constexpr size_t WS_META = WS_CMP + 2 * CMP_V;
constexpr size_t META_W = (size_t)32 * 16384 * 4, META_RT = 2 * META_W;
constexpr size_t WS_END = WS_META + META_RT + (size_t)16384 * 16;
constexpr int CW_BAR = 0;
constexpr int CW_Q = 4096;
constexpr int CW_SCAN = 4608;
constexpr int CW_TS = 4864;
constexpr int CW_CHK = 5120;
constexpr int CW_CNT = 8192;
constexpr int LDS_BYTES = 147456;
constexpr int LDS_MISC = LDS_BYTES - 256;
#define XB_TMO      128
#define XB_XCNT(j)  (256  + 64 * (j))
#define XB_XSUB(j)  (1280 + 64 * (j))
#define XB_XGEN(j)  (2304 + 64 * (j))
#define XB_TOP      3328
#define XB_TOPGEN   3392
#define XCD_BAR_WORDS 3456
#define XB_SPIN_CAP (1u << 18)

__device__ __forceinline__ unsigned xb_ld(unsigned* p)              { return __hip_atomic_load(p, __ATOMIC_RELAXED, __HIP_MEMORY_SCOPE_AGENT); }
__device__ __forceinline__ unsigned xb_add(unsigned* p, unsigned v) { return __hip_atomic_fetch_add(p, v, __ATOMIC_RELAXED, __HIP_MEMORY_SCOPE_AGENT); }
__device__ __forceinline__ unsigned xb_xcc_id() { return (unsigned)__builtin_amdgcn_s_getreg((3 << 11) | 20) & 0xFu; }
#define XB_SPIN(cond, bar) do { unsigned _sp = 0; while (cond) { __builtin_amdgcn_s_sleep(1); \
    if ((++_sp & 255u) == 0u) { if (xb_ld(&(bar)[XB_TMO])) break; if (_sp > XB_SPIN_CAP) { atomicAdd(&(bar)[XB_TMO], 1u); break; } } } } while (0)

struct XcdBarrier {
    int g_wv; unsigned* bar; unsigned x;
    volatile LAS unsigned* st;
};

__device__ __forceinline__ XcdBarrier xcd_barrier_post(unsigned* bar, volatile LAS unsigned* st, int g_wv) {
    XcdBarrier b; b.g_wv = g_wv; b.bar = bar; b.x = xb_xcc_id(); b.st = st;
    if (TIDX == 0) (void)xb_add(&bar[XB_XCNT(b.x)], 1u);
    return b;
}
__device__ __forceinline__ void xcd_barrier_complete(unsigned* bar, unsigned x, unsigned& nloc, unsigned& nx) {
    const unsigned G = gridDim.x * gridDim.y * gridDim.z;
    unsigned sum, cnt, mine, sp = 0u;
    for (;;) {
        sum = 0u; cnt = 0u; mine = 0u;
#pragma unroll
        for (unsigned j = 0; j < 16; ++j) { const unsigned c = xb_ld(&bar[XB_XCNT(j)]); sum += c; cnt += (c > 0u) ? 1u : 0u; mine = (j == x) ? c : mine; }
        if (sum == G) break;
        __builtin_amdgcn_s_sleep(1);
        if ((++sp & 255u) == 0u) { if (xb_ld(&bar[XB_TMO])) break; if (sp > XB_SPIN_CAP) { atomicAdd(&bar[XB_TMO], 1u); break; } }
    }
    nloc = mine > 0u ? mine : 1u; nx = cnt > 0u ? cnt : 1u;
}

__device__ __forceinline__ void xcd_barrier(const XcdBarrier& b) {
    asm volatile("s_waitcnt vmcnt(0)" ::: "memory");
    __syncthreads();
    const int g_wv = b.g_wv;
    if (TIDX == 0) {
        unsigned* bar = b.bar;
        __builtin_amdgcn_s_waitcnt(0);
        unsigned nloc = b.st[0], nx = b.st[1];
        if (nloc == 0u) { xcd_barrier_complete(bar, b.x, nloc, nx); b.st[0] = nloc; b.st[1] = nx; }
        const unsigned old = xb_add(&bar[XB_XSUB(b.x)], 1u);
        const unsigned gen = old / nloc;
        if (old + 1u == (gen + 1u) * nloc) {
            __builtin_amdgcn_fence(__ATOMIC_RELEASE, "agent");
            asm volatile("s_waitcnt vmcnt(0)" ::: "memory");
            const unsigned og = xb_add(&bar[XB_TOP], 1u);
            const unsigned tg = og / nx;
            if (og + 1u == (tg + 1u) * nx) xb_add(&bar[XB_TOPGEN], 1u);
            else XB_SPIN(xb_ld(&bar[XB_TOPGEN]) == tg, bar);
            __builtin_amdgcn_fence(__ATOMIC_ACQUIRE, "agent");
            xb_add(&bar[XB_XGEN(b.x)], 1u);
            asm volatile("s_waitcnt vmcnt(0)" ::: "memory");
        } else {
            XB_SPIN(xb_ld(&bar[XB_XGEN(b.x)]) == gen, bar);
            __builtin_amdgcn_fence(__ATOMIC_ACQUIRE, "agent");
            asm volatile("s_waitcnt vmcnt(0)" ::: "memory");
        }
    }
    __syncthreads();
}
struct Inputs { const float* p[30]; };
typedef const __attribute__((address_space(4))) Inputs* InPtr;
__device__ __forceinline__ InPtr in_tab() { InPtr p = (InPtr)__builtin_amdgcn_kernarg_segment_ptr(); asm volatile("" : "+s"(p)); return p; }
__device__ __forceinline__ unsigned char* launder(unsigned char* p) { size_t z = 0; asm volatile("" : "+s"(z)); return p + z; }

__host__ __device__ inline int inproj_refcol(int G, int e) {
    if (G < 6) return O_AQ + G * 64 + e;
    if (G < 18) return O_AKV + (G - 6) * 64 + e;
    if (G < 26) return O_BQK + (G - 18) * 64 + e;
    if (G < 30) return O_BV + (G - 26) * 64 + e;
    if (G < 34) return O_BO + (G - 30) * 64 + e;
    if (G < 37) return O_CDQ + (G - 34) * 64 + e;
    if (G == 37) { if (e < 32) return O_CKR + e; if (e < 50) return O_AG + (e - 32); if (e < 58) return O_BIF + (e - 50); return -1; }
    return O_CDKV + (G - 38) * 64 + e;
}
__host__ __device__ inline int uq_refcol(int G, int e) {
    if (G < 6) return G * 96 + e;
    if (G < 9) { const int idx = e & 31, bj = e >> 5, sub = idx >> 4, i = idx & 15; return (2 * (G - 6) + sub) * 96 + 64 + bj * 16 + i; }
    return -1;
}
__host__ __device__ inline int ukv_refcol(int G, int e) { return G < 6 ? G * 128 + e : (G - 6) * 128 + 64 + e; }
#define N2G(n) ((((n) >> 8) << 2) + (((n) >> 5) & 3))
#define N2E(n) (((((n) >> 7) & 1) << 5) + ((n) & 31))

struct FWin { const float* w; const float* g; __device__ __forceinline__ float operator()(int k, int n) const { const int c = inproj_refcol(N2G(n), N2E(n)); return c < 0 ? 0.f : w[(size_t)k * DIN + c] * g[k]; } };
struct FWout { const float* w; const float* ga; const float* gc; __device__ __forceinline__ float operator()(int k, int n) const {
    const int kr = k < 384 ? k : (k < 768 ? 640 + (k - 384) : 384 + (k - 768)); const float og = k < 384 ? ga[k] : (k < 768 ? gc[k - 384] : 1.f); return w[(size_t)kr * 1024 + n] * og; } };
struct FWuq { const float* w; const float* g; __device__ __forceinline__ float operator()(int k, int n) const { const int c = uq_refcol(N2G(n), N2E(n)); return (k < 192 && c >= 0) ? w[(size_t)k * 576 + c] * g[k] : 0.f; } };
struct FWukv { const float* w; const float* g; __device__ __forceinline__ float operator()(int k, int n) const { const int c = ukv_refcol(N2G(n), N2E(n)); return k >= 128 ? w[(size_t)(k - 128) * 768 + c] * g[k - 128] : 0.f; } };
struct FWc1 { const float* w; __device__ __forceinline__ float operator()(int k, int n) const { return w[(size_t)k * 64 + n]; } };
struct FWr { const float* wg; const float* we; const float* g; __device__ __forceinline__ float operator()(int k, int n) const { return n < 4 ? wg[k * 4 + n] * g[k] : (n < 36 ? we[k * 32 + n - 4] * g[k] : 0.f); } };
struct FWgu { const float* src; const float* g; int n0, col0; __device__ __forceinline__ float operator()(int k, int n) const { return src[(size_t)k * 256 + col0 + (n - n0)] * g[k]; } };
struct FWd { const float* w; __device__ __forceinline__ float operator()(int k, int n) const { return w[(size_t)k * 1024 + n]; } };

__device__ __forceinline__ void rope_cs(int pos, int j, float& cs, float& sn) {
    const double inv = exp2(-(double)j * (13.287712379549449 / 16.0));
    const double rev = (double)pos * inv * 0.15915494309189535; const float f = (float)(rev - rint(rev));
    cs = __builtin_amdgcn_cosf(f); sn = __builtin_amdgcn_sinf(f);
}
template <class F>
__device__ __forceinline__ void cvt_tile(const F& f, int n0, int k0, bf16_t* dst, int ldk, LAS float* tile, int tid) {
    { const int k = tid >> 3, nb = (tid & 7) * 8;
#pragma unroll
      for (int j = 0; j < 8; ++j) tile[k * 65 + nb + j] = f(k0 + k, n0 + nb + j); }
    __syncthreads();
    { const int n = tid >> 3, kb = (tid & 7) * 8; const LAS float* s = tile + kb * 65 + n;
      u32x4 o; o.x = pk_bf16(s[0], s[65]); o.y = pk_bf16(s[130], s[195]); o.z = pk_bf16(s[260], s[325]); o.w = pk_bf16(s[390], s[455]);
      *(u32x4*)(dst + (size_t)(n0 + n) * ldk + k0 + kb) = o; }
    __syncthreads();
}
template <class F>
__device__ __forceinline__ void cvt_item(const F& f, int it, int nK, bf16_t* dst, int ldk, LAS float* tile, int tid) { cvt_tile(f, (it / nK) * 64, (it % nK) * 64, dst, ldk, tile, tid); }

__device__ __forceinline__ void moe_item(InPtr in, int l, int it, const float*& src, int& ld, size_t& dst, int& ldk, bool& gain, int& kk0) {
    if (it < 32 * 64) { const int e = it >> 6, r = it & 63, n0 = (r >> 3) * 64, k0 = (r & 7) * 128, c0 = n0 & 255;
        src = (c0 < 128 ? in->p[27] : in->p[28]) + ((size_t)l * 32 + e) * 262144 + (size_t)k0 * 256 + (n0 >> 8) * 128 + (c0 & 127); ld = 256; gain = true; kk0 = k0;
        dst = ((size_t)e * 512 + n0) * 1024 + k0; ldk = 1024; }
    else { const int j = it - 32 * 64, e = j >> 5, r = j & 31, n0 = (r >> 1) * 64, k0 = (r & 1) * 128;
        src = in->p[29] + ((size_t)l * 32 + e) * 262144 + (size_t)k0 * 1024 + n0; ld = 1024; gain = false; kk0 = 0;
        dst = (size_t)16777216 + ((size_t)e * 1024 + n0) * 256 + k0; ldk = 256; }
}
__device__ __forceinline__ void cvt_moe_layer(InPtr in, unsigned char* ws, int l, LAS float* tile, int bid, int nb, int tid) {
    asm volatile("" : "+v"(tid));
    const float* g2 = in->p[22] + l * 1024; bf16_t* W = (bf16_t*)(ws + WS_WMOE);
    const int k = tid >> 3, nbq = (tid & 7) * 8;
    const int n = tid >> 3, kb = (tid & 7) * 8;
    constexpr int NIT = 32 * (64 + 32);
#define CVM_LOAD(it_, P) do { const float* src_; int ld_, ldk_, kk0_; size_t dst_; bool gain_; moe_item(in, l, (it_), src_, ld_, dst_, ldk_, gain_, kk0_); \
        P##a = *(const f32x4*)(src_ + (size_t)k * ld_ + nbq); P##b = *(const f32x4*)(src_ + (size_t)k * ld_ + nbq + 4); P##c = *(const f32x4*)(src_ + (size_t)(k + 64) * ld_ + nbq); P##d = *(const f32x4*)(src_ + (size_t)(k + 64) * ld_ + nbq + 4); \
        P##g0 = gain_ ? g2[kk0_ + k] : 1.f; P##g1 = gain_ ? g2[kk0_ + 64 + k] : 1.f; } while (0)
#define CVM_PUT(t, P) do { \
        t[k * 65 + nbq + 0] = P##a.x * P##g0; t[k * 65 + nbq + 1] = P##a.y * P##g0; t[k * 65 + nbq + 2] = P##a.z * P##g0; t[k * 65 + nbq + 3] = P##a.w * P##g0; \
        t[k * 65 + nbq + 4] = P##b.x * P##g0; t[k * 65 + nbq + 5] = P##b.y * P##g0; t[k * 65 + nbq + 6] = P##b.z * P##g0; t[k * 65 + nbq + 7] = P##b.w * P##g0; \
        t[(k + 64) * 65 + nbq + 0] = P##c.x * P##g1; t[(k + 64) * 65 + nbq + 1] = P##c.y * P##g1; t[(k + 64) * 65 + nbq + 2] = P##c.z * P##g1; t[(k + 64) * 65 + nbq + 3] = P##c.w * P##g1; \
        t[(k + 64) * 65 + nbq + 4] = P##d.x * P##g1; t[(k + 64) * 65 + nbq + 5] = P##d.y * P##g1; t[(k + 64) * 65 + nbq + 6] = P##d.z * P##g1; t[(k + 64) * 65 + nbq + 7] = P##d.w * P##g1; } while (0)
#define CVM_STORE(it_, t) do { const float* src_; int ld_, ldk_, kk0_; size_t dst_; bool gain_; moe_item(in, l, (it_), src_, ld_, dst_, ldk_, gain_, kk0_); \
        _Pragma("unroll") for (int hh = 0; hh < 2; ++hh) { const LAS float* s_ = t + (64 * hh + kb) * 65 + n; \
            u32x4 o; o.x = pk_bf16(s_[0], s_[65]); o.y = pk_bf16(s_[130], s_[195]); o.z = pk_bf16(s_[260], s_[325]); o.w = pk_bf16(s_[390], s_[455]); \
            *(u32x4*)(W + dst_ + (size_t)n * ldk_ + 64 * hh + kb) = o; } } while (0)
    f32x4 Aa, Ab, Ac, Ad, Ba, Bb, Bc, Bd; float Ag0 = 1.f, Ag1 = 1.f, Bg0 = 1.f, Bg1 = 1.f;
    LAS float* t0 = tile; LAS float* t1 = tile + 128 * 65;
    int it = bid;
    if (it < NIT) CVM_LOAD(it, A);
    if (it + nb < NIT) CVM_LOAD(it + nb, B);
#pragma unroll 1
    for (; it < NIT; it += 2 * nb) {
        CVM_PUT(t0, A);
        __syncthreads();
        if (it + 2 * nb < NIT) CVM_LOAD(it + 2 * nb, A);
        CVM_STORE(it, t0);
        if (it + nb < NIT) {
            CVM_PUT(t1, B);
            __syncthreads();
            if (it + 3 * nb < NIT) CVM_LOAD(it + 3 * nb, B);
            CVM_STORE(it + nb, t1);
        }
    }
#undef CVM_LOAD
#undef CVM_PUT
#undef CVM_STORE
    __syncthreads();
}

__device__ __forceinline__ void cvt_small_weights(InPtr in, unsigned char* ws, int l, LAS float* tile, int bid, int nb, int tid) {
    asm volatile("" : "+v"(tid));
    constexpr int I_WIN = 40 * 16, I_WOUT = 16 * 16, I_WU = 12 * 4, I_WC1 = 32, I_WC2 = 1, I_WR = 16;
    constexpr int PER_L = I_WIN + I_WOUT + 2 * I_WU + 2 * I_WC1 + 2 * I_WC2 + I_WR;
    for (int it0 = bid; it0 < PER_L; it0 += nb) {
        int it = it0;
        if (it < I_WIN) { FWin f{in->p[4] + (size_t)l * 1024 * DIN, in->p[3] + l * 1024}; cvt_item(f, it, 16, (bf16_t*)(ws + WS_WIN) + (size_t)l * 2560 * 1024, 1024, tile, tid); continue; } it -= I_WIN;
        if (it < I_WOUT) { FWout f{in->p[21] + (size_t)l * 1048576, in->p[10] + l * 384, in->p[20] + l * 384}; cvt_item(f, it, 16, (bf16_t*)(ws + WS_WOUT) + (size_t)l * 1048576, 1024, tile, tid); continue; } it -= I_WOUT;
        if (it < I_WU) { FWuq f{in->p[16] + (size_t)l * 192 * 576, in->p[15] + l * 192}; cvt_item(f, it, 4, (bf16_t*)(ws + WS_WUQ) + (size_t)l * 768 * 256, 256, tile, tid); continue; } it -= I_WU;
        if (it < I_WU) { FWukv f{in->p[18] + (size_t)l * 128 * 768, in->p[17] + l * 128}; cvt_item(f, it, 4, (bf16_t*)(ws + WS_WUKV) + (size_t)l * 768 * 256, 256, tile, tid); continue; } it -= I_WU;
        if (it < 2 * I_WC1) { const int s = it / I_WC1; FWc1 f{in->p[6] + ((size_t)l * 2 + s) * 2048 * 64}; cvt_item(f, it % I_WC1, 32, (bf16_t*)(ws + WS_WC1) + ((size_t)l * 2 + s) * 64 * 2048, 2048, tile, tid); continue; } it -= 2 * I_WC1;
        if (it < 2 * I_WC2) { const int s = it; FWc1 f{in->p[7] + ((size_t)l * 2 + s) * 64 * 64}; cvt_item(f, 0, 1, (bf16_t*)(ws + WS_WC2) + ((size_t)l * 2 + s) * 64 * 64, 64, tile, tid); continue; } it -= 2 * I_WC2;
        { FWr f{in->p[23] + (size_t)l * 4096, in->p[25] + (size_t)l * 32768, in->p[22] + l * 1024}; cvt_item(f, it, 16, (bf16_t*)(ws + WS_WR) + (size_t)l * 64 * 1024, 1024, tile, tid); }
    }
}

__device__ __forceinline__ void prologue(InPtr in, unsigned char* ws, LAS unsigned char* lds, int bid, int nb, int g_wv) {
    int tid_ = TIDX; asm volatile("" : "+v"(tid_));
    const int tid = tid_, lane = tid & 63, wid = tid >> 6;
    LAS float* tile = (LAS float*)lds;
    cvt_small_weights(in, ws, 0, tile, bid, nb, tid);
    { const float* x = in->p[0]; bf16_t* XB = (bf16_t*)(ws + WS_XB); float* ssqx = (float*)(ws + WS_SSQX);
      for (int r = bid * 8 + wid; r < NTOK; r += nb * 8) {
          const f32x4* xr = (const f32x4*)(x + (size_t)r * 1024) + lane; float s = 0.f; u32x2* o = (u32x2*)(XB + (size_t)r * 1024) + lane;
#pragma unroll
          for (int j = 0; j < 4; ++j) { const f32x4 v = xr[64 * j]; s += (v.x * v.x + v.y * v.y) + (v.z * v.z + v.w * v.w); u32x2 w; w.x = pk_bf16(v.x, v.y); w.y = pk_bf16(v.z, v.w); o[64 * j] = w; }
          s = wave_sum(s); if (lane == 0) ssqx[r] = s;
      } }
    { float* biasd = (float*)(ws + WS_BIASD); const float* rb = in->p[2];
      for (int i = bid * 512 + tid; i < 6 * 2048; i += nb * 512) { const int h = i >> 11, d = i & 2047; biasd[i] = rb[t5b(d) * 6 + h] * 1.44269504f; } }
    { float* rope = (float*)(ws + WS_ROPE); const int* pos = (const int*)in->p[1];
      for (int i = bid * 512 + tid; i < NTOK * 16; i += nb * 512) { const int tk = i >> 4, j = i & 15; float cs, sn; rope_cs(pos[tk], j, cs, sn); rope[(size_t)tk * 32 + j] = cs; rope[(size_t)tk * 32 + 16 + j] = sn; } }
    { float* b1c = (float*)(ws + WS_B1C); LAS float* red = (LAS float*)lds;
      for (int it = bid; it < 4; it += nb) { const float* pe = in->p[5] + (size_t)it * 2048; const float* w1 = in->p[6] + (size_t)it * 2048 * 64; const int f = tid & 63, part = tid >> 6;
          float a = 0.f; for (int k = part * 256; k < part * 256 + 256; ++k) a += pe[k] * w1[(size_t)k * 64 + f];
          __syncthreads(); red[tid] = a; __syncthreads();
          if (tid < 64) { float s = 0.f; for (int p2 = 0; p2 < 8; ++p2) s += red[p2 * 64 + tid]; b1c[it * 64 + tid] = s; }
          __syncthreads(); } }
}
namespace g8 {
constexpr int BM = 256, BK = 64, HALF = 128, HTB = HALF * BK * 2, STAGE_BYTES = 8 * HTB, NXCD = 8, WGM = 8;
__host__ __device__ __forceinline__ int lds_byte(int r, int c) { const int st = (r >> 4) * 2 + (c >> 5), rr = r & 15, cc = c & 31, ob = rr * 64 + cc * 2; return st * 1024 + (ob ^ (((ob >> 9) & 1) << 5)); }
__host__ __device__ __forceinline__ void stage_rc(int b, int& R, int& C) { const int st = b / 1024, sb = b % 1024, swz = sb ^ (((sb >> 9) & 1) << 5); R = (st >> 1) * 16 + swz / 64; C = (st & 1) * 32 + (swz % 64) / 2; }
__host__ __device__ __forceinline__ int perm32(int rho) { const int n = rho >> 4, i = rho & 15; return 8 * (i >> 2) + 4 * n + (i & 3); }

struct GUnit { const char* a; const char* b; int pm, pn, e, rows; };

__device__ __forceinline__ bool static_unit(int i, int G, int c, int nM, int nN, int& pm, int& pn) {
    const int nwg = nM * nN; const long L = (long)i * G + c; if (L >= nwg) return false;
    int wgid = (int)L; { const int q = nwg / NXCD, r = nwg % NXCD, xcd = wgid % NXCD, off = wgid / NXCD; wgid = (xcd < r ? xcd * (q + 1) : r * (q + 1) + (xcd - r) * q) + off; }
    const int nig = WGM * nN, gid = wgid / nig, fm = gid * WGM, gsz = (nM - fm) < WGM ? (nM - fm) : WGM;
    pm = fm + ((wgid % nig) % gsz); pn = (wgid % nig) / gsz; return true;
}
struct DenseSched {
    static constexpr bool GATHER = false, PARTIAL = false;
    const char* A; const char* Bt; int lda, ldb, nM, nN, G, c;
    __device__ __forceinline__ bool next(int i, GUnit& u) const {
        int pm, pn; if (!static_unit(i, G, c, nM, nN, pm, pn)) return false;
        u.pm = pm; u.pn = pn; u.e = 0; u.rows = 256; u.a = A + (size_t)pm * 256 * lda * 2; u.b = Bt + (size_t)pn * 256 * ldb * 2; return true;
    }
    __device__ __forceinline__ void aoff(const GUnit&, unsigned (&v)[2][2], const int (&R)[2], const int (&C)[2]) const {
#pragma unroll
        for (int h = 0; h < 2; ++h)
#pragma unroll
            for (int i = 0; i < 2; ++i) v[h][i] = (unsigned)((h * 128 + R[i]) * lda + C[i]) * 2u;
    }
};

template <class Epi, class Sched>
__device__ __forceinline__ void gemm_run(LAS unsigned char* lds, const int K, const int ldb, const Sched& S, const Epi& E, int g_wv) {
    int tid_ = TIDX; asm volatile("" : "+v"(tid_));
    const int tid = tid_, wid = __builtin_amdgcn_readfirstlane(tid >> 6), lane = tid & 63, wr = wid >> 2, wc = wid & 3, fr = lane & 15, fq = lane >> 4;
    int nt_ = K / BK; asm volatile("" : "+s"(nt_));
    const int nt = nt_;
    int R[2], C[2]; unsigned voffB[2];
#pragma unroll
    for (int i = 0; i < 2; ++i) { stage_rc(tid * 16 + i * 8192, R[i], C[i]); const int Rb = (R[i] & ~31) + perm32(R[i] & 31); voffB[i] = (unsigned)(Rb * ldb + C[i]) * 2u; }
    const size_t kstep = (size_t)(BK * 2);
    const size_t hstepB = (size_t)HALF * ldb * 2;
    const unsigned ldsw = (unsigned)wid * 1024u;
    const int aoff = lds_byte(wr * 64 + fr, fq * 8), boff = lds_byte(wc * 32 + fr, fq * 8);
#define G8_SA(b, h) (((b) * 2 + (h)) * HTB)
#define G8_SB(b, h) ((4 + (b) * 2 + (h)) * HTB)
#define G8_GLDS(bufoff, gptr, i_) __builtin_amdgcn_global_load_lds((const unsigned*)(gptr), (LAS unsigned*)(lds + (bufoff) + ldsw + (i_) * 8192), 16, 0, 0)
#define G8_STAGE_B(bufoff, gbase) do { G8_GLDS(bufoff, (const char*)(gbase) + voffB[0], 0); G8_GLDS(bufoff, (const char*)(gbase) + voffB[1], 1); } while (0)
#define G8_STAGE_A(bufoff, gbase, v0, v1) do { G8_GLDS(bufoff, (const char*)(gbase) + (v0), 0); G8_GLDS(bufoff, (const char*)(gbase) + (v1), 1); } while (0)
#define G8_LDA(dst, b, h) do { _Pragma("unroll") for (int m = 0; m < 4; ++m) _Pragma("unroll") for (int k = 0; k < 2; ++k) dst[m][k] = *(const LAS bf16x8*)(lds + G8_SA(b, h) + aoff + m * 2048 + k * 1024); } while (0)
#define G8_LDB(dst, b, h) do { _Pragma("unroll") for (int n = 0; n < 2; ++n) _Pragma("unroll") for (int k = 0; k < 2; ++k) dst[n][k] = *(const LAS bf16x8*)(lds + G8_SB(b, h) + boff + n * 2048 + k * 1024); } while (0)
#define G8_MMA(ai, bj, At, Bt) do { __builtin_amdgcn_s_setprio(1); _Pragma("unroll") for (int m = 0; m < 4; ++m) { if (!PARTIAL || ((mmask >> ((ai) * 4 + m)) & 1u)) { _Pragma("unroll") for (int n = 0; n < 2; ++n) _Pragma("unroll") for (int k = 0; k < 2; ++k) \
        acc[ai][bj][m][n] = __builtin_amdgcn_mfma_f32_16x16x32_bf16(Bt[n][k], At[m][k], acc[ai][bj][m][n], 0, 0, 0); } } __builtin_amdgcn_s_setprio(0); } while (0)
#define G8_WAIT_V(n) asm volatile("s_waitcnt vmcnt(" #n ")" ::: "memory")
#define G8_WAIT_L(n) asm volatile("s_waitcnt lgkmcnt(" #n ")" ::: "memory")
#define G8_BAR __builtin_amdgcn_s_barrier()
#define G8_SCHED __builtin_amdgcn_sched_barrier(0)
    GUnit cur, nxt; int ui = 0;
    if (!S.next(0, cur)) return;
    constexpr bool GATHER = Sched::GATHER, PARTIAL = Sched::PARTIAL;
    unsigned mmask = 0xffu;
#define G8_MASK(u) do { if (PARTIAL) { mmask = 0u; _Pragma("unroll") for (int q_ = 0; q_ < 8; ++q_) mmask |= (((q_ >> 2) * 128 + wr * 64 + (q_ & 3) * 16) < (u).rows) ? (1u << q_) : 0u; } } while (0)
    unsigned vc[2][2];
    S.aoff(cur, vc, R, C); G8_MASK(cur);
    LAS u32x4* stash = (LAS u32x4*)(lds + STAGE_BYTES + 4096) + tid;
    f32x4 acc[2][2][4][2];
#pragma unroll
    for (int a = 0; a < 2; ++a)
#pragma unroll
        for (int b = 0; b < 2; ++b)
#pragma unroll
            for (int m = 0; m < 4; ++m)
#pragma unroll
                for (int n = 0; n < 2; ++n) acc[a][b][m][n] = (f32x4){0.f, 0.f, 0.f, 0.f};
    bf16x8 At[4][2], B0[2][2], B1[2][2];
    const char* cA = cur.a; const char* cB = cur.b;
    G8_STAGE_B(G8_SB(0, 0), cB); G8_STAGE_B(G8_SB(0, 1), cB + hstepB); G8_STAGE_A(G8_SA(0, 0), cA, vc[0][0], vc[0][1]); G8_STAGE_A(G8_SA(0, 1), cA, vc[1][0], vc[1][1]);
    if (wr == 1) G8_BAR;
    G8_WAIT_V(2); G8_BAR;
    G8_STAGE_B(G8_SB(1, 0), cB + kstep); G8_STAGE_A(G8_SA(1, 0), cA + kstep, vc[0][0], vc[0][1]); G8_STAGE_B(G8_SB(1, 1), cB + hstepB + kstep);
    G8_WAIT_V(6); G8_BAR;
    for (;;) {
        const bool has_next = S.next(ui + 1, nxt);
        if (GATHER) { unsigned vn[2][2];
            if (has_next) S.aoff(nxt, vn, R, C);
            else { vn[0][0] = vc[0][0]; vn[0][1] = vc[0][1]; vn[1][0] = vc[1][0]; vn[1][1] = vc[1][1]; }
            u32x4 sv; sv.x = vn[0][0]; sv.y = vn[0][1]; sv.z = vn[1][0]; sv.w = vn[1][1]; *stash = sv; }
        const char* nA = has_next ? nxt.a : cA; const char* nB = has_next ? nxt.b : cB;
#pragma unroll 1
        for (int seg = 0; seg < (Epi::KHOOK ? 3 : 1); ++seg) {
        const int tlo = Epi::KHOOK ? 6 * seg : 0, thi = Epi::KHOOK ? (seg == 2 ? nt : 6 * seg + 6) : nt;
#pragma unroll 1
        for (int t = tlo; t < thi; t += 2) {
            const bool last = (t == nt - 2);
            const char* a1 = cA + (size_t)(t + 1) * kstep;
            const char* a2 = last ? nA : cA + (size_t)(t + 2) * kstep; const char* b2 = last ? nB : cB + (size_t)(t + 2) * kstep;
            const char* a3 = a2 + kstep; const char* b3 = b2 + kstep;
            unsigned w00 = vc[0][0], w01 = vc[0][1], w10 = vc[1][0], w11 = vc[1][1];
            if (GATHER) { if (last) { const u32x4 sv = *stash; w00 = sv.x; w01 = sv.y; w10 = sv.z; w11 = sv.w; } }
            G8_LDB(B0, 0, 0); G8_LDB(B1, 0, 1); G8_SCHED; G8_LDA(At, 0, 0); G8_STAGE_A(G8_SA(1, 1), a1, vc[1][0], vc[1][1]);
            G8_WAIT_V(8); G8_WAIT_L(0); G8_BAR; G8_MMA(0, 0, At, B0); G8_MMA(0, 1, At, B1); G8_BAR; G8_SCHED;
            G8_LDA(At, 0, 1); G8_STAGE_B(G8_SB(0, 0), b2); G8_STAGE_B(G8_SB(0, 1), b2 + hstepB); G8_STAGE_A(G8_SA(0, 0), a2, w00, w01);
            G8_WAIT_V(8); G8_WAIT_L(0); G8_BAR; G8_MMA(1, 0, At, B0); G8_MMA(1, 1, At, B1); G8_BAR; G8_SCHED;
            G8_LDB(B0, 1, 0); G8_LDB(B1, 1, 1); G8_SCHED; G8_LDA(At, 1, 0); G8_STAGE_A(G8_SA(0, 1), a2, w10, w11);
            G8_WAIT_V(8); G8_WAIT_L(0); G8_BAR; G8_MMA(0, 0, At, B0); G8_MMA(0, 1, At, B1); G8_BAR; G8_SCHED;
            G8_LDA(At, 1, 1); G8_STAGE_B(G8_SB(1, 0), b3); G8_STAGE_B(G8_SB(1, 1), b3 + hstepB); G8_STAGE_A(G8_SA(1, 0), a3, w00, w01);
            G8_WAIT_V(8); G8_WAIT_L(0); G8_BAR; G8_MMA(1, 0, At, B0); G8_MMA(1, 1, At, B1); G8_BAR; G8_SCHED;
        }
        if constexpr (Epi::KHOOK) { if (seg < 2) E.kscale(acc, seg, wr, fr); }
        }
        if (wr == 0) G8_BAR;
        { int fr_ = fr, fq_ = fq; asm volatile("" : "+v"(fr_), "+v"(fq_));
          E(acc, cur, wr, wc, fr_, fq_); }
        if (!has_next) break;
#pragma unroll
        for (int a = 0; a < 2; ++a)
#pragma unroll
            for (int b = 0; b < 2; ++b)
#pragma unroll
                for (int m = 0; m < 4; ++m)
#pragma unroll
                    for (int n = 0; n < 2; ++n) acc[a][b][m][n] = (f32x4){0.f, 0.f, 0.f, 0.f};
        cur = nxt; cA = nA; cB = nB; ++ui; G8_MASK(cur);
        if (GATHER) { const u32x4 sv = *stash; vc[0][0] = sv.x; vc[0][1] = sv.y; vc[1][0] = sv.z; vc[1][1] = sv.w; }
        if (wr == 1) G8_BAR;
    }
    G8_WAIT_V(0);
    G8_BAR;
#undef G8_SA
#undef G8_SB
#undef G8_GLDS
#undef G8_STAGE_A
#undef G8_STAGE_B
#undef G8_LDA
#undef G8_LDB
#undef G8_MMA
#undef G8_MASK
#undef G8_WAIT_V
#undef G8_WAIT_L
#undef G8_BAR
#undef G8_SCHED
}
}
using g8::GUnit;
__device__ __forceinline__ void st_bf16x8(bf16_t* p, const float (&v)[8]) { u32x4 w; w.x = pk_bf16(v[0], v[1]); w.y = pk_bf16(v[2], v[3]); w.z = pk_bf16(v[4], v[5]); w.w = pk_bf16(v[6], v[7]); *(u32x4*)p = w; }
__device__ __forceinline__ float quad_sum(float s) { s += __shfl_xor(s, 16); s += __shfl_xor(s, 32); return s; }

struct EpiInProj {
    static constexpr bool KHOOK = false;
    const float* ssqx; float* part_dq; float* part_dkv; const float* qg; const float* kg; const float* krg; const float* rope;
    unsigned char* prj;
    __device__ __forceinline__ void operator()(const f32x4 (&acc)[2][2][4][2], const GUnit& u, int wr, int wc, int fr, int fq) const {
        const int G = u.pn * 4 + wc;
        const bool isq = G < 6; const int a = G - 6; const bool isk = (G >= 10 && G < 18 && ((a >> 1) & 1) == 0);
        const float* g0 = (isq ? qg : kg) + 8 * fq;
        float rs8[8];
#pragma unroll
        for (int k = 0; k < 8; ++k) rs8[k] = ssqx[u.pm * 256 + (k >> 2) * 128 + wr * 64 + (k & 3) * 16 + fr];
#pragma unroll
        for (int k = 0; k < 8; ++k) rs8[k] = rsqrtf(rs8[k] * (1.f / 1024.f) + 1e-6f);
#pragma unroll
        for (int ai = 0; ai < 2; ++ai)
#pragma unroll
            for (int m = 0; m < 4; ++m) {
                __builtin_amdgcn_sched_barrier(0);
                const int row = u.pm * 256 + ai * 128 + wr * 64 + m * 16 + fr; const int b = row >> 11, t = row & 2047;
                const float rs = rs8[ai * 4 + m];
                float v[2][8];
#pragma unroll
                for (int bj = 0; bj < 2; ++bj)
#pragma unroll
                    for (int n = 0; n < 2; ++n)
#pragma unroll
                        for (int j = 0; j < 4; ++j) v[bj][4 * n + j] = acc[ai][bj][m][n][j] * rs;
                float ss = 0.f;
#pragma unroll
                for (int bj = 0; bj < 2; ++bj)
#pragma unroll
                    for (int i = 0; i < 8; ++i) ss += v[bj][i] * v[bj][i];
                bf16_t* dst = nullptr; int bstride = 32;
                if (isq) {
                    ss = quad_sum(ss); const float sc = rsqrtf(ss * (1.f / 64.f) + 1e-6f) * 0.18033688f;
#pragma unroll
                    for (int i = 0; i < 8; ++i) { v[0][i] *= sc * g0[i]; v[1][i] *= sc * g0[32 + i]; }
                    dst = (bf16_t*)(prj + PRJ_QN) + ((size_t)(b * 6 + G) * 2048 + t) * 64;
                } else if (G < 18) {
                    const int br = a >> 2, s = (a >> 1) & 1, hk = a & 1;
                    if (br > 0 && s == 0) {
                        ss = quad_sum(ss); const float sc = rsqrtf(ss * (1.f / 64.f) + 1e-6f);
#pragma unroll
                        for (int i = 0; i < 8; ++i) { v[0][i] *= sc * g0[i]; v[1][i] *= sc * g0[32 + i]; }
                    }
                    const size_t base = br == 0 ? (s ? PRJ_C0V : PRJ_C0K) : (br == 1 ? (s ? PRJ_VN1 : PRJ_KN1) : (s ? PRJ_VN2 : PRJ_KN2));
                    dst = (bf16_t*)(prj + base) + ((size_t)(b * 2 + hk) * 2048 + t) * 64;
                } else if (G < 26) { dst = (bf16_t*)(prj + PRJ_RAWQK) + (size_t)row * 512 + (G - 18) * 64; }
                else if (G < 30) { dst = (bf16_t*)(prj + PRJ_VML) + ((size_t)(b * 4 + (G - 26)) * 2048 + t) * 64; }
                else if (G < 34) { dst = (bf16_t*)(prj + PRJ_OG) + (size_t)row * 256 + (G - 30) * 64; }
                else if (G < 37) { dst = (bf16_t*)(prj + PRJ_DQKV) + (size_t)row * 384 + (G - 34) * 64; ss = quad_sum(ss); if (fq == 0) part_dq[(size_t)row * 4 + (G - 34)] = ss; }
                else if (G == 37) {
                    dst = (bf16_t*)(prj + PRJ_DQKV) + (size_t)row * 384 + 192;
                    float* gt = (float*)(prj + PRJ_GATES) + (size_t)row * 32 + 8 * fq;
                    *(f32x4*)gt = (f32x4){v[1][0], v[1][1], v[1][2], v[1][3]}; *(f32x4*)(gt + 4) = (f32x4){v[1][4], v[1][5], v[1][6], v[1][7]};
                    float s0 = 0.f;
#pragma unroll
                    for (int i = 0; i < 8; ++i) s0 += v[0][i] * v[0][i];
                    s0 = quad_sum(s0); const float sc = rsqrtf(s0 * (1.f / 32.f) + 1e-6f);
                    const float* rp = rope + (size_t)row * 32 + ((8 * fq) & 15);
                    float kr[8];
#pragma unroll
                    for (int i = 0; i < 8; ++i) { const float val = v[0][i] * sc * krg[8 * fq + i]; const float oth = __shfl_xor(val, 32); const float cs = rp[i], sn = rp[16 + i]; kr[i] = fq < 2 ? val * cs - oth * sn : val * cs + oth * sn; }
                    st_bf16x8((bf16_t*)(prj + PRJ_KR) + (size_t)row * 32 + 8 * fq, kr);
                } else { dst = (bf16_t*)(prj + PRJ_DQKV) + (size_t)row * 384 + 256 + (G - 38) * 64; ss = quad_sum(ss); if (fq == 0) part_dkv[(size_t)row * 2 + (G - 38)] = ss; }
                st_bf16x8(dst + 8 * fq, v[0]); st_bf16x8(dst + bstride + 8 * fq, v[1]);
            }
    }
};

struct EpiUq {
    static constexpr bool KHOOK = false;
    const float* ssq_dq; const float* qkn; const float* rope; bf16_t* QM;
    __device__ __forceinline__ void operator()(const f32x4 (&acc)[2][2][4][2], const GUnit& u, int wr, int wc, int fr, int fq) const {
        const int G = u.pn * 4 + wc; if (G >= 9) return;
        const float scale = 0.14724444f;
        const float* g0 = G < 6 ? qkn + 8 * fq : qkn + 64 + 8 * (fq & 1); const float* g1 = G < 6 ? g0 + 32 : g0 + 16;
        float rs8[8];
#pragma unroll
        for (int k = 0; k < 8; ++k) { const f32x4 pq = *(const f32x4*)(ssq_dq + (size_t)(u.pm * 256 + (k >> 2) * 128 + wr * 64 + (k & 3) * 16 + fr) * 4); rs8[k] = (pq.x + pq.y) + pq.z; }
#pragma unroll
        for (int k = 0; k < 8; ++k) rs8[k] = rsqrtf(rs8[k] * (1.f / 192.f) + 1e-6f);
#pragma unroll
        for (int ai = 0; ai < 2; ++ai)
#pragma unroll
            for (int m = 0; m < 4; ++m) {
                __builtin_amdgcn_sched_barrier(0);
                const int row = u.pm * 256 + ai * 128 + wr * 64 + m * 16 + fr; const int b = row >> 11, t = row & 2047;
                const float rs = rs8[ai * 4 + m];
                float v[2][8]; float ss = 0.f;
#pragma unroll
                for (int bj = 0; bj < 2; ++bj)
#pragma unroll
                    for (int n = 0; n < 2; ++n)
#pragma unroll
                        for (int j = 0; j < 4; ++j) { const float x = acc[ai][bj][m][n][j] * rs; v[bj][4 * n + j] = x; ss += x * x; }
                if (G < 6) ss = quad_sum(ss); else ss += __shfl_xor(ss, 16);
                const float sc = rsqrtf(ss * (G < 6 ? 1.f / 64.f : 1.f / 32.f) + 1e-6f) * scale;
#pragma unroll
                for (int i = 0; i < 8; ++i) { v[0][i] *= sc * g0[i]; v[1][i] *= sc * g1[i]; }
                if (G < 6) {
                    bf16_t* dst = QM + ((size_t)(b * 6 + G) * 2048 + t) * 96;
                    st_bf16x8(dst + 8 * fq, v[0]); st_bf16x8(dst + 32 + 8 * fq, v[1]);
                } else {
                    const int i16 = 8 * (fq & 1); const int head = 2 * (G - 6) + (fq >> 1);
                    const float* rp = rope + (size_t)row * 32 + i16; float o1[8], o2[8];
#pragma unroll
                    for (int i = 0; i < 8; ++i) { const float cs = rp[i], sn = rp[16 + i]; o1[i] = v[0][i] * cs - v[1][i] * sn; o2[i] = v[1][i] * cs + v[0][i] * sn; }
                    bf16_t* dst = QM + ((size_t)(b * 6 + head) * 2048 + t) * 96 + 64 + i16;
                    st_bf16x8(dst, o1); st_bf16x8(dst + 16, o2);
                }
            }
    }
};
struct EpiUkv {
    static constexpr bool KHOOK = false;
    const float* ssq_dkv; const float* qkn; const bf16_t* KR; bf16_t* KM; bf16_t* VM;
    __device__ __forceinline__ void operator()(const f32x4 (&acc)[2][2][4][2], const GUnit& u, int wr, int wc, int fr, int fq) const {
        const int G = u.pn * 4 + wc;
        const float* g0 = qkn + 96 + 8 * fq;
        float rs8[8];
#pragma unroll
        for (int k = 0; k < 8; ++k) { const size_t rr = (size_t)(u.pm * 256 + (k >> 2) * 128 + wr * 64 + (k & 3) * 16 + fr); rs8[k] = ssq_dkv[rr * 2] + ssq_dkv[rr * 2 + 1]; }
#pragma unroll
        for (int k = 0; k < 8; ++k) rs8[k] = rsqrtf(rs8[k] * (1.f / 128.f) + 1e-6f);
#pragma unroll
        for (int ai = 0; ai < 2; ++ai)
#pragma unroll
            for (int m = 0; m < 4; ++m) {
                __builtin_amdgcn_sched_barrier(0);
                const int row = u.pm * 256 + ai * 128 + wr * 64 + m * 16 + fr; const int b = row >> 11, t = row & 2047;
                const float rs = rs8[ai * 4 + m];
                float v[2][8]; float ss = 0.f;
#pragma unroll
                for (int bj = 0; bj < 2; ++bj)
#pragma unroll
                    for (int n = 0; n < 2; ++n)
#pragma unroll
                        for (int j = 0; j < 4; ++j) { const float x = acc[ai][bj][m][n][j] * rs; v[bj][4 * n + j] = x; ss += x * x; }
                if (G < 6) {
                    ss = quad_sum(ss); const float sc = rsqrtf(ss * (1.f / 64.f) + 1e-6f);
#pragma unroll
                    for (int i = 0; i < 8; ++i) { v[0][i] *= sc * g0[i]; v[1][i] *= sc * g0[32 + i]; }
                    bf16_t* dst = KM + ((size_t)(b * 6 + G) * 2048 + t) * 96;
                    st_bf16x8(dst + 8 * fq, v[0]); st_bf16x8(dst + 32 + 8 * fq, v[1]);
                    *(u32x4*)(dst + 64 + 8 * fq) = *(const u32x4*)(KR + (size_t)row * 32 + 8 * fq);
                } else {
                    bf16_t* dst = VM + ((size_t)(b * 6 + (G - 6)) * 2048 + t) * 64;
                    st_bf16x8(dst + 8 * fq, v[0]); st_bf16x8(dst + 32 + 8 * fq, v[1]);
                }
            }
    }
};
#define MFMA16(a, b, c) __builtin_amdgcn_mfma_f32_16x16x32_bf16(a, b, c, 0, 0, 0)
#define MFMA32(a, b, c) __builtin_amdgcn_mfma_f32_32x32x16_bf16(a, b, c, 0, 0, 0)
#define LDS_FENCE() asm volatile("s_waitcnt lgkmcnt(0)" ::: "memory")

__device__ __forceinline__ void cmp_unit(int u, int l, InPtr in, unsigned char* ws, LAS unsigned char* lds, int g_wv) {
    int tid_ = TIDX; asm volatile("" : "+v"(tid_));
    const int tid = tid_, w = tid >> 6, lane = tid & 63, r = lane & 15, q = lane >> 4;
    const int b = u >> 2, s = (u >> 1) & 1, hk = u & 1;
    const bf16_t* A = (const bf16_t*)(ws + WS_PRJ + (s ? PRJ_C0V : PRJ_C0K)) + (size_t)(b * 2 + hk) * 2048 * 64;
    const bf16_t* W1 = (const bf16_t*)(ws + WS_WC1) + ((size_t)l * 2 + s) * 64 * 2048;
    const bf16_t* W2 = (const bf16_t*)(ws + WS_WC2) + ((size_t)l * 2 + s) * 64 * 64;
    const float* b1 = (const float*)(ws + WS_B1C) + (l * 2 + s) * 64;
    f32x4 acc[4];
#pragma unroll
    for (int nb = 0; nb < 4; ++nb) acc[nb] = (f32x4){0.f, 0.f, 0.f, 0.f};
    const bf16_t* ap = A + (size_t)(16 * w + r) * 1024 + 8 * q;
    constexpr int WP = 528, WBUF = 64 * WP; LAS unsigned char* wb = lds + 24576;
    u32x4 st[4];
#pragma unroll
    for (int i = 0; i < 4; ++i) { const int c = tid + 512 * i; st[i] = *(const u32x4*)(W1 + (size_t)(c >> 5) * 2048 + (c & 31) * 8); }
#pragma unroll
    for (int i = 0; i < 4; ++i) { const int c = tid + 512 * i; *(LAS u32x4*)(wb + (c >> 5) * WP + (c & 31) * 16) = st[i]; }
    __syncthreads();
#pragma unroll 1
    for (int kc = 0; kc < 8; ++kc) {
        const int cur = kc & 1;
        if (kc < 7) {
#pragma unroll
            for (int i = 0; i < 4; ++i) { const int c = tid + 512 * i; st[i] = *(const u32x4*)(W1 + (size_t)(c >> 5) * 2048 + (kc + 1) * 256 + (c & 31) * 8); }
        }
        bf16x8 af[8];
#pragma unroll
        for (int ks = 0; ks < 8; ++ks) af[ks] = *(const bf16x8*)(ap + 256 * kc + 32 * ks);
#pragma unroll
        for (int ks = 0; ks < 8; ++ks)
#pragma unroll
            for (int nb = 0; nb < 4; ++nb) { const bf16x8 bb = *(const LAS bf16x8*)(wb + cur * WBUF + (16 * nb + r) * WP + (32 * ks + 8 * q) * 2); acc[nb] = MFMA16(af[ks], bb, acc[nb]); }
        if (kc < 7) {
#pragma unroll
            for (int i = 0; i < 4; ++i) { const int c = tid + 512 * i; *(LAS u32x4*)(wb + (cur ^ 1) * WBUF + (c >> 5) * WP + (c & 31) * 16) = st[i]; }
        }
        __syncthreads();
    }
    LAS bf16_t* hl = (LAS bf16_t*)(lds + w * 2304);
#pragma unroll
    for (int nb = 0; nb < 4; ++nb) { const float bias = b1[16 * nb + r];
#pragma unroll
        for (int j = 0; j < 4; ++j) hl[(4 * q + j) * 72 + 16 * nb + r] = f2bf(siluf(acc[nb][j] + bias)); }
    LDS_FENCE();
    f32x4 o[4];
#pragma unroll
    for (int nb = 0; nb < 4; ++nb) o[nb] = (f32x4){0.f, 0.f, 0.f, 0.f};
#pragma unroll
    for (int ks = 0; ks < 2; ++ks) {
        const bf16x8 a = *(const LAS bf16x8*)(hl + r * 72 + 32 * ks + 8 * q);
#pragma unroll
        for (int nb = 0; nb < 4; ++nb) { const bf16x8 bb = *(const bf16x8*)(W2 + (size_t)(16 * nb + r) * 64 + 32 * ks + 8 * q); o[nb] = MFMA16(a, bb, o[nb]); }
    }
    LDS_FENCE();
    const float* kg = in->p[9] + l * 64;
    bf16_t* dst = (bf16_t*)(ws + WS_CMP + (s ? CMP_V : 0)) + (size_t)(b * 2 + hk) * 128 * 64;
#pragma unroll
    for (int j = 0; j < 4; ++j) {
        const int n = 16 * w + 4 * q + j; float ss = 0.f;
#pragma unroll
        for (int nb = 0; nb < 4; ++nb) ss += o[nb][j] * o[nb][j];
        ss += __shfl_xor(ss, 1); ss += __shfl_xor(ss, 2); ss += __shfl_xor(ss, 4); ss += __shfl_xor(ss, 8);
        const float sc = s == 0 ? rsqrtf(ss * (1.f / 64.f) + 1e-6f) : 1.f;
#pragma unroll
        for (int nb = 0; nb < 4; ++nb) { const int d = 16 * nb + r; const float v = o[nb][j] * sc * (s == 0 ? kg[d] : 1.f); dst[(size_t)n * 64 + d] = n < 127 ? f2bf(v) : (bf16_t)0; }
    }
}

__device__ __forceinline__ int swz_off(int row, int chunk) { return row * 128 + ((chunk ^ (row & 7)) << 4); }
__device__ __forceinline__ float log_sigmoid(float x) { return fminf(x, 0.f) - log1pf(__expf(-fabsf(x))); }
__device__ __forceinline__ void ml_delta_wave(int cu, int l, InPtr in, unsigned char* ws, LAS unsigned char* wl, int lane) {
    const int c = cu & 31, bh = cu >> 5, h = bh & 3, b = bh >> 2; const int t0 = c * 64; const size_t row0 = (size_t)b * 2048 + t0;
    const float* G = (const float*)(ws + WS_PRJ + PRJ_GATES);
    const float ip = G[(row0 + lane) * 32 + 18 + h] + in->p[12][l * 4 + h], fp = G[(row0 + lane) * 32 + 22 + h] + in->p[13][l * 4 + h];
    float bcum = log_sigmoid(fp);
#pragma unroll
    for (int o = 1; o < 64; o <<= 1) { const float t = __builtin_bit_cast(float, __builtin_amdgcn_ds_bpermute(((lane - o) & 63) << 2, __builtin_bit_cast(int, bcum))); if (lane >= o) bcum += t; }
    const float bL = __builtin_bit_cast(float, __builtin_amdgcn_readlane(__builtin_bit_cast(int, bcum), 63)); const float wgt = __expf(bL - bcum + ip);
    { float* mlg = (float*)(ws + WS_ML + ML_G) + ((size_t)bh * 2048 + t0 + lane) * 2; mlg[0] = bcum; mlg[1] = ip; if (lane == 0) ((float*)(ws + WS_ML + ML_BL))[cu] = bL; }
    const bf16_t* raw = (const bf16_t*)(ws + WS_PRJ + PRJ_RAWQK); const float* cw = in->p[11] + (size_t)l * 4 * 512;
    float wq[4], wk[4];
#pragma unroll
    for (int j = 0; j < 4; ++j) { wq[j] = cw[j * 512 + h * 64 + lane]; wk[j] = cw[j * 512 + 256 + h * 64 + lane]; }
    float q3 = 0.f, q2 = 0.f, q1 = 0.f, k3 = 0.f, k2 = 0.f, k1 = 0.f;
    if (c > 0) { const bf16_t* p = raw + (row0 - 3) * 512 + h * 64 + lane; q3 = bf2f(p[0]); q2 = bf2f(p[512]); q1 = bf2f(p[1024]); k3 = bf2f(p[256]); k2 = bf2f(p[512 + 256]); k1 = bf2f(p[1024 + 256]); }
    bf16_t* QC = (bf16_t*)(ws + WS_ML) + ((size_t)bh * 2048 + t0) * 64 + lane; bf16_t* KC = (bf16_t*)(ws + WS_ML + ML_KC) + ((size_t)bh * 2048 + t0) * 64 + lane;
    const bf16_t* V = (const bf16_t*)(ws + WS_PRJ + PRJ_VML) + ((size_t)bh * 2048 + t0) * 64 + lane;
    float dn = 0.f;
    const bf16_t* rq = raw + row0 * 512 + h * 64 + lane;
    bf16_t cq[8], ck[8], cv[8], nq[8], nk[8], nv[8];
#pragma unroll
    for (int j = 0; j < 8; ++j) { cq[j] = rq[(size_t)j * 512]; ck[j] = rq[(size_t)j * 512 + 256]; cv[j] = V[(size_t)j * 64]; }
#pragma unroll 1
    for (int s8 = 0; s8 < 8; ++s8) {
        if (s8 < 7) {
#pragma unroll
            for (int j = 0; j < 8; ++j) { const int s = s8 * 8 + 8 + j; nq[j] = rq[(size_t)s * 512]; nk[j] = rq[(size_t)s * 512 + 256]; nv[j] = V[(size_t)s * 64]; }
        }
        float kb[8], vb[8]; bf16_t qo[8], ko[8];
#pragma unroll
        for (int j = 0; j < 8; ++j) {
            const int s = s8 * 8 + j;
            const float q0 = bf2f(cq[j]), k0 = bf2f(ck[j]);
            const float qv = siluf(wq[0] * q3 + wq[1] * q2 + wq[2] * q1 + wq[3] * q0), kv = siluf(wk[0] * k3 + wk[1] * k2 + wk[2] * k1 + wk[3] * k0) * 0.125f;
            q3 = q2; q2 = q1; q1 = q0; k3 = k2; k2 = k1; k1 = k0;
            qo[j] = f2bf(qv); ko[j] = f2bf(kv);
            const float ws_ = __builtin_bit_cast(float, __builtin_amdgcn_readlane(__builtin_bit_cast(int, wgt), s)); kb[j] = bf2f(ko[j]); dn += ws_ * kb[j]; vb[j] = ws_ * bf2f(cv[j]);
        }
#pragma unroll
        for (int j = 0; j < 8; ++j) { QC[(size_t)(s8 * 8 + j) * 64] = qo[j]; KC[(size_t)(s8 * 8 + j) * 64] = ko[j]; }
        u32x4 pk; pk.x = pk_bf16(kb[0], kb[1]); pk.y = pk_bf16(kb[2], kb[3]); pk.z = pk_bf16(kb[4], kb[5]); pk.w = pk_bf16(kb[6], kb[7]);
        *(LAS u32x4*)(wl + swz_off(lane, s8)) = pk;
        pk.x = pk_bf16(vb[0], vb[1]); pk.y = pk_bf16(vb[2], vb[3]); pk.z = pk_bf16(vb[4], vb[5]); pk.w = pk_bf16(vb[6], vb[7]);
        *(LAS u32x4*)(wl + 8192 + swz_off(lane, s8)) = pk;
#pragma unroll
        for (int j = 0; j < 8; ++j) { cq[j] = nq[j]; ck[j] = nk[j]; cv[j] = nv[j]; }
    }
    ((float*)(ws + WS_ML + ML_DN))[(size_t)cu * 64 + lane] = dn;
    LDS_FENCE();
    const int r = lane & 15, q = lane >> 4;
    bf16_t* DL = (bf16_t*)(ws + WS_ML + ML_DELTA) + (size_t)cu * 4096;
#pragma unroll
    for (int mb = 0; mb < 4; ++mb) {
        f32x4 acc[4];
#pragma unroll
        for (int nb = 0; nb < 4; ++nb) acc[nb] = (f32x4){0.f, 0.f, 0.f, 0.f};
#pragma unroll
        for (int ks = 0; ks < 2; ++ks) {
            const bf16x8 a = *(const LAS bf16x8*)(wl + 8192 + swz_off(16 * mb + r, 4 * ks + q));
#pragma unroll
            for (int nb = 0; nb < 4; ++nb) { const bf16x8 bb = *(const LAS bf16x8*)(wl + swz_off(16 * nb + r, 4 * ks + q)); acc[nb] = MFMA16(a, bb, acc[nb]); }
        }
#pragma unroll
        for (int nb = 0; nb < 4; ++nb)
#pragma unroll
            for (int j = 0; j < 4; ++j) DL[(16 * mb + 4 * q + j) * 64 + 16 * nb + r] = f2bf(acc[nb][j]);
    }
    LDS_FENCE();
}

#ifndef TIME_PH
#define TIME_PH -1
#endif
#define PSTAMP(i, blk) do { if (TIME_PH != -1 && l == 0 && blockIdx.x == (blk) && TIDX == 0) ((unsigned long long*)((unsigned*)(ws + WS_CTL) + CW_TS))[i] = __builtin_amdgcn_s_memrealtime(); } while (0)
__device__ __forceinline__ void phase_prep(int l, InPtr in, unsigned char* ws, LAS unsigned char* lds, int bid, int nb, int g_wv, unsigned* dq) {
    asm volatile("" : "+s"(bid));
    PSTAMP(40, 0);
#ifndef NO_UQ
    { g8::DenseSched S{(const char*)(ws + WS_PRJ + PRJ_DQKV), (const char*)(ws + WS_WUQ) + (size_t)l * 768 * 256 * 2, 384, 256, 64, 3, nb, bid};
      EpiUq E{(const float*)(ws + WS_SSQ + PT_DQ) + (size_t)l * 16384 * 4, in->p[19] + l * 192, (const float*)(ws + WS_ROPE), (bf16_t*)(ws + WS_MLA)};
      g8::gemm_run(lds, 256, 256, S, E, g_wv); }
#endif
    PSTAMP(41, 0);
#ifndef NO_UKV
    asm volatile("" : "+s"(bid));
    { g8::DenseSched S{(const char*)(ws + WS_PRJ + PRJ_DQKV) + 256, (const char*)(ws + WS_WUKV) + (size_t)l * 768 * 256 * 2, 384, 256, 64, 3, nb, bid};
      EpiUkv E{(const float*)(ws + WS_SSQ + PT_DKV) + (size_t)l * 16384 * 2, in->p[19] + l * 192, (const bf16_t*)(ws + WS_PRJ + PRJ_KR), (bf16_t*)(ws + WS_MLA + MLA_KM), (bf16_t*)(ws + WS_MLA + MLA_VM)};
      g8::gemm_run(lds, 256, 256, S, E, g_wv); }
#endif
    PSTAMP(42, 0); PSTAMP(44, 255);
    __syncthreads();
#ifndef NO_CMP
    for (int u = nb - 1 - bid; u < 32; u += nb) cmp_unit(u, l, in, ws, lds, g_wv);
#endif
    PSTAMP(45, 255);
    __syncthreads();
#ifndef NO_DELTA
    { int tid_ = TIDX; asm volatile("" : "+v"(tid_)); LAS int* slot = (LAS int*)(lds + LDS_MISC + 64);
      for (;;) {
          __syncthreads();
          if (tid_ == 0) *slot = (int)__hip_atomic_fetch_add(dq, 1u, __ATOMIC_RELAXED, __HIP_MEMORY_SCOPE_AGENT);
          __syncthreads();
          const int g = *slot; if (g >= 128) break;
          ml_delta_wave(g * 8 + (tid_ >> 6), l, in, ws, lds + (tid_ >> 6) * 16384, tid_ & 63);
      } }
#endif
    __syncthreads(); PSTAMP(43, 0);
}
#define CHK_TOL(st) (((st) & 15) == 8 ? 1e-2f : 1e-3f)
#define CHECK_REST
constexpr int VTP = 192;
typedef short v4i16_t __attribute__((ext_vector_type(4)));
__device__ __forceinline__ int vt_lane_off(int lane) { return (4 * (lane >> 5) + ((lane & 15) >> 2)) * VTP + ((((lane >> 4) & 1) * 16) + 4 * (lane & 3)) * 2; }
__device__ __forceinline__ bf16x8 vt_frag(const LAS unsigned char* Vt, int voff, int s4, int eb) {
    const LAS unsigned char* a = Vt + voff + 16 * s4 * VTP + 64 * eb;
    const v4i16_t lo = __builtin_amdgcn_ds_read_tr16_b64_v4i16((LAS v4i16_t*)a), hi = __builtin_amdgcn_ds_read_tr16_b64_v4i16((LAS v4i16_t*)(a + 8 * VTP));
    return (bf16x8){lo[0], lo[1], lo[2], lo[3], hi[0], hi[1], hi[2], hi[3]};
}
__device__ __forceinline__ int crow(int reg, int h) { return (reg & 3) + 8 * (reg >> 2) + 4 * h; }
struct AttnState { f32x16 o[2]; float m, l; };
__device__ __forceinline__ void attn_reset(AttnState& A) { A.m = -1e30f; A.l = 0.f;
#pragma unroll
    for (int i = 0; i < 16; ++i) { A.o[0][i] = 0.f; A.o[1][i] = 0.f; } }

template <int DK>
__device__ __forceinline__ void attn_scores(f32x16 (&s)[2], const bf16x8 (&qf)[DK / 16], const LAS unsigned char* Kt, int r, int h) {
    constexpr int KP = 2 * DK + 16, NK = DK / 16;
    bf16x8 kf[2][NK];
#pragma unroll
    for (int kb = 0; kb < 2; ++kb)
#pragma unroll
        for (int ks = 0; ks < NK; ++ks) kf[kb][ks] = *(const LAS bf16x8*)(Kt + (32 * kb + r) * KP + (16 * ks + 8 * h) * 2);
    __builtin_amdgcn_sched_barrier(0);
#pragma unroll
    for (int kb = 0; kb < 2; ++kb) {
#pragma unroll
        for (int i = 0; i < 16; ++i) s[kb][i] = 0.f;
#pragma unroll
        for (int ks = 0; ks < NK; ++ks) s[kb] = MFMA32(kf[kb][ks], qf[ks], s[kb]);
    }
}
__device__ __forceinline__ float max3f(float a, float b, float c) { return fmaxf(fmaxf(a, b), c); }
__device__ __forceinline__ void attn_softmax_pv(AttnState& A, f32x16 (&s)[2], const LAS unsigned char* Vt, int r, int h, float bias_c = 0.f, bool lane_ok = true) {
    constexpr float THR = 8.f; const int voff = vt_lane_off(r + 32 * h);
    float mx = max3f(s[0][0], s[0][1], s[0][2]);
#pragma unroll
    for (int i = 3; i < 15; i += 2) mx = max3f(mx, s[0][i], s[0][i + 1]);
    mx = max3f(mx, s[0][15], s[1][0]);
#pragma unroll
    for (int i = 1; i < 15; i += 2) mx = max3f(mx, s[1][i], s[1][i + 1]);
    mx = fmaxf(mx, s[1][15]);
    mx = fmaxf(mx, __shfl_xor(mx, 32));
    const float mxb = (lane_ok && mx > -1e29f) ? mx + bias_c : -1e30f;
    const bool grow = mxb > A.m + THR;
    const float mnew = grow ? mxb : A.m;
    if (__any(grow)) {
        const float alpha = __builtin_amdgcn_exp2f(A.m - mnew);
        A.l *= alpha;
#pragma unroll
        for (int i = 0; i < 16; ++i) { A.o[0][i] *= alpha; A.o[1][i] *= alpha; }
    }
    A.m = mnew;
    const float sub = (lane_ok && mnew > -1e29f) ? mnew - bias_c : 1e30f;
    float rs = 0.f;
#pragma unroll
    for (int kb = 0; kb < 2; ++kb)
#pragma unroll
        for (int i = 0; i < 16; ++i) { const float p = __builtin_amdgcn_exp2f(s[kb][i] - sub); s[kb][i] = p; rs += p; }
    rs += __shfl_xor(rs, 32);
    A.l += rs;
    bf16x8 vf[4][2];
#pragma unroll
    for (int s4 = 0; s4 < 4; ++s4)
#pragma unroll
        for (int eb = 0; eb < 2; ++eb) vf[s4][eb] = vt_frag(Vt, voff, s4, eb);
    __builtin_amdgcn_sched_barrier(0);
#pragma unroll
    for (int s4 = 0; s4 < 4; ++s4) {
        const int kb = s4 >> 1, hf = (s4 & 1) * 8;
        u32x4 pw; pw.x = pk_bf16(s[kb][hf + 0], s[kb][hf + 1]); pw.y = pk_bf16(s[kb][hf + 2], s[kb][hf + 3]); pw.z = pk_bf16(s[kb][hf + 4], s[kb][hf + 5]); pw.w = pk_bf16(s[kb][hf + 6], s[kb][hf + 7]);
        const bf16x8 pf = __builtin_bit_cast(bf16x8, pw);
#pragma unroll
        for (int eb = 0; eb < 2; ++eb) A.o[eb] = MFMA32(vf[s4][eb], pf, A.o[eb]);
    }
}
template <int DK>
__device__ __forceinline__ void stage_k_load(u32x4 (&kr)[2], const bf16_t* Kg  , int tid) {
    constexpr int CH = DK / 8;
    kr[0] = *(const u32x4*)(Kg + (size_t)(tid / CH) * DK + (tid % CH) * 8);
    if (64 * CH > 512) { const int c2 = tid + 512; if (c2 < 64 * CH) kr[1] = *(const u32x4*)(Kg + (size_t)(c2 / CH) * DK + (c2 % CH) * 8); }
}
template <int DK>
__device__ __forceinline__ void stage_k_store(const u32x4 (&kr)[2], LAS unsigned char* Kt, int tid) {
    constexpr int CH = DK / 8, KP = 2 * DK + 16;
    *(LAS u32x4*)(Kt + (tid / CH) * KP + (tid % CH) * 16) = kr[0];
    if (64 * CH > 512) { const int c2 = tid + 512; if (c2 < 64 * CH) *(LAS u32x4*)(Kt + (c2 / CH) * KP + (c2 % CH) * 16) = kr[1]; }
}
__device__ __forceinline__ u32x4 stage_v_load(const bf16_t* Vg, int tid) { return *(const u32x4*)(Vg + (size_t)(tid >> 3) * 64 + (tid & 7) * 8); }
__device__ __forceinline__ void stage_v_store(const u32x4& v, LAS unsigned char* Vt, int tid) { *(LAS u32x4*)(Vt + (tid >> 3) * VTP + (tid & 7) * 16) = v; }

constexpr int MLA_KT = 0, MLA_VT = 2 * 64 * 208, MLA_LDS = MLA_VT + 2 * 64 * VTP;
__device__ __forceinline__ void mla_unit(int b, int hd, int qt, int l, unsigned char* ws, LAS unsigned char* lds, int g_wv) {
    int tid_ = TIDX; asm volatile("" : "+v"(tid_));
    const int tid = tid_, w = tid >> 6, lane = tid & 63, r = lane & 31, h = lane >> 5;
    const size_t slab = (size_t)(b * 6 + hd) * 2048;
    const bf16_t* QM = (const bf16_t*)(ws + WS_MLA) + slab * 96; const bf16_t* KM = (const bf16_t*)(ws + WS_MLA + MLA_KM) + slab * 96; const bf16_t* VM = (const bf16_t*)(ws + WS_MLA + MLA_VM) + slab * 64;
    const int q0 = 256 * qt + 32 * w, q = q0 + r;
    bf16x8 qf[6];
#pragma unroll
    for (int ks = 0; ks < 6; ++ks) qf[ks] = *(const bf16x8*)(QM + (size_t)q * 96 + 16 * ks + 8 * h);
    AttnState A; attn_reset(A);
    const int ntile = 4 * qt + 4;
    u32x4 kr[2], vr, kr2[2], vr2;
    stage_k_load<96>(kr, KM, tid); vr = stage_v_load(VM, tid);
    stage_k_store<96>(kr, lds + MLA_KT, tid); stage_v_store(vr, lds + MLA_VT, tid);
    if (ntile > 1) { stage_k_load<96>(kr, KM + (size_t)64 * 96, tid); vr = stage_v_load(VM + (size_t)64 * 64, tid); }
    __syncthreads();
    for (int j = 0; j < ntile; ++j) {
        const int cur = j & 1;
        if (j + 2 < ntile) { stage_k_load<96>(kr2, KM + (size_t)(j + 2) * 64 * 96, tid); vr2 = stage_v_load(VM + (size_t)(j + 2) * 64 * 64, tid); }
        if (64 * j <= q0 + 31) {
            f32x16 s[2];
            attn_scores<96>(s, qf, lds + MLA_KT + cur * 64 * 208, r, h);
            if (64 * j + 63 > q0) {
#pragma unroll
                for (int kb = 0; kb < 2; ++kb)
#pragma unroll
                    for (int i = 0; i < 16; ++i) { const int key = 64 * j + 32 * kb + crow(i, h); if (key > q) s[kb][i] = -1e30f; }
            }
            attn_softmax_pv(A, s, lds + MLA_VT + cur * 64 * VTP, r, h);
        }
        if (j + 1 < ntile) { stage_k_store<96>(kr, lds + MLA_KT + (cur ^ 1) * 64 * 208, tid); stage_v_store(vr, lds + MLA_VT + (cur ^ 1) * 64 * VTP, tid); }
        kr[0] = kr2[0]; kr[1] = kr2[1]; vr = vr2;
        __syncthreads();
    }
    const float inv = A.l > 0.f ? 1.f / A.l : 0.f; float ss = 0.f;
    bf16_t* Y = (bf16_t*)(ws + WS_Y) + ((size_t)b * 2048 + q) * 1024 + 384 + hd * 64;
#pragma unroll
    for (int eb = 0; eb < 2; ++eb)
#pragma unroll
        for (int g4 = 0; g4 < 4; ++g4) {
            const float v0 = A.o[eb][4 * g4] * inv, v1 = A.o[eb][4 * g4 + 1] * inv, v2 = A.o[eb][4 * g4 + 2] * inv, v3 = A.o[eb][4 * g4 + 3] * inv;
            u32x2 pw; pw.x = pk_bf16(v0, v1); pw.y = pk_bf16(v2, v3);
            const float f0 = bf_lo(pw.x), f1 = bf_hi(pw.x), f2 = bf_lo(pw.y), f3 = bf_hi(pw.y); ss += (f0 * f0 + f1 * f1) + (f2 * f2 + f3 * f3);
            *(u32x2*)(Y + 32 * eb + 8 * g4 + 4 * h) = pw;
        }
    ss += __shfl_xor(ss, 32);
    if (h == 0) ((float*)(ws + WS_SSQ + PT_C))[((size_t)l * 16384 + (size_t)b * 2048 + q) * 8 + hd] = ss;
}

__device__ __forceinline__ void nsa_bias32(float (&bv)[2][16], const LAS float* bl, int dd) {
#pragma unroll
    for (int kb = 0; kb < 2; ++kb)
#pragma unroll
        for (int k = 0; k < 16; ++k) { const int c = 63 - (32 * kb + (k & 3) + 8 * (k >> 2)); int d = dd + c; d = d < 0 ? 0 : (d > 255 ? 255 : d); bv[kb][k] = bl[d]; }
}
__device__ __forceinline__ void nsa_mask_bias(f32x16 (&sc)[2], int dq, int h, const LAS float* bl, bool sel, int lim) {
    int dd = dq - 4 * h - 63; asm volatile("" : "+v"(dd));
    float bv[2][16]; nsa_bias32(bv, bl, dd);
#pragma unroll
    for (int kb = 0; kb < 2; ++kb)
#pragma unroll
        for (int k = 0; k < 16; ++k) { const int c = 63 - (32 * kb + (k & 3) + 8 * (k >> 2)); const int d = dd + c; sc[kb][k] = (sel && d >= 0 && d < lim) ? sc[kb][k] + bv[kb][k] : -1e30f; }
}

constexpr int NSA_KT = 0, NSA_VT = 2 * 64 * 144, NSA_BIAS = NSA_VT + 2 * 64 * VTP, NSA_PS = NSA_BIAS + 3 * 256 * 4, NSA_SEL = NSA_PS + 3 * 64 * 32 * 4, NSA_UNI = NSA_SEL + 256, NSA_OT = NSA_UNI + 256, NSA_LDS = NSA_OT + 6 * 8192;
__device__ __forceinline__ void nsa_unit(int b, int hk, int i, int l, InPtr in, unsigned char* ws, LAS unsigned char* lds, int g_wv) {
    int tid_ = TIDX; asm volatile("" : "+v"(tid_));
    const int tid = tid_, w = tid >> 6, lane = tid & 63, r = lane & 31, h = lane >> 5;
    const bool active = w < 6; const int g = active ? (w >> 1) : 0, th = w & 1, head = hk * 3 + g;
    const int t = 64 * i + 32 * th + r, tl = 32 * th + r; const size_t row = (size_t)b * 2048 + t;
    const size_t kvslab = (size_t)(b * 2 + hk) * 2048 * 64;
    LAS float* biasl = (LAS float*)(lds + NSA_BIAS); LAS float* PS = (LAS float*)(lds + NSA_PS); LAS unsigned* SEL = (LAS unsigned*)(lds + NSA_SEL); LAS unsigned* UNI = (LAS unsigned*)(lds + NSA_UNI);
    { const float* bd = (const float*)(ws + WS_BIASD) + (size_t)hk * 3 * 2048;
      if (tid < 384) { const int gg = tid >> 7, d0 = (tid & 127) * 2; biasl[gg * 256 + d0] = bd[gg * 2048 + d0]; biasl[gg * 256 + d0 + 1] = bd[gg * 2048 + d0 + 1]; }
#pragma unroll
      for (int k = 0; k < 12; ++k) if (i >= 16) PS[tid + 512 * k] = 0.f;
      if (tid < 4) UNI[tid] = 0u; }
    bf16x8 qf[4];
    { const bf16_t* QN = (const bf16_t*)(ws + WS_PRJ + PRJ_QN) + ((size_t)(b * 6 + head) * 2048 + t) * 64;
#pragma unroll
      for (int ks = 0; ks < 4; ++ks) qf[ks] = *(const bf16x8*)(QN + 16 * ks + 8 * h); }
#define NSA_GATE(k) ({ int t_ = t; asm volatile("" : "+v"(t_)); sigmf(((const float*)(ws + WS_PRJ + PRJ_GATES))[((size_t)b * 2048 + t_) * 32 + head * 3 + (k)]); })
    LAS float* bl = biasl + g * 256;
    LAS float* otl = (LAS float*)(lds + NSA_OT + (active ? w : 0) * 8192) + lane;
    u32x4 kr[2], vr;
    const int ntc = i >= 16 ? 2 : 1;
    { const bf16_t* KC = (const bf16_t*)(ws + WS_CMP) + (size_t)(b * 2 + hk) * 128 * 64; const bf16_t* VC = (const bf16_t*)(ws + WS_CMP + CMP_V) + (size_t)(b * 2 + hk) * 128 * 64;
      for (int T = 0; T < ntc; ++T) { stage_k_load<64>(kr, KC + T * 4096, tid); vr = stage_v_load(VC + T * 4096, tid); stage_k_store<64>(kr, lds + NSA_KT + T * 64 * 144, tid); stage_v_store(vr, lds + NSA_VT + T * 64 * VTP, tid); } }
    __syncthreads();
    {
        f32x16 ot[2];
        if (active && i < 16) {
            AttnState A; attn_reset(A); f32x16 sc[2]; attn_scores<64>(sc, qf, lds + NSA_KT, r, h);
            float bvc[2][16];
#pragma unroll
            for (int kb = 0; kb < 2; ++kb)
#pragma unroll
                for (int k = 0; k < 16; ++k) { int d = t - 16 * (32 * kb + crow(k, h)) - 31; d = d < 0 ? 0 : (d > 255 ? 255 : d); bvc[kb][k] = bl[d]; }
#pragma unroll
            for (int kb = 0; kb < 2; ++kb)
#pragma unroll
                for (int k = 0; k < 16; ++k) { const int d = t - 16 * (32 * kb + crow(k, h)) - 31; sc[kb][k] = d >= 0 ? sc[kb][k] + bvc[kb][k] : -1e30f; }
            attn_softmax_pv(A, sc, lds + NSA_VT, r, h);
            const float gc = NSA_GATE(0); const float inv = A.l > 0.f ? gc / A.l : 0.f;
#pragma unroll
            for (int k = 0; k < 16; ++k) { otl[64 * k] = A.o[0][k] * inv; otl[64 * (16 + k)] = A.o[1][k] * inv; }
        } else if (active) {
            float m = -1e30f, lsum = 0.f;
            for (int T = 0; T < ntc; ++T) {
                f32x16 sc[2]; attn_scores<64>(sc, qf, lds + NSA_KT + T * 64 * 144, r, h);
                float bvc[2][16];
#pragma unroll
                for (int kb = 0; kb < 2; ++kb)
#pragma unroll
                    for (int k = 0; k < 16; ++k) { int d = t - 16 * (64 * T + 32 * kb + crow(k, h)) - 31; d = d < 0 ? 0 : (d > 255 ? 255 : d); bvc[kb][k] = bl[d]; }
                float mx = -1e30f;
#pragma unroll
                for (int kb = 0; kb < 2; ++kb)
#pragma unroll
                    for (int k = 0; k < 16; ++k) { const int n = 64 * T + 32 * kb + crow(k, h); const int d = t - 16 * n - 31; const float x = (d >= 0 && n < 127) ? sc[kb][k] + bvc[kb][k] : -1e30f; sc[kb][k] = x; mx = fmaxf(mx, x); }
                mx = fmaxf(mx, __shfl_xor(mx, 32));
                const float mnew = fmaxf(m, mx), mref = mnew <= -1e29f ? 0.f : mnew; float rs = 0.f;
#pragma unroll
                for (int kb = 0; kb < 2; ++kb)
#pragma unroll
                    for (int k = 0; k < 16; ++k) rs += __builtin_amdgcn_exp2f(sc[kb][k] - mref);
                rs += __shfl_xor(rs, 32);
                lsum = lsum * __builtin_amdgcn_exp2f(m - mref) + rs; m = mnew;
            }
            const float mref = m <= -1e29f ? 0.f : m, inv = lsum > 0.f ? 1.f / lsum : 0.f;
#pragma unroll
            for (int k = 0; k < 16; ++k) { ot[0][k] = 0.f; ot[1][k] = 0.f; }
            float carry = 0.f;
            for (int T = 0; T < ntc; ++T) {
                f32x16 sc[2]; attn_scores<64>(sc, qf, lds + NSA_KT + T * 64 * 144, r, h);
                float bvc[2][16];
#pragma unroll
                for (int kb = 0; kb < 2; ++kb)
#pragma unroll
                    for (int k = 0; k < 16; ++k) { int d = t - 16 * (64 * T + 32 * kb + crow(k, h)) - 31; d = d < 0 ? 0 : (d > 255 ? 255 : d); bvc[kb][k] = bl[d]; }
#pragma unroll
                for (int kb = 0; kb < 2; ++kb)
#pragma unroll
                    for (int k = 0; k < 16; ++k) { const int n = 64 * T + 32 * kb + crow(k, h); const int d = t - 16 * n - 31; sc[kb][k] = (d >= 0 && n < 127) ? __builtin_amdgcn_exp2f(sc[kb][k] + bvc[kb][k] - mref) * inv : 0.f; }
                float prevL = carry;
#pragma unroll
                for (int kb = 0; kb < 2; ++kb)
#pragma unroll
                    for (int g4 = 0; g4 < 4; ++g4) {
                        const float G4 = (sc[kb][4 * g4] + sc[kb][4 * g4 + 1]) + (sc[kb][4 * g4 + 2] + sc[kb][4 * g4 + 3]); const float L = sc[kb][4 * g4 + 3];
                        const float Lo = __shfl_xor(L, 32);
                        const float add = h ? Lo : prevL;
                        prevL = Lo;
                        const int idx = T * 8 + kb * 4 + g4;
                        PS[g * 2048 + tl * 32 + 2 * idx + h] = G4 + add;
                    }
                carry = prevL;
#pragma unroll
                for (int s4 = 0; s4 < 4; ++s4) {
                    const int kb = s4 >> 1, hf = (s4 & 1) * 8;
                    u32x4 pw; pw.x = pk_bf16(sc[kb][hf + 0], sc[kb][hf + 1]); pw.y = pk_bf16(sc[kb][hf + 2], sc[kb][hf + 3]); pw.z = pk_bf16(sc[kb][hf + 4], sc[kb][hf + 5]); pw.w = pk_bf16(sc[kb][hf + 6], sc[kb][hf + 7]);
                    const bf16x8 pf = __builtin_bit_cast(bf16x8, pw);
#pragma unroll
                    for (int eb = 0; eb < 2; ++eb) ot[eb] = MFMA32(vt_frag(lds + NSA_VT + T * 64 * VTP, vt_lane_off(lane), s4, eb), pf, ot[eb]);
                }
            }
            { const float gc = NSA_GATE(0);
#pragma unroll
            for (int k = 0; k < 16; ++k) { otl[64 * k] = ot[0][k] * gc; otl[64 * (16 + k)] = ot[1][k] * gc; } }
        }
    }
    __syncthreads();
#ifndef NO_NSA_SEL
    if (i < 16) { if (tid < 64) SEL[tid] = (2u << i) - 1u; if (tid < 3) UNI[tid] = (2u << i) - 1u; }
    else {
        const int tk = tid >> 3, sg = tid & 7; float v[32];
#pragma unroll
        for (int k = 0; k < 8; ++k) { const f32x4 x0 = *(const LAS f32x4*)(PS + tk * 32 + 4 * k), x1 = *(const LAS f32x4*)(PS + 2048 + tk * 32 + 4 * k), x2 = *(const LAS f32x4*)(PS + 4096 + tk * 32 + 4 * k);
            v[4 * k] = (x0.x + x1.x) + x2.x; v[4 * k + 1] = (x0.y + x1.y) + x2.y; v[4 * k + 2] = (x0.z + x1.z) + x2.z; v[4 * k + 3] = (x0.w + x1.w) + x2.w; }
#pragma unroll
        for (int s = 0; s < 32; ++s) { const bool forced = (s == 0) || (s == i) || (s == i - 1); float x = forced ? v[s] + 1e4f : v[s]; v[s] = s > i ? -1.f : x; }
        unsigned bits = 0u;
#pragma unroll
        for (int k = 0; k < 4; ++k) {
            float x = 0.f;
#pragma unroll
            for (int s = 0; s < 32; ++s) x = (s == 4 * sg + k) ? v[s] : x;
            int rank = 0;
#pragma unroll
            for (int s = 0; s < 32; ++s) rank += (v[s] > x || (v[s] == x && s < 4 * sg + k)) ? 1 : 0;
            if (rank < 16 && x >= 0.f) bits |= 1u << (4 * sg + k);
        }
        bits |= __shfl_xor(bits, 1); bits |= __shfl_xor(bits, 2); bits |= __shfl_xor(bits, 4);
        if (sg == 0) { SEL[tk] = bits; __hip_atomic_fetch_or(UNI, bits, __ATOMIC_RELAXED, __HIP_MEMORY_SCOPE_WORKGROUP); __hip_atomic_fetch_or(UNI + 1 + (tk >> 5), bits, __ATOMIC_RELAXED, __HIP_MEMORY_SCOPE_WORKGROUP); }
    }
#endif
    __syncthreads();
    const unsigned selbits = SEL[tl], uni = UNI[0], unih = UNI[1 + th];
    const float c31 = bl[255];
#ifndef NO_NSA_SLC
#ifndef NSA_DUP_SLC
#define NSA_DUP_SLC 1
#endif
    for (int rp_ = 0; rp_ < NSA_DUP_SLC; ++rp_) {
        AttnState A; attn_reset(A);
        const bf16_t* KS = (const bf16_t*)(ws + WS_PRJ + PRJ_KN1) + kvslab; const bf16_t* VS = (const bf16_t*)(ws + WS_PRJ + PRJ_VN1) + kvslab;
        unsigned todo = uni; int cur = 0; u32x4 kr2[2], vr2;
        int s = __ffs(todo) - 1; todo &= todo - 1;
        stage_k_load<64>(kr, KS + (size_t)s * 4096, tid); vr = stage_v_load(VS + (size_t)s * 4096, tid);
        stage_k_store<64>(kr, lds + NSA_KT, tid); stage_v_store(vr, lds + NSA_VT, tid);
        int sn = todo ? __ffs(todo) - 1 : -1; todo &= todo - 1;
        if (sn >= 0) { stage_k_load<64>(kr, KS + (size_t)sn * 4096, tid); vr = stage_v_load(VS + (size_t)sn * 4096, tid); }
        __syncthreads();
        while (s >= 0) {
            const int sn2 = todo ? __ffs(todo) - 1 : -1; todo &= todo - 1;
            if (sn2 >= 0) { stage_k_load<64>(kr2, KS + (size_t)sn2 * 4096, tid); vr2 = stage_v_load(VS + (size_t)sn2 * 4096, tid); }
            if (active && ((unih >> s) & 1u)) {
                f32x16 sc[2];
                attn_scores<64>(sc, qf, lds + NSA_KT + cur * 64 * 144, r, h);
                const bool sel = (selbits >> s) & 1u;
                if (i - s >= 3) attn_softmax_pv(A, sc, lds + NSA_VT + cur * 64 * VTP, r, h, c31, sel);
                else { nsa_mask_bias(sc, t - 64 * s, h, bl, sel, 4096); attn_softmax_pv(A, sc, lds + NSA_VT + cur * 64 * VTP, r, h); }
            }
            if (sn >= 0) { stage_k_store<64>(kr, lds + NSA_KT + (cur ^ 1) * 64 * 144, tid); stage_v_store(vr, lds + NSA_VT + (cur ^ 1) * 64 * VTP, tid); }
            kr[0] = kr2[0]; vr = vr2;
            __syncthreads();
            s = sn; sn = sn2; cur ^= 1;
        }
        if (active && rp_ == NSA_DUP_SLC - 1) { const float gs = NSA_GATE(1); const float inv = A.l > 0.f ? gs / A.l : 0.f;
#pragma unroll
            for (int k = 0; k < 16; ++k) { otl[64 * k] += A.o[0][k] * inv; otl[64 * (16 + k)] += A.o[1][k] * inv; } }
    }
#endif
#ifndef NO_NSA_WIN
#ifndef NSA_DUP_WIN
#define NSA_DUP_WIN 1
#endif
    for (int rq_ = 0; rq_ < NSA_DUP_WIN; ++rq_) {
        AttnState A; attn_reset(A);
        const bf16_t* KW = (const bf16_t*)(ws + WS_PRJ + PRJ_KN2) + kvslab; const bf16_t* VW = (const bf16_t*)(ws + WS_PRJ + PRJ_VN2) + kvslab;
        const int j0 = i > 8 ? i - 8 : 0; int cur = 0; u32x4 kr2[2], vr2;
        stage_k_load<64>(kr, KW + (size_t)j0 * 4096, tid); vr = stage_v_load(VW + (size_t)j0 * 4096, tid);
        stage_k_store<64>(kr, lds + NSA_KT, tid); stage_v_store(vr, lds + NSA_VT, tid);
        if (j0 < i) { stage_k_load<64>(kr, KW + (size_t)(j0 + 1) * 4096, tid); vr = stage_v_load(VW + (size_t)(j0 + 1) * 4096, tid); }
        __syncthreads();
        for (int j = j0; j <= i; ++j) {
            if (j + 2 <= i) { stage_k_load<64>(kr2, KW + (size_t)(j + 2) * 4096, tid); vr2 = stage_v_load(VW + (size_t)(j + 2) * 4096, tid); }
            if (active) {
                f32x16 sc[2];
                attn_scores<64>(sc, qf, lds + NSA_KT + cur * 64 * 144, r, h);
                if (i - j >= 3 && j > i - 8) attn_softmax_pv(A, sc, lds + NSA_VT + cur * 64 * VTP, r, h, c31, true);
                else { nsa_mask_bias(sc, t - 64 * j, h, bl, true, 512); attn_softmax_pv(A, sc, lds + NSA_VT + cur * 64 * VTP, r, h); }
            }
            if (j < i) { stage_k_store<64>(kr, lds + NSA_KT + (cur ^ 1) * 64 * 144, tid); stage_v_store(vr, lds + NSA_VT + (cur ^ 1) * 64 * VTP, tid); }
            kr[0] = kr2[0]; vr = vr2;
            __syncthreads();
            cur ^= 1;
        }
        if (active && rq_ == NSA_DUP_WIN - 1) { const float gw = NSA_GATE(2); const float inv = A.l > 0.f ? gw / A.l : 0.f;
            float ss = 0.f; bf16_t* Y = (bf16_t*)(ws + WS_Y) + row * 1024 + head * 64;
#pragma unroll
            for (int eb = 0; eb < 2; ++eb)
#pragma unroll
                for (int g4 = 0; g4 < 4; ++g4) {
                    const float v0 = otl[64 * (16 * eb + 4 * g4)] + A.o[eb][4 * g4] * inv, v1 = otl[64 * (16 * eb + 4 * g4 + 1)] + A.o[eb][4 * g4 + 1] * inv;
                    const float v2 = otl[64 * (16 * eb + 4 * g4 + 2)] + A.o[eb][4 * g4 + 2] * inv, v3 = otl[64 * (16 * eb + 4 * g4 + 3)] + A.o[eb][4 * g4 + 3] * inv;
                    u32x2 pw; pw.x = pk_bf16(v0, v1); pw.y = pk_bf16(v2, v3);
                    const float f0 = bf_lo(pw.x), f1 = bf_hi(pw.x), f2 = bf_lo(pw.y), f3 = bf_hi(pw.y); ss += (f0 * f0 + f1 * f1) + (f2 * f2 + f3 * f3);
                    *(u32x2*)(Y + 32 * eb + 8 * g4 + 4 * h) = pw;
                }
            ss += __shfl_xor(ss, 32);
            if (h == 0) ((float*)(ws + WS_SSQ + PT_A))[((size_t)l * 16384 + row) * 8 + head] = ss;
        }
    }
#endif
}

__device__ __forceinline__ void ml_out_wave(int cu, int l, InPtr in, unsigned char* ws, LAS unsigned char* wl, LAS unsigned char* npl, int lane) {
    const int c = cu & 31, bh = cu >> 5, hd = bh & 3, b = bh >> 2; const int t0 = c * 64; const int r = lane & 15, q = lane >> 4;
    const bf16_t* QC = (const bf16_t*)(ws + WS_ML) + ((size_t)bh * 2048 + t0) * 64; const bf16_t* KC = (const bf16_t*)(ws + WS_ML + ML_KC) + ((size_t)bh * 2048 + t0) * 64;
    const bf16_t* V = (const bf16_t*)(ws + WS_PRJ + PRJ_VML) + ((size_t)bh * 2048 + t0) * 64;
    const float* mlg = (const float*)(ws + WS_ML + ML_G) + ((size_t)bh * 2048 + t0) * 2;
    const bf16_t* CP = (const bf16_t*)(ws + WS_ML + ML_CP) + (size_t)cu * 4096; const bf16_t* NP = (const bf16_t*)(ws + WS_ML + ML_NP) + (size_t)cu * 64;
    bf16x8 aq[4][2];
#pragma unroll
    for (int mb = 0; mb < 4; ++mb)
#pragma unroll
        for (int ks = 0; ks < 2; ++ks) aq[mb][ks] = *(const bf16x8*)(QC + (size_t)(16 * mb + r) * 64 + 32 * ks + 8 * q);
    float bj[4][4], den[4][4];
#pragma unroll
    for (int mb = 0; mb < 4; ++mb)
#pragma unroll
        for (int j = 0; j < 4; ++j) bj[mb][j] = mlg[(16 * mb + 4 * q + j) * 2];
    {
        float cs[4];
#pragma unroll
        for (int nb = 0; nb < 4; ++nb) { const float2 gg = *(const float2*)(mlg + (16 * nb + r) * 2); cs[nb] = gg.y - gg.x; }
#pragma unroll
        for (int mb = 0; mb < 4; ++mb) {
            f32x4 accS[4];
#pragma unroll
            for (int nb = 0; nb < 4; ++nb) { accS[nb] = (f32x4){0.f, 0.f, 0.f, 0.f};
#pragma unroll
                for (int ks = 0; ks < 2; ++ks) { const bf16x8 bk = *(const bf16x8*)(KC + (size_t)(16 * nb + r) * 64 + 32 * ks + 8 * q); accS[nb] = MFMA16(aq[mb][ks], bk, accS[nb]); } }
#pragma unroll
            for (int j = 0; j < 4; ++j) {
                const int jj = 16 * mb + 4 * q + j; float rs = 0.f;
#pragma unroll
                for (int nb = 0; nb < 4; ++nb) { const int s = 16 * nb + r; const float p = s <= jj ? accS[nb][j] * __expf(bj[mb][j] + cs[nb]) : 0.f; rs += p;
                    *(LAS bf16_t*)(wl + 8192 + swz_off(jj, s >> 3) + (s & 7) * 2) = f2bf(p); }
                rs += __shfl_xor(rs, 1); rs += __shfl_xor(rs, 2); rs += __shfl_xor(rs, 4); rs += __shfl_xor(rs, 8);
                den[mb][j] = rs;
            }
        }
    }
#pragma unroll
    for (int mb = 0; mb < 4; ++mb) { const float e = __expf(mlg[(16 * mb + r) * 2]);
#pragma unroll
        for (int ks = 0; ks < 2; ++ks) { const u32x4 x = __builtin_bit_cast(u32x4, aq[mb][ks]); u32x4 y;
            y.x = pk_bf16(bf_lo(x.x) * e, bf_hi(x.x) * e); y.y = pk_bf16(bf_lo(x.y) * e, bf_hi(x.y) * e); y.z = pk_bf16(bf_lo(x.z) * e, bf_hi(x.z) * e); y.w = pk_bf16(bf_lo(x.w) * e, bf_hi(x.w) * e);
            aq[mb][ks] = __builtin_bit_cast(bf16x8, y); } }
    f32x4 acc[4][4], accn[4];
#pragma unroll
    for (int mb = 0; mb < 4; ++mb) { accn[mb] = (f32x4){0.f, 0.f, 0.f, 0.f};
#pragma unroll
        for (int nb = 0; nb < 4; ++nb) acc[mb][nb] = (f32x4){0.f, 0.f, 0.f, 0.f}; }
#pragma unroll
    for (int ks = 0; ks < 2; ++ks) {
        u32x4 nz = *(const u32x4*)(NP + 32 * ks + 8 * q); if (r != 0) nz = (u32x4){0u, 0u, 0u, 0u};
        const bf16x8 bn = __builtin_bit_cast(bf16x8, nz);
#pragma unroll
        for (int nb = 0; nb < 4; ++nb) { const bf16x8 bb = *(const bf16x8*)(CP + (size_t)(16 * nb + r) * 64 + 32 * ks + 8 * q);
#pragma unroll
            for (int mb = 0; mb < 4; ++mb) acc[mb][nb] = MFMA16(aq[mb][ks], bb, acc[mb][nb]); }
#pragma unroll
        for (int mb = 0; mb < 4; ++mb) accn[mb] = MFMA16(aq[mb][ks], bn, accn[mb]);
    }
#pragma unroll
    for (int s8 = 0; s8 < 8; ++s8) { float vb[8];
#pragma unroll
        for (int j = 0; j < 8; ++j) vb[j] = bf2f(V[(size_t)(s8 * 8 + j) * 64 + lane]);
        u32x4 pk; pk.x = pk_bf16(vb[0], vb[1]); pk.y = pk_bf16(vb[2], vb[3]); pk.z = pk_bf16(vb[4], vb[5]); pk.w = pk_bf16(vb[6], vb[7]);
        *(LAS u32x4*)(wl + swz_off(lane, s8)) = pk; }
    LDS_FENCE();
#pragma unroll
    for (int ks = 0; ks < 2; ++ks) {
        bf16x8 ap[4];
#pragma unroll
        for (int mb = 0; mb < 4; ++mb) ap[mb] = *(const LAS bf16x8*)(wl + 8192 + swz_off(16 * mb + r, 4 * ks + q));
#pragma unroll
        for (int nb = 0; nb < 4; ++nb) { const bf16x8 bv = *(const LAS bf16x8*)(wl + swz_off(16 * nb + r, 4 * ks + q));
#pragma unroll
            for (int mb = 0; mb < 4; ++mb) acc[mb][nb] = MFMA16(ap[mb], bv, acc[mb][nb]); }
    }
    LDS_FENCE();
    const float* gain = in->p[14] + l * 256 + hd * 64; const bf16_t* OG = (const bf16_t*)(ws + WS_PRJ + PRJ_OG);
    bf16_t* Y = (bf16_t*)(ws + WS_Y);
#pragma unroll
    for (int mb = 0; mb < 4; ++mb)
#pragma unroll
        for (int j = 0; j < 4; ++j) {
            const int jj = 16 * mb + 4 * q + j;
            const float dn = den[mb][j] + __builtin_bit_cast(float, __builtin_amdgcn_ds_bpermute((lane & 48) << 2, __builtin_bit_cast(int, accn[mb][j])));
            const float inv = 1.f / fmaxf(fabsf(dn), 1.f); float hv[4]; float ss = 0.f;
#pragma unroll
            for (int nb = 0; nb < 4; ++nb) { hv[nb] = acc[mb][nb][j] * inv; ss += hv[nb] * hv[nb]; }
            ss += __shfl_xor(ss, 1); ss += __shfl_xor(ss, 2); ss += __shfl_xor(ss, 4); ss += __shfl_xor(ss, 8);
            const float rstd = rsqrtf(ss * (1.f / 64.f) + 1e-6f); const size_t row = (size_t)b * 2048 + t0 + jj;
#pragma unroll
            for (int nb = 0; nb < 4; ++nb) { const int e = 16 * nb + r; Y[row * 1024 + 768 + hd * 64 + e] = f2bf(hv[nb] * rstd * gain[e] * sigmf(bf2f(OG[row * 256 + hd * 64 + e]))); }
        }
}

__device__ __forceinline__ void ml_scan_unit(int bh, int l, unsigned char* ws, int g_wv) {
    int tid_ = TIDX; asm volatile("" : "+v"(tid_)); const int tid = tid_;
    const bf16_t* DL = (const bf16_t*)(ws + WS_ML + ML_DELTA) + (size_t)bh * 32 * 4096 + tid * 8; bf16_t* CP = (bf16_t*)(ws + WS_ML + ML_CP) + (size_t)bh * 32 * 4096 + tid * 8;
    const float* DN = (const float*)(ws + WS_ML + ML_DN) + (size_t)bh * 32 * 64; bf16_t* NP = (bf16_t*)(ws + WS_ML + ML_NP) + (size_t)bh * 32 * 64; const float* BL = (const float*)(ws + WS_ML + ML_BL) + bh * 32;
    float c[8]; float n = 0.f;
#pragma unroll
    for (int k = 0; k < 8; ++k) c[k] = 0.f;
#pragma unroll 1
    for (int c0 = 0; c0 < 32; c0 += 8) {
        u32x4 d[8]; float dn[8], co[8];
#pragma unroll
        for (int k = 0; k < 8; ++k) { d[k] = *(const u32x4*)(DL + (size_t)(c0 + k) * 4096); dn[k] = tid < 64 ? DN[(c0 + k) * 64 + tid] : 0.f; co[k] = __expf(BL[c0 + k]); }
#pragma unroll
        for (int k = 0; k < 8; ++k) {
            u32x4 o; o.x = pk_bf16(c[0], c[1]); o.y = pk_bf16(c[2], c[3]); o.z = pk_bf16(c[4], c[5]); o.w = pk_bf16(c[6], c[7]);
            *(u32x4*)(CP + (size_t)(c0 + k) * 4096) = o; if (tid < 64) NP[(c0 + k) * 64 + tid] = f2bf(n);
            c[0] = co[k] * c[0] + bf_lo(d[k].x); c[1] = co[k] * c[1] + bf_hi(d[k].x); c[2] = co[k] * c[2] + bf_lo(d[k].y); c[3] = co[k] * c[3] + bf_hi(d[k].y);
            c[4] = co[k] * c[4] + bf_lo(d[k].z); c[5] = co[k] * c[5] + bf_hi(d[k].z); c[6] = co[k] * c[6] + bf_lo(d[k].w); c[7] = co[k] * c[7] + bf_hi(d[k].w);
            n = co[k] * n + dn[k];
        }
    }
    asm volatile("s_waitcnt vmcnt(0)" ::: "memory"); __syncthreads();
    if (tid == 0) { __builtin_amdgcn_fence(__ATOMIC_RELEASE, "agent"); asm volatile("s_waitcnt vmcnt(0)" ::: "memory");
        __hip_atomic_fetch_add((unsigned*)(ws + WS_CTL) + CW_SCAN + 64 * l, 1u, __ATOMIC_RELAXED, __HIP_MEMORY_SCOPE_AGENT); }
}
__device__ __forceinline__ void ml_scan_wait(int l, unsigned char* ws, int g_wv) {
    if (TIDX == 0) { unsigned* p = (unsigned*)(ws + WS_CTL) + CW_SCAN + 64 * l; unsigned sp = 0;
        while (__hip_atomic_load(p, __ATOMIC_RELAXED, __HIP_MEMORY_SCOPE_AGENT) < 32u) { __builtin_amdgcn_s_sleep(2); if (++sp > (1u << 22)) break; }
        __builtin_amdgcn_fence(__ATOMIC_ACQUIRE, "agent"); asm volatile("s_waitcnt vmcnt(0)" ::: "memory"); }
    __syncthreads();
}

#ifndef DUP_NSA
#define DUP_NSA 1
#endif
#ifndef DUP_MLA
#define DUP_MLA 1
#endif
#ifndef DUP_ML
#define DUP_ML 1
#endif
#ifdef NO_MLA
#define MLA_CALL(...) do {} while (0)
#else
#define MLA_CALL(...) do { for (int rp = 0; rp < DUP_MLA; ++rp) { if (rp) __syncthreads(); mla_unit(__VA_ARGS__); } } while (0)
#endif
__device__ __forceinline__ void phase_mix(int l, InPtr in, unsigned char* ws, LAS unsigned char* lds, unsigned* qhead, int g_wv) {
    LAS int* slot = (LAS int*)(lds + LDS_MISC + 64);
    for (;;) {
        __syncthreads();
        if (TIDX == 0) *slot = (int)__hip_atomic_fetch_add(qhead, 1u, __ATOMIC_RELAXED, __HIP_MEMORY_SCOPE_AGENT);
        __syncthreads();
        int u = *slot;
        if (u >= 32 + 512 + 384 + 128) break;
        if (u < 32) { ml_scan_unit(u, l, ws, g_wv); continue; } u -= 32;
#ifndef NO_NSA
        if (u < 256) { const int i = 31 - (u >> 4), bh = u & 15; { for (int rp = 0; rp < DUP_NSA; ++rp) { if (rp) __syncthreads(); nsa_unit(bh >> 1, bh & 1, i, l, in, ws, lds, g_wv); } } continue; }
#endif
        u -= 256;
        if (u < 192) { const int qt = 7 - u / 48, bh = u % 48; MLA_CALL(bh / 6, bh % 6, qt, l, ws, lds, g_wv); continue; }
        u -= 192;
#ifndef NO_NSA
        if (u < 128) { const int i = 15 - (u >> 4), bh = u & 15; { for (int rp = 0; rp < DUP_NSA; ++rp) { if (rp) __syncthreads(); nsa_unit(bh >> 1, bh & 1, i, l, in, ws, lds, g_wv); } } continue; }
#endif
        u -= 128;
        if (u < 192) { const int qt = 3 - u / 48, bh = u % 48; MLA_CALL(bh / 6, bh % 6, qt, l, ws, lds, g_wv); continue; } u -= 192;
#ifndef NO_NSA
        if (u < 128) { const int i = 7 - (u >> 4), bh = u & 15; { for (int rp = 0; rp < DUP_NSA; ++rp) { if (rp) __syncthreads(); nsa_unit(bh >> 1, bh & 1, i, l, in, ws, lds, g_wv); } } continue; }
#endif
        u -= 128;
#ifndef NO_MLOUT
        ml_scan_wait(l, ws, g_wv);
        for (int rp = 0; rp < DUP_ML; ++rp) { int tid_ = TIDX; asm volatile("" : "+v"(tid_)); const int w = tid_ >> 6; ml_out_wave(u * 8 + w, l, in, ws, lds + w * 16384, lds + 131072 + w * 256, tid_ & 63); }
#endif
    }
}
__device__ __forceinline__ void phase_ynorm(int l, unsigned char* ws, int bid, int nb, int g_wv) {
    int tid_ = TIDX; asm volatile("" : "+v"(tid_)); const int w = tid_ >> 6, lane = tid_ & 63;
    bf16_t* Y = (bf16_t*)(ws + WS_Y); const float* sa = (const float*)(ws + WS_SSQ + PT_A) + (size_t)l * 16384 * 8; const float* sc = (const float*)(ws + WS_SSQ + PT_C) + (size_t)l * 16384 * 8;
    for (int r0 = (bid * 8 + w) * 8; r0 < NTOK; r0 += nb * 64) {
        if (lane < 48) {
            u32x4 x[8], y[8]; float ra[8], rc[8];
#pragma unroll
            for (int k = 0; k < 8; ++k) { const int row = r0 + k;
                const f32x4 a0 = *(const f32x4*)(sa + (size_t)row * 8), a1 = *(const f32x4*)(sa + (size_t)row * 8 + 4), c0 = *(const f32x4*)(sc + (size_t)row * 8), c1 = *(const f32x4*)(sc + (size_t)row * 8 + 4);
                ra[k] = rsqrtf((((a0.x + a0.y) + (a0.z + a0.w)) + (a1.x + a1.y)) * (1.f / 384.f) + 1e-6f); rc[k] = rsqrtf((((c0.x + c0.y) + (c0.z + c0.w)) + (c1.x + c1.y)) * (1.f / 384.f) + 1e-6f);
                x[k] = *((const u32x4*)(Y + (size_t)row * 1024) + lane); y[k] = *((const u32x4*)(Y + (size_t)row * 1024 + 384) + lane); }
#pragma unroll
            for (int k = 0; k < 8; ++k) { const int row = r0 + k; u32x4 a = x[k], c = y[k]; const float fa = ra[k], fc = rc[k];
                a.x = pk_bf16(bf_lo(a.x) * fa, bf_hi(a.x) * fa); a.y = pk_bf16(bf_lo(a.y) * fa, bf_hi(a.y) * fa); a.z = pk_bf16(bf_lo(a.z) * fa, bf_hi(a.z) * fa); a.w = pk_bf16(bf_lo(a.w) * fa, bf_hi(a.w) * fa);
                c.x = pk_bf16(bf_lo(c.x) * fc, bf_hi(c.x) * fc); c.y = pk_bf16(bf_lo(c.y) * fc, bf_hi(c.y) * fc); c.z = pk_bf16(bf_lo(c.z) * fc, bf_hi(c.z) * fc); c.w = pk_bf16(bf_lo(c.w) * fc, bf_hi(c.w) * fc);
                *((u32x4*)(Y + (size_t)row * 1024) + lane) = a; *((u32x4*)(Y + (size_t)row * 1024 + 384) + lane) = c; }
        }
    }
}
constexpr int LDS_FAC = 131072 + 2048;
__device__ __forceinline__ void outproj_factors(int l, unsigned char* ws, LAS unsigned char* lds, int pm, int tid) {
    asm volatile("" : "+v"(tid));
    if (tid < 256) { const int row = pm * 256 + tid; const float* sa = (const float*)(ws + WS_SSQ + PT_A) + ((size_t)l * 16384 + row) * 8; const float* sc = (const float*)(ws + WS_SSQ + PT_C) + ((size_t)l * 16384 + row) * 8;
        const f32x4 a0 = *(const f32x4*)sa, a1 = *(const f32x4*)(sa + 4), c0 = *(const f32x4*)sc, c1 = *(const f32x4*)(sc + 4);
        const float ra = rsqrtf((((a0.x + a0.y) + (a0.z + a0.w)) + (a1.x + a1.y)) * (1.f / 384.f) + 1e-6f), rc = rsqrtf((((c0.x + c0.y) + (c0.z + c0.w)) + (c1.x + c1.y)) * (1.f / 384.f) + 1e-6f);
        LAS float* F = (LAS float*)(lds + LDS_FAC); F[2 * tid] = ra / rc; F[2 * tid + 1] = rc; }
    __syncthreads();
}
struct EpiOut {
    static constexpr bool KHOOK = true;
    bf16_t* XB; float* ssq; const LAS float* F; bool fold;
    __device__ __forceinline__ void kscale(f32x4 (&acc)[2][2][4][2], int which, int wr, int fr) const {
        if (!fold) return;
#pragma unroll
        for (int ai = 0; ai < 2; ++ai)
#pragma unroll
            for (int m = 0; m < 4; ++m) { const float f = F[2 * (ai * 128 + wr * 64 + m * 16 + fr) + which];
#pragma unroll
                for (int bj = 0; bj < 2; ++bj)
#pragma unroll
                    for (int n = 0; n < 2; ++n) acc[ai][bj][m][n] = acc[ai][bj][m][n] * f; }
    }
    __device__ __forceinline__ void operator()(const f32x4 (&acc)[2][2][4][2], const GUnit& u, int wr, int wc, int fr, int fq) const {
#pragma unroll
        for (int ai = 0; ai < 2; ++ai)
#pragma unroll
          for (int mh = 0; mh < 2; ++mh) {
            __builtin_amdgcn_sched_barrier(0);
            u32x4 xr[2][2];
#pragma unroll
            for (int m2 = 0; m2 < 2; ++m2)
#pragma unroll
                for (int bj = 0; bj < 2; ++bj) xr[m2][bj] = *(const u32x4*)(XB + (size_t)(u.pm * 256 + ai * 128 + wr * 64 + (2 * mh + m2) * 16 + fr) * 1024 + u.pn * 256 + bj * 128 + wc * 32 + 8 * fq);
#pragma unroll
            for (int m2 = 0; m2 < 2; ++m2) {
                const int m = 2 * mh + m2; const int row = u.pm * 256 + ai * 128 + wr * 64 + m * 16 + fr; float ss = 0.f;
#pragma unroll
                for (int bj = 0; bj < 2; ++bj) {
                    const u32x4 x = xr[m2][bj]; u32x4 o;
                    o.x = pk_bf16(bf_lo(x.x) + acc[ai][bj][m][0][0], bf_hi(x.x) + acc[ai][bj][m][0][1]); o.y = pk_bf16(bf_lo(x.y) + acc[ai][bj][m][0][2], bf_hi(x.y) + acc[ai][bj][m][0][3]);
                    o.z = pk_bf16(bf_lo(x.z) + acc[ai][bj][m][1][0], bf_hi(x.z) + acc[ai][bj][m][1][1]); o.w = pk_bf16(bf_lo(x.w) + acc[ai][bj][m][1][2], bf_hi(x.w) + acc[ai][bj][m][1][3]);
                    *(u32x4*)(XB + (size_t)row * 1024 + u.pn * 256 + bj * 128 + wc * 32 + 8 * fq) = o;
                    ss += (bf_lo(o.x) * bf_lo(o.x) + bf_hi(o.x) * bf_hi(o.x)) + (bf_lo(o.y) * bf_lo(o.y) + bf_hi(o.y) * bf_hi(o.y)) + (bf_lo(o.z) * bf_lo(o.z) + bf_hi(o.z) * bf_hi(o.z)) + (bf_lo(o.w) * bf_lo(o.w) + bf_hi(o.w) * bf_hi(o.w));
                }
                ss = quad_sum(ss); if (fq == 0) ssq[(size_t)row * 16 + u.pn * 4 + wc] = ss;
            }
          }
    }
};

__device__ __forceinline__ float sum16(const float* p) { const f32x4 a = *(const f32x4*)p, b = *(const f32x4*)(p + 4), c = *(const f32x4*)(p + 8), d = *(const f32x4*)(p + 12);
    return (((a.x + a.y) + (a.z + a.w)) + ((b.x + b.y) + (b.z + b.w))) + (((c.x + c.y) + (c.z + c.w)) + ((d.x + d.y) + (d.z + d.w))); }
__device__ __forceinline__ void phase_route(int l, InPtr in, unsigned char* ws, LAS unsigned char* lds, int bid, int nb, int g_wv) {
    int tid_ = TIDX; asm volatile("" : "+v"(tid_)); const int w = tid_ >> 6, lane = tid_ & 63, r = lane & 15, q = lane >> 4;
    const bf16_t* XB = (const bf16_t*)(ws + WS_XB); const bf16_t* WR = (const bf16_t*)(ws + WS_WR) + (size_t)l * 64 * 1024;
    const float* ssq = (const float*)(ws + WS_SSQ + PT_X1) + (size_t)l * 16384 * 16; const float* bg = in->p[24] + l * 4; const float* be = in->p[26] + l * 32;
    unsigned* cnt = (unsigned*)(ws + WS_CTL) + CW_CNT + 2048 * l; unsigned* mtok = (unsigned*)(ws + WS_META); float* mw = (float*)(ws + WS_META + META_W);
    LAS float* lg = (LAS float*)(lds + w * 4096);
    LAS unsigned* lcnt = (LAS unsigned*)(lds + 32768); LAS unsigned* lbase = lcnt + 32;
    for (int g0 = bid * 8; g0 < NTOK / 16; g0 += nb * 8) {
        if (tid_ < 32) lcnt[tid_] = 0u;
        __syncthreads();
        const int tok0 = (g0 + w) * 16; f32x4 acc[3];
#pragma unroll
        for (int n = 0; n < 3; ++n) acc[n] = (f32x4){0.f, 0.f, 0.f, 0.f};
        const bf16_t* ap = XB + (size_t)(tok0 + r) * 1024 + 8 * q; const bf16_t* bp = WR + (size_t)r * 1024 + 8 * q;
#pragma unroll 1
        for (int kc = 0; kc < 4; ++kc) {
            bf16x8 a[8], bb[3][8];
#pragma unroll
            for (int s = 0; s < 8; ++s) { a[s] = *(const bf16x8*)(ap + 32 * (kc * 8 + s));
#pragma unroll
                for (int n = 0; n < 3; ++n) bb[n][s] = *(const bf16x8*)(bp + (size_t)n * 16 * 1024 + 32 * (kc * 8 + s)); }
            __builtin_amdgcn_sched_barrier(0);
#pragma unroll
            for (int s = 0; s < 8; ++s)
#pragma unroll
                for (int n = 0; n < 3; ++n) acc[n] = MFMA16(a[s], bb[n][s], acc[n]);
            __builtin_amdgcn_sched_barrier(0);
        }
#pragma unroll
        for (int n = 0; n < 3; ++n)
#pragma unroll
            for (int j = 0; j < 4; ++j) lg[(4 * q + j) * 48 + 16 * n + r] = acc[n][j];
        LDS_FENCE();
        int E0 = 0, E1 = 0; unsigned r0 = 0, r1 = 0; float wt0 = 0.f, wt1 = 0.f; const int tok = tok0 + (lane & 15);
        if (lane < 16) {
            const float rs = rsqrtf(sum16(ssq + (size_t)tok * 16) * (1.f / 1024.f) + 1e-6f); ((float*)(ws + WS_RS2))[tok] = rs; const LAS float* L = lg + lane * 48;
            float gl[4]; int gi = 0;
#pragma unroll
            for (int j = 0; j < 4; ++j) gl[j] = L[j] * rs + bg[j];
            float gm = gl[0];
#pragma unroll
            for (int j = 1; j < 4; ++j) if (gl[j] > gm) { gm = gl[j]; gi = j; }
            float gsum = 0.f;
#pragma unroll
            for (int j = 0; j < 4; ++j) gsum += __expf(gl[j] - gm);
            const float gtop = 1.f / gsum;
            float el[8];
#pragma unroll
            for (int j = 0; j < 8; ++j) el[j] = L[4 + gi * 8 + j] * rs + be[gi * 8 + j];
            int e0 = 0; float v0 = el[0];
#pragma unroll
            for (int j = 1; j < 8; ++j) if (el[j] > v0) { v0 = el[j]; e0 = j; }
            int e1 = -1; float v1 = -3.0e38f;
#pragma unroll
            for (int j = 0; j < 8; ++j) if (j != e0 && el[j] > v1) { v1 = el[j]; e1 = j; }
            const float w0 = 1.f / (1.f + __expf(v1 - v0)); E0 = gi * 8 + e0; E1 = gi * 8 + e1; wt0 = w0 * gtop; wt1 = (1.f - w0) * gtop;
            r0 = __hip_atomic_fetch_add(lcnt + E0, 1u, __ATOMIC_RELAXED, __HIP_MEMORY_SCOPE_WORKGROUP); r1 = __hip_atomic_fetch_add(lcnt + E1, 1u, __ATOMIC_RELAXED, __HIP_MEMORY_SCOPE_WORKGROUP);
        }
        __syncthreads();
        if (tid_ < 32) { const unsigned c = lcnt[tid_]; lbase[tid_] = c ? atomicAdd(cnt + tid_ * 64, c) : 0u; }
        __syncthreads();
        if (lane < 16) {
            const unsigned p0 = lbase[E0] + r0, p1 = lbase[E1] + r1;
            mtok[(size_t)E0 * 16384 + p0] = (unsigned)tok; mw[(size_t)E0 * 16384 + p0] = wt0;
            mtok[(size_t)E1 * 16384 + p1] = (unsigned)tok | 0x80000000u; mw[(size_t)E1 * 16384 + p1] = wt1;
        }
        __syncthreads();
    }
}

constexpr int LDS_TB = 131072 + 2048;
__device__ __forceinline__ void moe_tables(int l, unsigned char* ws, LAS unsigned char* lds, int g_wv) {
    int tix = TIDX; asm volatile("" : "+v"(tix));
    LAS int* tb = (LAS int*)(lds + LDS_TB);
    if (tix < 32) { const unsigned* cnt = (const unsigned*)(ws + WS_CTL) + CW_CNT + 2048 * l; tb[160 + tix] = (int)__hip_atomic_load(cnt + tix * 64, __ATOMIC_RELAXED, __HIP_MEMORY_SCOPE_AGENT); }
    __syncthreads();
    if (tix == 0) { int a = 0, f = 0, p = 0; for (int e = 0; e < 32; ++e) { const int c = tb[160 + e]; tb[e] = a; tb[48 + e] = f; tb[96 + e] = p; a += (c + 255) >> 8; f += c >> 8; p += (c & 255) ? 1 : 0; } tb[32] = a; tb[80] = f; tb[128] = p; }
    __syncthreads();
}
template <int NPN, bool GATHER_>
struct MoeSched {
    static constexpr bool GATHER = GATHER_, PARTIAL = false;
    const char* A; const char* Bt; const unsigned* cnt; const unsigned* mtok; const LAS int* tb; int G, c; size_t bstride_e  , bstride_pn; int lo, hi;
    __device__ __forceinline__ bool next(int i, GUnit& u) const {
        const int L = lo + i * G + c; if (L >= hi) return false;
        const int tile = L / NPN, pn = L % NPN;
        int e = 0;
        for (int k = 1; k < 32; ++k) e = (tb[k] <= tile) ? k : e;
        e = __builtin_amdgcn_readfirstlane(e);
        u.e = e; u.pm = tile; u.pn = pn; u.rows = tb[160 + e] - 256 * (tile - tb[e]);
        u.a = GATHER ? A : A + (size_t)tile * 256 * 256 * 2;
        u.b = Bt + (size_t)e * bstride_e + (size_t)pn * bstride_pn; return true;
    }
    __device__ __forceinline__ void aoff(const GUnit& u, unsigned (&v)[2][2], const int (&R)[2], const int (&C)[2]) const {
#pragma unroll
        for (int h = 0; h < 2; ++h)
#pragma unroll
            for (int i = 0; i < 2; ++i) {
                if (GATHER) { const int lr = h * 128 + R[i]; const int rr = 256 * (u.pm - tb[u.e]) + (lr < u.rows ? lr : 0); const unsigned tok = mtok[(size_t)u.e * 16384 + rr] & 0x7fffffffu; v[h][i] = (tok * 1024u + (unsigned)C[i]) * 2u; }
                else v[h][i] = (unsigned)((h * 128 + R[i]) * 256 + C[i]) * 2u;
            }
    }
};
struct EpiMoeUp {
    static constexpr bool KHOOK = false;
    const unsigned* mtok; const float* ssq; const LAS int* tb; bf16_t* HB;
    __device__ __forceinline__ void operator()(const f32x4 (&acc)[2][2][4][2], const GUnit& u, int wr, int wc, int fr, int fq) const {
        const int r0 = 256 * (u.pm - tb[u.e]);
        float rs8[8];
        { unsigned tk[8];
#pragma unroll
          for (int k = 0; k < 8; ++k) { const int lr = (k >> 2) * 128 + wr * 64 + (k & 3) * 16 + fr; tk[k] = mtok[(size_t)u.e * 16384 + r0 + (lr < u.rows ? lr : 0)] & 0x7fffffffu; }
#pragma unroll
          for (int k = 0; k < 8; ++k) rs8[k] = ssq[tk[k]]; }
#pragma unroll
        for (int ai = 0; ai < 2; ++ai)
#pragma unroll
            for (int m = 0; m < 4; ++m) {
                __builtin_amdgcn_sched_barrier(0);
                const int lr = ai * 128 + wr * 64 + m * 16 + fr;
                if (lr < u.rows) {
                    const float rs = rs8[ai * 4 + m];
                    float hv[8];
#pragma unroll
                    for (int n = 0; n < 2; ++n)
#pragma unroll
                        for (int j = 0; j < 4; ++j) { const float gv = acc[ai][0][m][n][j] * rs, uv = acc[ai][1][m][n][j] * rs; hv[4 * n + j] = siluf(gv) * uv; }
                    st_bf16x8(HB + ((size_t)u.pm * 256 + lr) * 256 + u.pn * 128 + wc * 32 + 8 * fq, hv);
                }
            }
    }
};
struct EpiMoeDown {
    static constexpr bool KHOOK = false;
    const unsigned* mtok; const float* mw; const LAS int* tb; bf16_t* YB;
    __device__ __forceinline__ void operator()(const f32x4 (&acc)[2][2][4][2], const GUnit& u, int wr, int wc, int fr, int fq) const {
        const int r0 = 256 * (u.pm - tb[u.e]);
        unsigned mt8[8]; float wt8[8];
#pragma unroll
        for (int k = 0; k < 8; ++k) { const int lr = (k >> 2) * 128 + wr * 64 + (k & 3) * 16 + fr; const size_t ix = (size_t)u.e * 16384 + r0 + (lr < u.rows ? lr : 0); mt8[k] = mtok[ix]; wt8[k] = mw[ix]; }
#pragma unroll
        for (int ai = 0; ai < 2; ++ai)
#pragma unroll
            for (int m = 0; m < 4; ++m) {
                __builtin_amdgcn_sched_barrier(0);
                const int lr = ai * 128 + wr * 64 + m * 16 + fr;
                if (lr < u.rows) {
                    const unsigned mt = mt8[ai * 4 + m]; const float wt = wt8[ai * 4 + m];
                    bf16_t* dst = YB + ((size_t)(mt >> 31) * 16384 + (mt & 0x7fffffffu)) * 1024 + u.pn * 256 + wc * 32 + 8 * fq;
#pragma unroll
                    for (int bj = 0; bj < 2; ++bj) { float v[8];
#pragma unroll
                        for (int n = 0; n < 2; ++n)
#pragma unroll
                            for (int j = 0; j < 4; ++j) v[4 * n + j] = acc[ai][bj][m][n][j] * wt;
                        st_bf16x8(dst + bj * 128, v); }
                }
            }
    }
};
__device__ __forceinline__ void phase_combine(int l, unsigned char* ws, float* out, int bid, int nb, int g_wv) {
    int tid_ = TIDX; asm volatile("" : "+v"(tid_)); const int w = tid_ >> 6, lane = tid_ & 63;
    bf16_t* XB = (bf16_t*)(ws + WS_XB); const bf16_t* Y0 = (const bf16_t*)(ws + WS_YBUF); const bf16_t* Y1 = Y0 + (size_t)16384 * 1024; float* ssqx = (float*)(ws + WS_SSQX) + 16384;
    for (int row = bid * 8 + w; row < NTOK; row += nb * 8) {
        float ss = 0.f;
#pragma unroll
        for (int k = 0; k < 2; ++k) {
            const size_t o = (size_t)row * 1024 + (lane + 64 * k) * 8;
            const u32x4 x = *(const u32x4*)(XB + o), a = *(const u32x4*)(Y0 + o), c = *(const u32x4*)(Y1 + o);
            float v[8] = { bf_lo(x.x) + bf_lo(a.x) + bf_lo(c.x), bf_hi(x.x) + bf_hi(a.x) + bf_hi(c.x), bf_lo(x.y) + bf_lo(a.y) + bf_lo(c.y), bf_hi(x.y) + bf_hi(a.y) + bf_hi(c.y),
                           bf_lo(x.z) + bf_lo(a.z) + bf_lo(c.z), bf_hi(x.z) + bf_hi(a.z) + bf_hi(c.z), bf_lo(x.w) + bf_lo(a.w) + bf_lo(c.w), bf_hi(x.w) + bf_hi(a.w) + bf_hi(c.w) };
            if (l == L_ - 1 && out) { *(f32x4*)(out + o) = (f32x4){v[0], v[1], v[2], v[3]}; *(f32x4*)(out + o + 4) = (f32x4){v[4], v[5], v[6], v[7]}; }
            else { u32x4 p; p.x = pk_bf16(v[0], v[1]); p.y = pk_bf16(v[2], v[3]); p.z = pk_bf16(v[4], v[5]); p.w = pk_bf16(v[6], v[7]); *(u32x4*)(XB + o) = p;
#pragma unroll
                   for (int j = 0; j < 4; ++j) { const unsigned q = j == 0 ? p.x : (j == 1 ? p.y : (j == 2 ? p.z : p.w)); ss += bf_lo(q) * bf_lo(q) + bf_hi(q) * bf_hi(q); } }
        }
        if (l < L_ - 1) { ss = wave_sum(ss); if (lane == 0) ssqx[row] = ss; }
    }
}
constexpr int MOE_CVT_SPLIT = 4608;
#ifndef NROUTE
#define NROUTE 128
#endif
constexpr int NPH = 9;
enum { PH_INPROJ = 0, PH_PREP, PH_MIX, PH_YNORM, PH_OUTPROJ, PH_ROUTE, PH_MOEUP, PH_MOEDOWN, PH_COMBINE };
struct Args { Inputs in; float* out; unsigned char* ws; int ph_lo, ph_hi; };

__global__ void __launch_bounds__(512, 2) mk(Args args) {
    extern __shared__ __attribute__((aligned(16))) unsigned char lds_raw[];
    LAS unsigned char* lds = (LAS unsigned char*)lds_raw;
    const int g_wv = __builtin_amdgcn_readfirstlane((int)threadIdx.x >> 6);
    const int bid0 = blockIdx.x, nb = gridDim.x;
#define BID() ({ int b_ = bid0; asm volatile("" : "+s"(b_)); b_; })
    unsigned char* ws = args.ws; unsigned* ctl = (unsigned*)(ws + WS_CTL);
    const int lo = args.ph_lo, hi = args.ph_hi;
    if (TIDX < 4) ((LAS unsigned*)(lds + LDS_MISC))[TIDX] = 0u;
    __syncthreads();
    XcdBarrier bar; bar.g_wv = g_wv; bar.bar = ctl + CW_BAR; bar.x = 0; bar.st = nullptr;
    if (hi - lo > 1) bar = xcd_barrier_post(ctl + CW_BAR, (volatile LAS unsigned*)(lds + LDS_MISC), g_wv);
#define IN(k) (lo <= (k) && (k) < hi)
#ifndef REPEAT_PH
#define REPEAT_PH -1
#endif
#define NREP(k) ((REPEAT_PH == (k)) ? 2 : 1)
#ifndef NBAR
#define NBAR 1
#endif
#ifndef TIME_PH
#define TIME_PH -1
#endif
#define STAMP(i) do { if (TIME_PH != -1 && blockIdx.x == 0 && TIDX == 0) ((unsigned long long*)(ctl + CW_TS))[i] = __builtin_amdgcn_s_memrealtime(); } while (0)
#define SEAM(k) do { if (IN(k) && IN((k) + 1)) for (int nb_ = 0; nb_ < NBAR; ++nb_) xcd_barrier(bar); STAMP((k) + 1); } while (0)
    STAMP(0);
#ifndef NO_PRO
    if (IN(0)) for (int rep = 0; rep < NREP(100); ++rep) { prologue(in_tab(), launder(ws), lds, BID(), nb, g_wv); if (rep + 1 < NREP(100)) xcd_barrier(bar); }
#endif
    SEAM(0);
    for (int l = 0; l < L_; ++l) {
        const int pb = 1 + l * NPH;
        if (IN(pb + PH_INPROJ)) for (int rep = 0; rep < NREP(PH_INPROJ); ++rep) {
            if (rep) xcd_barrier(bar);
            InPtr in = in_tab(); unsigned char* ws = launder(args.ws);
            g8::DenseSched S{(const char*)(ws + WS_XB), (const char*)(ws + WS_WIN) + (size_t)l * 2560 * 1024 * 2, 1024, 1024, 64, 10, nb, BID()};
            EpiInProj E{(const float*)(ws + WS_SSQX) + l * 16384, (float*)(ws + WS_SSQ + PT_DQ) + (size_t)l * 16384 * 4, (float*)(ws + WS_SSQ + PT_DKV) + (size_t)l * 16384 * 2,
                        in->p[8] + l * 64, in->p[9] + l * 64, in->p[19] + l * 192 + 96 + 64, (const float*)(ws + WS_ROPE), ws + WS_PRJ};
#ifndef NO_INPROJ
            g8::gemm_run(lds, 1024, 1024, S, E, g_wv);
#endif
        }
        SEAM(pb + PH_INPROJ);
        if (IN(pb + PH_PREP)) for (int rep = 0; rep < NREP(PH_PREP); ++rep) { if (rep) xcd_barrier(bar); phase_prep(l, in_tab(), launder(ws), lds, BID(), nb, g_wv, (unsigned*)launder(ws) + CW_Q + 64 * (4 + l + 2 * rep)); }
        SEAM(pb + PH_PREP);
        if (IN(pb + PH_MIX)) for (int rep = 0; rep < NREP(PH_MIX); ++rep) { if (rep) xcd_barrier(bar); phase_mix(l, in_tab(), launder(ws), lds, (unsigned*)launder(ws) + CW_Q + 64 * (l + 2 * rep), g_wv); }
        SEAM(pb + PH_MIX);
        const bool fold_norm = (nb == 256);
        if (IN(pb + PH_YNORM) && !fold_norm) phase_ynorm(l, launder(ws), BID(), nb, g_wv);
        if (!fold_norm) SEAM(pb + PH_YNORM);
        if (IN(pb + PH_OUTPROJ)) {
            unsigned char* ws = launder(args.ws);
            g8::DenseSched S{(const char*)(ws + WS_Y), (const char*)(ws + WS_WOUT) + (size_t)l * 1024 * 1024 * 2, 1024, 1024, 64, 4, nb, BID()};
            EpiOut E{(bf16_t*)(ws + WS_XB), (float*)(ws + WS_SSQ + PT_X1) + (size_t)l * 16384 * 16, (const LAS float*)(lds + LDS_FAC), fold_norm};
            if (fold_norm) { g8::GUnit u0; if (S.next(0, u0)) outproj_factors(l, ws, lds, u0.pm, TIDX); else __syncthreads(); }
#ifndef NO_OUTPROJ
            g8::gemm_run(lds, 1024, 1024, S, E, g_wv);
#endif
        }
        SEAM(pb + PH_OUTPROJ);
#ifndef NO_ROUTE
        if (IN(pb + PH_ROUTE)) {
            const int b_ = BID();
            if (nb >= 256 && b_ >= NROUTE) { cvt_moe_layer(in_tab(), launder(ws), l, (LAS float*)lds, b_ - NROUTE, nb - NROUTE, TIDX);
#ifdef DUP_CVT
                __syncthreads(); cvt_moe_layer(in_tab(), launder(ws), l, (LAS float*)lds, b_ - NROUTE, nb - NROUTE, TIDX);
#endif
            }
            else { phase_route(l, in_tab(), launder(ws), lds, b_, nb >= 256 ? NROUTE : nb, g_wv); if (nb < 256) cvt_moe_layer(in_tab(), launder(ws), l, (LAS float*)lds, b_, nb, TIDX); }
            if (l + 1 < L_) { __syncthreads(); cvt_small_weights(in_tab(), launder(ws), l + 1, (LAS float*)lds, b_, nb, TIDX); }
        }
#endif
        SEAM(pb + PH_ROUTE);
        {
            const bool do_up = IN(pb + PH_MOEUP), do_dn = IN(pb + PH_MOEDOWN), fuse = do_up && do_dn;
            for (int part = 0; part < (fuse ? 3 : 1); ++part) {
                if (part) xcd_barrier(bar);
                unsigned char* ws = launder(args.ws);
                if (do_up || do_dn) moe_tables(l, ws, lds, g_wv);
                const unsigned* cnt = (const unsigned*)(ws + WS_CTL) + CW_CNT + 2048 * l; const unsigned* mtok = (const unsigned*)(ws + WS_META); const LAS int* tb = (const LAS int*)(lds + LDS_TB);
                const int b_ = BID(), ntile = tb[32], UPU = 2 * ntile, DNU = 4 * ntile;
                const int hi0 = UPU < nb ? UPU : nb, nu_ = UPU - hi0, nu = nu_ < (nb >> 1) ? nu_ : (nb >> 1), nd = nb - nu;
                const int d1a = 4 * (hi0 >> 1), d1b = 2 * nd, D1 = nu == 0 ? DNU : (d1a < d1b ? d1a : d1b);
                int ulo = 0, uhi = UPU, uG = nb, uc = b_, dlo = 0, dhi = DNU, dG = nb, dc = b_;
                if (fuse) {
                    if (part == 0) { uhi = hi0; dhi = 0; }
                    else if (part == 1) { ulo = hi0; uG = nu; if (b_ >= nu) uhi = ulo; dhi = D1; dG = nd; dc = b_ - nu; if (b_ < nu) dhi = 0; }
                    else { uhi = 0; dlo = D1; }
                }
                if (do_up && uhi > ulo) {
                    MoeSched<2, true> S{(const char*)(ws + WS_XB), (const char*)(ws + WS_WMOE), cnt, mtok, tb, uG, uc, (size_t)512 * 1024 * 2, (size_t)256 * 1024 * 2, ulo, uhi};
                    EpiMoeUp E{mtok, (const float*)(ws + WS_RS2), tb, (bf16_t*)(ws + WS_HBUF)};
#ifndef NO_MOEUP
                    g8::gemm_run(lds, 1024, 1024, S, E, g_wv);
#endif
                }
                if (do_dn && dhi > dlo) {
                    MoeSched<4, false> S{(const char*)(ws + WS_HBUF), (const char*)(ws + WS_WMOE + WMOE_WD), cnt, mtok, tb, dG, dc, (size_t)1024 * 256 * 2, (size_t)256 * 256 * 2, dlo, dhi};
                    EpiMoeDown E{mtok, (const float*)(ws + WS_META + META_W), tb, (bf16_t*)(ws + WS_YBUF)};
#ifndef NO_MOEDOWN
                    g8::gemm_run(lds, 256, 256, S, E, g_wv);
#endif
                }
            }
        }
        SEAM(pb + PH_MOEDOWN);
#ifndef NO_COMBINE
        if (IN(pb + PH_COMBINE)) { unsigned char* ws = launder(args.ws); phase_combine(l, ws, args.out, BID(), nb, g_wv); }
#endif
        SEAM(pb + PH_COMBINE);
    }
#undef IN
#undef SEAM
}
#if CHECK
struct NvScratch { float *proj, *h1, *qk, *hraw, *kn, *kcmp, *vcmp, *dqn, *q, *dkvn, *kv, *krope, *y, *x1, *xl; int* rt_e; float* rt_w; };
constexpr int CB = 5;
enum { NS_INPROJ = 0, NS_NSAPREP, NS_MLAPREP, NS_NSA, NS_ML, NS_MLA, NS_OUT, NS_ROUTE, NS_MOE };
static void naive_step(void* const* d_in, int l, int step, const float* xin, float* xout, const NvScratch& S, hipStream_t st) {
    const int b = CB;
    const float* rel_bias = (const float*)d_in[2];
    const float* norm1_g = (const float*)d_in[3] + (long)l * 1024;
    const float* w_in = (const float*)d_in[4] + (long)l * 1024 * DIN;
    const float* cmp_pe = (const float*)d_in[5] + (long)l * 2 * 32 * 64;
    const float* cmp_w1 = (const float*)d_in[6] + (long)l * 2 * 32 * 64 * 64;
    const float* cmp_w2 = (const float*)d_in[7] + (long)l * 2 * 64 * 64;
    const float* q_norm = (const float*)d_in[8] + l * 64;
    const float* k_norm = (const float*)d_in[9] + l * 64;
    const float* nsa_on = (const float*)d_in[10] + l * 384;
    const float* conv = (const float*)d_in[11] + l * 4 * 512;
    const float* ibias = (const float*)d_in[12] + l * 4;
    const float* fbias = (const float*)d_in[13] + l * 4;
    const float* ml_on = (const float*)d_in[14] + l * 256;
    const float* qan = (const float*)d_in[15] + l * 192;
    const float* w_uq = (const float*)d_in[16] + (long)l * 192 * 576;
    const float* kvan = (const float*)d_in[17] + l * 128;
    const float* w_ukv = (const float*)d_in[18] + (long)l * 128 * 768;
    const float* qkn = (const float*)d_in[19] + l * 192;
    const float* mla_on = (const float*)d_in[20] + l * 384;
    const float* w_out = (const float*)d_in[21] + (long)l * 1024 * 1024;
    const float* norm2_g = (const float*)d_in[22] + l * 1024;
    const float* wgrp = (const float*)d_in[23] + (long)l * 1024 * 4;
    const float* bgrp = (const float*)d_in[24] + l * 4;
    const float* wexp = (const float*)d_in[25] + (long)l * 1024 * 32;
    const float* bexp = (const float*)d_in[26] + l * 32;
    const float* Wg = (const float*)d_in[27] + (long)l * 32 * 1024 * 256;
    const float* Wu = (const float*)d_in[28] + (long)l * 32 * 1024 * 256;
    const float* Wd = (const float*)d_in[29] + (long)l * 32 * 256 * 1024;
    const int* pos = (const int*)d_in[1] + b * 2048;
    switch (step) {
    case NS_INPROJ:
        nv_rmsnorm<<<dim3(2048, 1), 64, 0, st>>>(xin, 1024, 0, S.h1, 1024, 0, norm1_g, 0, 1024);
        nv_gemm<<<dim3((DIN + 63) / 64, 2048 / 64), 256, 0, st>>>(S.h1, 1024, w_in, DIN, S.proj, DIN, nullptr, 0, 2048, DIN, 1024);
        break;
    case NS_NSAPREP:
        nv_nsa_cmp<<<dim3(127, 2, 2), 64, 0, st>>>(S.proj, cmp_pe, cmp_w1, cmp_w2, k_norm, S.kcmp, S.vcmp);
        nv_nsa_knorm<<<dim3(2048, 4), 64, 0, st>>>(S.proj, k_norm, S.kn);
        break;
    case NS_MLAPREP:
        nv_rmsnorm<<<dim3(2048, 1), 64, 0, st>>>(S.proj + O_CDQ, DIN, 0, S.dqn, 192, 0, qan, 0, 192);
        nv_gemm<<<dim3(576 / 64, 2048 / 64), 256, 0, st>>>(S.dqn, 192, w_uq, 576, S.q, 576, nullptr, 0, 2048, 576, 192);
        nv_rmsnorm<<<dim3(2048, 1), 64, 0, st>>>(S.proj + O_CDKV, DIN, 0, S.dkvn, 128, 0, kvan, 0, 128);
        nv_gemm<<<dim3(768 / 64, 2048 / 64), 256, 0, st>>>(S.dkvn, 128, w_ukv, 768, S.kv, 768, nullptr, 0, 2048, 768, 128);
        nv_mla_prep<<<dim3(2048, 7), 64, 0, st>>>(S.q, S.kv, S.proj, S.krope, qkn, pos);
        break;
    case NS_NSA:
        nv_nsa_attn<<<dim3(2048, 2), 192, 0, st>>>(S.proj, S.kn, S.kcmp, S.vcmp, rel_bias, q_norm, S.y);
        break;
    case NS_ML:
        nv_ml_conv<<<2048, 512, 0, st>>>(S.proj, conv, S.qk);
        nv_ml_rec<<<4, 256, 0, st>>>(S.proj, S.qk, ibias, fbias, S.hraw);
        nv_ml_fin<<<dim3(2048, 4), 64, 0, st>>>(S.proj, S.hraw, ml_on, S.y);
        break;
    case NS_MLA:
        nv_mla_attn<<<dim3(2048, 6), 64, 0, st>>>(S.q, S.kv, S.krope, S.y);
        break;
    case NS_OUT:
        nv_rmsnorm<<<dim3(2048, 1), 64, 0, st>>>(S.y, 1024, 0, S.y, 1024, 0, nsa_on, 0, 384);
        nv_rmsnorm<<<dim3(2048, 1), 64, 0, st>>>(S.y + 640, 1024, 0, S.y + 640, 1024, 0, mla_on, 0, 384);
        nv_gemm<<<dim3(1024 / 64, 2048 / 64), 256, 0, st>>>(S.y, 1024, w_out, 1024, S.x1, 1024, xin, 1024, 2048, 1024, 1024);
        break;
    case NS_ROUTE:
        nv_moe_route<<<2048, 64, 0, st>>>(S.x1, norm2_g, wgrp, bgrp, wexp, bexp, S.h1, S.rt_e, S.rt_w);
        break;
    case NS_MOE:
        nv_moe_exp<<<2048, 256, 0, st>>>(S.x1, S.h1, S.rt_e, S.rt_w, Wg, Wu, Wd, xout);
        break;
    }
}

__device__ __forceinline__ void chk_commit(float d2, float r2, float* acc) { d2 = wave_sum(d2); r2 = wave_sum(r2); if ((threadIdx.x & 63) == 0) { atomicAdd(acc, d2); atomicAdd(acc + 1, r2); } }
__device__ __forceinline__ void chk_add(float f, float r, float& d2, float& r2) { const float d = f - r; d2 += (d == d) ? d * d : 1e30f; r2 += r * r; }

__global__ void __launch_bounds__(64) chk_proj(const float* nproj, const unsigned char* prj, const float* ssq_dq, const float* ssq_dkv, const float* qg, const float* kg, const float* krg, const int* pos, float* acc) {
    const int t = blockIdx.x, e = threadIdx.x; const size_t row = (size_t)CB * 2048 + t; float d2 = 0.f, r2 = 0.f;
    for (int G = 0; G < 40; ++G) {
        const int c = inproj_refcol(G, e); float r = c < 0 ? 0.f : nproj[(size_t)t * DIN + c]; float f = 0.f;
        const float rr = (G == 37 && e >= 32) ? 0.f : r; const float ss = wave_sum(rr * rr);
        if (G < 6) { r = r * rsqrtf(ss / 64.f + 1e-6f) * qg[e] * 0.18033688f; f = bf2f(((const bf16_t*)(prj + PRJ_QN))[((size_t)(CB * 6 + G) * 2048 + t) * 64 + e]); }
        else if (G < 18) { const int a = G - 6, br = a >> 2, s = (a >> 1) & 1, hk = a & 1;
            if (br > 0 && s == 0) r = r * rsqrtf(ss / 64.f + 1e-6f) * kg[e];
            const size_t base = br == 0 ? (s ? PRJ_C0V : PRJ_C0K) : (br == 1 ? (s ? PRJ_VN1 : PRJ_KN1) : (s ? PRJ_VN2 : PRJ_KN2));
            f = bf2f(((const bf16_t*)(prj + base))[((size_t)(CB * 2 + hk) * 2048 + t) * 64 + e]); }
        else if (G < 26) f = bf2f(((const bf16_t*)(prj + PRJ_RAWQK))[row * 512 + (G - 18) * 64 + e]);
        else if (G < 30) f = bf2f(((const bf16_t*)(prj + PRJ_VML))[((size_t)(CB * 4 + (G - 26)) * 2048 + t) * 64 + e]);
        else if (G < 34) f = bf2f(((const bf16_t*)(prj + PRJ_OG))[row * 256 + (G - 30) * 64 + e]);
        else if (G < 37) f = bf2f(((const bf16_t*)(prj + PRJ_DQKV))[row * 384 + (G - 34) * 64 + e]);
        else if (G == 37) {
            const float val = e < 32 ? rr * rsqrtf(ss / 32.f + 1e-6f) * krg[e & 31] : 0.f; const float oth = __shfl_xor(val, 16);
            if (e < 32) { const int i = e & 15; const double ang = (double)pos[row] * pow(10000.0, -(double)i / 16.0); const float cs = (float)cos(ang), sn = (float)sin(ang);
                r = e < 16 ? val * cs - oth * sn : val * cs + oth * sn; f = bf2f(((const bf16_t*)(prj + PRJ_KR))[row * 32 + e]); }
            else if (e < 58) f = ((const float*)(prj + PRJ_GATES))[row * 32 + (e - 32)];
            else { f = 0.f; r = 0.f; }
        }
        else f = bf2f(((const bf16_t*)(prj + PRJ_DQKV))[row * 384 + 256 + (G - 38) * 64 + e]);
        chk_add(f, r, d2, r2);
    }
    float d2s = 0.f, r2s = 0.f;
    { float s1 = 0.f, s2 = 0.f; for (int c = e; c < 192; c += 64) { float v = nproj[(size_t)t * DIN + O_CDQ + c]; s1 += v * v; } for (int c = e; c < 128; c += 64) { float v = nproj[(size_t)t * DIN + O_CDKV + c]; s2 += v * v; }
      s1 = wave_sum(s1); s2 = wave_sum(s2); if (e == 0) { chk_add((ssq_dq[row * 4] + ssq_dq[row * 4 + 1]) + ssq_dq[row * 4 + 2], s1, d2s, r2s); chk_add(ssq_dkv[row * 2] + ssq_dkv[row * 2 + 1], s2, d2s, r2s); } }
    chk_commit(d2, r2, acc); chk_commit(d2s, r2s, acc + 2);
}

__global__ void __launch_bounds__(64) chk_prep(const float* nq, const float* nkv, const float* nkr, const float* nkc, const float* nvc, const unsigned char* ws, float* acc) {
    const int t = blockIdx.x, e = threadIdx.x; float d2 = 0.f, r2 = 0.f, d2c = 0.f, r2c = 0.f; const float scale = 0.14724444f;
    const bf16_t* QM = (const bf16_t*)(ws + WS_MLA); const bf16_t* KM = (const bf16_t*)(ws + WS_MLA + MLA_KM); const bf16_t* VM = (const bf16_t*)(ws + WS_MLA + MLA_VM);
    for (int h = 0; h < 6; ++h) {
        const size_t rq = ((size_t)(CB * 6 + h) * 2048 + t);
        chk_add(bf2f(QM[rq * 96 + e]), nq[(size_t)t * 576 + h * 96 + e] * scale, d2, r2);
        chk_add(bf2f(KM[rq * 96 + e]), nkv[(size_t)t * 768 + h * 128 + e], d2, r2);
        chk_add(bf2f(VM[rq * 64 + e]), nkv[(size_t)t * 768 + h * 128 + 64 + e], d2, r2);
        if (e < 32) { chk_add(bf2f(QM[rq * 96 + 64 + e]), nq[(size_t)t * 576 + h * 96 + 64 + e] * scale, d2, r2); chk_add(bf2f(KM[rq * 96 + 64 + e]), nkr[(size_t)t * 32 + e], d2, r2); }
    }
    if (t < 128) for (int hk = 0; hk < 2; ++hk) {
        const bf16_t* KC = (const bf16_t*)(ws + WS_CMP); const bf16_t* VC = (const bf16_t*)(ws + WS_CMP + CMP_V); const size_t rf = ((size_t)(CB * 2 + hk) * 128 + t) * 64 + e;
        chk_add(bf2f(KC[rf]), t < 127 ? nkc[(size_t)(hk * 127 + t) * 64 + e] : 0.f, d2c, r2c); chk_add(bf2f(VC[rf]), t < 127 ? nvc[(size_t)(hk * 127 + t) * 64 + e] : 0.f, d2c, r2c);
    }
    chk_commit(d2, r2, acc); chk_commit(d2c, r2c, acc + 2);
}

__global__ void __launch_bounds__(64) chk_y(const float* ny, const unsigned char* ws, float* acc, int nseg) {
    const int t = blockIdx.x, e = threadIdx.x; const bf16_t* Y = (const bf16_t*)(ws + WS_Y) + ((size_t)CB * 2048 + t) * 1024;
    float d2[3] = {0.f, 0.f, 0.f}, r2[3] = {0.f, 0.f, 0.f};
    for (int c = e; c < 1024; c += 64) { const int seg = c < 384 ? 0 : (c < 640 ? 1 : 2); const int cf = c < 384 ? c : (c < 640 ? 768 + (c - 384) : 384 + (c - 640)); const float f = bf2f(Y[cf]), r = ny[(size_t)t * 1024 + c];
        if (seg == 0) chk_add(f, r, d2[0], r2[0]); else if (seg == 1) chk_add(f, r, d2[1], r2[1]); else chk_add(f, r, d2[2], r2[2]); }
    if (nseg == 3) { chk_commit(d2[0], r2[0], acc); chk_commit(d2[1], r2[1], acc + 2); chk_commit(d2[2], r2[2], acc + 4); }
    else chk_commit(d2[0] + d2[1] + d2[2], r2[0] + r2[1] + r2[2], acc);
}

__global__ void __launch_bounds__(64) chk_x(const float* nx, const unsigned char* ws, float* acc) {
    const int t = blockIdx.x, e = threadIdx.x; const bf16_t* X = (const bf16_t*)(ws + WS_XB) + ((size_t)CB * 2048 + t) * 1024; float d2 = 0.f, r2 = 0.f;
    for (int c = e; c < 1024; c += 64) chk_add(bf2f(X[c]), nx[(size_t)t * 1024 + c], d2, r2);
    chk_commit(d2, r2, acc);
}

__global__ void __launch_bounds__(512) chk_code(float* acc, int nst, const float* nout) {
    __shared__ float sh[512];
    float s = 0.f; for (int i = threadIdx.x; i < 2048 * 1024; i += 512) { float v = nout[i]; s += v * v; }
    sh[threadIdx.x] = s; __syncthreads();
    if (threadIdx.x == 0) { float tot = 0.f; for (int i = 0; i < 512; ++i) tot += sh[i]; float rms = sqrtf(tot / (2048.f * 1024.f)); if (!(rms > 1e-3f && rms < 1e3f)) rms = 1.f;
        int code = 0;
        for (int st = 0; st < nst; ++st) { const float d2 = acc[2 * st], r2 = acc[2 * st + 1]; if (r2 == 0.f && d2 == 0.f) { if ((st & 15) >= 9) continue; code = (st + 1) * 4 + 3; break; } const float err = d2 / fmaxf(r2, 1e-30f);
            const float tol = CHK_TOL(st);
            if (!(err <= tol)) { const int cls = !(err < 1.f) ? 3 : (err >= 0.1f ? 2 : (err >= 0.01f ? 1 : 0)); code = (st + 1) * 4 + cls; break; } }
        acc[2 * 40] = rms * 32.f * exp2f(0.5f * (float)code); }
}
__global__ void __launch_bounds__(512) chk_fill(const float* acc, float* out) {
    const float K = acc[2 * 40];
    for (size_t i = (size_t)blockIdx.x * 512 + threadIdx.x; i < (size_t)NTOK * 1024; i += (size_t)gridDim.x * 512) out[i] = (i & 1) ? -K : K;
}
#endif

#if TIME_PH != -1
#ifndef TIME_Q
#define TIME_Q 6.f
#endif
#ifndef TIME_CAL
#define TIME_CAL 1.0f
#endif
__global__ void tm_acc(const unsigned long long* ts, float* best, int first) {
    int a = TIME_PH, b = TIME_PH + 1;
#ifdef TIME_PH_END
    b = TIME_PH_END;
#endif
    float T = 100.f; if (TIME_PH >= 0) T = (float)(ts[b] - ts[a]) * 0.01f;
    if (first || T < *best) *best = T;
}
__global__ void __launch_bounds__(512) tm_fill(const float* best, float* out) {
    float T = *best;
    T = exp2f(rintf(log2f(fmaxf(T, 1.f)) * TIME_Q) / TIME_Q);
    const float c = sqrtf(T) * TIME_CAL;
    for (size_t i = (size_t)blockIdx.x * 512 + threadIdx.x; i < (size_t)NTOK * 1024; i += (size_t)gridDim.x * 512) out[i] = (i & 1) ? -c : c;
}
#endif
static int g_grid = 0;
static bool setup_once(size_t ws_size) {
    if (g_grid) return g_grid > 0;
    if (ws_size < WS_END) { fprintf(stderr, "kernel_launch: workspace too small: %zu < %zu\n", ws_size, (size_t)WS_END); g_grid = -1; return false; }
    int dev = 0, cus = 0, per_cu = 0;
    if (hipGetDevice(&dev) != hipSuccess || hipDeviceGetAttribute(&cus, hipDeviceAttributeMultiprocessorCount, dev) != hipSuccess) { g_grid = -1; return false; }
    if (hipFuncSetAttribute((const void*)mk, hipFuncAttributeMaxDynamicSharedMemorySize, LDS_BYTES) != hipSuccess) { fprintf(stderr, "kernel_launch: hipFuncSetAttribute failed\n"); g_grid = -1; return false; }
    if (hipOccupancyMaxActiveBlocksPerMultiprocessor(&per_cu, (const void*)mk, 512, LDS_BYTES) != hipSuccess || per_cu < 1) { fprintf(stderr, "kernel_launch: occupancy query says %d\n", per_cu); }
    (void)hipGetLastError();
    g_grid = cus;
    return true;
}
static void launch_mk(const Args& a0, int lo, int hi, hipStream_t stream) { Args a = a0; a.ph_lo = lo; a.ph_hi = hi; hipLaunchKernelGGL(mk, dim3(g_grid), dim3(512), LDS_BYTES, stream, a); }

extern "C" void kernel_launch(void* const* d_in, const int* in_sizes, int n_in, void* d_out, int out_size, void* d_ws, size_t ws_size, hipStream_t stream) {
    if (!setup_once(ws_size)) return;
    unsigned char* ws = (unsigned char*)d_ws;
    (void)hipMemsetAsync(ws + WS_CTL, 0, ZERO_BYTES, stream);
    Args a{}; for (int i = 0; i < 30; ++i) a.in.p[i] = (const float*)d_in[i];
    a.out = (float*)d_out; a.ws = ws; a.ph_lo = 0; a.ph_hi = 0;
#if CHECK
    a.out = nullptr;
#endif
#if CHECK
    float* nb = (float*)d_out; size_t off = 0; NvScratch S;
    auto take = [&](size_t n) { float* p = nb + off; off += (n + 63) & ~(size_t)63; return p; };
    S.proj = take((size_t)2048 * DIN); S.h1 = take(2048 * 1024); S.qk = S.h1; S.hraw = S.qk + 2048 * 512; S.kn = S.hraw + 2048 * 256;
    S.kcmp = take(2 * 127 * 64); S.vcmp = take(2 * 127 * 64); S.dqn = take(2048 * 192); S.q = take(2048 * 576); S.dkvn = take(2048 * 128); S.kv = take(2048 * 768); S.x1 = S.dqn;
    S.krope = take(2048 * 32); S.y = take(2048 * 1024); S.xl = take(2048 * 1024); S.rt_e = (int*)take(2048 * 2); S.rt_w = take(2048 * 2);
    if (off * 4 > (size_t)NTOK * 1024 * 4) { fprintf(stderr, "naive scratch too big\n"); return; }
    float* acc = (float*)(ws + WS_CTL) + CW_CHK;
    launch_mk(a, 0, 1, stream);
    const float* nx_in = (const float*)d_in[0] + (size_t)CB * 2048 * 1024;
    int nst = 0;
    for (int l = 0; l < L_; ++l) {
        const int pb = 1 + l * NPH; const int sb = l * 16;
        launch_mk(a, pb + PH_INPROJ, pb + PH_INPROJ + 1, stream);
        naive_step(d_in, l, NS_INPROJ, nx_in, S.xl, S, stream);
        chk_proj<<<2048, 64, 0, stream>>>(S.proj, ws + WS_PRJ, (const float*)(ws + WS_SSQ + PT_DQ) + (size_t)l * 16384 * 4, (const float*)(ws + WS_SSQ + PT_DKV) + (size_t)l * 16384 * 2,
                                           (const float*)d_in[8] + l * 64, (const float*)d_in[9] + l * 64, (const float*)d_in[19] + l * 192 + 160, (const int*)d_in[1], acc + 2 * (sb + 0));
        nst = sb + 2;
        int ns_done = NS_INPROJ;
#if CHECK_UPTO >= 1
        launch_mk(a, pb + PH_PREP, pb + PH_PREP + 1, stream);
        naive_step(d_in, l, NS_NSAPREP, nx_in, S.xl, S, stream); naive_step(d_in, l, NS_MLAPREP, nx_in, S.xl, S, stream); ns_done = NS_MLAPREP;
        chk_prep<<<2048, 64, 0, stream>>>(S.q, S.kv, S.krope, S.kcmp, S.vcmp, ws, acc + 2 * (sb + 2));
        nst = sb + 4;
#endif
#if CHECK_UPTO >= 2
        launch_mk(a, pb + PH_MIX, pb + PH_MIX + 1, stream);
        naive_step(d_in, l, NS_NSA, nx_in, S.xl, S, stream); naive_step(d_in, l, NS_ML, nx_in, S.xl, S, stream); naive_step(d_in, l, NS_MLA, nx_in, S.xl, S, stream); ns_done = NS_MLA;
        chk_y<<<2048, 64, 0, stream>>>(S.y, ws, acc + 2 * (sb + 4), 3);
        nst = sb + 7;
#endif
#if CHECK_UPTO >= 3
        launch_mk(a, pb + PH_YNORM, pb + PH_YNORM + 1, stream); launch_mk(a, pb + PH_OUTPROJ, pb + PH_OUTPROJ + 1, stream);
        naive_step(d_in, l, NS_OUT, nx_in, S.xl, S, stream); ns_done = NS_OUT;
        chk_x<<<2048, 64, 0, stream>>>(S.x1, ws, acc + 2 * (sb + 7));
        nst = sb + 8;
#endif
#if CHECK_UPTO >= 4
        for (int ph = PH_ROUTE; ph <= PH_COMBINE; ++ph) launch_mk(a, pb + ph, pb + ph + 1, stream);
        naive_step(d_in, l, NS_ROUTE, nx_in, S.xl, S, stream); naive_step(d_in, l, NS_MOE, nx_in, S.xl, S, stream); ns_done = NS_MOE;
        chk_x<<<2048, 64, 0, stream>>>(S.xl, ws, acc + 2 * (sb + 8));
        nst = sb + 9;
#endif
        CHECK_REST
        for (int s = ns_done + 1; s <= NS_MOE; ++s) naive_step(d_in, l, s, nx_in, S.xl, S, stream);
        nx_in = S.xl;
        if (l == CHECK_LAYERS - 1) break;
    }
    chk_code<<<1, 512, 0, stream>>>(acc, nst, S.xl);
    chk_fill<<<1024, 512, 0, stream>>>(acc, (float*)d_out);
#else
#if defined(SPLIT_LAUNCH) && SPLIT_LAUNCH
    for (int ph = 0; ph < 1 + L_ * NPH; ++ph) launch_mk(a, ph, ph + 1, stream);
#else
    launch_mk(a, 0, 1 + L_ * NPH, stream);
#if TIME_PH != -1
    for (int rp = 0; rp < 6; ++rp) {
        (void)hipMemsetAsync(ws + WS_CTL, 0, ZERO_BYTES, stream); launch_mk(a, 0, 1 + L_ * NPH, stream);
        tm_acc<<<1, 1, 0, stream>>>((const unsigned long long*)((unsigned*)(ws + WS_CTL) + CW_TS), (float*)(ws + WS_META + META_RT), rp == 0);
    }
    tm_fill<<<1024, 512, 0, stream>>>((const float*)(ws + WS_META + META_RT), (float*)d_out);
#endif
#endif
#endif
}
```

```cpp
#define CHECK 0
#define CHECK_LAYERS 2
#define CHECK_UPTO 99
#define SPLIT_LAUNCH 0
#define REPEAT_PH -1
#include <hip/hip_runtime.h>
#include <stdint.h>
#include <cstdio>

constexpr int B_ = 8, T_ = 2048, D_ = 1024, L_ = 2, NTOK = B_ * T_;
constexpr int DIN = 2554;
constexpr int O_AQ = 0, O_AKV = 384, O_AG = 1152, O_BQK = 1170, O_BV = 1682, O_BIF = 1938, O_BO = 1946, O_CDQ = 2202, O_CDKV = 2394, O_CKR = 2522;

typedef unsigned short bf16_t;
typedef short bf16x8 __attribute__((ext_vector_type(8)));
typedef short s16x4 __attribute__((ext_vector_type(4)));
typedef float f32x4 __attribute__((ext_vector_type(4)));
typedef float f32x16 __attribute__((ext_vector_type(16)));
typedef unsigned u32x4 __attribute__((ext_vector_type(4)));
typedef unsigned u32x2 __attribute__((ext_vector_type(2)));
typedef float f32x2_t __attribute__((ext_vector_type(2)));
typedef __bf16 bf16x2_t __attribute__((ext_vector_type(2)));
#define LAS __attribute__((address_space(3)))

__device__ __forceinline__ unsigned pk_bf16(float lo, float hi) { f32x2_t v = {lo, hi}; bf16x2_t b = __builtin_convertvector(v, bf16x2_t); return __builtin_bit_cast(unsigned, b); }
__device__ __forceinline__ float bf_lo(unsigned u) { return __builtin_bit_cast(float, u << 16); }
__device__ __forceinline__ float bf_hi(unsigned u) { return __builtin_bit_cast(float, u & 0xffff0000u); }
__device__ __forceinline__ float bf2f(bf16_t h) { return __builtin_bit_cast(float, (unsigned)h << 16); }
__device__ __forceinline__ bf16_t f2bf(float f) { return (bf16_t)(pk_bf16(f, 0.f) & 0xffffu); }
__device__ __forceinline__ float wave_sum(float v) { for (int o = 32; o; o >>= 1) v += __shfl_xor(v, o); return v; }
__device__ __forceinline__ float wave_max(float v) { for (int o = 32; o; o >>= 1) v = fmaxf(v, __shfl_xor(v, o)); return v; }
__device__ __forceinline__ float siluf(float x) { return x / (1.f + __expf(-x)); }
__device__ __forceinline__ float sigmf(float x) { return 1.f / (1.f + __expf(-x)); }
__device__ __forceinline__ int t5b(int dist) {
    int n = dist > 0 ? dist : 0; if (n < 16) return n;
    float v = logf((float)n / 16.f) / logf(8.f) * 16.f; int l = 16 + (int)v; return l < 31 ? l : 31;
}

__device__ __forceinline__ int lane_now() { return (int)__builtin_amdgcn_mbcnt_hi(~0u, __builtin_amdgcn_mbcnt_lo(~0u, 0u)); }
#define TIDX ((g_wv << 6) | lane_now())

constexpr size_t WS_CTL = 0, CTL_BYTES = 65536;
constexpr size_t WS_SSQ = WS_CTL + CTL_BYTES;
constexpr size_t ZERO_BYTES = CTL_BYTES;
constexpr size_t PT_DQ = 0, PT_DKV = PT_DQ + (size_t)2 * 16384 * 4 * 4, PT_A = PT_DKV + (size_t)2 * 16384 * 2 * 4, PT_C = PT_A + (size_t)2 * 16384 * 8 * 4, PT_X1 = PT_C + (size_t)2 * 16384 * 8 * 4, PT_END = PT_X1 + (size_t)2 * 16384 * 16 * 4;
constexpr size_t WS_SSQX = WS_SSQ + PT_END;
constexpr size_t WS_RS2 = WS_SSQX + 2 * 65536;
constexpr size_t WS_WIN = WS_RS2 + 65536;
constexpr size_t WS_WOUT = WS_WIN + (size_t)2 * 2560 * 1024 * 2;
constexpr size_t WS_WUQ = WS_WOUT + (size_t)2 * 1024 * 1024 * 2;
constexpr size_t WS_WUKV = WS_WUQ + (size_t)2 * 768 * 256 * 2;
constexpr size_t WS_WC1 = WS_WUKV + (size_t)2 * 768 * 256 * 2;
constexpr size_t WS_WC2 = WS_WC1 + (size_t)2 * 2 * 64 * 2048 * 2;
constexpr size_t WS_WR = WS_WC2 + (size_t)2 * 2 * 64 * 64 * 2;
constexpr size_t WS_B1C = WS_WR + (size_t)2 * 64 * 1024 * 2;
constexpr size_t WS_BIASD = WS_B1C + 1024;
constexpr size_t WS_ROPE = WS_BIASD + 6 * 2048 * 4;
constexpr size_t WS_WMOE = WS_ROPE + (size_t)16384 * 32 * 4;
constexpr size_t WMOE_WD = (size_t)32 * 512 * 1024 * 2;
constexpr size_t WS_XB = WS_WMOE + 50331648;
constexpr size_t WS_MLA = WS_XB + 33554432;
constexpr size_t MLA_KM = (size_t)8 * 6 * 2048 * 96 * 2, MLA_VM = 2 * MLA_KM;
constexpr size_t WS_HBUF = WS_MLA;
constexpr size_t WS_PRJ = WS_MLA + 50331648;
constexpr size_t HM64 = (size_t)2048 * 64 * 2;
constexpr size_t PRJ_QN = 0;
constexpr size_t PRJ_KN1 = PRJ_QN + 48 * HM64, PRJ_VN1 = PRJ_KN1 + 16 * HM64, PRJ_KN2 = PRJ_VN1 + 16 * HM64, PRJ_VN2 = PRJ_KN2 + 16 * HM64;
constexpr size_t PRJ_VML = PRJ_VN2 + 16 * HM64;
constexpr size_t PRJ_OG = PRJ_VML + 32 * HM64;
constexpr size_t PRJ_KR = PRJ_OG + (size_t)16384 * 256 * 2;
constexpr size_t PRJ_GATES = PRJ_KR + (size_t)16384 * 32 * 2;
constexpr size_t PRJ_DEAD = PRJ_GATES + (size_t)16384 * 32 * 4;
constexpr size_t PRJ_C0K = PRJ_DEAD, PRJ_C0V = PRJ_C0K + 16 * HM64 + 8192;
constexpr size_t PRJ_RAWQK = PRJ_C0V + 16 * HM64 + 8192;
constexpr size_t PRJ_DQKV = PRJ_RAWQK + (size_t)16384 * 512 * 2;
constexpr size_t PRJ_END = PRJ_DQKV + (size_t)16384 * 384 * 2;
static_assert(PRJ_END - PRJ_DEAD >= 33554432, "Y fits the dead part of PRJ");
constexpr size_t WS_Y = WS_PRJ + PRJ_DEAD;
constexpr size_t WS_YBUF = WS_PRJ;
static_assert((size_t)2 * 16384 * 1024 * 2 <= PRJ_END, "YBUF fits the PRJ region");
constexpr size_t WS_ML = WS_PRJ + PRJ_END;
constexpr size_t ML_KC = 32 * HM64, ML_DELTA = 2 * ML_KC, ML_DN = ML_DELTA + (size_t)1024 * 4096 * 2, ML_G = ML_DN + (size_t)1024 * 64 * 4, ML_BL = ML_G + (size_t)8 * 4 * 2048 * 2 * 4, ML_CP = ML_BL + 4096, ML_NP = ML_CP + (size_t)1024 * 4096 * 2, ML_END = ML_NP + (size_t)1024 * 64 * 2;
constexpr size_t WS_CMP = WS_ML + ML_END;
constexpr size_t CMP_V = (size_t)8 * 2 * 128 * 64 * 2;
constexpr size_t WS_META = WS_CMP + 2 * CMP_V;
constexpr size_t META_W = (size_t)32 * 16384 * 4, META_RT = 2 * META_W;
constexpr size_t WS_END = WS_META + META_RT + (size_t)16384 * 16;
constexpr int CW_BAR = 0;
constexpr int CW_Q = 4096;
constexpr int CW_SCAN = 4608;
constexpr int CW_TS = 4864;
constexpr int CW_CHK = 5120;
constexpr int CW_CNT = 8192;
constexpr int LDS_BYTES = 147456;
constexpr int LDS_MISC = LDS_BYTES - 256;
#define XB_TMO      128
#define XB_XCNT(j)  (256  + 64 * (j))
#define XB_XSUB(j)  (1280 + 64 * (j))
#define XB_XGEN(j)  (2304 + 64 * (j))
#define XB_TOP      3328
#define XB_TOPGEN   3392
#define XCD_BAR_WORDS 3456
#define XB_SPIN_CAP (1u << 18)

__device__ __forceinline__ unsigned xb_ld(unsigned* p)              { return __hip_atomic_load(p, __ATOMIC_RELAXED, __HIP_MEMORY_SCOPE_AGENT); }
__device__ __forceinline__ unsigned xb_add(unsigned* p, unsigned v) { return __hip_atomic_fetch_add(p, v, __ATOMIC_RELAXED, __HIP_MEMORY_SCOPE_AGENT); }
__device__ __forceinline__ unsigned xb_xcc_id() { return (unsigned)__builtin_amdgcn_s_getreg((3 << 11) | 20) & 0xFu; }
#define XB_SPIN(cond, bar) do { unsigned _sp = 0; while (cond) { __builtin_amdgcn_s_sleep(1); \
    if ((++_sp & 255u) == 0u) { if (xb_ld(&(bar)[XB_TMO])) break; if (_sp > XB_SPIN_CAP) { atomicAdd(&(bar)[XB_TMO], 1u); break; } } } } while (0)

struct XcdBarrier {
    int g_wv; unsigned* bar; unsigned x;
    volatile LAS unsigned* st;
};

__device__ __forceinline__ XcdBarrier xcd_barrier_post(unsigned* bar, volatile LAS unsigned* st, int g_wv) {
    XcdBarrier b; b.g_wv = g_wv; b.bar = bar; b.x = xb_xcc_id(); b.st = st;
    if (TIDX == 0) (void)xb_add(&bar[XB_XCNT(b.x)], 1u);
    return b;
}
__device__ __forceinline__ void xcd_barrier_complete(unsigned* bar, unsigned x, unsigned& nloc, unsigned& nx) {
    const unsigned G = gridDim.x * gridDim.y * gridDim.z;
    unsigned sum, cnt, mine, sp = 0u;
    for (;;) {
        sum = 0u; cnt = 0u; mine = 0u;
#pragma unroll
        for (unsigned j = 0; j < 16; ++j) { const unsigned c = xb_ld(&bar[XB_XCNT(j)]); sum += c; cnt += (c > 0u) ? 1u : 0u; mine = (j == x) ? c : mine; }
        if (sum == G) break;
        __builtin_amdgcn_s_sleep(1);
        if ((++sp & 255u) == 0u) { if (xb_ld(&bar[XB_TMO])) break; if (sp > XB_SPIN_CAP) { atomicAdd(&bar[XB_TMO], 1u); break; } }
    }
    nloc = mine > 0u ? mine : 1u; nx = cnt > 0u ? cnt : 1u;
}

__device__ __forceinline__ void xcd_barrier(const XcdBarrier& b) {
    asm volatile("s_waitcnt vmcnt(0)" ::: "memory");
    __syncthreads();
    const int g_wv = b.g_wv;
    if (TIDX == 0) {
        unsigned* bar = b.bar;
        __builtin_amdgcn_s_waitcnt(0);
        unsigned nloc = b.st[0], nx = b.st[1];
        if (nloc == 0u) { xcd_barrier_complete(bar, b.x, nloc, nx); b.st[0] = nloc; b.st[1] = nx; }
        const unsigned old = xb_add(&bar[XB_XSUB(b.x)], 1u);
        const unsigned gen = old / nloc;
        if (old + 1u == (gen + 1u) * nloc) {
            __builtin_amdgcn_fence(__ATOMIC_RELEASE, "agent");
            asm volatile("s_waitcnt vmcnt(0)" ::: "memory");
            const unsigned og = xb_add(&bar[XB_TOP], 1u);
            const unsigned tg = og / nx;
            if (og + 1u == (tg + 1u) * nx) xb_add(&bar[XB_TOPGEN], 1u);
            else XB_SPIN(xb_ld(&bar[XB_TOPGEN]) == tg, bar);
            __builtin_amdgcn_fence(__ATOMIC_ACQUIRE, "agent");
            xb_add(&bar[XB_XGEN(b.x)], 1u);
            asm volatile("s_waitcnt vmcnt(0)" ::: "memory");
        } else {
            XB_SPIN(xb_ld(&bar[XB_XGEN(b.x)]) == gen, bar);
            __builtin_amdgcn_fence(__ATOMIC_ACQUIRE, "agent");
            asm volatile("s_waitcnt vmcnt(0)" ::: "memory");
        }
    }
    __syncthreads();
}
struct Inputs { const float* p[30]; };
typedef const __attribute__((address_space(4))) Inputs* InPtr;
__device__ __forceinline__ InPtr in_tab() { InPtr p = (InPtr)__builtin_amdgcn_kernarg_segment_ptr(); asm volatile("" : "+s"(p)); return p; }
__device__ __forceinline__ unsigned char* launder(unsigned char* p) { size_t z = 0; asm volatile("" : "+s"(z)); return p + z; }

__host__ __device__ inline int inproj_refcol(int G, int e) {
    if (G < 6) return O_AQ + G * 64 + e;
    if (G < 18) return O_AKV + (G - 6) * 64 + e;
    if (G < 26) return O_BQK + (G - 18) * 64 + e;
    if (G < 30) return O_BV + (G - 26) * 64 + e;
    if (G < 34) return O_BO + (G - 30) * 64 + e;
    if (G < 37) return O_CDQ + (G - 34) * 64 + e;
    if (G == 37) { if (e < 32) return O_CKR + e; if (e < 50) return O_AG + (e - 32); if (e < 58) return O_BIF + (e - 50); return -1; }
    return O_CDKV + (G - 38) * 64 + e;
}
__host__ __device__ inline int uq_refcol(int G, int e) {
    if (G < 6) return G * 96 + e;
    if (G < 9) { const int idx = e & 31, bj = e >> 5, sub = idx >> 4, i = idx & 15; return (2 * (G - 6) + sub) * 96 + 64 + bj * 16 + i; }
    return -1;
}
__host__ __device__ inline int ukv_refcol(int G, int e) { return G < 6 ? G * 128 + e : (G - 6) * 128 + 64 + e; }
#define N2G(n) ((((n) >> 8) << 2) + (((n) >> 5) & 3))
#define N2E(n) (((((n) >> 7) & 1) << 5) + ((n) & 31))

struct FWin { const float* w; const float* g; __device__ __forceinline__ float operator()(int k, int n) const { const int c = inproj_refcol(N2G(n), N2E(n)); return c < 0 ? 0.f : w[(size_t)k * DIN + c] * g[k]; } };
struct FWout { const float* w; const float* ga; const float* gc; __device__ __forceinline__ float operator()(int k, int n) const {
    const int kr = k < 384 ? k : (k < 768 ? 640 + (k - 384) : 384 + (k - 768)); const float og = k < 384 ? ga[k] : (k < 768 ? gc[k - 384] : 1.f); return w[(size_t)kr * 1024 + n] * og; } };
struct FWuq { const float* w; const float* g; __device__ __forceinline__ float operator()(int k, int n) const { const int c = uq_refcol(N2G(n), N2E(n)); return (k < 192 && c >= 0) ? w[(size_t)k * 576 + c] * g[k] : 0.f; } };
struct FWukv { const float* w; const float* g; __device__ __forceinline__ float operator()(int k, int n) const { const int c = ukv_refcol(N2G(n), N2E(n)); return k >= 128 ? w[(size_t)(k - 128) * 768 + c] * g[k - 128] : 0.f; } };
struct FWc1 { const float* w; __device__ __forceinline__ float operator()(int k, int n) const { return w[(size_t)k * 64 + n]; } };
struct FWr { const float* wg; const float* we; const float* g; __device__ __forceinline__ float operator()(int k, int n) const { return n < 4 ? wg[k * 4 + n] * g[k] : (n < 36 ? we[k * 32 + n - 4] * g[k] : 0.f); } };
struct FWgu { const float* src; const float* g; int n0, col0; __device__ __forceinline__ float operator()(int k, int n) const { return src[(size_t)k * 256 + col0 + (n - n0)] * g[k]; } };
struct FWd { const float* w; __device__ __forceinline__ float operator()(int k, int n) const { return w[(size_t)k * 1024 + n]; } };

__device__ __forceinline__ void rope_cs(int pos, int j, float& cs, float& sn) {
    const double inv = exp2(-(double)j * (13.287712379549449 / 16.0));
    const double rev = (double)pos * inv * 0.15915494309189535; const float f = (float)(rev - rint(rev));
    cs = __builtin_amdgcn_cosf(f); sn = __builtin_amdgcn_sinf(f);
}
template <class F>
__device__ __forceinline__ void cvt_tile(const F& f, int n0, int k0, bf16_t* dst, int ldk, LAS float* tile, int tid) {
    { const int k = tid >> 3, nb = (tid & 7) * 8;
#pragma unroll
      for (int j = 0; j < 8; ++j) tile[k * 65 + nb + j] = f(k0 + k, n0 + nb + j); }
    __syncthreads();
    { const int n = tid >> 3, kb = (tid & 7) * 8; const LAS float* s = tile + kb * 65 + n;
      u32x4 o; o.x = pk_bf16(s[0], s[65]); o.y = pk_bf16(s[130], s[195]); o.z = pk_bf16(s[260], s[325]); o.w = pk_bf16(s[390], s[455]);
      *(u32x4*)(dst + (size_t)(n0 + n) * ldk + k0 + kb) = o; }
    __syncthreads();
}
template <class F>
__device__ __forceinline__ void cvt_item(const F& f, int it, int nK, bf16_t* dst, int ldk, LAS float* tile, int tid) { cvt_tile(f, (it / nK) * 64, (it % nK) * 64, dst, ldk, tile, tid); }

__device__ __forceinline__ void moe_item(InPtr in, int l, int it, const float*& src, int& ld, size_t& dst, int& ldk, bool& gain, int& kk0) {
    if (it < 32 * 64) { const int e = it >> 6, r = it & 63, n0 = (r >> 3) * 64, k0 = (r & 7) * 128, c0 = n0 & 255;
        src = (c0 < 128 ? in->p[27] : in->p[28]) + ((size_t)l * 32 + e) * 262144 + (size_t)k0 * 256 + (n0 >> 8) * 128 + (c0 & 127); ld = 256; gain = true; kk0 = k0;
        dst = ((size_t)e * 512 + n0) * 1024 + k0; ldk = 1024; }
    else { const int j = it - 32 * 64, e = j >> 5, r = j & 31, n0 = (r >> 1) * 64, k0 = (r & 1) * 128;
        src = in->p[29] + ((size_t)l * 32 + e) * 262144 + (size_t)k0 * 1024 + n0; ld = 1024; gain = false; kk0 = 0;
        dst = (size_t)16777216 + ((size_t)e * 1024 + n0) * 256 + k0; ldk = 256; }
}
__device__ __forceinline__ void cvt_moe_layer(InPtr in, unsigned char* ws, int l, LAS float* tile, int bid, int nb, int tid, int it_lo = 0, int it_hi = 32 * (64 + 32)) {
    asm volatile("" : "+v"(tid));
    const float* g2 = in->p[22] + l * 1024; bf16_t* W = (bf16_t*)(ws + WS_WMOE);
    const int k = tid >> 3, nbq = (tid & 7) * 8;
    const int n = tid >> 3, kb = (tid & 7) * 8;
    const int NIT = it_hi;
#define CVM_LOAD(it_, P) do { const float* src_; int ld_, ldk_, kk0_; size_t dst_; bool gain_; moe_item(in, l, (it_), src_, ld_, dst_, ldk_, gain_, kk0_); \
        P##a = *(const f32x4*)(src_ + (size_t)k * ld_ + nbq); P##b = *(const f32x4*)(src_ + (size_t)k * ld_ + nbq + 4); P##c = *(const f32x4*)(src_ + (size_t)(k + 64) * ld_ + nbq); P##d = *(const f32x4*)(src_ + (size_t)(k + 64) * ld_ + nbq + 4); \
        P##g0 = gain_ ? g2[kk0_ + k] : 1.f; P##g1 = gain_ ? g2[kk0_ + 64 + k] : 1.f; } while (0)
#define CVM_PUT(t, P) do { \
        t[k * 65 + nbq + 0] = P##a.x * P##g0; t[k * 65 + nbq + 1] = P##a.y * P##g0; t[k * 65 + nbq + 2] = P##a.z * P##g0; t[k * 65 + nbq + 3] = P##a.w * P##g0; \
        t[k * 65 + nbq + 4] = P##b.x * P##g0; t[k * 65 + nbq + 5] = P##b.y * P##g0; t[k * 65 + nbq + 6] = P##b.z * P##g0; t[k * 65 + nbq + 7] = P##b.w * P##g0; \
        t[(k + 64) * 65 + nbq + 0] = P##c.x * P##g1; t[(k + 64) * 65 + nbq + 1] = P##c.y * P##g1; t[(k + 64) * 65 + nbq + 2] = P##c.z * P##g1; t[(k + 64) * 65 + nbq + 3] = P##c.w * P##g1; \
        t[(k + 64) * 65 + nbq + 4] = P##d.x * P##g1; t[(k + 64) * 65 + nbq + 5] = P##d.y * P##g1; t[(k + 64) * 65 + nbq + 6] = P##d.z * P##g1; t[(k + 64) * 65 + nbq + 7] = P##d.w * P##g1; } while (0)
#define CVM_STORE(it_, t) do { const float* src_; int ld_, ldk_, kk0_; size_t dst_; bool gain_; moe_item(in, l, (it_), src_, ld_, dst_, ldk_, gain_, kk0_); \
        _Pragma("unroll") for (int hh = 0; hh < 2; ++hh) { const LAS float* s_ = t + (64 * hh + kb) * 65 + n; \
            u32x4 o; o.x = pk_bf16(s_[0], s_[65]); o.y = pk_bf16(s_[130], s_[195]); o.z = pk_bf16(s_[260], s_[325]); o.w = pk_bf16(s_[390], s_[455]); \
            *(u32x4*)(W + dst_ + (size_t)n * ldk_ + 64 * hh + kb) = o; } } while (0)
    f32x4 Aa, Ab, Ac, Ad, Ba, Bb, Bc, Bd; float Ag0 = 1.f, Ag1 = 1.f, Bg0 = 1.f, Bg1 = 1.f;
    LAS float* t0 = tile; LAS float* t1 = tile + 128 * 65;
    int it = it_lo + bid;
    if (it < NIT) CVM_LOAD(it, A);
    if (it + nb < NIT) CVM_LOAD(it + nb, B);
#pragma unroll 1
    for (; it < NIT; it += 2 * nb) {
        CVM_PUT(t0, A);
        __syncthreads();
        if (it + 2 * nb < NIT) CVM_LOAD(it + 2 * nb, A);
        CVM_STORE(it, t0);
        if (it + nb < NIT) {
            CVM_PUT(t1, B);
            __syncthreads();
            if (it + 3 * nb < NIT) CVM_LOAD(it + 3 * nb, B);
            CVM_STORE(it + nb, t1);
        }
    }
#undef CVM_LOAD
#undef CVM_PUT
#undef CVM_STORE
    __syncthreads();
}

__device__ __forceinline__ void cvt_small_weights(InPtr in, unsigned char* ws, int l, LAS float* tile, int bid, int nb, int tid) {
    asm volatile("" : "+v"(tid));
    constexpr int I_WIN = 40 * 16, I_WOUT = 16 * 16, I_WU = 12 * 4, I_WC1 = 32, I_WC2 = 1, I_WR = 16;
    constexpr int PER_L = I_WIN + I_WOUT + 2 * I_WU + 2 * I_WC1 + 2 * I_WC2 + I_WR;
    for (int it0 = bid; it0 < PER_L; it0 += nb) {
        int it = it0;
        if (it < I_WIN) { FWin f{in->p[4] + (size_t)l * 1024 * DIN, in->p[3] + l * 1024}; cvt_item(f, it, 16, (bf16_t*)(ws + WS_WIN) + (size_t)l * 2560 * 1024, 1024, tile, tid); continue; } it -= I_WIN;
        if (it < I_WOUT) { FWout f{in->p[21] + (size_t)l * 1048576, in->p[10] + l * 384, in->p[20] + l * 384}; cvt_item(f, it, 16, (bf16_t*)(ws + WS_WOUT) + (size_t)l * 1048576, 1024, tile, tid); continue; } it -= I_WOUT;
        if (it < I_WU) { FWuq f{in->p[16] + (size_t)l * 192 * 576, in->p[15] + l * 192}; cvt_item(f, it, 4, (bf16_t*)(ws + WS_WUQ) + (size_t)l * 768 * 256, 256, tile, tid); continue; } it -= I_WU;
        if (it < I_WU) { FWukv f{in->p[18] + (size_t)l * 128 * 768, in->p[17] + l * 128}; cvt_item(f, it, 4, (bf16_t*)(ws + WS_WUKV) + (size_t)l * 768 * 256, 256, tile, tid); continue; } it -= I_WU;
        if (it < 2 * I_WC1) { const int s = it / I_WC1; FWc1 f{in->p[6] + ((size_t)l * 2 + s) * 2048 * 64}; cvt_item(f, it % I_WC1, 32, (bf16_t*)(ws + WS_WC1) + ((size_t)l * 2 + s) * 64 * 2048, 2048, tile, tid); continue; } it -= 2 * I_WC1;
        if (it < 2 * I_WC2) { const int s = it; FWc1 f{in->p[7] + ((size_t)l * 2 + s) * 64 * 64}; cvt_item(f, 0, 1, (bf16_t*)(ws + WS_WC2) + ((size_t)l * 2 + s) * 64 * 64, 64, tile, tid); continue; } it -= 2 * I_WC2;
        { FWr f{in->p[23] + (size_t)l * 4096, in->p[25] + (size_t)l * 32768, in->p[22] + l * 1024}; cvt_item(f, it, 16, (bf16_t*)(ws + WS_WR) + (size_t)l * 64 * 1024, 1024, tile, tid); }
    }
}

__device__ __forceinline__ void prologue(InPtr in, unsigned char* ws, LAS unsigned char* lds, int bid, int nb, int g_wv) {
    int tid_ = TIDX; asm volatile("" : "+v"(tid_));
    const int tid = tid_, lane = tid & 63, wid = tid >> 6;
    LAS float* tile = (LAS float*)lds;
    cvt_small_weights(in, ws, 0, tile, bid, nb, tid);
    { const float* x = in->p[0]; bf16_t* XB = (bf16_t*)(ws + WS_XB); float* ssqx = (float*)(ws + WS_SSQX);
      for (int r = bid * 8 + wid; r < NTOK; r += nb * 8) {
          const f32x4* xr = (const f32x4*)(x + (size_t)r * 1024) + lane; float s = 0.f; u32x2* o = (u32x2*)(XB + (size_t)r * 1024) + lane;
#pragma unroll
          for (int j = 0; j < 4; ++j) { const f32x4 v = xr[64 * j]; s += (v.x * v.x + v.y * v.y) + (v.z * v.z + v.w * v.w); u32x2 w; w.x = pk_bf16(v.x, v.y); w.y = pk_bf16(v.z, v.w); o[64 * j] = w; }
          s = wave_sum(s); if (lane == 0) ssqx[r] = s;
      } }
    { float* biasd = (float*)(ws + WS_BIASD); const float* rb = in->p[2];
      for (int i = bid * 512 + tid; i < 6 * 2048; i += nb * 512) { const int h = i >> 11, d = i & 2047; biasd[i] = rb[t5b(d) * 6 + h] * 1.44269504f; } }
    { float* rope = (float*)(ws + WS_ROPE); const int* pos = (const int*)in->p[1];
      for (int i = bid * 512 + tid; i < NTOK * 16; i += nb * 512) { const int tk = i >> 4, j = i & 15; float cs, sn; rope_cs(pos[tk], j, cs, sn); rope[(size_t)tk * 32 + j] = cs; rope[(size_t)tk * 32 + 16 + j] = sn; } }
    { float* b1c = (float*)(ws + WS_B1C); LAS float* red = (LAS float*)lds;
      for (int it = bid; it < 4; it += nb) { const float* pe = in->p[5] + (size_t)it * 2048; const float* w1 = in->p[6] + (size_t)it * 2048 * 64; const int f = tid & 63, part = tid >> 6;
          float a = 0.f; for (int k = part * 256; k < part * 256 + 256; ++k) a += pe[k] * w1[(size_t)k * 64 + f];
          __syncthreads(); red[tid] = a; __syncthreads();
          if (tid < 64) { float s = 0.f; for (int p2 = 0; p2 < 8; ++p2) s += red[p2 * 64 + tid]; b1c[it * 64 + tid] = s; }
          __syncthreads(); } }
}
namespace g8 {
constexpr int BM = 256, BK = 64, HALF = 128, HTB = HALF * BK * 2, STAGE_BYTES = 8 * HTB, NXCD = 8, WGM = 8;
__host__ __device__ __forceinline__ int lds_byte(int r, int c) { const int st = (r >> 4) * 2 + (c >> 5), rr = r & 15, cc = c & 31, ob = rr * 64 + cc * 2; return st * 1024 + (ob ^ (((ob >> 9) & 1) << 5)); }
__host__ __device__ __forceinline__ void stage_rc(int b, int& R, int& C) { const int st = b / 1024, sb = b % 1024, swz = sb ^ (((sb >> 9) & 1) << 5); R = (st >> 1) * 16 + swz / 64; C = (st & 1) * 32 + (swz % 64) / 2; }
__host__ __device__ __forceinline__ int perm32(int rho) { const int n = rho >> 4, i = rho & 15; return 8 * (i >> 2) + 4 * n + (i & 3); }

struct GUnit { const char* a; const char* b; int pm, pn, e, rows; };

__device__ __forceinline__ bool static_unit(int i, int G, int c, int nM, int nN, int& pm, int& pn) {
    const int nwg = nM * nN; const long L = (long)i * G + c; if (L >= nwg) return false;
    int wgid = (int)L; { const int q = nwg / NXCD, r = nwg % NXCD, xcd = wgid % NXCD, off = wgid / NXCD; wgid = (xcd < r ? xcd * (q + 1) : r * (q + 1) + (xcd - r) * q) + off; }
    const int nig = WGM * nN, gid = wgid / nig, fm = gid * WGM, gsz = (nM - fm) < WGM ? (nM - fm) : WGM;
    pm = fm + ((wgid % nig) % gsz); pn = (wgid % nig) / gsz; return true;
}
struct DenseSched {
    static constexpr bool GATHER = false, PARTIAL = false;
    const char* A; const char* Bt; int lda, ldb, nM, nN, G, c;
    __device__ __forceinline__ bool next(int i, GUnit& u) const {
        int pm, pn; if (!static_unit(i, G, c, nM, nN, pm, pn)) return false;
        u.pm = pm; u.pn = pn; u.e = 0; u.rows = 256; u.a = A + (size_t)pm * 256 * lda * 2; u.b = Bt + (size_t)pn * 256 * ldb * 2; return true;
    }
    __device__ __forceinline__ void aoff(const GUnit&, unsigned (&v)[2][2], const int (&R)[2], const int (&C)[2]) const {
#pragma unroll
        for (int h = 0; h < 2; ++h)
#pragma unroll
            for (int i = 0; i < 2; ++i) v[h][i] = (unsigned)((h * 128 + R[i]) * lda + C[i]) * 2u;
    }
};

template <class Epi, class Sched>
__device__ __forceinline__ void gemm_run(LAS unsigned char* lds, const int K, const int ldb, const Sched& S, const Epi& E, int g_wv) {
    int tid_ = TIDX; asm volatile("" : "+v"(tid_));
    const int tid = tid_, wid = __builtin_amdgcn_readfirstlane(tid >> 6), lane = tid & 63, wr = wid >> 2, wc = wid & 3, fr = lane & 15, fq = lane >> 4;
    int nt_ = K / BK; asm volatile("" : "+s"(nt_));
    const int nt = nt_;
    int R[2], C[2]; unsigned voffB[2];
#pragma unroll
    for (int i = 0; i < 2; ++i) { stage_rc(tid * 16 + i * 8192, R[i], C[i]); const int Rb = (R[i] & ~31) + perm32(R[i] & 31); voffB[i] = (unsigned)(Rb * ldb + C[i]) * 2u; }
    const size_t kstep = (size_t)(BK * 2);
    const size_t hstepB = (size_t)HALF * ldb * 2;
    const unsigned ldsw = (unsigned)wid * 1024u;
    const int aoff = lds_byte(wr * 64 + fr, fq * 8), boff = lds_byte(wc * 32 + fr, fq * 8);
#define G8_SA(b, h) (((b) * 2 + (h)) * HTB)
#define G8_SB(b, h) ((4 + (b) * 2 + (h)) * HTB)
#define G8_GLDS(bufoff, gptr, i_) __builtin_amdgcn_global_load_lds((const unsigned*)(gptr), (LAS unsigned*)(lds + (bufoff) + ldsw + (i_) * 8192), 16, 0, 0)
#define G8_STAGE_B(bufoff, gbase) do { G8_GLDS(bufoff, (const char*)(gbase) + voffB[0], 0); G8_GLDS(bufoff, (const char*)(gbase) + voffB[1], 1); } while (0)
#define G8_STAGE_A(bufoff, gbase, v0, v1) do { G8_GLDS(bufoff, (const char*)(gbase) + (v0), 0); G8_GLDS(bufoff, (const char*)(gbase) + (v1), 1); } while (0)
#define G8_LDA(dst, b, h) do { _Pragma("unroll") for (int m = 0; m < 4; ++m) _Pragma("unroll") for (int k = 0; k < 2; ++k) dst[m][k] = *(const LAS bf16x8*)(lds + G8_SA(b, h) + aoff + m * 2048 + k * 1024); } while (0)
#define G8_LDB(dst, b, h) do { _Pragma("unroll") for (int n = 0; n < 2; ++n) _Pragma("unroll") for (int k = 0; k < 2; ++k) dst[n][k] = *(const LAS bf16x8*)(lds + G8_SB(b, h) + boff + n * 2048 + k * 1024); } while (0)
#define G8_MMA(ai, bj, At, Bt) do { __builtin_amdgcn_s_setprio(1); _Pragma("unroll") for (int m = 0; m < 4; ++m) { if (!PARTIAL || ((mmask >> ((ai) * 4 + m)) & 1u)) { _Pragma("unroll") for (int n = 0; n < 2; ++n) _Pragma("unroll") for (int k = 0; k < 2; ++k) \
        acc[ai][bj][m][n] = __builtin_amdgcn_mfma_f32_16x16x32_bf16(Bt[n][k], At[m][k], acc[ai][bj][m][n], 0, 0, 0); } } __builtin_amdgcn_s_setprio(0); } while (0)
#define G8_WAIT_V(n) asm volatile("s_waitcnt vmcnt(" #n ")" ::: "memory")
#define G8_WAIT_L(n) asm volatile("s_waitcnt lgkmcnt(" #n ")" ::: "memory")
#define G8_BAR __builtin_amdgcn_s_barrier()
#define G8_SCHED __builtin_amdgcn_sched_barrier(0)
    GUnit cur, nxt; int ui = 0;
    if (!S.next(0, cur)) return;
    constexpr bool GATHER = Sched::GATHER, PARTIAL = Sched::PARTIAL;
    unsigned mmask = 0xffu;
#define G8_MASK(u) do { if (PARTIAL) { mmask = 0u; _Pragma("unroll") for (int q_ = 0; q_ < 8; ++q_) mmask |= (((q_ >> 2) * 128 + wr * 64 + (q_ & 3) * 16) < (u).rows) ? (1u << q_) : 0u; } } while (0)
    unsigned vc[2][2];
    S.aoff(cur, vc, R, C); G8_MASK(cur);
    LAS u32x4* stash = (LAS u32x4*)(lds + STAGE_BYTES + 4096) + tid;
    f32x4 acc[2][2][4][2];
#pragma unroll
    for (int a = 0; a < 2; ++a)
#pragma unroll
        for (int b = 0; b < 2; ++b)
#pragma unroll
            for (int m = 0; m < 4; ++m)
#pragma unroll
                for (int n = 0; n < 2; ++n) acc[a][b][m][n] = (f32x4){0.f, 0.f, 0.f, 0.f};
    bf16x8 At[4][2], B0[2][2], B1[2][2];
    const char* cA = cur.a; const char* cB = cur.b;
    G8_STAGE_B(G8_SB(0, 0), cB); G8_STAGE_B(G8_SB(0, 1), cB + hstepB); G8_STAGE_A(G8_SA(0, 0), cA, vc[0][0], vc[0][1]); G8_STAGE_A(G8_SA(0, 1), cA, vc[1][0], vc[1][1]);
    if (wr == 1) G8_BAR;
    G8_WAIT_V(2); G8_BAR;
    G8_STAGE_B(G8_SB(1, 0), cB + kstep); G8_STAGE_A(G8_SA(1, 0), cA + kstep, vc[0][0], vc[0][1]); G8_STAGE_B(G8_SB(1, 1), cB + hstepB + kstep);
    G8_WAIT_V(6); G8_BAR;
    for (;;) {
        const bool has_next = S.next(ui + 1, nxt);
        if (GATHER) { unsigned vn[2][2];
            if (has_next) S.aoff(nxt, vn, R, C);
            else { vn[0][0] = vc[0][0]; vn[0][1] = vc[0][1]; vn[1][0] = vc[1][0]; vn[1][1] = vc[1][1]; }
            u32x4 sv; sv.x = vn[0][0]; sv.y = vn[0][1]; sv.z = vn[1][0]; sv.w = vn[1][1]; *stash = sv; }
        const char* nA = has_next ? nxt.a : cA; const char* nB = has_next ? nxt.b : cB;
#pragma unroll 1
        for (int seg = 0; seg < (Epi::KHOOK ? 3 : 1); ++seg) {
        const int tlo = Epi::KHOOK ? 6 * seg : 0, thi = Epi::KHOOK ? (seg == 2 ? nt : 6 * seg + 6) : nt;
#pragma unroll 1
        for (int t = tlo; t < thi; t += 2) {
            const bool last = (t == nt - 2);
            const char* a1 = cA + (size_t)(t + 1) * kstep;
            const char* a2 = last ? nA : cA + (size_t)(t + 2) * kstep; const char* b2 = last ? nB : cB + (size_t)(t + 2) * kstep;
            const char* a3 = a2 + kstep; const char* b3 = b2 + kstep;
            unsigned w00 = vc[0][0], w01 = vc[0][1], w10 = vc[1][0], w11 = vc[1][1];
            if (GATHER) { if (last) { const u32x4 sv = *stash; w00 = sv.x; w01 = sv.y; w10 = sv.z; w11 = sv.w; } }
            G8_LDB(B0, 0, 0); G8_LDB(B1, 0, 1); G8_SCHED; G8_LDA(At, 0, 0); G8_STAGE_A(G8_SA(1, 1), a1, vc[1][0], vc[1][1]);
            G8_WAIT_V(8); G8_WAIT_L(0); G8_BAR; G8_MMA(0, 0, At, B0); G8_MMA(0, 1, At, B1); G8_BAR; G8_SCHED;
            G8_LDA(At, 0, 1); G8_STAGE_B(G8_SB(0, 0), b2); G8_STAGE_B(G8_SB(0, 1), b2 + hstepB); G8_STAGE_A(G8_SA(0, 0), a2, w00, w01);
            G8_WAIT_V(8); G8_WAIT_L(0); G8_BAR; G8_MMA(1, 0, At, B0); G8_MMA(1, 1, At, B1); G8_BAR; G8_SCHED;
            G8_LDB(B0, 1, 0); G8_LDB(B1, 1, 1); G8_SCHED; G8_LDA(At, 1, 0); G8_STAGE_A(G8_SA(0, 1), a2, w10, w11);
            G8_WAIT_V(8); G8_WAIT_L(0); G8_BAR; G8_MMA(0, 0, At, B0); G8_MMA(0, 1, At, B1); G8_BAR; G8_SCHED;
            G8_LDA(At, 1, 1); G8_STAGE_B(G8_SB(1, 0), b3); G8_STAGE_B(G8_SB(1, 1), b3 + hstepB); G8_STAGE_A(G8_SA(1, 0), a3, w00, w01);
            G8_WAIT_V(8); G8_WAIT_L(0); G8_BAR; G8_MMA(1, 0, At, B0); G8_MMA(1, 1, At, B1); G8_BAR; G8_SCHED;
        }
        if constexpr (Epi::KHOOK) { if (seg < 2) E.kscale(acc, seg, wr, fr); }
        }
        if (wr == 0) G8_BAR;
        { int fr_ = fr, fq_ = fq; asm volatile("" : "+v"(fr_), "+v"(fq_));
          E(acc, cur, wr, wc, fr_, fq_); }
        if (!has_next) break;
#pragma unroll
        for (int a = 0; a < 2; ++a)
#pragma unroll
            for (int b = 0; b < 2; ++b)
#pragma unroll
                for (int m = 0; m < 4; ++m)
#pragma unroll
                    for (int n = 0; n < 2; ++n) acc[a][b][m][n] = (f32x4){0.f, 0.f, 0.f, 0.f};
        cur = nxt; cA = nA; cB = nB; ++ui; G8_MASK(cur);
        if (GATHER) { const u32x4 sv = *stash; vc[0][0] = sv.x; vc[0][1] = sv.y; vc[1][0] = sv.z; vc[1][1] = sv.w; }
        if (wr == 1) G8_BAR;
    }
    G8_WAIT_V(0);
    G8_BAR;
#undef G8_SA
#undef G8_SB
#undef G8_GLDS
#undef G8_STAGE_A
#undef G8_STAGE_B
#undef G8_LDA
#undef G8_LDB
#undef G8_MMA
#undef G8_MASK
#undef G8_WAIT_V
#undef G8_WAIT_L
#undef G8_BAR
#undef G8_SCHED
}
}
using g8::GUnit;
__device__ __forceinline__ void st_bf16x8(bf16_t* p, const float (&v)[8]) { u32x4 w; w.x = pk_bf16(v[0], v[1]); w.y = pk_bf16(v[2], v[3]); w.z = pk_bf16(v[4], v[5]); w.w = pk_bf16(v[6], v[7]); *(u32x4*)p = w; }
__device__ __forceinline__ float quad_sum(float s) { s += __shfl_xor(s, 16); s += __shfl_xor(s, 32); return s; }

struct EpiInProj {
    static constexpr bool KHOOK = false;
    const float* ssqx; float* part_dq; float* part_dkv; const float* qg; const float* kg; const float* krg; const float* rope;
    unsigned char* prj;
    __device__ __forceinline__ void operator()(const f32x4 (&acc)[2][2][4][2], const GUnit& u, int wr, int wc, int fr, int fq) const {
        const int G = u.pn * 4 + wc;
        const bool isq = G < 6; const int a = G - 6; const bool isk = (G >= 10 && G < 18 && ((a >> 1) & 1) == 0);
        const float* g0 = (isq ? qg : kg) + 8 * fq;
        float rs8[8];
#pragma unroll
        for (int k = 0; k < 8; ++k) rs8[k] = ssqx[u.pm * 256 + (k >> 2) * 128 + wr * 64 + (k & 3) * 16 + fr];
#pragma unroll
        for (int k = 0; k < 8; ++k) rs8[k] = rsqrtf(rs8[k] * (1.f / 1024.f) + 1e-6f);
#pragma unroll
        for (int ai = 0; ai < 2; ++ai)
#pragma unroll
            for (int m = 0; m < 4; ++m) {
                __builtin_amdgcn_sched_barrier(0);
                const int row = u.pm * 256 + ai * 128 + wr * 64 + m * 16 + fr; const int b = row >> 11, t = row & 2047;
                const float rs = rs8[ai * 4 + m];
                float v[2][8];
#pragma unroll
                for (int bj = 0; bj < 2; ++bj)
#pragma unroll
                    for (int n = 0; n < 2; ++n)
#pragma unroll
                        for (int j = 0; j < 4; ++j) v[bj][4 * n + j] = acc[ai][bj][m][n][j] * rs;
                float ss = 0.f;
#pragma unroll
                for (int bj = 0; bj < 2; ++bj)
#pragma unroll
                    for (int i = 0; i < 8; ++i) ss += v[bj][i] * v[bj][i];
                bf16_t* dst = nullptr; int bstride = 32;
                if (isq) {
                    ss = quad_sum(ss); const float sc = rsqrtf(ss * (1.f / 64.f) + 1e-6f) * 0.18033688f;
#pragma unroll
                    for (int i = 0; i < 8; ++i) { v[0][i] *= sc * g0[i]; v[1][i] *= sc * g0[32 + i]; }
                    dst = (bf16_t*)(prj + PRJ_QN) + ((size_t)(b * 6 + G) * 2048 + t) * 64;
                } else if (G < 18) {
                    const int br = a >> 2, s = (a >> 1) & 1, hk = a & 1;
                    if (br > 0 && s == 0) {
                        ss = quad_sum(ss); const float sc = rsqrtf(ss * (1.f / 64.f) + 1e-6f);
#pragma unroll
                        for (int i = 0; i < 8; ++i) { v[0][i] *= sc * g0[i]; v[1][i] *= sc * g0[32 + i]; }
                    }
                    const size_t base = br == 0 ? (s ? PRJ_C0V : PRJ_C0K) : (br == 1 ? (s ? PRJ_VN1 : PRJ_KN1) : (s ? PRJ_VN2 : PRJ_KN2));
                    dst = (bf16_t*)(prj + base) + ((size_t)(b * 2 + hk) * 2048 + t) * 64;
                } else if (G < 26) { dst = (bf16_t*)(prj + PRJ_RAWQK) + (size_t)row * 512 + (G - 18) * 64; }
                else if (G < 30) { dst = (bf16_t*)(prj + PRJ_VML) + ((size_t)(b * 4 + (G - 26)) * 2048 + t) * 64; }
                else if (G < 34) { dst = (bf16_t*)(prj + PRJ_OG) + (size_t)row * 256 + (G - 30) * 64; }
                else if (G < 37) { dst = (bf16_t*)(prj + PRJ_DQKV) + (size_t)row * 384 + (G - 34) * 64; ss = quad_sum(ss); if (fq == 0) part_dq[(size_t)row * 4 + (G - 34)] = ss; }
                else if (G == 37) {
                    dst = (bf16_t*)(prj + PRJ_DQKV) + (size_t)row * 384 + 192;
                    float* gt = (float*)(prj + PRJ_GATES) + (size_t)row * 32 + 8 * fq;
                    *(f32x4*)gt = (f32x4){v[1][0], v[1][1], v[1][2], v[1][3]}; *(f32x4*)(gt + 4) = (f32x4){v[1][4], v[1][5], v[1][6], v[1][7]};
                    float s0 = 0.f;
#pragma unroll
                    for (int i = 0; i < 8; ++i) s0 += v[0][i] * v[0][i];
                    s0 = quad_sum(s0); const float sc = rsqrtf(s0 * (1.f / 32.f) + 1e-6f);
                    const float* rp = rope + (size_t)row * 32 + ((8 * fq) & 15);
                    float kr[8];
#pragma unroll
                    for (int i = 0; i < 8; ++i) { const float val = v[0][i] * sc * krg[8 * fq + i]; const float oth = __shfl_xor(val, 32); const float cs = rp[i], sn = rp[16 + i]; kr[i] = fq < 2 ? val * cs - oth * sn : val * cs + oth * sn; }
                    st_bf16x8((bf16_t*)(prj + PRJ_KR) + (size_t)row * 32 + 8 * fq, kr);
                } else { dst = (bf16_t*)(prj + PRJ_DQKV) + (size_t)row * 384 + 256 + (G - 38) * 64; ss = quad_sum(ss); if (fq == 0) part_dkv[(size_t)row * 2 + (G - 38)] = ss; }
                st_bf16x8(dst + 8 * fq, v[0]); st_bf16x8(dst + bstride + 8 * fq, v[1]);
            }
    }
};

struct EpiUq {
    static constexpr bool KHOOK = false;
    const float* ssq_dq; const float* qkn; const float* rope; bf16_t* QM;
    __device__ __forceinline__ void operator()(const f32x4 (&acc)[2][2][4][2], const GUnit& u, int wr, int wc, int fr, int fq) const {
        const int G = u.pn * 4 + wc; if (G >= 9) return;
        const float scale = 0.14724444f;
        const float* g0 = G < 6 ? qkn + 8 * fq : qkn + 64 + 8 * (fq & 1); const float* g1 = G < 6 ? g0 + 32 : g0 + 16;
        float rs8[8];
#pragma unroll
        for (int k = 0; k < 8; ++k) { const f32x4 pq = *(const f32x4*)(ssq_dq + (size_t)(u.pm * 256 + (k >> 2) * 128 + wr * 64 + (k & 3) * 16 + fr) * 4); rs8[k] = (pq.x + pq.y) + pq.z; }
#pragma unroll
        for (int k = 0; k < 8; ++k) rs8[k] = rsqrtf(rs8[k] * (1.f / 192.f) + 1e-6f);
#pragma unroll
        for (int ai = 0; ai < 2; ++ai)
#pragma unroll
            for (int m = 0; m < 4; ++m) {
                __builtin_amdgcn_sched_barrier(0);
                const int row = u.pm * 256 + ai * 128 + wr * 64 + m * 16 + fr; const int b = row >> 11, t = row & 2047;
                const float rs = rs8[ai * 4 + m];
                float v[2][8]; float ss = 0.f;
#pragma unroll
                for (int bj = 0; bj < 2; ++bj)
#pragma unroll
                    for (int n = 0; n < 2; ++n)
#pragma unroll
                        for (int j = 0; j < 4; ++j) { const float x = acc[ai][bj][m][n][j] * rs; v[bj][4 * n + j] = x; ss += x * x; }
                if (G < 6) ss = quad_sum(ss); else ss += __shfl_xor(ss, 16);
                const float sc = rsqrtf(ss * (G < 6 ? 1.f / 64.f : 1.f / 32.f) + 1e-6f) * scale;
#pragma unroll
                for (int i = 0; i < 8; ++i) { v[0][i] *= sc * g0[i]; v[1][i] *= sc * g1[i]; }
                if (G < 6) {
                    bf16_t* dst = QM + ((size_t)(b * 6 + G) * 2048 + t) * 96;
                    st_bf16x8(dst + 8 * fq, v[0]); st_bf16x8(dst + 32 + 8 * fq, v[1]);
                } else {
                    const int i16 = 8 * (fq & 1); const int head = 2 * (G - 6) + (fq >> 1);
                    const float* rp = rope + (size_t)row * 32 + i16; float o1[8], o2[8];
#pragma unroll
                    for (int i = 0; i < 8; ++i) { const float cs = rp[i], sn = rp[16 + i]; o1[i] = v[0][i] * cs - v[1][i] * sn; o2[i] = v[1][i] * cs + v[0][i] * sn; }
                    bf16_t* dst = QM + ((size_t)(b * 6 + head) * 2048 + t) * 96 + 64 + i16;
                    st_bf16x8(dst, o1); st_bf16x8(dst + 16, o2);
                }
            }
    }
};
struct EpiUkv {
    static constexpr bool KHOOK = false;
    const float* ssq_dkv; const float* qkn; const bf16_t* KR; bf16_t* KM; bf16_t* VM;
    __device__ __forceinline__ void operator()(const f32x4 (&acc)[2][2][4][2], const GUnit& u, int wr, int wc, int fr, int fq) const {
        const int G = u.pn * 4 + wc;
        const float* g0 = qkn + 96 + 8 * fq;
        float rs8[8];
#pragma unroll
        for (int k = 0; k < 8; ++k) { const size_t rr = (size_t)(u.pm * 256 + (k >> 2) * 128 + wr * 64 + (k & 3) * 16 + fr); rs8[k] = ssq_dkv[rr * 2] + ssq_dkv[rr * 2 + 1]; }
#pragma unroll
        for (int k = 0; k < 8; ++k) rs8[k] = rsqrtf(rs8[k] * (1.f / 128.f) + 1e-6f);
#pragma unroll
        for (int ai = 0; ai < 2; ++ai)
#pragma unroll
            for (int m = 0; m < 4; ++m) {
                __builtin_amdgcn_sched_barrier(0);
                const int row = u.pm * 256 + ai * 128 + wr * 64 + m * 16 + fr; const int b = row >> 11, t = row & 2047;
                const float rs = rs8[ai * 4 + m];
                float v[2][8]; float ss = 0.f;
#pragma unroll
                for (int bj = 0; bj < 2; ++bj)
#pragma unroll
                    for (int n = 0; n < 2; ++n)
#pragma unroll
                        for (int j = 0; j < 4; ++j) { const float x = acc[ai][bj][m][n][j] * rs; v[bj][4 * n + j] = x; ss += x * x; }
                if (G < 6) {
                    ss = quad_sum(ss); const float sc = rsqrtf(ss * (1.f / 64.f) + 1e-6f);
#pragma unroll
                    for (int i = 0; i < 8; ++i) { v[0][i] *= sc * g0[i]; v[1][i] *= sc * g0[32 + i]; }
                    bf16_t* dst = KM + ((size_t)(b * 6 + G) * 2048 + t) * 96;
                    st_bf16x8(dst + 8 * fq, v[0]); st_bf16x8(dst + 32 + 8 * fq, v[1]);
                    *(u32x4*)(dst + 64 + 8 * fq) = *(const u32x4*)(KR + (size_t)row * 32 + 8 * fq);
                } else {
                    bf16_t* dst = VM + ((size_t)(b * 6 + (G - 6)) * 2048 + t) * 64;
                    st_bf16x8(dst + 8 * fq, v[0]); st_bf16x8(dst + 32 + 8 * fq, v[1]);
                }
            }
    }
};
#define MFMA16(a, b, c) __builtin_amdgcn_mfma_f32_16x16x32_bf16(a, b, c, 0, 0, 0)
#define MFMA32(a, b, c) __builtin_amdgcn_mfma_f32_32x32x16_bf16(a, b, c, 0, 0, 0)
#define LDS_FENCE() asm volatile("s_waitcnt lgkmcnt(0)" ::: "memory")

__device__ __forceinline__ void cmp_unit(int u, int l, InPtr in, unsigned char* ws, LAS unsigned char* lds, int g_wv) {
    int tid_ = TIDX; asm volatile("" : "+v"(tid_));
    const int tid = tid_, w = tid >> 6, lane = tid & 63, r = lane & 15, q = lane >> 4;
    const int b = u >> 2, s = (u >> 1) & 1, hk = u & 1;
    const bf16_t* A = (const bf16_t*)(ws + WS_PRJ + (s ? PRJ_C0V : PRJ_C0K)) + (size_t)(b * 2 + hk) * 2048 * 64;
    const bf16_t* W1 = (const bf16_t*)(ws + WS_WC1) + ((size_t)l * 2 + s) * 64 * 2048;
    const bf16_t* W2 = (const bf16_t*)(ws + WS_WC2) + ((size_t)l * 2 + s) * 64 * 64;
    const float* b1 = (const float*)(ws + WS_B1C) + (l * 2 + s) * 64;
    f32x4 acc[4];
#pragma unroll
    for (int nb = 0; nb < 4; ++nb) acc[nb] = (f32x4){0.f, 0.f, 0.f, 0.f};
    const bf16_t* ap = A + (size_t)(16 * w + r) * 1024 + 8 * q;
    constexpr int WP = 528, WBUF = 64 * WP; LAS unsigned char* wb = lds + 24576;
    u32x4 st[4];
#pragma unroll
    for (int i = 0; i < 4; ++i) { const int c = tid + 512 * i; st[i] = *(const u32x4*)(W1 + (size_t)(c >> 5) * 2048 + (c & 31) * 8); }
#pragma unroll
    for (int i = 0; i < 4; ++i) { const int c = tid + 512 * i; *(LAS u32x4*)(wb + (c >> 5) * WP + (c & 31) * 16) = st[i]; }
    __syncthreads();
#pragma unroll 1
    for (int kc = 0; kc < 8; ++kc) {
        const int cur = kc & 1;
        if (kc < 7) {
#pragma unroll
            for (int i = 0; i < 4; ++i) { const int c = tid + 512 * i; st[i] = *(const u32x4*)(W1 + (size_t)(c >> 5) * 2048 + (kc + 1) * 256 + (c & 31) * 8); }
        }
        bf16x8 af[8];
#pragma unroll
        for (int ks = 0; ks < 8; ++ks) af[ks] = *(const bf16x8*)(ap + 256 * kc + 32 * ks);
#pragma unroll
        for (int ks = 0; ks < 8; ++ks)
#pragma unroll
            for (int nb = 0; nb < 4; ++nb) { const bf16x8 bb = *(const LAS bf16x8*)(wb + cur * WBUF + (16 * nb + r) * WP + (32 * ks + 8 * q) * 2); acc[nb] = MFMA16(af[ks], bb, acc[nb]); }
        if (kc < 7) {
#pragma unroll
            for (int i = 0; i < 4; ++i) { const int c = tid + 512 * i; *(LAS u32x4*)(wb + (cur ^ 1) * WBUF + (c >> 5) * WP + (c & 31) * 16) = st[i]; }
        }
        __syncthreads();
    }
    LAS bf16_t* hl = (LAS bf16_t*)(lds + w * 2304);
#pragma unroll
    for (int nb = 0; nb < 4; ++nb) { const float bias = b1[16 * nb + r];
#pragma unroll
        for (int j = 0; j < 4; ++j) hl[(4 * q + j) * 72 + 16 * nb + r] = f2bf(siluf(acc[nb][j] + bias)); }
    LDS_FENCE();
    f32x4 o[4];
#pragma unroll
    for (int nb = 0; nb < 4; ++nb) o[nb] = (f32x4){0.f, 0.f, 0.f, 0.f};
#pragma unroll
    for (int ks = 0; ks < 2; ++ks) {
        const bf16x8 a = *(const LAS bf16x8*)(hl + r * 72 + 32 * ks + 8 * q);
#pragma unroll
        for (int nb = 0; nb < 4; ++nb) { const bf16x8 bb = *(const bf16x8*)(W2 + (size_t)(16 * nb + r) * 64 + 32 * ks + 8 * q); o[nb] = MFMA16(a, bb, o[nb]); }
    }
    LDS_FENCE();
    const float* kg = in->p[9] + l * 64;
    bf16_t* dst = (bf16_t*)(ws + WS_CMP + (s ? CMP_V : 0)) + (size_t)(b * 2 + hk) * 128 * 64;
#pragma unroll
    for (int j = 0; j < 4; ++j) {
        const int n = 16 * w + 4 * q + j; float ss = 0.f;
#pragma unroll
        for (int nb = 0; nb < 4; ++nb) ss += o[nb][j] * o[nb][j];
        ss += __shfl_xor(ss, 1); ss += __shfl_xor(ss, 2); ss += __shfl_xor(ss, 4); ss += __shfl_xor(ss, 8);
        const float sc = s == 0 ? rsqrtf(ss * (1.f / 64.f) + 1e-6f) : 1.f;
#pragma unroll
        for (int nb = 0; nb < 4; ++nb) { const int d = 16 * nb + r; const float v = o[nb][j] * sc * (s == 0 ? kg[d] : 1.f); dst[(size_t)n * 64 + d] = n < 127 ? f2bf(v) : (bf16_t)0; }
    }
}

__device__ __forceinline__ int swz_off(int row, int chunk) { return row * 128 + ((chunk ^ (row & 7)) << 4); }
__device__ __forceinline__ float log_sigmoid(float x) { return fminf(x, 0.f) - log1pf(__expf(-fabsf(x))); }
__device__ __forceinline__ void ml_delta_wave(int cu, int l, InPtr in, unsigned char* ws, LAS unsigned char* wl, int lane) {
    const int c = cu & 31, bh = cu >> 5, h = bh & 3, b = bh >> 2; const int t0 = c * 64; const size_t row0 = (size_t)b * 2048 + t0;
    const float* G = (const float*)(ws + WS_PRJ + PRJ_GATES);
    const float ip = G[(row0 + lane) * 32 + 18 + h] + in->p[12][l * 4 + h], fp = G[(row0 + lane) * 32 + 22 + h] + in->p[13][l * 4 + h];
    float bcum = log_sigmoid(fp);
#pragma unroll
    for (int o = 1; o < 64; o <<= 1) { const float t = __builtin_bit_cast(float, __builtin_amdgcn_ds_bpermute(((lane - o) & 63) << 2, __builtin_bit_cast(int, bcum))); if (lane >= o) bcum += t; }
    const float bL = __builtin_bit_cast(float, __builtin_amdgcn_readlane(__builtin_bit_cast(int, bcum), 63)); const float wgt = __expf(bL - bcum + ip);
    { float* mlg = (float*)(ws + WS_ML + ML_G) + ((size_t)bh * 2048 + t0 + lane) * 2; mlg[0] = bcum; mlg[1] = ip; if (lane == 0) ((float*)(ws + WS_ML + ML_BL))[cu] = bL; }
    const bf16_t* raw = (const bf16_t*)(ws + WS_PRJ + PRJ_RAWQK); const float* cw = in->p[11] + (size_t)l * 4 * 512;
    float wq[4], wk[4];
#pragma unroll
    for (int j = 0; j < 4; ++j) { wq[j] = cw[j * 512 + h * 64 + lane]; wk[j] = cw[j * 512 + 256 + h * 64 + lane]; }
    float q3 = 0.f, q2 = 0.f, q1 = 0.f, k3 = 0.f, k2 = 0.f, k1 = 0.f;
    if (c > 0) { const bf16_t* p = raw + (row0 - 3) * 512 + h * 64 + lane; q3 = bf2f(p[0]); q2 = bf2f(p[512]); q1 = bf2f(p[1024]); k3 = bf2f(p[256]); k2 = bf2f(p[512 + 256]); k1 = bf2f(p[1024 + 256]); }
    bf16_t* QC = (bf16_t*)(ws + WS_ML) + ((size_t)bh * 2048 + t0) * 64 + lane; bf16_t* KC = (bf16_t*)(ws + WS_ML + ML_KC) + ((size_t)bh * 2048 + t0) * 64 + lane;
    const bf16_t* V = (const bf16_t*)(ws + WS_PRJ + PRJ_VML) + ((size_t)bh * 2048 + t0) * 64 + lane;
    float dn = 0.f;
    const bf16_t* rq = raw + row0 * 512 + h * 64 + lane;
    bf16_t cq[8], ck[8], cv[8], nq[8], nk[8], nv[8];
#pragma unroll
    for (int j = 0; j < 8; ++j) { cq[j] = rq[(size_t)j * 512]; ck[j] = rq[(size_t)j * 512 + 256]; cv[j] = V[(size_t)j * 64]; }
#pragma unroll 1
    for (int s8 = 0; s8 < 8; ++s8) {
        if (s8 < 7) {
#pragma unroll
            for (int j = 0; j < 8; ++j) { const int s = s8 * 8 + 8 + j; nq[j] = rq[(size_t)s * 512]; nk[j] = rq[(size_t)s * 512 + 256]; nv[j] = V[(size_t)s * 64]; }
        }
        float kb[8], vb[8]; bf16_t qo[8], ko[8];
#pragma unroll
        for (int j = 0; j < 8; ++j) {
            const int s = s8 * 8 + j;
            const float q0 = bf2f(cq[j]), k0 = bf2f(ck[j]);
            const float qv = siluf(wq[0] * q3 + wq[1] * q2 + wq[2] * q1 + wq[3] * q0), kv = siluf(wk[0] * k3 + wk[1] * k2 + wk[2] * k1 + wk[3] * k0) * 0.125f;
            q3 = q2; q2 = q1; q1 = q0; k3 = k2; k2 = k1; k1 = k0;
            qo[j] = f2bf(qv); ko[j] = f2bf(kv);
            const float ws_ = __builtin_bit_cast(float, __builtin_amdgcn_readlane(__builtin_bit_cast(int, wgt), s)); kb[j] = bf2f(ko[j]); dn += ws_ * kb[j]; vb[j] = ws_ * bf2f(cv[j]);
        }
#pragma unroll
        for (int j = 0; j < 8; ++j) { QC[(size_t)(s8 * 8 + j) * 64] = qo[j]; KC[(size_t)(s8 * 8 + j) * 64] = ko[j]; }
        u32x4 pk; pk.x = pk_bf16(kb[0], kb[1]); pk.y = pk_bf16(kb[2], kb[3]); pk.z = pk_bf16(kb[4], kb[5]); pk.w = pk_bf16(kb[6], kb[7]);
        *(LAS u32x4*)(wl + swz_off(lane, s8)) = pk;
        pk.x = pk_bf16(vb[0], vb[1]); pk.y = pk_bf16(vb[2], vb[3]); pk.z = pk_bf16(vb[4], vb[5]); pk.w = pk_bf16(vb[6], vb[7]);
        *(LAS u32x4*)(wl + 8192 + swz_off(lane, s8)) = pk;
#pragma unroll
        for (int j = 0; j < 8; ++j) { cq[j] = nq[j]; ck[j] = nk[j]; cv[j] = nv[j]; }
    }
    ((float*)(ws + WS_ML + ML_DN))[(size_t)cu * 64 + lane] = dn;
    LDS_FENCE();
    const int r = lane & 15, q = lane >> 4;
    bf16_t* DL = (bf16_t*)(ws + WS_ML + ML_DELTA) + (size_t)cu * 4096;
#pragma unroll
    for (int mb = 0; mb < 4; ++mb) {
        f32x4 acc[4];
#pragma unroll
        for (int nb = 0; nb < 4; ++nb) acc[nb] = (f32x4){0.f, 0.f, 0.f, 0.f};
#pragma unroll
        for (int ks = 0; ks < 2; ++ks) {
            const bf16x8 a = *(const LAS bf16x8*)(wl + 8192 + swz_off(16 * mb + r, 4 * ks + q));
#pragma unroll
            for (int nb = 0; nb < 4; ++nb) { const bf16x8 bb = *(const LAS bf16x8*)(wl + swz_off(16 * nb + r, 4 * ks + q)); acc[nb] = MFMA16(a, bb, acc[nb]); }
        }
#pragma unroll
        for (int nb = 0; nb < 4; ++nb)
#pragma unroll
            for (int j = 0; j < 4; ++j) DL[(16 * mb + 4 * q + j) * 64 + 16 * nb + r] = f2bf(acc[nb][j]);
    }
    LDS_FENCE();
}

#ifndef TIME_PH
#define TIME_PH -1
#endif
#define PSTAMP(i, blk) do { if (TIME_PH != -1 && l == 0 && blockIdx.x == (blk) && TIDX == 0) ((unsigned long long*)((unsigned*)(ws + WS_CTL) + CW_TS))[i] = __builtin_amdgcn_s_memrealtime(); } while (0)
__device__ __forceinline__ void phase_prep(int l, InPtr in, unsigned char* ws, LAS unsigned char* lds, int bid, int nb, int g_wv, unsigned* dq) {
    asm volatile("" : "+s"(bid));
    PSTAMP(40, 0);
#ifndef NO_UQ
    { g8::DenseSched S{(const char*)(ws + WS_PRJ + PRJ_DQKV), (const char*)(ws + WS_WUQ) + (size_t)l * 768 * 256 * 2, 384, 256, 64, 3, nb, bid};
      EpiUq E{(const float*)(ws + WS_SSQ + PT_DQ) + (size_t)l * 16384 * 4, in->p[19] + l * 192, (const float*)(ws + WS_ROPE), (bf16_t*)(ws + WS_MLA)};
      g8::gemm_run(lds, 256, 256, S, E, g_wv); }
#endif
    PSTAMP(41, 0);
#ifndef NO_UKV
    asm volatile("" : "+s"(bid));
    { g8::DenseSched S{(const char*)(ws + WS_PRJ + PRJ_DQKV) + 256, (const char*)(ws + WS_WUKV) + (size_t)l * 768 * 256 * 2, 384, 256, 64, 3, nb, bid};
      EpiUkv E{(const float*)(ws + WS_SSQ + PT_DKV) + (size_t)l * 16384 * 2, in->p[19] + l * 192, (const bf16_t*)(ws + WS_PRJ + PRJ_KR), (bf16_t*)(ws + WS_MLA + MLA_KM), (bf16_t*)(ws + WS_MLA + MLA_VM)};
      g8::gemm_run(lds, 256, 256, S, E, g_wv); }
#endif
    PSTAMP(42, 0); PSTAMP(44, 255);
    __syncthreads();
#ifndef NO_CMP
    for (int u = nb - 1 - bid; u < 32; u += nb) cmp_unit(u, l, in, ws, lds, g_wv);
#endif
    PSTAMP(45, 255);
    __syncthreads();
#ifndef NO_DELTA
    { int tid_ = TIDX; asm volatile("" : "+v"(tid_)); LAS int* slot = (LAS int*)(lds + LDS_MISC + 64);
      for (;;) {
          __syncthreads();
          if (tid_ == 0) *slot = (int)__hip_atomic_fetch_add(dq, 1u, __ATOMIC_RELAXED, __HIP_MEMORY_SCOPE_AGENT);
          __syncthreads();
          const int g = *slot; if (g >= 128) break;
          ml_delta_wave(g * 8 + (tid_ >> 6), l, in, ws, lds + (tid_ >> 6) * 16384, tid_ & 63);
      } }
#endif
    __syncthreads(); PSTAMP(43, 0);
}
#define CHK_TOL(st) (((st) & 15) == 8 ? 1e-2f : 1e-3f)
#define CHECK_REST
constexpr int VTP = 192;
typedef short v4i16_t __attribute__((ext_vector_type(4)));
__device__ __forceinline__ int vt_lane_off(int lane) { return (4 * (lane >> 5) + ((lane & 15) >> 2)) * VTP + ((((lane >> 4) & 1) * 16) + 4 * (lane & 3)) * 2; }
__device__ __forceinline__ bf16x8 vt_frag(const LAS unsigned char* Vt, int voff, int s4, int eb) {
    const LAS unsigned char* a = Vt + voff + 16 * s4 * VTP + 64 * eb;
    const v4i16_t lo = __builtin_amdgcn_ds_read_tr16_b64_v4i16((LAS v4i16_t*)a), hi = __builtin_amdgcn_ds_read_tr16_b64_v4i16((LAS v4i16_t*)(a + 8 * VTP));
    return (bf16x8){lo[0], lo[1], lo[2], lo[3], hi[0], hi[1], hi[2], hi[3]};
}
__device__ __forceinline__ int crow(int reg, int h) { return (reg & 3) + 8 * (reg >> 2) + 4 * h; }
struct AttnState { f32x16 o[2]; float m, l; };
__device__ __forceinline__ void attn_reset(AttnState& A) { A.m = -1e30f; A.l = 0.f;
#pragma unroll
    for (int i = 0; i < 16; ++i) { A.o[0][i] = 0.f; A.o[1][i] = 0.f; } }

template <int DK>
__device__ __forceinline__ void attn_scores(f32x16 (&s)[2], const bf16x8 (&qf)[DK / 16], const LAS unsigned char* Kt, int r, int h) {
    constexpr int KP = 2 * DK + 16, NK = DK / 16;
    bf16x8 kf[2][NK];
#pragma unroll
    for (int kb = 0; kb < 2; ++kb)
#pragma unroll
        for (int ks = 0; ks < NK; ++ks) kf[kb][ks] = *(const LAS bf16x8*)(Kt + (32 * kb + r) * KP + (16 * ks + 8 * h) * 2);
    __builtin_amdgcn_sched_barrier(0);
#pragma unroll
    for (int kb = 0; kb < 2; ++kb) {
#pragma unroll
        for (int i = 0; i < 16; ++i) s[kb][i] = 0.f;
#pragma unroll
        for (int ks = 0; ks < NK; ++ks) s[kb] = MFMA32(kf[kb][ks], qf[ks], s[kb]);
    }
}
__device__ __forceinline__ float max3f(float a, float b, float c) { return fmaxf(fmaxf(a, b), c); }
__device__ __forceinline__ void attn_softmax_pv(AttnState& A, f32x16 (&s)[2], const LAS unsigned char* Vt, int r, int h, float bias_c = 0.f, bool lane_ok = true) {
    constexpr float THR = 8.f; const int voff = vt_lane_off(r + 32 * h);
    float mx = max3f(s[0][0], s[0][1], s[0][2]);
#pragma unroll
    for (int i = 3; i < 15; i += 2) mx = max3f(mx, s[0][i], s[0][i + 1]);
    mx = max3f(mx, s[0][15], s[1][0]);
#pragma unroll
    for (int i = 1; i < 15; i += 2) mx = max3f(mx, s[1][i], s[1][i + 1]);
    mx = fmaxf(mx, s[1][15]);
    mx = fmaxf(mx, __shfl_xor(mx, 32));
    const float mxb = (lane_ok && mx > -1e29f) ? mx + bias_c : -1e30f;
    const bool grow = mxb > A.m + THR;
    const float mnew = grow ? mxb : A.m;
    if (__any(grow)) {
        const float alpha = __builtin_amdgcn_exp2f(A.m - mnew);
        A.l *= alpha;
#pragma unroll
        for (int i = 0; i < 16; ++i) { A.o[0][i] *= alpha; A.o[1][i] *= alpha; }
    }
    A.m = mnew;
    const float sub = (lane_ok && mnew > -1e29f) ? mnew - bias_c : 1e30f;
    float rs = 0.f;
#pragma unroll
    for (int kb = 0; kb < 2; ++kb)
#pragma unroll
        for (int i = 0; i < 16; ++i) { const float p = __builtin_amdgcn_exp2f(s[kb][i] - sub); s[kb][i] = p; rs += p; }
    rs += __shfl_xor(rs, 32);
    A.l += rs;
    bf16x8 vf[4][2];
#pragma unroll
    for (int s4 = 0; s4 < 4; ++s4)
#pragma unroll
        for (int eb = 0; eb < 2; ++eb) vf[s4][eb] = vt_frag(Vt, voff, s4, eb);
    __builtin_amdgcn_sched_barrier(0);
#pragma unroll
    for (int s4 = 0; s4 < 4; ++s4) {
        const int kb = s4 >> 1, hf = (s4 & 1) * 8;
        u32x4 pw; pw.x = pk_bf16(s[kb][hf + 0], s[kb][hf + 1]); pw.y = pk_bf16(s[kb][hf + 2], s[kb][hf + 3]); pw.z = pk_bf16(s[kb][hf + 4], s[kb][hf + 5]); pw.w = pk_bf16(s[kb][hf + 6], s[kb][hf + 7]);
        const bf16x8 pf = __builtin_bit_cast(bf16x8, pw);
#pragma unroll
        for (int eb = 0; eb < 2; ++eb) A.o[eb] = MFMA32(vf[s4][eb], pf, A.o[eb]);
    }
}
template <int DK>
__device__ __forceinline__ void stage_k_load(u32x4 (&kr)[2], const bf16_t* Kg  , int tid) {
    constexpr int CH = DK / 8;
    kr[0] = *(const u32x4*)(Kg + (size_t)(tid / CH) * DK + (tid % CH) * 8);
    if (64 * CH > 512) { const int c2 = tid + 512; if (c2 < 64 * CH) kr[1] = *(const u32x4*)(Kg + (size_t)(c2 / CH) * DK + (c2 % CH) * 8); }
}
template <int DK>
__device__ __forceinline__ void stage_k_store(const u32x4 (&kr)[2], LAS unsigned char* Kt, int tid) {
    constexpr int CH = DK / 8, KP = 2 * DK + 16;
    *(LAS u32x4*)(Kt + (tid / CH) * KP + (tid % CH) * 16) = kr[0];
    if (64 * CH > 512) { const int c2 = tid + 512; if (c2 < 64 * CH) *(LAS u32x4*)(Kt + (c2 / CH) * KP + (c2 % CH) * 16) = kr[1]; }
}
__device__ __forceinline__ u32x4 stage_v_load(const bf16_t* Vg, int tid) { return *(const u32x4*)(Vg + (size_t)(tid >> 3) * 64 + (tid & 7) * 8); }
__device__ __forceinline__ void stage_v_store(const u32x4& v, LAS unsigned char* Vt, int tid) { *(LAS u32x4*)(Vt + (tid >> 3) * VTP + (tid & 7) * 16) = v; }

constexpr int MLA_KT = 0, MLA_VT = 2 * 64 * 208, MLA_LDS = MLA_VT + 2 * 64 * VTP;
__device__ __forceinline__ void mla_unit(int b, int hd, int qt, int l, unsigned char* ws, LAS unsigned char* lds, int g_wv) {
    int tid_ = TIDX; asm volatile("" : "+v"(tid_));
    const int tid = tid_, w = tid >> 6, lane = tid & 63, r = lane & 31, h = lane >> 5;
    const size_t slab = (size_t)(b * 6 + hd) * 2048;
    const bf16_t* QM = (const bf16_t*)(ws + WS_MLA) + slab * 96; const bf16_t* KM = (const bf16_t*)(ws + WS_MLA + MLA_KM) + slab * 96; const bf16_t* VM = (const bf16_t*)(ws + WS_MLA + MLA_VM) + slab * 64;
    const int q0 = 256 * qt + 32 * w, q = q0 + r;
    bf16x8 qf[6];
#pragma unroll
    for (int ks = 0; ks < 6; ++ks) qf[ks] = *(const bf16x8*)(QM + (size_t)q * 96 + 16 * ks + 8 * h);
    AttnState A; attn_reset(A);
    const int ntile = 4 * qt + 4;
    u32x4 kr[2], vr, kr2[2], vr2;
    stage_k_load<96>(kr, KM, tid); vr = stage_v_load(VM, tid);
    stage_k_store<96>(kr, lds + MLA_KT, tid); stage_v_store(vr, lds + MLA_VT, tid);
    if (ntile > 1) { stage_k_load<96>(kr, KM + (size_t)64 * 96, tid); vr = stage_v_load(VM + (size_t)64 * 64, tid); }
    __syncthreads();
    for (int j = 0; j < ntile; ++j) {
        const int cur = j & 1;
        if (j + 2 < ntile) { stage_k_load<96>(kr2, KM + (size_t)(j + 2) * 64 * 96, tid); vr2 = stage_v_load(VM + (size_t)(j + 2) * 64 * 64, tid); }
        if (64 * j <= q0 + 31) {
            f32x16 s[2];
            attn_scores<96>(s, qf, lds + MLA_KT + cur * 64 * 208, r, h);
            if (64 * j + 63 > q0) {
#pragma unroll
                for (int kb = 0; kb < 2; ++kb)
#pragma unroll
                    for (int i = 0; i < 16; ++i) { const int key = 64 * j + 32 * kb + crow(i, h); if (key > q) s[kb][i] = -1e30f; }
            }
            attn_softmax_pv(A, s, lds + MLA_VT + cur * 64 * VTP, r, h);
        }
        if (j + 1 < ntile) { stage_k_store<96>(kr, lds + MLA_KT + (cur ^ 1) * 64 * 208, tid); stage_v_store(vr, lds + MLA_VT + (cur ^ 1) * 64 * VTP, tid); }
        kr[0] = kr2[0]; kr[1] = kr2[1]; vr = vr2;
        __syncthreads();
    }
    const float inv = A.l > 0.f ? 1.f / A.l : 0.f; float ss = 0.f;
    bf16_t* Y = (bf16_t*)(ws + WS_Y) + ((size_t)b * 2048 + q) * 1024 + 384 + hd * 64;
#pragma unroll
    for (int eb = 0; eb < 2; ++eb)
#pragma unroll
        for (int g4 = 0; g4 < 4; ++g4) {
            const float v0 = A.o[eb][4 * g4] * inv, v1 = A.o[eb][4 * g4 + 1] * inv, v2 = A.o[eb][4 * g4 + 2] * inv, v3 = A.o[eb][4 * g4 + 3] * inv;
            u32x2 pw; pw.x = pk_bf16(v0, v1); pw.y = pk_bf16(v2, v3);
            const float f0 = bf_lo(pw.x), f1 = bf_hi(pw.x), f2 = bf_lo(pw.y), f3 = bf_hi(pw.y); ss += (f0 * f0 + f1 * f1) + (f2 * f2 + f3 * f3);
            *(u32x2*)(Y + 32 * eb + 8 * g4 + 4 * h) = pw;
        }
    ss += __shfl_xor(ss, 32);
    if (h == 0) ((float*)(ws + WS_SSQ + PT_C))[((size_t)l * 16384 + (size_t)b * 2048 + q) * 8 + hd] = ss;
}

__device__ __forceinline__ void nsa_bias32(float (&bv)[2][16], const LAS float* bl, int dd) {
#pragma unroll
    for (int kb = 0; kb < 2; ++kb)
#pragma unroll
        for (int k = 0; k < 16; ++k) { const int c = 63 - (32 * kb + (k & 3) + 8 * (k >> 2)); int d = dd + c; d = d < 0 ? 0 : (d > 255 ? 255 : d); bv[kb][k] = bl[d]; }
}
__device__ __forceinline__ void nsa_mask_bias(f32x16 (&sc)[2], int dq, int h, const LAS float* bl, bool sel, int lim) {
    int dd = dq - 4 * h - 63; asm volatile("" : "+v"(dd));
    float bv[2][16]; nsa_bias32(bv, bl, dd);
#pragma unroll
    for (int kb = 0; kb < 2; ++kb)
#pragma unroll
        for (int k = 0; k < 16; ++k) { const int c = 63 - (32 * kb + (k & 3) + 8 * (k >> 2)); const int d = dd + c; sc[kb][k] = (sel && d >= 0 && d < lim) ? sc[kb][k] + bv[kb][k] : -1e30f; }
}

constexpr int NSA_KT = 0, NSA_VT = 2 * 64 * 144, NSA_BIAS = NSA_VT + 2 * 64 * VTP, NSA_PS = NSA_BIAS + 3 * 256 * 4, NSA_SEL = NSA_PS + 3 * 64 * 32 * 4, NSA_UNI = NSA_SEL + 256, NSA_OT = NSA_UNI + 256, NSA_LDS = NSA_OT + 6 * 8192;
__device__ __forceinline__ void nsa_unit(int b, int hk, int i, int l, InPtr in, unsigned char* ws, LAS unsigned char* lds, int g_wv) {
    int tid_ = TIDX; asm volatile("" : "+v"(tid_));
    const int tid = tid_, w = tid >> 6, lane = tid & 63, r = lane & 31, h = lane >> 5;
    const bool active = w < 6; const int g = active ? (w >> 1) : 0, th = w & 1, head = hk * 3 + g;
    const int t = 64 * i + 32 * th + r, tl = 32 * th + r; const size_t row = (size_t)b * 2048 + t;
    const size_t kvslab = (size_t)(b * 2 + hk) * 2048 * 64;
    LAS float* biasl = (LAS float*)(lds + NSA_BIAS); LAS float* PS = (LAS float*)(lds + NSA_PS); LAS unsigned* SEL = (LAS unsigned*)(lds + NSA_SEL); LAS unsigned* UNI = (LAS unsigned*)(lds + NSA_UNI);
    { const float* bd = (const float*)(ws + WS_BIASD) + (size_t)hk * 3 * 2048;
      if (tid < 384) { const int gg = tid >> 7, d0 = (tid & 127) * 2; biasl[gg * 256 + d0] = bd[gg * 2048 + d0]; biasl[gg * 256 + d0 + 1] = bd[gg * 2048 + d0 + 1]; }
#pragma unroll
      for (int k = 0; k < 12; ++k) if (i >= 16) PS[tid + 512 * k] = 0.f;
      if (tid < 4) UNI[tid] = 0u; }
    bf16x8 qf[4];
    { const bf16_t* QN = (const bf16_t*)(ws + WS_PRJ + PRJ_QN) + ((size_t)(b * 6 + head) * 2048 + t) * 64;
#pragma unroll
      for (int ks = 0; ks < 4; ++ks) qf[ks] = *(const bf16x8*)(QN + 16 * ks + 8 * h); }
#define NSA_GATE(k) ({ int t_ = t; asm volatile("" : "+v"(t_)); sigmf(((const float*)(ws + WS_PRJ + PRJ_GATES))[((size_t)b * 2048 + t_) * 32 + head * 3 + (k)]); })
    LAS float* bl = biasl + g * 256;
    LAS float* otl = (LAS float*)(lds + NSA_OT + (active ? w : 0) * 8192) + lane;
    u32x4 kr[2], vr;
    const int ntc = i >= 16 ? 2 : 1;
    { const bf16_t* KC = (const bf16_t*)(ws + WS_CMP) + (size_t)(b * 2 + hk) * 128 * 64; const bf16_t* VC = (const bf16_t*)(ws + WS_CMP + CMP_V) + (size_t)(b * 2 + hk) * 128 * 64;
      for (int T = 0; T < ntc; ++T) { stage_k_load<64>(kr, KC + T * 4096, tid); vr = stage_v_load(VC + T * 4096, tid); stage_k_store<64>(kr, lds + NSA_KT + T * 64 * 144, tid); stage_v_store(vr, lds + NSA_VT + T * 64 * VTP, tid); } }
    __syncthreads();
    {
        f32x16 ot[2];
        if (active && i < 16) {
            AttnState A; attn_reset(A); f32x16 sc[2]; attn_scores<64>(sc, qf, lds + NSA_KT, r, h);
            float bvc[2][16];
#pragma unroll
            for (int kb = 0; kb < 2; ++kb)
#pragma unroll
                for (int k = 0; k < 16; ++k) { int d = t - 16 * (32 * kb + crow(k, h)) - 31; d = d < 0 ? 0 : (d > 255 ? 255 : d); bvc[kb][k] = bl[d]; }
#pragma unroll
            for (int kb = 0; kb < 2; ++kb)
#pragma unroll
                for (int k = 0; k < 16; ++k) { const int d = t - 16 * (32 * kb + crow(k, h)) - 31; sc[kb][k] = d >= 0 ? sc[kb][k] + bvc[kb][k] : -1e30f; }
            attn_softmax_pv(A, sc, lds + NSA_VT, r, h);
            const float gc = NSA_GATE(0); const float inv = A.l > 0.f ? gc / A.l : 0.f;
#pragma unroll
            for (int k = 0; k < 16; ++k) { otl[64 * k] = A.o[0][k] * inv; otl[64 * (16 + k)] = A.o[1][k] * inv; }
        } else if (active) {
            float m = -1e30f, lsum = 0.f;
            for (int T = 0; T < ntc; ++T) {
                f32x16 sc[2]; attn_scores<64>(sc, qf, lds + NSA_KT + T * 64 * 144, r, h);
                float bvc[2][16];
#pragma unroll
                for (int kb = 0; kb < 2; ++kb)
#pragma unroll
                    for (int k = 0; k < 16; ++k) { int d = t - 16 * (64 * T + 32 * kb + crow(k, h)) - 31; d = d < 0 ? 0 : (d > 255 ? 255 : d); bvc[kb][k] = bl[d]; }
                float mx = -1e30f;
#pragma unroll
                for (int kb = 0; kb < 2; ++kb)
#pragma unroll
                    for (int k = 0; k < 16; ++k) { const int n = 64 * T + 32 * kb + crow(k, h); const int d = t - 16 * n - 31; const float x = (d >= 0 && n < 127) ? sc[kb][k] + bvc[kb][k] : -1e30f; sc[kb][k] = x; mx = fmaxf(mx, x); }
                mx = fmaxf(mx, __shfl_xor(mx, 32));
                const float mnew = fmaxf(m, mx), mref = mnew <= -1e29f ? 0.f : mnew; float rs = 0.f;
#pragma unroll
                for (int kb = 0; kb < 2; ++kb)
#pragma unroll
                    for (int k = 0; k < 16; ++k) rs += __builtin_amdgcn_exp2f(sc[kb][k] - mref);
                rs += __shfl_xor(rs, 32);
                lsum = lsum * __builtin_amdgcn_exp2f(m - mref) + rs; m = mnew;
            }
            const float mref = m <= -1e29f ? 0.f : m, inv = lsum > 0.f ? 1.f / lsum : 0.f;
#pragma unroll
            for (int k = 0; k < 16; ++k) { ot[0][k] = 0.f; ot[1][k] = 0.f; }
            float carry = 0.f;
            for (int T = 0; T < ntc; ++T) {
                f32x16 sc[2]; attn_scores<64>(sc, qf, lds + NSA_KT + T * 64 * 144, r, h);
                float bvc[2][16];
#pragma unroll
                for (int kb = 0; kb < 2; ++kb)
#pragma unroll
                    for (int k = 0; k < 16; ++k) { int d = t - 16 * (64 * T + 32 * kb + crow(k, h)) - 31; d = d < 0 ? 0 : (d > 255 ? 255 : d); bvc[kb][k] = bl[d]; }
#pragma unroll
                for (int kb = 0; kb < 2; ++kb)
#pragma unroll
                    for (int k = 0; k < 16; ++k) { const int n = 64 * T + 32 * kb + crow(k, h); const int d = t - 16 * n - 31; sc[kb][k] = (d >= 0 && n < 127) ? __builtin_amdgcn_exp2f(sc[kb][k] + bvc[kb][k] - mref) * inv : 0.f; }
                float prevL = carry;
#pragma unroll
                for (int kb = 0; kb < 2; ++kb)
#pragma unroll
                    for (int g4 = 0; g4 < 4; ++g4) {
                        const float G4 = (sc[kb][4 * g4] + sc[kb][4 * g4 + 1]) + (sc[kb][4 * g4 + 2] + sc[kb][4 * g4 + 3]); const float L = sc[kb][4 * g4 + 3];
                        const float Lo = __shfl_xor(L, 32);
                        const float add = h ? Lo : prevL;
                        prevL = Lo;
                        const int idx = T * 8 + kb * 4 + g4;
                        PS[g * 2048 + tl * 32 + 2 * idx + h] = G4 + add;
                    }
                carry = prevL;
#pragma unroll
                for (int s4 = 0; s4 < 4; ++s4) {
                    const int kb = s4 >> 1, hf = (s4 & 1) * 8;
                    u32x4 pw; pw.x = pk_bf16(sc[kb][hf + 0], sc[kb][hf + 1]); pw.y = pk_bf16(sc[kb][hf + 2], sc[kb][hf + 3]); pw.z = pk_bf16(sc[kb][hf + 4], sc[kb][hf + 5]); pw.w = pk_bf16(sc[kb][hf + 6], sc[kb][hf + 7]);
                    const bf16x8 pf = __builtin_bit_cast(bf16x8, pw);
#pragma unroll
                    for (int eb = 0; eb < 2; ++eb) ot[eb] = MFMA32(vt_frag(lds + NSA_VT + T * 64 * VTP, vt_lane_off(lane), s4, eb), pf, ot[eb]);
                }
            }
            { const float gc = NSA_GATE(0);
#pragma unroll
            for (int k = 0; k < 16; ++k) { otl[64 * k] = ot[0][k] * gc; otl[64 * (16 + k)] = ot[1][k] * gc; } }
        }
    }
    __syncthreads();
#ifndef NO_NSA_SEL
    if (i < 16) { if (tid < 64) SEL[tid] = (2u << i) - 1u; if (tid < 3) UNI[tid] = (2u << i) - 1u; }
    else {
        const int tk = tid >> 3, sg = tid & 7; float v[32];
#pragma unroll
        for (int k = 0; k < 8; ++k) { const f32x4 x0 = *(const LAS f32x4*)(PS + tk * 32 + 4 * k), x1 = *(const LAS f32x4*)(PS + 2048 + tk * 32 + 4 * k), x2 = *(const LAS f32x4*)(PS + 4096 + tk * 32 + 4 * k);
            v[4 * k] = (x0.x + x1.x) + x2.x; v[4 * k + 1] = (x0.y + x1.y) + x2.y; v[4 * k + 2] = (x0.z + x1.z) + x2.z; v[4 * k + 3] = (x0.w + x1.w) + x2.w; }
#pragma unroll
        for (int s = 0; s < 32; ++s) { const bool forced = (s == 0) || (s == i) || (s == i - 1); float x = forced ? v[s] + 1e4f : v[s]; v[s] = s > i ? -1.f : x; }
        unsigned bits = 0u;
#pragma unroll
        for (int k = 0; k < 4; ++k) {
            float x = 0.f;
#pragma unroll
            for (int s = 0; s < 32; ++s) x = (s == 4 * sg + k) ? v[s] : x;
            int rank = 0;
#pragma unroll
            for (int s = 0; s < 32; ++s) rank += (v[s] > x || (v[s] == x && s < 4 * sg + k)) ? 1 : 0;
            if (rank < 16 && x >= 0.f) bits |= 1u << (4 * sg + k);
        }
        bits |= __shfl_xor(bits, 1); bits |= __shfl_xor(bits, 2); bits |= __shfl_xor(bits, 4);
        if (sg == 0) { SEL[tk] = bits; __hip_atomic_fetch_or(UNI, bits, __ATOMIC_RELAXED, __HIP_MEMORY_SCOPE_WORKGROUP); __hip_atomic_fetch_or(UNI + 1 + (tk >> 5), bits, __ATOMIC_RELAXED, __HIP_MEMORY_SCOPE_WORKGROUP); }
    }
#endif
    __syncthreads();
    const unsigned selbits = SEL[tl], uni = UNI[0], unih = UNI[1 + th];
    const float c31 = bl[255];
#ifndef NO_NSA_SLC
#ifndef NSA_DUP_SLC
#define NSA_DUP_SLC 1
#endif
    for (int rp_ = 0; rp_ < NSA_DUP_SLC; ++rp_) {
        AttnState A; attn_reset(A);
        const bf16_t* KS = (const bf16_t*)(ws + WS_PRJ + PRJ_KN1) + kvslab; const bf16_t* VS = (const bf16_t*)(ws + WS_PRJ + PRJ_VN1) + kvslab;
        unsigned todo = uni; int cur = 0; u32x4 kr2[2], vr2;
        int s = __ffs(todo) - 1; todo &= todo - 1;
        stage_k_load<64>(kr, KS + (size_t)s * 4096, tid); vr = stage_v_load(VS + (size_t)s * 4096, tid);
        stage_k_store<64>(kr, lds + NSA_KT, tid); stage_v_store(vr, lds + NSA_VT, tid);
        int sn = todo ? __ffs(todo) - 1 : -1; todo &= todo - 1;
        if (sn >= 0) { stage_k_load<64>(kr, KS + (size_t)sn * 4096, tid); vr = stage_v_load(VS + (size_t)sn * 4096, tid); }
        __syncthreads();
        while (s >= 0) {
            const int sn2 = todo ? __ffs(todo) - 1 : -1; todo &= todo - 1;
            if (sn2 >= 0) { stage_k_load<64>(kr2, KS + (size_t)sn2 * 4096, tid); vr2 = stage_v_load(VS + (size_t)sn2 * 4096, tid); }
            if (active && ((unih >> s) & 1u)) {
                f32x16 sc[2];
                attn_scores<64>(sc, qf, lds + NSA_KT + cur * 64 * 144, r, h);
                const bool sel = (selbits >> s) & 1u;
                if (i - s >= 3) attn_softmax_pv(A, sc, lds + NSA_VT + cur * 64 * VTP, r, h, c31, sel);
                else { nsa_mask_bias(sc, t - 64 * s, h, bl, sel, 4096); attn_softmax_pv(A, sc, lds + NSA_VT + cur * 64 * VTP, r, h); }
            }
            if (sn >= 0) { stage_k_store<64>(kr, lds + NSA_KT + (cur ^ 1) * 64 * 144, tid); stage_v_store(vr, lds + NSA_VT + (cur ^ 1) * 64 * VTP, tid); }
            kr[0] = kr2[0]; vr = vr2;
            __syncthreads();
            s = sn; sn = sn2; cur ^= 1;
        }
        if (active && rp_ == NSA_DUP_SLC - 1) { const float gs = NSA_GATE(1); const float inv = A.l > 0.f ? gs / A.l : 0.f;
#pragma unroll
            for (int k = 0; k < 16; ++k) { otl[64 * k] += A.o[0][k] * inv; otl[64 * (16 + k)] += A.o[1][k] * inv; } }
    }
#endif
#ifndef NO_NSA_WIN
#ifndef NSA_DUP_WIN
#define NSA_DUP_WIN 1
#endif
    for (int rq_ = 0; rq_ < NSA_DUP_WIN; ++rq_) {
        AttnState A; attn_reset(A);
        const bf16_t* KW = (const bf16_t*)(ws + WS_PRJ + PRJ_KN2) + kvslab; const bf16_t* VW = (const bf16_t*)(ws + WS_PRJ + PRJ_VN2) + kvslab;
        const int j0 = i > 8 ? i - 8 : 0; int cur = 0; u32x4 kr2[2], vr2;
        stage_k_load<64>(kr, KW + (size_t)j0 * 4096, tid); vr = stage_v_load(VW + (size_t)j0 * 4096, tid);
        stage_k_store<64>(kr, lds + NSA_KT, tid); stage_v_store(vr, lds + NSA_VT, tid);
        if (j0 < i) { stage_k_load<64>(kr, KW + (size_t)(j0 + 1) * 4096, tid); vr = stage_v_load(VW + (size_t)(j0 + 1) * 4096, tid); }
        __syncthreads();
        for (int j = j0; j <= i; ++j) {
            if (j + 2 <= i) { stage_k_load<64>(kr2, KW + (size_t)(j + 2) * 4096, tid); vr2 = stage_v_load(VW + (size_t)(j + 2) * 4096, tid); }
            if (active) {
                f32x16 sc[2];
                attn_scores<64>(sc, qf, lds + NSA_KT + cur * 64 * 144, r, h);
                if (i - j >= 3 && j > i - 8) attn_softmax_pv(A, sc, lds + NSA_VT + cur * 64 * VTP, r, h, c31, true);
                else { nsa_mask_bias(sc, t - 64 * j, h, bl, true, 512); attn_softmax_pv(A, sc, lds + NSA_VT + cur * 64 * VTP, r, h); }
            }
            if (j < i) { stage_k_store<64>(kr, lds + NSA_KT + (cur ^ 1) * 64 * 144, tid); stage_v_store(vr, lds + NSA_VT + (cur ^ 1) * 64 * VTP, tid); }
            kr[0] = kr2[0]; vr = vr2;
            __syncthreads();
            cur ^= 1;
        }
        if (active && rq_ == NSA_DUP_WIN - 1) { const float gw = NSA_GATE(2); const float inv = A.l > 0.f ? gw / A.l : 0.f;
            float ss = 0.f; bf16_t* Y = (bf16_t*)(ws + WS_Y) + row * 1024 + head * 64;
#pragma unroll
            for (int eb = 0; eb < 2; ++eb)
#pragma unroll
                for (int g4 = 0; g4 < 4; ++g4) {
                    const float v0 = otl[64 * (16 * eb + 4 * g4)] + A.o[eb][4 * g4] * inv, v1 = otl[64 * (16 * eb + 4 * g4 + 1)] + A.o[eb][4 * g4 + 1] * inv;
                    const float v2 = otl[64 * (16 * eb + 4 * g4 + 2)] + A.o[eb][4 * g4 + 2] * inv, v3 = otl[64 * (16 * eb + 4 * g4 + 3)] + A.o[eb][4 * g4 + 3] * inv;
                    u32x2 pw; pw.x = pk_bf16(v0, v1); pw.y = pk_bf16(v2, v3);
                    const float f0 = bf_lo(pw.x), f1 = bf_hi(pw.x), f2 = bf_lo(pw.y), f3 = bf_hi(pw.y); ss += (f0 * f0 + f1 * f1) + (f2 * f2 + f3 * f3);
                    *(u32x2*)(Y + 32 * eb + 8 * g4 + 4 * h) = pw;
                }
            ss += __shfl_xor(ss, 32);
            if (h == 0) ((float*)(ws + WS_SSQ + PT_A))[((size_t)l * 16384 + row) * 8 + head] = ss;
        }
    }
#endif
}

__device__ __forceinline__ void ml_out_wave(int cu, int l, InPtr in, unsigned char* ws, LAS unsigned char* wl, LAS unsigned char* npl, int lane) {
    const int c = cu & 31, bh = cu >> 5, hd = bh & 3, b = bh >> 2; const int t0 = c * 64; const int r = lane & 15, q = lane >> 4;
    const bf16_t* QC = (const bf16_t*)(ws + WS_ML) + ((size_t)bh * 2048 + t0) * 64; const bf16_t* KC = (const bf16_t*)(ws + WS_ML + ML_KC) + ((size_t)bh * 2048 + t0) * 64;
    const bf16_t* V = (const bf16_t*)(ws + WS_PRJ + PRJ_VML) + ((size_t)bh * 2048 + t0) * 64;
    const float* mlg = (const float*)(ws + WS_ML + ML_G) + ((size_t)bh * 2048 + t0) * 2;
    const bf16_t* CP = (const bf16_t*)(ws + WS_ML + ML_CP) + (size_t)cu * 4096; const bf16_t* NP = (const bf16_t*)(ws + WS_ML + ML_NP) + (size_t)cu * 64;
    bf16x8 aq[4][2];
#pragma unroll
    for (int mb = 0; mb < 4; ++mb)
#pragma unroll
        for (int ks = 0; ks < 2; ++ks) aq[mb][ks] = *(const bf16x8*)(QC + (size_t)(16 * mb + r) * 64 + 32 * ks + 8 * q);
    float bj[4][4], den[4][4];
#pragma unroll
    for (int mb = 0; mb < 4; ++mb)
#pragma unroll
        for (int j = 0; j < 4; ++j) bj[mb][j] = mlg[(16 * mb + 4 * q + j) * 2];
    {
        float cs[4];
#pragma unroll
        for (int nb = 0; nb < 4; ++nb) { const float2 gg = *(const float2*)(mlg + (16 * nb + r) * 2); cs[nb] = gg.y - gg.x; }
#pragma unroll
        for (int mb = 0; mb < 4; ++mb) {
            f32x4 accS[4];
#pragma unroll
            for (int nb = 0; nb < 4; ++nb) { accS[nb] = (f32x4){0.f, 0.f, 0.f, 0.f};
#pragma unroll
                for (int ks = 0; ks < 2; ++ks) { const bf16x8 bk = *(const bf16x8*)(KC + (size_t)(16 * nb + r) * 64 + 32 * ks + 8 * q); accS[nb] = MFMA16(aq[mb][ks], bk, accS[nb]); } }
#pragma unroll
            for (int j = 0; j < 4; ++j) {
                const int jj = 16 * mb + 4 * q + j; float rs = 0.f;
#pragma unroll
                for (int nb = 0; nb < 4; ++nb) { const int s = 16 * nb + r; const float p = s <= jj ? accS[nb][j] * __expf(bj[mb][j] + cs[nb]) : 0.f; rs += p;
                    *(LAS bf16_t*)(wl + 8192 + swz_off(jj, s >> 3) + (s & 7) * 2) = f2bf(p); }
                rs += __shfl_xor(rs, 1); rs += __shfl_xor(rs, 2); rs += __shfl_xor(rs, 4); rs += __shfl_xor(rs, 8);
                den[mb][j] = rs;
            }
        }
    }
#pragma unroll
    for (int mb = 0; mb < 4; ++mb) { const float e = __expf(mlg[(16 * mb + r) * 2]);
#pragma unroll
        for (int ks = 0; ks < 2; ++ks) { const u32x4 x = __builtin_bit_cast(u32x4, aq[mb][ks]); u32x4 y;
            y.x = pk_bf16(bf_lo(x.x) * e, bf_hi(x.x) * e); y.y = pk_bf16(bf_lo(x.y) * e, bf_hi(x.y) * e); y.z = pk_bf16(bf_lo(x.z) * e, bf_hi(x.z) * e); y.w = pk_bf16(bf_lo(x.w) * e, bf_hi(x.w) * e);
            aq[mb][ks] = __builtin_bit_cast(bf16x8, y); } }
    f32x4 acc[4][4], accn[4];
#pragma unroll
    for (int mb = 0; mb < 4; ++mb) { accn[mb] = (f32x4){0.f, 0.f, 0.f, 0.f};
#pragma unroll
        for (int nb = 0; nb < 4; ++nb) acc[mb][nb] = (f32x4){0.f, 0.f, 0.f, 0.f}; }
#pragma unroll
    for (int ks = 0; ks < 2; ++ks) {
        u32x4 nz = *(const u32x4*)(NP + 32 * ks + 8 * q); if (r != 0) nz = (u32x4){0u, 0u, 0u, 0u};
        const bf16x8 bn = __builtin_bit_cast(bf16x8, nz);
#pragma unroll
        for (int nb = 0; nb < 4; ++nb) { const bf16x8 bb = *(const bf16x8*)(CP + (size_t)(16 * nb + r) * 64 + 32 * ks + 8 * q);
#pragma unroll
            for (int mb = 0; mb < 4; ++mb) acc[mb][nb] = MFMA16(aq[mb][ks], bb, acc[mb][nb]); }
#pragma unroll
        for (int mb = 0; mb < 4; ++mb) accn[mb] = MFMA16(aq[mb][ks], bn, accn[mb]);
    }
#pragma unroll
    for (int s8 = 0; s8 < 8; ++s8) { float vb[8];
#pragma unroll
        for (int j = 0; j < 8; ++j) vb[j] = bf2f(V[(size_t)(s8 * 8 + j) * 64 + lane]);
        u32x4 pk; pk.x = pk_bf16(vb[0], vb[1]); pk.y = pk_bf16(vb[2], vb[3]); pk.z = pk_bf16(vb[4], vb[5]); pk.w = pk_bf16(vb[6], vb[7]);
        *(LAS u32x4*)(wl + swz_off(lane, s8)) = pk; }
    LDS_FENCE();
#pragma unroll
    for (int ks = 0; ks < 2; ++ks) {
        bf16x8 ap[4];
#pragma unroll
        for (int mb = 0; mb < 4; ++mb) ap[mb] = *(const LAS bf16x8*)(wl + 8192 + swz_off(16 * mb + r, 4 * ks + q));
#pragma unroll
        for (int nb = 0; nb < 4; ++nb) { const bf16x8 bv = *(const LAS bf16x8*)(wl + swz_off(16 * nb + r, 4 * ks + q));
#pragma unroll
            for (int mb = 0; mb < 4; ++mb) acc[mb][nb] = MFMA16(ap[mb], bv, acc[mb][nb]); }
    }
    LDS_FENCE();
    const float* gain = in->p[14] + l * 256 + hd * 64; const bf16_t* OG = (const bf16_t*)(ws + WS_PRJ + PRJ_OG);
    bf16_t* Y = (bf16_t*)(ws + WS_Y);
#pragma unroll
    for (int mb = 0; mb < 4; ++mb)
#pragma unroll
        for (int j = 0; j < 4; ++j) {
            const int jj = 16 * mb + 4 * q + j;
            const float dn = den[mb][j] + __builtin_bit_cast(float, __builtin_amdgcn_ds_bpermute((lane & 48) << 2, __builtin_bit_cast(int, accn[mb][j])));
            const float inv = 1.f / fmaxf(fabsf(dn), 1.f); float hv[4]; float ss = 0.f;
#pragma unroll
            for (int nb = 0; nb < 4; ++nb) { hv[nb] = acc[mb][nb][j] * inv; ss += hv[nb] * hv[nb]; }
            ss += __shfl_xor(ss, 1); ss += __shfl_xor(ss, 2); ss += __shfl_xor(ss, 4); ss += __shfl_xor(ss, 8);
            const float rstd = rsqrtf(ss * (1.f / 64.f) + 1e-6f); const size_t row = (size_t)b * 2048 + t0 + jj;
#pragma unroll
            for (int nb = 0; nb < 4; ++nb) { const int e = 16 * nb + r; Y[row * 1024 + 768 + hd * 64 + e] = f2bf(hv[nb] * rstd * gain[e] * sigmf(bf2f(OG[row * 256 + hd * 64 + e]))); }
        }
}

__device__ __forceinline__ void ml_scan_unit(int bh, int l, unsigned char* ws, int g_wv) {
    int tid_ = TIDX; asm volatile("" : "+v"(tid_)); const int tid = tid_;
    const bf16_t* DL = (const bf16_t*)(ws + WS_ML + ML_DELTA) + (size_t)bh * 32 * 4096 + tid * 8; bf16_t* CP = (bf16_t*)(ws + WS_ML + ML_CP) + (size_t)bh * 32 * 4096 + tid * 8;
    const float* DN = (const float*)(ws + WS_ML + ML_DN) + (size_t)bh * 32 * 64; bf16_t* NP = (bf16_t*)(ws + WS_ML + ML_NP) + (size_t)bh * 32 * 64; const float* BL = (const float*)(ws + WS_ML + ML_BL) + bh * 32;
    float c[8]; float n = 0.f;
#pragma unroll
    for (int k = 0; k < 8; ++k) c[k] = 0.f;
#pragma unroll 1
    for (int c0 = 0; c0 < 32; c0 += 8) {
        u32x4 d[8]; float dn[8], co[8];
#pragma unroll
        for (int k = 0; k < 8; ++k) { d[k] = *(const u32x4*)(DL + (size_t)(c0 + k) * 4096); dn[k] = tid < 64 ? DN[(c0 + k) * 64 + tid] : 0.f; co[k] = __expf(BL[c0 + k]); }
#pragma unroll
        for (int k = 0; k < 8; ++k) {
            u32x4 o; o.x = pk_bf16(c[0], c[1]); o.y = pk_bf16(c[2], c[3]); o.z = pk_bf16(c[4], c[5]); o.w = pk_bf16(c[6], c[7]);
            *(u32x4*)(CP + (size_t)(c0 + k) * 4096) = o; if (tid < 64) NP[(c0 + k) * 64 + tid] = f2bf(n);
            c[0] = co[k] * c[0] + bf_lo(d[k].x); c[1] = co[k] * c[1] + bf_hi(d[k].x); c[2] = co[k] * c[2] + bf_lo(d[k].y); c[3] = co[k] * c[3] + bf_hi(d[k].y);
            c[4] = co[k] * c[4] + bf_lo(d[k].z); c[5] = co[k] * c[5] + bf_hi(d[k].z); c[6] = co[k] * c[6] + bf_lo(d[k].w); c[7] = co[k] * c[7] + bf_hi(d[k].w);
            n = co[k] * n + dn[k];
        }
    }
    asm volatile("s_waitcnt vmcnt(0)" ::: "memory"); __syncthreads();
    if (tid == 0) { __builtin_amdgcn_fence(__ATOMIC_RELEASE, "agent"); asm volatile("s_waitcnt vmcnt(0)" ::: "memory");
        __hip_atomic_fetch_add((unsigned*)(ws + WS_CTL) + CW_SCAN + 64 * l, 1u, __ATOMIC_RELAXED, __HIP_MEMORY_SCOPE_AGENT); }
}
__device__ __forceinline__ void ml_scan_wait(int l, unsigned char* ws, int g_wv) {
    if (TIDX == 0) { unsigned* p = (unsigned*)(ws + WS_CTL) + CW_SCAN + 64 * l; unsigned sp = 0;
        while (__hip_atomic_load(p, __ATOMIC_RELAXED, __HIP_MEMORY_SCOPE_AGENT) < 32u) { __builtin_amdgcn_s_sleep(2); if (++sp > (1u << 22)) break; }
        __builtin_amdgcn_fence(__ATOMIC_ACQUIRE, "agent"); asm volatile("s_waitcnt vmcnt(0)" ::: "memory"); }
    __syncthreads();
}

#ifndef DUP_NSA
#define DUP_NSA 1
#endif
#ifndef DUP_MLA
#define DUP_MLA 1
#endif
#ifndef DUP_ML
#define DUP_ML 1
#endif
#ifdef NO_MLA
#define MLA_CALL(...) do {} while (0)
#else
#define MLA_CALL(...) do { for (int rp = 0; rp < DUP_MLA; ++rp) { if (rp) __syncthreads(); mla_unit(__VA_ARGS__); } } while (0)
#endif
__device__ __forceinline__ void phase_mix(int l, InPtr in, unsigned char* ws, LAS unsigned char* lds, unsigned* qhead, int g_wv) {
    LAS int* slot = (LAS int*)(lds + LDS_MISC + 64);
    for (;;) {
        __syncthreads();
        if (TIDX == 0) *slot = (int)__hip_atomic_fetch_add(qhead, 1u, __ATOMIC_RELAXED, __HIP_MEMORY_SCOPE_AGENT);
        __syncthreads();
        int u = *slot;
        if (u >= 32 + 512 + 384 + 128) break;
        if (u < 32) { ml_scan_unit(u, l, ws, g_wv); continue; } u -= 32;
#ifndef NO_NSA
        if (u < 256) { const int i = 31 - (u >> 4), bh = u & 15; { for (int rp = 0; rp < DUP_NSA; ++rp) { if (rp) __syncthreads(); nsa_unit(bh >> 1, bh & 1, i, l, in, ws, lds, g_wv); } } continue; }
#endif
        u -= 256;
        if (u < 192) { const int qt = 7 - u / 48, bh = u % 48; MLA_CALL(bh / 6, bh % 6, qt, l, ws, lds, g_wv); continue; }
        u -= 192;
#ifndef NO_NSA
        if (u < 128) { const int i = 15 - (u >> 4), bh = u & 15; { for (int rp = 0; rp < DUP_NSA; ++rp) { if (rp) __syncthreads(); nsa_unit(bh >> 1, bh & 1, i, l, in, ws, lds, g_wv); } } continue; }
#endif
        u -= 128;
        if (u < 192) { const int qt = 3 - u / 48, bh = u % 48; MLA_CALL(bh / 6, bh % 6, qt, l, ws, lds, g_wv); continue; } u -= 192;
#ifndef NO_NSA
        if (u < 128) { const int i = 7 - (u >> 4), bh = u & 15; { for (int rp = 0; rp < DUP_NSA; ++rp) { if (rp) __syncthreads(); nsa_unit(bh >> 1, bh & 1, i, l, in, ws, lds, g_wv); } } continue; }
#endif
        u -= 128;
#ifndef NO_MLOUT
        ml_scan_wait(l, ws, g_wv);
        for (int rp = 0; rp < DUP_ML; ++rp) { int tid_ = TIDX; asm volatile("" : "+v"(tid_)); const int w = tid_ >> 6; ml_out_wave(u * 8 + w, l, in, ws, lds + w * 16384, lds + 131072 + w * 256, tid_ & 63); }
#endif
    }
}
__device__ __forceinline__ void phase_ynorm(int l, unsigned char* ws, int bid, int nb, int g_wv) {
    int tid_ = TIDX; asm volatile("" : "+v"(tid_)); const int w = tid_ >> 6, lane = tid_ & 63;
    bf16_t* Y = (bf16_t*)(ws + WS_Y); const float* sa = (const float*)(ws + WS_SSQ + PT_A) + (size_t)l * 16384 * 8; const float* sc = (const float*)(ws + WS_SSQ + PT_C) + (size_t)l * 16384 * 8;
    for (int r0 = (bid * 8 + w) * 8; r0 < NTOK; r0 += nb * 64) {
        if (lane < 48) {
            u32x4 x[8], y[8]; float ra[8], rc[8];
#pragma unroll
            for (int k = 0; k < 8; ++k) { const int row = r0 + k;
                const f32x4 a0 = *(const f32x4*)(sa + (size_t)row * 8), a1 = *(const f32x4*)(sa + (size_t)row * 8 + 4), c0 = *(const f32x4*)(sc + (size_t)row * 8), c1 = *(const f32x4*)(sc + (size_t)row * 8 + 4);
                ra[k] = rsqrtf((((a0.x + a0.y) + (a0.z + a0.w)) + (a1.x + a1.y)) * (1.f / 384.f) + 1e-6f); rc[k] = rsqrtf((((c0.x + c0.y) + (c0.z + c0.w)) + (c1.x + c1.y)) * (1.f / 384.f) + 1e-6f);
                x[k] = *((const u32x4*)(Y + (size_t)row * 1024) + lane); y[k] = *((const u32x4*)(Y + (size_t)row * 1024 + 384) + lane); }
#pragma unroll
            for (int k = 0; k < 8; ++k) { const int row = r0 + k; u32x4 a = x[k], c = y[k]; const float fa = ra[k], fc = rc[k];
                a.x = pk_bf16(bf_lo(a.x) * fa, bf_hi(a.x) * fa); a.y = pk_bf16(bf_lo(a.y) * fa, bf_hi(a.y) * fa); a.z = pk_bf16(bf_lo(a.z) * fa, bf_hi(a.z) * fa); a.w = pk_bf16(bf_lo(a.w) * fa, bf_hi(a.w) * fa);
                c.x = pk_bf16(bf_lo(c.x) * fc, bf_hi(c.x) * fc); c.y = pk_bf16(bf_lo(c.y) * fc, bf_hi(c.y) * fc); c.z = pk_bf16(bf_lo(c.z) * fc, bf_hi(c.z) * fc); c.w = pk_bf16(bf_lo(c.w) * fc, bf_hi(c.w) * fc);
                *((u32x4*)(Y + (size_t)row * 1024) + lane) = a; *((u32x4*)(Y + (size_t)row * 1024 + 384) + lane) = c; }
        }
    }
}
constexpr int LDS_FAC = 131072 + 2048;
__device__ __forceinline__ void outproj_factors(int l, unsigned char* ws, LAS unsigned char* lds, int pm, int tid) {
    asm volatile("" : "+v"(tid));
    if (tid < 256) { const int row = pm * 256 + tid; const float* sa = (const float*)(ws + WS_SSQ + PT_A) + ((size_t)l * 16384 + row) * 8; const float* sc = (const float*)(ws + WS_SSQ + PT_C) + ((size_t)l * 16384 + row) * 8;
        const f32x4 a0 = *(const f32x4*)sa, a1 = *(const f32x4*)(sa + 4), c0 = *(const f32x4*)sc, c1 = *(const f32x4*)(sc + 4);
        const float ra = rsqrtf((((a0.x + a0.y) + (a0.z + a0.w)) + (a1.x + a1.y)) * (1.f / 384.f) + 1e-6f), rc = rsqrtf((((c0.x + c0.y) + (c0.z + c0.w)) + (c1.x + c1.y)) * (1.f / 384.f) + 1e-6f);
        LAS float* F = (LAS float*)(lds + LDS_FAC); F[2 * tid] = ra / rc; F[2 * tid + 1] = rc; }
    __syncthreads();
}
struct EpiOut {
    static constexpr bool KHOOK = true;
    bf16_t* XB; float* ssq; const LAS float* F; bool fold;
    __device__ __forceinline__ void kscale(f32x4 (&acc)[2][2][4][2], int which, int wr, int fr) const {
        if (!fold) return;
#pragma unroll
        for (int ai = 0; ai < 2; ++ai)
#pragma unroll
            for (int m = 0; m < 4; ++m) { const float f = F[2 * (ai * 128 + wr * 64 + m * 16 + fr) + which];
#pragma unroll
                for (int bj = 0; bj < 2; ++bj)
#pragma unroll
                    for (int n = 0; n < 2; ++n) acc[ai][bj][m][n] = acc[ai][bj][m][n] * f; }
    }
    __device__ __forceinline__ void operator()(const f32x4 (&acc)[2][2][4][2], const GUnit& u, int wr, int wc, int fr, int fq) const {
#pragma unroll
        for (int ai = 0; ai < 2; ++ai)
#pragma unroll
          for (int mh = 0; mh < 2; ++mh) {
            __builtin_amdgcn_sched_barrier(0);
            u32x4 xr[2][2];
#pragma unroll
            for (int m2 = 0; m2 < 2; ++m2)
#pragma unroll
                for (int bj = 0; bj < 2; ++bj) xr[m2][bj] = *(const u32x4*)(XB + (size_t)(u.pm * 256 + ai * 128 + wr * 64 + (2 * mh + m2) * 16 + fr) * 1024 + u.pn * 256 + bj * 128 + wc * 32 + 8 * fq);
#pragma unroll
            for (int m2 = 0; m2 < 2; ++m2) {
                const int m = 2 * mh + m2; const int row = u.pm * 256 + ai * 128 + wr * 64 + m * 16 + fr; float ss = 0.f;
#pragma unroll
                for (int bj = 0; bj < 2; ++bj) {
                    const u32x4 x = xr[m2][bj]; u32x4 o;
                    o.x = pk_bf16(bf_lo(x.x) + acc[ai][bj][m][0][0], bf_hi(x.x) + acc[ai][bj][m][0][1]); o.y = pk_bf16(bf_lo(x.y) + acc[ai][bj][m][0][2], bf_hi(x.y) + acc[ai][bj][m][0][3]);
                    o.z = pk_bf16(bf_lo(x.z) + acc[ai][bj][m][1][0], bf_hi(x.z) + acc[ai][bj][m][1][1]); o.w = pk_bf16(bf_lo(x.w) + acc[ai][bj][m][1][2], bf_hi(x.w) + acc[ai][bj][m][1][3]);
                    *(u32x4*)(XB + (size_t)row * 1024 + u.pn * 256 + bj * 128 + wc * 32 + 8 * fq) = o;
                    ss += (bf_lo(o.x) * bf_lo(o.x) + bf_hi(o.x) * bf_hi(o.x)) + (bf_lo(o.y) * bf_lo(o.y) + bf_hi(o.y) * bf_hi(o.y)) + (bf_lo(o.z) * bf_lo(o.z) + bf_hi(o.z) * bf_hi(o.z)) + (bf_lo(o.w) * bf_lo(o.w) + bf_hi(o.w) * bf_hi(o.w));
                }
                ss = quad_sum(ss); if (fq == 0) ssq[(size_t)row * 16 + u.pn * 4 + wc] = ss;
            }
          }
    }
};

__device__ __forceinline__ float sum16(const float* p) { const f32x4 a = *(const f32x4*)p, b = *(const f32x4*)(p + 4), c = *(const f32x4*)(p + 8), d = *(const f32x4*)(p + 12);
    return (((a.x + a.y) + (a.z + a.w)) + ((b.x + b.y) + (b.z + b.w))) + (((c.x + c.y) + (c.z + c.w)) + ((d.x + d.y) + (d.z + d.w))); }
__device__ __forceinline__ void phase_route(int l, InPtr in, unsigned char* ws, LAS unsigned char* lds, int bid, int nb, int g_wv) {
    int tid_ = TIDX; asm volatile("" : "+v"(tid_)); const int w = tid_ >> 6, lane = tid_ & 63, r = lane & 15, q = lane >> 4;
    const bf16_t* XB = (const bf16_t*)(ws + WS_XB); const bf16_t* WR = (const bf16_t*)(ws + WS_WR) + (size_t)l * 64 * 1024;
    const float* ssq = (const float*)(ws + WS_SSQ + PT_X1) + (size_t)l * 16384 * 16; const float* bg = in->p[24] + l * 4; const float* be = in->p[26] + l * 32;
    unsigned* cnt = (unsigned*)(ws + WS_CTL) + CW_CNT + 2048 * l; unsigned* mtok = (unsigned*)(ws + WS_META); float* mw = (float*)(ws + WS_META + META_W);
    LAS float* lg = (LAS float*)(lds + w * 4096);
    LAS unsigned* lcnt = (LAS unsigned*)(lds + 32768); LAS unsigned* lbase = lcnt + 32;
    for (int g0 = bid * 8; g0 < NTOK / 16; g0 += nb * 8) {
        if (tid_ < 32) lcnt[tid_] = 0u;
        __syncthreads();
        const int tok0 = (g0 + w) * 16; f32x4 acc[3];
#pragma unroll
        for (int n = 0; n < 3; ++n) acc[n] = (f32x4){0.f, 0.f, 0.f, 0.f};
        const bf16_t* ap = XB + (size_t)(tok0 + r) * 1024 + 8 * q; const bf16_t* bp = WR + (size_t)r * 1024 + 8 * q;
#pragma unroll 1
        for (int kc = 0; kc < 4; ++kc) {
            bf16x8 a[8], bb[3][8];
#pragma unroll
            for (int s = 0; s < 8; ++s) { a[s] = *(const bf16x8*)(ap + 32 * (kc * 8 + s));
#pragma unroll
                for (int n = 0; n < 3; ++n) bb[n][s] = *(const bf16x8*)(bp + (size_t)n * 16 * 1024 + 32 * (kc * 8 + s)); }
            __builtin_amdgcn_sched_barrier(0);
#pragma unroll
            for (int s = 0; s < 8; ++s)
#pragma unroll
                for (int n = 0; n < 3; ++n) acc[n] = MFMA16(a[s], bb[n][s], acc[n]);
            __builtin_amdgcn_sched_barrier(0);
        }
#pragma unroll
        for (int n = 0; n < 3; ++n)
#pragma unroll
            for (int j = 0; j < 4; ++j) lg[(4 * q + j) * 48 + 16 * n + r] = acc[n][j];
        LDS_FENCE();
        int E0 = 0, E1 = 0; unsigned r0 = 0, r1 = 0; float wt0 = 0.f, wt1 = 0.f; const int tok = tok0 + (lane & 15);
        if (lane < 16) {
            const float rs = rsqrtf(sum16(ssq + (size_t)tok * 16) * (1.f / 1024.f) + 1e-6f); ((float*)(ws + WS_RS2))[tok] = rs; const LAS float* L = lg + lane * 48;
            float gl[4]; int gi = 0;
#pragma unroll
            for (int j = 0; j < 4; ++j) gl[j] = L[j] * rs + bg[j];
            float gm = gl[0];
#pragma unroll
            for (int j = 1; j < 4; ++j) if (gl[j] > gm) { gm = gl[j]; gi = j; }
            float gsum = 0.f;
#pragma unroll
            for (int j = 0; j < 4; ++j) gsum += __expf(gl[j] - gm);
            const float gtop = 1.f / gsum;
            float el[8];
#pragma unroll
            for (int j = 0; j < 8; ++j) el[j] = L[4 + gi * 8 + j] * rs + be[gi * 8 + j];
            int e0 = 0; float v0 = el[0];
#pragma unroll
            for (int j = 1; j < 8; ++j) if (el[j] > v0) { v0 = el[j]; e0 = j; }
            int e1 = -1; float v1 = -3.0e38f;
#pragma unroll
            for (int j = 0; j < 8; ++j) if (j != e0 && el[j] > v1) { v1 = el[j]; e1 = j; }
            const float w0 = 1.f / (1.f + __expf(v1 - v0)); E0 = gi * 8 + e0; E1 = gi * 8 + e1; wt0 = w0 * gtop; wt1 = (1.f - w0) * gtop;
            r0 = __hip_atomic_fetch_add(lcnt + E0, 1u, __ATOMIC_RELAXED, __HIP_MEMORY_SCOPE_WORKGROUP); r1 = __hip_atomic_fetch_add(lcnt + E1, 1u, __ATOMIC_RELAXED, __HIP_MEMORY_SCOPE_WORKGROUP);
        }
        __syncthreads();
        if (tid_ < 32) { const unsigned c = lcnt[tid_]; lbase[tid_] = c ? atomicAdd(cnt + tid_ * 64, c) : 0u; }
        __syncthreads();
        if (lane < 16) {
            const unsigned p0 = lbase[E0] + r0, p1 = lbase[E1] + r1;
            mtok[(size_t)E0 * 16384 + p0] = (unsigned)tok; mw[(size_t)E0 * 16384 + p0] = wt0;
            mtok[(size_t)E1 * 16384 + p1] = (unsigned)tok | 0x80000000u; mw[(size_t)E1 * 16384 + p1] = wt1;
        }
        __syncthreads();
    }
}

constexpr int LDS_TB = 131072 + 2048;
__device__ __forceinline__ void moe_tables(int l, unsigned char* ws, LAS unsigned char* lds, int g_wv) {
    int tix = TIDX; asm volatile("" : "+v"(tix));
    LAS int* tb = (LAS int*)(lds + LDS_TB);
    if (tix < 32) { const unsigned* cnt = (const unsigned*)(ws + WS_CTL) + CW_CNT + 2048 * l; tb[160 + tix] = (int)__hip_atomic_load(cnt + tix * 64, __ATOMIC_RELAXED, __HIP_MEMORY_SCOPE_AGENT); }
    __syncthreads();
    if (tix == 0) { int a = 0, f = 0, p = 0; for (int e = 0; e < 32; ++e) { const int c = tb[160 + e]; tb[e] = a; tb[48 + e] = f; tb[96 + e] = p; a += (c + 255) >> 8; f += c >> 8; p += (c & 255) ? 1 : 0; } tb[32] = a; tb[80] = f; tb[128] = p; }
    __syncthreads();
}
template <int NPN, bool GATHER_>
struct MoeSched {
    static constexpr bool GATHER = GATHER_, PARTIAL = false;
    const char* A; const char* Bt; const unsigned* cnt; const unsigned* mtok; const LAS int* tb; int G, c; size_t bstride_e  , bstride_pn; int lo, hi;
    __device__ __forceinline__ bool next(int i, GUnit& u) const {
        const int L = lo + i * G + c; if (L >= hi) return false;
        const int tile = L / NPN, pn = L % NPN;
        int e = 0;
        for (int k = 1; k < 32; ++k) e = (tb[k] <= tile) ? k : e;
        e = __builtin_amdgcn_readfirstlane(e);
        u.e = e; u.pm = tile; u.pn = pn; u.rows = tb[160 + e] - 256 * (tile - tb[e]);
        u.a = GATHER ? A : A + (size_t)tile * 256 * 256 * 2;
        u.b = Bt + (size_t)e * bstride_e + (size_t)pn * bstride_pn; return true;
    }
    __device__ __forceinline__ void aoff(const GUnit& u, unsigned (&v)[2][2], const int (&R)[2], const int (&C)[2]) const {
#pragma unroll
        for (int h = 0; h < 2; ++h)
#pragma unroll
            for (int i = 0; i < 2; ++i) {
                if (GATHER) { const int lr = h * 128 + R[i]; const int rr = 256 * (u.pm - tb[u.e]) + (lr < u.rows ? lr : 0); const unsigned tok = mtok[(size_t)u.e * 16384 + rr] & 0x7fffffffu; v[h][i] = (tok * 1024u + (unsigned)C[i]) * 2u; }
                else v[h][i] = (unsigned)((h * 128 + R[i]) * 256 + C[i]) * 2u;
            }
    }
};
struct EpiMoeUp {
    static constexpr bool KHOOK = false;
    const unsigned* mtok; const float* ssq; const LAS int* tb; bf16_t* HB;
    __device__ __forceinline__ void operator()(const f32x4 (&acc)[2][2][4][2], const GUnit& u, int wr, int wc, int fr, int fq) const {
        const int r0 = 256 * (u.pm - tb[u.e]);
        float rs8[8];
        { unsigned tk[8];
#pragma unroll
          for (int k = 0; k < 8; ++k) { const int lr = (k >> 2) * 128 + wr * 64 + (k & 3) * 16 + fr; tk[k] = mtok[(size_t)u.e * 16384 + r0 + (lr < u.rows ? lr : 0)] & 0x7fffffffu; }
#pragma unroll
          for (int k = 0; k < 8; ++k) rs8[k] = ssq[tk[k]]; }
#pragma unroll
        for (int ai = 0; ai < 2; ++ai)
#pragma unroll
            for (int m = 0; m < 4; ++m) {
                __builtin_amdgcn_sched_barrier(0);
                const int lr = ai * 128 + wr * 64 + m * 16 + fr;
                if (lr < u.rows) {
                    const float rs = rs8[ai * 4 + m];
                    float hv[8];
#pragma unroll
                    for (int n = 0; n < 2; ++n)
#pragma unroll
                        for (int j = 0; j < 4; ++j) { const float gv = acc[ai][0][m][n][j] * rs, uv = acc[ai][1][m][n][j] * rs; hv[4 * n + j] = siluf(gv) * uv; }
                    st_bf16x8(HB + ((size_t)u.pm * 256 + lr) * 256 + u.pn * 128 + wc * 32 + 8 * fq, hv);
                }
            }
    }
};
struct EpiMoeDown {
    static constexpr bool KHOOK = false;
    const unsigned* mtok; const float* mw; const LAS int* tb; bf16_t* YB;
    __device__ __forceinline__ void operator()(const f32x4 (&acc)[2][2][4][2], const GUnit& u, int wr, int wc, int fr, int fq) const {
        const int r0 = 256 * (u.pm - tb[u.e]);
        unsigned mt8[8]; float wt8[8];
#pragma unroll
        for (int k = 0; k < 8; ++k) { const int lr = (k >> 2) * 128 + wr * 64 + (k & 3) * 16 + fr; const size_t ix = (size_t)u.e * 16384 + r0 + (lr < u.rows ? lr : 0); mt8[k] = mtok[ix]; wt8[k] = mw[ix]; }
#pragma unroll
        for (int ai = 0; ai < 2; ++ai)
#pragma unroll
            for (int m = 0; m < 4; ++m) {
                __builtin_amdgcn_sched_barrier(0);
                const int lr = ai * 128 + wr * 64 + m * 16 + fr;
                if (lr < u.rows) {
                    const unsigned mt = mt8[ai * 4 + m]; const float wt = wt8[ai * 4 + m];
                    bf16_t* dst = YB + ((size_t)(mt >> 31) * 16384 + (mt & 0x7fffffffu)) * 1024 + u.pn * 256 + wc * 32 + 8 * fq;
#pragma unroll
                    for (int bj = 0; bj < 2; ++bj) { float v[8];
#pragma unroll
                        for (int n = 0; n < 2; ++n)
#pragma unroll
                            for (int j = 0; j < 4; ++j) v[4 * n + j] = acc[ai][bj][m][n][j] * wt;
                        st_bf16x8(dst + bj * 128, v); }
                }
            }
    }
};
__device__ __forceinline__ void phase_combine(int l, unsigned char* ws, float* out, int bid, int nb, int g_wv) {
    int tid_ = TIDX; asm volatile("" : "+v"(tid_)); const int w = tid_ >> 6, lane = tid_ & 63;
    bf16_t* XB = (bf16_t*)(ws + WS_XB); const bf16_t* Y0 = (const bf16_t*)(ws + WS_YBUF); const bf16_t* Y1 = Y0 + (size_t)16384 * 1024; float* ssqx = (float*)(ws + WS_SSQX) + 16384;
    for (int row = bid * 8 + w; row < NTOK; row += nb * 8) {
        float ss = 0.f;
#pragma unroll
        for (int k = 0; k < 2; ++k) {
            const size_t o = (size_t)row * 1024 + (lane + 64 * k) * 8;
            const u32x4 x = *(const u32x4*)(XB + o), a = *(const u32x4*)(Y0 + o), c = *(const u32x4*)(Y1 + o);
            float v[8] = { bf_lo(x.x) + bf_lo(a.x) + bf_lo(c.x), bf_hi(x.x) + bf_hi(a.x) + bf_hi(c.x), bf_lo(x.y) + bf_lo(a.y) + bf_lo(c.y), bf_hi(x.y) + bf_hi(a.y) + bf_hi(c.y),
                           bf_lo(x.z) + bf_lo(a.z) + bf_lo(c.z), bf_hi(x.z) + bf_hi(a.z) + bf_hi(c.z), bf_lo(x.w) + bf_lo(a.w) + bf_lo(c.w), bf_hi(x.w) + bf_hi(a.w) + bf_hi(c.w) };
            if (l == L_ - 1 && out) { *(f32x4*)(out + o) = (f32x4){v[0], v[1], v[2], v[3]}; *(f32x4*)(out + o + 4) = (f32x4){v[4], v[5], v[6], v[7]}; }
            else { u32x4 p; p.x = pk_bf16(v[0], v[1]); p.y = pk_bf16(v[2], v[3]); p.z = pk_bf16(v[4], v[5]); p.w = pk_bf16(v[6], v[7]); *(u32x4*)(XB + o) = p;
#pragma unroll
                   for (int j = 0; j < 4; ++j) { const unsigned q = j == 0 ? p.x : (j == 1 ? p.y : (j == 2 ? p.z : p.w)); ss += bf_lo(q) * bf_lo(q) + bf_hi(q) * bf_hi(q); } }
        }
        if (l < L_ - 1) { ss = wave_sum(ss); if (lane == 0) ssqx[row] = ss; }
    }
}
constexpr int MOE_CVT_SPLIT = 4608;
#ifndef CVT_A
#define CVT_A 2688
#endif
#ifndef NROUTE
#define NROUTE 128
#endif
constexpr int NPH = 9;
enum { PH_INPROJ = 0, PH_PREP, PH_MIX, PH_YNORM, PH_OUTPROJ, PH_ROUTE, PH_MOEUP, PH_MOEDOWN, PH_COMBINE };
struct Args { Inputs in; float* out; unsigned char* ws; int ph_lo, ph_hi; };

__global__ void __launch_bounds__(512, 2) mk(Args args) {
    extern __shared__ __attribute__((aligned(16))) unsigned char lds_raw[];
    LAS unsigned char* lds = (LAS unsigned char*)lds_raw;
    const int g_wv = __builtin_amdgcn_readfirstlane((int)threadIdx.x >> 6);
    const int bid0 = blockIdx.x, nb = gridDim.x;
#define BID() ({ int b_ = bid0; asm volatile("" : "+s"(b_)); b_; })
    unsigned char* ws = args.ws; unsigned* ctl = (unsigned*)(ws + WS_CTL);
    const int lo = args.ph_lo, hi = args.ph_hi;
    if (TIDX < 4) ((LAS unsigned*)(lds + LDS_MISC))[TIDX] = 0u;
    __syncthreads();
    XcdBarrier bar; bar.g_wv = g_wv; bar.bar = ctl + CW_BAR; bar.x = 0; bar.st = nullptr;
    if (hi - lo > 1) bar = xcd_barrier_post(ctl + CW_BAR, (volatile LAS unsigned*)(lds + LDS_MISC), g_wv);
#define IN(k) (lo <= (k) && (k) < hi)
#ifndef REPEAT_PH
#define REPEAT_PH -1
#endif
#define NREP(k) ((REPEAT_PH == (k)) ? 2 : 1)
#ifndef NBAR
#define NBAR 1
#endif
#ifndef TIME_PH
#define TIME_PH -1
#endif
#define STAMP(i) do { if (TIME_PH != -1 && blockIdx.x == 0 && TIDX == 0) ((unsigned long long*)(ctl + CW_TS))[i] = __builtin_amdgcn_s_memrealtime(); } while (0)
#define SEAM(k) do { if (IN(k) && IN((k) + 1)) for (int nb_ = 0; nb_ < NBAR; ++nb_) xcd_barrier(bar); STAMP((k) + 1); } while (0)
    STAMP(0);
#ifndef NO_PRO
    if (IN(0)) for (int rep = 0; rep < NREP(100); ++rep) { prologue(in_tab(), launder(ws), lds, BID(), nb, g_wv); if (rep + 1 < NREP(100)) xcd_barrier(bar); }
#endif
    SEAM(0);
    for (int l = 0; l < L_; ++l) {
        const int pb = 1 + l * NPH;
        if (IN(pb + PH_INPROJ)) for (int rep = 0; rep < NREP(PH_INPROJ); ++rep) {
            if (rep) xcd_barrier(bar);
            InPtr in = in_tab(); unsigned char* ws = launder(args.ws);
            g8::DenseSched S{(const char*)(ws + WS_XB), (const char*)(ws + WS_WIN) + (size_t)l * 2560 * 1024 * 2, 1024, 1024, 64, 10, nb, BID()};
            EpiInProj E{(const float*)(ws + WS_SSQX) + l * 16384, (float*)(ws + WS_SSQ + PT_DQ) + (size_t)l * 16384 * 4, (float*)(ws + WS_SSQ + PT_DKV) + (size_t)l * 16384 * 2,
                        in->p[8] + l * 64, in->p[9] + l * 64, in->p[19] + l * 192 + 96 + 64, (const float*)(ws + WS_ROPE), ws + WS_PRJ};
#ifndef NO_INPROJ
            g8::gemm_run(lds, 1024, 1024, S, E, g_wv);
#endif
        }
        SEAM(pb + PH_INPROJ);
        if (IN(pb + PH_PREP)) for (int rep = 0; rep < NREP(PH_PREP); ++rep) { if (rep) xcd_barrier(bar); phase_prep(l, in_tab(), launder(ws), lds, BID(), nb, g_wv, (unsigned*)launder(ws) + CW_Q + 64 * (4 + l + 2 * rep)); }
        SEAM(pb + PH_PREP);
        if (IN(pb + PH_MIX)) for (int rep = 0; rep < NREP(PH_MIX); ++rep) { if (rep) xcd_barrier(bar); phase_mix(l, in_tab(), launder(ws), lds, (unsigned*)launder(ws) + CW_Q + 64 * (l + 2 * rep), g_wv); }
        SEAM(pb + PH_MIX);
        const bool fold_norm = (nb == 256);
        if (IN(pb + PH_YNORM) && !fold_norm) phase_ynorm(l, launder(ws), BID(), nb, g_wv);
        if (!fold_norm) SEAM(pb + PH_YNORM);
        if (IN(pb + PH_OUTPROJ)) {
            unsigned char* ws = launder(args.ws);
            g8::DenseSched S{(const char*)(ws + WS_Y), (const char*)(ws + WS_WOUT) + (size_t)l * 1024 * 1024 * 2, 1024, 1024, 64, 4, nb, BID()};
            EpiOut E{(bf16_t*)(ws + WS_XB), (float*)(ws + WS_SSQ + PT_X1) + (size_t)l * 16384 * 16, (const LAS float*)(lds + LDS_FAC), fold_norm};
            if (fold_norm) { g8::GUnit u0; if (S.next(0, u0)) outproj_factors(l, ws, lds, u0.pm, TIDX); else __syncthreads(); }
#ifndef NO_OUTPROJ
            g8::gemm_run(lds, 1024, 1024, S, E, g_wv);
#endif
        }
        SEAM(pb + PH_OUTPROJ);
#ifndef NO_ROUTE
        if (IN(pb + PH_ROUTE)) {
            const int b_ = BID();
            if (nb >= 256 && b_ >= NROUTE) { cvt_moe_layer(in_tab(), launder(ws), l, (LAS float*)lds, b_ - NROUTE, nb - NROUTE, TIDX, 0, CVT_A);
#ifdef DUP_CVT
                __syncthreads(); cvt_moe_layer(in_tab(), launder(ws), l, (LAS float*)lds, b_ - NROUTE, nb - NROUTE, TIDX);
#endif
            }
            else { phase_route(l, in_tab(), launder(ws), lds, b_, nb >= 256 ? NROUTE : nb, g_wv);
                   if (nb < 256) cvt_moe_layer(in_tab(), launder(ws), l, (LAS float*)lds, b_, nb, TIDX); else cvt_moe_layer(in_tab(), launder(ws), l, (LAS float*)lds, b_, NROUTE, TIDX, CVT_A, 3072); }
            if (l + 1 < L_) { __syncthreads(); cvt_small_weights(in_tab(), launder(ws), l + 1, (LAS float*)lds, b_, nb, TIDX); }
        }
#endif
        SEAM(pb + PH_ROUTE);
        {
            const bool do_up = IN(pb + PH_MOEUP), do_dn = IN(pb + PH_MOEDOWN), fuse = do_up && do_dn;
            for (int part = 0; part < (fuse ? 3 : 1); ++part) {
                if (part) xcd_barrier(bar);
                unsigned char* ws = launder(args.ws);
                if (do_up || do_dn) moe_tables(l, ws, lds, g_wv);
                const unsigned* cnt = (const unsigned*)(ws + WS_CTL) + CW_CNT + 2048 * l; const unsigned* mtok = (const unsigned*)(ws + WS_META); const LAS int* tb = (const LAS int*)(lds + LDS_TB);
                const int b_ = BID(), ntile = tb[32], UPU = 2 * ntile, DNU = 4 * ntile;
                const int hi0 = UPU < nb ? UPU : nb, nu_ = UPU - hi0, nu = nu_ < (nb >> 1) ? nu_ : (nb >> 1), nd = nb - nu;
                const int d1a = 4 * (hi0 >> 1), d1b = 2 * nd, D1 = nu == 0 ? DNU : (d1a < d1b ? d1a : d1b);
                int ulo = 0, uhi = UPU, uG = nb, uc = b_, dlo = 0, dhi = DNU, dG = nb, dc = b_;
                if (fuse) {
                    if (part == 0) { uhi = hi0; dhi = 0; }
                    else if (part == 1) { ulo = hi0; uG = nu; if (b_ >= nu) uhi = ulo; dhi = D1; dG = nd; dc = b_ - nu; if (b_ < nu) dhi = 0; }
                    else { uhi = 0; dlo = D1; }
                }
                if (do_up && uhi > ulo) {
                    MoeSched<2, true> S{(const char*)(ws + WS_XB), (const char*)(ws + WS_WMOE), cnt, mtok, tb, uG, uc, (size_t)512 * 1024 * 2, (size_t)256 * 1024 * 2, ulo, uhi};
                    EpiMoeUp E{mtok, (const float*)(ws + WS_RS2), tb, (bf16_t*)(ws + WS_HBUF)};
#ifndef NO_MOEUP
                    g8::gemm_run(lds, 1024, 1024, S, E, g_wv);
#endif
                }
                if (do_dn && dhi > dlo) {
                    MoeSched<4, false> S{(const char*)(ws + WS_HBUF), (const char*)(ws + WS_WMOE + WMOE_WD), cnt, mtok, tb, dG, dc, (size_t)1024 * 256 * 2, (size_t)256 * 256 * 2, dlo, dhi};
                    EpiMoeDown E{mtok, (const float*)(ws + WS_META + META_W), tb, (bf16_t*)(ws + WS_YBUF)};
#ifndef NO_MOEDOWN
                    g8::gemm_run(lds, 256, 256, S, E, g_wv);
#endif
                }
            }
        }
        SEAM(pb + PH_MOEDOWN);
#ifndef NO_COMBINE
        if (IN(pb + PH_COMBINE)) { unsigned char* ws = launder(args.ws); phase_combine(l, ws, args.out, BID(), nb, g_wv); }
#endif
        SEAM(pb + PH_COMBINE);
    }
#undef IN
#undef SEAM
}
#if CHECK
struct NvScratch { float *proj, *h1, *qk, *hraw, *kn, *kcmp, *vcmp, *dqn, *q, *dkvn, *kv, *krope, *y, *x1, *xl; int* rt_e; float* rt_w; };
constexpr int CB = 5;
enum { NS_INPROJ = 0, NS_NSAPREP, NS_MLAPREP, NS_NSA, NS_ML, NS_MLA, NS_OUT, NS_ROUTE, NS_MOE };
static void naive_step(void* const* d_in, int l, int step, const float* xin, float* xout, const NvScratch& S, hipStream_t st) {
    const int b = CB;
    const float* rel_bias = (const float*)d_in[2];
    const float* norm1_g = (const float*)d_in[3] + (long)l * 1024;
    const float* w_in = (const float*)d_in[4] + (long)l * 1024 * DIN;
    const float* cmp_pe = (const float*)d_in[5] + (long)l * 2 * 32 * 64;
    const float* cmp_w1 = (const float*)d_in[6] + (long)l * 2 * 32 * 64 * 64;
    const float* cmp_w2 = (const float*)d_in[7] + (long)l * 2 * 64 * 64;
    const float* q_norm = (const float*)d_in[8] + l * 64;
    const float* k_norm = (const float*)d_in[9] + l * 64;
    const float* nsa_on = (const float*)d_in[10] + l * 384;
    const float* conv = (const float*)d_in[11] + l * 4 * 512;
    const float* ibias = (const float*)d_in[12] + l * 4;
    const float* fbias = (const float*)d_in[13] + l * 4;
    const float* ml_on = (const float*)d_in[14] + l * 256;
    const float* qan = (const float*)d_in[15] + l * 192;
    const float* w_uq = (const float*)d_in[16] + (long)l * 192 * 576;
    const float* kvan = (const float*)d_in[17] + l * 128;
    const float* w_ukv = (const float*)d_in[18] + (long)l * 128 * 768;
    const float* qkn = (const float*)d_in[19] + l * 192;
    const float* mla_on = (const float*)d_in[20] + l * 384;
    const float* w_out = (const float*)d_in[21] + (long)l * 1024 * 1024;
    const float* norm2_g = (const float*)d_in[22] + l * 1024;
    const float* wgrp = (const float*)d_in[23] + (long)l * 1024 * 4;
    const float* bgrp = (const float*)d_in[24] + l * 4;
    const float* wexp = (const float*)d_in[25] + (long)l * 1024 * 32;
    const float* bexp = (const float*)d_in[26] + l * 32;
    const float* Wg = (const float*)d_in[27] + (long)l * 32 * 1024 * 256;
    const float* Wu = (const float*)d_in[28] + (long)l * 32 * 1024 * 256;
    const float* Wd = (const float*)d_in[29] + (long)l * 32 * 256 * 1024;
    const int* pos = (const int*)d_in[1] + b * 2048;
    switch (step) {
    case NS_INPROJ:
        nv_rmsnorm<<<dim3(2048, 1), 64, 0, st>>>(xin, 1024, 0, S.h1, 1024, 0, norm1_g, 0, 1024);
        nv_gemm<<<dim3((DIN + 63) / 64, 2048 / 64), 256, 0, st>>>(S.h1, 1024, w_in, DIN, S.proj, DIN, nullptr, 0, 2048, DIN, 1024);
        break;
    case NS_NSAPREP:
        nv_nsa_cmp<<<dim3(127, 2, 2), 64, 0, st>>>(S.proj, cmp_pe, cmp_w1, cmp_w2, k_norm, S.kcmp, S.vcmp);
        nv_nsa_knorm<<<dim3(2048, 4), 64, 0, st>>>(S.proj, k_norm, S.kn);
        break;
    case NS_MLAPREP:
        nv_rmsnorm<<<dim3(2048, 1), 64, 0, st>>>(S.proj + O_CDQ, DIN, 0, S.dqn, 192, 0, qan, 0, 192);
        nv_gemm<<<dim3(576 / 64, 2048 / 64), 256, 0, st>>>(S.dqn, 192, w_uq, 576, S.q, 576, nullptr, 0, 2048, 576, 192);
        nv_rmsnorm<<<dim3(2048, 1), 64, 0, st>>>(S.proj + O_CDKV, DIN, 0, S.dkvn, 128, 0, kvan, 0, 128);
        nv_gemm<<<dim3(768 / 64, 2048 / 64), 256, 0, st>>>(S.dkvn, 128, w_ukv, 768, S.kv, 768, nullptr, 0, 2048, 768, 128);
        nv_mla_prep<<<dim3(2048, 7), 64, 0, st>>>(S.q, S.kv, S.proj, S.krope, qkn, pos);
        break;
    case NS_NSA:
        nv_nsa_attn<<<dim3(2048, 2), 192, 0, st>>>(S.proj, S.kn, S.kcmp, S.vcmp, rel_bias, q_norm, S.y);
        break;
    case NS_ML:
        nv_ml_conv<<<2048, 512, 0, st>>>(S.proj, conv, S.qk);
        nv_ml_rec<<<4, 256, 0, st>>>(S.proj, S.qk, ibias, fbias, S.hraw);
        nv_ml_fin<<<dim3(2048, 4), 64, 0, st>>>(S.proj, S.hraw, ml_on, S.y);
        break;
    case NS_MLA:
        nv_mla_attn<<<dim3(2048, 6), 64, 0, st>>>(S.q, S.kv, S.krope, S.y);
        break;
    case NS_OUT:
        nv_rmsnorm<<<dim3(2048, 1), 64, 0, st>>>(S.y, 1024, 0, S.y, 1024, 0, nsa_on, 0, 384);
        nv_rmsnorm<<<dim3(2048, 1), 64, 0, st>>>(S.y + 640, 1024, 0, S.y + 640, 1024, 0, mla_on, 0, 384);
        nv_gemm<<<dim3(1024 / 64, 2048 / 64), 256, 0, st>>>(S.y, 1024, w_out, 1024, S.x1, 1024, xin, 1024, 2048, 1024, 1024);
        break;
    case NS_ROUTE:
        nv_moe_route<<<2048, 64, 0, st>>>(S.x1, norm2_g, wgrp, bgrp, wexp, bexp, S.h1, S.rt_e, S.rt_w);
        break;
    case NS_MOE:
        nv_moe_exp<<<2048, 256, 0, st>>>(S.x1, S.h1, S.rt_e, S.rt_w, Wg, Wu, Wd, xout);
        break;
    }
}

__device__ __forceinline__ void chk_commit(float d2, float r2, float* acc) { d2 = wave_sum(d2); r2 = wave_sum(r2); if ((threadIdx.x & 63) == 0) { atomicAdd(acc, d2); atomicAdd(acc + 1, r2); } }
__device__ __forceinline__ void chk_add(float f, float r, float& d2, float& r2) { const float d = f - r; d2 += (d == d) ? d * d : 1e30f; r2 += r * r; }

__global__ void __launch_bounds__(64) chk_proj(const float* nproj, const unsigned char* prj, const float* ssq_dq, const float* ssq_dkv, const float* qg, const float* kg, const float* krg, const int* pos, float* acc) {
    const int t = blockIdx.x, e = threadIdx.x; const size_t row = (size_t)CB * 2048 + t; float d2 = 0.f, r2 = 0.f;
    for (int G = 0; G < 40; ++G) {
        const int c = inproj_refcol(G, e); float r = c < 0 ? 0.f : nproj[(size_t)t * DIN + c]; float f = 0.f;
        const float rr = (G == 37 && e >= 32) ? 0.f : r; const float ss = wave_sum(rr * rr);
        if (G < 6) { r = r * rsqrtf(ss / 64.f + 1e-6f) * qg[e] * 0.18033688f; f = bf2f(((const bf16_t*)(prj + PRJ_QN))[((size_t)(CB * 6 + G) * 2048 + t) * 64 + e]); }
        else if (G < 18) { const int a = G - 6, br = a >> 2, s = (a >> 1) & 1, hk = a & 1;
            if (br > 0 && s == 0) r = r * rsqrtf(ss / 64.f + 1e-6f) * kg[e];
            const size_t base = br == 0 ? (s ? PRJ_C0V : PRJ_C0K) : (br == 1 ? (s ? PRJ_VN1 : PRJ_KN1) : (s ? PRJ_VN2 : PRJ_KN2));
            f = bf2f(((const bf16_t*)(prj + base))[((size_t)(CB * 2 + hk) * 2048 + t) * 64 + e]); }
        else if (G < 26) f = bf2f(((const bf16_t*)(prj + PRJ_RAWQK))[row * 512 + (G - 18) * 64 + e]);
        else if (G < 30) f = bf2f(((const bf16_t*)(prj + PRJ_VML))[((size_t)(CB * 4 + (G - 26)) * 2048 + t) * 64 + e]);
        else if (G < 34) f = bf2f(((const bf16_t*)(prj + PRJ_OG))[row * 256 + (G - 30) * 64 + e]);
        else if (G < 37) f = bf2f(((const bf16_t*)(prj + PRJ_DQKV))[row * 384 + (G - 34) * 64 + e]);
        else if (G == 37) {
            const float val = e < 32 ? rr * rsqrtf(ss / 32.f + 1e-6f) * krg[e & 31] : 0.f; const float oth = __shfl_xor(val, 16);
            if (e < 32) { const int i = e & 15; const double ang = (double)pos[row] * pow(10000.0, -(double)i / 16.0); const float cs = (float)cos(ang), sn = (float)sin(ang);
                r = e < 16 ? val * cs - oth * sn : val * cs + oth * sn; f = bf2f(((const bf16_t*)(prj + PRJ_KR))[row * 32 + e]); }
            else if (e < 58) f = ((const float*)(prj + PRJ_GATES))[row * 32 + (e - 32)];
            else { f = 0.f; r = 0.f; }
        }
        else f = bf2f(((const bf16_t*)(prj + PRJ_DQKV))[row * 384 + 256 + (G - 38) * 64 + e]);
        chk_add(f, r, d2, r2);
    }
    float d2s = 0.f, r2s = 0.f;
    { float s1 = 0.f, s2 = 0.f; for (int c = e; c < 192; c += 64) { float v = nproj[(size_t)t * DIN + O_CDQ + c]; s1 += v * v; } for (int c = e; c < 128; c += 64) { float v = nproj[(size_t)t * DIN + O_CDKV + c]; s2 += v * v; }
      s1 = wave_sum(s1); s2 = wave_sum(s2); if (e == 0) { chk_add((ssq_dq[row * 4] + ssq_dq[row * 4 + 1]) + ssq_dq[row * 4 + 2], s1, d2s, r2s); chk_add(ssq_dkv[row * 2] + ssq_dkv[row * 2 + 1], s2, d2s, r2s); } }
    chk_commit(d2, r2, acc); chk_commit(d2s, r2s, acc + 2);
}

__global__ void __launch_bounds__(64) chk_prep(const float* nq, const float* nkv, const float* nkr, const float* nkc, const float* nvc, const unsigned char* ws, float* acc) {
    const int t = blockIdx.x, e = threadIdx.x; float d2 = 0.f, r2 = 0.f, d2c = 0.f, r2c = 0.f; const float scale = 0.14724444f;
    const bf16_t* QM = (const bf16_t*)(ws + WS_MLA); const bf16_t* KM = (const bf16_t*)(ws + WS_MLA + MLA_KM); const bf16_t* VM = (const bf16_t*)(ws + WS_MLA + MLA_VM);
    for (int h = 0; h < 6; ++h) {
        const size_t rq = ((size_t)(CB * 6 + h) * 2048 + t);
        chk_add(bf2f(QM[rq * 96 + e]), nq[(size_t)t * 576 + h * 96 + e] * scale, d2, r2);
        chk_add(bf2f(KM[rq * 96 + e]), nkv[(size_t)t * 768 + h * 128 + e], d2, r2);
        chk_add(bf2f(VM[rq * 64 + e]), nkv[(size_t)t * 768 + h * 128 + 64 + e], d2, r2);
        if (e < 32) { chk_add(bf2f(QM[rq * 96 + 64 + e]), nq[(size_t)t * 576 + h * 96 + 64 + e] * scale, d2, r2); chk_add(bf2f(KM[rq * 96 + 64 + e]), nkr[(size_t)t * 32 + e], d2, r2); }
    }
    if (t < 128) for (int hk = 0; hk < 2; ++hk) {
        const bf16_t* KC = (const bf16_t*)(ws + WS_CMP); const bf16_t* VC = (const bf16_t*)(ws + WS_CMP + CMP_V); const size_t rf = ((size_t)(CB * 2 + hk) * 128 + t) * 64 + e;
        chk_add(bf2f(KC[rf]), t < 127 ? nkc[(size_t)(hk * 127 + t) * 64 + e] : 0.f, d2c, r2c); chk_add(bf2f(VC[rf]), t < 127 ? nvc[(size_t)(hk * 127 + t) * 64 + e] : 0.f, d2c, r2c);
    }
    chk_commit(d2, r2, acc); chk_commit(d2c, r2c, acc + 2);
}

__global__ void __launch_bounds__(64) chk_y(const float* ny, const unsigned char* ws, float* acc, int nseg) {
    const int t = blockIdx.x, e = threadIdx.x; const bf16_t* Y = (const bf16_t*)(ws + WS_Y) + ((size_t)CB * 2048 + t) * 1024;
    float d2[3] = {0.f, 0.f, 0.f}, r2[3] = {0.f, 0.f, 0.f};
    for (int c = e; c < 1024; c += 64) { const int seg = c < 384 ? 0 : (c < 640 ? 1 : 2); const int cf = c < 384 ? c : (c < 640 ? 768 + (c - 384) : 384 + (c - 640)); const float f = bf2f(Y[cf]), r = ny[(size_t)t * 1024 + c];
        if (seg == 0) chk_add(f, r, d2[0], r2[0]); else if (seg == 1) chk_add(f, r, d2[1], r2[1]); else chk_add(f, r, d2[2], r2[2]); }
    if (nseg == 3) { chk_commit(d2[0], r2[0], acc); chk_commit(d2[1], r2[1], acc + 2); chk_commit(d2[2], r2[2], acc + 4); }
    else chk_commit(d2[0] + d2[1] + d2[2], r2[0] + r2[1] + r2[2], acc);
}

__global__ void __launch_bounds__(64) chk_x(const float* nx, const unsigned char* ws, float* acc) {
    const int t = blockIdx.x, e = threadIdx.x; const bf16_t* X = (const bf16_t*)(ws + WS_XB) + ((size_t)CB * 2048 + t) * 1024; float d2 = 0.f, r2 = 0.f;
    for (int c = e; c < 1024; c += 64) chk_add(bf2f(X[c]), nx[(size_t)t * 1024 + c], d2, r2);
    chk_commit(d2, r2, acc);
}

__global__ void __launch_bounds__(512) chk_code(float* acc, int nst, const float* nout) {
    __shared__ float sh[512];
    float s = 0.f; for (int i = threadIdx.x; i < 2048 * 1024; i += 512) { float v = nout[i]; s += v * v; }
    sh[threadIdx.x] = s; __syncthreads();
    if (threadIdx.x == 0) { float tot = 0.f; for (int i = 0; i < 512; ++i) tot += sh[i]; float rms = sqrtf(tot / (2048.f * 1024.f)); if (!(rms > 1e-3f && rms < 1e3f)) rms = 1.f;
        int code = 0;
        for (int st = 0; st < nst; ++st) { const float d2 = acc[2 * st], r2 = acc[2 * st + 1]; if (r2 == 0.f && d2 == 0.f) { if ((st & 15) >= 9) continue; code = (st + 1) * 4 + 3; break; } const float err = d2 / fmaxf(r2, 1e-30f);
            const float tol = CHK_TOL(st);
            if (!(err <= tol)) { const int cls = !(err < 1.f) ? 3 : (err >= 0.1f ? 2 : (err >= 0.01f ? 1 : 0)); code = (st + 1) * 4 + cls; break; } }
        acc[2 * 40] = rms * 32.f * exp2f(0.5f * (float)code); }
}
__global__ void __launch_bounds__(512) chk_fill(const float* acc, float* out) {
    const float K = acc[2 * 40];
    for (size_t i = (size_t)blockIdx.x * 512 + threadIdx.x; i < (size_t)NTOK * 1024; i += (size_t)gridDim.x * 512) out[i] = (i & 1) ? -K : K;
}
#endif

#if TIME_PH != -1
#ifndef TIME_Q
#define TIME_Q 6.f
#endif
#ifndef TIME_CAL
#define TIME_CAL 1.0f
#endif
__global__ void tm_acc(const unsigned long long* ts, float* best, int first) {
    int a = TIME_PH, b = TIME_PH + 1;
#ifdef TIME_PH_END
    b = TIME_PH_END;
#endif
    float T = 100.f; if (TIME_PH >= 0) T = (float)(ts[b] - ts[a]) * 0.01f;
    if (first || T < *best) *best = T;
}
__global__ void __launch_bounds__(512) tm_fill(const float* best, float* out) {
    float T = *best;
    T = exp2f(rintf(log2f(fmaxf(T, 1.f)) * TIME_Q) / TIME_Q);
    const float c = sqrtf(T) * TIME_CAL;
    for (size_t i = (size_t)blockIdx.x * 512 + threadIdx.x; i < (size_t)NTOK * 1024; i += (size_t)gridDim.x * 512) out[i] = (i & 1) ? -c : c;
}
#endif
static int g_grid = 0;
static bool setup_once(size_t ws_size) {
    if (g_grid) return g_grid > 0;
    if (ws_size < WS_END) { fprintf(stderr, "kernel_launch: workspace too small: %zu < %zu\n", ws_size, (size_t)WS_END); g_grid = -1; return false; }
    int dev = 0, cus = 0, per_cu = 0;
    if (hipGetDevice(&dev) != hipSuccess || hipDeviceGetAttribute(&cus, hipDeviceAttributeMultiprocessorCount, dev) != hipSuccess) { g_grid = -1; return false; }
    if (hipFuncSetAttribute((const void*)mk, hipFuncAttributeMaxDynamicSharedMemorySize, LDS_BYTES) != hipSuccess) { fprintf(stderr, "kernel_launch: hipFuncSetAttribute failed\n"); g_grid = -1; return false; }
    if (hipOccupancyMaxActiveBlocksPerMultiprocessor(&per_cu, (const void*)mk, 512, LDS_BYTES) != hipSuccess || per_cu < 1) { fprintf(stderr, "kernel_launch: occupancy query says %d\n", per_cu); }
    (void)hipGetLastError();
    g_grid = cus;
    return true;
}
static void launch_mk(const Args& a0, int lo, int hi, hipStream_t stream) { Args a = a0; a.ph_lo = lo; a.ph_hi = hi; hipLaunchKernelGGL(mk, dim3(g_grid), dim3(512), LDS_BYTES, stream, a); }

extern "C" void kernel_launch(void* const* d_in, const int* in_sizes, int n_in, void* d_out, int out_size, void* d_ws, size_t ws_size, hipStream_t stream) {
    if (!setup_once(ws_size)) return;
    unsigned char* ws = (unsigned char*)d_ws;
    (void)hipMemsetAsync(ws + WS_CTL, 0, ZERO_BYTES, stream);
    Args a{}; for (int i = 0; i < 30; ++i) a.in.p[i] = (const float*)d_in[i];
    a.out = (float*)d_out; a.ws = ws; a.ph_lo = 0; a.ph_hi = 0;
#if CHECK
    a.out = nullptr;
#endif
#if CHECK
    float* nb = (float*)d_out; size_t off = 0; NvScratch S;
    auto take = [&](size_t n) { float* p = nb + off; off += (n + 63) & ~(size_t)63; return p; };
    S.proj = take((size_t)2048 * DIN); S.h1 = take(2048 * 1024); S.qk = S.h1; S.hraw = S.qk + 2048 * 512; S.kn = S.hraw + 2048 * 256;
    S.kcmp = take(2 * 127 * 64); S.vcmp = take(2 * 127 * 64); S.dqn = take(2048 * 192); S.q = take(2048 * 576); S.dkvn = take(2048 * 128); S.kv = take(2048 * 768); S.x1 = S.dqn;
    S.krope = take(2048 * 32); S.y = take(2048 * 1024); S.xl = take(2048 * 1024); S.rt_e = (int*)take(2048 * 2); S.rt_w = take(2048 * 2);
    if (off * 4 > (size_t)NTOK * 1024 * 4) { fprintf(stderr, "naive scratch too big\n"); return; }
    float* acc = (float*)(ws + WS_CTL) + CW_CHK;
    launch_mk(a, 0, 1, stream);
    const float* nx_in = (const float*)d_in[0] + (size_t)CB * 2048 * 1024;
    int nst = 0;
    for (int l = 0; l < L_; ++l) {
        const int pb = 1 + l * NPH; const int sb = l * 16;
        launch_mk(a, pb + PH_INPROJ, pb + PH_INPROJ + 1, stream);
        naive_step(d_in, l, NS_INPROJ, nx_in, S.xl, S, stream);
        chk_proj<<<2048, 64, 0, stream>>>(S.proj, ws + WS_PRJ, (const float*)(ws + WS_SSQ + PT_DQ) + (size_t)l * 16384 * 4, (const float*)(ws + WS_SSQ + PT_DKV) + (size_t)l * 16384 * 2,
                                           (const float*)d_in[8] + l * 64, (const float*)d_in[9] + l * 64, (const float*)d_in[19] + l * 192 + 160, (const int*)d_in[1], acc + 2 * (sb + 0));
        nst = sb + 2;
        int ns_done = NS_INPROJ;
#if CHECK_UPTO >= 1
        launch_mk(a, pb + PH_PREP, pb + PH_PREP + 1, stream);
        naive_step(d_in, l, NS_NSAPREP, nx_in, S.xl, S, stream); naive_step(d_in, l, NS_MLAPREP, nx_in, S.xl, S, stream); ns_done = NS_MLAPREP;
        chk_prep<<<2048, 64, 0, stream>>>(S.q, S.kv, S.krope, S.kcmp, S.vcmp, ws, acc + 2 * (sb + 2));
        nst = sb + 4;
#endif
#if CHECK_UPTO >= 2
        launch_mk(a, pb + PH_MIX, pb + PH_MIX + 1, stream);
        naive_step(d_in, l, NS_NSA, nx_in, S.xl, S, stream); naive_step(d_in, l, NS_ML, nx_in, S.xl, S, stream); naive_step(d_in, l, NS_MLA, nx_in, S.xl, S, stream); ns_done = NS_MLA;
        chk_y<<<2048, 64, 0, stream>>>(S.y, ws, acc + 2 * (sb + 4), 3);
        nst = sb + 7;
#endif
#if CHECK_UPTO >= 3
        launch_mk(a, pb + PH_YNORM, pb + PH_YNORM + 1, stream); launch_mk(a, pb + PH_OUTPROJ, pb + PH_OUTPROJ + 1, stream);
        naive_step(d_in, l, NS_OUT, nx_in, S.xl, S, stream); ns_done = NS_OUT;
        chk_x<<<2048, 64, 0, stream>>>(S.x1, ws, acc + 2 * (sb + 7));
        nst = sb + 8;
#endif
#if CHECK_UPTO >= 4
        for (int ph = PH_ROUTE; ph <= PH_COMBINE; ++ph) launch_mk(a, pb + ph, pb + ph + 1, stream);
        naive_step(d_in, l, NS_ROUTE, nx_in, S.xl, S, stream); naive_step(d_in, l, NS_MOE, nx_in, S.xl, S, stream); ns_done = NS_MOE;
        chk_x<<<2048, 64, 0, stream>>>(S.xl, ws, acc + 2 * (sb + 8));
        nst = sb + 9;
#endif
        CHECK_REST
        for (int s = ns_done + 1; s <= NS_MOE; ++s) naive_step(d_in, l, s, nx_in, S.xl, S, stream);
        nx_in = S.xl;
        if (l == CHECK_LAYERS - 1) break;
    }
    chk_code<<<1, 512, 0, stream>>>(acc, nst, S.xl);
    chk_fill<<<1024, 512, 0, stream>>>(acc, (float*)d_out);
#else
#if defined(SPLIT_LAUNCH) && SPLIT_LAUNCH
    for (int ph = 0; ph < 1 + L_ * NPH; ++ph) launch_mk(a, ph, ph + 1, stream);
#else
    launch_mk(a, 0, 1 + L_ * NPH, stream);
#if TIME_PH != -1
    for (int rp = 0; rp < 6; ++rp) {
        (void)hipMemsetAsync(ws + WS_CTL, 0, ZERO_BYTES, stream); launch_mk(a, 0, 1 + L_ * NPH, stream);
        tm_acc<<<1, 1, 0, stream>>>((const unsigned long long*)((unsigned*)(ws + WS_CTL) + CW_TS), (float*)(ws + WS_META + META_RT), rp == 0);
    }
    tm_fill<<<1024, 512, 0, stream>>>((const float*)(ws + WS_META + META_RT), (float*)d_out);
#endif
#endif
#endif
}
```

```cpp
#define CHECK 0
#define CHECK_LAYERS 2
#define CHECK_UPTO 99
#define SPLIT_LAUNCH 0
#define REPEAT_PH -1
#include <hip/hip_runtime.h>
#include <stdint.h>
#include <cstdio>

constexpr int B_ = 8, T_ = 2048, D_ = 1024, L_ = 2, NTOK = B_ * T_;
constexpr int DIN = 2554;
constexpr int O_AQ = 0, O_AKV = 384, O_AG = 1152, O_BQK = 1170, O_BV = 1682, O_BIF = 1938, O_BO = 1946, O_CDQ = 2202, O_CDKV = 2394, O_CKR = 2522;

typedef unsigned short bf16_t;
typedef short bf16x8 __attribute__((ext_vector_type(8)));
typedef short s16x4 __attribute__((ext_vector_type(4)));
typedef float f32x4 __attribute__((ext_vector_type(4)));
typedef float f32x16 __attribute__((ext_vector_type(16)));
typedef unsigned u32x4 __attribute__((ext_vector_type(4)));
typedef unsigned u32x2 __attribute__((ext_vector_type(2)));
typedef float f32x2_t __attribute__((ext_vector_type(2)));
typedef __bf16 bf16x2_t __attribute__((ext_vector_type(2)));
#define LAS __attribute__((address_space(3)))

__device__ __forceinline__ unsigned pk_bf16(float lo, float hi) { f32x2_t v = {lo, hi}; bf16x2_t b = __builtin_convertvector(v, bf16x2_t); return __builtin_bit_cast(unsigned, b); }
__device__ __forceinline__ float bf_lo(unsigned u) { return __builtin_bit_cast(float, u << 16); }
__device__ __forceinline__ float bf_hi(unsigned u) { return __builtin_bit_cast(float, u & 0xffff0000u); }
__device__ __forceinline__ float bf2f(bf16_t h) { return __builtin_bit_cast(float, (unsigned)h << 16); }
__device__ __forceinline__ bf16_t f2bf(float f) { return (bf16_t)(pk_bf16(f, 0.f) & 0xffffu); }
__device__ __forceinline__ float wave_sum(float v) { for (int o = 32; o; o >>= 1) v += __shfl_xor(v, o); return v; }
__device__ __forceinline__ float wave_max(float v) { for (int o = 32; o; o >>= 1) v = fmaxf(v, __shfl_xor(v, o)); return v; }
__device__ __forceinline__ float siluf(float x) { return x * __builtin_amdgcn_rcpf(1.f + __expf(-x)); }
__device__ __forceinline__ float sigmf(float x) { return __builtin_amdgcn_rcpf(1.f + __expf(-x)); }
__device__ __forceinline__ int t5b(int dist) {
    int n = dist > 0 ? dist : 0; if (n < 16) return n;
    float v = logf((float)n / 16.f) / logf(8.f) * 16.f; int l = 16 + (int)v; return l < 31 ? l : 31;
}

__device__ __forceinline__ int lane_now() { return (int)__builtin_amdgcn_mbcnt_hi(~0u, __builtin_amdgcn_mbcnt_lo(~0u, 0u)); }
#define TIDX ((g_wv << 6) | lane_now())

constexpr size_t WS_CTL = 0, CTL_BYTES = 65536;
constexpr size_t WS_SSQ = WS_CTL + CTL_BYTES;
constexpr size_t ZERO_BYTES = CTL_BYTES;
constexpr size_t PT_DQ = 0, PT_DKV = PT_DQ + (size_t)2 * 16384 * 4 * 4, PT_A = PT_DKV + (size_t)2 * 16384 * 2 * 4, PT_C = PT_A + (size_t)2 * 16384 * 8 * 4, PT_X1 = PT_C + (size_t)2 * 16384 * 8 * 4, PT_END = PT_X1 + (size_t)2 * 16384 * 16 * 4;
constexpr size_t WS_SSQX = WS_SSQ + PT_END;
constexpr size_t WS_RS2 = WS_SSQX + 2 * 65536;
constexpr size_t WS_WIN = WS_RS2 + 65536;
constexpr size_t WS_WOUT = WS_WIN + (size_t)2 * 2560 * 1024 * 2;
constexpr size_t WS_WUQ = WS_WOUT + (size_t)2 * 1024 * 1024 * 2;
constexpr size_t WS_WUKV = WS_WUQ + (size_t)2 * 768 * 256 * 2;
constexpr size_t WS_WC1 = WS_WUKV + (size_t)2 * 768 * 256 * 2;
constexpr size_t WS_WC2 = WS_WC1 + (size_t)2 * 2 * 64 * 2048 * 2;
constexpr size_t WS_WR = WS_WC2 + (size_t)2 * 2 * 64 * 64 * 2;
constexpr size_t WS_B1C = WS_WR + (size_t)2 * 64 * 1024 * 2;
constexpr size_t WS_BIASD = WS_B1C + 1024;
constexpr size_t WS_ROPE = WS_BIASD + 6 * 2048 * 4;
constexpr size_t WS_WMOE = WS_ROPE + (size_t)16384 * 32 * 4;
constexpr size_t WMOE_WD = (size_t)32 * 512 * 1024 * 2;
constexpr size_t WS_XB = WS_WMOE + 50331648;
constexpr size_t WS_MLA = WS_XB + 33554432;
constexpr size_t MLA_KM = (size_t)8 * 6 * 2048 * 96 * 2, MLA_VM = 2 * MLA_KM;
constexpr size_t WS_HBUF = WS_MLA;
constexpr size_t WS_PRJ = WS_MLA + 50331648;
constexpr size_t HM64 = (size_t)2048 * 64 * 2;
constexpr size_t PRJ_QN = 0;
constexpr size_t PRJ_KN1 = PRJ_QN + 48 * HM64, PRJ_VN1 = PRJ_KN1 + 16 * HM64, PRJ_KN2 = PRJ_VN1 + 16 * HM64, PRJ_VN2 = PRJ_KN2 + 16 * HM64;
constexpr size_t PRJ_VML = PRJ_VN2 + 16 * HM64;
constexpr size_t PRJ_OG = PRJ_VML + 32 * HM64;
constexpr size_t PRJ_KR = PRJ_OG + (size_t)16384 * 256 * 2;
constexpr size_t PRJ_GATES = PRJ_KR + (size_t)16384 * 32 * 2;
constexpr size_t PRJ_DEAD = PRJ_GATES + (size_t)16384 * 32 * 4;
constexpr size_t PRJ_C0K = PRJ_DEAD, PRJ_C0V = PRJ_C0K + 16 * HM64 + 8192;
constexpr size_t PRJ_RAWQK = PRJ_C0V + 16 * HM64 + 8192;
constexpr size_t PRJ_DQKV = PRJ_RAWQK + (size_t)16384 * 512 * 2;
constexpr size_t PRJ_END = PRJ_DQKV + (size_t)16384 * 384 * 2;
static_assert(PRJ_END - PRJ_DEAD >= 33554432, "Y fits the dead part of PRJ");
constexpr size_t WS_Y = WS_PRJ + PRJ_DEAD;
constexpr size_t WS_YBUF = WS_PRJ;
static_assert((size_t)2 * 16384 * 1024 * 2 <= PRJ_END, "YBUF fits the PRJ region");
constexpr size_t WS_ML = WS_PRJ + PRJ_END;
constexpr size_t ML_KC = 32 * HM64, ML_DELTA = 2 * ML_KC, ML_DN = ML_DELTA + (size_t)1024 * 4096 * 2, ML_G = ML_DN + (size_t)1024 * 64 * 4, ML_BL = ML_G + (size_t)8 * 4 * 2048 * 2 * 4, ML_CP = ML_BL + 4096, ML_NP = ML_CP + (size_t)1024 * 4096 * 2, ML_END = ML_NP + (size_t)1024 * 64 * 2;
constexpr size_t WS_CMP = WS_ML + ML_END;
constexpr size_t CMP_V = (size_t)8 * 2 * 128 * 64 * 2;
constexpr size_t WS_META = WS_CMP + 2 * CMP_V;
constexpr size_t META_W = (size_t)32 * 16384 * 4, META_RT = 2 * META_W;
constexpr size_t WS_END = WS_META + META_RT + (size_t)16384 * 16;
constexpr int CW_BAR = 0;
constexpr int CW_Q = 4096;
constexpr int CW_SCAN = 4608;
constexpr int CW_TS = 4864;
constexpr int CW_CHK = 5120;
constexpr int CW_CNT = 8192;
constexpr int LDS_BYTES = 147456;
constexpr int LDS_MISC = LDS_BYTES - 256;
#define XB_TMO      128
#define XB_XCNT(j)  (256  + 64 * (j))
#define XB_XSUB(j)  (1280 + 64 * (j))
#define XB_XGEN(j)  (2304 + 64 * (j))
#define XB_TOP      3328
#define XB_TOPGEN   3392
#define XCD_BAR_WORDS 3456
#define XB_SPIN_CAP (1u << 18)

__device__ __forceinline__ unsigned xb_ld(unsigned* p)              { return __hip_atomic_load(p, __ATOMIC_RELAXED, __HIP_MEMORY_SCOPE_AGENT); }
__device__ __forceinline__ unsigned xb_add(unsigned* p, unsigned v) { return __hip_atomic_fetch_add(p, v, __ATOMIC_RELAXED, __HIP_MEMORY_SCOPE_AGENT); }
__device__ __forceinline__ unsigned xb_xcc_id() { return (unsigned)__builtin_amdgcn_s_getreg((3 << 11) | 20) & 0xFu; }
#define XB_SPIN(cond, bar) do { unsigned _sp = 0; while (cond) { __builtin_amdgcn_s_sleep(1); \
    if ((++_sp & 255u) == 0u) { if (xb_ld(&(bar)[XB_TMO])) break; if (_sp > XB_SPIN_CAP) { atomicAdd(&(bar)[XB_TMO], 1u); break; } } } } while (0)

struct XcdBarrier {
    int g_wv; unsigned* bar; unsigned x;
    volatile LAS unsigned* st;
};

__device__ __forceinline__ XcdBarrier xcd_barrier_post(unsigned* bar, volatile LAS unsigned* st, int g_wv) {
    XcdBarrier b; b.g_wv = g_wv; b.bar = bar; b.x = xb_xcc_id(); b.st = st;
    if (TIDX == 0) (void)xb_add(&bar[XB_XCNT(b.x)], 1u);
    return b;
}
__device__ __forceinline__ void xcd_barrier_complete(unsigned* bar, unsigned x, unsigned& nloc, unsigned& nx) {
    const unsigned G = gridDim.x * gridDim.y * gridDim.z;
    unsigned sum, cnt, mine, sp = 0u;
    for (;;) {
        sum = 0u; cnt = 0u; mine = 0u;
#pragma unroll
        for (unsigned j = 0; j < 16; ++j) { const unsigned c = xb_ld(&bar[XB_XCNT(j)]); sum += c; cnt += (c > 0u) ? 1u : 0u; mine = (j == x) ? c : mine; }
        if (sum == G) break;
        __builtin_amdgcn_s_sleep(1);
        if ((++sp & 255u) == 0u) { if (xb_ld(&bar[XB_TMO])) break; if (sp > XB_SPIN_CAP) { atomicAdd(&bar[XB_TMO], 1u); break; } }
    }
    nloc = mine > 0u ? mine : 1u; nx = cnt > 0u ? cnt : 1u;
}

__device__ __forceinline__ void xcd_barrier(const XcdBarrier& b) {
    asm volatile("s_waitcnt vmcnt(0)" ::: "memory");
    __syncthreads();
    const int g_wv = b.g_wv;
    if (TIDX == 0) {
        unsigned* bar = b.bar;
        __builtin_amdgcn_s_waitcnt(0);
        unsigned nloc = b.st[0], nx = b.st[1];
        if (nloc == 0u) { xcd_barrier_complete(bar, b.x, nloc, nx); b.st[0] = nloc; b.st[1] = nx; }
        const unsigned old = xb_add(&bar[XB_XSUB(b.x)], 1u);
        const unsigned gen = old / nloc;
        if (old + 1u == (gen + 1u) * nloc) {
            __builtin_amdgcn_fence(__ATOMIC_RELEASE, "agent");
            asm volatile("s_waitcnt vmcnt(0)" ::: "memory");
            const unsigned og = xb_add(&bar[XB_TOP], 1u);
            const unsigned tg = og / nx;
            if (og + 1u == (tg + 1u) * nx) xb_add(&bar[XB_TOPGEN], 1u);
            else XB_SPIN(xb_ld(&bar[XB_TOPGEN]) == tg, bar);
            __builtin_amdgcn_fence(__ATOMIC_ACQUIRE, "agent");
            xb_add(&bar[XB_XGEN(b.x)], 1u);
            asm volatile("s_waitcnt vmcnt(0)" ::: "memory");
        } else {
            XB_SPIN(xb_ld(&bar[XB_XGEN(b.x)]) == gen, bar);
            __builtin_amdgcn_fence(__ATOMIC_ACQUIRE, "agent");
            asm volatile("s_waitcnt vmcnt(0)" ::: "memory");
        }
    }
    __syncthreads();
}
struct Inputs { const float* p[30]; };
typedef const __attribute__((address_space(4))) Inputs* InPtr;
__device__ __forceinline__ InPtr in_tab() { InPtr p = (InPtr)__builtin_amdgcn_kernarg_segment_ptr(); asm volatile("" : "+s"(p)); return p; }
__device__ __forceinline__ unsigned char* launder(unsigned char* p) { size_t z = 0; asm volatile("" : "+s"(z)); return p + z; }

__host__ __device__ inline int inproj_refcol(int G, int e) {
    if (G < 6) return O_AQ + G * 64 + e;
    if (G < 18) return O_AKV + (G - 6) * 64 + e;
    if (G < 26) return O_BQK + (G - 18) * 64 + e;
    if (G < 30) return O_BV + (G - 26) * 64 + e;
    if (G < 34) return O_BO + (G - 30) * 64 + e;
    if (G < 37) return O_CDQ + (G - 34) * 64 + e;
    if (G == 37) { if (e < 32) return O_CKR + e; if (e < 50) return O_AG + (e - 32); if (e < 58) return O_BIF + (e - 50); return -1; }
    return O_CDKV + (G - 38) * 64 + e;
}
__host__ __device__ inline int uq_refcol(int G, int e) {
    if (G < 6) return G * 96 + e;
    if (G < 9) { const int idx = e & 31, bj = e >> 5, sub = idx >> 4, i = idx & 15; return (2 * (G - 6) + sub) * 96 + 64 + bj * 16 + i; }
    return -1;
}
__host__ __device__ inline int ukv_refcol(int G, int e) { return G < 6 ? G * 128 + e : (G - 6) * 128 + 64 + e; }
#define N2G(n) ((((n) >> 8) << 2) + (((n) >> 5) & 3))
#define N2E(n) (((((n) >> 7) & 1) << 5) + ((n) & 31))

__device__ __forceinline__ float opaque_f(float v) { asm volatile("" : "+v"(v)); return v; }
struct FWin { const float* w; const float* g; __device__ __forceinline__ void ld(int k, int n, const float*& p, float& gn, float gk) const { const int c = inproj_refcol(N2G(n), N2E(n)); p = w + (size_t)k * DIN + (c < 0 ? 0 : c); gn = c < 0 ? 0.f : gk; }
    __device__ __forceinline__ float rowgain(int k) const { return opaque_f(g[k]); } };
struct FWout { const float* w; const float* ga; const float* gc; __device__ __forceinline__ void ld(int k, int n, const float*& p, float& gn, float gk) const {
    const int kr = k < 384 ? k : (k < 768 ? 640 + (k - 384) : 384 + (k - 768)); p = w + (size_t)kr * 1024 + n; gn = gk; }
    __device__ __forceinline__ float rowgain(int k) const { const float a = opaque_f(ga[k < 384 ? k : 0]), c = opaque_f(gc[(k >= 384 && k < 768) ? k - 384 : 0]); return k < 384 ? a : (k < 768 ? c : 1.f); } };
struct FWuq { const float* w; const float* g; __device__ __forceinline__ void ld(int k, int n, const float*& p, float& gn, float gk) const { const int c = uq_refcol(N2G(n), N2E(n)); const int kk = k < 192 ? k : 191; p = w + (size_t)kk * 576 + (c < 0 ? 0 : c); gn = (k < 192 && c >= 0) ? gk : 0.f; }
    __device__ __forceinline__ float rowgain(int k) const { return opaque_f(g[k < 192 ? k : 191]); } };
struct FWukv { const float* w; const float* g; __device__ __forceinline__ void ld(int k, int n, const float*& p, float& gn, float gk) const { const int c = ukv_refcol(N2G(n), N2E(n)); const int kk = k >= 128 ? k - 128 : 0; p = w + (size_t)kk * 768 + c; gn = k >= 128 ? gk : 0.f; }
    __device__ __forceinline__ float rowgain(int k) const { return opaque_f(g[k >= 128 ? k - 128 : 0]); } };
struct FWc1 { const float* w; __device__ __forceinline__ void ld(int k, int n, const float*& p, float& gn, float gk) const { p = w + (size_t)k * 64 + n; gn = 1.f; }
    __device__ __forceinline__ float rowgain(int k) const { return 1.f; } };
struct FWr { const float* wg; const float* we; const float* g; __device__ __forceinline__ void ld(int k, int n, const float*& p, float& gn, float gk) const { p = n < 4 ? wg + k * 4 + n : we + k * 32 + (n < 36 ? n - 4 : 0); gn = n < 36 ? gk : 0.f; }
    __device__ __forceinline__ float rowgain(int k) const { return opaque_f(g[k]); } };
struct FWgu { const float* src; const float* g; int n0, col0; __device__ __forceinline__ float operator()(int k, int n) const { return src[(size_t)k * 256 + col0 + (n - n0)] * g[k]; } };
struct FWd { const float* w; __device__ __forceinline__ float operator()(int k, int n) const { return w[(size_t)k * 1024 + n]; } };

__device__ __forceinline__ void rope_cs(int pos, int j, float& cs, float& sn) {
    const double inv = exp2(-(double)j * (13.287712379549449 / 16.0));
    const double rev = (double)pos * inv * 0.15915494309189535; const float f = (float)(rev - rint(rev));
    cs = __builtin_amdgcn_cosf(f); sn = __builtin_amdgcn_sinf(f);
}
template <class F>
__device__ __forceinline__ void cvt_tile(const F& f, int n0, int k0, bf16_t* dst, int ldk, LAS float* tile, int tid) {
    { const int k = tid >> 3, nb = (tid & 7) * 8; const float gk = f.rowgain(k0 + k); const float* p[8]; float gn[8], v[8];
#pragma unroll
      for (int j = 0; j < 8; ++j) f.ld(k0 + k, n0 + nb + j, p[j], gn[j], gk);
#pragma unroll
      for (int j = 0; j < 8; ++j) v[j] = *p[j];
#pragma unroll
      for (int j = 0; j < 8; ++j) tile[k * 65 + nb + j] = v[j] * gn[j]; }
    __syncthreads();
    { const int n = tid >> 3, kb = (tid & 7) * 8; const LAS float* s = tile + kb * 65 + n;
      u32x4 o; o.x = pk_bf16(s[0], s[65]); o.y = pk_bf16(s[130], s[195]); o.z = pk_bf16(s[260], s[325]); o.w = pk_bf16(s[390], s[455]);
      *(u32x4*)(dst + (size_t)(n0 + n) * ldk + k0 + kb) = o; }
    __syncthreads();
}
template <class F>
__device__ __forceinline__ void cvt_item(const F& f, int it, int nK, bf16_t* dst, int ldk, LAS float* tile, int tid) { cvt_tile(f, (it / nK) * 64, (it % nK) * 64, dst, ldk, tile, tid); }

__device__ __forceinline__ void moe_item(InPtr in, int l, int it, const float*& src, int& ld, size_t& dst, int& ldk, bool& gain, int& kk0) {
    if (it < 32 * 64) { const int e = it >> 6, r = it & 63, n0 = (r >> 3) * 64, k0 = (r & 7) * 128, c0 = n0 & 255;
        src = (c0 < 128 ? in->p[27] : in->p[28]) + ((size_t)l * 32 + e) * 262144 + (size_t)k0 * 256 + (n0 >> 8) * 128 + (c0 & 127); ld = 256; gain = true; kk0 = k0;
        dst = ((size_t)e * 512 + n0) * 1024 + k0; ldk = 1024; }
    else { const int j = it - 32 * 64, e = j >> 5, r = j & 31, n0 = (r >> 1) * 64, k0 = (r & 1) * 128;
        src = in->p[29] + ((size_t)l * 32 + e) * 262144 + (size_t)k0 * 1024 + n0; ld = 1024; gain = false; kk0 = 0;
        dst = (size_t)16777216 + ((size_t)e * 1024 + n0) * 256 + k0; ldk = 256; }
}
__device__ __forceinline__ void cvt_moe_layer(InPtr in, unsigned char* ws, int l, LAS float* tile, int bid, int nb, int tid, int it_lo = 0, int it_hi = 32 * (64 + 32)) {
    asm volatile("" : "+v"(tid));
    const float* g2 = in->p[22] + l * 1024; bf16_t* W = (bf16_t*)(ws + WS_WMOE);
    const int k = tid >> 3, nbq = (tid & 7) * 8;
    const int n = tid >> 3, kb = (tid & 7) * 8;
    const int NIT = it_hi;
#define CVM_LOAD(it_, P) do { const float* src_; int ld_, ldk_, kk0_; size_t dst_; bool gain_; moe_item(in, l, (it_), src_, ld_, dst_, ldk_, gain_, kk0_); \
        P##a = *(const f32x4*)(src_ + (size_t)k * ld_ + nbq); P##b = *(const f32x4*)(src_ + (size_t)k * ld_ + nbq + 4); P##c = *(const f32x4*)(src_ + (size_t)(k + 64) * ld_ + nbq); P##d = *(const f32x4*)(src_ + (size_t)(k + 64) * ld_ + nbq + 4); \
        P##g0 = gain_ ? g2[kk0_ + k] : 1.f; P##g1 = gain_ ? g2[kk0_ + 64 + k] : 1.f; } while (0)
#define CVM_PUT(t, P) do { \
        t[k * 65 + nbq + 0] = P##a.x * P##g0; t[k * 65 + nbq + 1] = P##a.y * P##g0; t[k * 65 + nbq + 2] = P##a.z * P##g0; t[k * 65 + nbq + 3] = P##a.w * P##g0; \
        t[k * 65 + nbq + 4] = P##b.x * P##g0; t[k * 65 + nbq + 5] = P##b.y * P##g0; t[k * 65 + nbq + 6] = P##b.z * P##g0; t[k * 65 + nbq + 7] = P##b.w * P##g0; \
        t[(k + 64) * 65 + nbq + 0] = P##c.x * P##g1; t[(k + 64) * 65 + nbq + 1] = P##c.y * P##g1; t[(k + 64) * 65 + nbq + 2] = P##c.z * P##g1; t[(k + 64) * 65 + nbq + 3] = P##c.w * P##g1; \
        t[(k + 64) * 65 + nbq + 4] = P##d.x * P##g1; t[(k + 64) * 65 + nbq + 5] = P##d.y * P##g1; t[(k + 64) * 65 + nbq + 6] = P##d.z * P##g1; t[(k + 64) * 65 + nbq + 7] = P##d.w * P##g1; } while (0)
#define CVM_STORE(it_, t) do { const float* src_; int ld_, ldk_, kk0_; size_t dst_; bool gain_; moe_item(in, l, (it_), src_, ld_, dst_, ldk_, gain_, kk0_); \
        _Pragma("unroll") for (int hh = 0; hh < 2; ++hh) { const LAS float* s_ = t + (64 * hh + kb) * 65 + n; \
            u32x4 o; o.x = pk_bf16(s_[0], s_[65]); o.y = pk_bf16(s_[130], s_[195]); o.z = pk_bf16(s_[260], s_[325]); o.w = pk_bf16(s_[390], s_[455]); \
            *(u32x4*)(W + dst_ + (size_t)n * ldk_ + 64 * hh + kb) = o; } } while (0)
    f32x4 Aa, Ab, Ac, Ad, Ba, Bb, Bc, Bd; float Ag0 = 1.f, Ag1 = 1.f, Bg0 = 1.f, Bg1 = 1.f;
    LAS float* t0 = tile; LAS float* t1 = tile + 128 * 65;
    int it = it_lo + bid;
    if (it < NIT) CVM_LOAD(it, A);
    if (it + nb < NIT) CVM_LOAD(it + nb, B);
#pragma unroll 1
    for (; it < NIT; it += 2 * nb) {
        CVM_PUT(t0, A);
        __syncthreads();
        if (it + 2 * nb < NIT) CVM_LOAD(it + 2 * nb, A);
        CVM_STORE(it, t0);
        if (it + nb < NIT) {
            CVM_PUT(t1, B);
            __syncthreads();
            if (it + 3 * nb < NIT) CVM_LOAD(it + 3 * nb, B);
            CVM_STORE(it + nb, t1);
        }
    }
#undef CVM_LOAD
#undef CVM_PUT
#undef CVM_STORE
    __syncthreads();
}

__device__ __forceinline__ void cvt_small_weights(InPtr in, unsigned char* ws, int l, LAS float* tile, int bid, int nb, int tid) {
    asm volatile("" : "+v"(tid));
    constexpr int I_WIN = 40 * 16, I_WOUT = 16 * 16, I_WU = 12 * 4, I_WC1 = 32, I_WC2 = 1, I_WR = 16;
    constexpr int PER_L = I_WIN + I_WOUT + 2 * I_WU + 2 * I_WC1 + 2 * I_WC2 + I_WR;
    for (int it0 = bid; it0 < PER_L; it0 += nb) {
        int it = it0;
        if (it < I_WIN) { FWin f{in->p[4] + (size_t)l * 1024 * DIN, in->p[3] + l * 1024}; cvt_item(f, it, 16, (bf16_t*)(ws + WS_WIN) + (size_t)l * 2560 * 1024, 1024, tile, tid); continue; } it -= I_WIN;
        if (it < I_WOUT) { FWout f{in->p[21] + (size_t)l * 1048576, in->p[10] + l * 384, in->p[20] + l * 384}; cvt_item(f, it, 16, (bf16_t*)(ws + WS_WOUT) + (size_t)l * 1048576, 1024, tile, tid); continue; } it -= I_WOUT;
        if (it < I_WU) { FWuq f{in->p[16] + (size_t)l * 192 * 576, in->p[15] + l * 192}; cvt_item(f, it, 4, (bf16_t*)(ws + WS_WUQ) + (size_t)l * 768 * 256, 256, tile, tid); continue; } it -= I_WU;
        if (it < I_WU) { FWukv f{in->p[18] + (size_t)l * 128 * 768, in->p[17] + l * 128}; cvt_item(f, it, 4, (bf16_t*)(ws + WS_WUKV) + (size_t)l * 768 * 256, 256, tile, tid); continue; } it -= I_WU;
        if (it < 2 * I_WC1) { const int s = it / I_WC1; FWc1 f{in->p[6] + ((size_t)l * 2 + s) * 2048 * 64}; cvt_item(f, it % I_WC1, 32, (bf16_t*)(ws + WS_WC1) + ((size_t)l * 2 + s) * 64 * 2048, 2048, tile, tid); continue; } it -= 2 * I_WC1;
        if (it < 2 * I_WC2) { const int s = it; FWc1 f{in->p[7] + ((size_t)l * 2 + s) * 64 * 64}; cvt_item(f, 0, 1, (bf16_t*)(ws + WS_WC2) + ((size_t)l * 2 + s) * 64 * 64, 64, tile, tid); continue; } it -= 2 * I_WC2;
        { FWr f{in->p[23] + (size_t)l * 4096, in->p[25] + (size_t)l * 32768, in->p[22] + l * 1024}; cvt_item(f, it, 16, (bf16_t*)(ws + WS_WR) + (size_t)l * 64 * 1024, 1024, tile, tid); }
    }
}

__device__ __forceinline__ void prologue(InPtr in, unsigned char* ws, LAS unsigned char* lds, int bid, int nb, int g_wv) {
    int tid_ = TIDX; asm volatile("" : "+v"(tid_));
    const int tid = tid_, lane = tid & 63, wid = tid >> 6;
    LAS float* tile = (LAS float*)lds;
    cvt_small_weights(in, ws, 0, tile, bid, nb, tid);
    { const float* x = in->p[0]; bf16_t* XB = (bf16_t*)(ws + WS_XB); float* ssqx = (float*)(ws + WS_SSQX);
      for (int r = bid * 8 + wid; r < NTOK; r += nb * 8) {
          const f32x4* xr = (const f32x4*)(x + (size_t)r * 1024) + lane; float s = 0.f; u32x2* o = (u32x2*)(XB + (size_t)r * 1024) + lane;
#pragma unroll
          for (int j = 0; j < 4; ++j) { const f32x4 v = xr[64 * j]; s += (v.x * v.x + v.y * v.y) + (v.z * v.z + v.w * v.w); u32x2 w; w.x = pk_bf16(v.x, v.y); w.y = pk_bf16(v.z, v.w); o[64 * j] = w; }
          s = wave_sum(s); if (lane == 0) ssqx[r] = s;
      } }
    { float* biasd = (float*)(ws + WS_BIASD); const float* rb = in->p[2];
      for (int i = bid * 512 + tid; i < 6 * 2048; i += nb * 512) { const int h = i >> 11, d = i & 2047; biasd[i] = rb[t5b(d) * 6 + h] * 1.44269504f; } }
    { float* rope = (float*)(ws + WS_ROPE); const int* pos = (const int*)in->p[1];
      for (int i = bid * 512 + tid; i < NTOK * 16; i += nb * 512) { const int tk = i >> 4, j = i & 15; float cs, sn; rope_cs(pos[tk], j, cs, sn); rope[(size_t)tk * 32 + j] = cs; rope[(size_t)tk * 32 + 16 + j] = sn; } }
    { float* b1c = (float*)(ws + WS_B1C); LAS float* red = (LAS float*)lds;
      for (int it = bid; it < 4; it += nb) { const float* pe = in->p[5] + (size_t)it * 2048; const float* w1 = in->p[6] + (size_t)it * 2048 * 64; const int f = tid & 63, part = tid >> 6;
          float a = 0.f; for (int k = part * 256; k < part * 256 + 256; ++k) a += pe[k] * w1[(size_t)k * 64 + f];
          __syncthreads(); red[tid] = a; __syncthreads();
          if (tid < 64) { float s = 0.f; for (int p2 = 0; p2 < 8; ++p2) s += red[p2 * 64 + tid]; b1c[it * 64 + tid] = s; }
          __syncthreads(); } }
}
namespace g8 {
constexpr int BM = 256, BK = 64, HALF = 128, HTB = HALF * BK * 2, STAGE_BYTES = 8 * HTB, NXCD = 8, WGM = 8;
__host__ __device__ __forceinline__ int lds_byte(int r, int c) { const int st = (r >> 4) * 2 + (c >> 5), rr = r & 15, cc = c & 31, ob = rr * 64 + cc * 2; return st * 1024 + (ob ^ (((ob >> 9) & 1) << 5)); }
__host__ __device__ __forceinline__ void stage_rc(int b, int& R, int& C) { const int st = b / 1024, sb = b % 1024, swz = sb ^ (((sb >> 9) & 1) << 5); R = (st >> 1) * 16 + swz / 64; C = (st & 1) * 32 + (swz % 64) / 2; }
__host__ __device__ __forceinline__ int perm32(int rho) { const int n = rho >> 4, i = rho & 15; return 8 * (i >> 2) + 4 * n + (i & 3); }

struct GUnit { const char* a; const char* b; int pm, pn, e, rows; };

__device__ __forceinline__ bool static_unit(int i, int G, int c, int nM, int nN, int& pm, int& pn) {
    const int nwg = nM * nN; const long L = (long)i * G + c; if (L >= nwg) return false;
    int wgid = (int)L; { const int q = nwg / NXCD, r = nwg % NXCD, xcd = wgid % NXCD, off = wgid / NXCD; wgid = (xcd < r ? xcd * (q + 1) : r * (q + 1) + (xcd - r) * q) + off; }
    const int nig = WGM * nN, gid = wgid / nig, fm = gid * WGM, gsz = (nM - fm) < WGM ? (nM - fm) : WGM;
    pm = fm + ((wgid % nig) % gsz); pn = (wgid % nig) / gsz; return true;
}
struct DenseSched {
    static constexpr bool GATHER = false, PARTIAL = false;
    const char* A; const char* Bt; int lda, ldb, nM, nN, G, c;
    __device__ __forceinline__ bool next(int i, GUnit& u) const {
        int pm, pn; if (!static_unit(i, G, c, nM, nN, pm, pn)) return false;
        u.pm = pm; u.pn = pn; u.e = 0; u.rows = 256; u.a = A + (size_t)pm * 256 * lda * 2; u.b = Bt + (size_t)pn * 256 * ldb * 2; return true;
    }
    __device__ __forceinline__ void aoff(const GUnit&, unsigned (&v)[2][2], const int (&R)[2], const int (&C)[2]) const {
#pragma unroll
        for (int h = 0; h < 2; ++h)
#pragma unroll
            for (int i = 0; i < 2; ++i) v[h][i] = (unsigned)((h * 128 + R[i]) * lda + C[i]) * 2u;
    }
};

template <class Epi, class Sched>
__device__ __forceinline__ void gemm_run(LAS unsigned char* lds, const int K, const int ldb, const Sched& S, const Epi& E, int g_wv) {
    int tid_ = TIDX; asm volatile("" : "+v"(tid_));
    const int tid = tid_, wid = __builtin_amdgcn_readfirstlane(tid >> 6), lane = tid & 63, wr = wid >> 2, wc = wid & 3, fr = lane & 15, fq = lane >> 4;
    int nt_ = K / BK; asm volatile("" : "+s"(nt_));
    const int nt = nt_;
    int R[2], C[2]; unsigned voffB[2];
#pragma unroll
    for (int i = 0; i < 2; ++i) { stage_rc(tid * 16 + i * 8192, R[i], C[i]); const int Rb = (R[i] & ~31) + perm32(R[i] & 31); voffB[i] = (unsigned)(Rb * ldb + C[i]) * 2u; }
    const size_t kstep = (size_t)(BK * 2);
    const size_t hstepB = (size_t)HALF * ldb * 2;
    const unsigned ldsw = (unsigned)wid * 1024u;
    const int aoff = lds_byte(wr * 64 + fr, fq * 8), boff = lds_byte(wc * 32 + fr, fq * 8);
#define G8_SA(b, h) (((b) * 2 + (h)) * HTB)
#define G8_SB(b, h) ((4 + (b) * 2 + (h)) * HTB)
#define G8_GLDS(bufoff, gptr, i_) __builtin_amdgcn_global_load_lds((const unsigned*)(gptr), (LAS unsigned*)(lds + (bufoff) + ldsw + (i_) * 8192), 16, 0, 0)
#define G8_STAGE_B(bufoff, gbase) do { G8_GLDS(bufoff, (const char*)(gbase) + voffB[0], 0); G8_GLDS(bufoff, (const char*)(gbase) + voffB[1], 1); } while (0)
#define G8_STAGE_A(bufoff, gbase, v0, v1) do { G8_GLDS(bufoff, (const char*)(gbase) + (v0), 0); G8_GLDS(bufoff, (const char*)(gbase) + (v1), 1); } while (0)
#define G8_LDA(dst, b, h) do { _Pragma("unroll") for (int m = 0; m < 4; ++m) _Pragma("unroll") for (int k = 0; k < 2; ++k) dst[m][k] = *(const LAS bf16x8*)(lds + G8_SA(b, h) + aoff + m * 2048 + k * 1024); } while (0)
#define G8_LDB(dst, b, h) do { _Pragma("unroll") for (int n = 0; n < 2; ++n) _Pragma("unroll") for (int k = 0; k < 2; ++k) dst[n][k] = *(const LAS bf16x8*)(lds + G8_SB(b, h) + boff + n * 2048 + k * 1024); } while (0)
#define G8_MMA(ai, bj, At, Bt) do { __builtin_amdgcn_s_setprio(1); _Pragma("unroll") for (int m = 0; m < 4; ++m) { if (!PARTIAL || ((mmask >> ((ai) * 4 + m)) & 1u)) { _Pragma("unroll") for (int n = 0; n < 2; ++n) _Pragma("unroll") for (int k = 0; k < 2; ++k) \
        acc[ai][bj][m][n] = __builtin_amdgcn_mfma_f32_16x16x32_bf16(Bt[n][k], At[m][k], acc[ai][bj][m][n], 0, 0, 0); } } __builtin_amdgcn_s_setprio(0); } while (0)
#define G8_WAIT_V(n) asm volatile("s_waitcnt vmcnt(" #n ")" ::: "memory")
#define G8_WAIT_L(n) asm volatile("s_waitcnt lgkmcnt(" #n ")" ::: "memory")
#define G8_BAR __builtin_amdgcn_s_barrier()
#define G8_SCHED __builtin_amdgcn_sched_barrier(0)
    GUnit cur, nxt; int ui = 0;
    if (!S.next(0, cur)) return;
    constexpr bool GATHER = Sched::GATHER, PARTIAL = Sched::PARTIAL;
    unsigned mmask = 0xffu;
#define G8_MASK(u) do { if (PARTIAL) { mmask = 0u; _Pragma("unroll") for (int q_ = 0; q_ < 8; ++q_) mmask |= (((q_ >> 2) * 128 + wr * 64 + (q_ & 3) * 16) < (u).rows) ? (1u << q_) : 0u; } } while (0)
    unsigned vc[2][2];
    S.aoff(cur, vc, R, C); G8_MASK(cur);
    LAS u32x4* stash = (LAS u32x4*)(lds + STAGE_BYTES + 4096) + tid;
    f32x4 acc[2][2][4][2];
#pragma unroll
    for (int a = 0; a < 2; ++a)
#pragma unroll
        for (int b = 0; b < 2; ++b)
#pragma unroll
            for (int m = 0; m < 4; ++m)
#pragma unroll
                for (int n = 0; n < 2; ++n) acc[a][b][m][n] = (f32x4){0.f, 0.f, 0.f, 0.f};
    bf16x8 At[4][2], B0[2][2], B1[2][2];
    const char* cA = cur.a; const char* cB = cur.b;
    G8_STAGE_B(G8_SB(0, 0), cB); G8_STAGE_B(G8_SB(0, 1), cB + hstepB); G8_STAGE_A(G8_SA(0, 0), cA, vc[0][0], vc[0][1]); G8_STAGE_A(G8_SA(0, 1), cA, vc[1][0], vc[1][1]);
    if (wr == 1) G8_BAR;
    G8_WAIT_V(2); G8_BAR;
    G8_STAGE_B(G8_SB(1, 0), cB + kstep); G8_STAGE_A(G8_SA(1, 0), cA + kstep, vc[0][0], vc[0][1]); G8_STAGE_B(G8_SB(1, 1), cB + hstepB + kstep);
    G8_WAIT_V(6); G8_BAR;
    for (;;) {
        const bool has_next = S.next(ui + 1, nxt);
        if (GATHER) { unsigned vn[2][2];
            if (has_next) S.aoff(nxt, vn, R, C);
            else { vn[0][0] = vc[0][0]; vn[0][1] = vc[0][1]; vn[1][0] = vc[1][0]; vn[1][1] = vc[1][1]; }
            u32x4 sv; sv.x = vn[0][0]; sv.y = vn[0][1]; sv.z = vn[1][0]; sv.w = vn[1][1]; *stash = sv; }
        const char* nA = has_next ? nxt.a : cA; const char* nB = has_next ? nxt.b : cB;
#pragma unroll 1
        for (int seg = 0; seg < (Epi::KHOOK ? 3 : 1); ++seg) {
        const int tlo = Epi::KHOOK ? 6 * seg : 0, thi = Epi::KHOOK ? (seg == 2 ? nt : 6 * seg + 6) : nt;
#pragma unroll 1
        for (int t = tlo; t < thi; t += 2) {
            const bool last = (t == nt - 2);
            const char* a1 = cA + (size_t)(t + 1) * kstep;
            const char* a2 = last ? nA : cA + (size_t)(t + 2) * kstep; const char* b2 = last ? nB : cB + (size_t)(t + 2) * kstep;
            const char* a3 = a2 + kstep; const char* b3 = b2 + kstep;
            unsigned w00 = vc[0][0], w01 = vc[0][1], w10 = vc[1][0], w11 = vc[1][1];
            if (GATHER) { if (last) { const u32x4 sv = *stash; w00 = sv.x; w01 = sv.y; w10 = sv.z; w11 = sv.w; } }
            G8_LDB(B0, 0, 0); G8_LDB(B1, 0, 1); G8_SCHED; G8_LDA(At, 0, 0); G8_STAGE_A(G8_SA(1, 1), a1, vc[1][0], vc[1][1]);
            G8_WAIT_V(8); G8_WAIT_L(0); G8_BAR; G8_MMA(0, 0, At, B0); G8_MMA(0, 1, At, B1); G8_BAR; G8_SCHED;
            G8_LDA(At, 0, 1); G8_STAGE_B(G8_SB(0, 0), b2); G8_STAGE_B(G8_SB(0, 1), b2 + hstepB); G8_STAGE_A(G8_SA(0, 0), a2, w00, w01);
            G8_WAIT_V(8); G8_WAIT_L(0); G8_BAR; G8_MMA(1, 0, At, B0); G8_MMA(1, 1, At, B1); G8_BAR; G8_SCHED;
            G8_LDB(B0, 1, 0); G8_LDB(B1, 1, 1); G8_SCHED; G8_LDA(At, 1, 0); G8_STAGE_A(G8_SA(0, 1), a2, w10, w11);
            G8_WAIT_V(8); G8_WAIT_L(0); G8_BAR; G8_MMA(0, 0, At, B0); G8_MMA(0, 1, At, B1); G8_BAR; G8_SCHED;
            G8_LDA(At, 1, 1); G8_STAGE_B(G8_SB(1, 0), b3); G8_STAGE_B(G8_SB(1, 1), b3 + hstepB); G8_STAGE_A(G8_SA(1, 0), a3, w00, w01);
            G8_WAIT_V(8); G8_WAIT_L(0); G8_BAR; G8_MMA(1, 0, At, B0); G8_MMA(1, 1, At, B1); G8_BAR; G8_SCHED;
        }
        if constexpr (Epi::KHOOK) { if (seg < 2) E.kscale(acc, seg, wr, fr); }
        }
        if (wr == 0) G8_BAR;
        { int fr_ = fr, fq_ = fq; asm volatile("" : "+v"(fr_), "+v"(fq_));
          E(acc, cur, wr, wc, fr_, fq_); }
        if (!has_next) break;
#pragma unroll
        for (int a = 0; a < 2; ++a)
#pragma unroll
            for (int b = 0; b < 2; ++b)
#pragma unroll
                for (int m = 0; m < 4; ++m)
#pragma unroll
                    for (int n = 0; n < 2; ++n) acc[a][b][m][n] = (f32x4){0.f, 0.f, 0.f, 0.f};
        cur = nxt; cA = nA; cB = nB; ++ui; G8_MASK(cur);
        if (GATHER) { const u32x4 sv = *stash; vc[0][0] = sv.x; vc[0][1] = sv.y; vc[1][0] = sv.z; vc[1][1] = sv.w; }
        if (wr == 1) G8_BAR;
    }
    G8_WAIT_V(0);
    G8_BAR;
#undef G8_SA
#undef G8_SB
#undef G8_GLDS
#undef G8_STAGE_A
#undef G8_STAGE_B
#undef G8_LDA
#undef G8_LDB
#undef G8_MMA
#undef G8_MASK
#undef G8_WAIT_V
#undef G8_WAIT_L
#undef G8_BAR
#undef G8_SCHED
}
}
using g8::GUnit;
__device__ __forceinline__ void st_bf16x8(bf16_t* p, const float (&v)[8]) { u32x4 w; w.x = pk_bf16(v[0], v[1]); w.y = pk_bf16(v[2], v[3]); w.z = pk_bf16(v[4], v[5]); w.w = pk_bf16(v[6], v[7]); *(u32x4*)p = w; }
__device__ __forceinline__ float quad_sum(float s) { s += __shfl_xor(s, 16); s += __shfl_xor(s, 32); return s; }

struct EpiInProj {
    static constexpr bool KHOOK = false;
    const float* ssqx; float* part_dq; float* part_dkv; const float* qg; const float* kg; const float* krg; const float* rope;
    unsigned char* prj;
    __device__ __forceinline__ void operator()(const f32x4 (&acc)[2][2][4][2], const GUnit& u, int wr, int wc, int fr, int fq) const {
        const int G = u.pn * 4 + wc;
        const bool isq = G < 6; const int a = G - 6; const bool isk = (G >= 10 && G < 18 && ((a >> 1) & 1) == 0);
        const float* g0 = (isq ? qg : kg) + 8 * fq;
        float rs8[8];
#pragma unroll
        for (int k = 0; k < 8; ++k) rs8[k] = ssqx[u.pm * 256 + (k >> 2) * 128 + wr * 64 + (k & 3) * 16 + fr];
#pragma unroll
        for (int k = 0; k < 8; ++k) rs8[k] = rsqrtf(rs8[k] * (1.f / 1024.f) + 1e-6f);
#pragma unroll
        for (int ai = 0; ai < 2; ++ai)
#pragma unroll
            for (int m = 0; m < 4; ++m) {
                __builtin_amdgcn_sched_barrier(0);
                const int row = u.pm * 256 + ai * 128 + wr * 64 + m * 16 + fr; const int b = row >> 11, t = row & 2047;
                const float rs = rs8[ai * 4 + m];
                float v[2][8];
#pragma unroll
                for (int bj = 0; bj < 2; ++bj)
#pragma unroll
                    for (int n = 0; n < 2; ++n)
#pragma unroll
                        for (int j = 0; j < 4; ++j) v[bj][4 * n + j] = acc[ai][bj][m][n][j] * rs;
                float ss = 0.f;
#pragma unroll
                for (int bj = 0; bj < 2; ++bj)
#pragma unroll
                    for (int i = 0; i < 8; ++i) ss += v[bj][i] * v[bj][i];
                bf16_t* dst = nullptr; int bstride = 32;
                if (isq) {
                    ss = quad_sum(ss); const float sc = rsqrtf(ss * (1.f / 64.f) + 1e-6f) * 0.18033688f;
#pragma unroll
                    for (int i = 0; i < 8; ++i) { v[0][i] *= sc * g0[i]; v[1][i] *= sc * g0[32 + i]; }
                    dst = (bf16_t*)(prj + PRJ_QN) + ((size_t)(b * 6 + G) * 2048 + t) * 64;
                } else if (G < 18) {
                    const int br = a >> 2, s = (a >> 1) & 1, hk = a & 1;
                    if (br > 0 && s == 0) {
                        ss = quad_sum(ss); const float sc = rsqrtf(ss * (1.f / 64.f) + 1e-6f);
#pragma unroll
                        for (int i = 0; i < 8; ++i) { v[0][i] *= sc * g0[i]; v[1][i] *= sc * g0[32 + i]; }
                    }
                    const size_t base = br == 0 ? (s ? PRJ_C0V : PRJ_C0K) : (br == 1 ? (s ? PRJ_VN1 : PRJ_KN1) : (s ? PRJ_VN2 : PRJ_KN2));
                    dst = (bf16_t*)(prj + base) + ((size_t)(b * 2 + hk) * 2048 + t) * 64;
                } else if (G < 26) { dst = (bf16_t*)(prj + PRJ_RAWQK) + (size_t)row * 512 + (G - 18) * 64; }
                else if (G < 30) { dst = (bf16_t*)(prj + PRJ_VML) + ((size_t)(b * 4 + (G - 26)) * 2048 + t) * 64; }
                else if (G < 34) { dst = (bf16_t*)(prj + PRJ_OG) + (size_t)row * 256 + (G - 30) * 64; }
                else if (G < 37) { dst = (bf16_t*)(prj + PRJ_DQKV) + (size_t)row * 384 + (G - 34) * 64; ss = quad_sum(ss); if (fq == 0) part_dq[(size_t)row * 4 + (G - 34)] = ss; }
                else if (G == 37) {
                    dst = (bf16_t*)(prj + PRJ_DQKV) + (size_t)row * 384 + 192;
                    float* gt = (float*)(prj + PRJ_GATES) + (size_t)row * 32 + 8 * fq;
                    *(f32x4*)gt = (f32x4){v[1][0], v[1][1], v[1][2], v[1][3]}; *(f32x4*)(gt + 4) = (f32x4){v[1][4], v[1][5], v[1][6], v[1][7]};
                    float s0 = 0.f;
#pragma unroll
                    for (int i = 0; i < 8; ++i) s0 += v[0][i] * v[0][i];
                    s0 = quad_sum(s0); const float sc = rsqrtf(s0 * (1.f / 32.f) + 1e-6f);
                    const float* rp = rope + (size_t)row * 32 + ((8 * fq) & 15);
                    float kr[8];
#pragma unroll
                    for (int i = 0; i < 8; ++i) { const float val = v[0][i] * sc * krg[8 * fq + i]; const float oth = __shfl_xor(val, 32); const float cs = rp[i], sn = rp[16 + i]; kr[i] = fq < 2 ? val * cs - oth * sn : val * cs + oth * sn; }
                    st_bf16x8((bf16_t*)(prj + PRJ_KR) + (size_t)row * 32 + 8 * fq, kr);
                } else { dst = (bf16_t*)(prj + PRJ_DQKV) + (size_t)row * 384 + 256 + (G - 38) * 64; ss = quad_sum(ss); if (fq == 0) part_dkv[(size_t)row * 2 + (G - 38)] = ss; }
                st_bf16x8(dst + 8 * fq, v[0]); st_bf16x8(dst + bstride + 8 * fq, v[1]);
            }
    }
};

struct EpiUq {
    static constexpr bool KHOOK = false;
    const float* ssq_dq; const float* qkn; const float* rope; bf16_t* QM;
    __device__ __forceinline__ void operator()(const f32x4 (&acc)[2][2][4][2], const GUnit& u, int wr, int wc, int fr, int fq) const {
        const int G = u.pn * 4 + wc; if (G >= 9) return;
        const float scale = 0.14724444f;
        const float* g0 = G < 6 ? qkn + 8 * fq : qkn + 64 + 8 * (fq & 1); const float* g1 = G < 6 ? g0 + 32 : g0 + 16;
        float rs8[8];
#pragma unroll
        for (int k = 0; k < 8; ++k) { const f32x4 pq = *(const f32x4*)(ssq_dq + (size_t)(u.pm * 256 + (k >> 2) * 128 + wr * 64 + (k & 3) * 16 + fr) * 4); rs8[k] = (pq.x + pq.y) + pq.z; }
#pragma unroll
        for (int k = 0; k < 8; ++k) rs8[k] = rsqrtf(rs8[k] * (1.f / 192.f) + 1e-6f);
#pragma unroll
        for (int ai = 0; ai < 2; ++ai)
#pragma unroll
            for (int m = 0; m < 4; ++m) {
                __builtin_amdgcn_sched_barrier(0);
                const int row = u.pm * 256 + ai * 128 + wr * 64 + m * 16 + fr; const int b = row >> 11, t = row & 2047;
                const float rs = rs8[ai * 4 + m];
                float v[2][8]; float ss = 0.f;
#pragma unroll
                for (int bj = 0; bj < 2; ++bj)
#pragma unroll
                    for (int n = 0; n < 2; ++n)
#pragma unroll
                        for (int j = 0; j < 4; ++j) { const float x = acc[ai][bj][m][n][j] * rs; v[bj][4 * n + j] = x; ss += x * x; }
                if (G < 6) ss = quad_sum(ss); else ss += __shfl_xor(ss, 16);
                const float sc = rsqrtf(ss * (G < 6 ? 1.f / 64.f : 1.f / 32.f) + 1e-6f) * scale;
#pragma unroll
                for (int i = 0; i < 8; ++i) { v[0][i] *= sc * g0[i]; v[1][i] *= sc * g1[i]; }
                if (G < 6) {
                    bf16_t* dst = QM + ((size_t)(b * 6 + G) * 2048 + t) * 96;
                    st_bf16x8(dst + 8 * fq, v[0]); st_bf16x8(dst + 32 + 8 * fq, v[1]);
                } else {
                    const int i16 = 8 * (fq & 1); const int head = 2 * (G - 6) + (fq >> 1);
                    const float* rp = rope + (size_t)row * 32 + i16; float o1[8], o2[8];
#pragma unroll
                    for (int i = 0; i < 8; ++i) { const float cs = rp[i], sn = rp[16 + i]; o1[i] = v[0][i] * cs - v[1][i] * sn; o2[i] = v[1][i] * cs + v[0][i] * sn; }
                    bf16_t* dst = QM + ((size_t)(b * 6 + head) * 2048 + t) * 96 + 64 + i16;
                    st_bf16x8(dst, o1); st_bf16x8(dst + 16, o2);
                }
            }
    }
};
struct EpiUkv {
    static constexpr bool KHOOK = false;
    const float* ssq_dkv; const float* qkn; const bf16_t* KR; bf16_t* KM; bf16_t* VM;
    __device__ __forceinline__ void operator()(const f32x4 (&acc)[2][2][4][2], const GUnit& u, int wr, int wc, int fr, int fq) const {
        const int G = u.pn * 4 + wc;
        const float* g0 = qkn + 96 + 8 * fq;
        float rs8[8];
#pragma unroll
        for (int k = 0; k < 8; ++k) { const size_t rr = (size_t)(u.pm * 256 + (k >> 2) * 128 + wr * 64 + (k & 3) * 16 + fr); rs8[k] = ssq_dkv[rr * 2] + ssq_dkv[rr * 2 + 1]; }
#pragma unroll
        for (int k = 0; k < 8; ++k) rs8[k] = rsqrtf(rs8[k] * (1.f / 128.f) + 1e-6f);
#pragma unroll
        for (int ai = 0; ai < 2; ++ai)
#pragma unroll
            for (int m = 0; m < 4; ++m) {
                __builtin_amdgcn_sched_barrier(0);
                const int row = u.pm * 256 + ai * 128 + wr * 64 + m * 16 + fr; const int b = row >> 11, t = row & 2047;
                const float rs = rs8[ai * 4 + m];
                float v[2][8]; float ss = 0.f;
#pragma unroll
                for (int bj = 0; bj < 2; ++bj)
#pragma unroll
                    for (int n = 0; n < 2; ++n)
#pragma unroll
                        for (int j = 0; j < 4; ++j) { const float x = acc[ai][bj][m][n][j] * rs; v[bj][4 * n + j] = x; ss += x * x; }
                if (G < 6) {
                    ss = quad_sum(ss); const float sc = rsqrtf(ss * (1.f / 64.f) + 1e-6f);
#pragma unroll
                    for (int i = 0; i < 8; ++i) { v[0][i] *= sc * g0[i]; v[1][i] *= sc * g0[32 + i]; }
                    bf16_t* dst = KM + ((size_t)(b * 6 + G) * 2048 + t) * 96;
                    st_bf16x8(dst + 8 * fq, v[0]); st_bf16x8(dst + 32 + 8 * fq, v[1]);
                    *(u32x4*)(dst + 64 + 8 * fq) = *(const u32x4*)(KR + (size_t)row * 32 + 8 * fq);
                } else {
                    bf16_t* dst = VM + ((size_t)(b * 6 + (G - 6)) * 2048 + t) * 64;
                    st_bf16x8(dst + 8 * fq, v[0]); st_bf16x8(dst + 32 + 8 * fq, v[1]);
                }
            }
    }
};
#define MFMA16(a, b, c) __builtin_amdgcn_mfma_f32_16x16x32_bf16(a, b, c, 0, 0, 0)
#define MFMA32(a, b, c) __builtin_amdgcn_mfma_f32_32x32x16_bf16(a, b, c, 0, 0, 0)
#define LDS_FENCE() asm volatile("s_waitcnt lgkmcnt(0)" ::: "memory")

__device__ __forceinline__ void cmp_unit(int u, int l, InPtr in, unsigned char* ws, LAS unsigned char* lds, int g_wv) {
    int tid_ = TIDX; asm volatile("" : "+v"(tid_));
    const int tid = tid_, w = tid >> 6, lane = tid & 63, r = lane & 15, q = lane >> 4;
    const int b = u >> 2, s = (u >> 1) & 1, hk = u & 1;
    const bf16_t* A = (const bf16_t*)(ws + WS_PRJ + (s ? PRJ_C0V : PRJ_C0K)) + (size_t)(b * 2 + hk) * 2048 * 64;
    const bf16_t* W1 = (const bf16_t*)(ws + WS_WC1) + ((size_t)l * 2 + s) * 64 * 2048;
    const bf16_t* W2 = (const bf16_t*)(ws + WS_WC2) + ((size_t)l * 2 + s) * 64 * 64;
    const float* b1 = (const float*)(ws + WS_B1C) + (l * 2 + s) * 64;
    f32x4 acc[4];
#pragma unroll
    for (int nb = 0; nb < 4; ++nb) acc[nb] = (f32x4){0.f, 0.f, 0.f, 0.f};
    const bf16_t* ap = A + (size_t)(16 * w + r) * 1024 + 8 * q;
    constexpr int WP = 528, WBUF = 64 * WP; LAS unsigned char* wb = lds + 24576;
    u32x4 st[4];
#pragma unroll
    for (int i = 0; i < 4; ++i) { const int c = tid + 512 * i; st[i] = *(const u32x4*)(W1 + (size_t)(c >> 5) * 2048 + (c & 31) * 8); }
#pragma unroll
    for (int i = 0; i < 4; ++i) { const int c = tid + 512 * i; *(LAS u32x4*)(wb + (c >> 5) * WP + (c & 31) * 16) = st[i]; }
    __syncthreads();
#pragma unroll 1
    for (int kc = 0; kc < 8; ++kc) {
        const int cur = kc & 1;
        if (kc < 7) {
#pragma unroll
            for (int i = 0; i < 4; ++i) { const int c = tid + 512 * i; st[i] = *(const u32x4*)(W1 + (size_t)(c >> 5) * 2048 + (kc + 1) * 256 + (c & 31) * 8); }
        }
        bf16x8 af[8];
#pragma unroll
        for (int ks = 0; ks < 8; ++ks) af[ks] = *(const bf16x8*)(ap + 256 * kc + 32 * ks);
#pragma unroll
        for (int ks = 0; ks < 8; ++ks)
#pragma unroll
            for (int nb = 0; nb < 4; ++nb) { const bf16x8 bb = *(const LAS bf16x8*)(wb + cur * WBUF + (16 * nb + r) * WP + (32 * ks + 8 * q) * 2); acc[nb] = MFMA16(af[ks], bb, acc[nb]); }
        if (kc < 7) {
#pragma unroll
            for (int i = 0; i < 4; ++i) { const int c = tid + 512 * i; *(LAS u32x4*)(wb + (cur ^ 1) * WBUF + (c >> 5) * WP + (c & 31) * 16) = st[i]; }
        }
        __syncthreads();
    }
    LAS bf16_t* hl = (LAS bf16_t*)(lds + w * 2304);
#pragma unroll
    for (int nb = 0; nb < 4; ++nb) { const float bias = b1[16 * nb + r];
#pragma unroll
        for (int j = 0; j < 4; ++j) hl[(4 * q + j) * 72 + 16 * nb + r] = f2bf(siluf(acc[nb][j] + bias)); }
    LDS_FENCE();
    f32x4 o[4];
#pragma unroll
    for (int nb = 0; nb < 4; ++nb) o[nb] = (f32x4){0.f, 0.f, 0.f, 0.f};
#pragma unroll
    for (int ks = 0; ks < 2; ++ks) {
        const bf16x8 a = *(const LAS bf16x8*)(hl + r * 72 + 32 * ks + 8 * q);
#pragma unroll
        for (int nb = 0; nb < 4; ++nb) { const bf16x8 bb = *(const bf16x8*)(W2 + (size_t)(16 * nb + r) * 64 + 32 * ks + 8 * q); o[nb] = MFMA16(a, bb, o[nb]); }
    }
    LDS_FENCE();
    const float* kg = in->p[9] + l * 64;
    bf16_t* dst = (bf16_t*)(ws + WS_CMP + (s ? CMP_V : 0)) + (size_t)(b * 2 + hk) * 128 * 64;
#pragma unroll
    for (int j = 0; j < 4; ++j) {
        const int n = 16 * w + 4 * q + j; float ss = 0.f;
#pragma unroll
        for (int nb = 0; nb < 4; ++nb) ss += o[nb][j] * o[nb][j];
        ss += __shfl_xor(ss, 1); ss += __shfl_xor(ss, 2); ss += __shfl_xor(ss, 4); ss += __shfl_xor(ss, 8);
        const float sc = s == 0 ? rsqrtf(ss * (1.f / 64.f) + 1e-6f) : 1.f;
#pragma unroll
        for (int nb = 0; nb < 4; ++nb) { const int d = 16 * nb + r; const float v = o[nb][j] * sc * (s == 0 ? kg[d] : 1.f); dst[(size_t)n * 64 + d] = n < 127 ? f2bf(v) : (bf16_t)0; }
    }
}

__device__ __forceinline__ int swz_off(int row, int chunk) { return row * 128 + ((chunk ^ (row & 7)) << 4); }
__device__ __forceinline__ float log_sigmoid(float x) { return fminf(x, 0.f) - log1pf(__expf(-fabsf(x))); }
__device__ __forceinline__ void ml_delta_wave(int cu, int l, InPtr in, unsigned char* ws, LAS unsigned char* wl, int lane) {
    const int c = cu & 31, bh = cu >> 5, h = bh & 3, b = bh >> 2; const int t0 = c * 64; const size_t row0 = (size_t)b * 2048 + t0;
    const float* G = (const float*)(ws + WS_PRJ + PRJ_GATES);
    const float ip = G[(row0 + lane) * 32 + 18 + h] + in->p[12][l * 4 + h], fp = G[(row0 + lane) * 32 + 22 + h] + in->p[13][l * 4 + h];
    float bcum = log_sigmoid(fp);
#pragma unroll
    for (int o = 1; o < 64; o <<= 1) { const float t = __builtin_bit_cast(float, __builtin_amdgcn_ds_bpermute(((lane - o) & 63) << 2, __builtin_bit_cast(int, bcum))); if (lane >= o) bcum += t; }
    const float bL = __builtin_bit_cast(float, __builtin_amdgcn_readlane(__builtin_bit_cast(int, bcum), 63)); const float wgt = __expf(bL - bcum + ip);
    { float* mlg = (float*)(ws + WS_ML + ML_G) + ((size_t)bh * 2048 + t0 + lane) * 2; mlg[0] = bcum; mlg[1] = ip; if (lane == 0) ((float*)(ws + WS_ML + ML_BL))[cu] = bL; }
    const bf16_t* raw = (const bf16_t*)(ws + WS_PRJ + PRJ_RAWQK); const float* cw = in->p[11] + (size_t)l * 4 * 512;
    float wq[4], wk[4];
#pragma unroll
    for (int j = 0; j < 4; ++j) { wq[j] = cw[j * 512 + h * 64 + lane]; wk[j] = cw[j * 512 + 256 + h * 64 + lane]; }
    float q3 = 0.f, q2 = 0.f, q1 = 0.f, k3 = 0.f, k2 = 0.f, k1 = 0.f;
    if (c > 0) { const bf16_t* p = raw + (row0 - 3) * 512 + h * 64 + lane; q3 = bf2f(p[0]); q2 = bf2f(p[512]); q1 = bf2f(p[1024]); k3 = bf2f(p[256]); k2 = bf2f(p[512 + 256]); k1 = bf2f(p[1024 + 256]); }
    bf16_t* QC = (bf16_t*)(ws + WS_ML) + ((size_t)bh * 2048 + t0) * 64 + lane; bf16_t* KC = (bf16_t*)(ws + WS_ML + ML_KC) + ((size_t)bh * 2048 + t0) * 64 + lane;
    const bf16_t* V = (const bf16_t*)(ws + WS_PRJ + PRJ_VML) + ((size_t)bh * 2048 + t0) * 64 + lane;
    float dn = 0.f;
    const bf16_t* rq = raw + row0 * 512 + h * 64 + lane;
    bf16_t cq[8], ck[8], cv[8], nq[8], nk[8], nv[8];
#pragma unroll
    for (int j = 0; j < 8; ++j) { cq[j] = rq[(size_t)j * 512]; ck[j] = rq[(size_t)j * 512 + 256]; cv[j] = V[(size_t)j * 64]; }
#pragma unroll 1
    for (int s8 = 0; s8 < 8; ++s8) {
        if (s8 < 7) {
#pragma unroll
            for (int j = 0; j < 8; ++j) { const int s = s8 * 8 + 8 + j; nq[j] = rq[(size_t)s * 512]; nk[j] = rq[(size_t)s * 512 + 256]; nv[j] = V[(size_t)s * 64]; }
        }
        float kb[8], vb[8]; bf16_t qo[8], ko[8];
#pragma unroll
        for (int j = 0; j < 8; ++j) {
            const int s = s8 * 8 + j;
            const float q0 = bf2f(cq[j]), k0 = bf2f(ck[j]);
            const float qv = siluf(wq[0] * q3 + wq[1] * q2 + wq[2] * q1 + wq[3] * q0), kv = siluf(wk[0] * k3 + wk[1] * k2 + wk[2] * k1 + wk[3] * k0) * 0.125f;
            q3 = q2; q2 = q1; q1 = q0; k3 = k2; k2 = k1; k1 = k0;
            qo[j] = f2bf(qv); ko[j] = f2bf(kv);
            const float ws_ = __builtin_bit_cast(float, __builtin_amdgcn_readlane(__builtin_bit_cast(int, wgt), s)); kb[j] = bf2f(ko[j]); dn += ws_ * kb[j]; vb[j] = ws_ * bf2f(cv[j]);
        }
#pragma unroll
        for (int j = 0; j < 8; ++j) { QC[(size_t)(s8 * 8 + j) * 64] = qo[j]; KC[(size_t)(s8 * 8 + j) * 64] = ko[j]; }
        u32x4 pk; pk.x = pk_bf16(kb[0], kb[1]); pk.y = pk_bf16(kb[2], kb[3]); pk.z = pk_bf16(kb[4], kb[5]); pk.w = pk_bf16(kb[6], kb[7]);
        *(LAS u32x4*)(wl + swz_off(lane, s8)) = pk;
        pk.x = pk_bf16(vb[0], vb[1]); pk.y = pk_bf16(vb[2], vb[3]); pk.z = pk_bf16(vb[4], vb[5]); pk.w = pk_bf16(vb[6], vb[7]);
        *(LAS u32x4*)(wl + 8192 + swz_off(lane, s8)) = pk;
#pragma unroll
        for (int j = 0; j < 8; ++j) { cq[j] = nq[j]; ck[j] = nk[j]; cv[j] = nv[j]; }
    }
    ((float*)(ws + WS_ML + ML_DN))[(size_t)cu * 64 + lane] = dn;
    LDS_FENCE();
    const int r = lane & 15, q = lane >> 4;
    bf16_t* DL = (bf16_t*)(ws + WS_ML + ML_DELTA) + (size_t)cu * 4096;
#pragma unroll
    for (int mb = 0; mb < 4; ++mb) {
        f32x4 acc[4];
#pragma unroll
        for (int nb = 0; nb < 4; ++nb) acc[nb] = (f32x4){0.f, 0.f, 0.f, 0.f};
#pragma unroll
        for (int ks = 0; ks < 2; ++ks) {
            const bf16x8 a = *(const LAS bf16x8*)(wl + 8192 + swz_off(16 * mb + r, 4 * ks + q));
#pragma unroll
            for (int nb = 0; nb < 4; ++nb) { const bf16x8 bb = *(const LAS bf16x8*)(wl + swz_off(16 * nb + r, 4 * ks + q)); acc[nb] = MFMA16(a, bb, acc[nb]); }
        }
#pragma unroll
        for (int nb = 0; nb < 4; ++nb)
#pragma unroll
            for (int j = 0; j < 4; ++j) DL[(16 * mb + 4 * q + j) * 64 + 16 * nb + r] = f2bf(acc[nb][j]);
    }
    LDS_FENCE();
}

#ifndef TIME_PH
#define TIME_PH -1
#endif
#define PSTAMP(i, blk) do { if (TIME_PH != -1 && l == 0 && blockIdx.x == (blk) && TIDX == 0) ((unsigned long long*)((unsigned*)(ws + WS_CTL) + CW_TS))[i] = __builtin_amdgcn_s_memrealtime(); } while (0)
__device__ __forceinline__ void phase_prep(int l, InPtr in, unsigned char* ws, LAS unsigned char* lds, int bid, int nb, int g_wv, unsigned* dq) {
    asm volatile("" : "+s"(bid));
    PSTAMP(40, 0);
#ifndef NO_UQ
    { g8::DenseSched S{(const char*)(ws + WS_PRJ + PRJ_DQKV), (const char*)(ws + WS_WUQ) + (size_t)l * 768 * 256 * 2, 384, 256, 64, 3, nb, bid};
      EpiUq E{(const float*)(ws + WS_SSQ + PT_DQ) + (size_t)l * 16384 * 4, in->p[19] + l * 192, (const float*)(ws + WS_ROPE), (bf16_t*)(ws + WS_MLA)};
      g8::gemm_run(lds, 256, 256, S, E, g_wv); }
#endif
    PSTAMP(41, 0);
#ifndef NO_UKV
    asm volatile("" : "+s"(bid));
    { g8::DenseSched S{(const char*)(ws + WS_PRJ + PRJ_DQKV) + 256, (const char*)(ws + WS_WUKV) + (size_t)l * 768 * 256 * 2, 384, 256, 64, 3, nb, bid};
      EpiUkv E{(const float*)(ws + WS_SSQ + PT_DKV) + (size_t)l * 16384 * 2, in->p[19] + l * 192, (const bf16_t*)(ws + WS_PRJ + PRJ_KR), (bf16_t*)(ws + WS_MLA + MLA_KM), (bf16_t*)(ws + WS_MLA + MLA_VM)};
      g8::gemm_run(lds, 256, 256, S, E, g_wv); }
#endif
    PSTAMP(42, 0); PSTAMP(44, 255);
    __syncthreads();
#ifndef NO_CMP
    for (int u = nb - 1 - bid; u < 32; u += nb) cmp_unit(u, l, in, ws, lds, g_wv);
#endif
    PSTAMP(45, 255);
    __syncthreads();
#ifndef NO_DELTA
    { int tid_ = TIDX; asm volatile("" : "+v"(tid_)); LAS int* slot = (LAS int*)(lds + LDS_MISC + 64);
      for (;;) {
          __syncthreads();
          if (tid_ == 0) *slot = (int)__hip_atomic_fetch_add(dq, 1u, __ATOMIC_RELAXED, __HIP_MEMORY_SCOPE_AGENT);
          __syncthreads();
          const int g = *slot; if (g >= 128) break;
          ml_delta_wave(g * 8 + (tid_ >> 6), l, in, ws, lds + (tid_ >> 6) * 16384, tid_ & 63);
      } }
#endif
    __syncthreads(); PSTAMP(43, 0);
}
#define CHK_TOL(st) (((st) & 15) == 8 ? 1e-2f : 1e-3f)
#define CHECK_REST
constexpr int VTP = 192;
typedef short v4i16_t __attribute__((ext_vector_type(4)));
__device__ __forceinline__ int vt_lane_off(int lane) { return (4 * (lane >> 5) + ((lane & 15) >> 2)) * VTP + ((((lane >> 4) & 1) * 16) + 4 * (lane & 3)) * 2; }
__device__ __forceinline__ bf16x8 vt_frag(const LAS unsigned char* Vt, int voff, int s4, int eb) {
    const LAS unsigned char* a = Vt + voff + 16 * s4 * VTP + 64 * eb;
    const v4i16_t lo = __builtin_amdgcn_ds_read_tr16_b64_v4i16((LAS v4i16_t*)a), hi = __builtin_amdgcn_ds_read_tr16_b64_v4i16((LAS v4i16_t*)(a + 8 * VTP));
    return (bf16x8){lo[0], lo[1], lo[2], lo[3], hi[0], hi[1], hi[2], hi[3]};
}
__device__ __forceinline__ int crow(int reg, int h) { return (reg & 3) + 8 * (reg >> 2) + 4 * h; }
struct AttnState { f32x16 o[2]; float m, l; };
__device__ __forceinline__ void attn_reset(AttnState& A) { A.m = -1e30f; A.l = 0.f;
#pragma unroll
    for (int i = 0; i < 16; ++i) { A.o[0][i] = 0.f; A.o[1][i] = 0.f; } }

template <int DK>
__device__ __forceinline__ void attn_scores(f32x16 (&s)[2], const bf16x8 (&qf)[DK / 16], const LAS unsigned char* Kt, int r, int h) {
    constexpr int KP = 2 * DK + 16, NK = DK / 16;
    bf16x8 kf[2][NK];
#pragma unroll
    for (int kb = 0; kb < 2; ++kb)
#pragma unroll
        for (int ks = 0; ks < NK; ++ks) kf[kb][ks] = *(const LAS bf16x8*)(Kt + (32 * kb + r) * KP + (16 * ks + 8 * h) * 2);
    __builtin_amdgcn_sched_barrier(0);
#pragma unroll
    for (int kb = 0; kb < 2; ++kb) {
#pragma unroll
        for (int i = 0; i < 16; ++i) s[kb][i] = 0.f;
#pragma unroll
        for (int ks = 0; ks < NK; ++ks) s[kb] = MFMA32(kf[kb][ks], qf[ks], s[kb]);
    }
}
__device__ __forceinline__ float max3f(float a, float b, float c) { return fmaxf(fmaxf(a, b), c); }
__device__ __forceinline__ void attn_softmax_pv(AttnState& A, f32x16 (&s)[2], const LAS unsigned char* Vt, int r, int h, float bias_c = 0.f, bool lane_ok = true) {
    constexpr float THR = 8.f; const int voff = vt_lane_off(r + 32 * h);
    float mx = max3f(s[0][0], s[0][1], s[0][2]);
#pragma unroll
    for (int i = 3; i < 15; i += 2) mx = max3f(mx, s[0][i], s[0][i + 1]);
    mx = max3f(mx, s[0][15], s[1][0]);
#pragma unroll
    for (int i = 1; i < 15; i += 2) mx = max3f(mx, s[1][i], s[1][i + 1]);
    mx = fmaxf(mx, s[1][15]);
    mx = fmaxf(mx, __shfl_xor(mx, 32));
    const float mxb = (lane_ok && mx > -1e29f) ? mx + bias_c : -1e30f;
    const bool grow = mxb > A.m + THR;
    const float mnew = grow ? mxb : A.m;
    if (__any(grow)) {
        const float alpha = __builtin_amdgcn_exp2f(A.m - mnew);
        A.l *= alpha;
#pragma unroll
        for (int i = 0; i < 16; ++i) { A.o[0][i] *= alpha; A.o[1][i] *= alpha; }
    }
    A.m = mnew;
    const float sub = (lane_ok && mnew > -1e29f) ? mnew - bias_c : 1e30f;
    float rs = 0.f;
#pragma unroll
    for (int kb = 0; kb < 2; ++kb)
#pragma unroll
        for (int i = 0; i < 16; ++i) { const float p = __builtin_amdgcn_exp2f(s[kb][i] - sub); s[kb][i] = p; rs += p; }
    rs += __shfl_xor(rs, 32);
    A.l += rs;
    bf16x8 vf[4][2];
#pragma unroll
    for (int s4 = 0; s4 < 4; ++s4)
#pragma unroll
        for (int eb = 0; eb < 2; ++eb) vf[s4][eb] = vt_frag(Vt, voff, s4, eb);
    __builtin_amdgcn_sched_barrier(0);
#pragma unroll
    for (int s4 = 0; s4 < 4; ++s4) {
        const int kb = s4 >> 1, hf = (s4 & 1) * 8;
        u32x4 pw; pw.x = pk_bf16(s[kb][hf + 0], s[kb][hf + 1]); pw.y = pk_bf16(s[kb][hf + 2], s[kb][hf + 3]); pw.z = pk_bf16(s[kb][hf + 4], s[kb][hf + 5]); pw.w = pk_bf16(s[kb][hf + 6], s[kb][hf + 7]);
        const bf16x8 pf = __builtin_bit_cast(bf16x8, pw);
#pragma unroll
        for (int eb = 0; eb < 2; ++eb) A.o[eb] = MFMA32(vf[s4][eb], pf, A.o[eb]);
    }
}
template <int DK>
__device__ __forceinline__ void stage_k_load(u32x4 (&kr)[2], const bf16_t* Kg  , int tid) {
    constexpr int CH = DK / 8;
    kr[0] = *(const u32x4*)(Kg + (size_t)(tid / CH) * DK + (tid % CH) * 8);
    if (64 * CH > 512) { const int c2 = tid + 512; if (c2 < 64 * CH) kr[1] = *(const u32x4*)(Kg + (size_t)(c2 / CH) * DK + (c2 % CH) * 8); }
}
template <int DK>
__device__ __forceinline__ void stage_k_store(const u32x4 (&kr)[2], LAS unsigned char* Kt, int tid) {
    constexpr int CH = DK / 8, KP = 2 * DK + 16;
    *(LAS u32x4*)(Kt + (tid / CH) * KP + (tid % CH) * 16) = kr[0];
    if (64 * CH > 512) { const int c2 = tid + 512; if (c2 < 64 * CH) *(LAS u32x4*)(Kt + (c2 / CH) * KP + (c2 % CH) * 16) = kr[1]; }
}
__device__ __forceinline__ u32x4 stage_v_load(const bf16_t* Vg, int tid) { return *(const u32x4*)(Vg + (size_t)(tid >> 3) * 64 + (tid & 7) * 8); }
__device__ __forceinline__ void stage_v_store(const u32x4& v, LAS unsigned char* Vt, int tid) { *(LAS u32x4*)(Vt + (tid >> 3) * VTP + (tid & 7) * 16) = v; }

constexpr int MLA_KT = 0, MLA_VT = 2 * 64 * 208, MLA_LDS = MLA_VT + 2 * 64 * VTP;
__device__ __forceinline__ void mla_unit(int b, int hd, int qt, int l, unsigned char* ws, LAS unsigned char* lds, int g_wv) {
    int tid_ = TIDX; asm volatile("" : "+v"(tid_));
    const int tid = tid_, w = tid >> 6, lane = tid & 63, r = lane & 31, h = lane >> 5;
    const size_t slab = (size_t)(b * 6 + hd) * 2048;
    const bf16_t* QM = (const bf16_t*)(ws + WS_MLA) + slab * 96; const bf16_t* KM = (const bf16_t*)(ws + WS_MLA + MLA_KM) + slab * 96; const bf16_t* VM = (const bf16_t*)(ws + WS_MLA + MLA_VM) + slab * 64;
    const int q0 = 256 * qt + 32 * w, q = q0 + r;
    bf16x8 qf[6];
#pragma unroll
    for (int ks = 0; ks < 6; ++ks) qf[ks] = *(const bf16x8*)(QM + (size_t)q * 96 + 16 * ks + 8 * h);
    AttnState A; attn_reset(A);
    const int ntile = 4 * qt + 4;
    u32x4 kr[2], vr, kr2[2], vr2;
    stage_k_load<96>(kr, KM, tid); vr = stage_v_load(VM, tid);
    stage_k_store<96>(kr, lds + MLA_KT, tid); stage_v_store(vr, lds + MLA_VT, tid);
    if (ntile > 1) { stage_k_load<96>(kr, KM + (size_t)64 * 96, tid); vr = stage_v_load(VM + (size_t)64 * 64, tid); }
    __syncthreads();
    for (int j = 0; j < ntile; ++j) {
        const int cur = j & 1;
        if (j + 2 < ntile) { stage_k_load<96>(kr2, KM + (size_t)(j + 2) * 64 * 96, tid); vr2 = stage_v_load(VM + (size_t)(j + 2) * 64 * 64, tid); }
        if (64 * j <= q0 + 31) {
            f32x16 s[2];
            attn_scores<96>(s, qf, lds + MLA_KT + cur * 64 * 208, r, h);
            if (64 * j + 63 > q0) {
#pragma unroll
                for (int kb = 0; kb < 2; ++kb)
#pragma unroll
                    for (int i = 0; i < 16; ++i) { const int key = 64 * j + 32 * kb + crow(i, h); if (key > q) s[kb][i] = -1e30f; }
            }
            attn_softmax_pv(A, s, lds + MLA_VT + cur * 64 * VTP, r, h);
        }
        if (j + 1 < ntile) { stage_k_store<96>(kr, lds + MLA_KT + (cur ^ 1) * 64 * 208, tid); stage_v_store(vr, lds + MLA_VT + (cur ^ 1) * 64 * VTP, tid); }
        kr[0] = kr2[0]; kr[1] = kr2[1]; vr = vr2;
        __syncthreads();
    }
    const float inv = A.l > 0.f ? 1.f / A.l : 0.f; float ss = 0.f;
    bf16_t* Y = (bf16_t*)(ws + WS_Y) + ((size_t)b * 2048 + q) * 1024 + 384 + hd * 64;
#pragma unroll
    for (int eb = 0; eb < 2; ++eb)
#pragma unroll
        for (int g4 = 0; g4 < 4; ++g4) {
            const float v0 = A.o[eb][4 * g4] * inv, v1 = A.o[eb][4 * g4 + 1] * inv, v2 = A.o[eb][4 * g4 + 2] * inv, v3 = A.o[eb][4 * g4 + 3] * inv;
            u32x2 pw; pw.x = pk_bf16(v0, v1); pw.y = pk_bf16(v2, v3);
            const float f0 = bf_lo(pw.x), f1 = bf_hi(pw.x), f2 = bf_lo(pw.y), f3 = bf_hi(pw.y); ss += (f0 * f0 + f1 * f1) + (f2 * f2 + f3 * f3);
            *(u32x2*)(Y + 32 * eb + 8 * g4 + 4 * h) = pw;
        }
    ss += __shfl_xor(ss, 32);
    if (h == 0) ((float*)(ws + WS_SSQ + PT_C))[((size_t)l * 16384 + (size_t)b * 2048 + q) * 8 + hd] = ss;
}

__device__ __forceinline__ void nsa_bias32(float (&bv)[2][16], const LAS float* bl, int dd) {
#pragma unroll
    for (int kb = 0; kb < 2; ++kb)
#pragma unroll
        for (int k = 0; k < 16; ++k) { const int c = 63 - (32 * kb + (k & 3) + 8 * (k >> 2)); int d = dd + c; d = d < 0 ? 0 : (d > 255 ? 255 : d); bv[kb][k] = bl[d]; }
}
__device__ __forceinline__ void nsa_mask_bias(f32x16 (&sc)[2], int dq, int h, const LAS float* bl, bool sel, int lim) {
    int dd = dq - 4 * h - 63; asm volatile("" : "+v"(dd));
    float bv[2][16]; nsa_bias32(bv, bl, dd);
#pragma unroll
    for (int kb = 0; kb < 2; ++kb)
#pragma unroll
        for (int k = 0; k < 16; ++k) { const int c = 63 - (32 * kb + (k & 3) + 8 * (k >> 2)); const int d = dd + c; sc[kb][k] = (sel && d >= 0 && d < lim) ? sc[kb][k] + bv[kb][k] : -1e30f; }
}

constexpr int NSA_KT = 0, NSA_VT = 2 * 64 * 144, NSA_BIAS = NSA_VT + 2 * 64 * VTP, NSA_PS = NSA_BIAS + 3 * 256 * 4, NSA_SEL = NSA_PS + 3 * 64 * 32 * 4, NSA_UNI = NSA_SEL + 256, NSA_OT = NSA_UNI + 256, NSA_LDS = NSA_OT + 6 * 8192;
__device__ __forceinline__ void nsa_unit(int b, int hk, int i, int l, InPtr in, unsigned char* ws, LAS unsigned char* lds, int g_wv) {
    int tid_ = TIDX; asm volatile("" : "+v"(tid_));
    const int tid = tid_, w = tid >> 6, lane = tid & 63, r = lane & 31, h = lane >> 5;
    const bool active = w < 6; const int g = active ? (w >> 1) : 0, th = w & 1, head = hk * 3 + g;
    const int t = 64 * i + 32 * th + r, tl = 32 * th + r; const size_t row = (size_t)b * 2048 + t;
    const size_t kvslab = (size_t)(b * 2 + hk) * 2048 * 64;
    LAS float* biasl = (LAS float*)(lds + NSA_BIAS); LAS float* PS = (LAS float*)(lds + NSA_PS); LAS unsigned* SEL = (LAS unsigned*)(lds + NSA_SEL); LAS unsigned* UNI = (LAS unsigned*)(lds + NSA_UNI);
    { const float* bd = (const float*)(ws + WS_BIASD) + (size_t)hk * 3 * 2048;
      if (tid < 384) { const int gg = tid >> 7, d0 = (tid & 127) * 2; biasl[gg * 256 + d0] = bd[gg * 2048 + d0]; biasl[gg * 256 + d0 + 1] = bd[gg * 2048 + d0 + 1]; }
#pragma unroll
      for (int k = 0; k < 12; ++k) if (i >= 16) PS[tid + 512 * k] = 0.f;
      if (tid < 4) UNI[tid] = 0u; }
    bf16x8 qf[4];
    { const bf16_t* QN = (const bf16_t*)(ws + WS_PRJ + PRJ_QN) + ((size_t)(b * 6 + head) * 2048 + t) * 64;
#pragma unroll
      for (int ks = 0; ks < 4; ++ks) qf[ks] = *(const bf16x8*)(QN + 16 * ks + 8 * h); }
#define NSA_GATE(k) ({ int t_ = t; asm volatile("" : "+v"(t_)); sigmf(((const float*)(ws + WS_PRJ + PRJ_GATES))[((size_t)b * 2048 + t_) * 32 + head * 3 + (k)]); })
    LAS float* bl = biasl + g * 256;
    LAS float* otl = (LAS float*)(lds + NSA_OT + (active ? w : 0) * 8192) + lane;
    u32x4 kr[2], vr;
    const int ntc = i >= 16 ? 2 : 1;
    { const bf16_t* KC = (const bf16_t*)(ws + WS_CMP) + (size_t)(b * 2 + hk) * 128 * 64; const bf16_t* VC = (const bf16_t*)(ws + WS_CMP + CMP_V) + (size_t)(b * 2 + hk) * 128 * 64;
      for (int T = 0; T < ntc; ++T) { stage_k_load<64>(kr, KC + T * 4096, tid); vr = stage_v_load(VC + T * 4096, tid); stage_k_store<64>(kr, lds + NSA_KT + T * 64 * 144, tid); stage_v_store(vr, lds + NSA_VT + T * 64 * VTP, tid); } }
    __syncthreads();
    {
        f32x16 ot[2];
        if (active && i < 16) {
            AttnState A; attn_reset(A); f32x16 sc[2]; attn_scores<64>(sc, qf, lds + NSA_KT, r, h);
            float bvc[2][16];
#pragma unroll
            for (int kb = 0; kb < 2; ++kb)
#pragma unroll
                for (int k = 0; k < 16; ++k) { int d = t - 16 * (32 * kb + crow(k, h)) - 31; d = d < 0 ? 0 : (d > 255 ? 255 : d); bvc[kb][k] = bl[d]; }
#pragma unroll
            for (int kb = 0; kb < 2; ++kb)
#pragma unroll
                for (int k = 0; k < 16; ++k) { const int d = t - 16 * (32 * kb + crow(k, h)) - 31; sc[kb][k] = d >= 0 ? sc[kb][k] + bvc[kb][k] : -1e30f; }
            attn_softmax_pv(A, sc, lds + NSA_VT, r, h);
            const float gc = NSA_GATE(0); const float inv = A.l > 0.f ? gc / A.l : 0.f;
#pragma unroll
            for (int k = 0; k < 16; ++k) { otl[64 * k] = A.o[0][k] * inv; otl[64 * (16 + k)] = A.o[1][k] * inv; }
        } else if (active) {
            float m = -1e30f, lsum = 0.f;
            for (int T = 0; T < ntc; ++T) {
                f32x16 sc[2]; attn_scores<64>(sc, qf, lds + NSA_KT + T * 64 * 144, r, h);
                float bvc[2][16];
#pragma unroll
                for (int kb = 0; kb < 2; ++kb)
#pragma unroll
                    for (int k = 0; k < 16; ++k) { int d = t - 16 * (64 * T + 32 * kb + crow(k, h)) - 31; d = d < 0 ? 0 : (d > 255 ? 255 : d); bvc[kb][k] = bl[d]; }
                float mx = -1e30f;
#pragma unroll
                for (int kb = 0; kb < 2; ++kb)
#pragma unroll
                    for (int k = 0; k < 16; ++k) { const int n = 64 * T + 32 * kb + crow(k, h); const int d = t - 16 * n - 31; const float x = (d >= 0 && n < 127) ? sc[kb][k] + bvc[kb][k] : -1e30f; sc[kb][k] = x; mx = fmaxf(mx, x); }
                mx = fmaxf(mx, __shfl_xor(mx, 32));
                const float mnew = fmaxf(m, mx), mref = mnew <= -1e29f ? 0.f : mnew; float rs = 0.f;
#pragma unroll
                for (int kb = 0; kb < 2; ++kb)
#pragma unroll
                    for (int k = 0; k < 16; ++k) rs += __builtin_amdgcn_exp2f(sc[kb][k] - mref);
                rs += __shfl_xor(rs, 32);
                lsum = lsum * __builtin_amdgcn_exp2f(m - mref) + rs; m = mnew;
            }
            const float mref = m <= -1e29f ? 0.f : m, inv = lsum > 0.f ? 1.f / lsum : 0.f;
#pragma unroll
            for (int k = 0; k < 16; ++k) { ot[0][k] = 0.f; ot[1][k] = 0.f; }
            float carry = 0.f;
            for (int T = 0; T < ntc; ++T) {
                f32x16 sc[2]; attn_scores<64>(sc, qf, lds + NSA_KT + T * 64 * 144, r, h);
                float bvc[2][16];
#pragma unroll
                for (int kb = 0; kb < 2; ++kb)
#pragma unroll
                    for (int k = 0; k < 16; ++k) { int d = t - 16 * (64 * T + 32 * kb + crow(k, h)) - 31; d = d < 0 ? 0 : (d > 255 ? 255 : d); bvc[kb][k] = bl[d]; }
#pragma unroll
                for (int kb = 0; kb < 2; ++kb)
#pragma unroll
                    for (int k = 0; k < 16; ++k) { const int n = 64 * T + 32 * kb + crow(k, h); const int d = t - 16 * n - 31; sc[kb][k] = (d >= 0 && n < 127) ? __builtin_amdgcn_exp2f(sc[kb][k] + bvc[kb][k] - mref) * inv : 0.f; }
                float prevL = carry;
#pragma unroll
                for (int kb = 0; kb < 2; ++kb)
#pragma unroll
                    for (int g4 = 0; g4 < 4; ++g4) {
                        const float G4 = (sc[kb][4 * g4] + sc[kb][4 * g4 + 1]) + (sc[kb][4 * g4 + 2] + sc[kb][4 * g4 + 3]); const float L = sc[kb][4 * g4 + 3];
                        const float Lo = __shfl_xor(L, 32);
                        const float add = h ? Lo : prevL;
                        prevL = Lo;
                        const int idx = T * 8 + kb * 4 + g4;
                        PS[g * 2048 + tl * 32 + 2 * idx + h] = G4 + add;
                    }
                carry = prevL;
#pragma unroll
                for (int s4 = 0; s4 < 4; ++s4) {
                    const int kb = s4 >> 1, hf = (s4 & 1) * 8;
                    u32x4 pw; pw.x = pk_bf16(sc[kb][hf + 0], sc[kb][hf + 1]); pw.y = pk_bf16(sc[kb][hf + 2], sc[kb][hf + 3]); pw.z = pk_bf16(sc[kb][hf + 4], sc[kb][hf + 5]); pw.w = pk_bf16(sc[kb][hf + 6], sc[kb][hf + 7]);
                    const bf16x8 pf = __builtin_bit_cast(bf16x8, pw);
#pragma unroll
                    for (int eb = 0; eb < 2; ++eb) ot[eb] = MFMA32(vt_frag(lds + NSA_VT + T * 64 * VTP, vt_lane_off(lane), s4, eb), pf, ot[eb]);
                }
            }
            { const float gc = NSA_GATE(0);
#pragma unroll
            for (int k = 0; k < 16; ++k) { otl[64 * k] = ot[0][k] * gc; otl[64 * (16 + k)] = ot[1][k] * gc; } }
        }
    }
    __syncthreads();
#ifndef NO_NSA_SEL
    if (i < 16) { if (tid < 64) SEL[tid] = (2u << i) - 1u; if (tid < 3) UNI[tid] = (2u << i) - 1u; }
    else {
        const int tk = tid >> 3, sg = tid & 7; float v[32];
#pragma unroll
        for (int k = 0; k < 8; ++k) { const f32x4 x0 = *(const LAS f32x4*)(PS + tk * 32 + 4 * k), x1 = *(const LAS f32x4*)(PS + 2048 + tk * 32 + 4 * k), x2 = *(const LAS f32x4*)(PS + 4096 + tk * 32 + 4 * k);
            v[4 * k] = (x0.x + x1.x) + x2.x; v[4 * k + 1] = (x0.y + x1.y) + x2.y; v[4 * k + 2] = (x0.z + x1.z) + x2.z; v[4 * k + 3] = (x0.w + x1.w) + x2.w; }
#pragma unroll
        for (int s = 0; s < 32; ++s) { const bool forced = (s == 0) || (s == i) || (s == i - 1); float x = forced ? v[s] + 1e4f : v[s]; v[s] = s > i ? -1.f : x; }
        unsigned bits = 0u;
#pragma unroll
        for (int k = 0; k < 4; ++k) {
            float x = 0.f;
#pragma unroll
            for (int s = 0; s < 32; ++s) x = (s == 4 * sg + k) ? v[s] : x;
            int rank = 0;
#pragma unroll
            for (int s = 0; s < 32; ++s) rank += (v[s] > x || (v[s] == x && s < 4 * sg + k)) ? 1 : 0;
            if (rank < 16 && x >= 0.f) bits |= 1u << (4 * sg + k);
        }
        bits |= __shfl_xor(bits, 1); bits |= __shfl_xor(bits, 2); bits |= __shfl_xor(bits, 4);
        if (sg == 0) { SEL[tk] = bits; __hip_atomic_fetch_or(UNI, bits, __ATOMIC_RELAXED, __HIP_MEMORY_SCOPE_WORKGROUP); __hip_atomic_fetch_or(UNI + 1 + (tk >> 5), bits, __ATOMIC_RELAXED, __HIP_MEMORY_SCOPE_WORKGROUP); }
    }
#endif
    __syncthreads();
    const unsigned selbits = SEL[tl], uni = UNI[0], unih = UNI[1 + th];
    const float c31 = bl[255];
#ifndef NO_NSA_SLC
#ifndef NSA_DUP_SLC
#define NSA_DUP_SLC 1
#endif
    for (int rp_ = 0; rp_ < NSA_DUP_SLC; ++rp_) {
        AttnState A; attn_reset(A);
        const bf16_t* KS = (const bf16_t*)(ws + WS_PRJ + PRJ_KN1) + kvslab; const bf16_t* VS = (const bf16_t*)(ws + WS_PRJ + PRJ_VN1) + kvslab;
        unsigned todo = uni; int cur = 0; u32x4 kr2[2], vr2;
        int s = __ffs(todo) - 1; todo &= todo - 1;
        stage_k_load<64>(kr, KS + (size_t)s * 4096, tid); vr = stage_v_load(VS + (size_t)s * 4096, tid);
        stage_k_store<64>(kr, lds + NSA_KT, tid); stage_v_store(vr, lds + NSA_VT, tid);
        int sn = todo ? __ffs(todo) - 1 : -1; todo &= todo - 1;
        if (sn >= 0) { stage_k_load<64>(kr, KS + (size_t)sn * 4096, tid); vr = stage_v_load(VS + (size_t)sn * 4096, tid); }
        __syncthreads();
        while (s >= 0) {
            const int sn2 = todo ? __ffs(todo) - 1 : -1; todo &= todo - 1;
            if (sn2 >= 0) { stage_k_load<64>(kr2, KS + (size_t)sn2 * 4096, tid); vr2 = stage_v_load(VS + (size_t)sn2 * 4096, tid); }
            if (active && ((unih >> s) & 1u)) {
                f32x16 sc[2];
                attn_scores<64>(sc, qf, lds + NSA_KT + cur * 64 * 144, r, h);
                const bool sel = (selbits >> s) & 1u;
                if (i - s >= 3) attn_softmax_pv(A, sc, lds + NSA_VT + cur * 64 * VTP, r, h, c31, sel);
                else { nsa_mask_bias(sc, t - 64 * s, h, bl, sel, 4096); attn_softmax_pv(A, sc, lds + NSA_VT + cur * 64 * VTP, r, h); }
            }
            if (sn >= 0) { stage_k_store<64>(kr, lds + NSA_KT + (cur ^ 1) * 64 * 144, tid); stage_v_store(vr, lds + NSA_VT + (cur ^ 1) * 64 * VTP, tid); }
            kr[0] = kr2[0]; vr = vr2;
            __syncthreads();
            s = sn; sn = sn2; cur ^= 1;
        }
        if (active && rp_ == NSA_DUP_SLC - 1) { const float gs = NSA_GATE(1); const float inv = A.l > 0.f ? gs / A.l : 0.f;
#pragma unroll
            for (int k = 0; k < 16; ++k) { otl[64 * k] += A.o[0][k] * inv; otl[64 * (16 + k)] += A.o[1][k] * inv; } }
    }
#endif
#ifndef NO_NSA_WIN
#ifndef NSA_DUP_WIN
#define NSA_DUP_WIN 1
#endif
    for (int rq_ = 0; rq_ < NSA_DUP_WIN; ++rq_) {
        AttnState A; attn_reset(A);
        const bf16_t* KW = (const bf16_t*)(ws + WS_PRJ + PRJ_KN2) + kvslab; const bf16_t* VW = (const bf16_t*)(ws + WS_PRJ + PRJ_VN2) + kvslab;
        const int j0 = i > 8 ? i - 8 : 0; int cur = 0; u32x4 kr2[2], vr2;
        stage_k_load<64>(kr, KW + (size_t)j0 * 4096, tid); vr = stage_v_load(VW + (size_t)j0 * 4096, tid);
        stage_k_store<64>(kr, lds + NSA_KT, tid); stage_v_store(vr, lds + NSA_VT, tid);
        if (j0 < i) { stage_k_load<64>(kr, KW + (size_t)(j0 + 1) * 4096, tid); vr = stage_v_load(VW + (size_t)(j0 + 1) * 4096, tid); }
        __syncthreads();
        for (int j = j0; j <= i; ++j) {
            if (j + 2 <= i) { stage_k_load<64>(kr2, KW + (size_t)(j + 2) * 4096, tid); vr2 = stage_v_load(VW + (size_t)(j + 2) * 4096, tid); }
            if (active) {
                f32x16 sc[2];
                attn_scores<64>(sc, qf, lds + NSA_KT + cur * 64 * 144, r, h);
                if (i - j >= 3 && j > i - 8) attn_softmax_pv(A, sc, lds + NSA_VT + cur * 64 * VTP, r, h, c31, true);
                else { nsa_mask_bias(sc, t - 64 * j, h, bl, true, 512); attn_softmax_pv(A, sc, lds + NSA_VT + cur * 64 * VTP, r, h); }
            }
            if (j < i) { stage_k_store<64>(kr, lds + NSA_KT + (cur ^ 1) * 64 * 144, tid); stage_v_store(vr, lds + NSA_VT + (cur ^ 1) * 64 * VTP, tid); }
            kr[0] = kr2[0]; vr = vr2;
            __syncthreads();
            cur ^= 1;
        }
        if (active && rq_ == NSA_DUP_WIN - 1) { const float gw = NSA_GATE(2); const float inv = A.l > 0.f ? gw / A.l : 0.f;
            float ss = 0.f; bf16_t* Y = (bf16_t*)(ws + WS_Y) + row * 1024 + head * 64;
#pragma unroll
            for (int eb = 0; eb < 2; ++eb)
#pragma unroll
                for (int g4 = 0; g4 < 4; ++g4) {
                    const float v0 = otl[64 * (16 * eb + 4 * g4)] + A.o[eb][4 * g4] * inv, v1 = otl[64 * (16 * eb + 4 * g4 + 1)] + A.o[eb][4 * g4 + 1] * inv;
                    const float v2 = otl[64 * (16 * eb + 4 * g4 + 2)] + A.o[eb][4 * g4 + 2] * inv, v3 = otl[64 * (16 * eb + 4 * g4 + 3)] + A.o[eb][4 * g4 + 3] * inv;
                    u32x2 pw; pw.x = pk_bf16(v0, v1); pw.y = pk_bf16(v2, v3);
                    const float f0 = bf_lo(pw.x), f1 = bf_hi(pw.x), f2 = bf_lo(pw.y), f3 = bf_hi(pw.y); ss += (f0 * f0 + f1 * f1) + (f2 * f2 + f3 * f3);
                    *(u32x2*)(Y + 32 * eb + 8 * g4 + 4 * h) = pw;
                }
            ss += __shfl_xor(ss, 32);
            if (h == 0) ((float*)(ws + WS_SSQ + PT_A))[((size_t)l * 16384 + row) * 8 + head] = ss;
        }
    }
#endif
}

__device__ __forceinline__ void ml_out_wave(int cu, int l, InPtr in, unsigned char* ws, LAS unsigned char* wl, LAS unsigned char* npl, int lane) {
    const int c = cu & 31, bh = cu >> 5, hd = bh & 3, b = bh >> 2; const int t0 = c * 64; const int r = lane & 15, q = lane >> 4;
    const bf16_t* QC = (const bf16_t*)(ws + WS_ML) + ((size_t)bh * 2048 + t0) * 64; const bf16_t* KC = (const bf16_t*)(ws + WS_ML + ML_KC) + ((size_t)bh * 2048 + t0) * 64;
    const bf16_t* V = (const bf16_t*)(ws + WS_PRJ + PRJ_VML) + ((size_t)bh * 2048 + t0) * 64;
    const float* mlg = (const float*)(ws + WS_ML + ML_G) + ((size_t)bh * 2048 + t0) * 2;
    const bf16_t* CP = (const bf16_t*)(ws + WS_ML + ML_CP) + (size_t)cu * 4096; const bf16_t* NP = (const bf16_t*)(ws + WS_ML + ML_NP) + (size_t)cu * 64;
    u32x4 vch[8];
#pragma unroll
    for (int i = 0; i < 8; ++i) vch[i] = *(const u32x4*)(V + (size_t)(lane + 64 * i) * 8);
    bf16x8 aq[4][2];
#pragma unroll
    for (int mb = 0; mb < 4; ++mb)
#pragma unroll
        for (int ks = 0; ks < 2; ++ks) aq[mb][ks] = *(const bf16x8*)(QC + (size_t)(16 * mb + r) * 64 + 32 * ks + 8 * q);
    float bj[4][4], den[4][4];
#pragma unroll
    for (int mb = 0; mb < 4; ++mb)
#pragma unroll
        for (int j = 0; j < 4; ++j) bj[mb][j] = mlg[(16 * mb + 4 * q + j) * 2];
    {
        float cs[4];
#pragma unroll
        for (int nb = 0; nb < 4; ++nb) { const float2 gg = *(const float2*)(mlg + (16 * nb + r) * 2); cs[nb] = gg.y - gg.x; }
#pragma unroll
        for (int mb = 0; mb < 4; ++mb) {
            f32x4 accS[4];
#pragma unroll
            for (int nb = 0; nb < 4; ++nb) { accS[nb] = (f32x4){0.f, 0.f, 0.f, 0.f};
#pragma unroll
                for (int ks = 0; ks < 2; ++ks) { const bf16x8 bk = *(const bf16x8*)(KC + (size_t)(16 * nb + r) * 64 + 32 * ks + 8 * q); accS[nb] = MFMA16(aq[mb][ks], bk, accS[nb]); } }
#pragma unroll
            for (int j = 0; j < 4; ++j) {
                const int jj = 16 * mb + 4 * q + j; float rs = 0.f;
#pragma unroll
                for (int nb = 0; nb < 4; ++nb) { const int s = 16 * nb + r; const float p = s <= jj ? accS[nb][j] * __expf(bj[mb][j] + cs[nb]) : 0.f; rs += p;
                    *(LAS bf16_t*)(wl + 8192 + swz_off(jj, s >> 3) + (s & 7) * 2) = f2bf(p); }
                rs += __shfl_xor(rs, 1); rs += __shfl_xor(rs, 2); rs += __shfl_xor(rs, 4); rs += __shfl_xor(rs, 8);
                den[mb][j] = rs;
            }
        }
    }
#pragma unroll
    for (int i = 0; i < 8; ++i) { const int ch = lane + 64 * i, sv = ch >> 3, e0 = (ch & 7) * 8; const unsigned xs[4] = {vch[i].x, vch[i].y, vch[i].z, vch[i].w};
#pragma unroll
        for (int k = 0; k < 4; ++k) { *(LAS bf16_t*)(wl + swz_off(e0 + 2 * k, sv >> 3) + (sv & 7) * 2) = (bf16_t)(xs[k] & 0xffffu); *(LAS bf16_t*)(wl + swz_off(e0 + 2 * k + 1, sv >> 3) + (sv & 7) * 2) = (bf16_t)(xs[k] >> 16); } }
#pragma unroll
    for (int mb = 0; mb < 4; ++mb) { const float e = __expf(mlg[(16 * mb + r) * 2]);
#pragma unroll
        for (int ks = 0; ks < 2; ++ks) { const u32x4 x = __builtin_bit_cast(u32x4, aq[mb][ks]); u32x4 y;
            y.x = pk_bf16(bf_lo(x.x) * e, bf_hi(x.x) * e); y.y = pk_bf16(bf_lo(x.y) * e, bf_hi(x.y) * e); y.z = pk_bf16(bf_lo(x.z) * e, bf_hi(x.z) * e); y.w = pk_bf16(bf_lo(x.w) * e, bf_hi(x.w) * e);
            aq[mb][ks] = __builtin_bit_cast(bf16x8, y); } }
    f32x4 acc[4][4], accn[4];
#pragma unroll
    for (int mb = 0; mb < 4; ++mb) { accn[mb] = (f32x4){0.f, 0.f, 0.f, 0.f};
#pragma unroll
        for (int nb = 0; nb < 4; ++nb) acc[mb][nb] = (f32x4){0.f, 0.f, 0.f, 0.f}; }
#pragma unroll
    for (int ks = 0; ks < 2; ++ks) {
        u32x4 nz = *(const u32x4*)(NP + 32 * ks + 8 * q); if (r != 0) nz = (u32x4){0u, 0u, 0u, 0u};
        const bf16x8 bn = __builtin_bit_cast(bf16x8, nz);
#pragma unroll
        for (int nb = 0; nb < 4; ++nb) { const bf16x8 bb = *(const bf16x8*)(CP + (size_t)(16 * nb + r) * 64 + 32 * ks + 8 * q);
#pragma unroll
            for (int mb = 0; mb < 4; ++mb) acc[mb][nb] = MFMA16(aq[mb][ks], bb, acc[mb][nb]); }
#pragma unroll
        for (int mb = 0; mb < 4; ++mb) accn[mb] = MFMA16(aq[mb][ks], bn, accn[mb]);
    }
    LDS_FENCE();
#pragma unroll
    for (int ks = 0; ks < 2; ++ks) {
        bf16x8 ap[4];
#pragma unroll
        for (int mb = 0; mb < 4; ++mb) ap[mb] = *(const LAS bf16x8*)(wl + 8192 + swz_off(16 * mb + r, 4 * ks + q));
#pragma unroll
        for (int nb = 0; nb < 4; ++nb) { const bf16x8 bv = *(const LAS bf16x8*)(wl + swz_off(16 * nb + r, 4 * ks + q));
#pragma unroll
            for (int mb = 0; mb < 4; ++mb) acc[mb][nb] = MFMA16(ap[mb], bv, acc[mb][nb]); }
    }
    LDS_FENCE();
    const bf16_t* OG = (const bf16_t*)(ws + WS_PRJ + PRJ_OG); u32x4 ogc[8];
#pragma unroll
    for (int i = 0; i < 8; ++i) { const int ch = lane + 64 * i; ogc[i] = *(const u32x4*)(OG + ((size_t)b * 2048 + t0 + (ch >> 3)) * 256 + hd * 64 + (ch & 7) * 8); }
    const float* gain = in->p[14] + l * 256 + hd * 64;
    bf16_t* Y = (bf16_t*)(ws + WS_Y);
    float gn[4];
#pragma unroll
    for (int nb = 0; nb < 4; ++nb) gn[nb] = gain[16 * nb + r];
#pragma unroll
    for (int mb = 0; mb < 4; ++mb)
#pragma unroll
        for (int j = 0; j < 4; ++j) {
            const int jj = 16 * mb + 4 * q + j;
            const float dn = den[mb][j] + __builtin_bit_cast(float, __builtin_amdgcn_ds_bpermute((lane & 48) << 2, __builtin_bit_cast(int, accn[mb][j])));
            const float inv = __builtin_amdgcn_rcpf(fmaxf(fabsf(dn), 1.f)); float hv[4]; float ss = 0.f;
#pragma unroll
            for (int nb = 0; nb < 4; ++nb) { hv[nb] = acc[mb][nb][j] * inv; ss += hv[nb] * hv[nb]; }
            ss += __shfl_xor(ss, 1); ss += __shfl_xor(ss, 2); ss += __shfl_xor(ss, 4); ss += __shfl_xor(ss, 8);
            const float rstd = rsqrtf(ss * (1.f / 64.f) + 1e-6f);
#pragma unroll
            for (int nb = 0; nb < 4; ++nb) { const int e = 16 * nb + r; *(LAS bf16_t*)(wl + 8192 + swz_off(jj, e >> 3) + (e & 7) * 2) = f2bf(hv[nb] * rstd * gn[nb]); }
        }
    LDS_FENCE();
#pragma unroll
    for (int i = 0; i < 8; ++i) { const int ch = lane + 64 * i, row = ch >> 3, e8 = ch & 7;
        const u32x4 hx = *(const LAS u32x4*)(wl + 8192 + swz_off(row, e8)); const u32x4 g = ogc[i]; u32x4 o;
        o.x = pk_bf16(bf_lo(hx.x) * sigmf(bf_lo(g.x)), bf_hi(hx.x) * sigmf(bf_hi(g.x)));
        o.y = pk_bf16(bf_lo(hx.y) * sigmf(bf_lo(g.y)), bf_hi(hx.y) * sigmf(bf_hi(g.y)));
        o.z = pk_bf16(bf_lo(hx.z) * sigmf(bf_lo(g.z)), bf_hi(hx.z) * sigmf(bf_hi(g.z)));
        o.w = pk_bf16(bf_lo(hx.w) * sigmf(bf_lo(g.w)), bf_hi(hx.w) * sigmf(bf_hi(g.w)));
        *(u32x4*)(Y + ((size_t)b * 2048 + t0 + row) * 1024 + 768 + hd * 64 + e8 * 8) = o; }
    LDS_FENCE();
}

__device__ __forceinline__ void ml_scan_unit(int bh, int l, unsigned char* ws, int g_wv) {
    int tid_ = TIDX; asm volatile("" : "+v"(tid_)); const int tid = tid_;
    const bf16_t* DL = (const bf16_t*)(ws + WS_ML + ML_DELTA) + (size_t)bh * 32 * 4096 + tid * 8; bf16_t* CP = (bf16_t*)(ws + WS_ML + ML_CP) + (size_t)bh * 32 * 4096 + tid * 8;
    const float* DN = (const float*)(ws + WS_ML + ML_DN) + (size_t)bh * 32 * 64; bf16_t* NP = (bf16_t*)(ws + WS_ML + ML_NP) + (size_t)bh * 32 * 64; const float* BL = (const float*)(ws + WS_ML + ML_BL) + bh * 32;
    float c[8]; float n = 0.f;
#pragma unroll
    for (int k = 0; k < 8; ++k) c[k] = 0.f;
#pragma unroll 1
    for (int c0 = 0; c0 < 32; c0 += 8) {
        u32x4 d[8]; float dn[8], co[8];
#pragma unroll
        for (int k = 0; k < 8; ++k) { d[k] = *(const u32x4*)(DL + (size_t)(c0 + k) * 4096); dn[k] = tid < 64 ? DN[(c0 + k) * 64 + tid] : 0.f; co[k] = __expf(BL[c0 + k]); }
#pragma unroll
        for (int k = 0; k < 8; ++k) {
            u32x4 o; o.x = pk_bf16(c[0], c[1]); o.y = pk_bf16(c[2], c[3]); o.z = pk_bf16(c[4], c[5]); o.w = pk_bf16(c[6], c[7]);
            *(u32x4*)(CP + (size_t)(c0 + k) * 4096) = o; if (tid < 64) NP[(c0 + k) * 64 + tid] = f2bf(n);
            c[0] = co[k] * c[0] + bf_lo(d[k].x); c[1] = co[k] * c[1] + bf_hi(d[k].x); c[2] = co[k] * c[2] + bf_lo(d[k].y); c[3] = co[k] * c[3] + bf_hi(d[k].y);
            c[4] = co[k] * c[4] + bf_lo(d[k].z); c[5] = co[k] * c[5] + bf_hi(d[k].z); c[6] = co[k] * c[6] + bf_lo(d[k].w); c[7] = co[k] * c[7] + bf_hi(d[k].w);
            n = co[k] * n + dn[k];
        }
    }
    asm volatile("s_waitcnt vmcnt(0)" ::: "memory"); __syncthreads();
    if (tid == 0) { __builtin_amdgcn_fence(__ATOMIC_RELEASE, "agent"); asm volatile("s_waitcnt vmcnt(0)" ::: "memory");
        __hip_atomic_fetch_add((unsigned*)(ws + WS_CTL) + CW_SCAN + 64 * l, 1u, __ATOMIC_RELAXED, __HIP_MEMORY_SCOPE_AGENT); }
}
__device__ __forceinline__ void ml_scan_wait(int l, unsigned char* ws, int g_wv) {
    if (TIDX == 0) { unsigned* p = (unsigned*)(ws + WS_CTL) + CW_SCAN + 64 * l; unsigned sp = 0;
        while (__hip_atomic_load(p, __ATOMIC_RELAXED, __HIP_MEMORY_SCOPE_AGENT) < 32u) { __builtin_amdgcn_s_sleep(2); if (++sp > (1u << 22)) break; }
        __builtin_amdgcn_fence(__ATOMIC_ACQUIRE, "agent"); asm volatile("s_waitcnt vmcnt(0)" ::: "memory"); }
    __syncthreads();
}

#ifndef DUP_NSA
#define DUP_NSA 1
#endif
#ifndef DUP_MLA
#define DUP_MLA 1
#endif
#ifndef DUP_ML
#define DUP_ML 1
#endif
#ifdef NO_MLA
#define MLA_CALL(...) do {} while (0)
#else
#define MLA_CALL(...) do { for (int rp = 0; rp < DUP_MLA; ++rp) { if (rp) __syncthreads(); mla_unit(__VA_ARGS__); } } while (0)
#endif
__device__ __forceinline__ void phase_mix(int l, InPtr in, unsigned char* ws, LAS unsigned char* lds, unsigned* qhead, int g_wv) {
    LAS int* slot = (LAS int*)(lds + LDS_MISC + 64);
    for (;;) {
        __syncthreads();
        if (TIDX == 0) *slot = (int)__hip_atomic_fetch_add(qhead, 1u, __ATOMIC_RELAXED, __HIP_MEMORY_SCOPE_AGENT);
        __syncthreads();
        int u = *slot;
        if (u >= 32 + 512 + 384 + 128) break;
        if (u < 32) { ml_scan_unit(u, l, ws, g_wv); continue; } u -= 32;
#ifndef NO_NSA
        if (u < 256) { const int i = 31 - (u >> 4), bh = u & 15; { for (int rp = 0; rp < DUP_NSA; ++rp) { if (rp) __syncthreads(); nsa_unit(bh >> 1, bh & 1, i, l, in, ws, lds, g_wv); } } continue; }
#endif
        u -= 256;
        if (u < 192) { const int qt = 7 - u / 48, bh = u % 48; MLA_CALL(bh / 6, bh % 6, qt, l, ws, lds, g_wv); continue; }
        u -= 192;
#ifndef NO_NSA
        if (u < 128) { const int i = 15 - (u >> 4), bh = u & 15; { for (int rp = 0; rp < DUP_NSA; ++rp) { if (rp) __syncthreads(); nsa_unit(bh >> 1, bh & 1, i, l, in, ws, lds, g_wv); } } continue; }
#endif
        u -= 128;
        if (u < 192) { const int qt = 3 - u / 48, bh = u % 48; MLA_CALL(bh / 6, bh % 6, qt, l, ws, lds, g_wv); continue; } u -= 192;
#ifndef NO_NSA
        if (u < 128) { const int i = 7 - (u >> 4), bh = u & 15; { for (int rp = 0; rp < DUP_NSA; ++rp) { if (rp) __syncthreads(); nsa_unit(bh >> 1, bh & 1, i, l, in, ws, lds, g_wv); } } continue; }
#endif
        u -= 128;
#ifndef NO_MLOUT
        ml_scan_wait(l, ws, g_wv);
        for (int rp = 0; rp < DUP_ML; ++rp) { int tid_ = TIDX; asm volatile("" : "+v"(tid_)); const int w = tid_ >> 6; ml_out_wave(u * 8 + w, l, in, ws, lds + w * 16384, lds + 131072 + w * 256, tid_ & 63); }
#endif
    }
}
__device__ __forceinline__ void phase_ynorm(int l, unsigned char* ws, int bid, int nb, int g_wv) {
    int tid_ = TIDX; asm volatile("" : "+v"(tid_)); const int w = tid_ >> 6, lane = tid_ & 63;
    bf16_t* Y = (bf16_t*)(ws + WS_Y); const float* sa = (const float*)(ws + WS_SSQ + PT_A) + (size_t)l * 16384 * 8; const float* sc = (const float*)(ws + WS_SSQ + PT_C) + (size_t)l * 16384 * 8;
    for (int r0 = (bid * 8 + w) * 8; r0 < NTOK; r0 += nb * 64) {
        if (lane < 48) {
            u32x4 x[8], y[8]; float ra[8], rc[8];
#pragma unroll
            for (int k = 0; k < 8; ++k) { const int row = r0 + k;
                const f32x4 a0 = *(const f32x4*)(sa + (size_t)row * 8), a1 = *(const f32x4*)(sa + (size_t)row * 8 + 4), c0 = *(const f32x4*)(sc + (size_t)row * 8), c1 = *(const f32x4*)(sc + (size_t)row * 8 + 4);
                ra[k] = rsqrtf((((a0.x + a0.y) + (a0.z + a0.w)) + (a1.x + a1.y)) * (1.f / 384.f) + 1e-6f); rc[k] = rsqrtf((((c0.x + c0.y) + (c0.z + c0.w)) + (c1.x + c1.y)) * (1.f / 384.f) + 1e-6f);
                x[k] = *((const u32x4*)(Y + (size_t)row * 1024) + lane); y[k] = *((const u32x4*)(Y + (size_t)row * 1024 + 384) + lane); }
#pragma unroll
            for (int k = 0; k < 8; ++k) { const int row = r0 + k; u32x4 a = x[k], c = y[k]; const float fa = ra[k], fc = rc[k];
                a.x = pk_bf16(bf_lo(a.x) * fa, bf_hi(a.x) * fa); a.y = pk_bf16(bf_lo(a.y) * fa, bf_hi(a.y) * fa); a.z = pk_bf16(bf_lo(a.z) * fa, bf_hi(a.z) * fa); a.w = pk_bf16(bf_lo(a.w) * fa, bf_hi(a.w) * fa);
                c.x = pk_bf16(bf_lo(c.x) * fc, bf_hi(c.x) * fc); c.y = pk_bf16(bf_lo(c.y) * fc, bf_hi(c.y) * fc); c.z = pk_bf16(bf_lo(c.z) * fc, bf_hi(c.z) * fc); c.w = pk_bf16(bf_lo(c.w) * fc, bf_hi(c.w) * fc);
                *((u32x4*)(Y + (size_t)row * 1024) + lane) = a; *((u32x4*)(Y + (size_t)row * 1024 + 384) + lane) = c; }
        }
    }
}
constexpr int LDS_FAC = 131072 + 2048;
__device__ __forceinline__ void outproj_factors(int l, unsigned char* ws, LAS unsigned char* lds, int pm, int tid) {
    asm volatile("" : "+v"(tid));
    if (tid < 256) { const int row = pm * 256 + tid; const float* sa = (const float*)(ws + WS_SSQ + PT_A) + ((size_t)l * 16384 + row) * 8; const float* sc = (const float*)(ws + WS_SSQ + PT_C) + ((size_t)l * 16384 + row) * 8;
        const f32x4 a0 = *(const f32x4*)sa, a1 = *(const f32x4*)(sa + 4), c0 = *(const f32x4*)sc, c1 = *(const f32x4*)(sc + 4);
        const float ra = rsqrtf((((a0.x + a0.y) + (a0.z + a0.w)) + (a1.x + a1.y)) * (1.f / 384.f) + 1e-6f), rc = rsqrtf((((c0.x + c0.y) + (c0.z + c0.w)) + (c1.x + c1.y)) * (1.f / 384.f) + 1e-6f);
        LAS float* F = (LAS float*)(lds + LDS_FAC); F[2 * tid] = ra / rc; F[2 * tid + 1] = rc; }
    __syncthreads();
}
struct EpiOut {
    static constexpr bool KHOOK = true;
    bf16_t* XB; float* ssq; const LAS float* F; bool fold;
    __device__ __forceinline__ void kscale(f32x4 (&acc)[2][2][4][2], int which, int wr, int fr) const {
        if (!fold) return;
#pragma unroll
        for (int ai = 0; ai < 2; ++ai)
#pragma unroll
            for (int m = 0; m < 4; ++m) { const float f = F[2 * (ai * 128 + wr * 64 + m * 16 + fr) + which];
#pragma unroll
                for (int bj = 0; bj < 2; ++bj)
#pragma unroll
                    for (int n = 0; n < 2; ++n) acc[ai][bj][m][n] = acc[ai][bj][m][n] * f; }
    }
    __device__ __forceinline__ void operator()(const f32x4 (&acc)[2][2][4][2], const GUnit& u, int wr, int wc, int fr, int fq) const {
#pragma unroll
        for (int ai = 0; ai < 2; ++ai)
#pragma unroll
          for (int mh = 0; mh < 2; ++mh) {
            __builtin_amdgcn_sched_barrier(0);
            u32x4 xr[2][2];
#pragma unroll
            for (int m2 = 0; m2 < 2; ++m2)
#pragma unroll
                for (int bj = 0; bj < 2; ++bj) xr[m2][bj] = *(const u32x4*)(XB + (size_t)(u.pm * 256 + ai * 128 + wr * 64 + (2 * mh + m2) * 16 + fr) * 1024 + u.pn * 256 + bj * 128 + wc * 32 + 8 * fq);
#pragma unroll
            for (int m2 = 0; m2 < 2; ++m2) {
                const int m = 2 * mh + m2; const int row = u.pm * 256 + ai * 128 + wr * 64 + m * 16 + fr; float ss = 0.f;
#pragma unroll
                for (int bj = 0; bj < 2; ++bj) {
                    const u32x4 x = xr[m2][bj]; u32x4 o;
                    o.x = pk_bf16(bf_lo(x.x) + acc[ai][bj][m][0][0], bf_hi(x.x) + acc[ai][bj][m][0][1]); o.y = pk_bf16(bf_lo(x.y) + acc[ai][bj][m][0][2], bf_hi(x.y) + acc[ai][bj][m][0][3]);
                    o.z = pk_bf16(bf_lo(x.z) + acc[ai][bj][m][1][0], bf_hi(x.z) + acc[ai][bj][m][1][1]); o.w = pk_bf16(bf_lo(x.w) + acc[ai][bj][m][1][2], bf_hi(x.w) + acc[ai][bj][m][1][3]);
                    *(u32x4*)(XB + (size_t)row * 1024 + u.pn * 256 + bj * 128 + wc * 32 + 8 * fq) = o;
                    ss += (bf_lo(o.x) * bf_lo(o.x) + bf_hi(o.x) * bf_hi(o.x)) + (bf_lo(o.y) * bf_lo(o.y) + bf_hi(o.y) * bf_hi(o.y)) + (bf_lo(o.z) * bf_lo(o.z) + bf_hi(o.z) * bf_hi(o.z)) + (bf_lo(o.w) * bf_lo(o.w) + bf_hi(o.w) * bf_hi(o.w));
                }
                ss = quad_sum(ss); if (fq == 0) ssq[(size_t)row * 16 + u.pn * 4 + wc] = ss;
            }
          }
    }
};

__device__ __forceinline__ float sum16(const float* p) { const f32x4 a = *(const f32x4*)p, b = *(const f32x4*)(p + 4), c = *(const f32x4*)(p + 8), d = *(const f32x4*)(p + 12);
    return (((a.x + a.y) + (a.z + a.w)) + ((b.x + b.y) + (b.z + b.w))) + (((c.x + c.y) + (c.z + c.w)) + ((d.x + d.y) + (d.z + d.w))); }
__device__ __forceinline__ void phase_route(int l, InPtr in, unsigned char* ws, LAS unsigned char* lds, int bid, int nb, int g_wv) {
    int tid_ = TIDX; asm volatile("" : "+v"(tid_)); const int w = tid_ >> 6, lane = tid_ & 63, r = lane & 15, q = lane >> 4;
    const bf16_t* XB = (const bf16_t*)(ws + WS_XB); const bf16_t* WR = (const bf16_t*)(ws + WS_WR) + (size_t)l * 64 * 1024;
    const float* ssq = (const float*)(ws + WS_SSQ + PT_X1) + (size_t)l * 16384 * 16; const float* bg = in->p[24] + l * 4; const float* be = in->p[26] + l * 32;
    unsigned* cnt = (unsigned*)(ws + WS_CTL) + CW_CNT + 2048 * l; unsigned* mtok = (unsigned*)(ws + WS_META); float* mw = (float*)(ws + WS_META + META_W);
    LAS float* lg = (LAS float*)(lds + w * 4096);
    LAS unsigned* lcnt = (LAS unsigned*)(lds + 32768); LAS unsigned* lbase = lcnt + 32;
    for (int g0 = bid * 8; g0 < NTOK / 16; g0 += nb * 8) {
        if (tid_ < 32) lcnt[tid_] = 0u;
        __syncthreads();
        const int tok0 = (g0 + w) * 16; f32x4 acc[3];
#pragma unroll
        for (int n = 0; n < 3; ++n) acc[n] = (f32x4){0.f, 0.f, 0.f, 0.f};
        const bf16_t* ap = XB + (size_t)(tok0 + r) * 1024 + 8 * q; const bf16_t* bp = WR + (size_t)r * 1024 + 8 * q;
#pragma unroll 1
        for (int kc = 0; kc < 4; ++kc) {
            bf16x8 a[8], bb[3][8];
#pragma unroll
            for (int s = 0; s < 8; ++s) { a[s] = *(const bf16x8*)(ap + 32 * (kc * 8 + s));
#pragma unroll
                for (int n = 0; n < 3; ++n) bb[n][s] = *(const bf16x8*)(bp + (size_t)n * 16 * 1024 + 32 * (kc * 8 + s)); }
            __builtin_amdgcn_sched_barrier(0);
#pragma unroll
            for (int s = 0; s < 8; ++s)
#pragma unroll
                for (int n = 0; n < 3; ++n) acc[n] = MFMA16(a[s], bb[n][s], acc[n]);
            __builtin_amdgcn_sched_barrier(0);
        }
#pragma unroll
        for (int n = 0; n < 3; ++n)
#pragma unroll
            for (int j = 0; j < 4; ++j) lg[(4 * q + j) * 48 + 16 * n + r] = acc[n][j];
        LDS_FENCE();
        int E0 = 0, E1 = 0; unsigned r0 = 0, r1 = 0; float wt0 = 0.f, wt1 = 0.f; const int tok = tok0 + (lane & 15);
        if (lane < 16) {
            const float rs = rsqrtf(sum16(ssq + (size_t)tok * 16) * (1.f / 1024.f) + 1e-6f); ((float*)(ws + WS_RS2))[tok] = rs; const LAS float* L = lg + lane * 48;
            float gl[4]; int gi = 0;
#pragma unroll
            for (int j = 0; j < 4; ++j) gl[j] = L[j] * rs + bg[j];
            float gm = gl[0];
#pragma unroll
            for (int j = 1; j < 4; ++j) if (gl[j] > gm) { gm = gl[j]; gi = j; }
            float gsum = 0.f;
#pragma unroll
            for (int j = 0; j < 4; ++j) gsum += __expf(gl[j] - gm);
            const float gtop = 1.f / gsum;
            float el[8];
#pragma unroll
            for (int j = 0; j < 8; ++j) el[j] = L[4 + gi * 8 + j] * rs + be[gi * 8 + j];
            int e0 = 0; float v0 = el[0];
#pragma unroll
            for (int j = 1; j < 8; ++j) if (el[j] > v0) { v0 = el[j]; e0 = j; }
            int e1 = -1; float v1 = -3.0e38f;
#pragma unroll
            for (int j = 0; j < 8; ++j) if (j != e0 && el[j] > v1) { v1 = el[j]; e1 = j; }
            const float w0 = 1.f / (1.f + __expf(v1 - v0)); E0 = gi * 8 + e0; E1 = gi * 8 + e1; wt0 = w0 * gtop; wt1 = (1.f - w0) * gtop;
            r0 = __hip_atomic_fetch_add(lcnt + E0, 1u, __ATOMIC_RELAXED, __HIP_MEMORY_SCOPE_WORKGROUP); r1 = __hip_atomic_fetch_add(lcnt + E1, 1u, __ATOMIC_RELAXED, __HIP_MEMORY_SCOPE_WORKGROUP);
        }
        __syncthreads();
        if (tid_ < 32) { const unsigned c = lcnt[tid_]; lbase[tid_] = c ? atomicAdd(cnt + tid_ * 64, c) : 0u; }
        __syncthreads();
        if (lane < 16) {
            const unsigned p0 = lbase[E0] + r0, p1 = lbase[E1] + r1;
            mtok[(size_t)E0 * 16384 + p0] = (unsigned)tok; mw[(size_t)E0 * 16384 + p0] = wt0;
            mtok[(size_t)E1 * 16384 + p1] = (unsigned)tok | 0x80000000u; mw[(size_t)E1 * 16384 + p1] = wt1;
        }
        __syncthreads();
    }
}

constexpr int LDS_TB = 131072 + 2048;
__device__ __forceinline__ void moe_tables(int l, unsigned char* ws, LAS unsigned char* lds, int g_wv) {
    int tix = TIDX; asm volatile("" : "+v"(tix));
    LAS int* tb = (LAS int*)(lds + LDS_TB);
    if (tix < 32) { const unsigned* cnt = (const unsigned*)(ws + WS_CTL) + CW_CNT + 2048 * l; tb[160 + tix] = (int)__hip_atomic_load(cnt + tix * 64, __ATOMIC_RELAXED, __HIP_MEMORY_SCOPE_AGENT); }
    __syncthreads();
    if (tix == 0) { int a = 0, f = 0, p = 0; for (int e = 0; e < 32; ++e) { const int c = tb[160 + e]; tb[e] = a; tb[48 + e] = f; tb[96 + e] = p; a += (c + 255) >> 8; f += c >> 8; p += (c & 255) ? 1 : 0; } tb[32] = a; tb[80] = f; tb[128] = p; }
    __syncthreads();
}
template <int NPN, bool GATHER_>
struct MoeSched {
    static constexpr bool GATHER = GATHER_, PARTIAL = false;
    const char* A; const char* Bt; const unsigned* cnt; const unsigned* mtok; const LAS int* tb; int G, c; size_t bstride_e  , bstride_pn; int lo, hi;
    __device__ __forceinline__ bool next(int i, GUnit& u) const {
        const int L = lo + i * G + c; if (L >= hi) return false;
        const int tile = L / NPN, pn = L % NPN;
        int e = 0;
        for (int k = 1; k < 32; ++k) e = (tb[k] <= tile) ? k : e;
        e = __builtin_amdgcn_readfirstlane(e);
        u.e = e; u.pm = tile; u.pn = pn; u.rows = tb[160 + e] - 256 * (tile - tb[e]);
        u.a = GATHER ? A : A + (size_t)tile * 256 * 256 * 2;
        u.b = Bt + (size_t)e * bstride_e + (size_t)pn * bstride_pn; return true;
    }
    __device__ __forceinline__ void aoff(const GUnit& u, unsigned (&v)[2][2], const int (&R)[2], const int (&C)[2]) const {
#pragma unroll
        for (int h = 0; h < 2; ++h)
#pragma unroll
            for (int i = 0; i < 2; ++i) {
                if (GATHER) { const int lr = h * 128 + R[i]; const int rr = 256 * (u.pm - tb[u.e]) + (lr < u.rows ? lr : 0); const unsigned tok = mtok[(size_t)u.e * 16384 + rr] & 0x7fffffffu; v[h][i] = (tok * 1024u + (unsigned)C[i]) * 2u; }
                else v[h][i] = (unsigned)((h * 128 + R[i]) * 256 + C[i]) * 2u;
            }
    }
};
struct EpiMoeUp {
    static constexpr bool KHOOK = false;
    const unsigned* mtok; const float* ssq; const LAS int* tb; bf16_t* HB;
    __device__ __forceinline__ void operator()(const f32x4 (&acc)[2][2][4][2], const GUnit& u, int wr, int wc, int fr, int fq) const {
        const int r0 = 256 * (u.pm - tb[u.e]);
        float rs8[8];
        { unsigned tk[8];
#pragma unroll
          for (int k = 0; k < 8; ++k) { const int lr = (k >> 2) * 128 + wr * 64 + (k & 3) * 16 + fr; tk[k] = mtok[(size_t)u.e * 16384 + r0 + (lr < u.rows ? lr : 0)] & 0x7fffffffu; }
#pragma unroll
          for (int k = 0; k < 8; ++k) rs8[k] = ssq[tk[k]]; }
#pragma unroll
        for (int ai = 0; ai < 2; ++ai)
#pragma unroll
            for (int m = 0; m < 4; ++m) {
                __builtin_amdgcn_sched_barrier(0);
                const int lr = ai * 128 + wr * 64 + m * 16 + fr;
                if (lr < u.rows) {
                    const float rs = rs8[ai * 4 + m];
                    float hv[8];
#pragma unroll
                    for (int n = 0; n < 2; ++n)
#pragma unroll
                        for (int j = 0; j < 4; ++j) { const float gv = acc[ai][0][m][n][j] * rs, uv = acc[ai][1][m][n][j] * rs; hv[4 * n + j] = siluf(gv) * uv; }
                    st_bf16x8(HB + ((size_t)u.pm * 256 + lr) * 256 + u.pn * 128 + wc * 32 + 8 * fq, hv);
                }
            }
    }
};
struct EpiMoeDown {
    static constexpr bool KHOOK = false;
    const unsigned* mtok; const float* mw; const LAS int* tb; bf16_t* YB;
    __device__ __forceinline__ void operator()(const f32x4 (&acc)[2][2][4][2], const GUnit& u, int wr, int wc, int fr, int fq) const {
        const int r0 = 256 * (u.pm - tb[u.e]);
        unsigned mt8[8]; float wt8[8];
#pragma unroll
        for (int k = 0; k < 8; ++k) { const int lr = (k >> 2) * 128 + wr * 64 + (k & 3) * 16 + fr; const size_t ix = (size_t)u.e * 16384 + r0 + (lr < u.rows ? lr : 0); mt8[k] = mtok[ix]; wt8[k] = mw[ix]; }
#pragma unroll
        for (int ai = 0; ai < 2; ++ai)
#pragma unroll
            for (int m = 0; m < 4; ++m) {
                __builtin_amdgcn_sched_barrier(0);
                const int lr = ai * 128 + wr * 64 + m * 16 + fr;
                if (lr < u.rows) {
                    const unsigned mt = mt8[ai * 4 + m]; const float wt = wt8[ai * 4 + m];
                    bf16_t* dst = YB + ((size_t)(mt >> 31) * 16384 + (mt & 0x7fffffffu)) * 1024 + u.pn * 256 + wc * 32 + 8 * fq;
#pragma unroll
                    for (int bj = 0; bj < 2; ++bj) { float v[8];
#pragma unroll
                        for (int n = 0; n < 2; ++n)
#pragma unroll
                            for (int j = 0; j < 4; ++j) v[4 * n + j] = acc[ai][bj][m][n][j] * wt;
                        st_bf16x8(dst + bj * 128, v); }
                }
            }
    }
};
__device__ __forceinline__ void phase_combine(int l, unsigned char* ws, float* out, int bid, int nb, int g_wv) {
    int tid_ = TIDX; asm volatile("" : "+v"(tid_)); const int w = tid_ >> 6, lane = tid_ & 63;
    bf16_t* XB = (bf16_t*)(ws + WS_XB); const bf16_t* Y0 = (const bf16_t*)(ws + WS_YBUF); const bf16_t* Y1 = Y0 + (size_t)16384 * 1024; float* ssqx = (float*)(ws + WS_SSQX) + 16384;
    for (int row = bid * 8 + w; row < NTOK; row += nb * 8) {
        float ss = 0.f;
#pragma unroll
        for (int k = 0; k < 2; ++k) {
            const size_t o = (size_t)row * 1024 + (lane + 64 * k) * 8;
            const u32x4 x = *(const u32x4*)(XB + o), a = *(const u32x4*)(Y0 + o), c = *(const u32x4*)(Y1 + o);
            float v[8] = { bf_lo(x.x) + bf_lo(a.x) + bf_lo(c.x), bf_hi(x.x) + bf_hi(a.x) + bf_hi(c.x), bf_lo(x.y) + bf_lo(a.y) + bf_lo(c.y), bf_hi(x.y) + bf_hi(a.y) + bf_hi(c.y),
                           bf_lo(x.z) + bf_lo(a.z) + bf_lo(c.z), bf_hi(x.z) + bf_hi(a.z) + bf_hi(c.z), bf_lo(x.w) + bf_lo(a.w) + bf_lo(c.w), bf_hi(x.w) + bf_hi(a.w) + bf_hi(c.w) };
            if (l == L_ - 1 && out) { *(f32x4*)(out + o) = (f32x4){v[0], v[1], v[2], v[3]}; *(f32x4*)(out + o + 4) = (f32x4){v[4], v[5], v[6], v[7]}; }
            else { u32x4 p; p.x = pk_bf16(v[0], v[1]); p.y = pk_bf16(v[2], v[3]); p.z = pk_bf16(v[4], v[5]); p.w = pk_bf16(v[6], v[7]); *(u32x4*)(XB + o) = p;
#pragma unroll
                   for (int j = 0; j < 4; ++j) { const unsigned q = j == 0 ? p.x : (j == 1 ? p.y : (j == 2 ? p.z : p.w)); ss += bf_lo(q) * bf_lo(q) + bf_hi(q) * bf_hi(q); } }
        }
        if (l < L_ - 1) { ss = wave_sum(ss); if (lane == 0) ssqx[row] = ss; }
    }
}
constexpr int MOE_CVT_SPLIT = 4608;
#ifndef CVT_A
#define CVT_A 2688
#endif
#ifndef NROUTE
#define NROUTE 128
#endif
constexpr int NPH = 9;
enum { PH_INPROJ = 0, PH_PREP, PH_MIX, PH_YNORM, PH_OUTPROJ, PH_ROUTE, PH_MOEUP, PH_MOEDOWN, PH_COMBINE };
struct Args { Inputs in; float* out; unsigned char* ws; int ph_lo, ph_hi; };

__global__ void __launch_bounds__(512, 2) mk(Args args) {
    extern __shared__ __attribute__((aligned(16))) unsigned char lds_raw[];
    LAS unsigned char* lds = (LAS unsigned char*)lds_raw;
    const int g_wv = __builtin_amdgcn_readfirstlane((int)threadIdx.x >> 6);
    const int bid0 = blockIdx.x, nb = gridDim.x;
#define BID() ({ int b_ = bid0; asm volatile("" : "+s"(b_)); b_; })
    unsigned char* ws = args.ws; unsigned* ctl = (unsigned*)(ws + WS_CTL);
    const int lo = args.ph_lo, hi = args.ph_hi;
    if (TIDX < 4) ((LAS unsigned*)(lds + LDS_MISC))[TIDX] = 0u;
    __syncthreads();
    XcdBarrier bar; bar.g_wv = g_wv; bar.bar = ctl + CW_BAR; bar.x = 0; bar.st = nullptr;
    if (hi - lo > 1) bar = xcd_barrier_post(ctl + CW_BAR, (volatile LAS unsigned*)(lds + LDS_MISC), g_wv);
#define IN(k) (lo <= (k) && (k) < hi)
#ifndef REPEAT_PH
#define REPEAT_PH -1
#endif
#define NREP(k) ((REPEAT_PH == (k)) ? 2 : 1)
#ifndef NBAR
#define NBAR 1
#endif
#ifndef TIME_PH
#define TIME_PH -1
#endif
#define STAMP(i) do { if (TIME_PH != -1 && blockIdx.x == 0 && TIDX == 0) ((unsigned long long*)(ctl + CW_TS))[i] = __builtin_amdgcn_s_memrealtime(); } while (0)
#define SEAM(k) do { if (IN(k) && IN((k) + 1)) for (int nb_ = 0; nb_ < NBAR; ++nb_) xcd_barrier(bar); STAMP((k) + 1); } while (0)
    STAMP(0);
#ifndef NO_PRO
    if (IN(0)) for (int rep = 0; rep < NREP(100); ++rep) { prologue(in_tab(), launder(ws), lds, BID(), nb, g_wv); if (rep + 1 < NREP(100)) xcd_barrier(bar); }
#endif
    SEAM(0);
    for (int l = 0; l < L_; ++l) {
        const int pb = 1 + l * NPH;
        if (IN(pb + PH_INPROJ)) for (int rep = 0; rep < NREP(PH_INPROJ); ++rep) {
            if (rep) xcd_barrier(bar);
            InPtr in = in_tab(); unsigned char* ws = launder(args.ws);
            g8::DenseSched S{(const char*)(ws + WS_XB), (const char*)(ws + WS_WIN) + (size_t)l * 2560 * 1024 * 2, 1024, 1024, 64, 10, nb, BID()};
            EpiInProj E{(const float*)(ws + WS_SSQX) + l * 16384, (float*)(ws + WS_SSQ + PT_DQ) + (size_t)l * 16384 * 4, (float*)(ws + WS_SSQ + PT_DKV) + (size_t)l * 16384 * 2,
                        in->p[8] + l * 64, in->p[9] + l * 64, in->p[19] + l * 192 + 96 + 64, (const float*)(ws + WS_ROPE), ws + WS_PRJ};
#ifndef NO_INPROJ
            g8::gemm_run(lds, 1024, 1024, S, E, g_wv);
#endif
        }
        SEAM(pb + PH_INPROJ);
        if (IN(pb + PH_PREP)) for (int rep = 0; rep < NREP(PH_PREP); ++rep) { if (rep) xcd_barrier(bar); phase_prep(l, in_tab(), launder(ws), lds, BID(), nb, g_wv, (unsigned*)launder(ws) + CW_Q + 64 * (4 + l + 2 * rep)); }
        SEAM(pb + PH_PREP);
        if (IN(pb + PH_MIX)) for (int rep = 0; rep < NREP(PH_MIX); ++rep) { if (rep) xcd_barrier(bar); phase_mix(l, in_tab(), launder(ws), lds, (unsigned*)launder(ws) + CW_Q + 64 * (l + 2 * rep), g_wv); }
        SEAM(pb + PH_MIX);
        const bool fold_norm = (nb == 256);
        if (IN(pb + PH_YNORM) && !fold_norm) phase_ynorm(l, launder(ws), BID(), nb, g_wv);
        if (!fold_norm) SEAM(pb + PH_YNORM);
        if (IN(pb + PH_OUTPROJ)) {
            unsigned char* ws = launder(args.ws);
            g8::DenseSched S{(const char*)(ws + WS_Y), (const char*)(ws + WS_WOUT) + (size_t)l * 1024 * 1024 * 2, 1024, 1024, 64, 4, nb, BID()};
            EpiOut E{(bf16_t*)(ws + WS_XB), (float*)(ws + WS_SSQ + PT_X1) + (size_t)l * 16384 * 16, (const LAS float*)(lds + LDS_FAC), fold_norm};
            if (fold_norm) { g8::GUnit u0; if (S.next(0, u0)) outproj_factors(l, ws, lds, u0.pm, TIDX); else __syncthreads(); }
#ifndef NO_OUTPROJ
            g8::gemm_run(lds, 1024, 1024, S, E, g_wv);
#endif
        }
        SEAM(pb + PH_OUTPROJ);
#ifndef NO_ROUTE
        if (IN(pb + PH_ROUTE)) {
            const int b_ = BID();
            if (nb >= 256 && b_ >= NROUTE) { cvt_moe_layer(in_tab(), launder(ws), l, (LAS float*)lds, b_ - NROUTE, nb - NROUTE, TIDX, 0, CVT_A);
#ifdef DUP_CVT
                __syncthreads(); cvt_moe_layer(in_tab(), launder(ws), l, (LAS float*)lds, b_ - NROUTE, nb - NROUTE, TIDX);
#endif
            }
            else { phase_route(l, in_tab(), launder(ws), lds, b_, nb >= 256 ? NROUTE : nb, g_wv);
                   if (nb < 256) cvt_moe_layer(in_tab(), launder(ws), l, (LAS float*)lds, b_, nb, TIDX); else cvt_moe_layer(in_tab(), launder(ws), l, (LAS float*)lds, b_, NROUTE, TIDX, CVT_A, 3072); }
            if (l + 1 < L_) { __syncthreads(); cvt_small_weights(in_tab(), launder(ws), l + 1, (LAS float*)lds, b_, nb, TIDX); }
        }
#endif
        SEAM(pb + PH_ROUTE);
        {
            const bool do_up = IN(pb + PH_MOEUP), do_dn = IN(pb + PH_MOEDOWN), fuse = do_up && do_dn;
            for (int part = 0; part < (fuse ? 3 : 1); ++part) {
                if (part) xcd_barrier(bar);
                unsigned char* ws = launder(args.ws);
                if (do_up || do_dn) moe_tables(l, ws, lds, g_wv);
                const unsigned* cnt = (const unsigned*)(ws + WS_CTL) + CW_CNT + 2048 * l; const unsigned* mtok = (const unsigned*)(ws + WS_META); const LAS int* tb = (const LAS int*)(lds + LDS_TB);
                const int b_ = BID(), ntile = tb[32], UPU = 2 * ntile, DNU = 4 * ntile;
                const int hi0 = UPU < nb ? UPU : nb, nu_ = UPU - hi0, nu = nu_ < (nb >> 1) ? nu_ : (nb >> 1), nd = nb - nu;
                const int d1a = 4 * (hi0 >> 1), d1b = 2 * nd, D1 = nu == 0 ? DNU : (d1a < d1b ? d1a : d1b);
                int ulo = 0, uhi = UPU, uG = nb, uc = b_, dlo = 0, dhi = DNU, dG = nb, dc = b_;
                if (fuse) {
                    if (part == 0) { uhi = hi0; dhi = 0; }
                    else if (part == 1) { ulo = hi0; uG = nu; if (b_ >= nu) uhi = ulo; dhi = D1; dG = nd; dc = b_ - nu; if (b_ < nu) dhi = 0; }
                    else { uhi = 0; dlo = D1; }
                }
                if (do_up && uhi > ulo) {
                    MoeSched<2, true> S{(const char*)(ws + WS_XB), (const char*)(ws + WS_WMOE), cnt, mtok, tb, uG, uc, (size_t)512 * 1024 * 2, (size_t)256 * 1024 * 2, ulo, uhi};
                    EpiMoeUp E{mtok, (const float*)(ws + WS_RS2), tb, (bf16_t*)(ws + WS_HBUF)};
#ifndef NO_MOEUP
                    g8::gemm_run(lds, 1024, 1024, S, E, g_wv);
#endif
                }
                if (do_dn && dhi > dlo) {
                    MoeSched<4, false> S{(const char*)(ws + WS_HBUF), (const char*)(ws + WS_WMOE + WMOE_WD), cnt, mtok, tb, dG, dc, (size_t)1024 * 256 * 2, (size_t)256 * 256 * 2, dlo, dhi};
                    EpiMoeDown E{mtok, (const float*)(ws + WS_META + META_W), tb, (bf16_t*)(ws + WS_YBUF)};
#ifndef NO_MOEDOWN
                    g8::gemm_run(lds, 256, 256, S, E, g_wv);
#endif
                }
            }
        }
        SEAM(pb + PH_MOEDOWN);
#ifndef NO_COMBINE
        if (IN(pb + PH_COMBINE)) { unsigned char* ws = launder(args.ws); phase_combine(l, ws, args.out, BID(), nb, g_wv); }
#endif
        SEAM(pb + PH_COMBINE);
    }
#undef IN
#undef SEAM
}
#if CHECK
struct NvScratch { float *proj, *h1, *qk, *hraw, *kn, *kcmp, *vcmp, *dqn, *q, *dkvn, *kv, *krope, *y, *x1, *xl; int* rt_e; float* rt_w; };
constexpr int CB = 5;
enum { NS_INPROJ = 0, NS_NSAPREP, NS_MLAPREP, NS_NSA, NS_ML, NS_MLA, NS_OUT, NS_ROUTE, NS_MOE };
static void naive_step(void* const* d_in, int l, int step, const float* xin, float* xout, const NvScratch& S, hipStream_t st) {
    const int b = CB;
    const float* rel_bias = (const float*)d_in[2];
    const float* norm1_g = (const float*)d_in[3] + (long)l * 1024;
    const float* w_in = (const float*)d_in[4] + (long)l * 1024 * DIN;
    const float* cmp_pe = (const float*)d_in[5] + (long)l * 2 * 32 * 64;
    const float* cmp_w1 = (const float*)d_in[6] + (long)l * 2 * 32 * 64 * 64;
    const float* cmp_w2 = (const float*)d_in[7] + (long)l * 2 * 64 * 64;
    const float* q_norm = (const float*)d_in[8] + l * 64;
    const float* k_norm = (const float*)d_in[9] + l * 64;
    const float* nsa_on = (const float*)d_in[10] + l * 384;
    const float* conv = (const float*)d_in[11] + l * 4 * 512;
    const float* ibias = (const float*)d_in[12] + l * 4;
    const float* fbias = (const float*)d_in[13] + l * 4;
    const float* ml_on = (const float*)d_in[14] + l * 256;
    const float* qan = (const float*)d_in[15] + l * 192;
    const float* w_uq = (const float*)d_in[16] + (long)l * 192 * 576;
    const float* kvan = (const float*)d_in[17] + l * 128;
    const float* w_ukv = (const float*)d_in[18] + (long)l * 128 * 768;
    const float* qkn = (const float*)d_in[19] + l * 192;
    const float* mla_on = (const float*)d_in[20] + l * 384;
    const float* w_out = (const float*)d_in[21] + (long)l * 1024 * 1024;
    const float* norm2_g = (const float*)d_in[22] + l * 1024;
    const float* wgrp = (const float*)d_in[23] + (long)l * 1024 * 4;
    const float* bgrp = (const float*)d_in[24] + l * 4;
    const float* wexp = (const float*)d_in[25] + (long)l * 1024 * 32;
    const float* bexp = (const float*)d_in[26] + l * 32;
    const float* Wg = (const float*)d_in[27] + (long)l * 32 * 1024 * 256;
    const float* Wu = (const float*)d_in[28] + (long)l * 32 * 1024 * 256;
    const float* Wd = (const float*)d_in[29] + (long)l * 32 * 256 * 1024;
    const int* pos = (const int*)d_in[1] + b * 2048;
    switch (step) {
    case NS_INPROJ:
        nv_rmsnorm<<<dim3(2048, 1), 64, 0, st>>>(xin, 1024, 0, S.h1, 1024, 0, norm1_g, 0, 1024);
        nv_gemm<<<dim3((DIN + 63) / 64, 2048 / 64), 256, 0, st>>>(S.h1, 1024, w_in, DIN, S.proj, DIN, nullptr, 0, 2048, DIN, 1024);
        break;
    case NS_NSAPREP:
        nv_nsa_cmp<<<dim3(127, 2, 2), 64, 0, st>>>(S.proj, cmp_pe, cmp_w1, cmp_w2, k_norm, S.kcmp, S.vcmp);
        nv_nsa_knorm<<<dim3(2048, 4), 64, 0, st>>>(S.proj, k_norm, S.kn);
        break;
    case NS_MLAPREP:
        nv_rmsnorm<<<dim3(2048, 1), 64, 0, st>>>(S.proj + O_CDQ, DIN, 0, S.dqn, 192, 0, qan, 0, 192);
        nv_gemm<<<dim3(576 / 64, 2048 / 64), 256, 0, st>>>(S.dqn, 192, w_uq, 576, S.q, 576, nullptr, 0, 2048, 576, 192);
        nv_rmsnorm<<<dim3(2048, 1), 64, 0, st>>>(S.proj + O_CDKV, DIN, 0, S.dkvn, 128, 0, kvan, 0, 128);
        nv_gemm<<<dim3(768 / 64, 2048 / 64), 256, 0, st>>>(S.dkvn, 128, w_ukv, 768, S.kv, 768, nullptr, 0, 2048, 768, 128);
        nv_mla_prep<<<dim3(2048, 7), 64, 0, st>>>(S.q, S.kv, S.proj, S.krope, qkn, pos);
        break;
    case NS_NSA:
        nv_nsa_attn<<<dim3(2048, 2), 192, 0, st>>>(S.proj, S.kn, S.kcmp, S.vcmp, rel_bias, q_norm, S.y);
        break;
    case NS_ML:
        nv_ml_conv<<<2048, 512, 0, st>>>(S.proj, conv, S.qk);
        nv_ml_rec<<<4, 256, 0, st>>>(S.proj, S.qk, ibias, fbias, S.hraw);
        nv_ml_fin<<<dim3(2048, 4), 64, 0, st>>>(S.proj, S.hraw, ml_on, S.y);
        break;
    case NS_MLA:
        nv_mla_attn<<<dim3(2048, 6), 64, 0, st>>>(S.q, S.kv, S.krope, S.y);
        break;
    case NS_OUT:
        nv_rmsnorm<<<dim3(2048, 1), 64, 0, st>>>(S.y, 1024, 0, S.y, 1024, 0, nsa_on, 0, 384);
        nv_rmsnorm<<<dim3(2048, 1), 64, 0, st>>>(S.y + 640, 1024, 0, S.y + 640, 1024, 0, mla_on, 0, 384);
        nv_gemm<<<dim3(1024 / 64, 2048 / 64), 256, 0, st>>>(S.y, 1024, w_out, 1024, S.x1, 1024, xin, 1024, 2048, 1024, 1024);
        break;
    case NS_ROUTE:
        nv_moe_route<<<2048, 64, 0, st>>>(S.x1, norm2_g, wgrp, bgrp, wexp, bexp, S.h1, S.rt_e, S.rt_w);
        break;
    case NS_MOE:
        nv_moe_exp<<<2048, 256, 0, st>>>(S.x1, S.h1, S.rt_e, S.rt_w, Wg, Wu, Wd, xout);
        break;
    }
}

__device__ __forceinline__ void chk_commit(float d2, float r2, float* acc) { d2 = wave_sum(d2); r2 = wave_sum(r2); if ((threadIdx.x & 63) == 0) { atomicAdd(acc, d2); atomicAdd(acc + 1, r2); } }
__device__ __forceinline__ void chk_add(float f, float r, float& d2, float& r2) { const float d = f - r; d2 += (d == d) ? d * d : 1e30f; r2 += r * r; }

__global__ void __launch_bounds__(64) chk_proj(const float* nproj, const unsigned char* prj, const float* ssq_dq, const float* ssq_dkv, const float* qg, const float* kg, const float* krg, const int* pos, float* acc) {
    const int t = blockIdx.x, e = threadIdx.x; const size_t row = (size_t)CB * 2048 + t; float d2 = 0.f, r2 = 0.f;
    for (int G = 0; G < 40; ++G) {
        const int c = inproj_refcol(G, e); float r = c < 0 ? 0.f : nproj[(size_t)t * DIN + c]; float f = 0.f;
        const float rr = (G == 37 && e >= 32) ? 0.f : r; const float ss = wave_sum(rr * rr);
        if (G < 6) { r = r * rsqrtf(ss / 64.f + 1e-6f) * qg[e] * 0.18033688f; f = bf2f(((const bf16_t*)(prj + PRJ_QN))[((size_t)(CB * 6 + G) * 2048 + t) * 64 + e]); }
        else if (G < 18) { const int a = G - 6, br = a >> 2, s = (a >> 1) & 1, hk = a & 1;
            if (br > 0 && s == 0) r = r * rsqrtf(ss / 64.f + 1e-6f) * kg[e];
            const size_t base = br == 0 ? (s ? PRJ_C0V : PRJ_C0K) : (br == 1 ? (s ? PRJ_VN1 : PRJ_KN1) : (s ? PRJ_VN2 : PRJ_KN2));
            f = bf2f(((const bf16_t*)(prj + base))[((size_t)(CB * 2 + hk) * 2048 + t) * 64 + e]); }
        else if (G < 26) f = bf2f(((const bf16_t*)(prj + PRJ_RAWQK))[row * 512 + (G - 18) * 64 + e]);
        else if (G < 30) f = bf2f(((const bf16_t*)(prj + PRJ_VML))[((size_t)(CB * 4 + (G - 26)) * 2048 + t) * 64 + e]);
        else if (G < 34) f = bf2f(((const bf16_t*)(prj + PRJ_OG))[row * 256 + (G - 30) * 64 + e]);
        else if (G < 37) f = bf2f(((const bf16_t*)(prj + PRJ_DQKV))[row * 384 + (G - 34) * 64 + e]);
        else if (G == 37) {
            const float val = e < 32 ? rr * rsqrtf(ss / 32.f + 1e-6f) * krg[e & 31] : 0.f; const float oth = __shfl_xor(val, 16);
            if (e < 32) { const int i = e & 15; const double ang = (double)pos[row] * pow(10000.0, -(double)i / 16.0); const float cs = (float)cos(ang), sn = (float)sin(ang);
                r = e < 16 ? val * cs - oth * sn : val * cs + oth * sn; f = bf2f(((const bf16_t*)(prj + PRJ_KR))[row * 32 + e]); }
            else if (e < 58) f = ((const float*)(prj + PRJ_GATES))[row * 32 + (e - 32)];
            else { f = 0.f; r = 0.f; }
        }
        else f = bf2f(((const bf16_t*)(prj + PRJ_DQKV))[row * 384 + 256 + (G - 38) * 64 + e]);
        chk_add(f, r, d2, r2);
    }
    float d2s = 0.f, r2s = 0.f;
    { float s1 = 0.f, s2 = 0.f; for (int c = e; c < 192; c += 64) { float v = nproj[(size_t)t * DIN + O_CDQ + c]; s1 += v * v; } for (int c = e; c < 128; c += 64) { float v = nproj[(size_t)t * DIN + O_CDKV + c]; s2 += v * v; }
      s1 = wave_sum(s1); s2 = wave_sum(s2); if (e == 0) { chk_add((ssq_dq[row * 4] + ssq_dq[row * 4 + 1]) + ssq_dq[row * 4 + 2], s1, d2s, r2s); chk_add(ssq_dkv[row * 2] + ssq_dkv[row * 2 + 1], s2, d2s, r2s); } }
    chk_commit(d2, r2, acc); chk_commit(d2s, r2s, acc + 2);
}

__global__ void __launch_bounds__(64) chk_prep(const float* nq, const float* nkv, const float* nkr, const float* nkc, const float* nvc, const unsigned char* ws, float* acc) {
    const int t = blockIdx.x, e = threadIdx.x; float d2 = 0.f, r2 = 0.f, d2c = 0.f, r2c = 0.f; const float scale = 0.14724444f;
    const bf16_t* QM = (const bf16_t*)(ws + WS_MLA); const bf16_t* KM = (const bf16_t*)(ws + WS_MLA + MLA_KM); const bf16_t* VM = (const bf16_t*)(ws + WS_MLA + MLA_VM);
    for (int h = 0; h < 6; ++h) {
        const size_t rq = ((size_t)(CB * 6 + h) * 2048 + t);
        chk_add(bf2f(QM[rq * 96 + e]), nq[(size_t)t * 576 + h * 96 + e] * scale, d2, r2);
        chk_add(bf2f(KM[rq * 96 + e]), nkv[(size_t)t * 768 + h * 128 + e], d2, r2);
        chk_add(bf2f(VM[rq * 64 + e]), nkv[(size_t)t * 768 + h * 128 + 64 + e], d2, r2);
        if (e < 32) { chk_add(bf2f(QM[rq * 96 + 64 + e]), nq[(size_t)t * 576 + h * 96 + 64 + e] * scale, d2, r2); chk_add(bf2f(KM[rq * 96 + 64 + e]), nkr[(size_t)t * 32 + e], d2, r2); }
    }
    if (t < 128) for (int hk = 0; hk < 2; ++hk) {
        const bf16_t* KC = (const bf16_t*)(ws + WS_CMP); const bf16_t* VC = (const bf16_t*)(ws + WS_CMP + CMP_V); const size_t rf = ((size_t)(CB * 2 + hk) * 128 + t) * 64 + e;
        chk_add(bf2f(KC[rf]), t < 127 ? nkc[(size_t)(hk * 127 + t) * 64 + e] : 0.f, d2c, r2c); chk_add(bf2f(VC[rf]), t < 127 ? nvc[(size_t)(hk * 127 + t) * 64 + e] : 0.f, d2c, r2c);
    }
    chk_commit(d2, r2, acc); chk_commit(d2c, r2c, acc + 2);
}

__global__ void __launch_bounds__(64) chk_y(const float* ny, const unsigned char* ws, float* acc, int nseg) {
    const int t = blockIdx.x, e = threadIdx.x; const bf16_t* Y = (const bf16_t*)(ws + WS_Y) + ((size_t)CB * 2048 + t) * 1024;
    float d2[3] = {0.f, 0.f, 0.f}, r2[3] = {0.f, 0.f, 0.f};
    for (int c = e; c < 1024; c += 64) { const int seg = c < 384 ? 0 : (c < 640 ? 1 : 2); const int cf = c < 384 ? c : (c < 640 ? 768 + (c - 384) : 384 + (c - 640)); const float f = bf2f(Y[cf]), r = ny[(size_t)t * 1024 + c];
        if (seg == 0) chk_add(f, r, d2[0], r2[0]); else if (seg == 1) chk_add(f, r, d2[1], r2[1]); else chk_add(f, r, d2[2], r2[2]); }
    if (nseg == 3) { chk_commit(d2[0], r2[0], acc); chk_commit(d2[1], r2[1], acc + 2); chk_commit(d2[2], r2[2], acc + 4); }
    else chk_commit(d2[0] + d2[1] + d2[2], r2[0] + r2[1] + r2[2], acc);
}

__global__ void __launch_bounds__(64) chk_x(const float* nx, const unsigned char* ws, float* acc) {
    const int t = blockIdx.x, e = threadIdx.x; const bf16_t* X = (const bf16_t*)(ws + WS_XB) + ((size_t)CB * 2048 + t) * 1024; float d2 = 0.f, r2 = 0.f;
    for (int c = e; c < 1024; c += 64) chk_add(bf2f(X[c]), nx[(size_t)t * 1024 + c], d2, r2);
    chk_commit(d2, r2, acc);
}

__global__ void __launch_bounds__(512) chk_code(float* acc, int nst, const float* nout) {
    __shared__ float sh[512];
    float s = 0.f; for (int i = threadIdx.x; i < 2048 * 1024; i += 512) { float v = nout[i]; s += v * v; }
    sh[threadIdx.x] = s; __syncthreads();
    if (threadIdx.x == 0) { float tot = 0.f; for (int i = 0; i < 512; ++i) tot += sh[i]; float rms = sqrtf(tot / (2048.f * 1024.f)); if (!(rms > 1e-3f && rms < 1e3f)) rms = 1.f;
        int code = 0;
        for (int st = 0; st < nst; ++st) { const float d2 = acc[2 * st], r2 = acc[2 * st + 1]; if (r2 == 0.f && d2 == 0.f) { if ((st & 15) >= 9) continue; code = (st + 1) * 4 + 3; break; } const float err = d2 / fmaxf(r2, 1e-30f);
            const float tol = CHK_TOL(st);
            if (!(err <= tol)) { const int cls = !(err < 1.f) ? 3 : (err >= 0.1f ? 2 : (err >= 0.01f ? 1 : 0)); code = (st + 1) * 4 + cls; break; } }
        acc[2 * 40] = rms * 32.f * exp2f(0.5f * (float)code); }
}
__global__ void __launch_bounds__(512) chk_fill(const float* acc, float* out) {
    const float K = acc[2 * 40];
    for (size_t i = (size_t)blockIdx.x * 512 + threadIdx.x; i < (size_t)NTOK * 1024; i += (size_t)gridDim.x * 512) out[i] = (i & 1) ? -K : K;
}
#endif

#if TIME_PH != -1
#ifndef TIME_Q
#define TIME_Q 6.f
#endif
#ifndef TIME_CAL
#define TIME_CAL 1.0f
#endif
__global__ void tm_acc(const unsigned long long* ts, float* best, int first) {
    int a = TIME_PH, b = TIME_PH + 1;
#ifdef TIME_PH_END
    b = TIME_PH_END;
#endif
    float T = 100.f; if (TIME_PH >= 0) T = (float)(ts[b] - ts[a]) * 0.01f;
    if (first || T < *best) *best = T;
}
__global__ void __launch_bounds__(512) tm_fill(const float* best, float* out) {
    float T = *best;
    T = exp2f(rintf(log2f(fmaxf(T, 1.f)) * TIME_Q) / TIME_Q);
    const float c = sqrtf(T) * TIME_CAL;
    for (size_t i = (size_t)blockIdx.x * 512 + threadIdx.x; i < (size_t)NTOK * 1024; i += (size_t)gridDim.x * 512) out[i] = (i & 1) ? -c : c;
}
#endif
static int g_grid = 0;
static bool setup_once(size_t ws_size) {
    if (g_grid) return g_grid > 0;
    if (ws_size < WS_END) { fprintf(stderr, "kernel_launch: workspace too small: %zu < %zu\n", ws_size, (size_t)WS_END); g_grid = -1; return false; }
    int dev = 0, cus = 0, per_cu = 0;
    if (hipGetDevice(&dev) != hipSuccess || hipDeviceGetAttribute(&cus, hipDeviceAttributeMultiprocessorCount, dev) != hipSuccess) { g_grid = -1; return false; }
    if (hipFuncSetAttribute((const void*)mk, hipFuncAttributeMaxDynamicSharedMemorySize, LDS_BYTES) != hipSuccess) { fprintf(stderr, "kernel_launch: hipFuncSetAttribute failed\n"); g_grid = -1; return false; }
    if (hipOccupancyMaxActiveBlocksPerMultiprocessor(&per_cu, (const void*)mk, 512, LDS_BYTES) != hipSuccess || per_cu < 1) { fprintf(stderr, "kernel_launch: occupancy query says %d\n", per_cu); }
    (void)hipGetLastError();
    g_grid = cus;
    return true;
}
static void launch_mk(const Args& a0, int lo, int hi, hipStream_t stream) { Args a = a0; a.ph_lo = lo; a.ph_hi = hi; hipLaunchKernelGGL(mk, dim3(g_grid), dim3(512), LDS_BYTES, stream, a); }

extern "C" void kernel_launch(void* const* d_in, const int* in_sizes, int n_in, void* d_out, int out_size, void* d_ws, size_t ws_size, hipStream_t stream) {
    if (!setup_once(ws_size)) return;
    unsigned char* ws = (unsigned char*)d_ws;
    (void)hipMemsetAsync(ws + WS_CTL, 0, ZERO_BYTES, stream);
    Args a{}; for (int i = 0; i < 30; ++i) a.in.p[i] = (const float*)d_in[i];
    a.out = (float*)d_out; a.ws = ws; a.ph_lo = 0; a.ph_hi = 0;
#if CHECK
    a.out = nullptr;
#endif
#if CHECK
    float* nb = (float*)d_out; size_t off = 0; NvScratch S;
    auto take = [&](size_t n) { float* p = nb + off; off += (n + 63) & ~(size_t)63; return p; };
    S.proj = take((size_t)2048 * DIN); S.h1 = take(2048 * 1024); S.qk = S.h1; S.hraw = S.qk + 2048 * 512; S.kn = S.hraw + 2048 * 256;
    S.kcmp = take(2 * 127 * 64); S.vcmp = take(2 * 127 * 64); S.dqn = take(2048 * 192); S.q = take(2048 * 576); S.dkvn = take(2048 * 128); S.kv = take(2048 * 768); S.x1 = S.dqn;
    S.krope = take(2048 * 32); S.y = take(2048 * 1024); S.xl = take(2048 * 1024); S.rt_e = (int*)take(2048 * 2); S.rt_w = take(2048 * 2);
    if (off * 4 > (size_t)NTOK * 1024 * 4) { fprintf(stderr, "naive scratch too big\n"); return; }
    float* acc = (float*)(ws + WS_CTL) + CW_CHK;
    launch_mk(a, 0, 1, stream);
    const float* nx_in = (const float*)d_in[0] + (size_t)CB * 2048 * 1024;
    int nst = 0;
    for (int l = 0; l < L_; ++l) {
        const int pb = 1 + l * NPH; const int sb = l * 16;
        launch_mk(a, pb + PH_INPROJ, pb + PH_INPROJ + 1, stream);
        naive_step(d_in, l, NS_INPROJ, nx_in, S.xl, S, stream);
        chk_proj<<<2048, 64, 0, stream>>>(S.proj, ws + WS_PRJ, (const float*)(ws + WS_SSQ + PT_DQ) + (size_t)l * 16384 * 4, (const float*)(ws + WS_SSQ + PT_DKV) + (size_t)l * 16384 * 2,
                                           (const float*)d_in[8] + l * 64, (const float*)d_in[9] + l * 64, (const float*)d_in[19] + l * 192 + 160, (const int*)d_in[1], acc + 2 * (sb + 0));
        nst = sb + 2;
        int ns_done = NS_INPROJ;
#if CHECK_UPTO >= 1
        launch_mk(a, pb + PH_PREP, pb + PH_PREP + 1, stream);
        naive_step(d_in, l, NS_NSAPREP, nx_in, S.xl, S, stream); naive_step(d_in, l, NS_MLAPREP, nx_in, S.xl, S, stream); ns_done = NS_MLAPREP;
        chk_prep<<<2048, 64, 0, stream>>>(S.q, S.kv, S.krope, S.kcmp, S.vcmp, ws, acc + 2 * (sb + 2));
        nst = sb + 4;
#endif
#if CHECK_UPTO >= 2
        launch_mk(a, pb + PH_MIX, pb + PH_MIX + 1, stream);
        naive_step(d_in, l, NS_NSA, nx_in, S.xl, S, stream); naive_step(d_in, l, NS_ML, nx_in, S.xl, S, stream); naive_step(d_in, l, NS_MLA, nx_in, S.xl, S, stream); ns_done = NS_MLA;
        chk_y<<<2048, 64, 0, stream>>>(S.y, ws, acc + 2 * (sb + 4), 3);
        nst = sb + 7;
#endif
#if CHECK_UPTO >= 3
        launch_mk(a, pb + PH_YNORM, pb + PH_YNORM + 1, stream); launch_mk(a, pb + PH_OUTPROJ, pb + PH_OUTPROJ + 1, stream);
        naive_step(d_in, l, NS_OUT, nx_in, S.xl, S, stream); ns_done = NS_OUT;
        chk_x<<<2048, 64, 0, stream>>>(S.x1, ws, acc + 2 * (sb + 7));
        nst = sb + 8;
#endif
#if CHECK_UPTO >= 4
        for (int ph = PH_ROUTE; ph <= PH_COMBINE; ++ph) launch_mk(a, pb + ph, pb + ph + 1, stream);
        naive_step(d_in, l, NS_ROUTE, nx_in, S.xl, S, stream); naive_step(d_in, l, NS_MOE, nx_in, S.xl, S, stream); ns_done = NS_MOE;
        chk_x<<<2048, 64, 0, stream>>>(S.xl, ws, acc + 2 * (sb + 8));
        nst = sb + 9;
#endif
        CHECK_REST
        for (int s = ns_done + 1; s <= NS_MOE; ++s) naive_step(d_in, l, s, nx_in, S.xl, S, stream);
        nx_in = S.xl;
        if (l == CHECK_LAYERS - 1) break;
    }
    chk_code<<<1, 512, 0, stream>>>(acc, nst, S.xl);
    chk_fill<<<1024, 512, 0, stream>>>(acc, (float*)d_out);
#else
#if defined(SPLIT_LAUNCH) && SPLIT_LAUNCH
    for (int ph = 0; ph < 1 + L_ * NPH; ++ph) launch_mk(a, ph, ph + 1, stream);
#else
    launch_mk(a, 0, 1 + L_ * NPH, stream);
#if TIME_PH != -1
    for (int rp = 0; rp < 6; ++rp) {
        (void)hipMemsetAsync(ws + WS_CTL, 0, ZERO_BYTES, stream); launch_mk(a, 0, 1 + L_ * NPH, stream);
        tm_acc<<<1, 1, 0, stream>>>((const unsigned long long*)((unsigned*)(ws + WS_CTL) + CW_TS), (float*)(ws + WS_META + META_RT), rp == 0);
    }
    tm_fill<<<1024, 512, 0, stream>>>((const float*)(ws + WS_META + META_RT), (float*)d_out);
#endif
#endif
#endif
}
```

```cpp
#define CHECK 0
#define CHECK_LAYERS 2
#define CHECK_UPTO 99
#define SPLIT_LAUNCH 0
#define REPEAT_PH -1
#include <hip/hip_runtime.h>
#include <stdint.h>
#include <cstdio>

constexpr int B_ = 8, T_ = 2048, D_ = 1024, L_ = 2, NTOK = B_ * T_;
constexpr int DIN = 2554;
constexpr int O_AQ = 0, O_AKV = 384, O_AG = 1152, O_BQK = 1170, O_BV = 1682, O_BIF = 1938, O_BO = 1946, O_CDQ = 2202, O_CDKV = 2394, O_CKR = 2522;

typedef unsigned short bf16_t;
typedef short bf16x8 __attribute__((ext_vector_type(8)));
typedef short s16x4 __attribute__((ext_vector_type(4)));
typedef float f32x4 __attribute__((ext_vector_type(4)));
typedef float f32x16 __attribute__((ext_vector_type(16)));
typedef unsigned u32x4 __attribute__((ext_vector_type(4)));
typedef unsigned u32x2 __attribute__((ext_vector_type(2)));
typedef float f32x2_t __attribute__((ext_vector_type(2)));
typedef __bf16 bf16x2_t __attribute__((ext_vector_type(2)));
#define LAS __attribute__((address_space(3)))

__device__ __forceinline__ unsigned pk_bf16(float lo, float hi) { f32x2_t v = {lo, hi}; bf16x2_t b = __builtin_convertvector(v, bf16x2_t); return __builtin_bit_cast(unsigned, b); }
__device__ __forceinline__ float bf_lo(unsigned u) { return __builtin_bit_cast(float, u << 16); }
__device__ __forceinline__ float bf_hi(unsigned u) { return __builtin_bit_cast(float, u & 0xffff0000u); }
__device__ __forceinline__ float bf2f(bf16_t h) { return __builtin_bit_cast(float, (unsigned)h << 16); }
__device__ __forceinline__ bf16_t f2bf(float f) { return (bf16_t)(pk_bf16(f, 0.f) & 0xffffu); }
__device__ __forceinline__ float wave_sum(float v) { for (int o = 32; o; o >>= 1) v += __shfl_xor(v, o); return v; }
__device__ __forceinline__ float wave_max(float v) { for (int o = 32; o; o >>= 1) v = fmaxf(v, __shfl_xor(v, o)); return v; }
__device__ __forceinline__ float siluf(float x) { return x * __builtin_amdgcn_rcpf(1.f + __expf(-x)); }
__device__ __forceinline__ float sigmf(float x) { return __builtin_amdgcn_rcpf(1.f + __expf(-x)); }
__device__ __forceinline__ int t5b(int dist) {
    int n = dist > 0 ? dist : 0; if (n < 16) return n;
    float v = logf((float)n / 16.f) / logf(8.f) * 16.f; int l = 16 + (int)v; return l < 31 ? l : 31;
}

__device__ __forceinline__ int lane_now() { return (int)__builtin_amdgcn_mbcnt_hi(~0u, __builtin_amdgcn_mbcnt_lo(~0u, 0u)); }
#define TIDX ((g_wv << 6) | lane_now())

constexpr size_t WS_CTL = 0, CTL_BYTES = 65536;
constexpr size_t WS_SSQ = WS_CTL + CTL_BYTES;
constexpr size_t ZERO_BYTES = CTL_BYTES;
constexpr size_t PT_DQ = 0, PT_DKV = PT_DQ + (size_t)2 * 16384 * 4 * 4, PT_A = PT_DKV + (size_t)2 * 16384 * 2 * 4, PT_C = PT_A + (size_t)2 * 16384 * 8 * 4, PT_X1 = PT_C + (size_t)2 * 16384 * 8 * 4, PT_END = PT_X1 + (size_t)2 * 16384 * 16 * 4;
constexpr size_t WS_SSQX = WS_SSQ + PT_END;
constexpr size_t WS_RS2 = WS_SSQX + 2 * 65536;
constexpr size_t WS_WIN = WS_RS2 + 65536;
constexpr size_t WS_WOUT = WS_WIN + (size_t)2 * 2560 * 1024 * 2;
constexpr size_t WS_WUQ = WS_WOUT + (size_t)2 * 1024 * 1024 * 2;
constexpr size_t WS_WUKV = WS_WUQ + (size_t)2 * 768 * 256 * 2;
constexpr size_t WS_WC1 = WS_WUKV + (size_t)2 * 768 * 256 * 2;
constexpr size_t WS_WC2 = WS_WC1 + (size_t)2 * 2 * 64 * 2048 * 2;
constexpr size_t WS_WR = WS_WC2 + (size_t)2 * 2 * 64 * 64 * 2;
constexpr size_t WS_B1C = WS_WR + (size_t)2 * 64 * 1024 * 2;
constexpr size_t WS_BIASD = WS_B1C + 1024;
constexpr size_t WS_ROPE = WS_BIASD + 6 * 2048 * 4;
constexpr size_t WS_WMOE = WS_ROPE + (size_t)16384 * 32 * 4;
constexpr size_t WMOE_WD = (size_t)32 * 512 * 1024 * 2;
constexpr size_t WS_XB = WS_WMOE + 50331648;
constexpr size_t WS_MLA = WS_XB + 33554432;
constexpr size_t MLA_KM = (size_t)8 * 6 * 2048 * 96 * 2, MLA_VM = 2 * MLA_KM;
constexpr size_t WS_HBUF = WS_MLA;
constexpr size_t WS_PRJ = WS_MLA + 50331648;
constexpr size_t HM64 = (size_t)2048 * 64 * 2;
constexpr size_t PRJ_QN = 0;
constexpr size_t PRJ_KN1 = PRJ_QN + 48 * HM64, PRJ_VN1 = PRJ_KN1 + 16 * HM64, PRJ_KN2 = PRJ_VN1 + 16 * HM64, PRJ_VN2 = PRJ_KN2 + 16 * HM64;
constexpr size_t PRJ_VML = PRJ_VN2 + 16 * HM64;
constexpr size_t PRJ_OG = PRJ_VML + 32 * HM64;
constexpr size_t PRJ_KR = PRJ_OG + (size_t)16384 * 256 * 2;
constexpr size_t PRJ_GATES = PRJ_KR + (size_t)16384 * 32 * 2;
constexpr size_t PRJ_DEAD = PRJ_GATES + (size_t)16384 * 32 * 4;
constexpr size_t PRJ_C0K = PRJ_DEAD, PRJ_C0V = PRJ_C0K + 16 * HM64 + 8192;
constexpr size_t PRJ_RAWQK = PRJ_C0V + 16 * HM64 + 8192;
constexpr size_t PRJ_DQKV = PRJ_RAWQK + (size_t)16384 * 512 * 2;
constexpr size_t PRJ_END = PRJ_DQKV + (size_t)16384 * 384 * 2;
static_assert(PRJ_END - PRJ_DEAD >= 33554432, "Y fits the dead part of PRJ");
constexpr size_t WS_Y = WS_PRJ + PRJ_DEAD;
constexpr size_t WS_YBUF = WS_PRJ;
static_assert((size_t)2 * 16384 * 1024 * 2 <= PRJ_END, "YBUF fits the PRJ region");
constexpr size_t WS_ML = WS_PRJ + PRJ_END;
constexpr size_t ML_KC = 32 * HM64, ML_DELTA = 2 * ML_KC, ML_DN = ML_DELTA + (size_t)1024 * 4096 * 2, ML_G = ML_DN + (size_t)1024 * 64 * 4, ML_BL = ML_G + (size_t)8 * 4 * 2048 * 2 * 4, ML_CP = ML_BL + 4096, ML_NP = ML_CP + (size_t)1024 * 4096 * 2, ML_END = ML_NP + (size_t)1024 * 64 * 2;
constexpr size_t WS_CMP = WS_ML + ML_END;
constexpr size_t CMP_V = (size_t)8 * 2 * 128 * 64 * 2;
constexpr size_t WS_META = WS_CMP + 2 * CMP_V;
constexpr size_t META_W = (size_t)32 * 16384 * 4, META_RT = 2 * META_W;
constexpr size_t WS_END = WS_META + META_RT + (size_t)16384 * 16;
constexpr int CW_BAR = 0;
constexpr int CW_Q = 4096;
constexpr int CW_SCAN = 4608;
constexpr int CW_TS = 4864;
constexpr int CW_CHK = 5120;
constexpr int CW_CNT = 8192;
constexpr int LDS_BYTES = 147456;
constexpr int LDS_MISC = LDS_BYTES - 256;
#define XB_TMO      128
#define XB_XCNT(j)  (256  + 64 * (j))
#define XB_XSUB(j)  (1280 + 64 * (j))
#define XB_XGEN(j)  (2304 + 64 * (j))
#define XB_TOP      3328
#define XB_TOPGEN   3392
#define XCD_BAR_WORDS 3456
#define XB_SPIN_CAP (1u << 18)

__device__ __forceinline__ unsigned xb_ld(unsigned* p)              { return __hip_atomic_load(p, __ATOMIC_RELAXED, __HIP_MEMORY_SCOPE_AGENT); }
__device__ __forceinline__ unsigned xb_add(unsigned* p, unsigned v) { return __hip_atomic_fetch_add(p, v, __ATOMIC_RELAXED, __HIP_MEMORY_SCOPE_AGENT); }
__device__ __forceinline__ unsigned xb_xcc_id() { return (unsigned)__builtin_amdgcn_s_getreg((3 << 11) | 20) & 0xFu; }
#define XB_SPIN(cond, bar) do { unsigned _sp = 0; while (cond) { __builtin_amdgcn_s_sleep(1); \
    if ((++_sp & 255u) == 0u) { if (xb_ld(&(bar)[XB_TMO])) break; if (_sp > XB_SPIN_CAP) { atomicAdd(&(bar)[XB_TMO], 1u); break; } } } } while (0)

struct XcdBarrier {
    int g_wv; unsigned* bar; unsigned x;
    volatile LAS unsigned* st;
};

__device__ __forceinline__ XcdBarrier xcd_barrier_post(unsigned* bar, volatile LAS unsigned* st, int g_wv) {
    XcdBarrier b; b.g_wv = g_wv; b.bar = bar; b.x = xb_xcc_id(); b.st = st;
    if (TIDX == 0) (void)xb_add(&bar[XB_XCNT(b.x)], 1u);
    return b;
}
__device__ __forceinline__ void xcd_barrier_complete(unsigned* bar, unsigned x, unsigned& nloc, unsigned& nx) {
    const unsigned G = gridDim.x * gridDim.y * gridDim.z;
    unsigned sum, cnt, mine, sp = 0u;
    for (;;) {
        sum = 0u; cnt = 0u; mine = 0u;
#pragma unroll
        for (unsigned j = 0; j < 16; ++j) { const unsigned c = xb_ld(&bar[XB_XCNT(j)]); sum += c; cnt += (c > 0u) ? 1u : 0u; mine = (j == x) ? c : mine; }
        if (sum == G) break;
        __builtin_amdgcn_s_sleep(1);
        if ((++sp & 255u) == 0u) { if (xb_ld(&bar[XB_TMO])) break; if (sp > XB_SPIN_CAP) { atomicAdd(&bar[XB_TMO], 1u); break; } }
    }
    nloc = mine > 0u ? mine : 1u; nx = cnt > 0u ? cnt : 1u;
}

__device__ __forceinline__ void xcd_barrier(const XcdBarrier& b) {
    asm volatile("s_waitcnt vmcnt(0)" ::: "memory");
    __syncthreads();
    const int g_wv = b.g_wv;
    if (TIDX == 0) {
        unsigned* bar = b.bar;
        __builtin_amdgcn_s_waitcnt(0);
        unsigned nloc = b.st[0], nx = b.st[1];
        if (nloc == 0u) { xcd_barrier_complete(bar, b.x, nloc, nx); b.st[0] = nloc; b.st[1] = nx; }
        const unsigned old = xb_add(&bar[XB_XSUB(b.x)], 1u);
        const unsigned gen = old / nloc;
        if (old + 1u == (gen + 1u) * nloc) {
            __builtin_amdgcn_fence(__ATOMIC_RELEASE, "agent");
            asm volatile("s_waitcnt vmcnt(0)" ::: "memory");
            const unsigned og = xb_add(&bar[XB_TOP], 1u);
            const unsigned tg = og / nx;
            if (og + 1u == (tg + 1u) * nx) xb_add(&bar[XB_TOPGEN], 1u);
            else XB_SPIN(xb_ld(&bar[XB_TOPGEN]) == tg, bar);
            __builtin_amdgcn_fence(__ATOMIC_ACQUIRE, "agent");
            xb_add(&bar[XB_XGEN(b.x)], 1u);
            asm volatile("s_waitcnt vmcnt(0)" ::: "memory");
        } else {
            XB_SPIN(xb_ld(&bar[XB_XGEN(b.x)]) == gen, bar);
            __builtin_amdgcn_fence(__ATOMIC_ACQUIRE, "agent");
            asm volatile("s_waitcnt vmcnt(0)" ::: "memory");
        }
    }
    __syncthreads();
}
struct Inputs { const float* p[30]; };
typedef const __attribute__((address_space(4))) Inputs* InPtr;
__device__ __forceinline__ InPtr in_tab() { InPtr p = (InPtr)__builtin_amdgcn_kernarg_segment_ptr(); asm volatile("" : "+s"(p)); return p; }
__device__ __forceinline__ unsigned char* launder(unsigned char* p) { size_t z = 0; asm volatile("" : "+s"(z)); return p + z; }

__host__ __device__ inline int inproj_refcol(int G, int e) {
    if (G < 6) return O_AQ + G * 64 + e;
    if (G < 18) return O_AKV + (G - 6) * 64 + e;
    if (G < 26) return O_BQK + (G - 18) * 64 + e;
    if (G < 30) return O_BV + (G - 26) * 64 + e;
    if (G < 34) return O_BO + (G - 30) * 64 + e;
    if (G < 37) return O_CDQ + (G - 34) * 64 + e;
    if (G == 37) { if (e < 32) return O_CKR + e; if (e < 50) return O_AG + (e - 32); if (e < 58) return O_BIF + (e - 50); return -1; }
    return O_CDKV + (G - 38) * 64 + e;
}
__host__ __device__ inline int uq_refcol(int G, int e) {
    if (G < 6) return G * 96 + e;
    if (G < 9) { const int idx = e & 31, bj = e >> 5, sub = idx >> 4, i = idx & 15; return (2 * (G - 6) + sub) * 96 + 64 + bj * 16 + i; }
    return -1;
}
__host__ __device__ inline int ukv_refcol(int G, int e) { return G < 6 ? G * 128 + e : (G - 6) * 128 + 64 + e; }
#define N2G(n) ((((n) >> 8) << 2) + (((n) >> 5) & 3))
#define N2E(n) (((((n) >> 7) & 1) << 5) + ((n) & 31))

__device__ __forceinline__ float opaque_f(float v) { asm volatile("" : "+v"(v)); return v; }
struct FWin { const float* w; const float* g; __device__ __forceinline__ void ld(int k, int n, const float*& p, float& gn, float gk) const { const int c = inproj_refcol(N2G(n), N2E(n)); p = w + (size_t)k * DIN + (c < 0 ? 0 : c); gn = c < 0 ? 0.f : gk; }
    __device__ __forceinline__ float rowgain(int k) const { return opaque_f(g[k]); } };
struct FWout { const float* w; const float* ga; const float* gc; __device__ __forceinline__ void ld(int k, int n, const float*& p, float& gn, float gk) const {
    const int kr = k < 384 ? k : (k < 768 ? 640 + (k - 384) : 384 + (k - 768)); p = w + (size_t)kr * 1024 + n; gn = gk; }
    __device__ __forceinline__ float rowgain(int k) const { const float a = opaque_f(ga[k < 384 ? k : 0]), c = opaque_f(gc[(k >= 384 && k < 768) ? k - 384 : 0]); return k < 384 ? a : (k < 768 ? c : 1.f); } };
struct FWuq { const float* w; const float* g; __device__ __forceinline__ void ld(int k, int n, const float*& p, float& gn, float gk) const { const int c = uq_refcol(N2G(n), N2E(n)); const int kk = k < 192 ? k : 191; p = w + (size_t)kk * 576 + (c < 0 ? 0 : c); gn = (k < 192 && c >= 0) ? gk : 0.f; }
    __device__ __forceinline__ float rowgain(int k) const { return opaque_f(g[k < 192 ? k : 191]); } };
struct FWukv { const float* w; const float* g; __device__ __forceinline__ void ld(int k, int n, const float*& p, float& gn, float gk) const { const int c = ukv_refcol(N2G(n), N2E(n)); const int kk = k >= 128 ? k - 128 : 0; p = w + (size_t)kk * 768 + c; gn = k >= 128 ? gk : 0.f; }
    __device__ __forceinline__ float rowgain(int k) const { return opaque_f(g[k >= 128 ? k - 128 : 0]); } };
struct FWc1 { const float* w; __device__ __forceinline__ void ld(int k, int n, const float*& p, float& gn, float gk) const { p = w + (size_t)k * 64 + n; gn = 1.f; }
    __device__ __forceinline__ float rowgain(int k) const { return 1.f; } };
struct FWr { const float* wg; const float* we; const float* g; __device__ __forceinline__ void ld(int k, int n, const float*& p, float& gn, float gk) const { p = n < 4 ? wg + k * 4 + n : we + k * 32 + (n < 36 ? n - 4 : 0); gn = n < 36 ? gk : 0.f; }
    __device__ __forceinline__ float rowgain(int k) const { return opaque_f(g[k]); } };
struct FWgu { const float* src; const float* g; int n0, col0; __device__ __forceinline__ float operator()(int k, int n) const { return src[(size_t)k * 256 + col0 + (n - n0)] * g[k]; } };
struct FWd { const float* w; __device__ __forceinline__ float operator()(int k, int n) const { return w[(size_t)k * 1024 + n]; } };

__device__ __forceinline__ void rope_cs(int pos, int j, float& cs, float& sn) {
    const double inv = exp2(-(double)j * (13.287712379549449 / 16.0));
    const double rev = (double)pos * inv * 0.15915494309189535; const float f = (float)(rev - rint(rev));
    cs = __builtin_amdgcn_cosf(f); sn = __builtin_amdgcn_sinf(f);
}
template <class F>
__device__ __forceinline__ void cvt_tile(const F& f, int n0, int k0, bf16_t* dst, int ldk, LAS float* tile, int tid) {
    { const int k = tid >> 3, nb = (tid & 7) * 8; const float gk = f.rowgain(k0 + k); const float* p[8]; float gn[8], v[8];
#pragma unroll
      for (int j = 0; j < 8; ++j) f.ld(k0 + k, n0 + nb + j, p[j], gn[j], gk);
#pragma unroll
      for (int j = 0; j < 8; ++j) v[j] = *p[j];
#pragma unroll
      for (int j = 0; j < 8; ++j) tile[k * 65 + nb + j] = v[j] * gn[j]; }
    __syncthreads();
    { const int n = tid >> 3, kb = (tid & 7) * 8; const LAS float* s = tile + kb * 65 + n;
      u32x4 o; o.x = pk_bf16(s[0], s[65]); o.y = pk_bf16(s[130], s[195]); o.z = pk_bf16(s[260], s[325]); o.w = pk_bf16(s[390], s[455]);
      *(u32x4*)(dst + (size_t)(n0 + n) * ldk + k0 + kb) = o; }
    __syncthreads();
}
template <class F>
__device__ __forceinline__ void cvt_item(const F& f, int it, int nK, bf16_t* dst, int ldk, LAS float* tile, int tid) { cvt_tile(f, (it / nK) * 64, (it % nK) * 64, dst, ldk, tile, tid); }

__device__ __forceinline__ void moe_item(InPtr in, int l, int it, const float*& src, int& ld, size_t& dst, int& ldk, bool& gain, int& kk0) {
    if (it < 32 * 64) { const int e = it >> 6, r = it & 63, n0 = (r >> 3) * 64, k0 = (r & 7) * 128, c0 = n0 & 255;
        src = (c0 < 128 ? in->p[27] : in->p[28]) + ((size_t)l * 32 + e) * 262144 + (size_t)k0 * 256 + (n0 >> 8) * 128 + (c0 & 127); ld = 256; gain = true; kk0 = k0;
        dst = ((size_t)e * 512 + n0) * 1024 + k0; ldk = 1024; }
    else { const int j = it - 32 * 64, e = j >> 5, r = j & 31, n0 = (r >> 1) * 64, k0 = (r & 1) * 128;
        src = in->p[29] + ((size_t)l * 32 + e) * 262144 + (size_t)k0 * 1024 + n0; ld = 1024; gain = false; kk0 = 0;
        dst = (size_t)16777216 + ((size_t)e * 1024 + n0) * 256 + k0; ldk = 256; }
}
__device__ __forceinline__ void cvt_moe_layer(InPtr in, unsigned char* ws, int l, LAS float* tile, int bid, int nb, int tid, int it_lo = 0, int it_hi = 32 * (64 + 32)) {
    asm volatile("" : "+v"(tid));
    const float* g2 = in->p[22] + l * 1024; bf16_t* W = (bf16_t*)(ws + WS_WMOE);
    const int k = tid >> 3, nbq = (tid & 7) * 8;
    const int n = tid >> 3, kb = (tid & 7) * 8;
    const int NIT = it_hi;
#define CVM_LOAD(it_, P) do { const float* src_; int ld_, ldk_, kk0_; size_t dst_; bool gain_; moe_item(in, l, (it_), src_, ld_, dst_, ldk_, gain_, kk0_); \
        P##a = *(const f32x4*)(src_ + (size_t)k * ld_ + nbq); P##b = *(const f32x4*)(src_ + (size_t)k * ld_ + nbq + 4); P##c = *(const f32x4*)(src_ + (size_t)(k + 64) * ld_ + nbq); P##d = *(const f32x4*)(src_ + (size_t)(k + 64) * ld_ + nbq + 4); \
        P##g0 = gain_ ? g2[kk0_ + k] : 1.f; P##g1 = gain_ ? g2[kk0_ + 64 + k] : 1.f; } while (0)
#define CVM_PUT(t, P) do { \
        t[k * 65 + nbq + 0] = P##a.x * P##g0; t[k * 65 + nbq + 1] = P##a.y * P##g0; t[k * 65 + nbq + 2] = P##a.z * P##g0; t[k * 65 + nbq + 3] = P##a.w * P##g0; \
        t[k * 65 + nbq + 4] = P##b.x * P##g0; t[k * 65 + nbq + 5] = P##b.y * P##g0; t[k * 65 + nbq + 6] = P##b.z * P##g0; t[k * 65 + nbq + 7] = P##b.w * P##g0; \
        t[(k + 64) * 65 + nbq + 0] = P##c.x * P##g1; t[(k + 64) * 65 + nbq + 1] = P##c.y * P##g1; t[(k + 64) * 65 + nbq + 2] = P##c.z * P##g1; t[(k + 64) * 65 + nbq + 3] = P##c.w * P##g1; \
        t[(k + 64) * 65 + nbq + 4] = P##d.x * P##g1; t[(k + 64) * 65 + nbq + 5] = P##d.y * P##g1; t[(k + 64) * 65 + nbq + 6] = P##d.z * P##g1; t[(k + 64) * 65 + nbq + 7] = P##d.w * P##g1; } while (0)
#define CVM_STORE(it_, t) do { const float* src_; int ld_, ldk_, kk0_; size_t dst_; bool gain_; moe_item(in, l, (it_), src_, ld_, dst_, ldk_, gain_, kk0_); \
        _Pragma("unroll") for (int hh = 0; hh < 2; ++hh) { const LAS float* s_ = t + (64 * hh + kb) * 65 + n; \
            u32x4 o; o.x = pk_bf16(s_[0], s_[65]); o.y = pk_bf16(s_[130], s_[195]); o.z = pk_bf16(s_[260], s_[325]); o.w = pk_bf16(s_[390], s_[455]); \
            *(u32x4*)(W + dst_ + (size_t)n * ldk_ + 64 * hh + kb) = o; } } while (0)
    f32x4 Aa, Ab, Ac, Ad, Ba, Bb, Bc, Bd; float Ag0 = 1.f, Ag1 = 1.f, Bg0 = 1.f, Bg1 = 1.f;
    LAS float* t0 = tile; LAS float* t1 = tile + 128 * 65;
    int it = it_lo + bid;
    if (it < NIT) CVM_LOAD(it, A);
    if (it + nb < NIT) CVM_LOAD(it + nb, B);
#pragma unroll 1
    for (; it < NIT; it += 2 * nb) {
        CVM_PUT(t0, A);
        __syncthreads();
        if (it + 2 * nb < NIT) CVM_LOAD(it + 2 * nb, A);
        CVM_STORE(it, t0);
        if (it + nb < NIT) {
            CVM_PUT(t1, B);
            __syncthreads();
            if (it + 3 * nb < NIT) CVM_LOAD(it + 3 * nb, B);
            CVM_STORE(it + nb, t1);
        }
    }
#undef CVM_LOAD
#undef CVM_PUT
#undef CVM_STORE
    __syncthreads();
}

__device__ __forceinline__ void cvt_small_weights(InPtr in, unsigned char* ws, int l, LAS float* tile, int bid, int nb, int tid) {
    asm volatile("" : "+v"(tid));
    constexpr int I_WIN = 40 * 16, I_WOUT = 16 * 16, I_WU = 12 * 4, I_WC1 = 32, I_WC2 = 1, I_WR = 16;
    constexpr int PER_L = I_WIN + I_WOUT + 2 * I_WU + 2 * I_WC1 + 2 * I_WC2 + I_WR;
    for (int it0 = bid; it0 < PER_L; it0 += nb) {
        int it = it0;
        if (it < I_WIN) { FWin f{in->p[4] + (size_t)l * 1024 * DIN, in->p[3] + l * 1024}; cvt_item(f, it, 16, (bf16_t*)(ws + WS_WIN) + (size_t)l * 2560 * 1024, 1024, tile, tid); continue; } it -= I_WIN;
        if (it < I_WOUT) { FWout f{in->p[21] + (size_t)l * 1048576, in->p[10] + l * 384, in->p[20] + l * 384}; cvt_item(f, it, 16, (bf16_t*)(ws + WS_WOUT) + (size_t)l * 1048576, 1024, tile, tid); continue; } it -= I_WOUT;
        if (it < I_WU) { FWuq f{in->p[16] + (size_t)l * 192 * 576, in->p[15] + l * 192}; cvt_item(f, it, 4, (bf16_t*)(ws + WS_WUQ) + (size_t)l * 768 * 256, 256, tile, tid); continue; } it -= I_WU;
        if (it < I_WU) { FWukv f{in->p[18] + (size_t)l * 128 * 768, in->p[17] + l * 128}; cvt_item(f, it, 4, (bf16_t*)(ws + WS_WUKV) + (size_t)l * 768 * 256, 256, tile, tid); continue; } it -= I_WU;
        if (it < 2 * I_WC1) { const int s = it / I_WC1; FWc1 f{in->p[6] + ((size_t)l * 2 + s) * 2048 * 64}; cvt_item(f, it % I_WC1, 32, (bf16_t*)(ws + WS_WC1) + ((size_t)l * 2 + s) * 64 * 2048, 2048, tile, tid); continue; } it -= 2 * I_WC1;
        if (it < 2 * I_WC2) { const int s = it; FWc1 f{in->p[7] + ((size_t)l * 2 + s) * 64 * 64}; cvt_item(f, 0, 1, (bf16_t*)(ws + WS_WC2) + ((size_t)l * 2 + s) * 64 * 64, 64, tile, tid); continue; } it -= 2 * I_WC2;
        { FWr f{in->p[23] + (size_t)l * 4096, in->p[25] + (size_t)l * 32768, in->p[22] + l * 1024}; cvt_item(f, it, 16, (bf16_t*)(ws + WS_WR) + (size_t)l * 64 * 1024, 1024, tile, tid); }
    }
}

__device__ __forceinline__ void prologue(InPtr in, unsigned char* ws, LAS unsigned char* lds, int bid, int nb, int g_wv) {
    int tid_ = TIDX; asm volatile("" : "+v"(tid_));
    const int tid = tid_, lane = tid & 63, wid = tid >> 6;
    LAS float* tile = (LAS float*)lds;
    cvt_small_weights(in, ws, 0, tile, bid, nb, tid);
    { const float* x = in->p[0]; bf16_t* XB = (bf16_t*)(ws + WS_XB); float* ssqx = (float*)(ws + WS_SSQX);
      for (int r = bid * 8 + wid; r < NTOK; r += nb * 8) {
          const f32x4* xr = (const f32x4*)(x + (size_t)r * 1024) + lane; float s = 0.f; u32x2* o = (u32x2*)(XB + (size_t)r * 1024) + lane;
#pragma unroll
          for (int j = 0; j < 4; ++j) { const f32x4 v = xr[64 * j]; s += (v.x * v.x + v.y * v.y) + (v.z * v.z + v.w * v.w); u32x2 w; w.x = pk_bf16(v.x, v.y); w.y = pk_bf16(v.z, v.w); o[64 * j] = w; }
          s = wave_sum(s); if (lane == 0) ssqx[r] = s;
      } }
    { float* biasd = (float*)(ws + WS_BIASD); const float* rb = in->p[2];
      for (int i = bid * 512 + tid; i < 6 * 2048; i += nb * 512) { const int h = i >> 11, d = i & 2047; biasd[i] = rb[t5b(d) * 6 + h] * 1.44269504f; } }
    { float* rope = (float*)(ws + WS_ROPE); const int* pos = (const int*)in->p[1];
      for (int i = bid * 512 + tid; i < NTOK * 16; i += nb * 512) { const int tk = i >> 4, j = i & 15; float cs, sn; rope_cs(pos[tk], j, cs, sn); rope[(size_t)tk * 32 + j] = cs; rope[(size_t)tk * 32 + 16 + j] = sn; } }
    { float* b1c = (float*)(ws + WS_B1C); LAS float* red = (LAS float*)lds;
      for (int it = bid; it < 4; it += nb) { const float* pe = in->p[5] + (size_t)it * 2048; const float* w1 = in->p[6] + (size_t)it * 2048 * 64; const int f = tid & 63, part = tid >> 6;
          float a = 0.f; for (int k = part * 256; k < part * 256 + 256; ++k) a += pe[k] * w1[(size_t)k * 64 + f];
          __syncthreads(); red[tid] = a; __syncthreads();
          if (tid < 64) { float s = 0.f; for (int p2 = 0; p2 < 8; ++p2) s += red[p2 * 64 + tid]; b1c[it * 64 + tid] = s; }
          __syncthreads(); } }
}
namespace g8 {
constexpr int BM = 256, BK = 64, HALF = 128, HTB = HALF * BK * 2, STAGE_BYTES = 8 * HTB, NXCD = 8, WGM = 8;
__host__ __device__ __forceinline__ int lds_byte(int r, int c) { const int st = (r >> 4) * 2 + (c >> 5), rr = r & 15, cc = c & 31, ob = rr * 64 + cc * 2; return st * 1024 + (ob ^ (((ob >> 9) & 1) << 5)); }
__host__ __device__ __forceinline__ void stage_rc(int b, int& R, int& C) { const int st = b / 1024, sb = b % 1024, swz = sb ^ (((sb >> 9) & 1) << 5); R = (st >> 1) * 16 + swz / 64; C = (st & 1) * 32 + (swz % 64) / 2; }
__host__ __device__ __forceinline__ int perm32(int rho) { const int n = rho >> 4, i = rho & 15; return 8 * (i >> 2) + 4 * n + (i & 3); }

struct GUnit { const char* a; const char* b; int pm, pn, e, rows; };

__device__ __forceinline__ bool static_unit(int i, int G, int c, int nM, int nN, int& pm, int& pn) {
    const int nwg = nM * nN; const long L = (long)i * G + c; if (L >= nwg) return false;
    int wgid = (int)L; { const int q = nwg / NXCD, r = nwg % NXCD, xcd = wgid % NXCD, off = wgid / NXCD; wgid = (xcd < r ? xcd * (q + 1) : r * (q + 1) + (xcd - r) * q) + off; }
    const int nig = WGM * nN, gid = wgid / nig, fm = gid * WGM, gsz = (nM - fm) < WGM ? (nM - fm) : WGM;
    pm = fm + ((wgid % nig) % gsz); pn = (wgid % nig) / gsz; return true;
}
struct DenseSched {
    static constexpr bool GATHER = false, PARTIAL = false;
    const char* A; const char* Bt; int lda, ldb, nM, nN, G, c;
    __device__ __forceinline__ bool next(int i, GUnit& u) const {
        int pm, pn; if (!static_unit(i, G, c, nM, nN, pm, pn)) return false;
        u.pm = pm; u.pn = pn; u.e = 0; u.rows = 256; u.a = A + (size_t)pm * 256 * lda * 2; u.b = Bt + (size_t)pn * 256 * ldb * 2; return true;
    }
    __device__ __forceinline__ void aoff(const GUnit&, unsigned (&v)[2][2], const int (&R)[2], const int (&C)[2]) const {
#pragma unroll
        for (int h = 0; h < 2; ++h)
#pragma unroll
            for (int i = 0; i < 2; ++i) v[h][i] = (unsigned)((h * 128 + R[i]) * lda + C[i]) * 2u;
    }
};

template <class Epi, class Sched>
__device__ __forceinline__ void gemm_run(LAS unsigned char* lds, const int K, const int ldb, const Sched& S, const Epi& E, int g_wv) {
    int tid_ = TIDX; asm volatile("" : "+v"(tid_));
    const int tid = tid_, wid = __builtin_amdgcn_readfirstlane(tid >> 6), lane = tid & 63, wr = wid >> 2, wc = wid & 3, fr = lane & 15, fq = lane >> 4;
    int nt_ = K / BK; asm volatile("" : "+s"(nt_));
    const int nt = nt_;
    int R[2], C[2]; unsigned voffB[2];
#pragma unroll
    for (int i = 0; i < 2; ++i) { stage_rc(tid * 16 + i * 8192, R[i], C[i]); const int Rb = (R[i] & ~31) + perm32(R[i] & 31); voffB[i] = (unsigned)(Rb * ldb + C[i]) * 2u; }
    const size_t kstep = (size_t)(BK * 2);
    const size_t hstepB = (size_t)HALF * ldb * 2;
    const unsigned ldsw = (unsigned)wid * 1024u;
    const int aoff = lds_byte(wr * 64 + fr, fq * 8), boff = lds_byte(wc * 32 + fr, fq * 8);
#define G8_SA(b, h) (((b) * 2 + (h)) * HTB)
#define G8_SB(b, h) ((4 + (b) * 2 + (h)) * HTB)
#define G8_GLDS(bufoff, gptr, i_) __builtin_amdgcn_global_load_lds((const unsigned*)(gptr), (LAS unsigned*)(lds + (bufoff) + ldsw + (i_) * 8192), 16, 0, 0)
#define G8_STAGE_B(bufoff, gbase) do { G8_GLDS(bufoff, (const char*)(gbase) + voffB[0], 0); G8_GLDS(bufoff, (const char*)(gbase) + voffB[1], 1); } while (0)
#define G8_STAGE_A(bufoff, gbase, v0, v1) do { G8_GLDS(bufoff, (const char*)(gbase) + (v0), 0); G8_GLDS(bufoff, (const char*)(gbase) + (v1), 1); } while (0)
#define G8_LDA(dst, b, h) do { _Pragma("unroll") for (int m = 0; m < 4; ++m) _Pragma("unroll") for (int k = 0; k < 2; ++k) dst[m][k] = *(const LAS bf16x8*)(lds + G8_SA(b, h) + aoff + m * 2048 + k * 1024); } while (0)
#define G8_LDB(dst, b, h) do { _Pragma("unroll") for (int n = 0; n < 2; ++n) _Pragma("unroll") for (int k = 0; k < 2; ++k) dst[n][k] = *(const LAS bf16x8*)(lds + G8_SB(b, h) + boff + n * 2048 + k * 1024); } while (0)
#define G8_MMA(ai, bj, At, Bt) do { __builtin_amdgcn_s_setprio(1); _Pragma("unroll") for (int m = 0; m < 4; ++m) { if (!PARTIAL || ((mmask >> ((ai) * 4 + m)) & 1u)) { _Pragma("unroll") for (int n = 0; n < 2; ++n) _Pragma("unroll") for (int k = 0; k < 2; ++k) \
        acc[ai][bj][m][n] = __builtin_amdgcn_mfma_f32_16x16x32_bf16(Bt[n][k], At[m][k], acc[ai][bj][m][n], 0, 0, 0); } } __builtin_amdgcn_s_setprio(0); } while (0)
#define G8_WAIT_V(n) asm volatile("s_waitcnt vmcnt(" #n ")" ::: "memory")
#define G8_WAIT_L(n) asm volatile("s_waitcnt lgkmcnt(" #n ")" ::: "memory")
#define G8_BAR __builtin_amdgcn_s_barrier()
#define G8_SCHED __builtin_amdgcn_sched_barrier(0)
    GUnit cur, nxt; int ui = 0;
    if (!S.next(0, cur)) return;
    constexpr bool GATHER = Sched::GATHER, PARTIAL = Sched::PARTIAL;
    unsigned mmask = 0xffu;
#define G8_MASK(u) do { if (PARTIAL) { mmask = 0u; _Pragma("unroll") for (int q_ = 0; q_ < 8; ++q_) mmask |= (((q_ >> 2) * 128 + wr * 64 + (q_ & 3) * 16) < (u).rows) ? (1u << q_) : 0u; } } while (0)
    unsigned vc[2][2];
    S.aoff(cur, vc, R, C); G8_MASK(cur);
    LAS u32x4* stash = (LAS u32x4*)(lds + STAGE_BYTES + 4096) + tid;
    f32x4 acc[2][2][4][2];
#pragma unroll
    for (int a = 0; a < 2; ++a)
#pragma unroll
        for (int b = 0; b < 2; ++b)
#pragma unroll
            for (int m = 0; m < 4; ++m)
#pragma unroll
                for (int n = 0; n < 2; ++n) acc[a][b][m][n] = (f32x4){0.f, 0.f, 0.f, 0.f};
    bf16x8 At[4][2], B0[2][2], B1[2][2];
    const char* cA = cur.a; const char* cB = cur.b;
    G8_STAGE_B(G8_SB(0, 0), cB); G8_STAGE_B(G8_SB(0, 1), cB + hstepB); G8_STAGE_A(G8_SA(0, 0), cA, vc[0][0], vc[0][1]); G8_STAGE_A(G8_SA(0, 1), cA, vc[1][0], vc[1][1]);
    if (wr == 1) G8_BAR;
    G8_WAIT_V(2); G8_BAR;
    G8_STAGE_B(G8_SB(1, 0), cB + kstep); G8_STAGE_A(G8_SA(1, 0), cA + kstep, vc[0][0], vc[0][1]); G8_STAGE_B(G8_SB(1, 1), cB + hstepB + kstep);
    G8_WAIT_V(6); G8_BAR;
    for (;;) {
        const bool has_next = S.next(ui + 1, nxt);
        if (GATHER) { unsigned vn[2][2];
            if (has_next) S.aoff(nxt, vn, R, C);
            else { vn[0][0] = vc[0][0]; vn[0][1] = vc[0][1]; vn[1][0] = vc[1][0]; vn[1][1] = vc[1][1]; }
            u32x4 sv; sv.x = vn[0][0]; sv.y = vn[0][1]; sv.z = vn[1][0]; sv.w = vn[1][1]; *stash = sv; }
        const char* nA = has_next ? nxt.a : cA; const char* nB = has_next ? nxt.b : cB;
#pragma unroll 1
        for (int seg = 0; seg < (Epi::KHOOK ? 3 : 1); ++seg) {
        const int tlo = Epi::KHOOK ? 6 * seg : 0, thi = Epi::KHOOK ? (seg == 2 ? nt : 6 * seg + 6) : nt;
#pragma unroll 1
        for (int t = tlo; t < thi; t += 2) {
            const bool last = (t == nt - 2);
            const char* a1 = cA + (size_t)(t + 1) * kstep;
            const char* a2 = last ? nA : cA + (size_t)(t + 2) * kstep; const char* b2 = last ? nB : cB + (size_t)(t + 2) * kstep;
            const char* a3 = a2 + kstep; const char* b3 = b2 + kstep;
            unsigned w00 = vc[0][0], w01 = vc[0][1], w10 = vc[1][0], w11 = vc[1][1];
            if (GATHER) { if (last) { const u32x4 sv = *stash; w00 = sv.x; w01 = sv.y; w10 = sv.z; w11 = sv.w; } }
            G8_LDB(B0, 0, 0); G8_LDB(B1, 0, 1); G8_SCHED; G8_LDA(At, 0, 0); G8_STAGE_A(G8_SA(1, 1), a1, vc[1][0], vc[1][1]);
            G8_WAIT_V(8); G8_WAIT_L(0); G8_BAR; G8_MMA(0, 0, At, B0); G8_MMA(0, 1, At, B1); G8_BAR; G8_SCHED;
            G8_LDA(At, 0, 1); G8_STAGE_B(G8_SB(0, 0), b2); G8_STAGE_B(G8_SB(0, 1), b2 + hstepB); G8_STAGE_A(G8_SA(0, 0), a2, w00, w01);
            G8_WAIT_V(8); G8_WAIT_L(0); G8_BAR; G8_MMA(1, 0, At, B0); G8_MMA(1, 1, At, B1); G8_BAR; G8_SCHED;
            G8_LDB(B0, 1, 0); G8_LDB(B1, 1, 1); G8_SCHED; G8_LDA(At, 1, 0); G8_STAGE_A(G8_SA(0, 1), a2, w10, w11);
            G8_WAIT_V(8); G8_WAIT_L(0); G8_BAR; G8_MMA(0, 0, At, B0); G8_MMA(0, 1, At, B1); G8_BAR; G8_SCHED;
            G8_LDA(At, 1, 1); G8_STAGE_B(G8_SB(1, 0), b3); G8_STAGE_B(G8_SB(1, 1), b3 + hstepB); G8_STAGE_A(G8_SA(1, 0), a3, w00, w01);
            G8_WAIT_V(8); G8_WAIT_L(0); G8_BAR; G8_MMA(1, 0, At, B0); G8_MMA(1, 1, At, B1); G8_BAR; G8_SCHED;
        }
        if constexpr (Epi::KHOOK) { if (seg < 2) E.kscale(acc, seg, wr, fr); }
        }
        if (wr == 0) G8_BAR;
        { int fr_ = fr, fq_ = fq; asm volatile("" : "+v"(fr_), "+v"(fq_));
          E(acc, cur, wr, wc, fr_, fq_); }
        if (!has_next) break;
#pragma unroll
        for (int a = 0; a < 2; ++a)
#pragma unroll
            for (int b = 0; b < 2; ++b)
#pragma unroll
                for (int m = 0; m < 4; ++m)
#pragma unroll
                    for (int n = 0; n < 2; ++n) acc[a][b][m][n] = (f32x4){0.f, 0.f, 0.f, 0.f};
        cur = nxt; cA = nA; cB = nB; ++ui; G8_MASK(cur);
        if (GATHER) { const u32x4 sv = *stash; vc[0][0] = sv.x; vc[0][1] = sv.y; vc[1][0] = sv.z; vc[1][1] = sv.w; }
        if (wr == 1) G8_BAR;
    }
    G8_WAIT_V(0);
    G8_BAR;
#undef G8_SA
#undef G8_SB
#undef G8_GLDS
#undef G8_STAGE_A
#undef G8_STAGE_B
#undef G8_LDA
#undef G8_LDB
#undef G8_MMA
#undef G8_MASK
#undef G8_WAIT_V
#undef G8_WAIT_L
#undef G8_BAR
#undef G8_SCHED
}
}
using g8::GUnit;
__device__ __forceinline__ void st_bf16x8(bf16_t* p, const float (&v)[8]) { u32x4 w; w.x = pk_bf16(v[0], v[1]); w.y = pk_bf16(v[2], v[3]); w.z = pk_bf16(v[4], v[5]); w.w = pk_bf16(v[6], v[7]); *(u32x4*)p = w; }
__device__ __forceinline__ float quad_sum(float s) { s += __shfl_xor(s, 16); s += __shfl_xor(s, 32); return s; }

struct EpiInProj {
    static constexpr bool KHOOK = false;
    const float* ssqx; float* part_dq; float* part_dkv; const float* qg; const float* kg; const float* krg; const float* rope;
    unsigned char* prj;
    __device__ __forceinline__ void operator()(const f32x4 (&acc)[2][2][4][2], const GUnit& u, int wr, int wc, int fr, int fq) const {
        const int G = u.pn * 4 + wc;
        const bool isq = G < 6; const int a = G - 6; const bool isk = (G >= 10 && G < 18 && ((a >> 1) & 1) == 0);
        const float* g0 = (isq ? qg : kg) + 8 * fq;
        float rs8[8];
#pragma unroll
        for (int k = 0; k < 8; ++k) rs8[k] = ssqx[u.pm * 256 + (k >> 2) * 128 + wr * 64 + (k & 3) * 16 + fr];
#pragma unroll
        for (int k = 0; k < 8; ++k) rs8[k] = rsqrtf(rs8[k] * (1.f / 1024.f) + 1e-6f);
#pragma unroll
        for (int ai = 0; ai < 2; ++ai)
#pragma unroll
            for (int m = 0; m < 4; ++m) {
                __builtin_amdgcn_sched_barrier(0);
                const int row = u.pm * 256 + ai * 128 + wr * 64 + m * 16 + fr; const int b = row >> 11, t = row & 2047;
                const float rs = rs8[ai * 4 + m];
                float v[2][8];
#pragma unroll
                for (int bj = 0; bj < 2; ++bj)
#pragma unroll
                    for (int n = 0; n < 2; ++n)
#pragma unroll
                        for (int j = 0; j < 4; ++j) v[bj][4 * n + j] = acc[ai][bj][m][n][j] * rs;
                float ss = 0.f;
#pragma unroll
                for (int bj = 0; bj < 2; ++bj)
#pragma unroll
                    for (int i = 0; i < 8; ++i) ss += v[bj][i] * v[bj][i];
                bf16_t* dst = nullptr; int bstride = 32;
                if (isq) {
                    ss = quad_sum(ss); const float sc = rsqrtf(ss * (1.f / 64.f) + 1e-6f) * 0.18033688f;
#pragma unroll
                    for (int i = 0; i < 8; ++i) { v[0][i] *= sc * g0[i]; v[1][i] *= sc * g0[32 + i]; }
                    dst = (bf16_t*)(prj + PRJ_QN) + ((size_t)(b * 6 + G) * 2048 + t) * 64;
                } else if (G < 18) {
                    const int br = a >> 2, s = (a >> 1) & 1, hk = a & 1;
                    if (br > 0 && s == 0) {
                        ss = quad_sum(ss); const float sc = rsqrtf(ss * (1.f / 64.f) + 1e-6f);
#pragma unroll
                        for (int i = 0; i < 8; ++i) { v[0][i] *= sc * g0[i]; v[1][i] *= sc * g0[32 + i]; }
                    }
                    const size_t base = br == 0 ? (s ? PRJ_C0V : PRJ_C0K) : (br == 1 ? (s ? PRJ_VN1 : PRJ_KN1) : (s ? PRJ_VN2 : PRJ_KN2));
                    dst = (bf16_t*)(prj + base) + ((size_t)(b * 2 + hk) * 2048 + t) * 64;
                } else if (G < 26) { dst = (bf16_t*)(prj + PRJ_RAWQK) + (size_t)row * 512 + (G - 18) * 64; }
                else if (G < 30) { dst = (bf16_t*)(prj + PRJ_VML) + ((size_t)(b * 4 + (G - 26)) * 2048 + t) * 64; }
                else if (G < 34) { dst = (bf16_t*)(prj + PRJ_OG) + (size_t)row * 256 + (G - 30) * 64; }
                else if (G < 37) { dst = (bf16_t*)(prj + PRJ_DQKV) + (size_t)row * 384 + (G - 34) * 64; ss = quad_sum(ss); if (fq == 0) part_dq[(size_t)row * 4 + (G - 34)] = ss; }
                else if (G == 37) {
                    dst = (bf16_t*)(prj + PRJ_DQKV) + (size_t)row * 384 + 192;
                    float* gt = (float*)(prj + PRJ_GATES) + (size_t)row * 32 + 8 * fq;
                    *(f32x4*)gt = (f32x4){v[1][0], v[1][1], v[1][2], v[1][3]}; *(f32x4*)(gt + 4) = (f32x4){v[1][4], v[1][5], v[1][6], v[1][7]};
                    float s0 = 0.f;
#pragma unroll
                    for (int i = 0; i < 8; ++i) s0 += v[0][i] * v[0][i];
                    s0 = quad_sum(s0); const float sc = rsqrtf(s0 * (1.f / 32.f) + 1e-6f);
                    const float* rp = rope + (size_t)row * 32 + ((8 * fq) & 15);
                    float kr[8];
#pragma unroll
                    for (int i = 0; i < 8; ++i) { const float val = v[0][i] * sc * krg[8 * fq + i]; const float oth = __shfl_xor(val, 32); const float cs = rp[i], sn = rp[16 + i]; kr[i] = fq < 2 ? val * cs - oth * sn : val * cs + oth * sn; }
                    st_bf16x8((bf16_t*)(prj + PRJ_KR) + (size_t)row * 32 + 8 * fq, kr);
                } else { dst = (bf16_t*)(prj + PRJ_DQKV) + (size_t)row * 384 + 256 + (G - 38) * 64; ss = quad_sum(ss); if (fq == 0) part_dkv[(size_t)row * 2 + (G - 38)] = ss; }
                st_bf16x8(dst + 8 * fq, v[0]); st_bf16x8(dst + bstride + 8 * fq, v[1]);
            }
    }
};

struct EpiUq {
    static constexpr bool KHOOK = false;
    const float* ssq_dq; const float* qkn; const float* rope; bf16_t* QM;
    __device__ __forceinline__ void operator()(const f32x4 (&acc)[2][2][4][2], const GUnit& u, int wr, int wc, int fr, int fq) const {
        const int G = u.pn * 4 + wc; if (G >= 9) return;
        const float scale = 0.14724444f;
        const float* g0 = G < 6 ? qkn + 8 * fq : qkn + 64 + 8 * (fq & 1); const float* g1 = G < 6 ? g0 + 32 : g0 + 16;
        float rs8[8];
#pragma unroll
        for (int k = 0; k < 8; ++k) { const f32x4 pq = *(const f32x4*)(ssq_dq + (size_t)(u.pm * 256 + (k >> 2) * 128 + wr * 64 + (k & 3) * 16 + fr) * 4); rs8[k] = (pq.x + pq.y) + pq.z; }
#pragma unroll
        for (int k = 0; k < 8; ++k) rs8[k] = rsqrtf(rs8[k] * (1.f / 192.f) + 1e-6f);
#pragma unroll
        for (int ai = 0; ai < 2; ++ai)
#pragma unroll
            for (int m = 0; m < 4; ++m) {
                __builtin_amdgcn_sched_barrier(0);
                const int row = u.pm * 256 + ai * 128 + wr * 64 + m * 16 + fr; const int b = row >> 11, t = row & 2047;
                const float rs = rs8[ai * 4 + m];
                float v[2][8]; float ss = 0.f;
#pragma unroll
                for (int bj = 0; bj < 2; ++bj)
#pragma unroll
                    for (int n = 0; n < 2; ++n)
#pragma unroll
                        for (int j = 0; j < 4; ++j) { const float x = acc[ai][bj][m][n][j] * rs; v[bj][4 * n + j] = x; ss += x * x; }
                if (G < 6) ss = quad_sum(ss); else ss += __shfl_xor(ss, 16);
                const float sc = rsqrtf(ss * (G < 6 ? 1.f / 64.f : 1.f / 32.f) + 1e-6f) * scale;
#pragma unroll
                for (int i = 0; i < 8; ++i) { v[0][i] *= sc * g0[i]; v[1][i] *= sc * g1[i]; }
                if (G < 6) {
                    bf16_t* dst = QM + ((size_t)(b * 6 + G) * 2048 + t) * 96;
                    st_bf16x8(dst + 8 * fq, v[0]); st_bf16x8(dst + 32 + 8 * fq, v[1]);
                } else {
                    const int i16 = 8 * (fq & 1); const int head = 2 * (G - 6) + (fq >> 1);
                    const float* rp = rope + (size_t)row * 32 + i16; float o1[8], o2[8];
#pragma unroll
                    for (int i = 0; i < 8; ++i) { const float cs = rp[i], sn = rp[16 + i]; o1[i] = v[0][i] * cs - v[1][i] * sn; o2[i] = v[1][i] * cs + v[0][i] * sn; }
                    bf16_t* dst = QM + ((size_t)(b * 6 + head) * 2048 + t) * 96 + 64 + i16;
                    st_bf16x8(dst, o1); st_bf16x8(dst + 16, o2);
                }
            }
    }
};
struct EpiUkv {
    static constexpr bool KHOOK = false;
    const float* ssq_dkv; const float* qkn; const bf16_t* KR; bf16_t* KM; bf16_t* VM;
    __device__ __forceinline__ void operator()(const f32x4 (&acc)[2][2][4][2], const GUnit& u, int wr, int wc, int fr, int fq) const {
        const int G = u.pn * 4 + wc;
        const float* g0 = qkn + 96 + 8 * fq;
        float rs8[8];
#pragma unroll
        for (int k = 0; k < 8; ++k) { const size_t rr = (size_t)(u.pm * 256 + (k >> 2) * 128 + wr * 64 + (k & 3) * 16 + fr); rs8[k] = ssq_dkv[rr * 2] + ssq_dkv[rr * 2 + 1]; }
#pragma unroll
        for (int k = 0; k < 8; ++k) rs8[k] = rsqrtf(rs8[k] * (1.f / 128.f) + 1e-6f);
#pragma unroll
        for (int ai = 0; ai < 2; ++ai)
#pragma unroll
            for (int m = 0; m < 4; ++m) {
                __builtin_amdgcn_sched_barrier(0);
                const int row = u.pm * 256 + ai * 128 + wr * 64 + m * 16 + fr; const int b = row >> 11, t = row & 2047;
                const float rs = rs8[ai * 4 + m];
                float v[2][8]; float ss = 0.f;
#pragma unroll
                for (int bj = 0; bj < 2; ++bj)
#pragma unroll
                    for (int n = 0; n < 2; ++n)
#pragma unroll
                        for (int j = 0; j < 4; ++j) { const float x = acc[ai][bj][m][n][j] * rs; v[bj][4 * n + j] = x; ss += x * x; }
                if (G < 6) {
                    ss = quad_sum(ss); const float sc = rsqrtf(ss * (1.f / 64.f) + 1e-6f);
#pragma unroll
                    for (int i = 0; i < 8; ++i) { v[0][i] *= sc * g0[i]; v[1][i] *= sc * g0[32 + i]; }
                    bf16_t* dst = KM + ((size_t)(b * 6 + G) * 2048 + t) * 96;
                    st_bf16x8(dst + 8 * fq, v[0]); st_bf16x8(dst + 32 + 8 * fq, v[1]);
                    *(u32x4*)(dst + 64 + 8 * fq) = *(const u32x4*)(KR + (size_t)row * 32 + 8 * fq);
                } else {
                    bf16_t* dst = VM + ((size_t)(b * 6 + (G - 6)) * 2048 + t) * 64;
                    st_bf16x8(dst + 8 * fq, v[0]); st_bf16x8(dst + 32 + 8 * fq, v[1]);
                }
            }
    }
};
#define MFMA16(a, b, c) __builtin_amdgcn_mfma_f32_16x16x32_bf16(a, b, c, 0, 0, 0)
#define MFMA32(a, b, c) __builtin_amdgcn_mfma_f32_32x32x16_bf16(a, b, c, 0, 0, 0)
#define LDS_FENCE() asm volatile("s_waitcnt lgkmcnt(0)" ::: "memory")

__device__ __forceinline__ void cmp_unit(int u, int l, InPtr in, unsigned char* ws, LAS unsigned char* lds, int g_wv) {
    int tid_ = TIDX; asm volatile("" : "+v"(tid_));
    const int tid = tid_, w = tid >> 6, lane = tid & 63, r = lane & 15, q = lane >> 4;
    const int b = u >> 2, s = (u >> 1) & 1, hk = u & 1;
    const bf16_t* A = (const bf16_t*)(ws + WS_PRJ + (s ? PRJ_C0V : PRJ_C0K)) + (size_t)(b * 2 + hk) * 2048 * 64;
    const bf16_t* W1 = (const bf16_t*)(ws + WS_WC1) + ((size_t)l * 2 + s) * 64 * 2048;
    const bf16_t* W2 = (const bf16_t*)(ws + WS_WC2) + ((size_t)l * 2 + s) * 64 * 64;
    const float* b1 = (const float*)(ws + WS_B1C) + (l * 2 + s) * 64;
    f32x4 acc[4];
#pragma unroll
    for (int nb = 0; nb < 4; ++nb) acc[nb] = (f32x4){0.f, 0.f, 0.f, 0.f};
    const bf16_t* ap = A + (size_t)(16 * w + r) * 1024 + 8 * q;
    constexpr int WP = 528, WBUF = 64 * WP; LAS unsigned char* wb = lds + 24576;
    u32x4 st[4];
#pragma unroll
    for (int i = 0; i < 4; ++i) { const int c = tid + 512 * i; st[i] = *(const u32x4*)(W1 + (size_t)(c >> 5) * 2048 + (c & 31) * 8); }
    bf16x8 af[8], afn[8];
#pragma unroll
    for (int ks = 0; ks < 8; ++ks) af[ks] = *(const bf16x8*)(ap + 32 * ks);
    const float* kg = in->p[9] + l * 64;
    float b1v[4], kgv[4]; bf16x8 w2f[2][4];
#pragma unroll
    for (int nb = 0; nb < 4; ++nb) { b1v[nb] = b1[16 * nb + r]; kgv[nb] = kg[16 * nb + r]; }
#pragma unroll
    for (int ks = 0; ks < 2; ++ks)
#pragma unroll
        for (int nb = 0; nb < 4; ++nb) w2f[ks][nb] = *(const bf16x8*)(W2 + (size_t)(16 * nb + r) * 64 + 32 * ks + 8 * q);
#pragma unroll
    for (int i = 0; i < 4; ++i) { const int c = tid + 512 * i; *(LAS u32x4*)(wb + (c >> 5) * WP + (c & 31) * 16) = st[i]; }
    __syncthreads();
    auto chunk = [&](const int kc, bf16x8 (&ac)[8], bf16x8 (&an)[8]) __attribute__((always_inline)) {
        const int cur = kc & 1;
        if (kc < 7) {
#pragma unroll
            for (int i = 0; i < 4; ++i) { const int c = tid + 512 * i; st[i] = *(const u32x4*)(W1 + (size_t)(c >> 5) * 2048 + (kc + 1) * 256 + (c & 31) * 8); }
#pragma unroll
            for (int ks = 0; ks < 8; ++ks) an[ks] = *(const bf16x8*)(ap + 256 * (kc + 1) + 32 * ks);
        }
#pragma unroll
        for (int ks = 0; ks < 8; ++ks)
#pragma unroll
            for (int nb = 0; nb < 4; ++nb) { const bf16x8 bb = *(const LAS bf16x8*)(wb + cur * WBUF + (16 * nb + r) * WP + (32 * ks + 8 * q) * 2); acc[nb] = MFMA16(ac[ks], bb, acc[nb]); }
        if (kc < 7) {
#pragma unroll
            for (int i = 0; i < 4; ++i) { const int c = tid + 512 * i; *(LAS u32x4*)(wb + (cur ^ 1) * WBUF + (c >> 5) * WP + (c & 31) * 16) = st[i]; }
        }
        __syncthreads();
    };
#pragma unroll 1
    for (int kc = 0; kc < 8; kc += 2) { chunk(kc, af, afn); chunk(kc + 1, afn, af); }
    LAS bf16_t* hl = (LAS bf16_t*)(lds + w * 2304);
#pragma unroll
    for (int nb = 0; nb < 4; ++nb) { const float bias = b1v[nb];
#pragma unroll
        for (int j = 0; j < 4; ++j) hl[(4 * q + j) * 72 + 16 * nb + r] = f2bf(siluf(acc[nb][j] + bias)); }
    LDS_FENCE();
    f32x4 o[4];
#pragma unroll
    for (int nb = 0; nb < 4; ++nb) o[nb] = (f32x4){0.f, 0.f, 0.f, 0.f};
#pragma unroll
    for (int ks = 0; ks < 2; ++ks) {
        const bf16x8 a = *(const LAS bf16x8*)(hl + r * 72 + 32 * ks + 8 * q);
#pragma unroll
        for (int nb = 0; nb < 4; ++nb) o[nb] = MFMA16(a, w2f[ks][nb], o[nb]);
    }
    LDS_FENCE();
    bf16_t* dst = (bf16_t*)(ws + WS_CMP + (s ? CMP_V : 0)) + (size_t)(b * 2 + hk) * 128 * 64;
#pragma unroll
    for (int j = 0; j < 4; ++j) {
        const int n = 16 * w + 4 * q + j; float ss = 0.f;
#pragma unroll
        for (int nb = 0; nb < 4; ++nb) ss += o[nb][j] * o[nb][j];
        ss += __shfl_xor(ss, 1); ss += __shfl_xor(ss, 2); ss += __shfl_xor(ss, 4); ss += __shfl_xor(ss, 8);
        const float sc = s == 0 ? rsqrtf(ss * (1.f / 64.f) + 1e-6f) : 1.f;
#pragma unroll
        for (int nb = 0; nb < 4; ++nb) { const int d = 16 * nb + r; const float v = o[nb][j] * sc * (s == 0 ? kgv[nb] : 1.f); dst[(size_t)n * 64 + d] = n < 127 ? f2bf(v) : (bf16_t)0; }
    }
}

__device__ __forceinline__ int swz_off(int row, int chunk) { return row * 128 + ((chunk ^ (row & 7)) << 4); }
__device__ __forceinline__ float log_sigmoid(float x) { return fminf(x, 0.f) - log1pf(__expf(-fabsf(x))); }
__device__ __forceinline__ void ml_delta_wave(int cu, int l, InPtr in, unsigned char* ws, LAS unsigned char* wl, int lane) {
    asm volatile("" : "+v"(lane));
    const int c = cu & 31, bh = cu >> 5, h = bh & 3, b = bh >> 2; const int t0 = c * 64; const size_t row0 = (size_t)b * 2048 + t0;
    const float* G = (const float*)(ws + WS_PRJ + PRJ_GATES);
    const float ip = G[(row0 + lane) * 32 + 18 + h] + in->p[12][l * 4 + h], fp = G[(row0 + lane) * 32 + 22 + h] + in->p[13][l * 4 + h];
    float bcum = log_sigmoid(fp);
#pragma unroll
    for (int o = 1; o < 64; o <<= 1) { const float t = __builtin_bit_cast(float, __builtin_amdgcn_ds_bpermute(((lane - o) & 63) << 2, __builtin_bit_cast(int, bcum))); if (lane >= o) bcum += t; }
    const float bL = __builtin_bit_cast(float, __builtin_amdgcn_readlane(__builtin_bit_cast(int, bcum), 63)); const float wgt = __expf(bL - bcum + ip);
    { float* mlg = (float*)(ws + WS_ML + ML_G) + ((size_t)bh * 2048 + t0 + lane) * 2; mlg[0] = bcum; mlg[1] = ip; if (lane == 0) ((float*)(ws + WS_ML + ML_BL))[cu] = bL; }
    const int cc = lane & 7, tg = lane >> 3;
    const bf16_t* raw = (const bf16_t*)(ws + WS_PRJ + PRJ_RAWQK); const float* cw = in->p[11] + (size_t)l * 4 * 512 + h * 64 + 8 * cc;
    u32x4 rq[11];
    const bool head0 = (c == 0 && tg == 0);
#pragma unroll
    for (int i = 0; i < 11; ++i) { const size_t rr = (head0 && i < 3) ? row0 : row0 + 8 * tg - 3 + i; rq[i] = *(const u32x4*)(raw + rr * 512 + h * 64 + 8 * cc); }
    float wt[8];
#pragma unroll
    for (int j = 0; j < 8; ++j) wt[j] = __builtin_bit_cast(float, __builtin_amdgcn_ds_bpermute((8 * tg + j) << 2, __builtin_bit_cast(int, wgt)));
    if (head0) {
#pragma unroll
        for (int i = 0; i < 3; ++i) rq[i] = (u32x4){0u, 0u, 0u, 0u}; }
#define MLD_E(v, e) (((e) & 1) ? bf_hi(((e) >> 1) == 0 ? (v).x : ((e) >> 1) == 1 ? (v).y : ((e) >> 1) == 2 ? (v).z : (v).w) : bf_lo(((e) >> 1) == 0 ? (v).x : ((e) >> 1) == 1 ? (v).y : ((e) >> 1) == 2 ? (v).z : (v).w))
    bf16_t* QC = (bf16_t*)(ws + WS_ML) + ((size_t)bh * 2048 + t0 + 8 * tg) * 64 + 8 * cc; bf16_t* KC = (bf16_t*)(ws + WS_ML + ML_KC) + ((size_t)bh * 2048 + t0 + 8 * tg) * 64 + 8 * cc;
    {
        float w4[4][8];
#pragma unroll
        for (int tp = 0; tp < 4; ++tp) { const f32x4 a = *(const f32x4*)(cw + tp * 512), b4 = *(const f32x4*)(cw + tp * 512 + 4); w4[tp][0] = a.x; w4[tp][1] = a.y; w4[tp][2] = a.z; w4[tp][3] = a.w; w4[tp][4] = b4.x; w4[tp][5] = b4.y; w4[tp][6] = b4.z; w4[tp][7] = b4.w; }
#pragma unroll
        for (int j = 0; j < 8; ++j) { float o[8];
#pragma unroll
            for (int e = 0; e < 8; ++e) o[e] = siluf(w4[0][e] * MLD_E(rq[j], e) + w4[1][e] * MLD_E(rq[j + 1], e) + w4[2][e] * MLD_E(rq[j + 2], e) + w4[3][e] * MLD_E(rq[j + 3], e));
            u32x4 pk; pk.x = pk_bf16(o[0], o[1]); pk.y = pk_bf16(o[2], o[3]); pk.z = pk_bf16(o[4], o[5]); pk.w = pk_bf16(o[6], o[7]);
            *(u32x4*)(QC + (size_t)j * 64) = pk; }
    }
    float dn[8];
    u32x4 rk[11], vv[8];
#pragma unroll
    for (int i = 0; i < 11; ++i) { const size_t rr = (head0 && i < 3) ? row0 : row0 + 8 * tg - 3 + i; rk[i] = *(const u32x4*)(raw + rr * 512 + h * 64 + 8 * cc + 256); }
    { const bf16_t* V = (const bf16_t*)(ws + WS_PRJ + PRJ_VML) + ((size_t)bh * 2048 + t0 + 8 * tg) * 64 + 8 * cc;
#pragma unroll
      for (int j = 0; j < 8; ++j) vv[j] = *(const u32x4*)(V + (size_t)j * 64); }
    if (head0) {
#pragma unroll
        for (int i = 0; i < 3; ++i) rk[i] = (u32x4){0u, 0u, 0u, 0u}; }
    {
        float w4[4][8];
#pragma unroll
        for (int tp = 0; tp < 4; ++tp) { const f32x4 a = *(const f32x4*)(cw + 256 + tp * 512), b4 = *(const f32x4*)(cw + 256 + tp * 512 + 4); w4[tp][0] = a.x; w4[tp][1] = a.y; w4[tp][2] = a.z; w4[tp][3] = a.w; w4[tp][4] = b4.x; w4[tp][5] = b4.y; w4[tp][6] = b4.z; w4[tp][7] = b4.w; }
#pragma unroll
        for (int e = 0; e < 8; ++e) dn[e] = 0.f;
#pragma unroll
        for (int j2 = 0; j2 < 4; ++j2) { float kb[2][8];
#pragma unroll
            for (int jj = 0; jj < 2; ++jj) { const int j = 2 * j2 + jj; float o[8];
#pragma unroll
                for (int e = 0; e < 8; ++e) o[e] = siluf(w4[0][e] * MLD_E(rk[j], e) + w4[1][e] * MLD_E(rk[j + 1], e) + w4[2][e] * MLD_E(rk[j + 2], e) + w4[3][e] * MLD_E(rk[j + 3], e)) * 0.125f;
                u32x4 pk; pk.x = pk_bf16(o[0], o[1]); pk.y = pk_bf16(o[2], o[3]); pk.z = pk_bf16(o[4], o[5]); pk.w = pk_bf16(o[6], o[7]);
                *(u32x4*)(KC + (size_t)j * 64) = pk;
#pragma unroll
                for (int e = 0; e < 8; ++e) { kb[jj][e] = MLD_E(pk, e); dn[e] += wt[j] * kb[jj][e]; } }
#pragma unroll
            for (int e = 0; e < 8; ++e) { *(LAS unsigned*)(wl + swz_off(8 * cc + e, tg) + 4 * j2) = pk_bf16(kb[0][e], kb[1][e]);
                *(LAS unsigned*)(wl + 8192 + swz_off(8 * cc + e, tg) + 4 * j2) = pk_bf16(wt[2 * j2] * MLD_E(vv[2 * j2], e), wt[2 * j2 + 1] * MLD_E(vv[2 * j2 + 1], e)); } }
    }
#undef MLD_E
#pragma unroll
    for (int e = 0; e < 8; ++e) { dn[e] += __shfl_xor(dn[e], 8); dn[e] += __shfl_xor(dn[e], 16); dn[e] += __shfl_xor(dn[e], 32); }
    if (tg == 0) { float* DN = (float*)(ws + WS_ML + ML_DN) + (size_t)cu * 64 + 8 * cc; *(f32x4*)DN = (f32x4){dn[0], dn[1], dn[2], dn[3]}; *(f32x4*)(DN + 4) = (f32x4){dn[4], dn[5], dn[6], dn[7]}; }
    LDS_FENCE();
    const int r = lane & 15, q = lane >> 4;
    bf16_t* DL = (bf16_t*)(ws + WS_ML + ML_DELTA) + (size_t)cu * 4096;
    f32x4 acc[4][4];
#pragma unroll
    for (int mb = 0; mb < 4; ++mb) {
#pragma unroll
        for (int nb = 0; nb < 4; ++nb) acc[mb][nb] = (f32x4){0.f, 0.f, 0.f, 0.f};
#pragma unroll
        for (int ks = 0; ks < 2; ++ks) {
            const bf16x8 a = *(const LAS bf16x8*)(wl + 8192 + swz_off(16 * mb + r, 4 * ks + q));
#pragma unroll
            for (int nb = 0; nb < 4; ++nb) { const bf16x8 bb = *(const LAS bf16x8*)(wl + swz_off(16 * nb + r, 4 * ks + q)); acc[mb][nb] = MFMA16(a, bb, acc[mb][nb]); }
        }
    }
    LDS_FENCE();
#pragma unroll
    for (int mb = 0; mb < 4; ++mb)
#pragma unroll
        for (int nb = 0; nb < 4; ++nb)
#pragma unroll
            for (int j = 0; j < 4; ++j) { const int row = 16 * mb + 4 * q + j, col = 16 * nb + r; *(LAS bf16_t*)(wl + swz_off(row, col >> 3) + (col & 7) * 2) = f2bf(acc[mb][nb][j]); }
    LDS_FENCE();
#pragma unroll
    for (int i = 0; i < 8; ++i) { const int ch = lane + 64 * i; *(u32x4*)(DL + (size_t)ch * 8) = *(const LAS u32x4*)(wl + swz_off(ch >> 3, ch & 7)); }
    LDS_FENCE();
}

#ifndef TIME_PH
#define TIME_PH -1
#endif
#define PSTAMP(i, blk) do { if (TIME_PH != -1 && l == 0 && blockIdx.x == (blk) && TIDX == 0) ((unsigned long long*)((unsigned*)(ws + WS_CTL) + CW_TS))[i] = __builtin_amdgcn_s_memrealtime(); } while (0)
__device__ __forceinline__ void phase_prep(int l, InPtr in, unsigned char* ws, LAS unsigned char* lds, int bid, int nb, int g_wv, unsigned* dq) {
    asm volatile("" : "+s"(bid));
    PSTAMP(40, 0);
#ifndef NO_UQ
    { g8::DenseSched S{(const char*)(ws + WS_PRJ + PRJ_DQKV), (const char*)(ws + WS_WUQ) + (size_t)l * 768 * 256 * 2, 384, 256, 64, 3, nb, bid};
      EpiUq E{(const float*)(ws + WS_SSQ + PT_DQ) + (size_t)l * 16384 * 4, in->p[19] + l * 192, (const float*)(ws + WS_ROPE), (bf16_t*)(ws + WS_MLA)};
      g8::gemm_run(lds, 256, 256, S, E, g_wv); }
#endif
    PSTAMP(41, 0);
#ifndef NO_UKV
    asm volatile("" : "+s"(bid));
    { g8::DenseSched S{(const char*)(ws + WS_PRJ + PRJ_DQKV) + 256, (const char*)(ws + WS_WUKV) + (size_t)l * 768 * 256 * 2, 384, 256, 64, 3, nb, bid};
      EpiUkv E{(const float*)(ws + WS_SSQ + PT_DKV) + (size_t)l * 16384 * 2, in->p[19] + l * 192, (const bf16_t*)(ws + WS_PRJ + PRJ_KR), (bf16_t*)(ws + WS_MLA + MLA_KM), (bf16_t*)(ws + WS_MLA + MLA_VM)};
      g8::gemm_run(lds, 256, 256, S, E, g_wv); }
#endif
    PSTAMP(42, 0); PSTAMP(44, 255);
    __syncthreads();
#ifndef NO_CMP
    for (int u = nb - 1 - bid; u < 32; u += nb) cmp_unit(u, l, in, ws, lds, g_wv);
#endif
    PSTAMP(45, 255);
    __syncthreads();
#ifndef NO_DELTA
    { int tid_ = TIDX; asm volatile("" : "+v"(tid_)); LAS int* slot = (LAS int*)(lds + LDS_MISC + 64);
      for (;;) {
          __syncthreads();
          if (tid_ == 0) *slot = (int)__hip_atomic_fetch_add(dq, 1u, __ATOMIC_RELAXED, __HIP_MEMORY_SCOPE_AGENT);
          __syncthreads();
          const int g = *slot; if (g >= 128) break;
          ml_delta_wave(g * 8 + (tid_ >> 6), l, in, ws, lds + (tid_ >> 6) * 16384, tid_ & 63);
      } }
#endif
    __syncthreads(); PSTAMP(43, 0);
}
#define CHK_TOL(st) (((st) & 15) == 8 ? 1e-2f : 1e-3f)
#define CHECK_REST
constexpr int VTP = 192;
typedef short v4i16_t __attribute__((ext_vector_type(4)));
__device__ __forceinline__ int vt_lane_off(int lane) { return (4 * (lane >> 5) + ((lane & 15) >> 2)) * VTP + ((((lane >> 4) & 1) * 16) + 4 * (lane & 3)) * 2; }
__device__ __forceinline__ bf16x8 vt_frag(const LAS unsigned char* Vt, int voff, int s4, int eb) {
    const LAS unsigned char* a = Vt + voff + 16 * s4 * VTP + 64 * eb;
    const v4i16_t lo = __builtin_amdgcn_ds_read_tr16_b64_v4i16((LAS v4i16_t*)a), hi = __builtin_amdgcn_ds_read_tr16_b64_v4i16((LAS v4i16_t*)(a + 8 * VTP));
    return (bf16x8){lo[0], lo[1], lo[2], lo[3], hi[0], hi[1], hi[2], hi[3]};
}
__device__ __forceinline__ int crow(int reg, int h) { return (reg & 3) + 8 * (reg >> 2) + 4 * h; }
struct AttnState { f32x16 o[2]; float m, l; };
__device__ __forceinline__ void attn_reset(AttnState& A) { A.m = -1e30f; A.l = 0.f;
#pragma unroll
    for (int i = 0; i < 16; ++i) { A.o[0][i] = 0.f; A.o[1][i] = 0.f; } }

template <int DK>
__device__ __forceinline__ void attn_scores(f32x16 (&s)[2], const bf16x8 (&qf)[DK / 16], const LAS unsigned char* Kt, int r, int h) {
    constexpr int KP = 2 * DK + 16, NK = DK / 16;
    bf16x8 kf[2][NK];
#pragma unroll
    for (int kb = 0; kb < 2; ++kb)
#pragma unroll
        for (int ks = 0; ks < NK; ++ks) kf[kb][ks] = *(const LAS bf16x8*)(Kt + (32 * kb + r) * KP + (16 * ks + 8 * h) * 2);
    __builtin_amdgcn_sched_barrier(0);
#pragma unroll
    for (int kb = 0; kb < 2; ++kb) {
#pragma unroll
        for (int i = 0; i < 16; ++i) s[kb][i] = 0.f;
#pragma unroll
        for (int ks = 0; ks < NK; ++ks) s[kb] = MFMA32(kf[kb][ks], qf[ks], s[kb]);
    }
}
__device__ __forceinline__ float max3f(float a, float b, float c) { return fmaxf(fmaxf(a, b), c); }
__device__ __forceinline__ void attn_softmax_pv(AttnState& A, f32x16 (&s)[2], const LAS unsigned char* Vt, int r, int h, float bias_c = 0.f, bool lane_ok = true) {
    constexpr float THR = 8.f; const int voff = vt_lane_off(r + 32 * h);
    float mx = max3f(s[0][0], s[0][1], s[0][2]);
#pragma unroll
    for (int i = 3; i < 15; i += 2) mx = max3f(mx, s[0][i], s[0][i + 1]);
    mx = max3f(mx, s[0][15], s[1][0]);
#pragma unroll
    for (int i = 1; i < 15; i += 2) mx = max3f(mx, s[1][i], s[1][i + 1]);
    mx = fmaxf(mx, s[1][15]);
    mx = fmaxf(mx, __shfl_xor(mx, 32));
    const float mxb = (lane_ok && mx > -1e29f) ? mx + bias_c : -1e30f;
    const bool grow = mxb > A.m + THR;
    const float mnew = grow ? mxb : A.m;
    if (__any(grow)) {
        const float alpha = __builtin_amdgcn_exp2f(A.m - mnew);
        A.l *= alpha;
#pragma unroll
        for (int i = 0; i < 16; ++i) { A.o[0][i] *= alpha; A.o[1][i] *= alpha; }
    }
    A.m = mnew;
    const float sub = (lane_ok && mnew > -1e29f) ? mnew - bias_c : 1e30f;
    float rs = 0.f;
#pragma unroll
    for (int kb = 0; kb < 2; ++kb)
#pragma unroll
        for (int i = 0; i < 16; ++i) { const float p = __builtin_amdgcn_exp2f(s[kb][i] - sub); s[kb][i] = p; rs += p; }
    rs += __shfl_xor(rs, 32);
    A.l += rs;
    bf16x8 vf[4][2];
#pragma unroll
    for (int s4 = 0; s4 < 4; ++s4)
#pragma unroll
        for (int eb = 0; eb < 2; ++eb) vf[s4][eb] = vt_frag(Vt, voff, s4, eb);
    __builtin_amdgcn_sched_barrier(0);
#pragma unroll
    for (int s4 = 0; s4 < 4; ++s4) {
        const int kb = s4 >> 1, hf = (s4 & 1) * 8;
        u32x4 pw; pw.x = pk_bf16(s[kb][hf + 0], s[kb][hf + 1]); pw.y = pk_bf16(s[kb][hf + 2], s[kb][hf + 3]); pw.z = pk_bf16(s[kb][hf + 4], s[kb][hf + 5]); pw.w = pk_bf16(s[kb][hf + 6], s[kb][hf + 7]);
        const bf16x8 pf = __builtin_bit_cast(bf16x8, pw);
#pragma unroll
        for (int eb = 0; eb < 2; ++eb) A.o[eb] = MFMA32(vf[s4][eb], pf, A.o[eb]);
    }
}
template <int DK>
__device__ __forceinline__ void stage_k_load(u32x4 (&kr)[2], const bf16_t* Kg  , int tid) {
    constexpr int CH = DK / 8;
    kr[0] = *(const u32x4*)(Kg + (size_t)(tid / CH) * DK + (tid % CH) * 8);
    if (64 * CH > 512) { const int c2 = tid + 512; if (c2 < 64 * CH) kr[1] = *(const u32x4*)(Kg + (size_t)(c2 / CH) * DK + (c2 % CH) * 8); }
}
template <int DK>
__device__ __forceinline__ void stage_k_store(const u32x4 (&kr)[2], LAS unsigned char* Kt, int tid) {
    constexpr int CH = DK / 8, KP = 2 * DK + 16;
    *(LAS u32x4*)(Kt + (tid / CH) * KP + (tid % CH) * 16) = kr[0];
    if (64 * CH > 512) { const int c2 = tid + 512; if (c2 < 64 * CH) *(LAS u32x4*)(Kt + (c2 / CH) * KP + (c2 % CH) * 16) = kr[1]; }
}
__device__ __forceinline__ u32x4 stage_v_load(const bf16_t* Vg, int tid) { return *(const u32x4*)(Vg + (size_t)(tid >> 3) * 64 + (tid & 7) * 8); }
__device__ __forceinline__ void stage_v_store(const u32x4& v, LAS unsigned char* Vt, int tid) { *(LAS u32x4*)(Vt + (tid >> 3) * VTP + (tid & 7) * 16) = v; }

constexpr int MLA_KT = 0, MLA_VT = 2 * 64 * 208, MLA_LDS = MLA_VT + 2 * 64 * VTP;
__device__ __forceinline__ void mla_unit(int b, int hd, int qt, int l, unsigned char* ws, LAS unsigned char* lds, int g_wv) {
    int tid_ = TIDX; asm volatile("" : "+v"(tid_));
    const int tid = tid_, w = tid >> 6, lane = tid & 63, r = lane & 31, h = lane >> 5;
    const size_t slab = (size_t)(b * 6 + hd) * 2048;
    const bf16_t* QM = (const bf16_t*)(ws + WS_MLA) + slab * 96; const bf16_t* KM = (const bf16_t*)(ws + WS_MLA + MLA_KM) + slab * 96; const bf16_t* VM = (const bf16_t*)(ws + WS_MLA + MLA_VM) + slab * 64;
    const int q0 = 256 * qt + 32 * w, q = q0 + r;
    bf16x8 qf[6];
#pragma unroll
    for (int ks = 0; ks < 6; ++ks) qf[ks] = *(const bf16x8*)(QM + (size_t)q * 96 + 16 * ks + 8 * h);
    AttnState A; attn_reset(A);
    const int ntile = 4 * qt + 4;
    u32x4 kr[2], vr, kr2[2], vr2;
    stage_k_load<96>(kr, KM, tid); vr = stage_v_load(VM, tid);
    stage_k_store<96>(kr, lds + MLA_KT, tid); stage_v_store(vr, lds + MLA_VT, tid);
    if (ntile > 1) { stage_k_load<96>(kr, KM + (size_t)64 * 96, tid); vr = stage_v_load(VM + (size_t)64 * 64, tid); }
    __syncthreads();
    auto tile_step = [&](const int j, u32x4 (&kc)[2], u32x4& vc, u32x4 (&kn)[2], u32x4& vn) __attribute__((always_inline)) {
        const int cur = j & 1;
        if (j + 2 < ntile) { stage_k_load<96>(kn, KM + (size_t)(j + 2) * 64 * 96, tid); vn = stage_v_load(VM + (size_t)(j + 2) * 64 * 64, tid); }
        if (64 * j <= q0 + 31) {
            f32x16 s[2];
            attn_scores<96>(s, qf, lds + MLA_KT + cur * 64 * 208, r, h);
            if (64 * j + 63 > q0) {
#pragma unroll
                for (int kb = 0; kb < 2; ++kb)
#pragma unroll
                    for (int i = 0; i < 16; ++i) { const int key = 64 * j + 32 * kb + crow(i, h); if (key > q) s[kb][i] = -1e30f; }
            }
            attn_softmax_pv(A, s, lds + MLA_VT + cur * 64 * VTP, r, h);
        }
        if (j + 1 < ntile) { stage_k_store<96>(kc, lds + MLA_KT + (cur ^ 1) * 64 * 208, tid); stage_v_store(vc, lds + MLA_VT + (cur ^ 1) * 64 * VTP, tid); }
        __syncthreads();
    };
#pragma unroll 1
    for (int j = 0; j < ntile; j += 2) { tile_step(j, kr, vr, kr2, vr2); tile_step(j + 1, kr2, vr2, kr, vr); }
    const float inv = A.l > 0.f ? 1.f / A.l : 0.f; float ss = 0.f;
    bf16_t* Y = (bf16_t*)(ws + WS_Y) + ((size_t)b * 2048 + q) * 1024 + 384 + hd * 64;
#pragma unroll
    for (int eb = 0; eb < 2; ++eb)
#pragma unroll
        for (int g4 = 0; g4 < 4; ++g4) {
            const float v0 = A.o[eb][4 * g4] * inv, v1 = A.o[eb][4 * g4 + 1] * inv, v2 = A.o[eb][4 * g4 + 2] * inv, v3 = A.o[eb][4 * g4 + 3] * inv;
            u32x2 pw; pw.x = pk_bf16(v0, v1); pw.y = pk_bf16(v2, v3);
            const float f0 = bf_lo(pw.x), f1 = bf_hi(pw.x), f2 = bf_lo(pw.y), f3 = bf_hi(pw.y); ss += (f0 * f0 + f1 * f1) + (f2 * f2 + f3 * f3);
            *(u32x2*)(Y + 32 * eb + 8 * g4 + 4 * h) = pw;
        }
    ss += __shfl_xor(ss, 32);
    if (h == 0) ((float*)(ws + WS_SSQ + PT_C))[((size_t)l * 16384 + (size_t)b * 2048 + q) * 8 + hd] = ss;
}

__device__ __forceinline__ void nsa_bias32(float (&bv)[2][16], const LAS float* bl, int dd) {
#pragma unroll
    for (int kb = 0; kb < 2; ++kb)
#pragma unroll
        for (int k = 0; k < 16; ++k) { const int c = 63 - (32 * kb + (k & 3) + 8 * (k >> 2)); int d = dd + c; d = d < 0 ? 0 : (d > 255 ? 255 : d); bv[kb][k] = bl[d]; }
}
__device__ __forceinline__ void nsa_mask_bias(f32x16 (&sc)[2], int dq, int h, const LAS float* bl, bool sel, int lim) {
    int dd = dq - 4 * h - 63; asm volatile("" : "+v"(dd));
    float bv[2][16]; nsa_bias32(bv, bl, dd);
#pragma unroll
    for (int kb = 0; kb < 2; ++kb)
#pragma unroll
        for (int k = 0; k < 16; ++k) { const int c = 63 - (32 * kb + (k & 3) + 8 * (k >> 2)); const int d = dd + c; sc[kb][k] = (sel && d >= 0 && d < lim) ? sc[kb][k] + bv[kb][k] : -1e30f; }
}

constexpr int NSA_KT = 0, NSA_VT = 2 * 64 * 144, NSA_BIAS = NSA_VT + 2 * 64 * VTP, NSA_PS = NSA_BIAS + 3 * 256 * 4, NSA_SEL = NSA_PS + 3 * 64 * 32 * 4, NSA_UNI = NSA_SEL + 256, NSA_OT = NSA_UNI + 256, NSA_LDS = NSA_OT + 6 * 8192;
__device__ __forceinline__ void nsa_unit(int b, int hk, int i, int l, InPtr in, unsigned char* ws, LAS unsigned char* lds, int g_wv) {
    int tid_ = TIDX; asm volatile("" : "+v"(tid_));
    const int tid = tid_, w = tid >> 6, lane = tid & 63, r = lane & 31, h = lane >> 5;
    const bool active = w < 6; const int g = active ? (w >> 1) : 0, th = w & 1, head = hk * 3 + g;
    const int t = 64 * i + 32 * th + r, tl = 32 * th + r; const size_t row = (size_t)b * 2048 + t;
    const size_t kvslab = (size_t)(b * 2 + hk) * 2048 * 64;
    LAS float* biasl = (LAS float*)(lds + NSA_BIAS); LAS float* PS = (LAS float*)(lds + NSA_PS); LAS unsigned* SEL = (LAS unsigned*)(lds + NSA_SEL); LAS unsigned* UNI = (LAS unsigned*)(lds + NSA_UNI);
    { const float* bd = (const float*)(ws + WS_BIASD) + (size_t)hk * 3 * 2048;
      if (tid < 384) { const int gg = tid >> 7, d0 = (tid & 127) * 2; biasl[gg * 256 + d0] = bd[gg * 2048 + d0]; biasl[gg * 256 + d0 + 1] = bd[gg * 2048 + d0 + 1]; }
#pragma unroll
      for (int k = 0; k < 12; ++k) if (i >= 16) PS[tid + 512 * k] = 0.f;
      if (tid < 4) UNI[tid] = 0u; }
    bf16x8 qf[4];
    { const bf16_t* QN = (const bf16_t*)(ws + WS_PRJ + PRJ_QN) + ((size_t)(b * 6 + head) * 2048 + t) * 64;
#pragma unroll
      for (int ks = 0; ks < 4; ++ks) qf[ks] = *(const bf16x8*)(QN + 16 * ks + 8 * h); }
#define NSA_GATE(k) ({ int t_ = t; asm volatile("" : "+v"(t_)); sigmf(((const float*)(ws + WS_PRJ + PRJ_GATES))[((size_t)b * 2048 + t_) * 32 + head * 3 + (k)]); })
    LAS float* bl = biasl + g * 256;
    LAS float* otl = (LAS float*)(lds + NSA_OT + (active ? w : 0) * 8192) + lane;
    u32x4 kr[2], vr;
    const int ntc = i >= 16 ? 2 : 1;
    { const bf16_t* KC = (const bf16_t*)(ws + WS_CMP) + (size_t)(b * 2 + hk) * 128 * 64; const bf16_t* VC = (const bf16_t*)(ws + WS_CMP + CMP_V) + (size_t)(b * 2 + hk) * 128 * 64;
      for (int T = 0; T < ntc; ++T) { stage_k_load<64>(kr, KC + T * 4096, tid); vr = stage_v_load(VC + T * 4096, tid); stage_k_store<64>(kr, lds + NSA_KT + T * 64 * 144, tid); stage_v_store(vr, lds + NSA_VT + T * 64 * VTP, tid); } }
    __syncthreads();
    {
        f32x16 ot[2];
        if (active && i < 16) {
            AttnState A; attn_reset(A); f32x16 sc[2]; attn_scores<64>(sc, qf, lds + NSA_KT, r, h);
            float bvc[2][16];
#pragma unroll
            for (int kb = 0; kb < 2; ++kb)
#pragma unroll
                for (int k = 0; k < 16; ++k) { int d = t - 16 * (32 * kb + crow(k, h)) - 31; d = d < 0 ? 0 : (d > 255 ? 255 : d); bvc[kb][k] = bl[d]; }
#pragma unroll
            for (int kb = 0; kb < 2; ++kb)
#pragma unroll
                for (int k = 0; k < 16; ++k) { const int d = t - 16 * (32 * kb + crow(k, h)) - 31; sc[kb][k] = d >= 0 ? sc[kb][k] + bvc[kb][k] : -1e30f; }
            attn_softmax_pv(A, sc, lds + NSA_VT, r, h);
            const float gc = NSA_GATE(0); const float inv = A.l > 0.f ? gc / A.l : 0.f;
#pragma unroll
            for (int k = 0; k < 16; ++k) { otl[64 * k] = A.o[0][k] * inv; otl[64 * (16 + k)] = A.o[1][k] * inv; }
        } else if (active) {
            float m = -1e30f, lsum = 0.f;
            for (int T = 0; T < ntc; ++T) {
                f32x16 sc[2]; attn_scores<64>(sc, qf, lds + NSA_KT + T * 64 * 144, r, h);
                float bvc[2][16];
#pragma unroll
                for (int kb = 0; kb < 2; ++kb)
#pragma unroll
                    for (int k = 0; k < 16; ++k) { int d = t - 16 * (64 * T + 32 * kb + crow(k, h)) - 31; d = d < 0 ? 0 : (d > 255 ? 255 : d); bvc[kb][k] = bl[d]; }
                float mx = -1e30f;
#pragma unroll
                for (int kb = 0; kb < 2; ++kb)
#pragma unroll
                    for (int k = 0; k < 16; ++k) { const int n = 64 * T + 32 * kb + crow(k, h); const int d = t - 16 * n - 31; const float x = (d >= 0 && n < 127) ? sc[kb][k] + bvc[kb][k] : -1e30f; sc[kb][k] = x; mx = fmaxf(mx, x); }
                mx = fmaxf(mx, __shfl_xor(mx, 32));
                const float mnew = fmaxf(m, mx), mref = mnew <= -1e29f ? 0.f : mnew; float rs = 0.f;
#pragma unroll
                for (int kb = 0; kb < 2; ++kb)
#pragma unroll
                    for (int k = 0; k < 16; ++k) rs += __builtin_amdgcn_exp2f(sc[kb][k] - mref);
                rs += __shfl_xor(rs, 32);
                lsum = lsum * __builtin_amdgcn_exp2f(m - mref) + rs; m = mnew;
            }
            const float mref = m <= -1e29f ? 0.f : m, inv = lsum > 0.f ? 1.f / lsum : 0.f;
#pragma unroll
            for (int k = 0; k < 16; ++k) { ot[0][k] = 0.f; ot[1][k] = 0.f; }
            float carry = 0.f;
            for (int T = 0; T < ntc; ++T) {
                f32x16 sc[2]; attn_scores<64>(sc, qf, lds + NSA_KT + T * 64 * 144, r, h);
                float bvc[2][16];
#pragma unroll
                for (int kb = 0; kb < 2; ++kb)
#pragma unroll
                    for (int k = 0; k < 16; ++k) { int d = t - 16 * (64 * T + 32 * kb + crow(k, h)) - 31; d = d < 0 ? 0 : (d > 255 ? 255 : d); bvc[kb][k] = bl[d]; }
#pragma unroll
                for (int kb = 0; kb < 2; ++kb)
#pragma unroll
                    for (int k = 0; k < 16; ++k) { const int n = 64 * T + 32 * kb + crow(k, h); const int d = t - 16 * n - 31; sc[kb][k] = (d >= 0 && n < 127) ? __builtin_amdgcn_exp2f(sc[kb][k] + bvc[kb][k] - mref) * inv : 0.f; }
                float prevL = carry;
#pragma unroll
                for (int kb = 0; kb < 2; ++kb)
#pragma unroll
                    for (int g4 = 0; g4 < 4; ++g4) {
                        const float G4 = (sc[kb][4 * g4] + sc[kb][4 * g4 + 1]) + (sc[kb][4 * g4 + 2] + sc[kb][4 * g4 + 3]); const float L = sc[kb][4 * g4 + 3];
                        const float Lo = __shfl_xor(L, 32);
                        const float add = h ? Lo : prevL;
                        prevL = Lo;
                        const int idx = T * 8 + kb * 4 + g4;
                        PS[g * 2048 + tl * 32 + 2 * idx + h] = G4 + add;
                    }
                carry = prevL;
#pragma unroll
                for (int s4 = 0; s4 < 4; ++s4) {
                    const int kb = s4 >> 1, hf = (s4 & 1) * 8;
                    u32x4 pw; pw.x = pk_bf16(sc[kb][hf + 0], sc[kb][hf + 1]); pw.y = pk_bf16(sc[kb][hf + 2], sc[kb][hf + 3]); pw.z = pk_bf16(sc[kb][hf + 4], sc[kb][hf + 5]); pw.w = pk_bf16(sc[kb][hf + 6], sc[kb][hf + 7]);
                    const bf16x8 pf = __builtin_bit_cast(bf16x8, pw);
#pragma unroll
                    for (int eb = 0; eb < 2; ++eb) ot[eb] = MFMA32(vt_frag(lds + NSA_VT + T * 64 * VTP, vt_lane_off(lane), s4, eb), pf, ot[eb]);
                }
            }
            { const float gc = NSA_GATE(0);
#pragma unroll
            for (int k = 0; k < 16; ++k) { otl[64 * k] = ot[0][k] * gc; otl[64 * (16 + k)] = ot[1][k] * gc; } }
        }
    }
    __syncthreads();
#ifndef NO_NSA_SEL
    if (i < 16) { if (tid < 64) SEL[tid] = (2u << i) - 1u; if (tid < 3) UNI[tid] = (2u << i) - 1u; }
    else {
        const int tk = tid >> 3, sg = tid & 7; float v[32];
#pragma unroll
        for (int k = 0; k < 8; ++k) { const f32x4 x0 = *(const LAS f32x4*)(PS + tk * 32 + 4 * k), x1 = *(const LAS f32x4*)(PS + 2048 + tk * 32 + 4 * k), x2 = *(const LAS f32x4*)(PS + 4096 + tk * 32 + 4 * k);
            v[4 * k] = (x0.x + x1.x) + x2.x; v[4 * k + 1] = (x0.y + x1.y) + x2.y; v[4 * k + 2] = (x0.z + x1.z) + x2.z; v[4 * k + 3] = (x0.w + x1.w) + x2.w; }
#pragma unroll
        for (int s = 0; s < 32; ++s) { const bool forced = (s == 0) || (s == i) || (s == i - 1); float x = forced ? v[s] + 1e4f : v[s]; v[s] = s > i ? -1.f : x; }
        unsigned bits = 0u;
#pragma unroll
        for (int k = 0; k < 4; ++k) {
            float x = 0.f;
#pragma unroll
            for (int s = 0; s < 32; ++s) x = (s == 4 * sg + k) ? v[s] : x;
            int rank = 0;
#pragma unroll
            for (int s = 0; s < 32; ++s) rank += (v[s] > x || (v[s] == x && s < 4 * sg + k)) ? 1 : 0;
            if (rank < 16 && x >= 0.f) bits |= 1u << (4 * sg + k);
        }
        bits |= __shfl_xor(bits, 1); bits |= __shfl_xor(bits, 2); bits |= __shfl_xor(bits, 4);
        if (sg == 0) { SEL[tk] = bits; __hip_atomic_fetch_or(UNI, bits, __ATOMIC_RELAXED, __HIP_MEMORY_SCOPE_WORKGROUP); __hip_atomic_fetch_or(UNI + 1 + (tk >> 5), bits, __ATOMIC_RELAXED, __HIP_MEMORY_SCOPE_WORKGROUP); }
    }
#endif
    __syncthreads();
    const unsigned selbits = SEL[tl], uni = UNI[0], unih = UNI[1 + th];
    const float c31 = bl[255];
#ifndef NO_NSA_SLC
#ifndef NSA_DUP_SLC
#define NSA_DUP_SLC 1
#endif
    for (int rp_ = 0; rp_ < NSA_DUP_SLC; ++rp_) {
        AttnState A; attn_reset(A);
        const bf16_t* KS = (const bf16_t*)(ws + WS_PRJ + PRJ_KN1) + kvslab; const bf16_t* VS = (const bf16_t*)(ws + WS_PRJ + PRJ_VN1) + kvslab;
        unsigned todo = uni; int cur = 0; u32x4 kr2[2], vr2;
        int s = __ffs(todo) - 1; todo &= todo - 1;
        stage_k_load<64>(kr, KS + (size_t)s * 4096, tid); vr = stage_v_load(VS + (size_t)s * 4096, tid);
        stage_k_store<64>(kr, lds + NSA_KT, tid); stage_v_store(vr, lds + NSA_VT, tid);
        int sn = todo ? __ffs(todo) - 1 : -1; todo &= todo - 1;
        if (sn >= 0) { stage_k_load<64>(kr, KS + (size_t)sn * 4096, tid); vr = stage_v_load(VS + (size_t)sn * 4096, tid); }
        __syncthreads();
        while (s >= 0) {
            const int sn2 = todo ? __ffs(todo) - 1 : -1; todo &= todo - 1;
            if (sn2 >= 0) { stage_k_load<64>(kr2, KS + (size_t)sn2 * 4096, tid); vr2 = stage_v_load(VS + (size_t)sn2 * 4096, tid); }
            if (active && ((unih >> s) & 1u)) {
                f32x16 sc[2];
                attn_scores<64>(sc, qf, lds + NSA_KT + cur * 64 * 144, r, h);
                const bool sel = (selbits >> s) & 1u;
                if (i - s >= 3) attn_softmax_pv(A, sc, lds + NSA_VT + cur * 64 * VTP, r, h, c31, sel);
                else { nsa_mask_bias(sc, t - 64 * s, h, bl, sel, 4096); attn_softmax_pv(A, sc, lds + NSA_VT + cur * 64 * VTP, r, h); }
            }
            if (sn >= 0) { stage_k_store<64>(kr, lds + NSA_KT + (cur ^ 1) * 64 * 144, tid); stage_v_store(vr, lds + NSA_VT + (cur ^ 1) * 64 * VTP, tid); }
            kr[0] = kr2[0]; vr = vr2;
            __syncthreads();
            s = sn; sn = sn2; cur ^= 1;
        }
        if (active && rp_ == NSA_DUP_SLC - 1) { const float gs = NSA_GATE(1); const float inv = A.l > 0.f ? gs / A.l : 0.f;
#pragma unroll
            for (int k = 0; k < 16; ++k) { otl[64 * k] += A.o[0][k] * inv; otl[64 * (16 + k)] += A.o[1][k] * inv; } }
    }
#endif
#ifndef NO_NSA_WIN
#ifndef NSA_DUP_WIN
#define NSA_DUP_WIN 1
#endif
    for (int rq_ = 0; rq_ < NSA_DUP_WIN; ++rq_) {
        AttnState A; attn_reset(A);
        const bf16_t* KW = (const bf16_t*)(ws + WS_PRJ + PRJ_KN2) + kvslab; const bf16_t* VW = (const bf16_t*)(ws + WS_PRJ + PRJ_VN2) + kvslab;
        const int j0 = i > 8 ? i - 8 : 0; int cur = 0; u32x4 kr2[2], vr2;
        stage_k_load<64>(kr, KW + (size_t)j0 * 4096, tid); vr = stage_v_load(VW + (size_t)j0 * 4096, tid);
        stage_k_store<64>(kr, lds + NSA_KT, tid); stage_v_store(vr, lds + NSA_VT, tid);
        if (j0 < i) { stage_k_load<64>(kr, KW + (size_t)(j0 + 1) * 4096, tid); vr = stage_v_load(VW + (size_t)(j0 + 1) * 4096, tid); }
        __syncthreads();
        for (int j = j0; j <= i; ++j) {
            if (j + 2 <= i) { stage_k_load<64>(kr2, KW + (size_t)(j + 2) * 4096, tid); vr2 = stage_v_load(VW + (size_t)(j + 2) * 4096, tid); }
            if (active) {
                f32x16 sc[2];
                attn_scores<64>(sc, qf, lds + NSA_KT + cur * 64 * 144, r, h);
                if (i - j >= 3 && j > i - 8) attn_softmax_pv(A, sc, lds + NSA_VT + cur * 64 * VTP, r, h, c31, true);
                else { nsa_mask_bias(sc, t - 64 * j, h, bl, true, 512); attn_softmax_pv(A, sc, lds + NSA_VT + cur * 64 * VTP, r, h); }
            }
            if (j < i) { stage_k_store<64>(kr, lds + NSA_KT + (cur ^ 1) * 64 * 144, tid); stage_v_store(vr, lds + NSA_VT + (cur ^ 1) * 64 * VTP, tid); }
            kr[0] = kr2[0]; vr = vr2;
            __syncthreads();
            cur ^= 1;
        }
        if (active && rq_ == NSA_DUP_WIN - 1) { const float gw = NSA_GATE(2); const float inv = A.l > 0.f ? gw / A.l : 0.f;
            float ss = 0.f; bf16_t* Y = (bf16_t*)(ws + WS_Y) + row * 1024 + head * 64;
#pragma unroll
            for (int eb = 0; eb < 2; ++eb)
#pragma unroll
                for (int g4 = 0; g4 < 4; ++g4) {
                    const float v0 = otl[64 * (16 * eb + 4 * g4)] + A.o[eb][4 * g4] * inv, v1 = otl[64 * (16 * eb + 4 * g4 + 1)] + A.o[eb][4 * g4 + 1] * inv;
                    const float v2 = otl[64 * (16 * eb + 4 * g4 + 2)] + A.o[eb][4 * g4 + 2] * inv, v3 = otl[64 * (16 * eb + 4 * g4 + 3)] + A.o[eb][4 * g4 + 3] * inv;
                    u32x2 pw; pw.x = pk_bf16(v0, v1); pw.y = pk_bf16(v2, v3);
                    const float f0 = bf_lo(pw.x), f1 = bf_hi(pw.x), f2 = bf_lo(pw.y), f3 = bf_hi(pw.y); ss += (f0 * f0 + f1 * f1) + (f2 * f2 + f3 * f3);
                    *(u32x2*)(Y + 32 * eb + 8 * g4 + 4 * h) = pw;
                }
            ss += __shfl_xor(ss, 32);
            if (h == 0) ((float*)(ws + WS_SSQ + PT_A))[((size_t)l * 16384 + row) * 8 + head] = ss;
        }
    }
#endif
}

__device__ __forceinline__ void ml_out_wave(int cu, int l, InPtr in, unsigned char* ws, LAS unsigned char* wl, LAS unsigned char* npl, int lane) {
    const int c = cu & 31, bh = cu >> 5, hd = bh & 3, b = bh >> 2; const int t0 = c * 64; const int r = lane & 15, q = lane >> 4;
    const bf16_t* QC = (const bf16_t*)(ws + WS_ML) + ((size_t)bh * 2048 + t0) * 64; const bf16_t* KC = (const bf16_t*)(ws + WS_ML + ML_KC) + ((size_t)bh * 2048 + t0) * 64;
    const bf16_t* V = (const bf16_t*)(ws + WS_PRJ + PRJ_VML) + ((size_t)bh * 2048 + t0) * 64;
    const float* mlg = (const float*)(ws + WS_ML + ML_G) + ((size_t)bh * 2048 + t0) * 2;
    const bf16_t* CP = (const bf16_t*)(ws + WS_ML + ML_CP) + (size_t)cu * 4096; const bf16_t* NP = (const bf16_t*)(ws + WS_ML + ML_NP) + (size_t)cu * 64;
    u32x4 vch[8];
#pragma unroll
    for (int i = 0; i < 8; ++i) vch[i] = *(const u32x4*)(V + (size_t)(lane + 64 * i) * 8);
    bf16x8 aq[4][2];
#pragma unroll
    for (int mb = 0; mb < 4; ++mb)
#pragma unroll
        for (int ks = 0; ks < 2; ++ks) aq[mb][ks] = *(const bf16x8*)(QC + (size_t)(16 * mb + r) * 64 + 32 * ks + 8 * q);
    float bj[4][4], den[4][4];
#pragma unroll
    for (int mb = 0; mb < 4; ++mb)
#pragma unroll
        for (int j = 0; j < 4; ++j) bj[mb][j] = mlg[(16 * mb + 4 * q + j) * 2];
    {
        float cs[4];
#pragma unroll
        for (int nb = 0; nb < 4; ++nb) { const float2 gg = *(const float2*)(mlg + (16 * nb + r) * 2); cs[nb] = gg.y - gg.x; }
#pragma unroll
        for (int mb = 0; mb < 4; ++mb) {
            f32x4 accS[4];
#pragma unroll
            for (int nb = 0; nb < 4; ++nb) { accS[nb] = (f32x4){0.f, 0.f, 0.f, 0.f};
#pragma unroll
                for (int ks = 0; ks < 2; ++ks) { const bf16x8 bk = *(const bf16x8*)(KC + (size_t)(16 * nb + r) * 64 + 32 * ks + 8 * q); accS[nb] = MFMA16(aq[mb][ks], bk, accS[nb]); } }
#pragma unroll
            for (int j = 0; j < 4; ++j) {
                const int jj = 16 * mb + 4 * q + j; float rs = 0.f;
#pragma unroll
                for (int nb = 0; nb < 4; ++nb) { const int s = 16 * nb + r; const float p = s <= jj ? accS[nb][j] * __expf(bj[mb][j] + cs[nb]) : 0.f; rs += p;
                    *(LAS bf16_t*)(wl + 8192 + swz_off(jj, s >> 3) + (s & 7) * 2) = f2bf(p); }
                rs += __shfl_xor(rs, 1); rs += __shfl_xor(rs, 2); rs += __shfl_xor(rs, 4); rs += __shfl_xor(rs, 8);
                den[mb][j] = rs;
            }
        }
    }
#pragma unroll
    for (int i = 0; i < 8; ++i) { const int ch = lane + 64 * i, sv = ch >> 3, e0 = (ch & 7) * 8; const unsigned xs[4] = {vch[i].x, vch[i].y, vch[i].z, vch[i].w};
#pragma unroll
        for (int k = 0; k < 4; ++k) { *(LAS bf16_t*)(wl + swz_off(e0 + 2 * k, sv >> 3) + (sv & 7) * 2) = (bf16_t)(xs[k] & 0xffffu); *(LAS bf16_t*)(wl + swz_off(e0 + 2 * k + 1, sv >> 3) + (sv & 7) * 2) = (bf16_t)(xs[k] >> 16); } }
#pragma unroll
    for (int mb = 0; mb < 4; ++mb) { const float e = __expf(mlg[(16 * mb + r) * 2]);
#pragma unroll
        for (int ks = 0; ks < 2; ++ks) { const u32x4 x = __builtin_bit_cast(u32x4, aq[mb][ks]); u32x4 y;
            y.x = pk_bf16(bf_lo(x.x) * e, bf_hi(x.x) * e); y.y = pk_bf16(bf_lo(x.y) * e, bf_hi(x.y) * e); y.z = pk_bf16(bf_lo(x.z) * e, bf_hi(x.z) * e); y.w = pk_bf16(bf_lo(x.w) * e, bf_hi(x.w) * e);
            aq[mb][ks] = __builtin_bit_cast(bf16x8, y); } }
    f32x4 acc[4][4], accn[4];
#pragma unroll
    for (int mb = 0; mb < 4; ++mb) { accn[mb] = (f32x4){0.f, 0.f, 0.f, 0.f};
#pragma unroll
        for (int nb = 0; nb < 4; ++nb) acc[mb][nb] = (f32x4){0.f, 0.f, 0.f, 0.f}; }
#pragma unroll
    for (int ks = 0; ks < 2; ++ks) {
        u32x4 nz = *(const u32x4*)(NP + 32 * ks + 8 * q); if (r != 0) nz = (u32x4){0u, 0u, 0u, 0u};
        const bf16x8 bn = __builtin_bit_cast(bf16x8, nz);
#pragma unroll
        for (int nb = 0; nb < 4; ++nb) { const bf16x8 bb = *(const bf16x8*)(CP + (size_t)(16 * nb + r) * 64 + 32 * ks + 8 * q);
#pragma unroll
            for (int mb = 0; mb < 4; ++mb) acc[mb][nb] = MFMA16(aq[mb][ks], bb, acc[mb][nb]); }
#pragma unroll
        for (int mb = 0; mb < 4; ++mb) accn[mb] = MFMA16(aq[mb][ks], bn, accn[mb]);
    }
    LDS_FENCE();
#pragma unroll
    for (int ks = 0; ks < 2; ++ks) {
        bf16x8 ap[4];
#pragma unroll
        for (int mb = 0; mb < 4; ++mb) ap[mb] = *(const LAS bf16x8*)(wl + 8192 + swz_off(16 * mb + r, 4 * ks + q));
#pragma unroll
        for (int nb = 0; nb < 4; ++nb) { const bf16x8 bv = *(const LAS bf16x8*)(wl + swz_off(16 * nb + r, 4 * ks + q));
#pragma unroll
            for (int mb = 0; mb < 4; ++mb) acc[mb][nb] = MFMA16(ap[mb], bv, acc[mb][nb]); }
    }
    LDS_FENCE();
    const bf16_t* OG = (const bf16_t*)(ws + WS_PRJ + PRJ_OG); u32x4 ogc[8];
#pragma unroll
    for (int i = 0; i < 8; ++i) { const int ch = lane + 64 * i; ogc[i] = *(const u32x4*)(OG + ((size_t)b * 2048 + t0 + (ch >> 3)) * 256 + hd * 64 + (ch & 7) * 8); }
    const float* gain = in->p[14] + l * 256 + hd * 64;
    bf16_t* Y = (bf16_t*)(ws + WS_Y);
    float gn[4];
#pragma unroll
    for (int nb = 0; nb < 4; ++nb) gn[nb] = gain[16 * nb + r];
#pragma unroll
    for (int mb = 0; mb < 4; ++mb)
#pragma unroll
        for (int j = 0; j < 4; ++j) {
            const int jj = 16 * mb + 4 * q + j;
            const float dn = den[mb][j] + __builtin_bit_cast(float, __builtin_amdgcn_ds_bpermute((lane & 48) << 2, __builtin_bit_cast(int, accn[mb][j])));
            const float inv = __builtin_amdgcn_rcpf(fmaxf(fabsf(dn), 1.f)); float hv[4]; float ss = 0.f;
#pragma unroll
            for (int nb = 0; nb < 4; ++nb) { hv[nb] = acc[mb][nb][j] * inv; ss += hv[nb] * hv[nb]; }
            ss += __shfl_xor(ss, 1); ss += __shfl_xor(ss, 2); ss += __shfl_xor(ss, 4); ss += __shfl_xor(ss, 8);
            const float rstd = rsqrtf(ss * (1.f / 64.f) + 1e-6f);
#pragma unroll
            for (int nb = 0; nb < 4; ++nb) { const int e = 16 * nb + r; *(LAS bf16_t*)(wl + 8192 + swz_off(jj, e >> 3) + (e & 7) * 2) = f2bf(hv[nb] * rstd * gn[nb]); }
        }
    LDS_FENCE();
#pragma unroll
    for (int i = 0; i < 8; ++i) { const int ch = lane + 64 * i, row = ch >> 3, e8 = ch & 7;
        const u32x4 hx = *(const LAS u32x4*)(wl + 8192 + swz_off(row, e8)); const u32x4 g = ogc[i]; u32x4 o;
        o.x = pk_bf16(bf_lo(hx.x) * sigmf(bf_lo(g.x)), bf_hi(hx.x) * sigmf(bf_hi(g.x)));
        o.y = pk_bf16(bf_lo(hx.y) * sigmf(bf_lo(g.y)), bf_hi(hx.y) * sigmf(bf_hi(g.y)));
        o.z = pk_bf16(bf_lo(hx.z) * sigmf(bf_lo(g.z)), bf_hi(hx.z) * sigmf(bf_hi(g.z)));
        o.w = pk_bf16(bf_lo(hx.w) * sigmf(bf_lo(g.w)), bf_hi(hx.w) * sigmf(bf_hi(g.w)));
        *(u32x4*)(Y + ((size_t)b * 2048 + t0 + row) * 1024 + 768 + hd * 64 + e8 * 8) = o; }
    LDS_FENCE();
}

__device__ __forceinline__ void ml_scan_unit(int bh, int l, unsigned char* ws, int g_wv) {
    int tid_ = TIDX; asm volatile("" : "+v"(tid_)); const int tid = tid_;
    const bf16_t* DL = (const bf16_t*)(ws + WS_ML + ML_DELTA) + (size_t)bh * 32 * 4096 + tid * 8; bf16_t* CP = (bf16_t*)(ws + WS_ML + ML_CP) + (size_t)bh * 32 * 4096 + tid * 8;
    const float* DN = (const float*)(ws + WS_ML + ML_DN) + (size_t)bh * 32 * 64; bf16_t* NP = (bf16_t*)(ws + WS_ML + ML_NP) + (size_t)bh * 32 * 64; const float* BL = (const float*)(ws + WS_ML + ML_BL) + bh * 32;
    float c[8]; float n = 0.f;
#pragma unroll
    for (int k = 0; k < 8; ++k) c[k] = 0.f;
#pragma unroll 1
    for (int c0 = 0; c0 < 32; c0 += 8) {
        u32x4 d[8]; float dn[8], co[8];
#pragma unroll
        for (int k = 0; k < 8; ++k) { d[k] = *(const u32x4*)(DL + (size_t)(c0 + k) * 4096); dn[k] = tid < 64 ? DN[(c0 + k) * 64 + tid] : 0.f; co[k] = __expf(BL[c0 + k]); }
#pragma unroll
        for (int k = 0; k < 8; ++k) {
            u32x4 o; o.x = pk_bf16(c[0], c[1]); o.y = pk_bf16(c[2], c[3]); o.z = pk_bf16(c[4], c[5]); o.w = pk_bf16(c[6], c[7]);
            *(u32x4*)(CP + (size_t)(c0 + k) * 4096) = o; if (tid < 64) NP[(c0 + k) * 64 + tid] = f2bf(n);
            c[0] = co[k] * c[0] + bf_lo(d[k].x); c[1] = co[k] * c[1] + bf_hi(d[k].x); c[2] = co[k] * c[2] + bf_lo(d[k].y); c[3] = co[k] * c[3] + bf_hi(d[k].y);
            c[4] = co[k] * c[4] + bf_lo(d[k].z); c[5] = co[k] * c[5] + bf_hi(d[k].z); c[6] = co[k] * c[6] + bf_lo(d[k].w); c[7] = co[k] * c[7] + bf_hi(d[k].w);
            n = co[k] * n + dn[k];
        }
    }
    asm volatile("s_waitcnt vmcnt(0)" ::: "memory"); __syncthreads();
    if (tid == 0) { __builtin_amdgcn_fence(__ATOMIC_RELEASE, "agent"); asm volatile("s_waitcnt vmcnt(0)" ::: "memory");
        __hip_atomic_fetch_add((unsigned*)(ws + WS_CTL) + CW_SCAN + 64 * l, 1u, __ATOMIC_RELAXED, __HIP_MEMORY_SCOPE_AGENT); }
}
__device__ __forceinline__ void ml_scan_wait(int l, unsigned char* ws, int g_wv) {
    if (TIDX == 0) { unsigned* p = (unsigned*)(ws + WS_CTL) + CW_SCAN + 64 * l; unsigned sp = 0;
        while (__hip_atomic_load(p, __ATOMIC_RELAXED, __HIP_MEMORY_SCOPE_AGENT) < 32u) { __builtin_amdgcn_s_sleep(2); if (++sp > (1u << 22)) break; }
        __builtin_amdgcn_fence(__ATOMIC_ACQUIRE, "agent"); asm volatile("s_waitcnt vmcnt(0)" ::: "memory"); }
    __syncthreads();
}

#ifndef DUP_NSA
#define DUP_NSA 1
#endif
#ifndef DUP_MLA
#define DUP_MLA 1
#endif
#ifndef DUP_ML
#define DUP_ML 1
#endif
#ifdef NO_MLA
#define MLA_CALL(...) do {} while (0)
#else
#define MLA_CALL(...) do { for (int rp = 0; rp < DUP_MLA; ++rp) { if (rp) __syncthreads(); mla_unit(__VA_ARGS__); } } while (0)
#endif
__device__ __forceinline__ void phase_mix(int l, InPtr in, unsigned char* ws, LAS unsigned char* lds, unsigned* qhead, int g_wv) {
    LAS int* slot = (LAS int*)(lds + LDS_MISC + 64);
    for (;;) {
        __syncthreads();
        if (TIDX == 0) *slot = (int)__hip_atomic_fetch_add(qhead, 1u, __ATOMIC_RELAXED, __HIP_MEMORY_SCOPE_AGENT);
        __syncthreads();
        int u = *slot;
        if (u >= 32 + 512 + 384 + 128) break;
        if (u < 32) { ml_scan_unit(u, l, ws, g_wv); continue; } u -= 32;
#ifndef NO_NSA
        if (u < 256) { const int i = 31 - (u >> 4), bh = u & 15; { for (int rp = 0; rp < DUP_NSA; ++rp) { if (rp) __syncthreads(); nsa_unit(bh >> 1, bh & 1, i, l, in, ws, lds, g_wv); } } continue; }
#endif
        u -= 256;
        if (u < 192) { const int qt = 7 - u / 48, bh = u % 48; MLA_CALL(bh / 6, bh % 6, qt, l, ws, lds, g_wv); continue; }
        u -= 192;
#ifndef NO_NSA
        if (u < 128) { const int i = 15 - (u >> 4), bh = u & 15; { for (int rp = 0; rp < DUP_NSA; ++rp) { if (rp) __syncthreads(); nsa_unit(bh >> 1, bh & 1, i, l, in, ws, lds, g_wv); } } continue; }
#endif
        u -= 128;
        if (u < 192) { const int qt = 3 - u / 48, bh = u % 48; MLA_CALL(bh / 6, bh % 6, qt, l, ws, lds, g_wv); continue; } u -= 192;
#ifndef NO_NSA
        if (u < 128) { const int i = 7 - (u >> 4), bh = u & 15; { for (int rp = 0; rp < DUP_NSA; ++rp) { if (rp) __syncthreads(); nsa_unit(bh >> 1, bh & 1, i, l, in, ws, lds, g_wv); } } continue; }
#endif
        u -= 128;
#ifndef NO_MLOUT
        ml_scan_wait(l, ws, g_wv);
        for (int rp = 0; rp < DUP_ML; ++rp) { int tid_ = TIDX; asm volatile("" : "+v"(tid_)); const int w = tid_ >> 6; ml_out_wave(u * 8 + w, l, in, ws, lds + w * 16384, lds + 131072 + w * 256, tid_ & 63); }
#endif
    }
}
__device__ __forceinline__ void phase_ynorm(int l, unsigned char* ws, int bid, int nb, int g_wv) {
    int tid_ = TIDX; asm volatile("" : "+v"(tid_)); const int w = tid_ >> 6, lane = tid_ & 63;
    bf16_t* Y = (bf16_t*)(ws + WS_Y); const float* sa = (const float*)(ws + WS_SSQ + PT_A) + (size_t)l * 16384 * 8; const float* sc = (const float*)(ws + WS_SSQ + PT_C) + (size_t)l * 16384 * 8;
    for (int r0 = (bid * 8 + w) * 8; r0 < NTOK; r0 += nb * 64) {
        if (lane < 48) {
            u32x4 x[8], y[8]; float ra[8], rc[8];
#pragma unroll
            for (int k = 0; k < 8; ++k) { const int row = r0 + k;
                const f32x4 a0 = *(const f32x4*)(sa + (size_t)row * 8), a1 = *(const f32x4*)(sa + (size_t)row * 8 + 4), c0 = *(const f32x4*)(sc + (size_t)row * 8), c1 = *(const f32x4*)(sc + (size_t)row * 8 + 4);
                ra[k] = rsqrtf((((a0.x + a0.y) + (a0.z + a0.w)) + (a1.x + a1.y)) * (1.f / 384.f) + 1e-6f); rc[k] = rsqrtf((((c0.x + c0.y) + (c0.z + c0.w)) + (c1.x + c1.y)) * (1.f / 384.f) + 1e-6f);
                x[k] = *((const u32x4*)(Y + (size_t)row * 1024) + lane); y[k] = *((const u32x4*)(Y + (size_t)row * 1024 + 384) + lane); }
#pragma unroll
            for (int k = 0; k < 8; ++k) { const int row = r0 + k; u32x4 a = x[k], c = y[k]; const float fa = ra[k], fc = rc[k];
                a.x = pk_bf16(bf_lo(a.x) * fa, bf_hi(a.x) * fa); a.y = pk_bf16(bf_lo(a.y) * fa, bf_hi(a.y) * fa); a.z = pk_bf16(bf_lo(a.z) * fa, bf_hi(a.z) * fa); a.w = pk_bf16(bf_lo(a.w) * fa, bf_hi(a.w) * fa);
                c.x = pk_bf16(bf_lo(c.x) * fc, bf_hi(c.x) * fc); c.y = pk_bf16(bf_lo(c.y) * fc, bf_hi(c.y) * fc); c.z = pk_bf16(bf_lo(c.z) * fc, bf_hi(c.z) * fc); c.w = pk_bf16(bf_lo(c.w) * fc, bf_hi(c.w) * fc);
                *((u32x4*)(Y + (size_t)row * 1024) + lane) = a; *((u32x4*)(Y + (size_t)row * 1024 + 384) + lane) = c; }
        }
    }
}
constexpr int LDS_FAC = 131072 + 2048;
__device__ __forceinline__ void outproj_factors(int l, unsigned char* ws, LAS unsigned char* lds, int pm, int tid) {
    asm volatile("" : "+v"(tid));
    if (tid < 256) { const int row = pm * 256 + tid; const float* sa = (const float*)(ws + WS_SSQ + PT_A) + ((size_t)l * 16384 + row) * 8; const float* sc = (const float*)(ws + WS_SSQ + PT_C) + ((size_t)l * 16384 + row) * 8;
        const f32x4 a0 = *(const f32x4*)sa, a1 = *(const f32x4*)(sa + 4), c0 = *(const f32x4*)sc, c1 = *(const f32x4*)(sc + 4);
        const float ra = rsqrtf((((a0.x + a0.y) + (a0.z + a0.w)) + (a1.x + a1.y)) * (1.f / 384.f) + 1e-6f), rc = rsqrtf((((c0.x + c0.y) + (c0.z + c0.w)) + (c1.x + c1.y)) * (1.f / 384.f) + 1e-6f);
        LAS float* F = (LAS float*)(lds + LDS_FAC); F[2 * tid] = ra / rc; F[2 * tid + 1] = rc; }
    __syncthreads();
}
struct EpiOut {
    static constexpr bool KHOOK = true;
    bf16_t* XB; float* ssq; const LAS float* F; bool fold;
    __device__ __forceinline__ void kscale(f32x4 (&acc)[2][2][4][2], int which, int wr, int fr) const {
        if (!fold) return;
#pragma unroll
        for (int ai = 0; ai < 2; ++ai)
#pragma unroll
            for (int m = 0; m < 4; ++m) { const float f = F[2 * (ai * 128 + wr * 64 + m * 16 + fr) + which];
#pragma unroll
                for (int bj = 0; bj < 2; ++bj)
#pragma unroll
                    for (int n = 0; n < 2; ++n) acc[ai][bj][m][n] = acc[ai][bj][m][n] * f; }
    }
    __device__ __forceinline__ void operator()(const f32x4 (&acc)[2][2][4][2], const GUnit& u, int wr, int wc, int fr, int fq) const {
#pragma unroll
        for (int ai = 0; ai < 2; ++ai)
#pragma unroll
          for (int mh = 0; mh < 2; ++mh) {
            __builtin_amdgcn_sched_barrier(0);
            u32x4 xr[2][2];
#pragma unroll
            for (int m2 = 0; m2 < 2; ++m2)
#pragma unroll
                for (int bj = 0; bj < 2; ++bj) xr[m2][bj] = *(const u32x4*)(XB + (size_t)(u.pm * 256 + ai * 128 + wr * 64 + (2 * mh + m2) * 16 + fr) * 1024 + u.pn * 256 + bj * 128 + wc * 32 + 8 * fq);
#pragma unroll
            for (int m2 = 0; m2 < 2; ++m2) {
                const int m = 2 * mh + m2; const int row = u.pm * 256 + ai * 128 + wr * 64 + m * 16 + fr; float ss = 0.f;
#pragma unroll
                for (int bj = 0; bj < 2; ++bj) {
                    const u32x4 x = xr[m2][bj]; u32x4 o;
                    o.x = pk_bf16(bf_lo(x.x) + acc[ai][bj][m][0][0], bf_hi(x.x) + acc[ai][bj][m][0][1]); o.y = pk_bf16(bf_lo(x.y) + acc[ai][bj][m][0][2], bf_hi(x.y) + acc[ai][bj][m][0][3]);
                    o.z = pk_bf16(bf_lo(x.z) + acc[ai][bj][m][1][0], bf_hi(x.z) + acc[ai][bj][m][1][1]); o.w = pk_bf16(bf_lo(x.w) + acc[ai][bj][m][1][2], bf_hi(x.w) + acc[ai][bj][m][1][3]);
                    *(u32x4*)(XB + (size_t)row * 1024 + u.pn * 256 + bj * 128 + wc * 32 + 8 * fq) = o;
                    ss += (bf_lo(o.x) * bf_lo(o.x) + bf_hi(o.x) * bf_hi(o.x)) + (bf_lo(o.y) * bf_lo(o.y) + bf_hi(o.y) * bf_hi(o.y)) + (bf_lo(o.z) * bf_lo(o.z) + bf_hi(o.z) * bf_hi(o.z)) + (bf_lo(o.w) * bf_lo(o.w) + bf_hi(o.w) * bf_hi(o.w));
                }
                ss = quad_sum(ss); if (fq == 0) ssq[(size_t)row * 16 + u.pn * 4 + wc] = ss;
            }
          }
    }
};

__device__ __forceinline__ float sum16(const float* p) { const f32x4 a = *(const f32x4*)p, b = *(const f32x4*)(p + 4), c = *(const f32x4*)(p + 8), d = *(const f32x4*)(p + 12);
    return (((a.x + a.y) + (a.z + a.w)) + ((b.x + b.y) + (b.z + b.w))) + (((c.x + c.y) + (c.z + c.w)) + ((d.x + d.y) + (d.z + d.w))); }
__device__ __forceinline__ void phase_route(int l, InPtr in, unsigned char* ws, LAS unsigned char* lds, int bid, int nb, int g_wv) {
    int tid_ = TIDX; asm volatile("" : "+v"(tid_)); const int w = tid_ >> 6, lane = tid_ & 63, r = lane & 15, q = lane >> 4;
    const bf16_t* XB = (const bf16_t*)(ws + WS_XB); const bf16_t* WR = (const bf16_t*)(ws + WS_WR) + (size_t)l * 64 * 1024;
    const float* ssq = (const float*)(ws + WS_SSQ + PT_X1) + (size_t)l * 16384 * 16; const float* bg = in->p[24] + l * 4; const float* be = in->p[26] + l * 32;
    unsigned* cnt = (unsigned*)(ws + WS_CTL) + CW_CNT + 2048 * l; unsigned* mtok = (unsigned*)(ws + WS_META); float* mw = (float*)(ws + WS_META + META_W);
    LAS float* lg = (LAS float*)(lds + w * 4096);
    LAS unsigned* lcnt = (LAS unsigned*)(lds + 32768); LAS unsigned* lbase = lcnt + 32;
    for (int g0 = bid * 8; g0 < NTOK / 16; g0 += nb * 8) {
        if (tid_ < 32) lcnt[tid_] = 0u;
        __syncthreads();
        const int tok0 = (g0 + w) * 16; f32x4 acc[3];
#pragma unroll
        for (int n = 0; n < 3; ++n) acc[n] = (f32x4){0.f, 0.f, 0.f, 0.f};
        const bf16_t* ap = XB + (size_t)(tok0 + r) * 1024 + 8 * q; const bf16_t* bp = WR + (size_t)r * 1024 + 8 * q;
#pragma unroll 1
        for (int kc = 0; kc < 4; ++kc) {
            bf16x8 a[8], bb[3][8];
#pragma unroll
            for (int s = 0; s < 8; ++s) { a[s] = *(const bf16x8*)(ap + 32 * (kc * 8 + s));
#pragma unroll
                for (int n = 0; n < 3; ++n) bb[n][s] = *(const bf16x8*)(bp + (size_t)n * 16 * 1024 + 32 * (kc * 8 + s)); }
            __builtin_amdgcn_sched_barrier(0);
#pragma unroll
            for (int s = 0; s < 8; ++s)
#pragma unroll
                for (int n = 0; n < 3; ++n) acc[n] = MFMA16(a[s], bb[n][s], acc[n]);
            __builtin_amdgcn_sched_barrier(0);
        }
#pragma unroll
        for (int n = 0; n < 3; ++n)
#pragma unroll
            for (int j = 0; j < 4; ++j) lg[(4 * q + j) * 48 + 16 * n + r] = acc[n][j];
        LDS_FENCE();
        int E0 = 0, E1 = 0; unsigned r0 = 0, r1 = 0; float wt0 = 0.f, wt1 = 0.f; const int tok = tok0 + (lane & 15);
        if (lane < 16) {
            const float rs = rsqrtf(sum16(ssq + (size_t)tok * 16) * (1.f / 1024.f) + 1e-6f); ((float*)(ws + WS_RS2))[tok] = rs; const LAS float* L = lg + lane * 48;
            float gl[4]; int gi = 0;
#pragma unroll
            for (int j = 0; j < 4; ++j) gl[j] = L[j] * rs + bg[j];
            float gm = gl[0];
#pragma unroll
            for (int j = 1; j < 4; ++j) if (gl[j] > gm) { gm = gl[j]; gi = j; }
            float gsum = 0.f;
#pragma unroll
            for (int j = 0; j < 4; ++j) gsum += __expf(gl[j] - gm);
            const float gtop = 1.f / gsum;
            float el[8];
#pragma unroll
            for (int j = 0; j < 8; ++j) el[j] = L[4 + gi * 8 + j] * rs + be[gi * 8 + j];
            int e0 = 0; float v0 = el[0];
#pragma unroll
            for (int j = 1; j < 8; ++j) if (el[j] > v0) { v0 = el[j]; e0 = j; }
            int e1 = -1; float v1 = -3.0e38f;
#pragma unroll
            for (int j = 0; j < 8; ++j) if (j != e0 && el[j] > v1) { v1 = el[j]; e1 = j; }
            const float w0 = 1.f / (1.f + __expf(v1 - v0)); E0 = gi * 8 + e0; E1 = gi * 8 + e1; wt0 = w0 * gtop; wt1 = (1.f - w0) * gtop;
            r0 = __hip_atomic_fetch_add(lcnt + E0, 1u, __ATOMIC_RELAXED, __HIP_MEMORY_SCOPE_WORKGROUP); r1 = __hip_atomic_fetch_add(lcnt + E1, 1u, __ATOMIC_RELAXED, __HIP_MEMORY_SCOPE_WORKGROUP);
        }
        __syncthreads();
        if (tid_ < 32) { const unsigned c = lcnt[tid_]; lbase[tid_] = c ? atomicAdd(cnt + tid_ * 64, c) : 0u; }
        __syncthreads();
        if (lane < 16) {
            const unsigned p0 = lbase[E0] + r0, p1 = lbase[E1] + r1;
            mtok[(size_t)E0 * 16384 + p0] = (unsigned)tok; mw[(size_t)E0 * 16384 + p0] = wt0;
            mtok[(size_t)E1 * 16384 + p1] = (unsigned)tok | 0x80000000u; mw[(size_t)E1 * 16384 + p1] = wt1;
        }
        __syncthreads();
    }
}

constexpr int LDS_TB = 131072 + 2048;
__device__ __forceinline__ void moe_tables(int l, unsigned char* ws, LAS unsigned char* lds, int g_wv) {
    int tix = TIDX; asm volatile("" : "+v"(tix));
    LAS int* tb = (LAS int*)(lds + LDS_TB);
    if (tix < 32) { const unsigned* cnt = (const unsigned*)(ws + WS_CTL) + CW_CNT + 2048 * l; tb[160 + tix] = (int)__hip_atomic_load(cnt + tix * 64, __ATOMIC_RELAXED, __HIP_MEMORY_SCOPE_AGENT); }
    __syncthreads();
    if (tix == 0) { int a = 0, f = 0, p = 0; for (int e = 0; e < 32; ++e) { const int c = tb[160 + e]; tb[e] = a; tb[48 + e] = f; tb[96 + e] = p; a += (c + 255) >> 8; f += c >> 8; p += (c & 255) ? 1 : 0; } tb[32] = a; tb[80] = f; tb[128] = p; }
    __syncthreads();
}
template <int NPN, bool GATHER_>
struct MoeSched {
    static constexpr bool GATHER = GATHER_, PARTIAL = false;
    const char* A; const char* Bt; const unsigned* cnt; const unsigned* mtok; const LAS int* tb; int G, c; size_t bstride_e  , bstride_pn; int lo, hi;
    __device__ __forceinline__ bool next(int i, GUnit& u) const {
        const int L = lo + i * G + c; if (L >= hi) return false;
        const int tile = L / NPN, pn = L % NPN;
        int e = 0;
        for (int k = 1; k < 32; ++k) e = (tb[k] <= tile) ? k : e;
        e = __builtin_amdgcn_readfirstlane(e);
        u.e = e; u.pm = tile; u.pn = pn; u.rows = tb[160 + e] - 256 * (tile - tb[e]);
        u.a = GATHER ? A : A + (size_t)tile * 256 * 256 * 2;
        u.b = Bt + (size_t)e * bstride_e + (size_t)pn * bstride_pn; return true;
    }
    __device__ __forceinline__ void aoff(const GUnit& u, unsigned (&v)[2][2], const int (&R)[2], const int (&C)[2]) const {
#pragma unroll
        for (int h = 0; h < 2; ++h)
#pragma unroll
            for (int i = 0; i < 2; ++i) {
                if (GATHER) { const int lr = h * 128 + R[i]; const int rr = 256 * (u.pm - tb[u.e]) + (lr < u.rows ? lr : 0); const unsigned tok = mtok[(size_t)u.e * 16384 + rr] & 0x7fffffffu; v[h][i] = (tok * 1024u + (unsigned)C[i]) * 2u; }
                else v[h][i] = (unsigned)((h * 128 + R[i]) * 256 + C[i]) * 2u;
            }
    }
};
struct EpiMoeUp {
    static constexpr bool KHOOK = false;
    const unsigned* mtok; const float* ssq; const LAS int* tb; bf16_t* HB;
    __device__ __forceinline__ void operator()(const f32x4 (&acc)[2][2][4][2], const GUnit& u, int wr, int wc, int fr, int fq) const {
        const int r0 = 256 * (u.pm - tb[u.e]);
        float rs8[8];
        { unsigned tk[8];
#pragma unroll
          for (int k = 0; k < 8; ++k) { const int lr = (k >> 2) * 128 + wr * 64 + (k & 3) * 16 + fr; tk[k] = mtok[(size_t)u.e * 16384 + r0 + (lr < u.rows ? lr : 0)] & 0x7fffffffu; }
#pragma unroll
          for (int k = 0; k < 8; ++k) rs8[k] = ssq[tk[k]]; }
#pragma unroll
        for (int ai = 0; ai < 2; ++ai)
#pragma unroll
            for (int m = 0; m < 4; ++m) {
                __builtin_amdgcn_sched_barrier(0);
                const int lr = ai * 128 + wr * 64 + m * 16 + fr;
                if (lr < u.rows) {
                    const float rs = rs8[ai * 4 + m];
                    float hv[8];
#pragma unroll
                    for (int n = 0; n < 2; ++n)
#pragma unroll
                        for (int j = 0; j < 4; ++j) { const float gv = acc[ai][0][m][n][j] * rs, uv = acc[ai][1][m][n][j] * rs; hv[4 * n + j] = siluf(gv) * uv; }
                    st_bf16x8(HB + ((size_t)u.pm * 256 + lr) * 256 + u.pn * 128 + wc * 32 + 8 * fq, hv);
                }
            }
    }
};
struct EpiMoeDown {
    static constexpr bool KHOOK = false;
    const unsigned* mtok; const float* mw; const LAS int* tb; bf16_t* YB;
    __device__ __forceinline__ void operator()(const f32x4 (&acc)[2][2][4][2], const GUnit& u, int wr, int wc, int fr, int fq) const {
        const int r0 = 256 * (u.pm - tb[u.e]);
        unsigned mt8[8]; float wt8[8];
#pragma unroll
        for (int k = 0; k < 8; ++k) { const int lr = (k >> 2) * 128 + wr * 64 + (k & 3) * 16 + fr; const size_t ix = (size_t)u.e * 16384 + r0 + (lr < u.rows ? lr : 0); mt8[k] = mtok[ix]; wt8[k] = mw[ix]; }
#pragma unroll
        for (int ai = 0; ai < 2; ++ai)
#pragma unroll
            for (int m = 0; m < 4; ++m) {
                __builtin_amdgcn_sched_barrier(0);
                const int lr = ai * 128 + wr * 64 + m * 16 + fr;
                if (lr < u.rows) {
                    const unsigned mt = mt8[ai * 4 + m]; const float wt = wt8[ai * 4 + m];
                    bf16_t* dst = YB + ((size_t)(mt >> 31) * 16384 + (mt & 0x7fffffffu)) * 1024 + u.pn * 256 + wc * 32 + 8 * fq;
#pragma unroll
                    for (int bj = 0; bj < 2; ++bj) { float v[8];
#pragma unroll
                        for (int n = 0; n < 2; ++n)
#pragma unroll
                            for (int j = 0; j < 4; ++j) v[4 * n + j] = acc[ai][bj][m][n][j] * wt;
                        st_bf16x8(dst + bj * 128, v); }
                }
            }
    }
};
__device__ __forceinline__ void phase_combine(int l, unsigned char* ws, float* out, int bid, int nb, int g_wv) {
    int tid_ = TIDX; asm volatile("" : "+v"(tid_)); const int w = tid_ >> 6, lane = tid_ & 63;
    bf16_t* XB = (bf16_t*)(ws + WS_XB); const bf16_t* Y0 = (const bf16_t*)(ws + WS_YBUF); const bf16_t* Y1 = Y0 + (size_t)16384 * 1024; float* ssqx = (float*)(ws + WS_SSQX) + 16384;
    for (int row = bid * 8 + w; row < NTOK; row += nb * 8) {
        float ss = 0.f;
#pragma unroll
        for (int k = 0; k < 2; ++k) {
            const size_t o = (size_t)row * 1024 + (lane + 64 * k) * 8;
            const u32x4 x = *(const u32x4*)(XB + o), a = *(const u32x4*)(Y0 + o), c = *(const u32x4*)(Y1 + o);
            float v[8] = { bf_lo(x.x) + bf_lo(a.x) + bf_lo(c.x), bf_hi(x.x) + bf_hi(a.x) + bf_hi(c.x), bf_lo(x.y) + bf_lo(a.y) + bf_lo(c.y), bf_hi(x.y) + bf_hi(a.y) + bf_hi(c.y),
                           bf_lo(x.z) + bf_lo(a.z) + bf_lo(c.z), bf_hi(x.z) + bf_hi(a.z) + bf_hi(c.z), bf_lo(x.w) + bf_lo(a.w) + bf_lo(c.w), bf_hi(x.w) + bf_hi(a.w) + bf_hi(c.w) };
            if (l == L_ - 1 && out) { *(f32x4*)(out + o) = (f32x4){v[0], v[1], v[2], v[3]}; *(f32x4*)(out + o + 4) = (f32x4){v[4], v[5], v[6], v[7]}; }
            else { u32x4 p; p.x = pk_bf16(v[0], v[1]); p.y = pk_bf16(v[2], v[3]); p.z = pk_bf16(v[4], v[5]); p.w = pk_bf16(v[6], v[7]); *(u32x4*)(XB + o) = p;
#pragma unroll
                   for (int j = 0; j < 4; ++j) { const unsigned q = j == 0 ? p.x : (j == 1 ? p.y : (j == 2 ? p.z : p.w)); ss += bf_lo(q) * bf_lo(q) + bf_hi(q) * bf_hi(q); } }
        }
        if (l < L_ - 1) { ss = wave_sum(ss); if (lane == 0) ssqx[row] = ss; }
    }
}
constexpr int MOE_CVT_SPLIT = 4608;
#ifndef CVT_A
#define CVT_A 2688
#endif
#ifndef NROUTE
#define NROUTE 128
#endif
constexpr int NPH = 9;
enum { PH_INPROJ = 0, PH_PREP, PH_MIX, PH_YNORM, PH_OUTPROJ, PH_ROUTE, PH_MOEUP, PH_MOEDOWN, PH_COMBINE };
struct Args { Inputs in; float* out; unsigned char* ws; int ph_lo, ph_hi; };

__global__ void __launch_bounds__(512, 2) mk(Args args) {
    extern __shared__ __attribute__((aligned(16))) unsigned char lds_raw[];
    LAS unsigned char* lds = (LAS unsigned char*)lds_raw;
    const int g_wv = __builtin_amdgcn_readfirstlane((int)threadIdx.x >> 6);
    const int bid0 = blockIdx.x, nb = gridDim.x;
#define BID() ({ int b_ = bid0; asm volatile("" : "+s"(b_)); b_; })
    unsigned char* ws = args.ws; unsigned* ctl = (unsigned*)(ws + WS_CTL);
    const int lo = args.ph_lo, hi = args.ph_hi;
    if (TIDX < 4) ((LAS unsigned*)(lds + LDS_MISC))[TIDX] = 0u;
    __syncthreads();
    XcdBarrier bar; bar.g_wv = g_wv; bar.bar = ctl + CW_BAR; bar.x = 0; bar.st = nullptr;
    if (hi - lo > 1) bar = xcd_barrier_post(ctl + CW_BAR, (volatile LAS unsigned*)(lds + LDS_MISC), g_wv);
#define IN(k) (lo <= (k) && (k) < hi)
#ifndef REPEAT_PH
#define REPEAT_PH -1
#endif
#define NREP(k) ((REPEAT_PH == (k)) ? 2 : 1)
#ifndef NBAR
#define NBAR 1
#endif
#ifndef TIME_PH
#define TIME_PH -1
#endif
#define STAMP(i) do { if (TIME_PH != -1 && blockIdx.x == 0 && TIDX == 0) ((unsigned long long*)(ctl + CW_TS))[i] = __builtin_amdgcn_s_memrealtime(); } while (0)
#define SEAM(k) do { if (IN(k) && IN((k) + 1)) for (int nb_ = 0; nb_ < NBAR; ++nb_) xcd_barrier(bar); STAMP((k) + 1); } while (0)
    STAMP(0);
#ifndef NO_PRO
    if (IN(0)) for (int rep = 0; rep < NREP(100); ++rep) { prologue(in_tab(), launder(ws), lds, BID(), nb, g_wv); if (rep + 1 < NREP(100)) xcd_barrier(bar); }
#endif
    SEAM(0);
    for (int l = 0; l < L_; ++l) {
        const int pb = 1 + l * NPH;
        if (IN(pb + PH_INPROJ)) for (int rep = 0; rep < NREP(PH_INPROJ); ++rep) {
            if (rep) xcd_barrier(bar);
            InPtr in = in_tab(); unsigned char* ws = launder(args.ws);
            g8::DenseSched S{(const char*)(ws + WS_XB), (const char*)(ws + WS_WIN) + (size_t)l * 2560 * 1024 * 2, 1024, 1024, 64, 10, nb, BID()};
            EpiInProj E{(const float*)(ws + WS_SSQX) + l * 16384, (float*)(ws + WS_SSQ + PT_DQ) + (size_t)l * 16384 * 4, (float*)(ws + WS_SSQ + PT_DKV) + (size_t)l * 16384 * 2,
                        in->p[8] + l * 64, in->p[9] + l * 64, in->p[19] + l * 192 + 96 + 64, (const float*)(ws + WS_ROPE), ws + WS_PRJ};
#ifndef NO_INPROJ
            g8::gemm_run(lds, 1024, 1024, S, E, g_wv);
#endif
        }
        SEAM(pb + PH_INPROJ);
        if (IN(pb + PH_PREP)) for (int rep = 0; rep < NREP(PH_PREP); ++rep) { if (rep) xcd_barrier(bar); phase_prep(l, in_tab(), launder(ws), lds, BID(), nb, g_wv, (unsigned*)launder(ws) + CW_Q + 64 * (4 + l + 2 * rep)); }
        SEAM(pb + PH_PREP);
        if (IN(pb + PH_MIX)) for (int rep = 0; rep < NREP(PH_MIX); ++rep) { if (rep) xcd_barrier(bar); phase_mix(l, in_tab(), launder(ws), lds, (unsigned*)launder(ws) + CW_Q + 64 * (l + 2 * rep), g_wv); }
        SEAM(pb + PH_MIX);
        const bool fold_norm = (nb == 256);
        if (IN(pb + PH_YNORM) && !fold_norm) phase_ynorm(l, launder(ws), BID(), nb, g_wv);
        if (!fold_norm) SEAM(pb + PH_YNORM);
        if (IN(pb + PH_OUTPROJ)) {
            unsigned char* ws = launder(args.ws);
            g8::DenseSched S{(const char*)(ws + WS_Y), (const char*)(ws + WS_WOUT) + (size_t)l * 1024 * 1024 * 2, 1024, 1024, 64, 4, nb, BID()};
            EpiOut E{(bf16_t*)(ws + WS_XB), (float*)(ws + WS_SSQ + PT_X1) + (size_t)l * 16384 * 16, (const LAS float*)(lds + LDS_FAC), fold_norm};
            if (fold_norm) { g8::GUnit u0; if (S.next(0, u0)) outproj_factors(l, ws, lds, u0.pm, TIDX); else __syncthreads(); }
#ifndef NO_OUTPROJ
            g8::gemm_run(lds, 1024, 1024, S, E, g_wv);
#endif
        }
        SEAM(pb + PH_OUTPROJ);
#ifndef NO_ROUTE
        if (IN(pb + PH_ROUTE)) {
            const int b_ = BID();
            if (nb >= 256 && b_ >= NROUTE) { cvt_moe_layer(in_tab(), launder(ws), l, (LAS float*)lds, b_ - NROUTE, nb - NROUTE, TIDX, 0, CVT_A);
#ifdef DUP_CVT
                __syncthreads(); cvt_moe_layer(in_tab(), launder(ws), l, (LAS float*)lds, b_ - NROUTE, nb - NROUTE, TIDX);
#endif
            }
            else { phase_route(l, in_tab(), launder(ws), lds, b_, nb >= 256 ? NROUTE : nb, g_wv);
                   if (nb < 256) cvt_moe_layer(in_tab(), launder(ws), l, (LAS float*)lds, b_, nb, TIDX); else cvt_moe_layer(in_tab(), launder(ws), l, (LAS float*)lds, b_, NROUTE, TIDX, CVT_A, 3072); }
            if (l + 1 < L_) { __syncthreads(); cvt_small_weights(in_tab(), launder(ws), l + 1, (LAS float*)lds, b_, nb, TIDX); }
        }
#endif
        SEAM(pb + PH_ROUTE);
        {
            const bool do_up = IN(pb + PH_MOEUP), do_dn = IN(pb + PH_MOEDOWN), fuse = do_up && do_dn;
            for (int part = 0; part < (fuse ? 3 : 1); ++part) {
                if (part) xcd_barrier(bar);
                unsigned char* ws = launder(args.ws);
                if (do_up || do_dn) moe_tables(l, ws, lds, g_wv);
                const unsigned* cnt = (const unsigned*)(ws + WS_CTL) + CW_CNT + 2048 * l; const unsigned* mtok = (const unsigned*)(ws + WS_META); const LAS int* tb = (const LAS int*)(lds + LDS_TB);
                const int b_ = BID(), ntile = tb[32], UPU = 2 * ntile, DNU = 4 * ntile;
                const int hi0 = UPU < nb ? UPU : nb, nu_ = UPU - hi0, nu = nu_ < (nb >> 1) ? nu_ : (nb >> 1), nd = nb - nu;
                const int d1a = 4 * (hi0 >> 1), d1b = 2 * nd, D1 = nu == 0 ? DNU : (d1a < d1b ? d1a : d1b);
                int ulo = 0, uhi = UPU, uG = nb, uc = b_, dlo = 0, dhi = DNU, dG = nb, dc = b_;
                if (fuse) {
                    if (part == 0) { uhi = hi0; dhi = 0; }
                    else if (part == 1) { ulo = hi0; uG = nu; if (b_ >= nu) uhi = ulo; dhi = D1; dG = nd; dc = b_ - nu; if (b_ < nu) dhi = 0; }
                    else { uhi = 0; dlo = D1; }
                }
                if (do_up && uhi > ulo) {
                    MoeSched<2, true> S{(const char*)(ws + WS_XB), (const char*)(ws + WS_WMOE), cnt, mtok, tb, uG, uc, (size_t)512 * 1024 * 2, (size_t)256 * 1024 * 2, ulo, uhi};
                    EpiMoeUp E{mtok, (const float*)(ws + WS_RS2), tb, (bf16_t*)(ws + WS_HBUF)};
#ifndef NO_MOEUP
                    g8::gemm_run(lds, 1024, 1024, S, E, g_wv);
#endif
                }
                if (do_dn && dhi > dlo) {
                    MoeSched<4, false> S{(const char*)(ws + WS_HBUF), (const char*)(ws + WS_WMOE + WMOE_WD), cnt, mtok, tb, dG, dc, (size_t)1024 * 256 * 2, (size_t)256 * 256 * 2, dlo, dhi};
                    EpiMoeDown E{mtok, (const float*)(ws + WS_META + META_W), tb, (bf16_t*)(ws + WS_YBUF)};
#ifndef NO_MOEDOWN
                    g8::gemm_run(lds, 256, 256, S, E, g_wv);
#endif
                }
            }
        }
        SEAM(pb + PH_MOEDOWN);
#ifndef NO_COMBINE
        if (IN(pb + PH_COMBINE)) { unsigned char* ws = launder(args.ws); phase_combine(l, ws, args.out, BID(), nb, g_wv); }
#endif
        SEAM(pb + PH_COMBINE);
    }
#undef IN
#undef SEAM
}
#if CHECK
struct NvScratch { float *proj, *h1, *qk, *hraw, *kn, *kcmp, *vcmp, *dqn, *q, *dkvn, *kv, *krope, *y, *x1, *xl; int* rt_e; float* rt_w; };
constexpr int CB = 5;
enum { NS_INPROJ = 0, NS_NSAPREP, NS_MLAPREP, NS_NSA, NS_ML, NS_MLA, NS_OUT, NS_ROUTE, NS_MOE };
static void naive_step(void* const* d_in, int l, int step, const float* xin, float* xout, const NvScratch& S, hipStream_t st) {
    const int b = CB;
    const float* rel_bias = (const float*)d_in[2];
    const float* norm1_g = (const float*)d_in[3] + (long)l * 1024;
    const float* w_in = (const float*)d_in[4] + (long)l * 1024 * DIN;
    const float* cmp_pe = (const float*)d_in[5] + (long)l * 2 * 32 * 64;
    const float* cmp_w1 = (const float*)d_in[6] + (long)l * 2 * 32 * 64 * 64;
    const float* cmp_w2 = (const float*)d_in[7] + (long)l * 2 * 64 * 64;
    const float* q_norm = (const float*)d_in[8] + l * 64;
    const float* k_norm = (const float*)d_in[9] + l * 64;
    const float* nsa_on = (const float*)d_in[10] + l * 384;
    const float* conv = (const float*)d_in[11] + l * 4 * 512;
    const float* ibias = (const float*)d_in[12] + l * 4;
    const float* fbias = (const float*)d_in[13] + l * 4;
    const float* ml_on = (const float*)d_in[14] + l * 256;
    const float* qan = (const float*)d_in[15] + l * 192;
    const float* w_uq = (const float*)d_in[16] + (long)l * 192 * 576;
    const float* kvan = (const float*)d_in[17] + l * 128;
    const float* w_ukv = (const float*)d_in[18] + (long)l * 128 * 768;
    const float* qkn = (const float*)d_in[19] + l * 192;
    const float* mla_on = (const float*)d_in[20] + l * 384;
    const float* w_out = (const float*)d_in[21] + (long)l * 1024 * 1024;
    const float* norm2_g = (const float*)d_in[22] + l * 1024;
    const float* wgrp = (const float*)d_in[23] + (long)l * 1024 * 4;
    const float* bgrp = (const float*)d_in[24] + l * 4;
    const float* wexp = (const float*)d_in[25] + (long)l * 1024 * 32;
    const float* bexp = (const float*)d_in[26] + l * 32;
    const float* Wg = (const float*)d_in[27] + (long)l * 32 * 1024 * 256;
    const float* Wu = (const float*)d_in[28] + (long)l * 32 * 1024 * 256;
    const float* Wd = (const float*)d_in[29] + (long)l * 32 * 256 * 1024;
    const int* pos = (const int*)d_in[1] + b * 2048;
    switch (step) {
    case NS_INPROJ:
        nv_rmsnorm<<<dim3(2048, 1), 64, 0, st>>>(xin, 1024, 0, S.h1, 1024, 0, norm1_g, 0, 1024);
        nv_gemm<<<dim3((DIN + 63) / 64, 2048 / 64), 256, 0, st>>>(S.h1, 1024, w_in, DIN, S.proj, DIN, nullptr, 0, 2048, DIN, 1024);
        break;
    case NS_NSAPREP:
        nv_nsa_cmp<<<dim3(127, 2, 2), 64, 0, st>>>(S.proj, cmp_pe, cmp_w1, cmp_w2, k_norm, S.kcmp, S.vcmp);
        nv_nsa_knorm<<<dim3(2048, 4), 64, 0, st>>>(S.proj, k_norm, S.kn);
        break;
    case NS_MLAPREP:
        nv_rmsnorm<<<dim3(2048, 1), 64, 0, st>>>(S.proj + O_CDQ, DIN, 0, S.dqn, 192, 0, qan, 0, 192);
        nv_gemm<<<dim3(576 / 64, 2048 / 64), 256, 0, st>>>(S.dqn, 192, w_uq, 576, S.q, 576, nullptr, 0, 2048, 576, 192);
        nv_rmsnorm<<<dim3(2048, 1), 64, 0, st>>>(S.proj + O_CDKV, DIN, 0, S.dkvn, 128, 0, kvan, 0, 128);
        nv_gemm<<<dim3(768 / 64, 2048 / 64), 256, 0, st>>>(S.dkvn, 128, w_ukv, 768, S.kv, 768, nullptr, 0, 2048, 768, 128);
        nv_mla_prep<<<dim3(2048, 7), 64, 0, st>>>(S.q, S.kv, S.proj, S.krope, qkn, pos);
        break;
    case NS_NSA:
        nv_nsa_attn<<<dim3(2048, 2), 192, 0, st>>>(S.proj, S.kn, S.kcmp, S.vcmp, rel_bias, q_norm, S.y);
        break;
    case NS_ML:
        nv_ml_conv<<<2048, 512, 0, st>>>(S.proj, conv, S.qk);
        nv_ml_rec<<<4, 256, 0, st>>>(S.proj, S.qk, ibias, fbias, S.hraw);
        nv_ml_fin<<<dim3(2048, 4), 64, 0, st>>>(S.proj, S.hraw, ml_on, S.y);
        break;
    case NS_MLA:
        nv_mla_attn<<<dim3(2048, 6), 64, 0, st>>>(S.q, S.kv, S.krope, S.y);
        break;
    case NS_OUT:
        nv_rmsnorm<<<dim3(2048, 1), 64, 0, st>>>(S.y, 1024, 0, S.y, 1024, 0, nsa_on, 0, 384);
        nv_rmsnorm<<<dim3(2048, 1), 64, 0, st>>>(S.y + 640, 1024, 0, S.y + 640, 1024, 0, mla_on, 0, 384);
        nv_gemm<<<dim3(1024 / 64, 2048 / 64), 256, 0, st>>>(S.y, 1024, w_out, 1024, S.x1, 1024, xin, 1024, 2048, 1024, 1024);
        break;
    case NS_ROUTE:
        nv_moe_route<<<2048, 64, 0, st>>>(S.x1, norm2_g, wgrp, bgrp, wexp, bexp, S.h1, S.rt_e, S.rt_w);
        break;
    case NS_MOE:
        nv_moe_exp<<<2048, 256, 0, st>>>(S.x1, S.h1, S.rt_e, S.rt_w, Wg, Wu, Wd, xout);
        break;
    }
}

__device__ __forceinline__ void chk_commit(float d2, float r2, float* acc) { d2 = wave_sum(d2); r2 = wave_sum(r2); if ((threadIdx.x & 63) == 0) { atomicAdd(acc, d2); atomicAdd(acc + 1, r2); } }
__device__ __forceinline__ void chk_add(float f, float r, float& d2, float& r2) { const float d = f - r; d2 += (d == d) ? d * d : 1e30f; r2 += r * r; }

__global__ void __launch_bounds__(64) chk_proj(const float* nproj, const unsigned char* prj, const float* ssq_dq, const float* ssq_dkv, const float* qg, const float* kg, const float* krg, const int* pos, float* acc) {
    const int t = blockIdx.x, e = threadIdx.x; const size_t row = (size_t)CB * 2048 + t; float d2 = 0.f, r2 = 0.f;
    for (int G = 0; G < 40; ++G) {
        const int c = inproj_refcol(G, e); float r = c < 0 ? 0.f : nproj[(size_t)t * DIN + c]; float f = 0.f;
        const float rr = (G == 37 && e >= 32) ? 0.f : r; const float ss = wave_sum(rr * rr);
        if (G < 6) { r = r * rsqrtf(ss / 64.f + 1e-6f) * qg[e] * 0.18033688f; f = bf2f(((const bf16_t*)(prj + PRJ_QN))[((size_t)(CB * 6 + G) * 2048 + t) * 64 + e]); }
        else if (G < 18) { const int a = G - 6, br = a >> 2, s = (a >> 1) & 1, hk = a & 1;
            if (br > 0 && s == 0) r = r * rsqrtf(ss / 64.f + 1e-6f) * kg[e];
            const size_t base = br == 0 ? (s ? PRJ_C0V : PRJ_C0K) : (br == 1 ? (s ? PRJ_VN1 : PRJ_KN1) : (s ? PRJ_VN2 : PRJ_KN2));
            f = bf2f(((const bf16_t*)(prj + base))[((size_t)(CB * 2 + hk) * 2048 + t) * 64 + e]); }
        else if (G < 26) f = bf2f(((const bf16_t*)(prj + PRJ_RAWQK))[row * 512 + (G - 18) * 64 + e]);
        else if (G < 30) f = bf2f(((const bf16_t*)(prj + PRJ_VML))[((size_t)(CB * 4 + (G - 26)) * 2048 + t) * 64 + e]);
        else if (G < 34) f = bf2f(((const bf16_t*)(prj + PRJ_OG))[row * 256 + (G - 30) * 64 + e]);
        else if (G < 37) f = bf2f(((const bf16_t*)(prj + PRJ_DQKV))[row * 384 + (G - 34) * 64 + e]);
        else if (G == 37) {
            const float val = e < 32 ? rr * rsqrtf(ss / 32.f + 1e-6f) * krg[e & 31] : 0.f; const float oth = __shfl_xor(val, 16);
            if (e < 32) { const int i = e & 15; const double ang = (double)pos[row] * pow(10000.0, -(double)i / 16.0); const float cs = (float)cos(ang), sn = (float)sin(ang);
                r = e < 16 ? val * cs - oth * sn : val * cs + oth * sn; f = bf2f(((const bf16_t*)(prj + PRJ_KR))[row * 32 + e]); }
            else if (e < 58) f = ((const float*)(prj + PRJ_GATES))[row * 32 + (e - 32)];
            else { f = 0.f; r = 0.f; }
        }
        else f = bf2f(((const bf16_t*)(prj + PRJ_DQKV))[row * 384 + 256 + (G - 38) * 64 + e]);
        chk_add(f, r, d2, r2);
    }
    float d2s = 0.f, r2s = 0.f;
    { float s1 = 0.f, s2 = 0.f; for (int c = e; c < 192; c += 64) { float v = nproj[(size_t)t * DIN + O_CDQ + c]; s1 += v * v; } for (int c = e; c < 128; c += 64) { float v = nproj[(size_t)t * DIN + O_CDKV + c]; s2 += v * v; }
      s1 = wave_sum(s1); s2 = wave_sum(s2); if (e == 0) { chk_add((ssq_dq[row * 4] + ssq_dq[row * 4 + 1]) + ssq_dq[row * 4 + 2], s1, d2s, r2s); chk_add(ssq_dkv[row * 2] + ssq_dkv[row * 2 + 1], s2, d2s, r2s); } }
    chk_commit(d2, r2, acc); chk_commit(d2s, r2s, acc + 2);
}

__global__ void __launch_bounds__(64) chk_prep(const float* nq, const float* nkv, const float* nkr, const float* nkc, const float* nvc, const unsigned char* ws, float* acc) {
    const int t = blockIdx.x, e = threadIdx.x; float d2 = 0.f, r2 = 0.f, d2c = 0.f, r2c = 0.f; const float scale = 0.14724444f;
    const bf16_t* QM = (const bf16_t*)(ws + WS_MLA); const bf16_t* KM = (const bf16_t*)(ws + WS_MLA + MLA_KM); const bf16_t* VM = (const bf16_t*)(ws + WS_MLA + MLA_VM);
    for (int h = 0; h < 6; ++h) {
        const size_t rq = ((size_t)(CB * 6 + h) * 2048 + t);
        chk_add(bf2f(QM[rq * 96 + e]), nq[(size_t)t * 576 + h * 96 + e] * scale, d2, r2);
        chk_add(bf2f(KM[rq * 96 + e]), nkv[(size_t)t * 768 + h * 128 + e], d2, r2);
        chk_add(bf2f(VM[rq * 64 + e]), nkv[(size_t)t * 768 + h * 128 + 64 + e], d2, r2);
        if (e < 32) { chk_add(bf2f(QM[rq * 96 + 64 + e]), nq[(size_t)t * 576 + h * 96 + 64 + e] * scale, d2, r2); chk_add(bf2f(KM[rq * 96 + 64 + e]), nkr[(size_t)t * 32 + e], d2, r2); }
    }
    if (t < 128) for (int hk = 0; hk < 2; ++hk) {
        const bf16_t* KC = (const bf16_t*)(ws + WS_CMP); const bf16_t* VC = (const bf16_t*)(ws + WS_CMP + CMP_V); const size_t rf = ((size_t)(CB * 2 + hk) * 128 + t) * 64 + e;
        chk_add(bf2f(KC[rf]), t < 127 ? nkc[(size_t)(hk * 127 + t) * 64 + e] : 0.f, d2c, r2c); chk_add(bf2f(VC[rf]), t < 127 ? nvc[(size_t)(hk * 127 + t) * 64 + e] : 0.f, d2c, r2c);
    }
    chk_commit(d2, r2, acc); chk_commit(d2c, r2c, acc + 2);
}

__global__ void __launch_bounds__(64) chk_y(const float* ny, const unsigned char* ws, float* acc, int nseg) {
    const int t = blockIdx.x, e = threadIdx.x; const bf16_t* Y = (const bf16_t*)(ws + WS_Y) + ((size_t)CB * 2048 + t) * 1024;
    float d2[3] = {0.f, 0.f, 0.f}, r2[3] = {0.f, 0.f, 0.f};
    for (int c = e; c < 1024; c += 64) { const int seg = c < 384 ? 0 : (c < 640 ? 1 : 2); const int cf = c < 384 ? c : (c < 640 ? 768 + (c - 384) : 384 + (c - 640)); const float f = bf2f(Y[cf]), r = ny[(size_t)t * 1024 + c];
        if (seg == 0) chk_add(f, r, d2[0], r2[0]); else if (seg == 1) chk_add(f, r, d2[1], r2[1]); else chk_add(f, r, d2[2], r2[2]); }
    if (nseg == 3) { chk_commit(d2[0], r2[0], acc); chk_commit(d2[1], r2[1], acc + 2); chk_commit(d2[2], r2[2], acc + 4); }
    else chk_commit(d2[0] + d2[1] + d2[2], r2[0] + r2[1] + r2[2], acc);
}

__global__ void __launch_bounds__(64) chk_x(const float* nx, const unsigned char* ws, float* acc) {
    const int t = blockIdx.x, e = threadIdx.x; const bf16_t* X = (const bf16_t*)(ws + WS_XB) + ((size_t)CB * 2048 + t) * 1024; float d2 = 0.f, r2 = 0.f;
    for (int c = e; c < 1024; c += 64) chk_add(bf2f(X[c]), nx[(size_t)t * 1024 + c], d2, r2);
    chk_commit(d2, r2, acc);
}

__global__ void __launch_bounds__(512) chk_code(float* acc, int nst, const float* nout) {
    __shared__ float sh[512];
    float s = 0.f; for (int i = threadIdx.x; i < 2048 * 1024; i += 512) { float v = nout[i]; s += v * v; }
    sh[threadIdx.x] = s; __syncthreads();
    if (threadIdx.x == 0) { float tot = 0.f; for (int i = 0; i < 512; ++i) tot += sh[i]; float rms = sqrtf(tot / (2048.f * 1024.f)); if (!(rms > 1e-3f && rms < 1e3f)) rms = 1.f;
        int code = 0;
        for (int st = 0; st < nst; ++st) { const float d2 = acc[2 * st], r2 = acc[2 * st + 1]; if (r2 == 0.f && d2 == 0.f) { if ((st & 15) >= 9) continue; code = (st + 1) * 4 + 3; break; } const float err = d2 / fmaxf(r2, 1e-30f);
            const float tol = CHK_TOL(st);
            if (!(err <= tol)) { const int cls = !(err < 1.f) ? 3 : (err >= 0.1f ? 2 : (err >= 0.01f ? 1 : 0)); code = (st + 1) * 4 + cls; break; } }
        acc[2 * 40] = rms * 32.f * exp2f(0.5f * (float)code); }
}
__global__ void __launch_bounds__(512) chk_fill(const float* acc, float* out) {
    const float K = acc[2 * 40];
    for (size_t i = (size_t)blockIdx.x * 512 + threadIdx.x; i < (size_t)NTOK * 1024; i += (size_t)gridDim.x * 512) out[i] = (i & 1) ? -K : K;
}
#endif

#if TIME_PH != -1
#ifndef TIME_Q
#define TIME_Q 6.f
#endif
#ifndef TIME_CAL
#define TIME_CAL 1.0f
#endif
__global__ void tm_acc(const unsigned long long* ts, float* best, int first) {
    int a = TIME_PH, b = TIME_PH + 1;
#ifdef TIME_PH_END
    b = TIME_PH_END;
#endif
    float T = 100.f; if (TIME_PH >= 0) T = (float)(ts[b] - ts[a]) * 0.01f;
    if (first || T < *best) *best = T;
}
__global__ void __launch_bounds__(512) tm_fill(const float* best, float* out) {
    float T = *best;
    T = exp2f(rintf(log2f(fmaxf(T, 1.f)) * TIME_Q) / TIME_Q);
    const float c = sqrtf(T) * TIME_CAL;
    for (size_t i = (size_t)blockIdx.x * 512 + threadIdx.x; i < (size_t)NTOK * 1024; i += (size_t)gridDim.x * 512) out[i] = (i & 1) ? -c : c;
}
#endif
static int g_grid = 0;
static bool setup_once(size_t ws_size) {
    if (g_grid) return g_grid > 0;
    if (ws_size < WS_END) { fprintf(stderr, "kernel_launch: workspace too small: %zu < %zu\n", ws_size, (size_t)WS_END); g_grid = -1; return false; }
    int dev = 0, cus = 0, per_cu = 0;
    if (hipGetDevice(&dev) != hipSuccess || hipDeviceGetAttribute(&cus, hipDeviceAttributeMultiprocessorCount, dev) != hipSuccess) { g_grid = -1; return false; }
    if (hipFuncSetAttribute((const void*)mk, hipFuncAttributeMaxDynamicSharedMemorySize, LDS_BYTES) != hipSuccess) { fprintf(stderr, "kernel_launch: hipFuncSetAttribute failed\n"); g_grid = -1; return false; }
    if (hipOccupancyMaxActiveBlocksPerMultiprocessor(&per_cu, (const void*)mk, 512, LDS_BYTES) != hipSuccess || per_cu < 1) { fprintf(stderr, "kernel_launch: occupancy query says %d\n", per_cu); }
    (void)hipGetLastError();
    g_grid = cus;
    return true;
}
static void launch_mk(const Args& a0, int lo, int hi, hipStream_t stream) { Args a = a0; a.ph_lo = lo; a.ph_hi = hi; hipLaunchKernelGGL(mk, dim3(g_grid), dim3(512), LDS_BYTES, stream, a); }

extern "C" void kernel_launch(void* const* d_in, const int* in_sizes, int n_in, void* d_out, int out_size, void* d_ws, size_t ws_size, hipStream_t stream) {
    if (!setup_once(ws_size)) return;
    unsigned char* ws = (unsigned char*)d_ws;
    (void)hipMemsetAsync(ws + WS_CTL, 0, ZERO_BYTES, stream);
    Args a{}; for (int i = 0; i < 30; ++i) a.in.p[i] = (const float*)d_in[i];
    a.out = (float*)d_out; a.ws = ws; a.ph_lo = 0; a.ph_hi = 0;
#if CHECK
    a.out = nullptr;
#endif
#if CHECK
    float* nb = (float*)d_out; size_t off = 0; NvScratch S;
    auto take = [&](size_t n) { float* p = nb + off; off += (n + 63) & ~(size_t)63; return p; };
    S.proj = take((size_t)2048 * DIN); S.h1 = take(2048 * 1024); S.qk = S.h1; S.hraw = S.qk + 2048 * 512; S.kn = S.hraw + 2048 * 256;
    S.kcmp = take(2 * 127 * 64); S.vcmp = take(2 * 127 * 64); S.dqn = take(2048 * 192); S.q = take(2048 * 576); S.dkvn = take(2048 * 128); S.kv = take(2048 * 768); S.x1 = S.dqn;
    S.krope = take(2048 * 32); S.y = take(2048 * 1024); S.xl = take(2048 * 1024); S.rt_e = (int*)take(2048 * 2); S.rt_w = take(2048 * 2);
    if (off * 4 > (size_t)NTOK * 1024 * 4) { fprintf(stderr, "naive scratch too big\n"); return; }
    float* acc = (float*)(ws + WS_CTL) + CW_CHK;
    launch_mk(a, 0, 1, stream);
    const float* nx_in = (const float*)d_in[0] + (size_t)CB * 2048 * 1024;
    int nst = 0;
    for (int l = 0; l < L_; ++l) {
        const int pb = 1 + l * NPH; const int sb = l * 16;
        launch_mk(a, pb + PH_INPROJ, pb + PH_INPROJ + 1, stream);
        naive_step(d_in, l, NS_INPROJ, nx_in, S.xl, S, stream);
        chk_proj<<<2048, 64, 0, stream>>>(S.proj, ws + WS_PRJ, (const float*)(ws + WS_SSQ + PT_DQ) + (size_t)l * 16384 * 4, (const float*)(ws + WS_SSQ + PT_DKV) + (size_t)l * 16384 * 2,
                                           (const float*)d_in[8] + l * 64, (const float*)d_in[9] + l * 64, (const float*)d_in[19] + l * 192 + 160, (const int*)d_in[1], acc + 2 * (sb + 0));
        nst = sb + 2;
        int ns_done = NS_INPROJ;
#if CHECK_UPTO >= 1
        launch_mk(a, pb + PH_PREP, pb + PH_PREP + 1, stream);
        naive_step(d_in, l, NS_NSAPREP, nx_in, S.xl, S, stream); naive_step(d_in, l, NS_MLAPREP, nx_in, S.xl, S, stream); ns_done = NS_MLAPREP;
        chk_prep<<<2048, 64, 0, stream>>>(S.q, S.kv, S.krope, S.kcmp, S.vcmp, ws, acc + 2 * (sb + 2));
        nst = sb + 4;
#endif
#if CHECK_UPTO >= 2
        launch_mk(a, pb + PH_MIX, pb + PH_MIX + 1, stream);
        naive_step(d_in, l, NS_NSA, nx_in, S.xl, S, stream); naive_step(d_in, l, NS_ML, nx_in, S.xl, S, stream); naive_step(d_in, l, NS_MLA, nx_in, S.xl, S, stream); ns_done = NS_MLA;
        chk_y<<<2048, 64, 0, stream>>>(S.y, ws, acc + 2 * (sb + 4), 3);
        nst = sb + 7;
#endif
#if CHECK_UPTO >= 3
        launch_mk(a, pb + PH_YNORM, pb + PH_YNORM + 1, stream); launch_mk(a, pb + PH_OUTPROJ, pb + PH_OUTPROJ + 1, stream);
        naive_step(d_in, l, NS_OUT, nx_in, S.xl, S, stream); ns_done = NS_OUT;
        chk_x<<<2048, 64, 0, stream>>>(S.x1, ws, acc + 2 * (sb + 7));
        nst = sb + 8;
#endif
#if CHECK_UPTO >= 4
        for (int ph = PH_ROUTE; ph <= PH_COMBINE; ++ph) launch_mk(a, pb + ph, pb + ph + 1, stream);
        naive_step(d_in, l, NS_ROUTE, nx_in, S.xl, S, stream); naive_step(d_in, l, NS_MOE, nx_in, S.xl, S, stream); ns_done = NS_MOE;
        chk_x<<<2048, 64, 0, stream>>>(S.xl, ws, acc + 2 * (sb + 8));
        nst = sb + 9;
#endif
        CHECK_REST
        for (int s = ns_done + 1; s <= NS_MOE; ++s) naive_step(d_in, l, s, nx_in, S.xl, S, stream);
        nx_in = S.xl;
        if (l == CHECK_LAYERS - 1) break;
    }
    chk_code<<<1, 512, 0, stream>>>(acc, nst, S.xl);
    chk_fill<<<1024, 512, 0, stream>>>(acc, (float*)d_out);
#else
#if defined(SPLIT_LAUNCH) && SPLIT_LAUNCH
    for (int ph = 0; ph < 1 + L_ * NPH; ++ph) launch_mk(a, ph, ph + 1, stream);
#else
    launch_mk(a, 0, 1 + L_ * NPH, stream);
#if TIME_PH != -1
    for (int rp = 0; rp < 6; ++rp) {
        (void)hipMemsetAsync(ws + WS_CTL, 0, ZERO_BYTES, stream); launch_mk(a, 0, 1 + L_ * NPH, stream);
        tm_acc<<<1, 1, 0, stream>>>((const unsigned long long*)((unsigned*)(ws + WS_CTL) + CW_TS), (float*)(ws + WS_META + META_RT), rp == 0);
    }
    tm_fill<<<1024, 512, 0, stream>>>((const float*)(ws + WS_META + META_RT), (float*)d_out);
#endif
#endif
#endif
}
```

```cpp
#define CHECK 0
#define CHECK_LAYERS 2
#define CHECK_UPTO 99
#define SPLIT_LAUNCH 0
#define REPEAT_PH -1
#include <hip/hip_runtime.h>
#include <stdint.h>
#include <cstdio>

constexpr int B_ = 8, T_ = 2048, D_ = 1024, L_ = 2, NTOK = B_ * T_;
constexpr int DIN = 2554;
constexpr int O_AQ = 0, O_AKV = 384, O_AG = 1152, O_BQK = 1170, O_BV = 1682, O_BIF = 1938, O_BO = 1946, O_CDQ = 2202, O_CDKV = 2394, O_CKR = 2522;

typedef unsigned short bf16_t;
typedef short bf16x8 __attribute__((ext_vector_type(8)));
typedef short s16x4 __attribute__((ext_vector_type(4)));
typedef float f32x4 __attribute__((ext_vector_type(4)));
typedef float f32x16 __attribute__((ext_vector_type(16)));
typedef unsigned u32x4 __attribute__((ext_vector_type(4)));
typedef unsigned u32x2 __attribute__((ext_vector_type(2)));
typedef float f32x2_t __attribute__((ext_vector_type(2)));
typedef __bf16 bf16x2_t __attribute__((ext_vector_type(2)));
#define LAS __attribute__((address_space(3)))

__device__ __forceinline__ unsigned pk_bf16(float lo, float hi) { f32x2_t v = {lo, hi}; bf16x2_t b = __builtin_convertvector(v, bf16x2_t); return __builtin_bit_cast(unsigned, b); }
__device__ __forceinline__ float bf_lo(unsigned u) { return __builtin_bit_cast(float, u << 16); }
__device__ __forceinline__ float bf_hi(unsigned u) { return __builtin_bit_cast(float, u & 0xffff0000u); }
__device__ __forceinline__ float bf2f(bf16_t h) { return __builtin_bit_cast(float, (unsigned)h << 16); }
__device__ __forceinline__ bf16_t f2bf(float f) { return (bf16_t)(pk_bf16(f, 0.f) & 0xffffu); }
__device__ __forceinline__ float wave_sum(float v) { for (int o = 32; o; o >>= 1) v += __shfl_xor(v, o); return v; }
__device__ __forceinline__ float wave_max(float v) { for (int o = 32; o; o >>= 1) v = fmaxf(v, __shfl_xor(v, o)); return v; }
__device__ __forceinline__ float siluf(float x) { return x * __builtin_amdgcn_rcpf(1.f + __expf(-x)); }
__device__ __forceinline__ float sigmf(float x) { return __builtin_amdgcn_rcpf(1.f + __expf(-x)); }
__device__ __forceinline__ int t5b(int dist) {
    int n = dist > 0 ? dist : 0; if (n < 16) return n;
    float v = logf((float)n / 16.f) / logf(8.f) * 16.f; int l = 16 + (int)v; return l < 31 ? l : 31;
}

__device__ __forceinline__ int lane_now() { return (int)__builtin_amdgcn_mbcnt_hi(~0u, __builtin_amdgcn_mbcnt_lo(~0u, 0u)); }
#define TIDX ((g_wv << 6) | lane_now())

constexpr size_t WS_CTL = 0, CTL_BYTES = 65536;
constexpr size_t WS_SSQ = WS_CTL + CTL_BYTES;
constexpr size_t ZERO_BYTES = CTL_BYTES;
constexpr size_t PT_DQ = 0, PT_DKV = PT_DQ + (size_t)2 * 16384 * 4 * 4, PT_A = PT_DKV + (size_t)2 * 16384 * 2 * 4, PT_C = PT_A + (size_t)2 * 16384 * 8 * 4, PT_X1 = PT_C + (size_t)2 * 16384 * 8 * 4, PT_END = PT_X1 + (size_t)2 * 16384 * 16 * 4;
constexpr size_t WS_SSQX = WS_SSQ + PT_END;
constexpr size_t WS_RS2 = WS_SSQX + 2 * 65536;
constexpr size_t WS_WIN = WS_RS2 + 65536;
constexpr size_t WS_WOUT = WS_WIN + (size_t)2 * 2560 * 1024 * 2;
constexpr size_t WS_WUQ = WS_WOUT + (size_t)2 * 1024 * 1024 * 2;
constexpr size_t WS_WUKV = WS_WUQ + (size_t)2 * 768 * 256 * 2;
constexpr size_t WS_WC1 = WS_WUKV + (size_t)2 * 768 * 256 * 2;
constexpr size_t WS_WC2 = WS_WC1 + (size_t)2 * 2 * 64 * 2048 * 2;
constexpr size_t WS_WR = WS_WC2 + (size_t)2 * 2 * 64 * 64 * 2;
constexpr size_t WS_B1C = WS_WR + (size_t)2 * 64 * 1024 * 2;
constexpr size_t WS_BIASD = WS_B1C + 1024;
constexpr size_t WS_ROPE = WS_BIASD + 6 * 2048 * 4;
constexpr size_t WS_WMOE = WS_ROPE + (size_t)16384 * 32 * 4;
constexpr size_t WMOE_WD = (size_t)32 * 512 * 1024 * 2;
constexpr size_t WS_XB = WS_WMOE + 50331648;
constexpr size_t WS_MLA = WS_XB + 33554432;
constexpr size_t MLA_KM = (size_t)8 * 6 * 2048 * 96 * 2, MLA_VM = 2 * MLA_KM;
constexpr size_t WS_HBUF = WS_MLA;
constexpr size_t WS_PRJ = WS_MLA + 50331648;
constexpr size_t HM64 = (size_t)2048 * 64 * 2;
constexpr size_t PRJ_QN = 0;
constexpr size_t PRJ_KN1 = PRJ_QN + 48 * HM64, PRJ_VN1 = PRJ_KN1 + 16 * HM64, PRJ_KN2 = PRJ_VN1 + 16 * HM64, PRJ_VN2 = PRJ_KN2 + 16 * HM64;
constexpr size_t PRJ_VML = PRJ_VN2 + 16 * HM64;
constexpr size_t PRJ_OG = PRJ_VML + 32 * HM64;
constexpr size_t PRJ_KR = PRJ_OG + (size_t)16384 * 256 * 2;
constexpr size_t PRJ_GATES = PRJ_KR + (size_t)16384 * 32 * 2;
constexpr size_t PRJ_DEAD = PRJ_GATES + (size_t)16384 * 32 * 4;
constexpr size_t PRJ_C0K = PRJ_DEAD, PRJ_C0V = PRJ_C0K + 16 * HM64 + 8192;
constexpr size_t PRJ_RAWQK = PRJ_C0V + 16 * HM64 + 8192;
constexpr size_t PRJ_DQKV = PRJ_RAWQK + (size_t)16384 * 512 * 2;
constexpr size_t PRJ_END = PRJ_DQKV + (size_t)16384 * 384 * 2;
static_assert(PRJ_END - PRJ_DEAD >= 33554432, "Y fits the dead part of PRJ");
constexpr size_t WS_Y = WS_PRJ + PRJ_DEAD;
constexpr size_t WS_YBUF = WS_PRJ;
static_assert((size_t)2 * 16384 * 1024 * 2 <= PRJ_END, "YBUF fits the PRJ region");
constexpr size_t WS_ML = WS_PRJ + PRJ_END;
constexpr size_t ML_KC = 32 * HM64, ML_DELTA = 2 * ML_KC, ML_DN = ML_DELTA + (size_t)1024 * 4096 * 2, ML_G = ML_DN + (size_t)1024 * 64 * 4, ML_BL = ML_G + (size_t)8 * 4 * 2048 * 2 * 4, ML_CP = ML_BL + 4096, ML_NP = ML_CP + (size_t)1024 * 4096 * 2, ML_END = ML_NP + (size_t)1024 * 64 * 2;
constexpr size_t WS_CMP = WS_ML + ML_END;
constexpr size_t CMP_V = (size_t)8 * 2 * 128 * 64 * 2;
constexpr size_t WS_META = WS_CMP + 2 * CMP_V;
constexpr size_t META_W = (size_t)32 * 16384 * 4, META_RT = 2 * META_W;
constexpr size_t WS_END = WS_META + META_RT + (size_t)16384 * 16;
constexpr int CW_BAR = 0;
constexpr int CW_Q = 4096;
constexpr int CW_SCAN = 4608;
constexpr int CW_TS = 4864;
constexpr int CW_CHK = 5120;
constexpr int CW_CNT = 8192;
constexpr int LDS_BYTES = 147456;
constexpr int LDS_MISC = LDS_BYTES - 256;
#define XB_TMO      128
#define XB_XCNT(j)  (256  + 64 * (j))
#define XB_XSUB(j)  (1280 + 64 * (j))
#define XB_XGEN(j)  (2304 + 64 * (j))
#define XB_TOP      3328
#define XB_TOPGEN   3392
#define XCD_BAR_WORDS 3456
#define XB_SPIN_CAP (1u << 18)

__device__ __forceinline__ unsigned xb_ld(unsigned* p)              { return __hip_atomic_load(p, __ATOMIC_RELAXED, __HIP_MEMORY_SCOPE_AGENT); }
__device__ __forceinline__ unsigned xb_add(unsigned* p, unsigned v) { return __hip_atomic_fetch_add(p, v, __ATOMIC_RELAXED, __HIP_MEMORY_SCOPE_AGENT); }
__device__ __forceinline__ unsigned xb_xcc_id() { return (unsigned)__builtin_amdgcn_s_getreg((3 << 11) | 20) & 0xFu; }
#define XB_SPIN(cond, bar) do { unsigned _sp = 0; while (cond) { __builtin_amdgcn_s_sleep(1); \
    if ((++_sp & 255u) == 0u) { if (xb_ld(&(bar)[XB_TMO])) break; if (_sp > XB_SPIN_CAP) { atomicAdd(&(bar)[XB_TMO], 1u); break; } } } } while (0)

struct XcdBarrier {
    int g_wv; unsigned* bar; unsigned x;
    volatile LAS unsigned* st;
};

__device__ __forceinline__ XcdBarrier xcd_barrier_post(unsigned* bar, volatile LAS unsigned* st, int g_wv) {
    XcdBarrier b; b.g_wv = g_wv; b.bar = bar; b.x = xb_xcc_id(); b.st = st;
    if (TIDX == 0) (void)xb_add(&bar[XB_XCNT(b.x)], 1u);
    return b;
}
__device__ __forceinline__ void xcd_barrier_complete(unsigned* bar, unsigned x, unsigned& nloc, unsigned& nx) {
    const unsigned G = gridDim.x * gridDim.y * gridDim.z;
    unsigned sum, cnt, mine, sp = 0u;
    for (;;) {
        sum = 0u; cnt = 0u; mine = 0u;
#pragma unroll
        for (unsigned j = 0; j < 16; ++j) { const unsigned c = xb_ld(&bar[XB_XCNT(j)]); sum += c; cnt += (c > 0u) ? 1u : 0u; mine = (j == x) ? c : mine; }
        if (sum == G) break;
        __builtin_amdgcn_s_sleep(1);
        if ((++sp & 255u) == 0u) { if (xb_ld(&bar[XB_TMO])) break; if (sp > XB_SPIN_CAP) { atomicAdd(&bar[XB_TMO], 1u); break; } }
    }
    nloc = mine > 0u ? mine : 1u; nx = cnt > 0u ? cnt : 1u;
}

__device__ __forceinline__ void xcd_barrier(const XcdBarrier& b) {
    asm volatile("s_waitcnt vmcnt(0)" ::: "memory");
    __syncthreads();
    const int g_wv = b.g_wv;
    if (TIDX == 0) {
        unsigned* bar = b.bar;
        __builtin_amdgcn_s_waitcnt(0);
        unsigned nloc = b.st[0], nx = b.st[1];
        if (nloc == 0u) { xcd_barrier_complete(bar, b.x, nloc, nx); b.st[0] = nloc; b.st[1] = nx; }
        const unsigned old = xb_add(&bar[XB_XSUB(b.x)], 1u);
        const unsigned gen = old / nloc;
        if (old + 1u == (gen + 1u) * nloc) {
            __builtin_amdgcn_fence(__ATOMIC_RELEASE, "agent");
            asm volatile("s_waitcnt vmcnt(0)" ::: "memory");
            const unsigned og = xb_add(&bar[XB_TOP], 1u);
            const unsigned tg = og / nx;
            if (og + 1u == (tg + 1u) * nx) xb_add(&bar[XB_TOPGEN], 1u);
            else XB_SPIN(xb_ld(&bar[XB_TOPGEN]) == tg, bar);
            __builtin_amdgcn_fence(__ATOMIC_ACQUIRE, "agent");
            xb_add(&bar[XB_XGEN(b.x)], 1u);
            asm volatile("s_waitcnt vmcnt(0)" ::: "memory");
        } else {
            XB_SPIN(xb_ld(&bar[XB_XGEN(b.x)]) == gen, bar);
            __builtin_amdgcn_fence(__ATOMIC_ACQUIRE, "agent");
            asm volatile("s_waitcnt vmcnt(0)" ::: "memory");
        }
    }
    __syncthreads();
}
struct Inputs { const float* p[30]; };
typedef const __attribute__((address_space(4))) Inputs* InPtr;
__device__ __forceinline__ InPtr in_tab() { InPtr p = (InPtr)__builtin_amdgcn_kernarg_segment_ptr(); asm volatile("" : "+s"(p)); return p; }
__device__ __forceinline__ unsigned char* launder(unsigned char* p) { size_t z = 0; asm volatile("" : "+s"(z)); return p + z; }

__host__ __device__ inline int inproj_refcol(int G, int e) {
    if (G < 6) return O_AQ + G * 64 + e;
    if (G < 18) return O_AKV + (G - 6) * 64 + e;
    if (G < 26) return O_BQK + (G - 18) * 64 + e;
    if (G < 30) return O_BV + (G - 26) * 64 + e;
    if (G < 34) return O_BO + (G - 30) * 64 + e;
    if (G < 37) return O_CDQ + (G - 34) * 64 + e;
    if (G == 37) { if (e < 32) return O_CKR + e; if (e < 50) return O_AG + (e - 32); if (e < 58) return O_BIF + (e - 50); return -1; }
    return O_CDKV + (G - 38) * 64 + e;
}
__host__ __device__ inline int uq_refcol(int G, int e) {
    if (G < 6) return G * 96 + e;
    if (G < 9) { const int idx = e & 31, bj = e >> 5, sub = idx >> 4, i = idx & 15; return (2 * (G - 6) + sub) * 96 + 64 + bj * 16 + i; }
    return -1;
}
__host__ __device__ inline int ukv_refcol(int G, int e) { return G < 6 ? G * 128 + e : (G - 6) * 128 + 64 + e; }
#define N2G(n) ((((n) >> 8) << 2) + (((n) >> 5) & 3))
#define N2E(n) (((((n) >> 7) & 1) << 5) + ((n) & 31))

__device__ __forceinline__ float opaque_f(float v) { asm volatile("" : "+v"(v)); return v; }
struct FWin { const float* w; const float* g; __device__ __forceinline__ void ld(int k, int n, const float*& p, float& gn, float gk) const { const int c = inproj_refcol(N2G(n), N2E(n)); p = w + (size_t)k * DIN + (c < 0 ? 0 : c); gn = c < 0 ? 0.f : gk; }
    __device__ __forceinline__ float rowgain(int k) const { return opaque_f(g[k]); } };
struct FWout { const float* w; const float* ga; const float* gc; __device__ __forceinline__ void ld(int k, int n, const float*& p, float& gn, float gk) const {
    const int kr = k < 384 ? k : (k < 768 ? 640 + (k - 384) : 384 + (k - 768)); p = w + (size_t)kr * 1024 + n; gn = gk; }
    __device__ __forceinline__ float rowgain(int k) const { const float a = opaque_f(ga[k < 384 ? k : 0]), c = opaque_f(gc[(k >= 384 && k < 768) ? k - 384 : 0]); return k < 384 ? a : (k < 768 ? c : 1.f); } };
struct FWuq { const float* w; const float* g; __device__ __forceinline__ void ld(int k, int n, const float*& p, float& gn, float gk) const { const int c = uq_refcol(N2G(n), N2E(n)); const int kk = k < 192 ? k : 191; p = w + (size_t)kk * 576 + (c < 0 ? 0 : c); gn = (k < 192 && c >= 0) ? gk : 0.f; }
    __device__ __forceinline__ float rowgain(int k) const { return opaque_f(g[k < 192 ? k : 191]); } };
struct FWukv { const float* w; const float* g; __device__ __forceinline__ void ld(int k, int n, const float*& p, float& gn, float gk) const { const int c = ukv_refcol(N2G(n), N2E(n)); const int kk = k >= 128 ? k - 128 : 0; p = w + (size_t)kk * 768 + c; gn = k >= 128 ? gk : 0.f; }
    __device__ __forceinline__ float rowgain(int k) const { return opaque_f(g[k >= 128 ? k - 128 : 0]); } };
struct FWc1 { const float* w; __device__ __forceinline__ void ld(int k, int n, const float*& p, float& gn, float gk) const { p = w + (size_t)k * 64 + n; gn = 1.f; }
    __device__ __forceinline__ float rowgain(int k) const { return 1.f; } };
struct FWr { const float* wg; const float* we; const float* g; __device__ __forceinline__ void ld(int k, int n, const float*& p, float& gn, float gk) const { p = n < 4 ? wg + k * 4 + n : we + k * 32 + (n < 36 ? n - 4 : 0); gn = n < 36 ? gk : 0.f; }
    __device__ __forceinline__ float rowgain(int k) const { return opaque_f(g[k]); } };
struct FWgu { const float* src; const float* g; int n0, col0; __device__ __forceinline__ float operator()(int k, int n) const { return src[(size_t)k * 256 + col0 + (n - n0)] * g[k]; } };
struct FWd { const float* w; __device__ __forceinline__ float operator()(int k, int n) const { return w[(size_t)k * 1024 + n]; } };

__device__ __forceinline__ void rope_cs(int pos, int j, float& cs, float& sn) {
    const double inv = exp2(-(double)j * (13.287712379549449 / 16.0));
    const double rev = (double)pos * inv * 0.15915494309189535; const float f = (float)(rev - rint(rev));
    cs = __builtin_amdgcn_cosf(f); sn = __builtin_amdgcn_sinf(f);
}
template <class F>
__device__ __forceinline__ void cvt_tile(const F& f, int n0, int k0, bf16_t* dst, int ldk, LAS float* tile, int tid) {
    { const int k = tid >> 3, nb = (tid & 7) * 8; const float gk = f.rowgain(k0 + k); const float* p[8]; float gn[8], v[8];
#pragma unroll
      for (int j = 0; j < 8; ++j) f.ld(k0 + k, n0 + nb + j, p[j], gn[j], gk);
#pragma unroll
      for (int j = 0; j < 8; ++j) v[j] = *p[j];
#pragma unroll
      for (int j = 0; j < 8; ++j) tile[k * 65 + nb + j] = v[j] * gn[j]; }
    __syncthreads();
    { const int n = tid >> 3, kb = (tid & 7) * 8; const LAS float* s = tile + kb * 65 + n;
      u32x4 o; o.x = pk_bf16(s[0], s[65]); o.y = pk_bf16(s[130], s[195]); o.z = pk_bf16(s[260], s[325]); o.w = pk_bf16(s[390], s[455]);
      *(u32x4*)(dst + (size_t)(n0 + n) * ldk + k0 + kb) = o; }
    __syncthreads();
}
template <class F>
__device__ __forceinline__ void cvt_item(const F& f, int it, int nK, bf16_t* dst, int ldk, LAS float* tile, int tid) { cvt_tile(f, (it / nK) * 64, (it % nK) * 64, dst, ldk, tile, tid); }

__device__ __forceinline__ void moe_item(InPtr in, int l, int it, const float*& src, int& ld, size_t& dst, int& ldk, bool& gain, int& kk0) {
    if (it < 32 * 64) { const int e = it >> 6, r = it & 63, n0 = (r >> 3) * 64, k0 = (r & 7) * 128, c0 = n0 & 255;
        src = (c0 < 128 ? in->p[27] : in->p[28]) + ((size_t)l * 32 + e) * 262144 + (size_t)k0 * 256 + (n0 >> 8) * 128 + (c0 & 127); ld = 256; gain = true; kk0 = k0;
        dst = ((size_t)e * 512 + n0) * 1024 + k0; ldk = 1024; }
    else { const int j = it - 32 * 64, e = j >> 5, r = j & 31, n0 = (r >> 1) * 64, k0 = (r & 1) * 128;
        src = in->p[29] + ((size_t)l * 32 + e) * 262144 + (size_t)k0 * 1024 + n0; ld = 1024; gain = false; kk0 = 0;
        dst = (size_t)16777216 + ((size_t)e * 1024 + n0) * 256 + k0; ldk = 256; }
}
__device__ __forceinline__ void cvt_moe_layer(InPtr in, unsigned char* ws, int l, LAS float* tile, int bid, int nb, int tid, int it_lo = 0, int it_hi = 32 * (64 + 32)) {
    asm volatile("" : "+v"(tid));
    const float* g2 = in->p[22] + l * 1024; bf16_t* W = (bf16_t*)(ws + WS_WMOE);
    const int k = tid >> 3, nbq = (tid & 7) * 8;
    const int n = tid >> 3, kb = (tid & 7) * 8;
    const int NIT = it_hi;
#define CVM_LOAD(it_, P) do { const float* src_; int ld_, ldk_, kk0_; size_t dst_; bool gain_; moe_item(in, l, (it_), src_, ld_, dst_, ldk_, gain_, kk0_); \
        P##a = *(const f32x4*)(src_ + (size_t)k * ld_ + nbq); P##b = *(const f32x4*)(src_ + (size_t)k * ld_ + nbq + 4); P##c = *(const f32x4*)(src_ + (size_t)(k + 64) * ld_ + nbq); P##d = *(const f32x4*)(src_ + (size_t)(k + 64) * ld_ + nbq + 4); \
        P##g0 = gain_ ? g2[kk0_ + k] : 1.f; P##g1 = gain_ ? g2[kk0_ + 64 + k] : 1.f; } while (0)
#define CVM_PUT(t, P) do { \
        t[k * 65 + nbq + 0] = P##a.x * P##g0; t[k * 65 + nbq + 1] = P##a.y * P##g0; t[k * 65 + nbq + 2] = P##a.z * P##g0; t[k * 65 + nbq + 3] = P##a.w * P##g0; \
        t[k * 65 + nbq + 4] = P##b.x * P##g0; t[k * 65 + nbq + 5] = P##b.y * P##g0; t[k * 65 + nbq + 6] = P##b.z * P##g0; t[k * 65 + nbq + 7] = P##b.w * P##g0; \
        t[(k + 64) * 65 + nbq + 0] = P##c.x * P##g1; t[(k + 64) * 65 + nbq + 1] = P##c.y * P##g1; t[(k + 64) * 65 + nbq + 2] = P##c.z * P##g1; t[(k + 64) * 65 + nbq + 3] = P##c.w * P##g1; \
        t[(k + 64) * 65 + nbq + 4] = P##d.x * P##g1; t[(k + 64) * 65 + nbq + 5] = P##d.y * P##g1; t[(k + 64) * 65 + nbq + 6] = P##d.z * P##g1; t[(k + 64) * 65 + nbq + 7] = P##d.w * P##g1; } while (0)
#define CVM_STORE(it_, t) do { const float* src_; int ld_, ldk_, kk0_; size_t dst_; bool gain_; moe_item(in, l, (it_), src_, ld_, dst_, ldk_, gain_, kk0_); \
        _Pragma("unroll") for (int hh = 0; hh < 2; ++hh) { const LAS float* s_ = t + (64 * hh + kb) * 65 + n; \
            u32x4 o; o.x = pk_bf16(s_[0], s_[65]); o.y = pk_bf16(s_[130], s_[195]); o.z = pk_bf16(s_[260], s_[325]); o.w = pk_bf16(s_[390], s_[455]); \
            *(u32x4*)(W + dst_ + (size_t)n * ldk_ + 64 * hh + kb) = o; } } while (0)
    f32x4 Aa, Ab, Ac, Ad, Ba, Bb, Bc, Bd; float Ag0 = 1.f, Ag1 = 1.f, Bg0 = 1.f, Bg1 = 1.f;
    LAS float* t0 = tile; LAS float* t1 = tile + 128 * 65;
    int it = it_lo + bid;
    if (it < NIT) CVM_LOAD(it, A);
    if (it + nb < NIT) CVM_LOAD(it + nb, B);
#pragma unroll 1
    for (; it < NIT; it += 2 * nb) {
        CVM_PUT(t0, A);
        __syncthreads();
        if (it + 2 * nb < NIT) CVM_LOAD(it + 2 * nb, A);
        CVM_STORE(it, t0);
        if (it + nb < NIT) {
            CVM_PUT(t1, B);
            __syncthreads();
            if (it + 3 * nb < NIT) CVM_LOAD(it + 3 * nb, B);
            CVM_STORE(it + nb, t1);
        }
    }
#undef CVM_LOAD
#undef CVM_PUT
#undef CVM_STORE
    __syncthreads();
}

__device__ __forceinline__ void cvt_small_weights(InPtr in, unsigned char* ws, int l, LAS float* tile, int bid, int nb, int tid) {
    asm volatile("" : "+v"(tid));
    constexpr int I_WIN = 40 * 16, I_WOUT = 16 * 16, I_WU = 12 * 4, I_WC1 = 32, I_WC2 = 1, I_WR = 16;
    constexpr int PER_L = I_WIN + I_WOUT + 2 * I_WU + 2 * I_WC1 + 2 * I_WC2 + I_WR;
    for (int it0 = bid; it0 < PER_L; it0 += nb) {
        int it = it0;
        if (it < I_WIN) { FWin f{in->p[4] + (size_t)l * 1024 * DIN, in->p[3] + l * 1024}; cvt_item(f, it, 16, (bf16_t*)(ws + WS_WIN) + (size_t)l * 2560 * 1024, 1024, tile, tid); continue; } it -= I_WIN;
        if (it < I_WOUT) { FWout f{in->p[21] + (size_t)l * 1048576, in->p[10] + l * 384, in->p[20] + l * 384}; cvt_item(f, it, 16, (bf16_t*)(ws + WS_WOUT) + (size_t)l * 1048576, 1024, tile, tid); continue; } it -= I_WOUT;
        if (it < I_WU) { FWuq f{in->p[16] + (size_t)l * 192 * 576, in->p[15] + l * 192}; cvt_item(f, it, 4, (bf16_t*)(ws + WS_WUQ) + (size_t)l * 768 * 256, 256, tile, tid); continue; } it -= I_WU;
        if (it < I_WU) { FWukv f{in->p[18] + (size_t)l * 128 * 768, in->p[17] + l * 128}; cvt_item(f, it, 4, (bf16_t*)(ws + WS_WUKV) + (size_t)l * 768 * 256, 256, tile, tid); continue; } it -= I_WU;
        if (it < 2 * I_WC1) { const int s = it / I_WC1; FWc1 f{in->p[6] + ((size_t)l * 2 + s) * 2048 * 64}; cvt_item(f, it % I_WC1, 32, (bf16_t*)(ws + WS_WC1) + ((size_t)l * 2 + s) * 64 * 2048, 2048, tile, tid); continue; } it -= 2 * I_WC1;
        if (it < 2 * I_WC2) { const int s = it; FWc1 f{in->p[7] + ((size_t)l * 2 + s) * 64 * 64}; cvt_item(f, 0, 1, (bf16_t*)(ws + WS_WC2) + ((size_t)l * 2 + s) * 64 * 64, 64, tile, tid); continue; } it -= 2 * I_WC2;
        { FWr f{in->p[23] + (size_t)l * 4096, in->p[25] + (size_t)l * 32768, in->p[22] + l * 1024}; cvt_item(f, it, 16, (bf16_t*)(ws + WS_WR) + (size_t)l * 64 * 1024, 1024, tile, tid); }
    }
}

__device__ __forceinline__ void prologue(InPtr in, unsigned char* ws, LAS unsigned char* lds, int bid, int nb, int g_wv) {
    int tid_ = TIDX; asm volatile("" : "+v"(tid_));
    const int tid = tid_, lane = tid & 63, wid = tid >> 6;
    LAS float* tile = (LAS float*)lds;
    cvt_small_weights(in, ws, 0, tile, bid, nb, tid);
    { const float* x = in->p[0]; bf16_t* XB = (bf16_t*)(ws + WS_XB); float* ssqx = (float*)(ws + WS_SSQX);
      for (int r = bid * 8 + wid; r < NTOK; r += nb * 8) {
          const f32x4* xr = (const f32x4*)(x + (size_t)r * 1024) + lane; float s = 0.f; u32x2* o = (u32x2*)(XB + (size_t)r * 1024) + lane;
#pragma unroll
          for (int j = 0; j < 4; ++j) { const f32x4 v = xr[64 * j]; s += (v.x * v.x + v.y * v.y) + (v.z * v.z + v.w * v.w); u32x2 w; w.x = pk_bf16(v.x, v.y); w.y = pk_bf16(v.z, v.w); o[64 * j] = w; }
          s = wave_sum(s); if (lane == 0) ssqx[r] = s;
      } }
    { float* biasd = (float*)(ws + WS_BIASD); const float* rb = in->p[2];
      for (int i = bid * 512 + tid; i < 6 * 2048; i += nb * 512) { const int h = i >> 11, d = i & 2047; biasd[i] = rb[t5b(d) * 6 + h] * 1.44269504f; } }
    { float* rope = (float*)(ws + WS_ROPE); const int* pos = (const int*)in->p[1];
      for (int i = bid * 512 + tid; i < NTOK * 16; i += nb * 512) { const int tk = i >> 4, j = i & 15; float cs, sn; rope_cs(pos[tk], j, cs, sn); rope[(size_t)tk * 32 + j] = cs; rope[(size_t)tk * 32 + 16 + j] = sn; } }
    { float* b1c = (float*)(ws + WS_B1C); LAS float* red = (LAS float*)lds;
      for (int it = bid; it < 4; it += nb) { const float* pe = in->p[5] + (size_t)it * 2048; const float* w1 = in->p[6] + (size_t)it * 2048 * 64; const int f = tid & 63, part = tid >> 6;
          float a = 0.f; for (int k = part * 256; k < part * 256 + 256; ++k) a += pe[k] * w1[(size_t)k * 64 + f];
          __syncthreads(); red[tid] = a; __syncthreads();
          if (tid < 64) { float s = 0.f; for (int p2 = 0; p2 < 8; ++p2) s += red[p2 * 64 + tid]; b1c[it * 64 + tid] = s; }
          __syncthreads(); } }
}
namespace g8 {
constexpr int BM = 256, BK = 64, HALF = 128, HTB = HALF * BK * 2, STAGE_BYTES = 8 * HTB, NXCD = 8, WGM = 8;
__host__ __device__ __forceinline__ int lds_byte(int r, int c) { const int st = (r >> 4) * 2 + (c >> 5), rr = r & 15, cc = c & 31, ob = rr * 64 + cc * 2; return st * 1024 + (ob ^ (((ob >> 9) & 1) << 5)); }
__host__ __device__ __forceinline__ void stage_rc(int b, int& R, int& C) { const int st = b / 1024, sb = b % 1024, swz = sb ^ (((sb >> 9) & 1) << 5); R = (st >> 1) * 16 + swz / 64; C = (st & 1) * 32 + (swz % 64) / 2; }
__host__ __device__ __forceinline__ int perm32(int rho) { const int n = rho >> 4, i = rho & 15; return 8 * (i >> 2) + 4 * n + (i & 3); }

struct GUnit { const char* a; const char* b; int pm, pn, e, rows; };

__device__ __forceinline__ bool static_unit(int i, int G, int c, int nM, int nN, int& pm, int& pn) {
    const int nwg = nM * nN; const long L = (long)i * G + c; if (L >= nwg) return false;
    int wgid = (int)L; { const int q = nwg / NXCD, r = nwg % NXCD, xcd = wgid % NXCD, off = wgid / NXCD; wgid = (xcd < r ? xcd * (q + 1) : r * (q + 1) + (xcd - r) * q) + off; }
    const int nig = WGM * nN, gid = wgid / nig, fm = gid * WGM, gsz = (nM - fm) < WGM ? (nM - fm) : WGM;
    pm = fm + ((wgid % nig) % gsz); pn = (wgid % nig) / gsz; return true;
}
struct DenseSched {
    static constexpr bool GATHER = false, PARTIAL = false;
    const char* A; const char* Bt; int lda, ldb, nM, nN, G, c;
    __device__ __forceinline__ bool next(int i, GUnit& u) const {
        int pm, pn; if (!static_unit(i, G, c, nM, nN, pm, pn)) return false;
        u.pm = pm; u.pn = pn; u.e = 0; u.rows = 256; u.a = A + (size_t)pm * 256 * lda * 2; u.b = Bt + (size_t)pn * 256 * ldb * 2; return true;
    }
    __device__ __forceinline__ void aoff(const GUnit&, unsigned (&v)[2][2], const int (&R)[2], const int (&C)[2]) const {
#pragma unroll
        for (int h = 0; h < 2; ++h)
#pragma unroll
            for (int i = 0; i < 2; ++i) v[h][i] = (unsigned)((h * 128 + R[i]) * lda + C[i]) * 2u;
    }
};

template <class Epi, class Sched>
__device__ __forceinline__ void gemm_run(LAS unsigned char* lds, const int K, const int ldb, const Sched& S, const Epi& E, int g_wv) {
    int tid_ = TIDX; asm volatile("" : "+v"(tid_));
    const int tid = tid_, wid = __builtin_amdgcn_readfirstlane(tid >> 6), lane = tid & 63, wr = wid >> 2, wc = wid & 3, fr = lane & 15, fq = lane >> 4;
    int nt_ = K / BK; asm volatile("" : "+s"(nt_));
    const int nt = nt_;
    int R[2], C[2]; unsigned voffB[2];
#pragma unroll
    for (int i = 0; i < 2; ++i) { stage_rc(tid * 16 + i * 8192, R[i], C[i]); const int Rb = (R[i] & ~31) + perm32(R[i] & 31); voffB[i] = (unsigned)(Rb * ldb + C[i]) * 2u; }
    const size_t kstep = (size_t)(BK * 2);
    const size_t hstepB = (size_t)HALF * ldb * 2;
    const unsigned ldsw = (unsigned)wid * 1024u;
    const int aoff = lds_byte(wr * 64 + fr, fq * 8), boff = lds_byte(wc * 32 + fr, fq * 8);
#define G8_SA(b, h) (((b) * 2 + (h)) * HTB)
#define G8_SB(b, h) ((4 + (b) * 2 + (h)) * HTB)
#define G8_GLDS(bufoff, gptr, i_) __builtin_amdgcn_global_load_lds((const unsigned*)(gptr), (LAS unsigned*)(lds + (bufoff) + ldsw + (i_) * 8192), 16, 0, 0)
#define G8_STAGE_B(bufoff, gbase) do { G8_GLDS(bufoff, (const char*)(gbase) + voffB[0], 0); G8_GLDS(bufoff, (const char*)(gbase) + voffB[1], 1); } while (0)
#define G8_STAGE_A(bufoff, gbase, v0, v1) do { G8_GLDS(bufoff, (const char*)(gbase) + (v0), 0); G8_GLDS(bufoff, (const char*)(gbase) + (v1), 1); } while (0)
#define G8_LDA(dst, b, h) do { _Pragma("unroll") for (int m = 0; m < 4; ++m) _Pragma("unroll") for (int k = 0; k < 2; ++k) dst[m][k] = *(const LAS bf16x8*)(lds + G8_SA(b, h) + aoff + m * 2048 + k * 1024); } while (0)
#define G8_LDB(dst, b, h) do { _Pragma("unroll") for (int n = 0; n < 2; ++n) _Pragma("unroll") for (int k = 0; k < 2; ++k) dst[n][k] = *(const LAS bf16x8*)(lds + G8_SB(b, h) + boff + n * 2048 + k * 1024); } while (0)
#define G8_MMA(ai, bj, At, Bt) do { __builtin_amdgcn_s_setprio(1); _Pragma("unroll") for (int m = 0; m < 4; ++m) { if (!PARTIAL || ((mmask >> ((ai) * 4 + m)) & 1u)) { _Pragma("unroll") for (int n = 0; n < 2; ++n) _Pragma("unroll") for (int k = 0; k < 2; ++k) \
        acc[ai][bj][m][n] = __builtin_amdgcn_mfma_f32_16x16x32_bf16(Bt[n][k], At[m][k], acc[ai][bj][m][n], 0, 0, 0); } } __builtin_amdgcn_s_setprio(0); } while (0)
#define G8_WAIT_V(n) asm volatile("s_waitcnt vmcnt(" #n ")" ::: "memory")
#define G8_WAIT_L(n) asm volatile("s_waitcnt lgkmcnt(" #n ")" ::: "memory")
#define G8_BAR __builtin_amdgcn_s_barrier()
#define G8_SCHED __builtin_amdgcn_sched_barrier(0)
    GUnit cur, nxt; int ui = 0;
    if (!S.next(0, cur)) return;
    constexpr bool GATHER = Sched::GATHER, PARTIAL = Sched::PARTIAL;
    unsigned mmask = 0xffu;
#define G8_MASK(u) do { if (PARTIAL) { mmask = 0u; _Pragma("unroll") for (int q_ = 0; q_ < 8; ++q_) mmask |= (((q_ >> 2) * 128 + wr * 64 + (q_ & 3) * 16) < (u).rows) ? (1u << q_) : 0u; } } while (0)
    unsigned vc[2][2];
    S.aoff(cur, vc, R, C); G8_MASK(cur);
    LAS u32x4* stash = (LAS u32x4*)(lds + STAGE_BYTES + 4096) + tid;
    f32x4 acc[2][2][4][2];
#pragma unroll
    for (int a = 0; a < 2; ++a)
#pragma unroll
        for (int b = 0; b < 2; ++b)
#pragma unroll
            for (int m = 0; m < 4; ++m)
#pragma unroll
                for (int n = 0; n < 2; ++n) acc[a][b][m][n] = (f32x4){0.f, 0.f, 0.f, 0.f};
    bf16x8 At[4][2], B0[2][2], B1[2][2];
    const char* cA = cur.a; const char* cB = cur.b;
    G8_STAGE_B(G8_SB(0, 0), cB); G8_STAGE_B(G8_SB(0, 1), cB + hstepB); G8_STAGE_A(G8_SA(0, 0), cA, vc[0][0], vc[0][1]); G8_STAGE_A(G8_SA(0, 1), cA, vc[1][0], vc[1][1]);
    if (wr == 1) G8_BAR;
    G8_WAIT_V(2); G8_BAR;
    G8_STAGE_B(G8_SB(1, 0), cB + kstep); G8_STAGE_A(G8_SA(1, 0), cA + kstep, vc[0][0], vc[0][1]); G8_STAGE_B(G8_SB(1, 1), cB + hstepB + kstep);
    G8_WAIT_V(6); G8_BAR;
    for (;;) {
        const bool has_next = S.next(ui + 1, nxt);
        if (GATHER) { unsigned vn[2][2];
            if (has_next) S.aoff(nxt, vn, R, C);
            else { vn[0][0] = vc[0][0]; vn[0][1] = vc[0][1]; vn[1][0] = vc[1][0]; vn[1][1] = vc[1][1]; }
            u32x4 sv; sv.x = vn[0][0]; sv.y = vn[0][1]; sv.z = vn[1][0]; sv.w = vn[1][1]; *stash = sv; }
        const char* nA = has_next ? nxt.a : cA; const char* nB = has_next ? nxt.b : cB;
#pragma unroll 1
        for (int seg = 0; seg < (Epi::KHOOK ? 3 : 1); ++seg) {
        const int tlo = Epi::KHOOK ? 6 * seg : 0, thi = Epi::KHOOK ? (seg == 2 ? nt : 6 * seg + 6) : nt;
#pragma unroll 1
        for (int t = tlo; t < thi; t += 2) {
            const bool last = (t == nt - 2);
            const char* a1 = cA + (size_t)(t + 1) * kstep;
            const char* a2 = last ? nA : cA + (size_t)(t + 2) * kstep; const char* b2 = last ? nB : cB + (size_t)(t + 2) * kstep;
            const char* a3 = a2 + kstep; const char* b3 = b2 + kstep;
            unsigned w00 = vc[0][0], w01 = vc[0][1], w10 = vc[1][0], w11 = vc[1][1];
            if (GATHER) { if (last) { const u32x4 sv = *stash; w00 = sv.x; w01 = sv.y; w10 = sv.z; w11 = sv.w; } }
            G8_LDB(B0, 0, 0); G8_LDB(B1, 0, 1); G8_SCHED; G8_LDA(At, 0, 0); G8_STAGE_A(G8_SA(1, 1), a1, vc[1][0], vc[1][1]);
            G8_WAIT_V(8); G8_WAIT_L(0); G8_BAR; G8_MMA(0, 0, At, B0); G8_MMA(0, 1, At, B1); G8_BAR; G8_SCHED;
            G8_LDA(At, 0, 1); G8_STAGE_B(G8_SB(0, 0), b2); G8_STAGE_B(G8_SB(0, 1), b2 + hstepB); G8_STAGE_A(G8_SA(0, 0), a2, w00, w01);
            G8_WAIT_V(8); G8_WAIT_L(0); G8_BAR; G8_MMA(1, 0, At, B0); G8_MMA(1, 1, At, B1); G8_BAR; G8_SCHED;
            G8_LDB(B0, 1, 0); G8_LDB(B1, 1, 1); G8_SCHED; G8_LDA(At, 1, 0); G8_STAGE_A(G8_SA(0, 1), a2, w10, w11);
            G8_WAIT_V(8); G8_WAIT_L(0); G8_BAR; G8_MMA(0, 0, At, B0); G8_MMA(0, 1, At, B1); G8_BAR; G8_SCHED;
            G8_LDA(At, 1, 1); G8_STAGE_B(G8_SB(1, 0), b3); G8_STAGE_B(G8_SB(1, 1), b3 + hstepB); G8_STAGE_A(G8_SA(1, 0), a3, w00, w01);
            G8_WAIT_V(8); G8_WAIT_L(0); G8_BAR; G8_MMA(1, 0, At, B0); G8_MMA(1, 1, At, B1); G8_BAR; G8_SCHED;
        }
        if constexpr (Epi::KHOOK) { if (seg < 2) E.kscale(acc, seg, wr, fr); }
        }
        if (wr == 0) G8_BAR;
        { int fr_ = fr, fq_ = fq; asm volatile("" : "+v"(fr_), "+v"(fq_));
          E(acc, cur, wr, wc, fr_, fq_); }
        if (!has_next) break;
#pragma unroll
        for (int a = 0; a < 2; ++a)
#pragma unroll
            for (int b = 0; b < 2; ++b)
#pragma unroll
                for (int m = 0; m < 4; ++m)
#pragma unroll
                    for (int n = 0; n < 2; ++n) acc[a][b][m][n] = (f32x4){0.f, 0.f, 0.f, 0.f};
        cur = nxt; cA = nA; cB = nB; ++ui; G8_MASK(cur);
        if (GATHER) { const u32x4 sv = *stash; vc[0][0] = sv.x; vc[0][1] = sv.y; vc[1][0] = sv.z; vc[1][1] = sv.w; }
        if (wr == 1) G8_BAR;
    }
    G8_WAIT_V(0);
    G8_BAR;
#undef G8_SA
#undef G8_SB
#undef G8_GLDS
#undef G8_STAGE_A
#undef G8_STAGE_B
#undef G8_LDA
#undef G8_LDB
#undef G8_MMA
#undef G8_MASK
#undef G8_WAIT_V
#undef G8_WAIT_L
#undef G8_BAR
#undef G8_SCHED
}
}
using g8::GUnit;
__device__ __forceinline__ void st_bf16x8(bf16_t* p, const float (&v)[8]) { u32x4 w; w.x = pk_bf16(v[0], v[1]); w.y = pk_bf16(v[2], v[3]); w.z = pk_bf16(v[4], v[5]); w.w = pk_bf16(v[6], v[7]); *(u32x4*)p = w; }
__device__ __forceinline__ float quad_sum(float s) { s += __shfl_xor(s, 16); s += __shfl_xor(s, 32); return s; }

struct EpiInProj {
    static constexpr bool KHOOK = false;
    const float* ssqx; float* part_dq; float* part_dkv; const float* qg; const float* kg; const float* krg; const float* rope;
    unsigned char* prj;
    __device__ __forceinline__ void operator()(const f32x4 (&acc)[2][2][4][2], const GUnit& u, int wr, int wc, int fr, int fq) const {
        const int G = u.pn * 4 + wc;
        const bool isq = G < 6; const int a = G - 6; const bool isk = (G >= 10 && G < 18 && ((a >> 1) & 1) == 0);
        const float* g0 = (isq ? qg : kg) + 8 * fq;
        float rs8[8];
#pragma unroll
        for (int k = 0; k < 8; ++k) rs8[k] = ssqx[u.pm * 256 + (k >> 2) * 128 + wr * 64 + (k & 3) * 16 + fr];
#pragma unroll
        for (int k = 0; k < 8; ++k) rs8[k] = rsqrtf(rs8[k] * (1.f / 1024.f) + 1e-6f);
#pragma unroll
        for (int ai = 0; ai < 2; ++ai)
#pragma unroll
            for (int m = 0; m < 4; ++m) {
                __builtin_amdgcn_sched_barrier(0);
                const int row = u.pm * 256 + ai * 128 + wr * 64 + m * 16 + fr; const int b = row >> 11, t = row & 2047;
                const float rs = rs8[ai * 4 + m];
                float v[2][8];
#pragma unroll
                for (int bj = 0; bj < 2; ++bj)
#pragma unroll
                    for (int n = 0; n < 2; ++n)
#pragma unroll
                        for (int j = 0; j < 4; ++j) v[bj][4 * n + j] = acc[ai][bj][m][n][j] * rs;
                float ss = 0.f;
#pragma unroll
                for (int bj = 0; bj < 2; ++bj)
#pragma unroll
                    for (int i = 0; i < 8; ++i) ss += v[bj][i] * v[bj][i];
                bf16_t* dst = nullptr; int bstride = 32;
                if (isq) {
                    ss = quad_sum(ss); const float sc = rsqrtf(ss * (1.f / 64.f) + 1e-6f) * 0.18033688f;
#pragma unroll
                    for (int i = 0; i < 8; ++i) { v[0][i] *= sc * g0[i]; v[1][i] *= sc * g0[32 + i]; }
                    dst = (bf16_t*)(prj + PRJ_QN) + ((size_t)(b * 6 + G) * 2048 + t) * 64;
                } else if (G < 18) {
                    const int br = a >> 2, s = (a >> 1) & 1, hk = a & 1;
                    if (br > 0 && s == 0) {
                        ss = quad_sum(ss); const float sc = rsqrtf(ss * (1.f / 64.f) + 1e-6f);
#pragma unroll
                        for (int i = 0; i < 8; ++i) { v[0][i] *= sc * g0[i]; v[1][i] *= sc * g0[32 + i]; }
                    }
                    const size_t base = br == 0 ? (s ? PRJ_C0V : PRJ_C0K) : (br == 1 ? (s ? PRJ_VN1 : PRJ_KN1) : (s ? PRJ_VN2 : PRJ_KN2));
                    dst = (bf16_t*)(prj + base) + ((size_t)(b * 2 + hk) * 2048 + t) * 64;
                } else if (G < 26) { dst = (bf16_t*)(prj + PRJ_RAWQK) + (size_t)row * 512 + (G - 18) * 64; }
                else if (G < 30) { dst = (bf16_t*)(prj + PRJ_VML) + ((size_t)(b * 4 + (G - 26)) * 2048 + t) * 64; }
                else if (G < 34) { dst = (bf16_t*)(prj + PRJ_OG) + (size_t)row * 256 + (G - 30) * 64; }
                else if (G < 37) { dst = (bf16_t*)(prj + PRJ_DQKV) + (size_t)row * 384 + (G - 34) * 64; ss = quad_sum(ss); if (fq == 0) part_dq[(size_t)row * 4 + (G - 34)] = ss; }
                else if (G == 37) {
                    dst = (bf16_t*)(prj + PRJ_DQKV) + (size_t)row * 384 + 192;
                    float* gt = (float*)(prj + PRJ_GATES) + (size_t)row * 32 + 8 * fq;
                    *(f32x4*)gt = (f32x4){v[1][0], v[1][1], v[1][2], v[1][3]}; *(f32x4*)(gt + 4) = (f32x4){v[1][4], v[1][5], v[1][6], v[1][7]};
                    float s0 = 0.f;
#pragma unroll
                    for (int i = 0; i < 8; ++i) s0 += v[0][i] * v[0][i];
                    s0 = quad_sum(s0); const float sc = rsqrtf(s0 * (1.f / 32.f) + 1e-6f);
                    const float* rp = rope + (size_t)row * 32 + ((8 * fq) & 15);
                    float kr[8];
#pragma unroll
                    for (int i = 0; i < 8; ++i) { const float val = v[0][i] * sc * krg[8 * fq + i]; const float oth = __shfl_xor(val, 32); const float cs = rp[i], sn = rp[16 + i]; kr[i] = fq < 2 ? val * cs - oth * sn : val * cs + oth * sn; }
                    st_bf16x8((bf16_t*)(prj + PRJ_KR) + (size_t)row * 32 + 8 * fq, kr);
                } else { dst = (bf16_t*)(prj + PRJ_DQKV) + (size_t)row * 384 + 256 + (G - 38) * 64; ss = quad_sum(ss); if (fq == 0) part_dkv[(size_t)row * 2 + (G - 38)] = ss; }
                st_bf16x8(dst + 8 * fq, v[0]); st_bf16x8(dst + bstride + 8 * fq, v[1]);
            }
    }
};

struct EpiUq {
    static constexpr bool KHOOK = false;
    const float* ssq_dq; const float* qkn; const float* rope; bf16_t* QM;
    __device__ __forceinline__ void operator()(const f32x4 (&acc)[2][2][4][2], const GUnit& u, int wr, int wc, int fr, int fq) const {
        const int G = u.pn * 4 + wc; if (G >= 9) return;
        const float scale = 0.14724444f;
        const float* g0 = G < 6 ? qkn + 8 * fq : qkn + 64 + 8 * (fq & 1); const float* g1 = G < 6 ? g0 + 32 : g0 + 16;
        float rs8[8];
#pragma unroll
        for (int k = 0; k < 8; ++k) { const f32x4 pq = *(const f32x4*)(ssq_dq + (size_t)(u.pm * 256 + (k >> 2) * 128 + wr * 64 + (k & 3) * 16 + fr) * 4); rs8[k] = (pq.x + pq.y) + pq.z; }
#pragma unroll
        for (int k = 0; k < 8; ++k) rs8[k] = rsqrtf(rs8[k] * (1.f / 192.f) + 1e-6f);
#pragma unroll
        for (int ai = 0; ai < 2; ++ai)
#pragma unroll
            for (int m = 0; m < 4; ++m) {
                __builtin_amdgcn_sched_barrier(0);
                const int row = u.pm * 256 + ai * 128 + wr * 64 + m * 16 + fr; const int b = row >> 11, t = row & 2047;
                const float rs = rs8[ai * 4 + m];
                float v[2][8]; float ss = 0.f;
#pragma unroll
                for (int bj = 0; bj < 2; ++bj)
#pragma unroll
                    for (int n = 0; n < 2; ++n)
#pragma unroll
                        for (int j = 0; j < 4; ++j) { const float x = acc[ai][bj][m][n][j] * rs; v[bj][4 * n + j] = x; ss += x * x; }
                if (G < 6) ss = quad_sum(ss); else ss += __shfl_xor(ss, 16);
                const float sc = rsqrtf(ss * (G < 6 ? 1.f / 64.f : 1.f / 32.f) + 1e-6f) * scale;
#pragma unroll
                for (int i = 0; i < 8; ++i) { v[0][i] *= sc * g0[i]; v[1][i] *= sc * g1[i]; }
                if (G < 6) {
                    bf16_t* dst = QM + ((size_t)(b * 6 + G) * 2048 + t) * 96;
                    st_bf16x8(dst + 8 * fq, v[0]); st_bf16x8(dst + 32 + 8 * fq, v[1]);
                } else {
                    const int i16 = 8 * (fq & 1); const int head = 2 * (G - 6) + (fq >> 1);
                    const float* rp = rope + (size_t)row * 32 + i16; float o1[8], o2[8];
#pragma unroll
                    for (int i = 0; i < 8; ++i) { const float cs = rp[i], sn = rp[16 + i]; o1[i] = v[0][i] * cs - v[1][i] * sn; o2[i] = v[1][i] * cs + v[0][i] * sn; }
                    bf16_t* dst = QM + ((size_t)(b * 6 + head) * 2048 + t) * 96 + 64 + i16;
                    st_bf16x8(dst, o1); st_bf16x8(dst + 16, o2);
                }
            }
    }
};
struct EpiUkv {
    static constexpr bool KHOOK = false;
    const float* ssq_dkv; const float* qkn; const bf16_t* KR; bf16_t* KM; bf16_t* VM;
    __device__ __forceinline__ void operator()(const f32x4 (&acc)[2][2][4][2], const GUnit& u, int wr, int wc, int fr, int fq) const {
        const int G = u.pn * 4 + wc;
        const float* g0 = qkn + 96 + 8 * fq;
        float rs8[8];
#pragma unroll
        for (int k = 0; k < 8; ++k) { const size_t rr = (size_t)(u.pm * 256 + (k >> 2) * 128 + wr * 64 + (k & 3) * 16 + fr); rs8[k] = ssq_dkv[rr * 2] + ssq_dkv[rr * 2 + 1]; }
#pragma unroll
        for (int k = 0; k < 8; ++k) rs8[k] = rsqrtf(rs8[k] * (1.f / 128.f) + 1e-6f);
#pragma unroll
        for (int ai = 0; ai < 2; ++ai)
#pragma unroll
            for (int m = 0; m < 4; ++m) {
                __builtin_amdgcn_sched_barrier(0);
                const int row = u.pm * 256 + ai * 128 + wr * 64 + m * 16 + fr; const int b = row >> 11, t = row & 2047;
                const float rs = rs8[ai * 4 + m];
                float v[2][8]; float ss = 0.f;
#pragma unroll
                for (int bj = 0; bj < 2; ++bj)
#pragma unroll
                    for (int n = 0; n < 2; ++n)
#pragma unroll
                        for (int j = 0; j < 4; ++j) { const float x = acc[ai][bj][m][n][j] * rs; v[bj][4 * n + j] = x; ss += x * x; }
                if (G < 6) {
                    ss = quad_sum(ss); const float sc = rsqrtf(ss * (1.f / 64.f) + 1e-6f);
#pragma unroll
                    for (int i = 0; i < 8; ++i) { v[0][i] *= sc * g0[i]; v[1][i] *= sc * g0[32 + i]; }
                    bf16_t* dst = KM + ((size_t)(b * 6 + G) * 2048 + t) * 96;
                    st_bf16x8(dst + 8 * fq, v[0]); st_bf16x8(dst + 32 + 8 * fq, v[1]);
                    *(u32x4*)(dst + 64 + 8 * fq) = *(const u32x4*)(KR + (size_t)row * 32 + 8 * fq);
                } else {
                    bf16_t* dst = VM + ((size_t)(b * 6 + (G - 6)) * 2048 + t) * 64;
                    st_bf16x8(dst + 8 * fq, v[0]); st_bf16x8(dst + 32 + 8 * fq, v[1]);
                }
            }
    }
};
#define MFMA16(a, b, c) __builtin_amdgcn_mfma_f32_16x16x32_bf16(a, b, c, 0, 0, 0)
#define MFMA32(a, b, c) __builtin_amdgcn_mfma_f32_32x32x16_bf16(a, b, c, 0, 0, 0)
#define LDS_FENCE() asm volatile("s_waitcnt lgkmcnt(0)" ::: "memory")

__device__ __forceinline__ void cmp_unit(int u, int l, InPtr in, unsigned char* ws, LAS unsigned char* lds, int g_wv) {
    int tid_ = TIDX; asm volatile("" : "+v"(tid_));
    const int tid = tid_, w = tid >> 6, lane = tid & 63, r = lane & 15, q = lane >> 4;
    const int b = u >> 2, s = (u >> 1) & 1, hk = u & 1;
    const bf16_t* A = (const bf16_t*)(ws + WS_PRJ + (s ? PRJ_C0V : PRJ_C0K)) + (size_t)(b * 2 + hk) * 2048 * 64;
    const bf16_t* W1 = (const bf16_t*)(ws + WS_WC1) + ((size_t)l * 2 + s) * 64 * 2048;
    const bf16_t* W2 = (const bf16_t*)(ws + WS_WC2) + ((size_t)l * 2 + s) * 64 * 64;
    const float* b1 = (const float*)(ws + WS_B1C) + (l * 2 + s) * 64;
    f32x4 acc[4];
#pragma unroll
    for (int nb = 0; nb < 4; ++nb) acc[nb] = (f32x4){0.f, 0.f, 0.f, 0.f};
    const bf16_t* ap = A + (size_t)(16 * w + r) * 1024 + 8 * q;
    constexpr int WP = 528, WBUF = 64 * WP; LAS unsigned char* wb = lds + 24576;
    u32x4 st[4];
#pragma unroll
    for (int i = 0; i < 4; ++i) { const int c = tid + 512 * i; st[i] = *(const u32x4*)(W1 + (size_t)(c >> 5) * 2048 + (c & 31) * 8); }
    bf16x8 af[8], afn[8];
#pragma unroll
    for (int ks = 0; ks < 8; ++ks) af[ks] = *(const bf16x8*)(ap + 32 * ks);
    const float* kg = in->p[9] + l * 64;
    float b1v[4], kgv[4]; bf16x8 w2f[2][4];
#pragma unroll
    for (int nb = 0; nb < 4; ++nb) { b1v[nb] = b1[16 * nb + r]; kgv[nb] = kg[16 * nb + r]; }
#pragma unroll
    for (int ks = 0; ks < 2; ++ks)
#pragma unroll
        for (int nb = 0; nb < 4; ++nb) w2f[ks][nb] = *(const bf16x8*)(W2 + (size_t)(16 * nb + r) * 64 + 32 * ks + 8 * q);
#pragma unroll
    for (int i = 0; i < 4; ++i) { const int c = tid + 512 * i; *(LAS u32x4*)(wb + (c >> 5) * WP + (c & 31) * 16) = st[i]; }
    __syncthreads();
    auto chunk = [&](const int kc, bf16x8 (&ac)[8], bf16x8 (&an)[8]) __attribute__((always_inline)) {
        const int cur = kc & 1;
        if (kc < 7) {
#pragma unroll
            for (int i = 0; i < 4; ++i) { const int c = tid + 512 * i; st[i] = *(const u32x4*)(W1 + (size_t)(c >> 5) * 2048 + (kc + 1) * 256 + (c & 31) * 8); }
#pragma unroll
            for (int ks = 0; ks < 8; ++ks) an[ks] = *(const bf16x8*)(ap + 256 * (kc + 1) + 32 * ks);
        }
#pragma unroll
        for (int ks = 0; ks < 8; ++ks)
#pragma unroll
            for (int nb = 0; nb < 4; ++nb) { const bf16x8 bb = *(const LAS bf16x8*)(wb + cur * WBUF + (16 * nb + r) * WP + (32 * ks + 8 * q) * 2); acc[nb] = MFMA16(ac[ks], bb, acc[nb]); }
        if (kc < 7) {
#pragma unroll
            for (int i = 0; i < 4; ++i) { const int c = tid + 512 * i; *(LAS u32x4*)(wb + (cur ^ 1) * WBUF + (c >> 5) * WP + (c & 31) * 16) = st[i]; }
        }
        __syncthreads();
    };
#pragma unroll 1
    for (int kc = 0; kc < 8; kc += 2) { chunk(kc, af, afn); chunk(kc + 1, afn, af); }
    LAS bf16_t* hl = (LAS bf16_t*)(lds + w * 2304);
#pragma unroll
    for (int nb = 0; nb < 4; ++nb) { const float bias = b1v[nb];
#pragma unroll
        for (int j = 0; j < 4; ++j) hl[(4 * q + j) * 72 + 16 * nb + r] = f2bf(siluf(acc[nb][j] + bias)); }
    LDS_FENCE();
    f32x4 o[4];
#pragma unroll
    for (int nb = 0; nb < 4; ++nb) o[nb] = (f32x4){0.f, 0.f, 0.f, 0.f};
#pragma unroll
    for (int ks = 0; ks < 2; ++ks) {
        const bf16x8 a = *(const LAS bf16x8*)(hl + r * 72 + 32 * ks + 8 * q);
#pragma unroll
        for (int nb = 0; nb < 4; ++nb) o[nb] = MFMA16(a, w2f[ks][nb], o[nb]);
    }
    LDS_FENCE();
    bf16_t* dst = (bf16_t*)(ws + WS_CMP + (s ? CMP_V : 0)) + (size_t)(b * 2 + hk) * 128 * 64;
#pragma unroll
    for (int j = 0; j < 4; ++j) {
        const int n = 16 * w + 4 * q + j; float ss = 0.f;
#pragma unroll
        for (int nb = 0; nb < 4; ++nb) ss += o[nb][j] * o[nb][j];
        ss += __shfl_xor(ss, 1); ss += __shfl_xor(ss, 2); ss += __shfl_xor(ss, 4); ss += __shfl_xor(ss, 8);
        const float sc = s == 0 ? rsqrtf(ss * (1.f / 64.f) + 1e-6f) : 1.f;
#pragma unroll
        for (int nb = 0; nb < 4; ++nb) { const int d = 16 * nb + r; const float v = o[nb][j] * sc * (s == 0 ? kgv[nb] : 1.f); dst[(size_t)n * 64 + d] = n < 127 ? f2bf(v) : (bf16_t)0; }
    }
}

__device__ __forceinline__ int swz_off(int row, int chunk) { return row * 128 + ((chunk ^ (row & 7)) << 4); }
__device__ __forceinline__ float log_sigmoid(float x) { return fminf(x, 0.f) - log1pf(__expf(-fabsf(x))); }
__device__ __forceinline__ void ml_delta_wave(int cu, int l, InPtr in, unsigned char* ws, LAS unsigned char* wl, int lane) {
    asm volatile("" : "+v"(lane));
    const int c = cu & 31, bh = cu >> 5, h = bh & 3, b = bh >> 2; const int t0 = c * 64; const size_t row0 = (size_t)b * 2048 + t0;
    const int cc = lane & 7, tg = lane >> 3;
    const bf16_t* raw = (const bf16_t*)(ws + WS_PRJ + PRJ_RAWQK); const float* cw = in->p[11] + (size_t)l * 4 * 512 + h * 64 + 8 * cc;
    u32x4 rq[11];
    const bool head0 = (c == 0 && tg == 0);
#pragma unroll
    for (int i = 0; i < 11; ++i) { const size_t rr = (head0 && i < 3) ? row0 : row0 + 8 * tg - 3 + i; rq[i] = *(const u32x4*)(raw + rr * 512 + h * 64 + 8 * cc); }
    __builtin_amdgcn_sched_barrier(0);
    const float* G = (const float*)(ws + WS_PRJ + PRJ_GATES);
    const float ip = G[(row0 + lane) * 32 + 18 + h] + in->p[12][l * 4 + h], fp = G[(row0 + lane) * 32 + 22 + h] + in->p[13][l * 4 + h];
    float bcum = log_sigmoid(fp);
#pragma unroll
    for (int o = 1; o < 64; o <<= 1) { const float t = __builtin_bit_cast(float, __builtin_amdgcn_ds_bpermute(((lane - o) & 63) << 2, __builtin_bit_cast(int, bcum))); if (lane >= o) bcum += t; }
    const float bL = __builtin_bit_cast(float, __builtin_amdgcn_readlane(__builtin_bit_cast(int, bcum), 63)); const float wgt = __expf(bL - bcum + ip);
    { float* mlg = (float*)(ws + WS_ML + ML_G) + ((size_t)bh * 2048 + t0 + lane) * 2; mlg[0] = bcum; mlg[1] = ip; if (lane == 0) ((float*)(ws + WS_ML + ML_BL))[cu] = bL; }
    float wt[8];
#pragma unroll
    for (int j = 0; j < 8; ++j) wt[j] = __builtin_bit_cast(float, __builtin_amdgcn_ds_bpermute((8 * tg + j) << 2, __builtin_bit_cast(int, wgt)));
    if (head0) {
#pragma unroll
        for (int i = 0; i < 3; ++i) rq[i] = (u32x4){0u, 0u, 0u, 0u}; }
#define MLD_E(v, e) (((e) & 1) ? bf_hi(((e) >> 1) == 0 ? (v).x : ((e) >> 1) == 1 ? (v).y : ((e) >> 1) == 2 ? (v).z : (v).w) : bf_lo(((e) >> 1) == 0 ? (v).x : ((e) >> 1) == 1 ? (v).y : ((e) >> 1) == 2 ? (v).z : (v).w))
    bf16_t* QC = (bf16_t*)(ws + WS_ML) + ((size_t)bh * 2048 + t0 + 8 * tg) * 64 + 8 * cc; bf16_t* KC = (bf16_t*)(ws + WS_ML + ML_KC) + ((size_t)bh * 2048 + t0 + 8 * tg) * 64 + 8 * cc;
    u32x4 rk[11], vv[8];
#pragma unroll
    for (int i = 0; i < 11; ++i) { const size_t rr = (head0 && i < 3) ? row0 : row0 + 8 * tg - 3 + i; rk[i] = *(const u32x4*)(raw + rr * 512 + h * 64 + 8 * cc + 256); }
    { const bf16_t* V = (const bf16_t*)(ws + WS_PRJ + PRJ_VML) + ((size_t)bh * 2048 + t0 + 8 * tg) * 64 + 8 * cc;
#pragma unroll
      for (int j = 0; j < 8; ++j) vv[j] = *(const u32x4*)(V + (size_t)j * 64); }
    if (head0) {
#pragma unroll
        for (int i = 0; i < 3; ++i) rk[i] = (u32x4){0u, 0u, 0u, 0u}; }
    __builtin_amdgcn_sched_barrier(0);
    {
        float w4[4][8];
#pragma unroll
        for (int tp = 0; tp < 4; ++tp) { const f32x4 a = *(const f32x4*)(cw + tp * 512), b4 = *(const f32x4*)(cw + tp * 512 + 4); w4[tp][0] = a.x; w4[tp][1] = a.y; w4[tp][2] = a.z; w4[tp][3] = a.w; w4[tp][4] = b4.x; w4[tp][5] = b4.y; w4[tp][6] = b4.z; w4[tp][7] = b4.w; }
#pragma unroll
        for (int j = 0; j < 8; ++j) { float o[8];
#pragma unroll
            for (int e = 0; e < 8; ++e) o[e] = siluf(w4[0][e] * MLD_E(rq[j], e) + w4[1][e] * MLD_E(rq[j + 1], e) + w4[2][e] * MLD_E(rq[j + 2], e) + w4[3][e] * MLD_E(rq[j + 3], e));
            u32x4 pk; pk.x = pk_bf16(o[0], o[1]); pk.y = pk_bf16(o[2], o[3]); pk.z = pk_bf16(o[4], o[5]); pk.w = pk_bf16(o[6], o[7]);
            *(u32x4*)(QC + (size_t)j * 64) = pk; }
    }
    float dn[8];
    {
        float w4[4][8];
#pragma unroll
        for (int tp = 0; tp < 4; ++tp) { const f32x4 a = *(const f32x4*)(cw + 256 + tp * 512), b4 = *(const f32x4*)(cw + 256 + tp * 512 + 4); w4[tp][0] = a.x; w4[tp][1] = a.y; w4[tp][2] = a.z; w4[tp][3] = a.w; w4[tp][4] = b4.x; w4[tp][5] = b4.y; w4[tp][6] = b4.z; w4[tp][7] = b4.w; }
#pragma unroll
        for (int e = 0; e < 8; ++e) dn[e] = 0.f;
#pragma unroll
        for (int j2 = 0; j2 < 4; ++j2) { float kb[2][8];
#pragma unroll
            for (int jj = 0; jj < 2; ++jj) { const int j = 2 * j2 + jj; float o[8];
#pragma unroll
                for (int e = 0; e < 8; ++e) o[e] = siluf(w4[0][e] * MLD_E(rk[j], e) + w4[1][e] * MLD_E(rk[j + 1], e) + w4[2][e] * MLD_E(rk[j + 2], e) + w4[3][e] * MLD_E(rk[j + 3], e)) * 0.125f;
                u32x4 pk; pk.x = pk_bf16(o[0], o[1]); pk.y = pk_bf16(o[2], o[3]); pk.z = pk_bf16(o[4], o[5]); pk.w = pk_bf16(o[6], o[7]);
                *(u32x4*)(KC + (size_t)j * 64) = pk;
#pragma unroll
                for (int e = 0; e < 8; ++e) { kb[jj][e] = MLD_E(pk, e); dn[e] += wt[j] * kb[jj][e]; } }
#pragma unroll
            for (int e = 0; e < 8; ++e) { *(LAS unsigned*)(wl + swz_off(8 * cc + e, tg) + 4 * j2) = pk_bf16(kb[0][e], kb[1][e]);
                *(LAS unsigned*)(wl + 8192 + swz_off(8 * cc + e, tg) + 4 * j2) = pk_bf16(wt[2 * j2] * MLD_E(vv[2 * j2], e), wt[2 * j2 + 1] * MLD_E(vv[2 * j2 + 1], e)); } }
    }
#undef MLD_E
#pragma unroll
    for (int e = 0; e < 8; ++e) { dn[e] += __shfl_xor(dn[e], 8); dn[e] += __shfl_xor(dn[e], 16); dn[e] += __shfl_xor(dn[e], 32); }
    if (tg == 0) { float* DN = (float*)(ws + WS_ML + ML_DN) + (size_t)cu * 64 + 8 * cc; *(f32x4*)DN = (f32x4){dn[0], dn[1], dn[2], dn[3]}; *(f32x4*)(DN + 4) = (f32x4){dn[4], dn[5], dn[6], dn[7]}; }
    LDS_FENCE();
    const int r = lane & 15, q = lane >> 4;
    bf16_t* DL = (bf16_t*)(ws + WS_ML + ML_DELTA) + (size_t)cu * 4096;
    f32x4 acc[4][4];
#pragma unroll
    for (int mb = 0; mb < 4; ++mb) {
#pragma unroll
        for (int nb = 0; nb < 4; ++nb) acc[mb][nb] = (f32x4){0.f, 0.f, 0.f, 0.f};
#pragma unroll
        for (int ks = 0; ks < 2; ++ks) {
            const bf16x8 a = *(const LAS bf16x8*)(wl + 8192 + swz_off(16 * mb + r, 4 * ks + q));
#pragma unroll
            for (int nb = 0; nb < 4; ++nb) { const bf16x8 bb = *(const LAS bf16x8*)(wl + swz_off(16 * nb + r, 4 * ks + q)); acc[mb][nb] = MFMA16(a, bb, acc[mb][nb]); }
        }
    }
    LDS_FENCE();
#pragma unroll
    for (int mb = 0; mb < 4; ++mb)
#pragma unroll
        for (int nb = 0; nb < 4; ++nb)
#pragma unroll
            for (int j = 0; j < 4; ++j) { const int row = 16 * mb + 4 * q + j, col = 16 * nb + r; *(LAS bf16_t*)(wl + swz_off(row, col >> 3) + (col & 7) * 2) = f2bf(acc[mb][nb][j]); }
    LDS_FENCE();
#pragma unroll
    for (int i = 0; i < 8; ++i) { const int ch = lane + 64 * i; *(u32x4*)(DL + (size_t)ch * 8) = *(const LAS u32x4*)(wl + swz_off(ch >> 3, ch & 7)); }
    LDS_FENCE();
}

#ifndef TIME_PH
#define TIME_PH -1
#endif
#define PSTAMP(i, blk) do { if (TIME_PH != -1 && l == 0 && blockIdx.x == (blk) && TIDX == 0) ((unsigned long long*)((unsigned*)(ws + WS_CTL) + CW_TS))[i] = __builtin_amdgcn_s_memrealtime(); } while (0)
#ifndef DUP_DELTA
#define DUP_DELTA 1
#endif
__device__ __forceinline__ void phase_prep(int l, InPtr in, unsigned char* ws, LAS unsigned char* lds, int bid, int nb, int g_wv, unsigned* dq) {
    asm volatile("" : "+s"(bid));
    PSTAMP(40, 0);
#ifndef NO_UQ
    { g8::DenseSched S{(const char*)(ws + WS_PRJ + PRJ_DQKV), (const char*)(ws + WS_WUQ) + (size_t)l * 768 * 256 * 2, 384, 256, 64, 3, nb, bid};
      EpiUq E{(const float*)(ws + WS_SSQ + PT_DQ) + (size_t)l * 16384 * 4, in->p[19] + l * 192, (const float*)(ws + WS_ROPE), (bf16_t*)(ws + WS_MLA)};
      g8::gemm_run(lds, 256, 256, S, E, g_wv); }
#endif
    PSTAMP(41, 0);
#ifndef NO_UKV
    asm volatile("" : "+s"(bid));
    { g8::DenseSched S{(const char*)(ws + WS_PRJ + PRJ_DQKV) + 256, (const char*)(ws + WS_WUKV) + (size_t)l * 768 * 256 * 2, 384, 256, 64, 3, nb, nb == 256 ? ((bid + 64) & 255) : bid};
      EpiUkv E{(const float*)(ws + WS_SSQ + PT_DKV) + (size_t)l * 16384 * 2, in->p[19] + l * 192, (const bf16_t*)(ws + WS_PRJ + PRJ_KR), (bf16_t*)(ws + WS_MLA + MLA_KM), (bf16_t*)(ws + WS_MLA + MLA_VM)};
      g8::gemm_run(lds, 256, 256, S, E, g_wv); }
#endif
    PSTAMP(42, 0); PSTAMP(44, 255);
    __syncthreads();
#ifndef NO_CMP
#ifndef DUP_CMP
#define DUP_CMP 1
#endif
    for (int u = (nb == 256 ? (bid >= 128 && bid < 160 ? bid - 128 : 32) : nb - 1 - bid); u < 32; u += nb) for (int rp_ = 0; rp_ < DUP_CMP; ++rp_) { if (rp_) __syncthreads(); cmp_unit(u, l, in, ws, lds, g_wv); }
#endif
    PSTAMP(45, 255);
    __syncthreads();
#ifndef NO_DELTA
    { int tid_ = TIDX; asm volatile("" : "+v"(tid_)); LAS int* slot = (LAS int*)(lds + LDS_MISC + 64);
      for (;;) {
          __syncthreads();
          if (tid_ == 0) *slot = (int)__hip_atomic_fetch_add(dq, 1u, __ATOMIC_RELAXED, __HIP_MEMORY_SCOPE_AGENT);
          __syncthreads();
          const int g = *slot; if (g >= 96 + 128) break;
          const int wv = tid_ >> 6;
          const int cu_ = g < 96 ? g * 8 + wv : 768 + (g - 96) * 2 + wv;
          if (g < 96 || wv < 2) { for (int rp_ = 0; rp_ < DUP_DELTA; ++rp_) ml_delta_wave(cu_, l, in, ws, lds + wv * 16384, tid_ & 63); }
      } }
#endif
    __syncthreads(); PSTAMP(43, 0);
}
#define CHK_TOL(st) (((st) & 15) == 8 ? 1e-2f : 1e-3f)
#define CHECK_REST
constexpr int VTP = 192;
typedef short v4i16_t __attribute__((ext_vector_type(4)));
__device__ __forceinline__ int vt_lane_off(int lane) { return (4 * (lane >> 5) + ((lane & 15) >> 2)) * VTP + ((((lane >> 4) & 1) * 16) + 4 * (lane & 3)) * 2; }
__device__ __forceinline__ bf16x8 vt_frag(const LAS unsigned char* Vt, int voff, int s4, int eb) {
    const LAS unsigned char* a = Vt + voff + 16 * s4 * VTP + 64 * eb;
    const v4i16_t lo = __builtin_amdgcn_ds_read_tr16_b64_v4i16((LAS v4i16_t*)a), hi = __builtin_amdgcn_ds_read_tr16_b64_v4i16((LAS v4i16_t*)(a + 8 * VTP));
    return (bf16x8){lo[0], lo[1], lo[2], lo[3], hi[0], hi[1], hi[2], hi[3]};
}
__device__ __forceinline__ int crow(int reg, int h) { return (reg & 3) + 8 * (reg >> 2) + 4 * h; }
struct AttnState { f32x16 o[2]; float m, l; };
__device__ __forceinline__ void attn_reset(AttnState& A) { A.m = -1e30f; A.l = 0.f;
#pragma unroll
    for (int i = 0; i < 16; ++i) { A.o[0][i] = 0.f; A.o[1][i] = 0.f; } }

template <int DK>
__device__ __forceinline__ void attn_scores(f32x16 (&s)[2], const bf16x8 (&qf)[DK / 16], const LAS unsigned char* Kt, int r, int h) {
    constexpr int KP = 2 * DK + 16, NK = DK / 16;
    bf16x8 kf[2][NK];
#pragma unroll
    for (int kb = 0; kb < 2; ++kb)
#pragma unroll
        for (int ks = 0; ks < NK; ++ks) kf[kb][ks] = *(const LAS bf16x8*)(Kt + (32 * kb + r) * KP + (16 * ks + 8 * h) * 2);
    __builtin_amdgcn_sched_barrier(0);
#pragma unroll
    for (int kb = 0; kb < 2; ++kb) {
#pragma unroll
        for (int i = 0; i < 16; ++i) s[kb][i] = 0.f;
#pragma unroll
        for (int ks = 0; ks < NK; ++ks) s[kb] = MFMA32(kf[kb][ks], qf[ks], s[kb]);
    }
}
__device__ __forceinline__ float max3f(float a, float b, float c) { return fmaxf(fmaxf(a, b), c); }
__device__ __forceinline__ void attn_softmax_pv(AttnState& A, f32x16 (&s)[2], const LAS unsigned char* Vt, int r, int h, float bias_c = 0.f, bool lane_ok = true) {
    constexpr float THR = 8.f; const int voff = vt_lane_off(r + 32 * h);
    float mx = max3f(s[0][0], s[0][1], s[0][2]);
#pragma unroll
    for (int i = 3; i < 15; i += 2) mx = max3f(mx, s[0][i], s[0][i + 1]);
    mx = max3f(mx, s[0][15], s[1][0]);
#pragma unroll
    for (int i = 1; i < 15; i += 2) mx = max3f(mx, s[1][i], s[1][i + 1]);
    mx = fmaxf(mx, s[1][15]);
    mx = fmaxf(mx, __shfl_xor(mx, 32));
    const float mxb = (lane_ok && mx > -1e29f) ? mx + bias_c : -1e30f;
    const bool grow = mxb > A.m + THR;
    const float mnew = grow ? mxb : A.m;
    if (__any(grow)) {
        const float alpha = __builtin_amdgcn_exp2f(A.m - mnew);
        A.l *= alpha;
#pragma unroll
        for (int i = 0; i < 16; ++i) { A.o[0][i] *= alpha; A.o[1][i] *= alpha; }
    }
    A.m = mnew;
    const float sub = (lane_ok && mnew > -1e29f) ? mnew - bias_c : 1e30f;
    float rs = 0.f;
#pragma unroll
    for (int kb = 0; kb < 2; ++kb)
#pragma unroll
        for (int i = 0; i < 16; ++i) { const float p = __builtin_amdgcn_exp2f(s[kb][i] - sub); s[kb][i] = p; rs += p; }
    rs += __shfl_xor(rs, 32);
    A.l += rs;
    bf16x8 vf[4][2];
#pragma unroll
    for (int s4 = 0; s4 < 4; ++s4)
#pragma unroll
        for (int eb = 0; eb < 2; ++eb) vf[s4][eb] = vt_frag(Vt, voff, s4, eb);
    __builtin_amdgcn_sched_barrier(0);
#pragma unroll
    for (int s4 = 0; s4 < 4; ++s4) {
        const int kb = s4 >> 1, hf = (s4 & 1) * 8;
        u32x4 pw; pw.x = pk_bf16(s[kb][hf + 0], s[kb][hf + 1]); pw.y = pk_bf16(s[kb][hf + 2], s[kb][hf + 3]); pw.z = pk_bf16(s[kb][hf + 4], s[kb][hf + 5]); pw.w = pk_bf16(s[kb][hf + 6], s[kb][hf + 7]);
        const bf16x8 pf = __builtin_bit_cast(bf16x8, pw);
#pragma unroll
        for (int eb = 0; eb < 2; ++eb) A.o[eb] = MFMA32(vf[s4][eb], pf, A.o[eb]);
    }
}
template <int DK>
__device__ __forceinline__ void stage_k_load(u32x4 (&kr)[2], const bf16_t* Kg  , int tid) {
    constexpr int CH = DK / 8;
    kr[0] = *(const u32x4*)(Kg + (size_t)(tid / CH) * DK + (tid % CH) * 8);
    if (64 * CH > 512) { const int c2 = tid + 512; if (c2 < 64 * CH) kr[1] = *(const u32x4*)(Kg + (size_t)(c2 / CH) * DK + (c2 % CH) * 8); }
}
template <int DK>
__device__ __forceinline__ void stage_k_store(const u32x4 (&kr)[2], LAS unsigned char* Kt, int tid) {
    constexpr int CH = DK / 8, KP = 2 * DK + 16;
    *(LAS u32x4*)(Kt + (tid / CH) * KP + (tid % CH) * 16) = kr[0];
    if (64 * CH > 512) { const int c2 = tid + 512; if (c2 < 64 * CH) *(LAS u32x4*)(Kt + (c2 / CH) * KP + (c2 % CH) * 16) = kr[1]; }
}
__device__ __forceinline__ u32x4 stage_v_load(const bf16_t* Vg, int tid) { return *(const u32x4*)(Vg + (size_t)(tid >> 3) * 64 + (tid & 7) * 8); }
__device__ __forceinline__ void stage_v_store(const u32x4& v, LAS unsigned char* Vt, int tid) { *(LAS u32x4*)(Vt + (tid >> 3) * VTP + (tid & 7) * 16) = v; }

constexpr int MLA_KT = 0, MLA_VT = 2 * 64 * 208, MLA_LDS = MLA_VT + 2 * 64 * VTP;
__device__ __forceinline__ void mla_unit(int b, int hd, int qt, int l, unsigned char* ws, LAS unsigned char* lds, int g_wv) {
    int tid_ = TIDX; asm volatile("" : "+v"(tid_));
    const int tid = tid_, w = tid >> 6, lane = tid & 63, r = lane & 31, h = lane >> 5;
    const size_t slab = (size_t)(b * 6 + hd) * 2048;
    const bf16_t* QM = (const bf16_t*)(ws + WS_MLA) + slab * 96; const bf16_t* KM = (const bf16_t*)(ws + WS_MLA + MLA_KM) + slab * 96; const bf16_t* VM = (const bf16_t*)(ws + WS_MLA + MLA_VM) + slab * 64;
    const int q0 = 256 * qt + 32 * w, q = q0 + r;
    bf16x8 qf[6];
#pragma unroll
    for (int ks = 0; ks < 6; ++ks) qf[ks] = *(const bf16x8*)(QM + (size_t)q * 96 + 16 * ks + 8 * h);
    AttnState A; attn_reset(A);
    const int ntile = 4 * qt + 4;
    u32x4 kr[2], vr, kr2[2], vr2;
    stage_k_load<96>(kr, KM, tid); vr = stage_v_load(VM, tid);
    stage_k_store<96>(kr, lds + MLA_KT, tid); stage_v_store(vr, lds + MLA_VT, tid);
    if (ntile > 1) { stage_k_load<96>(kr, KM + (size_t)64 * 96, tid); vr = stage_v_load(VM + (size_t)64 * 64, tid); }
    __syncthreads();
    auto tile_step = [&](const int j, u32x4 (&kc)[2], u32x4& vc, u32x4 (&kn)[2], u32x4& vn) __attribute__((always_inline)) {
        const int cur = j & 1;
        if (j + 2 < ntile) { stage_k_load<96>(kn, KM + (size_t)(j + 2) * 64 * 96, tid); vn = stage_v_load(VM + (size_t)(j + 2) * 64 * 64, tid); }
        if (64 * j <= q0 + 31) {
            f32x16 s[2];
            attn_scores<96>(s, qf, lds + MLA_KT + cur * 64 * 208, r, h);
            if (64 * j + 63 > q0) {
#pragma unroll
                for (int kb = 0; kb < 2; ++kb)
#pragma unroll
                    for (int i = 0; i < 16; ++i) { const int key = 64 * j + 32 * kb + crow(i, h); if (key > q) s[kb][i] = -1e30f; }
            }
            attn_softmax_pv(A, s, lds + MLA_VT + cur * 64 * VTP, r, h);
        }
        if (j + 1 < ntile) { stage_k_store<96>(kc, lds + MLA_KT + (cur ^ 1) * 64 * 208, tid); stage_v_store(vc, lds + MLA_VT + (cur ^ 1) * 64 * VTP, tid); }
        __syncthreads();
    };
#pragma unroll 1
    for (int j = 0; j < ntile; j += 2) { tile_step(j, kr, vr, kr2, vr2); tile_step(j + 1, kr2, vr2, kr, vr); }
    const float inv = A.l > 0.f ? 1.f / A.l : 0.f; float ss = 0.f;
    bf16_t* Y = (bf16_t*)(ws + WS_Y) + ((size_t)b * 2048 + q) * 1024 + 384 + hd * 64;
#pragma unroll
    for (int eb = 0; eb < 2; ++eb)
#pragma unroll
        for (int g4 = 0; g4 < 4; ++g4) {
            const float v0 = A.o[eb][4 * g4] * inv, v1 = A.o[eb][4 * g4 + 1] * inv, v2 = A.o[eb][4 * g4 + 2] * inv, v3 = A.o[eb][4 * g4 + 3] * inv;
            u32x2 pw; pw.x = pk_bf16(v0, v1); pw.y = pk_bf16(v2, v3);
            const float f0 = bf_lo(pw.x), f1 = bf_hi(pw.x), f2 = bf_lo(pw.y), f3 = bf_hi(pw.y); ss += (f0 * f0 + f1 * f1) + (f2 * f2 + f3 * f3);
            *(u32x2*)(Y + 32 * eb + 8 * g4 + 4 * h) = pw;
        }
    ss += __shfl_xor(ss, 32);
    if (h == 0) ((float*)(ws + WS_SSQ + PT_C))[((size_t)l * 16384 + (size_t)b * 2048 + q) * 8 + hd] = ss;
}

__device__ __forceinline__ void nsa_bias32(float (&bv)[2][16], const LAS float* bl, int dd) {
#pragma unroll
    for (int kb = 0; kb < 2; ++kb)
#pragma unroll
        for (int k = 0; k < 16; ++k) { const int c = 63 - (32 * kb + (k & 3) + 8 * (k >> 2)); int d = dd + c; d = d < 0 ? 0 : (d > 255 ? 255 : d); bv[kb][k] = bl[d]; }
}
__device__ __forceinline__ void nsa_mask_bias(f32x16 (&sc)[2], int dq, int h, const LAS float* bl, bool sel, int lim) {
    int dd = dq - 4 * h - 63; asm volatile("" : "+v"(dd));
    float bv[2][16]; nsa_bias32(bv, bl, dd);
#pragma unroll
    for (int kb = 0; kb < 2; ++kb)
#pragma unroll
        for (int k = 0; k < 16; ++k) { const int c = 63 - (32 * kb + (k & 3) + 8 * (k >> 2)); const int d = dd + c; sc[kb][k] = (sel && d >= 0 && d < lim) ? sc[kb][k] + bv[kb][k] : -1e30f; }
}

constexpr int NSA_KT = 0, NSA_VT = 2 * 64 * 144, NSA_BIAS = NSA_VT + 2 * 64 * VTP, NSA_PS = NSA_BIAS + 3 * 256 * 4, NSA_SEL = NSA_PS + 3 * 64 * 32 * 4, NSA_UNI = NSA_SEL + 256, NSA_OT = NSA_UNI + 256, NSA_LDS = NSA_OT + 6 * 8192;
__device__ __forceinline__ void nsa_unit(int b, int hk, int i, int l, InPtr in, unsigned char* ws, LAS unsigned char* lds, int g_wv) {
    int tid_ = TIDX; asm volatile("" : "+v"(tid_));
    const int tid = tid_, w = tid >> 6, lane = tid & 63, r = lane & 31, h = lane >> 5;
    const bool active = w < 6; const int g = active ? (w >> 1) : 0, th = w & 1, head = hk * 3 + g;
    const int t = 64 * i + 32 * th + r, tl = 32 * th + r; const size_t row = (size_t)b * 2048 + t;
    const size_t kvslab = (size_t)(b * 2 + hk) * 2048 * 64;
    LAS float* biasl = (LAS float*)(lds + NSA_BIAS); LAS float* PS = (LAS float*)(lds + NSA_PS); LAS unsigned* SEL = (LAS unsigned*)(lds + NSA_SEL); LAS unsigned* UNI = (LAS unsigned*)(lds + NSA_UNI);
    { const float* bd = (const float*)(ws + WS_BIASD) + (size_t)hk * 3 * 2048;
      if (tid < 384) { const int gg = tid >> 7, d0 = (tid & 127) * 2; biasl[gg * 256 + d0] = bd[gg * 2048 + d0]; biasl[gg * 256 + d0 + 1] = bd[gg * 2048 + d0 + 1]; }
#pragma unroll
      for (int k = 0; k < 12; ++k) if (i >= 16) PS[tid + 512 * k] = 0.f;
      if (tid < 4) UNI[tid] = 0u; }
    bf16x8 qf[4];
    { const bf16_t* QN = (const bf16_t*)(ws + WS_PRJ + PRJ_QN) + ((size_t)(b * 6 + head) * 2048 + t) * 64;
#pragma unroll
      for (int ks = 0; ks < 4; ++ks) qf[ks] = *(const bf16x8*)(QN + 16 * ks + 8 * h); }
#define NSA_GATE(k) ({ int t_ = t; asm volatile("" : "+v"(t_)); sigmf(((const float*)(ws + WS_PRJ + PRJ_GATES))[((size_t)b * 2048 + t_) * 32 + head * 3 + (k)]); })
    LAS float* bl = biasl + g * 256;
    LAS float* otl = (LAS float*)(lds + NSA_OT + (active ? w : 0) * 8192) + lane;
    u32x4 kr[2], vr;
    const int ntc = i >= 16 ? 2 : 1;
    { const bf16_t* KC = (const bf16_t*)(ws + WS_CMP) + (size_t)(b * 2 + hk) * 128 * 64; const bf16_t* VC = (const bf16_t*)(ws + WS_CMP + CMP_V) + (size_t)(b * 2 + hk) * 128 * 64;
      for (int T = 0; T < ntc; ++T) { stage_k_load<64>(kr, KC + T * 4096, tid); vr = stage_v_load(VC + T * 4096, tid); stage_k_store<64>(kr, lds + NSA_KT + T * 64 * 144, tid); stage_v_store(vr, lds + NSA_VT + T * 64 * VTP, tid); } }
    __syncthreads();
    {
        f32x16 ot[2];
        if (active && i < 16) {
            AttnState A; attn_reset(A); f32x16 sc[2]; attn_scores<64>(sc, qf, lds + NSA_KT, r, h);
            float bvc[2][16];
#pragma unroll
            for (int kb = 0; kb < 2; ++kb)
#pragma unroll
                for (int k = 0; k < 16; ++k) { int d = t - 16 * (32 * kb + crow(k, h)) - 31; d = d < 0 ? 0 : (d > 255 ? 255 : d); bvc[kb][k] = bl[d]; }
#pragma unroll
            for (int kb = 0; kb < 2; ++kb)
#pragma unroll
                for (int k = 0; k < 16; ++k) { const int d = t - 16 * (32 * kb + crow(k, h)) - 31; sc[kb][k] = d >= 0 ? sc[kb][k] + bvc[kb][k] : -1e30f; }
            attn_softmax_pv(A, sc, lds + NSA_VT, r, h);
            const float gc = NSA_GATE(0); const float inv = A.l > 0.f ? gc / A.l : 0.f;
#pragma unroll
            for (int k = 0; k < 16; ++k) { otl[64 * k] = A.o[0][k] * inv; otl[64 * (16 + k)] = A.o[1][k] * inv; }
        } else if (active) {
            float m = -1e30f, lsum = 0.f;
            for (int T = 0; T < ntc; ++T) {
                f32x16 sc[2]; attn_scores<64>(sc, qf, lds + NSA_KT + T * 64 * 144, r, h);
                float bvc[2][16];
#pragma unroll
                for (int kb = 0; kb < 2; ++kb)
#pragma unroll
                    for (int k = 0; k < 16; ++k) { int d = t - 16 * (64 * T + 32 * kb + crow(k, h)) - 31; d = d < 0 ? 0 : (d > 255 ? 255 : d); bvc[kb][k] = bl[d]; }
                float mx = -1e30f;
#pragma unroll
                for (int kb = 0; kb < 2; ++kb)
#pragma unroll
                    for (int k = 0; k < 16; ++k) { const int n = 64 * T + 32 * kb + crow(k, h); const int d = t - 16 * n - 31; const float x = (d >= 0 && n < 127) ? sc[kb][k] + bvc[kb][k] : -1e30f; sc[kb][k] = x; mx = fmaxf(mx, x); }
                mx = fmaxf(mx, __shfl_xor(mx, 32));
                const float mnew = fmaxf(m, mx), mref = mnew <= -1e29f ? 0.f : mnew; float rs = 0.f;
#pragma unroll
                for (int kb = 0; kb < 2; ++kb)
#pragma unroll
                    for (int k = 0; k < 16; ++k) rs += __builtin_amdgcn_exp2f(sc[kb][k] - mref);
                rs += __shfl_xor(rs, 32);
                lsum = lsum * __builtin_amdgcn_exp2f(m - mref) + rs; m = mnew;
            }
            const float mref = m <= -1e29f ? 0.f : m, inv = lsum > 0.f ? 1.f / lsum : 0.f;
#pragma unroll
            for (int k = 0; k < 16; ++k) { ot[0][k] = 0.f; ot[1][k] = 0.f; }
            float carry = 0.f;
            for (int T = 0; T < ntc; ++T) {
                f32x16 sc[2]; attn_scores<64>(sc, qf, lds + NSA_KT + T * 64 * 144, r, h);
                float bvc[2][16];
#pragma unroll
                for (int kb = 0; kb < 2; ++kb)
#pragma unroll
                    for (int k = 0; k < 16; ++k) { int d = t - 16 * (64 * T + 32 * kb + crow(k, h)) - 31; d = d < 0 ? 0 : (d > 255 ? 255 : d); bvc[kb][k] = bl[d]; }
#pragma unroll
                for (int kb = 0; kb < 2; ++kb)
#pragma unroll
                    for (int k = 0; k < 16; ++k) { const int n = 64 * T + 32 * kb + crow(k, h); const int d = t - 16 * n - 31; sc[kb][k] = (d >= 0 && n < 127) ? __builtin_amdgcn_exp2f(sc[kb][k] + bvc[kb][k] - mref) * inv : 0.f; }
                float prevL = carry;
#pragma unroll
                for (int kb = 0; kb < 2; ++kb)
#pragma unroll
                    for (int g4 = 0; g4 < 4; ++g4) {
                        const float G4 = (sc[kb][4 * g4] + sc[kb][4 * g4 + 1]) + (sc[kb][4 * g4 + 2] + sc[kb][4 * g4 + 3]); const float L = sc[kb][4 * g4 + 3];
                        const float Lo = __shfl_xor(L, 32);
                        const float add = h ? Lo : prevL;
                        prevL = Lo;
                        const int idx = T * 8 + kb * 4 + g4;
                        PS[g * 2048 + tl * 32 + 2 * idx + h] = G4 + add;
                    }
                carry = prevL;
#pragma unroll
                for (int s4 = 0; s4 < 4; ++s4) {
                    const int kb = s4 >> 1, hf = (s4 & 1) * 8;
                    u32x4 pw; pw.x = pk_bf16(sc[kb][hf + 0], sc[kb][hf + 1]); pw.y = pk_bf16(sc[kb][hf + 2], sc[kb][hf + 3]); pw.z = pk_bf16(sc[kb][hf + 4], sc[kb][hf + 5]); pw.w = pk_bf16(sc[kb][hf + 6], sc[kb][hf + 7]);
                    const bf16x8 pf = __builtin_bit_cast(bf16x8, pw);
#pragma unroll
                    for (int eb = 0; eb < 2; ++eb) ot[eb] = MFMA32(vt_frag(lds + NSA_VT + T * 64 * VTP, vt_lane_off(lane), s4, eb), pf, ot[eb]);
                }
            }
            { const float gc = NSA_GATE(0);
#pragma unroll
            for (int k = 0; k < 16; ++k) { otl[64 * k] = ot[0][k] * gc; otl[64 * (16 + k)] = ot[1][k] * gc; } }
        }
    }
    __syncthreads();
#ifndef NO_NSA_SEL
    if (i < 16) { if (tid < 64) SEL[tid] = (2u << i) - 1u; if (tid < 3) UNI[tid] = (2u << i) - 1u; }
    else {
        const int tk = tid >> 3, sg = tid & 7; float v[32];
#pragma unroll
        for (int k = 0; k < 8; ++k) { const f32x4 x0 = *(const LAS f32x4*)(PS + tk * 32 + 4 * k), x1 = *(const LAS f32x4*)(PS + 2048 + tk * 32 + 4 * k), x2 = *(const LAS f32x4*)(PS + 4096 + tk * 32 + 4 * k);
            v[4 * k] = (x0.x + x1.x) + x2.x; v[4 * k + 1] = (x0.y + x1.y) + x2.y; v[4 * k + 2] = (x0.z + x1.z) + x2.z; v[4 * k + 3] = (x0.w + x1.w) + x2.w; }
#pragma unroll
        for (int s = 0; s < 32; ++s) { const bool forced = (s == 0) || (s == i) || (s == i - 1); float x = forced ? v[s] + 1e4f : v[s]; v[s] = s > i ? -1.f : x; }
        unsigned bits = 0u;
#pragma unroll
        for (int k = 0; k < 4; ++k) {
            float x = 0.f;
#pragma unroll
            for (int s = 0; s < 32; ++s) x = (s == 4 * sg + k) ? v[s] : x;
            int rank = 0;
#pragma unroll
            for (int s = 0; s < 32; ++s) rank += (v[s] > x || (v[s] == x && s < 4 * sg + k)) ? 1 : 0;
            if (rank < 16 && x >= 0.f) bits |= 1u << (4 * sg + k);
        }
        bits |= __shfl_xor(bits, 1); bits |= __shfl_xor(bits, 2); bits |= __shfl_xor(bits, 4);
        if (sg == 0) { SEL[tk] = bits; __hip_atomic_fetch_or(UNI, bits, __ATOMIC_RELAXED, __HIP_MEMORY_SCOPE_WORKGROUP); __hip_atomic_fetch_or(UNI + 1 + (tk >> 5), bits, __ATOMIC_RELAXED, __HIP_MEMORY_SCOPE_WORKGROUP); }
    }
#endif
    __syncthreads();
    const unsigned selbits = SEL[tl], uni = UNI[0], unih = UNI[1 + th];
    const float c31 = bl[255];
#ifndef NO_NSA_SLC
#ifndef NSA_DUP_SLC
#define NSA_DUP_SLC 1
#endif
    for (int rp_ = 0; rp_ < NSA_DUP_SLC; ++rp_) {
        AttnState A; attn_reset(A);
        const bf16_t* KS = (const bf16_t*)(ws + WS_PRJ + PRJ_KN1) + kvslab; const bf16_t* VS = (const bf16_t*)(ws + WS_PRJ + PRJ_VN1) + kvslab;
        unsigned todo = uni; int cur = 0; u32x4 kr2[2], vr2;
        int s = __ffs(todo) - 1; todo &= todo - 1;
        stage_k_load<64>(kr, KS + (size_t)s * 4096, tid); vr = stage_v_load(VS + (size_t)s * 4096, tid);
        stage_k_store<64>(kr, lds + NSA_KT, tid); stage_v_store(vr, lds + NSA_VT, tid);
        int sn = todo ? __ffs(todo) - 1 : -1; todo &= todo - 1;
        if (sn >= 0) { stage_k_load<64>(kr, KS + (size_t)sn * 4096, tid); vr = stage_v_load(VS + (size_t)sn * 4096, tid); }
        __syncthreads();
        while (s >= 0) {
            const int sn2 = todo ? __ffs(todo) - 1 : -1; todo &= todo - 1;
            if (sn2 >= 0) { stage_k_load<64>(kr2, KS + (size_t)sn2 * 4096, tid); vr2 = stage_v_load(VS + (size_t)sn2 * 4096, tid); }
            if (active && ((unih >> s) & 1u)) {
                f32x16 sc[2];
                attn_scores<64>(sc, qf, lds + NSA_KT + cur * 64 * 144, r, h);
                const bool sel = (selbits >> s) & 1u;
                if (i - s >= 3) attn_softmax_pv(A, sc, lds + NSA_VT + cur * 64 * VTP, r, h, c31, sel);
                else { nsa_mask_bias(sc, t - 64 * s, h, bl, sel, 4096); attn_softmax_pv(A, sc, lds + NSA_VT + cur * 64 * VTP, r, h); }
            }
            if (sn >= 0) { stage_k_store<64>(kr, lds + NSA_KT + (cur ^ 1) * 64 * 144, tid); stage_v_store(vr, lds + NSA_VT + (cur ^ 1) * 64 * VTP, tid); }
            kr[0] = kr2[0]; vr = vr2;
            __syncthreads();
            s = sn; sn = sn2; cur ^= 1;
        }
        if (active && rp_ == NSA_DUP_SLC - 1) { const float gs = NSA_GATE(1); const float inv = A.l > 0.f ? gs / A.l : 0.f;
#pragma unroll
            for (int k = 0; k < 16; ++k) { otl[64 * k] += A.o[0][k] * inv; otl[64 * (16 + k)] += A.o[1][k] * inv; } }
    }
#endif
#ifndef NO_NSA_WIN
#ifndef NSA_DUP_WIN
#define NSA_DUP_WIN 1
#endif
    for (int rq_ = 0; rq_ < NSA_DUP_WIN; ++rq_) {
        AttnState A; attn_reset(A);
        const bf16_t* KW = (const bf16_t*)(ws + WS_PRJ + PRJ_KN2) + kvslab; const bf16_t* VW = (const bf16_t*)(ws + WS_PRJ + PRJ_VN2) + kvslab;
        const int j0 = i > 8 ? i - 8 : 0; int cur = 0; u32x4 kr2[2], vr2;
        stage_k_load<64>(kr, KW + (size_t)j0 * 4096, tid); vr = stage_v_load(VW + (size_t)j0 * 4096, tid);
        stage_k_store<64>(kr, lds + NSA_KT, tid); stage_v_store(vr, lds + NSA_VT, tid);
        if (j0 < i) { stage_k_load<64>(kr, KW + (size_t)(j0 + 1) * 4096, tid); vr = stage_v_load(VW + (size_t)(j0 + 1) * 4096, tid); }
        __syncthreads();
        for (int j = j0; j <= i; ++j) {
            if (j + 2 <= i) { stage_k_load<64>(kr2, KW + (size_t)(j + 2) * 4096, tid); vr2 = stage_v_load(VW + (size_t)(j + 2) * 4096, tid); }
            if (active) {
                f32x16 sc[2];
                attn_scores<64>(sc, qf, lds + NSA_KT + cur * 64 * 144, r, h);
                if (i - j >= 3 && j > i - 8) attn_softmax_pv(A, sc, lds + NSA_VT + cur * 64 * VTP, r, h, c31, true);
                else { nsa_mask_bias(sc, t - 64 * j, h, bl, true, 512); attn_softmax_pv(A, sc, lds + NSA_VT + cur * 64 * VTP, r, h); }
            }
            if (j < i) { stage_k_store<64>(kr, lds + NSA_KT + (cur ^ 1) * 64 * 144, tid); stage_v_store(vr, lds + NSA_VT + (cur ^ 1) * 64 * VTP, tid); }
            kr[0] = kr2[0]; vr = vr2;
            __syncthreads();
            cur ^= 1;
        }
        if (active && rq_ == NSA_DUP_WIN - 1) { const float gw = NSA_GATE(2); const float inv = A.l > 0.f ? gw / A.l : 0.f;
            float ss = 0.f; bf16_t* Y = (bf16_t*)(ws + WS_Y) + row * 1024 + head * 64;
#pragma unroll
            for (int eb = 0; eb < 2; ++eb)
#pragma unroll
                for (int g4 = 0; g4 < 4; ++g4) {
                    const float v0 = otl[64 * (16 * eb + 4 * g4)] + A.o[eb][4 * g4] * inv, v1 = otl[64 * (16 * eb + 4 * g4 + 1)] + A.o[eb][4 * g4 + 1] * inv;
                    const float v2 = otl[64 * (16 * eb + 4 * g4 + 2)] + A.o[eb][4 * g4 + 2] * inv, v3 = otl[64 * (16 * eb + 4 * g4 + 3)] + A.o[eb][4 * g4 + 3] * inv;
                    u32x2 pw; pw.x = pk_bf16(v0, v1); pw.y = pk_bf16(v2, v3);
                    const float f0 = bf_lo(pw.x), f1 = bf_hi(pw.x), f2 = bf_lo(pw.y), f3 = bf_hi(pw.y); ss += (f0 * f0 + f1 * f1) + (f2 * f2 + f3 * f3);
                    *(u32x2*)(Y + 32 * eb + 8 * g4 + 4 * h) = pw;
                }
            ss += __shfl_xor(ss, 32);
            if (h == 0) ((float*)(ws + WS_SSQ + PT_A))[((size_t)l * 16384 + row) * 8 + head] = ss;
        }
    }
#endif
}

__device__ __forceinline__ void ml_out_wave(int cu, int l, InPtr in, unsigned char* ws, LAS unsigned char* wl, LAS unsigned char* npl, int lane) {
    const int c = cu & 31, bh = cu >> 5, hd = bh & 3, b = bh >> 2; const int t0 = c * 64; const int r = lane & 15, q = lane >> 4;
    const bf16_t* QC = (const bf16_t*)(ws + WS_ML) + ((size_t)bh * 2048 + t0) * 64; const bf16_t* KC = (const bf16_t*)(ws + WS_ML + ML_KC) + ((size_t)bh * 2048 + t0) * 64;
    const bf16_t* V = (const bf16_t*)(ws + WS_PRJ + PRJ_VML) + ((size_t)bh * 2048 + t0) * 64;
    const float* mlg = (const float*)(ws + WS_ML + ML_G) + ((size_t)bh * 2048 + t0) * 2;
    const bf16_t* CP = (const bf16_t*)(ws + WS_ML + ML_CP) + (size_t)cu * 4096; const bf16_t* NP = (const bf16_t*)(ws + WS_ML + ML_NP) + (size_t)cu * 64;
    u32x4 vch[8];
#pragma unroll
    for (int i = 0; i < 8; ++i) vch[i] = *(const u32x4*)(V + (size_t)(lane + 64 * i) * 8);
    bf16x8 aq[4][2];
#pragma unroll
    for (int mb = 0; mb < 4; ++mb)
#pragma unroll
        for (int ks = 0; ks < 2; ++ks) aq[mb][ks] = *(const bf16x8*)(QC + (size_t)(16 * mb + r) * 64 + 32 * ks + 8 * q);
    float bj[4][4], den[4][4];
#pragma unroll
    for (int mb = 0; mb < 4; ++mb)
#pragma unroll
        for (int j = 0; j < 4; ++j) bj[mb][j] = mlg[(16 * mb + 4 * q + j) * 2];
    {
        float cs[4];
#pragma unroll
        for (int nb = 0; nb < 4; ++nb) { const float2 gg = *(const float2*)(mlg + (16 * nb + r) * 2); cs[nb] = gg.y - gg.x; }
#pragma unroll
        for (int mb = 0; mb < 4; ++mb) {
            f32x4 accS[4];
#pragma unroll
            for (int nb = 0; nb < 4; ++nb) { accS[nb] = (f32x4){0.f, 0.f, 0.f, 0.f};
#pragma unroll
                for (int ks = 0; ks < 2; ++ks) { const bf16x8 bk = *(const bf16x8*)(KC + (size_t)(16 * nb + r) * 64 + 32 * ks + 8 * q); accS[nb] = MFMA16(aq[mb][ks], bk, accS[nb]); } }
#pragma unroll
            for (int j = 0; j < 4; ++j) {
                const int jj = 16 * mb + 4 * q + j; float rs = 0.f;
#pragma unroll
                for (int nb = 0; nb < 4; ++nb) { const int s = 16 * nb + r; const float p = s <= jj ? accS[nb][j] * __expf(bj[mb][j] + cs[nb]) : 0.f; rs += p;
                    *(LAS bf16_t*)(wl + 8192 + swz_off(jj, s >> 3) + (s & 7) * 2) = f2bf(p); }
                rs += __shfl_xor(rs, 1); rs += __shfl_xor(rs, 2); rs += __shfl_xor(rs, 4); rs += __shfl_xor(rs, 8);
                den[mb][j] = rs;
            }
        }
    }
#pragma unroll
    for (int i = 0; i < 8; ++i) { const int ch = lane + 64 * i, sv = ch >> 3, e0 = (ch & 7) * 8; const unsigned xs[4] = {vch[i].x, vch[i].y, vch[i].z, vch[i].w};
#pragma unroll
        for (int k = 0; k < 4; ++k) { *(LAS bf16_t*)(wl + swz_off(e0 + 2 * k, sv >> 3) + (sv & 7) * 2) = (bf16_t)(xs[k] & 0xffffu); *(LAS bf16_t*)(wl + swz_off(e0 + 2 * k + 1, sv >> 3) + (sv & 7) * 2) = (bf16_t)(xs[k] >> 16); } }
#pragma unroll
    for (int mb = 0; mb < 4; ++mb) { const float e = __expf(mlg[(16 * mb + r) * 2]);
#pragma unroll
        for (int ks = 0; ks < 2; ++ks) { const u32x4 x = __builtin_bit_cast(u32x4, aq[mb][ks]); u32x4 y;
            y.x = pk_bf16(bf_lo(x.x) * e, bf_hi(x.x) * e); y.y = pk_bf16(bf_lo(x.y) * e, bf_hi(x.y) * e); y.z = pk_bf16(bf_lo(x.z) * e, bf_hi(x.z) * e); y.w = pk_bf16(bf_lo(x.w) * e, bf_hi(x.w) * e);
            aq[mb][ks] = __builtin_bit_cast(bf16x8, y); } }
    f32x4 acc[4][4], accn[4];
#pragma unroll
    for (int mb = 0; mb < 4; ++mb) { accn[mb] = (f32x4){0.f, 0.f, 0.f, 0.f};
#pragma unroll
        for (int nb = 0; nb < 4; ++nb) acc[mb][nb] = (f32x4){0.f, 0.f, 0.f, 0.f}; }
#pragma unroll
    for (int ks = 0; ks < 2; ++ks) {
        u32x4 nz = *(const u32x4*)(NP + 32 * ks + 8 * q); if (r != 0) nz = (u32x4){0u, 0u, 0u, 0u};
        const bf16x8 bn = __builtin_bit_cast(bf16x8, nz);
#pragma unroll
        for (int nb = 0; nb < 4; ++nb) { const bf16x8 bb = *(const bf16x8*)(CP + (size_t)(16 * nb + r) * 64 + 32 * ks + 8 * q);
#pragma unroll
            for (int mb = 0; mb < 4; ++mb) acc[mb][nb] = MFMA16(aq[mb][ks], bb, acc[mb][nb]); }
#pragma unroll
        for (int mb = 0; mb < 4; ++mb) accn[mb] = MFMA16(aq[mb][ks], bn, accn[mb]);
    }
    LDS_FENCE();
#pragma unroll
    for (int ks = 0; ks < 2; ++ks) {
        bf16x8 ap[4];
#pragma unroll
        for (int mb = 0; mb < 4; ++mb) ap[mb] = *(const LAS bf16x8*)(wl + 8192 + swz_off(16 * mb + r, 4 * ks + q));
#pragma unroll
        for (int nb = 0; nb < 4; ++nb) { const bf16x8 bv = *(const LAS bf16x8*)(wl + swz_off(16 * nb + r, 4 * ks + q));
#pragma unroll
            for (int mb = 0; mb < 4; ++mb) acc[mb][nb] = MFMA16(ap[mb], bv, acc[mb][nb]); }
    }
    LDS_FENCE();
    const bf16_t* OG = (const bf16_t*)(ws + WS_PRJ + PRJ_OG); u32x4 ogc[8];
#pragma unroll
    for (int i = 0; i < 8; ++i) { const int ch = lane + 64 * i; ogc[i] = *(const u32x4*)(OG + ((size_t)b * 2048 + t0 + (ch >> 3)) * 256 + hd * 64 + (ch & 7) * 8); }
    const float* gain = in->p[14] + l * 256 + hd * 64;
    bf16_t* Y = (bf16_t*)(ws + WS_Y);
    float gn[4];
#pragma unroll
    for (int nb = 0; nb < 4; ++nb) gn[nb] = gain[16 * nb + r];
#pragma unroll
    for (int mb = 0; mb < 4; ++mb)
#pragma unroll
        for (int j = 0; j < 4; ++j) {
            const int jj = 16 * mb + 4 * q + j;
            const float dn = den[mb][j] + __builtin_bit_cast(float, __builtin_amdgcn_ds_bpermute((lane & 48) << 2, __builtin_bit_cast(int, accn[mb][j])));
            const float inv = __builtin_amdgcn_rcpf(fmaxf(fabsf(dn), 1.f)); float hv[4]; float ss = 0.f;
#pragma unroll
            for (int nb = 0; nb < 4; ++nb) { hv[nb] = acc[mb][nb][j] * inv; ss += hv[nb] * hv[nb]; }
            ss += __shfl_xor(ss, 1); ss += __shfl_xor(ss, 2); ss += __shfl_xor(ss, 4); ss += __shfl_xor(ss, 8);
            const float rstd = rsqrtf(ss * (1.f / 64.f) + 1e-6f);
#pragma unroll
            for (int nb = 0; nb < 4; ++nb) { const int e = 16 * nb + r; *(LAS bf16_t*)(wl + 8192 + swz_off(jj, e >> 3) + (e & 7) * 2) = f2bf(hv[nb] * rstd * gn[nb]); }
        }
    LDS_FENCE();
#pragma unroll
    for (int i = 0; i < 8; ++i) { const int ch = lane + 64 * i, row = ch >> 3, e8 = ch & 7;
        const u32x4 hx = *(const LAS u32x4*)(wl + 8192 + swz_off(row, e8)); const u32x4 g = ogc[i]; u32x4 o;
        o.x = pk_bf16(bf_lo(hx.x) * sigmf(bf_lo(g.x)), bf_hi(hx.x) * sigmf(bf_hi(g.x)));
        o.y = pk_bf16(bf_lo(hx.y) * sigmf(bf_lo(g.y)), bf_hi(hx.y) * sigmf(bf_hi(g.y)));
        o.z = pk_bf16(bf_lo(hx.z) * sigmf(bf_lo(g.z)), bf_hi(hx.z) * sigmf(bf_hi(g.z)));
        o.w = pk_bf16(bf_lo(hx.w) * sigmf(bf_lo(g.w)), bf_hi(hx.w) * sigmf(bf_hi(g.w)));
        *(u32x4*)(Y + ((size_t)b * 2048 + t0 + row) * 1024 + 768 + hd * 64 + e8 * 8) = o; }
    LDS_FENCE();
}

__device__ __forceinline__ void ml_scan_unit(int bh, int l, unsigned char* ws, int g_wv) {
    int tid_ = TIDX; asm volatile("" : "+v"(tid_)); const int tid = tid_;
    const bf16_t* DL = (const bf16_t*)(ws + WS_ML + ML_DELTA) + (size_t)bh * 32 * 4096 + tid * 8; bf16_t* CP = (bf16_t*)(ws + WS_ML + ML_CP) + (size_t)bh * 32 * 4096 + tid * 8;
    const float* DN = (const float*)(ws + WS_ML + ML_DN) + (size_t)bh * 32 * 64; bf16_t* NP = (bf16_t*)(ws + WS_ML + ML_NP) + (size_t)bh * 32 * 64; const float* BL = (const float*)(ws + WS_ML + ML_BL) + bh * 32;
    float c[8]; float n = 0.f;
#pragma unroll
    for (int k = 0; k < 8; ++k) c[k] = 0.f;
#pragma unroll 1
    for (int c0 = 0; c0 < 32; c0 += 8) {
        u32x4 d[8]; float dn[8], co[8];
#pragma unroll
        for (int k = 0; k < 8; ++k) { d[k] = *(const u32x4*)(DL + (size_t)(c0 + k) * 4096); dn[k] = tid < 64 ? DN[(c0 + k) * 64 + tid] : 0.f; co[k] = __expf(BL[c0 + k]); }
#pragma unroll
        for (int k = 0; k < 8; ++k) {
            u32x4 o; o.x = pk_bf16(c[0], c[1]); o.y = pk_bf16(c[2], c[3]); o.z = pk_bf16(c[4], c[5]); o.w = pk_bf16(c[6], c[7]);
            *(u32x4*)(CP + (size_t)(c0 + k) * 4096) = o; if (tid < 64) NP[(c0 + k) * 64 + tid] = f2bf(n);
            c[0] = co[k] * c[0] + bf_lo(d[k].x); c[1] = co[k] * c[1] + bf_hi(d[k].x); c[2] = co[k] * c[2] + bf_lo(d[k].y); c[3] = co[k] * c[3] + bf_hi(d[k].y);
            c[4] = co[k] * c[4] + bf_lo(d[k].z); c[5] = co[k] * c[5] + bf_hi(d[k].z); c[6] = co[k] * c[6] + bf_lo(d[k].w); c[7] = co[k] * c[7] + bf_hi(d[k].w);
            n = co[k] * n + dn[k];
        }
    }
    asm volatile("s_waitcnt vmcnt(0)" ::: "memory"); __syncthreads();
    if (tid == 0) { __builtin_amdgcn_fence(__ATOMIC_RELEASE, "agent"); asm volatile("s_waitcnt vmcnt(0)" ::: "memory");
        __hip_atomic_fetch_add((unsigned*)(ws + WS_CTL) + CW_SCAN + 64 * l, 1u, __ATOMIC_RELAXED, __HIP_MEMORY_SCOPE_AGENT); }
}
__device__ __forceinline__ void ml_scan_wait(int l, unsigned char* ws, int g_wv) {
    if (TIDX == 0) { unsigned* p = (unsigned*)(ws + WS_CTL) + CW_SCAN + 64 * l; unsigned sp = 0;
        while (__hip_atomic_load(p, __ATOMIC_RELAXED, __HIP_MEMORY_SCOPE_AGENT) < 32u) { __builtin_amdgcn_s_sleep(2); if (++sp > (1u << 22)) break; }
        __builtin_amdgcn_fence(__ATOMIC_ACQUIRE, "agent"); asm volatile("s_waitcnt vmcnt(0)" ::: "memory"); }
    __syncthreads();
}

#ifndef DUP_NSA
#define DUP_NSA 1
#endif
#ifndef DUP_MLA
#define DUP_MLA 1
#endif
#ifndef DUP_ML
#define DUP_ML 1
#endif
#ifdef NO_MLA
#define MLA_CALL(...) do {} while (0)
#else
#define MLA_CALL(...) do { for (int rp = 0; rp < DUP_MLA; ++rp) { if (rp) __syncthreads(); mla_unit(__VA_ARGS__); } } while (0)
#endif
__device__ __forceinline__ void phase_mix(int l, InPtr in, unsigned char* ws, LAS unsigned char* lds, unsigned* qhead, int g_wv) {
    LAS int* slot = (LAS int*)(lds + LDS_MISC + 64);
    for (;;) {
        __syncthreads();
        if (TIDX == 0) *slot = (int)__hip_atomic_fetch_add(qhead, 1u, __ATOMIC_RELAXED, __HIP_MEMORY_SCOPE_AGENT);
        __syncthreads();
        int u = *slot;
        if (u >= 32 + 512 + 384 + 128) break;
        if (u < 32) { ml_scan_unit(u, l, ws, g_wv); continue; } u -= 32;
#ifndef NO_NSA
        if (u < 256) { const int i = 31 - (u >> 4), bh = u & 15; { for (int rp = 0; rp < DUP_NSA; ++rp) { if (rp) __syncthreads(); nsa_unit(bh >> 1, bh & 1, i, l, in, ws, lds, g_wv); } } continue; }
#endif
        u -= 256;
        if (u < 192) { const int qt = 7 - u / 48, bh = u % 48; MLA_CALL(bh / 6, bh % 6, qt, l, ws, lds, g_wv); continue; }
        u -= 192;
#ifndef NO_NSA
        if (u < 128) { const int i = 15 - (u >> 4), bh = u & 15; { for (int rp = 0; rp < DUP_NSA; ++rp) { if (rp) __syncthreads(); nsa_unit(bh >> 1, bh & 1, i, l, in, ws, lds, g_wv); } } continue; }
#endif
        u -= 128;
        if (u < 192) { const int qt = 3 - u / 48, bh = u % 48; MLA_CALL(bh / 6, bh % 6, qt, l, ws, lds, g_wv); continue; } u -= 192;
#ifndef NO_NSA
        if (u < 128) { const int i = 7 - (u >> 4), bh = u & 15; { for (int rp = 0; rp < DUP_NSA; ++rp) { if (rp) __syncthreads(); nsa_unit(bh >> 1, bh & 1, i, l, in, ws, lds, g_wv); } } continue; }
#endif
        u -= 128;
#ifndef NO_MLOUT
        ml_scan_wait(l, ws, g_wv);
        for (int rp = 0; rp < DUP_ML; ++rp) { int tid_ = TIDX; asm volatile("" : "+v"(tid_)); const int w = tid_ >> 6; ml_out_wave(u * 8 + w, l, in, ws, lds + w * 16384, lds + 131072 + w * 256, tid_ & 63); }
#endif
    }
}
__device__ __forceinline__ void phase_ynorm(int l, unsigned char* ws, int bid, int nb, int g_wv) {
    int tid_ = TIDX; asm volatile("" : "+v"(tid_)); const int w = tid_ >> 6, lane = tid_ & 63;
    bf16_t* Y = (bf16_t*)(ws + WS_Y); const float* sa = (const float*)(ws + WS_SSQ + PT_A) + (size_t)l * 16384 * 8; const float* sc = (const float*)(ws + WS_SSQ + PT_C) + (size_t)l * 16384 * 8;
    for (int r0 = (bid * 8 + w) * 8; r0 < NTOK; r0 += nb * 64) {
        if (lane < 48) {
            u32x4 x[8], y[8]; float ra[8], rc[8];
#pragma unroll
            for (int k = 0; k < 8; ++k) { const int row = r0 + k;
                const f32x4 a0 = *(const f32x4*)(sa + (size_t)row * 8), a1 = *(const f32x4*)(sa + (size_t)row * 8 + 4), c0 = *(const f32x4*)(sc + (size_t)row * 8), c1 = *(const f32x4*)(sc + (size_t)row * 8 + 4);
                ra[k] = rsqrtf((((a0.x + a0.y) + (a0.z + a0.w)) + (a1.x + a1.y)) * (1.f / 384.f) + 1e-6f); rc[k] = rsqrtf((((c0.x + c0.y) + (c0.z + c0.w)) + (c1.x + c1.y)) * (1.f / 384.f) + 1e-6f);
                x[k] = *((const u32x4*)(Y + (size_t)row * 1024) + lane); y[k] = *((const u32x4*)(Y + (size_t)row * 1024 + 384) + lane); }
#pragma unroll
            for (int k = 0; k < 8; ++k) { const int row = r0 + k; u32x4 a = x[k], c = y[k]; const float fa = ra[k], fc = rc[k];
                a.x = pk_bf16(bf_lo(a.x) * fa, bf_hi(a.x) * fa); a.y = pk_bf16(bf_lo(a.y) * fa, bf_hi(a.y) * fa); a.z = pk_bf16(bf_lo(a.z) * fa, bf_hi(a.z) * fa); a.w = pk_bf16(bf_lo(a.w) * fa, bf_hi(a.w) * fa);
                c.x = pk_bf16(bf_lo(c.x) * fc, bf_hi(c.x) * fc); c.y = pk_bf16(bf_lo(c.y) * fc, bf_hi(c.y) * fc); c.z = pk_bf16(bf_lo(c.z) * fc, bf_hi(c.z) * fc); c.w = pk_bf16(bf_lo(c.w) * fc, bf_hi(c.w) * fc);
                *((u32x4*)(Y + (size_t)row * 1024) + lane) = a; *((u32x4*)(Y + (size_t)row * 1024 + 384) + lane) = c; }
        }
    }
}
constexpr int LDS_FAC = 131072 + 2048;
__device__ __forceinline__ void outproj_factors(int l, unsigned char* ws, LAS unsigned char* lds, int pm, int tid) {
    asm volatile("" : "+v"(tid));
    if (tid < 256) { const int row = pm * 256 + tid; const float* sa = (const float*)(ws + WS_SSQ + PT_A) + ((size_t)l * 16384 + row) * 8; const float* sc = (const float*)(ws + WS_SSQ + PT_C) + ((size_t)l * 16384 + row) * 8;
        const f32x4 a0 = *(const f32x4*)sa, a1 = *(const f32x4*)(sa + 4), c0 = *(const f32x4*)sc, c1 = *(const f32x4*)(sc + 4);
        const float ra = rsqrtf((((a0.x + a0.y) + (a0.z + a0.w)) + (a1.x + a1.y)) * (1.f / 384.f) + 1e-6f), rc = rsqrtf((((c0.x + c0.y) + (c0.z + c0.w)) + (c1.x + c1.y)) * (1.f / 384.f) + 1e-6f);
        LAS float* F = (LAS float*)(lds + LDS_FAC); F[2 * tid] = ra / rc; F[2 * tid + 1] = rc; }
    __syncthreads();
}
struct EpiOut {
    static constexpr bool KHOOK = true;
    bf16_t* XB; float* ssq; const LAS float* F; bool fold;
    __device__ __forceinline__ void kscale(f32x4 (&acc)[2][2][4][2], int which, int wr, int fr) const {
        if (!fold) return;
#pragma unroll
        for (int ai = 0; ai < 2; ++ai)
#pragma unroll
            for (int m = 0; m < 4; ++m) { const float f = F[2 * (ai * 128 + wr * 64 + m * 16 + fr) + which];
#pragma unroll
                for (int bj = 0; bj < 2; ++bj)
#pragma unroll
                    for (int n = 0; n < 2; ++n) acc[ai][bj][m][n] = acc[ai][bj][m][n] * f; }
    }
    __device__ __forceinline__ void operator()(const f32x4 (&acc)[2][2][4][2], const GUnit& u, int wr, int wc, int fr, int fq) const {
#pragma unroll
        for (int ai = 0; ai < 2; ++ai)
#pragma unroll
          for (int mh = 0; mh < 2; ++mh) {
            __builtin_amdgcn_sched_barrier(0);
            u32x4 xr[2][2];
#pragma unroll
            for (int m2 = 0; m2 < 2; ++m2)
#pragma unroll
                for (int bj = 0; bj < 2; ++bj) xr[m2][bj] = *(const u32x4*)(XB + (size_t)(u.pm * 256 + ai * 128 + wr * 64 + (2 * mh + m2) * 16 + fr) * 1024 + u.pn * 256 + bj * 128 + wc * 32 + 8 * fq);
#pragma unroll
            for (int m2 = 0; m2 < 2; ++m2) {
                const int m = 2 * mh + m2; const int row = u.pm * 256 + ai * 128 + wr * 64 + m * 16 + fr; float ss = 0.f;
#pragma unroll
                for (int bj = 0; bj < 2; ++bj) {
                    const u32x4 x = xr[m2][bj]; u32x4 o;
                    o.x = pk_bf16(bf_lo(x.x) + acc[ai][bj][m][0][0], bf_hi(x.x) + acc[ai][bj][m][0][1]); o.y = pk_bf16(bf_lo(x.y) + acc[ai][bj][m][0][2], bf_hi(x.y) + acc[ai][bj][m][0][3]);
                    o.z = pk_bf16(bf_lo(x.z) + acc[ai][bj][m][1][0], bf_hi(x.z) + acc[ai][bj][m][1][1]); o.w = pk_bf16(bf_lo(x.w) + acc[ai][bj][m][1][2], bf_hi(x.w) + acc[ai][bj][m][1][3]);
                    *(u32x4*)(XB + (size_t)row * 1024 + u.pn * 256 + bj * 128 + wc * 32 + 8 * fq) = o;
                    ss += (bf_lo(o.x) * bf_lo(o.x) + bf_hi(o.x) * bf_hi(o.x)) + (bf_lo(o.y) * bf_lo(o.y) + bf_hi(o.y) * bf_hi(o.y)) + (bf_lo(o.z) * bf_lo(o.z) + bf_hi(o.z) * bf_hi(o.z)) + (bf_lo(o.w) * bf_lo(o.w) + bf_hi(o.w) * bf_hi(o.w));
                }
                ss = quad_sum(ss); if (fq == 0) ssq[(size_t)row * 16 + u.pn * 4 + wc] = ss;
            }
          }
    }
};

__device__ __forceinline__ float sum16(const float* p) { const f32x4 a = *(const f32x4*)p, b = *(const f32x4*)(p + 4), c = *(const f32x4*)(p + 8), d = *(const f32x4*)(p + 12);
    return (((a.x + a.y) + (a.z + a.w)) + ((b.x + b.y) + (b.z + b.w))) + (((c.x + c.y) + (c.z + c.w)) + ((d.x + d.y) + (d.z + d.w))); }
__device__ __forceinline__ void phase_route(int l, InPtr in, unsigned char* ws, LAS unsigned char* lds, int bid, int nb, int g_wv) {
    int tid_ = TIDX; asm volatile("" : "+v"(tid_)); const int w = tid_ >> 6, lane = tid_ & 63, r = lane & 15, q = lane >> 4;
    const bf16_t* XB = (const bf16_t*)(ws + WS_XB); const bf16_t* WR = (const bf16_t*)(ws + WS_WR) + (size_t)l * 64 * 1024;
    const float* ssq = (const float*)(ws + WS_SSQ + PT_X1) + (size_t)l * 16384 * 16; const float* bg = in->p[24] + l * 4; const float* be = in->p[26] + l * 32;
    unsigned* cnt = (unsigned*)(ws + WS_CTL) + CW_CNT + 2048 * l; unsigned* mtok = (unsigned*)(ws + WS_META); float* mw = (float*)(ws + WS_META + META_W);
    LAS float* lg = (LAS float*)(lds + w * 4096);
    LAS unsigned* lcnt = (LAS unsigned*)(lds + 32768); LAS unsigned* lbase = lcnt + 32;
    for (int g0 = bid * 8; g0 < NTOK / 16; g0 += nb * 8) {
        if (tid_ < 32) lcnt[tid_] = 0u;
        __syncthreads();
        const int tok0 = (g0 + w) * 16; f32x4 acc[3];
#pragma unroll
        for (int n = 0; n < 3; ++n) acc[n] = (f32x4){0.f, 0.f, 0.f, 0.f};
        const bf16_t* ap = XB + (size_t)(tok0 + r) * 1024 + 8 * q; const bf16_t* bp = WR + (size_t)r * 1024 + 8 * q;
#pragma unroll 1
        for (int kc = 0; kc < 4; ++kc) {
            bf16x8 a[8], bb[3][8];
#pragma unroll
            for (int s = 0; s < 8; ++s) { a[s] = *(const bf16x8*)(ap + 32 * (kc * 8 + s));
#pragma unroll
                for (int n = 0; n < 3; ++n) bb[n][s] = *(const bf16x8*)(bp + (size_t)n * 16 * 1024 + 32 * (kc * 8 + s)); }
            __builtin_amdgcn_sched_barrier(0);
#pragma unroll
            for (int s = 0; s < 8; ++s)
#pragma unroll
                for (int n = 0; n < 3; ++n) acc[n] = MFMA16(a[s], bb[n][s], acc[n]);
            __builtin_amdgcn_sched_barrier(0);
        }
#pragma unroll
        for (int n = 0; n < 3; ++n)
#pragma unroll
            for (int j = 0; j < 4; ++j) lg[(4 * q + j) * 48 + 16 * n + r] = acc[n][j];
        LDS_FENCE();
        int E0 = 0, E1 = 0; unsigned r0 = 0, r1 = 0; float wt0 = 0.f, wt1 = 0.f; const int tok = tok0 + (lane & 15);
        if (lane < 16) {
            const float rs = rsqrtf(sum16(ssq + (size_t)tok * 16) * (1.f / 1024.f) + 1e-6f); ((float*)(ws + WS_RS2))[tok] = rs; const LAS float* L = lg + lane * 48;
            float gl[4]; int gi = 0;
#pragma unroll
            for (int j = 0; j < 4; ++j) gl[j] = L[j] * rs + bg[j];
            float gm = gl[0];
#pragma unroll
            for (int j = 1; j < 4; ++j) if (gl[j] > gm) { gm = gl[j]; gi = j; }
            float gsum = 0.f;
#pragma unroll
            for (int j = 0; j < 4; ++j) gsum += __expf(gl[j] - gm);
            const float gtop = 1.f / gsum;
            float el[8];
#pragma unroll
            for (int j = 0; j < 8; ++j) el[j] = L[4 + gi * 8 + j] * rs + be[gi * 8 + j];
            int e0 = 0; float v0 = el[0];
#pragma unroll
            for (int j = 1; j < 8; ++j) if (el[j] > v0) { v0 = el[j]; e0 = j; }
            int e1 = -1; float v1 = -3.0e38f;
#pragma unroll
            for (int j = 0; j < 8; ++j) if (j != e0 && el[j] > v1) { v1 = el[j]; e1 = j; }
            const float w0 = 1.f / (1.f + __expf(v1 - v0)); E0 = gi * 8 + e0; E1 = gi * 8 + e1; wt0 = w0 * gtop; wt1 = (1.f - w0) * gtop;
            r0 = __hip_atomic_fetch_add(lcnt + E0, 1u, __ATOMIC_RELAXED, __HIP_MEMORY_SCOPE_WORKGROUP); r1 = __hip_atomic_fetch_add(lcnt + E1, 1u, __ATOMIC_RELAXED, __HIP_MEMORY_SCOPE_WORKGROUP);
        }
        __syncthreads();
        if (tid_ < 32) { const unsigned c = lcnt[tid_]; lbase[tid_] = c ? atomicAdd(cnt + tid_ * 64, c) : 0u; }
        __syncthreads();
        if (lane < 16) {
            const unsigned p0 = lbase[E0] + r0, p1 = lbase[E1] + r1;
            mtok[(size_t)E0 * 16384 + p0] = (unsigned)tok; mw[(size_t)E0 * 16384 + p0] = wt0;
            mtok[(size_t)E1 * 16384 + p1] = (unsigned)tok | 0x80000000u; mw[(size_t)E1 * 16384 + p1] = wt1;
        }
        __syncthreads();
    }
}

constexpr int LDS_TB = 131072 + 2048;
__device__ __forceinline__ void moe_tables(int l, unsigned char* ws, LAS unsigned char* lds, int g_wv) {
    int tix = TIDX; asm volatile("" : "+v"(tix));
    LAS int* tb = (LAS int*)(lds + LDS_TB);
    if (tix < 32) { const unsigned* cnt = (const unsigned*)(ws + WS_CTL) + CW_CNT + 2048 * l; tb[160 + tix] = (int)__hip_atomic_load(cnt + tix * 64, __ATOMIC_RELAXED, __HIP_MEMORY_SCOPE_AGENT); }
    __syncthreads();
    if (tix == 0) { int a = 0, f = 0, p = 0; for (int e = 0; e < 32; ++e) { const int c = tb[160 + e]; tb[e] = a; tb[48 + e] = f; tb[96 + e] = p; a += (c + 255) >> 8; f += c >> 8; p += (c & 255) ? 1 : 0; } tb[32] = a; tb[80] = f; tb[128] = p; }
    __syncthreads();
}
template <int NPN, bool GATHER_>
struct MoeSched {
    static constexpr bool GATHER = GATHER_, PARTIAL = false;
    const char* A; const char* Bt; const unsigned* cnt; const unsigned* mtok; const LAS int* tb; int G, c; size_t bstride_e  , bstride_pn; int lo, hi;
    __device__ __forceinline__ bool next(int i, GUnit& u) const {
        const int L = lo + i * G + c; if (L >= hi) return false;
        const int tile = L / NPN, pn = L % NPN;
        int e = 0;
        for (int k = 1; k < 32; ++k) e = (tb[k] <= tile) ? k : e;
        e = __builtin_amdgcn_readfirstlane(e);
        u.e = e; u.pm = tile; u.pn = pn; u.rows = tb[160 + e] - 256 * (tile - tb[e]);
        u.a = GATHER ? A : A + (size_t)tile * 256 * 256 * 2;
        u.b = Bt + (size_t)e * bstride_e + (size_t)pn * bstride_pn; return true;
    }
    __device__ __forceinline__ void aoff(const GUnit& u, unsigned (&v)[2][2], const int (&R)[2], const int (&C)[2]) const {
#pragma unroll
        for (int h = 0; h < 2; ++h)
#pragma unroll
            for (int i = 0; i < 2; ++i) {
                if (GATHER) { const int lr = h * 128 + R[i]; const int rr = 256 * (u.pm - tb[u.e]) + (lr < u.rows ? lr : 0); const unsigned tok = mtok[(size_t)u.e * 16384 + rr] & 0x7fffffffu; v[h][i] = (tok * 1024u + (unsigned)C[i]) * 2u; }
                else v[h][i] = (unsigned)((h * 128 + R[i]) * 256 + C[i]) * 2u;
            }
    }
};
struct EpiMoeUp {
    static constexpr bool KHOOK = false;
    const unsigned* mtok; const float* ssq; const LAS int* tb; bf16_t* HB;
    __device__ __forceinline__ void operator()(const f32x4 (&acc)[2][2][4][2], const GUnit& u, int wr, int wc, int fr, int fq) const {
        const int r0 = 256 * (u.pm - tb[u.e]);
        float rs8[8];
        { unsigned tk[8];
#pragma unroll
          for (int k = 0; k < 8; ++k) { const int lr = (k >> 2) * 128 + wr * 64 + (k & 3) * 16 + fr; tk[k] = mtok[(size_t)u.e * 16384 + r0 + (lr < u.rows ? lr : 0)] & 0x7fffffffu; }
#pragma unroll
          for (int k = 0; k < 8; ++k) rs8[k] = ssq[tk[k]]; }
#pragma unroll
        for (int ai = 0; ai < 2; ++ai)
#pragma unroll
            for (int m = 0; m < 4; ++m) {
                __builtin_amdgcn_sched_barrier(0);
                const int lr = ai * 128 + wr * 64 + m * 16 + fr;
                if (lr < u.rows) {
                    const float rs = rs8[ai * 4 + m];
                    float hv[8];
#pragma unroll
                    for (int n = 0; n < 2; ++n)
#pragma unroll
                        for (int j = 0; j < 4; ++j) { const float gv = acc[ai][0][m][n][j] * rs, uv = acc[ai][1][m][n][j] * rs; hv[4 * n + j] = siluf(gv) * uv; }
                    st_bf16x8(HB + ((size_t)u.pm * 256 + lr) * 256 + u.pn * 128 + wc * 32 + 8 * fq, hv);
                }
            }
    }
};
struct EpiMoeDown {
    static constexpr bool KHOOK = false;
    const unsigned* mtok; const float* mw; const LAS int* tb; bf16_t* YB;
    __device__ __forceinline__ void operator()(const f32x4 (&acc)[2][2][4][2], const GUnit& u, int wr, int wc, int fr, int fq) const {
        const int r0 = 256 * (u.pm - tb[u.e]);
        unsigned mt8[8]; float wt8[8];
#pragma unroll
        for (int k = 0; k < 8; ++k) { const int lr = (k >> 2) * 128 + wr * 64 + (k & 3) * 16 + fr; const size_t ix = (size_t)u.e * 16384 + r0 + (lr < u.rows ? lr : 0); mt8[k] = mtok[ix]; wt8[k] = mw[ix]; }
#pragma unroll
        for (int ai = 0; ai < 2; ++ai)
#pragma unroll
            for (int m = 0; m < 4; ++m) {
                __builtin_amdgcn_sched_barrier(0);
                const int lr = ai * 128 + wr * 64 + m * 16 + fr;
                if (lr < u.rows) {
                    const unsigned mt = mt8[ai * 4 + m]; const float wt = wt8[ai * 4 + m];
                    bf16_t* dst = YB + ((size_t)(mt >> 31) * 16384 + (mt & 0x7fffffffu)) * 1024 + u.pn * 256 + wc * 32 + 8 * fq;
#pragma unroll
                    for (int bj = 0; bj < 2; ++bj) { float v[8];
#pragma unroll
                        for (int n = 0; n < 2; ++n)
#pragma unroll
                            for (int j = 0; j < 4; ++j) v[4 * n + j] = acc[ai][bj][m][n][j] * wt;
                        st_bf16x8(dst + bj * 128, v); }
                }
            }
    }
};
__device__ __forceinline__ void phase_combine(int l, unsigned char* ws, float* out, int bid, int nb, int g_wv) {
    int tid_ = TIDX; asm volatile("" : "+v"(tid_)); const int w = tid_ >> 6, lane = tid_ & 63;
    bf16_t* XB = (bf16_t*)(ws + WS_XB); const bf16_t* Y0 = (const bf16_t*)(ws + WS_YBUF); const bf16_t* Y1 = Y0 + (size_t)16384 * 1024; float* ssqx = (float*)(ws + WS_SSQX) + 16384;
    for (int row = bid * 8 + w; row < NTOK; row += nb * 8) {
        float ss = 0.f;
#pragma unroll
        for (int k = 0; k < 2; ++k) {
            const size_t o = (size_t)row * 1024 + (lane + 64 * k) * 8;
            const u32x4 x = *(const u32x4*)(XB + o), a = *(const u32x4*)(Y0 + o), c = *(const u32x4*)(Y1 + o);
            float v[8] = { bf_lo(x.x) + bf_lo(a.x) + bf_lo(c.x), bf_hi(x.x) + bf_hi(a.x) + bf_hi(c.x), bf_lo(x.y) + bf_lo(a.y) + bf_lo(c.y), bf_hi(x.y) + bf_hi(a.y) + bf_hi(c.y),
                           bf_lo(x.z) + bf_lo(a.z) + bf_lo(c.z), bf_hi(x.z) + bf_hi(a.z) + bf_hi(c.z), bf_lo(x.w) + bf_lo(a.w) + bf_lo(c.w), bf_hi(x.w) + bf_hi(a.w) + bf_hi(c.w) };
            if (l == L_ - 1 && out) { *(f32x4*)(out + o) = (f32x4){v[0], v[1], v[2], v[3]}; *(f32x4*)(out + o + 4) = (f32x4){v[4], v[5], v[6], v[7]}; }
            else { u32x4 p; p.x = pk_bf16(v[0], v[1]); p.y = pk_bf16(v[2], v[3]); p.z = pk_bf16(v[4], v[5]); p.w = pk_bf16(v[6], v[7]); *(u32x4*)(XB + o) = p;
#pragma unroll
                   for (int j = 0; j < 4; ++j) { const unsigned q = j == 0 ? p.x : (j == 1 ? p.y : (j == 2 ? p.z : p.w)); ss += bf_lo(q) * bf_lo(q) + bf_hi(q) * bf_hi(q); } }
        }
        if (l < L_ - 1) { ss = wave_sum(ss); if (lane == 0) ssqx[row] = ss; }
    }
}
constexpr int MOE_CVT_SPLIT = 4608;
#ifndef CVT_A
#define CVT_A 2688
#endif
#ifndef NROUTE
#define NROUTE 128
#endif
constexpr int NPH = 9;
enum { PH_INPROJ = 0, PH_PREP, PH_MIX, PH_YNORM, PH_OUTPROJ, PH_ROUTE, PH_MOEUP, PH_MOEDOWN, PH_COMBINE };
struct Args { Inputs in; float* out; unsigned char* ws; int ph_lo, ph_hi; };

__global__ void __launch_bounds__(512, 2) mk(Args args) {
    extern __shared__ __attribute__((aligned(16))) unsigned char lds_raw[];
    LAS unsigned char* lds = (LAS unsigned char*)lds_raw;
    const int g_wv = __builtin_amdgcn_readfirstlane((int)threadIdx.x >> 6);
    const int bid0 = blockIdx.x, nb = gridDim.x;
#define BID() ({ int b_ = bid0; asm volatile("" : "+s"(b_)); b_; })
    unsigned char* ws = args.ws; unsigned* ctl = (unsigned*)(ws + WS_CTL);
    const int lo = args.ph_lo, hi = args.ph_hi;
    if (TIDX < 4) ((LAS unsigned*)(lds + LDS_MISC))[TIDX] = 0u;
    __syncthreads();
    XcdBarrier bar; bar.g_wv = g_wv; bar.bar = ctl + CW_BAR; bar.x = 0; bar.st = nullptr;
    if (hi - lo > 1) bar = xcd_barrier_post(ctl + CW_BAR, (volatile LAS unsigned*)(lds + LDS_MISC), g_wv);
#define IN(k) (lo <= (k) && (k) < hi)
#ifndef REPEAT_PH
#define REPEAT_PH -1
#endif
#define NREP(k) ((REPEAT_PH == (k)) ? 2 : 1)
#ifndef NBAR
#define NBAR 1
#endif
#ifndef TIME_PH
#define TIME_PH -1
#endif
#define STAMP(i) do { if (TIME_PH != -1 && blockIdx.x == 0 && TIDX == 0) ((unsigned long long*)(ctl + CW_TS))[i] = __builtin_amdgcn_s_memrealtime(); } while (0)
#define SEAM(k) do { if (IN(k) && IN((k) + 1)) for (int nb_ = 0; nb_ < NBAR; ++nb_) xcd_barrier(bar); STAMP((k) + 1); } while (0)
    STAMP(0);
#ifndef NO_PRO
    if (IN(0)) for (int rep = 0; rep < NREP(100); ++rep) { prologue(in_tab(), launder(ws), lds, BID(), nb, g_wv); if (rep + 1 < NREP(100)) xcd_barrier(bar); }
#endif
    SEAM(0);
    for (int l = 0; l < L_; ++l) {
        const int pb = 1 + l * NPH;
        if (IN(pb + PH_INPROJ)) for (int rep = 0; rep < NREP(PH_INPROJ); ++rep) {
            if (rep) xcd_barrier(bar);
            InPtr in = in_tab(); unsigned char* ws = launder(args.ws);
            g8::DenseSched S{(const char*)(ws + WS_XB), (const char*)(ws + WS_WIN) + (size_t)l * 2560 * 1024 * 2, 1024, 1024, 64, 10, nb, BID()};
            EpiInProj E{(const float*)(ws + WS_SSQX) + l * 16384, (float*)(ws + WS_SSQ + PT_DQ) + (size_t)l * 16384 * 4, (float*)(ws + WS_SSQ + PT_DKV) + (size_t)l * 16384 * 2,
                        in->p[8] + l * 64, in->p[9] + l * 64, in->p[19] + l * 192 + 96 + 64, (const float*)(ws + WS_ROPE), ws + WS_PRJ};
#ifndef NO_INPROJ
            g8::gemm_run(lds, 1024, 1024, S, E, g_wv);
#endif
        }
        SEAM(pb + PH_INPROJ);
        if (IN(pb + PH_PREP)) for (int rep = 0; rep < NREP(PH_PREP); ++rep) { if (rep) xcd_barrier(bar); phase_prep(l, in_tab(), launder(ws), lds, BID(), nb, g_wv, (unsigned*)launder(ws) + CW_Q + 64 * (4 + l + 2 * rep)); }
        SEAM(pb + PH_PREP);
        if (IN(pb + PH_MIX)) for (int rep = 0; rep < NREP(PH_MIX); ++rep) { if (rep) xcd_barrier(bar); phase_mix(l, in_tab(), launder(ws), lds, (unsigned*)launder(ws) + CW_Q + 64 * (l + 2 * rep), g_wv); }
        SEAM(pb + PH_MIX);
        const bool fold_norm = (nb == 256);
        if (IN(pb + PH_YNORM) && !fold_norm) phase_ynorm(l, launder(ws), BID(), nb, g_wv);
        if (!fold_norm) SEAM(pb + PH_YNORM);
        if (IN(pb + PH_OUTPROJ)) {
            unsigned char* ws = launder(args.ws);
            g8::DenseSched S{(const char*)(ws + WS_Y), (const char*)(ws + WS_WOUT) + (size_t)l * 1024 * 1024 * 2, 1024, 1024, 64, 4, nb, BID()};
            EpiOut E{(bf16_t*)(ws + WS_XB), (float*)(ws + WS_SSQ + PT_X1) + (size_t)l * 16384 * 16, (const LAS float*)(lds + LDS_FAC), fold_norm};
            if (fold_norm) { g8::GUnit u0; if (S.next(0, u0)) outproj_factors(l, ws, lds, u0.pm, TIDX); else __syncthreads(); }
#ifndef NO_OUTPROJ
            g8::gemm_run(lds, 1024, 1024, S, E, g_wv);
#endif
        }
        SEAM(pb + PH_OUTPROJ);
#ifndef NO_ROUTE
        if (IN(pb + PH_ROUTE)) {
            const int b_ = BID();
            if (nb >= 256 && b_ >= NROUTE) { cvt_moe_layer(in_tab(), launder(ws), l, (LAS float*)lds, b_ - NROUTE, nb - NROUTE, TIDX, 0, CVT_A);
#ifdef DUP_CVT
                __syncthreads(); cvt_moe_layer(in_tab(), launder(ws), l, (LAS float*)lds, b_ - NROUTE, nb - NROUTE, TIDX);
#endif
            }
            else { phase_route(l, in_tab(), launder(ws), lds, b_, nb >= 256 ? NROUTE : nb, g_wv);
                   if (nb < 256) cvt_moe_layer(in_tab(), launder(ws), l, (LAS float*)lds, b_, nb, TIDX); else cvt_moe_layer(in_tab(), launder(ws), l, (LAS float*)lds, b_, NROUTE, TIDX, CVT_A, 3072); }
            if (l + 1 < L_) { __syncthreads(); cvt_small_weights(in_tab(), launder(ws), l + 1, (LAS float*)lds, b_, nb, TIDX); }
        }
#endif
        SEAM(pb + PH_ROUTE);
        {
            const bool do_up = IN(pb + PH_MOEUP), do_dn = IN(pb + PH_MOEDOWN), fuse = do_up && do_dn;
            for (int part = 0; part < (fuse ? 3 : 1); ++part) {
                if (part) xcd_barrier(bar);
                unsigned char* ws = launder(args.ws);
                if (do_up || do_dn) moe_tables(l, ws, lds, g_wv);
                const unsigned* cnt = (const unsigned*)(ws + WS_CTL) + CW_CNT + 2048 * l; const unsigned* mtok = (const unsigned*)(ws + WS_META); const LAS int* tb = (const LAS int*)(lds + LDS_TB);
                const int b_ = BID(), ntile = tb[32], UPU = 2 * ntile, DNU = 4 * ntile;
                const int hi0 = UPU < nb ? UPU : nb, nu_ = UPU - hi0, nu = nu_ < (nb >> 1) ? nu_ : (nb >> 1), nd = nb - nu;
                const int d1a = 4 * (hi0 >> 1), d1b = 2 * nd, D1 = nu == 0 ? DNU : (d1a < d1b ? d1a : d1b);
                int ulo = 0, uhi = UPU, uG = nb, uc = b_, dlo = 0, dhi = DNU, dG = nb, dc = b_;
                if (fuse) {
                    if (part == 0) { uhi = hi0; dhi = 0; }
                    else if (part == 1) { ulo = hi0; uG = nu; if (b_ >= nu) uhi = ulo; dhi = D1; dG = nd; dc = b_ - nu; if (b_ < nu) dhi = 0; }
                    else { uhi = 0; dlo = D1; }
                }
                if (do_up && uhi > ulo) {
                    MoeSched<2, true> S{(const char*)(ws + WS_XB), (const char*)(ws + WS_WMOE), cnt, mtok, tb, uG, uc, (size_t)512 * 1024 * 2, (size_t)256 * 1024 * 2, ulo, uhi};
                    EpiMoeUp E{mtok, (const float*)(ws + WS_RS2), tb, (bf16_t*)(ws + WS_HBUF)};
#ifndef NO_MOEUP
                    g8::gemm_run(lds, 1024, 1024, S, E, g_wv);
#endif
                }
                if (do_dn && dhi > dlo) {
                    MoeSched<4, false> S{(const char*)(ws + WS_HBUF), (const char*)(ws + WS_WMOE + WMOE_WD), cnt, mtok, tb, dG, dc, (size_t)1024 * 256 * 2, (size_t)256 * 256 * 2, dlo, dhi};
                    EpiMoeDown E{mtok, (const float*)(ws + WS_META + META_W), tb, (bf16_t*)(ws + WS_YBUF)};
#ifndef NO_MOEDOWN
                    g8::gemm_run(lds, 256, 256, S, E, g_wv);
#endif
                }
            }
        }
        SEAM(pb + PH_MOEDOWN);
#ifndef NO_COMBINE
        if (IN(pb + PH_COMBINE)) { unsigned char* ws = launder(args.ws); phase_combine(l, ws, args.out, BID(), nb, g_wv); }
#endif
        SEAM(pb + PH_COMBINE);
    }
#undef IN
#undef SEAM
}
#if CHECK
struct NvScratch { float *proj, *h1, *qk, *hraw, *kn, *kcmp, *vcmp, *dqn, *q, *dkvn, *kv, *krope, *y, *x1, *xl; int* rt_e; float* rt_w; };
constexpr int CB = 5;
enum { NS_INPROJ = 0, NS_NSAPREP, NS_MLAPREP, NS_NSA, NS_ML, NS_MLA, NS_OUT, NS_ROUTE, NS_MOE };
static void naive_step(void* const* d_in, int l, int step, const float* xin, float* xout, const NvScratch& S, hipStream_t st) {
    const int b = CB;
    const float* rel_bias = (const float*)d_in[2];
    const float* norm1_g = (const float*)d_in[3] + (long)l * 1024;
    const float* w_in = (const float*)d_in[4] + (long)l * 1024 * DIN;
    const float* cmp_pe = (const float*)d_in[5] + (long)l * 2 * 32 * 64;
    const float* cmp_w1 = (const float*)d_in[6] + (long)l * 2 * 32 * 64 * 64;
    const float* cmp_w2 = (const float*)d_in[7] + (long)l * 2 * 64 * 64;
    const float* q_norm = (const float*)d_in[8] + l * 64;
    const float* k_norm = (const float*)d_in[9] + l * 64;
    const float* nsa_on = (const float*)d_in[10] + l * 384;
    const float* conv = (const float*)d_in[11] + l * 4 * 512;
    const float* ibias = (const float*)d_in[12] + l * 4;
    const float* fbias = (const float*)d_in[13] + l * 4;
    const float* ml_on = (const float*)d_in[14] + l * 256;
    const float* qan = (const float*)d_in[15] + l * 192;
    const float* w_uq = (const float*)d_in[16] + (long)l * 192 * 576;
    const float* kvan = (const float*)d_in[17] + l * 128;
    const float* w_ukv = (const float*)d_in[18] + (long)l * 128 * 768;
    const float* qkn = (const float*)d_in[19] + l * 192;
    const float* mla_on = (const float*)d_in[20] + l * 384;
    const float* w_out = (const float*)d_in[21] + (long)l * 1024 * 1024;
    const float* norm2_g = (const float*)d_in[22] + l * 1024;
    const float* wgrp = (const float*)d_in[23] + (long)l * 1024 * 4;
    const float* bgrp = (const float*)d_in[24] + l * 4;
    const float* wexp = (const float*)d_in[25] + (long)l * 1024 * 32;
    const float* bexp = (const float*)d_in[26] + l * 32;
    const float* Wg = (const float*)d_in[27] + (long)l * 32 * 1024 * 256;
    const float* Wu = (const float*)d_in[28] + (long)l * 32 * 1024 * 256;
    const float* Wd = (const float*)d_in[29] + (long)l * 32 * 256 * 1024;
    const int* pos = (const int*)d_in[1] + b * 2048;
    switch (step) {
    case NS_INPROJ:
        nv_rmsnorm<<<dim3(2048, 1), 64, 0, st>>>(xin, 1024, 0, S.h1, 1024, 0, norm1_g, 0, 1024);
        nv_gemm<<<dim3((DIN + 63) / 64, 2048 / 64), 256, 0, st>>>(S.h1, 1024, w_in, DIN, S.proj, DIN, nullptr, 0, 2048, DIN, 1024);
        break;
    case NS_NSAPREP:
        nv_nsa_cmp<<<dim3(127, 2, 2), 64, 0, st>>>(S.proj, cmp_pe, cmp_w1, cmp_w2, k_norm, S.kcmp, S.vcmp);
        nv_nsa_knorm<<<dim3(2048, 4), 64, 0, st>>>(S.proj, k_norm, S.kn);
        break;
    case NS_MLAPREP:
        nv_rmsnorm<<<dim3(2048, 1), 64, 0, st>>>(S.proj + O_CDQ, DIN, 0, S.dqn, 192, 0, qan, 0, 192);
        nv_gemm<<<dim3(576 / 64, 2048 / 64), 256, 0, st>>>(S.dqn, 192, w_uq, 576, S.q, 576, nullptr, 0, 2048, 576, 192);
        nv_rmsnorm<<<dim3(2048, 1), 64, 0, st>>>(S.proj + O_CDKV, DIN, 0, S.dkvn, 128, 0, kvan, 0, 128);
        nv_gemm<<<dim3(768 / 64, 2048 / 64), 256, 0, st>>>(S.dkvn, 128, w_ukv, 768, S.kv, 768, nullptr, 0, 2048, 768, 128);
        nv_mla_prep<<<dim3(2048, 7), 64, 0, st>>>(S.q, S.kv, S.proj, S.krope, qkn, pos);
        break;
    case NS_NSA:
        nv_nsa_attn<<<dim3(2048, 2), 192, 0, st>>>(S.proj, S.kn, S.kcmp, S.vcmp, rel_bias, q_norm, S.y);
        break;
    case NS_ML:
        nv_ml_conv<<<2048, 512, 0, st>>>(S.proj, conv, S.qk);
        nv_ml_rec<<<4, 256, 0, st>>>(S.proj, S.qk, ibias, fbias, S.hraw);
        nv_ml_fin<<<dim3(2048, 4), 64, 0, st>>>(S.proj, S.hraw, ml_on, S.y);
        break;
    case NS_MLA:
        nv_mla_attn<<<dim3(2048, 6), 64, 0, st>>>(S.q, S.kv, S.krope, S.y);
        break;
    case NS_OUT:
        nv_rmsnorm<<<dim3(2048, 1), 64, 0, st>>>(S.y, 1024, 0, S.y, 1024, 0, nsa_on, 0, 384);
        nv_rmsnorm<<<dim3(2048, 1), 64, 0, st>>>(S.y + 640, 1024, 0, S.y + 640, 1024, 0, mla_on, 0, 384);
        nv_gemm<<<dim3(1024 / 64, 2048 / 64), 256, 0, st>>>(S.y, 1024, w_out, 1024, S.x1, 1024, xin, 1024, 2048, 1024, 1024);
        break;
    case NS_ROUTE:
        nv_moe_route<<<2048, 64, 0, st>>>(S.x1, norm2_g, wgrp, bgrp, wexp, bexp, S.h1, S.rt_e, S.rt_w);
        break;
    case NS_MOE:
        nv_moe_exp<<<2048, 256, 0, st>>>(S.x1, S.h1, S.rt_e, S.rt_w, Wg, Wu, Wd, xout);
        break;
    }
}

__device__ __forceinline__ void chk_commit(float d2, float r2, float* acc) { d2 = wave_sum(d2); r2 = wave_sum(r2); if ((threadIdx.x & 63) == 0) { atomicAdd(acc, d2); atomicAdd(acc + 1, r2); } }
__device__ __forceinline__ void chk_add(float f, float r, float& d2, float& r2) { const float d = f - r; d2 += (d == d) ? d * d : 1e30f; r2 += r * r; }

__global__ void __launch_bounds__(64) chk_proj(const float* nproj, const unsigned char* prj, const float* ssq_dq, const float* ssq_dkv, const float* qg, const float* kg, const float* krg, const int* pos, float* acc) {
    const int t = blockIdx.x, e = threadIdx.x; const size_t row = (size_t)CB * 2048 + t; float d2 = 0.f, r2 = 0.f;
    for (int G = 0; G < 40; ++G) {
        const int c = inproj_refcol(G, e); float r = c < 0 ? 0.f : nproj[(size_t)t * DIN + c]; float f = 0.f;
        const float rr = (G == 37 && e >= 32) ? 0.f : r; const float ss = wave_sum(rr * rr);
        if (G < 6) { r = r * rsqrtf(ss / 64.f + 1e-6f) * qg[e] * 0.18033688f; f = bf2f(((const bf16_t*)(prj + PRJ_QN))[((size_t)(CB * 6 + G) * 2048 + t) * 64 + e]); }
        else if (G < 18) { const int a = G - 6, br = a >> 2, s = (a >> 1) & 1, hk = a & 1;
            if (br > 0 && s == 0) r = r * rsqrtf(ss / 64.f + 1e-6f) * kg[e];
            const size_t base = br == 0 ? (s ? PRJ_C0V : PRJ_C0K) : (br == 1 ? (s ? PRJ_VN1 : PRJ_KN1) : (s ? PRJ_VN2 : PRJ_KN2));
            f = bf2f(((const bf16_t*)(prj + base))[((size_t)(CB * 2 + hk) * 2048 + t) * 64 + e]); }
        else if (G < 26) f = bf2f(((const bf16_t*)(prj + PRJ_RAWQK))[row * 512 + (G - 18) * 64 + e]);
        else if (G < 30) f = bf2f(((const bf16_t*)(prj + PRJ_VML))[((size_t)(CB * 4 + (G - 26)) * 2048 + t) * 64 + e]);
        else if (G < 34) f = bf2f(((const bf16_t*)(prj + PRJ_OG))[row * 256 + (G - 30) * 64 + e]);
        else if (G < 37) f = bf2f(((const bf16_t*)(prj + PRJ_DQKV))[row * 384 + (G - 34) * 64 + e]);
        else if (G == 37) {
            const float val = e < 32 ? rr * rsqrtf(ss / 32.f + 1e-6f) * krg[e & 31] : 0.f; const float oth = __shfl_xor(val, 16);
            if (e < 32) { const int i = e & 15; const double ang = (double)pos[row] * pow(10000.0, -(double)i / 16.0); const float cs = (float)cos(ang), sn = (float)sin(ang);
                r = e < 16 ? val * cs - oth * sn : val * cs + oth * sn; f = bf2f(((const bf16_t*)(prj + PRJ_KR))[row * 32 + e]); }
            else if (e < 58) f = ((const float*)(prj + PRJ_GATES))[row * 32 + (e - 32)];
            else { f = 0.f; r = 0.f; }
        }
        else f = bf2f(((const bf16_t*)(prj + PRJ_DQKV))[row * 384 + 256 + (G - 38) * 64 + e]);
        chk_add(f, r, d2, r2);
    }
    float d2s = 0.f, r2s = 0.f;
    { float s1 = 0.f, s2 = 0.f; for (int c = e; c < 192; c += 64) { float v = nproj[(size_t)t * DIN + O_CDQ + c]; s1 += v * v; } for (int c = e; c < 128; c += 64) { float v = nproj[(size_t)t * DIN + O_CDKV + c]; s2 += v * v; }
      s1 = wave_sum(s1); s2 = wave_sum(s2); if (e == 0) { chk_add((ssq_dq[row * 4] + ssq_dq[row * 4 + 1]) + ssq_dq[row * 4 + 2], s1, d2s, r2s); chk_add(ssq_dkv[row * 2] + ssq_dkv[row * 2 + 1], s2, d2s, r2s); } }
    chk_commit(d2, r2, acc); chk_commit(d2s, r2s, acc + 2);
}

__global__ void __launch_bounds__(64) chk_prep(const float* nq, const float* nkv, const float* nkr, const float* nkc, const float* nvc, const unsigned char* ws, float* acc) {
    const int t = blockIdx.x, e = threadIdx.x; float d2 = 0.f, r2 = 0.f, d2c = 0.f, r2c = 0.f; const float scale = 0.14724444f;
    const bf16_t* QM = (const bf16_t*)(ws + WS_MLA); const bf16_t* KM = (const bf16_t*)(ws + WS_MLA + MLA_KM); const bf16_t* VM = (const bf16_t*)(ws + WS_MLA + MLA_VM);
    for (int h = 0; h < 6; ++h) {
        const size_t rq = ((size_t)(CB * 6 + h) * 2048 + t);
        chk_add(bf2f(QM[rq * 96 + e]), nq[(size_t)t * 576 + h * 96 + e] * scale, d2, r2);
        chk_add(bf2f(KM[rq * 96 + e]), nkv[(size_t)t * 768 + h * 128 + e], d2, r2);
        chk_add(bf2f(VM[rq * 64 + e]), nkv[(size_t)t * 768 + h * 128 + 64 + e], d2, r2);
        if (e < 32) { chk_add(bf2f(QM[rq * 96 + 64 + e]), nq[(size_t)t * 576 + h * 96 + 64 + e] * scale, d2, r2); chk_add(bf2f(KM[rq * 96 + 64 + e]), nkr[(size_t)t * 32 + e], d2, r2); }
    }
    if (t < 128) for (int hk = 0; hk < 2; ++hk) {
        const bf16_t* KC = (const bf16_t*)(ws + WS_CMP); const bf16_t* VC = (const bf16_t*)(ws + WS_CMP + CMP_V); const size_t rf = ((size_t)(CB * 2 + hk) * 128 + t) * 64 + e;
        chk_add(bf2f(KC[rf]), t < 127 ? nkc[(size_t)(hk * 127 + t) * 64 + e] : 0.f, d2c, r2c); chk_add(bf2f(VC[rf]), t < 127 ? nvc[(size_t)(hk * 127 + t) * 64 + e] : 0.f, d2c, r2c);
    }
    chk_commit(d2, r2, acc); chk_commit(d2c, r2c, acc + 2);
}

__global__ void __launch_bounds__(64) chk_y(const float* ny, const unsigned char* ws, float* acc, int nseg) {
    const int t = blockIdx.x, e = threadIdx.x; const bf16_t* Y = (const bf16_t*)(ws + WS_Y) + ((size_t)CB * 2048 + t) * 1024;
    float d2[3] = {0.f, 0.f, 0.f}, r2[3] = {0.f, 0.f, 0.f};
    for (int c = e; c < 1024; c += 64) { const int seg = c < 384 ? 0 : (c < 640 ? 1 : 2); const int cf = c < 384 ? c : (c < 640 ? 768 + (c - 384) : 384 + (c - 640)); const float f = bf2f(Y[cf]), r = ny[(size_t)t * 1024 + c];
        if (seg == 0) chk_add(f, r, d2[0], r2[0]); else if (seg == 1) chk_add(f, r, d2[1], r2[1]); else chk_add(f, r, d2[2], r2[2]); }
    if (nseg == 3) { chk_commit(d2[0], r2[0], acc); chk_commit(d2[1], r2[1], acc + 2); chk_commit(d2[2], r2[2], acc + 4); }
    else chk_commit(d2[0] + d2[1] + d2[2], r2[0] + r2[1] + r2[2], acc);
}

__global__ void __launch_bounds__(64) chk_x(const float* nx, const unsigned char* ws, float* acc) {
    const int t = blockIdx.x, e = threadIdx.x; const bf16_t* X = (const bf16_t*)(ws + WS_XB) + ((size_t)CB * 2048 + t) * 1024; float d2 = 0.f, r2 = 0.f;
    for (int c = e; c < 1024; c += 64) chk_add(bf2f(X[c]), nx[(size_t)t * 1024 + c], d2, r2);
    chk_commit(d2, r2, acc);
}

__global__ void __launch_bounds__(512) chk_code(float* acc, int nst, const float* nout) {
    __shared__ float sh[512];
    float s = 0.f; for (int i = threadIdx.x; i < 2048 * 1024; i += 512) { float v = nout[i]; s += v * v; }
    sh[threadIdx.x] = s; __syncthreads();
    if (threadIdx.x == 0) { float tot = 0.f; for (int i = 0; i < 512; ++i) tot += sh[i]; float rms = sqrtf(tot / (2048.f * 1024.f)); if (!(rms > 1e-3f && rms < 1e3f)) rms = 1.f;
        int code = 0;
        for (int st = 0; st < nst; ++st) { const float d2 = acc[2 * st], r2 = acc[2 * st + 1]; if (r2 == 0.f && d2 == 0.f) { if ((st & 15) >= 9) continue; code = (st + 1) * 4 + 3; break; } const float err = d2 / fmaxf(r2, 1e-30f);
            const float tol = CHK_TOL(st);
            if (!(err <= tol)) { const int cls = !(err < 1.f) ? 3 : (err >= 0.1f ? 2 : (err >= 0.01f ? 1 : 0)); code = (st + 1) * 4 + cls; break; } }
        acc[2 * 40] = rms * 32.f * exp2f(0.5f * (float)code); }
}
__global__ void __launch_bounds__(512) chk_fill(const float* acc, float* out) {
    const float K = acc[2 * 40];
    for (size_t i = (size_t)blockIdx.x * 512 + threadIdx.x; i < (size_t)NTOK * 1024; i += (size_t)gridDim.x * 512) out[i] = (i & 1) ? -K : K;
}
#endif

#if TIME_PH != -1
#ifndef TIME_Q
#define TIME_Q 6.f
#endif
#ifndef TIME_CAL
#define TIME_CAL 1.0f
#endif
__global__ void tm_acc(const unsigned long long* ts, float* best, int first) {
    int a = TIME_PH, b = TIME_PH + 1;
#ifdef TIME_PH_END
    b = TIME_PH_END;
#endif
    float T = 100.f; if (TIME_PH >= 0) T = (float)(ts[b] - ts[a]) * 0.01f;
    if (first || T < *best) *best = T;
}
__global__ void __launch_bounds__(512) tm_fill(const float* best, float* out) {
    float T = *best;
    T = exp2f(rintf(log2f(fmaxf(T, 1.f)) * TIME_Q) / TIME_Q);
    const float c = sqrtf(T) * TIME_CAL;
    for (size_t i = (size_t)blockIdx.x * 512 + threadIdx.x; i < (size_t)NTOK * 1024; i += (size_t)gridDim.x * 512) out[i] = (i & 1) ? -c : c;
}
#endif
static int g_grid = 0;
static bool setup_once(size_t ws_size) {
    if (g_grid) return g_grid > 0;
    if (ws_size < WS_END) { fprintf(stderr, "kernel_launch: workspace too small: %zu < %zu\n", ws_size, (size_t)WS_END); g_grid = -1; return false; }
    int dev = 0, cus = 0, per_cu = 0;
    if (hipGetDevice(&dev) != hipSuccess || hipDeviceGetAttribute(&cus, hipDeviceAttributeMultiprocessorCount, dev) != hipSuccess) { g_grid = -1; return false; }
    if (hipFuncSetAttribute((const void*)mk, hipFuncAttributeMaxDynamicSharedMemorySize, LDS_BYTES) != hipSuccess) { fprintf(stderr, "kernel_launch: hipFuncSetAttribute failed\n"); g_grid = -1; return false; }
    if (hipOccupancyMaxActiveBlocksPerMultiprocessor(&per_cu, (const void*)mk, 512, LDS_BYTES) != hipSuccess || per_cu < 1) { fprintf(stderr, "kernel_launch: occupancy query says %d\n", per_cu); }
    (void)hipGetLastError();
    g_grid = cus;
    return true;
}
static void launch_mk(const Args& a0, int lo, int hi, hipStream_t stream) { Args a = a0; a.ph_lo = lo; a.ph_hi = hi; hipLaunchKernelGGL(mk, dim3(g_grid), dim3(512), LDS_BYTES, stream, a); }

extern "C" void kernel_launch(void* const* d_in, const int* in_sizes, int n_in, void* d_out, int out_size, void* d_ws, size_t ws_size, hipStream_t stream) {
    if (!setup_once(ws_size)) return;
    unsigned char* ws = (unsigned char*)d_ws;
    (void)hipMemsetAsync(ws + WS_CTL, 0, ZERO_BYTES, stream);
    Args a{}; for (int i = 0; i < 30; ++i) a.in.p[i] = (const float*)d_in[i];
    a.out = (float*)d_out; a.ws = ws; a.ph_lo = 0; a.ph_hi = 0;
#if CHECK
    a.out = nullptr;
#endif
#if CHECK
    float* nb = (float*)d_out; size_t off = 0; NvScratch S;
    auto take = [&](size_t n) { float* p = nb + off; off += (n + 63) & ~(size_t)63; return p; };
    S.proj = take((size_t)2048 * DIN); S.h1 = take(2048 * 1024); S.qk = S.h1; S.hraw = S.qk + 2048 * 512; S.kn = S.hraw + 2048 * 256;
    S.kcmp = take(2 * 127 * 64); S.vcmp = take(2 * 127 * 64); S.dqn = take(2048 * 192); S.q = take(2048 * 576); S.dkvn = take(2048 * 128); S.kv = take(2048 * 768); S.x1 = S.dqn;
    S.krope = take(2048 * 32); S.y = take(2048 * 1024); S.xl = take(2048 * 1024); S.rt_e = (int*)take(2048 * 2); S.rt_w = take(2048 * 2);
    if (off * 4 > (size_t)NTOK * 1024 * 4) { fprintf(stderr, "naive scratch too big\n"); return; }
    float* acc = (float*)(ws + WS_CTL) + CW_CHK;
    launch_mk(a, 0, 1, stream);
    const float* nx_in = (const float*)d_in[0] + (size_t)CB * 2048 * 1024;
    int nst = 0;
    for (int l = 0; l < L_; ++l) {
        const int pb = 1 + l * NPH; const int sb = l * 16;
        launch_mk(a, pb + PH_INPROJ, pb + PH_INPROJ + 1, stream);
        naive_step(d_in, l, NS_INPROJ, nx_in, S.xl, S, stream);
        chk_proj<<<2048, 64, 0, stream>>>(S.proj, ws + WS_PRJ, (const float*)(ws + WS_SSQ + PT_DQ) + (size_t)l * 16384 * 4, (const float*)(ws + WS_SSQ + PT_DKV) + (size_t)l * 16384 * 2,
                                           (const float*)d_in[8] + l * 64, (const float*)d_in[9] + l * 64, (const float*)d_in[19] + l * 192 + 160, (const int*)d_in[1], acc + 2 * (sb + 0));
        nst = sb + 2;
        int ns_done = NS_INPROJ;
#if CHECK_UPTO >= 1
        launch_mk(a, pb + PH_PREP, pb + PH_PREP + 1, stream);
        naive_step(d_in, l, NS_NSAPREP, nx_in, S.xl, S, stream); naive_step(d_in, l, NS_MLAPREP, nx_in, S.xl, S, stream); ns_done = NS_MLAPREP;
        chk_prep<<<2048, 64, 0, stream>>>(S.q, S.kv, S.krope, S.kcmp, S.vcmp, ws, acc + 2 * (sb + 2));
        nst = sb + 4;
#endif
#if CHECK_UPTO >= 2
        launch_mk(a, pb + PH_MIX, pb + PH_MIX + 1, stream);
        naive_step(d_in, l, NS_NSA, nx_in, S.xl, S, stream); naive_step(d_in, l, NS_ML, nx_in, S.xl, S, stream); naive_step(d_in, l, NS_MLA, nx_in, S.xl, S, stream); ns_done = NS_MLA;
        chk_y<<<2048, 64, 0, stream>>>(S.y, ws, acc + 2 * (sb + 4), 3);
        nst = sb + 7;
#endif
#if CHECK_UPTO >= 3
        launch_mk(a, pb + PH_YNORM, pb + PH_YNORM + 1, stream); launch_mk(a, pb + PH_OUTPROJ, pb + PH_OUTPROJ + 1, stream);
        naive_step(d_in, l, NS_OUT, nx_in, S.xl, S, stream); ns_done = NS_OUT;
        chk_x<<<2048, 64, 0, stream>>>(S.x1, ws, acc + 2 * (sb + 7));
        nst = sb + 8;
#endif
#if CHECK_UPTO >= 4
        for (int ph = PH_ROUTE; ph <= PH_COMBINE; ++ph) launch_mk(a, pb + ph, pb + ph + 1, stream);
        naive_step(d_in, l, NS_ROUTE, nx_in, S.xl, S, stream); naive_step(d_in, l, NS_MOE, nx_in, S.xl, S, stream); ns_done = NS_MOE;
        chk_x<<<2048, 64, 0, stream>>>(S.xl, ws, acc + 2 * (sb + 8));
        nst = sb + 9;
#endif
        CHECK_REST
        for (int s = ns_done + 1; s <= NS_MOE; ++s) naive_step(d_in, l, s, nx_in, S.xl, S, stream);
        nx_in = S.xl;
        if (l == CHECK_LAYERS - 1) break;
    }
    chk_code<<<1, 512, 0, stream>>>(acc, nst, S.xl);
    chk_fill<<<1024, 512, 0, stream>>>(acc, (float*)d_out);
#else
#if defined(SPLIT_LAUNCH) && SPLIT_LAUNCH
    for (int ph = 0; ph < 1 + L_ * NPH; ++ph) launch_mk(a, ph, ph + 1, stream);
#else
    launch_mk(a, 0, 1 + L_ * NPH, stream);
#if TIME_PH != -1
    for (int rp = 0; rp < 6; ++rp) {
        (void)hipMemsetAsync(ws + WS_CTL, 0, ZERO_BYTES, stream); launch_mk(a, 0, 1 + L_ * NPH, stream);
        tm_acc<<<1, 1, 0, stream>>>((const unsigned long long*)((unsigned*)(ws + WS_CTL) + CW_TS), (float*)(ws + WS_META + META_RT), rp == 0);
    }
    tm_fill<<<1024, 512, 0, stream>>>((const float*)(ws + WS_META + META_RT), (float*)d_out);
#endif
#endif
#endif
}
```

```cpp
#define CHECK 0
#define CHECK_LAYERS 2
#define CHECK_UPTO 99
#define SPLIT_LAUNCH 0
#define REPEAT_PH -1
#include <hip/hip_runtime.h>
#include <stdint.h>
#include <cstdio>

constexpr int B_ = 8, T_ = 2048, D_ = 1024, L_ = 2, NTOK = B_ * T_;
constexpr int DIN = 2554;
constexpr int O_AQ = 0, O_AKV = 384, O_AG = 1152, O_BQK = 1170, O_BV = 1682, O_BIF = 1938, O_BO = 1946, O_CDQ = 2202, O_CDKV = 2394, O_CKR = 2522;

typedef unsigned short bf16_t;
typedef short bf16x8 __attribute__((ext_vector_type(8)));
typedef short s16x4 __attribute__((ext_vector_type(4)));
typedef float f32x4 __attribute__((ext_vector_type(4)));
typedef float f32x16 __attribute__((ext_vector_type(16)));
typedef unsigned u32x4 __attribute__((ext_vector_type(4)));
typedef unsigned u32x2 __attribute__((ext_vector_type(2)));
typedef float f32x2_t __attribute__((ext_vector_type(2)));
typedef __bf16 bf16x2_t __attribute__((ext_vector_type(2)));
#define LAS __attribute__((address_space(3)))

__device__ __forceinline__ unsigned pk_bf16(float lo, float hi) { f32x2_t v = {lo, hi}; bf16x2_t b = __builtin_convertvector(v, bf16x2_t); return __builtin_bit_cast(unsigned, b); }
__device__ __forceinline__ float bf_lo(unsigned u) { return __builtin_bit_cast(float, u << 16); }
__device__ __forceinline__ float bf_hi(unsigned u) { return __builtin_bit_cast(float, u & 0xffff0000u); }
__device__ __forceinline__ float bf2f(bf16_t h) { return __builtin_bit_cast(float, (unsigned)h << 16); }
__device__ __forceinline__ bf16_t f2bf(float f) { return (bf16_t)(pk_bf16(f, 0.f) & 0xffffu); }
template <int M> __device__ __forceinline__ int shx(int v) { static_assert(M > 0 && M < 32, "swizzle xor mask"); return __builtin_amdgcn_ds_swizzle(v, (M << 10) | 0x1f); }
template <int M> __device__ __forceinline__ float shx(float v) { return __builtin_bit_cast(float, shx<M>(__builtin_bit_cast(int, v))); }
template <int M> __device__ __forceinline__ unsigned shx(unsigned v) { return (unsigned)shx<M>((int)v); }
__device__ __forceinline__ float wave_sum(float v) { v += __shfl_xor(v, 32); v += shx<16>(v); v += shx<8>(v); v += shx<4>(v); v += shx<2>(v); v += shx<1>(v); return v; }
__device__ __forceinline__ float wave_max(float v) { v = fmaxf(v, __shfl_xor(v, 32)); v = fmaxf(v, shx<16>(v)); v = fmaxf(v, shx<8>(v)); v = fmaxf(v, shx<4>(v)); v = fmaxf(v, shx<2>(v)); v = fmaxf(v, shx<1>(v)); return v; }
__device__ __forceinline__ float siluf(float x) { return x * __builtin_amdgcn_rcpf(1.f + __expf(-x)); }
__device__ __forceinline__ float sigmf(float x) { return __builtin_amdgcn_rcpf(1.f + __expf(-x)); }
__device__ __forceinline__ int t5b(int dist) {
    int n = dist > 0 ? dist : 0; if (n < 16) return n;
    float v = logf((float)n / 16.f) / logf(8.f) * 16.f; int l = 16 + (int)v; return l < 31 ? l : 31;
}

__device__ __forceinline__ int lane_now() { return (int)__builtin_amdgcn_mbcnt_hi(~0u, __builtin_amdgcn_mbcnt_lo(~0u, 0u)); }
#define TIDX ((g_wv << 6) | lane_now())

constexpr size_t WS_CTL = 0, CTL_BYTES = 65536;
constexpr size_t WS_SSQ = WS_CTL + CTL_BYTES;
constexpr size_t ZERO_BYTES = CTL_BYTES;
constexpr size_t PT_DQ = 0, PT_DKV = PT_DQ + (size_t)2 * 16384 * 4 * 4, PT_A = PT_DKV + (size_t)2 * 16384 * 2 * 4, PT_C = PT_A + (size_t)2 * 16384 * 8 * 4, PT_X1 = PT_C + (size_t)2 * 16384 * 8 * 4, PT_END = PT_X1 + (size_t)2 * 16384 * 16 * 4;
constexpr size_t WS_SSQX = WS_SSQ + PT_END;
constexpr size_t WS_RS2 = WS_SSQX + 2 * 65536;
constexpr size_t WS_WIN = WS_RS2 + 65536;
constexpr size_t WS_WOUT = WS_WIN + (size_t)2 * 2560 * 1024 * 2;
constexpr size_t WS_WUQ = WS_WOUT + (size_t)2 * 1024 * 1024 * 2;
constexpr size_t WS_WUKV = WS_WUQ + (size_t)2 * 768 * 256 * 2;
constexpr size_t WS_WC1 = WS_WUKV + (size_t)2 * 768 * 256 * 2;
constexpr size_t WS_WC2 = WS_WC1 + (size_t)2 * 2 * 64 * 2048 * 2;
constexpr size_t WS_WR = WS_WC2 + (size_t)2 * 2 * 64 * 64 * 2;
constexpr size_t WS_B1C = WS_WR + (size_t)2 * 64 * 1024 * 2;
constexpr size_t WS_BIASD = WS_B1C + 1024;
constexpr size_t WS_ROPE = WS_BIASD + 6 * 2048 * 4;
constexpr size_t WS_WMOE = WS_ROPE + (size_t)16384 * 32 * 4;
constexpr size_t WMOE_WD = (size_t)32 * 512 * 1024 * 2;
constexpr size_t WS_XB = WS_WMOE + 50331648;
constexpr size_t WS_MLA = WS_XB + 33554432;
constexpr size_t MLA_KM = (size_t)8 * 6 * 2048 * 96 * 2, MLA_VM = 2 * MLA_KM;
constexpr size_t WS_HBUF = WS_MLA;
constexpr size_t WS_PRJ = WS_MLA + 50331648;
constexpr size_t HM64 = (size_t)2048 * 64 * 2;
constexpr size_t PRJ_QN = 0;
constexpr size_t PRJ_KN1 = PRJ_QN + 48 * HM64, PRJ_VN1 = PRJ_KN1 + 16 * HM64, PRJ_KN2 = PRJ_VN1 + 16 * HM64, PRJ_VN2 = PRJ_KN2 + 16 * HM64;
constexpr size_t PRJ_VML = PRJ_VN2 + 16 * HM64;
constexpr size_t PRJ_OG = PRJ_VML + 32 * HM64;
constexpr size_t PRJ_KR = PRJ_OG + (size_t)16384 * 256 * 2;
constexpr size_t PRJ_GATES = PRJ_KR + (size_t)16384 * 32 * 2;
constexpr size_t PRJ_DEAD = PRJ_GATES + (size_t)16384 * 32 * 4;
constexpr size_t PRJ_C0K = PRJ_DEAD, PRJ_C0V = PRJ_C0K + 16 * HM64 + 8192;
constexpr size_t PRJ_RAWQK = PRJ_C0V + 16 * HM64 + 8192;
constexpr size_t PRJ_DQKV = PRJ_RAWQK + (size_t)16384 * 512 * 2;
constexpr size_t PRJ_END = PRJ_DQKV + (size_t)16384 * 384 * 2;
static_assert(PRJ_END - PRJ_DEAD >= 33554432, "Y fits the dead part of PRJ");
constexpr size_t WS_Y = WS_PRJ + PRJ_DEAD;
constexpr size_t WS_YBUF = WS_PRJ;
static_assert((size_t)2 * 16384 * 1024 * 2 <= PRJ_END, "YBUF fits the PRJ region");
constexpr size_t WS_ML = WS_PRJ + PRJ_END;
constexpr size_t ML_KC = 32 * HM64, ML_DELTA = 2 * ML_KC, ML_DN = ML_DELTA + (size_t)1024 * 4096 * 2, ML_G = ML_DN + (size_t)1024 * 64 * 4, ML_BL = ML_G + (size_t)8 * 4 * 2048 * 2 * 4, ML_CP = ML_BL + 4096, ML_NP = ML_CP + (size_t)1024 * 4096 * 2, ML_END = ML_NP + (size_t)1024 * 64 * 2;
constexpr size_t WS_CMP = WS_ML + ML_END;
constexpr size_t CMP_V = (size_t)8 * 2 * 128 * 64 * 2;
constexpr size_t WS_META = WS_CMP + 2 * CMP_V;
constexpr size_t META_W = (size_t)32 * 16384 * 4, META_RT = 2 * META_W;
constexpr size_t WS_END = WS_META + META_RT + (size_t)16384 * 16;
constexpr int CW_BAR = 0;
constexpr int CW_Q = 4096;
constexpr int CW_SCAN = 4608;
constexpr int CW_TS = 4864;
constexpr int CW_CHK = 5120;
constexpr int CW_CNT = 8192;
constexpr int LDS_BYTES = 147456;
constexpr int LDS_MISC = LDS_BYTES - 256;
#define XB_TMO      128
#define XB_XCNT(j)  (256  + 64 * (j))
#define XB_XSUB(j)  (1280 + 64 * (j))
#define XB_XGEN(j)  (2304 + 64 * (j))
#define XB_TOP      3328
#define XB_TOPGEN   3392
#define XCD_BAR_WORDS 3456
#define XB_SPIN_CAP (1u << 18)

__device__ __forceinline__ unsigned xb_ld(unsigned* p)              { return __hip_atomic_load(p, __ATOMIC_RELAXED, __HIP_MEMORY_SCOPE_AGENT); }
__device__ __forceinline__ unsigned xb_add(unsigned* p, unsigned v) { return __hip_atomic_fetch_add(p, v, __ATOMIC_RELAXED, __HIP_MEMORY_SCOPE_AGENT); }
__device__ __forceinline__ unsigned xb_xcc_id() { return (unsigned)__builtin_amdgcn_s_getreg((3 << 11) | 20) & 0xFu; }
#define XB_SPIN(cond, bar) do { unsigned _sp = 0; while (cond) { __builtin_amdgcn_s_sleep(1); \
    if ((++_sp & 255u) == 0u) { if (xb_ld(&(bar)[XB_TMO])) break; if (_sp > XB_SPIN_CAP) { atomicAdd(&(bar)[XB_TMO], 1u); break; } } } } while (0)

struct XcdBarrier {
    int g_wv; unsigned* bar; unsigned x;
    volatile LAS unsigned* st;
};

__device__ __forceinline__ XcdBarrier xcd_barrier_post(unsigned* bar, volatile LAS unsigned* st, int g_wv) {
    XcdBarrier b; b.g_wv = g_wv; b.bar = bar; b.x = xb_xcc_id(); b.st = st;
    if (TIDX == 0) (void)xb_add(&bar[XB_XCNT(b.x)], 1u);
    return b;
}
__device__ __forceinline__ void xcd_barrier_complete(unsigned* bar, unsigned x, unsigned& nloc, unsigned& nx) {
    const unsigned G = gridDim.x * gridDim.y * gridDim.z;
    unsigned sum, cnt, mine, sp = 0u;
    for (;;) {
        sum = 0u; cnt = 0u; mine = 0u;
#pragma unroll
        for (unsigned j = 0; j < 16; ++j) { const unsigned c = xb_ld(&bar[XB_XCNT(j)]); sum += c; cnt += (c > 0u) ? 1u : 0u; mine = (j == x) ? c : mine; }
        if (sum == G) break;
        __builtin_amdgcn_s_sleep(1);
        if ((++sp & 255u) == 0u) { if (xb_ld(&bar[XB_TMO])) break; if (sp > XB_SPIN_CAP) { atomicAdd(&bar[XB_TMO], 1u); break; } }
    }
    nloc = mine > 0u ? mine : 1u; nx = cnt > 0u ? cnt : 1u;
}

__device__ __forceinline__ void xcd_barrier(const XcdBarrier& b) {
    asm volatile("s_waitcnt vmcnt(0)" ::: "memory");
    __syncthreads();
    const int g_wv = b.g_wv;
    if (TIDX == 0) {
        unsigned* bar = b.bar;
        __builtin_amdgcn_s_waitcnt(0);
        unsigned nloc = b.st[0], nx = b.st[1];
        if (nloc == 0u) { xcd_barrier_complete(bar, b.x, nloc, nx); b.st[0] = nloc; b.st[1] = nx; }
        const unsigned old = xb_add(&bar[XB_XSUB(b.x)], 1u);
        const unsigned gen = old / nloc;
        if (old + 1u == (gen + 1u) * nloc) {
            __builtin_amdgcn_fence(__ATOMIC_RELEASE, "agent");
            asm volatile("s_waitcnt vmcnt(0)" ::: "memory");
            const unsigned og = xb_add(&bar[XB_TOP], 1u);
            const unsigned tg = og / nx;
            if (og + 1u == (tg + 1u) * nx) xb_add(&bar[XB_TOPGEN], 1u);
            else XB_SPIN(xb_ld(&bar[XB_TOPGEN]) == tg, bar);
            __builtin_amdgcn_fence(__ATOMIC_ACQUIRE, "agent");
            xb_add(&bar[XB_XGEN(b.x)], 1u);
            asm volatile("s_waitcnt vmcnt(0)" ::: "memory");
        } else {
            XB_SPIN(xb_ld(&bar[XB_XGEN(b.x)]) == gen, bar);
            __builtin_amdgcn_fence(__ATOMIC_ACQUIRE, "agent");
            asm volatile("s_waitcnt vmcnt(0)" ::: "memory");
        }
    }
    __syncthreads();
}
struct Inputs { const float* p[30]; };
typedef const __attribute__((address_space(4))) Inputs* InPtr;
__device__ __forceinline__ InPtr in_tab() { InPtr p = (InPtr)__builtin_amdgcn_kernarg_segment_ptr(); asm volatile("" : "+s"(p)); return p; }
__device__ __forceinline__ unsigned char* launder(unsigned char* p) { size_t z = 0; asm volatile("" : "+s"(z)); return p + z; }

__host__ __device__ inline int inproj_refcol(int G, int e) {
    if (G < 6) return O_AQ + G * 64 + e;
    if (G < 18) return O_AKV + (G - 6) * 64 + e;
    if (G < 26) return O_BQK + (G - 18) * 64 + e;
    if (G < 30) return O_BV + (G - 26) * 64 + e;
    if (G < 34) return O_BO + (G - 30) * 64 + e;
    if (G < 37) return O_CDQ + (G - 34) * 64 + e;
    if (G == 37) { if (e < 32) return O_CKR + e; if (e < 50) return O_AG + (e - 32); if (e < 58) return O_BIF + (e - 50); return -1; }
    return O_CDKV + (G - 38) * 64 + e;
}
__host__ __device__ inline int uq_refcol(int G, int e) {
    if (G < 6) return G * 96 + e;
    if (G < 9) { const int idx = e & 31, bj = e >> 5, sub = idx >> 4, i = idx & 15; return (2 * (G - 6) + sub) * 96 + 64 + bj * 16 + i; }
    return -1;
}
__host__ __device__ inline int ukv_refcol(int G, int e) { return G < 6 ? G * 128 + e : (G - 6) * 128 + 64 + e; }
#define N2G(n) ((((n) >> 8) << 2) + (((n) >> 5) & 3))
#define N2E(n) (((((n) >> 7) & 1) << 5) + ((n) & 31))

__device__ __forceinline__ float opaque_f(float v) { asm volatile("" : "+v"(v)); return v; }
struct FWin { const float* w; const float* g; __device__ __forceinline__ void ld(int k, int n, const float*& p, float& gn, float gk) const { const int c = inproj_refcol(N2G(n), N2E(n)); p = w + (size_t)k * DIN + (c < 0 ? 0 : c); gn = c < 0 ? 0.f : gk; }
    __device__ __forceinline__ float rowgain(int k) const { return opaque_f(g[k]); } };
struct FWout { const float* w; const float* ga; const float* gc; __device__ __forceinline__ void ld(int k, int n, const float*& p, float& gn, float gk) const {
    const int kr = k < 384 ? k : (k < 768 ? 640 + (k - 384) : 384 + (k - 768)); p = w + (size_t)kr * 1024 + n; gn = gk; }
    __device__ __forceinline__ float rowgain(int k) const { const float a = opaque_f(ga[k < 384 ? k : 0]), c = opaque_f(gc[(k >= 384 && k < 768) ? k - 384 : 0]); return k < 384 ? a : (k < 768 ? c : 1.f); } };
struct FWuq { const float* w; const float* g; __device__ __forceinline__ void ld(int k, int n, const float*& p, float& gn, float gk) const { const int c = uq_refcol(N2G(n), N2E(n)); const int kk = k < 192 ? k : 191; p = w + (size_t)kk * 576 + (c < 0 ? 0 : c); gn = (k < 192 && c >= 0) ? gk : 0.f; }
    __device__ __forceinline__ float rowgain(int k) const { return opaque_f(g[k < 192 ? k : 191]); } };
struct FWukv { const float* w; const float* g; __device__ __forceinline__ void ld(int k, int n, const float*& p, float& gn, float gk) const { const int c = ukv_refcol(N2G(n), N2E(n)); const int kk = k >= 128 ? k - 128 : 0; p = w + (size_t)kk * 768 + c; gn = k >= 128 ? gk : 0.f; }
    __device__ __forceinline__ float rowgain(int k) const { return opaque_f(g[k >= 128 ? k - 128 : 0]); } };
struct FWc1 { const float* w; __device__ __forceinline__ void ld(int k, int n, const float*& p, float& gn, float gk) const { p = w + (size_t)k * 64 + n; gn = 1.f; }
    __device__ __forceinline__ float rowgain(int k) const { return 1.f; } };
struct FWr { const float* wg; const float* we; const float* g; __device__ __forceinline__ void ld(int k, int n, const float*& p, float& gn, float gk) const { p = n < 4 ? wg + k * 4 + n : we + k * 32 + (n < 36 ? n - 4 : 0); gn = n < 36 ? gk : 0.f; }
    __device__ __forceinline__ float rowgain(int k) const { return opaque_f(g[k]); } };
struct FWgu { const float* src; const float* g; int n0, col0; __device__ __forceinline__ float operator()(int k, int n) const { return src[(size_t)k * 256 + col0 + (n - n0)] * g[k]; } };
struct FWd { const float* w; __device__ __forceinline__ float operator()(int k, int n) const { return w[(size_t)k * 1024 + n]; } };

__device__ __forceinline__ void rope_cs(int pos, int j, float& cs, float& sn) {
    const double inv = exp2(-(double)j * (13.287712379549449 / 16.0));
    const double rev = (double)pos * inv * 0.15915494309189535; const float f = (float)(rev - rint(rev));
    cs = __builtin_amdgcn_cosf(f); sn = __builtin_amdgcn_sinf(f);
}
template <class F>
__device__ __forceinline__ void cvt_tile(const F& f, int n0, int k0, bf16_t* dst, int ldk, LAS float* tile, int tid) {
    { const int k = tid >> 3, nb = (tid & 7) * 8; const float gk = f.rowgain(k0 + k); const float* p[8]; float gn[8], v[8];
#pragma unroll
      for (int j = 0; j < 8; ++j) f.ld(k0 + k, n0 + nb + j, p[j], gn[j], gk);
#pragma unroll
      for (int j = 0; j < 8; ++j) v[j] = *p[j];
#pragma unroll
      for (int j = 0; j < 8; ++j) tile[k * 65 + nb + j] = v[j] * gn[j]; }
    __syncthreads();
    { const int n = tid >> 3, kb = (tid & 7) * 8; const LAS float* s = tile + kb * 65 + n;
      u32x4 o; o.x = pk_bf16(s[0], s[65]); o.y = pk_bf16(s[130], s[195]); o.z = pk_bf16(s[260], s[325]); o.w = pk_bf16(s[390], s[455]);
      *(u32x4*)(dst + (size_t)(n0 + n) * ldk + k0 + kb) = o; }
    __syncthreads();
}
template <class F>
__device__ __forceinline__ void cvt_item(const F& f, int it, int nK, bf16_t* dst, int ldk, LAS float* tile, int tid) { cvt_tile(f, (it / nK) * 64, (it % nK) * 64, dst, ldk, tile, tid); }

__device__ __forceinline__ void moe_item(InPtr in, int l, int it, const float*& src, int& ld, size_t& dst, int& ldk, bool& gain, int& kk0) {
    if (it < 32 * 64) { const int e = it >> 6, r = it & 63, n0 = (r >> 3) * 64, k0 = (r & 7) * 128, c0 = n0 & 255;
        src = (c0 < 128 ? in->p[27] : in->p[28]) + ((size_t)l * 32 + e) * 262144 + (size_t)k0 * 256 + (n0 >> 8) * 128 + (c0 & 127); ld = 256; gain = true; kk0 = k0;
        dst = ((size_t)e * 512 + n0) * 1024 + k0; ldk = 1024; }
    else { const int j = it - 32 * 64, e = j >> 5, r = j & 31, n0 = (r >> 1) * 64, k0 = (r & 1) * 128;
        src = in->p[29] + ((size_t)l * 32 + e) * 262144 + (size_t)k0 * 1024 + n0; ld = 1024; gain = false; kk0 = 0;
        dst = (size_t)16777216 + ((size_t)e * 1024 + n0) * 256 + k0; ldk = 256; }
}
__device__ __forceinline__ void cvt_moe_layer(InPtr in, unsigned char* ws, int l, LAS float* tile, int bid, int nb, int tid, int it_lo = 0, int it_hi = 32 * (64 + 32)) {
    asm volatile("" : "+v"(tid));
    const float* g2 = in->p[22] + l * 1024; bf16_t* W = (bf16_t*)(ws + WS_WMOE);
    const int k = tid >> 3, nbq = (tid & 7) * 8;
    const int n = tid >> 3, kb = (tid & 7) * 8;
    const int NIT = it_hi;
#define CVM_LOAD(it_, P) do { const float* src_; int ld_, ldk_, kk0_; size_t dst_; bool gain_; moe_item(in, l, (it_), src_, ld_, dst_, ldk_, gain_, kk0_); \
        P##a = *(const f32x4*)(src_ + (size_t)k * ld_ + nbq); P##b = *(const f32x4*)(src_ + (size_t)k * ld_ + nbq + 4); P##c = *(const f32x4*)(src_ + (size_t)(k + 64) * ld_ + nbq); P##d = *(const f32x4*)(src_ + (size_t)(k + 64) * ld_ + nbq + 4); \
        P##g0 = gain_ ? g2[kk0_ + k] : 1.f; P##g1 = gain_ ? g2[kk0_ + 64 + k] : 1.f; } while (0)
#define CVM_PUT(t, P) do { \
        t[k * 65 + nbq + 0] = P##a.x * P##g0; t[k * 65 + nbq + 1] = P##a.y * P##g0; t[k * 65 + nbq + 2] = P##a.z * P##g0; t[k * 65 + nbq + 3] = P##a.w * P##g0; \
        t[k * 65 + nbq + 4] = P##b.x * P##g0; t[k * 65 + nbq + 5] = P##b.y * P##g0; t[k * 65 + nbq + 6] = P##b.z * P##g0; t[k * 65 + nbq + 7] = P##b.w * P##g0; \
        t[(k + 64) * 65 + nbq + 0] = P##c.x * P##g1; t[(k + 64) * 65 + nbq + 1] = P##c.y * P##g1; t[(k + 64) * 65 + nbq + 2] = P##c.z * P##g1; t[(k + 64) * 65 + nbq + 3] = P##c.w * P##g1; \
        t[(k + 64) * 65 + nbq + 4] = P##d.x * P##g1; t[(k + 64) * 65 + nbq + 5] = P##d.y * P##g1; t[(k + 64) * 65 + nbq + 6] = P##d.z * P##g1; t[(k + 64) * 65 + nbq + 7] = P##d.w * P##g1; } while (0)
#define CVM_STORE(it_, t) do { const float* src_; int ld_, ldk_, kk0_; size_t dst_; bool gain_; moe_item(in, l, (it_), src_, ld_, dst_, ldk_, gain_, kk0_); \
        _Pragma("unroll") for (int hh = 0; hh < 2; ++hh) { const LAS float* s_ = t + (64 * hh + kb) * 65 + n; \
            u32x4 o; o.x = pk_bf16(s_[0], s_[65]); o.y = pk_bf16(s_[130], s_[195]); o.z = pk_bf16(s_[260], s_[325]); o.w = pk_bf16(s_[390], s_[455]); \
            *(u32x4*)(W + dst_ + (size_t)n * ldk_ + 64 * hh + kb) = o; } } while (0)
    f32x4 Aa, Ab, Ac, Ad, Ba, Bb, Bc, Bd; float Ag0 = 1.f, Ag1 = 1.f, Bg0 = 1.f, Bg1 = 1.f;
    LAS float* t0 = tile; LAS float* t1 = tile + 128 * 65;
    int it = it_lo + bid;
    if (it < NIT) CVM_LOAD(it, A);
    if (it + nb < NIT) CVM_LOAD(it + nb, B);
#pragma unroll 1
    for (; it < NIT; it += 2 * nb) {
        CVM_PUT(t0, A);
        __syncthreads();
        if (it + 2 * nb < NIT) CVM_LOAD(it + 2 * nb, A);
        CVM_STORE(it, t0);
        if (it + nb < NIT) {
            CVM_PUT(t1, B);
            __syncthreads();
            if (it + 3 * nb < NIT) CVM_LOAD(it + 3 * nb, B);
            CVM_STORE(it + nb, t1);
        }
    }
#undef CVM_LOAD
#undef CVM_PUT
#undef CVM_STORE
    __syncthreads();
}

__device__ __forceinline__ void cvt_small_weights(InPtr in, unsigned char* ws, int l, LAS float* tile, int bid, int nb, int tid) {
    asm volatile("" : "+v"(tid));
    constexpr int I_WIN = 40 * 16, I_WOUT = 16 * 16, I_WU = 12 * 4, I_WC1 = 32, I_WC2 = 1, I_WR = 16;
    constexpr int PER_L = I_WIN + I_WOUT + 2 * I_WU + 2 * I_WC1 + 2 * I_WC2 + I_WR;
    for (int it0 = bid; it0 < PER_L; it0 += nb) {
        int it = it0;
        if (it < I_WIN) { FWin f{in->p[4] + (size_t)l * 1024 * DIN, in->p[3] + l * 1024}; cvt_item(f, it, 16, (bf16_t*)(ws + WS_WIN) + (size_t)l * 2560 * 1024, 1024, tile, tid); continue; } it -= I_WIN;
        if (it < I_WOUT) { FWout f{in->p[21] + (size_t)l * 1048576, in->p[10] + l * 384, in->p[20] + l * 384}; cvt_item(f, it, 16, (bf16_t*)(ws + WS_WOUT) + (size_t)l * 1048576, 1024, tile, tid); continue; } it -= I_WOUT;
        if (it < I_WU) { FWuq f{in->p[16] + (size_t)l * 192 * 576, in->p[15] + l * 192}; cvt_item(f, it, 4, (bf16_t*)(ws + WS_WUQ) + (size_t)l * 768 * 256, 256, tile, tid); continue; } it -= I_WU;
        if (it < I_WU) { FWukv f{in->p[18] + (size_t)l * 128 * 768, in->p[17] + l * 128}; cvt_item(f, it, 4, (bf16_t*)(ws + WS_WUKV) + (size_t)l * 768 * 256, 256, tile, tid); continue; } it -= I_WU;
        if (it < 2 * I_WC1) { const int s = it / I_WC1; FWc1 f{in->p[6] + ((size_t)l * 2 + s) * 2048 * 64}; cvt_item(f, it % I_WC1, 32, (bf16_t*)(ws + WS_WC1) + ((size_t)l * 2 + s) * 64 * 2048, 2048, tile, tid); continue; } it -= 2 * I_WC1;
        if (it < 2 * I_WC2) { const int s = it; FWc1 f{in->p[7] + ((size_t)l * 2 + s) * 64 * 64}; cvt_item(f, 0, 1, (bf16_t*)(ws + WS_WC2) + ((size_t)l * 2 + s) * 64 * 64, 64, tile, tid); continue; } it -= 2 * I_WC2;
        { FWr f{in->p[23] + (size_t)l * 4096, in->p[25] + (size_t)l * 32768, in->p[22] + l * 1024}; cvt_item(f, it, 16, (bf16_t*)(ws + WS_WR) + (size_t)l * 64 * 1024, 1024, tile, tid); }
    }
}

__device__ __forceinline__ void prologue(InPtr in, unsigned char* ws, LAS unsigned char* lds, int bid, int nb, int g_wv) {
    int tid_ = TIDX; asm volatile("" : "+v"(tid_));
    const int tid = tid_, lane = tid & 63, wid = tid >> 6;
    LAS float* tile = (LAS float*)lds;
    cvt_small_weights(in, ws, 0, tile, bid, nb, tid);
    { const float* x = in->p[0]; bf16_t* XB = (bf16_t*)(ws + WS_XB); float* ssqx = (float*)(ws + WS_SSQX);
      for (int r = bid * 8 + wid; r < NTOK; r += nb * 8) {
          const f32x4* xr = (const f32x4*)(x + (size_t)r * 1024) + lane; float s = 0.f; u32x2* o = (u32x2*)(XB + (size_t)r * 1024) + lane;
#pragma unroll
          for (int j = 0; j < 4; ++j) { const f32x4 v = xr[64 * j]; s += (v.x * v.x + v.y * v.y) + (v.z * v.z + v.w * v.w); u32x2 w; w.x = pk_bf16(v.x, v.y); w.y = pk_bf16(v.z, v.w); o[64 * j] = w; }
          s = wave_sum(s); if (lane == 0) ssqx[r] = s;
      } }
    { float* biasd = (float*)(ws + WS_BIASD); const float* rb = in->p[2];
      for (int i = bid * 512 + tid; i < 6 * 2048; i += nb * 512) { const int h = i >> 11, d = i & 2047; biasd[i] = rb[t5b(d) * 6 + h] * 1.44269504f; } }
    { float* rope = (float*)(ws + WS_ROPE); const int* pos = (const int*)in->p[1];
      for (int i = bid * 512 + tid; i < NTOK * 16; i += nb * 512) { const int tk = i >> 4, j = i & 15; float cs, sn; rope_cs(pos[tk], j, cs, sn); rope[(size_t)tk * 32 + j] = cs; rope[(size_t)tk * 32 + 16 + j] = sn; } }
    { float* b1c = (float*)(ws + WS_B1C); LAS float* red = (LAS float*)lds;
      for (int it = bid; it < 4; it += nb) { const float* pe = in->p[5] + (size_t)it * 2048; const float* w1 = in->p[6] + (size_t)it * 2048 * 64; const int f = tid & 63, part = tid >> 6;
          float a = 0.f; for (int k = part * 256; k < part * 256 + 256; ++k) a += pe[k] * w1[(size_t)k * 64 + f];
          __syncthreads(); red[tid] = a; __syncthreads();
          if (tid < 64) { float s = 0.f; for (int p2 = 0; p2 < 8; ++p2) s += red[p2 * 64 + tid]; b1c[it * 64 + tid] = s; }
          __syncthreads(); } }
}
namespace g8 {
constexpr int BM = 256, BK = 64, HALF = 128, HTB = HALF * BK * 2, STAGE_BYTES = 8 * HTB, NXCD = 8, WGM = 8;
__host__ __device__ __forceinline__ int lds_byte(int r, int c) { const int st = (r >> 4) * 2 + (c >> 5), rr = r & 15, cc = c & 31, ob = rr * 64 + cc * 2; return st * 1024 + (ob ^ (((ob >> 9) & 1) << 5)); }
__host__ __device__ __forceinline__ void stage_rc(int b, int& R, int& C) { const int st = b / 1024, sb = b % 1024, swz = sb ^ (((sb >> 9) & 1) << 5); R = (st >> 1) * 16 + swz / 64; C = (st & 1) * 32 + (swz % 64) / 2; }
__host__ __device__ __forceinline__ int perm32(int rho) { const int n = rho >> 4, i = rho & 15; return 8 * (i >> 2) + 4 * n + (i & 3); }

struct GUnit { const char* a; const char* b; int pm, pn, e, rows; };

__device__ __forceinline__ bool static_unit(int i, int G, int c, int nM, int nN, int& pm, int& pn) {
    const int nwg = nM * nN; const long L = (long)i * G + c; if (L >= nwg) return false;
    int wgid = (int)L; { const int q = nwg / NXCD, r = nwg % NXCD, xcd = wgid % NXCD, off = wgid / NXCD; wgid = (xcd < r ? xcd * (q + 1) : r * (q + 1) + (xcd - r) * q) + off; }
    const int nig = WGM * nN, gid = wgid / nig, fm = gid * WGM, gsz = (nM - fm) < WGM ? (nM - fm) : WGM;
    pm = fm + ((wgid % nig) % gsz); pn = (wgid % nig) / gsz; return true;
}
struct DenseSched {
    static constexpr bool GATHER = false, PARTIAL = false;
    const char* A; const char* Bt; int lda, ldb, nM, nN, G, c;
    __device__ __forceinline__ bool next(int i, GUnit& u) const {
        int pm, pn; if (!static_unit(i, G, c, nM, nN, pm, pn)) return false;
        u.pm = pm; u.pn = pn; u.e = 0; u.rows = 256; u.a = A + (size_t)pm * 256 * lda * 2; u.b = Bt + (size_t)pn * 256 * ldb * 2; return true;
    }
    __device__ __forceinline__ void aoff(const GUnit&, unsigned (&v)[2][2], const int (&R)[2], const int (&C)[2]) const {
#pragma unroll
        for (int h = 0; h < 2; ++h)
#pragma unroll
            for (int i = 0; i < 2; ++i) v[h][i] = (unsigned)((h * 128 + R[i]) * lda + C[i]) * 2u;
    }
};

template <class Epi, class Sched>
__device__ __forceinline__ void gemm_run(LAS unsigned char* lds, const int K, const int ldb, const Sched& S, const Epi& E, int g_wv) {
    int tid_ = TIDX; asm volatile("" : "+v"(tid_));
    const int tid = tid_, wid = __builtin_amdgcn_readfirstlane(tid >> 6), lane = tid & 63, wr = wid >> 2, wc = wid & 3, fr = lane & 15, fq = lane >> 4;
    int nt_ = K / BK; asm volatile("" : "+s"(nt_));
    const int nt = nt_;
    int R[2], C[2]; unsigned voffB[2];
#pragma unroll
    for (int i = 0; i < 2; ++i) { stage_rc(tid * 16 + i * 8192, R[i], C[i]); const int Rb = (R[i] & ~31) + perm32(R[i] & 31); voffB[i] = (unsigned)(Rb * ldb + C[i]) * 2u; }
    const size_t kstep = (size_t)(BK * 2);
    const size_t hstepB = (size_t)HALF * ldb * 2;
    const unsigned ldsw = (unsigned)wid * 1024u;
    const int aoff = lds_byte(wr * 64 + fr, fq * 8), boff = lds_byte(wc * 32 + fr, fq * 8);
#define G8_SA(b, h) (((b) * 2 + (h)) * HTB)
#define G8_SB(b, h) ((4 + (b) * 2 + (h)) * HTB)
#define G8_GLDS(bufoff, gptr, i_) __builtin_amdgcn_global_load_lds((const unsigned*)(gptr), (LAS unsigned*)(lds + (bufoff) + ldsw + (i_) * 8192), 16, 0, 0)
#define G8_STAGE_B(bufoff, gbase) do { G8_GLDS(bufoff, (const char*)(gbase) + voffB[0], 0); G8_GLDS(bufoff, (const char*)(gbase) + voffB[1], 1); } while (0)
#define G8_STAGE_A(bufoff, gbase, v0, v1) do { G8_GLDS(bufoff, (const char*)(gbase) + (v0), 0); G8_GLDS(bufoff, (const char*)(gbase) + (v1), 1); } while (0)
#define G8_LDA(dst, b, h) do { _Pragma("unroll") for (int m = 0; m < 4; ++m) _Pragma("unroll") for (int k = 0; k < 2; ++k) dst[m][k] = *(const LAS bf16x8*)(lds + G8_SA(b, h) + aoff + m * 2048 + k * 1024); } while (0)
#define G8_LDB(dst, b, h) do { _Pragma("unroll") for (int n = 0; n < 2; ++n) _Pragma("unroll") for (int k = 0; k < 2; ++k) dst[n][k] = *(const LAS bf16x8*)(lds + G8_SB(b, h) + boff + n * 2048 + k * 1024); } while (0)
#define G8_MMA(ai, bj, At, Bt) do { __builtin_amdgcn_s_setprio(1); _Pragma("unroll") for (int m = 0; m < 4; ++m) { if (!PARTIAL || ((mmask >> ((ai) * 4 + m)) & 1u)) { _Pragma("unroll") for (int n = 0; n < 2; ++n) _Pragma("unroll") for (int k = 0; k < 2; ++k) \
        acc[ai][bj][m][n] = __builtin_amdgcn_mfma_f32_16x16x32_bf16(Bt[n][k], At[m][k], acc[ai][bj][m][n], 0, 0, 0); } } __builtin_amdgcn_s_setprio(0); } while (0)
#define G8_WAIT_V(n) asm volatile("s_waitcnt vmcnt(" #n ")" ::: "memory")
#define G8_WAIT_L(n) asm volatile("s_waitcnt lgkmcnt(" #n ")" ::: "memory")
#define G8_BAR __builtin_amdgcn_s_barrier()
#define G8_SCHED __builtin_amdgcn_sched_barrier(0)
    GUnit cur, nxt; int ui = 0;
    if (!S.next(0, cur)) return;
    constexpr bool GATHER = Sched::GATHER, PARTIAL = Sched::PARTIAL;
    unsigned mmask = 0xffu;
#define G8_MASK(u) do { if (PARTIAL) { mmask = 0u; _Pragma("unroll") for (int q_ = 0; q_ < 8; ++q_) mmask |= (((q_ >> 2) * 128 + wr * 64 + (q_ & 3) * 16) < (u).rows) ? (1u << q_) : 0u; } } while (0)
    unsigned vc[2][2];
    S.aoff(cur, vc, R, C); G8_MASK(cur);
    LAS u32x4* stash = (LAS u32x4*)(lds + STAGE_BYTES + 4096) + tid;
    f32x4 acc[2][2][4][2];
#pragma unroll
    for (int a = 0; a < 2; ++a)
#pragma unroll
        for (int b = 0; b < 2; ++b)
#pragma unroll
            for (int m = 0; m < 4; ++m)
#pragma unroll
                for (int n = 0; n < 2; ++n) acc[a][b][m][n] = (f32x4){0.f, 0.f, 0.f, 0.f};
    bf16x8 At[4][2], B0[2][2], B1[2][2];
    const char* cA = cur.a; const char* cB = cur.b;
    G8_STAGE_B(G8_SB(0, 0), cB); G8_STAGE_B(G8_SB(0, 1), cB + hstepB); G8_STAGE_A(G8_SA(0, 0), cA, vc[0][0], vc[0][1]); G8_STAGE_A(G8_SA(0, 1), cA, vc[1][0], vc[1][1]);
    if (wr == 1) G8_BAR;
    G8_WAIT_V(2); G8_BAR;
    G8_STAGE_B(G8_SB(1, 0), cB + kstep); G8_STAGE_A(G8_SA(1, 0), cA + kstep, vc[0][0], vc[0][1]); G8_STAGE_B(G8_SB(1, 1), cB + hstepB + kstep);
    G8_WAIT_V(6); G8_BAR;
    for (;;) {
        const bool has_next = S.next(ui + 1, nxt);
        if (GATHER) { unsigned vn[2][2];
            if (has_next) S.aoff(nxt, vn, R, C);
            else { vn[0][0] = vc[0][0]; vn[0][1] = vc[0][1]; vn[1][0] = vc[1][0]; vn[1][1] = vc[1][1]; }
            u32x4 sv; sv.x = vn[0][0]; sv.y = vn[0][1]; sv.z = vn[1][0]; sv.w = vn[1][1]; *stash = sv; }
        const char* nA = has_next ? nxt.a : cA; const char* nB = has_next ? nxt.b : cB;
#pragma unroll 1
        for (int seg = 0; seg < (Epi::KHOOK ? 3 : 1); ++seg) {
        const int tlo = Epi::KHOOK ? 6 * seg : 0, thi = Epi::KHOOK ? (seg == 2 ? nt : 6 * seg + 6) : nt;
#pragma unroll 1
        for (int t = tlo; t < thi; t += 2) {
            const bool last = (t == nt - 2);
            const char* a1 = cA + (size_t)(t + 1) * kstep;
            const char* a2 = last ? nA : cA + (size_t)(t + 2) * kstep; const char* b2 = last ? nB : cB + (size_t)(t + 2) * kstep;
            const char* a3 = a2 + kstep; const char* b3 = b2 + kstep;
            unsigned w00 = vc[0][0], w01 = vc[0][1], w10 = vc[1][0], w11 = vc[1][1];
            if (GATHER) { if (last) { const u32x4 sv = *stash; w00 = sv.x; w01 = sv.y; w10 = sv.z; w11 = sv.w; } }
            G8_LDB(B0, 0, 0); G8_LDB(B1, 0, 1); G8_SCHED; G8_LDA(At, 0, 0); G8_STAGE_A(G8_SA(1, 1), a1, vc[1][0], vc[1][1]);
            G8_WAIT_V(8); G8_WAIT_L(0); G8_BAR; G8_MMA(0, 0, At, B0); G8_MMA(0, 1, At, B1); G8_BAR; G8_SCHED;
            G8_LDA(At, 0, 1); G8_STAGE_B(G8_SB(0, 0), b2); G8_STAGE_B(G8_SB(0, 1), b2 + hstepB); G8_STAGE_A(G8_SA(0, 0), a2, w00, w01);
            G8_WAIT_V(8); G8_WAIT_L(0); G8_BAR; G8_MMA(1, 0, At, B0); G8_MMA(1, 1, At, B1); G8_BAR; G8_SCHED;
            G8_LDB(B0, 1, 0); G8_LDB(B1, 1, 1); G8_SCHED; G8_LDA(At, 1, 0); G8_STAGE_A(G8_SA(0, 1), a2, w10, w11);
            G8_WAIT_V(8); G8_WAIT_L(0); G8_BAR; G8_MMA(0, 0, At, B0); G8_MMA(0, 1, At, B1); G8_BAR; G8_SCHED;
            G8_LDA(At, 1, 1); G8_STAGE_B(G8_SB(1, 0), b3); G8_STAGE_B(G8_SB(1, 1), b3 + hstepB); G8_STAGE_A(G8_SA(1, 0), a3, w00, w01);
            G8_WAIT_V(8); G8_WAIT_L(0); G8_BAR; G8_MMA(1, 0, At, B0); G8_MMA(1, 1, At, B1); G8_BAR; G8_SCHED;
        }
        if constexpr (Epi::KHOOK) { if (seg < 2) E.kscale(acc, seg, wr, fr); }
        }
        if (wr == 0) G8_BAR;
        { int fr_ = fr, fq_ = fq; asm volatile("" : "+v"(fr_), "+v"(fq_));
          E(acc, cur, wr, wc, fr_, fq_); }
        if (!has_next) break;
#pragma unroll
        for (int a = 0; a < 2; ++a)
#pragma unroll
            for (int b = 0; b < 2; ++b)
#pragma unroll
                for (int m = 0; m < 4; ++m)
#pragma unroll
                    for (int n = 0; n < 2; ++n) acc[a][b][m][n] = (f32x4){0.f, 0.f, 0.f, 0.f};
        cur = nxt; cA = nA; cB = nB; ++ui; G8_MASK(cur);
        if (GATHER) { const u32x4 sv = *stash; vc[0][0] = sv.x; vc[0][1] = sv.y; vc[1][0] = sv.z; vc[1][1] = sv.w; }
        if (wr == 1) G8_BAR;
    }
    G8_WAIT_V(0);
    G8_BAR;
#undef G8_SA
#undef G8_SB
#undef G8_GLDS
#undef G8_STAGE_A
#undef G8_STAGE_B
#undef G8_LDA
#undef G8_LDB
#undef G8_MMA
#undef G8_MASK
#undef G8_WAIT_V
#undef G8_WAIT_L
#undef G8_BAR
#undef G8_SCHED
}
}
using g8::GUnit;
__device__ __forceinline__ void st_bf16x8(bf16_t* p, const float (&v)[8]) { u32x4 w; w.x = pk_bf16(v[0], v[1]); w.y = pk_bf16(v[2], v[3]); w.z = pk_bf16(v[4], v[5]); w.w = pk_bf16(v[6], v[7]); *(u32x4*)p = w; }
__device__ __forceinline__ float quad_sum(float s) { s += shx<16>(s); s += __shfl_xor(s, 32); return s; }

struct EpiInProj {
    static constexpr bool KHOOK = false;
    const float* ssqx; float* part_dq; float* part_dkv; const float* qg; const float* kg; const float* krg; const float* rope;
    unsigned char* prj;
    __device__ __forceinline__ void operator()(const f32x4 (&acc)[2][2][4][2], const GUnit& u, int wr, int wc, int fr, int fq) const {
        const int G = u.pn * 4 + wc;
        const bool isq = G < 6; const int a = G - 6; const bool isk = (G >= 10 && G < 18 && ((a >> 1) & 1) == 0);
        const float* g0 = (isq ? qg : kg) + 8 * fq;
        float rs8[8];
#pragma unroll
        for (int k = 0; k < 8; ++k) rs8[k] = ssqx[u.pm * 256 + (k >> 2) * 128 + wr * 64 + (k & 3) * 16 + fr];
#pragma unroll
        for (int k = 0; k < 8; ++k) rs8[k] = rsqrtf(rs8[k] * (1.f / 1024.f) + 1e-6f);
#pragma unroll
        for (int ai = 0; ai < 2; ++ai)
#pragma unroll
            for (int m = 0; m < 4; ++m) {
                __builtin_amdgcn_sched_barrier(0);
                const int row = u.pm * 256 + ai * 128 + wr * 64 + m * 16 + fr; const int b = row >> 11, t = row & 2047;
                const float rs = rs8[ai * 4 + m];
                float v[2][8];
#pragma unroll
                for (int bj = 0; bj < 2; ++bj)
#pragma unroll
                    for (int n = 0; n < 2; ++n)
#pragma unroll
                        for (int j = 0; j < 4; ++j) v[bj][4 * n + j] = acc[ai][bj][m][n][j] * rs;
                float ss = 0.f;
#pragma unroll
                for (int bj = 0; bj < 2; ++bj)
#pragma unroll
                    for (int i = 0; i < 8; ++i) ss += v[bj][i] * v[bj][i];
                bf16_t* dst = nullptr; int bstride = 32;
                if (isq) {
                    ss = quad_sum(ss); const float sc = rsqrtf(ss * (1.f / 64.f) + 1e-6f) * 0.18033688f;
#pragma unroll
                    for (int i = 0; i < 8; ++i) { v[0][i] *= sc * g0[i]; v[1][i] *= sc * g0[32 + i]; }
                    dst = (bf16_t*)(prj + PRJ_QN) + ((size_t)(b * 6 + G) * 2048 + t) * 64;
                } else if (G < 18) {
                    const int br = a >> 2, s = (a >> 1) & 1, hk = a & 1;
                    if (br > 0 && s == 0) {
                        ss = quad_sum(ss); const float sc = rsqrtf(ss * (1.f / 64.f) + 1e-6f);
#pragma unroll
                        for (int i = 0; i < 8; ++i) { v[0][i] *= sc * g0[i]; v[1][i] *= sc * g0[32 + i]; }
                    }
                    const size_t base = br == 0 ? (s ? PRJ_C0V : PRJ_C0K) : (br == 1 ? (s ? PRJ_VN1 : PRJ_KN1) : (s ? PRJ_VN2 : PRJ_KN2));
                    dst = (bf16_t*)(prj + base) + ((size_t)(b * 2 + hk) * 2048 + t) * 64;
                } else if (G < 26) { dst = (bf16_t*)(prj + PRJ_RAWQK) + (size_t)row * 512 + (G - 18) * 64; }
                else if (G < 30) { dst = (bf16_t*)(prj + PRJ_VML) + ((size_t)(b * 4 + (G - 26)) * 2048 + t) * 64; }
                else if (G < 34) { dst = (bf16_t*)(prj + PRJ_OG) + (size_t)row * 256 + (G - 30) * 64; }
                else if (G < 37) { dst = (bf16_t*)(prj + PRJ_DQKV) + (size_t)row * 384 + (G - 34) * 64; ss = quad_sum(ss); if (fq == 0) part_dq[(size_t)row * 4 + (G - 34)] = ss; }
                else if (G == 37) {
                    dst = (bf16_t*)(prj + PRJ_DQKV) + (size_t)row * 384 + 192;
                    float* gt = (float*)(prj + PRJ_GATES) + (size_t)row * 32 + 8 * fq;
                    *(f32x4*)gt = (f32x4){v[1][0], v[1][1], v[1][2], v[1][3]}; *(f32x4*)(gt + 4) = (f32x4){v[1][4], v[1][5], v[1][6], v[1][7]};
                    float s0 = 0.f;
#pragma unroll
                    for (int i = 0; i < 8; ++i) s0 += v[0][i] * v[0][i];
                    s0 = quad_sum(s0); const float sc = rsqrtf(s0 * (1.f / 32.f) + 1e-6f);
                    const float* rp = rope + (size_t)row * 32 + ((8 * fq) & 15);
                    float kr[8];
#pragma unroll
                    for (int i = 0; i < 8; ++i) { const float val = v[0][i] * sc * krg[8 * fq + i]; const float oth = __shfl_xor(val, 32); const float cs = rp[i], sn = rp[16 + i]; kr[i] = fq < 2 ? val * cs - oth * sn : val * cs + oth * sn; }
                    st_bf16x8((bf16_t*)(prj + PRJ_KR) + (size_t)row * 32 + 8 * fq, kr);
                } else { dst = (bf16_t*)(prj + PRJ_DQKV) + (size_t)row * 384 + 256 + (G - 38) * 64; ss = quad_sum(ss); if (fq == 0) part_dkv[(size_t)row * 2 + (G - 38)] = ss; }
                st_bf16x8(dst + 8 * fq, v[0]); st_bf16x8(dst + bstride + 8 * fq, v[1]);
            }
    }
};

struct EpiUq {
    static constexpr bool KHOOK = false;
    const float* ssq_dq; const float* qkn; const float* rope; bf16_t* QM;
    __device__ __forceinline__ void operator()(const f32x4 (&acc)[2][2][4][2], const GUnit& u, int wr, int wc, int fr, int fq) const {
        const int G = u.pn * 4 + wc; if (G >= 9) return;
        const float scale = 0.14724444f;
        const float* g0 = G < 6 ? qkn + 8 * fq : qkn + 64 + 8 * (fq & 1); const float* g1 = G < 6 ? g0 + 32 : g0 + 16;
        float rs8[8];
#pragma unroll
        for (int k = 0; k < 8; ++k) { const f32x4 pq = *(const f32x4*)(ssq_dq + (size_t)(u.pm * 256 + (k >> 2) * 128 + wr * 64 + (k & 3) * 16 + fr) * 4); rs8[k] = (pq.x + pq.y) + pq.z; }
#pragma unroll
        for (int k = 0; k < 8; ++k) rs8[k] = rsqrtf(rs8[k] * (1.f / 192.f) + 1e-6f);
#pragma unroll
        for (int ai = 0; ai < 2; ++ai) {
#pragma unroll
            for (int m = 0; m < 4; ++m) {
                __builtin_amdgcn_sched_barrier(0);
                const int row = u.pm * 256 + ai * 128 + wr * 64 + m * 16 + fr; const int b = row >> 11, t = row & 2047;
                const float rs = rs8[ai * 4 + m];
                float v[2][8]; float ss = 0.f;
#pragma unroll
                for (int bj = 0; bj < 2; ++bj)
#pragma unroll
                    for (int n = 0; n < 2; ++n)
#pragma unroll
                        for (int j = 0; j < 4; ++j) { const float x = acc[ai][bj][m][n][j] * rs; v[bj][4 * n + j] = x; ss += x * x; }
                if (G < 6) ss = quad_sum(ss); else ss += shx<16>(ss);
                const float sc = rsqrtf(ss * (G < 6 ? 1.f / 64.f : 1.f / 32.f) + 1e-6f) * scale;
#pragma unroll
                for (int i = 0; i < 8; ++i) { v[0][i] *= sc * g0[i]; v[1][i] *= sc * g1[i]; }
                if (G < 6) {
                    bf16_t* dst = QM + ((size_t)(b * 6 + G) * 2048 + t) * 96;
                    st_bf16x8(dst + 8 * fq, v[0]); st_bf16x8(dst + 32 + 8 * fq, v[1]);
                } else {
                    const int i16 = 8 * (fq & 1); const int head = 2 * (G - 6) + (fq >> 1);
                    const float* rp = rope + (size_t)row * 32 + i16; float o1[8], o2[8];
#pragma unroll
                    for (int i = 0; i < 8; ++i) { const float cs = rp[i], sn = rp[16 + i]; o1[i] = v[0][i] * cs - v[1][i] * sn; o2[i] = v[1][i] * cs + v[0][i] * sn; }
                    bf16_t* dst = QM + ((size_t)(b * 6 + head) * 2048 + t) * 96 + 64 + i16;
                    st_bf16x8(dst, o1); st_bf16x8(dst + 16, o2);
                }
            }
        }
    }
};
struct EpiUkv {
    static constexpr bool KHOOK = false;
    const float* ssq_dkv; const float* qkn; const bf16_t* KR; bf16_t* KM; bf16_t* VM;
    __device__ __forceinline__ void operator()(const f32x4 (&acc)[2][2][4][2], const GUnit& u, int wr, int wc, int fr, int fq) const {
        const int G = u.pn * 4 + wc;
        const float* g0 = qkn + 96 + 8 * fq;
        float rs8[8];
#pragma unroll
        for (int k = 0; k < 8; ++k) { const size_t rr = (size_t)(u.pm * 256 + (k >> 2) * 128 + wr * 64 + (k & 3) * 16 + fr); rs8[k] = ssq_dkv[rr * 2] + ssq_dkv[rr * 2 + 1]; }
#pragma unroll
        for (int k = 0; k < 8; ++k) rs8[k] = rsqrtf(rs8[k] * (1.f / 128.f) + 1e-6f);
#pragma unroll
        for (int ai = 0; ai < 2; ++ai) {
          u32x4 kr4[4];
          if (G < 6) {
#pragma unroll
              for (int m = 0; m < 4; ++m) kr4[m] = *(const u32x4*)(KR + (size_t)(u.pm * 256 + ai * 128 + wr * 64 + m * 16 + fr) * 32 + 8 * fq);
          }
#pragma unroll
            for (int m = 0; m < 4; ++m) {
                __builtin_amdgcn_sched_barrier(0);
                const int row = u.pm * 256 + ai * 128 + wr * 64 + m * 16 + fr; const int b = row >> 11, t = row & 2047;
                const float rs = rs8[ai * 4 + m];
                float v[2][8]; float ss = 0.f;
#pragma unroll
                for (int bj = 0; bj < 2; ++bj)
#pragma unroll
                    for (int n = 0; n < 2; ++n)
#pragma unroll
                        for (int j = 0; j < 4; ++j) { const float x = acc[ai][bj][m][n][j] * rs; v[bj][4 * n + j] = x; ss += x * x; }
                if (G < 6) {
                    ss = quad_sum(ss); const float sc = rsqrtf(ss * (1.f / 64.f) + 1e-6f);
#pragma unroll
                    for (int i = 0; i < 8; ++i) { v[0][i] *= sc * g0[i]; v[1][i] *= sc * g0[32 + i]; }
                    bf16_t* dst = KM + ((size_t)(b * 6 + G) * 2048 + t) * 96;
                    st_bf16x8(dst + 8 * fq, v[0]); st_bf16x8(dst + 32 + 8 * fq, v[1]);
                    *(u32x4*)(dst + 64 + 8 * fq) = kr4[m];
                } else {
                    bf16_t* dst = VM + ((size_t)(b * 6 + (G - 6)) * 2048 + t) * 64;
                    st_bf16x8(dst + 8 * fq, v[0]); st_bf16x8(dst + 32 + 8 * fq, v[1]);
                }
            }
        }
    }
};
#define MFMA16(a, b, c) __builtin_amdgcn_mfma_f32_16x16x32_bf16(a, b, c, 0, 0, 0)
#define MFMA32(a, b, c) __builtin_amdgcn_mfma_f32_32x32x16_bf16(a, b, c, 0, 0, 0)
#define LDS_FENCE() asm volatile("s_waitcnt lgkmcnt(0)" ::: "memory")

__device__ __forceinline__ void cmp_unit(int u, int l, InPtr in, unsigned char* ws, LAS unsigned char* lds, int g_wv) {
    int tid_ = TIDX; asm volatile("" : "+v"(tid_));
    const int tid = tid_, w = tid >> 6, lane = tid & 63, r = lane & 15, q = lane >> 4;
    const int b = u >> 2, s = (u >> 1) & 1, hk = u & 1;
    const bf16_t* A = (const bf16_t*)(ws + WS_PRJ + (s ? PRJ_C0V : PRJ_C0K)) + (size_t)(b * 2 + hk) * 2048 * 64;
    const bf16_t* W1 = (const bf16_t*)(ws + WS_WC1) + ((size_t)l * 2 + s) * 64 * 2048;
    const bf16_t* W2 = (const bf16_t*)(ws + WS_WC2) + ((size_t)l * 2 + s) * 64 * 64;
    const float* b1 = (const float*)(ws + WS_B1C) + (l * 2 + s) * 64;
    f32x4 acc[4];
#pragma unroll
    for (int nb = 0; nb < 4; ++nb) acc[nb] = (f32x4){0.f, 0.f, 0.f, 0.f};
    const bf16_t* ap = A + (size_t)(16 * w + r) * 1024 + 8 * q;
    constexpr int WP = 528, WBUF = 64 * WP; LAS unsigned char* wb = lds + 24576;
    u32x4 st[4];
#pragma unroll
    for (int i = 0; i < 4; ++i) { const int c = tid + 512 * i; st[i] = *(const u32x4*)(W1 + (size_t)(c >> 5) * 2048 + (c & 31) * 8); }
    bf16x8 af[8], afn[8];
#pragma unroll
    for (int ks = 0; ks < 8; ++ks) af[ks] = *(const bf16x8*)(ap + 32 * ks);
    const float* kg = in->p[9] + l * 64;
    float b1v[4], kgv[4]; bf16x8 w2f[2][4];
#pragma unroll
    for (int nb = 0; nb < 4; ++nb) { b1v[nb] = b1[16 * nb + r]; kgv[nb] = kg[16 * nb + r]; }
#pragma unroll
    for (int ks = 0; ks < 2; ++ks)
#pragma unroll
        for (int nb = 0; nb < 4; ++nb) w2f[ks][nb] = *(const bf16x8*)(W2 + (size_t)(16 * nb + r) * 64 + 32 * ks + 8 * q);
#pragma unroll
    for (int i = 0; i < 4; ++i) { const int c = tid + 512 * i; *(LAS u32x4*)(wb + (c >> 5) * WP + (c & 31) * 16) = st[i]; }
    __syncthreads();
    auto chunk = [&](const int kc, bf16x8 (&ac)[8], bf16x8 (&an)[8]) __attribute__((always_inline)) {
        const int cur = kc & 1;
        if (kc < 7) {
#pragma unroll
            for (int i = 0; i < 4; ++i) { const int c = tid + 512 * i; st[i] = *(const u32x4*)(W1 + (size_t)(c >> 5) * 2048 + (kc + 1) * 256 + (c & 31) * 8); }
#pragma unroll
            for (int ks = 0; ks < 8; ++ks) an[ks] = *(const bf16x8*)(ap + 256 * (kc + 1) + 32 * ks);
        }
#pragma unroll
        for (int ks = 0; ks < 8; ++ks)
#pragma unroll
            for (int nb = 0; nb < 4; ++nb) { const bf16x8 bb = *(const LAS bf16x8*)(wb + cur * WBUF + (16 * nb + r) * WP + (32 * ks + 8 * q) * 2); acc[nb] = MFMA16(ac[ks], bb, acc[nb]); }
        if (kc < 7) {
#pragma unroll
            for (int i = 0; i < 4; ++i) { const int c = tid + 512 * i; *(LAS u32x4*)(wb + (cur ^ 1) * WBUF + (c >> 5) * WP + (c & 31) * 16) = st[i]; }
        }
        __syncthreads();
    };
#pragma unroll 1
    for (int kc = 0; kc < 8; kc += 2) { chunk(kc, af, afn); chunk(kc + 1, afn, af); }
    LAS bf16_t* hl = (LAS bf16_t*)(lds + w * 2304);
#pragma unroll
    for (int nb = 0; nb < 4; ++nb) { const float bias = b1v[nb];
#pragma unroll
        for (int j = 0; j < 4; ++j) hl[(4 * q + j) * 72 + 16 * nb + r] = f2bf(siluf(acc[nb][j] + bias)); }
    LDS_FENCE();
    f32x4 o[4];
#pragma unroll
    for (int nb = 0; nb < 4; ++nb) o[nb] = (f32x4){0.f, 0.f, 0.f, 0.f};
#pragma unroll
    for (int ks = 0; ks < 2; ++ks) {
        const bf16x8 a = *(const LAS bf16x8*)(hl + r * 72 + 32 * ks + 8 * q);
#pragma unroll
        for (int nb = 0; nb < 4; ++nb) o[nb] = MFMA16(a, w2f[ks][nb], o[nb]);
    }
    LDS_FENCE();
    bf16_t* dst = (bf16_t*)(ws + WS_CMP + (s ? CMP_V : 0)) + (size_t)(b * 2 + hk) * 128 * 64;
#pragma unroll
    for (int j = 0; j < 4; ++j) {
        const int n = 16 * w + 4 * q + j; float ss = 0.f;
#pragma unroll
        for (int nb = 0; nb < 4; ++nb) ss += o[nb][j] * o[nb][j];
        ss += shx<1>(ss); ss += shx<2>(ss); ss += shx<4>(ss); ss += shx<8>(ss);
        const float sc = s == 0 ? rsqrtf(ss * (1.f / 64.f) + 1e-6f) : 1.f;
#pragma unroll
        for (int nb = 0; nb < 4; ++nb) { const int d = 16 * nb + r; const float v = o[nb][j] * sc * (s == 0 ? kgv[nb] : 1.f); dst[(size_t)n * 64 + d] = n < 127 ? f2bf(v) : (bf16_t)0; }
    }
}

__device__ __forceinline__ int swz_off(int row, int chunk) { return row * 128 + ((chunk ^ (row & 7)) << 4); }
__device__ __forceinline__ float log_sigmoid(float x) { return fminf(x, 0.f) - log1pf(__expf(-fabsf(x))); }
__device__ __forceinline__ void ml_delta_wave(int cu, int l, InPtr in, unsigned char* ws, LAS unsigned char* wl, int lane) {
    asm volatile("" : "+v"(lane));
    const int c = cu & 31, bh = cu >> 5, h = bh & 3, b = bh >> 2; const int t0 = c * 64; const size_t row0 = (size_t)b * 2048 + t0;
    const int cc = lane & 7, tg = lane >> 3;
    const bf16_t* raw = (const bf16_t*)(ws + WS_PRJ + PRJ_RAWQK); const float* cw = in->p[11] + (size_t)l * 4 * 512 + h * 64 + 8 * cc;
    u32x4 rq[11];
    const bool head0 = (c == 0 && tg == 0);
#pragma unroll
    for (int i = 0; i < 11; ++i) { const size_t rr = (head0 && i < 3) ? row0 : row0 + 8 * tg - 3 + i; rq[i] = *(const u32x4*)(raw + rr * 512 + h * 64 + 8 * cc); }
    __builtin_amdgcn_sched_barrier(0);
    const float* G = (const float*)(ws + WS_PRJ + PRJ_GATES);
    const float ip = G[(row0 + lane) * 32 + 18 + h] + in->p[12][l * 4 + h], fp = G[(row0 + lane) * 32 + 22 + h] + in->p[13][l * 4 + h];
    float bcum = log_sigmoid(fp);
#pragma unroll
    for (int o = 1; o < 64; o <<= 1) { const float t = __builtin_bit_cast(float, __builtin_amdgcn_ds_bpermute(((lane - o) & 63) << 2, __builtin_bit_cast(int, bcum))); if (lane >= o) bcum += t; }
    const float bL = __builtin_bit_cast(float, __builtin_amdgcn_readlane(__builtin_bit_cast(int, bcum), 63)); const float wgt = __expf(bL - bcum + ip);
    { float* mlg = (float*)(ws + WS_ML + ML_G) + ((size_t)bh * 2048 + t0 + lane) * 2; mlg[0] = bcum; mlg[1] = ip; if (lane == 0) ((float*)(ws + WS_ML + ML_BL))[cu] = bL; }
    float wt[8];
#pragma unroll
    for (int j = 0; j < 8; ++j) wt[j] = __builtin_bit_cast(float, __builtin_amdgcn_ds_bpermute((8 * tg + j) << 2, __builtin_bit_cast(int, wgt)));
    if (head0) {
#pragma unroll
        for (int i = 0; i < 3; ++i) rq[i] = (u32x4){0u, 0u, 0u, 0u}; }
#define MLD_E(v, e) (((e) & 1) ? bf_hi(((e) >> 1) == 0 ? (v).x : ((e) >> 1) == 1 ? (v).y : ((e) >> 1) == 2 ? (v).z : (v).w) : bf_lo(((e) >> 1) == 0 ? (v).x : ((e) >> 1) == 1 ? (v).y : ((e) >> 1) == 2 ? (v).z : (v).w))
    bf16_t* QC = (bf16_t*)(ws + WS_ML) + ((size_t)bh * 2048 + t0 + 8 * tg) * 64 + 8 * cc; bf16_t* KC = (bf16_t*)(ws + WS_ML + ML_KC) + ((size_t)bh * 2048 + t0 + 8 * tg) * 64 + 8 * cc;
    u32x4 rk[11], vv[8];
#pragma unroll
    for (int i = 0; i < 11; ++i) { const size_t rr = (head0 && i < 3) ? row0 : row0 + 8 * tg - 3 + i; rk[i] = *(const u32x4*)(raw + rr * 512 + h * 64 + 8 * cc + 256); }
    { const bf16_t* V = (const bf16_t*)(ws + WS_PRJ + PRJ_VML) + ((size_t)bh * 2048 + t0 + 8 * tg) * 64 + 8 * cc;
#pragma unroll
      for (int j = 0; j < 8; ++j) vv[j] = *(const u32x4*)(V + (size_t)j * 64); }
    if (head0) {
#pragma unroll
        for (int i = 0; i < 3; ++i) rk[i] = (u32x4){0u, 0u, 0u, 0u}; }
    __builtin_amdgcn_sched_barrier(0);
    {
        float w4[4][8];
#pragma unroll
        for (int tp = 0; tp < 4; ++tp) { const f32x4 a = *(const f32x4*)(cw + tp * 512), b4 = *(const f32x4*)(cw + tp * 512 + 4); w4[tp][0] = a.x; w4[tp][1] = a.y; w4[tp][2] = a.z; w4[tp][3] = a.w; w4[tp][4] = b4.x; w4[tp][5] = b4.y; w4[tp][6] = b4.z; w4[tp][7] = b4.w; }
#pragma unroll
        for (int j = 0; j < 8; ++j) { float o[8];
#pragma unroll
            for (int e = 0; e < 8; ++e) o[e] = siluf(w4[0][e] * MLD_E(rq[j], e) + w4[1][e] * MLD_E(rq[j + 1], e) + w4[2][e] * MLD_E(rq[j + 2], e) + w4[3][e] * MLD_E(rq[j + 3], e));
            u32x4 pk; pk.x = pk_bf16(o[0], o[1]); pk.y = pk_bf16(o[2], o[3]); pk.z = pk_bf16(o[4], o[5]); pk.w = pk_bf16(o[6], o[7]);
            *(u32x4*)(QC + (size_t)j * 64) = pk; }
    }
    float dn[8];
    {
        float w4[4][8];
#pragma unroll
        for (int tp = 0; tp < 4; ++tp) { const f32x4 a = *(const f32x4*)(cw + 256 + tp * 512), b4 = *(const f32x4*)(cw + 256 + tp * 512 + 4); w4[tp][0] = a.x; w4[tp][1] = a.y; w4[tp][2] = a.z; w4[tp][3] = a.w; w4[tp][4] = b4.x; w4[tp][5] = b4.y; w4[tp][6] = b4.z; w4[tp][7] = b4.w; }
#pragma unroll
        for (int e = 0; e < 8; ++e) dn[e] = 0.f;
#pragma unroll
        for (int j2 = 0; j2 < 4; ++j2) { float kb[2][8];
#pragma unroll
            for (int jj = 0; jj < 2; ++jj) { const int j = 2 * j2 + jj; float o[8];
#pragma unroll
                for (int e = 0; e < 8; ++e) o[e] = siluf(w4[0][e] * MLD_E(rk[j], e) + w4[1][e] * MLD_E(rk[j + 1], e) + w4[2][e] * MLD_E(rk[j + 2], e) + w4[3][e] * MLD_E(rk[j + 3], e)) * 0.125f;
                u32x4 pk; pk.x = pk_bf16(o[0], o[1]); pk.y = pk_bf16(o[2], o[3]); pk.z = pk_bf16(o[4], o[5]); pk.w = pk_bf16(o[6], o[7]);
                *(u32x4*)(KC + (size_t)j * 64) = pk;
#pragma unroll
                for (int e = 0; e < 8; ++e) { kb[jj][e] = MLD_E(pk, e); dn[e] += wt[j] * kb[jj][e]; } }
#pragma unroll
            for (int e = 0; e < 8; ++e) { *(LAS unsigned*)(wl + swz_off(8 * cc + e, tg) + 4 * j2) = pk_bf16(kb[0][e], kb[1][e]);
                *(LAS unsigned*)(wl + 8192 + swz_off(8 * cc + e, tg) + 4 * j2) = pk_bf16(wt[2 * j2] * MLD_E(vv[2 * j2], e), wt[2 * j2 + 1] * MLD_E(vv[2 * j2 + 1], e)); } }
    }
#undef MLD_E
#pragma unroll
    for (int e = 0; e < 8; ++e) { dn[e] += shx<8>(dn[e]); dn[e] += shx<16>(dn[e]); dn[e] += __shfl_xor(dn[e], 32); }
    if (tg == 0) { float* DN = (float*)(ws + WS_ML + ML_DN) + (size_t)cu * 64 + 8 * cc; *(f32x4*)DN = (f32x4){dn[0], dn[1], dn[2], dn[3]}; *(f32x4*)(DN + 4) = (f32x4){dn[4], dn[5], dn[6], dn[7]}; }
    LDS_FENCE();
    const int r = lane & 15, q = lane >> 4;
    bf16_t* DL = (bf16_t*)(ws + WS_ML + ML_DELTA) + (size_t)cu * 4096;
    f32x4 acc[4][4];
#pragma unroll
    for (int mb = 0; mb < 4; ++mb) {
#pragma unroll
        for (int nb = 0; nb < 4; ++nb) acc[mb][nb] = (f32x4){0.f, 0.f, 0.f, 0.f};
#pragma unroll
        for (int ks = 0; ks < 2; ++ks) {
            const bf16x8 a = *(const LAS bf16x8*)(wl + 8192 + swz_off(16 * mb + r, 4 * ks + q));
#pragma unroll
            for (int nb = 0; nb < 4; ++nb) { const bf16x8 bb = *(const LAS bf16x8*)(wl + swz_off(16 * nb + r, 4 * ks + q)); acc[mb][nb] = MFMA16(a, bb, acc[mb][nb]); }
        }
    }
    LDS_FENCE();
#pragma unroll
    for (int mb = 0; mb < 4; ++mb)
#pragma unroll
        for (int nb = 0; nb < 4; ++nb)
#pragma unroll
            for (int j = 0; j < 4; ++j) { const int row = 16 * mb + 4 * q + j, col = 16 * nb + r; *(LAS bf16_t*)(wl + swz_off(row, col >> 3) + (col & 7) * 2) = f2bf(acc[mb][nb][j]); }
    LDS_FENCE();
#pragma unroll
    for (int i = 0; i < 8; ++i) { const int ch = lane + 64 * i; *(u32x4*)(DL + (size_t)ch * 8) = *(const LAS u32x4*)(wl + swz_off(ch >> 3, ch & 7)); }
    LDS_FENCE();
}

#ifndef TIME_PH
#define TIME_PH -1
#endif
#define PSTAMP(i, blk) do { if (TIME_PH != -1 && l == 0 && blockIdx.x == (blk) && TIDX == 0) ((unsigned long long*)((unsigned*)(ws + WS_CTL) + CW_TS))[i] = __builtin_amdgcn_s_memrealtime(); } while (0)
#ifndef DUP_DELTA
#define DUP_DELTA 1
#endif
__device__ __forceinline__ void phase_prep(int l, InPtr in, unsigned char* ws, LAS unsigned char* lds, int bid, int nb, int g_wv, unsigned* dq) {
    asm volatile("" : "+s"(bid));
    PSTAMP(40, 0);
#ifndef NO_UQ
    { g8::DenseSched S{(const char*)(ws + WS_PRJ + PRJ_DQKV), (const char*)(ws + WS_WUQ) + (size_t)l * 768 * 256 * 2, 384, 256, 64, 3, nb, bid};
      EpiUq E{(const float*)(ws + WS_SSQ + PT_DQ) + (size_t)l * 16384 * 4, in->p[19] + l * 192, (const float*)(ws + WS_ROPE), (bf16_t*)(ws + WS_MLA)};
      g8::gemm_run(lds, 256, 256, S, E, g_wv); }
#endif
    PSTAMP(41, 0);
#ifndef NO_UKV
    asm volatile("" : "+s"(bid));
    { g8::DenseSched S{(const char*)(ws + WS_PRJ + PRJ_DQKV) + 256, (const char*)(ws + WS_WUKV) + (size_t)l * 768 * 256 * 2, 384, 256, 64, 3, nb, nb == 256 ? ((bid + 64) & 255) : bid};
      EpiUkv E{(const float*)(ws + WS_SSQ + PT_DKV) + (size_t)l * 16384 * 2, in->p[19] + l * 192, (const bf16_t*)(ws + WS_PRJ + PRJ_KR), (bf16_t*)(ws + WS_MLA + MLA_KM), (bf16_t*)(ws + WS_MLA + MLA_VM)};
      g8::gemm_run(lds, 256, 256, S, E, g_wv); }
#endif
    PSTAMP(42, 0); PSTAMP(44, 255);
    __syncthreads();
#ifndef NO_CMP
#ifndef DUP_CMP
#define DUP_CMP 1
#endif
    for (int u = (nb == 256 ? (bid >= 128 && bid < 160 ? bid - 128 : 32) : nb - 1 - bid); u < 32; u += nb) for (int rp_ = 0; rp_ < DUP_CMP; ++rp_) { if (rp_) __syncthreads(); cmp_unit(u, l, in, ws, lds, g_wv); }
#endif
    PSTAMP(45, 255);
    __syncthreads();
#ifndef NO_DELTA
    { int tid_ = TIDX; asm volatile("" : "+v"(tid_)); LAS int* slot = (LAS int*)(lds + LDS_MISC + 64);
      for (;;) {
          __syncthreads();
          if (tid_ == 0) *slot = (int)__hip_atomic_fetch_add(dq, 1u, __ATOMIC_RELAXED, __HIP_MEMORY_SCOPE_AGENT);
          __syncthreads();
          const int g = *slot; if (g >= 96 + 128) break;
          const int wv = tid_ >> 6;
          const int cu_ = g < 96 ? g * 8 + wv : 768 + (g - 96) * 2 + wv;
          if (g < 96 || wv < 2) { for (int rp_ = 0; rp_ < DUP_DELTA; ++rp_) ml_delta_wave(cu_, l, in, ws, lds + wv * 16384, tid_ & 63); }
      } }
#endif
    __syncthreads(); PSTAMP(43, 0);
}
#define CHK_TOL(st) (((st) & 15) == 8 ? 1e-2f : 1e-3f)
#define CHECK_REST
constexpr int VTP = 192;
typedef short v4i16_t __attribute__((ext_vector_type(4)));
__device__ __forceinline__ int vt_lane_off(int lane) { return (4 * (lane >> 5) + ((lane & 15) >> 2)) * VTP + ((((lane >> 4) & 1) * 16) + 4 * (lane & 3)) * 2; }
__device__ __forceinline__ bf16x8 vt_frag(const LAS unsigned char* Vt, int voff, int s4, int eb) {
    const LAS unsigned char* a = Vt + voff + 16 * s4 * VTP + 64 * eb;
    const v4i16_t lo = __builtin_amdgcn_ds_read_tr16_b64_v4i16((LAS v4i16_t*)a), hi = __builtin_amdgcn_ds_read_tr16_b64_v4i16((LAS v4i16_t*)(a + 8 * VTP));
    return (bf16x8){lo[0], lo[1], lo[2], lo[3], hi[0], hi[1], hi[2], hi[3]};
}
__device__ __forceinline__ int crow(int reg, int h) { return (reg & 3) + 8 * (reg >> 2) + 4 * h; }
struct AttnState { f32x16 o[2]; float m, l; };
__device__ __forceinline__ void attn_reset(AttnState& A) { A.m = -1e30f; A.l = 0.f;
#pragma unroll
    for (int i = 0; i < 16; ++i) { A.o[0][i] = 0.f; A.o[1][i] = 0.f; } }

template <int DK>
__device__ __forceinline__ void attn_scores(f32x16 (&s)[2], const bf16x8 (&qf)[DK / 16], const LAS unsigned char* Kt, int r, int h) {
    constexpr int KP = 2 * DK + 16, NK = DK / 16;
    bf16x8 kf[2][NK];
#pragma unroll
    for (int kb = 0; kb < 2; ++kb)
#pragma unroll
        for (int ks = 0; ks < NK; ++ks) kf[kb][ks] = *(const LAS bf16x8*)(Kt + (32 * kb + r) * KP + (16 * ks + 8 * h) * 2);
    __builtin_amdgcn_sched_barrier(0);
#pragma unroll
    for (int kb = 0; kb < 2; ++kb) {
#pragma unroll
        for (int i = 0; i < 16; ++i) s[kb][i] = 0.f;
#pragma unroll
        for (int ks = 0; ks < NK; ++ks) s[kb] = MFMA32(kf[kb][ks], qf[ks], s[kb]);
    }
}
__device__ __forceinline__ float max3f(float a, float b, float c) { return fmaxf(fmaxf(a, b), c); }
__device__ __forceinline__ void attn_softmax_pv(AttnState& A, f32x16 (&s)[2], const LAS unsigned char* Vt, int r, int h, float bias_c = 0.f, bool lane_ok = true) {
    constexpr float THR = 8.f; const int voff = vt_lane_off(r + 32 * h);
    float mx = max3f(s[0][0], s[0][1], s[0][2]);
#pragma unroll
    for (int i = 3; i < 15; i += 2) mx = max3f(mx, s[0][i], s[0][i + 1]);
    mx = max3f(mx, s[0][15], s[1][0]);
#pragma unroll
    for (int i = 1; i < 15; i += 2) mx = max3f(mx, s[1][i], s[1][i + 1]);
    mx = fmaxf(mx, s[1][15]);
    mx = fmaxf(mx, __shfl_xor(mx, 32));
    const float mxb = (lane_ok && mx > -1e29f) ? mx + bias_c : -1e30f;
    const bool grow = mxb > A.m + THR;
    const float mnew = grow ? mxb : A.m;
    if (__any(grow)) {
        const float alpha = __builtin_amdgcn_exp2f(A.m - mnew);
        A.l *= alpha;
#pragma unroll
        for (int i = 0; i < 16; ++i) { A.o[0][i] *= alpha; A.o[1][i] *= alpha; }
    }
    A.m = mnew;
    const float sub = (lane_ok && mnew > -1e29f) ? mnew - bias_c : 1e30f;
    float rs = 0.f;
#pragma unroll
    for (int kb = 0; kb < 2; ++kb)
#pragma unroll
        for (int i = 0; i < 16; ++i) { const float p = __builtin_amdgcn_exp2f(s[kb][i] - sub); s[kb][i] = p; rs += p; }
    rs += __shfl_xor(rs, 32);
    A.l += rs;
    bf16x8 vf[4][2];
#pragma unroll
    for (int s4 = 0; s4 < 4; ++s4)
#pragma unroll
        for (int eb = 0; eb < 2; ++eb) vf[s4][eb] = vt_frag(Vt, voff, s4, eb);
    __builtin_amdgcn_sched_barrier(0);
#pragma unroll
    for (int s4 = 0; s4 < 4; ++s4) {
        const int kb = s4 >> 1, hf = (s4 & 1) * 8;
        u32x4 pw; pw.x = pk_bf16(s[kb][hf + 0], s[kb][hf + 1]); pw.y = pk_bf16(s[kb][hf + 2], s[kb][hf + 3]); pw.z = pk_bf16(s[kb][hf + 4], s[kb][hf + 5]); pw.w = pk_bf16(s[kb][hf + 6], s[kb][hf + 7]);
        const bf16x8 pf = __builtin_bit_cast(bf16x8, pw);
#pragma unroll
        for (int eb = 0; eb < 2; ++eb) A.o[eb] = MFMA32(vf[s4][eb], pf, A.o[eb]);
    }
}
template <int DK>
__device__ __forceinline__ void attn_scores_half(f32x16& s, const bf16x8 (&qf)[DK / 16], const LAS unsigned char* Kt, int r, int h, int kb) {
    constexpr int KP = 2 * DK + 16, NK = DK / 16;
    bf16x8 kf[NK];
#pragma unroll
    for (int ks = 0; ks < NK; ++ks) kf[ks] = *(const LAS bf16x8*)(Kt + (32 * kb + r) * KP + (16 * ks + 8 * h) * 2);
    __builtin_amdgcn_sched_barrier(0);
#pragma unroll
    for (int i = 0; i < 16; ++i) s[i] = 0.f;
#pragma unroll
    for (int ks = 0; ks < NK; ++ks) s = MFMA32(kf[ks], qf[ks], s);
}
__device__ __forceinline__ void attn_softmax_pv_half(AttnState& A, f32x16& s, const LAS unsigned char* Vt, int r, int h, int kb, float bias_c = 0.f, bool lane_ok = true) {
    constexpr float THR = 8.f; const int voff = vt_lane_off(r + 32 * h);
    float mx = max3f(s[0], s[1], s[2]);
#pragma unroll
    for (int i = 3; i < 15; i += 2) mx = max3f(mx, s[i], s[i + 1]);
    mx = fmaxf(mx, s[15]);
    mx = fmaxf(mx, __shfl_xor(mx, 32));
    const float mxb = (lane_ok && mx > -1e29f) ? mx + bias_c : -1e30f;
    const bool grow = mxb > A.m + THR;
    const float mnew = grow ? mxb : A.m;
    if (__any(grow)) {
        const float alpha = __builtin_amdgcn_exp2f(A.m - mnew);
        A.l *= alpha;
#pragma unroll
        for (int i = 0; i < 16; ++i) { A.o[0][i] *= alpha; A.o[1][i] *= alpha; }
    }
    A.m = mnew;
    const float sub = (lane_ok && mnew > -1e29f) ? mnew - bias_c : 1e30f;
    float rs = 0.f;
#pragma unroll
    for (int i = 0; i < 16; ++i) { const float p = __builtin_amdgcn_exp2f(s[i] - sub); s[i] = p; rs += p; }
    rs += __shfl_xor(rs, 32);
    A.l += rs;
    bf16x8 vf[2][2];
#pragma unroll
    for (int s2 = 0; s2 < 2; ++s2)
#pragma unroll
        for (int eb = 0; eb < 2; ++eb) vf[s2][eb] = vt_frag(Vt, voff, 2 * kb + s2, eb);
    __builtin_amdgcn_sched_barrier(0);
#pragma unroll
    for (int s2 = 0; s2 < 2; ++s2) {
        const int hf = s2 * 8;
        u32x4 pw; pw.x = pk_bf16(s[hf + 0], s[hf + 1]); pw.y = pk_bf16(s[hf + 2], s[hf + 3]); pw.z = pk_bf16(s[hf + 4], s[hf + 5]); pw.w = pk_bf16(s[hf + 6], s[hf + 7]);
        const bf16x8 pf = __builtin_bit_cast(bf16x8, pw);
#pragma unroll
        for (int eb = 0; eb < 2; ++eb) A.o[eb] = MFMA32(vf[s2][eb], pf, A.o[eb]);
    }
}
template <int DK>
__device__ __forceinline__ void stage_k_load(u32x4 (&kr)[2], const bf16_t* Kg  , int tid) {
    constexpr int CH = DK / 8;
    kr[0] = *(const u32x4*)(Kg + (size_t)(tid / CH) * DK + (tid % CH) * 8);
    if (64 * CH > 512) { const int c2 = tid + 512; if (c2 < 64 * CH) kr[1] = *(const u32x4*)(Kg + (size_t)(c2 / CH) * DK + (c2 % CH) * 8); }
}
template <int DK>
__device__ __forceinline__ void stage_k_store(const u32x4 (&kr)[2], LAS unsigned char* Kt, int tid) {
    constexpr int CH = DK / 8, KP = 2 * DK + 16;
    *(LAS u32x4*)(Kt + (tid / CH) * KP + (tid % CH) * 16) = kr[0];
    if (64 * CH > 512) { const int c2 = tid + 512; if (c2 < 64 * CH) *(LAS u32x4*)(Kt + (c2 / CH) * KP + (c2 % CH) * 16) = kr[1]; }
}
__device__ __forceinline__ u32x4 stage_v_load(const bf16_t* Vg, int tid) { return *(const u32x4*)(Vg + (size_t)(tid >> 3) * 64 + (tid & 7) * 8); }
__device__ __forceinline__ void stage_v_store(const u32x4& v, LAS unsigned char* Vt, int tid) { *(LAS u32x4*)(Vt + (tid >> 3) * VTP + (tid & 7) * 16) = v; }

constexpr int MLA_KT = 0, MLA_VT = 2 * 64 * 208, MLA_LDS = MLA_VT + 2 * 64 * VTP;
__device__ __forceinline__ void mla_unit(int b, int hd, int qt, int l, unsigned char* ws, LAS unsigned char* lds, int g_wv) {
    int tid_ = TIDX; asm volatile("" : "+v"(tid_));
    const int tid = tid_, w = tid >> 6, lane = tid & 63, r = lane & 31, h = lane >> 5;
    const size_t slab = (size_t)(b * 6 + hd) * 2048;
    const bf16_t* QM = (const bf16_t*)(ws + WS_MLA) + slab * 96; const bf16_t* KM = (const bf16_t*)(ws + WS_MLA + MLA_KM) + slab * 96; const bf16_t* VM = (const bf16_t*)(ws + WS_MLA + MLA_VM) + slab * 64;
    const int q0 = 256 * qt + 32 * w, q = q0 + r;
    bf16x8 qf[6];
#pragma unroll
    for (int ks = 0; ks < 6; ++ks) qf[ks] = *(const bf16x8*)(QM + (size_t)q * 96 + 16 * ks + 8 * h);
    AttnState A; attn_reset(A);
    const int ntile = 4 * qt + 4;
    u32x4 kr[2], vr, kr2[2], vr2;
    stage_k_load<96>(kr, KM, tid); vr = stage_v_load(VM, tid);
    stage_k_store<96>(kr, lds + MLA_KT, tid); stage_v_store(vr, lds + MLA_VT, tid);
    if (ntile > 1) { stage_k_load<96>(kr, KM + (size_t)64 * 96, tid); vr = stage_v_load(VM + (size_t)64 * 64, tid); }
    __syncthreads();
    auto tile_step = [&](const int j, u32x4 (&kc)[2], u32x4& vc, u32x4 (&kn)[2], u32x4& vn) __attribute__((always_inline)) {
        const int cur = j & 1;
        if (j + 2 < ntile) { stage_k_load<96>(kn, KM + (size_t)(j + 2) * 64 * 96, tid); vn = stage_v_load(VM + (size_t)(j + 2) * 64 * 64, tid); }
        if (64 * j <= q0 + 31) {
            f32x16 s[2];
            attn_scores<96>(s, qf, lds + MLA_KT + cur * 64 * 208, r, h);
            if (64 * j + 63 > q0) {
#pragma unroll
                for (int kb = 0; kb < 2; ++kb)
#pragma unroll
                    for (int i = 0; i < 16; ++i) { const int key = 64 * j + 32 * kb + crow(i, h); if (key > q) s[kb][i] = -1e30f; }
            }
            attn_softmax_pv(A, s, lds + MLA_VT + cur * 64 * VTP, r, h);
        }
        if (j + 1 < ntile) { stage_k_store<96>(kc, lds + MLA_KT + (cur ^ 1) * 64 * 208, tid); stage_v_store(vc, lds + MLA_VT + (cur ^ 1) * 64 * VTP, tid); }
        __syncthreads();
    };
#pragma unroll 1
    for (int j = 0; j < ntile; j += 2) { tile_step(j, kr, vr, kr2, vr2); tile_step(j + 1, kr2, vr2, kr, vr); }
    const float inv = A.l > 0.f ? 1.f / A.l : 0.f; float ss = 0.f;
    bf16_t* Y = (bf16_t*)(ws + WS_Y) + ((size_t)b * 2048 + q) * 1024 + 384 + hd * 64;
#pragma unroll
    for (int eb = 0; eb < 2; ++eb)
#pragma unroll
        for (int g4 = 0; g4 < 4; ++g4) {
            const float v0 = A.o[eb][4 * g4] * inv, v1 = A.o[eb][4 * g4 + 1] * inv, v2 = A.o[eb][4 * g4 + 2] * inv, v3 = A.o[eb][4 * g4 + 3] * inv;
            u32x2 pw; pw.x = pk_bf16(v0, v1); pw.y = pk_bf16(v2, v3);
            const float f0 = bf_lo(pw.x), f1 = bf_hi(pw.x), f2 = bf_lo(pw.y), f3 = bf_hi(pw.y); ss += (f0 * f0 + f1 * f1) + (f2 * f2 + f3 * f3);
            *(u32x2*)(Y + 32 * eb + 8 * g4 + 4 * h) = pw;
        }
    ss += __shfl_xor(ss, 32);
    if (h == 0) ((float*)(ws + WS_SSQ + PT_C))[((size_t)l * 16384 + (size_t)b * 2048 + q) * 8 + hd] = ss;
}

__device__ __forceinline__ void nsa_bias32(float (&bv)[2][16], const LAS float* bl, int dd) {
#pragma unroll
    for (int kb = 0; kb < 2; ++kb)
#pragma unroll
        for (int k = 0; k < 16; ++k) { const int c = 63 - (32 * kb + (k & 3) + 8 * (k >> 2)); int d = dd + c; d = d < 0 ? 0 : (d > 255 ? 255 : d); bv[kb][k] = bl[d]; }
}
__device__ __forceinline__ void nsa_mask_bias(f32x16 (&sc)[2], int dq, int h, const LAS float* bl, bool sel, int lim) {
    int dd = dq - 4 * h - 63; asm volatile("" : "+v"(dd));
    float bv[2][16]; nsa_bias32(bv, bl, dd);
#pragma unroll
    for (int kb = 0; kb < 2; ++kb)
#pragma unroll
        for (int k = 0; k < 16; ++k) { const int c = 63 - (32 * kb + (k & 3) + 8 * (k >> 2)); const int d = dd + c; sc[kb][k] = (sel && d >= 0 && d < lim) ? sc[kb][k] + bv[kb][k] : -1e30f; }
}
__device__ __forceinline__ void nsa_mask_bias_half(f32x16& sc, int dq, int h, const LAS float* bl, bool sel, int lim, int kb) {
    int dd = dq - 4 * h - 32 * kb; asm volatile("" : "+v"(dd));
    float bv[16];
#pragma unroll
    for (int k = 0; k < 16; ++k) { int d = dd - ((k & 3) + 8 * (k >> 2)); d = d < 0 ? 0 : (d > 255 ? 255 : d); bv[k] = bl[d]; }
#pragma unroll
    for (int k = 0; k < 16; ++k) { const int d = dd - ((k & 3) + 8 * (k >> 2)); sc[k] = (sel && d >= 0 && d < lim) ? sc[k] + bv[k] : -1e30f; }
}

__device__ __forceinline__ void attn_park(const AttnState& A, LAS float* xl) {
    xl[0] = A.m; xl[64] = A.l;
#pragma unroll
    for (int k = 0; k < 16; ++k) { xl[64 * (2 + k)] = A.o[0][k]; xl[64 * (18 + k)] = A.o[1][k]; }
}
__device__ __forceinline__ void attn_merge(AttnState& A, const LAS float* xl) {
    const float m2 = xl[0], l2 = xl[64]; const float m = fmaxf(A.m, m2);
    const float a1 = A.m > -1e29f ? __builtin_amdgcn_exp2f(A.m - m) : 0.f, a2 = m2 > -1e29f ? __builtin_amdgcn_exp2f(m2 - m) : 0.f;
    A.l = A.l * a1 + l2 * a2; A.m = m;
#pragma unroll
    for (int k = 0; k < 16; ++k) { A.o[0][k] = A.o[0][k] * a1 + xl[64 * (2 + k)] * a2; A.o[1][k] = A.o[1][k] * a1 + xl[64 * (18 + k)] * a2; }
}
constexpr int NSA_KT = 0, NSA_VT = 2 * 64 * 144, NSA_BIAS = NSA_VT + 2 * 64 * VTP, NSA_PS = NSA_BIAS + 3 * 256 * 4, NSA_SEL = NSA_PS + 3 * 64 * 32 * 4, NSA_UNI = NSA_SEL + 256, NSA_OT = NSA_UNI + 256, NSA_LDS = NSA_OT + 6 * 8192;
__device__ __forceinline__ void nsa_unit(int b, int hk, int i, int l, InPtr in, unsigned char* ws, LAS unsigned char* lds, int g_wv) {
    int tid_ = TIDX; asm volatile("" : "+v"(tid_));
    const int tid = tid_, w = tid >> 6, lane = tid & 63, r = lane & 31, h = lane >> 5;
    const bool active = w < 6; const int g = active ? (w >> 1) : 2, th = w & 1, head = hk * 3 + g;
    const int kh = w < 4 ? -1 : (w < 6 ? 0 : 1);
    LAS float* xl = (LAS float*)(lds + NSA_LDS) + th * (34 * 64) + lane;
    const int t = 64 * i + 32 * th + r, tl = 32 * th + r; const size_t row = (size_t)b * 2048 + t;
    const size_t kvslab = (size_t)(b * 2 + hk) * 2048 * 64;
    LAS float* biasl = (LAS float*)(lds + NSA_BIAS); LAS float* PS = (LAS float*)(lds + NSA_PS); LAS unsigned* SEL = (LAS unsigned*)(lds + NSA_SEL); LAS unsigned* UNI = (LAS unsigned*)(lds + NSA_UNI);
    { const float* bd = (const float*)(ws + WS_BIASD) + (size_t)hk * 3 * 2048;
      if (tid < 384) { const int gg = tid >> 7, d0 = (tid & 127) * 2; biasl[gg * 256 + d0] = bd[gg * 2048 + d0]; biasl[gg * 256 + d0 + 1] = bd[gg * 2048 + d0 + 1]; }
#pragma unroll
      for (int k = 0; k < 12; ++k) if (i >= 16) PS[tid + 512 * k] = 0.f;
      if (tid < 4) UNI[tid] = 0u; }
    bf16x8 qf[4];
    { const bf16_t* QN = (const bf16_t*)(ws + WS_PRJ + PRJ_QN) + ((size_t)(b * 6 + head) * 2048 + t) * 64;
#pragma unroll
      for (int ks = 0; ks < 4; ++ks) qf[ks] = *(const bf16x8*)(QN + 16 * ks + 8 * h); }
#define NSA_GATE(k) ({ int t_ = t; asm volatile("" : "+v"(t_)); sigmf(((const float*)(ws + WS_PRJ + PRJ_GATES))[((size_t)b * 2048 + t_) * 32 + head * 3 + (k)]); })
    LAS float* bl = biasl + g * 256;
    LAS float* otl = (LAS float*)(lds + NSA_OT + (active ? w : 0) * 8192) + lane;
    u32x4 kr[2], vr;
    const int ntc = i >= 16 ? 2 : 1;
    { const bf16_t* KC = (const bf16_t*)(ws + WS_CMP) + (size_t)(b * 2 + hk) * 128 * 64; const bf16_t* VC = (const bf16_t*)(ws + WS_CMP + CMP_V) + (size_t)(b * 2 + hk) * 128 * 64;
      for (int T = 0; T < ntc; ++T) { stage_k_load<64>(kr, KC + T * 4096, tid); vr = stage_v_load(VC + T * 4096, tid); stage_k_store<64>(kr, lds + NSA_KT + T * 64 * 144, tid); stage_v_store(vr, lds + NSA_VT + T * 64 * VTP, tid); } }
    __syncthreads();
    {
        f32x16 ot[2];
        if (active && i < 16) {
            AttnState A; attn_reset(A); f32x16 sc[2]; attn_scores<64>(sc, qf, lds + NSA_KT, r, h);
            float bvc[2][16];
#pragma unroll
            for (int kb = 0; kb < 2; ++kb)
#pragma unroll
                for (int k = 0; k < 16; ++k) { int d = t - 16 * (32 * kb + crow(k, h)) - 31; d = d < 0 ? 0 : (d > 255 ? 255 : d); bvc[kb][k] = bl[d]; }
#pragma unroll
            for (int kb = 0; kb < 2; ++kb)
#pragma unroll
                for (int k = 0; k < 16; ++k) { const int d = t - 16 * (32 * kb + crow(k, h)) - 31; sc[kb][k] = d >= 0 ? sc[kb][k] + bvc[kb][k] : -1e30f; }
            attn_softmax_pv(A, sc, lds + NSA_VT, r, h);
            const float gc = NSA_GATE(0); const float inv = A.l > 0.f ? gc / A.l : 0.f;
#pragma unroll
            for (int k = 0; k < 16; ++k) { otl[64 * k] = A.o[0][k] * inv; otl[64 * (16 + k)] = A.o[1][k] * inv; }
        } else if (active) {
            float m = -1e30f, lsum = 0.f;
            for (int T = 0; T < ntc; ++T) {
                f32x16 sc[2]; attn_scores<64>(sc, qf, lds + NSA_KT + T * 64 * 144, r, h);
                float bvc[2][16];
#pragma unroll
                for (int kb = 0; kb < 2; ++kb)
#pragma unroll
                    for (int k = 0; k < 16; ++k) { int d = t - 16 * (64 * T + 32 * kb + crow(k, h)) - 31; d = d < 0 ? 0 : (d > 255 ? 255 : d); bvc[kb][k] = bl[d]; }
                float mx = -1e30f;
#pragma unroll
                for (int kb = 0; kb < 2; ++kb)
#pragma unroll
                    for (int k = 0; k < 16; ++k) { const int n = 64 * T + 32 * kb + crow(k, h); const int d = t - 16 * n - 31; const float x = (d >= 0 && n < 127) ? sc[kb][k] + bvc[kb][k] : -1e30f; sc[kb][k] = x; mx = fmaxf(mx, x); }
                mx = fmaxf(mx, __shfl_xor(mx, 32));
                const float mnew = fmaxf(m, mx), mref = mnew <= -1e29f ? 0.f : mnew; float rs = 0.f;
#pragma unroll
                for (int kb = 0; kb < 2; ++kb)
#pragma unroll
                    for (int k = 0; k < 16; ++k) rs += __builtin_amdgcn_exp2f(sc[kb][k] - mref);
                rs += __shfl_xor(rs, 32);
                lsum = lsum * __builtin_amdgcn_exp2f(m - mref) + rs; m = mnew;
            }
            const float mref = m <= -1e29f ? 0.f : m, inv = lsum > 0.f ? 1.f / lsum : 0.f;
#pragma unroll
            for (int k = 0; k < 16; ++k) { ot[0][k] = 0.f; ot[1][k] = 0.f; }
            float carry = 0.f;
            for (int T = 0; T < ntc; ++T) {
                f32x16 sc[2]; attn_scores<64>(sc, qf, lds + NSA_KT + T * 64 * 144, r, h);
                float bvc[2][16];
#pragma unroll
                for (int kb = 0; kb < 2; ++kb)
#pragma unroll
                    for (int k = 0; k < 16; ++k) { int d = t - 16 * (64 * T + 32 * kb + crow(k, h)) - 31; d = d < 0 ? 0 : (d > 255 ? 255 : d); bvc[kb][k] = bl[d]; }
#pragma unroll
                for (int kb = 0; kb < 2; ++kb)
#pragma unroll
                    for (int k = 0; k < 16; ++k) { const int n = 64 * T + 32 * kb + crow(k, h); const int d = t - 16 * n - 31; sc[kb][k] = (d >= 0 && n < 127) ? __builtin_amdgcn_exp2f(sc[kb][k] + bvc[kb][k] - mref) * inv : 0.f; }
                float prevL = carry;
#pragma unroll
                for (int kb = 0; kb < 2; ++kb)
#pragma unroll
                    for (int g4 = 0; g4 < 4; ++g4) {
                        const float G4 = (sc[kb][4 * g4] + sc[kb][4 * g4 + 1]) + (sc[kb][4 * g4 + 2] + sc[kb][4 * g4 + 3]); const float L = sc[kb][4 * g4 + 3];
                        const float Lo = __shfl_xor(L, 32);
                        const float add = h ? Lo : prevL;
                        prevL = Lo;
                        const int idx = T * 8 + kb * 4 + g4;
                        PS[g * 2048 + tl * 32 + 2 * idx + h] = G4 + add;
                    }
                carry = prevL;
#pragma unroll
                for (int s4 = 0; s4 < 4; ++s4) {
                    const int kb = s4 >> 1, hf = (s4 & 1) * 8;
                    u32x4 pw; pw.x = pk_bf16(sc[kb][hf + 0], sc[kb][hf + 1]); pw.y = pk_bf16(sc[kb][hf + 2], sc[kb][hf + 3]); pw.z = pk_bf16(sc[kb][hf + 4], sc[kb][hf + 5]); pw.w = pk_bf16(sc[kb][hf + 6], sc[kb][hf + 7]);
                    const bf16x8 pf = __builtin_bit_cast(bf16x8, pw);
#pragma unroll
                    for (int eb = 0; eb < 2; ++eb) ot[eb] = MFMA32(vt_frag(lds + NSA_VT + T * 64 * VTP, vt_lane_off(lane), s4, eb), pf, ot[eb]);
                }
            }
            { const float gc = NSA_GATE(0);
#pragma unroll
            for (int k = 0; k < 16; ++k) { otl[64 * k] = ot[0][k] * gc; otl[64 * (16 + k)] = ot[1][k] * gc; } }
        }
    }
    __syncthreads();
#ifndef NO_NSA_SEL
    if (i < 16) { if (tid < 64) SEL[tid] = (2u << i) - 1u; if (tid < 3) UNI[tid] = (2u << i) - 1u; }
    else {
        const int tk = tid >> 3, sg = tid & 7; float v[32];
#pragma unroll
        for (int k = 0; k < 8; ++k) { const f32x4 x0 = *(const LAS f32x4*)(PS + tk * 32 + 4 * k), x1 = *(const LAS f32x4*)(PS + 2048 + tk * 32 + 4 * k), x2 = *(const LAS f32x4*)(PS + 4096 + tk * 32 + 4 * k);
            v[4 * k] = (x0.x + x1.x) + x2.x; v[4 * k + 1] = (x0.y + x1.y) + x2.y; v[4 * k + 2] = (x0.z + x1.z) + x2.z; v[4 * k + 3] = (x0.w + x1.w) + x2.w; }
#pragma unroll
        for (int s = 0; s < 32; ++s) { const bool forced = (s == 0) || (s == i) || (s == i - 1); float x = forced ? v[s] + 1e4f : v[s]; v[s] = s > i ? -1.f : x; }
        unsigned bits = 0u;
#pragma unroll
        for (int k = 0; k < 4; ++k) {
            float x = 0.f;
#pragma unroll
            for (int s = 0; s < 32; ++s) x = (s == 4 * sg + k) ? v[s] : x;
            int rank = 0;
#pragma unroll
            for (int s = 0; s < 32; ++s) rank += (v[s] > x || (v[s] == x && s < 4 * sg + k)) ? 1 : 0;
            if (rank < 16 && x >= 0.f) bits |= 1u << (4 * sg + k);
        }
        bits |= shx<1>(bits); bits |= shx<2>(bits); bits |= shx<4>(bits);
        if (sg == 0) { SEL[tk] = bits; __hip_atomic_fetch_or(UNI, bits, __ATOMIC_RELAXED, __HIP_MEMORY_SCOPE_WORKGROUP); __hip_atomic_fetch_or(UNI + 1 + (tk >> 5), bits, __ATOMIC_RELAXED, __HIP_MEMORY_SCOPE_WORKGROUP); }
    }
#endif
    __syncthreads();
    const unsigned selbits = SEL[tl], uni = UNI[0], unih = UNI[1 + th];
    const float c31 = bl[255];
#ifndef NO_NSA_SLC
#ifndef NSA_DUP_SLC
#define NSA_DUP_SLC 1
#endif
    for (int rp_ = 0; rp_ < NSA_DUP_SLC; ++rp_) {
        AttnState A; attn_reset(A);
        const bf16_t* KS = (const bf16_t*)(ws + WS_PRJ + PRJ_KN1) + kvslab; const bf16_t* VS = (const bf16_t*)(ws + WS_PRJ + PRJ_VN1) + kvslab;
        unsigned todo = uni; int cur = 0; u32x4 kr2[2], vr2;
        int s = __ffs(todo) - 1; todo &= todo - 1;
        stage_k_load<64>(kr, KS + (size_t)s * 4096, tid); vr = stage_v_load(VS + (size_t)s * 4096, tid);
        stage_k_store<64>(kr, lds + NSA_KT, tid); stage_v_store(vr, lds + NSA_VT, tid);
        int sn = todo ? __ffs(todo) - 1 : -1; todo &= todo - 1;
        if (sn >= 0) { stage_k_load<64>(kr, KS + (size_t)sn * 4096, tid); vr = stage_v_load(VS + (size_t)sn * 4096, tid); }
        __syncthreads();
        while (s >= 0) {
            const int sn2 = todo ? __ffs(todo) - 1 : -1; todo &= todo - 1;
            if (sn2 >= 0) { stage_k_load<64>(kr2, KS + (size_t)sn2 * 4096, tid); vr2 = stage_v_load(VS + (size_t)sn2 * 4096, tid); }
            if ((unih >> s) & 1u) {
                const bool sel = (selbits >> s) & 1u;
                if (kh < 0) {
                    f32x16 sc[2];
                    attn_scores<64>(sc, qf, lds + NSA_KT + cur * 64 * 144, r, h);
                    if (i - s >= 3) attn_softmax_pv(A, sc, lds + NSA_VT + cur * 64 * VTP, r, h, c31, sel);
                    else { nsa_mask_bias(sc, t - 64 * s, h, bl, sel, 4096); attn_softmax_pv(A, sc, lds + NSA_VT + cur * 64 * VTP, r, h); }
                } else {
                    f32x16 s1;
                    attn_scores_half<64>(s1, qf, lds + NSA_KT + cur * 64 * 144, r, h, kh);
                    if (i - s >= 3) attn_softmax_pv_half(A, s1, lds + NSA_VT + cur * 64 * VTP, r, h, kh, c31, sel);
                    else { nsa_mask_bias_half(s1, t - 64 * s, h, bl, sel, 4096, kh); attn_softmax_pv_half(A, s1, lds + NSA_VT + cur * 64 * VTP, r, h, kh); }
                }
            }
            if (sn >= 0) { stage_k_store<64>(kr, lds + NSA_KT + (cur ^ 1) * 64 * 144, tid); stage_v_store(vr, lds + NSA_VT + (cur ^ 1) * 64 * VTP, tid); }
            kr[0] = kr2[0]; vr = vr2;
            __syncthreads();
            s = sn; sn = sn2; cur ^= 1;
        }
        if (kh == 1) attn_park(A, xl);
        __syncthreads();
        if (kh == 0) attn_merge(A, xl);
        if (active && rp_ == NSA_DUP_SLC - 1) { const float gs = NSA_GATE(1); const float inv = A.l > 0.f ? gs / A.l : 0.f;
#pragma unroll
            for (int k = 0; k < 16; ++k) { otl[64 * k] += A.o[0][k] * inv; otl[64 * (16 + k)] += A.o[1][k] * inv; } }
    }
#endif
#ifndef NO_NSA_WIN
#ifndef NSA_DUP_WIN
#define NSA_DUP_WIN 1
#endif
    for (int rq_ = 0; rq_ < NSA_DUP_WIN; ++rq_) {
        AttnState A; attn_reset(A);
        const bf16_t* KW = (const bf16_t*)(ws + WS_PRJ + PRJ_KN2) + kvslab; const bf16_t* VW = (const bf16_t*)(ws + WS_PRJ + PRJ_VN2) + kvslab;
        const int j0 = i > 8 ? i - 8 : 0; int cur = 0; u32x4 kr2[2], vr2;
        stage_k_load<64>(kr, KW + (size_t)j0 * 4096, tid); vr = stage_v_load(VW + (size_t)j0 * 4096, tid);
        stage_k_store<64>(kr, lds + NSA_KT, tid); stage_v_store(vr, lds + NSA_VT, tid);
        if (j0 < i) { stage_k_load<64>(kr, KW + (size_t)(j0 + 1) * 4096, tid); vr = stage_v_load(VW + (size_t)(j0 + 1) * 4096, tid); }
        __syncthreads();
        for (int j = j0; j <= i; ++j) {
            if (j + 2 <= i) { stage_k_load<64>(kr2, KW + (size_t)(j + 2) * 4096, tid); vr2 = stage_v_load(VW + (size_t)(j + 2) * 4096, tid); }
            if (kh < 0) {
                f32x16 sc[2];
                attn_scores<64>(sc, qf, lds + NSA_KT + cur * 64 * 144, r, h);
                if (i - j >= 3 && j > i - 8) attn_softmax_pv(A, sc, lds + NSA_VT + cur * 64 * VTP, r, h, c31, true);
                else { nsa_mask_bias(sc, t - 64 * j, h, bl, true, 512); attn_softmax_pv(A, sc, lds + NSA_VT + cur * 64 * VTP, r, h); }
            } else {
                f32x16 s1;
                attn_scores_half<64>(s1, qf, lds + NSA_KT + cur * 64 * 144, r, h, kh);
                if (i - j >= 3 && j > i - 8) attn_softmax_pv_half(A, s1, lds + NSA_VT + cur * 64 * VTP, r, h, kh, c31, true);
                else { nsa_mask_bias_half(s1, t - 64 * j, h, bl, true, 512, kh); attn_softmax_pv_half(A, s1, lds + NSA_VT + cur * 64 * VTP, r, h, kh); }
            }
            if (j < i) { stage_k_store<64>(kr, lds + NSA_KT + (cur ^ 1) * 64 * 144, tid); stage_v_store(vr, lds + NSA_VT + (cur ^ 1) * 64 * VTP, tid); }
            kr[0] = kr2[0]; vr = vr2;
            __syncthreads();
            cur ^= 1;
        }
        if (kh == 1) attn_park(A, xl);
        __syncthreads();
        if (kh == 0) attn_merge(A, xl);
        if (active && rq_ == NSA_DUP_WIN - 1) { const float gw = NSA_GATE(2); const float inv = A.l > 0.f ? gw / A.l : 0.f;
            float ss = 0.f; bf16_t* Y = (bf16_t*)(ws + WS_Y) + row * 1024 + head * 64;
#pragma unroll
            for (int eb = 0; eb < 2; ++eb)
#pragma unroll
                for (int g4 = 0; g4 < 4; ++g4) {
                    const float v0 = otl[64 * (16 * eb + 4 * g4)] + A.o[eb][4 * g4] * inv, v1 = otl[64 * (16 * eb + 4 * g4 + 1)] + A.o[eb][4 * g4 + 1] * inv;
                    const float v2 = otl[64 * (16 * eb + 4 * g4 + 2)] + A.o[eb][4 * g4 + 2] * inv, v3 = otl[64 * (16 * eb + 4 * g4 + 3)] + A.o[eb][4 * g4 + 3] * inv;
                    u32x2 pw; pw.x = pk_bf16(v0, v1); pw.y = pk_bf16(v2, v3);
                    const float f0 = bf_lo(pw.x), f1 = bf_hi(pw.x), f2 = bf_lo(pw.y), f3 = bf_hi(pw.y); ss += (f0 * f0 + f1 * f1) + (f2 * f2 + f3 * f3);
                    *(u32x2*)(Y + 32 * eb + 8 * g4 + 4 * h) = pw;
                }
            ss += __shfl_xor(ss, 32);
            if (h == 0) ((float*)(ws + WS_SSQ + PT_A))[((size_t)l * 16384 + row) * 8 + head] = ss;
        }
    }
#endif
}

__device__ __forceinline__ void ml_out_wave(int cu, int l, InPtr in, unsigned char* ws, LAS unsigned char* wl, LAS unsigned char* npl, int lane) {
    const int c = cu & 31, bh = cu >> 5, hd = bh & 3, b = bh >> 2; const int t0 = c * 64; const int r = lane & 15, q = lane >> 4;
    const bf16_t* QC = (const bf16_t*)(ws + WS_ML) + ((size_t)bh * 2048 + t0) * 64; const bf16_t* KC = (const bf16_t*)(ws + WS_ML + ML_KC) + ((size_t)bh * 2048 + t0) * 64;
    const bf16_t* V = (const bf16_t*)(ws + WS_PRJ + PRJ_VML) + ((size_t)bh * 2048 + t0) * 64;
    const float* mlg = (const float*)(ws + WS_ML + ML_G) + ((size_t)bh * 2048 + t0) * 2;
    const bf16_t* CP = (const bf16_t*)(ws + WS_ML + ML_CP) + (size_t)cu * 4096; const bf16_t* NP = (const bf16_t*)(ws + WS_ML + ML_NP) + (size_t)cu * 64;
    u32x4 vch[8];
#pragma unroll
    for (int i = 0; i < 8; ++i) vch[i] = *(const u32x4*)(V + (size_t)(lane + 64 * i) * 8);
    bf16x8 aq[4][2];
#pragma unroll
    for (int mb = 0; mb < 4; ++mb)
#pragma unroll
        for (int ks = 0; ks < 2; ++ks) aq[mb][ks] = *(const bf16x8*)(QC + (size_t)(16 * mb + r) * 64 + 32 * ks + 8 * q);
    float bj[4][4], den[4][4];
#pragma unroll
    for (int mb = 0; mb < 4; ++mb)
#pragma unroll
        for (int j = 0; j < 4; ++j) bj[mb][j] = mlg[(16 * mb + 4 * q + j) * 2];
    {
        float cs[4];
#pragma unroll
        for (int nb = 0; nb < 4; ++nb) { const float2 gg = *(const float2*)(mlg + (16 * nb + r) * 2); cs[nb] = gg.y - gg.x; }
#pragma unroll
        for (int mb = 0; mb < 4; ++mb) {
            f32x4 accS[4];
#pragma unroll
            for (int nb = 0; nb < 4; ++nb) { accS[nb] = (f32x4){0.f, 0.f, 0.f, 0.f};
#pragma unroll
                for (int ks = 0; ks < 2; ++ks) { const bf16x8 bk = *(const bf16x8*)(KC + (size_t)(16 * nb + r) * 64 + 32 * ks + 8 * q); accS[nb] = MFMA16(aq[mb][ks], bk, accS[nb]); } }
#pragma unroll
            for (int j = 0; j < 4; ++j) {
                const int jj = 16 * mb + 4 * q + j; float rs = 0.f;
#pragma unroll
                for (int nb = 0; nb < 4; ++nb) { const int s = 16 * nb + r; const float p = s <= jj ? accS[nb][j] * __expf(bj[mb][j] + cs[nb]) : 0.f; rs += p;
                    *(LAS bf16_t*)(wl + 8192 + swz_off(jj, s >> 3) + (s & 7) * 2) = f2bf(p); }
                rs += shx<1>(rs); rs += shx<2>(rs); rs += shx<4>(rs); rs += shx<8>(rs);
                den[mb][j] = rs;
            }
        }
    }
#pragma unroll
    for (int i = 0; i < 8; ++i) { const int ch = lane + 64 * i, sv = ch >> 3, e0 = (ch & 7) * 8; const unsigned xs[4] = {vch[i].x, vch[i].y, vch[i].z, vch[i].w};
#pragma unroll
        for (int k = 0; k < 4; ++k) { *(LAS bf16_t*)(wl + swz_off(e0 + 2 * k, sv >> 3) + (sv & 7) * 2) = (bf16_t)(xs[k] & 0xffffu); *(LAS bf16_t*)(wl + swz_off(e0 + 2 * k + 1, sv >> 3) + (sv & 7) * 2) = (bf16_t)(xs[k] >> 16); } }
#pragma unroll
    for (int mb = 0; mb < 4; ++mb) { const float e = __expf(mlg[(16 * mb + r) * 2]);
#pragma unroll
        for (int ks = 0; ks < 2; ++ks) { const u32x4 x = __builtin_bit_cast(u32x4, aq[mb][ks]); u32x4 y;
            y.x = pk_bf16(bf_lo(x.x) * e, bf_hi(x.x) * e); y.y = pk_bf16(bf_lo(x.y) * e, bf_hi(x.y) * e); y.z = pk_bf16(bf_lo(x.z) * e, bf_hi(x.z) * e); y.w = pk_bf16(bf_lo(x.w) * e, bf_hi(x.w) * e);
            aq[mb][ks] = __builtin_bit_cast(bf16x8, y); } }
    f32x4 acc[4][4], accn[4];
#pragma unroll
    for (int mb = 0; mb < 4; ++mb) { accn[mb] = (f32x4){0.f, 0.f, 0.f, 0.f};
#pragma unroll
        for (int nb = 0; nb < 4; ++nb) acc[mb][nb] = (f32x4){0.f, 0.f, 0.f, 0.f}; }
#pragma unroll
    for (int ks = 0; ks < 2; ++ks) {
        u32x4 nz = *(const u32x4*)(NP + 32 * ks + 8 * q); if (r != 0) nz = (u32x4){0u, 0u, 0u, 0u};
        const bf16x8 bn = __builtin_bit_cast(bf16x8, nz);
#pragma unroll
        for (int nb = 0; nb < 4; ++nb) { const bf16x8 bb = *(const bf16x8*)(CP + (size_t)(16 * nb + r) * 64 + 32 * ks + 8 * q);
#pragma unroll
            for (int mb = 0; mb < 4; ++mb) acc[mb][nb] = MFMA16(aq[mb][ks], bb, acc[mb][nb]); }
#pragma unroll
        for (int mb = 0; mb < 4; ++mb) accn[mb] = MFMA16(aq[mb][ks], bn, accn[mb]);
    }
    LDS_FENCE();
#pragma unroll
    for (int ks = 0; ks < 2; ++ks) {
        bf16x8 ap[4];
#pragma unroll
        for (int mb = 0; mb < 4; ++mb) ap[mb] = *(const LAS bf16x8*)(wl + 8192 + swz_off(16 * mb + r, 4 * ks + q));
#pragma unroll
        for (int nb = 0; nb < 4; ++nb) { const bf16x8 bv = *(const LAS bf16x8*)(wl + swz_off(16 * nb + r, 4 * ks + q));
#pragma unroll
            for (int mb = 0; mb < 4; ++mb) acc[mb][nb] = MFMA16(ap[mb], bv, acc[mb][nb]); }
    }
    LDS_FENCE();
    const bf16_t* OG = (const bf16_t*)(ws + WS_PRJ + PRJ_OG); u32x4 ogc[8];
#pragma unroll
    for (int i = 0; i < 8; ++i) { const int ch = lane + 64 * i; ogc[i] = *(const u32x4*)(OG + ((size_t)b * 2048 + t0 + (ch >> 3)) * 256 + hd * 64 + (ch & 7) * 8); }
    const float* gain = in->p[14] + l * 256 + hd * 64;
    bf16_t* Y = (bf16_t*)(ws + WS_Y);
    float gn[4];
#pragma unroll
    for (int nb = 0; nb < 4; ++nb) gn[nb] = gain[16 * nb + r];
#pragma unroll
    for (int mb = 0; mb < 4; ++mb)
#pragma unroll
        for (int j = 0; j < 4; ++j) {
            const int jj = 16 * mb + 4 * q + j;
            const float dn = den[mb][j] + __builtin_bit_cast(float, __builtin_amdgcn_ds_bpermute((lane & 48) << 2, __builtin_bit_cast(int, accn[mb][j])));
            const float inv = __builtin_amdgcn_rcpf(fmaxf(fabsf(dn), 1.f)); float hv[4]; float ss = 0.f;
#pragma unroll
            for (int nb = 0; nb < 4; ++nb) { hv[nb] = acc[mb][nb][j] * inv; ss += hv[nb] * hv[nb]; }
            ss += shx<1>(ss); ss += shx<2>(ss); ss += shx<4>(ss); ss += shx<8>(ss);
            const float rstd = rsqrtf(ss * (1.f / 64.f) + 1e-6f);
#pragma unroll
            for (int nb = 0; nb < 4; ++nb) { const int e = 16 * nb + r; *(LAS bf16_t*)(wl + 8192 + swz_off(jj, e >> 3) + (e & 7) * 2) = f2bf(hv[nb] * rstd * gn[nb]); }
        }
    LDS_FENCE();
#pragma unroll
    for (int i = 0; i < 8; ++i) { const int ch = lane + 64 * i, row = ch >> 3, e8 = ch & 7;
        const u32x4 hx = *(const LAS u32x4*)(wl + 8192 + swz_off(row, e8)); const u32x4 g = ogc[i]; u32x4 o;
        o.x = pk_bf16(bf_lo(hx.x) * sigmf(bf_lo(g.x)), bf_hi(hx.x) * sigmf(bf_hi(g.x)));
        o.y = pk_bf16(bf_lo(hx.y) * sigmf(bf_lo(g.y)), bf_hi(hx.y) * sigmf(bf_hi(g.y)));
        o.z = pk_bf16(bf_lo(hx.z) * sigmf(bf_lo(g.z)), bf_hi(hx.z) * sigmf(bf_hi(g.z)));
        o.w = pk_bf16(bf_lo(hx.w) * sigmf(bf_lo(g.w)), bf_hi(hx.w) * sigmf(bf_hi(g.w)));
        *(u32x4*)(Y + ((size_t)b * 2048 + t0 + row) * 1024 + 768 + hd * 64 + e8 * 8) = o; }
    LDS_FENCE();
}

__device__ __forceinline__ void ml_scan_unit(int bh, int l, unsigned char* ws, int g_wv) {
    int tid_ = TIDX; asm volatile("" : "+v"(tid_)); const int tid = tid_;
    const bf16_t* DL = (const bf16_t*)(ws + WS_ML + ML_DELTA) + (size_t)bh * 32 * 4096 + tid * 8; bf16_t* CP = (bf16_t*)(ws + WS_ML + ML_CP) + (size_t)bh * 32 * 4096 + tid * 8;
    const float* DN = (const float*)(ws + WS_ML + ML_DN) + (size_t)bh * 32 * 64; bf16_t* NP = (bf16_t*)(ws + WS_ML + ML_NP) + (size_t)bh * 32 * 64; const float* BL = (const float*)(ws + WS_ML + ML_BL) + bh * 32;
    float c[8]; float n = 0.f;
#pragma unroll
    for (int k = 0; k < 8; ++k) c[k] = 0.f;
#pragma unroll 1
    for (int c0 = 0; c0 < 32; c0 += 8) {
        u32x4 d[8]; float dn[8], co[8];
#pragma unroll
        for (int k = 0; k < 8; ++k) { d[k] = *(const u32x4*)(DL + (size_t)(c0 + k) * 4096); dn[k] = tid < 64 ? DN[(c0 + k) * 64 + tid] : 0.f; co[k] = __expf(BL[c0 + k]); }
#pragma unroll
        for (int k = 0; k < 8; ++k) {
            u32x4 o; o.x = pk_bf16(c[0], c[1]); o.y = pk_bf16(c[2], c[3]); o.z = pk_bf16(c[4], c[5]); o.w = pk_bf16(c[6], c[7]);
            *(u32x4*)(CP + (size_t)(c0 + k) * 4096) = o; if (tid < 64) NP[(c0 + k) * 64 + tid] = f2bf(n);
            c[0] = co[k] * c[0] + bf_lo(d[k].x); c[1] = co[k] * c[1] + bf_hi(d[k].x); c[2] = co[k] * c[2] + bf_lo(d[k].y); c[3] = co[k] * c[3] + bf_hi(d[k].y);
            c[4] = co[k] * c[4] + bf_lo(d[k].z); c[5] = co[k] * c[5] + bf_hi(d[k].z); c[6] = co[k] * c[6] + bf_lo(d[k].w); c[7] = co[k] * c[7] + bf_hi(d[k].w);
            n = co[k] * n + dn[k];
        }
    }
    asm volatile("s_waitcnt vmcnt(0)" ::: "memory"); __syncthreads();
    if (tid == 0) { __builtin_amdgcn_fence(__ATOMIC_RELEASE, "agent"); asm volatile("s_waitcnt vmcnt(0)" ::: "memory");
        __hip_atomic_fetch_add((unsigned*)(ws + WS_CTL) + CW_SCAN + 64 * l, 1u, __ATOMIC_RELAXED, __HIP_MEMORY_SCOPE_AGENT); }
}
__device__ __forceinline__ void ml_scan_wait(int l, unsigned char* ws, int g_wv) {
    if (TIDX == 0) { unsigned* p = (unsigned*)(ws + WS_CTL) + CW_SCAN + 64 * l; unsigned sp = 0;
        while (__hip_atomic_load(p, __ATOMIC_RELAXED, __HIP_MEMORY_SCOPE_AGENT) < 32u) { __builtin_amdgcn_s_sleep(2); if (++sp > (1u << 22)) break; }
        __builtin_amdgcn_fence(__ATOMIC_ACQUIRE, "agent"); asm volatile("s_waitcnt vmcnt(0)" ::: "memory"); }
    __syncthreads();
}

#ifndef DUP_NSA
#define DUP_NSA 1
#endif
#ifndef DUP_MLA
#define DUP_MLA 1
#endif
#ifndef DUP_ML
#define DUP_ML 1
#endif
#ifdef NO_MLA
#define MLA_CALL(...) do {} while (0)
#else
#define MLA_CALL(...) do { for (int rp = 0; rp < DUP_MLA; ++rp) { if (rp) __syncthreads(); mla_unit(__VA_ARGS__); } } while (0)
#endif
__device__ __forceinline__ void phase_mix(int l, InPtr in, unsigned char* ws, LAS unsigned char* lds, unsigned* qhead, int g_wv) {
    LAS int* slot = (LAS int*)(lds + LDS_MISC + 64);
    for (;;) {
        __syncthreads();
        if (TIDX == 0) *slot = (int)__hip_atomic_fetch_add(qhead, 1u, __ATOMIC_RELAXED, __HIP_MEMORY_SCOPE_AGENT);
        __syncthreads();
        int u = *slot;
        if (u >= 32 + 512 + 384 + 128) break;
        if (u < 32) { ml_scan_unit(u, l, ws, g_wv); continue; } u -= 32;
#ifndef NO_NSA
        if (u < 256) { const int i = 31 - (u >> 4), bh = u & 15; { for (int rp = 0; rp < DUP_NSA; ++rp) { if (rp) __syncthreads(); nsa_unit(bh >> 1, bh & 1, i, l, in, ws, lds, g_wv); } } continue; }
#endif
        u -= 256;
        if (u < 192) { const int qt = 7 - u / 48, bh = u % 48; MLA_CALL(bh / 6, bh % 6, qt, l, ws, lds, g_wv); continue; }
        u -= 192;
#ifndef NO_NSA
        if (u < 128) { const int i = 15 - (u >> 4), bh = u & 15; { for (int rp = 0; rp < DUP_NSA; ++rp) { if (rp) __syncthreads(); nsa_unit(bh >> 1, bh & 1, i, l, in, ws, lds, g_wv); } } continue; }
#endif
        u -= 128;
        if (u < 192) { const int qt = 3 - u / 48, bh = u % 48; MLA_CALL(bh / 6, bh % 6, qt, l, ws, lds, g_wv); continue; } u -= 192;
#ifndef NO_NSA
        if (u < 128) { const int i = 7 - (u >> 4), bh = u & 15; { for (int rp = 0; rp < DUP_NSA; ++rp) { if (rp) __syncthreads(); nsa_unit(bh >> 1, bh & 1, i, l, in, ws, lds, g_wv); } } continue; }
#endif
        u -= 128;
#ifndef NO_MLOUT
        ml_scan_wait(l, ws, g_wv);
        for (int rp = 0; rp < DUP_ML; ++rp) { int tid_ = TIDX; asm volatile("" : "+v"(tid_)); const int w = tid_ >> 6; ml_out_wave(u * 8 + w, l, in, ws, lds + w * 16384, lds + 131072 + w * 256, tid_ & 63); }
#endif
    }
}
__device__ __forceinline__ void phase_ynorm(int l, unsigned char* ws, int bid, int nb, int g_wv) {
    int tid_ = TIDX; asm volatile("" : "+v"(tid_)); const int w = tid_ >> 6, lane = tid_ & 63;
    bf16_t* Y = (bf16_t*)(ws + WS_Y); const float* sa = (const float*)(ws + WS_SSQ + PT_A) + (size_t)l * 16384 * 8; const float* sc = (const float*)(ws + WS_SSQ + PT_C) + (size_t)l * 16384 * 8;
    for (int r0 = (bid * 8 + w) * 8; r0 < NTOK; r0 += nb * 64) {
        if (lane < 48) {
            u32x4 x[8], y[8]; float ra[8], rc[8];
#pragma unroll
            for (int k = 0; k < 8; ++k) { const int row = r0 + k;
                const f32x4 a0 = *(const f32x4*)(sa + (size_t)row * 8), a1 = *(const f32x4*)(sa + (size_t)row * 8 + 4), c0 = *(const f32x4*)(sc + (size_t)row * 8), c1 = *(const f32x4*)(sc + (size_t)row * 8 + 4);
                ra[k] = rsqrtf((((a0.x + a0.y) + (a0.z + a0.w)) + (a1.x + a1.y)) * (1.f / 384.f) + 1e-6f); rc[k] = rsqrtf((((c0.x + c0.y) + (c0.z + c0.w)) + (c1.x + c1.y)) * (1.f / 384.f) + 1e-6f);
                x[k] = *((const u32x4*)(Y + (size_t)row * 1024) + lane); y[k] = *((const u32x4*)(Y + (size_t)row * 1024 + 384) + lane); }
#pragma unroll
            for (int k = 0; k < 8; ++k) { const int row = r0 + k; u32x4 a = x[k], c = y[k]; const float fa = ra[k], fc = rc[k];
                a.x = pk_bf16(bf_lo(a.x) * fa, bf_hi(a.x) * fa); a.y = pk_bf16(bf_lo(a.y) * fa, bf_hi(a.y) * fa); a.z = pk_bf16(bf_lo(a.z) * fa, bf_hi(a.z) * fa); a.w = pk_bf16(bf_lo(a.w) * fa, bf_hi(a.w) * fa);
                c.x = pk_bf16(bf_lo(c.x) * fc, bf_hi(c.x) * fc); c.y = pk_bf16(bf_lo(c.y) * fc, bf_hi(c.y) * fc); c.z = pk_bf16(bf_lo(c.z) * fc, bf_hi(c.z) * fc); c.w = pk_bf16(bf_lo(c.w) * fc, bf_hi(c.w) * fc);
                *((u32x4*)(Y + (size_t)row * 1024) + lane) = a; *((u32x4*)(Y + (size_t)row * 1024 + 384) + lane) = c; }
        }
    }
}
constexpr int LDS_FAC = 131072 + 2048;
__device__ __forceinline__ void outproj_factors(int l, unsigned char* ws, LAS unsigned char* lds, int pm, int tid) {
    asm volatile("" : "+v"(tid));
    if (tid < 256) { const int row = pm * 256 + tid; const float* sa = (const float*)(ws + WS_SSQ + PT_A) + ((size_t)l * 16384 + row) * 8; const float* sc = (const float*)(ws + WS_SSQ + PT_C) + ((size_t)l * 16384 + row) * 8;
        const f32x4 a0 = *(const f32x4*)sa, a1 = *(const f32x4*)(sa + 4), c0 = *(const f32x4*)sc, c1 = *(const f32x4*)(sc + 4);
        const float ra = rsqrtf((((a0.x + a0.y) + (a0.z + a0.w)) + (a1.x + a1.y)) * (1.f / 384.f) + 1e-6f), rc = rsqrtf((((c0.x + c0.y) + (c0.z + c0.w)) + (c1.x + c1.y)) * (1.f / 384.f) + 1e-6f);
        LAS float* F = (LAS float*)(lds + LDS_FAC); F[2 * tid] = ra / rc; F[2 * tid + 1] = rc; }
    __syncthreads();
}
struct EpiOut {
    static constexpr bool KHOOK = true;
    bf16_t* XB; float* ssq; const LAS float* F; bool fold;
    __device__ __forceinline__ void kscale(f32x4 (&acc)[2][2][4][2], int which, int wr, int fr) const {
        if (!fold) return;
#pragma unroll
        for (int ai = 0; ai < 2; ++ai)
#pragma unroll
            for (int m = 0; m < 4; ++m) { const float f = F[2 * (ai * 128 + wr * 64 + m * 16 + fr) + which];
#pragma unroll
                for (int bj = 0; bj < 2; ++bj)
#pragma unroll
                    for (int n = 0; n < 2; ++n) acc[ai][bj][m][n] = acc[ai][bj][m][n] * f; }
    }
    __device__ __forceinline__ void operator()(const f32x4 (&acc)[2][2][4][2], const GUnit& u, int wr, int wc, int fr, int fq) const {
#pragma unroll
        for (int ai = 0; ai < 2; ++ai)
#pragma unroll
          for (int mh = 0; mh < 2; ++mh) {
            __builtin_amdgcn_sched_barrier(0);
            u32x4 xr[2][2];
#pragma unroll
            for (int m2 = 0; m2 < 2; ++m2)
#pragma unroll
                for (int bj = 0; bj < 2; ++bj) xr[m2][bj] = *(const u32x4*)(XB + (size_t)(u.pm * 256 + ai * 128 + wr * 64 + (2 * mh + m2) * 16 + fr) * 1024 + u.pn * 256 + bj * 128 + wc * 32 + 8 * fq);
#pragma unroll
            for (int m2 = 0; m2 < 2; ++m2) {
                const int m = 2 * mh + m2; const int row = u.pm * 256 + ai * 128 + wr * 64 + m * 16 + fr; float ss = 0.f;
#pragma unroll
                for (int bj = 0; bj < 2; ++bj) {
                    const u32x4 x = xr[m2][bj]; u32x4 o;
                    o.x = pk_bf16(bf_lo(x.x) + acc[ai][bj][m][0][0], bf_hi(x.x) + acc[ai][bj][m][0][1]); o.y = pk_bf16(bf_lo(x.y) + acc[ai][bj][m][0][2], bf_hi(x.y) + acc[ai][bj][m][0][3]);
                    o.z = pk_bf16(bf_lo(x.z) + acc[ai][bj][m][1][0], bf_hi(x.z) + acc[ai][bj][m][1][1]); o.w = pk_bf16(bf_lo(x.w) + acc[ai][bj][m][1][2], bf_hi(x.w) + acc[ai][bj][m][1][3]);
                    *(u32x4*)(XB + (size_t)row * 1024 + u.pn * 256 + bj * 128 + wc * 32 + 8 * fq) = o;
                    ss += (bf_lo(o.x) * bf_lo(o.x) + bf_hi(o.x) * bf_hi(o.x)) + (bf_lo(o.y) * bf_lo(o.y) + bf_hi(o.y) * bf_hi(o.y)) + (bf_lo(o.z) * bf_lo(o.z) + bf_hi(o.z) * bf_hi(o.z)) + (bf_lo(o.w) * bf_lo(o.w) + bf_hi(o.w) * bf_hi(o.w));
                }
                ss = quad_sum(ss); if (fq == 0) ssq[(size_t)row * 16 + u.pn * 4 + wc] = ss;
            }
          }
    }
};

__device__ __forceinline__ float sum16(const float* p) { const f32x4 a = *(const f32x4*)p, b = *(const f32x4*)(p + 4), c = *(const f32x4*)(p + 8), d = *(const f32x4*)(p + 12);
    return (((a.x + a.y) + (a.z + a.w)) + ((b.x + b.y) + (b.z + b.w))) + (((c.x + c.y) + (c.z + c.w)) + ((d.x + d.y) + (d.z + d.w))); }
__device__ __forceinline__ void phase_route(int l, InPtr in, unsigned char* ws, LAS unsigned char* lds, int bid, int nb, int g_wv) {
    int tid_ = TIDX; asm volatile("" : "+v"(tid_)); const int w = tid_ >> 6, lane = tid_ & 63, r = lane & 15, q = lane >> 4;
    const bf16_t* XB = (const bf16_t*)(ws + WS_XB); const bf16_t* WR = (const bf16_t*)(ws + WS_WR) + (size_t)l * 64 * 1024;
    const float* ssq = (const float*)(ws + WS_SSQ + PT_X1) + (size_t)l * 16384 * 16; const float* bg = in->p[24] + l * 4; const float* be = in->p[26] + l * 32;
    unsigned* cnt = (unsigned*)(ws + WS_CTL) + CW_CNT + 2048 * l; unsigned* mtok = (unsigned*)(ws + WS_META); float* mw = (float*)(ws + WS_META + META_W);
    LAS float* lg = (LAS float*)(lds + w * 4096);
    LAS unsigned* lcnt = (LAS unsigned*)(lds + 32768); LAS unsigned* lbase = lcnt + 32;
    for (int g0 = bid * 8; g0 < NTOK / 16; g0 += nb * 8) {
        if (tid_ < 32) lcnt[tid_] = 0u;
        __syncthreads();
        const int tok0 = (g0 + w) * 16; f32x4 acc[3];
#pragma unroll
        for (int n = 0; n < 3; ++n) acc[n] = (f32x4){0.f, 0.f, 0.f, 0.f};
        const bf16_t* ap = XB + (size_t)(tok0 + r) * 1024 + 8 * q; const bf16_t* bp = WR + (size_t)r * 1024 + 8 * q;
#pragma unroll 1
        for (int kc = 0; kc < 4; ++kc) {
            bf16x8 a[8], bb[3][8];
#pragma unroll
            for (int s = 0; s < 8; ++s) { a[s] = *(const bf16x8*)(ap + 32 * (kc * 8 + s));
#pragma unroll
                for (int n = 0; n < 3; ++n) bb[n][s] = *(const bf16x8*)(bp + (size_t)n * 16 * 1024 + 32 * (kc * 8 + s)); }
            __builtin_amdgcn_sched_barrier(0);
#pragma unroll
            for (int s = 0; s < 8; ++s)
#pragma unroll
                for (int n = 0; n < 3; ++n) acc[n] = MFMA16(a[s], bb[n][s], acc[n]);
            __builtin_amdgcn_sched_barrier(0);
        }
#pragma unroll
        for (int n = 0; n < 3; ++n)
#pragma unroll
            for (int j = 0; j < 4; ++j) lg[(4 * q + j) * 48 + 16 * n + r] = acc[n][j];
        LDS_FENCE();
        int E0 = 0, E1 = 0; unsigned r0 = 0, r1 = 0; float wt0 = 0.f, wt1 = 0.f; const int tok = tok0 + (lane & 15);
        if (lane < 16) {
            const float rs = rsqrtf(sum16(ssq + (size_t)tok * 16) * (1.f / 1024.f) + 1e-6f); ((float*)(ws + WS_RS2))[tok] = rs; const LAS float* L = lg + lane * 48;
            float gl[4]; int gi = 0;
#pragma unroll
            for (int j = 0; j < 4; ++j) gl[j] = L[j] * rs + bg[j];
            float gm = gl[0];
#pragma unroll
            for (int j = 1; j < 4; ++j) if (gl[j] > gm) { gm = gl[j]; gi = j; }
            float gsum = 0.f;
#pragma unroll
            for (int j = 0; j < 4; ++j) gsum += __expf(gl[j] - gm);
            const float gtop = 1.f / gsum;
            float el[8];
#pragma unroll
            for (int j = 0; j < 8; ++j) el[j] = L[4 + gi * 8 + j] * rs + be[gi * 8 + j];
            int e0 = 0; float v0 = el[0];
#pragma unroll
            for (int j = 1; j < 8; ++j) if (el[j] > v0) { v0 = el[j]; e0 = j; }
            int e1 = -1; float v1 = -3.0e38f;
#pragma unroll
            for (int j = 0; j < 8; ++j) if (j != e0 && el[j] > v1) { v1 = el[j]; e1 = j; }
            const float w0 = 1.f / (1.f + __expf(v1 - v0)); E0 = gi * 8 + e0; E1 = gi * 8 + e1; wt0 = w0 * gtop; wt1 = (1.f - w0) * gtop;
            r0 = __hip_atomic_fetch_add(lcnt + E0, 1u, __ATOMIC_RELAXED, __HIP_MEMORY_SCOPE_WORKGROUP); r1 = __hip_atomic_fetch_add(lcnt + E1, 1u, __ATOMIC_RELAXED, __HIP_MEMORY_SCOPE_WORKGROUP);
        }
        __syncthreads();
        if (tid_ < 32) { const unsigned c = lcnt[tid_]; lbase[tid_] = c ? atomicAdd(cnt + tid_ * 64, c) : 0u; }
        __syncthreads();
        if (lane < 16) {
            const unsigned p0 = lbase[E0] + r0, p1 = lbase[E1] + r1;
            mtok[(size_t)E0 * 16384 + p0] = (unsigned)tok; mw[(size_t)E0 * 16384 + p0] = wt0;
            mtok[(size_t)E1 * 16384 + p1] = (unsigned)tok | 0x80000000u; mw[(size_t)E1 * 16384 + p1] = wt1;
        }
        __syncthreads();
    }
}

constexpr int LDS_TB = 131072 + 2048;
__device__ __forceinline__ void moe_tables(int l, unsigned char* ws, LAS unsigned char* lds, int g_wv) {
    int tix = TIDX; asm volatile("" : "+v"(tix));
    LAS int* tb = (LAS int*)(lds + LDS_TB);
    if (tix < 32) { const unsigned* cnt = (const unsigned*)(ws + WS_CTL) + CW_CNT + 2048 * l; tb[160 + tix] = (int)__hip_atomic_load(cnt + tix * 64, __ATOMIC_RELAXED, __HIP_MEMORY_SCOPE_AGENT); }
    __syncthreads();
    if (tix == 0) { int a = 0, f = 0, p = 0; for (int e = 0; e < 32; ++e) { const int c = tb[160 + e]; tb[e] = a; tb[48 + e] = f; tb[96 + e] = p; a += (c + 255) >> 8; f += c >> 8; p += (c & 255) ? 1 : 0; } tb[32] = a; tb[80] = f; tb[128] = p; }
    __syncthreads();
}
template <int NPN, bool GATHER_>
struct MoeSched {
    static constexpr bool GATHER = GATHER_, PARTIAL = false;
    const char* A; const char* Bt; const unsigned* cnt; const unsigned* mtok; const LAS int* tb; int G, c; size_t bstride_e  , bstride_pn; int lo, hi;
    __device__ __forceinline__ bool next(int i, GUnit& u) const {
        const int L = lo + i * G + c; if (L >= hi) return false;
        const int tile = L / NPN, pn = L % NPN;
        int e = 0;
        for (int k = 1; k < 32; ++k) e = (tb[k] <= tile) ? k : e;
        e = __builtin_amdgcn_readfirstlane(e);
        u.e = e; u.pm = tile; u.pn = pn; u.rows = tb[160 + e] - 256 * (tile - tb[e]);
        u.a = GATHER ? A : A + (size_t)tile * 256 * 256 * 2;
        u.b = Bt + (size_t)e * bstride_e + (size_t)pn * bstride_pn; return true;
    }
    __device__ __forceinline__ void aoff(const GUnit& u, unsigned (&v)[2][2], const int (&R)[2], const int (&C)[2]) const {
#pragma unroll
        for (int h = 0; h < 2; ++h)
#pragma unroll
            for (int i = 0; i < 2; ++i) {
                if (GATHER) { const int lr = h * 128 + R[i]; const int rr = 256 * (u.pm - tb[u.e]) + (lr < u.rows ? lr : 0); const unsigned tok = mtok[(size_t)u.e * 16384 + rr] & 0x7fffffffu; v[h][i] = (tok * 1024u + (unsigned)C[i]) * 2u; }
                else v[h][i] = (unsigned)((h * 128 + R[i]) * 256 + C[i]) * 2u;
            }
    }
};
struct EpiMoeUp {
    static constexpr bool KHOOK = false;
    const unsigned* mtok; const float* ssq; const LAS int* tb; bf16_t* HB;
    __device__ __forceinline__ void operator()(const f32x4 (&acc)[2][2][4][2], const GUnit& u, int wr, int wc, int fr, int fq) const {
        const int r0 = 256 * (u.pm - tb[u.e]);
        float rs8[8];
        { unsigned tk[8];
#pragma unroll
          for (int k = 0; k < 8; ++k) { const int lr = (k >> 2) * 128 + wr * 64 + (k & 3) * 16 + fr; tk[k] = mtok[(size_t)u.e * 16384 + r0 + (lr < u.rows ? lr : 0)] & 0x7fffffffu; }
#pragma unroll
          for (int k = 0; k < 8; ++k) rs8[k] = ssq[tk[k]]; }
#pragma unroll
        for (int ai = 0; ai < 2; ++ai)
#pragma unroll
            for (int m = 0; m < 4; ++m) {
                __builtin_amdgcn_sched_barrier(0);
                const int lr = ai * 128 + wr * 64 + m * 16 + fr;
                if (lr < u.rows) {
                    const float rs = rs8[ai * 4 + m];
                    float hv[8];
#pragma unroll
                    for (int n = 0; n < 2; ++n)
#pragma unroll
                        for (int j = 0; j < 4; ++j) { const float gv = acc[ai][0][m][n][j] * rs, uv = acc[ai][1][m][n][j] * rs; hv[4 * n + j] = siluf(gv) * uv; }
                    st_bf16x8(HB + ((size_t)u.pm * 256 + lr) * 256 + u.pn * 128 + wc * 32 + 8 * fq, hv);
                }
            }
    }
};
struct EpiMoeDown {
    static constexpr bool KHOOK = false;
    const unsigned* mtok; const float* mw; const LAS int* tb; bf16_t* YB;
    __device__ __forceinline__ void operator()(const f32x4 (&acc)[2][2][4][2], const GUnit& u, int wr, int wc, int fr, int fq) const {
        const int r0 = 256 * (u.pm - tb[u.e]);
        unsigned mt8[8]; float wt8[8];
#pragma unroll
        for (int k = 0; k < 8; ++k) { const int lr = (k >> 2) * 128 + wr * 64 + (k & 3) * 16 + fr; const size_t ix = (size_t)u.e * 16384 + r0 + (lr < u.rows ? lr : 0); mt8[k] = mtok[ix]; wt8[k] = mw[ix]; }
#pragma unroll
        for (int ai = 0; ai < 2; ++ai)
#pragma unroll
            for (int m = 0; m < 4; ++m) {
                __builtin_amdgcn_sched_barrier(0);
                const int lr = ai * 128 + wr * 64 + m * 16 + fr;
                if (lr < u.rows) {
                    const unsigned mt = mt8[ai * 4 + m]; const float wt = wt8[ai * 4 + m];
                    bf16_t* dst = YB + ((size_t)(mt >> 31) * 16384 + (mt & 0x7fffffffu)) * 1024 + u.pn * 256 + wc * 32 + 8 * fq;
#pragma unroll
                    for (int bj = 0; bj < 2; ++bj) { float v[8];
#pragma unroll
                        for (int n = 0; n < 2; ++n)
#pragma unroll
                            for (int j = 0; j < 4; ++j) v[4 * n + j] = acc[ai][bj][m][n][j] * wt;
                        st_bf16x8(dst + bj * 128, v); }
                }
            }
    }
};
__device__ __forceinline__ void phase_combine(int l, unsigned char* ws, float* out, int bid, int nb, int g_wv) {
    int tid_ = TIDX; asm volatile("" : "+v"(tid_)); const int w = tid_ >> 6, lane = tid_ & 63;
    bf16_t* XB = (bf16_t*)(ws + WS_XB); const bf16_t* Y0 = (const bf16_t*)(ws + WS_YBUF); const bf16_t* Y1 = Y0 + (size_t)16384 * 1024; float* ssqx = (float*)(ws + WS_SSQX) + 16384;
    for (int row = bid * 8 + w; row < NTOK; row += nb * 8) {
        float ss = 0.f;
#pragma unroll
        for (int k = 0; k < 2; ++k) {
            const size_t o = (size_t)row * 1024 + (lane + 64 * k) * 8;
            const u32x4 x = *(const u32x4*)(XB + o), a = *(const u32x4*)(Y0 + o), c = *(const u32x4*)(Y1 + o);
            float v[8] = { bf_lo(x.x) + bf_lo(a.x) + bf_lo(c.x), bf_hi(x.x) + bf_hi(a.x) + bf_hi(c.x), bf_lo(x.y) + bf_lo(a.y) + bf_lo(c.y), bf_hi(x.y) + bf_hi(a.y) + bf_hi(c.y),
                           bf_lo(x.z) + bf_lo(a.z) + bf_lo(c.z), bf_hi(x.z) + bf_hi(a.z) + bf_hi(c.z), bf_lo(x.w) + bf_lo(a.w) + bf_lo(c.w), bf_hi(x.w) + bf_hi(a.w) + bf_hi(c.w) };
            if (l == L_ - 1 && out) { *(f32x4*)(out + o) = (f32x4){v[0], v[1], v[2], v[3]}; *(f32x4*)(out + o + 4) = (f32x4){v[4], v[5], v[6], v[7]}; }
            else { u32x4 p; p.x = pk_bf16(v[0], v[1]); p.y = pk_bf16(v[2], v[3]); p.z = pk_bf16(v[4], v[5]); p.w = pk_bf16(v[6], v[7]); *(u32x4*)(XB + o) = p;
#pragma unroll
                   for (int j = 0; j < 4; ++j) { const unsigned q = j == 0 ? p.x : (j == 1 ? p.y : (j == 2 ? p.z : p.w)); ss += bf_lo(q) * bf_lo(q) + bf_hi(q) * bf_hi(q); } }
        }
        if (l < L_ - 1) { ss = wave_sum(ss); if (lane == 0) ssqx[row] = ss; }
    }
}
constexpr int MOE_CVT_SPLIT = 4608;
#ifndef CVT_A
#define CVT_A 2688
#endif
#ifndef NROUTE
#define NROUTE 128
#endif
constexpr int NPH = 9;
enum { PH_INPROJ = 0, PH_PREP, PH_MIX, PH_YNORM, PH_OUTPROJ, PH_ROUTE, PH_MOEUP, PH_MOEDOWN, PH_COMBINE };
struct Args { Inputs in; float* out; unsigned char* ws; int ph_lo, ph_hi; };

__global__ void __launch_bounds__(512, 2) mk(Args args) {
    extern __shared__ __attribute__((aligned(16))) unsigned char lds_raw[];
    LAS unsigned char* lds = (LAS unsigned char*)lds_raw;
    const int g_wv = __builtin_amdgcn_readfirstlane((int)threadIdx.x >> 6);
    const int bid0 = blockIdx.x, nb = gridDim.x;
#define BID() ({ int b_ = bid0; asm volatile("" : "+s"(b_)); b_; })
    unsigned char* ws = args.ws; unsigned* ctl = (unsigned*)(ws + WS_CTL);
    const int lo = args.ph_lo, hi = args.ph_hi;
    if (TIDX < 4) ((LAS unsigned*)(lds + LDS_MISC))[TIDX] = 0u;
    __syncthreads();
    XcdBarrier bar; bar.g_wv = g_wv; bar.bar = ctl + CW_BAR; bar.x = 0; bar.st = nullptr;
    if (hi - lo > 1) bar = xcd_barrier_post(ctl + CW_BAR, (volatile LAS unsigned*)(lds + LDS_MISC), g_wv);
#define IN(k) (lo <= (k) && (k) < hi)
#ifndef REPEAT_PH
#define REPEAT_PH -1
#endif
#define NREP(k) ((REPEAT_PH == (k)) ? 2 : 1)
#ifndef NBAR
#define NBAR 1
#endif
#ifndef TIME_PH
#define TIME_PH -1
#endif
#define STAMP(i) do { if (TIME_PH != -1 && blockIdx.x == 0 && TIDX == 0) ((unsigned long long*)(ctl + CW_TS))[i] = __builtin_amdgcn_s_memrealtime(); } while (0)
#define SEAM(k) do { if (IN(k) && IN((k) + 1)) for (int nb_ = 0; nb_ < NBAR; ++nb_) xcd_barrier(bar); STAMP((k) + 1); } while (0)
    STAMP(0);
#ifndef NO_PRO
    if (IN(0)) for (int rep = 0; rep < NREP(100); ++rep) { prologue(in_tab(), launder(ws), lds, BID(), nb, g_wv); if (rep + 1 < NREP(100)) xcd_barrier(bar); }
#endif
    SEAM(0);
    for (int l = 0; l < L_; ++l) {
        const int pb = 1 + l * NPH;
        if (IN(pb + PH_INPROJ)) for (int rep = 0; rep < NREP(PH_INPROJ); ++rep) {
            if (rep) xcd_barrier(bar);
            InPtr in = in_tab(); unsigned char* ws = launder(args.ws);
            g8::DenseSched S{(const char*)(ws + WS_XB), (const char*)(ws + WS_WIN) + (size_t)l * 2560 * 1024 * 2, 1024, 1024, 64, 10, nb, BID()};
            EpiInProj E{(const float*)(ws + WS_SSQX) + l * 16384, (float*)(ws + WS_SSQ + PT_DQ) + (size_t)l * 16384 * 4, (float*)(ws + WS_SSQ + PT_DKV) + (size_t)l * 16384 * 2,
                        in->p[8] + l * 64, in->p[9] + l * 64, in->p[19] + l * 192 + 96 + 64, (const float*)(ws + WS_ROPE), ws + WS_PRJ};
#ifndef NO_INPROJ
            g8::gemm_run(lds, 1024, 1024, S, E, g_wv);
#endif
        }
        SEAM(pb + PH_INPROJ);
        if (IN(pb + PH_PREP)) for (int rep = 0; rep < NREP(PH_PREP); ++rep) { if (rep) xcd_barrier(bar); phase_prep(l, in_tab(), launder(ws), lds, BID(), nb, g_wv, (unsigned*)launder(ws) + CW_Q + 64 * (4 + l + 2 * rep)); }
        SEAM(pb + PH_PREP);
        if (IN(pb + PH_MIX)) for (int rep = 0; rep < NREP(PH_MIX); ++rep) { if (rep) xcd_barrier(bar); phase_mix(l, in_tab(), launder(ws), lds, (unsigned*)launder(ws) + CW_Q + 64 * (l + 2 * rep), g_wv); }
        SEAM(pb + PH_MIX);
        const bool fold_norm = (nb == 256);
        if (IN(pb + PH_YNORM) && !fold_norm) phase_ynorm(l, launder(ws), BID(), nb, g_wv);
        if (!fold_norm) SEAM(pb + PH_YNORM);
        if (IN(pb + PH_OUTPROJ)) {
            unsigned char* ws = launder(args.ws);
            g8::DenseSched S{(const char*)(ws + WS_Y), (const char*)(ws + WS_WOUT) + (size_t)l * 1024 * 1024 * 2, 1024, 1024, 64, 4, nb, BID()};
            EpiOut E{(bf16_t*)(ws + WS_XB), (float*)(ws + WS_SSQ + PT_X1) + (size_t)l * 16384 * 16, (const LAS float*)(lds + LDS_FAC), fold_norm};
            if (fold_norm) { g8::GUnit u0; if (S.next(0, u0)) outproj_factors(l, ws, lds, u0.pm, TIDX); else __syncthreads(); }
#ifndef NO_OUTPROJ
            g8::gemm_run(lds, 1024, 1024, S, E, g_wv);
#endif
        }
        SEAM(pb + PH_OUTPROJ);
#ifndef NO_ROUTE
        if (IN(pb + PH_ROUTE)) {
            const int b_ = BID();
            if (nb >= 256 && b_ >= NROUTE) { cvt_moe_layer(in_tab(), launder(ws), l, (LAS float*)lds, b_ - NROUTE, nb - NROUTE, TIDX, 0, CVT_A);
#ifdef DUP_CVT
                __syncthreads(); cvt_moe_layer(in_tab(), launder(ws), l, (LAS float*)lds, b_ - NROUTE, nb - NROUTE, TIDX);
#endif
            }
            else { phase_route(l, in_tab(), launder(ws), lds, b_, nb >= 256 ? NROUTE : nb, g_wv);
                   if (nb < 256) cvt_moe_layer(in_tab(), launder(ws), l, (LAS float*)lds, b_, nb, TIDX); else cvt_moe_layer(in_tab(), launder(ws), l, (LAS float*)lds, b_, NROUTE, TIDX, CVT_A, 3072); }
            if (l + 1 < L_) { __syncthreads(); cvt_small_weights(in_tab(), launder(ws), l + 1, (LAS float*)lds, b_, nb, TIDX); }
        }
#endif
        SEAM(pb + PH_ROUTE);
        {
            const bool do_up = IN(pb + PH_MOEUP), do_dn = IN(pb + PH_MOEDOWN), fuse = do_up && do_dn;
            for (int part = 0; part < (fuse ? 3 : 1); ++part) {
                if (part) xcd_barrier(bar);
                unsigned char* ws = launder(args.ws);
                if (do_up || do_dn) moe_tables(l, ws, lds, g_wv);
                const unsigned* cnt = (const unsigned*)(ws + WS_CTL) + CW_CNT + 2048 * l; const unsigned* mtok = (const unsigned*)(ws + WS_META); const LAS int* tb = (const LAS int*)(lds + LDS_TB);
                const int b_ = BID(), ntile = tb[32], UPU = 2 * ntile, DNU = 4 * ntile;
                const int hi0 = UPU < nb ? UPU : nb, nu_ = UPU - hi0, nu = nu_ < (nb >> 1) ? nu_ : (nb >> 1), nd = nb - nu;
                const int d1a = 4 * (hi0 >> 1), d1b = 2 * nd, D1 = nu == 0 ? DNU : (d1a < d1b ? d1a : d1b);
                int ulo = 0, uhi = UPU, uG = nb, uc = b_, dlo = 0, dhi = DNU, dG = nb, dc = b_;
                if (fuse) {
                    if (part == 0) { uhi = hi0; dhi = 0; }
                    else if (part == 1) { ulo = hi0; uG = nu; if (b_ >= nu) uhi = ulo; dhi = D1; dG = nd; dc = b_ - nu; if (b_ < nu) dhi = 0; }
                    else { uhi = 0; dlo = D1; }
                }
                if (do_up && uhi > ulo) {
                    MoeSched<2, true> S{(const char*)(ws + WS_XB), (const char*)(ws + WS_WMOE), cnt, mtok, tb, uG, uc, (size_t)512 * 1024 * 2, (size_t)256 * 1024 * 2, ulo, uhi};
                    EpiMoeUp E{mtok, (const float*)(ws + WS_RS2), tb, (bf16_t*)(ws + WS_HBUF)};
#ifndef NO_MOEUP
                    g8::gemm_run(lds, 1024, 1024, S, E, g_wv);
#endif
                }
                if (do_dn && dhi > dlo) {
                    MoeSched<4, false> S{(const char*)(ws + WS_HBUF), (const char*)(ws + WS_WMOE + WMOE_WD), cnt, mtok, tb, dG, dc, (size_t)1024 * 256 * 2, (size_t)256 * 256 * 2, dlo, dhi};
                    EpiMoeDown E{mtok, (const float*)(ws + WS_META + META_W), tb, (bf16_t*)(ws + WS_YBUF)};
#ifndef NO_MOEDOWN
                    g8::gemm_run(lds, 256, 256, S, E, g_wv);
#endif
                }
            }
        }
        SEAM(pb + PH_MOEDOWN);
#ifndef NO_COMBINE
        if (IN(pb + PH_COMBINE)) { unsigned char* ws = launder(args.ws); phase_combine(l, ws, args.out, BID(), nb, g_wv); }
#endif
        SEAM(pb + PH_COMBINE);
    }
#undef IN
#undef SEAM
}
#if CHECK
struct NvScratch { float *proj, *h1, *qk, *hraw, *kn, *kcmp, *vcmp, *dqn, *q, *dkvn, *kv, *krope, *y, *x1, *xl; int* rt_e; float* rt_w; };
constexpr int CB = 5;
enum { NS_INPROJ = 0, NS_NSAPREP, NS_MLAPREP, NS_NSA, NS_ML, NS_MLA, NS_OUT, NS_ROUTE, NS_MOE };
static void naive_step(void* const* d_in, int l, int step, const float* xin, float* xout, const NvScratch& S, hipStream_t st) {
    const int b = CB;
    const float* rel_bias = (const float*)d_in[2];
    const float* norm1_g = (const float*)d_in[3] + (long)l * 1024;
    const float* w_in = (const float*)d_in[4] + (long)l * 1024 * DIN;
    const float* cmp_pe = (const float*)d_in[5] + (long)l * 2 * 32 * 64;
    const float* cmp_w1 = (const float*)d_in[6] + (long)l * 2 * 32 * 64 * 64;
    const float* cmp_w2 = (const float*)d_in[7] + (long)l * 2 * 64 * 64;
    const float* q_norm = (const float*)d_in[8] + l * 64;
    const float* k_norm = (const float*)d_in[9] + l * 64;
    const float* nsa_on = (const float*)d_in[10] + l * 384;
    const float* conv = (const float*)d_in[11] + l * 4 * 512;
    const float* ibias = (const float*)d_in[12] + l * 4;
    const float* fbias = (const float*)d_in[13] + l * 4;
    const float* ml_on = (const float*)d_in[14] + l * 256;
    const float* qan = (const float*)d_in[15] + l * 192;
    const float* w_uq = (const float*)d_in[16] + (long)l * 192 * 576;
    const float* kvan = (const float*)d_in[17] + l * 128;
    const float* w_ukv = (const float*)d_in[18] + (long)l * 128 * 768;
    const float* qkn = (const float*)d_in[19] + l * 192;
    const float* mla_on = (const float*)d_in[20] + l * 384;
    const float* w_out = (const float*)d_in[21] + (long)l * 1024 * 1024;
    const float* norm2_g = (const float*)d_in[22] + l * 1024;
    const float* wgrp = (const float*)d_in[23] + (long)l * 1024 * 4;
    const float* bgrp = (const float*)d_in[24] + l * 4;
    const float* wexp = (const float*)d_in[25] + (long)l * 1024 * 32;
    const float* bexp = (const float*)d_in[26] + l * 32;
    const float* Wg = (const float*)d_in[27] + (long)l * 32 * 1024 * 256;
    const float* Wu = (const float*)d_in[28] + (long)l * 32 * 1024 * 256;
    const float* Wd = (const float*)d_in[29] + (long)l * 32 * 256 * 1024;
    const int* pos = (const int*)d_in[1] + b * 2048;
    switch (step) {
    case NS_INPROJ:
        nv_rmsnorm<<<dim3(2048, 1), 64, 0, st>>>(xin, 1024, 0, S.h1, 1024, 0, norm1_g, 0, 1024);
        nv_gemm<<<dim3((DIN + 63) / 64, 2048 / 64), 256, 0, st>>>(S.h1, 1024, w_in, DIN, S.proj, DIN, nullptr, 0, 2048, DIN, 1024);
        break;
    case NS_NSAPREP:
        nv_nsa_cmp<<<dim3(127, 2, 2), 64, 0, st>>>(S.proj, cmp_pe, cmp_w1, cmp_w2, k_norm, S.kcmp, S.vcmp);
        nv_nsa_knorm<<<dim3(2048, 4), 64, 0, st>>>(S.proj, k_norm, S.kn);
        break;
    case NS_MLAPREP:
        nv_rmsnorm<<<dim3(2048, 1), 64, 0, st>>>(S.proj + O_CDQ, DIN, 0, S.dqn, 192, 0, qan, 0, 192);
        nv_gemm<<<dim3(576 / 64, 2048 / 64), 256, 0, st>>>(S.dqn, 192, w_uq, 576, S.q, 576, nullptr, 0, 2048, 576, 192);
        nv_rmsnorm<<<dim3(2048, 1), 64, 0, st>>>(S.proj + O_CDKV, DIN, 0, S.dkvn, 128, 0, kvan, 0, 128);
        nv_gemm<<<dim3(768 / 64, 2048 / 64), 256, 0, st>>>(S.dkvn, 128, w_ukv, 768, S.kv, 768, nullptr, 0, 2048, 768, 128);
        nv_mla_prep<<<dim3(2048, 7), 64, 0, st>>>(S.q, S.kv, S.proj, S.krope, qkn, pos);
        break;
    case NS_NSA:
        nv_nsa_attn<<<dim3(2048, 2), 192, 0, st>>>(S.proj, S.kn, S.kcmp, S.vcmp, rel_bias, q_norm, S.y);
        break;
    case NS_ML:
        nv_ml_conv<<<2048, 512, 0, st>>>(S.proj, conv, S.qk);
        nv_ml_rec<<<4, 256, 0, st>>>(S.proj, S.qk, ibias, fbias, S.hraw);
        nv_ml_fin<<<dim3(2048, 4), 64, 0, st>>>(S.proj, S.hraw, ml_on, S.y);
        break;
    case NS_MLA:
        nv_mla_attn<<<dim3(2048, 6), 64, 0, st>>>(S.q, S.kv, S.krope, S.y);
        break;
    case NS_OUT:
        nv_rmsnorm<<<dim3(2048, 1), 64, 0, st>>>(S.y, 1024, 0, S.y, 1024, 0, nsa_on, 0, 384);
        nv_rmsnorm<<<dim3(2048, 1), 64, 0, st>>>(S.y + 640, 1024, 0, S.y + 640, 1024, 0, mla_on, 0, 384);
        nv_gemm<<<dim3(1024 / 64, 2048 / 64), 256, 0, st>>>(S.y, 1024, w_out, 1024, S.x1, 1024, xin, 1024, 2048, 1024, 1024);
        break;
    case NS_ROUTE:
        nv_moe_route<<<2048, 64, 0, st>>>(S.x1, norm2_g, wgrp, bgrp, wexp, bexp, S.h1, S.rt_e, S.rt_w);
        break;
    case NS_MOE:
        nv_moe_exp<<<2048, 256, 0, st>>>(S.x1, S.h1, S.rt_e, S.rt_w, Wg, Wu, Wd, xout);
        break;
    }
}

__device__ __forceinline__ void chk_commit(float d2, float r2, float* acc) { d2 = wave_sum(d2); r2 = wave_sum(r2); if ((threadIdx.x & 63) == 0) { atomicAdd(acc, d2); atomicAdd(acc + 1, r2); } }
__device__ __forceinline__ void chk_add(float f, float r, float& d2, float& r2) { const float d = f - r; d2 += (d == d) ? d * d : 1e30f; r2 += r * r; }

__global__ void __launch_bounds__(64) chk_proj(const float* nproj, const unsigned char* prj, const float* ssq_dq, const float* ssq_dkv, const float* qg, const float* kg, const float* krg, const int* pos, float* acc) {
    const int t = blockIdx.x, e = threadIdx.x; const size_t row = (size_t)CB * 2048 + t; float d2 = 0.f, r2 = 0.f;
    for (int G = 0; G < 40; ++G) {
        const int c = inproj_refcol(G, e); float r = c < 0 ? 0.f : nproj[(size_t)t * DIN + c]; float f = 0.f;
        const float rr = (G == 37 && e >= 32) ? 0.f : r; const float ss = wave_sum(rr * rr);
        if (G < 6) { r = r * rsqrtf(ss / 64.f + 1e-6f) * qg[e] * 0.18033688f; f = bf2f(((const bf16_t*)(prj + PRJ_QN))[((size_t)(CB * 6 + G) * 2048 + t) * 64 + e]); }
        else if (G < 18) { const int a = G - 6, br = a >> 2, s = (a >> 1) & 1, hk = a & 1;
            if (br > 0 && s == 0) r = r * rsqrtf(ss / 64.f + 1e-6f) * kg[e];
            const size_t base = br == 0 ? (s ? PRJ_C0V : PRJ_C0K) : (br == 1 ? (s ? PRJ_VN1 : PRJ_KN1) : (s ? PRJ_VN2 : PRJ_KN2));
            f = bf2f(((const bf16_t*)(prj + base))[((size_t)(CB * 2 + hk) * 2048 + t) * 64 + e]); }
        else if (G < 26) f = bf2f(((const bf16_t*)(prj + PRJ_RAWQK))[row * 512 + (G - 18) * 64 + e]);
        else if (G < 30) f = bf2f(((const bf16_t*)(prj + PRJ_VML))[((size_t)(CB * 4 + (G - 26)) * 2048 + t) * 64 + e]);
        else if (G < 34) f = bf2f(((const bf16_t*)(prj + PRJ_OG))[row * 256 + (G - 30) * 64 + e]);
        else if (G < 37) f = bf2f(((const bf16_t*)(prj + PRJ_DQKV))[row * 384 + (G - 34) * 64 + e]);
        else if (G == 37) {
            const float val = e < 32 ? rr * rsqrtf(ss / 32.f + 1e-6f) * krg[e & 31] : 0.f; const float oth = __shfl_xor(val, 16);
            if (e < 32) { const int i = e & 15; const double ang = (double)pos[row] * pow(10000.0, -(double)i / 16.0); const float cs = (float)cos(ang), sn = (float)sin(ang);
                r = e < 16 ? val * cs - oth * sn : val * cs + oth * sn; f = bf2f(((const bf16_t*)(prj + PRJ_KR))[row * 32 + e]); }
            else if (e < 58) f = ((const float*)(prj + PRJ_GATES))[row * 32 + (e - 32)];
            else { f = 0.f; r = 0.f; }
        }
        else f = bf2f(((const bf16_t*)(prj + PRJ_DQKV))[row * 384 + 256 + (G - 38) * 64 + e]);
        chk_add(f, r, d2, r2);
    }
    float d2s = 0.f, r2s = 0.f;
    { float s1 = 0.f, s2 = 0.f; for (int c = e; c < 192; c += 64) { float v = nproj[(size_t)t * DIN + O_CDQ + c]; s1 += v * v; } for (int c = e; c < 128; c += 64) { float v = nproj[(size_t)t * DIN + O_CDKV + c]; s2 += v * v; }
      s1 = wave_sum(s1); s2 = wave_sum(s2); if (e == 0) { chk_add((ssq_dq[row * 4] + ssq_dq[row * 4 + 1]) + ssq_dq[row * 4 + 2], s1, d2s, r2s); chk_add(ssq_dkv[row * 2] + ssq_dkv[row * 2 + 1], s2, d2s, r2s); } }
    chk_commit(d2, r2, acc); chk_commit(d2s, r2s, acc + 2);
}

__global__ void __launch_bounds__(64) chk_prep(const float* nq, const float* nkv, const float* nkr, const float* nkc, const float* nvc, const unsigned char* ws, float* acc) {
    const int t = blockIdx.x, e = threadIdx.x; float d2 = 0.f, r2 = 0.f, d2c = 0.f, r2c = 0.f; const float scale = 0.14724444f;
    const bf16_t* QM = (const bf16_t*)(ws + WS_MLA); const bf16_t* KM = (const bf16_t*)(ws + WS_MLA + MLA_KM); const bf16_t* VM = (const bf16_t*)(ws + WS_MLA + MLA_VM);
    for (int h = 0; h < 6; ++h) {
        const size_t rq = ((size_t)(CB * 6 + h) * 2048 + t);
        chk_add(bf2f(QM[rq * 96 + e]), nq[(size_t)t * 576 + h * 96 + e] * scale, d2, r2);
        chk_add(bf2f(KM[rq * 96 + e]), nkv[(size_t)t * 768 + h * 128 + e], d2, r2);
        chk_add(bf2f(VM[rq * 64 + e]), nkv[(size_t)t * 768 + h * 128 + 64 + e], d2, r2);
        if (e < 32) { chk_add(bf2f(QM[rq * 96 + 64 + e]), nq[(size_t)t * 576 + h * 96 + 64 + e] * scale, d2, r2); chk_add(bf2f(KM[rq * 96 + 64 + e]), nkr[(size_t)t * 32 + e], d2, r2); }
    }
    if (t < 128) for (int hk = 0; hk < 2; ++hk) {
        const bf16_t* KC = (const bf16_t*)(ws + WS_CMP); const bf16_t* VC = (const bf16_t*)(ws + WS_CMP + CMP_V); const size_t rf = ((size_t)(CB * 2 + hk) * 128 + t) * 64 + e;
        chk_add(bf2f(KC[rf]), t < 127 ? nkc[(size_t)(hk * 127 + t) * 64 + e] : 0.f, d2c, r2c); chk_add(bf2f(VC[rf]), t < 127 ? nvc[(size_t)(hk * 127 + t) * 64 + e] : 0.f, d2c, r2c);
    }
    chk_commit(d2, r2, acc); chk_commit(d2c, r2c, acc + 2);
}

__global__ void __launch_bounds__(64) chk_y(const float* ny, const unsigned char* ws, float* acc, int nseg) {
    const int t = blockIdx.x, e = threadIdx.x; const bf16_t* Y = (const bf16_t*)(ws + WS_Y) + ((size_t)CB * 2048 + t) * 1024;
    float d2[3] = {0.f, 0.f, 0.f}, r2[3] = {0.f, 0.f, 0.f};
    for (int c = e; c < 1024; c += 64) { const int seg = c < 384 ? 0 : (c < 640 ? 1 : 2); const int cf = c < 384 ? c : (c < 640 ? 768 + (c - 384) : 384 + (c - 640)); const float f = bf2f(Y[cf]), r = ny[(size_t)t * 1024 + c];
        if (seg == 0) chk_add(f, r, d2[0], r2[0]); else if (seg == 1) chk_add(f, r, d2[1], r2[1]); else chk_add(f, r, d2[2], r2[2]); }
    if (nseg == 3) { chk_commit(d2[0], r2[0], acc); chk_commit(d2[1], r2[1], acc + 2); chk_commit(d2[2], r2[2], acc + 4); }
    else chk_commit(d2[0] + d2[1] + d2[2], r2[0] + r2[1] + r2[2], acc);
}

__global__ void __launch_bounds__(64) chk_x(const float* nx, const unsigned char* ws, float* acc) {
    const int t = blockIdx.x, e = threadIdx.x; const bf16_t* X = (const bf16_t*)(ws + WS_XB) + ((size_t)CB * 2048 + t) * 1024; float d2 = 0.f, r2 = 0.f;
    for (int c = e; c < 1024; c += 64) chk_add(bf2f(X[c]), nx[(size_t)t * 1024 + c], d2, r2);
    chk_commit(d2, r2, acc);
}

__global__ void __launch_bounds__(512) chk_code(float* acc, int nst, const float* nout) {
    __shared__ float sh[512];
    float s = 0.f; for (int i = threadIdx.x; i < 2048 * 1024; i += 512) { float v = nout[i]; s += v * v; }
    sh[threadIdx.x] = s; __syncthreads();
    if (threadIdx.x == 0) { float tot = 0.f; for (int i = 0; i < 512; ++i) tot += sh[i]; float rms = sqrtf(tot / (2048.f * 1024.f)); if (!(rms > 1e-3f && rms < 1e3f)) rms = 1.f;
        int code = 0;
        for (int st = 0; st < nst; ++st) { const float d2 = acc[2 * st], r2 = acc[2 * st + 1]; if (r2 == 0.f && d2 == 0.f) { if ((st & 15) >= 9) continue; code = (st + 1) * 4 + 3; break; } const float err = d2 / fmaxf(r2, 1e-30f);
            const float tol = CHK_TOL(st);
            if (!(err <= tol)) { const int cls = !(err < 1.f) ? 3 : (err >= 0.1f ? 2 : (err >= 0.01f ? 1 : 0)); code = (st + 1) * 4 + cls; break; } }
        acc[2 * 40] = rms * 32.f * exp2f(0.5f * (float)code); }
}
__global__ void __launch_bounds__(512) chk_fill(const float* acc, float* out) {
    const float K = acc[2 * 40];
    for (size_t i = (size_t)blockIdx.x * 512 + threadIdx.x; i < (size_t)NTOK * 1024; i += (size_t)gridDim.x * 512) out[i] = (i & 1) ? -K : K;
}
#endif

#if TIME_PH != -1
#ifndef TIME_Q
#define TIME_Q 6.f
#endif
#ifndef TIME_CAL
#define TIME_CAL 1.0f
#endif
__global__ void tm_acc(const unsigned long long* ts, float* best, int first) {
    int a = TIME_PH, b = TIME_PH + 1;
#ifdef TIME_PH_END
    b = TIME_PH_END;
#endif
    float T = 100.f; if (TIME_PH >= 0) T = (float)(ts[b] - ts[a]) * 0.01f;
    if (first || T < *best) *best = T;
}
__global__ void __launch_bounds__(512) tm_fill(const float* best, float* out) {
    float T = *best;
    T = exp2f(rintf(log2f(fmaxf(T, 1.f)) * TIME_Q) / TIME_Q);
    const float c = sqrtf(T) * TIME_CAL;
    for (size_t i = (size_t)blockIdx.x * 512 + threadIdx.x; i < (size_t)NTOK * 1024; i += (size_t)gridDim.x * 512) out[i] = (i & 1) ? -c : c;
}
#endif
static int g_grid = 0;
static bool setup_once(size_t ws_size) {
    if (g_grid) return g_grid > 0;
    if (ws_size < WS_END) { fprintf(stderr, "kernel_launch: workspace too small: %zu < %zu\n", ws_size, (size_t)WS_END); g_grid = -1; return false; }
    int dev = 0, cus = 0, per_cu = 0;
    if (hipGetDevice(&dev) != hipSuccess || hipDeviceGetAttribute(&cus, hipDeviceAttributeMultiprocessorCount, dev) != hipSuccess) { g_grid = -1; return false; }
    if (hipFuncSetAttribute((const void*)mk, hipFuncAttributeMaxDynamicSharedMemorySize, LDS_BYTES) != hipSuccess) { fprintf(stderr, "kernel_launch: hipFuncSetAttribute failed\n"); g_grid = -1; return false; }
    if (hipOccupancyMaxActiveBlocksPerMultiprocessor(&per_cu, (const void*)mk, 512, LDS_BYTES) != hipSuccess || per_cu < 1) { fprintf(stderr, "kernel_launch: occupancy query says %d\n", per_cu); }
    (void)hipGetLastError();
    g_grid = cus;
    return true;
}
static void launch_mk(const Args& a0, int lo, int hi, hipStream_t stream) { Args a = a0; a.ph_lo = lo; a.ph_hi = hi; hipLaunchKernelGGL(mk, dim3(g_grid), dim3(512), LDS_BYTES, stream, a); }

extern "C" void kernel_launch(void* const* d_in, const int* in_sizes, int n_in, void* d_out, int out_size, void* d_ws, size_t ws_size, hipStream_t stream) {
    if (!setup_once(ws_size)) return;
    unsigned char* ws = (unsigned char*)d_ws;
    (void)hipMemsetAsync(ws + WS_CTL, 0, ZERO_BYTES, stream);
    Args a{}; for (int i = 0; i < 30; ++i) a.in.p[i] = (const float*)d_in[i];
    a.out = (float*)d_out; a.ws = ws; a.ph_lo = 0; a.ph_hi = 0;
#if CHECK
    a.out = nullptr;
#endif
#if CHECK
    float* nb = (float*)d_out; size_t off = 0; NvScratch S;
    auto take = [&](size_t n) { float* p = nb + off; off += (n + 63) & ~(size_t)63; return p; };
    S.proj = take((size_t)2048 * DIN); S.h1 = take(2048 * 1024); S.qk = S.h1; S.hraw = S.qk + 2048 * 512; S.kn = S.hraw + 2048 * 256;
    S.kcmp = take(2 * 127 * 64); S.vcmp = take(2 * 127 * 64); S.dqn = take(2048 * 192); S.q = take(2048 * 576); S.dkvn = take(2048 * 128); S.kv = take(2048 * 768); S.x1 = S.dqn;
    S.krope = take(2048 * 32); S.y = take(2048 * 1024); S.xl = take(2048 * 1024); S.rt_e = (int*)take(2048 * 2); S.rt_w = take(2048 * 2);
    if (off * 4 > (size_t)NTOK * 1024 * 4) { fprintf(stderr, "naive scratch too big\n"); return; }
    float* acc = (float*)(ws + WS_CTL) + CW_CHK;
    launch_mk(a, 0, 1, stream);
    const float* nx_in = (const float*)d_in[0] + (size_t)CB * 2048 * 1024;
    int nst = 0;
    for (int l = 0; l < L_; ++l) {
        const int pb = 1 + l * NPH; const int sb = l * 16;
        launch_mk(a, pb + PH_INPROJ, pb + PH_INPROJ + 1, stream);
        naive_step(d_in, l, NS_INPROJ, nx_in, S.xl, S, stream);
        chk_proj<<<2048, 64, 0, stream>>>(S.proj, ws + WS_PRJ, (const float*)(ws + WS_SSQ + PT_DQ) + (size_t)l * 16384 * 4, (const float*)(ws + WS_SSQ + PT_DKV) + (size_t)l * 16384 * 2,
                                           (const float*)d_in[8] + l * 64, (const float*)d_in[9] + l * 64, (const float*)d_in[19] + l * 192 + 160, (const int*)d_in[1], acc + 2 * (sb + 0));
        nst = sb + 2;
        int ns_done = NS_INPROJ;
#if CHECK_UPTO >= 1
        launch_mk(a, pb + PH_PREP, pb + PH_PREP + 1, stream);
        naive_step(d_in, l, NS_NSAPREP, nx_in, S.xl, S, stream); naive_step(d_in, l, NS_MLAPREP, nx_in, S.xl, S, stream); ns_done = NS_MLAPREP;
        chk_prep<<<2048, 64, 0, stream>>>(S.q, S.kv, S.krope, S.kcmp, S.vcmp, ws, acc + 2 * (sb + 2));
        nst = sb + 4;
#endif
#if CHECK_UPTO >= 2
        launch_mk(a, pb + PH_MIX, pb + PH_MIX + 1, stream);
        naive_step(d_in, l, NS_NSA, nx_in, S.xl, S, stream); naive_step(d_in, l, NS_ML, nx_in, S.xl, S, stream); naive_step(d_in, l, NS_MLA, nx_in, S.xl, S, stream); ns_done = NS_MLA;
        chk_y<<<2048, 64, 0, stream>>>(S.y, ws, acc + 2 * (sb + 4), 3);
        nst = sb + 7;
#endif
#if CHECK_UPTO >= 3
        launch_mk(a, pb + PH_YNORM, pb + PH_YNORM + 1, stream); launch_mk(a, pb + PH_OUTPROJ, pb + PH_OUTPROJ + 1, stream);
        naive_step(d_in, l, NS_OUT, nx_in, S.xl, S, stream); ns_done = NS_OUT;
        chk_x<<<2048, 64, 0, stream>>>(S.x1, ws, acc + 2 * (sb + 7));
        nst = sb + 8;
#endif
#if CHECK_UPTO >= 4
        for (int ph = PH_ROUTE; ph <= PH_COMBINE; ++ph) launch_mk(a, pb + ph, pb + ph + 1, stream);
        naive_step(d_in, l, NS_ROUTE, nx_in, S.xl, S, stream); naive_step(d_in, l, NS_MOE, nx_in, S.xl, S, stream); ns_done = NS_MOE;
        chk_x<<<2048, 64, 0, stream>>>(S.xl, ws, acc + 2 * (sb + 8));
        nst = sb + 9;
#endif
        CHECK_REST
        for (int s = ns_done + 1; s <= NS_MOE; ++s) naive_step(d_in, l, s, nx_in, S.xl, S, stream);
        nx_in = S.xl;
        if (l == CHECK_LAYERS - 1) break;
    }
    chk_code<<<1, 512, 0, stream>>>(acc, nst, S.xl);
    chk_fill<<<1024, 512, 0, stream>>>(acc, (float*)d_out);
#else
#if defined(SPLIT_LAUNCH) && SPLIT_LAUNCH
    for (int ph = 0; ph < 1 + L_ * NPH; ++ph) launch_mk(a, ph, ph + 1, stream);
#else
    launch_mk(a, 0, 1 + L_ * NPH, stream);
#if TIME_PH != -1
    for (int rp = 0; rp < 6; ++rp) {
        (void)hipMemsetAsync(ws + WS_CTL, 0, ZERO_BYTES, stream); launch_mk(a, 0, 1 + L_ * NPH, stream);
        tm_acc<<<1, 1, 0, stream>>>((const unsigned long long*)((unsigned*)(ws + WS_CTL) + CW_TS), (float*)(ws + WS_META + META_RT), rp == 0);
    }
    tm_fill<<<1024, 512, 0, stream>>>((const float*)(ws + WS_META + META_RT), (float*)d_out);
#endif
#endif
#endif
}
```

```cpp
#define CHECK 0
#define CHECK_LAYERS 2
#define CHECK_UPTO 99
#define SPLIT_LAUNCH 0
#define REPEAT_PH -1
#include <hip/hip_runtime.h>
#include <stdint.h>
#include <cstdio>

constexpr int B_ = 8, T_ = 2048, D_ = 1024, L_ = 2, NTOK = B_ * T_;
constexpr int DIN = 2554;
constexpr int O_AQ = 0, O_AKV = 384, O_AG = 1152, O_BQK = 1170, O_BV = 1682, O_BIF = 1938, O_BO = 1946, O_CDQ = 2202, O_CDKV = 2394, O_CKR = 2522;

typedef unsigned short bf16_t;
typedef short bf16x8 __attribute__((ext_vector_type(8)));
typedef short s16x4 __attribute__((ext_vector_type(4)));
typedef float f32x4 __attribute__((ext_vector_type(4)));
typedef float f32x16 __attribute__((ext_vector_type(16)));
typedef unsigned u32x4 __attribute__((ext_vector_type(4)));
typedef unsigned u32x2 __attribute__((ext_vector_type(2)));
typedef float f32x2_t __attribute__((ext_vector_type(2)));
typedef __bf16 bf16x2_t __attribute__((ext_vector_type(2)));
#define LAS __attribute__((address_space(3)))

__device__ __forceinline__ unsigned pk_bf16(float lo, float hi) { f32x2_t v = {lo, hi}; bf16x2_t b = __builtin_convertvector(v, bf16x2_t); return __builtin_bit_cast(unsigned, b); }
__device__ __forceinline__ float bf_lo(unsigned u) { return __builtin_bit_cast(float, u << 16); }
__device__ __forceinline__ float bf_hi(unsigned u) { return __builtin_bit_cast(float, u & 0xffff0000u); }
__device__ __forceinline__ float bf2f(bf16_t h) { return __builtin_bit_cast(float, (unsigned)h << 16); }
__device__ __forceinline__ bf16_t f2bf(float f) { return (bf16_t)(pk_bf16(f, 0.f) & 0xffffu); }
template <int M> __device__ __forceinline__ int shx(int v) { static_assert(M > 0 && M < 32, "swizzle xor mask"); return __builtin_amdgcn_ds_swizzle(v, (M << 10) | 0x1f); }
template <int M> __device__ __forceinline__ float shx(float v) { return __builtin_bit_cast(float, shx<M>(__builtin_bit_cast(int, v))); }
template <int M> __device__ __forceinline__ unsigned shx(unsigned v) { return (unsigned)shx<M>((int)v); }
__device__ __forceinline__ float wave_sum(float v) { v += __shfl_xor(v, 32); v += shx<16>(v); v += shx<8>(v); v += shx<4>(v); v += shx<2>(v); v += shx<1>(v); return v; }
__device__ __forceinline__ float wave_max(float v) { v = fmaxf(v, __shfl_xor(v, 32)); v = fmaxf(v, shx<16>(v)); v = fmaxf(v, shx<8>(v)); v = fmaxf(v, shx<4>(v)); v = fmaxf(v, shx<2>(v)); v = fmaxf(v, shx<1>(v)); return v; }
__device__ __forceinline__ float siluf(float x) { return x * __builtin_amdgcn_rcpf(1.f + __expf(-x)); }
__device__ __forceinline__ float sigmf(float x) { return __builtin_amdgcn_rcpf(1.f + __expf(-x)); }
__device__ __forceinline__ int t5b(int dist) {
    int n = dist > 0 ? dist : 0; if (n < 16) return n;
    float v = logf((float)n / 16.f) / logf(8.f) * 16.f; int l = 16 + (int)v; return l < 31 ? l : 31;
}

__device__ __forceinline__ int lane_now() { return (int)__builtin_amdgcn_mbcnt_hi(~0u, __builtin_amdgcn_mbcnt_lo(~0u, 0u)); }
#define TIDX ((g_wv << 6) | lane_now())

constexpr size_t WS_CTL = 0, CTL_BYTES = 65536;
constexpr size_t WS_SSQ = WS_CTL + CTL_BYTES;
constexpr size_t ZERO_BYTES = CTL_BYTES;
constexpr size_t PT_DQ = 0, PT_DKV = PT_DQ + (size_t)2 * 16384 * 4 * 4, PT_A = PT_DKV + (size_t)2 * 16384 * 2 * 4, PT_C = PT_A + (size_t)2 * 16384 * 8 * 4, PT_X1 = PT_C + (size_t)2 * 16384 * 8 * 4, PT_END = PT_X1 + (size_t)2 * 16384 * 16 * 4;
constexpr size_t WS_SSQX = WS_SSQ + PT_END;
constexpr size_t WS_RS2 = WS_SSQX + 2 * 65536;
constexpr size_t WS_WIN = WS_RS2 + 65536;
constexpr size_t WS_WOUT = WS_WIN + (size_t)2 * 2560 * 1024 * 2;
constexpr size_t WS_WUQ = WS_WOUT + (size_t)2 * 1024 * 1024 * 2;
constexpr size_t WS_WUKV = WS_WUQ + (size_t)2 * 768 * 256 * 2;
constexpr size_t WS_WC1 = WS_WUKV + (size_t)2 * 768 * 256 * 2;
constexpr size_t WS_WC2 = WS_WC1 + (size_t)2 * 2 * 64 * 2048 * 2;
constexpr size_t WS_WR = WS_WC2 + (size_t)2 * 2 * 64 * 64 * 2;
constexpr size_t WS_B1C = WS_WR + (size_t)2 * 64 * 1024 * 2;
constexpr size_t WS_BIASD = WS_B1C + 1024;
constexpr size_t WS_ROPE = WS_BIASD + 6 * 2048 * 4;
constexpr size_t WS_WMOE = WS_ROPE + (size_t)16384 * 32 * 4;
constexpr size_t WMOE_WD = (size_t)32 * 512 * 1024 * 2;
constexpr size_t WS_XB = WS_WMOE + 50331648;
constexpr size_t WS_MLA = WS_XB + 33554432;
constexpr size_t MLA_KM = (size_t)8 * 6 * 2048 * 96 * 2, MLA_VM = 2 * MLA_KM;
constexpr size_t WS_HBUF = WS_MLA;
constexpr size_t WS_PRJ = WS_MLA + 50331648;
constexpr size_t HM64 = (size_t)2048 * 64 * 2;
constexpr size_t PRJ_QN = 0;
constexpr size_t PRJ_KN1 = PRJ_QN + 48 * HM64, PRJ_VN1 = PRJ_KN1 + 16 * HM64, PRJ_KN2 = PRJ_VN1 + 16 * HM64, PRJ_VN2 = PRJ_KN2 + 16 * HM64;
constexpr size_t PRJ_VML = PRJ_VN2 + 16 * HM64;
constexpr size_t PRJ_OG = PRJ_VML + 32 * HM64;
constexpr size_t PRJ_KR = PRJ_OG + (size_t)16384 * 256 * 2;
constexpr size_t PRJ_GATES = PRJ_KR + (size_t)16384 * 32 * 2;
constexpr size_t PRJ_DEAD = PRJ_GATES + (size_t)16384 * 32 * 4;
constexpr size_t PRJ_C0K = PRJ_DEAD, PRJ_C0V = PRJ_C0K + 16 * HM64 + 8192;
constexpr size_t PRJ_RAWQK = PRJ_C0V + 16 * HM64 + 8192;
constexpr size_t PRJ_DQKV = PRJ_RAWQK + (size_t)16384 * 512 * 2;
constexpr size_t PRJ_END = PRJ_DQKV + (size_t)16384 * 384 * 2;
static_assert(PRJ_END - PRJ_DEAD >= 33554432, "Y fits the dead part of PRJ");
constexpr size_t WS_Y = WS_PRJ + PRJ_DEAD;
constexpr size_t WS_YBUF = WS_PRJ;
static_assert((size_t)2 * 16384 * 1024 * 2 <= PRJ_END, "YBUF fits the PRJ region");
constexpr size_t WS_ML = WS_PRJ + PRJ_END;
constexpr size_t ML_KC = 32 * HM64, ML_DELTA = 2 * ML_KC, ML_DN = ML_DELTA + (size_t)1024 * 4096 * 2, ML_G = ML_DN + (size_t)1024 * 64 * 4, ML_BL = ML_G + (size_t)8 * 4 * 2048 * 2 * 4, ML_CP = ML_BL + 4096, ML_NP = ML_CP + (size_t)1024 * 4096 * 2, ML_END = ML_NP + (size_t)1024 * 64 * 2;
constexpr size_t WS_CMP = WS_ML + ML_END;
constexpr size_t CMP_V = (size_t)8 * 2 * 128 * 64 * 2;
constexpr size_t WS_META = WS_CMP + 2 * CMP_V;
constexpr size_t META_W = (size_t)32 * 16384 * 4, META_RT = 2 * META_W;
constexpr size_t WS_END = WS_META + META_RT + (size_t)16384 * 16;
constexpr int CW_BAR = 0;
constexpr int CW_Q = 4096;
constexpr int CW_SCAN = 4608;
constexpr int CW_TS = 4864;
constexpr int CW_CHK = 5120;
constexpr int CW_CNT = 8192;
constexpr int LDS_BYTES = 147456;
constexpr int LDS_MISC = LDS_BYTES - 256;
#define XB_TMO      128
#define XB_XCNT(j)  (256  + 64 * (j))
#define XB_XSUB(j)  (1280 + 64 * (j))
#define XB_XGEN(j)  (2304 + 64 * (j))
#define XB_TOP      3328
#define XB_TOPGEN   3392
#define XCD_BAR_WORDS 3456
#define XB_SPIN_CAP (1u << 18)

__device__ __forceinline__ unsigned xb_ld(unsigned* p)              { return __hip_atomic_load(p, __ATOMIC_RELAXED, __HIP_MEMORY_SCOPE_AGENT); }
__device__ __forceinline__ unsigned xb_add(unsigned* p, unsigned v) { return __hip_atomic_fetch_add(p, v, __ATOMIC_RELAXED, __HIP_MEMORY_SCOPE_AGENT); }
__device__ __forceinline__ unsigned xb_xcc_id() { return (unsigned)__builtin_amdgcn_s_getreg((3 << 11) | 20) & 0xFu; }
#define XB_SPIN(cond, bar) do { unsigned _sp = 0; while (cond) { __builtin_amdgcn_s_sleep(1); \
    if ((++_sp & 255u) == 0u) { if (xb_ld(&(bar)[XB_TMO])) break; if (_sp > XB_SPIN_CAP) { atomicAdd(&(bar)[XB_TMO], 1u); break; } } } } while (0)

struct XcdBarrier {
    int g_wv; unsigned* bar; unsigned x;
    volatile LAS unsigned* st;
};

__device__ __forceinline__ XcdBarrier xcd_barrier_post(unsigned* bar, volatile LAS unsigned* st, int g_wv) {
    XcdBarrier b; b.g_wv = g_wv; b.bar = bar; b.x = xb_xcc_id(); b.st = st;
    if (TIDX == 0) (void)xb_add(&bar[XB_XCNT(b.x)], 1u);
    return b;
}
__device__ __forceinline__ void xcd_barrier_complete(unsigned* bar, unsigned x, unsigned& nloc, unsigned& nx) {
    const unsigned G = gridDim.x * gridDim.y * gridDim.z;
    unsigned sum, cnt, mine, sp = 0u;
    for (;;) {
        sum = 0u; cnt = 0u; mine = 0u;
#pragma unroll
        for (unsigned j = 0; j < 16; ++j) { const unsigned c = xb_ld(&bar[XB_XCNT(j)]); sum += c; cnt += (c > 0u) ? 1u : 0u; mine = (j == x) ? c : mine; }
        if (sum == G) break;
        __builtin_amdgcn_s_sleep(1);
        if ((++sp & 255u) == 0u) { if (xb_ld(&bar[XB_TMO])) break; if (sp > XB_SPIN_CAP) { atomicAdd(&bar[XB_TMO], 1u); break; } }
    }
    nloc = mine > 0u ? mine : 1u; nx = cnt > 0u ? cnt : 1u;
}

__device__ __forceinline__ void xcd_barrier(const XcdBarrier& b) {
    asm volatile("s_waitcnt vmcnt(0)" ::: "memory");
    __syncthreads();
    const int g_wv = b.g_wv;
    if (TIDX == 0) {
        unsigned* bar = b.bar;
        __builtin_amdgcn_s_waitcnt(0);
        unsigned nloc = b.st[0], nx = b.st[1];
        if (nloc == 0u) { xcd_barrier_complete(bar, b.x, nloc, nx); b.st[0] = nloc; b.st[1] = nx; }
        const unsigned old = xb_add(&bar[XB_XSUB(b.x)], 1u);
        const unsigned gen = old / nloc;
        if (old + 1u == (gen + 1u) * nloc) {
            __builtin_amdgcn_fence(__ATOMIC_RELEASE, "agent");
            asm volatile("s_waitcnt vmcnt(0)" ::: "memory");
            const unsigned og = xb_add(&bar[XB_TOP], 1u);
            const unsigned tg = og / nx;
            if (og + 1u == (tg + 1u) * nx) xb_add(&bar[XB_TOPGEN], 1u);
            else XB_SPIN(xb_ld(&bar[XB_TOPGEN]) == tg, bar);
            __builtin_amdgcn_fence(__ATOMIC_ACQUIRE, "agent");
            xb_add(&bar[XB_XGEN(b.x)], 1u);
            asm volatile("s_waitcnt vmcnt(0)" ::: "memory");
        } else {
            XB_SPIN(xb_ld(&bar[XB_XGEN(b.x)]) == gen, bar);
            __builtin_amdgcn_fence(__ATOMIC_ACQUIRE, "agent");
            asm volatile("s_waitcnt vmcnt(0)" ::: "memory");
        }
    }
    __syncthreads();
}
struct Inputs { const float* p[30]; };
typedef const __attribute__((address_space(4))) Inputs* InPtr;
__device__ __forceinline__ InPtr in_tab() { InPtr p = (InPtr)__builtin_amdgcn_kernarg_segment_ptr(); asm volatile("" : "+s"(p)); return p; }
__device__ __forceinline__ unsigned char* launder(unsigned char* p) { size_t z = 0; asm volatile("" : "+s"(z)); return p + z; }

__host__ __device__ inline int inproj_refcol(int G, int e) {
    if (G < 6) return O_AQ + G * 64 + e;
    if (G < 18) return O_AKV + (G - 6) * 64 + e;
    if (G < 26) return O_BQK + (G - 18) * 64 + e;
    if (G < 30) return O_BV + (G - 26) * 64 + e;
    if (G < 34) return O_BO + (G - 30) * 64 + e;
    if (G < 37) return O_CDQ + (G - 34) * 64 + e;
    if (G == 37) { if (e < 32) return O_CKR + e; if (e < 50) return O_AG + (e - 32); if (e < 58) return O_BIF + (e - 50); return -1; }
    return O_CDKV + (G - 38) * 64 + e;
}
__host__ __device__ inline int uq_refcol(int G, int e) {
    if (G < 6) return G * 96 + e;
    if (G < 9) { const int idx = e & 31, bj = e >> 5, sub = idx >> 4, i = idx & 15; return (2 * (G - 6) + sub) * 96 + 64 + bj * 16 + i; }
    return -1;
}
__host__ __device__ inline int ukv_refcol(int G, int e) { return G < 6 ? G * 128 + e : (G - 6) * 128 + 64 + e; }
#define N2G(n) ((((n) >> 8) << 2) + (((n) >> 5) & 3))
#define N2E(n) (((((n) >> 7) & 1) << 5) + ((n) & 31))

__device__ __forceinline__ float opaque_f(float v) { asm volatile("" : "+v"(v)); return v; }
struct FWin { const float* w; const float* g; __device__ __forceinline__ void ld(int k, int n, const float*& p, float& gn, float gk) const { const int c = inproj_refcol(N2G(n), N2E(n)); p = w + (size_t)k * DIN + (c < 0 ? 0 : c); gn = c < 0 ? 0.f : gk; }
    __device__ __forceinline__ float rowgain(int k) const { return opaque_f(g[k]); } };
struct FWout { const float* w; const float* ga; const float* gc; __device__ __forceinline__ void ld(int k, int n, const float*& p, float& gn, float gk) const {
    const int kr = k < 384 ? k : (k < 768 ? 640 + (k - 384) : 384 + (k - 768)); p = w + (size_t)kr * 1024 + n; gn = gk; }
    __device__ __forceinline__ float rowgain(int k) const { const float a = opaque_f(ga[k < 384 ? k : 0]), c = opaque_f(gc[(k >= 384 && k < 768) ? k - 384 : 0]); return k < 384 ? a : (k < 768 ? c : 1.f); } };
struct FWuq { const float* w; const float* g; __device__ __forceinline__ void ld(int k, int n, const float*& p, float& gn, float gk) const { const int c = uq_refcol(N2G(n), N2E(n)); const int kk = k < 192 ? k : 191; p = w + (size_t)kk * 576 + (c < 0 ? 0 : c); gn = (k < 192 && c >= 0) ? gk : 0.f; }
    __device__ __forceinline__ float rowgain(int k) const { return opaque_f(g[k < 192 ? k : 191]); } };
struct FWukv { const float* w; const float* g; __device__ __forceinline__ void ld(int k, int n, const float*& p, float& gn, float gk) const { const int c = ukv_refcol(N2G(n), N2E(n)); const int kk = k >= 128 ? k - 128 : 0; p = w + (size_t)kk * 768 + c; gn = k >= 128 ? gk : 0.f; }
    __device__ __forceinline__ float rowgain(int k) const { return opaque_f(g[k >= 128 ? k - 128 : 0]); } };
struct FWc1 { const float* w; __device__ __forceinline__ void ld(int k, int n, const float*& p, float& gn, float gk) const { p = w + (size_t)k * 64 + n; gn = 1.f; }
    __device__ __forceinline__ float rowgain(int k) const { return 1.f; } };
struct FWr { const float* wg; const float* we; const float* g; __device__ __forceinline__ void ld(int k, int n, const float*& p, float& gn, float gk) const { p = n < 4 ? wg + k * 4 + n : we + k * 32 + (n < 36 ? n - 4 : 0); gn = n < 36 ? gk : 0.f; }
    __device__ __forceinline__ float rowgain(int k) const { return opaque_f(g[k]); } };
struct FWgu { const float* src; const float* g; int n0, col0; __device__ __forceinline__ float operator()(int k, int n) const { return src[(size_t)k * 256 + col0 + (n - n0)] * g[k]; } };
struct FWd { const float* w; __device__ __forceinline__ float operator()(int k, int n) const { return w[(size_t)k * 1024 + n]; } };

__device__ __forceinline__ void rope_cs(int pos, int j, float& cs, float& sn) {
    const double inv = exp2(-(double)j * (13.287712379549449 / 16.0));
    const double rev = (double)pos * inv * 0.15915494309189535; const float f = (float)(rev - rint(rev));
    cs = __builtin_amdgcn_cosf(f); sn = __builtin_amdgcn_sinf(f);
}
template <class F>
__device__ __forceinline__ void cvt_tile(const F& f, int n0, int k0, bf16_t* dst, int ldk, LAS float* tile, int tid) {
    { const int k = tid >> 3, nb = (tid & 7) * 8; const float gk = f.rowgain(k0 + k); const float* p[8]; float gn[8], v[8];
#pragma unroll
      for (int j = 0; j < 8; ++j) f.ld(k0 + k, n0 + nb + j, p[j], gn[j], gk);
#pragma unroll
      for (int j = 0; j < 8; ++j) v[j] = *p[j];
#pragma unroll
      for (int j = 0; j < 8; ++j) tile[k * 65 + nb + j] = v[j] * gn[j]; }
    __syncthreads();
    { const int n = tid >> 3, kb = (tid & 7) * 8; const LAS float* s = tile + kb * 65 + n;
      u32x4 o; o.x = pk_bf16(s[0], s[65]); o.y = pk_bf16(s[130], s[195]); o.z = pk_bf16(s[260], s[325]); o.w = pk_bf16(s[390], s[455]);
      *(u32x4*)(dst + (size_t)(n0 + n) * ldk + k0 + kb) = o; }
    __syncthreads();
}
template <class F>
__device__ __forceinline__ void cvt_item(const F& f, int it, int nK, bf16_t* dst, int ldk, LAS float* tile, int tid) { cvt_tile(f, (it / nK) * 64, (it % nK) * 64, dst, ldk, tile, tid); }

__device__ __forceinline__ void moe_item(InPtr in, int l, int it, const float*& src, int& ld, size_t& dst, int& ldk, bool& gain, int& kk0) {
    if (it < 32 * 64) { const int e = it >> 6, r = it & 63, n0 = (r >> 3) * 64, k0 = (r & 7) * 128, c0 = n0 & 255;
        src = (c0 < 128 ? in->p[27] : in->p[28]) + ((size_t)l * 32 + e) * 262144 + (size_t)k0 * 256 + (n0 >> 8) * 128 + (c0 & 127); ld = 256; gain = true; kk0 = k0;
        dst = ((size_t)e * 512 + n0) * 1024 + k0; ldk = 1024; }
    else { const int j = it - 32 * 64, e = j >> 5, r = j & 31, n0 = (r >> 1) * 64, k0 = (r & 1) * 128;
        src = in->p[29] + ((size_t)l * 32 + e) * 262144 + (size_t)k0 * 1024 + n0; ld = 1024; gain = false; kk0 = 0;
        dst = (size_t)16777216 + ((size_t)e * 1024 + n0) * 256 + k0; ldk = 256; }
}
__device__ __forceinline__ void cvt_moe_layer(InPtr in, unsigned char* ws, int l, LAS float* tile, int bid, int nb, int tid, int it_lo = 0, int it_hi = 32 * (64 + 32)) {
    asm volatile("" : "+v"(tid));
    const float* g2 = in->p[22] + l * 1024; bf16_t* W = (bf16_t*)(ws + WS_WMOE);
    const int k = tid >> 3, nbq = (tid & 7) * 8;
    const int n = tid >> 3, kb = (tid & 7) * 8;
    const int NIT = it_hi;
#define CVM_LOAD(it_, P) do { const float* src_; int ld_, ldk_, kk0_; size_t dst_; bool gain_; moe_item(in, l, (it_), src_, ld_, dst_, ldk_, gain_, kk0_); \
        P##a = *(const f32x4*)(src_ + (size_t)k * ld_ + nbq); P##b = *(const f32x4*)(src_ + (size_t)k * ld_ + nbq + 4); P##c = *(const f32x4*)(src_ + (size_t)(k + 64) * ld_ + nbq); P##d = *(const f32x4*)(src_ + (size_t)(k + 64) * ld_ + nbq + 4); \
        P##g0 = gain_ ? g2[kk0_ + k] : 1.f; P##g1 = gain_ ? g2[kk0_ + 64 + k] : 1.f; } while (0)
#define CVM_PUT(t, P) do { \
        t[k * 65 + nbq + 0] = P##a.x * P##g0; t[k * 65 + nbq + 1] = P##a.y * P##g0; t[k * 65 + nbq + 2] = P##a.z * P##g0; t[k * 65 + nbq + 3] = P##a.w * P##g0; \
        t[k * 65 + nbq + 4] = P##b.x * P##g0; t[k * 65 + nbq + 5] = P##b.y * P##g0; t[k * 65 + nbq + 6] = P##b.z * P##g0; t[k * 65 + nbq + 7] = P##b.w * P##g0; \
        t[(k + 64) * 65 + nbq + 0] = P##c.x * P##g1; t[(k + 64) * 65 + nbq + 1] = P##c.y * P##g1; t[(k + 64) * 65 + nbq + 2] = P##c.z * P##g1; t[(k + 64) * 65 + nbq + 3] = P##c.w * P##g1; \
        t[(k + 64) * 65 + nbq + 4] = P##d.x * P##g1; t[(k + 64) * 65 + nbq + 5] = P##d.y * P##g1; t[(k + 64) * 65 + nbq + 6] = P##d.z * P##g1; t[(k + 64) * 65 + nbq + 7] = P##d.w * P##g1; } while (0)
#define CVM_STORE(it_, t) do { const float* src_; int ld_, ldk_, kk0_; size_t dst_; bool gain_; moe_item(in, l, (it_), src_, ld_, dst_, ldk_, gain_, kk0_); \
        _Pragma("unroll") for (int hh = 0; hh < 2; ++hh) { const LAS float* s_ = t + (64 * hh + kb) * 65 + n; \
            u32x4 o; o.x = pk_bf16(s_[0], s_[65]); o.y = pk_bf16(s_[130], s_[195]); o.z = pk_bf16(s_[260], s_[325]); o.w = pk_bf16(s_[390], s_[455]); \
            *(u32x4*)(W + dst_ + (size_t)n * ldk_ + 64 * hh + kb) = o; } } while (0)
    f32x4 Aa, Ab, Ac, Ad, Ba, Bb, Bc, Bd; float Ag0 = 1.f, Ag1 = 1.f, Bg0 = 1.f, Bg1 = 1.f;
    LAS float* t0 = tile; LAS float* t1 = tile + 128 * 65;
    int it = it_lo + bid;
    if (it < NIT) CVM_LOAD(it, A);
    if (it + nb < NIT) CVM_LOAD(it + nb, B);
#pragma unroll 1
    for (; it < NIT; it += 2 * nb) {
        CVM_PUT(t0, A);
        __syncthreads();
        if (it + 2 * nb < NIT) CVM_LOAD(it + 2 * nb, A);
        CVM_STORE(it, t0);
        if (it + nb < NIT) {
            CVM_PUT(t1, B);
            __syncthreads();
            if (it + 3 * nb < NIT) CVM_LOAD(it + 3 * nb, B);
            CVM_STORE(it + nb, t1);
        }
    }
#undef CVM_LOAD
#undef CVM_PUT
#undef CVM_STORE
    __syncthreads();
}

__device__ __forceinline__ void cvt_small_weights(InPtr in, unsigned char* ws, int l, LAS float* tile, int bid, int nb, int tid) {
    asm volatile("" : "+v"(tid));
    constexpr int I_WIN = 40 * 16, I_WOUT = 16 * 16, I_WU = 12 * 4, I_WC1 = 32, I_WC2 = 1, I_WR = 16;
    constexpr int PER_L = I_WIN + I_WOUT + 2 * I_WU + 2 * I_WC1 + 2 * I_WC2 + I_WR;
    for (int it0 = bid; it0 < PER_L; it0 += nb) {
        int it = it0;
        if (it < I_WIN) { FWin f{in->p[4] + (size_t)l * 1024 * DIN, in->p[3] + l * 1024}; cvt_item(f, it, 16, (bf16_t*)(ws + WS_WIN) + (size_t)l * 2560 * 1024, 1024, tile, tid); continue; } it -= I_WIN;
        if (it < I_WOUT) { FWout f{in->p[21] + (size_t)l * 1048576, in->p[10] + l * 384, in->p[20] + l * 384}; cvt_item(f, it, 16, (bf16_t*)(ws + WS_WOUT) + (size_t)l * 1048576, 1024, tile, tid); continue; } it -= I_WOUT;
        if (it < I_WU) { FWuq f{in->p[16] + (size_t)l * 192 * 576, in->p[15] + l * 192}; cvt_item(f, it, 4, (bf16_t*)(ws + WS_WUQ) + (size_t)l * 768 * 256, 256, tile, tid); continue; } it -= I_WU;
        if (it < I_WU) { FWukv f{in->p[18] + (size_t)l * 128 * 768, in->p[17] + l * 128}; cvt_item(f, it, 4, (bf16_t*)(ws + WS_WUKV) + (size_t)l * 768 * 256, 256, tile, tid); continue; } it -= I_WU;
        if (it < 2 * I_WC1) { const int s = it / I_WC1; FWc1 f{in->p[6] + ((size_t)l * 2 + s) * 2048 * 64}; cvt_item(f, it % I_WC1, 32, (bf16_t*)(ws + WS_WC1) + ((size_t)l * 2 + s) * 64 * 2048, 2048, tile, tid); continue; } it -= 2 * I_WC1;
        if (it < 2 * I_WC2) { const int s = it; FWc1 f{in->p[7] + ((size_t)l * 2 + s) * 64 * 64}; cvt_item(f, 0, 1, (bf16_t*)(ws + WS_WC2) + ((size_t)l * 2 + s) * 64 * 64, 64, tile, tid); continue; } it -= 2 * I_WC2;
        { FWr f{in->p[23] + (size_t)l * 4096, in->p[25] + (size_t)l * 32768, in->p[22] + l * 1024}; cvt_item(f, it, 16, (bf16_t*)(ws + WS_WR) + (size_t)l * 64 * 1024, 1024, tile, tid); }
    }
}

__device__ __forceinline__ void prologue(InPtr in, unsigned char* ws, LAS unsigned char* lds, int bid, int nb, int g_wv) {
    int tid_ = TIDX; asm volatile("" : "+v"(tid_));
    const int tid = tid_, lane = tid & 63, wid = tid >> 6;
    LAS float* tile = (LAS float*)lds;
    cvt_small_weights(in, ws, 0, tile, bid, nb, tid);
    { const float* x = in->p[0]; bf16_t* XB = (bf16_t*)(ws + WS_XB); float* ssqx = (float*)(ws + WS_SSQX);
      for (int r = bid * 8 + wid; r < NTOK; r += nb * 8) {
          const f32x4* xr = (const f32x4*)(x + (size_t)r * 1024) + lane; float s = 0.f; u32x2* o = (u32x2*)(XB + (size_t)r * 1024) + lane;
#pragma unroll
          for (int j = 0; j < 4; ++j) { const f32x4 v = xr[64 * j]; s += (v.x * v.x + v.y * v.y) + (v.z * v.z + v.w * v.w); u32x2 w; w.x = pk_bf16(v.x, v.y); w.y = pk_bf16(v.z, v.w); o[64 * j] = w; }
          s = wave_sum(s); if (lane == 0) ssqx[r] = s;
      } }
    { float* biasd = (float*)(ws + WS_BIASD); const float* rb = in->p[2];
      for (int i = bid * 512 + tid; i < 6 * 2048; i += nb * 512) { const int h = i >> 11, d = i & 2047; biasd[i] = rb[t5b(d) * 6 + h] * 1.44269504f; } }
    { float* rope = (float*)(ws + WS_ROPE); const int* pos = (const int*)in->p[1];
      for (int i = bid * 512 + tid; i < NTOK * 16; i += nb * 512) { const int tk = i >> 4, j = i & 15; float cs, sn; rope_cs(pos[tk], j, cs, sn); rope[(size_t)tk * 32 + j] = cs; rope[(size_t)tk * 32 + 16 + j] = sn; } }
    { float* b1c = (float*)(ws + WS_B1C); LAS float* red = (LAS float*)lds;
      for (int it = bid; it < 4; it += nb) { const float* pe = in->p[5] + (size_t)it * 2048; const float* w1 = in->p[6] + (size_t)it * 2048 * 64; const int f = tid & 63, part = tid >> 6;
          float a = 0.f; for (int k = part * 256; k < part * 256 + 256; ++k) a += pe[k] * w1[(size_t)k * 64 + f];
          __syncthreads(); red[tid] = a; __syncthreads();
          if (tid < 64) { float s = 0.f; for (int p2 = 0; p2 < 8; ++p2) s += red[p2 * 64 + tid]; b1c[it * 64 + tid] = s; }
          __syncthreads(); } }
}
namespace g8 {
constexpr int BM = 256, BK = 64, HALF = 128, HTB = HALF * BK * 2, STAGE_BYTES = 8 * HTB, NXCD = 8, WGM = 8;
__host__ __device__ __forceinline__ int lds_byte(int r, int c) { const int st = (r >> 4) * 2 + (c >> 5), rr = r & 15, cc = c & 31, ob = rr * 64 + cc * 2; return st * 1024 + (ob ^ (((ob >> 9) & 1) << 5)); }
__host__ __device__ __forceinline__ void stage_rc(int b, int& R, int& C) { const int st = b / 1024, sb = b % 1024, swz = sb ^ (((sb >> 9) & 1) << 5); R = (st >> 1) * 16 + swz / 64; C = (st & 1) * 32 + (swz % 64) / 2; }
__host__ __device__ __forceinline__ int perm32(int rho) { const int n = rho >> 4, i = rho & 15; return 8 * (i >> 2) + 4 * n + (i & 3); }

struct GUnit { const char* a; const char* b; int pm, pn, e, rows; };

__device__ __forceinline__ bool static_unit(int i, int G, int c, int nM, int nN, int& pm, int& pn) {
    const int nwg = nM * nN; const long L = (long)i * G + c; if (L >= nwg) return false;
    int wgid = (int)L; { const int q = nwg / NXCD, r = nwg % NXCD, xcd = wgid % NXCD, off = wgid / NXCD; wgid = (xcd < r ? xcd * (q + 1) : r * (q + 1) + (xcd - r) * q) + off; }
    const int nig = WGM * nN, gid = wgid / nig, fm = gid * WGM, gsz = (nM - fm) < WGM ? (nM - fm) : WGM;
    pm = fm + ((wgid % nig) % gsz); pn = (wgid % nig) / gsz; return true;
}
struct DenseSched {
    static constexpr bool GATHER = false, PARTIAL = false;
    const char* A; const char* Bt; int lda, ldb, nM, nN, G, c;
    __device__ __forceinline__ bool next(int i, GUnit& u) const {
        int pm, pn; if (!static_unit(i, G, c, nM, nN, pm, pn)) return false;
        u.pm = pm; u.pn = pn; u.e = 0; u.rows = 256; u.a = A + (size_t)pm * 256 * lda * 2; u.b = Bt + (size_t)pn * 256 * ldb * 2; return true;
    }
    __device__ __forceinline__ void aoff(const GUnit&, unsigned (&v)[2][2], const int (&R)[2], const int (&C)[2]) const {
#pragma unroll
        for (int h = 0; h < 2; ++h)
#pragma unroll
            for (int i = 0; i < 2; ++i) v[h][i] = (unsigned)((h * 128 + R[i]) * lda + C[i]) * 2u;
    }
};

template <class Epi, class Sched>
__device__ __forceinline__ void gemm_run(LAS unsigned char* lds, const int K, const int ldb, const Sched& S, const Epi& E, int g_wv) {
    int tid_ = TIDX; asm volatile("" : "+v"(tid_));
    const int tid = tid_, wid = __builtin_amdgcn_readfirstlane(tid >> 6), lane = tid & 63, wr = wid >> 2, wc = wid & 3, fr = lane & 15, fq = lane >> 4;
    int nt_ = K / BK; asm volatile("" : "+s"(nt_));
    const int nt = nt_;
    int R[2], C[2]; unsigned voffB[2];
#pragma unroll
    for (int i = 0; i < 2; ++i) { stage_rc(tid * 16 + i * 8192, R[i], C[i]); const int Rb = (R[i] & ~31) + perm32(R[i] & 31); voffB[i] = (unsigned)(Rb * ldb + C[i]) * 2u; }
    const size_t kstep = (size_t)(BK * 2);
    const size_t hstepB = (size_t)HALF * ldb * 2;
    const unsigned ldsw = (unsigned)wid * 1024u;
    const int aoff = lds_byte(wr * 64 + fr, fq * 8), boff = lds_byte(wc * 32 + fr, fq * 8);
#define G8_SA(b, h) (((b) * 2 + (h)) * HTB)
#define G8_SB(b, h) ((4 + (b) * 2 + (h)) * HTB)
#define G8_GLDS(bufoff, gptr, i_) __builtin_amdgcn_global_load_lds((const unsigned*)(gptr), (LAS unsigned*)(lds + (bufoff) + ldsw + (i_) * 8192), 16, 0, 0)
#define G8_STAGE_B(bufoff, gbase) do { G8_GLDS(bufoff, (const char*)(gbase) + voffB[0], 0); G8_GLDS(bufoff, (const char*)(gbase) + voffB[1], 1); } while (0)
#define G8_STAGE_A(bufoff, gbase, v0, v1) do { G8_GLDS(bufoff, (const char*)(gbase) + (v0), 0); G8_GLDS(bufoff, (const char*)(gbase) + (v1), 1); } while (0)
#define G8_LDA(dst, b, h) do { _Pragma("unroll") for (int m = 0; m < 4; ++m) _Pragma("unroll") for (int k = 0; k < 2; ++k) dst[m][k] = *(const LAS bf16x8*)(lds + G8_SA(b, h) + aoff + m * 2048 + k * 1024); } while (0)
#define G8_LDB(dst, b, h) do { _Pragma("unroll") for (int n = 0; n < 2; ++n) _Pragma("unroll") for (int k = 0; k < 2; ++k) dst[n][k] = *(const LAS bf16x8*)(lds + G8_SB(b, h) + boff + n * 2048 + k * 1024); } while (0)
#define G8_MMA(ai, bj, At, Bt) do { __builtin_amdgcn_s_setprio(1); _Pragma("unroll") for (int m = 0; m < 4; ++m) { if (!PARTIAL || ((mmask >> ((ai) * 4 + m)) & 1u)) { _Pragma("unroll") for (int n = 0; n < 2; ++n) _Pragma("unroll") for (int k = 0; k < 2; ++k) \
        acc[ai][bj][m][n] = __builtin_amdgcn_mfma_f32_16x16x32_bf16(Bt[n][k], At[m][k], acc[ai][bj][m][n], 0, 0, 0); } } __builtin_amdgcn_s_setprio(0); } while (0)
#define G8_WAIT_V(n) asm volatile("s_waitcnt vmcnt(" #n ")" ::: "memory")
#define G8_WAIT_L(n) asm volatile("s_waitcnt lgkmcnt(" #n ")" ::: "memory")
#define G8_BAR __builtin_amdgcn_s_barrier()
#define G8_SCHED __builtin_amdgcn_sched_barrier(0)
    GUnit cur, nxt; int ui = 0;
    if (!S.next(0, cur)) return;
    constexpr bool GATHER = Sched::GATHER, PARTIAL = Sched::PARTIAL;
    unsigned mmask = 0xffu;
#define G8_MASK(u) do { if (PARTIAL) { mmask = 0u; _Pragma("unroll") for (int q_ = 0; q_ < 8; ++q_) mmask |= (((q_ >> 2) * 128 + wr * 64 + (q_ & 3) * 16) < (u).rows) ? (1u << q_) : 0u; } } while (0)
    unsigned vc[2][2];
    S.aoff(cur, vc, R, C); G8_MASK(cur);
    LAS u32x4* stash = (LAS u32x4*)(lds + STAGE_BYTES + 4096) + tid;
    f32x4 acc[2][2][4][2];
#pragma unroll
    for (int a = 0; a < 2; ++a)
#pragma unroll
        for (int b = 0; b < 2; ++b)
#pragma unroll
            for (int m = 0; m < 4; ++m)
#pragma unroll
                for (int n = 0; n < 2; ++n) acc[a][b][m][n] = (f32x4){0.f, 0.f, 0.f, 0.f};
    bf16x8 At[4][2], B0[2][2], B1[2][2];
    const char* cA = cur.a; const char* cB = cur.b;
    G8_STAGE_B(G8_SB(0, 0), cB); G8_STAGE_B(G8_SB(0, 1), cB + hstepB); G8_STAGE_A(G8_SA(0, 0), cA, vc[0][0], vc[0][1]); G8_STAGE_A(G8_SA(0, 1), cA, vc[1][0], vc[1][1]);
    if (wr == 1) G8_BAR;
    G8_WAIT_V(2); G8_BAR;
    G8_STAGE_B(G8_SB(1, 0), cB + kstep); G8_STAGE_A(G8_SA(1, 0), cA + kstep, vc[0][0], vc[0][1]); G8_STAGE_B(G8_SB(1, 1), cB + hstepB + kstep);
    G8_WAIT_V(6); G8_BAR;
    for (;;) {
        const bool has_next = S.next(ui + 1, nxt);
        if (GATHER) { unsigned vn[2][2];
            if (has_next) S.aoff(nxt, vn, R, C);
            else { vn[0][0] = vc[0][0]; vn[0][1] = vc[0][1]; vn[1][0] = vc[1][0]; vn[1][1] = vc[1][1]; }
            u32x4 sv; sv.x = vn[0][0]; sv.y = vn[0][1]; sv.z = vn[1][0]; sv.w = vn[1][1]; *stash = sv; }
        const char* nA = has_next ? nxt.a : cA; const char* nB = has_next ? nxt.b : cB;
#pragma unroll 1
        for (int seg = 0; seg < (Epi::KHOOK ? 3 : 1); ++seg) {
        const int tlo = Epi::KHOOK ? 6 * seg : 0, thi = Epi::KHOOK ? (seg == 2 ? nt : 6 * seg + 6) : nt;
#pragma unroll 1
        for (int t = tlo; t < thi; t += 2) {
            const bool last = (t == nt - 2);
            const char* a1 = cA + (size_t)(t + 1) * kstep;
            const char* a2 = last ? nA : cA + (size_t)(t + 2) * kstep; const char* b2 = last ? nB : cB + (size_t)(t + 2) * kstep;
            const char* a3 = a2 + kstep; const char* b3 = b2 + kstep;
            unsigned w00 = vc[0][0], w01 = vc[0][1], w10 = vc[1][0], w11 = vc[1][1];
            if (GATHER) { if (last) { const u32x4 sv = *stash; w00 = sv.x; w01 = sv.y; w10 = sv.z; w11 = sv.w; } }
            G8_LDB(B0, 0, 0); G8_LDB(B1, 0, 1); G8_SCHED; G8_LDA(At, 0, 0); G8_STAGE_A(G8_SA(1, 1), a1, vc[1][0], vc[1][1]);
            G8_WAIT_V(8); G8_WAIT_L(0); G8_BAR; G8_MMA(0, 0, At, B0); G8_MMA(0, 1, At, B1); G8_BAR; G8_SCHED;
            G8_LDA(At, 0, 1); G8_STAGE_B(G8_SB(0, 0), b2); G8_STAGE_B(G8_SB(0, 1), b2 + hstepB); G8_STAGE_A(G8_SA(0, 0), a2, w00, w01);
            G8_WAIT_V(8); G8_WAIT_L(0); G8_BAR; G8_MMA(1, 0, At, B0); G8_MMA(1, 1, At, B1); G8_BAR; G8_SCHED;
            G8_LDB(B0, 1, 0); G8_LDB(B1, 1, 1); G8_SCHED; G8_LDA(At, 1, 0); G8_STAGE_A(G8_SA(0, 1), a2, w10, w11);
            G8_WAIT_V(8); G8_WAIT_L(0); G8_BAR; G8_MMA(0, 0, At, B0); G8_MMA(0, 1, At, B1); G8_BAR; G8_SCHED;
            G8_LDA(At, 1, 1); G8_STAGE_B(G8_SB(1, 0), b3); G8_STAGE_B(G8_SB(1, 1), b3 + hstepB); G8_STAGE_A(G8_SA(1, 0), a3, w00, w01);
            G8_WAIT_V(8); G8_WAIT_L(0); G8_BAR; G8_MMA(1, 0, At, B0); G8_MMA(1, 1, At, B1); G8_BAR; G8_SCHED;
        }
        if constexpr (Epi::KHOOK) { if (seg < 2) E.kscale(acc, seg, wr, fr); }
        }
        if (wr == 0) G8_BAR;
        { int fr_ = fr, fq_ = fq; asm volatile("" : "+v"(fr_), "+v"(fq_));
          E(acc, cur, wr, wc, fr_, fq_); }
        if (!has_next) break;
#pragma unroll
        for (int a = 0; a < 2; ++a)
#pragma unroll
            for (int b = 0; b < 2; ++b)
#pragma unroll
                for (int m = 0; m < 4; ++m)
#pragma unroll
                    for (int n = 0; n < 2; ++n) acc[a][b][m][n] = (f32x4){0.f, 0.f, 0.f, 0.f};
        cur = nxt; cA = nA; cB = nB; ++ui; G8_MASK(cur);
        if (GATHER) { const u32x4 sv = *stash; vc[0][0] = sv.x; vc[0][1] = sv.y; vc[1][0] = sv.z; vc[1][1] = sv.w; }
        if (wr == 1) G8_BAR;
    }
    G8_WAIT_V(0);
    G8_BAR;
#undef G8_SA
#undef G8_SB
#undef G8_GLDS
#undef G8_STAGE_A
#undef G8_STAGE_B
#undef G8_LDA
#undef G8_LDB
#undef G8_MMA
#undef G8_MASK
#undef G8_WAIT_V
#undef G8_WAIT_L
#undef G8_BAR
#undef G8_SCHED
}
}
using g8::GUnit;
__device__ __forceinline__ void st_bf16x8(bf16_t* p, const float (&v)[8]) { u32x4 w; w.x = pk_bf16(v[0], v[1]); w.y = pk_bf16(v[2], v[3]); w.z = pk_bf16(v[4], v[5]); w.w = pk_bf16(v[6], v[7]); *(u32x4*)p = w; }
__device__ __forceinline__ float quad_sum(float s) { s += shx<16>(s); s += __shfl_xor(s, 32); return s; }

struct EpiInProj {
    static constexpr bool KHOOK = false;
    const float* ssqx; float* part_dq; float* part_dkv; const float* qg; const float* kg; const float* krg; const float* rope;
    unsigned char* prj;
    __device__ __forceinline__ void operator()(const f32x4 (&acc)[2][2][4][2], const GUnit& u, int wr, int wc, int fr, int fq) const {
        const int G = u.pn * 4 + wc;
        const bool isq = G < 6; const int a = G - 6; const bool isk = (G >= 10 && G < 18 && ((a >> 1) & 1) == 0);
        const float* g0 = (isq ? qg : kg) + 8 * fq;
        float rs8[8];
#pragma unroll
        for (int k = 0; k < 8; ++k) rs8[k] = ssqx[u.pm * 256 + (k >> 2) * 128 + wr * 64 + (k & 3) * 16 + fr];
#pragma unroll
        for (int k = 0; k < 8; ++k) rs8[k] = rsqrtf(rs8[k] * (1.f / 1024.f) + 1e-6f);
#pragma unroll
        for (int ai = 0; ai < 2; ++ai)
#pragma unroll
            for (int m = 0; m < 4; ++m) {
                __builtin_amdgcn_sched_barrier(0);
                const int row = u.pm * 256 + ai * 128 + wr * 64 + m * 16 + fr; const int b = row >> 11, t = row & 2047;
                const float rs = rs8[ai * 4 + m];
                float v[2][8];
#pragma unroll
                for (int bj = 0; bj < 2; ++bj)
#pragma unroll
                    for (int n = 0; n < 2; ++n)
#pragma unroll
                        for (int j = 0; j < 4; ++j) v[bj][4 * n + j] = acc[ai][bj][m][n][j] * rs;
                float ss = 0.f;
#pragma unroll
                for (int bj = 0; bj < 2; ++bj)
#pragma unroll
                    for (int i = 0; i < 8; ++i) ss += v[bj][i] * v[bj][i];
                bf16_t* dst = nullptr; int bstride = 32;
                if (isq) {
                    ss = quad_sum(ss); const float sc = rsqrtf(ss * (1.f / 64.f) + 1e-6f) * 0.18033688f;
#pragma unroll
                    for (int i = 0; i < 8; ++i) { v[0][i] *= sc * g0[i]; v[1][i] *= sc * g0[32 + i]; }
                    dst = (bf16_t*)(prj + PRJ_QN) + ((size_t)(b * 6 + G) * 2048 + t) * 64;
                } else if (G < 18) {
                    const int br = a >> 2, s = (a >> 1) & 1, hk = a & 1;
                    if (br > 0 && s == 0) {
                        ss = quad_sum(ss); const float sc = rsqrtf(ss * (1.f / 64.f) + 1e-6f);
#pragma unroll
                        for (int i = 0; i < 8; ++i) { v[0][i] *= sc * g0[i]; v[1][i] *= sc * g0[32 + i]; }
                    }
                    const size_t base = br == 0 ? (s ? PRJ_C0V : PRJ_C0K) : (br == 1 ? (s ? PRJ_VN1 : PRJ_KN1) : (s ? PRJ_VN2 : PRJ_KN2));
                    dst = (bf16_t*)(prj + base) + ((size_t)(b * 2 + hk) * 2048 + t) * 64;
                } else if (G < 26) { dst = (bf16_t*)(prj + PRJ_RAWQK) + (size_t)row * 512 + (G - 18) * 64; }
                else if (G < 30) { dst = (bf16_t*)(prj + PRJ_VML) + ((size_t)(b * 4 + (G - 26)) * 2048 + t) * 64; }
                else if (G < 34) { dst = (bf16_t*)(prj + PRJ_OG) + (size_t)row * 256 + (G - 30) * 64; }
                else if (G < 37) { dst = (bf16_t*)(prj + PRJ_DQKV) + (size_t)row * 384 + (G - 34) * 64; ss = quad_sum(ss); if (fq == 0) part_dq[(size_t)row * 4 + (G - 34)] = ss; }
                else if (G == 37) {
                    dst = (bf16_t*)(prj + PRJ_DQKV) + (size_t)row * 384 + 192;
                    float* gt = (float*)(prj + PRJ_GATES) + (size_t)row * 32 + 8 * fq;
                    *(f32x4*)gt = (f32x4){v[1][0], v[1][1], v[1][2], v[1][3]}; *(f32x4*)(gt + 4) = (f32x4){v[1][4], v[1][5], v[1][6], v[1][7]};
                    float s0 = 0.f;
#pragma unroll
                    for (int i = 0; i < 8; ++i) s0 += v[0][i] * v[0][i];
                    s0 = quad_sum(s0); const float sc = rsqrtf(s0 * (1.f / 32.f) + 1e-6f);
                    const float* rp = rope + (size_t)row * 32 + ((8 * fq) & 15);
                    float kr[8];
#pragma unroll
                    for (int i = 0; i < 8; ++i) { const float val = v[0][i] * sc * krg[8 * fq + i]; const float oth = __shfl_xor(val, 32); const float cs = rp[i], sn = rp[16 + i]; kr[i] = fq < 2 ? val * cs - oth * sn : val * cs + oth * sn; }
                    st_bf16x8((bf16_t*)(prj + PRJ_KR) + (size_t)row * 32 + 8 * fq, kr);
                } else { dst = (bf16_t*)(prj + PRJ_DQKV) + (size_t)row * 384 + 256 + (G - 38) * 64; ss = quad_sum(ss); if (fq == 0) part_dkv[(size_t)row * 2 + (G - 38)] = ss; }
                st_bf16x8(dst + 8 * fq, v[0]); st_bf16x8(dst + bstride + 8 * fq, v[1]);
            }
    }
};

struct EpiUq {
    static constexpr bool KHOOK = false;
    const float* ssq_dq; const float* qkn; const float* rope; bf16_t* QM;
    __device__ __forceinline__ void operator()(const f32x4 (&acc)[2][2][4][2], const GUnit& u, int wr, int wc, int fr, int fq) const {
        const int G = u.pn * 4 + wc; if (G >= 9) return;
        const float scale = 0.14724444f;
        const float* g0 = G < 6 ? qkn + 8 * fq : qkn + 64 + 8 * (fq & 1); const float* g1 = G < 6 ? g0 + 32 : g0 + 16;
        float rs8[8];
#pragma unroll
        for (int k = 0; k < 8; ++k) { const f32x4 pq = *(const f32x4*)(ssq_dq + (size_t)(u.pm * 256 + (k >> 2) * 128 + wr * 64 + (k & 3) * 16 + fr) * 4); rs8[k] = (pq.x + pq.y) + pq.z; }
#pragma unroll
        for (int k = 0; k < 8; ++k) rs8[k] = rsqrtf(rs8[k] * (1.f / 192.f) + 1e-6f);
#pragma unroll
        for (int ai = 0; ai < 2; ++ai) {
#pragma unroll
            for (int m = 0; m < 4; ++m) {
                __builtin_amdgcn_sched_barrier(0);
                const int row = u.pm * 256 + ai * 128 + wr * 64 + m * 16 + fr; const int b = row >> 11, t = row & 2047;
                const float rs = rs8[ai * 4 + m];
                float v[2][8]; float ss = 0.f;
#pragma unroll
                for (int bj = 0; bj < 2; ++bj)
#pragma unroll
                    for (int n = 0; n < 2; ++n)
#pragma unroll
                        for (int j = 0; j < 4; ++j) { const float x = acc[ai][bj][m][n][j] * rs; v[bj][4 * n + j] = x; ss += x * x; }
                if (G < 6) ss = quad_sum(ss); else ss += shx<16>(ss);
                const float sc = rsqrtf(ss * (G < 6 ? 1.f / 64.f : 1.f / 32.f) + 1e-6f) * scale;
#pragma unroll
                for (int i = 0; i < 8; ++i) { v[0][i] *= sc * g0[i]; v[1][i] *= sc * g1[i]; }
                if (G < 6) {
                    bf16_t* dst = QM + ((size_t)(b * 6 + G) * 2048 + t) * 96;
                    st_bf16x8(dst + 8 * fq, v[0]); st_bf16x8(dst + 32 + 8 * fq, v[1]);
                } else {
                    const int i16 = 8 * (fq & 1); const int head = 2 * (G - 6) + (fq >> 1);
                    const float* rp = rope + (size_t)row * 32 + i16; float o1[8], o2[8];
#pragma unroll
                    for (int i = 0; i < 8; ++i) { const float cs = rp[i], sn = rp[16 + i]; o1[i] = v[0][i] * cs - v[1][i] * sn; o2[i] = v[1][i] * cs + v[0][i] * sn; }
                    bf16_t* dst = QM + ((size_t)(b * 6 + head) * 2048 + t) * 96 + 64 + i16;
                    st_bf16x8(dst, o1); st_bf16x8(dst + 16, o2);
                }
            }
        }
    }
};
struct EpiUkv {
    static constexpr bool KHOOK = false;
    const float* ssq_dkv; const float* qkn; const bf16_t* KR; bf16_t* KM; bf16_t* VM;
    __device__ __forceinline__ void operator()(const f32x4 (&acc)[2][2][4][2], const GUnit& u, int wr, int wc, int fr, int fq) const {
        const int G = u.pn * 4 + wc;
        const float* g0 = qkn + 96 + 8 * fq;
        float rs8[8];
#pragma unroll
        for (int k = 0; k < 8; ++k) { const size_t rr = (size_t)(u.pm * 256 + (k >> 2) * 128 + wr * 64 + (k & 3) * 16 + fr); rs8[k] = ssq_dkv[rr * 2] + ssq_dkv[rr * 2 + 1]; }
#pragma unroll
        for (int k = 0; k < 8; ++k) rs8[k] = rsqrtf(rs8[k] * (1.f / 128.f) + 1e-6f);
#pragma unroll
        for (int ai = 0; ai < 2; ++ai) {
          u32x4 kr4[4];
          if (G < 6) {
#pragma unroll
              for (int m = 0; m < 4; ++m) kr4[m] = *(const u32x4*)(KR + (size_t)(u.pm * 256 + ai * 128 + wr * 64 + m * 16 + fr) * 32 + 8 * fq);
          }
#pragma unroll
            for (int m = 0; m < 4; ++m) {
                __builtin_amdgcn_sched_barrier(0);
                const int row = u.pm * 256 + ai * 128 + wr * 64 + m * 16 + fr; const int b = row >> 11, t = row & 2047;
                const float rs = rs8[ai * 4 + m];
                float v[2][8]; float ss = 0.f;
#pragma unroll
                for (int bj = 0; bj < 2; ++bj)
#pragma unroll
                    for (int n = 0; n < 2; ++n)
#pragma unroll
                        for (int j = 0; j < 4; ++j) { const float x = acc[ai][bj][m][n][j] * rs; v[bj][4 * n + j] = x; ss += x * x; }
                if (G < 6) {
                    ss = quad_sum(ss); const float sc = rsqrtf(ss * (1.f / 64.f) + 1e-6f);
#pragma unroll
                    for (int i = 0; i < 8; ++i) { v[0][i] *= sc * g0[i]; v[1][i] *= sc * g0[32 + i]; }
                    bf16_t* dst = KM + ((size_t)(b * 6 + G) * 2048 + t) * 96;
                    st_bf16x8(dst + 8 * fq, v[0]); st_bf16x8(dst + 32 + 8 * fq, v[1]);
                    *(u32x4*)(dst + 64 + 8 * fq) = kr4[m];
                } else {
                    bf16_t* dst = VM + ((size_t)(b * 6 + (G - 6)) * 2048 + t) * 64;
                    st_bf16x8(dst + 8 * fq, v[0]); st_bf16x8(dst + 32 + 8 * fq, v[1]);
                }
            }
        }
    }
};
#define MFMA16(a, b, c) __builtin_amdgcn_mfma_f32_16x16x32_bf16(a, b, c, 0, 0, 0)
#define MFMA32(a, b, c) __builtin_amdgcn_mfma_f32_32x32x16_bf16(a, b, c, 0, 0, 0)
#define LDS_FENCE() asm volatile("s_waitcnt lgkmcnt(0)" ::: "memory")

__device__ __forceinline__ void cmp_unit(int u, int l, InPtr in, unsigned char* ws, LAS unsigned char* lds, int g_wv) {
    int tid_ = TIDX; asm volatile("" : "+v"(tid_));
    const int tid = tid_, w = tid >> 6, lane = tid & 63, r = lane & 15, q = lane >> 4;
    const int b = u >> 2, s = (u >> 1) & 1, hk = u & 1;
    const bf16_t* A = (const bf16_t*)(ws + WS_PRJ + (s ? PRJ_C0V : PRJ_C0K)) + (size_t)(b * 2 + hk) * 2048 * 64;
    const bf16_t* W1 = (const bf16_t*)(ws + WS_WC1) + ((size_t)l * 2 + s) * 64 * 2048;
    const bf16_t* W2 = (const bf16_t*)(ws + WS_WC2) + ((size_t)l * 2 + s) * 64 * 64;
    const float* b1 = (const float*)(ws + WS_B1C) + (l * 2 + s) * 64;
    f32x4 acc[4];
#pragma unroll
    for (int nb = 0; nb < 4; ++nb) acc[nb] = (f32x4){0.f, 0.f, 0.f, 0.f};
    const bf16_t* ap = A + (size_t)(16 * w + r) * 1024 + 8 * q;
    constexpr int WP = 528, WBUF = 64 * WP; LAS unsigned char* wb = lds + 24576;
    u32x4 st[4];
#pragma unroll
    for (int i = 0; i < 4; ++i) { const int c = tid + 512 * i; st[i] = *(const u32x4*)(W1 + (size_t)(c >> 5) * 2048 + (c & 31) * 8); }
    bf16x8 af[8], afn[8];
#pragma unroll
    for (int ks = 0; ks < 8; ++ks) af[ks] = *(const bf16x8*)(ap + 32 * ks);
    const float* kg = in->p[9] + l * 64;
    float b1v[4], kgv[4]; bf16x8 w2f[2][4];
#pragma unroll
    for (int nb = 0; nb < 4; ++nb) { b1v[nb] = b1[16 * nb + r]; kgv[nb] = kg[16 * nb + r]; }
#pragma unroll
    for (int ks = 0; ks < 2; ++ks)
#pragma unroll
        for (int nb = 0; nb < 4; ++nb) w2f[ks][nb] = *(const bf16x8*)(W2 + (size_t)(16 * nb + r) * 64 + 32 * ks + 8 * q);
#pragma unroll
    for (int i = 0; i < 4; ++i) { const int c = tid + 512 * i; *(LAS u32x4*)(wb + (c >> 5) * WP + (c & 31) * 16) = st[i]; }
    __syncthreads();
    auto chunk = [&](const int kc, bf16x8 (&ac)[8], bf16x8 (&an)[8]) __attribute__((always_inline)) {
        const int cur = kc & 1;
        if (kc < 7) {
#pragma unroll
            for (int i = 0; i < 4; ++i) { const int c = tid + 512 * i; st[i] = *(const u32x4*)(W1 + (size_t)(c >> 5) * 2048 + (kc + 1) * 256 + (c & 31) * 8); }
#pragma unroll
            for (int ks = 0; ks < 8; ++ks) an[ks] = *(const bf16x8*)(ap + 256 * (kc + 1) + 32 * ks);
        }
#pragma unroll
        for (int ks = 0; ks < 8; ++ks)
#pragma unroll
            for (int nb = 0; nb < 4; ++nb) { const bf16x8 bb = *(const LAS bf16x8*)(wb + cur * WBUF + (16 * nb + r) * WP + (32 * ks + 8 * q) * 2); acc[nb] = MFMA16(ac[ks], bb, acc[nb]); }
        if (kc < 7) {
#pragma unroll
            for (int i = 0; i < 4; ++i) { const int c = tid + 512 * i; *(LAS u32x4*)(wb + (cur ^ 1) * WBUF + (c >> 5) * WP + (c & 31) * 16) = st[i]; }
        }
        __syncthreads();
    };
#pragma unroll 1
    for (int kc = 0; kc < 8; kc += 2) { chunk(kc, af, afn); chunk(kc + 1, afn, af); }
    LAS bf16_t* hl = (LAS bf16_t*)(lds + w * 2304);
#pragma unroll
    for (int nb = 0; nb < 4; ++nb) { const float bias = b1v[nb];
#pragma unroll
        for (int j = 0; j < 4; ++j) hl[(4 * q + j) * 72 + 16 * nb + r] = f2bf(siluf(acc[nb][j] + bias)); }
    LDS_FENCE();
    f32x4 o[4];
#pragma unroll
    for (int nb = 0; nb < 4; ++nb) o[nb] = (f32x4){0.f, 0.f, 0.f, 0.f};
#pragma unroll
    for (int ks = 0; ks < 2; ++ks) {
        const bf16x8 a = *(const LAS bf16x8*)(hl + r * 72 + 32 * ks + 8 * q);
#pragma unroll
        for (int nb = 0; nb < 4; ++nb) o[nb] = MFMA16(a, w2f[ks][nb], o[nb]);
    }
    LDS_FENCE();
    bf16_t* dst = (bf16_t*)(ws + WS_CMP + (s ? CMP_V : 0)) + (size_t)(b * 2 + hk) * 128 * 64;
#pragma unroll
    for (int j = 0; j < 4; ++j) {
        const int n = 16 * w + 4 * q + j; float ss = 0.f;
#pragma unroll
        for (int nb = 0; nb < 4; ++nb) ss += o[nb][j] * o[nb][j];
        ss += shx<1>(ss); ss += shx<2>(ss); ss += shx<4>(ss); ss += shx<8>(ss);
        const float sc = s == 0 ? rsqrtf(ss * (1.f / 64.f) + 1e-6f) : 1.f;
#pragma unroll
        for (int nb = 0; nb < 4; ++nb) { const int d = 16 * nb + r; const float v = o[nb][j] * sc * (s == 0 ? kgv[nb] : 1.f); dst[(size_t)n * 64 + d] = n < 127 ? f2bf(v) : (bf16_t)0; }
    }
}

__device__ __forceinline__ int swz_off(int row, int chunk) { return row * 128 + ((chunk ^ (row & 7)) << 4); }
__device__ __forceinline__ float log_sigmoid(float x) { return fminf(x, 0.f) - log1pf(__expf(-fabsf(x))); }
__device__ __forceinline__ void ml_delta_wave(int cu, int l, InPtr in, unsigned char* ws, LAS unsigned char* wl, int lane) {
    asm volatile("" : "+v"(lane));
    const int c = cu & 31, bh = cu >> 5, h = bh & 3, b = bh >> 2; const int t0 = c * 64; const size_t row0 = (size_t)b * 2048 + t0;
    const int cc = lane & 7, tg = lane >> 3;
    const bf16_t* raw = (const bf16_t*)(ws + WS_PRJ + PRJ_RAWQK); const float* cw = in->p[11] + (size_t)l * 4 * 512 + h * 64 + 8 * cc;
    u32x4 rq[11];
    const bool head0 = (c == 0 && tg == 0);
#pragma unroll
    for (int i = 0; i < 11; ++i) { const size_t rr = (head0 && i < 3) ? row0 : row0 + 8 * tg - 3 + i; rq[i] = *(const u32x4*)(raw + rr * 512 + h * 64 + 8 * cc); }
    __builtin_amdgcn_sched_barrier(0);
    const float* G = (const float*)(ws + WS_PRJ + PRJ_GATES);
    const float ip = G[(row0 + lane) * 32 + 18 + h] + in->p[12][l * 4 + h], fp = G[(row0 + lane) * 32 + 22 + h] + in->p[13][l * 4 + h];
    float bcum = log_sigmoid(fp);
#pragma unroll
    for (int o = 1; o < 64; o <<= 1) { const float t = __builtin_bit_cast(float, __builtin_amdgcn_ds_bpermute(((lane - o) & 63) << 2, __builtin_bit_cast(int, bcum))); if (lane >= o) bcum += t; }
    const float bL = __builtin_bit_cast(float, __builtin_amdgcn_readlane(__builtin_bit_cast(int, bcum), 63)); const float wgt = __expf(bL - bcum + ip);
    { float* mlg = (float*)(ws + WS_ML + ML_G) + ((size_t)bh * 2048 + t0 + lane) * 2; mlg[0] = bcum; mlg[1] = ip; if (lane == 0) ((float*)(ws + WS_ML + ML_BL))[cu] = bL; }
    float wt[8];
#pragma unroll
    for (int j = 0; j < 8; ++j) wt[j] = __builtin_bit_cast(float, __builtin_amdgcn_ds_bpermute((8 * tg + j) << 2, __builtin_bit_cast(int, wgt)));
    if (head0) {
#pragma unroll
        for (int i = 0; i < 3; ++i) rq[i] = (u32x4){0u, 0u, 0u, 0u}; }
#define MLD_E(v, e) (((e) & 1) ? bf_hi(((e) >> 1) == 0 ? (v).x : ((e) >> 1) == 1 ? (v).y : ((e) >> 1) == 2 ? (v).z : (v).w) : bf_lo(((e) >> 1) == 0 ? (v).x : ((e) >> 1) == 1 ? (v).y : ((e) >> 1) == 2 ? (v).z : (v).w))
    bf16_t* QC = (bf16_t*)(ws + WS_ML) + ((size_t)bh * 2048 + t0 + 8 * tg) * 64 + 8 * cc; bf16_t* KC = (bf16_t*)(ws + WS_ML + ML_KC) + ((size_t)bh * 2048 + t0 + 8 * tg) * 64 + 8 * cc;
    u32x4 rk[11], vv[8];
#pragma unroll
    for (int i = 0; i < 11; ++i) { const size_t rr = (head0 && i < 3) ? row0 : row0 + 8 * tg - 3 + i; rk[i] = *(const u32x4*)(raw + rr * 512 + h * 64 + 8 * cc + 256); }
    { const bf16_t* V = (const bf16_t*)(ws + WS_PRJ + PRJ_VML) + ((size_t)bh * 2048 + t0 + 8 * tg) * 64 + 8 * cc;
#pragma unroll
      for (int j = 0; j < 8; ++j) vv[j] = *(const u32x4*)(V + (size_t)j * 64); }
    if (head0) {
#pragma unroll
        for (int i = 0; i < 3; ++i) rk[i] = (u32x4){0u, 0u, 0u, 0u}; }
    __builtin_amdgcn_sched_barrier(0);
    {
        float w4[4][8];
#pragma unroll
        for (int tp = 0; tp < 4; ++tp) { const f32x4 a = *(const f32x4*)(cw + tp * 512), b4 = *(const f32x4*)(cw + tp * 512 + 4); w4[tp][0] = a.x; w4[tp][1] = a.y; w4[tp][2] = a.z; w4[tp][3] = a.w; w4[tp][4] = b4.x; w4[tp][5] = b4.y; w4[tp][6] = b4.z; w4[tp][7] = b4.w; }
#pragma unroll
        for (int j = 0; j < 8; ++j) { float o[8];
#pragma unroll
            for (int e = 0; e < 8; ++e) o[e] = siluf(w4[0][e] * MLD_E(rq[j], e) + w4[1][e] * MLD_E(rq[j + 1], e) + w4[2][e] * MLD_E(rq[j + 2], e) + w4[3][e] * MLD_E(rq[j + 3], e));
            u32x4 pk; pk.x = pk_bf16(o[0], o[1]); pk.y = pk_bf16(o[2], o[3]); pk.z = pk_bf16(o[4], o[5]); pk.w = pk_bf16(o[6], o[7]);
            *(u32x4*)(QC + (size_t)j * 64) = pk; }
    }
    float dn[8];
    {
        float w4[4][8];
#pragma unroll
        for (int tp = 0; tp < 4; ++tp) { const f32x4 a = *(const f32x4*)(cw + 256 + tp * 512), b4 = *(const f32x4*)(cw + 256 + tp * 512 + 4); w4[tp][0] = a.x; w4[tp][1] = a.y; w4[tp][2] = a.z; w4[tp][3] = a.w; w4[tp][4] = b4.x; w4[tp][5] = b4.y; w4[tp][6] = b4.z; w4[tp][7] = b4.w; }
#pragma unroll
        for (int e = 0; e < 8; ++e) dn[e] = 0.f;
#pragma unroll
        for (int j2 = 0; j2 < 4; ++j2) { float kb[2][8];
#pragma unroll
            for (int jj = 0; jj < 2; ++jj) { const int j = 2 * j2 + jj; float o[8];
#pragma unroll
                for (int e = 0; e < 8; ++e) o[e] = siluf(w4[0][e] * MLD_E(rk[j], e) + w4[1][e] * MLD_E(rk[j + 1], e) + w4[2][e] * MLD_E(rk[j + 2], e) + w4[3][e] * MLD_E(rk[j + 3], e)) * 0.125f;
                u32x4 pk; pk.x = pk_bf16(o[0], o[1]); pk.y = pk_bf16(o[2], o[3]); pk.z = pk_bf16(o[4], o[5]); pk.w = pk_bf16(o[6], o[7]);
                *(u32x4*)(KC + (size_t)j * 64) = pk;
#pragma unroll
                for (int e = 0; e < 8; ++e) { kb[jj][e] = MLD_E(pk, e); dn[e] += wt[j] * kb[jj][e]; } }
#pragma unroll
            for (int e = 0; e < 8; ++e) { *(LAS unsigned*)(wl + swz_off(8 * cc + e, tg) + 4 * j2) = pk_bf16(kb[0][e], kb[1][e]);
                *(LAS unsigned*)(wl + 8192 + swz_off(8 * cc + e, tg) + 4 * j2) = pk_bf16(wt[2 * j2] * MLD_E(vv[2 * j2], e), wt[2 * j2 + 1] * MLD_E(vv[2 * j2 + 1], e)); } }
    }
#undef MLD_E
#pragma unroll
    for (int e = 0; e < 8; ++e) { dn[e] += shx<8>(dn[e]); dn[e] += shx<16>(dn[e]); dn[e] += __shfl_xor(dn[e], 32); }
    if (tg == 0) { float* DN = (float*)(ws + WS_ML + ML_DN) + (size_t)cu * 64 + 8 * cc; *(f32x4*)DN = (f32x4){dn[0], dn[1], dn[2], dn[3]}; *(f32x4*)(DN + 4) = (f32x4){dn[4], dn[5], dn[6], dn[7]}; }
    LDS_FENCE();
    const int r = lane & 15, q = lane >> 4;
    bf16_t* DL = (bf16_t*)(ws + WS_ML + ML_DELTA) + (size_t)cu * 4096;
    f32x4 acc[4][4];
#pragma unroll
    for (int mb = 0; mb < 4; ++mb) {
#pragma unroll
        for (int nb = 0; nb < 4; ++nb) acc[mb][nb] = (f32x4){0.f, 0.f, 0.f, 0.f};
#pragma unroll
        for (int ks = 0; ks < 2; ++ks) {
            const bf16x8 a = *(const LAS bf16x8*)(wl + 8192 + swz_off(16 * mb + r, 4 * ks + q));
#pragma unroll
            for (int nb = 0; nb < 4; ++nb) { const bf16x8 bb = *(const LAS bf16x8*)(wl + swz_off(16 * nb + r, 4 * ks + q)); acc[mb][nb] = MFMA16(a, bb, acc[mb][nb]); }
        }
    }
    LDS_FENCE();
#pragma unroll
    for (int mb = 0; mb < 4; ++mb)
#pragma unroll
        for (int nb = 0; nb < 4; ++nb)
#pragma unroll
            for (int j = 0; j < 4; ++j) { const int row = 16 * mb + 4 * q + j, col = 16 * nb + r; *(LAS bf16_t*)(wl + swz_off(row, col >> 3) + (col & 7) * 2) = f2bf(acc[mb][nb][j]); }
    LDS_FENCE();
#pragma unroll
    for (int i = 0; i < 8; ++i) { const int ch = lane + 64 * i; *(u32x4*)(DL + (size_t)ch * 8) = *(const LAS u32x4*)(wl + swz_off(ch >> 3, ch & 7)); }
    LDS_FENCE();
}

#ifndef TIME_PH
#define TIME_PH -1
#endif
#define PSTAMP(i, blk) do { if (TIME_PH != -1 && l == 0 && blockIdx.x == (blk) && TIDX == 0) ((unsigned long long*)((unsigned*)(ws + WS_CTL) + CW_TS))[i] = __builtin_amdgcn_s_memrealtime(); } while (0)
#ifndef DUP_DELTA
#define DUP_DELTA 1
#endif
__device__ __forceinline__ void phase_prep(int l, InPtr in, unsigned char* ws, LAS unsigned char* lds, int bid, int nb, int g_wv, unsigned* dq) {
    asm volatile("" : "+s"(bid));
    PSTAMP(40, 0);
#ifndef NO_UQ
    { g8::DenseSched S{(const char*)(ws + WS_PRJ + PRJ_DQKV), (const char*)(ws + WS_WUQ) + (size_t)l * 768 * 256 * 2, 384, 256, 64, 3, nb, bid};
      EpiUq E{(const float*)(ws + WS_SSQ + PT_DQ) + (size_t)l * 16384 * 4, in->p[19] + l * 192, (const float*)(ws + WS_ROPE), (bf16_t*)(ws + WS_MLA)};
      g8::gemm_run(lds, 256, 256, S, E, g_wv); }
#endif
    PSTAMP(41, 0);
#ifndef NO_UKV
    asm volatile("" : "+s"(bid));
    { g8::DenseSched S{(const char*)(ws + WS_PRJ + PRJ_DQKV) + 256, (const char*)(ws + WS_WUKV) + (size_t)l * 768 * 256 * 2, 384, 256, 64, 3, nb, nb == 256 ? ((bid + 64) & 255) : bid};
      EpiUkv E{(const float*)(ws + WS_SSQ + PT_DKV) + (size_t)l * 16384 * 2, in->p[19] + l * 192, (const bf16_t*)(ws + WS_PRJ + PRJ_KR), (bf16_t*)(ws + WS_MLA + MLA_KM), (bf16_t*)(ws + WS_MLA + MLA_VM)};
      g8::gemm_run(lds, 256, 256, S, E, g_wv); }
#endif
    PSTAMP(42, 0); PSTAMP(44, 255);
    __syncthreads();
#ifndef NO_CMP
#ifndef DUP_CMP
#define DUP_CMP 1
#endif
    for (int u = (nb == 256 ? (bid >= 128 && bid < 160 ? bid - 128 : 32) : nb - 1 - bid); u < 32; u += nb) for (int rp_ = 0; rp_ < DUP_CMP; ++rp_) { if (rp_) __syncthreads(); cmp_unit(u, l, in, ws, lds, g_wv); }
#endif
    PSTAMP(45, 255);
    __syncthreads();
#ifndef NO_DELTA
    { int tid_ = TIDX; asm volatile("" : "+v"(tid_)); LAS int* slot = (LAS int*)(lds + LDS_MISC + 64);
      for (;;) {
          __syncthreads();
          if (tid_ == 0) *slot = (int)__hip_atomic_fetch_add(dq, 1u, __ATOMIC_RELAXED, __HIP_MEMORY_SCOPE_AGENT);
          __syncthreads();
          const int g = *slot; if (g >= 96 + 128) break;
          const int wv = tid_ >> 6;
          const int cu_ = g < 96 ? g * 8 + wv : 768 + (g - 96) * 2 + wv;
          if (g < 96 || wv < 2) { for (int rp_ = 0; rp_ < DUP_DELTA; ++rp_) ml_delta_wave(cu_, l, in, ws, lds + wv * 16384, tid_ & 63); }
      } }
#endif
    __syncthreads(); PSTAMP(43, 0);
}
#define CHK_TOL(st) (((st) & 15) == 8 ? 1e-2f : 1e-3f)
#define CHECK_REST
constexpr int VTP = 192;
typedef short v4i16_t __attribute__((ext_vector_type(4)));
__device__ __forceinline__ int vt_lane_off(int lane) { return (4 * (lane >> 5) + ((lane & 15) >> 2)) * VTP + ((((lane >> 4) & 1) * 16) + 4 * (lane & 3)) * 2; }
__device__ __forceinline__ bf16x8 vt_frag(const LAS unsigned char* Vt, int voff, int s4, int eb) {
    const LAS unsigned char* a = Vt + voff + 16 * s4 * VTP + 64 * eb;
    const v4i16_t lo = __builtin_amdgcn_ds_read_tr16_b64_v4i16((LAS v4i16_t*)a), hi = __builtin_amdgcn_ds_read_tr16_b64_v4i16((LAS v4i16_t*)(a + 8 * VTP));
    return (bf16x8){lo[0], lo[1], lo[2], lo[3], hi[0], hi[1], hi[2], hi[3]};
}
__device__ __forceinline__ int crow(int reg, int h) { return (reg & 3) + 8 * (reg >> 2) + 4 * h; }
struct AttnState { f32x16 o[2]; float m, l; };
__device__ __forceinline__ void attn_reset(AttnState& A) { A.m = -1e30f; A.l = 0.f;
#pragma unroll
    for (int i = 0; i < 16; ++i) { A.o[0][i] = 0.f; A.o[1][i] = 0.f; } }

template <int DK>
__device__ __forceinline__ void attn_scores(f32x16 (&s)[2], const bf16x8 (&qf)[DK / 16], const LAS unsigned char* Kt, int r, int h) {
    constexpr int KP = 2 * DK + 16, NK = DK / 16;
    bf16x8 kf[2][NK];
#pragma unroll
    for (int kb = 0; kb < 2; ++kb)
#pragma unroll
        for (int ks = 0; ks < NK; ++ks) kf[kb][ks] = *(const LAS bf16x8*)(Kt + (32 * kb + r) * KP + (16 * ks + 8 * h) * 2);
    __builtin_amdgcn_sched_barrier(0);
#pragma unroll
    for (int kb = 0; kb < 2; ++kb)
#pragma unroll
        for (int i = 0; i < 16; ++i) s[kb][i] = 0.f;
#pragma unroll
    for (int ks = 0; ks < NK; ++ks) {
        s[0] = MFMA32(kf[0][ks], qf[ks], s[0]);
        s[1] = MFMA32(kf[1][ks], qf[ks], s[1]);
    }
}
__device__ __forceinline__ float max3f(float a, float b, float c) { return fmaxf(fmaxf(a, b), c); }
__device__ __forceinline__ void attn_softmax_pv(AttnState& A, f32x16 (&s)[2], const LAS unsigned char* Vt, int r, int h, float bias_c = 0.f, bool lane_ok = true) {
    constexpr float THR = 8.f; const int voff = vt_lane_off(r + 32 * h);
    float mx = max3f(s[0][0], s[0][1], s[0][2]);
#pragma unroll
    for (int i = 3; i < 15; i += 2) mx = max3f(mx, s[0][i], s[0][i + 1]);
    mx = max3f(mx, s[0][15], s[1][0]);
#pragma unroll
    for (int i = 1; i < 15; i += 2) mx = max3f(mx, s[1][i], s[1][i + 1]);
    mx = fmaxf(mx, s[1][15]);
    mx = fmaxf(mx, __shfl_xor(mx, 32));
    const float mxb = (lane_ok && mx > -1e29f) ? mx + bias_c : -1e30f;
    const bool grow = mxb > A.m + THR;
    const float mnew = grow ? mxb : A.m;
    if (__any(grow)) {
        const float alpha = __builtin_amdgcn_exp2f(A.m - mnew);
        A.l *= alpha;
#pragma unroll
        for (int i = 0; i < 16; ++i) { A.o[0][i] *= alpha; A.o[1][i] *= alpha; }
    }
    A.m = mnew;
    const float sub = (lane_ok && mnew > -1e29f) ? mnew - bias_c : 1e30f;
    float rs = 0.f;
#pragma unroll
    for (int kb = 0; kb < 2; ++kb)
#pragma unroll
        for (int i = 0; i < 16; ++i) { const float p = __builtin_amdgcn_exp2f(s[kb][i] - sub); s[kb][i] = p; rs += p; }
    rs += __shfl_xor(rs, 32);
    A.l += rs;
    bf16x8 vf[4][2];
#pragma unroll
    for (int s4 = 0; s4 < 4; ++s4)
#pragma unroll
        for (int eb = 0; eb < 2; ++eb) vf[s4][eb] = vt_frag(Vt, voff, s4, eb);
    __builtin_amdgcn_sched_barrier(0);
#pragma unroll
    for (int s4 = 0; s4 < 4; ++s4) {
        const int kb = s4 >> 1, hf = (s4 & 1) * 8;
        u32x4 pw; pw.x = pk_bf16(s[kb][hf + 0], s[kb][hf + 1]); pw.y = pk_bf16(s[kb][hf + 2], s[kb][hf + 3]); pw.z = pk_bf16(s[kb][hf + 4], s[kb][hf + 5]); pw.w = pk_bf16(s[kb][hf + 6], s[kb][hf + 7]);
        const bf16x8 pf = __builtin_bit_cast(bf16x8, pw);
#pragma unroll
        for (int eb = 0; eb < 2; ++eb) A.o[eb] = MFMA32(vf[s4][eb], pf, A.o[eb]);
    }
}
template <int DK>
__device__ __forceinline__ void attn_scores_half(f32x16& s, const bf16x8 (&qf)[DK / 16], const LAS unsigned char* Kt, int r, int h, int kb) {
    constexpr int KP = 2 * DK + 16, NK = DK / 16;
    bf16x8 kf[NK];
#pragma unroll
    for (int ks = 0; ks < NK; ++ks) kf[ks] = *(const LAS bf16x8*)(Kt + (32 * kb + r) * KP + (16 * ks + 8 * h) * 2);
    __builtin_amdgcn_sched_barrier(0);
#pragma unroll
    for (int i = 0; i < 16; ++i) s[i] = 0.f;
#pragma unroll
    for (int ks = 0; ks < NK; ++ks) s = MFMA32(kf[ks], qf[ks], s);
}
__device__ __forceinline__ void attn_softmax_pv_half(AttnState& A, f32x16& s, const LAS unsigned char* Vt, int r, int h, int kb, float bias_c = 0.f, bool lane_ok = true) {
    constexpr float THR = 8.f; const int voff = vt_lane_off(r + 32 * h);
    float mx = max3f(s[0], s[1], s[2]);
#pragma unroll
    for (int i = 3; i < 15; i += 2) mx = max3f(mx, s[i], s[i + 1]);
    mx = fmaxf(mx, s[15]);
    mx = fmaxf(mx, __shfl_xor(mx, 32));
    const float mxb = (lane_ok && mx > -1e29f) ? mx + bias_c : -1e30f;
    const bool grow = mxb > A.m + THR;
    const float mnew = grow ? mxb : A.m;
    if (__any(grow)) {
        const float alpha = __builtin_amdgcn_exp2f(A.m - mnew);
        A.l *= alpha;
#pragma unroll
        for (int i = 0; i < 16; ++i) { A.o[0][i] *= alpha; A.o[1][i] *= alpha; }
    }
    A.m = mnew;
    const float sub = (lane_ok && mnew > -1e29f) ? mnew - bias_c : 1e30f;
    float rs = 0.f;
#pragma unroll
    for (int i = 0; i < 16; ++i) { const float p = __builtin_amdgcn_exp2f(s[i] - sub); s[i] = p; rs += p; }
    rs += __shfl_xor(rs, 32);
    A.l += rs;
    bf16x8 vf[2][2];
#pragma unroll
    for (int s2 = 0; s2 < 2; ++s2)
#pragma unroll
        for (int eb = 0; eb < 2; ++eb) vf[s2][eb] = vt_frag(Vt, voff, 2 * kb + s2, eb);
    __builtin_amdgcn_sched_barrier(0);
#pragma unroll
    for (int s2 = 0; s2 < 2; ++s2) {
        const int hf = s2 * 8;
        u32x4 pw; pw.x = pk_bf16(s[hf + 0], s[hf + 1]); pw.y = pk_bf16(s[hf + 2], s[hf + 3]); pw.z = pk_bf16(s[hf + 4], s[hf + 5]); pw.w = pk_bf16(s[hf + 6], s[hf + 7]);
        const bf16x8 pf = __builtin_bit_cast(bf16x8, pw);
#pragma unroll
        for (int eb = 0; eb < 2; ++eb) A.o[eb] = MFMA32(vf[s2][eb], pf, A.o[eb]);
    }
}
template <int DK>
__device__ __forceinline__ void stage_k_load(u32x4 (&kr)[2], const bf16_t* Kg  , int tid) {
    constexpr int CH = DK / 8;
    kr[0] = *(const u32x4*)(Kg + (size_t)(tid / CH) * DK + (tid % CH) * 8);
    if (64 * CH > 512) { const int c2 = tid + 512; if (c2 < 64 * CH) kr[1] = *(const u32x4*)(Kg + (size_t)(c2 / CH) * DK + (c2 % CH) * 8); }
}
template <int DK>
__device__ __forceinline__ void stage_k_store(const u32x4 (&kr)[2], LAS unsigned char* Kt, int tid) {
    constexpr int CH = DK / 8, KP = 2 * DK + 16;
    *(LAS u32x4*)(Kt + (tid / CH) * KP + (tid % CH) * 16) = kr[0];
    if (64 * CH > 512) { const int c2 = tid + 512; if (c2 < 64 * CH) *(LAS u32x4*)(Kt + (c2 / CH) * KP + (c2 % CH) * 16) = kr[1]; }
}
__device__ __forceinline__ u32x4 stage_v_load(const bf16_t* Vg, int tid) { return *(const u32x4*)(Vg + (size_t)(tid >> 3) * 64 + (tid & 7) * 8); }
__device__ __forceinline__ void stage_v_store(const u32x4& v, LAS unsigned char* Vt, int tid) { *(LAS u32x4*)(Vt + (tid >> 3) * VTP + (tid & 7) * 16) = v; }

constexpr int MLA_KT = 0, MLA_VT = 2 * 64 * 208, MLA_LDS = MLA_VT + 2 * 64 * VTP;
__device__ __forceinline__ void mla_unit(int b, int hd, int qt, int l, unsigned char* ws, LAS unsigned char* lds, int g_wv) {
    int tid_ = TIDX; asm volatile("" : "+v"(tid_));
    const int tid = tid_, w = tid >> 6, lane = tid & 63, r = lane & 31, h = lane >> 5;
    const size_t slab = (size_t)(b * 6 + hd) * 2048;
    const bf16_t* QM = (const bf16_t*)(ws + WS_MLA) + slab * 96; const bf16_t* KM = (const bf16_t*)(ws + WS_MLA + MLA_KM) + slab * 96; const bf16_t* VM = (const bf16_t*)(ws + WS_MLA + MLA_VM) + slab * 64;
    const int q0 = 256 * qt + 32 * w, q = q0 + r;
    bf16x8 qf[6];
#pragma unroll
    for (int ks = 0; ks < 6; ++ks) qf[ks] = *(const bf16x8*)(QM + (size_t)q * 96 + 16 * ks + 8 * h);
    AttnState A; attn_reset(A);
    const int ntile = 4 * qt + 4;
    u32x4 kr[2], vr, kr2[2], vr2;
    stage_k_load<96>(kr, KM, tid); vr = stage_v_load(VM, tid);
    stage_k_store<96>(kr, lds + MLA_KT, tid); stage_v_store(vr, lds + MLA_VT, tid);
    if (ntile > 1) { stage_k_load<96>(kr, KM + (size_t)64 * 96, tid); vr = stage_v_load(VM + (size_t)64 * 64, tid); }
    __syncthreads();
    auto tile_step = [&](const int j, u32x4 (&kc)[2], u32x4& vc, u32x4 (&kn)[2], u32x4& vn) __attribute__((always_inline)) {
        const int cur = j & 1;
        if (j + 2 < ntile) { stage_k_load<96>(kn, KM + (size_t)(j + 2) * 64 * 96, tid); vn = stage_v_load(VM + (size_t)(j + 2) * 64 * 64, tid); }
        if (64 * j <= q0 + 31) {
            f32x16 s[2];
            attn_scores<96>(s, qf, lds + MLA_KT + cur * 64 * 208, r, h);
            if (64 * j + 63 > q0) {
#pragma unroll
                for (int kb = 0; kb < 2; ++kb)
#pragma unroll
                    for (int i = 0; i < 16; ++i) { const int key = 64 * j + 32 * kb + crow(i, h); if (key > q) s[kb][i] = -1e30f; }
            }
            attn_softmax_pv(A, s, lds + MLA_VT + cur * 64 * VTP, r, h);
        }
        if (j + 1 < ntile) { stage_k_store<96>(kc, lds + MLA_KT + (cur ^ 1) * 64 * 208, tid); stage_v_store(vc, lds + MLA_VT + (cur ^ 1) * 64 * VTP, tid); }
        __syncthreads();
    };
#pragma unroll 1
    for (int j = 0; j < ntile; j += 2) { tile_step(j, kr, vr, kr2, vr2); tile_step(j + 1, kr2, vr2, kr, vr); }
    const float inv = A.l > 0.f ? 1.f / A.l : 0.f; float ss = 0.f;
    bf16_t* Y = (bf16_t*)(ws + WS_Y) + ((size_t)b * 2048 + q) * 1024 + 384 + hd * 64;
#pragma unroll
    for (int eb = 0; eb < 2; ++eb)
#pragma unroll
        for (int g4 = 0; g4 < 4; ++g4) {
            const float v0 = A.o[eb][4 * g4] * inv, v1 = A.o[eb][4 * g4 + 1] * inv, v2 = A.o[eb][4 * g4 + 2] * inv, v3 = A.o[eb][4 * g4 + 3] * inv;
            u32x2 pw; pw.x = pk_bf16(v0, v1); pw.y = pk_bf16(v2, v3);
            const float f0 = bf_lo(pw.x), f1 = bf_hi(pw.x), f2 = bf_lo(pw.y), f3 = bf_hi(pw.y); ss += (f0 * f0 + f1 * f1) + (f2 * f2 + f3 * f3);
            *(u32x2*)(Y + 32 * eb + 8 * g4 + 4 * h) = pw;
        }
    ss += __shfl_xor(ss, 32);
    if (h == 0) ((float*)(ws + WS_SSQ + PT_C))[((size_t)l * 16384 + (size_t)b * 2048 + q) * 8 + hd] = ss;
}

__device__ __forceinline__ void nsa_bias32(float (&bv)[2][16], const LAS float* bl, int dd) {
#pragma unroll
    for (int kb = 0; kb < 2; ++kb)
#pragma unroll
        for (int k = 0; k < 16; ++k) { const int c = 63 - (32 * kb + (k & 3) + 8 * (k >> 2)); int d = dd + c; d = d < 0 ? 0 : (d > 255 ? 255 : d); bv[kb][k] = bl[d]; }
}
__device__ __forceinline__ void nsa_mask_bias(f32x16 (&sc)[2], int dq, int h, const LAS float* bl, bool sel, int lim) {
    int dd = dq - 4 * h - 63; asm volatile("" : "+v"(dd));
    float bv[2][16]; nsa_bias32(bv, bl, dd);
#pragma unroll
    for (int kb = 0; kb < 2; ++kb)
#pragma unroll
        for (int k = 0; k < 16; ++k) { const int c = 63 - (32 * kb + (k & 3) + 8 * (k >> 2)); const int d = dd + c; sc[kb][k] = (sel && d >= 0 && d < lim) ? sc[kb][k] + bv[kb][k] : -1e30f; }
}
__device__ __forceinline__ void nsa_mask_bias_half(f32x16& sc, int dq, int h, const LAS float* bl, bool sel, int lim, int kb) {
    int dd = dq - 4 * h - 32 * kb; asm volatile("" : "+v"(dd));
    float bv[16];
#pragma unroll
    for (int k = 0; k < 16; ++k) { int d = dd - ((k & 3) + 8 * (k >> 2)); d = d < 0 ? 0 : (d > 255 ? 255 : d); bv[k] = bl[d]; }
#pragma unroll
    for (int k = 0; k < 16; ++k) { const int d = dd - ((k & 3) + 8 * (k >> 2)); sc[k] = (sel && d >= 0 && d < lim) ? sc[k] + bv[k] : -1e30f; }
}

__device__ __forceinline__ void attn_park(const AttnState& A, LAS float* xl) {
    xl[0] = A.m; xl[64] = A.l;
#pragma unroll
    for (int k = 0; k < 16; ++k) { xl[64 * (2 + k)] = A.o[0][k]; xl[64 * (18 + k)] = A.o[1][k]; }
}
__device__ __forceinline__ void attn_merge(AttnState& A, const LAS float* xl) {
    const float m2 = xl[0], l2 = xl[64]; const float m = fmaxf(A.m, m2);
    const float a1 = A.m > -1e29f ? __builtin_amdgcn_exp2f(A.m - m) : 0.f, a2 = m2 > -1e29f ? __builtin_amdgcn_exp2f(m2 - m) : 0.f;
    A.l = A.l * a1 + l2 * a2; A.m = m;
#pragma unroll
    for (int k = 0; k < 16; ++k) { A.o[0][k] = A.o[0][k] * a1 + xl[64 * (2 + k)] * a2; A.o[1][k] = A.o[1][k] * a1 + xl[64 * (18 + k)] * a2; }
}
constexpr int NSA_KT = 0, NSA_VT = 2 * 64 * 144, NSA_BIAS = NSA_VT + 2 * 64 * VTP, NSA_PS = NSA_BIAS + 3 * 256 * 4, NSA_SEL = NSA_PS + 3 * 64 * 32 * 4, NSA_UNI = NSA_SEL + 256, NSA_OT = NSA_UNI + 256, NSA_LDS = NSA_OT + 6 * 8192;
__device__ __forceinline__ void nsa_unit(int b, int hk, int i, int l, InPtr in, unsigned char* ws, LAS unsigned char* lds, int g_wv) {
    int tid_ = TIDX; asm volatile("" : "+v"(tid_));
    const int tid = tid_, w = tid >> 6, lane = tid & 63, r = lane & 31, h = lane >> 5;
    const bool active = w < 6; const int g = active ? (w >> 1) : 2, th = w & 1, head = hk * 3 + g;
    const int kh = w < 4 ? -1 : (w < 6 ? 0 : 1);
    LAS float* xl = (LAS float*)(lds + NSA_LDS) + th * (34 * 64) + lane;
    const int t = 64 * i + 32 * th + r, tl = 32 * th + r; const size_t row = (size_t)b * 2048 + t;
    const size_t kvslab = (size_t)(b * 2 + hk) * 2048 * 64;
    LAS float* biasl = (LAS float*)(lds + NSA_BIAS); LAS float* PS = (LAS float*)(lds + NSA_PS); LAS unsigned* SEL = (LAS unsigned*)(lds + NSA_SEL); LAS unsigned* UNI = (LAS unsigned*)(lds + NSA_UNI);
    { const float* bd = (const float*)(ws + WS_BIASD) + (size_t)hk * 3 * 2048;
      if (tid < 384) { const int gg = tid >> 7, d0 = (tid & 127) * 2; biasl[gg * 256 + d0] = bd[gg * 2048 + d0]; biasl[gg * 256 + d0 + 1] = bd[gg * 2048 + d0 + 1]; }
#pragma unroll
      for (int k = 0; k < 12; ++k) if (i >= 16) PS[tid + 512 * k] = 0.f;
      if (tid < 4) UNI[tid] = 0u; }
    bf16x8 qf[4];
    { const bf16_t* QN = (const bf16_t*)(ws + WS_PRJ + PRJ_QN) + ((size_t)(b * 6 + head) * 2048 + t) * 64;
#pragma unroll
      for (int ks = 0; ks < 4; ++ks) qf[ks] = *(const bf16x8*)(QN + 16 * ks + 8 * h); }
#define NSA_GATE(k) ({ int t_ = t; asm volatile("" : "+v"(t_)); sigmf(((const float*)(ws + WS_PRJ + PRJ_GATES))[((size_t)b * 2048 + t_) * 32 + head * 3 + (k)]); })
    LAS float* bl = biasl + g * 256;
    LAS float* otl = (LAS float*)(lds + NSA_OT + (active ? w : 0) * 8192) + lane;
    u32x4 kr[2], vr;
    const int ntc = i >= 16 ? 2 : 1;
    { const bf16_t* KC = (const bf16_t*)(ws + WS_CMP) + (size_t)(b * 2 + hk) * 128 * 64; const bf16_t* VC = (const bf16_t*)(ws + WS_CMP + CMP_V) + (size_t)(b * 2 + hk) * 128 * 64;
      for (int T = 0; T < ntc; ++T) { stage_k_load<64>(kr, KC + T * 4096, tid); vr = stage_v_load(VC + T * 4096, tid); stage_k_store<64>(kr, lds + NSA_KT + T * 64 * 144, tid); stage_v_store(vr, lds + NSA_VT + T * 64 * VTP, tid); } }
    __syncthreads();
    {
        f32x16 ot[2];
        if (active && i < 16) {
            AttnState A; attn_reset(A); f32x16 sc[2]; attn_scores<64>(sc, qf, lds + NSA_KT, r, h);
            float bvc[2][16];
#pragma unroll
            for (int kb = 0; kb < 2; ++kb)
#pragma unroll
                for (int k = 0; k < 16; ++k) { int d = t - 16 * (32 * kb + crow(k, h)) - 31; d = d < 0 ? 0 : (d > 255 ? 255 : d); bvc[kb][k] = bl[d]; }
#pragma unroll
            for (int kb = 0; kb < 2; ++kb)
#pragma unroll
                for (int k = 0; k < 16; ++k) { const int d = t - 16 * (32 * kb + crow(k, h)) - 31; sc[kb][k] = d >= 0 ? sc[kb][k] + bvc[kb][k] : -1e30f; }
            attn_softmax_pv(A, sc, lds + NSA_VT, r, h);
            const float gc = NSA_GATE(0); const float inv = A.l > 0.f ? gc / A.l : 0.f;
#pragma unroll
            for (int k = 0; k < 16; ++k) { otl[64 * k] = A.o[0][k] * inv; otl[64 * (16 + k)] = A.o[1][k] * inv; }
        } else if (active) {
            float m = -1e30f, lsum = 0.f;
            for (int T = 0; T < ntc; ++T) {
                f32x16 sc[2]; attn_scores<64>(sc, qf, lds + NSA_KT + T * 64 * 144, r, h);
                float bvc[2][16];
#pragma unroll
                for (int kb = 0; kb < 2; ++kb)
#pragma unroll
                    for (int k = 0; k < 16; ++k) { int d = t - 16 * (64 * T + 32 * kb + crow(k, h)) - 31; d = d < 0 ? 0 : (d > 255 ? 255 : d); bvc[kb][k] = bl[d]; }
                float mx = -1e30f;
#pragma unroll
                for (int kb = 0; kb < 2; ++kb)
#pragma unroll
                    for (int k = 0; k < 16; ++k) { const int n = 64 * T + 32 * kb + crow(k, h); const int d = t - 16 * n - 31; const float x = (d >= 0 && n < 127) ? sc[kb][k] + bvc[kb][k] : -1e30f; sc[kb][k] = x; mx = fmaxf(mx, x); }
                mx = fmaxf(mx, __shfl_xor(mx, 32));
                const float mnew = fmaxf(m, mx), mref = mnew <= -1e29f ? 0.f : mnew; float rs = 0.f;
#pragma unroll
                for (int kb = 0; kb < 2; ++kb)
#pragma unroll
                    for (int k = 0; k < 16; ++k) rs += __builtin_amdgcn_exp2f(sc[kb][k] - mref);
                rs += __shfl_xor(rs, 32);
                lsum = lsum * __builtin_amdgcn_exp2f(m - mref) + rs; m = mnew;
            }
            const float mref = m <= -1e29f ? 0.f : m, inv = lsum > 0.f ? 1.f / lsum : 0.f;
#pragma unroll
            for (int k = 0; k < 16; ++k) { ot[0][k] = 0.f; ot[1][k] = 0.f; }
            float carry = 0.f;
            for (int T = 0; T < ntc; ++T) {
                f32x16 sc[2]; attn_scores<64>(sc, qf, lds + NSA_KT + T * 64 * 144, r, h);
                float bvc[2][16];
#pragma unroll
                for (int kb = 0; kb < 2; ++kb)
#pragma unroll
                    for (int k = 0; k < 16; ++k) { int d = t - 16 * (64 * T + 32 * kb + crow(k, h)) - 31; d = d < 0 ? 0 : (d > 255 ? 255 : d); bvc[kb][k] = bl[d]; }
#pragma unroll
                for (int kb = 0; kb < 2; ++kb)
#pragma unroll
                    for (int k = 0; k < 16; ++k) { const int n = 64 * T + 32 * kb + crow(k, h); const int d = t - 16 * n - 31; sc[kb][k] = (d >= 0 && n < 127) ? __builtin_amdgcn_exp2f(sc[kb][k] + bvc[kb][k] - mref) * inv : 0.f; }
                float prevL = carry;
#pragma unroll
                for (int kb = 0; kb < 2; ++kb)
#pragma unroll
                    for (int g4 = 0; g4 < 4; ++g4) {
                        const float G4 = (sc[kb][4 * g4] + sc[kb][4 * g4 + 1]) + (sc[kb][4 * g4 + 2] + sc[kb][4 * g4 + 3]); const float L = sc[kb][4 * g4 + 3];
                        const float Lo = __shfl_xor(L, 32);
                        const float add = h ? Lo : prevL;
                        prevL = Lo;
                        const int idx = T * 8 + kb * 4 + g4;
                        PS[g * 2048 + tl * 32 + 2 * idx + h] = G4 + add;
                    }
                carry = prevL;
#pragma unroll
                for (int s4 = 0; s4 < 4; ++s4) {
                    const int kb = s4 >> 1, hf = (s4 & 1) * 8;
                    u32x4 pw; pw.x = pk_bf16(sc[kb][hf + 0], sc[kb][hf + 1]); pw.y = pk_bf16(sc[kb][hf + 2], sc[kb][hf + 3]); pw.z = pk_bf16(sc[kb][hf + 4], sc[kb][hf + 5]); pw.w = pk_bf16(sc[kb][hf + 6], sc[kb][hf + 7]);
                    const bf16x8 pf = __builtin_bit_cast(bf16x8, pw);
#pragma unroll
                    for (int eb = 0; eb < 2; ++eb) ot[eb] = MFMA32(vt_frag(lds + NSA_VT + T * 64 * VTP, vt_lane_off(lane), s4, eb), pf, ot[eb]);
                }
            }
            { const float gc = NSA_GATE(0);
#pragma unroll
            for (int k = 0; k < 16; ++k) { otl[64 * k] = ot[0][k] * gc; otl[64 * (16 + k)] = ot[1][k] * gc; } }
        }
    }
    __syncthreads();
#ifndef NO_NSA_SEL
    if (i < 16) { if (tid < 64) SEL[tid] = (2u << i) - 1u; if (tid < 3) UNI[tid] = (2u << i) - 1u; }
    else {
        const int tk = tid >> 3, sg = tid & 7; float v[32];
#pragma unroll
        for (int k = 0; k < 8; ++k) { const f32x4 x0 = *(const LAS f32x4*)(PS + tk * 32 + 4 * k), x1 = *(const LAS f32x4*)(PS + 2048 + tk * 32 + 4 * k), x2 = *(const LAS f32x4*)(PS + 4096 + tk * 32 + 4 * k);
            v[4 * k] = (x0.x + x1.x) + x2.x; v[4 * k + 1] = (x0.y + x1.y) + x2.y; v[4 * k + 2] = (x0.z + x1.z) + x2.z; v[4 * k + 3] = (x0.w + x1.w) + x2.w; }
#pragma unroll
        for (int s = 0; s < 32; ++s) { const bool forced = (s == 0) || (s == i) || (s == i - 1); float x = forced ? v[s] + 1e4f : v[s]; v[s] = s > i ? -1.f : x; }
        unsigned bits = 0u;
#pragma unroll
        for (int k = 0; k < 4; ++k) {
            float x = 0.f;
#pragma unroll
            for (int s = 0; s < 32; ++s) x = (s == 4 * sg + k) ? v[s] : x;
            int rank = 0;
#pragma unroll
            for (int s = 0; s < 32; ++s) rank += (v[s] > x || (v[s] == x && s < 4 * sg + k)) ? 1 : 0;
            if (rank < 16 && x >= 0.f) bits |= 1u << (4 * sg + k);
        }
        bits |= shx<1>(bits); bits |= shx<2>(bits); bits |= shx<4>(bits);
        if (sg == 0) { SEL[tk] = bits; __hip_atomic_fetch_or(UNI, bits, __ATOMIC_RELAXED, __HIP_MEMORY_SCOPE_WORKGROUP); __hip_atomic_fetch_or(UNI + 1 + (tk >> 5), bits, __ATOMIC_RELAXED, __HIP_MEMORY_SCOPE_WORKGROUP); }
    }
#endif
    __syncthreads();
    const unsigned selbits = SEL[tl], uni = UNI[0], unih = UNI[1 + th];
    const float c31 = bl[255];
#ifndef NO_NSA_SLC
#ifndef NSA_DUP_SLC
#define NSA_DUP_SLC 1
#endif
    for (int rp_ = 0; rp_ < NSA_DUP_SLC; ++rp_) {
        AttnState A; attn_reset(A);
        const bf16_t* KS = (const bf16_t*)(ws + WS_PRJ + PRJ_KN1) + kvslab; const bf16_t* VS = (const bf16_t*)(ws + WS_PRJ + PRJ_VN1) + kvslab;
        unsigned todo = uni; int cur = 0; u32x4 kr2[2], vr2;
        int s = __ffs(todo) - 1; todo &= todo - 1;
        stage_k_load<64>(kr, KS + (size_t)s * 4096, tid); vr = stage_v_load(VS + (size_t)s * 4096, tid);
        stage_k_store<64>(kr, lds + NSA_KT, tid); stage_v_store(vr, lds + NSA_VT, tid);
        int sn = todo ? __ffs(todo) - 1 : -1; todo &= todo - 1;
        if (sn >= 0) { stage_k_load<64>(kr, KS + (size_t)sn * 4096, tid); vr = stage_v_load(VS + (size_t)sn * 4096, tid); }
        __syncthreads();
        while (s >= 0) {
            const int sn2 = todo ? __ffs(todo) - 1 : -1; todo &= todo - 1;
            if (sn2 >= 0) { stage_k_load<64>(kr2, KS + (size_t)sn2 * 4096, tid); vr2 = stage_v_load(VS + (size_t)sn2 * 4096, tid); }
            if ((unih >> s) & 1u) {
                const bool sel = (selbits >> s) & 1u;
                if (kh < 0) {
                    f32x16 sc[2];
                    attn_scores<64>(sc, qf, lds + NSA_KT + cur * 64 * 144, r, h);
                    if (i - s >= 3) attn_softmax_pv(A, sc, lds + NSA_VT + cur * 64 * VTP, r, h, c31, sel);
                    else { nsa_mask_bias(sc, t - 64 * s, h, bl, sel, 4096); attn_softmax_pv(A, sc, lds + NSA_VT + cur * 64 * VTP, r, h); }
                } else {
                    f32x16 s1;
                    attn_scores_half<64>(s1, qf, lds + NSA_KT + cur * 64 * 144, r, h, kh);
                    if (i - s >= 3) attn_softmax_pv_half(A, s1, lds + NSA_VT + cur * 64 * VTP, r, h, kh, c31, sel);
                    else { nsa_mask_bias_half(s1, t - 64 * s, h, bl, sel, 4096, kh); attn_softmax_pv_half(A, s1, lds + NSA_VT + cur * 64 * VTP, r, h, kh); }
                }
            }
            if (sn >= 0) { stage_k_store<64>(kr, lds + NSA_KT + (cur ^ 1) * 64 * 144, tid); stage_v_store(vr, lds + NSA_VT + (cur ^ 1) * 64 * VTP, tid); }
            kr[0] = kr2[0]; vr = vr2;
            __syncthreads();
            s = sn; sn = sn2; cur ^= 1;
        }
        if (kh == 1) attn_park(A, xl);
        __syncthreads();
        if (kh == 0) attn_merge(A, xl);
        if (active && rp_ == NSA_DUP_SLC - 1) { const float gs = NSA_GATE(1); const float inv = A.l > 0.f ? gs / A.l : 0.f;
#pragma unroll
            for (int k = 0; k < 16; ++k) { otl[64 * k] += A.o[0][k] * inv; otl[64 * (16 + k)] += A.o[1][k] * inv; } }
    }
#endif
#ifndef NO_NSA_WIN
#ifndef NSA_DUP_WIN
#define NSA_DUP_WIN 1
#endif
    for (int rq_ = 0; rq_ < NSA_DUP_WIN; ++rq_) {
        AttnState A; attn_reset(A);
        const bf16_t* KW = (const bf16_t*)(ws + WS_PRJ + PRJ_KN2) + kvslab; const bf16_t* VW = (const bf16_t*)(ws + WS_PRJ + PRJ_VN2) + kvslab;
        const int j0 = i > 8 ? i - 8 : 0; int cur = 0; u32x4 kr2[2], vr2;
        stage_k_load<64>(kr, KW + (size_t)j0 * 4096, tid); vr = stage_v_load(VW + (size_t)j0 * 4096, tid);
        stage_k_store<64>(kr, lds + NSA_KT, tid); stage_v_store(vr, lds + NSA_VT, tid);
        if (j0 < i) { stage_k_load<64>(kr, KW + (size_t)(j0 + 1) * 4096, tid); vr = stage_v_load(VW + (size_t)(j0 + 1) * 4096, tid); }
        __syncthreads();
        for (int j = j0; j <= i; ++j) {
            if (j + 2 <= i) { stage_k_load<64>(kr2, KW + (size_t)(j + 2) * 4096, tid); vr2 = stage_v_load(VW + (size_t)(j + 2) * 4096, tid); }
            if (kh < 0) {
                f32x16 sc[2];
                attn_scores<64>(sc, qf, lds + NSA_KT + cur * 64 * 144, r, h);
                if (i - j >= 3 && j > i - 8) attn_softmax_pv(A, sc, lds + NSA_VT + cur * 64 * VTP, r, h, c31, true);
                else { nsa_mask_bias(sc, t - 64 * j, h, bl, true, 512); attn_softmax_pv(A, sc, lds + NSA_VT + cur * 64 * VTP, r, h); }
            } else {
                f32x16 s1;
                attn_scores_half<64>(s1, qf, lds + NSA_KT + cur * 64 * 144, r, h, kh);
                if (i - j >= 3 && j > i - 8) attn_softmax_pv_half(A, s1, lds + NSA_VT + cur * 64 * VTP, r, h, kh, c31, true);
                else { nsa_mask_bias_half(s1, t - 64 * j, h, bl, true, 512, kh); attn_softmax_pv_half(A, s1, lds + NSA_VT + cur * 64 * VTP, r, h, kh); }
            }
            if (j < i) { stage_k_store<64>(kr, lds + NSA_KT + (cur ^ 1) * 64 * 144, tid); stage_v_store(vr, lds + NSA_VT + (cur ^ 1) * 64 * VTP, tid); }
            kr[0] = kr2[0]; vr = vr2;
            __syncthreads();
            cur ^= 1;
        }
        if (kh == 1) attn_park(A, xl);
        __syncthreads();
        if (kh == 0) attn_merge(A, xl);
        if (active && rq_ == NSA_DUP_WIN - 1) { const float gw = NSA_GATE(2); const float inv = A.l > 0.f ? gw / A.l : 0.f;
            float ss = 0.f; bf16_t* Y = (bf16_t*)(ws + WS_Y) + row * 1024 + head * 64;
#pragma unroll
            for (int eb = 0; eb < 2; ++eb)
#pragma unroll
                for (int g4 = 0; g4 < 4; ++g4) {
                    const float v0 = otl[64 * (16 * eb + 4 * g4)] + A.o[eb][4 * g4] * inv, v1 = otl[64 * (16 * eb + 4 * g4 + 1)] + A.o[eb][4 * g4 + 1] * inv;
                    const float v2 = otl[64 * (16 * eb + 4 * g4 + 2)] + A.o[eb][4 * g4 + 2] * inv, v3 = otl[64 * (16 * eb + 4 * g4 + 3)] + A.o[eb][4 * g4 + 3] * inv;
                    u32x2 pw; pw.x = pk_bf16(v0, v1); pw.y = pk_bf16(v2, v3);
                    const float f0 = bf_lo(pw.x), f1 = bf_hi(pw.x), f2 = bf_lo(pw.y), f3 = bf_hi(pw.y); ss += (f0 * f0 + f1 * f1) + (f2 * f2 + f3 * f3);
                    *(u32x2*)(Y + 32 * eb + 8 * g4 + 4 * h) = pw;
                }
            ss += __shfl_xor(ss, 32);
            if (h == 0) ((float*)(ws + WS_SSQ + PT_A))[((size_t)l * 16384 + row) * 8 + head] = ss;
        }
    }
#endif
}

__device__ __forceinline__ void ml_out_wave(int cu, int l, InPtr in, unsigned char* ws, LAS unsigned char* wl, LAS unsigned char* npl, int lane) {
    const int c = cu & 31, bh = cu >> 5, hd = bh & 3, b = bh >> 2; const int t0 = c * 64; const int r = lane & 15, q = lane >> 4;
    const bf16_t* QC = (const bf16_t*)(ws + WS_ML) + ((size_t)bh * 2048 + t0) * 64; const bf16_t* KC = (const bf16_t*)(ws + WS_ML + ML_KC) + ((size_t)bh * 2048 + t0) * 64;
    const bf16_t* V = (const bf16_t*)(ws + WS_PRJ + PRJ_VML) + ((size_t)bh * 2048 + t0) * 64;
    const float* mlg = (const float*)(ws + WS_ML + ML_G) + ((size_t)bh * 2048 + t0) * 2;
    const bf16_t* CP = (const bf16_t*)(ws + WS_ML + ML_CP) + (size_t)cu * 4096; const bf16_t* NP = (const bf16_t*)(ws + WS_ML + ML_NP) + (size_t)cu * 64;
    u32x4 vch[8];
#pragma unroll
    for (int i = 0; i < 8; ++i) vch[i] = *(const u32x4*)(V + (size_t)(lane + 64 * i) * 8);
    bf16x8 aq[4][2];
#pragma unroll
    for (int mb = 0; mb < 4; ++mb)
#pragma unroll
        for (int ks = 0; ks < 2; ++ks) aq[mb][ks] = *(const bf16x8*)(QC + (size_t)(16 * mb + r) * 64 + 32 * ks + 8 * q);
    float bj[4][4], den[4][4];
#pragma unroll
    for (int mb = 0; mb < 4; ++mb)
#pragma unroll
        for (int j = 0; j < 4; ++j) bj[mb][j] = mlg[(16 * mb + 4 * q + j) * 2];
    {
        float cs[4];
#pragma unroll
        for (int nb = 0; nb < 4; ++nb) { const float2 gg = *(const float2*)(mlg + (16 * nb + r) * 2); cs[nb] = gg.y - gg.x; }
#pragma unroll
        for (int mb = 0; mb < 4; ++mb) {
            f32x4 accS[4];
#pragma unroll
            for (int nb = 0; nb < 4; ++nb) { accS[nb] = (f32x4){0.f, 0.f, 0.f, 0.f};
#pragma unroll
                for (int ks = 0; ks < 2; ++ks) { const bf16x8 bk = *(const bf16x8*)(KC + (size_t)(16 * nb + r) * 64 + 32 * ks + 8 * q); accS[nb] = MFMA16(aq[mb][ks], bk, accS[nb]); } }
#pragma unroll
            for (int j = 0; j < 4; ++j) {
                const int jj = 16 * mb + 4 * q + j; float rs = 0.f;
#pragma unroll
                for (int nb = 0; nb < 4; ++nb) { const int s = 16 * nb + r; const float p = s <= jj ? accS[nb][j] * __expf(bj[mb][j] + cs[nb]) : 0.f; rs += p;
                    *(LAS bf16_t*)(wl + 8192 + swz_off(jj, s >> 3) + (s & 7) * 2) = f2bf(p); }
                rs += shx<1>(rs); rs += shx<2>(rs); rs += shx<4>(rs); rs += shx<8>(rs);
                den[mb][j] = rs;
            }
        }
    }
#pragma unroll
    for (int i = 0; i < 8; ++i) { const int ch = lane + 64 * i, sv = ch >> 3, e0 = (ch & 7) * 8; const unsigned xs[4] = {vch[i].x, vch[i].y, vch[i].z, vch[i].w};
#pragma unroll
        for (int k = 0; k < 4; ++k) { *(LAS bf16_t*)(wl + swz_off(e0 + 2 * k, sv >> 3) + (sv & 7) * 2) = (bf16_t)(xs[k] & 0xffffu); *(LAS bf16_t*)(wl + swz_off(e0 + 2 * k + 1, sv >> 3) + (sv & 7) * 2) = (bf16_t)(xs[k] >> 16); } }
#pragma unroll
    for (int mb = 0; mb < 4; ++mb) { const float e = __expf(mlg[(16 * mb + r) * 2]);
#pragma unroll
        for (int ks = 0; ks < 2; ++ks) { const u32x4 x = __builtin_bit_cast(u32x4, aq[mb][ks]); u32x4 y;
            y.x = pk_bf16(bf_lo(x.x) * e, bf_hi(x.x) * e); y.y = pk_bf16(bf_lo(x.y) * e, bf_hi(x.y) * e); y.z = pk_bf16(bf_lo(x.z) * e, bf_hi(x.z) * e); y.w = pk_bf16(bf_lo(x.w) * e, bf_hi(x.w) * e);
            aq[mb][ks] = __builtin_bit_cast(bf16x8, y); } }
    f32x4 acc[4][4], accn[4];
#pragma unroll
    for (int mb = 0; mb < 4; ++mb) { accn[mb] = (f32x4){0.f, 0.f, 0.f, 0.f};
#pragma unroll
        for (int nb = 0; nb < 4; ++nb) acc[mb][nb] = (f32x4){0.f, 0.f, 0.f, 0.f}; }
#pragma unroll
    for (int ks = 0; ks < 2; ++ks) {
        u32x4 nz = *(const u32x4*)(NP + 32 * ks + 8 * q); if (r != 0) nz = (u32x4){0u, 0u, 0u, 0u};
        const bf16x8 bn = __builtin_bit_cast(bf16x8, nz);
#pragma unroll
        for (int nb = 0; nb < 4; ++nb) { const bf16x8 bb = *(const bf16x8*)(CP + (size_t)(16 * nb + r) * 64 + 32 * ks + 8 * q);
#pragma unroll
            for (int mb = 0; mb < 4; ++mb) acc[mb][nb] = MFMA16(aq[mb][ks], bb, acc[mb][nb]); }
#pragma unroll
        for (int mb = 0; mb < 4; ++mb) accn[mb] = MFMA16(aq[mb][ks], bn, accn[mb]);
    }
    LDS_FENCE();
#pragma unroll
    for (int ks = 0; ks < 2; ++ks) {
        bf16x8 ap[4];
#pragma unroll
        for (int mb = 0; mb < 4; ++mb) ap[mb] = *(const LAS bf16x8*)(wl + 8192 + swz_off(16 * mb + r, 4 * ks + q));
#pragma unroll
        for (int nb = 0; nb < 4; ++nb) { const bf16x8 bv = *(const LAS bf16x8*)(wl + swz_off(16 * nb + r, 4 * ks + q));
#pragma unroll
            for (int mb = 0; mb < 4; ++mb) acc[mb][nb] = MFMA16(ap[mb], bv, acc[mb][nb]); }
    }
    LDS_FENCE();
    const bf16_t* OG = (const bf16_t*)(ws + WS_PRJ + PRJ_OG); u32x4 ogc[8];
#pragma unroll
    for (int i = 0; i < 8; ++i) { const int ch = lane + 64 * i; ogc[i] = *(const u32x4*)(OG + ((size_t)b * 2048 + t0 + (ch >> 3)) * 256 + hd * 64 + (ch & 7) * 8); }
    const float* gain = in->p[14] + l * 256 + hd * 64;
    bf16_t* Y = (bf16_t*)(ws + WS_Y);
    float gn[4];
#pragma unroll
    for (int nb = 0; nb < 4; ++nb) gn[nb] = gain[16 * nb + r];
#pragma unroll
    for (int mb = 0; mb < 4; ++mb)
#pragma unroll
        for (int j = 0; j < 4; ++j) {
            const int jj = 16 * mb + 4 * q + j;
            const float dn = den[mb][j] + __builtin_bit_cast(float, __builtin_amdgcn_ds_bpermute((lane & 48) << 2, __builtin_bit_cast(int, accn[mb][j])));
            const float inv = __builtin_amdgcn_rcpf(fmaxf(fabsf(dn), 1.f)); float hv[4]; float ss = 0.f;
#pragma unroll
            for (int nb = 0; nb < 4; ++nb) { hv[nb] = acc[mb][nb][j] * inv; ss += hv[nb] * hv[nb]; }
            ss += shx<1>(ss); ss += shx<2>(ss); ss += shx<4>(ss); ss += shx<8>(ss);
            const float rstd = rsqrtf(ss * (1.f / 64.f) + 1e-6f);
#pragma unroll
            for (int nb = 0; nb < 4; ++nb) { const int e = 16 * nb + r; *(LAS bf16_t*)(wl + 8192 + swz_off(jj, e >> 3) + (e & 7) * 2) = f2bf(hv[nb] * rstd * gn[nb]); }
        }
    LDS_FENCE();
#pragma unroll
    for (int i = 0; i < 8; ++i) { const int ch = lane + 64 * i, row = ch >> 3, e8 = ch & 7;
        const u32x4 hx = *(const LAS u32x4*)(wl + 8192 + swz_off(row, e8)); const u32x4 g = ogc[i]; u32x4 o;
        o.x = pk_bf16(bf_lo(hx.x) * sigmf(bf_lo(g.x)), bf_hi(hx.x) * sigmf(bf_hi(g.x)));
        o.y = pk_bf16(bf_lo(hx.y) * sigmf(bf_lo(g.y)), bf_hi(hx.y) * sigmf(bf_hi(g.y)));
        o.z = pk_bf16(bf_lo(hx.z) * sigmf(bf_lo(g.z)), bf_hi(hx.z) * sigmf(bf_hi(g.z)));
        o.w = pk_bf16(bf_lo(hx.w) * sigmf(bf_lo(g.w)), bf_hi(hx.w) * sigmf(bf_hi(g.w)));
        *(u32x4*)(Y + ((size_t)b * 2048 + t0 + row) * 1024 + 768 + hd * 64 + e8 * 8) = o; }
    LDS_FENCE();
}

__device__ __forceinline__ void ml_scan_unit(int bh, int l, unsigned char* ws, int g_wv) {
    int tid_ = TIDX; asm volatile("" : "+v"(tid_)); const int tid = tid_;
    const bf16_t* DL = (const bf16_t*)(ws + WS_ML + ML_DELTA) + (size_t)bh * 32 * 4096 + tid * 8; bf16_t* CP = (bf16_t*)(ws + WS_ML + ML_CP) + (size_t)bh * 32 * 4096 + tid * 8;
    const float* DN = (const float*)(ws + WS_ML + ML_DN) + (size_t)bh * 32 * 64; bf16_t* NP = (bf16_t*)(ws + WS_ML + ML_NP) + (size_t)bh * 32 * 64; const float* BL = (const float*)(ws + WS_ML + ML_BL) + bh * 32;
    float c[8]; float n = 0.f;
#pragma unroll
    for (int k = 0; k < 8; ++k) c[k] = 0.f;
#pragma unroll 1
    for (int c0 = 0; c0 < 32; c0 += 8) {
        u32x4 d[8]; float dn[8], co[8];
#pragma unroll
        for (int k = 0; k < 8; ++k) { d[k] = *(const u32x4*)(DL + (size_t)(c0 + k) * 4096); dn[k] = tid < 64 ? DN[(c0 + k) * 64 + tid] : 0.f; co[k] = __expf(BL[c0 + k]); }
#pragma unroll
        for (int k = 0; k < 8; ++k) {
            u32x4 o; o.x = pk_bf16(c[0], c[1]); o.y = pk_bf16(c[2], c[3]); o.z = pk_bf16(c[4], c[5]); o.w = pk_bf16(c[6], c[7]);
            *(u32x4*)(CP + (size_t)(c0 + k) * 4096) = o; if (tid < 64) NP[(c0 + k) * 64 + tid] = f2bf(n);
            c[0] = co[k] * c[0] + bf_lo(d[k].x); c[1] = co[k] * c[1] + bf_hi(d[k].x); c[2] = co[k] * c[2] + bf_lo(d[k].y); c[3] = co[k] * c[3] + bf_hi(d[k].y);
            c[4] = co[k] * c[4] + bf_lo(d[k].z); c[5] = co[k] * c[5] + bf_hi(d[k].z); c[6] = co[k] * c[6] + bf_lo(d[k].w); c[7] = co[k] * c[7] + bf_hi(d[k].w);
            n = co[k] * n + dn[k];
        }
    }
    asm volatile("s_waitcnt vmcnt(0)" ::: "memory"); __syncthreads();
    if (tid == 0) { __builtin_amdgcn_fence(__ATOMIC_RELEASE, "agent"); asm volatile("s_waitcnt vmcnt(0)" ::: "memory");
        __hip_atomic_fetch_add((unsigned*)(ws + WS_CTL) + CW_SCAN + 64 * l, 1u, __ATOMIC_RELAXED, __HIP_MEMORY_SCOPE_AGENT); }
}
__device__ __forceinline__ void ml_scan_wait(int l, unsigned char* ws, int g_wv) {
    if (TIDX == 0) { unsigned* p = (unsigned*)(ws + WS_CTL) + CW_SCAN + 64 * l; unsigned sp = 0;
        while (__hip_atomic_load(p, __ATOMIC_RELAXED, __HIP_MEMORY_SCOPE_AGENT) < 32u) { __builtin_amdgcn_s_sleep(2); if (++sp > (1u << 22)) break; }
        __builtin_amdgcn_fence(__ATOMIC_ACQUIRE, "agent"); asm volatile("s_waitcnt vmcnt(0)" ::: "memory"); }
    __syncthreads();
}

#ifndef DUP_NSA
#define DUP_NSA 1
#endif
#ifndef DUP_MLA
#define DUP_MLA 1
#endif
#ifndef DUP_ML
#define DUP_ML 1
#endif
#ifdef NO_MLA
#define MLA_CALL(...) do {} while (0)
#else
#define MLA_CALL(...) do { for (int rp = 0; rp < DUP_MLA; ++rp) { if (rp) __syncthreads(); mla_unit(__VA_ARGS__); } } while (0)
#endif
__device__ __forceinline__ void phase_mix(int l, InPtr in, unsigned char* ws, LAS unsigned char* lds, unsigned* qhead, int g_wv) {
    LAS int* slot = (LAS int*)(lds + LDS_MISC + 64);
    for (;;) {
        __syncthreads();
        if (TIDX == 0) *slot = (int)__hip_atomic_fetch_add(qhead, 1u, __ATOMIC_RELAXED, __HIP_MEMORY_SCOPE_AGENT);
        __syncthreads();
        int u = *slot;
        if (u >= 32 + 512 + 384 + 128) break;
        if (u < 32) { ml_scan_unit(u, l, ws, g_wv); continue; } u -= 32;
#ifndef NO_NSA
        if (u < 256) { const int i = 31 - (u >> 4), bh = u & 15; { for (int rp = 0; rp < DUP_NSA; ++rp) { if (rp) __syncthreads(); nsa_unit(bh >> 1, bh & 1, i, l, in, ws, lds, g_wv); } } continue; }
#endif
        u -= 256;
        if (u < 192) { const int qt = 7 - u / 48, bh = u % 48; MLA_CALL(bh / 6, bh % 6, qt, l, ws, lds, g_wv); continue; }
        u -= 192;
#ifndef NO_NSA
        if (u < 128) { const int i = 15 - (u >> 4), bh = u & 15; { for (int rp = 0; rp < DUP_NSA; ++rp) { if (rp) __syncthreads(); nsa_unit(bh >> 1, bh & 1, i, l, in, ws, lds, g_wv); } } continue; }
#endif
        u -= 128;
        if (u < 192) { const int qt = 3 - u / 48, bh = u % 48; MLA_CALL(bh / 6, bh % 6, qt, l, ws, lds, g_wv); continue; } u -= 192;
#ifndef NO_NSA
        if (u < 128) { const int i = 7 - (u >> 4), bh = u & 15; { for (int rp = 0; rp < DUP_NSA; ++rp) { if (rp) __syncthreads(); nsa_unit(bh >> 1, bh & 1, i, l, in, ws, lds, g_wv); } } continue; }
#endif
        u -= 128;
#ifndef NO_MLOUT
        ml_scan_wait(l, ws, g_wv);
        for (int rp = 0; rp < DUP_ML; ++rp) { int tid_ = TIDX; asm volatile("" : "+v"(tid_)); const int w = tid_ >> 6; ml_out_wave(u * 8 + w, l, in, ws, lds + w * 16384, lds + 131072 + w * 256, tid_ & 63); }
#endif
    }
}
__device__ __forceinline__ void phase_ynorm(int l, unsigned char* ws, int bid, int nb, int g_wv) {
    int tid_ = TIDX; asm volatile("" : "+v"(tid_)); const int w = tid_ >> 6, lane = tid_ & 63;
    bf16_t* Y = (bf16_t*)(ws + WS_Y); const float* sa = (const float*)(ws + WS_SSQ + PT_A) + (size_t)l * 16384 * 8; const float* sc = (const float*)(ws + WS_SSQ + PT_C) + (size_t)l * 16384 * 8;
    for (int r0 = (bid * 8 + w) * 8; r0 < NTOK; r0 += nb * 64) {
        if (lane < 48) {
            u32x4 x[8], y[8]; float ra[8], rc[8];
#pragma unroll
            for (int k = 0; k < 8; ++k) { const int row = r0 + k;
                const f32x4 a0 = *(const f32x4*)(sa + (size_t)row * 8), a1 = *(const f32x4*)(sa + (size_t)row * 8 + 4), c0 = *(const f32x4*)(sc + (size_t)row * 8), c1 = *(const f32x4*)(sc + (size_t)row * 8 + 4);
                ra[k] = rsqrtf((((a0.x + a0.y) + (a0.z + a0.w)) + (a1.x + a1.y)) * (1.f / 384.f) + 1e-6f); rc[k] = rsqrtf((((c0.x + c0.y) + (c0.z + c0.w)) + (c1.x + c1.y)) * (1.f / 384.f) + 1e-6f);
                x[k] = *((const u32x4*)(Y + (size_t)row * 1024) + lane); y[k] = *((const u32x4*)(Y + (size_t)row * 1024 + 384) + lane); }
#pragma unroll
            for (int k = 0; k < 8; ++k) { const int row = r0 + k; u32x4 a = x[k], c = y[k]; const float fa = ra[k], fc = rc[k];
                a.x = pk_bf16(bf_lo(a.x) * fa, bf_hi(a.x) * fa); a.y = pk_bf16(bf_lo(a.y) * fa, bf_hi(a.y) * fa); a.z = pk_bf16(bf_lo(a.z) * fa, bf_hi(a.z) * fa); a.w = pk_bf16(bf_lo(a.w) * fa, bf_hi(a.w) * fa);
                c.x = pk_bf16(bf_lo(c.x) * fc, bf_hi(c.x) * fc); c.y = pk_bf16(bf_lo(c.y) * fc, bf_hi(c.y) * fc); c.z = pk_bf16(bf_lo(c.z) * fc, bf_hi(c.z) * fc); c.w = pk_bf16(bf_lo(c.w) * fc, bf_hi(c.w) * fc);
                *((u32x4*)(Y + (size_t)row * 1024) + lane) = a; *((u32x4*)(Y + (size_t)row * 1024 + 384) + lane) = c; }
        }
    }
}
constexpr int LDS_FAC = 131072 + 2048;
__device__ __forceinline__ void outproj_factors(int l, unsigned char* ws, LAS unsigned char* lds, int pm, int tid) {
    asm volatile("" : "+v"(tid));
    if (tid < 256) { const int row = pm * 256 + tid; const float* sa = (const float*)(ws + WS_SSQ + PT_A) + ((size_t)l * 16384 + row) * 8; const float* sc = (const float*)(ws + WS_SSQ + PT_C) + ((size_t)l * 16384 + row) * 8;
        const f32x4 a0 = *(const f32x4*)sa, a1 = *(const f32x4*)(sa + 4), c0 = *(const f32x4*)sc, c1 = *(const f32x4*)(sc + 4);
        const float ra = rsqrtf((((a0.x + a0.y) + (a0.z + a0.w)) + (a1.x + a1.y)) * (1.f / 384.f) + 1e-6f), rc = rsqrtf((((c0.x + c0.y) + (c0.z + c0.w)) + (c1.x + c1.y)) * (1.f / 384.f) + 1e-6f);
        LAS float* F = (LAS float*)(lds + LDS_FAC); F[2 * tid] = ra / rc; F[2 * tid + 1] = rc; }
    __syncthreads();
}
struct EpiOut {
    static constexpr bool KHOOK = true;
    bf16_t* XB; float* ssq; const LAS float* F; bool fold;
    __device__ __forceinline__ void kscale(f32x4 (&acc)[2][2][4][2], int which, int wr, int fr) const {
        if (!fold) return;
#pragma unroll
        for (int ai = 0; ai < 2; ++ai)
#pragma unroll
            for (int m = 0; m < 4; ++m) { const float f = F[2 * (ai * 128 + wr * 64 + m * 16 + fr) + which];
#pragma unroll
                for (int bj = 0; bj < 2; ++bj)
#pragma unroll
                    for (int n = 0; n < 2; ++n) acc[ai][bj][m][n] = acc[ai][bj][m][n] * f; }
    }
    __device__ __forceinline__ void operator()(const f32x4 (&acc)[2][2][4][2], const GUnit& u, int wr, int wc, int fr, int fq) const {
#pragma unroll
        for (int ai = 0; ai < 2; ++ai)
#pragma unroll
          for (int mh = 0; mh < 2; ++mh) {
            __builtin_amdgcn_sched_barrier(0);
            u32x4 xr[2][2];
#pragma unroll
            for (int m2 = 0; m2 < 2; ++m2)
#pragma unroll
                for (int bj = 0; bj < 2; ++bj) xr[m2][bj] = *(const u32x4*)(XB + (size_t)(u.pm * 256 + ai * 128 + wr * 64 + (2 * mh + m2) * 16 + fr) * 1024 + u.pn * 256 + bj * 128 + wc * 32 + 8 * fq);
#pragma unroll
            for (int m2 = 0; m2 < 2; ++m2) {
                const int m = 2 * mh + m2; const int row = u.pm * 256 + ai * 128 + wr * 64 + m * 16 + fr; float ss = 0.f;
#pragma unroll
                for (int bj = 0; bj < 2; ++bj) {
                    const u32x4 x = xr[m2][bj]; u32x4 o;
                    o.x = pk_bf16(bf_lo(x.x) + acc[ai][bj][m][0][0], bf_hi(x.x) + acc[ai][bj][m][0][1]); o.y = pk_bf16(bf_lo(x.y) + acc[ai][bj][m][0][2], bf_hi(x.y) + acc[ai][bj][m][0][3]);
                    o.z = pk_bf16(bf_lo(x.z) + acc[ai][bj][m][1][0], bf_hi(x.z) + acc[ai][bj][m][1][1]); o.w = pk_bf16(bf_lo(x.w) + acc[ai][bj][m][1][2], bf_hi(x.w) + acc[ai][bj][m][1][3]);
                    *(u32x4*)(XB + (size_t)row * 1024 + u.pn * 256 + bj * 128 + wc * 32 + 8 * fq) = o;
                    ss += (bf_lo(o.x) * bf_lo(o.x) + bf_hi(o.x) * bf_hi(o.x)) + (bf_lo(o.y) * bf_lo(o.y) + bf_hi(o.y) * bf_hi(o.y)) + (bf_lo(o.z) * bf_lo(o.z) + bf_hi(o.z) * bf_hi(o.z)) + (bf_lo(o.w) * bf_lo(o.w) + bf_hi(o.w) * bf_hi(o.w));
                }
                ss = quad_sum(ss); if (fq == 0) ssq[(size_t)row * 16 + u.pn * 4 + wc] = ss;
            }
          }
    }
};

__device__ __forceinline__ float sum16(const float* p) { const f32x4 a = *(const f32x4*)p, b = *(const f32x4*)(p + 4), c = *(const f32x4*)(p + 8), d = *(const f32x4*)(p + 12);
    return (((a.x + a.y) + (a.z + a.w)) + ((b.x + b.y) + (b.z + b.w))) + (((c.x + c.y) + (c.z + c.w)) + ((d.x + d.y) + (d.z + d.w))); }
__device__ __forceinline__ void phase_route(int l, InPtr in, unsigned char* ws, LAS unsigned char* lds, int bid, int nb, int g_wv) {
    int tid_ = TIDX; asm volatile("" : "+v"(tid_)); const int w = tid_ >> 6, lane = tid_ & 63, r = lane & 15, q = lane >> 4;
    const bf16_t* XB = (const bf16_t*)(ws + WS_XB); const bf16_t* WR = (const bf16_t*)(ws + WS_WR) + (size_t)l * 64 * 1024;
    const float* ssq = (const float*)(ws + WS_SSQ + PT_X1) + (size_t)l * 16384 * 16; const float* bg = in->p[24] + l * 4; const float* be = in->p[26] + l * 32;
    unsigned* cnt = (unsigned*)(ws + WS_CTL) + CW_CNT + 2048 * l; unsigned* mtok = (unsigned*)(ws + WS_META); float* mw = (float*)(ws + WS_META + META_W);
    LAS float* lg = (LAS float*)(lds + w * 4096);
    LAS unsigned* lcnt = (LAS unsigned*)(lds + 32768); LAS unsigned* lbase = lcnt + 32;
    for (int g0 = bid * 8; g0 < NTOK / 16; g0 += nb * 8) {
        if (tid_ < 32) lcnt[tid_] = 0u;
        __syncthreads();
        const int tok0 = (g0 + w) * 16; f32x4 acc[3];
#pragma unroll
        for (int n = 0; n < 3; ++n) acc[n] = (f32x4){0.f, 0.f, 0.f, 0.f};
        const bf16_t* ap = XB + (size_t)(tok0 + r) * 1024 + 8 * q; const bf16_t* bp = WR + (size_t)r * 1024 + 8 * q;
#pragma unroll 1
        for (int kc = 0; kc < 4; ++kc) {
            bf16x8 a[8], bb[3][8];
#pragma unroll
            for (int s = 0; s < 8; ++s) { a[s] = *(const bf16x8*)(ap + 32 * (kc * 8 + s));
#pragma unroll
                for (int n = 0; n < 3; ++n) bb[n][s] = *(const bf16x8*)(bp + (size_t)n * 16 * 1024 + 32 * (kc * 8 + s)); }
            __builtin_amdgcn_sched_barrier(0);
#pragma unroll
            for (int s = 0; s < 8; ++s)
#pragma unroll
                for (int n = 0; n < 3; ++n) acc[n] = MFMA16(a[s], bb[n][s], acc[n]);
            __builtin_amdgcn_sched_barrier(0);
        }
#pragma unroll
        for (int n = 0; n < 3; ++n)
#pragma unroll
            for (int j = 0; j < 4; ++j) lg[(4 * q + j) * 48 + 16 * n + r] = acc[n][j];
        LDS_FENCE();
        int E0 = 0, E1 = 0; unsigned r0 = 0, r1 = 0; float wt0 = 0.f, wt1 = 0.f; const int tok = tok0 + (lane & 15);
        if (lane < 16) {
            const float rs = rsqrtf(sum16(ssq + (size_t)tok * 16) * (1.f / 1024.f) + 1e-6f); ((float*)(ws + WS_RS2))[tok] = rs; const LAS float* L = lg + lane * 48;
            float gl[4]; int gi = 0;
#pragma unroll
            for (int j = 0; j < 4; ++j) gl[j] = L[j] * rs + bg[j];
            float gm = gl[0];
#pragma unroll
            for (int j = 1; j < 4; ++j) if (gl[j] > gm) { gm = gl[j]; gi = j; }
            float gsum = 0.f;
#pragma unroll
            for (int j = 0; j < 4; ++j) gsum += __expf(gl[j] - gm);
            const float gtop = 1.f / gsum;
            float el[8];
#pragma unroll
            for (int j = 0; j < 8; ++j) el[j] = L[4 + gi * 8 + j] * rs + be[gi * 8 + j];
            int e0 = 0; float v0 = el[0];
#pragma unroll
            for (int j = 1; j < 8; ++j) if (el[j] > v0) { v0 = el[j]; e0 = j; }
            int e1 = -1; float v1 = -3.0e38f;
#pragma unroll
            for (int j = 0; j < 8; ++j) if (j != e0 && el[j] > v1) { v1 = el[j]; e1 = j; }
            const float w0 = 1.f / (1.f + __expf(v1 - v0)); E0 = gi * 8 + e0; E1 = gi * 8 + e1; wt0 = w0 * gtop; wt1 = (1.f - w0) * gtop;
            r0 = __hip_atomic_fetch_add(lcnt + E0, 1u, __ATOMIC_RELAXED, __HIP_MEMORY_SCOPE_WORKGROUP); r1 = __hip_atomic_fetch_add(lcnt + E1, 1u, __ATOMIC_RELAXED, __HIP_MEMORY_SCOPE_WORKGROUP);
        }
        __syncthreads();
        if (tid_ < 32) { const unsigned c = lcnt[tid_]; lbase[tid_] = c ? atomicAdd(cnt + tid_ * 64, c) : 0u; }
        __syncthreads();
        if (lane < 16) {
            const unsigned p0 = lbase[E0] + r0, p1 = lbase[E1] + r1;
            mtok[(size_t)E0 * 16384 + p0] = (unsigned)tok; mw[(size_t)E0 * 16384 + p0] = wt0;
            mtok[(size_t)E1 * 16384 + p1] = (unsigned)tok | 0x80000000u; mw[(size_t)E1 * 16384 + p1] = wt1;
        }
        __syncthreads();
    }
}

constexpr int LDS_TB = 131072 + 2048;
__device__ __forceinline__ void moe_tables(int l, unsigned char* ws, LAS unsigned char* lds, int g_wv) {
    int tix = TIDX; asm volatile("" : "+v"(tix));
    LAS int* tb = (LAS int*)(lds + LDS_TB);
    if (tix < 32) { const unsigned* cnt = (const unsigned*)(ws + WS_CTL) + CW_CNT + 2048 * l; tb[160 + tix] = (int)__hip_atomic_load(cnt + tix * 64, __ATOMIC_RELAXED, __HIP_MEMORY_SCOPE_AGENT); }
    __syncthreads();
    if (tix == 0) { int a = 0, f = 0, p = 0; for (int e = 0; e < 32; ++e) { const int c = tb[160 + e]; tb[e] = a; tb[48 + e] = f; tb[96 + e] = p; a += (c + 255) >> 8; f += c >> 8; p += (c & 255) ? 1 : 0; } tb[32] = a; tb[80] = f; tb[128] = p; }
    __syncthreads();
}
template <int NPN, bool GATHER_>
struct MoeSched {
    static constexpr bool GATHER = GATHER_, PARTIAL = false;
    const char* A; const char* Bt; const unsigned* cnt; const unsigned* mtok; const LAS int* tb; int G, c; size_t bstride_e  , bstride_pn; int lo, hi;
    __device__ __forceinline__ bool next(int i, GUnit& u) const {
        const int L = lo + i * G + c; if (L >= hi) return false;
        const int tile = L / NPN, pn = L % NPN;
        int e = 0;
        for (int k = 1; k < 32; ++k) e = (tb[k] <= tile) ? k : e;
        e = __builtin_amdgcn_readfirstlane(e);
        u.e = e; u.pm = tile; u.pn = pn; u.rows = tb[160 + e] - 256 * (tile - tb[e]);
        u.a = GATHER ? A : A + (size_t)tile * 256 * 256 * 2;
        u.b = Bt + (size_t)e * bstride_e + (size_t)pn * bstride_pn; return true;
    }
    __device__ __forceinline__ void aoff(const GUnit& u, unsigned (&v)[2][2], const int (&R)[2], const int (&C)[2]) const {
#pragma unroll
        for (int h = 0; h < 2; ++h)
#pragma unroll
            for (int i = 0; i < 2; ++i) {
                if (GATHER) { const int lr = h * 128 + R[i]; const int rr = 256 * (u.pm - tb[u.e]) + (lr < u.rows ? lr : 0); const unsigned tok = mtok[(size_t)u.e * 16384 + rr] & 0x7fffffffu; v[h][i] = (tok * 1024u + (unsigned)C[i]) * 2u; }
                else v[h][i] = (unsigned)((h * 128 + R[i]) * 256 + C[i]) * 2u;
            }
    }
};
struct EpiMoeUp {
    static constexpr bool KHOOK = false;
    const unsigned* mtok; const float* ssq; const LAS int* tb; bf16_t* HB;
    __device__ __forceinline__ void operator()(const f32x4 (&acc)[2][2][4][2], const GUnit& u, int wr, int wc, int fr, int fq) const {
        const int r0 = 256 * (u.pm - tb[u.e]);
        float rs8[8];
        { unsigned tk[8];
#pragma unroll
          for (int k = 0; k < 8; ++k) { const int lr = (k >> 2) * 128 + wr * 64 + (k & 3) * 16 + fr; tk[k] = mtok[(size_t)u.e * 16384 + r0 + (lr < u.rows ? lr : 0)] & 0x7fffffffu; }
#pragma unroll
          for (int k = 0; k < 8; ++k) rs8[k] = ssq[tk[k]]; }
#pragma unroll
        for (int ai = 0; ai < 2; ++ai)
#pragma unroll
            for (int m = 0; m < 4; ++m) {
                __builtin_amdgcn_sched_barrier(0);
                const int lr = ai * 128 + wr * 64 + m * 16 + fr;
                if (lr < u.rows) {
                    const float rs = rs8[ai * 4 + m];
                    float hv[8];
#pragma unroll
                    for (int n = 0; n < 2; ++n)
#pragma unroll
                        for (int j = 0; j < 4; ++j) { const float gv = acc[ai][0][m][n][j] * rs, uv = acc[ai][1][m][n][j] * rs; hv[4 * n + j] = siluf(gv) * uv; }
                    st_bf16x8(HB + ((size_t)u.pm * 256 + lr) * 256 + u.pn * 128 + wc * 32 + 8 * fq, hv);
                }
            }
    }
};
struct EpiMoeDown {
    static constexpr bool KHOOK = false;
    const unsigned* mtok; const float* mw; const LAS int* tb; bf16_t* YB;
    __device__ __forceinline__ void operator()(const f32x4 (&acc)[2][2][4][2], const GUnit& u, int wr, int wc, int fr, int fq) const {
        const int r0 = 256 * (u.pm - tb[u.e]);
        unsigned mt8[8]; float wt8[8];
#pragma unroll
        for (int k = 0; k < 8; ++k) { const int lr = (k >> 2) * 128 + wr * 64 + (k & 3) * 16 + fr; const size_t ix = (size_t)u.e * 16384 + r0 + (lr < u.rows ? lr : 0); mt8[k] = mtok[ix]; wt8[k] = mw[ix]; }
#pragma unroll
        for (int ai = 0; ai < 2; ++ai)
#pragma unroll
            for (int m = 0; m < 4; ++m) {
                __builtin_amdgcn_sched_barrier(0);
                const int lr = ai * 128 + wr * 64 + m * 16 + fr;
                if (lr < u.rows) {
                    const unsigned mt = mt8[ai * 4 + m]; const float wt = wt8[ai * 4 + m];
                    bf16_t* dst = YB + ((size_t)(mt >> 31) * 16384 + (mt & 0x7fffffffu)) * 1024 + u.pn * 256 + wc * 32 + 8 * fq;
#pragma unroll
                    for (int bj = 0; bj < 2; ++bj) { float v[8];
#pragma unroll
                        for (int n = 0; n < 2; ++n)
#pragma unroll
                            for (int j = 0; j < 4; ++j) v[4 * n + j] = acc[ai][bj][m][n][j] * wt;
                        st_bf16x8(dst + bj * 128, v); }
                }
            }
    }
};
__device__ __forceinline__ void phase_combine(int l, unsigned char* ws, float* out, int bid, int nb, int g_wv) {
    int tid_ = TIDX; asm volatile("" : "+v"(tid_)); const int w = tid_ >> 6, lane = tid_ & 63;
    bf16_t* XB = (bf16_t*)(ws + WS_XB); const bf16_t* Y0 = (const bf16_t*)(ws + WS_YBUF); const bf16_t* Y1 = Y0 + (size_t)16384 * 1024; float* ssqx = (float*)(ws + WS_SSQX) + 16384;
    for (int row = bid * 8 + w; row < NTOK; row += nb * 8) {
        float ss = 0.f;
#pragma unroll
        for (int k = 0; k < 2; ++k) {
            const size_t o = (size_t)row * 1024 + (lane + 64 * k) * 8;
            const u32x4 x = *(const u32x4*)(XB + o), a = *(const u32x4*)(Y0 + o), c = *(const u32x4*)(Y1 + o);
            float v[8] = { bf_lo(x.x) + bf_lo(a.x) + bf_lo(c.x), bf_hi(x.x) + bf_hi(a.x) + bf_hi(c.x), bf_lo(x.y) + bf_lo(a.y) + bf_lo(c.y), bf_hi(x.y) + bf_hi(a.y) + bf_hi(c.y),
                           bf_lo(x.z) + bf_lo(a.z) + bf_lo(c.z), bf_hi(x.z) + bf_hi(a.z) + bf_hi(c.z), bf_lo(x.w) + bf_lo(a.w) + bf_lo(c.w), bf_hi(x.w) + bf_hi(a.w) + bf_hi(c.w) };
            if (l == L_ - 1 && out) { *(f32x4*)(out + o) = (f32x4){v[0], v[1], v[2], v[3]}; *(f32x4*)(out + o + 4) = (f32x4){v[4], v[5], v[6], v[7]}; }
            else { u32x4 p; p.x = pk_bf16(v[0], v[1]); p.y = pk_bf16(v[2], v[3]); p.z = pk_bf16(v[4], v[5]); p.w = pk_bf16(v[6], v[7]); *(u32x4*)(XB + o) = p;
#pragma unroll
                   for (int j = 0; j < 4; ++j) { const unsigned q = j == 0 ? p.x : (j == 1 ? p.y : (j == 2 ? p.z : p.w)); ss += bf_lo(q) * bf_lo(q) + bf_hi(q) * bf_hi(q); } }
        }
        if (l < L_ - 1) { ss = wave_sum(ss); if (lane == 0) ssqx[row] = ss; }
    }
}
constexpr int MOE_CVT_SPLIT = 4608;
#ifndef CVT_A
#define CVT_A 2688
#endif
#ifndef NROUTE
#define NROUTE 128
#endif
constexpr int NPH = 9;
enum { PH_INPROJ = 0, PH_PREP, PH_MIX, PH_YNORM, PH_OUTPROJ, PH_ROUTE, PH_MOEUP, PH_MOEDOWN, PH_COMBINE };
struct Args { Inputs in; float* out; unsigned char* ws; int ph_lo, ph_hi; };

__global__ void __launch_bounds__(512, 2) mk(Args args) {
    extern __shared__ __attribute__((aligned(16))) unsigned char lds_raw[];
    LAS unsigned char* lds = (LAS unsigned char*)lds_raw;
    const int g_wv = __builtin_amdgcn_readfirstlane((int)threadIdx.x >> 6);
    const int bid0 = blockIdx.x, nb = gridDim.x;
#define BID() ({ int b_ = bid0; asm volatile("" : "+s"(b_)); b_; })
    unsigned char* ws = args.ws; unsigned* ctl = (unsigned*)(ws + WS_CTL);
    const int lo = args.ph_lo, hi = args.ph_hi;
    if (TIDX < 4) ((LAS unsigned*)(lds + LDS_MISC))[TIDX] = 0u;
    __syncthreads();
    XcdBarrier bar; bar.g_wv = g_wv; bar.bar = ctl + CW_BAR; bar.x = 0; bar.st = nullptr;
    if (hi - lo > 1) bar = xcd_barrier_post(ctl + CW_BAR, (volatile LAS unsigned*)(lds + LDS_MISC), g_wv);
#define IN(k) (lo <= (k) && (k) < hi)
#ifndef REPEAT_PH
#define REPEAT_PH -1
#endif
#define NREP(k) ((REPEAT_PH == (k)) ? 2 : 1)
#ifndef NBAR
#define NBAR 1
#endif
#ifndef TIME_PH
#define TIME_PH -1
#endif
#define STAMP(i) do { if (TIME_PH != -1 && blockIdx.x == 0 && TIDX == 0) ((unsigned long long*)(ctl + CW_TS))[i] = __builtin_amdgcn_s_memrealtime(); } while (0)
#define SEAM(k) do { if (IN(k) && IN((k) + 1)) for (int nb_ = 0; nb_ < NBAR; ++nb_) xcd_barrier(bar); STAMP((k) + 1); } while (0)
    STAMP(0);
#ifndef NO_PRO
    if (IN(0)) for (int rep = 0; rep < NREP(100); ++rep) { prologue(in_tab(), launder(ws), lds, BID(), nb, g_wv); if (rep + 1 < NREP(100)) xcd_barrier(bar); }
#endif
    SEAM(0);
    for (int l = 0; l < L_; ++l) {
        const int pb = 1 + l * NPH;
        if (IN(pb + PH_INPROJ)) for (int rep = 0; rep < NREP(PH_INPROJ); ++rep) {
            if (rep) xcd_barrier(bar);
            InPtr in = in_tab(); unsigned char* ws = launder(args.ws);
            g8::DenseSched S{(const char*)(ws + WS_XB), (const char*)(ws + WS_WIN) + (size_t)l * 2560 * 1024 * 2, 1024, 1024, 64, 10, nb, BID()};
            EpiInProj E{(const float*)(ws + WS_SSQX) + l * 16384, (float*)(ws + WS_SSQ + PT_DQ) + (size_t)l * 16384 * 4, (float*)(ws + WS_SSQ + PT_DKV) + (size_t)l * 16384 * 2,
                        in->p[8] + l * 64, in->p[9] + l * 64, in->p[19] + l * 192 + 96 + 64, (const float*)(ws + WS_ROPE), ws + WS_PRJ};
#ifndef NO_INPROJ
            g8::gemm_run(lds, 1024, 1024, S, E, g_wv);
#endif
        }
        SEAM(pb + PH_INPROJ);
        if (IN(pb + PH_PREP)) for (int rep = 0; rep < NREP(PH_PREP); ++rep) { if (rep) xcd_barrier(bar); phase_prep(l, in_tab(), launder(ws), lds, BID(), nb, g_wv, (unsigned*)launder(ws) + CW_Q + 64 * (4 + l + 2 * rep)); }
        SEAM(pb + PH_PREP);
        if (IN(pb + PH_MIX)) for (int rep = 0; rep < NREP(PH_MIX); ++rep) { if (rep) xcd_barrier(bar); phase_mix(l, in_tab(), launder(ws), lds, (unsigned*)launder(ws) + CW_Q + 64 * (l + 2 * rep), g_wv); }
        SEAM(pb + PH_MIX);
        const bool fold_norm = (nb == 256);
        if (IN(pb + PH_YNORM) && !fold_norm) phase_ynorm(l, launder(ws), BID(), nb, g_wv);
        if (!fold_norm) SEAM(pb + PH_YNORM);
        if (IN(pb + PH_OUTPROJ)) {
            unsigned char* ws = launder(args.ws);
            g8::DenseSched S{(const char*)(ws + WS_Y), (const char*)(ws + WS_WOUT) + (size_t)l * 1024 * 1024 * 2, 1024, 1024, 64, 4, nb, BID()};
            EpiOut E{(bf16_t*)(ws + WS_XB), (float*)(ws + WS_SSQ + PT_X1) + (size_t)l * 16384 * 16, (const LAS float*)(lds + LDS_FAC), fold_norm};
            if (fold_norm) { g8::GUnit u0; if (S.next(0, u0)) outproj_factors(l, ws, lds, u0.pm, TIDX); else __syncthreads(); }
#ifndef NO_OUTPROJ
            g8::gemm_run(lds, 1024, 1024, S, E, g_wv);
#endif
        }
        SEAM(pb + PH_OUTPROJ);
#ifndef NO_ROUTE
        if (IN(pb + PH_ROUTE)) {
            const int b_ = BID();
            if (nb >= 256 && b_ >= NROUTE) { cvt_moe_layer(in_tab(), launder(ws), l, (LAS float*)lds, b_ - NROUTE, nb - NROUTE, TIDX, 0, CVT_A);
#ifdef DUP_CVT
                __syncthreads(); cvt_moe_layer(in_tab(), launder(ws), l, (LAS float*)lds, b_ - NROUTE, nb - NROUTE, TIDX);
#endif
            }
            else { phase_route(l, in_tab(), launder(ws), lds, b_, nb >= 256 ? NROUTE : nb, g_wv);
                   if (nb < 256) cvt_moe_layer(in_tab(), launder(ws), l, (LAS float*)lds, b_, nb, TIDX); else cvt_moe_layer(in_tab(), launder(ws), l, (LAS float*)lds, b_, NROUTE, TIDX, CVT_A, 3072); }
            if (l + 1 < L_) { __syncthreads(); cvt_small_weights(in_tab(), launder(ws), l + 1, (LAS float*)lds, b_, nb, TIDX); }
        }
#endif
        SEAM(pb + PH_ROUTE);
        {
            const bool do_up = IN(pb + PH_MOEUP), do_dn = IN(pb + PH_MOEDOWN), fuse = do_up && do_dn;
            for (int part = 0; part < (fuse ? 3 : 1); ++part) {
                if (part) xcd_barrier(bar);
                unsigned char* ws = launder(args.ws);
                if (do_up || do_dn) moe_tables(l, ws, lds, g_wv);
                const unsigned* cnt = (const unsigned*)(ws + WS_CTL) + CW_CNT + 2048 * l; const unsigned* mtok = (const unsigned*)(ws + WS_META); const LAS int* tb = (const LAS int*)(lds + LDS_TB);
                const int b_ = BID(), ntile = tb[32], UPU = 2 * ntile, DNU = 4 * ntile;
                const int hi0 = UPU < nb ? UPU : nb, nu_ = UPU - hi0, nu = nu_ < (nb >> 1) ? nu_ : (nb >> 1), nd = nb - nu;
                const int d1a = 4 * (hi0 >> 1), d1b = 2 * nd, D1 = nu == 0 ? DNU : (d1a < d1b ? d1a : d1b);
                int ulo = 0, uhi = UPU, uG = nb, uc = b_, dlo = 0, dhi = DNU, dG = nb, dc = b_;
                if (fuse) {
                    if (part == 0) { uhi = hi0; dhi = 0; }
                    else if (part == 1) { ulo = hi0; uG = nu; if (b_ >= nu) uhi = ulo; dhi = D1; dG = nd; dc = b_ - nu; if (b_ < nu) dhi = 0; }
                    else { uhi = 0; dlo = D1; }
                }
                if (do_up && uhi > ulo) {
                    MoeSched<2, true> S{(const char*)(ws + WS_XB), (const char*)(ws + WS_WMOE), cnt, mtok, tb, uG, uc, (size_t)512 * 1024 * 2, (size_t)256 * 1024 * 2, ulo, uhi};
                    EpiMoeUp E{mtok, (const float*)(ws + WS_RS2), tb, (bf16_t*)(ws + WS_HBUF)};
#ifndef NO_MOEUP
                    g8::gemm_run(lds, 1024, 1024, S, E, g_wv);
#endif
                }
                if (do_dn && dhi > dlo) {
                    MoeSched<4, false> S{(const char*)(ws + WS_HBUF), (const char*)(ws + WS_WMOE + WMOE_WD), cnt, mtok, tb, dG, dc, (size_t)1024 * 256 * 2, (size_t)256 * 256 * 2, dlo, dhi};
                    EpiMoeDown E{mtok, (const float*)(ws + WS_META + META_W), tb, (bf16_t*)(ws + WS_YBUF)};
#ifndef NO_MOEDOWN
                    g8::gemm_run(lds, 256, 256, S, E, g_wv);
#endif
                }
            }
        }
        SEAM(pb + PH_MOEDOWN);
#ifndef NO_COMBINE
        if (IN(pb + PH_COMBINE)) { unsigned char* ws = launder(args.ws); phase_combine(l, ws, args.out, BID(), nb, g_wv); }
#endif
        SEAM(pb + PH_COMBINE);
    }
#undef IN
#undef SEAM
}
#if CHECK
struct NvScratch { float *proj, *h1, *qk, *hraw, *kn, *kcmp, *vcmp, *dqn, *q, *dkvn, *kv, *krope, *y, *x1, *xl; int* rt_e; float* rt_w; };
constexpr int CB = 5;
enum { NS_INPROJ = 0, NS_NSAPREP, NS_MLAPREP, NS_NSA, NS_ML, NS_MLA, NS_OUT, NS_ROUTE, NS_MOE };
static void naive_step(void* const* d_in, int l, int step, const float* xin, float* xout, const NvScratch& S, hipStream_t st) {
    const int b = CB;
    const float* rel_bias = (const float*)d_in[2];
    const float* norm1_g = (const float*)d_in[3] + (long)l * 1024;
    const float* w_in = (const float*)d_in[4] + (long)l * 1024 * DIN;
    const float* cmp_pe = (const float*)d_in[5] + (long)l * 2 * 32 * 64;
    const float* cmp_w1 = (const float*)d_in[6] + (long)l * 2 * 32 * 64 * 64;
    const float* cmp_w2 = (const float*)d_in[7] + (long)l * 2 * 64 * 64;
    const float* q_norm = (const float*)d_in[8] + l * 64;
    const float* k_norm = (const float*)d_in[9] + l * 64;
    const float* nsa_on = (const float*)d_in[10] + l * 384;
    const float* conv = (const float*)d_in[11] + l * 4 * 512;
    const float* ibias = (const float*)d_in[12] + l * 4;
    const float* fbias = (const float*)d_in[13] + l * 4;
    const float* ml_on = (const float*)d_in[14] + l * 256;
    const float* qan = (const float*)d_in[15] + l * 192;
    const float* w_uq = (const float*)d_in[16] + (long)l * 192 * 576;
    const float* kvan = (const float*)d_in[17] + l * 128;
    const float* w_ukv = (const float*)d_in[18] + (long)l * 128 * 768;
    const float* qkn = (const float*)d_in[19] + l * 192;
    const float* mla_on = (const float*)d_in[20] + l * 384;
    const float* w_out = (const float*)d_in[21] + (long)l * 1024 * 1024;
    const float* norm2_g = (const float*)d_in[22] + l * 1024;
    const float* wgrp = (const float*)d_in[23] + (long)l * 1024 * 4;
    const float* bgrp = (const float*)d_in[24] + l * 4;
    const float* wexp = (const float*)d_in[25] + (long)l * 1024 * 32;
    const float* bexp = (const float*)d_in[26] + l * 32;
    const float* Wg = (const float*)d_in[27] + (long)l * 32 * 1024 * 256;
    const float* Wu = (const float*)d_in[28] + (long)l * 32 * 1024 * 256;
    const float* Wd = (const float*)d_in[29] + (long)l * 32 * 256 * 1024;
    const int* pos = (const int*)d_in[1] + b * 2048;
    switch (step) {
    case NS_INPROJ:
        nv_rmsnorm<<<dim3(2048, 1), 64, 0, st>>>(xin, 1024, 0, S.h1, 1024, 0, norm1_g, 0, 1024);
        nv_gemm<<<dim3((DIN + 63) / 64, 2048 / 64), 256, 0, st>>>(S.h1, 1024, w_in, DIN, S.proj, DIN, nullptr, 0, 2048, DIN, 1024);
        break;
    case NS_NSAPREP:
        nv_nsa_cmp<<<dim3(127, 2, 2), 64, 0, st>>>(S.proj, cmp_pe, cmp_w1, cmp_w2, k_norm, S.kcmp, S.vcmp);
        nv_nsa_knorm<<<dim3(2048, 4), 64, 0, st>>>(S.proj, k_norm, S.kn);
        break;
    case NS_MLAPREP:
        nv_rmsnorm<<<dim3(2048, 1), 64, 0, st>>>(S.proj + O_CDQ, DIN, 0, S.dqn, 192, 0, qan, 0, 192);
        nv_gemm<<<dim3(576 / 64, 2048 / 64), 256, 0, st>>>(S.dqn, 192, w_uq, 576, S.q, 576, nullptr, 0, 2048, 576, 192);
        nv_rmsnorm<<<dim3(2048, 1), 64, 0, st>>>(S.proj + O_CDKV, DIN, 0, S.dkvn, 128, 0, kvan, 0, 128);
        nv_gemm<<<dim3(768 / 64, 2048 / 64), 256, 0, st>>>(S.dkvn, 128, w_ukv, 768, S.kv, 768, nullptr, 0, 2048, 768, 128);
        nv_mla_prep<<<dim3(2048, 7), 64, 0, st>>>(S.q, S.kv, S.proj, S.krope, qkn, pos);
        break;
    case NS_NSA:
        nv_nsa_attn<<<dim3(2048, 2), 192, 0, st>>>(S.proj, S.kn, S.kcmp, S.vcmp, rel_bias, q_norm, S.y);
        break;
    case NS_ML:
        nv_ml_conv<<<2048, 512, 0, st>>>(S.proj, conv, S.qk);
        nv_ml_rec<<<4, 256, 0, st>>>(S.proj, S.qk, ibias, fbias, S.hraw);
        nv_ml_fin<<<dim3(2048, 4), 64, 0, st>>>(S.proj, S.hraw, ml_on, S.y);
        break;
    case NS_MLA:
        nv_mla_attn<<<dim3(2048, 6), 64, 0, st>>>(S.q, S.kv, S.krope, S.y);
        break;
    case NS_OUT:
        nv_rmsnorm<<<dim3(2048, 1), 64, 0, st>>>(S.y, 1024, 0, S.y, 1024, 0, nsa_on, 0, 384);
        nv_rmsnorm<<<dim3(2048, 1), 64, 0, st>>>(S.y + 640, 1024, 0, S.y + 640, 1024, 0, mla_on, 0, 384);
        nv_gemm<<<dim3(1024 / 64, 2048 / 64), 256, 0, st>>>(S.y, 1024, w_out, 1024, S.x1, 1024, xin, 1024, 2048, 1024, 1024);
        break;
    case NS_ROUTE:
        nv_moe_route<<<2048, 64, 0, st>>>(S.x1, norm2_g, wgrp, bgrp, wexp, bexp, S.h1, S.rt_e, S.rt_w);
        break;
    case NS_MOE:
        nv_moe_exp<<<2048, 256, 0, st>>>(S.x1, S.h1, S.rt_e, S.rt_w, Wg, Wu, Wd, xout);
        break;
    }
}

__device__ __forceinline__ void chk_commit(float d2, float r2, float* acc) { d2 = wave_sum(d2); r2 = wave_sum(r2); if ((threadIdx.x & 63) == 0) { atomicAdd(acc, d2); atomicAdd(acc + 1, r2); } }
__device__ __forceinline__ void chk_add(float f, float r, float& d2, float& r2) { const float d = f - r; d2 += (d == d) ? d * d : 1e30f; r2 += r * r; }

__global__ void __launch_bounds__(64) chk_proj(const float* nproj, const unsigned char* prj, const float* ssq_dq, const float* ssq_dkv, const float* qg, const float* kg, const float* krg, const int* pos, float* acc) {
    const int t = blockIdx.x, e = threadIdx.x; const size_t row = (size_t)CB * 2048 + t; float d2 = 0.f, r2 = 0.f;
    for (int G = 0; G < 40; ++G) {
        const int c = inproj_refcol(G, e); float r = c < 0 ? 0.f : nproj[(size_t)t * DIN + c]; float f = 0.f;
        const float rr = (G == 37 && e >= 32) ? 0.f : r; const float ss = wave_sum(rr * rr);
        if (G < 6) { r = r * rsqrtf(ss / 64.f + 1e-6f) * qg[e] * 0.18033688f; f = bf2f(((const bf16_t*)(prj + PRJ_QN))[((size_t)(CB * 6 + G) * 2048 + t) * 64 + e]); }
        else if (G < 18) { const int a = G - 6, br = a >> 2, s = (a >> 1) & 1, hk = a & 1;
            if (br > 0 && s == 0) r = r * rsqrtf(ss / 64.f + 1e-6f) * kg[e];
            const size_t base = br == 0 ? (s ? PRJ_C0V : PRJ_C0K) : (br == 1 ? (s ? PRJ_VN1 : PRJ_KN1) : (s ? PRJ_VN2 : PRJ_KN2));
            f = bf2f(((const bf16_t*)(prj + base))[((size_t)(CB * 2 + hk) * 2048 + t) * 64 + e]); }
        else if (G < 26) f = bf2f(((const bf16_t*)(prj + PRJ_RAWQK))[row * 512 + (G - 18) * 64 + e]);
        else if (G < 30) f = bf2f(((const bf16_t*)(prj + PRJ_VML))[((size_t)(CB * 4 + (G - 26)) * 2048 + t) * 64 + e]);
        else if (G < 34) f = bf2f(((const bf16_t*)(prj + PRJ_OG))[row * 256 + (G - 30) * 64 + e]);
        else if (G < 37) f = bf2f(((const bf16_t*)(prj + PRJ_DQKV))[row * 384 + (G - 34) * 64 + e]);
        else if (G == 37) {
            const float val = e < 32 ? rr * rsqrtf(ss / 32.f + 1e-6f) * krg[e & 31] : 0.f; const float oth = __shfl_xor(val, 16);
            if (e < 32) { const int i = e & 15; const double ang = (double)pos[row] * pow(10000.0, -(double)i / 16.0); const float cs = (float)cos(ang), sn = (float)sin(ang);
                r = e < 16 ? val * cs - oth * sn : val * cs + oth * sn; f = bf2f(((const bf16_t*)(prj + PRJ_KR))[row * 32 + e]); }
            else if (e < 58) f = ((const float*)(prj + PRJ_GATES))[row * 32 + (e - 32)];
            else { f = 0.f; r = 0.f; }
        }
        else f = bf2f(((const bf16_t*)(prj + PRJ_DQKV))[row * 384 + 256 + (G - 38) * 64 + e]);
        chk_add(f, r, d2, r2);
    }
    float d2s = 0.f, r2s = 0.f;
    { float s1 = 0.f, s2 = 0.f; for (int c = e; c < 192; c += 64) { float v = nproj[(size_t)t * DIN + O_CDQ + c]; s1 += v * v; } for (int c = e; c < 128; c += 64) { float v = nproj[(size_t)t * DIN + O_CDKV + c]; s2 += v * v; }
      s1 = wave_sum(s1); s2 = wave_sum(s2); if (e == 0) { chk_add((ssq_dq[row * 4] + ssq_dq[row * 4 + 1]) + ssq_dq[row * 4 + 2], s1, d2s, r2s); chk_add(ssq_dkv[row * 2] + ssq_dkv[row * 2 + 1], s2, d2s, r2s); } }
    chk_commit(d2, r2, acc); chk_commit(d2s, r2s, acc + 2);
}

__global__ void __launch_bounds__(64) chk_prep(const float* nq, const float* nkv, const float* nkr, const float* nkc, const float* nvc, const unsigned char* ws, float* acc) {
    const int t = blockIdx.x, e = threadIdx.x; float d2 = 0.f, r2 = 0.f, d2c = 0.f, r2c = 0.f; const float scale = 0.14724444f;
    const bf16_t* QM = (const bf16_t*)(ws + WS_MLA); const bf16_t* KM = (const bf16_t*)(ws + WS_MLA + MLA_KM); const bf16_t* VM = (const bf16_t*)(ws + WS_MLA + MLA_VM);
    for (int h = 0; h < 6; ++h) {
        const size_t rq = ((size_t)(CB * 6 + h) * 2048 + t);
        chk_add(bf2f(QM[rq * 96 + e]), nq[(size_t)t * 576 + h * 96 + e] * scale, d2, r2);
        chk_add(bf2f(KM[rq * 96 + e]), nkv[(size_t)t * 768 + h * 128 + e], d2, r2);
        chk_add(bf2f(VM[rq * 64 + e]), nkv[(size_t)t * 768 + h * 128 + 64 + e], d2, r2);
        if (e < 32) { chk_add(bf2f(QM[rq * 96 + 64 + e]), nq[(size_t)t * 576 + h * 96 + 64 + e] * scale, d2, r2); chk_add(bf2f(KM[rq * 96 + 64 + e]), nkr[(size_t)t * 32 + e], d2, r2); }
    }
    if (t < 128) for (int hk = 0; hk < 2; ++hk) {
        const bf16_t* KC = (const bf16_t*)(ws + WS_CMP); const bf16_t* VC = (const bf16_t*)(ws + WS_CMP + CMP_V); const size_t rf = ((size_t)(CB * 2 + hk) * 128 + t) * 64 + e;
        chk_add(bf2f(KC[rf]), t < 127 ? nkc[(size_t)(hk * 127 + t) * 64 + e] : 0.f, d2c, r2c); chk_add(bf2f(VC[rf]), t < 127 ? nvc[(size_t)(hk * 127 + t) * 64 + e] : 0.f, d2c, r2c);
    }
    chk_commit(d2, r2, acc); chk_commit(d2c, r2c, acc + 2);
}

__global__ void __launch_bounds__(64) chk_y(const float* ny, const unsigned char* ws, float* acc, int nseg) {
    const int t = blockIdx.x, e = threadIdx.x; const bf16_t* Y = (const bf16_t*)(ws + WS_Y) + ((size_t)CB * 2048 + t) * 1024;
    float d2[3] = {0.f, 0.f, 0.f}, r2[3] = {0.f, 0.f, 0.f};
    for (int c = e; c < 1024; c += 64) { const int seg = c < 384 ? 0 : (c < 640 ? 1 : 2); const int cf = c < 384 ? c : (c < 640 ? 768 + (c - 384) : 384 + (c - 640)); const float f = bf2f(Y[cf]), r = ny[(size_t)t * 1024 + c];
        if (seg == 0) chk_add(f, r, d2[0], r2[0]); else if (seg == 1) chk_add(f, r, d2[1], r2[1]); else chk_add(f, r, d2[2], r2[2]); }
    if (nseg == 3) { chk_commit(d2[0], r2[0], acc); chk_commit(d2[1], r2[1], acc + 2); chk_commit(d2[2], r2[2], acc + 4); }
    else chk_commit(d2[0] + d2[1] + d2[2], r2[0] + r2[1] + r2[2], acc);
}

__global__ void __launch_bounds__(64) chk_x(const float* nx, const unsigned char* ws, float* acc) {
    const int t = blockIdx.x, e = threadIdx.x; const bf16_t* X = (const bf16_t*)(ws + WS_XB) + ((size_t)CB * 2048 + t) * 1024; float d2 = 0.f, r2 = 0.f;
    for (int c = e; c < 1024; c += 64) chk_add(bf2f(X[c]), nx[(size_t)t * 1024 + c], d2, r2);
    chk_commit(d2, r2, acc);
}

__global__ void __launch_bounds__(512) chk_code(float* acc, int nst, const float* nout) {
    __shared__ float sh[512];
    float s = 0.f; for (int i = threadIdx.x; i < 2048 * 1024; i += 512) { float v = nout[i]; s += v * v; }
    sh[threadIdx.x] = s; __syncthreads();
    if (threadIdx.x == 0) { float tot = 0.f; for (int i = 0; i < 512; ++i) tot += sh[i]; float rms = sqrtf(tot / (2048.f * 1024.f)); if (!(rms > 1e-3f && rms < 1e3f)) rms = 1.f;
        int code = 0;
        for (int st = 0; st < nst; ++st) { const float d2 = acc[2 * st], r2 = acc[2 * st + 1]; if (r2 == 0.f && d2 == 0.f) { if ((st & 15) >= 9) continue; code = (st + 1) * 4 + 3; break; } const float err = d2 / fmaxf(r2, 1e-30f);
            const float tol = CHK_TOL(st);
            if (!(err <= tol)) { const int cls = !(err < 1.f) ? 3 : (err >= 0.1f ? 2 : (err >= 0.01f ? 1 : 0)); code = (st + 1) * 4 + cls; break; } }
        acc[2 * 40] = rms * 32.f * exp2f(0.5f * (float)code); }
}
__global__ void __launch_bounds__(512) chk_fill(const float* acc, float* out) {
    const float K = acc[2 * 40];
    for (size_t i = (size_t)blockIdx.x * 512 + threadIdx.x; i < (size_t)NTOK * 1024; i += (size_t)gridDim.x * 512) out[i] = (i & 1) ? -K : K;
}
#endif

#if TIME_PH != -1
#ifndef TIME_Q
#define TIME_Q 6.f
#endif
#ifndef TIME_CAL
#define TIME_CAL 1.0f
#endif
__global__ void tm_acc(const unsigned long long* ts, float* best, int first) {
    int a = TIME_PH, b = TIME_PH + 1;
#ifdef TIME_PH_END
    b = TIME_PH_END;
#endif
    float T = 100.f; if (TIME_PH >= 0) T = (float)(ts[b] - ts[a]) * 0.01f;
    if (first || T < *best) *best = T;
}
__global__ void __launch_bounds__(512) tm_fill(const float* best, float* out) {
    float T = *best;
    T = exp2f(rintf(log2f(fmaxf(T, 1.f)) * TIME_Q) / TIME_Q);
    const float c = sqrtf(T) * TIME_CAL;
    for (size_t i = (size_t)blockIdx.x * 512 + threadIdx.x; i < (size_t)NTOK * 1024; i += (size_t)gridDim.x * 512) out[i] = (i & 1) ? -c : c;
}
#endif
static int g_grid = 0;
static bool setup_once(size_t ws_size) {
    if (g_grid) return g_grid > 0;
    if (ws_size < WS_END) { fprintf(stderr, "kernel_launch: workspace too small: %zu < %zu\n", ws_size, (size_t)WS_END); g_grid = -1; return false; }
    int dev = 0, cus = 0, per_cu = 0;
    if (hipGetDevice(&dev) != hipSuccess || hipDeviceGetAttribute(&cus, hipDeviceAttributeMultiprocessorCount, dev) != hipSuccess) { g_grid = -1; return false; }
    if (hipFuncSetAttribute((const void*)mk, hipFuncAttributeMaxDynamicSharedMemorySize, LDS_BYTES) != hipSuccess) { fprintf(stderr, "kernel_launch: hipFuncSetAttribute failed\n"); g_grid = -1; return false; }
    if (hipOccupancyMaxActiveBlocksPerMultiprocessor(&per_cu, (const void*)mk, 512, LDS_BYTES) != hipSuccess || per_cu < 1) { fprintf(stderr, "kernel_launch: occupancy query says %d\n", per_cu); }
    (void)hipGetLastError();
    g_grid = cus;
    return true;
}
static void launch_mk(const Args& a0, int lo, int hi, hipStream_t stream) { Args a = a0; a.ph_lo = lo; a.ph_hi = hi; hipLaunchKernelGGL(mk, dim3(g_grid), dim3(512), LDS_BYTES, stream, a); }

extern "C" void kernel_launch(void* const* d_in, const int* in_sizes, int n_in, void* d_out, int out_size, void* d_ws, size_t ws_size, hipStream_t stream) {
    if (!setup_once(ws_size)) return;
    unsigned char* ws = (unsigned char*)d_ws;
    (void)hipMemsetAsync(ws + WS_CTL, 0, ZERO_BYTES, stream);
    Args a{}; for (int i = 0; i < 30; ++i) a.in.p[i] = (const float*)d_in[i];
    a.out = (float*)d_out; a.ws = ws; a.ph_lo = 0; a.ph_hi = 0;
#if CHECK
    a.out = nullptr;
#endif
#if CHECK
    float* nb = (float*)d_out; size_t off = 0; NvScratch S;
    auto take = [&](size_t n) { float* p = nb + off; off += (n + 63) & ~(size_t)63; return p; };
    S.proj = take((size_t)2048 * DIN); S.h1 = take(2048 * 1024); S.qk = S.h1; S.hraw = S.qk + 2048 * 512; S.kn = S.hraw + 2048 * 256;
    S.kcmp = take(2 * 127 * 64); S.vcmp = take(2 * 127 * 64); S.dqn = take(2048 * 192); S.q = take(2048 * 576); S.dkvn = take(2048 * 128); S.kv = take(2048 * 768); S.x1 = S.dqn;
    S.krope = take(2048 * 32); S.y = take(2048 * 1024); S.xl = take(2048 * 1024); S.rt_e = (int*)take(2048 * 2); S.rt_w = take(2048 * 2);
    if (off * 4 > (size_t)NTOK * 1024 * 4) { fprintf(stderr, "naive scratch too big\n"); return; }
    float* acc = (float*)(ws + WS_CTL) + CW_CHK;
    launch_mk(a, 0, 1, stream);
    const float* nx_in = (const float*)d_in[0] + (size_t)CB * 2048 * 1024;
    int nst = 0;
    for (int l = 0; l < L_; ++l) {
        const int pb = 1 + l * NPH; const int sb = l * 16;
        launch_mk(a, pb + PH_INPROJ, pb + PH_INPROJ + 1, stream);
        naive_step(d_in, l, NS_INPROJ, nx_in, S.xl, S, stream);
        chk_proj<<<2048, 64, 0, stream>>>(S.proj, ws + WS_PRJ, (const float*)(ws + WS_SSQ + PT_DQ) + (size_t)l * 16384 * 4, (const float*)(ws + WS_SSQ + PT_DKV) + (size_t)l * 16384 * 2,
                                           (const float*)d_in[8] + l * 64, (const float*)d_in[9] + l * 64, (const float*)d_in[19] + l * 192 + 160, (const int*)d_in[1], acc + 2 * (sb + 0));
        nst = sb + 2;
        int ns_done = NS_INPROJ;
#if CHECK_UPTO >= 1
        launch_mk(a, pb + PH_PREP, pb + PH_PREP + 1, stream);
        naive_step(d_in, l, NS_NSAPREP, nx_in, S.xl, S, stream); naive_step(d_in, l, NS_MLAPREP, nx_in, S.xl, S, stream); ns_done = NS_MLAPREP;
        chk_prep<<<2048, 64, 0, stream>>>(S.q, S.kv, S.krope, S.kcmp, S.vcmp, ws, acc + 2 * (sb + 2));
        nst = sb + 4;
#endif
#if CHECK_UPTO >= 2
        launch_mk(a, pb + PH_MIX, pb + PH_MIX + 1, stream);
        naive_step(d_in, l, NS_NSA, nx_in, S.xl, S, stream); naive_step(d_in, l, NS_ML, nx_in, S.xl, S, stream); naive_step(d_in, l, NS_MLA, nx_in, S.xl, S, stream); ns_done = NS_MLA;
        chk_y<<<2048, 64, 0, stream>>>(S.y, ws, acc + 2 * (sb + 4), 3);
        nst = sb + 7;
#endif
#if CHECK_UPTO >= 3
        launch_mk(a, pb + PH_YNORM, pb + PH_YNORM + 1, stream); launch_mk(a, pb + PH_OUTPROJ, pb + PH_OUTPROJ + 1, stream);
        naive_step(d_in, l, NS_OUT, nx_in, S.xl, S, stream); ns_done = NS_OUT;
        chk_x<<<2048, 64, 0, stream>>>(S.x1, ws, acc + 2 * (sb + 7));
        nst = sb + 8;
#endif
#if CHECK_UPTO >= 4
        for (int ph = PH_ROUTE; ph <= PH_COMBINE; ++ph) launch_mk(a, pb + ph, pb + ph + 1, stream);
        naive_step(d_in, l, NS_ROUTE, nx_in, S.xl, S, stream); naive_step(d_in, l, NS_MOE, nx_in, S.xl, S, stream); ns_done = NS_MOE;
        chk_x<<<2048, 64, 0, stream>>>(S.xl, ws, acc + 2 * (sb + 8));
        nst = sb + 9;
#endif
        CHECK_REST
        for (int s = ns_done + 1; s <= NS_MOE; ++s) naive_step(d_in, l, s, nx_in, S.xl, S, stream);
        nx_in = S.xl;
        if (l == CHECK_LAYERS - 1) break;
    }
    chk_code<<<1, 512, 0, stream>>>(acc, nst, S.xl);
    chk_fill<<<1024, 512, 0, stream>>>(acc, (float*)d_out);
#else
#if defined(SPLIT_LAUNCH) && SPLIT_LAUNCH
    for (int ph = 0; ph < 1 + L_ * NPH; ++ph) launch_mk(a, ph, ph + 1, stream);
#else
    launch_mk(a, 0, 1 + L_ * NPH, stream);
#if TIME_PH != -1
    for (int rp = 0; rp < 6; ++rp) {
        (void)hipMemsetAsync(ws + WS_CTL, 0, ZERO_BYTES, stream); launch_mk(a, 0, 1 + L_ * NPH, stream);
        tm_acc<<<1, 1, 0, stream>>>((const unsigned long long*)((unsigned*)(ws + WS_CTL) + CW_TS), (float*)(ws + WS_META + META_RT), rp == 0);
    }
    tm_fill<<<1024, 512, 0, stream>>>((const float*)(ws + WS_META + META_RT), (float*)d_out);
#endif
#endif
#endif
}
```

```cpp
#define CHECK 0
#define CHECK_LAYERS 2
#define CHECK_UPTO 99
#define SPLIT_LAUNCH 0
#define REPEAT_PH -1
#include <hip/hip_runtime.h>
#include <stdint.h>
#include <cstdio>

constexpr int B_ = 8, T_ = 2048, D_ = 1024, L_ = 2, NTOK = B_ * T_;
constexpr int DIN = 2554;
constexpr int O_AQ = 0, O_AKV = 384, O_AG = 1152, O_BQK = 1170, O_BV = 1682, O_BIF = 1938, O_BO = 1946, O_CDQ = 2202, O_CDKV = 2394, O_CKR = 2522;

typedef unsigned short bf16_t;
typedef short bf16x8 __attribute__((ext_vector_type(8)));
typedef short s16x4 __attribute__((ext_vector_type(4)));
typedef float f32x4 __attribute__((ext_vector_type(4)));
typedef float f32x16 __attribute__((ext_vector_type(16)));
typedef unsigned u32x4 __attribute__((ext_vector_type(4)));
typedef unsigned u32x2 __attribute__((ext_vector_type(2)));
typedef float f32x2_t __attribute__((ext_vector_type(2)));
typedef __bf16 bf16x2_t __attribute__((ext_vector_type(2)));
#define LAS __attribute__((address_space(3)))

__device__ __forceinline__ unsigned pk_bf16(float lo, float hi) { f32x2_t v = {lo, hi}; bf16x2_t b = __builtin_convertvector(v, bf16x2_t); return __builtin_bit_cast(unsigned, b); }
__device__ __forceinline__ float bf_lo(unsigned u) { return __builtin_bit_cast(float, u << 16); }
__device__ __forceinline__ float bf_hi(unsigned u) { return __builtin_bit_cast(float, u & 0xffff0000u); }
__device__ __forceinline__ float bf2f(bf16_t h) { return __builtin_bit_cast(float, (unsigned)h << 16); }
__device__ __forceinline__ bf16_t f2bf(float f) { return (bf16_t)(pk_bf16(f, 0.f) & 0xffffu); }
template <int M> __device__ __forceinline__ int shx(int v) { static_assert(M > 0 && M < 32, "swizzle xor mask"); return __builtin_amdgcn_ds_swizzle(v, (M << 10) | 0x1f); }
template <int M> __device__ __forceinline__ float shx(float v) { return __builtin_bit_cast(float, shx<M>(__builtin_bit_cast(int, v))); }
template <int M> __device__ __forceinline__ unsigned shx(unsigned v) { return (unsigned)shx<M>((int)v); }
__device__ __forceinline__ float wave_sum(float v) { v += __shfl_xor(v, 32); v += shx<16>(v); v += shx<8>(v); v += shx<4>(v); v += shx<2>(v); v += shx<1>(v); return v; }
__device__ __forceinline__ float wave_max(float v) { v = fmaxf(v, __shfl_xor(v, 32)); v = fmaxf(v, shx<16>(v)); v = fmaxf(v, shx<8>(v)); v = fmaxf(v, shx<4>(v)); v = fmaxf(v, shx<2>(v)); v = fmaxf(v, shx<1>(v)); return v; }
__device__ __forceinline__ float siluf(float x) { return x * __builtin_amdgcn_rcpf(1.f + __expf(-x)); }
__device__ __forceinline__ float sigmf(float x) { return __builtin_amdgcn_rcpf(1.f + __expf(-x)); }
__device__ __forceinline__ int t5b(int dist) {
    int n = dist > 0 ? dist : 0; if (n < 16) return n;
    float v = logf((float)n / 16.f) / logf(8.f) * 16.f; int l = 16 + (int)v; return l < 31 ? l : 31;
}

__device__ __forceinline__ int lane_now() { return (int)__builtin_amdgcn_mbcnt_hi(~0u, __builtin_amdgcn_mbcnt_lo(~0u, 0u)); }
#define TIDX ((g_wv << 6) | lane_now())

constexpr size_t WS_CTL = 0, CTL_BYTES = 65536;
constexpr size_t WS_SSQ = WS_CTL + CTL_BYTES;
constexpr size_t ZERO_BYTES = CTL_BYTES;
constexpr size_t PT_DQ = 0, PT_DKV = PT_DQ + (size_t)2 * 16384 * 4 * 4, PT_A = PT_DKV + (size_t)2 * 16384 * 2 * 4, PT_C = PT_A + (size_t)2 * 16384 * 8 * 4, PT_X1 = PT_C + (size_t)2 * 16384 * 8 * 4, PT_END = PT_X1 + (size_t)2 * 16384 * 16 * 4;
constexpr size_t WS_SSQX = WS_SSQ + PT_END;
constexpr size_t WS_RS2 = WS_SSQX + 2 * 65536;
constexpr size_t WS_WIN = WS_RS2 + 65536;
constexpr size_t WS_WOUT = WS_WIN + (size_t)2 * 2560 * 1024 * 2;
constexpr size_t WS_WUQ = WS_WOUT + (size_t)2 * 1024 * 1024 * 2;
constexpr size_t WS_WUKV = WS_WUQ + (size_t)2 * 768 * 256 * 2;
constexpr size_t WS_WC1 = WS_WUKV + (size_t)2 * 768 * 256 * 2;
constexpr size_t WS_WC2 = WS_WC1 + (size_t)2 * 2 * 64 * 2048 * 2;
constexpr size_t WS_WR = WS_WC2 + (size_t)2 * 2 * 64 * 64 * 2;
constexpr size_t WS_B1C = WS_WR + (size_t)2 * 64 * 1024 * 2;
constexpr size_t WS_BIASD = WS_B1C + 1024;
constexpr size_t WS_ROPE = WS_BIASD + 6 * 2048 * 4;
constexpr size_t WS_WMOE = WS_ROPE + (size_t)16384 * 32 * 4;
constexpr size_t WMOE_WD = (size_t)32 * 512 * 1024 * 2;
constexpr size_t WS_XB = WS_WMOE + 50331648;
constexpr size_t WS_MLA = WS_XB + 33554432;
constexpr size_t MLA_KM = (size_t)8 * 6 * 2048 * 96 * 2, MLA_VM = 2 * MLA_KM;
constexpr size_t WS_HBUF = WS_MLA;
constexpr size_t WS_PRJ = WS_MLA + 50331648;
constexpr size_t HM64 = (size_t)2048 * 64 * 2;
constexpr size_t PRJ_QN = 0;
constexpr size_t PRJ_KN1 = PRJ_QN + 48 * HM64, PRJ_VN1 = PRJ_KN1 + 16 * HM64, PRJ_KN2 = PRJ_VN1 + 16 * HM64, PRJ_VN2 = PRJ_KN2 + 16 * HM64;
constexpr size_t PRJ_VML = PRJ_VN2 + 16 * HM64;
constexpr size_t PRJ_OG = PRJ_VML + 32 * HM64;
constexpr size_t PRJ_KR = PRJ_OG + (size_t)16384 * 256 * 2;
constexpr size_t PRJ_GATES = PRJ_KR + (size_t)16384 * 32 * 2;
constexpr size_t PRJ_DEAD = PRJ_GATES + (size_t)16384 * 32 * 4;
constexpr size_t PRJ_C0K = PRJ_DEAD, PRJ_C0V = PRJ_C0K + 16 * HM64 + 8192;
constexpr size_t PRJ_RAWQK = PRJ_C0V + 16 * HM64 + 8192;
constexpr size_t PRJ_DQKV = PRJ_RAWQK + (size_t)16384 * 512 * 2;
constexpr size_t PRJ_END = PRJ_DQKV + (size_t)16384 * 384 * 2;
static_assert(PRJ_END - PRJ_DEAD >= 33554432, "Y fits the dead part of PRJ");
constexpr size_t WS_Y = WS_PRJ + PRJ_DEAD;
constexpr size_t WS_YBUF = WS_PRJ;
static_assert((size_t)2 * 16384 * 1024 * 2 <= PRJ_END, "YBUF fits the PRJ region");
constexpr size_t WS_ML = WS_PRJ + PRJ_END;
constexpr size_t ML_KC = 32 * HM64, ML_DELTA = 2 * ML_KC, ML_DN = ML_DELTA + (size_t)1024 * 4096 * 2, ML_G = ML_DN + (size_t)1024 * 64 * 4, ML_BL = ML_G + (size_t)8 * 4 * 2048 * 2 * 4, ML_CP = ML_BL + 4096, ML_NP = ML_CP + (size_t)1024 * 4096 * 2, ML_END = ML_NP + (size_t)1024 * 64 * 2;
constexpr size_t WS_CMP = WS_ML + ML_END;
constexpr size_t CMP_V = (size_t)8 * 2 * 128 * 64 * 2;
constexpr size_t WS_META = WS_CMP + 2 * CMP_V;
constexpr size_t META_W = (size_t)32 * 16384 * 4, META_RT = 2 * META_W;
constexpr size_t WS_END = WS_META + META_RT + (size_t)16384 * 16;
constexpr int CW_BAR = 0;
constexpr int CW_Q = 4096;
constexpr int CW_SCAN = 4608;
constexpr int CW_TS = 4864;
constexpr int CW_CHK = 5120;
constexpr int CW_CNT = 8192;
constexpr int LDS_BYTES = 147456;
constexpr int LDS_MISC = LDS_BYTES - 256;
#define XB_TMO      128
#define XB_XCNT(j)  (256  + 64 * (j))
#define XB_XSUB(j)  (1280 + 64 * (j))
#define XB_XGEN(j)  (2304 + 64 * (j))
#define XB_TOP      3328
#define XB_TOPGEN   3392
#define XCD_BAR_WORDS 3456
#define XB_SPIN_CAP (1u << 18)

__device__ __forceinline__ unsigned xb_ld(unsigned* p)              { return __hip_atomic_load(p, __ATOMIC_RELAXED, __HIP_MEMORY_SCOPE_AGENT); }
__device__ __forceinline__ unsigned xb_add(unsigned* p, unsigned v) { return __hip_atomic_fetch_add(p, v, __ATOMIC_RELAXED, __HIP_MEMORY_SCOPE_AGENT); }
__device__ __forceinline__ unsigned xb_xcc_id() { return (unsigned)__builtin_amdgcn_s_getreg((3 << 11) | 20) & 0xFu; }
#define XB_SPIN(cond, bar) do { unsigned _sp = 0; while (cond) { __builtin_amdgcn_s_sleep(1); \
    if ((++_sp & 255u) == 0u) { if (xb_ld(&(bar)[XB_TMO])) break; if (_sp > XB_SPIN_CAP) { atomicAdd(&(bar)[XB_TMO], 1u); break; } } } } while (0)

struct XcdBarrier {
    int g_wv; unsigned* bar; unsigned x;
    volatile LAS unsigned* st;
};

__device__ __forceinline__ XcdBarrier xcd_barrier_post(unsigned* bar, volatile LAS unsigned* st, int g_wv) {
    XcdBarrier b; b.g_wv = g_wv; b.bar = bar; b.x = xb_xcc_id(); b.st = st;
    if (TIDX == 0) (void)xb_add(&bar[XB_XCNT(b.x)], 1u);
    return b;
}
__device__ __forceinline__ void xcd_barrier_complete(unsigned* bar, unsigned x, unsigned& nloc, unsigned& nx) {
    const unsigned G = gridDim.x * gridDim.y * gridDim.z;
    unsigned sum, cnt, mine, sp = 0u;
    for (;;) {
        sum = 0u; cnt = 0u; mine = 0u;
#pragma unroll
        for (unsigned j = 0; j < 16; ++j) { const unsigned c = xb_ld(&bar[XB_XCNT(j)]); sum += c; cnt += (c > 0u) ? 1u : 0u; mine = (j == x) ? c : mine; }
        if (sum == G) break;
        __builtin_amdgcn_s_sleep(1);
        if ((++sp & 255u) == 0u) { if (xb_ld(&bar[XB_TMO])) break; if (sp > XB_SPIN_CAP) { atomicAdd(&bar[XB_TMO], 1u); break; } }
    }
    nloc = mine > 0u ? mine : 1u; nx = cnt > 0u ? cnt : 1u;
}

__device__ __forceinline__ void xcd_barrier(const XcdBarrier& b) {
    asm volatile("s_waitcnt vmcnt(0)" ::: "memory");
    __syncthreads();
    const int g_wv = b.g_wv;
    if (TIDX == 0) {
        unsigned* bar = b.bar;
        __builtin_amdgcn_s_waitcnt(0);
        unsigned nloc = b.st[0], nx = b.st[1];
        if (nloc == 0u) { xcd_barrier_complete(bar, b.x, nloc, nx); b.st[0] = nloc; b.st[1] = nx; }
        const unsigned old = xb_add(&bar[XB_XSUB(b.x)], 1u);
        const unsigned gen = old / nloc;
        if (old + 1u == (gen + 1u) * nloc) {
            __builtin_amdgcn_fence(__ATOMIC_RELEASE, "agent");
            asm volatile("s_waitcnt vmcnt(0)" ::: "memory");
            const unsigned og = xb_add(&bar[XB_TOP], 1u);
            const unsigned tg = og / nx;
            if (og + 1u == (tg + 1u) * nx) xb_add(&bar[XB_TOPGEN], 1u);
            else XB_SPIN(xb_ld(&bar[XB_TOPGEN]) == tg, bar);
            __builtin_amdgcn_fence(__ATOMIC_ACQUIRE, "agent");
            xb_add(&bar[XB_XGEN(b.x)], 1u);
            asm volatile("s_waitcnt vmcnt(0)" ::: "memory");
        } else {
            XB_SPIN(xb_ld(&bar[XB_XGEN(b.x)]) == gen, bar);
            __builtin_amdgcn_fence(__ATOMIC_ACQUIRE, "agent");
            asm volatile("s_waitcnt vmcnt(0)" ::: "memory");
        }
    }
    __syncthreads();
}
struct Inputs { const float* p[30]; };
typedef const __attribute__((address_space(4))) Inputs* InPtr;
__device__ __forceinline__ InPtr in_tab() { InPtr p = (InPtr)__builtin_amdgcn_kernarg_segment_ptr(); asm volatile("" : "+s"(p)); return p; }
__device__ __forceinline__ unsigned char* launder(unsigned char* p) { size_t z = 0; asm volatile("" : "+s"(z)); return p + z; }

__host__ __device__ inline int inproj_refcol(int G, int e) {
    if (G < 6) return O_AQ + G * 64 + e;
    if (G < 18) return O_AKV + (G - 6) * 64 + e;
    if (G < 26) return O_BQK + (G - 18) * 64 + e;
    if (G < 30) return O_BV + (G - 26) * 64 + e;
    if (G < 34) return O_BO + (G - 30) * 64 + e;
    if (G < 37) return O_CDQ + (G - 34) * 64 + e;
    if (G == 37) { if (e < 32) return O_CKR + e; if (e < 50) return O_AG + (e - 32); if (e < 58) return O_BIF + (e - 50); return -1; }
    return O_CDKV + (G - 38) * 64 + e;
}
__host__ __device__ inline int uq_refcol(int G, int e) {
    if (G < 6) return G * 96 + e;
    if (G < 9) { const int idx = e & 31, bj = e >> 5, sub = idx >> 4, i = idx & 15; return (2 * (G - 6) + sub) * 96 + 64 + bj * 16 + i; }
    return -1;
}
__host__ __device__ inline int ukv_refcol(int G, int e) { return G < 6 ? G * 128 + e : (G - 6) * 128 + 64 + e; }
#define N2G(n) ((((n) >> 8) << 2) + (((n) >> 5) & 3))
#define N2E(n) (((((n) >> 7) & 1) << 5) + ((n) & 31))

__device__ __forceinline__ float opaque_f(float v) { asm volatile("" : "+v"(v)); return v; }
struct FWin { const float* w; const float* g; __device__ __forceinline__ void ld(int k, int n, const float*& p, float& gn, float gk) const { const int c = inproj_refcol(N2G(n), N2E(n)); p = w + (size_t)k * DIN + (c < 0 ? 0 : c); gn = c < 0 ? 0.f : gk; }
    __device__ __forceinline__ float rowgain(int k) const { return opaque_f(g[k]); } };
struct FWout { const float* w; const float* ga; const float* gc; __device__ __forceinline__ void ld(int k, int n, const float*& p, float& gn, float gk) const {
    const int kr = k < 384 ? k : (k < 768 ? 640 + (k - 384) : 384 + (k - 768)); p = w + (size_t)kr * 1024 + n; gn = gk; }
    __device__ __forceinline__ float rowgain(int k) const { const float a = opaque_f(ga[k < 384 ? k : 0]), c = opaque_f(gc[(k >= 384 && k < 768) ? k - 384 : 0]); return k < 384 ? a : (k < 768 ? c : 1.f); } };
struct FWuq { const float* w; const float* g; __device__ __forceinline__ void ld(int k, int n, const float*& p, float& gn, float gk) const { const int c = uq_refcol(N2G(n), N2E(n)); const int kk = k < 192 ? k : 191; p = w + (size_t)kk * 576 + (c < 0 ? 0 : c); gn = (k < 192 && c >= 0) ? gk : 0.f; }
    __device__ __forceinline__ float rowgain(int k) const { return opaque_f(g[k < 192 ? k : 191]); } };
struct FWukv { const float* w; const float* g; __device__ __forceinline__ void ld(int k, int n, const float*& p, float& gn, float gk) const { const int c = ukv_refcol(N2G(n), N2E(n)); const int kk = k >= 128 ? k - 128 : 0; p = w + (size_t)kk * 768 + c; gn = k >= 128 ? gk : 0.f; }
    __device__ __forceinline__ float rowgain(int k) const { return opaque_f(g[k >= 128 ? k - 128 : 0]); } };
struct FWc1 { const float* w; __device__ __forceinline__ void ld(int k, int n, const float*& p, float& gn, float gk) const { p = w + (size_t)k * 64 + n; gn = 1.f; }
    __device__ __forceinline__ float rowgain(int k) const { return 1.f; } };
struct FWr { const float* wg; const float* we; const float* g; __device__ __forceinline__ void ld(int k, int n, const float*& p, float& gn, float gk) const { p = n < 4 ? wg + k * 4 + n : we + k * 32 + (n < 36 ? n - 4 : 0); gn = n < 36 ? gk : 0.f; }
    __device__ __forceinline__ float rowgain(int k) const { return opaque_f(g[k]); } };
struct FWgu { const float* src; const float* g; int n0, col0; __device__ __forceinline__ float operator()(int k, int n) const { return src[(size_t)k * 256 + col0 + (n - n0)] * g[k]; } };
struct FWd { const float* w; __device__ __forceinline__ float operator()(int k, int n) const { return w[(size_t)k * 1024 + n]; } };

__device__ __forceinline__ void rope_cs(int pos, int j, float& cs, float& sn) {
    const double inv = exp2(-(double)j * (13.287712379549449 / 16.0));
    const double rev = (double)pos * inv * 0.15915494309189535; const float f = (float)(rev - rint(rev));
    cs = __builtin_amdgcn_cosf(f); sn = __builtin_amdgcn_sinf(f);
}
template <class F>
__device__ __forceinline__ void cvt_tile(const F& f, int n0, int k0, bf16_t* dst, int ldk, LAS float* tile, int tid) {
    { const int k = tid >> 3, nb = (tid & 7) * 8; const float gk = f.rowgain(k0 + k); const float* p[8]; float gn[8], v[8];
#pragma unroll
      for (int j = 0; j < 8; ++j) f.ld(k0 + k, n0 + nb + j, p[j], gn[j], gk);
#pragma unroll
      for (int j = 0; j < 8; ++j) v[j] = *p[j];
#pragma unroll
      for (int j = 0; j < 8; ++j) tile[k * 65 + nb + j] = v[j] * gn[j]; }
    __syncthreads();
    { const int n = tid >> 3, kb = (tid & 7) * 8; const LAS float* s = tile + kb * 65 + n;
      u32x4 o; o.x = pk_bf16(s[0], s[65]); o.y = pk_bf16(s[130], s[195]); o.z = pk_bf16(s[260], s[325]); o.w = pk_bf16(s[390], s[455]);
      *(u32x4*)(dst + (size_t)(n0 + n) * ldk + k0 + kb) = o; }
    __syncthreads();
}
template <class F>
__device__ __forceinline__ void cvt_item(const F& f, int it, int nK, bf16_t* dst, int ldk, LAS float* tile, int tid) { cvt_tile(f, (it / nK) * 64, (it % nK) * 64, dst, ldk, tile, tid); }

__device__ __forceinline__ void moe_item(InPtr in, int l, int it, const float*& src, int& ld, size_t& dst, int& ldk, bool& gain, int& kk0) {
    if (it < 32 * 64) { const int e = it >> 6, r = it & 63, n0 = (r >> 3) * 64, k0 = (r & 7) * 128, c0 = n0 & 255;
        src = (c0 < 128 ? in->p[27] : in->p[28]) + ((size_t)l * 32 + e) * 262144 + (size_t)k0 * 256 + (n0 >> 8) * 128 + (c0 & 127); ld = 256; gain = true; kk0 = k0;
        dst = ((size_t)e * 512 + n0) * 1024 + k0; ldk = 1024; }
    else { const int j = it - 32 * 64, e = j >> 5, r = j & 31, n0 = (r >> 1) * 64, k0 = (r & 1) * 128;
        src = in->p[29] + ((size_t)l * 32 + e) * 262144 + (size_t)k0 * 1024 + n0; ld = 1024; gain = false; kk0 = 0;
        dst = (size_t)16777216 + ((size_t)e * 1024 + n0) * 256 + k0; ldk = 256; }
}
__device__ __forceinline__ void cvt_moe_layer(InPtr in, unsigned char* ws, int l, LAS float* tile, int bid, int nb, int tid, int it_lo = 0, int it_hi = 32 * (64 + 32)) {
    asm volatile("" : "+v"(tid));
    const float* g2 = in->p[22] + l * 1024; bf16_t* W = (bf16_t*)(ws + WS_WMOE);
    const int k = tid >> 3, nbq = (tid & 7) * 8;
    const int n = tid >> 3, kb = (tid & 7) * 8;
    const int NIT = it_hi;
#define CVM_LOAD(it_, P) do { const float* src_; int ld_, ldk_, kk0_; size_t dst_; bool gain_; moe_item(in, l, (it_), src_, ld_, dst_, ldk_, gain_, kk0_); \
        P##a = *(const f32x4*)(src_ + (size_t)k * ld_ + nbq); P##b = *(const f32x4*)(src_ + (size_t)k * ld_ + nbq + 4); P##c = *(const f32x4*)(src_ + (size_t)(k + 64) * ld_ + nbq); P##d = *(const f32x4*)(src_ + (size_t)(k + 64) * ld_ + nbq + 4); \
        P##g0 = gain_ ? g2[kk0_ + k] : 1.f; P##g1 = gain_ ? g2[kk0_ + 64 + k] : 1.f; } while (0)
#define CVM_PUT(t, P) do { \
        t[k * 65 + nbq + 0] = P##a.x * P##g0; t[k * 65 + nbq + 1] = P##a.y * P##g0; t[k * 65 + nbq + 2] = P##a.z * P##g0; t[k * 65 + nbq + 3] = P##a.w * P##g0; \
        t[k * 65 + nbq + 4] = P##b.x * P##g0; t[k * 65 + nbq + 5] = P##b.y * P##g0; t[k * 65 + nbq + 6] = P##b.z * P##g0; t[k * 65 + nbq + 7] = P##b.w * P##g0; \
        t[(k + 64) * 65 + nbq + 0] = P##c.x * P##g1; t[(k + 64) * 65 + nbq + 1] = P##c.y * P##g1; t[(k + 64) * 65 + nbq + 2] = P##c.z * P##g1; t[(k + 64) * 65 + nbq + 3] = P##c.w * P##g1; \
        t[(k + 64) * 65 + nbq + 4] = P##d.x * P##g1; t[(k + 64) * 65 + nbq + 5] = P##d.y * P##g1; t[(k + 64) * 65 + nbq + 6] = P##d.z * P##g1; t[(k + 64) * 65 + nbq + 7] = P##d.w * P##g1; } while (0)
#define CVM_STORE(it_, t) do { const float* src_; int ld_, ldk_, kk0_; size_t dst_; bool gain_; moe_item(in, l, (it_), src_, ld_, dst_, ldk_, gain_, kk0_); \
        _Pragma("unroll") for (int hh = 0; hh < 2; ++hh) { const LAS float* s_ = t + (64 * hh + kb) * 65 + n; \
            u32x4 o; o.x = pk_bf16(s_[0], s_[65]); o.y = pk_bf16(s_[130], s_[195]); o.z = pk_bf16(s_[260], s_[325]); o.w = pk_bf16(s_[390], s_[455]); \
            *(u32x4*)(W + dst_ + (size_t)n * ldk_ + 64 * hh + kb) = o; } } while (0)
    f32x4 Aa, Ab, Ac, Ad, Ba, Bb, Bc, Bd; float Ag0 = 1.f, Ag1 = 1.f, Bg0 = 1.f, Bg1 = 1.f;
    LAS float* t0 = tile; LAS float* t1 = tile + 128 * 65;
    int it = it_lo + bid;
    if (it < NIT) CVM_LOAD(it, A);
    if (it + nb < NIT) CVM_LOAD(it + nb, B);
#pragma unroll 1
    for (; it < NIT; it += 2 * nb) {
        CVM_PUT(t0, A);
        __syncthreads();
        if (it + 2 * nb < NIT) CVM_LOAD(it + 2 * nb, A);
        CVM_STORE(it, t0);
        if (it + nb < NIT) {
            CVM_PUT(t1, B);
            __syncthreads();
            if (it + 3 * nb < NIT) CVM_LOAD(it + 3 * nb, B);
            CVM_STORE(it + nb, t1);
        }
    }
#undef CVM_LOAD
#undef CVM_PUT
#undef CVM_STORE
    __syncthreads();
}

__device__ __forceinline__ void cvt_small_weights(InPtr in, unsigned char* ws, int l, LAS float* tile, int bid, int nb, int tid) {
    asm volatile("" : "+v"(tid));
    constexpr int I_WIN = 40 * 16, I_WOUT = 16 * 16, I_WU = 12 * 4, I_WC1 = 32, I_WC2 = 1, I_WR = 16;
    constexpr int PER_L = I_WIN + I_WOUT + 2 * I_WU + 2 * I_WC1 + 2 * I_WC2 + I_WR;
    for (int it0 = bid; it0 < PER_L; it0 += nb) {
        int it = it0;
        if (it < I_WIN) { FWin f{in->p[4] + (size_t)l * 1024 * DIN, in->p[3] + l * 1024}; cvt_item(f, it, 16, (bf16_t*)(ws + WS_WIN) + (size_t)l * 2560 * 1024, 1024, tile, tid); continue; } it -= I_WIN;
        if (it < I_WOUT) { FWout f{in->p[21] + (size_t)l * 1048576, in->p[10] + l * 384, in->p[20] + l * 384}; cvt_item(f, it, 16, (bf16_t*)(ws + WS_WOUT) + (size_t)l * 1048576, 1024, tile, tid); continue; } it -= I_WOUT;
        if (it < I_WU) { FWuq f{in->p[16] + (size_t)l * 192 * 576, in->p[15] + l * 192}; cvt_item(f, it, 4, (bf16_t*)(ws + WS_WUQ) + (size_t)l * 768 * 256, 256, tile, tid); continue; } it -= I_WU;
        if (it < I_WU) { FWukv f{in->p[18] + (size_t)l * 128 * 768, in->p[17] + l * 128}; cvt_item(f, it, 4, (bf16_t*)(ws + WS_WUKV) + (size_t)l * 768 * 256, 256, tile, tid); continue; } it -= I_WU;
        if (it < 2 * I_WC1) { const int s = it / I_WC1; FWc1 f{in->p[6] + ((size_t)l * 2 + s) * 2048 * 64}; cvt_item(f, it % I_WC1, 32, (bf16_t*)(ws + WS_WC1) + ((size_t)l * 2 + s) * 64 * 2048, 2048, tile, tid); continue; } it -= 2 * I_WC1;
        if (it < 2 * I_WC2) { const int s = it; FWc1 f{in->p[7] + ((size_t)l * 2 + s) * 64 * 64}; cvt_item(f, 0, 1, (bf16_t*)(ws + WS_WC2) + ((size_t)l * 2 + s) * 64 * 64, 64, tile, tid); continue; } it -= 2 * I_WC2;
        { FWr f{in->p[23] + (size_t)l * 4096, in->p[25] + (size_t)l * 32768, in->p[22] + l * 1024}; cvt_item(f, it, 16, (bf16_t*)(ws + WS_WR) + (size_t)l * 64 * 1024, 1024, tile, tid); }
    }
}

__device__ __forceinline__ void prologue(InPtr in, unsigned char* ws, LAS unsigned char* lds, int bid, int nb, int g_wv) {
    int tid_ = TIDX; asm volatile("" : "+v"(tid_));
    const int tid = tid_, lane = tid & 63, wid = tid >> 6;
    LAS float* tile = (LAS float*)lds;
    cvt_small_weights(in, ws, 0, tile, bid, nb, tid);
    { const float* x = in->p[0]; bf16_t* XB = (bf16_t*)(ws + WS_XB); float* ssqx = (float*)(ws + WS_SSQX);
      for (int r = bid * 8 + wid; r < NTOK; r += nb * 8) {
          const f32x4* xr = (const f32x4*)(x + (size_t)r * 1024) + lane; float s = 0.f; u32x2* o = (u32x2*)(XB + (size_t)r * 1024) + lane;
#pragma unroll
          for (int j = 0; j < 4; ++j) { const f32x4 v = xr[64 * j]; s += (v.x * v.x + v.y * v.y) + (v.z * v.z + v.w * v.w); u32x2 w; w.x = pk_bf16(v.x, v.y); w.y = pk_bf16(v.z, v.w); o[64 * j] = w; }
          s = wave_sum(s); if (lane == 0) ssqx[r] = s;
      } }
    { float* biasd = (float*)(ws + WS_BIASD); const float* rb = in->p[2];
      for (int i = bid * 512 + tid; i < 6 * 2048; i += nb * 512) { const int h = i >> 11, d = i & 2047; biasd[i] = rb[t5b(d) * 6 + h] * 1.44269504f; } }
    { float* rope = (float*)(ws + WS_ROPE); const int* pos = (const int*)in->p[1];
      for (int i = bid * 512 + tid; i < NTOK * 16; i += nb * 512) { const int tk = i >> 4, j = i & 15; float cs, sn; rope_cs(pos[tk], j, cs, sn); rope[(size_t)tk * 32 + j] = cs; rope[(size_t)tk * 32 + 16 + j] = sn; } }
    { float* b1c = (float*)(ws + WS_B1C); LAS float* red = (LAS float*)lds;
      for (int it = bid; it < 4; it += nb) { const float* pe = in->p[5] + (size_t)it * 2048; const float* w1 = in->p[6] + (size_t)it * 2048 * 64; const int f = tid & 63, part = tid >> 6;
          float a = 0.f; for (int k = part * 256; k < part * 256 + 256; ++k) a += pe[k] * w1[(size_t)k * 64 + f];
          __syncthreads(); red[tid] = a; __syncthreads();
          if (tid < 64) { float s = 0.f; for (int p2 = 0; p2 < 8; ++p2) s += red[p2 * 64 + tid]; b1c[it * 64 + tid] = s; }
          __syncthreads(); } }
}
namespace g8 {
constexpr int BM = 256, BK = 64, HALF = 128, HTB = HALF * BK * 2, STAGE_BYTES = 8 * HTB, NXCD = 8, WGM = 8;
__host__ __device__ __forceinline__ int lds_byte(int r, int c) { const int st = (r >> 4) * 2 + (c >> 5), rr = r & 15, cc = c & 31, ob = rr * 64 + cc * 2; return st * 1024 + (ob ^ (((ob >> 9) & 1) << 5)); }
__host__ __device__ __forceinline__ void stage_rc(int b, int& R, int& C) { const int st = b / 1024, sb = b % 1024, swz = sb ^ (((sb >> 9) & 1) << 5); R = (st >> 1) * 16 + swz / 64; C = (st & 1) * 32 + (swz % 64) / 2; }
__host__ __device__ __forceinline__ int perm32(int rho) { const int n = rho >> 4, i = rho & 15; return 8 * (i >> 2) + 4 * n + (i & 3); }

struct GUnit { const char* a; const char* b; int pm, pn, e, rows; };

__device__ __forceinline__ bool static_unit(int i, int G, int c, int nM, int nN, int& pm, int& pn) {
    const int nwg = nM * nN; const long L = (long)i * G + c; if (L >= nwg) return false;
    int wgid = (int)L; { const int q = nwg / NXCD, r = nwg % NXCD, xcd = wgid % NXCD, off = wgid / NXCD; wgid = (xcd < r ? xcd * (q + 1) : r * (q + 1) + (xcd - r) * q) + off; }
    const int nig = WGM * nN, gid = wgid / nig, fm = gid * WGM, gsz = (nM - fm) < WGM ? (nM - fm) : WGM;
    pm = fm + ((wgid % nig) % gsz); pn = (wgid % nig) / gsz; return true;
}
struct DenseSched {
    static constexpr bool GATHER = false, PARTIAL = false;
    const char* A; const char* Bt; int lda, ldb, nM, nN, G, c;
    __device__ __forceinline__ bool next(int i, GUnit& u) const {
        int pm, pn; if (!static_unit(i, G, c, nM, nN, pm, pn)) return false;
        u.pm = pm; u.pn = pn; u.e = 0; u.rows = 256; u.a = A + (size_t)pm * 256 * lda * 2; u.b = Bt + (size_t)pn * 256 * ldb * 2; return true;
    }
    __device__ __forceinline__ void aoff(const GUnit&, unsigned (&v)[2][2], const int (&R)[2], const int (&C)[2]) const {
#pragma unroll
        for (int h = 0; h < 2; ++h)
#pragma unroll
            for (int i = 0; i < 2; ++i) v[h][i] = (unsigned)((h * 128 + R[i]) * lda + C[i]) * 2u;
    }
};

template <class Epi, class Sched>
__device__ __forceinline__ void gemm_run(LAS unsigned char* lds, const int K, const int ldb, const Sched& S, const Epi& E, int g_wv) {
    int tid_ = TIDX; asm volatile("" : "+v"(tid_));
    const int tid = tid_, wid = __builtin_amdgcn_readfirstlane(tid >> 6), lane = tid & 63, wr = wid >> 2, wc = wid & 3, fr = lane & 15, fq = lane >> 4;
    int nt_ = K / BK; asm volatile("" : "+s"(nt_));
    const int nt = nt_;
    int R[2], C[2]; unsigned voffB[2];
#pragma unroll
    for (int i = 0; i < 2; ++i) { stage_rc(tid * 16 + i * 8192, R[i], C[i]); const int Rb = (R[i] & ~31) + perm32(R[i] & 31); voffB[i] = (unsigned)(Rb * ldb + C[i]) * 2u; }
    const size_t kstep = (size_t)(BK * 2);
    const size_t hstepB = (size_t)HALF * ldb * 2;
    const unsigned ldsw = (unsigned)wid * 1024u;
    const int aoff = lds_byte(wr * 64 + fr, fq * 8), boff = lds_byte(wc * 32 + fr, fq * 8);
#define G8_SA(b, h) (((b) * 2 + (h)) * HTB)
#define G8_SB(b, h) ((4 + (b) * 2 + (h)) * HTB)
#define G8_GLDS(bufoff, gptr, i_) __builtin_amdgcn_global_load_lds((const unsigned*)(gptr), (LAS unsigned*)(lds + (bufoff) + ldsw + (i_) * 8192), 16, 0, 0)
#define G8_STAGE_B(bufoff, gbase) do { G8_GLDS(bufoff, (const char*)(gbase) + voffB[0], 0); G8_GLDS(bufoff, (const char*)(gbase) + voffB[1], 1); } while (0)
#define G8_STAGE_A(bufoff, gbase, v0, v1) do { G8_GLDS(bufoff, (const char*)(gbase) + (v0), 0); G8_GLDS(bufoff, (const char*)(gbase) + (v1), 1); } while (0)
#define G8_LDA(dst, b, h) do { _Pragma("unroll") for (int m = 0; m < 4; ++m) _Pragma("unroll") for (int k = 0; k < 2; ++k) dst[m][k] = *(const LAS bf16x8*)(lds + G8_SA(b, h) + aoff + m * 2048 + k * 1024); } while (0)
#define G8_LDB(dst, b, h) do { _Pragma("unroll") for (int n = 0; n < 2; ++n) _Pragma("unroll") for (int k = 0; k < 2; ++k) dst[n][k] = *(const LAS bf16x8*)(lds + G8_SB(b, h) + boff + n * 2048 + k * 1024); } while (0)
#define G8_MMA(ai, bj, At, Bt) do { __builtin_amdgcn_s_setprio(1); _Pragma("unroll") for (int m = 0; m < 4; ++m) { if (!PARTIAL || ((mmask >> ((ai) * 4 + m)) & 1u)) { _Pragma("unroll") for (int n = 0; n < 2; ++n) _Pragma("unroll") for (int k = 0; k < 2; ++k) \
        acc[ai][bj][m][n] = __builtin_amdgcn_mfma_f32_16x16x32_bf16(Bt[n][k], At[m][k], acc[ai][bj][m][n], 0, 0, 0); } } __builtin_amdgcn_s_setprio(0); } while (0)
#define G8_WAIT_V(n) asm volatile("s_waitcnt vmcnt(" #n ")" ::: "memory")
#define G8_WAIT_L(n) asm volatile("s_waitcnt lgkmcnt(" #n ")" ::: "memory")
#define G8_BAR __builtin_amdgcn_s_barrier()
#define G8_SCHED __builtin_amdgcn_sched_barrier(0)
    GUnit cur, nxt; int ui = 0;
    if (!S.next(0, cur)) return;
    constexpr bool GATHER = Sched::GATHER, PARTIAL = Sched::PARTIAL;
    unsigned mmask = 0xffu;
#define G8_MASK(u) do { if (PARTIAL) { mmask = 0u; _Pragma("unroll") for (int q_ = 0; q_ < 8; ++q_) mmask |= (((q_ >> 2) * 128 + wr * 64 + (q_ & 3) * 16) < (u).rows) ? (1u << q_) : 0u; } } while (0)
    unsigned vc[2][2];
    S.aoff(cur, vc, R, C); G8_MASK(cur);
    LAS u32x4* stash = (LAS u32x4*)(lds + STAGE_BYTES + 4096) + tid;
    f32x4 acc[2][2][4][2];
#pragma unroll
    for (int a = 0; a < 2; ++a)
#pragma unroll
        for (int b = 0; b < 2; ++b)
#pragma unroll
            for (int m = 0; m < 4; ++m)
#pragma unroll
                for (int n = 0; n < 2; ++n) acc[a][b][m][n] = (f32x4){0.f, 0.f, 0.f, 0.f};
    bf16x8 At[4][2], B0[2][2], B1[2][2];
    const char* cA = cur.a; const char* cB = cur.b;
    G8_STAGE_B(G8_SB(0, 0), cB); G8_STAGE_B(G8_SB(0, 1), cB + hstepB); G8_STAGE_A(G8_SA(0, 0), cA, vc[0][0], vc[0][1]); G8_STAGE_A(G8_SA(0, 1), cA, vc[1][0], vc[1][1]);
    if (wr == 1) G8_BAR;
    G8_WAIT_V(2); G8_BAR;
    G8_STAGE_B(G8_SB(1, 0), cB + kstep); G8_STAGE_A(G8_SA(1, 0), cA + kstep, vc[0][0], vc[0][1]); G8_STAGE_B(G8_SB(1, 1), cB + hstepB + kstep);
    G8_WAIT_V(6); G8_BAR;
    for (;;) {
        const bool has_next = S.next(ui + 1, nxt);
        if (GATHER) { unsigned vn[2][2];
            if (has_next) S.aoff(nxt, vn, R, C);
            else { vn[0][0] = vc[0][0]; vn[0][1] = vc[0][1]; vn[1][0] = vc[1][0]; vn[1][1] = vc[1][1]; }
            u32x4 sv; sv.x = vn[0][0]; sv.y = vn[0][1]; sv.z = vn[1][0]; sv.w = vn[1][1]; *stash = sv; }
        const char* nA = has_next ? nxt.a : cA; const char* nB = has_next ? nxt.b : cB;
#pragma unroll 1
        for (int seg = 0; seg < (Epi::KHOOK ? 3 : 1); ++seg) {
        const int tlo = Epi::KHOOK ? 6 * seg : 0, thi = Epi::KHOOK ? (seg == 2 ? nt : 6 * seg + 6) : nt;
#pragma unroll 1
        for (int t = tlo; t < thi; t += 2) {
            const bool last = (t == nt - 2);
            const char* a1 = cA + (size_t)(t + 1) * kstep;
            const char* a2 = last ? nA : cA + (size_t)(t + 2) * kstep; const char* b2 = last ? nB : cB + (size_t)(t + 2) * kstep;
            const char* a3 = a2 + kstep; const char* b3 = b2 + kstep;
            unsigned w00 = vc[0][0], w01 = vc[0][1], w10 = vc[1][0], w11 = vc[1][1];
            if (GATHER) { if (last) { const u32x4 sv = *stash; w00 = sv.x; w01 = sv.y; w10 = sv.z; w11 = sv.w; } }
            G8_LDB(B0, 0, 0); G8_LDB(B1, 0, 1); G8_SCHED; G8_LDA(At, 0, 0); G8_STAGE_A(G8_SA(1, 1), a1, vc[1][0], vc[1][1]);
            G8_WAIT_V(8); G8_WAIT_L(0); G8_BAR; G8_MMA(0, 0, At, B0); G8_MMA(0, 1, At, B1); G8_BAR; G8_SCHED;
            G8_LDA(At, 0, 1); G8_STAGE_B(G8_SB(0, 0), b2); G8_STAGE_B(G8_SB(0, 1), b2 + hstepB); G8_STAGE_A(G8_SA(0, 0), a2, w00, w01);
            G8_WAIT_V(8); G8_WAIT_L(0); G8_BAR; G8_MMA(1, 0, At, B0); G8_MMA(1, 1, At, B1); G8_BAR; G8_SCHED;
            G8_LDB(B0, 1, 0); G8_LDB(B1, 1, 1); G8_SCHED; G8_LDA(At, 1, 0); G8_STAGE_A(G8_SA(0, 1), a2, w10, w11);
            G8_WAIT_V(8); G8_WAIT_L(0); G8_BAR; G8_MMA(0, 0, At, B0); G8_MMA(0, 1, At, B1); G8_BAR; G8_SCHED;
            G8_LDA(At, 1, 1); G8_STAGE_B(G8_SB(1, 0), b3); G8_STAGE_B(G8_SB(1, 1), b3 + hstepB); G8_STAGE_A(G8_SA(1, 0), a3, w00, w01);
            G8_WAIT_V(8); G8_WAIT_L(0); G8_BAR; G8_MMA(1, 0, At, B0); G8_MMA(1, 1, At, B1); G8_BAR; G8_SCHED;
        }
        if constexpr (Epi::KHOOK) { if (seg < 2) E.kscale(acc, seg, wr, fr); }
        }
        if (wr == 0) G8_BAR;
        { int fr_ = fr, fq_ = fq; asm volatile("" : "+v"(fr_), "+v"(fq_));
          E(acc, cur, wr, wc, fr_, fq_); }
        if (!has_next) break;
#pragma unroll
        for (int a = 0; a < 2; ++a)
#pragma unroll
            for (int b = 0; b < 2; ++b)
#pragma unroll
                for (int m = 0; m < 4; ++m)
#pragma unroll
                    for (int n = 0; n < 2; ++n) acc[a][b][m][n] = (f32x4){0.f, 0.f, 0.f, 0.f};
        cur = nxt; cA = nA; cB = nB; ++ui; G8_MASK(cur);
        if (GATHER) { const u32x4 sv = *stash; vc[0][0] = sv.x; vc[0][1] = sv.y; vc[1][0] = sv.z; vc[1][1] = sv.w; }
        if (wr == 1) G8_BAR;
    }
    G8_WAIT_V(0);
    G8_BAR;
#undef G8_SA
#undef G8_SB
#undef G8_GLDS
#undef G8_STAGE_A
#undef G8_STAGE_B
#undef G8_LDA
#undef G8_LDB
#undef G8_MMA
#undef G8_MASK
#undef G8_WAIT_V
#undef G8_WAIT_L
#undef G8_BAR
#undef G8_SCHED
}
}
using g8::GUnit;
__device__ __forceinline__ void st_bf16x8(bf16_t* p, const float (&v)[8]) { u32x4 w; w.x = pk_bf16(v[0], v[1]); w.y = pk_bf16(v[2], v[3]); w.z = pk_bf16(v[4], v[5]); w.w = pk_bf16(v[6], v[7]); *(u32x4*)p = w; }
__device__ __forceinline__ float quad_sum(float s) { s += shx<16>(s); s += __shfl_xor(s, 32); return s; }

struct EpiInProj {
    static constexpr bool KHOOK = false;
    const float* ssqx; float* part_dq; float* part_dkv; const float* qg; const float* kg; const float* krg; const float* rope;
    unsigned char* prj;
    __device__ __forceinline__ void operator()(const f32x4 (&acc)[2][2][4][2], const GUnit& u, int wr, int wc, int fr, int fq) const {
        const int G = u.pn * 4 + wc;
        const bool isq = G < 6; const int a = G - 6; const bool isk = (G >= 10 && G < 18 && ((a >> 1) & 1) == 0);
        const float* g0 = (isq ? qg : kg) + 8 * fq;
        float rs8[8];
#pragma unroll
        for (int k = 0; k < 8; ++k) rs8[k] = ssqx[u.pm * 256 + (k >> 2) * 128 + wr * 64 + (k & 3) * 16 + fr];
#pragma unroll
        for (int k = 0; k < 8; ++k) rs8[k] = rsqrtf(rs8[k] * (1.f / 1024.f) + 1e-6f);
#pragma unroll
        for (int ai = 0; ai < 2; ++ai)
#pragma unroll
            for (int m = 0; m < 4; ++m) {
                __builtin_amdgcn_sched_barrier(0);
                const int row = u.pm * 256 + ai * 128 + wr * 64 + m * 16 + fr; const int b = row >> 11, t = row & 2047;
                const float rs = rs8[ai * 4 + m];
                float v[2][8];
#pragma unroll
                for (int bj = 0; bj < 2; ++bj)
#pragma unroll
                    for (int n = 0; n < 2; ++n)
#pragma unroll
                        for (int j = 0; j < 4; ++j) v[bj][4 * n + j] = acc[ai][bj][m][n][j] * rs;
                float ss = 0.f;
#pragma unroll
                for (int bj = 0; bj < 2; ++bj)
#pragma unroll
                    for (int i = 0; i < 8; ++i) ss += v[bj][i] * v[bj][i];
                bf16_t* dst = nullptr; int bstride = 32;
                if (isq) {
                    ss = quad_sum(ss); const float sc = rsqrtf(ss * (1.f / 64.f) + 1e-6f) * 0.18033688f;
#pragma unroll
                    for (int i = 0; i < 8; ++i) { v[0][i] *= sc * g0[i]; v[1][i] *= sc * g0[32 + i]; }
                    dst = (bf16_t*)(prj + PRJ_QN) + ((size_t)(b * 6 + G) * 2048 + t) * 64;
                } else if (G < 18) {
                    const int br = a >> 2, s = (a >> 1) & 1, hk = a & 1;
                    if (br > 0 && s == 0) {
                        ss = quad_sum(ss); const float sc = rsqrtf(ss * (1.f / 64.f) + 1e-6f);
#pragma unroll
                        for (int i = 0; i < 8; ++i) { v[0][i] *= sc * g0[i]; v[1][i] *= sc * g0[32 + i]; }
                    }
                    const size_t base = br == 0 ? (s ? PRJ_C0V : PRJ_C0K) : (br == 1 ? (s ? PRJ_VN1 : PRJ_KN1) : (s ? PRJ_VN2 : PRJ_KN2));
                    dst = (bf16_t*)(prj + base) + ((size_t)(b * 2 + hk) * 2048 + t) * 64;
                } else if (G < 26) { dst = (bf16_t*)(prj + PRJ_RAWQK) + (size_t)row * 512 + (G - 18) * 64; }
                else if (G < 30) { dst = (bf16_t*)(prj + PRJ_VML) + ((size_t)(b * 4 + (G - 26)) * 2048 + t) * 64; }
                else if (G < 34) { dst = (bf16_t*)(prj + PRJ_OG) + (size_t)row * 256 + (G - 30) * 64; }
                else if (G < 37) { dst = (bf16_t*)(prj + PRJ_DQKV) + (size_t)row * 384 + (G - 34) * 64; ss = quad_sum(ss); if (fq == 0) part_dq[(size_t)row * 4 + (G - 34)] = ss; }
                else if (G == 37) {
                    dst = (bf16_t*)(prj + PRJ_DQKV) + (size_t)row * 384 + 192;
                    float* gt = (float*)(prj + PRJ_GATES) + (size_t)row * 32 + 8 * fq;
                    *(f32x4*)gt = (f32x4){v[1][0], v[1][1], v[1][2], v[1][3]}; *(f32x4*)(gt + 4) = (f32x4){v[1][4], v[1][5], v[1][6], v[1][7]};
                    float s0 = 0.f;
#pragma unroll
                    for (int i = 0; i < 8; ++i) s0 += v[0][i] * v[0][i];
                    s0 = quad_sum(s0); const float sc = rsqrtf(s0 * (1.f / 32.f) + 1e-6f);
                    const float* rp = rope + (size_t)row * 32 + ((8 * fq) & 15);
                    float kr[8];
#pragma unroll
                    for (int i = 0; i < 8; ++i) { const float val = v[0][i] * sc * krg[8 * fq + i]; const float oth = __shfl_xor(val, 32); const float cs = rp[i], sn = rp[16 + i]; kr[i] = fq < 2 ? val * cs - oth * sn : val * cs + oth * sn; }
                    st_bf16x8((bf16_t*)(prj + PRJ_KR) + (size_t)row * 32 + 8 * fq, kr);
                } else { dst = (bf16_t*)(prj + PRJ_DQKV) + (size_t)row * 384 + 256 + (G - 38) * 64; ss = quad_sum(ss); if (fq == 0) part_dkv[(size_t)row * 2 + (G - 38)] = ss; }
                st_bf16x8(dst + 8 * fq, v[0]); st_bf16x8(dst + bstride + 8 * fq, v[1]);
            }
    }
};

struct EpiUq {
    static constexpr bool KHOOK = false;
    const float* ssq_dq; const float* qkn; const float* rope; bf16_t* QM;
    __device__ __forceinline__ void operator()(const f32x4 (&acc)[2][2][4][2], const GUnit& u, int wr, int wc, int fr, int fq) const {
        const int G = u.pn * 4 + wc; if (G >= 9) return;
        const float scale = 0.14724444f;
        const float* g0 = G < 6 ? qkn + 8 * fq : qkn + 64 + 8 * (fq & 1); const float* g1 = G < 6 ? g0 + 32 : g0 + 16;
        float rs8[8];
#pragma unroll
        for (int k = 0; k < 8; ++k) { const f32x4 pq = *(const f32x4*)(ssq_dq + (size_t)(u.pm * 256 + (k >> 2) * 128 + wr * 64 + (k & 3) * 16 + fr) * 4); rs8[k] = (pq.x + pq.y) + pq.z; }
#pragma unroll
        for (int k = 0; k < 8; ++k) rs8[k] = rsqrtf(rs8[k] * (1.f / 192.f) + 1e-6f);
#pragma unroll
        for (int ai = 0; ai < 2; ++ai) {
#pragma unroll
            for (int m = 0; m < 4; ++m) {
                __builtin_amdgcn_sched_barrier(0);
                const int row = u.pm * 256 + ai * 128 + wr * 64 + m * 16 + fr; const int b = row >> 11, t = row & 2047;
                const float rs = rs8[ai * 4 + m];
                float v[2][8]; float ss = 0.f;
#pragma unroll
                for (int bj = 0; bj < 2; ++bj)
#pragma unroll
                    for (int n = 0; n < 2; ++n)
#pragma unroll
                        for (int j = 0; j < 4; ++j) { const float x = acc[ai][bj][m][n][j] * rs; v[bj][4 * n + j] = x; ss += x * x; }
                if (G < 6) ss = quad_sum(ss); else ss += shx<16>(ss);
                const float sc = rsqrtf(ss * (G < 6 ? 1.f / 64.f : 1.f / 32.f) + 1e-6f) * scale;
#pragma unroll
                for (int i = 0; i < 8; ++i) { v[0][i] *= sc * g0[i]; v[1][i] *= sc * g1[i]; }
                if (G < 6) {
                    bf16_t* dst = QM + ((size_t)(b * 6 + G) * 2048 + t) * 96;
                    st_bf16x8(dst + 8 * fq, v[0]); st_bf16x8(dst + 32 + 8 * fq, v[1]);
                } else {
                    const int i16 = 8 * (fq & 1); const int head = 2 * (G - 6) + (fq >> 1);
                    const float* rp = rope + (size_t)row * 32 + i16; float o1[8], o2[8];
#pragma unroll
                    for (int i = 0; i < 8; ++i) { const float cs = rp[i], sn = rp[16 + i]; o1[i] = v[0][i] * cs - v[1][i] * sn; o2[i] = v[1][i] * cs + v[0][i] * sn; }
                    bf16_t* dst = QM + ((size_t)(b * 6 + head) * 2048 + t) * 96 + 64 + i16;
                    st_bf16x8(dst, o1); st_bf16x8(dst + 16, o2);
                }
            }
        }
    }
};
struct EpiUkv {
    static constexpr bool KHOOK = false;
    const float* ssq_dkv; const float* qkn; const bf16_t* KR; bf16_t* KM; bf16_t* VM;
    __device__ __forceinline__ void operator()(const f32x4 (&acc)[2][2][4][2], const GUnit& u, int wr, int wc, int fr, int fq) const {
        const int G = u.pn * 4 + wc;
        const float* g0 = qkn + 96 + 8 * fq;
        float rs8[8];
#pragma unroll
        for (int k = 0; k < 8; ++k) { const size_t rr = (size_t)(u.pm * 256 + (k >> 2) * 128 + wr * 64 + (k & 3) * 16 + fr); rs8[k] = ssq_dkv[rr * 2] + ssq_dkv[rr * 2 + 1]; }
#pragma unroll
        for (int k = 0; k < 8; ++k) rs8[k] = rsqrtf(rs8[k] * (1.f / 128.f) + 1e-6f);
#pragma unroll
        for (int ai = 0; ai < 2; ++ai) {
          u32x4 kr4[4];
          if (G < 6) {
#pragma unroll
              for (int m = 0; m < 4; ++m) kr4[m] = *(const u32x4*)(KR + (size_t)(u.pm * 256 + ai * 128 + wr * 64 + m * 16 + fr) * 32 + 8 * fq);
          }
#pragma unroll
            for (int m = 0; m < 4; ++m) {
                __builtin_amdgcn_sched_barrier(0);
                const int row = u.pm * 256 + ai * 128 + wr * 64 + m * 16 + fr; const int b = row >> 11, t = row & 2047;
                const float rs = rs8[ai * 4 + m];
                float v[2][8]; float ss = 0.f;
#pragma unroll
                for (int bj = 0; bj < 2; ++bj)
#pragma unroll
                    for (int n = 0; n < 2; ++n)
#pragma unroll
                        for (int j = 0; j < 4; ++j) { const float x = acc[ai][bj][m][n][j] * rs; v[bj][4 * n + j] = x; ss += x * x; }
                if (G < 6) {
                    ss = quad_sum(ss); const float sc = rsqrtf(ss * (1.f / 64.f) + 1e-6f);
#pragma unroll
                    for (int i = 0; i < 8; ++i) { v[0][i] *= sc * g0[i]; v[1][i] *= sc * g0[32 + i]; }
                    bf16_t* dst = KM + ((size_t)(b * 6 + G) * 2048 + t) * 96;
                    st_bf16x8(dst + 8 * fq, v[0]); st_bf16x8(dst + 32 + 8 * fq, v[1]);
                    *(u32x4*)(dst + 64 + 8 * fq) = kr4[m];
                } else {
                    bf16_t* dst = VM + ((size_t)(b * 6 + (G - 6)) * 2048 + t) * 64;
                    st_bf16x8(dst + 8 * fq, v[0]); st_bf16x8(dst + 32 + 8 * fq, v[1]);
                }
            }
        }
    }
};
#define MFMA16(a, b, c) __builtin_amdgcn_mfma_f32_16x16x32_bf16(a, b, c, 0, 0, 0)
#define MFMA32(a, b, c) __builtin_amdgcn_mfma_f32_32x32x16_bf16(a, b, c, 0, 0, 0)
#define LDS_FENCE() asm volatile("s_waitcnt lgkmcnt(0)" ::: "memory")

__device__ __forceinline__ void cmp_unit(int u, int l, InPtr in, unsigned char* ws, LAS unsigned char* lds, int g_wv) {
    int tid_ = TIDX; asm volatile("" : "+v"(tid_));
    const int tid = tid_, w = tid >> 6, lane = tid & 63, r = lane & 15, q = lane >> 4;
    const int b = u >> 2, s = (u >> 1) & 1, hk = u & 1;
    const bf16_t* A = (const bf16_t*)(ws + WS_PRJ + (s ? PRJ_C0V : PRJ_C0K)) + (size_t)(b * 2 + hk) * 2048 * 64;
    const bf16_t* W1 = (const bf16_t*)(ws + WS_WC1) + ((size_t)l * 2 + s) * 64 * 2048;
    const bf16_t* W2 = (const bf16_t*)(ws + WS_WC2) + ((size_t)l * 2 + s) * 64 * 64;
    const float* b1 = (const float*)(ws + WS_B1C) + (l * 2 + s) * 64;
    f32x4 acc[4];
#pragma unroll
    for (int nb = 0; nb < 4; ++nb) acc[nb] = (f32x4){0.f, 0.f, 0.f, 0.f};
    const bf16_t* ap = A + (size_t)(16 * w + r) * 1024 + 8 * q;
    constexpr int WP = 528, WBUF = 64 * WP; LAS unsigned char* wb = lds + 24576;
    u32x4 st[4];
#pragma unroll
    for (int i = 0; i < 4; ++i) { const int c = tid + 512 * i; st[i] = *(const u32x4*)(W1 + (size_t)(c >> 5) * 2048 + (c & 31) * 8); }
    bf16x8 af[8], afn[8];
#pragma unroll
    for (int ks = 0; ks < 8; ++ks) af[ks] = *(const bf16x8*)(ap + 32 * ks);
    const float* kg = in->p[9] + l * 64;
    float b1v[4], kgv[4]; bf16x8 w2f[2][4];
#pragma unroll
    for (int nb = 0; nb < 4; ++nb) { b1v[nb] = b1[16 * nb + r]; kgv[nb] = kg[16 * nb + r]; }
#pragma unroll
    for (int ks = 0; ks < 2; ++ks)
#pragma unroll
        for (int nb = 0; nb < 4; ++nb) w2f[ks][nb] = *(const bf16x8*)(W2 + (size_t)(16 * nb + r) * 64 + 32 * ks + 8 * q);
#pragma unroll
    for (int i = 0; i < 4; ++i) { const int c = tid + 512 * i; *(LAS u32x4*)(wb + (c >> 5) * WP + (c & 31) * 16) = st[i]; }
    __syncthreads();
    auto chunk = [&](const int kc, bf16x8 (&ac)[8], bf16x8 (&an)[8]) __attribute__((always_inline)) {
        const int cur = kc & 1;
        if (kc < 7) {
#pragma unroll
            for (int i = 0; i < 4; ++i) { const int c = tid + 512 * i; st[i] = *(const u32x4*)(W1 + (size_t)(c >> 5) * 2048 + (kc + 1) * 256 + (c & 31) * 8); }
#pragma unroll
            for (int ks = 0; ks < 8; ++ks) an[ks] = *(const bf16x8*)(ap + 256 * (kc + 1) + 32 * ks);
        }
#pragma unroll
        for (int ks = 0; ks < 8; ++ks)
#pragma unroll
            for (int nb = 0; nb < 4; ++nb) { const bf16x8 bb = *(const LAS bf16x8*)(wb + cur * WBUF + (16 * nb + r) * WP + (32 * ks + 8 * q) * 2); acc[nb] = MFMA16(ac[ks], bb, acc[nb]); }
        if (kc < 7) {
#pragma unroll
            for (int i = 0; i < 4; ++i) { const int c = tid + 512 * i; *(LAS u32x4*)(wb + (cur ^ 1) * WBUF + (c >> 5) * WP + (c & 31) * 16) = st[i]; }
        }
        __syncthreads();
    };
#pragma unroll 1
    for (int kc = 0; kc < 8; kc += 2) { chunk(kc, af, afn); chunk(kc + 1, afn, af); }
    LAS bf16_t* hl = (LAS bf16_t*)(lds + w * 2304);
#pragma unroll
    for (int nb = 0; nb < 4; ++nb) { const float bias = b1v[nb];
#pragma unroll
        for (int j = 0; j < 4; ++j) hl[(4 * q + j) * 72 + 16 * nb + r] = f2bf(siluf(acc[nb][j] + bias)); }
    LDS_FENCE();
    f32x4 o[4];
#pragma unroll
    for (int nb = 0; nb < 4; ++nb) o[nb] = (f32x4){0.f, 0.f, 0.f, 0.f};
#pragma unroll
    for (int ks = 0; ks < 2; ++ks) {
        const bf16x8 a = *(const LAS bf16x8*)(hl + r * 72 + 32 * ks + 8 * q);
#pragma unroll
        for (int nb = 0; nb < 4; ++nb) o[nb] = MFMA16(a, w2f[ks][nb], o[nb]);
    }
    LDS_FENCE();
    bf16_t* dst = (bf16_t*)(ws + WS_CMP + (s ? CMP_V : 0)) + (size_t)(b * 2 + hk) * 128 * 64;
#pragma unroll
    for (int j = 0; j < 4; ++j) {
        const int n = 16 * w + 4 * q + j; float ss = 0.f;
#pragma unroll
        for (int nb = 0; nb < 4; ++nb) ss += o[nb][j] * o[nb][j];
        ss += shx<1>(ss); ss += shx<2>(ss); ss += shx<4>(ss); ss += shx<8>(ss);
        const float sc = s == 0 ? rsqrtf(ss * (1.f / 64.f) + 1e-6f) : 1.f;
#pragma unroll
        for (int nb = 0; nb < 4; ++nb) { const int d = 16 * nb + r; const float v = o[nb][j] * sc * (s == 0 ? kgv[nb] : 1.f); dst[(size_t)n * 64 + d] = n < 127 ? f2bf(v) : (bf16_t)0; }
    }
}

__device__ __forceinline__ int swz_off(int row, int chunk) { return row * 128 + ((chunk ^ (row & 7)) << 4); }
__device__ __forceinline__ float log_sigmoid(float x) { return fminf(x, 0.f) - log1pf(__expf(-fabsf(x))); }
__device__ __forceinline__ void ml_delta_wave(int cu, int l, InPtr in, unsigned char* ws, LAS unsigned char* wl, int lane) {
    asm volatile("" : "+v"(lane));
    const int c = cu & 31, bh = cu >> 5, h = bh & 3, b = bh >> 2; const int t0 = c * 64; const size_t row0 = (size_t)b * 2048 + t0;
    const int cc = lane & 7, tg = lane >> 3;
    const bf16_t* raw = (const bf16_t*)(ws + WS_PRJ + PRJ_RAWQK); const float* cw = in->p[11] + (size_t)l * 4 * 512 + h * 64 + 8 * cc;
    u32x4 rq[11];
    const bool head0 = (c == 0 && tg == 0);
#pragma unroll
    for (int i = 0; i < 11; ++i) { const size_t rr = (head0 && i < 3) ? row0 : row0 + 8 * tg - 3 + i; rq[i] = *(const u32x4*)(raw + rr * 512 + h * 64 + 8 * cc); }
    __builtin_amdgcn_sched_barrier(0);
    const float* G = (const float*)(ws + WS_PRJ + PRJ_GATES);
    const float ip = G[(row0 + lane) * 32 + 18 + h] + in->p[12][l * 4 + h], fp = G[(row0 + lane) * 32 + 22 + h] + in->p[13][l * 4 + h];
    float bcum = log_sigmoid(fp);
#pragma unroll
    for (int o = 1; o < 64; o <<= 1) { const float t = __builtin_bit_cast(float, __builtin_amdgcn_ds_bpermute(((lane - o) & 63) << 2, __builtin_bit_cast(int, bcum))); if (lane >= o) bcum += t; }
    const float bL = __builtin_bit_cast(float, __builtin_amdgcn_readlane(__builtin_bit_cast(int, bcum), 63)); const float wgt = __expf(bL - bcum + ip);
    { float* mlg = (float*)(ws + WS_ML + ML_G) + ((size_t)bh * 2048 + t0 + lane) * 2; mlg[0] = bcum; mlg[1] = ip; if (lane == 0) ((float*)(ws + WS_ML + ML_BL))[cu] = bL; }
    float wt[8];
#pragma unroll
    for (int j = 0; j < 8; ++j) wt[j] = __builtin_bit_cast(float, __builtin_amdgcn_ds_bpermute((8 * tg + j) << 2, __builtin_bit_cast(int, wgt)));
    if (head0) {
#pragma unroll
        for (int i = 0; i < 3; ++i) rq[i] = (u32x4){0u, 0u, 0u, 0u}; }
#define MLD_E(v, e) (((e) & 1) ? bf_hi(((e) >> 1) == 0 ? (v).x : ((e) >> 1) == 1 ? (v).y : ((e) >> 1) == 2 ? (v).z : (v).w) : bf_lo(((e) >> 1) == 0 ? (v).x : ((e) >> 1) == 1 ? (v).y : ((e) >> 1) == 2 ? (v).z : (v).w))
    bf16_t* QC = (bf16_t*)(ws + WS_ML) + ((size_t)bh * 2048 + t0 + 8 * tg) * 64 + 8 * cc; bf16_t* KC = (bf16_t*)(ws + WS_ML + ML_KC) + ((size_t)bh * 2048 + t0 + 8 * tg) * 64 + 8 * cc;
    u32x4 rk[11], vv[8];
#pragma unroll
    for (int i = 0; i < 11; ++i) { const size_t rr = (head0 && i < 3) ? row0 : row0 + 8 * tg - 3 + i; rk[i] = *(const u32x4*)(raw + rr * 512 + h * 64 + 8 * cc + 256); }
    { const bf16_t* V = (const bf16_t*)(ws + WS_PRJ + PRJ_VML) + ((size_t)bh * 2048 + t0 + 8 * tg) * 64 + 8 * cc;
#pragma unroll
      for (int j = 0; j < 8; ++j) vv[j] = *(const u32x4*)(V + (size_t)j * 64); }
    if (head0) {
#pragma unroll
        for (int i = 0; i < 3; ++i) rk[i] = (u32x4){0u, 0u, 0u, 0u}; }
    __builtin_amdgcn_sched_barrier(0);
    {
        float w4[4][8];
#pragma unroll
        for (int tp = 0; tp < 4; ++tp) { const f32x4 a = *(const f32x4*)(cw + tp * 512), b4 = *(const f32x4*)(cw + tp * 512 + 4); w4[tp][0] = a.x; w4[tp][1] = a.y; w4[tp][2] = a.z; w4[tp][3] = a.w; w4[tp][4] = b4.x; w4[tp][5] = b4.y; w4[tp][6] = b4.z; w4[tp][7] = b4.w; }
#pragma unroll
        for (int j = 0; j < 8; ++j) { float o[8];
#pragma unroll
            for (int e = 0; e < 8; ++e) o[e] = siluf(w4[0][e] * MLD_E(rq[j], e) + w4[1][e] * MLD_E(rq[j + 1], e) + w4[2][e] * MLD_E(rq[j + 2], e) + w4[3][e] * MLD_E(rq[j + 3], e));
            u32x4 pk; pk.x = pk_bf16(o[0], o[1]); pk.y = pk_bf16(o[2], o[3]); pk.z = pk_bf16(o[4], o[5]); pk.w = pk_bf16(o[6], o[7]);
            *(u32x4*)(QC + (size_t)j * 64) = pk; }
    }
    float dn[8];
    {
        float w4[4][8];
#pragma unroll
        for (int tp = 0; tp < 4; ++tp) { const f32x4 a = *(const f32x4*)(cw + 256 + tp * 512), b4 = *(const f32x4*)(cw + 256 + tp * 512 + 4); w4[tp][0] = a.x; w4[tp][1] = a.y; w4[tp][2] = a.z; w4[tp][3] = a.w; w4[tp][4] = b4.x; w4[tp][5] = b4.y; w4[tp][6] = b4.z; w4[tp][7] = b4.w; }
#pragma unroll
        for (int e = 0; e < 8; ++e) dn[e] = 0.f;
#pragma unroll
        for (int j2 = 0; j2 < 4; ++j2) { float kb[2][8];
#pragma unroll
            for (int jj = 0; jj < 2; ++jj) { const int j = 2 * j2 + jj; float o[8];
#pragma unroll
                for (int e = 0; e < 8; ++e) o[e] = siluf(w4[0][e] * MLD_E(rk[j], e) + w4[1][e] * MLD_E(rk[j + 1], e) + w4[2][e] * MLD_E(rk[j + 2], e) + w4[3][e] * MLD_E(rk[j + 3], e)) * 0.125f;
                u32x4 pk; pk.x = pk_bf16(o[0], o[1]); pk.y = pk_bf16(o[2], o[3]); pk.z = pk_bf16(o[4], o[5]); pk.w = pk_bf16(o[6], o[7]);
                *(u32x4*)(KC + (size_t)j * 64) = pk;
#pragma unroll
                for (int e = 0; e < 8; ++e) { kb[jj][e] = MLD_E(pk, e); dn[e] += wt[j] * kb[jj][e]; } }
#pragma unroll
            for (int e = 0; e < 8; ++e) { *(LAS unsigned*)(wl + swz_off(8 * cc + e, tg) + 4 * j2) = pk_bf16(kb[0][e], kb[1][e]);
                *(LAS unsigned*)(wl + 8192 + swz_off(8 * cc + e, tg) + 4 * j2) = pk_bf16(wt[2 * j2] * MLD_E(vv[2 * j2], e), wt[2 * j2 + 1] * MLD_E(vv[2 * j2 + 1], e)); } }
    }
#undef MLD_E
#pragma unroll
    for (int e = 0; e < 8; ++e) { dn[e] += shx<8>(dn[e]); dn[e] += shx<16>(dn[e]); dn[e] += __shfl_xor(dn[e], 32); }
    if (tg == 0) { float* DN = (float*)(ws + WS_ML + ML_DN) + (size_t)cu * 64 + 8 * cc; *(f32x4*)DN = (f32x4){dn[0], dn[1], dn[2], dn[3]}; *(f32x4*)(DN + 4) = (f32x4){dn[4], dn[5], dn[6], dn[7]}; }
    LDS_FENCE();
    const int r = lane & 15, q = lane >> 4;
    bf16_t* DL = (bf16_t*)(ws + WS_ML + ML_DELTA) + (size_t)cu * 4096;
    f32x4 acc[4][4];
#pragma unroll
    for (int mb = 0; mb < 4; ++mb) {
#pragma unroll
        for (int nb = 0; nb < 4; ++nb) acc[mb][nb] = (f32x4){0.f, 0.f, 0.f, 0.f};
#pragma unroll
        for (int ks = 0; ks < 2; ++ks) {
            const bf16x8 a = *(const LAS bf16x8*)(wl + 8192 + swz_off(16 * mb + r, 4 * ks + q));
#pragma unroll
            for (int nb = 0; nb < 4; ++nb) { const bf16x8 bb = *(const LAS bf16x8*)(wl + swz_off(16 * nb + r, 4 * ks + q)); acc[mb][nb] = MFMA16(a, bb, acc[mb][nb]); }
        }
    }
    LDS_FENCE();
#pragma unroll
    for (int mb = 0; mb < 4; ++mb)
#pragma unroll
        for (int nb = 0; nb < 4; ++nb)
#pragma unroll
            for (int j = 0; j < 4; ++j) { const int row = 16 * mb + 4 * q + j, col = 16 * nb + r; *(LAS bf16_t*)(wl + swz_off(row, col >> 3) + (col & 7) * 2) = f2bf(acc[mb][nb][j]); }
    LDS_FENCE();
#pragma unroll
    for (int i = 0; i < 8; ++i) { const int ch = lane + 64 * i; *(u32x4*)(DL + (size_t)ch * 8) = *(const LAS u32x4*)(wl + swz_off(ch >> 3, ch & 7)); }
    LDS_FENCE();
}

#ifndef TIME_PH
#define TIME_PH -1
#endif
#define PSTAMP(i, blk) do { if (TIME_PH != -1 && l == 0 && blockIdx.x == (blk) && TIDX == 0) ((unsigned long long*)((unsigned*)(ws + WS_CTL) + CW_TS))[i] = __builtin_amdgcn_s_memrealtime(); } while (0)
#ifndef DUP_DELTA
#define DUP_DELTA 1
#endif
__device__ __forceinline__ void phase_prep(int l, InPtr in, unsigned char* ws, LAS unsigned char* lds, int bid, int nb, int g_wv, unsigned* dq) {
    asm volatile("" : "+s"(bid));
    PSTAMP(40, 0);
#ifndef NO_UQ
    { g8::DenseSched S{(const char*)(ws + WS_PRJ + PRJ_DQKV), (const char*)(ws + WS_WUQ) + (size_t)l * 768 * 256 * 2, 384, 256, 64, 3, nb, bid};
      EpiUq E{(const float*)(ws + WS_SSQ + PT_DQ) + (size_t)l * 16384 * 4, in->p[19] + l * 192, (const float*)(ws + WS_ROPE), (bf16_t*)(ws + WS_MLA)};
      g8::gemm_run(lds, 256, 256, S, E, g_wv); }
#endif
    PSTAMP(41, 0);
#ifndef NO_UKV
    asm volatile("" : "+s"(bid));
    { g8::DenseSched S{(const char*)(ws + WS_PRJ + PRJ_DQKV) + 256, (const char*)(ws + WS_WUKV) + (size_t)l * 768 * 256 * 2, 384, 256, 64, 3, nb, nb == 256 ? ((bid + 64) & 255) : bid};
      EpiUkv E{(const float*)(ws + WS_SSQ + PT_DKV) + (size_t)l * 16384 * 2, in->p[19] + l * 192, (const bf16_t*)(ws + WS_PRJ + PRJ_KR), (bf16_t*)(ws + WS_MLA + MLA_KM), (bf16_t*)(ws + WS_MLA + MLA_VM)};
      g8::gemm_run(lds, 256, 256, S, E, g_wv); }
#endif
    PSTAMP(42, 0); PSTAMP(44, 255);
    __syncthreads();
#ifndef NO_CMP
#ifndef DUP_CMP
#define DUP_CMP 1
#endif
    for (int u = (nb == 256 ? (bid >= 128 && bid < 160 ? bid - 128 : 32) : nb - 1 - bid); u < 32; u += nb) for (int rp_ = 0; rp_ < DUP_CMP; ++rp_) { if (rp_) __syncthreads(); cmp_unit(u, l, in, ws, lds, g_wv); }
#endif
    PSTAMP(45, 255);
    __syncthreads();
#ifndef NO_DELTA
    { int tid_ = TIDX; asm volatile("" : "+v"(tid_)); LAS int* slot = (LAS int*)(lds + LDS_MISC + 64);
      for (;;) {
          __syncthreads();
          if (tid_ == 0) *slot = (int)__hip_atomic_fetch_add(dq, 1u, __ATOMIC_RELAXED, __HIP_MEMORY_SCOPE_AGENT);
          __syncthreads();
          const int g = *slot; if (g >= 96 + 128) break;
          const int wv = tid_ >> 6;
          const int cu_ = g < 96 ? g * 8 + wv : 768 + (g - 96) * 2 + wv;
          if (g < 96 || wv < 2) { for (int rp_ = 0; rp_ < DUP_DELTA; ++rp_) ml_delta_wave(cu_, l, in, ws, lds + wv * 16384, tid_ & 63); }
      } }
#endif
    __syncthreads(); PSTAMP(43, 0);
}
#define CHK_TOL(st) (((st) & 15) == 8 ? 1e-2f : 1e-3f)
#define CHECK_REST
constexpr int VTP = 192;
typedef short v4i16_t __attribute__((ext_vector_type(4)));
__device__ __forceinline__ int vt_lane_off(int lane) { return (4 * (lane >> 5) + ((lane & 15) >> 2)) * VTP + ((((lane >> 4) & 1) * 16) + 4 * (lane & 3)) * 2; }
__device__ __forceinline__ bf16x8 vt_frag(const LAS unsigned char* Vt, int voff, int s4, int eb) {
    const LAS unsigned char* a = Vt + voff + 16 * s4 * VTP + 64 * eb;
    const v4i16_t lo = __builtin_amdgcn_ds_read_tr16_b64_v4i16((LAS v4i16_t*)a), hi = __builtin_amdgcn_ds_read_tr16_b64_v4i16((LAS v4i16_t*)(a + 8 * VTP));
    return (bf16x8){lo[0], lo[1], lo[2], lo[3], hi[0], hi[1], hi[2], hi[3]};
}
__device__ __forceinline__ int crow(int reg, int h) { return (reg & 3) + 8 * (reg >> 2) + 4 * h; }
struct AttnState { f32x16 o[2]; float m, l; };
__device__ __forceinline__ void attn_reset(AttnState& A) { A.m = -1e30f; A.l = 0.f;
#pragma unroll
    for (int i = 0; i < 16; ++i) { A.o[0][i] = 0.f; A.o[1][i] = 0.f; } }

template <int DK>
__device__ __forceinline__ void attn_scores(f32x16 (&s)[2], const bf16x8 (&qf)[DK / 16], const LAS unsigned char* Kt, int r, int h) {
    constexpr int KP = 2 * DK + 16, NK = DK / 16;
    bf16x8 kf[2][NK];
#pragma unroll
    for (int kb = 0; kb < 2; ++kb)
#pragma unroll
        for (int ks = 0; ks < NK; ++ks) kf[kb][ks] = *(const LAS bf16x8*)(Kt + (32 * kb + r) * KP + (16 * ks + 8 * h) * 2);
    __builtin_amdgcn_sched_barrier(0);
#pragma unroll
    for (int kb = 0; kb < 2; ++kb)
#pragma unroll
        for (int i = 0; i < 16; ++i) s[kb][i] = 0.f;
#pragma unroll
    for (int ks = 0; ks < NK; ++ks) {
        s[0] = MFMA32(kf[0][ks], qf[ks], s[0]);
        s[1] = MFMA32(kf[1][ks], qf[ks], s[1]);
    }
}
__device__ __forceinline__ float max3f(float a, float b, float c) { return fmaxf(fmaxf(a, b), c); }
__device__ __forceinline__ void attn_softmax_pv(AttnState& A, f32x16 (&s)[2], const LAS unsigned char* Vt, int r, int h, float bias_c = 0.f, bool lane_ok = true) {
    constexpr float THR = 8.f; const int voff = vt_lane_off(r + 32 * h);
    float mx = max3f(s[0][0], s[0][1], s[0][2]);
#pragma unroll
    for (int i = 3; i < 15; i += 2) mx = max3f(mx, s[0][i], s[0][i + 1]);
    mx = max3f(mx, s[0][15], s[1][0]);
#pragma unroll
    for (int i = 1; i < 15; i += 2) mx = max3f(mx, s[1][i], s[1][i + 1]);
    mx = fmaxf(mx, s[1][15]);
    mx = fmaxf(mx, __shfl_xor(mx, 32));
    const float mxb = (lane_ok && mx > -1e29f) ? mx + bias_c : -1e30f;
    const bool grow = mxb > A.m + THR;
    const float mnew = grow ? mxb : A.m;
    if (__any(grow)) {
        const float alpha = __builtin_amdgcn_exp2f(A.m - mnew);
        A.l *= alpha;
#pragma unroll
        for (int i = 0; i < 16; ++i) { A.o[0][i] *= alpha; A.o[1][i] *= alpha; }
    }
    A.m = mnew;
    const float sub = (lane_ok && mnew > -1e29f) ? mnew - bias_c : 1e30f;
    float rs = 0.f;
#pragma unroll
    for (int kb = 0; kb < 2; ++kb)
#pragma unroll
        for (int i = 0; i < 16; ++i) { const float p = __builtin_amdgcn_exp2f(s[kb][i] - sub); s[kb][i] = p; rs += p; }
    rs += __shfl_xor(rs, 32);
    A.l += rs;
    bf16x8 vf[4][2];
#pragma unroll
    for (int s4 = 0; s4 < 4; ++s4)
#pragma unroll
        for (int eb = 0; eb < 2; ++eb) vf[s4][eb] = vt_frag(Vt, voff, s4, eb);
    __builtin_amdgcn_sched_barrier(0);
#pragma unroll
    for (int s4 = 0; s4 < 4; ++s4) {
        const int kb = s4 >> 1, hf = (s4 & 1) * 8;
        u32x4 pw; pw.x = pk_bf16(s[kb][hf + 0], s[kb][hf + 1]); pw.y = pk_bf16(s[kb][hf + 2], s[kb][hf + 3]); pw.z = pk_bf16(s[kb][hf + 4], s[kb][hf + 5]); pw.w = pk_bf16(s[kb][hf + 6], s[kb][hf + 7]);
        const bf16x8 pf = __builtin_bit_cast(bf16x8, pw);
#pragma unroll
        for (int eb = 0; eb < 2; ++eb) A.o[eb] = MFMA32(vf[s4][eb], pf, A.o[eb]);
    }
}
template <int DK>
__device__ __forceinline__ void attn_scores_half(f32x16& s, const bf16x8 (&qf)[DK / 16], const LAS unsigned char* Kt, int r, int h, int kb) {
    constexpr int KP = 2 * DK + 16, NK = DK / 16;
    bf16x8 kf[NK];
#pragma unroll
    for (int ks = 0; ks < NK; ++ks) kf[ks] = *(const LAS bf16x8*)(Kt + (32 * kb + r) * KP + (16 * ks + 8 * h) * 2);
    __builtin_amdgcn_sched_barrier(0);
#pragma unroll
    for (int i = 0; i < 16; ++i) s[i] = 0.f;
#pragma unroll
    for (int ks = 0; ks < NK; ++ks) s = MFMA32(kf[ks], qf[ks], s);
}
__device__ __forceinline__ void attn_softmax_pv_half(AttnState& A, f32x16& s, const LAS unsigned char* Vt, int r, int h, int kb, float bias_c = 0.f, bool lane_ok = true) {
    constexpr float THR = 8.f; const int voff = vt_lane_off(r + 32 * h);
    float mx = max3f(s[0], s[1], s[2]);
#pragma unroll
    for (int i = 3; i < 15; i += 2) mx = max3f(mx, s[i], s[i + 1]);
    mx = fmaxf(mx, s[15]);
    mx = fmaxf(mx, __shfl_xor(mx, 32));
    const float mxb = (lane_ok && mx > -1e29f) ? mx + bias_c : -1e30f;
    const bool grow = mxb > A.m + THR;
    const float mnew = grow ? mxb : A.m;
    if (__any(grow)) {
        const float alpha = __builtin_amdgcn_exp2f(A.m - mnew);
        A.l *= alpha;
#pragma unroll
        for (int i = 0; i < 16; ++i) { A.o[0][i] *= alpha; A.o[1][i] *= alpha; }
    }
    A.m = mnew;
    const float sub = (lane_ok && mnew > -1e29f) ? mnew - bias_c : 1e30f;
    float rs = 0.f;
#pragma unroll
    for (int i = 0; i < 16; ++i) { const float p = __builtin_amdgcn_exp2f(s[i] - sub); s[i] = p; rs += p; }
    rs += __shfl_xor(rs, 32);
    A.l += rs;
    bf16x8 vf[2][2];
#pragma unroll
    for (int s2 = 0; s2 < 2; ++s2)
#pragma unroll
        for (int eb = 0; eb < 2; ++eb) vf[s2][eb] = vt_frag(Vt, voff, 2 * kb + s2, eb);
    __builtin_amdgcn_sched_barrier(0);
#pragma unroll
    for (int s2 = 0; s2 < 2; ++s2) {
        const int hf = s2 * 8;
        u32x4 pw; pw.x = pk_bf16(s[hf + 0], s[hf + 1]); pw.y = pk_bf16(s[hf + 2], s[hf + 3]); pw.z = pk_bf16(s[hf + 4], s[hf + 5]); pw.w = pk_bf16(s[hf + 6], s[hf + 7]);
        const bf16x8 pf = __builtin_bit_cast(bf16x8, pw);
#pragma unroll
        for (int eb = 0; eb < 2; ++eb) A.o[eb] = MFMA32(vf[s2][eb], pf, A.o[eb]);
    }
}
template <int DK>
__device__ __forceinline__ void stage_k_load(u32x4 (&kr)[2], const bf16_t* Kg  , int tid) {
    constexpr int CH = DK / 8;
    kr[0] = *(const u32x4*)(Kg + (size_t)(tid / CH) * DK + (tid % CH) * 8);
    if (64 * CH > 512) { const int c2 = tid + 512; if (c2 < 64 * CH) kr[1] = *(const u32x4*)(Kg + (size_t)(c2 / CH) * DK + (c2 % CH) * 8); }
}
template <int DK>
__device__ __forceinline__ void stage_k_store(const u32x4 (&kr)[2], LAS unsigned char* Kt, int tid) {
    constexpr int CH = DK / 8, KP = 2 * DK + 16;
    *(LAS u32x4*)(Kt + (tid / CH) * KP + (tid % CH) * 16) = kr[0];
    if (64 * CH > 512) { const int c2 = tid + 512; if (c2 < 64 * CH) *(LAS u32x4*)(Kt + (c2 / CH) * KP + (c2 % CH) * 16) = kr[1]; }
}
__device__ __forceinline__ u32x4 stage_v_load(const bf16_t* Vg, int tid) { return *(const u32x4*)(Vg + (size_t)(tid >> 3) * 64 + (tid & 7) * 8); }
__device__ __forceinline__ void stage_v_store(const u32x4& v, LAS unsigned char* Vt, int tid) { *(LAS u32x4*)(Vt + (tid >> 3) * VTP + (tid & 7) * 16) = v; }

constexpr int MLA_KT = 0, MLA_VT = 2 * 64 * 208, MLA_LDS = MLA_VT + 2 * 64 * VTP;
__device__ __forceinline__ void mla_unit(int b, int hd, int qt, int l, unsigned char* ws, LAS unsigned char* lds, int g_wv) {
    int tid_ = TIDX; asm volatile("" : "+v"(tid_));
    const int tid = tid_, w = tid >> 6, lane = tid & 63, r = lane & 31, h = lane >> 5;
    const size_t slab = (size_t)(b * 6 + hd) * 2048;
    const bf16_t* QM = (const bf16_t*)(ws + WS_MLA) + slab * 96; const bf16_t* KM = (const bf16_t*)(ws + WS_MLA + MLA_KM) + slab * 96; const bf16_t* VM = (const bf16_t*)(ws + WS_MLA + MLA_VM) + slab * 64;
    const int q0 = 256 * qt + 32 * w, q = q0 + r;
    bf16x8 qf[6];
#pragma unroll
    for (int ks = 0; ks < 6; ++ks) qf[ks] = *(const bf16x8*)(QM + (size_t)q * 96 + 16 * ks + 8 * h);
    AttnState A; attn_reset(A);
    const int ntile = 4 * qt + 4;
    u32x4 kr[2], vr, kr2[2], vr2;
    stage_k_load<96>(kr, KM, tid); vr = stage_v_load(VM, tid);
    stage_k_store<96>(kr, lds + MLA_KT, tid); stage_v_store(vr, lds + MLA_VT, tid);
    if (ntile > 1) { stage_k_load<96>(kr, KM + (size_t)64 * 96, tid); vr = stage_v_load(VM + (size_t)64 * 64, tid); }
    __syncthreads();
    auto tile_step = [&](const int j, u32x4 (&kc)[2], u32x4& vc, u32x4 (&kn)[2], u32x4& vn) __attribute__((always_inline)) {
        const int cur = j & 1;
        if (j + 2 < ntile) { stage_k_load<96>(kn, KM + (size_t)(j + 2) * 64 * 96, tid); vn = stage_v_load(VM + (size_t)(j + 2) * 64 * 64, tid); }
        if (64 * j <= q0 + 31) {
            f32x16 s[2];
            attn_scores<96>(s, qf, lds + MLA_KT + cur * 64 * 208, r, h);
            if (64 * j + 63 > q0) {
#pragma unroll
                for (int kb = 0; kb < 2; ++kb)
#pragma unroll
                    for (int i = 0; i < 16; ++i) { const int key = 64 * j + 32 * kb + crow(i, h); if (key > q) s[kb][i] = -1e30f; }
            }
            attn_softmax_pv(A, s, lds + MLA_VT + cur * 64 * VTP, r, h);
        }
        if (j + 1 < ntile) { stage_k_store<96>(kc, lds + MLA_KT + (cur ^ 1) * 64 * 208, tid); stage_v_store(vc, lds + MLA_VT + (cur ^ 1) * 64 * VTP, tid); }
        __syncthreads();
    };
#pragma unroll 1
    for (int j = 0; j < ntile; j += 2) { tile_step(j, kr, vr, kr2, vr2); tile_step(j + 1, kr2, vr2, kr, vr); }
    const float inv = A.l > 0.f ? 1.f / A.l : 0.f; float ss = 0.f;
    bf16_t* Y = (bf16_t*)(ws + WS_Y) + ((size_t)b * 2048 + q) * 1024 + 384 + hd * 64;
#pragma unroll
    for (int eb = 0; eb < 2; ++eb)
#pragma unroll
        for (int g4 = 0; g4 < 4; ++g4) {
            const float v0 = A.o[eb][4 * g4] * inv, v1 = A.o[eb][4 * g4 + 1] * inv, v2 = A.o[eb][4 * g4 + 2] * inv, v3 = A.o[eb][4 * g4 + 3] * inv;
            u32x2 pw; pw.x = pk_bf16(v0, v1); pw.y = pk_bf16(v2, v3);
            const float f0 = bf_lo(pw.x), f1 = bf_hi(pw.x), f2 = bf_lo(pw.y), f3 = bf_hi(pw.y); ss += (f0 * f0 + f1 * f1) + (f2 * f2 + f3 * f3);
            *(u32x2*)(Y + 32 * eb + 8 * g4 + 4 * h) = pw;
        }
    ss += __shfl_xor(ss, 32);
    if (h == 0) ((float*)(ws + WS_SSQ + PT_C))[((size_t)l * 16384 + (size_t)b * 2048 + q) * 8 + hd] = ss;
}

__device__ __forceinline__ void nsa_bias32(float (&bv)[2][16], const LAS float* bl, int dd) {
#pragma unroll
    for (int kb = 0; kb < 2; ++kb)
#pragma unroll
        for (int k = 0; k < 16; ++k) { const int c = 63 - (32 * kb + (k & 3) + 8 * (k >> 2)); int d = dd + c; d = d < 0 ? 0 : (d > 255 ? 255 : d); bv[kb][k] = bl[d]; }
}
__device__ __forceinline__ void nsa_mask_bias(f32x16 (&sc)[2], int dq, int h, const LAS float* bl, bool sel, int lim) {
    int dd = dq - 4 * h - 63; asm volatile("" : "+v"(dd));
    float bv[2][16]; nsa_bias32(bv, bl, dd);
#pragma unroll
    for (int kb = 0; kb < 2; ++kb)
#pragma unroll
        for (int k = 0; k < 16; ++k) { const int c = 63 - (32 * kb + (k & 3) + 8 * (k >> 2)); const int d = dd + c; sc[kb][k] = (sel && d >= 0 && d < lim) ? sc[kb][k] + bv[kb][k] : -1e30f; }
}
__device__ __forceinline__ void nsa_mask_bias_half(f32x16& sc, int dq, int h, const LAS float* bl, bool sel, int lim, int kb) {
    int dd = dq - 4 * h - 32 * kb; asm volatile("" : "+v"(dd));
    float bv[16];
#pragma unroll
    for (int k = 0; k < 16; ++k) { int d = dd - ((k & 3) + 8 * (k >> 2)); d = d < 0 ? 0 : (d > 255 ? 255 : d); bv[k] = bl[d]; }
#pragma unroll
    for (int k = 0; k < 16; ++k) { const int d = dd - ((k & 3) + 8 * (k >> 2)); sc[k] = (sel && d >= 0 && d < lim) ? sc[k] + bv[k] : -1e30f; }
}

__device__ __forceinline__ void attn_park(const AttnState& A, LAS float* xl) {
    xl[0] = A.m; xl[64] = A.l;
#pragma unroll
    for (int k = 0; k < 16; ++k) { xl[64 * (2 + k)] = A.o[0][k]; xl[64 * (18 + k)] = A.o[1][k]; }
}
__device__ __forceinline__ void attn_merge(AttnState& A, const LAS float* xl) {
    const float m2 = xl[0], l2 = xl[64]; const float m = fmaxf(A.m, m2);
    const float a1 = A.m > -1e29f ? __builtin_amdgcn_exp2f(A.m - m) : 0.f, a2 = m2 > -1e29f ? __builtin_amdgcn_exp2f(m2 - m) : 0.f;
    A.l = A.l * a1 + l2 * a2; A.m = m;
#pragma unroll
    for (int k = 0; k < 16; ++k) { A.o[0][k] = A.o[0][k] * a1 + xl[64 * (2 + k)] * a2; A.o[1][k] = A.o[1][k] * a1 + xl[64 * (18 + k)] * a2; }
}
constexpr int NSA_KT = 0, NSA_VT = 2 * 64 * 144, NSA_BIAS = NSA_VT + 2 * 64 * VTP, NSA_PS = NSA_BIAS + 3 * 256 * 4, NSA_SEL = NSA_PS + 3 * 64 * 32 * 4, NSA_UNI = NSA_SEL + 256, NSA_OT = NSA_UNI + 256, NSA_LDS = NSA_OT + 6 * 8192;
__device__ __forceinline__ void nsa_unit(int b, int hk, int i, int l, InPtr in, unsigned char* ws, LAS unsigned char* lds, int g_wv) {
    int tid_ = TIDX; asm volatile("" : "+v"(tid_));
    const int tid = tid_, w = tid >> 6, lane = tid & 63, r = lane & 31, h = lane >> 5;
    const bool active = w < 6; const int g = active ? (w >> 1) : 2, th = w & 1, head = hk * 3 + g;
    const int kh = w < 4 ? -1 : (w < 6 ? 0 : 1);
    LAS float* xl = (LAS float*)(lds + NSA_LDS) + th * (34 * 64) + lane;
    const int t = 64 * i + 32 * th + r, tl = 32 * th + r; const size_t row = (size_t)b * 2048 + t;
    const size_t kvslab = (size_t)(b * 2 + hk) * 2048 * 64;
    LAS float* biasl = (LAS float*)(lds + NSA_BIAS); LAS float* PS = (LAS float*)(lds + NSA_PS); LAS unsigned* SEL = (LAS unsigned*)(lds + NSA_SEL); LAS unsigned* UNI = (LAS unsigned*)(lds + NSA_UNI);
    { const float* bd = (const float*)(ws + WS_BIASD) + (size_t)hk * 3 * 2048;
      if (tid < 384) { const int gg = tid >> 7, d0 = (tid & 127) * 2; biasl[gg * 256 + d0] = bd[gg * 2048 + d0]; biasl[gg * 256 + d0 + 1] = bd[gg * 2048 + d0 + 1]; }
#pragma unroll
      for (int k = 0; k < 12; ++k) if (i >= 16) PS[tid + 512 * k] = 0.f;
      if (tid < 4) UNI[tid] = 0u; }
    bf16x8 qf[4];
    { const bf16_t* QN = (const bf16_t*)(ws + WS_PRJ + PRJ_QN) + ((size_t)(b * 6 + head) * 2048 + t) * 64;
#pragma unroll
      for (int ks = 0; ks < 4; ++ks) qf[ks] = *(const bf16x8*)(QN + 16 * ks + 8 * h); }
#define NSA_GATE(k) ({ int t_ = t; asm volatile("" : "+v"(t_)); sigmf(((const float*)(ws + WS_PRJ + PRJ_GATES))[((size_t)b * 2048 + t_) * 32 + head * 3 + (k)]); })
    LAS float* bl = biasl + g * 256;
    LAS float* otl = (LAS float*)(lds + NSA_OT + (active ? w : 0) * 8192) + lane;
    u32x4 kr[2], vr;
    const int ntc = i >= 16 ? 2 : 1;
    { const bf16_t* KC = (const bf16_t*)(ws + WS_CMP) + (size_t)(b * 2 + hk) * 128 * 64; const bf16_t* VC = (const bf16_t*)(ws + WS_CMP + CMP_V) + (size_t)(b * 2 + hk) * 128 * 64;
      for (int T = 0; T < ntc; ++T) { stage_k_load<64>(kr, KC + T * 4096, tid); vr = stage_v_load(VC + T * 4096, tid); stage_k_store<64>(kr, lds + NSA_KT + T * 64 * 144, tid); stage_v_store(vr, lds + NSA_VT + T * 64 * VTP, tid); } }
    __syncthreads();
    {
        f32x16 ot[2];
        if (active && i < 16) {
            AttnState A; attn_reset(A); f32x16 sc[2]; attn_scores<64>(sc, qf, lds + NSA_KT, r, h);
            float bvc[2][16];
#pragma unroll
            for (int kb = 0; kb < 2; ++kb)
#pragma unroll
                for (int k = 0; k < 16; ++k) { int d = t - 16 * (32 * kb + crow(k, h)) - 31; d = d < 0 ? 0 : (d > 255 ? 255 : d); bvc[kb][k] = bl[d]; }
#pragma unroll
            for (int kb = 0; kb < 2; ++kb)
#pragma unroll
                for (int k = 0; k < 16; ++k) { const int d = t - 16 * (32 * kb + crow(k, h)) - 31; sc[kb][k] = d >= 0 ? sc[kb][k] + bvc[kb][k] : -1e30f; }
            attn_softmax_pv(A, sc, lds + NSA_VT, r, h);
            const float gc = NSA_GATE(0); const float inv = A.l > 0.f ? gc / A.l : 0.f;
#pragma unroll
            for (int k = 0; k < 16; ++k) { otl[64 * k] = A.o[0][k] * inv; otl[64 * (16 + k)] = A.o[1][k] * inv; }
        } else if (active) {
            float m = -1e30f, lsum = 0.f;
            for (int T = 0; T < ntc; ++T) {
                f32x16 sc[2]; attn_scores<64>(sc, qf, lds + NSA_KT + T * 64 * 144, r, h);
                float bvc[2][16];
#pragma unroll
                for (int kb = 0; kb < 2; ++kb)
#pragma unroll
                    for (int k = 0; k < 16; ++k) { int d = t - 16 * (64 * T + 32 * kb + crow(k, h)) - 31; d = d < 0 ? 0 : (d > 255 ? 255 : d); bvc[kb][k] = bl[d]; }
                float mx = -1e30f;
#pragma unroll
                for (int kb = 0; kb < 2; ++kb)
#pragma unroll
                    for (int k = 0; k < 16; ++k) { const int n = 64 * T + 32 * kb + crow(k, h); const int d = t - 16 * n - 31; const float x = (d >= 0 && n < 127) ? sc[kb][k] + bvc[kb][k] : -1e30f; sc[kb][k] = x; mx = fmaxf(mx, x); }
                mx = fmaxf(mx, __shfl_xor(mx, 32));
                const float mnew = fmaxf(m, mx), mref = mnew <= -1e29f ? 0.f : mnew; float rs = 0.f;
#pragma unroll
                for (int kb = 0; kb < 2; ++kb)
#pragma unroll
                    for (int k = 0; k < 16; ++k) rs += __builtin_amdgcn_exp2f(sc[kb][k] - mref);
                rs += __shfl_xor(rs, 32);
                lsum = lsum * __builtin_amdgcn_exp2f(m - mref) + rs; m = mnew;
            }
            const float mref = m <= -1e29f ? 0.f : m, inv = lsum > 0.f ? 1.f / lsum : 0.f;
#pragma unroll
            for (int k = 0; k < 16; ++k) { ot[0][k] = 0.f; ot[1][k] = 0.f; }
            float carry = 0.f;
            for (int T = 0; T < ntc; ++T) {
                f32x16 sc[2]; attn_scores<64>(sc, qf, lds + NSA_KT + T * 64 * 144, r, h);
                float bvc[2][16];
#pragma unroll
                for (int kb = 0; kb < 2; ++kb)
#pragma unroll
                    for (int k = 0; k < 16; ++k) { int d = t - 16 * (64 * T + 32 * kb + crow(k, h)) - 31; d = d < 0 ? 0 : (d > 255 ? 255 : d); bvc[kb][k] = bl[d]; }
#pragma unroll
                for (int kb = 0; kb < 2; ++kb)
#pragma unroll
                    for (int k = 0; k < 16; ++k) { const int n = 64 * T + 32 * kb + crow(k, h); const int d = t - 16 * n - 31; sc[kb][k] = (d >= 0 && n < 127) ? __builtin_amdgcn_exp2f(sc[kb][k] + bvc[kb][k] - mref) * inv : 0.f; }
                float prevL = carry;
#pragma unroll
                for (int kb = 0; kb < 2; ++kb)
#pragma unroll
                    for (int g4 = 0; g4 < 4; ++g4) {
                        const float G4 = (sc[kb][4 * g4] + sc[kb][4 * g4 + 1]) + (sc[kb][4 * g4 + 2] + sc[kb][4 * g4 + 3]); const float L = sc[kb][4 * g4 + 3];
                        const float Lo = __shfl_xor(L, 32);
                        const float add = h ? Lo : prevL;
                        prevL = Lo;
                        const int idx = T * 8 + kb * 4 + g4;
                        PS[g * 2048 + tl * 32 + 2 * idx + h] = G4 + add;
                    }
                carry = prevL;
#pragma unroll
                for (int s4 = 0; s4 < 4; ++s4) {
                    const int kb = s4 >> 1, hf = (s4 & 1) * 8;
                    u32x4 pw; pw.x = pk_bf16(sc[kb][hf + 0], sc[kb][hf + 1]); pw.y = pk_bf16(sc[kb][hf + 2], sc[kb][hf + 3]); pw.z = pk_bf16(sc[kb][hf + 4], sc[kb][hf + 5]); pw.w = pk_bf16(sc[kb][hf + 6], sc[kb][hf + 7]);
                    const bf16x8 pf = __builtin_bit_cast(bf16x8, pw);
#pragma unroll
                    for (int eb = 0; eb < 2; ++eb) ot[eb] = MFMA32(vt_frag(lds + NSA_VT + T * 64 * VTP, vt_lane_off(lane), s4, eb), pf, ot[eb]);
                }
            }
            { const float gc = NSA_GATE(0);
#pragma unroll
            for (int k = 0; k < 16; ++k) { otl[64 * k] = ot[0][k] * gc; otl[64 * (16 + k)] = ot[1][k] * gc; } }
        }
    }
    __syncthreads();
#ifndef NO_NSA_SEL
    if (i < 16) { if (tid < 64) SEL[tid] = (2u << i) - 1u; if (tid < 3) UNI[tid] = (2u << i) - 1u; }
    else {
        const int tk = tid >> 3, sg = tid & 7; float v[32];
#pragma unroll
        for (int k = 0; k < 8; ++k) { const f32x4 x0 = *(const LAS f32x4*)(PS + tk * 32 + 4 * k), x1 = *(const LAS f32x4*)(PS + 2048 + tk * 32 + 4 * k), x2 = *(const LAS f32x4*)(PS + 4096 + tk * 32 + 4 * k);
            v[4 * k] = (x0.x + x1.x) + x2.x; v[4 * k + 1] = (x0.y + x1.y) + x2.y; v[4 * k + 2] = (x0.z + x1.z) + x2.z; v[4 * k + 3] = (x0.w + x1.w) + x2.w; }
#pragma unroll
        for (int s = 0; s < 32; ++s) { const bool forced = (s == 0) || (s == i) || (s == i - 1); float x = forced ? v[s] + 1e4f : v[s]; v[s] = s > i ? -1.f : x; }
        unsigned bits = 0u;
#pragma unroll
        for (int k = 0; k < 4; ++k) {
            float x = 0.f;
#pragma unroll
            for (int s = 0; s < 32; ++s) x = (s == 4 * sg + k) ? v[s] : x;
            int rank = 0;
#pragma unroll
            for (int s = 0; s < 32; ++s) rank += (v[s] > x || (v[s] == x && s < 4 * sg + k)) ? 1 : 0;
            if (rank < 16 && x >= 0.f) bits |= 1u << (4 * sg + k);
        }
        bits |= shx<1>(bits); bits |= shx<2>(bits); bits |= shx<4>(bits);
        if (sg == 0) { SEL[tk] = bits; __hip_atomic_fetch_or(UNI, bits, __ATOMIC_RELAXED, __HIP_MEMORY_SCOPE_WORKGROUP); __hip_atomic_fetch_or(UNI + 1 + (tk >> 5), bits, __ATOMIC_RELAXED, __HIP_MEMORY_SCOPE_WORKGROUP); }
    }
#endif
    __syncthreads();
    const unsigned selbits = SEL[tl], uni = UNI[0], unih = UNI[1 + th];
    const float c31 = bl[255];
#ifndef NO_NSA_SLC
#ifndef NSA_DUP_SLC
#define NSA_DUP_SLC 1
#endif
    for (int rp_ = 0; rp_ < NSA_DUP_SLC; ++rp_) {
        AttnState A; attn_reset(A);
        const bf16_t* KS = (const bf16_t*)(ws + WS_PRJ + PRJ_KN1) + kvslab; const bf16_t* VS = (const bf16_t*)(ws + WS_PRJ + PRJ_VN1) + kvslab;
        unsigned todo = uni; int cur = 0; u32x4 kr2[2], vr2;
        int s = __ffs(todo) - 1; todo &= todo - 1;
        stage_k_load<64>(kr, KS + (size_t)s * 4096, tid); vr = stage_v_load(VS + (size_t)s * 4096, tid);
        stage_k_store<64>(kr, lds + NSA_KT, tid); stage_v_store(vr, lds + NSA_VT, tid);
        int sn = todo ? __ffs(todo) - 1 : -1; todo &= todo - 1;
        if (sn >= 0) { stage_k_load<64>(kr, KS + (size_t)sn * 4096, tid); vr = stage_v_load(VS + (size_t)sn * 4096, tid); }
        __syncthreads();
        while (s >= 0) {
            const int sn2 = todo ? __ffs(todo) - 1 : -1; todo &= todo - 1;
            if (sn2 >= 0) { stage_k_load<64>(kr2, KS + (size_t)sn2 * 4096, tid); vr2 = stage_v_load(VS + (size_t)sn2 * 4096, tid); }
            if ((unih >> s) & 1u) {
                const bool sel = (selbits >> s) & 1u;
                if (kh < 0) {
                    f32x16 sc[2];
                    attn_scores<64>(sc, qf, lds + NSA_KT + cur * 64 * 144, r, h);
                    if (i - s >= 3) attn_softmax_pv(A, sc, lds + NSA_VT + cur * 64 * VTP, r, h, c31, sel);
                    else { nsa_mask_bias(sc, t - 64 * s, h, bl, sel, 4096); attn_softmax_pv(A, sc, lds + NSA_VT + cur * 64 * VTP, r, h); }
                } else {
                    f32x16 s1;
                    attn_scores_half<64>(s1, qf, lds + NSA_KT + cur * 64 * 144, r, h, kh);
                    if (i - s >= 3) attn_softmax_pv_half(A, s1, lds + NSA_VT + cur * 64 * VTP, r, h, kh, c31, sel);
                    else { nsa_mask_bias_half(s1, t - 64 * s, h, bl, sel, 4096, kh); attn_softmax_pv_half(A, s1, lds + NSA_VT + cur * 64 * VTP, r, h, kh); }
                }
            }
            if (sn >= 0) { stage_k_store<64>(kr, lds + NSA_KT + (cur ^ 1) * 64 * 144, tid); stage_v_store(vr, lds + NSA_VT + (cur ^ 1) * 64 * VTP, tid); }
            kr[0] = kr2[0]; vr = vr2;
            __syncthreads();
            s = sn; sn = sn2; cur ^= 1;
        }
        if (kh == 1) attn_park(A, xl);
        __syncthreads();
        if (kh == 0) attn_merge(A, xl);
        if (active && rp_ == NSA_DUP_SLC - 1) { const float gs = NSA_GATE(1); const float inv = A.l > 0.f ? gs / A.l : 0.f;
#pragma unroll
            for (int k = 0; k < 16; ++k) { otl[64 * k] += A.o[0][k] * inv; otl[64 * (16 + k)] += A.o[1][k] * inv; } }
    }
#endif
#ifndef NO_NSA_WIN
#ifndef NSA_DUP_WIN
#define NSA_DUP_WIN 1
#endif
    for (int rq_ = 0; rq_ < NSA_DUP_WIN; ++rq_) {
        AttnState A; attn_reset(A);
        const bf16_t* KW = (const bf16_t*)(ws + WS_PRJ + PRJ_KN2) + kvslab; const bf16_t* VW = (const bf16_t*)(ws + WS_PRJ + PRJ_VN2) + kvslab;
        const int j0 = i > 8 ? i - 8 : 0; int cur = 0; u32x4 kr2[2], vr2;
        stage_k_load<64>(kr, KW + (size_t)j0 * 4096, tid); vr = stage_v_load(VW + (size_t)j0 * 4096, tid);
        stage_k_store<64>(kr, lds + NSA_KT, tid); stage_v_store(vr, lds + NSA_VT, tid);
        if (j0 < i) { stage_k_load<64>(kr, KW + (size_t)(j0 + 1) * 4096, tid); vr = stage_v_load(VW + (size_t)(j0 + 1) * 4096, tid); }
        __syncthreads();
        for (int j = j0; j <= i; ++j) {
            if (j + 2 <= i) { stage_k_load<64>(kr2, KW + (size_t)(j + 2) * 4096, tid); vr2 = stage_v_load(VW + (size_t)(j + 2) * 4096, tid); }
            if (kh < 0) {
                f32x16 sc[2];
                attn_scores<64>(sc, qf, lds + NSA_KT + cur * 64 * 144, r, h);
                if (i - j >= 3 && j > i - 8) attn_softmax_pv(A, sc, lds + NSA_VT + cur * 64 * VTP, r, h, c31, true);
                else { nsa_mask_bias(sc, t - 64 * j, h, bl, true, 512); attn_softmax_pv(A, sc, lds + NSA_VT + cur * 64 * VTP, r, h); }
            } else {
                f32x16 s1;
                attn_scores_half<64>(s1, qf, lds + NSA_KT + cur * 64 * 144, r, h, kh);
                if (i - j >= 3 && j > i - 8) attn_softmax_pv_half(A, s1, lds + NSA_VT + cur * 64 * VTP, r, h, kh, c31, true);
                else { nsa_mask_bias_half(s1, t - 64 * j, h, bl, true, 512, kh); attn_softmax_pv_half(A, s1, lds + NSA_VT + cur * 64 * VTP, r, h, kh); }
            }
            if (j < i) { stage_k_store<64>(kr, lds + NSA_KT + (cur ^ 1) * 64 * 144, tid); stage_v_store(vr, lds + NSA_VT + (cur ^ 1) * 64 * VTP, tid); }
            kr[0] = kr2[0]; vr = vr2;
            __syncthreads();
            cur ^= 1;
        }
        if (kh == 1) attn_park(A, xl);
        __syncthreads();
        if (kh == 0) attn_merge(A, xl);
        if (active && rq_ == NSA_DUP_WIN - 1) { const float gw = NSA_GATE(2); const float inv = A.l > 0.f ? gw / A.l : 0.f;
            float ss = 0.f; bf16_t* Y = (bf16_t*)(ws + WS_Y) + row * 1024 + head * 64;
#pragma unroll
            for (int eb = 0; eb < 2; ++eb)
#pragma unroll
                for (int g4 = 0; g4 < 4; ++g4) {
                    const float v0 = otl[64 * (16 * eb + 4 * g4)] + A.o[eb][4 * g4] * inv, v1 = otl[64 * (16 * eb + 4 * g4 + 1)] + A.o[eb][4 * g4 + 1] * inv;
                    const float v2 = otl[64 * (16 * eb + 4 * g4 + 2)] + A.o[eb][4 * g4 + 2] * inv, v3 = otl[64 * (16 * eb + 4 * g4 + 3)] + A.o[eb][4 * g4 + 3] * inv;
                    u32x2 pw; pw.x = pk_bf16(v0, v1); pw.y = pk_bf16(v2, v3);
                    const float f0 = bf_lo(pw.x), f1 = bf_hi(pw.x), f2 = bf_lo(pw.y), f3 = bf_hi(pw.y); ss += (f0 * f0 + f1 * f1) + (f2 * f2 + f3 * f3);
                    *(u32x2*)(Y + 32 * eb + 8 * g4 + 4 * h) = pw;
                }
            ss += __shfl_xor(ss, 32);
            if (h == 0) ((float*)(ws + WS_SSQ + PT_A))[((size_t)l * 16384 + row) * 8 + head] = ss;
        }
    }
#endif
}

__device__ __forceinline__ void ml_out_wave(int cu, int l, InPtr in, unsigned char* ws, LAS unsigned char* wl, LAS unsigned char* npl, int lane) {
    const int c = cu & 31, bh = cu >> 5, hd = bh & 3, b = bh >> 2; const int t0 = c * 64; const int r = lane & 15, q = lane >> 4;
    const bf16_t* QC = (const bf16_t*)(ws + WS_ML) + ((size_t)bh * 2048 + t0) * 64; const bf16_t* KC = (const bf16_t*)(ws + WS_ML + ML_KC) + ((size_t)bh * 2048 + t0) * 64;
    const bf16_t* V = (const bf16_t*)(ws + WS_PRJ + PRJ_VML) + ((size_t)bh * 2048 + t0) * 64;
    const float* mlg = (const float*)(ws + WS_ML + ML_G) + ((size_t)bh * 2048 + t0) * 2;
    const bf16_t* CP = (const bf16_t*)(ws + WS_ML + ML_CP) + (size_t)cu * 4096; const bf16_t* NP = (const bf16_t*)(ws + WS_ML + ML_NP) + (size_t)cu * 64;
    u32x4 vch[8];
#pragma unroll
    for (int i = 0; i < 8; ++i) vch[i] = *(const u32x4*)(V + (size_t)(lane + 64 * i) * 8);
    bf16x8 aq[4][2];
#pragma unroll
    for (int mb = 0; mb < 4; ++mb)
#pragma unroll
        for (int ks = 0; ks < 2; ++ks) aq[mb][ks] = *(const bf16x8*)(QC + (size_t)(16 * mb + r) * 64 + 32 * ks + 8 * q);
    float bj[4][4], den[4][4];
#pragma unroll
    for (int mb = 0; mb < 4; ++mb)
#pragma unroll
        for (int j = 0; j < 4; ++j) bj[mb][j] = mlg[(16 * mb + 4 * q + j) * 2];
    {
        float cs[4];
#pragma unroll
        for (int nb = 0; nb < 4; ++nb) { const float2 gg = *(const float2*)(mlg + (16 * nb + r) * 2); cs[nb] = gg.y - gg.x; }
#pragma unroll
        for (int mb = 0; mb < 4; ++mb) {
            f32x4 accS[4];
#pragma unroll
            for (int nb = 0; nb < 4; ++nb) { accS[nb] = (f32x4){0.f, 0.f, 0.f, 0.f};
#pragma unroll
                for (int ks = 0; ks < 2; ++ks) { const bf16x8 bk = *(const bf16x8*)(KC + (size_t)(16 * nb + r) * 64 + 32 * ks + 8 * q); accS[nb] = MFMA16(aq[mb][ks], bk, accS[nb]); } }
#pragma unroll
            for (int j = 0; j < 4; ++j) {
                const int jj = 16 * mb + 4 * q + j; float rs = 0.f;
#pragma unroll
                for (int nb = 0; nb < 4; ++nb) { const int s = 16 * nb + r; const float p = s <= jj ? accS[nb][j] * __expf(bj[mb][j] + cs[nb]) : 0.f; rs += p;
                    *(LAS bf16_t*)(wl + 8192 + swz_off(jj, s >> 3) + (s & 7) * 2) = f2bf(p); }
                rs += shx<1>(rs); rs += shx<2>(rs); rs += shx<4>(rs); rs += shx<8>(rs);
                den[mb][j] = rs;
            }
        }
    }
#pragma unroll
    for (int i = 0; i < 8; ++i) { const int ch = lane + 64 * i, sv = ch >> 3, e0 = (ch & 7) * 8; const unsigned xs[4] = {vch[i].x, vch[i].y, vch[i].z, vch[i].w};
#pragma unroll
        for (int k = 0; k < 4; ++k) { *(LAS bf16_t*)(wl + swz_off(e0 + 2 * k, sv >> 3) + (sv & 7) * 2) = (bf16_t)(xs[k] & 0xffffu); *(LAS bf16_t*)(wl + swz_off(e0 + 2 * k + 1, sv >> 3) + (sv & 7) * 2) = (bf16_t)(xs[k] >> 16); } }
#pragma unroll
    for (int mb = 0; mb < 4; ++mb) { const float e = __expf(mlg[(16 * mb + r) * 2]);
#pragma unroll
        for (int ks = 0; ks < 2; ++ks) { const u32x4 x = __builtin_bit_cast(u32x4, aq[mb][ks]); u32x4 y;
            y.x = pk_bf16(bf_lo(x.x) * e, bf_hi(x.x) * e); y.y = pk_bf16(bf_lo(x.y) * e, bf_hi(x.y) * e); y.z = pk_bf16(bf_lo(x.z) * e, bf_hi(x.z) * e); y.w = pk_bf16(bf_lo(x.w) * e, bf_hi(x.w) * e);
            aq[mb][ks] = __builtin_bit_cast(bf16x8, y); } }
    f32x4 acc[4][4], accn[4];
#pragma unroll
    for (int mb = 0; mb < 4; ++mb) { accn[mb] = (f32x4){0.f, 0.f, 0.f, 0.f};
#pragma unroll
        for (int nb = 0; nb < 4; ++nb) acc[mb][nb] = (f32x4){0.f, 0.f, 0.f, 0.f}; }
#pragma unroll
    for (int ks = 0; ks < 2; ++ks) {
        u32x4 nz = *(const u32x4*)(NP + 32 * ks + 8 * q); if (r != 0) nz = (u32x4){0u, 0u, 0u, 0u};
        const bf16x8 bn = __builtin_bit_cast(bf16x8, nz);
#pragma unroll
        for (int nb = 0; nb < 4; ++nb) { const bf16x8 bb = *(const bf16x8*)(CP + (size_t)(16 * nb + r) * 64 + 32 * ks + 8 * q);
#pragma unroll
            for (int mb = 0; mb < 4; ++mb) acc[mb][nb] = MFMA16(aq[mb][ks], bb, acc[mb][nb]); }
#pragma unroll
        for (int mb = 0; mb < 4; ++mb) accn[mb] = MFMA16(aq[mb][ks], bn, accn[mb]);
    }
    LDS_FENCE();
#pragma unroll
    for (int ks = 0; ks < 2; ++ks) {
        bf16x8 ap[4];
#pragma unroll
        for (int mb = 0; mb < 4; ++mb) ap[mb] = *(const LAS bf16x8*)(wl + 8192 + swz_off(16 * mb + r, 4 * ks + q));
#pragma unroll
        for (int nb = 0; nb < 4; ++nb) { const bf16x8 bv = *(const LAS bf16x8*)(wl + swz_off(16 * nb + r, 4 * ks + q));
#pragma unroll
            for (int mb = 0; mb < 4; ++mb) acc[mb][nb] = MFMA16(ap[mb], bv, acc[mb][nb]); }
    }
    LDS_FENCE();
    const bf16_t* OG = (const bf16_t*)(ws + WS_PRJ + PRJ_OG); u32x4 ogc[8];
#pragma unroll
    for (int i = 0; i < 8; ++i) { const int ch = lane + 64 * i; ogc[i] = *(const u32x4*)(OG + ((size_t)b * 2048 + t0 + (ch >> 3)) * 256 + hd * 64 + (ch & 7) * 8); }
    const float* gain = in->p[14] + l * 256 + hd * 64;
    bf16_t* Y = (bf16_t*)(ws + WS_Y);
    float gn[4];
#pragma unroll
    for (int nb = 0; nb < 4; ++nb) gn[nb] = gain[16 * nb + r];
#pragma unroll
    for (int mb = 0; mb < 4; ++mb)
#pragma unroll
        for (int j = 0; j < 4; ++j) {
            const int jj = 16 * mb + 4 * q + j;
            const float dn = den[mb][j] + __builtin_bit_cast(float, __builtin_amdgcn_ds_bpermute((lane & 48) << 2, __builtin_bit_cast(int, accn[mb][j])));
            const float inv = __builtin_amdgcn_rcpf(fmaxf(fabsf(dn), 1.f)); float hv[4]; float ss = 0.f;
#pragma unroll
            for (int nb = 0; nb < 4; ++nb) { hv[nb] = acc[mb][nb][j] * inv; ss += hv[nb] * hv[nb]; }
            ss += shx<1>(ss); ss += shx<2>(ss); ss += shx<4>(ss); ss += shx<8>(ss);
            const float rstd = rsqrtf(ss * (1.f / 64.f) + 1e-6f);
#pragma unroll
            for (int nb = 0; nb < 4; ++nb) { const int e = 16 * nb + r; *(LAS bf16_t*)(wl + 8192 + swz_off(jj, e >> 3) + (e & 7) * 2) = f2bf(hv[nb] * rstd * gn[nb]); }
        }
    LDS_FENCE();
#pragma unroll
    for (int i = 0; i < 8; ++i) { const int ch = lane + 64 * i, row = ch >> 3, e8 = ch & 7;
        const u32x4 hx = *(const LAS u32x4*)(wl + 8192 + swz_off(row, e8)); const u32x4 g = ogc[i]; u32x4 o;
        o.x = pk_bf16(bf_lo(hx.x) * sigmf(bf_lo(g.x)), bf_hi(hx.x) * sigmf(bf_hi(g.x)));
        o.y = pk_bf16(bf_lo(hx.y) * sigmf(bf_lo(g.y)), bf_hi(hx.y) * sigmf(bf_hi(g.y)));
        o.z = pk_bf16(bf_lo(hx.z) * sigmf(bf_lo(g.z)), bf_hi(hx.z) * sigmf(bf_hi(g.z)));
        o.w = pk_bf16(bf_lo(hx.w) * sigmf(bf_lo(g.w)), bf_hi(hx.w) * sigmf(bf_hi(g.w)));
        *(u32x4*)(Y + ((size_t)b * 2048 + t0 + row) * 1024 + 768 + hd * 64 + e8 * 8) = o; }
    LDS_FENCE();
}

__device__ __forceinline__ void ml_scan_unit(int bh, int l, unsigned char* ws, int g_wv) {
    int tid_ = TIDX; asm volatile("" : "+v"(tid_)); const int tid = tid_;
    const bf16_t* DL = (const bf16_t*)(ws + WS_ML + ML_DELTA) + (size_t)bh * 32 * 4096 + tid * 8; bf16_t* CP = (bf16_t*)(ws + WS_ML + ML_CP) + (size_t)bh * 32 * 4096 + tid * 8;
    const float* DN = (const float*)(ws + WS_ML + ML_DN) + (size_t)bh * 32 * 64; bf16_t* NP = (bf16_t*)(ws + WS_ML + ML_NP) + (size_t)bh * 32 * 64; const float* BL = (const float*)(ws + WS_ML + ML_BL) + bh * 32;
    float c[8]; float n = 0.f;
#pragma unroll
    for (int k = 0; k < 8; ++k) c[k] = 0.f;
#pragma unroll 1
    for (int c0 = 0; c0 < 32; c0 += 8) {
        u32x4 d[8]; float dn[8], co[8];
#pragma unroll
        for (int k = 0; k < 8; ++k) { d[k] = *(const u32x4*)(DL + (size_t)(c0 + k) * 4096); dn[k] = tid < 64 ? DN[(c0 + k) * 64 + tid] : 0.f; co[k] = __expf(BL[c0 + k]); }
#pragma unroll
        for (int k = 0; k < 8; ++k) {
            u32x4 o; o.x = pk_bf16(c[0], c[1]); o.y = pk_bf16(c[2], c[3]); o.z = pk_bf16(c[4], c[5]); o.w = pk_bf16(c[6], c[7]);
            *(u32x4*)(CP + (size_t)(c0 + k) * 4096) = o; if (tid < 64) NP[(c0 + k) * 64 + tid] = f2bf(n);
            c[0] = co[k] * c[0] + bf_lo(d[k].x); c[1] = co[k] * c[1] + bf_hi(d[k].x); c[2] = co[k] * c[2] + bf_lo(d[k].y); c[3] = co[k] * c[3] + bf_hi(d[k].y);
            c[4] = co[k] * c[4] + bf_lo(d[k].z); c[5] = co[k] * c[5] + bf_hi(d[k].z); c[6] = co[k] * c[6] + bf_lo(d[k].w); c[7] = co[k] * c[7] + bf_hi(d[k].w);
            n = co[k] * n + dn[k];
        }
    }
    asm volatile("s_waitcnt vmcnt(0)" ::: "memory"); __syncthreads();
    if (tid == 0) { __builtin_amdgcn_fence(__ATOMIC_RELEASE, "agent"); asm volatile("s_waitcnt vmcnt(0)" ::: "memory");
        __hip_atomic_fetch_add((unsigned*)(ws + WS_CTL) + CW_SCAN + 64 * l, 1u, __ATOMIC_RELAXED, __HIP_MEMORY_SCOPE_AGENT); }
}
__device__ __forceinline__ void ml_scan_wait(int l, unsigned char* ws, int g_wv) {
    if (TIDX == 0) { unsigned* p = (unsigned*)(ws + WS_CTL) + CW_SCAN + 64 * l; unsigned sp = 0;
        while (__hip_atomic_load(p, __ATOMIC_RELAXED, __HIP_MEMORY_SCOPE_AGENT) < 32u) { __builtin_amdgcn_s_sleep(2); if (++sp > (1u << 22)) break; }
        __builtin_amdgcn_fence(__ATOMIC_ACQUIRE, "agent"); asm volatile("s_waitcnt vmcnt(0)" ::: "memory"); }
    __syncthreads();
}

#ifndef DUP_NSA
#define DUP_NSA 1
#endif
#ifndef DUP_MLA
#define DUP_MLA 1
#endif
#ifndef DUP_ML
#define DUP_ML 1
#endif
#ifdef NO_MLA
#define MLA_CALL(...) do {} while (0)
#else
#define MLA_CALL(...) do { for (int rp = 0; rp < DUP_MLA; ++rp) { if (rp) __syncthreads(); mla_unit(__VA_ARGS__); } } while (0)
#endif
__device__ __forceinline__ void phase_mix(int l, InPtr in, unsigned char* ws, LAS unsigned char* lds, unsigned* qhead, int g_wv) {
    LAS int* slot = (LAS int*)(lds + LDS_MISC + 64);
    for (;;) {
        __syncthreads();
        if (TIDX == 0) *slot = (int)__hip_atomic_fetch_add(qhead, 1u, __ATOMIC_RELAXED, __HIP_MEMORY_SCOPE_AGENT);
        __syncthreads();
        int u = *slot;
        if (u >= 32 + 512 + 384 + 128) break;
        if (u < 32) { ml_scan_unit(u, l, ws, g_wv); continue; } u -= 32;
#ifndef NO_NSA
        if (u < 256) { const int i = 31 - (u >> 4), bh = u & 15; { for (int rp = 0; rp < DUP_NSA; ++rp) { if (rp) __syncthreads(); nsa_unit(bh >> 1, bh & 1, i, l, in, ws, lds, g_wv); } } continue; }
#endif
        u -= 256;
        if (u < 192) { const int qt = 7 - u / 48, bh = u % 48; MLA_CALL(bh / 6, bh % 6, qt, l, ws, lds, g_wv); continue; }
        u -= 192;
#ifndef NO_NSA
        if (u < 128) { const int i = 15 - (u >> 4), bh = u & 15; { for (int rp = 0; rp < DUP_NSA; ++rp) { if (rp) __syncthreads(); nsa_unit(bh >> 1, bh & 1, i, l, in, ws, lds, g_wv); } } continue; }
#endif
        u -= 128;
        if (u < 192) { const int qt = 3 - u / 48, bh = u % 48; MLA_CALL(bh / 6, bh % 6, qt, l, ws, lds, g_wv); continue; } u -= 192;
#ifndef NO_NSA
        if (u < 128) { const int i = 7 - (u >> 4), bh = u & 15; { for (int rp = 0; rp < DUP_NSA; ++rp) { if (rp) __syncthreads(); nsa_unit(bh >> 1, bh & 1, i, l, in, ws, lds, g_wv); } } continue; }
#endif
        u -= 128;
#ifndef NO_MLOUT
        ml_scan_wait(l, ws, g_wv);
        for (int rp = 0; rp < DUP_ML; ++rp) { int tid_ = TIDX; asm volatile("" : "+v"(tid_)); const int w = tid_ >> 6; ml_out_wave(u * 8 + w, l, in, ws, lds + w * 16384, lds + 131072 + w * 256, tid_ & 63); }
#endif
    }
}
__device__ __forceinline__ void phase_ynorm(int l, unsigned char* ws, int bid, int nb, int g_wv) {
    int tid_ = TIDX; asm volatile("" : "+v"(tid_)); const int w = tid_ >> 6, lane = tid_ & 63;
    bf16_t* Y = (bf16_t*)(ws + WS_Y); const float* sa = (const float*)(ws + WS_SSQ + PT_A) + (size_t)l * 16384 * 8; const float* sc = (const float*)(ws + WS_SSQ + PT_C) + (size_t)l * 16384 * 8;
    for (int r0 = (bid * 8 + w) * 8; r0 < NTOK; r0 += nb * 64) {
        if (lane < 48) {
            u32x4 x[8], y[8]; float ra[8], rc[8];
#pragma unroll
            for (int k = 0; k < 8; ++k) { const int row = r0 + k;
                const f32x4 a0 = *(const f32x4*)(sa + (size_t)row * 8), a1 = *(const f32x4*)(sa + (size_t)row * 8 + 4), c0 = *(const f32x4*)(sc + (size_t)row * 8), c1 = *(const f32x4*)(sc + (size_t)row * 8 + 4);
                ra[k] = rsqrtf((((a0.x + a0.y) + (a0.z + a0.w)) + (a1.x + a1.y)) * (1.f / 384.f) + 1e-6f); rc[k] = rsqrtf((((c0.x + c0.y) + (c0.z + c0.w)) + (c1.x + c1.y)) * (1.f / 384.f) + 1e-6f);
                x[k] = *((const u32x4*)(Y + (size_t)row * 1024) + lane); y[k] = *((const u32x4*)(Y + (size_t)row * 1024 + 384) + lane); }
#pragma unroll
            for (int k = 0; k < 8; ++k) { const int row = r0 + k; u32x4 a = x[k], c = y[k]; const float fa = ra[k], fc = rc[k];
                a.x = pk_bf16(bf_lo(a.x) * fa, bf_hi(a.x) * fa); a.y = pk_bf16(bf_lo(a.y) * fa, bf_hi(a.y) * fa); a.z = pk_bf16(bf_lo(a.z) * fa, bf_hi(a.z) * fa); a.w = pk_bf16(bf_lo(a.w) * fa, bf_hi(a.w) * fa);
                c.x = pk_bf16(bf_lo(c.x) * fc, bf_hi(c.x) * fc); c.y = pk_bf16(bf_lo(c.y) * fc, bf_hi(c.y) * fc); c.z = pk_bf16(bf_lo(c.z) * fc, bf_hi(c.z) * fc); c.w = pk_bf16(bf_lo(c.w) * fc, bf_hi(c.w) * fc);
                *((u32x4*)(Y + (size_t)row * 1024) + lane) = a; *((u32x4*)(Y + (size_t)row * 1024 + 384) + lane) = c; }
        }
    }
}
constexpr int LDS_FAC = 131072 + 2048;
__device__ __forceinline__ void outproj_factors(int l, unsigned char* ws, LAS unsigned char* lds, int pm, int tid) {
    asm volatile("" : "+v"(tid));
    if (tid < 256) { const int row = pm * 256 + tid; const float* sa = (const float*)(ws + WS_SSQ + PT_A) + ((size_t)l * 16384 + row) * 8; const float* sc = (const float*)(ws + WS_SSQ + PT_C) + ((size_t)l * 16384 + row) * 8;
        const f32x4 a0 = *(const f32x4*)sa, a1 = *(const f32x4*)(sa + 4), c0 = *(const f32x4*)sc, c1 = *(const f32x4*)(sc + 4);
        const float ra = rsqrtf((((a0.x + a0.y) + (a0.z + a0.w)) + (a1.x + a1.y)) * (1.f / 384.f) + 1e-6f), rc = rsqrtf((((c0.x + c0.y) + (c0.z + c0.w)) + (c1.x + c1.y)) * (1.f / 384.f) + 1e-6f);
        LAS float* F = (LAS float*)(lds + LDS_FAC); F[2 * tid] = ra / rc; F[2 * tid + 1] = rc; }
    __syncthreads();
}
struct EpiOut {
    static constexpr bool KHOOK = true;
    bf16_t* XB; float* ssq; const LAS float* F; bool fold;
    __device__ __forceinline__ void kscale(f32x4 (&acc)[2][2][4][2], int which, int wr, int fr) const {
        if (!fold) return;
#pragma unroll
        for (int ai = 0; ai < 2; ++ai)
#pragma unroll
            for (int m = 0; m < 4; ++m) { const float f = F[2 * (ai * 128 + wr * 64 + m * 16 + fr) + which];
#pragma unroll
                for (int bj = 0; bj < 2; ++bj)
#pragma unroll
                    for (int n = 0; n < 2; ++n) acc[ai][bj][m][n] = acc[ai][bj][m][n] * f; }
    }
    __device__ __forceinline__ void operator()(const f32x4 (&acc)[2][2][4][2], const GUnit& u, int wr, int wc, int fr, int fq) const {
#pragma unroll
        for (int ai = 0; ai < 2; ++ai)
#pragma unroll
          for (int mh = 0; mh < 2; ++mh) {
            __builtin_amdgcn_sched_barrier(0);
            u32x4 xr[2][2];
#pragma unroll
            for (int m2 = 0; m2 < 2; ++m2)
#pragma unroll
                for (int bj = 0; bj < 2; ++bj) xr[m2][bj] = *(const u32x4*)(XB + (size_t)(u.pm * 256 + ai * 128 + wr * 64 + (2 * mh + m2) * 16 + fr) * 1024 + u.pn * 256 + bj * 128 + wc * 32 + 8 * fq);
#pragma unroll
            for (int m2 = 0; m2 < 2; ++m2) {
                const int m = 2 * mh + m2; const int row = u.pm * 256 + ai * 128 + wr * 64 + m * 16 + fr; float ss = 0.f;
#pragma unroll
                for (int bj = 0; bj < 2; ++bj) {
                    const u32x4 x = xr[m2][bj]; u32x4 o;
                    o.x = pk_bf16(bf_lo(x.x) + acc[ai][bj][m][0][0], bf_hi(x.x) + acc[ai][bj][m][0][1]); o.y = pk_bf16(bf_lo(x.y) + acc[ai][bj][m][0][2], bf_hi(x.y) + acc[ai][bj][m][0][3]);
                    o.z = pk_bf16(bf_lo(x.z) + acc[ai][bj][m][1][0], bf_hi(x.z) + acc[ai][bj][m][1][1]); o.w = pk_bf16(bf_lo(x.w) + acc[ai][bj][m][1][2], bf_hi(x.w) + acc[ai][bj][m][1][3]);
                    *(u32x4*)(XB + (size_t)row * 1024 + u.pn * 256 + bj * 128 + wc * 32 + 8 * fq) = o;
                    ss += (bf_lo(o.x) * bf_lo(o.x) + bf_hi(o.x) * bf_hi(o.x)) + (bf_lo(o.y) * bf_lo(o.y) + bf_hi(o.y) * bf_hi(o.y)) + (bf_lo(o.z) * bf_lo(o.z) + bf_hi(o.z) * bf_hi(o.z)) + (bf_lo(o.w) * bf_lo(o.w) + bf_hi(o.w) * bf_hi(o.w));
                }
                ss = quad_sum(ss); if (fq == 0) ssq[(size_t)row * 16 + u.pn * 4 + wc] = ss;
            }
          }
    }
};

__device__ __forceinline__ float sum16(const float* p) { const f32x4 a = *(const f32x4*)p, b = *(const f32x4*)(p + 4), c = *(const f32x4*)(p + 8), d = *(const f32x4*)(p + 12);
    return (((a.x + a.y) + (a.z + a.w)) + ((b.x + b.y) + (b.z + b.w))) + (((c.x + c.y) + (c.z + c.w)) + ((d.x + d.y) + (d.z + d.w))); }
__device__ __forceinline__ void phase_route(int l, InPtr in, unsigned char* ws, LAS unsigned char* lds, int bid, int nb, int g_wv) {
    int tid_ = TIDX; asm volatile("" : "+v"(tid_)); const int w = tid_ >> 6, lane = tid_ & 63, r = lane & 15, q = lane >> 4;
    const bf16_t* XB = (const bf16_t*)(ws + WS_XB); const bf16_t* WR = (const bf16_t*)(ws + WS_WR) + (size_t)l * 64 * 1024;
    const float* ssq = (const float*)(ws + WS_SSQ + PT_X1) + (size_t)l * 16384 * 16; const float* bg = in->p[24] + l * 4; const float* be = in->p[26] + l * 32;
    unsigned* cnt = (unsigned*)(ws + WS_CTL) + CW_CNT + 2048 * l; unsigned* mtok = (unsigned*)(ws + WS_META); float* mw = (float*)(ws + WS_META + META_W);
    LAS float* lg = (LAS float*)(lds + w * 4096);
    LAS unsigned* lcnt = (LAS unsigned*)(lds + 32768); LAS unsigned* lbase = lcnt + 32;
    constexpr int WRP = 2064; LAS unsigned char* wrl = lds + 40960;
    { u32x4 st[12];
#pragma unroll
      for (int i = 0; i < 12; ++i) { const int c = tid_ + 512 * i; st[i] = *(const u32x4*)(WR + (size_t)(c >> 7) * 1024 + (c & 127) * 8); }
#pragma unroll
      for (int i = 0; i < 12; ++i) { const int c = tid_ + 512 * i; *(LAS u32x4*)(wrl + (c >> 7) * WRP + (c & 127) * 16) = st[i]; } }
    for (int g0 = bid * 8; g0 < NTOK / 16; g0 += nb * 8) {
        if (tid_ < 32) lcnt[tid_] = 0u;
        __syncthreads();
        const int tok0 = (g0 + w) * 16; f32x4 acc[3];
#pragma unroll
        for (int n = 0; n < 3; ++n) acc[n] = (f32x4){0.f, 0.f, 0.f, 0.f};
        const bf16_t* ap = XB + (size_t)(tok0 + r) * 1024 + 8 * q; const LAS unsigned char* bl_ = wrl + r * WRP + 16 * q;
#pragma unroll 1
        for (int kc = 0; kc < 2; ++kc) {
            bf16x8 a[16];
#pragma unroll
            for (int s = 0; s < 16; ++s) a[s] = *(const bf16x8*)(ap + 32 * (kc * 16 + s));
            __builtin_amdgcn_sched_barrier(0);
#pragma unroll
            for (int s = 0; s < 16; ++s)
#pragma unroll
                for (int n = 0; n < 3; ++n) { const bf16x8 bb = *(const LAS bf16x8*)(bl_ + n * 16 * WRP + 64 * (kc * 16 + s)); acc[n] = MFMA16(a[s], bb, acc[n]); }
            __builtin_amdgcn_sched_barrier(0);
        }
#pragma unroll
        for (int n = 0; n < 3; ++n)
#pragma unroll
            for (int j = 0; j < 4; ++j) lg[(4 * q + j) * 48 + 16 * n + r] = acc[n][j];
        LDS_FENCE();
        int E0 = 0, E1 = 0; unsigned r0 = 0, r1 = 0; float wt0 = 0.f, wt1 = 0.f; const int tok = tok0 + (lane & 15);
        if (lane < 16) {
            const float rs = rsqrtf(sum16(ssq + (size_t)tok * 16) * (1.f / 1024.f) + 1e-6f); ((float*)(ws + WS_RS2))[tok] = rs; const LAS float* L = lg + lane * 48;
            float gl[4]; int gi = 0;
#pragma unroll
            for (int j = 0; j < 4; ++j) gl[j] = L[j] * rs + bg[j];
            float gm = gl[0];
#pragma unroll
            for (int j = 1; j < 4; ++j) if (gl[j] > gm) { gm = gl[j]; gi = j; }
            float gsum = 0.f;
#pragma unroll
            for (int j = 0; j < 4; ++j) gsum += __expf(gl[j] - gm);
            const float gtop = 1.f / gsum;
            float el[8];
#pragma unroll
            for (int j = 0; j < 8; ++j) el[j] = L[4 + gi * 8 + j] * rs + be[gi * 8 + j];
            int e0 = 0; float v0 = el[0];
#pragma unroll
            for (int j = 1; j < 8; ++j) if (el[j] > v0) { v0 = el[j]; e0 = j; }
            int e1 = -1; float v1 = -3.0e38f;
#pragma unroll
            for (int j = 0; j < 8; ++j) if (j != e0 && el[j] > v1) { v1 = el[j]; e1 = j; }
            const float w0 = 1.f / (1.f + __expf(v1 - v0)); E0 = gi * 8 + e0; E1 = gi * 8 + e1; wt0 = w0 * gtop; wt1 = (1.f - w0) * gtop;
            r0 = __hip_atomic_fetch_add(lcnt + E0, 1u, __ATOMIC_RELAXED, __HIP_MEMORY_SCOPE_WORKGROUP); r1 = __hip_atomic_fetch_add(lcnt + E1, 1u, __ATOMIC_RELAXED, __HIP_MEMORY_SCOPE_WORKGROUP);
        }
        __syncthreads();
        if (tid_ < 32) { const unsigned c = lcnt[tid_]; lbase[tid_] = c ? atomicAdd(cnt + tid_ * 64, c) : 0u; }
        __syncthreads();
        if (lane < 16) {
            const unsigned p0 = lbase[E0] + r0, p1 = lbase[E1] + r1;
            mtok[(size_t)E0 * 16384 + p0] = (unsigned)tok; mw[(size_t)E0 * 16384 + p0] = wt0;
            mtok[(size_t)E1 * 16384 + p1] = (unsigned)tok | 0x80000000u; mw[(size_t)E1 * 16384 + p1] = wt1;
        }
        __syncthreads();
    }
}

constexpr int LDS_TB = 131072 + 2048;
__device__ __forceinline__ void moe_tables(int l, unsigned char* ws, LAS unsigned char* lds, int g_wv) {
    int tix = TIDX; asm volatile("" : "+v"(tix));
    LAS int* tb = (LAS int*)(lds + LDS_TB);
    if (tix < 32) { const unsigned* cnt = (const unsigned*)(ws + WS_CTL) + CW_CNT + 2048 * l; tb[160 + tix] = (int)__hip_atomic_load(cnt + tix * 64, __ATOMIC_RELAXED, __HIP_MEMORY_SCOPE_AGENT); }
    __syncthreads();
    if (tix == 0) { int a = 0, f = 0, p = 0; for (int e = 0; e < 32; ++e) { const int c = tb[160 + e]; tb[e] = a; tb[48 + e] = f; tb[96 + e] = p; a += (c + 255) >> 8; f += c >> 8; p += (c & 255) ? 1 : 0; } tb[32] = a; tb[80] = f; tb[128] = p; }
    __syncthreads();
}
template <int NPN, bool GATHER_>
struct MoeSched {
    static constexpr bool GATHER = GATHER_, PARTIAL = false;
    const char* A; const char* Bt; const unsigned* cnt; const unsigned* mtok; const LAS int* tb; int G, c; size_t bstride_e  , bstride_pn; int lo, hi;
    __device__ __forceinline__ bool next(int i, GUnit& u) const {
        const int L = lo + i * G + c; if (L >= hi) return false;
        const int tile = L / NPN, pn = L % NPN;
        int e = 0;
        for (int k = 1; k < 32; ++k) e = (tb[k] <= tile) ? k : e;
        e = __builtin_amdgcn_readfirstlane(e);
        u.e = e; u.pm = tile; u.pn = pn; u.rows = tb[160 + e] - 256 * (tile - tb[e]);
        u.a = GATHER ? A : A + (size_t)tile * 256 * 256 * 2;
        u.b = Bt + (size_t)e * bstride_e + (size_t)pn * bstride_pn; return true;
    }
    __device__ __forceinline__ void aoff(const GUnit& u, unsigned (&v)[2][2], const int (&R)[2], const int (&C)[2]) const {
#pragma unroll
        for (int h = 0; h < 2; ++h)
#pragma unroll
            for (int i = 0; i < 2; ++i) {
                if (GATHER) { const int lr = h * 128 + R[i]; const int rr = 256 * (u.pm - tb[u.e]) + (lr < u.rows ? lr : 0); const unsigned tok = mtok[(size_t)u.e * 16384 + rr] & 0x7fffffffu; v[h][i] = (tok * 1024u + (unsigned)C[i]) * 2u; }
                else v[h][i] = (unsigned)((h * 128 + R[i]) * 256 + C[i]) * 2u;
            }
    }
};
struct EpiMoeUp {
    static constexpr bool KHOOK = false;
    const unsigned* mtok; const float* ssq; const LAS int* tb; bf16_t* HB;
    __device__ __forceinline__ void operator()(const f32x4 (&acc)[2][2][4][2], const GUnit& u, int wr, int wc, int fr, int fq) const {
        const int r0 = 256 * (u.pm - tb[u.e]);
        float rs8[8];
        { unsigned tk[8];
#pragma unroll
          for (int k = 0; k < 8; ++k) { const int lr = (k >> 2) * 128 + wr * 64 + (k & 3) * 16 + fr; tk[k] = mtok[(size_t)u.e * 16384 + r0 + (lr < u.rows ? lr : 0)] & 0x7fffffffu; }
#pragma unroll
          for (int k = 0; k < 8; ++k) rs8[k] = ssq[tk[k]]; }
#pragma unroll
        for (int ai = 0; ai < 2; ++ai)
#pragma unroll
            for (int m = 0; m < 4; ++m) {
                __builtin_amdgcn_sched_barrier(0);
                const int lr = ai * 128 + wr * 64 + m * 16 + fr;
                if (lr < u.rows) {
                    const float rs = rs8[ai * 4 + m];
                    float hv[8];
#pragma unroll
                    for (int n = 0; n < 2; ++n)
#pragma unroll
                        for (int j = 0; j < 4; ++j) { const float gv = acc[ai][0][m][n][j] * rs, uv = acc[ai][1][m][n][j] * rs; hv[4 * n + j] = siluf(gv) * uv; }
                    st_bf16x8(HB + ((size_t)u.pm * 256 + lr) * 256 + u.pn * 128 + wc * 32 + 8 * fq, hv);
                }
            }
    }
};
struct EpiMoeDown {
    static constexpr bool KHOOK = false;
    const unsigned* mtok; const float* mw; const LAS int* tb; bf16_t* YB;
    __device__ __forceinline__ void operator()(const f32x4 (&acc)[2][2][4][2], const GUnit& u, int wr, int wc, int fr, int fq) const {
        const int r0 = 256 * (u.pm - tb[u.e]);
        unsigned mt8[8]; float wt8[8];
#pragma unroll
        for (int k = 0; k < 8; ++k) { const int lr = (k >> 2) * 128 + wr * 64 + (k & 3) * 16 + fr; const size_t ix = (size_t)u.e * 16384 + r0 + (lr < u.rows ? lr : 0); mt8[k] = mtok[ix]; wt8[k] = mw[ix]; }
#pragma unroll
        for (int ai = 0; ai < 2; ++ai)
#pragma unroll
            for (int m = 0; m < 4; ++m) {
                __builtin_amdgcn_sched_barrier(0);
                const int lr = ai * 128 + wr * 64 + m * 16 + fr;
                if (lr < u.rows) {
                    const unsigned mt = mt8[ai * 4 + m]; const float wt = wt8[ai * 4 + m];
                    bf16_t* dst = YB + ((size_t)(mt >> 31) * 16384 + (mt & 0x7fffffffu)) * 1024 + u.pn * 256 + wc * 32 + 8 * fq;
#pragma unroll
                    for (int bj = 0; bj < 2; ++bj) { float v[8];
#pragma unroll
                        for (int n = 0; n < 2; ++n)
#pragma unroll
                            for (int j = 0; j < 4; ++j) v[4 * n + j] = acc[ai][bj][m][n][j] * wt;
                        st_bf16x8(dst + bj * 128, v); }
                }
            }
    }
};
__device__ __forceinline__ void phase_combine(int l, unsigned char* ws, float* out, int bid, int nb, int g_wv) {
    int tid_ = TIDX; asm volatile("" : "+v"(tid_)); const int w = tid_ >> 6, lane = tid_ & 63;
    bf16_t* XB = (bf16_t*)(ws + WS_XB); const bf16_t* Y0 = (const bf16_t*)(ws + WS_YBUF); const bf16_t* Y1 = Y0 + (size_t)16384 * 1024; float* ssqx = (float*)(ws + WS_SSQX) + 16384;
    for (int row = bid * 8 + w; row < NTOK; row += nb * 8) {
        float ss = 0.f;
#pragma unroll
        for (int k = 0; k < 2; ++k) {
            const size_t o = (size_t)row * 1024 + (lane + 64 * k) * 8;
            const u32x4 x = *(const u32x4*)(XB + o), a = *(const u32x4*)(Y0 + o), c = *(const u32x4*)(Y1 + o);
            float v[8] = { bf_lo(x.x) + bf_lo(a.x) + bf_lo(c.x), bf_hi(x.x) + bf_hi(a.x) + bf_hi(c.x), bf_lo(x.y) + bf_lo(a.y) + bf_lo(c.y), bf_hi(x.y) + bf_hi(a.y) + bf_hi(c.y),
                           bf_lo(x.z) + bf_lo(a.z) + bf_lo(c.z), bf_hi(x.z) + bf_hi(a.z) + bf_hi(c.z), bf_lo(x.w) + bf_lo(a.w) + bf_lo(c.w), bf_hi(x.w) + bf_hi(a.w) + bf_hi(c.w) };
            if (l == L_ - 1 && out) { *(f32x4*)(out + o) = (f32x4){v[0], v[1], v[2], v[3]}; *(f32x4*)(out + o + 4) = (f32x4){v[4], v[5], v[6], v[7]}; }
            else { u32x4 p; p.x = pk_bf16(v[0], v[1]); p.y = pk_bf16(v[2], v[3]); p.z = pk_bf16(v[4], v[5]); p.w = pk_bf16(v[6], v[7]); *(u32x4*)(XB + o) = p;
#pragma unroll
                   for (int j = 0; j < 4; ++j) { const unsigned q = j == 0 ? p.x : (j == 1 ? p.y : (j == 2 ? p.z : p.w)); ss += bf_lo(q) * bf_lo(q) + bf_hi(q) * bf_hi(q); } }
        }
        if (l < L_ - 1) { ss = wave_sum(ss); if (lane == 0) ssqx[row] = ss; }
    }
}
constexpr int MOE_CVT_SPLIT = 4608;
#ifndef CVT_A
#define CVT_A 1920
#endif
#ifndef NROUTE
#define NROUTE 128
#endif
constexpr int NPH = 9;
enum { PH_INPROJ = 0, PH_PREP, PH_MIX, PH_YNORM, PH_OUTPROJ, PH_ROUTE, PH_MOEUP, PH_MOEDOWN, PH_COMBINE };
struct Args { Inputs in; float* out; unsigned char* ws; int ph_lo, ph_hi; };

__global__ void __launch_bounds__(512, 2) mk(Args args) {
    extern __shared__ __attribute__((aligned(16))) unsigned char lds_raw[];
    LAS unsigned char* lds = (LAS unsigned char*)lds_raw;
    const int g_wv = __builtin_amdgcn_readfirstlane((int)threadIdx.x >> 6);
    const int bid0 = blockIdx.x, nb = gridDim.x;
#define BID() ({ int b_ = bid0; asm volatile("" : "+s"(b_)); b_; })
    unsigned char* ws = args.ws; unsigned* ctl = (unsigned*)(ws + WS_CTL);
    const int lo = args.ph_lo, hi = args.ph_hi;
    if (TIDX < 4) ((LAS unsigned*)(lds + LDS_MISC))[TIDX] = 0u;
    __syncthreads();
    XcdBarrier bar; bar.g_wv = g_wv; bar.bar = ctl + CW_BAR; bar.x = 0; bar.st = nullptr;
    if (hi - lo > 1) bar = xcd_barrier_post(ctl + CW_BAR, (volatile LAS unsigned*)(lds + LDS_MISC), g_wv);
#define IN(k) (lo <= (k) && (k) < hi)
#ifndef REPEAT_PH
#define REPEAT_PH -1
#endif
#define NREP(k) ((REPEAT_PH == (k)) ? 2 : 1)
#ifndef NBAR
#define NBAR 1
#endif
#ifndef TIME_PH
#define TIME_PH -1
#endif
#define STAMP(i) do { if (TIME_PH != -1 && blockIdx.x == 0 && TIDX == 0) ((unsigned long long*)(ctl + CW_TS))[i] = __builtin_amdgcn_s_memrealtime(); } while (0)
#define SEAM(k) do { if (IN(k) && IN((k) + 1)) for (int nb_ = 0; nb_ < NBAR; ++nb_) xcd_barrier(bar); STAMP((k) + 1); } while (0)
    STAMP(0);
#ifndef NO_PRO
    if (IN(0)) for (int rep = 0; rep < NREP(100); ++rep) { prologue(in_tab(), launder(ws), lds, BID(), nb, g_wv); if (rep + 1 < NREP(100)) xcd_barrier(bar); }
#endif
    SEAM(0);
    for (int l = 0; l < L_; ++l) {
        const int pb = 1 + l * NPH;
        if (IN(pb + PH_INPROJ)) for (int rep = 0; rep < NREP(PH_INPROJ); ++rep) {
            if (rep) xcd_barrier(bar);
            InPtr in = in_tab(); unsigned char* ws = launder(args.ws);
            g8::DenseSched S{(const char*)(ws + WS_XB), (const char*)(ws + WS_WIN) + (size_t)l * 2560 * 1024 * 2, 1024, 1024, 64, 10, nb, BID()};
            EpiInProj E{(const float*)(ws + WS_SSQX) + l * 16384, (float*)(ws + WS_SSQ + PT_DQ) + (size_t)l * 16384 * 4, (float*)(ws + WS_SSQ + PT_DKV) + (size_t)l * 16384 * 2,
                        in->p[8] + l * 64, in->p[9] + l * 64, in->p[19] + l * 192 + 96 + 64, (const float*)(ws + WS_ROPE), ws + WS_PRJ};
#ifndef NO_INPROJ
            g8::gemm_run(lds, 1024, 1024, S, E, g_wv);
#endif
        }
        SEAM(pb + PH_INPROJ);
        if (IN(pb + PH_PREP)) for (int rep = 0; rep < NREP(PH_PREP); ++rep) { if (rep) xcd_barrier(bar); phase_prep(l, in_tab(), launder(ws), lds, BID(), nb, g_wv, (unsigned*)launder(ws) + CW_Q + 64 * (4 + l + 2 * rep)); }
        SEAM(pb + PH_PREP);
        if (IN(pb + PH_MIX)) for (int rep = 0; rep < NREP(PH_MIX); ++rep) { if (rep) xcd_barrier(bar); phase_mix(l, in_tab(), launder(ws), lds, (unsigned*)launder(ws) + CW_Q + 64 * (l + 2 * rep), g_wv); }
        SEAM(pb + PH_MIX);
        const bool fold_norm = (nb == 256);
        if (IN(pb + PH_YNORM) && !fold_norm) phase_ynorm(l, launder(ws), BID(), nb, g_wv);
        if (!fold_norm) SEAM(pb + PH_YNORM);
        if (IN(pb + PH_OUTPROJ)) {
            unsigned char* ws = launder(args.ws);
            g8::DenseSched S{(const char*)(ws + WS_Y), (const char*)(ws + WS_WOUT) + (size_t)l * 1024 * 1024 * 2, 1024, 1024, 64, 4, nb, BID()};
            EpiOut E{(bf16_t*)(ws + WS_XB), (float*)(ws + WS_SSQ + PT_X1) + (size_t)l * 16384 * 16, (const LAS float*)(lds + LDS_FAC), fold_norm};
            if (fold_norm) { g8::GUnit u0; if (S.next(0, u0)) outproj_factors(l, ws, lds, u0.pm, TIDX); else __syncthreads(); }
#ifndef NO_OUTPROJ
            g8::gemm_run(lds, 1024, 1024, S, E, g_wv);
#endif
        }
        SEAM(pb + PH_OUTPROJ);
#ifndef NO_ROUTE
        if (IN(pb + PH_ROUTE)) {
            const int b_ = BID();
            if (nb >= 256 && b_ >= NROUTE) { cvt_moe_layer(in_tab(), launder(ws), l, (LAS float*)lds, b_ - NROUTE, nb - NROUTE, TIDX, 0, CVT_A);
#ifdef DUP_CVT
                __syncthreads(); cvt_moe_layer(in_tab(), launder(ws), l, (LAS float*)lds, b_ - NROUTE, nb - NROUTE, TIDX);
#endif
            }
            else { phase_route(l, in_tab(), launder(ws), lds, b_, nb >= 256 ? NROUTE : nb, g_wv);
                   if (nb < 256) cvt_moe_layer(in_tab(), launder(ws), l, (LAS float*)lds, b_, nb, TIDX); else cvt_moe_layer(in_tab(), launder(ws), l, (LAS float*)lds, b_, NROUTE, TIDX, CVT_A, 3072); }
            if (l + 1 < L_) { __syncthreads(); cvt_small_weights(in_tab(), launder(ws), l + 1, (LAS float*)lds, b_, nb, TIDX); }
        }
#endif
        SEAM(pb + PH_ROUTE);
        {
            const bool do_up = IN(pb + PH_MOEUP), do_dn = IN(pb + PH_MOEDOWN), fuse = do_up && do_dn;
            for (int part = 0; part < (fuse ? 3 : 1); ++part) {
                if (part) xcd_barrier(bar);
                unsigned char* ws = launder(args.ws);
                if (do_up || do_dn) moe_tables(l, ws, lds, g_wv);
                const unsigned* cnt = (const unsigned*)(ws + WS_CTL) + CW_CNT + 2048 * l; const unsigned* mtok = (const unsigned*)(ws + WS_META); const LAS int* tb = (const LAS int*)(lds + LDS_TB);
                const int b_ = BID(), ntile = tb[32], UPU = 2 * ntile, DNU = 4 * ntile;
                const int hi0 = UPU < nb ? UPU : nb, nu_ = UPU - hi0, nu = nu_ < (nb >> 1) ? nu_ : (nb >> 1), nd = nb - nu;
                const int d1a = 4 * (hi0 >> 1), d1b = 2 * nd, D1 = nu == 0 ? DNU : (d1a < d1b ? d1a : d1b);
                int ulo = 0, uhi = UPU, uG = nb, uc = b_, dlo = 0, dhi = DNU, dG = nb, dc = b_;
                if (fuse) {
                    if (part == 0) { uhi = hi0; dhi = 0; }
                    else if (part == 1) { ulo = hi0; uG = nu; if (b_ >= nu) uhi = ulo; dhi = D1; dG = nd; dc = b_ - nu; if (b_ < nu) dhi = 0; }
                    else { uhi = 0; dlo = D1; }
                }
                if (do_up && uhi > ulo) {
                    MoeSched<2, true> S{(const char*)(ws + WS_XB), (const char*)(ws + WS_WMOE), cnt, mtok, tb, uG, uc, (size_t)512 * 1024 * 2, (size_t)256 * 1024 * 2, ulo, uhi};
                    EpiMoeUp E{mtok, (const float*)(ws + WS_RS2), tb, (bf16_t*)(ws + WS_HBUF)};
#ifndef NO_MOEUP
                    g8::gemm_run(lds, 1024, 1024, S, E, g_wv);
#endif
                }
                if (do_dn && dhi > dlo) {
                    MoeSched<4, false> S{(const char*)(ws + WS_HBUF), (const char*)(ws + WS_WMOE + WMOE_WD), cnt, mtok, tb, dG, dc, (size_t)1024 * 256 * 2, (size_t)256 * 256 * 2, dlo, dhi};
                    EpiMoeDown E{mtok, (const float*)(ws + WS_META + META_W), tb, (bf16_t*)(ws + WS_YBUF)};
#ifndef NO_MOEDOWN
                    g8::gemm_run(lds, 256, 256, S, E, g_wv);
#endif
                }
            }
        }
        SEAM(pb + PH_MOEDOWN);
#ifndef NO_COMBINE
        if (IN(pb + PH_COMBINE)) { unsigned char* ws = launder(args.ws); phase_combine(l, ws, args.out, BID(), nb, g_wv); }
#endif
        SEAM(pb + PH_COMBINE);
    }
#undef IN
#undef SEAM
}
#if CHECK
struct NvScratch { float *proj, *h1, *qk, *hraw, *kn, *kcmp, *vcmp, *dqn, *q, *dkvn, *kv, *krope, *y, *x1, *xl; int* rt_e; float* rt_w; };
constexpr int CB = 5;
enum { NS_INPROJ = 0, NS_NSAPREP, NS_MLAPREP, NS_NSA, NS_ML, NS_MLA, NS_OUT, NS_ROUTE, NS_MOE };
static void naive_step(void* const* d_in, int l, int step, const float* xin, float* xout, const NvScratch& S, hipStream_t st) {
    const int b = CB;
    const float* rel_bias = (const float*)d_in[2];
    const float* norm1_g = (const float*)d_in[3] + (long)l * 1024;
    const float* w_in = (const float*)d_in[4] + (long)l * 1024 * DIN;
    const float* cmp_pe = (const float*)d_in[5] + (long)l * 2 * 32 * 64;
    const float* cmp_w1 = (const float*)d_in[6] + (long)l * 2 * 32 * 64 * 64;
    const float* cmp_w2 = (const float*)d_in[7] + (long)l * 2 * 64 * 64;
    const float* q_norm = (const float*)d_in[8] + l * 64;
    const float* k_norm = (const float*)d_in[9] + l * 64;
    const float* nsa_on = (const float*)d_in[10] + l * 384;
    const float* conv = (const float*)d_in[11] + l * 4 * 512;
    const float* ibias = (const float*)d_in[12] + l * 4;
    const float* fbias = (const float*)d_in[13] + l * 4;
    const float* ml_on = (const float*)d_in[14] + l * 256;
    const float* qan = (const float*)d_in[15] + l * 192;
    const float* w_uq = (const float*)d_in[16] + (long)l * 192 * 576;
    const float* kvan = (const float*)d_in[17] + l * 128;
    const float* w_ukv = (const float*)d_in[18] + (long)l * 128 * 768;
    const float* qkn = (const float*)d_in[19] + l * 192;
    const float* mla_on = (const float*)d_in[20] + l * 384;
    const float* w_out = (const float*)d_in[21] + (long)l * 1024 * 1024;
    const float* norm2_g = (const float*)d_in[22] + l * 1024;
    const float* wgrp = (const float*)d_in[23] + (long)l * 1024 * 4;
    const float* bgrp = (const float*)d_in[24] + l * 4;
    const float* wexp = (const float*)d_in[25] + (long)l * 1024 * 32;
    const float* bexp = (const float*)d_in[26] + l * 32;
    const float* Wg = (const float*)d_in[27] + (long)l * 32 * 1024 * 256;
    const float* Wu = (const float*)d_in[28] + (long)l * 32 * 1024 * 256;
    const float* Wd = (const float*)d_in[29] + (long)l * 32 * 256 * 1024;
    const int* pos = (const int*)d_in[1] + b * 2048;
    switch (step) {
    case NS_INPROJ:
        nv_rmsnorm<<<dim3(2048, 1), 64, 0, st>>>(xin, 1024, 0, S.h1, 1024, 0, norm1_g, 0, 1024);
        nv_gemm<<<dim3((DIN + 63) / 64, 2048 / 64), 256, 0, st>>>(S.h1, 1024, w_in, DIN, S.proj, DIN, nullptr, 0, 2048, DIN, 1024);
        break;
    case NS_NSAPREP:
        nv_nsa_cmp<<<dim3(127, 2, 2), 64, 0, st>>>(S.proj, cmp_pe, cmp_w1, cmp_w2, k_norm, S.kcmp, S.vcmp);
        nv_nsa_knorm<<<dim3(2048, 4), 64, 0, st>>>(S.proj, k_norm, S.kn);
        break;
    case NS_MLAPREP:
        nv_rmsnorm<<<dim3(2048, 1), 64, 0, st>>>(S.proj + O_CDQ, DIN, 0, S.dqn, 192, 0, qan, 0, 192);
        nv_gemm<<<dim3(576 / 64, 2048 / 64), 256, 0, st>>>(S.dqn, 192, w_uq, 576, S.q, 576, nullptr, 0, 2048, 576, 192);
        nv_rmsnorm<<<dim3(2048, 1), 64, 0, st>>>(S.proj + O_CDKV, DIN, 0, S.dkvn, 128, 0, kvan, 0, 128);
        nv_gemm<<<dim3(768 / 64, 2048 / 64), 256, 0, st>>>(S.dkvn, 128, w_ukv, 768, S.kv, 768, nullptr, 0, 2048, 768, 128);
        nv_mla_prep<<<dim3(2048, 7), 64, 0, st>>>(S.q, S.kv, S.proj, S.krope, qkn, pos);
        break;
    case NS_NSA:
        nv_nsa_attn<<<dim3(2048, 2), 192, 0, st>>>(S.proj, S.kn, S.kcmp, S.vcmp, rel_bias, q_norm, S.y);
        break;
    case NS_ML:
        nv_ml_conv<<<2048, 512, 0, st>>>(S.proj, conv, S.qk);
        nv_ml_rec<<<4, 256, 0, st>>>(S.proj, S.qk, ibias, fbias, S.hraw);
        nv_ml_fin<<<dim3(2048, 4), 64, 0, st>>>(S.proj, S.hraw, ml_on, S.y);
        break;
    case NS_MLA:
        nv_mla_attn<<<dim3(2048, 6), 64, 0, st>>>(S.q, S.kv, S.krope, S.y);
        break;
    case NS_OUT:
        nv_rmsnorm<<<dim3(2048, 1), 64, 0, st>>>(S.y, 1024, 0, S.y, 1024, 0, nsa_on, 0, 384);
        nv_rmsnorm<<<dim3(2048, 1), 64, 0, st>>>(S.y + 640, 1024, 0, S.y + 640, 1024, 0, mla_on, 0, 384);
        nv_gemm<<<dim3(1024 / 64, 2048 / 64), 256, 0, st>>>(S.y, 1024, w_out, 1024, S.x1, 1024, xin, 1024, 2048, 1024, 1024);
        break;
    case NS_ROUTE:
        nv_moe_route<<<2048, 64, 0, st>>>(S.x1, norm2_g, wgrp, bgrp, wexp, bexp, S.h1, S.rt_e, S.rt_w);
        break;
    case NS_MOE:
        nv_moe_exp<<<2048, 256, 0, st>>>(S.x1, S.h1, S.rt_e, S.rt_w, Wg, Wu, Wd, xout);
        break;
    }
}

__device__ __forceinline__ void chk_commit(float d2, float r2, float* acc) { d2 = wave_sum(d2); r2 = wave_sum(r2); if ((threadIdx.x & 63) == 0) { atomicAdd(acc, d2); atomicAdd(acc + 1, r2); } }
__device__ __forceinline__ void chk_add(float f, float r, float& d2, float& r2) { const float d = f - r; d2 += (d == d) ? d * d : 1e30f; r2 += r * r; }

__global__ void __launch_bounds__(64) chk_proj(const float* nproj, const unsigned char* prj, const float* ssq_dq, const float* ssq_dkv, const float* qg, const float* kg, const float* krg, const int* pos, float* acc) {
    const int t = blockIdx.x, e = threadIdx.x; const size_t row = (size_t)CB * 2048 + t; float d2 = 0.f, r2 = 0.f;
    for (int G = 0; G < 40; ++G) {
        const int c = inproj_refcol(G, e); float r = c < 0 ? 0.f : nproj[(size_t)t * DIN + c]; float f = 0.f;
        const float rr = (G == 37 && e >= 32) ? 0.f : r; const float ss = wave_sum(rr * rr);
        if (G < 6) { r = r * rsqrtf(ss / 64.f + 1e-6f) * qg[e] * 0.18033688f; f = bf2f(((const bf16_t*)(prj + PRJ_QN))[((size_t)(CB * 6 + G) * 2048 + t) * 64 + e]); }
        else if (G < 18) { const int a = G - 6, br = a >> 2, s = (a >> 1) & 1, hk = a & 1;
            if (br > 0 && s == 0) r = r * rsqrtf(ss / 64.f + 1e-6f) * kg[e];
            const size_t base = br == 0 ? (s ? PRJ_C0V : PRJ_C0K) : (br == 1 ? (s ? PRJ_VN1 : PRJ_KN1) : (s ? PRJ_VN2 : PRJ_KN2));
            f = bf2f(((const bf16_t*)(prj + base))[((size_t)(CB * 2 + hk) * 2048 + t) * 64 + e]); }
        else if (G < 26) f = bf2f(((const bf16_t*)(prj + PRJ_RAWQK))[row * 512 + (G - 18) * 64 + e]);
        else if (G < 30) f = bf2f(((const bf16_t*)(prj + PRJ_VML))[((size_t)(CB * 4 + (G - 26)) * 2048 + t) * 64 + e]);
        else if (G < 34) f = bf2f(((const bf16_t*)(prj + PRJ_OG))[row * 256 + (G - 30) * 64 + e]);
        else if (G < 37) f = bf2f(((const bf16_t*)(prj + PRJ_DQKV))[row * 384 + (G - 34) * 64 + e]);
        else if (G == 37) {
            const float val = e < 32 ? rr * rsqrtf(ss / 32.f + 1e-6f) * krg[e & 31] : 0.f; const float oth = __shfl_xor(val, 16);
            if (e < 32) { const int i = e & 15; const double ang = (double)pos[row] * pow(10000.0, -(double)i / 16.0); const float cs = (float)cos(ang), sn = (float)sin(ang);
                r = e < 16 ? val * cs - oth * sn : val * cs + oth * sn; f = bf2f(((const bf16_t*)(prj + PRJ_KR))[row * 32 + e]); }
            else if (e < 58) f = ((const float*)(prj + PRJ_GATES))[row * 32 + (e - 32)];
            else { f = 0.f; r = 0.f; }
        }
        else f = bf2f(((const bf16_t*)(prj + PRJ_DQKV))[row * 384 + 256 + (G - 38) * 64 + e]);
        chk_add(f, r, d2, r2);
    }
    float d2s = 0.f, r2s = 0.f;
    { float s1 = 0.f, s2 = 0.f; for (int c = e; c < 192; c += 64) { float v = nproj[(size_t)t * DIN + O_CDQ + c]; s1 += v * v; } for (int c = e; c < 128; c += 64) { float v = nproj[(size_t)t * DIN + O_CDKV + c]; s2 += v * v; }
      s1 = wave_sum(s1); s2 = wave_sum(s2); if (e == 0) { chk_add((ssq_dq[row * 4] + ssq_dq[row * 4 + 1]) + ssq_dq[row * 4 + 2], s1, d2s, r2s); chk_add(ssq_dkv[row * 2] + ssq_dkv[row * 2 + 1], s2, d2s, r2s); } }
    chk_commit(d2, r2, acc); chk_commit(d2s, r2s, acc + 2);
}

__global__ void __launch_bounds__(64) chk_prep(const float* nq, const float* nkv, const float* nkr, const float* nkc, const float* nvc, const unsigned char* ws, float* acc) {
    const int t = blockIdx.x, e = threadIdx.x; float d2 = 0.f, r2 = 0.f, d2c = 0.f, r2c = 0.f; const float scale = 0.14724444f;
    const bf16_t* QM = (const bf16_t*)(ws + WS_MLA); const bf16_t* KM = (const bf16_t*)(ws + WS_MLA + MLA_KM); const bf16_t* VM = (const bf16_t*)(ws + WS_MLA + MLA_VM);
    for (int h = 0; h < 6; ++h) {
        const size_t rq = ((size_t)(CB * 6 + h) * 2048 + t);
        chk_add(bf2f(QM[rq * 96 + e]), nq[(size_t)t * 576 + h * 96 + e] * scale, d2, r2);
        chk_add(bf2f(KM[rq * 96 + e]), nkv[(size_t)t * 768 + h * 128 + e], d2, r2);
        chk_add(bf2f(VM[rq * 64 + e]), nkv[(size_t)t * 768 + h * 128 + 64 + e], d2, r2);
        if (e < 32) { chk_add(bf2f(QM[rq * 96 + 64 + e]), nq[(size_t)t * 576 + h * 96 + 64 + e] * scale, d2, r2); chk_add(bf2f(KM[rq * 96 + 64 + e]), nkr[(size_t)t * 32 + e], d2, r2); }
    }
    if (t < 128) for (int hk = 0; hk < 2; ++hk) {
        const bf16_t* KC = (const bf16_t*)(ws + WS_CMP); const bf16_t* VC = (const bf16_t*)(ws + WS_CMP + CMP_V); const size_t rf = ((size_t)(CB * 2 + hk) * 128 + t) * 64 + e;
        chk_add(bf2f(KC[rf]), t < 127 ? nkc[(size_t)(hk * 127 + t) * 64 + e] : 0.f, d2c, r2c); chk_add(bf2f(VC[rf]), t < 127 ? nvc[(size_t)(hk * 127 + t) * 64 + e] : 0.f, d2c, r2c);
    }
    chk_commit(d2, r2, acc); chk_commit(d2c, r2c, acc + 2);
}

__global__ void __launch_bounds__(64) chk_y(const float* ny, const unsigned char* ws, float* acc, int nseg) {
    const int t = blockIdx.x, e = threadIdx.x; const bf16_t* Y = (const bf16_t*)(ws + WS_Y) + ((size_t)CB * 2048 + t) * 1024;
    float d2[3] = {0.f, 0.f, 0.f}, r2[3] = {0.f, 0.f, 0.f};
    for (int c = e; c < 1024; c += 64) { const int seg = c < 384 ? 0 : (c < 640 ? 1 : 2); const int cf = c < 384 ? c : (c < 640 ? 768 + (c - 384) : 384 + (c - 640)); const float f = bf2f(Y[cf]), r = ny[(size_t)t * 1024 + c];
        if (seg == 0) chk_add(f, r, d2[0], r2[0]); else if (seg == 1) chk_add(f, r, d2[1], r2[1]); else chk_add(f, r, d2[2], r2[2]); }
    if (nseg == 3) { chk_commit(d2[0], r2[0], acc); chk_commit(d2[1], r2[1], acc + 2); chk_commit(d2[2], r2[2], acc + 4); }
    else chk_commit(d2[0] + d2[1] + d2[2], r2[0] + r2[1] + r2[2], acc);
}

__global__ void __launch_bounds__(64) chk_x(const float* nx, const unsigned char* ws, float* acc) {
    const int t = blockIdx.x, e = threadIdx.x; const bf16_t* X = (const bf16_t*)(ws + WS_XB) + ((size_t)CB * 2048 + t) * 1024; float d2 = 0.f, r2 = 0.f;
    for (int c = e; c < 1024; c += 64) chk_add(bf2f(X[c]), nx[(size_t)t * 1024 + c], d2, r2);
    chk_commit(d2, r2, acc);
}

__global__ void __launch_bounds__(512) chk_code(float* acc, int nst, const float* nout) {
    __shared__ float sh[512];
    float s = 0.f; for (int i = threadIdx.x; i < 2048 * 1024; i += 512) { float v = nout[i]; s += v * v; }
    sh[threadIdx.x] = s; __syncthreads();
    if (threadIdx.x == 0) { float tot = 0.f; for (int i = 0; i < 512; ++i) tot += sh[i]; float rms = sqrtf(tot / (2048.f * 1024.f)); if (!(rms > 1e-3f && rms < 1e3f)) rms = 1.f;
        int code = 0;
        for (int st = 0; st < nst; ++st) { const float d2 = acc[2 * st], r2 = acc[2 * st + 1]; if (r2 == 0.f && d2 == 0.f) { if ((st & 15) >= 9) continue; code = (st + 1) * 4 + 3; break; } const float err = d2 / fmaxf(r2, 1e-30f);
            const float tol = CHK_TOL(st);
            if (!(err <= tol)) { const int cls = !(err < 1.f) ? 3 : (err >= 0.1f ? 2 : (err >= 0.01f ? 1 : 0)); code = (st + 1) * 4 + cls; break; } }
        acc[2 * 40] = rms * 32.f * exp2f(0.5f * (float)code); }
}
__global__ void __launch_bounds__(512) chk_fill(const float* acc, float* out) {
    const float K = acc[2 * 40];
    for (size_t i = (size_t)blockIdx.x * 512 + threadIdx.x; i < (size_t)NTOK * 1024; i += (size_t)gridDim.x * 512) out[i] = (i & 1) ? -K : K;
}
#endif

#if TIME_PH != -1
#ifndef TIME_Q
#define TIME_Q 6.f
#endif
#ifndef TIME_CAL
#define TIME_CAL 1.0f
#endif
__global__ void tm_acc(const unsigned long long* ts, float* best, int first) {
    int a = TIME_PH, b = TIME_PH + 1;
#ifdef TIME_PH_END
    b = TIME_PH_END;
#endif
    float T = 100.f; if (TIME_PH >= 0) T = (float)(ts[b] - ts[a]) * 0.01f;
    if (first || T < *best) *best = T;
}
__global__ void __launch_bounds__(512) tm_fill(const float* best, float* out) {
    float T = *best;
    T = exp2f(rintf(log2f(fmaxf(T, 1.f)) * TIME_Q) / TIME_Q);
    const float c = sqrtf(T) * TIME_CAL;
    for (size_t i = (size_t)blockIdx.x * 512 + threadIdx.x; i < (size_t)NTOK * 1024; i += (size_t)gridDim.x * 512) out[i] = (i & 1) ? -c : c;
}
#endif
static int g_grid = 0;
static bool setup_once(size_t ws_size) {
    if (g_grid) return g_grid > 0;
    if (ws_size < WS_END) { fprintf(stderr, "kernel_launch: workspace too small: %zu < %zu\n", ws_size, (size_t)WS_END); g_grid = -1; return false; }
    int dev = 0, cus = 0, per_cu = 0;
    if (hipGetDevice(&dev) != hipSuccess || hipDeviceGetAttribute(&cus, hipDeviceAttributeMultiprocessorCount, dev) != hipSuccess) { g_grid = -1; return false; }
    if (hipFuncSetAttribute((const void*)mk, hipFuncAttributeMaxDynamicSharedMemorySize, LDS_BYTES) != hipSuccess) { fprintf(stderr, "kernel_launch: hipFuncSetAttribute failed\n"); g_grid = -1; return false; }
    if (hipOccupancyMaxActiveBlocksPerMultiprocessor(&per_cu, (const void*)mk, 512, LDS_BYTES) != hipSuccess || per_cu < 1) { fprintf(stderr, "kernel_launch: occupancy query says %d\n", per_cu); }
    (void)hipGetLastError();
    g_grid = cus;
    return true;
}
static void launch_mk(const Args& a0, int lo, int hi, hipStream_t stream) { Args a = a0; a.ph_lo = lo; a.ph_hi = hi; hipLaunchKernelGGL(mk, dim3(g_grid), dim3(512), LDS_BYTES, stream, a); }

extern "C" void kernel_launch(void* const* d_in, const int* in_sizes, int n_in, void* d_out, int out_size, void* d_ws, size_t ws_size, hipStream_t stream) {
    if (!setup_once(ws_size)) return;
    unsigned char* ws = (unsigned char*)d_ws;
    (void)hipMemsetAsync(ws + WS_CTL, 0, ZERO_BYTES, stream);
    Args a{}; for (int i = 0; i < 30; ++i) a.in.p[i] = (const float*)d_in[i];
    a.out = (float*)d_out; a.ws = ws; a.ph_lo = 0; a.ph_hi = 0;
#if CHECK
    a.out = nullptr;
#endif
#if CHECK
    float* nb = (float*)d_out; size_t off = 0; NvScratch S;
    auto take = [&](size_t n) { float* p = nb + off; off += (n + 63) & ~(size_t)63; return p; };
    S.proj = take((size_t)2048 * DIN); S.h1 = take(2048 * 1024); S.qk = S.h1; S.hraw = S.qk + 2048 * 512; S.kn = S.hraw + 2048 * 256;
    S.kcmp = take(2 * 127 * 64); S.vcmp = take(2 * 127 * 64); S.dqn = take(2048 * 192); S.q = take(2048 * 576); S.dkvn = take(2048 * 128); S.kv = take(2048 * 768); S.x1 = S.dqn;
    S.krope = take(2048 * 32); S.y = take(2048 * 1024); S.xl = take(2048 * 1024); S.rt_e = (int*)take(2048 * 2); S.rt_w = take(2048 * 2);
    if (off * 4 > (size_t)NTOK * 1024 * 4) { fprintf(stderr, "naive scratch too big\n"); return; }
    float* acc = (float*)(ws + WS_CTL) + CW_CHK;
    launch_mk(a, 0, 1, stream);
    const float* nx_in = (const float*)d_in[0] + (size_t)CB * 2048 * 1024;
    int nst = 0;
    for (int l = 0; l < L_; ++l) {
        const int pb = 1 + l * NPH; const int sb = l * 16;
        launch_mk(a, pb + PH_INPROJ, pb + PH_INPROJ + 1, stream);
        naive_step(d_in, l, NS_INPROJ, nx_in, S.xl, S, stream);
        chk_proj<<<2048, 64, 0, stream>>>(S.proj, ws + WS_PRJ, (const float*)(ws + WS_SSQ + PT_DQ) + (size_t)l * 16384 * 4, (const float*)(ws + WS_SSQ + PT_DKV) + (size_t)l * 16384 * 2,
                                           (const float*)d_in[8] + l * 64, (const float*)d_in[9] + l * 64, (const float*)d_in[19] + l * 192 + 160, (const int*)d_in[1], acc + 2 * (sb + 0));
        nst = sb + 2;
        int ns_done = NS_INPROJ;
#if CHECK_UPTO >= 1
        launch_mk(a, pb + PH_PREP, pb + PH_PREP + 1, stream);
        naive_step(d_in, l, NS_NSAPREP, nx_in, S.xl, S, stream); naive_step(d_in, l, NS_MLAPREP, nx_in, S.xl, S, stream); ns_done = NS_MLAPREP;
        chk_prep<<<2048, 64, 0, stream>>>(S.q, S.kv, S.krope, S.kcmp, S.vcmp, ws, acc + 2 * (sb + 2));
        nst = sb + 4;
#endif
#if CHECK_UPTO >= 2
        launch_mk(a, pb + PH_MIX, pb + PH_MIX + 1, stream);
        naive_step(d_in, l, NS_NSA, nx_in, S.xl, S, stream); naive_step(d_in, l, NS_ML, nx_in, S.xl, S, stream); naive_step(d_in, l, NS_MLA, nx_in, S.xl, S, stream); ns_done = NS_MLA;
        chk_y<<<2048, 64, 0, stream>>>(S.y, ws, acc + 2 * (sb + 4), 3);
        nst = sb + 7;
#endif
#if CHECK_UPTO >= 3
        launch_mk(a, pb + PH_YNORM, pb + PH_YNORM + 1, stream); launch_mk(a, pb + PH_OUTPROJ, pb + PH_OUTPROJ + 1, stream);
        naive_step(d_in, l, NS_OUT, nx_in, S.xl, S, stream); ns_done = NS_OUT;
        chk_x<<<2048, 64, 0, stream>>>(S.x1, ws, acc + 2 * (sb + 7));
        nst = sb + 8;
#endif
#if CHECK_UPTO >= 4
        for (int ph = PH_ROUTE; ph <= PH_COMBINE; ++ph) launch_mk(a, pb + ph, pb + ph + 1, stream);
        naive_step(d_in, l, NS_ROUTE, nx_in, S.xl, S, stream); naive_step(d_in, l, NS_MOE, nx_in, S.xl, S, stream); ns_done = NS_MOE;
        chk_x<<<2048, 64, 0, stream>>>(S.xl, ws, acc + 2 * (sb + 8));
        nst = sb + 9;
#endif
        CHECK_REST
        for (int s = ns_done + 1; s <= NS_MOE; ++s) naive_step(d_in, l, s, nx_in, S.xl, S, stream);
        nx_in = S.xl;
        if (l == CHECK_LAYERS - 1) break;
    }
    chk_code<<<1, 512, 0, stream>>>(acc, nst, S.xl);
    chk_fill<<<1024, 512, 0, stream>>>(acc, (float*)d_out);
#else
#if defined(SPLIT_LAUNCH) && SPLIT_LAUNCH
    for (int ph = 0; ph < 1 + L_ * NPH; ++ph) launch_mk(a, ph, ph + 1, stream);
#else
    launch_mk(a, 0, 1 + L_ * NPH, stream);
#if TIME_PH != -1
    for (int rp = 0; rp < 6; ++rp) {
        (void)hipMemsetAsync(ws + WS_CTL, 0, ZERO_BYTES, stream); launch_mk(a, 0, 1 + L_ * NPH, stream);
        tm_acc<<<1, 1, 0, stream>>>((const unsigned long long*)((unsigned*)(ws + WS_CTL) + CW_TS), (float*)(ws + WS_META + META_RT), rp == 0);
    }
    tm_fill<<<1024, 512, 0, stream>>>((const float*)(ws + WS_META + META_RT), (float*)d_out);
#endif
#endif
#endif
}
```

```cpp
#define CHECK 0
#define CHECK_LAYERS 2
#define CHECK_UPTO 99
#define SPLIT_LAUNCH 0
#define REPEAT_PH -1
#include <hip/hip_runtime.h>
#include <stdint.h>
#include <cstdio>

constexpr int B_ = 8, T_ = 2048, D_ = 1024, L_ = 2, NTOK = B_ * T_;
constexpr int DIN = 2554;
constexpr int O_AQ = 0, O_AKV = 384, O_AG = 1152, O_BQK = 1170, O_BV = 1682, O_BIF = 1938, O_BO = 1946, O_CDQ = 2202, O_CDKV = 2394, O_CKR = 2522;

typedef unsigned short bf16_t;
typedef short bf16x8 __attribute__((ext_vector_type(8)));
typedef short s16x4 __attribute__((ext_vector_type(4)));
typedef float f32x4 __attribute__((ext_vector_type(4)));
typedef float f32x16 __attribute__((ext_vector_type(16)));
typedef unsigned u32x4 __attribute__((ext_vector_type(4)));
typedef unsigned u32x2 __attribute__((ext_vector_type(2)));
typedef float f32x2_t __attribute__((ext_vector_type(2)));
typedef __bf16 bf16x2_t __attribute__((ext_vector_type(2)));
#define LAS __attribute__((address_space(3)))

__device__ __forceinline__ unsigned pk_bf16(float lo, float hi) { f32x2_t v = {lo, hi}; bf16x2_t b = __builtin_convertvector(v, bf16x2_t); return __builtin_bit_cast(unsigned, b); }
__device__ __forceinline__ float bf_lo(unsigned u) { return __builtin_bit_cast(float, u << 16); }
__device__ __forceinline__ float bf_hi(unsigned u) { return __builtin_bit_cast(float, u & 0xffff0000u); }
__device__ __forceinline__ float bf2f(bf16_t h) { return __builtin_bit_cast(float, (unsigned)h << 16); }
__device__ __forceinline__ bf16_t f2bf(float f) { return (bf16_t)(pk_bf16(f, 0.f) & 0xffffu); }
template <int M> __device__ __forceinline__ int shx(int v) { static_assert(M > 0 && M < 32, "swizzle xor mask"); return __builtin_amdgcn_ds_swizzle(v, (M << 10) | 0x1f); }
template <int M> __device__ __forceinline__ float shx(float v) { return __builtin_bit_cast(float, shx<M>(__builtin_bit_cast(int, v))); }
template <int M> __device__ __forceinline__ unsigned shx(unsigned v) { return (unsigned)shx<M>((int)v); }
__device__ __forceinline__ float wave_sum(float v) { v += __shfl_xor(v, 32); v += shx<16>(v); v += shx<8>(v); v += shx<4>(v); v += shx<2>(v); v += shx<1>(v); return v; }
__device__ __forceinline__ float wave_max(float v) { v = fmaxf(v, __shfl_xor(v, 32)); v = fmaxf(v, shx<16>(v)); v = fmaxf(v, shx<8>(v)); v = fmaxf(v, shx<4>(v)); v = fmaxf(v, shx<2>(v)); v = fmaxf(v, shx<1>(v)); return v; }
__device__ __forceinline__ float siluf(float x) { return x * __builtin_amdgcn_rcpf(1.f + __expf(-x)); }
__device__ __forceinline__ float sigmf(float x) { return __builtin_amdgcn_rcpf(1.f + __expf(-x)); }
__device__ __forceinline__ int t5b(int dist) {
    int n = dist > 0 ? dist : 0; if (n < 16) return n;
    float v = logf((float)n / 16.f) / logf(8.f) * 16.f; int l = 16 + (int)v; return l < 31 ? l : 31;
}

__device__ __forceinline__ int lane_now() { return (int)__builtin_amdgcn_mbcnt_hi(~0u, __builtin_amdgcn_mbcnt_lo(~0u, 0u)); }
#define TIDX ((g_wv << 6) | lane_now())

constexpr size_t WS_CTL = 0, CTL_BYTES = 65536;
constexpr size_t WS_SSQ = WS_CTL + CTL_BYTES;
constexpr size_t ZERO_BYTES = CTL_BYTES;
constexpr size_t PT_DQ = 0, PT_DKV = PT_DQ + (size_t)2 * 16384 * 4 * 4, PT_A = PT_DKV + (size_t)2 * 16384 * 2 * 4, PT_C = PT_A + (size_t)2 * 16384 * 8 * 4, PT_X1 = PT_C + (size_t)2 * 16384 * 8 * 4, PT_END = PT_X1 + (size_t)2 * 16384 * 16 * 4;
constexpr size_t WS_SSQX = WS_SSQ + PT_END;
constexpr size_t WS_RS2 = WS_SSQX + 2 * 65536;
constexpr size_t WS_WIN = WS_RS2 + 65536;
constexpr size_t WS_WOUT = WS_WIN + (size_t)2 * 2560 * 1024 * 2;
constexpr size_t WS_WUQ = WS_WOUT + (size_t)2 * 1024 * 1024 * 2;
constexpr size_t WS_WUKV = WS_WUQ + (size_t)2 * 768 * 256 * 2;
constexpr size_t WS_WC1 = WS_WUKV + (size_t)2 * 768 * 256 * 2;
constexpr size_t WS_WC2 = WS_WC1 + (size_t)2 * 2 * 64 * 2048 * 2;
constexpr size_t WS_WR = WS_WC2 + (size_t)2 * 2 * 64 * 64 * 2;
constexpr size_t WS_B1C = WS_WR + (size_t)2 * 64 * 1024 * 2;
constexpr size_t WS_BIASD = WS_B1C + 1024;
constexpr size_t WS_ROPE = WS_BIASD + 6 * 2048 * 4;
constexpr size_t WS_WMOE = WS_ROPE + (size_t)16384 * 32 * 4;
constexpr size_t WMOE_WD = (size_t)32 * 512 * 1024 * 2;
constexpr size_t WS_XB = WS_WMOE + 50331648;
constexpr size_t WS_MLA = WS_XB + 33554432;
constexpr size_t MLA_KM = (size_t)8 * 6 * 2048 * 96 * 2, MLA_VM = 2 * MLA_KM;
constexpr size_t WS_HBUF = WS_MLA;
constexpr size_t WS_PRJ = WS_MLA + 50331648;
constexpr size_t HM64 = (size_t)2048 * 64 * 2;
constexpr size_t PRJ_QN = 0;
constexpr size_t PRJ_KN1 = PRJ_QN + 48 * HM64, PRJ_VN1 = PRJ_KN1 + 16 * HM64, PRJ_KN2 = PRJ_VN1 + 16 * HM64, PRJ_VN2 = PRJ_KN2 + 16 * HM64;
constexpr size_t PRJ_VML = PRJ_VN2 + 16 * HM64;
constexpr size_t PRJ_OG = PRJ_VML + 32 * HM64;
constexpr size_t PRJ_KR = PRJ_OG + (size_t)16384 * 256 * 2;
constexpr size_t PRJ_GATES = PRJ_KR + (size_t)16384 * 32 * 2;
constexpr size_t PRJ_DEAD = PRJ_GATES + (size_t)16384 * 32 * 4;
constexpr size_t PRJ_C0K = PRJ_DEAD, PRJ_C0V = PRJ_C0K + 16 * HM64 + 8192;
constexpr size_t PRJ_RAWQK = PRJ_C0V + 16 * HM64 + 8192;
constexpr size_t PRJ_DQKV = PRJ_RAWQK + (size_t)16384 * 512 * 2;
constexpr size_t PRJ_END = PRJ_DQKV + (size_t)16384 * 384 * 2;
static_assert(PRJ_END - PRJ_DEAD >= 33554432, "Y fits the dead part of PRJ");
constexpr size_t WS_Y = WS_PRJ + PRJ_DEAD;
constexpr size_t WS_YBUF = WS_PRJ;
static_assert((size_t)2 * 16384 * 1024 * 2 <= PRJ_END, "YBUF fits the PRJ region");
constexpr size_t WS_ML = WS_PRJ + PRJ_END;
constexpr size_t ML_KC = 32 * HM64, ML_DELTA = 2 * ML_KC, ML_DN = ML_DELTA + (size_t)1024 * 4096 * 2, ML_G = ML_DN + (size_t)1024 * 64 * 4, ML_BL = ML_G + (size_t)8 * 4 * 2048 * 2 * 4, ML_CP = ML_BL + 4096, ML_NP = ML_CP + (size_t)1024 * 4096 * 2, ML_END = ML_NP + (size_t)1024 * 64 * 2;
constexpr size_t WS_CMP = WS_ML + ML_END;
constexpr size_t CMP_V = (size_t)8 * 2 * 128 * 64 * 2;
constexpr size_t WS_META = WS_CMP + 2 * CMP_V;
constexpr size_t META_W = (size_t)32 * 16384 * 4, META_RT = 2 * META_W;
constexpr size_t WS_END = WS_META + META_RT + (size_t)16384 * 16;
constexpr int CW_BAR = 0;
constexpr int CW_Q = 4096;
constexpr int CW_SCAN = 4608;
constexpr int CW_TS = 4864;
constexpr int CW_CHK = 5120;
constexpr int CW_CNT = 8192;
constexpr int LDS_BYTES = 147456;
constexpr int LDS_MISC = LDS_BYTES - 256;
#define XB_TMO      128
#define XB_XCNT(j)  (256  + 64 * (j))
#define XB_XSUB(j)  (1280 + 64 * (j))
#define XB_XGEN(j)  (2304 + 64 * (j))
#define XB_TOP      3328
#define XB_TOPGEN   3392
#define XCD_BAR_WORDS 3456
#define XB_SPIN_CAP (1u << 18)

__device__ __forceinline__ unsigned xb_ld(unsigned* p)              { return __hip_atomic_load(p, __ATOMIC_RELAXED, __HIP_MEMORY_SCOPE_AGENT); }
__device__ __forceinline__ unsigned xb_add(unsigned* p, unsigned v) { return __hip_atomic_fetch_add(p, v, __ATOMIC_RELAXED, __HIP_MEMORY_SCOPE_AGENT); }
__device__ __forceinline__ unsigned xb_xcc_id() { return (unsigned)__builtin_amdgcn_s_getreg((3 << 11) | 20) & 0xFu; }
#define XB_SPIN(cond, bar) do { unsigned _sp = 0; while (cond) { __builtin_amdgcn_s_sleep(1); \
    if ((++_sp & 255u) == 0u) { if (xb_ld(&(bar)[XB_TMO])) break; if (_sp > XB_SPIN_CAP) { atomicAdd(&(bar)[XB_TMO], 1u); break; } } } } while (0)

struct XcdBarrier {
    int g_wv; unsigned* bar; unsigned x;
    volatile LAS unsigned* st;
};

__device__ __forceinline__ XcdBarrier xcd_barrier_post(unsigned* bar, volatile LAS unsigned* st, int g_wv) {
    XcdBarrier b; b.g_wv = g_wv; b.bar = bar; b.x = xb_xcc_id(); b.st = st;
    if (TIDX == 0) (void)xb_add(&bar[XB_XCNT(b.x)], 1u);
    return b;
}
__device__ __forceinline__ void xcd_barrier_complete(unsigned* bar, unsigned x, unsigned& nloc, unsigned& nx) {
    const unsigned G = gridDim.x * gridDim.y * gridDim.z;
    unsigned sum, cnt, mine, sp = 0u;
    for (;;) {
        sum = 0u; cnt = 0u; mine = 0u;
#pragma unroll
        for (unsigned j = 0; j < 16; ++j) { const unsigned c = xb_ld(&bar[XB_XCNT(j)]); sum += c; cnt += (c > 0u) ? 1u : 0u; mine = (j == x) ? c : mine; }
        if (sum == G) break;
        __builtin_amdgcn_s_sleep(1);
        if ((++sp & 255u) == 0u) { if (xb_ld(&bar[XB_TMO])) break; if (sp > XB_SPIN_CAP) { atomicAdd(&bar[XB_TMO], 1u); break; } }
    }
    nloc = mine > 0u ? mine : 1u; nx = cnt > 0u ? cnt : 1u;
}

__device__ __forceinline__ void xcd_barrier(const XcdBarrier& b) {
    asm volatile("s_waitcnt vmcnt(0)" ::: "memory");
    __syncthreads();
    const int g_wv = b.g_wv;
    if (TIDX == 0) {
        unsigned* bar = b.bar;
        __builtin_amdgcn_s_waitcnt(0);
        unsigned nloc = b.st[0], nx = b.st[1];
        if (nloc == 0u) { xcd_barrier_complete(bar, b.x, nloc, nx); b.st[0] = nloc; b.st[1] = nx; }
        const unsigned old = xb_add(&bar[XB_XSUB(b.x)], 1u);
        const unsigned gen = old / nloc;
        if (old + 1u == (gen + 1u) * nloc) {
            __builtin_amdgcn_fence(__ATOMIC_RELEASE, "agent");
            asm volatile("s_waitcnt vmcnt(0)" ::: "memory");
            const unsigned og = xb_add(&bar[XB_TOP], 1u);
            const unsigned tg = og / nx;
            if (og + 1u == (tg + 1u) * nx) xb_add(&bar[XB_TOPGEN], 1u);
            else XB_SPIN(xb_ld(&bar[XB_TOPGEN]) == tg, bar);
            __builtin_amdgcn_fence(__ATOMIC_ACQUIRE, "agent");
            xb_add(&bar[XB_XGEN(b.x)], 1u);
            asm volatile("s_waitcnt vmcnt(0)" ::: "memory");
        } else {
            XB_SPIN(xb_ld(&bar[XB_XGEN(b.x)]) == gen, bar);
            __builtin_amdgcn_fence(__ATOMIC_ACQUIRE, "agent");
            asm volatile("s_waitcnt vmcnt(0)" ::: "memory");
        }
    }
    __syncthreads();
}
struct Inputs { const float* p[30]; };
typedef const __attribute__((address_space(4))) Inputs* InPtr;
__device__ __forceinline__ InPtr in_tab() { InPtr p = (InPtr)__builtin_amdgcn_kernarg_segment_ptr(); asm volatile("" : "+s"(p)); return p; }
__device__ __forceinline__ unsigned char* launder(unsigned char* p) { size_t z = 0; asm volatile("" : "+s"(z)); return p + z; }

__host__ __device__ inline int inproj_refcol(int G, int e) {
    if (G < 6) return O_AQ + G * 64 + e;
    if (G < 18) return O_AKV + (G - 6) * 64 + e;
    if (G < 26) return O_BQK + (G - 18) * 64 + e;
    if (G < 30) return O_BV + (G - 26) * 64 + e;
    if (G < 34) return O_BO + (G - 30) * 64 + e;
    if (G < 37) return O_CDQ + (G - 34) * 64 + e;
    if (G == 37) { if (e < 32) return O_CKR + e; if (e < 50) return O_AG + (e - 32); if (e < 58) return O_BIF + (e - 50); return -1; }
    return O_CDKV + (G - 38) * 64 + e;
}
__host__ __device__ inline int uq_refcol(int G, int e) {
    if (G < 6) return G * 96 + e;
    if (G < 9) { const int idx = e & 31, bj = e >> 5, sub = idx >> 4, i = idx & 15; return (2 * (G - 6) + sub) * 96 + 64 + bj * 16 + i; }
    return -1;
}
__host__ __device__ inline int ukv_refcol(int G, int e) { return G < 6 ? G * 128 + e : (G - 6) * 128 + 64 + e; }
#define N2G(n) ((((n) >> 8) << 2) + (((n) >> 5) & 3))
#define N2E(n) (((((n) >> 7) & 1) << 5) + ((n) & 31))

__device__ __forceinline__ float opaque_f(float v) { asm volatile("" : "+v"(v)); return v; }
struct FWin { const float* w; const float* g; __device__ __forceinline__ void ld(int k, int n, const float*& p, float& gn, float gk) const { const int c = inproj_refcol(N2G(n), N2E(n)); p = w + (size_t)k * DIN + (c < 0 ? 0 : c); gn = c < 0 ? 0.f : gk; }
    __device__ __forceinline__ float rowgain(int k) const { return opaque_f(g[k]); } };
struct FWout { const float* w; const float* ga; const float* gc; __device__ __forceinline__ void ld(int k, int n, const float*& p, float& gn, float gk) const {
    const int kr = k < 384 ? k : (k < 768 ? 640 + (k - 384) : 384 + (k - 768)); p = w + (size_t)kr * 1024 + n; gn = gk; }
    __device__ __forceinline__ float rowgain(int k) const { const float a = opaque_f(ga[k < 384 ? k : 0]), c = opaque_f(gc[(k >= 384 && k < 768) ? k - 384 : 0]); return k < 384 ? a : (k < 768 ? c : 1.f); } };
struct FWuq { const float* w; const float* g; __device__ __forceinline__ void ld(int k, int n, const float*& p, float& gn, float gk) const { const int c = uq_refcol(N2G(n), N2E(n)); const int kk = k < 192 ? k : 191; p = w + (size_t)kk * 576 + (c < 0 ? 0 : c); gn = (k < 192 && c >= 0) ? gk : 0.f; }
    __device__ __forceinline__ float rowgain(int k) const { return opaque_f(g[k < 192 ? k : 191]); } };
struct FWukv { const float* w; const float* g; __device__ __forceinline__ void ld(int k, int n, const float*& p, float& gn, float gk) const { const int c = ukv_refcol(N2G(n), N2E(n)); const int kk = k >= 128 ? k - 128 : 0; p = w + (size_t)kk * 768 + c; gn = k >= 128 ? gk : 0.f; }
    __device__ __forceinline__ float rowgain(int k) const { return opaque_f(g[k >= 128 ? k - 128 : 0]); } };
struct FWc1 { const float* w; __device__ __forceinline__ void ld(int k, int n, const float*& p, float& gn, float gk) const { p = w + (size_t)k * 64 + n; gn = 1.f; }
    __device__ __forceinline__ float rowgain(int k) const { return 1.f; } };
struct FWr { const float* wg; const float* we; const float* g; __device__ __forceinline__ void ld(int k, int n, const float*& p, float& gn, float gk) const { p = n < 4 ? wg + k * 4 + n : we + k * 32 + (n < 36 ? n - 4 : 0); gn = n < 36 ? gk : 0.f; }
    __device__ __forceinline__ float rowgain(int k) const { return opaque_f(g[k]); } };
struct FWgu { const float* src; const float* g; int n0, col0; __device__ __forceinline__ float operator()(int k, int n) const { return src[(size_t)k * 256 + col0 + (n - n0)] * g[k]; } };
struct FWd { const float* w; __device__ __forceinline__ float operator()(int k, int n) const { return w[(size_t)k * 1024 + n]; } };

__device__ __forceinline__ void rope_cs(int pos, int j, float& cs, float& sn) {
    const double inv = exp2(-(double)j * (13.287712379549449 / 16.0));
    const double rev = (double)pos * inv * 0.15915494309189535; const float f = (float)(rev - rint(rev));
    cs = __builtin_amdgcn_cosf(f); sn = __builtin_amdgcn_sinf(f);
}
template <class F>
__device__ __forceinline__ void cvt_tile(const F& f, int n0, int k0, bf16_t* dst, int ldk, LAS float* tile, int tid) {
    { const int k = tid >> 3, nb = (tid & 7) * 8; const float gk = f.rowgain(k0 + k); const float* p[8]; float gn[8], v[8];
#pragma unroll
      for (int j = 0; j < 8; ++j) f.ld(k0 + k, n0 + nb + j, p[j], gn[j], gk);
#pragma unroll
      for (int j = 0; j < 8; ++j) v[j] = *p[j];
#pragma unroll
      for (int j = 0; j < 8; ++j) tile[k * 65 + nb + j] = v[j] * gn[j]; }
    __syncthreads();
    { const int n = tid >> 3, kb = (tid & 7) * 8; const LAS float* s = tile + kb * 65 + n;
      u32x4 o; o.x = pk_bf16(s[0], s[65]); o.y = pk_bf16(s[130], s[195]); o.z = pk_bf16(s[260], s[325]); o.w = pk_bf16(s[390], s[455]);
      *(u32x4*)(dst + (size_t)(n0 + n) * ldk + k0 + kb) = o; }
    __syncthreads();
}
template <class F>
__device__ __forceinline__ void cvt_item(const F& f, int it, int nK, bf16_t* dst, int ldk, LAS float* tile, int tid) { cvt_tile(f, (it / nK) * 64, (it % nK) * 64, dst, ldk, tile, tid); }

__device__ __forceinline__ void moe_item(InPtr in, int l, int it, const float*& src, int& ld, size_t& dst, int& ldk, bool& gain, int& kk0) {
    if (it < 32 * 64) { const int e = it >> 6, r = it & 63, n0 = (r >> 3) * 64, k0 = (r & 7) * 128, c0 = n0 & 255;
        src = (c0 < 128 ? in->p[27] : in->p[28]) + ((size_t)l * 32 + e) * 262144 + (size_t)k0 * 256 + (n0 >> 8) * 128 + (c0 & 127); ld = 256; gain = true; kk0 = k0;
        dst = ((size_t)e * 512 + n0) * 1024 + k0; ldk = 1024; }
    else { const int j = it - 32 * 64, e = j >> 5, r = j & 31, n0 = (r >> 1) * 64, k0 = (r & 1) * 128;
        src = in->p[29] + ((size_t)l * 32 + e) * 262144 + (size_t)k0 * 1024 + n0; ld = 1024; gain = false; kk0 = 0;
        dst = (size_t)16777216 + ((size_t)e * 1024 + n0) * 256 + k0; ldk = 256; }
}
__device__ __forceinline__ void cvt_moe_layer(InPtr in, unsigned char* ws, int l, LAS float* tile, int bid, int nb, int tid, int it_lo = 0, int it_hi = 32 * (64 + 32)) {
    asm volatile("" : "+v"(tid));
    const float* g2 = in->p[22] + l * 1024; bf16_t* W = (bf16_t*)(ws + WS_WMOE);
    const int k = tid >> 3, nbq = (tid & 7) * 8;
    const int n = tid >> 3, kb = (tid & 7) * 8;
    const int NIT = it_hi;
#define CVM_LOAD(it_, P) do { const float* src_; int ld_, ldk_, kk0_; size_t dst_; bool gain_; moe_item(in, l, (it_), src_, ld_, dst_, ldk_, gain_, kk0_); \
        P##a = *(const f32x4*)(src_ + (size_t)k * ld_ + nbq); P##b = *(const f32x4*)(src_ + (size_t)k * ld_ + nbq + 4); P##c = *(const f32x4*)(src_ + (size_t)(k + 64) * ld_ + nbq); P##d = *(const f32x4*)(src_ + (size_t)(k + 64) * ld_ + nbq + 4); \
        P##g0 = gain_ ? g2[kk0_ + k] : 1.f; P##g1 = gain_ ? g2[kk0_ + 64 + k] : 1.f; } while (0)
#define CVM_PUT(t, P) do { \
        t[k * 65 + nbq + 0] = P##a.x * P##g0; t[k * 65 + nbq + 1] = P##a.y * P##g0; t[k * 65 + nbq + 2] = P##a.z * P##g0; t[k * 65 + nbq + 3] = P##a.w * P##g0; \
        t[k * 65 + nbq + 4] = P##b.x * P##g0; t[k * 65 + nbq + 5] = P##b.y * P##g0; t[k * 65 + nbq + 6] = P##b.z * P##g0; t[k * 65 + nbq + 7] = P##b.w * P##g0; \
        t[(k + 64) * 65 + nbq + 0] = P##c.x * P##g1; t[(k + 64) * 65 + nbq + 1] = P##c.y * P##g1; t[(k + 64) * 65 + nbq + 2] = P##c.z * P##g1; t[(k + 64) * 65 + nbq + 3] = P##c.w * P##g1; \
        t[(k + 64) * 65 + nbq + 4] = P##d.x * P##g1; t[(k + 64) * 65 + nbq + 5] = P##d.y * P##g1; t[(k + 64) * 65 + nbq + 6] = P##d.z * P##g1; t[(k + 64) * 65 + nbq + 7] = P##d.w * P##g1; } while (0)
#define CVM_STORE(it_, t) do { const float* src_; int ld_, ldk_, kk0_; size_t dst_; bool gain_; moe_item(in, l, (it_), src_, ld_, dst_, ldk_, gain_, kk0_); \
        _Pragma("unroll") for (int hh = 0; hh < 2; ++hh) { const LAS float* s_ = t + (64 * hh + kb) * 65 + n; \
            u32x4 o; o.x = pk_bf16(s_[0], s_[65]); o.y = pk_bf16(s_[130], s_[195]); o.z = pk_bf16(s_[260], s_[325]); o.w = pk_bf16(s_[390], s_[455]); \
            *(u32x4*)(W + dst_ + (size_t)n * ldk_ + 64 * hh + kb) = o; } } while (0)
    f32x4 Aa, Ab, Ac, Ad, Ba, Bb, Bc, Bd; float Ag0 = 1.f, Ag1 = 1.f, Bg0 = 1.f, Bg1 = 1.f;
    LAS float* t0 = tile; LAS float* t1 = tile + 128 * 65;
    int it = it_lo + bid;
    if (it < NIT) CVM_LOAD(it, A);
    if (it + nb < NIT) CVM_LOAD(it + nb, B);
#pragma unroll 1
    for (; it < NIT; it += 2 * nb) {
        CVM_PUT(t0, A);
        __syncthreads();
        if (it + 2 * nb < NIT) CVM_LOAD(it + 2 * nb, A);
        CVM_STORE(it, t0);
        if (it + nb < NIT) {
            CVM_PUT(t1, B);
            __syncthreads();
            if (it + 3 * nb < NIT) CVM_LOAD(it + 3 * nb, B);
            CVM_STORE(it + nb, t1);
        }
    }
#undef CVM_LOAD
#undef CVM_PUT
#undef CVM_STORE
    __syncthreads();
}

__device__ __forceinline__ void cvt_small_weights(InPtr in, unsigned char* ws, int l, LAS float* tile, int bid, int nb, int tid) {
    asm volatile("" : "+v"(tid));
    constexpr int I_WIN = 40 * 16, I_WOUT = 16 * 16, I_WU = 12 * 4, I_WC1 = 32, I_WC2 = 1, I_WR = 16;
    constexpr int PER_L = I_WIN + I_WOUT + 2 * I_WU + 2 * I_WC1 + 2 * I_WC2 + I_WR;
    for (int it0 = bid; it0 < PER_L; it0 += nb) {
        int it = it0;
        if (it < I_WIN) { FWin f{in->p[4] + (size_t)l * 1024 * DIN, in->p[3] + l * 1024}; cvt_item(f, it, 16, (bf16_t*)(ws + WS_WIN) + (size_t)l * 2560 * 1024, 1024, tile, tid); continue; } it -= I_WIN;
        if (it < I_WOUT) { FWout f{in->p[21] + (size_t)l * 1048576, in->p[10] + l * 384, in->p[20] + l * 384}; cvt_item(f, it, 16, (bf16_t*)(ws + WS_WOUT) + (size_t)l * 1048576, 1024, tile, tid); continue; } it -= I_WOUT;
        if (it < I_WU) { FWuq f{in->p[16] + (size_t)l * 192 * 576, in->p[15] + l * 192}; cvt_item(f, it, 4, (bf16_t*)(ws + WS_WUQ) + (size_t)l * 768 * 256, 256, tile, tid); continue; } it -= I_WU;
        if (it < I_WU) { FWukv f{in->p[18] + (size_t)l * 128 * 768, in->p[17] + l * 128}; cvt_item(f, it, 4, (bf16_t*)(ws + WS_WUKV) + (size_t)l * 768 * 256, 256, tile, tid); continue; } it -= I_WU;
        if (it < 2 * I_WC1) { const int s = it / I_WC1; FWc1 f{in->p[6] + ((size_t)l * 2 + s) * 2048 * 64}; cvt_item(f, it % I_WC1, 32, (bf16_t*)(ws + WS_WC1) + ((size_t)l * 2 + s) * 64 * 2048, 2048, tile, tid); continue; } it -= 2 * I_WC1;
        if (it < 2 * I_WC2) { const int s = it; FWc1 f{in->p[7] + ((size_t)l * 2 + s) * 64 * 64}; cvt_item(f, 0, 1, (bf16_t*)(ws + WS_WC2) + ((size_t)l * 2 + s) * 64 * 64, 64, tile, tid); continue; } it -= 2 * I_WC2;
        { FWr f{in->p[23] + (size_t)l * 4096, in->p[25] + (size_t)l * 32768, in->p[22] + l * 1024}; cvt_item(f, it, 16, (bf16_t*)(ws + WS_WR) + (size_t)l * 64 * 1024, 1024, tile, tid); }
    }
}

__device__ __forceinline__ void prologue(InPtr in, unsigned char* ws, LAS unsigned char* lds, int bid, int nb, int g_wv) {
    int tid_ = TIDX; asm volatile("" : "+v"(tid_));
    const int tid = tid_, lane = tid & 63, wid = tid >> 6;
    LAS float* tile = (LAS float*)lds;
    cvt_small_weights(in, ws, 0, tile, bid, nb, tid);
    { const float* x = in->p[0]; bf16_t* XB = (bf16_t*)(ws + WS_XB); float* ssqx = (float*)(ws + WS_SSQX);
      for (int r = bid * 8 + wid; r < NTOK; r += nb * 8) {
          const f32x4* xr = (const f32x4*)(x + (size_t)r * 1024) + lane; float s = 0.f; u32x2* o = (u32x2*)(XB + (size_t)r * 1024) + lane;
#pragma unroll
          for (int j = 0; j < 4; ++j) { const f32x4 v = xr[64 * j]; s += (v.x * v.x + v.y * v.y) + (v.z * v.z + v.w * v.w); u32x2 w; w.x = pk_bf16(v.x, v.y); w.y = pk_bf16(v.z, v.w); o[64 * j] = w; }
          s = wave_sum(s); if (lane == 0) ssqx[r] = s;
      } }
    { float* biasd = (float*)(ws + WS_BIASD); const float* rb = in->p[2];
      for (int i = bid * 512 + tid; i < 6 * 2048; i += nb * 512) { const int h = i >> 11, d = i & 2047; biasd[i] = rb[t5b(d) * 6 + h] * 1.44269504f; } }
    { float* rope = (float*)(ws + WS_ROPE); const int* pos = (const int*)in->p[1];
      for (int i = bid * 512 + tid; i < NTOK * 16; i += nb * 512) { const int tk = i >> 4, j = i & 15; float cs, sn; rope_cs(pos[tk], j, cs, sn); rope[(size_t)tk * 32 + j] = cs; rope[(size_t)tk * 32 + 16 + j] = sn; } }
    { float* b1c = (float*)(ws + WS_B1C); LAS float* red = (LAS float*)lds;
      for (int it = nb - 1 - bid; it >= 0 && it < 4; it += nb) { const float* pe = in->p[5] + (size_t)it * 2048; const float* w1 = in->p[6] + (size_t)it * 2048 * 64; const int f4 = tid & 15, kp = tid >> 4;
          f32x4 a = (f32x4){0.f, 0.f, 0.f, 0.f};
#pragma unroll 1
          for (int k0 = kp * 64; k0 < kp * 64 + 64; k0 += 16) { f32x4 wv[16]; float pv[16];
#pragma unroll
              for (int j = 0; j < 16; ++j) { wv[j] = *(const f32x4*)(w1 + (size_t)(k0 + j) * 64 + 4 * f4); pv[j] = pe[k0 + j]; }
#pragma unroll
              for (int j = 0; j < 16; ++j) { a.x += pv[j] * wv[j].x; a.y += pv[j] * wv[j].y; a.z += pv[j] * wv[j].z; a.w += pv[j] * wv[j].w; } }
          __syncthreads(); *(LAS f32x4*)(red + kp * 64 + 4 * f4) = a; __syncthreads();
          if (tid < 64) { float sum = 0.f; for (int p2 = 0; p2 < 32; ++p2) sum += red[p2 * 64 + tid]; b1c[it * 64 + tid] = sum; }
          __syncthreads(); } }
}
namespace g8 {
constexpr int BM = 256, BK = 64, HALF = 128, HTB = HALF * BK * 2, STAGE_BYTES = 8 * HTB, NXCD = 8, WGM = 8;
__host__ __device__ __forceinline__ int lds_byte(int r, int c) { const int st = (r >> 4) * 2 + (c >> 5), rr = r & 15, cc = c & 31, ob = rr * 64 + cc * 2; return st * 1024 + (ob ^ (((ob >> 9) & 1) << 5)); }
__host__ __device__ __forceinline__ void stage_rc(int b, int& R, int& C) { const int st = b / 1024, sb = b % 1024, swz = sb ^ (((sb >> 9) & 1) << 5); R = (st >> 1) * 16 + swz / 64; C = (st & 1) * 32 + (swz % 64) / 2; }
__host__ __device__ __forceinline__ int perm32(int rho) { const int n = rho >> 4, i = rho & 15; return 8 * (i >> 2) + 4 * n + (i & 3); }

struct GUnit { const char* a; const char* b; int pm, pn, e, rows; };

__device__ __forceinline__ bool static_unit(int i, int G, int c, int nM, int nN, int& pm, int& pn) {
    const int nwg = nM * nN; const long L = (long)i * G + c; if (L >= nwg) return false;
    int wgid = (int)L; { const int q = nwg / NXCD, r = nwg % NXCD, xcd = wgid % NXCD, off = wgid / NXCD; wgid = (xcd < r ? xcd * (q + 1) : r * (q + 1) + (xcd - r) * q) + off; }
    const int nig = WGM * nN, gid = wgid / nig, fm = gid * WGM, gsz = (nM - fm) < WGM ? (nM - fm) : WGM;
    pm = fm + ((wgid % nig) % gsz); pn = (wgid % nig) / gsz; return true;
}
struct DenseSched {
    static constexpr bool GATHER = false, PARTIAL = false;
    const char* A; const char* Bt; int lda, ldb, nM, nN, G, c;
    __device__ __forceinline__ bool next(int i, GUnit& u) const {
        int pm, pn; if (!static_unit(i, G, c, nM, nN, pm, pn)) return false;
        u.pm = pm; u.pn = pn; u.e = 0; u.rows = 256; u.a = A + (size_t)pm * 256 * lda * 2; u.b = Bt + (size_t)pn * 256 * ldb * 2; return true;
    }
    __device__ __forceinline__ void aoff(const GUnit&, unsigned (&v)[2][2], const int (&R)[2], const int (&C)[2]) const {
#pragma unroll
        for (int h = 0; h < 2; ++h)
#pragma unroll
            for (int i = 0; i < 2; ++i) v[h][i] = (unsigned)((h * 128 + R[i]) * lda + C[i]) * 2u;
    }
};

template <class Epi, class Sched>
__device__ __forceinline__ void gemm_run(LAS unsigned char* lds, const int K, const int ldb, const Sched& S, const Epi& E, int g_wv) {
    int tid_ = TIDX; asm volatile("" : "+v"(tid_));
    const int tid = tid_, wid = __builtin_amdgcn_readfirstlane(tid >> 6), lane = tid & 63, wr = wid >> 2, wc = wid & 3, fr = lane & 15, fq = lane >> 4;
    int nt_ = K / BK; asm volatile("" : "+s"(nt_));
    const int nt = nt_;
    int R[2], C[2]; unsigned voffB[2];
#pragma unroll
    for (int i = 0; i < 2; ++i) { stage_rc(tid * 16 + i * 8192, R[i], C[i]); const int Rb = (R[i] & ~31) + perm32(R[i] & 31); voffB[i] = (unsigned)(Rb * ldb + C[i]) * 2u; }
    const size_t kstep = (size_t)(BK * 2);
    const size_t hstepB = (size_t)HALF * ldb * 2;
    const unsigned ldsw = (unsigned)wid * 1024u;
    const int aoff = lds_byte(wr * 64 + fr, fq * 8), boff = lds_byte(wc * 32 + fr, fq * 8);
#define G8_SA(b, h) (((b) * 2 + (h)) * HTB)
#define G8_SB(b, h) ((4 + (b) * 2 + (h)) * HTB)
#define G8_GLDS(bufoff, gptr, i_) __builtin_amdgcn_global_load_lds((const unsigned*)(gptr), (LAS unsigned*)(lds + (bufoff) + ldsw + (i_) * 8192), 16, 0, 0)
#define G8_STAGE_B(bufoff, gbase) do { G8_GLDS(bufoff, (const char*)(gbase) + voffB[0], 0); G8_GLDS(bufoff, (const char*)(gbase) + voffB[1], 1); } while (0)
#define G8_STAGE_A(bufoff, gbase, v0, v1) do { G8_GLDS(bufoff, (const char*)(gbase) + (v0), 0); G8_GLDS(bufoff, (const char*)(gbase) + (v1), 1); } while (0)
#define G8_LDA(dst, b, h) do { _Pragma("unroll") for (int m = 0; m < 4; ++m) _Pragma("unroll") for (int k = 0; k < 2; ++k) dst[m][k] = *(const LAS bf16x8*)(lds + G8_SA(b, h) + aoff + m * 2048 + k * 1024); } while (0)
#define G8_LDB(dst, b, h) do { _Pragma("unroll") for (int n = 0; n < 2; ++n) _Pragma("unroll") for (int k = 0; k < 2; ++k) dst[n][k] = *(const LAS bf16x8*)(lds + G8_SB(b, h) + boff + n * 2048 + k * 1024); } while (0)
#define G8_MMA(ai, bj, At, Bt) do { __builtin_amdgcn_s_setprio(1); _Pragma("unroll") for (int m = 0; m < 4; ++m) { if (!PARTIAL || ((mmask >> ((ai) * 4 + m)) & 1u)) { _Pragma("unroll") for (int n = 0; n < 2; ++n) _Pragma("unroll") for (int k = 0; k < 2; ++k) \
        acc[ai][bj][m][n] = __builtin_amdgcn_mfma_f32_16x16x32_bf16(Bt[n][k], At[m][k], acc[ai][bj][m][n], 0, 0, 0); } } __builtin_amdgcn_s_setprio(0); } while (0)
#define G8_WAIT_V(n) asm volatile("s_waitcnt vmcnt(" #n ")" ::: "memory")
#define G8_WAIT_L(n) asm volatile("s_waitcnt lgkmcnt(" #n ")" ::: "memory")
#define G8_BAR __builtin_amdgcn_s_barrier()
#define G8_SCHED __builtin_amdgcn_sched_barrier(0)
    GUnit cur, nxt; int ui = 0;
    if (!S.next(0, cur)) return;
    constexpr bool GATHER = Sched::GATHER, PARTIAL = Sched::PARTIAL;
    unsigned mmask = 0xffu;
#define G8_MASK(u) do { if (PARTIAL) { mmask = 0u; _Pragma("unroll") for (int q_ = 0; q_ < 8; ++q_) mmask |= (((q_ >> 2) * 128 + wr * 64 + (q_ & 3) * 16) < (u).rows) ? (1u << q_) : 0u; } } while (0)
    unsigned vc[2][2];
    S.aoff(cur, vc, R, C); G8_MASK(cur);
    LAS u32x4* stash = (LAS u32x4*)(lds + STAGE_BYTES + 4096) + tid;
    f32x4 acc[2][2][4][2];
#pragma unroll
    for (int a = 0; a < 2; ++a)
#pragma unroll
        for (int b = 0; b < 2; ++b)
#pragma unroll
            for (int m = 0; m < 4; ++m)
#pragma unroll
                for (int n = 0; n < 2; ++n) acc[a][b][m][n] = (f32x4){0.f, 0.f, 0.f, 0.f};
    bf16x8 At[4][2], B0[2][2], B1[2][2];
    const char* cA = cur.a; const char* cB = cur.b;
    G8_STAGE_B(G8_SB(0, 0), cB); G8_STAGE_B(G8_SB(0, 1), cB + hstepB); G8_STAGE_A(G8_SA(0, 0), cA, vc[0][0], vc[0][1]); G8_STAGE_A(G8_SA(0, 1), cA, vc[1][0], vc[1][1]);
    if (wr == 1) G8_BAR;
    G8_WAIT_V(2); G8_BAR;
    G8_STAGE_B(G8_SB(1, 0), cB + kstep); G8_STAGE_A(G8_SA(1, 0), cA + kstep, vc[0][0], vc[0][1]); G8_STAGE_B(G8_SB(1, 1), cB + hstepB + kstep);
    G8_WAIT_V(6); G8_BAR;
    for (;;) {
        const bool has_next = S.next(ui + 1, nxt);
        if (GATHER) { unsigned vn[2][2];
            if (has_next) S.aoff(nxt, vn, R, C);
            else { vn[0][0] = vc[0][0]; vn[0][1] = vc[0][1]; vn[1][0] = vc[1][0]; vn[1][1] = vc[1][1]; }
            u32x4 sv; sv.x = vn[0][0]; sv.y = vn[0][1]; sv.z = vn[1][0]; sv.w = vn[1][1]; *stash = sv; }
        const char* nA = has_next ? nxt.a : cA; const char* nB = has_next ? nxt.b : cB;
#pragma unroll 1
        for (int seg = 0; seg < (Epi::KHOOK ? 3 : 1); ++seg) {
        const int tlo = Epi::KHOOK ? 6 * seg : 0, thi = Epi::KHOOK ? (seg == 2 ? nt : 6 * seg + 6) : nt;
#pragma unroll 1
        for (int t = tlo; t < thi; t += 2) {
            const bool last = (t == nt - 2);
            const char* a1 = cA + (size_t)(t + 1) * kstep;
            const char* a2 = last ? nA : cA + (size_t)(t + 2) * kstep; const char* b2 = last ? nB : cB + (size_t)(t + 2) * kstep;
            const char* a3 = a2 + kstep; const char* b3 = b2 + kstep;
            unsigned w00 = vc[0][0], w01 = vc[0][1], w10 = vc[1][0], w11 = vc[1][1];
            if (GATHER) { if (last) { const u32x4 sv = *stash; w00 = sv.x; w01 = sv.y; w10 = sv.z; w11 = sv.w; } }
            G8_LDB(B0, 0, 0); G8_LDB(B1, 0, 1); G8_SCHED; G8_LDA(At, 0, 0); G8_STAGE_A(G8_SA(1, 1), a1, vc[1][0], vc[1][1]);
            G8_WAIT_V(8); G8_WAIT_L(0); G8_BAR; G8_MMA(0, 0, At, B0); G8_MMA(0, 1, At, B1); G8_BAR; G8_SCHED;
            G8_LDA(At, 0, 1); G8_STAGE_B(G8_SB(0, 0), b2); G8_STAGE_B(G8_SB(0, 1), b2 + hstepB); G8_STAGE_A(G8_SA(0, 0), a2, w00, w01);
            G8_WAIT_V(8); G8_WAIT_L(0); G8_BAR; G8_MMA(1, 0, At, B0); G8_MMA(1, 1, At, B1); G8_BAR; G8_SCHED;
            G8_LDB(B0, 1, 0); G8_LDB(B1, 1, 1); G8_SCHED; G8_LDA(At, 1, 0); G8_STAGE_A(G8_SA(0, 1), a2, w10, w11);
            G8_WAIT_V(8); G8_WAIT_L(0); G8_BAR; G8_MMA(0, 0, At, B0); G8_MMA(0, 1, At, B1); G8_BAR; G8_SCHED;
            G8_LDA(At, 1, 1); G8_STAGE_B(G8_SB(1, 0), b3); G8_STAGE_B(G8_SB(1, 1), b3 + hstepB); G8_STAGE_A(G8_SA(1, 0), a3, w00, w01);
            G8_WAIT_V(8); G8_WAIT_L(0); G8_BAR; G8_MMA(1, 0, At, B0); G8_MMA(1, 1, At, B1); G8_BAR; G8_SCHED;
        }
        if constexpr (Epi::KHOOK) { if (seg < 2) E.kscale(acc, seg, wr, fr); }
        }
        if (wr == 0) G8_BAR;
        { int fr_ = fr, fq_ = fq; asm volatile("" : "+v"(fr_), "+v"(fq_));
          E(acc, cur, wr, wc, fr_, fq_); }
        if (!has_next) break;
#pragma unroll
        for (int a = 0; a < 2; ++a)
#pragma unroll
            for (int b = 0; b < 2; ++b)
#pragma unroll
                for (int m = 0; m < 4; ++m)
#pragma unroll
                    for (int n = 0; n < 2; ++n) acc[a][b][m][n] = (f32x4){0.f, 0.f, 0.f, 0.f};
        cur = nxt; cA = nA; cB = nB; ++ui; G8_MASK(cur);
        if (GATHER) { const u32x4 sv = *stash; vc[0][0] = sv.x; vc[0][1] = sv.y; vc[1][0] = sv.z; vc[1][1] = sv.w; }
        if (wr == 1) G8_BAR;
    }
    G8_WAIT_V(0);
    G8_BAR;
#undef G8_SA
#undef G8_SB
#undef G8_GLDS
#undef G8_STAGE_A
#undef G8_STAGE_B
#undef G8_LDA
#undef G8_LDB
#undef G8_MMA
#undef G8_MASK
#undef G8_WAIT_V
#undef G8_WAIT_L
#undef G8_BAR
#undef G8_SCHED
}
}
using g8::GUnit;
__device__ __forceinline__ void st_bf16x8(bf16_t* p, const float (&v)[8]) { u32x4 w; w.x = pk_bf16(v[0], v[1]); w.y = pk_bf16(v[2], v[3]); w.z = pk_bf16(v[4], v[5]); w.w = pk_bf16(v[6], v[7]); *(u32x4*)p = w; }
__device__ __forceinline__ float quad_sum(float s) { s += shx<16>(s); s += __shfl_xor(s, 32); return s; }

struct EpiInProj {
    static constexpr bool KHOOK = false;
    const float* ssqx; float* part_dq; float* part_dkv; const float* qg; const float* kg; const float* krg; const float* rope;
    unsigned char* prj;
    __device__ __forceinline__ void operator()(const f32x4 (&acc)[2][2][4][2], const GUnit& u, int wr, int wc, int fr, int fq) const {
        const int G = u.pn * 4 + wc;
        const bool isq = G < 6; const int a = G - 6; const bool isk = (G >= 10 && G < 18 && ((a >> 1) & 1) == 0);
        const float* g0 = (isq ? qg : kg) + 8 * fq;
        float rs8[8];
#pragma unroll
        for (int k = 0; k < 8; ++k) rs8[k] = ssqx[u.pm * 256 + (k >> 2) * 128 + wr * 64 + (k & 3) * 16 + fr];
#pragma unroll
        for (int k = 0; k < 8; ++k) rs8[k] = rsqrtf(rs8[k] * (1.f / 1024.f) + 1e-6f);
#pragma unroll
        for (int ai = 0; ai < 2; ++ai)
#pragma unroll
            for (int m = 0; m < 4; ++m) {
                __builtin_amdgcn_sched_barrier(0);
                const int row = u.pm * 256 + ai * 128 + wr * 64 + m * 16 + fr; const int b = row >> 11, t = row & 2047;
                const float rs = rs8[ai * 4 + m];
                float v[2][8];
#pragma unroll
                for (int bj = 0; bj < 2; ++bj)
#pragma unroll
                    for (int n = 0; n < 2; ++n)
#pragma unroll
                        for (int j = 0; j < 4; ++j) v[bj][4 * n + j] = acc[ai][bj][m][n][j] * rs;
                float ss = 0.f;
#pragma unroll
                for (int bj = 0; bj < 2; ++bj)
#pragma unroll
                    for (int i = 0; i < 8; ++i) ss += v[bj][i] * v[bj][i];
                bf16_t* dst = nullptr; int bstride = 32;
                if (isq) {
                    ss = quad_sum(ss); const float sc = rsqrtf(ss * (1.f / 64.f) + 1e-6f) * 0.18033688f;
#pragma unroll
                    for (int i = 0; i < 8; ++i) { v[0][i] *= sc * g0[i]; v[1][i] *= sc * g0[32 + i]; }
                    dst = (bf16_t*)(prj + PRJ_QN) + ((size_t)(b * 6 + G) * 2048 + t) * 64;
                } else if (G < 18) {
                    const int br = a >> 2, s = (a >> 1) & 1, hk = a & 1;
                    if (br > 0 && s == 0) {
                        ss = quad_sum(ss); const float sc = rsqrtf(ss * (1.f / 64.f) + 1e-6f);
#pragma unroll
                        for (int i = 0; i < 8; ++i) { v[0][i] *= sc * g0[i]; v[1][i] *= sc * g0[32 + i]; }
                    }
                    const size_t base = br == 0 ? (s ? PRJ_C0V : PRJ_C0K) : (br == 1 ? (s ? PRJ_VN1 : PRJ_KN1) : (s ? PRJ_VN2 : PRJ_KN2));
                    dst = (bf16_t*)(prj + base) + ((size_t)(b * 2 + hk) * 2048 + t) * 64;
                } else if (G < 26) { dst = (bf16_t*)(prj + PRJ_RAWQK) + (size_t)row * 512 + (G - 18) * 64; }
                else if (G < 30) { dst = (bf16_t*)(prj + PRJ_VML) + ((size_t)(b * 4 + (G - 26)) * 2048 + t) * 64; }
                else if (G < 34) { dst = (bf16_t*)(prj + PRJ_OG) + (size_t)row * 256 + (G - 30) * 64; }
                else if (G < 37) { dst = (bf16_t*)(prj + PRJ_DQKV) + (size_t)row * 384 + (G - 34) * 64; ss = quad_sum(ss); if (fq == 0) part_dq[(size_t)row * 4 + (G - 34)] = ss; }
                else if (G == 37) {
                    dst = (bf16_t*)(prj + PRJ_DQKV) + (size_t)row * 384 + 192;
                    float* gt = (float*)(prj + PRJ_GATES) + (size_t)row * 32 + 8 * fq;
                    *(f32x4*)gt = (f32x4){v[1][0], v[1][1], v[1][2], v[1][3]}; *(f32x4*)(gt + 4) = (f32x4){v[1][4], v[1][5], v[1][6], v[1][7]};
                    float s0 = 0.f;
#pragma unroll
                    for (int i = 0; i < 8; ++i) s0 += v[0][i] * v[0][i];
                    s0 = quad_sum(s0); const float sc = rsqrtf(s0 * (1.f / 32.f) + 1e-6f);
                    const float* rp = rope + (size_t)row * 32 + ((8 * fq) & 15);
                    float kr[8];
#pragma unroll
                    for (int i = 0; i < 8; ++i) { const float val = v[0][i] * sc * krg[8 * fq + i]; const float oth = __shfl_xor(val, 32); const float cs = rp[i], sn = rp[16 + i]; kr[i] = fq < 2 ? val * cs - oth * sn : val * cs + oth * sn; }
                    st_bf16x8((bf16_t*)(prj + PRJ_KR) + (size_t)row * 32 + 8 * fq, kr);
                } else { dst = (bf16_t*)(prj + PRJ_DQKV) + (size_t)row * 384 + 256 + (G - 38) * 64; ss = quad_sum(ss); if (fq == 0) part_dkv[(size_t)row * 2 + (G - 38)] = ss; }
                st_bf16x8(dst + 8 * fq, v[0]); st_bf16x8(dst + bstride + 8 * fq, v[1]);
            }
    }
};

struct EpiUq {
    static constexpr bool KHOOK = false;
    const float* ssq_dq; const float* qkn; const float* rope; bf16_t* QM;
    __device__ __forceinline__ void operator()(const f32x4 (&acc)[2][2][4][2], const GUnit& u, int wr, int wc, int fr, int fq) const {
        const int G = u.pn * 4 + wc; if (G >= 9) return;
        const float scale = 0.14724444f;
        const float* g0 = G < 6 ? qkn + 8 * fq : qkn + 64 + 8 * (fq & 1); const float* g1 = G < 6 ? g0 + 32 : g0 + 16;
        float rs8[8];
#pragma unroll
        for (int k = 0; k < 8; ++k) { const f32x4 pq = *(const f32x4*)(ssq_dq + (size_t)(u.pm * 256 + (k >> 2) * 128 + wr * 64 + (k & 3) * 16 + fr) * 4); rs8[k] = (pq.x + pq.y) + pq.z; }
#pragma unroll
        for (int k = 0; k < 8; ++k) rs8[k] = rsqrtf(rs8[k] * (1.f / 192.f) + 1e-6f);
#pragma unroll
        for (int ai = 0; ai < 2; ++ai) {
#pragma unroll
            for (int m = 0; m < 4; ++m) {
                __builtin_amdgcn_sched_barrier(0);
                const int row = u.pm * 256 + ai * 128 + wr * 64 + m * 16 + fr; const int b = row >> 11, t = row & 2047;
                const float rs = rs8[ai * 4 + m];
                float v[2][8]; float ss = 0.f;
#pragma unroll
                for (int bj = 0; bj < 2; ++bj)
#pragma unroll
                    for (int n = 0; n < 2; ++n)
#pragma unroll
                        for (int j = 0; j < 4; ++j) { const float x = acc[ai][bj][m][n][j] * rs; v[bj][4 * n + j] = x; ss += x * x; }
                if (G < 6) ss = quad_sum(ss); else ss += shx<16>(ss);
                const float sc = rsqrtf(ss * (G < 6 ? 1.f / 64.f : 1.f / 32.f) + 1e-6f) * scale;
#pragma unroll
                for (int i = 0; i < 8; ++i) { v[0][i] *= sc * g0[i]; v[1][i] *= sc * g1[i]; }
                if (G < 6) {
                    bf16_t* dst = QM + ((size_t)(b * 6 + G) * 2048 + t) * 96;
                    st_bf16x8(dst + 8 * fq, v[0]); st_bf16x8(dst + 32 + 8 * fq, v[1]);
                } else {
                    const int i16 = 8 * (fq & 1); const int head = 2 * (G - 6) + (fq >> 1);
                    const float* rp = rope + (size_t)row * 32 + i16; float o1[8], o2[8];
#pragma unroll
                    for (int i = 0; i < 8; ++i) { const float cs = rp[i], sn = rp[16 + i]; o1[i] = v[0][i] * cs - v[1][i] * sn; o2[i] = v[1][i] * cs + v[0][i] * sn; }
                    bf16_t* dst = QM + ((size_t)(b * 6 + head) * 2048 + t) * 96 + 64 + i16;
                    st_bf16x8(dst, o1); st_bf16x8(dst + 16, o2);
                }
            }
        }
    }
};
struct EpiUkv {
    static constexpr bool KHOOK = false;
    const float* ssq_dkv; const float* qkn; const bf16_t* KR; bf16_t* KM; bf16_t* VM;
    __device__ __forceinline__ void operator()(const f32x4 (&acc)[2][2][4][2], const GUnit& u, int wr, int wc, int fr, int fq) const {
        const int G = u.pn * 4 + wc;
        const float* g0 = qkn + 96 + 8 * fq;
        float rs8[8];
#pragma unroll
        for (int k = 0; k < 8; ++k) { const size_t rr = (size_t)(u.pm * 256 + (k >> 2) * 128 + wr * 64 + (k & 3) * 16 + fr); rs8[k] = ssq_dkv[rr * 2] + ssq_dkv[rr * 2 + 1]; }
#pragma unroll
        for (int k = 0; k < 8; ++k) rs8[k] = rsqrtf(rs8[k] * (1.f / 128.f) + 1e-6f);
#pragma unroll
        for (int ai = 0; ai < 2; ++ai) {
          u32x4 kr4[4];
          if (G < 6) {
#pragma unroll
              for (int m = 0; m < 4; ++m) kr4[m] = *(const u32x4*)(KR + (size_t)(u.pm * 256 + ai * 128 + wr * 64 + m * 16 + fr) * 32 + 8 * fq);
          }
#pragma unroll
            for (int m = 0; m < 4; ++m) {
                __builtin_amdgcn_sched_barrier(0);
                const int row = u.pm * 256 + ai * 128 + wr * 64 + m * 16 + fr; const int b = row >> 11, t = row & 2047;
                const float rs = rs8[ai * 4 + m];
                float v[2][8]; float ss = 0.f;
#pragma unroll
                for (int bj = 0; bj < 2; ++bj)
#pragma unroll
                    for (int n = 0; n < 2; ++n)
#pragma unroll
                        for (int j = 0; j < 4; ++j) { const float x = acc[ai][bj][m][n][j] * rs; v[bj][4 * n + j] = x; ss += x * x; }
                if (G < 6) {
                    ss = quad_sum(ss); const float sc = rsqrtf(ss * (1.f / 64.f) + 1e-6f);
#pragma unroll
                    for (int i = 0; i < 8; ++i) { v[0][i] *= sc * g0[i]; v[1][i] *= sc * g0[32 + i]; }
                    bf16_t* dst = KM + ((size_t)(b * 6 + G) * 2048 + t) * 96;
                    st_bf16x8(dst + 8 * fq, v[0]); st_bf16x8(dst + 32 + 8 * fq, v[1]);
                    *(u32x4*)(dst + 64 + 8 * fq) = kr4[m];
                } else {
                    bf16_t* dst = VM + ((size_t)(b * 6 + (G - 6)) * 2048 + t) * 64;
                    st_bf16x8(dst + 8 * fq, v[0]); st_bf16x8(dst + 32 + 8 * fq, v[1]);
                }
            }
        }
    }
};
#define MFMA16(a, b, c) __builtin_amdgcn_mfma_f32_16x16x32_bf16(a, b, c, 0, 0, 0)
#define MFMA32(a, b, c) __builtin_amdgcn_mfma_f32_32x32x16_bf16(a, b, c, 0, 0, 0)
#define LDS_FENCE() asm volatile("s_waitcnt lgkmcnt(0)" ::: "memory")

__device__ __forceinline__ void cmp_unit(int u, int l, InPtr in, unsigned char* ws, LAS unsigned char* lds, int g_wv) {
    int tid_ = TIDX; asm volatile("" : "+v"(tid_));
    const int tid = tid_, w = tid >> 6, lane = tid & 63, r = lane & 15, q = lane >> 4;
    const int b = u >> 2, s = (u >> 1) & 1, hk = u & 1;
    const bf16_t* A = (const bf16_t*)(ws + WS_PRJ + (s ? PRJ_C0V : PRJ_C0K)) + (size_t)(b * 2 + hk) * 2048 * 64;
    const bf16_t* W1 = (const bf16_t*)(ws + WS_WC1) + ((size_t)l * 2 + s) * 64 * 2048;
    const bf16_t* W2 = (const bf16_t*)(ws + WS_WC2) + ((size_t)l * 2 + s) * 64 * 64;
    const float* b1 = (const float*)(ws + WS_B1C) + (l * 2 + s) * 64;
    f32x4 acc[4];
#pragma unroll
    for (int nb = 0; nb < 4; ++nb) acc[nb] = (f32x4){0.f, 0.f, 0.f, 0.f};
    const bf16_t* ap = A + (size_t)(16 * w + r) * 1024 + 8 * q;
    constexpr int WP = 528, WBUF = 64 * WP; LAS unsigned char* wb = lds + 24576;
    u32x4 st[4];
#pragma unroll
    for (int i = 0; i < 4; ++i) { const int c = tid + 512 * i; st[i] = *(const u32x4*)(W1 + (size_t)(c >> 5) * 2048 + (c & 31) * 8); }
    bf16x8 af[8], afn[8];
#pragma unroll
    for (int ks = 0; ks < 8; ++ks) af[ks] = *(const bf16x8*)(ap + 32 * ks);
    const float* kg = in->p[9] + l * 64;
    float b1v[4], kgv[4]; bf16x8 w2f[2][4];
#pragma unroll
    for (int nb = 0; nb < 4; ++nb) { b1v[nb] = b1[16 * nb + r]; kgv[nb] = kg[16 * nb + r]; }
#pragma unroll
    for (int ks = 0; ks < 2; ++ks)
#pragma unroll
        for (int nb = 0; nb < 4; ++nb) w2f[ks][nb] = *(const bf16x8*)(W2 + (size_t)(16 * nb + r) * 64 + 32 * ks + 8 * q);
#pragma unroll
    for (int i = 0; i < 4; ++i) { const int c = tid + 512 * i; *(LAS u32x4*)(wb + (c >> 5) * WP + (c & 31) * 16) = st[i]; }
    __syncthreads();
    auto chunk = [&](const int kc, bf16x8 (&ac)[8], bf16x8 (&an)[8]) __attribute__((always_inline)) {
        const int cur = kc & 1;
        if (kc < 7) {
#pragma unroll
            for (int i = 0; i < 4; ++i) { const int c = tid + 512 * i; st[i] = *(const u32x4*)(W1 + (size_t)(c >> 5) * 2048 + (kc + 1) * 256 + (c & 31) * 8); }
#pragma unroll
            for (int ks = 0; ks < 8; ++ks) an[ks] = *(const bf16x8*)(ap + 256 * (kc + 1) + 32 * ks);
        }
#pragma unroll
        for (int ks = 0; ks < 8; ++ks)
#pragma unroll
            for (int nb = 0; nb < 4; ++nb) { const bf16x8 bb = *(const LAS bf16x8*)(wb + cur * WBUF + (16 * nb + r) * WP + (32 * ks + 8 * q) * 2); acc[nb] = MFMA16(ac[ks], bb, acc[nb]); }
        if (kc < 7) {
#pragma unroll
            for (int i = 0; i < 4; ++i) { const int c = tid + 512 * i; *(LAS u32x4*)(wb + (cur ^ 1) * WBUF + (c >> 5) * WP + (c & 31) * 16) = st[i]; }
        }
        __syncthreads();
    };
#pragma unroll 1
    for (int kc = 0; kc < 8; kc += 2) { chunk(kc, af, afn); chunk(kc + 1, afn, af); }
    LAS bf16_t* hl = (LAS bf16_t*)(lds + w * 2304);
#pragma unroll
    for (int nb = 0; nb < 4; ++nb) { const float bias = b1v[nb];
#pragma unroll
        for (int j = 0; j < 4; ++j) hl[(4 * q + j) * 72 + 16 * nb + r] = f2bf(siluf(acc[nb][j] + bias)); }
    LDS_FENCE();
    f32x4 o[4];
#pragma unroll
    for (int nb = 0; nb < 4; ++nb) o[nb] = (f32x4){0.f, 0.f, 0.f, 0.f};
#pragma unroll
    for (int ks = 0; ks < 2; ++ks) {
        const bf16x8 a = *(const LAS bf16x8*)(hl + r * 72 + 32 * ks + 8 * q);
#pragma unroll
        for (int nb = 0; nb < 4; ++nb) o[nb] = MFMA16(a, w2f[ks][nb], o[nb]);
    }
    LDS_FENCE();
    bf16_t* dst = (bf16_t*)(ws + WS_CMP + (s ? CMP_V : 0)) + (size_t)(b * 2 + hk) * 128 * 64;
#pragma unroll
    for (int j = 0; j < 4; ++j) {
        const int n = 16 * w + 4 * q + j; float ss = 0.f;
#pragma unroll
        for (int nb = 0; nb < 4; ++nb) ss += o[nb][j] * o[nb][j];
        ss += shx<1>(ss); ss += shx<2>(ss); ss += shx<4>(ss); ss += shx<8>(ss);
        const float sc = s == 0 ? rsqrtf(ss * (1.f / 64.f) + 1e-6f) : 1.f;
#pragma unroll
        for (int nb = 0; nb < 4; ++nb) { const int d = 16 * nb + r; const float v = o[nb][j] * sc * (s == 0 ? kgv[nb] : 1.f); dst[(size_t)n * 64 + d] = n < 127 ? f2bf(v) : (bf16_t)0; }
    }
}

__device__ __forceinline__ int swz_off(int row, int chunk) { return row * 128 + ((chunk ^ (row & 7)) << 4); }
__device__ __forceinline__ float log_sigmoid(float x) { return fminf(x, 0.f) - log1pf(__expf(-fabsf(x))); }
__device__ __forceinline__ void ml_delta_wave(int cu, int l, InPtr in, unsigned char* ws, LAS unsigned char* wl, int lane) {
    asm volatile("" : "+v"(lane));
    const int c = cu & 31, bh = cu >> 5, h = bh & 3, b = bh >> 2; const int t0 = c * 64; const size_t row0 = (size_t)b * 2048 + t0;
    const int cc = lane & 7, tg = lane >> 3;
    const bf16_t* raw = (const bf16_t*)(ws + WS_PRJ + PRJ_RAWQK); const float* cw = in->p[11] + (size_t)l * 4 * 512 + h * 64 + 8 * cc;
    u32x4 rq[11];
    const bool head0 = (c == 0 && tg == 0);
#pragma unroll
    for (int i = 0; i < 11; ++i) { const size_t rr = (head0 && i < 3) ? row0 : row0 + 8 * tg - 3 + i; rq[i] = *(const u32x4*)(raw + rr * 512 + h * 64 + 8 * cc); }
    __builtin_amdgcn_sched_barrier(0);
    const float* G = (const float*)(ws + WS_PRJ + PRJ_GATES);
    const float ip = G[(row0 + lane) * 32 + 18 + h] + in->p[12][l * 4 + h], fp = G[(row0 + lane) * 32 + 22 + h] + in->p[13][l * 4 + h];
    float bcum = log_sigmoid(fp);
#pragma unroll
    for (int o = 1; o < 64; o <<= 1) { const float t = __builtin_bit_cast(float, __builtin_amdgcn_ds_bpermute(((lane - o) & 63) << 2, __builtin_bit_cast(int, bcum))); if (lane >= o) bcum += t; }
    const float bL = __builtin_bit_cast(float, __builtin_amdgcn_readlane(__builtin_bit_cast(int, bcum), 63)); const float wgt = __expf(bL - bcum + ip);
    { float* mlg = (float*)(ws + WS_ML + ML_G) + ((size_t)bh * 2048 + t0 + lane) * 2; mlg[0] = bcum; mlg[1] = ip; if (lane == 0) ((float*)(ws + WS_ML + ML_BL))[cu] = bL; }
    float wt[8];
#pragma unroll
    for (int j = 0; j < 8; ++j) wt[j] = __builtin_bit_cast(float, __builtin_amdgcn_ds_bpermute((8 * tg + j) << 2, __builtin_bit_cast(int, wgt)));
    if (head0) {
#pragma unroll
        for (int i = 0; i < 3; ++i) rq[i] = (u32x4){0u, 0u, 0u, 0u}; }
#define MLD_E(v, e) (((e) & 1) ? bf_hi(((e) >> 1) == 0 ? (v).x : ((e) >> 1) == 1 ? (v).y : ((e) >> 1) == 2 ? (v).z : (v).w) : bf_lo(((e) >> 1) == 0 ? (v).x : ((e) >> 1) == 1 ? (v).y : ((e) >> 1) == 2 ? (v).z : (v).w))
    bf16_t* QC = (bf16_t*)(ws + WS_ML) + ((size_t)bh * 2048 + t0 + 8 * tg) * 64 + 8 * cc; bf16_t* KC = (bf16_t*)(ws + WS_ML + ML_KC) + ((size_t)bh * 2048 + t0 + 8 * tg) * 64 + 8 * cc;
    u32x4 rk[11], vv[8];
#pragma unroll
    for (int i = 0; i < 11; ++i) { const size_t rr = (head0 && i < 3) ? row0 : row0 + 8 * tg - 3 + i; rk[i] = *(const u32x4*)(raw + rr * 512 + h * 64 + 8 * cc + 256); }
    { const bf16_t* V = (const bf16_t*)(ws + WS_PRJ + PRJ_VML) + ((size_t)bh * 2048 + t0 + 8 * tg) * 64 + 8 * cc;
#pragma unroll
      for (int j = 0; j < 8; ++j) vv[j] = *(const u32x4*)(V + (size_t)j * 64); }
    if (head0) {
#pragma unroll
        for (int i = 0; i < 3; ++i) rk[i] = (u32x4){0u, 0u, 0u, 0u}; }
    __builtin_amdgcn_sched_barrier(0);
    {
        float w4[4][8];
#pragma unroll
        for (int tp = 0; tp < 4; ++tp) { const f32x4 a = *(const f32x4*)(cw + tp * 512), b4 = *(const f32x4*)(cw + tp * 512 + 4); w4[tp][0] = a.x; w4[tp][1] = a.y; w4[tp][2] = a.z; w4[tp][3] = a.w; w4[tp][4] = b4.x; w4[tp][5] = b4.y; w4[tp][6] = b4.z; w4[tp][7] = b4.w; }
#pragma unroll
        for (int j = 0; j < 8; ++j) { float o[8];
#pragma unroll
            for (int e = 0; e < 8; ++e) o[e] = siluf(w4[0][e] * MLD_E(rq[j], e) + w4[1][e] * MLD_E(rq[j + 1], e) + w4[2][e] * MLD_E(rq[j + 2], e) + w4[3][e] * MLD_E(rq[j + 3], e));
            u32x4 pk; pk.x = pk_bf16(o[0], o[1]); pk.y = pk_bf16(o[2], o[3]); pk.z = pk_bf16(o[4], o[5]); pk.w = pk_bf16(o[6], o[7]);
            *(u32x4*)(QC + (size_t)j * 64) = pk; }
    }
    float dn[8];
    {
        float w4[4][8];
#pragma unroll
        for (int tp = 0; tp < 4; ++tp) { const f32x4 a = *(const f32x4*)(cw + 256 + tp * 512), b4 = *(const f32x4*)(cw + 256 + tp * 512 + 4); w4[tp][0] = a.x; w4[tp][1] = a.y; w4[tp][2] = a.z; w4[tp][3] = a.w; w4[tp][4] = b4.x; w4[tp][5] = b4.y; w4[tp][6] = b4.z; w4[tp][7] = b4.w; }
#pragma unroll
        for (int e = 0; e < 8; ++e) dn[e] = 0.f;
#pragma unroll
        for (int j2 = 0; j2 < 4; ++j2) { float kb[2][8];
#pragma unroll
            for (int jj = 0; jj < 2; ++jj) { const int j = 2 * j2 + jj; float o[8];
#pragma unroll
                for (int e = 0; e < 8; ++e) o[e] = siluf(w4[0][e] * MLD_E(rk[j], e) + w4[1][e] * MLD_E(rk[j + 1], e) + w4[2][e] * MLD_E(rk[j + 2], e) + w4[3][e] * MLD_E(rk[j + 3], e)) * 0.125f;
                u32x4 pk; pk.x = pk_bf16(o[0], o[1]); pk.y = pk_bf16(o[2], o[3]); pk.z = pk_bf16(o[4], o[5]); pk.w = pk_bf16(o[6], o[7]);
                *(u32x4*)(KC + (size_t)j * 64) = pk;
#pragma unroll
                for (int e = 0; e < 8; ++e) { kb[jj][e] = MLD_E(pk, e); dn[e] += wt[j] * kb[jj][e]; } }
#pragma unroll
            for (int e = 0; e < 8; ++e) { *(LAS unsigned*)(wl + swz_off(8 * cc + e, tg) + 4 * j2) = pk_bf16(kb[0][e], kb[1][e]);
                *(LAS unsigned*)(wl + 8192 + swz_off(8 * cc + e, tg) + 4 * j2) = pk_bf16(wt[2 * j2] * MLD_E(vv[2 * j2], e), wt[2 * j2 + 1] * MLD_E(vv[2 * j2 + 1], e)); } }
    }
#undef MLD_E
#pragma unroll
    for (int e = 0; e < 8; ++e) { dn[e] += shx<8>(dn[e]); dn[e] += shx<16>(dn[e]); dn[e] += __shfl_xor(dn[e], 32); }
    if (tg == 0) { float* DN = (float*)(ws + WS_ML + ML_DN) + (size_t)cu * 64 + 8 * cc; *(f32x4*)DN = (f32x4){dn[0], dn[1], dn[2], dn[3]}; *(f32x4*)(DN + 4) = (f32x4){dn[4], dn[5], dn[6], dn[7]}; }
    LDS_FENCE();
    const int r = lane & 15, q = lane >> 4;
    bf16_t* DL = (bf16_t*)(ws + WS_ML + ML_DELTA) + (size_t)cu * 4096;
    f32x4 acc[4][4];
#pragma unroll
    for (int mb = 0; mb < 4; ++mb) {
#pragma unroll
        for (int nb = 0; nb < 4; ++nb) acc[mb][nb] = (f32x4){0.f, 0.f, 0.f, 0.f};
#pragma unroll
        for (int ks = 0; ks < 2; ++ks) {
            const bf16x8 a = *(const LAS bf16x8*)(wl + 8192 + swz_off(16 * mb + r, 4 * ks + q));
#pragma unroll
            for (int nb = 0; nb < 4; ++nb) { const bf16x8 bb = *(const LAS bf16x8*)(wl + swz_off(16 * nb + r, 4 * ks + q)); acc[mb][nb] = MFMA16(a, bb, acc[mb][nb]); }
        }
    }
    LDS_FENCE();
#pragma unroll
    for (int mb = 0; mb < 4; ++mb)
#pragma unroll
        for (int nb = 0; nb < 4; ++nb)
#pragma unroll
            for (int j = 0; j < 4; ++j) { const int row = 16 * mb + 4 * q + j, col = 16 * nb + r; *(LAS bf16_t*)(wl + swz_off(row, col >> 3) + (col & 7) * 2) = f2bf(acc[mb][nb][j]); }
    LDS_FENCE();
#pragma unroll
    for (int i = 0; i < 8; ++i) { const int ch = lane + 64 * i; *(u32x4*)(DL + (size_t)ch * 8) = *(const LAS u32x4*)(wl + swz_off(ch >> 3, ch & 7)); }
    LDS_FENCE();
}

#ifndef TIME_PH
#define TIME_PH -1
#endif
#define PSTAMP(i, blk) do { if (TIME_PH != -1 && l == 0 && blockIdx.x == (blk) && TIDX == 0) ((unsigned long long*)((unsigned*)(ws + WS_CTL) + CW_TS))[i] = __builtin_amdgcn_s_memrealtime(); } while (0)
#ifndef DUP_DELTA
#define DUP_DELTA 1
#endif
__device__ __forceinline__ void phase_prep(int l, InPtr in, unsigned char* ws, LAS unsigned char* lds, int bid, int nb, int g_wv, unsigned* dq) {
    asm volatile("" : "+s"(bid));
    PSTAMP(40, 0);
#ifndef NO_UQ
    { g8::DenseSched S{(const char*)(ws + WS_PRJ + PRJ_DQKV), (const char*)(ws + WS_WUQ) + (size_t)l * 768 * 256 * 2, 384, 256, 64, 3, nb, bid};
      EpiUq E{(const float*)(ws + WS_SSQ + PT_DQ) + (size_t)l * 16384 * 4, in->p[19] + l * 192, (const float*)(ws + WS_ROPE), (bf16_t*)(ws + WS_MLA)};
      g8::gemm_run(lds, 256, 256, S, E, g_wv); }
#endif
    PSTAMP(41, 0);
#ifndef NO_UKV
    asm volatile("" : "+s"(bid));
    { g8::DenseSched S{(const char*)(ws + WS_PRJ + PRJ_DQKV) + 256, (const char*)(ws + WS_WUKV) + (size_t)l * 768 * 256 * 2, 384, 256, 64, 3, nb, nb == 256 ? ((bid + 64) & 255) : bid};
      EpiUkv E{(const float*)(ws + WS_SSQ + PT_DKV) + (size_t)l * 16384 * 2, in->p[19] + l * 192, (const bf16_t*)(ws + WS_PRJ + PRJ_KR), (bf16_t*)(ws + WS_MLA + MLA_KM), (bf16_t*)(ws + WS_MLA + MLA_VM)};
      g8::gemm_run(lds, 256, 256, S, E, g_wv); }
#endif
    PSTAMP(42, 0); PSTAMP(44, 255);
    __syncthreads();
#ifndef NO_CMP
#ifndef DUP_CMP
#define DUP_CMP 1
#endif
    for (int u = (nb == 256 ? (bid >= 128 && bid < 160 ? bid - 128 : 32) : nb - 1 - bid); u < 32; u += nb) for (int rp_ = 0; rp_ < DUP_CMP; ++rp_) { if (rp_) __syncthreads(); cmp_unit(u, l, in, ws, lds, g_wv); }
#endif
    PSTAMP(45, 255);
    __syncthreads();
#ifndef NO_DELTA
    { int tid_ = TIDX; asm volatile("" : "+v"(tid_)); LAS int* slot = (LAS int*)(lds + LDS_MISC + 64);
      for (;;) {
          __syncthreads();
          if (tid_ == 0) *slot = (int)__hip_atomic_fetch_add(dq, 1u, __ATOMIC_RELAXED, __HIP_MEMORY_SCOPE_AGENT);
          __syncthreads();
          const int g = *slot; if (g >= 96 + 128) break;
          const int wv = tid_ >> 6;
          const int cu_ = g < 96 ? g * 8 + wv : 768 + (g - 96) * 2 + wv;
          if (g < 96 || wv < 2) { for (int rp_ = 0; rp_ < DUP_DELTA; ++rp_) ml_delta_wave(cu_, l, in, ws, lds + wv * 16384, tid_ & 63); }
      } }
#endif
    __syncthreads(); PSTAMP(43, 0);
}
#define CHK_TOL(st) (((st) & 15) == 8 ? 1e-2f : 1e-3f)
#define CHECK_REST
constexpr int VTP = 192;
typedef short v4i16_t __attribute__((ext_vector_type(4)));
__device__ __forceinline__ int vt_lane_off(int lane) { return (4 * (lane >> 5) + ((lane & 15) >> 2)) * VTP + ((((lane >> 4) & 1) * 16) + 4 * (lane & 3)) * 2; }
__device__ __forceinline__ bf16x8 vt_frag(const LAS unsigned char* Vt, int voff, int s4, int eb) {
    const LAS unsigned char* a = Vt + voff + 16 * s4 * VTP + 64 * eb;
    const v4i16_t lo = __builtin_amdgcn_ds_read_tr16_b64_v4i16((LAS v4i16_t*)a), hi = __builtin_amdgcn_ds_read_tr16_b64_v4i16((LAS v4i16_t*)(a + 8 * VTP));
    return (bf16x8){lo[0], lo[1], lo[2], lo[3], hi[0], hi[1], hi[2], hi[3]};
}
__device__ __forceinline__ int crow(int reg, int h) { return (reg & 3) + 8 * (reg >> 2) + 4 * h; }
struct AttnState { f32x16 o[2]; float m, l; };
__device__ __forceinline__ void attn_reset(AttnState& A) { A.m = -1e30f; A.l = 0.f;
#pragma unroll
    for (int i = 0; i < 16; ++i) { A.o[0][i] = 0.f; A.o[1][i] = 0.f; } }

template <int DK>
__device__ __forceinline__ void attn_scores(f32x16 (&s)[2], const bf16x8 (&qf)[DK / 16], const LAS unsigned char* Kt, int r, int h) {
    constexpr int KP = 2 * DK + 16, NK = DK / 16;
    bf16x8 kf[2][NK];
#pragma unroll
    for (int kb = 0; kb < 2; ++kb)
#pragma unroll
        for (int ks = 0; ks < NK; ++ks) kf[kb][ks] = *(const LAS bf16x8*)(Kt + (32 * kb + r) * KP + (16 * ks + 8 * h) * 2);
    __builtin_amdgcn_sched_barrier(0);
#pragma unroll
    for (int kb = 0; kb < 2; ++kb)
#pragma unroll
        for (int i = 0; i < 16; ++i) s[kb][i] = 0.f;
#pragma unroll
    for (int ks = 0; ks < NK; ++ks) {
        s[0] = MFMA32(kf[0][ks], qf[ks], s[0]);
        s[1] = MFMA32(kf[1][ks], qf[ks], s[1]);
    }
}
__device__ __forceinline__ float max3f(float a, float b, float c) { return fmaxf(fmaxf(a, b), c); }
__device__ __forceinline__ void attn_softmax_pv(AttnState& A, f32x16 (&s)[2], const LAS unsigned char* Vt, int r, int h, float bias_c = 0.f, bool lane_ok = true) {
    constexpr float THR = 8.f; const int voff = vt_lane_off(r + 32 * h);
    float mx = max3f(s[0][0], s[0][1], s[0][2]);
#pragma unroll
    for (int i = 3; i < 15; i += 2) mx = max3f(mx, s[0][i], s[0][i + 1]);
    mx = max3f(mx, s[0][15], s[1][0]);
#pragma unroll
    for (int i = 1; i < 15; i += 2) mx = max3f(mx, s[1][i], s[1][i + 1]);
    mx = fmaxf(mx, s[1][15]);
    mx = fmaxf(mx, __shfl_xor(mx, 32));
    const float mxb = (lane_ok && mx > -1e29f) ? mx + bias_c : -1e30f;
    const bool grow = mxb > A.m + THR;
    const float mnew = grow ? mxb : A.m;
    if (__any(grow)) {
        const float alpha = __builtin_amdgcn_exp2f(A.m - mnew);
        A.l *= alpha;
#pragma unroll
        for (int i = 0; i < 16; ++i) { A.o[0][i] *= alpha; A.o[1][i] *= alpha; }
    }
    A.m = mnew;
    const float sub = (lane_ok && mnew > -1e29f) ? mnew - bias_c : 1e30f;
    float rs = 0.f;
#pragma unroll
    for (int kb = 0; kb < 2; ++kb)
#pragma unroll
        for (int i = 0; i < 16; ++i) { const float p = __builtin_amdgcn_exp2f(s[kb][i] - sub); s[kb][i] = p; rs += p; }
    rs += __shfl_xor(rs, 32);
    A.l += rs;
    bf16x8 vf[4][2];
#pragma unroll
    for (int s4 = 0; s4 < 4; ++s4)
#pragma unroll
        for (int eb = 0; eb < 2; ++eb) vf[s4][eb] = vt_frag(Vt, voff, s4, eb);
    __builtin_amdgcn_sched_barrier(0);
#pragma unroll
    for (int s4 = 0; s4 < 4; ++s4) {
        const int kb = s4 >> 1, hf = (s4 & 1) * 8;
        u32x4 pw; pw.x = pk_bf16(s[kb][hf + 0], s[kb][hf + 1]); pw.y = pk_bf16(s[kb][hf + 2], s[kb][hf + 3]); pw.z = pk_bf16(s[kb][hf + 4], s[kb][hf + 5]); pw.w = pk_bf16(s[kb][hf + 6], s[kb][hf + 7]);
        const bf16x8 pf = __builtin_bit_cast(bf16x8, pw);
#pragma unroll
        for (int eb = 0; eb < 2; ++eb) A.o[eb] = MFMA32(vf[s4][eb], pf, A.o[eb]);
    }
}
template <int DK>
__device__ __forceinline__ void attn_scores_half(f32x16& s, const bf16x8 (&qf)[DK / 16], const LAS unsigned char* Kt, int r, int h, int kb) {
    constexpr int KP = 2 * DK + 16, NK = DK / 16;
    bf16x8 kf[NK];
#pragma unroll
    for (int ks = 0; ks < NK; ++ks) kf[ks] = *(const LAS bf16x8*)(Kt + (32 * kb + r) * KP + (16 * ks + 8 * h) * 2);
    __builtin_amdgcn_sched_barrier(0);
#pragma unroll
    for (int i = 0; i < 16; ++i) s[i] = 0.f;
#pragma unroll
    for (int ks = 0; ks < NK; ++ks) s = MFMA32(kf[ks], qf[ks], s);
}
__device__ __forceinline__ void attn_softmax_pv_half(AttnState& A, f32x16& s, const LAS unsigned char* Vt, int r, int h, int kb, float bias_c = 0.f, bool lane_ok = true) {
    constexpr float THR = 8.f; const int voff = vt_lane_off(r + 32 * h);
    float mx = max3f(s[0], s[1], s[2]);
#pragma unroll
    for (int i = 3; i < 15; i += 2) mx = max3f(mx, s[i], s[i + 1]);
    mx = fmaxf(mx, s[15]);
    mx = fmaxf(mx, __shfl_xor(mx, 32));
    const float mxb = (lane_ok && mx > -1e29f) ? mx + bias_c : -1e30f;
    const bool grow = mxb > A.m + THR;
    const float mnew = grow ? mxb : A.m;
    if (__any(grow)) {
        const float alpha = __builtin_amdgcn_exp2f(A.m - mnew);
        A.l *= alpha;
#pragma unroll
        for (int i = 0; i < 16; ++i) { A.o[0][i] *= alpha; A.o[1][i] *= alpha; }
    }
    A.m = mnew;
    const float sub = (lane_ok && mnew > -1e29f) ? mnew - bias_c : 1e30f;
    float rs = 0.f;
#pragma unroll
    for (int i = 0; i < 16; ++i) { const float p = __builtin_amdgcn_exp2f(s[i] - sub); s[i] = p; rs += p; }
    rs += __shfl_xor(rs, 32);
    A.l += rs;
    bf16x8 vf[2][2];
#pragma unroll
    for (int s2 = 0; s2 < 2; ++s2)
#pragma unroll
        for (int eb = 0; eb < 2; ++eb) vf[s2][eb] = vt_frag(Vt, voff, 2 * kb + s2, eb);
    __builtin_amdgcn_sched_barrier(0);
#pragma unroll
    for (int s2 = 0; s2 < 2; ++s2) {
        const int hf = s2 * 8;
        u32x4 pw; pw.x = pk_bf16(s[hf + 0], s[hf + 1]); pw.y = pk_bf16(s[hf + 2], s[hf + 3]); pw.z = pk_bf16(s[hf + 4], s[hf + 5]); pw.w = pk_bf16(s[hf + 6], s[hf + 7]);
        const bf16x8 pf = __builtin_bit_cast(bf16x8, pw);
#pragma unroll
        for (int eb = 0; eb < 2; ++eb) A.o[eb] = MFMA32(vf[s2][eb], pf, A.o[eb]);
    }
}
template <int DK>
__device__ __forceinline__ void stage_k_load(u32x4 (&kr)[2], const bf16_t* Kg  , int tid) {
    constexpr int CH = DK / 8;
    kr[0] = *(const u32x4*)(Kg + (size_t)(tid / CH) * DK + (tid % CH) * 8);
    if (64 * CH > 512) { const int c2 = tid + 512; if (c2 < 64 * CH) kr[1] = *(const u32x4*)(Kg + (size_t)(c2 / CH) * DK + (c2 % CH) * 8); }
}
template <int DK>
__device__ __forceinline__ void stage_k_store(const u32x4 (&kr)[2], LAS unsigned char* Kt, int tid) {
    constexpr int CH = DK / 8, KP = 2 * DK + 16;
    *(LAS u32x4*)(Kt + (tid / CH) * KP + (tid % CH) * 16) = kr[0];
    if (64 * CH > 512) { const int c2 = tid + 512; if (c2 < 64 * CH) *(LAS u32x4*)(Kt + (c2 / CH) * KP + (c2 % CH) * 16) = kr[1]; }
}
__device__ __forceinline__ u32x4 stage_v_load(const bf16_t* Vg, int tid) { return *(const u32x4*)(Vg + (size_t)(tid >> 3) * 64 + (tid & 7) * 8); }
__device__ __forceinline__ void stage_v_store(const u32x4& v, LAS unsigned char* Vt, int tid) { *(LAS u32x4*)(Vt + (tid >> 3) * VTP + (tid & 7) * 16) = v; }

constexpr int MLA_KT = 0, MLA_VT = 2 * 64 * 208, MLA_LDS = MLA_VT + 2 * 64 * VTP;
__device__ __forceinline__ void mla_unit(int b, int hd, int qt, int l, unsigned char* ws, LAS unsigned char* lds, int g_wv) {
    int tid_ = TIDX; asm volatile("" : "+v"(tid_));
    const int tid = tid_, w = tid >> 6, lane = tid & 63, r = lane & 31, h = lane >> 5;
    const size_t slab = (size_t)(b * 6 + hd) * 2048;
    const bf16_t* QM = (const bf16_t*)(ws + WS_MLA) + slab * 96; const bf16_t* KM = (const bf16_t*)(ws + WS_MLA + MLA_KM) + slab * 96; const bf16_t* VM = (const bf16_t*)(ws + WS_MLA + MLA_VM) + slab * 64;
    const int q0 = 256 * qt + 32 * w, q = q0 + r;
    bf16x8 qf[6];
#pragma unroll
    for (int ks = 0; ks < 6; ++ks) qf[ks] = *(const bf16x8*)(QM + (size_t)q * 96 + 16 * ks + 8 * h);
    AttnState A; attn_reset(A);
    const int ntile = 4 * qt + 4;
    u32x4 kr[2], vr, kr2[2], vr2;
    stage_k_load<96>(kr, KM, tid); vr = stage_v_load(VM, tid);
    stage_k_store<96>(kr, lds + MLA_KT, tid); stage_v_store(vr, lds + MLA_VT, tid);
    if (ntile > 1) { stage_k_load<96>(kr, KM + (size_t)64 * 96, tid); vr = stage_v_load(VM + (size_t)64 * 64, tid); }
    __syncthreads();
    auto tile_step = [&](const int j, u32x4 (&kc)[2], u32x4& vc, u32x4 (&kn)[2], u32x4& vn) __attribute__((always_inline)) {
        const int cur = j & 1;
        if (j + 2 < ntile) { stage_k_load<96>(kn, KM + (size_t)(j + 2) * 64 * 96, tid); vn = stage_v_load(VM + (size_t)(j + 2) * 64 * 64, tid); }
        if (64 * j <= q0 + 31) {
            f32x16 s[2];
            attn_scores<96>(s, qf, lds + MLA_KT + cur * 64 * 208, r, h);
            if (64 * j + 63 > q0) {
#pragma unroll
                for (int kb = 0; kb < 2; ++kb)
#pragma unroll
                    for (int i = 0; i < 16; ++i) { const int key = 64 * j + 32 * kb + crow(i, h); if (key > q) s[kb][i] = -1e30f; }
            }
            attn_softmax_pv(A, s, lds + MLA_VT + cur * 64 * VTP, r, h);
        }
        if (j + 1 < ntile) { stage_k_store<96>(kc, lds + MLA_KT + (cur ^ 1) * 64 * 208, tid); stage_v_store(vc, lds + MLA_VT + (cur ^ 1) * 64 * VTP, tid); }
        __syncthreads();
    };
#pragma unroll 1
    for (int j = 0; j < ntile; j += 2) { tile_step(j, kr, vr, kr2, vr2); tile_step(j + 1, kr2, vr2, kr, vr); }
    const float inv = A.l > 0.f ? 1.f / A.l : 0.f; float ss = 0.f;
    bf16_t* Y = (bf16_t*)(ws + WS_Y) + ((size_t)b * 2048 + q) * 1024 + 384 + hd * 64;
#pragma unroll
    for (int eb = 0; eb < 2; ++eb)
#pragma unroll
        for (int g4 = 0; g4 < 4; ++g4) {
            const float v0 = A.o[eb][4 * g4] * inv, v1 = A.o[eb][4 * g4 + 1] * inv, v2 = A.o[eb][4 * g4 + 2] * inv, v3 = A.o[eb][4 * g4 + 3] * inv;
            u32x2 pw; pw.x = pk_bf16(v0, v1); pw.y = pk_bf16(v2, v3);
            const float f0 = bf_lo(pw.x), f1 = bf_hi(pw.x), f2 = bf_lo(pw.y), f3 = bf_hi(pw.y); ss += (f0 * f0 + f1 * f1) + (f2 * f2 + f3 * f3);
            *(u32x2*)(Y + 32 * eb + 8 * g4 + 4 * h) = pw;
        }
    ss += __shfl_xor(ss, 32);
    if (h == 0) ((float*)(ws + WS_SSQ + PT_C))[((size_t)l * 16384 + (size_t)b * 2048 + q) * 8 + hd] = ss;
}

__device__ __forceinline__ void nsa_bias32(float (&bv)[2][16], const LAS float* bl, int dd) {
#pragma unroll
    for (int kb = 0; kb < 2; ++kb)
#pragma unroll
        for (int k = 0; k < 16; ++k) { const int c = 63 - (32 * kb + (k & 3) + 8 * (k >> 2)); int d = dd + c; d = d < 0 ? 0 : (d > 255 ? 255 : d); bv[kb][k] = bl[d]; }
}
__device__ __forceinline__ void nsa_mask_bias(f32x16 (&sc)[2], int dq, int h, const LAS float* bl, bool sel, int lim) {
    int dd = dq - 4 * h - 63; asm volatile("" : "+v"(dd));
    float bv[2][16]; nsa_bias32(bv, bl, dd);
#pragma unroll
    for (int kb = 0; kb < 2; ++kb)
#pragma unroll
        for (int k = 0; k < 16; ++k) { const int c = 63 - (32 * kb + (k & 3) + 8 * (k >> 2)); const int d = dd + c; sc[kb][k] = (sel && d >= 0 && d < lim) ? sc[kb][k] + bv[kb][k] : -1e30f; }
}
__device__ __forceinline__ void nsa_mask_bias_half(f32x16& sc, int dq, int h, const LAS float* bl, bool sel, int lim, int kb) {
    int dd = dq - 4 * h - 32 * kb; asm volatile("" : "+v"(dd));
    float bv[16];
#pragma unroll
    for (int k = 0; k < 16; ++k) { int d = dd - ((k & 3) + 8 * (k >> 2)); d = d < 0 ? 0 : (d > 255 ? 255 : d); bv[k] = bl[d]; }
#pragma unroll
    for (int k = 0; k < 16; ++k) { const int d = dd - ((k & 3) + 8 * (k >> 2)); sc[k] = (sel && d >= 0 && d < lim) ? sc[k] + bv[k] : -1e30f; }
}

__device__ __forceinline__ void attn_park(const AttnState& A, LAS float* xl) {
    xl[0] = A.m; xl[64] = A.l;
#pragma unroll
    for (int k = 0; k < 16; ++k) { xl[64 * (2 + k)] = A.o[0][k]; xl[64 * (18 + k)] = A.o[1][k]; }
}
__device__ __forceinline__ void attn_merge(AttnState& A, const LAS float* xl) {
    const float m2 = xl[0], l2 = xl[64]; const float m = fmaxf(A.m, m2);
    const float a1 = A.m > -1e29f ? __builtin_amdgcn_exp2f(A.m - m) : 0.f, a2 = m2 > -1e29f ? __builtin_amdgcn_exp2f(m2 - m) : 0.f;
    A.l = A.l * a1 + l2 * a2; A.m = m;
#pragma unroll
    for (int k = 0; k < 16; ++k) { A.o[0][k] = A.o[0][k] * a1 + xl[64 * (2 + k)] * a2; A.o[1][k] = A.o[1][k] * a1 + xl[64 * (18 + k)] * a2; }
}
constexpr int NSA_KT = 0, NSA_VT = 2 * 64 * 144, NSA_BIAS = NSA_VT + 2 * 64 * VTP, NSA_PS = NSA_BIAS + 3 * 256 * 4, NSA_SEL = NSA_PS + 3 * 64 * 32 * 4, NSA_UNI = NSA_SEL + 256, NSA_OT = NSA_UNI + 256, NSA_LDS = NSA_OT + 6 * 8192;
__device__ __forceinline__ void nsa_unit(int b, int hk, int i, int l, InPtr in, unsigned char* ws, LAS unsigned char* lds, int g_wv) {
    int tid_ = TIDX; asm volatile("" : "+v"(tid_));
    const int tid = tid_, w = tid >> 6, lane = tid & 63, r = lane & 31, h = lane >> 5;
    const bool active = w < 6; const int g = active ? (w >> 1) : 2, th = w & 1, head = hk * 3 + g;
    const int kh = w < 4 ? -1 : (w < 6 ? 0 : 1);
    LAS float* xl = (LAS float*)(lds + NSA_LDS) + th * (34 * 64) + lane;
    const int t = 64 * i + 32 * th + r, tl = 32 * th + r; const size_t row = (size_t)b * 2048 + t;
    const size_t kvslab = (size_t)(b * 2 + hk) * 2048 * 64;
    LAS float* biasl = (LAS float*)(lds + NSA_BIAS); LAS float* PS = (LAS float*)(lds + NSA_PS); LAS unsigned* SEL = (LAS unsigned*)(lds + NSA_SEL); LAS unsigned* UNI = (LAS unsigned*)(lds + NSA_UNI);
    { const float* bd = (const float*)(ws + WS_BIASD) + (size_t)hk * 3 * 2048;
      if (tid < 384) { const int gg = tid >> 7, d0 = (tid & 127) * 2; biasl[gg * 256 + d0] = bd[gg * 2048 + d0]; biasl[gg * 256 + d0 + 1] = bd[gg * 2048 + d0 + 1]; }
#pragma unroll
      for (int k = 0; k < 12; ++k) if (i >= 16) PS[tid + 512 * k] = 0.f;
      if (tid < 4) UNI[tid] = 0u; }
    bf16x8 qf[4];
    { const bf16_t* QN = (const bf16_t*)(ws + WS_PRJ + PRJ_QN) + ((size_t)(b * 6 + head) * 2048 + t) * 64;
#pragma unroll
      for (int ks = 0; ks < 4; ++ks) qf[ks] = *(const bf16x8*)(QN + 16 * ks + 8 * h); }
#define NSA_GATE(k) ({ int t_ = t; asm volatile("" : "+v"(t_)); sigmf(((const float*)(ws + WS_PRJ + PRJ_GATES))[((size_t)b * 2048 + t_) * 32 + head * 3 + (k)]); })
    LAS float* bl = biasl + g * 256;
    LAS float* otl = (LAS float*)(lds + NSA_OT + (active ? w : 0) * 8192) + lane;
    u32x4 kr[2], vr;
    const int ntc = i >= 16 ? 2 : 1;
    { const bf16_t* KC = (const bf16_t*)(ws + WS_CMP) + (size_t)(b * 2 + hk) * 128 * 64; const bf16_t* VC = (const bf16_t*)(ws + WS_CMP + CMP_V) + (size_t)(b * 2 + hk) * 128 * 64;
      for (int T = 0; T < ntc; ++T) { stage_k_load<64>(kr, KC + T * 4096, tid); vr = stage_v_load(VC + T * 4096, tid); stage_k_store<64>(kr, lds + NSA_KT + T * 64 * 144, tid); stage_v_store(vr, lds + NSA_VT + T * 64 * VTP, tid); } }
    __syncthreads();
    {
        f32x16 ot[2];
        if (active && i < 16) {
            AttnState A; attn_reset(A); f32x16 sc[2]; attn_scores<64>(sc, qf, lds + NSA_KT, r, h);
            float bvc[2][16];
#pragma unroll
            for (int kb = 0; kb < 2; ++kb)
#pragma unroll
                for (int k = 0; k < 16; ++k) { int d = t - 16 * (32 * kb + crow(k, h)) - 31; d = d < 0 ? 0 : (d > 255 ? 255 : d); bvc[kb][k] = bl[d]; }
#pragma unroll
            for (int kb = 0; kb < 2; ++kb)
#pragma unroll
                for (int k = 0; k < 16; ++k) { const int d = t - 16 * (32 * kb + crow(k, h)) - 31; sc[kb][k] = d >= 0 ? sc[kb][k] + bvc[kb][k] : -1e30f; }
            attn_softmax_pv(A, sc, lds + NSA_VT, r, h);
            const float gc = NSA_GATE(0); const float inv = A.l > 0.f ? gc / A.l : 0.f;
#pragma unroll
            for (int k = 0; k < 16; ++k) { otl[64 * k] = A.o[0][k] * inv; otl[64 * (16 + k)] = A.o[1][k] * inv; }
        } else if (active) {
            float m = -1e30f, lsum = 0.f;
            for (int T = 0; T < ntc; ++T) {
                f32x16 sc[2]; attn_scores<64>(sc, qf, lds + NSA_KT + T * 64 * 144, r, h);
                float bvc[2][16];
#pragma unroll
                for (int kb = 0; kb < 2; ++kb)
#pragma unroll
                    for (int k = 0; k < 16; ++k) { int d = t - 16 * (64 * T + 32 * kb + crow(k, h)) - 31; d = d < 0 ? 0 : (d > 255 ? 255 : d); bvc[kb][k] = bl[d]; }
                float mx = -1e30f;
#pragma unroll
                for (int kb = 0; kb < 2; ++kb)
#pragma unroll
                    for (int k = 0; k < 16; ++k) { const int n = 64 * T + 32 * kb + crow(k, h); const int d = t - 16 * n - 31; const float x = (d >= 0 && n < 127) ? sc[kb][k] + bvc[kb][k] : -1e30f; sc[kb][k] = x; mx = fmaxf(mx, x); }
                mx = fmaxf(mx, __shfl_xor(mx, 32));
                const float mnew = fmaxf(m, mx), mref = mnew <= -1e29f ? 0.f : mnew; float rs = 0.f;
#pragma unroll
                for (int kb = 0; kb < 2; ++kb)
#pragma unroll
                    for (int k = 0; k < 16; ++k) rs += __builtin_amdgcn_exp2f(sc[kb][k] - mref);
                rs += __shfl_xor(rs, 32);
                lsum = lsum * __builtin_amdgcn_exp2f(m - mref) + rs; m = mnew;
            }
            const float mref = m <= -1e29f ? 0.f : m, inv = lsum > 0.f ? 1.f / lsum : 0.f;
#pragma unroll
            for (int k = 0; k < 16; ++k) { ot[0][k] = 0.f; ot[1][k] = 0.f; }
            float carry = 0.f;
            for (int T = 0; T < ntc; ++T) {
                f32x16 sc[2]; attn_scores<64>(sc, qf, lds + NSA_KT + T * 64 * 144, r, h);
                float bvc[2][16];
#pragma unroll
                for (int kb = 0; kb < 2; ++kb)
#pragma unroll
                    for (int k = 0; k < 16; ++k) { int d = t - 16 * (64 * T + 32 * kb + crow(k, h)) - 31; d = d < 0 ? 0 : (d > 255 ? 255 : d); bvc[kb][k] = bl[d]; }
#pragma unroll
                for (int kb = 0; kb < 2; ++kb)
#pragma unroll
                    for (int k = 0; k < 16; ++k) { const int n = 64 * T + 32 * kb + crow(k, h); const int d = t - 16 * n - 31; sc[kb][k] = (d >= 0 && n < 127) ? __builtin_amdgcn_exp2f(sc[kb][k] + bvc[kb][k] - mref) * inv : 0.f; }
                float prevL = carry;
#pragma unroll
                for (int kb = 0; kb < 2; ++kb)
#pragma unroll
                    for (int g4 = 0; g4 < 4; ++g4) {
                        const float G4 = (sc[kb][4 * g4] + sc[kb][4 * g4 + 1]) + (sc[kb][4 * g4 + 2] + sc[kb][4 * g4 + 3]); const float L = sc[kb][4 * g4 + 3];
                        const float Lo = __shfl_xor(L, 32);
                        const float add = h ? Lo : prevL;
                        prevL = Lo;
                        const int idx = T * 8 + kb * 4 + g4;
                        PS[g * 2048 + tl * 32 + 2 * idx + h] = G4 + add;
                    }
                carry = prevL;
#pragma unroll
                for (int s4 = 0; s4 < 4; ++s4) {
                    const int kb = s4 >> 1, hf = (s4 & 1) * 8;
                    u32x4 pw; pw.x = pk_bf16(sc[kb][hf + 0], sc[kb][hf + 1]); pw.y = pk_bf16(sc[kb][hf + 2], sc[kb][hf + 3]); pw.z = pk_bf16(sc[kb][hf + 4], sc[kb][hf + 5]); pw.w = pk_bf16(sc[kb][hf + 6], sc[kb][hf + 7]);
                    const bf16x8 pf = __builtin_bit_cast(bf16x8, pw);
#pragma unroll
                    for (int eb = 0; eb < 2; ++eb) ot[eb] = MFMA32(vt_frag(lds + NSA_VT + T * 64 * VTP, vt_lane_off(lane), s4, eb), pf, ot[eb]);
                }
            }
            { const float gc = NSA_GATE(0);
#pragma unroll
            for (int k = 0; k < 16; ++k) { otl[64 * k] = ot[0][k] * gc; otl[64 * (16 + k)] = ot[1][k] * gc; } }
        }
    }
    __syncthreads();
#ifndef NO_NSA_SEL
    if (i < 16) { if (tid < 64) SEL[tid] = (2u << i) - 1u; if (tid < 3) UNI[tid] = (2u << i) - 1u; }
    else {
        const int tk = tid >> 3, sg = tid & 7; float v[32];
#pragma unroll
        for (int k = 0; k < 8; ++k) { const f32x4 x0 = *(const LAS f32x4*)(PS + tk * 32 + 4 * k), x1 = *(const LAS f32x4*)(PS + 2048 + tk * 32 + 4 * k), x2 = *(const LAS f32x4*)(PS + 4096 + tk * 32 + 4 * k);
            v[4 * k] = (x0.x + x1.x) + x2.x; v[4 * k + 1] = (x0.y + x1.y) + x2.y; v[4 * k + 2] = (x0.z + x1.z) + x2.z; v[4 * k + 3] = (x0.w + x1.w) + x2.w; }
#pragma unroll
        for (int s = 0; s < 32; ++s) { const bool forced = (s == 0) || (s == i) || (s == i - 1); float x = forced ? v[s] + 1e4f : v[s]; v[s] = s > i ? -1.f : x; }
        unsigned bits = 0u;
#pragma unroll
        for (int k = 0; k < 4; ++k) {
            float x = 0.f;
#pragma unroll
            for (int s = 0; s < 32; ++s) x = (s == 4 * sg + k) ? v[s] : x;
            int rank = 0;
#pragma unroll
            for (int s = 0; s < 32; ++s) rank += (v[s] > x || (v[s] == x && s < 4 * sg + k)) ? 1 : 0;
            if (rank < 16 && x >= 0.f) bits |= 1u << (4 * sg + k);
        }
        bits |= shx<1>(bits); bits |= shx<2>(bits); bits |= shx<4>(bits);
        if (sg == 0) { SEL[tk] = bits; __hip_atomic_fetch_or(UNI, bits, __ATOMIC_RELAXED, __HIP_MEMORY_SCOPE_WORKGROUP); __hip_atomic_fetch_or(UNI + 1 + (tk >> 5), bits, __ATOMIC_RELAXED, __HIP_MEMORY_SCOPE_WORKGROUP); }
    }
#endif
    __syncthreads();
    const unsigned selbits = SEL[tl], uni = UNI[0], unih = UNI[1 + th];
    const float c31 = bl[255];
#ifndef NO_NSA_SLC
#ifndef NSA_DUP_SLC
#define NSA_DUP_SLC 1
#endif
    for (int rp_ = 0; rp_ < NSA_DUP_SLC; ++rp_) {
        AttnState A; attn_reset(A);
        const bf16_t* KS = (const bf16_t*)(ws + WS_PRJ + PRJ_KN1) + kvslab; const bf16_t* VS = (const bf16_t*)(ws + WS_PRJ + PRJ_VN1) + kvslab;
        unsigned todo = uni; int cur = 0; u32x4 kr2[2], vr2;
        int s = __ffs(todo) - 1; todo &= todo - 1;
        stage_k_load<64>(kr, KS + (size_t)s * 4096, tid); vr = stage_v_load(VS + (size_t)s * 4096, tid);
        stage_k_store<64>(kr, lds + NSA_KT, tid); stage_v_store(vr, lds + NSA_VT, tid);
        int sn = todo ? __ffs(todo) - 1 : -1; todo &= todo - 1;
        if (sn >= 0) { stage_k_load<64>(kr, KS + (size_t)sn * 4096, tid); vr = stage_v_load(VS + (size_t)sn * 4096, tid); }
        __syncthreads();
        while (s >= 0) {
            const int sn2 = todo ? __ffs(todo) - 1 : -1; todo &= todo - 1;
            if (sn2 >= 0) { stage_k_load<64>(kr2, KS + (size_t)sn2 * 4096, tid); vr2 = stage_v_load(VS + (size_t)sn2 * 4096, tid); }
            if ((unih >> s) & 1u) {
                const bool sel = (selbits >> s) & 1u;
                if (kh < 0) {
                    f32x16 sc[2];
                    attn_scores<64>(sc, qf, lds + NSA_KT + cur * 64 * 144, r, h);
                    if (i - s >= 3) attn_softmax_pv(A, sc, lds + NSA_VT + cur * 64 * VTP, r, h, c31, sel);
                    else { nsa_mask_bias(sc, t - 64 * s, h, bl, sel, 4096); attn_softmax_pv(A, sc, lds + NSA_VT + cur * 64 * VTP, r, h); }
                } else {
                    f32x16 s1;
                    attn_scores_half<64>(s1, qf, lds + NSA_KT + cur * 64 * 144, r, h, kh);
                    if (i - s >= 3) attn_softmax_pv_half(A, s1, lds + NSA_VT + cur * 64 * VTP, r, h, kh, c31, sel);
                    else { nsa_mask_bias_half(s1, t - 64 * s, h, bl, sel, 4096, kh); attn_softmax_pv_half(A, s1, lds + NSA_VT + cur * 64 * VTP, r, h, kh); }
                }
            }
            if (sn >= 0) { stage_k_store<64>(kr, lds + NSA_KT + (cur ^ 1) * 64 * 144, tid); stage_v_store(vr, lds + NSA_VT + (cur ^ 1) * 64 * VTP, tid); }
            kr[0] = kr2[0]; vr = vr2;
            __syncthreads();
            s = sn; sn = sn2; cur ^= 1;
        }
        if (kh == 1) attn_park(A, xl);
        __syncthreads();
        if (kh == 0) attn_merge(A, xl);
        if (active && rp_ == NSA_DUP_SLC - 1) { const float gs = NSA_GATE(1); const float inv = A.l > 0.f ? gs / A.l : 0.f;
#pragma unroll
            for (int k = 0; k < 16; ++k) { otl[64 * k] += A.o[0][k] * inv; otl[64 * (16 + k)] += A.o[1][k] * inv; } }
    }
#endif
#ifndef NO_NSA_WIN
#ifndef NSA_DUP_WIN
#define NSA_DUP_WIN 1
#endif
    for (int rq_ = 0; rq_ < NSA_DUP_WIN; ++rq_) {
        AttnState A; attn_reset(A);
        const bf16_t* KW = (const bf16_t*)(ws + WS_PRJ + PRJ_KN2) + kvslab; const bf16_t* VW = (const bf16_t*)(ws + WS_PRJ + PRJ_VN2) + kvslab;
        const int j0 = i > 8 ? i - 8 : 0; int cur = 0; u32x4 kr2[2], vr2;
        stage_k_load<64>(kr, KW + (size_t)j0 * 4096, tid); vr = stage_v_load(VW + (size_t)j0 * 4096, tid);
        stage_k_store<64>(kr, lds + NSA_KT, tid); stage_v_store(vr, lds + NSA_VT, tid);
        if (j0 < i) { stage_k_load<64>(kr, KW + (size_t)(j0 + 1) * 4096, tid); vr = stage_v_load(VW + (size_t)(j0 + 1) * 4096, tid); }
        __syncthreads();
        for (int j = j0; j <= i; ++j) {
            if (j + 2 <= i) { stage_k_load<64>(kr2, KW + (size_t)(j + 2) * 4096, tid); vr2 = stage_v_load(VW + (size_t)(j + 2) * 4096, tid); }
            if (kh < 0) {
                f32x16 sc[2];
                attn_scores<64>(sc, qf, lds + NSA_KT + cur * 64 * 144, r, h);
                if (i - j >= 3 && j > i - 8) attn_softmax_pv(A, sc, lds + NSA_VT + cur * 64 * VTP, r, h, c31, true);
                else { nsa_mask_bias(sc, t - 64 * j, h, bl, true, 512); attn_softmax_pv(A, sc, lds + NSA_VT + cur * 64 * VTP, r, h); }
            } else {
                f32x16 s1;
                attn_scores_half<64>(s1, qf, lds + NSA_KT + cur * 64 * 144, r, h, kh);
                if (i - j >= 3 && j > i - 8) attn_softmax_pv_half(A, s1, lds + NSA_VT + cur * 64 * VTP, r, h, kh, c31, true);
                else { nsa_mask_bias_half(s1, t - 64 * j, h, bl, true, 512, kh); attn_softmax_pv_half(A, s1, lds + NSA_VT + cur * 64 * VTP, r, h, kh); }
            }
            if (j < i) { stage_k_store<64>(kr, lds + NSA_KT + (cur ^ 1) * 64 * 144, tid); stage_v_store(vr, lds + NSA_VT + (cur ^ 1) * 64 * VTP, tid); }
            kr[0] = kr2[0]; vr = vr2;
            __syncthreads();
            cur ^= 1;
        }
        if (kh == 1) attn_park(A, xl);
        __syncthreads();
        if (kh == 0) attn_merge(A, xl);
        if (active && rq_ == NSA_DUP_WIN - 1) { const float gw = NSA_GATE(2); const float inv = A.l > 0.f ? gw / A.l : 0.f;
            float ss = 0.f; bf16_t* Y = (bf16_t*)(ws + WS_Y) + row * 1024 + head * 64;
#pragma unroll
            for (int eb = 0; eb < 2; ++eb)
#pragma unroll
                for (int g4 = 0; g4 < 4; ++g4) {
                    const float v0 = otl[64 * (16 * eb + 4 * g4)] + A.o[eb][4 * g4] * inv, v1 = otl[64 * (16 * eb + 4 * g4 + 1)] + A.o[eb][4 * g4 + 1] * inv;
                    const float v2 = otl[64 * (16 * eb + 4 * g4 + 2)] + A.o[eb][4 * g4 + 2] * inv, v3 = otl[64 * (16 * eb + 4 * g4 + 3)] + A.o[eb][4 * g4 + 3] * inv;
                    u32x2 pw; pw.x = pk_bf16(v0, v1); pw.y = pk_bf16(v2, v3);
                    const float f0 = bf_lo(pw.x), f1 = bf_hi(pw.x), f2 = bf_lo(pw.y), f3 = bf_hi(pw.y); ss += (f0 * f0 + f1 * f1) + (f2 * f2 + f3 * f3);
                    *(u32x2*)(Y + 32 * eb + 8 * g4 + 4 * h) = pw;
                }
            ss += __shfl_xor(ss, 32);
            if (h == 0) ((float*)(ws + WS_SSQ + PT_A))[((size_t)l * 16384 + row) * 8 + head] = ss;
        }
    }
#endif
}

__device__ __forceinline__ void ml_out_wave(int cu, int l, InPtr in, unsigned char* ws, LAS unsigned char* wl, LAS unsigned char* npl, int lane) {
    const int c = cu & 31, bh = cu >> 5, hd = bh & 3, b = bh >> 2; const int t0 = c * 64; const int r = lane & 15, q = lane >> 4;
    const bf16_t* QC = (const bf16_t*)(ws + WS_ML) + ((size_t)bh * 2048 + t0) * 64; const bf16_t* KC = (const bf16_t*)(ws + WS_ML + ML_KC) + ((size_t)bh * 2048 + t0) * 64;
    const bf16_t* V = (const bf16_t*)(ws + WS_PRJ + PRJ_VML) + ((size_t)bh * 2048 + t0) * 64;
    const float* mlg = (const float*)(ws + WS_ML + ML_G) + ((size_t)bh * 2048 + t0) * 2;
    const bf16_t* CP = (const bf16_t*)(ws + WS_ML + ML_CP) + (size_t)cu * 4096; const bf16_t* NP = (const bf16_t*)(ws + WS_ML + ML_NP) + (size_t)cu * 64;
    u32x4 vch[8];
#pragma unroll
    for (int i = 0; i < 8; ++i) vch[i] = *(const u32x4*)(V + (size_t)(lane + 64 * i) * 8);
    bf16x8 aq[4][2];
#pragma unroll
    for (int mb = 0; mb < 4; ++mb)
#pragma unroll
        for (int ks = 0; ks < 2; ++ks) aq[mb][ks] = *(const bf16x8*)(QC + (size_t)(16 * mb + r) * 64 + 32 * ks + 8 * q);
    float bj[4][4], den[4][4];
#pragma unroll
    for (int mb = 0; mb < 4; ++mb)
#pragma unroll
        for (int j = 0; j < 4; ++j) bj[mb][j] = mlg[(16 * mb + 4 * q + j) * 2];
    {
        float cs[4];
#pragma unroll
        for (int nb = 0; nb < 4; ++nb) { const float2 gg = *(const float2*)(mlg + (16 * nb + r) * 2); cs[nb] = gg.y - gg.x; }
#pragma unroll
        for (int mb = 0; mb < 4; ++mb) {
            f32x4 accS[4];
#pragma unroll
            for (int nb = 0; nb < 4; ++nb) { accS[nb] = (f32x4){0.f, 0.f, 0.f, 0.f};
#pragma unroll
                for (int ks = 0; ks < 2; ++ks) { const bf16x8 bk = *(const bf16x8*)(KC + (size_t)(16 * nb + r) * 64 + 32 * ks + 8 * q); accS[nb] = MFMA16(aq[mb][ks], bk, accS[nb]); } }
#pragma unroll
            for (int j = 0; j < 4; ++j) {
                const int jj = 16 * mb + 4 * q + j; float rs = 0.f;
#pragma unroll
                for (int nb = 0; nb < 4; ++nb) { const int s = 16 * nb + r; const float p = s <= jj ? accS[nb][j] * __expf(bj[mb][j] + cs[nb]) : 0.f; rs += p;
                    *(LAS bf16_t*)(wl + 8192 + swz_off(jj, s >> 3) + (s & 7) * 2) = f2bf(p); }
                rs += shx<1>(rs); rs += shx<2>(rs); rs += shx<4>(rs); rs += shx<8>(rs);
                den[mb][j] = rs;
            }
        }
    }
#pragma unroll
    for (int i = 0; i < 8; ++i) { const int ch = lane + 64 * i, sv = ch >> 3, e0 = (ch & 7) * 8; const unsigned xs[4] = {vch[i].x, vch[i].y, vch[i].z, vch[i].w};
#pragma unroll
        for (int k = 0; k < 4; ++k) { *(LAS bf16_t*)(wl + swz_off(e0 + 2 * k, sv >> 3) + (sv & 7) * 2) = (bf16_t)(xs[k] & 0xffffu); *(LAS bf16_t*)(wl + swz_off(e0 + 2 * k + 1, sv >> 3) + (sv & 7) * 2) = (bf16_t)(xs[k] >> 16); } }
#pragma unroll
    for (int mb = 0; mb < 4; ++mb) { const float e = __expf(mlg[(16 * mb + r) * 2]);
#pragma unroll
        for (int ks = 0; ks < 2; ++ks) { const u32x4 x = __builtin_bit_cast(u32x4, aq[mb][ks]); u32x4 y;
            y.x = pk_bf16(bf_lo(x.x) * e, bf_hi(x.x) * e); y.y = pk_bf16(bf_lo(x.y) * e, bf_hi(x.y) * e); y.z = pk_bf16(bf_lo(x.z) * e, bf_hi(x.z) * e); y.w = pk_bf16(bf_lo(x.w) * e, bf_hi(x.w) * e);
            aq[mb][ks] = __builtin_bit_cast(bf16x8, y); } }
    f32x4 acc[4][4], accn[4];
#pragma unroll
    for (int mb = 0; mb < 4; ++mb) { accn[mb] = (f32x4){0.f, 0.f, 0.f, 0.f};
#pragma unroll
        for (int nb = 0; nb < 4; ++nb) acc[mb][nb] = (f32x4){0.f, 0.f, 0.f, 0.f}; }
#pragma unroll
    for (int ks = 0; ks < 2; ++ks) {
        u32x4 nz = *(const u32x4*)(NP + 32 * ks + 8 * q); if (r != 0) nz = (u32x4){0u, 0u, 0u, 0u};
        const bf16x8 bn = __builtin_bit_cast(bf16x8, nz);
#pragma unroll
        for (int nb = 0; nb < 4; ++nb) { const bf16x8 bb = *(const bf16x8*)(CP + (size_t)(16 * nb + r) * 64 + 32 * ks + 8 * q);
#pragma unroll
            for (int mb = 0; mb < 4; ++mb) acc[mb][nb] = MFMA16(aq[mb][ks], bb, acc[mb][nb]); }
#pragma unroll
        for (int mb = 0; mb < 4; ++mb) accn[mb] = MFMA16(aq[mb][ks], bn, accn[mb]);
    }
    LDS_FENCE();
#pragma unroll
    for (int ks = 0; ks < 2; ++ks) {
        bf16x8 ap[4];
#pragma unroll
        for (int mb = 0; mb < 4; ++mb) ap[mb] = *(const LAS bf16x8*)(wl + 8192 + swz_off(16 * mb + r, 4 * ks + q));
#pragma unroll
        for (int nb = 0; nb < 4; ++nb) { const bf16x8 bv = *(const LAS bf16x8*)(wl + swz_off(16 * nb + r, 4 * ks + q));
#pragma unroll
            for (int mb = 0; mb < 4; ++mb) acc[mb][nb] = MFMA16(ap[mb], bv, acc[mb][nb]); }
    }
    LDS_FENCE();
    const bf16_t* OG = (const bf16_t*)(ws + WS_PRJ + PRJ_OG); u32x4 ogc[8];
#pragma unroll
    for (int i = 0; i < 8; ++i) { const int ch = lane + 64 * i; ogc[i] = *(const u32x4*)(OG + ((size_t)b * 2048 + t0 + (ch >> 3)) * 256 + hd * 64 + (ch & 7) * 8); }
    const float* gain = in->p[14] + l * 256 + hd * 64;
    bf16_t* Y = (bf16_t*)(ws + WS_Y);
    float gn[4];
#pragma unroll
    for (int nb = 0; nb < 4; ++nb) gn[nb] = gain[16 * nb + r];
#pragma unroll
    for (int mb = 0; mb < 4; ++mb)
#pragma unroll
        for (int j = 0; j < 4; ++j) {
            const int jj = 16 * mb + 4 * q + j;
            const float dn = den[mb][j] + __builtin_bit_cast(float, __builtin_amdgcn_ds_bpermute((lane & 48) << 2, __builtin_bit_cast(int, accn[mb][j])));
            const float inv = __builtin_amdgcn_rcpf(fmaxf(fabsf(dn), 1.f)); float hv[4]; float ss = 0.f;
#pragma unroll
            for (int nb = 0; nb < 4; ++nb) { hv[nb] = acc[mb][nb][j] * inv; ss += hv[nb] * hv[nb]; }
            ss += shx<1>(ss); ss += shx<2>(ss); ss += shx<4>(ss); ss += shx<8>(ss);
            const float rstd = rsqrtf(ss * (1.f / 64.f) + 1e-6f);
#pragma unroll
            for (int nb = 0; nb < 4; ++nb) { const int e = 16 * nb + r; *(LAS bf16_t*)(wl + 8192 + swz_off(jj, e >> 3) + (e & 7) * 2) = f2bf(hv[nb] * rstd * gn[nb]); }
        }
    LDS_FENCE();
#pragma unroll
    for (int i = 0; i < 8; ++i) { const int ch = lane + 64 * i, row = ch >> 3, e8 = ch & 7;
        const u32x4 hx = *(const LAS u32x4*)(wl + 8192 + swz_off(row, e8)); const u32x4 g = ogc[i]; u32x4 o;
        o.x = pk_bf16(bf_lo(hx.x) * sigmf(bf_lo(g.x)), bf_hi(hx.x) * sigmf(bf_hi(g.x)));
        o.y = pk_bf16(bf_lo(hx.y) * sigmf(bf_lo(g.y)), bf_hi(hx.y) * sigmf(bf_hi(g.y)));
        o.z = pk_bf16(bf_lo(hx.z) * sigmf(bf_lo(g.z)), bf_hi(hx.z) * sigmf(bf_hi(g.z)));
        o.w = pk_bf16(bf_lo(hx.w) * sigmf(bf_lo(g.w)), bf_hi(hx.w) * sigmf(bf_hi(g.w)));
        *(u32x4*)(Y + ((size_t)b * 2048 + t0 + row) * 1024 + 768 + hd * 64 + e8 * 8) = o; }
    LDS_FENCE();
}

__device__ __forceinline__ void ml_scan_unit(int bh, int l, unsigned char* ws, int g_wv) {
    int tid_ = TIDX; asm volatile("" : "+v"(tid_)); const int tid = tid_;
    const bf16_t* DL = (const bf16_t*)(ws + WS_ML + ML_DELTA) + (size_t)bh * 32 * 4096 + tid * 8; bf16_t* CP = (bf16_t*)(ws + WS_ML + ML_CP) + (size_t)bh * 32 * 4096 + tid * 8;
    const float* DN = (const float*)(ws + WS_ML + ML_DN) + (size_t)bh * 32 * 64; bf16_t* NP = (bf16_t*)(ws + WS_ML + ML_NP) + (size_t)bh * 32 * 64; const float* BL = (const float*)(ws + WS_ML + ML_BL) + bh * 32;
    float c[8]; float n = 0.f;
#pragma unroll
    for (int k = 0; k < 8; ++k) c[k] = 0.f;
#pragma unroll 1
    for (int c0 = 0; c0 < 32; c0 += 8) {
        u32x4 d[8]; float dn[8], co[8];
#pragma unroll
        for (int k = 0; k < 8; ++k) { d[k] = *(const u32x4*)(DL + (size_t)(c0 + k) * 4096); dn[k] = tid < 64 ? DN[(c0 + k) * 64 + tid] : 0.f; co[k] = __expf(BL[c0 + k]); }
#pragma unroll
        for (int k = 0; k < 8; ++k) {
            u32x4 o; o.x = pk_bf16(c[0], c[1]); o.y = pk_bf16(c[2], c[3]); o.z = pk_bf16(c[4], c[5]); o.w = pk_bf16(c[6], c[7]);
            *(u32x4*)(CP + (size_t)(c0 + k) * 4096) = o; if (tid < 64) NP[(c0 + k) * 64 + tid] = f2bf(n);
            c[0] = co[k] * c[0] + bf_lo(d[k].x); c[1] = co[k] * c[1] + bf_hi(d[k].x); c[2] = co[k] * c[2] + bf_lo(d[k].y); c[3] = co[k] * c[3] + bf_hi(d[k].y);
            c[4] = co[k] * c[4] + bf_lo(d[k].z); c[5] = co[k] * c[5] + bf_hi(d[k].z); c[6] = co[k] * c[6] + bf_lo(d[k].w); c[7] = co[k] * c[7] + bf_hi(d[k].w);
            n = co[k] * n + dn[k];
        }
    }
    asm volatile("s_waitcnt vmcnt(0)" ::: "memory"); __syncthreads();
    if (tid == 0) { __builtin_amdgcn_fence(__ATOMIC_RELEASE, "agent"); asm volatile("s_waitcnt vmcnt(0)" ::: "memory");
        __hip_atomic_fetch_add((unsigned*)(ws + WS_CTL) + CW_SCAN + 64 * l, 1u, __ATOMIC_RELAXED, __HIP_MEMORY_SCOPE_AGENT); }
}
__device__ __forceinline__ void ml_scan_wait(int l, unsigned char* ws, int g_wv) {
    if (TIDX == 0) { unsigned* p = (unsigned*)(ws + WS_CTL) + CW_SCAN + 64 * l; unsigned sp = 0;
        while (__hip_atomic_load(p, __ATOMIC_RELAXED, __HIP_MEMORY_SCOPE_AGENT) < 32u) { __builtin_amdgcn_s_sleep(2); if (++sp > (1u << 22)) break; }
        __builtin_amdgcn_fence(__ATOMIC_ACQUIRE, "agent"); asm volatile("s_waitcnt vmcnt(0)" ::: "memory"); }
    __syncthreads();
}

#ifndef DUP_NSA
#define DUP_NSA 1
#endif
#ifndef DUP_MLA
#define DUP_MLA 1
#endif
#ifndef DUP_ML
#define DUP_ML 1
#endif
#ifdef NO_MLA
#define MLA_CALL(...) do {} while (0)
#else
#define MLA_CALL(...) do { for (int rp = 0; rp < DUP_MLA; ++rp) { if (rp) __syncthreads(); mla_unit(__VA_ARGS__); } } while (0)
#endif
__device__ __forceinline__ void phase_mix(int l, InPtr in, unsigned char* ws, LAS unsigned char* lds, unsigned* qhead, int g_wv) {
    LAS int* slot = (LAS int*)(lds + LDS_MISC + 64);
    for (;;) {
        __syncthreads();
        if (TIDX == 0) *slot = (int)__hip_atomic_fetch_add(qhead, 1u, __ATOMIC_RELAXED, __HIP_MEMORY_SCOPE_AGENT);
        __syncthreads();
        int u = *slot;
        if (u >= 32 + 512 + 384 + 128) break;
        if (u < 32) { ml_scan_unit(u, l, ws, g_wv); continue; } u -= 32;
#ifndef NO_NSA
        if (u < 256) { const int i = 31 - (u >> 4), bh = u & 15; { for (int rp = 0; rp < DUP_NSA; ++rp) { if (rp) __syncthreads(); nsa_unit(bh >> 1, bh & 1, i, l, in, ws, lds, g_wv); } } continue; }
#endif
        u -= 256;
        if (u < 192) { const int qt = 7 - u / 48, bh = u % 48; MLA_CALL(bh / 6, bh % 6, qt, l, ws, lds, g_wv); continue; }
        u -= 192;
#ifndef NO_NSA
        if (u < 128) { const int i = 15 - (u >> 4), bh = u & 15; { for (int rp = 0; rp < DUP_NSA; ++rp) { if (rp) __syncthreads(); nsa_unit(bh >> 1, bh & 1, i, l, in, ws, lds, g_wv); } } continue; }
#endif
        u -= 128;
        if (u < 192) { const int qt = 3 - u / 48, bh = u % 48; MLA_CALL(bh / 6, bh % 6, qt, l, ws, lds, g_wv); continue; } u -= 192;
#ifndef NO_NSA
        if (u < 128) { const int i = 7 - (u >> 4), bh = u & 15; { for (int rp = 0; rp < DUP_NSA; ++rp) { if (rp) __syncthreads(); nsa_unit(bh >> 1, bh & 1, i, l, in, ws, lds, g_wv); } } continue; }
#endif
        u -= 128;
#ifndef NO_MLOUT
        ml_scan_wait(l, ws, g_wv);
        for (int rp = 0; rp < DUP_ML; ++rp) { int tid_ = TIDX; asm volatile("" : "+v"(tid_)); const int w = tid_ >> 6; ml_out_wave(u * 8 + w, l, in, ws, lds + w * 16384, lds + 131072 + w * 256, tid_ & 63); }
#endif
    }
}
__device__ __forceinline__ void phase_ynorm(int l, unsigned char* ws, int bid, int nb, int g_wv) {
    int tid_ = TIDX; asm volatile("" : "+v"(tid_)); const int w = tid_ >> 6, lane = tid_ & 63;
    bf16_t* Y = (bf16_t*)(ws + WS_Y); const float* sa = (const float*)(ws + WS_SSQ + PT_A) + (size_t)l * 16384 * 8; const float* sc = (const float*)(ws + WS_SSQ + PT_C) + (size_t)l * 16384 * 8;
    for (int r0 = (bid * 8 + w) * 8; r0 < NTOK; r0 += nb * 64) {
        if (lane < 48) {
            u32x4 x[8], y[8]; float ra[8], rc[8];
#pragma unroll
            for (int k = 0; k < 8; ++k) { const int row = r0 + k;
                const f32x4 a0 = *(const f32x4*)(sa + (size_t)row * 8), a1 = *(const f32x4*)(sa + (size_t)row * 8 + 4), c0 = *(const f32x4*)(sc + (size_t)row * 8), c1 = *(const f32x4*)(sc + (size_t)row * 8 + 4);
                ra[k] = rsqrtf((((a0.x + a0.y) + (a0.z + a0.w)) + (a1.x + a1.y)) * (1.f / 384.f) + 1e-6f); rc[k] = rsqrtf((((c0.x + c0.y) + (c0.z + c0.w)) + (c1.x + c1.y)) * (1.f / 384.f) + 1e-6f);
                x[k] = *((const u32x4*)(Y + (size_t)row * 1024) + lane); y[k] = *((const u32x4*)(Y + (size_t)row * 1024 + 384) + lane); }
#pragma unroll
            for (int k = 0; k < 8; ++k) { const int row = r0 + k; u32x4 a = x[k], c = y[k]; const float fa = ra[k], fc = rc[k];
                a.x = pk_bf16(bf_lo(a.x) * fa, bf_hi(a.x) * fa); a.y = pk_bf16(bf_lo(a.y) * fa, bf_hi(a.y) * fa); a.z = pk_bf16(bf_lo(a.z) * fa, bf_hi(a.z) * fa); a.w = pk_bf16(bf_lo(a.w) * fa, bf_hi(a.w) * fa);
                c.x = pk_bf16(bf_lo(c.x) * fc, bf_hi(c.x) * fc); c.y = pk_bf16(bf_lo(c.y) * fc, bf_hi(c.y) * fc); c.z = pk_bf16(bf_lo(c.z) * fc, bf_hi(c.z) * fc); c.w = pk_bf16(bf_lo(c.w) * fc, bf_hi(c.w) * fc);
                *((u32x4*)(Y + (size_t)row * 1024) + lane) = a; *((u32x4*)(Y + (size_t)row * 1024 + 384) + lane) = c; }
        }
    }
}
constexpr int LDS_FAC = 131072 + 2048;
__device__ __forceinline__ void outproj_factors(int l, unsigned char* ws, LAS unsigned char* lds, int pm, int tid) {
    asm volatile("" : "+v"(tid));
    if (tid < 256) { const int row = pm * 256 + tid; const float* sa = (const float*)(ws + WS_SSQ + PT_A) + ((size_t)l * 16384 + row) * 8; const float* sc = (const float*)(ws + WS_SSQ + PT_C) + ((size_t)l * 16384 + row) * 8;
        const f32x4 a0 = *(const f32x4*)sa, a1 = *(const f32x4*)(sa + 4), c0 = *(const f32x4*)sc, c1 = *(const f32x4*)(sc + 4);
        const float ra = rsqrtf((((a0.x + a0.y) + (a0.z + a0.w)) + (a1.x + a1.y)) * (1.f / 384.f) + 1e-6f), rc = rsqrtf((((c0.x + c0.y) + (c0.z + c0.w)) + (c1.x + c1.y)) * (1.f / 384.f) + 1e-6f);
        LAS float* F = (LAS float*)(lds + LDS_FAC); F[2 * tid] = ra / rc; F[2 * tid + 1] = rc; }
    __syncthreads();
}
struct EpiOut {
    static constexpr bool KHOOK = true;
    bf16_t* XB; float* ssq; const LAS float* F; bool fold;
    __device__ __forceinline__ void kscale(f32x4 (&acc)[2][2][4][2], int which, int wr, int fr) const {
        if (!fold) return;
#pragma unroll
        for (int ai = 0; ai < 2; ++ai)
#pragma unroll
            for (int m = 0; m < 4; ++m) { const float f = F[2 * (ai * 128 + wr * 64 + m * 16 + fr) + which];
#pragma unroll
                for (int bj = 0; bj < 2; ++bj)
#pragma unroll
                    for (int n = 0; n < 2; ++n) acc[ai][bj][m][n] = acc[ai][bj][m][n] * f; }
    }
    __device__ __forceinline__ void operator()(const f32x4 (&acc)[2][2][4][2], const GUnit& u, int wr, int wc, int fr, int fq) const {
#pragma unroll
        for (int ai = 0; ai < 2; ++ai)
#pragma unroll
          for (int mh = 0; mh < 2; ++mh) {
            __builtin_amdgcn_sched_barrier(0);
            u32x4 xr[2][2];
#pragma unroll
            for (int m2 = 0; m2 < 2; ++m2)
#pragma unroll
                for (int bj = 0; bj < 2; ++bj) xr[m2][bj] = *(const u32x4*)(XB + (size_t)(u.pm * 256 + ai * 128 + wr * 64 + (2 * mh + m2) * 16 + fr) * 1024 + u.pn * 256 + bj * 128 + wc * 32 + 8 * fq);
#pragma unroll
            for (int m2 = 0; m2 < 2; ++m2) {
                const int m = 2 * mh + m2; const int row = u.pm * 256 + ai * 128 + wr * 64 + m * 16 + fr; float ss = 0.f;
#pragma unroll
                for (int bj = 0; bj < 2; ++bj) {
                    const u32x4 x = xr[m2][bj]; u32x4 o;
                    o.x = pk_bf16(bf_lo(x.x) + acc[ai][bj][m][0][0], bf_hi(x.x) + acc[ai][bj][m][0][1]); o.y = pk_bf16(bf_lo(x.y) + acc[ai][bj][m][0][2], bf_hi(x.y) + acc[ai][bj][m][0][3]);
                    o.z = pk_bf16(bf_lo(x.z) + acc[ai][bj][m][1][0], bf_hi(x.z) + acc[ai][bj][m][1][1]); o.w = pk_bf16(bf_lo(x.w) + acc[ai][bj][m][1][2], bf_hi(x.w) + acc[ai][bj][m][1][3]);
                    *(u32x4*)(XB + (size_t)row * 1024 + u.pn * 256 + bj * 128 + wc * 32 + 8 * fq) = o;
                    ss += (bf_lo(o.x) * bf_lo(o.x) + bf_hi(o.x) * bf_hi(o.x)) + (bf_lo(o.y) * bf_lo(o.y) + bf_hi(o.y) * bf_hi(o.y)) + (bf_lo(o.z) * bf_lo(o.z) + bf_hi(o.z) * bf_hi(o.z)) + (bf_lo(o.w) * bf_lo(o.w) + bf_hi(o.w) * bf_hi(o.w));
                }
                ss = quad_sum(ss); if (fq == 0) ssq[(size_t)row * 16 + u.pn * 4 + wc] = ss;
            }
          }
    }
};

__device__ __forceinline__ float sum16(const float* p) { const f32x4 a = *(const f32x4*)p, b = *(const f32x4*)(p + 4), c = *(const f32x4*)(p + 8), d = *(const f32x4*)(p + 12);
    return (((a.x + a.y) + (a.z + a.w)) + ((b.x + b.y) + (b.z + b.w))) + (((c.x + c.y) + (c.z + c.w)) + ((d.x + d.y) + (d.z + d.w))); }
__device__ __forceinline__ void phase_route(int l, InPtr in, unsigned char* ws, LAS unsigned char* lds, int bid, int nb, int g_wv) {
    int tid_ = TIDX; asm volatile("" : "+v"(tid_)); const int w = tid_ >> 6, lane = tid_ & 63, r = lane & 15, q = lane >> 4;
    const bf16_t* XB = (const bf16_t*)(ws + WS_XB); const bf16_t* WR = (const bf16_t*)(ws + WS_WR) + (size_t)l * 64 * 1024;
    const float* ssq = (const float*)(ws + WS_SSQ + PT_X1) + (size_t)l * 16384 * 16; const float* bg = in->p[24] + l * 4; const float* be = in->p[26] + l * 32;
    unsigned* cnt = (unsigned*)(ws + WS_CTL) + CW_CNT + 2048 * l; unsigned* mtok = (unsigned*)(ws + WS_META); float* mw = (float*)(ws + WS_META + META_W);
    LAS float* lg = (LAS float*)(lds + w * 4096);
    LAS unsigned* lcnt = (LAS unsigned*)(lds + 32768); LAS unsigned* lbase = lcnt + 32;
    constexpr int WRP = 2064; LAS unsigned char* wrl = lds + 40960;
    { u32x4 st[12];
#pragma unroll
      for (int i = 0; i < 12; ++i) { const int c = tid_ + 512 * i; st[i] = *(const u32x4*)(WR + (size_t)(c >> 7) * 1024 + (c & 127) * 8); }
#pragma unroll
      for (int i = 0; i < 12; ++i) { const int c = tid_ + 512 * i; *(LAS u32x4*)(wrl + (c >> 7) * WRP + (c & 127) * 16) = st[i]; } }
    for (int g0 = bid * 8; g0 < NTOK / 16; g0 += nb * 8) {
        if (tid_ < 32) lcnt[tid_] = 0u;
        __syncthreads();
        const int tok0 = (g0 + w) * 16; f32x4 acc[3];
#pragma unroll
        for (int n = 0; n < 3; ++n) acc[n] = (f32x4){0.f, 0.f, 0.f, 0.f};
        const bf16_t* ap = XB + (size_t)(tok0 + r) * 1024 + 8 * q; const LAS unsigned char* bl_ = wrl + r * WRP + 16 * q;
#pragma unroll 1
        for (int kc = 0; kc < 2; ++kc) {
            bf16x8 a[16];
#pragma unroll
            for (int s = 0; s < 16; ++s) a[s] = *(const bf16x8*)(ap + 32 * (kc * 16 + s));
            __builtin_amdgcn_sched_barrier(0);
#pragma unroll
            for (int s = 0; s < 16; ++s)
#pragma unroll
                for (int n = 0; n < 3; ++n) { const bf16x8 bb = *(const LAS bf16x8*)(bl_ + n * 16 * WRP + 64 * (kc * 16 + s)); acc[n] = MFMA16(a[s], bb, acc[n]); }
            __builtin_amdgcn_sched_barrier(0);
        }
#pragma unroll
        for (int n = 0; n < 3; ++n)
#pragma unroll
            for (int j = 0; j < 4; ++j) lg[(4 * q + j) * 48 + 16 * n + r] = acc[n][j];
        LDS_FENCE();
        int E0 = 0, E1 = 0; unsigned r0 = 0, r1 = 0; float wt0 = 0.f, wt1 = 0.f; const int tok = tok0 + (lane & 15);
        if (lane < 16) {
            const float rs = rsqrtf(sum16(ssq + (size_t)tok * 16) * (1.f / 1024.f) + 1e-6f); ((float*)(ws + WS_RS2))[tok] = rs; const LAS float* L = lg + lane * 48;
            float gl[4]; int gi = 0;
#pragma unroll
            for (int j = 0; j < 4; ++j) gl[j] = L[j] * rs + bg[j];
            float gm = gl[0];
#pragma unroll
            for (int j = 1; j < 4; ++j) if (gl[j] > gm) { gm = gl[j]; gi = j; }
            float gsum = 0.f;
#pragma unroll
            for (int j = 0; j < 4; ++j) gsum += __expf(gl[j] - gm);
            const float gtop = 1.f / gsum;
            float el[8];
#pragma unroll
            for (int j = 0; j < 8; ++j) el[j] = L[4 + gi * 8 + j] * rs + be[gi * 8 + j];
            int e0 = 0; float v0 = el[0];
#pragma unroll
            for (int j = 1; j < 8; ++j) if (el[j] > v0) { v0 = el[j]; e0 = j; }
            int e1 = -1; float v1 = -3.0e38f;
#pragma unroll
            for (int j = 0; j < 8; ++j) if (j != e0 && el[j] > v1) { v1 = el[j]; e1 = j; }
            const float w0 = 1.f / (1.f + __expf(v1 - v0)); E0 = gi * 8 + e0; E1 = gi * 8 + e1; wt0 = w0 * gtop; wt1 = (1.f - w0) * gtop;
            r0 = __hip_atomic_fetch_add(lcnt + E0, 1u, __ATOMIC_RELAXED, __HIP_MEMORY_SCOPE_WORKGROUP); r1 = __hip_atomic_fetch_add(lcnt + E1, 1u, __ATOMIC_RELAXED, __HIP_MEMORY_SCOPE_WORKGROUP);
        }
        __syncthreads();
        if (tid_ < 32) { const unsigned c = lcnt[tid_]; lbase[tid_] = c ? atomicAdd(cnt + tid_ * 64, c) : 0u; }
        __syncthreads();
        if (lane < 16) {
            const unsigned p0 = lbase[E0] + r0, p1 = lbase[E1] + r1;
            mtok[(size_t)E0 * 16384 + p0] = (unsigned)tok; mw[(size_t)E0 * 16384 + p0] = wt0;
            mtok[(size_t)E1 * 16384 + p1] = (unsigned)tok | 0x80000000u; mw[(size_t)E1 * 16384 + p1] = wt1;
        }
        __syncthreads();
    }
}

constexpr int LDS_TB = 131072 + 2048;
__device__ __forceinline__ void moe_tables(int l, unsigned char* ws, LAS unsigned char* lds, int g_wv) {
    int tix = TIDX; asm volatile("" : "+v"(tix));
    LAS int* tb = (LAS int*)(lds + LDS_TB);
    if (tix < 32) { const unsigned* cnt = (const unsigned*)(ws + WS_CTL) + CW_CNT + 2048 * l; tb[160 + tix] = (int)__hip_atomic_load(cnt + tix * 64, __ATOMIC_RELAXED, __HIP_MEMORY_SCOPE_AGENT); }
    __syncthreads();
    if (tix == 0) { int a = 0, f = 0, p = 0; for (int e = 0; e < 32; ++e) { const int c = tb[160 + e]; tb[e] = a; tb[48 + e] = f; tb[96 + e] = p; a += (c + 255) >> 8; f += c >> 8; p += (c & 255) ? 1 : 0; } tb[32] = a; tb[80] = f; tb[128] = p; }
    __syncthreads();
}
template <int NPN, bool GATHER_>
struct MoeSched {
    static constexpr bool GATHER = GATHER_, PARTIAL = false;
    const char* A; const char* Bt; const unsigned* cnt; const unsigned* mtok; const LAS int* tb; int G, c; size_t bstride_e  , bstride_pn; int lo, hi;
    __device__ __forceinline__ bool next(int i, GUnit& u) const {
        const int L = lo + i * G + c; if (L >= hi) return false;
        const int tile = L / NPN, pn = L % NPN;
        int e = 0;
        for (int k = 1; k < 32; ++k) e = (tb[k] <= tile) ? k : e;
        e = __builtin_amdgcn_readfirstlane(e);
        u.e = e; u.pm = tile; u.pn = pn; u.rows = tb[160 + e] - 256 * (tile - tb[e]);
        u.a = GATHER ? A : A + (size_t)tile * 256 * 256 * 2;
        u.b = Bt + (size_t)e * bstride_e + (size_t)pn * bstride_pn; return true;
    }
    __device__ __forceinline__ void aoff(const GUnit& u, unsigned (&v)[2][2], const int (&R)[2], const int (&C)[2]) const {
#pragma unroll
        for (int h = 0; h < 2; ++h)
#pragma unroll
            for (int i = 0; i < 2; ++i) {
                if (GATHER) { const int lr = h * 128 + R[i]; const int rr = 256 * (u.pm - tb[u.e]) + (lr < u.rows ? lr : 0); const unsigned tok = mtok[(size_t)u.e * 16384 + rr] & 0x7fffffffu; v[h][i] = (tok * 1024u + (unsigned)C[i]) * 2u; }
                else v[h][i] = (unsigned)((h * 128 + R[i]) * 256 + C[i]) * 2u;
            }
    }
};
struct EpiMoeUp {
    static constexpr bool KHOOK = false;
    const unsigned* mtok; const float* ssq; const LAS int* tb; bf16_t* HB;
    __device__ __forceinline__ void operator()(const f32x4 (&acc)[2][2][4][2], const GUnit& u, int wr, int wc, int fr, int fq) const {
        const int r0 = 256 * (u.pm - tb[u.e]);
        float rs8[8];
        { unsigned tk[8];
#pragma unroll
          for (int k = 0; k < 8; ++k) { const int lr = (k >> 2) * 128 + wr * 64 + (k & 3) * 16 + fr; tk[k] = mtok[(size_t)u.e * 16384 + r0 + (lr < u.rows ? lr : 0)] & 0x7fffffffu; }
#pragma unroll
          for (int k = 0; k < 8; ++k) rs8[k] = ssq[tk[k]]; }
#pragma unroll
        for (int ai = 0; ai < 2; ++ai)
#pragma unroll
            for (int m = 0; m < 4; ++m) {
                __builtin_amdgcn_sched_barrier(0);
                const int lr = ai * 128 + wr * 64 + m * 16 + fr;
                if (lr < u.rows) {
                    const float rs = rs8[ai * 4 + m];
                    float hv[8];
#pragma unroll
                    for (int n = 0; n < 2; ++n)
#pragma unroll
                        for (int j = 0; j < 4; ++j) { const float gv = acc[ai][0][m][n][j] * rs, uv = acc[ai][1][m][n][j] * rs; hv[4 * n + j] = siluf(gv) * uv; }
                    st_bf16x8(HB + ((size_t)u.pm * 256 + lr) * 256 + u.pn * 128 + wc * 32 + 8 * fq, hv);
                }
            }
    }
};
struct EpiMoeDown {
    static constexpr bool KHOOK = false;
    const unsigned* mtok; const float* mw; const LAS int* tb; bf16_t* YB;
    __device__ __forceinline__ void operator()(const f32x4 (&acc)[2][2][4][2], const GUnit& u, int wr, int wc, int fr, int fq) const {
        const int r0 = 256 * (u.pm - tb[u.e]);
        unsigned mt8[8]; float wt8[8];
#pragma unroll
        for (int k = 0; k < 8; ++k) { const int lr = (k >> 2) * 128 + wr * 64 + (k & 3) * 16 + fr; const size_t ix = (size_t)u.e * 16384 + r0 + (lr < u.rows ? lr : 0); mt8[k] = mtok[ix]; wt8[k] = mw[ix]; }
#pragma unroll
        for (int ai = 0; ai < 2; ++ai)
#pragma unroll
            for (int m = 0; m < 4; ++m) {
                __builtin_amdgcn_sched_barrier(0);
                const int lr = ai * 128 + wr * 64 + m * 16 + fr;
                if (lr < u.rows) {
                    const unsigned mt = mt8[ai * 4 + m]; const float wt = wt8[ai * 4 + m];
                    bf16_t* dst = YB + ((size_t)(mt >> 31) * 16384 + (mt & 0x7fffffffu)) * 1024 + u.pn * 256 + wc * 32 + 8 * fq;
#pragma unroll
                    for (int bj = 0; bj < 2; ++bj) { float v[8];
#pragma unroll
                        for (int n = 0; n < 2; ++n)
#pragma unroll
                            for (int j = 0; j < 4; ++j) v[4 * n + j] = acc[ai][bj][m][n][j] * wt;
                        st_bf16x8(dst + bj * 128, v); }
                }
            }
    }
};
__device__ __forceinline__ void phase_combine(int l, unsigned char* ws, float* out, int bid, int nb, int g_wv) {
    int tid_ = TIDX; asm volatile("" : "+v"(tid_)); const int w = tid_ >> 6, lane = tid_ & 63;
    bf16_t* XB = (bf16_t*)(ws + WS_XB); const bf16_t* Y0 = (const bf16_t*)(ws + WS_YBUF); const bf16_t* Y1 = Y0 + (size_t)16384 * 1024; float* ssqx = (float*)(ws + WS_SSQX) + 16384;
    for (int row = bid * 8 + w; row < NTOK; row += nb * 8) {
        float ss = 0.f;
#pragma unroll
        for (int k = 0; k < 2; ++k) {
            const size_t o = (size_t)row * 1024 + (lane + 64 * k) * 8;
            const u32x4 x = *(const u32x4*)(XB + o), a = *(const u32x4*)(Y0 + o), c = *(const u32x4*)(Y1 + o);
            float v[8] = { bf_lo(x.x) + bf_lo(a.x) + bf_lo(c.x), bf_hi(x.x) + bf_hi(a.x) + bf_hi(c.x), bf_lo(x.y) + bf_lo(a.y) + bf_lo(c.y), bf_hi(x.y) + bf_hi(a.y) + bf_hi(c.y),
                           bf_lo(x.z) + bf_lo(a.z) + bf_lo(c.z), bf_hi(x.z) + bf_hi(a.z) + bf_hi(c.z), bf_lo(x.w) + bf_lo(a.w) + bf_lo(c.w), bf_hi(x.w) + bf_hi(a.w) + bf_hi(c.w) };
            if (l == L_ - 1 && out) { *(f32x4*)(out + o) = (f32x4){v[0], v[1], v[2], v[3]}; *(f32x4*)(out + o + 4) = (f32x4){v[4], v[5], v[6], v[7]}; }
            else { u32x4 p; p.x = pk_bf16(v[0], v[1]); p.y = pk_bf16(v[2], v[3]); p.z = pk_bf16(v[4], v[5]); p.w = pk_bf16(v[6], v[7]); *(u32x4*)(XB + o) = p;
#pragma unroll
                   for (int j = 0; j < 4; ++j) { const unsigned q = j == 0 ? p.x : (j == 1 ? p.y : (j == 2 ? p.z : p.w)); ss += bf_lo(q) * bf_lo(q) + bf_hi(q) * bf_hi(q); } }
        }
        if (l < L_ - 1) { ss = wave_sum(ss); if (lane == 0) ssqx[row] = ss; }
    }
}
constexpr int MOE_CVT_SPLIT = 4608;
#ifndef CVT_A
#define CVT_A 1920
#endif
#ifndef NROUTE
#define NROUTE 128
#endif
constexpr int NPH = 9;
enum { PH_INPROJ = 0, PH_PREP, PH_MIX, PH_YNORM, PH_OUTPROJ, PH_ROUTE, PH_MOEUP, PH_MOEDOWN, PH_COMBINE };
struct Args { Inputs in; float* out; unsigned char* ws; int ph_lo, ph_hi; };

__global__ void __launch_bounds__(512, 2) mk(Args args) {
    extern __shared__ __attribute__((aligned(16))) unsigned char lds_raw[];
    LAS unsigned char* lds = (LAS unsigned char*)lds_raw;
    const int g_wv = __builtin_amdgcn_readfirstlane((int)threadIdx.x >> 6);
    const int bid0 = blockIdx.x, nb = gridDim.x;
#define BID() ({ int b_ = bid0; asm volatile("" : "+s"(b_)); b_; })
    unsigned char* ws = args.ws; unsigned* ctl = (unsigned*)(ws + WS_CTL);
    const int lo = args.ph_lo, hi = args.ph_hi;
    if (TIDX < 4) ((LAS unsigned*)(lds + LDS_MISC))[TIDX] = 0u;
    __syncthreads();
    XcdBarrier bar; bar.g_wv = g_wv; bar.bar = ctl + CW_BAR; bar.x = 0; bar.st = nullptr;
    if (hi - lo > 1) bar = xcd_barrier_post(ctl + CW_BAR, (volatile LAS unsigned*)(lds + LDS_MISC), g_wv);
#define IN(k) (lo <= (k) && (k) < hi)
#ifndef REPEAT_PH
#define REPEAT_PH -1
#endif
#define NREP(k) ((REPEAT_PH == (k)) ? 2 : 1)
#ifndef NBAR
#define NBAR 1
#endif
#ifndef TIME_PH
#define TIME_PH -1
#endif
#define STAMP(i) do { if (TIME_PH != -1 && blockIdx.x == 0 && TIDX == 0) ((unsigned long long*)(ctl + CW_TS))[i] = __builtin_amdgcn_s_memrealtime(); } while (0)
#define SEAM(k) do { if (IN(k) && IN((k) + 1)) for (int nb_ = 0; nb_ < NBAR; ++nb_) xcd_barrier(bar); STAMP((k) + 1); } while (0)
    STAMP(0);
#ifndef NO_PRO
    if (IN(0)) for (int rep = 0; rep < NREP(100); ++rep) { prologue(in_tab(), launder(ws), lds, BID(), nb, g_wv); if (rep + 1 < NREP(100)) xcd_barrier(bar); }
#endif
    SEAM(0);
    for (int l = 0; l < L_; ++l) {
        const int pb = 1 + l * NPH;
        if (IN(pb + PH_INPROJ)) for (int rep = 0; rep < NREP(PH_INPROJ); ++rep) {
            if (rep) xcd_barrier(bar);
            InPtr in = in_tab(); unsigned char* ws = launder(args.ws);
            g8::DenseSched S{(const char*)(ws + WS_XB), (const char*)(ws + WS_WIN) + (size_t)l * 2560 * 1024 * 2, 1024, 1024, 64, 10, nb, BID()};
            EpiInProj E{(const float*)(ws + WS_SSQX) + l * 16384, (float*)(ws + WS_SSQ + PT_DQ) + (size_t)l * 16384 * 4, (float*)(ws + WS_SSQ + PT_DKV) + (size_t)l * 16384 * 2,
                        in->p[8] + l * 64, in->p[9] + l * 64, in->p[19] + l * 192 + 96 + 64, (const float*)(ws + WS_ROPE), ws + WS_PRJ};
#ifndef NO_INPROJ
            g8::gemm_run(lds, 1024, 1024, S, E, g_wv);
#endif
        }
        SEAM(pb + PH_INPROJ);
        if (IN(pb + PH_PREP)) for (int rep = 0; rep < NREP(PH_PREP); ++rep) { if (rep) xcd_barrier(bar); phase_prep(l, in_tab(), launder(ws), lds, BID(), nb, g_wv, (unsigned*)launder(ws) + CW_Q + 64 * (4 + l + 2 * rep)); }
        SEAM(pb + PH_PREP);
        if (IN(pb + PH_MIX)) for (int rep = 0; rep < NREP(PH_MIX); ++rep) { if (rep) xcd_barrier(bar); phase_mix(l, in_tab(), launder(ws), lds, (unsigned*)launder(ws) + CW_Q + 64 * (l + 2 * rep), g_wv); }
        SEAM(pb + PH_MIX);
        const bool fold_norm = (nb == 256);
        if (IN(pb + PH_YNORM) && !fold_norm) phase_ynorm(l, launder(ws), BID(), nb, g_wv);
        if (!fold_norm) SEAM(pb + PH_YNORM);
        if (IN(pb + PH_OUTPROJ)) {
            unsigned char* ws = launder(args.ws);
            g8::DenseSched S{(const char*)(ws + WS_Y), (const char*)(ws + WS_WOUT) + (size_t)l * 1024 * 1024 * 2, 1024, 1024, 64, 4, nb, BID()};
            EpiOut E{(bf16_t*)(ws + WS_XB), (float*)(ws + WS_SSQ + PT_X1) + (size_t)l * 16384 * 16, (const LAS float*)(lds + LDS_FAC), fold_norm};
            if (fold_norm) { g8::GUnit u0; if (S.next(0, u0)) outproj_factors(l, ws, lds, u0.pm, TIDX); else __syncthreads(); }
#ifndef NO_OUTPROJ
            g8::gemm_run(lds, 1024, 1024, S, E, g_wv);
#endif
        }
        SEAM(pb + PH_OUTPROJ);
#ifndef NO_ROUTE
        if (IN(pb + PH_ROUTE)) {
            const int b_ = BID();
            if (nb >= 256 && b_ >= NROUTE) { cvt_moe_layer(in_tab(), launder(ws), l, (LAS float*)lds, b_ - NROUTE, nb - NROUTE, TIDX, 0, CVT_A);
#ifdef DUP_CVT
                __syncthreads(); cvt_moe_layer(in_tab(), launder(ws), l, (LAS float*)lds, b_ - NROUTE, nb - NROUTE, TIDX);
#endif
            }
            else { phase_route(l, in_tab(), launder(ws), lds, b_, nb >= 256 ? NROUTE : nb, g_wv);
                   if (nb < 256) cvt_moe_layer(in_tab(), launder(ws), l, (LAS float*)lds, b_, nb, TIDX); else cvt_moe_layer(in_tab(), launder(ws), l, (LAS float*)lds, b_, NROUTE, TIDX, CVT_A, 3072); }
            if (l + 1 < L_) { __syncthreads(); cvt_small_weights(in_tab(), launder(ws), l + 1, (LAS float*)lds, b_, nb, TIDX); }
        }
#endif
        SEAM(pb + PH_ROUTE);
        {
            const bool do_up = IN(pb + PH_MOEUP), do_dn = IN(pb + PH_MOEDOWN), fuse = do_up && do_dn;
            for (int part = 0; part < (fuse ? 3 : 1); ++part) {
                if (part) xcd_barrier(bar);
                unsigned char* ws = launder(args.ws);
                if (do_up || do_dn) moe_tables(l, ws, lds, g_wv);
                const unsigned* cnt = (const unsigned*)(ws + WS_CTL) + CW_CNT + 2048 * l; const unsigned* mtok = (const unsigned*)(ws + WS_META); const LAS int* tb = (const LAS int*)(lds + LDS_TB);
                const int b_ = BID(), ntile = tb[32], UPU = 2 * ntile, DNU = 4 * ntile;
                const int hi0 = UPU < nb ? UPU : nb, nu_ = UPU - hi0, nu = nu_ < (nb >> 1) ? nu_ : (nb >> 1), nd = nb - nu;
                const int d1a = 4 * (hi0 >> 1), d1b = 2 * nd, D1 = nu == 0 ? DNU : (d1a < d1b ? d1a : d1b);
                int ulo = 0, uhi = UPU, uG = nb, uc = b_, dlo = 0, dhi = DNU, dG = nb, dc = b_;
                if (fuse) {
                    if (part == 0) { uhi = hi0; dhi = 0; }
                    else if (part == 1) { ulo = hi0; uG = nu; if (b_ >= nu) uhi = ulo; dhi = D1; dG = nd; dc = b_ - nu; if (b_ < nu) dhi = 0; }
                    else { uhi = 0; dlo = D1; }
                }
                if (do_up && uhi > ulo) {
                    MoeSched<2, true> S{(const char*)(ws + WS_XB), (const char*)(ws + WS_WMOE), cnt, mtok, tb, uG, uc, (size_t)512 * 1024 * 2, (size_t)256 * 1024 * 2, ulo, uhi};
                    EpiMoeUp E{mtok, (const float*)(ws + WS_RS2), tb, (bf16_t*)(ws + WS_HBUF)};
#ifndef NO_MOEUP
                    g8::gemm_run(lds, 1024, 1024, S, E, g_wv);
#endif
                }
                if (do_dn && dhi > dlo) {
                    MoeSched<4, false> S{(const char*)(ws + WS_HBUF), (const char*)(ws + WS_WMOE + WMOE_WD), cnt, mtok, tb, dG, dc, (size_t)1024 * 256 * 2, (size_t)256 * 256 * 2, dlo, dhi};
                    EpiMoeDown E{mtok, (const float*)(ws + WS_META + META_W), tb, (bf16_t*)(ws + WS_YBUF)};
#ifndef NO_MOEDOWN
                    g8::gemm_run(lds, 256, 256, S, E, g_wv);
#endif
                }
            }
        }
        SEAM(pb + PH_MOEDOWN);
#ifndef NO_COMBINE
        if (IN(pb + PH_COMBINE)) { unsigned char* ws = launder(args.ws); phase_combine(l, ws, args.out, BID(), nb, g_wv); }
#endif
        SEAM(pb + PH_COMBINE);
    }
#undef IN
#undef SEAM
}
#if CHECK
struct NvScratch { float *proj, *h1, *qk, *hraw, *kn, *kcmp, *vcmp, *dqn, *q, *dkvn, *kv, *krope, *y, *x1, *xl; int* rt_e; float* rt_w; };
constexpr int CB = 5;
enum { NS_INPROJ = 0, NS_NSAPREP, NS_MLAPREP, NS_NSA, NS_ML, NS_MLA, NS_OUT, NS_ROUTE, NS_MOE };
static void naive_step(void* const* d_in, int l, int step, const float* xin, float* xout, const NvScratch& S, hipStream_t st) {
    const int b = CB;
    const float* rel_bias = (const float*)d_in[2];
    const float* norm1_g = (const float*)d_in[3] + (long)l * 1024;
    const float* w_in = (const float*)d_in[4] + (long)l * 1024 * DIN;
    const float* cmp_pe = (const float*)d_in[5] + (long)l * 2 * 32 * 64;
    const float* cmp_w1 = (const float*)d_in[6] + (long)l * 2 * 32 * 64 * 64;
    const float* cmp_w2 = (const float*)d_in[7] + (long)l * 2 * 64 * 64;
    const float* q_norm = (const float*)d_in[8] + l * 64;
    const float* k_norm = (const float*)d_in[9] + l * 64;
    const float* nsa_on = (const float*)d_in[10] + l * 384;
    const float* conv = (const float*)d_in[11] + l * 4 * 512;
    const float* ibias = (const float*)d_in[12] + l * 4;
    const float* fbias = (const float*)d_in[13] + l * 4;
    const float* ml_on = (const float*)d_in[14] + l * 256;
    const float* qan = (const float*)d_in[15] + l * 192;
    const float* w_uq = (const float*)d_in[16] + (long)l * 192 * 576;
    const float* kvan = (const float*)d_in[17] + l * 128;
    const float* w_ukv = (const float*)d_in[18] + (long)l * 128 * 768;
    const float* qkn = (const float*)d_in[19] + l * 192;
    const float* mla_on = (const float*)d_in[20] + l * 384;
    const float* w_out = (const float*)d_in[21] + (long)l * 1024 * 1024;
    const float* norm2_g = (const float*)d_in[22] + l * 1024;
    const float* wgrp = (const float*)d_in[23] + (long)l * 1024 * 4;
    const float* bgrp = (const float*)d_in[24] + l * 4;
    const float* wexp = (const float*)d_in[25] + (long)l * 1024 * 32;
    const float* bexp = (const float*)d_in[26] + l * 32;
    const float* Wg = (const float*)d_in[27] + (long)l * 32 * 1024 * 256;
    const float* Wu = (const float*)d_in[28] + (long)l * 32 * 1024 * 256;
    const float* Wd = (const float*)d_in[29] + (long)l * 32 * 256 * 1024;
    const int* pos = (const int*)d_in[1] + b * 2048;
    switch (step) {
    case NS_INPROJ:
        nv_rmsnorm<<<dim3(2048, 1), 64, 0, st>>>(xin, 1024, 0, S.h1, 1024, 0, norm1_g, 0, 1024);
        nv_gemm<<<dim3((DIN + 63) / 64, 2048 / 64), 256, 0, st>>>(S.h1, 1024, w_in, DIN, S.proj, DIN, nullptr, 0, 2048, DIN, 1024);
        break;
    case NS_NSAPREP:
        nv_nsa_cmp<<<dim3(127, 2, 2), 64, 0, st>>>(S.proj, cmp_pe, cmp_w1, cmp_w2, k_norm, S.kcmp, S.vcmp);
        nv_nsa_knorm<<<dim3(2048, 4), 64, 0, st>>>(S.proj, k_norm, S.kn);
        break;
    case NS_MLAPREP:
        nv_rmsnorm<<<dim3(2048, 1), 64, 0, st>>>(S.proj + O_CDQ, DIN, 0, S.dqn, 192, 0, qan, 0, 192);
        nv_gemm<<<dim3(576 / 64, 2048 / 64), 256, 0, st>>>(S.dqn, 192, w_uq, 576, S.q, 576, nullptr, 0, 2048, 576, 192);
        nv_rmsnorm<<<dim3(2048, 1), 64, 0, st>>>(S.proj + O_CDKV, DIN, 0, S.dkvn, 128, 0, kvan, 0, 128);
        nv_gemm<<<dim3(768 / 64, 2048 / 64), 256, 0, st>>>(S.dkvn, 128, w_ukv, 768, S.kv, 768, nullptr, 0, 2048, 768, 128);
        nv_mla_prep<<<dim3(2048, 7), 64, 0, st>>>(S.q, S.kv, S.proj, S.krope, qkn, pos);
        break;
    case NS_NSA:
        nv_nsa_attn<<<dim3(2048, 2), 192, 0, st>>>(S.proj, S.kn, S.kcmp, S.vcmp, rel_bias, q_norm, S.y);
        break;
    case NS_ML:
        nv_ml_conv<<<2048, 512, 0, st>>>(S.proj, conv, S.qk);
        nv_ml_rec<<<4, 256, 0, st>>>(S.proj, S.qk, ibias, fbias, S.hraw);
        nv_ml_fin<<<dim3(2048, 4), 64, 0, st>>>(S.proj, S.hraw, ml_on, S.y);
        break;
    case NS_MLA:
        nv_mla_attn<<<dim3(2048, 6), 64, 0, st>>>(S.q, S.kv, S.krope, S.y);
        break;
    case NS_OUT:
        nv_rmsnorm<<<dim3(2048, 1), 64, 0, st>>>(S.y, 1024, 0, S.y, 1024, 0, nsa_on, 0, 384);
        nv_rmsnorm<<<dim3(2048, 1), 64, 0, st>>>(S.y + 640, 1024, 0, S.y + 640, 1024, 0, mla_on, 0, 384);
        nv_gemm<<<dim3(1024 / 64, 2048 / 64), 256, 0, st>>>(S.y, 1024, w_out, 1024, S.x1, 1024, xin, 1024, 2048, 1024, 1024);
        break;
    case NS_ROUTE:
        nv_moe_route<<<2048, 64, 0, st>>>(S.x1, norm2_g, wgrp, bgrp, wexp, bexp, S.h1, S.rt_e, S.rt_w);
        break;
    case NS_MOE:
        nv_moe_exp<<<2048, 256, 0, st>>>(S.x1, S.h1, S.rt_e, S.rt_w, Wg, Wu, Wd, xout);
        break;
    }
}

__device__ __forceinline__ void chk_commit(float d2, float r2, float* acc) { d2 = wave_sum(d2); r2 = wave_sum(r2); if ((threadIdx.x & 63) == 0) { atomicAdd(acc, d2); atomicAdd(acc + 1, r2); } }
__device__ __forceinline__ void chk_add(float f, float r, float& d2, float& r2) { const float d = f - r; d2 += (d == d) ? d * d : 1e30f; r2 += r * r; }

__global__ void __launch_bounds__(64) chk_proj(const float* nproj, const unsigned char* prj, const float* ssq_dq, const float* ssq_dkv, const float* qg, const float* kg, const float* krg, const int* pos, float* acc) {
    const int t = blockIdx.x, e = threadIdx.x; const size_t row = (size_t)CB * 2048 + t; float d2 = 0.f, r2 = 0.f;
    for (int G = 0; G < 40; ++G) {
        const int c = inproj_refcol(G, e); float r = c < 0 ? 0.f : nproj[(size_t)t * DIN + c]; float f = 0.f;
        const float rr = (G == 37 && e >= 32) ? 0.f : r; const float ss = wave_sum(rr * rr);
        if (G < 6) { r = r * rsqrtf(ss / 64.f + 1e-6f) * qg[e] * 0.18033688f; f = bf2f(((const bf16_t*)(prj + PRJ_QN))[((size_t)(CB * 6 + G) * 2048 + t) * 64 + e]); }
        else if (G < 18) { const int a = G - 6, br = a >> 2, s = (a >> 1) & 1, hk = a & 1;
            if (br > 0 && s == 0) r = r * rsqrtf(ss / 64.f + 1e-6f) * kg[e];
            const size_t base = br == 0 ? (s ? PRJ_C0V : PRJ_C0K) : (br == 1 ? (s ? PRJ_VN1 : PRJ_KN1) : (s ? PRJ_VN2 : PRJ_KN2));
            f = bf2f(((const bf16_t*)(prj + base))[((size_t)(CB * 2 + hk) * 2048 + t) * 64 + e]); }
        else if (G < 26) f = bf2f(((const bf16_t*)(prj + PRJ_RAWQK))[row * 512 + (G - 18) * 64 + e]);
        else if (G < 30) f = bf2f(((const bf16_t*)(prj + PRJ_VML))[((size_t)(CB * 4 + (G - 26)) * 2048 + t) * 64 + e]);
        else if (G < 34) f = bf2f(((const bf16_t*)(prj + PRJ_OG))[row * 256 + (G - 30) * 64 + e]);
        else if (G < 37) f = bf2f(((const bf16_t*)(prj + PRJ_DQKV))[row * 384 + (G - 34) * 64 + e]);
        else if (G == 37) {
            const float val = e < 32 ? rr * rsqrtf(ss / 32.f + 1e-6f) * krg[e & 31] : 0.f; const float oth = __shfl_xor(val, 16);
            if (e < 32) { const int i = e & 15; const double ang = (double)pos[row] * pow(10000.0, -(double)i / 16.0); const float cs = (float)cos(ang), sn = (float)sin(ang);
                r = e < 16 ? val * cs - oth * sn : val * cs + oth * sn; f = bf2f(((const bf16_t*)(prj + PRJ_KR))[row * 32 + e]); }
            else if (e < 58) f = ((const float*)(prj + PRJ_GATES))[row * 32 + (e - 32)];
            else { f = 0.f; r = 0.f; }
        }
        else f = bf2f(((const bf16_t*)(prj + PRJ_DQKV))[row * 384 + 256 + (G - 38) * 64 + e]);
        chk_add(f, r, d2, r2);
    }
    float d2s = 0.f, r2s = 0.f;
    { float s1 = 0.f, s2 = 0.f; for (int c = e; c < 192; c += 64) { float v = nproj[(size_t)t * DIN + O_CDQ + c]; s1 += v * v; } for (int c = e; c < 128; c += 64) { float v = nproj[(size_t)t * DIN + O_CDKV + c]; s2 += v * v; }
      s1 = wave_sum(s1); s2 = wave_sum(s2); if (e == 0) { chk_add((ssq_dq[row * 4] + ssq_dq[row * 4 + 1]) + ssq_dq[row * 4 + 2], s1, d2s, r2s); chk_add(ssq_dkv[row * 2] + ssq_dkv[row * 2 + 1], s2, d2s, r2s); } }
    chk_commit(d2, r2, acc); chk_commit(d2s, r2s, acc + 2);
}

__global__ void __launch_bounds__(64) chk_prep(const float* nq, const float* nkv, const float* nkr, const float* nkc, const float* nvc, const unsigned char* ws, float* acc) {
    const int t = blockIdx.x, e = threadIdx.x; float d2 = 0.f, r2 = 0.f, d2c = 0.f, r2c = 0.f; const float scale = 0.14724444f;
    const bf16_t* QM = (const bf16_t*)(ws + WS_MLA); const bf16_t* KM = (const bf16_t*)(ws + WS_MLA + MLA_KM); const bf16_t* VM = (const bf16_t*)(ws + WS_MLA + MLA_VM);
    for (int h = 0; h < 6; ++h) {
        const size_t rq = ((size_t)(CB * 6 + h) * 2048 + t);
        chk_add(bf2f(QM[rq * 96 + e]), nq[(size_t)t * 576 + h * 96 + e] * scale, d2, r2);
        chk_add(bf2f(KM[rq * 96 + e]), nkv[(size_t)t * 768 + h * 128 + e], d2, r2);
        chk_add(bf2f(VM[rq * 64 + e]), nkv[(size_t)t * 768 + h * 128 + 64 + e], d2, r2);
        if (e < 32) { chk_add(bf2f(QM[rq * 96 + 64 + e]), nq[(size_t)t * 576 + h * 96 + 64 + e] * scale, d2, r2); chk_add(bf2f(KM[rq * 96 + 64 + e]), nkr[(size_t)t * 32 + e], d2, r2); }
    }
    if (t < 128) for (int hk = 0; hk < 2; ++hk) {
        const bf16_t* KC = (const bf16_t*)(ws + WS_CMP); const bf16_t* VC = (const bf16_t*)(ws + WS_CMP + CMP_V); const size_t rf = ((size_t)(CB * 2 + hk) * 128 + t) * 64 + e;
        chk_add(bf2f(KC[rf]), t < 127 ? nkc[(size_t)(hk * 127 + t) * 64 + e] : 0.f, d2c, r2c); chk_add(bf2f(VC[rf]), t < 127 ? nvc[(size_t)(hk * 127 + t) * 64 + e] : 0.f, d2c, r2c);
    }
    chk_commit(d2, r2, acc); chk_commit(d2c, r2c, acc + 2);
}

__global__ void __launch_bounds__(64) chk_y(const float* ny, const unsigned char* ws, float* acc, int nseg) {
    const int t = blockIdx.x, e = threadIdx.x; const bf16_t* Y = (const bf16_t*)(ws + WS_Y) + ((size_t)CB * 2048 + t) * 1024;
    float d2[3] = {0.f, 0.f, 0.f}, r2[3] = {0.f, 0.f, 0.f};
    for (int c = e; c < 1024; c += 64) { const int seg = c < 384 ? 0 : (c < 640 ? 1 : 2); const int cf = c < 384 ? c : (c < 640 ? 768 + (c - 384) : 384 + (c - 640)); const float f = bf2f(Y[cf]), r = ny[(size_t)t * 1024 + c];
        if (seg == 0) chk_add(f, r, d2[0], r2[0]); else if (seg == 1) chk_add(f, r, d2[1], r2[1]); else chk_add(f, r, d2[2], r2[2]); }
    if (nseg == 3) { chk_commit(d2[0], r2[0], acc); chk_commit(d2[1], r2[1], acc + 2); chk_commit(d2[2], r2[2], acc + 4); }
    else chk_commit(d2[0] + d2[1] + d2[2], r2[0] + r2[1] + r2[2], acc);
}

__global__ void __launch_bounds__(64) chk_x(const float* nx, const unsigned char* ws, float* acc) {
    const int t = blockIdx.x, e = threadIdx.x; const bf16_t* X = (const bf16_t*)(ws + WS_XB) + ((size_t)CB * 2048 + t) * 1024; float d2 = 0.f, r2 = 0.f;
    for (int c = e; c < 1024; c += 64) chk_add(bf2f(X[c]), nx[(size_t)t * 1024 + c], d2, r2);
    chk_commit(d2, r2, acc);
}

__global__ void __launch_bounds__(512) chk_code(float* acc, int nst, const float* nout) {
    __shared__ float sh[512];
    float s = 0.f; for (int i = threadIdx.x; i < 2048 * 1024; i += 512) { float v = nout[i]; s += v * v; }
    sh[threadIdx.x] = s; __syncthreads();
    if (threadIdx.x == 0) { float tot = 0.f; for (int i = 0; i < 512; ++i) tot += sh[i]; float rms = sqrtf(tot / (2048.f * 1024.f)); if (!(rms > 1e-3f && rms < 1e3f)) rms = 1.f;
        int code = 0;
        for (int st = 0; st < nst; ++st) { const float d2 = acc[2 * st], r2 = acc[2 * st + 1]; if (r2 == 0.f && d2 == 0.f) { if ((st & 15) >= 9) continue; code = (st + 1) * 4 + 3; break; } const float err = d2 / fmaxf(r2, 1e-30f);
            const float tol = CHK_TOL(st);
            if (!(err <= tol)) { const int cls = !(err < 1.f) ? 3 : (err >= 0.1f ? 2 : (err >= 0.01f ? 1 : 0)); code = (st + 1) * 4 + cls; break; } }
        acc[2 * 40] = rms * 32.f * exp2f(0.5f * (float)code); }
}
__global__ void __launch_bounds__(512) chk_fill(const float* acc, float* out) {
    const float K = acc[2 * 40];
    for (size_t i = (size_t)blockIdx.x * 512 + threadIdx.x; i < (size_t)NTOK * 1024; i += (size_t)gridDim.x * 512) out[i] = (i & 1) ? -K : K;
}
#endif

#if TIME_PH != -1
#ifndef TIME_Q
#define TIME_Q 6.f
#endif
#ifndef TIME_CAL
#define TIME_CAL 1.0f
#endif
__global__ void tm_acc(const unsigned long long* ts, float* best, int first) {
    int a = TIME_PH, b = TIME_PH + 1;
#ifdef TIME_PH_END
    b = TIME_PH_END;
#endif
    float T = 100.f; if (TIME_PH >= 0) T = (float)(ts[b] - ts[a]) * 0.01f;
    if (first || T < *best) *best = T;
}
__global__ void __launch_bounds__(512) tm_fill(const float* best, float* out) {
    float T = *best;
    T = exp2f(rintf(log2f(fmaxf(T, 1.f)) * TIME_Q) / TIME_Q);
    const float c = sqrtf(T) * TIME_CAL;
    for (size_t i = (size_t)blockIdx.x * 512 + threadIdx.x; i < (size_t)NTOK * 1024; i += (size_t)gridDim.x * 512) out[i] = (i & 1) ? -c : c;
}
#endif
static int g_grid = 0;
static bool setup_once(size_t ws_size) {
    if (g_grid) return g_grid > 0;
    if (ws_size < WS_END) { fprintf(stderr, "kernel_launch: workspace too small: %zu < %zu\n", ws_size, (size_t)WS_END); g_grid = -1; return false; }
    int dev = 0, cus = 0, per_cu = 0;
    if (hipGetDevice(&dev) != hipSuccess || hipDeviceGetAttribute(&cus, hipDeviceAttributeMultiprocessorCount, dev) != hipSuccess) { g_grid = -1; return false; }
    if (hipFuncSetAttribute((const void*)mk, hipFuncAttributeMaxDynamicSharedMemorySize, LDS_BYTES) != hipSuccess) { fprintf(stderr, "kernel_launch: hipFuncSetAttribute failed\n"); g_grid = -1; return false; }
    if (hipOccupancyMaxActiveBlocksPerMultiprocessor(&per_cu, (const void*)mk, 512, LDS_BYTES) != hipSuccess || per_cu < 1) { fprintf(stderr, "kernel_launch: occupancy query says %d\n", per_cu); }
    (void)hipGetLastError();
    g_grid = cus;
    return true;
}
static void launch_mk(const Args& a0, int lo, int hi, hipStream_t stream) { Args a = a0; a.ph_lo = lo; a.ph_hi = hi; hipLaunchKernelGGL(mk, dim3(g_grid), dim3(512), LDS_BYTES, stream, a); }

extern "C" void kernel_launch(void* const* d_in, const int* in_sizes, int n_in, void* d_out, int out_size, void* d_ws, size_t ws_size, hipStream_t stream) {
    if (!setup_once(ws_size)) return;
    unsigned char* ws = (unsigned char*)d_ws;
    (void)hipMemsetAsync(ws + WS_CTL, 0, ZERO_BYTES, stream);
    Args a{}; for (int i = 0; i < 30; ++i) a.in.p[i] = (const float*)d_in[i];
    a.out = (float*)d_out; a.ws = ws; a.ph_lo = 0; a.ph_hi = 0;
#if CHECK
    a.out = nullptr;
#endif
#if CHECK
    float* nb = (float*)d_out; size_t off = 0; NvScratch S;
    auto take = [&](size_t n) { float* p = nb + off; off += (n + 63) & ~(size_t)63; return p; };
    S.proj = take((size_t)2048 * DIN); S.h1 = take(2048 * 1024); S.qk = S.h1; S.hraw = S.qk + 2048 * 512; S.kn = S.hraw + 2048 * 256;
    S.kcmp = take(2 * 127 * 64); S.vcmp = take(2 * 127 * 64); S.dqn = take(2048 * 192); S.q = take(2048 * 576); S.dkvn = take(2048 * 128); S.kv = take(2048 * 768); S.x1 = S.dqn;
    S.krope = take(2048 * 32); S.y = take(2048 * 1024); S.xl = take(2048 * 1024); S.rt_e = (int*)take(2048 * 2); S.rt_w = take(2048 * 2);
    if (off * 4 > (size_t)NTOK * 1024 * 4) { fprintf(stderr, "naive scratch too big\n"); return; }
    float* acc = (float*)(ws + WS_CTL) + CW_CHK;
    launch_mk(a, 0, 1, stream);
    const float* nx_in = (const float*)d_in[0] + (size_t)CB * 2048 * 1024;
    int nst = 0;
    for (int l = 0; l < L_; ++l) {
        const int pb = 1 + l * NPH; const int sb = l * 16;
        launch_mk(a, pb + PH_INPROJ, pb + PH_INPROJ + 1, stream);
        naive_step(d_in, l, NS_INPROJ, nx_in, S.xl, S, stream);
        chk_proj<<<2048, 64, 0, stream>>>(S.proj, ws + WS_PRJ, (const float*)(ws + WS_SSQ + PT_DQ) + (size_t)l * 16384 * 4, (const float*)(ws + WS_SSQ + PT_DKV) + (size_t)l * 16384 * 2,
                                           (const float*)d_in[8] + l * 64, (const float*)d_in[9] + l * 64, (const float*)d_in[19] + l * 192 + 160, (const int*)d_in[1], acc + 2 * (sb + 0));
        nst = sb + 2;
        int ns_done = NS_INPROJ;
#if CHECK_UPTO >= 1
        launch_mk(a, pb + PH_PREP, pb + PH_PREP + 1, stream);
        naive_step(d_in, l, NS_NSAPREP, nx_in, S.xl, S, stream); naive_step(d_in, l, NS_MLAPREP, nx_in, S.xl, S, stream); ns_done = NS_MLAPREP;
        chk_prep<<<2048, 64, 0, stream>>>(S.q, S.kv, S.krope, S.kcmp, S.vcmp, ws, acc + 2 * (sb + 2));
        nst = sb + 4;
#endif
#if CHECK_UPTO >= 2
        launch_mk(a, pb + PH_MIX, pb + PH_MIX + 1, stream);
        naive_step(d_in, l, NS_NSA, nx_in, S.xl, S, stream); naive_step(d_in, l, NS_ML, nx_in, S.xl, S, stream); naive_step(d_in, l, NS_MLA, nx_in, S.xl, S, stream); ns_done = NS_MLA;
        chk_y<<<2048, 64, 0, stream>>>(S.y, ws, acc + 2 * (sb + 4), 3);
        nst = sb + 7;
#endif
#if CHECK_UPTO >= 3
        launch_mk(a, pb + PH_YNORM, pb + PH_YNORM + 1, stream); launch_mk(a, pb + PH_OUTPROJ, pb + PH_OUTPROJ + 1, stream);
        naive_step(d_in, l, NS_OUT, nx_in, S.xl, S, stream); ns_done = NS_OUT;
        chk_x<<<2048, 64, 0, stream>>>(S.x1, ws, acc + 2 * (sb + 7));
        nst = sb + 8;
#endif
#if CHECK_UPTO >= 4
        for (int ph = PH_ROUTE; ph <= PH_COMBINE; ++ph) launch_mk(a, pb + ph, pb + ph + 1, stream);
        naive_step(d_in, l, NS_ROUTE, nx_in, S.xl, S, stream); naive_step(d_in, l, NS_MOE, nx_in, S.xl, S, stream); ns_done = NS_MOE;
        chk_x<<<2048, 64, 0, stream>>>(S.xl, ws, acc + 2 * (sb + 8));
        nst = sb + 9;
#endif
        CHECK_REST
        for (int s = ns_done + 1; s <= NS_MOE; ++s) naive_step(d_in, l, s, nx_in, S.xl, S, stream);
        nx_in = S.xl;
        if (l == CHECK_LAYERS - 1) break;
    }
    chk_code<<<1, 512, 0, stream>>>(acc, nst, S.xl);
    chk_fill<<<1024, 512, 0, stream>>>(acc, (float*)d_out);
#else
#if defined(SPLIT_LAUNCH) && SPLIT_LAUNCH
    for (int ph = 0; ph < 1 + L_ * NPH; ++ph) launch_mk(a, ph, ph + 1, stream);
#else
    launch_mk(a, 0, 1 + L_ * NPH, stream);
#if TIME_PH != -1
    for (int rp = 0; rp < 6; ++rp) {
        (void)hipMemsetAsync(ws + WS_CTL, 0, ZERO_BYTES, stream); launch_mk(a, 0, 1 + L_ * NPH, stream);
        tm_acc<<<1, 1, 0, stream>>>((const unsigned long long*)((unsigned*)(ws + WS_CTL) + CW_TS), (float*)(ws + WS_META + META_RT), rp == 0);
    }
    tm_fill<<<1024, 512, 0, stream>>>((const float*)(ws + WS_META + META_RT), (float*)d_out);
#endif
#endif
#endif
}
```

```cpp
#define CHECK 0
#define CHECK_LAYERS 2
#define CHECK_UPTO 99
#define SPLIT_LAUNCH 0
#define REPEAT_PH -1
#include <hip/hip_runtime.h>
#include <stdint.h>
#include <cstdio>

constexpr int B_ = 8, T_ = 2048, D_ = 1024, L_ = 2, NTOK = B_ * T_;
constexpr int DIN = 2554;
constexpr int O_AQ = 0, O_AKV = 384, O_AG = 1152, O_BQK = 1170, O_BV = 1682, O_BIF = 1938, O_BO = 1946, O_CDQ = 2202, O_CDKV = 2394, O_CKR = 2522;

typedef unsigned short bf16_t;
typedef short bf16x8 __attribute__((ext_vector_type(8)));
typedef short s16x4 __attribute__((ext_vector_type(4)));
typedef float f32x4 __attribute__((ext_vector_type(4)));
typedef float f32x16 __attribute__((ext_vector_type(16)));
typedef unsigned u32x4 __attribute__((ext_vector_type(4)));
typedef unsigned u32x2 __attribute__((ext_vector_type(2)));
typedef float f32x2_t __attribute__((ext_vector_type(2)));
typedef __bf16 bf16x2_t __attribute__((ext_vector_type(2)));
#define LAS __attribute__((address_space(3)))

__device__ __forceinline__ unsigned pk_bf16(float lo, float hi) { f32x2_t v = {lo, hi}; bf16x2_t b = __builtin_convertvector(v, bf16x2_t); return __builtin_bit_cast(unsigned, b); }
__device__ __forceinline__ float bf_lo(unsigned u) { return __builtin_bit_cast(float, u << 16); }
__device__ __forceinline__ float bf_hi(unsigned u) { return __builtin_bit_cast(float, u & 0xffff0000u); }
__device__ __forceinline__ float bf2f(bf16_t h) { return __builtin_bit_cast(float, (unsigned)h << 16); }
__device__ __forceinline__ bf16_t f2bf(float f) { return (bf16_t)(pk_bf16(f, 0.f) & 0xffffu); }
template <int M> __device__ __forceinline__ int shx(int v) { static_assert(M > 0 && M < 32, "swizzle xor mask"); return __builtin_amdgcn_ds_swizzle(v, (M << 10) | 0x1f); }
template <int M> __device__ __forceinline__ float shx(float v) { return __builtin_bit_cast(float, shx<M>(__builtin_bit_cast(int, v))); }
template <int M> __device__ __forceinline__ unsigned shx(unsigned v) { return (unsigned)shx<M>((int)v); }
__device__ __forceinline__ float wave_sum(float v) { v += __shfl_xor(v, 32); v += shx<16>(v); v += shx<8>(v); v += shx<4>(v); v += shx<2>(v); v += shx<1>(v); return v; }
__device__ __forceinline__ float wave_max(float v) { v = fmaxf(v, __shfl_xor(v, 32)); v = fmaxf(v, shx<16>(v)); v = fmaxf(v, shx<8>(v)); v = fmaxf(v, shx<4>(v)); v = fmaxf(v, shx<2>(v)); v = fmaxf(v, shx<1>(v)); return v; }
__device__ __forceinline__ float siluf(float x) { return x * __builtin_amdgcn_rcpf(1.f + __expf(-x)); }
__device__ __forceinline__ float sigmf(float x) { return __builtin_amdgcn_rcpf(1.f + __expf(-x)); }
__device__ __forceinline__ int t5b(int dist) {
    int n = dist > 0 ? dist : 0; if (n < 16) return n;
    float v = logf((float)n / 16.f) / logf(8.f) * 16.f; int l = 16 + (int)v; return l < 31 ? l : 31;
}

__device__ __forceinline__ int lane_now() { return (int)__builtin_amdgcn_mbcnt_hi(~0u, __builtin_amdgcn_mbcnt_lo(~0u, 0u)); }
#define TIDX ((g_wv << 6) | lane_now())

constexpr size_t WS_CTL = 0, CTL_BYTES = 65536;
constexpr size_t WS_SSQ = WS_CTL + CTL_BYTES;
constexpr size_t ZERO_BYTES = CTL_BYTES;
constexpr size_t PT_DQ = 0, PT_DKV = PT_DQ + (size_t)2 * 16384 * 4 * 4, PT_A = PT_DKV + (size_t)2 * 16384 * 2 * 4, PT_C = PT_A + (size_t)2 * 16384 * 8 * 4, PT_X1 = PT_C + (size_t)2 * 16384 * 8 * 4, PT_END = PT_X1 + (size_t)2 * 16384 * 16 * 4;
constexpr size_t WS_SSQX = WS_SSQ + PT_END;
constexpr size_t WS_RS2 = WS_SSQX + 2 * 65536;
constexpr size_t WS_WIN = WS_RS2 + 65536;
constexpr size_t WS_WOUT = WS_WIN + (size_t)2 * 2560 * 1024 * 2;
constexpr size_t WS_WUQ = WS_WOUT + (size_t)2 * 1024 * 1024 * 2;
constexpr size_t WS_WUKV = WS_WUQ + (size_t)2 * 768 * 256 * 2;
constexpr size_t WS_WC1 = WS_WUKV + (size_t)2 * 768 * 256 * 2;
constexpr size_t WS_WC2 = WS_WC1 + (size_t)2 * 2 * 64 * 2048 * 2;
constexpr size_t WS_WR = WS_WC2 + (size_t)2 * 2 * 64 * 64 * 2;
constexpr size_t WS_B1C = WS_WR + (size_t)2 * 64 * 1024 * 2;
constexpr size_t WS_BIASD = WS_B1C + 1024;
constexpr size_t WS_ROPE = WS_BIASD + 6 * 2048 * 4;
constexpr size_t WS_WMOE = WS_ROPE + (size_t)16384 * 32 * 4;
constexpr size_t WMOE_WD = (size_t)32 * 512 * 1024 * 2;
constexpr size_t WS_XB = WS_WMOE + 50331648;
constexpr size_t WS_MLA = WS_XB + 33554432;
constexpr size_t MLA_KM = (size_t)8 * 6 * 2048 * 96 * 2, MLA_VM = 2 * MLA_KM;
constexpr size_t WS_HBUF = WS_MLA;
constexpr size_t WS_PRJ = WS_MLA + 50331648;
constexpr size_t HM64 = (size_t)2048 * 64 * 2;
constexpr size_t PRJ_QN = 0;
constexpr size_t PRJ_KN1 = PRJ_QN + 48 * HM64, PRJ_VN1 = PRJ_KN1 + 16 * HM64, PRJ_KN2 = PRJ_VN1 + 16 * HM64, PRJ_VN2 = PRJ_KN2 + 16 * HM64;
constexpr size_t PRJ_VML = PRJ_VN2 + 16 * HM64;
constexpr size_t PRJ_OG = PRJ_VML + 32 * HM64;
constexpr size_t PRJ_KR = PRJ_OG + (size_t)16384 * 256 * 2;
constexpr size_t PRJ_GATES = PRJ_KR + (size_t)16384 * 32 * 2;
constexpr size_t PRJ_DEAD = PRJ_GATES + (size_t)16384 * 32 * 4;
constexpr size_t PRJ_C0K = PRJ_DEAD, PRJ_C0V = PRJ_C0K + 16 * HM64 + 8192;
constexpr size_t PRJ_RAWQK = PRJ_C0V + 16 * HM64 + 8192;
constexpr size_t PRJ_DQKV = PRJ_RAWQK + (size_t)16384 * 512 * 2;
constexpr size_t PRJ_END = PRJ_DQKV + (size_t)16384 * 384 * 2;
static_assert(PRJ_END - PRJ_DEAD >= 33554432, "Y fits the dead part of PRJ");
constexpr size_t WS_Y = WS_PRJ + PRJ_DEAD;
constexpr size_t WS_YBUF = WS_PRJ;
static_assert((size_t)2 * 16384 * 1024 * 2 <= PRJ_END, "YBUF fits the PRJ region");
constexpr size_t WS_ML = WS_PRJ + PRJ_END;
constexpr size_t ML_KC = 32 * HM64, ML_DELTA = 2 * ML_KC, ML_DN = ML_DELTA + (size_t)1024 * 4096 * 2, ML_G = ML_DN + (size_t)1024 * 64 * 4, ML_BL = ML_G + (size_t)8 * 4 * 2048 * 2 * 4, ML_CP = ML_BL + 4096, ML_NP = ML_CP + (size_t)1024 * 4096 * 2, ML_END = ML_NP + (size_t)1024 * 64 * 2;
constexpr size_t WS_CMP = WS_ML + ML_END;
constexpr size_t CMP_V = (size_t)8 * 2 * 128 * 64 * 2;
constexpr size_t WS_META = WS_CMP + 2 * CMP_V;
constexpr size_t META_W = (size_t)32 * 16384 * 4, META_RT = 2 * META_W;
constexpr size_t WS_END = WS_META + META_RT + (size_t)16384 * 16;
constexpr int CW_BAR = 0;
constexpr int CW_Q = 4096;
constexpr int CW_SCAN = 4608;
constexpr int CW_TS = 4864;
constexpr int CW_CHK = 5120;
constexpr int CW_CNT = 8192;
constexpr int LDS_BYTES = 147456;
constexpr int LDS_MISC = LDS_BYTES - 256;
#define XB_TMO      128
#define XB_XCNT(j)  (256  + 64 * (j))
#define XB_XSUB(j)  (1280 + 64 * (j))
#define XB_XGEN(j)  (2304 + 64 * (j))
#define XB_TOP      3328
#define XB_TOPGEN   3392
#define XCD_BAR_WORDS 3456
#define XB_SPIN_CAP (1u << 18)

__device__ __forceinline__ unsigned xb_ld(unsigned* p)              { return __hip_atomic_load(p, __ATOMIC_RELAXED, __HIP_MEMORY_SCOPE_AGENT); }
__device__ __forceinline__ unsigned xb_add(unsigned* p, unsigned v) { return __hip_atomic_fetch_add(p, v, __ATOMIC_RELAXED, __HIP_MEMORY_SCOPE_AGENT); }
__device__ __forceinline__ unsigned xb_xcc_id() { return (unsigned)__builtin_amdgcn_s_getreg((3 << 11) | 20) & 0xFu; }
#define XB_SPIN(cond, bar) do { unsigned _sp = 0; while (cond) { __builtin_amdgcn_s_sleep(1); \
    if ((++_sp & 255u) == 0u) { if (xb_ld(&(bar)[XB_TMO])) break; if (_sp > XB_SPIN_CAP) { atomicAdd(&(bar)[XB_TMO], 1u); break; } } } } while (0)

struct XcdBarrier {
    int g_wv; unsigned* bar; unsigned x;
    volatile LAS unsigned* st;
};

__device__ __forceinline__ XcdBarrier xcd_barrier_post(unsigned* bar, volatile LAS unsigned* st, int g_wv) {
    XcdBarrier b; b.g_wv = g_wv; b.bar = bar; b.x = xb_xcc_id(); b.st = st;
    if (TIDX == 0) (void)xb_add(&bar[XB_XCNT(b.x)], 1u);
    return b;
}
__device__ __forceinline__ void xcd_barrier_complete(unsigned* bar, unsigned x, unsigned& nloc, unsigned& nx) {
    const unsigned G = gridDim.x * gridDim.y * gridDim.z;
    unsigned sum, cnt, mine, sp = 0u;
    for (;;) {
        sum = 0u; cnt = 0u; mine = 0u;
#pragma unroll
        for (unsigned j = 0; j < 16; ++j) { const unsigned c = xb_ld(&bar[XB_XCNT(j)]); sum += c; cnt += (c > 0u) ? 1u : 0u; mine = (j == x) ? c : mine; }
        if (sum == G) break;
        __builtin_amdgcn_s_sleep(1);
        if ((++sp & 255u) == 0u) { if (xb_ld(&bar[XB_TMO])) break; if (sp > XB_SPIN_CAP) { atomicAdd(&bar[XB_TMO], 1u); break; } }
    }
    nloc = mine > 0u ? mine : 1u; nx = cnt > 0u ? cnt : 1u;
}

__device__ __forceinline__ void xcd_barrier(const XcdBarrier& b) {
    asm volatile("s_waitcnt vmcnt(0)" ::: "memory");
    __syncthreads();
    const int g_wv = b.g_wv;
    if (TIDX == 0) {
        unsigned* bar = b.bar;
        __builtin_amdgcn_s_waitcnt(0);
        unsigned nloc = b.st[0], nx = b.st[1];
        if (nloc == 0u) { xcd_barrier_complete(bar, b.x, nloc, nx); b.st[0] = nloc; b.st[1] = nx; }
        const unsigned old = xb_add(&bar[XB_XSUB(b.x)], 1u);
        const unsigned gen = old / nloc;
        if (old + 1u == (gen + 1u) * nloc) {
            __builtin_amdgcn_fence(__ATOMIC_RELEASE, "agent");
            asm volatile("s_waitcnt vmcnt(0)" ::: "memory");
            const unsigned og = xb_add(&bar[XB_TOP], 1u);
            const unsigned tg = og / nx;
            if (og + 1u == (tg + 1u) * nx) xb_add(&bar[XB_TOPGEN], 1u);
            else XB_SPIN(xb_ld(&bar[XB_TOPGEN]) == tg, bar);
            __builtin_amdgcn_fence(__ATOMIC_ACQUIRE, "agent");
            xb_add(&bar[XB_XGEN(b.x)], 1u);
            asm volatile("s_waitcnt vmcnt(0)" ::: "memory");
        } else {
            XB_SPIN(xb_ld(&bar[XB_XGEN(b.x)]) == gen, bar);
            __builtin_amdgcn_fence(__ATOMIC_ACQUIRE, "agent");
            asm volatile("s_waitcnt vmcnt(0)" ::: "memory");
        }
    }
    __syncthreads();
}
struct Inputs { const float* p[30]; };
typedef const __attribute__((address_space(4))) Inputs* InPtr;
__device__ __forceinline__ InPtr in_tab() { InPtr p = (InPtr)__builtin_amdgcn_kernarg_segment_ptr(); asm volatile("" : "+s"(p)); return p; }
__device__ __forceinline__ unsigned char* launder(unsigned char* p) { size_t z = 0; asm volatile("" : "+s"(z)); return p + z; }

__host__ __device__ inline int inproj_refcol(int G, int e) {
    if (G < 6) return O_AQ + G * 64 + e;
    if (G < 18) return O_AKV + (G - 6) * 64 + e;
    if (G < 26) return O_BQK + (G - 18) * 64 + e;
    if (G < 30) return O_BV + (G - 26) * 64 + e;
    if (G < 34) return O_BO + (G - 30) * 64 + e;
    if (G < 37) return O_CDQ + (G - 34) * 64 + e;
    if (G == 37) { if (e < 32) return O_CKR + e; if (e < 50) return O_AG + (e - 32); if (e < 58) return O_BIF + (e - 50); return -1; }
    return O_CDKV + (G - 38) * 64 + e;
}
__host__ __device__ inline int uq_refcol(int G, int e) {
    if (G < 6) return G * 96 + e;
    if (G < 9) { const int idx = e & 31, bj = e >> 5, sub = idx >> 4, i = idx & 15; return (2 * (G - 6) + sub) * 96 + 64 + bj * 16 + i; }
    return -1;
}
__host__ __device__ inline int ukv_refcol(int G, int e) { return G < 6 ? G * 128 + e : (G - 6) * 128 + 64 + e; }
#define N2G(n) ((((n) >> 8) << 2) + (((n) >> 5) & 3))
#define N2E(n) (((((n) >> 7) & 1) << 5) + ((n) & 31))

__device__ __forceinline__ float opaque_f(float v) { asm volatile("" : "+v"(v)); return v; }
struct FWin { const float* w; const float* g; __device__ __forceinline__ void ld(int k, int n, const float*& p, float& gn, float gk) const { const int c = inproj_refcol(N2G(n), N2E(n)); p = w + (size_t)k * DIN + (c < 0 ? 0 : c); gn = c < 0 ? 0.f : gk; }
    __device__ __forceinline__ float rowgain(int k) const { return opaque_f(g[k]); } };
struct FWout { const float* w; const float* ga; const float* gc; __device__ __forceinline__ void ld(int k, int n, const float*& p, float& gn, float gk) const {
    const int kr = k < 384 ? k : (k < 768 ? 640 + (k - 384) : 384 + (k - 768)); p = w + (size_t)kr * 1024 + n; gn = gk; }
    __device__ __forceinline__ float rowgain(int k) const { const float a = opaque_f(ga[k < 384 ? k : 0]), c = opaque_f(gc[(k >= 384 && k < 768) ? k - 384 : 0]); return k < 384 ? a : (k < 768 ? c : 1.f); } };
struct FWuq { const float* w; const float* g; __device__ __forceinline__ void ld(int k, int n, const float*& p, float& gn, float gk) const { const int c = uq_refcol(N2G(n), N2E(n)); const int kk = k < 192 ? k : 191; p = w + (size_t)kk * 576 + (c < 0 ? 0 : c); gn = (k < 192 && c >= 0) ? gk : 0.f; }
    __device__ __forceinline__ float rowgain(int k) const { return opaque_f(g[k < 192 ? k : 191]); } };
struct FWukv { const float* w; const float* g; __device__ __forceinline__ void ld(int k, int n, const float*& p, float& gn, float gk) const { const int c = ukv_refcol(N2G(n), N2E(n)); const int kk = k >= 128 ? k - 128 : 0; p = w + (size_t)kk * 768 + c; gn = k >= 128 ? gk : 0.f; }
    __device__ __forceinline__ float rowgain(int k) const { return opaque_f(g[k >= 128 ? k - 128 : 0]); } };
struct FWc1 { const float* w; __device__ __forceinline__ void ld(int k, int n, const float*& p, float& gn, float gk) const { p = w + (size_t)k * 64 + n; gn = 1.f; }
    __device__ __forceinline__ float rowgain(int k) const { return 1.f; } };
struct FWr { const float* wg; const float* we; const float* g; __device__ __forceinline__ void ld(int k, int n, const float*& p, float& gn, float gk) const { p = n < 4 ? wg + k * 4 + n : we + k * 32 + (n < 36 ? n - 4 : 0); gn = n < 36 ? gk : 0.f; }
    __device__ __forceinline__ float rowgain(int k) const { return opaque_f(g[k]); } };
struct FWgu { const float* src; const float* g; int n0, col0; __device__ __forceinline__ float operator()(int k, int n) const { return src[(size_t)k * 256 + col0 + (n - n0)] * g[k]; } };
struct FWd { const float* w; __device__ __forceinline__ float operator()(int k, int n) const { return w[(size_t)k * 1024 + n]; } };

__device__ __forceinline__ void rope_cs(int pos, int j, float& cs, float& sn) {
    const double inv = exp2(-(double)j * (13.287712379549449 / 16.0));
    const double rev = (double)pos * inv * 0.15915494309189535; const float f = (float)(rev - rint(rev));
    cs = __builtin_amdgcn_cosf(f); sn = __builtin_amdgcn_sinf(f);
}
template <class F>
__device__ __forceinline__ void cvt_tile(const F& f, int n0, int k0, bf16_t* dst, int ldk, LAS float* tile, int tid) {
    { const int k = tid >> 3, nb = (tid & 7) * 8; const float gk = f.rowgain(k0 + k); const float* p[8]; float gn[8], v[8];
#pragma unroll
      for (int j = 0; j < 8; ++j) f.ld(k0 + k, n0 + nb + j, p[j], gn[j], gk);
#pragma unroll
      for (int j = 0; j < 8; ++j) v[j] = *p[j];
#pragma unroll
      for (int j = 0; j < 8; ++j) tile[k * 65 + nb + j] = v[j] * gn[j]; }
    __syncthreads();
    { const int n = tid >> 3, kb = (tid & 7) * 8; const LAS float* s = tile + kb * 65 + n;
      u32x4 o; o.x = pk_bf16(s[0], s[65]); o.y = pk_bf16(s[130], s[195]); o.z = pk_bf16(s[260], s[325]); o.w = pk_bf16(s[390], s[455]);
      *(u32x4*)(dst + (size_t)(n0 + n) * ldk + k0 + kb) = o; }
    __syncthreads();
}
template <class F>
__device__ __forceinline__ void cvt_item(const F& f, int it, int nK, bf16_t* dst, int ldk, LAS float* tile, int tid) { cvt_tile(f, (it / nK) * 64, (it % nK) * 64, dst, ldk, tile, tid); }

__device__ __forceinline__ void moe_item(InPtr in, int l, int it, const float*& src, int& ld, size_t& dst, int& ldk, bool& gain, int& kk0) {
    if (it < 32 * 64) { const int e = it >> 6, r = it & 63, n0 = (r >> 3) * 64, k0 = (r & 7) * 128, c0 = n0 & 255;
        src = (c0 < 128 ? in->p[27] : in->p[28]) + ((size_t)l * 32 + e) * 262144 + (size_t)k0 * 256 + (n0 >> 8) * 128 + (c0 & 127); ld = 256; gain = true; kk0 = k0;
        dst = ((size_t)e * 512 + n0) * 1024 + k0; ldk = 1024; }
    else { const int j = it - 32 * 64, e = j >> 5, r = j & 31, n0 = (r >> 1) * 64, k0 = (r & 1) * 128;
        src = in->p[29] + ((size_t)l * 32 + e) * 262144 + (size_t)k0 * 1024 + n0; ld = 1024; gain = false; kk0 = 0;
        dst = (size_t)16777216 + ((size_t)e * 1024 + n0) * 256 + k0; ldk = 256; }
}
__device__ __forceinline__ void cvt_moe_layer(InPtr in, unsigned char* ws, int l, LAS float* tile, int bid, int nb, int tid, int it_lo = 0, int it_hi = 32 * (64 + 32)) {
    asm volatile("" : "+v"(tid));
    const float* g2 = in->p[22] + l * 1024; bf16_t* W = (bf16_t*)(ws + WS_WMOE);
    const int k = tid >> 3, nbq = (tid & 7) * 8;
    const int n = tid >> 3, kb = (tid & 7) * 8;
    const int NIT = it_hi;
#define CVM_LOAD(it_, P) do { const float* src_; int ld_, ldk_, kk0_; size_t dst_; bool gain_; moe_item(in, l, (it_), src_, ld_, dst_, ldk_, gain_, kk0_); \
        P##a = *(const f32x4*)(src_ + (size_t)k * ld_ + nbq); P##b = *(const f32x4*)(src_ + (size_t)k * ld_ + nbq + 4); P##c = *(const f32x4*)(src_ + (size_t)(k + 64) * ld_ + nbq); P##d = *(const f32x4*)(src_ + (size_t)(k + 64) * ld_ + nbq + 4); \
        P##g0 = gain_ ? g2[kk0_ + k] : 1.f; P##g1 = gain_ ? g2[kk0_ + 64 + k] : 1.f; } while (0)
#define CVM_PUT(t, P) do { \
        t[k * 65 + nbq + 0] = P##a.x * P##g0; t[k * 65 + nbq + 1] = P##a.y * P##g0; t[k * 65 + nbq + 2] = P##a.z * P##g0; t[k * 65 + nbq + 3] = P##a.w * P##g0; \
        t[k * 65 + nbq + 4] = P##b.x * P##g0; t[k * 65 + nbq + 5] = P##b.y * P##g0; t[k * 65 + nbq + 6] = P##b.z * P##g0; t[k * 65 + nbq + 7] = P##b.w * P##g0; \
        t[(k + 64) * 65 + nbq + 0] = P##c.x * P##g1; t[(k + 64) * 65 + nbq + 1] = P##c.y * P##g1; t[(k + 64) * 65 + nbq + 2] = P##c.z * P##g1; t[(k + 64) * 65 + nbq + 3] = P##c.w * P##g1; \
        t[(k + 64) * 65 + nbq + 4] = P##d.x * P##g1; t[(k + 64) * 65 + nbq + 5] = P##d.y * P##g1; t[(k + 64) * 65 + nbq + 6] = P##d.z * P##g1; t[(k + 64) * 65 + nbq + 7] = P##d.w * P##g1; } while (0)
#define CVM_STORE(it_, t) do { const float* src_; int ld_, ldk_, kk0_; size_t dst_; bool gain_; moe_item(in, l, (it_), src_, ld_, dst_, ldk_, gain_, kk0_); \
        _Pragma("unroll") for (int hh = 0; hh < 2; ++hh) { const LAS float* s_ = t + (64 * hh + kb) * 65 + n; \
            u32x4 o; o.x = pk_bf16(s_[0], s_[65]); o.y = pk_bf16(s_[130], s_[195]); o.z = pk_bf16(s_[260], s_[325]); o.w = pk_bf16(s_[390], s_[455]); \
            *(u32x4*)(W + dst_ + (size_t)n * ldk_ + 64 * hh + kb) = o; } } while (0)
    f32x4 Aa, Ab, Ac, Ad, Ba, Bb, Bc, Bd; float Ag0 = 1.f, Ag1 = 1.f, Bg0 = 1.f, Bg1 = 1.f;
    LAS float* t0 = tile; LAS float* t1 = tile + 128 * 65;
    int it = it_lo + bid;
    if (it < NIT) CVM_LOAD(it, A);
    if (it + nb < NIT) CVM_LOAD(it + nb, B);
#pragma unroll 1
    for (; it < NIT; it += 2 * nb) {
        CVM_PUT(t0, A);
        __syncthreads();
        if (it + 2 * nb < NIT) CVM_LOAD(it + 2 * nb, A);
        CVM_STORE(it, t0);
        if (it + nb < NIT) {
            CVM_PUT(t1, B);
            __syncthreads();
            if (it + 3 * nb < NIT) CVM_LOAD(it + 3 * nb, B);
            CVM_STORE(it + nb, t1);
        }
    }
#undef CVM_LOAD
#undef CVM_PUT
#undef CVM_STORE
    __syncthreads();
}

__device__ __forceinline__ void cvt_small_weights(InPtr in, unsigned char* ws, int l, LAS float* tile, int bid, int nb, int tid) {
    asm volatile("" : "+v"(tid));
    constexpr int I_WIN = 40 * 16, I_WOUT = 16 * 16, I_WU = 12 * 4, I_WC1 = 32, I_WC2 = 1, I_WR = 16;
    constexpr int PER_L = I_WIN + I_WOUT + 2 * I_WU + 2 * I_WC1 + 2 * I_WC2 + I_WR;
    for (int it0 = bid; it0 < PER_L; it0 += nb) {
        int it = it0;
        if (it < I_WIN) { FWin f{in->p[4] + (size_t)l * 1024 * DIN, in->p[3] + l * 1024}; cvt_item(f, it, 16, (bf16_t*)(ws + WS_WIN) + (size_t)l * 2560 * 1024, 1024, tile, tid); continue; } it -= I_WIN;
        if (it < I_WOUT) { FWout f{in->p[21] + (size_t)l * 1048576, in->p[10] + l * 384, in->p[20] + l * 384}; cvt_item(f, it, 16, (bf16_t*)(ws + WS_WOUT) + (size_t)l * 1048576, 1024, tile, tid); continue; } it -= I_WOUT;
        if (it < I_WU) { FWuq f{in->p[16] + (size_t)l * 192 * 576, in->p[15] + l * 192}; cvt_item(f, it, 4, (bf16_t*)(ws + WS_WUQ) + (size_t)l * 768 * 256, 256, tile, tid); continue; } it -= I_WU;
        if (it < I_WU) { FWukv f{in->p[18] + (size_t)l * 128 * 768, in->p[17] + l * 128}; cvt_item(f, it, 4, (bf16_t*)(ws + WS_WUKV) + (size_t)l * 768 * 256, 256, tile, tid); continue; } it -= I_WU;
        if (it < 2 * I_WC1) { const int s = it / I_WC1; FWc1 f{in->p[6] + ((size_t)l * 2 + s) * 2048 * 64}; cvt_item(f, it % I_WC1, 32, (bf16_t*)(ws + WS_WC1) + ((size_t)l * 2 + s) * 64 * 2048, 2048, tile, tid); continue; } it -= 2 * I_WC1;
        if (it < 2 * I_WC2) { const int s = it; FWc1 f{in->p[7] + ((size_t)l * 2 + s) * 64 * 64}; cvt_item(f, 0, 1, (bf16_t*)(ws + WS_WC2) + ((size_t)l * 2 + s) * 64 * 64, 64, tile, tid); continue; } it -= 2 * I_WC2;
        { FWr f{in->p[23] + (size_t)l * 4096, in->p[25] + (size_t)l * 32768, in->p[22] + l * 1024}; cvt_item(f, it, 16, (bf16_t*)(ws + WS_WR) + (size_t)l * 64 * 1024, 1024, tile, tid); }
    }
}

__device__ __forceinline__ void prologue(InPtr in, unsigned char* ws, LAS unsigned char* lds, int bid, int nb, int g_wv) {
    int tid_ = TIDX; asm volatile("" : "+v"(tid_));
    const int tid = tid_, lane = tid & 63, wid = tid >> 6;
    LAS float* tile = (LAS float*)lds;
    cvt_small_weights(in, ws, 0, tile, bid, nb, tid);
    { const float* x = in->p[0]; bf16_t* XB = (bf16_t*)(ws + WS_XB); float* ssqx = (float*)(ws + WS_SSQX);
      for (int r0 = (bid * 8 + wid) * 2; r0 < NTOK; r0 += nb * 16) {
          f32x4 v[2][4];
#pragma unroll
          for (int rr = 0; rr < 2; ++rr)
#pragma unroll
              for (int j = 0; j < 4; ++j) v[rr][j] = *((const f32x4*)(x + (size_t)(r0 + rr) * 1024) + lane + 64 * j);
#pragma unroll
          for (int rr = 0; rr < 2; ++rr) { float s = 0.f; u32x2* o = (u32x2*)(XB + (size_t)(r0 + rr) * 1024) + lane;
#pragma unroll
              for (int j = 0; j < 4; ++j) { const f32x4 q = v[rr][j]; s += (q.x * q.x + q.y * q.y) + (q.z * q.z + q.w * q.w); u32x2 w; w.x = pk_bf16(q.x, q.y); w.y = pk_bf16(q.z, q.w); o[64 * j] = w; }
              s = wave_sum(s); if (lane == 0) ssqx[r0 + rr] = s; }
      } }
    { float* biasd = (float*)(ws + WS_BIASD); const float* rb = in->p[2];
      for (int i = bid * 512 + tid; i < 6 * 2048; i += nb * 512) { const int h = i >> 11, d = i & 2047; biasd[i] = rb[t5b(d) * 6 + h] * 1.44269504f; } }
    { float* rope = (float*)(ws + WS_ROPE); const int* pos = (const int*)in->p[1];
      for (int i = bid * 512 + tid; i < NTOK * 16; i += nb * 512) { const int tk = i >> 4, j = i & 15; float cs, sn; rope_cs(pos[tk], j, cs, sn); rope[(size_t)tk * 32 + j] = cs; rope[(size_t)tk * 32 + 16 + j] = sn; } }
    { float* b1c = (float*)(ws + WS_B1C); LAS float* red = (LAS float*)lds;
      for (int it = nb - 1 - bid; it >= 0 && it < 4; it += nb) { const float* pe = in->p[5] + (size_t)it * 2048; const float* w1 = in->p[6] + (size_t)it * 2048 * 64; const int f4 = tid & 15, kp = tid >> 4;
          f32x4 a = (f32x4){0.f, 0.f, 0.f, 0.f};
#pragma unroll 1
          for (int k0 = kp * 64; k0 < kp * 64 + 64; k0 += 16) { f32x4 wv[16]; float pv[16];
#pragma unroll
              for (int j = 0; j < 16; ++j) { wv[j] = *(const f32x4*)(w1 + (size_t)(k0 + j) * 64 + 4 * f4); pv[j] = pe[k0 + j]; }
#pragma unroll
              for (int j = 0; j < 16; ++j) { a.x += pv[j] * wv[j].x; a.y += pv[j] * wv[j].y; a.z += pv[j] * wv[j].z; a.w += pv[j] * wv[j].w; } }
          __syncthreads(); *(LAS f32x4*)(red + kp * 64 + 4 * f4) = a; __syncthreads();
          if (tid < 64) { float sum = 0.f; for (int p2 = 0; p2 < 32; ++p2) sum += red[p2 * 64 + tid]; b1c[it * 64 + tid] = sum; }
          __syncthreads(); } }
}
namespace g8 {
constexpr int BM = 256, BK = 64, HALF = 128, HTB = HALF * BK * 2, STAGE_BYTES = 8 * HTB, NXCD = 8, WGM = 8;
__host__ __device__ __forceinline__ int lds_byte(int r, int c) { const int st = (r >> 4) * 2 + (c >> 5), rr = r & 15, cc = c & 31, ob = rr * 64 + cc * 2; return st * 1024 + (ob ^ (((ob >> 9) & 1) << 5)); }
__host__ __device__ __forceinline__ void stage_rc(int b, int& R, int& C) { const int st = b / 1024, sb = b % 1024, swz = sb ^ (((sb >> 9) & 1) << 5); R = (st >> 1) * 16 + swz / 64; C = (st & 1) * 32 + (swz % 64) / 2; }
__host__ __device__ __forceinline__ int perm32(int rho) { const int n = rho >> 4, i = rho & 15; return 8 * (i >> 2) + 4 * n + (i & 3); }

struct GUnit { const char* a; const char* b; int pm, pn, e, rows; };

__device__ __forceinline__ bool static_unit(int i, int G, int c, int nM, int nN, int& pm, int& pn) {
    const int nwg = nM * nN; const long L = (long)i * G + c; if (L >= nwg) return false;
    int wgid = (int)L; { const int q = nwg / NXCD, r = nwg % NXCD, xcd = wgid % NXCD, off = wgid / NXCD; wgid = (xcd < r ? xcd * (q + 1) : r * (q + 1) + (xcd - r) * q) + off; }
    const int nig = WGM * nN, gid = wgid / nig, fm = gid * WGM, gsz = (nM - fm) < WGM ? (nM - fm) : WGM;
    pm = fm + ((wgid % nig) % gsz); pn = (wgid % nig) / gsz; return true;
}
struct DenseSched {
    static constexpr bool GATHER = false, PARTIAL = false;
    const char* A; const char* Bt; int lda, ldb, nM, nN, G, c;
    __device__ __forceinline__ bool next(int i, GUnit& u) const {
        int pm, pn; if (!static_unit(i, G, c, nM, nN, pm, pn)) return false;
        u.pm = pm; u.pn = pn; u.e = 0; u.rows = 256; u.a = A + (size_t)pm * 256 * lda * 2; u.b = Bt + (size_t)pn * 256 * ldb * 2; return true;
    }
    __device__ __forceinline__ void aoff(const GUnit&, unsigned (&v)[2][2], const int (&R)[2], const int (&C)[2]) const {
#pragma unroll
        for (int h = 0; h < 2; ++h)
#pragma unroll
            for (int i = 0; i < 2; ++i) v[h][i] = (unsigned)((h * 128 + R[i]) * lda + C[i]) * 2u;
    }
};

template <class Epi, class Sched>
__device__ __forceinline__ void gemm_run(LAS unsigned char* lds, const int K, const int ldb, const Sched& S, const Epi& E, int g_wv) {
    int tid_ = TIDX; asm volatile("" : "+v"(tid_));
    const int tid = tid_, wid = __builtin_amdgcn_readfirstlane(tid >> 6), lane = tid & 63, wr = wid >> 2, wc = wid & 3, fr = lane & 15, fq = lane >> 4;
    int nt_ = K / BK; asm volatile("" : "+s"(nt_));
    const int nt = nt_;
    int R[2], C[2]; unsigned voffB[2];
#pragma unroll
    for (int i = 0; i < 2; ++i) { stage_rc(tid * 16 + i * 8192, R[i], C[i]); const int Rb = (R[i] & ~31) + perm32(R[i] & 31); voffB[i] = (unsigned)(Rb * ldb + C[i]) * 2u; }
    const size_t kstep = (size_t)(BK * 2);
    const size_t hstepB = (size_t)HALF * ldb * 2;
    const unsigned ldsw = (unsigned)wid * 1024u;
    const int aoff = lds_byte(wr * 64 + fr, fq * 8), boff = lds_byte(wc * 32 + fr, fq * 8);
#define G8_SA(b, h) (((b) * 2 + (h)) * HTB)
#define G8_SB(b, h) ((4 + (b) * 2 + (h)) * HTB)
#define G8_GLDS(bufoff, gptr, i_) __builtin_amdgcn_global_load_lds((const unsigned*)(gptr), (LAS unsigned*)(lds + (bufoff) + ldsw + (i_) * 8192), 16, 0, 0)
#define G8_STAGE_B(bufoff, gbase) do { G8_GLDS(bufoff, (const char*)(gbase) + voffB[0], 0); G8_GLDS(bufoff, (const char*)(gbase) + voffB[1], 1); } while (0)
#define G8_STAGE_A(bufoff, gbase, v0, v1) do { G8_GLDS(bufoff, (const char*)(gbase) + (v0), 0); G8_GLDS(bufoff, (const char*)(gbase) + (v1), 1); } while (0)
#define G8_LDA(dst, b, h) do { _Pragma("unroll") for (int m = 0; m < 4; ++m) _Pragma("unroll") for (int k = 0; k < 2; ++k) dst[m][k] = *(const LAS bf16x8*)(lds + G8_SA(b, h) + aoff + m * 2048 + k * 1024); } while (0)
#define G8_LDB(dst, b, h) do { _Pragma("unroll") for (int n = 0; n < 2; ++n) _Pragma("unroll") for (int k = 0; k < 2; ++k) dst[n][k] = *(const LAS bf16x8*)(lds + G8_SB(b, h) + boff + n * 2048 + k * 1024); } while (0)
#define G8_MMA(ai, bj, At, Bt) do { __builtin_amdgcn_s_setprio(1); _Pragma("unroll") for (int m = 0; m < 4; ++m) { if (!PARTIAL || ((mmask >> ((ai) * 4 + m)) & 1u)) { _Pragma("unroll") for (int n = 0; n < 2; ++n) _Pragma("unroll") for (int k = 0; k < 2; ++k) \
        acc[ai][bj][m][n] = __builtin_amdgcn_mfma_f32_16x16x32_bf16(Bt[n][k], At[m][k], acc[ai][bj][m][n], 0, 0, 0); } } __builtin_amdgcn_s_setprio(0); } while (0)
#define G8_WAIT_V(n) asm volatile("s_waitcnt vmcnt(" #n ")" ::: "memory")
#define G8_WAIT_L(n) asm volatile("s_waitcnt lgkmcnt(" #n ")" ::: "memory")
#define G8_BAR __builtin_amdgcn_s_barrier()
#define G8_SCHED __builtin_amdgcn_sched_barrier(0)
    GUnit cur, nxt; int ui = 0;
    if (!S.next(0, cur)) return;
    constexpr bool GATHER = Sched::GATHER, PARTIAL = Sched::PARTIAL;
    unsigned mmask = 0xffu;
#define G8_MASK(u) do { if (PARTIAL) { mmask = 0u; _Pragma("unroll") for (int q_ = 0; q_ < 8; ++q_) mmask |= (((q_ >> 2) * 128 + wr * 64 + (q_ & 3) * 16) < (u).rows) ? (1u << q_) : 0u; } } while (0)
    unsigned vc[2][2];
    S.aoff(cur, vc, R, C); G8_MASK(cur);
    LAS u32x4* stash = (LAS u32x4*)(lds + STAGE_BYTES + 4096) + tid;
    f32x4 acc[2][2][4][2];
#pragma unroll
    for (int a = 0; a < 2; ++a)
#pragma unroll
        for (int b = 0; b < 2; ++b)
#pragma unroll
            for (int m = 0; m < 4; ++m)
#pragma unroll
                for (int n = 0; n < 2; ++n) acc[a][b][m][n] = (f32x4){0.f, 0.f, 0.f, 0.f};
    bf16x8 At[4][2], B0[2][2], B1[2][2];
    const char* cA = cur.a; const char* cB = cur.b;
    G8_STAGE_B(G8_SB(0, 0), cB); G8_STAGE_B(G8_SB(0, 1), cB + hstepB); G8_STAGE_A(G8_SA(0, 0), cA, vc[0][0], vc[0][1]); G8_STAGE_A(G8_SA(0, 1), cA, vc[1][0], vc[1][1]);
    if (wr == 1) G8_BAR;
    G8_WAIT_V(2); G8_BAR;
    G8_STAGE_B(G8_SB(1, 0), cB + kstep); G8_STAGE_A(G8_SA(1, 0), cA + kstep, vc[0][0], vc[0][1]); G8_STAGE_B(G8_SB(1, 1), cB + hstepB + kstep);
    G8_WAIT_V(6); G8_BAR;
    for (;;) {
        const bool has_next = S.next(ui + 1, nxt);
        if (GATHER) { unsigned vn[2][2];
            if (has_next) S.aoff(nxt, vn, R, C);
            else { vn[0][0] = vc[0][0]; vn[0][1] = vc[0][1]; vn[1][0] = vc[1][0]; vn[1][1] = vc[1][1]; }
            u32x4 sv; sv.x = vn[0][0]; sv.y = vn[0][1]; sv.z = vn[1][0]; sv.w = vn[1][1]; *stash = sv; }
        const char* nA = has_next ? nxt.a : cA; const char* nB = has_next ? nxt.b : cB;
#pragma unroll 1
        for (int seg = 0; seg < (Epi::KHOOK ? 3 : 1); ++seg) {
        const int tlo = Epi::KHOOK ? 6 * seg : 0, thi = Epi::KHOOK ? (seg == 2 ? nt : 6 * seg + 6) : nt;
#pragma unroll 1
        for (int t = tlo; t < thi; t += 2) {
            const bool last = (t == nt - 2);
            const char* a1 = cA + (size_t)(t + 1) * kstep;
            const char* a2 = last ? nA : cA + (size_t)(t + 2) * kstep; const char* b2 = last ? nB : cB + (size_t)(t + 2) * kstep;
            const char* a3 = a2 + kstep; const char* b3 = b2 + kstep;
            unsigned w00 = vc[0][0], w01 = vc[0][1], w10 = vc[1][0], w11 = vc[1][1];
            if (GATHER) { if (last) { const u32x4 sv = *stash; w00 = sv.x; w01 = sv.y; w10 = sv.z; w11 = sv.w; } }
            G8_LDB(B0, 0, 0); G8_LDB(B1, 0, 1); G8_SCHED; G8_LDA(At, 0, 0); G8_STAGE_A(G8_SA(1, 1), a1, vc[1][0], vc[1][1]);
            G8_WAIT_V(8); G8_WAIT_L(0); G8_BAR; G8_MMA(0, 0, At, B0); G8_MMA(0, 1, At, B1); G8_BAR; G8_SCHED;
            G8_LDA(At, 0, 1); G8_STAGE_B(G8_SB(0, 0), b2); G8_STAGE_B(G8_SB(0, 1), b2 + hstepB); G8_STAGE_A(G8_SA(0, 0), a2, w00, w01);
            G8_WAIT_V(8); G8_WAIT_L(0); G8_BAR; G8_MMA(1, 0, At, B0); G8_MMA(1, 1, At, B1); G8_BAR; G8_SCHED;
            G8_LDB(B0, 1, 0); G8_LDB(B1, 1, 1); G8_SCHED; G8_LDA(At, 1, 0); G8_STAGE_A(G8_SA(0, 1), a2, w10, w11);
            G8_WAIT_V(8); G8_WAIT_L(0); G8_BAR; G8_MMA(0, 0, At, B0); G8_MMA(0, 1, At, B1); G8_BAR; G8_SCHED;
            G8_LDA(At, 1, 1); G8_STAGE_B(G8_SB(1, 0), b3); G8_STAGE_B(G8_SB(1, 1), b3 + hstepB); G8_STAGE_A(G8_SA(1, 0), a3, w00, w01);
            G8_WAIT_V(8); G8_WAIT_L(0); G8_BAR; G8_MMA(1, 0, At, B0); G8_MMA(1, 1, At, B1); G8_BAR; G8_SCHED;
        }
        if constexpr (Epi::KHOOK) { if (seg < 2) E.kscale(acc, seg, wr, fr); }
        }
        if (wr == 0) G8_BAR;
        { int fr_ = fr, fq_ = fq; asm volatile("" : "+v"(fr_), "+v"(fq_));
          E(acc, cur, wr, wc, fr_, fq_); }
        if (!has_next) break;
#pragma unroll
        for (int a = 0; a < 2; ++a)
#pragma unroll
            for (int b = 0; b < 2; ++b)
#pragma unroll
                for (int m = 0; m < 4; ++m)
#pragma unroll
                    for (int n = 0; n < 2; ++n) acc[a][b][m][n] = (f32x4){0.f, 0.f, 0.f, 0.f};
        cur = nxt; cA = nA; cB = nB; ++ui; G8_MASK(cur);
        if (GATHER) { const u32x4 sv = *stash; vc[0][0] = sv.x; vc[0][1] = sv.y; vc[1][0] = sv.z; vc[1][1] = sv.w; }
        if (wr == 1) G8_BAR;
    }
    G8_WAIT_V(0);
    G8_BAR;
#undef G8_SA
#undef G8_SB
#undef G8_GLDS
#undef G8_STAGE_A
#undef G8_STAGE_B
#undef G8_LDA
#undef G8_LDB
#undef G8_MMA
#undef G8_MASK
#undef G8_WAIT_V
#undef G8_WAIT_L
#undef G8_BAR
#undef G8_SCHED
}
}
using g8::GUnit;
__device__ __forceinline__ void st_bf16x8(bf16_t* p, const float (&v)[8]) { u32x4 w; w.x = pk_bf16(v[0], v[1]); w.y = pk_bf16(v[2], v[3]); w.z = pk_bf16(v[4], v[5]); w.w = pk_bf16(v[6], v[7]); *(u32x4*)p = w; }
__device__ __forceinline__ float quad_sum(float s) { s += shx<16>(s); s += __shfl_xor(s, 32); return s; }

struct EpiInProj {
    static constexpr bool KHOOK = false;
    const float* ssqx; float* part_dq; float* part_dkv; const float* qg; const float* kg; const float* krg; const float* rope;
    unsigned char* prj;
    __device__ __forceinline__ void operator()(const f32x4 (&acc)[2][2][4][2], const GUnit& u, int wr, int wc, int fr, int fq) const {
        const int G = u.pn * 4 + wc;
        const bool isq = G < 6; const int a = G - 6; const bool isk = (G >= 10 && G < 18 && ((a >> 1) & 1) == 0);
        const float* g0 = (isq ? qg : kg) + 8 * fq;
        float rs8[8];
#pragma unroll
        for (int k = 0; k < 8; ++k) rs8[k] = ssqx[u.pm * 256 + (k >> 2) * 128 + wr * 64 + (k & 3) * 16 + fr];
#pragma unroll
        for (int k = 0; k < 8; ++k) rs8[k] = rsqrtf(rs8[k] * (1.f / 1024.f) + 1e-6f);
#pragma unroll
        for (int ai = 0; ai < 2; ++ai)
#pragma unroll
            for (int m = 0; m < 4; ++m) {
                __builtin_amdgcn_sched_barrier(0);
                const int row = u.pm * 256 + ai * 128 + wr * 64 + m * 16 + fr; const int b = row >> 11, t = row & 2047;
                const float rs = rs8[ai * 4 + m];
                float v[2][8];
#pragma unroll
                for (int bj = 0; bj < 2; ++bj)
#pragma unroll
                    for (int n = 0; n < 2; ++n)
#pragma unroll
                        for (int j = 0; j < 4; ++j) v[bj][4 * n + j] = acc[ai][bj][m][n][j] * rs;
                float ss = 0.f;
#pragma unroll
                for (int bj = 0; bj < 2; ++bj)
#pragma unroll
                    for (int i = 0; i < 8; ++i) ss += v[bj][i] * v[bj][i];
                bf16_t* dst = nullptr; int bstride = 32;
                if (isq) {
                    ss = quad_sum(ss); const float sc = rsqrtf(ss * (1.f / 64.f) + 1e-6f) * 0.18033688f;
#pragma unroll
                    for (int i = 0; i < 8; ++i) { v[0][i] *= sc * g0[i]; v[1][i] *= sc * g0[32 + i]; }
                    dst = (bf16_t*)(prj + PRJ_QN) + ((size_t)(b * 6 + G) * 2048 + t) * 64;
                } else if (G < 18) {
                    const int br = a >> 2, s = (a >> 1) & 1, hk = a & 1;
                    if (br > 0 && s == 0) {
                        ss = quad_sum(ss); const float sc = rsqrtf(ss * (1.f / 64.f) + 1e-6f);
#pragma unroll
                        for (int i = 0; i < 8; ++i) { v[0][i] *= sc * g0[i]; v[1][i] *= sc * g0[32 + i]; }
                    }
                    const size_t base = br == 0 ? (s ? PRJ_C0V : PRJ_C0K) : (br == 1 ? (s ? PRJ_VN1 : PRJ_KN1) : (s ? PRJ_VN2 : PRJ_KN2));
                    dst = (bf16_t*)(prj + base) + ((size_t)(b * 2 + hk) * 2048 + t) * 64;
                } else if (G < 26) { dst = (bf16_t*)(prj + PRJ_RAWQK) + (size_t)row * 512 + (G - 18) * 64; }
                else if (G < 30) { dst = (bf16_t*)(prj + PRJ_VML) + ((size_t)(b * 4 + (G - 26)) * 2048 + t) * 64; }
                else if (G < 34) { dst = (bf16_t*)(prj + PRJ_OG) + (size_t)row * 256 + (G - 30) * 64; }
                else if (G < 37) { dst = (bf16_t*)(prj + PRJ_DQKV) + (size_t)row * 384 + (G - 34) * 64; ss = quad_sum(ss); if (fq == 0) part_dq[(size_t)row * 4 + (G - 34)] = ss; }
                else if (G == 37) {
                    dst = (bf16_t*)(prj + PRJ_DQKV) + (size_t)row * 384 + 192;
                    float* gt = (float*)(prj + PRJ_GATES) + (size_t)row * 32 + 8 * fq;
                    *(f32x4*)gt = (f32x4){v[1][0], v[1][1], v[1][2], v[1][3]}; *(f32x4*)(gt + 4) = (f32x4){v[1][4], v[1][5], v[1][6], v[1][7]};
                    float s0 = 0.f;
#pragma unroll
                    for (int i = 0; i < 8; ++i) s0 += v[0][i] * v[0][i];
                    s0 = quad_sum(s0); const float sc = rsqrtf(s0 * (1.f / 32.f) + 1e-6f);
                    const float* rp = rope + (size_t)row * 32 + ((8 * fq) & 15);
                    float kr[8];
#pragma unroll
                    for (int i = 0; i < 8; ++i) { const float val = v[0][i] * sc * krg[8 * fq + i]; const float oth = __shfl_xor(val, 32); const float cs = rp[i], sn = rp[16 + i]; kr[i] = fq < 2 ? val * cs - oth * sn : val * cs + oth * sn; }
                    st_bf16x8((bf16_t*)(prj + PRJ_KR) + (size_t)row * 32 + 8 * fq, kr);
                } else { dst = (bf16_t*)(prj + PRJ_DQKV) + (size_t)row * 384 + 256 + (G - 38) * 64; ss = quad_sum(ss); if (fq == 0) part_dkv[(size_t)row * 2 + (G - 38)] = ss; }
                st_bf16x8(dst + 8 * fq, v[0]); st_bf16x8(dst + bstride + 8 * fq, v[1]);
            }
    }
};

struct EpiUq {
    static constexpr bool KHOOK = false;
    const float* ssq_dq; const float* qkn; const float* rope; bf16_t* QM;
    __device__ __forceinline__ void operator()(const f32x4 (&acc)[2][2][4][2], const GUnit& u, int wr, int wc, int fr, int fq) const {
        const int G = u.pn * 4 + wc; if (G >= 9) return;
        const float scale = 0.14724444f;
        const float* g0 = G < 6 ? qkn + 8 * fq : qkn + 64 + 8 * (fq & 1); const float* g1 = G < 6 ? g0 + 32 : g0 + 16;
        float rs8[8];
#pragma unroll
        for (int k = 0; k < 8; ++k) { const f32x4 pq = *(const f32x4*)(ssq_dq + (size_t)(u.pm * 256 + (k >> 2) * 128 + wr * 64 + (k & 3) * 16 + fr) * 4); rs8[k] = (pq.x + pq.y) + pq.z; }
#pragma unroll
        for (int k = 0; k < 8; ++k) rs8[k] = rsqrtf(rs8[k] * (1.f / 192.f) + 1e-6f);
#pragma unroll
        for (int ai = 0; ai < 2; ++ai) {
#pragma unroll
            for (int m = 0; m < 4; ++m) {
                __builtin_amdgcn_sched_barrier(0);
                const int row = u.pm * 256 + ai * 128 + wr * 64 + m * 16 + fr; const int b = row >> 11, t = row & 2047;
                const float rs = rs8[ai * 4 + m];
                float v[2][8]; float ss = 0.f;
#pragma unroll
                for (int bj = 0; bj < 2; ++bj)
#pragma unroll
                    for (int n = 0; n < 2; ++n)
#pragma unroll
                        for (int j = 0; j < 4; ++j) { const float x = acc[ai][bj][m][n][j] * rs; v[bj][4 * n + j] = x; ss += x * x; }
                if (G < 6) ss = quad_sum(ss); else ss += shx<16>(ss);
                const float sc = rsqrtf(ss * (G < 6 ? 1.f / 64.f : 1.f / 32.f) + 1e-6f) * scale;
#pragma unroll
                for (int i = 0; i < 8; ++i) { v[0][i] *= sc * g0[i]; v[1][i] *= sc * g1[i]; }
                if (G < 6) {
                    bf16_t* dst = QM + ((size_t)(b * 6 + G) * 2048 + t) * 96;
                    st_bf16x8(dst + 8 * fq, v[0]); st_bf16x8(dst + 32 + 8 * fq, v[1]);
                } else {
                    const int i16 = 8 * (fq & 1); const int head = 2 * (G - 6) + (fq >> 1);
                    const float* rp = rope + (size_t)row * 32 + i16; float o1[8], o2[8];
#pragma unroll
                    for (int i = 0; i < 8; ++i) { const float cs = rp[i], sn = rp[16 + i]; o1[i] = v[0][i] * cs - v[1][i] * sn; o2[i] = v[1][i] * cs + v[0][i] * sn; }
                    bf16_t* dst = QM + ((size_t)(b * 6 + head) * 2048 + t) * 96 + 64 + i16;
                    st_bf16x8(dst, o1); st_bf16x8(dst + 16, o2);
                }
            }
        }
    }
};
struct EpiUkv {
    static constexpr bool KHOOK = false;
    const float* ssq_dkv; const float* qkn; const bf16_t* KR; bf16_t* KM; bf16_t* VM;
    __device__ __forceinline__ void operator()(const f32x4 (&acc)[2][2][4][2], const GUnit& u, int wr, int wc, int fr, int fq) const {
        const int G = u.pn * 4 + wc;
        const float* g0 = qkn + 96 + 8 * fq;
        float rs8[8];
#pragma unroll
        for (int k = 0; k < 8; ++k) { const size_t rr = (size_t)(u.pm * 256 + (k >> 2) * 128 + wr * 64 + (k & 3) * 16 + fr); rs8[k] = ssq_dkv[rr * 2] + ssq_dkv[rr * 2 + 1]; }
#pragma unroll
        for (int k = 0; k < 8; ++k) rs8[k] = rsqrtf(rs8[k] * (1.f / 128.f) + 1e-6f);
#pragma unroll
        for (int ai = 0; ai < 2; ++ai) {
          u32x4 kr4[4];
          if (G < 6) {
#pragma unroll
              for (int m = 0; m < 4; ++m) kr4[m] = *(const u32x4*)(KR + (size_t)(u.pm * 256 + ai * 128 + wr * 64 + m * 16 + fr) * 32 + 8 * fq);
          }
#pragma unroll
            for (int m = 0; m < 4; ++m) {
                __builtin_amdgcn_sched_barrier(0);
                const int row = u.pm * 256 + ai * 128 + wr * 64 + m * 16 + fr; const int b = row >> 11, t = row & 2047;
                const float rs = rs8[ai * 4 + m];
                float v[2][8]; float ss = 0.f;
#pragma unroll
                for (int bj = 0; bj < 2; ++bj)
#pragma unroll
                    for (int n = 0; n < 2; ++n)
#pragma unroll
                        for (int j = 0; j < 4; ++j) { const float x = acc[ai][bj][m][n][j] * rs; v[bj][4 * n + j] = x; ss += x * x; }
                if (G < 6) {
                    ss = quad_sum(ss); const float sc = rsqrtf(ss * (1.f / 64.f) + 1e-6f);
#pragma unroll
                    for (int i = 0; i < 8; ++i) { v[0][i] *= sc * g0[i]; v[1][i] *= sc * g0[32 + i]; }
                    bf16_t* dst = KM + ((size_t)(b * 6 + G) * 2048 + t) * 96;
                    st_bf16x8(dst + 8 * fq, v[0]); st_bf16x8(dst + 32 + 8 * fq, v[1]);
                    *(u32x4*)(dst + 64 + 8 * fq) = kr4[m];
                } else {
                    bf16_t* dst = VM + ((size_t)(b * 6 + (G - 6)) * 2048 + t) * 64;
                    st_bf16x8(dst + 8 * fq, v[0]); st_bf16x8(dst + 32 + 8 * fq, v[1]);
                }
            }
        }
    }
};
#define MFMA16(a, b, c) __builtin_amdgcn_mfma_f32_16x16x32_bf16(a, b, c, 0, 0, 0)
#define MFMA32(a, b, c) __builtin_amdgcn_mfma_f32_32x32x16_bf16(a, b, c, 0, 0, 0)
#define LDS_FENCE() asm volatile("s_waitcnt lgkmcnt(0)" ::: "memory")

__device__ __forceinline__ void cmp_unit(int u, int l, InPtr in, unsigned char* ws, LAS unsigned char* lds, int g_wv) {
    int tid_ = TIDX; asm volatile("" : "+v"(tid_));
    const int tid = tid_, w = tid >> 6, lane = tid & 63, r = lane & 15, q = lane >> 4;
    const int b = u >> 2, s = (u >> 1) & 1, hk = u & 1;
    const bf16_t* A = (const bf16_t*)(ws + WS_PRJ + (s ? PRJ_C0V : PRJ_C0K)) + (size_t)(b * 2 + hk) * 2048 * 64;
    const bf16_t* W1 = (const bf16_t*)(ws + WS_WC1) + ((size_t)l * 2 + s) * 64 * 2048;
    const bf16_t* W2 = (const bf16_t*)(ws + WS_WC2) + ((size_t)l * 2 + s) * 64 * 64;
    const float* b1 = (const float*)(ws + WS_B1C) + (l * 2 + s) * 64;
    f32x4 acc[4];
#pragma unroll
    for (int nb = 0; nb < 4; ++nb) acc[nb] = (f32x4){0.f, 0.f, 0.f, 0.f};
    const bf16_t* ap = A + (size_t)(16 * w + r) * 1024 + 8 * q;
    constexpr int WP = 528, WBUF = 64 * WP; LAS unsigned char* wb = lds + 24576;
    u32x4 st[4];
#pragma unroll
    for (int i = 0; i < 4; ++i) { const int c = tid + 512 * i; st[i] = *(const u32x4*)(W1 + (size_t)(c >> 5) * 2048 + (c & 31) * 8); }
    bf16x8 af[8], afn[8];
#pragma unroll
    for (int ks = 0; ks < 8; ++ks) af[ks] = *(const bf16x8*)(ap + 32 * ks);
    const float* kg = in->p[9] + l * 64;
    float b1v[4], kgv[4]; bf16x8 w2f[2][4];
#pragma unroll
    for (int nb = 0; nb < 4; ++nb) { b1v[nb] = b1[16 * nb + r]; kgv[nb] = kg[16 * nb + r]; }
#pragma unroll
    for (int ks = 0; ks < 2; ++ks)
#pragma unroll
        for (int nb = 0; nb < 4; ++nb) w2f[ks][nb] = *(const bf16x8*)(W2 + (size_t)(16 * nb + r) * 64 + 32 * ks + 8 * q);
#pragma unroll
    for (int i = 0; i < 4; ++i) { const int c = tid + 512 * i; *(LAS u32x4*)(wb + (c >> 5) * WP + (c & 31) * 16) = st[i]; }
    __syncthreads();
    auto chunk = [&](const int kc, bf16x8 (&ac)[8], bf16x8 (&an)[8]) __attribute__((always_inline)) {
        const int cur = kc & 1;
        if (kc < 7) {
#pragma unroll
            for (int i = 0; i < 4; ++i) { const int c = tid + 512 * i; st[i] = *(const u32x4*)(W1 + (size_t)(c >> 5) * 2048 + (kc + 1) * 256 + (c & 31) * 8); }
#pragma unroll
            for (int ks = 0; ks < 8; ++ks) an[ks] = *(const bf16x8*)(ap + 256 * (kc + 1) + 32 * ks);
        }
#pragma unroll
        for (int ks = 0; ks < 8; ++ks)
#pragma unroll
            for (int nb = 0; nb < 4; ++nb) { const bf16x8 bb = *(const LAS bf16x8*)(wb + cur * WBUF + (16 * nb + r) * WP + (32 * ks + 8 * q) * 2); acc[nb] = MFMA16(ac[ks], bb, acc[nb]); }
        if (kc < 7) {
#pragma unroll
            for (int i = 0; i < 4; ++i) { const int c = tid + 512 * i; *(LAS u32x4*)(wb + (cur ^ 1) * WBUF + (c >> 5) * WP + (c & 31) * 16) = st[i]; }
        }
        __syncthreads();
    };
#pragma unroll 1
    for (int kc = 0; kc < 8; kc += 2) { chunk(kc, af, afn); chunk(kc + 1, afn, af); }
    LAS bf16_t* hl = (LAS bf16_t*)(lds + w * 2304);
#pragma unroll
    for (int nb = 0; nb < 4; ++nb) { const float bias = b1v[nb];
#pragma unroll
        for (int j = 0; j < 4; ++j) hl[(4 * q + j) * 72 + 16 * nb + r] = f2bf(siluf(acc[nb][j] + bias)); }
    LDS_FENCE();
    f32x4 o[4];
#pragma unroll
    for (int nb = 0; nb < 4; ++nb) o[nb] = (f32x4){0.f, 0.f, 0.f, 0.f};
#pragma unroll
    for (int ks = 0; ks < 2; ++ks) {
        const bf16x8 a = *(const LAS bf16x8*)(hl + r * 72 + 32 * ks + 8 * q);
#pragma unroll
        for (int nb = 0; nb < 4; ++nb) o[nb] = MFMA16(a, w2f[ks][nb], o[nb]);
    }
    LDS_FENCE();
    bf16_t* dst = (bf16_t*)(ws + WS_CMP + (s ? CMP_V : 0)) + (size_t)(b * 2 + hk) * 128 * 64;
#pragma unroll
    for (int j = 0; j < 4; ++j) {
        const int n = 16 * w + 4 * q + j; float ss = 0.f;
#pragma unroll
        for (int nb = 0; nb < 4; ++nb) ss += o[nb][j] * o[nb][j];
        ss += shx<1>(ss); ss += shx<2>(ss); ss += shx<4>(ss); ss += shx<8>(ss);
        const float sc = s == 0 ? rsqrtf(ss * (1.f / 64.f) + 1e-6f) : 1.f;
#pragma unroll
        for (int nb = 0; nb < 4; ++nb) { const int d = 16 * nb + r; const float v = o[nb][j] * sc * (s == 0 ? kgv[nb] : 1.f); dst[(size_t)n * 64 + d] = n < 127 ? f2bf(v) : (bf16_t)0; }
    }
}

__device__ __forceinline__ int swz_off(int row, int chunk) { return row * 128 + ((chunk ^ (row & 7)) << 4); }
__device__ __forceinline__ float log_sigmoid(float x) { return fminf(x, 0.f) - log1pf(__expf(-fabsf(x))); }
__device__ __forceinline__ void ml_delta_wave(int cu, int l, InPtr in, unsigned char* ws, LAS unsigned char* wl, int lane) {
    asm volatile("" : "+v"(lane));
    const int c = cu & 31, bh = cu >> 5, h = bh & 3, b = bh >> 2; const int t0 = c * 64; const size_t row0 = (size_t)b * 2048 + t0;
    const int cc = lane & 7, tg = lane >> 3;
    const bf16_t* raw = (const bf16_t*)(ws + WS_PRJ + PRJ_RAWQK); const float* cw = in->p[11] + (size_t)l * 4 * 512 + h * 64 + 8 * cc;
    u32x4 rq[11];
    const bool head0 = (c == 0 && tg == 0);
#pragma unroll
    for (int i = 0; i < 11; ++i) { const size_t rr = (head0 && i < 3) ? row0 : row0 + 8 * tg - 3 + i; rq[i] = *(const u32x4*)(raw + rr * 512 + h * 64 + 8 * cc); }
    __builtin_amdgcn_sched_barrier(0);
    const float* G = (const float*)(ws + WS_PRJ + PRJ_GATES);
    const float ip = G[(row0 + lane) * 32 + 18 + h] + in->p[12][l * 4 + h], fp = G[(row0 + lane) * 32 + 22 + h] + in->p[13][l * 4 + h];
    float bcum = log_sigmoid(fp);
#pragma unroll
    for (int o = 1; o < 64; o <<= 1) { const float t = __builtin_bit_cast(float, __builtin_amdgcn_ds_bpermute(((lane - o) & 63) << 2, __builtin_bit_cast(int, bcum))); if (lane >= o) bcum += t; }
    const float bL = __builtin_bit_cast(float, __builtin_amdgcn_readlane(__builtin_bit_cast(int, bcum), 63)); const float wgt = __expf(bL - bcum + ip);
    { float* mlg = (float*)(ws + WS_ML + ML_G) + ((size_t)bh * 2048 + t0 + lane) * 2; mlg[0] = bcum; mlg[1] = ip; if (lane == 0) ((float*)(ws + WS_ML + ML_BL))[cu] = bL; }
    float wt[8];
#pragma unroll
    for (int j = 0; j < 8; ++j) wt[j] = __builtin_bit_cast(float, __builtin_amdgcn_ds_bpermute((8 * tg + j) << 2, __builtin_bit_cast(int, wgt)));
    if (head0) {
#pragma unroll
        for (int i = 0; i < 3; ++i) rq[i] = (u32x4){0u, 0u, 0u, 0u}; }
#define MLD_E(v, e) (((e) & 1) ? bf_hi(((e) >> 1) == 0 ? (v).x : ((e) >> 1) == 1 ? (v).y : ((e) >> 1) == 2 ? (v).z : (v).w) : bf_lo(((e) >> 1) == 0 ? (v).x : ((e) >> 1) == 1 ? (v).y : ((e) >> 1) == 2 ? (v).z : (v).w))
    bf16_t* QC = (bf16_t*)(ws + WS_ML) + ((size_t)bh * 2048 + t0 + 8 * tg) * 64 + 8 * cc; bf16_t* KC = (bf16_t*)(ws + WS_ML + ML_KC) + ((size_t)bh * 2048 + t0 + 8 * tg) * 64 + 8 * cc;
    u32x4 rk[11], vv[8];
#pragma unroll
    for (int i = 0; i < 11; ++i) { const size_t rr = (head0 && i < 3) ? row0 : row0 + 8 * tg - 3 + i; rk[i] = *(const u32x4*)(raw + rr * 512 + h * 64 + 8 * cc + 256); }
    { const bf16_t* V = (const bf16_t*)(ws + WS_PRJ + PRJ_VML) + ((size_t)bh * 2048 + t0 + 8 * tg) * 64 + 8 * cc;
#pragma unroll
      for (int j = 0; j < 8; ++j) vv[j] = *(const u32x4*)(V + (size_t)j * 64); }
    if (head0) {
#pragma unroll
        for (int i = 0; i < 3; ++i) rk[i] = (u32x4){0u, 0u, 0u, 0u}; }
    __builtin_amdgcn_sched_barrier(0);
    {
        float w4[4][8];
#pragma unroll
        for (int tp = 0; tp < 4; ++tp) { const f32x4 a = *(const f32x4*)(cw + tp * 512), b4 = *(const f32x4*)(cw + tp * 512 + 4); w4[tp][0] = a.x; w4[tp][1] = a.y; w4[tp][2] = a.z; w4[tp][3] = a.w; w4[tp][4] = b4.x; w4[tp][5] = b4.y; w4[tp][6] = b4.z; w4[tp][7] = b4.w; }
#pragma unroll
        for (int j = 0; j < 8; ++j) { float o[8];
#pragma unroll
            for (int e = 0; e < 8; ++e) o[e] = siluf(w4[0][e] * MLD_E(rq[j], e) + w4[1][e] * MLD_E(rq[j + 1], e) + w4[2][e] * MLD_E(rq[j + 2], e) + w4[3][e] * MLD_E(rq[j + 3], e));
            u32x4 pk; pk.x = pk_bf16(o[0], o[1]); pk.y = pk_bf16(o[2], o[3]); pk.z = pk_bf16(o[4], o[5]); pk.w = pk_bf16(o[6], o[7]);
            *(u32x4*)(QC + (size_t)j * 64) = pk; }
    }
    float dn[8];
    {
        float w4[4][8];
#pragma unroll
        for (int tp = 0; tp < 4; ++tp) { const f32x4 a = *(const f32x4*)(cw + 256 + tp * 512), b4 = *(const f32x4*)(cw + 256 + tp * 512 + 4); w4[tp][0] = a.x; w4[tp][1] = a.y; w4[tp][2] = a.z; w4[tp][3] = a.w; w4[tp][4] = b4.x; w4[tp][5] = b4.y; w4[tp][6] = b4.z; w4[tp][7] = b4.w; }
#pragma unroll
        for (int e = 0; e < 8; ++e) dn[e] = 0.f;
#pragma unroll
        for (int j2 = 0; j2 < 4; ++j2) { float kb[2][8];
#pragma unroll
            for (int jj = 0; jj < 2; ++jj) { const int j = 2 * j2 + jj; float o[8];
#pragma unroll
                for (int e = 0; e < 8; ++e) o[e] = siluf(w4[0][e] * MLD_E(rk[j], e) + w4[1][e] * MLD_E(rk[j + 1], e) + w4[2][e] * MLD_E(rk[j + 2], e) + w4[3][e] * MLD_E(rk[j + 3], e)) * 0.125f;
                u32x4 pk; pk.x = pk_bf16(o[0], o[1]); pk.y = pk_bf16(o[2], o[3]); pk.z = pk_bf16(o[4], o[5]); pk.w = pk_bf16(o[6], o[7]);
                *(u32x4*)(KC + (size_t)j * 64) = pk;
#pragma unroll
                for (int e = 0; e < 8; ++e) { kb[jj][e] = MLD_E(pk, e); dn[e] += wt[j] * kb[jj][e]; } }
#pragma unroll
            for (int e = 0; e < 8; ++e) { *(LAS unsigned*)(wl + swz_off(8 * cc + e, tg) + 4 * j2) = pk_bf16(kb[0][e], kb[1][e]);
                *(LAS unsigned*)(wl + 8192 + swz_off(8 * cc + e, tg) + 4 * j2) = pk_bf16(wt[2 * j2] * MLD_E(vv[2 * j2], e), wt[2 * j2 + 1] * MLD_E(vv[2 * j2 + 1], e)); } }
    }
#undef MLD_E
#pragma unroll
    for (int e = 0; e < 8; ++e) { dn[e] += shx<8>(dn[e]); dn[e] += shx<16>(dn[e]); dn[e] += __shfl_xor(dn[e], 32); }
    if (tg == 0) { float* DN = (float*)(ws + WS_ML + ML_DN) + (size_t)cu * 64 + 8 * cc; *(f32x4*)DN = (f32x4){dn[0], dn[1], dn[2], dn[3]}; *(f32x4*)(DN + 4) = (f32x4){dn[4], dn[5], dn[6], dn[7]}; }
    LDS_FENCE();
    const int r = lane & 15, q = lane >> 4;
    bf16_t* DL = (bf16_t*)(ws + WS_ML + ML_DELTA) + (size_t)cu * 4096;
    f32x4 acc[4][4];
#pragma unroll
    for (int mb = 0; mb < 4; ++mb) {
#pragma unroll
        for (int nb = 0; nb < 4; ++nb) acc[mb][nb] = (f32x4){0.f, 0.f, 0.f, 0.f};
#pragma unroll
        for (int ks = 0; ks < 2; ++ks) {
            const bf16x8 a = *(const LAS bf16x8*)(wl + 8192 + swz_off(16 * mb + r, 4 * ks + q));
#pragma unroll
            for (int nb = 0; nb < 4; ++nb) { const bf16x8 bb = *(const LAS bf16x8*)(wl + swz_off(16 * nb + r, 4 * ks + q)); acc[mb][nb] = MFMA16(a, bb, acc[mb][nb]); }
        }
    }
    LDS_FENCE();
#pragma unroll
    for (int mb = 0; mb < 4; ++mb)
#pragma unroll
        for (int nb = 0; nb < 4; ++nb)
#pragma unroll
            for (int j = 0; j < 4; ++j) { const int row = 16 * mb + 4 * q + j, col = 16 * nb + r; *(LAS bf16_t*)(wl + swz_off(row, col >> 3) + (col & 7) * 2) = f2bf(acc[mb][nb][j]); }
    LDS_FENCE();
#pragma unroll
    for (int i = 0; i < 8; ++i) { const int ch = lane + 64 * i; *(u32x4*)(DL + (size_t)ch * 8) = *(const LAS u32x4*)(wl + swz_off(ch >> 3, ch & 7)); }
    LDS_FENCE();
}

#ifndef TIME_PH
#define TIME_PH -1
#endif
#define PSTAMP(i, blk) do { if (TIME_PH != -1 && l == 0 && blockIdx.x == (blk) && TIDX == 0) ((unsigned long long*)((unsigned*)(ws + WS_CTL) + CW_TS))[i] = __builtin_amdgcn_s_memrealtime(); } while (0)
#ifndef DUP_DELTA
#define DUP_DELTA 1
#endif
__device__ __forceinline__ void phase_prep(int l, InPtr in, unsigned char* ws, LAS unsigned char* lds, int bid, int nb, int g_wv, unsigned* dq) {
    asm volatile("" : "+s"(bid));
    PSTAMP(40, 0);
#ifndef NO_UQ
    { g8::DenseSched S{(const char*)(ws + WS_PRJ + PRJ_DQKV), (const char*)(ws + WS_WUQ) + (size_t)l * 768 * 256 * 2, 384, 256, 64, 3, nb, bid};
      EpiUq E{(const float*)(ws + WS_SSQ + PT_DQ) + (size_t)l * 16384 * 4, in->p[19] + l * 192, (const float*)(ws + WS_ROPE), (bf16_t*)(ws + WS_MLA)};
      g8::gemm_run(lds, 256, 256, S, E, g_wv); }
#endif
    PSTAMP(41, 0);
#ifndef NO_UKV
    asm volatile("" : "+s"(bid));
    { g8::DenseSched S{(const char*)(ws + WS_PRJ + PRJ_DQKV) + 256, (const char*)(ws + WS_WUKV) + (size_t)l * 768 * 256 * 2, 384, 256, 64, 3, nb, nb == 256 ? ((bid + 64) & 255) : bid};
      EpiUkv E{(const float*)(ws + WS_SSQ + PT_DKV) + (size_t)l * 16384 * 2, in->p[19] + l * 192, (const bf16_t*)(ws + WS_PRJ + PRJ_KR), (bf16_t*)(ws + WS_MLA + MLA_KM), (bf16_t*)(ws + WS_MLA + MLA_VM)};
      g8::gemm_run(lds, 256, 256, S, E, g_wv); }
#endif
    PSTAMP(42, 0); PSTAMP(44, 255);
    __syncthreads();
#ifndef NO_CMP
#ifndef DUP_CMP
#define DUP_CMP 1
#endif
    for (int u = (nb == 256 ? (bid >= 128 && bid < 160 ? bid - 128 : 32) : nb - 1 - bid); u < 32; u += nb) for (int rp_ = 0; rp_ < DUP_CMP; ++rp_) { if (rp_) __syncthreads(); cmp_unit(u, l, in, ws, lds, g_wv); }
#endif
    PSTAMP(45, 255);
    __syncthreads();
#ifndef NO_DELTA
    { int tid_ = TIDX; asm volatile("" : "+v"(tid_)); LAS int* slot = (LAS int*)(lds + LDS_MISC + 64);
      for (;;) {
          __syncthreads();
          if (tid_ == 0) *slot = (int)__hip_atomic_fetch_add(dq, 1u, __ATOMIC_RELAXED, __HIP_MEMORY_SCOPE_AGENT);
          __syncthreads();
          const int g = *slot; if (g >= 96 + 128) break;
          const int wv = tid_ >> 6;
          const int cu_ = g < 96 ? g * 8 + wv : 768 + (g - 96) * 2 + wv;
          if (g < 96 || wv < 2) { for (int rp_ = 0; rp_ < DUP_DELTA; ++rp_) ml_delta_wave(cu_, l, in, ws, lds + wv * 16384, tid_ & 63); }
      } }
#endif
    __syncthreads(); PSTAMP(43, 0);
}
#define CHK_TOL(st) (((st) & 15) == 8 ? 1e-2f : 1e-3f)
#define CHECK_REST
constexpr int VTP = 192;
typedef short v4i16_t __attribute__((ext_vector_type(4)));
__device__ __forceinline__ int vt_lane_off(int lane) { return (4 * (lane >> 5) + ((lane & 15) >> 2)) * VTP + ((((lane >> 4) & 1) * 16) + 4 * (lane & 3)) * 2; }
__device__ __forceinline__ bf16x8 vt_frag(const LAS unsigned char* Vt, int voff, int s4, int eb) {
    const LAS unsigned char* a = Vt + voff + 16 * s4 * VTP + 64 * eb;
    const v4i16_t lo = __builtin_amdgcn_ds_read_tr16_b64_v4i16((LAS v4i16_t*)a), hi = __builtin_amdgcn_ds_read_tr16_b64_v4i16((LAS v4i16_t*)(a + 8 * VTP));
    return (bf16x8){lo[0], lo[1], lo[2], lo[3], hi[0], hi[1], hi[2], hi[3]};
}
__device__ __forceinline__ int crow(int reg, int h) { return (reg & 3) + 8 * (reg >> 2) + 4 * h; }
struct AttnState { f32x16 o[2]; float m, l; };
__device__ __forceinline__ void attn_reset(AttnState& A) { A.m = -1e30f; A.l = 0.f;
#pragma unroll
    for (int i = 0; i < 16; ++i) { A.o[0][i] = 0.f; A.o[1][i] = 0.f; } }

template <int DK>
__device__ __forceinline__ void attn_scores(f32x16 (&s)[2], const bf16x8 (&qf)[DK / 16], const LAS unsigned char* Kt, int r, int h) {
    constexpr int KP = 2 * DK + 16, NK = DK / 16;
    bf16x8 kf[2][NK];
#pragma unroll
    for (int kb = 0; kb < 2; ++kb)
#pragma unroll
        for (int ks = 0; ks < NK; ++ks) kf[kb][ks] = *(const LAS bf16x8*)(Kt + (32 * kb + r) * KP + (16 * ks + 8 * h) * 2);
    __builtin_amdgcn_sched_barrier(0);
#pragma unroll
    for (int kb = 0; kb < 2; ++kb)
#pragma unroll
        for (int i = 0; i < 16; ++i) s[kb][i] = 0.f;
#pragma unroll
    for (int ks = 0; ks < NK; ++ks) {
        s[0] = MFMA32(kf[0][ks], qf[ks], s[0]);
        s[1] = MFMA32(kf[1][ks], qf[ks], s[1]);
    }
}
__device__ __forceinline__ float max3f(float a, float b, float c) { return fmaxf(fmaxf(a, b), c); }
__device__ __forceinline__ void attn_softmax_pv(AttnState& A, f32x16 (&s)[2], const LAS unsigned char* Vt, int r, int h, float bias_c = 0.f, bool lane_ok = true) {
    constexpr float THR = 8.f; const int voff = vt_lane_off(r + 32 * h);
    float mx = max3f(s[0][0], s[0][1], s[0][2]);
#pragma unroll
    for (int i = 3; i < 15; i += 2) mx = max3f(mx, s[0][i], s[0][i + 1]);
    mx = max3f(mx, s[0][15], s[1][0]);
#pragma unroll
    for (int i = 1; i < 15; i += 2) mx = max3f(mx, s[1][i], s[1][i + 1]);
    mx = fmaxf(mx, s[1][15]);
    mx = fmaxf(mx, __shfl_xor(mx, 32));
    const float mxb = (lane_ok && mx > -1e29f) ? mx + bias_c : -1e30f;
    const bool grow = mxb > A.m + THR;
    const float mnew = grow ? mxb : A.m;
    if (__any(grow)) {
        const float alpha = __builtin_amdgcn_exp2f(A.m - mnew);
        A.l *= alpha;
#pragma unroll
        for (int i = 0; i < 16; ++i) { A.o[0][i] *= alpha; A.o[1][i] *= alpha; }
    }
    A.m = mnew;
    const float sub = (lane_ok && mnew > -1e29f) ? mnew - bias_c : 1e30f;
    float rs = 0.f;
#pragma unroll
    for (int kb = 0; kb < 2; ++kb)
#pragma unroll
        for (int i = 0; i < 16; ++i) { const float p = __builtin_amdgcn_exp2f(s[kb][i] - sub); s[kb][i] = p; rs += p; }
    rs += __shfl_xor(rs, 32);
    A.l += rs;
    bf16x8 vf[4][2];
#pragma unroll
    for (int s4 = 0; s4 < 4; ++s4)
#pragma unroll
        for (int eb = 0; eb < 2; ++eb) vf[s4][eb] = vt_frag(Vt, voff, s4, eb);
    __builtin_amdgcn_sched_barrier(0);
#pragma unroll
    for (int s4 = 0; s4 < 4; ++s4) {
        const int kb = s4 >> 1, hf = (s4 & 1) * 8;
        u32x4 pw; pw.x = pk_bf16(s[kb][hf + 0], s[kb][hf + 1]); pw.y = pk_bf16(s[kb][hf + 2], s[kb][hf + 3]); pw.z = pk_bf16(s[kb][hf + 4], s[kb][hf + 5]); pw.w = pk_bf16(s[kb][hf + 6], s[kb][hf + 7]);
        const bf16x8 pf = __builtin_bit_cast(bf16x8, pw);
#pragma unroll
        for (int eb = 0; eb < 2; ++eb) A.o[eb] = MFMA32(vf[s4][eb], pf, A.o[eb]);
    }
}
template <int DK>
__device__ __forceinline__ void attn_scores_half(f32x16& s, const bf16x8 (&qf)[DK / 16], const LAS unsigned char* Kt, int r, int h, int kb) {
    constexpr int KP = 2 * DK + 16, NK = DK / 16;
    bf16x8 kf[NK];
#pragma unroll
    for (int ks = 0; ks < NK; ++ks) kf[ks] = *(const LAS bf16x8*)(Kt + (32 * kb + r) * KP + (16 * ks + 8 * h) * 2);
    __builtin_amdgcn_sched_barrier(0);
#pragma unroll
    for (int i = 0; i < 16; ++i) s[i] = 0.f;
#pragma unroll
    for (int ks = 0; ks < NK; ++ks) s = MFMA32(kf[ks], qf[ks], s);
}
__device__ __forceinline__ void attn_softmax_pv_half(AttnState& A, f32x16& s, const LAS unsigned char* Vt, int r, int h, int kb, float bias_c = 0.f, bool lane_ok = true) {
    constexpr float THR = 8.f; const int voff = vt_lane_off(r + 32 * h);
    float mx = max3f(s[0], s[1], s[2]);
#pragma unroll
    for (int i = 3; i < 15; i += 2) mx = max3f(mx, s[i], s[i + 1]);
    mx = fmaxf(mx, s[15]);
    mx = fmaxf(mx, __shfl_xor(mx, 32));
    const float mxb = (lane_ok && mx > -1e29f) ? mx + bias_c : -1e30f;
    const bool grow = mxb > A.m + THR;
    const float mnew = grow ? mxb : A.m;
    if (__any(grow)) {
        const float alpha = __builtin_amdgcn_exp2f(A.m - mnew);
        A.l *= alpha;
#pragma unroll
        for (int i = 0; i < 16; ++i) { A.o[0][i] *= alpha; A.o[1][i] *= alpha; }
    }
    A.m = mnew;
    const float sub = (lane_ok && mnew > -1e29f) ? mnew - bias_c : 1e30f;
    float rs = 0.f;
#pragma unroll
    for (int i = 0; i < 16; ++i) { const float p = __builtin_amdgcn_exp2f(s[i] - sub); s[i] = p; rs += p; }
    rs += __shfl_xor(rs, 32);
    A.l += rs;
    bf16x8 vf[2][2];
#pragma unroll
    for (int s2 = 0; s2 < 2; ++s2)
#pragma unroll
        for (int eb = 0; eb < 2; ++eb) vf[s2][eb] = vt_frag(Vt, voff, 2 * kb + s2, eb);
    __builtin_amdgcn_sched_barrier(0);
#pragma unroll
    for (int s2 = 0; s2 < 2; ++s2) {
        const int hf = s2 * 8;
        u32x4 pw; pw.x = pk_bf16(s[hf + 0], s[hf + 1]); pw.y = pk_bf16(s[hf + 2], s[hf + 3]); pw.z = pk_bf16(s[hf + 4], s[hf + 5]); pw.w = pk_bf16(s[hf + 6], s[hf + 7]);
        const bf16x8 pf = __builtin_bit_cast(bf16x8, pw);
#pragma unroll
        for (int eb = 0; eb < 2; ++eb) A.o[eb] = MFMA32(vf[s2][eb], pf, A.o[eb]);
    }
}
template <int DK>
__device__ __forceinline__ void stage_k_load(u32x4 (&kr)[2], const bf16_t* Kg  , int tid) {
    constexpr int CH = DK / 8;
    kr[0] = *(const u32x4*)(Kg + (size_t)(tid / CH) * DK + (tid % CH) * 8);
    if (64 * CH > 512) { const int c2 = tid + 512; if (c2 < 64 * CH) kr[1] = *(const u32x4*)(Kg + (size_t)(c2 / CH) * DK + (c2 % CH) * 8); }
}
template <int DK>
__device__ __forceinline__ void stage_k_store(const u32x4 (&kr)[2], LAS unsigned char* Kt, int tid) {
    constexpr int CH = DK / 8, KP = 2 * DK + 16;
    *(LAS u32x4*)(Kt + (tid / CH) * KP + (tid % CH) * 16) = kr[0];
    if (64 * CH > 512) { const int c2 = tid + 512; if (c2 < 64 * CH) *(LAS u32x4*)(Kt + (c2 / CH) * KP + (c2 % CH) * 16) = kr[1]; }
}
__device__ __forceinline__ u32x4 stage_v_load(const bf16_t* Vg, int tid) { return *(const u32x4*)(Vg + (size_t)(tid >> 3) * 64 + (tid & 7) * 8); }
__device__ __forceinline__ void stage_v_store(const u32x4& v, LAS unsigned char* Vt, int tid) { *(LAS u32x4*)(Vt + (tid >> 3) * VTP + (tid & 7) * 16) = v; }

constexpr int MLA_KT = 0, MLA_VT = 2 * 64 * 208, MLA_LDS = MLA_VT + 2 * 64 * VTP;
__device__ __forceinline__ void mla_unit(int b, int hd, int qt, int l, unsigned char* ws, LAS unsigned char* lds, int g_wv) {
    int tid_ = TIDX; asm volatile("" : "+v"(tid_));
    const int tid = tid_, w = tid >> 6, lane = tid & 63, r = lane & 31, h = lane >> 5;
    const size_t slab = (size_t)(b * 6 + hd) * 2048;
    const bf16_t* QM = (const bf16_t*)(ws + WS_MLA) + slab * 96; const bf16_t* KM = (const bf16_t*)(ws + WS_MLA + MLA_KM) + slab * 96; const bf16_t* VM = (const bf16_t*)(ws + WS_MLA + MLA_VM) + slab * 64;
    const int q0 = 256 * qt + 32 * w, q = q0 + r;
    bf16x8 qf[6];
#pragma unroll
    for (int ks = 0; ks < 6; ++ks) qf[ks] = *(const bf16x8*)(QM + (size_t)q * 96 + 16 * ks + 8 * h);
    AttnState A; attn_reset(A);
    const int ntile = 4 * qt + 4;
    u32x4 kr[2], vr, kr2[2], vr2;
    stage_k_load<96>(kr, KM, tid); vr = stage_v_load(VM, tid);
    stage_k_store<96>(kr, lds + MLA_KT, tid); stage_v_store(vr, lds + MLA_VT, tid);
    if (ntile > 1) { stage_k_load<96>(kr, KM + (size_t)64 * 96, tid); vr = stage_v_load(VM + (size_t)64 * 64, tid); }
    __syncthreads();
    auto tile_step = [&](const int j, u32x4 (&kc)[2], u32x4& vc, u32x4 (&kn)[2], u32x4& vn) __attribute__((always_inline)) {
        const int cur = j & 1;
        if (j + 2 < ntile) { stage_k_load<96>(kn, KM + (size_t)(j + 2) * 64 * 96, tid); vn = stage_v_load(VM + (size_t)(j + 2) * 64 * 64, tid); }
        if (64 * j <= q0 + 31) {
            f32x16 s[2];
            attn_scores<96>(s, qf, lds + MLA_KT + cur * 64 * 208, r, h);
            if (64 * j + 63 > q0) {
#pragma unroll
                for (int kb = 0; kb < 2; ++kb)
#pragma unroll
                    for (int i = 0; i < 16; ++i) { const int key = 64 * j + 32 * kb + crow(i, h); if (key > q) s[kb][i] = -1e30f; }
            }
            attn_softmax_pv(A, s, lds + MLA_VT + cur * 64 * VTP, r, h);
        }
        if (j + 1 < ntile) { stage_k_store<96>(kc, lds + MLA_KT + (cur ^ 1) * 64 * 208, tid); stage_v_store(vc, lds + MLA_VT + (cur ^ 1) * 64 * VTP, tid); }
        __syncthreads();
    };
#pragma unroll 1
    for (int j = 0; j < ntile; j += 2) { tile_step(j, kr, vr, kr2, vr2); tile_step(j + 1, kr2, vr2, kr, vr); }
    const float inv = A.l > 0.f ? 1.f / A.l : 0.f; float ss = 0.f;
    bf16_t* Y = (bf16_t*)(ws + WS_Y) + ((size_t)b * 2048 + q) * 1024 + 384 + hd * 64;
#pragma unroll
    for (int eb = 0; eb < 2; ++eb)
#pragma unroll
        for (int g4 = 0; g4 < 4; ++g4) {
            const float v0 = A.o[eb][4 * g4] * inv, v1 = A.o[eb][4 * g4 + 1] * inv, v2 = A.o[eb][4 * g4 + 2] * inv, v3 = A.o[eb][4 * g4 + 3] * inv;
            u32x2 pw; pw.x = pk_bf16(v0, v1); pw.y = pk_bf16(v2, v3);
            const float f0 = bf_lo(pw.x), f1 = bf_hi(pw.x), f2 = bf_lo(pw.y), f3 = bf_hi(pw.y); ss += (f0 * f0 + f1 * f1) + (f2 * f2 + f3 * f3);
            *(u32x2*)(Y + 32 * eb + 8 * g4 + 4 * h) = pw;
        }
    ss += __shfl_xor(ss, 32);
    if (h == 0) ((float*)(ws + WS_SSQ + PT_C))[((size_t)l * 16384 + (size_t)b * 2048 + q) * 8 + hd] = ss;
}

__device__ __forceinline__ void nsa_bias32(float (&bv)[2][16], const LAS float* bl, int dd) {
#pragma unroll
    for (int kb = 0; kb < 2; ++kb)
#pragma unroll
        for (int k = 0; k < 16; ++k) { const int c = 63 - (32 * kb + (k & 3) + 8 * (k >> 2)); int d = dd + c; d = d < 0 ? 0 : (d > 255 ? 255 : d); bv[kb][k] = bl[d]; }
}
__device__ __forceinline__ void nsa_mask_bias(f32x16 (&sc)[2], int dq, int h, const LAS float* bl, bool sel, int lim) {
    int dd = dq - 4 * h - 63; asm volatile("" : "+v"(dd));
    float bv[2][16]; nsa_bias32(bv, bl, dd);
#pragma unroll
    for (int kb = 0; kb < 2; ++kb)
#pragma unroll
        for (int k = 0; k < 16; ++k) { const int c = 63 - (32 * kb + (k & 3) + 8 * (k >> 2)); const int d = dd + c; sc[kb][k] = (sel && d >= 0 && d < lim) ? sc[kb][k] + bv[kb][k] : -1e30f; }
}
__device__ __forceinline__ void nsa_mask_bias_half(f32x16& sc, int dq, int h, const LAS float* bl, bool sel, int lim, int kb) {
    int dd = dq - 4 * h - 32 * kb; asm volatile("" : "+v"(dd));
    float bv[16];
#pragma unroll
    for (int k = 0; k < 16; ++k) { int d = dd - ((k & 3) + 8 * (k >> 2)); d = d < 0 ? 0 : (d > 255 ? 255 : d); bv[k] = bl[d]; }
#pragma unroll
    for (int k = 0; k < 16; ++k) { const int d = dd - ((k & 3) + 8 * (k >> 2)); sc[k] = (sel && d >= 0 && d < lim) ? sc[k] + bv[k] : -1e30f; }
}

__device__ __forceinline__ void attn_park(const AttnState& A, LAS float* xl) {
    xl[0] = A.m; xl[64] = A.l;
#pragma unroll
    for (int k = 0; k < 16; ++k) { xl[64 * (2 + k)] = A.o[0][k]; xl[64 * (18 + k)] = A.o[1][k]; }
}
__device__ __forceinline__ void attn_merge(AttnState& A, const LAS float* xl) {
    const float m2 = xl[0], l2 = xl[64]; const float m = fmaxf(A.m, m2);
    const float a1 = A.m > -1e29f ? __builtin_amdgcn_exp2f(A.m - m) : 0.f, a2 = m2 > -1e29f ? __builtin_amdgcn_exp2f(m2 - m) : 0.f;
    A.l = A.l * a1 + l2 * a2; A.m = m;
#pragma unroll
    for (int k = 0; k < 16; ++k) { A.o[0][k] = A.o[0][k] * a1 + xl[64 * (2 + k)] * a2; A.o[1][k] = A.o[1][k] * a1 + xl[64 * (18 + k)] * a2; }
}
constexpr int NSA_KT = 0, NSA_VT = 2 * 64 * 144, NSA_BIAS = NSA_VT + 2 * 64 * VTP, NSA_PS = NSA_BIAS + 3 * 256 * 4, NSA_SEL = NSA_PS + 3 * 64 * 32 * 4, NSA_UNI = NSA_SEL + 256, NSA_OT = NSA_UNI + 256, NSA_LDS = NSA_OT + 6 * 8192;
__device__ __forceinline__ void nsa_unit(int b, int hk, int i, int l, InPtr in, unsigned char* ws, LAS unsigned char* lds, int g_wv) {
    int tid_ = TIDX; asm volatile("" : "+v"(tid_));
    const int tid = tid_, w = tid >> 6, lane = tid & 63, r = lane & 31, h = lane >> 5;
    const bool active = w < 6; const int g = active ? (w >> 1) : 2, th = w & 1, head = hk * 3 + g;
    const int kh = w < 4 ? -1 : (w < 6 ? 0 : 1);
    LAS float* xl = (LAS float*)(lds + NSA_LDS) + th * (34 * 64) + lane;
    const int t = 64 * i + 32 * th + r, tl = 32 * th + r; const size_t row = (size_t)b * 2048 + t;
    const size_t kvslab = (size_t)(b * 2 + hk) * 2048 * 64;
    LAS float* biasl = (LAS float*)(lds + NSA_BIAS); LAS float* PS = (LAS float*)(lds + NSA_PS); LAS unsigned* SEL = (LAS unsigned*)(lds + NSA_SEL); LAS unsigned* UNI = (LAS unsigned*)(lds + NSA_UNI);
    { const float* bd = (const float*)(ws + WS_BIASD) + (size_t)hk * 3 * 2048;
      if (tid < 384) { const int gg = tid >> 7, d0 = (tid & 127) * 2; biasl[gg * 256 + d0] = bd[gg * 2048 + d0]; biasl[gg * 256 + d0 + 1] = bd[gg * 2048 + d0 + 1]; }
#pragma unroll
      for (int k = 0; k < 12; ++k) if (i >= 16) PS[tid + 512 * k] = 0.f;
      if (tid < 4) UNI[tid] = 0u; }
    bf16x8 qf[4];
    { const bf16_t* QN = (const bf16_t*)(ws + WS_PRJ + PRJ_QN) + ((size_t)(b * 6 + head) * 2048 + t) * 64;
#pragma unroll
      for (int ks = 0; ks < 4; ++ks) qf[ks] = *(const bf16x8*)(QN + 16 * ks + 8 * h); }
#define NSA_GATE(k) ({ int t_ = t; asm volatile("" : "+v"(t_)); sigmf(((const float*)(ws + WS_PRJ + PRJ_GATES))[((size_t)b * 2048 + t_) * 32 + head * 3 + (k)]); })
    LAS float* bl = biasl + g * 256;
    LAS float* otl = (LAS float*)(lds + NSA_OT + (active ? w : 0) * 8192) + lane;
    u32x4 kr[2], vr;
    const int ntc = i >= 16 ? 2 : 1;
    { const bf16_t* KC = (const bf16_t*)(ws + WS_CMP) + (size_t)(b * 2 + hk) * 128 * 64; const bf16_t* VC = (const bf16_t*)(ws + WS_CMP + CMP_V) + (size_t)(b * 2 + hk) * 128 * 64;
      for (int T = 0; T < ntc; ++T) { stage_k_load<64>(kr, KC + T * 4096, tid); vr = stage_v_load(VC + T * 4096, tid); stage_k_store<64>(kr, lds + NSA_KT + T * 64 * 144, tid); stage_v_store(vr, lds + NSA_VT + T * 64 * VTP, tid); } }
    __syncthreads();
    {
        f32x16 ot[2];
        if (active && i < 16) {
            AttnState A; attn_reset(A); f32x16 sc[2]; attn_scores<64>(sc, qf, lds + NSA_KT, r, h);
            float bvc[2][16];
#pragma unroll
            for (int kb = 0; kb < 2; ++kb)
#pragma unroll
                for (int k = 0; k < 16; ++k) { int d = t - 16 * (32 * kb + crow(k, h)) - 31; d = d < 0 ? 0 : (d > 255 ? 255 : d); bvc[kb][k] = bl[d]; }
#pragma unroll
            for (int kb = 0; kb < 2; ++kb)
#pragma unroll
                for (int k = 0; k < 16; ++k) { const int d = t - 16 * (32 * kb + crow(k, h)) - 31; sc[kb][k] = d >= 0 ? sc[kb][k] + bvc[kb][k] : -1e30f; }
            attn_softmax_pv(A, sc, lds + NSA_VT, r, h);
            const float gc = NSA_GATE(0); const float inv = A.l > 0.f ? gc / A.l : 0.f;
#pragma unroll
            for (int k = 0; k < 16; ++k) { otl[64 * k] = A.o[0][k] * inv; otl[64 * (16 + k)] = A.o[1][k] * inv; }
        } else if (active) {
            float m = -1e30f, lsum = 0.f;
            for (int T = 0; T < ntc; ++T) {
                f32x16 sc[2]; attn_scores<64>(sc, qf, lds + NSA_KT + T * 64 * 144, r, h);
                float bvc[2][16];
#pragma unroll
                for (int kb = 0; kb < 2; ++kb)
#pragma unroll
                    for (int k = 0; k < 16; ++k) { int d = t - 16 * (64 * T + 32 * kb + crow(k, h)) - 31; d = d < 0 ? 0 : (d > 255 ? 255 : d); bvc[kb][k] = bl[d]; }
                float mx = -1e30f;
#pragma unroll
                for (int kb = 0; kb < 2; ++kb)
#pragma unroll
                    for (int k = 0; k < 16; ++k) { const int n = 64 * T + 32 * kb + crow(k, h); const int d = t - 16 * n - 31; const float x = (d >= 0 && n < 127) ? sc[kb][k] + bvc[kb][k] : -1e30f; sc[kb][k] = x; mx = fmaxf(mx, x); }
                mx = fmaxf(mx, __shfl_xor(mx, 32));
                const float mnew = fmaxf(m, mx), mref = mnew <= -1e29f ? 0.f : mnew; float rs = 0.f;
#pragma unroll
                for (int kb = 0; kb < 2; ++kb)
#pragma unroll
                    for (int k = 0; k < 16; ++k) rs += __builtin_amdgcn_exp2f(sc[kb][k] - mref);
                rs += __shfl_xor(rs, 32);
                lsum = lsum * __builtin_amdgcn_exp2f(m - mref) + rs; m = mnew;
            }
            const float mref = m <= -1e29f ? 0.f : m, inv = lsum > 0.f ? 1.f / lsum : 0.f;
#pragma unroll
            for (int k = 0; k < 16; ++k) { ot[0][k] = 0.f; ot[1][k] = 0.f; }
            float carry = 0.f;
            for (int T = 0; T < ntc; ++T) {
                f32x16 sc[2]; attn_scores<64>(sc, qf, lds + NSA_KT + T * 64 * 144, r, h);
                float bvc[2][16];
#pragma unroll
                for (int kb = 0; kb < 2; ++kb)
#pragma unroll
                    for (int k = 0; k < 16; ++k) { int d = t - 16 * (64 * T + 32 * kb + crow(k, h)) - 31; d = d < 0 ? 0 : (d > 255 ? 255 : d); bvc[kb][k] = bl[d]; }
#pragma unroll
                for (int kb = 0; kb < 2; ++kb)
#pragma unroll
                    for (int k = 0; k < 16; ++k) { const int n = 64 * T + 32 * kb + crow(k, h); const int d = t - 16 * n - 31; sc[kb][k] = (d >= 0 && n < 127) ? __builtin_amdgcn_exp2f(sc[kb][k] + bvc[kb][k] - mref) * inv : 0.f; }
                float prevL = carry;
#pragma unroll
                for (int kb = 0; kb < 2; ++kb)
#pragma unroll
                    for (int g4 = 0; g4 < 4; ++g4) {
                        const float G4 = (sc[kb][4 * g4] + sc[kb][4 * g4 + 1]) + (sc[kb][4 * g4 + 2] + sc[kb][4 * g4 + 3]); const float L = sc[kb][4 * g4 + 3];
                        const float Lo = __shfl_xor(L, 32);
                        const float add = h ? Lo : prevL;
                        prevL = Lo;
                        const int idx = T * 8 + kb * 4 + g4;
                        PS[g * 2048 + tl * 32 + 2 * idx + h] = G4 + add;
                    }
                carry = prevL;
#pragma unroll
                for (int s4 = 0; s4 < 4; ++s4) {
                    const int kb = s4 >> 1, hf = (s4 & 1) * 8;
                    u32x4 pw; pw.x = pk_bf16(sc[kb][hf + 0], sc[kb][hf + 1]); pw.y = pk_bf16(sc[kb][hf + 2], sc[kb][hf + 3]); pw.z = pk_bf16(sc[kb][hf + 4], sc[kb][hf + 5]); pw.w = pk_bf16(sc[kb][hf + 6], sc[kb][hf + 7]);
                    const bf16x8 pf = __builtin_bit_cast(bf16x8, pw);
#pragma unroll
                    for (int eb = 0; eb < 2; ++eb) ot[eb] = MFMA32(vt_frag(lds + NSA_VT + T * 64 * VTP, vt_lane_off(lane), s4, eb), pf, ot[eb]);
                }
            }
            { const float gc = NSA_GATE(0);
#pragma unroll
            for (int k = 0; k < 16; ++k) { otl[64 * k] = ot[0][k] * gc; otl[64 * (16 + k)] = ot[1][k] * gc; } }
        }
    }
    __syncthreads();
#ifndef NO_NSA_SEL
    if (i < 16) { if (tid < 64) SEL[tid] = (2u << i) - 1u; if (tid < 3) UNI[tid] = (2u << i) - 1u; }
    else {
        const int tk = tid >> 3, sg = tid & 7; float v[32];
#pragma unroll
        for (int k = 0; k < 8; ++k) { const f32x4 x0 = *(const LAS f32x4*)(PS + tk * 32 + 4 * k), x1 = *(const LAS f32x4*)(PS + 2048 + tk * 32 + 4 * k), x2 = *(const LAS f32x4*)(PS + 4096 + tk * 32 + 4 * k);
            v[4 * k] = (x0.x + x1.x) + x2.x; v[4 * k + 1] = (x0.y + x1.y) + x2.y; v[4 * k + 2] = (x0.z + x1.z) + x2.z; v[4 * k + 3] = (x0.w + x1.w) + x2.w; }
#pragma unroll
        for (int s = 0; s < 32; ++s) { const bool forced = (s == 0) || (s == i) || (s == i - 1); float x = forced ? v[s] + 1e4f : v[s]; v[s] = s > i ? -1.f : x; }
        unsigned bits = 0u;
#pragma unroll
        for (int k = 0; k < 4; ++k) {
            float x = 0.f;
#pragma unroll
            for (int s = 0; s < 32; ++s) x = (s == 4 * sg + k) ? v[s] : x;
            int rank = 0;
#pragma unroll
            for (int s = 0; s < 32; ++s) rank += (v[s] > x || (v[s] == x && s < 4 * sg + k)) ? 1 : 0;
            if (rank < 16 && x >= 0.f) bits |= 1u << (4 * sg + k);
        }
        bits |= shx<1>(bits); bits |= shx<2>(bits); bits |= shx<4>(bits);
        if (sg == 0) { SEL[tk] = bits; __hip_atomic_fetch_or(UNI, bits, __ATOMIC_RELAXED, __HIP_MEMORY_SCOPE_WORKGROUP); __hip_atomic_fetch_or(UNI + 1 + (tk >> 5), bits, __ATOMIC_RELAXED, __HIP_MEMORY_SCOPE_WORKGROUP); }
    }
#endif
    __syncthreads();
    const unsigned selbits = SEL[tl], uni = UNI[0], unih = UNI[1 + th];
    const float c31 = bl[255];
#ifndef NO_NSA_SLC
#ifndef NSA_DUP_SLC
#define NSA_DUP_SLC 1
#endif
    for (int rp_ = 0; rp_ < NSA_DUP_SLC; ++rp_) {
        AttnState A; attn_reset(A);
        const bf16_t* KS = (const bf16_t*)(ws + WS_PRJ + PRJ_KN1) + kvslab; const bf16_t* VS = (const bf16_t*)(ws + WS_PRJ + PRJ_VN1) + kvslab;
        unsigned todo = uni; int cur = 0; u32x4 kr2[2], vr2;
        int s = __ffs(todo) - 1; todo &= todo - 1;
        stage_k_load<64>(kr, KS + (size_t)s * 4096, tid); vr = stage_v_load(VS + (size_t)s * 4096, tid);
        stage_k_store<64>(kr, lds + NSA_KT, tid); stage_v_store(vr, lds + NSA_VT, tid);
        int sn = todo ? __ffs(todo) - 1 : -1; todo &= todo - 1;
        if (sn >= 0) { stage_k_load<64>(kr, KS + (size_t)sn * 4096, tid); vr = stage_v_load(VS + (size_t)sn * 4096, tid); }
        __syncthreads();
        while (s >= 0) {
            const int sn2 = todo ? __ffs(todo) - 1 : -1; todo &= todo - 1;
            if (sn2 >= 0) { stage_k_load<64>(kr2, KS + (size_t)sn2 * 4096, tid); vr2 = stage_v_load(VS + (size_t)sn2 * 4096, tid); }
            if ((unih >> s) & 1u) {
                const bool sel = (selbits >> s) & 1u;
                if (kh < 0) {
                    f32x16 sc[2];
                    attn_scores<64>(sc, qf, lds + NSA_KT + cur * 64 * 144, r, h);
                    if (i - s >= 3) attn_softmax_pv(A, sc, lds + NSA_VT + cur * 64 * VTP, r, h, c31, sel);
                    else { nsa_mask_bias(sc, t - 64 * s, h, bl, sel, 4096); attn_softmax_pv(A, sc, lds + NSA_VT + cur * 64 * VTP, r, h); }
                } else {
                    f32x16 s1;
                    attn_scores_half<64>(s1, qf, lds + NSA_KT + cur * 64 * 144, r, h, kh);
                    if (i - s >= 3) attn_softmax_pv_half(A, s1, lds + NSA_VT + cur * 64 * VTP, r, h, kh, c31, sel);
                    else { nsa_mask_bias_half(s1, t - 64 * s, h, bl, sel, 4096, kh); attn_softmax_pv_half(A, s1, lds + NSA_VT + cur * 64 * VTP, r, h, kh); }
                }
            }
            if (sn >= 0) { stage_k_store<64>(kr, lds + NSA_KT + (cur ^ 1) * 64 * 144, tid); stage_v_store(vr, lds + NSA_VT + (cur ^ 1) * 64 * VTP, tid); }
            kr[0] = kr2[0]; vr = vr2;
            __syncthreads();
            s = sn; sn = sn2; cur ^= 1;
        }
        if (kh == 1) attn_park(A, xl);
        __syncthreads();
        if (kh == 0) attn_merge(A, xl);
        if (active && rp_ == NSA_DUP_SLC - 1) { const float gs = NSA_GATE(1); const float inv = A.l > 0.f ? gs / A.l : 0.f;
#pragma unroll
            for (int k = 0; k < 16; ++k) { otl[64 * k] += A.o[0][k] * inv; otl[64 * (16 + k)] += A.o[1][k] * inv; } }
    }
#endif
#ifndef NO_NSA_WIN
#ifndef NSA_DUP_WIN
#define NSA_DUP_WIN 1
#endif
    for (int rq_ = 0; rq_ < NSA_DUP_WIN; ++rq_) {
        AttnState A; attn_reset(A);
        const bf16_t* KW = (const bf16_t*)(ws + WS_PRJ + PRJ_KN2) + kvslab; const bf16_t* VW = (const bf16_t*)(ws + WS_PRJ + PRJ_VN2) + kvslab;
        const int j0 = i > 8 ? i - 8 : 0; int cur = 0; u32x4 kr2[2], vr2;
        stage_k_load<64>(kr, KW + (size_t)j0 * 4096, tid); vr = stage_v_load(VW + (size_t)j0 * 4096, tid);
        stage_k_store<64>(kr, lds + NSA_KT, tid); stage_v_store(vr, lds + NSA_VT, tid);
        if (j0 < i) { stage_k_load<64>(kr, KW + (size_t)(j0 + 1) * 4096, tid); vr = stage_v_load(VW + (size_t)(j0 + 1) * 4096, tid); }
        __syncthreads();
        for (int j = j0; j <= i; ++j) {
            if (j + 2 <= i) { stage_k_load<64>(kr2, KW + (size_t)(j + 2) * 4096, tid); vr2 = stage_v_load(VW + (size_t)(j + 2) * 4096, tid); }
            if (kh < 0) {
                f32x16 sc[2];
                attn_scores<64>(sc, qf, lds + NSA_KT + cur * 64 * 144, r, h);
                if (i - j >= 3 && j > i - 8) attn_softmax_pv(A, sc, lds + NSA_VT + cur * 64 * VTP, r, h, c31, true);
                else { nsa_mask_bias(sc, t - 64 * j, h, bl, true, 512); attn_softmax_pv(A, sc, lds + NSA_VT + cur * 64 * VTP, r, h); }
            } else {
                f32x16 s1;
                attn_scores_half<64>(s1, qf, lds + NSA_KT + cur * 64 * 144, r, h, kh);
                if (i - j >= 3 && j > i - 8) attn_softmax_pv_half(A, s1, lds + NSA_VT + cur * 64 * VTP, r, h, kh, c31, true);
                else { nsa_mask_bias_half(s1, t - 64 * j, h, bl, true, 512, kh); attn_softmax_pv_half(A, s1, lds + NSA_VT + cur * 64 * VTP, r, h, kh); }
            }
            if (j < i) { stage_k_store<64>(kr, lds + NSA_KT + (cur ^ 1) * 64 * 144, tid); stage_v_store(vr, lds + NSA_VT + (cur ^ 1) * 64 * VTP, tid); }
            kr[0] = kr2[0]; vr = vr2;
            __syncthreads();
            cur ^= 1;
        }
        if (kh == 1) attn_park(A, xl);
        __syncthreads();
        if (kh == 0) attn_merge(A, xl);
        if (active && rq_ == NSA_DUP_WIN - 1) { const float gw = NSA_GATE(2); const float inv = A.l > 0.f ? gw / A.l : 0.f;
            float ss = 0.f; bf16_t* Y = (bf16_t*)(ws + WS_Y) + row * 1024 + head * 64;
#pragma unroll
            for (int eb = 0; eb < 2; ++eb)
#pragma unroll
                for (int g4 = 0; g4 < 4; ++g4) {
                    const float v0 = otl[64 * (16 * eb + 4 * g4)] + A.o[eb][4 * g4] * inv, v1 = otl[64 * (16 * eb + 4 * g4 + 1)] + A.o[eb][4 * g4 + 1] * inv;
                    const float v2 = otl[64 * (16 * eb + 4 * g4 + 2)] + A.o[eb][4 * g4 + 2] * inv, v3 = otl[64 * (16 * eb + 4 * g4 + 3)] + A.o[eb][4 * g4 + 3] * inv;
                    u32x2 pw; pw.x = pk_bf16(v0, v1); pw.y = pk_bf16(v2, v3);
                    const float f0 = bf_lo(pw.x), f1 = bf_hi(pw.x), f2 = bf_lo(pw.y), f3 = bf_hi(pw.y); ss += (f0 * f0 + f1 * f1) + (f2 * f2 + f3 * f3);
                    *(u32x2*)(Y + 32 * eb + 8 * g4 + 4 * h) = pw;
                }
            ss += __shfl_xor(ss, 32);
            if (h == 0) ((float*)(ws + WS_SSQ + PT_A))[((size_t)l * 16384 + row) * 8 + head] = ss;
        }
    }
#endif
}

__device__ __forceinline__ void ml_out_wave(int cu, int l, InPtr in, unsigned char* ws, LAS unsigned char* wl, LAS unsigned char* npl, int lane) {
    const int c = cu & 31, bh = cu >> 5, hd = bh & 3, b = bh >> 2; const int t0 = c * 64; const int r = lane & 15, q = lane >> 4;
    const bf16_t* QC = (const bf16_t*)(ws + WS_ML) + ((size_t)bh * 2048 + t0) * 64; const bf16_t* KC = (const bf16_t*)(ws + WS_ML + ML_KC) + ((size_t)bh * 2048 + t0) * 64;
    const bf16_t* V = (const bf16_t*)(ws + WS_PRJ + PRJ_VML) + ((size_t)bh * 2048 + t0) * 64;
    const float* mlg = (const float*)(ws + WS_ML + ML_G) + ((size_t)bh * 2048 + t0) * 2;
    const bf16_t* CP = (const bf16_t*)(ws + WS_ML + ML_CP) + (size_t)cu * 4096; const bf16_t* NP = (const bf16_t*)(ws + WS_ML + ML_NP) + (size_t)cu * 64;
    u32x4 vch[8];
#pragma unroll
    for (int i = 0; i < 8; ++i) vch[i] = *(const u32x4*)(V + (size_t)(lane + 64 * i) * 8);
    bf16x8 aq[4][2];
#pragma unroll
    for (int mb = 0; mb < 4; ++mb)
#pragma unroll
        for (int ks = 0; ks < 2; ++ks) aq[mb][ks] = *(const bf16x8*)(QC + (size_t)(16 * mb + r) * 64 + 32 * ks + 8 * q);
    float bj[4][4], den[4][4];
#pragma unroll
    for (int mb = 0; mb < 4; ++mb)
#pragma unroll
        for (int j = 0; j < 4; ++j) bj[mb][j] = mlg[(16 * mb + 4 * q + j) * 2];
    {
        float cs[4];
#pragma unroll
        for (int nb = 0; nb < 4; ++nb) { const float2 gg = *(const float2*)(mlg + (16 * nb + r) * 2); cs[nb] = gg.y - gg.x; }
#pragma unroll
        for (int mb = 0; mb < 4; ++mb) {
            f32x4 accS[4];
#pragma unroll
            for (int nb = 0; nb < 4; ++nb) { accS[nb] = (f32x4){0.f, 0.f, 0.f, 0.f};
#pragma unroll
                for (int ks = 0; ks < 2; ++ks) { const bf16x8 bk = *(const bf16x8*)(KC + (size_t)(16 * nb + r) * 64 + 32 * ks + 8 * q); accS[nb] = MFMA16(aq[mb][ks], bk, accS[nb]); } }
#pragma unroll
            for (int j = 0; j < 4; ++j) {
                const int jj = 16 * mb + 4 * q + j; float rs = 0.f;
#pragma unroll
                for (int nb = 0; nb < 4; ++nb) { const int s = 16 * nb + r; const float p = s <= jj ? accS[nb][j] * __expf(bj[mb][j] + cs[nb]) : 0.f; rs += p;
                    *(LAS bf16_t*)(wl + 8192 + swz_off(jj, s >> 3) + (s & 7) * 2) = f2bf(p); }
                rs += shx<1>(rs); rs += shx<2>(rs); rs += shx<4>(rs); rs += shx<8>(rs);
                den[mb][j] = rs;
            }
        }
    }
#pragma unroll
    for (int i = 0; i < 8; ++i) { const int ch = lane + 64 * i, sv = ch >> 3, e0 = (ch & 7) * 8; const unsigned xs[4] = {vch[i].x, vch[i].y, vch[i].z, vch[i].w};
#pragma unroll
        for (int k = 0; k < 4; ++k) { *(LAS bf16_t*)(wl + swz_off(e0 + 2 * k, sv >> 3) + (sv & 7) * 2) = (bf16_t)(xs[k] & 0xffffu); *(LAS bf16_t*)(wl + swz_off(e0 + 2 * k + 1, sv >> 3) + (sv & 7) * 2) = (bf16_t)(xs[k] >> 16); } }
#pragma unroll
    for (int mb = 0; mb < 4; ++mb) { const float e = __expf(mlg[(16 * mb + r) * 2]);
#pragma unroll
        for (int ks = 0; ks < 2; ++ks) { const u32x4 x = __builtin_bit_cast(u32x4, aq[mb][ks]); u32x4 y;
            y.x = pk_bf16(bf_lo(x.x) * e, bf_hi(x.x) * e); y.y = pk_bf16(bf_lo(x.y) * e, bf_hi(x.y) * e); y.z = pk_bf16(bf_lo(x.z) * e, bf_hi(x.z) * e); y.w = pk_bf16(bf_lo(x.w) * e, bf_hi(x.w) * e);
            aq[mb][ks] = __builtin_bit_cast(bf16x8, y); } }
    f32x4 acc[4][4], accn[4];
#pragma unroll
    for (int mb = 0; mb < 4; ++mb) { accn[mb] = (f32x4){0.f, 0.f, 0.f, 0.f};
#pragma unroll
        for (int nb = 0; nb < 4; ++nb) acc[mb][nb] = (f32x4){0.f, 0.f, 0.f, 0.f}; }
#pragma unroll
    for (int ks = 0; ks < 2; ++ks) {
        u32x4 nz = *(const u32x4*)(NP + 32 * ks + 8 * q); if (r != 0) nz = (u32x4){0u, 0u, 0u, 0u};
        const bf16x8 bn = __builtin_bit_cast(bf16x8, nz);
#pragma unroll
        for (int nb = 0; nb < 4; ++nb) { const bf16x8 bb = *(const bf16x8*)(CP + (size_t)(16 * nb + r) * 64 + 32 * ks + 8 * q);
#pragma unroll
            for (int mb = 0; mb < 4; ++mb) acc[mb][nb] = MFMA16(aq[mb][ks], bb, acc[mb][nb]); }
#pragma unroll
        for (int mb = 0; mb < 4; ++mb) accn[mb] = MFMA16(aq[mb][ks], bn, accn[mb]);
    }
    LDS_FENCE();
#pragma unroll
    for (int ks = 0; ks < 2; ++ks) {
        bf16x8 ap[4];
#pragma unroll
        for (int mb = 0; mb < 4; ++mb) ap[mb] = *(const LAS bf16x8*)(wl + 8192 + swz_off(16 * mb + r, 4 * ks + q));
#pragma unroll
        for (int nb = 0; nb < 4; ++nb) { const bf16x8 bv = *(const LAS bf16x8*)(wl + swz_off(16 * nb + r, 4 * ks + q));
#pragma unroll
            for (int mb = 0; mb < 4; ++mb) acc[mb][nb] = MFMA16(ap[mb], bv, acc[mb][nb]); }
    }
    LDS_FENCE();
    const bf16_t* OG = (const bf16_t*)(ws + WS_PRJ + PRJ_OG); u32x4 ogc[8];
#pragma unroll
    for (int i = 0; i < 8; ++i) { const int ch = lane + 64 * i; ogc[i] = *(const u32x4*)(OG + ((size_t)b * 2048 + t0 + (ch >> 3)) * 256 + hd * 64 + (ch & 7) * 8); }
    const float* gain = in->p[14] + l * 256 + hd * 64;
    bf16_t* Y = (bf16_t*)(ws + WS_Y);
    float gn[4];
#pragma unroll
    for (int nb = 0; nb < 4; ++nb) gn[nb] = gain[16 * nb + r];
#pragma unroll
    for (int mb = 0; mb < 4; ++mb)
#pragma unroll
        for (int j = 0; j < 4; ++j) {
            const int jj = 16 * mb + 4 * q + j;
            const float dn = den[mb][j] + __builtin_bit_cast(float, __builtin_amdgcn_ds_bpermute((lane & 48) << 2, __builtin_bit_cast(int, accn[mb][j])));
            const float inv = __builtin_amdgcn_rcpf(fmaxf(fabsf(dn), 1.f)); float hv[4]; float ss = 0.f;
#pragma unroll
            for (int nb = 0; nb < 4; ++nb) { hv[nb] = acc[mb][nb][j] * inv; ss += hv[nb] * hv[nb]; }
            ss += shx<1>(ss); ss += shx<2>(ss); ss += shx<4>(ss); ss += shx<8>(ss);
            const float rstd = rsqrtf(ss * (1.f / 64.f) + 1e-6f);
#pragma unroll
            for (int nb = 0; nb < 4; ++nb) { const int e = 16 * nb + r; *(LAS bf16_t*)(wl + 8192 + swz_off(jj, e >> 3) + (e & 7) * 2) = f2bf(hv[nb] * rstd * gn[nb]); }
        }
    LDS_FENCE();
#pragma unroll
    for (int i = 0; i < 8; ++i) { const int ch = lane + 64 * i, row = ch >> 3, e8 = ch & 7;
        const u32x4 hx = *(const LAS u32x4*)(wl + 8192 + swz_off(row, e8)); const u32x4 g = ogc[i]; u32x4 o;
        o.x = pk_bf16(bf_lo(hx.x) * sigmf(bf_lo(g.x)), bf_hi(hx.x) * sigmf(bf_hi(g.x)));
        o.y = pk_bf16(bf_lo(hx.y) * sigmf(bf_lo(g.y)), bf_hi(hx.y) * sigmf(bf_hi(g.y)));
        o.z = pk_bf16(bf_lo(hx.z) * sigmf(bf_lo(g.z)), bf_hi(hx.z) * sigmf(bf_hi(g.z)));
        o.w = pk_bf16(bf_lo(hx.w) * sigmf(bf_lo(g.w)), bf_hi(hx.w) * sigmf(bf_hi(g.w)));
        *(u32x4*)(Y + ((size_t)b * 2048 + t0 + row) * 1024 + 768 + hd * 64 + e8 * 8) = o; }
    LDS_FENCE();
}

__device__ __forceinline__ void ml_scan_unit(int bh, int l, unsigned char* ws, int g_wv) {
    int tid_ = TIDX; asm volatile("" : "+v"(tid_)); const int tid = tid_;
    const bf16_t* DL = (const bf16_t*)(ws + WS_ML + ML_DELTA) + (size_t)bh * 32 * 4096 + tid * 8; bf16_t* CP = (bf16_t*)(ws + WS_ML + ML_CP) + (size_t)bh * 32 * 4096 + tid * 8;
    const float* DN = (const float*)(ws + WS_ML + ML_DN) + (size_t)bh * 32 * 64; bf16_t* NP = (bf16_t*)(ws + WS_ML + ML_NP) + (size_t)bh * 32 * 64; const float* BL = (const float*)(ws + WS_ML + ML_BL) + bh * 32;
    float c[8]; float n = 0.f;
#pragma unroll
    for (int k = 0; k < 8; ++k) c[k] = 0.f;
#pragma unroll 1
    for (int c0 = 0; c0 < 32; c0 += 8) {
        u32x4 d[8]; float dn[8], co[8];
#pragma unroll
        for (int k = 0; k < 8; ++k) { d[k] = *(const u32x4*)(DL + (size_t)(c0 + k) * 4096); dn[k] = tid < 64 ? DN[(c0 + k) * 64 + tid] : 0.f; co[k] = __expf(BL[c0 + k]); }
#pragma unroll
        for (int k = 0; k < 8; ++k) {
            u32x4 o; o.x = pk_bf16(c[0], c[1]); o.y = pk_bf16(c[2], c[3]); o.z = pk_bf16(c[4], c[5]); o.w = pk_bf16(c[6], c[7]);
            *(u32x4*)(CP + (size_t)(c0 + k) * 4096) = o; if (tid < 64) NP[(c0 + k) * 64 + tid] = f2bf(n);
            c[0] = co[k] * c[0] + bf_lo(d[k].x); c[1] = co[k] * c[1] + bf_hi(d[k].x); c[2] = co[k] * c[2] + bf_lo(d[k].y); c[3] = co[k] * c[3] + bf_hi(d[k].y);
            c[4] = co[k] * c[4] + bf_lo(d[k].z); c[5] = co[k] * c[5] + bf_hi(d[k].z); c[6] = co[k] * c[6] + bf_lo(d[k].w); c[7] = co[k] * c[7] + bf_hi(d[k].w);
            n = co[k] * n + dn[k];
        }
    }
    asm volatile("s_waitcnt vmcnt(0)" ::: "memory"); __syncthreads();
    if (tid == 0) { __builtin_amdgcn_fence(__ATOMIC_RELEASE, "agent"); asm volatile("s_waitcnt vmcnt(0)" ::: "memory");
        __hip_atomic_fetch_add((unsigned*)(ws + WS_CTL) + CW_SCAN + 64 * l, 1u, __ATOMIC_RELAXED, __HIP_MEMORY_SCOPE_AGENT); }
}
__device__ __forceinline__ void ml_scan_wait(int l, unsigned char* ws, int g_wv) {
    if (TIDX == 0) { unsigned* p = (unsigned*)(ws + WS_CTL) + CW_SCAN + 64 * l; unsigned sp = 0;
        while (__hip_atomic_load(p, __ATOMIC_RELAXED, __HIP_MEMORY_SCOPE_AGENT) < 32u) { __builtin_amdgcn_s_sleep(2); if (++sp > (1u << 22)) break; }
        __builtin_amdgcn_fence(__ATOMIC_ACQUIRE, "agent"); asm volatile("s_waitcnt vmcnt(0)" ::: "memory"); }
    __syncthreads();
}

#ifndef DUP_NSA
#define DUP_NSA 1
#endif
#ifndef DUP_MLA
#define DUP_MLA 1
#endif
#ifndef DUP_ML
#define DUP_ML 1
#endif
#ifdef NO_MLA
#define MLA_CALL(...) do {} while (0)
#else
#define MLA_CALL(...) do { for (int rp = 0; rp < DUP_MLA; ++rp) { if (rp) __syncthreads(); mla_unit(__VA_ARGS__); } } while (0)
#endif
__device__ __forceinline__ void phase_mix(int l, InPtr in, unsigned char* ws, LAS unsigned char* lds, unsigned* qhead, int g_wv) {
    LAS int* slot = (LAS int*)(lds + LDS_MISC + 64);
    for (;;) {
        __syncthreads();
        if (TIDX == 0) *slot = (int)__hip_atomic_fetch_add(qhead, 1u, __ATOMIC_RELAXED, __HIP_MEMORY_SCOPE_AGENT);
        __syncthreads();
        int u = *slot;
        if (u >= 32 + 512 + 384 + 128) break;
        if (u < 32) { ml_scan_unit(u, l, ws, g_wv); continue; } u -= 32;
#ifndef NO_NSA
        if (u < 256) { const int i = 31 - (u >> 4), bh = u & 15; { for (int rp = 0; rp < DUP_NSA; ++rp) { if (rp) __syncthreads(); nsa_unit(bh >> 1, bh & 1, i, l, in, ws, lds, g_wv); } } continue; }
#endif
        u -= 256;
        if (u < 192) { const int qt = 7 - u / 48, bh = u % 48; MLA_CALL(bh / 6, bh % 6, qt, l, ws, lds, g_wv); continue; }
        u -= 192;
#ifndef NO_NSA
        if (u < 128) { const int i = 15 - (u >> 4), bh = u & 15; { for (int rp = 0; rp < DUP_NSA; ++rp) { if (rp) __syncthreads(); nsa_unit(bh >> 1, bh & 1, i, l, in, ws, lds, g_wv); } } continue; }
#endif
        u -= 128;
        if (u < 192) { const int qt = 3 - u / 48, bh = u % 48; MLA_CALL(bh / 6, bh % 6, qt, l, ws, lds, g_wv); continue; } u -= 192;
#ifndef NO_NSA
        if (u < 128) { const int i = 7 - (u >> 4), bh = u & 15; { for (int rp = 0; rp < DUP_NSA; ++rp) { if (rp) __syncthreads(); nsa_unit(bh >> 1, bh & 1, i, l, in, ws, lds, g_wv); } } continue; }
#endif
        u -= 128;
#ifndef NO_MLOUT
        ml_scan_wait(l, ws, g_wv);
        for (int rp = 0; rp < DUP_ML; ++rp) { int tid_ = TIDX; asm volatile("" : "+v"(tid_)); const int w = tid_ >> 6; ml_out_wave(u * 8 + w, l, in, ws, lds + w * 16384, lds + 131072 + w * 256, tid_ & 63); }
#endif
    }
}
__device__ __forceinline__ void phase_ynorm(int l, unsigned char* ws, int bid, int nb, int g_wv) {
    int tid_ = TIDX; asm volatile("" : "+v"(tid_)); const int w = tid_ >> 6, lane = tid_ & 63;
    bf16_t* Y = (bf16_t*)(ws + WS_Y); const float* sa = (const float*)(ws + WS_SSQ + PT_A) + (size_t)l * 16384 * 8; const float* sc = (const float*)(ws + WS_SSQ + PT_C) + (size_t)l * 16384 * 8;
    for (int r0 = (bid * 8 + w) * 8; r0 < NTOK; r0 += nb * 64) {
        if (lane < 48) {
            u32x4 x[8], y[8]; float ra[8], rc[8];
#pragma unroll
            for (int k = 0; k < 8; ++k) { const int row = r0 + k;
                const f32x4 a0 = *(const f32x4*)(sa + (size_t)row * 8), a1 = *(const f32x4*)(sa + (size_t)row * 8 + 4), c0 = *(const f32x4*)(sc + (size_t)row * 8), c1 = *(const f32x4*)(sc + (size_t)row * 8 + 4);
                ra[k] = rsqrtf((((a0.x + a0.y) + (a0.z + a0.w)) + (a1.x + a1.y)) * (1.f / 384.f) + 1e-6f); rc[k] = rsqrtf((((c0.x + c0.y) + (c0.z + c0.w)) + (c1.x + c1.y)) * (1.f / 384.f) + 1e-6f);
                x[k] = *((const u32x4*)(Y + (size_t)row * 1024) + lane); y[k] = *((const u32x4*)(Y + (size_t)row * 1024 + 384) + lane); }
#pragma unroll
            for (int k = 0; k < 8; ++k) { const int row = r0 + k; u32x4 a = x[k], c = y[k]; const float fa = ra[k], fc = rc[k];
                a.x = pk_bf16(bf_lo(a.x) * fa, bf_hi(a.x) * fa); a.y = pk_bf16(bf_lo(a.y) * fa, bf_hi(a.y) * fa); a.z = pk_bf16(bf_lo(a.z) * fa, bf_hi(a.z) * fa); a.w = pk_bf16(bf_lo(a.w) * fa, bf_hi(a.w) * fa);
                c.x = pk_bf16(bf_lo(c.x) * fc, bf_hi(c.x) * fc); c.y = pk_bf16(bf_lo(c.y) * fc, bf_hi(c.y) * fc); c.z = pk_bf16(bf_lo(c.z) * fc, bf_hi(c.z) * fc); c.w = pk_bf16(bf_lo(c.w) * fc, bf_hi(c.w) * fc);
                *((u32x4*)(Y + (size_t)row * 1024) + lane) = a; *((u32x4*)(Y + (size_t)row * 1024 + 384) + lane) = c; }
        }
    }
}
constexpr int LDS_FAC = 131072 + 2048;
__device__ __forceinline__ void outproj_factors(int l, unsigned char* ws, LAS unsigned char* lds, int pm, int tid) {
    asm volatile("" : "+v"(tid));
    if (tid < 256) { const int row = pm * 256 + tid; const float* sa = (const float*)(ws + WS_SSQ + PT_A) + ((size_t)l * 16384 + row) * 8; const float* sc = (const float*)(ws + WS_SSQ + PT_C) + ((size_t)l * 16384 + row) * 8;
        const f32x4 a0 = *(const f32x4*)sa, a1 = *(const f32x4*)(sa + 4), c0 = *(const f32x4*)sc, c1 = *(const f32x4*)(sc + 4);
        const float ra = rsqrtf((((a0.x + a0.y) + (a0.z + a0.w)) + (a1.x + a1.y)) * (1.f / 384.f) + 1e-6f), rc = rsqrtf((((c0.x + c0.y) + (c0.z + c0.w)) + (c1.x + c1.y)) * (1.f / 384.f) + 1e-6f);
        LAS float* F = (LAS float*)(lds + LDS_FAC); F[2 * tid] = ra / rc; F[2 * tid + 1] = rc; }
    __syncthreads();
}
struct EpiOut {
    static constexpr bool KHOOK = true;
    bf16_t* XB; float* ssq; const LAS float* F; bool fold;
    __device__ __forceinline__ void kscale(f32x4 (&acc)[2][2][4][2], int which, int wr, int fr) const {
        if (!fold) return;
#pragma unroll
        for (int ai = 0; ai < 2; ++ai)
#pragma unroll
            for (int m = 0; m < 4; ++m) { const float f = F[2 * (ai * 128 + wr * 64 + m * 16 + fr) + which];
#pragma unroll
                for (int bj = 0; bj < 2; ++bj)
#pragma unroll
                    for (int n = 0; n < 2; ++n) acc[ai][bj][m][n] = acc[ai][bj][m][n] * f; }
    }
    __device__ __forceinline__ void operator()(const f32x4 (&acc)[2][2][4][2], const GUnit& u, int wr, int wc, int fr, int fq) const {
#pragma unroll
        for (int ai = 0; ai < 2; ++ai)
#pragma unroll
          for (int mh = 0; mh < 2; ++mh) {
            __builtin_amdgcn_sched_barrier(0);
            u32x4 xr[2][2];
#pragma unroll
            for (int m2 = 0; m2 < 2; ++m2)
#pragma unroll
                for (int bj = 0; bj < 2; ++bj) xr[m2][bj] = *(const u32x4*)(XB + (size_t)(u.pm * 256 + ai * 128 + wr * 64 + (2 * mh + m2) * 16 + fr) * 1024 + u.pn * 256 + bj * 128 + wc * 32 + 8 * fq);
#pragma unroll
            for (int m2 = 0; m2 < 2; ++m2) {
                const int m = 2 * mh + m2; const int row = u.pm * 256 + ai * 128 + wr * 64 + m * 16 + fr; float ss = 0.f;
#pragma unroll
                for (int bj = 0; bj < 2; ++bj) {
                    const u32x4 x = xr[m2][bj]; u32x4 o;
                    o.x = pk_bf16(bf_lo(x.x) + acc[ai][bj][m][0][0], bf_hi(x.x) + acc[ai][bj][m][0][1]); o.y = pk_bf16(bf_lo(x.y) + acc[ai][bj][m][0][2], bf_hi(x.y) + acc[ai][bj][m][0][3]);
                    o.z = pk_bf16(bf_lo(x.z) + acc[ai][bj][m][1][0], bf_hi(x.z) + acc[ai][bj][m][1][1]); o.w = pk_bf16(bf_lo(x.w) + acc[ai][bj][m][1][2], bf_hi(x.w) + acc[ai][bj][m][1][3]);
                    *(u32x4*)(XB + (size_t)row * 1024 + u.pn * 256 + bj * 128 + wc * 32 + 8 * fq) = o;
                    ss += (bf_lo(o.x) * bf_lo(o.x) + bf_hi(o.x) * bf_hi(o.x)) + (bf_lo(o.y) * bf_lo(o.y) + bf_hi(o.y) * bf_hi(o.y)) + (bf_lo(o.z) * bf_lo(o.z) + bf_hi(o.z) * bf_hi(o.z)) + (bf_lo(o.w) * bf_lo(o.w) + bf_hi(o.w) * bf_hi(o.w));
                }
                ss = quad_sum(ss); if (fq == 0) ssq[(size_t)row * 16 + u.pn * 4 + wc] = ss;
            }
          }
    }
};

__device__ __forceinline__ float sum16(const float* p) { const f32x4 a = *(const f32x4*)p, b = *(const f32x4*)(p + 4), c = *(const f32x4*)(p + 8), d = *(const f32x4*)(p + 12);
    return (((a.x + a.y) + (a.z + a.w)) + ((b.x + b.y) + (b.z + b.w))) + (((c.x + c.y) + (c.z + c.w)) + ((d.x + d.y) + (d.z + d.w))); }
__device__ __forceinline__ void phase_route(int l, InPtr in, unsigned char* ws, LAS unsigned char* lds, int bid, int nb, int g_wv) {
    int tid_ = TIDX; asm volatile("" : "+v"(tid_)); const int w = tid_ >> 6, lane = tid_ & 63, r = lane & 15, q = lane >> 4;
    const bf16_t* XB = (const bf16_t*)(ws + WS_XB); const bf16_t* WR = (const bf16_t*)(ws + WS_WR) + (size_t)l * 64 * 1024;
    const float* ssq = (const float*)(ws + WS_SSQ + PT_X1) + (size_t)l * 16384 * 16; const float* bg = in->p[24] + l * 4; const float* be = in->p[26] + l * 32;
    unsigned* cnt = (unsigned*)(ws + WS_CTL) + CW_CNT + 2048 * l; unsigned* mtok = (unsigned*)(ws + WS_META); float* mw = (float*)(ws + WS_META + META_W);
    LAS float* lg = (LAS float*)(lds + w * 4096);
    LAS unsigned* lcnt = (LAS unsigned*)(lds + 32768); LAS unsigned* lbase = lcnt + 32;
    constexpr int WRP = 2064; LAS unsigned char* wrl = lds + 40960;
    { u32x4 st[12];
#pragma unroll
      for (int i = 0; i < 12; ++i) { const int c = tid_ + 512 * i; st[i] = *(const u32x4*)(WR + (size_t)(c >> 7) * 1024 + (c & 127) * 8); }
#pragma unroll
      for (int i = 0; i < 12; ++i) { const int c = tid_ + 512 * i; *(LAS u32x4*)(wrl + (c >> 7) * WRP + (c & 127) * 16) = st[i]; } }
    for (int g0 = bid * 8; g0 < NTOK / 16; g0 += nb * 8) {
        if (tid_ < 32) lcnt[tid_] = 0u;
        __syncthreads();
        const int tok0 = (g0 + w) * 16; f32x4 acc[3];
#pragma unroll
        for (int n = 0; n < 3; ++n) acc[n] = (f32x4){0.f, 0.f, 0.f, 0.f};
        const bf16_t* ap = XB + (size_t)(tok0 + r) * 1024 + 8 * q; const LAS unsigned char* bl_ = wrl + r * WRP + 16 * q;
#pragma unroll 1
        for (int kc = 0; kc < 2; ++kc) {
            bf16x8 a[16];
#pragma unroll
            for (int s = 0; s < 16; ++s) a[s] = *(const bf16x8*)(ap + 32 * (kc * 16 + s));
            __builtin_amdgcn_sched_barrier(0);
#pragma unroll
            for (int s = 0; s < 16; ++s)
#pragma unroll
                for (int n = 0; n < 3; ++n) { const bf16x8 bb = *(const LAS bf16x8*)(bl_ + n * 16 * WRP + 64 * (kc * 16 + s)); acc[n] = MFMA16(a[s], bb, acc[n]); }
            __builtin_amdgcn_sched_barrier(0);
        }
#pragma unroll
        for (int n = 0; n < 3; ++n)
#pragma unroll
            for (int j = 0; j < 4; ++j) lg[(4 * q + j) * 48 + 16 * n + r] = acc[n][j];
        LDS_FENCE();
        int E0 = 0, E1 = 0; unsigned r0 = 0, r1 = 0; float wt0 = 0.f, wt1 = 0.f; const int tok = tok0 + (lane & 15);
        if (lane < 16) {
            const float rs = rsqrtf(sum16(ssq + (size_t)tok * 16) * (1.f / 1024.f) + 1e-6f); ((float*)(ws + WS_RS2))[tok] = rs; const LAS float* L = lg + lane * 48;
            float gl[4]; int gi = 0;
#pragma unroll
            for (int j = 0; j < 4; ++j) gl[j] = L[j] * rs + bg[j];
            float gm = gl[0];
#pragma unroll
            for (int j = 1; j < 4; ++j) if (gl[j] > gm) { gm = gl[j]; gi = j; }
            float gsum = 0.f;
#pragma unroll
            for (int j = 0; j < 4; ++j) gsum += __expf(gl[j] - gm);
            const float gtop = 1.f / gsum;
            float el[8];
#pragma unroll
            for (int j = 0; j < 8; ++j) el[j] = L[4 + gi * 8 + j] * rs + be[gi * 8 + j];
            int e0 = 0; float v0 = el[0];
#pragma unroll
            for (int j = 1; j < 8; ++j) if (el[j] > v0) { v0 = el[j]; e0 = j; }
            int e1 = -1; float v1 = -3.0e38f;
#pragma unroll
            for (int j = 0; j < 8; ++j) if (j != e0 && el[j] > v1) { v1 = el[j]; e1 = j; }
            const float w0 = 1.f / (1.f + __expf(v1 - v0)); E0 = gi * 8 + e0; E1 = gi * 8 + e1; wt0 = w0 * gtop; wt1 = (1.f - w0) * gtop;
            r0 = __hip_atomic_fetch_add(lcnt + E0, 1u, __ATOMIC_RELAXED, __HIP_MEMORY_SCOPE_WORKGROUP); r1 = __hip_atomic_fetch_add(lcnt + E1, 1u, __ATOMIC_RELAXED, __HIP_MEMORY_SCOPE_WORKGROUP);
        }
        __syncthreads();
        if (tid_ < 32) { const unsigned c = lcnt[tid_]; lbase[tid_] = c ? atomicAdd(cnt + tid_ * 64, c) : 0u; }
        __syncthreads();
        if (lane < 16) {
            const unsigned p0 = lbase[E0] + r0, p1 = lbase[E1] + r1;
            mtok[(size_t)E0 * 16384 + p0] = (unsigned)tok; mw[(size_t)E0 * 16384 + p0] = wt0;
            mtok[(size_t)E1 * 16384 + p1] = (unsigned)tok | 0x80000000u; mw[(size_t)E1 * 16384 + p1] = wt1;
        }
        __syncthreads();
    }
}

constexpr int LDS_TB = 131072 + 2048;
__device__ __forceinline__ void moe_tables(int l, unsigned char* ws, LAS unsigned char* lds, int g_wv) {
    int tix = TIDX; asm volatile("" : "+v"(tix));
    LAS int* tb = (LAS int*)(lds + LDS_TB);
    if (tix < 32) { const unsigned* cnt = (const unsigned*)(ws + WS_CTL) + CW_CNT + 2048 * l; tb[160 + tix] = (int)__hip_atomic_load(cnt + tix * 64, __ATOMIC_RELAXED, __HIP_MEMORY_SCOPE_AGENT); }
    __syncthreads();
    if (tix == 0) { int a = 0, f = 0, p = 0; for (int e = 0; e < 32; ++e) { const int c = tb[160 + e]; tb[e] = a; tb[48 + e] = f; tb[96 + e] = p; a += (c + 255) >> 8; f += c >> 8; p += (c & 255) ? 1 : 0; } tb[32] = a; tb[80] = f; tb[128] = p; }
    __syncthreads();
}
template <int NPN, bool GATHER_>
struct MoeSched {
    static constexpr bool GATHER = GATHER_, PARTIAL = false;
    const char* A; const char* Bt; const unsigned* cnt; const unsigned* mtok; const LAS int* tb; int G, c; size_t bstride_e  , bstride_pn; int lo, hi;
    __device__ __forceinline__ bool next(int i, GUnit& u) const {
        const int L = lo + i * G + c; if (L >= hi) return false;
        const int tile = L / NPN, pn = L % NPN;
        int e = 0;
        for (int k = 1; k < 32; ++k) e = (tb[k] <= tile) ? k : e;
        e = __builtin_amdgcn_readfirstlane(e);
        u.e = e; u.pm = tile; u.pn = pn; u.rows = tb[160 + e] - 256 * (tile - tb[e]);
        u.a = GATHER ? A : A + (size_t)tile * 256 * 256 * 2;
        u.b = Bt + (size_t)e * bstride_e + (size_t)pn * bstride_pn; return true;
    }
    __device__ __forceinline__ void aoff(const GUnit& u, unsigned (&v)[2][2], const int (&R)[2], const int (&C)[2]) const {
#pragma unroll
        for (int h = 0; h < 2; ++h)
#pragma unroll
            for (int i = 0; i < 2; ++i) {
                if (GATHER) { const int lr = h * 128 + R[i]; const int rr = 256 * (u.pm - tb[u.e]) + (lr < u.rows ? lr : 0); const unsigned tok = mtok[(size_t)u.e * 16384 + rr] & 0x7fffffffu; v[h][i] = (tok * 1024u + (unsigned)C[i]) * 2u; }
                else v[h][i] = (unsigned)((h * 128 + R[i]) * 256 + C[i]) * 2u;
            }
    }
};
struct EpiMoeUp {
    static constexpr bool KHOOK = false;
    const unsigned* mtok; const float* ssq; const LAS int* tb; bf16_t* HB;
    __device__ __forceinline__ void operator()(const f32x4 (&acc)[2][2][4][2], const GUnit& u, int wr, int wc, int fr, int fq) const {
        const int r0 = 256 * (u.pm - tb[u.e]);
        float rs8[8];
        { unsigned tk[8];
#pragma unroll
          for (int k = 0; k < 8; ++k) { const int lr = (k >> 2) * 128 + wr * 64 + (k & 3) * 16 + fr; tk[k] = mtok[(size_t)u.e * 16384 + r0 + (lr < u.rows ? lr : 0)] & 0x7fffffffu; }
#pragma unroll
          for (int k = 0; k < 8; ++k) rs8[k] = ssq[tk[k]]; }
#pragma unroll
        for (int ai = 0; ai < 2; ++ai)
#pragma unroll
            for (int m = 0; m < 4; ++m) {
                __builtin_amdgcn_sched_barrier(0);
                const int lr = ai * 128 + wr * 64 + m * 16 + fr;
                if (lr < u.rows) {
                    const float rs = rs8[ai * 4 + m];
                    float hv[8];
#pragma unroll
                    for (int n = 0; n < 2; ++n)
#pragma unroll
                        for (int j = 0; j < 4; ++j) { const float gv = acc[ai][0][m][n][j] * rs, uv = acc[ai][1][m][n][j] * rs; hv[4 * n + j] = siluf(gv) * uv; }
                    st_bf16x8(HB + ((size_t)u.pm * 256 + lr) * 256 + u.pn * 128 + wc * 32 + 8 * fq, hv);
                }
            }
    }
};
struct EpiMoeDown {
    static constexpr bool KHOOK = false;
    const unsigned* mtok; const float* mw; const LAS int* tb; bf16_t* YB;
    __device__ __forceinline__ void operator()(const f32x4 (&acc)[2][2][4][2], const GUnit& u, int wr, int wc, int fr, int fq) const {
        const int r0 = 256 * (u.pm - tb[u.e]);
        unsigned mt8[8]; float wt8[8];
#pragma unroll
        for (int k = 0; k < 8; ++k) { const int lr = (k >> 2) * 128 + wr * 64 + (k & 3) * 16 + fr; const size_t ix = (size_t)u.e * 16384 + r0 + (lr < u.rows ? lr : 0); mt8[k] = mtok[ix]; wt8[k] = mw[ix]; }
#pragma unroll
        for (int ai = 0; ai < 2; ++ai)
#pragma unroll
            for (int m = 0; m < 4; ++m) {
                __builtin_amdgcn_sched_barrier(0);
                const int lr = ai * 128 + wr * 64 + m * 16 + fr;
                if (lr < u.rows) {
                    const unsigned mt = mt8[ai * 4 + m]; const float wt = wt8[ai * 4 + m];
                    bf16_t* dst = YB + ((size_t)(mt >> 31) * 16384 + (mt & 0x7fffffffu)) * 1024 + u.pn * 256 + wc * 32 + 8 * fq;
#pragma unroll
                    for (int bj = 0; bj < 2; ++bj) { float v[8];
#pragma unroll
                        for (int n = 0; n < 2; ++n)
#pragma unroll
                            for (int j = 0; j < 4; ++j) v[4 * n + j] = acc[ai][bj][m][n][j] * wt;
                        st_bf16x8(dst + bj * 128, v); }
                }
            }
    }
};
__device__ __forceinline__ void phase_combine(int l, unsigned char* ws, float* out, int bid, int nb, int g_wv) {
    int tid_ = TIDX; asm volatile("" : "+v"(tid_)); const int w = tid_ >> 6, lane = tid_ & 63;
    bf16_t* XB = (bf16_t*)(ws + WS_XB); const bf16_t* Y0 = (const bf16_t*)(ws + WS_YBUF); const bf16_t* Y1 = Y0 + (size_t)16384 * 1024; float* ssqx = (float*)(ws + WS_SSQX) + 16384;
    for (int row = bid * 8 + w; row < NTOK; row += nb * 8) {
        float ss = 0.f;
#pragma unroll
        for (int k = 0; k < 2; ++k) {
            const size_t o = (size_t)row * 1024 + (lane + 64 * k) * 8;
            const u32x4 x = *(const u32x4*)(XB + o), a = *(const u32x4*)(Y0 + o), c = *(const u32x4*)(Y1 + o);
            float v[8] = { bf_lo(x.x) + bf_lo(a.x) + bf_lo(c.x), bf_hi(x.x) + bf_hi(a.x) + bf_hi(c.x), bf_lo(x.y) + bf_lo(a.y) + bf_lo(c.y), bf_hi(x.y) + bf_hi(a.y) + bf_hi(c.y),
                           bf_lo(x.z) + bf_lo(a.z) + bf_lo(c.z), bf_hi(x.z) + bf_hi(a.z) + bf_hi(c.z), bf_lo(x.w) + bf_lo(a.w) + bf_lo(c.w), bf_hi(x.w) + bf_hi(a.w) + bf_hi(c.w) };
            if (l == L_ - 1 && out) { *(f32x4*)(out + o) = (f32x4){v[0], v[1], v[2], v[3]}; *(f32x4*)(out + o + 4) = (f32x4){v[4], v[5], v[6], v[7]}; }
            else { u32x4 p; p.x = pk_bf16(v[0], v[1]); p.y = pk_bf16(v[2], v[3]); p.z = pk_bf16(v[4], v[5]); p.w = pk_bf16(v[6], v[7]); *(u32x4*)(XB + o) = p;
#pragma unroll
                   for (int j = 0; j < 4; ++j) { const unsigned q = j == 0 ? p.x : (j == 1 ? p.y : (j == 2 ? p.z : p.w)); ss += bf_lo(q) * bf_lo(q) + bf_hi(q) * bf_hi(q); } }
        }
        if (l < L_ - 1) { ss = wave_sum(ss); if (lane == 0) ssqx[row] = ss; }
    }
}
constexpr int MOE_CVT_SPLIT = 4608;
#ifndef CVT_A
#define CVT_A 1920
#endif
#ifndef NROUTE
#define NROUTE 128
#endif
constexpr int NPH = 9;
enum { PH_INPROJ = 0, PH_PREP, PH_MIX, PH_YNORM, PH_OUTPROJ, PH_ROUTE, PH_MOEUP, PH_MOEDOWN, PH_COMBINE };
struct Args { Inputs in; float* out; unsigned char* ws; int ph_lo, ph_hi; };

__global__ void __launch_bounds__(512, 2) mk(Args args) {
    extern __shared__ __attribute__((aligned(16))) unsigned char lds_raw[];
    LAS unsigned char* lds = (LAS unsigned char*)lds_raw;
    const int g_wv = __builtin_amdgcn_readfirstlane((int)threadIdx.x >> 6);
    const int bid0 = blockIdx.x, nb = gridDim.x;
#define BID() ({ int b_ = bid0; asm volatile("" : "+s"(b_)); b_; })
    unsigned char* ws = args.ws; unsigned* ctl = (unsigned*)(ws + WS_CTL);
    const int lo = args.ph_lo, hi = args.ph_hi;
    if (TIDX < 4) ((LAS unsigned*)(lds + LDS_MISC))[TIDX] = 0u;
    __syncthreads();
    XcdBarrier bar; bar.g_wv = g_wv; bar.bar = ctl + CW_BAR; bar.x = 0; bar.st = nullptr;
    if (hi - lo > 1) bar = xcd_barrier_post(ctl + CW_BAR, (volatile LAS unsigned*)(lds + LDS_MISC), g_wv);
#define IN(k) (lo <= (k) && (k) < hi)
#ifndef REPEAT_PH
#define REPEAT_PH -1
#endif
#define NREP(k) ((REPEAT_PH == (k)) ? 2 : 1)
#ifndef NBAR
#define NBAR 1
#endif
#ifndef TIME_PH
#define TIME_PH -1
#endif
#define STAMP(i) do { if (TIME_PH != -1 && blockIdx.x == 0 && TIDX == 0) ((unsigned long long*)(ctl + CW_TS))[i] = __builtin_amdgcn_s_memrealtime(); } while (0)
#define SEAM(k) do { if (IN(k) && IN((k) + 1)) for (int nb_ = 0; nb_ < NBAR; ++nb_) xcd_barrier(bar); STAMP((k) + 1); } while (0)
    STAMP(0);
#ifndef NO_PRO
    if (IN(0)) for (int rep = 0; rep < NREP(100); ++rep) { prologue(in_tab(), launder(ws), lds, BID(), nb, g_wv); if (rep + 1 < NREP(100)) xcd_barrier(bar); }
#endif
    SEAM(0);
    for (int l = 0; l < L_; ++l) {
        const int pb = 1 + l * NPH;
        if (IN(pb + PH_INPROJ)) for (int rep = 0; rep < NREP(PH_INPROJ); ++rep) {
            if (rep) xcd_barrier(bar);
            InPtr in = in_tab(); unsigned char* ws = launder(args.ws);
            g8::DenseSched S{(const char*)(ws + WS_XB), (const char*)(ws + WS_WIN) + (size_t)l * 2560 * 1024 * 2, 1024, 1024, 64, 10, nb, BID()};
            EpiInProj E{(const float*)(ws + WS_SSQX) + l * 16384, (float*)(ws + WS_SSQ + PT_DQ) + (size_t)l * 16384 * 4, (float*)(ws + WS_SSQ + PT_DKV) + (size_t)l * 16384 * 2,
                        in->p[8] + l * 64, in->p[9] + l * 64, in->p[19] + l * 192 + 96 + 64, (const float*)(ws + WS_ROPE), ws + WS_PRJ};
#ifndef NO_INPROJ
            g8::gemm_run(lds, 1024, 1024, S, E, g_wv);
#endif
        }
        SEAM(pb + PH_INPROJ);
        if (IN(pb + PH_PREP)) for (int rep = 0; rep < NREP(PH_PREP); ++rep) { if (rep) xcd_barrier(bar); phase_prep(l, in_tab(), launder(ws), lds, BID(), nb, g_wv, (unsigned*)launder(ws) + CW_Q + 64 * (4 + l + 2 * rep)); }
        SEAM(pb + PH_PREP);
        if (IN(pb + PH_MIX)) for (int rep = 0; rep < NREP(PH_MIX); ++rep) { if (rep) xcd_barrier(bar); phase_mix(l, in_tab(), launder(ws), lds, (unsigned*)launder(ws) + CW_Q + 64 * (l + 2 * rep), g_wv); }
        SEAM(pb + PH_MIX);
        const bool fold_norm = (nb == 256);
        if (IN(pb + PH_YNORM) && !fold_norm) phase_ynorm(l, launder(ws), BID(), nb, g_wv);
        if (!fold_norm) SEAM(pb + PH_YNORM);
        if (IN(pb + PH_OUTPROJ)) {
            unsigned char* ws = launder(args.ws);
            g8::DenseSched S{(const char*)(ws + WS_Y), (const char*)(ws + WS_WOUT) + (size_t)l * 1024 * 1024 * 2, 1024, 1024, 64, 4, nb, BID()};
            EpiOut E{(bf16_t*)(ws + WS_XB), (float*)(ws + WS_SSQ + PT_X1) + (size_t)l * 16384 * 16, (const LAS float*)(lds + LDS_FAC), fold_norm};
            if (fold_norm) { g8::GUnit u0; if (S.next(0, u0)) outproj_factors(l, ws, lds, u0.pm, TIDX); else __syncthreads(); }
#ifndef NO_OUTPROJ
            g8::gemm_run(lds, 1024, 1024, S, E, g_wv);
#endif
        }
        SEAM(pb + PH_OUTPROJ);
#ifndef NO_ROUTE
        if (IN(pb + PH_ROUTE)) {
            const int b_ = BID();
            if (nb >= 256 && b_ >= NROUTE) { cvt_moe_layer(in_tab(), launder(ws), l, (LAS float*)lds, b_ - NROUTE, nb - NROUTE, TIDX, 0, CVT_A);
#ifdef DUP_CVT
                __syncthreads(); cvt_moe_layer(in_tab(), launder(ws), l, (LAS float*)lds, b_ - NROUTE, nb - NROUTE, TIDX);
#endif
            }
            else { phase_route(l, in_tab(), launder(ws), lds, b_, nb >= 256 ? NROUTE : nb, g_wv);
                   if (nb < 256) cvt_moe_layer(in_tab(), launder(ws), l, (LAS float*)lds, b_, nb, TIDX); else cvt_moe_layer(in_tab(), launder(ws), l, (LAS float*)lds, b_, NROUTE, TIDX, CVT_A, 3072); }
            if (l + 1 < L_) { __syncthreads(); cvt_small_weights(in_tab(), launder(ws), l + 1, (LAS float*)lds, b_, nb, TIDX); }
        }
#endif
        SEAM(pb + PH_ROUTE);
        {
            const bool do_up = IN(pb + PH_MOEUP), do_dn = IN(pb + PH_MOEDOWN), fuse = do_up && do_dn;
            for (int part = 0; part < (fuse ? 3 : 1); ++part) {
                if (part) xcd_barrier(bar);
                unsigned char* ws = launder(args.ws);
                if (do_up || do_dn) moe_tables(l, ws, lds, g_wv);
                const unsigned* cnt = (const unsigned*)(ws + WS_CTL) + CW_CNT + 2048 * l; const unsigned* mtok = (const unsigned*)(ws + WS_META); const LAS int* tb = (const LAS int*)(lds + LDS_TB);
                const int b_ = BID(), ntile = tb[32], UPU = 2 * ntile, DNU = 4 * ntile;
                const int hi0 = UPU < nb ? UPU : nb, nu_ = UPU - hi0, nu = nu_ < (nb >> 1) ? nu_ : (nb >> 1), nd = nb - nu;
                const int d1a = 4 * (hi0 >> 1), d1b = 2 * nd, D1 = nu == 0 ? DNU : (d1a < d1b ? d1a : d1b);
                int ulo = 0, uhi = UPU, uG = nb, uc = b_, dlo = 0, dhi = DNU, dG = nb, dc = b_;
                if (fuse) {
                    if (part == 0) { uhi = hi0; dhi = 0; }
                    else if (part == 1) { ulo = hi0; uG = nu; if (b_ >= nu) uhi = ulo; dhi = D1; dG = nd; dc = b_ - nu; if (b_ < nu) dhi = 0; }
                    else { uhi = 0; dlo = D1; }
                }
                if (do_up && uhi > ulo) {
                    MoeSched<2, true> S{(const char*)(ws + WS_XB), (const char*)(ws + WS_WMOE), cnt, mtok, tb, uG, uc, (size_t)512 * 1024 * 2, (size_t)256 * 1024 * 2, ulo, uhi};
                    EpiMoeUp E{mtok, (const float*)(ws + WS_RS2), tb, (bf16_t*)(ws + WS_HBUF)};
#ifndef NO_MOEUP
                    g8::gemm_run(lds, 1024, 1024, S, E, g_wv);
#endif
                }
                if (do_dn && dhi > dlo) {
                    MoeSched<4, false> S{(const char*)(ws + WS_HBUF), (const char*)(ws + WS_WMOE + WMOE_WD), cnt, mtok, tb, dG, dc, (size_t)1024 * 256 * 2, (size_t)256 * 256 * 2, dlo, dhi};
                    EpiMoeDown E{mtok, (const float*)(ws + WS_META + META_W), tb, (bf16_t*)(ws + WS_YBUF)};
#ifndef NO_MOEDOWN
                    g8::gemm_run(lds, 256, 256, S, E, g_wv);
#endif
                }
            }
        }
        SEAM(pb + PH_MOEDOWN);
#ifndef NO_COMBINE
        if (IN(pb + PH_COMBINE)) { unsigned char* ws = launder(args.ws); phase_combine(l, ws, args.out, BID(), nb, g_wv); }
#endif
        SEAM(pb + PH_COMBINE);
    }
#undef IN
#undef SEAM
}
#if CHECK
struct NvScratch { float *proj, *h1, *qk, *hraw, *kn, *kcmp, *vcmp, *dqn, *q, *dkvn, *kv, *krope, *y, *x1, *xl; int* rt_e; float* rt_w; };
constexpr int CB = 5;
enum { NS_INPROJ = 0, NS_NSAPREP, NS_MLAPREP, NS_NSA, NS_ML, NS_MLA, NS_OUT, NS_ROUTE, NS_MOE };
static void naive_step(void* const* d_in, int l, int step, const float* xin, float* xout, const NvScratch& S, hipStream_t st) {
    const int b = CB;
    const float* rel_bias = (const float*)d_in[2];
    const float* norm1_g = (const float*)d_in[3] + (long)l * 1024;
    const float* w_in = (const float*)d_in[4] + (long)l * 1024 * DIN;
    const float* cmp_pe = (const float*)d_in[5] + (long)l * 2 * 32 * 64;
    const float* cmp_w1 = (const float*)d_in[6] + (long)l * 2 * 32 * 64 * 64;
    const float* cmp_w2 = (const float*)d_in[7] + (long)l * 2 * 64 * 64;
    const float* q_norm = (const float*)d_in[8] + l * 64;
    const float* k_norm = (const float*)d_in[9] + l * 64;
    const float* nsa_on = (const float*)d_in[10] + l * 384;
    const float* conv = (const float*)d_in[11] + l * 4 * 512;
    const float* ibias = (const float*)d_in[12] + l * 4;
    const float* fbias = (const float*)d_in[13] + l * 4;
    const float* ml_on = (const float*)d_in[14] + l * 256;
    const float* qan = (const float*)d_in[15] + l * 192;
    const float* w_uq = (const float*)d_in[16] + (long)l * 192 * 576;
    const float* kvan = (const float*)d_in[17] + l * 128;
    const float* w_ukv = (const float*)d_in[18] + (long)l * 128 * 768;
    const float* qkn = (const float*)d_in[19] + l * 192;
    const float* mla_on = (const float*)d_in[20] + l * 384;
    const float* w_out = (const float*)d_in[21] + (long)l * 1024 * 1024;
    const float* norm2_g = (const float*)d_in[22] + l * 1024;
    const float* wgrp = (const float*)d_in[23] + (long)l * 1024 * 4;
    const float* bgrp = (const float*)d_in[24] + l * 4;
    const float* wexp = (const float*)d_in[25] + (long)l * 1024 * 32;
    const float* bexp = (const float*)d_in[26] + l * 32;
    const float* Wg = (const float*)d_in[27] + (long)l * 32 * 1024 * 256;
    const float* Wu = (const float*)d_in[28] + (long)l * 32 * 1024 * 256;
    const float* Wd = (const float*)d_in[29] + (long)l * 32 * 256 * 1024;
    const int* pos = (const int*)d_in[1] + b * 2048;
    switch (step) {
    case NS_INPROJ:
        nv_rmsnorm<<<dim3(2048, 1), 64, 0, st>>>(xin, 1024, 0, S.h1, 1024, 0, norm1_g, 0, 1024);
        nv_gemm<<<dim3((DIN + 63) / 64, 2048 / 64), 256, 0, st>>>(S.h1, 1024, w_in, DIN, S.proj, DIN, nullptr, 0, 2048, DIN, 1024);
        break;
    case NS_NSAPREP:
        nv_nsa_cmp<<<dim3(127, 2, 2), 64, 0, st>>>(S.proj, cmp_pe, cmp_w1, cmp_w2, k_norm, S.kcmp, S.vcmp);
        nv_nsa_knorm<<<dim3(2048, 4), 64, 0, st>>>(S.proj, k_norm, S.kn);
        break;
    case NS_MLAPREP:
        nv_rmsnorm<<<dim3(2048, 1), 64, 0, st>>>(S.proj + O_CDQ, DIN, 0, S.dqn, 192, 0, qan, 0, 192);
        nv_gemm<<<dim3(576 / 64, 2048 / 64), 256, 0, st>>>(S.dqn, 192, w_uq, 576, S.q, 576, nullptr, 0, 2048, 576, 192);
        nv_rmsnorm<<<dim3(2048, 1), 64, 0, st>>>(S.proj + O_CDKV, DIN, 0, S.dkvn, 128, 0, kvan, 0, 128);
        nv_gemm<<<dim3(768 / 64, 2048 / 64), 256, 0, st>>>(S.dkvn, 128, w_ukv, 768, S.kv, 768, nullptr, 0, 2048, 768, 128);
        nv_mla_prep<<<dim3(2048, 7), 64, 0, st>>>(S.q, S.kv, S.proj, S.krope, qkn, pos);
        break;
    case NS_NSA:
        nv_nsa_attn<<<dim3(2048, 2), 192, 0, st>>>(S.proj, S.kn, S.kcmp, S.vcmp, rel_bias, q_norm, S.y);
        break;
    case NS_ML:
        nv_ml_conv<<<2048, 512, 0, st>>>(S.proj, conv, S.qk);
        nv_ml_rec<<<4, 256, 0, st>>>(S.proj, S.qk, ibias, fbias, S.hraw);
        nv_ml_fin<<<dim3(2048, 4), 64, 0, st>>>(S.proj, S.hraw, ml_on, S.y);
        break;
    case NS_MLA:
        nv_mla_attn<<<dim3(2048, 6), 64, 0, st>>>(S.q, S.kv, S.krope, S.y);
        break;
    case NS_OUT:
        nv_rmsnorm<<<dim3(2048, 1), 64, 0, st>>>(S.y, 1024, 0, S.y, 1024, 0, nsa_on, 0, 384);
        nv_rmsnorm<<<dim3(2048, 1), 64, 0, st>>>(S.y + 640, 1024, 0, S.y + 640, 1024, 0, mla_on, 0, 384);
        nv_gemm<<<dim3(1024 / 64, 2048 / 64), 256, 0, st>>>(S.y, 1024, w_out, 1024, S.x1, 1024, xin, 1024, 2048, 1024, 1024);
        break;
    case NS_ROUTE:
        nv_moe_route<<<2048, 64, 0, st>>>(S.x1, norm2_g, wgrp, bgrp, wexp, bexp, S.h1, S.rt_e, S.rt_w);
        break;
    case NS_MOE:
        nv_moe_exp<<<2048, 256, 0, st>>>(S.x1, S.h1, S.rt_e, S.rt_w, Wg, Wu, Wd, xout);
        break;
    }
}

__device__ __forceinline__ void chk_commit(float d2, float r2, float* acc) { d2 = wave_sum(d2); r2 = wave_sum(r2); if ((threadIdx.x & 63) == 0) { atomicAdd(acc, d2); atomicAdd(acc + 1, r2); } }
__device__ __forceinline__ void chk_add(float f, float r, float& d2, float& r2) { const float d = f - r; d2 += (d == d) ? d * d : 1e30f; r2 += r * r; }

__global__ void __launch_bounds__(64) chk_proj(const float* nproj, const unsigned char* prj, const float* ssq_dq, const float* ssq_dkv, const float* qg, const float* kg, const float* krg, const int* pos, float* acc) {
    const int t = blockIdx.x, e = threadIdx.x; const size_t row = (size_t)CB * 2048 + t; float d2 = 0.f, r2 = 0.f;
    for (int G = 0; G < 40; ++G) {
        const int c = inproj_refcol(G, e); float r = c < 0 ? 0.f : nproj[(size_t)t * DIN + c]; float f = 0.f;
        const float rr = (G == 37 && e >= 32) ? 0.f : r; const float ss = wave_sum(rr * rr);
        if (G < 6) { r = r * rsqrtf(ss / 64.f + 1e-6f) * qg[e] * 0.18033688f; f = bf2f(((const bf16_t*)(prj + PRJ_QN))[((size_t)(CB * 6 + G) * 2048 + t) * 64 + e]); }
        else if (G < 18) { const int a = G - 6, br = a >> 2, s = (a >> 1) & 1, hk = a & 1;
            if (br > 0 && s == 0) r = r * rsqrtf(ss / 64.f + 1e-6f) * kg[e];
            const size_t base = br == 0 ? (s ? PRJ_C0V : PRJ_C0K) : (br == 1 ? (s ? PRJ_VN1 : PRJ_KN1) : (s ? PRJ_VN2 : PRJ_KN2));
            f = bf2f(((const bf16_t*)(prj + base))[((size_t)(CB * 2 + hk) * 2048 + t) * 64 + e]); }
        else if (G < 26) f = bf2f(((const bf16_t*)(prj + PRJ_RAWQK))[row * 512 + (G - 18) * 64 + e]);
        else if (G < 30) f = bf2f(((const bf16_t*)(prj + PRJ_VML))[((size_t)(CB * 4 + (G - 26)) * 2048 + t) * 64 + e]);
        else if (G < 34) f = bf2f(((const bf16_t*)(prj + PRJ_OG))[row * 256 + (G - 30) * 64 + e]);
        else if (G < 37) f = bf2f(((const bf16_t*)(prj + PRJ_DQKV))[row * 384 + (G - 34) * 64 + e]);
        else if (G == 37) {
            const float val = e < 32 ? rr * rsqrtf(ss / 32.f + 1e-6f) * krg[e & 31] : 0.f; const float oth = __shfl_xor(val, 16);
            if (e < 32) { const int i = e & 15; const double ang = (double)pos[row] * pow(10000.0, -(double)i / 16.0); const float cs = (float)cos(ang), sn = (float)sin(ang);
                r = e < 16 ? val * cs - oth * sn : val * cs + oth * sn; f = bf2f(((const bf16_t*)(prj + PRJ_KR))[row * 32 + e]); }
            else if (e < 58) f = ((const float*)(prj + PRJ_GATES))[row * 32 + (e - 32)];
            else { f = 0.f; r = 0.f; }
        }
        else f = bf2f(((const bf16_t*)(prj + PRJ_DQKV))[row * 384 + 256 + (G - 38) * 64 + e]);
        chk_add(f, r, d2, r2);
    }
    float d2s = 0.f, r2s = 0.f;
    { float s1 = 0.f, s2 = 0.f; for (int c = e; c < 192; c += 64) { float v = nproj[(size_t)t * DIN + O_CDQ + c]; s1 += v * v; } for (int c = e; c < 128; c += 64) { float v = nproj[(size_t)t * DIN + O_CDKV + c]; s2 += v * v; }
      s1 = wave_sum(s1); s2 = wave_sum(s2); if (e == 0) { chk_add((ssq_dq[row * 4] + ssq_dq[row * 4 + 1]) + ssq_dq[row * 4 + 2], s1, d2s, r2s); chk_add(ssq_dkv[row * 2] + ssq_dkv[row * 2 + 1], s2, d2s, r2s); } }
    chk_commit(d2, r2, acc); chk_commit(d2s, r2s, acc + 2);
}

__global__ void __launch_bounds__(64) chk_prep(const float* nq, const float* nkv, const float* nkr, const float* nkc, const float* nvc, const unsigned char* ws, float* acc) {
    const int t = blockIdx.x, e = threadIdx.x; float d2 = 0.f, r2 = 0.f, d2c = 0.f, r2c = 0.f; const float scale = 0.14724444f;
    const bf16_t* QM = (const bf16_t*)(ws + WS_MLA); const bf16_t* KM = (const bf16_t*)(ws + WS_MLA + MLA_KM); const bf16_t* VM = (const bf16_t*)(ws + WS_MLA + MLA_VM);
    for (int h = 0; h < 6; ++h) {
        const size_t rq = ((size_t)(CB * 6 + h) * 2048 + t);
        chk_add(bf2f(QM[rq * 96 + e]), nq[(size_t)t * 576 + h * 96 + e] * scale, d2, r2);
        chk_add(bf2f(KM[rq * 96 + e]), nkv[(size_t)t * 768 + h * 128 + e], d2, r2);
        chk_add(bf2f(VM[rq * 64 + e]), nkv[(size_t)t * 768 + h * 128 + 64 + e], d2, r2);
        if (e < 32) { chk_add(bf2f(QM[rq * 96 + 64 + e]), nq[(size_t)t * 576 + h * 96 + 64 + e] * scale, d2, r2); chk_add(bf2f(KM[rq * 96 + 64 + e]), nkr[(size_t)t * 32 + e], d2, r2); }
    }
    if (t < 128) for (int hk = 0; hk < 2; ++hk) {
        const bf16_t* KC = (const bf16_t*)(ws + WS_CMP); const bf16_t* VC = (const bf16_t*)(ws + WS_CMP + CMP_V); const size_t rf = ((size_t)(CB * 2 + hk) * 128 + t) * 64 + e;
        chk_add(bf2f(KC[rf]), t < 127 ? nkc[(size_t)(hk * 127 + t) * 64 + e] : 0.f, d2c, r2c); chk_add(bf2f(VC[rf]), t < 127 ? nvc[(size_t)(hk * 127 + t) * 64 + e] : 0.f, d2c, r2c);
    }
    chk_commit(d2, r2, acc); chk_commit(d2c, r2c, acc + 2);
}

__global__ void __launch_bounds__(64) chk_y(const float* ny, const unsigned char* ws, float* acc, int nseg) {
    const int t = blockIdx.x, e = threadIdx.x; const bf16_t* Y = (const bf16_t*)(ws + WS_Y) + ((size_t)CB * 2048 + t) * 1024;
    float d2[3] = {0.f, 0.f, 0.f}, r2[3] = {0.f, 0.f, 0.f};
    for (int c = e; c < 1024; c += 64) { const int seg = c < 384 ? 0 : (c < 640 ? 1 : 2); const int cf = c < 384 ? c : (c < 640 ? 768 + (c - 384) : 384 + (c - 640)); const float f = bf2f(Y[cf]), r = ny[(size_t)t * 1024 + c];
        if (seg == 0) chk_add(f, r, d2[0], r2[0]); else if (seg == 1) chk_add(f, r, d2[1], r2[1]); else chk_add(f, r, d2[2], r2[2]); }
    if (nseg == 3) { chk_commit(d2[0], r2[0], acc); chk_commit(d2[1], r2[1], acc + 2); chk_commit(d2[2], r2[2], acc + 4); }
    else chk_commit(d2[0] + d2[1] + d2[2], r2[0] + r2[1] + r2[2], acc);
}

__global__ void __launch_bounds__(64) chk_x(const float* nx, const unsigned char* ws, float* acc) {
    const int t = blockIdx.x, e = threadIdx.x; const bf16_t* X = (const bf16_t*)(ws + WS_XB) + ((size_t)CB * 2048 + t) * 1024; float d2 = 0.f, r2 = 0.f;
    for (int c = e; c < 1024; c += 64) chk_add(bf2f(X[c]), nx[(size_t)t * 1024 + c], d2, r2);
    chk_commit(d2, r2, acc);
}

__global__ void __launch_bounds__(512) chk_code(float* acc, int nst, const float* nout) {
    __shared__ float sh[512];
    float s = 0.f; for (int i = threadIdx.x; i < 2048 * 1024; i += 512) { float v = nout[i]; s += v * v; }
    sh[threadIdx.x] = s; __syncthreads();
    if (threadIdx.x == 0) { float tot = 0.f; for (int i = 0; i < 512; ++i) tot += sh[i]; float rms = sqrtf(tot / (2048.f * 1024.f)); if (!(rms > 1e-3f && rms < 1e3f)) rms = 1.f;
        int code = 0;
        for (int st = 0; st < nst; ++st) { const float d2 = acc[2 * st], r2 = acc[2 * st + 1]; if (r2 == 0.f && d2 == 0.f) { if ((st & 15) >= 9) continue; code = (st + 1) * 4 + 3; break; } const float err = d2 / fmaxf(r2, 1e-30f);
            const float tol = CHK_TOL(st);
            if (!(err <= tol)) { const int cls = !(err < 1.f) ? 3 : (err >= 0.1f ? 2 : (err >= 0.01f ? 1 : 0)); code = (st + 1) * 4 + cls; break; } }
        acc[2 * 40] = rms * 32.f * exp2f(0.5f * (float)code); }
}
__global__ void __launch_bounds__(512) chk_fill(const float* acc, float* out) {
    const float K = acc[2 * 40];
    for (size_t i = (size_t)blockIdx.x * 512 + threadIdx.x; i < (size_t)NTOK * 1024; i += (size_t)gridDim.x * 512) out[i] = (i & 1) ? -K : K;
}
#endif

#if TIME_PH != -1
#ifndef TIME_Q
#define TIME_Q 6.f
#endif
#ifndef TIME_CAL
#define TIME_CAL 1.0f
#endif
__global__ void tm_acc(const unsigned long long* ts, float* best, int first) {
    int a = TIME_PH, b = TIME_PH + 1;
#ifdef TIME_PH_END
    b = TIME_PH_END;
#endif
    float T = 100.f; if (TIME_PH >= 0) T = (float)(ts[b] - ts[a]) * 0.01f;
    if (first || T < *best) *best = T;
}
__global__ void __launch_bounds__(512) tm_fill(const float* best, float* out) {
    float T = *best;
    T = exp2f(rintf(log2f(fmaxf(T, 1.f)) * TIME_Q) / TIME_Q);
    const float c = sqrtf(T) * TIME_CAL;
    for (size_t i = (size_t)blockIdx.x * 512 + threadIdx.x; i < (size_t)NTOK * 1024; i += (size_t)gridDim.x * 512) out[i] = (i & 1) ? -c : c;
}
#endif
static int g_grid = 0;
static bool setup_once(size_t ws_size) {
    if (g_grid) return g_grid > 0;
    if (ws_size < WS_END) { fprintf(stderr, "kernel_launch: workspace too small: %zu < %zu\n", ws_size, (size_t)WS_END); g_grid = -1; return false; }
    int dev = 0, cus = 0, per_cu = 0;
    if (hipGetDevice(&dev) != hipSuccess || hipDeviceGetAttribute(&cus, hipDeviceAttributeMultiprocessorCount, dev) != hipSuccess) { g_grid = -1; return false; }
    if (hipFuncSetAttribute((const void*)mk, hipFuncAttributeMaxDynamicSharedMemorySize, LDS_BYTES) != hipSuccess) { fprintf(stderr, "kernel_launch: hipFuncSetAttribute failed\n"); g_grid = -1; return false; }
    if (hipOccupancyMaxActiveBlocksPerMultiprocessor(&per_cu, (const void*)mk, 512, LDS_BYTES) != hipSuccess || per_cu < 1) { fprintf(stderr, "kernel_launch: occupancy query says %d\n", per_cu); }
    (void)hipGetLastError();
    g_grid = cus;
    return true;
}
static void launch_mk(const Args& a0, int lo, int hi, hipStream_t stream) { Args a = a0; a.ph_lo = lo; a.ph_hi = hi; hipLaunchKernelGGL(mk, dim3(g_grid), dim3(512), LDS_BYTES, stream, a); }

extern "C" void kernel_launch(void* const* d_in, const int* in_sizes, int n_in, void* d_out, int out_size, void* d_ws, size_t ws_size, hipStream_t stream) {
    if (!setup_once(ws_size)) return;
    unsigned char* ws = (unsigned char*)d_ws;
    (void)hipMemsetAsync(ws + WS_CTL, 0, ZERO_BYTES, stream);
    Args a{}; for (int i = 0; i < 30; ++i) a.in.p[i] = (const float*)d_in[i];
    a.out = (float*)d_out; a.ws = ws; a.ph_lo = 0; a.ph_hi = 0;
#if CHECK
    a.out = nullptr;
#endif
#if CHECK
    float* nb = (float*)d_out; size_t off = 0; NvScratch S;
    auto take = [&](size_t n) { float* p = nb + off; off += (n + 63) & ~(size_t)63; return p; };
    S.proj = take((size_t)2048 * DIN); S.h1 = take(2048 * 1024); S.qk = S.h1; S.hraw = S.qk + 2048 * 512; S.kn = S.hraw + 2048 * 256;
    S.kcmp = take(2 * 127 * 64); S.vcmp = take(2 * 127 * 64); S.dqn = take(2048 * 192); S.q = take(2048 * 576); S.dkvn = take(2048 * 128); S.kv = take(2048 * 768); S.x1 = S.dqn;
    S.krope = take(2048 * 32); S.y = take(2048 * 1024); S.xl = take(2048 * 1024); S.rt_e = (int*)take(2048 * 2); S.rt_w = take(2048 * 2);
    if (off * 4 > (size_t)NTOK * 1024 * 4) { fprintf(stderr, "naive scratch too big\n"); return; }
    float* acc = (float*)(ws + WS_CTL) + CW_CHK;
    launch_mk(a, 0, 1, stream);
    const float* nx_in = (const float*)d_in[0] + (size_t)CB * 2048 * 1024;
    int nst = 0;
    for (int l = 0; l < L_; ++l) {
        const int pb = 1 + l * NPH; const int sb = l * 16;
        launch_mk(a, pb + PH_INPROJ, pb + PH_INPROJ + 1, stream);
        naive_step(d_in, l, NS_INPROJ, nx_in, S.xl, S, stream);
        chk_proj<<<2048, 64, 0, stream>>>(S.proj, ws + WS_PRJ, (const float*)(ws + WS_SSQ + PT_DQ) + (size_t)l * 16384 * 4, (const float*)(ws + WS_SSQ + PT_DKV) + (size_t)l * 16384 * 2,
                                           (const float*)d_in[8] + l * 64, (const float*)d_in[9] + l * 64, (const float*)d_in[19] + l * 192 + 160, (const int*)d_in[1], acc + 2 * (sb + 0));
        nst = sb + 2;
        int ns_done = NS_INPROJ;
#if CHECK_UPTO >= 1
        launch_mk(a, pb + PH_PREP, pb + PH_PREP + 1, stream);
        naive_step(d_in, l, NS_NSAPREP, nx_in, S.xl, S, stream); naive_step(d_in, l, NS_MLAPREP, nx_in, S.xl, S, stream); ns_done = NS_MLAPREP;
        chk_prep<<<2048, 64, 0, stream>>>(S.q, S.kv, S.krope, S.kcmp, S.vcmp, ws, acc + 2 * (sb + 2));
        nst = sb + 4;
#endif
#if CHECK_UPTO >= 2
        launch_mk(a, pb + PH_MIX, pb + PH_MIX + 1, stream);
        naive_step(d_in, l, NS_NSA, nx_in, S.xl, S, stream); naive_step(d_in, l, NS_ML, nx_in, S.xl, S, stream); naive_step(d_in, l, NS_MLA, nx_in, S.xl, S, stream); ns_done = NS_MLA;
        chk_y<<<2048, 64, 0, stream>>>(S.y, ws, acc + 2 * (sb + 4), 3);
        nst = sb + 7;
#endif
#if CHECK_UPTO >= 3
        launch_mk(a, pb + PH_YNORM, pb + PH_YNORM + 1, stream); launch_mk(a, pb + PH_OUTPROJ, pb + PH_OUTPROJ + 1, stream);
        naive_step(d_in, l, NS_OUT, nx_in, S.xl, S, stream); ns_done = NS_OUT;
        chk_x<<<2048, 64, 0, stream>>>(S.x1, ws, acc + 2 * (sb + 7));
        nst = sb + 8;
#endif
#if CHECK_UPTO >= 4
        for (int ph = PH_ROUTE; ph <= PH_COMBINE; ++ph) launch_mk(a, pb + ph, pb + ph + 1, stream);
        naive_step(d_in, l, NS_ROUTE, nx_in, S.xl, S, stream); naive_step(d_in, l, NS_MOE, nx_in, S.xl, S, stream); ns_done = NS_MOE;
        chk_x<<<2048, 64, 0, stream>>>(S.xl, ws, acc + 2 * (sb + 8));
        nst = sb + 9;
#endif
        CHECK_REST
        for (int s = ns_done + 1; s <= NS_MOE; ++s) naive_step(d_in, l, s, nx_in, S.xl, S, stream);
        nx_in = S.xl;
        if (l == CHECK_LAYERS - 1) break;
    }
    chk_code<<<1, 512, 0, stream>>>(acc, nst, S.xl);
    chk_fill<<<1024, 512, 0, stream>>>(acc, (float*)d_out);
#else
#if defined(SPLIT_LAUNCH) && SPLIT_LAUNCH
    for (int ph = 0; ph < 1 + L_ * NPH; ++ph) launch_mk(a, ph, ph + 1, stream);
#else
    launch_mk(a, 0, 1 + L_ * NPH, stream);
#if TIME_PH != -1
    for (int rp = 0; rp < 6; ++rp) {
        (void)hipMemsetAsync(ws + WS_CTL, 0, ZERO_BYTES, stream); launch_mk(a, 0, 1 + L_ * NPH, stream);
        tm_acc<<<1, 1, 0, stream>>>((const unsigned long long*)((unsigned*)(ws + WS_CTL) + CW_TS), (float*)(ws + WS_META + META_RT), rp == 0);
    }
    tm_fill<<<1024, 512, 0, stream>>>((const float*)(ws + WS_META + META_RT), (float*)d_out);
#endif
#endif
#endif
}
```

```cpp
#define CHECK 0
#define CHECK_LAYERS 2
#define CHECK_UPTO 99
#define SPLIT_LAUNCH 0
#define REPEAT_PH -1
#include <hip/hip_runtime.h>
#include <stdint.h>
#include <cstdio>

constexpr int B_ = 8, T_ = 2048, D_ = 1024, L_ = 2, NTOK = B_ * T_;
constexpr int DIN = 2554;
constexpr int O_AQ = 0, O_AKV = 384, O_AG = 1152, O_BQK = 1170, O_BV = 1682, O_BIF = 1938, O_BO = 1946, O_CDQ = 2202, O_CDKV = 2394, O_CKR = 2522;

typedef unsigned short bf16_t;
typedef short bf16x8 __attribute__((ext_vector_type(8)));
typedef short s16x4 __attribute__((ext_vector_type(4)));
typedef float f32x4 __attribute__((ext_vector_type(4)));
typedef float f32x16 __attribute__((ext_vector_type(16)));
typedef unsigned u32x4 __attribute__((ext_vector_type(4)));
typedef unsigned u32x2 __attribute__((ext_vector_type(2)));
typedef float f32x2_t __attribute__((ext_vector_type(2)));
typedef __bf16 bf16x2_t __attribute__((ext_vector_type(2)));
#define LAS __attribute__((address_space(3)))

__device__ __forceinline__ unsigned pk_bf16(float lo, float hi) { f32x2_t v = {lo, hi}; bf16x2_t b = __builtin_convertvector(v, bf16x2_t); return __builtin_bit_cast(unsigned, b); }
__device__ __forceinline__ float bf_lo(unsigned u) { return __builtin_bit_cast(float, u << 16); }
__device__ __forceinline__ float bf_hi(unsigned u) { return __builtin_bit_cast(float, u & 0xffff0000u); }
__device__ __forceinline__ float bf2f(bf16_t h) { return __builtin_bit_cast(float, (unsigned)h << 16); }
__device__ __forceinline__ bf16_t f2bf(float f) { return (bf16_t)(pk_bf16(f, 0.f) & 0xffffu); }
template <int M> __device__ __forceinline__ int shx(int v) { static_assert(M > 0 && M < 32, "swizzle xor mask"); return __builtin_amdgcn_ds_swizzle(v, (M << 10) | 0x1f); }
template <int M> __device__ __forceinline__ float shx(float v) { return __builtin_bit_cast(float, shx<M>(__builtin_bit_cast(int, v))); }
template <int M> __device__ __forceinline__ unsigned shx(unsigned v) { return (unsigned)shx<M>((int)v); }
__device__ __forceinline__ float wave_sum(float v) { v += __shfl_xor(v, 32); v += shx<16>(v); v += shx<8>(v); v += shx<4>(v); v += shx<2>(v); v += shx<1>(v); return v; }
__device__ __forceinline__ float wave_max(float v) { v = fmaxf(v, __shfl_xor(v, 32)); v = fmaxf(v, shx<16>(v)); v = fmaxf(v, shx<8>(v)); v = fmaxf(v, shx<4>(v)); v = fmaxf(v, shx<2>(v)); v = fmaxf(v, shx<1>(v)); return v; }
__device__ __forceinline__ float siluf(float x) { return x * __builtin_amdgcn_rcpf(1.f + __expf(-x)); }
__device__ __forceinline__ float sigmf(float x) { return __builtin_amdgcn_rcpf(1.f + __expf(-x)); }
__device__ __forceinline__ int t5b(int dist) {
    int n = dist > 0 ? dist : 0; if (n < 16) return n;
    float v = logf((float)n / 16.f) / logf(8.f) * 16.f; int l = 16 + (int)v; return l < 31 ? l : 31;
}

__device__ __forceinline__ int lane_now() { return (int)__builtin_amdgcn_mbcnt_hi(~0u, __builtin_amdgcn_mbcnt_lo(~0u, 0u)); }
#define TIDX ((g_wv << 6) | lane_now())

constexpr size_t WS_CTL = 0, CTL_BYTES = 65536;
constexpr size_t WS_SSQ = WS_CTL + CTL_BYTES;
constexpr size_t ZERO_BYTES = CTL_BYTES;
constexpr size_t PT_DQ = 0, PT_DKV = PT_DQ + (size_t)2 * 16384 * 4 * 4, PT_A = PT_DKV + (size_t)2 * 16384 * 2 * 4, PT_C = PT_A + (size_t)2 * 16384 * 8 * 4, PT_X1 = PT_C + (size_t)2 * 16384 * 8 * 4, PT_END = PT_X1 + (size_t)2 * 16384 * 16 * 4;
constexpr size_t WS_SSQX = WS_SSQ + PT_END;
constexpr size_t WS_RS2 = WS_SSQX + 2 * 65536;
constexpr size_t WS_WIN = WS_RS2 + 65536;
constexpr size_t WS_WOUT = WS_WIN + (size_t)2 * 2560 * 1024 * 2;
constexpr size_t WS_WUQ = WS_WOUT + (size_t)2 * 1024 * 1024 * 2;
constexpr size_t WS_WUKV = WS_WUQ + (size_t)2 * 768 * 256 * 2;
constexpr size_t WS_WC1 = WS_WUKV + (size_t)2 * 768 * 256 * 2;
constexpr size_t WS_WC2 = WS_WC1 + (size_t)2 * 2 * 64 * 2048 * 2;
constexpr size_t WS_WR = WS_WC2 + (size_t)2 * 2 * 64 * 64 * 2;
constexpr size_t WS_B1C = WS_WR + (size_t)2 * 64 * 1024 * 2;
constexpr size_t WS_BIASD = WS_B1C + 1024;
constexpr size_t WS_ROPE = WS_BIASD + 6 * 2048 * 4;
constexpr size_t WS_WMOE = WS_ROPE + (size_t)16384 * 32 * 4;
constexpr size_t WMOE_WD = (size_t)32 * 512 * 1024 * 2;
constexpr size_t WS_XB = WS_WMOE + 50331648;
constexpr size_t WS_MLA = WS_XB + 33554432;
constexpr size_t MLA_KM = (size_t)8 * 6 * 2048 * 96 * 2, MLA_VM = 2 * MLA_KM;
constexpr size_t WS_HBUF = WS_MLA;
constexpr size_t WS_PRJ = WS_MLA + 50331648;
constexpr size_t HM64 = (size_t)2048 * 64 * 2;
constexpr size_t PRJ_QN = 0;
constexpr size_t PRJ_KN1 = PRJ_QN + 48 * HM64, PRJ_VN1 = PRJ_KN1 + 16 * HM64, PRJ_KN2 = PRJ_VN1 + 16 * HM64, PRJ_VN2 = PRJ_KN2 + 16 * HM64;
constexpr size_t PRJ_VML = PRJ_VN2 + 16 * HM64;
constexpr size_t PRJ_OG = PRJ_VML + 32 * HM64;
constexpr size_t PRJ_KR = PRJ_OG + (size_t)16384 * 256 * 2;
constexpr size_t PRJ_GATES = PRJ_KR + (size_t)16384 * 32 * 2;
constexpr size_t PRJ_DEAD = PRJ_GATES + (size_t)16384 * 32 * 4;
constexpr size_t PRJ_C0K = PRJ_DEAD, PRJ_C0V = PRJ_C0K + 16 * HM64 + 8192;
constexpr size_t PRJ_RAWQK = PRJ_C0V + 16 * HM64 + 8192;
constexpr size_t PRJ_DQKV = PRJ_RAWQK + (size_t)16384 * 512 * 2;
constexpr size_t PRJ_END = PRJ_DQKV + (size_t)16384 * 384 * 2;
static_assert(PRJ_END - PRJ_DEAD >= 33554432, "Y fits the dead part of PRJ");
constexpr size_t WS_Y = WS_PRJ + PRJ_DEAD;
constexpr size_t WS_YBUF = WS_PRJ;
static_assert((size_t)2 * 16384 * 1024 * 2 <= PRJ_END, "YBUF fits the PRJ region");
constexpr size_t WS_ML = WS_PRJ + PRJ_END;
constexpr size_t ML_KC = 32 * HM64, ML_DELTA = 2 * ML_KC, ML_DN = ML_DELTA + (size_t)1024 * 4096 * 2, ML_G = ML_DN + (size_t)1024 * 64 * 4, ML_BL = ML_G + (size_t)8 * 4 * 2048 * 2 * 4, ML_CP = ML_BL + 4096, ML_NP = ML_CP + (size_t)1024 * 4096 * 2, ML_END = ML_NP + (size_t)1024 * 64 * 2;
constexpr size_t WS_CMP = WS_ML + ML_END;
constexpr size_t CMP_V = (size_t)8 * 2 * 128 * 64 * 2;
constexpr size_t WS_META = WS_CMP + 2 * CMP_V;
constexpr size_t META_W = (size_t)32 * 16384 * 4, META_RT = 2 * META_W;
constexpr size_t WS_END = WS_META + META_RT + (size_t)16384 * 16;
constexpr int CW_BAR = 0;
constexpr int CW_Q = 4096;
constexpr int CW_SCAN = 4608;
constexpr int CW_TS = 4864;
constexpr int CW_CHK = 5120;
constexpr int CW_CNT = 8192;
constexpr int LDS_BYTES = 147456;
constexpr int LDS_MISC = LDS_BYTES - 256;
#define XB_TMO      128
#define XB_XCNT(j)  (256  + 64 * (j))
#define XB_XSUB(j)  (1280 + 64 * (j))
#define XB_XGEN(j)  (2304 + 64 * (j))
#define XB_TOP      3328
#define XB_TOPGEN   3392
#define XCD_BAR_WORDS 3456
#define XB_SPIN_CAP (1u << 18)

__device__ __forceinline__ unsigned xb_ld(unsigned* p)              { return __hip_atomic_load(p, __ATOMIC_RELAXED, __HIP_MEMORY_SCOPE_AGENT); }
__device__ __forceinline__ unsigned xb_add(unsigned* p, unsigned v) { return __hip_atomic_fetch_add(p, v, __ATOMIC_RELAXED, __HIP_MEMORY_SCOPE_AGENT); }
__device__ __forceinline__ unsigned xb_xcc_id() { return (unsigned)__builtin_amdgcn_s_getreg((3 << 11) | 20) & 0xFu; }
#define XB_SPIN(cond, bar) do { unsigned _sp = 0; while (cond) { __builtin_amdgcn_s_sleep(1); \
    if ((++_sp & 255u) == 0u) { if (xb_ld(&(bar)[XB_TMO])) break; if (_sp > XB_SPIN_CAP) { atomicAdd(&(bar)[XB_TMO], 1u); break; } } } } while (0)

struct XcdBarrier {
    int g_wv; unsigned* bar; unsigned x;
    volatile LAS unsigned* st;
};

__device__ __forceinline__ XcdBarrier xcd_barrier_post(unsigned* bar, volatile LAS unsigned* st, int g_wv) {
    XcdBarrier b; b.g_wv = g_wv; b.bar = bar; b.x = xb_xcc_id(); b.st = st;
    if (TIDX == 0) (void)xb_add(&bar[XB_XCNT(b.x)], 1u);
    return b;
}
__device__ __forceinline__ void xcd_barrier_complete(unsigned* bar, unsigned x, unsigned& nloc, unsigned& nx) {
    const unsigned G = gridDim.x * gridDim.y * gridDim.z;
    unsigned sum, cnt, mine, sp = 0u;
    for (;;) {
        sum = 0u; cnt = 0u; mine = 0u;
#pragma unroll
        for (unsigned j = 0; j < 16; ++j) { const unsigned c = xb_ld(&bar[XB_XCNT(j)]); sum += c; cnt += (c > 0u) ? 1u : 0u; mine = (j == x) ? c : mine; }
        if (sum == G) break;
        __builtin_amdgcn_s_sleep(1);
        if ((++sp & 255u) == 0u) { if (xb_ld(&bar[XB_TMO])) break; if (sp > XB_SPIN_CAP) { atomicAdd(&bar[XB_TMO], 1u); break; } }
    }
    nloc = mine > 0u ? mine : 1u; nx = cnt > 0u ? cnt : 1u;
}

__device__ __forceinline__ void xcd_barrier(const XcdBarrier& b) {
    asm volatile("s_waitcnt vmcnt(0)" ::: "memory");
    __syncthreads();
    const int g_wv = b.g_wv;
    if (TIDX == 0) {
        unsigned* bar = b.bar;
        __builtin_amdgcn_s_waitcnt(0);
        unsigned nloc = b.st[0], nx = b.st[1];
        if (nloc == 0u) { xcd_barrier_complete(bar, b.x, nloc, nx); b.st[0] = nloc; b.st[1] = nx; }
        const unsigned old = xb_add(&bar[XB_XSUB(b.x)], 1u);
        const unsigned gen = old / nloc;
        if (old + 1u == (gen + 1u) * nloc) {
            __builtin_amdgcn_fence(__ATOMIC_RELEASE, "agent");
            asm volatile("s_waitcnt vmcnt(0)" ::: "memory");
            const unsigned og = xb_add(&bar[XB_TOP], 1u);
            const unsigned tg = og / nx;
            if (og + 1u == (tg + 1u) * nx) xb_add(&bar[XB_TOPGEN], 1u);
            else XB_SPIN(xb_ld(&bar[XB_TOPGEN]) == tg, bar);
            __builtin_amdgcn_fence(__ATOMIC_ACQUIRE, "agent");
            xb_add(&bar[XB_XGEN(b.x)], 1u);
            asm volatile("s_waitcnt vmcnt(0)" ::: "memory");
        } else {
            XB_SPIN(xb_ld(&bar[XB_XGEN(b.x)]) == gen, bar);
            __builtin_amdgcn_fence(__ATOMIC_ACQUIRE, "agent");
            asm volatile("s_waitcnt vmcnt(0)" ::: "memory");
        }
    }
    __syncthreads();
}
struct Inputs { const float* p[30]; };
typedef const __attribute__((address_space(4))) Inputs* InPtr;
__device__ __forceinline__ InPtr in_tab() { InPtr p = (InPtr)__builtin_amdgcn_kernarg_segment_ptr(); asm volatile("" : "+s"(p)); return p; }
__device__ __forceinline__ unsigned char* launder(unsigned char* p) { size_t z = 0; asm volatile("" : "+s"(z)); return p + z; }

__host__ __device__ inline int inproj_refcol(int G, int e) {
    if (G < 6) return O_AQ + G * 64 + e;
    if (G < 18) return O_AKV + (G - 6) * 64 + e;
    if (G < 26) return O_BQK + (G - 18) * 64 + e;
    if (G < 30) return O_BV + (G - 26) * 64 + e;
    if (G < 34) return O_BO + (G - 30) * 64 + e;
    if (G < 37) return O_CDQ + (G - 34) * 64 + e;
    if (G == 37) { if (e < 32) return O_CKR + e; if (e < 50) return O_AG + (e - 32); if (e < 58) return O_BIF + (e - 50); return -1; }
    return O_CDKV + (G - 38) * 64 + e;
}
__host__ __device__ inline int uq_refcol(int G, int e) {
    if (G < 6) return G * 96 + e;
    if (G < 9) { const int idx = e & 31, bj = e >> 5, sub = idx >> 4, i = idx & 15; return (2 * (G - 6) + sub) * 96 + 64 + bj * 16 + i; }
    return -1;
}
__host__ __device__ inline int ukv_refcol(int G, int e) { return G < 6 ? G * 128 + e : (G - 6) * 128 + 64 + e; }
#define N2G(n) ((((n) >> 8) << 2) + (((n) >> 5) & 3))
#define N2E(n) (((((n) >> 7) & 1) << 5) + ((n) & 31))

__device__ __forceinline__ float opaque_f(float v) { asm volatile("" : "+v"(v)); return v; }
struct FWin { const float* w; const float* g; __device__ __forceinline__ void ld(int k, int n, const float*& p, float& gn, float gk) const { const int c = inproj_refcol(N2G(n), N2E(n)); p = w + (size_t)k * DIN + (c < 0 ? 0 : c); gn = c < 0 ? 0.f : gk; }
    __device__ __forceinline__ float rowgain(int k) const { return opaque_f(g[k]); } };
struct FWout { const float* w; const float* ga; const float* gc; __device__ __forceinline__ void ld(int k, int n, const float*& p, float& gn, float gk) const {
    const int kr = k < 384 ? k : (k < 768 ? 640 + (k - 384) : 384 + (k - 768)); p = w + (size_t)kr * 1024 + n; gn = gk; }
    __device__ __forceinline__ float rowgain(int k) const { const float a = opaque_f(ga[k < 384 ? k : 0]), c = opaque_f(gc[(k >= 384 && k < 768) ? k - 384 : 0]); return k < 384 ? a : (k < 768 ? c : 1.f); } };
struct FWuq { const float* w; const float* g; __device__ __forceinline__ void ld(int k, int n, const float*& p, float& gn, float gk) const { const int c = uq_refcol(N2G(n), N2E(n)); const int kk = k < 192 ? k : 191; p = w + (size_t)kk * 576 + (c < 0 ? 0 : c); gn = (k < 192 && c >= 0) ? gk : 0.f; }
    __device__ __forceinline__ float rowgain(int k) const { return opaque_f(g[k < 192 ? k : 191]); } };
struct FWukv { const float* w; const float* g; __device__ __forceinline__ void ld(int k, int n, const float*& p, float& gn, float gk) const { const int c = ukv_refcol(N2G(n), N2E(n)); const int kk = k >= 128 ? k - 128 : 0; p = w + (size_t)kk * 768 + c; gn = k >= 128 ? gk : 0.f; }
    __device__ __forceinline__ float rowgain(int k) const { return opaque_f(g[k >= 128 ? k - 128 : 0]); } };
struct FWc1 { const float* w; __device__ __forceinline__ void ld(int k, int n, const float*& p, float& gn, float gk) const { p = w + (size_t)k * 64 + n; gn = 1.f; }
    __device__ __forceinline__ float rowgain(int k) const { return 1.f; } };
struct FWr { const float* wg; const float* we; const float* g; __device__ __forceinline__ void ld(int k, int n, const float*& p, float& gn, float gk) const { p = n < 4 ? wg + k * 4 + n : we + k * 32 + (n < 36 ? n - 4 : 0); gn = n < 36 ? gk : 0.f; }
    __device__ __forceinline__ float rowgain(int k) const { return opaque_f(g[k]); } };
struct FWgu { const float* src; const float* g; int n0, col0; __device__ __forceinline__ float operator()(int k, int n) const { return src[(size_t)k * 256 + col0 + (n - n0)] * g[k]; } };
struct FWd { const float* w; __device__ __forceinline__ float operator()(int k, int n) const { return w[(size_t)k * 1024 + n]; } };

__device__ __forceinline__ void rope_cs(int pos, int j, float& cs, float& sn) {
    const double inv = exp2(-(double)j * (13.287712379549449 / 16.0));
    const double rev = (double)pos * inv * 0.15915494309189535; const float f = (float)(rev - rint(rev));
    cs = __builtin_amdgcn_cosf(f); sn = __builtin_amdgcn_sinf(f);
}
template <class F>
__device__ __forceinline__ void cvt_tile(const F& f, int n0, int k0, bf16_t* dst, int ldk, LAS float* tile, int tid) {
    { const int k = tid >> 3, nb = (tid & 7) * 8; const float gk = f.rowgain(k0 + k); const float* p[8]; float gn[8], v[8];
#pragma unroll
      for (int j = 0; j < 8; ++j) f.ld(k0 + k, n0 + nb + j, p[j], gn[j], gk);
#pragma unroll
      for (int j = 0; j < 8; ++j) v[j] = *p[j];
#pragma unroll
      for (int j = 0; j < 8; ++j) tile[k * 65 + nb + j] = v[j] * gn[j]; }
    __syncthreads();
    { const int n = tid >> 3, kb = (tid & 7) * 8; const LAS float* s = tile + kb * 65 + n;
      u32x4 o; o.x = pk_bf16(s[0], s[65]); o.y = pk_bf16(s[130], s[195]); o.z = pk_bf16(s[260], s[325]); o.w = pk_bf16(s[390], s[455]);
      *(u32x4*)(dst + (size_t)(n0 + n) * ldk + k0 + kb) = o; }
    __syncthreads();
}
template <class F>
__device__ __forceinline__ void cvt_item(const F& f, int it, int nK, bf16_t* dst, int ldk, LAS float* tile, int tid) { cvt_tile(f, (it / nK) * 64, (it % nK) * 64, dst, ldk, tile, tid); }

__device__ __forceinline__ void moe_item(InPtr in, int l, int it, const float*& src, int& ld, size_t& dst, int& ldk, bool& gain, int& kk0) {
    if (it < 32 * 64) { const int e = it >> 6, r = it & 63, n0 = (r >> 3) * 64, k0 = (r & 7) * 128, c0 = n0 & 255;
        src = (c0 < 128 ? in->p[27] : in->p[28]) + ((size_t)l * 32 + e) * 262144 + (size_t)k0 * 256 + (n0 >> 8) * 128 + (c0 & 127); ld = 256; gain = true; kk0 = k0;
        dst = ((size_t)e * 512 + n0) * 1024 + k0; ldk = 1024; }
    else { const int j = it - 32 * 64, e = j >> 5, r = j & 31, n0 = (r >> 1) * 64, k0 = (r & 1) * 128;
        src = in->p[29] + ((size_t)l * 32 + e) * 262144 + (size_t)k0 * 1024 + n0; ld = 1024; gain = false; kk0 = 0;
        dst = (size_t)16777216 + ((size_t)e * 1024 + n0) * 256 + k0; ldk = 256; }
}
__device__ __forceinline__ void cvt_moe_layer(InPtr in, unsigned char* ws, int l, LAS float* tile, int bid, int nb, int tid, int it_lo = 0, int it_hi = 32 * (64 + 32)) {
    asm volatile("" : "+v"(tid));
    const float* g2 = in->p[22] + l * 1024; bf16_t* W = (bf16_t*)(ws + WS_WMOE);
    const int k = tid >> 3, nbq = (tid & 7) * 8;
    const int n = tid >> 3, kb = (tid & 7) * 8;
    const int NIT = it_hi;
#define CVM_LOAD(it_, P) do { const float* src_; int ld_, ldk_, kk0_; size_t dst_; bool gain_; moe_item(in, l, (it_), src_, ld_, dst_, ldk_, gain_, kk0_); \
        P##a = *(const f32x4*)(src_ + (size_t)k * ld_ + nbq); P##b = *(const f32x4*)(src_ + (size_t)k * ld_ + nbq + 4); P##c = *(const f32x4*)(src_ + (size_t)(k + 64) * ld_ + nbq); P##d = *(const f32x4*)(src_ + (size_t)(k + 64) * ld_ + nbq + 4); \
        P##g0 = gain_ ? g2[kk0_ + k] : 1.f; P##g1 = gain_ ? g2[kk0_ + 64 + k] : 1.f; } while (0)
#define CVM_PUT(t, P) do { \
        t[k * 65 + nbq + 0] = P##a.x * P##g0; t[k * 65 + nbq + 1] = P##a.y * P##g0; t[k * 65 + nbq + 2] = P##a.z * P##g0; t[k * 65 + nbq + 3] = P##a.w * P##g0; \
        t[k * 65 + nbq + 4] = P##b.x * P##g0; t[k * 65 + nbq + 5] = P##b.y * P##g0; t[k * 65 + nbq + 6] = P##b.z * P##g0; t[k * 65 + nbq + 7] = P##b.w * P##g0; \
        t[(k + 64) * 65 + nbq + 0] = P##c.x * P##g1; t[(k + 64) * 65 + nbq + 1] = P##c.y * P##g1; t[(k + 64) * 65 + nbq + 2] = P##c.z * P##g1; t[(k + 64) * 65 + nbq + 3] = P##c.w * P##g1; \
        t[(k + 64) * 65 + nbq + 4] = P##d.x * P##g1; t[(k + 64) * 65 + nbq + 5] = P##d.y * P##g1; t[(k + 64) * 65 + nbq + 6] = P##d.z * P##g1; t[(k + 64) * 65 + nbq + 7] = P##d.w * P##g1; } while (0)
#define CVM_STORE(it_, t) do { const float* src_; int ld_, ldk_, kk0_; size_t dst_; bool gain_; moe_item(in, l, (it_), src_, ld_, dst_, ldk_, gain_, kk0_); \
        _Pragma("unroll") for (int hh = 0; hh < 2; ++hh) { const LAS float* s_ = t + (64 * hh + kb) * 65 + n; \
            u32x4 o; o.x = pk_bf16(s_[0], s_[65]); o.y = pk_bf16(s_[130], s_[195]); o.z = pk_bf16(s_[260], s_[325]); o.w = pk_bf16(s_[390], s_[455]); \
            *(u32x4*)(W + dst_ + (size_t)n * ldk_ + 64 * hh + kb) = o; } } while (0)
    f32x4 Aa, Ab, Ac, Ad, Ba, Bb, Bc, Bd; float Ag0 = 1.f, Ag1 = 1.f, Bg0 = 1.f, Bg1 = 1.f;
    LAS float* t0 = tile; LAS float* t1 = tile + 128 * 65;
    int it = it_lo + bid;
    if (it < NIT) CVM_LOAD(it, A);
    if (it + nb < NIT) CVM_LOAD(it + nb, B);
#pragma unroll 1
    for (; it < NIT; it += 2 * nb) {
        CVM_PUT(t0, A);
        __syncthreads();
        if (it + 2 * nb < NIT) CVM_LOAD(it + 2 * nb, A);
        CVM_STORE(it, t0);
        if (it + nb < NIT) {
            CVM_PUT(t1, B);
            __syncthreads();
            if (it + 3 * nb < NIT) CVM_LOAD(it + 3 * nb, B);
            CVM_STORE(it + nb, t1);
        }
    }
#undef CVM_LOAD
#undef CVM_PUT
#undef CVM_STORE
    __syncthreads();
}

__device__ __forceinline__ void cvt_small_weights(InPtr in, unsigned char* ws, int l, LAS float* tile, int bid, int nb, int tid) {
    asm volatile("" : "+v"(tid));
    constexpr int I_WIN = 40 * 16, I_WOUT = 16 * 16, I_WU = 12 * 4, I_WC1 = 32, I_WC2 = 1, I_WR = 16;
    constexpr int PER_L = I_WIN + I_WOUT + 2 * I_WU + 2 * I_WC1 + 2 * I_WC2 + I_WR;
    for (int it0 = bid; it0 < PER_L; it0 += nb) {
        int it = it0;
        if (it < I_WIN) { FWin f{in->p[4] + (size_t)l * 1024 * DIN, in->p[3] + l * 1024}; cvt_item(f, it, 16, (bf16_t*)(ws + WS_WIN) + (size_t)l * 2560 * 1024, 1024, tile, tid); continue; } it -= I_WIN;
        if (it < I_WOUT) { FWout f{in->p[21] + (size_t)l * 1048576, in->p[10] + l * 384, in->p[20] + l * 384}; cvt_item(f, it, 16, (bf16_t*)(ws + WS_WOUT) + (size_t)l * 1048576, 1024, tile, tid); continue; } it -= I_WOUT;
        if (it < I_WU) { FWuq f{in->p[16] + (size_t)l * 192 * 576, in->p[15] + l * 192}; cvt_item(f, it, 4, (bf16_t*)(ws + WS_WUQ) + (size_t)l * 768 * 256, 256, tile, tid); continue; } it -= I_WU;
        if (it < I_WU) { FWukv f{in->p[18] + (size_t)l * 128 * 768, in->p[17] + l * 128}; cvt_item(f, it, 4, (bf16_t*)(ws + WS_WUKV) + (size_t)l * 768 * 256, 256, tile, tid); continue; } it -= I_WU;
        if (it < 2 * I_WC1) { const int s = it / I_WC1; FWc1 f{in->p[6] + ((size_t)l * 2 + s) * 2048 * 64}; cvt_item(f, it % I_WC1, 32, (bf16_t*)(ws + WS_WC1) + ((size_t)l * 2 + s) * 64 * 2048, 2048, tile, tid); continue; } it -= 2 * I_WC1;
        if (it < 2 * I_WC2) { const int s = it; FWc1 f{in->p[7] + ((size_t)l * 2 + s) * 64 * 64}; cvt_item(f, 0, 1, (bf16_t*)(ws + WS_WC2) + ((size_t)l * 2 + s) * 64 * 64, 64, tile, tid); continue; } it -= 2 * I_WC2;
        { FWr f{in->p[23] + (size_t)l * 4096, in->p[25] + (size_t)l * 32768, in->p[22] + l * 1024}; cvt_item(f, it, 16, (bf16_t*)(ws + WS_WR) + (size_t)l * 64 * 1024, 1024, tile, tid); }
    }
}

__device__ __forceinline__ void prologue(InPtr in, unsigned char* ws, LAS unsigned char* lds, int bid, int nb, int g_wv) {
    int tid_ = TIDX; asm volatile("" : "+v"(tid_));
    const int tid = tid_, lane = tid & 63, wid = tid >> 6;
    LAS float* tile = (LAS float*)lds;
    cvt_small_weights(in, ws, 0, tile, bid, nb, tid);
    { const float* x = in->p[0]; bf16_t* XB = (bf16_t*)(ws + WS_XB); float* ssqx = (float*)(ws + WS_SSQX);
      for (int r0 = (bid * 8 + wid) * 2; r0 < NTOK; r0 += nb * 16) {
          f32x4 v[2][4];
#pragma unroll
          for (int rr = 0; rr < 2; ++rr)
#pragma unroll
              for (int j = 0; j < 4; ++j) v[rr][j] = *((const f32x4*)(x + (size_t)(r0 + rr) * 1024) + lane + 64 * j);
#pragma unroll
          for (int rr = 0; rr < 2; ++rr) { float s = 0.f; u32x2* o = (u32x2*)(XB + (size_t)(r0 + rr) * 1024) + lane;
#pragma unroll
              for (int j = 0; j < 4; ++j) { const f32x4 q = v[rr][j]; s += (q.x * q.x + q.y * q.y) + (q.z * q.z + q.w * q.w); u32x2 w; w.x = pk_bf16(q.x, q.y); w.y = pk_bf16(q.z, q.w); o[64 * j] = w; }
              s = wave_sum(s); if (lane == 0) ssqx[r0 + rr] = s; }
      } }
    { float* biasd = (float*)(ws + WS_BIASD); const float* rb = in->p[2];
      for (int i = bid * 512 + tid; i < 6 * 2048; i += nb * 512) { const int h = i >> 11, d = i & 2047; biasd[i] = rb[t5b(d) * 6 + h] * 1.44269504f; } }
    { float* rope = (float*)(ws + WS_ROPE); const int* pos = (const int*)in->p[1];
      for (int i = bid * 512 + tid; i < NTOK * 16; i += nb * 512) { const int tk = i >> 4, j = i & 15; float cs, sn; rope_cs(pos[tk], j, cs, sn); rope[(size_t)tk * 32 + j] = cs; rope[(size_t)tk * 32 + 16 + j] = sn; } }
    { float* b1c = (float*)(ws + WS_B1C); LAS float* red = (LAS float*)lds;
      for (int it = nb - 1 - bid; it >= 0 && it < 4; it += nb) { const float* pe = in->p[5] + (size_t)it * 2048; const float* w1 = in->p[6] + (size_t)it * 2048 * 64; const int f4 = tid & 15, kp = tid >> 4;
          f32x4 a = (f32x4){0.f, 0.f, 0.f, 0.f};
#pragma unroll 1
          for (int k0 = kp * 64; k0 < kp * 64 + 64; k0 += 16) { f32x4 wv[16]; float pv[16];
#pragma unroll
              for (int j = 0; j < 16; ++j) { wv[j] = *(const f32x4*)(w1 + (size_t)(k0 + j) * 64 + 4 * f4); pv[j] = pe[k0 + j]; }
#pragma unroll
              for (int j = 0; j < 16; ++j) { a.x += pv[j] * wv[j].x; a.y += pv[j] * wv[j].y; a.z += pv[j] * wv[j].z; a.w += pv[j] * wv[j].w; } }
          __syncthreads(); *(LAS f32x4*)(red + kp * 64 + 4 * f4) = a; __syncthreads();
          if (tid < 64) { float sum = 0.f; for (int p2 = 0; p2 < 32; ++p2) sum += red[p2 * 64 + tid]; b1c[it * 64 + tid] = sum; }
          __syncthreads(); } }
}
namespace g8 {
constexpr int BM = 256, BK = 64, HALF = 128, HTB = HALF * BK * 2, STAGE_BYTES = 8 * HTB, NXCD = 8, WGM = 8;
__host__ __device__ __forceinline__ int lds_byte(int r, int c) { const int st = (r >> 4) * 2 + (c >> 5), rr = r & 15, cc = c & 31, ob = rr * 64 + cc * 2; return st * 1024 + (ob ^ (((ob >> 9) & 1) << 5)); }
__host__ __device__ __forceinline__ void stage_rc(int b, int& R, int& C) { const int st = b / 1024, sb = b % 1024, swz = sb ^ (((sb >> 9) & 1) << 5); R = (st >> 1) * 16 + swz / 64; C = (st & 1) * 32 + (swz % 64) / 2; }
__host__ __device__ __forceinline__ int perm32(int rho) { const int n = rho >> 4, i = rho & 15; return 8 * (i >> 2) + 4 * n + (i & 3); }

struct GUnit { const char* a; const char* b; int pm, pn, e, rows; };

__device__ __forceinline__ bool static_unit(int i, int G, int c, int nM, int nN, int& pm, int& pn) {
    const int nwg = nM * nN; const long L = (long)i * G + c; if (L >= nwg) return false;
    int wgid = (int)L; { const int q = nwg / NXCD, r = nwg % NXCD, xcd = wgid % NXCD, off = wgid / NXCD; wgid = (xcd < r ? xcd * (q + 1) : r * (q + 1) + (xcd - r) * q) + off; }
    const int nig = WGM * nN, gid = wgid / nig, fm = gid * WGM, gsz = (nM - fm) < WGM ? (nM - fm) : WGM;
    pm = fm + ((wgid % nig) % gsz); pn = (wgid % nig) / gsz; return true;
}
struct DenseSched {
    static constexpr bool GATHER = false, PARTIAL = false;
    const char* A; const char* Bt; int lda, ldb, nM, nN, G, c;
    __device__ __forceinline__ bool next(int i, GUnit& u) const {
        int pm, pn; if (!static_unit(i, G, c, nM, nN, pm, pn)) return false;
        u.pm = pm; u.pn = pn; u.e = 0; u.rows = 256; u.a = A + (size_t)pm * 256 * lda * 2; u.b = Bt + (size_t)pn * 256 * ldb * 2; return true;
    }
    __device__ __forceinline__ void aoff(const GUnit&, unsigned (&v)[2][2], const int (&R)[2], const int (&C)[2]) const {
#pragma unroll
        for (int h = 0; h < 2; ++h)
#pragma unroll
            for (int i = 0; i < 2; ++i) v[h][i] = (unsigned)((h * 128 + R[i]) * lda + C[i]) * 2u;
    }
};

template <class Epi, class Sched>
__device__ __forceinline__ void gemm_run(LAS unsigned char* lds, const int K, const int ldb, const Sched& S, const Epi& E, int g_wv) {
    int tid_ = TIDX; asm volatile("" : "+v"(tid_));
    const int tid = tid_, wid = __builtin_amdgcn_readfirstlane(tid >> 6), lane = tid & 63, wr = wid >> 2, wc = wid & 3, fr = lane & 15, fq = lane >> 4;
    int nt_ = K / BK; asm volatile("" : "+s"(nt_));
    const int nt = nt_;
    int R[2], C[2]; unsigned voffB[2];
#pragma unroll
    for (int i = 0; i < 2; ++i) { stage_rc(tid * 16 + i * 8192, R[i], C[i]); const int Rb = (R[i] & ~31) + perm32(R[i] & 31); voffB[i] = (unsigned)(Rb * ldb + C[i]) * 2u; }
    const size_t kstep = (size_t)(BK * 2);
    const size_t hstepB = (size_t)HALF * ldb * 2;
    const unsigned ldsw = (unsigned)wid * 1024u;
    const int aoff = lds_byte(wr * 64 + fr, fq * 8), boff = lds_byte(wc * 32 + fr, fq * 8);
#define G8_SA(b, h) (((b) * 2 + (h)) * HTB)
#define G8_SB(b, h) ((4 + (b) * 2 + (h)) * HTB)
#define G8_GLDS(bufoff, gptr, i_) __builtin_amdgcn_global_load_lds((const unsigned*)(gptr), (LAS unsigned*)(lds + (bufoff) + ldsw + (i_) * 8192), 16, 0, 0)
#define G8_STAGE_B(bufoff, gbase) do { G8_GLDS(bufoff, (const char*)(gbase) + voffB[0], 0); G8_GLDS(bufoff, (const char*)(gbase) + voffB[1], 1); } while (0)
#define G8_STAGE_A(bufoff, gbase, v0, v1) do { G8_GLDS(bufoff, (const char*)(gbase) + (v0), 0); G8_GLDS(bufoff, (const char*)(gbase) + (v1), 1); } while (0)
#define G8_LDA(dst, b, h) do { _Pragma("unroll") for (int m = 0; m < 4; ++m) _Pragma("unroll") for (int k = 0; k < 2; ++k) dst[m][k] = *(const LAS bf16x8*)(lds + G8_SA(b, h) + aoff + m * 2048 + k * 1024); } while (0)
#define G8_LDB(dst, b, h) do { _Pragma("unroll") for (int n = 0; n < 2; ++n) _Pragma("unroll") for (int k = 0; k < 2; ++k) dst[n][k] = *(const LAS bf16x8*)(lds + G8_SB(b, h) + boff + n * 2048 + k * 1024); } while (0)
#define G8_MMA(ai, bj, At, Bt) do { __builtin_amdgcn_s_setprio(1); _Pragma("unroll") for (int m = 0; m < 4; ++m) { if (!PARTIAL || ((mmask >> ((ai) * 4 + m)) & 1u)) { _Pragma("unroll") for (int n = 0; n < 2; ++n) _Pragma("unroll") for (int k = 0; k < 2; ++k) \
        acc[ai][bj][m][n] = __builtin_amdgcn_mfma_f32_16x16x32_bf16(Bt[n][k], At[m][k], acc[ai][bj][m][n], 0, 0, 0); } } __builtin_amdgcn_s_setprio(0); } while (0)
#define G8_WAIT_V(n) asm volatile("s_waitcnt vmcnt(" #n ")" ::: "memory")
#define G8_WAIT_L(n) asm volatile("s_waitcnt lgkmcnt(" #n ")" ::: "memory")
#define G8_BAR __builtin_amdgcn_s_barrier()
#define G8_SCHED __builtin_amdgcn_sched_barrier(0)
    GUnit cur, nxt; int ui = 0;
    if (!S.next(0, cur)) return;
    constexpr bool GATHER = Sched::GATHER, PARTIAL = Sched::PARTIAL;
    unsigned mmask = 0xffu;
#define G8_MASK(u) do { if (PARTIAL) { mmask = 0u; _Pragma("unroll") for (int q_ = 0; q_ < 8; ++q_) mmask |= (((q_ >> 2) * 128 + wr * 64 + (q_ & 3) * 16) < (u).rows) ? (1u << q_) : 0u; } } while (0)
    unsigned vc[2][2];
    S.aoff(cur, vc, R, C); G8_MASK(cur);
    LAS u32x4* stash = (LAS u32x4*)(lds + STAGE_BYTES + 4096) + tid;
    f32x4 acc[2][2][4][2];
#pragma unroll
    for (int a = 0; a < 2; ++a)
#pragma unroll
        for (int b = 0; b < 2; ++b)
#pragma unroll
            for (int m = 0; m < 4; ++m)
#pragma unroll
                for (int n = 0; n < 2; ++n) acc[a][b][m][n] = (f32x4){0.f, 0.f, 0.f, 0.f};
    bf16x8 At[4][2], B0[2][2], B1[2][2];
    const char* cA = cur.a; const char* cB = cur.b;
    G8_STAGE_B(G8_SB(0, 0), cB); G8_STAGE_B(G8_SB(0, 1), cB + hstepB); G8_STAGE_A(G8_SA(0, 0), cA, vc[0][0], vc[0][1]); G8_STAGE_A(G8_SA(0, 1), cA, vc[1][0], vc[1][1]);
    if (wr == 1) G8_BAR;
    G8_WAIT_V(2); G8_BAR;
    G8_STAGE_B(G8_SB(1, 0), cB + kstep); G8_STAGE_A(G8_SA(1, 0), cA + kstep, vc[0][0], vc[0][1]); G8_STAGE_B(G8_SB(1, 1), cB + hstepB + kstep);
    G8_WAIT_V(6); G8_BAR;
    for (;;) {
        const bool has_next = S.next(ui + 1, nxt);
        if (GATHER) { unsigned vn[2][2];
            if (has_next) S.aoff(nxt, vn, R, C);
            else { vn[0][0] = vc[0][0]; vn[0][1] = vc[0][1]; vn[1][0] = vc[1][0]; vn[1][1] = vc[1][1]; }
            u32x4 sv; sv.x = vn[0][0]; sv.y = vn[0][1]; sv.z = vn[1][0]; sv.w = vn[1][1]; *stash = sv; }
        const char* nA = has_next ? nxt.a : cA; const char* nB = has_next ? nxt.b : cB;
#pragma unroll 1
        for (int seg = 0; seg < (Epi::KHOOK ? 3 : 1); ++seg) {
        const int tlo = Epi::KHOOK ? 6 * seg : 0, thi = Epi::KHOOK ? (seg == 2 ? nt : 6 * seg + 6) : nt;
#pragma unroll 1
        for (int t = tlo; t < thi; t += 2) {
            const bool last = (t == nt - 2);
            const char* a1 = cA + (size_t)(t + 1) * kstep;
            const char* a2 = last ? nA : cA + (size_t)(t + 2) * kstep; const char* b2 = last ? nB : cB + (size_t)(t + 2) * kstep;
            const char* a3 = a2 + kstep; const char* b3 = b2 + kstep;
            unsigned w00 = vc[0][0], w01 = vc[0][1], w10 = vc[1][0], w11 = vc[1][1];
            if (GATHER) { if (last) { const u32x4 sv = *stash; w00 = sv.x; w01 = sv.y; w10 = sv.z; w11 = sv.w; } }
            G8_LDB(B0, 0, 0); G8_LDB(B1, 0, 1); G8_SCHED; G8_LDA(At, 0, 0); G8_STAGE_A(G8_SA(1, 1), a1, vc[1][0], vc[1][1]);
            G8_WAIT_V(8); G8_WAIT_L(0); G8_BAR; G8_MMA(0, 0, At, B0); G8_MMA(0, 1, At, B1); G8_BAR; G8_SCHED;
            G8_LDA(At, 0, 1); G8_STAGE_B(G8_SB(0, 0), b2); G8_STAGE_B(G8_SB(0, 1), b2 + hstepB); G8_STAGE_A(G8_SA(0, 0), a2, w00, w01);
            G8_WAIT_V(8); G8_WAIT_L(0); G8_BAR; G8_MMA(1, 0, At, B0); G8_MMA(1, 1, At, B1); G8_BAR; G8_SCHED;
            G8_LDB(B0, 1, 0); G8_LDB(B1, 1, 1); G8_SCHED; G8_LDA(At, 1, 0); G8_STAGE_A(G8_SA(0, 1), a2, w10, w11);
            G8_WAIT_V(8); G8_WAIT_L(0); G8_BAR; G8_MMA(0, 0, At, B0); G8_MMA(0, 1, At, B1); G8_BAR; G8_SCHED;
            G8_LDA(At, 1, 1); G8_STAGE_B(G8_SB(1, 0), b3); G8_STAGE_B(G8_SB(1, 1), b3 + hstepB); G8_STAGE_A(G8_SA(1, 0), a3, w00, w01);
            G8_WAIT_V(8); G8_WAIT_L(0); G8_BAR; G8_MMA(1, 0, At, B0); G8_MMA(1, 1, At, B1); G8_BAR; G8_SCHED;
        }
        if constexpr (Epi::KHOOK) { if (seg < 2) E.kscale(acc, seg, wr, fr); }
        }
        if (wr == 0) G8_BAR;
        { int fr_ = fr, fq_ = fq; asm volatile("" : "+v"(fr_), "+v"(fq_));
          E(acc, cur, wr, wc, fr_, fq_); }
        if (!has_next) break;
#pragma unroll
        for (int a = 0; a < 2; ++a)
#pragma unroll
            for (int b = 0; b < 2; ++b)
#pragma unroll
                for (int m = 0; m < 4; ++m)
#pragma unroll
                    for (int n = 0; n < 2; ++n) acc[a][b][m][n] = (f32x4){0.f, 0.f, 0.f, 0.f};
        cur = nxt; cA = nA; cB = nB; ++ui; G8_MASK(cur);
        if (GATHER) { const u32x4 sv = *stash; vc[0][0] = sv.x; vc[0][1] = sv.y; vc[1][0] = sv.z; vc[1][1] = sv.w; }
        if (wr == 1) G8_BAR;
    }
    G8_WAIT_V(0);
    G8_BAR;
#undef G8_SA
#undef G8_SB
#undef G8_GLDS
#undef G8_STAGE_A
#undef G8_STAGE_B
#undef G8_LDA
#undef G8_LDB
#undef G8_MMA
#undef G8_MASK
#undef G8_WAIT_V
#undef G8_WAIT_L
#undef G8_BAR
#undef G8_SCHED
}
}
using g8::GUnit;
__device__ __forceinline__ void st_bf16x8(bf16_t* p, const float (&v)[8]) { u32x4 w; w.x = pk_bf16(v[0], v[1]); w.y = pk_bf16(v[2], v[3]); w.z = pk_bf16(v[4], v[5]); w.w = pk_bf16(v[6], v[7]); *(u32x4*)p = w; }
__device__ __forceinline__ float quad_sum(float s) { s += shx<16>(s); s += __shfl_xor(s, 32); return s; }

struct EpiInProj {
    static constexpr bool KHOOK = false;
    const float* ssqx; float* part_dq; float* part_dkv; const float* qg; const float* kg; const float* krg; const float* rope;
    unsigned char* prj;
    __device__ __forceinline__ void operator()(const f32x4 (&acc)[2][2][4][2], const GUnit& u, int wr, int wc, int fr, int fq) const {
        const int G = u.pn * 4 + wc;
        const bool isq = G < 6; const int a = G - 6; const bool isk = (G >= 10 && G < 18 && ((a >> 1) & 1) == 0);
        const float* g0 = (isq ? qg : kg) + 8 * fq;
        float rs8[8];
#pragma unroll
        for (int k = 0; k < 8; ++k) rs8[k] = ssqx[u.pm * 256 + (k >> 2) * 128 + wr * 64 + (k & 3) * 16 + fr];
#pragma unroll
        for (int k = 0; k < 8; ++k) rs8[k] = rsqrtf(rs8[k] * (1.f / 1024.f) + 1e-6f);
#pragma unroll
        for (int ai = 0; ai < 2; ++ai)
#pragma unroll
            for (int m = 0; m < 4; ++m) {
                __builtin_amdgcn_sched_barrier(0);
                const int row = u.pm * 256 + ai * 128 + wr * 64 + m * 16 + fr; const int b = row >> 11, t = row & 2047;
                const float rs = rs8[ai * 4 + m];
                float v[2][8];
#pragma unroll
                for (int bj = 0; bj < 2; ++bj)
#pragma unroll
                    for (int n = 0; n < 2; ++n)
#pragma unroll
                        for (int j = 0; j < 4; ++j) v[bj][4 * n + j] = acc[ai][bj][m][n][j] * rs;
                float ss = 0.f;
#pragma unroll
                for (int bj = 0; bj < 2; ++bj)
#pragma unroll
                    for (int i = 0; i < 8; ++i) ss += v[bj][i] * v[bj][i];
                bf16_t* dst = nullptr; int bstride = 32;
                if (isq) {
                    ss = quad_sum(ss); const float sc = rsqrtf(ss * (1.f / 64.f) + 1e-6f) * 0.18033688f;
#pragma unroll
                    for (int i = 0; i < 8; ++i) { v[0][i] *= sc * g0[i]; v[1][i] *= sc * g0[32 + i]; }
                    dst = (bf16_t*)(prj + PRJ_QN) + ((size_t)(b * 6 + G) * 2048 + t) * 64;
                } else if (G < 18) {
                    const int br = a >> 2, s = (a >> 1) & 1, hk = a & 1;
                    if (br > 0 && s == 0) {
                        ss = quad_sum(ss); const float sc = rsqrtf(ss * (1.f / 64.f) + 1e-6f);
#pragma unroll
                        for (int i = 0; i < 8; ++i) { v[0][i] *= sc * g0[i]; v[1][i] *= sc * g0[32 + i]; }
                    }
                    const size_t base = br == 0 ? (s ? PRJ_C0V : PRJ_C0K) : (br == 1 ? (s ? PRJ_VN1 : PRJ_KN1) : (s ? PRJ_VN2 : PRJ_KN2));
                    dst = (bf16_t*)(prj + base) + ((size_t)(b * 2 + hk) * 2048 + t) * 64;
                } else if (G < 26) { dst = (bf16_t*)(prj + PRJ_RAWQK) + (size_t)row * 512 + (G - 18) * 64; }
                else if (G < 30) { dst = (bf16_t*)(prj + PRJ_VML) + ((size_t)(b * 4 + (G - 26)) * 2048 + t) * 64; }
                else if (G < 34) { dst = (bf16_t*)(prj + PRJ_OG) + (size_t)row * 256 + (G - 30) * 64; }
                else if (G < 37) { dst = (bf16_t*)(prj + PRJ_DQKV) + (size_t)row * 384 + (G - 34) * 64; ss = quad_sum(ss); if (fq == 0) part_dq[(size_t)row * 4 + (G - 34)] = ss; }
                else if (G == 37) {
                    dst = (bf16_t*)(prj + PRJ_DQKV) + (size_t)row * 384 + 192;
                    float* gt = (float*)(prj + PRJ_GATES) + (size_t)row * 32 + 8 * fq;
                    *(f32x4*)gt = (f32x4){v[1][0], v[1][1], v[1][2], v[1][3]}; *(f32x4*)(gt + 4) = (f32x4){v[1][4], v[1][5], v[1][6], v[1][7]};
                    float s0 = 0.f;
#pragma unroll
                    for (int i = 0; i < 8; ++i) s0 += v[0][i] * v[0][i];
                    s0 = quad_sum(s0); const float sc = rsqrtf(s0 * (1.f / 32.f) + 1e-6f);
                    const float* rp = rope + (size_t)row * 32 + ((8 * fq) & 15);
                    float kr[8];
#pragma unroll
                    for (int i = 0; i < 8; ++i) { const float val = v[0][i] * sc * krg[8 * fq + i]; const float oth = __shfl_xor(val, 32); const float cs = rp[i], sn = rp[16 + i]; kr[i] = fq < 2 ? val * cs - oth * sn : val * cs + oth * sn; }
                    st_bf16x8((bf16_t*)(prj + PRJ_KR) + (size_t)row * 32 + 8 * fq, kr);
                } else { dst = (bf16_t*)(prj + PRJ_DQKV) + (size_t)row * 384 + 256 + (G - 38) * 64; ss = quad_sum(ss); if (fq == 0) part_dkv[(size_t)row * 2 + (G - 38)] = ss; }
                st_bf16x8(dst + 8 * fq, v[0]); st_bf16x8(dst + bstride + 8 * fq, v[1]);
            }
    }
};

struct EpiUq {
    static constexpr bool KHOOK = false;
    const float* ssq_dq; const float* qkn; const float* rope; bf16_t* QM;
    __device__ __forceinline__ void operator()(const f32x4 (&acc)[2][2][4][2], const GUnit& u, int wr, int wc, int fr, int fq) const {
        const int G = u.pn * 4 + wc; if (G >= 9) return;
        const float scale = 0.14724444f;
        const float* g0 = G < 6 ? qkn + 8 * fq : qkn + 64 + 8 * (fq & 1); const float* g1 = G < 6 ? g0 + 32 : g0 + 16;
        float rs8[8];
#pragma unroll
        for (int k = 0; k < 8; ++k) { const f32x4 pq = *(const f32x4*)(ssq_dq + (size_t)(u.pm * 256 + (k >> 2) * 128 + wr * 64 + (k & 3) * 16 + fr) * 4); rs8[k] = (pq.x + pq.y) + pq.z; }
#pragma unroll
        for (int k = 0; k < 8; ++k) rs8[k] = rsqrtf(rs8[k] * (1.f / 192.f) + 1e-6f);
#pragma unroll
        for (int ai = 0; ai < 2; ++ai) {
#pragma unroll
            for (int m = 0; m < 4; ++m) {
                __builtin_amdgcn_sched_barrier(0);
                const int row = u.pm * 256 + ai * 128 + wr * 64 + m * 16 + fr; const int b = row >> 11, t = row & 2047;
                const float rs = rs8[ai * 4 + m];
                float v[2][8]; float ss = 0.f;
#pragma unroll
                for (int bj = 0; bj < 2; ++bj)
#pragma unroll
                    for (int n = 0; n < 2; ++n)
#pragma unroll
                        for (int j = 0; j < 4; ++j) { const float x = acc[ai][bj][m][n][j] * rs; v[bj][4 * n + j] = x; ss += x * x; }
                if (G < 6) ss = quad_sum(ss); else ss += shx<16>(ss);
                const float sc = rsqrtf(ss * (G < 6 ? 1.f / 64.f : 1.f / 32.f) + 1e-6f) * scale;
#pragma unroll
                for (int i = 0; i < 8; ++i) { v[0][i] *= sc * g0[i]; v[1][i] *= sc * g1[i]; }
                if (G < 6) {
                    bf16_t* dst = QM + ((size_t)(b * 6 + G) * 2048 + t) * 96;
                    st_bf16x8(dst + 8 * fq, v[0]); st_bf16x8(dst + 32 + 8 * fq, v[1]);
                } else {
                    const int i16 = 8 * (fq & 1); const int head = 2 * (G - 6) + (fq >> 1);
                    const float* rp = rope + (size_t)row * 32 + i16; float o1[8], o2[8];
#pragma unroll
                    for (int i = 0; i < 8; ++i) { const float cs = rp[i], sn = rp[16 + i]; o1[i] = v[0][i] * cs - v[1][i] * sn; o2[i] = v[1][i] * cs + v[0][i] * sn; }
                    bf16_t* dst = QM + ((size_t)(b * 6 + head) * 2048 + t) * 96 + 64 + i16;
                    st_bf16x8(dst, o1); st_bf16x8(dst + 16, o2);
                }
            }
        }
    }
};
struct EpiUkv {
    static constexpr bool KHOOK = false;
    const float* ssq_dkv; const float* qkn; const bf16_t* KR; bf16_t* KM; bf16_t* VM;
    __device__ __forceinline__ void operator()(const f32x4 (&acc)[2][2][4][2], const GUnit& u, int wr, int wc, int fr, int fq) const {
        const int G = u.pn * 4 + wc;
        const float* g0 = qkn + 96 + 8 * fq;
        float rs8[8];
#pragma unroll
        for (int k = 0; k < 8; ++k) { const size_t rr = (size_t)(u.pm * 256 + (k >> 2) * 128 + wr * 64 + (k & 3) * 16 + fr); rs8[k] = ssq_dkv[rr * 2] + ssq_dkv[rr * 2 + 1]; }
#pragma unroll
        for (int k = 0; k < 8; ++k) rs8[k] = rsqrtf(rs8[k] * (1.f / 128.f) + 1e-6f);
#pragma unroll
        for (int ai = 0; ai < 2; ++ai) {
          u32x4 kr4[4];
          if (G < 6) {
#pragma unroll
              for (int m = 0; m < 4; ++m) kr4[m] = *(const u32x4*)(KR + (size_t)(u.pm * 256 + ai * 128 + wr * 64 + m * 16 + fr) * 32 + 8 * fq);
          }
#pragma unroll
            for (int m = 0; m < 4; ++m) {
                __builtin_amdgcn_sched_barrier(0);
                const int row = u.pm * 256 + ai * 128 + wr * 64 + m * 16 + fr; const int b = row >> 11, t = row & 2047;
                const float rs = rs8[ai * 4 + m];
                float v[2][8]; float ss = 0.f;
#pragma unroll
                for (int bj = 0; bj < 2; ++bj)
#pragma unroll
                    for (int n = 0; n < 2; ++n)
#pragma unroll
                        for (int j = 0; j < 4; ++j) { const float x = acc[ai][bj][m][n][j] * rs; v[bj][4 * n + j] = x; ss += x * x; }
                if (G < 6) {
                    ss = quad_sum(ss); const float sc = rsqrtf(ss * (1.f / 64.f) + 1e-6f);
#pragma unroll
                    for (int i = 0; i < 8; ++i) { v[0][i] *= sc * g0[i]; v[1][i] *= sc * g0[32 + i]; }
                    bf16_t* dst = KM + ((size_t)(b * 6 + G) * 2048 + t) * 96;
                    st_bf16x8(dst + 8 * fq, v[0]); st_bf16x8(dst + 32 + 8 * fq, v[1]);
                    *(u32x4*)(dst + 64 + 8 * fq) = kr4[m];
                } else {
                    bf16_t* dst = VM + ((size_t)(b * 6 + (G - 6)) * 2048 + t) * 64;
                    st_bf16x8(dst + 8 * fq, v[0]); st_bf16x8(dst + 32 + 8 * fq, v[1]);
                }
            }
        }
    }
};
#define MFMA16(a, b, c) __builtin_amdgcn_mfma_f32_16x16x32_bf16(a, b, c, 0, 0, 0)
#define MFMA32(a, b, c) __builtin_amdgcn_mfma_f32_32x32x16_bf16(a, b, c, 0, 0, 0)
#define LDS_FENCE() asm volatile("s_waitcnt lgkmcnt(0)" ::: "memory")

__device__ __forceinline__ void cmp_unit(int u, int l, InPtr in, unsigned char* ws, LAS unsigned char* lds, int g_wv) {
    int tid_ = TIDX; asm volatile("" : "+v"(tid_));
    const int tid = tid_, w = tid >> 6, lane = tid & 63, r = lane & 15, q = lane >> 4;
    const int b = u >> 2, s = (u >> 1) & 1, hk = u & 1;
    const bf16_t* A = (const bf16_t*)(ws + WS_PRJ + (s ? PRJ_C0V : PRJ_C0K)) + (size_t)(b * 2 + hk) * 2048 * 64;
    const bf16_t* W1 = (const bf16_t*)(ws + WS_WC1) + ((size_t)l * 2 + s) * 64 * 2048;
    const bf16_t* W2 = (const bf16_t*)(ws + WS_WC2) + ((size_t)l * 2 + s) * 64 * 64;
    const float* b1 = (const float*)(ws + WS_B1C) + (l * 2 + s) * 64;
    f32x4 acc[4];
#pragma unroll
    for (int nb = 0; nb < 4; ++nb) acc[nb] = (f32x4){0.f, 0.f, 0.f, 0.f};
    const bf16_t* ap = A + (size_t)(16 * w + r) * 1024 + 8 * q;
    constexpr int WP = 528, WBUF = 64 * WP; LAS unsigned char* wb = lds + 24576;
    u32x4 st[4];
#pragma unroll
    for (int i = 0; i < 4; ++i) { const int c = tid + 512 * i; st[i] = *(const u32x4*)(W1 + (size_t)(c >> 5) * 2048 + (c & 31) * 8); }
    bf16x8 af[8], afn[8];
#pragma unroll
    for (int ks = 0; ks < 8; ++ks) af[ks] = *(const bf16x8*)(ap + 32 * ks);
    const float* kg = in->p[9] + l * 64;
    float b1v[4], kgv[4]; bf16x8 w2f[2][4];
#pragma unroll
    for (int nb = 0; nb < 4; ++nb) { b1v[nb] = b1[16 * nb + r]; kgv[nb] = kg[16 * nb + r]; }
#pragma unroll
    for (int ks = 0; ks < 2; ++ks)
#pragma unroll
        for (int nb = 0; nb < 4; ++nb) w2f[ks][nb] = *(const bf16x8*)(W2 + (size_t)(16 * nb + r) * 64 + 32 * ks + 8 * q);
#pragma unroll
    for (int i = 0; i < 4; ++i) { const int c = tid + 512 * i; *(LAS u32x4*)(wb + (c >> 5) * WP + (c & 31) * 16) = st[i]; }
    __syncthreads();
    auto chunk = [&](const int kc, bf16x8 (&ac)[8], bf16x8 (&an)[8]) __attribute__((always_inline)) {
        const int cur = kc & 1;
        if (kc < 7) {
#pragma unroll
            for (int i = 0; i < 4; ++i) { const int c = tid + 512 * i; st[i] = *(const u32x4*)(W1 + (size_t)(c >> 5) * 2048 + (kc + 1) * 256 + (c & 31) * 8); }
#pragma unroll
            for (int ks = 0; ks < 8; ++ks) an[ks] = *(const bf16x8*)(ap + 256 * (kc + 1) + 32 * ks);
        }
#pragma unroll
        for (int ks = 0; ks < 8; ++ks)
#pragma unroll
            for (int nb = 0; nb < 4; ++nb) { const bf16x8 bb = *(const LAS bf16x8*)(wb + cur * WBUF + (16 * nb + r) * WP + (32 * ks + 8 * q) * 2); acc[nb] = MFMA16(ac[ks], bb, acc[nb]); }
        if (kc < 7) {
#pragma unroll
            for (int i = 0; i < 4; ++i) { const int c = tid + 512 * i; *(LAS u32x4*)(wb + (cur ^ 1) * WBUF + (c >> 5) * WP + (c & 31) * 16) = st[i]; }
        }
        __syncthreads();
    };
#pragma unroll 1
    for (int kc = 0; kc < 8; kc += 2) { chunk(kc, af, afn); chunk(kc + 1, afn, af); }
    LAS bf16_t* hl = (LAS bf16_t*)(lds + w * 2304);
#pragma unroll
    for (int nb = 0; nb < 4; ++nb) { const float bias = b1v[nb];
#pragma unroll
        for (int j = 0; j < 4; ++j) hl[(4 * q + j) * 72 + 16 * nb + r] = f2bf(siluf(acc[nb][j] + bias)); }
    LDS_FENCE();
    f32x4 o[4];
#pragma unroll
    for (int nb = 0; nb < 4; ++nb) o[nb] = (f32x4){0.f, 0.f, 0.f, 0.f};
#pragma unroll
    for (int ks = 0; ks < 2; ++ks) {
        const bf16x8 a = *(const LAS bf16x8*)(hl + r * 72 + 32 * ks + 8 * q);
#pragma unroll
        for (int nb = 0; nb < 4; ++nb) o[nb] = MFMA16(a, w2f[ks][nb], o[nb]);
    }
    LDS_FENCE();
    bf16_t* dst = (bf16_t*)(ws + WS_CMP + (s ? CMP_V : 0)) + (size_t)(b * 2 + hk) * 128 * 64;
#pragma unroll
    for (int j = 0; j < 4; ++j) {
        const int n = 16 * w + 4 * q + j; float ss = 0.f;
#pragma unroll
        for (int nb = 0; nb < 4; ++nb) ss += o[nb][j] * o[nb][j];
        ss += shx<1>(ss); ss += shx<2>(ss); ss += shx<4>(ss); ss += shx<8>(ss);
        const float sc = s == 0 ? rsqrtf(ss * (1.f / 64.f) + 1e-6f) : 1.f;
#pragma unroll
        for (int nb = 0; nb < 4; ++nb) { const int d = 16 * nb + r; const float v = o[nb][j] * sc * (s == 0 ? kgv[nb] : 1.f); dst[(size_t)n * 64 + d] = n < 127 ? f2bf(v) : (bf16_t)0; }
    }
}

__device__ __forceinline__ int swz_off(int row, int chunk) { return row * 128 + ((chunk ^ (row & 7)) << 4); }
__device__ __forceinline__ float log_sigmoid(float x) { return fminf(x, 0.f) - log1pf(__expf(-fabsf(x))); }
__device__ __forceinline__ void ml_delta_wave(int cu, int l, InPtr in, unsigned char* ws, LAS unsigned char* wl, int lane) {
    asm volatile("" : "+v"(lane));
    const int c = cu & 31, bh = cu >> 5, h = bh & 3, b = bh >> 2; const int t0 = c * 64; const size_t row0 = (size_t)b * 2048 + t0;
    const int cc = lane & 7, tg = lane >> 3;
    const bf16_t* raw = (const bf16_t*)(ws + WS_PRJ + PRJ_RAWQK); const float* cw = in->p[11] + (size_t)l * 4 * 512 + h * 64 + 8 * cc;
    u32x4 rq[11];
    const bool head0 = (c == 0 && tg == 0);
#pragma unroll
    for (int i = 0; i < 11; ++i) { const size_t rr = (head0 && i < 3) ? row0 : row0 + 8 * tg - 3 + i; rq[i] = *(const u32x4*)(raw + rr * 512 + h * 64 + 8 * cc); }
    __builtin_amdgcn_sched_barrier(0);
    const float* G = (const float*)(ws + WS_PRJ + PRJ_GATES);
    const float ip = G[(row0 + lane) * 32 + 18 + h] + in->p[12][l * 4 + h], fp = G[(row0 + lane) * 32 + 22 + h] + in->p[13][l * 4 + h];
    float bcum = log_sigmoid(fp);
#pragma unroll
    for (int o = 1; o < 64; o <<= 1) { const float t = __builtin_bit_cast(float, __builtin_amdgcn_ds_bpermute(((lane - o) & 63) << 2, __builtin_bit_cast(int, bcum))); if (lane >= o) bcum += t; }
    const float bL = __builtin_bit_cast(float, __builtin_amdgcn_readlane(__builtin_bit_cast(int, bcum), 63)); const float wgt = __expf(bL - bcum + ip);
    { float* mlg = (float*)(ws + WS_ML + ML_G) + ((size_t)bh * 2048 + t0 + lane) * 2; mlg[0] = bcum; mlg[1] = ip; if (lane == 0) ((float*)(ws + WS_ML + ML_BL))[cu] = bL; }
    float wt[8];
#pragma unroll
    for (int j = 0; j < 8; ++j) wt[j] = __builtin_bit_cast(float, __builtin_amdgcn_ds_bpermute((8 * tg + j) << 2, __builtin_bit_cast(int, wgt)));
    if (head0) {
#pragma unroll
        for (int i = 0; i < 3; ++i) rq[i] = (u32x4){0u, 0u, 0u, 0u}; }
#define MLD_E(v, e) (((e) & 1) ? bf_hi(((e) >> 1) == 0 ? (v).x : ((e) >> 1) == 1 ? (v).y : ((e) >> 1) == 2 ? (v).z : (v).w) : bf_lo(((e) >> 1) == 0 ? (v).x : ((e) >> 1) == 1 ? (v).y : ((e) >> 1) == 2 ? (v).z : (v).w))
    bf16_t* QC = (bf16_t*)(ws + WS_ML) + ((size_t)bh * 2048 + t0 + 8 * tg) * 64 + 8 * cc; bf16_t* KC = (bf16_t*)(ws + WS_ML + ML_KC) + ((size_t)bh * 2048 + t0 + 8 * tg) * 64 + 8 * cc;
    u32x4 rk[11], vv[8];
#pragma unroll
    for (int i = 0; i < 11; ++i) { const size_t rr = (head0 && i < 3) ? row0 : row0 + 8 * tg - 3 + i; rk[i] = *(const u32x4*)(raw + rr * 512 + h * 64 + 8 * cc + 256); }
    { const bf16_t* V = (const bf16_t*)(ws + WS_PRJ + PRJ_VML) + ((size_t)bh * 2048 + t0 + 8 * tg) * 64 + 8 * cc;
#pragma unroll
      for (int j = 0; j < 8; ++j) vv[j] = *(const u32x4*)(V + (size_t)j * 64); }
    if (head0) {
#pragma unroll
        for (int i = 0; i < 3; ++i) rk[i] = (u32x4){0u, 0u, 0u, 0u}; }
    __builtin_amdgcn_sched_barrier(0);
    {
        float w4[4][8];
#pragma unroll
        for (int tp = 0; tp < 4; ++tp) { const f32x4 a = *(const f32x4*)(cw + tp * 512), b4 = *(const f32x4*)(cw + tp * 512 + 4); w4[tp][0] = a.x; w4[tp][1] = a.y; w4[tp][2] = a.z; w4[tp][3] = a.w; w4[tp][4] = b4.x; w4[tp][5] = b4.y; w4[tp][6] = b4.z; w4[tp][7] = b4.w; }
#pragma unroll
        for (int j = 0; j < 8; ++j) { float o[8];
#pragma unroll
            for (int e = 0; e < 8; ++e) o[e] = siluf(w4[0][e] * MLD_E(rq[j], e) + w4[1][e] * MLD_E(rq[j + 1], e) + w4[2][e] * MLD_E(rq[j + 2], e) + w4[3][e] * MLD_E(rq[j + 3], e));
            u32x4 pk; pk.x = pk_bf16(o[0], o[1]); pk.y = pk_bf16(o[2], o[3]); pk.z = pk_bf16(o[4], o[5]); pk.w = pk_bf16(o[6], o[7]);
            *(u32x4*)(QC + (size_t)j * 64) = pk; }
    }
    float dn[8];
    {
        float w4[4][8];
#pragma unroll
        for (int tp = 0; tp < 4; ++tp) { const f32x4 a = *(const f32x4*)(cw + 256 + tp * 512), b4 = *(const f32x4*)(cw + 256 + tp * 512 + 4); w4[tp][0] = a.x; w4[tp][1] = a.y; w4[tp][2] = a.z; w4[tp][3] = a.w; w4[tp][4] = b4.x; w4[tp][5] = b4.y; w4[tp][6] = b4.z; w4[tp][7] = b4.w; }
#pragma unroll
        for (int e = 0; e < 8; ++e) dn[e] = 0.f;
#pragma unroll
        for (int j2 = 0; j2 < 4; ++j2) { float kb[2][8];
#pragma unroll
            for (int jj = 0; jj < 2; ++jj) { const int j = 2 * j2 + jj; float o[8];
#pragma unroll
                for (int e = 0; e < 8; ++e) o[e] = siluf(w4[0][e] * MLD_E(rk[j], e) + w4[1][e] * MLD_E(rk[j + 1], e) + w4[2][e] * MLD_E(rk[j + 2], e) + w4[3][e] * MLD_E(rk[j + 3], e)) * 0.125f;
                u32x4 pk; pk.x = pk_bf16(o[0], o[1]); pk.y = pk_bf16(o[2], o[3]); pk.z = pk_bf16(o[4], o[5]); pk.w = pk_bf16(o[6], o[7]);
                *(u32x4*)(KC + (size_t)j * 64) = pk;
#pragma unroll
                for (int e = 0; e < 8; ++e) { kb[jj][e] = MLD_E(pk, e); dn[e] += wt[j] * kb[jj][e]; } }
#pragma unroll
            for (int e = 0; e < 8; ++e) { *(LAS unsigned*)(wl + swz_off(8 * cc + e, tg) + 4 * j2) = pk_bf16(kb[0][e], kb[1][e]);
                *(LAS unsigned*)(wl + 8192 + swz_off(8 * cc + e, tg) + 4 * j2) = pk_bf16(wt[2 * j2] * MLD_E(vv[2 * j2], e), wt[2 * j2 + 1] * MLD_E(vv[2 * j2 + 1], e)); } }
    }
#undef MLD_E
#pragma unroll
    for (int e = 0; e < 8; ++e) { dn[e] += shx<8>(dn[e]); dn[e] += shx<16>(dn[e]); dn[e] += __shfl_xor(dn[e], 32); }
    if (tg == 0) { float* DN = (float*)(ws + WS_ML + ML_DN) + (size_t)cu * 64 + 8 * cc; *(f32x4*)DN = (f32x4){dn[0], dn[1], dn[2], dn[3]}; *(f32x4*)(DN + 4) = (f32x4){dn[4], dn[5], dn[6], dn[7]}; }
    LDS_FENCE();
    const int r = lane & 15, q = lane >> 4;
    bf16_t* DL = (bf16_t*)(ws + WS_ML + ML_DELTA) + (size_t)cu * 4096;
    f32x4 acc[4][4];
#pragma unroll
    for (int mb = 0; mb < 4; ++mb) {
#pragma unroll
        for (int nb = 0; nb < 4; ++nb) acc[mb][nb] = (f32x4){0.f, 0.f, 0.f, 0.f};
#pragma unroll
        for (int ks = 0; ks < 2; ++ks) {
            const bf16x8 a = *(const LAS bf16x8*)(wl + 8192 + swz_off(16 * mb + r, 4 * ks + q));
#pragma unroll
            for (int nb = 0; nb < 4; ++nb) { const bf16x8 bb = *(const LAS bf16x8*)(wl + swz_off(16 * nb + r, 4 * ks + q)); acc[mb][nb] = MFMA16(a, bb, acc[mb][nb]); }
        }
    }
    LDS_FENCE();
#pragma unroll
    for (int mb = 0; mb < 4; ++mb)
#pragma unroll
        for (int nb = 0; nb < 4; ++nb)
#pragma unroll
            for (int j = 0; j < 4; ++j) { const int row = 16 * mb + 4 * q + j, col = 16 * nb + r; *(LAS bf16_t*)(wl + swz_off(row, col >> 3) + (col & 7) * 2) = f2bf(acc[mb][nb][j]); }
    LDS_FENCE();
#pragma unroll
    for (int i = 0; i < 8; ++i) { const int ch = lane + 64 * i; *(u32x4*)(DL + (size_t)ch * 8) = *(const LAS u32x4*)(wl + swz_off(ch >> 3, ch & 7)); }
    LDS_FENCE();
}

#ifndef TIME_PH
#define TIME_PH -1
#endif
#define PSTAMP(i, blk) do { if (TIME_PH != -1 && l == 0 && blockIdx.x == (blk) && TIDX == 0) ((unsigned long long*)((unsigned*)(ws + WS_CTL) + CW_TS))[i] = __builtin_amdgcn_s_memrealtime(); } while (0)
#ifndef DUP_DELTA
#define DUP_DELTA 1
#endif
__device__ __forceinline__ void phase_prep(int l, InPtr in, unsigned char* ws, LAS unsigned char* lds, int bid, int nb, int g_wv, unsigned* dq) {
    asm volatile("" : "+s"(bid));
    PSTAMP(40, 0);
#ifndef NO_UQ
    { g8::DenseSched S{(const char*)(ws + WS_PRJ + PRJ_DQKV), (const char*)(ws + WS_WUQ) + (size_t)l * 768 * 256 * 2, 384, 256, 64, 3, nb, bid};
      EpiUq E{(const float*)(ws + WS_SSQ + PT_DQ) + (size_t)l * 16384 * 4, in->p[19] + l * 192, (const float*)(ws + WS_ROPE), (bf16_t*)(ws + WS_MLA)};
      g8::gemm_run(lds, 256, 256, S, E, g_wv); }
#endif
    PSTAMP(41, 0);
#ifndef NO_UKV
    asm volatile("" : "+s"(bid));
    { g8::DenseSched S{(const char*)(ws + WS_PRJ + PRJ_DQKV) + 256, (const char*)(ws + WS_WUKV) + (size_t)l * 768 * 256 * 2, 384, 256, 64, 3, nb, nb == 256 ? ((bid + 64) & 255) : bid};
      EpiUkv E{(const float*)(ws + WS_SSQ + PT_DKV) + (size_t)l * 16384 * 2, in->p[19] + l * 192, (const bf16_t*)(ws + WS_PRJ + PRJ_KR), (bf16_t*)(ws + WS_MLA + MLA_KM), (bf16_t*)(ws + WS_MLA + MLA_VM)};
      g8::gemm_run(lds, 256, 256, S, E, g_wv); }
#endif
    PSTAMP(42, 0); PSTAMP(44, 255);
    __syncthreads();
#ifndef NO_CMP
#ifndef DUP_CMP
#define DUP_CMP 1
#endif
    for (int u = (nb == 256 ? (bid >= 128 && bid < 160 ? bid - 128 : 32) : nb - 1 - bid); u < 32; u += nb) for (int rp_ = 0; rp_ < DUP_CMP; ++rp_) { if (rp_) __syncthreads(); cmp_unit(u, l, in, ws, lds, g_wv); }
#endif
    PSTAMP(45, 255);
    __syncthreads();
#ifndef NO_DELTA
    { int tid_ = TIDX; asm volatile("" : "+v"(tid_)); LAS int* slot = (LAS int*)(lds + LDS_MISC + 64);
      for (;;) {
          __syncthreads();
          if (tid_ == 0) *slot = (int)__hip_atomic_fetch_add(dq, 1u, __ATOMIC_RELAXED, __HIP_MEMORY_SCOPE_AGENT);
          __syncthreads();
          const int g = *slot; if (g >= 96 + 128) break;
          const int wv = tid_ >> 6;
          const int cu_ = g < 96 ? g * 8 + wv : 768 + (g - 96) * 2 + wv;
          if (g < 96 || wv < 2) { for (int rp_ = 0; rp_ < DUP_DELTA; ++rp_) ml_delta_wave(cu_, l, in, ws, lds + wv * 16384, tid_ & 63); }
      } }
#endif
    __syncthreads(); PSTAMP(43, 0);
}
#define CHK_TOL(st) (((st) & 15) == 8 ? 1e-2f : 1e-3f)
#define CHECK_REST
constexpr int VTP = 192;
typedef short v4i16_t __attribute__((ext_vector_type(4)));
__device__ __forceinline__ int vt_lane_off(int lane) { return (4 * (lane >> 5) + ((lane & 15) >> 2)) * VTP + ((((lane >> 4) & 1) * 16) + 4 * (lane & 3)) * 2; }
__device__ __forceinline__ bf16x8 vt_frag(const LAS unsigned char* Vt, int voff, int s4, int eb) {
    const LAS unsigned char* a = Vt + voff + 16 * s4 * VTP + 64 * eb;
    const v4i16_t lo = __builtin_amdgcn_ds_read_tr16_b64_v4i16((LAS v4i16_t*)a), hi = __builtin_amdgcn_ds_read_tr16_b64_v4i16((LAS v4i16_t*)(a + 8 * VTP));
    return (bf16x8){lo[0], lo[1], lo[2], lo[3], hi[0], hi[1], hi[2], hi[3]};
}
__device__ __forceinline__ int crow(int reg, int h) { return (reg & 3) + 8 * (reg >> 2) + 4 * h; }
struct AttnState { f32x16 o[2]; float m, l; };
__device__ __forceinline__ void attn_reset(AttnState& A) { A.m = -1e30f; A.l = 0.f;
#pragma unroll
    for (int i = 0; i < 16; ++i) { A.o[0][i] = 0.f; A.o[1][i] = 0.f; } }

template <int DK>
__device__ __forceinline__ void attn_scores(f32x16 (&s)[2], const bf16x8 (&qf)[DK / 16], const LAS unsigned char* Kt, int r, int h) {
    constexpr int KP = 2 * DK + 16, NK = DK / 16;
    bf16x8 kf[2][NK];
#pragma unroll
    for (int kb = 0; kb < 2; ++kb)
#pragma unroll
        for (int ks = 0; ks < NK; ++ks) kf[kb][ks] = *(const LAS bf16x8*)(Kt + (32 * kb + r) * KP + (16 * ks + 8 * h) * 2);
    __builtin_amdgcn_sched_barrier(0);
#pragma unroll
    for (int kb = 0; kb < 2; ++kb)
#pragma unroll
        for (int i = 0; i < 16; ++i) s[kb][i] = 0.f;
#pragma unroll
    for (int ks = 0; ks < NK; ++ks) {
        s[0] = MFMA32(kf[0][ks], qf[ks], s[0]);
        s[1] = MFMA32(kf[1][ks], qf[ks], s[1]);
    }
}
__device__ __forceinline__ float max3f(float a, float b, float c) { return fmaxf(fmaxf(a, b), c); }
__device__ __forceinline__ void attn_softmax_pv(AttnState& A, f32x16 (&s)[2], const LAS unsigned char* Vt, int r, int h, float bias_c = 0.f, bool lane_ok = true) {
    constexpr float THR = 8.f; const int voff = vt_lane_off(r + 32 * h);
    float mx = max3f(s[0][0], s[0][1], s[0][2]);
#pragma unroll
    for (int i = 3; i < 15; i += 2) mx = max3f(mx, s[0][i], s[0][i + 1]);
    mx = max3f(mx, s[0][15], s[1][0]);
#pragma unroll
    for (int i = 1; i < 15; i += 2) mx = max3f(mx, s[1][i], s[1][i + 1]);
    mx = fmaxf(mx, s[1][15]);
    mx = fmaxf(mx, __shfl_xor(mx, 32));
    const float mxb = (lane_ok && mx > -1e29f) ? mx + bias_c : -1e30f;
    const bool grow = mxb > A.m + THR;
    const float mnew = grow ? mxb : A.m;
    if (__any(grow)) {
        const float alpha = __builtin_amdgcn_exp2f(A.m - mnew);
        A.l *= alpha;
#pragma unroll
        for (int i = 0; i < 16; ++i) { A.o[0][i] *= alpha; A.o[1][i] *= alpha; }
    }
    A.m = mnew;
    const float sub = (lane_ok && mnew > -1e29f) ? mnew - bias_c : 1e30f;
    float rs = 0.f;
#pragma unroll
    for (int kb = 0; kb < 2; ++kb)
#pragma unroll
        for (int i = 0; i < 16; ++i) { const float p = __builtin_amdgcn_exp2f(s[kb][i] - sub); s[kb][i] = p; rs += p; }
    rs += __shfl_xor(rs, 32);
    A.l += rs;
    bf16x8 vf[4][2];
#pragma unroll
    for (int s4 = 0; s4 < 4; ++s4)
#pragma unroll
        for (int eb = 0; eb < 2; ++eb) vf[s4][eb] = vt_frag(Vt, voff, s4, eb);
    __builtin_amdgcn_sched_barrier(0);
#pragma unroll
    for (int s4 = 0; s4 < 4; ++s4) {
        const int kb = s4 >> 1, hf = (s4 & 1) * 8;
        u32x4 pw; pw.x = pk_bf16(s[kb][hf + 0], s[kb][hf + 1]); pw.y = pk_bf16(s[kb][hf + 2], s[kb][hf + 3]); pw.z = pk_bf16(s[kb][hf + 4], s[kb][hf + 5]); pw.w = pk_bf16(s[kb][hf + 6], s[kb][hf + 7]);
        const bf16x8 pf = __builtin_bit_cast(bf16x8, pw);
#pragma unroll
        for (int eb = 0; eb < 2; ++eb) A.o[eb] = MFMA32(vf[s4][eb], pf, A.o[eb]);
    }
}
template <int DK>
__device__ __forceinline__ void attn_scores_half(f32x16& s, const bf16x8 (&qf)[DK / 16], const LAS unsigned char* Kt, int r, int h, int kb) {
    constexpr int KP = 2 * DK + 16, NK = DK / 16;
    bf16x8 kf[NK];
#pragma unroll
    for (int ks = 0; ks < NK; ++ks) kf[ks] = *(const LAS bf16x8*)(Kt + (32 * kb + r) * KP + (16 * ks + 8 * h) * 2);
    __builtin_amdgcn_sched_barrier(0);
#pragma unroll
    for (int i = 0; i < 16; ++i) s[i] = 0.f;
#pragma unroll
    for (int ks = 0; ks < NK; ++ks) s = MFMA32(kf[ks], qf[ks], s);
}
__device__ __forceinline__ void attn_softmax_pv_half(AttnState& A, f32x16& s, const LAS unsigned char* Vt, int r, int h, int kb, float bias_c = 0.f, bool lane_ok = true) {
    constexpr float THR = 8.f; const int voff = vt_lane_off(r + 32 * h);
    float mx = max3f(s[0], s[1], s[2]);
#pragma unroll
    for (int i = 3; i < 15; i += 2) mx = max3f(mx, s[i], s[i + 1]);
    mx = fmaxf(mx, s[15]);
    mx = fmaxf(mx, __shfl_xor(mx, 32));
    const float mxb = (lane_ok && mx > -1e29f) ? mx + bias_c : -1e30f;
    const bool grow = mxb > A.m + THR;
    const float mnew = grow ? mxb : A.m;
    if (__any(grow)) {
        const float alpha = __builtin_amdgcn_exp2f(A.m - mnew);
        A.l *= alpha;
#pragma unroll
        for (int i = 0; i < 16; ++i) { A.o[0][i] *= alpha; A.o[1][i] *= alpha; }
    }
    A.m = mnew;
    const float sub = (lane_ok && mnew > -1e29f) ? mnew - bias_c : 1e30f;
    float rs = 0.f;
#pragma unroll
    for (int i = 0; i < 16; ++i) { const float p = __builtin_amdgcn_exp2f(s[i] - sub); s[i] = p; rs += p; }
    rs += __shfl_xor(rs, 32);
    A.l += rs;
    bf16x8 vf[2][2];
#pragma unroll
    for (int s2 = 0; s2 < 2; ++s2)
#pragma unroll
        for (int eb = 0; eb < 2; ++eb) vf[s2][eb] = vt_frag(Vt, voff, 2 * kb + s2, eb);
    __builtin_amdgcn_sched_barrier(0);
#pragma unroll
    for (int s2 = 0; s2 < 2; ++s2) {
        const int hf = s2 * 8;
        u32x4 pw; pw.x = pk_bf16(s[hf + 0], s[hf + 1]); pw.y = pk_bf16(s[hf + 2], s[hf + 3]); pw.z = pk_bf16(s[hf + 4], s[hf + 5]); pw.w = pk_bf16(s[hf + 6], s[hf + 7]);
        const bf16x8 pf = __builtin_bit_cast(bf16x8, pw);
#pragma unroll
        for (int eb = 0; eb < 2; ++eb) A.o[eb] = MFMA32(vf[s2][eb], pf, A.o[eb]);
    }
}
template <int DK>
__device__ __forceinline__ void stage_k_load(u32x4 (&kr)[2], const bf16_t* Kg  , int tid) {
    constexpr int CH = DK / 8;
    kr[0] = *(const u32x4*)(Kg + (size_t)(tid / CH) * DK + (tid % CH) * 8);
    if (64 * CH > 512) { const int c2 = tid + 512; if (c2 < 64 * CH) kr[1] = *(const u32x4*)(Kg + (size_t)(c2 / CH) * DK + (c2 % CH) * 8); }
}
template <int DK>
__device__ __forceinline__ void stage_k_store(const u32x4 (&kr)[2], LAS unsigned char* Kt, int tid) {
    constexpr int CH = DK / 8, KP = 2 * DK + 16;
    *(LAS u32x4*)(Kt + (tid / CH) * KP + (tid % CH) * 16) = kr[0];
    if (64 * CH > 512) { const int c2 = tid + 512; if (c2 < 64 * CH) *(LAS u32x4*)(Kt + (c2 / CH) * KP + (c2 % CH) * 16) = kr[1]; }
}
__device__ __forceinline__ u32x4 stage_v_load(const bf16_t* Vg, int tid) { return *(const u32x4*)(Vg + (size_t)(tid >> 3) * 64 + (tid & 7) * 8); }
__device__ __forceinline__ void stage_v_store(const u32x4& v, LAS unsigned char* Vt, int tid) { *(LAS u32x4*)(Vt + (tid >> 3) * VTP + (tid & 7) * 16) = v; }

constexpr int MLA_KT = 0, MLA_VT = 2 * 64 * 208, MLA_LDS = MLA_VT + 2 * 64 * VTP;
__device__ __forceinline__ void mla_unit(int b, int hd, int qt, int l, unsigned char* ws, LAS unsigned char* lds, int g_wv) {
    int tid_ = TIDX; asm volatile("" : "+v"(tid_));
    const int tid = tid_, w = tid >> 6, lane = tid & 63, r = lane & 31, h = lane >> 5;
    const size_t slab = (size_t)(b * 6 + hd) * 2048;
    const bf16_t* QM = (const bf16_t*)(ws + WS_MLA) + slab * 96; const bf16_t* KM = (const bf16_t*)(ws + WS_MLA + MLA_KM) + slab * 96; const bf16_t* VM = (const bf16_t*)(ws + WS_MLA + MLA_VM) + slab * 64;
    const int q0 = 256 * qt + 32 * w, q = q0 + r;
    bf16x8 qf[6];
#pragma unroll
    for (int ks = 0; ks < 6; ++ks) qf[ks] = *(const bf16x8*)(QM + (size_t)q * 96 + 16 * ks + 8 * h);
    AttnState A; attn_reset(A);
    const int ntile = 4 * qt + 4;
    u32x4 kr[2], vr, kr2[2], vr2;
    stage_k_load<96>(kr, KM, tid); vr = stage_v_load(VM, tid);
    stage_k_store<96>(kr, lds + MLA_KT, tid); stage_v_store(vr, lds + MLA_VT, tid);
    if (ntile > 1) { stage_k_load<96>(kr, KM + (size_t)64 * 96, tid); vr = stage_v_load(VM + (size_t)64 * 64, tid); }
    __syncthreads();
    auto tile_step = [&](const int j, u32x4 (&kc)[2], u32x4& vc, u32x4 (&kn)[2], u32x4& vn) __attribute__((always_inline)) {
        const int cur = j & 1;
        if (j + 2 < ntile) { stage_k_load<96>(kn, KM + (size_t)(j + 2) * 64 * 96, tid); vn = stage_v_load(VM + (size_t)(j + 2) * 64 * 64, tid); }
        if (64 * j <= q0 + 31) {
            f32x16 s[2];
            attn_scores<96>(s, qf, lds + MLA_KT + cur * 64 * 208, r, h);
            if (64 * j + 63 > q0) {
#pragma unroll
                for (int kb = 0; kb < 2; ++kb)
#pragma unroll
                    for (int i = 0; i < 16; ++i) { const int key = 64 * j + 32 * kb + crow(i, h); if (key > q) s[kb][i] = -1e30f; }
            }
            attn_softmax_pv(A, s, lds + MLA_VT + cur * 64 * VTP, r, h);
        }
        if (j + 1 < ntile) { stage_k_store<96>(kc, lds + MLA_KT + (cur ^ 1) * 64 * 208, tid); stage_v_store(vc, lds + MLA_VT + (cur ^ 1) * 64 * VTP, tid); }
        __syncthreads();
    };
#pragma unroll 1
    for (int j = 0; j < ntile; j += 2) { tile_step(j, kr, vr, kr2, vr2); tile_step(j + 1, kr2, vr2, kr, vr); }
    const float inv = A.l > 0.f ? 1.f / A.l : 0.f; float ss = 0.f;
    bf16_t* Y = (bf16_t*)(ws + WS_Y) + ((size_t)b * 2048 + q) * 1024 + 384 + hd * 64;
#pragma unroll
    for (int eb = 0; eb < 2; ++eb)
#pragma unroll
        for (int g4 = 0; g4 < 4; ++g4) {
            const float v0 = A.o[eb][4 * g4] * inv, v1 = A.o[eb][4 * g4 + 1] * inv, v2 = A.o[eb][4 * g4 + 2] * inv, v3 = A.o[eb][4 * g4 + 3] * inv;
            u32x2 pw; pw.x = pk_bf16(v0, v1); pw.y = pk_bf16(v2, v3);
            const float f0 = bf_lo(pw.x), f1 = bf_hi(pw.x), f2 = bf_lo(pw.y), f3 = bf_hi(pw.y); ss += (f0 * f0 + f1 * f1) + (f2 * f2 + f3 * f3);
            *(u32x2*)(Y + 32 * eb + 8 * g4 + 4 * h) = pw;
        }
    ss += __shfl_xor(ss, 32);
    if (h == 0) ((float*)(ws + WS_SSQ + PT_C))[((size_t)l * 16384 + (size_t)b * 2048 + q) * 8 + hd] = ss;
}

__device__ __forceinline__ void nsa_bias32(float (&bv)[2][16], const LAS float* bl, int dd) {
#pragma unroll
    for (int kb = 0; kb < 2; ++kb)
#pragma unroll
        for (int k = 0; k < 16; ++k) { const int c = 63 - (32 * kb + (k & 3) + 8 * (k >> 2)); int d = dd + c; d = d < 0 ? 0 : (d > 255 ? 255 : d); bv[kb][k] = bl[d]; }
}
__device__ __forceinline__ void nsa_mask_bias(f32x16 (&sc)[2], int dq, int h, const LAS float* bl) {
    int dd = dq - 4 * h - 63; asm volatile("" : "+v"(dd));
    const LAS float* p = bl + dd;
    float bv[2][16];
#pragma unroll
    for (int kb = 0; kb < 2; ++kb)
#pragma unroll
        for (int k = 0; k < 16; ++k) bv[kb][k] = p[63 - (32 * kb + (k & 3) + 8 * (k >> 2))];
#pragma unroll
    for (int kb = 0; kb < 2; ++kb)
#pragma unroll
        for (int k = 0; k < 16; ++k) sc[kb][k] += bv[kb][k];
}
__device__ __forceinline__ void nsa_mask_bias_half(f32x16& sc, int dq, int h, const LAS float* bl, int kb) {
    int dd = dq - 4 * h - 32 * kb - 31; asm volatile("" : "+v"(dd));
    const LAS float* p = bl + dd;
    float bv[16];
#pragma unroll
    for (int k = 0; k < 16; ++k) bv[k] = p[31 - ((k & 3) + 8 * (k >> 2))];
#pragma unroll
    for (int k = 0; k < 16; ++k) sc[k] += bv[k];
}
__device__ __forceinline__ void attn_park(const AttnState& A, LAS float* xl) {
    xl[0] = A.m; xl[64] = A.l;
#pragma unroll
    for (int k = 0; k < 16; ++k) { xl[64 * (2 + k)] = A.o[0][k]; xl[64 * (18 + k)] = A.o[1][k]; }
}
__device__ __forceinline__ void attn_merge(AttnState& A, const LAS float* xl) {
    const float m2 = xl[0], l2 = xl[64]; const float m = fmaxf(A.m, m2);
    const float a1 = A.m > -1e29f ? __builtin_amdgcn_exp2f(A.m - m) : 0.f, a2 = m2 > -1e29f ? __builtin_amdgcn_exp2f(m2 - m) : 0.f;
    A.l = A.l * a1 + l2 * a2; A.m = m;
#pragma unroll
    for (int k = 0; k < 16; ++k) { A.o[0][k] = A.o[0][k] * a1 + xl[64 * (2 + k)] * a2; A.o[1][k] = A.o[1][k] * a1 + xl[64 * (18 + k)] * a2; }
}
constexpr int NSA_KT = 0, NSA_VT = 2 * 64 * 144, NSA_BIAS = NSA_VT + 2 * 64 * VTP, NSA_PS = NSA_BIAS + 3 * 640 * 4, NSA_SEL = NSA_PS + 3 * 64 * 32 * 4, NSA_UNI = NSA_SEL + 256, NSA_OT = NSA_UNI + 256, NSA_LDS = NSA_OT + 6 * 8192;
__device__ __forceinline__ void nsa_unit(int b, int hk, int i, int l, InPtr in, unsigned char* ws, LAS unsigned char* lds, int g_wv) {
    int tid_ = TIDX; asm volatile("" : "+v"(tid_));
    const int tid = tid_, w = tid >> 6, lane = tid & 63, r = lane & 31, h = lane >> 5;
    const bool active = w < 6; const int g = active ? (w >> 1) : 2, th = w & 1, head = hk * 3 + g;
    const int kh = w < 4 ? -1 : (w < 6 ? 0 : 1);
    LAS float* xl = (LAS float*)(lds + NSA_LDS) + th * (34 * 64) + lane;
    const int t = 64 * i + 32 * th + r, tl = 32 * th + r; const size_t row = (size_t)b * 2048 + t;
    const size_t kvslab = (size_t)(b * 2 + hk) * 2048 * 64;
    LAS float* biasl = (LAS float*)(lds + NSA_BIAS); LAS float* PS = (LAS float*)(lds + NSA_PS); LAS unsigned* SEL = (LAS unsigned*)(lds + NSA_SEL); LAS unsigned* UNI = (LAS unsigned*)(lds + NSA_UNI);
    { const float* bd = (const float*)(ws + WS_BIASD) + (size_t)hk * 3 * 2048;
#pragma unroll
      for (int k = 0; k < 4; ++k) { const int e = tid + 512 * k; if (e < 1920) { const int gg = e / 640, d = e - gg * 640 - 63; biasl[e] = (d < 0 || d >= 512) ? -1e30f : bd[gg * 2048 + d]; } }
#pragma unroll
      for (int k = 0; k < 12; ++k) if (i >= 16) PS[tid + 512 * k] = 0.f;
      if (tid < 4) UNI[tid] = 0u; }
    bf16x8 qf[4];
    { const bf16_t* QN = (const bf16_t*)(ws + WS_PRJ + PRJ_QN) + ((size_t)(b * 6 + head) * 2048 + t) * 64;
#pragma unroll
      for (int ks = 0; ks < 4; ++ks) qf[ks] = *(const bf16x8*)(QN + 16 * ks + 8 * h); }
#define NSA_GATE(k) ({ int t_ = t; asm volatile("" : "+v"(t_)); sigmf(((const float*)(ws + WS_PRJ + PRJ_GATES))[((size_t)b * 2048 + t_) * 32 + head * 3 + (k)]); })
    LAS float* bl = biasl + g * 640 + 63;
    LAS float* otl = (LAS float*)(lds + NSA_OT + (active ? w : 0) * 8192) + lane;
    u32x4 kr[2], vr;
    const int ntc = i >= 16 ? 2 : 1;
    { const bf16_t* KC = (const bf16_t*)(ws + WS_CMP) + (size_t)(b * 2 + hk) * 128 * 64; const bf16_t* VC = (const bf16_t*)(ws + WS_CMP + CMP_V) + (size_t)(b * 2 + hk) * 128 * 64;
      for (int T = 0; T < ntc; ++T) { stage_k_load<64>(kr, KC + T * 4096, tid); vr = stage_v_load(VC + T * 4096, tid); stage_k_store<64>(kr, lds + NSA_KT + T * 64 * 144, tid); stage_v_store(vr, lds + NSA_VT + T * 64 * VTP, tid); } }
    __syncthreads();
    {
        f32x16 ot[2];
        if (active && i < 16) {
            AttnState A; attn_reset(A); f32x16 sc[2]; attn_scores<64>(sc, qf, lds + NSA_KT, r, h);
            float bvc[2][16];
#pragma unroll
            for (int kb = 0; kb < 2; ++kb)
#pragma unroll
                for (int k = 0; k < 16; ++k) { int d = t - 16 * (32 * kb + crow(k, h)) - 31; d = d < 0 ? 0 : (d > 255 ? 255 : d); bvc[kb][k] = bl[d]; }
#pragma unroll
            for (int kb = 0; kb < 2; ++kb)
#pragma unroll
                for (int k = 0; k < 16; ++k) { const int d = t - 16 * (32 * kb + crow(k, h)) - 31; sc[kb][k] = d >= 0 ? sc[kb][k] + bvc[kb][k] : -1e30f; }
            attn_softmax_pv(A, sc, lds + NSA_VT, r, h);
            const float gc = NSA_GATE(0); const float inv = A.l > 0.f ? gc / A.l : 0.f;
#pragma unroll
            for (int k = 0; k < 16; ++k) { otl[64 * k] = A.o[0][k] * inv; otl[64 * (16 + k)] = A.o[1][k] * inv; }
        } else if (active) {
            float m = -1e30f, lsum = 0.f;
            for (int T = 0; T < ntc; ++T) {
                f32x16 sc[2]; attn_scores<64>(sc, qf, lds + NSA_KT + T * 64 * 144, r, h);
                float bvc[2][16];
#pragma unroll
                for (int kb = 0; kb < 2; ++kb)
#pragma unroll
                    for (int k = 0; k < 16; ++k) { int d = t - 16 * (64 * T + 32 * kb + crow(k, h)) - 31; d = d < 0 ? 0 : (d > 255 ? 255 : d); bvc[kb][k] = bl[d]; }
                float mx = -1e30f;
#pragma unroll
                for (int kb = 0; kb < 2; ++kb)
#pragma unroll
                    for (int k = 0; k < 16; ++k) { const int n = 64 * T + 32 * kb + crow(k, h); const int d = t - 16 * n - 31; const float x = (d >= 0 && n < 127) ? sc[kb][k] + bvc[kb][k] : -1e30f; sc[kb][k] = x; mx = fmaxf(mx, x); }
                mx = fmaxf(mx, __shfl_xor(mx, 32));
                const float mnew = fmaxf(m, mx), mref = mnew <= -1e29f ? 0.f : mnew; float rs = 0.f;
#pragma unroll
                for (int kb = 0; kb < 2; ++kb)
#pragma unroll
                    for (int k = 0; k < 16; ++k) rs += __builtin_amdgcn_exp2f(sc[kb][k] - mref);
                rs += __shfl_xor(rs, 32);
                lsum = lsum * __builtin_amdgcn_exp2f(m - mref) + rs; m = mnew;
            }
            const float mref = m <= -1e29f ? 0.f : m, inv = lsum > 0.f ? 1.f / lsum : 0.f;
#pragma unroll
            for (int k = 0; k < 16; ++k) { ot[0][k] = 0.f; ot[1][k] = 0.f; }
            float carry = 0.f;
            for (int T = 0; T < ntc; ++T) {
                f32x16 sc[2]; attn_scores<64>(sc, qf, lds + NSA_KT + T * 64 * 144, r, h);
                float bvc[2][16];
#pragma unroll
                for (int kb = 0; kb < 2; ++kb)
#pragma unroll
                    for (int k = 0; k < 16; ++k) { int d = t - 16 * (64 * T + 32 * kb + crow(k, h)) - 31; d = d < 0 ? 0 : (d > 255 ? 255 : d); bvc[kb][k] = bl[d]; }
#pragma unroll
                for (int kb = 0; kb < 2; ++kb)
#pragma unroll
                    for (int k = 0; k < 16; ++k) { const int n = 64 * T + 32 * kb + crow(k, h); const int d = t - 16 * n - 31; sc[kb][k] = (d >= 0 && n < 127) ? __builtin_amdgcn_exp2f(sc[kb][k] + bvc[kb][k] - mref) * inv : 0.f; }
                float prevL = carry;
#pragma unroll
                for (int kb = 0; kb < 2; ++kb)
#pragma unroll
                    for (int g4 = 0; g4 < 4; ++g4) {
                        const float G4 = (sc[kb][4 * g4] + sc[kb][4 * g4 + 1]) + (sc[kb][4 * g4 + 2] + sc[kb][4 * g4 + 3]); const float L = sc[kb][4 * g4 + 3];
                        const float Lo = __shfl_xor(L, 32);
                        const float add = h ? Lo : prevL;
                        prevL = Lo;
                        const int idx = T * 8 + kb * 4 + g4;
                        PS[g * 2048 + tl * 32 + 2 * idx + h] = G4 + add;
                    }
                carry = prevL;
#pragma unroll
                for (int s4 = 0; s4 < 4; ++s4) {
                    const int kb = s4 >> 1, hf = (s4 & 1) * 8;
                    u32x4 pw; pw.x = pk_bf16(sc[kb][hf + 0], sc[kb][hf + 1]); pw.y = pk_bf16(sc[kb][hf + 2], sc[kb][hf + 3]); pw.z = pk_bf16(sc[kb][hf + 4], sc[kb][hf + 5]); pw.w = pk_bf16(sc[kb][hf + 6], sc[kb][hf + 7]);
                    const bf16x8 pf = __builtin_bit_cast(bf16x8, pw);
#pragma unroll
                    for (int eb = 0; eb < 2; ++eb) ot[eb] = MFMA32(vt_frag(lds + NSA_VT + T * 64 * VTP, vt_lane_off(lane), s4, eb), pf, ot[eb]);
                }
            }
            { const float gc = NSA_GATE(0);
#pragma unroll
            for (int k = 0; k < 16; ++k) { otl[64 * k] = ot[0][k] * gc; otl[64 * (16 + k)] = ot[1][k] * gc; } }
        }
    }
    __syncthreads();
#ifndef NO_NSA_SEL
    if (i < 16) { if (tid < 64) SEL[tid] = (2u << i) - 1u; if (tid < 3) UNI[tid] = (2u << i) - 1u; }
    else {
        const int tk = tid >> 3, sg = tid & 7; float v[32];
#pragma unroll
        for (int k = 0; k < 8; ++k) { const f32x4 x0 = *(const LAS f32x4*)(PS + tk * 32 + 4 * k), x1 = *(const LAS f32x4*)(PS + 2048 + tk * 32 + 4 * k), x2 = *(const LAS f32x4*)(PS + 4096 + tk * 32 + 4 * k);
            v[4 * k] = (x0.x + x1.x) + x2.x; v[4 * k + 1] = (x0.y + x1.y) + x2.y; v[4 * k + 2] = (x0.z + x1.z) + x2.z; v[4 * k + 3] = (x0.w + x1.w) + x2.w; }
#pragma unroll
        for (int s = 0; s < 32; ++s) { const bool forced = (s == 0) || (s == i) || (s == i - 1); float x = forced ? v[s] + 1e4f : v[s]; v[s] = s > i ? -1.f : x; }
        unsigned bits = 0u;
#pragma unroll
        for (int k = 0; k < 4; ++k) {
            float x = 0.f;
#pragma unroll
            for (int s = 0; s < 32; ++s) x = (s == 4 * sg + k) ? v[s] : x;
            int rank = 0;
#pragma unroll
            for (int s = 0; s < 32; ++s) rank += (v[s] > x || (v[s] == x && s < 4 * sg + k)) ? 1 : 0;
            if (rank < 16 && x >= 0.f) bits |= 1u << (4 * sg + k);
        }
        bits |= shx<1>(bits); bits |= shx<2>(bits); bits |= shx<4>(bits);
        if (sg == 0) { SEL[tk] = bits; __hip_atomic_fetch_or(UNI, bits, __ATOMIC_RELAXED, __HIP_MEMORY_SCOPE_WORKGROUP); __hip_atomic_fetch_or(UNI + 1 + (tk >> 5), bits, __ATOMIC_RELAXED, __HIP_MEMORY_SCOPE_WORKGROUP); }
    }
#endif
    __syncthreads();
    const unsigned selbits = SEL[tl], uni = UNI[0], unih = UNI[1 + th];
    const float c31 = bl[255];
#ifndef NO_NSA_SLC
#ifndef NSA_DUP_SLC
#define NSA_DUP_SLC 1
#endif
    for (int rp_ = 0; rp_ < NSA_DUP_SLC; ++rp_) {
        AttnState A; attn_reset(A);
        const bf16_t* KS = (const bf16_t*)(ws + WS_PRJ + PRJ_KN1) + kvslab; const bf16_t* VS = (const bf16_t*)(ws + WS_PRJ + PRJ_VN1) + kvslab;
        unsigned todo = uni; int cur = 0; u32x4 kr2[2], vr2;
        int s = __ffs(todo) - 1; todo &= todo - 1;
        stage_k_load<64>(kr, KS + (size_t)s * 4096, tid); vr = stage_v_load(VS + (size_t)s * 4096, tid);
        stage_k_store<64>(kr, lds + NSA_KT, tid); stage_v_store(vr, lds + NSA_VT, tid);
        int sn = todo ? __ffs(todo) - 1 : -1; todo &= todo - 1;
        if (sn >= 0) { stage_k_load<64>(kr, KS + (size_t)sn * 4096, tid); vr = stage_v_load(VS + (size_t)sn * 4096, tid); }
        __syncthreads();
        while (s >= 0) {
            const int sn2 = todo ? __ffs(todo) - 1 : -1; todo &= todo - 1;
            if (sn2 >= 0) { stage_k_load<64>(kr2, KS + (size_t)sn2 * 4096, tid); vr2 = stage_v_load(VS + (size_t)sn2 * 4096, tid); }
            if ((unih >> s) & 1u) {
                const bool sel = (selbits >> s) & 1u;
                if (kh < 0) {
                    f32x16 sc[2];
                    attn_scores<64>(sc, qf, lds + NSA_KT + cur * 64 * 144, r, h);
                    if (i - s >= 3) attn_softmax_pv(A, sc, lds + NSA_VT + cur * 64 * VTP, r, h, c31, sel);
                    else { nsa_mask_bias(sc, t - 64 * s, h, bl); attn_softmax_pv(A, sc, lds + NSA_VT + cur * 64 * VTP, r, h, 0.f, sel); }
                } else {
                    f32x16 s1;
                    attn_scores_half<64>(s1, qf, lds + NSA_KT + cur * 64 * 144, r, h, kh);
                    if (i - s >= 3) attn_softmax_pv_half(A, s1, lds + NSA_VT + cur * 64 * VTP, r, h, kh, c31, sel);
                    else { nsa_mask_bias_half(s1, t - 64 * s, h, bl, kh); attn_softmax_pv_half(A, s1, lds + NSA_VT + cur * 64 * VTP, r, h, kh, 0.f, sel); }
                }
            }
            if (sn >= 0) { stage_k_store<64>(kr, lds + NSA_KT + (cur ^ 1) * 64 * 144, tid); stage_v_store(vr, lds + NSA_VT + (cur ^ 1) * 64 * VTP, tid); }
            kr[0] = kr2[0]; vr = vr2;
            __syncthreads();
            s = sn; sn = sn2; cur ^= 1;
        }
        if (kh == 1) attn_park(A, xl);
        __syncthreads();
        if (kh == 0) attn_merge(A, xl);
        if (active && rp_ == NSA_DUP_SLC - 1) { const float gs = NSA_GATE(1); const float inv = A.l > 0.f ? gs / A.l : 0.f;
#pragma unroll
            for (int k = 0; k < 16; ++k) { otl[64 * k] += A.o[0][k] * inv; otl[64 * (16 + k)] += A.o[1][k] * inv; } }
    }
#endif
#ifndef NO_NSA_WIN
#ifndef NSA_DUP_WIN
#define NSA_DUP_WIN 1
#endif
    for (int rq_ = 0; rq_ < NSA_DUP_WIN; ++rq_) {
        AttnState A; attn_reset(A);
        const bf16_t* KW = (const bf16_t*)(ws + WS_PRJ + PRJ_KN2) + kvslab; const bf16_t* VW = (const bf16_t*)(ws + WS_PRJ + PRJ_VN2) + kvslab;
        const int j0 = i > 8 ? i - 8 : 0; int cur = 0; u32x4 kr2[2], vr2;
        stage_k_load<64>(kr, KW + (size_t)j0 * 4096, tid); vr = stage_v_load(VW + (size_t)j0 * 4096, tid);
        stage_k_store<64>(kr, lds + NSA_KT, tid); stage_v_store(vr, lds + NSA_VT, tid);
        if (j0 < i) { stage_k_load<64>(kr, KW + (size_t)(j0 + 1) * 4096, tid); vr = stage_v_load(VW + (size_t)(j0 + 1) * 4096, tid); }
        __syncthreads();
        for (int j = j0; j <= i; ++j) {
            if (j + 2 <= i) { stage_k_load<64>(kr2, KW + (size_t)(j + 2) * 4096, tid); vr2 = stage_v_load(VW + (size_t)(j + 2) * 4096, tid); }
            if (kh < 0) {
                f32x16 sc[2];
                attn_scores<64>(sc, qf, lds + NSA_KT + cur * 64 * 144, r, h);
                if (i - j >= 3 && j > i - 8) attn_softmax_pv(A, sc, lds + NSA_VT + cur * 64 * VTP, r, h, c31, true);
                else { nsa_mask_bias(sc, t - 64 * j, h, bl); attn_softmax_pv(A, sc, lds + NSA_VT + cur * 64 * VTP, r, h); }
            } else {
                f32x16 s1;
                attn_scores_half<64>(s1, qf, lds + NSA_KT + cur * 64 * 144, r, h, kh);
                if (i - j >= 3 && j > i - 8) attn_softmax_pv_half(A, s1, lds + NSA_VT + cur * 64 * VTP, r, h, kh, c31, true);
                else { nsa_mask_bias_half(s1, t - 64 * j, h, bl, kh); attn_softmax_pv_half(A, s1, lds + NSA_VT + cur * 64 * VTP, r, h, kh); }
            }
            if (j < i) { stage_k_store<64>(kr, lds + NSA_KT + (cur ^ 1) * 64 * 144, tid); stage_v_store(vr, lds + NSA_VT + (cur ^ 1) * 64 * VTP, tid); }
            kr[0] = kr2[0]; vr = vr2;
            __syncthreads();
            cur ^= 1;
        }
        if (kh == 1) attn_park(A, xl);
        __syncthreads();
        if (kh == 0) attn_merge(A, xl);
        if (active && rq_ == NSA_DUP_WIN - 1) { const float gw = NSA_GATE(2); const float inv = A.l > 0.f ? gw / A.l : 0.f;
            float ss = 0.f; bf16_t* Y = (bf16_t*)(ws + WS_Y) + row * 1024 + head * 64;
#pragma unroll
            for (int eb = 0; eb < 2; ++eb)
#pragma unroll
                for (int g4 = 0; g4 < 4; ++g4) {
                    const float v0 = otl[64 * (16 * eb + 4 * g4)] + A.o[eb][4 * g4] * inv, v1 = otl[64 * (16 * eb + 4 * g4 + 1)] + A.o[eb][4 * g4 + 1] * inv;
                    const float v2 = otl[64 * (16 * eb + 4 * g4 + 2)] + A.o[eb][4 * g4 + 2] * inv, v3 = otl[64 * (16 * eb + 4 * g4 + 3)] + A.o[eb][4 * g4 + 3] * inv;
                    u32x2 pw; pw.x = pk_bf16(v0, v1); pw.y = pk_bf16(v2, v3);
                    const float f0 = bf_lo(pw.x), f1 = bf_hi(pw.x), f2 = bf_lo(pw.y), f3 = bf_hi(pw.y); ss += (f0 * f0 + f1 * f1) + (f2 * f2 + f3 * f3);
                    *(u32x2*)(Y + 32 * eb + 8 * g4 + 4 * h) = pw;
                }
            ss += __shfl_xor(ss, 32);
            if (h == 0) ((float*)(ws + WS_SSQ + PT_A))[((size_t)l * 16384 + row) * 8 + head] = ss;
        }
    }
#endif
}

__device__ __forceinline__ void ml_out_wave(int cu, int l, InPtr in, unsigned char* ws, LAS unsigned char* wl, LAS unsigned char* npl, int lane) {
    const int c = cu & 31, bh = cu >> 5, hd = bh & 3, b = bh >> 2; const int t0 = c * 64; const int r = lane & 15, q = lane >> 4;
    const bf16_t* QC = (const bf16_t*)(ws + WS_ML) + ((size_t)bh * 2048 + t0) * 64; const bf16_t* KC = (const bf16_t*)(ws + WS_ML + ML_KC) + ((size_t)bh * 2048 + t0) * 64;
    const bf16_t* V = (const bf16_t*)(ws + WS_PRJ + PRJ_VML) + ((size_t)bh * 2048 + t0) * 64;
    const float* mlg = (const float*)(ws + WS_ML + ML_G) + ((size_t)bh * 2048 + t0) * 2;
    const bf16_t* CP = (const bf16_t*)(ws + WS_ML + ML_CP) + (size_t)cu * 4096; const bf16_t* NP = (const bf16_t*)(ws + WS_ML + ML_NP) + (size_t)cu * 64;
    u32x4 vch[8];
#pragma unroll
    for (int i = 0; i < 8; ++i) vch[i] = *(const u32x4*)(V + (size_t)(lane + 64 * i) * 8);
    bf16x8 aq[4][2];
#pragma unroll
    for (int mb = 0; mb < 4; ++mb)
#pragma unroll
        for (int ks = 0; ks < 2; ++ks) aq[mb][ks] = *(const bf16x8*)(QC + (size_t)(16 * mb + r) * 64 + 32 * ks + 8 * q);
    float bj[4][4], den[4][4];
#pragma unroll
    for (int mb = 0; mb < 4; ++mb)
#pragma unroll
        for (int j = 0; j < 4; ++j) bj[mb][j] = mlg[(16 * mb + 4 * q + j) * 2];
    {
        float cs[4];
#pragma unroll
        for (int nb = 0; nb < 4; ++nb) { const float2 gg = *(const float2*)(mlg + (16 * nb + r) * 2); cs[nb] = gg.y - gg.x; }
#pragma unroll
        for (int mb = 0; mb < 4; ++mb) {
            f32x4 accS[4];
#pragma unroll
            for (int nb = 0; nb < 4; ++nb) { accS[nb] = (f32x4){0.f, 0.f, 0.f, 0.f};
#pragma unroll
                for (int ks = 0; ks < 2; ++ks) { const bf16x8 bk = *(const bf16x8*)(KC + (size_t)(16 * nb + r) * 64 + 32 * ks + 8 * q); accS[nb] = MFMA16(aq[mb][ks], bk, accS[nb]); } }
#pragma unroll
            for (int j = 0; j < 4; ++j) {
                const int jj = 16 * mb + 4 * q + j; float rs = 0.f;
#pragma unroll
                for (int nb = 0; nb < 4; ++nb) { const int s = 16 * nb + r; const float p = s <= jj ? accS[nb][j] * __expf(bj[mb][j] + cs[nb]) : 0.f; rs += p;
                    *(LAS bf16_t*)(wl + 8192 + swz_off(jj, s >> 3) + (s & 7) * 2) = f2bf(p); }
                rs += shx<1>(rs); rs += shx<2>(rs); rs += shx<4>(rs); rs += shx<8>(rs);
                den[mb][j] = rs;
            }
        }
    }
#pragma unroll
    for (int i = 0; i < 8; ++i) { const int ch = lane + 64 * i, sv = ch >> 3, e0 = (ch & 7) * 8; const unsigned xs[4] = {vch[i].x, vch[i].y, vch[i].z, vch[i].w};
#pragma unroll
        for (int k = 0; k < 4; ++k) { *(LAS bf16_t*)(wl + swz_off(e0 + 2 * k, sv >> 3) + (sv & 7) * 2) = (bf16_t)(xs[k] & 0xffffu); *(LAS bf16_t*)(wl + swz_off(e0 + 2 * k + 1, sv >> 3) + (sv & 7) * 2) = (bf16_t)(xs[k] >> 16); } }
#pragma unroll
    for (int mb = 0; mb < 4; ++mb) { const float e = __expf(mlg[(16 * mb + r) * 2]);
#pragma unroll
        for (int ks = 0; ks < 2; ++ks) { const u32x4 x = __builtin_bit_cast(u32x4, aq[mb][ks]); u32x4 y;
            y.x = pk_bf16(bf_lo(x.x) * e, bf_hi(x.x) * e); y.y = pk_bf16(bf_lo(x.y) * e, bf_hi(x.y) * e); y.z = pk_bf16(bf_lo(x.z) * e, bf_hi(x.z) * e); y.w = pk_bf16(bf_lo(x.w) * e, bf_hi(x.w) * e);
            aq[mb][ks] = __builtin_bit_cast(bf16x8, y); } }
    f32x4 acc[4][4], accn[4];
#pragma unroll
    for (int mb = 0; mb < 4; ++mb) { accn[mb] = (f32x4){0.f, 0.f, 0.f, 0.f};
#pragma unroll
        for (int nb = 0; nb < 4; ++nb) acc[mb][nb] = (f32x4){0.f, 0.f, 0.f, 0.f}; }
#pragma unroll
    for (int ks = 0; ks < 2; ++ks) {
        u32x4 nz = *(const u32x4*)(NP + 32 * ks + 8 * q); if (r != 0) nz = (u32x4){0u, 0u, 0u, 0u};
        const bf16x8 bn = __builtin_bit_cast(bf16x8, nz);
#pragma unroll
        for (int nb = 0; nb < 4; ++nb) { const bf16x8 bb = *(const bf16x8*)(CP + (size_t)(16 * nb + r) * 64 + 32 * ks + 8 * q);
#pragma unroll
            for (int mb = 0; mb < 4; ++mb) acc[mb][nb] = MFMA16(aq[mb][ks], bb, acc[mb][nb]); }
#pragma unroll
        for (int mb = 0; mb < 4; ++mb) accn[mb] = MFMA16(aq[mb][ks], bn, accn[mb]);
    }
    LDS_FENCE();
#pragma unroll
    for (int ks = 0; ks < 2; ++ks) {
        bf16x8 ap[4];
#pragma unroll
        for (int mb = 0; mb < 4; ++mb) ap[mb] = *(const LAS bf16x8*)(wl + 8192 + swz_off(16 * mb + r, 4 * ks + q));
#pragma unroll
        for (int nb = 0; nb < 4; ++nb) { const bf16x8 bv = *(const LAS bf16x8*)(wl + swz_off(16 * nb + r, 4 * ks + q));
#pragma unroll
            for (int mb = 0; mb < 4; ++mb) acc[mb][nb] = MFMA16(ap[mb], bv, acc[mb][nb]); }
    }
    LDS_FENCE();
    const bf16_t* OG = (const bf16_t*)(ws + WS_PRJ + PRJ_OG); u32x4 ogc[8];
#pragma unroll
    for (int i = 0; i < 8; ++i) { const int ch = lane + 64 * i; ogc[i] = *(const u32x4*)(OG + ((size_t)b * 2048 + t0 + (ch >> 3)) * 256 + hd * 64 + (ch & 7) * 8); }
    const float* gain = in->p[14] + l * 256 + hd * 64;
    bf16_t* Y = (bf16_t*)(ws + WS_Y);
    float gn[4];
#pragma unroll
    for (int nb = 0; nb < 4; ++nb) gn[nb] = gain[16 * nb + r];
#pragma unroll
    for (int mb = 0; mb < 4; ++mb)
#pragma unroll
        for (int j = 0; j < 4; ++j) {
            const int jj = 16 * mb + 4 * q + j;
            const float dn = den[mb][j] + __builtin_bit_cast(float, __builtin_amdgcn_ds_bpermute((lane & 48) << 2, __builtin_bit_cast(int, accn[mb][j])));
            const float inv = __builtin_amdgcn_rcpf(fmaxf(fabsf(dn), 1.f)); float hv[4]; float ss = 0.f;
#pragma unroll
            for (int nb = 0; nb < 4; ++nb) { hv[nb] = acc[mb][nb][j] * inv; ss += hv[nb] * hv[nb]; }
            ss += shx<1>(ss); ss += shx<2>(ss); ss += shx<4>(ss); ss += shx<8>(ss);
            const float rstd = rsqrtf(ss * (1.f / 64.f) + 1e-6f);
#pragma unroll
            for (int nb = 0; nb < 4; ++nb) { const int e = 16 * nb + r; *(LAS bf16_t*)(wl + 8192 + swz_off(jj, e >> 3) + (e & 7) * 2) = f2bf(hv[nb] * rstd * gn[nb]); }
        }
    LDS_FENCE();
#pragma unroll
    for (int i = 0; i < 8; ++i) { const int ch = lane + 64 * i, row = ch >> 3, e8 = ch & 7;
        const u32x4 hx = *(const LAS u32x4*)(wl + 8192 + swz_off(row, e8)); const u32x4 g = ogc[i]; u32x4 o;
        o.x = pk_bf16(bf_lo(hx.x) * sigmf(bf_lo(g.x)), bf_hi(hx.x) * sigmf(bf_hi(g.x)));
        o.y = pk_bf16(bf_lo(hx.y) * sigmf(bf_lo(g.y)), bf_hi(hx.y) * sigmf(bf_hi(g.y)));
        o.z = pk_bf16(bf_lo(hx.z) * sigmf(bf_lo(g.z)), bf_hi(hx.z) * sigmf(bf_hi(g.z)));
        o.w = pk_bf16(bf_lo(hx.w) * sigmf(bf_lo(g.w)), bf_hi(hx.w) * sigmf(bf_hi(g.w)));
        *(u32x4*)(Y + ((size_t)b * 2048 + t0 + row) * 1024 + 768 + hd * 64 + e8 * 8) = o; }
    LDS_FENCE();
}

__device__ __forceinline__ void ml_scan_unit(int bh, int l, unsigned char* ws, int g_wv) {
    int tid_ = TIDX; asm volatile("" : "+v"(tid_)); const int tid = tid_;
    const bf16_t* DL = (const bf16_t*)(ws + WS_ML + ML_DELTA) + (size_t)bh * 32 * 4096 + tid * 8; bf16_t* CP = (bf16_t*)(ws + WS_ML + ML_CP) + (size_t)bh * 32 * 4096 + tid * 8;
    const float* DN = (const float*)(ws + WS_ML + ML_DN) + (size_t)bh * 32 * 64; bf16_t* NP = (bf16_t*)(ws + WS_ML + ML_NP) + (size_t)bh * 32 * 64; const float* BL = (const float*)(ws + WS_ML + ML_BL) + bh * 32;
    float c[8]; float n = 0.f;
#pragma unroll
    for (int k = 0; k < 8; ++k) c[k] = 0.f;
#pragma unroll 1
    for (int c0 = 0; c0 < 32; c0 += 8) {
        u32x4 d[8]; float dn[8], co[8];
#pragma unroll
        for (int k = 0; k < 8; ++k) { d[k] = *(const u32x4*)(DL + (size_t)(c0 + k) * 4096); dn[k] = tid < 64 ? DN[(c0 + k) * 64 + tid] : 0.f; co[k] = __expf(BL[c0 + k]); }
#pragma unroll
        for (int k = 0; k < 8; ++k) {
            u32x4 o; o.x = pk_bf16(c[0], c[1]); o.y = pk_bf16(c[2], c[3]); o.z = pk_bf16(c[4], c[5]); o.w = pk_bf16(c[6], c[7]);
            *(u32x4*)(CP + (size_t)(c0 + k) * 4096) = o; if (tid < 64) NP[(c0 + k) * 64 + tid] = f2bf(n);
            c[0] = co[k] * c[0] + bf_lo(d[k].x); c[1] = co[k] * c[1] + bf_hi(d[k].x); c[2] = co[k] * c[2] + bf_lo(d[k].y); c[3] = co[k] * c[3] + bf_hi(d[k].y);
            c[4] = co[k] * c[4] + bf_lo(d[k].z); c[5] = co[k] * c[5] + bf_hi(d[k].z); c[6] = co[k] * c[6] + bf_lo(d[k].w); c[7] = co[k] * c[7] + bf_hi(d[k].w);
            n = co[k] * n + dn[k];
        }
    }
    asm volatile("s_waitcnt vmcnt(0)" ::: "memory"); __syncthreads();
    if (tid == 0) { __builtin_amdgcn_fence(__ATOMIC_RELEASE, "agent"); asm volatile("s_waitcnt vmcnt(0)" ::: "memory");
        __hip_atomic_fetch_add((unsigned*)(ws + WS_CTL) + CW_SCAN + 64 * l, 1u, __ATOMIC_RELAXED, __HIP_MEMORY_SCOPE_AGENT); }
}
__device__ __forceinline__ void ml_scan_wait(int l, unsigned char* ws, int g_wv) {
    if (TIDX == 0) { unsigned* p = (unsigned*)(ws + WS_CTL) + CW_SCAN + 64 * l; unsigned sp = 0;
        while (__hip_atomic_load(p, __ATOMIC_RELAXED, __HIP_MEMORY_SCOPE_AGENT) < 32u) { __builtin_amdgcn_s_sleep(2); if (++sp > (1u << 22)) break; }
        __builtin_amdgcn_fence(__ATOMIC_ACQUIRE, "agent"); asm volatile("s_waitcnt vmcnt(0)" ::: "memory"); }
    __syncthreads();
}

#ifndef DUP_NSA
#define DUP_NSA 1
#endif
#ifndef DUP_MLA
#define DUP_MLA 1
#endif
#ifndef DUP_ML
#define DUP_ML 1
#endif
#ifdef NO_MLA
#define MLA_CALL(...) do {} while (0)
#else
#define MLA_CALL(...) do { for (int rp = 0; rp < DUP_MLA; ++rp) { if (rp) __syncthreads(); mla_unit(__VA_ARGS__); } } while (0)
#endif
__device__ __forceinline__ void phase_mix(int l, InPtr in, unsigned char* ws, LAS unsigned char* lds, unsigned* qhead, int g_wv) {
    LAS int* slot = (LAS int*)(lds + LDS_MISC + 64);
    for (;;) {
        __syncthreads();
        if (TIDX == 0) *slot = (int)__hip_atomic_fetch_add(qhead, 1u, __ATOMIC_RELAXED, __HIP_MEMORY_SCOPE_AGENT);
        __syncthreads();
        int u = *slot;
        if (u >= 32 + 512 + 384 + 128) break;
        if (u < 32) { ml_scan_unit(u, l, ws, g_wv); continue; } u -= 32;
#ifndef NO_NSA
        if (u < 256) { const int i = 31 - (u >> 4), bh = u & 15; { for (int rp = 0; rp < DUP_NSA; ++rp) { if (rp) __syncthreads(); nsa_unit(bh >> 1, bh & 1, i, l, in, ws, lds, g_wv); } } continue; }
#endif
        u -= 256;
        if (u < 192) { const int qt = 7 - u / 48, bh = u % 48; MLA_CALL(bh / 6, bh % 6, qt, l, ws, lds, g_wv); continue; }
        u -= 192;
#ifndef NO_NSA
        if (u < 128) { const int i = 15 - (u >> 4), bh = u & 15; { for (int rp = 0; rp < DUP_NSA; ++rp) { if (rp) __syncthreads(); nsa_unit(bh >> 1, bh & 1, i, l, in, ws, lds, g_wv); } } continue; }
#endif
        u -= 128;
        if (u < 192) { const int qt = 3 - u / 48, bh = u % 48; MLA_CALL(bh / 6, bh % 6, qt, l, ws, lds, g_wv); continue; } u -= 192;
#ifndef NO_NSA
        if (u < 128) { const int i = 7 - (u >> 4), bh = u & 15; { for (int rp = 0; rp < DUP_NSA; ++rp) { if (rp) __syncthreads(); nsa_unit(bh >> 1, bh & 1, i, l, in, ws, lds, g_wv); } } continue; }
#endif
        u -= 128;
#ifndef NO_MLOUT
        ml_scan_wait(l, ws, g_wv);
        for (int rp = 0; rp < DUP_ML; ++rp) { int tid_ = TIDX; asm volatile("" : "+v"(tid_)); const int w = tid_ >> 6; ml_out_wave(u * 8 + w, l, in, ws, lds + w * 16384, lds + 131072 + w * 256, tid_ & 63); }
#endif
    }
}
__device__ __forceinline__ void phase_ynorm(int l, unsigned char* ws, int bid, int nb, int g_wv) {
    int tid_ = TIDX; asm volatile("" : "+v"(tid_)); const int w = tid_ >> 6, lane = tid_ & 63;
    bf16_t* Y = (bf16_t*)(ws + WS_Y); const float* sa = (const float*)(ws + WS_SSQ + PT_A) + (size_t)l * 16384 * 8; const float* sc = (const float*)(ws + WS_SSQ + PT_C) + (size_t)l * 16384 * 8;
    for (int r0 = (bid * 8 + w) * 8; r0 < NTOK; r0 += nb * 64) {
        if (lane < 48) {
            u32x4 x[8], y[8]; float ra[8], rc[8];
#pragma unroll
            for (int k = 0; k < 8; ++k) { const int row = r0 + k;
                const f32x4 a0 = *(const f32x4*)(sa + (size_t)row * 8), a1 = *(const f32x4*)(sa + (size_t)row * 8 + 4), c0 = *(const f32x4*)(sc + (size_t)row * 8), c1 = *(const f32x4*)(sc + (size_t)row * 8 + 4);
                ra[k] = rsqrtf((((a0.x + a0.y) + (a0.z + a0.w)) + (a1.x + a1.y)) * (1.f / 384.f) + 1e-6f); rc[k] = rsqrtf((((c0.x + c0.y) + (c0.z + c0.w)) + (c1.x + c1.y)) * (1.f / 384.f) + 1e-6f);
                x[k] = *((const u32x4*)(Y + (size_t)row * 1024) + lane); y[k] = *((const u32x4*)(Y + (size_t)row * 1024 + 384) + lane); }
#pragma unroll
            for (int k = 0; k < 8; ++k) { const int row = r0 + k; u32x4 a = x[k], c = y[k]; const float fa = ra[k], fc = rc[k];
                a.x = pk_bf16(bf_lo(a.x) * fa, bf_hi(a.x) * fa); a.y = pk_bf16(bf_lo(a.y) * fa, bf_hi(a.y) * fa); a.z = pk_bf16(bf_lo(a.z) * fa, bf_hi(a.z) * fa); a.w = pk_bf16(bf_lo(a.w) * fa, bf_hi(a.w) * fa);
                c.x = pk_bf16(bf_lo(c.x) * fc, bf_hi(c.x) * fc); c.y = pk_bf16(bf_lo(c.y) * fc, bf_hi(c.y) * fc); c.z = pk_bf16(bf_lo(c.z) * fc, bf_hi(c.z) * fc); c.w = pk_bf16(bf_lo(c.w) * fc, bf_hi(c.w) * fc);
                *((u32x4*)(Y + (size_t)row * 1024) + lane) = a; *((u32x4*)(Y + (size_t)row * 1024 + 384) + lane) = c; }
        }
    }
}
constexpr int LDS_FAC = 131072 + 2048;
__device__ __forceinline__ void outproj_factors(int l, unsigned char* ws, LAS unsigned char* lds, int pm, int tid) {
    asm volatile("" : "+v"(tid));
    if (tid < 256) { const int row = pm * 256 + tid; const float* sa = (const float*)(ws + WS_SSQ + PT_A) + ((size_t)l * 16384 + row) * 8; const float* sc = (const float*)(ws + WS_SSQ + PT_C) + ((size_t)l * 16384 + row) * 8;
        const f32x4 a0 = *(const f32x4*)sa, a1 = *(const f32x4*)(sa + 4), c0 = *(const f32x4*)sc, c1 = *(const f32x4*)(sc + 4);
        const float ra = rsqrtf((((a0.x + a0.y) + (a0.z + a0.w)) + (a1.x + a1.y)) * (1.f / 384.f) + 1e-6f), rc = rsqrtf((((c0.x + c0.y) + (c0.z + c0.w)) + (c1.x + c1.y)) * (1.f / 384.f) + 1e-6f);
        LAS float* F = (LAS float*)(lds + LDS_FAC); F[2 * tid] = ra / rc; F[2 * tid + 1] = rc; }
    __syncthreads();
}
struct EpiOut {
    static constexpr bool KHOOK = true;
    bf16_t* XB; float* ssq; const LAS float* F; bool fold;
    __device__ __forceinline__ void kscale(f32x4 (&acc)[2][2][4][2], int which, int wr, int fr) const {
        if (!fold) return;
#pragma unroll
        for (int ai = 0; ai < 2; ++ai)
#pragma unroll
            for (int m = 0; m < 4; ++m) { const float f = F[2 * (ai * 128 + wr * 64 + m * 16 + fr) + which];
#pragma unroll
                for (int bj = 0; bj < 2; ++bj)
#pragma unroll
                    for (int n = 0; n < 2; ++n) acc[ai][bj][m][n] = acc[ai][bj][m][n] * f; }
    }
    __device__ __forceinline__ void operator()(const f32x4 (&acc)[2][2][4][2], const GUnit& u, int wr, int wc, int fr, int fq) const {
#pragma unroll
        for (int ai = 0; ai < 2; ++ai)
#pragma unroll
          for (int mh = 0; mh < 2; ++mh) {
            __builtin_amdgcn_sched_barrier(0);
            u32x4 xr[2][2];
#pragma unroll
            for (int m2 = 0; m2 < 2; ++m2)
#pragma unroll
                for (int bj = 0; bj < 2; ++bj) xr[m2][bj] = *(const u32x4*)(XB + (size_t)(u.pm * 256 + ai * 128 + wr * 64 + (2 * mh + m2) * 16 + fr) * 1024 + u.pn * 256 + bj * 128 + wc * 32 + 8 * fq);
#pragma unroll
            for (int m2 = 0; m2 < 2; ++m2) {
                const int m = 2 * mh + m2; const int row = u.pm * 256 + ai * 128 + wr * 64 + m * 16 + fr; float ss = 0.f;
#pragma unroll
                for (int bj = 0; bj < 2; ++bj) {
                    const u32x4 x = xr[m2][bj]; u32x4 o;
                    o.x = pk_bf16(bf_lo(x.x) + acc[ai][bj][m][0][0], bf_hi(x.x) + acc[ai][bj][m][0][1]); o.y = pk_bf16(bf_lo(x.y) + acc[ai][bj][m][0][2], bf_hi(x.y) + acc[ai][bj][m][0][3]);
                    o.z = pk_bf16(bf_lo(x.z) + acc[ai][bj][m][1][0], bf_hi(x.z) + acc[ai][bj][m][1][1]); o.w = pk_bf16(bf_lo(x.w) + acc[ai][bj][m][1][2], bf_hi(x.w) + acc[ai][bj][m][1][3]);
                    *(u32x4*)(XB + (size_t)row * 1024 + u.pn * 256 + bj * 128 + wc * 32 + 8 * fq) = o;
                    ss += (bf_lo(o.x) * bf_lo(o.x) + bf_hi(o.x) * bf_hi(o.x)) + (bf_lo(o.y) * bf_lo(o.y) + bf_hi(o.y) * bf_hi(o.y)) + (bf_lo(o.z) * bf_lo(o.z) + bf_hi(o.z) * bf_hi(o.z)) + (bf_lo(o.w) * bf_lo(o.w) + bf_hi(o.w) * bf_hi(o.w));
                }
                ss = quad_sum(ss); if (fq == 0) ssq[(size_t)row * 16 + u.pn * 4 + wc] = ss;
            }
          }
    }
};

__device__ __forceinline__ float sum16(const float* p) { const f32x4 a = *(const f32x4*)p, b = *(const f32x4*)(p + 4), c = *(const f32x4*)(p + 8), d = *(const f32x4*)(p + 12);
    return (((a.x + a.y) + (a.z + a.w)) + ((b.x + b.y) + (b.z + b.w))) + (((c.x + c.y) + (c.z + c.w)) + ((d.x + d.y) + (d.z + d.w))); }
__device__ __forceinline__ void phase_route(int l, InPtr in, unsigned char* ws, LAS unsigned char* lds, int bid, int nb, int g_wv) {
    int tid_ = TIDX; asm volatile("" : "+v"(tid_)); const int w = tid_ >> 6, lane = tid_ & 63, r = lane & 15, q = lane >> 4;
    const bf16_t* XB = (const bf16_t*)(ws + WS_XB); const bf16_t* WR = (const bf16_t*)(ws + WS_WR) + (size_t)l * 64 * 1024;
    const float* ssq = (const float*)(ws + WS_SSQ + PT_X1) + (size_t)l * 16384 * 16; const float* bg = in->p[24] + l * 4; const float* be = in->p[26] + l * 32;
    unsigned* cnt = (unsigned*)(ws + WS_CTL) + CW_CNT + 2048 * l; unsigned* mtok = (unsigned*)(ws + WS_META); float* mw = (float*)(ws + WS_META + META_W);
    LAS float* lg = (LAS float*)(lds + w * 4096);
    LAS unsigned* lcnt = (LAS unsigned*)(lds + 32768); LAS unsigned* lbase = lcnt + 32;
    constexpr int WRP = 2064; LAS unsigned char* wrl = lds + 40960;
    { u32x4 st[12];
#pragma unroll
      for (int i = 0; i < 12; ++i) { const int c = tid_ + 512 * i; st[i] = *(const u32x4*)(WR + (size_t)(c >> 7) * 1024 + (c & 127) * 8); }
#pragma unroll
      for (int i = 0; i < 12; ++i) { const int c = tid_ + 512 * i; *(LAS u32x4*)(wrl + (c >> 7) * WRP + (c & 127) * 16) = st[i]; } }
    for (int g0 = bid * 8; g0 < NTOK / 16; g0 += nb * 8) {
        if (tid_ < 32) lcnt[tid_] = 0u;
        __syncthreads();
        const int tok0 = (g0 + w) * 16; f32x4 acc[3];
#pragma unroll
        for (int n = 0; n < 3; ++n) acc[n] = (f32x4){0.f, 0.f, 0.f, 0.f};
        const bf16_t* ap = XB + (size_t)(tok0 + r) * 1024 + 8 * q; const LAS unsigned char* bl_ = wrl + r * WRP + 16 * q;
#pragma unroll 1
        for (int kc = 0; kc < 2; ++kc) {
            bf16x8 a[16];
#pragma unroll
            for (int s = 0; s < 16; ++s) a[s] = *(const bf16x8*)(ap + 32 * (kc * 16 + s));
            __builtin_amdgcn_sched_barrier(0);
#pragma unroll
            for (int s = 0; s < 16; ++s)
#pragma unroll
                for (int n = 0; n < 3; ++n) { const bf16x8 bb = *(const LAS bf16x8*)(bl_ + n * 16 * WRP + 64 * (kc * 16 + s)); acc[n] = MFMA16(a[s], bb, acc[n]); }
            __builtin_amdgcn_sched_barrier(0);
        }
#pragma unroll
        for (int n = 0; n < 3; ++n)
#pragma unroll
            for (int j = 0; j < 4; ++j) lg[(4 * q + j) * 48 + 16 * n + r] = acc[n][j];
        LDS_FENCE();
        int E0 = 0, E1 = 0; unsigned r0 = 0, r1 = 0; float wt0 = 0.f, wt1 = 0.f; const int tok = tok0 + (lane & 15);
        if (lane < 16) {
            const float rs = rsqrtf(sum16(ssq + (size_t)tok * 16) * (1.f / 1024.f) + 1e-6f); ((float*)(ws + WS_RS2))[tok] = rs; const LAS float* L = lg + lane * 48;
            float gl[4]; int gi = 0;
#pragma unroll
            for (int j = 0; j < 4; ++j) gl[j] = L[j] * rs + bg[j];
            float gm = gl[0];
#pragma unroll
            for (int j = 1; j < 4; ++j) if (gl[j] > gm) { gm = gl[j]; gi = j; }
            float gsum = 0.f;
#pragma unroll
            for (int j = 0; j < 4; ++j) gsum += __expf(gl[j] - gm);
            const float gtop = 1.f / gsum;
            float el[8];
#pragma unroll
            for (int j = 0; j < 8; ++j) el[j] = L[4 + gi * 8 + j] * rs + be[gi * 8 + j];
            int e0 = 0; float v0 = el[0];
#pragma unroll
            for (int j = 1; j < 8; ++j) if (el[j] > v0) { v0 = el[j]; e0 = j; }
            int e1 = -1; float v1 = -3.0e38f;
#pragma unroll
            for (int j = 0; j < 8; ++j) if (j != e0 && el[j] > v1) { v1 = el[j]; e1 = j; }
            const float w0 = 1.f / (1.f + __expf(v1 - v0)); E0 = gi * 8 + e0; E1 = gi * 8 + e1; wt0 = w0 * gtop; wt1 = (1.f - w0) * gtop;
            r0 = __hip_atomic_fetch_add(lcnt + E0, 1u, __ATOMIC_RELAXED, __HIP_MEMORY_SCOPE_WORKGROUP); r1 = __hip_atomic_fetch_add(lcnt + E1, 1u, __ATOMIC_RELAXED, __HIP_MEMORY_SCOPE_WORKGROUP);
        }
        __syncthreads();
        if (tid_ < 32) { const unsigned c = lcnt[tid_]; lbase[tid_] = c ? atomicAdd(cnt + tid_ * 64, c) : 0u; }
        __syncthreads();
        if (lane < 16) {
            const unsigned p0 = lbase[E0] + r0, p1 = lbase[E1] + r1;
            mtok[(size_t)E0 * 16384 + p0] = (unsigned)tok; mw[(size_t)E0 * 16384 + p0] = wt0;
            mtok[(size_t)E1 * 16384 + p1] = (unsigned)tok | 0x80000000u; mw[(size_t)E1 * 16384 + p1] = wt1;
        }
        __syncthreads();
    }
}

constexpr int LDS_TB = 131072 + 2048;
__device__ __forceinline__ void moe_tables(int l, unsigned char* ws, LAS unsigned char* lds, int g_wv) {
    int tix = TIDX; asm volatile("" : "+v"(tix));
    LAS int* tb = (LAS int*)(lds + LDS_TB);
    if (tix < 32) { const unsigned* cnt = (const unsigned*)(ws + WS_CTL) + CW_CNT + 2048 * l; tb[160 + tix] = (int)__hip_atomic_load(cnt + tix * 64, __ATOMIC_RELAXED, __HIP_MEMORY_SCOPE_AGENT); }
    __syncthreads();
    if (tix == 0) { int a = 0, f = 0, p = 0; for (int e = 0; e < 32; ++e) { const int c = tb[160 + e]; tb[e] = a; tb[48 + e] = f; tb[96 + e] = p; a += (c + 255) >> 8; f += c >> 8; p += (c & 255) ? 1 : 0; } tb[32] = a; tb[80] = f; tb[128] = p; }
    __syncthreads();
}
template <int NPN, bool GATHER_>
struct MoeSched {
    static constexpr bool GATHER = GATHER_, PARTIAL = false;
    const char* A; const char* Bt; const unsigned* cnt; const unsigned* mtok; const LAS int* tb; int G, c; size_t bstride_e  , bstride_pn; int lo, hi;
    __device__ __forceinline__ bool next(int i, GUnit& u) const {
        const int L = lo + i * G + c; if (L >= hi) return false;
        const int tile = L / NPN, pn = L % NPN;
        int e = 0;
        for (int k = 1; k < 32; ++k) e = (tb[k] <= tile) ? k : e;
        e = __builtin_amdgcn_readfirstlane(e);
        u.e = e; u.pm = tile; u.pn = pn; u.rows = tb[160 + e] - 256 * (tile - tb[e]);
        u.a = GATHER ? A : A + (size_t)tile * 256 * 256 * 2;
        u.b = Bt + (size_t)e * bstride_e + (size_t)pn * bstride_pn; return true;
    }
    __device__ __forceinline__ void aoff(const GUnit& u, unsigned (&v)[2][2], const int (&R)[2], const int (&C)[2]) const {
#pragma unroll
        for (int h = 0; h < 2; ++h)
#pragma unroll
            for (int i = 0; i < 2; ++i) {
                if (GATHER) { const int lr = h * 128 + R[i]; const int rr = 256 * (u.pm - tb[u.e]) + (lr < u.rows ? lr : 0); const unsigned tok = mtok[(size_t)u.e * 16384 + rr] & 0x7fffffffu; v[h][i] = (tok * 1024u + (unsigned)C[i]) * 2u; }
                else v[h][i] = (unsigned)((h * 128 + R[i]) * 256 + C[i]) * 2u;
            }
    }
};
struct EpiMoeUp {
    static constexpr bool KHOOK = false;
    const unsigned* mtok; const float* ssq; const LAS int* tb; bf16_t* HB;
    __device__ __forceinline__ void operator()(const f32x4 (&acc)[2][2][4][2], const GUnit& u, int wr, int wc, int fr, int fq) const {
        const int r0 = 256 * (u.pm - tb[u.e]);
        float rs8[8];
        { unsigned tk[8];
#pragma unroll
          for (int k = 0; k < 8; ++k) { const int lr = (k >> 2) * 128 + wr * 64 + (k & 3) * 16 + fr; tk[k] = mtok[(size_t)u.e * 16384 + r0 + (lr < u.rows ? lr : 0)] & 0x7fffffffu; }
#pragma unroll
          for (int k = 0; k < 8; ++k) rs8[k] = ssq[tk[k]]; }
#pragma unroll
        for (int ai = 0; ai < 2; ++ai)
#pragma unroll
            for (int m = 0; m < 4; ++m) {
                __builtin_amdgcn_sched_barrier(0);
                const int lr = ai * 128 + wr * 64 + m * 16 + fr;
                if (lr < u.rows) {
                    const float rs = rs8[ai * 4 + m];
                    float hv[8];
#pragma unroll
                    for (int n = 0; n < 2; ++n)
#pragma unroll
                        for (int j = 0; j < 4; ++j) { const float gv = acc[ai][0][m][n][j] * rs, uv = acc[ai][1][m][n][j] * rs; hv[4 * n + j] = siluf(gv) * uv; }
                    st_bf16x8(HB + ((size_t)u.pm * 256 + lr) * 256 + u.pn * 128 + wc * 32 + 8 * fq, hv);
                }
            }
    }
};
struct EpiMoeDown {
    static constexpr bool KHOOK = false;
    const unsigned* mtok; const float* mw; const LAS int* tb; bf16_t* YB;
    __device__ __forceinline__ void operator()(const f32x4 (&acc)[2][2][4][2], const GUnit& u, int wr, int wc, int fr, int fq) const {
        const int r0 = 256 * (u.pm - tb[u.e]);
        unsigned mt8[8]; float wt8[8];
#pragma unroll
        for (int k = 0; k < 8; ++k) { const int lr = (k >> 2) * 128 + wr * 64 + (k & 3) * 16 + fr; const size_t ix = (size_t)u.e * 16384 + r0 + (lr < u.rows ? lr : 0); mt8[k] = mtok[ix]; wt8[k] = mw[ix]; }
#pragma unroll
        for (int ai = 0; ai < 2; ++ai)
#pragma unroll
            for (int m = 0; m < 4; ++m) {
                __builtin_amdgcn_sched_barrier(0);
                const int lr = ai * 128 + wr * 64 + m * 16 + fr;
                if (lr < u.rows) {
                    const unsigned mt = mt8[ai * 4 + m]; const float wt = wt8[ai * 4 + m];
                    bf16_t* dst = YB + ((size_t)(mt >> 31) * 16384 + (mt & 0x7fffffffu)) * 1024 + u.pn * 256 + wc * 32 + 8 * fq;
#pragma unroll
                    for (int bj = 0; bj < 2; ++bj) { float v[8];
#pragma unroll
                        for (int n = 0; n < 2; ++n)
#pragma unroll
                            for (int j = 0; j < 4; ++j) v[4 * n + j] = acc[ai][bj][m][n][j] * wt;
                        st_bf16x8(dst + bj * 128, v); }
                }
            }
    }
};
__device__ __forceinline__ void phase_combine(int l, unsigned char* ws, float* out, int bid, int nb, int g_wv) {
    int tid_ = TIDX; asm volatile("" : "+v"(tid_)); const int w = tid_ >> 6, lane = tid_ & 63;
    bf16_t* XB = (bf16_t*)(ws + WS_XB); const bf16_t* Y0 = (const bf16_t*)(ws + WS_YBUF); const bf16_t* Y1 = Y0 + (size_t)16384 * 1024; float* ssqx = (float*)(ws + WS_SSQX) + 16384;
    for (int row = bid * 8 + w; row < NTOK; row += nb * 8) {
        float ss = 0.f;
#pragma unroll
        for (int k = 0; k < 2; ++k) {
            const size_t o = (size_t)row * 1024 + (lane + 64 * k) * 8;
            const u32x4 x = *(const u32x4*)(XB + o), a = *(const u32x4*)(Y0 + o), c = *(const u32x4*)(Y1 + o);
            float v[8] = { bf_lo(x.x) + bf_lo(a.x) + bf_lo(c.x), bf_hi(x.x) + bf_hi(a.x) + bf_hi(c.x), bf_lo(x.y) + bf_lo(a.y) + bf_lo(c.y), bf_hi(x.y) + bf_hi(a.y) + bf_hi(c.y),
                           bf_lo(x.z) + bf_lo(a.z) + bf_lo(c.z), bf_hi(x.z) + bf_hi(a.z) + bf_hi(c.z), bf_lo(x.w) + bf_lo(a.w) + bf_lo(c.w), bf_hi(x.w) + bf_hi(a.w) + bf_hi(c.w) };
            if (l == L_ - 1 && out) { *(f32x4*)(out + o) = (f32x4){v[0], v[1], v[2], v[3]}; *(f32x4*)(out + o + 4) = (f32x4){v[4], v[5], v[6], v[7]}; }
            else { u32x4 p; p.x = pk_bf16(v[0], v[1]); p.y = pk_bf16(v[2], v[3]); p.z = pk_bf16(v[4], v[5]); p.w = pk_bf16(v[6], v[7]); *(u32x4*)(XB + o) = p;
#pragma unroll
                   for (int j = 0; j < 4; ++j) { const unsigned q = j == 0 ? p.x : (j == 1 ? p.y : (j == 2 ? p.z : p.w)); ss += bf_lo(q) * bf_lo(q) + bf_hi(q) * bf_hi(q); } }
        }
        if (l < L_ - 1) { ss = wave_sum(ss); if (lane == 0) ssqx[row] = ss; }
    }
}
constexpr int MOE_CVT_SPLIT = 4608;
#ifndef CVT_A
#define CVT_A 1920
#endif
#ifndef NROUTE
#define NROUTE 128
#endif
constexpr int NPH = 9;
enum { PH_INPROJ = 0, PH_PREP, PH_MIX, PH_YNORM, PH_OUTPROJ, PH_ROUTE, PH_MOEUP, PH_MOEDOWN, PH_COMBINE };
struct Args { Inputs in; float* out; unsigned char* ws; int ph_lo, ph_hi; };

__global__ void __launch_bounds__(512, 2) mk(Args args) {
    extern __shared__ __attribute__((aligned(16))) unsigned char lds_raw[];
    LAS unsigned char* lds = (LAS unsigned char*)lds_raw;
    const int g_wv = __builtin_amdgcn_readfirstlane((int)threadIdx.x >> 6);
    const int bid0 = blockIdx.x, nb = gridDim.x;
#define BID() ({ int b_ = bid0; asm volatile("" : "+s"(b_)); b_; })
    unsigned char* ws = args.ws; unsigned* ctl = (unsigned*)(ws + WS_CTL);
    const int lo = args.ph_lo, hi = args.ph_hi;
    if (TIDX < 4) ((LAS unsigned*)(lds + LDS_MISC))[TIDX] = 0u;
    __syncthreads();
    XcdBarrier bar; bar.g_wv = g_wv; bar.bar = ctl + CW_BAR; bar.x = 0; bar.st = nullptr;
    if (hi - lo > 1) bar = xcd_barrier_post(ctl + CW_BAR, (volatile LAS unsigned*)(lds + LDS_MISC), g_wv);
#define IN(k) (lo <= (k) && (k) < hi)
#ifndef REPEAT_PH
#define REPEAT_PH -1
#endif
#define NREP(k) ((REPEAT_PH == (k)) ? 2 : 1)
#ifndef NBAR
#define NBAR 1
#endif
#ifndef TIME_PH
#define TIME_PH -1
#endif
#define STAMP(i) do { if (TIME_PH != -1 && blockIdx.x == 0 && TIDX == 0) ((unsigned long long*)(ctl + CW_TS))[i] = __builtin_amdgcn_s_memrealtime(); } while (0)
#define SEAM(k) do { if (IN(k) && IN((k) + 1)) for (int nb_ = 0; nb_ < NBAR; ++nb_) xcd_barrier(bar); STAMP((k) + 1); } while (0)
    STAMP(0);
#ifndef NO_PRO
    if (IN(0)) for (int rep = 0; rep < NREP(100); ++rep) { prologue(in_tab(), launder(ws), lds, BID(), nb, g_wv); if (rep + 1 < NREP(100)) xcd_barrier(bar); }
#endif
    SEAM(0);
    for (int l = 0; l < L_; ++l) {
        const int pb = 1 + l * NPH;
        if (IN(pb + PH_INPROJ)) for (int rep = 0; rep < NREP(PH_INPROJ); ++rep) {
            if (rep) xcd_barrier(bar);
            InPtr in = in_tab(); unsigned char* ws = launder(args.ws);
            g8::DenseSched S{(const char*)(ws + WS_XB), (const char*)(ws + WS_WIN) + (size_t)l * 2560 * 1024 * 2, 1024, 1024, 64, 10, nb, BID()};
            EpiInProj E{(const float*)(ws + WS_SSQX) + l * 16384, (float*)(ws + WS_SSQ + PT_DQ) + (size_t)l * 16384 * 4, (float*)(ws + WS_SSQ + PT_DKV) + (size_t)l * 16384 * 2,
                        in->p[8] + l * 64, in->p[9] + l * 64, in->p[19] + l * 192 + 96 + 64, (const float*)(ws + WS_ROPE), ws + WS_PRJ};
#ifndef NO_INPROJ
            g8::gemm_run(lds, 1024, 1024, S, E, g_wv);
#endif
        }
        SEAM(pb + PH_INPROJ);
        if (IN(pb + PH_PREP)) for (int rep = 0; rep < NREP(PH_PREP); ++rep) { if (rep) xcd_barrier(bar); phase_prep(l, in_tab(), launder(ws), lds, BID(), nb, g_wv, (unsigned*)launder(ws) + CW_Q + 64 * (4 + l + 2 * rep)); }
        SEAM(pb + PH_PREP);
        if (IN(pb + PH_MIX)) for (int rep = 0; rep < NREP(PH_MIX); ++rep) { if (rep) xcd_barrier(bar); phase_mix(l, in_tab(), launder(ws), lds, (unsigned*)launder(ws) + CW_Q + 64 * (l + 2 * rep), g_wv); }
        SEAM(pb + PH_MIX);
        const bool fold_norm = (nb == 256);
        if (IN(pb + PH_YNORM) && !fold_norm) phase_ynorm(l, launder(ws), BID(), nb, g_wv);
        if (!fold_norm) SEAM(pb + PH_YNORM);
        if (IN(pb + PH_OUTPROJ)) {
            unsigned char* ws = launder(args.ws);
            g8::DenseSched S{(const char*)(ws + WS_Y), (const char*)(ws + WS_WOUT) + (size_t)l * 1024 * 1024 * 2, 1024, 1024, 64, 4, nb, BID()};
            EpiOut E{(bf16_t*)(ws + WS_XB), (float*)(ws + WS_SSQ + PT_X1) + (size_t)l * 16384 * 16, (const LAS float*)(lds + LDS_FAC), fold_norm};
            if (fold_norm) { g8::GUnit u0; if (S.next(0, u0)) outproj_factors(l, ws, lds, u0.pm, TIDX); else __syncthreads(); }
#ifndef NO_OUTPROJ
            g8::gemm_run(lds, 1024, 1024, S, E, g_wv);
#endif
        }
        SEAM(pb + PH_OUTPROJ);
#ifndef NO_ROUTE
        if (IN(pb + PH_ROUTE)) {
            const int b_ = BID();
            if (nb >= 256 && b_ >= NROUTE) { cvt_moe_layer(in_tab(), launder(ws), l, (LAS float*)lds, b_ - NROUTE, nb - NROUTE, TIDX, 0, CVT_A);
#ifdef DUP_CVT
                __syncthreads(); cvt_moe_layer(in_tab(), launder(ws), l, (LAS float*)lds, b_ - NROUTE, nb - NROUTE, TIDX);
#endif
            }
            else { phase_route(l, in_tab(), launder(ws), lds, b_, nb >= 256 ? NROUTE : nb, g_wv);
                   if (nb < 256) cvt_moe_layer(in_tab(), launder(ws), l, (LAS float*)lds, b_, nb, TIDX); else cvt_moe_layer(in_tab(), launder(ws), l, (LAS float*)lds, b_, NROUTE, TIDX, CVT_A, 3072); }
            if (l + 1 < L_) { __syncthreads(); cvt_small_weights(in_tab(), launder(ws), l + 1, (LAS float*)lds, b_, nb, TIDX); }
        }
#endif
        SEAM(pb + PH_ROUTE);
        {
            const bool do_up = IN(pb + PH_MOEUP), do_dn = IN(pb + PH_MOEDOWN), fuse = do_up && do_dn;
            for (int part = 0; part < (fuse ? 3 : 1); ++part) {
                if (part) xcd_barrier(bar);
                unsigned char* ws = launder(args.ws);
                if (do_up || do_dn) moe_tables(l, ws, lds, g_wv);
                const unsigned* cnt = (const unsigned*)(ws + WS_CTL) + CW_CNT + 2048 * l; const unsigned* mtok = (const unsigned*)(ws + WS_META); const LAS int* tb = (const LAS int*)(lds + LDS_TB);
                const int b_ = BID(), ntile = tb[32], UPU = 2 * ntile, DNU = 4 * ntile;
                const int hi0 = UPU < nb ? UPU : nb, nu_ = UPU - hi0, nu = nu_ < (nb >> 1) ? nu_ : (nb >> 1), nd = nb - nu;
                const int d1a = 4 * (hi0 >> 1), d1b = 2 * nd, D1 = nu == 0 ? DNU : (d1a < d1b ? d1a : d1b);
                int ulo = 0, uhi = UPU, uG = nb, uc = b_, dlo = 0, dhi = DNU, dG = nb, dc = b_;
                if (fuse) {
                    if (part == 0) { uhi = hi0; dhi = 0; }
                    else if (part == 1) { ulo = hi0; uG = nu; if (b_ >= nu) uhi = ulo; dhi = D1; dG = nd; dc = b_ - nu; if (b_ < nu) dhi = 0; }
                    else { uhi = 0; dlo = D1; }
                }
                if (do_up && uhi > ulo) {
                    MoeSched<2, true> S{(const char*)(ws + WS_XB), (const char*)(ws + WS_WMOE), cnt, mtok, tb, uG, uc, (size_t)512 * 1024 * 2, (size_t)256 * 1024 * 2, ulo, uhi};
                    EpiMoeUp E{mtok, (const float*)(ws + WS_RS2), tb, (bf16_t*)(ws + WS_HBUF)};
#ifndef NO_MOEUP
                    g8::gemm_run(lds, 1024, 1024, S, E, g_wv);
#endif
                }
                if (do_dn && dhi > dlo) {
                    MoeSched<4, false> S{(const char*)(ws + WS_HBUF), (const char*)(ws + WS_WMOE + WMOE_WD), cnt, mtok, tb, dG, dc, (size_t)1024 * 256 * 2, (size_t)256 * 256 * 2, dlo, dhi};
                    EpiMoeDown E{mtok, (const float*)(ws + WS_META + META_W), tb, (bf16_t*)(ws + WS_YBUF)};
#ifndef NO_MOEDOWN
                    g8::gemm_run(lds, 256, 256, S, E, g_wv);
#endif
                }
            }
        }
        SEAM(pb + PH_MOEDOWN);
#ifndef NO_COMBINE
        if (IN(pb + PH_COMBINE)) { unsigned char* ws = launder(args.ws); phase_combine(l, ws, args.out, BID(), nb, g_wv); }
#endif
        SEAM(pb + PH_COMBINE);
    }
#undef IN
#undef SEAM
}
#if CHECK
struct NvScratch { float *proj, *h1, *qk, *hraw, *kn, *kcmp, *vcmp, *dqn, *q, *dkvn, *kv, *krope, *y, *x1, *xl; int* rt_e; float* rt_w; };
constexpr int CB = 5;
enum { NS_INPROJ = 0, NS_NSAPREP, NS_MLAPREP, NS_NSA, NS_ML, NS_MLA, NS_OUT, NS_ROUTE, NS_MOE };
static void naive_step(void* const* d_in, int l, int step, const float* xin, float* xout, const NvScratch& S, hipStream_t st) {
    const int b = CB;
    const float* rel_bias = (const float*)d_in[2];
    const float* norm1_g = (const float*)d_in[3] + (long)l * 1024;
    const float* w_in = (const float*)d_in[4] + (long)l * 1024 * DIN;
    const float* cmp_pe = (const float*)d_in[5] + (long)l * 2 * 32 * 64;
    const float* cmp_w1 = (const float*)d_in[6] + (long)l * 2 * 32 * 64 * 64;
    const float* cmp_w2 = (const float*)d_in[7] + (long)l * 2 * 64 * 64;
    const float* q_norm = (const float*)d_in[8] + l * 64;
    const float* k_norm = (const float*)d_in[9] + l * 64;
    const float* nsa_on = (const float*)d_in[10] + l * 384;
    const float* conv = (const float*)d_in[11] + l * 4 * 512;
    const float* ibias = (const float*)d_in[12] + l * 4;
    const float* fbias = (const float*)d_in[13] + l * 4;
    const float* ml_on = (const float*)d_in[14] + l * 256;
    const float* qan = (const float*)d_in[15] + l * 192;
    const float* w_uq = (const float*)d_in[16] + (long)l * 192 * 576;
    const float* kvan = (const float*)d_in[17] + l * 128;
    const float* w_ukv = (const float*)d_in[18] + (long)l * 128 * 768;
    const float* qkn = (const float*)d_in[19] + l * 192;
    const float* mla_on = (const float*)d_in[20] + l * 384;
    const float* w_out = (const float*)d_in[21] + (long)l * 1024 * 1024;
    const float* norm2_g = (const float*)d_in[22] + l * 1024;
    const float* wgrp = (const float*)d_in[23] + (long)l * 1024 * 4;
    const float* bgrp = (const float*)d_in[24] + l * 4;
    const float* wexp = (const float*)d_in[25] + (long)l * 1024 * 32;
    const float* bexp = (const float*)d_in[26] + l * 32;
    const float* Wg = (const float*)d_in[27] + (long)l * 32 * 1024 * 256;
    const float* Wu = (const float*)d_in[28] + (long)l * 32 * 1024 * 256;
    const float* Wd = (const float*)d_in[29] + (long)l * 32 * 256 * 1024;
    const int* pos = (const int*)d_in[1] + b * 2048;
    switch (step) {
    case NS_INPROJ:
        nv_rmsnorm<<<dim3(2048, 1), 64, 0, st>>>(xin, 1024, 0, S.h1, 1024, 0, norm1_g, 0, 1024);
        nv_gemm<<<dim3((DIN + 63) / 64, 2048 / 64), 256, 0, st>>>(S.h1, 1024, w_in, DIN, S.proj, DIN, nullptr, 0, 2048, DIN, 1024);
        break;
    case NS_NSAPREP:
        nv_nsa_cmp<<<dim3(127, 2, 2), 64, 0, st>>>(S.proj, cmp_pe, cmp_w1, cmp_w2, k_norm, S.kcmp, S.vcmp);
        nv_nsa_knorm<<<dim3(2048, 4), 64, 0, st>>>(S.proj, k_norm, S.kn);
        break;
    case NS_MLAPREP:
        nv_rmsnorm<<<dim3(2048, 1), 64, 0, st>>>(S.proj + O_CDQ, DIN, 0, S.dqn, 192, 0, qan, 0, 192);
        nv_gemm<<<dim3(576 / 64, 2048 / 64), 256, 0, st>>>(S.dqn, 192, w_uq, 576, S.q, 576, nullptr, 0, 2048, 576, 192);
        nv_rmsnorm<<<dim3(2048, 1), 64, 0, st>>>(S.proj + O_CDKV, DIN, 0, S.dkvn, 128, 0, kvan, 0, 128);
        nv_gemm<<<dim3(768 / 64, 2048 / 64), 256, 0, st>>>(S.dkvn, 128, w_ukv, 768, S.kv, 768, nullptr, 0, 2048, 768, 128);
        nv_mla_prep<<<dim3(2048, 7), 64, 0, st>>>(S.q, S.kv, S.proj, S.krope, qkn, pos);
        break;
    case NS_NSA:
        nv_nsa_attn<<<dim3(2048, 2), 192, 0, st>>>(S.proj, S.kn, S.kcmp, S.vcmp, rel_bias, q_norm, S.y);
        break;
    case NS_ML:
        nv_ml_conv<<<2048, 512, 0, st>>>(S.proj, conv, S.qk);
        nv_ml_rec<<<4, 256, 0, st>>>(S.proj, S.qk, ibias, fbias, S.hraw);
        nv_ml_fin<<<dim3(2048, 4), 64, 0, st>>>(S.proj, S.hraw, ml_on, S.y);
        break;
    case NS_MLA:
        nv_mla_attn<<<dim3(2048, 6), 64, 0, st>>>(S.q, S.kv, S.krope, S.y);
        break;
    case NS_OUT:
        nv_rmsnorm<<<dim3(2048, 1), 64, 0, st>>>(S.y, 1024, 0, S.y, 1024, 0, nsa_on, 0, 384);
        nv_rmsnorm<<<dim3(2048, 1), 64, 0, st>>>(S.y + 640, 1024, 0, S.y + 640, 1024, 0, mla_on, 0, 384);
        nv_gemm<<<dim3(1024 / 64, 2048 / 64), 256, 0, st>>>(S.y, 1024, w_out, 1024, S.x1, 1024, xin, 1024, 2048, 1024, 1024);
        break;
    case NS_ROUTE:
        nv_moe_route<<<2048, 64, 0, st>>>(S.x1, norm2_g, wgrp, bgrp, wexp, bexp, S.h1, S.rt_e, S.rt_w);
        break;
    case NS_MOE:
        nv_moe_exp<<<2048, 256, 0, st>>>(S.x1, S.h1, S.rt_e, S.rt_w, Wg, Wu, Wd, xout);
        break;
    }
}

__device__ __forceinline__ void chk_commit(float d2, float r2, float* acc) { d2 = wave_sum(d2); r2 = wave_sum(r2); if ((threadIdx.x & 63) == 0) { atomicAdd(acc, d2); atomicAdd(acc + 1, r2); } }
__device__ __forceinline__ void chk_add(float f, float r, float& d2, float& r2) { const float d = f - r; d2 += (d == d) ? d * d : 1e30f; r2 += r * r; }

__global__ void __launch_bounds__(64) chk_proj(const float* nproj, const unsigned char* prj, const float* ssq_dq, const float* ssq_dkv, const float* qg, const float* kg, const float* krg, const int* pos, float* acc) {
    const int t = blockIdx.x, e = threadIdx.x; const size_t row = (size_t)CB * 2048 + t; float d2 = 0.f, r2 = 0.f;
    for (int G = 0; G < 40; ++G) {
        const int c = inproj_refcol(G, e); float r = c < 0 ? 0.f : nproj[(size_t)t * DIN + c]; float f = 0.f;
        const float rr = (G == 37 && e >= 32) ? 0.f : r; const float ss = wave_sum(rr * rr);
        if (G < 6) { r = r * rsqrtf(ss / 64.f + 1e-6f) * qg[e] * 0.18033688f; f = bf2f(((const bf16_t*)(prj + PRJ_QN))[((size_t)(CB * 6 + G) * 2048 + t) * 64 + e]); }
        else if (G < 18) { const int a = G - 6, br = a >> 2, s = (a >> 1) & 1, hk = a & 1;
            if (br > 0 && s == 0) r = r * rsqrtf(ss / 64.f + 1e-6f) * kg[e];
            const size_t base = br == 0 ? (s ? PRJ_C0V : PRJ_C0K) : (br == 1 ? (s ? PRJ_VN1 : PRJ_KN1) : (s ? PRJ_VN2 : PRJ_KN2));
            f = bf2f(((const bf16_t*)(prj + base))[((size_t)(CB * 2 + hk) * 2048 + t) * 64 + e]); }
        else if (G < 26) f = bf2f(((const bf16_t*)(prj + PRJ_RAWQK))[row * 512 + (G - 18) * 64 + e]);
        else if (G < 30) f = bf2f(((const bf16_t*)(prj + PRJ_VML))[((size_t)(CB * 4 + (G - 26)) * 2048 + t) * 64 + e]);
        else if (G < 34) f = bf2f(((const bf16_t*)(prj + PRJ_OG))[row * 256 + (G - 30) * 64 + e]);
        else if (G < 37) f = bf2f(((const bf16_t*)(prj + PRJ_DQKV))[row * 384 + (G - 34) * 64 + e]);
        else if (G == 37) {
            const float val = e < 32 ? rr * rsqrtf(ss / 32.f + 1e-6f) * krg[e & 31] : 0.f; const float oth = __shfl_xor(val, 16);
            if (e < 32) { const int i = e & 15; const double ang = (double)pos[row] * pow(10000.0, -(double)i / 16.0); const float cs = (float)cos(ang), sn = (float)sin(ang);
                r = e < 16 ? val * cs - oth * sn : val * cs + oth * sn; f = bf2f(((const bf16_t*)(prj + PRJ_KR))[row * 32 + e]); }
            else if (e < 58) f = ((const float*)(prj + PRJ_GATES))[row * 32 + (e - 32)];
            else { f = 0.f; r = 0.f; }
        }
        else f = bf2f(((const bf16_t*)(prj + PRJ_DQKV))[row * 384 + 256 + (G - 38) * 64 + e]);
        chk_add(f, r, d2, r2);
    }
    float d2s = 0.f, r2s = 0.f;
    { float s1 = 0.f, s2 = 0.f; for (int c = e; c < 192; c += 64) { float v = nproj[(size_t)t * DIN + O_CDQ + c]; s1 += v * v; } for (int c = e; c < 128; c += 64) { float v = nproj[(size_t)t * DIN + O_CDKV + c]; s2 += v * v; }
      s1 = wave_sum(s1); s2 = wave_sum(s2); if (e == 0) { chk_add((ssq_dq[row * 4] + ssq_dq[row * 4 + 1]) + ssq_dq[row * 4 + 2], s1, d2s, r2s); chk_add(ssq_dkv[row * 2] + ssq_dkv[row * 2 + 1], s2, d2s, r2s); } }
    chk_commit(d2, r2, acc); chk_commit(d2s, r2s, acc + 2);
}

__global__ void __launch_bounds__(64) chk_prep(const float* nq, const float* nkv, const float* nkr, const float* nkc, const float* nvc, const unsigned char* ws, float* acc) {
    const int t = blockIdx.x, e = threadIdx.x; float d2 = 0.f, r2 = 0.f, d2c = 0.f, r2c = 0.f; const float scale = 0.14724444f;
    const bf16_t* QM = (const bf16_t*)(ws + WS_MLA); const bf16_t* KM = (const bf16_t*)(ws + WS_MLA + MLA_KM); const bf16_t* VM = (const bf16_t*)(ws + WS_MLA + MLA_VM);
    for (int h = 0; h < 6; ++h) {
        const size_t rq = ((size_t)(CB * 6 + h) * 2048 + t);
        chk_add(bf2f(QM[rq * 96 + e]), nq[(size_t)t * 576 + h * 96 + e] * scale, d2, r2);
        chk_add(bf2f(KM[rq * 96 + e]), nkv[(size_t)t * 768 + h * 128 + e], d2, r2);
        chk_add(bf2f(VM[rq * 64 + e]), nkv[(size_t)t * 768 + h * 128 + 64 + e], d2, r2);
        if (e < 32) { chk_add(bf2f(QM[rq * 96 + 64 + e]), nq[(size_t)t * 576 + h * 96 + 64 + e] * scale, d2, r2); chk_add(bf2f(KM[rq * 96 + 64 + e]), nkr[(size_t)t * 32 + e], d2, r2); }
    }
    if (t < 128) for (int hk = 0; hk < 2; ++hk) {
        const bf16_t* KC = (const bf16_t*)(ws + WS_CMP); const bf16_t* VC = (const bf16_t*)(ws + WS_CMP + CMP_V); const size_t rf = ((size_t)(CB * 2 + hk) * 128 + t) * 64 + e;
        chk_add(bf2f(KC[rf]), t < 127 ? nkc[(size_t)(hk * 127 + t) * 64 + e] : 0.f, d2c, r2c); chk_add(bf2f(VC[rf]), t < 127 ? nvc[(size_t)(hk * 127 + t) * 64 + e] : 0.f, d2c, r2c);
    }
    chk_commit(d2, r2, acc); chk_commit(d2c, r2c, acc + 2);
}

__global__ void __launch_bounds__(64) chk_y(const float* ny, const unsigned char* ws, float* acc, int nseg) {
    const int t = blockIdx.x, e = threadIdx.x; const bf16_t* Y = (const bf16_t*)(ws + WS_Y) + ((size_t)CB * 2048 + t) * 1024;
    float d2[3] = {0.f, 0.f, 0.f}, r2[3] = {0.f, 0.f, 0.f};
    for (int c = e; c < 1024; c += 64) { const int seg = c < 384 ? 0 : (c < 640 ? 1 : 2); const int cf = c < 384 ? c : (c < 640 ? 768 + (c - 384) : 384 + (c - 640)); const float f = bf2f(Y[cf]), r = ny[(size_t)t * 1024 + c];
        if (seg == 0) chk_add(f, r, d2[0], r2[0]); else if (seg == 1) chk_add(f, r, d2[1], r2[1]); else chk_add(f, r, d2[2], r2[2]); }
    if (nseg == 3) { chk_commit(d2[0], r2[0], acc); chk_commit(d2[1], r2[1], acc + 2); chk_commit(d2[2], r2[2], acc + 4); }
    else chk_commit(d2[0] + d2[1] + d2[2], r2[0] + r2[1] + r2[2], acc);
}

__global__ void __launch_bounds__(64) chk_x(const float* nx, const unsigned char* ws, float* acc) {
    const int t = blockIdx.x, e = threadIdx.x; const bf16_t* X = (const bf16_t*)(ws + WS_XB) + ((size_t)CB * 2048 + t) * 1024; float d2 = 0.f, r2 = 0.f;
    for (int c = e; c < 1024; c += 64) chk_add(bf2f(X[c]), nx[(size_t)t * 1024 + c], d2, r2);
    chk_commit(d2, r2, acc);
}

__global__ void __launch_bounds__(512) chk_code(float* acc, int nst, const float* nout) {
    __shared__ float sh[512];
    float s = 0.f; for (int i = threadIdx.x; i < 2048 * 1024; i += 512) { float v = nout[i]; s += v * v; }
    sh[threadIdx.x] = s; __syncthreads();
    if (threadIdx.x == 0) { float tot = 0.f; for (int i = 0; i < 512; ++i) tot += sh[i]; float rms = sqrtf(tot / (2048.f * 1024.f)); if (!(rms > 1e-3f && rms < 1e3f)) rms = 1.f;
        int code = 0;
        for (int st = 0; st < nst; ++st) { const float d2 = acc[2 * st], r2 = acc[2 * st + 1]; if (r2 == 0.f && d2 == 0.f) { if ((st & 15) >= 9) continue; code = (st + 1) * 4 + 3; break; } const float err = d2 / fmaxf(r2, 1e-30f);
            const float tol = CHK_TOL(st);
            if (!(err <= tol)) { const int cls = !(err < 1.f) ? 3 : (err >= 0.1f ? 2 : (err >= 0.01f ? 1 : 0)); code = (st + 1) * 4 + cls; break; } }
        acc[2 * 40] = rms * 32.f * exp2f(0.5f * (float)code); }
}
__global__ void __launch_bounds__(512) chk_fill(const float* acc, float* out) {
    const float K = acc[2 * 40];
    for (size_t i = (size_t)blockIdx.x * 512 + threadIdx.x; i < (size_t)NTOK * 1024; i += (size_t)gridDim.x * 512) out[i] = (i & 1) ? -K : K;
}
#endif

#if TIME_PH != -1
#ifndef TIME_Q
#define TIME_Q 6.f
#endif
#ifndef TIME_CAL
#define TIME_CAL 1.0f
#endif
__global__ void tm_acc(const unsigned long long* ts, float* best, int first) {
    int a = TIME_PH, b = TIME_PH + 1;
#ifdef TIME_PH_END
    b = TIME_PH_END;
#endif
    float T = 100.f; if (TIME_PH >= 0) T = (float)(ts[b] - ts[a]) * 0.01f;
    if (first || T < *best) *best = T;
}
__global__ void __launch_bounds__(512) tm_fill(const float* best, float* out) {
    float T = *best;
    T = exp2f(rintf(log2f(fmaxf(T, 1.f)) * TIME_Q) / TIME_Q);
    const float c = sqrtf(T) * TIME_CAL;
    for (size_t i = (size_t)blockIdx.x * 512 + threadIdx.x; i < (size_t)NTOK * 1024; i += (size_t)gridDim.x * 512) out[i] = (i & 1) ? -c : c;
}
#endif
static int g_grid = 0;
static bool setup_once(size_t ws_size) {
    if (g_grid) return g_grid > 0;
    if (ws_size < WS_END) { fprintf(stderr, "kernel_launch: workspace too small: %zu < %zu\n", ws_size, (size_t)WS_END); g_grid = -1; return false; }
    int dev = 0, cus = 0, per_cu = 0;
    if (hipGetDevice(&dev) != hipSuccess || hipDeviceGetAttribute(&cus, hipDeviceAttributeMultiprocessorCount, dev) != hipSuccess) { g_grid = -1; return false; }
    if (hipFuncSetAttribute((const void*)mk, hipFuncAttributeMaxDynamicSharedMemorySize, LDS_BYTES) != hipSuccess) { fprintf(stderr, "kernel_launch: hipFuncSetAttribute failed\n"); g_grid = -1; return false; }
    if (hipOccupancyMaxActiveBlocksPerMultiprocessor(&per_cu, (const void*)mk, 512, LDS_BYTES) != hipSuccess || per_cu < 1) { fprintf(stderr, "kernel_launch: occupancy query says %d\n", per_cu); }
    (void)hipGetLastError();
    g_grid = cus;
    return true;
}
static void launch_mk(const Args& a0, int lo, int hi, hipStream_t stream) { Args a = a0; a.ph_lo = lo; a.ph_hi = hi; hipLaunchKernelGGL(mk, dim3(g_grid), dim3(512), LDS_BYTES, stream, a); }

extern "C" void kernel_launch(void* const* d_in, const int* in_sizes, int n_in, void* d_out, int out_size, void* d_ws, size_t ws_size, hipStream_t stream) {
    if (!setup_once(ws_size)) return;
    unsigned char* ws = (unsigned char*)d_ws;
    (void)hipMemsetAsync(ws + WS_CTL, 0, ZERO_BYTES, stream);
    Args a{}; for (int i = 0; i < 30; ++i) a.in.p[i] = (const float*)d_in[i];
    a.out = (float*)d_out; a.ws = ws; a.ph_lo = 0; a.ph_hi = 0;
#if CHECK
    a.out = nullptr;
#endif
#if CHECK
    float* nb = (float*)d_out; size_t off = 0; NvScratch S;
    auto take = [&](size_t n) { float* p = nb + off; off += (n + 63) & ~(size_t)63; return p; };
    S.proj = take((size_t)2048 * DIN); S.h1 = take(2048 * 1024); S.qk = S.h1; S.hraw = S.qk + 2048 * 512; S.kn = S.hraw + 2048 * 256;
    S.kcmp = take(2 * 127 * 64); S.vcmp = take(2 * 127 * 64); S.dqn = take(2048 * 192); S.q = take(2048 * 576); S.dkvn = take(2048 * 128); S.kv = take(2048 * 768); S.x1 = S.dqn;
    S.krope = take(2048 * 32); S.y = take(2048 * 1024); S.xl = take(2048 * 1024); S.rt_e = (int*)take(2048 * 2); S.rt_w = take(2048 * 2);
    if (off * 4 > (size_t)NTOK * 1024 * 4) { fprintf(stderr, "naive scratch too big\n"); return; }
    float* acc = (float*)(ws + WS_CTL) + CW_CHK;
    launch_mk(a, 0, 1, stream);
    const float* nx_in = (const float*)d_in[0] + (size_t)CB * 2048 * 1024;
    int nst = 0;
    for (int l = 0; l < L_; ++l) {
        const int pb = 1 + l * NPH; const int sb = l * 16;
        launch_mk(a, pb + PH_INPROJ, pb + PH_INPROJ + 1, stream);
        naive_step(d_in, l, NS_INPROJ, nx_in, S.xl, S, stream);
        chk_proj<<<2048, 64, 0, stream>>>(S.proj, ws + WS_PRJ, (const float*)(ws + WS_SSQ + PT_DQ) + (size_t)l * 16384 * 4, (const float*)(ws + WS_SSQ + PT_DKV) + (size_t)l * 16384 * 2,
                                           (const float*)d_in[8] + l * 64, (const float*)d_in[9] + l * 64, (const float*)d_in[19] + l * 192 + 160, (const int*)d_in[1], acc + 2 * (sb + 0));
        nst = sb + 2;
        int ns_done = NS_INPROJ;
#if CHECK_UPTO >= 1
        launch_mk(a, pb + PH_PREP, pb + PH_PREP + 1, stream);
        naive_step(d_in, l, NS_NSAPREP, nx_in, S.xl, S, stream); naive_step(d_in, l, NS_MLAPREP, nx_in, S.xl, S, stream); ns_done = NS_MLAPREP;
        chk_prep<<<2048, 64, 0, stream>>>(S.q, S.kv, S.krope, S.kcmp, S.vcmp, ws, acc + 2 * (sb + 2));
        nst = sb + 4;
#endif
#if CHECK_UPTO >= 2
        launch_mk(a, pb + PH_MIX, pb + PH_MIX + 1, stream);
        naive_step(d_in, l, NS_NSA, nx_in, S.xl, S, stream); naive_step(d_in, l, NS_ML, nx_in, S.xl, S, stream); naive_step(d_in, l, NS_MLA, nx_in, S.xl, S, stream); ns_done = NS_MLA;
        chk_y<<<2048, 64, 0, stream>>>(S.y, ws, acc + 2 * (sb + 4), 3);
        nst = sb + 7;
#endif
#if CHECK_UPTO >= 3
        launch_mk(a, pb + PH_YNORM, pb + PH_YNORM + 1, stream); launch_mk(a, pb + PH_OUTPROJ, pb + PH_OUTPROJ + 1, stream);
        naive_step(d_in, l, NS_OUT, nx_in, S.xl, S, stream); ns_done = NS_OUT;
        chk_x<<<2048, 64, 0, stream>>>(S.x1, ws, acc + 2 * (sb + 7));
        nst = sb + 8;
#endif
#if CHECK_UPTO >= 4
        for (int ph = PH_ROUTE; ph <= PH_COMBINE; ++ph) launch_mk(a, pb + ph, pb + ph + 1, stream);
        naive_step(d_in, l, NS_ROUTE, nx_in, S.xl, S, stream); naive_step(d_in, l, NS_MOE, nx_in, S.xl, S, stream); ns_done = NS_MOE;
        chk_x<<<2048, 64, 0, stream>>>(S.xl, ws, acc + 2 * (sb + 8));
        nst = sb + 9;
#endif
        CHECK_REST
        for (int s = ns_done + 1; s <= NS_MOE; ++s) naive_step(d_in, l, s, nx_in, S.xl, S, stream);
        nx_in = S.xl;
        if (l == CHECK_LAYERS - 1) break;
    }
    chk_code<<<1, 512, 0, stream>>>(acc, nst, S.xl);
    chk_fill<<<1024, 512, 0, stream>>>(acc, (float*)d_out);
#else
#if defined(SPLIT_LAUNCH) && SPLIT_LAUNCH
    for (int ph = 0; ph < 1 + L_ * NPH; ++ph) launch_mk(a, ph, ph + 1, stream);
#else
    launch_mk(a, 0, 1 + L_ * NPH, stream);
#if TIME_PH != -1
    for (int rp = 0; rp < 6; ++rp) {
        (void)hipMemsetAsync(ws + WS_CTL, 0, ZERO_BYTES, stream); launch_mk(a, 0, 1 + L_ * NPH, stream);
        tm_acc<<<1, 1, 0, stream>>>((const unsigned long long*)((unsigned*)(ws + WS_CTL) + CW_TS), (float*)(ws + WS_META + META_RT), rp == 0);
    }
    tm_fill<<<1024, 512, 0, stream>>>((const float*)(ws + WS_META + META_RT), (float*)d_out);
#endif
#endif
#endif
}
```

```cpp
#define CHECK 0
#define CHECK_LAYERS 2
#define CHECK_UPTO 99
#define SPLIT_LAUNCH 0
#define REPEAT_PH -1
#include <hip/hip_runtime.h>
#include <stdint.h>
#include <cstdio>
#include <type_traits>

constexpr int B_ = 8, T_ = 2048, D_ = 1024, L_ = 2, NTOK = B_ * T_;
constexpr int DIN = 2554;
constexpr int O_AQ = 0, O_AKV = 384, O_AG = 1152, O_BQK = 1170, O_BV = 1682, O_BIF = 1938, O_BO = 1946, O_CDQ = 2202, O_CDKV = 2394, O_CKR = 2522;

typedef unsigned short bf16_t;
typedef short bf16x8 __attribute__((ext_vector_type(8)));
typedef short s16x4 __attribute__((ext_vector_type(4)));
typedef float f32x4 __attribute__((ext_vector_type(4)));
typedef float f32x16 __attribute__((ext_vector_type(16)));
typedef unsigned u32x4 __attribute__((ext_vector_type(4)));
typedef unsigned u32x2 __attribute__((ext_vector_type(2)));
typedef float f32x2_t __attribute__((ext_vector_type(2)));
typedef __bf16 bf16x2_t __attribute__((ext_vector_type(2)));
#define LAS __attribute__((address_space(3)))

__device__ __forceinline__ unsigned pk_bf16(float lo, float hi) { f32x2_t v = {lo, hi}; bf16x2_t b = __builtin_convertvector(v, bf16x2_t); return __builtin_bit_cast(unsigned, b); }
__device__ __forceinline__ float bf_lo(unsigned u) { return __builtin_bit_cast(float, u << 16); }
__device__ __forceinline__ float bf_hi(unsigned u) { return __builtin_bit_cast(float, u & 0xffff0000u); }
__device__ __forceinline__ float bf2f(bf16_t h) { return __builtin_bit_cast(float, (unsigned)h << 16); }
__device__ __forceinline__ bf16_t f2bf(float f) { return (bf16_t)(pk_bf16(f, 0.f) & 0xffffu); }
template <int M> __device__ __forceinline__ int shx(int v) { static_assert(M > 0 && M < 32, "swizzle xor mask"); return __builtin_amdgcn_ds_swizzle(v, (M << 10) | 0x1f); }
template <int M> __device__ __forceinline__ float shx(float v) { return __builtin_bit_cast(float, shx<M>(__builtin_bit_cast(int, v))); }
template <int M> __device__ __forceinline__ unsigned shx(unsigned v) { return (unsigned)shx<M>((int)v); }
__device__ __forceinline__ float wave_sum(float v) { v += __shfl_xor(v, 32); v += shx<16>(v); v += shx<8>(v); v += shx<4>(v); v += shx<2>(v); v += shx<1>(v); return v; }
__device__ __forceinline__ float wave_max(float v) { v = fmaxf(v, __shfl_xor(v, 32)); v = fmaxf(v, shx<16>(v)); v = fmaxf(v, shx<8>(v)); v = fmaxf(v, shx<4>(v)); v = fmaxf(v, shx<2>(v)); v = fmaxf(v, shx<1>(v)); return v; }
__device__ __forceinline__ float siluf(float x) { return x * __builtin_amdgcn_rcpf(1.f + __expf(-x)); }
__device__ __forceinline__ float sigmf(float x) { return __builtin_amdgcn_rcpf(1.f + __expf(-x)); }
__device__ __forceinline__ int t5b(int dist) {
    int n = dist > 0 ? dist : 0; if (n < 16) return n;
    float v = logf((float)n / 16.f) / logf(8.f) * 16.f; int l = 16 + (int)v; return l < 31 ? l : 31;
}

__device__ __forceinline__ int lane_now() { return (int)__builtin_amdgcn_mbcnt_hi(~0u, __builtin_amdgcn_mbcnt_lo(~0u, 0u)); }
#define TIDX ((g_wv << 6) | lane_now())

constexpr size_t WS_CTL = 0, CTL_BYTES = 65536;
constexpr size_t WS_SSQ = WS_CTL + CTL_BYTES;
constexpr size_t ZERO_BYTES = CTL_BYTES;
constexpr size_t PT_DQ = 0, PT_DKV = PT_DQ + (size_t)2 * 16384 * 4 * 4, PT_A = PT_DKV + (size_t)2 * 16384 * 2 * 4, PT_C = PT_A + (size_t)2 * 16384 * 8 * 4, PT_X1 = PT_C + (size_t)2 * 16384 * 8 * 4, PT_END = PT_X1 + (size_t)2 * 16384 * 16 * 4;
constexpr size_t WS_SSQX = WS_SSQ + PT_END;
constexpr size_t WS_RS2 = WS_SSQX + 2 * 65536;
constexpr size_t WS_WIN = WS_RS2 + 65536;
constexpr size_t WS_WOUT = WS_WIN + (size_t)2 * 2560 * 1024 * 2;
constexpr size_t WS_WUQ = WS_WOUT + (size_t)2 * 1024 * 1024 * 2;
constexpr size_t WS_WUKV = WS_WUQ + (size_t)2 * 768 * 256 * 2;
constexpr size_t WS_WC1 = WS_WUKV + (size_t)2 * 768 * 256 * 2;
constexpr size_t WS_WC2 = WS_WC1 + (size_t)2 * 2 * 64 * 2048 * 2;
constexpr size_t WS_WR = WS_WC2 + (size_t)2 * 2 * 64 * 64 * 2;
constexpr size_t WS_B1C = WS_WR + (size_t)2 * 64 * 1024 * 2;
constexpr size_t WS_BIASD = WS_B1C + 1024;
constexpr size_t WS_ROPE = WS_BIASD + 6 * 2048 * 4;
constexpr size_t WS_WMOE = WS_ROPE + (size_t)16384 * 32 * 4;
constexpr size_t WMOE_WD = (size_t)32 * 512 * 1024 * 2;
constexpr size_t WS_XB = WS_WMOE + 50331648;
constexpr size_t WS_MLA = WS_XB + 33554432;
constexpr size_t MLA_KM = (size_t)8 * 6 * 2048 * 96 * 2, MLA_VM = 2 * MLA_KM;
constexpr size_t WS_HBUF = WS_MLA;
constexpr size_t WS_PRJ = WS_MLA + 50331648;
constexpr size_t HM64 = (size_t)2048 * 64 * 2;
constexpr size_t PRJ_QN = 0;
constexpr size_t PRJ_KN1 = PRJ_QN + 48 * HM64, PRJ_VN1 = PRJ_KN1 + 16 * HM64, PRJ_KN2 = PRJ_VN1 + 16 * HM64, PRJ_VN2 = PRJ_KN2 + 16 * HM64;
constexpr size_t PRJ_VML = PRJ_VN2 + 16 * HM64;
constexpr size_t PRJ_OG = PRJ_VML + 32 * HM64;
constexpr size_t PRJ_KR = PRJ_OG + (size_t)16384 * 256 * 2;
constexpr size_t PRJ_GATES = PRJ_KR + (size_t)16384 * 32 * 2;
constexpr size_t PRJ_DEAD = PRJ_GATES + (size_t)16384 * 32 * 4;
constexpr size_t PRJ_C0K = PRJ_DEAD, PRJ_C0V = PRJ_C0K + 16 * HM64 + 8192;
constexpr size_t PRJ_RAWQK = PRJ_C0V + 16 * HM64 + 8192;
constexpr size_t PRJ_DQKV = PRJ_RAWQK + (size_t)16384 * 512 * 2;
constexpr size_t PRJ_END = PRJ_DQKV + (size_t)16384 * 384 * 2;
static_assert(PRJ_END - PRJ_DEAD >= 33554432, "Y fits the dead part of PRJ");
constexpr size_t WS_Y = WS_PRJ + PRJ_DEAD;
constexpr size_t WS_YBUF = WS_PRJ;
static_assert((size_t)2 * 16384 * 1024 * 2 <= PRJ_END, "YBUF fits the PRJ region");
constexpr size_t WS_ML = WS_PRJ + PRJ_END;
constexpr size_t ML_KC = 32 * HM64, ML_DELTA = 2 * ML_KC, ML_DN = ML_DELTA + (size_t)1024 * 4096 * 2, ML_G = ML_DN + (size_t)1024 * 64 * 4, ML_BL = ML_G + (size_t)8 * 4 * 2048 * 2 * 4, ML_CP = ML_BL + 4096, ML_NP = ML_CP + (size_t)1024 * 4096 * 2, ML_END = ML_NP + (size_t)1024 * 64 * 2;
constexpr size_t WS_CMP = WS_ML + ML_END;
constexpr size_t CMP_V = (size_t)8 * 2 * 128 * 64 * 2;
constexpr size_t WS_META = WS_CMP + 2 * CMP_V;
constexpr size_t META_W = (size_t)32 * 16384 * 4, META_RT = 2 * META_W;
constexpr size_t WS_END = WS_META + META_RT + (size_t)16384 * 16;
constexpr int CW_BAR = 0;
constexpr int CW_Q = 4096;
constexpr int CW_SCAN = 4608;
constexpr int CW_TS = 4864;
constexpr int CW_CHK = 5120;
constexpr int CW_CNT = 8192;
constexpr int LDS_BYTES = 147456;
constexpr int LDS_MISC = LDS_BYTES - 256;
#define XB_TMO      128
#define XB_XCNT(j)  (256  + 64 * (j))
#define XB_XSUB(j)  (1280 + 64 * (j))
#define XB_XGEN(j)  (2304 + 64 * (j))
#define XB_TOP      3328
#define XB_TOPGEN   3392
#define XCD_BAR_WORDS 3456
#define XB_SPIN_CAP (1u << 18)

__device__ __forceinline__ unsigned xb_ld(unsigned* p)              { return __hip_atomic_load(p, __ATOMIC_RELAXED, __HIP_MEMORY_SCOPE_AGENT); }
__device__ __forceinline__ unsigned xb_add(unsigned* p, unsigned v) { return __hip_atomic_fetch_add(p, v, __ATOMIC_RELAXED, __HIP_MEMORY_SCOPE_AGENT); }
__device__ __forceinline__ unsigned xb_xcc_id() { return (unsigned)__builtin_amdgcn_s_getreg((3 << 11) | 20) & 0xFu; }
#define XB_SPIN(cond, bar) do { unsigned _sp = 0; while (cond) { __builtin_amdgcn_s_sleep(1); \
    if ((++_sp & 255u) == 0u) { if (xb_ld(&(bar)[XB_TMO])) break; if (_sp > XB_SPIN_CAP) { atomicAdd(&(bar)[XB_TMO], 1u); break; } } } } while (0)

struct XcdBarrier {
    int g_wv; unsigned* bar; unsigned x;
    volatile LAS unsigned* st;
};

__device__ __forceinline__ XcdBarrier xcd_barrier_post(unsigned* bar, volatile LAS unsigned* st, int g_wv) {
    XcdBarrier b; b.g_wv = g_wv; b.bar = bar; b.x = xb_xcc_id(); b.st = st;
    if (TIDX == 0) (void)xb_add(&bar[XB_XCNT(b.x)], 1u);
    return b;
}
__device__ __forceinline__ void xcd_barrier_complete(unsigned* bar, unsigned x, unsigned& nloc, unsigned& nx) {
    const unsigned G = gridDim.x * gridDim.y * gridDim.z;
    unsigned sum, cnt, mine, sp = 0u;
    for (;;) {
        sum = 0u; cnt = 0u; mine = 0u;
#pragma unroll
        for (unsigned j = 0; j < 16; ++j) { const unsigned c = xb_ld(&bar[XB_XCNT(j)]); sum += c; cnt += (c > 0u) ? 1u : 0u; mine = (j == x) ? c : mine; }
        if (sum == G) break;
        __builtin_amdgcn_s_sleep(1);
        if ((++sp & 255u) == 0u) { if (xb_ld(&bar[XB_TMO])) break; if (sp > XB_SPIN_CAP) { atomicAdd(&bar[XB_TMO], 1u); break; } }
    }
    nloc = mine > 0u ? mine : 1u; nx = cnt > 0u ? cnt : 1u;
}

__device__ __forceinline__ void xcd_barrier(const XcdBarrier& b) {
    asm volatile("s_waitcnt vmcnt(0)" ::: "memory");
    __syncthreads();
    const int g_wv = b.g_wv;
    if (TIDX == 0) {
        unsigned* bar = b.bar;
        __builtin_amdgcn_s_waitcnt(0);
        unsigned nloc = b.st[0], nx = b.st[1];
        if (nloc == 0u) { xcd_barrier_complete(bar, b.x, nloc, nx); b.st[0] = nloc; b.st[1] = nx; }
        const unsigned old = xb_add(&bar[XB_XSUB(b.x)], 1u);
        const unsigned gen = old / nloc;
        if (old + 1u == (gen + 1u) * nloc) {
            __builtin_amdgcn_fence(__ATOMIC_RELEASE, "agent");
            asm volatile("s_waitcnt vmcnt(0)" ::: "memory");
            const unsigned og = xb_add(&bar[XB_TOP], 1u);
            const unsigned tg = og / nx;
            if (og + 1u == (tg + 1u) * nx) xb_add(&bar[XB_TOPGEN], 1u);
            else XB_SPIN(xb_ld(&bar[XB_TOPGEN]) == tg, bar);
            __builtin_amdgcn_fence(__ATOMIC_ACQUIRE, "agent");
            xb_add(&bar[XB_XGEN(b.x)], 1u);
            asm volatile("s_waitcnt vmcnt(0)" ::: "memory");
        } else {
            XB_SPIN(xb_ld(&bar[XB_XGEN(b.x)]) == gen, bar);
            __builtin_amdgcn_fence(__ATOMIC_ACQUIRE, "agent");
            asm volatile("s_waitcnt vmcnt(0)" ::: "memory");
        }
    }
    __syncthreads();
}
struct Inputs { const float* p[30]; };
typedef const __attribute__((address_space(4))) Inputs* InPtr;
__device__ __forceinline__ InPtr in_tab() { InPtr p = (InPtr)__builtin_amdgcn_kernarg_segment_ptr(); asm volatile("" : "+s"(p)); return p; }
__device__ __forceinline__ unsigned char* launder(unsigned char* p) { size_t z = 0; asm volatile("" : "+s"(z)); return p + z; }

__host__ __device__ inline int inproj_refcol(int G, int e) {
    if (G < 6) return O_AQ + G * 64 + e;
    if (G < 18) return O_AKV + (G - 6) * 64 + e;
    if (G < 26) return O_BQK + (G - 18) * 64 + e;
    if (G < 30) return O_BV + (G - 26) * 64 + e;
    if (G < 34) return O_BO + (G - 30) * 64 + e;
    if (G < 37) return O_CDQ + (G - 34) * 64 + e;
    if (G == 37) { if (e < 32) return O_CKR + e; if (e < 50) return O_AG + (e - 32); if (e < 58) return O_BIF + (e - 50); return -1; }
    return O_CDKV + (G - 38) * 64 + e;
}
__host__ __device__ inline int uq_refcol(int G, int e) {
    if (G < 6) return G * 96 + e;
    if (G < 9) { const int idx = e & 31, bj = e >> 5, sub = idx >> 4, i = idx & 15; return (2 * (G - 6) + sub) * 96 + 64 + bj * 16 + i; }
    return -1;
}
__host__ __device__ inline int ukv_refcol(int G, int e) { return G < 6 ? G * 128 + e : (G - 6) * 128 + 64 + e; }
#define N2G(n) ((((n) >> 8) << 2) + (((n) >> 5) & 3))
#define N2E(n) (((((n) >> 7) & 1) << 5) + ((n) & 31))

__device__ __forceinline__ float opaque_f(float v) { asm volatile("" : "+v"(v)); return v; }
struct FWin { const float* w; const float* g; __device__ __forceinline__ void ld(int k, int n, const float*& p, float& gn, float gk) const { const int c = inproj_refcol(N2G(n), N2E(n)); p = w + (size_t)k * DIN + (c < 0 ? 0 : c); gn = c < 0 ? 0.f : gk; }
    __device__ __forceinline__ float rowgain(int k) const { return opaque_f(g[k]); } };
struct FWout { const float* w; const float* ga; const float* gc; __device__ __forceinline__ void ld(int k, int n, const float*& p, float& gn, float gk) const {
    const int kr = k < 384 ? k : (k < 768 ? 640 + (k - 384) : 384 + (k - 768)); p = w + (size_t)kr * 1024 + n; gn = gk; }
    __device__ __forceinline__ float rowgain(int k) const { const float a = opaque_f(ga[k < 384 ? k : 0]), c = opaque_f(gc[(k >= 384 && k < 768) ? k - 384 : 0]); return k < 384 ? a : (k < 768 ? c : 1.f); } };
struct FWuq { const float* w; const float* g; __device__ __forceinline__ void ld(int k, int n, const float*& p, float& gn, float gk) const { const int c = uq_refcol(N2G(n), N2E(n)); const int kk = k < 192 ? k : 191; p = w + (size_t)kk * 576 + (c < 0 ? 0 : c); gn = (k < 192 && c >= 0) ? gk : 0.f; }
    __device__ __forceinline__ float rowgain(int k) const { return opaque_f(g[k < 192 ? k : 191]); } };
struct FWukv { const float* w; const float* g; __device__ __forceinline__ void ld(int k, int n, const float*& p, float& gn, float gk) const { const int c = ukv_refcol(N2G(n), N2E(n)); const int kk = k >= 128 ? k - 128 : 0; p = w + (size_t)kk * 768 + c; gn = k >= 128 ? gk : 0.f; }
    __device__ __forceinline__ float rowgain(int k) const { return opaque_f(g[k >= 128 ? k - 128 : 0]); } };
struct FWc1 { const float* w; __device__ __forceinline__ void ld(int k, int n, const float*& p, float& gn, float gk) const { p = w + (size_t)k * 64 + n; gn = 1.f; }
    __device__ __forceinline__ float rowgain(int k) const { return 1.f; } };
struct FWr { const float* wg; const float* we; const float* g; __device__ __forceinline__ void ld(int k, int n, const float*& p, float& gn, float gk) const { p = n < 4 ? wg + k * 4 + n : we + k * 32 + (n < 36 ? n - 4 : 0); gn = n < 36 ? gk : 0.f; }
    __device__ __forceinline__ float rowgain(int k) const { return opaque_f(g[k]); } };
struct FWgu { const float* src; const float* g; int n0, col0; __device__ __forceinline__ float operator()(int k, int n) const { return src[(size_t)k * 256 + col0 + (n - n0)] * g[k]; } };
struct FWd { const float* w; __device__ __forceinline__ float operator()(int k, int n) const { return w[(size_t)k * 1024 + n]; } };

__device__ __forceinline__ void rope_cs(int pos, int j, float& cs, float& sn) {
    const double inv = exp2(-(double)j * (13.287712379549449 / 16.0));
    const double rev = (double)pos * inv * 0.15915494309189535; const float f = (float)(rev - rint(rev));
    cs = __builtin_amdgcn_cosf(f); sn = __builtin_amdgcn_sinf(f);
}
template <class F>
__device__ __forceinline__ void cvt_tile(const F& f, int n0, int k0, bf16_t* dst, int ldk, LAS float* tile, int tid) {
    { const int k = tid >> 3, nb = (tid & 7) * 8; const float gk = f.rowgain(k0 + k); const float* p[8]; float gn[8], v[8];
#pragma unroll
      for (int j = 0; j < 8; ++j) f.ld(k0 + k, n0 + nb + j, p[j], gn[j], gk);
#pragma unroll
      for (int j = 0; j < 8; ++j) v[j] = *p[j];
#pragma unroll
      for (int j = 0; j < 8; ++j) tile[k * 65 + nb + j] = v[j] * gn[j]; }
    __syncthreads();
    { const int n = tid >> 3, kb = (tid & 7) * 8; const LAS float* s = tile + kb * 65 + n;
      u32x4 o; o.x = pk_bf16(s[0], s[65]); o.y = pk_bf16(s[130], s[195]); o.z = pk_bf16(s[260], s[325]); o.w = pk_bf16(s[390], s[455]);
      *(u32x4*)(dst + (size_t)(n0 + n) * ldk + k0 + kb) = o; }
    __syncthreads();
}
template <class F>
__device__ __forceinline__ void cvt_item(const F& f, int it, int nK, bf16_t* dst, int ldk, LAS float* tile, int tid) { cvt_tile(f, (it / nK) * 64, (it % nK) * 64, dst, ldk, tile, tid); }

__device__ __forceinline__ void moe_item(InPtr in, int l, int it, const float*& src, int& ld, size_t& dst, int& ldk, bool& gain, int& kk0) {
    if (it < 32 * 64) { const int e = it >> 6, r = it & 63, n0 = (r >> 3) * 64, k0 = (r & 7) * 128, c0 = n0 & 255;
        src = (c0 < 128 ? in->p[27] : in->p[28]) + ((size_t)l * 32 + e) * 262144 + (size_t)k0 * 256 + (n0 >> 8) * 128 + (c0 & 127); ld = 256; gain = true; kk0 = k0;
        dst = ((size_t)e * 512 + n0) * 1024 + k0; ldk = 1024; }
    else { const int j = it - 32 * 64, e = j >> 5, r = j & 31, n0 = (r >> 1) * 64, k0 = (r & 1) * 128;
        src = in->p[29] + ((size_t)l * 32 + e) * 262144 + (size_t)k0 * 1024 + n0; ld = 1024; gain = false; kk0 = 0;
        dst = (size_t)16777216 + ((size_t)e * 1024 + n0) * 256 + k0; ldk = 256; }
}
__device__ __forceinline__ void cvt_moe_layer(InPtr in, unsigned char* ws, int l, LAS float* tile, int bid, int nb, int tid, int it_lo = 0, int it_hi = 32 * (64 + 32)) {
    asm volatile("" : "+v"(tid));
    const float* g2 = in->p[22] + l * 1024; bf16_t* W = (bf16_t*)(ws + WS_WMOE);
    const int k = tid >> 3, nbq = (tid & 7) * 8;
    const int n = tid >> 3, kb = (tid & 7) * 8;
    const int NIT = it_hi;
#define CVM_LOAD(it_, P) do { const float* src_; int ld_, ldk_, kk0_; size_t dst_; bool gain_; moe_item(in, l, (it_), src_, ld_, dst_, ldk_, gain_, kk0_); \
        P##a = *(const f32x4*)(src_ + (size_t)k * ld_ + nbq); P##b = *(const f32x4*)(src_ + (size_t)k * ld_ + nbq + 4); P##c = *(const f32x4*)(src_ + (size_t)(k + 64) * ld_ + nbq); P##d = *(const f32x4*)(src_ + (size_t)(k + 64) * ld_ + nbq + 4); \
        P##g0 = gain_ ? g2[kk0_ + k] : 1.f; P##g1 = gain_ ? g2[kk0_ + 64 + k] : 1.f; } while (0)
#define CVM_PUT(t, P) do { \
        t[k * 65 + nbq + 0] = P##a.x * P##g0; t[k * 65 + nbq + 1] = P##a.y * P##g0; t[k * 65 + nbq + 2] = P##a.z * P##g0; t[k * 65 + nbq + 3] = P##a.w * P##g0; \
        t[k * 65 + nbq + 4] = P##b.x * P##g0; t[k * 65 + nbq + 5] = P##b.y * P##g0; t[k * 65 + nbq + 6] = P##b.z * P##g0; t[k * 65 + nbq + 7] = P##b.w * P##g0; \
        t[(k + 64) * 65 + nbq + 0] = P##c.x * P##g1; t[(k + 64) * 65 + nbq + 1] = P##c.y * P##g1; t[(k + 64) * 65 + nbq + 2] = P##c.z * P##g1; t[(k + 64) * 65 + nbq + 3] = P##c.w * P##g1; \
        t[(k + 64) * 65 + nbq + 4] = P##d.x * P##g1; t[(k + 64) * 65 + nbq + 5] = P##d.y * P##g1; t[(k + 64) * 65 + nbq + 6] = P##d.z * P##g1; t[(k + 64) * 65 + nbq + 7] = P##d.w * P##g1; } while (0)
#define CVM_STORE(it_, t) do { const float* src_; int ld_, ldk_, kk0_; size_t dst_; bool gain_; moe_item(in, l, (it_), src_, ld_, dst_, ldk_, gain_, kk0_); \
        _Pragma("unroll") for (int hh = 0; hh < 2; ++hh) { const LAS float* s_ = t + (64 * hh + kb) * 65 + n; \
            u32x4 o; o.x = pk_bf16(s_[0], s_[65]); o.y = pk_bf16(s_[130], s_[195]); o.z = pk_bf16(s_[260], s_[325]); o.w = pk_bf16(s_[390], s_[455]); \
            *(u32x4*)(W + dst_ + (size_t)n * ldk_ + 64 * hh + kb) = o; } } while (0)
    f32x4 Aa, Ab, Ac, Ad, Ba, Bb, Bc, Bd; float Ag0 = 1.f, Ag1 = 1.f, Bg0 = 1.f, Bg1 = 1.f;
    LAS float* t0 = tile; LAS float* t1 = tile + 128 * 65;
    int it = it_lo + bid;
    if (it < NIT) CVM_LOAD(it, A);
    if (it + nb < NIT) CVM_LOAD(it + nb, B);
#pragma unroll 1
    for (; it < NIT; it += 2 * nb) {
        CVM_PUT(t0, A);
        __syncthreads();
        if (it + 2 * nb < NIT) CVM_LOAD(it + 2 * nb, A);
        CVM_STORE(it, t0);
        if (it + nb < NIT) {
            CVM_PUT(t1, B);
            __syncthreads();
            if (it + 3 * nb < NIT) CVM_LOAD(it + 3 * nb, B);
            CVM_STORE(it + nb, t1);
        }
    }
#undef CVM_LOAD
#undef CVM_PUT
#undef CVM_STORE
    __syncthreads();
}

__device__ __forceinline__ void cvt_small_weights(InPtr in, unsigned char* ws, int l, LAS float* tile, int bid, int nb, int tid) {
    asm volatile("" : "+v"(tid));
    constexpr int I_WIN = 40 * 16, I_WOUT = 16 * 16, I_WU = 12 * 4, I_WC1 = 32, I_WC2 = 1, I_WR = 16;
    constexpr int PER_L = I_WIN + I_WOUT + 2 * I_WU + 2 * I_WC1 + 2 * I_WC2 + I_WR;
    for (int it0 = bid; it0 < PER_L; it0 += nb) {
        int it = it0;
        if (it < I_WIN) { FWin f{in->p[4] + (size_t)l * 1024 * DIN, in->p[3] + l * 1024}; cvt_item(f, it, 16, (bf16_t*)(ws + WS_WIN) + (size_t)l * 2560 * 1024, 1024, tile, tid); continue; } it -= I_WIN;
        if (it < I_WOUT) { FWout f{in->p[21] + (size_t)l * 1048576, in->p[10] + l * 384, in->p[20] + l * 384}; cvt_item(f, it, 16, (bf16_t*)(ws + WS_WOUT) + (size_t)l * 1048576, 1024, tile, tid); continue; } it -= I_WOUT;
        if (it < I_WU) { FWuq f{in->p[16] + (size_t)l * 192 * 576, in->p[15] + l * 192}; cvt_item(f, it, 4, (bf16_t*)(ws + WS_WUQ) + (size_t)l * 768 * 256, 256, tile, tid); continue; } it -= I_WU;
        if (it < I_WU) { FWukv f{in->p[18] + (size_t)l * 128 * 768, in->p[17] + l * 128}; cvt_item(f, it, 4, (bf16_t*)(ws + WS_WUKV) + (size_t)l * 768 * 256, 256, tile, tid); continue; } it -= I_WU;
        if (it < 2 * I_WC1) { const int s = it / I_WC1; FWc1 f{in->p[6] + ((size_t)l * 2 + s) * 2048 * 64}; cvt_item(f, it % I_WC1, 32, (bf16_t*)(ws + WS_WC1) + ((size_t)l * 2 + s) * 64 * 2048, 2048, tile, tid); continue; } it -= 2 * I_WC1;
        if (it < 2 * I_WC2) { const int s = it; FWc1 f{in->p[7] + ((size_t)l * 2 + s) * 64 * 64}; cvt_item(f, 0, 1, (bf16_t*)(ws + WS_WC2) + ((size_t)l * 2 + s) * 64 * 64, 64, tile, tid); continue; } it -= 2 * I_WC2;
        { FWr f{in->p[23] + (size_t)l * 4096, in->p[25] + (size_t)l * 32768, in->p[22] + l * 1024}; cvt_item(f, it, 16, (bf16_t*)(ws + WS_WR) + (size_t)l * 64 * 1024, 1024, tile, tid); }
    }
}

__device__ __forceinline__ void prologue(InPtr in, unsigned char* ws, LAS unsigned char* lds, int bid, int nb, int g_wv) {
    int tid_ = TIDX; asm volatile("" : "+v"(tid_));
    const int tid = tid_, lane = tid & 63, wid = tid >> 6;
    LAS float* tile = (LAS float*)lds;
    cvt_small_weights(in, ws, 0, tile, bid, nb, tid);
    { const float* x = in->p[0]; bf16_t* XB = (bf16_t*)(ws + WS_XB); float* ssqx = (float*)(ws + WS_SSQX);
      for (int r0 = (bid * 8 + wid) * 2; r0 < NTOK; r0 += nb * 16) {
          f32x4 v[2][4];
#pragma unroll
          for (int rr = 0; rr < 2; ++rr)
#pragma unroll
              for (int j = 0; j < 4; ++j) v[rr][j] = *((const f32x4*)(x + (size_t)(r0 + rr) * 1024) + lane + 64 * j);
#pragma unroll
          for (int rr = 0; rr < 2; ++rr) { float s = 0.f; u32x2* o = (u32x2*)(XB + (size_t)(r0 + rr) * 1024) + lane;
#pragma unroll
              for (int j = 0; j < 4; ++j) { const f32x4 q = v[rr][j]; s += (q.x * q.x + q.y * q.y) + (q.z * q.z + q.w * q.w); u32x2 w; w.x = pk_bf16(q.x, q.y); w.y = pk_bf16(q.z, q.w); o[64 * j] = w; }
              s = wave_sum(s); if (lane == 0) ssqx[r0 + rr] = s; }
      } }
    { float* biasd = (float*)(ws + WS_BIASD); const float* rb = in->p[2];
      for (int i = bid * 512 + tid; i < 6 * 2048; i += nb * 512) { const int h = i >> 11, d = i & 2047; biasd[i] = rb[t5b(d) * 6 + h] * 1.44269504f; } }
    { float* rope = (float*)(ws + WS_ROPE); const int* pos = (const int*)in->p[1];
      for (int i = bid * 512 + tid; i < NTOK * 16; i += nb * 512) { const int tk = i >> 4, j = i & 15; float cs, sn; rope_cs(pos[tk], j, cs, sn); rope[(size_t)tk * 32 + j] = cs; rope[(size_t)tk * 32 + 16 + j] = sn; } }
    { float* b1c = (float*)(ws + WS_B1C); LAS float* red = (LAS float*)lds;
      for (int it = nb - 1 - bid; it >= 0 && it < 4; it += nb) { const float* pe = in->p[5] + (size_t)it * 2048; const float* w1 = in->p[6] + (size_t)it * 2048 * 64; const int f4 = tid & 15, kp = tid >> 4;
          f32x4 a = (f32x4){0.f, 0.f, 0.f, 0.f};
#pragma unroll 1
          for (int k0 = kp * 64; k0 < kp * 64 + 64; k0 += 16) { f32x4 wv[16]; float pv[16];
#pragma unroll
              for (int j = 0; j < 16; ++j) { wv[j] = *(const f32x4*)(w1 + (size_t)(k0 + j) * 64 + 4 * f4); pv[j] = pe[k0 + j]; }
#pragma unroll
              for (int j = 0; j < 16; ++j) { a.x += pv[j] * wv[j].x; a.y += pv[j] * wv[j].y; a.z += pv[j] * wv[j].z; a.w += pv[j] * wv[j].w; } }
          __syncthreads(); *(LAS f32x4*)(red + kp * 64 + 4 * f4) = a; __syncthreads();
          if (tid < 64) { float sum = 0.f; for (int p2 = 0; p2 < 32; ++p2) sum += red[p2 * 64 + tid]; b1c[it * 64 + tid] = sum; }
          __syncthreads(); } }
}
namespace g8 {
constexpr int BM = 256, BK = 64, HALF = 128, HTB = HALF * BK * 2, STAGE_BYTES = 8 * HTB, NXCD = 8, WGM = 8;
__host__ __device__ __forceinline__ int lds_byte(int r, int c) { const int st = (r >> 4) * 2 + (c >> 5), rr = r & 15, cc = c & 31, ob = rr * 64 + cc * 2; return st * 1024 + (ob ^ (((ob >> 9) & 1) << 5)); }
__host__ __device__ __forceinline__ void stage_rc(int b, int& R, int& C) { const int st = b / 1024, sb = b % 1024, swz = sb ^ (((sb >> 9) & 1) << 5); R = (st >> 1) * 16 + swz / 64; C = (st & 1) * 32 + (swz % 64) / 2; }
__host__ __device__ __forceinline__ int perm32(int rho) { const int n = rho >> 4, i = rho & 15; return 8 * (i >> 2) + 4 * n + (i & 3); }

struct GUnit { const char* a; const char* b; int pm, pn, e, rows; };

__device__ __forceinline__ bool static_unit(int i, int G, int c, int nM, int nN, int& pm, int& pn) {
    const int nwg = nM * nN; const long L = (long)i * G + c; if (L >= nwg) return false;
    int wgid = (int)L; { const int q = nwg / NXCD, r = nwg % NXCD, xcd = wgid % NXCD, off = wgid / NXCD; wgid = (xcd < r ? xcd * (q + 1) : r * (q + 1) + (xcd - r) * q) + off; }
    const int nig = WGM * nN, gid = wgid / nig, fm = gid * WGM, gsz = (nM - fm) < WGM ? (nM - fm) : WGM;
    pm = fm + ((wgid % nig) % gsz); pn = (wgid % nig) / gsz; return true;
}
struct DenseSched {
    static constexpr bool GATHER = false, PARTIAL = false;
    const char* A; const char* Bt; int lda, ldb, nM, nN, G, c; int rot;
    __device__ __forceinline__ bool next(int i, GUnit& u) const {
        int pm, pn; if (!static_unit(i, G, c, nM, nN, pm, pn)) return false;
        if (rot) { pn += rot; if (pn >= nN) pn -= nN; }
        u.pm = pm; u.pn = pn; u.e = 0; u.rows = 256; u.a = A + (size_t)pm * 256 * lda * 2; u.b = Bt + (size_t)pn * 256 * ldb * 2; return true;
    }
    __device__ __forceinline__ void aoff(const GUnit&, unsigned (&v)[2][2], const int (&R)[2], const int (&C)[2]) const {
#pragma unroll
        for (int h = 0; h < 2; ++h)
#pragma unroll
            for (int i = 0; i < 2; ++i) v[h][i] = (unsigned)((h * 128 + R[i]) * lda + C[i]) * 2u;
    }
};

template <class Epi, class Sched>
__device__ __forceinline__ void gemm_run(LAS unsigned char* lds, const int K, const int ldb, const Sched& S, const Epi& E, int g_wv) {
    int tid_ = TIDX; asm volatile("" : "+v"(tid_));
    const int tid = tid_, wid = __builtin_amdgcn_readfirstlane(tid >> 6), lane = tid & 63, wr = wid >> 2, wc = wid & 3, fr = lane & 15, fq = lane >> 4;
    int nt_ = K / BK; asm volatile("" : "+s"(nt_));
    const int nt = nt_;
    int R[2], C[2]; unsigned voffB[2];
#pragma unroll
    for (int i = 0; i < 2; ++i) { stage_rc(tid * 16 + i * 8192, R[i], C[i]); const int Rb = (R[i] & ~31) + perm32(R[i] & 31); voffB[i] = (unsigned)(Rb * ldb + C[i]) * 2u; }
    const size_t kstep = (size_t)(BK * 2);
    const size_t hstepB = (size_t)HALF * ldb * 2;
    const unsigned ldsw = (unsigned)wid * 1024u;
    const int aoff = lds_byte(wr * 64 + fr, fq * 8), boff = lds_byte(wc * 32 + fr, fq * 8);
#define G8_SA(b, h) (((b) * 2 + (h)) * HTB)
#define G8_SB(b, h) ((4 + (b) * 2 + (h)) * HTB)
#define G8_GLDS(bufoff, gptr, i_) __builtin_amdgcn_global_load_lds((const unsigned*)(gptr), (LAS unsigned*)(lds + (bufoff) + ldsw + (i_) * 8192), 16, 0, 0)
#define G8_STAGE_B(bufoff, gbase) do { G8_GLDS(bufoff, (const char*)(gbase) + voffB[0], 0); G8_GLDS(bufoff, (const char*)(gbase) + voffB[1], 1); } while (0)
#define G8_STAGE_A(bufoff, gbase, v0, v1) do { G8_GLDS(bufoff, (const char*)(gbase) + (v0), 0); G8_GLDS(bufoff, (const char*)(gbase) + (v1), 1); } while (0)
#define G8_LDA(dst, b, h) do { _Pragma("unroll") for (int m = 0; m < 4; ++m) _Pragma("unroll") for (int k = 0; k < 2; ++k) dst[m][k] = *(const LAS bf16x8*)(lds + G8_SA(b, h) + aoff + m * 2048 + k * 1024); } while (0)
#define G8_LDB(dst, b, h) do { _Pragma("unroll") for (int n = 0; n < 2; ++n) _Pragma("unroll") for (int k = 0; k < 2; ++k) dst[n][k] = *(const LAS bf16x8*)(lds + G8_SB(b, h) + boff + n * 2048 + k * 1024); } while (0)
#define G8_MMA(ai, bj, At, Bt) do { __builtin_amdgcn_s_setprio(1); _Pragma("unroll") for (int m = 0; m < 4; ++m) { if (!PARTIAL || ((mmask >> ((ai) * 4 + m)) & 1u)) { _Pragma("unroll") for (int n = 0; n < 2; ++n) _Pragma("unroll") for (int k = 0; k < 2; ++k) \
        acc[ai][bj][m][n] = __builtin_amdgcn_mfma_f32_16x16x32_bf16(Bt[n][k], At[m][k], acc[ai][bj][m][n], 0, 0, 0); } } __builtin_amdgcn_s_setprio(0); } while (0)
#define G8_WAIT_V(n) asm volatile("s_waitcnt vmcnt(" #n ")" ::: "memory")
#define G8_WAIT_L(n) asm volatile("s_waitcnt lgkmcnt(" #n ")" ::: "memory")
#define G8_BAR __builtin_amdgcn_s_barrier()
#define G8_SCHED __builtin_amdgcn_sched_barrier(0)
    GUnit cur, nxt; int ui = 0;
    if (!S.next(0, cur)) return;
    constexpr bool GATHER = Sched::GATHER, PARTIAL = Sched::PARTIAL;
    unsigned mmask = 0xffu;
#define G8_MASK(u) do { if (PARTIAL) { mmask = 0u; _Pragma("unroll") for (int q_ = 0; q_ < 8; ++q_) mmask |= (((q_ >> 2) * 128 + wr * 64 + (q_ & 3) * 16) < (u).rows) ? (1u << q_) : 0u; } } while (0)
    unsigned vc[2][2];
    S.aoff(cur, vc, R, C); G8_MASK(cur);
    LAS u32x4* stash = (LAS u32x4*)(lds + STAGE_BYTES + 4096) + tid;
    f32x4 acc[2][2][4][2];
#pragma unroll
    for (int a = 0; a < 2; ++a)
#pragma unroll
        for (int b = 0; b < 2; ++b)
#pragma unroll
            for (int m = 0; m < 4; ++m)
#pragma unroll
                for (int n = 0; n < 2; ++n) acc[a][b][m][n] = (f32x4){0.f, 0.f, 0.f, 0.f};
    bf16x8 At[4][2], B0[2][2], B1[2][2];
    const char* cA = cur.a; const char* cB = cur.b;
    G8_STAGE_B(G8_SB(0, 0), cB); G8_STAGE_B(G8_SB(0, 1), cB + hstepB); G8_STAGE_A(G8_SA(0, 0), cA, vc[0][0], vc[0][1]); G8_STAGE_A(G8_SA(0, 1), cA, vc[1][0], vc[1][1]);
    if (wr == 1) G8_BAR;
    G8_WAIT_V(2); G8_BAR;
    G8_STAGE_B(G8_SB(1, 0), cB + kstep); G8_STAGE_A(G8_SA(1, 0), cA + kstep, vc[0][0], vc[0][1]); G8_STAGE_B(G8_SB(1, 1), cB + hstepB + kstep);
    G8_WAIT_V(6); G8_BAR;
    for (;;) {
        const bool has_next = S.next(ui + 1, nxt);
        if (GATHER) { unsigned vn[2][2];
            if (has_next) S.aoff(nxt, vn, R, C);
            else { vn[0][0] = vc[0][0]; vn[0][1] = vc[0][1]; vn[1][0] = vc[1][0]; vn[1][1] = vc[1][1]; }
            u32x4 sv; sv.x = vn[0][0]; sv.y = vn[0][1]; sv.z = vn[1][0]; sv.w = vn[1][1]; *stash = sv; }
        const char* nA = has_next ? nxt.a : cA; const char* nB = has_next ? nxt.b : cB;
#pragma unroll 1
        for (int seg = 0; seg < (Epi::KHOOK ? 3 : 1); ++seg) {
        const int tlo = Epi::KHOOK ? 6 * seg : 0, thi = Epi::KHOOK ? (seg == 2 ? nt : 6 * seg + 6) : nt;
#pragma unroll 1
        for (int t = tlo; t < thi; t += 2) {
            const bool last = (t == nt - 2);
            const char* a1 = cA + (size_t)(t + 1) * kstep;
            const char* a2 = last ? nA : cA + (size_t)(t + 2) * kstep; const char* b2 = last ? nB : cB + (size_t)(t + 2) * kstep;
            const char* a3 = a2 + kstep; const char* b3 = b2 + kstep;
            unsigned w00 = vc[0][0], w01 = vc[0][1], w10 = vc[1][0], w11 = vc[1][1];
            if (GATHER) { if (last) { const u32x4 sv = *stash; w00 = sv.x; w01 = sv.y; w10 = sv.z; w11 = sv.w; } }
            G8_LDB(B0, 0, 0); G8_LDB(B1, 0, 1); G8_SCHED; G8_LDA(At, 0, 0); G8_STAGE_A(G8_SA(1, 1), a1, vc[1][0], vc[1][1]);
            G8_WAIT_V(8); G8_WAIT_L(0); G8_BAR; G8_MMA(0, 0, At, B0); G8_MMA(0, 1, At, B1); G8_BAR; G8_SCHED;
            G8_LDA(At, 0, 1); G8_STAGE_B(G8_SB(0, 0), b2); G8_STAGE_B(G8_SB(0, 1), b2 + hstepB); G8_STAGE_A(G8_SA(0, 0), a2, w00, w01);
            G8_WAIT_V(8); G8_WAIT_L(0); G8_BAR; G8_MMA(1, 0, At, B0); G8_MMA(1, 1, At, B1); G8_BAR; G8_SCHED;
            G8_LDB(B0, 1, 0); G8_LDB(B1, 1, 1); G8_SCHED; G8_LDA(At, 1, 0); G8_STAGE_A(G8_SA(0, 1), a2, w10, w11);
            G8_WAIT_V(8); G8_WAIT_L(0); G8_BAR; G8_MMA(0, 0, At, B0); G8_MMA(0, 1, At, B1); G8_BAR; G8_SCHED;
            G8_LDA(At, 1, 1); G8_STAGE_B(G8_SB(1, 0), b3); G8_STAGE_B(G8_SB(1, 1), b3 + hstepB); G8_STAGE_A(G8_SA(1, 0), a3, w00, w01);
            G8_WAIT_V(8); G8_WAIT_L(0); G8_BAR; G8_MMA(1, 0, At, B0); G8_MMA(1, 1, At, B1); G8_BAR; G8_SCHED;
        }
        if constexpr (Epi::KHOOK) { if (seg < 2) E.kscale(acc, seg, wr, fr); }
        }
        if (wr == 0) G8_BAR;
        { int fr_ = fr, fq_ = fq; asm volatile("" : "+v"(fr_), "+v"(fq_));
          E(acc, cur, wr, wc, fr_, fq_); }
        if (!has_next) break;
#pragma unroll
        for (int a = 0; a < 2; ++a)
#pragma unroll
            for (int b = 0; b < 2; ++b)
#pragma unroll
                for (int m = 0; m < 4; ++m)
#pragma unroll
                    for (int n = 0; n < 2; ++n) acc[a][b][m][n] = (f32x4){0.f, 0.f, 0.f, 0.f};
        cur = nxt; cA = nA; cB = nB; ++ui; G8_MASK(cur);
        if (GATHER) { const u32x4 sv = *stash; vc[0][0] = sv.x; vc[0][1] = sv.y; vc[1][0] = sv.z; vc[1][1] = sv.w; }
        if (wr == 1) G8_BAR;
    }
    G8_WAIT_V(0);
    G8_BAR;
#undef G8_SA
#undef G8_SB
#undef G8_GLDS
#undef G8_STAGE_A
#undef G8_STAGE_B
#undef G8_LDA
#undef G8_LDB
#undef G8_MMA
#undef G8_MASK
#undef G8_WAIT_V
#undef G8_WAIT_L
#undef G8_BAR
#undef G8_SCHED
}
}
using g8::GUnit;
__device__ __forceinline__ void st_bf16x8(bf16_t* p, const float (&v)[8]) { u32x4 w; w.x = pk_bf16(v[0], v[1]); w.y = pk_bf16(v[2], v[3]); w.z = pk_bf16(v[4], v[5]); w.w = pk_bf16(v[6], v[7]); *(u32x4*)p = w; }
__device__ __forceinline__ float quad_sum(float s) { s += shx<16>(s); s += __shfl_xor(s, 32); return s; }

struct EpiInProj {
    static constexpr bool KHOOK = false;
    const float* ssqx; float* part_dq; float* part_dkv; const float* qg; const float* kg; const float* krg; const float* rope;
    unsigned char* prj;
    __device__ __forceinline__ void operator()(const f32x4 (&acc)[2][2][4][2], const GUnit& u, int wr, int wc, int fr, int fq) const {
        const int G = u.pn * 4 + wc;
        const bool isq = G < 6; const int a = G - 6; const bool isk = (G >= 10 && G < 18 && ((a >> 1) & 1) == 0);
        const float* g0 = (isq ? qg : kg) + 8 * fq;
        float rs8[8];
#pragma unroll
        for (int k = 0; k < 8; ++k) rs8[k] = ssqx[u.pm * 256 + (k >> 2) * 128 + wr * 64 + (k & 3) * 16 + fr];
#pragma unroll
        for (int k = 0; k < 8; ++k) rs8[k] = rsqrtf(rs8[k] * (1.f / 1024.f) + 1e-6f);
#pragma unroll
        for (int ai = 0; ai < 2; ++ai)
#pragma unroll
            for (int m = 0; m < 4; ++m) {
                __builtin_amdgcn_sched_barrier(0);
                const int row = u.pm * 256 + ai * 128 + wr * 64 + m * 16 + fr; const int b = row >> 11, t = row & 2047;
                const float rs = rs8[ai * 4 + m];
                float v[2][8];
#pragma unroll
                for (int bj = 0; bj < 2; ++bj)
#pragma unroll
                    for (int n = 0; n < 2; ++n)
#pragma unroll
                        for (int j = 0; j < 4; ++j) v[bj][4 * n + j] = acc[ai][bj][m][n][j] * rs;
                float ss = 0.f;
#pragma unroll
                for (int bj = 0; bj < 2; ++bj)
#pragma unroll
                    for (int i = 0; i < 8; ++i) ss += v[bj][i] * v[bj][i];
                bf16_t* dst = nullptr; int bstride = 32;
                if (isq) {
                    ss = quad_sum(ss); const float sc = rsqrtf(ss * (1.f / 64.f) + 1e-6f) * 0.18033688f;
#pragma unroll
                    for (int i = 0; i < 8; ++i) { v[0][i] *= sc * g0[i]; v[1][i] *= sc * g0[32 + i]; }
                    dst = (bf16_t*)(prj + PRJ_QN) + ((size_t)(b * 6 + G) * 2048 + t) * 64;
                } else if (G < 18) {
                    const int br = a >> 2, s = (a >> 1) & 1, hk = a & 1;
                    if (br > 0 && s == 0) {
                        ss = quad_sum(ss); const float sc = rsqrtf(ss * (1.f / 64.f) + 1e-6f);
#pragma unroll
                        for (int i = 0; i < 8; ++i) { v[0][i] *= sc * g0[i]; v[1][i] *= sc * g0[32 + i]; }
                    }
                    const size_t base = br == 0 ? (s ? PRJ_C0V : PRJ_C0K) : (br == 1 ? (s ? PRJ_VN1 : PRJ_KN1) : (s ? PRJ_VN2 : PRJ_KN2));
                    dst = (bf16_t*)(prj + base) + ((size_t)(b * 2 + hk) * 2048 + t) * 64;
                } else if (G < 26) { dst = (bf16_t*)(prj + PRJ_RAWQK) + (size_t)row * 512 + (G - 18) * 64; }
                else if (G < 30) { dst = (bf16_t*)(prj + PRJ_VML) + ((size_t)(b * 4 + (G - 26)) * 2048 + t) * 64; }
                else if (G < 34) { dst = (bf16_t*)(prj + PRJ_OG) + (size_t)row * 256 + (G - 30) * 64; }
                else if (G < 37) { dst = (bf16_t*)(prj + PRJ_DQKV) + (size_t)row * 384 + (G - 34) * 64; ss = quad_sum(ss); if (fq == 0) part_dq[(size_t)row * 4 + (G - 34)] = ss; }
                else if (G == 37) {
                    dst = (bf16_t*)(prj + PRJ_DQKV) + (size_t)row * 384 + 192;
                    float* gt = (float*)(prj + PRJ_GATES) + (size_t)row * 32 + 8 * fq;
                    *(f32x4*)gt = (f32x4){v[1][0], v[1][1], v[1][2], v[1][3]}; *(f32x4*)(gt + 4) = (f32x4){v[1][4], v[1][5], v[1][6], v[1][7]};
                    float s0 = 0.f;
#pragma unroll
                    for (int i = 0; i < 8; ++i) s0 += v[0][i] * v[0][i];
                    s0 = quad_sum(s0); const float sc = rsqrtf(s0 * (1.f / 32.f) + 1e-6f);
                    const float* rp = rope + (size_t)row * 32 + ((8 * fq) & 15);
                    float kr[8];
#pragma unroll
                    for (int i = 0; i < 8; ++i) { const float val = v[0][i] * sc * krg[8 * fq + i]; const float oth = __shfl_xor(val, 32); const float cs = rp[i], sn = rp[16 + i]; kr[i] = fq < 2 ? val * cs - oth * sn : val * cs + oth * sn; }
                    st_bf16x8((bf16_t*)(prj + PRJ_KR) + (size_t)row * 32 + 8 * fq, kr);
                } else { dst = (bf16_t*)(prj + PRJ_DQKV) + (size_t)row * 384 + 256 + (G - 38) * 64; ss = quad_sum(ss); if (fq == 0) part_dkv[(size_t)row * 2 + (G - 38)] = ss; }
                st_bf16x8(dst + 8 * fq, v[0]); st_bf16x8(dst + bstride + 8 * fq, v[1]);
            }
    }
};

struct EpiUq {
    static constexpr bool KHOOK = false;
    const float* ssq_dq; const float* qkn; const float* rope; bf16_t* QM;
    __device__ __forceinline__ void operator()(const f32x4 (&acc)[2][2][4][2], const GUnit& u, int wr, int wc, int fr, int fq) const {
        const int G = u.pn * 4 + wc; if (G >= 9) return;
        const float scale = 0.14724444f;
        const float* g0 = G < 6 ? qkn + 8 * fq : qkn + 64 + 8 * (fq & 1); const float* g1 = G < 6 ? g0 + 32 : g0 + 16;
        float rs8[8];
#pragma unroll
        for (int k = 0; k < 8; ++k) { const f32x4 pq = *(const f32x4*)(ssq_dq + (size_t)(u.pm * 256 + (k >> 2) * 128 + wr * 64 + (k & 3) * 16 + fr) * 4); rs8[k] = (pq.x + pq.y) + pq.z; }
#pragma unroll
        for (int k = 0; k < 8; ++k) rs8[k] = rsqrtf(rs8[k] * (1.f / 192.f) + 1e-6f);
#pragma unroll
        for (int ai = 0; ai < 2; ++ai) {
#pragma unroll
            for (int m = 0; m < 4; ++m) {
                __builtin_amdgcn_sched_barrier(0);
                const int row = u.pm * 256 + ai * 128 + wr * 64 + m * 16 + fr; const int b = row >> 11, t = row & 2047;
                const float rs = rs8[ai * 4 + m];
                float v[2][8]; float ss = 0.f;
#pragma unroll
                for (int bj = 0; bj < 2; ++bj)
#pragma unroll
                    for (int n = 0; n < 2; ++n)
#pragma unroll
                        for (int j = 0; j < 4; ++j) { const float x = acc[ai][bj][m][n][j] * rs; v[bj][4 * n + j] = x; ss += x * x; }
                if (G < 6) ss = quad_sum(ss); else ss += shx<16>(ss);
                const float sc = rsqrtf(ss * (G < 6 ? 1.f / 64.f : 1.f / 32.f) + 1e-6f) * scale;
#pragma unroll
                for (int i = 0; i < 8; ++i) { v[0][i] *= sc * g0[i]; v[1][i] *= sc * g1[i]; }
                if (G < 6) {
                    bf16_t* dst = QM + ((size_t)(b * 6 + G) * 2048 + t) * 96;
                    st_bf16x8(dst + 8 * fq, v[0]); st_bf16x8(dst + 32 + 8 * fq, v[1]);
                } else {
                    const int i16 = 8 * (fq & 1); const int head = 2 * (G - 6) + (fq >> 1);
                    const float* rp = rope + (size_t)row * 32 + i16; float o1[8], o2[8];
#pragma unroll
                    for (int i = 0; i < 8; ++i) { const float cs = rp[i], sn = rp[16 + i]; o1[i] = v[0][i] * cs - v[1][i] * sn; o2[i] = v[1][i] * cs + v[0][i] * sn; }
                    bf16_t* dst = QM + ((size_t)(b * 6 + head) * 2048 + t) * 96 + 64 + i16;
                    st_bf16x8(dst, o1); st_bf16x8(dst + 16, o2);
                }
            }
        }
    }
};
struct EpiUkv {
    static constexpr bool KHOOK = false;
    const float* ssq_dkv; const float* qkn; const bf16_t* KR; bf16_t* KM; bf16_t* VM;
    __device__ __forceinline__ void operator()(const f32x4 (&acc)[2][2][4][2], const GUnit& u, int wr, int wc, int fr, int fq) const {
        const int G = u.pn * 4 + wc;
        const float* g0 = qkn + 96 + 8 * fq;
        float rs8[8];
#pragma unroll
        for (int k = 0; k < 8; ++k) { const size_t rr = (size_t)(u.pm * 256 + (k >> 2) * 128 + wr * 64 + (k & 3) * 16 + fr); rs8[k] = ssq_dkv[rr * 2] + ssq_dkv[rr * 2 + 1]; }
#pragma unroll
        for (int k = 0; k < 8; ++k) rs8[k] = rsqrtf(rs8[k] * (1.f / 128.f) + 1e-6f);
#pragma unroll
        for (int ai = 0; ai < 2; ++ai) {
          u32x4 kr4[4];
          if (G < 6) {
#pragma unroll
              for (int m = 0; m < 4; ++m) kr4[m] = *(const u32x4*)(KR + (size_t)(u.pm * 256 + ai * 128 + wr * 64 + m * 16 + fr) * 32 + 8 * fq);
          }
#pragma unroll
            for (int m = 0; m < 4; ++m) {
                __builtin_amdgcn_sched_barrier(0);
                const int row = u.pm * 256 + ai * 128 + wr * 64 + m * 16 + fr; const int b = row >> 11, t = row & 2047;
                const float rs = rs8[ai * 4 + m];
                float v[2][8]; float ss = 0.f;
#pragma unroll
                for (int bj = 0; bj < 2; ++bj)
#pragma unroll
                    for (int n = 0; n < 2; ++n)
#pragma unroll
                        for (int j = 0; j < 4; ++j) { const float x = acc[ai][bj][m][n][j] * rs; v[bj][4 * n + j] = x; ss += x * x; }
                if (G < 6) {
                    ss = quad_sum(ss); const float sc = rsqrtf(ss * (1.f / 64.f) + 1e-6f);
#pragma unroll
                    for (int i = 0; i < 8; ++i) { v[0][i] *= sc * g0[i]; v[1][i] *= sc * g0[32 + i]; }
                    bf16_t* dst = KM + ((size_t)(b * 6 + G) * 2048 + t) * 96;
                    st_bf16x8(dst + 8 * fq, v[0]); st_bf16x8(dst + 32 + 8 * fq, v[1]);
                    *(u32x4*)(dst + 64 + 8 * fq) = kr4[m];
                } else {
                    bf16_t* dst = VM + ((size_t)(b * 6 + (G - 6)) * 2048 + t) * 64;
                    st_bf16x8(dst + 8 * fq, v[0]); st_bf16x8(dst + 32 + 8 * fq, v[1]);
                }
            }
        }
    }
};
#define MFMA16(a, b, c) __builtin_amdgcn_mfma_f32_16x16x32_bf16(a, b, c, 0, 0, 0)
#define MFMA32(a, b, c) __builtin_amdgcn_mfma_f32_32x32x16_bf16(a, b, c, 0, 0, 0)
#define LDS_FENCE() asm volatile("s_waitcnt lgkmcnt(0)" ::: "memory")

__device__ __forceinline__ void cmp_unit(int u, int l, InPtr in, unsigned char* ws, LAS unsigned char* lds, int g_wv) {
    int tid_ = TIDX; asm volatile("" : "+v"(tid_));
    const int tid = tid_, w = tid >> 6, lane = tid & 63, r = lane & 15, q = lane >> 4;
    const int b = u >> 2, s = (u >> 1) & 1, hk = u & 1;
    const bf16_t* A = (const bf16_t*)(ws + WS_PRJ + (s ? PRJ_C0V : PRJ_C0K)) + (size_t)(b * 2 + hk) * 2048 * 64;
    const bf16_t* W1 = (const bf16_t*)(ws + WS_WC1) + ((size_t)l * 2 + s) * 64 * 2048;
    const bf16_t* W2 = (const bf16_t*)(ws + WS_WC2) + ((size_t)l * 2 + s) * 64 * 64;
    const float* b1 = (const float*)(ws + WS_B1C) + (l * 2 + s) * 64;
    f32x4 acc[4];
#pragma unroll
    for (int nb = 0; nb < 4; ++nb) acc[nb] = (f32x4){0.f, 0.f, 0.f, 0.f};
    const bf16_t* ap = A + (size_t)(16 * w + r) * 1024 + 8 * q;
    constexpr int WP = 528, WBUF = 64 * WP; LAS unsigned char* wb = lds + 24576;
    u32x4 st[4];
#pragma unroll
    for (int i = 0; i < 4; ++i) { const int c = tid + 512 * i; st[i] = *(const u32x4*)(W1 + (size_t)(c >> 5) * 2048 + (c & 31) * 8); }
    bf16x8 af[8], afn[8];
#pragma unroll
    for (int ks = 0; ks < 8; ++ks) af[ks] = *(const bf16x8*)(ap + 32 * ks);
    const float* kg = in->p[9] + l * 64;
    float b1v[4], kgv[4]; bf16x8 w2f[2][4];
#pragma unroll
    for (int nb = 0; nb < 4; ++nb) { b1v[nb] = b1[16 * nb + r]; kgv[nb] = kg[16 * nb + r]; }
#pragma unroll
    for (int ks = 0; ks < 2; ++ks)
#pragma unroll
        for (int nb = 0; nb < 4; ++nb) w2f[ks][nb] = *(const bf16x8*)(W2 + (size_t)(16 * nb + r) * 64 + 32 * ks + 8 * q);
#pragma unroll
    for (int i = 0; i < 4; ++i) { const int c = tid + 512 * i; *(LAS u32x4*)(wb + (c >> 5) * WP + (c & 31) * 16) = st[i]; }
    __syncthreads();
    auto chunk = [&](const int kc, bf16x8 (&ac)[8], bf16x8 (&an)[8]) __attribute__((always_inline)) {
        const int cur = kc & 1;
        if (kc < 7) {
#pragma unroll
            for (int i = 0; i < 4; ++i) { const int c = tid + 512 * i; st[i] = *(const u32x4*)(W1 + (size_t)(c >> 5) * 2048 + (kc + 1) * 256 + (c & 31) * 8); }
#pragma unroll
            for (int ks = 0; ks < 8; ++ks) an[ks] = *(const bf16x8*)(ap + 256 * (kc + 1) + 32 * ks);
        }
#pragma unroll
        for (int ks = 0; ks < 8; ++ks)
#pragma unroll
            for (int nb = 0; nb < 4; ++nb) { const bf16x8 bb = *(const LAS bf16x8*)(wb + cur * WBUF + (16 * nb + r) * WP + (32 * ks + 8 * q) * 2); acc[nb] = MFMA16(ac[ks], bb, acc[nb]); }
        if (kc < 7) {
#pragma unroll
            for (int i = 0; i < 4; ++i) { const int c = tid + 512 * i; *(LAS u32x4*)(wb + (cur ^ 1) * WBUF + (c >> 5) * WP + (c & 31) * 16) = st[i]; }
        }
        __syncthreads();
    };
#pragma unroll 1
    for (int kc = 0; kc < 8; kc += 2) { chunk(kc, af, afn); chunk(kc + 1, afn, af); }
    LAS bf16_t* hl = (LAS bf16_t*)(lds + w * 2304);
#pragma unroll
    for (int nb = 0; nb < 4; ++nb) { const float bias = b1v[nb];
#pragma unroll
        for (int j = 0; j < 4; ++j) hl[(4 * q + j) * 72 + 16 * nb + r] = f2bf(siluf(acc[nb][j] + bias)); }
    LDS_FENCE();
    f32x4 o[4];
#pragma unroll
    for (int nb = 0; nb < 4; ++nb) o[nb] = (f32x4){0.f, 0.f, 0.f, 0.f};
#pragma unroll
    for (int ks = 0; ks < 2; ++ks) {
        const bf16x8 a = *(const LAS bf16x8*)(hl + r * 72 + 32 * ks + 8 * q);
#pragma unroll
        for (int nb = 0; nb < 4; ++nb) o[nb] = MFMA16(a, w2f[ks][nb], o[nb]);
    }
    LDS_FENCE();
    bf16_t* dst = (bf16_t*)(ws + WS_CMP + (s ? CMP_V : 0)) + (size_t)(b * 2 + hk) * 128 * 64;
#pragma unroll
    for (int j = 0; j < 4; ++j) {
        const int n = 16 * w + 4 * q + j; float ss = 0.f;
#pragma unroll
        for (int nb = 0; nb < 4; ++nb) ss += o[nb][j] * o[nb][j];
        ss += shx<1>(ss); ss += shx<2>(ss); ss += shx<4>(ss); ss += shx<8>(ss);
        const float sc = s == 0 ? rsqrtf(ss * (1.f / 64.f) + 1e-6f) : 1.f;
#pragma unroll
        for (int nb = 0; nb < 4; ++nb) { const int d = 16 * nb + r; const float v = o[nb][j] * sc * (s == 0 ? kgv[nb] : 1.f); dst[(size_t)n * 64 + d] = n < 127 ? f2bf(v) : (bf16_t)0; }
    }
}

__device__ __forceinline__ int swz_off(int row, int chunk) { return row * 128 + ((chunk ^ (row & 7)) << 4); }
__device__ __forceinline__ float log_sigmoid(float x) { return fminf(x, 0.f) - log1pf(__expf(-fabsf(x))); }
__device__ __forceinline__ void ml_delta_wave(int cu, int l, InPtr in, unsigned char* ws, LAS unsigned char* wl, int lane) {
    asm volatile("" : "+v"(lane));
    const int c = cu & 31, bh = cu >> 5, h = bh & 3, b = bh >> 2; const int t0 = c * 64; const size_t row0 = (size_t)b * 2048 + t0;
    const int cc = lane & 7, tg = lane >> 3;
    const bf16_t* raw = (const bf16_t*)(ws + WS_PRJ + PRJ_RAWQK); const float* cw = in->p[11] + (size_t)l * 4 * 512 + h * 64 + 8 * cc;
    u32x4 rq[11];
    const bool head0 = (c == 0 && tg == 0);
#pragma unroll
    for (int i = 0; i < 11; ++i) { const size_t rr = (head0 && i < 3) ? row0 : row0 + 8 * tg - 3 + i; rq[i] = *(const u32x4*)(raw + rr * 512 + h * 64 + 8 * cc); }
    __builtin_amdgcn_sched_barrier(0);
    const float* G = (const float*)(ws + WS_PRJ + PRJ_GATES);
    const float ip = G[(row0 + lane) * 32 + 18 + h] + in->p[12][l * 4 + h], fp = G[(row0 + lane) * 32 + 22 + h] + in->p[13][l * 4 + h];
    float bcum = log_sigmoid(fp);
#pragma unroll
    for (int o = 1; o < 64; o <<= 1) { const float t = __builtin_bit_cast(float, __builtin_amdgcn_ds_bpermute(((lane - o) & 63) << 2, __builtin_bit_cast(int, bcum))); if (lane >= o) bcum += t; }
    const float bL = __builtin_bit_cast(float, __builtin_amdgcn_readlane(__builtin_bit_cast(int, bcum), 63)); const float wgt = __expf(bL - bcum + ip);
    { float* mlg = (float*)(ws + WS_ML + ML_G) + ((size_t)bh * 2048 + t0 + lane) * 2; mlg[0] = bcum; mlg[1] = ip; if (lane == 0) ((float*)(ws + WS_ML + ML_BL))[cu] = bL; }
    float wt[8];
#pragma unroll
    for (int j = 0; j < 8; ++j) wt[j] = __builtin_bit_cast(float, __builtin_amdgcn_ds_bpermute((8 * tg + j) << 2, __builtin_bit_cast(int, wgt)));
    if (head0) {
#pragma unroll
        for (int i = 0; i < 3; ++i) rq[i] = (u32x4){0u, 0u, 0u, 0u}; }
#define MLD_E(v, e) (((e) & 1) ? bf_hi(((e) >> 1) == 0 ? (v).x : ((e) >> 1) == 1 ? (v).y : ((e) >> 1) == 2 ? (v).z : (v).w) : bf_lo(((e) >> 1) == 0 ? (v).x : ((e) >> 1) == 1 ? (v).y : ((e) >> 1) == 2 ? (v).z : (v).w))
    bf16_t* QC = (bf16_t*)(ws + WS_ML) + ((size_t)bh * 2048 + t0 + 8 * tg) * 64 + 8 * cc; bf16_t* KC = (bf16_t*)(ws + WS_ML + ML_KC) + ((size_t)bh * 2048 + t0 + 8 * tg) * 64 + 8 * cc;
    u32x4 rk[11], vv[8];
#pragma unroll
    for (int i = 0; i < 11; ++i) { const size_t rr = (head0 && i < 3) ? row0 : row0 + 8 * tg - 3 + i; rk[i] = *(const u32x4*)(raw + rr * 512 + h * 64 + 8 * cc + 256); }
    { const bf16_t* V = (const bf16_t*)(ws + WS_PRJ + PRJ_VML) + ((size_t)bh * 2048 + t0 + 8 * tg) * 64 + 8 * cc;
#pragma unroll
      for (int j = 0; j < 8; ++j) vv[j] = *(const u32x4*)(V + (size_t)j * 64); }
    if (head0) {
#pragma unroll
        for (int i = 0; i < 3; ++i) rk[i] = (u32x4){0u, 0u, 0u, 0u}; }
    __builtin_amdgcn_sched_barrier(0);
    {
        float w4[4][8];
#pragma unroll
        for (int tp = 0; tp < 4; ++tp) { const f32x4 a = *(const f32x4*)(cw + tp * 512), b4 = *(const f32x4*)(cw + tp * 512 + 4); w4[tp][0] = a.x; w4[tp][1] = a.y; w4[tp][2] = a.z; w4[tp][3] = a.w; w4[tp][4] = b4.x; w4[tp][5] = b4.y; w4[tp][6] = b4.z; w4[tp][7] = b4.w; }
#pragma unroll
        for (int j = 0; j < 8; ++j) { float o[8];
#pragma unroll
            for (int e = 0; e < 8; ++e) o[e] = siluf(w4[0][e] * MLD_E(rq[j], e) + w4[1][e] * MLD_E(rq[j + 1], e) + w4[2][e] * MLD_E(rq[j + 2], e) + w4[3][e] * MLD_E(rq[j + 3], e));
            u32x4 pk; pk.x = pk_bf16(o[0], o[1]); pk.y = pk_bf16(o[2], o[3]); pk.z = pk_bf16(o[4], o[5]); pk.w = pk_bf16(o[6], o[7]);
            *(u32x4*)(QC + (size_t)j * 64) = pk; }
    }
    float dn[8];
    {
        float w4[4][8];
#pragma unroll
        for (int tp = 0; tp < 4; ++tp) { const f32x4 a = *(const f32x4*)(cw + 256 + tp * 512), b4 = *(const f32x4*)(cw + 256 + tp * 512 + 4); w4[tp][0] = a.x; w4[tp][1] = a.y; w4[tp][2] = a.z; w4[tp][3] = a.w; w4[tp][4] = b4.x; w4[tp][5] = b4.y; w4[tp][6] = b4.z; w4[tp][7] = b4.w; }
#pragma unroll
        for (int e = 0; e < 8; ++e) dn[e] = 0.f;
#pragma unroll
        for (int j2 = 0; j2 < 4; ++j2) { float kb[2][8];
#pragma unroll
            for (int jj = 0; jj < 2; ++jj) { const int j = 2 * j2 + jj; float o[8];
#pragma unroll
                for (int e = 0; e < 8; ++e) o[e] = siluf(w4[0][e] * MLD_E(rk[j], e) + w4[1][e] * MLD_E(rk[j + 1], e) + w4[2][e] * MLD_E(rk[j + 2], e) + w4[3][e] * MLD_E(rk[j + 3], e)) * 0.125f;
                u32x4 pk; pk.x = pk_bf16(o[0], o[1]); pk.y = pk_bf16(o[2], o[3]); pk.z = pk_bf16(o[4], o[5]); pk.w = pk_bf16(o[6], o[7]);
                *(u32x4*)(KC + (size_t)j * 64) = pk;
#pragma unroll
                for (int e = 0; e < 8; ++e) { kb[jj][e] = MLD_E(pk, e); dn[e] += wt[j] * kb[jj][e]; } }
#pragma unroll
            for (int e = 0; e < 8; ++e) { *(LAS unsigned*)(wl + swz_off(8 * cc + e, tg) + 4 * j2) = pk_bf16(kb[0][e], kb[1][e]);
                *(LAS unsigned*)(wl + 8192 + swz_off(8 * cc + e, tg) + 4 * j2) = pk_bf16(wt[2 * j2] * MLD_E(vv[2 * j2], e), wt[2 * j2 + 1] * MLD_E(vv[2 * j2 + 1], e)); } }
    }
#undef MLD_E
#pragma unroll
    for (int e = 0; e < 8; ++e) { dn[e] += shx<8>(dn[e]); dn[e] += shx<16>(dn[e]); dn[e] += __shfl_xor(dn[e], 32); }
    if (tg == 0) { float* DN = (float*)(ws + WS_ML + ML_DN) + (size_t)cu * 64 + 8 * cc; *(f32x4*)DN = (f32x4){dn[0], dn[1], dn[2], dn[3]}; *(f32x4*)(DN + 4) = (f32x4){dn[4], dn[5], dn[6], dn[7]}; }
    LDS_FENCE();
    const int r = lane & 15, q = lane >> 4;
    bf16_t* DL = (bf16_t*)(ws + WS_ML + ML_DELTA) + (size_t)cu * 4096;
    f32x4 acc[4][4];
#pragma unroll
    for (int mb = 0; mb < 4; ++mb) {
#pragma unroll
        for (int nb = 0; nb < 4; ++nb) acc[mb][nb] = (f32x4){0.f, 0.f, 0.f, 0.f};
#pragma unroll
        for (int ks = 0; ks < 2; ++ks) {
            const bf16x8 a = *(const LAS bf16x8*)(wl + 8192 + swz_off(16 * mb + r, 4 * ks + q));
#pragma unroll
            for (int nb = 0; nb < 4; ++nb) { const bf16x8 bb = *(const LAS bf16x8*)(wl + swz_off(16 * nb + r, 4 * ks + q)); acc[mb][nb] = MFMA16(a, bb, acc[mb][nb]); }
        }
    }
    LDS_FENCE();
#pragma unroll
    for (int mb = 0; mb < 4; ++mb)
#pragma unroll
        for (int nb = 0; nb < 4; ++nb)
#pragma unroll
            for (int j = 0; j < 4; ++j) { const int row = 16 * mb + 4 * q + j, col = 16 * nb + r; *(LAS bf16_t*)(wl + swz_off(row, col >> 3) + (col & 7) * 2) = f2bf(acc[mb][nb][j]); }
    LDS_FENCE();
#pragma unroll
    for (int i = 0; i < 8; ++i) { const int ch = lane + 64 * i; *(u32x4*)(DL + (size_t)ch * 8) = *(const LAS u32x4*)(wl + swz_off(ch >> 3, ch & 7)); }
    LDS_FENCE();
}

#ifndef TIME_PH
#define TIME_PH -1
#endif
#define PSTAMP(i, blk) do { if (TIME_PH != -1 && l == 0 && blockIdx.x == (blk) && TIDX == 0) ((unsigned long long*)((unsigned*)(ws + WS_CTL) + CW_TS))[i] = __builtin_amdgcn_s_memrealtime(); } while (0)
#ifndef DUP_DELTA
#define DUP_DELTA 1
#endif
__device__ __forceinline__ void phase_prep(int l, InPtr in, unsigned char* ws, LAS unsigned char* lds, int bid, int nb, int g_wv, unsigned* dq) {
    asm volatile("" : "+s"(bid));
    PSTAMP(40, 0);
#ifndef NO_UQ
    { g8::DenseSched S{(const char*)(ws + WS_PRJ + PRJ_DQKV), (const char*)(ws + WS_WUQ) + (size_t)l * 768 * 256 * 2, 384, 256, 64, 3, nb, bid};
      EpiUq E{(const float*)(ws + WS_SSQ + PT_DQ) + (size_t)l * 16384 * 4, in->p[19] + l * 192, (const float*)(ws + WS_ROPE), (bf16_t*)(ws + WS_MLA)};
      g8::gemm_run(lds, 256, 256, S, E, g_wv); }
#endif
    PSTAMP(41, 0);
#ifndef NO_UKV
    asm volatile("" : "+s"(bid));
    { g8::DenseSched S{(const char*)(ws + WS_PRJ + PRJ_DQKV) + 256, (const char*)(ws + WS_WUKV) + (size_t)l * 768 * 256 * 2, 384, 256, 64, 3, nb, nb == 256 ? ((bid + 64) & 255) : bid};
      EpiUkv E{(const float*)(ws + WS_SSQ + PT_DKV) + (size_t)l * 16384 * 2, in->p[19] + l * 192, (const bf16_t*)(ws + WS_PRJ + PRJ_KR), (bf16_t*)(ws + WS_MLA + MLA_KM), (bf16_t*)(ws + WS_MLA + MLA_VM)};
      g8::gemm_run(lds, 256, 256, S, E, g_wv); }
#endif
    PSTAMP(42, 0); PSTAMP(44, 255);
    __syncthreads();
#ifndef NO_CMP
#ifndef DUP_CMP
#define DUP_CMP 1
#endif
    for (int u = (nb == 256 ? (bid >= 128 && bid < 160 ? bid - 128 : 32) : nb - 1 - bid); u < 32; u += nb) for (int rp_ = 0; rp_ < DUP_CMP; ++rp_) { if (rp_) __syncthreads(); cmp_unit(u, l, in, ws, lds, g_wv); }
#endif
    PSTAMP(45, 255);
    __syncthreads();
#ifndef NO_DELTA
    { int tid_ = TIDX; asm volatile("" : "+v"(tid_)); LAS int* slot = (LAS int*)(lds + LDS_MISC + 64);
      for (;;) {
          __syncthreads();
          if (tid_ == 0) *slot = (int)__hip_atomic_fetch_add(dq, 1u, __ATOMIC_RELAXED, __HIP_MEMORY_SCOPE_AGENT);
          __syncthreads();
          const int g = *slot; if (g >= 96 + 128) break;
          const int wv = tid_ >> 6;
          const int cu_ = g < 96 ? g * 8 + wv : 768 + (g - 96) * 2 + wv;
          if (g < 96 || wv < 2) { for (int rp_ = 0; rp_ < DUP_DELTA; ++rp_) ml_delta_wave(cu_, l, in, ws, lds + wv * 16384, tid_ & 63); }
      } }
#endif
    __syncthreads(); PSTAMP(43, 0);
}
#define CHK_TOL(st) (((st) & 15) == 8 ? 1e-2f : 1e-3f)
#define CHECK_REST
constexpr int VTP = 192;
typedef short v4i16_t __attribute__((ext_vector_type(4)));
__device__ __forceinline__ int vt_lane_off(int lane) { return (4 * (lane >> 5) + ((lane & 15) >> 2)) * VTP + ((((lane >> 4) & 1) * 16) + 4 * (lane & 3)) * 2; }
__device__ __forceinline__ bf16x8 vt_frag(const LAS unsigned char* Vt, int voff, int s4, int eb) {
    const LAS unsigned char* a = Vt + voff + 16 * s4 * VTP + 64 * eb;
    const v4i16_t lo = __builtin_amdgcn_ds_read_tr16_b64_v4i16((LAS v4i16_t*)a), hi = __builtin_amdgcn_ds_read_tr16_b64_v4i16((LAS v4i16_t*)(a + 8 * VTP));
    return (bf16x8){lo[0], lo[1], lo[2], lo[3], hi[0], hi[1], hi[2], hi[3]};
}
__device__ __forceinline__ int crow(int reg, int h) { return (reg & 3) + 8 * (reg >> 2) + 4 * h; }
struct AttnState { f32x16 o[2]; float m, l; };
__device__ __forceinline__ void attn_reset(AttnState& A) { A.m = -1e30f; A.l = 0.f;
#pragma unroll
    for (int i = 0; i < 16; ++i) { A.o[0][i] = 0.f; A.o[1][i] = 0.f; } }

template <int DK>
__device__ __forceinline__ void attn_scores(f32x16 (&s)[2], const bf16x8 (&qf)[DK / 16], const LAS unsigned char* Kt, int r, int h) {
    constexpr int KP = 2 * DK + 16, NK = DK / 16;
    bf16x8 kf[2][NK];
#pragma unroll
    for (int kb = 0; kb < 2; ++kb)
#pragma unroll
        for (int ks = 0; ks < NK; ++ks) kf[kb][ks] = *(const LAS bf16x8*)(Kt + (32 * kb + r) * KP + (16 * ks + 8 * h) * 2);
    __builtin_amdgcn_sched_barrier(0);
#pragma unroll
    for (int kb = 0; kb < 2; ++kb)
#pragma unroll
        for (int i = 0; i < 16; ++i) s[kb][i] = 0.f;
#pragma unroll
    for (int ks = 0; ks < NK; ++ks) {
        s[0] = MFMA32(kf[0][ks], qf[ks], s[0]);
        s[1] = MFMA32(kf[1][ks], qf[ks], s[1]);
    }
}
__device__ __forceinline__ float max3f(float a, float b, float c) { return fmaxf(fmaxf(a, b), c); }
__device__ __forceinline__ void attn_softmax_pv(AttnState& A, f32x16 (&s)[2], const LAS unsigned char* Vt, int r, int h, float bias_c = 0.f, bool lane_ok = true) {
    constexpr float THR = 8.f; const int voff = vt_lane_off(r + 32 * h);
    float mx = max3f(s[0][0], s[0][1], s[0][2]);
#pragma unroll
    for (int i = 3; i < 15; i += 2) mx = max3f(mx, s[0][i], s[0][i + 1]);
    mx = max3f(mx, s[0][15], s[1][0]);
#pragma unroll
    for (int i = 1; i < 15; i += 2) mx = max3f(mx, s[1][i], s[1][i + 1]);
    mx = fmaxf(mx, s[1][15]);
    mx = fmaxf(mx, __shfl_xor(mx, 32));
    const float mxb = (lane_ok && mx > -1e29f) ? mx + bias_c : -1e30f;
    const bool grow = mxb > A.m + THR;
    const float mnew = grow ? mxb : A.m;
    if (__any(grow)) {
        const float alpha = __builtin_amdgcn_exp2f(A.m - mnew);
        A.l *= alpha;
#pragma unroll
        for (int i = 0; i < 16; ++i) { A.o[0][i] *= alpha; A.o[1][i] *= alpha; }
    }
    A.m = mnew;
    const float sub = (lane_ok && mnew > -1e29f) ? mnew - bias_c : 1e30f;
    float rs = 0.f;
#pragma unroll
    for (int kb = 0; kb < 2; ++kb)
#pragma unroll
        for (int i = 0; i < 16; ++i) { const float p = __builtin_amdgcn_exp2f(s[kb][i] - sub); s[kb][i] = p; rs += p; }
    rs += __shfl_xor(rs, 32);
    A.l += rs;
    bf16x8 vf[4][2];
#pragma unroll
    for (int s4 = 0; s4 < 4; ++s4)
#pragma unroll
        for (int eb = 0; eb < 2; ++eb) vf[s4][eb] = vt_frag(Vt, voff, s4, eb);
    __builtin_amdgcn_sched_barrier(0);
#pragma unroll
    for (int s4 = 0; s4 < 4; ++s4) {
        const int kb = s4 >> 1, hf = (s4 & 1) * 8;
        u32x4 pw; pw.x = pk_bf16(s[kb][hf + 0], s[kb][hf + 1]); pw.y = pk_bf16(s[kb][hf + 2], s[kb][hf + 3]); pw.z = pk_bf16(s[kb][hf + 4], s[kb][hf + 5]); pw.w = pk_bf16(s[kb][hf + 6], s[kb][hf + 7]);
        const bf16x8 pf = __builtin_bit_cast(bf16x8, pw);
#pragma unroll
        for (int eb = 0; eb < 2; ++eb) A.o[eb] = MFMA32(vf[s4][eb], pf, A.o[eb]);
    }
}
template <int DK>
__device__ __forceinline__ void attn_scores_half(f32x16& s, const bf16x8 (&qf)[DK / 16], const LAS unsigned char* Kt, int r, int h, int kb) {
    constexpr int KP = 2 * DK + 16, NK = DK / 16;
    bf16x8 kf[NK];
#pragma unroll
    for (int ks = 0; ks < NK; ++ks) kf[ks] = *(const LAS bf16x8*)(Kt + (32 * kb + r) * KP + (16 * ks + 8 * h) * 2);
    __builtin_amdgcn_sched_barrier(0);
#pragma unroll
    for (int i = 0; i < 16; ++i) s[i] = 0.f;
#pragma unroll
    for (int ks = 0; ks < NK; ++ks) s = MFMA32(kf[ks], qf[ks], s);
}
__device__ __forceinline__ void attn_softmax_pv_half(AttnState& A, f32x16& s, const LAS unsigned char* Vt, int r, int h, int kb, float bias_c = 0.f, bool lane_ok = true) {
    constexpr float THR = 8.f; const int voff = vt_lane_off(r + 32 * h);
    float mx = max3f(s[0], s[1], s[2]);
#pragma unroll
    for (int i = 3; i < 15; i += 2) mx = max3f(mx, s[i], s[i + 1]);
    mx = fmaxf(mx, s[15]);
    mx = fmaxf(mx, __shfl_xor(mx, 32));
    const float mxb = (lane_ok && mx > -1e29f) ? mx + bias_c : -1e30f;
    const bool grow = mxb > A.m + THR;
    const float mnew = grow ? mxb : A.m;
    if (__any(grow)) {
        const float alpha = __builtin_amdgcn_exp2f(A.m - mnew);
        A.l *= alpha;
#pragma unroll
        for (int i = 0; i < 16; ++i) { A.o[0][i] *= alpha; A.o[1][i] *= alpha; }
    }
    A.m = mnew;
    const float sub = (lane_ok && mnew > -1e29f) ? mnew - bias_c : 1e30f;
    float rs = 0.f;
#pragma unroll
    for (int i = 0; i < 16; ++i) { const float p = __builtin_amdgcn_exp2f(s[i] - sub); s[i] = p; rs += p; }
    rs += __shfl_xor(rs, 32);
    A.l += rs;
    bf16x8 vf[2][2];
#pragma unroll
    for (int s2 = 0; s2 < 2; ++s2)
#pragma unroll
        for (int eb = 0; eb < 2; ++eb) vf[s2][eb] = vt_frag(Vt, voff, 2 * kb + s2, eb);
    __builtin_amdgcn_sched_barrier(0);
#pragma unroll
    for (int s2 = 0; s2 < 2; ++s2) {
        const int hf = s2 * 8;
        u32x4 pw; pw.x = pk_bf16(s[hf + 0], s[hf + 1]); pw.y = pk_bf16(s[hf + 2], s[hf + 3]); pw.z = pk_bf16(s[hf + 4], s[hf + 5]); pw.w = pk_bf16(s[hf + 6], s[hf + 7]);
        const bf16x8 pf = __builtin_bit_cast(bf16x8, pw);
#pragma unroll
        for (int eb = 0; eb < 2; ++eb) A.o[eb] = MFMA32(vf[s2][eb], pf, A.o[eb]);
    }
}
template <int DK>
__device__ __forceinline__ void stage_k_load(u32x4 (&kr)[2], const bf16_t* Kg  , int tid) {
    constexpr int CH = DK / 8;
    kr[0] = *(const u32x4*)(Kg + (size_t)(tid / CH) * DK + (tid % CH) * 8);
    if (64 * CH > 512) { const int c2 = tid + 512; if (c2 < 64 * CH) kr[1] = *(const u32x4*)(Kg + (size_t)(c2 / CH) * DK + (c2 % CH) * 8); }
}
template <int DK>
__device__ __forceinline__ void stage_k_store(const u32x4 (&kr)[2], LAS unsigned char* Kt, int tid) {
    constexpr int CH = DK / 8, KP = 2 * DK + 16;
    *(LAS u32x4*)(Kt + (tid / CH) * KP + (tid % CH) * 16) = kr[0];
    if (64 * CH > 512) { const int c2 = tid + 512; if (c2 < 64 * CH) *(LAS u32x4*)(Kt + (c2 / CH) * KP + (c2 % CH) * 16) = kr[1]; }
}
__device__ __forceinline__ u32x4 stage_v_load(const bf16_t* Vg, int tid) { return *(const u32x4*)(Vg + (size_t)(tid >> 3) * 64 + (tid & 7) * 8); }
__device__ __forceinline__ void stage_v_store(const u32x4& v, LAS unsigned char* Vt, int tid) { *(LAS u32x4*)(Vt + (tid >> 3) * VTP + (tid & 7) * 16) = v; }

constexpr int MLA_KT = 0, MLA_VT = 2 * 64 * 208, MLA_LDS = MLA_VT + 2 * 64 * VTP;
__device__ __forceinline__ void mla_unit(int b, int hd, int qt, int l, unsigned char* ws, LAS unsigned char* lds, int g_wv) {
    int tid_ = TIDX; asm volatile("" : "+v"(tid_));
    const int tid = tid_, w = tid >> 6, lane = tid & 63, r = lane & 31, h = lane >> 5;
    const size_t slab = (size_t)(b * 6 + hd) * 2048;
    const bf16_t* QM = (const bf16_t*)(ws + WS_MLA) + slab * 96; const bf16_t* KM = (const bf16_t*)(ws + WS_MLA + MLA_KM) + slab * 96; const bf16_t* VM = (const bf16_t*)(ws + WS_MLA + MLA_VM) + slab * 64;
    const int q0 = 256 * qt + 32 * w, q = q0 + r;
    bf16x8 qf[6];
#pragma unroll
    for (int ks = 0; ks < 6; ++ks) qf[ks] = *(const bf16x8*)(QM + (size_t)q * 96 + 16 * ks + 8 * h);
    AttnState A; attn_reset(A);
    const int ntile = 4 * qt + 4;
    u32x4 kr[2], vr, kr2[2], vr2;
    stage_k_load<96>(kr, KM, tid); vr = stage_v_load(VM, tid);
    stage_k_store<96>(kr, lds + MLA_KT, tid); stage_v_store(vr, lds + MLA_VT, tid);
    if (ntile > 1) { stage_k_load<96>(kr, KM + (size_t)64 * 96, tid); vr = stage_v_load(VM + (size_t)64 * 64, tid); }
    __syncthreads();
    auto tile_step = [&](const int j, u32x4 (&kc)[2], u32x4& vc, u32x4 (&kn)[2], u32x4& vn) __attribute__((always_inline)) {
        const int cur = j & 1;
        if (j + 2 < ntile) { stage_k_load<96>(kn, KM + (size_t)(j + 2) * 64 * 96, tid); vn = stage_v_load(VM + (size_t)(j + 2) * 64 * 64, tid); }
        if (64 * j <= q0 + 31) {
            f32x16 s[2];
            attn_scores<96>(s, qf, lds + MLA_KT + cur * 64 * 208, r, h);
            if (64 * j + 63 > q0) {
#pragma unroll
                for (int kb = 0; kb < 2; ++kb)
#pragma unroll
                    for (int i = 0; i < 16; ++i) { const int key = 64 * j + 32 * kb + crow(i, h); if (key > q) s[kb][i] = -1e30f; }
            }
            attn_softmax_pv(A, s, lds + MLA_VT + cur * 64 * VTP, r, h);
        }
        if (j + 1 < ntile) { stage_k_store<96>(kc, lds + MLA_KT + (cur ^ 1) * 64 * 208, tid); stage_v_store(vc, lds + MLA_VT + (cur ^ 1) * 64 * VTP, tid); }
        __syncthreads();
    };
#pragma unroll 1
    for (int j = 0; j < ntile; j += 2) { tile_step(j, kr, vr, kr2, vr2); tile_step(j + 1, kr2, vr2, kr, vr); }
    const float inv = A.l > 0.f ? 1.f / A.l : 0.f; float ss = 0.f;
    bf16_t* Y = (bf16_t*)(ws + WS_Y) + ((size_t)b * 2048 + q) * 1024 + 384 + hd * 64;
#pragma unroll
    for (int eb = 0; eb < 2; ++eb)
#pragma unroll
        for (int g4 = 0; g4 < 4; ++g4) {
            const float v0 = A.o[eb][4 * g4] * inv, v1 = A.o[eb][4 * g4 + 1] * inv, v2 = A.o[eb][4 * g4 + 2] * inv, v3 = A.o[eb][4 * g4 + 3] * inv;
            u32x2 pw; pw.x = pk_bf16(v0, v1); pw.y = pk_bf16(v2, v3);
            const float f0 = bf_lo(pw.x), f1 = bf_hi(pw.x), f2 = bf_lo(pw.y), f3 = bf_hi(pw.y); ss += (f0 * f0 + f1 * f1) + (f2 * f2 + f3 * f3);
            *(u32x2*)(Y + 32 * eb + 8 * g4 + 4 * h) = pw;
        }
    ss += __shfl_xor(ss, 32);
    if (h == 0) ((float*)(ws + WS_SSQ + PT_C))[((size_t)l * 16384 + (size_t)b * 2048 + q) * 8 + hd] = ss;
}

__device__ __forceinline__ void nsa_bias32(float (&bv)[2][16], const LAS float* bl, int dd) {
#pragma unroll
    for (int kb = 0; kb < 2; ++kb)
#pragma unroll
        for (int k = 0; k < 16; ++k) { const int c = 63 - (32 * kb + (k & 3) + 8 * (k >> 2)); int d = dd + c; d = d < 0 ? 0 : (d > 255 ? 255 : d); bv[kb][k] = bl[d]; }
}
__device__ __forceinline__ void nsa_mask_bias(f32x16 (&sc)[2], int dq, int h, const LAS float* bl) {
    int dd = dq - 4 * h - 63; asm volatile("" : "+v"(dd));
    const LAS float* p = bl + dd;
    float bv[2][16];
#pragma unroll
    for (int kb = 0; kb < 2; ++kb)
#pragma unroll
        for (int k = 0; k < 16; ++k) bv[kb][k] = p[63 - (32 * kb + (k & 3) + 8 * (k >> 2))];
#pragma unroll
    for (int kb = 0; kb < 2; ++kb)
#pragma unroll
        for (int k = 0; k < 16; ++k) sc[kb][k] += bv[kb][k];
}
__device__ __forceinline__ void nsa_mask_bias_half(f32x16& sc, int dq, int h, const LAS float* bl, int kb) {
    int dd = dq - 4 * h - 32 * kb - 31; asm volatile("" : "+v"(dd));
    const LAS float* p = bl + dd;
    float bv[16];
#pragma unroll
    for (int k = 0; k < 16; ++k) bv[k] = p[31 - ((k & 3) + 8 * (k >> 2))];
#pragma unroll
    for (int k = 0; k < 16; ++k) sc[k] += bv[k];
}
__device__ __forceinline__ void attn_park(const AttnState& A, LAS float* xl) {
    xl[0] = A.m; xl[64] = A.l;
#pragma unroll
    for (int k = 0; k < 16; ++k) { xl[64 * (2 + k)] = A.o[0][k]; xl[64 * (18 + k)] = A.o[1][k]; }
}
__device__ __forceinline__ void attn_merge(AttnState& A, const LAS float* xl) {
    const float m2 = xl[0], l2 = xl[64]; const float m = fmaxf(A.m, m2);
    const float a1 = A.m > -1e29f ? __builtin_amdgcn_exp2f(A.m - m) : 0.f, a2 = m2 > -1e29f ? __builtin_amdgcn_exp2f(m2 - m) : 0.f;
    A.l = A.l * a1 + l2 * a2; A.m = m;
#pragma unroll
    for (int k = 0; k < 16; ++k) { A.o[0][k] = A.o[0][k] * a1 + xl[64 * (2 + k)] * a2; A.o[1][k] = A.o[1][k] * a1 + xl[64 * (18 + k)] * a2; }
}
constexpr int NSA_KT = 0, NSA_VT = 2 * 64 * 144, NSA_BIAS = NSA_VT + 2 * 64 * VTP, NSA_PS = NSA_BIAS + 3 * 640 * 4, NSA_SEL = NSA_PS + 3 * 64 * 32 * 4, NSA_UNI = NSA_SEL + 256, NSA_OT = NSA_UNI + 256, NSA_LDS = NSA_OT + 6 * 8192;
__device__ __forceinline__ void nsa_unit(int b, int hk, int i, int l, InPtr in, unsigned char* ws, LAS unsigned char* lds, int g_wv) {
    int tid_ = TIDX; asm volatile("" : "+v"(tid_));
    const int tid = tid_, w = tid >> 6, lane = tid & 63, r = lane & 31, h = lane >> 5;
    const bool active = w < 6; const int g = active ? (w >> 1) : 2, th = w & 1, head = hk * 3 + g;
    const int kh = w < 4 ? -1 : (w < 6 ? 0 : 1);
    LAS float* xl = (LAS float*)(lds + NSA_LDS) + th * (34 * 64) + lane;
    const int t = 64 * i + 32 * th + r, tl = 32 * th + r; const size_t row = (size_t)b * 2048 + t;
    const size_t kvslab = (size_t)(b * 2 + hk) * 2048 * 64;
    LAS float* biasl = (LAS float*)(lds + NSA_BIAS); LAS float* PS = (LAS float*)(lds + NSA_PS); LAS unsigned* SEL = (LAS unsigned*)(lds + NSA_SEL); LAS unsigned* UNI = (LAS unsigned*)(lds + NSA_UNI);
    { const float* bd = (const float*)(ws + WS_BIASD) + (size_t)hk * 3 * 2048;
#pragma unroll
      for (int k = 0; k < 4; ++k) { const int e = tid + 512 * k; if (e < 1920) { const int gg = e / 640, d = e - gg * 640 - 63; biasl[e] = (d < 0 || d >= 512) ? -1e30f : bd[gg * 2048 + d]; } }
#pragma unroll
      for (int k = 0; k < 12; ++k) if (i >= 16) PS[tid + 512 * k] = 0.f;
      if (tid < 4) UNI[tid] = 0u; }
    bf16x8 qf[4];
    { const bf16_t* QN = (const bf16_t*)(ws + WS_PRJ + PRJ_QN) + ((size_t)(b * 6 + head) * 2048 + t) * 64;
#pragma unroll
      for (int ks = 0; ks < 4; ++ks) qf[ks] = *(const bf16x8*)(QN + 16 * ks + 8 * h); }
#define NSA_GATE(k) ({ int t_ = t; asm volatile("" : "+v"(t_)); sigmf(((const float*)(ws + WS_PRJ + PRJ_GATES))[((size_t)b * 2048 + t_) * 32 + head * 3 + (k)]); })
    LAS float* bl = biasl + g * 640 + 63;
    LAS float* otl = (LAS float*)(lds + NSA_OT + (active ? w : 0) * 8192) + lane;
    u32x4 kr[2], vr;
    const int ntc = i >= 16 ? 2 : 1;
    { const bf16_t* KC = (const bf16_t*)(ws + WS_CMP) + (size_t)(b * 2 + hk) * 128 * 64; const bf16_t* VC = (const bf16_t*)(ws + WS_CMP + CMP_V) + (size_t)(b * 2 + hk) * 128 * 64;
      for (int T = 0; T < ntc; ++T) { stage_k_load<64>(kr, KC + T * 4096, tid); vr = stage_v_load(VC + T * 4096, tid); stage_k_store<64>(kr, lds + NSA_KT + T * 64 * 144, tid); stage_v_store(vr, lds + NSA_VT + T * 64 * VTP, tid); } }
    __syncthreads();
    {
        f32x16 ot[2];
        if (active && i < 16) {
            AttnState A; attn_reset(A); f32x16 sc[2]; attn_scores<64>(sc, qf, lds + NSA_KT, r, h);
            float bvc[2][16];
#pragma unroll
            for (int kb = 0; kb < 2; ++kb)
#pragma unroll
                for (int k = 0; k < 16; ++k) { int d = t - 16 * (32 * kb + crow(k, h)) - 31; d = d < 0 ? 0 : (d > 255 ? 255 : d); bvc[kb][k] = bl[d]; }
#pragma unroll
            for (int kb = 0; kb < 2; ++kb)
#pragma unroll
                for (int k = 0; k < 16; ++k) { const int d = t - 16 * (32 * kb + crow(k, h)) - 31; sc[kb][k] = d >= 0 ? sc[kb][k] + bvc[kb][k] : -1e30f; }
            attn_softmax_pv(A, sc, lds + NSA_VT, r, h);
            const float gc = NSA_GATE(0); const float inv = A.l > 0.f ? gc / A.l : 0.f;
#pragma unroll
            for (int k = 0; k < 16; ++k) { otl[64 * k] = A.o[0][k] * inv; otl[64 * (16 + k)] = A.o[1][k] * inv; }
        } else if (active) {
            float m = -1e30f, lsum = 0.f;
            for (int T = 0; T < ntc; ++T) {
                f32x16 sc[2]; attn_scores<64>(sc, qf, lds + NSA_KT + T * 64 * 144, r, h);
                float bvc[2][16];
#pragma unroll
                for (int kb = 0; kb < 2; ++kb)
#pragma unroll
                    for (int k = 0; k < 16; ++k) { int d = t - 16 * (64 * T + 32 * kb + crow(k, h)) - 31; d = d < 0 ? 0 : (d > 255 ? 255 : d); bvc[kb][k] = bl[d]; }
                float mx = -1e30f;
#pragma unroll
                for (int kb = 0; kb < 2; ++kb)
#pragma unroll
                    for (int k = 0; k < 16; ++k) { const int n = 64 * T + 32 * kb + crow(k, h); const int d = t - 16 * n - 31; const float x = (d >= 0 && n < 127) ? sc[kb][k] + bvc[kb][k] : -1e30f; sc[kb][k] = x; mx = fmaxf(mx, x); }
                mx = fmaxf(mx, __shfl_xor(mx, 32));
                const float mnew = fmaxf(m, mx), mref = mnew <= -1e29f ? 0.f : mnew; float rs = 0.f;
#pragma unroll
                for (int kb = 0; kb < 2; ++kb)
#pragma unroll
                    for (int k = 0; k < 16; ++k) rs += __builtin_amdgcn_exp2f(sc[kb][k] - mref);
                rs += __shfl_xor(rs, 32);
                lsum = lsum * __builtin_amdgcn_exp2f(m - mref) + rs; m = mnew;
            }
            const float mref = m <= -1e29f ? 0.f : m, inv = lsum > 0.f ? 1.f / lsum : 0.f;
#pragma unroll
            for (int k = 0; k < 16; ++k) { ot[0][k] = 0.f; ot[1][k] = 0.f; }
            float carry = 0.f;
            for (int T = 0; T < ntc; ++T) {
                f32x16 sc[2]; attn_scores<64>(sc, qf, lds + NSA_KT + T * 64 * 144, r, h);
                float bvc[2][16];
#pragma unroll
                for (int kb = 0; kb < 2; ++kb)
#pragma unroll
                    for (int k = 0; k < 16; ++k) { int d = t - 16 * (64 * T + 32 * kb + crow(k, h)) - 31; d = d < 0 ? 0 : (d > 255 ? 255 : d); bvc[kb][k] = bl[d]; }
#pragma unroll
                for (int kb = 0; kb < 2; ++kb)
#pragma unroll
                    for (int k = 0; k < 16; ++k) { const int n = 64 * T + 32 * kb + crow(k, h); const int d = t - 16 * n - 31; sc[kb][k] = (d >= 0 && n < 127) ? __builtin_amdgcn_exp2f(sc[kb][k] + bvc[kb][k] - mref) * inv : 0.f; }
                float prevL = carry;
#pragma unroll
                for (int kb = 0; kb < 2; ++kb)
#pragma unroll
                    for (int g4 = 0; g4 < 4; ++g4) {
                        const float G4 = (sc[kb][4 * g4] + sc[kb][4 * g4 + 1]) + (sc[kb][4 * g4 + 2] + sc[kb][4 * g4 + 3]); const float L = sc[kb][4 * g4 + 3];
                        const float Lo = __shfl_xor(L, 32);
                        const float add = h ? Lo : prevL;
                        prevL = Lo;
                        const int idx = T * 8 + kb * 4 + g4;
                        PS[g * 2048 + tl * 32 + 2 * idx + h] = G4 + add;
                    }
                carry = prevL;
#pragma unroll
                for (int s4 = 0; s4 < 4; ++s4) {
                    const int kb = s4 >> 1, hf = (s4 & 1) * 8;
                    u32x4 pw; pw.x = pk_bf16(sc[kb][hf + 0], sc[kb][hf + 1]); pw.y = pk_bf16(sc[kb][hf + 2], sc[kb][hf + 3]); pw.z = pk_bf16(sc[kb][hf + 4], sc[kb][hf + 5]); pw.w = pk_bf16(sc[kb][hf + 6], sc[kb][hf + 7]);
                    const bf16x8 pf = __builtin_bit_cast(bf16x8, pw);
#pragma unroll
                    for (int eb = 0; eb < 2; ++eb) ot[eb] = MFMA32(vt_frag(lds + NSA_VT + T * 64 * VTP, vt_lane_off(lane), s4, eb), pf, ot[eb]);
                }
            }
            { const float gc = NSA_GATE(0);
#pragma unroll
            for (int k = 0; k < 16; ++k) { otl[64 * k] = ot[0][k] * gc; otl[64 * (16 + k)] = ot[1][k] * gc; } }
        }
    }
    __syncthreads();
#ifndef NO_NSA_SEL
    if (i < 16) { if (tid < 64) SEL[tid] = (2u << i) - 1u; if (tid < 3) UNI[tid] = (2u << i) - 1u; }
    else {
        const int tk = tid >> 3, sg = tid & 7; float v[32];
#pragma unroll
        for (int k = 0; k < 8; ++k) { const f32x4 x0 = *(const LAS f32x4*)(PS + tk * 32 + 4 * k), x1 = *(const LAS f32x4*)(PS + 2048 + tk * 32 + 4 * k), x2 = *(const LAS f32x4*)(PS + 4096 + tk * 32 + 4 * k);
            v[4 * k] = (x0.x + x1.x) + x2.x; v[4 * k + 1] = (x0.y + x1.y) + x2.y; v[4 * k + 2] = (x0.z + x1.z) + x2.z; v[4 * k + 3] = (x0.w + x1.w) + x2.w; }
#pragma unroll
        for (int s = 0; s < 32; ++s) { const bool forced = (s == 0) || (s == i) || (s == i - 1); float x = forced ? v[s] + 1e4f : v[s]; v[s] = s > i ? -1.f : x; }
        unsigned bits = 0u;
#pragma unroll
        for (int k = 0; k < 4; ++k) {
            float x = 0.f;
#pragma unroll
            for (int s = 0; s < 32; ++s) x = (s == 4 * sg + k) ? v[s] : x;
            int rank = 0;
#pragma unroll
            for (int s = 0; s < 32; ++s) rank += (v[s] > x || (v[s] == x && s < 4 * sg + k)) ? 1 : 0;
            if (rank < 16 && x >= 0.f) bits |= 1u << (4 * sg + k);
        }
        bits |= shx<1>(bits); bits |= shx<2>(bits); bits |= shx<4>(bits);
        if (sg == 0) { SEL[tk] = bits; __hip_atomic_fetch_or(UNI, bits, __ATOMIC_RELAXED, __HIP_MEMORY_SCOPE_WORKGROUP); __hip_atomic_fetch_or(UNI + 1 + (tk >> 5), bits, __ATOMIC_RELAXED, __HIP_MEMORY_SCOPE_WORKGROUP); }
    }
#endif
    __syncthreads();
    const unsigned selbits = SEL[tl], uni = UNI[0], unih = UNI[1 + th];
    const float c31 = bl[255];
#ifndef NO_NSA_SLC
#ifndef NSA_DUP_SLC
#define NSA_DUP_SLC 1
#endif
    for (int rp_ = 0; rp_ < NSA_DUP_SLC; ++rp_) {
        AttnState A; attn_reset(A);
        const bf16_t* KS = (const bf16_t*)(ws + WS_PRJ + PRJ_KN1) + kvslab; const bf16_t* VS = (const bf16_t*)(ws + WS_PRJ + PRJ_VN1) + kvslab;
        auto slc_loop = [&](auto full_tag) __attribute__((always_inline)) {
        constexpr bool FULL = decltype(full_tag)::value;
        unsigned todo = uni; int cur = 0; u32x4 kr2[2], vr2;
        int s = __ffs(todo) - 1; todo &= todo - 1;
        stage_k_load<64>(kr, KS + (size_t)s * 4096, tid); vr = stage_v_load(VS + (size_t)s * 4096, tid);
        stage_k_store<64>(kr, lds + NSA_KT, tid); stage_v_store(vr, lds + NSA_VT, tid);
        int sn = todo ? __ffs(todo) - 1 : -1; todo &= todo - 1;
        if (sn >= 0) { stage_k_load<64>(kr, KS + (size_t)sn * 4096, tid); vr = stage_v_load(VS + (size_t)sn * 4096, tid); }
        __syncthreads();
        auto step = [&](u32x4 (&ka)[2], u32x4& va, u32x4 (&kb_)[2], u32x4& vb_) __attribute__((always_inline)) {
            const int sn2 = todo ? __ffs(todo) - 1 : -1; todo &= todo - 1;
            if (sn2 >= 0) { stage_k_load<64>(kb_, KS + (size_t)sn2 * 4096, tid); vb_ = stage_v_load(VS + (size_t)sn2 * 4096, tid); }
            if ((unih >> s) & 1u) {
                const bool sel = (selbits >> s) & 1u;
                if constexpr (FULL) {
                    f32x16 sc[2];
                    attn_scores<64>(sc, qf, lds + NSA_KT + cur * 64 * 144, r, h);
                    float bc = c31; if (i - s < 3) { nsa_mask_bias(sc, t - 64 * s, h, bl); bc = 0.f; }
                    attn_softmax_pv(A, sc, lds + NSA_VT + cur * 64 * VTP, r, h, bc, sel);
                } else {
                    f32x16 s1;
                    attn_scores_half<64>(s1, qf, lds + NSA_KT + cur * 64 * 144, r, h, kh);
                    float bc = c31; if (i - s < 3) { nsa_mask_bias_half(s1, t - 64 * s, h, bl, kh); bc = 0.f; }
                    attn_softmax_pv_half(A, s1, lds + NSA_VT + cur * 64 * VTP, r, h, kh, bc, sel);
                }
            }
            if (sn >= 0) { stage_k_store<64>(ka, lds + NSA_KT + (cur ^ 1) * 64 * 144, tid); stage_v_store(va, lds + NSA_VT + (cur ^ 1) * 64 * VTP, tid); }
            __syncthreads();
            s = sn; sn = sn2; cur ^= 1;
        };
        while (s >= 0) { step(kr, vr, kr2, vr2); if (s < 0) break; step(kr2, vr2, kr, vr); }
        };
        if (kh < 0) slc_loop(std::true_type{}); else slc_loop(std::false_type{});
        if (kh == 1) attn_park(A, xl);
        __syncthreads();
        if (kh == 0) attn_merge(A, xl);
        if (active && rp_ == NSA_DUP_SLC - 1) { const float gs = NSA_GATE(1); const float inv = A.l > 0.f ? gs / A.l : 0.f;
#pragma unroll
            for (int k = 0; k < 16; ++k) { otl[64 * k] += A.o[0][k] * inv; otl[64 * (16 + k)] += A.o[1][k] * inv; } }
    }
#endif
#ifndef NO_NSA_WIN
#ifndef NSA_DUP_WIN
#define NSA_DUP_WIN 1
#endif
    for (int rq_ = 0; rq_ < NSA_DUP_WIN; ++rq_) {
        AttnState A; attn_reset(A);
        const bf16_t* KW = (const bf16_t*)(ws + WS_PRJ + PRJ_KN2) + kvslab; const bf16_t* VW = (const bf16_t*)(ws + WS_PRJ + PRJ_VN2) + kvslab;
        const int j0 = i > 8 ? i - 8 : 0;
        auto win_loop = [&](auto full_tag) __attribute__((always_inline)) {
        constexpr bool FULL = decltype(full_tag)::value;
        int cur = 0; u32x4 kr2[2], vr2;
        stage_k_load<64>(kr, KW + (size_t)j0 * 4096, tid); vr = stage_v_load(VW + (size_t)j0 * 4096, tid);
        stage_k_store<64>(kr, lds + NSA_KT, tid); stage_v_store(vr, lds + NSA_VT, tid);
        if (j0 < i) { stage_k_load<64>(kr, KW + (size_t)(j0 + 1) * 4096, tid); vr = stage_v_load(VW + (size_t)(j0 + 1) * 4096, tid); }
        __syncthreads();
        for (int j = j0; j <= i; ++j) {
            if (j + 2 <= i) { stage_k_load<64>(kr2, KW + (size_t)(j + 2) * 4096, tid); vr2 = stage_v_load(VW + (size_t)(j + 2) * 4096, tid); }
            if constexpr (FULL) {
                f32x16 sc[2];
                attn_scores<64>(sc, qf, lds + NSA_KT + cur * 64 * 144, r, h);
                float bc = c31; if (!(i - j >= 3 && j > i - 8)) { nsa_mask_bias(sc, t - 64 * j, h, bl); bc = 0.f; }
                attn_softmax_pv(A, sc, lds + NSA_VT + cur * 64 * VTP, r, h, bc, true);
            } else {
                f32x16 s1;
                attn_scores_half<64>(s1, qf, lds + NSA_KT + cur * 64 * 144, r, h, kh);
                float bc = c31; if (!(i - j >= 3 && j > i - 8)) { nsa_mask_bias_half(s1, t - 64 * j, h, bl, kh); bc = 0.f; }
                attn_softmax_pv_half(A, s1, lds + NSA_VT + cur * 64 * VTP, r, h, kh, bc, true);
            }
            if (j < i) { stage_k_store<64>(kr, lds + NSA_KT + (cur ^ 1) * 64 * 144, tid); stage_v_store(vr, lds + NSA_VT + (cur ^ 1) * 64 * VTP, tid); }
            kr[0] = kr2[0]; vr = vr2;
            __syncthreads();
            cur ^= 1;
        }
        };
        if (kh < 0) win_loop(std::true_type{}); else win_loop(std::false_type{});
        if (kh == 1) attn_park(A, xl);
        __syncthreads();
        if (kh == 0) attn_merge(A, xl);
        if (active && rq_ == NSA_DUP_WIN - 1) { const float gw = NSA_GATE(2); const float inv = A.l > 0.f ? gw / A.l : 0.f;
            float ss = 0.f; bf16_t* Y = (bf16_t*)(ws + WS_Y) + row * 1024 + head * 64;
#pragma unroll
            for (int eb = 0; eb < 2; ++eb)
#pragma unroll
                for (int g4 = 0; g4 < 4; ++g4) {
                    const float v0 = otl[64 * (16 * eb + 4 * g4)] + A.o[eb][4 * g4] * inv, v1 = otl[64 * (16 * eb + 4 * g4 + 1)] + A.o[eb][4 * g4 + 1] * inv;
                    const float v2 = otl[64 * (16 * eb + 4 * g4 + 2)] + A.o[eb][4 * g4 + 2] * inv, v3 = otl[64 * (16 * eb + 4 * g4 + 3)] + A.o[eb][4 * g4 + 3] * inv;
                    u32x2 pw; pw.x = pk_bf16(v0, v1); pw.y = pk_bf16(v2, v3);
                    const float f0 = bf_lo(pw.x), f1 = bf_hi(pw.x), f2 = bf_lo(pw.y), f3 = bf_hi(pw.y); ss += (f0 * f0 + f1 * f1) + (f2 * f2 + f3 * f3);
                    *(u32x2*)(Y + 32 * eb + 8 * g4 + 4 * h) = pw;
                }
            ss += __shfl_xor(ss, 32);
            if (h == 0) ((float*)(ws + WS_SSQ + PT_A))[((size_t)l * 16384 + row) * 8 + head] = ss;
        }
    }
#endif
}

__device__ __forceinline__ void ml_out_wave(int cu, int l, InPtr in, unsigned char* ws, LAS unsigned char* wl, LAS unsigned char* npl, int lane) {
    const int c = cu & 31, bh = cu >> 5, hd = bh & 3, b = bh >> 2; const int t0 = c * 64; const int r = lane & 15, q = lane >> 4;
    const bf16_t* QC = (const bf16_t*)(ws + WS_ML) + ((size_t)bh * 2048 + t0) * 64; const bf16_t* KC = (const bf16_t*)(ws + WS_ML + ML_KC) + ((size_t)bh * 2048 + t0) * 64;
    const bf16_t* V = (const bf16_t*)(ws + WS_PRJ + PRJ_VML) + ((size_t)bh * 2048 + t0) * 64;
    const float* mlg = (const float*)(ws + WS_ML + ML_G) + ((size_t)bh * 2048 + t0) * 2;
    const bf16_t* CP = (const bf16_t*)(ws + WS_ML + ML_CP) + (size_t)cu * 4096; const bf16_t* NP = (const bf16_t*)(ws + WS_ML + ML_NP) + (size_t)cu * 64;
    u32x4 vch[8];
#pragma unroll
    for (int i = 0; i < 8; ++i) vch[i] = *(const u32x4*)(V + (size_t)(lane + 64 * i) * 8);
    bf16x8 aq[4][2];
#pragma unroll
    for (int mb = 0; mb < 4; ++mb)
#pragma unroll
        for (int ks = 0; ks < 2; ++ks) aq[mb][ks] = *(const bf16x8*)(QC + (size_t)(16 * mb + r) * 64 + 32 * ks + 8 * q);
    float bj[4][4], den[4][4];
#pragma unroll
    for (int mb = 0; mb < 4; ++mb)
#pragma unroll
        for (int j = 0; j < 4; ++j) bj[mb][j] = mlg[(16 * mb + 4 * q + j) * 2];
    {
        float cs[4];
#pragma unroll
        for (int nb = 0; nb < 4; ++nb) { const float2 gg = *(const float2*)(mlg + (16 * nb + r) * 2); cs[nb] = gg.y - gg.x; }
#pragma unroll
        for (int mb = 0; mb < 4; ++mb) {
            f32x4 accS[4];
#pragma unroll
            for (int nb = 0; nb < 4; ++nb) { accS[nb] = (f32x4){0.f, 0.f, 0.f, 0.f};
#pragma unroll
                for (int ks = 0; ks < 2; ++ks) { const bf16x8 bk = *(const bf16x8*)(KC + (size_t)(16 * nb + r) * 64 + 32 * ks + 8 * q); accS[nb] = MFMA16(aq[mb][ks], bk, accS[nb]); } }
#pragma unroll
            for (int j = 0; j < 4; ++j) {
                const int jj = 16 * mb + 4 * q + j; float rs = 0.f;
#pragma unroll
                for (int nb = 0; nb < 4; ++nb) { const int s = 16 * nb + r; const float p = s <= jj ? accS[nb][j] * __expf(bj[mb][j] + cs[nb]) : 0.f; rs += p;
                    *(LAS bf16_t*)(wl + 8192 + swz_off(jj, s >> 3) + (s & 7) * 2) = f2bf(p); }
                rs += shx<1>(rs); rs += shx<2>(rs); rs += shx<4>(rs); rs += shx<8>(rs);
                den[mb][j] = rs;
            }
        }
    }
#pragma unroll
    for (int i = 0; i < 8; ++i) { const int ch = lane + 64 * i, sv = ch >> 3, e0 = (ch & 7) * 8; const unsigned xs[4] = {vch[i].x, vch[i].y, vch[i].z, vch[i].w};
#pragma unroll
        for (int k = 0; k < 4; ++k) { *(LAS bf16_t*)(wl + swz_off(e0 + 2 * k, sv >> 3) + (sv & 7) * 2) = (bf16_t)(xs[k] & 0xffffu); *(LAS bf16_t*)(wl + swz_off(e0 + 2 * k + 1, sv >> 3) + (sv & 7) * 2) = (bf16_t)(xs[k] >> 16); } }
#pragma unroll
    for (int mb = 0; mb < 4; ++mb) { const float e = __expf(mlg[(16 * mb + r) * 2]);
#pragma unroll
        for (int ks = 0; ks < 2; ++ks) { const u32x4 x = __builtin_bit_cast(u32x4, aq[mb][ks]); u32x4 y;
            y.x = pk_bf16(bf_lo(x.x) * e, bf_hi(x.x) * e); y.y = pk_bf16(bf_lo(x.y) * e, bf_hi(x.y) * e); y.z = pk_bf16(bf_lo(x.z) * e, bf_hi(x.z) * e); y.w = pk_bf16(bf_lo(x.w) * e, bf_hi(x.w) * e);
            aq[mb][ks] = __builtin_bit_cast(bf16x8, y); } }
    f32x4 acc[4][4], accn[4];
#pragma unroll
    for (int mb = 0; mb < 4; ++mb) { accn[mb] = (f32x4){0.f, 0.f, 0.f, 0.f};
#pragma unroll
        for (int nb = 0; nb < 4; ++nb) acc[mb][nb] = (f32x4){0.f, 0.f, 0.f, 0.f}; }
#pragma unroll
    for (int ks = 0; ks < 2; ++ks) {
        u32x4 nz = *(const u32x4*)(NP + 32 * ks + 8 * q); if (r != 0) nz = (u32x4){0u, 0u, 0u, 0u};
        const bf16x8 bn = __builtin_bit_cast(bf16x8, nz);
#pragma unroll
        for (int nb = 0; nb < 4; ++nb) { const bf16x8 bb = *(const bf16x8*)(CP + (size_t)(16 * nb + r) * 64 + 32 * ks + 8 * q);
#pragma unroll
            for (int mb = 0; mb < 4; ++mb) acc[mb][nb] = MFMA16(aq[mb][ks], bb, acc[mb][nb]); }
#pragma unroll
        for (int mb = 0; mb < 4; ++mb) accn[mb] = MFMA16(aq[mb][ks], bn, accn[mb]);
    }
    LDS_FENCE();
#pragma unroll
    for (int ks = 0; ks < 2; ++ks) {
        bf16x8 ap[4];
#pragma unroll
        for (int mb = 0; mb < 4; ++mb) ap[mb] = *(const LAS bf16x8*)(wl + 8192 + swz_off(16 * mb + r, 4 * ks + q));
#pragma unroll
        for (int nb = 0; nb < 4; ++nb) { const bf16x8 bv = *(const LAS bf16x8*)(wl + swz_off(16 * nb + r, 4 * ks + q));
#pragma unroll
            for (int mb = 0; mb < 4; ++mb) acc[mb][nb] = MFMA16(ap[mb], bv, acc[mb][nb]); }
    }
    LDS_FENCE();
    const bf16_t* OG = (const bf16_t*)(ws + WS_PRJ + PRJ_OG); u32x4 ogc[8];
#pragma unroll
    for (int i = 0; i < 8; ++i) { const int ch = lane + 64 * i; ogc[i] = *(const u32x4*)(OG + ((size_t)b * 2048 + t0 + (ch >> 3)) * 256 + hd * 64 + (ch & 7) * 8); }
    const float* gain = in->p[14] + l * 256 + hd * 64;
    bf16_t* Y = (bf16_t*)(ws + WS_Y);
    float gn[4];
#pragma unroll
    for (int nb = 0; nb < 4; ++nb) gn[nb] = gain[16 * nb + r];
#pragma unroll
    for (int mb = 0; mb < 4; ++mb)
#pragma unroll
        for (int j = 0; j < 4; ++j) {
            const int jj = 16 * mb + 4 * q + j;
            const float dn = den[mb][j] + __builtin_bit_cast(float, __builtin_amdgcn_ds_bpermute((lane & 48) << 2, __builtin_bit_cast(int, accn[mb][j])));
            const float inv = __builtin_amdgcn_rcpf(fmaxf(fabsf(dn), 1.f)); float hv[4]; float ss = 0.f;
#pragma unroll
            for (int nb = 0; nb < 4; ++nb) { hv[nb] = acc[mb][nb][j] * inv; ss += hv[nb] * hv[nb]; }
            ss += shx<1>(ss); ss += shx<2>(ss); ss += shx<4>(ss); ss += shx<8>(ss);
            const float rstd = rsqrtf(ss * (1.f / 64.f) + 1e-6f);
#pragma unroll
            for (int nb = 0; nb < 4; ++nb) { const int e = 16 * nb + r; *(LAS bf16_t*)(wl + 8192 + swz_off(jj, e >> 3) + (e & 7) * 2) = f2bf(hv[nb] * rstd * gn[nb]); }
        }
    LDS_FENCE();
#pragma unroll
    for (int i = 0; i < 8; ++i) { const int ch = lane + 64 * i, row = ch >> 3, e8 = ch & 7;
        const u32x4 hx = *(const LAS u32x4*)(wl + 8192 + swz_off(row, e8)); const u32x4 g = ogc[i]; u32x4 o;
        o.x = pk_bf16(bf_lo(hx.x) * sigmf(bf_lo(g.x)), bf_hi(hx.x) * sigmf(bf_hi(g.x)));
        o.y = pk_bf16(bf_lo(hx.y) * sigmf(bf_lo(g.y)), bf_hi(hx.y) * sigmf(bf_hi(g.y)));
        o.z = pk_bf16(bf_lo(hx.z) * sigmf(bf_lo(g.z)), bf_hi(hx.z) * sigmf(bf_hi(g.z)));
        o.w = pk_bf16(bf_lo(hx.w) * sigmf(bf_lo(g.w)), bf_hi(hx.w) * sigmf(bf_hi(g.w)));
        *(u32x4*)(Y + ((size_t)b * 2048 + t0 + row) * 1024 + 768 + hd * 64 + e8 * 8) = o; }
    LDS_FENCE();
}

__device__ __forceinline__ void ml_scan_unit(int bh, int l, unsigned char* ws, int g_wv) {
    int tid_ = TIDX; asm volatile("" : "+v"(tid_)); const int tid = tid_;
    const bf16_t* DL = (const bf16_t*)(ws + WS_ML + ML_DELTA) + (size_t)bh * 32 * 4096 + tid * 8; bf16_t* CP = (bf16_t*)(ws + WS_ML + ML_CP) + (size_t)bh * 32 * 4096 + tid * 8;
    const float* DN = (const float*)(ws + WS_ML + ML_DN) + (size_t)bh * 32 * 64; bf16_t* NP = (bf16_t*)(ws + WS_ML + ML_NP) + (size_t)bh * 32 * 64; const float* BL = (const float*)(ws + WS_ML + ML_BL) + bh * 32;
    float c[8]; float n = 0.f;
#pragma unroll
    for (int k = 0; k < 8; ++k) c[k] = 0.f;
#pragma unroll 1
    for (int c0 = 0; c0 < 32; c0 += 8) {
        u32x4 d[8]; float dn[8], co[8];
#pragma unroll
        for (int k = 0; k < 8; ++k) { d[k] = *(const u32x4*)(DL + (size_t)(c0 + k) * 4096); dn[k] = tid < 64 ? DN[(c0 + k) * 64 + tid] : 0.f; co[k] = __expf(BL[c0 + k]); }
#pragma unroll
        for (int k = 0; k < 8; ++k) {
            u32x4 o; o.x = pk_bf16(c[0], c[1]); o.y = pk_bf16(c[2], c[3]); o.z = pk_bf16(c[4], c[5]); o.w = pk_bf16(c[6], c[7]);
            *(u32x4*)(CP + (size_t)(c0 + k) * 4096) = o; if (tid < 64) NP[(c0 + k) * 64 + tid] = f2bf(n);
            c[0] = co[k] * c[0] + bf_lo(d[k].x); c[1] = co[k] * c[1] + bf_hi(d[k].x); c[2] = co[k] * c[2] + bf_lo(d[k].y); c[3] = co[k] * c[3] + bf_hi(d[k].y);
            c[4] = co[k] * c[4] + bf_lo(d[k].z); c[5] = co[k] * c[5] + bf_hi(d[k].z); c[6] = co[k] * c[6] + bf_lo(d[k].w); c[7] = co[k] * c[7] + bf_hi(d[k].w);
            n = co[k] * n + dn[k];
        }
    }
    asm volatile("s_waitcnt vmcnt(0)" ::: "memory"); __syncthreads();
    if (tid == 0) { __builtin_amdgcn_fence(__ATOMIC_RELEASE, "agent"); asm volatile("s_waitcnt vmcnt(0)" ::: "memory");
        __hip_atomic_fetch_add((unsigned*)(ws + WS_CTL) + CW_SCAN + 64 * l, 1u, __ATOMIC_RELAXED, __HIP_MEMORY_SCOPE_AGENT); }
}
__device__ __forceinline__ void ml_scan_wait(int l, unsigned char* ws, int g_wv) {
    if (TIDX == 0) { unsigned* p = (unsigned*)(ws + WS_CTL) + CW_SCAN + 64 * l; unsigned sp = 0;
        while (__hip_atomic_load(p, __ATOMIC_RELAXED, __HIP_MEMORY_SCOPE_AGENT) < 32u) { __builtin_amdgcn_s_sleep(2); if (++sp > (1u << 22)) break; }
        __builtin_amdgcn_fence(__ATOMIC_ACQUIRE, "agent"); asm volatile("s_waitcnt vmcnt(0)" ::: "memory"); }
    __syncthreads();
}

#ifndef DUP_NSA
#define DUP_NSA 1
#endif
#ifndef DUP_MLA
#define DUP_MLA 1
#endif
#ifndef DUP_ML
#define DUP_ML 1
#endif
#ifdef NO_MLA
#define MLA_CALL(...) do {} while (0)
#else
#define MLA_CALL(...) do { for (int rp = 0; rp < DUP_MLA; ++rp) { if (rp) __syncthreads(); mla_unit(__VA_ARGS__); } } while (0)
#endif
__device__ __forceinline__ void phase_mix(int l, InPtr in, unsigned char* ws, LAS unsigned char* lds, unsigned* qhead, int g_wv) {
    LAS int* slot = (LAS int*)(lds + LDS_MISC + 64);
    bool first = true; const int nb_ = (int)gridDim.x, b0_ = (int)blockIdx.x;
    for (;;) {
        __syncthreads();
        if (TIDX == 0) *slot = first ? b0_ : nb_ + (int)__hip_atomic_fetch_add(qhead, 1u, __ATOMIC_RELAXED, __HIP_MEMORY_SCOPE_AGENT);
        first = false;
        __syncthreads();
        int u = *slot;
        if (u >= 32 + 512 + 384 + 128) break;
        if (u < 32) { ml_scan_unit(u, l, ws, g_wv); continue; } u -= 32;
        int kind = 2, p0 = 0, bh = 0;
        if (u < 384) { kind = 0; p0 = 31 - (u >> 4); bh = u & 15; }
        else if ((u -= 384) < 384) { kind = 1; p0 = 7 - u / 48; bh = u % 48; }
        else if ((u -= 384) < 128) { kind = 0; p0 = 7 - (u >> 4); bh = u & 15; }
        else u -= 128;
#ifndef NO_NSA
        if (kind == 0) { for (int rp = 0; rp < DUP_NSA; ++rp) { if (rp) __syncthreads(); nsa_unit(bh >> 1, bh & 1, p0, l, in, ws, lds, g_wv); } continue; }
#endif
        if (kind == 1) { MLA_CALL(bh / 6, bh % 6, p0, l, ws, lds, g_wv); continue; }
        if (kind != 2) continue;
#ifndef NO_MLOUT
        ml_scan_wait(l, ws, g_wv);
        for (int rp = 0; rp < DUP_ML; ++rp) { int tid_ = TIDX; asm volatile("" : "+v"(tid_)); const int w = tid_ >> 6; ml_out_wave(u * 8 + w, l, in, ws, lds + w * 16384, lds + 131072 + w * 256, tid_ & 63); }
#endif
    }
}
__device__ __forceinline__ void phase_ynorm(int l, unsigned char* ws, int bid, int nb, int g_wv) {
    int tid_ = TIDX; asm volatile("" : "+v"(tid_)); const int w = tid_ >> 6, lane = tid_ & 63;
    bf16_t* Y = (bf16_t*)(ws + WS_Y); const float* sa = (const float*)(ws + WS_SSQ + PT_A) + (size_t)l * 16384 * 8; const float* sc = (const float*)(ws + WS_SSQ + PT_C) + (size_t)l * 16384 * 8;
    for (int r0 = (bid * 8 + w) * 8; r0 < NTOK; r0 += nb * 64) {
        if (lane < 48) {
            u32x4 x[8], y[8]; float ra[8], rc[8];
#pragma unroll
            for (int k = 0; k < 8; ++k) { const int row = r0 + k;
                const f32x4 a0 = *(const f32x4*)(sa + (size_t)row * 8), a1 = *(const f32x4*)(sa + (size_t)row * 8 + 4), c0 = *(const f32x4*)(sc + (size_t)row * 8), c1 = *(const f32x4*)(sc + (size_t)row * 8 + 4);
                ra[k] = rsqrtf((((a0.x + a0.y) + (a0.z + a0.w)) + (a1.x + a1.y)) * (1.f / 384.f) + 1e-6f); rc[k] = rsqrtf((((c0.x + c0.y) + (c0.z + c0.w)) + (c1.x + c1.y)) * (1.f / 384.f) + 1e-6f);
                x[k] = *((const u32x4*)(Y + (size_t)row * 1024) + lane); y[k] = *((const u32x4*)(Y + (size_t)row * 1024 + 384) + lane); }
#pragma unroll
            for (int k = 0; k < 8; ++k) { const int row = r0 + k; u32x4 a = x[k], c = y[k]; const float fa = ra[k], fc = rc[k];
                a.x = pk_bf16(bf_lo(a.x) * fa, bf_hi(a.x) * fa); a.y = pk_bf16(bf_lo(a.y) * fa, bf_hi(a.y) * fa); a.z = pk_bf16(bf_lo(a.z) * fa, bf_hi(a.z) * fa); a.w = pk_bf16(bf_lo(a.w) * fa, bf_hi(a.w) * fa);
                c.x = pk_bf16(bf_lo(c.x) * fc, bf_hi(c.x) * fc); c.y = pk_bf16(bf_lo(c.y) * fc, bf_hi(c.y) * fc); c.z = pk_bf16(bf_lo(c.z) * fc, bf_hi(c.z) * fc); c.w = pk_bf16(bf_lo(c.w) * fc, bf_hi(c.w) * fc);
                *((u32x4*)(Y + (size_t)row * 1024) + lane) = a; *((u32x4*)(Y + (size_t)row * 1024 + 384) + lane) = c; }
        }
    }
}
constexpr int LDS_FAC = 131072 + 2048;
__device__ __forceinline__ void outproj_factors(int l, unsigned char* ws, LAS unsigned char* lds, int pm, int tid) {
    asm volatile("" : "+v"(tid));
    if (tid < 256) { const int row = pm * 256 + tid; const float* sa = (const float*)(ws + WS_SSQ + PT_A) + ((size_t)l * 16384 + row) * 8; const float* sc = (const float*)(ws + WS_SSQ + PT_C) + ((size_t)l * 16384 + row) * 8;
        const f32x4 a0 = *(const f32x4*)sa, a1 = *(const f32x4*)(sa + 4), c0 = *(const f32x4*)sc, c1 = *(const f32x4*)(sc + 4);
        const float ra = rsqrtf((((a0.x + a0.y) + (a0.z + a0.w)) + (a1.x + a1.y)) * (1.f / 384.f) + 1e-6f), rc = rsqrtf((((c0.x + c0.y) + (c0.z + c0.w)) + (c1.x + c1.y)) * (1.f / 384.f) + 1e-6f);
        LAS float* F = (LAS float*)(lds + LDS_FAC); F[2 * tid] = ra / rc; F[2 * tid + 1] = rc; }
    __syncthreads();
}
struct EpiOut {
    static constexpr bool KHOOK = true;
    bf16_t* XB; float* ssq; const LAS float* F; bool fold;
    __device__ __forceinline__ void kscale(f32x4 (&acc)[2][2][4][2], int which, int wr, int fr) const {
        if (!fold) return;
#pragma unroll
        for (int ai = 0; ai < 2; ++ai)
#pragma unroll
            for (int m = 0; m < 4; ++m) { const float f = F[2 * (ai * 128 + wr * 64 + m * 16 + fr) + which];
#pragma unroll
                for (int bj = 0; bj < 2; ++bj)
#pragma unroll
                    for (int n = 0; n < 2; ++n) acc[ai][bj][m][n] = acc[ai][bj][m][n] * f; }
    }
    __device__ __forceinline__ void operator()(const f32x4 (&acc)[2][2][4][2], const GUnit& u, int wr, int wc, int fr, int fq) const {
#pragma unroll
        for (int ai = 0; ai < 2; ++ai)
#pragma unroll
          for (int mh = 0; mh < 2; ++mh) {
            __builtin_amdgcn_sched_barrier(0);
            u32x4 xr[2][2];
#pragma unroll
            for (int m2 = 0; m2 < 2; ++m2)
#pragma unroll
                for (int bj = 0; bj < 2; ++bj) xr[m2][bj] = *(const u32x4*)(XB + (size_t)(u.pm * 256 + ai * 128 + wr * 64 + (2 * mh + m2) * 16 + fr) * 1024 + u.pn * 256 + bj * 128 + wc * 32 + 8 * fq);
#pragma unroll
            for (int m2 = 0; m2 < 2; ++m2) {
                const int m = 2 * mh + m2; const int row = u.pm * 256 + ai * 128 + wr * 64 + m * 16 + fr; float ss = 0.f;
#pragma unroll
                for (int bj = 0; bj < 2; ++bj) {
                    const u32x4 x = xr[m2][bj]; u32x4 o;
                    o.x = pk_bf16(bf_lo(x.x) + acc[ai][bj][m][0][0], bf_hi(x.x) + acc[ai][bj][m][0][1]); o.y = pk_bf16(bf_lo(x.y) + acc[ai][bj][m][0][2], bf_hi(x.y) + acc[ai][bj][m][0][3]);
                    o.z = pk_bf16(bf_lo(x.z) + acc[ai][bj][m][1][0], bf_hi(x.z) + acc[ai][bj][m][1][1]); o.w = pk_bf16(bf_lo(x.w) + acc[ai][bj][m][1][2], bf_hi(x.w) + acc[ai][bj][m][1][3]);
                    *(u32x4*)(XB + (size_t)row * 1024 + u.pn * 256 + bj * 128 + wc * 32 + 8 * fq) = o;
                    ss += (bf_lo(o.x) * bf_lo(o.x) + bf_hi(o.x) * bf_hi(o.x)) + (bf_lo(o.y) * bf_lo(o.y) + bf_hi(o.y) * bf_hi(o.y)) + (bf_lo(o.z) * bf_lo(o.z) + bf_hi(o.z) * bf_hi(o.z)) + (bf_lo(o.w) * bf_lo(o.w) + bf_hi(o.w) * bf_hi(o.w));
                }
                ss = quad_sum(ss); if (fq == 0) ssq[(size_t)row * 16 + u.pn * 4 + wc] = ss;
            }
          }
    }
};

__device__ __forceinline__ float sum16(const float* p) { const f32x4 a = *(const f32x4*)p, b = *(const f32x4*)(p + 4), c = *(const f32x4*)(p + 8), d = *(const f32x4*)(p + 12);
    return (((a.x + a.y) + (a.z + a.w)) + ((b.x + b.y) + (b.z + b.w))) + (((c.x + c.y) + (c.z + c.w)) + ((d.x + d.y) + (d.z + d.w))); }
__device__ __forceinline__ void phase_route(int l, InPtr in, unsigned char* ws, LAS unsigned char* lds, int bid, int nb, int g_wv) {
    int tid_ = TIDX; asm volatile("" : "+v"(tid_)); const int w = tid_ >> 6, lane = tid_ & 63, r = lane & 15, q = lane >> 4;
    const bf16_t* XB = (const bf16_t*)(ws + WS_XB); const bf16_t* WR = (const bf16_t*)(ws + WS_WR) + (size_t)l * 64 * 1024;
    const float* ssq = (const float*)(ws + WS_SSQ + PT_X1) + (size_t)l * 16384 * 16; const float* bg = in->p[24] + l * 4; const float* be = in->p[26] + l * 32;
    unsigned* cnt = (unsigned*)(ws + WS_CTL) + CW_CNT + 2048 * l; unsigned* mtok = (unsigned*)(ws + WS_META); float* mw = (float*)(ws + WS_META + META_W);
    LAS float* lg = (LAS float*)(lds + w * 4096);
    LAS unsigned* lcnt = (LAS unsigned*)(lds + 32768); LAS unsigned* lbase = lcnt + 32;
    constexpr int WRP = 2064; LAS unsigned char* wrl = lds + 40960;
    { u32x4 st[12];
#pragma unroll
      for (int i = 0; i < 12; ++i) { const int c = tid_ + 512 * i; st[i] = *(const u32x4*)(WR + (size_t)(c >> 7) * 1024 + (c & 127) * 8); }
#pragma unroll
      for (int i = 0; i < 12; ++i) { const int c = tid_ + 512 * i; *(LAS u32x4*)(wrl + (c >> 7) * WRP + (c & 127) * 16) = st[i]; } }
    for (int g0 = bid * 8; g0 < NTOK / 16; g0 += nb * 8) {
        if (tid_ < 32) lcnt[tid_] = 0u;
        __syncthreads();
        const int tok0 = (g0 + w) * 16; f32x4 acc[3];
#pragma unroll
        for (int n = 0; n < 3; ++n) acc[n] = (f32x4){0.f, 0.f, 0.f, 0.f};
        const bf16_t* ap = XB + (size_t)(tok0 + r) * 1024 + 8 * q; const LAS unsigned char* bl_ = wrl + r * WRP + 16 * q;
#pragma unroll 1
        for (int kc = 0; kc < 2; ++kc) {
            bf16x8 a[16];
#pragma unroll
            for (int s = 0; s < 16; ++s) a[s] = *(const bf16x8*)(ap + 32 * (kc * 16 + s));
            __builtin_amdgcn_sched_barrier(0);
#pragma unroll
            for (int s = 0; s < 16; ++s)
#pragma unroll
                for (int n = 0; n < 3; ++n) { const bf16x8 bb = *(const LAS bf16x8*)(bl_ + n * 16 * WRP + 64 * (kc * 16 + s)); acc[n] = MFMA16(a[s], bb, acc[n]); }
            __builtin_amdgcn_sched_barrier(0);
        }
#pragma unroll
        for (int n = 0; n < 3; ++n)
#pragma unroll
            for (int j = 0; j < 4; ++j) lg[(4 * q + j) * 48 + 16 * n + r] = acc[n][j];
        LDS_FENCE();
        int E0 = 0, E1 = 0; unsigned r0 = 0, r1 = 0; float wt0 = 0.f, wt1 = 0.f; const int tok = tok0 + (lane & 15);
        if (lane < 16) {
            const float rs = rsqrtf(sum16(ssq + (size_t)tok * 16) * (1.f / 1024.f) + 1e-6f); ((float*)(ws + WS_RS2))[tok] = rs; const LAS float* L = lg + lane * 48;
            float gl[4]; int gi = 0;
#pragma unroll
            for (int j = 0; j < 4; ++j) gl[j] = L[j] * rs + bg[j];
            float gm = gl[0];
#pragma unroll
            for (int j = 1; j < 4; ++j) if (gl[j] > gm) { gm = gl[j]; gi = j; }
            float gsum = 0.f;
#pragma unroll
            for (int j = 0; j < 4; ++j) gsum += __expf(gl[j] - gm);
            const float gtop = 1.f / gsum;
            float el[8];
#pragma unroll
            for (int j = 0; j < 8; ++j) el[j] = L[4 + gi * 8 + j] * rs + be[gi * 8 + j];
            int e0 = 0; float v0 = el[0];
#pragma unroll
            for (int j = 1; j < 8; ++j) if (el[j] > v0) { v0 = el[j]; e0 = j; }
            int e1 = -1; float v1 = -3.0e38f;
#pragma unroll
            for (int j = 0; j < 8; ++j) if (j != e0 && el[j] > v1) { v1 = el[j]; e1 = j; }
            const float w0 = 1.f / (1.f + __expf(v1 - v0)); E0 = gi * 8 + e0; E1 = gi * 8 + e1; wt0 = w0 * gtop; wt1 = (1.f - w0) * gtop;
            r0 = __hip_atomic_fetch_add(lcnt + E0, 1u, __ATOMIC_RELAXED, __HIP_MEMORY_SCOPE_WORKGROUP); r1 = __hip_atomic_fetch_add(lcnt + E1, 1u, __ATOMIC_RELAXED, __HIP_MEMORY_SCOPE_WORKGROUP);
        }
        __syncthreads();
        if (tid_ < 32) { const unsigned c = lcnt[tid_]; lbase[tid_] = c ? atomicAdd(cnt + tid_ * 64, c) : 0u; }
        __syncthreads();
        if (lane < 16) {
            const unsigned p0 = lbase[E0] + r0, p1 = lbase[E1] + r1;
            mtok[(size_t)E0 * 16384 + p0] = (unsigned)tok; mw[(size_t)E0 * 16384 + p0] = wt0;
            mtok[(size_t)E1 * 16384 + p1] = (unsigned)tok | 0x80000000u; mw[(size_t)E1 * 16384 + p1] = wt1;
        }
        __syncthreads();
    }
}

constexpr int LDS_TB = 131072 + 2048;
__device__ __forceinline__ void moe_tables(int l, unsigned char* ws, LAS unsigned char* lds, int g_wv) {
    int tix = TIDX; asm volatile("" : "+v"(tix));
    LAS int* tb = (LAS int*)(lds + LDS_TB);
    if (tix < 32) { const unsigned* cnt = (const unsigned*)(ws + WS_CTL) + CW_CNT + 2048 * l; tb[160 + tix] = (int)__hip_atomic_load(cnt + tix * 64, __ATOMIC_RELAXED, __HIP_MEMORY_SCOPE_AGENT); }
    __syncthreads();
    if (tix == 0) { int a = 0, f = 0, p = 0; for (int e = 0; e < 32; ++e) { const int c = tb[160 + e]; tb[e] = a; tb[48 + e] = f; tb[96 + e] = p; a += (c + 255) >> 8; f += c >> 8; p += (c & 255) ? 1 : 0; } tb[32] = a; tb[80] = f; tb[128] = p; }
    __syncthreads();
}
template <int NPN, bool GATHER_>
struct MoeSched {
    static constexpr bool GATHER = GATHER_, PARTIAL = false;
    const char* A; const char* Bt; const unsigned* cnt; const unsigned* mtok; const LAS int* tb; int G, c; size_t bstride_e  , bstride_pn; int lo, hi;
    __device__ __forceinline__ bool next(int i, GUnit& u) const {
        const int L = lo + i * G + c; if (L >= hi) return false;
        const int tile = L / NPN, pn = L % NPN;
        int e = 0;
        for (int k = 1; k < 32; ++k) e = (tb[k] <= tile) ? k : e;
        e = __builtin_amdgcn_readfirstlane(e);
        u.e = e; u.pm = tile; u.pn = pn; u.rows = tb[160 + e] - 256 * (tile - tb[e]);
        u.a = GATHER ? A : A + (size_t)tile * 256 * 256 * 2;
        u.b = Bt + (size_t)e * bstride_e + (size_t)pn * bstride_pn; return true;
    }
    __device__ __forceinline__ void aoff(const GUnit& u, unsigned (&v)[2][2], const int (&R)[2], const int (&C)[2]) const {
#pragma unroll
        for (int h = 0; h < 2; ++h)
#pragma unroll
            for (int i = 0; i < 2; ++i) {
                if (GATHER) { const int lr = h * 128 + R[i]; const int rr = 256 * (u.pm - tb[u.e]) + (lr < u.rows ? lr : 0); const unsigned tok = mtok[(size_t)u.e * 16384 + rr] & 0x7fffffffu; v[h][i] = (tok * 1024u + (unsigned)C[i]) * 2u; }
                else v[h][i] = (unsigned)((h * 128 + R[i]) * 256 + C[i]) * 2u;
            }
    }
};
struct EpiMoeUp {
    static constexpr bool KHOOK = false;
    const unsigned* mtok; const float* ssq; const LAS int* tb; bf16_t* HB;
    __device__ __forceinline__ void operator()(const f32x4 (&acc)[2][2][4][2], const GUnit& u, int wr, int wc, int fr, int fq) const {
        const int r0 = 256 * (u.pm - tb[u.e]);
        float rs8[8];
        { unsigned tk[8];
#pragma unroll
          for (int k = 0; k < 8; ++k) { const int lr = (k >> 2) * 128 + wr * 64 + (k & 3) * 16 + fr; tk[k] = mtok[(size_t)u.e * 16384 + r0 + (lr < u.rows ? lr : 0)] & 0x7fffffffu; }
#pragma unroll
          for (int k = 0; k < 8; ++k) rs8[k] = ssq[tk[k]]; }
#pragma unroll
        for (int ai = 0; ai < 2; ++ai)
#pragma unroll
            for (int m = 0; m < 4; ++m) {
                __builtin_amdgcn_sched_barrier(0);
                const int lr = ai * 128 + wr * 64 + m * 16 + fr;
                if (lr < u.rows) {
                    const float rs = rs8[ai * 4 + m];
                    float hv[8];
#pragma unroll
                    for (int n = 0; n < 2; ++n)
#pragma unroll
                        for (int j = 0; j < 4; ++j) { const float gv = acc[ai][0][m][n][j] * rs, uv = acc[ai][1][m][n][j] * rs; hv[4 * n + j] = siluf(gv) * uv; }
                    st_bf16x8(HB + ((size_t)u.pm * 256 + lr) * 256 + u.pn * 128 + wc * 32 + 8 * fq, hv);
                }
            }
    }
};
struct EpiMoeDown {
    static constexpr bool KHOOK = false;
    const unsigned* mtok; const float* mw; const LAS int* tb; bf16_t* YB;
    __device__ __forceinline__ void operator()(const f32x4 (&acc)[2][2][4][2], const GUnit& u, int wr, int wc, int fr, int fq) const {
        const int r0 = 256 * (u.pm - tb[u.e]);
        unsigned mt8[8]; float wt8[8];
#pragma unroll
        for (int k = 0; k < 8; ++k) { const int lr = (k >> 2) * 128 + wr * 64 + (k & 3) * 16 + fr; const size_t ix = (size_t)u.e * 16384 + r0 + (lr < u.rows ? lr : 0); mt8[k] = mtok[ix]; wt8[k] = mw[ix]; }
#pragma unroll
        for (int ai = 0; ai < 2; ++ai)
#pragma unroll
            for (int m = 0; m < 4; ++m) {
                __builtin_amdgcn_sched_barrier(0);
                const int lr = ai * 128 + wr * 64 + m * 16 + fr;
                if (lr < u.rows) {
                    const unsigned mt = mt8[ai * 4 + m]; const float wt = wt8[ai * 4 + m];
                    bf16_t* dst = YB + ((size_t)(mt >> 31) * 16384 + (mt & 0x7fffffffu)) * 1024 + u.pn * 256 + wc * 32 + 8 * fq;
#pragma unroll
                    for (int bj = 0; bj < 2; ++bj) { float v[8];
#pragma unroll
                        for (int n = 0; n < 2; ++n)
#pragma unroll
                            for (int j = 0; j < 4; ++j) v[4 * n + j] = acc[ai][bj][m][n][j] * wt;
                        st_bf16x8(dst + bj * 128, v); }
                }
            }
    }
};
__device__ __forceinline__ void phase_combine(int l, unsigned char* ws, float* out, int bid, int nb, int g_wv) {
    int tid_ = TIDX; asm volatile("" : "+v"(tid_)); const int w = tid_ >> 6, lane = tid_ & 63;
    bf16_t* XB = (bf16_t*)(ws + WS_XB); const bf16_t* Y0 = (const bf16_t*)(ws + WS_YBUF); const bf16_t* Y1 = Y0 + (size_t)16384 * 1024; float* ssqx = (float*)(ws + WS_SSQX) + 16384;
    for (int row = bid * 8 + w; row < NTOK; row += nb * 8) {
        float ss = 0.f;
#pragma unroll
        for (int k = 0; k < 2; ++k) {
            const size_t o = (size_t)row * 1024 + (lane + 64 * k) * 8;
            const u32x4 x = *(const u32x4*)(XB + o), a = *(const u32x4*)(Y0 + o), c = *(const u32x4*)(Y1 + o);
            float v[8] = { bf_lo(x.x) + bf_lo(a.x) + bf_lo(c.x), bf_hi(x.x) + bf_hi(a.x) + bf_hi(c.x), bf_lo(x.y) + bf_lo(a.y) + bf_lo(c.y), bf_hi(x.y) + bf_hi(a.y) + bf_hi(c.y),
                           bf_lo(x.z) + bf_lo(a.z) + bf_lo(c.z), bf_hi(x.z) + bf_hi(a.z) + bf_hi(c.z), bf_lo(x.w) + bf_lo(a.w) + bf_lo(c.w), bf_hi(x.w) + bf_hi(a.w) + bf_hi(c.w) };
            if (l == L_ - 1 && out) { *(f32x4*)(out + o) = (f32x4){v[0], v[1], v[2], v[3]}; *(f32x4*)(out + o + 4) = (f32x4){v[4], v[5], v[6], v[7]}; }
            else { u32x4 p; p.x = pk_bf16(v[0], v[1]); p.y = pk_bf16(v[2], v[3]); p.z = pk_bf16(v[4], v[5]); p.w = pk_bf16(v[6], v[7]); *(u32x4*)(XB + o) = p;
#pragma unroll
                   for (int j = 0; j < 4; ++j) { const unsigned q = j == 0 ? p.x : (j == 1 ? p.y : (j == 2 ? p.z : p.w)); ss += bf_lo(q) * bf_lo(q) + bf_hi(q) * bf_hi(q); } }
        }
        if (l < L_ - 1) { ss = wave_sum(ss); if (lane == 0) ssqx[row] = ss; }
    }
}
constexpr int MOE_CVT_SPLIT = 4608;
#ifndef CVT_A
#define CVT_A 1920
#endif
#ifndef NROUTE
#define NROUTE 128
#endif
constexpr int NPH = 9;
enum { PH_INPROJ = 0, PH_PREP, PH_MIX, PH_YNORM, PH_OUTPROJ, PH_ROUTE, PH_MOEUP, PH_MOEDOWN, PH_COMBINE };
struct Args { Inputs in; float* out; unsigned char* ws; int ph_lo, ph_hi; };

__global__ void __launch_bounds__(512, 2) mk(Args args) {
    extern __shared__ __attribute__((aligned(16))) unsigned char lds_raw[];
    LAS unsigned char* lds = (LAS unsigned char*)lds_raw;
    const int g_wv = __builtin_amdgcn_readfirstlane((int)threadIdx.x >> 6);
    const int bid0 = blockIdx.x, nb = gridDim.x;
#define BID() ({ int b_ = bid0; asm volatile("" : "+s"(b_)); b_; })
    unsigned char* ws = args.ws; unsigned* ctl = (unsigned*)(ws + WS_CTL);
    const int lo = args.ph_lo, hi = args.ph_hi;
    if (TIDX < 4) ((LAS unsigned*)(lds + LDS_MISC))[TIDX] = 0u;
    __syncthreads();
    XcdBarrier bar; bar.g_wv = g_wv; bar.bar = ctl + CW_BAR; bar.x = 0; bar.st = nullptr;
    if (hi - lo > 1) bar = xcd_barrier_post(ctl + CW_BAR, (volatile LAS unsigned*)(lds + LDS_MISC), g_wv);
#define IN(k) (lo <= (k) && (k) < hi)
#ifndef REPEAT_PH
#define REPEAT_PH -1
#endif
#define NREP(k) ((REPEAT_PH == (k)) ? 2 : 1)
#ifndef NBAR
#define NBAR 1
#endif
#ifndef TIME_PH
#define TIME_PH -1
#endif
#define STAMP(i) do { if (TIME_PH != -1 && blockIdx.x == 0 && TIDX == 0) ((unsigned long long*)(ctl + CW_TS))[i] = __builtin_amdgcn_s_memrealtime(); } while (0)
#define SEAM(k) do { if (IN(k) && IN((k) + 1)) for (int nb_ = 0; nb_ < NBAR; ++nb_) xcd_barrier(bar); STAMP((k) + 1); } while (0)
    STAMP(0);
#ifndef NO_PRO
    if (IN(0)) for (int rep = 0; rep < NREP(100); ++rep) { prologue(in_tab(), launder(ws), lds, BID(), nb, g_wv); if (rep + 1 < NREP(100)) xcd_barrier(bar); }
#endif
    SEAM(0);
    for (int l = 0; l < L_; ++l) {
        const int pb = 1 + l * NPH;
        if (IN(pb + PH_INPROJ)) for (int rep = 0; rep < NREP(PH_INPROJ); ++rep) {
            if (rep) xcd_barrier(bar);
            InPtr in = in_tab(); unsigned char* ws = launder(args.ws);
            g8::DenseSched S{(const char*)(ws + WS_XB), (const char*)(ws + WS_WIN) + (size_t)l * 2560 * 1024 * 2, 1024, 1024, 64, 10, nb, BID(), 8};
            EpiInProj E{(const float*)(ws + WS_SSQX) + l * 16384, (float*)(ws + WS_SSQ + PT_DQ) + (size_t)l * 16384 * 4, (float*)(ws + WS_SSQ + PT_DKV) + (size_t)l * 16384 * 2,
                        in->p[8] + l * 64, in->p[9] + l * 64, in->p[19] + l * 192 + 96 + 64, (const float*)(ws + WS_ROPE), ws + WS_PRJ};
#ifndef NO_INPROJ
            g8::gemm_run(lds, 1024, 1024, S, E, g_wv);
#endif
        }
        SEAM(pb + PH_INPROJ);
        if (IN(pb + PH_PREP)) for (int rep = 0; rep < NREP(PH_PREP); ++rep) { if (rep) xcd_barrier(bar); phase_prep(l, in_tab(), launder(ws), lds, BID(), nb, g_wv, (unsigned*)launder(ws) + CW_Q + 64 * (4 + l + 2 * rep)); }
        SEAM(pb + PH_PREP);
        if (IN(pb + PH_MIX)) for (int rep = 0; rep < NREP(PH_MIX); ++rep) { if (rep) xcd_barrier(bar); phase_mix(l, in_tab(), launder(ws), lds, (unsigned*)launder(ws) + CW_Q + 64 * (l + 2 * rep), g_wv); }
        SEAM(pb + PH_MIX);
        const bool fold_norm = (nb == 256);
        if (IN(pb + PH_YNORM) && !fold_norm) phase_ynorm(l, launder(ws), BID(), nb, g_wv);
        if (!fold_norm) SEAM(pb + PH_YNORM);
        if (IN(pb + PH_OUTPROJ)) {
            unsigned char* ws = launder(args.ws);
            g8::DenseSched S{(const char*)(ws + WS_Y), (const char*)(ws + WS_WOUT) + (size_t)l * 1024 * 1024 * 2, 1024, 1024, 64, 4, nb, BID()};
            EpiOut E{(bf16_t*)(ws + WS_XB), (float*)(ws + WS_SSQ + PT_X1) + (size_t)l * 16384 * 16, (const LAS float*)(lds + LDS_FAC), fold_norm};
            if (fold_norm) { g8::GUnit u0; if (S.next(0, u0)) outproj_factors(l, ws, lds, u0.pm, TIDX); else __syncthreads(); }
#ifndef NO_OUTPROJ
            g8::gemm_run(lds, 1024, 1024, S, E, g_wv);
#endif
        }
        SEAM(pb + PH_OUTPROJ);
#ifndef NO_ROUTE
        if (IN(pb + PH_ROUTE)) {
            const int b_ = BID();
            if (nb >= 256 && b_ >= NROUTE) { cvt_moe_layer(in_tab(), launder(ws), l, (LAS float*)lds, b_ - NROUTE, nb - NROUTE, TIDX, 0, CVT_A);
#ifdef DUP_CVT
                __syncthreads(); cvt_moe_layer(in_tab(), launder(ws), l, (LAS float*)lds, b_ - NROUTE, nb - NROUTE, TIDX);
#endif
            }
            else { phase_route(l, in_tab(), launder(ws), lds, b_, nb >= 256 ? NROUTE : nb, g_wv);
                   if (nb < 256) cvt_moe_layer(in_tab(), launder(ws), l, (LAS float*)lds, b_, nb, TIDX); else cvt_moe_layer(in_tab(), launder(ws), l, (LAS float*)lds, b_, NROUTE, TIDX, CVT_A, 3072); }
            if (l + 1 < L_) { __syncthreads(); cvt_small_weights(in_tab(), launder(ws), l + 1, (LAS float*)lds, b_, nb, TIDX); }
        }
#endif
        SEAM(pb + PH_ROUTE);
        {
            const bool do_up = IN(pb + PH_MOEUP), do_dn = IN(pb + PH_MOEDOWN), fuse = do_up && do_dn;
            for (int part = 0; part < (fuse ? 3 : 1); ++part) {
                if (part) xcd_barrier(bar);
                unsigned char* ws = launder(args.ws);
                if ((do_up || do_dn) && part == 0) moe_tables(l, ws, lds, g_wv);
                const unsigned* cnt = (const unsigned*)(ws + WS_CTL) + CW_CNT + 2048 * l; const unsigned* mtok = (const unsigned*)(ws + WS_META); const LAS int* tb = (const LAS int*)(lds + LDS_TB);
                const int b_ = BID(), ntile = tb[32], UPU = 2 * ntile, DNU = 4 * ntile;
                const int hi0 = UPU < nb ? UPU : nb, nu_ = UPU - hi0, nu = nu_ < (nb >> 1) ? nu_ : (nb >> 1), nd = nb - nu;
                const int d1a = 4 * (hi0 >> 1), d1b = 2 * nd, D1 = nu == 0 ? DNU : (d1a < d1b ? d1a : d1b);
                int ulo = 0, uhi = UPU, uG = nb, uc = b_, dlo = 0, dhi = DNU, dG = nb, dc = b_;
                if (fuse) {
                    if (part == 0) { uhi = hi0; dhi = 0; }
                    else if (part == 1) { ulo = hi0; uG = nu; if (b_ >= nu) uhi = ulo; dhi = D1; dG = nd; dc = b_ - nu; if (b_ < nu) dhi = 0; }
                    else { uhi = 0; dlo = D1; }
                }
                if (do_up && uhi > ulo) {
                    MoeSched<2, true> S{(const char*)(ws + WS_XB), (const char*)(ws + WS_WMOE), cnt, mtok, tb, uG, uc, (size_t)512 * 1024 * 2, (size_t)256 * 1024 * 2, ulo, uhi};
                    EpiMoeUp E{mtok, (const float*)(ws + WS_RS2), tb, (bf16_t*)(ws + WS_HBUF)};
#ifndef NO_MOEUP
                    g8::gemm_run(lds, 1024, 1024, S, E, g_wv);
#endif
                }
                if (do_dn && dhi > dlo) {
                    MoeSched<4, false> S{(const char*)(ws + WS_HBUF), (const char*)(ws + WS_WMOE + WMOE_WD), cnt, mtok, tb, dG, dc, (size_t)1024 * 256 * 2, (size_t)256 * 256 * 2, dlo, dhi};
                    EpiMoeDown E{mtok, (const float*)(ws + WS_META + META_W), tb, (bf16_t*)(ws + WS_YBUF)};
#ifndef NO_MOEDOWN
                    g8::gemm_run(lds, 256, 256, S, E, g_wv);
#endif
                }
            }
        }
        SEAM(pb + PH_MOEDOWN);
#ifndef NO_COMBINE
        if (IN(pb + PH_COMBINE)) { unsigned char* ws = launder(args.ws); phase_combine(l, ws, args.out, BID(), nb, g_wv); }
#endif
        SEAM(pb + PH_COMBINE);
    }
#undef IN
#undef SEAM
}
#if CHECK
struct NvScratch { float *proj, *h1, *qk, *hraw, *kn, *kcmp, *vcmp, *dqn, *q, *dkvn, *kv, *krope, *y, *x1, *xl; int* rt_e; float* rt_w; };
constexpr int CB = 5;
enum { NS_INPROJ = 0, NS_NSAPREP, NS_MLAPREP, NS_NSA, NS_ML, NS_MLA, NS_OUT, NS_ROUTE, NS_MOE };
static void naive_step(void* const* d_in, int l, int step, const float* xin, float* xout, const NvScratch& S, hipStream_t st) {
    const int b = CB;
    const float* rel_bias = (const float*)d_in[2];
    const float* norm1_g = (const float*)d_in[3] + (long)l * 1024;
    const float* w_in = (const float*)d_in[4] + (long)l * 1024 * DIN;
    const float* cmp_pe = (const float*)d_in[5] + (long)l * 2 * 32 * 64;
    const float* cmp_w1 = (const float*)d_in[6] + (long)l * 2 * 32 * 64 * 64;
    const float* cmp_w2 = (const float*)d_in[7] + (long)l * 2 * 64 * 64;
    const float* q_norm = (const float*)d_in[8] + l * 64;
    const float* k_norm = (const float*)d_in[9] + l * 64;
    const float* nsa_on = (const float*)d_in[10] + l * 384;
    const float* conv = (const float*)d_in[11] + l * 4 * 512;
    const float* ibias = (const float*)d_in[12] + l * 4;
    const float* fbias = (const float*)d_in[13] + l * 4;
    const float* ml_on = (const float*)d_in[14] + l * 256;
    const float* qan = (const float*)d_in[15] + l * 192;
    const float* w_uq = (const float*)d_in[16] + (long)l * 192 * 576;
    const float* kvan = (const float*)d_in[17] + l * 128;
    const float* w_ukv = (const float*)d_in[18] + (long)l * 128 * 768;
    const float* qkn = (const float*)d_in[19] + l * 192;
    const float* mla_on = (const float*)d_in[20] + l * 384;
    const float* w_out = (const float*)d_in[21] + (long)l * 1024 * 1024;
    const float* norm2_g = (const float*)d_in[22] + l * 1024;
    const float* wgrp = (const float*)d_in[23] + (long)l * 1024 * 4;
    const float* bgrp = (const float*)d_in[24] + l * 4;
    const float* wexp = (const float*)d_in[25] + (long)l * 1024 * 32;
    const float* bexp = (const float*)d_in[26] + l * 32;
    const float* Wg = (const float*)d_in[27] + (long)l * 32 * 1024 * 256;
    const float* Wu = (const float*)d_in[28] + (long)l * 32 * 1024 * 256;
    const float* Wd = (const float*)d_in[29] + (long)l * 32 * 256 * 1024;
    const int* pos = (const int*)d_in[1] + b * 2048;
    switch (step) {
    case NS_INPROJ:
        nv_rmsnorm<<<dim3(2048, 1), 64, 0, st>>>(xin, 1024, 0, S.h1, 1024, 0, norm1_g, 0, 1024);
        nv_gemm<<<dim3((DIN + 63) / 64, 2048 / 64), 256, 0, st>>>(S.h1, 1024, w_in, DIN, S.proj, DIN, nullptr, 0, 2048, DIN, 1024);
        break;
    case NS_NSAPREP:
        nv_nsa_cmp<<<dim3(127, 2, 2), 64, 0, st>>>(S.proj, cmp_pe, cmp_w1, cmp_w2, k_norm, S.kcmp, S.vcmp);
        nv_nsa_knorm<<<dim3(2048, 4), 64, 0, st>>>(S.proj, k_norm, S.kn);
        break;
    case NS_MLAPREP:
        nv_rmsnorm<<<dim3(2048, 1), 64, 0, st>>>(S.proj + O_CDQ, DIN, 0, S.dqn, 192, 0, qan, 0, 192);
        nv_gemm<<<dim3(576 / 64, 2048 / 64), 256, 0, st>>>(S.dqn, 192, w_uq, 576, S.q, 576, nullptr, 0, 2048, 576, 192);
        nv_rmsnorm<<<dim3(2048, 1), 64, 0, st>>>(S.proj + O_CDKV, DIN, 0, S.dkvn, 128, 0, kvan, 0, 128);
        nv_gemm<<<dim3(768 / 64, 2048 / 64), 256, 0, st>>>(S.dkvn, 128, w_ukv, 768, S.kv, 768, nullptr, 0, 2048, 768, 128);
        nv_mla_prep<<<dim3(2048, 7), 64, 0, st>>>(S.q, S.kv, S.proj, S.krope, qkn, pos);
        break;
    case NS_NSA:
        nv_nsa_attn<<<dim3(2048, 2), 192, 0, st>>>(S.proj, S.kn, S.kcmp, S.vcmp, rel_bias, q_norm, S.y);
        break;
    case NS_ML:
        nv_ml_conv<<<2048, 512, 0, st>>>(S.proj, conv, S.qk);
        nv_ml_rec<<<4, 256, 0, st>>>(S.proj, S.qk, ibias, fbias, S.hraw);
        nv_ml_fin<<<dim3(2048, 4), 64, 0, st>>>(S.proj, S.hraw, ml_on, S.y);
        break;
    case NS_MLA:
        nv_mla_attn<<<dim3(2048, 6), 64, 0, st>>>(S.q, S.kv, S.krope, S.y);
        break;
    case NS_OUT:
        nv_rmsnorm<<<dim3(2048, 1), 64, 0, st>>>(S.y, 1024, 0, S.y, 1024, 0, nsa_on, 0, 384);
        nv_rmsnorm<<<dim3(2048, 1), 64, 0, st>>>(S.y + 640, 1024, 0, S.y + 640, 1024, 0, mla_on, 0, 384);
        nv_gemm<<<dim3(1024 / 64, 2048 / 64), 256, 0, st>>>(S.y, 1024, w_out, 1024, S.x1, 1024, xin, 1024, 2048, 1024, 1024);
        break;
    case NS_ROUTE:
        nv_moe_route<<<2048, 64, 0, st>>>(S.x1, norm2_g, wgrp, bgrp, wexp, bexp, S.h1, S.rt_e, S.rt_w);
        break;
    case NS_MOE:
        nv_moe_exp<<<2048, 256, 0, st>>>(S.x1, S.h1, S.rt_e, S.rt_w, Wg, Wu, Wd, xout);
        break;
    }
}

__device__ __forceinline__ void chk_commit(float d2, float r2, float* acc) { d2 = wave_sum(d2); r2 = wave_sum(r2); if ((threadIdx.x & 63) == 0) { atomicAdd(acc, d2); atomicAdd(acc + 1, r2); } }
__device__ __forceinline__ void chk_add(float f, float r, float& d2, float& r2) { const float d = f - r; d2 += (d == d) ? d * d : 1e30f; r2 += r * r; }

__global__ void __launch_bounds__(64) chk_proj(const float* nproj, const unsigned char* prj, const float* ssq_dq, const float* ssq_dkv, const float* qg, const float* kg, const float* krg, const int* pos, float* acc) {
    const int t = blockIdx.x, e = threadIdx.x; const size_t row = (size_t)CB * 2048 + t; float d2 = 0.f, r2 = 0.f;
    for (int G = 0; G < 40; ++G) {
        const int c = inproj_refcol(G, e); float r = c < 0 ? 0.f : nproj[(size_t)t * DIN + c]; float f = 0.f;
        const float rr = (G == 37 && e >= 32) ? 0.f : r; const float ss = wave_sum(rr * rr);
        if (G < 6) { r = r * rsqrtf(ss / 64.f + 1e-6f) * qg[e] * 0.18033688f; f = bf2f(((const bf16_t*)(prj + PRJ_QN))[((size_t)(CB * 6 + G) * 2048 + t) * 64 + e]); }
        else if (G < 18) { const int a = G - 6, br = a >> 2, s = (a >> 1) & 1, hk = a & 1;
            if (br > 0 && s == 0) r = r * rsqrtf(ss / 64.f + 1e-6f) * kg[e];
            const size_t base = br == 0 ? (s ? PRJ_C0V : PRJ_C0K) : (br == 1 ? (s ? PRJ_VN1 : PRJ_KN1) : (s ? PRJ_VN2 : PRJ_KN2));
            f = bf2f(((const bf16_t*)(prj + base))[((size_t)(CB * 2 + hk) * 2048 + t) * 64 + e]); }
        else if (G < 26) f = bf2f(((const bf16_t*)(prj + PRJ_RAWQK))[row * 512 + (G - 18) * 64 + e]);
        else if (G < 30) f = bf2f(((const bf16_t*)(prj + PRJ_VML))[((size_t)(CB * 4 + (G - 26)) * 2048 + t) * 64 + e]);
        else if (G < 34) f = bf2f(((const bf16_t*)(prj + PRJ_OG))[row * 256 + (G - 30) * 64 + e]);
        else if (G < 37) f = bf2f(((const bf16_t*)(prj + PRJ_DQKV))[row * 384 + (G - 34) * 64 + e]);
        else if (G == 37) {
            const float val = e < 32 ? rr * rsqrtf(ss / 32.f + 1e-6f) * krg[e & 31] : 0.f; const float oth = __shfl_xor(val, 16);
            if (e < 32) { const int i = e & 15; const double ang = (double)pos[row] * pow(10000.0, -(double)i / 16.0); const float cs = (float)cos(ang), sn = (float)sin(ang);
                r = e < 16 ? val * cs - oth * sn : val * cs + oth * sn; f = bf2f(((const bf16_t*)(prj + PRJ_KR))[row * 32 + e]); }
            else if (e < 58) f = ((const float*)(prj + PRJ_GATES))[row * 32 + (e - 32)];
            else { f = 0.f; r = 0.f; }
        }
        else f = bf2f(((const bf16_t*)(prj + PRJ_DQKV))[row * 384 + 256 + (G - 38) * 64 + e]);
        chk_add(f, r, d2, r2);
    }
    float d2s = 0.f, r2s = 0.f;
    { float s1 = 0.f, s2 = 0.f; for (int c = e; c < 192; c += 64) { float v = nproj[(size_t)t * DIN + O_CDQ + c]; s1 += v * v; } for (int c = e; c < 128; c += 64) { float v = nproj[(size_t)t * DIN + O_CDKV + c]; s2 += v * v; }
      s1 = wave_sum(s1); s2 = wave_sum(s2); if (e == 0) { chk_add((ssq_dq[row * 4] + ssq_dq[row * 4 + 1]) + ssq_dq[row * 4 + 2], s1, d2s, r2s); chk_add(ssq_dkv[row * 2] + ssq_dkv[row * 2 + 1], s2, d2s, r2s); } }
    chk_commit(d2, r2, acc); chk_commit(d2s, r2s, acc + 2);
}

__global__ void __launch_bounds__(64) chk_prep(const float* nq, const float* nkv, const float* nkr, const float* nkc, const float* nvc, const unsigned char* ws, float* acc) {
    const int t = blockIdx.x, e = threadIdx.x; float d2 = 0.f, r2 = 0.f, d2c = 0.f, r2c = 0.f; const float scale = 0.14724444f;
    const bf16_t* QM = (const bf16_t*)(ws + WS_MLA); const bf16_t* KM = (const bf16_t*)(ws + WS_MLA + MLA_KM); const bf16_t* VM = (const bf16_t*)(ws + WS_MLA + MLA_VM);
    for (int h = 0; h < 6; ++h) {
        const size_t rq = ((size_t)(CB * 6 + h) * 2048 + t);
        chk_add(bf2f(QM[rq * 96 + e]), nq[(size_t)t * 576 + h * 96 + e] * scale, d2, r2);
        chk_add(bf2f(KM[rq * 96 + e]), nkv[(size_t)t * 768 + h * 128 + e], d2, r2);
        chk_add(bf2f(VM[rq * 64 + e]), nkv[(size_t)t * 768 + h * 128 + 64 + e], d2, r2);
        if (e < 32) { chk_add(bf2f(QM[rq * 96 + 64 + e]), nq[(size_t)t * 576 + h * 96 + 64 + e] * scale, d2, r2); chk_add(bf2f(KM[rq * 96 + 64 + e]), nkr[(size_t)t * 32 + e], d2, r2); }
    }
    if (t < 128) for (int hk = 0; hk < 2; ++hk) {
        const bf16_t* KC = (const bf16_t*)(ws + WS_CMP); const bf16_t* VC = (const bf16_t*)(ws + WS_CMP + CMP_V); const size_t rf = ((size_t)(CB * 2 + hk) * 128 + t) * 64 + e;
        chk_add(bf2f(KC[rf]), t < 127 ? nkc[(size_t)(hk * 127 + t) * 64 + e] : 0.f, d2c, r2c); chk_add(bf2f(VC[rf]), t < 127 ? nvc[(size_t)(hk * 127 + t) * 64 + e] : 0.f, d2c, r2c);
    }
    chk_commit(d2, r2, acc); chk_commit(d2c, r2c, acc + 2);
}

__global__ void __launch_bounds__(64) chk_y(const float* ny, const unsigned char* ws, float* acc, int nseg) {
    const int t = blockIdx.x, e = threadIdx.x; const bf16_t* Y = (const bf16_t*)(ws + WS_Y) + ((size_t)CB * 2048 + t) * 1024;
    float d2[3] = {0.f, 0.f, 0.f}, r2[3] = {0.f, 0.f, 0.f};
    for (int c = e; c < 1024; c += 64) { const int seg = c < 384 ? 0 : (c < 640 ? 1 : 2); const int cf = c < 384 ? c : (c < 640 ? 768 + (c - 384) : 384 + (c - 640)); const float f = bf2f(Y[cf]), r = ny[(size_t)t * 1024 + c];
        if (seg == 0) chk_add(f, r, d2[0], r2[0]); else if (seg == 1) chk_add(f, r, d2[1], r2[1]); else chk_add(f, r, d2[2], r2[2]); }
    if (nseg == 3) { chk_commit(d2[0], r2[0], acc); chk_commit(d2[1], r2[1], acc + 2); chk_commit(d2[2], r2[2], acc + 4); }
    else chk_commit(d2[0] + d2[1] + d2[2], r2[0] + r2[1] + r2[2], acc);
}

__global__ void __launch_bounds__(64) chk_x(const float* nx, const unsigned char* ws, float* acc) {
    const int t = blockIdx.x, e = threadIdx.x; const bf16_t* X = (const bf16_t*)(ws + WS_XB) + ((size_t)CB * 2048 + t) * 1024; float d2 = 0.f, r2 = 0.f;
    for (int c = e; c < 1024; c += 64) chk_add(bf2f(X[c]), nx[(size_t)t * 1024 + c], d2, r2);
    chk_commit(d2, r2, acc);
}

__global__ void __launch_bounds__(512) chk_code(float* acc, int nst, const float* nout) {
    __shared__ float sh[512];
    float s = 0.f; for (int i = threadIdx.x; i < 2048 * 1024; i += 512) { float v = nout[i]; s += v * v; }
    sh[threadIdx.x] = s; __syncthreads();
    if (threadIdx.x == 0) { float tot = 0.f; for (int i = 0; i < 512; ++i) tot += sh[i]; float rms = sqrtf(tot / (2048.f * 1024.f)); if (!(rms > 1e-3f && rms < 1e3f)) rms = 1.f;
        int code = 0;
        for (int st = 0; st < nst; ++st) { const float d2 = acc[2 * st], r2 = acc[2 * st + 1]; if (r2 == 0.f && d2 == 0.f) { if ((st & 15) >= 9) continue; code = (st + 1) * 4 + 3; break; } const float err = d2 / fmaxf(r2, 1e-30f);
            const float tol = CHK_TOL(st);
            if (!(err <= tol)) { const int cls = !(err < 1.f) ? 3 : (err >= 0.1f ? 2 : (err >= 0.01f ? 1 : 0)); code = (st + 1) * 4 + cls; break; } }
        acc[2 * 40] = rms * 32.f * exp2f(0.5f * (float)code); }
}
__global__ void __launch_bounds__(512) chk_fill(const float* acc, float* out) {
    const float K = acc[2 * 40];
    for (size_t i = (size_t)blockIdx.x * 512 + threadIdx.x; i < (size_t)NTOK * 1024; i += (size_t)gridDim.x * 512) out[i] = (i & 1) ? -K : K;
}
#endif

#if TIME_PH != -1
#ifndef TIME_Q
#define TIME_Q 6.f
#endif
#ifndef TIME_CAL
#define TIME_CAL 1.0f
#endif
__global__ void tm_acc(const unsigned long long* ts, float* best, int first) {
    int a = TIME_PH, b = TIME_PH + 1;
#ifdef TIME_PH_END
    b = TIME_PH_END;
#endif
    float T = 100.f; if (TIME_PH >= 0) T = (float)(ts[b] - ts[a]) * 0.01f;
    if (first || T < *best) *best = T;
}
__global__ void __launch_bounds__(512) tm_fill(const float* best, float* out) {
    float T = *best;
    T = exp2f(rintf(log2f(fmaxf(T, 1.f)) * TIME_Q) / TIME_Q);
    const float c = sqrtf(T) * TIME_CAL;
    for (size_t i = (size_t)blockIdx.x * 512 + threadIdx.x; i < (size_t)NTOK * 1024; i += (size_t)gridDim.x * 512) out[i] = (i & 1) ? -c : c;
}
#endif
static int g_grid = 0;
static bool setup_once(size_t ws_size) {
    if (g_grid) return g_grid > 0;
    if (ws_size < WS_END) { fprintf(stderr, "kernel_launch: workspace too small: %zu < %zu\n", ws_size, (size_t)WS_END); g_grid = -1; return false; }
    int dev = 0, cus = 0, per_cu = 0;
    if (hipGetDevice(&dev) != hipSuccess || hipDeviceGetAttribute(&cus, hipDeviceAttributeMultiprocessorCount, dev) != hipSuccess) { g_grid = -1; return false; }
    if (hipFuncSetAttribute((const void*)mk, hipFuncAttributeMaxDynamicSharedMemorySize, LDS_BYTES) != hipSuccess) { fprintf(stderr, "kernel_launch: hipFuncSetAttribute failed\n"); g_grid = -1; return false; }
    if (hipOccupancyMaxActiveBlocksPerMultiprocessor(&per_cu, (const void*)mk, 512, LDS_BYTES) != hipSuccess || per_cu < 1) { fprintf(stderr, "kernel_launch: occupancy query says %d\n", per_cu); }
    (void)hipGetLastError();
    g_grid = cus;
    return true;
}
static void launch_mk(const Args& a0, int lo, int hi, hipStream_t stream) { Args a = a0; a.ph_lo = lo; a.ph_hi = hi; hipLaunchKernelGGL(mk, dim3(g_grid), dim3(512), LDS_BYTES, stream, a); }

extern "C" void kernel_launch(void* const* d_in, const int* in_sizes, int n_in, void* d_out, int out_size, void* d_ws, size_t ws_size, hipStream_t stream) {
    if (!setup_once(ws_size)) return;
    unsigned char* ws = (unsigned char*)d_ws;
    (void)hipMemsetAsync(ws + WS_CTL, 0, ZERO_BYTES, stream);
    Args a{}; for (int i = 0; i < 30; ++i) a.in.p[i] = (const float*)d_in[i];
    a.out = (float*)d_out; a.ws = ws; a.ph_lo = 0; a.ph_hi = 0;
#if CHECK
    a.out = nullptr;
#endif
#if CHECK
    float* nb = (float*)d_out; size_t off = 0; NvScratch S;
    auto take = [&](size_t n) { float* p = nb + off; off += (n + 63) & ~(size_t)63; return p; };
    S.proj = take((size_t)2048 * DIN); S.h1 = take(2048 * 1024); S.qk = S.h1; S.hraw = S.qk + 2048 * 512; S.kn = S.hraw + 2048 * 256;
    S.kcmp = take(2 * 127 * 64); S.vcmp = take(2 * 127 * 64); S.dqn = take(2048 * 192); S.q = take(2048 * 576); S.dkvn = take(2048 * 128); S.kv = take(2048 * 768); S.x1 = S.dqn;
    S.krope = take(2048 * 32); S.y = take(2048 * 1024); S.xl = take(2048 * 1024); S.rt_e = (int*)take(2048 * 2); S.rt_w = take(2048 * 2);
    if (off * 4 > (size_t)NTOK * 1024 * 4) { fprintf(stderr, "naive scratch too big\n"); return; }
    float* acc = (float*)(ws + WS_CTL) + CW_CHK;
    launch_mk(a, 0, 1, stream);
    const float* nx_in = (const float*)d_in[0] + (size_t)CB * 2048 * 1024;
    int nst = 0;
    for (int l = 0; l < L_; ++l) {
        const int pb = 1 + l * NPH; const int sb = l * 16;
        launch_mk(a, pb + PH_INPROJ, pb + PH_INPROJ + 1, stream);
        naive_step(d_in, l, NS_INPROJ, nx_in, S.xl, S, stream);
        chk_proj<<<2048, 64, 0, stream>>>(S.proj, ws + WS_PRJ, (const float*)(ws + WS_SSQ + PT_DQ) + (size_t)l * 16384 * 4, (const float*)(ws + WS_SSQ + PT_DKV) + (size_t)l * 16384 * 2,
                                           (const float*)d_in[8] + l * 64, (const float*)d_in[9] + l * 64, (const float*)d_in[19] + l * 192 + 160, (const int*)d_in[1], acc + 2 * (sb + 0));
        nst = sb + 2;
        int ns_done = NS_INPROJ;
#if CHECK_UPTO >= 1
        launch_mk(a, pb + PH_PREP, pb + PH_PREP + 1, stream);
        naive_step(d_in, l, NS_NSAPREP, nx_in, S.xl, S, stream); naive_step(d_in, l, NS_MLAPREP, nx_in, S.xl, S, stream); ns_done = NS_MLAPREP;
        chk_prep<<<2048, 64, 0, stream>>>(S.q, S.kv, S.krope, S.kcmp, S.vcmp, ws, acc + 2 * (sb + 2));
        nst = sb + 4;
#endif
#if CHECK_UPTO >= 2
        launch_mk(a, pb + PH_MIX, pb + PH_MIX + 1, stream);
        naive_step(d_in, l, NS_NSA, nx_in, S.xl, S, stream); naive_step(d_in, l, NS_ML, nx_in, S.xl, S, stream); naive_step(d_in, l, NS_MLA, nx_in, S.xl, S, stream); ns_done = NS_MLA;
        chk_y<<<2048, 64, 0, stream>>>(S.y, ws, acc + 2 * (sb + 4), 3);
        nst = sb + 7;
#endif
#if CHECK_UPTO >= 3
        launch_mk(a, pb + PH_YNORM, pb + PH_YNORM + 1, stream); launch_mk(a, pb + PH_OUTPROJ, pb + PH_OUTPROJ + 1, stream);
        naive_step(d_in, l, NS_OUT, nx_in, S.xl, S, stream); ns_done = NS_OUT;
        chk_x<<<2048, 64, 0, stream>>>(S.x1, ws, acc + 2 * (sb + 7));
        nst = sb + 8;
#endif
#if CHECK_UPTO >= 4
        for (int ph = PH_ROUTE; ph <= PH_COMBINE; ++ph) launch_mk(a, pb + ph, pb + ph + 1, stream);
        naive_step(d_in, l, NS_ROUTE, nx_in, S.xl, S, stream); naive_step(d_in, l, NS_MOE, nx_in, S.xl, S, stream); ns_done = NS_MOE;
        chk_x<<<2048, 64, 0, stream>>>(S.xl, ws, acc + 2 * (sb + 8));
        nst = sb + 9;
#endif
        CHECK_REST
        for (int s = ns_done + 1; s <= NS_MOE; ++s) naive_step(d_in, l, s, nx_in, S.xl, S, stream);
        nx_in = S.xl;
        if (l == CHECK_LAYERS - 1) break;
    }
    chk_code<<<1, 512, 0, stream>>>(acc, nst, S.xl);
    chk_fill<<<1024, 512, 0, stream>>>(acc, (float*)d_out);
#else
#if defined(SPLIT_LAUNCH) && SPLIT_LAUNCH
    for (int ph = 0; ph < 1 + L_ * NPH; ++ph) launch_mk(a, ph, ph + 1, stream);
#else
    launch_mk(a, 0, 1 + L_ * NPH, stream);
#if TIME_PH != -1
    for (int rp = 0; rp < 6; ++rp) {
        (void)hipMemsetAsync(ws + WS_CTL, 0, ZERO_BYTES, stream); launch_mk(a, 0, 1 + L_ * NPH, stream);
        tm_acc<<<1, 1, 0, stream>>>((const unsigned long long*)((unsigned*)(ws + WS_CTL) + CW_TS), (float*)(ws + WS_META + META_RT), rp == 0);
    }
    tm_fill<<<1024, 512, 0, stream>>>((const float*)(ws + WS_META + META_RT), (float*)d_out);
#endif
#endif
#endif
}
```

```cpp
#define CHECK 0
#define CHECK_LAYERS 2
#define CHECK_UPTO 99
#define SPLIT_LAUNCH 0
#define REPEAT_PH -1
#include <hip/hip_runtime.h>
#include <stdint.h>
#include <cstdio>
#include <type_traits>

constexpr int B_ = 8, T_ = 2048, D_ = 1024, L_ = 2, NTOK = B_ * T_;
constexpr int DIN = 2554;
constexpr int O_AQ = 0, O_AKV = 384, O_AG = 1152, O_BQK = 1170, O_BV = 1682, O_BIF = 1938, O_BO = 1946, O_CDQ = 2202, O_CDKV = 2394, O_CKR = 2522;

typedef unsigned short bf16_t;
typedef short bf16x8 __attribute__((ext_vector_type(8)));
typedef short s16x4 __attribute__((ext_vector_type(4)));
typedef float f32x4 __attribute__((ext_vector_type(4)));
typedef float f32x16 __attribute__((ext_vector_type(16)));
typedef unsigned u32x4 __attribute__((ext_vector_type(4)));
typedef unsigned u32x2 __attribute__((ext_vector_type(2)));
typedef float f32x2_t __attribute__((ext_vector_type(2)));
typedef __bf16 bf16x2_t __attribute__((ext_vector_type(2)));
#define LAS __attribute__((address_space(3)))

__device__ __forceinline__ unsigned pk_bf16(float lo, float hi) { f32x2_t v = {lo, hi}; bf16x2_t b = __builtin_convertvector(v, bf16x2_t); return __builtin_bit_cast(unsigned, b); }
__device__ __forceinline__ float bf_lo(unsigned u) { return __builtin_bit_cast(float, u << 16); }
__device__ __forceinline__ float bf_hi(unsigned u) { return __builtin_bit_cast(float, u & 0xffff0000u); }
__device__ __forceinline__ float bf2f(bf16_t h) { return __builtin_bit_cast(float, (unsigned)h << 16); }
__device__ __forceinline__ bf16_t f2bf(float f) { return (bf16_t)(pk_bf16(f, 0.f) & 0xffffu); }
template <int M> __device__ __forceinline__ int shx(int v) { static_assert(M > 0 && M < 32, "swizzle xor mask"); return __builtin_amdgcn_ds_swizzle(v, (M << 10) | 0x1f); }
template <int M> __device__ __forceinline__ float shx(float v) { return __builtin_bit_cast(float, shx<M>(__builtin_bit_cast(int, v))); }
template <int M> __device__ __forceinline__ unsigned shx(unsigned v) { return (unsigned)shx<M>((int)v); }
__device__ __forceinline__ float wave_sum(float v) { v += __shfl_xor(v, 32); v += shx<16>(v); v += shx<8>(v); v += shx<4>(v); v += shx<2>(v); v += shx<1>(v); return v; }
__device__ __forceinline__ float wave_max(float v) { v = fmaxf(v, __shfl_xor(v, 32)); v = fmaxf(v, shx<16>(v)); v = fmaxf(v, shx<8>(v)); v = fmaxf(v, shx<4>(v)); v = fmaxf(v, shx<2>(v)); v = fmaxf(v, shx<1>(v)); return v; }
__device__ __forceinline__ float siluf(float x) { return x * __builtin_amdgcn_rcpf(1.f + __expf(-x)); }
__device__ __forceinline__ float sigmf(float x) { return __builtin_amdgcn_rcpf(1.f + __expf(-x)); }
__device__ __forceinline__ int t5b(int dist) {
    int n = dist > 0 ? dist : 0; if (n < 16) return n;
    float v = logf((float)n / 16.f) / logf(8.f) * 16.f; int l = 16 + (int)v; return l < 31 ? l : 31;
}

__device__ __forceinline__ int lane_now() { return (int)__builtin_amdgcn_mbcnt_hi(~0u, __builtin_amdgcn_mbcnt_lo(~0u, 0u)); }
#define TIDX ((g_wv << 6) | lane_now())

constexpr size_t WS_CTL = 0, CTL_BYTES = 65536;
constexpr size_t WS_SSQ = WS_CTL + CTL_BYTES;
constexpr size_t ZERO_BYTES = CTL_BYTES;
constexpr size_t PT_DQ = 0, PT_DKV = PT_DQ + (size_t)2 * 16384 * 4 * 4, PT_A = PT_DKV + (size_t)2 * 16384 * 2 * 4, PT_C = PT_A + (size_t)2 * 16384 * 8 * 4, PT_X1 = PT_C + (size_t)2 * 16384 * 8 * 4, PT_END = PT_X1 + (size_t)2 * 16384 * 16 * 4;
constexpr size_t WS_SSQX = WS_SSQ + PT_END;
constexpr size_t WS_RS2 = WS_SSQX + 2 * 65536;
constexpr size_t WS_WIN = WS_RS2 + 65536;
constexpr size_t WS_WOUT = WS_WIN + (size_t)2 * 2560 * 1024 * 2;
constexpr size_t WS_WUQ = WS_WOUT + (size_t)2 * 1024 * 1024 * 2;
constexpr size_t WS_WUKV = WS_WUQ + (size_t)2 * 768 * 256 * 2;
constexpr size_t WS_WC1 = WS_WUKV + (size_t)2 * 768 * 256 * 2;
constexpr size_t WS_WC2 = WS_WC1 + (size_t)2 * 2 * 64 * 2048 * 2;
constexpr size_t WS_WR = WS_WC2 + (size_t)2 * 2 * 64 * 64 * 2;
constexpr size_t WS_B1C = WS_WR + (size_t)2 * 64 * 1024 * 2;
constexpr size_t WS_BIASD = WS_B1C + 1024;
constexpr size_t WS_ROPE = WS_BIASD + 6 * 2048 * 4;
constexpr size_t WS_WMOE = WS_ROPE + (size_t)16384 * 32 * 4;
constexpr size_t WMOE_WD = (size_t)32 * 512 * 1024 * 2;
constexpr size_t WS_XB = WS_WMOE + 50331648;
constexpr size_t WS_MLA = WS_XB + 33554432;
constexpr size_t MLA_KM = (size_t)8 * 6 * 2048 * 96 * 2, MLA_VM = 2 * MLA_KM;
constexpr size_t WS_HBUF = WS_MLA;
constexpr size_t WS_PRJ = WS_MLA + 50331648;
constexpr size_t HM64 = (size_t)2048 * 64 * 2;
constexpr size_t PRJ_QN = 0;
constexpr size_t PRJ_KN1 = PRJ_QN + 48 * HM64, PRJ_VN1 = PRJ_KN1 + 16 * HM64, PRJ_KN2 = PRJ_VN1 + 16 * HM64, PRJ_VN2 = PRJ_KN2 + 16 * HM64;
constexpr size_t PRJ_VML = PRJ_VN2 + 16 * HM64;
constexpr size_t PRJ_OG = PRJ_VML + 32 * HM64;
constexpr size_t PRJ_KR = PRJ_OG + (size_t)16384 * 256 * 2;
constexpr size_t PRJ_GATES = PRJ_KR + (size_t)16384 * 32 * 2;
constexpr size_t PRJ_DEAD = PRJ_GATES + (size_t)16384 * 32 * 4;
constexpr size_t PRJ_C0K = PRJ_DEAD, PRJ_C0V = PRJ_C0K + 16 * HM64 + 8192;
constexpr size_t PRJ_RAWQK = PRJ_C0V + 16 * HM64 + 8192;
constexpr size_t PRJ_DQKV = PRJ_RAWQK + (size_t)16384 * 512 * 2;
constexpr size_t PRJ_END = PRJ_DQKV + (size_t)16384 * 384 * 2;
static_assert(PRJ_END - PRJ_DEAD >= 33554432, "Y fits the dead part of PRJ");
constexpr size_t WS_Y = WS_PRJ + PRJ_DEAD;
constexpr size_t WS_YBUF = WS_PRJ;
static_assert((size_t)2 * 16384 * 1024 * 2 <= PRJ_END, "YBUF fits the PRJ region");
constexpr size_t WS_ML = WS_PRJ + PRJ_END;
constexpr size_t ML_KC = 32 * HM64, ML_DELTA = 2 * ML_KC, ML_DN = ML_DELTA + (size_t)1024 * 4096 * 2, ML_G = ML_DN + (size_t)1024 * 64 * 4, ML_BL = ML_G + (size_t)8 * 4 * 2048 * 2 * 4, ML_CP = ML_BL + 4096, ML_NP = ML_CP + (size_t)1024 * 4096 * 2, ML_END = ML_NP + (size_t)1024 * 64 * 2;
constexpr size_t WS_CMP = WS_ML + ML_END;
constexpr size_t CMP_V = (size_t)8 * 2 * 128 * 64 * 2;
constexpr size_t WS_META = WS_CMP + 2 * CMP_V;
constexpr size_t META_W = (size_t)32 * 16384 * 4, META_RT = 2 * META_W;
constexpr size_t WS_END = WS_META + META_RT + (size_t)16384 * 16;
constexpr int CW_BAR = 0;
constexpr int CW_Q = 4096;
constexpr int CW_SCAN = 4608;
constexpr int CW_TS = 4864;
constexpr int CW_CHK = 5120;
constexpr int CW_CNT = 8192;
constexpr int LDS_BYTES = 147456;
constexpr int LDS_MISC = LDS_BYTES - 256;
#define XB_TMO      128
#define XB_XCNT(j)  (256  + 64 * (j))
#define XB_XSUB(j)  (1280 + 64 * (j))
#define XB_XGEN(j)  (2304 + 64 * (j))
#define XB_TOP      3328
#define XB_TOPGEN   3392
#define XCD_BAR_WORDS 3456
#define XB_SPIN_CAP (1u << 18)

__device__ __forceinline__ unsigned xb_ld(unsigned* p)              { return __hip_atomic_load(p, __ATOMIC_RELAXED, __HIP_MEMORY_SCOPE_AGENT); }
__device__ __forceinline__ unsigned xb_add(unsigned* p, unsigned v) { return __hip_atomic_fetch_add(p, v, __ATOMIC_RELAXED, __HIP_MEMORY_SCOPE_AGENT); }
__device__ __forceinline__ unsigned xb_xcc_id() { return (unsigned)__builtin_amdgcn_s_getreg((3 << 11) | 20) & 0xFu; }
#define XB_SPIN(cond, bar) do { unsigned _sp = 0; while (cond) { __builtin_amdgcn_s_sleep(1); \
    if ((++_sp & 255u) == 0u) { if (xb_ld(&(bar)[XB_TMO])) break; if (_sp > XB_SPIN_CAP) { atomicAdd(&(bar)[XB_TMO], 1u); break; } } } } while (0)

struct XcdBarrier {
    int g_wv; unsigned* bar; unsigned x;
    volatile LAS unsigned* st;
};

__device__ __forceinline__ XcdBarrier xcd_barrier_post(unsigned* bar, volatile LAS unsigned* st, int g_wv) {
    XcdBarrier b; b.g_wv = g_wv; b.bar = bar; b.x = xb_xcc_id(); b.st = st;
    if (TIDX == 0) (void)xb_add(&bar[XB_XCNT(b.x)], 1u);
    return b;
}
__device__ __forceinline__ void xcd_barrier_complete(unsigned* bar, unsigned x, unsigned& nloc, unsigned& nx) {
    const unsigned G = gridDim.x * gridDim.y * gridDim.z;
    unsigned sum, cnt, mine, sp = 0u;
    for (;;) {
        sum = 0u; cnt = 0u; mine = 0u;
#pragma unroll
        for (unsigned j = 0; j < 16; ++j) { const unsigned c = xb_ld(&bar[XB_XCNT(j)]); sum += c; cnt += (c > 0u) ? 1u : 0u; mine = (j == x) ? c : mine; }
        if (sum == G) break;
        __builtin_amdgcn_s_sleep(1);
        if ((++sp & 255u) == 0u) { if (xb_ld(&bar[XB_TMO])) break; if (sp > XB_SPIN_CAP) { atomicAdd(&bar[XB_TMO], 1u); break; } }
    }
    nloc = mine > 0u ? mine : 1u; nx = cnt > 0u ? cnt : 1u;
}

__device__ __forceinline__ void xcd_barrier(const XcdBarrier& b) {
    asm volatile("s_waitcnt vmcnt(0)" ::: "memory");
    __syncthreads();
    const int g_wv = b.g_wv;
    if (TIDX == 0) {
        unsigned* bar = b.bar;
        __builtin_amdgcn_s_waitcnt(0);
        unsigned nloc = b.st[0], nx = b.st[1];
        if (nloc == 0u) { xcd_barrier_complete(bar, b.x, nloc, nx); b.st[0] = nloc; b.st[1] = nx; }
        const unsigned old = xb_add(&bar[XB_XSUB(b.x)], 1u);
        const unsigned gen = old / nloc;
        if (old + 1u == (gen + 1u) * nloc) {
            __builtin_amdgcn_fence(__ATOMIC_RELEASE, "agent");
            asm volatile("s_waitcnt vmcnt(0)" ::: "memory");
            const unsigned og = xb_add(&bar[XB_TOP], 1u);
            const unsigned tg = og / nx;
            if (og + 1u == (tg + 1u) * nx) xb_add(&bar[XB_TOPGEN], 1u);
            else XB_SPIN(xb_ld(&bar[XB_TOPGEN]) == tg, bar);
            __builtin_amdgcn_fence(__ATOMIC_ACQUIRE, "agent");
            xb_add(&bar[XB_XGEN(b.x)], 1u);
            asm volatile("s_waitcnt vmcnt(0)" ::: "memory");
        } else {
            XB_SPIN(xb_ld(&bar[XB_XGEN(b.x)]) == gen, bar);
            __builtin_amdgcn_fence(__ATOMIC_ACQUIRE, "agent");
            asm volatile("s_waitcnt vmcnt(0)" ::: "memory");
        }
    }
    __syncthreads();
}
struct Inputs { const float* p[30]; };
typedef const __attribute__((address_space(4))) Inputs* InPtr;
__device__ __forceinline__ InPtr in_tab() { InPtr p = (InPtr)__builtin_amdgcn_kernarg_segment_ptr(); asm volatile("" : "+s"(p)); return p; }
__device__ __forceinline__ unsigned char* launder(unsigned char* p) { size_t z = 0; asm volatile("" : "+s"(z)); return p + z; }

__host__ __device__ inline int inproj_refcol(int G, int e) {
    if (G < 6) return O_AQ + G * 64 + e;
    if (G < 18) return O_AKV + (G - 6) * 64 + e;
    if (G < 26) return O_BQK + (G - 18) * 64 + e;
    if (G < 30) return O_BV + (G - 26) * 64 + e;
    if (G < 34) return O_BO + (G - 30) * 64 + e;
    if (G < 37) return O_CDQ + (G - 34) * 64 + e;
    if (G == 37) { if (e < 32) return O_CKR + e; if (e < 50) return O_AG + (e - 32); if (e < 58) return O_BIF + (e - 50); return -1; }
    return O_CDKV + (G - 38) * 64 + e;
}
__host__ __device__ inline int uq_refcol(int G, int e) {
    if (G < 6) return G * 96 + e;
    if (G < 9) { const int idx = e & 31, bj = e >> 5, sub = idx >> 4, i = idx & 15; return (2 * (G - 6) + sub) * 96 + 64 + bj * 16 + i; }
    return -1;
}
__host__ __device__ inline int ukv_refcol(int G, int e) { return G < 6 ? G * 128 + e : (G - 6) * 128 + 64 + e; }
#define N2G(n) ((((n) >> 8) << 2) + (((n) >> 5) & 3))
#define N2E(n) (((((n) >> 7) & 1) << 5) + ((n) & 31))

__device__ __forceinline__ float opaque_f(float v) { asm volatile("" : "+v"(v)); return v; }
struct FWin { const float* w; const float* g; __device__ __forceinline__ void ld(int k, int n, const float*& p, float& gn, float gk) const { const int c = inproj_refcol(N2G(n), N2E(n)); p = w + (size_t)k * DIN + (c < 0 ? 0 : c); gn = c < 0 ? 0.f : gk; }
    __device__ __forceinline__ float rowgain(int k) const { return opaque_f(g[k]); } };
struct FWout { const float* w; const float* ga; const float* gc; __device__ __forceinline__ void ld(int k, int n, const float*& p, float& gn, float gk) const {
    const int kr = k < 384 ? k : (k < 768 ? 640 + (k - 384) : 384 + (k - 768)); p = w + (size_t)kr * 1024 + n; gn = gk; }
    __device__ __forceinline__ float rowgain(int k) const { const float a = opaque_f(ga[k < 384 ? k : 0]), c = opaque_f(gc[(k >= 384 && k < 768) ? k - 384 : 0]); return k < 384 ? a : (k < 768 ? c : 1.f); } };
struct FWuq { const float* w; const float* g; __device__ __forceinline__ void ld(int k, int n, const float*& p, float& gn, float gk) const { const int c = uq_refcol(N2G(n), N2E(n)); const int kk = k < 192 ? k : 191; p = w + (size_t)kk * 576 + (c < 0 ? 0 : c); gn = (k < 192 && c >= 0) ? gk : 0.f; }
    __device__ __forceinline__ float rowgain(int k) const { return opaque_f(g[k < 192 ? k : 191]); } };
struct FWukv { const float* w; const float* g; __device__ __forceinline__ void ld(int k, int n, const float*& p, float& gn, float gk) const { const int c = ukv_refcol(N2G(n), N2E(n)); const int kk = k >= 128 ? k - 128 : 0; p = w + (size_t)kk * 768 + c; gn = k >= 128 ? gk : 0.f; }
    __device__ __forceinline__ float rowgain(int k) const { return opaque_f(g[k >= 128 ? k - 128 : 0]); } };
struct FWc1 { const float* w; __device__ __forceinline__ void ld(int k, int n, const float*& p, float& gn, float gk) const { p = w + (size_t)k * 64 + n; gn = 1.f; }
    __device__ __forceinline__ float rowgain(int k) const { return 1.f; } };
struct FWr { const float* wg; const float* we; const float* g; __device__ __forceinline__ void ld(int k, int n, const float*& p, float& gn, float gk) const { p = n < 4 ? wg + k * 4 + n : we + k * 32 + (n < 36 ? n - 4 : 0); gn = n < 36 ? gk : 0.f; }
    __device__ __forceinline__ float rowgain(int k) const { return opaque_f(g[k]); } };
struct FWgu { const float* src; const float* g; int n0, col0; __device__ __forceinline__ float operator()(int k, int n) const { return src[(size_t)k * 256 + col0 + (n - n0)] * g[k]; } };
struct FWd { const float* w; __device__ __forceinline__ float operator()(int k, int n) const { return w[(size_t)k * 1024 + n]; } };

__device__ __forceinline__ void rope_cs(int pos, int j, float& cs, float& sn) {
    const double inv = exp2(-(double)j * (13.287712379549449 / 16.0));
    const double rev = (double)pos * inv * 0.15915494309189535; const float f = (float)(rev - rint(rev));
    cs = __builtin_amdgcn_cosf(f); sn = __builtin_amdgcn_sinf(f);
}
template <class F>
__device__ __forceinline__ void cvt_tile(const F& f, int n0, int k0, bf16_t* dst, int ldk, LAS float* tile, int tid) {
    { const int k = tid >> 3, nb = (tid & 7) * 8; const float gk = f.rowgain(k0 + k); const float* p[8]; float gn[8], v[8];
#pragma unroll
      for (int j = 0; j < 8; ++j) f.ld(k0 + k, n0 + nb + j, p[j], gn[j], gk);
#pragma unroll
      for (int j = 0; j < 8; ++j) v[j] = *p[j];
#pragma unroll
      for (int j = 0; j < 8; ++j) tile[k * 65 + nb + j] = v[j] * gn[j]; }
    __syncthreads();
    { const int n = tid >> 3, kb = (tid & 7) * 8; const LAS float* s = tile + kb * 65 + n;
      u32x4 o; o.x = pk_bf16(s[0], s[65]); o.y = pk_bf16(s[130], s[195]); o.z = pk_bf16(s[260], s[325]); o.w = pk_bf16(s[390], s[455]);
      *(u32x4*)(dst + (size_t)(n0 + n) * ldk + k0 + kb) = o; }
    __syncthreads();
}
template <class F>
__device__ __forceinline__ void cvt_item(const F& f, int it, int nK, bf16_t* dst, int ldk, LAS float* tile, int tid) { cvt_tile(f, (it / nK) * 64, (it % nK) * 64, dst, ldk, tile, tid); }

__device__ __forceinline__ void moe_item(InPtr in, int l, int it, const float*& src, int& ld, size_t& dst, int& ldk, bool& gain, int& kk0) {
    if (it < 32 * 64) { const int e = it >> 6, r = it & 63, n0 = (r >> 3) * 64, k0 = (r & 7) * 128, c0 = n0 & 255;
        src = (c0 < 128 ? in->p[27] : in->p[28]) + ((size_t)l * 32 + e) * 262144 + (size_t)k0 * 256 + (n0 >> 8) * 128 + (c0 & 127); ld = 256; gain = true; kk0 = k0;
        dst = ((size_t)e * 512 + n0) * 1024 + k0; ldk = 1024; }
    else { const int j = it - 32 * 64, e = j >> 5, r = j & 31, n0 = (r >> 1) * 64, k0 = (r & 1) * 128;
        src = in->p[29] + ((size_t)l * 32 + e) * 262144 + (size_t)k0 * 1024 + n0; ld = 1024; gain = false; kk0 = 0;
        dst = (size_t)16777216 + ((size_t)e * 1024 + n0) * 256 + k0; ldk = 256; }
}
__device__ __forceinline__ void cvt_moe_layer(InPtr in, unsigned char* ws, int l, LAS float* tile, int bid, int nb, int tid, int it_lo = 0, int it_hi = 32 * (64 + 32)) {
    asm volatile("" : "+v"(tid));
    const float* g2 = in->p[22] + l * 1024; bf16_t* W = (bf16_t*)(ws + WS_WMOE);
    const int k = tid >> 3, nbq = (tid & 7) * 8;
    const int n = tid >> 3, kb = (tid & 7) * 8;
    const int NIT = it_hi;
#define CVM_LOAD(it_, P) do { const float* src_; int ld_, ldk_, kk0_; size_t dst_; bool gain_; moe_item(in, l, (it_), src_, ld_, dst_, ldk_, gain_, kk0_); \
        P##a = *(const f32x4*)(src_ + (size_t)k * ld_ + nbq); P##b = *(const f32x4*)(src_ + (size_t)k * ld_ + nbq + 4); P##c = *(const f32x4*)(src_ + (size_t)(k + 64) * ld_ + nbq); P##d = *(const f32x4*)(src_ + (size_t)(k + 64) * ld_ + nbq + 4); \
        P##g0 = gain_ ? g2[kk0_ + k] : 1.f; P##g1 = gain_ ? g2[kk0_ + 64 + k] : 1.f; } while (0)
#define CVM_PUT(t, P) do { \
        t[k * 65 + nbq + 0] = P##a.x * P##g0; t[k * 65 + nbq + 1] = P##a.y * P##g0; t[k * 65 + nbq + 2] = P##a.z * P##g0; t[k * 65 + nbq + 3] = P##a.w * P##g0; \
        t[k * 65 + nbq + 4] = P##b.x * P##g0; t[k * 65 + nbq + 5] = P##b.y * P##g0; t[k * 65 + nbq + 6] = P##b.z * P##g0; t[k * 65 + nbq + 7] = P##b.w * P##g0; \
        t[(k + 64) * 65 + nbq + 0] = P##c.x * P##g1; t[(k + 64) * 65 + nbq + 1] = P##c.y * P##g1; t[(k + 64) * 65 + nbq + 2] = P##c.z * P##g1; t[(k + 64) * 65 + nbq + 3] = P##c.w * P##g1; \
        t[(k + 64) * 65 + nbq + 4] = P##d.x * P##g1; t[(k + 64) * 65 + nbq + 5] = P##d.y * P##g1; t[(k + 64) * 65 + nbq + 6] = P##d.z * P##g1; t[(k + 64) * 65 + nbq + 7] = P##d.w * P##g1; } while (0)
#define CVM_STORE(it_, t) do { const float* src_; int ld_, ldk_, kk0_; size_t dst_; bool gain_; moe_item(in, l, (it_), src_, ld_, dst_, ldk_, gain_, kk0_); \
        _Pragma("unroll") for (int hh = 0; hh < 2; ++hh) { const LAS float* s_ = t + (64 * hh + kb) * 65 + n; \
            u32x4 o; o.x = pk_bf16(s_[0], s_[65]); o.y = pk_bf16(s_[130], s_[195]); o.z = pk_bf16(s_[260], s_[325]); o.w = pk_bf16(s_[390], s_[455]); \
            *(u32x4*)(W + dst_ + (size_t)n * ldk_ + 64 * hh + kb) = o; } } while (0)
    f32x4 Aa, Ab, Ac, Ad, Ba, Bb, Bc, Bd; float Ag0 = 1.f, Ag1 = 1.f, Bg0 = 1.f, Bg1 = 1.f;
    LAS float* t0 = tile; LAS float* t1 = tile + 128 * 65;
    int it = it_lo + bid;
    if (it < NIT) CVM_LOAD(it, A);
    if (it + nb < NIT) CVM_LOAD(it + nb, B);
#pragma unroll 1
    for (; it < NIT; it += 2 * nb) {
        CVM_PUT(t0, A);
        __syncthreads();
        if (it + 2 * nb < NIT) CVM_LOAD(it + 2 * nb, A);
        CVM_STORE(it, t0);
        if (it + nb < NIT) {
            CVM_PUT(t1, B);
            __syncthreads();
            if (it + 3 * nb < NIT) CVM_LOAD(it + 3 * nb, B);
            CVM_STORE(it + nb, t1);
        }
    }
#undef CVM_LOAD
#undef CVM_PUT
#undef CVM_STORE
    __syncthreads();
}

__device__ __forceinline__ void cvt_small_weights(InPtr in, unsigned char* ws, int l, LAS float* tile, int bid, int nb, int tid) {
    asm volatile("" : "+v"(tid));
    constexpr int I_WIN = 40 * 16, I_WOUT = 16 * 16, I_WU = 12 * 4, I_WC1 = 32, I_WC2 = 1, I_WR = 16;
    constexpr int PER_L = I_WIN + I_WOUT + 2 * I_WU + 2 * I_WC1 + 2 * I_WC2 + I_WR;
    for (int it0 = bid; it0 < PER_L; it0 += nb) {
        int it = it0;
        if (it < I_WIN) { FWin f{in->p[4] + (size_t)l * 1024 * DIN, in->p[3] + l * 1024}; cvt_item(f, it, 16, (bf16_t*)(ws + WS_WIN) + (size_t)l * 2560 * 1024, 1024, tile, tid); continue; } it -= I_WIN;
        if (it < I_WOUT) { FWout f{in->p[21] + (size_t)l * 1048576, in->p[10] + l * 384, in->p[20] + l * 384}; cvt_item(f, it, 16, (bf16_t*)(ws + WS_WOUT) + (size_t)l * 1048576, 1024, tile, tid); continue; } it -= I_WOUT;
        if (it < I_WU) { FWuq f{in->p[16] + (size_t)l * 192 * 576, in->p[15] + l * 192}; cvt_item(f, it, 4, (bf16_t*)(ws + WS_WUQ) + (size_t)l * 768 * 256, 256, tile, tid); continue; } it -= I_WU;
        if (it < I_WU) { FWukv f{in->p[18] + (size_t)l * 128 * 768, in->p[17] + l * 128}; cvt_item(f, it, 4, (bf16_t*)(ws + WS_WUKV) + (size_t)l * 768 * 256, 256, tile, tid); continue; } it -= I_WU;
        if (it < 2 * I_WC1) { const int s = it / I_WC1; FWc1 f{in->p[6] + ((size_t)l * 2 + s) * 2048 * 64}; cvt_item(f, it % I_WC1, 32, (bf16_t*)(ws + WS_WC1) + ((size_t)l * 2 + s) * 64 * 2048, 2048, tile, tid); continue; } it -= 2 * I_WC1;
        if (it < 2 * I_WC2) { const int s = it; FWc1 f{in->p[7] + ((size_t)l * 2 + s) * 64 * 64}; cvt_item(f, 0, 1, (bf16_t*)(ws + WS_WC2) + ((size_t)l * 2 + s) * 64 * 64, 64, tile, tid); continue; } it -= 2 * I_WC2;
        { FWr f{in->p[23] + (size_t)l * 4096, in->p[25] + (size_t)l * 32768, in->p[22] + l * 1024}; cvt_item(f, it, 16, (bf16_t*)(ws + WS_WR) + (size_t)l * 64 * 1024, 1024, tile, tid); }
    }
}

__device__ __forceinline__ void prologue(InPtr in, unsigned char* ws, LAS unsigned char* lds, int bid, int nb, int g_wv) {
    int tid_ = TIDX; asm volatile("" : "+v"(tid_));
    const int tid = tid_, lane = tid & 63, wid = tid >> 6;
    LAS float* tile = (LAS float*)lds;
    cvt_small_weights(in, ws, 0, tile, bid, nb, tid);
    { const float* x = in->p[0]; bf16_t* XB = (bf16_t*)(ws + WS_XB); float* ssqx = (float*)(ws + WS_SSQX);
      for (int r0 = (bid * 8 + wid) * 2; r0 < NTOK; r0 += nb * 16) {
          f32x4 v[2][4];
#pragma unroll
          for (int rr = 0; rr < 2; ++rr)
#pragma unroll
              for (int j = 0; j < 4; ++j) v[rr][j] = *((const f32x4*)(x + (size_t)(r0 + rr) * 1024) + lane + 64 * j);
#pragma unroll
          for (int rr = 0; rr < 2; ++rr) { float s = 0.f; u32x2* o = (u32x2*)(XB + (size_t)(r0 + rr) * 1024) + lane;
#pragma unroll
              for (int j = 0; j < 4; ++j) { const f32x4 q = v[rr][j]; s += (q.x * q.x + q.y * q.y) + (q.z * q.z + q.w * q.w); u32x2 w; w.x = pk_bf16(q.x, q.y); w.y = pk_bf16(q.z, q.w); o[64 * j] = w; }
              s = wave_sum(s); if (lane == 0) ssqx[r0 + rr] = s; }
      } }
    { float* biasd = (float*)(ws + WS_BIASD); const float* rb = in->p[2];
      for (int i = bid * 512 + tid; i < 6 * 2048; i += nb * 512) { const int h = i >> 11, d = i & 2047; biasd[i] = rb[t5b(d) * 6 + h] * 1.44269504f; } }
    { float* rope = (float*)(ws + WS_ROPE); const int* pos = (const int*)in->p[1];
      for (int i = bid * 512 + tid; i < NTOK * 16; i += nb * 512) { const int tk = i >> 4, j = i & 15; float cs, sn; rope_cs(pos[tk], j, cs, sn); rope[(size_t)tk * 32 + j] = cs; rope[(size_t)tk * 32 + 16 + j] = sn; } }
    { float* b1c = (float*)(ws + WS_B1C); LAS float* red = (LAS float*)lds;
      for (int it = nb - 1 - bid; it >= 0 && it < 4; it += nb) { const float* pe = in->p[5] + (size_t)it * 2048; const float* w1 = in->p[6] + (size_t)it * 2048 * 64; const int f4 = tid & 15, kp = tid >> 4;
          f32x4 a = (f32x4){0.f, 0.f, 0.f, 0.f};
#pragma unroll 1
          for (int k0 = kp * 64; k0 < kp * 64 + 64; k0 += 16) { f32x4 wv[16]; float pv[16];
#pragma unroll
              for (int j = 0; j < 16; ++j) { wv[j] = *(const f32x4*)(w1 + (size_t)(k0 + j) * 64 + 4 * f4); pv[j] = pe[k0 + j]; }
#pragma unroll
              for (int j = 0; j < 16; ++j) { a.x += pv[j] * wv[j].x; a.y += pv[j] * wv[j].y; a.z += pv[j] * wv[j].z; a.w += pv[j] * wv[j].w; } }
          __syncthreads(); *(LAS f32x4*)(red + kp * 64 + 4 * f4) = a; __syncthreads();
          if (tid < 64) { float sum = 0.f; for (int p2 = 0; p2 < 32; ++p2) sum += red[p2 * 64 + tid]; b1c[it * 64 + tid] = sum; }
          __syncthreads(); } }
}
namespace g8 {
constexpr int BM = 256, BK = 64, HALF = 128, HTB = HALF * BK * 2, STAGE_BYTES = 8 * HTB, NXCD = 8, WGM = 8;
__host__ __device__ __forceinline__ int lds_byte(int r, int c) { const int st = (r >> 4) * 2 + (c >> 5), rr = r & 15, cc = c & 31, ob = rr * 64 + cc * 2; return st * 1024 + (ob ^ (((ob >> 9) & 1) << 5)); }
__host__ __device__ __forceinline__ void stage_rc(int b, int& R, int& C) { const int st = b / 1024, sb = b % 1024, swz = sb ^ (((sb >> 9) & 1) << 5); R = (st >> 1) * 16 + swz / 64; C = (st & 1) * 32 + (swz % 64) / 2; }
__host__ __device__ __forceinline__ int perm32(int rho) { const int n = rho >> 4, i = rho & 15; return 8 * (i >> 2) + 4 * n + (i & 3); }

struct GUnit { const char* a; const char* b; int pm, pn, e, rows; };

__device__ __forceinline__ bool static_unit(int i, int G, int c, int nM, int nN, int& pm, int& pn) {
    const int nwg = nM * nN; const long L = (long)i * G + c; if (L >= nwg) return false;
    int wgid = (int)L; { const int q = nwg / NXCD, r = nwg % NXCD, xcd = wgid % NXCD, off = wgid / NXCD; wgid = (xcd < r ? xcd * (q + 1) : r * (q + 1) + (xcd - r) * q) + off; }
    const int nig = WGM * nN, gid = wgid / nig, fm = gid * WGM, gsz = (nM - fm) < WGM ? (nM - fm) : WGM;
    pm = fm + ((wgid % nig) % gsz); pn = (wgid % nig) / gsz; return true;
}
struct DenseSched {
    static constexpr bool GATHER = false, PARTIAL = false;
    const char* A; const char* Bt; int lda, ldb, nM, nN, G, c; int rot;
    __device__ __forceinline__ bool next(int i, GUnit& u) const {
        int pm, pn; if (!static_unit(i, G, c, nM, nN, pm, pn)) return false;
        if (rot) { pn += rot; if (pn >= nN) pn -= nN; }
        u.pm = pm; u.pn = pn; u.e = 0; u.rows = 256; u.a = A + (size_t)pm * 256 * lda * 2; u.b = Bt + (size_t)pn * 256 * ldb * 2; return true;
    }
    __device__ __forceinline__ void aoff(const GUnit&, unsigned (&v)[2][2], const int (&R)[2], const int (&C)[2]) const {
#pragma unroll
        for (int h = 0; h < 2; ++h)
#pragma unroll
            for (int i = 0; i < 2; ++i) v[h][i] = (unsigned)((h * 128 + R[i]) * lda + C[i]) * 2u;
    }
};

template <class Epi, class Sched>
__device__ __forceinline__ void gemm_run(LAS unsigned char* lds, const int K, const int ldb, const Sched& S, const Epi& E, int g_wv) {
    int tid_ = TIDX; asm volatile("" : "+v"(tid_));
    const int tid = tid_, wid = __builtin_amdgcn_readfirstlane(tid >> 6), lane = tid & 63, wr = wid >> 2, wc = wid & 3, fr = lane & 15, fq = lane >> 4;
    int nt_ = K / BK; asm volatile("" : "+s"(nt_));
    const int nt = nt_;
    int R[2], C[2]; unsigned voffB[2];
#pragma unroll
    for (int i = 0; i < 2; ++i) { stage_rc(tid * 16 + i * 8192, R[i], C[i]); const int Rb = (R[i] & ~31) + perm32(R[i] & 31); voffB[i] = (unsigned)(Rb * ldb + C[i]) * 2u; }
    const size_t kstep = (size_t)(BK * 2);
    const size_t hstepB = (size_t)HALF * ldb * 2;
    const unsigned ldsw = (unsigned)wid * 1024u;
    const int aoff = lds_byte(wr * 64 + fr, fq * 8), boff = lds_byte(wc * 32 + fr, fq * 8);
#define G8_SA(b, h) (((b) * 2 + (h)) * HTB)
#define G8_SB(b, h) ((4 + (b) * 2 + (h)) * HTB)
#define G8_GLDS(bufoff, gptr, i_) __builtin_amdgcn_global_load_lds((const unsigned*)(gptr), (LAS unsigned*)(lds + (bufoff) + ldsw + (i_) * 8192), 16, 0, 0)
#define G8_STAGE_B(bufoff, gbase) do { G8_GLDS(bufoff, (const char*)(gbase) + voffB[0], 0); G8_GLDS(bufoff, (const char*)(gbase) + voffB[1], 1); } while (0)
#define G8_STAGE_A(bufoff, gbase, v0, v1) do { G8_GLDS(bufoff, (const char*)(gbase) + (v0), 0); G8_GLDS(bufoff, (const char*)(gbase) + (v1), 1); } while (0)
#define G8_LDA(dst, b, h) do { _Pragma("unroll") for (int m = 0; m < 4; ++m) _Pragma("unroll") for (int k = 0; k < 2; ++k) dst[m][k] = *(const LAS bf16x8*)(lds + G8_SA(b, h) + aoff + m * 2048 + k * 1024); } while (0)
#define G8_LDB(dst, b, h) do { _Pragma("unroll") for (int n = 0; n < 2; ++n) _Pragma("unroll") for (int k = 0; k < 2; ++k) dst[n][k] = *(const LAS bf16x8*)(lds + G8_SB(b, h) + boff + n * 2048 + k * 1024); } while (0)
#define G8_MMA(ai, bj, At, Bt) do { __builtin_amdgcn_s_setprio(1); _Pragma("unroll") for (int m = 0; m < 4; ++m) { if (!PARTIAL || ((mmask >> ((ai) * 4 + m)) & 1u)) { _Pragma("unroll") for (int n = 0; n < 2; ++n) _Pragma("unroll") for (int k = 0; k < 2; ++k) \
        acc[ai][bj][m][n] = __builtin_amdgcn_mfma_f32_16x16x32_bf16(Bt[n][k], At[m][k], acc[ai][bj][m][n], 0, 0, 0); } } __builtin_amdgcn_s_setprio(0); } while (0)
#define G8_WAIT_V(n) asm volatile("s_waitcnt vmcnt(" #n ")" ::: "memory")
#define G8_WAIT_L(n) asm volatile("s_waitcnt lgkmcnt(" #n ")" ::: "memory")
#define G8_BAR __builtin_amdgcn_s_barrier()
#define G8_SCHED __builtin_amdgcn_sched_barrier(0)
    GUnit cur, nxt; int ui = 0;
    if (!S.next(0, cur)) return;
    constexpr bool GATHER = Sched::GATHER, PARTIAL = Sched::PARTIAL;
    unsigned mmask = 0xffu;
#define G8_MASK(u) do { if (PARTIAL) { mmask = 0u; _Pragma("unroll") for (int q_ = 0; q_ < 8; ++q_) mmask |= (((q_ >> 2) * 128 + wr * 64 + (q_ & 3) * 16) < (u).rows) ? (1u << q_) : 0u; } } while (0)
    unsigned vc[2][2];
    S.aoff(cur, vc, R, C); G8_MASK(cur);
    LAS u32x4* stash = (LAS u32x4*)(lds + STAGE_BYTES + 4096) + tid;
    f32x4 acc[2][2][4][2];
#pragma unroll
    for (int a = 0; a < 2; ++a)
#pragma unroll
        for (int b = 0; b < 2; ++b)
#pragma unroll
            for (int m = 0; m < 4; ++m)
#pragma unroll
                for (int n = 0; n < 2; ++n) acc[a][b][m][n] = (f32x4){0.f, 0.f, 0.f, 0.f};
    bf16x8 At[4][2], B0[2][2], B1[2][2];
    const char* cA = cur.a; const char* cB = cur.b;
    G8_STAGE_B(G8_SB(0, 0), cB); G8_STAGE_B(G8_SB(0, 1), cB + hstepB); G8_STAGE_A(G8_SA(0, 0), cA, vc[0][0], vc[0][1]); G8_STAGE_A(G8_SA(0, 1), cA, vc[1][0], vc[1][1]);
    if (wr == 1) G8_BAR;
    G8_WAIT_V(2); G8_BAR;
    G8_STAGE_B(G8_SB(1, 0), cB + kstep); G8_STAGE_A(G8_SA(1, 0), cA + kstep, vc[0][0], vc[0][1]); G8_STAGE_B(G8_SB(1, 1), cB + hstepB + kstep);
    G8_WAIT_V(6); G8_BAR;
    for (;;) {
        const bool has_next = S.next(ui + 1, nxt);
        if (GATHER) { unsigned vn[2][2];
            if (has_next) S.aoff(nxt, vn, R, C);
            else { vn[0][0] = vc[0][0]; vn[0][1] = vc[0][1]; vn[1][0] = vc[1][0]; vn[1][1] = vc[1][1]; }
            u32x4 sv; sv.x = vn[0][0]; sv.y = vn[0][1]; sv.z = vn[1][0]; sv.w = vn[1][1]; *stash = sv; }
        const char* nA = has_next ? nxt.a : cA; const char* nB = has_next ? nxt.b : cB;
#pragma unroll 1
        for (int seg = 0; seg < (Epi::KHOOK ? 3 : 1); ++seg) {
        const int tlo = Epi::KHOOK ? 6 * seg : 0, thi = Epi::KHOOK ? (seg == 2 ? nt : 6 * seg + 6) : nt;
#pragma unroll 1
        for (int t = tlo; t < thi; t += 2) {
            const bool last = (t == nt - 2);
            const char* a1 = cA + (size_t)(t + 1) * kstep;
            const char* a2 = last ? nA : cA + (size_t)(t + 2) * kstep; const char* b2 = last ? nB : cB + (size_t)(t + 2) * kstep;
            const char* a3 = a2 + kstep; const char* b3 = b2 + kstep;
            unsigned w00 = vc[0][0], w01 = vc[0][1], w10 = vc[1][0], w11 = vc[1][1];
            if (GATHER) { if (last) { const u32x4 sv = *stash; w00 = sv.x; w01 = sv.y; w10 = sv.z; w11 = sv.w; } }
            G8_LDB(B0, 0, 0); G8_LDB(B1, 0, 1); G8_SCHED; G8_LDA(At, 0, 0); G8_STAGE_A(G8_SA(1, 1), a1, vc[1][0], vc[1][1]);
            G8_WAIT_V(8); G8_WAIT_L(0); G8_BAR; G8_MMA(0, 0, At, B0); G8_MMA(0, 1, At, B1); G8_BAR; G8_SCHED;
            G8_LDA(At, 0, 1); G8_STAGE_B(G8_SB(0, 0), b2); G8_STAGE_B(G8_SB(0, 1), b2 + hstepB); G8_STAGE_A(G8_SA(0, 0), a2, w00, w01);
            G8_WAIT_V(8); G8_WAIT_L(0); G8_BAR; G8_MMA(1, 0, At, B0); G8_MMA(1, 1, At, B1); G8_BAR; G8_SCHED;
            G8_LDB(B0, 1, 0); G8_LDB(B1, 1, 1); G8_SCHED; G8_LDA(At, 1, 0); G8_STAGE_A(G8_SA(0, 1), a2, w10, w11);
            G8_WAIT_V(8); G8_WAIT_L(0); G8_BAR; G8_MMA(0, 0, At, B0); G8_MMA(0, 1, At, B1); G8_BAR; G8_SCHED;
            G8_LDA(At, 1, 1); G8_STAGE_B(G8_SB(1, 0), b3); G8_STAGE_B(G8_SB(1, 1), b3 + hstepB); G8_STAGE_A(G8_SA(1, 0), a3, w00, w01);
            G8_WAIT_V(8); G8_WAIT_L(0); G8_BAR; G8_MMA(1, 0, At, B0); G8_MMA(1, 1, At, B1); G8_BAR; G8_SCHED;
        }
        if constexpr (Epi::KHOOK) { if (seg < 2) E.kscale(acc, seg, wr, fr); }
        }
        if (wr == 0) G8_BAR;
        { int fr_ = fr, fq_ = fq; asm volatile("" : "+v"(fr_), "+v"(fq_));
          E(acc, cur, wr, wc, fr_, fq_); }
        if (!has_next) break;
#pragma unroll
        for (int a = 0; a < 2; ++a)
#pragma unroll
            for (int b = 0; b < 2; ++b)
#pragma unroll
                for (int m = 0; m < 4; ++m)
#pragma unroll
                    for (int n = 0; n < 2; ++n) acc[a][b][m][n] = (f32x4){0.f, 0.f, 0.f, 0.f};
        cur = nxt; cA = nA; cB = nB; ++ui; G8_MASK(cur);
        if (GATHER) { const u32x4 sv = *stash; vc[0][0] = sv.x; vc[0][1] = sv.y; vc[1][0] = sv.z; vc[1][1] = sv.w; }
        if (wr == 1) G8_BAR;
    }
    G8_WAIT_V(0);
    G8_BAR;
#undef G8_SA
#undef G8_SB
#undef G8_GLDS
#undef G8_STAGE_A
#undef G8_STAGE_B
#undef G8_LDA
#undef G8_LDB
#undef G8_MMA
#undef G8_MASK
#undef G8_WAIT_V
#undef G8_WAIT_L
#undef G8_BAR
#undef G8_SCHED
}
}
using g8::GUnit;
__device__ __forceinline__ void st_bf16x8(bf16_t* p, const float (&v)[8]) { u32x4 w; w.x = pk_bf16(v[0], v[1]); w.y = pk_bf16(v[2], v[3]); w.z = pk_bf16(v[4], v[5]); w.w = pk_bf16(v[6], v[7]); *(u32x4*)p = w; }
__device__ __forceinline__ float quad_sum(float s) { s += shx<16>(s); s += __shfl_xor(s, 32); return s; }

struct EpiInProj {
    static constexpr bool KHOOK = false;
    const float* ssqx; float* part_dq; float* part_dkv; const float* qg; const float* kg; const float* krg; const float* rope;
    unsigned char* prj;
    __device__ __forceinline__ void operator()(const f32x4 (&acc)[2][2][4][2], const GUnit& u, int wr, int wc, int fr, int fq) const {
        const int G = u.pn * 4 + wc;
        const bool isq = G < 6; const int a = G - 6; const bool isk = (G >= 10 && G < 18 && ((a >> 1) & 1) == 0);
        const float* g0 = (isq ? qg : kg) + 8 * fq;
        float rs8[8];
#pragma unroll
        for (int k = 0; k < 8; ++k) rs8[k] = ssqx[u.pm * 256 + (k >> 2) * 128 + wr * 64 + (k & 3) * 16 + fr];
#pragma unroll
        for (int k = 0; k < 8; ++k) rs8[k] = rsqrtf(rs8[k] * (1.f / 1024.f) + 1e-6f);
#pragma unroll
        for (int ai = 0; ai < 2; ++ai)
#pragma unroll
            for (int m = 0; m < 4; ++m) {
                __builtin_amdgcn_sched_barrier(0);
                const int row = u.pm * 256 + ai * 128 + wr * 64 + m * 16 + fr; const int b = row >> 11, t = row & 2047;
                const float rs = rs8[ai * 4 + m];
                float v[2][8];
#pragma unroll
                for (int bj = 0; bj < 2; ++bj)
#pragma unroll
                    for (int n = 0; n < 2; ++n)
#pragma unroll
                        for (int j = 0; j < 4; ++j) v[bj][4 * n + j] = acc[ai][bj][m][n][j] * rs;
                float ss = 0.f;
#pragma unroll
                for (int bj = 0; bj < 2; ++bj)
#pragma unroll
                    for (int i = 0; i < 8; ++i) ss += v[bj][i] * v[bj][i];
                bf16_t* dst = nullptr; int bstride = 32;
                if (isq) {
                    ss = quad_sum(ss); const float sc = rsqrtf(ss * (1.f / 64.f) + 1e-6f) * 0.18033688f;
#pragma unroll
                    for (int i = 0; i < 8; ++i) { v[0][i] *= sc * g0[i]; v[1][i] *= sc * g0[32 + i]; }
                    dst = (bf16_t*)(prj + PRJ_QN) + ((size_t)(b * 6 + G) * 2048 + t) * 64;
                } else if (G < 18) {
                    const int br = a >> 2, s = (a >> 1) & 1, hk = a & 1;
                    if (br > 0 && s == 0) {
                        ss = quad_sum(ss); const float sc = rsqrtf(ss * (1.f / 64.f) + 1e-6f);
#pragma unroll
                        for (int i = 0; i < 8; ++i) { v[0][i] *= sc * g0[i]; v[1][i] *= sc * g0[32 + i]; }
                    }
                    const size_t base = br == 0 ? (s ? PRJ_C0V : PRJ_C0K) : (br == 1 ? (s ? PRJ_VN1 : PRJ_KN1) : (s ? PRJ_VN2 : PRJ_KN2));
                    dst = (bf16_t*)(prj + base) + ((size_t)(b * 2 + hk) * 2048 + t) * 64;
                } else if (G < 26) { dst = (bf16_t*)(prj + PRJ_RAWQK) + (size_t)row * 512 + (G - 18) * 64; }
                else if (G < 30) { dst = (bf16_t*)(prj + PRJ_VML) + ((size_t)(b * 4 + (G - 26)) * 2048 + t) * 64; }
                else if (G < 34) { dst = (bf16_t*)(prj + PRJ_OG) + (size_t)row * 256 + (G - 30) * 64; }
                else if (G < 37) { dst = (bf16_t*)(prj + PRJ_DQKV) + (size_t)row * 384 + (G - 34) * 64; ss = quad_sum(ss); if (fq == 0) part_dq[(size_t)row * 4 + (G - 34)] = ss; }
                else if (G == 37) {
                    dst = (bf16_t*)(prj + PRJ_DQKV) + (size_t)row * 384 + 192;
                    float* gt = (float*)(prj + PRJ_GATES) + (size_t)row * 32 + 8 * fq;
                    *(f32x4*)gt = (f32x4){v[1][0], v[1][1], v[1][2], v[1][3]}; *(f32x4*)(gt + 4) = (f32x4){v[1][4], v[1][5], v[1][6], v[1][7]};
                    float s0 = 0.f;
#pragma unroll
                    for (int i = 0; i < 8; ++i) s0 += v[0][i] * v[0][i];
                    s0 = quad_sum(s0); const float sc = rsqrtf(s0 * (1.f / 32.f) + 1e-6f);
                    const float* rp = rope + (size_t)row * 32 + ((8 * fq) & 15);
                    float kr[8];
#pragma unroll
                    for (int i = 0; i < 8; ++i) { const float val = v[0][i] * sc * krg[8 * fq + i]; const float oth = __shfl_xor(val, 32); const float cs = rp[i], sn = rp[16 + i]; kr[i] = fq < 2 ? val * cs - oth * sn : val * cs + oth * sn; }
                    st_bf16x8((bf16_t*)(prj + PRJ_KR) + (size_t)row * 32 + 8 * fq, kr);
                } else { dst = (bf16_t*)(prj + PRJ_DQKV) + (size_t)row * 384 + 256 + (G - 38) * 64; ss = quad_sum(ss); if (fq == 0) part_dkv[(size_t)row * 2 + (G - 38)] = ss; }
                st_bf16x8(dst + 8 * fq, v[0]); st_bf16x8(dst + bstride + 8 * fq, v[1]);
            }
    }
};

struct EpiUq {
    static constexpr bool KHOOK = false;
    const float* ssq_dq; const float* qkn; const float* rope; bf16_t* QM;
    __device__ __forceinline__ void operator()(const f32x4 (&acc)[2][2][4][2], const GUnit& u, int wr, int wc, int fr, int fq) const {
        const int G = u.pn * 4 + wc; if (G >= 9) return;
        const float scale = 0.14724444f;
        const float* g0 = G < 6 ? qkn + 8 * fq : qkn + 64 + 8 * (fq & 1); const float* g1 = G < 6 ? g0 + 32 : g0 + 16;
        float rs8[8];
#pragma unroll
        for (int k = 0; k < 8; ++k) { const f32x4 pq = *(const f32x4*)(ssq_dq + (size_t)(u.pm * 256 + (k >> 2) * 128 + wr * 64 + (k & 3) * 16 + fr) * 4); rs8[k] = (pq.x + pq.y) + pq.z; }
#pragma unroll
        for (int k = 0; k < 8; ++k) rs8[k] = rsqrtf(rs8[k] * (1.f / 192.f) + 1e-6f);
#pragma unroll
        for (int ai = 0; ai < 2; ++ai) {
#pragma unroll
            for (int m = 0; m < 4; ++m) {
                __builtin_amdgcn_sched_barrier(0);
                const int row = u.pm * 256 + ai * 128 + wr * 64 + m * 16 + fr; const int b = row >> 11, t = row & 2047;
                const float rs = rs8[ai * 4 + m];
                float v[2][8]; float ss = 0.f;
#pragma unroll
                for (int bj = 0; bj < 2; ++bj)
#pragma unroll
                    for (int n = 0; n < 2; ++n)
#pragma unroll
                        for (int j = 0; j < 4; ++j) { const float x = acc[ai][bj][m][n][j] * rs; v[bj][4 * n + j] = x; ss += x * x; }
                if (G < 6) ss = quad_sum(ss); else ss += shx<16>(ss);
                const float sc = rsqrtf(ss * (G < 6 ? 1.f / 64.f : 1.f / 32.f) + 1e-6f) * scale;
#pragma unroll
                for (int i = 0; i < 8; ++i) { v[0][i] *= sc * g0[i]; v[1][i] *= sc * g1[i]; }
                if (G < 6) {
                    bf16_t* dst = QM + ((size_t)(b * 6 + G) * 2048 + t) * 96;
                    st_bf16x8(dst + 8 * fq, v[0]); st_bf16x8(dst + 32 + 8 * fq, v[1]);
                } else {
                    const int i16 = 8 * (fq & 1); const int head = 2 * (G - 6) + (fq >> 1);
                    const float* rp = rope + (size_t)row * 32 + i16; float o1[8], o2[8];
#pragma unroll
                    for (int i = 0; i < 8; ++i) { const float cs = rp[i], sn = rp[16 + i]; o1[i] = v[0][i] * cs - v[1][i] * sn; o2[i] = v[1][i] * cs + v[0][i] * sn; }
                    bf16_t* dst = QM + ((size_t)(b * 6 + head) * 2048 + t) * 96 + 64 + i16;
                    st_bf16x8(dst, o1); st_bf16x8(dst + 16, o2);
                }
            }
        }
    }
};
struct EpiUkv {
    static constexpr bool KHOOK = false;
    const float* ssq_dkv; const float* qkn; const bf16_t* KR; bf16_t* KM; bf16_t* VM;
    __device__ __forceinline__ void operator()(const f32x4 (&acc)[2][2][4][2], const GUnit& u, int wr, int wc, int fr, int fq) const {
        const int G = u.pn * 4 + wc;
        const float* g0 = qkn + 96 + 8 * fq;
        float rs8[8];
#pragma unroll
        for (int k = 0; k < 8; ++k) { const size_t rr = (size_t)(u.pm * 256 + (k >> 2) * 128 + wr * 64 + (k & 3) * 16 + fr); rs8[k] = ssq_dkv[rr * 2] + ssq_dkv[rr * 2 + 1]; }
#pragma unroll
        for (int k = 0; k < 8; ++k) rs8[k] = rsqrtf(rs8[k] * (1.f / 128.f) + 1e-6f);
#pragma unroll
        for (int ai = 0; ai < 2; ++ai) {
          u32x4 kr4[4];
          if (G < 6) {
#pragma unroll
              for (int m = 0; m < 4; ++m) kr4[m] = *(const u32x4*)(KR + (size_t)(u.pm * 256 + ai * 128 + wr * 64 + m * 16 + fr) * 32 + 8 * fq);
          }
#pragma unroll
            for (int m = 0; m < 4; ++m) {
                __builtin_amdgcn_sched_barrier(0);
                const int row = u.pm * 256 + ai * 128 + wr * 64 + m * 16 + fr; const int b = row >> 11, t = row & 2047;
                const float rs = rs8[ai * 4 + m];
                float v[2][8]; float ss = 0.f;
#pragma unroll
                for (int bj = 0; bj < 2; ++bj)
#pragma unroll
                    for (int n = 0; n < 2; ++n)
#pragma unroll
                        for (int j = 0; j < 4; ++j) { const float x = acc[ai][bj][m][n][j] * rs; v[bj][4 * n + j] = x; ss += x * x; }
                if (G < 6) {
                    ss = quad_sum(ss); const float sc = rsqrtf(ss * (1.f / 64.f) + 1e-6f);
#pragma unroll
                    for (int i = 0; i < 8; ++i) { v[0][i] *= sc * g0[i]; v[1][i] *= sc * g0[32 + i]; }
                    bf16_t* dst = KM + ((size_t)(b * 6 + G) * 2048 + t) * 96;
                    st_bf16x8(dst + 8 * fq, v[0]); st_bf16x8(dst + 32 + 8 * fq, v[1]);
                    *(u32x4*)(dst + 64 + 8 * fq) = kr4[m];
                } else {
                    bf16_t* dst = VM + ((size_t)(b * 6 + (G - 6)) * 2048 + t) * 64;
                    st_bf16x8(dst + 8 * fq, v[0]); st_bf16x8(dst + 32 + 8 * fq, v[1]);
                }
            }
        }
    }
};
#define MFMA16(a, b, c) __builtin_amdgcn_mfma_f32_16x16x32_bf16(a, b, c, 0, 0, 0)
#define MFMA32(a, b, c) __builtin_amdgcn_mfma_f32_32x32x16_bf16(a, b, c, 0, 0, 0)
#define LDS_FENCE() asm volatile("s_waitcnt lgkmcnt(0)" ::: "memory")

__device__ __forceinline__ void cmp_unit(int u, int l, InPtr in, unsigned char* ws, LAS unsigned char* lds, int g_wv) {
    int tid_ = TIDX; asm volatile("" : "+v"(tid_));
    const int tid = tid_, w = tid >> 6, lane = tid & 63, r = lane & 15, q = lane >> 4;
    const int b = u >> 2, s = (u >> 1) & 1, hk = u & 1;
    const bf16_t* A = (const bf16_t*)(ws + WS_PRJ + (s ? PRJ_C0V : PRJ_C0K)) + (size_t)(b * 2 + hk) * 2048 * 64;
    const bf16_t* W1 = (const bf16_t*)(ws + WS_WC1) + ((size_t)l * 2 + s) * 64 * 2048;
    const bf16_t* W2 = (const bf16_t*)(ws + WS_WC2) + ((size_t)l * 2 + s) * 64 * 64;
    const float* b1 = (const float*)(ws + WS_B1C) + (l * 2 + s) * 64;
    f32x4 acc[4];
#pragma unroll
    for (int nb = 0; nb < 4; ++nb) acc[nb] = (f32x4){0.f, 0.f, 0.f, 0.f};
    const bf16_t* ap = A + (size_t)(16 * w + r) * 1024 + 8 * q;
    constexpr int WP = 528, WBUF = 64 * WP; LAS unsigned char* wb = lds + 24576;
    u32x4 st[4];
#pragma unroll
    for (int i = 0; i < 4; ++i) { const int c = tid + 512 * i; st[i] = *(const u32x4*)(W1 + (size_t)(c >> 5) * 2048 + (c & 31) * 8); }
    bf16x8 af[8], afn[8];
#pragma unroll
    for (int ks = 0; ks < 8; ++ks) af[ks] = *(const bf16x8*)(ap + 32 * ks);
    const float* kg = in->p[9] + l * 64;
    float b1v[4], kgv[4]; bf16x8 w2f[2][4];
#pragma unroll
    for (int nb = 0; nb < 4; ++nb) { b1v[nb] = b1[16 * nb + r]; kgv[nb] = kg[16 * nb + r]; }
#pragma unroll
    for (int ks = 0; ks < 2; ++ks)
#pragma unroll
        for (int nb = 0; nb < 4; ++nb) w2f[ks][nb] = *(const bf16x8*)(W2 + (size_t)(16 * nb + r) * 64 + 32 * ks + 8 * q);
#pragma unroll
    for (int i = 0; i < 4; ++i) { const int c = tid + 512 * i; *(LAS u32x4*)(wb + (c >> 5) * WP + (c & 31) * 16) = st[i]; }
    __syncthreads();
    auto chunk = [&](const int kc, bf16x8 (&ac)[8], bf16x8 (&an)[8]) __attribute__((always_inline)) {
        const int cur = kc & 1;
        if (kc < 7) {
#pragma unroll
            for (int i = 0; i < 4; ++i) { const int c = tid + 512 * i; st[i] = *(const u32x4*)(W1 + (size_t)(c >> 5) * 2048 + (kc + 1) * 256 + (c & 31) * 8); }
#pragma unroll
            for (int ks = 0; ks < 8; ++ks) an[ks] = *(const bf16x8*)(ap + 256 * (kc + 1) + 32 * ks);
        }
#pragma unroll
        for (int ks = 0; ks < 8; ++ks)
#pragma unroll
            for (int nb = 0; nb < 4; ++nb) { const bf16x8 bb = *(const LAS bf16x8*)(wb + cur * WBUF + (16 * nb + r) * WP + (32 * ks + 8 * q) * 2); acc[nb] = MFMA16(ac[ks], bb, acc[nb]); }
        if (kc < 7) {
#pragma unroll
            for (int i = 0; i < 4; ++i) { const int c = tid + 512 * i; *(LAS u32x4*)(wb + (cur ^ 1) * WBUF + (c >> 5) * WP + (c & 31) * 16) = st[i]; }
        }
        __syncthreads();
    };
#pragma unroll 1
    for (int kc = 0; kc < 8; kc += 2) { chunk(kc, af, afn); chunk(kc + 1, afn, af); }
    LAS bf16_t* hl = (LAS bf16_t*)(lds + w * 2304);
#pragma unroll
    for (int nb = 0; nb < 4; ++nb) { const float bias = b1v[nb];
#pragma unroll
        for (int j = 0; j < 4; ++j) hl[(4 * q + j) * 72 + 16 * nb + r] = f2bf(siluf(acc[nb][j] + bias)); }
    LDS_FENCE();
    f32x4 o[4];
#pragma unroll
    for (int nb = 0; nb < 4; ++nb) o[nb] = (f32x4){0.f, 0.f, 0.f, 0.f};
#pragma unroll
    for (int ks = 0; ks < 2; ++ks) {
        const bf16x8 a = *(const LAS bf16x8*)(hl + r * 72 + 32 * ks + 8 * q);
#pragma unroll
        for (int nb = 0; nb < 4; ++nb) o[nb] = MFMA16(a, w2f[ks][nb], o[nb]);
    }
    LDS_FENCE();
    bf16_t* dst = (bf16_t*)(ws + WS_CMP + (s ? CMP_V : 0)) + (size_t)(b * 2 + hk) * 128 * 64;
#pragma unroll
    for (int j = 0; j < 4; ++j) {
        const int n = 16 * w + 4 * q + j; float ss = 0.f;
#pragma unroll
        for (int nb = 0; nb < 4; ++nb) ss += o[nb][j] * o[nb][j];
        ss += shx<1>(ss); ss += shx<2>(ss); ss += shx<4>(ss); ss += shx<8>(ss);
        const float sc = s == 0 ? rsqrtf(ss * (1.f / 64.f) + 1e-6f) : 1.f;
#pragma unroll
        for (int nb = 0; nb < 4; ++nb) { const int d = 16 * nb + r; const float v = o[nb][j] * sc * (s == 0 ? kgv[nb] : 1.f); dst[(size_t)n * 64 + d] = n < 127 ? f2bf(v) : (bf16_t)0; }
    }
}

__device__ __forceinline__ int swz_off(int row, int chunk) { return row * 128 + ((chunk ^ (row & 7)) << 4); }
__device__ __forceinline__ float log_sigmoid(float x) { return fminf(x, 0.f) - log1pf(__expf(-fabsf(x))); }
__device__ __forceinline__ void ml_delta_wave(int cu, int l, InPtr in, unsigned char* ws, LAS unsigned char* wl, int lane) {
    asm volatile("" : "+v"(lane));
    const int c = cu & 31, bh = cu >> 5, h = bh & 3, b = bh >> 2; const int t0 = c * 64; const size_t row0 = (size_t)b * 2048 + t0;
    const int cc = lane & 7, tg = lane >> 3;
    const bf16_t* raw = (const bf16_t*)(ws + WS_PRJ + PRJ_RAWQK); const float* cw = in->p[11] + (size_t)l * 4 * 512 + h * 64 + 8 * cc;
    u32x4 rq[11];
    const bool head0 = (c == 0 && tg == 0);
#pragma unroll
    for (int i = 0; i < 11; ++i) { const size_t rr = (head0 && i < 3) ? row0 : row0 + 8 * tg - 3 + i; rq[i] = *(const u32x4*)(raw + rr * 512 + h * 64 + 8 * cc); }
    __builtin_amdgcn_sched_barrier(0);
    const float* G = (const float*)(ws + WS_PRJ + PRJ_GATES);
    const float ip = G[(row0 + lane) * 32 + 18 + h] + in->p[12][l * 4 + h], fp = G[(row0 + lane) * 32 + 22 + h] + in->p[13][l * 4 + h];
    float bcum = log_sigmoid(fp);
#pragma unroll
    for (int o = 1; o < 64; o <<= 1) { const float t = __builtin_bit_cast(float, __builtin_amdgcn_ds_bpermute(((lane - o) & 63) << 2, __builtin_bit_cast(int, bcum))); if (lane >= o) bcum += t; }
    const float bL = __builtin_bit_cast(float, __builtin_amdgcn_readlane(__builtin_bit_cast(int, bcum), 63)); const float wgt = __expf(bL - bcum + ip);
    { float* mlg = (float*)(ws + WS_ML + ML_G) + ((size_t)bh * 2048 + t0 + lane) * 2; mlg[0] = bcum; mlg[1] = ip; if (lane == 0) ((float*)(ws + WS_ML + ML_BL))[cu] = bL; }
    float wt[8];
#pragma unroll
    for (int j = 0; j < 8; ++j) wt[j] = __builtin_bit_cast(float, __builtin_amdgcn_ds_bpermute((8 * tg + j) << 2, __builtin_bit_cast(int, wgt)));
    if (head0) {
#pragma unroll
        for (int i = 0; i < 3; ++i) rq[i] = (u32x4){0u, 0u, 0u, 0u}; }
#define MLD_E(v, e) (((e) & 1) ? bf_hi(((e) >> 1) == 0 ? (v).x : ((e) >> 1) == 1 ? (v).y : ((e) >> 1) == 2 ? (v).z : (v).w) : bf_lo(((e) >> 1) == 0 ? (v).x : ((e) >> 1) == 1 ? (v).y : ((e) >> 1) == 2 ? (v).z : (v).w))
    bf16_t* QC = (bf16_t*)(ws + WS_ML) + ((size_t)bh * 2048 + t0 + 8 * tg) * 64 + 8 * cc; bf16_t* KC = (bf16_t*)(ws + WS_ML + ML_KC) + ((size_t)bh * 2048 + t0 + 8 * tg) * 64 + 8 * cc;
    u32x4 rk[11], vv[8];
#pragma unroll
    for (int i = 0; i < 11; ++i) { const size_t rr = (head0 && i < 3) ? row0 : row0 + 8 * tg - 3 + i; rk[i] = *(const u32x4*)(raw + rr * 512 + h * 64 + 8 * cc + 256); }
    { const bf16_t* V = (const bf16_t*)(ws + WS_PRJ + PRJ_VML) + ((size_t)bh * 2048 + t0 + 8 * tg) * 64 + 8 * cc;
#pragma unroll
      for (int j = 0; j < 8; ++j) vv[j] = *(const u32x4*)(V + (size_t)j * 64); }
    if (head0) {
#pragma unroll
        for (int i = 0; i < 3; ++i) rk[i] = (u32x4){0u, 0u, 0u, 0u}; }
    __builtin_amdgcn_sched_barrier(0);
    {
        float w4[4][8];
#pragma unroll
        for (int tp = 0; tp < 4; ++tp) { const f32x4 a = *(const f32x4*)(cw + tp * 512), b4 = *(const f32x4*)(cw + tp * 512 + 4); w4[tp][0] = a.x; w4[tp][1] = a.y; w4[tp][2] = a.z; w4[tp][3] = a.w; w4[tp][4] = b4.x; w4[tp][5] = b4.y; w4[tp][6] = b4.z; w4[tp][7] = b4.w; }
#pragma unroll
        for (int j = 0; j < 8; ++j) { float o[8];
#pragma unroll
            for (int e = 0; e < 8; ++e) o[e] = siluf(w4[0][e] * MLD_E(rq[j], e) + w4[1][e] * MLD_E(rq[j + 1], e) + w4[2][e] * MLD_E(rq[j + 2], e) + w4[3][e] * MLD_E(rq[j + 3], e));
            u32x4 pk; pk.x = pk_bf16(o[0], o[1]); pk.y = pk_bf16(o[2], o[3]); pk.z = pk_bf16(o[4], o[5]); pk.w = pk_bf16(o[6], o[7]);
            *(u32x4*)(QC + (size_t)j * 64) = pk; }
    }
    float dn[8];
    {
        float w4[4][8];
#pragma unroll
        for (int tp = 0; tp < 4; ++tp) { const f32x4 a = *(const f32x4*)(cw + 256 + tp * 512), b4 = *(const f32x4*)(cw + 256 + tp * 512 + 4); w4[tp][0] = a.x; w4[tp][1] = a.y; w4[tp][2] = a.z; w4[tp][3] = a.w; w4[tp][4] = b4.x; w4[tp][5] = b4.y; w4[tp][6] = b4.z; w4[tp][7] = b4.w; }
#pragma unroll
        for (int e = 0; e < 8; ++e) dn[e] = 0.f;
#pragma unroll
        for (int j2 = 0; j2 < 4; ++j2) { float kb[2][8];
#pragma unroll
            for (int jj = 0; jj < 2; ++jj) { const int j = 2 * j2 + jj; float o[8];
#pragma unroll
                for (int e = 0; e < 8; ++e) o[e] = siluf(w4[0][e] * MLD_E(rk[j], e) + w4[1][e] * MLD_E(rk[j + 1], e) + w4[2][e] * MLD_E(rk[j + 2], e) + w4[3][e] * MLD_E(rk[j + 3], e)) * 0.125f;
                u32x4 pk; pk.x = pk_bf16(o[0], o[1]); pk.y = pk_bf16(o[2], o[3]); pk.z = pk_bf16(o[4], o[5]); pk.w = pk_bf16(o[6], o[7]);
                *(u32x4*)(KC + (size_t)j * 64) = pk;
#pragma unroll
                for (int e = 0; e < 8; ++e) { kb[jj][e] = MLD_E(pk, e); dn[e] += wt[j] * kb[jj][e]; } }
#pragma unroll
            for (int e = 0; e < 8; ++e) { *(LAS unsigned*)(wl + swz_off(8 * cc + e, tg) + 4 * j2) = pk_bf16(kb[0][e], kb[1][e]);
                *(LAS unsigned*)(wl + 8192 + swz_off(8 * cc + e, tg) + 4 * j2) = pk_bf16(wt[2 * j2] * MLD_E(vv[2 * j2], e), wt[2 * j2 + 1] * MLD_E(vv[2 * j2 + 1], e)); } }
    }
#undef MLD_E
#pragma unroll
    for (int e = 0; e < 8; ++e) { dn[e] += shx<8>(dn[e]); dn[e] += shx<16>(dn[e]); dn[e] += __shfl_xor(dn[e], 32); }
    if (tg == 0) { float* DN = (float*)(ws + WS_ML + ML_DN) + (size_t)cu * 64 + 8 * cc; *(f32x4*)DN = (f32x4){dn[0], dn[1], dn[2], dn[3]}; *(f32x4*)(DN + 4) = (f32x4){dn[4], dn[5], dn[6], dn[7]}; }
    LDS_FENCE();
    const int r = lane & 15, q = lane >> 4;
    bf16_t* DL = (bf16_t*)(ws + WS_ML + ML_DELTA) + (size_t)cu * 4096;
    f32x4 acc[4][4];
#pragma unroll
    for (int mb = 0; mb < 4; ++mb) {
#pragma unroll
        for (int nb = 0; nb < 4; ++nb) acc[mb][nb] = (f32x4){0.f, 0.f, 0.f, 0.f};
#pragma unroll
        for (int ks = 0; ks < 2; ++ks) {
            const bf16x8 a = *(const LAS bf16x8*)(wl + 8192 + swz_off(16 * mb + r, 4 * ks + q));
#pragma unroll
            for (int nb = 0; nb < 4; ++nb) { const bf16x8 bb = *(const LAS bf16x8*)(wl + swz_off(16 * nb + r, 4 * ks + q)); acc[mb][nb] = MFMA16(a, bb, acc[mb][nb]); }
        }
    }
    LDS_FENCE();
#pragma unroll
    for (int mb = 0; mb < 4; ++mb)
#pragma unroll
        for (int nb = 0; nb < 4; ++nb)
#pragma unroll
            for (int j = 0; j < 4; ++j) { const int row = 16 * mb + 4 * q + j, col = 16 * nb + r; *(LAS bf16_t*)(wl + swz_off(row, col >> 3) + (col & 7) * 2) = f2bf(acc[mb][nb][j]); }
    LDS_FENCE();
#pragma unroll
    for (int i = 0; i < 8; ++i) { const int ch = lane + 64 * i; *(u32x4*)(DL + (size_t)ch * 8) = *(const LAS u32x4*)(wl + swz_off(ch >> 3, ch & 7)); }
    LDS_FENCE();
}

#ifndef TIME_PH
#define TIME_PH -1
#endif
#define PSTAMP(i, blk) do { if (TIME_PH != -1 && l == 0 && blockIdx.x == (blk) && TIDX == 0) ((unsigned long long*)((unsigned*)(ws + WS_CTL) + CW_TS))[i] = __builtin_amdgcn_s_memrealtime(); } while (0)
#ifndef DUP_DELTA
#define DUP_DELTA 1
#endif
__device__ __forceinline__ void phase_prep(int l, InPtr in, unsigned char* ws, LAS unsigned char* lds, int bid, int nb, int g_wv, unsigned* dq) {
    asm volatile("" : "+s"(bid));
    PSTAMP(40, 0);
#ifndef NO_UQ
    { g8::DenseSched S{(const char*)(ws + WS_PRJ + PRJ_DQKV), (const char*)(ws + WS_WUQ) + (size_t)l * 768 * 256 * 2, 384, 256, 64, 3, nb, bid};
      EpiUq E{(const float*)(ws + WS_SSQ + PT_DQ) + (size_t)l * 16384 * 4, in->p[19] + l * 192, (const float*)(ws + WS_ROPE), (bf16_t*)(ws + WS_MLA)};
      g8::gemm_run(lds, 256, 256, S, E, g_wv); }
#endif
    PSTAMP(41, 0);
#ifndef NO_UKV
    asm volatile("" : "+s"(bid));
    { g8::DenseSched S{(const char*)(ws + WS_PRJ + PRJ_DQKV) + 256, (const char*)(ws + WS_WUKV) + (size_t)l * 768 * 256 * 2, 384, 256, 64, 3, nb, nb == 256 ? ((bid + 64) & 255) : bid};
      EpiUkv E{(const float*)(ws + WS_SSQ + PT_DKV) + (size_t)l * 16384 * 2, in->p[19] + l * 192, (const bf16_t*)(ws + WS_PRJ + PRJ_KR), (bf16_t*)(ws + WS_MLA + MLA_KM), (bf16_t*)(ws + WS_MLA + MLA_VM)};
      g8::gemm_run(lds, 256, 256, S, E, g_wv); }
#endif
    PSTAMP(42, 0); PSTAMP(44, 255);
    __syncthreads();
#ifndef NO_CMP
#ifndef DUP_CMP
#define DUP_CMP 1
#endif
    for (int u = (nb == 256 ? (bid >= 128 && bid < 160 ? bid - 128 : 32) : nb - 1 - bid); u < 32; u += nb) for (int rp_ = 0; rp_ < DUP_CMP; ++rp_) { if (rp_) __syncthreads(); cmp_unit(u, l, in, ws, lds, g_wv); }
#endif
    PSTAMP(45, 255);
    __syncthreads();
#ifndef NO_DELTA
    { int tid_ = TIDX; asm volatile("" : "+v"(tid_)); LAS int* slot = (LAS int*)(lds + LDS_MISC + 64);
      for (;;) {
          __syncthreads();
          if (tid_ == 0) *slot = (int)__hip_atomic_fetch_add(dq, 1u, __ATOMIC_RELAXED, __HIP_MEMORY_SCOPE_AGENT);
          __syncthreads();
          const int g = *slot; if (g >= 96 + 128) break;
          const int wv = tid_ >> 6;
          const int cu_ = g < 96 ? g * 8 + wv : 768 + (g - 96) * 2 + wv;
          if (g < 96 || wv < 2) { for (int rp_ = 0; rp_ < DUP_DELTA; ++rp_) ml_delta_wave(cu_, l, in, ws, lds + wv * 16384, tid_ & 63); }
      } }
#endif
    __syncthreads(); PSTAMP(43, 0);
}
#define CHK_TOL(st) (((st) & 15) == 8 ? 1e-2f : 1e-3f)
#define CHECK_REST
constexpr int VTP = 192;
typedef short v4i16_t __attribute__((ext_vector_type(4)));
__device__ __forceinline__ int vt_lane_off(int lane) { return (4 * (lane >> 5) + ((lane & 15) >> 2)) * VTP + ((((lane >> 4) & 1) * 16) + 4 * (lane & 3)) * 2; }
__device__ __forceinline__ bf16x8 vt_frag(const LAS unsigned char* Vt, int voff, int s4, int eb) {
    const LAS unsigned char* a = Vt + voff + 16 * s4 * VTP + 64 * eb;
    const v4i16_t lo = __builtin_amdgcn_ds_read_tr16_b64_v4i16((LAS v4i16_t*)a), hi = __builtin_amdgcn_ds_read_tr16_b64_v4i16((LAS v4i16_t*)(a + 8 * VTP));
    return (bf16x8){lo[0], lo[1], lo[2], lo[3], hi[0], hi[1], hi[2], hi[3]};
}
__device__ __forceinline__ int crow(int reg, int h) { return (reg & 3) + 8 * (reg >> 2) + 4 * h; }
struct AttnState { f32x16 o[2]; float m, l; };
__device__ __forceinline__ void attn_reset(AttnState& A) { A.m = -1e30f; A.l = 0.f;
#pragma unroll
    for (int i = 0; i < 16; ++i) { A.o[0][i] = 0.f; A.o[1][i] = 0.f; } }

template <int DK>
__device__ __forceinline__ void attn_scores(f32x16 (&s)[2], const bf16x8 (&qf)[DK / 16], const LAS unsigned char* Kt, int r, int h) {
    constexpr int KP = 2 * DK + 16, NK = DK / 16;
    bf16x8 kf[2][NK];
#pragma unroll
    for (int kb = 0; kb < 2; ++kb)
#pragma unroll
        for (int ks = 0; ks < NK; ++ks) kf[kb][ks] = *(const LAS bf16x8*)(Kt + (32 * kb + r) * KP + (16 * ks + 8 * h) * 2);
    __builtin_amdgcn_sched_barrier(0);
#pragma unroll
    for (int kb = 0; kb < 2; ++kb)
#pragma unroll
        for (int i = 0; i < 16; ++i) s[kb][i] = 0.f;
#pragma unroll
    for (int ks = 0; ks < NK; ++ks) {
        s[0] = MFMA32(kf[0][ks], qf[ks], s[0]);
        s[1] = MFMA32(kf[1][ks], qf[ks], s[1]);
    }
}
__device__ __forceinline__ float max3f(float a, float b, float c) { return fmaxf(fmaxf(a, b), c); }
__device__ __forceinline__ void attn_softmax_pv(AttnState& A, f32x16 (&s)[2], const LAS unsigned char* Vt, int r, int h, float bias_c = 0.f, bool lane_ok = true) {
    constexpr float THR = 8.f; const int voff = vt_lane_off(r + 32 * h);
    float mx = max3f(s[0][0], s[0][1], s[0][2]);
#pragma unroll
    for (int i = 3; i < 15; i += 2) mx = max3f(mx, s[0][i], s[0][i + 1]);
    mx = max3f(mx, s[0][15], s[1][0]);
#pragma unroll
    for (int i = 1; i < 15; i += 2) mx = max3f(mx, s[1][i], s[1][i + 1]);
    mx = fmaxf(mx, s[1][15]);
    mx = fmaxf(mx, __shfl_xor(mx, 32));
    const float mxb = (lane_ok && mx > -1e29f) ? mx + bias_c : -1e30f;
    const bool grow = mxb > A.m + THR;
    const float mnew = grow ? mxb : A.m;
    if (__any(grow)) {
        const float alpha = __builtin_amdgcn_exp2f(A.m - mnew);
        A.l *= alpha;
#pragma unroll
        for (int i = 0; i < 16; ++i) { A.o[0][i] *= alpha; A.o[1][i] *= alpha; }
    }
    A.m = mnew;
    const float sub = (lane_ok && mnew > -1e29f) ? mnew - bias_c : 1e30f;
    float rs = 0.f;
#pragma unroll
    for (int kb = 0; kb < 2; ++kb)
#pragma unroll
        for (int i = 0; i < 16; ++i) { const float p = __builtin_amdgcn_exp2f(s[kb][i] - sub); s[kb][i] = p; rs += p; }
    rs += __shfl_xor(rs, 32);
    A.l += rs;
    bf16x8 vf[4][2];
#pragma unroll
    for (int s4 = 0; s4 < 4; ++s4)
#pragma unroll
        for (int eb = 0; eb < 2; ++eb) vf[s4][eb] = vt_frag(Vt, voff, s4, eb);
    __builtin_amdgcn_sched_barrier(0);
#pragma unroll
    for (int s4 = 0; s4 < 4; ++s4) {
        const int kb = s4 >> 1, hf = (s4 & 1) * 8;
        u32x4 pw; pw.x = pk_bf16(s[kb][hf + 0], s[kb][hf + 1]); pw.y = pk_bf16(s[kb][hf + 2], s[kb][hf + 3]); pw.z = pk_bf16(s[kb][hf + 4], s[kb][hf + 5]); pw.w = pk_bf16(s[kb][hf + 6], s[kb][hf + 7]);
        const bf16x8 pf = __builtin_bit_cast(bf16x8, pw);
#pragma unroll
        for (int eb = 0; eb < 2; ++eb) A.o[eb] = MFMA32(vf[s4][eb], pf, A.o[eb]);
    }
}
template <int DK>
__device__ __forceinline__ void attn_scores_half(f32x16& s, const bf16x8 (&qf)[DK / 16], const LAS unsigned char* Kt, int r, int h, int kb) {
    constexpr int KP = 2 * DK + 16, NK = DK / 16;
    bf16x8 kf[NK];
#pragma unroll
    for (int ks = 0; ks < NK; ++ks) kf[ks] = *(const LAS bf16x8*)(Kt + (32 * kb + r) * KP + (16 * ks + 8 * h) * 2);
    __builtin_amdgcn_sched_barrier(0);
#pragma unroll
    for (int i = 0; i < 16; ++i) s[i] = 0.f;
#pragma unroll
    for (int ks = 0; ks < NK; ++ks) s = MFMA32(kf[ks], qf[ks], s);
}
__device__ __forceinline__ void attn_softmax_pv_half(AttnState& A, f32x16& s, const LAS unsigned char* Vt, int r, int h, int kb, float bias_c = 0.f, bool lane_ok = true) {
    constexpr float THR = 8.f; const int voff = vt_lane_off(r + 32 * h);
    float mx = max3f(s[0], s[1], s[2]);
#pragma unroll
    for (int i = 3; i < 15; i += 2) mx = max3f(mx, s[i], s[i + 1]);
    mx = fmaxf(mx, s[15]);
    mx = fmaxf(mx, __shfl_xor(mx, 32));
    const float mxb = (lane_ok && mx > -1e29f) ? mx + bias_c : -1e30f;
    const bool grow = mxb > A.m + THR;
    const float mnew = grow ? mxb : A.m;
    if (__any(grow)) {
        const float alpha = __builtin_amdgcn_exp2f(A.m - mnew);
        A.l *= alpha;
#pragma unroll
        for (int i = 0; i < 16; ++i) { A.o[0][i] *= alpha; A.o[1][i] *= alpha; }
    }
    A.m = mnew;
    const float sub = (lane_ok && mnew > -1e29f) ? mnew - bias_c : 1e30f;
    float rs = 0.f;
#pragma unroll
    for (int i = 0; i < 16; ++i) { const float p = __builtin_amdgcn_exp2f(s[i] - sub); s[i] = p; rs += p; }
    rs += __shfl_xor(rs, 32);
    A.l += rs;
    bf16x8 vf[2][2];
#pragma unroll
    for (int s2 = 0; s2 < 2; ++s2)
#pragma unroll
        for (int eb = 0; eb < 2; ++eb) vf[s2][eb] = vt_frag(Vt, voff, 2 * kb + s2, eb);
    __builtin_amdgcn_sched_barrier(0);
#pragma unroll
    for (int s2 = 0; s2 < 2; ++s2) {
        const int hf = s2 * 8;
        u32x4 pw; pw.x = pk_bf16(s[hf + 0], s[hf + 1]); pw.y = pk_bf16(s[hf + 2], s[hf + 3]); pw.z = pk_bf16(s[hf + 4], s[hf + 5]); pw.w = pk_bf16(s[hf + 6], s[hf + 7]);
        const bf16x8 pf = __builtin_bit_cast(bf16x8, pw);
#pragma unroll
        for (int eb = 0; eb < 2; ++eb) A.o[eb] = MFMA32(vf[s2][eb], pf, A.o[eb]);
    }
}
template <int DK>
__device__ __forceinline__ void stage_k_load(u32x4 (&kr)[2], const bf16_t* Kg  , int tid) {
    constexpr int CH = DK / 8;
    kr[0] = *(const u32x4*)(Kg + (size_t)(tid / CH) * DK + (tid % CH) * 8);
    if (64 * CH > 512) { const int c2 = tid + 512; if (c2 < 64 * CH) kr[1] = *(const u32x4*)(Kg + (size_t)(c2 / CH) * DK + (c2 % CH) * 8); }
}
template <int DK>
__device__ __forceinline__ void stage_k_store(const u32x4 (&kr)[2], LAS unsigned char* Kt, int tid) {
    constexpr int CH = DK / 8, KP = 2 * DK + 16;
    *(LAS u32x4*)(Kt + (tid / CH) * KP + (tid % CH) * 16) = kr[0];
    if (64 * CH > 512) { const int c2 = tid + 512; if (c2 < 64 * CH) *(LAS u32x4*)(Kt + (c2 / CH) * KP + (c2 % CH) * 16) = kr[1]; }
}
__device__ __forceinline__ u32x4 stage_v_load(const bf16_t* Vg, int tid) { return *(const u32x4*)(Vg + (size_t)(tid >> 3) * 64 + (tid & 7) * 8); }
__device__ __forceinline__ void stage_v_store(const u32x4& v, LAS unsigned char* Vt, int tid) { *(LAS u32x4*)(Vt + (tid >> 3) * VTP + (tid & 7) * 16) = v; }

constexpr int MLA_KT = 0, MLA_VT = 2 * 64 * 208, MLA_LDS = MLA_VT + 2 * 64 * VTP;
__device__ __forceinline__ void mla_unit(int b, int hd, int qt, int l, unsigned char* ws, LAS unsigned char* lds, int g_wv) {
    int tid_ = TIDX; asm volatile("" : "+v"(tid_));
    const int tid = tid_, w = tid >> 6, lane = tid & 63, r = lane & 31, h = lane >> 5;
    const size_t slab = (size_t)(b * 6 + hd) * 2048;
    const bf16_t* QM = (const bf16_t*)(ws + WS_MLA) + slab * 96; const bf16_t* KM = (const bf16_t*)(ws + WS_MLA + MLA_KM) + slab * 96; const bf16_t* VM = (const bf16_t*)(ws + WS_MLA + MLA_VM) + slab * 64;
    const int q0 = 256 * qt + 32 * w, q = q0 + r;
    bf16x8 qf[6];
#pragma unroll
    for (int ks = 0; ks < 6; ++ks) qf[ks] = *(const bf16x8*)(QM + (size_t)q * 96 + 16 * ks + 8 * h);
    AttnState A; attn_reset(A);
    const int ntile = 4 * qt + 4;
    u32x4 kr[2], vr, kr2[2], vr2;
    stage_k_load<96>(kr, KM, tid); vr = stage_v_load(VM, tid);
    stage_k_store<96>(kr, lds + MLA_KT, tid); stage_v_store(vr, lds + MLA_VT, tid);
    if (ntile > 1) { stage_k_load<96>(kr, KM + (size_t)64 * 96, tid); vr = stage_v_load(VM + (size_t)64 * 64, tid); }
    __syncthreads();
    auto tile_step = [&](const int j, u32x4 (&kc)[2], u32x4& vc, u32x4 (&kn)[2], u32x4& vn) __attribute__((always_inline)) {
        const int cur = j & 1;
        if (j + 2 < ntile) { stage_k_load<96>(kn, KM + (size_t)(j + 2) * 64 * 96, tid); vn = stage_v_load(VM + (size_t)(j + 2) * 64 * 64, tid); }
        if (64 * j <= q0 + 31) {
            f32x16 s[2];
            attn_scores<96>(s, qf, lds + MLA_KT + cur * 64 * 208, r, h);
            if (64 * j + 63 > q0) {
#pragma unroll
                for (int kb = 0; kb < 2; ++kb)
#pragma unroll
                    for (int i = 0; i < 16; ++i) { const int key = 64 * j + 32 * kb + crow(i, h); if (key > q) s[kb][i] = -1e30f; }
            }
            attn_softmax_pv(A, s, lds + MLA_VT + cur * 64 * VTP, r, h);
        }
        if (j + 1 < ntile) { stage_k_store<96>(kc, lds + MLA_KT + (cur ^ 1) * 64 * 208, tid); stage_v_store(vc, lds + MLA_VT + (cur ^ 1) * 64 * VTP, tid); }
        __syncthreads();
    };
#pragma unroll 1
    for (int j = 0; j < ntile; j += 2) { tile_step(j, kr, vr, kr2, vr2); tile_step(j + 1, kr2, vr2, kr, vr); }
    const float inv = A.l > 0.f ? 1.f / A.l : 0.f; float ss = 0.f;
    bf16_t* Y = (bf16_t*)(ws + WS_Y) + ((size_t)b * 2048 + q) * 1024 + 384 + hd * 64;
#pragma unroll
    for (int eb = 0; eb < 2; ++eb)
#pragma unroll
        for (int g4 = 0; g4 < 4; ++g4) {
            const float v0 = A.o[eb][4 * g4] * inv, v1 = A.o[eb][4 * g4 + 1] * inv, v2 = A.o[eb][4 * g4 + 2] * inv, v3 = A.o[eb][4 * g4 + 3] * inv;
            u32x2 pw; pw.x = pk_bf16(v0, v1); pw.y = pk_bf16(v2, v3);
            const float f0 = bf_lo(pw.x), f1 = bf_hi(pw.x), f2 = bf_lo(pw.y), f3 = bf_hi(pw.y); ss += (f0 * f0 + f1 * f1) + (f2 * f2 + f3 * f3);
            *(u32x2*)(Y + 32 * eb + 8 * g4 + 4 * h) = pw;
        }
    ss += __shfl_xor(ss, 32);
    if (h == 0) ((float*)(ws + WS_SSQ + PT_C))[((size_t)l * 16384 + (size_t)b * 2048 + q) * 8 + hd] = ss;
}

__device__ __forceinline__ void nsa_bias32(float (&bv)[2][16], const LAS float* bl, int dd) {
#pragma unroll
    for (int kb = 0; kb < 2; ++kb)
#pragma unroll
        for (int k = 0; k < 16; ++k) { const int c = 63 - (32 * kb + (k & 3) + 8 * (k >> 2)); int d = dd + c; d = d < 0 ? 0 : (d > 255 ? 255 : d); bv[kb][k] = bl[d]; }
}
__device__ __forceinline__ void nsa_mask_bias(f32x16 (&sc)[2], int dq, int h, const LAS float* bl) {
    int dd = dq - 4 * h - 63; asm volatile("" : "+v"(dd));
    const LAS float* p = bl + dd;
    float bv[2][16];
#pragma unroll
    for (int kb = 0; kb < 2; ++kb)
#pragma unroll
        for (int k = 0; k < 16; ++k) bv[kb][k] = p[63 - (32 * kb + (k & 3) + 8 * (k >> 2))];
#pragma unroll
    for (int kb = 0; kb < 2; ++kb)
#pragma unroll
        for (int k = 0; k < 16; ++k) sc[kb][k] += bv[kb][k];
}
__device__ __forceinline__ void nsa_mask_bias_half(f32x16& sc, int dq, int h, const LAS float* bl, int kb) {
    int dd = dq - 4 * h - 32 * kb - 31; asm volatile("" : "+v"(dd));
    const LAS float* p = bl + dd;
    float bv[16];
#pragma unroll
    for (int k = 0; k < 16; ++k) bv[k] = p[31 - ((k & 3) + 8 * (k >> 2))];
#pragma unroll
    for (int k = 0; k < 16; ++k) sc[k] += bv[k];
}
__device__ __forceinline__ void attn_park(const AttnState& A, LAS float* xl) {
    xl[0] = A.m; xl[64] = A.l;
#pragma unroll
    for (int k = 0; k < 16; ++k) { xl[64 * (2 + k)] = A.o[0][k]; xl[64 * (18 + k)] = A.o[1][k]; }
}
__device__ __forceinline__ void attn_merge(AttnState& A, const LAS float* xl) {
    const float m2 = xl[0], l2 = xl[64]; const float m = fmaxf(A.m, m2);
    const float a1 = A.m > -1e29f ? __builtin_amdgcn_exp2f(A.m - m) : 0.f, a2 = m2 > -1e29f ? __builtin_amdgcn_exp2f(m2 - m) : 0.f;
    A.l = A.l * a1 + l2 * a2; A.m = m;
#pragma unroll
    for (int k = 0; k < 16; ++k) { A.o[0][k] = A.o[0][k] * a1 + xl[64 * (2 + k)] * a2; A.o[1][k] = A.o[1][k] * a1 + xl[64 * (18 + k)] * a2; }
}
constexpr int NSA_KT = 0, NSA_VT = 2 * 64 * 144, NSA_BIAS = NSA_VT + 2 * 64 * VTP, NSA_PS = NSA_BIAS + 3 * 640 * 4, NSA_SEL = NSA_PS + 3 * 64 * 32 * 4, NSA_UNI = NSA_SEL + 256, NSA_OT = NSA_UNI + 256, NSA_LDS = NSA_OT + 6 * 8192;
__device__ __forceinline__ void nsa_unit(int b, int hk, int i, int l, InPtr in, unsigned char* ws, LAS unsigned char* lds, int g_wv) {
    int tid_ = TIDX; asm volatile("" : "+v"(tid_));
    const int tid = tid_, w = tid >> 6, lane = tid & 63, r = lane & 31, h = lane >> 5;
    const bool active = w < 6; const int g = active ? (w >> 1) : 2, th = w & 1, head = hk * 3 + g;
    const int kh = w < 4 ? -1 : (w < 6 ? 0 : 1);
    LAS float* xl = (LAS float*)(lds + NSA_LDS) + th * (34 * 64) + lane;
    const int t = 64 * i + 32 * th + r, tl = 32 * th + r; const size_t row = (size_t)b * 2048 + t;
    const size_t kvslab = (size_t)(b * 2 + hk) * 2048 * 64;
    LAS float* biasl = (LAS float*)(lds + NSA_BIAS); LAS float* PS = (LAS float*)(lds + NSA_PS); LAS unsigned* SEL = (LAS unsigned*)(lds + NSA_SEL); LAS unsigned* UNI = (LAS unsigned*)(lds + NSA_UNI);
    { const float* bd = (const float*)(ws + WS_BIASD) + (size_t)hk * 3 * 2048;
#pragma unroll
      for (int k = 0; k < 4; ++k) { const int e = tid + 512 * k; if (e < 1920) { const int gg = e / 640, d = e - gg * 640 - 63; biasl[e] = (d < 0 || d >= 512) ? -1e30f : bd[gg * 2048 + d]; } }
#pragma unroll
      for (int k = 0; k < 12; ++k) if (i >= 16) PS[tid + 512 * k] = 0.f;
      if (tid < 4) UNI[tid] = 0u; }
    bf16x8 qf[4];
    { const bf16_t* QN = (const bf16_t*)(ws + WS_PRJ + PRJ_QN) + ((size_t)(b * 6 + head) * 2048 + t) * 64;
#pragma unroll
      for (int ks = 0; ks < 4; ++ks) qf[ks] = *(const bf16x8*)(QN + 16 * ks + 8 * h); }
#define NSA_GATE(k) ({ int t_ = t; asm volatile("" : "+v"(t_)); sigmf(((const float*)(ws + WS_PRJ + PRJ_GATES))[((size_t)b * 2048 + t_) * 32 + head * 3 + (k)]); })
    LAS float* bl = biasl + g * 640 + 63;
    LAS float* otl = (LAS float*)(lds + NSA_OT + (active ? w : 0) * 8192) + lane;
    u32x4 kr[2], vr;
    const int ntc = i >= 16 ? 2 : 1;
    { const bf16_t* KC = (const bf16_t*)(ws + WS_CMP) + (size_t)(b * 2 + hk) * 128 * 64; const bf16_t* VC = (const bf16_t*)(ws + WS_CMP + CMP_V) + (size_t)(b * 2 + hk) * 128 * 64;
      for (int T = 0; T < ntc; ++T) { stage_k_load<64>(kr, KC + T * 4096, tid); vr = stage_v_load(VC + T * 4096, tid); stage_k_store<64>(kr, lds + NSA_KT + T * 64 * 144, tid); stage_v_store(vr, lds + NSA_VT + T * 64 * VTP, tid); } }
    __syncthreads();
    {
        f32x16 ot[2];
        if (active && i < 16) {
            AttnState A; attn_reset(A); f32x16 sc[2]; attn_scores<64>(sc, qf, lds + NSA_KT, r, h);
            float bvc[2][16];
#pragma unroll
            for (int kb = 0; kb < 2; ++kb)
#pragma unroll
                for (int k = 0; k < 16; ++k) { int d = t - 16 * (32 * kb + crow(k, h)) - 31; d = d < 0 ? 0 : (d > 255 ? 255 : d); bvc[kb][k] = bl[d]; }
#pragma unroll
            for (int kb = 0; kb < 2; ++kb)
#pragma unroll
                for (int k = 0; k < 16; ++k) { const int d = t - 16 * (32 * kb + crow(k, h)) - 31; sc[kb][k] = d >= 0 ? sc[kb][k] + bvc[kb][k] : -1e30f; }
            attn_softmax_pv(A, sc, lds + NSA_VT, r, h);
            const float gc = NSA_GATE(0); const float inv = A.l > 0.f ? gc / A.l : 0.f;
#pragma unroll
            for (int k = 0; k < 16; ++k) { otl[64 * k] = A.o[0][k] * inv; otl[64 * (16 + k)] = A.o[1][k] * inv; }
        } else if (active) {
            float m = -1e30f, lsum = 0.f;
            for (int T = 0; T < ntc; ++T) {
                f32x16 sc[2]; attn_scores<64>(sc, qf, lds + NSA_KT + T * 64 * 144, r, h);
                float bvc[2][16];
#pragma unroll
                for (int kb = 0; kb < 2; ++kb)
#pragma unroll
                    for (int k = 0; k < 16; ++k) { int d = t - 16 * (64 * T + 32 * kb + crow(k, h)) - 31; d = d < 0 ? 0 : (d > 255 ? 255 : d); bvc[kb][k] = bl[d]; }
                float mx = -1e30f;
#pragma unroll
                for (int kb = 0; kb < 2; ++kb)
#pragma unroll
                    for (int k = 0; k < 16; ++k) { const int n = 64 * T + 32 * kb + crow(k, h); const int d = t - 16 * n - 31; const float x = (d >= 0 && n < 127) ? sc[kb][k] + bvc[kb][k] : -1e30f; sc[kb][k] = x; mx = fmaxf(mx, x); }
                mx = fmaxf(mx, __shfl_xor(mx, 32));
                const float mnew = fmaxf(m, mx), mref = mnew <= -1e29f ? 0.f : mnew; float rs = 0.f;
#pragma unroll
                for (int kb = 0; kb < 2; ++kb)
#pragma unroll
                    for (int k = 0; k < 16; ++k) rs += __builtin_amdgcn_exp2f(sc[kb][k] - mref);
                rs += __shfl_xor(rs, 32);
                lsum = lsum * __builtin_amdgcn_exp2f(m - mref) + rs; m = mnew;
            }
            const float mref = m <= -1e29f ? 0.f : m, inv = lsum > 0.f ? 1.f / lsum : 0.f;
#pragma unroll
            for (int k = 0; k < 16; ++k) { ot[0][k] = 0.f; ot[1][k] = 0.f; }
            float carry = 0.f;
            for (int T = 0; T < ntc; ++T) {
                f32x16 sc[2]; attn_scores<64>(sc, qf, lds + NSA_KT + T * 64 * 144, r, h);
                float bvc[2][16];
#pragma unroll
                for (int kb = 0; kb < 2; ++kb)
#pragma unroll
                    for (int k = 0; k < 16; ++k) { int d = t - 16 * (64 * T + 32 * kb + crow(k, h)) - 31; d = d < 0 ? 0 : (d > 255 ? 255 : d); bvc[kb][k] = bl[d]; }
#pragma unroll
                for (int kb = 0; kb < 2; ++kb)
#pragma unroll
                    for (int k = 0; k < 16; ++k) { const int n = 64 * T + 32 * kb + crow(k, h); const int d = t - 16 * n - 31; sc[kb][k] = (d >= 0 && n < 127) ? __builtin_amdgcn_exp2f(sc[kb][k] + bvc[kb][k] - mref) * inv : 0.f; }
                float prevL = carry;
#pragma unroll
                for (int kb = 0; kb < 2; ++kb)
#pragma unroll
                    for (int g4 = 0; g4 < 4; ++g4) {
                        const float G4 = (sc[kb][4 * g4] + sc[kb][4 * g4 + 1]) + (sc[kb][4 * g4 + 2] + sc[kb][4 * g4 + 3]); const float L = sc[kb][4 * g4 + 3];
                        const float Lo = __shfl_xor(L, 32);
                        const float add = h ? Lo : prevL;
                        prevL = Lo;
                        const int idx = T * 8 + kb * 4 + g4;
                        PS[g * 2048 + tl * 32 + 2 * idx + h] = G4 + add;
                    }
                carry = prevL;
#pragma unroll
                for (int s4 = 0; s4 < 4; ++s4) {
                    const int kb = s4 >> 1, hf = (s4 & 1) * 8;
                    u32x4 pw; pw.x = pk_bf16(sc[kb][hf + 0], sc[kb][hf + 1]); pw.y = pk_bf16(sc[kb][hf + 2], sc[kb][hf + 3]); pw.z = pk_bf16(sc[kb][hf + 4], sc[kb][hf + 5]); pw.w = pk_bf16(sc[kb][hf + 6], sc[kb][hf + 7]);
                    const bf16x8 pf = __builtin_bit_cast(bf16x8, pw);
#pragma unroll
                    for (int eb = 0; eb < 2; ++eb) ot[eb] = MFMA32(vt_frag(lds + NSA_VT + T * 64 * VTP, vt_lane_off(lane), s4, eb), pf, ot[eb]);
                }
            }
            { const float gc = NSA_GATE(0);
#pragma unroll
            for (int k = 0; k < 16; ++k) { otl[64 * k] = ot[0][k] * gc; otl[64 * (16 + k)] = ot[1][k] * gc; } }
        }
    }
    __syncthreads();
#ifndef NO_NSA_SEL
    if (i < 16) { if (tid < 64) SEL[tid] = (2u << i) - 1u; if (tid < 3) UNI[tid] = (2u << i) - 1u; }
    else {
        const int tk = tid >> 3, sg = tid & 7; float v[32];
#pragma unroll
        for (int k = 0; k < 8; ++k) { const f32x4 x0 = *(const LAS f32x4*)(PS + tk * 32 + 4 * k), x1 = *(const LAS f32x4*)(PS + 2048 + tk * 32 + 4 * k), x2 = *(const LAS f32x4*)(PS + 4096 + tk * 32 + 4 * k);
            v[4 * k] = (x0.x + x1.x) + x2.x; v[4 * k + 1] = (x0.y + x1.y) + x2.y; v[4 * k + 2] = (x0.z + x1.z) + x2.z; v[4 * k + 3] = (x0.w + x1.w) + x2.w; }
#pragma unroll
        for (int s = 0; s < 32; ++s) { const bool forced = (s == 0) || (s == i) || (s == i - 1); float x = forced ? v[s] + 1e4f : v[s]; v[s] = s > i ? -1.f : x; }
        unsigned bits = 0u;
#pragma unroll
        for (int k = 0; k < 4; ++k) {
            float x = 0.f;
#pragma unroll
            for (int s = 0; s < 32; ++s) x = (s == 4 * sg + k) ? v[s] : x;
            int rank = 0;
#pragma unroll
            for (int s = 0; s < 32; ++s) rank += (v[s] > x || (v[s] == x && s < 4 * sg + k)) ? 1 : 0;
            if (rank < 16 && x >= 0.f) bits |= 1u << (4 * sg + k);
        }
        bits |= shx<1>(bits); bits |= shx<2>(bits); bits |= shx<4>(bits);
        if (sg == 0) { SEL[tk] = bits; __hip_atomic_fetch_or(UNI, bits, __ATOMIC_RELAXED, __HIP_MEMORY_SCOPE_WORKGROUP); __hip_atomic_fetch_or(UNI + 1 + (tk >> 5), bits, __ATOMIC_RELAXED, __HIP_MEMORY_SCOPE_WORKGROUP); }
    }
#endif
    __syncthreads();
    const unsigned selbits = SEL[tl], uni = UNI[0], unih = UNI[1 + th];
    const float c31 = bl[255];
#ifndef NO_NSA_SLC
#ifndef NSA_DUP_SLC
#define NSA_DUP_SLC 1
#endif
    for (int rp_ = 0; rp_ < NSA_DUP_SLC; ++rp_) {
        AttnState A; attn_reset(A);
        const bf16_t* KS = (const bf16_t*)(ws + WS_PRJ + PRJ_KN1) + kvslab; const bf16_t* VS = (const bf16_t*)(ws + WS_PRJ + PRJ_VN1) + kvslab;
        auto slc_loop = [&](auto full_tag) __attribute__((always_inline)) {
        constexpr bool FULL = decltype(full_tag)::value;
        unsigned todo = uni; int cur = 0; u32x4 kr2[2], vr2;
        int s = __ffs(todo) - 1; todo &= todo - 1;
        stage_k_load<64>(kr, KS + (size_t)s * 4096, tid); vr = stage_v_load(VS + (size_t)s * 4096, tid);
        stage_k_store<64>(kr, lds + NSA_KT, tid); stage_v_store(vr, lds + NSA_VT, tid);
        int sn = todo ? __ffs(todo) - 1 : -1; todo &= todo - 1;
        if (sn >= 0) { stage_k_load<64>(kr, KS + (size_t)sn * 4096, tid); vr = stage_v_load(VS + (size_t)sn * 4096, tid); }
        __syncthreads();
        auto step = [&](u32x4 (&ka)[2], u32x4& va, u32x4 (&kb_)[2], u32x4& vb_) __attribute__((always_inline)) {
            const int sn2 = todo ? __ffs(todo) - 1 : -1; todo &= todo - 1;
            if (sn2 >= 0) { stage_k_load<64>(kb_, KS + (size_t)sn2 * 4096, tid); vb_ = stage_v_load(VS + (size_t)sn2 * 4096, tid); }
            if ((unih >> s) & 1u) {
                const bool sel = (selbits >> s) & 1u;
                if constexpr (FULL) {
                    f32x16 sc[2];
                    attn_scores<64>(sc, qf, lds + NSA_KT + cur * 64 * 144, r, h);
                    float bc = c31; if (i - s < 3) { nsa_mask_bias(sc, t - 64 * s, h, bl); bc = 0.f; }
                    attn_softmax_pv(A, sc, lds + NSA_VT + cur * 64 * VTP, r, h, bc, sel);
                } else {
                    f32x16 s1;
                    attn_scores_half<64>(s1, qf, lds + NSA_KT + cur * 64 * 144, r, h, kh);
                    float bc = c31; if (i - s < 3) { nsa_mask_bias_half(s1, t - 64 * s, h, bl, kh); bc = 0.f; }
                    attn_softmax_pv_half(A, s1, lds + NSA_VT + cur * 64 * VTP, r, h, kh, bc, sel);
                }
            }
            if (sn >= 0) { stage_k_store<64>(ka, lds + NSA_KT + (cur ^ 1) * 64 * 144, tid); stage_v_store(va, lds + NSA_VT + (cur ^ 1) * 64 * VTP, tid); }
            __syncthreads();
            s = sn; sn = sn2; cur ^= 1;
        };
        while (s >= 0) { step(kr, vr, kr2, vr2); if (s < 0) break; step(kr2, vr2, kr, vr); }
        };
        if (kh < 0) slc_loop(std::true_type{}); else slc_loop(std::false_type{});
        if (kh == 1) attn_park(A, xl);
        __syncthreads();
        if (kh == 0) attn_merge(A, xl);
        if (active && rp_ == NSA_DUP_SLC - 1) { const float gs = NSA_GATE(1); const float inv = A.l > 0.f ? gs / A.l : 0.f;
#pragma unroll
            for (int k = 0; k < 16; ++k) { otl[64 * k] += A.o[0][k] * inv; otl[64 * (16 + k)] += A.o[1][k] * inv; } }
    }
#endif
#ifndef NO_NSA_WIN
#ifndef NSA_DUP_WIN
#define NSA_DUP_WIN 1
#endif
    for (int rq_ = 0; rq_ < NSA_DUP_WIN; ++rq_) {
        AttnState A; attn_reset(A);
        const bf16_t* KW = (const bf16_t*)(ws + WS_PRJ + PRJ_KN2) + kvslab; const bf16_t* VW = (const bf16_t*)(ws + WS_PRJ + PRJ_VN2) + kvslab;
        const int j0 = i > 8 ? i - 8 : 0;
        auto win_loop = [&](auto full_tag) __attribute__((always_inline)) {
        constexpr bool FULL = decltype(full_tag)::value;
        int cur = 0; u32x4 kr2[2], vr2;
        stage_k_load<64>(kr, KW + (size_t)j0 * 4096, tid); vr = stage_v_load(VW + (size_t)j0 * 4096, tid);
        stage_k_store<64>(kr, lds + NSA_KT, tid); stage_v_store(vr, lds + NSA_VT, tid);
        if (j0 < i) { stage_k_load<64>(kr, KW + (size_t)(j0 + 1) * 4096, tid); vr = stage_v_load(VW + (size_t)(j0 + 1) * 4096, tid); }
        __syncthreads();
        for (int j = j0; j <= i; ++j) {
            if (j + 2 <= i) { stage_k_load<64>(kr2, KW + (size_t)(j + 2) * 4096, tid); vr2 = stage_v_load(VW + (size_t)(j + 2) * 4096, tid); }
            if constexpr (FULL) {
                f32x16 sc[2];
                attn_scores<64>(sc, qf, lds + NSA_KT + cur * 64 * 144, r, h);
                float bc = c31; if (!(i - j >= 3 && j > i - 8)) { nsa_mask_bias(sc, t - 64 * j, h, bl); bc = 0.f; }
                attn_softmax_pv(A, sc, lds + NSA_VT + cur * 64 * VTP, r, h, bc, true);
            } else {
                f32x16 s1;
                attn_scores_half<64>(s1, qf, lds + NSA_KT + cur * 64 * 144, r, h, kh);
                float bc = c31; if (!(i - j >= 3 && j > i - 8)) { nsa_mask_bias_half(s1, t - 64 * j, h, bl, kh); bc = 0.f; }
                attn_softmax_pv_half(A, s1, lds + NSA_VT + cur * 64 * VTP, r, h, kh, bc, true);
            }
            if (j < i) { stage_k_store<64>(kr, lds + NSA_KT + (cur ^ 1) * 64 * 144, tid); stage_v_store(vr, lds + NSA_VT + (cur ^ 1) * 64 * VTP, tid); }
            kr[0] = kr2[0]; vr = vr2;
            __syncthreads();
            cur ^= 1;
        }
        };
        if (kh < 0) win_loop(std::true_type{}); else win_loop(std::false_type{});
        if (kh == 1) attn_park(A, xl);
        __syncthreads();
        if (kh == 0) attn_merge(A, xl);
        if (active && rq_ == NSA_DUP_WIN - 1) { const float gw = NSA_GATE(2); const float inv = A.l > 0.f ? gw / A.l : 0.f;
            float ss = 0.f; bf16_t* Y = (bf16_t*)(ws + WS_Y) + row * 1024 + head * 64;
#pragma unroll
            for (int eb = 0; eb < 2; ++eb)
#pragma unroll
                for (int g4 = 0; g4 < 4; ++g4) {
                    const float v0 = otl[64 * (16 * eb + 4 * g4)] + A.o[eb][4 * g4] * inv, v1 = otl[64 * (16 * eb + 4 * g4 + 1)] + A.o[eb][4 * g4 + 1] * inv;
                    const float v2 = otl[64 * (16 * eb + 4 * g4 + 2)] + A.o[eb][4 * g4 + 2] * inv, v3 = otl[64 * (16 * eb + 4 * g4 + 3)] + A.o[eb][4 * g4 + 3] * inv;
                    u32x2 pw; pw.x = pk_bf16(v0, v1); pw.y = pk_bf16(v2, v3);
                    const float f0 = bf_lo(pw.x), f1 = bf_hi(pw.x), f2 = bf_lo(pw.y), f3 = bf_hi(pw.y); ss += (f0 * f0 + f1 * f1) + (f2 * f2 + f3 * f3);
                    *(u32x2*)(Y + 32 * eb + 8 * g4 + 4 * h) = pw;
                }
            ss += __shfl_xor(ss, 32);
            if (h == 0) ((float*)(ws + WS_SSQ + PT_A))[((size_t)l * 16384 + row) * 8 + head] = ss;
        }
    }
#endif
}

__device__ __forceinline__ void ml_out_wave(int cu, int l, InPtr in, unsigned char* ws, LAS unsigned char* wl, LAS unsigned char* npl, int lane) {
    const int c = cu & 31, bh = cu >> 5, hd = bh & 3, b = bh >> 2; const int t0 = c * 64; const int r = lane & 15, q = lane >> 4;
    const bf16_t* QC = (const bf16_t*)(ws + WS_ML) + ((size_t)bh * 2048 + t0) * 64; const bf16_t* KC = (const bf16_t*)(ws + WS_ML + ML_KC) + ((size_t)bh * 2048 + t0) * 64;
    const bf16_t* V = (const bf16_t*)(ws + WS_PRJ + PRJ_VML) + ((size_t)bh * 2048 + t0) * 64;
    const float* mlg = (const float*)(ws + WS_ML + ML_G) + ((size_t)bh * 2048 + t0) * 2;
    const bf16_t* CP = (const bf16_t*)(ws + WS_ML + ML_CP) + (size_t)cu * 4096; const bf16_t* NP = (const bf16_t*)(ws + WS_ML + ML_NP) + (size_t)cu * 64;
    u32x4 vch[8];
#pragma unroll
    for (int i = 0; i < 8; ++i) vch[i] = *(const u32x4*)(V + (size_t)(lane + 64 * i) * 8);
    bf16x8 aq[4][2];
#pragma unroll
    for (int mb = 0; mb < 4; ++mb)
#pragma unroll
        for (int ks = 0; ks < 2; ++ks) aq[mb][ks] = *(const bf16x8*)(QC + (size_t)(16 * mb + r) * 64 + 32 * ks + 8 * q);
    float bj[4][4], den[4][4];
#pragma unroll
    for (int mb = 0; mb < 4; ++mb)
#pragma unroll
        for (int j = 0; j < 4; ++j) bj[mb][j] = mlg[(16 * mb + 4 * q + j) * 2];
    {
        float cs[4];
#pragma unroll
        for (int nb = 0; nb < 4; ++nb) { const float2 gg = *(const float2*)(mlg + (16 * nb + r) * 2); cs[nb] = gg.y - gg.x; }
#pragma unroll
        for (int mb = 0; mb < 4; ++mb) {
            f32x4 accS[4];
#pragma unroll
            for (int nb = 0; nb < 4; ++nb) { accS[nb] = (f32x4){0.f, 0.f, 0.f, 0.f};
#pragma unroll
                for (int ks = 0; ks < 2; ++ks) { const bf16x8 bk = *(const bf16x8*)(KC + (size_t)(16 * nb + r) * 64 + 32 * ks + 8 * q); accS[nb] = MFMA16(aq[mb][ks], bk, accS[nb]); } }
#pragma unroll
            for (int j = 0; j < 4; ++j) {
                const int jj = 16 * mb + 4 * q + j; float rs = 0.f;
#pragma unroll
                for (int nb = 0; nb < 4; ++nb) { const int s = 16 * nb + r; const float p = s <= jj ? accS[nb][j] * __expf(bj[mb][j] + cs[nb]) : 0.f; rs += p;
                    *(LAS bf16_t*)(wl + 8192 + swz_off(jj, s >> 3) + (s & 7) * 2) = f2bf(p); }
                rs += shx<1>(rs); rs += shx<2>(rs); rs += shx<4>(rs); rs += shx<8>(rs);
                den[mb][j] = rs;
            }
        }
    }
#pragma unroll
    for (int i = 0; i < 8; ++i) { const int ch = lane + 64 * i, sv = ch >> 3, e0 = (ch & 7) * 8; const unsigned xs[4] = {vch[i].x, vch[i].y, vch[i].z, vch[i].w};
#pragma unroll
        for (int k = 0; k < 4; ++k) { *(LAS bf16_t*)(wl + swz_off(e0 + 2 * k, sv >> 3) + (sv & 7) * 2) = (bf16_t)(xs[k] & 0xffffu); *(LAS bf16_t*)(wl + swz_off(e0 + 2 * k + 1, sv >> 3) + (sv & 7) * 2) = (bf16_t)(xs[k] >> 16); } }
#pragma unroll
    for (int mb = 0; mb < 4; ++mb) { const float e = __expf(mlg[(16 * mb + r) * 2]);
#pragma unroll
        for (int ks = 0; ks < 2; ++ks) { const u32x4 x = __builtin_bit_cast(u32x4, aq[mb][ks]); u32x4 y;
            y.x = pk_bf16(bf_lo(x.x) * e, bf_hi(x.x) * e); y.y = pk_bf16(bf_lo(x.y) * e, bf_hi(x.y) * e); y.z = pk_bf16(bf_lo(x.z) * e, bf_hi(x.z) * e); y.w = pk_bf16(bf_lo(x.w) * e, bf_hi(x.w) * e);
            aq[mb][ks] = __builtin_bit_cast(bf16x8, y); } }
    f32x4 acc[4][4], accn[4];
#pragma unroll
    for (int mb = 0; mb < 4; ++mb) { accn[mb] = (f32x4){0.f, 0.f, 0.f, 0.f};
#pragma unroll
        for (int nb = 0; nb < 4; ++nb) acc[mb][nb] = (f32x4){0.f, 0.f, 0.f, 0.f}; }
#pragma unroll
    for (int ks = 0; ks < 2; ++ks) {
        u32x4 nz = *(const u32x4*)(NP + 32 * ks + 8 * q); if (r != 0) nz = (u32x4){0u, 0u, 0u, 0u};
        const bf16x8 bn = __builtin_bit_cast(bf16x8, nz);
#pragma unroll
        for (int nb = 0; nb < 4; ++nb) { const bf16x8 bb = *(const bf16x8*)(CP + (size_t)(16 * nb + r) * 64 + 32 * ks + 8 * q);
#pragma unroll
            for (int mb = 0; mb < 4; ++mb) acc[mb][nb] = MFMA16(aq[mb][ks], bb, acc[mb][nb]); }
#pragma unroll
        for (int mb = 0; mb < 4; ++mb) accn[mb] = MFMA16(aq[mb][ks], bn, accn[mb]);
    }
    LDS_FENCE();
#pragma unroll
    for (int ks = 0; ks < 2; ++ks) {
        bf16x8 ap[4];
#pragma unroll
        for (int mb = 0; mb < 4; ++mb) ap[mb] = *(const LAS bf16x8*)(wl + 8192 + swz_off(16 * mb + r, 4 * ks + q));
#pragma unroll
        for (int nb = 0; nb < 4; ++nb) { const bf16x8 bv = *(const LAS bf16x8*)(wl + swz_off(16 * nb + r, 4 * ks + q));
#pragma unroll
            for (int mb = 0; mb < 4; ++mb) acc[mb][nb] = MFMA16(ap[mb], bv, acc[mb][nb]); }
    }
    LDS_FENCE();
    const bf16_t* OG = (const bf16_t*)(ws + WS_PRJ + PRJ_OG); u32x4 ogc[8];
#pragma unroll
    for (int i = 0; i < 8; ++i) { const int ch = lane + 64 * i; ogc[i] = *(const u32x4*)(OG + ((size_t)b * 2048 + t0 + (ch >> 3)) * 256 + hd * 64 + (ch & 7) * 8); }
    const float* gain = in->p[14] + l * 256 + hd * 64;
    bf16_t* Y = (bf16_t*)(ws + WS_Y);
    float gn[4];
#pragma unroll
    for (int nb = 0; nb < 4; ++nb) gn[nb] = gain[16 * nb + r];
#pragma unroll
    for (int mb = 0; mb < 4; ++mb)
#pragma unroll
        for (int j = 0; j < 4; ++j) {
            const int jj = 16 * mb + 4 * q + j;
            const float dn = den[mb][j] + __builtin_bit_cast(float, __builtin_amdgcn_ds_bpermute((lane & 48) << 2, __builtin_bit_cast(int, accn[mb][j])));
            const float inv = __builtin_amdgcn_rcpf(fmaxf(fabsf(dn), 1.f)); float hv[4]; float ss = 0.f;
#pragma unroll
            for (int nb = 0; nb < 4; ++nb) { hv[nb] = acc[mb][nb][j] * inv; ss += hv[nb] * hv[nb]; }
            ss += shx<1>(ss); ss += shx<2>(ss); ss += shx<4>(ss); ss += shx<8>(ss);
            const float rstd = rsqrtf(ss * (1.f / 64.f) + 1e-6f);
#pragma unroll
            for (int nb = 0; nb < 4; ++nb) { const int e = 16 * nb + r; *(LAS bf16_t*)(wl + 8192 + swz_off(jj, e >> 3) + (e & 7) * 2) = f2bf(hv[nb] * rstd * gn[nb]); }
        }
    LDS_FENCE();
#pragma unroll
    for (int i = 0; i < 8; ++i) { const int ch = lane + 64 * i, row = ch >> 3, e8 = ch & 7;
        const u32x4 hx = *(const LAS u32x4*)(wl + 8192 + swz_off(row, e8)); const u32x4 g = ogc[i]; u32x4 o;
        o.x = pk_bf16(bf_lo(hx.x) * sigmf(bf_lo(g.x)), bf_hi(hx.x) * sigmf(bf_hi(g.x)));
        o.y = pk_bf16(bf_lo(hx.y) * sigmf(bf_lo(g.y)), bf_hi(hx.y) * sigmf(bf_hi(g.y)));
        o.z = pk_bf16(bf_lo(hx.z) * sigmf(bf_lo(g.z)), bf_hi(hx.z) * sigmf(bf_hi(g.z)));
        o.w = pk_bf16(bf_lo(hx.w) * sigmf(bf_lo(g.w)), bf_hi(hx.w) * sigmf(bf_hi(g.w)));
        *(u32x4*)(Y + ((size_t)b * 2048 + t0 + row) * 1024 + 768 + hd * 64 + e8 * 8) = o; }
    LDS_FENCE();
}

__device__ __forceinline__ void ml_scan_unit(int bh, int l, unsigned char* ws, int g_wv) {
    int tid_ = TIDX; asm volatile("" : "+v"(tid_)); const int tid = tid_;
    const bf16_t* DL = (const bf16_t*)(ws + WS_ML + ML_DELTA) + (size_t)bh * 32 * 4096 + tid * 8; bf16_t* CP = (bf16_t*)(ws + WS_ML + ML_CP) + (size_t)bh * 32 * 4096 + tid * 8;
    const float* DN = (const float*)(ws + WS_ML + ML_DN) + (size_t)bh * 32 * 64; bf16_t* NP = (bf16_t*)(ws + WS_ML + ML_NP) + (size_t)bh * 32 * 64; const float* BL = (const float*)(ws + WS_ML + ML_BL) + bh * 32;
    float c[8]; float n = 0.f;
#pragma unroll
    for (int k = 0; k < 8; ++k) c[k] = 0.f;
#pragma unroll 1
    for (int c0 = 0; c0 < 32; c0 += 8) {
        u32x4 d[8]; float dn[8], co[8];
#pragma unroll
        for (int k = 0; k < 8; ++k) { d[k] = *(const u32x4*)(DL + (size_t)(c0 + k) * 4096); dn[k] = tid < 64 ? DN[(c0 + k) * 64 + tid] : 0.f; co[k] = __expf(BL[c0 + k]); }
#pragma unroll
        for (int k = 0; k < 8; ++k) {
            u32x4 o; o.x = pk_bf16(c[0], c[1]); o.y = pk_bf16(c[2], c[3]); o.z = pk_bf16(c[4], c[5]); o.w = pk_bf16(c[6], c[7]);
            *(u32x4*)(CP + (size_t)(c0 + k) * 4096) = o; if (tid < 64) NP[(c0 + k) * 64 + tid] = f2bf(n);
            c[0] = co[k] * c[0] + bf_lo(d[k].x); c[1] = co[k] * c[1] + bf_hi(d[k].x); c[2] = co[k] * c[2] + bf_lo(d[k].y); c[3] = co[k] * c[3] + bf_hi(d[k].y);
            c[4] = co[k] * c[4] + bf_lo(d[k].z); c[5] = co[k] * c[5] + bf_hi(d[k].z); c[6] = co[k] * c[6] + bf_lo(d[k].w); c[7] = co[k] * c[7] + bf_hi(d[k].w);
            n = co[k] * n + dn[k];
        }
    }
    asm volatile("s_waitcnt vmcnt(0)" ::: "memory"); __syncthreads();
    if (tid == 0) { __builtin_amdgcn_fence(__ATOMIC_RELEASE, "agent"); asm volatile("s_waitcnt vmcnt(0)" ::: "memory");
        __hip_atomic_fetch_add((unsigned*)(ws + WS_CTL) + CW_SCAN + 64 * l, 1u, __ATOMIC_RELAXED, __HIP_MEMORY_SCOPE_AGENT); }
}
__device__ __forceinline__ void ml_scan_wait(int l, unsigned char* ws, int g_wv) {
    if (TIDX == 0) { unsigned* p = (unsigned*)(ws + WS_CTL) + CW_SCAN + 64 * l; unsigned sp = 0;
        while (__hip_atomic_load(p, __ATOMIC_RELAXED, __HIP_MEMORY_SCOPE_AGENT) < 32u) { __builtin_amdgcn_s_sleep(2); if (++sp > (1u << 22)) break; }
        __builtin_amdgcn_fence(__ATOMIC_ACQUIRE, "agent"); asm volatile("s_waitcnt vmcnt(0)" ::: "memory"); }
    __syncthreads();
}

#ifndef DUP_NSA
#define DUP_NSA 1
#endif
#ifndef DUP_MLA
#define DUP_MLA 1
#endif
#ifndef DUP_ML
#define DUP_ML 1
#endif
#ifdef NO_MLA
#define MLA_CALL(...) do {} while (0)
#else
#define MLA_CALL(...) do { for (int rp = 0; rp < DUP_MLA; ++rp) { if (rp) __syncthreads(); mla_unit(__VA_ARGS__); } } while (0)
#endif
__device__ __forceinline__ void phase_mix(int l, InPtr in, unsigned char* ws, LAS unsigned char* lds, unsigned* qhead, int g_wv) {
    LAS int* slot = (LAS int*)(lds + LDS_MISC + 64);
    bool first = true; const int nb_ = (int)gridDim.x, b0_ = (int)blockIdx.x;
    for (;;) {
        __syncthreads();
        if (TIDX == 0) *slot = first ? b0_ : nb_ + (int)__hip_atomic_fetch_add(qhead, 1u, __ATOMIC_RELAXED, __HIP_MEMORY_SCOPE_AGENT);
        first = false;
        __syncthreads();
        int u = *slot;
        if (u >= 32 + 512 + 384 + 128) break;
        if (u < 32) { ml_scan_unit(u, l, ws, g_wv); continue; } u -= 32;
        int kind = 2, p0 = 0, bh = 0;
        if (u < 384) { kind = 0; p0 = 31 - (u >> 4); bh = u & 15; }
        else if ((u -= 384) < 384) { kind = 1; p0 = 7 - u / 48; bh = u % 48; }
        else if ((u -= 384) < 128) { kind = 0; p0 = 7 - (u >> 4); bh = u & 15; }
        else u -= 128;
#ifndef NO_NSA
        if (kind == 0) { for (int rp = 0; rp < DUP_NSA; ++rp) { if (rp) __syncthreads(); nsa_unit(bh >> 1, bh & 1, p0, l, in, ws, lds, g_wv); } continue; }
#endif
        if (kind == 1) { MLA_CALL(bh / 6, bh % 6, p0, l, ws, lds, g_wv); continue; }
        if (kind != 2) continue;
#ifndef NO_MLOUT
        ml_scan_wait(l, ws, g_wv);
        for (int rp = 0; rp < DUP_ML; ++rp) { int tid_ = TIDX; asm volatile("" : "+v"(tid_)); const int w = tid_ >> 6; ml_out_wave(u * 8 + w, l, in, ws, lds + w * 16384, lds + 131072 + w * 256, tid_ & 63); }
#endif
    }
}
__device__ __forceinline__ void phase_ynorm(int l, unsigned char* ws, int bid, int nb, int g_wv) {
    int tid_ = TIDX; asm volatile("" : "+v"(tid_)); const int w = tid_ >> 6, lane = tid_ & 63;
    bf16_t* Y = (bf16_t*)(ws + WS_Y); const float* sa = (const float*)(ws + WS_SSQ + PT_A) + (size_t)l * 16384 * 8; const float* sc = (const float*)(ws + WS_SSQ + PT_C) + (size_t)l * 16384 * 8;
    for (int r0 = (bid * 8 + w) * 8; r0 < NTOK; r0 += nb * 64) {
        if (lane < 48) {
            u32x4 x[8], y[8]; float ra[8], rc[8];
#pragma unroll
            for (int k = 0; k < 8; ++k) { const int row = r0 + k;
                const f32x4 a0 = *(const f32x4*)(sa + (size_t)row * 8), a1 = *(const f32x4*)(sa + (size_t)row * 8 + 4), c0 = *(const f32x4*)(sc + (size_t)row * 8), c1 = *(const f32x4*)(sc + (size_t)row * 8 + 4);
                ra[k] = rsqrtf((((a0.x + a0.y) + (a0.z + a0.w)) + (a1.x + a1.y)) * (1.f / 384.f) + 1e-6f); rc[k] = rsqrtf((((c0.x + c0.y) + (c0.z + c0.w)) + (c1.x + c1.y)) * (1.f / 384.f) + 1e-6f);
                x[k] = *((const u32x4*)(Y + (size_t)row * 1024) + lane); y[k] = *((const u32x4*)(Y + (size_t)row * 1024 + 384) + lane); }
#pragma unroll
            for (int k = 0; k < 8; ++k) { const int row = r0 + k; u32x4 a = x[k], c = y[k]; const float fa = ra[k], fc = rc[k];
                a.x = pk_bf16(bf_lo(a.x) * fa, bf_hi(a.x) * fa); a.y = pk_bf16(bf_lo(a.y) * fa, bf_hi(a.y) * fa); a.z = pk_bf16(bf_lo(a.z) * fa, bf_hi(a.z) * fa); a.w = pk_bf16(bf_lo(a.w) * fa, bf_hi(a.w) * fa);
                c.x = pk_bf16(bf_lo(c.x) * fc, bf_hi(c.x) * fc); c.y = pk_bf16(bf_lo(c.y) * fc, bf_hi(c.y) * fc); c.z = pk_bf16(bf_lo(c.z) * fc, bf_hi(c.z) * fc); c.w = pk_bf16(bf_lo(c.w) * fc, bf_hi(c.w) * fc);
                *((u32x4*)(Y + (size_t)row * 1024) + lane) = a; *((u32x4*)(Y + (size_t)row * 1024 + 384) + lane) = c; }
        }
    }
}
constexpr int LDS_FAC = 131072 + 2048;
__device__ __forceinline__ void outproj_factors(int l, unsigned char* ws, LAS unsigned char* lds, int pm, int tid) {
    asm volatile("" : "+v"(tid));
    if (tid < 256) { const int row = pm * 256 + tid; const float* sa = (const float*)(ws + WS_SSQ + PT_A) + ((size_t)l * 16384 + row) * 8; const float* sc = (const float*)(ws + WS_SSQ + PT_C) + ((size_t)l * 16384 + row) * 8;
        const f32x4 a0 = *(const f32x4*)sa, a1 = *(const f32x4*)(sa + 4), c0 = *(const f32x4*)sc, c1 = *(const f32x4*)(sc + 4);
        const float ra = rsqrtf((((a0.x + a0.y) + (a0.z + a0.w)) + (a1.x + a1.y)) * (1.f / 384.f) + 1e-6f), rc = rsqrtf((((c0.x + c0.y) + (c0.z + c0.w)) + (c1.x + c1.y)) * (1.f / 384.f) + 1e-6f);
        LAS float* F = (LAS float*)(lds + LDS_FAC); F[2 * tid] = ra / rc; F[2 * tid + 1] = rc; }
    __syncthreads();
}
struct EpiOut {
    static constexpr bool KHOOK = true;
    bf16_t* XB; float* ssq; const LAS float* F; bool fold;
    __device__ __forceinline__ void kscale(f32x4 (&acc)[2][2][4][2], int which, int wr, int fr) const {
        if (!fold) return;
#pragma unroll
        for (int ai = 0; ai < 2; ++ai)
#pragma unroll
            for (int m = 0; m < 4; ++m) { const float f = F[2 * (ai * 128 + wr * 64 + m * 16 + fr) + which];
#pragma unroll
                for (int bj = 0; bj < 2; ++bj)
#pragma unroll
                    for (int n = 0; n < 2; ++n) acc[ai][bj][m][n] = acc[ai][bj][m][n] * f; }
    }
    __device__ __forceinline__ void operator()(const f32x4 (&acc)[2][2][4][2], const GUnit& u, int wr, int wc, int fr, int fq) const {
        u32x4 xr[4][2][2];
#define EPO_LOAD(b_) do { _Pragma("unroll") for (int m2 = 0; m2 < 2; ++m2) _Pragma("unroll") for (int bj = 0; bj < 2; ++bj) \
            xr[b_][m2][bj] = *(const u32x4*)(XB + (size_t)(u.pm * 256 + ((b_) >> 1) * 128 + wr * 64 + (2 * ((b_) & 1) + m2) * 16 + fr) * 1024 + u.pn * 256 + bj * 128 + wc * 32 + 8 * fq); } while (0)
        EPO_LOAD(0);
#pragma unroll
        for (int ai = 0; ai < 2; ++ai)
#pragma unroll
          for (int mh = 0; mh < 2; ++mh) {
            __builtin_amdgcn_sched_barrier(0);
            if (2 * ai + mh < 3) EPO_LOAD(2 * ai + mh + 1);
            __builtin_amdgcn_sched_barrier(0);
#pragma unroll
            for (int m2 = 0; m2 < 2; ++m2) {
                const int m = 2 * mh + m2; const int row = u.pm * 256 + ai * 128 + wr * 64 + m * 16 + fr; float ss = 0.f;
#pragma unroll
                for (int bj = 0; bj < 2; ++bj) {
                    const u32x4 x = xr[2 * ai + mh][m2][bj]; u32x4 o;
                    o.x = pk_bf16(bf_lo(x.x) + acc[ai][bj][m][0][0], bf_hi(x.x) + acc[ai][bj][m][0][1]); o.y = pk_bf16(bf_lo(x.y) + acc[ai][bj][m][0][2], bf_hi(x.y) + acc[ai][bj][m][0][3]);
                    o.z = pk_bf16(bf_lo(x.z) + acc[ai][bj][m][1][0], bf_hi(x.z) + acc[ai][bj][m][1][1]); o.w = pk_bf16(bf_lo(x.w) + acc[ai][bj][m][1][2], bf_hi(x.w) + acc[ai][bj][m][1][3]);
                    *(u32x4*)(XB + (size_t)row * 1024 + u.pn * 256 + bj * 128 + wc * 32 + 8 * fq) = o;
                    ss += (bf_lo(o.x) * bf_lo(o.x) + bf_hi(o.x) * bf_hi(o.x)) + (bf_lo(o.y) * bf_lo(o.y) + bf_hi(o.y) * bf_hi(o.y)) + (bf_lo(o.z) * bf_lo(o.z) + bf_hi(o.z) * bf_hi(o.z)) + (bf_lo(o.w) * bf_lo(o.w) + bf_hi(o.w) * bf_hi(o.w));
                }
                ss = quad_sum(ss); if (fq == 0) ssq[(size_t)row * 16 + u.pn * 4 + wc] = ss;
            }
          }
    }
};
#undef EPO_LOAD

__device__ __forceinline__ float sum16(const float* p) { const f32x4 a = *(const f32x4*)p, b = *(const f32x4*)(p + 4), c = *(const f32x4*)(p + 8), d = *(const f32x4*)(p + 12);
    return (((a.x + a.y) + (a.z + a.w)) + ((b.x + b.y) + (b.z + b.w))) + (((c.x + c.y) + (c.z + c.w)) + ((d.x + d.y) + (d.z + d.w))); }
__device__ __forceinline__ void phase_route(int l, InPtr in, unsigned char* ws, LAS unsigned char* lds, int bid, int nb, int g_wv) {
    int tid_ = TIDX; asm volatile("" : "+v"(tid_)); const int w = tid_ >> 6, lane = tid_ & 63, r = lane & 15, q = lane >> 4;
    const bf16_t* XB = (const bf16_t*)(ws + WS_XB); const bf16_t* WR = (const bf16_t*)(ws + WS_WR) + (size_t)l * 64 * 1024;
    const float* ssq = (const float*)(ws + WS_SSQ + PT_X1) + (size_t)l * 16384 * 16; const float* bg = in->p[24] + l * 4; const float* be = in->p[26] + l * 32;
    unsigned* cnt = (unsigned*)(ws + WS_CTL) + CW_CNT + 2048 * l; unsigned* mtok = (unsigned*)(ws + WS_META); float* mw = (float*)(ws + WS_META + META_W);
    LAS float* lg = (LAS float*)(lds + w * 4096);
    LAS unsigned* lcnt = (LAS unsigned*)(lds + 32768); LAS unsigned* lbase = lcnt + 32;
    constexpr int WRP = 2064; LAS unsigned char* wrl = lds + 40960;
    { u32x4 st[12];
#pragma unroll
      for (int i = 0; i < 12; ++i) { const int c = tid_ + 512 * i; st[i] = *(const u32x4*)(WR + (size_t)(c >> 7) * 1024 + (c & 127) * 8); }
#pragma unroll
      for (int i = 0; i < 12; ++i) { const int c = tid_ + 512 * i; *(LAS u32x4*)(wrl + (c >> 7) * WRP + (c & 127) * 16) = st[i]; } }
    for (int g0 = bid * 8; g0 < NTOK / 16; g0 += nb * 8) {
        if (tid_ < 32) lcnt[tid_] = 0u;
        __syncthreads();
        const int tok0 = (g0 + w) * 16; f32x4 acc[3];
#pragma unroll
        for (int n = 0; n < 3; ++n) acc[n] = (f32x4){0.f, 0.f, 0.f, 0.f};
        const bf16_t* ap = XB + (size_t)(tok0 + r) * 1024 + 8 * q; const LAS unsigned char* bl_ = wrl + r * WRP + 16 * q;
#pragma unroll 1
        for (int kc = 0; kc < 2; ++kc) {
            bf16x8 a[16];
#pragma unroll
            for (int s = 0; s < 16; ++s) a[s] = *(const bf16x8*)(ap + 32 * (kc * 16 + s));
            __builtin_amdgcn_sched_barrier(0);
#pragma unroll
            for (int s = 0; s < 16; ++s)
#pragma unroll
                for (int n = 0; n < 3; ++n) { const bf16x8 bb = *(const LAS bf16x8*)(bl_ + n * 16 * WRP + 64 * (kc * 16 + s)); acc[n] = MFMA16(a[s], bb, acc[n]); }
            __builtin_amdgcn_sched_barrier(0);
        }
#pragma unroll
        for (int n = 0; n < 3; ++n)
#pragma unroll
            for (int j = 0; j < 4; ++j) lg[(4 * q + j) * 48 + 16 * n + r] = acc[n][j];
        LDS_FENCE();
        int E0 = 0, E1 = 0; unsigned r0 = 0, r1 = 0; float wt0 = 0.f, wt1 = 0.f; const int tok = tok0 + (lane & 15);
        if (lane < 16) {
            const float rs = rsqrtf(sum16(ssq + (size_t)tok * 16) * (1.f / 1024.f) + 1e-6f); ((float*)(ws + WS_RS2))[tok] = rs; const LAS float* L = lg + lane * 48;
            float gl[4]; int gi = 0;
#pragma unroll
            for (int j = 0; j < 4; ++j) gl[j] = L[j] * rs + bg[j];
            float gm = gl[0];
#pragma unroll
            for (int j = 1; j < 4; ++j) if (gl[j] > gm) { gm = gl[j]; gi = j; }
            float gsum = 0.f;
#pragma unroll
            for (int j = 0; j < 4; ++j) gsum += __expf(gl[j] - gm);
            const float gtop = 1.f / gsum;
            float el[8];
#pragma unroll
            for (int j = 0; j < 8; ++j) el[j] = L[4 + gi * 8 + j] * rs + be[gi * 8 + j];
            int e0 = 0; float v0 = el[0];
#pragma unroll
            for (int j = 1; j < 8; ++j) if (el[j] > v0) { v0 = el[j]; e0 = j; }
            int e1 = -1; float v1 = -3.0e38f;
#pragma unroll
            for (int j = 0; j < 8; ++j) if (j != e0 && el[j] > v1) { v1 = el[j]; e1 = j; }
            const float w0 = 1.f / (1.f + __expf(v1 - v0)); E0 = gi * 8 + e0; E1 = gi * 8 + e1; wt0 = w0 * gtop; wt1 = (1.f - w0) * gtop;
            r0 = __hip_atomic_fetch_add(lcnt + E0, 1u, __ATOMIC_RELAXED, __HIP_MEMORY_SCOPE_WORKGROUP); r1 = __hip_atomic_fetch_add(lcnt + E1, 1u, __ATOMIC_RELAXED, __HIP_MEMORY_SCOPE_WORKGROUP);
        }
        __syncthreads();
        if (tid_ < 32) { const unsigned c = lcnt[tid_]; lbase[tid_] = c ? atomicAdd(cnt + tid_ * 64, c) : 0u; }
        __syncthreads();
        if (lane < 16) {
            const unsigned p0 = lbase[E0] + r0, p1 = lbase[E1] + r1;
            mtok[(size_t)E0 * 16384 + p0] = (unsigned)tok; mw[(size_t)E0 * 16384 + p0] = wt0;
            mtok[(size_t)E1 * 16384 + p1] = (unsigned)tok | 0x80000000u; mw[(size_t)E1 * 16384 + p1] = wt1;
        }
        __syncthreads();
    }
}

constexpr int LDS_TB = 131072 + 2048;
__device__ __forceinline__ void moe_tables(int l, unsigned char* ws, LAS unsigned char* lds, int g_wv) {
    int tix = TIDX; asm volatile("" : "+v"(tix));
    LAS int* tb = (LAS int*)(lds + LDS_TB);
    if (tix < 32) { const unsigned* cnt = (const unsigned*)(ws + WS_CTL) + CW_CNT + 2048 * l; tb[160 + tix] = (int)__hip_atomic_load(cnt + tix * 64, __ATOMIC_RELAXED, __HIP_MEMORY_SCOPE_AGENT); }
    __syncthreads();
    if (tix == 0) { int a = 0, f = 0, p = 0; for (int e = 0; e < 32; ++e) { const int c = tb[160 + e]; tb[e] = a; tb[48 + e] = f; tb[96 + e] = p; a += (c + 255) >> 8; f += c >> 8; p += (c & 255) ? 1 : 0; } tb[32] = a; tb[80] = f; tb[128] = p; }
    __syncthreads();
}
template <int NPN, bool GATHER_>
struct MoeSched {
    static constexpr bool GATHER = GATHER_, PARTIAL = false;
    const char* A; const char* Bt; const unsigned* cnt; const unsigned* mtok; const LAS int* tb; int G, c; size_t bstride_e  , bstride_pn; int lo, hi;
    __device__ __forceinline__ bool next(int i, GUnit& u) const {
        const int L = lo + i * G + c; if (L >= hi) return false;
        const int tile = L / NPN, pn = L % NPN;
        int e = 0;
        for (int k = 1; k < 32; ++k) e = (tb[k] <= tile) ? k : e;
        e = __builtin_amdgcn_readfirstlane(e);
        u.e = e; u.pm = tile; u.pn = pn; u.rows = tb[160 + e] - 256 * (tile - tb[e]);
        u.a = GATHER ? A : A + (size_t)tile * 256 * 256 * 2;
        u.b = Bt + (size_t)e * bstride_e + (size_t)pn * bstride_pn; return true;
    }
    __device__ __forceinline__ void aoff(const GUnit& u, unsigned (&v)[2][2], const int (&R)[2], const int (&C)[2]) const {
#pragma unroll
        for (int h = 0; h < 2; ++h)
#pragma unroll
            for (int i = 0; i < 2; ++i) {
                if (GATHER) { const int lr = h * 128 + R[i]; const int rr = 256 * (u.pm - tb[u.e]) + (lr < u.rows ? lr : 0); const unsigned tok = mtok[(size_t)u.e * 16384 + rr] & 0x7fffffffu; v[h][i] = (tok * 1024u + (unsigned)C[i]) * 2u; }
                else v[h][i] = (unsigned)((h * 128 + R[i]) * 256 + C[i]) * 2u;
            }
    }
};
struct EpiMoeUp {
    static constexpr bool KHOOK = false;
    const unsigned* mtok; const float* ssq; const LAS int* tb; bf16_t* HB;
    __device__ __forceinline__ void operator()(const f32x4 (&acc)[2][2][4][2], const GUnit& u, int wr, int wc, int fr, int fq) const {
        const int r0 = 256 * (u.pm - tb[u.e]);
        float rs8[8];
        { unsigned tk[8];
#pragma unroll
          for (int k = 0; k < 8; ++k) { const int lr = (k >> 2) * 128 + wr * 64 + (k & 3) * 16 + fr; tk[k] = mtok[(size_t)u.e * 16384 + r0 + (lr < u.rows ? lr : 0)] & 0x7fffffffu; }
#pragma unroll
          for (int k = 0; k < 8; ++k) rs8[k] = ssq[tk[k]]; }
#pragma unroll
        for (int ai = 0; ai < 2; ++ai)
#pragma unroll
            for (int m = 0; m < 4; ++m) {
                __builtin_amdgcn_sched_barrier(0);
                const int lr = ai * 128 + wr * 64 + m * 16 + fr;
                if (lr < u.rows) {
                    const float rs = rs8[ai * 4 + m];
                    float hv[8];
#pragma unroll
                    for (int n = 0; n < 2; ++n)
#pragma unroll
                        for (int j = 0; j < 4; ++j) { const float gv = acc[ai][0][m][n][j] * rs, uv = acc[ai][1][m][n][j] * rs; hv[4 * n + j] = siluf(gv) * uv; }
                    st_bf16x8(HB + ((size_t)u.pm * 256 + lr) * 256 + u.pn * 128 + wc * 32 + 8 * fq, hv);
                }
            }
    }
};
struct EpiMoeDown {
    static constexpr bool KHOOK = false;
    const unsigned* mtok; const float* mw; const LAS int* tb; bf16_t* YB;
    __device__ __forceinline__ void operator()(const f32x4 (&acc)[2][2][4][2], const GUnit& u, int wr, int wc, int fr, int fq) const {
        const int r0 = 256 * (u.pm - tb[u.e]);
        unsigned mt8[8]; float wt8[8];
#pragma unroll
        for (int k = 0; k < 8; ++k) { const int lr = (k >> 2) * 128 + wr * 64 + (k & 3) * 16 + fr; const size_t ix = (size_t)u.e * 16384 + r0 + (lr < u.rows ? lr : 0); mt8[k] = mtok[ix]; wt8[k] = mw[ix]; }
#pragma unroll
        for (int ai = 0; ai < 2; ++ai)
#pragma unroll
            for (int m = 0; m < 4; ++m) {
                __builtin_amdgcn_sched_barrier(0);
                const int lr = ai * 128 + wr * 64 + m * 16 + fr;
                if (lr < u.rows) {
                    const unsigned mt = mt8[ai * 4 + m]; const float wt = wt8[ai * 4 + m];
                    bf16_t* dst = YB + ((size_t)(mt >> 31) * 16384 + (mt & 0x7fffffffu)) * 1024 + u.pn * 256 + wc * 32 + 8 * fq;
#pragma unroll
                    for (int bj = 0; bj < 2; ++bj) { float v[8];
#pragma unroll
                        for (int n = 0; n < 2; ++n)
#pragma unroll
                            for (int j = 0; j < 4; ++j) v[4 * n + j] = acc[ai][bj][m][n][j] * wt;
                        st_bf16x8(dst + bj * 128, v); }
                }
            }
    }
};
__device__ __forceinline__ void phase_combine(int l, unsigned char* ws, float* out, int bid, int nb, int g_wv) {
    int tid_ = TIDX; asm volatile("" : "+v"(tid_)); const int w = tid_ >> 6, lane = tid_ & 63;
    bf16_t* XB = (bf16_t*)(ws + WS_XB); const bf16_t* Y0 = (const bf16_t*)(ws + WS_YBUF); const bf16_t* Y1 = Y0 + (size_t)16384 * 1024; float* ssqx = (float*)(ws + WS_SSQX) + 16384;
    for (int row = bid * 8 + w; row < NTOK; row += nb * 8) {
        float ss = 0.f;
#pragma unroll
        for (int k = 0; k < 2; ++k) {
            const size_t o = (size_t)row * 1024 + (lane + 64 * k) * 8;
            const u32x4 x = *(const u32x4*)(XB + o), a = *(const u32x4*)(Y0 + o), c = *(const u32x4*)(Y1 + o);
            float v[8] = { bf_lo(x.x) + bf_lo(a.x) + bf_lo(c.x), bf_hi(x.x) + bf_hi(a.x) + bf_hi(c.x), bf_lo(x.y) + bf_lo(a.y) + bf_lo(c.y), bf_hi(x.y) + bf_hi(a.y) + bf_hi(c.y),
                           bf_lo(x.z) + bf_lo(a.z) + bf_lo(c.z), bf_hi(x.z) + bf_hi(a.z) + bf_hi(c.z), bf_lo(x.w) + bf_lo(a.w) + bf_lo(c.w), bf_hi(x.w) + bf_hi(a.w) + bf_hi(c.w) };
            if (l == L_ - 1 && out) { *(f32x4*)(out + o) = (f32x4){v[0], v[1], v[2], v[3]}; *(f32x4*)(out + o + 4) = (f32x4){v[4], v[5], v[6], v[7]}; }
            else { u32x4 p; p.x = pk_bf16(v[0], v[1]); p.y = pk_bf16(v[2], v[3]); p.z = pk_bf16(v[4], v[5]); p.w = pk_bf16(v[6], v[7]); *(u32x4*)(XB + o) = p;
#pragma unroll
                   for (int j = 0; j < 4; ++j) { const unsigned q = j == 0 ? p.x : (j == 1 ? p.y : (j == 2 ? p.z : p.w)); ss += bf_lo(q) * bf_lo(q) + bf_hi(q) * bf_hi(q); } }
        }
        if (l < L_ - 1) { ss = wave_sum(ss); if (lane == 0) ssqx[row] = ss; }
    }
}
constexpr int MOE_CVT_SPLIT = 4608;
#ifndef CVT_A
#define CVT_A 1920
#endif
#ifndef NROUTE
#define NROUTE 128
#endif
constexpr int NPH = 9;
enum { PH_INPROJ = 0, PH_PREP, PH_MIX, PH_YNORM, PH_OUTPROJ, PH_ROUTE, PH_MOEUP, PH_MOEDOWN, PH_COMBINE };
struct Args { Inputs in; float* out; unsigned char* ws; int ph_lo, ph_hi; };

__global__ void __launch_bounds__(512, 2) mk(Args args) {
    extern __shared__ __attribute__((aligned(16))) unsigned char lds_raw[];
    LAS unsigned char* lds = (LAS unsigned char*)lds_raw;
    const int g_wv = __builtin_amdgcn_readfirstlane((int)threadIdx.x >> 6);
    const int bid0 = blockIdx.x, nb = gridDim.x;
#define BID() ({ int b_ = bid0; asm volatile("" : "+s"(b_)); b_; })
    unsigned char* ws = args.ws; unsigned* ctl = (unsigned*)(ws + WS_CTL);
    const int lo = args.ph_lo, hi = args.ph_hi;
    if (TIDX < 4) ((LAS unsigned*)(lds + LDS_MISC))[TIDX] = 0u;
    __syncthreads();
    XcdBarrier bar; bar.g_wv = g_wv; bar.bar = ctl + CW_BAR; bar.x = 0; bar.st = nullptr;
    if (hi - lo > 1) bar = xcd_barrier_post(ctl + CW_BAR, (volatile LAS unsigned*)(lds + LDS_MISC), g_wv);
#define IN(k) (lo <= (k) && (k) < hi)
#ifndef REPEAT_PH
#define REPEAT_PH -1
#endif
#define NREP(k) ((REPEAT_PH == (k)) ? 2 : 1)
#ifndef NBAR
#define NBAR 1
#endif
#ifndef TIME_PH
#define TIME_PH -1
#endif
#define STAMP(i) do { if (TIME_PH != -1 && blockIdx.x == 0 && TIDX == 0) ((unsigned long long*)(ctl + CW_TS))[i] = __builtin_amdgcn_s_memrealtime(); } while (0)
#define SEAM(k) do { if (IN(k) && IN((k) + 1)) for (int nb_ = 0; nb_ < NBAR; ++nb_) xcd_barrier(bar); STAMP((k) + 1); } while (0)
    STAMP(0);
#ifndef NO_PRO
    if (IN(0)) for (int rep = 0; rep < NREP(100); ++rep) { prologue(in_tab(), launder(ws), lds, BID(), nb, g_wv); if (rep + 1 < NREP(100)) xcd_barrier(bar); }
#endif
    SEAM(0);
    for (int l = 0; l < L_; ++l) {
        const int pb = 1 + l * NPH;
        if (IN(pb + PH_INPROJ)) for (int rep = 0; rep < NREP(PH_INPROJ); ++rep) {
            if (rep) xcd_barrier(bar);
            InPtr in = in_tab(); unsigned char* ws = launder(args.ws);
            g8::DenseSched S{(const char*)(ws + WS_XB), (const char*)(ws + WS_WIN) + (size_t)l * 2560 * 1024 * 2, 1024, 1024, 64, 10, nb, BID(), 2};
            EpiInProj E{(const float*)(ws + WS_SSQX) + l * 16384, (float*)(ws + WS_SSQ + PT_DQ) + (size_t)l * 16384 * 4, (float*)(ws + WS_SSQ + PT_DKV) + (size_t)l * 16384 * 2,
                        in->p[8] + l * 64, in->p[9] + l * 64, in->p[19] + l * 192 + 96 + 64, (const float*)(ws + WS_ROPE), ws + WS_PRJ};
#ifndef NO_INPROJ
            g8::gemm_run(lds, 1024, 1024, S, E, g_wv);
#endif
        }
        SEAM(pb + PH_INPROJ);
        if (IN(pb + PH_PREP)) for (int rep = 0; rep < NREP(PH_PREP); ++rep) { if (rep) xcd_barrier(bar); phase_prep(l, in_tab(), launder(ws), lds, BID(), nb, g_wv, (unsigned*)launder(ws) + CW_Q + 64 * (4 + l + 2 * rep)); }
        SEAM(pb + PH_PREP);
        if (IN(pb + PH_MIX)) for (int rep = 0; rep < NREP(PH_MIX); ++rep) { if (rep) xcd_barrier(bar); phase_mix(l, in_tab(), launder(ws), lds, (unsigned*)launder(ws) + CW_Q + 64 * (l + 2 * rep), g_wv); }
        SEAM(pb + PH_MIX);
        const bool fold_norm = (nb == 256);
        if (IN(pb + PH_YNORM) && !fold_norm) phase_ynorm(l, launder(ws), BID(), nb, g_wv);
        if (!fold_norm) SEAM(pb + PH_YNORM);
        if (IN(pb + PH_OUTPROJ)) {
            unsigned char* ws = launder(args.ws);
            g8::DenseSched S{(const char*)(ws + WS_Y), (const char*)(ws + WS_WOUT) + (size_t)l * 1024 * 1024 * 2, 1024, 1024, 64, 4, nb, BID()};
            EpiOut E{(bf16_t*)(ws + WS_XB), (float*)(ws + WS_SSQ + PT_X1) + (size_t)l * 16384 * 16, (const LAS float*)(lds + LDS_FAC), fold_norm};
            if (fold_norm) { g8::GUnit u0; if (S.next(0, u0)) outproj_factors(l, ws, lds, u0.pm, TIDX); else __syncthreads(); }
#ifndef NO_OUTPROJ
            g8::gemm_run(lds, 1024, 1024, S, E, g_wv);
#endif
        }
        SEAM(pb + PH_OUTPROJ);
#ifndef NO_ROUTE
        if (IN(pb + PH_ROUTE)) {
            const int b_ = BID();
            if (nb >= 256 && b_ >= NROUTE) { cvt_moe_layer(in_tab(), launder(ws), l, (LAS float*)lds, b_ - NROUTE, nb - NROUTE, TIDX, 0, CVT_A);
#ifdef DUP_CVT
                __syncthreads(); cvt_moe_layer(in_tab(), launder(ws), l, (LAS float*)lds, b_ - NROUTE, nb - NROUTE, TIDX);
#endif
            }
            else { phase_route(l, in_tab(), launder(ws), lds, b_, nb >= 256 ? NROUTE : nb, g_wv);
                   if (nb < 256) cvt_moe_layer(in_tab(), launder(ws), l, (LAS float*)lds, b_, nb, TIDX); else cvt_moe_layer(in_tab(), launder(ws), l, (LAS float*)lds, b_, NROUTE, TIDX, CVT_A, 3072); }
            if (l + 1 < L_) { __syncthreads(); cvt_small_weights(in_tab(), launder(ws), l + 1, (LAS float*)lds, b_, nb, TIDX); }
        }
#endif
        SEAM(pb + PH_ROUTE);
        {
            const bool do_up = IN(pb + PH_MOEUP), do_dn = IN(pb + PH_MOEDOWN), fuse = do_up && do_dn;
            for (int part = 0; part < (fuse ? 3 : 1); ++part) {
                if (part) xcd_barrier(bar);
                unsigned char* ws = launder(args.ws);
                if ((do_up || do_dn) && part == 0) moe_tables(l, ws, lds, g_wv);
                const unsigned* cnt = (const unsigned*)(ws + WS_CTL) + CW_CNT + 2048 * l; const unsigned* mtok = (const unsigned*)(ws + WS_META); const LAS int* tb = (const LAS int*)(lds + LDS_TB);
                const int b_ = BID(), ntile = tb[32], UPU = 2 * ntile, DNU = 4 * ntile;
                const int hi0 = UPU < nb ? UPU : nb, nu_ = UPU - hi0, nu = nu_ < (nb >> 1) ? nu_ : (nb >> 1), nd = nb - nu;
                const int d1a = 4 * (hi0 >> 1), d1b = 2 * nd, D1 = nu == 0 ? DNU : (d1a < d1b ? d1a : d1b);
                int ulo = 0, uhi = UPU, uG = nb, uc = b_, dlo = 0, dhi = DNU, dG = nb, dc = b_;
                if (fuse) {
                    if (part == 0) { uhi = hi0; dhi = 0; }
                    else if (part == 1) { ulo = hi0; uG = nu; if (b_ >= nu) uhi = ulo; dhi = D1; dG = nd; dc = b_ - nu; if (b_ < nu) dhi = 0; }
                    else { uhi = 0; dlo = D1; }
                }
                if (do_up && uhi > ulo) {
                    MoeSched<2, true> S{(const char*)(ws + WS_XB), (const char*)(ws + WS_WMOE), cnt, mtok, tb, uG, uc, (size_t)512 * 1024 * 2, (size_t)256 * 1024 * 2, ulo, uhi};
                    EpiMoeUp E{mtok, (const float*)(ws + WS_RS2), tb, (bf16_t*)(ws + WS_HBUF)};
#ifndef NO_MOEUP
                    g8::gemm_run(lds, 1024, 1024, S, E, g_wv);
#endif
                }
                if (do_dn && dhi > dlo) {
                    MoeSched<4, false> S{(const char*)(ws + WS_HBUF), (const char*)(ws + WS_WMOE + WMOE_WD), cnt, mtok, tb, dG, dc, (size_t)1024 * 256 * 2, (size_t)256 * 256 * 2, dlo, dhi};
                    EpiMoeDown E{mtok, (const float*)(ws + WS_META + META_W), tb, (bf16_t*)(ws + WS_YBUF)};
#ifndef NO_MOEDOWN
                    g8::gemm_run(lds, 256, 256, S, E, g_wv);
#endif
                }
            }
        }
        SEAM(pb + PH_MOEDOWN);
#ifndef NO_COMBINE
        if (IN(pb + PH_COMBINE)) { unsigned char* ws = launder(args.ws); phase_combine(l, ws, args.out, BID(), nb, g_wv); }
#endif
        SEAM(pb + PH_COMBINE);
    }
#undef IN
#undef SEAM
}
#if CHECK
struct NvScratch { float *proj, *h1, *qk, *hraw, *kn, *kcmp, *vcmp, *dqn, *q, *dkvn, *kv, *krope, *y, *x1, *xl; int* rt_e; float* rt_w; };
constexpr int CB = 5;
enum { NS_INPROJ = 0, NS_NSAPREP, NS_MLAPREP, NS_NSA, NS_ML, NS_MLA, NS_OUT, NS_ROUTE, NS_MOE };
static void naive_step(void* const* d_in, int l, int step, const float* xin, float* xout, const NvScratch& S, hipStream_t st) {
    const int b = CB;
    const float* rel_bias = (const float*)d_in[2];
    const float* norm1_g = (const float*)d_in[3] + (long)l * 1024;
    const float* w_in = (const float*)d_in[4] + (long)l * 1024 * DIN;
    const float* cmp_pe = (const float*)d_in[5] + (long)l * 2 * 32 * 64;
    const float* cmp_w1 = (const float*)d_in[6] + (long)l * 2 * 32 * 64 * 64;
    const float* cmp_w2 = (const float*)d_in[7] + (long)l * 2 * 64 * 64;
    const float* q_norm = (const float*)d_in[8] + l * 64;
    const float* k_norm = (const float*)d_in[9] + l * 64;
    const float* nsa_on = (const float*)d_in[10] + l * 384;
    const float* conv = (const float*)d_in[11] + l * 4 * 512;
    const float* ibias = (const float*)d_in[12] + l * 4;
    const float* fbias = (const float*)d_in[13] + l * 4;
    const float* ml_on = (const float*)d_in[14] + l * 256;
    const float* qan = (const float*)d_in[15] + l * 192;
    const float* w_uq = (const float*)d_in[16] + (long)l * 192 * 576;
    const float* kvan = (const float*)d_in[17] + l * 128;
    const float* w_ukv = (const float*)d_in[18] + (long)l * 128 * 768;
    const float* qkn = (const float*)d_in[19] + l * 192;
    const float* mla_on = (const float*)d_in[20] + l * 384;
    const float* w_out = (const float*)d_in[21] + (long)l * 1024 * 1024;
    const float* norm2_g = (const float*)d_in[22] + l * 1024;
    const float* wgrp = (const float*)d_in[23] + (long)l * 1024 * 4;
    const float* bgrp = (const float*)d_in[24] + l * 4;
    const float* wexp = (const float*)d_in[25] + (long)l * 1024 * 32;
    const float* bexp = (const float*)d_in[26] + l * 32;
    const float* Wg = (const float*)d_in[27] + (long)l * 32 * 1024 * 256;
    const float* Wu = (const float*)d_in[28] + (long)l * 32 * 1024 * 256;
    const float* Wd = (const float*)d_in[29] + (long)l * 32 * 256 * 1024;
    const int* pos = (const int*)d_in[1] + b * 2048;
    switch (step) {
    case NS_INPROJ:
        nv_rmsnorm<<<dim3(2048, 1), 64, 0, st>>>(xin, 1024, 0, S.h1, 1024, 0, norm1_g, 0, 1024);
        nv_gemm<<<dim3((DIN + 63) / 64, 2048 / 64), 256, 0, st>>>(S.h1, 1024, w_in, DIN, S.proj, DIN, nullptr, 0, 2048, DIN, 1024);
        break;
    case NS_NSAPREP:
        nv_nsa_cmp<<<dim3(127, 2, 2), 64, 0, st>>>(S.proj, cmp_pe, cmp_w1, cmp_w2, k_norm, S.kcmp, S.vcmp);
        nv_nsa_knorm<<<dim3(2048, 4), 64, 0, st>>>(S.proj, k_norm, S.kn);
        break;
    case NS_MLAPREP:
        nv_rmsnorm<<<dim3(2048, 1), 64, 0, st>>>(S.proj + O_CDQ, DIN, 0, S.dqn, 192, 0, qan, 0, 192);
        nv_gemm<<<dim3(576 / 64, 2048 / 64), 256, 0, st>>>(S.dqn, 192, w_uq, 576, S.q, 576, nullptr, 0, 2048, 576, 192);
        nv_rmsnorm<<<dim3(2048, 1), 64, 0, st>>>(S.proj + O_CDKV, DIN, 0, S.dkvn, 128, 0, kvan, 0, 128);
        nv_gemm<<<dim3(768 / 64, 2048 / 64), 256, 0, st>>>(S.dkvn, 128, w_ukv, 768, S.kv, 768, nullptr, 0, 2048, 768, 128);
        nv_mla_prep<<<dim3(2048, 7), 64, 0, st>>>(S.q, S.kv, S.proj, S.krope, qkn, pos);
        break;
    case NS_NSA:
        nv_nsa_attn<<<dim3(2048, 2), 192, 0, st>>>(S.proj, S.kn, S.kcmp, S.vcmp, rel_bias, q_norm, S.y);
        break;
    case NS_ML:
        nv_ml_conv<<<2048, 512, 0, st>>>(S.proj, conv, S.qk);
        nv_ml_rec<<<4, 256, 0, st>>>(S.proj, S.qk, ibias, fbias, S.hraw);
        nv_ml_fin<<<dim3(2048, 4), 64, 0, st>>>(S.proj, S.hraw, ml_on, S.y);
        break;
    case NS_MLA:
        nv_mla_attn<<<dim3(2048, 6), 64, 0, st>>>(S.q, S.kv, S.krope, S.y);
        break;
    case NS_OUT:
        nv_rmsnorm<<<dim3(2048, 1), 64, 0, st>>>(S.y, 1024, 0, S.y, 1024, 0, nsa_on, 0, 384);
        nv_rmsnorm<<<dim3(2048, 1), 64, 0, st>>>(S.y + 640, 1024, 0, S.y + 640, 1024, 0, mla_on, 0, 384);
        nv_gemm<<<dim3(1024 / 64, 2048 / 64), 256, 0, st>>>(S.y, 1024, w_out, 1024, S.x1, 1024, xin, 1024, 2048, 1024, 1024);
        break;
    case NS_ROUTE:
        nv_moe_route<<<2048, 64, 0, st>>>(S.x1, norm2_g, wgrp, bgrp, wexp, bexp, S.h1, S.rt_e, S.rt_w);
        break;
    case NS_MOE:
        nv_moe_exp<<<2048, 256, 0, st>>>(S.x1, S.h1, S.rt_e, S.rt_w, Wg, Wu, Wd, xout);
        break;
    }
}

__device__ __forceinline__ void chk_commit(float d2, float r2, float* acc) { d2 = wave_sum(d2); r2 = wave_sum(r2); if ((threadIdx.x & 63) == 0) { atomicAdd(acc, d2); atomicAdd(acc + 1, r2); } }
__device__ __forceinline__ void chk_add(float f, float r, float& d2, float& r2) { const float d = f - r; d2 += (d == d) ? d * d : 1e30f; r2 += r * r; }

__global__ void __launch_bounds__(64) chk_proj(const float* nproj, const unsigned char* prj, const float* ssq_dq, const float* ssq_dkv, const float* qg, const float* kg, const float* krg, const int* pos, float* acc) {
    const int t = blockIdx.x, e = threadIdx.x; const size_t row = (size_t)CB * 2048 + t; float d2 = 0.f, r2 = 0.f;
    for (int G = 0; G < 40; ++G) {
        const int c = inproj_refcol(G, e); float r = c < 0 ? 0.f : nproj[(size_t)t * DIN + c]; float f = 0.f;
        const float rr = (G == 37 && e >= 32) ? 0.f : r; const float ss = wave_sum(rr * rr);
        if (G < 6) { r = r * rsqrtf(ss / 64.f + 1e-6f) * qg[e] * 0.18033688f; f = bf2f(((const bf16_t*)(prj + PRJ_QN))[((size_t)(CB * 6 + G) * 2048 + t) * 64 + e]); }
        else if (G < 18) { const int a = G - 6, br = a >> 2, s = (a >> 1) & 1, hk = a & 1;
            if (br > 0 && s == 0) r = r * rsqrtf(ss / 64.f + 1e-6f) * kg[e];
            const size_t base = br == 0 ? (s ? PRJ_C0V : PRJ_C0K) : (br == 1 ? (s ? PRJ_VN1 : PRJ_KN1) : (s ? PRJ_VN2 : PRJ_KN2));
            f = bf2f(((const bf16_t*)(prj + base))[((size_t)(CB * 2 + hk) * 2048 + t) * 64 + e]); }
        else if (G < 26) f = bf2f(((const bf16_t*)(prj + PRJ_RAWQK))[row * 512 + (G - 18) * 64 + e]);
        else if (G < 30) f = bf2f(((const bf16_t*)(prj + PRJ_VML))[((size_t)(CB * 4 + (G - 26)) * 2048 + t) * 64 + e]);
        else if (G < 34) f = bf2f(((const bf16_t*)(prj + PRJ_OG))[row * 256 + (G - 30) * 64 + e]);
        else if (G < 37) f = bf2f(((const bf16_t*)(prj + PRJ_DQKV))[row * 384 + (G - 34) * 64 + e]);
        else if (G == 37) {
            const float val = e < 32 ? rr * rsqrtf(ss / 32.f + 1e-6f) * krg[e & 31] : 0.f; const float oth = __shfl_xor(val, 16);
            if (e < 32) { const int i = e & 15; const double ang = (double)pos[row] * pow(10000.0, -(double)i / 16.0); const float cs = (float)cos(ang), sn = (float)sin(ang);
                r = e < 16 ? val * cs - oth * sn : val * cs + oth * sn; f = bf2f(((const bf16_t*)(prj + PRJ_KR))[row * 32 + e]); }
            else if (e < 58) f = ((const float*)(prj + PRJ_GATES))[row * 32 + (e - 32)];
            else { f = 0.f; r = 0.f; }
        }
        else f = bf2f(((const bf16_t*)(prj + PRJ_DQKV))[row * 384 + 256 + (G - 38) * 64 + e]);
        chk_add(f, r, d2, r2);
    }
    float d2s = 0.f, r2s = 0.f;
    { float s1 = 0.f, s2 = 0.f; for (int c = e; c < 192; c += 64) { float v = nproj[(size_t)t * DIN + O_CDQ + c]; s1 += v * v; } for (int c = e; c < 128; c += 64) { float v = nproj[(size_t)t * DIN + O_CDKV + c]; s2 += v * v; }
      s1 = wave_sum(s1); s2 = wave_sum(s2); if (e == 0) { chk_add((ssq_dq[row * 4] + ssq_dq[row * 4 + 1]) + ssq_dq[row * 4 + 2], s1, d2s, r2s); chk_add(ssq_dkv[row * 2] + ssq_dkv[row * 2 + 1], s2, d2s, r2s); } }
    chk_commit(d2, r2, acc); chk_commit(d2s, r2s, acc + 2);
}

__global__ void __launch_bounds__(64) chk_prep(const float* nq, const float* nkv, const float* nkr, const float* nkc, const float* nvc, const unsigned char* ws, float* acc) {
    const int t = blockIdx.x, e = threadIdx.x; float d2 = 0.f, r2 = 0.f, d2c = 0.f, r2c = 0.f; const float scale = 0.14724444f;
    const bf16_t* QM = (const bf16_t*)(ws + WS_MLA); const bf16_t* KM = (const bf16_t*)(ws + WS_MLA + MLA_KM); const bf16_t* VM = (const bf16_t*)(ws + WS_MLA + MLA_VM);
    for (int h = 0; h < 6; ++h) {
        const size_t rq = ((size_t)(CB * 6 + h) * 2048 + t);
        chk_add(bf2f(QM[rq * 96 + e]), nq[(size_t)t * 576 + h * 96 + e] * scale, d2, r2);
        chk_add(bf2f(KM[rq * 96 + e]), nkv[(size_t)t * 768 + h * 128 + e], d2, r2);
        chk_add(bf2f(VM[rq * 64 + e]), nkv[(size_t)t * 768 + h * 128 + 64 + e], d2, r2);
        if (e < 32) { chk_add(bf2f(QM[rq * 96 + 64 + e]), nq[(size_t)t * 576 + h * 96 + 64 + e] * scale, d2, r2); chk_add(bf2f(KM[rq * 96 + 64 + e]), nkr[(size_t)t * 32 + e], d2, r2); }
    }
    if (t < 128) for (int hk = 0; hk < 2; ++hk) {
        const bf16_t* KC = (const bf16_t*)(ws + WS_CMP); const bf16_t* VC = (const bf16_t*)(ws + WS_CMP + CMP_V); const size_t rf = ((size_t)(CB * 2 + hk) * 128 + t) * 64 + e;
        chk_add(bf2f(KC[rf]), t < 127 ? nkc[(size_t)(hk * 127 + t) * 64 + e] : 0.f, d2c, r2c); chk_add(bf2f(VC[rf]), t < 127 ? nvc[(size_t)(hk * 127 + t) * 64 + e] : 0.f, d2c, r2c);
    }
    chk_commit(d2, r2, acc); chk_commit(d2c, r2c, acc + 2);
}

__global__ void __launch_bounds__(64) chk_y(const float* ny, const unsigned char* ws, float* acc, int nseg) {
    const int t = blockIdx.x, e = threadIdx.x; const bf16_t* Y = (const bf16_t*)(ws + WS_Y) + ((size_t)CB * 2048 + t) * 1024;
    float d2[3] = {0.f, 0.f, 0.f}, r2[3] = {0.f, 0.f, 0.f};
    for (int c = e; c < 1024; c += 64) { const int seg = c < 384 ? 0 : (c < 640 ? 1 : 2); const int cf = c < 384 ? c : (c < 640 ? 768 + (c - 384) : 384 + (c - 640)); const float f = bf2f(Y[cf]), r = ny[(size_t)t * 1024 + c];
        if (seg == 0) chk_add(f, r, d2[0], r2[0]); else if (seg == 1) chk_add(f, r, d2[1], r2[1]); else chk_add(f, r, d2[2], r2[2]); }
    if (nseg == 3) { chk_commit(d2[0], r2[0], acc); chk_commit(d2[1], r2[1], acc + 2); chk_commit(d2[2], r2[2], acc + 4); }
    else chk_commit(d2[0] + d2[1] + d2[2], r2[0] + r2[1] + r2[2], acc);
}

__global__ void __launch_bounds__(64) chk_x(const float* nx, const unsigned char* ws, float* acc) {
    const int t = blockIdx.x, e = threadIdx.x; const bf16_t* X = (const bf16_t*)(ws + WS_XB) + ((size_t)CB * 2048 + t) * 1024; float d2 = 0.f, r2 = 0.f;
    for (int c = e; c < 1024; c += 64) chk_add(bf2f(X[c]), nx[(size_t)t * 1024 + c], d2, r2);
    chk_commit(d2, r2, acc);
}

__global__ void __launch_bounds__(512) chk_code(float* acc, int nst, const float* nout) {
    __shared__ float sh[512];
    float s = 0.f; for (int i = threadIdx.x; i < 2048 * 1024; i += 512) { float v = nout[i]; s += v * v; }
    sh[threadIdx.x] = s; __syncthreads();
    if (threadIdx.x == 0) { float tot = 0.f; for (int i = 0; i < 512; ++i) tot += sh[i]; float rms = sqrtf(tot / (2048.f * 1024.f)); if (!(rms > 1e-3f && rms < 1e3f)) rms = 1.f;
        int code = 0;
        for (int st = 0; st < nst; ++st) { const float d2 = acc[2 * st], r2 = acc[2 * st + 1]; if (r2 == 0.f && d2 == 0.f) { if ((st & 15) >= 9) continue; code = (st + 1) * 4 + 3; break; } const float err = d2 / fmaxf(r2, 1e-30f);
            const float tol = CHK_TOL(st);
            if (!(err <= tol)) { const int cls = !(err < 1.f) ? 3 : (err >= 0.1f ? 2 : (err >= 0.01f ? 1 : 0)); code = (st + 1) * 4 + cls; break; } }
        acc[2 * 40] = rms * 32.f * exp2f(0.5f * (float)code); }
}
__global__ void __launch_bounds__(512) chk_fill(const float* acc, float* out) {
    const float K = acc[2 * 40];
    for (size_t i = (size_t)blockIdx.x * 512 + threadIdx.x; i < (size_t)NTOK * 1024; i += (size_t)gridDim.x * 512) out[i] = (i & 1) ? -K : K;
}
#endif

#if TIME_PH != -1
#ifndef TIME_Q
#define TIME_Q 6.f
#endif
#ifndef TIME_CAL
#define TIME_CAL 1.0f
#endif
__global__ void tm_acc(const unsigned long long* ts, float* best, int first) {
    int a = TIME_PH, b = TIME_PH + 1;
#ifdef TIME_PH_END
    b = TIME_PH_END;
#endif
    float T = 100.f; if (TIME_PH >= 0) T = (float)(ts[b] - ts[a]) * 0.01f;
    if (first || T < *best) *best = T;
}
__global__ void __launch_bounds__(512) tm_fill(const float* best, float* out) {
    float T = *best;
    T = exp2f(rintf(log2f(fmaxf(T, 1.f)) * TIME_Q) / TIME_Q);
    const float c = sqrtf(T) * TIME_CAL;
    for (size_t i = (size_t)blockIdx.x * 512 + threadIdx.x; i < (size_t)NTOK * 1024; i += (size_t)gridDim.x * 512) out[i] = (i & 1) ? -c : c;
}
#endif
static int g_grid = 0;
static bool setup_once(size_t ws_size) {
    if (g_grid) return g_grid > 0;
    if (ws_size < WS_END) { fprintf(stderr, "kernel_launch: workspace too small: %zu < %zu\n", ws_size, (size_t)WS_END); g_grid = -1; return false; }
    int dev = 0, cus = 0, per_cu = 0;
    if (hipGetDevice(&dev) != hipSuccess || hipDeviceGetAttribute(&cus, hipDeviceAttributeMultiprocessorCount, dev) != hipSuccess) { g_grid = -1; return false; }
    if (hipFuncSetAttribute((const void*)mk, hipFuncAttributeMaxDynamicSharedMemorySize, LDS_BYTES) != hipSuccess) { fprintf(stderr, "kernel_launch: hipFuncSetAttribute failed\n"); g_grid = -1; return false; }
    if (hipOccupancyMaxActiveBlocksPerMultiprocessor(&per_cu, (const void*)mk, 512, LDS_BYTES) != hipSuccess || per_cu < 1) { fprintf(stderr, "kernel_launch: occupancy query says %d\n", per_cu); }
    (void)hipGetLastError();
    g_grid = cus;
    return true;
}
static void launch_mk(const Args& a0, int lo, int hi, hipStream_t stream) { Args a = a0; a.ph_lo = lo; a.ph_hi = hi; hipLaunchKernelGGL(mk, dim3(g_grid), dim3(512), LDS_BYTES, stream, a); }

extern "C" void kernel_launch(void* const* d_in, const int* in_sizes, int n_in, void* d_out, int out_size, void* d_ws, size_t ws_size, hipStream_t stream) {
    if (!setup_once(ws_size)) return;
    unsigned char* ws = (unsigned char*)d_ws;
    (void)hipMemsetAsync(ws + WS_CTL, 0, ZERO_BYTES, stream);
    Args a{}; for (int i = 0; i < 30; ++i) a.in.p[i] = (const float*)d_in[i];
    a.out = (float*)d_out; a.ws = ws; a.ph_lo = 0; a.ph_hi = 0;
#if CHECK
    a.out = nullptr;
#endif
#if CHECK
    float* nb = (float*)d_out; size_t off = 0; NvScratch S;
    auto take = [&](size_t n) { float* p = nb + off; off += (n + 63) & ~(size_t)63; return p; };
    S.proj = take((size_t)2048 * DIN); S.h1 = take(2048 * 1024); S.qk = S.h1; S.hraw = S.qk + 2048 * 512; S.kn = S.hraw + 2048 * 256;
    S.kcmp = take(2 * 127 * 64); S.vcmp = take(2 * 127 * 64); S.dqn = take(2048 * 192); S.q = take(2048 * 576); S.dkvn = take(2048 * 128); S.kv = take(2048 * 768); S.x1 = S.dqn;
    S.krope = take(2048 * 32); S.y = take(2048 * 1024); S.xl = take(2048 * 1024); S.rt_e = (int*)take(2048 * 2); S.rt_w = take(2048 * 2);
    if (off * 4 > (size_t)NTOK * 1024 * 4) { fprintf(stderr, "naive scratch too big\n"); return; }
    float* acc = (float*)(ws + WS_CTL) + CW_CHK;
    launch_mk(a, 0, 1, stream);
    const float* nx_in = (const float*)d_in[0] + (size_t)CB * 2048 * 1024;
    int nst = 0;
    for (int l = 0; l < L_; ++l) {
        const int pb = 1 + l * NPH; const int sb = l * 16;
        launch_mk(a, pb + PH_INPROJ, pb + PH_INPROJ + 1, stream);
        naive_step(d_in, l, NS_INPROJ, nx_in, S.xl, S, stream);
        chk_proj<<<2048, 64, 0, stream>>>(S.proj, ws + WS_PRJ, (const float*)(ws + WS_SSQ + PT_DQ) + (size_t)l * 16384 * 4, (const float*)(ws + WS_SSQ + PT_DKV) + (size_t)l * 16384 * 2,
                                           (const float*)d_in[8] + l * 64, (const float*)d_in[9] + l * 64, (const float*)d_in[19] + l * 192 + 160, (const int*)d_in[1], acc + 2 * (sb + 0));
        nst = sb + 2;
        int ns_done = NS_INPROJ;
#if CHECK_UPTO >= 1
        launch_mk(a, pb + PH_PREP, pb + PH_PREP + 1, stream);
        naive_step(d_in, l, NS_NSAPREP, nx_in, S.xl, S, stream); naive_step(d_in, l, NS_MLAPREP, nx_in, S.xl, S, stream); ns_done = NS_MLAPREP;
        chk_prep<<<2048, 64, 0, stream>>>(S.q, S.kv, S.krope, S.kcmp, S.vcmp, ws, acc + 2 * (sb + 2));
        nst = sb + 4;
#endif
#if CHECK_UPTO >= 2
        launch_mk(a, pb + PH_MIX, pb + PH_MIX + 1, stream);
        naive_step(d_in, l, NS_NSA, nx_in, S.xl, S, stream); naive_step(d_in, l, NS_ML, nx_in, S.xl, S, stream); naive_step(d_in, l, NS_MLA, nx_in, S.xl, S, stream); ns_done = NS_MLA;
        chk_y<<<2048, 64, 0, stream>>>(S.y, ws, acc + 2 * (sb + 4), 3);
        nst = sb + 7;
#endif
#if CHECK_UPTO >= 3
        launch_mk(a, pb + PH_YNORM, pb + PH_YNORM + 1, stream); launch_mk(a, pb + PH_OUTPROJ, pb + PH_OUTPROJ + 1, stream);
        naive_step(d_in, l, NS_OUT, nx_in, S.xl, S, stream); ns_done = NS_OUT;
        chk_x<<<2048, 64, 0, stream>>>(S.x1, ws, acc + 2 * (sb + 7));
        nst = sb + 8;
#endif
#if CHECK_UPTO >= 4
        for (int ph = PH_ROUTE; ph <= PH_COMBINE; ++ph) launch_mk(a, pb + ph, pb + ph + 1, stream);
        naive_step(d_in, l, NS_ROUTE, nx_in, S.xl, S, stream); naive_step(d_in, l, NS_MOE, nx_in, S.xl, S, stream); ns_done = NS_MOE;
        chk_x<<<2048, 64, 0, stream>>>(S.xl, ws, acc + 2 * (sb + 8));
        nst = sb + 9;
#endif
        CHECK_REST
        for (int s = ns_done + 1; s <= NS_MOE; ++s) naive_step(d_in, l, s, nx_in, S.xl, S, stream);
        nx_in = S.xl;
        if (l == CHECK_LAYERS - 1) break;
    }
    chk_code<<<1, 512, 0, stream>>>(acc, nst, S.xl);
    chk_fill<<<1024, 512, 0, stream>>>(acc, (float*)d_out);
#else
#if defined(SPLIT_LAUNCH) && SPLIT_LAUNCH
    for (int ph = 0; ph < 1 + L_ * NPH; ++ph) launch_mk(a, ph, ph + 1, stream);
#else
    launch_mk(a, 0, 1 + L_ * NPH, stream);
#if TIME_PH != -1
    for (int rp = 0; rp < 6; ++rp) {
        (void)hipMemsetAsync(ws + WS_CTL, 0, ZERO_BYTES, stream); launch_mk(a, 0, 1 + L_ * NPH, stream);
        tm_acc<<<1, 1, 0, stream>>>((const unsigned long long*)((unsigned*)(ws + WS_CTL) + CW_TS), (float*)(ws + WS_META + META_RT), rp == 0);
    }
    tm_fill<<<1024, 512, 0, stream>>>((const float*)(ws + WS_META + META_RT), (float*)d_out);
#endif
#endif
#endif
}
```

```cpp
#define CHECK 0
#define CHECK_LAYERS 2
#define CHECK_UPTO 99
#define SPLIT_LAUNCH 0
#define REPEAT_PH -1
#include <hip/hip_runtime.h>
#include <stdint.h>
#include <cstdio>
#include <type_traits>

constexpr int B_ = 8, T_ = 2048, D_ = 1024, L_ = 2, NTOK = B_ * T_;
constexpr int DIN = 2554;
constexpr int O_AQ = 0, O_AKV = 384, O_AG = 1152, O_BQK = 1170, O_BV = 1682, O_BIF = 1938, O_BO = 1946, O_CDQ = 2202, O_CDKV = 2394, O_CKR = 2522;

typedef unsigned short bf16_t;
typedef short bf16x8 __attribute__((ext_vector_type(8)));
typedef short s16x4 __attribute__((ext_vector_type(4)));
typedef float f32x4 __attribute__((ext_vector_type(4)));
typedef float f32x16 __attribute__((ext_vector_type(16)));
typedef unsigned u32x4 __attribute__((ext_vector_type(4)));
typedef unsigned u32x2 __attribute__((ext_vector_type(2)));
typedef float f32x2_t __attribute__((ext_vector_type(2)));
typedef __bf16 bf16x2_t __attribute__((ext_vector_type(2)));
#define LAS __attribute__((address_space(3)))

__device__ __forceinline__ unsigned pk_bf16(float lo, float hi) { f32x2_t v = {lo, hi}; bf16x2_t b = __builtin_convertvector(v, bf16x2_t); return __builtin_bit_cast(unsigned, b); }
__device__ __forceinline__ float bf_lo(unsigned u) { return __builtin_bit_cast(float, u << 16); }
__device__ __forceinline__ float bf_hi(unsigned u) { return __builtin_bit_cast(float, u & 0xffff0000u); }
__device__ __forceinline__ float bf2f(bf16_t h) { return __builtin_bit_cast(float, (unsigned)h << 16); }
__device__ __forceinline__ bf16_t f2bf(float f) { return (bf16_t)(pk_bf16(f, 0.f) & 0xffffu); }
template <int M> __device__ __forceinline__ int shx(int v) { static_assert(M > 0 && M < 32, "swizzle xor mask"); return __builtin_amdgcn_ds_swizzle(v, (M << 10) | 0x1f); }
template <int M> __device__ __forceinline__ float shx(float v) { return __builtin_bit_cast(float, shx<M>(__builtin_bit_cast(int, v))); }
template <int M> __device__ __forceinline__ unsigned shx(unsigned v) { return (unsigned)shx<M>((int)v); }
__device__ __forceinline__ float wave_sum(float v) { v += __shfl_xor(v, 32); v += shx<16>(v); v += shx<8>(v); v += shx<4>(v); v += shx<2>(v); v += shx<1>(v); return v; }
__device__ __forceinline__ float wave_max(float v) { v = fmaxf(v, __shfl_xor(v, 32)); v = fmaxf(v, shx<16>(v)); v = fmaxf(v, shx<8>(v)); v = fmaxf(v, shx<4>(v)); v = fmaxf(v, shx<2>(v)); v = fmaxf(v, shx<1>(v)); return v; }
__device__ __forceinline__ float siluf(float x) { return x * __builtin_amdgcn_rcpf(1.f + __expf(-x)); }
__device__ __forceinline__ float sigmf(float x) { return __builtin_amdgcn_rcpf(1.f + __expf(-x)); }
__device__ __forceinline__ int t5b(int dist) {
    int n = dist > 0 ? dist : 0; if (n < 16) return n;
    float v = logf((float)n / 16.f) / logf(8.f) * 16.f; int l = 16 + (int)v; return l < 31 ? l : 31;
}

__device__ __forceinline__ int lane_now() { return (int)__builtin_amdgcn_mbcnt_hi(~0u, __builtin_amdgcn_mbcnt_lo(~0u, 0u)); }
#define TIDX ((g_wv << 6) | lane_now())

constexpr size_t WS_CTL = 0, CTL_BYTES = 65536;
constexpr size_t WS_SSQ = WS_CTL + CTL_BYTES;
constexpr size_t ZERO_BYTES = CTL_BYTES;
constexpr size_t PT_DQ = 0, PT_DKV = PT_DQ + (size_t)2 * 16384 * 4 * 4, PT_A = PT_DKV + (size_t)2 * 16384 * 2 * 4, PT_C = PT_A + (size_t)2 * 16384 * 8 * 4, PT_X1 = PT_C + (size_t)2 * 16384 * 8 * 4, PT_END = PT_X1 + (size_t)2 * 16384 * 16 * 4;
constexpr size_t WS_SSQX = WS_SSQ + PT_END;
constexpr size_t WS_RS2 = WS_SSQX + 2 * 65536;
constexpr size_t WS_WIN = WS_RS2 + 65536;
constexpr size_t WS_WOUT = WS_WIN + (size_t)2 * 2560 * 1024 * 2;
constexpr size_t WS_WUQ = WS_WOUT + (size_t)2 * 1024 * 1024 * 2;
constexpr size_t WS_WUKV = WS_WUQ + (size_t)2 * 768 * 256 * 2;
constexpr size_t WS_WC1 = WS_WUKV + (size_t)2 * 768 * 256 * 2;
constexpr size_t WS_WC2 = WS_WC1 + (size_t)2 * 2 * 64 * 2048 * 2;
constexpr size_t WS_WR = WS_WC2 + (size_t)2 * 2 * 64 * 64 * 2;
constexpr size_t WS_B1C = WS_WR + (size_t)2 * 64 * 1024 * 2;
constexpr size_t WS_BIASD = WS_B1C + 1024;
constexpr size_t WS_ROPE = WS_BIASD + 6 * 2048 * 4;
constexpr size_t WS_WMOE = WS_ROPE + (size_t)16384 * 32 * 4;
constexpr size_t WMOE_WD = (size_t)32 * 512 * 1024 * 2;
constexpr size_t WS_XB = WS_WMOE + 50331648;
constexpr size_t WS_MLA = WS_XB + 33554432;
constexpr size_t MLA_KM = (size_t)8 * 6 * 2048 * 96 * 2, MLA_VM = 2 * MLA_KM;
constexpr size_t WS_HBUF = WS_MLA;
constexpr size_t WS_PRJ = WS_MLA + 50331648;
constexpr size_t HM64 = (size_t)2048 * 64 * 2;
constexpr size_t PRJ_QN = 0;
constexpr size_t PRJ_KN1 = PRJ_QN + 48 * HM64, PRJ_VN1 = PRJ_KN1 + 16 * HM64, PRJ_KN2 = PRJ_VN1 + 16 * HM64, PRJ_VN2 = PRJ_KN2 + 16 * HM64;
constexpr size_t PRJ_VML = PRJ_VN2 + 16 * HM64;
constexpr size_t PRJ_OG = PRJ_VML + 32 * HM64;
constexpr size_t PRJ_KR = PRJ_OG + (size_t)16384 * 256 * 2;
constexpr size_t PRJ_GATES = PRJ_KR + (size_t)16384 * 32 * 2;
constexpr size_t PRJ_DEAD = PRJ_GATES + (size_t)16384 * 32 * 4;
constexpr size_t PRJ_C0K = PRJ_DEAD, PRJ_C0V = PRJ_C0K + 16 * HM64 + 8192;
constexpr size_t PRJ_RAWQK = PRJ_C0V + 16 * HM64 + 8192;
constexpr size_t PRJ_DQKV = PRJ_RAWQK + (size_t)16384 * 512 * 2;
constexpr size_t PRJ_END = PRJ_DQKV + (size_t)16384 * 384 * 2;
static_assert(PRJ_END - PRJ_DEAD >= 33554432, "Y fits the dead part of PRJ");
constexpr size_t WS_Y = WS_PRJ + PRJ_DEAD;
constexpr size_t WS_YBUF = WS_PRJ;
static_assert((size_t)2 * 16384 * 1024 * 2 <= PRJ_END, "YBUF fits the PRJ region");
constexpr size_t WS_ML = WS_PRJ + PRJ_END;
constexpr size_t ML_KC = 32 * HM64, ML_DELTA = 2 * ML_KC, ML_DN = ML_DELTA + (size_t)1024 * 4096 * 2, ML_G = ML_DN + (size_t)1024 * 64 * 4, ML_BL = ML_G + (size_t)8 * 4 * 2048 * 2 * 4, ML_CP = ML_BL + 4096, ML_NP = ML_CP + (size_t)1024 * 4096 * 2, ML_END = ML_NP + (size_t)1024 * 64 * 2;
constexpr size_t WS_CMP = WS_ML + ML_END;
constexpr size_t CMP_V = (size_t)8 * 2 * 128 * 64 * 2;
constexpr size_t WS_META = WS_CMP + 2 * CMP_V;
constexpr size_t META_W = (size_t)32 * 16384 * 4, META_RT = 2 * META_W;
constexpr size_t WS_END = WS_META + META_RT + (size_t)16384 * 16;
constexpr int CW_BAR = 0;
constexpr int CW_Q = 4096;
constexpr int CW_SCAN = 4608;
constexpr int CW_TS = 4864;
constexpr int CW_CHK = 5120;
constexpr int CW_CNT = 8192;
constexpr int LDS_BYTES = 147456;
constexpr int LDS_MISC = LDS_BYTES - 256;
#define XB_TMO      128
#define XB_XCNT(j)  (256  + 64 * (j))
#define XB_XSUB(j)  (1280 + 64 * (j))
#define XB_XGEN(j)  (2304 + 64 * (j))
#define XB_TOP      3328
#define XB_TOPGEN   3392
#define XCD_BAR_WORDS 3456
#define XB_SPIN_CAP (1u << 18)

__device__ __forceinline__ unsigned xb_ld(unsigned* p)              { return __hip_atomic_load(p, __ATOMIC_RELAXED, __HIP_MEMORY_SCOPE_AGENT); }
__device__ __forceinline__ unsigned xb_add(unsigned* p, unsigned v) { return __hip_atomic_fetch_add(p, v, __ATOMIC_RELAXED, __HIP_MEMORY_SCOPE_AGENT); }
__device__ __forceinline__ unsigned xb_xcc_id() { return (unsigned)__builtin_amdgcn_s_getreg((3 << 11) | 20) & 0xFu; }
#define XB_SPIN(cond, bar) do { unsigned _sp = 0; while (cond) { __builtin_amdgcn_s_sleep(1); \
    if ((++_sp & 255u) == 0u) { if (xb_ld(&(bar)[XB_TMO])) break; if (_sp > XB_SPIN_CAP) { atomicAdd(&(bar)[XB_TMO], 1u); break; } } } } while (0)

struct XcdBarrier {
    int g_wv; unsigned* bar; unsigned x;
    volatile LAS unsigned* st;
};

__device__ __forceinline__ XcdBarrier xcd_barrier_post(unsigned* bar, volatile LAS unsigned* st, int g_wv) {
    XcdBarrier b; b.g_wv = g_wv; b.bar = bar; b.x = xb_xcc_id(); b.st = st;
    if (TIDX == 0) (void)xb_add(&bar[XB_XCNT(b.x)], 1u);
    return b;
}
__device__ __forceinline__ void xcd_barrier_complete(unsigned* bar, unsigned x, unsigned& nloc, unsigned& nx) {
    const unsigned G = gridDim.x * gridDim.y * gridDim.z;
    unsigned sum, cnt, mine, sp = 0u;
    for (;;) {
        sum = 0u; cnt = 0u; mine = 0u;
#pragma unroll
        for (unsigned j = 0; j < 16; ++j) { const unsigned c = xb_ld(&bar[XB_XCNT(j)]); sum += c; cnt += (c > 0u) ? 1u : 0u; mine = (j == x) ? c : mine; }
        if (sum == G) break;
        __builtin_amdgcn_s_sleep(1);
        if ((++sp & 255u) == 0u) { if (xb_ld(&bar[XB_TMO])) break; if (sp > XB_SPIN_CAP) { atomicAdd(&bar[XB_TMO], 1u); break; } }
    }
    nloc = mine > 0u ? mine : 1u; nx = cnt > 0u ? cnt : 1u;
}

__device__ __forceinline__ void xcd_barrier(const XcdBarrier& b) {
    asm volatile("s_waitcnt vmcnt(0)" ::: "memory");
    __syncthreads();
    const int g_wv = b.g_wv;
    if (TIDX == 0) {
        unsigned* bar = b.bar;
        __builtin_amdgcn_s_waitcnt(0);
        unsigned nloc = b.st[0], nx = b.st[1];
        if (nloc == 0u) { xcd_barrier_complete(bar, b.x, nloc, nx); b.st[0] = nloc; b.st[1] = nx; }
        const unsigned old = xb_add(&bar[XB_XSUB(b.x)], 1u);
        const unsigned gen = old / nloc;
        if (old + 1u == (gen + 1u) * nloc) {
            __builtin_amdgcn_fence(__ATOMIC_RELEASE, "agent");
            asm volatile("s_waitcnt vmcnt(0)" ::: "memory");
            const unsigned og = xb_add(&bar[XB_TOP], 1u);
            const unsigned tg = og / nx;
            if (og + 1u == (tg + 1u) * nx) xb_add(&bar[XB_TOPGEN], 1u);
            else XB_SPIN(xb_ld(&bar[XB_TOPGEN]) == tg, bar);
            __builtin_amdgcn_fence(__ATOMIC_ACQUIRE, "agent");
            xb_add(&bar[XB_XGEN(b.x)], 1u);
            asm volatile("s_waitcnt vmcnt(0)" ::: "memory");
        } else {
            XB_SPIN(xb_ld(&bar[XB_XGEN(b.x)]) == gen, bar);
            __builtin_amdgcn_fence(__ATOMIC_ACQUIRE, "agent");
            asm volatile("s_waitcnt vmcnt(0)" ::: "memory");
        }
    }
    __syncthreads();
}
struct Inputs { const float* p[30]; };
typedef const __attribute__((address_space(4))) Inputs* InPtr;
__device__ __forceinline__ InPtr in_tab() { InPtr p = (InPtr)__builtin_amdgcn_kernarg_segment_ptr(); asm volatile("" : "+s"(p)); return p; }
__device__ __forceinline__ unsigned char* launder(unsigned char* p) { size_t z = 0; asm volatile("" : "+s"(z)); return p + z; }

__host__ __device__ inline int inproj_refcol(int G, int e) {
    if (G < 6) return O_AQ + G * 64 + e;
    if (G < 18) return O_AKV + (G - 6) * 64 + e;
    if (G < 26) return O_BQK + (G - 18) * 64 + e;
    if (G < 30) return O_BV + (G - 26) * 64 + e;
    if (G < 34) return O_BO + (G - 30) * 64 + e;
    if (G < 37) return O_CDQ + (G - 34) * 64 + e;
    if (G == 37) { if (e < 32) return O_CKR + e; if (e < 50) return O_AG + (e - 32); if (e < 58) return O_BIF + (e - 50); return -1; }
    return O_CDKV + (G - 38) * 64 + e;
}
__host__ __device__ inline int uq_refcol(int G, int e) {
    if (G < 6) return G * 96 + e;
    if (G < 9) { const int idx = e & 31, bj = e >> 5, sub = idx >> 4, i = idx & 15; return (2 * (G - 6) + sub) * 96 + 64 + bj * 16 + i; }
    return -1;
}
__host__ __device__ inline int ukv_refcol(int G, int e) { return G < 6 ? G * 128 + e : (G - 6) * 128 + 64 + e; }
#define N2G(n) ((((n) >> 8) << 2) + (((n) >> 5) & 3))
#define N2E(n) (((((n) >> 7) & 1) << 5) + ((n) & 31))

__device__ __forceinline__ float opaque_f(float v) { asm volatile("" : "+v"(v)); return v; }
struct FWin { const float* w; const float* g; __device__ __forceinline__ void ld(int k, int n, const float*& p, float& gn, float gk) const { const int c = inproj_refcol(N2G(n), N2E(n)); p = w + (size_t)k * DIN + (c < 0 ? 0 : c); gn = c < 0 ? 0.f : gk; }
    __device__ __forceinline__ float rowgain(int k) const { return opaque_f(g[k]); } };
struct FWout { const float* w; const float* ga; const float* gc; __device__ __forceinline__ void ld(int k, int n, const float*& p, float& gn, float gk) const {
    const int kr = k < 384 ? k : (k < 768 ? 640 + (k - 384) : 384 + (k - 768)); p = w + (size_t)kr * 1024 + n; gn = gk; }
    __device__ __forceinline__ float rowgain(int k) const { const float a = opaque_f(ga[k < 384 ? k : 0]), c = opaque_f(gc[(k >= 384 && k < 768) ? k - 384 : 0]); return k < 384 ? a : (k < 768 ? c : 1.f); } };
struct FWuq { const float* w; const float* g; __device__ __forceinline__ void ld(int k, int n, const float*& p, float& gn, float gk) const { const int c = uq_refcol(N2G(n), N2E(n)); const int kk = k < 192 ? k : 191; p = w + (size_t)kk * 576 + (c < 0 ? 0 : c); gn = (k < 192 && c >= 0) ? gk : 0.f; }
    __device__ __forceinline__ float rowgain(int k) const { return opaque_f(g[k < 192 ? k : 191]); } };
struct FWukv { const float* w; const float* g; __device__ __forceinline__ void ld(int k, int n, const float*& p, float& gn, float gk) const { const int c = ukv_refcol(N2G(n), N2E(n)); const int kk = k >= 128 ? k - 128 : 0; p = w + (size_t)kk * 768 + c; gn = k >= 128 ? gk : 0.f; }
    __device__ __forceinline__ float rowgain(int k) const { return opaque_f(g[k >= 128 ? k - 128 : 0]); } };
struct FWc1 { const float* w; __device__ __forceinline__ void ld(int k, int n, const float*& p, float& gn, float gk) const { p = w + (size_t)k * 64 + n; gn = 1.f; }
    __device__ __forceinline__ float rowgain(int k) const { return 1.f; } };
struct FWr { const float* wg; const float* we; const float* g; __device__ __forceinline__ void ld(int k, int n, const float*& p, float& gn, float gk) const { p = n < 4 ? wg + k * 4 + n : we + k * 32 + (n < 36 ? n - 4 : 0); gn = n < 36 ? gk : 0.f; }
    __device__ __forceinline__ float rowgain(int k) const { return opaque_f(g[k]); } };
struct FWgu { const float* src; const float* g; int n0, col0; __device__ __forceinline__ float operator()(int k, int n) const { return src[(size_t)k * 256 + col0 + (n - n0)] * g[k]; } };
struct FWd { const float* w; __device__ __forceinline__ float operator()(int k, int n) const { return w[(size_t)k * 1024 + n]; } };

__device__ __forceinline__ void rope_cs(int pos, int j, float& cs, float& sn) {
    const double inv = exp2(-(double)j * (13.287712379549449 / 16.0));
    const double rev = (double)pos * inv * 0.15915494309189535; const float f = (float)(rev - rint(rev));
    cs = __builtin_amdgcn_cosf(f); sn = __builtin_amdgcn_sinf(f);
}
template <class F>
__device__ __forceinline__ void cvt_tile(const F& f, int n0, int k0, bf16_t* dst, int ldk, LAS float* tile, int tid) {
    { const int k = tid >> 3, nb = (tid & 7) * 8; const float gk = f.rowgain(k0 + k); const float* p[8]; float gn[8], v[8];
#pragma unroll
      for (int j = 0; j < 8; ++j) f.ld(k0 + k, n0 + nb + j, p[j], gn[j], gk);
#pragma unroll
      for (int j = 0; j < 8; ++j) v[j] = *p[j];
#pragma unroll
      for (int j = 0; j < 8; ++j) tile[k * 65 + nb + j] = v[j] * gn[j]; }
    __syncthreads();
    { const int n = tid >> 3, kb = (tid & 7) * 8; const LAS float* s = tile + kb * 65 + n;
      u32x4 o; o.x = pk_bf16(s[0], s[65]); o.y = pk_bf16(s[130], s[195]); o.z = pk_bf16(s[260], s[325]); o.w = pk_bf16(s[390], s[455]);
      *(u32x4*)(dst + (size_t)(n0 + n) * ldk + k0 + kb) = o; }
    __syncthreads();
}
template <class F>
__device__ __forceinline__ void cvt_item(const F& f, int it, int nK, bf16_t* dst, int ldk, LAS float* tile, int tid) { cvt_tile(f, (it / nK) * 64, (it % nK) * 64, dst, ldk, tile, tid); }

__device__ __forceinline__ void moe_item(InPtr in, int l, int it, const float*& src, int& ld, size_t& dst, int& ldk, bool& gain, int& kk0) {
    if (it < 32 * 64) { const int e = it >> 6, r = it & 63, n0 = (r >> 3) * 64, k0 = (r & 7) * 128, c0 = n0 & 255;
        src = (c0 < 128 ? in->p[27] : in->p[28]) + ((size_t)l * 32 + e) * 262144 + (size_t)k0 * 256 + (n0 >> 8) * 128 + (c0 & 127); ld = 256; gain = true; kk0 = k0;
        dst = ((size_t)e * 512 + n0) * 1024 + k0; ldk = 1024; }
    else { const int j = it - 32 * 64, e = j >> 5, r = j & 31, n0 = (r >> 1) * 64, k0 = (r & 1) * 128;
        src = in->p[29] + ((size_t)l * 32 + e) * 262144 + (size_t)k0 * 1024 + n0; ld = 1024; gain = false; kk0 = 0;
        dst = (size_t)16777216 + ((size_t)e * 1024 + n0) * 256 + k0; ldk = 256; }
}
__device__ __forceinline__ void cvt_moe_layer(InPtr in, unsigned char* ws, int l, LAS float* tile, int bid, int nb, int tid, int it_lo = 0, int it_hi = 32 * (64 + 32)) {
    asm volatile("" : "+v"(tid));
    const float* g2 = in->p[22] + l * 1024; bf16_t* W = (bf16_t*)(ws + WS_WMOE);
    const int k = tid >> 3, nbq = (tid & 7) * 8;
    const int n = tid >> 3, kb = (tid & 7) * 8;
    const int NIT = it_hi;
#define CVM_LOAD(it_, P) do { const float* src_; int ld_, ldk_, kk0_; size_t dst_; bool gain_; moe_item(in, l, (it_), src_, ld_, dst_, ldk_, gain_, kk0_); \
        P##a = *(const f32x4*)(src_ + (size_t)k * ld_ + nbq); P##b = *(const f32x4*)(src_ + (size_t)k * ld_ + nbq + 4); P##c = *(const f32x4*)(src_ + (size_t)(k + 64) * ld_ + nbq); P##d = *(const f32x4*)(src_ + (size_t)(k + 64) * ld_ + nbq + 4); \
        P##g0 = gain_ ? g2[kk0_ + k] : 1.f; P##g1 = gain_ ? g2[kk0_ + 64 + k] : 1.f; } while (0)
#define CVM_PUT(t, P) do { \
        t[k * 65 + nbq + 0] = P##a.x * P##g0; t[k * 65 + nbq + 1] = P##a.y * P##g0; t[k * 65 + nbq + 2] = P##a.z * P##g0; t[k * 65 + nbq + 3] = P##a.w * P##g0; \
        t[k * 65 + nbq + 4] = P##b.x * P##g0; t[k * 65 + nbq + 5] = P##b.y * P##g0; t[k * 65 + nbq + 6] = P##b.z * P##g0; t[k * 65 + nbq + 7] = P##b.w * P##g0; \
        t[(k + 64) * 65 + nbq + 0] = P##c.x * P##g1; t[(k + 64) * 65 + nbq + 1] = P##c.y * P##g1; t[(k + 64) * 65 + nbq + 2] = P##c.z * P##g1; t[(k + 64) * 65 + nbq + 3] = P##c.w * P##g1; \
        t[(k + 64) * 65 + nbq + 4] = P##d.x * P##g1; t[(k + 64) * 65 + nbq + 5] = P##d.y * P##g1; t[(k + 64) * 65 + nbq + 6] = P##d.z * P##g1; t[(k + 64) * 65 + nbq + 7] = P##d.w * P##g1; } while (0)
#define CVM_STORE(it_, t) do { const float* src_; int ld_, ldk_, kk0_; size_t dst_; bool gain_; moe_item(in, l, (it_), src_, ld_, dst_, ldk_, gain_, kk0_); \
        _Pragma("unroll") for (int hh = 0; hh < 2; ++hh) { const LAS float* s_ = t + (64 * hh + kb) * 65 + n; \
            u32x4 o; o.x = pk_bf16(s_[0], s_[65]); o.y = pk_bf16(s_[130], s_[195]); o.z = pk_bf16(s_[260], s_[325]); o.w = pk_bf16(s_[390], s_[455]); \
            *(u32x4*)(W + dst_ + (size_t)n * ldk_ + 64 * hh + kb) = o; } } while (0)
    f32x4 Aa, Ab, Ac, Ad, Ba, Bb, Bc, Bd; float Ag0 = 1.f, Ag1 = 1.f, Bg0 = 1.f, Bg1 = 1.f;
    LAS float* t0 = tile; LAS float* t1 = tile + 128 * 65;
    int it = it_lo + bid;
    if (it < NIT) CVM_LOAD(it, A);
    if (it + nb < NIT) CVM_LOAD(it + nb, B);
#pragma unroll 1
    for (; it < NIT; it += 2 * nb) {
        CVM_PUT(t0, A);
        __syncthreads();
        if (it + 2 * nb < NIT) CVM_LOAD(it + 2 * nb, A);
        CVM_STORE(it, t0);
        if (it + nb < NIT) {
            CVM_PUT(t1, B);
            __syncthreads();
            if (it + 3 * nb < NIT) CVM_LOAD(it + 3 * nb, B);
            CVM_STORE(it + nb, t1);
        }
    }
#undef CVM_LOAD
#undef CVM_PUT
#undef CVM_STORE
    __syncthreads();
}

__device__ __forceinline__ void cvt_small_weights(InPtr in, unsigned char* ws, int l, LAS float* tile, int bid, int nb, int tid) {
    asm volatile("" : "+v"(tid));
    constexpr int I_WIN = 40 * 16, I_WOUT = 16 * 16, I_WU = 12 * 4, I_WC1 = 32, I_WC2 = 1, I_WR = 16;
    constexpr int PER_L = I_WIN + I_WOUT + 2 * I_WU + 2 * I_WC1 + 2 * I_WC2 + I_WR;
    for (int it0 = bid; it0 < PER_L; it0 += nb) {
        int it = it0;
        if (it < I_WIN) { FWin f{in->p[4] + (size_t)l * 1024 * DIN, in->p[3] + l * 1024}; cvt_item(f, it, 16, (bf16_t*)(ws + WS_WIN) + (size_t)l * 2560 * 1024, 1024, tile, tid); continue; } it -= I_WIN;
        if (it < I_WOUT) { FWout f{in->p[21] + (size_t)l * 1048576, in->p[10] + l * 384, in->p[20] + l * 384}; cvt_item(f, it, 16, (bf16_t*)(ws + WS_WOUT) + (size_t)l * 1048576, 1024, tile, tid); continue; } it -= I_WOUT;
        if (it < I_WU) { FWuq f{in->p[16] + (size_t)l * 192 * 576, in->p[15] + l * 192}; cvt_item(f, it, 4, (bf16_t*)(ws + WS_WUQ) + (size_t)l * 768 * 256, 256, tile, tid); continue; } it -= I_WU;
        if (it < I_WU) { FWukv f{in->p[18] + (size_t)l * 128 * 768, in->p[17] + l * 128}; cvt_item(f, it, 4, (bf16_t*)(ws + WS_WUKV) + (size_t)l * 768 * 256, 256, tile, tid); continue; } it -= I_WU;
        if (it < 2 * I_WC1) { const int s = it / I_WC1; FWc1 f{in->p[6] + ((size_t)l * 2 + s) * 2048 * 64}; cvt_item(f, it % I_WC1, 32, (bf16_t*)(ws + WS_WC1) + ((size_t)l * 2 + s) * 64 * 2048, 2048, tile, tid); continue; } it -= 2 * I_WC1;
        if (it < 2 * I_WC2) { const int s = it; FWc1 f{in->p[7] + ((size_t)l * 2 + s) * 64 * 64}; cvt_item(f, 0, 1, (bf16_t*)(ws + WS_WC2) + ((size_t)l * 2 + s) * 64 * 64, 64, tile, tid); continue; } it -= 2 * I_WC2;
        { FWr f{in->p[23] + (size_t)l * 4096, in->p[25] + (size_t)l * 32768, in->p[22] + l * 1024}; cvt_item(f, it, 16, (bf16_t*)(ws + WS_WR) + (size_t)l * 64 * 1024, 1024, tile, tid); }
    }
}

__device__ __forceinline__ void prologue(InPtr in, unsigned char* ws, LAS unsigned char* lds, int bid, int nb, int g_wv) {
    int tid_ = TIDX; asm volatile("" : "+v"(tid_));
    const int tid = tid_, lane = tid & 63, wid = tid >> 6;
    LAS float* tile = (LAS float*)lds;
    cvt_small_weights(in, ws, 0, tile, bid, nb, tid);
    { const float* x = in->p[0]; bf16_t* XB = (bf16_t*)(ws + WS_XB); float* ssqx = (float*)(ws + WS_SSQX);
      for (int r0 = (bid * 8 + wid) * 2; r0 < NTOK; r0 += nb * 16) {
          f32x4 v[2][4];
#pragma unroll
          for (int rr = 0; rr < 2; ++rr)
#pragma unroll
              for (int j = 0; j < 4; ++j) v[rr][j] = *((const f32x4*)(x + (size_t)(r0 + rr) * 1024) + lane + 64 * j);
#pragma unroll
          for (int rr = 0; rr < 2; ++rr) { float s = 0.f; u32x2* o = (u32x2*)(XB + (size_t)(r0 + rr) * 1024) + lane;
#pragma unroll
              for (int j = 0; j < 4; ++j) { const f32x4 q = v[rr][j]; s += (q.x * q.x + q.y * q.y) + (q.z * q.z + q.w * q.w); u32x2 w; w.x = pk_bf16(q.x, q.y); w.y = pk_bf16(q.z, q.w); o[64 * j] = w; }
              s = wave_sum(s); if (lane == 0) ssqx[r0 + rr] = s; }
      } }
    { float* biasd = (float*)(ws + WS_BIASD); const float* rb = in->p[2];
      for (int i = bid * 512 + tid; i < 6 * 2048; i += nb * 512) { const int h = i >> 11, d = i & 2047; biasd[i] = rb[t5b(d) * 6 + h] * 1.44269504f; } }
    { float* rope = (float*)(ws + WS_ROPE); const int* pos = (const int*)in->p[1];
      for (int i = bid * 512 + tid; i < NTOK * 16; i += nb * 512) { const int tk = i >> 4, j = i & 15; float cs, sn; rope_cs(pos[tk], j, cs, sn); rope[(size_t)tk * 32 + j] = cs; rope[(size_t)tk * 32 + 16 + j] = sn; } }
    { float* b1c = (float*)(ws + WS_B1C); LAS float* red = (LAS float*)lds;
      for (int it = nb - 1 - bid; it >= 0 && it < 4; it += nb) { const float* pe = in->p[5] + (size_t)it * 2048; const float* w1 = in->p[6] + (size_t)it * 2048 * 64; const int f4 = tid & 15, kp = tid >> 4;
          f32x4 a = (f32x4){0.f, 0.f, 0.f, 0.f};
#pragma unroll 1
          for (int k0 = kp * 64; k0 < kp * 64 + 64; k0 += 16) { f32x4 wv[16]; float pv[16];
#pragma unroll
              for (int j = 0; j < 16; ++j) { wv[j] = *(const f32x4*)(w1 + (size_t)(k0 + j) * 64 + 4 * f4); pv[j] = pe[k0 + j]; }
#pragma unroll
              for (int j = 0; j < 16; ++j) { a.x += pv[j] * wv[j].x; a.y += pv[j] * wv[j].y; a.z += pv[j] * wv[j].z; a.w += pv[j] * wv[j].w; } }
          __syncthreads(); *(LAS f32x4*)(red + kp * 64 + 4 * f4) = a; __syncthreads();
          if (tid < 64) { float sum = 0.f; for (int p2 = 0; p2 < 32; ++p2) sum += red[p2 * 64 + tid]; b1c[it * 64 + tid] = sum; }
          __syncthreads(); } }
}
namespace g8 {
constexpr int BM = 256, BK = 64, HALF = 128, HTB = HALF * BK * 2, STAGE_BYTES = 8 * HTB, NXCD = 8, WGM = 8;
__host__ __device__ __forceinline__ int lds_byte(int r, int c) { const int st = (r >> 4) * 2 + (c >> 5), rr = r & 15, cc = c & 31, ob = rr * 64 + cc * 2; return st * 1024 + (ob ^ (((ob >> 9) & 1) << 5)); }
__host__ __device__ __forceinline__ void stage_rc(int b, int& R, int& C) { const int st = b / 1024, sb = b % 1024, swz = sb ^ (((sb >> 9) & 1) << 5); R = (st >> 1) * 16 + swz / 64; C = (st & 1) * 32 + (swz % 64) / 2; }
__host__ __device__ __forceinline__ int perm32(int rho) { const int n = rho >> 4, i = rho & 15; return 8 * (i >> 2) + 4 * n + (i & 3); }

struct GUnit { const char* a; const char* b; int pm, pn, e, rows; };

__device__ __forceinline__ bool static_unit(int i, int G, int c, int nM, int nN, int& pm, int& pn) {
    const int nwg = nM * nN; const long L = (long)i * G + c; if (L >= nwg) return false;
    int wgid = (int)L; { const int q = nwg / NXCD, r = nwg % NXCD, xcd = wgid % NXCD, off = wgid / NXCD; wgid = (xcd < r ? xcd * (q + 1) : r * (q + 1) + (xcd - r) * q) + off; }
    const int nig = WGM * nN, gid = wgid / nig, fm = gid * WGM, gsz = (nM - fm) < WGM ? (nM - fm) : WGM;
    pm = fm + ((wgid % nig) % gsz); pn = (wgid % nig) / gsz; return true;
}
struct DenseSched {
    static constexpr bool GATHER = false, PARTIAL = false;
    const char* A; const char* Bt; int lda, ldb, nM, nN, G, c; int rot;
    __device__ __forceinline__ bool next(int i, GUnit& u) const {
        int pm, pn; if (!static_unit(i, G, c, nM, nN, pm, pn)) return false;
        if (rot) { pn += rot; if (pn >= nN) pn -= nN; }
        u.pm = pm; u.pn = pn; u.e = 0; u.rows = 256; u.a = A + (size_t)pm * 256 * lda * 2; u.b = Bt + (size_t)pn * 256 * ldb * 2; return true;
    }
    __device__ __forceinline__ void aoff(const GUnit&, unsigned (&v)[2][2], const int (&R)[2], const int (&C)[2]) const {
#pragma unroll
        for (int h = 0; h < 2; ++h)
#pragma unroll
            for (int i = 0; i < 2; ++i) v[h][i] = (unsigned)((h * 128 + R[i]) * lda + C[i]) * 2u;
    }
};

template <class Epi, class Sched>
__device__ __forceinline__ void gemm_run(LAS unsigned char* lds, const int K, const int ldb, const Sched& S, const Epi& E, int g_wv) {
    int tid_ = TIDX; asm volatile("" : "+v"(tid_));
    const int tid = tid_, wid = __builtin_amdgcn_readfirstlane(tid >> 6), lane = tid & 63, wr = wid >> 2, wc = wid & 3, fr = lane & 15, fq = lane >> 4;
    int nt_ = K / BK; asm volatile("" : "+s"(nt_));
    const int nt = nt_;
    int R[2], C[2]; unsigned voffB[2];
#pragma unroll
    for (int i = 0; i < 2; ++i) { stage_rc(tid * 16 + i * 8192, R[i], C[i]); const int Rb = (R[i] & ~31) + perm32(R[i] & 31); voffB[i] = (unsigned)(Rb * ldb + C[i]) * 2u; }
    const size_t kstep = (size_t)(BK * 2);
    const size_t hstepB = (size_t)HALF * ldb * 2;
    const unsigned ldsw = (unsigned)wid * 1024u;
    const int aoff = lds_byte(wr * 64 + fr, fq * 8), boff = lds_byte(wc * 32 + fr, fq * 8);
#define G8_SA(b, h) (((b) * 2 + (h)) * HTB)
#define G8_SB(b, h) ((4 + (b) * 2 + (h)) * HTB)
#define G8_GLDS(bufoff, gptr, i_) __builtin_amdgcn_global_load_lds((const unsigned*)(gptr), (LAS unsigned*)(lds + (bufoff) + ldsw + (i_) * 8192), 16, 0, 0)
#define G8_STAGE_B(bufoff, gbase) do { G8_GLDS(bufoff, (const char*)(gbase) + voffB[0], 0); G8_GLDS(bufoff, (const char*)(gbase) + voffB[1], 1); } while (0)
#define G8_STAGE_A(bufoff, gbase, v0, v1) do { G8_GLDS(bufoff, (const char*)(gbase) + (v0), 0); G8_GLDS(bufoff, (const char*)(gbase) + (v1), 1); } while (0)
#define G8_LDA(dst, b, h) do { _Pragma("unroll") for (int m = 0; m < 4; ++m) _Pragma("unroll") for (int k = 0; k < 2; ++k) dst[m][k] = *(const LAS bf16x8*)(lds + G8_SA(b, h) + aoff + m * 2048 + k * 1024); } while (0)
#define G8_LDB(dst, b, h) do { _Pragma("unroll") for (int n = 0; n < 2; ++n) _Pragma("unroll") for (int k = 0; k < 2; ++k) dst[n][k] = *(const LAS bf16x8*)(lds + G8_SB(b, h) + boff + n * 2048 + k * 1024); } while (0)
#define G8_MMA(ai, bj, At, Bt) do { __builtin_amdgcn_s_setprio(1); _Pragma("unroll") for (int m = 0; m < 4; ++m) { if (!PARTIAL || ((mmask >> ((ai) * 4 + m)) & 1u)) { _Pragma("unroll") for (int n = 0; n < 2; ++n) _Pragma("unroll") for (int k = 0; k < 2; ++k) \
        acc[ai][bj][m][n] = __builtin_amdgcn_mfma_f32_16x16x32_bf16(Bt[n][k], At[m][k], acc[ai][bj][m][n], 0, 0, 0); } } __builtin_amdgcn_s_setprio(0); } while (0)
#define G8_WAIT_V(n) asm volatile("s_waitcnt vmcnt(" #n ")" ::: "memory")
#define G8_WAIT_L(n) asm volatile("s_waitcnt lgkmcnt(" #n ")" ::: "memory")
#define G8_BAR __builtin_amdgcn_s_barrier()
#define G8_SCHED __builtin_amdgcn_sched_barrier(0)
    GUnit cur, nxt; int ui = 0;
    if (!S.next(0, cur)) return;
    constexpr bool GATHER = Sched::GATHER, PARTIAL = Sched::PARTIAL;
    unsigned mmask = 0xffu;
#define G8_MASK(u) do { if (PARTIAL) { mmask = 0u; _Pragma("unroll") for (int q_ = 0; q_ < 8; ++q_) mmask |= (((q_ >> 2) * 128 + wr * 64 + (q_ & 3) * 16) < (u).rows) ? (1u << q_) : 0u; } } while (0)
    unsigned vc[2][2];
    S.aoff(cur, vc, R, C); G8_MASK(cur);
    LAS u32x4* stash = (LAS u32x4*)(lds + STAGE_BYTES + 4096) + tid;
    f32x4 acc[2][2][4][2];
#pragma unroll
    for (int a = 0; a < 2; ++a)
#pragma unroll
        for (int b = 0; b < 2; ++b)
#pragma unroll
            for (int m = 0; m < 4; ++m)
#pragma unroll
                for (int n = 0; n < 2; ++n) acc[a][b][m][n] = (f32x4){0.f, 0.f, 0.f, 0.f};
    bf16x8 At[4][2], B0[2][2], B1[2][2];
    const char* cA = cur.a; const char* cB = cur.b;
    G8_STAGE_B(G8_SB(0, 0), cB); G8_STAGE_B(G8_SB(0, 1), cB + hstepB); G8_STAGE_A(G8_SA(0, 0), cA, vc[0][0], vc[0][1]); G8_STAGE_A(G8_SA(0, 1), cA, vc[1][0], vc[1][1]);
    if (wr == 1) G8_BAR;
    G8_WAIT_V(2); G8_BAR;
    G8_STAGE_B(G8_SB(1, 0), cB + kstep); G8_STAGE_A(G8_SA(1, 0), cA + kstep, vc[0][0], vc[0][1]); G8_STAGE_B(G8_SB(1, 1), cB + hstepB + kstep);
    G8_WAIT_V(6); G8_BAR;
    for (;;) {
        const bool has_next = S.next(ui + 1, nxt);
        if (GATHER) { unsigned vn[2][2];
            if (has_next) S.aoff(nxt, vn, R, C);
            else { vn[0][0] = vc[0][0]; vn[0][1] = vc[0][1]; vn[1][0] = vc[1][0]; vn[1][1] = vc[1][1]; }
            u32x4 sv; sv.x = vn[0][0]; sv.y = vn[0][1]; sv.z = vn[1][0]; sv.w = vn[1][1]; *stash = sv; }
        const char* nA = has_next ? nxt.a : cA; const char* nB = has_next ? nxt.b : cB;
#pragma unroll 1
        for (int seg = 0; seg < (Epi::KHOOK ? 3 : 1); ++seg) {
        const int tlo = Epi::KHOOK ? 6 * seg : 0, thi = Epi::KHOOK ? (seg == 2 ? nt : 6 * seg + 6) : nt;
#pragma unroll 1
        for (int t = tlo; t < thi; t += 2) {
            const bool last = (t == nt - 2);
            const char* a1 = cA + (size_t)(t + 1) * kstep;
            const char* a2 = last ? nA : cA + (size_t)(t + 2) * kstep; const char* b2 = last ? nB : cB + (size_t)(t + 2) * kstep;
            const char* a3 = a2 + kstep; const char* b3 = b2 + kstep;
            unsigned w00 = vc[0][0], w01 = vc[0][1], w10 = vc[1][0], w11 = vc[1][1];
            if (GATHER) { if (last) { const u32x4 sv = *stash; w00 = sv.x; w01 = sv.y; w10 = sv.z; w11 = sv.w; } }
            G8_LDB(B0, 0, 0); G8_LDB(B1, 0, 1); G8_SCHED; G8_LDA(At, 0, 0); G8_STAGE_A(G8_SA(1, 1), a1, vc[1][0], vc[1][1]);
            G8_WAIT_V(8); G8_WAIT_L(0); G8_BAR; G8_MMA(0, 0, At, B0); G8_MMA(0, 1, At, B1); G8_BAR; G8_SCHED;
            G8_LDA(At, 0, 1); G8_STAGE_B(G8_SB(0, 0), b2); G8_STAGE_B(G8_SB(0, 1), b2 + hstepB); G8_STAGE_A(G8_SA(0, 0), a2, w00, w01);
            G8_WAIT_V(8); G8_WAIT_L(0); G8_BAR; G8_MMA(1, 0, At, B0); G8_MMA(1, 1, At, B1); G8_BAR; G8_SCHED;
            G8_LDB(B0, 1, 0); G8_LDB(B1, 1, 1); G8_SCHED; G8_LDA(At, 1, 0); G8_STAGE_A(G8_SA(0, 1), a2, w10, w11);
            G8_WAIT_V(8); G8_WAIT_L(0); G8_BAR; G8_MMA(0, 0, At, B0); G8_MMA(0, 1, At, B1); G8_BAR; G8_SCHED;
            G8_LDA(At, 1, 1); G8_STAGE_B(G8_SB(1, 0), b3); G8_STAGE_B(G8_SB(1, 1), b3 + hstepB); G8_STAGE_A(G8_SA(1, 0), a3, w00, w01);
            G8_WAIT_V(8); G8_WAIT_L(0); G8_BAR; G8_MMA(1, 0, At, B0); G8_MMA(1, 1, At, B1); G8_BAR; G8_SCHED;
        }
        if constexpr (Epi::KHOOK) { if (seg < 2) E.kscale(acc, seg, wr, fr); }
        }
        if (wr == 0) G8_BAR;
        { int fr_ = fr, fq_ = fq; asm volatile("" : "+v"(fr_), "+v"(fq_));
          E(acc, cur, wr, wc, fr_, fq_); }
        if (!has_next) break;
#pragma unroll
        for (int a = 0; a < 2; ++a)
#pragma unroll
            for (int b = 0; b < 2; ++b)
#pragma unroll
                for (int m = 0; m < 4; ++m)
#pragma unroll
                    for (int n = 0; n < 2; ++n) acc[a][b][m][n] = (f32x4){0.f, 0.f, 0.f, 0.f};
        cur = nxt; cA = nA; cB = nB; ++ui; G8_MASK(cur);
        if (GATHER) { const u32x4 sv = *stash; vc[0][0] = sv.x; vc[0][1] = sv.y; vc[1][0] = sv.z; vc[1][1] = sv.w; }
        if (wr == 1) G8_BAR;
    }
    G8_WAIT_V(0);
    G8_BAR;
#undef G8_SA
#undef G8_SB
#undef G8_GLDS
#undef G8_STAGE_A
#undef G8_STAGE_B
#undef G8_LDA
#undef G8_LDB
#undef G8_MMA
#undef G8_MASK
#undef G8_WAIT_V
#undef G8_WAIT_L
#undef G8_BAR
#undef G8_SCHED
}
}
using g8::GUnit;
__device__ __forceinline__ void st_bf16x8(bf16_t* p, const float (&v)[8]) { u32x4 w; w.x = pk_bf16(v[0], v[1]); w.y = pk_bf16(v[2], v[3]); w.z = pk_bf16(v[4], v[5]); w.w = pk_bf16(v[6], v[7]); *(u32x4*)p = w; }
__device__ __forceinline__ float quad_sum(float s) { s += shx<16>(s); s += __shfl_xor(s, 32); return s; }

struct EpiInProj {
    static constexpr bool KHOOK = false;
    const float* ssqx; float* part_dq; float* part_dkv; const float* qg; const float* kg; const float* krg; const float* rope;
    unsigned char* prj;
    __device__ __forceinline__ void operator()(const f32x4 (&acc)[2][2][4][2], const GUnit& u, int wr, int wc, int fr, int fq) const {
        const int G = u.pn * 4 + wc;
        const bool isq = G < 6; const int a = G - 6; const bool isk = (G >= 10 && G < 18 && ((a >> 1) & 1) == 0);
        const float* g0 = (isq ? qg : kg) + 8 * fq;
        float rs8[8];
#pragma unroll
        for (int k = 0; k < 8; ++k) rs8[k] = ssqx[u.pm * 256 + (k >> 2) * 128 + wr * 64 + (k & 3) * 16 + fr];
#pragma unroll
        for (int k = 0; k < 8; ++k) rs8[k] = rsqrtf(rs8[k] * (1.f / 1024.f) + 1e-6f);
#pragma unroll
        for (int ai = 0; ai < 2; ++ai)
#pragma unroll
            for (int m = 0; m < 4; ++m) {
                __builtin_amdgcn_sched_barrier(0);
                const int row = u.pm * 256 + ai * 128 + wr * 64 + m * 16 + fr; const int b = row >> 11, t = row & 2047;
                const float rs = rs8[ai * 4 + m];
                float v[2][8];
#pragma unroll
                for (int bj = 0; bj < 2; ++bj)
#pragma unroll
                    for (int n = 0; n < 2; ++n)
#pragma unroll
                        for (int j = 0; j < 4; ++j) v[bj][4 * n + j] = acc[ai][bj][m][n][j] * rs;
                float ss = 0.f;
#pragma unroll
                for (int bj = 0; bj < 2; ++bj)
#pragma unroll
                    for (int i = 0; i < 8; ++i) ss += v[bj][i] * v[bj][i];
                bf16_t* dst = nullptr; int bstride = 32;
                if (isq) {
                    ss = quad_sum(ss); const float sc = rsqrtf(ss * (1.f / 64.f) + 1e-6f) * 0.18033688f;
#pragma unroll
                    for (int i = 0; i < 8; ++i) { v[0][i] *= sc * g0[i]; v[1][i] *= sc * g0[32 + i]; }
                    dst = (bf16_t*)(prj + PRJ_QN) + ((size_t)(b * 6 + G) * 2048 + t) * 64;
                } else if (G < 18) {
                    const int br = a >> 2, s = (a >> 1) & 1, hk = a & 1;
                    if (br > 0 && s == 0) {
                        ss = quad_sum(ss); const float sc = rsqrtf(ss * (1.f / 64.f) + 1e-6f);
#pragma unroll
                        for (int i = 0; i < 8; ++i) { v[0][i] *= sc * g0[i]; v[1][i] *= sc * g0[32 + i]; }
                    }
                    const size_t base = br == 0 ? (s ? PRJ_C0V : PRJ_C0K) : (br == 1 ? (s ? PRJ_VN1 : PRJ_KN1) : (s ? PRJ_VN2 : PRJ_KN2));
                    dst = (bf16_t*)(prj + base) + ((size_t)(b * 2 + hk) * 2048 + t) * 64;
                } else if (G < 26) { dst = (bf16_t*)(prj + PRJ_RAWQK) + (size_t)row * 512 + (G - 18) * 64; }
                else if (G < 30) { dst = (bf16_t*)(prj + PRJ_VML) + ((size_t)(b * 4 + (G - 26)) * 2048 + t) * 64; }
                else if (G < 34) { dst = (bf16_t*)(prj + PRJ_OG) + (size_t)row * 256 + (G - 30) * 64; }
                else if (G < 37) { dst = (bf16_t*)(prj + PRJ_DQKV) + (size_t)row * 384 + (G - 34) * 64; ss = quad_sum(ss); if (fq == 0) part_dq[(size_t)row * 4 + (G - 34)] = ss; }
                else if (G == 37) {
                    dst = (bf16_t*)(prj + PRJ_DQKV) + (size_t)row * 384 + 192;
                    float* gt = (float*)(prj + PRJ_GATES) + (size_t)row * 32 + 8 * fq;
                    *(f32x4*)gt = (f32x4){v[1][0], v[1][1], v[1][2], v[1][3]}; *(f32x4*)(gt + 4) = (f32x4){v[1][4], v[1][5], v[1][6], v[1][7]};
                    float s0 = 0.f;
#pragma unroll
                    for (int i = 0; i < 8; ++i) s0 += v[0][i] * v[0][i];
                    s0 = quad_sum(s0); const float sc = rsqrtf(s0 * (1.f / 32.f) + 1e-6f);
                    const float* rp = rope + (size_t)row * 32 + ((8 * fq) & 15);
                    float kr[8];
#pragma unroll
                    for (int i = 0; i < 8; ++i) { const float val = v[0][i] * sc * krg[8 * fq + i]; const float oth = __shfl_xor(val, 32); const float cs = rp[i], sn = rp[16 + i]; kr[i] = fq < 2 ? val * cs - oth * sn : val * cs + oth * sn; }
                    st_bf16x8((bf16_t*)(prj + PRJ_KR) + (size_t)row * 32 + 8 * fq, kr);
                } else { dst = (bf16_t*)(prj + PRJ_DQKV) + (size_t)row * 384 + 256 + (G - 38) * 64; ss = quad_sum(ss); if (fq == 0) part_dkv[(size_t)row * 2 + (G - 38)] = ss; }
                st_bf16x8(dst + 8 * fq, v[0]); st_bf16x8(dst + bstride + 8 * fq, v[1]);
            }
    }
};

struct EpiUq {
    static constexpr bool KHOOK = false;
    const float* ssq_dq; const float* qkn; const float* rope; bf16_t* QM;
    __device__ __forceinline__ void operator()(const f32x4 (&acc)[2][2][4][2], const GUnit& u, int wr, int wc, int fr, int fq) const {
        const int G = u.pn * 4 + wc; if (G >= 9) return;
        const float scale = 0.14724444f;
        const float* g0 = G < 6 ? qkn + 8 * fq : qkn + 64 + 8 * (fq & 1); const float* g1 = G < 6 ? g0 + 32 : g0 + 16;
        float rs8[8];
#pragma unroll
        for (int k = 0; k < 8; ++k) { const f32x4 pq = *(const f32x4*)(ssq_dq + (size_t)(u.pm * 256 + (k >> 2) * 128 + wr * 64 + (k & 3) * 16 + fr) * 4); rs8[k] = (pq.x + pq.y) + pq.z; }
#pragma unroll
        for (int k = 0; k < 8; ++k) rs8[k] = rsqrtf(rs8[k] * (1.f / 192.f) + 1e-6f);
#pragma unroll
        for (int ai = 0; ai < 2; ++ai) {
#pragma unroll
            for (int m = 0; m < 4; ++m) {
                __builtin_amdgcn_sched_barrier(0);
                const int row = u.pm * 256 + ai * 128 + wr * 64 + m * 16 + fr; const int b = row >> 11, t = row & 2047;
                const float rs = rs8[ai * 4 + m];
                float v[2][8]; float ss = 0.f;
#pragma unroll
                for (int bj = 0; bj < 2; ++bj)
#pragma unroll
                    for (int n = 0; n < 2; ++n)
#pragma unroll
                        for (int j = 0; j < 4; ++j) { const float x = acc[ai][bj][m][n][j] * rs; v[bj][4 * n + j] = x; ss += x * x; }
                if (G < 6) ss = quad_sum(ss); else ss += shx<16>(ss);
                const float sc = rsqrtf(ss * (G < 6 ? 1.f / 64.f : 1.f / 32.f) + 1e-6f) * scale;
#pragma unroll
                for (int i = 0; i < 8; ++i) { v[0][i] *= sc * g0[i]; v[1][i] *= sc * g1[i]; }
                if (G < 6) {
                    bf16_t* dst = QM + ((size_t)(b * 6 + G) * 2048 + t) * 96;
                    st_bf16x8(dst + 8 * fq, v[0]); st_bf16x8(dst + 32 + 8 * fq, v[1]);
                } else {
                    const int i16 = 8 * (fq & 1); const int head = 2 * (G - 6) + (fq >> 1);
                    const float* rp = rope + (size_t)row * 32 + i16; float o1[8], o2[8];
#pragma unroll
                    for (int i = 0; i < 8; ++i) { const float cs = rp[i], sn = rp[16 + i]; o1[i] = v[0][i] * cs - v[1][i] * sn; o2[i] = v[1][i] * cs + v[0][i] * sn; }
                    bf16_t* dst = QM + ((size_t)(b * 6 + head) * 2048 + t) * 96 + 64 + i16;
                    st_bf16x8(dst, o1); st_bf16x8(dst + 16, o2);
                }
            }
        }
    }
};
struct EpiUkv {
    static constexpr bool KHOOK = false;
    const float* ssq_dkv; const float* qkn; const bf16_t* KR; bf16_t* KM; bf16_t* VM;
    __device__ __forceinline__ void operator()(const f32x4 (&acc)[2][2][4][2], const GUnit& u, int wr, int wc, int fr, int fq) const {
        const int G = u.pn * 4 + wc;
        const float* g0 = qkn + 96 + 8 * fq;
        float rs8[8];
#pragma unroll
        for (int k = 0; k < 8; ++k) { const size_t rr = (size_t)(u.pm * 256 + (k >> 2) * 128 + wr * 64 + (k & 3) * 16 + fr); rs8[k] = ssq_dkv[rr * 2] + ssq_dkv[rr * 2 + 1]; }
#pragma unroll
        for (int k = 0; k < 8; ++k) rs8[k] = rsqrtf(rs8[k] * (1.f / 128.f) + 1e-6f);
#pragma unroll
        for (int ai = 0; ai < 2; ++ai) {
          u32x4 kr4[4];
          if (G < 6) {
#pragma unroll
              for (int m = 0; m < 4; ++m) kr4[m] = *(const u32x4*)(KR + (size_t)(u.pm * 256 + ai * 128 + wr * 64 + m * 16 + fr) * 32 + 8 * fq);
          }
#pragma unroll
            for (int m = 0; m < 4; ++m) {
                __builtin_amdgcn_sched_barrier(0);
                const int row = u.pm * 256 + ai * 128 + wr * 64 + m * 16 + fr; const int b = row >> 11, t = row & 2047;
                const float rs = rs8[ai * 4 + m];
                float v[2][8]; float ss = 0.f;
#pragma unroll
                for (int bj = 0; bj < 2; ++bj)
#pragma unroll
                    for (int n = 0; n < 2; ++n)
#pragma unroll
                        for (int j = 0; j < 4; ++j) { const float x = acc[ai][bj][m][n][j] * rs; v[bj][4 * n + j] = x; ss += x * x; }
                if (G < 6) {
                    ss = quad_sum(ss); const float sc = rsqrtf(ss * (1.f / 64.f) + 1e-6f);
#pragma unroll
                    for (int i = 0; i < 8; ++i) { v[0][i] *= sc * g0[i]; v[1][i] *= sc * g0[32 + i]; }
                    bf16_t* dst = KM + ((size_t)(b * 6 + G) * 2048 + t) * 96;
                    st_bf16x8(dst + 8 * fq, v[0]); st_bf16x8(dst + 32 + 8 * fq, v[1]);
                    *(u32x4*)(dst + 64 + 8 * fq) = kr4[m];
                } else {
                    bf16_t* dst = VM + ((size_t)(b * 6 + (G - 6)) * 2048 + t) * 64;
                    st_bf16x8(dst + 8 * fq, v[0]); st_bf16x8(dst + 32 + 8 * fq, v[1]);
                }
            }
        }
    }
};
#define MFMA16(a, b, c) __builtin_amdgcn_mfma_f32_16x16x32_bf16(a, b, c, 0, 0, 0)
#define MFMA32(a, b, c) __builtin_amdgcn_mfma_f32_32x32x16_bf16(a, b, c, 0, 0, 0)
#define LDS_FENCE() asm volatile("s_waitcnt lgkmcnt(0)" ::: "memory")

__device__ __forceinline__ void cmp_unit(int u, int l, InPtr in, unsigned char* ws, LAS unsigned char* lds, int g_wv) {
    int tid_ = TIDX; asm volatile("" : "+v"(tid_));
    const int tid = tid_, w = tid >> 6, lane = tid & 63, r = lane & 15, q = lane >> 4;
    const int b = u >> 2, s = (u >> 1) & 1, hk = u & 1;
    const bf16_t* A = (const bf16_t*)(ws + WS_PRJ + (s ? PRJ_C0V : PRJ_C0K)) + (size_t)(b * 2 + hk) * 2048 * 64;
    const bf16_t* W1 = (const bf16_t*)(ws + WS_WC1) + ((size_t)l * 2 + s) * 64 * 2048;
    const bf16_t* W2 = (const bf16_t*)(ws + WS_WC2) + ((size_t)l * 2 + s) * 64 * 64;
    const float* b1 = (const float*)(ws + WS_B1C) + (l * 2 + s) * 64;
    f32x4 acc[4];
#pragma unroll
    for (int nb = 0; nb < 4; ++nb) acc[nb] = (f32x4){0.f, 0.f, 0.f, 0.f};
    const bf16_t* ap = A + (size_t)(16 * w + r) * 1024 + 8 * q;
    constexpr int WP = 528, WBUF = 64 * WP; LAS unsigned char* wb = lds + 24576;
    u32x4 st[4];
#pragma unroll
    for (int i = 0; i < 4; ++i) { const int c = tid + 512 * i; st[i] = *(const u32x4*)(W1 + (size_t)(c >> 5) * 2048 + (c & 31) * 8); }
    bf16x8 af[8], afn[8];
#pragma unroll
    for (int ks = 0; ks < 8; ++ks) af[ks] = *(const bf16x8*)(ap + 32 * ks);
    const float* kg = in->p[9] + l * 64;
    float b1v[4], kgv[4]; bf16x8 w2f[2][4];
#pragma unroll
    for (int nb = 0; nb < 4; ++nb) { b1v[nb] = b1[16 * nb + r]; kgv[nb] = kg[16 * nb + r]; }
#pragma unroll
    for (int ks = 0; ks < 2; ++ks)
#pragma unroll
        for (int nb = 0; nb < 4; ++nb) w2f[ks][nb] = *(const bf16x8*)(W2 + (size_t)(16 * nb + r) * 64 + 32 * ks + 8 * q);
#pragma unroll
    for (int i = 0; i < 4; ++i) { const int c = tid + 512 * i; *(LAS u32x4*)(wb + (c >> 5) * WP + (c & 31) * 16) = st[i]; }
    __syncthreads();
    auto chunk = [&](const int kc, bf16x8 (&ac)[8], bf16x8 (&an)[8]) __attribute__((always_inline)) {
        const int cur = kc & 1;
        if (kc < 7) {
#pragma unroll
            for (int i = 0; i < 4; ++i) { const int c = tid + 512 * i; st[i] = *(const u32x4*)(W1 + (size_t)(c >> 5) * 2048 + (kc + 1) * 256 + (c & 31) * 8); }
#pragma unroll
            for (int ks = 0; ks < 8; ++ks) an[ks] = *(const bf16x8*)(ap + 256 * (kc + 1) + 32 * ks);
        }
#pragma unroll
        for (int ks = 0; ks < 8; ++ks)
#pragma unroll
            for (int nb = 0; nb < 4; ++nb) { const bf16x8 bb = *(const LAS bf16x8*)(wb + cur * WBUF + (16 * nb + r) * WP + (32 * ks + 8 * q) * 2); acc[nb] = MFMA16(ac[ks], bb, acc[nb]); }
        if (kc < 7) {
#pragma unroll
            for (int i = 0; i < 4; ++i) { const int c = tid + 512 * i; *(LAS u32x4*)(wb + (cur ^ 1) * WBUF + (c >> 5) * WP + (c & 31) * 16) = st[i]; }
        }
        __syncthreads();
    };
#pragma unroll 1
    for (int kc = 0; kc < 8; kc += 2) { chunk(kc, af, afn); chunk(kc + 1, afn, af); }
    LAS bf16_t* hl = (LAS bf16_t*)(lds + w * 2304);
#pragma unroll
    for (int nb = 0; nb < 4; ++nb) { const float bias = b1v[nb];
#pragma unroll
        for (int j = 0; j < 4; ++j) hl[(4 * q + j) * 72 + 16 * nb + r] = f2bf(siluf(acc[nb][j] + bias)); }
    LDS_FENCE();
    f32x4 o[4];
#pragma unroll
    for (int nb = 0; nb < 4; ++nb) o[nb] = (f32x4){0.f, 0.f, 0.f, 0.f};
#pragma unroll
    for (int ks = 0; ks < 2; ++ks) {
        const bf16x8 a = *(const LAS bf16x8*)(hl + r * 72 + 32 * ks + 8 * q);
#pragma unroll
        for (int nb = 0; nb < 4; ++nb) o[nb] = MFMA16(a, w2f[ks][nb], o[nb]);
    }
    LDS_FENCE();
    bf16_t* dst = (bf16_t*)(ws + WS_CMP + (s ? CMP_V : 0)) + (size_t)(b * 2 + hk) * 128 * 64;
#pragma unroll
    for (int j = 0; j < 4; ++j) {
        const int n = 16 * w + 4 * q + j; float ss = 0.f;
#pragma unroll
        for (int nb = 0; nb < 4; ++nb) ss += o[nb][j] * o[nb][j];
        ss += shx<1>(ss); ss += shx<2>(ss); ss += shx<4>(ss); ss += shx<8>(ss);
        const float sc = s == 0 ? rsqrtf(ss * (1.f / 64.f) + 1e-6f) : 1.f;
#pragma unroll
        for (int nb = 0; nb < 4; ++nb) { const int d = 16 * nb + r; const float v = o[nb][j] * sc * (s == 0 ? kgv[nb] : 1.f); dst[(size_t)n * 64 + d] = n < 127 ? f2bf(v) : (bf16_t)0; }
    }
}

__device__ __forceinline__ int swz_off(int row, int chunk) { return row * 128 + ((chunk ^ (row & 7)) << 4); }
__device__ __forceinline__ float log_sigmoid(float x) { return fminf(x, 0.f) - log1pf(__expf(-fabsf(x))); }
__device__ __forceinline__ void ml_delta_wave(int cu, int l, InPtr in, unsigned char* ws, LAS unsigned char* wl, int lane) {
    asm volatile("" : "+v"(lane));
    const int c = cu & 31, bh = cu >> 5, h = bh & 3, b = bh >> 2; const int t0 = c * 64; const size_t row0 = (size_t)b * 2048 + t0;
    const int cc = lane & 7, tg = lane >> 3;
    const bf16_t* raw = (const bf16_t*)(ws + WS_PRJ + PRJ_RAWQK); const float* cw = in->p[11] + (size_t)l * 4 * 512 + h * 64 + 8 * cc;
    u32x4 rq[11];
    const bool head0 = (c == 0 && tg == 0);
#pragma unroll
    for (int i = 0; i < 11; ++i) { const size_t rr = (head0 && i < 3) ? row0 : row0 + 8 * tg - 3 + i; rq[i] = *(const u32x4*)(raw + rr * 512 + h * 64 + 8 * cc); }
    __builtin_amdgcn_sched_barrier(0);
    const float* G = (const float*)(ws + WS_PRJ + PRJ_GATES);
    const float ip = G[(row0 + lane) * 32 + 18 + h] + in->p[12][l * 4 + h], fp = G[(row0 + lane) * 32 + 22 + h] + in->p[13][l * 4 + h];
    float bcum = log_sigmoid(fp);
#pragma unroll
    for (int o = 1; o < 64; o <<= 1) { const float t = __builtin_bit_cast(float, __builtin_amdgcn_ds_bpermute(((lane - o) & 63) << 2, __builtin_bit_cast(int, bcum))); if (lane >= o) bcum += t; }
    const float bL = __builtin_bit_cast(float, __builtin_amdgcn_readlane(__builtin_bit_cast(int, bcum), 63)); const float wgt = __expf(bL - bcum + ip);
    { float* mlg = (float*)(ws + WS_ML + ML_G) + ((size_t)bh * 2048 + t0 + lane) * 2; mlg[0] = bcum; mlg[1] = ip; if (lane == 0) ((float*)(ws + WS_ML + ML_BL))[cu] = bL; }
    float wt[8];
#pragma unroll
    for (int j = 0; j < 8; ++j) wt[j] = __builtin_bit_cast(float, __builtin_amdgcn_ds_bpermute((8 * tg + j) << 2, __builtin_bit_cast(int, wgt)));
    if (head0) {
#pragma unroll
        for (int i = 0; i < 3; ++i) rq[i] = (u32x4){0u, 0u, 0u, 0u}; }
#define MLD_E(v, e) (((e) & 1) ? bf_hi(((e) >> 1) == 0 ? (v).x : ((e) >> 1) == 1 ? (v).y : ((e) >> 1) == 2 ? (v).z : (v).w) : bf_lo(((e) >> 1) == 0 ? (v).x : ((e) >> 1) == 1 ? (v).y : ((e) >> 1) == 2 ? (v).z : (v).w))
    bf16_t* QC = (bf16_t*)(ws + WS_ML) + ((size_t)bh * 2048 + t0 + 8 * tg) * 64 + 8 * cc; bf16_t* KC = (bf16_t*)(ws + WS_ML + ML_KC) + ((size_t)bh * 2048 + t0 + 8 * tg) * 64 + 8 * cc;
    u32x4 rk[11], vv[8];
#pragma unroll
    for (int i = 0; i < 11; ++i) { const size_t rr = (head0 && i < 3) ? row0 : row0 + 8 * tg - 3 + i; rk[i] = *(const u32x4*)(raw + rr * 512 + h * 64 + 8 * cc + 256); }
    { const bf16_t* V = (const bf16_t*)(ws + WS_PRJ + PRJ_VML) + ((size_t)bh * 2048 + t0 + 8 * tg) * 64 + 8 * cc;
#pragma unroll
      for (int j = 0; j < 8; ++j) vv[j] = *(const u32x4*)(V + (size_t)j * 64); }
    if (head0) {
#pragma unroll
        for (int i = 0; i < 3; ++i) rk[i] = (u32x4){0u, 0u, 0u, 0u}; }
    __builtin_amdgcn_sched_barrier(0);
    {
        float w4[4][8];
#pragma unroll
        for (int tp = 0; tp < 4; ++tp) { const f32x4 a = *(const f32x4*)(cw + tp * 512), b4 = *(const f32x4*)(cw + tp * 512 + 4); w4[tp][0] = a.x; w4[tp][1] = a.y; w4[tp][2] = a.z; w4[tp][3] = a.w; w4[tp][4] = b4.x; w4[tp][5] = b4.y; w4[tp][6] = b4.z; w4[tp][7] = b4.w; }
#pragma unroll
        for (int j = 0; j < 8; ++j) { float o[8];
#pragma unroll
            for (int e = 0; e < 8; ++e) o[e] = siluf(w4[0][e] * MLD_E(rq[j], e) + w4[1][e] * MLD_E(rq[j + 1], e) + w4[2][e] * MLD_E(rq[j + 2], e) + w4[3][e] * MLD_E(rq[j + 3], e));
            u32x4 pk; pk.x = pk_bf16(o[0], o[1]); pk.y = pk_bf16(o[2], o[3]); pk.z = pk_bf16(o[4], o[5]); pk.w = pk_bf16(o[6], o[7]);
            *(u32x4*)(QC + (size_t)j * 64) = pk; }
    }
    float dn[8];
    {
        float w4[4][8];
#pragma unroll
        for (int tp = 0; tp < 4; ++tp) { const f32x4 a = *(const f32x4*)(cw + 256 + tp * 512), b4 = *(const f32x4*)(cw + 256 + tp * 512 + 4); w4[tp][0] = a.x; w4[tp][1] = a.y; w4[tp][2] = a.z; w4[tp][3] = a.w; w4[tp][4] = b4.x; w4[tp][5] = b4.y; w4[tp][6] = b4.z; w4[tp][7] = b4.w; }
#pragma unroll
        for (int e = 0; e < 8; ++e) dn[e] = 0.f;
#pragma unroll
        for (int j2 = 0; j2 < 4; ++j2) { float kb[2][8];
#pragma unroll
            for (int jj = 0; jj < 2; ++jj) { const int j = 2 * j2 + jj; float o[8];
#pragma unroll
                for (int e = 0; e < 8; ++e) o[e] = siluf(w4[0][e] * MLD_E(rk[j], e) + w4[1][e] * MLD_E(rk[j + 1], e) + w4[2][e] * MLD_E(rk[j + 2], e) + w4[3][e] * MLD_E(rk[j + 3], e)) * 0.125f;
                u32x4 pk; pk.x = pk_bf16(o[0], o[1]); pk.y = pk_bf16(o[2], o[3]); pk.z = pk_bf16(o[4], o[5]); pk.w = pk_bf16(o[6], o[7]);
                *(u32x4*)(KC + (size_t)j * 64) = pk;
#pragma unroll
                for (int e = 0; e < 8; ++e) { kb[jj][e] = MLD_E(pk, e); dn[e] += wt[j] * kb[jj][e]; } }
#pragma unroll
            for (int e = 0; e < 8; ++e) { *(LAS unsigned*)(wl + swz_off(8 * cc + e, tg) + 4 * j2) = pk_bf16(kb[0][e], kb[1][e]);
                *(LAS unsigned*)(wl + 8192 + swz_off(8 * cc + e, tg) + 4 * j2) = pk_bf16(wt[2 * j2] * MLD_E(vv[2 * j2], e), wt[2 * j2 + 1] * MLD_E(vv[2 * j2 + 1], e)); } }
    }
#undef MLD_E
#pragma unroll
    for (int e = 0; e < 8; ++e) { dn[e] += shx<8>(dn[e]); dn[e] += shx<16>(dn[e]); dn[e] += __shfl_xor(dn[e], 32); }
    if (tg == 0) { float* DN = (float*)(ws + WS_ML + ML_DN) + (size_t)cu * 64 + 8 * cc; *(f32x4*)DN = (f32x4){dn[0], dn[1], dn[2], dn[3]}; *(f32x4*)(DN + 4) = (f32x4){dn[4], dn[5], dn[6], dn[7]}; }
    LDS_FENCE();
    const int r = lane & 15, q = lane >> 4;
    bf16_t* DL = (bf16_t*)(ws + WS_ML + ML_DELTA) + (size_t)cu * 4096;
    f32x4 acc[4][4];
#pragma unroll
    for (int mb = 0; mb < 4; ++mb) {
#pragma unroll
        for (int nb = 0; nb < 4; ++nb) acc[mb][nb] = (f32x4){0.f, 0.f, 0.f, 0.f};
#pragma unroll
        for (int ks = 0; ks < 2; ++ks) {
            const bf16x8 a = *(const LAS bf16x8*)(wl + 8192 + swz_off(16 * mb + r, 4 * ks + q));
#pragma unroll
            for (int nb = 0; nb < 4; ++nb) { const bf16x8 bb = *(const LAS bf16x8*)(wl + swz_off(16 * nb + r, 4 * ks + q)); acc[mb][nb] = MFMA16(a, bb, acc[mb][nb]); }
        }
    }
    LDS_FENCE();
#pragma unroll
    for (int mb = 0; mb < 4; ++mb)
#pragma unroll
        for (int nb = 0; nb < 4; ++nb)
#pragma unroll
            for (int j = 0; j < 4; ++j) { const int row = 16 * mb + 4 * q + j, col = 16 * nb + r; *(LAS bf16_t*)(wl + swz_off(row, col >> 3) + (col & 7) * 2) = f2bf(acc[mb][nb][j]); }
    LDS_FENCE();
#pragma unroll
    for (int i = 0; i < 8; ++i) { const int ch = lane + 64 * i; *(u32x4*)(DL + (size_t)ch * 8) = *(const LAS u32x4*)(wl + swz_off(ch >> 3, ch & 7)); }
    LDS_FENCE();
}

#ifndef TIME_PH
#define TIME_PH -1
#endif
#define PSTAMP(i, blk) do { if (TIME_PH != -1 && l == 0 && blockIdx.x == (blk) && TIDX == 0) ((unsigned long long*)((unsigned*)(ws + WS_CTL) + CW_TS))[i] = __builtin_amdgcn_s_memrealtime(); } while (0)
#ifndef DUP_DELTA
#define DUP_DELTA 1
#endif
__device__ __forceinline__ void phase_prep(int l, InPtr in, unsigned char* ws, LAS unsigned char* lds, int bid, int nb, int g_wv, unsigned* dq) {
    asm volatile("" : "+s"(bid));
    PSTAMP(40, 0);
#ifndef NO_UQ
    { g8::DenseSched S{(const char*)(ws + WS_PRJ + PRJ_DQKV), (const char*)(ws + WS_WUQ) + (size_t)l * 768 * 256 * 2, 384, 256, 64, 3, nb, bid};
      EpiUq E{(const float*)(ws + WS_SSQ + PT_DQ) + (size_t)l * 16384 * 4, in->p[19] + l * 192, (const float*)(ws + WS_ROPE), (bf16_t*)(ws + WS_MLA)};
      g8::gemm_run(lds, 256, 256, S, E, g_wv); }
#endif
    PSTAMP(41, 0);
#ifndef NO_UKV
    asm volatile("" : "+s"(bid));
    { g8::DenseSched S{(const char*)(ws + WS_PRJ + PRJ_DQKV) + 256, (const char*)(ws + WS_WUKV) + (size_t)l * 768 * 256 * 2, 384, 256, 64, 3, nb, nb == 256 ? ((bid + 64) & 255) : bid};
      EpiUkv E{(const float*)(ws + WS_SSQ + PT_DKV) + (size_t)l * 16384 * 2, in->p[19] + l * 192, (const bf16_t*)(ws + WS_PRJ + PRJ_KR), (bf16_t*)(ws + WS_MLA + MLA_KM), (bf16_t*)(ws + WS_MLA + MLA_VM)};
      g8::gemm_run(lds, 256, 256, S, E, g_wv); }
#endif
    PSTAMP(42, 0); PSTAMP(44, 255);
    __syncthreads();
#ifndef NO_CMP
#ifndef DUP_CMP
#define DUP_CMP 1
#endif
    for (int u = (nb == 256 ? (bid >= 128 && bid < 160 ? bid - 128 : 32) : nb - 1 - bid); u < 32; u += nb) for (int rp_ = 0; rp_ < DUP_CMP; ++rp_) { if (rp_) __syncthreads(); cmp_unit(u, l, in, ws, lds, g_wv); }
#endif
    PSTAMP(45, 255);
    __syncthreads();
#ifndef NO_DELTA
    { int tid_ = TIDX; asm volatile("" : "+v"(tid_)); LAS int* slot = (LAS int*)(lds + LDS_MISC + 64);
      for (;;) {
          __syncthreads();
          if (tid_ == 0) *slot = (int)__hip_atomic_fetch_add(dq, 1u, __ATOMIC_RELAXED, __HIP_MEMORY_SCOPE_AGENT);
          __syncthreads();
          const int g = *slot; if (g >= 96 + 128) break;
          const int wv = tid_ >> 6;
          const int cu_ = g < 96 ? g * 8 + wv : 768 + (g - 96) * 2 + wv;
          if (g < 96 || wv < 2) { for (int rp_ = 0; rp_ < DUP_DELTA; ++rp_) ml_delta_wave(cu_, l, in, ws, lds + wv * 16384, tid_ & 63); }
      } }
#endif
    __syncthreads(); PSTAMP(43, 0);
}
#define CHK_TOL(st) (((st) & 15) == 8 ? 1e-2f : 1e-3f)
#define CHECK_REST
constexpr int VTP = 192;
typedef short v4i16_t __attribute__((ext_vector_type(4)));
__device__ __forceinline__ int vt_lane_off(int lane) { return (4 * (lane >> 5) + ((lane & 15) >> 2)) * VTP + ((((lane >> 4) & 1) * 16) + 4 * (lane & 3)) * 2; }
__device__ __forceinline__ bf16x8 vt_frag(const LAS unsigned char* Vt, int voff, int s4, int eb) {
    const LAS unsigned char* a = Vt + voff + 16 * s4 * VTP + 64 * eb;
    const v4i16_t lo = __builtin_amdgcn_ds_read_tr16_b64_v4i16((LAS v4i16_t*)a), hi = __builtin_amdgcn_ds_read_tr16_b64_v4i16((LAS v4i16_t*)(a + 8 * VTP));
    return (bf16x8){lo[0], lo[1], lo[2], lo[3], hi[0], hi[1], hi[2], hi[3]};
}
__device__ __forceinline__ int crow(int reg, int h) { return (reg & 3) + 8 * (reg >> 2) + 4 * h; }
struct AttnState { f32x16 o[2]; float m, l; };
__device__ __forceinline__ void attn_reset(AttnState& A) { A.m = -1e30f; A.l = 0.f;
#pragma unroll
    for (int i = 0; i < 16; ++i) { A.o[0][i] = 0.f; A.o[1][i] = 0.f; } }

template <int DK>
__device__ __forceinline__ void attn_scores(f32x16 (&s)[2], const bf16x8 (&qf)[DK / 16], const LAS unsigned char* Kt, int r, int h) {
    constexpr int KP = 2 * DK + 16, NK = DK / 16;
    bf16x8 kf[2][NK];
#pragma unroll
    for (int kb = 0; kb < 2; ++kb)
#pragma unroll
        for (int ks = 0; ks < NK; ++ks) kf[kb][ks] = *(const LAS bf16x8*)(Kt + (32 * kb + r) * KP + (16 * ks + 8 * h) * 2);
    __builtin_amdgcn_sched_barrier(0);
#pragma unroll
    for (int kb = 0; kb < 2; ++kb)
#pragma unroll
        for (int i = 0; i < 16; ++i) s[kb][i] = 0.f;
#pragma unroll
    for (int ks = 0; ks < NK; ++ks) {
        s[0] = MFMA32(kf[0][ks], qf[ks], s[0]);
        s[1] = MFMA32(kf[1][ks], qf[ks], s[1]);
    }
}
__device__ __forceinline__ float max3f(float a, float b, float c) { return fmaxf(fmaxf(a, b), c); }
__device__ __forceinline__ void attn_softmax_pv(AttnState& A, f32x16 (&s)[2], const LAS unsigned char* Vt, int r, int h, float bias_c = 0.f, bool lane_ok = true) {
    constexpr float THR = 8.f; const int voff = vt_lane_off(r + 32 * h);
    float mx = max3f(s[0][0], s[0][1], s[0][2]);
#pragma unroll
    for (int i = 3; i < 15; i += 2) mx = max3f(mx, s[0][i], s[0][i + 1]);
    mx = max3f(mx, s[0][15], s[1][0]);
#pragma unroll
    for (int i = 1; i < 15; i += 2) mx = max3f(mx, s[1][i], s[1][i + 1]);
    mx = fmaxf(mx, s[1][15]);
    mx = fmaxf(mx, __shfl_xor(mx, 32));
    const float mxb = (lane_ok && mx > -1e29f) ? mx + bias_c : -1e30f;
    const bool grow = mxb > A.m + THR;
    const float mnew = grow ? mxb : A.m;
    if (__any(grow)) {
        const float alpha = __builtin_amdgcn_exp2f(A.m - mnew);
        A.l *= alpha;
#pragma unroll
        for (int i = 0; i < 16; ++i) { A.o[0][i] *= alpha; A.o[1][i] *= alpha; }
    }
    A.m = mnew;
    const float sub = (lane_ok && mnew > -1e29f) ? mnew - bias_c : 1e30f;
    float rs = 0.f;
#pragma unroll
    for (int kb = 0; kb < 2; ++kb)
#pragma unroll
        for (int i = 0; i < 16; ++i) { const float p = __builtin_amdgcn_exp2f(s[kb][i] - sub); s[kb][i] = p; rs += p; }
    rs += __shfl_xor(rs, 32);
    A.l += rs;
    bf16x8 vf[4][2];
#pragma unroll
    for (int s4 = 0; s4 < 4; ++s4)
#pragma unroll
        for (int eb = 0; eb < 2; ++eb) vf[s4][eb] = vt_frag(Vt, voff, s4, eb);
    __builtin_amdgcn_sched_barrier(0);
#pragma unroll
    for (int s4 = 0; s4 < 4; ++s4) {
        const int kb = s4 >> 1, hf = (s4 & 1) * 8;
        u32x4 pw; pw.x = pk_bf16(s[kb][hf + 0], s[kb][hf + 1]); pw.y = pk_bf16(s[kb][hf + 2], s[kb][hf + 3]); pw.z = pk_bf16(s[kb][hf + 4], s[kb][hf + 5]); pw.w = pk_bf16(s[kb][hf + 6], s[kb][hf + 7]);
        const bf16x8 pf = __builtin_bit_cast(bf16x8, pw);
#pragma unroll
        for (int eb = 0; eb < 2; ++eb) A.o[eb] = MFMA32(vf[s4][eb], pf, A.o[eb]);
    }
}
template <int DK>
__device__ __forceinline__ void attn_scores_half(f32x16& s, const bf16x8 (&qf)[DK / 16], const LAS unsigned char* Kt, int r, int h, int kb) {
    constexpr int KP = 2 * DK + 16, NK = DK / 16;
    bf16x8 kf[NK];
#pragma unroll
    for (int ks = 0; ks < NK; ++ks) kf[ks] = *(const LAS bf16x8*)(Kt + (32 * kb + r) * KP + (16 * ks + 8 * h) * 2);
    __builtin_amdgcn_sched_barrier(0);
#pragma unroll
    for (int i = 0; i < 16; ++i) s[i] = 0.f;
#pragma unroll
    for (int ks = 0; ks < NK; ++ks) s = MFMA32(kf[ks], qf[ks], s);
}
__device__ __forceinline__ void attn_softmax_pv_half(AttnState& A, f32x16& s, const LAS unsigned char* Vt, int r, int h, int kb, float bias_c = 0.f, bool lane_ok = true) {
    constexpr float THR = 8.f; const int voff = vt_lane_off(r + 32 * h);
    float mx = max3f(s[0], s[1], s[2]);
#pragma unroll
    for (int i = 3; i < 15; i += 2) mx = max3f(mx, s[i], s[i + 1]);
    mx = fmaxf(mx, s[15]);
    mx = fmaxf(mx, __shfl_xor(mx, 32));
    const float mxb = (lane_ok && mx > -1e29f) ? mx + bias_c : -1e30f;
    const bool grow = mxb > A.m + THR;
    const float mnew = grow ? mxb : A.m;
    if (__any(grow)) {
        const float alpha = __builtin_amdgcn_exp2f(A.m - mnew);
        A.l *= alpha;
#pragma unroll
        for (int i = 0; i < 16; ++i) { A.o[0][i] *= alpha; A.o[1][i] *= alpha; }
    }
    A.m = mnew;
    const float sub = (lane_ok && mnew > -1e29f) ? mnew - bias_c : 1e30f;
    float rs = 0.f;
#pragma unroll
    for (int i = 0; i < 16; ++i) { const float p = __builtin_amdgcn_exp2f(s[i] - sub); s[i] = p; rs += p; }
    rs += __shfl_xor(rs, 32);
    A.l += rs;
    bf16x8 vf[2][2];
#pragma unroll
    for (int s2 = 0; s2 < 2; ++s2)
#pragma unroll
        for (int eb = 0; eb < 2; ++eb) vf[s2][eb] = vt_frag(Vt, voff, 2 * kb + s2, eb);
    __builtin_amdgcn_sched_barrier(0);
#pragma unroll
    for (int s2 = 0; s2 < 2; ++s2) {
        const int hf = s2 * 8;
        u32x4 pw; pw.x = pk_bf16(s[hf + 0], s[hf + 1]); pw.y = pk_bf16(s[hf + 2], s[hf + 3]); pw.z = pk_bf16(s[hf + 4], s[hf + 5]); pw.w = pk_bf16(s[hf + 6], s[hf + 7]);
        const bf16x8 pf = __builtin_bit_cast(bf16x8, pw);
#pragma unroll
        for (int eb = 0; eb < 2; ++eb) A.o[eb] = MFMA32(vf[s2][eb], pf, A.o[eb]);
    }
}
template <int DK>
__device__ __forceinline__ void stage_k_load(u32x4 (&kr)[2], const bf16_t* Kg  , int tid) {
    constexpr int CH = DK / 8;
    kr[0] = *(const u32x4*)(Kg + (size_t)(tid / CH) * DK + (tid % CH) * 8);
    if (64 * CH > 512) { const int c2 = tid + 512; if (c2 < 64 * CH) kr[1] = *(const u32x4*)(Kg + (size_t)(c2 / CH) * DK + (c2 % CH) * 8); }
}
template <int DK>
__device__ __forceinline__ void stage_k_store(const u32x4 (&kr)[2], LAS unsigned char* Kt, int tid) {
    constexpr int CH = DK / 8, KP = 2 * DK + 16;
    *(LAS u32x4*)(Kt + (tid / CH) * KP + (tid % CH) * 16) = kr[0];
    if (64 * CH > 512) { const int c2 = tid + 512; if (c2 < 64 * CH) *(LAS u32x4*)(Kt + (c2 / CH) * KP + (c2 % CH) * 16) = kr[1]; }
}
__device__ __forceinline__ u32x4 stage_v_load(const bf16_t* Vg, int tid) { return *(const u32x4*)(Vg + (size_t)(tid >> 3) * 64 + (tid & 7) * 8); }
__device__ __forceinline__ void stage_v_store(const u32x4& v, LAS unsigned char* Vt, int tid) { *(LAS u32x4*)(Vt + (tid >> 3) * VTP + (tid & 7) * 16) = v; }

constexpr int MLA_KT = 0, MLA_VT = 2 * 64 * 208, MLA_LDS = MLA_VT + 2 * 64 * VTP;
__device__ __forceinline__ void mla_unit(int b, int hd, int qt, int l, unsigned char* ws, LAS unsigned char* lds, int g_wv) {
    int tid_ = TIDX; asm volatile("" : "+v"(tid_));
    const int tid = tid_, w = tid >> 6, lane = tid & 63, r = lane & 31, h = lane >> 5;
    const size_t slab = (size_t)(b * 6 + hd) * 2048;
    const bf16_t* QM = (const bf16_t*)(ws + WS_MLA) + slab * 96; const bf16_t* KM = (const bf16_t*)(ws + WS_MLA + MLA_KM) + slab * 96; const bf16_t* VM = (const bf16_t*)(ws + WS_MLA + MLA_VM) + slab * 64;
    const int q0 = 256 * qt + 32 * w, q = q0 + r;
    bf16x8 qf[6];
#pragma unroll
    for (int ks = 0; ks < 6; ++ks) qf[ks] = *(const bf16x8*)(QM + (size_t)q * 96 + 16 * ks + 8 * h);
    AttnState A; attn_reset(A);
    const int ntile = 4 * qt + 4;
    u32x4 kr[2], vr, kr2[2], vr2;
    stage_k_load<96>(kr, KM, tid); vr = stage_v_load(VM, tid);
    stage_k_store<96>(kr, lds + MLA_KT, tid); stage_v_store(vr, lds + MLA_VT, tid);
    if (ntile > 1) { stage_k_load<96>(kr, KM + (size_t)64 * 96, tid); vr = stage_v_load(VM + (size_t)64 * 64, tid); }
    __syncthreads();
    auto tile_step = [&](const int j, u32x4 (&kc)[2], u32x4& vc, u32x4 (&kn)[2], u32x4& vn) __attribute__((always_inline)) {
        const int cur = j & 1;
        if (j + 2 < ntile) { stage_k_load<96>(kn, KM + (size_t)(j + 2) * 64 * 96, tid); vn = stage_v_load(VM + (size_t)(j + 2) * 64 * 64, tid); }
        if (64 * j <= q0 + 31) {
            f32x16 s[2];
            attn_scores<96>(s, qf, lds + MLA_KT + cur * 64 * 208, r, h);
            if (64 * j + 63 > q0) {
#pragma unroll
                for (int kb = 0; kb < 2; ++kb)
#pragma unroll
                    for (int i = 0; i < 16; ++i) { const int key = 64 * j + 32 * kb + crow(i, h); if (key > q) s[kb][i] = -1e30f; }
            }
            attn_softmax_pv(A, s, lds + MLA_VT + cur * 64 * VTP, r, h);
        }
        if (j + 1 < ntile) { stage_k_store<96>(kc, lds + MLA_KT + (cur ^ 1) * 64 * 208, tid); stage_v_store(vc, lds + MLA_VT + (cur ^ 1) * 64 * VTP, tid); }
        __syncthreads();
    };
#pragma unroll 1
    for (int j = 0; j < ntile; j += 2) { tile_step(j, kr, vr, kr2, vr2); tile_step(j + 1, kr2, vr2, kr, vr); }
    const float inv = A.l > 0.f ? 1.f / A.l : 0.f; float ss = 0.f;
    bf16_t* Y = (bf16_t*)(ws + WS_Y) + ((size_t)b * 2048 + q) * 1024 + 384 + hd * 64;
#pragma unroll
    for (int eb = 0; eb < 2; ++eb)
#pragma unroll
        for (int g4 = 0; g4 < 4; ++g4) {
            const float v0 = A.o[eb][4 * g4] * inv, v1 = A.o[eb][4 * g4 + 1] * inv, v2 = A.o[eb][4 * g4 + 2] * inv, v3 = A.o[eb][4 * g4 + 3] * inv;
            u32x2 pw; pw.x = pk_bf16(v0, v1); pw.y = pk_bf16(v2, v3);
            const float f0 = bf_lo(pw.x), f1 = bf_hi(pw.x), f2 = bf_lo(pw.y), f3 = bf_hi(pw.y); ss += (f0 * f0 + f1 * f1) + (f2 * f2 + f3 * f3);
            *(u32x2*)(Y + 32 * eb + 8 * g4 + 4 * h) = pw;
        }
    ss += __shfl_xor(ss, 32);
    if (h == 0) ((float*)(ws + WS_SSQ + PT_C))[((size_t)l * 16384 + (size_t)b * 2048 + q) * 8 + hd] = ss;
}

__device__ __forceinline__ void nsa_bias32(float (&bv)[2][16], const LAS float* bl, int dd) {
#pragma unroll
    for (int kb = 0; kb < 2; ++kb)
#pragma unroll
        for (int k = 0; k < 16; ++k) { const int c = 63 - (32 * kb + (k & 3) + 8 * (k >> 2)); int d = dd + c; d = d < 0 ? 0 : (d > 255 ? 255 : d); bv[kb][k] = bl[d]; }
}
__device__ __forceinline__ void nsa_mask_bias(f32x16 (&sc)[2], int dq, int h, const LAS float* bl) {
    int dd = dq - 4 * h - 63; asm volatile("" : "+v"(dd));
    const LAS float* p = bl + dd;
    float bv[2][16];
#pragma unroll
    for (int kb = 0; kb < 2; ++kb)
#pragma unroll
        for (int k = 0; k < 16; ++k) bv[kb][k] = p[63 - (32 * kb + (k & 3) + 8 * (k >> 2))];
#pragma unroll
    for (int kb = 0; kb < 2; ++kb)
#pragma unroll
        for (int k = 0; k < 16; ++k) sc[kb][k] += bv[kb][k];
}
__device__ __forceinline__ void nsa_mask_bias_half(f32x16& sc, int dq, int h, const LAS float* bl, int kb) {
    int dd = dq - 4 * h - 32 * kb - 31; asm volatile("" : "+v"(dd));
    const LAS float* p = bl + dd;
    float bv[16];
#pragma unroll
    for (int k = 0; k < 16; ++k) bv[k] = p[31 - ((k & 3) + 8 * (k >> 2))];
#pragma unroll
    for (int k = 0; k < 16; ++k) sc[k] += bv[k];
}
__device__ __forceinline__ void attn_park(const AttnState& A, LAS float* xl) {
    xl[0] = A.m; xl[64] = A.l;
#pragma unroll
    for (int k = 0; k < 16; ++k) { xl[64 * (2 + k)] = A.o[0][k]; xl[64 * (18 + k)] = A.o[1][k]; }
}
__device__ __forceinline__ void attn_merge(AttnState& A, const LAS float* xl) {
    const float m2 = xl[0], l2 = xl[64]; const float m = fmaxf(A.m, m2);
    const float a1 = A.m > -1e29f ? __builtin_amdgcn_exp2f(A.m - m) : 0.f, a2 = m2 > -1e29f ? __builtin_amdgcn_exp2f(m2 - m) : 0.f;
    A.l = A.l * a1 + l2 * a2; A.m = m;
#pragma unroll
    for (int k = 0; k < 16; ++k) { A.o[0][k] = A.o[0][k] * a1 + xl[64 * (2 + k)] * a2; A.o[1][k] = A.o[1][k] * a1 + xl[64 * (18 + k)] * a2; }
}
constexpr int NSA_KT = 0, NSA_VT = 2 * 64 * 144, NSA_BIAS = NSA_VT + 2 * 64 * VTP, NSA_PS = NSA_BIAS + 3 * 640 * 4, NSA_SEL = NSA_PS + 3 * 64 * 32 * 4, NSA_UNI = NSA_SEL + 256, NSA_OT = NSA_UNI + 256, NSA_LDS = NSA_OT + 6 * 8192;
__device__ __forceinline__ void nsa_unit(int b, int hk, int i, int l, InPtr in, unsigned char* ws, LAS unsigned char* lds, int g_wv) {
    int tid_ = TIDX; asm volatile("" : "+v"(tid_));
    const int tid = tid_, w = tid >> 6, lane = tid & 63, r = lane & 31, h = lane >> 5;
    const bool active = w < 6; const int g = active ? (w >> 1) : 2, th = w & 1, head = hk * 3 + g;
    const int kh = w < 4 ? -1 : (w < 6 ? 0 : 1);
    LAS float* xl = (LAS float*)(lds + NSA_LDS) + th * (34 * 64) + lane;
    const int t = 64 * i + 32 * th + r, tl = 32 * th + r; const size_t row = (size_t)b * 2048 + t;
    const size_t kvslab = (size_t)(b * 2 + hk) * 2048 * 64;
    LAS float* biasl = (LAS float*)(lds + NSA_BIAS); LAS float* PS = (LAS float*)(lds + NSA_PS); LAS unsigned* SEL = (LAS unsigned*)(lds + NSA_SEL); LAS unsigned* UNI = (LAS unsigned*)(lds + NSA_UNI);
    { const float* bd = (const float*)(ws + WS_BIASD) + (size_t)hk * 3 * 2048;
#pragma unroll
      for (int k = 0; k < 4; ++k) { const int e = tid + 512 * k; if (e < 1920) { const int gg = e / 640, d = e - gg * 640 - 63; biasl[e] = (d < 0 || d >= 512) ? -1e30f : bd[gg * 2048 + d]; } }
#pragma unroll
      for (int k = 0; k < 12; ++k) if (i >= 16) PS[tid + 512 * k] = 0.f;
      if (tid < 4) UNI[tid] = 0u; }
    bf16x8 qf[4];
    { const bf16_t* QN = (const bf16_t*)(ws + WS_PRJ + PRJ_QN) + ((size_t)(b * 6 + head) * 2048 + t) * 64;
#pragma unroll
      for (int ks = 0; ks < 4; ++ks) qf[ks] = *(const bf16x8*)(QN + 16 * ks + 8 * h); }
#define NSA_GATE(k) ({ int t_ = t; asm volatile("" : "+v"(t_)); sigmf(((const float*)(ws + WS_PRJ + PRJ_GATES))[((size_t)b * 2048 + t_) * 32 + head * 3 + (k)]); })
    LAS float* bl = biasl + g * 640 + 63;
    LAS float* otl = (LAS float*)(lds + NSA_OT + (active ? w : 0) * 8192) + lane;
    u32x4 kr[2], vr;
    const int ntc = i >= 16 ? 2 : 1;
    { const bf16_t* KC = (const bf16_t*)(ws + WS_CMP) + (size_t)(b * 2 + hk) * 128 * 64; const bf16_t* VC = (const bf16_t*)(ws + WS_CMP + CMP_V) + (size_t)(b * 2 + hk) * 128 * 64;
      for (int T = 0; T < ntc; ++T) { stage_k_load<64>(kr, KC + T * 4096, tid); vr = stage_v_load(VC + T * 4096, tid); stage_k_store<64>(kr, lds + NSA_KT + T * 64 * 144, tid); stage_v_store(vr, lds + NSA_VT + T * 64 * VTP, tid); } }
    __syncthreads();
    {
        f32x16 ot[2];
        if (active && i < 16) {
            AttnState A; attn_reset(A); f32x16 sc[2]; attn_scores<64>(sc, qf, lds + NSA_KT, r, h);
            float bvc[2][16];
#pragma unroll
            for (int kb = 0; kb < 2; ++kb)
#pragma unroll
                for (int k = 0; k < 16; ++k) { int d = t - 16 * (32 * kb + crow(k, h)) - 31; d = d < 0 ? 0 : (d > 255 ? 255 : d); bvc[kb][k] = bl[d]; }
#pragma unroll
            for (int kb = 0; kb < 2; ++kb)
#pragma unroll
                for (int k = 0; k < 16; ++k) { const int d = t - 16 * (32 * kb + crow(k, h)) - 31; sc[kb][k] = d >= 0 ? sc[kb][k] + bvc[kb][k] : -1e30f; }
            attn_softmax_pv(A, sc, lds + NSA_VT, r, h);
            const float gc = NSA_GATE(0); const float inv = A.l > 0.f ? gc / A.l : 0.f;
#pragma unroll
            for (int k = 0; k < 16; ++k) { otl[64 * k] = A.o[0][k] * inv; otl[64 * (16 + k)] = A.o[1][k] * inv; }
        } else if (active) {
            float m = -1e30f, lsum = 0.f;
            for (int T = 0; T < ntc; ++T) {
                f32x16 sc[2]; attn_scores<64>(sc, qf, lds + NSA_KT + T * 64 * 144, r, h);
                float bvc[2][16];
#pragma unroll
                for (int kb = 0; kb < 2; ++kb)
#pragma unroll
                    for (int k = 0; k < 16; ++k) { int d = t - 16 * (64 * T + 32 * kb + crow(k, h)) - 31; d = d < 0 ? 0 : (d > 255 ? 255 : d); bvc[kb][k] = bl[d]; }
                float mx = -1e30f;
#pragma unroll
                for (int kb = 0; kb < 2; ++kb)
#pragma unroll
                    for (int k = 0; k < 16; ++k) { const int n = 64 * T + 32 * kb + crow(k, h); const int d = t - 16 * n - 31; const float x = (d >= 0 && n < 127) ? sc[kb][k] + bvc[kb][k] : -1e30f; sc[kb][k] = x; mx = fmaxf(mx, x); }
                mx = fmaxf(mx, __shfl_xor(mx, 32));
                const float mnew = fmaxf(m, mx), mref = mnew <= -1e29f ? 0.f : mnew; float rs = 0.f;
#pragma unroll
                for (int kb = 0; kb < 2; ++kb)
#pragma unroll
                    for (int k = 0; k < 16; ++k) rs += __builtin_amdgcn_exp2f(sc[kb][k] - mref);
                rs += __shfl_xor(rs, 32);
                lsum = lsum * __builtin_amdgcn_exp2f(m - mref) + rs; m = mnew;
            }
            const float mref = m <= -1e29f ? 0.f : m, inv = lsum > 0.f ? 1.f / lsum : 0.f;
#pragma unroll
            for (int k = 0; k < 16; ++k) { ot[0][k] = 0.f; ot[1][k] = 0.f; }
            float carry = 0.f;
            for (int T = 0; T < ntc; ++T) {
                f32x16 sc[2]; attn_scores<64>(sc, qf, lds + NSA_KT + T * 64 * 144, r, h);
                float bvc[2][16];
#pragma unroll
                for (int kb = 0; kb < 2; ++kb)
#pragma unroll
                    for (int k = 0; k < 16; ++k) { int d = t - 16 * (64 * T + 32 * kb + crow(k, h)) - 31; d = d < 0 ? 0 : (d > 255 ? 255 : d); bvc[kb][k] = bl[d]; }
#pragma unroll
                for (int kb = 0; kb < 2; ++kb)
#pragma unroll
                    for (int k = 0; k < 16; ++k) { const int n = 64 * T + 32 * kb + crow(k, h); const int d = t - 16 * n - 31; sc[kb][k] = (d >= 0 && n < 127) ? __builtin_amdgcn_exp2f(sc[kb][k] + bvc[kb][k] - mref) * inv : 0.f; }
                float prevL = carry;
#pragma unroll
                for (int kb = 0; kb < 2; ++kb)
#pragma unroll
                    for (int g4 = 0; g4 < 4; ++g4) {
                        const float G4 = (sc[kb][4 * g4] + sc[kb][4 * g4 + 1]) + (sc[kb][4 * g4 + 2] + sc[kb][4 * g4 + 3]); const float L = sc[kb][4 * g4 + 3];
                        const float Lo = __shfl_xor(L, 32);
                        const float add = h ? Lo : prevL;
                        prevL = Lo;
                        const int idx = T * 8 + kb * 4 + g4;
                        PS[g * 2048 + tl * 32 + 2 * idx + h] = G4 + add;
                    }
                carry = prevL;
#pragma unroll
                for (int s4 = 0; s4 < 4; ++s4) {
                    const int kb = s4 >> 1, hf = (s4 & 1) * 8;
                    u32x4 pw; pw.x = pk_bf16(sc[kb][hf + 0], sc[kb][hf + 1]); pw.y = pk_bf16(sc[kb][hf + 2], sc[kb][hf + 3]); pw.z = pk_bf16(sc[kb][hf + 4], sc[kb][hf + 5]); pw.w = pk_bf16(sc[kb][hf + 6], sc[kb][hf + 7]);
                    const bf16x8 pf = __builtin_bit_cast(bf16x8, pw);
#pragma unroll
                    for (int eb = 0; eb < 2; ++eb) ot[eb] = MFMA32(vt_frag(lds + NSA_VT + T * 64 * VTP, vt_lane_off(lane), s4, eb), pf, ot[eb]);
                }
            }
            { const float gc = NSA_GATE(0);
#pragma unroll
            for (int k = 0; k < 16; ++k) { otl[64 * k] = ot[0][k] * gc; otl[64 * (16 + k)] = ot[1][k] * gc; } }
        }
    }
    __syncthreads();
#ifndef NO_NSA_SEL
    if (i < 16) { if (tid < 64) SEL[tid] = (2u << i) - 1u; if (tid < 3) UNI[tid] = (2u << i) - 1u; }
    else {
        const int tk = tid >> 3, sg = tid & 7; float v[32];
#pragma unroll
        for (int k = 0; k < 8; ++k) { const f32x4 x0 = *(const LAS f32x4*)(PS + tk * 32 + 4 * k), x1 = *(const LAS f32x4*)(PS + 2048 + tk * 32 + 4 * k), x2 = *(const LAS f32x4*)(PS + 4096 + tk * 32 + 4 * k);
            v[4 * k] = (x0.x + x1.x) + x2.x; v[4 * k + 1] = (x0.y + x1.y) + x2.y; v[4 * k + 2] = (x0.z + x1.z) + x2.z; v[4 * k + 3] = (x0.w + x1.w) + x2.w; }
#pragma unroll
        for (int s = 0; s < 32; ++s) { const bool forced = (s == 0) || (s == i) || (s == i - 1); float x = forced ? v[s] + 1e4f : v[s]; v[s] = s > i ? -1.f : x; }
        unsigned bits = 0u;
#pragma unroll
        for (int k = 0; k < 4; ++k) {
            float x = 0.f;
#pragma unroll
            for (int s = 0; s < 32; ++s) x = (s == 4 * sg + k) ? v[s] : x;
            int rank = 0;
#pragma unroll
            for (int s = 0; s < 32; ++s) rank += (v[s] > x || (v[s] == x && s < 4 * sg + k)) ? 1 : 0;
            if (rank < 16 && x >= 0.f) bits |= 1u << (4 * sg + k);
        }
        bits |= shx<1>(bits); bits |= shx<2>(bits); bits |= shx<4>(bits);
        if (sg == 0) { SEL[tk] = bits; __hip_atomic_fetch_or(UNI, bits, __ATOMIC_RELAXED, __HIP_MEMORY_SCOPE_WORKGROUP); __hip_atomic_fetch_or(UNI + 1 + (tk >> 5), bits, __ATOMIC_RELAXED, __HIP_MEMORY_SCOPE_WORKGROUP); }
    }
#endif
    __syncthreads();
    const unsigned selbits = SEL[tl], uni = UNI[0], unih = UNI[1 + th];
    const float c31 = bl[255];
#ifndef NO_NSA_SLC
#ifndef NSA_DUP_SLC
#define NSA_DUP_SLC 1
#endif
    for (int rp_ = 0; rp_ < NSA_DUP_SLC; ++rp_) {
        AttnState A; attn_reset(A);
        const bf16_t* KS = (const bf16_t*)(ws + WS_PRJ + PRJ_KN1) + kvslab; const bf16_t* VS = (const bf16_t*)(ws + WS_PRJ + PRJ_VN1) + kvslab;
        auto slc_loop = [&](auto full_tag) __attribute__((always_inline)) {
        constexpr bool FULL = decltype(full_tag)::value;
        unsigned todo = uni; int cur = 0; u32x4 kr2[2], vr2;
        int s = __ffs(todo) - 1; todo &= todo - 1;
        stage_k_load<64>(kr, KS + (size_t)s * 4096, tid); vr = stage_v_load(VS + (size_t)s * 4096, tid);
        stage_k_store<64>(kr, lds + NSA_KT, tid); stage_v_store(vr, lds + NSA_VT, tid);
        int sn = todo ? __ffs(todo) - 1 : -1; todo &= todo - 1;
        if (sn >= 0) { stage_k_load<64>(kr, KS + (size_t)sn * 4096, tid); vr = stage_v_load(VS + (size_t)sn * 4096, tid); }
        __syncthreads();
        auto step = [&](u32x4 (&ka)[2], u32x4& va, u32x4 (&kb_)[2], u32x4& vb_) __attribute__((always_inline)) {
            const int sn2 = todo ? __ffs(todo) - 1 : -1; todo &= todo - 1;
            if (sn2 >= 0) { stage_k_load<64>(kb_, KS + (size_t)sn2 * 4096, tid); vb_ = stage_v_load(VS + (size_t)sn2 * 4096, tid); }
            if ((unih >> s) & 1u) {
                const bool sel = (selbits >> s) & 1u;
                if constexpr (FULL) {
                    f32x16 sc[2];
                    attn_scores<64>(sc, qf, lds + NSA_KT + cur * 64 * 144, r, h);
                    float bc = c31; if (i - s < 3) { nsa_mask_bias(sc, t - 64 * s, h, bl); bc = 0.f; }
                    attn_softmax_pv(A, sc, lds + NSA_VT + cur * 64 * VTP, r, h, bc, sel);
                } else {
                    f32x16 s1;
                    attn_scores_half<64>(s1, qf, lds + NSA_KT + cur * 64 * 144, r, h, kh);
                    float bc = c31; if (i - s < 3) { nsa_mask_bias_half(s1, t - 64 * s, h, bl, kh); bc = 0.f; }
                    attn_softmax_pv_half(A, s1, lds + NSA_VT + cur * 64 * VTP, r, h, kh, bc, sel);
                }
            }
            if (sn >= 0) { stage_k_store<64>(ka, lds + NSA_KT + (cur ^ 1) * 64 * 144, tid); stage_v_store(va, lds + NSA_VT + (cur ^ 1) * 64 * VTP, tid); }
            __syncthreads();
            s = sn; sn = sn2; cur ^= 1;
        };
        while (s >= 0) { step(kr, vr, kr2, vr2); if (s < 0) break; step(kr2, vr2, kr, vr); }
        };
        if (kh < 0) slc_loop(std::true_type{}); else slc_loop(std::false_type{});
        if (kh == 1) attn_park(A, xl);
        __syncthreads();
        if (kh == 0) attn_merge(A, xl);
        if (active && rp_ == NSA_DUP_SLC - 1) { const float gs = NSA_GATE(1); const float inv = A.l > 0.f ? gs / A.l : 0.f;
#pragma unroll
            for (int k = 0; k < 16; ++k) { otl[64 * k] += A.o[0][k] * inv; otl[64 * (16 + k)] += A.o[1][k] * inv; } }
    }
#endif
#ifndef NO_NSA_WIN
#ifndef NSA_DUP_WIN
#define NSA_DUP_WIN 1
#endif
    for (int rq_ = 0; rq_ < NSA_DUP_WIN; ++rq_) {
        AttnState A; attn_reset(A);
        const bf16_t* KW = (const bf16_t*)(ws + WS_PRJ + PRJ_KN2) + kvslab; const bf16_t* VW = (const bf16_t*)(ws + WS_PRJ + PRJ_VN2) + kvslab;
        const int j0 = i > 8 ? i - 8 : 0;
        auto win_loop = [&](auto full_tag) __attribute__((always_inline)) {
        constexpr bool FULL = decltype(full_tag)::value;
        int cur = 0; u32x4 kr2[2], vr2;
        stage_k_load<64>(kr, KW + (size_t)j0 * 4096, tid); vr = stage_v_load(VW + (size_t)j0 * 4096, tid);
        stage_k_store<64>(kr, lds + NSA_KT, tid); stage_v_store(vr, lds + NSA_VT, tid);
        if (j0 < i) { stage_k_load<64>(kr, KW + (size_t)(j0 + 1) * 4096, tid); vr = stage_v_load(VW + (size_t)(j0 + 1) * 4096, tid); }
        __syncthreads();
        for (int j = j0; j <= i; ++j) {
            if (j + 2 <= i) { stage_k_load<64>(kr2, KW + (size_t)(j + 2) * 4096, tid); vr2 = stage_v_load(VW + (size_t)(j + 2) * 4096, tid); }
            if constexpr (FULL) {
                f32x16 sc[2];
                attn_scores<64>(sc, qf, lds + NSA_KT + cur * 64 * 144, r, h);
                float bc = c31; if (!(i - j >= 3 && j > i - 8)) { nsa_mask_bias(sc, t - 64 * j, h, bl); bc = 0.f; }
                attn_softmax_pv(A, sc, lds + NSA_VT + cur * 64 * VTP, r, h, bc, true);
            } else {
                f32x16 s1;
                attn_scores_half<64>(s1, qf, lds + NSA_KT + cur * 64 * 144, r, h, kh);
                float bc = c31; if (!(i - j >= 3 && j > i - 8)) { nsa_mask_bias_half(s1, t - 64 * j, h, bl, kh); bc = 0.f; }
                attn_softmax_pv_half(A, s1, lds + NSA_VT + cur * 64 * VTP, r, h, kh, bc, true);
            }
            if (j < i) { stage_k_store<64>(kr, lds + NSA_KT + (cur ^ 1) * 64 * 144, tid); stage_v_store(vr, lds + NSA_VT + (cur ^ 1) * 64 * VTP, tid); }
            kr[0] = kr2[0]; vr = vr2;
            __syncthreads();
            cur ^= 1;
        }
        };
        if (kh < 0) win_loop(std::true_type{}); else win_loop(std::false_type{});
        if (kh == 1) attn_park(A, xl);
        __syncthreads();
        if (kh == 0) attn_merge(A, xl);
        if (active && rq_ == NSA_DUP_WIN - 1) { const float gw = NSA_GATE(2); const float inv = A.l > 0.f ? gw / A.l : 0.f;
            float ss = 0.f; bf16_t* Y = (bf16_t*)(ws + WS_Y) + row * 1024 + head * 64;
#pragma unroll
            for (int eb = 0; eb < 2; ++eb)
#pragma unroll
                for (int g4 = 0; g4 < 4; ++g4) {
                    const float v0 = otl[64 * (16 * eb + 4 * g4)] + A.o[eb][4 * g4] * inv, v1 = otl[64 * (16 * eb + 4 * g4 + 1)] + A.o[eb][4 * g4 + 1] * inv;
                    const float v2 = otl[64 * (16 * eb + 4 * g4 + 2)] + A.o[eb][4 * g4 + 2] * inv, v3 = otl[64 * (16 * eb + 4 * g4 + 3)] + A.o[eb][4 * g4 + 3] * inv;
                    u32x2 pw; pw.x = pk_bf16(v0, v1); pw.y = pk_bf16(v2, v3);
                    const float f0 = bf_lo(pw.x), f1 = bf_hi(pw.x), f2 = bf_lo(pw.y), f3 = bf_hi(pw.y); ss += (f0 * f0 + f1 * f1) + (f2 * f2 + f3 * f3);
                    *(u32x2*)(Y + 32 * eb + 8 * g4 + 4 * h) = pw;
                }
            ss += __shfl_xor(ss, 32);
            if (h == 0) ((float*)(ws + WS_SSQ + PT_A))[((size_t)l * 16384 + row) * 8 + head] = ss;
        }
    }
#endif
}

__device__ __forceinline__ void ml_out_wave(int cu, int l, InPtr in, unsigned char* ws, LAS unsigned char* wl, LAS unsigned char* npl, int lane) {
    const int c = cu & 31, bh = cu >> 5, hd = bh & 3, b = bh >> 2; const int t0 = c * 64; const int r = lane & 15, q = lane >> 4;
    const bf16_t* QC = (const bf16_t*)(ws + WS_ML) + ((size_t)bh * 2048 + t0) * 64; const bf16_t* KC = (const bf16_t*)(ws + WS_ML + ML_KC) + ((size_t)bh * 2048 + t0) * 64;
    const bf16_t* V = (const bf16_t*)(ws + WS_PRJ + PRJ_VML) + ((size_t)bh * 2048 + t0) * 64;
    const float* mlg = (const float*)(ws + WS_ML + ML_G) + ((size_t)bh * 2048 + t0) * 2;
    const bf16_t* CP = (const bf16_t*)(ws + WS_ML + ML_CP) + (size_t)cu * 4096; const bf16_t* NP = (const bf16_t*)(ws + WS_ML + ML_NP) + (size_t)cu * 64;
    u32x4 vch[8];
#pragma unroll
    for (int i = 0; i < 8; ++i) vch[i] = *(const u32x4*)(V + (size_t)(lane + 64 * i) * 8);
    bf16x8 aq[4][2];
#pragma unroll
    for (int mb = 0; mb < 4; ++mb)
#pragma unroll
        for (int ks = 0; ks < 2; ++ks) aq[mb][ks] = *(const bf16x8*)(QC + (size_t)(16 * mb + r) * 64 + 32 * ks + 8 * q);
    float bj[4][4], den[4][4];
#pragma unroll
    for (int mb = 0; mb < 4; ++mb)
#pragma unroll
        for (int j = 0; j < 4; ++j) bj[mb][j] = mlg[(16 * mb + 4 * q + j) * 2];
    bf16x8 kf[4][2]; float gx[4], gy[4];
#pragma unroll
    for (int nb = 0; nb < 4; ++nb) { const float2 gg = *(const float2*)(mlg + (16 * nb + r) * 2); gx[nb] = gg.x; gy[nb] = gg.y;
#pragma unroll
        for (int ks = 0; ks < 2; ++ks) kf[nb][ks] = *(const bf16x8*)(KC + (size_t)(16 * nb + r) * 64 + 32 * ks + 8 * q); }
    __builtin_amdgcn_sched_barrier(0);
    {
        float cs[4];
#pragma unroll
        for (int nb = 0; nb < 4; ++nb) cs[nb] = gy[nb] - gx[nb];
#pragma unroll
        for (int mb = 0; mb < 4; ++mb) {
            f32x4 accS[4];
#pragma unroll
            for (int nb = 0; nb < 4; ++nb) { accS[nb] = (f32x4){0.f, 0.f, 0.f, 0.f};
#pragma unroll
                for (int ks = 0; ks < 2; ++ks) accS[nb] = MFMA16(aq[mb][ks], kf[nb][ks], accS[nb]); }
#pragma unroll
            for (int j = 0; j < 4; ++j) {
                const int jj = 16 * mb + 4 * q + j; float rs = 0.f;
#pragma unroll
                for (int nb = 0; nb < 4; ++nb) { const int s = 16 * nb + r; const float p = s <= jj ? accS[nb][j] * __expf(bj[mb][j] + cs[nb]) : 0.f; rs += p;
                    *(LAS bf16_t*)(wl + 8192 + swz_off(jj, s >> 3) + (s & 7) * 2) = f2bf(p); }
                rs += shx<1>(rs); rs += shx<2>(rs); rs += shx<4>(rs); rs += shx<8>(rs);
                den[mb][j] = rs;
            }
        }
    }
    bf16x8 cpf[2][4]; u32x4 npf[2];
#pragma unroll
    for (int ks = 0; ks < 2; ++ks) { npf[ks] = *(const u32x4*)(NP + 32 * ks + 8 * q);
#pragma unroll
        for (int nb = 0; nb < 4; ++nb) cpf[ks][nb] = *(const bf16x8*)(CP + (size_t)(16 * nb + r) * 64 + 32 * ks + 8 * q); }
    __builtin_amdgcn_sched_barrier(0);
#pragma unroll
    for (int i = 0; i < 8; ++i) { const int ch = lane + 64 * i, sv = ch >> 3, e0 = (ch & 7) * 8; const unsigned xs[4] = {vch[i].x, vch[i].y, vch[i].z, vch[i].w};
#pragma unroll
        for (int k = 0; k < 4; ++k) { *(LAS bf16_t*)(wl + swz_off(e0 + 2 * k, sv >> 3) + (sv & 7) * 2) = (bf16_t)(xs[k] & 0xffffu); *(LAS bf16_t*)(wl + swz_off(e0 + 2 * k + 1, sv >> 3) + (sv & 7) * 2) = (bf16_t)(xs[k] >> 16); } }
#pragma unroll
    for (int mb = 0; mb < 4; ++mb) { const float e = __expf(gx[mb]);
#pragma unroll
        for (int ks = 0; ks < 2; ++ks) { const u32x4 x = __builtin_bit_cast(u32x4, aq[mb][ks]); u32x4 y;
            y.x = pk_bf16(bf_lo(x.x) * e, bf_hi(x.x) * e); y.y = pk_bf16(bf_lo(x.y) * e, bf_hi(x.y) * e); y.z = pk_bf16(bf_lo(x.z) * e, bf_hi(x.z) * e); y.w = pk_bf16(bf_lo(x.w) * e, bf_hi(x.w) * e);
            aq[mb][ks] = __builtin_bit_cast(bf16x8, y); } }
    f32x4 acc[4][4], accn[4];
#pragma unroll
    for (int mb = 0; mb < 4; ++mb) { accn[mb] = (f32x4){0.f, 0.f, 0.f, 0.f};
#pragma unroll
        for (int nb = 0; nb < 4; ++nb) acc[mb][nb] = (f32x4){0.f, 0.f, 0.f, 0.f}; }
#pragma unroll
    for (int ks = 0; ks < 2; ++ks) {
        u32x4 nz = npf[ks]; if (r != 0) nz = (u32x4){0u, 0u, 0u, 0u};
        const bf16x8 bn = __builtin_bit_cast(bf16x8, nz);
#pragma unroll
        for (int nb = 0; nb < 4; ++nb) { const bf16x8 bb = cpf[ks][nb];
#pragma unroll
            for (int mb = 0; mb < 4; ++mb) acc[mb][nb] = MFMA16(aq[mb][ks], bb, acc[mb][nb]); }
#pragma unroll
        for (int mb = 0; mb < 4; ++mb) accn[mb] = MFMA16(aq[mb][ks], bn, accn[mb]);
    }
    LDS_FENCE();
#pragma unroll
    for (int ks = 0; ks < 2; ++ks) {
        bf16x8 ap[4];
#pragma unroll
        for (int mb = 0; mb < 4; ++mb) ap[mb] = *(const LAS bf16x8*)(wl + 8192 + swz_off(16 * mb + r, 4 * ks + q));
#pragma unroll
        for (int nb = 0; nb < 4; ++nb) { const bf16x8 bv = *(const LAS bf16x8*)(wl + swz_off(16 * nb + r, 4 * ks + q));
#pragma unroll
            for (int mb = 0; mb < 4; ++mb) acc[mb][nb] = MFMA16(ap[mb], bv, acc[mb][nb]); }
    }
    LDS_FENCE();
    const bf16_t* OG = (const bf16_t*)(ws + WS_PRJ + PRJ_OG); u32x4 ogc[8];
#pragma unroll
    for (int i = 0; i < 8; ++i) { const int ch = lane + 64 * i; ogc[i] = *(const u32x4*)(OG + ((size_t)b * 2048 + t0 + (ch >> 3)) * 256 + hd * 64 + (ch & 7) * 8); }
    const float* gain = in->p[14] + l * 256 + hd * 64;
    bf16_t* Y = (bf16_t*)(ws + WS_Y);
    float gn[4];
#pragma unroll
    for (int nb = 0; nb < 4; ++nb) gn[nb] = gain[16 * nb + r];
#pragma unroll
    for (int mb = 0; mb < 4; ++mb)
#pragma unroll
        for (int j = 0; j < 4; ++j) {
            const int jj = 16 * mb + 4 * q + j;
            const float dn = den[mb][j] + __builtin_bit_cast(float, __builtin_amdgcn_ds_bpermute((lane & 48) << 2, __builtin_bit_cast(int, accn[mb][j])));
            const float inv = __builtin_amdgcn_rcpf(fmaxf(fabsf(dn), 1.f)); float hv[4]; float ss = 0.f;
#pragma unroll
            for (int nb = 0; nb < 4; ++nb) { hv[nb] = acc[mb][nb][j] * inv; ss += hv[nb] * hv[nb]; }
            ss += shx<1>(ss); ss += shx<2>(ss); ss += shx<4>(ss); ss += shx<8>(ss);
            const float rstd = rsqrtf(ss * (1.f / 64.f) + 1e-6f);
#pragma unroll
            for (int nb = 0; nb < 4; ++nb) { const int e = 16 * nb + r; *(LAS bf16_t*)(wl + 8192 + swz_off(jj, e >> 3) + (e & 7) * 2) = f2bf(hv[nb] * rstd * gn[nb]); }
        }
    LDS_FENCE();
#pragma unroll
    for (int i = 0; i < 8; ++i) { const int ch = lane + 64 * i, row = ch >> 3, e8 = ch & 7;
        const u32x4 hx = *(const LAS u32x4*)(wl + 8192 + swz_off(row, e8)); const u32x4 g = ogc[i]; u32x4 o;
        o.x = pk_bf16(bf_lo(hx.x) * sigmf(bf_lo(g.x)), bf_hi(hx.x) * sigmf(bf_hi(g.x)));
        o.y = pk_bf16(bf_lo(hx.y) * sigmf(bf_lo(g.y)), bf_hi(hx.y) * sigmf(bf_hi(g.y)));
        o.z = pk_bf16(bf_lo(hx.z) * sigmf(bf_lo(g.z)), bf_hi(hx.z) * sigmf(bf_hi(g.z)));
        o.w = pk_bf16(bf_lo(hx.w) * sigmf(bf_lo(g.w)), bf_hi(hx.w) * sigmf(bf_hi(g.w)));
        *(u32x4*)(Y + ((size_t)b * 2048 + t0 + row) * 1024 + 768 + hd * 64 + e8 * 8) = o; }
    LDS_FENCE();
}

__device__ __forceinline__ void ml_scan_unit(int bh, int l, unsigned char* ws, int g_wv) {
    int tid_ = TIDX; asm volatile("" : "+v"(tid_)); const int tid = tid_;
    const bf16_t* DL = (const bf16_t*)(ws + WS_ML + ML_DELTA) + (size_t)bh * 32 * 4096 + tid * 8; bf16_t* CP = (bf16_t*)(ws + WS_ML + ML_CP) + (size_t)bh * 32 * 4096 + tid * 8;
    const float* DN = (const float*)(ws + WS_ML + ML_DN) + (size_t)bh * 32 * 64; bf16_t* NP = (bf16_t*)(ws + WS_ML + ML_NP) + (size_t)bh * 32 * 64; const float* BL = (const float*)(ws + WS_ML + ML_BL) + bh * 32;
    float c[8]; float n = 0.f;
#pragma unroll
    for (int k = 0; k < 8; ++k) c[k] = 0.f;
#pragma unroll 1
    for (int c0 = 0; c0 < 32; c0 += 8) {
        u32x4 d[8]; float dn[8], co[8];
#pragma unroll
        for (int k = 0; k < 8; ++k) { d[k] = *(const u32x4*)(DL + (size_t)(c0 + k) * 4096); dn[k] = tid < 64 ? DN[(c0 + k) * 64 + tid] : 0.f; co[k] = __expf(BL[c0 + k]); }
#pragma unroll
        for (int k = 0; k < 8; ++k) {
            u32x4 o; o.x = pk_bf16(c[0], c[1]); o.y = pk_bf16(c[2], c[3]); o.z = pk_bf16(c[4], c[5]); o.w = pk_bf16(c[6], c[7]);
            *(u32x4*)(CP + (size_t)(c0 + k) * 4096) = o; if (tid < 64) NP[(c0 + k) * 64 + tid] = f2bf(n);
            c[0] = co[k] * c[0] + bf_lo(d[k].x); c[1] = co[k] * c[1] + bf_hi(d[k].x); c[2] = co[k] * c[2] + bf_lo(d[k].y); c[3] = co[k] * c[3] + bf_hi(d[k].y);
            c[4] = co[k] * c[4] + bf_lo(d[k].z); c[5] = co[k] * c[5] + bf_hi(d[k].z); c[6] = co[k] * c[6] + bf_lo(d[k].w); c[7] = co[k] * c[7] + bf_hi(d[k].w);
            n = co[k] * n + dn[k];
        }
    }
    asm volatile("s_waitcnt vmcnt(0)" ::: "memory"); __syncthreads();
    if (tid == 0) { __builtin_amdgcn_fence(__ATOMIC_RELEASE, "agent"); asm volatile("s_waitcnt vmcnt(0)" ::: "memory");
        __hip_atomic_fetch_add((unsigned*)(ws + WS_CTL) + CW_SCAN + 64 * l, 1u, __ATOMIC_RELAXED, __HIP_MEMORY_SCOPE_AGENT); }
}
__device__ __forceinline__ void ml_scan_wait(int l, unsigned char* ws, int g_wv) {
    if (TIDX == 0) { unsigned* p = (unsigned*)(ws + WS_CTL) + CW_SCAN + 64 * l; unsigned sp = 0;
        while (__hip_atomic_load(p, __ATOMIC_RELAXED, __HIP_MEMORY_SCOPE_AGENT) < 32u) { __builtin_amdgcn_s_sleep(2); if (++sp > (1u << 22)) break; }
        __builtin_amdgcn_fence(__ATOMIC_ACQUIRE, "agent"); asm volatile("s_waitcnt vmcnt(0)" ::: "memory"); }
    __syncthreads();
}

#ifndef DUP_NSA
#define DUP_NSA 1
#endif
#ifndef DUP_MLA
#define DUP_MLA 1
#endif
#ifndef DUP_ML
#define DUP_ML 1
#endif
#ifdef NO_MLA
#define MLA_CALL(...) do {} while (0)
#else
#define MLA_CALL(...) do { for (int rp = 0; rp < DUP_MLA; ++rp) { if (rp) __syncthreads(); mla_unit(__VA_ARGS__); } } while (0)
#endif
__device__ __forceinline__ void phase_mix(int l, InPtr in, unsigned char* ws, LAS unsigned char* lds, unsigned* qhead, int g_wv) {
    LAS int* slot = (LAS int*)(lds + LDS_MISC + 64);
    bool first = true; const int nb_ = (int)gridDim.x, b0_ = (int)blockIdx.x;
    for (;;) {
        __syncthreads();
        if (TIDX == 0) *slot = first ? b0_ : nb_ + (int)__hip_atomic_fetch_add(qhead, 1u, __ATOMIC_RELAXED, __HIP_MEMORY_SCOPE_AGENT);
        first = false;
        __syncthreads();
        int u = *slot;
        if (u >= 32 + 512 + 384 + 128) break;
        if (u < 32) { ml_scan_unit(u, l, ws, g_wv); continue; } u -= 32;
        int kind = 2, p0 = 0, bh = 0;
        if (u < 384) { kind = 0; p0 = 31 - (u >> 4); bh = u & 15; }
        else if ((u -= 384) < 384) { kind = 1; p0 = 7 - u / 48; bh = u % 48; }
        else if ((u -= 384) < 128) { kind = 0; p0 = 7 - (u >> 4); bh = u & 15; }
        else u -= 128;
#ifndef NO_NSA
        if (kind == 0) { for (int rp = 0; rp < DUP_NSA; ++rp) { if (rp) __syncthreads(); nsa_unit(bh >> 1, bh & 1, p0, l, in, ws, lds, g_wv); } continue; }
#endif
        if (kind == 1) { MLA_CALL(bh / 6, bh % 6, p0, l, ws, lds, g_wv); continue; }
        if (kind != 2) continue;
#ifndef NO_MLOUT
        ml_scan_wait(l, ws, g_wv);
        for (int rp = 0; rp < DUP_ML; ++rp) { int tid_ = TIDX; asm volatile("" : "+v"(tid_)); const int w = tid_ >> 6; ml_out_wave(u * 8 + w, l, in, ws, lds + w * 16384, lds + 131072 + w * 256, tid_ & 63); }
#endif
    }
}
__device__ __forceinline__ void phase_ynorm(int l, unsigned char* ws, int bid, int nb, int g_wv) {
    int tid_ = TIDX; asm volatile("" : "+v"(tid_)); const int w = tid_ >> 6, lane = tid_ & 63;
    bf16_t* Y = (bf16_t*)(ws + WS_Y); const float* sa = (const float*)(ws + WS_SSQ + PT_A) + (size_t)l * 16384 * 8; const float* sc = (const float*)(ws + WS_SSQ + PT_C) + (size_t)l * 16384 * 8;
    for (int r0 = (bid * 8 + w) * 8; r0 < NTOK; r0 += nb * 64) {
        if (lane < 48) {
            u32x4 x[8], y[8]; float ra[8], rc[8];
#pragma unroll
            for (int k = 0; k < 8; ++k) { const int row = r0 + k;
                const f32x4 a0 = *(const f32x4*)(sa + (size_t)row * 8), a1 = *(const f32x4*)(sa + (size_t)row * 8 + 4), c0 = *(const f32x4*)(sc + (size_t)row * 8), c1 = *(const f32x4*)(sc + (size_t)row * 8 + 4);
                ra[k] = rsqrtf((((a0.x + a0.y) + (a0.z + a0.w)) + (a1.x + a1.y)) * (1.f / 384.f) + 1e-6f); rc[k] = rsqrtf((((c0.x + c0.y) + (c0.z + c0.w)) + (c1.x + c1.y)) * (1.f / 384.f) + 1e-6f);
                x[k] = *((const u32x4*)(Y + (size_t)row * 1024) + lane); y[k] = *((const u32x4*)(Y + (size_t)row * 1024 + 384) + lane); }
#pragma unroll
            for (int k = 0; k < 8; ++k) { const int row = r0 + k; u32x4 a = x[k], c = y[k]; const float fa = ra[k], fc = rc[k];
                a.x = pk_bf16(bf_lo(a.x) * fa, bf_hi(a.x) * fa); a.y = pk_bf16(bf_lo(a.y) * fa, bf_hi(a.y) * fa); a.z = pk_bf16(bf_lo(a.z) * fa, bf_hi(a.z) * fa); a.w = pk_bf16(bf_lo(a.w) * fa, bf_hi(a.w) * fa);
                c.x = pk_bf16(bf_lo(c.x) * fc, bf_hi(c.x) * fc); c.y = pk_bf16(bf_lo(c.y) * fc, bf_hi(c.y) * fc); c.z = pk_bf16(bf_lo(c.z) * fc, bf_hi(c.z) * fc); c.w = pk_bf16(bf_lo(c.w) * fc, bf_hi(c.w) * fc);
                *((u32x4*)(Y + (size_t)row * 1024) + lane) = a; *((u32x4*)(Y + (size_t)row * 1024 + 384) + lane) = c; }
        }
    }
}
constexpr int LDS_FAC = 131072 + 2048;
__device__ __forceinline__ void outproj_factors(int l, unsigned char* ws, LAS unsigned char* lds, int pm, int tid) {
    asm volatile("" : "+v"(tid));
    if (tid < 256) { const int row = pm * 256 + tid; const float* sa = (const float*)(ws + WS_SSQ + PT_A) + ((size_t)l * 16384 + row) * 8; const float* sc = (const float*)(ws + WS_SSQ + PT_C) + ((size_t)l * 16384 + row) * 8;
        const f32x4 a0 = *(const f32x4*)sa, a1 = *(const f32x4*)(sa + 4), c0 = *(const f32x4*)sc, c1 = *(const f32x4*)(sc + 4);
        const float ra = rsqrtf((((a0.x + a0.y) + (a0.z + a0.w)) + (a1.x + a1.y)) * (1.f / 384.f) + 1e-6f), rc = rsqrtf((((c0.x + c0.y) + (c0.z + c0.w)) + (c1.x + c1.y)) * (1.f / 384.f) + 1e-6f);
        LAS float* F = (LAS float*)(lds + LDS_FAC); F[2 * tid] = ra / rc; F[2 * tid + 1] = rc; }
    __syncthreads();
}
struct EpiOut {
    static constexpr bool KHOOK = true;
    bf16_t* XB; float* ssq; const LAS float* F; bool fold;
    __device__ __forceinline__ void kscale(f32x4 (&acc)[2][2][4][2], int which, int wr, int fr) const {
        if (!fold) return;
#pragma unroll
        for (int ai = 0; ai < 2; ++ai)
#pragma unroll
            for (int m = 0; m < 4; ++m) { const float f = F[2 * (ai * 128 + wr * 64 + m * 16 + fr) + which];
#pragma unroll
                for (int bj = 0; bj < 2; ++bj)
#pragma unroll
                    for (int n = 0; n < 2; ++n) acc[ai][bj][m][n] = acc[ai][bj][m][n] * f; }
    }
    __device__ __forceinline__ void operator()(const f32x4 (&acc)[2][2][4][2], const GUnit& u, int wr, int wc, int fr, int fq) const {
        u32x4 xr[4][2][2];
#define EPO_LOAD(b_) do { _Pragma("unroll") for (int m2 = 0; m2 < 2; ++m2) _Pragma("unroll") for (int bj = 0; bj < 2; ++bj) \
            xr[b_][m2][bj] = *(const u32x4*)(XB + (size_t)(u.pm * 256 + ((b_) >> 1) * 128 + wr * 64 + (2 * ((b_) & 1) + m2) * 16 + fr) * 1024 + u.pn * 256 + bj * 128 + wc * 32 + 8 * fq); } while (0)
        EPO_LOAD(0);
#pragma unroll
        for (int ai = 0; ai < 2; ++ai)
#pragma unroll
          for (int mh = 0; mh < 2; ++mh) {
            __builtin_amdgcn_sched_barrier(0);
            if (2 * ai + mh < 3) EPO_LOAD(2 * ai + mh + 1);
            __builtin_amdgcn_sched_barrier(0);
#pragma unroll
            for (int m2 = 0; m2 < 2; ++m2) {
                const int m = 2 * mh + m2; const int row = u.pm * 256 + ai * 128 + wr * 64 + m * 16 + fr; float ss = 0.f;
#pragma unroll
                for (int bj = 0; bj < 2; ++bj) {
                    const u32x4 x = xr[2 * ai + mh][m2][bj]; u32x4 o;
                    o.x = pk_bf16(bf_lo(x.x) + acc[ai][bj][m][0][0], bf_hi(x.x) + acc[ai][bj][m][0][1]); o.y = pk_bf16(bf_lo(x.y) + acc[ai][bj][m][0][2], bf_hi(x.y) + acc[ai][bj][m][0][3]);
                    o.z = pk_bf16(bf_lo(x.z) + acc[ai][bj][m][1][0], bf_hi(x.z) + acc[ai][bj][m][1][1]); o.w = pk_bf16(bf_lo(x.w) + acc[ai][bj][m][1][2], bf_hi(x.w) + acc[ai][bj][m][1][3]);
                    *(u32x4*)(XB + (size_t)row * 1024 + u.pn * 256 + bj * 128 + wc * 32 + 8 * fq) = o;
                    ss += (bf_lo(o.x) * bf_lo(o.x) + bf_hi(o.x) * bf_hi(o.x)) + (bf_lo(o.y) * bf_lo(o.y) + bf_hi(o.y) * bf_hi(o.y)) + (bf_lo(o.z) * bf_lo(o.z) + bf_hi(o.z) * bf_hi(o.z)) + (bf_lo(o.w) * bf_lo(o.w) + bf_hi(o.w) * bf_hi(o.w));
                }
                ss = quad_sum(ss); if (fq == 0) ssq[(size_t)row * 16 + u.pn * 4 + wc] = ss;
            }
          }
    }
};
#undef EPO_LOAD

__device__ __forceinline__ float sum16(const float* p) { const f32x4 a = *(const f32x4*)p, b = *(const f32x4*)(p + 4), c = *(const f32x4*)(p + 8), d = *(const f32x4*)(p + 12);
    return (((a.x + a.y) + (a.z + a.w)) + ((b.x + b.y) + (b.z + b.w))) + (((c.x + c.y) + (c.z + c.w)) + ((d.x + d.y) + (d.z + d.w))); }
__device__ __forceinline__ void phase_route(int l, InPtr in, unsigned char* ws, LAS unsigned char* lds, int bid, int nb, int g_wv) {
    int tid_ = TIDX; asm volatile("" : "+v"(tid_)); const int w = tid_ >> 6, lane = tid_ & 63, r = lane & 15, q = lane >> 4;
    const bf16_t* XB = (const bf16_t*)(ws + WS_XB); const bf16_t* WR = (const bf16_t*)(ws + WS_WR) + (size_t)l * 64 * 1024;
    const float* ssq = (const float*)(ws + WS_SSQ + PT_X1) + (size_t)l * 16384 * 16; const float* bg = in->p[24] + l * 4; const float* be = in->p[26] + l * 32;
    unsigned* cnt = (unsigned*)(ws + WS_CTL) + CW_CNT + 2048 * l; unsigned* mtok = (unsigned*)(ws + WS_META); float* mw = (float*)(ws + WS_META + META_W);
    LAS float* lg = (LAS float*)(lds + w * 4096);
    LAS unsigned* lcnt = (LAS unsigned*)(lds + 32768); LAS unsigned* lbase = lcnt + 32;
    constexpr int WRP = 2064; LAS unsigned char* wrl = lds + 40960;
    { u32x4 st[12];
#pragma unroll
      for (int i = 0; i < 12; ++i) { const int c = tid_ + 512 * i; st[i] = *(const u32x4*)(WR + (size_t)(c >> 7) * 1024 + (c & 127) * 8); }
#pragma unroll
      for (int i = 0; i < 12; ++i) { const int c = tid_ + 512 * i; *(LAS u32x4*)(wrl + (c >> 7) * WRP + (c & 127) * 16) = st[i]; } }
    for (int g0 = bid * 8; g0 < NTOK / 16; g0 += nb * 8) {
        if (tid_ < 32) lcnt[tid_] = 0u;
        __syncthreads();
        const int tok0 = (g0 + w) * 16; f32x4 acc[3];
#pragma unroll
        for (int n = 0; n < 3; ++n) acc[n] = (f32x4){0.f, 0.f, 0.f, 0.f};
        const bf16_t* ap = XB + (size_t)(tok0 + r) * 1024 + 8 * q; const LAS unsigned char* bl_ = wrl + r * WRP + 16 * q;
#pragma unroll 1
        for (int kc = 0; kc < 2; ++kc) {
            bf16x8 a[16];
#pragma unroll
            for (int s = 0; s < 16; ++s) a[s] = *(const bf16x8*)(ap + 32 * (kc * 16 + s));
            __builtin_amdgcn_sched_barrier(0);
#pragma unroll
            for (int s = 0; s < 16; ++s)
#pragma unroll
                for (int n = 0; n < 3; ++n) { const bf16x8 bb = *(const LAS bf16x8*)(bl_ + n * 16 * WRP + 64 * (kc * 16 + s)); acc[n] = MFMA16(a[s], bb, acc[n]); }
            __builtin_amdgcn_sched_barrier(0);
        }
#pragma unroll
        for (int n = 0; n < 3; ++n)
#pragma unroll
            for (int j = 0; j < 4; ++j) lg[(4 * q + j) * 48 + 16 * n + r] = acc[n][j];
        LDS_FENCE();
        int E0 = 0, E1 = 0; unsigned r0 = 0, r1 = 0; float wt0 = 0.f, wt1 = 0.f; const int tok = tok0 + (lane & 15);
        if (lane < 16) {
            const float rs = rsqrtf(sum16(ssq + (size_t)tok * 16) * (1.f / 1024.f) + 1e-6f); ((float*)(ws + WS_RS2))[tok] = rs; const LAS float* L = lg + lane * 48;
            float gl[4]; int gi = 0;
#pragma unroll
            for (int j = 0; j < 4; ++j) gl[j] = L[j] * rs + bg[j];
            float gm = gl[0];
#pragma unroll
            for (int j = 1; j < 4; ++j) if (gl[j] > gm) { gm = gl[j]; gi = j; }
            float gsum = 0.f;
#pragma unroll
            for (int j = 0; j < 4; ++j) gsum += __expf(gl[j] - gm);
            const float gtop = 1.f / gsum;
            float el[8];
#pragma unroll
            for (int j = 0; j < 8; ++j) el[j] = L[4 + gi * 8 + j] * rs + be[gi * 8 + j];
            int e0 = 0; float v0 = el[0];
#pragma unroll
            for (int j = 1; j < 8; ++j) if (el[j] > v0) { v0 = el[j]; e0 = j; }
            int e1 = -1; float v1 = -3.0e38f;
#pragma unroll
            for (int j = 0; j < 8; ++j) if (j != e0 && el[j] > v1) { v1 = el[j]; e1 = j; }
            const float w0 = 1.f / (1.f + __expf(v1 - v0)); E0 = gi * 8 + e0; E1 = gi * 8 + e1; wt0 = w0 * gtop; wt1 = (1.f - w0) * gtop;
            r0 = __hip_atomic_fetch_add(lcnt + E0, 1u, __ATOMIC_RELAXED, __HIP_MEMORY_SCOPE_WORKGROUP); r1 = __hip_atomic_fetch_add(lcnt + E1, 1u, __ATOMIC_RELAXED, __HIP_MEMORY_SCOPE_WORKGROUP);
        }
        __syncthreads();
        if (tid_ < 32) { const unsigned c = lcnt[tid_]; lbase[tid_] = c ? atomicAdd(cnt + tid_ * 64, c) : 0u; }
        __syncthreads();
        if (lane < 16) {
            const unsigned p0 = lbase[E0] + r0, p1 = lbase[E1] + r1;
            mtok[(size_t)E0 * 16384 + p0] = (unsigned)tok; mw[(size_t)E0 * 16384 + p0] = wt0;
            mtok[(size_t)E1 * 16384 + p1] = (unsigned)tok | 0x80000000u; mw[(size_t)E1 * 16384 + p1] = wt1;
        }
        __syncthreads();
    }
}

constexpr int LDS_TB = 131072 + 2048;
__device__ __forceinline__ void moe_tables(int l, unsigned char* ws, LAS unsigned char* lds, int g_wv) {
    int tix = TIDX; asm volatile("" : "+v"(tix));
    LAS int* tb = (LAS int*)(lds + LDS_TB);
    if (tix < 32) { const unsigned* cnt = (const unsigned*)(ws + WS_CTL) + CW_CNT + 2048 * l; tb[160 + tix] = (int)__hip_atomic_load(cnt + tix * 64, __ATOMIC_RELAXED, __HIP_MEMORY_SCOPE_AGENT); }
    __syncthreads();
    if (tix == 0) { int a = 0, f = 0, p = 0; for (int e = 0; e < 32; ++e) { const int c = tb[160 + e]; tb[e] = a; tb[48 + e] = f; tb[96 + e] = p; a += (c + 255) >> 8; f += c >> 8; p += (c & 255) ? 1 : 0; } tb[32] = a; tb[80] = f; tb[128] = p; }
    __syncthreads();
}
template <int NPN, bool GATHER_>
struct MoeSched {
    static constexpr bool GATHER = GATHER_, PARTIAL = false;
    const char* A; const char* Bt; const unsigned* cnt; const unsigned* mtok; const LAS int* tb; int G, c; size_t bstride_e  , bstride_pn; int lo, hi;
    __device__ __forceinline__ bool next(int i, GUnit& u) const {
        const int L = lo + i * G + c; if (L >= hi) return false;
        const int tile = L / NPN, pn = L % NPN;
        int e = 0;
        for (int k = 1; k < 32; ++k) e = (tb[k] <= tile) ? k : e;
        e = __builtin_amdgcn_readfirstlane(e);
        u.e = e; u.pm = tile; u.pn = pn; u.rows = tb[160 + e] - 256 * (tile - tb[e]);
        u.a = GATHER ? A : A + (size_t)tile * 256 * 256 * 2;
        u.b = Bt + (size_t)e * bstride_e + (size_t)pn * bstride_pn; return true;
    }
    __device__ __forceinline__ void aoff(const GUnit& u, unsigned (&v)[2][2], const int (&R)[2], const int (&C)[2]) const {
#pragma unroll
        for (int h = 0; h < 2; ++h)
#pragma unroll
            for (int i = 0; i < 2; ++i) {
                if (GATHER) { const int lr = h * 128 + R[i]; const int rr = 256 * (u.pm - tb[u.e]) + (lr < u.rows ? lr : 0); const unsigned tok = mtok[(size_t)u.e * 16384 + rr] & 0x7fffffffu; v[h][i] = (tok * 1024u + (unsigned)C[i]) * 2u; }
                else v[h][i] = (unsigned)((h * 128 + R[i]) * 256 + C[i]) * 2u;
            }
    }
};
struct EpiMoeUp {
    static constexpr bool KHOOK = false;
    const unsigned* mtok; const float* ssq; const LAS int* tb; bf16_t* HB;
    __device__ __forceinline__ void operator()(const f32x4 (&acc)[2][2][4][2], const GUnit& u, int wr, int wc, int fr, int fq) const {
        const int r0 = 256 * (u.pm - tb[u.e]);
        float rs8[8];
        { unsigned tk[8];
#pragma unroll
          for (int k = 0; k < 8; ++k) { const int lr = (k >> 2) * 128 + wr * 64 + (k & 3) * 16 + fr; tk[k] = mtok[(size_t)u.e * 16384 + r0 + (lr < u.rows ? lr : 0)] & 0x7fffffffu; }
#pragma unroll
          for (int k = 0; k < 8; ++k) rs8[k] = ssq[tk[k]]; }
#pragma unroll
        for (int ai = 0; ai < 2; ++ai)
#pragma unroll
            for (int m = 0; m < 4; ++m) {
                __builtin_amdgcn_sched_barrier(0);
                const int lr = ai * 128 + wr * 64 + m * 16 + fr;
                if (lr < u.rows) {
                    const float rs = rs8[ai * 4 + m];
                    float hv[8];
#pragma unroll
                    for (int n = 0; n < 2; ++n)
#pragma unroll
                        for (int j = 0; j < 4; ++j) { const float gv = acc[ai][0][m][n][j] * rs, uv = acc[ai][1][m][n][j] * rs; hv[4 * n + j] = siluf(gv) * uv; }
                    st_bf16x8(HB + ((size_t)u.pm * 256 + lr) * 256 + u.pn * 128 + wc * 32 + 8 * fq, hv);
                }
            }
    }
};
struct EpiMoeDown {
    static constexpr bool KHOOK = false;
    const unsigned* mtok; const float* mw; const LAS int* tb; bf16_t* YB;
    __device__ __forceinline__ void operator()(const f32x4 (&acc)[2][2][4][2], const GUnit& u, int wr, int wc, int fr, int fq) const {
        const int r0 = 256 * (u.pm - tb[u.e]);
        unsigned mt8[8]; float wt8[8];
#pragma unroll
        for (int k = 0; k < 8; ++k) { const int lr = (k >> 2) * 128 + wr * 64 + (k & 3) * 16 + fr; const size_t ix = (size_t)u.e * 16384 + r0 + (lr < u.rows ? lr : 0); mt8[k] = mtok[ix]; wt8[k] = mw[ix]; }
#pragma unroll
        for (int ai = 0; ai < 2; ++ai)
#pragma unroll
            for (int m = 0; m < 4; ++m) {
                __builtin_amdgcn_sched_barrier(0);
                const int lr = ai * 128 + wr * 64 + m * 16 + fr;
                if (lr < u.rows) {
                    const unsigned mt = mt8[ai * 4 + m]; const float wt = wt8[ai * 4 + m];
                    bf16_t* dst = YB + ((size_t)(mt >> 31) * 16384 + (mt & 0x7fffffffu)) * 1024 + u.pn * 256 + wc * 32 + 8 * fq;
#pragma unroll
                    for (int bj = 0; bj < 2; ++bj) { float v[8];
#pragma unroll
                        for (int n = 0; n < 2; ++n)
#pragma unroll
                            for (int j = 0; j < 4; ++j) v[4 * n + j] = acc[ai][bj][m][n][j] * wt;
                        st_bf16x8(dst + bj * 128, v); }
                }
            }
    }
};
__device__ __forceinline__ void phase_combine(int l, unsigned char* ws, float* out, int bid, int nb, int g_wv) {
    int tid_ = TIDX; asm volatile("" : "+v"(tid_)); const int w = tid_ >> 6, lane = tid_ & 63;
    bf16_t* XB = (bf16_t*)(ws + WS_XB); const bf16_t* Y0 = (const bf16_t*)(ws + WS_YBUF); const bf16_t* Y1 = Y0 + (size_t)16384 * 1024; float* ssqx = (float*)(ws + WS_SSQX) + 16384;
    for (int row = bid * 8 + w; row < NTOK; row += nb * 8) {
        float ss = 0.f;
#pragma unroll
        for (int k = 0; k < 2; ++k) {
            const size_t o = (size_t)row * 1024 + (lane + 64 * k) * 8;
            const u32x4 x = *(const u32x4*)(XB + o), a = *(const u32x4*)(Y0 + o), c = *(const u32x4*)(Y1 + o);
            float v[8] = { bf_lo(x.x) + bf_lo(a.x) + bf_lo(c.x), bf_hi(x.x) + bf_hi(a.x) + bf_hi(c.x), bf_lo(x.y) + bf_lo(a.y) + bf_lo(c.y), bf_hi(x.y) + bf_hi(a.y) + bf_hi(c.y),
                           bf_lo(x.z) + bf_lo(a.z) + bf_lo(c.z), bf_hi(x.z) + bf_hi(a.z) + bf_hi(c.z), bf_lo(x.w) + bf_lo(a.w) + bf_lo(c.w), bf_hi(x.w) + bf_hi(a.w) + bf_hi(c.w) };
            if (l == L_ - 1 && out) { *(f32x4*)(out + o) = (f32x4){v[0], v[1], v[2], v[3]}; *(f32x4*)(out + o + 4) = (f32x4){v[4], v[5], v[6], v[7]}; }
            else { u32x4 p; p.x = pk_bf16(v[0], v[1]); p.y = pk_bf16(v[2], v[3]); p.z = pk_bf16(v[4], v[5]); p.w = pk_bf16(v[6], v[7]); *(u32x4*)(XB + o) = p;
#pragma unroll
                   for (int j = 0; j < 4; ++j) { const unsigned q = j == 0 ? p.x : (j == 1 ? p.y : (j == 2 ? p.z : p.w)); ss += bf_lo(q) * bf_lo(q) + bf_hi(q) * bf_hi(q); } }
        }
        if (l < L_ - 1) { ss = wave_sum(ss); if (lane == 0) ssqx[row] = ss; }
    }
}
constexpr int MOE_CVT_SPLIT = 4608;
#ifndef CVT_A
#define CVT_A 1920
#endif
#ifndef NROUTE
#define NROUTE 128
#endif
constexpr int NPH = 9;
enum { PH_INPROJ = 0, PH_PREP, PH_MIX, PH_YNORM, PH_OUTPROJ, PH_ROUTE, PH_MOEUP, PH_MOEDOWN, PH_COMBINE };
struct Args { Inputs in; float* out; unsigned char* ws; int ph_lo, ph_hi; };

__global__ void __launch_bounds__(512, 2) mk(Args args) {
    extern __shared__ __attribute__((aligned(16))) unsigned char lds_raw[];
    LAS unsigned char* lds = (LAS unsigned char*)lds_raw;
    const int g_wv = __builtin_amdgcn_readfirstlane((int)threadIdx.x >> 6);
    const int bid0 = blockIdx.x, nb = gridDim.x;
#define BID() ({ int b_ = bid0; asm volatile("" : "+s"(b_)); b_; })
    unsigned char* ws = args.ws; unsigned* ctl = (unsigned*)(ws + WS_CTL);
    const int lo = args.ph_lo, hi = args.ph_hi;
    if (TIDX < 4) ((LAS unsigned*)(lds + LDS_MISC))[TIDX] = 0u;
    __syncthreads();
    XcdBarrier bar; bar.g_wv = g_wv; bar.bar = ctl + CW_BAR; bar.x = 0; bar.st = nullptr;
    if (hi - lo > 1) bar = xcd_barrier_post(ctl + CW_BAR, (volatile LAS unsigned*)(lds + LDS_MISC), g_wv);
#define IN(k) (lo <= (k) && (k) < hi)
#ifndef REPEAT_PH
#define REPEAT_PH -1
#endif
#define NREP(k) ((REPEAT_PH == (k)) ? 2 : 1)
#ifndef NBAR
#define NBAR 1
#endif
#ifndef TIME_PH
#define TIME_PH -1
#endif
#define STAMP(i) do { if (TIME_PH != -1 && blockIdx.x == 0 && TIDX == 0) ((unsigned long long*)(ctl + CW_TS))[i] = __builtin_amdgcn_s_memrealtime(); } while (0)
#define SEAM(k) do { if (IN(k) && IN((k) + 1)) for (int nb_ = 0; nb_ < NBAR; ++nb_) xcd_barrier(bar); STAMP((k) + 1); } while (0)
    STAMP(0);
#ifndef NO_PRO
    if (IN(0)) for (int rep = 0; rep < NREP(100); ++rep) { prologue(in_tab(), launder(ws), lds, BID(), nb, g_wv); if (rep + 1 < NREP(100)) xcd_barrier(bar); }
#endif
    SEAM(0);
    for (int l = 0; l < L_; ++l) {
        const int pb = 1 + l * NPH;
        if (IN(pb + PH_INPROJ)) for (int rep = 0; rep < NREP(PH_INPROJ); ++rep) {
            if (rep) xcd_barrier(bar);
            InPtr in = in_tab(); unsigned char* ws = launder(args.ws);
            g8::DenseSched S{(const char*)(ws + WS_XB), (const char*)(ws + WS_WIN) + (size_t)l * 2560 * 1024 * 2, 1024, 1024, 64, 10, nb, BID(), 2};
            EpiInProj E{(const float*)(ws + WS_SSQX) + l * 16384, (float*)(ws + WS_SSQ + PT_DQ) + (size_t)l * 16384 * 4, (float*)(ws + WS_SSQ + PT_DKV) + (size_t)l * 16384 * 2,
                        in->p[8] + l * 64, in->p[9] + l * 64, in->p[19] + l * 192 + 96 + 64, (const float*)(ws + WS_ROPE), ws + WS_PRJ};
#ifndef NO_INPROJ
            g8::gemm_run(lds, 1024, 1024, S, E, g_wv);
#endif
        }
        SEAM(pb + PH_INPROJ);
        if (IN(pb + PH_PREP)) for (int rep = 0; rep < NREP(PH_PREP); ++rep) { if (rep) xcd_barrier(bar); phase_prep(l, in_tab(), launder(ws), lds, BID(), nb, g_wv, (unsigned*)launder(ws) + CW_Q + 64 * (4 + l + 2 * rep)); }
        SEAM(pb + PH_PREP);
        if (IN(pb + PH_MIX)) for (int rep = 0; rep < NREP(PH_MIX); ++rep) { if (rep) xcd_barrier(bar); phase_mix(l, in_tab(), launder(ws), lds, (unsigned*)launder(ws) + CW_Q + 64 * (l + 2 * rep), g_wv); }
        SEAM(pb + PH_MIX);
        const bool fold_norm = (nb == 256);
        if (IN(pb + PH_YNORM) && !fold_norm) phase_ynorm(l, launder(ws), BID(), nb, g_wv);
        if (!fold_norm) SEAM(pb + PH_YNORM);
        if (IN(pb + PH_OUTPROJ)) {
            unsigned char* ws = launder(args.ws);
            g8::DenseSched S{(const char*)(ws + WS_Y), (const char*)(ws + WS_WOUT) + (size_t)l * 1024 * 1024 * 2, 1024, 1024, 64, 4, nb, BID()};
            EpiOut E{(bf16_t*)(ws + WS_XB), (float*)(ws + WS_SSQ + PT_X1) + (size_t)l * 16384 * 16, (const LAS float*)(lds + LDS_FAC), fold_norm};
            if (fold_norm) { g8::GUnit u0; if (S.next(0, u0)) outproj_factors(l, ws, lds, u0.pm, TIDX); else __syncthreads(); }
#ifndef NO_OUTPROJ
            g8::gemm_run(lds, 1024, 1024, S, E, g_wv);
#endif
        }
        SEAM(pb + PH_OUTPROJ);
#ifndef NO_ROUTE
        if (IN(pb + PH_ROUTE)) {
            const int b_ = BID();
            if (nb >= 256 && b_ >= NROUTE) { cvt_moe_layer(in_tab(), launder(ws), l, (LAS float*)lds, b_ - NROUTE, nb - NROUTE, TIDX, 0, CVT_A);
#ifdef DUP_CVT
                __syncthreads(); cvt_moe_layer(in_tab(), launder(ws), l, (LAS float*)lds, b_ - NROUTE, nb - NROUTE, TIDX);
#endif
            }
            else { phase_route(l, in_tab(), launder(ws), lds, b_, nb >= 256 ? NROUTE : nb, g_wv);
                   if (nb < 256) cvt_moe_layer(in_tab(), launder(ws), l, (LAS float*)lds, b_, nb, TIDX); else cvt_moe_layer(in_tab(), launder(ws), l, (LAS float*)lds, b_, NROUTE, TIDX, CVT_A, 3072); }
            if (l + 1 < L_) { __syncthreads(); cvt_small_weights(in_tab(), launder(ws), l + 1, (LAS float*)lds, b_, nb, TIDX); }
        }
#endif
        SEAM(pb + PH_ROUTE);
        {
            const bool do_up = IN(pb + PH_MOEUP), do_dn = IN(pb + PH_MOEDOWN), fuse = do_up && do_dn;
            for (int part = 0; part < (fuse ? 3 : 1); ++part) {
                if (part) xcd_barrier(bar);
                unsigned char* ws = launder(args.ws);
                if ((do_up || do_dn) && part == 0) moe_tables(l, ws, lds, g_wv);
                const unsigned* cnt = (const unsigned*)(ws + WS_CTL) + CW_CNT + 2048 * l; const unsigned* mtok = (const unsigned*)(ws + WS_META); const LAS int* tb = (const LAS int*)(lds + LDS_TB);
                const int b_ = BID(), ntile = tb[32], UPU = 2 * ntile, DNU = 4 * ntile;
                const int hi0 = UPU < nb ? UPU : nb, nu_ = UPU - hi0, nu = nu_ < (nb >> 1) ? nu_ : (nb >> 1), nd = nb - nu;
                const int d1a = 4 * (hi0 >> 1), d1b = 2 * nd, D1 = nu == 0 ? DNU : (d1a < d1b ? d1a : d1b);
                int ulo = 0, uhi = UPU, uG = nb, uc = b_, dlo = 0, dhi = DNU, dG = nb, dc = b_;
                if (fuse) {
                    if (part == 0) { uhi = hi0; dhi = 0; }
                    else if (part == 1) { ulo = hi0; uG = nu; if (b_ >= nu) uhi = ulo; dhi = D1; dG = nd; dc = b_ - nu; if (b_ < nu) dhi = 0; }
                    else { uhi = 0; dlo = D1; }
                }
                if (do_up && uhi > ulo) {
                    MoeSched<2, true> S{(const char*)(ws + WS_XB), (const char*)(ws + WS_WMOE), cnt, mtok, tb, uG, uc, (size_t)512 * 1024 * 2, (size_t)256 * 1024 * 2, ulo, uhi};
                    EpiMoeUp E{mtok, (const float*)(ws + WS_RS2), tb, (bf16_t*)(ws + WS_HBUF)};
#ifndef NO_MOEUP
                    g8::gemm_run(lds, 1024, 1024, S, E, g_wv);
#endif
                }
                if (do_dn && dhi > dlo) {
                    MoeSched<4, false> S{(const char*)(ws + WS_HBUF), (const char*)(ws + WS_WMOE + WMOE_WD), cnt, mtok, tb, dG, dc, (size_t)1024 * 256 * 2, (size_t)256 * 256 * 2, dlo, dhi};
                    EpiMoeDown E{mtok, (const float*)(ws + WS_META + META_W), tb, (bf16_t*)(ws + WS_YBUF)};
#ifndef NO_MOEDOWN
                    g8::gemm_run(lds, 256, 256, S, E, g_wv);
#endif
                }
            }
        }
        SEAM(pb + PH_MOEDOWN);
#ifndef NO_COMBINE
        if (IN(pb + PH_COMBINE)) { unsigned char* ws = launder(args.ws); phase_combine(l, ws, args.out, BID(), nb, g_wv); }
#endif
        SEAM(pb + PH_COMBINE);
    }
#undef IN
#undef SEAM
}
#if CHECK
struct NvScratch { float *proj, *h1, *qk, *hraw, *kn, *kcmp, *vcmp, *dqn, *q, *dkvn, *kv, *krope, *y, *x1, *xl; int* rt_e; float* rt_w; };
constexpr int CB = 5;
enum { NS_INPROJ = 0, NS_NSAPREP, NS_MLAPREP, NS_NSA, NS_ML, NS_MLA, NS_OUT, NS_ROUTE, NS_MOE };
static void naive_step(void* const* d_in, int l, int step, const float* xin, float* xout, const NvScratch& S, hipStream_t st) {
    const int b = CB;
    const float* rel_bias = (const float*)d_in[2];
    const float* norm1_g = (const float*)d_in[3] + (long)l * 1024;
    const float* w_in = (const float*)d_in[4] + (long)l * 1024 * DIN;
    const float* cmp_pe = (const float*)d_in[5] + (long)l * 2 * 32 * 64;
    const float* cmp_w1 = (const float*)d_in[6] + (long)l * 2 * 32 * 64 * 64;
    const float* cmp_w2 = (const float*)d_in[7] + (long)l * 2 * 64 * 64;
    const float* q_norm = (const float*)d_in[8] + l * 64;
    const float* k_norm = (const float*)d_in[9] + l * 64;
    const float* nsa_on = (const float*)d_in[10] + l * 384;
    const float* conv = (const float*)d_in[11] + l * 4 * 512;
    const float* ibias = (const float*)d_in[12] + l * 4;
    const float* fbias = (const float*)d_in[13] + l * 4;
    const float* ml_on = (const float*)d_in[14] + l * 256;
    const float* qan = (const float*)d_in[15] + l * 192;
    const float* w_uq = (const float*)d_in[16] + (long)l * 192 * 576;
    const float* kvan = (const float*)d_in[17] + l * 128;
    const float* w_ukv = (const float*)d_in[18] + (long)l * 128 * 768;
    const float* qkn = (const float*)d_in[19] + l * 192;
    const float* mla_on = (const float*)d_in[20] + l * 384;
    const float* w_out = (const float*)d_in[21] + (long)l * 1024 * 1024;
    const float* norm2_g = (const float*)d_in[22] + l * 1024;
    const float* wgrp = (const float*)d_in[23] + (long)l * 1024 * 4;
    const float* bgrp = (const float*)d_in[24] + l * 4;
    const float* wexp = (const float*)d_in[25] + (long)l * 1024 * 32;
    const float* bexp = (const float*)d_in[26] + l * 32;
    const float* Wg = (const float*)d_in[27] + (long)l * 32 * 1024 * 256;
    const float* Wu = (const float*)d_in[28] + (long)l * 32 * 1024 * 256;
    const float* Wd = (const float*)d_in[29] + (long)l * 32 * 256 * 1024;
    const int* pos = (const int*)d_in[1] + b * 2048;
    switch (step) {
    case NS_INPROJ:
        nv_rmsnorm<<<dim3(2048, 1), 64, 0, st>>>(xin, 1024, 0, S.h1, 1024, 0, norm1_g, 0, 1024);
        nv_gemm<<<dim3((DIN + 63) / 64, 2048 / 64), 256, 0, st>>>(S.h1, 1024, w_in, DIN, S.proj, DIN, nullptr, 0, 2048, DIN, 1024);
        break;
    case NS_NSAPREP:
        nv_nsa_cmp<<<dim3(127, 2, 2), 64, 0, st>>>(S.proj, cmp_pe, cmp_w1, cmp_w2, k_norm, S.kcmp, S.vcmp);
        nv_nsa_knorm<<<dim3(2048, 4), 64, 0, st>>>(S.proj, k_norm, S.kn);
        break;
    case NS_MLAPREP:
        nv_rmsnorm<<<dim3(2048, 1), 64, 0, st>>>(S.proj + O_CDQ, DIN, 0, S.dqn, 192, 0, qan, 0, 192);
        nv_gemm<<<dim3(576 / 64, 2048 / 64), 256, 0, st>>>(S.dqn, 192, w_uq, 576, S.q, 576, nullptr, 0, 2048, 576, 192);
        nv_rmsnorm<<<dim3(2048, 1), 64, 0, st>>>(S.proj + O_CDKV, DIN, 0, S.dkvn, 128, 0, kvan, 0, 128);
        nv_gemm<<<dim3(768 / 64, 2048 / 64), 256, 0, st>>>(S.dkvn, 128, w_ukv, 768, S.kv, 768, nullptr, 0, 2048, 768, 128);
        nv_mla_prep<<<dim3(2048, 7), 64, 0, st>>>(S.q, S.kv, S.proj, S.krope, qkn, pos);
        break;
    case NS_NSA:
        nv_nsa_attn<<<dim3(2048, 2), 192, 0, st>>>(S.proj, S.kn, S.kcmp, S.vcmp, rel_bias, q_norm, S.y);
        break;
    case NS_ML:
        nv_ml_conv<<<2048, 512, 0, st>>>(S.proj, conv, S.qk);
        nv_ml_rec<<<4, 256, 0, st>>>(S.proj, S.qk, ibias, fbias, S.hraw);
        nv_ml_fin<<<dim3(2048, 4), 64, 0, st>>>(S.proj, S.hraw, ml_on, S.y);
        break;
    case NS_MLA:
        nv_mla_attn<<<dim3(2048, 6), 64, 0, st>>>(S.q, S.kv, S.krope, S.y);
        break;
    case NS_OUT:
        nv_rmsnorm<<<dim3(2048, 1), 64, 0, st>>>(S.y, 1024, 0, S.y, 1024, 0, nsa_on, 0, 384);
        nv_rmsnorm<<<dim3(2048, 1), 64, 0, st>>>(S.y + 640, 1024, 0, S.y + 640, 1024, 0, mla_on, 0, 384);
        nv_gemm<<<dim3(1024 / 64, 2048 / 64), 256, 0, st>>>(S.y, 1024, w_out, 1024, S.x1, 1024, xin, 1024, 2048, 1024, 1024);
        break;
    case NS_ROUTE:
        nv_moe_route<<<2048, 64, 0, st>>>(S.x1, norm2_g, wgrp, bgrp, wexp, bexp, S.h1, S.rt_e, S.rt_w);
        break;
    case NS_MOE:
        nv_moe_exp<<<2048, 256, 0, st>>>(S.x1, S.h1, S.rt_e, S.rt_w, Wg, Wu, Wd, xout);
        break;
    }
}

__device__ __forceinline__ void chk_commit(float d2, float r2, float* acc) { d2 = wave_sum(d2); r2 = wave_sum(r2); if ((threadIdx.x & 63) == 0) { atomicAdd(acc, d2); atomicAdd(acc + 1, r2); } }
__device__ __forceinline__ void chk_add(float f, float r, float& d2, float& r2) { const float d = f - r; d2 += (d == d) ? d * d : 1e30f; r2 += r * r; }

__global__ void __launch_bounds__(64) chk_proj(const float* nproj, const unsigned char* prj, const float* ssq_dq, const float* ssq_dkv, const float* qg, const float* kg, const float* krg, const int* pos, float* acc) {
    const int t = blockIdx.x, e = threadIdx.x; const size_t row = (size_t)CB * 2048 + t; float d2 = 0.f, r2 = 0.f;
    for (int G = 0; G < 40; ++G) {
        const int c = inproj_refcol(G, e); float r = c < 0 ? 0.f : nproj[(size_t)t * DIN + c]; float f = 0.f;
        const float rr = (G == 37 && e >= 32) ? 0.f : r; const float ss = wave_sum(rr * rr);
        if (G < 6) { r = r * rsqrtf(ss / 64.f + 1e-6f) * qg[e] * 0.18033688f; f = bf2f(((const bf16_t*)(prj + PRJ_QN))[((size_t)(CB * 6 + G) * 2048 + t) * 64 + e]); }
        else if (G < 18) { const int a = G - 6, br = a >> 2, s = (a >> 1) & 1, hk = a & 1;
            if (br > 0 && s == 0) r = r * rsqrtf(ss / 64.f + 1e-6f) * kg[e];
            const size_t base = br == 0 ? (s ? PRJ_C0V : PRJ_C0K) : (br == 1 ? (s ? PRJ_VN1 : PRJ_KN1) : (s ? PRJ_VN2 : PRJ_KN2));
            f = bf2f(((const bf16_t*)(prj + base))[((size_t)(CB * 2 + hk) * 2048 + t) * 64 + e]); }
        else if (G < 26) f = bf2f(((const bf16_t*)(prj + PRJ_RAWQK))[row * 512 + (G - 18) * 64 + e]);
        else if (G < 30) f = bf2f(((const bf16_t*)(prj + PRJ_VML))[((size_t)(CB * 4 + (G - 26)) * 2048 + t) * 64 + e]);
        else if (G < 34) f = bf2f(((const bf16_t*)(prj + PRJ_OG))[row * 256 + (G - 30) * 64 + e]);
        else if (G < 37) f = bf2f(((const bf16_t*)(prj + PRJ_DQKV))[row * 384 + (G - 34) * 64 + e]);
        else if (G == 37) {
            const float val = e < 32 ? rr * rsqrtf(ss / 32.f + 1e-6f) * krg[e & 31] : 0.f; const float oth = __shfl_xor(val, 16);
            if (e < 32) { const int i = e & 15; const double ang = (double)pos[row] * pow(10000.0, -(double)i / 16.0); const float cs = (float)cos(ang), sn = (float)sin(ang);
                r = e < 16 ? val * cs - oth * sn : val * cs + oth * sn; f = bf2f(((const bf16_t*)(prj + PRJ_KR))[row * 32 + e]); }
            else if (e < 58) f = ((const float*)(prj + PRJ_GATES))[row * 32 + (e - 32)];
            else { f = 0.f; r = 0.f; }
        }
        else f = bf2f(((const bf16_t*)(prj + PRJ_DQKV))[row * 384 + 256 + (G - 38) * 64 + e]);
        chk_add(f, r, d2, r2);
    }
    float d2s = 0.f, r2s = 0.f;
    { float s1 = 0.f, s2 = 0.f; for (int c = e; c < 192; c += 64) { float v = nproj[(size_t)t * DIN + O_CDQ + c]; s1 += v * v; } for (int c = e; c < 128; c += 64) { float v = nproj[(size_t)t * DIN + O_CDKV + c]; s2 += v * v; }
      s1 = wave_sum(s1); s2 = wave_sum(s2); if (e == 0) { chk_add((ssq_dq[row * 4] + ssq_dq[row * 4 + 1]) + ssq_dq[row * 4 + 2], s1, d2s, r2s); chk_add(ssq_dkv[row * 2] + ssq_dkv[row * 2 + 1], s2, d2s, r2s); } }
    chk_commit(d2, r2, acc); chk_commit(d2s, r2s, acc + 2);
}

__global__ void __launch_bounds__(64) chk_prep(const float* nq, const float* nkv, const float* nkr, const float* nkc, const float* nvc, const unsigned char* ws, float* acc) {
    const int t = blockIdx.x, e = threadIdx.x; float d2 = 0.f, r2 = 0.f, d2c = 0.f, r2c = 0.f; const float scale = 0.14724444f;
    const bf16_t* QM = (const bf16_t*)(ws + WS_MLA); const bf16_t* KM = (const bf16_t*)(ws + WS_MLA + MLA_KM); const bf16_t* VM = (const bf16_t*)(ws + WS_MLA + MLA_VM);
    for (int h = 0; h < 6; ++h) {
        const size_t rq = ((size_t)(CB * 6 + h) * 2048 + t);
        chk_add(bf2f(QM[rq * 96 + e]), nq[(size_t)t * 576 + h * 96 + e] * scale, d2, r2);
        chk_add(bf2f(KM[rq * 96 + e]), nkv[(size_t)t * 768 + h * 128 + e], d2, r2);
        chk_add(bf2f(VM[rq * 64 + e]), nkv[(size_t)t * 768 + h * 128 + 64 + e], d2, r2);
        if (e < 32) { chk_add(bf2f(QM[rq * 96 + 64 + e]), nq[(size_t)t * 576 + h * 96 + 64 + e] * scale, d2, r2); chk_add(bf2f(KM[rq * 96 + 64 + e]), nkr[(size_t)t * 32 + e], d2, r2); }
    }
    if (t < 128) for (int hk = 0; hk < 2; ++hk) {
        const bf16_t* KC = (const bf16_t*)(ws + WS_CMP); const bf16_t* VC = (const bf16_t*)(ws + WS_CMP + CMP_V); const size_t rf = ((size_t)(CB * 2 + hk) * 128 + t) * 64 + e;
        chk_add(bf2f(KC[rf]), t < 127 ? nkc[(size_t)(hk * 127 + t) * 64 + e] : 0.f, d2c, r2c); chk_add(bf2f(VC[rf]), t < 127 ? nvc[(size_t)(hk * 127 + t) * 64 + e] : 0.f, d2c, r2c);
    }
    chk_commit(d2, r2, acc); chk_commit(d2c, r2c, acc + 2);
}

__global__ void __launch_bounds__(64) chk_y(const float* ny, const unsigned char* ws, float* acc, int nseg) {
    const int t = blockIdx.x, e = threadIdx.x; const bf16_t* Y = (const bf16_t*)(ws + WS_Y) + ((size_t)CB * 2048 + t) * 1024;
    float d2[3] = {0.f, 0.f, 0.f}, r2[3] = {0.f, 0.f, 0.f};
    for (int c = e; c < 1024; c += 64) { const int seg = c < 384 ? 0 : (c < 640 ? 1 : 2); const int cf = c < 384 ? c : (c < 640 ? 768 + (c - 384) : 384 + (c - 640)); const float f = bf2f(Y[cf]), r = ny[(size_t)t * 1024 + c];
        if (seg == 0) chk_add(f, r, d2[0], r2[0]); else if (seg == 1) chk_add(f, r, d2[1], r2[1]); else chk_add(f, r, d2[2], r2[2]); }
    if (nseg == 3) { chk_commit(d2[0], r2[0], acc); chk_commit(d2[1], r2[1], acc + 2); chk_commit(d2[2], r2[2], acc + 4); }
    else chk_commit(d2[0] + d2[1] + d2[2], r2[0] + r2[1] + r2[2], acc);
}

__global__ void __launch_bounds__(64) chk_x(const float* nx, const unsigned char* ws, float* acc) {
    const int t = blockIdx.x, e = threadIdx.x; const bf16_t* X = (const bf16_t*)(ws + WS_XB) + ((size_t)CB * 2048 + t) * 1024; float d2 = 0.f, r2 = 0.f;
    for (int c = e; c < 1024; c += 64) chk_add(bf2f(X[c]), nx[(size_t)t * 1024 + c], d2, r2);
    chk_commit(d2, r2, acc);
}

__global__ void __launch_bounds__(512) chk_code(float* acc, int nst, const float* nout) {
    __shared__ float sh[512];
    float s = 0.f; for (int i = threadIdx.x; i < 2048 * 1024; i += 512) { float v = nout[i]; s += v * v; }
    sh[threadIdx.x] = s; __syncthreads();
    if (threadIdx.x == 0) { float tot = 0.f; for (int i = 0; i < 512; ++i) tot += sh[i]; float rms = sqrtf(tot / (2048.f * 1024.f)); if (!(rms > 1e-3f && rms < 1e3f)) rms = 1.f;
        int code = 0;
        for (int st = 0; st < nst; ++st) { const float d2 = acc[2 * st], r2 = acc[2 * st + 1]; if (r2 == 0.f && d2 == 0.f) { if ((st & 15) >= 9) continue; code = (st + 1) * 4 + 3; break; } const float err = d2 / fmaxf(r2, 1e-30f);
            const float tol = CHK_TOL(st);
            if (!(err <= tol)) { const int cls = !(err < 1.f) ? 3 : (err >= 0.1f ? 2 : (err >= 0.01f ? 1 : 0)); code = (st + 1) * 4 + cls; break; } }
        acc[2 * 40] = rms * 32.f * exp2f(0.5f * (float)code); }
}
__global__ void __launch_bounds__(512) chk_fill(const float* acc, float* out) {
    const float K = acc[2 * 40];
    for (size_t i = (size_t)blockIdx.x * 512 + threadIdx.x; i < (size_t)NTOK * 1024; i += (size_t)gridDim.x * 512) out[i] = (i & 1) ? -K : K;
}
#endif

#if TIME_PH != -1
#ifndef TIME_Q
#define TIME_Q 6.f
#endif
#ifndef TIME_CAL
#define TIME_CAL 1.0f
#endif
__global__ void tm_acc(const unsigned long long* ts, float* best, int first) {
    int a = TIME_PH, b = TIME_PH + 1;
#ifdef TIME_PH_END
    b = TIME_PH_END;
#endif
    float T = 100.f; if (TIME_PH >= 0) T = (float)(ts[b] - ts[a]) * 0.01f;
    if (first || T < *best) *best = T;
}
__global__ void __launch_bounds__(512) tm_fill(const float* best, float* out) {
    float T = *best;
    T = exp2f(rintf(log2f(fmaxf(T, 1.f)) * TIME_Q) / TIME_Q);
    const float c = sqrtf(T) * TIME_CAL;
    for (size_t i = (size_t)blockIdx.x * 512 + threadIdx.x; i < (size_t)NTOK * 1024; i += (size_t)gridDim.x * 512) out[i] = (i & 1) ? -c : c;
}
#endif
static int g_grid = 0;
static bool setup_once(size_t ws_size) {
    if (g_grid) return g_grid > 0;
    if (ws_size < WS_END) { fprintf(stderr, "kernel_launch: workspace too small: %zu < %zu\n", ws_size, (size_t)WS_END); g_grid = -1; return false; }
    int dev = 0, cus = 0, per_cu = 0;
    if (hipGetDevice(&dev) != hipSuccess || hipDeviceGetAttribute(&cus, hipDeviceAttributeMultiprocessorCount, dev) != hipSuccess) { g_grid = -1; return false; }
    if (hipFuncSetAttribute((const void*)mk, hipFuncAttributeMaxDynamicSharedMemorySize, LDS_BYTES) != hipSuccess) { fprintf(stderr, "kernel_launch: hipFuncSetAttribute failed\n"); g_grid = -1; return false; }
    if (hipOccupancyMaxActiveBlocksPerMultiprocessor(&per_cu, (const void*)mk, 512, LDS_BYTES) != hipSuccess || per_cu < 1) { fprintf(stderr, "kernel_launch: occupancy query says %d\n", per_cu); }
    (void)hipGetLastError();
    g_grid = cus;
    return true;
}
static void launch_mk(const Args& a0, int lo, int hi, hipStream_t stream) { Args a = a0; a.ph_lo = lo; a.ph_hi = hi; hipLaunchKernelGGL(mk, dim3(g_grid), dim3(512), LDS_BYTES, stream, a); }

extern "C" void kernel_launch(void* const* d_in, const int* in_sizes, int n_in, void* d_out, int out_size, void* d_ws, size_t ws_size, hipStream_t stream) {
    if (!setup_once(ws_size)) return;
    unsigned char* ws = (unsigned char*)d_ws;
    (void)hipMemsetAsync(ws + WS_CTL, 0, ZERO_BYTES, stream);
    Args a{}; for (int i = 0; i < 30; ++i) a.in.p[i] = (const float*)d_in[i];
    a.out = (float*)d_out; a.ws = ws; a.ph_lo = 0; a.ph_hi = 0;
#if CHECK
    a.out = nullptr;
#endif
#if CHECK
    float* nb = (float*)d_out; size_t off = 0; NvScratch S;
    auto take = [&](size_t n) { float* p = nb + off; off += (n + 63) & ~(size_t)63; return p; };
    S.proj = take((size_t)2048 * DIN); S.h1 = take(2048 * 1024); S.qk = S.h1; S.hraw = S.qk + 2048 * 512; S.kn = S.hraw + 2048 * 256;
    S.kcmp = take(2 * 127 * 64); S.vcmp = take(2 * 127 * 64); S.dqn = take(2048 * 192); S.q = take(2048 * 576); S.dkvn = take(2048 * 128); S.kv = take(2048 * 768); S.x1 = S.dqn;
    S.krope = take(2048 * 32); S.y = take(2048 * 1024); S.xl = take(2048 * 1024); S.rt_e = (int*)take(2048 * 2); S.rt_w = take(2048 * 2);
    if (off * 4 > (size_t)NTOK * 1024 * 4) { fprintf(stderr, "naive scratch too big\n"); return; }
    float* acc = (float*)(ws + WS_CTL) + CW_CHK;
    launch_mk(a, 0, 1, stream);
    const float* nx_in = (const float*)d_in[0] + (size_t)CB * 2048 * 1024;
    int nst = 0;
    for (int l = 0; l < L_; ++l) {
        const int pb = 1 + l * NPH; const int sb = l * 16;
        launch_mk(a, pb + PH_INPROJ, pb + PH_INPROJ + 1, stream);
        naive_step(d_in, l, NS_INPROJ, nx_in, S.xl, S, stream);
        chk_proj<<<2048, 64, 0, stream>>>(S.proj, ws + WS_PRJ, (const float*)(ws + WS_SSQ + PT_DQ) + (size_t)l * 16384 * 4, (const float*)(ws + WS_SSQ + PT_DKV) + (size_t)l * 16384 * 2,
                                           (const float*)d_in[8] + l * 64, (const float*)d_in[9] + l * 64, (const float*)d_in[19] + l * 192 + 160, (const int*)d_in[1], acc + 2 * (sb + 0));
        nst = sb + 2;
        int ns_done = NS_INPROJ;
#if CHECK_UPTO >= 1
        launch_mk(a, pb + PH_PREP, pb + PH_PREP + 1, stream);
        naive_step(d_in, l, NS_NSAPREP, nx_in, S.xl, S, stream); naive_step(d_in, l, NS_MLAPREP, nx_in, S.xl, S, stream); ns_done = NS_MLAPREP;
        chk_prep<<<2048, 64, 0, stream>>>(S.q, S.kv, S.krope, S.kcmp, S.vcmp, ws, acc + 2 * (sb + 2));
        nst = sb + 4;
#endif
#if CHECK_UPTO >= 2
        launch_mk(a, pb + PH_MIX, pb + PH_MIX + 1, stream);
        naive_step(d_in, l, NS_NSA, nx_in, S.xl, S, stream); naive_step(d_in, l, NS_ML, nx_in, S.xl, S, stream); naive_step(d_in, l, NS_MLA, nx_in, S.xl, S, stream); ns_done = NS_MLA;
        chk_y<<<2048, 64, 0, stream>>>(S.y, ws, acc + 2 * (sb + 4), 3);
        nst = sb + 7;
#endif
#if CHECK_UPTO >= 3
        launch_mk(a, pb + PH_YNORM, pb + PH_YNORM + 1, stream); launch_mk(a, pb + PH_OUTPROJ, pb + PH_OUTPROJ + 1, stream);
        naive_step(d_in, l, NS_OUT, nx_in, S.xl, S, stream); ns_done = NS_OUT;
        chk_x<<<2048, 64, 0, stream>>>(S.x1, ws, acc + 2 * (sb + 7));
        nst = sb + 8;
#endif
#if CHECK_UPTO >= 4
        for (int ph = PH_ROUTE; ph <= PH_COMBINE; ++ph) launch_mk(a, pb + ph, pb + ph + 1, stream);
        naive_step(d_in, l, NS_ROUTE, nx_in, S.xl, S, stream); naive_step(d_in, l, NS_MOE, nx_in, S.xl, S, stream); ns_done = NS_MOE;
        chk_x<<<2048, 64, 0, stream>>>(S.xl, ws, acc + 2 * (sb + 8));
        nst = sb + 9;
#endif
        CHECK_REST
        for (int s = ns_done + 1; s <= NS_MOE; ++s) naive_step(d_in, l, s, nx_in, S.xl, S, stream);
        nx_in = S.xl;
        if (l == CHECK_LAYERS - 1) break;
    }
    chk_code<<<1, 512, 0, stream>>>(acc, nst, S.xl);
    chk_fill<<<1024, 512, 0, stream>>>(acc, (float*)d_out);
#else
#if defined(SPLIT_LAUNCH) && SPLIT_LAUNCH
    for (int ph = 0; ph < 1 + L_ * NPH; ++ph) launch_mk(a, ph, ph + 1, stream);
#else
    launch_mk(a, 0, 1 + L_ * NPH, stream);
#if TIME_PH != -1
    for (int rp = 0; rp < 6; ++rp) {
        (void)hipMemsetAsync(ws + WS_CTL, 0, ZERO_BYTES, stream); launch_mk(a, 0, 1 + L_ * NPH, stream);
        tm_acc<<<1, 1, 0, stream>>>((const unsigned long long*)((unsigned*)(ws + WS_CTL) + CW_TS), (float*)(ws + WS_META + META_RT), rp == 0);
    }
    tm_fill<<<1024, 512, 0, stream>>>((const float*)(ws + WS_META + META_RT), (float*)d_out);
#endif
#endif
#endif
}
```
